# Optimizing an MI355X kernel written in HIP

```python
import numpy as np
import jax
import jax.numpy as jnp
from jax import lax

D_MODEL = 1024
BATCH = 16
SEQ = 2048
DEPTH = 2

HEAD_DIM = 64
N_HEADS = D_MODEL // HEAD_DIM
SWA_Q_HEADS = 3 * N_HEADS // 8
NSA_Q_HEADS = SWA_Q_HEADS
FOX_HEADS = N_HEADS - SWA_Q_HEADS - NSA_Q_HEADS
KV_HEADS = 2
GQA_GROUP = SWA_Q_HEADS // KV_HEADS
Q_BLOCK = 128
SWA_WINDOW = 128
CMP_BLOCK = 32
CMP_STRIDE = 16
SEL_BLOCK = 64
SEL_TOP_N = 8
NSA_WINDOW = 512
SEL_Q_CHUNK = 32
SEL_FORCE = 1.0e4
FORGET_BIAS_INIT = 3.0
N_EXPERTS = 32
TOP_K = 4
D_EXPERT = D_MODEL
SWIGLU_LIMIT = 7.0
SWIGLU_ALPHA = 1.702
MOE_BLOCK = 128
LN_EPS = 1e-5

FOX_W = FOX_HEADS * HEAD_DIM
SWA_QW = SWA_Q_HEADS * HEAD_DIM
NSA_QW = NSA_Q_HEADS * HEAD_DIM
KV_W = KV_HEADS * HEAD_DIM
COL_SIZES = (FOX_W, FOX_W, FOX_W, FOX_HEADS,
             SWA_QW, KV_W, KV_W,
             NSA_QW, KV_W, KV_W, KV_W, KV_W, KV_W, KV_W, 3 * NSA_Q_HEADS)
N_IN_COLS = sum(COL_SIZES)
FOX_F_OFFSET = 3 * FOX_W

kernel_name = "hybrid_fox_swa_nsa_moe_deepnorm"


def _layer_norm(x, g, b):
    xf = x.astype(jnp.float32)
    mu = jnp.mean(xf, axis=-1, keepdims=True)
    var = jnp.mean(jnp.square(xf - mu), axis=-1, keepdims=True)
    return ((xf - mu) * lax.rsqrt(var + LN_EPS) * g + b).astype(x.dtype)


def _masked_softmax(s, mask):
    m = jnp.max(jnp.where(mask, s, -jnp.inf), axis=-1, keepdims=True)
    m = jnp.where(jnp.isfinite(m), m, 0.0)
    e = jnp.where(mask, jnp.exp(s - m), 0.0)
    d = jnp.sum(e, axis=-1, keepdims=True)
    return e / jnp.where(d > 0, d, 1.0)


def _alibi_slopes():
    n = SWA_Q_HEADS + NSA_Q_HEADS
    s = 2.0 ** (-8.0 * np.arange(1, n + 1) / n)
    swa = jnp.asarray(s[0::2].reshape(KV_HEADS, GQA_GROUP), jnp.float32)
    nsa = jnp.asarray(s[1::2].reshape(KV_HEADS, GQA_GROUP), jnp.float32)
    return swa, nsa


def _heads(t, *heads):
    return t.reshape(t.shape[0], t.shape[1], *heads, HEAD_DIM)


def _forgetting_attention(q, k, v, f_logit):
    S = q.shape[1]
    scale = HEAD_DIM ** -0.5
    c = jnp.cumsum(jax.nn.log_sigmoid(f_logit.astype(jnp.float32)), axis=1)
    c = jnp.transpose(c, (0, 2, 1))
    outs = []
    for i in range(S // Q_BLOCK):
        q0, q1 = i * Q_BLOCK, (i + 1) * Q_BLOCK
        s = jnp.einsum('bqhd,bkhd->bhqk', q[:, q0:q1], k[:, :q1],
                       preferred_element_type=jnp.float32) * scale
        s = s + c[:, :, q0:q1, None] - c[:, :, None, :q1]
        causal = jnp.arange(q1)[None, :] <= jnp.arange(q0, q1)[:, None]
        p = jax.nn.softmax(jnp.where(causal, s, -jnp.inf), axis=-1)
        outs.append(jnp.einsum('bhqk,bkhd->bqhd', p.astype(v.dtype), v[:, :q1]))
    return jnp.concatenate(outs, axis=1)


def _banded_gqa(q, k, v, window, slopes, sinks=None):
    B_, S, KV, G, Dh = q.shape
    scale = Dh ** -0.5
    span = window + Q_BLOCK
    pad = ((0, 0), (window, 0), (0, 0), (0, 0))
    kp = jnp.pad(k, pad)
    vp = jnp.pad(v, pad)
    qi = jnp.arange(Q_BLOCK)[:, None]
    kj = jnp.arange(span)[None, :]
    dist = qi + window - kj
    in_band = (dist >= 0) & (dist < window)
    bias = -slopes[:, :, None, None] * dist.astype(jnp.float32)

    def block(i):
        qb = lax.dynamic_slice_in_dim(q, i * Q_BLOCK, Q_BLOCK, axis=1)
        kb = lax.dynamic_slice_in_dim(kp, i * Q_BLOCK, span, axis=1)
        vb = lax.dynamic_slice_in_dim(vp, i * Q_BLOCK, span, axis=1)
        valid = in_band & (kj + i * Q_BLOCK - window >= 0)
        s = jnp.einsum('bqhgd,bkhd->bhgqk', qb, kb,
                       preferred_element_type=jnp.float32) * scale + bias
        if sinks is None:
            p = _masked_softmax(s, valid)
        else:
            s = jnp.where(valid, s, -jnp.inf)
            sink = sinks.astype(jnp.float32)[None, :, :, None, None]
            m = jnp.maximum(jnp.max(s, axis=-1, keepdims=True), sink)
            e = jnp.exp(s - m)
            p = e / (jnp.sum(e, axis=-1, keepdims=True) + jnp.exp(sink - m))
        return jnp.einsum('bhgqk,bkhd->bqhgd', p.astype(v.dtype), vb)

    out = lax.map(block, jnp.arange(S // Q_BLOCK))
    return jnp.moveaxis(out, 0, 1).reshape(B_, S, KV, G, Dh)


def _compress(kv, pe, w1, w2):
    B_, S, KV, Dh = kv.shape
    nc = (S - CMP_BLOCK) // CMP_STRIDE + 1
    idx = np.arange(nc)[:, None] * CMP_STRIDE + np.arange(CMP_BLOCK)[None, :]
    blocks = kv[:, idx] + pe[None, None, :, None, :]
    blocks = jnp.moveaxis(blocks, 3, 2).reshape(B_, nc, KV, CMP_BLOCK * Dh)
    return jax.nn.gelu(blocks @ w1) @ w2


def _nsa(q, k_cmp, v_cmp, k_sel, v_sel, k_win, v_win, gate_logit, slopes, pe, w1, w2):
    B_, S, KV, G, Dh = q.shape
    scale = Dh ** -0.5
    t = jnp.arange(S)

    kc = _compress(k_cmp, pe[0], w1[0], w2[0])
    vc = _compress(v_cmp, pe[1], w1[1], w2[1])
    nc = kc.shape[1]
    cmp_start = np.arange(nc) * CMP_STRIDE
    cmp_end = cmp_start + CMP_BLOCK - 1
    cdist = (t[:, None] - cmp_end[None, :]).astype(jnp.float32)
    s = jnp.einsum('bthgd,bchd->bthgc', q, kc, preferred_element_type=jnp.float32) * scale
    s = s - slopes[None, None, :, :, None] * cdist[None, :, None, None, :]
    cmask = (cmp_end[None, :] <= t[:, None])[None, :, None, None, :]
    p_cmp = _masked_softmax(s, cmask)
    o_cmp = jnp.einsum('bthgc,bchd->bthgd', p_cmp.astype(vc.dtype), vc)

    ns = S // SEL_BLOCK
    sel_start = np.arange(ns) * SEL_BLOCK
    ov = np.clip(np.minimum(cmp_start[:, None] + CMP_BLOCK, sel_start[None, :] + SEL_BLOCK)
                 - np.maximum(cmp_start[:, None], sel_start[None, :]), 0, None) / CMP_BLOCK
    p_slc = jnp.einsum('bthgc,cn->bthn', p_cmp, jnp.asarray(ov, jnp.float32))
    cur = t // SEL_BLOCK
    j = jnp.arange(ns)
    forced = (j[None, :] == 0) | (j[None, :] == cur[:, None]) | (j[None, :] == cur[:, None] - 1)
    future = j[None, :] > cur[:, None]
    score = jnp.where(future[:, None, :], -1.0,
                      jnp.where(forced[:, None, :], SEL_FORCE, p_slc))
    n_sel = min(SEL_TOP_N, ns)
    _, sel_idx = lax.top_k(score, n_sel)

    ksb = jnp.transpose(k_sel.reshape(B_, ns, SEL_BLOCK, KV, Dh), (0, 3, 1, 2, 4))
    vsb = jnp.transpose(v_sel.reshape(B_, ns, SEL_BLOCK, KV, Dh), (0, 3, 1, 2, 4))
    nch = S // SEL_Q_CHUNK
    qc = jnp.transpose(q.reshape(B_, nch, SEL_Q_CHUNK, KV, G, Dh), (1, 0, 3, 2, 4, 5))
    ic = jnp.transpose(sel_idx.reshape(B_, nch, SEL_Q_CHUNK, KV, n_sel), (1, 0, 3, 2, 4))
    bi = jnp.arange(B_)[:, None, None, None]
    hi = jnp.arange(KV)[None, :, None, None]

    def chunk(args):
        qx, ix, c0 = args
        kg = ksb[bi, hi, ix]
        vg = vsb[bi, hi, ix]
        s = jnp.einsum('bhqgd,bhqnkd->bhqgnk', qx, kg,
                       preferred_element_type=jnp.float32) * scale
        tpos = c0 + jnp.arange(SEL_Q_CHUNK)
        spos = ix[..., None] * SEL_BLOCK + jnp.arange(SEL_BLOCK)
        dist = tpos[None, None, :, None, None] - spos
        s = s - slopes[None, :, None, :, None, None] * dist[:, :, :, None].astype(jnp.float32)
        s = s.reshape(B_, KV, SEL_Q_CHUNK, G, n_sel * SEL_BLOCK)
        valid = (dist >= 0).reshape(B_, KV, SEL_Q_CHUNK, 1, n_sel * SEL_BLOCK)
        p = _masked_softmax(s, valid)
        return jnp.einsum('bhqgm,bhqmd->bhqgd', p.astype(vg.dtype),
                          vg.reshape(B_, KV, SEL_Q_CHUNK, n_sel * SEL_BLOCK, Dh))

    o_sel = lax.map(chunk, (qc, ic, jnp.arange(nch) * SEL_Q_CHUNK))
    o_sel = jnp.transpose(o_sel, (1, 0, 3, 2, 4, 5)).reshape(B_, S, KV, G, Dh)

    o_win = _banded_gqa(q, k_win, v_win, NSA_WINDOW, slopes)

    g = jax.nn.sigmoid(gate_logit.reshape(B_, S, KV, G, 3))
    return g[..., 0:1] * o_cmp + g[..., 1:2] * o_sel + g[..., 2:3] * o_win


def _moe(x, router_w, router_b, w_gu, b_gu, w_dn, b_dn):
    B_, S, D = x.shape
    N = B_ * S
    NK = N * TOP_K
    xf = x.reshape(N, D)
    logits = (xf @ router_w + router_b).astype(jnp.float32)
    top_v, top_e = lax.top_k(logits, TOP_K)
    gate_w = jax.nn.softmax(top_v, axis=-1).astype(x.dtype)
    e_flat = top_e.reshape(NK)
    w_flat = gate_w.reshape(NK)
    tok = jnp.arange(NK, dtype=jnp.int32) // TOP_K
    counts = jnp.bincount(e_flat, length=N_EXPERTS)
    padded = (counts + MOE_BLOCK - 1) // MOE_BLOCK * MOE_BLOCK
    pad_end = jnp.cumsum(padded)
    pad_start = pad_end - padded
    grp_start = jnp.cumsum(counts) - counts
    order = jnp.argsort(e_flat)
    se = e_flat[order]
    dest = pad_start[se] + jnp.arange(NK) - grp_start[se]
    nblk = -(-NK // MOE_BLOCK) + N_EXPERTS
    P = nblk * MOE_BLOCK
    buf_tok = jnp.full((P,), N, jnp.int32).at[dest].set(tok[order])
    buf_w = jnp.zeros((P,), x.dtype).at[dest].set(w_flat[order])
    blk_e = jnp.minimum(jnp.searchsorted(pad_end, jnp.arange(nblk) * MOE_BLOCK, side='right'),
                        N_EXPERTS - 1)
    x_pad = jnp.concatenate([xf, jnp.zeros((1, D), x.dtype)], axis=0)

    def expert_block(args):
        e, tk = args
        h = x_pad[tk] @ w_gu[e] + b_gu[e]
        gate, up = h[:, 0::2], h[:, 1::2]
        gate = jnp.minimum(gate, SWIGLU_LIMIT)
        up = jnp.clip(up, -SWIGLU_LIMIT, SWIGLU_LIMIT)
        glu = gate * jax.nn.sigmoid(gate * SWIGLU_ALPHA)
        return ((up + 1.0) * glu) @ w_dn[e] + b_dn[e]

    y = lax.map(expert_block, (blk_e, buf_tok.reshape(nblk, MOE_BLOCK)))
    y = y.reshape(P, D) * buf_w[:, None]
    out = jnp.zeros((N + 1, D), x.dtype).at[buf_tok].add(y)[:N]
    return out.reshape(B_, S, D)


def setup_inputs(seed: int = 0) -> dict:
    key = jax.random.key(seed)
    ks = jax.random.split(key, 18)
    beta = (8.0 * DEPTH) ** -0.25
    L, D = DEPTH, D_MODEL

    def nrm(k, shape, scale):
        return scale * jax.random.normal(k, shape, jnp.float32)

    x = nrm(ks[0], (BATCH, SEQ, D), 1.0)
    w_in = nrm(ks[1], (L, D, N_IN_COLS), D ** -0.5)
    b_in = nrm(ks[2], (L, N_IN_COLS), 0.01).at[:, FOX_F_OFFSET:FOX_F_OFFSET + FOX_HEADS].add(FORGET_BIAS_INIT)
    sinks = nrm(ks[3], (L, SWA_Q_HEADS), 0.5)
    cmp_pe = nrm(ks[4], (L, 2, CMP_BLOCK, HEAD_DIM), 0.02)
    cmp_w1 = nrm(ks[5], (L, 2, CMP_BLOCK * HEAD_DIM, HEAD_DIM), (CMP_BLOCK * HEAD_DIM) ** -0.5)
    cmp_w2 = nrm(ks[6], (L, 2, HEAD_DIM, HEAD_DIM), HEAD_DIM ** -0.5)
    w_out = nrm(ks[7], (L, D, D), beta * D ** -0.5)
    ln1_g = 1.0 + nrm(ks[8], (L, D), 0.02)
    ln1_b = nrm(ks[9], (L, D), 0.02)
    router_w = nrm(ks[10], (L, D, N_EXPERTS), D ** -0.5)
    router_b = nrm(ks[11], (L, N_EXPERTS), 0.01)
    w_gate_up = nrm(ks[12], (L, N_EXPERTS, D, 2 * D_EXPERT), D ** -0.5)
    b_gate_up = nrm(ks[13], (L, N_EXPERTS, 2 * D_EXPERT), 0.01)
    w_down = nrm(ks[14], (L, N_EXPERTS, D_EXPERT, D), beta * D_EXPERT ** -0.5)
    b_down = nrm(ks[15], (L, N_EXPERTS, D), 0.01)
    ln2_g = 1.0 + nrm(ks[16], (L, D), 0.02)
    ln2_b = nrm(ks[17], (L, D), 0.02)
    return {"x": x, "w_in": w_in, "b_in": b_in, "sinks": sinks,
            "cmp_pe": cmp_pe, "cmp_w1": cmp_w1, "cmp_w2": cmp_w2, "w_out": w_out,
            "ln1_g": ln1_g, "ln1_b": ln1_b, "router_w": router_w, "router_b": router_b,
            "w_gate_up": w_gate_up, "b_gate_up": b_gate_up, "w_down": w_down,
            "b_down": b_down, "ln2_g": ln2_g, "ln2_b": ln2_b}


def reference(x, w_in, b_in, sinks, cmp_pe, cmp_w1, cmp_w2, w_out, ln1_g, ln1_b,
              router_w, router_b, w_gate_up, b_gate_up, w_down, b_down, ln2_g, ln2_b):
    alpha = (2.0 * DEPTH) ** 0.25
    B_, S, _ = x.shape
    slopes_swa, slopes_nsa = _alibi_slopes()
    splits = np.cumsum(COL_SIZES)[:-1].tolist()
    for l in range(DEPTH):
        h = x @ w_in[l] + b_in[l]
        (fq, fk, fv, ff, sq, sk, sv, nq, nkc, nvc, nks, nvs, nkw, nvw, ng) = jnp.split(h, splits, axis=-1)
        o_fox = _forgetting_attention(_heads(fq, FOX_HEADS), _heads(fk, FOX_HEADS),
                                      _heads(fv, FOX_HEADS), ff)
        o_swa = _banded_gqa(_heads(sq, KV_HEADS, GQA_GROUP), _heads(sk, KV_HEADS),
                            _heads(sv, KV_HEADS), SWA_WINDOW, slopes_swa,
                            sinks[l].reshape(KV_HEADS, GQA_GROUP))
        o_nsa = _nsa(_heads(nq, KV_HEADS, GQA_GROUP), _heads(nkc, KV_HEADS), _heads(nvc, KV_HEADS),
                     _heads(nks, KV_HEADS), _heads(nvs, KV_HEADS), _heads(nkw, KV_HEADS),
                     _heads(nvw, KV_HEADS), ng, slopes_nsa, cmp_pe[l], cmp_w1[l], cmp_w2[l])
        mix = jnp.concatenate([o_fox.reshape(B_, S, FOX_W), o_swa.reshape(B_, S, SWA_QW),
                               o_nsa.reshape(B_, S, NSA_QW)], axis=-1) @ w_out[l]
        x = _layer_norm(alpha * x + mix, ln1_g[l], ln1_b[l])
        ffn = _moe(x, router_w[l], router_b[l], w_gate_up[l], b_gate_up[l], w_down[l], b_down[l])
        x = _layer_norm(alpha * x + ffn, ln2_g[l], ln2_b[l])
    return x
```

```cpp
#include <hip/hip_runtime.h>
#include <hip/hip_cooperative_groups.h>
#include <cstdio>
#include <cstdint>
namespace cg = cooperative_groups;

#ifndef ONE_LAUNCH
#define ONE_LAUNCH 0
#endif

typedef unsigned short bf16_t;
typedef short bf16x8 __attribute__((ext_vector_type(8)));
typedef float f32x4 __attribute__((ext_vector_type(4)));
typedef unsigned u32x4 __attribute__((ext_vector_type(4)));
typedef unsigned u32x2 __attribute__((ext_vector_type(2)));

constexpr int DM = 1024, NB = 16, SEQ = 2048, NTOK = NB * SEQ, NL = 2;
constexpr int NCOL = 2582, NMAIN = 2560, NPAD = 2688, NE = 32, DFF = 1024;
constexpr int C_FQ = 0, C_FK = 256, C_FV = 512, C_SQ = 768, C_SK = 1152, C_SV = 1280, C_NQ = 1408,
              C_NKC = 1792, C_NVC = 1920, C_NKS = 2048, C_NVS = 2176, C_NKW = 2304, C_NVW = 2432;
constexpr int HS_W = 32;
constexpr int NVH = 10;
constexpr int LIST_CAP = NTOK;
constexpr int MAXSLOT = NTOK * 4 + NE * 128;
constexpr float ALPHA = 1.41421356237f, LN_EPS = 1e-5f, QSCALE = 0.125f;
constexpr int LDS_BYTES = 65536;

struct Params {
    const float *x, *w_in, *b_in, *sinks, *cmp_pe, *cmp_w1, *cmp_w2, *w_out, *ln1_g, *ln1_b, *router_w, *router_b,
                *w_gu, *b_gu, *w_dn, *b_dn, *ln2_g, *ln2_b;
    float* out;
    unsigned* ctrl;
    bf16_t *WinT, *WoT, *W1T, *W2T, *WguT, *WdnT;
    float *rwT, *binp, *bgup, *b1c;
    float* xf;
    bf16_t* xb;
    bf16_t* hb;
    float* hs;
    bf16_t* vT;
    float* cF;
    bf16_t *kc, *vc, *vcT;
    bf16_t* ob;
    float* tbuf;
    float* x1f; bf16_t* x1b;
    int* top_e; float* gw;
    int* lists;
    bf16_t* act;
    bf16_t* ybuf;
};

__device__ __forceinline__ float bf2f(bf16_t h) { return __uint_as_float(((unsigned)h) << 16); }
__device__ __forceinline__ bf16_t f2bf(float f) { unsigned u = __float_as_uint(f); u += 0x7fffu + ((u >> 16) & 1u); return (bf16_t)(u >> 16); }
__device__ __forceinline__ unsigned pack2(float lo, float hi) { return (unsigned)f2bf(lo) | ((unsigned)f2bf(hi) << 16); }
__device__ __forceinline__ float wave_sum(float v) {
#pragma unroll
    for (int o = 32; o > 0; o >>= 1) v += __shfl_xor(v, o);
    return v;
}
__device__ __forceinline__ float wave_max(float v) {
#pragma unroll
    for (int o = 32; o > 0; o >>= 1) v = fmaxf(v, __shfl_xor(v, o));
    return v;
}
__device__ __forceinline__ void lds_wave_sync() { asm volatile("s_waitcnt lgkmcnt(0)" ::: "memory"); __builtin_amdgcn_wave_barrier(); }
__device__ __forceinline__ float slope_swa(int hq) { return exp2f(-8.0f * (float)(2 * hq + 1) / 12.0f); }
__device__ __forceinline__ float slope_nsa(int hq) { return exp2f(-8.0f * (float)(2 * hq + 2) / 12.0f); }

template <int PERM>
__device__ __forceinline__ int perm_row(int n) {
    if (PERM == 1) { if (n < 768) return n; if (n < 772) return 2560 + (n - 768); if (n < 2564) return n - 4; return n; }
    if (PERM == 2) { const int f = n >> 1, s = n & 1; return (f >> 5) * 64 + s * 32 + (f & 31); }
    return n;
}
template <int PERM>
__device__ __forceinline__ void conv_tile(const float* __restrict__ src, int K, int N, int kt, int nt, bf16_t* __restrict__ dst, float* lds) {
    int tid = threadIdx.x; asm volatile("" : "+v"(tid));
#pragma unroll
    for (int i = 0; i < 4; ++i) {
        const int kk = (tid >> 4) + 16 * i, nn = (tid & 15) * 4;
        const int k = kt * 64 + kk, n = nt * 64 + nn;
        const float* p = src + (size_t)k * N + n;
        float v0 = 0.f, v1 = 0.f, v2 = 0.f, v3 = 0.f;
        if (n + 3 < N) { v0 = p[0]; v1 = p[1]; v2 = p[2]; v3 = p[3]; }
        else { if (n < N) v0 = p[0]; if (n + 1 < N) v1 = p[1]; if (n + 2 < N) v2 = p[2]; }
        float* l = lds + kk * 65 + nn; l[0] = v0; l[1] = v1; l[2] = v2; l[3] = v3;
    }
    __syncthreads();
#pragma unroll
    for (int i = 0; i < 2; ++i) {
        const int idx = tid + 256 * i, nn = idx >> 3, kc = idx & 7, n = nt * 64 + nn;
        if (n < N) {
            const float* l = lds + (kc * 8) * 65 + nn;
            u32x4 w; w.x = pack2(l[0], l[65]); w.y = pack2(l[130], l[195]); w.z = pack2(l[260], l[325]); w.w = pack2(l[390], l[455]);
            *(u32x4*)(dst + (size_t)perm_row<PERM>(n) * K + kt * 64 + kc * 8) = w;
        }
    }
    __syncthreads();
}

__device__ void phase0(const Params& p, char* ldsc) {
    float* lds = (float*)ldsc;
    int tid = threadIdx.x; asm volatile("" : "+v"(tid));
    const int G = gridDim.x, bid = blockIdx.x;
    const size_t gtid = (size_t)bid * 256 + tid, gthreads = (size_t)G * 256;
    for (size_t i = gtid; i < (size_t)NL * NPAD; i += gthreads) {
        const int l = (int)(i / NPAD), r = (int)(i % NPAD);
        float v = 0.f;
        if (r < 2560) { const int n = r < 768 ? r : r + 4; v = p.b_in[l * NCOL + n]; }
        else if (r < 2564) v = p.b_in[l * NCOL + 768 + (r - 2560)];
        else if (r < 2582) v = p.b_in[l * NCOL + r];
        p.binp[i] = v;
    }
    for (size_t i = gtid; i < (size_t)NL * NE * 2048; i += gthreads) {
        const int r = (int)(i % 2048); const size_t le = i / 2048;
        const int q = r >> 6, s = (r >> 5) & 1, f = q * 32 + (r & 31);
        p.bgup[i] = p.b_gu[le * 2048 + 2 * f + s];
    }
    for (size_t i = gtid; i < (size_t)NL * NE * 1024; i += gthreads) {
        const int k = (int)(i % 1024), e = (int)((i / 1024) % NE), l = (int)(i / (1024 * NE));
        p.rwT[i] = p.router_w[((size_t)l * 1024 + k) * NE + e];
    }
    for (size_t i = gtid; i < (size_t)NL * (NPAD - NCOL) * 1024; i += gthreads) {
        const int l = (int)(i / ((NPAD - NCOL) * 1024)); const size_t r = i % ((size_t)(NPAD - NCOL) * 1024);
        p.WinT[(size_t)l * NPAD * 1024 + (size_t)NCOL * 1024 + r] = 0;
    }
    for (size_t i = gtid; i < (size_t)NTOK * DM / 4; i += gthreads) {
        const float4 v = ((const float4*)p.x)[i];
        u32x2 w; w.x = pack2(v.x, v.y); w.y = pack2(v.z, v.w);
        ((u32x2*)p.xb)[i] = w;
    }
    if (bid < 4) {
        const int j = tid & 63, part = tid >> 6;
        const float* pe = p.cmp_pe + (size_t)bid * 2048; const float* w1 = p.cmp_w1 + (size_t)bid * 2048 * 64;
        float s = 0.f;
        for (int kk = part * 512; kk < part * 512 + 512; ++kk) s += pe[kk] * w1[(size_t)kk * 64 + j];
        lds[tid] = s; __syncthreads();
        if (tid < 64) p.b1c[bid * 64 + tid] = lds[tid] + lds[tid + 64] + lds[tid + 128] + lds[tid + 192];
        __syncthreads();
    }
    constexpr int T_WIN = NL * 16 * 41, T_WO = NL * 16 * 16, T_W1 = NL * 2 * 32, T_W2 = NL * 2, T_GU = NL * NE * 16 * 32, T_DN = NL * NE * 16 * 16;
    constexpr int TOT = T_WIN + T_WO + T_W1 + T_W2 + T_GU + T_DN;
    for (int t = bid; t < TOT; t += G) {
        int u = t;
        if (u < T_GU) { const int m = u / 512, r = u % 512; conv_tile<2>(p.w_gu + (size_t)m * 1024 * 2048, 1024, 2048, r / 32, r % 32, p.WguT + (size_t)m * 2048 * 1024, lds); continue; }
        u -= T_GU;
        if (u < T_DN) { const int m = u / 256, r = u % 256; conv_tile<0>(p.w_dn + (size_t)m * 1024 * 1024, 1024, 1024, r / 16, r % 16, p.WdnT + (size_t)m * 1024 * 1024, lds); continue; }
        u -= T_DN;
        if (u < T_WIN) { const int m = u / 656, r = u % 656; conv_tile<1>(p.w_in + (size_t)m * 1024 * NCOL, 1024, NCOL, r / 41, r % 41, p.WinT + (size_t)m * NPAD * 1024, lds); continue; }
        u -= T_WIN;
        if (u < T_WO) { const int m = u / 256, r = u % 256; conv_tile<0>(p.w_out + (size_t)m * 1024 * 1024, 1024, 1024, r / 16, r % 16, p.WoT + (size_t)m * 1024 * 1024, lds); continue; }
        u -= T_WO;
        if (u < T_W1) { const int m = u / 32, r = u % 32; conv_tile<0>(p.cmp_w1 + (size_t)m * 2048 * 64, 2048, 64, r, 0, p.W1T + (size_t)m * 64 * 2048, lds); continue; }
        u -= T_W1;
        { const int m = u; conv_tile<0>(p.cmp_w2 + (size_t)m * 64 * 64, 64, 64, 0, 0, p.W2T + (size_t)m * 64 * 64, lds); }
    }
}

template <class Epi>
__device__ __forceinline__ void gemm128(const bf16_t* __restrict__ A, size_t lda, const int* rowsrc, int m0,
                                        const bf16_t* __restrict__ Bt, int K, char* lds, const Epi& epi) {
    int tid = threadIdx.x; asm volatile("" : "+v"(tid));
    const int wid = tid >> 6, lane = tid & 63, wr = wid >> 1, wc = wid & 1, fr = lane & 15, fq = lane >> 4;
    char* SA = lds; char* SB = lds + 8192;
    const bf16_t* ap[2]; const bf16_t* bp[2];
#pragma unroll
    for (int i = 0; i < 2; ++i) {
        const int b = tid * 16 + i * 4096, r = b >> 6, c = (b & 63) >> 1;
        const int arow = rowsrc ? rowsrc[r] : (m0 + r);
        ap[i] = A + (size_t)arow * lda + c; bp[i] = Bt + (size_t)r * K + c;
    }
    f32x4 acc[4][4];
#pragma unroll
    for (int m = 0; m < 4; ++m)
#pragma unroll
        for (int n = 0; n < 4; ++n) acc[m][n] = (f32x4){0.f, 0.f, 0.f, 0.f};
    for (int kt = 0; kt < K / 32; ++kt) {
#pragma unroll
        for (int i = 0; i < 2; ++i) {
            const int b = tid * 16 + i * 4096;
            __builtin_amdgcn_global_load_lds((const unsigned*)(ap[i] + kt * 32), (__attribute__((address_space(3))) unsigned*)(SA + b), 16, 0, 0);
            __builtin_amdgcn_global_load_lds((const unsigned*)(bp[i] + kt * 32), (__attribute__((address_space(3))) unsigned*)(SB + b), 16, 0, 0);
        }
        asm volatile("s_waitcnt vmcnt(0)" ::: "memory");
        __syncthreads();
        bf16x8 At[4], Bl[4];
#pragma unroll
        for (int m = 0; m < 4; ++m) At[m] = *(const bf16x8*)(SA + (wr * 64 + m * 16 + fr) * 64 + fq * 16);
#pragma unroll
        for (int n = 0; n < 4; ++n) Bl[n] = *(const bf16x8*)(SB + (wc * 64 + n * 16 + fr) * 64 + fq * 16);
#pragma unroll
        for (int m = 0; m < 4; ++m)
#pragma unroll
            for (int n = 0; n < 4; ++n) acc[m][n] = __builtin_amdgcn_mfma_f32_16x16x32_bf16(Bl[n], At[m], acc[m][n], 0, 0, 0);
        __syncthreads();
    }
    epi(acc, wr * 64 + fr, wc * 64 + 4 * fq);
}

struct EpiInProj {
    const Params* p; int l, m0, n0;
    __device__ __forceinline__ void operator()(const f32x4 (&acc)[4][4], int r0, int c0) const {
        const float* bias = p->binp + l * NPAD + n0;
        if (n0 == NMAIN) {
#pragma unroll
            for (int n = 0; n < 2; ++n) {
                const int c = c0 + n * 16;
                if (c < 22 + 3) {
#pragma unroll
                    for (int m = 0; m < 4; ++m) {
                        const int row = m0 + r0 + m * 16;
#pragma unroll
                        for (int j = 0; j < 4; ++j) if (c + j < 22) p->hs[(size_t)row * HS_W + c + j] = acc[m][n][j] + bias[c + j];
                    }
                }
            }
            return;
        }
        int vh = -1;
        if (n0 == 512) vh = 0; else if (n0 == 640) vh = 2; else if (n0 == 1280) vh = 4; else if (n0 == 2176) vh = 6; else if (n0 == 2432) vh = 8;
#pragma unroll
        for (int n = 0; n < 4; ++n) {
            const int c = c0 + n * 16;
            const f32x4 bv = *(const f32x4*)(bias + c);
#pragma unroll
            for (int m = 0; m < 4; ++m) {
                const int row = m0 + r0 + m * 16;
                const f32x4 v = acc[m][n] + bv;
                u32x2 w; w.x = pack2(v[0], v[1]); w.y = pack2(v[2], v[3]);
                *(u32x2*)(p->hb + (size_t)row * NMAIN + n0 + c) = w;
                if (vh >= 0) {
                    const int b = row >> 11, s = row & 2047, hh = vh + (c >> 6), d = c & 63;
                    bf16_t* vt = p->vT + (((size_t)b * NVH + hh) * 64 + d) * SEQ + s;
                    vt[0] = (bf16_t)(w.x & 0xffff); vt[SEQ] = (bf16_t)(w.x >> 16); vt[2 * SEQ] = (bf16_t)(w.y & 0xffff); vt[3 * SEQ] = (bf16_t)(w.y >> 16);
                }
            }
        }
    }
};
struct EpiOutProj {
    const float* xin; float* t; int m0, n0;
    __device__ __forceinline__ void operator()(const f32x4 (&acc)[4][4], int r0, int c0) const {
#pragma unroll
        for (int m = 0; m < 4; ++m)
#pragma unroll
            for (int n = 0; n < 4; ++n) {
                const size_t off = (size_t)(m0 + r0 + m * 16) * DM + n0 + c0 + n * 16;
                const f32x4 xv = *(const f32x4*)(xin + off);
                *(f32x4*)(t + off) = xv * ALPHA + acc[m][n];
            }
    }
};
struct EpiGateUp {
    bf16_t* act; const float* bias; int slot0, n0;
    __device__ __forceinline__ void operator()(const f32x4 (&acc)[4][4], int r0, int c0) const {
        const int wcb = c0 & 64, q4 = c0 & 63;
        const int fbase = ((n0 + wcb) >> 6) * 32;
#pragma unroll
        for (int n = 0; n < 2; ++n) {
            const f32x4 bg = *(const f32x4*)(bias + n0 + wcb + n * 16 + q4), bu = *(const f32x4*)(bias + n0 + wcb + 32 + n * 16 + q4);
#pragma unroll
            for (int m = 0; m < 4; ++m) {
                const f32x4 g4 = acc[m][n] + bg, u4 = acc[m][n + 2] + bu;
                float o[4];
#pragma unroll
                for (int j = 0; j < 4; ++j) {
                    const float g = fminf(g4[j], 7.0f), u = fminf(fmaxf(u4[j], -7.0f), 7.0f);
                    const float glu = g / (1.0f + __expf(-1.702f * g));
                    o[j] = (u + 1.0f) * glu;
                }
                u32x2 w; w.x = pack2(o[0], o[1]); w.y = pack2(o[2], o[3]);
                *(u32x2*)(act + (size_t)(slot0 + r0 + m * 16) * DFF + fbase + n * 16 + q4) = w;
            }
        }
    }
};
struct EpiDown {
    bf16_t* ybuf; const float* bias; const int* lst; int cnt, rb, n0;
    __device__ __forceinline__ void operator()(const f32x4 (&acc)[4][4], int r0, int c0) const {
#pragma unroll
        for (int m = 0; m < 4; ++m) {
            const int lr = rb * 128 + r0 + m * 16;
            if (lr < cnt) {
                const int a = lst[lr];
#pragma unroll
                for (int n = 0; n < 4; ++n) {
                    const int c = n0 + c0 + n * 16;
                    const f32x4 v = acc[m][n] + *(const f32x4*)(bias + c);
                    u32x2 w; w.x = pack2(v[0], v[1]); w.y = pack2(v[2], v[3]);
                    *(u32x2*)(ybuf + (size_t)a * DM + c) = w;
                }
            }
        }
    }
};

__device__ void phase_inproj(const Params& p, int l, char* lds) {
    constexpr int NT = NPAD / 128, MT = NTOK / 128;
    const bf16_t* W = p.WinT + (size_t)l * NPAD * 1024;
    for (int t = blockIdx.x; t < MT * NT; t += gridDim.x) {
        const int mt = t / NT, nt = t % NT;
        EpiInProj e{&p, l, mt * 128, nt * 128};
        gemm128(p.xb, DM, nullptr, mt * 128, W + (size_t)nt * 128 * 1024, 1024, lds, e);
    }
}
__device__ void phase_outproj(const Params& p, int l, const float* xin, char* lds) {
    constexpr int NT = 8, MT = NTOK / 128;
    const bf16_t* W = p.WoT + (size_t)l * 1024 * 1024;
    for (int t = blockIdx.x; t < MT * NT; t += gridDim.x) {
        const int mt = t / NT, nt = t % NT;
        EpiOutProj e{xin, p.tbuf, mt * 128, nt * 128};
        gemm128(p.ob, DM, nullptr, mt * 128, W + (size_t)nt * 128 * 1024, 1024, lds, e);
    }
}
__device__ __forceinline__ void build_tiles(const Params& p, int l, int* ptile, int* ecnt) {
    if (threadIdx.x < NE) ecnt[threadIdx.x] = (int)__hip_atomic_load(p.ctrl + 64 + l * NE + threadIdx.x, __ATOMIC_RELAXED, __HIP_MEMORY_SCOPE_AGENT);
    __syncthreads();
    if (threadIdx.x == 0) { int s = 0; for (int e = 0; e < NE; ++e) { ptile[e] = s; s += (ecnt[e] + 127) >> 7; } ptile[NE] = s; }
    __syncthreads();
}
__device__ void phase_gateup(const Params& p, int l, char* lds) {
    int* ptile = (int*)(lds + 16384); int* ecnt = ptile + 40; int* rows = ecnt + 40;
    build_tiles(p, l, ptile, ecnt);
    const int ntile = ptile[NE];
    for (int t = blockIdx.x; t < ntile * 16; t += gridDim.x) {
        const int rbt = t >> 4, nt = t & 15;
        int e = 0; while (ptile[e + 1] <= rbt) ++e;
        const int rb = rbt - ptile[e], cnt = ecnt[e];
        const int* lst = p.lists + (size_t)e * LIST_CAP;
        if (threadIdx.x < 128) { const int lr = rb * 128 + threadIdx.x; rows[threadIdx.x] = lr < cnt ? (lst[lr] >> 2) : 0; }
        __syncthreads();
        EpiGateUp ep{p.act, p.bgup + ((size_t)l * NE + e) * 2048, rbt * 128, nt * 128};
        gemm128(p.x1b, DM, rows, 0, p.WguT + (((size_t)l * NE + e) * 2048 + (size_t)nt * 128) * 1024, 1024, lds, ep);
    }
}
__device__ void phase_down(const Params& p, int l, char* lds) {
    int* ptile = (int*)(lds + 16384); int* ecnt = ptile + 40;
    build_tiles(p, l, ptile, ecnt);
    const int ntile = ptile[NE];
    for (int t = blockIdx.x; t < ntile * 8; t += gridDim.x) {
        const int rbt = t >> 3, nt = t & 7;
        int e = 0; while (ptile[e + 1] <= rbt) ++e;
        const int rb = rbt - ptile[e];
        EpiDown ep{p.ybuf, p.b_dn + ((size_t)l * NE + e) * 1024, p.lists + (size_t)e * LIST_CAP, ecnt[e], rb, nt * 128};
        gemm128(p.act, DFF, nullptr, rbt * 128, p.WdnT + (((size_t)l * NE + e) * 1024 + (size_t)nt * 128) * 1024, 1024, lds, ep);
    }
}

__device__ __forceinline__ float gelu_tanh(float x) {
    const float u = 0.7978845608028654f * (x + 0.044715f * x * x * x);
    const float e = __expf(-2.0f * fabsf(u)); const float th = (1.0f - e) / (1.0f + e);
    return 0.5f * x * (1.0f + (u < 0.f ? -th : th));
}
__device__ void phase_prep(const Params& p, int l, char* lds) {
    int tid = threadIdx.x; asm volatile("" : "+v"(tid));
    const int wid = tid >> 6, lane = tid & 63, fr = lane & 15, fq = lane >> 4;
    const int gw = blockIdx.x * 4 + wid, nw = gridDim.x * 4;
    for (int u = gw; u < NB * 4; u += nw) {
        const int b = u >> 2, h = u & 3;
        const float* src = p.hs + (size_t)b * SEQ * HS_W + h;
        float* dst = p.cF + (size_t)u * SEQ;
        float tot = 0.f;
        for (int i = 0; i < 32; ++i) { const float f = src[(size_t)(lane * 32 + i) * HS_W]; tot += fminf(f, 0.f) - log1pf(__expf(-fabsf(f))); }
        float inc = tot;
#pragma unroll
        for (int o = 1; o < 64; o <<= 1) { const float v = __shfl_up(inc, o); if (lane >= o) inc += v; }
        float run = inc - tot;
        for (int i = 0; i < 32; ++i) { const float f = src[(size_t)(lane * 32 + i) * HS_W]; run += fminf(f, 0.f) - log1pf(__expf(-fabsf(f))); dst[lane * 32 + i] = run; }
    }
    bf16_t* h1 = (bf16_t*)(lds + wid * 2048);
    for (int u = gw; u < NB * 2 * 2 * 8; u += nw) {
        const int ct = u & 7, which = (u >> 3) & 1, kvh = (u >> 4) & 1, b = u >> 5;
        const int colo = (which ? C_NVC : C_NKC) + kvh * 64;
        const int c_lane = ct * 16 + fr;
        const int tokbase = min(c_lane, 126) * 16;
        const bf16_t* arow = p.hb + ((size_t)b * SEQ + tokbase) * NMAIN + colo + fq * 8;
        const bf16_t* w1 = p.W1T + ((size_t)(l * 2 + which) * 64 + fr) * 2048 + fq * 8;
        f32x4 acc[4];
#pragma unroll
        for (int n = 0; n < 4; ++n) acc[n] = (f32x4){0.f, 0.f, 0.f, 0.f};
        for (int ks = 0; ks < 64; ++ks) {
            const bf16x8 a = *(const bf16x8*)(arow + (size_t)(ks >> 1) * NMAIN + (ks & 1) * 32);
#pragma unroll
            for (int n = 0; n < 4; ++n) {
                const bf16x8 bb = *(const bf16x8*)(w1 + (size_t)n * 16 * 2048 + ks * 32);
                acc[n] = __builtin_amdgcn_mfma_f32_16x16x32_bf16(a, bb, acc[n], 0, 0, 0);
            }
        }
        const float* b1 = p.b1c + (l * 2 + which) * 64;
#pragma unroll
        for (int n = 0; n < 4; ++n)
#pragma unroll
            for (int r = 0; r < 4; ++r) h1[(fq * 4 + r) * 64 + n * 16 + fr] = f2bf(gelu_tanh(acc[n][r] + b1[n * 16 + fr]));
        lds_wave_sync();
        const bf16_t* w2 = p.W2T + ((size_t)(l * 2 + which) * 64 + fr) * 64 + fq * 8;
        f32x4 o2[4];
#pragma unroll
        for (int n = 0; n < 4; ++n) o2[n] = (f32x4){0.f, 0.f, 0.f, 0.f};
#pragma unroll
        for (int ks = 0; ks < 2; ++ks) {
            const bf16x8 a = *(const bf16x8*)(h1 + fr * 64 + ks * 32 + fq * 8);
#pragma unroll
            for (int n = 0; n < 4; ++n) {
                const bf16x8 bb = *(const bf16x8*)(w2 + (size_t)n * 16 * 64 + ks * 32);
                o2[n] = __builtin_amdgcn_mfma_f32_16x16x32_bf16(a, bb, o2[n], 0, 0, 0);
            }
        }
        lds_wave_sync();
        const size_t base = ((size_t)b * 2 + kvh) * 128 * 64;
#pragma unroll
        for (int n = 0; n < 4; ++n)
#pragma unroll
            for (int r = 0; r < 4; ++r) {
                const int c = ct * 16 + fq * 4 + r, j2 = n * 16 + fr;
                const bf16_t v = c < 127 ? f2bf(o2[n][r]) : (bf16_t)0;
                if (which == 0) p.kc[base + (size_t)c * 64 + j2] = v;
                else { p.vc[base + (size_t)c * 64 + j2] = v; p.vcT[base + (size_t)j2 * 128 + c] = v; }
            }
    }
}

__device__ __forceinline__ void load_q(const bf16_t* qp, float* q, int lane) {
    q[lane] = bf2f(qp[lane]) * QSCALE;
    lds_wave_sync();
}
__device__ __forceinline__ float dot_q(const bf16_t* kp, const float* q) {
    float s = 0.f;
#pragma unroll
    for (int i = 0; i < 8; ++i) {
        const u32x4 w = *(const u32x4*)(kp + i * 8);
        const float4 qa = *(const float4*)(q + i * 8), qb = *(const float4*)(q + i * 8 + 4);
        s += qa.x * __uint_as_float(w.x << 16) + qa.y * __uint_as_float(w.x & 0xffff0000u)
           + qa.z * __uint_as_float(w.y << 16) + qa.w * __uint_as_float(w.y & 0xffff0000u)
           + qb.x * __uint_as_float(w.z << 16) + qb.y * __uint_as_float(w.z & 0xffff0000u)
           + qb.z * __uint_as_float(w.w << 16) + qb.w * __uint_as_float(w.w & 0xffff0000u);
    }
    return s;
}
constexpr float NEG_INF = -__builtin_huge_valf();
template <class BF>
__device__ __forceinline__ float score_keys(const float* q, const bf16_t* Kb, size_t ld, int s_lo, int cnt, float* sc, int lane, const BF& bf) {
    float mx = NEG_INF;
    for (int i = lane; i < cnt; i += 64) {
        const int s = s_lo + i; float bias; const bool ok = bf(s, bias);
        float v = NEG_INF;
        if (ok) v = dot_q(Kb + (size_t)s * ld, q) + bias;
        sc[i] = v; mx = fmaxf(mx, v);
    }
    return mx;
}
__device__ __forceinline__ float softmax_lds(float* sc, int n, float mx, int lane) {
    float sum = 0.f;
    for (int i = lane; i < n; i += 64) { const float v = sc[i]; const float e = (v == NEG_INF) ? 0.f : __expf(v - mx); sc[i] = e; sum += e; }
    sum = wave_sum(sum);
    lds_wave_sync();
    return sum;
}
__device__ __forceinline__ float pv_keys(const bf16_t* Vb, size_t ld, int s_lo, int cnt, const float* sc, int lane, float o) {
    for (int i = 0; i < cnt; ++i) { const float pr = sc[i]; if (pr != 0.f) o += pr * bf2f(Vb[(size_t)(s_lo + i) * ld + lane]); }
    return o;
}

__device__ void phase_attn_naive(const Params& p, int l, char* lds) {
    int tid = threadIdx.x; asm volatile("" : "+v"(tid));
    const int wid = tid >> 6, lane = tid & 63;
    float* sc = (float*)(lds + wid * 9216);
    float* q = sc + 2176;
    const int gwv = blockIdx.x * 4 + wid, nw = gridDim.x * 4;
    for (int u = gwv; u < NTOK * 4; u += nw) {
        const int h = u & 3, tok = u >> 2, b = tok >> 11, t = tok & 2047;
        load_q(p.hb + (size_t)tok * NMAIN + C_FQ + h * 64, q, lane);
        const float* c = p.cF + ((size_t)b * 4 + h) * SEQ; const float ct = c[t];
        const bf16_t* Kb = p.hb + (size_t)b * SEQ * NMAIN + C_FK + h * 64;
        const bf16_t* Vb = p.hb + (size_t)b * SEQ * NMAIN + C_FV + h * 64;
        float mx = score_keys(q, Kb, NMAIN, 0, t + 1, sc, lane, [&](int s, float& bias) { bias = ct - c[s]; return true; });
        mx = wave_max(mx);
        const float sum = softmax_lds(sc, t + 1, mx, lane);
        const float o = pv_keys(Vb, NMAIN, 0, t + 1, sc, lane, 0.f);
        p.ob[(size_t)tok * DM + h * 64 + lane] = f2bf(o / sum);
        lds_wave_sync();
    }
    for (int u = gwv; u < NTOK * 6; u += nw) {
        const int hq = u % 6, tok = u / 6, b = tok >> 11, t = tok & 2047, kv = hq / 3;
        load_q(p.hb + (size_t)tok * NMAIN + C_SQ + hq * 64, q, lane);
        const float sl = slope_swa(hq), sink = p.sinks[l * 6 + hq];
        const bf16_t* Kb = p.hb + (size_t)b * SEQ * NMAIN + C_SK + kv * 64;
        const bf16_t* Vb = p.hb + (size_t)b * SEQ * NMAIN + C_SV + kv * 64;
        const int s_lo = max(0, t - 127), cnt = t - s_lo + 1;
        float mx = score_keys(q, Kb, NMAIN, s_lo, cnt, sc, lane, [&](int s, float& bias) { bias = -sl * (float)(t - s); return true; });
        mx = fmaxf(wave_max(mx), sink);
        const float sum = softmax_lds(sc, cnt, mx, lane) + __expf(sink - mx);
        const float o = pv_keys(Vb, NMAIN, s_lo, cnt, sc, lane, 0.f);
        p.ob[(size_t)tok * DM + 256 + hq * 64 + lane] = f2bf(o / sum);
        lds_wave_sync();
    }
    for (int u = gwv; u < NTOK * 2; u += nw) {
        const int kv = u & 1, tok = u >> 1, b = tok >> 11, t = tok & 2047;
        const int ncv = t >= 31 ? ((t - 31) >> 4) + 1 : 0, cur = t >> 6;
        const bf16_t* Kc = p.kc + ((size_t)b * 2 + kv) * 128 * 64;
        const bf16_t* Vc = p.vc + ((size_t)b * 2 + kv) * 128 * 64;
        float pslc = 0.f;
        for (int g = 0; g < 3; ++g) {
            const int hq = kv * 3 + g; const float sl = slope_nsa(hq);
            load_q(p.hb + (size_t)tok * NMAIN + C_NQ + hq * 64, q, lane);
            float mx = score_keys(q, Kc, 64, 0, ncv, sc, lane, [&](int c, float& bias) { bias = -sl * (float)(t - (16 * c + 31)); return true; });
            for (int i = ncv + lane; i < 132; i += 64) sc[i] = NEG_INF;
            mx = wave_max(mx);
            const float sum = softmax_lds(sc, 132, mx, lane);
            if (lane < 32 && ncv > 0) {
                const int n = lane; float a = sc[4 * n] + sc[4 * n + 1] + sc[4 * n + 2] + 0.5f * sc[4 * n + 3];
                if (n > 0) a += 0.5f * sc[4 * n - 1];
                pslc += a / sum;
            }
            lds_wave_sync();
        }
        unsigned mask = 1u | (1u << cur); if (cur >= 1) mask |= 1u << (cur - 1);
        if (cur >= 3) {
            const int ncand = cur - 2;
            if (ncand <= 5) { for (int j = 1; j <= cur - 2; ++j) mask |= 1u << j; }
            else {
                for (int r = 0; r < 5; ++r) {
                    const bool cand = lane >= 1 && lane <= cur - 2 && !((mask >> lane) & 1u);
                    const float v = cand ? pslc : -1.0f;
                    const float mxv = wave_max(v);
                    const unsigned long long bal = __ballot(cand && v == mxv);
                    const int pick = bal ? (int)__builtin_ctzll(bal) : 0;
                    mask |= 1u << pick;
                }
            }
        }
        for (int g = 0; g < 3; ++g) {
            const int hq = kv * 3 + g; const float sl = slope_nsa(hq);
            load_q(p.hb + (size_t)tok * NMAIN + C_NQ + hq * 64, q, lane);
            const float* gl = p.hs + (size_t)tok * HS_W + 4 + hq * 3;
            const float g0 = 1.f / (1.f + __expf(-gl[0])), g1 = 1.f / (1.f + __expf(-gl[1])), g2 = 1.f / (1.f + __expf(-gl[2]));
            float outv = 0.f;
            if (ncv > 0) {
                float mx = score_keys(q, Kc, 64, 0, ncv, sc, lane, [&](int c, float& bias) { bias = -sl * (float)(t - (16 * c + 31)); return true; });
                mx = wave_max(mx);
                const float sum = softmax_lds(sc, ncv, mx, lane);
                const float o = pv_keys(Vc, 64, 0, ncv, sc, lane, 0.f);
                outv += g0 * o / sum;
                lds_wave_sync();
            }
            {
                const bf16_t* Kb = p.hb + (size_t)b * SEQ * NMAIN + C_NKS + kv * 64;
                const bf16_t* Vb = p.hb + (size_t)b * SEQ * NMAIN + C_NVS + kv * 64;
                float mx = NEG_INF; int nb = 0;
                for (int j = 0; j <= cur; ++j) if ((mask >> j) & 1u) {
                    mx = fmaxf(mx, score_keys(q, Kb, NMAIN, j * 64, 64, sc + nb * 64, lane, [&](int s, float& bias) { bias = -sl * (float)(t - s); return s <= t; }));
                    ++nb;
                }
                mx = wave_max(mx);
                const float sum = softmax_lds(sc, nb * 64, mx, lane);
                float o = 0.f; nb = 0;
                for (int j = 0; j <= cur; ++j) if ((mask >> j) & 1u) { o = pv_keys(Vb, NMAIN, j * 64, 64, sc + nb * 64, lane, o); ++nb; }
                outv += g1 * o / sum;
                lds_wave_sync();
            }
            {
                const bf16_t* Kb = p.hb + (size_t)b * SEQ * NMAIN + C_NKW + kv * 64;
                const bf16_t* Vb = p.hb + (size_t)b * SEQ * NMAIN + C_NVW + kv * 64;
                const int s_lo = max(0, t - 511), cnt = t - s_lo + 1;
                float mx = score_keys(q, Kb, NMAIN, s_lo, cnt, sc, lane, [&](int s, float& bias) { bias = -sl * (float)(t - s); return true; });
                mx = wave_max(mx);
                const float sum = softmax_lds(sc, cnt, mx, lane);
                const float o = pv_keys(Vb, NMAIN, s_lo, cnt, sc, lane, 0.f);
                outv += g2 * o / sum;
                lds_wave_sync();
            }
            p.ob[(size_t)tok * DM + 640 + hq * 64 + lane] = f2bf(outv);
        }
    }
}

__device__ void phase_ln1_router(const Params& p, int l, char* lds) {
    int tid = threadIdx.x; asm volatile("" : "+v"(tid));
    const int wid = tid >> 6, lane = tid & 63, fr = lane & 15, fq = lane >> 4;
    float* lg = (float*)lds + wid * 512;
    int* lcnt = (int*)(lds + 8192); int* lbase = lcnt + 32;
    const float* g1 = p.ln1_g + l * DM; const float* b1 = p.ln1_b + l * DM;
    const float* rw = p.rwT + (size_t)l * NE * 1024; const float* rb = p.router_b + l * NE;
    unsigned* gcount = p.ctrl + 64 + l * NE;
    for (int grp = blockIdx.x; grp < NTOK / 64; grp += gridDim.x) {
        const int tok0 = grp * 64 + wid * 16;
        if (tid < 32) lcnt[tid] = 0;
        for (int r = 0; r < 16; ++r) {
            const size_t row = (size_t)(tok0 + r);
            float4 v[4]; float s = 0.f;
#pragma unroll
            for (int j = 0; j < 4; ++j) { v[j] = *(const float4*)(p.tbuf + row * DM + j * 256 + lane * 4); s += (v[j].x + v[j].y) + (v[j].z + v[j].w); }
            const float mean = wave_sum(s) * (1.0f / 1024.0f);
            float qv = 0.f;
#pragma unroll
            for (int j = 0; j < 4; ++j) { v[j].x -= mean; v[j].y -= mean; v[j].z -= mean; v[j].w -= mean; qv += (v[j].x * v[j].x + v[j].y * v[j].y) + (v[j].z * v[j].z + v[j].w * v[j].w); }
            const float rstd = rsqrtf(wave_sum(qv) * (1.0f / 1024.0f) + LN_EPS);
#pragma unroll
            for (int j = 0; j < 4; ++j) {
                const int c = j * 256 + lane * 4;
                const float4 gg = *(const float4*)(g1 + c), bb = *(const float4*)(b1 + c);
                float4 y; y.x = v[j].x * rstd * gg.x + bb.x; y.y = v[j].y * rstd * gg.y + bb.y; y.z = v[j].z * rstd * gg.z + bb.z; y.w = v[j].w * rstd * gg.w + bb.w;
                *(float4*)(p.x1f + row * DM + c) = y;
                u32x2 w; w.x = pack2(y.x, y.y); w.y = pack2(y.z, y.w);
                *(u32x2*)(p.x1b + row * DM + c) = w;
            }
        }
        __syncthreads();
        f32x4 a0 = (f32x4){0.f, 0.f, 0.f, 0.f}, a1 = a0;
        const float* xr = p.x1f + (size_t)(tok0 + fr) * DM + 4 * fq;
        const float* w0 = rw + (size_t)fr * 1024 + 4 * fq; const float* w1 = rw + (size_t)(16 + fr) * 1024 + 4 * fq;
        for (int k0 = 0; k0 < 1024; k0 += 16) {
            const float4 xa = *(const float4*)(xr + k0), wb0 = *(const float4*)(w0 + k0), wb1 = *(const float4*)(w1 + k0);
            a0 = __builtin_amdgcn_mfma_f32_16x16x4f32(xa.x, wb0.x, a0, 0, 0, 0); a1 = __builtin_amdgcn_mfma_f32_16x16x4f32(xa.x, wb1.x, a1, 0, 0, 0);
            a0 = __builtin_amdgcn_mfma_f32_16x16x4f32(xa.y, wb0.y, a0, 0, 0, 0); a1 = __builtin_amdgcn_mfma_f32_16x16x4f32(xa.y, wb1.y, a1, 0, 0, 0);
            a0 = __builtin_amdgcn_mfma_f32_16x16x4f32(xa.z, wb0.z, a0, 0, 0, 0); a1 = __builtin_amdgcn_mfma_f32_16x16x4f32(xa.z, wb1.z, a1, 0, 0, 0);
            a0 = __builtin_amdgcn_mfma_f32_16x16x4f32(xa.w, wb0.w, a0, 0, 0, 0); a1 = __builtin_amdgcn_mfma_f32_16x16x4f32(xa.w, wb1.w, a1, 0, 0, 0);
        }
#pragma unroll
        for (int r = 0; r < 4; ++r) { lg[(fq * 4 + r) * 32 + fr] = a0[r] + rb[fr]; lg[(fq * 4 + r) * 32 + 16 + fr] = a1[r] + rb[16 + fr]; }
        lds_wave_sync();
        int e4[4] = {0, 0, 0, 0}; int rk[4] = {0, 0, 0, 0};
        if (lane < 16) {
            const float* my = lg + lane * 32; unsigned taken = 0u; float tv[4];
#pragma unroll
            for (int k = 0; k < 4; ++k) {
                float best = NEG_INF; int bi = 0;
                for (int e = 0; e < 32; ++e) { const float xv = my[e]; if (!((taken >> e) & 1u) && xv > best) { best = xv; bi = e; } }
                taken |= 1u << bi; e4[k] = bi; tv[k] = best;
            }
            const float e1 = __expf(tv[1] - tv[0]), e2 = __expf(tv[2] - tv[0]), e3 = __expf(tv[3] - tv[0]);
            const float inv = 1.0f / (1.0f + e1 + e2 + e3);
            const size_t row = (size_t)(tok0 + lane);
            *(int4*)(p.top_e + row * 4) = make_int4(e4[0], e4[1], e4[2], e4[3]);
            *(float4*)(p.gw + row * 4) = make_float4(inv, e1 * inv, e2 * inv, e3 * inv);
        }
        __syncthreads();
        if (lane < 16) {
#pragma unroll
            for (int k = 0; k < 4; ++k) rk[k] = atomicAdd(&lcnt[e4[k]], 1);
        }
        __syncthreads();
        if (tid < 32) { const int c = lcnt[tid]; lbase[tid] = c ? (int)__hip_atomic_fetch_add(gcount + tid, (unsigned)c, __ATOMIC_RELAXED, __HIP_MEMORY_SCOPE_AGENT) : 0; }
        __syncthreads();
        if (lane < 16) {
            const int row = tok0 + lane;
#pragma unroll
            for (int k = 0; k < 4; ++k) p.lists[(size_t)e4[k] * LIST_CAP + lbase[e4[k]] + rk[k]] = row * 4 + k;
        }
        __syncthreads();
    }
}

__device__ void phase_ln2(const Params& p, int l, float* xout) {
    int tid = threadIdx.x; asm volatile("" : "+v"(tid));
    const int wid = tid >> 6, lane = tid & 63;
    const float* g2 = p.ln2_g + l * DM; const float* b2 = p.ln2_b + l * DM;
    for (int row = blockIdx.x * 4 + wid; row < NTOK; row += gridDim.x * 4) {
        const float4 gwv = *(const float4*)(p.gw + (size_t)row * 4);
        const float gk[4] = {gwv.x, gwv.y, gwv.z, gwv.w};
        float4 v[4]; float s = 0.f;
#pragma unroll
        for (int j = 0; j < 4; ++j) {
            const int c = j * 256 + lane * 4;
            const float4 xv = *(const float4*)(p.x1f + (size_t)row * DM + c);
            float4 a; a.x = xv.x * ALPHA; a.y = xv.y * ALPHA; a.z = xv.z * ALPHA; a.w = xv.w * ALPHA;
#pragma unroll
            for (int k = 0; k < 4; ++k) {
                const u32x2 w = *(const u32x2*)(p.ybuf + ((size_t)row * 4 + k) * DM + c);
                a.x += gk[k] * __uint_as_float(w.x << 16); a.y += gk[k] * __uint_as_float(w.x & 0xffff0000u);
                a.z += gk[k] * __uint_as_float(w.y << 16); a.w += gk[k] * __uint_as_float(w.y & 0xffff0000u);
            }
            v[j] = a; s += (a.x + a.y) + (a.z + a.w);
        }
        const float mean = wave_sum(s) * (1.0f / 1024.0f);
        float qv = 0.f;
#pragma unroll
        for (int j = 0; j < 4; ++j) { v[j].x -= mean; v[j].y -= mean; v[j].z -= mean; v[j].w -= mean; qv += (v[j].x * v[j].x + v[j].y * v[j].y) + (v[j].z * v[j].z + v[j].w * v[j].w); }
        const float rstd = rsqrtf(wave_sum(qv) * (1.0f / 1024.0f) + LN_EPS);
#pragma unroll
        for (int j = 0; j < 4; ++j) {
            const int c = j * 256 + lane * 4;
            const float4 gg = *(const float4*)(g2 + c), bb = *(const float4*)(b2 + c);
            float4 y; y.x = v[j].x * rstd * gg.x + bb.x; y.y = v[j].y * rstd * gg.y + bb.y; y.z = v[j].z * rstd * gg.z + bb.z; y.w = v[j].w * rstd * gg.w + bb.w;
            *(float4*)(xout + (size_t)row * DM + c) = y;
            u32x2 w; w.x = pack2(y.x, y.y); w.y = pack2(y.z, y.w);
            *(u32x2*)(p.xb + (size_t)row * DM + c) = w;
        }
    }
}

constexpr int NPHASE = 1 + 8 * NL;
__global__ void __launch_bounds__(256, 2) fwd_kernel(Params p, int ph_lo, int ph_hi) {
    extern __shared__ __attribute__((aligned(16))) char lds[];
    cg::grid_group grid = cg::this_grid();
    for (int ph = ph_lo; ph < ph_hi; ++ph) {
        if (ph > ph_lo) grid.sync();
#ifndef SKIP_P0
        if (ph == 0) { phase0(p, lds); continue; }
#else
        if (ph == 0) continue;
#endif
        const int l = (ph - 1) >> 3, s = (ph - 1) & 7;
        const float* xin = l == 0 ? p.x : p.xf;
        float* xout = l == NL - 1 ? p.out : p.xf;
        switch (s) {
#ifndef SKIP_S0
            case 0: phase_inproj(p, l, lds); break;
#endif
#ifndef SKIP_S1
            case 1: phase_prep(p, l, lds); break;
#endif
#ifndef SKIP_S2
            case 2: phase_attn_naive(p, l, lds); break;
#endif
#ifndef SKIP_S3
            case 3: phase_outproj(p, l, xin, lds); break;
#endif
#ifndef SKIP_S4
            case 4: phase_ln1_router(p, l, lds); break;
#endif
#ifndef SKIP_S5
            case 5: phase_gateup(p, l, lds); break;
#endif
#ifndef SKIP_S6
            case 6: phase_down(p, l, lds); break;
#endif
#ifndef SKIP_S7
            default: phase_ln2(p, l, xout); break;
#else
            default: break;
#endif
        }
    }
}

static inline size_t align_up(size_t v, size_t a) { return (v + a - 1) / a * a; }

extern "C" void kernel_launch(void* const* d_in, const int* in_sizes, int n_in, void* d_out, int out_size, void* d_ws, size_t ws_size, hipStream_t stream) {
    Params p{};
    p.x = (const float*)d_in[0]; p.w_in = (const float*)d_in[1]; p.b_in = (const float*)d_in[2]; p.sinks = (const float*)d_in[3];
    p.cmp_pe = (const float*)d_in[4]; p.cmp_w1 = (const float*)d_in[5]; p.cmp_w2 = (const float*)d_in[6]; p.w_out = (const float*)d_in[7];
    p.ln1_g = (const float*)d_in[8]; p.ln1_b = (const float*)d_in[9]; p.router_w = (const float*)d_in[10]; p.router_b = (const float*)d_in[11];
    p.w_gu = (const float*)d_in[12]; p.b_gu = (const float*)d_in[13]; p.w_dn = (const float*)d_in[14]; p.b_dn = (const float*)d_in[15];
    p.ln2_g = (const float*)d_in[16]; p.ln2_b = (const float*)d_in[17];
    p.out = (float*)d_out;
    char* w = (char*)d_ws; size_t off = 0;
    auto take = [&](size_t bytes) { char* r = w + off; off = align_up(off + bytes, 256); return r; };
    p.ctrl = (unsigned*)take(65536);
    p.WinT = (bf16_t*)take((size_t)NL * NPAD * 1024 * 2);
    p.WoT = (bf16_t*)take((size_t)NL * 1024 * 1024 * 2);
    p.W1T = (bf16_t*)take((size_t)NL * 2 * 64 * 2048 * 2);
    p.W2T = (bf16_t*)take((size_t)NL * 2 * 64 * 64 * 2);
    p.WguT = (bf16_t*)take((size_t)NL * NE * 2048 * 1024 * 2);
    p.WdnT = (bf16_t*)take((size_t)NL * NE * 1024 * 1024 * 2);
    p.rwT = (float*)take((size_t)NL * NE * 1024 * 4);
    p.binp = (float*)take((size_t)NL * NPAD * 4);
    p.bgup = (float*)take((size_t)NL * NE * 2048 * 4);
    p.b1c = (float*)take(4 * 64 * 4);
    p.xf = (float*)take((size_t)NTOK * DM * 4);
    p.xb = (bf16_t*)take((size_t)NTOK * DM * 2);
    p.hb = (bf16_t*)take((size_t)NTOK * NMAIN * 2);
    p.hs = (float*)take((size_t)NTOK * HS_W * 4);
    p.vT = (bf16_t*)take((size_t)NB * NVH * 64 * SEQ * 2);
    p.cF = (float*)take((size_t)NB * 4 * SEQ * 4);
    p.kc = (bf16_t*)take((size_t)NB * 2 * 128 * 64 * 2);
    p.vc = (bf16_t*)take((size_t)NB * 2 * 128 * 64 * 2);
    p.vcT = (bf16_t*)take((size_t)NB * 2 * 128 * 64 * 2);
    p.ob = (bf16_t*)take((size_t)NTOK * DM * 2);
    p.tbuf = (float*)take((size_t)NTOK * DM * 4);
    p.x1f = (float*)take((size_t)NTOK * DM * 4);
    p.x1b = (bf16_t*)take((size_t)NTOK * DM * 2);
    p.top_e = (int*)take((size_t)NTOK * 4 * 4);
    p.gw = (float*)take((size_t)NTOK * 4 * 4);
    p.lists = (int*)take((size_t)NE * LIST_CAP * 4);
    p.act = (bf16_t*)take((size_t)MAXSLOT * DFF * 2);
    p.ybuf = (bf16_t*)take((size_t)NTOK * 4 * DM * 2);
    if (off > ws_size) { fprintf(stderr, "workspace too small: need %zu have %zu\n", off, ws_size); return; }

    static int grid_blocks = 0;
    if (!grid_blocks) {
        int dev = 0, cus = 0, per_cu = 0;
        hipGetDevice(&dev);
        hipDeviceGetAttribute(&cus, hipDeviceAttributeMultiprocessorCount, dev);
        hipFuncSetAttribute((const void*)fwd_kernel, hipFuncAttributeMaxDynamicSharedMemorySize, LDS_BYTES);
        hipOccupancyMaxActiveBlocksPerMultiprocessor(&per_cu, fwd_kernel, 256, LDS_BYTES);
        if (per_cu > 2) per_cu = 2;
        if (per_cu < 1) per_cu = 1;
        grid_blocks = cus * per_cu;
    }
    hipMemsetAsync(p.ctrl, 0, 65536, stream);
#if ONE_LAUNCH
    int lo = 0, hi = NPHASE;
    void* args[] = {&p, &lo, &hi};
    hipError_t e = hipLaunchCooperativeKernel((const void*)fwd_kernel, dim3(grid_blocks), dim3(256), args, LDS_BYTES, stream);
    if (e != hipSuccess) fprintf(stderr, "cooperative launch failed: %s (grid %d)\n", hipGetErrorString(e), grid_blocks);
#else
    for (int ph = 0; ph < NPHASE; ++ph) fwd_kernel<<<grid_blocks, 256, LDS_BYTES, stream>>>(p, ph, ph + 1);
#endif
}
```

```cpp
#include <hip/hip_runtime.h>
#include <hip/hip_cooperative_groups.h>
#include <cstdio>
#include <cstdint>
namespace cg = cooperative_groups;

#ifndef ONE_LAUNCH
#define ONE_LAUNCH 1
#endif

typedef unsigned short bf16_t;
typedef short bf16x8 __attribute__((ext_vector_type(8)));
typedef float f32x4 __attribute__((ext_vector_type(4)));
typedef unsigned u32x4 __attribute__((ext_vector_type(4)));
typedef unsigned u32x2 __attribute__((ext_vector_type(2)));

constexpr int DM = 1024, NB = 16, SEQ = 2048, NTOK = NB * SEQ, NL = 2;
constexpr int NCOL = 2582, NMAIN = 2560, NPAD = 2688, NE = 32, DFF = 1024;
constexpr int C_FQ = 0, C_FK = 256, C_FV = 512, C_SQ = 768, C_SK = 1152, C_SV = 1280, C_NQ = 1408,
              C_NKC = 1792, C_NVC = 1920, C_NKS = 2048, C_NVS = 2176, C_NKW = 2304, C_NVW = 2432;
constexpr int HS_W = 32;
constexpr int NVH = 10;
constexpr int LIST_CAP = NTOK;
constexpr int MAXSLOT = NTOK * 4 + NE * 128;
constexpr float ALPHA = 1.41421356237f, LN_EPS = 1e-5f, QSCALE = 0.125f;
constexpr int LDS_BYTES = 65536;

struct Params {
    const float *x, *w_in, *b_in, *sinks, *cmp_pe, *cmp_w1, *cmp_w2, *w_out, *ln1_g, *ln1_b, *router_w, *router_b,
                *w_gu, *b_gu, *w_dn, *b_dn, *ln2_g, *ln2_b;
    float* out;
    unsigned* ctrl;
    bf16_t *WinT, *WoT, *W1T, *W2T, *WguT, *WdnT;
    float *rwT, *binp, *bgup, *b1c;
    float* xf;
    bf16_t* xb;
    bf16_t* hb;
    float* hs;
    bf16_t* vT;
    float* cF;
    bf16_t *kc, *vc, *vcT;
    bf16_t* ob;
    float* tbuf;
    float* x1f; bf16_t* x1b;
    int* top_e; float* gw;
    int* lists;
    bf16_t* act;
    bf16_t* ybuf;
};

__device__ __forceinline__ float bf2f(bf16_t h) { return __uint_as_float(((unsigned)h) << 16); }
__device__ __forceinline__ bf16_t f2bf(float f) { unsigned u = __float_as_uint(f); u += 0x7fffu + ((u >> 16) & 1u); return (bf16_t)(u >> 16); }
__device__ __forceinline__ unsigned pack2(float lo, float hi) { return (unsigned)f2bf(lo) | ((unsigned)f2bf(hi) << 16); }
__device__ __forceinline__ float wave_sum(float v) {
#pragma unroll
    for (int o = 32; o > 0; o >>= 1) v += __shfl_xor(v, o);
    return v;
}
__device__ __forceinline__ float wave_max(float v) {
#pragma unroll
    for (int o = 32; o > 0; o >>= 1) v = fmaxf(v, __shfl_xor(v, o));
    return v;
}
__device__ __forceinline__ void lds_wave_sync() { asm volatile("s_waitcnt lgkmcnt(0)" ::: "memory"); __builtin_amdgcn_wave_barrier(); }
__device__ __forceinline__ float slope_swa(int hq) { return exp2f(-8.0f * (float)(2 * hq + 1) / 12.0f); }
__device__ __forceinline__ float slope_nsa(int hq) { return exp2f(-8.0f * (float)(2 * hq + 2) / 12.0f); }

template <int PERM>
__device__ __forceinline__ int perm_row(int n) {
    if (PERM == 1) { if (n < 768) return n; if (n < 772) return 2560 + (n - 768); if (n < 2564) return n - 4; return n; }
    if (PERM == 2) { const int f = n >> 1, s = n & 1; return (f >> 5) * 64 + s * 32 + (f & 31); }
    return n;
}
template <int PERM>
__device__ __forceinline__ void conv_tile(const float* __restrict__ src, int K, int N, int kt, int nt, bf16_t* __restrict__ dst, float* lds) {
    int tid = threadIdx.x; asm volatile("" : "+v"(tid));
#pragma unroll
    for (int i = 0; i < 4; ++i) {
        const int kk = (tid >> 4) + 16 * i, nn = (tid & 15) * 4;
        const int k = kt * 64 + kk, n = nt * 64 + nn;
        const float* p = src + (size_t)k * N + n;
        float v0 = 0.f, v1 = 0.f, v2 = 0.f, v3 = 0.f;
        if (n + 3 < N) { v0 = p[0]; v1 = p[1]; v2 = p[2]; v3 = p[3]; }
        else { if (n < N) v0 = p[0]; if (n + 1 < N) v1 = p[1]; if (n + 2 < N) v2 = p[2]; }
        float* l = lds + kk * 65 + nn; l[0] = v0; l[1] = v1; l[2] = v2; l[3] = v3;
    }
    __syncthreads();
#pragma unroll
    for (int i = 0; i < 2; ++i) {
        const int idx = tid + 256 * i, nn = idx >> 3, kc = idx & 7, n = nt * 64 + nn;
        if (n < N) {
            const float* l = lds + (kc * 8) * 65 + nn;
            u32x4 w; w.x = pack2(l[0], l[65]); w.y = pack2(l[130], l[195]); w.z = pack2(l[260], l[325]); w.w = pack2(l[390], l[455]);
            *(u32x4*)(dst + (size_t)perm_row<PERM>(n) * K + kt * 64 + kc * 8) = w;
        }
    }
    __syncthreads();
}

__device__ void phase0(const Params& p, char* ldsc) {
    float* lds = (float*)ldsc;
    int tid = threadIdx.x; asm volatile("" : "+v"(tid));
    const int G = gridDim.x, bid = blockIdx.x;
    const size_t gtid = (size_t)bid * 256 + tid, gthreads = (size_t)G * 256;
    for (size_t i = gtid; i < (size_t)NL * NPAD; i += gthreads) {
        const int l = (int)(i / NPAD), r = (int)(i % NPAD);
        float v = 0.f;
        if (r < 2560) { const int n = r < 768 ? r : r + 4; v = p.b_in[l * NCOL + n]; }
        else if (r < 2564) v = p.b_in[l * NCOL + 768 + (r - 2560)];
        else if (r < 2582) v = p.b_in[l * NCOL + r];
        p.binp[i] = v;
    }
    for (size_t i = gtid; i < (size_t)NL * NE * 2048; i += gthreads) {
        const int r = (int)(i % 2048); const size_t le = i / 2048;
        const int q = r >> 6, s = (r >> 5) & 1, f = q * 32 + (r & 31);
        p.bgup[i] = p.b_gu[le * 2048 + 2 * f + s];
    }
    for (size_t i = gtid; i < (size_t)NL * NE * 1024; i += gthreads) {
        const int k = (int)(i % 1024), e = (int)((i / 1024) % NE), l = (int)(i / (1024 * NE));
        p.rwT[i] = p.router_w[((size_t)l * 1024 + k) * NE + e];
    }
    for (size_t i = gtid; i < (size_t)NL * (NPAD - NCOL) * 1024; i += gthreads) {
        const int l = (int)(i / ((NPAD - NCOL) * 1024)); const size_t r = i % ((size_t)(NPAD - NCOL) * 1024);
        p.WinT[(size_t)l * NPAD * 1024 + (size_t)NCOL * 1024 + r] = 0;
    }
    for (size_t i = gtid; i < (size_t)NTOK * DM / 4; i += gthreads) {
        const float4 v = ((const float4*)p.x)[i];
        u32x2 w; w.x = pack2(v.x, v.y); w.y = pack2(v.z, v.w);
        ((u32x2*)p.xb)[i] = w;
    }
    if (bid < 4) {
        const int j = tid & 63, part = tid >> 6;
        const float* pe = p.cmp_pe + (size_t)bid * 2048; const float* w1 = p.cmp_w1 + (size_t)bid * 2048 * 64;
        float s = 0.f;
        for (int kk = part * 512; kk < part * 512 + 512; ++kk) s += pe[kk] * w1[(size_t)kk * 64 + j];
        lds[tid] = s; __syncthreads();
        if (tid < 64) p.b1c[bid * 64 + tid] = lds[tid] + lds[tid + 64] + lds[tid + 128] + lds[tid + 192];
        __syncthreads();
    }
    constexpr int T_WIN = NL * 16 * 41, T_WO = NL * 16 * 16, T_W1 = NL * 2 * 32, T_W2 = NL * 2, T_GU = NL * NE * 16 * 32, T_DN = NL * NE * 16 * 16;
    constexpr int TOT = T_WIN + T_WO + T_W1 + T_W2 + T_GU + T_DN;
    for (int t = bid; t < TOT; t += G) {
        int u = t;
        if (u < T_GU) { const int m = u / 512, r = u % 512; conv_tile<2>(p.w_gu + (size_t)m * 1024 * 2048, 1024, 2048, r / 32, r % 32, p.WguT + (size_t)m * 2048 * 1024, lds); continue; }
        u -= T_GU;
        if (u < T_DN) { const int m = u / 256, r = u % 256; conv_tile<0>(p.w_dn + (size_t)m * 1024 * 1024, 1024, 1024, r / 16, r % 16, p.WdnT + (size_t)m * 1024 * 1024, lds); continue; }
        u -= T_DN;
        if (u < T_WIN) { const int m = u / 656, r = u % 656; conv_tile<1>(p.w_in + (size_t)m * 1024 * NCOL, 1024, NCOL, r / 41, r % 41, p.WinT + (size_t)m * NPAD * 1024, lds); continue; }
        u -= T_WIN;
        if (u < T_WO) { const int m = u / 256, r = u % 256; conv_tile<0>(p.w_out + (size_t)m * 1024 * 1024, 1024, 1024, r / 16, r % 16, p.WoT + (size_t)m * 1024 * 1024, lds); continue; }
        u -= T_WO;
        if (u < T_W1) { const int m = u / 32, r = u % 32; conv_tile<0>(p.cmp_w1 + (size_t)m * 2048 * 64, 2048, 64, r, 0, p.W1T + (size_t)m * 64 * 2048, lds); continue; }
        u -= T_W1;
        { const int m = u; conv_tile<0>(p.cmp_w2 + (size_t)m * 64 * 64, 64, 64, 0, 0, p.W2T + (size_t)m * 64 * 64, lds); }
    }
}

template <class Epi>
__device__ __forceinline__ void gemm128(const bf16_t* __restrict__ A, size_t lda, const int* rowsrc, int m0,
                                        const bf16_t* __restrict__ Bt, int K, char* lds, const Epi& epi) {
    int tid = threadIdx.x; asm volatile("" : "+v"(tid));
    const int wid = tid >> 6, lane = tid & 63, wr = wid >> 1, wc = wid & 1, fr = lane & 15, fq = lane >> 4;
    char* SA = lds; char* SB = lds + 8192;
    const bf16_t* ap[2]; const bf16_t* bp[2];
#pragma unroll
    for (int i = 0; i < 2; ++i) {
        const int b = tid * 16 + i * 4096, r = b >> 6, c = (b & 63) >> 1;
        const int arow = rowsrc ? rowsrc[r] : (m0 + r);
        ap[i] = A + (size_t)arow * lda + c; bp[i] = Bt + (size_t)r * K + c;
    }
    f32x4 acc[4][4];
#pragma unroll
    for (int m = 0; m < 4; ++m)
#pragma unroll
        for (int n = 0; n < 4; ++n) acc[m][n] = (f32x4){0.f, 0.f, 0.f, 0.f};
    for (int kt = 0; kt < K / 32; ++kt) {
#pragma unroll
        for (int i = 0; i < 2; ++i) {
            const int b = tid * 16 + i * 4096;
            __builtin_amdgcn_global_load_lds((const unsigned*)(ap[i] + kt * 32), (__attribute__((address_space(3))) unsigned*)(SA + b), 16, 0, 0);
            __builtin_amdgcn_global_load_lds((const unsigned*)(bp[i] + kt * 32), (__attribute__((address_space(3))) unsigned*)(SB + b), 16, 0, 0);
        }
        asm volatile("s_waitcnt vmcnt(0)" ::: "memory");
        __syncthreads();
        bf16x8 At[4], Bl[4];
#pragma unroll
        for (int m = 0; m < 4; ++m) At[m] = *(const bf16x8*)(SA + (wr * 64 + m * 16 + fr) * 64 + fq * 16);
#pragma unroll
        for (int n = 0; n < 4; ++n) Bl[n] = *(const bf16x8*)(SB + (wc * 64 + n * 16 + fr) * 64 + fq * 16);
#pragma unroll
        for (int m = 0; m < 4; ++m)
#pragma unroll
            for (int n = 0; n < 4; ++n) acc[m][n] = __builtin_amdgcn_mfma_f32_16x16x32_bf16(Bl[n], At[m], acc[m][n], 0, 0, 0);
        __syncthreads();
    }
    epi(acc, wr * 64 + fr, wc * 64 + 4 * fq);
}

struct EpiInProj {
    const Params* p; int l, m0, n0;
    __device__ __forceinline__ void operator()(const f32x4 (&acc)[4][4], int r0, int c0) const {
        const float* bias = p->binp + l * NPAD + n0;
        if (n0 == NMAIN) {
#pragma unroll
            for (int n = 0; n < 2; ++n) {
                const int c = c0 + n * 16;
                if (c < 22 + 3) {
#pragma unroll
                    for (int m = 0; m < 4; ++m) {
                        const int row = m0 + r0 + m * 16;
#pragma unroll
                        for (int j = 0; j < 4; ++j) if (c + j < 22) p->hs[(size_t)row * HS_W + c + j] = acc[m][n][j] + bias[c + j];
                    }
                }
            }
            return;
        }
        int vh = -1;
        if (n0 == 512) vh = 0; else if (n0 == 640) vh = 2; else if (n0 == 1280) vh = 4; else if (n0 == 2176) vh = 6; else if (n0 == 2432) vh = 8;
#pragma unroll
        for (int n = 0; n < 4; ++n) {
            const int c = c0 + n * 16;
            const f32x4 bv = *(const f32x4*)(bias + c);
#pragma unroll
            for (int m = 0; m < 4; ++m) {
                const int row = m0 + r0 + m * 16;
                const f32x4 v = acc[m][n] + bv;
                u32x2 w; w.x = pack2(v[0], v[1]); w.y = pack2(v[2], v[3]);
                *(u32x2*)(p->hb + (size_t)row * NMAIN + n0 + c) = w;
                if (vh >= 0) {
                    const int b = row >> 11, s = row & 2047, hh = vh + (c >> 6), d = c & 63;
                    bf16_t* vt = p->vT + (((size_t)b * NVH + hh) * 64 + d) * SEQ + s;
                    vt[0] = (bf16_t)(w.x & 0xffff); vt[SEQ] = (bf16_t)(w.x >> 16); vt[2 * SEQ] = (bf16_t)(w.y & 0xffff); vt[3 * SEQ] = (bf16_t)(w.y >> 16);
                }
            }
        }
    }
};
struct EpiOutProj {
    const float* xin; float* t; int m0, n0;
    __device__ __forceinline__ void operator()(const f32x4 (&acc)[4][4], int r0, int c0) const {
#pragma unroll
        for (int m = 0; m < 4; ++m)
#pragma unroll
            for (int n = 0; n < 4; ++n) {
                const size_t off = (size_t)(m0 + r0 + m * 16) * DM + n0 + c0 + n * 16;
                const f32x4 xv = *(const f32x4*)(xin + off);
                *(f32x4*)(t + off) = xv * ALPHA + acc[m][n];
            }
    }
};
struct EpiGateUp {
    bf16_t* act; const float* bias; int slot0, n0;
    __device__ __forceinline__ void operator()(const f32x4 (&acc)[4][4], int r0, int c0) const {
        const int wcb = c0 & 64, q4 = c0 & 63;
        const int fbase = ((n0 + wcb) >> 6) * 32;
#pragma unroll
        for (int n = 0; n < 2; ++n) {
            const f32x4 bg = *(const f32x4*)(bias + n0 + wcb + n * 16 + q4), bu = *(const f32x4*)(bias + n0 + wcb + 32 + n * 16 + q4);
#pragma unroll
            for (int m = 0; m < 4; ++m) {
                const f32x4 g4 = acc[m][n] + bg, u4 = acc[m][n + 2] + bu;
                float o[4];
#pragma unroll
                for (int j = 0; j < 4; ++j) {
                    const float g = fminf(g4[j], 7.0f), u = fminf(fmaxf(u4[j], -7.0f), 7.0f);
                    const float glu = g / (1.0f + __expf(-1.702f * g));
                    o[j] = (u + 1.0f) * glu;
                }
                u32x2 w; w.x = pack2(o[0], o[1]); w.y = pack2(o[2], o[3]);
                *(u32x2*)(act + (size_t)(slot0 + r0 + m * 16) * DFF + fbase + n * 16 + q4) = w;
            }
        }
    }
};
struct EpiDown {
    bf16_t* ybuf; const float* bias; const int* lst; int cnt, rb, n0;
    __device__ __forceinline__ void operator()(const f32x4 (&acc)[4][4], int r0, int c0) const {
#pragma unroll
        for (int m = 0; m < 4; ++m) {
            const int lr = rb * 128 + r0 + m * 16;
            if (lr < cnt) {
                const int a = lst[lr];
#pragma unroll
                for (int n = 0; n < 4; ++n) {
                    const int c = n0 + c0 + n * 16;
                    const f32x4 v = acc[m][n] + *(const f32x4*)(bias + c);
                    u32x2 w; w.x = pack2(v[0], v[1]); w.y = pack2(v[2], v[3]);
                    *(u32x2*)(ybuf + (size_t)a * DM + c) = w;
                }
            }
        }
    }
};

__device__ void phase_inproj(const Params& p, int l, char* lds) {
    constexpr int NT = NPAD / 128, MT = NTOK / 128;
    const bf16_t* W = p.WinT + (size_t)l * NPAD * 1024;
    for (int t = blockIdx.x; t < MT * NT; t += gridDim.x) {
        const int mt = t / NT, nt = t % NT;
        EpiInProj e{&p, l, mt * 128, nt * 128};
        gemm128(p.xb, DM, nullptr, mt * 128, W + (size_t)nt * 128 * 1024, 1024, lds, e);
    }
}
__device__ void phase_outproj(const Params& p, int l, const float* xin, char* lds) {
    constexpr int NT = 8, MT = NTOK / 128;
    const bf16_t* W = p.WoT + (size_t)l * 1024 * 1024;
    for (int t = blockIdx.x; t < MT * NT; t += gridDim.x) {
        const int mt = t / NT, nt = t % NT;
        EpiOutProj e{xin, p.tbuf, mt * 128, nt * 128};
        gemm128(p.ob, DM, nullptr, mt * 128, W + (size_t)nt * 128 * 1024, 1024, lds, e);
    }
}
__device__ __forceinline__ void build_tiles(const Params& p, int l, int* ptile, int* ecnt) {
    if (threadIdx.x < NE) ecnt[threadIdx.x] = (int)__hip_atomic_load(p.ctrl + 64 + l * NE + threadIdx.x, __ATOMIC_RELAXED, __HIP_MEMORY_SCOPE_AGENT);
    __syncthreads();
    if (threadIdx.x == 0) { int s = 0; for (int e = 0; e < NE; ++e) { ptile[e] = s; s += (ecnt[e] + 127) >> 7; } ptile[NE] = s; }
    __syncthreads();
}
__device__ void phase_gateup(const Params& p, int l, char* lds) {
    int* ptile = (int*)(lds + 16384); int* ecnt = ptile + 40; int* rows = ecnt + 40;
    build_tiles(p, l, ptile, ecnt);
    const int ntile = ptile[NE];
    for (int t = blockIdx.x; t < ntile * 16; t += gridDim.x) {
        const int rbt = t >> 4, nt = t & 15;
        int e = 0; while (ptile[e + 1] <= rbt) ++e;
        const int rb = rbt - ptile[e], cnt = ecnt[e];
        const int* lst = p.lists + (size_t)e * LIST_CAP;
        if (threadIdx.x < 128) { const int lr = rb * 128 + threadIdx.x; rows[threadIdx.x] = lr < cnt ? (lst[lr] >> 2) : 0; }
        __syncthreads();
        EpiGateUp ep{p.act, p.bgup + ((size_t)l * NE + e) * 2048, rbt * 128, nt * 128};
        gemm128(p.x1b, DM, rows, 0, p.WguT + (((size_t)l * NE + e) * 2048 + (size_t)nt * 128) * 1024, 1024, lds, ep);
    }
}
__device__ void phase_down(const Params& p, int l, char* lds) {
    int* ptile = (int*)(lds + 16384); int* ecnt = ptile + 40;
    build_tiles(p, l, ptile, ecnt);
    const int ntile = ptile[NE];
    for (int t = blockIdx.x; t < ntile * 8; t += gridDim.x) {
        const int rbt = t >> 3, nt = t & 7;
        int e = 0; while (ptile[e + 1] <= rbt) ++e;
        const int rb = rbt - ptile[e];
        EpiDown ep{p.ybuf, p.b_dn + ((size_t)l * NE + e) * 1024, p.lists + (size_t)e * LIST_CAP, ecnt[e], rb, nt * 128};
        gemm128(p.act, DFF, nullptr, rbt * 128, p.WdnT + (((size_t)l * NE + e) * 1024 + (size_t)nt * 128) * 1024, 1024, lds, ep);
    }
}

__device__ __forceinline__ float gelu_tanh(float x) {
    const float u = 0.7978845608028654f * (x + 0.044715f * x * x * x);
    const float e = __expf(-2.0f * fabsf(u)); const float th = (1.0f - e) / (1.0f + e);
    return 0.5f * x * (1.0f + (u < 0.f ? -th : th));
}
__device__ void phase_prep(const Params& p, int l, char* lds) {
    int tid = threadIdx.x; asm volatile("" : "+v"(tid));
    const int wid = tid >> 6, lane = tid & 63, fr = lane & 15, fq = lane >> 4;
    const int gw = blockIdx.x * 4 + wid, nw = gridDim.x * 4;
    for (int u = gw; u < NB * 4; u += nw) {
        const int b = u >> 2, h = u & 3;
        const float* src = p.hs + (size_t)b * SEQ * HS_W + h;
        float* dst = p.cF + (size_t)u * SEQ;
        float tot = 0.f;
        for (int i = 0; i < 32; ++i) { const float f = src[(size_t)(lane * 32 + i) * HS_W]; tot += fminf(f, 0.f) - log1pf(__expf(-fabsf(f))); }
        float inc = tot;
#pragma unroll
        for (int o = 1; o < 64; o <<= 1) { const float v = __shfl_up(inc, o); if (lane >= o) inc += v; }
        float run = inc - tot;
        for (int i = 0; i < 32; ++i) { const float f = src[(size_t)(lane * 32 + i) * HS_W]; run += fminf(f, 0.f) - log1pf(__expf(-fabsf(f))); dst[lane * 32 + i] = run; }
    }
    bf16_t* h1 = (bf16_t*)(lds + wid * 2048);
    for (int u = gw; u < NB * 2 * 2 * 8; u += nw) {
        const int ct = u & 7, which = (u >> 3) & 1, kvh = (u >> 4) & 1, b = u >> 5;
        const int colo = (which ? C_NVC : C_NKC) + kvh * 64;
        const int c_lane = ct * 16 + fr;
        const int tokbase = min(c_lane, 126) * 16;
        const bf16_t* arow = p.hb + ((size_t)b * SEQ + tokbase) * NMAIN + colo + fq * 8;
        const bf16_t* w1 = p.W1T + ((size_t)(l * 2 + which) * 64 + fr) * 2048 + fq * 8;
        f32x4 acc[4];
#pragma unroll
        for (int n = 0; n < 4; ++n) acc[n] = (f32x4){0.f, 0.f, 0.f, 0.f};
        for (int ks = 0; ks < 64; ++ks) {
            const bf16x8 a = *(const bf16x8*)(arow + (size_t)(ks >> 1) * NMAIN + (ks & 1) * 32);
#pragma unroll
            for (int n = 0; n < 4; ++n) {
                const bf16x8 bb = *(const bf16x8*)(w1 + (size_t)n * 16 * 2048 + ks * 32);
                acc[n] = __builtin_amdgcn_mfma_f32_16x16x32_bf16(a, bb, acc[n], 0, 0, 0);
            }
        }
        const float* b1 = p.b1c + (l * 2 + which) * 64;
#pragma unroll
        for (int n = 0; n < 4; ++n)
#pragma unroll
            for (int r = 0; r < 4; ++r) h1[(fq * 4 + r) * 64 + n * 16 + fr] = f2bf(gelu_tanh(acc[n][r] + b1[n * 16 + fr]));
        lds_wave_sync();
        const bf16_t* w2 = p.W2T + ((size_t)(l * 2 + which) * 64 + fr) * 64 + fq * 8;
        f32x4 o2[4];
#pragma unroll
        for (int n = 0; n < 4; ++n) o2[n] = (f32x4){0.f, 0.f, 0.f, 0.f};
#pragma unroll
        for (int ks = 0; ks < 2; ++ks) {
            const bf16x8 a = *(const bf16x8*)(h1 + fr * 64 + ks * 32 + fq * 8);
#pragma unroll
            for (int n = 0; n < 4; ++n) {
                const bf16x8 bb = *(const bf16x8*)(w2 + (size_t)n * 16 * 64 + ks * 32);
                o2[n] = __builtin_amdgcn_mfma_f32_16x16x32_bf16(a, bb, o2[n], 0, 0, 0);
            }
        }
        lds_wave_sync();
        const size_t base = ((size_t)b * 2 + kvh) * 128 * 64;
#pragma unroll
        for (int n = 0; n < 4; ++n)
#pragma unroll
            for (int r = 0; r < 4; ++r) {
                const int c = ct * 16 + fq * 4 + r, j2 = n * 16 + fr;
                const bf16_t v = c < 127 ? f2bf(o2[n][r]) : (bf16_t)0;
                if (which == 0) p.kc[base + (size_t)c * 64 + j2] = v;
                else { p.vc[base + (size_t)c * 64 + j2] = v; p.vcT[base + (size_t)j2 * 128 + c] = v; }
            }
    }
}

__device__ __forceinline__ void load_q(const bf16_t* qp, float* q, int lane) {
    q[lane] = bf2f(qp[lane]) * QSCALE;
    lds_wave_sync();
}
__device__ __forceinline__ float dot_q(const bf16_t* kp, const float* q) {
    float s = 0.f;
#pragma unroll
    for (int i = 0; i < 8; ++i) {
        const u32x4 w = *(const u32x4*)(kp + i * 8);
        const float4 qa = *(const float4*)(q + i * 8), qb = *(const float4*)(q + i * 8 + 4);
        s += qa.x * __uint_as_float(w.x << 16) + qa.y * __uint_as_float(w.x & 0xffff0000u)
           + qa.z * __uint_as_float(w.y << 16) + qa.w * __uint_as_float(w.y & 0xffff0000u)
           + qb.x * __uint_as_float(w.z << 16) + qb.y * __uint_as_float(w.z & 0xffff0000u)
           + qb.z * __uint_as_float(w.w << 16) + qb.w * __uint_as_float(w.w & 0xffff0000u);
    }
    return s;
}
constexpr float NEG_INF = -__builtin_huge_valf();
template <class BF>
__device__ __forceinline__ float score_keys(const float* q, const bf16_t* Kb, size_t ld, int s_lo, int cnt, float* sc, int lane, const BF& bf) {
    float mx = NEG_INF;
    for (int i = lane; i < cnt; i += 64) {
        const int s = s_lo + i; float bias; const bool ok = bf(s, bias);
        float v = NEG_INF;
        if (ok) v = dot_q(Kb + (size_t)s * ld, q) + bias;
        sc[i] = v; mx = fmaxf(mx, v);
    }
    return mx;
}
__device__ __forceinline__ float softmax_lds(float* sc, int n, float mx, int lane) {
    float sum = 0.f;
    for (int i = lane; i < n; i += 64) { const float v = sc[i]; const float e = (v == NEG_INF) ? 0.f : __expf(v - mx); sc[i] = e; sum += e; }
    sum = wave_sum(sum);
    lds_wave_sync();
    return sum;
}
__device__ __forceinline__ float pv_keys(const bf16_t* Vb, size_t ld, int s_lo, int cnt, const float* sc, int lane, float o) {
    for (int i = 0; i < cnt; ++i) { const float pr = sc[i]; if (pr != 0.f) o += pr * bf2f(Vb[(size_t)(s_lo + i) * ld + lane]); }
    return o;
}

__device__ void phase_attn_naive(const Params& p, int l, char* lds) {
    int tid = threadIdx.x; asm volatile("" : "+v"(tid));
    const int wid = tid >> 6, lane = tid & 63;
    float* sc = (float*)(lds + wid * 9216);
    float* q = sc + 2176;
    const int gwv = blockIdx.x * 4 + wid, nw = gridDim.x * 4;
    for (int u = gwv; u < NTOK * 4; u += nw) {
        const int h = u & 3, tok = u >> 2, b = tok >> 11, t = tok & 2047;
        load_q(p.hb + (size_t)tok * NMAIN + C_FQ + h * 64, q, lane);
        const float* c = p.cF + ((size_t)b * 4 + h) * SEQ; const float ct = c[t];
        const bf16_t* Kb = p.hb + (size_t)b * SEQ * NMAIN + C_FK + h * 64;
        const bf16_t* Vb = p.hb + (size_t)b * SEQ * NMAIN + C_FV + h * 64;
        float mx = score_keys(q, Kb, NMAIN, 0, t + 1, sc, lane, [&](int s, float& bias) { bias = ct - c[s]; return true; });
        mx = wave_max(mx);
        const float sum = softmax_lds(sc, t + 1, mx, lane);
        const float o = pv_keys(Vb, NMAIN, 0, t + 1, sc, lane, 0.f);
        p.ob[(size_t)tok * DM + h * 64 + lane] = f2bf(o / sum);
        lds_wave_sync();
    }
    for (int u = gwv; u < NTOK * 6; u += nw) {
        const int hq = u % 6, tok = u / 6, b = tok >> 11, t = tok & 2047, kv = hq / 3;
        load_q(p.hb + (size_t)tok * NMAIN + C_SQ + hq * 64, q, lane);
        const float sl = slope_swa(hq), sink = p.sinks[l * 6 + hq];
        const bf16_t* Kb = p.hb + (size_t)b * SEQ * NMAIN + C_SK + kv * 64;
        const bf16_t* Vb = p.hb + (size_t)b * SEQ * NMAIN + C_SV + kv * 64;
        const int s_lo = max(0, t - 127), cnt = t - s_lo + 1;
        float mx = score_keys(q, Kb, NMAIN, s_lo, cnt, sc, lane, [&](int s, float& bias) { bias = -sl * (float)(t - s); return true; });
        mx = fmaxf(wave_max(mx), sink);
        const float sum = softmax_lds(sc, cnt, mx, lane) + __expf(sink - mx);
        const float o = pv_keys(Vb, NMAIN, s_lo, cnt, sc, lane, 0.f);
        p.ob[(size_t)tok * DM + 256 + hq * 64 + lane] = f2bf(o / sum);
        lds_wave_sync();
    }
    for (int u = gwv; u < NTOK * 2; u += nw) {
        const int kv = u & 1, tok = u >> 1, b = tok >> 11, t = tok & 2047;
        const int ncv = t >= 31 ? ((t - 31) >> 4) + 1 : 0, cur = t >> 6;
        const bf16_t* Kc = p.kc + ((size_t)b * 2 + kv) * 128 * 64;
        const bf16_t* Vc = p.vc + ((size_t)b * 2 + kv) * 128 * 64;
        float pslc = 0.f;
        for (int g = 0; g < 3; ++g) {
            const int hq = kv * 3 + g; const float sl = slope_nsa(hq);
            load_q(p.hb + (size_t)tok * NMAIN + C_NQ + hq * 64, q, lane);
            float mx = score_keys(q, Kc, 64, 0, ncv, sc, lane, [&](int c, float& bias) { bias = -sl * (float)(t - (16 * c + 31)); return true; });
            for (int i = ncv + lane; i < 132; i += 64) sc[i] = NEG_INF;
            mx = wave_max(mx);
            const float sum = softmax_lds(sc, 132, mx, lane);
            if (lane < 32 && ncv > 0) {
                const int n = lane; float a = sc[4 * n] + sc[4 * n + 1] + sc[4 * n + 2] + 0.5f * sc[4 * n + 3];
                if (n > 0) a += 0.5f * sc[4 * n - 1];
                pslc += a / sum;
            }
            lds_wave_sync();
        }
        unsigned mask = 1u | (1u << cur); if (cur >= 1) mask |= 1u << (cur - 1);
        if (cur >= 3) {
            const int ncand = cur - 2;
            if (ncand <= 5) { for (int j = 1; j <= cur - 2; ++j) mask |= 1u << j; }
            else {
                for (int r = 0; r < 5; ++r) {
                    const bool cand = lane >= 1 && lane <= cur - 2 && !((mask >> lane) & 1u);
                    const float v = cand ? pslc : -1.0f;
                    const float mxv = wave_max(v);
                    const unsigned long long bal = __ballot(cand && v == mxv);
                    const int pick = bal ? (int)__builtin_ctzll(bal) : 0;
                    mask |= 1u << pick;
                }
            }
        }
        for (int g = 0; g < 3; ++g) {
            const int hq = kv * 3 + g; const float sl = slope_nsa(hq);
            load_q(p.hb + (size_t)tok * NMAIN + C_NQ + hq * 64, q, lane);
            const float* gl = p.hs + (size_t)tok * HS_W + 4 + hq * 3;
            const float g0 = 1.f / (1.f + __expf(-gl[0])), g1 = 1.f / (1.f + __expf(-gl[1])), g2 = 1.f / (1.f + __expf(-gl[2]));
            float outv = 0.f;
            if (ncv > 0) {
                float mx = score_keys(q, Kc, 64, 0, ncv, sc, lane, [&](int c, float& bias) { bias = -sl * (float)(t - (16 * c + 31)); return true; });
                mx = wave_max(mx);
                const float sum = softmax_lds(sc, ncv, mx, lane);
                const float o = pv_keys(Vc, 64, 0, ncv, sc, lane, 0.f);
                outv += g0 * o / sum;
                lds_wave_sync();
            }
            {
                const bf16_t* Kb = p.hb + (size_t)b * SEQ * NMAIN + C_NKS + kv * 64;
                const bf16_t* Vb = p.hb + (size_t)b * SEQ * NMAIN + C_NVS + kv * 64;
                float mx = NEG_INF; int nb = 0;
                for (int j = 0; j <= cur; ++j) if ((mask >> j) & 1u) {
                    mx = fmaxf(mx, score_keys(q, Kb, NMAIN, j * 64, 64, sc + nb * 64, lane, [&](int s, float& bias) { bias = -sl * (float)(t - s); return s <= t; }));
                    ++nb;
                }
                mx = wave_max(mx);
                const float sum = softmax_lds(sc, nb * 64, mx, lane);
                float o = 0.f; nb = 0;
                for (int j = 0; j <= cur; ++j) if ((mask >> j) & 1u) { o = pv_keys(Vb, NMAIN, j * 64, 64, sc + nb * 64, lane, o); ++nb; }
                outv += g1 * o / sum;
                lds_wave_sync();
            }
            {
                const bf16_t* Kb = p.hb + (size_t)b * SEQ * NMAIN + C_NKW + kv * 64;
                const bf16_t* Vb = p.hb + (size_t)b * SEQ * NMAIN + C_NVW + kv * 64;
                const int s_lo = max(0, t - 511), cnt = t - s_lo + 1;
                float mx = score_keys(q, Kb, NMAIN, s_lo, cnt, sc, lane, [&](int s, float& bias) { bias = -sl * (float)(t - s); return true; });
                mx = wave_max(mx);
                const float sum = softmax_lds(sc, cnt, mx, lane);
                const float o = pv_keys(Vb, NMAIN, s_lo, cnt, sc, lane, 0.f);
                outv += g2 * o / sum;
                lds_wave_sync();
            }
            p.ob[(size_t)tok * DM + 640 + hq * 64 + lane] = f2bf(outv);
        }
    }
}

__device__ void phase_ln1_router(const Params& p, int l, char* lds) {
    int tid = threadIdx.x; asm volatile("" : "+v"(tid));
    const int wid = tid >> 6, lane = tid & 63, fr = lane & 15, fq = lane >> 4;
    float* lg = (float*)lds + wid * 512;
    int* lcnt = (int*)(lds + 8192); int* lbase = lcnt + 32;
    const float* g1 = p.ln1_g + l * DM; const float* b1 = p.ln1_b + l * DM;
    const float* rw = p.rwT + (size_t)l * NE * 1024; const float* rb = p.router_b + l * NE;
    unsigned* gcount = p.ctrl + 64 + l * NE;
    for (int grp = blockIdx.x; grp < NTOK / 64; grp += gridDim.x) {
        const int tok0 = grp * 64 + wid * 16;
        if (tid < 32) lcnt[tid] = 0;
        for (int r = 0; r < 16; ++r) {
            const size_t row = (size_t)(tok0 + r);
            float4 v[4]; float s = 0.f;
#pragma unroll
            for (int j = 0; j < 4; ++j) { v[j] = *(const float4*)(p.tbuf + row * DM + j * 256 + lane * 4); s += (v[j].x + v[j].y) + (v[j].z + v[j].w); }
            const float mean = wave_sum(s) * (1.0f / 1024.0f);
            float qv = 0.f;
#pragma unroll
            for (int j = 0; j < 4; ++j) { v[j].x -= mean; v[j].y -= mean; v[j].z -= mean; v[j].w -= mean; qv += (v[j].x * v[j].x + v[j].y * v[j].y) + (v[j].z * v[j].z + v[j].w * v[j].w); }
            const float rstd = rsqrtf(wave_sum(qv) * (1.0f / 1024.0f) + LN_EPS);
#pragma unroll
            for (int j = 0; j < 4; ++j) {
                const int c = j * 256 + lane * 4;
                const float4 gg = *(const float4*)(g1 + c), bb = *(const float4*)(b1 + c);
                float4 y; y.x = v[j].x * rstd * gg.x + bb.x; y.y = v[j].y * rstd * gg.y + bb.y; y.z = v[j].z * rstd * gg.z + bb.z; y.w = v[j].w * rstd * gg.w + bb.w;
                *(float4*)(p.x1f + row * DM + c) = y;
                u32x2 w; w.x = pack2(y.x, y.y); w.y = pack2(y.z, y.w);
                *(u32x2*)(p.x1b + row * DM + c) = w;
            }
        }
        __syncthreads();
        f32x4 a0 = (f32x4){0.f, 0.f, 0.f, 0.f}, a1 = a0;
        const float* xr = p.x1f + (size_t)(tok0 + fr) * DM + 4 * fq;
        const float* w0 = rw + (size_t)fr * 1024 + 4 * fq; const float* w1 = rw + (size_t)(16 + fr) * 1024 + 4 * fq;
        for (int k0 = 0; k0 < 1024; k0 += 16) {
            const float4 xa = *(const float4*)(xr + k0), wb0 = *(const float4*)(w0 + k0), wb1 = *(const float4*)(w1 + k0);
            a0 = __builtin_amdgcn_mfma_f32_16x16x4f32(xa.x, wb0.x, a0, 0, 0, 0); a1 = __builtin_amdgcn_mfma_f32_16x16x4f32(xa.x, wb1.x, a1, 0, 0, 0);
            a0 = __builtin_amdgcn_mfma_f32_16x16x4f32(xa.y, wb0.y, a0, 0, 0, 0); a1 = __builtin_amdgcn_mfma_f32_16x16x4f32(xa.y, wb1.y, a1, 0, 0, 0);
            a0 = __builtin_amdgcn_mfma_f32_16x16x4f32(xa.z, wb0.z, a0, 0, 0, 0); a1 = __builtin_amdgcn_mfma_f32_16x16x4f32(xa.z, wb1.z, a1, 0, 0, 0);
            a0 = __builtin_amdgcn_mfma_f32_16x16x4f32(xa.w, wb0.w, a0, 0, 0, 0); a1 = __builtin_amdgcn_mfma_f32_16x16x4f32(xa.w, wb1.w, a1, 0, 0, 0);
        }
#pragma unroll
        for (int r = 0; r < 4; ++r) { lg[(fq * 4 + r) * 32 + fr] = a0[r] + rb[fr]; lg[(fq * 4 + r) * 32 + 16 + fr] = a1[r] + rb[16 + fr]; }
        lds_wave_sync();
        int e4[4] = {0, 0, 0, 0}; int rk[4] = {0, 0, 0, 0};
        if (lane < 16) {
            const float* my = lg + lane * 32; unsigned taken = 0u; float tv[4];
#pragma unroll
            for (int k = 0; k < 4; ++k) {
                float best = NEG_INF; int bi = 0;
                for (int e = 0; e < 32; ++e) { const float xv = my[e]; if (!((taken >> e) & 1u) && xv > best) { best = xv; bi = e; } }
                taken |= 1u << bi; e4[k] = bi; tv[k] = best;
            }
            const float e1 = __expf(tv[1] - tv[0]), e2 = __expf(tv[2] - tv[0]), e3 = __expf(tv[3] - tv[0]);
            const float inv = 1.0f / (1.0f + e1 + e2 + e3);
            const size_t row = (size_t)(tok0 + lane);
            *(int4*)(p.top_e + row * 4) = make_int4(e4[0], e4[1], e4[2], e4[3]);
            *(float4*)(p.gw + row * 4) = make_float4(inv, e1 * inv, e2 * inv, e3 * inv);
        }
        __syncthreads();
        if (lane < 16) {
#pragma unroll
            for (int k = 0; k < 4; ++k) rk[k] = atomicAdd(&lcnt[e4[k]], 1);
        }
        __syncthreads();
        if (tid < 32) { const int c = lcnt[tid]; lbase[tid] = c ? (int)__hip_atomic_fetch_add(gcount + tid, (unsigned)c, __ATOMIC_RELAXED, __HIP_MEMORY_SCOPE_AGENT) : 0; }
        __syncthreads();
        if (lane < 16) {
            const int row = tok0 + lane;
#pragma unroll
            for (int k = 0; k < 4; ++k) p.lists[(size_t)e4[k] * LIST_CAP + lbase[e4[k]] + rk[k]] = row * 4 + k;
        }
        __syncthreads();
    }
}

__device__ void phase_ln2(const Params& p, int l, float* xout) {
    int tid = threadIdx.x; asm volatile("" : "+v"(tid));
    const int wid = tid >> 6, lane = tid & 63;
    const float* g2 = p.ln2_g + l * DM; const float* b2 = p.ln2_b + l * DM;
    for (int row = blockIdx.x * 4 + wid; row < NTOK; row += gridDim.x * 4) {
        const float4 gwv = *(const float4*)(p.gw + (size_t)row * 4);
        const float gk[4] = {gwv.x, gwv.y, gwv.z, gwv.w};
        float4 v[4]; float s = 0.f;
#pragma unroll
        for (int j = 0; j < 4; ++j) {
            const int c = j * 256 + lane * 4;
            const float4 xv = *(const float4*)(p.x1f + (size_t)row * DM + c);
            float4 a; a.x = xv.x * ALPHA; a.y = xv.y * ALPHA; a.z = xv.z * ALPHA; a.w = xv.w * ALPHA;
#pragma unroll
            for (int k = 0; k < 4; ++k) {
                const u32x2 w = *(const u32x2*)(p.ybuf + ((size_t)row * 4 + k) * DM + c);
                a.x += gk[k] * __uint_as_float(w.x << 16); a.y += gk[k] * __uint_as_float(w.x & 0xffff0000u);
                a.z += gk[k] * __uint_as_float(w.y << 16); a.w += gk[k] * __uint_as_float(w.y & 0xffff0000u);
            }
            v[j] = a; s += (a.x + a.y) + (a.z + a.w);
        }
        const float mean = wave_sum(s) * (1.0f / 1024.0f);
        float qv = 0.f;
#pragma unroll
        for (int j = 0; j < 4; ++j) { v[j].x -= mean; v[j].y -= mean; v[j].z -= mean; v[j].w -= mean; qv += (v[j].x * v[j].x + v[j].y * v[j].y) + (v[j].z * v[j].z + v[j].w * v[j].w); }
        const float rstd = rsqrtf(wave_sum(qv) * (1.0f / 1024.0f) + LN_EPS);
#pragma unroll
        for (int j = 0; j < 4; ++j) {
            const int c = j * 256 + lane * 4;
            const float4 gg = *(const float4*)(g2 + c), bb = *(const float4*)(b2 + c);
            float4 y; y.x = v[j].x * rstd * gg.x + bb.x; y.y = v[j].y * rstd * gg.y + bb.y; y.z = v[j].z * rstd * gg.z + bb.z; y.w = v[j].w * rstd * gg.w + bb.w;
            *(float4*)(xout + (size_t)row * DM + c) = y;
            u32x2 w; w.x = pack2(y.x, y.y); w.y = pack2(y.z, y.w);
            *(u32x2*)(p.xb + (size_t)row * DM + c) = w;
        }
    }
}

constexpr int NPHASE = 1 + 8 * NL;
__global__ void __launch_bounds__(256, 2) fwd_kernel(Params p, int ph_lo, int ph_hi) {
    extern __shared__ __attribute__((aligned(16))) char lds[];
    cg::grid_group grid = cg::this_grid();
    for (int ph = ph_lo; ph < ph_hi; ++ph) {
        if (ph > ph_lo) grid.sync();
#ifndef SKIP_P0
        if (ph == 0) { phase0(p, lds); continue; }
#else
        if (ph == 0) continue;
#endif
        const int l = (ph - 1) >> 3, s = (ph - 1) & 7;
        const float* xin = l == 0 ? p.x : p.xf;
        float* xout = l == NL - 1 ? p.out : p.xf;
        switch (s) {
#ifndef SKIP_S0
            case 0: phase_inproj(p, l, lds); break;
#endif
#ifndef SKIP_S1
            case 1: phase_prep(p, l, lds); break;
#endif
#ifndef SKIP_S2
            case 2: phase_attn_naive(p, l, lds); break;
#endif
#ifndef SKIP_S3
            case 3: phase_outproj(p, l, xin, lds); break;
#endif
#ifndef SKIP_S4
            case 4: phase_ln1_router(p, l, lds); break;
#endif
#ifndef SKIP_S5
            case 5: phase_gateup(p, l, lds); break;
#endif
#ifndef SKIP_S6
            case 6: phase_down(p, l, lds); break;
#endif
#ifndef SKIP_S7
            default: phase_ln2(p, l, xout); break;
#else
            default: break;
#endif
        }
    }
}

static inline size_t align_up(size_t v, size_t a) { return (v + a - 1) / a * a; }

extern "C" void kernel_launch(void* const* d_in, const int* in_sizes, int n_in, void* d_out, int out_size, void* d_ws, size_t ws_size, hipStream_t stream) {
    Params p{};
    p.x = (const float*)d_in[0]; p.w_in = (const float*)d_in[1]; p.b_in = (const float*)d_in[2]; p.sinks = (const float*)d_in[3];
    p.cmp_pe = (const float*)d_in[4]; p.cmp_w1 = (const float*)d_in[5]; p.cmp_w2 = (const float*)d_in[6]; p.w_out = (const float*)d_in[7];
    p.ln1_g = (const float*)d_in[8]; p.ln1_b = (const float*)d_in[9]; p.router_w = (const float*)d_in[10]; p.router_b = (const float*)d_in[11];
    p.w_gu = (const float*)d_in[12]; p.b_gu = (const float*)d_in[13]; p.w_dn = (const float*)d_in[14]; p.b_dn = (const float*)d_in[15];
    p.ln2_g = (const float*)d_in[16]; p.ln2_b = (const float*)d_in[17];
    p.out = (float*)d_out;
    char* w = (char*)d_ws; size_t off = 0;
    auto take = [&](size_t bytes) { char* r = w + off; off = align_up(off + bytes, 256); return r; };
    p.ctrl = (unsigned*)take(65536);
    p.WinT = (bf16_t*)take((size_t)NL * NPAD * 1024 * 2);
    p.WoT = (bf16_t*)take((size_t)NL * 1024 * 1024 * 2);
    p.W1T = (bf16_t*)take((size_t)NL * 2 * 64 * 2048 * 2);
    p.W2T = (bf16_t*)take((size_t)NL * 2 * 64 * 64 * 2);
    p.WguT = (bf16_t*)take((size_t)NL * NE * 2048 * 1024 * 2);
    p.WdnT = (bf16_t*)take((size_t)NL * NE * 1024 * 1024 * 2);
    p.rwT = (float*)take((size_t)NL * NE * 1024 * 4);
    p.binp = (float*)take((size_t)NL * NPAD * 4);
    p.bgup = (float*)take((size_t)NL * NE * 2048 * 4);
    p.b1c = (float*)take(4 * 64 * 4);
    p.xf = (float*)take((size_t)NTOK * DM * 4);
    p.xb = (bf16_t*)take((size_t)NTOK * DM * 2);
    p.hb = (bf16_t*)take((size_t)NTOK * NMAIN * 2);
    p.hs = (float*)take((size_t)NTOK * HS_W * 4);
    p.vT = (bf16_t*)take((size_t)NB * NVH * 64 * SEQ * 2);
    p.cF = (float*)take((size_t)NB * 4 * SEQ * 4);
    p.kc = (bf16_t*)take((size_t)NB * 2 * 128 * 64 * 2);
    p.vc = (bf16_t*)take((size_t)NB * 2 * 128 * 64 * 2);
    p.vcT = (bf16_t*)take((size_t)NB * 2 * 128 * 64 * 2);
    p.ob = (bf16_t*)take((size_t)NTOK * DM * 2);
    p.tbuf = (float*)take((size_t)NTOK * DM * 4);
    p.x1f = (float*)take((size_t)NTOK * DM * 4);
    p.x1b = (bf16_t*)take((size_t)NTOK * DM * 2);
    p.top_e = (int*)take((size_t)NTOK * 4 * 4);
    p.gw = (float*)take((size_t)NTOK * 4 * 4);
    p.lists = (int*)take((size_t)NE * LIST_CAP * 4);
    p.act = (bf16_t*)take((size_t)MAXSLOT * DFF * 2);
    p.ybuf = (bf16_t*)take((size_t)NTOK * 4 * DM * 2);
    if (off > ws_size) { fprintf(stderr, "workspace too small: need %zu have %zu\n", off, ws_size); return; }

    static int grid_blocks = 0;
    if (!grid_blocks) {
        int dev = 0, cus = 0, per_cu = 0;
        hipGetDevice(&dev);
        hipDeviceGetAttribute(&cus, hipDeviceAttributeMultiprocessorCount, dev);
        hipFuncSetAttribute((const void*)fwd_kernel, hipFuncAttributeMaxDynamicSharedMemorySize, LDS_BYTES);
        hipOccupancyMaxActiveBlocksPerMultiprocessor(&per_cu, fwd_kernel, 256, LDS_BYTES);
        if (per_cu > 2) per_cu = 2;
        if (per_cu < 1) per_cu = 1;
        grid_blocks = cus * per_cu;
    }
    hipMemsetAsync(p.ctrl, 0, 65536, stream);
#if ONE_LAUNCH
    int lo = 0, hi = NPHASE;
    void* args[] = {&p, &lo, &hi};
    hipError_t e = hipLaunchCooperativeKernel((const void*)fwd_kernel, dim3(grid_blocks), dim3(256), args, LDS_BYTES, stream);
    if (e != hipSuccess) fprintf(stderr, "cooperative launch failed: %s (grid %d)\n", hipGetErrorString(e), grid_blocks);
#else
    for (int ph = 0; ph < NPHASE; ++ph) fwd_kernel<<<grid_blocks, 256, LDS_BYTES, stream>>>(p, ph, ph + 1);
#endif
}
```

```cpp
#include <hip/hip_runtime.h>
#include <hip/hip_cooperative_groups.h>
#include <cstdio>
#include <cstdint>
namespace cg = cooperative_groups;

#ifndef ONE_LAUNCH
#define ONE_LAUNCH 1
#endif

typedef unsigned short bf16_t;
typedef short bf16x8 __attribute__((ext_vector_type(8)));
typedef float f32x4 __attribute__((ext_vector_type(4)));
typedef unsigned u32x4 __attribute__((ext_vector_type(4)));
typedef unsigned u32x2 __attribute__((ext_vector_type(2)));

constexpr int DM = 1024, NB = 16, SEQ = 2048, NTOK = NB * SEQ, NL = 2;
constexpr int NCOL = 2582, NMAIN = 2560, NPAD = 2688, NE = 32, DFF = 1024;
constexpr int C_FQ = 0, C_FK = 256, C_FV = 512, C_SQ = 768, C_SK = 1152, C_SV = 1280, C_NQ = 1408,
              C_NKC = 1792, C_NVC = 1920, C_NKS = 2048, C_NVS = 2176, C_NKW = 2304, C_NVW = 2432;
constexpr int HS_W = 32;
constexpr int NVH = 10;
constexpr int LIST_CAP = NTOK;
constexpr int MAXSLOT = NTOK * 4 + NE * 128;
constexpr float ALPHA = 1.41421356237f, LN_EPS = 1e-5f, QSCALE = 0.125f;
constexpr int LDS_BYTES = 65536;

struct Params {
    const float *x, *w_in, *b_in, *sinks, *cmp_pe, *cmp_w1, *cmp_w2, *w_out, *ln1_g, *ln1_b, *router_w, *router_b,
                *w_gu, *b_gu, *w_dn, *b_dn, *ln2_g, *ln2_b;
    float* out;
    unsigned* ctrl;
    bf16_t *WinT, *WoT, *W1T, *W2T, *WguT, *WdnT;
    float *rwT, *binp, *bgup, *b1c;
    float* xf;
    bf16_t* xb;
    bf16_t* hb;
    float* hs;
    bf16_t* vT;
    float* cF;
    bf16_t *kc, *vc, *vcT;
    bf16_t* ob;
    float* tbuf;
    float* x1f; bf16_t* x1b;
    int* top_e; float* gw;
    int* lists;
    bf16_t* act;
    bf16_t* ybuf;
};

__device__ __forceinline__ float bf2f(bf16_t h) { return __uint_as_float(((unsigned)h) << 16); }
__device__ __forceinline__ bf16_t f2bf(float f) { unsigned u = __float_as_uint(f); u += 0x7fffu + ((u >> 16) & 1u); return (bf16_t)(u >> 16); }
__device__ __forceinline__ unsigned pack2(float lo, float hi) { return (unsigned)f2bf(lo) | ((unsigned)f2bf(hi) << 16); }
__device__ __forceinline__ float wave_sum(float v) {
#pragma unroll
    for (int o = 32; o > 0; o >>= 1) v += __shfl_xor(v, o);
    return v;
}
__device__ __forceinline__ float wave_max(float v) {
#pragma unroll
    for (int o = 32; o > 0; o >>= 1) v = fmaxf(v, __shfl_xor(v, o));
    return v;
}
__device__ __forceinline__ void lds_wave_sync() { asm volatile("s_waitcnt lgkmcnt(0)" ::: "memory"); __builtin_amdgcn_wave_barrier(); }
__device__ __forceinline__ float slope_swa(int hq) { return exp2f(-8.0f * (float)(2 * hq + 1) / 12.0f); }
__device__ __forceinline__ float slope_nsa(int hq) { return exp2f(-8.0f * (float)(2 * hq + 2) / 12.0f); }

template <int PERM>
__device__ __forceinline__ int perm_row(int n) {
    if (PERM == 1) { if (n < 768) return n; if (n < 772) return 2560 + (n - 768); if (n < 2564) return n - 4; return n; }
    if (PERM == 2) { const int f = n >> 1, s = n & 1; return (f >> 5) * 64 + s * 32 + (f & 31); }
    return n;
}
template <int PERM>
__device__ __forceinline__ void conv_tile(const float* __restrict__ src, int K, int N, int kt, int nt, bf16_t* __restrict__ dst, float* lds) {
    int tid = threadIdx.x; asm volatile("" : "+v"(tid));
#pragma unroll
    for (int i = 0; i < 4; ++i) {
        const int kk = (tid >> 4) + 16 * i, nn = (tid & 15) * 4;
        const int k = kt * 64 + kk, n = nt * 64 + nn;
        const float* p = src + (size_t)k * N + n;
        float v0 = 0.f, v1 = 0.f, v2 = 0.f, v3 = 0.f;
        if (n + 3 < N) { v0 = p[0]; v1 = p[1]; v2 = p[2]; v3 = p[3]; }
        else { if (n < N) v0 = p[0]; if (n + 1 < N) v1 = p[1]; if (n + 2 < N) v2 = p[2]; }
        float* l = lds + kk * 65 + nn; l[0] = v0; l[1] = v1; l[2] = v2; l[3] = v3;
    }
    __syncthreads();
#pragma unroll
    for (int i = 0; i < 2; ++i) {
        const int idx = tid + 256 * i, nn = idx >> 3, kc = idx & 7, n = nt * 64 + nn;
        if (n < N) {
            const float* l = lds + (kc * 8) * 65 + nn;
            u32x4 w; w.x = pack2(l[0], l[65]); w.y = pack2(l[130], l[195]); w.z = pack2(l[260], l[325]); w.w = pack2(l[390], l[455]);
            *(u32x4*)(dst + (size_t)perm_row<PERM>(n) * K + kt * 64 + kc * 8) = w;
        }
    }
    __syncthreads();
}

__device__ void phase0(const Params& p, char* ldsc) {
    float* lds = (float*)ldsc;
    int tid = threadIdx.x; asm volatile("" : "+v"(tid));
    const int G = gridDim.x, bid = blockIdx.x;
    const size_t gtid = (size_t)bid * 256 + tid, gthreads = (size_t)G * 256;
    for (size_t i = gtid; i < (size_t)NL * NPAD; i += gthreads) {
        const int l = (int)(i / NPAD), r = (int)(i % NPAD);
        float v = 0.f;
        if (r < 2560) { const int n = r < 768 ? r : r + 4; v = p.b_in[l * NCOL + n]; }
        else if (r < 2564) v = p.b_in[l * NCOL + 768 + (r - 2560)];
        else if (r < 2582) v = p.b_in[l * NCOL + r];
        p.binp[i] = v;
    }
    for (size_t i = gtid; i < (size_t)NL * NE * 2048; i += gthreads) {
        const int r = (int)(i % 2048); const size_t le = i / 2048;
        const int q = r >> 6, s = (r >> 5) & 1, f = q * 32 + (r & 31);
        p.bgup[i] = p.b_gu[le * 2048 + 2 * f + s];
    }
    for (size_t i = gtid; i < (size_t)NL * NE * 1024; i += gthreads) {
        const int k = (int)(i % 1024), e = (int)((i / 1024) % NE), l = (int)(i / (1024 * NE));
        p.rwT[i] = p.router_w[((size_t)l * 1024 + k) * NE + e];
    }
    for (size_t i = gtid; i < (size_t)NL * (NPAD - NCOL) * 1024; i += gthreads) {
        const int l = (int)(i / ((NPAD - NCOL) * 1024)); const size_t r = i % ((size_t)(NPAD - NCOL) * 1024);
        p.WinT[(size_t)l * NPAD * 1024 + (size_t)NCOL * 1024 + r] = 0;
    }
    for (size_t i = gtid; i < (size_t)NTOK * DM / 4; i += gthreads) {
        const float4 v = ((const float4*)p.x)[i];
        u32x2 w; w.x = pack2(v.x, v.y); w.y = pack2(v.z, v.w);
        ((u32x2*)p.xb)[i] = w;
    }
    if (bid < 4) {
        const int j = tid & 63, part = tid >> 6;
        const float* pe = p.cmp_pe + (size_t)bid * 2048; const float* w1 = p.cmp_w1 + (size_t)bid * 2048 * 64;
        float s = 0.f;
        for (int kk = part * 512; kk < part * 512 + 512; ++kk) s += pe[kk] * w1[(size_t)kk * 64 + j];
        lds[tid] = s; __syncthreads();
        if (tid < 64) p.b1c[bid * 64 + tid] = lds[tid] + lds[tid + 64] + lds[tid + 128] + lds[tid + 192];
        __syncthreads();
    }
    constexpr int T_WIN = NL * 16 * 41, T_WO = NL * 16 * 16, T_W1 = NL * 2 * 32, T_W2 = NL * 2, T_GU = NL * NE * 16 * 32, T_DN = NL * NE * 16 * 16;
    constexpr int TOT = T_WIN + T_WO + T_W1 + T_W2 + T_GU + T_DN;
    for (int t = bid; t < TOT; t += G) {
        int u = t;
        if (u < T_GU) { const int m = u / 512, r = u % 512; conv_tile<2>(p.w_gu + (size_t)m * 1024 * 2048, 1024, 2048, r / 32, r % 32, p.WguT + (size_t)m * 2048 * 1024, lds); continue; }
        u -= T_GU;
        if (u < T_DN) { const int m = u / 256, r = u % 256; conv_tile<0>(p.w_dn + (size_t)m * 1024 * 1024, 1024, 1024, r / 16, r % 16, p.WdnT + (size_t)m * 1024 * 1024, lds); continue; }
        u -= T_DN;
        if (u < T_WIN) { const int m = u / 656, r = u % 656; conv_tile<1>(p.w_in + (size_t)m * 1024 * NCOL, 1024, NCOL, r / 41, r % 41, p.WinT + (size_t)m * NPAD * 1024, lds); continue; }
        u -= T_WIN;
        if (u < T_WO) { const int m = u / 256, r = u % 256; conv_tile<0>(p.w_out + (size_t)m * 1024 * 1024, 1024, 1024, r / 16, r % 16, p.WoT + (size_t)m * 1024 * 1024, lds); continue; }
        u -= T_WO;
        if (u < T_W1) { const int m = u / 32, r = u % 32; conv_tile<0>(p.cmp_w1 + (size_t)m * 2048 * 64, 2048, 64, r, 0, p.W1T + (size_t)m * 64 * 2048, lds); continue; }
        u -= T_W1;
        { const int m = u; conv_tile<0>(p.cmp_w2 + (size_t)m * 64 * 64, 64, 64, 0, 0, p.W2T + (size_t)m * 64 * 64, lds); }
    }
}

template <class Epi>
__device__ __forceinline__ void gemm128(const bf16_t* __restrict__ A, size_t lda, const int* rowsrc, int m0,
                                        const bf16_t* __restrict__ Bt, int K, char* lds, const Epi& epi) {
    int tid = threadIdx.x; asm volatile("" : "+v"(tid));
    const int wid = tid >> 6, lane = tid & 63, wr = wid >> 1, wc = wid & 1, fr = lane & 15, fq = lane >> 4;
    char* SA = lds; char* SB = lds + 8192;
    const bf16_t* ap[2]; const bf16_t* bp[2];
#pragma unroll
    for (int i = 0; i < 2; ++i) {
        const int b = tid * 16 + i * 4096, r = b >> 6, c = (b & 63) >> 1;
        const int arow = rowsrc ? rowsrc[r] : (m0 + r);
        ap[i] = A + (size_t)arow * lda + c; bp[i] = Bt + (size_t)r * K + c;
    }
    f32x4 acc[4][4];
#pragma unroll
    for (int m = 0; m < 4; ++m)
#pragma unroll
        for (int n = 0; n < 4; ++n) acc[m][n] = (f32x4){0.f, 0.f, 0.f, 0.f};
    for (int kt = 0; kt < K / 32; ++kt) {
#pragma unroll
        for (int i = 0; i < 2; ++i) {
            const int b = tid * 16 + i * 4096;
            __builtin_amdgcn_global_load_lds((const unsigned*)(ap[i] + kt * 32), (__attribute__((address_space(3))) unsigned*)(SA + b), 16, 0, 0);
            __builtin_amdgcn_global_load_lds((const unsigned*)(bp[i] + kt * 32), (__attribute__((address_space(3))) unsigned*)(SB + b), 16, 0, 0);
        }
        asm volatile("s_waitcnt vmcnt(0)" ::: "memory");
        __syncthreads();
        bf16x8 At[4], Bl[4];
#pragma unroll
        for (int m = 0; m < 4; ++m) At[m] = *(const bf16x8*)(SA + (wr * 64 + m * 16 + fr) * 64 + fq * 16);
#pragma unroll
        for (int n = 0; n < 4; ++n) Bl[n] = *(const bf16x8*)(SB + (wc * 64 + n * 16 + fr) * 64 + fq * 16);
#pragma unroll
        for (int m = 0; m < 4; ++m)
#pragma unroll
            for (int n = 0; n < 4; ++n) acc[m][n] = __builtin_amdgcn_mfma_f32_16x16x32_bf16(Bl[n], At[m], acc[m][n], 0, 0, 0);
        __syncthreads();
    }
    epi(acc, wr * 64 + fr, wc * 64 + 4 * fq);
}

struct EpiInProj {
    const Params* p; int l, m0, n0;
    __device__ __forceinline__ void operator()(const f32x4 (&acc)[4][4], int r0, int c0) const {
        const float* bias = p->binp + l * NPAD + n0;
        if (n0 == NMAIN) {
#pragma unroll
            for (int n = 0; n < 2; ++n) {
                const int c = c0 + n * 16;
                if (c < 22 + 3) {
#pragma unroll
                    for (int m = 0; m < 4; ++m) {
                        const int row = m0 + r0 + m * 16;
#pragma unroll
                        for (int j = 0; j < 4; ++j) if (c + j < 22) p->hs[(size_t)row * HS_W + c + j] = acc[m][n][j] + bias[c + j];
                    }
                }
            }
            return;
        }
        int vh = -1;
        if (n0 == 512) vh = 0; else if (n0 == 640) vh = 2; else if (n0 == 1280) vh = 4; else if (n0 == 2176) vh = 6; else if (n0 == 2432) vh = 8;
#pragma unroll
        for (int n = 0; n < 4; ++n) {
            const int c = c0 + n * 16;
            const f32x4 bv = *(const f32x4*)(bias + c);
#pragma unroll
            for (int m = 0; m < 4; ++m) {
                const int row = m0 + r0 + m * 16;
                const f32x4 v = acc[m][n] + bv;
                u32x2 w; w.x = pack2(v[0], v[1]); w.y = pack2(v[2], v[3]);
                *(u32x2*)(p->hb + (size_t)row * NMAIN + n0 + c) = w;
                if (vh >= 0) {
                    const int b = row >> 11, s = row & 2047, hh = vh + (c >> 6), d = c & 63;
                    bf16_t* vt = p->vT + (((size_t)b * NVH + hh) * 64 + d) * SEQ + s;
                    vt[0] = (bf16_t)(w.x & 0xffff); vt[SEQ] = (bf16_t)(w.x >> 16); vt[2 * SEQ] = (bf16_t)(w.y & 0xffff); vt[3 * SEQ] = (bf16_t)(w.y >> 16);
                }
            }
        }
    }
};
struct EpiOutProj {
    const float* xin; float* t; int m0, n0;
    __device__ __forceinline__ void operator()(const f32x4 (&acc)[4][4], int r0, int c0) const {
#pragma unroll
        for (int m = 0; m < 4; ++m)
#pragma unroll
            for (int n = 0; n < 4; ++n) {
                const size_t off = (size_t)(m0 + r0 + m * 16) * DM + n0 + c0 + n * 16;
                const f32x4 xv = *(const f32x4*)(xin + off);
                *(f32x4*)(t + off) = xv * ALPHA + acc[m][n];
            }
    }
};
struct EpiGateUp {
    bf16_t* act; const float* bias; int slot0, n0;
    __device__ __forceinline__ void operator()(const f32x4 (&acc)[4][4], int r0, int c0) const {
        const int wcb = c0 & 64, q4 = c0 & 63;
        const int fbase = ((n0 + wcb) >> 6) * 32;
#pragma unroll
        for (int n = 0; n < 2; ++n) {
            const f32x4 bg = *(const f32x4*)(bias + n0 + wcb + n * 16 + q4), bu = *(const f32x4*)(bias + n0 + wcb + 32 + n * 16 + q4);
#pragma unroll
            for (int m = 0; m < 4; ++m) {
                const f32x4 g4 = acc[m][n] + bg, u4 = acc[m][n + 2] + bu;
                float o[4];
#pragma unroll
                for (int j = 0; j < 4; ++j) {
                    const float g = fminf(g4[j], 7.0f), u = fminf(fmaxf(u4[j], -7.0f), 7.0f);
                    const float glu = g / (1.0f + __expf(-1.702f * g));
                    o[j] = (u + 1.0f) * glu;
                }
                u32x2 w; w.x = pack2(o[0], o[1]); w.y = pack2(o[2], o[3]);
                *(u32x2*)(act + (size_t)(slot0 + r0 + m * 16) * DFF + fbase + n * 16 + q4) = w;
            }
        }
    }
};
struct EpiDown {
    bf16_t* ybuf; const float* bias; const int* lst; int cnt, rb, n0;
    __device__ __forceinline__ void operator()(const f32x4 (&acc)[4][4], int r0, int c0) const {
#pragma unroll
        for (int m = 0; m < 4; ++m) {
            const int lr = rb * 128 + r0 + m * 16;
            if (lr < cnt) {
                const int a = lst[lr];
#pragma unroll
                for (int n = 0; n < 4; ++n) {
                    const int c = n0 + c0 + n * 16;
                    const f32x4 v = acc[m][n] + *(const f32x4*)(bias + c);
                    u32x2 w; w.x = pack2(v[0], v[1]); w.y = pack2(v[2], v[3]);
                    *(u32x2*)(ybuf + (size_t)a * DM + c) = w;
                }
            }
        }
    }
};

__device__ void phase_inproj(const Params& p, int l, char* lds) {
    constexpr int NT = NPAD / 128, MT = NTOK / 128;
    const bf16_t* W = p.WinT + (size_t)l * NPAD * 1024;
    for (int t = blockIdx.x; t < MT * NT; t += gridDim.x) {
        const int mt = t / NT, nt = t % NT;
        EpiInProj e{&p, l, mt * 128, nt * 128};
        gemm128(p.xb, DM, nullptr, mt * 128, W + (size_t)nt * 128 * 1024, 1024, lds, e);
    }
}
__device__ void phase_outproj(const Params& p, int l, const float* xin, char* lds) {
    constexpr int NT = 8, MT = NTOK / 128;
    const bf16_t* W = p.WoT + (size_t)l * 1024 * 1024;
    for (int t = blockIdx.x; t < MT * NT; t += gridDim.x) {
        const int mt = t / NT, nt = t % NT;
        EpiOutProj e{xin, p.tbuf, mt * 128, nt * 128};
        gemm128(p.ob, DM, nullptr, mt * 128, W + (size_t)nt * 128 * 1024, 1024, lds, e);
    }
}
__device__ __forceinline__ void build_tiles(const Params& p, int l, int* ptile, int* ecnt) {
    if (threadIdx.x < NE) ecnt[threadIdx.x] = (int)__hip_atomic_load(p.ctrl + 64 + l * NE + threadIdx.x, __ATOMIC_RELAXED, __HIP_MEMORY_SCOPE_AGENT);
    __syncthreads();
    if (threadIdx.x == 0) { int s = 0; for (int e = 0; e < NE; ++e) { ptile[e] = s; s += (ecnt[e] + 127) >> 7; } ptile[NE] = s; }
    __syncthreads();
}
__device__ void phase_gateup(const Params& p, int l, char* lds) {
    int* ptile = (int*)(lds + 16384); int* ecnt = ptile + 40; int* rows = ecnt + 40;
    build_tiles(p, l, ptile, ecnt);
    const int ntile = ptile[NE];
    for (int t = blockIdx.x; t < ntile * 16; t += gridDim.x) {
        const int rbt = t >> 4, nt = t & 15;
        int e = 0; while (ptile[e + 1] <= rbt) ++e;
        const int rb = rbt - ptile[e], cnt = ecnt[e];
        const int* lst = p.lists + (size_t)e * LIST_CAP;
        if (threadIdx.x < 128) { const int lr = rb * 128 + threadIdx.x; rows[threadIdx.x] = lr < cnt ? (lst[lr] >> 2) : 0; }
        __syncthreads();
        EpiGateUp ep{p.act, p.bgup + ((size_t)l * NE + e) * 2048, rbt * 128, nt * 128};
        gemm128(p.x1b, DM, rows, 0, p.WguT + (((size_t)l * NE + e) * 2048 + (size_t)nt * 128) * 1024, 1024, lds, ep);
    }
}
__device__ void phase_down(const Params& p, int l, char* lds) {
    int* ptile = (int*)(lds + 16384); int* ecnt = ptile + 40;
    build_tiles(p, l, ptile, ecnt);
    const int ntile = ptile[NE];
    for (int t = blockIdx.x; t < ntile * 8; t += gridDim.x) {
        const int rbt = t >> 3, nt = t & 7;
        int e = 0; while (ptile[e + 1] <= rbt) ++e;
        const int rb = rbt - ptile[e];
        EpiDown ep{p.ybuf, p.b_dn + ((size_t)l * NE + e) * 1024, p.lists + (size_t)e * LIST_CAP, ecnt[e], rb, nt * 128};
        gemm128(p.act, DFF, nullptr, rbt * 128, p.WdnT + (((size_t)l * NE + e) * 1024 + (size_t)nt * 128) * 1024, 1024, lds, ep);
    }
}

__device__ __forceinline__ float gelu_tanh(float x) {
    const float u = 0.7978845608028654f * (x + 0.044715f * x * x * x);
    const float e = __expf(-2.0f * fabsf(u)); const float th = (1.0f - e) / (1.0f + e);
    return 0.5f * x * (1.0f + (u < 0.f ? -th : th));
}
__device__ void phase_prep(const Params& p, int l, char* lds) {
    int tid = threadIdx.x; asm volatile("" : "+v"(tid));
    const int wid = tid >> 6, lane = tid & 63, fr = lane & 15, fq = lane >> 4;
    const int gw = blockIdx.x * 4 + wid, nw = gridDim.x * 4;
    for (int u = gw; u < NB * 4; u += nw) {
        const int b = u >> 2, h = u & 3;
        const float* src = p.hs + (size_t)b * SEQ * HS_W + h;
        float* dst = p.cF + (size_t)u * SEQ;
        float tot = 0.f;
        for (int i = 0; i < 32; ++i) { const float f = src[(size_t)(lane * 32 + i) * HS_W]; tot += fminf(f, 0.f) - log1pf(__expf(-fabsf(f))); }
        float inc = tot;
#pragma unroll
        for (int o = 1; o < 64; o <<= 1) { const float v = __shfl_up(inc, o); if (lane >= o) inc += v; }
        float run = inc - tot;
        for (int i = 0; i < 32; ++i) { const float f = src[(size_t)(lane * 32 + i) * HS_W]; run += fminf(f, 0.f) - log1pf(__expf(-fabsf(f))); dst[lane * 32 + i] = run; }
    }
    bf16_t* h1 = (bf16_t*)(lds + wid * 2048);
    for (int u = gw; u < NB * 2 * 2 * 8; u += nw) {
        const int ct = u & 7, which = (u >> 3) & 1, kvh = (u >> 4) & 1, b = u >> 5;
        const int colo = (which ? C_NVC : C_NKC) + kvh * 64;
        const int c_lane = ct * 16 + fr;
        const int tokbase = min(c_lane, 126) * 16;
        const bf16_t* arow = p.hb + ((size_t)b * SEQ + tokbase) * NMAIN + colo + fq * 8;
        const bf16_t* w1 = p.W1T + ((size_t)(l * 2 + which) * 64 + fr) * 2048 + fq * 8;
        f32x4 acc[4];
#pragma unroll
        for (int n = 0; n < 4; ++n) acc[n] = (f32x4){0.f, 0.f, 0.f, 0.f};
        for (int ks = 0; ks < 64; ++ks) {
            const bf16x8 a = *(const bf16x8*)(arow + (size_t)(ks >> 1) * NMAIN + (ks & 1) * 32);
#pragma unroll
            for (int n = 0; n < 4; ++n) {
                const bf16x8 bb = *(const bf16x8*)(w1 + (size_t)n * 16 * 2048 + ks * 32);
                acc[n] = __builtin_amdgcn_mfma_f32_16x16x32_bf16(a, bb, acc[n], 0, 0, 0);
            }
        }
        const float* b1 = p.b1c + (l * 2 + which) * 64;
#pragma unroll
        for (int n = 0; n < 4; ++n)
#pragma unroll
            for (int r = 0; r < 4; ++r) h1[(fq * 4 + r) * 64 + n * 16 + fr] = f2bf(gelu_tanh(acc[n][r] + b1[n * 16 + fr]));
        lds_wave_sync();
        const bf16_t* w2 = p.W2T + ((size_t)(l * 2 + which) * 64 + fr) * 64 + fq * 8;
        f32x4 o2[4];
#pragma unroll
        for (int n = 0; n < 4; ++n) o2[n] = (f32x4){0.f, 0.f, 0.f, 0.f};
#pragma unroll
        for (int ks = 0; ks < 2; ++ks) {
            const bf16x8 a = *(const bf16x8*)(h1 + fr * 64 + ks * 32 + fq * 8);
#pragma unroll
            for (int n = 0; n < 4; ++n) {
                const bf16x8 bb = *(const bf16x8*)(w2 + (size_t)n * 16 * 64 + ks * 32);
                o2[n] = __builtin_amdgcn_mfma_f32_16x16x32_bf16(a, bb, o2[n], 0, 0, 0);
            }
        }
        lds_wave_sync();
        const size_t base = ((size_t)b * 2 + kvh) * 128 * 64;
#pragma unroll
        for (int n = 0; n < 4; ++n)
#pragma unroll
            for (int r = 0; r < 4; ++r) {
                const int c = ct * 16 + fq * 4 + r, j2 = n * 16 + fr;
                const bf16_t v = c < 127 ? f2bf(o2[n][r]) : (bf16_t)0;
                if (which == 0) p.kc[base + (size_t)c * 64 + j2] = v;
                else { p.vc[base + (size_t)c * 64 + j2] = v; p.vcT[base + (size_t)j2 * 128 + c] = v; }
            }
    }
}

__device__ __forceinline__ void load_q(const bf16_t* qp, float* q, int lane) {
    q[lane] = bf2f(qp[lane]) * QSCALE;
    lds_wave_sync();
}
__device__ __forceinline__ float dot_q(const bf16_t* kp, const float* q) {
    float s = 0.f;
#pragma unroll
    for (int i = 0; i < 8; ++i) {
        const u32x4 w = *(const u32x4*)(kp + i * 8);
        const float4 qa = *(const float4*)(q + i * 8), qb = *(const float4*)(q + i * 8 + 4);
        s += qa.x * __uint_as_float(w.x << 16) + qa.y * __uint_as_float(w.x & 0xffff0000u)
           + qa.z * __uint_as_float(w.y << 16) + qa.w * __uint_as_float(w.y & 0xffff0000u)
           + qb.x * __uint_as_float(w.z << 16) + qb.y * __uint_as_float(w.z & 0xffff0000u)
           + qb.z * __uint_as_float(w.w << 16) + qb.w * __uint_as_float(w.w & 0xffff0000u);
    }
    return s;
}
constexpr float NEG_INF = -__builtin_huge_valf();
template <class BF>
__device__ __forceinline__ float score_keys(const float* q, const bf16_t* Kb, size_t ld, int s_lo, int cnt, float* sc, int lane, const BF& bf) {
    float mx = NEG_INF;
    for (int i = lane; i < cnt; i += 64) {
        const int s = s_lo + i; float bias; const bool ok = bf(s, bias);
        float v = NEG_INF;
        if (ok) v = dot_q(Kb + (size_t)s * ld, q) + bias;
        sc[i] = v; mx = fmaxf(mx, v);
    }
    return mx;
}
__device__ __forceinline__ float softmax_lds(float* sc, int n, float mx, int lane) {
    float sum = 0.f;
    for (int i = lane; i < n; i += 64) { const float v = sc[i]; const float e = (v == NEG_INF) ? 0.f : __expf(v - mx); sc[i] = e; sum += e; }
    sum = wave_sum(sum);
    lds_wave_sync();
    return sum;
}
__device__ __forceinline__ float pv_keys(const bf16_t* Vb, size_t ld, int s_lo, int cnt, const float* sc, int lane, float o) {
    for (int i = 0; i < cnt; ++i) { const float pr = sc[i]; if (pr != 0.f) o += pr * bf2f(Vb[(size_t)(s_lo + i) * ld + lane]); }
    return o;
}

__device__ void phase_attn_naive(const Params& p, int l, char* lds) {
    int tid = threadIdx.x; asm volatile("" : "+v"(tid));
    const int wid = tid >> 6, lane = tid & 63;
    float* sc = (float*)(lds + wid * 9216);
    float* q = sc + 2176;
    const int gwv = blockIdx.x * 4 + wid, nw = gridDim.x * 4;
    for (int u = gwv; u < NTOK * 4; u += nw) {
        const int h = u & 3, tok = u >> 2, b = tok >> 11, t = tok & 2047;
        load_q(p.hb + (size_t)tok * NMAIN + C_FQ + h * 64, q, lane);
        const float* c = p.cF + ((size_t)b * 4 + h) * SEQ; const float ct = c[t];
        const bf16_t* Kb = p.hb + (size_t)b * SEQ * NMAIN + C_FK + h * 64;
        const bf16_t* Vb = p.hb + (size_t)b * SEQ * NMAIN + C_FV + h * 64;
        float mx = score_keys(q, Kb, NMAIN, 0, t + 1, sc, lane, [&](int s, float& bias) { bias = ct - c[s]; return true; });
        mx = wave_max(mx);
        const float sum = softmax_lds(sc, t + 1, mx, lane);
        const float o = pv_keys(Vb, NMAIN, 0, t + 1, sc, lane, 0.f);
        p.ob[(size_t)tok * DM + h * 64 + lane] = f2bf(o / sum);
        lds_wave_sync();
    }
    for (int u = gwv; u < NTOK * 6; u += nw) {
        const int hq = u % 6, tok = u / 6, b = tok >> 11, t = tok & 2047, kv = hq / 3;
        load_q(p.hb + (size_t)tok * NMAIN + C_SQ + hq * 64, q, lane);
        const float sl = slope_swa(hq), sink = p.sinks[l * 6 + hq];
        const bf16_t* Kb = p.hb + (size_t)b * SEQ * NMAIN + C_SK + kv * 64;
        const bf16_t* Vb = p.hb + (size_t)b * SEQ * NMAIN + C_SV + kv * 64;
        const int s_lo = max(0, t - 127), cnt = t - s_lo + 1;
        float mx = score_keys(q, Kb, NMAIN, s_lo, cnt, sc, lane, [&](int s, float& bias) { bias = -sl * (float)(t - s); return true; });
        mx = fmaxf(wave_max(mx), sink);
        const float sum = softmax_lds(sc, cnt, mx, lane) + __expf(sink - mx);
        const float o = pv_keys(Vb, NMAIN, s_lo, cnt, sc, lane, 0.f);
        p.ob[(size_t)tok * DM + 256 + hq * 64 + lane] = f2bf(o / sum);
        lds_wave_sync();
    }
    for (int u = gwv; u < NTOK * 2; u += nw) {
        const int kv = u & 1, tok = u >> 1, b = tok >> 11, t = tok & 2047;
        const int ncv = t >= 31 ? ((t - 31) >> 4) + 1 : 0, cur = t >> 6;
        const bf16_t* Kc = p.kc + ((size_t)b * 2 + kv) * 128 * 64;
        const bf16_t* Vc = p.vc + ((size_t)b * 2 + kv) * 128 * 64;
        float pslc = 0.f;
        for (int g = 0; g < 3; ++g) {
            const int hq = kv * 3 + g; const float sl = slope_nsa(hq);
            load_q(p.hb + (size_t)tok * NMAIN + C_NQ + hq * 64, q, lane);
            float mx = score_keys(q, Kc, 64, 0, ncv, sc, lane, [&](int c, float& bias) { bias = -sl * (float)(t - (16 * c + 31)); return true; });
            for (int i = ncv + lane; i < 132; i += 64) sc[i] = NEG_INF;
            mx = wave_max(mx);
            const float sum = softmax_lds(sc, 132, mx, lane);
            if (lane < 32 && ncv > 0) {
                const int n = lane; float a = sc[4 * n] + sc[4 * n + 1] + sc[4 * n + 2] + 0.5f * sc[4 * n + 3];
                if (n > 0) a += 0.5f * sc[4 * n - 1];
                pslc += a / sum;
            }
            lds_wave_sync();
        }
        unsigned mask = 1u | (1u << cur); if (cur >= 1) mask |= 1u << (cur - 1);
        if (cur >= 3) {
            const int ncand = cur - 2;
            if (ncand <= 5) { for (int j = 1; j <= cur - 2; ++j) mask |= 1u << j; }
            else {
                for (int r = 0; r < 5; ++r) {
                    const bool cand = lane >= 1 && lane <= cur - 2 && !((mask >> lane) & 1u);
                    const float v = cand ? pslc : -1.0f;
                    const float mxv = wave_max(v);
                    const unsigned long long bal = __ballot(cand && v == mxv);
                    const int pick = bal ? (int)__builtin_ctzll(bal) : 0;
                    mask |= 1u << pick;
                }
            }
        }
        for (int g = 0; g < 3; ++g) {
            const int hq = kv * 3 + g; const float sl = slope_nsa(hq);
            load_q(p.hb + (size_t)tok * NMAIN + C_NQ + hq * 64, q, lane);
            const float* gl = p.hs + (size_t)tok * HS_W + 4 + hq * 3;
            const float g0 = 1.f / (1.f + __expf(-gl[0])), g1 = 1.f / (1.f + __expf(-gl[1])), g2 = 1.f / (1.f + __expf(-gl[2]));
            float outv = 0.f;
            if (ncv > 0) {
                float mx = score_keys(q, Kc, 64, 0, ncv, sc, lane, [&](int c, float& bias) { bias = -sl * (float)(t - (16 * c + 31)); return true; });
                mx = wave_max(mx);
                const float sum = softmax_lds(sc, ncv, mx, lane);
                const float o = pv_keys(Vc, 64, 0, ncv, sc, lane, 0.f);
                outv += g0 * o / sum;
                lds_wave_sync();
            }
            {
                const bf16_t* Kb = p.hb + (size_t)b * SEQ * NMAIN + C_NKS + kv * 64;
                const bf16_t* Vb = p.hb + (size_t)b * SEQ * NMAIN + C_NVS + kv * 64;
                float mx = NEG_INF; int nb = 0;
                for (int j = 0; j <= cur; ++j) if ((mask >> j) & 1u) {
                    mx = fmaxf(mx, score_keys(q, Kb, NMAIN, j * 64, 64, sc + nb * 64, lane, [&](int s, float& bias) { bias = -sl * (float)(t - s); return s <= t; }));
                    ++nb;
                }
                mx = wave_max(mx);
                const float sum = softmax_lds(sc, nb * 64, mx, lane);
                float o = 0.f; nb = 0;
                for (int j = 0; j <= cur; ++j) if ((mask >> j) & 1u) { o = pv_keys(Vb, NMAIN, j * 64, 64, sc + nb * 64, lane, o); ++nb; }
                outv += g1 * o / sum;
                lds_wave_sync();
            }
            {
                const bf16_t* Kb = p.hb + (size_t)b * SEQ * NMAIN + C_NKW + kv * 64;
                const bf16_t* Vb = p.hb + (size_t)b * SEQ * NMAIN + C_NVW + kv * 64;
                const int s_lo = max(0, t - 511), cnt = t - s_lo + 1;
                float mx = score_keys(q, Kb, NMAIN, s_lo, cnt, sc, lane, [&](int s, float& bias) { bias = -sl * (float)(t - s); return true; });
                mx = wave_max(mx);
                const float sum = softmax_lds(sc, cnt, mx, lane);
                const float o = pv_keys(Vb, NMAIN, s_lo, cnt, sc, lane, 0.f);
                outv += g2 * o / sum;
                lds_wave_sync();
            }
            p.ob[(size_t)tok * DM + 640 + hq * 64 + lane] = f2bf(outv);
        }
    }
}

constexpr float L2E = 1.4426950408889634f, MASKV = -1e30f, SCL2 = QSCALE * L2E;
template <int NQT, class MB>
__device__ __forceinline__ void attn_chunk(const bf16_t* __restrict__ Kb, size_t ldk, const bf16_t* __restrict__ VTb, size_t ldv, int kc0,
                                           const bf16x8 (&qf)[NQT][2], f32x4 (&o)[NQT][4], float (&m)[NQT], float (&l)[NQT], int fr, int fq, const MB& mb) {
    const bf16_t* kp = Kb + (size_t)(kc0 + (fr >> 2) * 8 + (fr & 3)) * ldk + fq * 8;
    bf16x8 kf[2][2];
    kf[0][0] = *(const bf16x8*)(kp); kf[0][1] = *(const bf16x8*)(kp + 32);
    kf[1][0] = *(const bf16x8*)(kp + 4 * ldk); kf[1][1] = *(const bf16x8*)(kp + 4 * ldk + 32);
    const bf16_t* vp = VTb + (size_t)fr * ldv + kc0 + fq * 8;
    bf16x8 vf[4];
#pragma unroll
    for (int dt = 0; dt < 4; ++dt) vf[dt] = *(const bf16x8*)(vp + (size_t)dt * 16 * ldv);
#pragma unroll
    for (int qt = 0; qt < NQT; ++qt) {
        f32x4 s0 = (f32x4){0.f, 0.f, 0.f, 0.f}, s1 = s0;
        s0 = __builtin_amdgcn_mfma_f32_16x16x32_bf16(kf[0][0], qf[qt][0], s0, 0, 0, 0);
        s0 = __builtin_amdgcn_mfma_f32_16x16x32_bf16(kf[0][1], qf[qt][1], s0, 0, 0, 0);
        s1 = __builtin_amdgcn_mfma_f32_16x16x32_bf16(kf[1][0], qf[qt][0], s1, 0, 0, 0);
        s1 = __builtin_amdgcn_mfma_f32_16x16x32_bf16(kf[1][1], qf[qt][1], s1, 0, 0, 0);
        float v[8];
#pragma unroll
        for (int j = 0; j < 4; ++j) { v[j] = mb(qt, j, s0[j]); v[j + 4] = mb(qt, j + 4, s1[j]); }
        float mx = fmaxf(fmaxf(fmaxf(v[0], v[1]), fmaxf(v[2], v[3])), fmaxf(fmaxf(v[4], v[5]), fmaxf(v[6], v[7])));
        mx = fmaxf(mx, __shfl_xor(mx, 16)); mx = fmaxf(mx, __shfl_xor(mx, 32));
        const float mnew = fmaxf(m[qt], mx);
        const float alpha = __builtin_amdgcn_exp2f(m[qt] - mnew);
        m[qt] = mnew;
        float pr[8]; float ps = 0.f;
#pragma unroll
        for (int j = 0; j < 8; ++j) { pr[j] = v[j] > -1e29f ? __builtin_amdgcn_exp2f(v[j] - mnew) : 0.f; ps += pr[j]; }
        l[qt] = l[qt] * alpha + ps;
#pragma unroll
        for (int dt = 0; dt < 4; ++dt) o[qt][dt] *= alpha;
        union { bf16x8 v8; unsigned u[4]; } pf;
        pf.u[0] = pack2(pr[0], pr[1]); pf.u[1] = pack2(pr[2], pr[3]); pf.u[2] = pack2(pr[4], pr[5]); pf.u[3] = pack2(pr[6], pr[7]);
#pragma unroll
        for (int dt = 0; dt < 4; ++dt) o[qt][dt] = __builtin_amdgcn_mfma_f32_16x16x32_bf16(vf[dt], pf.v8, o[qt][dt], 0, 0, 0);
        __builtin_amdgcn_sched_barrier(0);
    }
}
template <int NQT>
__device__ __forceinline__ void attn_init(f32x4 (&o)[NQT][4], float (&m)[NQT], float (&l)[NQT]) {
#pragma unroll
    for (int qt = 0; qt < NQT; ++qt) { m[qt] = MASKV; l[qt] = 0.f;
#pragma unroll
        for (int dt = 0; dt < 4; ++dt) o[qt][dt] = (f32x4){0.f, 0.f, 0.f, 0.f}; }
}
__device__ __forceinline__ float lsum4(float l) { l += __shfl_xor(l, 16); l += __shfl_xor(l, 32); return l; }
__device__ __forceinline__ void store_o4(bf16_t* dst, const f32x4 v) { u32x2 w; w.x = pack2(v[0], v[1]); w.y = pack2(v[2], v[3]); *(u32x2*)dst = w; }

__device__ __forceinline__ void fox_unit(const Params& p, int b, int h, int qb, int fr, int fq) {
    const int t0 = qb * 64;
    const bf16_t* Qb = p.hb + ((size_t)b * SEQ + t0) * NMAIN + C_FQ + h * 64 + fq * 8;
    bf16x8 qf[4][2];
#pragma unroll
    for (int qt = 0; qt < 4; ++qt) { qf[qt][0] = *(const bf16x8*)(Qb + (size_t)(qt * 16 + fr) * NMAIN); qf[qt][1] = *(const bf16x8*)(Qb + (size_t)(qt * 16 + fr) * NMAIN + 32); }
    const float* cf = p.cF + ((size_t)b * 4 + h) * SEQ;
    float cq[4];
#pragma unroll
    for (int qt = 0; qt < 4; ++qt) cq[qt] = cf[t0 + qt * 16 + fr] * L2E;
    f32x4 o[4][4]; float m[4], l[4];
    attn_init<4>(o, m, l);
    const bf16_t* Kb = p.hb + (size_t)b * SEQ * NMAIN + C_FK + h * 64;
    const bf16_t* VTb = p.vT + ((size_t)b * NVH + h) * 64 * SEQ;
    const int nchunk = (t0 + 64) >> 5;
    for (int c = 0; c < nchunk; ++c) {
        const int kc0 = c * 32;
        const float4 ca = *(const float4*)(cf + kc0 + 8 * fq), cb = *(const float4*)(cf + kc0 + 8 * fq + 4);
        const float ck[8] = {ca.x * L2E, ca.y * L2E, ca.z * L2E, ca.w * L2E, cb.x * L2E, cb.y * L2E, cb.z * L2E, cb.w * L2E};
        const bool diag = kc0 + 31 > t0;
        const int kq = kc0 + 8 * fq - t0 - fr;
        attn_chunk<4>(Kb, NMAIN, VTb, SEQ, kc0, qf, o, m, l, fr, fq, [&](int qt, int j, float raw) {
            float v = raw * SCL2 + cq[qt] - ck[j];
            if (diag && (kq + j - 16 * qt) > 0) v = MASKV;
            return v; });
    }
#pragma unroll
    for (int qt = 0; qt < 4; ++qt) {
        const float inv = 1.0f / lsum4(l[qt]);
        bf16_t* dst = p.ob + ((size_t)b * SEQ + t0 + qt * 16 + fr) * DM + h * 64 + 4 * fq;
#pragma unroll
        for (int dt = 0; dt < 4; ++dt) store_o4(dst + dt * 16, o[qt][dt] * inv);
    }
}
__device__ __forceinline__ void swa_unit(const Params& p, int l_, int b, int kv, int pos, int fr, int fq) {
    const int t0 = pos * 16, t = t0 + fr;
    const bf16_t* Qb = p.hb + ((size_t)b * SEQ + t) * NMAIN + C_SQ + kv * 192 + fq * 8;
    bf16x8 qf[3][2];
#pragma unroll
    for (int g = 0; g < 3; ++g) { qf[g][0] = *(const bf16x8*)(Qb + g * 64); qf[g][1] = *(const bf16x8*)(Qb + g * 64 + 32); }
    float sl[3];
#pragma unroll
    for (int g = 0; g < 3; ++g) sl[g] = slope_swa(kv * 3 + g) * L2E;
    f32x4 o[3][4]; float m[3], l[3];
    attn_init<3>(o, m, l);
    const bf16_t* Kb = p.hb + (size_t)b * SEQ * NMAIN + C_SK + kv * 64;
    const bf16_t* VTb = p.vT + ((size_t)b * NVH + 4 + kv) * 64 * SEQ;
    const int c_lo = max(0, t0 - 127) >> 5, c_hi = (t0 + 15) >> 5;
    for (int c = c_lo; c <= c_hi; ++c) {
        const int kc0 = c * 32, dq = t - kc0 - 8 * fq;
        attn_chunk<3>(Kb, NMAIN, VTb, SEQ, kc0, qf, o, m, l, fr, fq, [&](int g, int j, float raw) {
            const int dist = dq - j;
            return (dist >= 0 && dist < 128) ? raw * SCL2 - sl[g] * (float)dist : MASKV; });
    }
#pragma unroll
    for (int g = 0; g < 3; ++g) {
        const float sink = p.sinks[l_ * 6 + kv * 3 + g] * L2E;
        const float inv = 1.0f / (lsum4(l[g]) + __builtin_amdgcn_exp2f(sink - m[g]));
        bf16_t* dst = p.ob + ((size_t)b * SEQ + t) * DM + 256 + (kv * 3 + g) * 64 + 4 * fq;
#pragma unroll
        for (int dt = 0; dt < 4; ++dt) store_o4(dst + dt * 16, o[g][dt] * inv);
    }
}
__device__ __forceinline__ void nsa_unit(const Params& p, int b, int kv, int pos, int fr, int fq, int lane, float* ps, unsigned* msk, float* otl) {
    const int t0 = pos * 16, t = t0 + fr, cur = t0 >> 6;
    const bf16_t* Qb = p.hb + ((size_t)b * SEQ + t) * NMAIN + C_NQ + kv * 192 + fq * 8;
    bf16x8 qf[3][2];
#pragma unroll
    for (int g = 0; g < 3; ++g) { qf[g][0] = *(const bf16x8*)(Qb + g * 64); qf[g][1] = *(const bf16x8*)(Qb + g * 64 + 32); }
    float sl[3];
#pragma unroll
    for (int g = 0; g < 3; ++g) sl[g] = slope_nsa(kv * 3 + g) * L2E;
    const float* gl = p.hs + ((size_t)b * SEQ + t) * HS_W + 4 + kv * 9;
    f32x4 o[3][4]; float m[3], l[3];
    f32x4* otv = (f32x4*)otl + lane;
#pragma unroll
    for (int i = 0; i < 8; ++i) ps[lane + 64 * i] = 0.f;
    {
        const bf16_t* Kb = p.kc + ((size_t)b * 2 + kv) * 128 * 64;
        const bf16_t* VTb = p.vcT + ((size_t)b * 2 + kv) * 64 * 128;
        const int ncv = (t0 + 15 >= 31) ? ((t0 + 15 - 31) >> 4) + 1 : 0;
        const int nch = (ncv + 31) >> 5;
        attn_init<3>(o, m, l);
        const int dq0 = t - 31 - 16 * 8 * fq;
        for (int c = 0; c < nch; ++c) {
            const int kc0 = c * 32, dq = dq0 - 16 * kc0;
            attn_chunk<3>(Kb, 64, VTb, 128, kc0, qf, o, m, l, fr, fq, [&](int g, int j, float raw) {
                const int dist = dq - 16 * j;
                return dist >= 0 ? raw * SCL2 - sl[g] * (float)dist : MASKV; });
        }
        float il[3];
#pragma unroll
        for (int g = 0; g < 3; ++g) {
            const float lt = lsum4(l[g]); il[g] = lt > 0.f ? 1.0f / lt : 0.f;
            const float gate = 1.0f / (1.0f + __expf(-gl[g * 3 + 0]));
#pragma unroll
            for (int dt = 0; dt < 4; ++dt) otv[(g * 4 + dt) * 64] = o[g][dt] * (il[g] * gate);
        }
        float carry_prev = 0.f;
        for (int c = 0; c < nch; ++c) {
            const int kc0 = c * 32, dq = dq0 - 16 * kc0;
            const bf16_t* kp = Kb + (size_t)(kc0 + (fr >> 2) * 8 + (fr & 3)) * 64 + fq * 8;
            const bf16x8 k00 = *(const bf16x8*)(kp), k01 = *(const bf16x8*)(kp + 32), k10 = *(const bf16x8*)(kp + 256), k11 = *(const bf16x8*)(kp + 256 + 32);
            float pc[8];
#pragma unroll
            for (int j = 0; j < 8; ++j) pc[j] = 0.f;
#pragma unroll
            for (int g = 0; g < 3; ++g) {
                f32x4 s0 = (f32x4){0.f, 0.f, 0.f, 0.f}, s1 = s0;
                s0 = __builtin_amdgcn_mfma_f32_16x16x32_bf16(k00, qf[g][0], s0, 0, 0, 0); s0 = __builtin_amdgcn_mfma_f32_16x16x32_bf16(k01, qf[g][1], s0, 0, 0, 0);
                s1 = __builtin_amdgcn_mfma_f32_16x16x32_bf16(k10, qf[g][0], s1, 0, 0, 0); s1 = __builtin_amdgcn_mfma_f32_16x16x32_bf16(k11, qf[g][1], s1, 0, 0, 0);
#pragma unroll
                for (int j = 0; j < 8; ++j) {
                    const int dist = dq - 16 * j; const float raw = j < 4 ? s0[j] : s1[j - 4];
                    if (dist >= 0) pc[j] += __builtin_amdgcn_exp2f(raw * SCL2 - sl[g] * (float)dist - m[g]) * il[g];
                }
            }
            const float cout = 0.5f * pc[7];
            float cin = __shfl_up(cout, 16);
            const float cwrap = __shfl(cout, fr + 48);
            if (fq == 0) cin = carry_prev;
            carry_prev = cwrap;
            const int n0 = (kc0 >> 2) + 2 * fq;
            ps[fr * 32 + n0] = cin + pc[0] + pc[1] + pc[2] + 0.5f * pc[3];
            ps[fr * 32 + n0 + 1] = 0.5f * pc[3] + pc[4] + pc[5] + pc[6] + 0.5f * pc[7];
        }
    }
    lds_wave_sync();
    if (lane < 16) {
        unsigned mask = 1u | (1u << cur); if (cur >= 1) mask |= 1u << (cur - 1);
        if (cur >= 3) {
            if (cur - 2 <= 5) mask |= (1u << (cur - 1)) - 2u;
            else {
                const float* my = ps + lane * 32;
                for (int r = 0; r < 5; ++r) {
                    float best = -1.0f; int bi = 1;
                    for (int j = 1; j <= cur - 2; ++j) { const float v = my[j]; if (!((mask >> j) & 1u) && v > best) { best = v; bi = j; } }
                    mask |= 1u << bi;
                }
            }
        }
        msk[lane] = mask;
    }
    lds_wave_sync();
    const unsigned qmask = msk[fr];
    lds_wave_sync();
    {
        const bf16_t* Kb = p.hb + (size_t)b * SEQ * NMAIN + C_NKS + kv * 64;
        const bf16_t* VTb = p.vT + ((size_t)b * NVH + 6 + kv) * 64 * SEQ;
        attn_init<3>(o, m, l);
        for (int kb = 0; kb <= cur; ++kb) {
            const bool mine = (qmask >> kb) & 1u;
            if (__ballot(mine) == 0ull) continue;
#pragma unroll 1
            for (int hc = 0; hc < 2; ++hc) {
                const int kc0 = kb * 64 + hc * 32, dq = t - kc0 - 8 * fq;
                attn_chunk<3>(Kb, NMAIN, VTb, SEQ, kc0, qf, o, m, l, fr, fq, [&](int g, int j, float raw) {
                    const int dist = dq - j;
                    return (mine && dist >= 0) ? raw * SCL2 - sl[g] * (float)dist : MASKV; });
            }
        }
#pragma unroll
        for (int g = 0; g < 3; ++g) {
            const float lt = lsum4(l[g]); const float sc = (lt > 0.f ? 1.0f / lt : 0.f) / (1.0f + __expf(-gl[g * 3 + 1]));
#pragma unroll
            for (int dt = 0; dt < 4; ++dt) otv[(g * 4 + dt) * 64] += o[g][dt] * sc;
        }
    }
    {
        const bf16_t* Kb = p.hb + (size_t)b * SEQ * NMAIN + C_NKW + kv * 64;
        const bf16_t* VTb = p.vT + ((size_t)b * NVH + 8 + kv) * 64 * SEQ;
        attn_init<3>(o, m, l);
        const int c_lo = max(0, t0 - 511) >> 5, c_hi = (t0 + 15) >> 5;
        for (int c = c_lo; c <= c_hi; ++c) {
            const int kc0 = c * 32, dq = t - kc0 - 8 * fq;
            attn_chunk<3>(Kb, NMAIN, VTb, SEQ, kc0, qf, o, m, l, fr, fq, [&](int g, int j, float raw) {
                const int dist = dq - j;
                return (dist >= 0 && dist < 512) ? raw * SCL2 - sl[g] * (float)dist : MASKV; });
        }
#pragma unroll
        for (int g = 0; g < 3; ++g) {
            const float lt = lsum4(l[g]); const float sc = (lt > 0.f ? 1.0f / lt : 0.f) / (1.0f + __expf(-gl[g * 3 + 2]));
            bf16_t* dst = p.ob + ((size_t)b * SEQ + t) * DM + 640 + (kv * 3 + g) * 64 + 4 * fq;
#pragma unroll
            for (int dt = 0; dt < 4; ++dt) store_o4(dst + dt * 16, otv[(g * 4 + dt) * 64] + o[g][dt] * sc);
        }
    }
}

__device__ void phase_attn(const Params& p, int l, char* lds) {
    int tid = threadIdx.x; asm volatile("" : "+v"(tid));
    const int wid = tid >> 6, lane = tid & 63, fr = lane & 15, fq = lane >> 4;
    float* ps = (float*)(lds + wid * 14592); unsigned* msk = (unsigned*)(ps + 512); float* otl = ps + 576;
    unsigned* ctr = p.ctrl + 16 + l;
    constexpr unsigned NU_NSA = NB * 2 * 128, NU_FOX = NB * 4 * 32, NU_SWA = NB * 2 * 128;
    for (;;) {
        unsigned u = 0;
        if (lane == 0) u = __hip_atomic_fetch_add(ctr, 1u, __ATOMIC_RELAXED, __HIP_MEMORY_SCOPE_AGENT);
        u = (unsigned)__builtin_amdgcn_readfirstlane((int)u);
        if (u >= NU_NSA + NU_FOX + NU_SWA) break;
        if (u < NU_NSA) { const int pos = 127 - (int)(u >> 5), r = u & 31; nsa_unit(p, r >> 1, r & 1, pos, fr, fq, lane, ps, msk, otl); }
        else if (u < NU_NSA + NU_FOX) { const unsigned v = u - NU_NSA; const int qb = 31 - (int)(v >> 6), r = v & 63; fox_unit(p, r >> 2, r & 3, qb, fr, fq); }
        else { const unsigned v = u - NU_NSA - NU_FOX; const int pos = 127 - (int)(v >> 5), r = v & 31; swa_unit(p, l, r >> 1, r & 1, pos, fr, fq); }
    }
}

__device__ void phase_ln1_router(const Params& p, int l, char* lds) {
    int tid = threadIdx.x; asm volatile("" : "+v"(tid));
    const int wid = tid >> 6, lane = tid & 63, fr = lane & 15, fq = lane >> 4;
    float* lg = (float*)lds + wid * 512;
    int* lcnt = (int*)(lds + 8192); int* lbase = lcnt + 32;
    const float* g1 = p.ln1_g + l * DM; const float* b1 = p.ln1_b + l * DM;
    const float* rw = p.rwT + (size_t)l * NE * 1024; const float* rb = p.router_b + l * NE;
    unsigned* gcount = p.ctrl + 64 + l * NE;
    for (int grp = blockIdx.x; grp < NTOK / 64; grp += gridDim.x) {
        const int tok0 = grp * 64 + wid * 16;
        if (tid < 32) lcnt[tid] = 0;
        for (int r = 0; r < 16; ++r) {
            const size_t row = (size_t)(tok0 + r);
            float4 v[4]; float s = 0.f;
#pragma unroll
            for (int j = 0; j < 4; ++j) { v[j] = *(const float4*)(p.tbuf + row * DM + j * 256 + lane * 4); s += (v[j].x + v[j].y) + (v[j].z + v[j].w); }
            const float mean = wave_sum(s) * (1.0f / 1024.0f);
            float qv = 0.f;
#pragma unroll
            for (int j = 0; j < 4; ++j) { v[j].x -= mean; v[j].y -= mean; v[j].z -= mean; v[j].w -= mean; qv += (v[j].x * v[j].x + v[j].y * v[j].y) + (v[j].z * v[j].z + v[j].w * v[j].w); }
            const float rstd = rsqrtf(wave_sum(qv) * (1.0f / 1024.0f) + LN_EPS);
#pragma unroll
            for (int j = 0; j < 4; ++j) {
                const int c = j * 256 + lane * 4;
                const float4 gg = *(const float4*)(g1 + c), bb = *(const float4*)(b1 + c);
                float4 y; y.x = v[j].x * rstd * gg.x + bb.x; y.y = v[j].y * rstd * gg.y + bb.y; y.z = v[j].z * rstd * gg.z + bb.z; y.w = v[j].w * rstd * gg.w + bb.w;
                *(float4*)(p.x1f + row * DM + c) = y;
                u32x2 w; w.x = pack2(y.x, y.y); w.y = pack2(y.z, y.w);
                *(u32x2*)(p.x1b + row * DM + c) = w;
            }
        }
        __syncthreads();
        f32x4 a0 = (f32x4){0.f, 0.f, 0.f, 0.f}, a1 = a0;
        const float* xr = p.x1f + (size_t)(tok0 + fr) * DM + 4 * fq;
        const float* w0 = rw + (size_t)fr * 1024 + 4 * fq; const float* w1 = rw + (size_t)(16 + fr) * 1024 + 4 * fq;
        for (int k0 = 0; k0 < 1024; k0 += 16) {
            const float4 xa = *(const float4*)(xr + k0), wb0 = *(const float4*)(w0 + k0), wb1 = *(const float4*)(w1 + k0);
            a0 = __builtin_amdgcn_mfma_f32_16x16x4f32(xa.x, wb0.x, a0, 0, 0, 0); a1 = __builtin_amdgcn_mfma_f32_16x16x4f32(xa.x, wb1.x, a1, 0, 0, 0);
            a0 = __builtin_amdgcn_mfma_f32_16x16x4f32(xa.y, wb0.y, a0, 0, 0, 0); a1 = __builtin_amdgcn_mfma_f32_16x16x4f32(xa.y, wb1.y, a1, 0, 0, 0);
            a0 = __builtin_amdgcn_mfma_f32_16x16x4f32(xa.z, wb0.z, a0, 0, 0, 0); a1 = __builtin_amdgcn_mfma_f32_16x16x4f32(xa.z, wb1.z, a1, 0, 0, 0);
            a0 = __builtin_amdgcn_mfma_f32_16x16x4f32(xa.w, wb0.w, a0, 0, 0, 0); a1 = __builtin_amdgcn_mfma_f32_16x16x4f32(xa.w, wb1.w, a1, 0, 0, 0);
        }
#pragma unroll
        for (int r = 0; r < 4; ++r) { lg[(fq * 4 + r) * 32 + fr] = a0[r] + rb[fr]; lg[(fq * 4 + r) * 32 + 16 + fr] = a1[r] + rb[16 + fr]; }
        lds_wave_sync();
        int e4[4] = {0, 0, 0, 0}; int rk[4] = {0, 0, 0, 0};
        if (lane < 16) {
            const float* my = lg + lane * 32; unsigned taken = 0u; float tv[4];
#pragma unroll
            for (int k = 0; k < 4; ++k) {
                float best = NEG_INF; int bi = 0;
                for (int e = 0; e < 32; ++e) { const float xv = my[e]; if (!((taken >> e) & 1u) && xv > best) { best = xv; bi = e; } }
                taken |= 1u << bi; e4[k] = bi; tv[k] = best;
            }
            const float e1 = __expf(tv[1] - tv[0]), e2 = __expf(tv[2] - tv[0]), e3 = __expf(tv[3] - tv[0]);
            const float inv = 1.0f / (1.0f + e1 + e2 + e3);
            const size_t row = (size_t)(tok0 + lane);
            *(int4*)(p.top_e + row * 4) = make_int4(e4[0], e4[1], e4[2], e4[3]);
            *(float4*)(p.gw + row * 4) = make_float4(inv, e1 * inv, e2 * inv, e3 * inv);
        }
        __syncthreads();
        if (lane < 16) {
#pragma unroll
            for (int k = 0; k < 4; ++k) rk[k] = atomicAdd(&lcnt[e4[k]], 1);
        }
        __syncthreads();
        if (tid < 32) { const int c = lcnt[tid]; lbase[tid] = c ? (int)__hip_atomic_fetch_add(gcount + tid, (unsigned)c, __ATOMIC_RELAXED, __HIP_MEMORY_SCOPE_AGENT) : 0; }
        __syncthreads();
        if (lane < 16) {
            const int row = tok0 + lane;
#pragma unroll
            for (int k = 0; k < 4; ++k) p.lists[(size_t)e4[k] * LIST_CAP + lbase[e4[k]] + rk[k]] = row * 4 + k;
        }
        __syncthreads();
    }
}

__device__ void phase_ln2(const Params& p, int l, float* xout) {
    int tid = threadIdx.x; asm volatile("" : "+v"(tid));
    const int wid = tid >> 6, lane = tid & 63;
    const float* g2 = p.ln2_g + l * DM; const float* b2 = p.ln2_b + l * DM;
    for (int row = blockIdx.x * 4 + wid; row < NTOK; row += gridDim.x * 4) {
        const float4 gwv = *(const float4*)(p.gw + (size_t)row * 4);
        const float gk[4] = {gwv.x, gwv.y, gwv.z, gwv.w};
        float4 v[4]; float s = 0.f;
#pragma unroll
        for (int j = 0; j < 4; ++j) {
            const int c = j * 256 + lane * 4;
            const float4 xv = *(const float4*)(p.x1f + (size_t)row * DM + c);
            float4 a; a.x = xv.x * ALPHA; a.y = xv.y * ALPHA; a.z = xv.z * ALPHA; a.w = xv.w * ALPHA;
#pragma unroll
            for (int k = 0; k < 4; ++k) {
                const u32x2 w = *(const u32x2*)(p.ybuf + ((size_t)row * 4 + k) * DM + c);
                a.x += gk[k] * __uint_as_float(w.x << 16); a.y += gk[k] * __uint_as_float(w.x & 0xffff0000u);
                a.z += gk[k] * __uint_as_float(w.y << 16); a.w += gk[k] * __uint_as_float(w.y & 0xffff0000u);
            }
            v[j] = a; s += (a.x + a.y) + (a.z + a.w);
        }
        const float mean = wave_sum(s) * (1.0f / 1024.0f);
        float qv = 0.f;
#pragma unroll
        for (int j = 0; j < 4; ++j) { v[j].x -= mean; v[j].y -= mean; v[j].z -= mean; v[j].w -= mean; qv += (v[j].x * v[j].x + v[j].y * v[j].y) + (v[j].z * v[j].z + v[j].w * v[j].w); }
        const float rstd = rsqrtf(wave_sum(qv) * (1.0f / 1024.0f) + LN_EPS);
#pragma unroll
        for (int j = 0; j < 4; ++j) {
            const int c = j * 256 + lane * 4;
            const float4 gg = *(const float4*)(g2 + c), bb = *(const float4*)(b2 + c);
            float4 y; y.x = v[j].x * rstd * gg.x + bb.x; y.y = v[j].y * rstd * gg.y + bb.y; y.z = v[j].z * rstd * gg.z + bb.z; y.w = v[j].w * rstd * gg.w + bb.w;
            *(float4*)(xout + (size_t)row * DM + c) = y;
            u32x2 w; w.x = pack2(y.x, y.y); w.y = pack2(y.z, y.w);
            *(u32x2*)(p.xb + (size_t)row * DM + c) = w;
        }
    }
}

constexpr int NPHASE = 1 + 8 * NL;
__global__ void __launch_bounds__(256, 2) fwd_kernel(Params p, int ph_lo, int ph_hi) {
    extern __shared__ __attribute__((aligned(16))) char lds[];
    cg::grid_group grid = cg::this_grid();
    for (int ph = ph_lo; ph < ph_hi; ++ph) {
        if (ph > ph_lo) grid.sync();
#ifndef SKIP_P0
        if (ph == 0) { phase0(p, lds); continue; }
#else
        if (ph == 0) continue;
#endif
        const int l = (ph - 1) >> 3, s = (ph - 1) & 7;
        const float* xin = l == 0 ? p.x : p.xf;
        float* xout = l == NL - 1 ? p.out : p.xf;
        switch (s) {
#ifndef SKIP_S0
            case 0: phase_inproj(p, l, lds); break;
#endif
#ifndef SKIP_S1
            case 1: phase_prep(p, l, lds); break;
#endif
#ifndef SKIP_S2
#ifdef NAIVE_ATTN
            case 2: phase_attn_naive(p, l, lds); break;
#else
            case 2: phase_attn(p, l, lds); break;
#endif
#endif
#ifndef SKIP_S3
            case 3: phase_outproj(p, l, xin, lds); break;
#endif
#ifndef SKIP_S4
            case 4: phase_ln1_router(p, l, lds); break;
#endif
#ifndef SKIP_S5
            case 5: phase_gateup(p, l, lds); break;
#endif
#ifndef SKIP_S6
            case 6: phase_down(p, l, lds); break;
#endif
#ifndef SKIP_S7
            default: phase_ln2(p, l, xout); break;
#else
            default: break;
#endif
        }
    }
}

static inline size_t align_up(size_t v, size_t a) { return (v + a - 1) / a * a; }

extern "C" void kernel_launch(void* const* d_in, const int* in_sizes, int n_in, void* d_out, int out_size, void* d_ws, size_t ws_size, hipStream_t stream) {
    Params p{};
    p.x = (const float*)d_in[0]; p.w_in = (const float*)d_in[1]; p.b_in = (const float*)d_in[2]; p.sinks = (const float*)d_in[3];
    p.cmp_pe = (const float*)d_in[4]; p.cmp_w1 = (const float*)d_in[5]; p.cmp_w2 = (const float*)d_in[6]; p.w_out = (const float*)d_in[7];
    p.ln1_g = (const float*)d_in[8]; p.ln1_b = (const float*)d_in[9]; p.router_w = (const float*)d_in[10]; p.router_b = (const float*)d_in[11];
    p.w_gu = (const float*)d_in[12]; p.b_gu = (const float*)d_in[13]; p.w_dn = (const float*)d_in[14]; p.b_dn = (const float*)d_in[15];
    p.ln2_g = (const float*)d_in[16]; p.ln2_b = (const float*)d_in[17];
    p.out = (float*)d_out;
    char* w = (char*)d_ws; size_t off = 0;
    auto take = [&](size_t bytes) { char* r = w + off; off = align_up(off + bytes, 256); return r; };
    p.ctrl = (unsigned*)take(65536);
    p.WinT = (bf16_t*)take((size_t)NL * NPAD * 1024 * 2);
    p.WoT = (bf16_t*)take((size_t)NL * 1024 * 1024 * 2);
    p.W1T = (bf16_t*)take((size_t)NL * 2 * 64 * 2048 * 2);
    p.W2T = (bf16_t*)take((size_t)NL * 2 * 64 * 64 * 2);
    p.WguT = (bf16_t*)take((size_t)NL * NE * 2048 * 1024 * 2);
    p.WdnT = (bf16_t*)take((size_t)NL * NE * 1024 * 1024 * 2);
    p.rwT = (float*)take((size_t)NL * NE * 1024 * 4);
    p.binp = (float*)take((size_t)NL * NPAD * 4);
    p.bgup = (float*)take((size_t)NL * NE * 2048 * 4);
    p.b1c = (float*)take(4 * 64 * 4);
    p.xf = (float*)take((size_t)NTOK * DM * 4);
    p.xb = (bf16_t*)take((size_t)NTOK * DM * 2);
    p.hb = (bf16_t*)take((size_t)NTOK * NMAIN * 2);
    p.hs = (float*)take((size_t)NTOK * HS_W * 4);
    p.vT = (bf16_t*)take((size_t)NB * NVH * 64 * SEQ * 2);
    p.cF = (float*)take((size_t)NB * 4 * SEQ * 4);
    p.kc = (bf16_t*)take((size_t)NB * 2 * 128 * 64 * 2);
    p.vc = (bf16_t*)take((size_t)NB * 2 * 128 * 64 * 2);
    p.vcT = (bf16_t*)take((size_t)NB * 2 * 128 * 64 * 2);
    p.ob = (bf16_t*)take((size_t)NTOK * DM * 2);
    p.tbuf = (float*)take((size_t)NTOK * DM * 4);
    p.x1f = (float*)take((size_t)NTOK * DM * 4);
    p.x1b = (bf16_t*)take((size_t)NTOK * DM * 2);
    p.top_e = (int*)take((size_t)NTOK * 4 * 4);
    p.gw = (float*)take((size_t)NTOK * 4 * 4);
    p.lists = (int*)take((size_t)NE * LIST_CAP * 4);
    p.act = (bf16_t*)take((size_t)MAXSLOT * DFF * 2);
    p.ybuf = (bf16_t*)take((size_t)NTOK * 4 * DM * 2);
    if (off > ws_size) { fprintf(stderr, "workspace too small: need %zu have %zu\n", off, ws_size); return; }

    static int grid_blocks = 0;
    if (!grid_blocks) {
        int dev = 0, cus = 0, per_cu = 0;
        hipGetDevice(&dev);
        hipDeviceGetAttribute(&cus, hipDeviceAttributeMultiprocessorCount, dev);
        hipFuncSetAttribute((const void*)fwd_kernel, hipFuncAttributeMaxDynamicSharedMemorySize, LDS_BYTES);
        hipOccupancyMaxActiveBlocksPerMultiprocessor(&per_cu, fwd_kernel, 256, LDS_BYTES);
        if (per_cu > 2) per_cu = 2;
        if (per_cu < 1) per_cu = 1;
        grid_blocks = cus * per_cu;
    }
    hipMemsetAsync(p.ctrl, 0, 65536, stream);
#if ONE_LAUNCH
    int lo = 0, hi = NPHASE;
    void* args[] = {&p, &lo, &hi};
    hipError_t e = hipLaunchCooperativeKernel((const void*)fwd_kernel, dim3(grid_blocks), dim3(256), args, LDS_BYTES, stream);
    if (e != hipSuccess) fprintf(stderr, "cooperative launch failed: %s (grid %d)\n", hipGetErrorString(e), grid_blocks);
#else
    for (int ph = 0; ph < NPHASE; ++ph) fwd_kernel<<<grid_blocks, 256, LDS_BYTES, stream>>>(p, ph, ph + 1);
#endif
}
```

```cpp
#include <hip/hip_runtime.h>
#include <hip/hip_cooperative_groups.h>
#include <cstdio>
#include <cstdint>
namespace cg = cooperative_groups;

#ifndef ONE_LAUNCH
#define ONE_LAUNCH 1
#endif

typedef unsigned short bf16_t;
typedef short bf16x8 __attribute__((ext_vector_type(8)));
typedef float f32x4 __attribute__((ext_vector_type(4)));
typedef unsigned u32x4 __attribute__((ext_vector_type(4)));
typedef unsigned u32x2 __attribute__((ext_vector_type(2)));

constexpr int DM = 1024, NB = 16, SEQ = 2048, NTOK = NB * SEQ, NL = 2;
constexpr int NCOL = 2582, NMAIN = 2560, NPAD = 2688, NE = 32, DFF = 1024;
constexpr int C_FQ = 0, C_FK = 256, C_FV = 512, C_SQ = 768, C_SK = 1152, C_SV = 1280, C_NQ = 1408,
              C_NKC = 1792, C_NVC = 1920, C_NKS = 2048, C_NVS = 2176, C_NKW = 2304, C_NVW = 2432;
constexpr int HS_W = 32;
constexpr int NVH = 10;
constexpr int LIST_CAP = NTOK;
constexpr int MAXSLOT = NTOK * 4 + NE * 128;
constexpr float ALPHA = 1.41421356237f, LN_EPS = 1e-5f, QSCALE = 0.125f;
constexpr int LDS_BYTES = 65536;

struct Params {
    const float *x, *w_in, *b_in, *sinks, *cmp_pe, *cmp_w1, *cmp_w2, *w_out, *ln1_g, *ln1_b, *router_w, *router_b,
                *w_gu, *b_gu, *w_dn, *b_dn, *ln2_g, *ln2_b;
    float* out;
    unsigned* ctrl;
    bf16_t *WinT, *WoT, *W1T, *W2T, *WguT, *WdnT;
    float *rwT, *binp, *bgup, *b1c;
    float* xf;
    bf16_t* xb;
    bf16_t* hb;
    float* hs;
    bf16_t* vT;
    float* cF;
    bf16_t *kc, *vc, *vcT;
    bf16_t* ob;
    float* tbuf;
    float* x1f; bf16_t* x1b;
    int* top_e; float* gw;
    int* lists;
    bf16_t* act;
    bf16_t* ybuf;
};

__device__ __forceinline__ float bf2f(bf16_t h) { return __uint_as_float(((unsigned)h) << 16); }
__device__ __forceinline__ bf16_t f2bf(float f) { unsigned u = __float_as_uint(f); u += 0x7fffu + ((u >> 16) & 1u); return (bf16_t)(u >> 16); }
__device__ __forceinline__ unsigned pack2(float lo, float hi) { return (unsigned)f2bf(lo) | ((unsigned)f2bf(hi) << 16); }
__device__ __forceinline__ float wave_sum(float v) {
#pragma unroll
    for (int o = 32; o > 0; o >>= 1) v += __shfl_xor(v, o);
    return v;
}
__device__ __forceinline__ float wave_max(float v) {
#pragma unroll
    for (int o = 32; o > 0; o >>= 1) v = fmaxf(v, __shfl_xor(v, o));
    return v;
}
__device__ __forceinline__ void lds_wave_sync() { asm volatile("s_waitcnt lgkmcnt(0)" ::: "memory"); __builtin_amdgcn_wave_barrier(); }
__device__ __forceinline__ float slope_swa(int hq) { return exp2f(-8.0f * (float)(2 * hq + 1) / 12.0f); }
__device__ __forceinline__ float slope_nsa(int hq) { return exp2f(-8.0f * (float)(2 * hq + 2) / 12.0f); }

template <int PERM>
__device__ __forceinline__ int perm_row(int n) {
    if (PERM == 1) { if (n < 768) return n; if (n < 772) return 2560 + (n - 768); if (n < 2564) return n - 4; return n; }
    if (PERM == 2) { const int f = n >> 1, s = n & 1; return (f >> 5) * 64 + s * 32 + (f & 31); }
    return n;
}
template <int PERM>
__device__ __forceinline__ void conv_tile(const float* __restrict__ src, int K, int N, int kt, int nt, bf16_t* __restrict__ dst, float* lds) {
    int tid = threadIdx.x; asm volatile("" : "+v"(tid));
#pragma unroll
    for (int i = 0; i < 4; ++i) {
        const int kk = (tid >> 4) + 16 * i, nn = (tid & 15) * 4;
        const int k = kt * 64 + kk, n = nt * 64 + nn;
        const float* p = src + (size_t)k * N + n;
        float v0 = 0.f, v1 = 0.f, v2 = 0.f, v3 = 0.f;
        if (n + 3 < N) { v0 = p[0]; v1 = p[1]; v2 = p[2]; v3 = p[3]; }
        else { if (n < N) v0 = p[0]; if (n + 1 < N) v1 = p[1]; if (n + 2 < N) v2 = p[2]; }
        float* l = lds + kk * 65 + nn; l[0] = v0; l[1] = v1; l[2] = v2; l[3] = v3;
    }
    __syncthreads();
#pragma unroll
    for (int i = 0; i < 2; ++i) {
        const int idx = tid + 256 * i, nn = idx >> 3, kc = idx & 7, n = nt * 64 + nn;
        if (n < N) {
            const float* l = lds + (kc * 8) * 65 + nn;
            u32x4 w; w.x = pack2(l[0], l[65]); w.y = pack2(l[130], l[195]); w.z = pack2(l[260], l[325]); w.w = pack2(l[390], l[455]);
            *(u32x4*)(dst + (size_t)perm_row<PERM>(n) * K + kt * 64 + kc * 8) = w;
        }
    }
    __syncthreads();
}

__device__ void phase0(const Params& p, char* ldsc) {
    float* lds = (float*)ldsc;
    int tid = threadIdx.x; asm volatile("" : "+v"(tid));
    const int G = gridDim.x, bid = blockIdx.x;
    const size_t gtid = (size_t)bid * 256 + tid, gthreads = (size_t)G * 256;
    for (size_t i = gtid; i < (size_t)NL * NPAD; i += gthreads) {
        const int l = (int)(i / NPAD), r = (int)(i % NPAD);
        float v = 0.f;
        if (r < 2560) { const int n = r < 768 ? r : r + 4; v = p.b_in[l * NCOL + n]; }
        else if (r < 2564) v = p.b_in[l * NCOL + 768 + (r - 2560)];
        else if (r < 2582) v = p.b_in[l * NCOL + r];
        p.binp[i] = v;
    }
    for (size_t i = gtid; i < (size_t)NL * NE * 2048; i += gthreads) {
        const int r = (int)(i % 2048); const size_t le = i / 2048;
        const int q = r >> 6, s = (r >> 5) & 1, f = q * 32 + (r & 31);
        p.bgup[i] = p.b_gu[le * 2048 + 2 * f + s];
    }
    for (size_t i = gtid; i < (size_t)NL * NE * 1024; i += gthreads) {
        const int k = (int)(i % 1024), e = (int)((i / 1024) % NE), l = (int)(i / (1024 * NE));
        p.rwT[i] = p.router_w[((size_t)l * 1024 + k) * NE + e];
    }
    for (size_t i = gtid; i < (size_t)NL * (NPAD - NCOL) * 1024; i += gthreads) {
        const int l = (int)(i / ((NPAD - NCOL) * 1024)); const size_t r = i % ((size_t)(NPAD - NCOL) * 1024);
        p.WinT[(size_t)l * NPAD * 1024 + (size_t)NCOL * 1024 + r] = 0;
    }
    for (size_t i = gtid; i < (size_t)NTOK * DM / 4; i += gthreads) {
        const float4 v = ((const float4*)p.x)[i];
        u32x2 w; w.x = pack2(v.x, v.y); w.y = pack2(v.z, v.w);
        ((u32x2*)p.xb)[i] = w;
    }
    if (bid < 4) {
        const int j = tid & 63, part = tid >> 6;
        const float* pe = p.cmp_pe + (size_t)bid * 2048; const float* w1 = p.cmp_w1 + (size_t)bid * 2048 * 64;
        float s = 0.f;
        for (int kk = part * 512; kk < part * 512 + 512; ++kk) s += pe[kk] * w1[(size_t)kk * 64 + j];
        lds[tid] = s; __syncthreads();
        if (tid < 64) p.b1c[bid * 64 + tid] = lds[tid] + lds[tid + 64] + lds[tid + 128] + lds[tid + 192];
        __syncthreads();
    }
    constexpr int T_WIN = NL * 16 * 41, T_WO = NL * 16 * 16, T_W1 = NL * 2 * 32, T_W2 = NL * 2, T_GU = NL * NE * 16 * 32, T_DN = NL * NE * 16 * 16;
    constexpr int TOT = T_WIN + T_WO + T_W1 + T_W2 + T_GU + T_DN;
    for (int t = bid; t < TOT; t += G) {
        int u = t;
        if (u < T_GU) { const int m = u / 512, r = u % 512; conv_tile<2>(p.w_gu + (size_t)m * 1024 * 2048, 1024, 2048, r / 32, r % 32, p.WguT + (size_t)m * 2048 * 1024, lds); continue; }
        u -= T_GU;
        if (u < T_DN) { const int m = u / 256, r = u % 256; conv_tile<0>(p.w_dn + (size_t)m * 1024 * 1024, 1024, 1024, r / 16, r % 16, p.WdnT + (size_t)m * 1024 * 1024, lds); continue; }
        u -= T_DN;
        if (u < T_WIN) { const int m = u / 656, r = u % 656; conv_tile<1>(p.w_in + (size_t)m * 1024 * NCOL, 1024, NCOL, r / 41, r % 41, p.WinT + (size_t)m * NPAD * 1024, lds); continue; }
        u -= T_WIN;
        if (u < T_WO) { const int m = u / 256, r = u % 256; conv_tile<0>(p.w_out + (size_t)m * 1024 * 1024, 1024, 1024, r / 16, r % 16, p.WoT + (size_t)m * 1024 * 1024, lds); continue; }
        u -= T_WO;
        if (u < T_W1) { const int m = u / 32, r = u % 32; conv_tile<0>(p.cmp_w1 + (size_t)m * 2048 * 64, 2048, 64, r, 0, p.W1T + (size_t)m * 64 * 2048, lds); continue; }
        u -= T_W1;
        { const int m = u; conv_tile<0>(p.cmp_w2 + (size_t)m * 64 * 64, 64, 64, 0, 0, p.W2T + (size_t)m * 64 * 64, lds); }
    }
}

template <class Epi>
__device__ __forceinline__ void gemm128(const bf16_t* __restrict__ A, size_t lda, const int* rowsrc, int m0,
                                        const bf16_t* __restrict__ Bt, int K, char* lds, const Epi& epi) {
    int tid = threadIdx.x; asm volatile("" : "+v"(tid));
    const int wid = tid >> 6, lane = tid & 63, wr = wid >> 1, wc = wid & 1, fr = lane & 15, fq = lane >> 4;
    char* SA = lds; char* SB = lds + 8192;
    const bf16_t* ap[2]; const bf16_t* bp[2];
#pragma unroll
    for (int i = 0; i < 2; ++i) {
        const int b = tid * 16 + i * 4096, r = b >> 6, c = (b & 63) >> 1;
        const int arow = rowsrc ? rowsrc[r] : (m0 + r);
        ap[i] = A + (size_t)arow * lda + c; bp[i] = Bt + (size_t)r * K + c;
    }
    f32x4 acc[4][4];
#pragma unroll
    for (int m = 0; m < 4; ++m)
#pragma unroll
        for (int n = 0; n < 4; ++n) acc[m][n] = (f32x4){0.f, 0.f, 0.f, 0.f};
    for (int kt = 0; kt < K / 32; ++kt) {
#pragma unroll
        for (int i = 0; i < 2; ++i) {
            const int b = tid * 16 + i * 4096;
            __builtin_amdgcn_global_load_lds((const unsigned*)(ap[i] + kt * 32), (__attribute__((address_space(3))) unsigned*)(SA + b), 16, 0, 0);
            __builtin_amdgcn_global_load_lds((const unsigned*)(bp[i] + kt * 32), (__attribute__((address_space(3))) unsigned*)(SB + b), 16, 0, 0);
        }
        asm volatile("s_waitcnt vmcnt(0)" ::: "memory");
        __syncthreads();
        bf16x8 At[4], Bl[4];
#pragma unroll
        for (int m = 0; m < 4; ++m) At[m] = *(const bf16x8*)(SA + (wr * 64 + m * 16 + fr) * 64 + fq * 16);
#pragma unroll
        for (int n = 0; n < 4; ++n) Bl[n] = *(const bf16x8*)(SB + (wc * 64 + n * 16 + fr) * 64 + fq * 16);
#pragma unroll
        for (int m = 0; m < 4; ++m)
#pragma unroll
            for (int n = 0; n < 4; ++n) acc[m][n] = __builtin_amdgcn_mfma_f32_16x16x32_bf16(Bl[n], At[m], acc[m][n], 0, 0, 0);
        __syncthreads();
    }
    epi(acc, wr * 64 + fr, wc * 64 + 4 * fq);
}

struct EpiInProj {
    const Params* p; int l, m0, n0;
    __device__ __forceinline__ void operator()(const f32x4 (&acc)[4][4], int r0, int c0) const {
        const float* bias = p->binp + l * NPAD + n0;
        if (n0 == NMAIN) {
#pragma unroll
            for (int n = 0; n < 2; ++n) {
                const int c = c0 + n * 16;
                if (c < 22 + 3) {
#pragma unroll
                    for (int m = 0; m < 4; ++m) {
                        const int row = m0 + r0 + m * 16;
#pragma unroll
                        for (int j = 0; j < 4; ++j) if (c + j < 22) p->hs[(size_t)row * HS_W + c + j] = acc[m][n][j] + bias[c + j];
                    }
                }
            }
            return;
        }
        int vh = -1;
        if (n0 == 512) vh = 0; else if (n0 == 640) vh = 2; else if (n0 == 1280) vh = 4; else if (n0 == 2176) vh = 6; else if (n0 == 2432) vh = 8;
#pragma unroll
        for (int n = 0; n < 4; ++n) {
            const int c = c0 + n * 16;
            const f32x4 bv = *(const f32x4*)(bias + c);
#pragma unroll
            for (int m = 0; m < 4; ++m) {
                const int row = m0 + r0 + m * 16;
                const f32x4 v = acc[m][n] + bv;
                u32x2 w; w.x = pack2(v[0], v[1]); w.y = pack2(v[2], v[3]);
                *(u32x2*)(p->hb + (size_t)row * NMAIN + n0 + c) = w;
                if (vh >= 0) {
                    const int b = row >> 11, s = row & 2047, hh = vh + (c >> 6), d = c & 63;
                    bf16_t* vt = p->vT + (((size_t)b * NVH + hh) * 64 + d) * SEQ + s;
                    vt[0] = (bf16_t)(w.x & 0xffff); vt[SEQ] = (bf16_t)(w.x >> 16); vt[2 * SEQ] = (bf16_t)(w.y & 0xffff); vt[3 * SEQ] = (bf16_t)(w.y >> 16);
                }
            }
        }
    }
};
struct EpiOutProj {
    const float* xin; float* t; int m0, n0;
    __device__ __forceinline__ void operator()(const f32x4 (&acc)[4][4], int r0, int c0) const {
#pragma unroll
        for (int m = 0; m < 4; ++m)
#pragma unroll
            for (int n = 0; n < 4; ++n) {
                const size_t off = (size_t)(m0 + r0 + m * 16) * DM + n0 + c0 + n * 16;
                const f32x4 xv = *(const f32x4*)(xin + off);
                *(f32x4*)(t + off) = xv * ALPHA + acc[m][n];
            }
    }
};
struct EpiGateUp {
    bf16_t* act; const float* bias; int slot0, n0;
    __device__ __forceinline__ void operator()(const f32x4 (&acc)[4][4], int r0, int c0) const {
        const int wcb = c0 & 64, q4 = c0 & 63;
        const int fbase = ((n0 + wcb) >> 6) * 32;
#pragma unroll
        for (int n = 0; n < 2; ++n) {
            const f32x4 bg = *(const f32x4*)(bias + n0 + wcb + n * 16 + q4), bu = *(const f32x4*)(bias + n0 + wcb + 32 + n * 16 + q4);
#pragma unroll
            for (int m = 0; m < 4; ++m) {
                const f32x4 g4 = acc[m][n] + bg, u4 = acc[m][n + 2] + bu;
                float o[4];
#pragma unroll
                for (int j = 0; j < 4; ++j) {
                    const float g = fminf(g4[j], 7.0f), u = fminf(fmaxf(u4[j], -7.0f), 7.0f);
                    const float glu = g / (1.0f + __expf(-1.702f * g));
                    o[j] = (u + 1.0f) * glu;
                }
                u32x2 w; w.x = pack2(o[0], o[1]); w.y = pack2(o[2], o[3]);
                *(u32x2*)(act + (size_t)(slot0 + r0 + m * 16) * DFF + fbase + n * 16 + q4) = w;
            }
        }
    }
};
struct EpiDown {
    bf16_t* ybuf; const float* bias; const int* lst; int cnt, rb, n0;
    __device__ __forceinline__ void operator()(const f32x4 (&acc)[4][4], int r0, int c0) const {
#pragma unroll
        for (int m = 0; m < 4; ++m) {
            const int lr = rb * 128 + r0 + m * 16;
            if (lr < cnt) {
                const int a = lst[lr];
#pragma unroll
                for (int n = 0; n < 4; ++n) {
                    const int c = n0 + c0 + n * 16;
                    const f32x4 v = acc[m][n] + *(const f32x4*)(bias + c);
                    u32x2 w; w.x = pack2(v[0], v[1]); w.y = pack2(v[2], v[3]);
                    *(u32x2*)(ybuf + (size_t)a * DM + c) = w;
                }
            }
        }
    }
};

__device__ void phase_inproj(const Params& p, int l, char* lds) {
    constexpr int NT = NPAD / 128, MT = NTOK / 128;
    const bf16_t* W = p.WinT + (size_t)l * NPAD * 1024;
    for (int t = blockIdx.x; t < MT * NT; t += gridDim.x) {
        const int mt = t / NT, nt = t % NT;
        EpiInProj e{&p, l, mt * 128, nt * 128};
        gemm128(p.xb, DM, nullptr, mt * 128, W + (size_t)nt * 128 * 1024, 1024, lds, e);
    }
}
__device__ void phase_outproj(const Params& p, int l, const float* xin, char* lds) {
    constexpr int NT = 8, MT = NTOK / 128;
    const bf16_t* W = p.WoT + (size_t)l * 1024 * 1024;
    for (int t = blockIdx.x; t < MT * NT; t += gridDim.x) {
        const int mt = t / NT, nt = t % NT;
        EpiOutProj e{xin, p.tbuf, mt * 128, nt * 128};
        gemm128(p.ob, DM, nullptr, mt * 128, W + (size_t)nt * 128 * 1024, 1024, lds, e);
    }
}
__device__ __forceinline__ void build_tiles(const Params& p, int l, int* ptile, int* ecnt) {
    if (threadIdx.x < NE) ecnt[threadIdx.x] = (int)__hip_atomic_load(p.ctrl + 64 + l * NE + threadIdx.x, __ATOMIC_RELAXED, __HIP_MEMORY_SCOPE_AGENT);
    __syncthreads();
    if (threadIdx.x == 0) { int s = 0; for (int e = 0; e < NE; ++e) { ptile[e] = s; s += (ecnt[e] + 127) >> 7; } ptile[NE] = s; }
    __syncthreads();
}
__device__ void phase_gateup(const Params& p, int l, char* lds) {
    int* ptile = (int*)(lds + 16384); int* ecnt = ptile + 40; int* rows = ecnt + 40;
    build_tiles(p, l, ptile, ecnt);
    const int ntile = ptile[NE];
    for (int t = blockIdx.x; t < ntile * 16; t += gridDim.x) {
        const int rbt = t >> 4, nt = t & 15;
        int e = 0; while (ptile[e + 1] <= rbt) ++e;
        const int rb = rbt - ptile[e], cnt = ecnt[e];
        const int* lst = p.lists + (size_t)e * LIST_CAP;
        if (threadIdx.x < 128) { const int lr = rb * 128 + threadIdx.x; rows[threadIdx.x] = lr < cnt ? (lst[lr] >> 2) : 0; }
        __syncthreads();
        EpiGateUp ep{p.act, p.bgup + ((size_t)l * NE + e) * 2048, rbt * 128, nt * 128};
        gemm128(p.x1b, DM, rows, 0, p.WguT + (((size_t)l * NE + e) * 2048 + (size_t)nt * 128) * 1024, 1024, lds, ep);
    }
}
__device__ void phase_down(const Params& p, int l, char* lds) {
    int* ptile = (int*)(lds + 16384); int* ecnt = ptile + 40;
    build_tiles(p, l, ptile, ecnt);
    const int ntile = ptile[NE];
    for (int t = blockIdx.x; t < ntile * 8; t += gridDim.x) {
        const int rbt = t >> 3, nt = t & 7;
        int e = 0; while (ptile[e + 1] <= rbt) ++e;
        const int rb = rbt - ptile[e];
        EpiDown ep{p.ybuf, p.b_dn + ((size_t)l * NE + e) * 1024, p.lists + (size_t)e * LIST_CAP, ecnt[e], rb, nt * 128};
        gemm128(p.act, DFF, nullptr, rbt * 128, p.WdnT + (((size_t)l * NE + e) * 1024 + (size_t)nt * 128) * 1024, 1024, lds, ep);
    }
}

__device__ __forceinline__ float gelu_tanh(float x) {
    const float u = 0.7978845608028654f * (x + 0.044715f * x * x * x);
    const float e = __expf(-2.0f * fabsf(u)); const float th = (1.0f - e) / (1.0f + e);
    return 0.5f * x * (1.0f + (u < 0.f ? -th : th));
}
__device__ void phase_prep(const Params& p, int l, char* lds) {
    int tid = threadIdx.x; asm volatile("" : "+v"(tid));
    const int wid = tid >> 6, lane = tid & 63, fr = lane & 15, fq = lane >> 4;
    const int gw = blockIdx.x * 4 + wid, nw = gridDim.x * 4;
    for (int u = gw; u < NB * 4; u += nw) {
        const int b = u >> 2, h = u & 3;
        const float* src = p.hs + (size_t)b * SEQ * HS_W + h;
        float* dst = p.cF + (size_t)u * SEQ;
        float tot = 0.f;
        for (int i = 0; i < 32; ++i) { const float f = src[(size_t)(lane * 32 + i) * HS_W]; tot += fminf(f, 0.f) - log1pf(__expf(-fabsf(f))); }
        float inc = tot;
#pragma unroll
        for (int o = 1; o < 64; o <<= 1) { const float v = __shfl_up(inc, o); if (lane >= o) inc += v; }
        float run = inc - tot;
        for (int i = 0; i < 32; ++i) { const float f = src[(size_t)(lane * 32 + i) * HS_W]; run += fminf(f, 0.f) - log1pf(__expf(-fabsf(f))); dst[lane * 32 + i] = run; }
    }
    bf16_t* h1 = (bf16_t*)(lds + wid * 2048);
    for (int u = gw; u < NB * 2 * 2 * 8; u += nw) {
        const int ct = u & 7, which = (u >> 3) & 1, kvh = (u >> 4) & 1, b = u >> 5;
        const int colo = (which ? C_NVC : C_NKC) + kvh * 64;
        const int c_lane = ct * 16 + fr;
        const int tokbase = min(c_lane, 126) * 16;
        const bf16_t* arow = p.hb + ((size_t)b * SEQ + tokbase) * NMAIN + colo + fq * 8;
        const bf16_t* w1 = p.W1T + ((size_t)(l * 2 + which) * 64 + fr) * 2048 + fq * 8;
        f32x4 acc[4];
#pragma unroll
        for (int n = 0; n < 4; ++n) acc[n] = (f32x4){0.f, 0.f, 0.f, 0.f};
        for (int ks = 0; ks < 64; ++ks) {
            const bf16x8 a = *(const bf16x8*)(arow + (size_t)(ks >> 1) * NMAIN + (ks & 1) * 32);
#pragma unroll
            for (int n = 0; n < 4; ++n) {
                const bf16x8 bb = *(const bf16x8*)(w1 + (size_t)n * 16 * 2048 + ks * 32);
                acc[n] = __builtin_amdgcn_mfma_f32_16x16x32_bf16(a, bb, acc[n], 0, 0, 0);
            }
        }
        const float* b1 = p.b1c + (l * 2 + which) * 64;
#pragma unroll
        for (int n = 0; n < 4; ++n)
#pragma unroll
            for (int r = 0; r < 4; ++r) h1[(fq * 4 + r) * 64 + n * 16 + fr] = f2bf(gelu_tanh(acc[n][r] + b1[n * 16 + fr]));
        lds_wave_sync();
        const bf16_t* w2 = p.W2T + ((size_t)(l * 2 + which) * 64 + fr) * 64 + fq * 8;
        f32x4 o2[4];
#pragma unroll
        for (int n = 0; n < 4; ++n) o2[n] = (f32x4){0.f, 0.f, 0.f, 0.f};
#pragma unroll
        for (int ks = 0; ks < 2; ++ks) {
            const bf16x8 a = *(const bf16x8*)(h1 + fr * 64 + ks * 32 + fq * 8);
#pragma unroll
            for (int n = 0; n < 4; ++n) {
                const bf16x8 bb = *(const bf16x8*)(w2 + (size_t)n * 16 * 64 + ks * 32);
                o2[n] = __builtin_amdgcn_mfma_f32_16x16x32_bf16(a, bb, o2[n], 0, 0, 0);
            }
        }
        lds_wave_sync();
        const size_t base = ((size_t)b * 2 + kvh) * 128 * 64;
#pragma unroll
        for (int n = 0; n < 4; ++n)
#pragma unroll
            for (int r = 0; r < 4; ++r) {
                const int c = ct * 16 + fq * 4 + r, j2 = n * 16 + fr;
                const bf16_t v = c < 127 ? f2bf(o2[n][r]) : (bf16_t)0;
                if (which == 0) p.kc[base + (size_t)c * 64 + j2] = v;
                else { p.vc[base + (size_t)c * 64 + j2] = v; p.vcT[base + (size_t)j2 * 128 + c] = v; }
            }
    }
}

__device__ __forceinline__ void load_q(const bf16_t* qp, float* q, int lane) {
    q[lane] = bf2f(qp[lane]) * QSCALE;
    lds_wave_sync();
}
__device__ __forceinline__ float dot_q(const bf16_t* kp, const float* q) {
    float s = 0.f;
#pragma unroll
    for (int i = 0; i < 8; ++i) {
        const u32x4 w = *(const u32x4*)(kp + i * 8);
        const float4 qa = *(const float4*)(q + i * 8), qb = *(const float4*)(q + i * 8 + 4);
        s += qa.x * __uint_as_float(w.x << 16) + qa.y * __uint_as_float(w.x & 0xffff0000u)
           + qa.z * __uint_as_float(w.y << 16) + qa.w * __uint_as_float(w.y & 0xffff0000u)
           + qb.x * __uint_as_float(w.z << 16) + qb.y * __uint_as_float(w.z & 0xffff0000u)
           + qb.z * __uint_as_float(w.w << 16) + qb.w * __uint_as_float(w.w & 0xffff0000u);
    }
    return s;
}
constexpr float NEG_INF = -__builtin_huge_valf();
template <class BF>
__device__ __forceinline__ float score_keys(const float* q, const bf16_t* Kb, size_t ld, int s_lo, int cnt, float* sc, int lane, const BF& bf) {
    float mx = NEG_INF;
    for (int i = lane; i < cnt; i += 64) {
        const int s = s_lo + i; float bias; const bool ok = bf(s, bias);
        float v = NEG_INF;
        if (ok) v = dot_q(Kb + (size_t)s * ld, q) + bias;
        sc[i] = v; mx = fmaxf(mx, v);
    }
    return mx;
}
__device__ __forceinline__ float softmax_lds(float* sc, int n, float mx, int lane) {
    float sum = 0.f;
    for (int i = lane; i < n; i += 64) { const float v = sc[i]; const float e = (v == NEG_INF) ? 0.f : __expf(v - mx); sc[i] = e; sum += e; }
    sum = wave_sum(sum);
    lds_wave_sync();
    return sum;
}
__device__ __forceinline__ float pv_keys(const bf16_t* Vb, size_t ld, int s_lo, int cnt, const float* sc, int lane, float o) {
    for (int i = 0; i < cnt; ++i) { const float pr = sc[i]; if (pr != 0.f) o += pr * bf2f(Vb[(size_t)(s_lo + i) * ld + lane]); }
    return o;
}

__device__ void phase_attn_naive(const Params& p, int l, char* lds) {
    int tid = threadIdx.x; asm volatile("" : "+v"(tid));
    const int wid = tid >> 6, lane = tid & 63;
    float* sc = (float*)(lds + wid * 9216);
    float* q = sc + 2176;
    const int gwv = blockIdx.x * 4 + wid, nw = gridDim.x * 4;
    for (int u = gwv; u < NTOK * 4; u += nw) {
        const int h = u & 3, tok = u >> 2, b = tok >> 11, t = tok & 2047;
        load_q(p.hb + (size_t)tok * NMAIN + C_FQ + h * 64, q, lane);
        const float* c = p.cF + ((size_t)b * 4 + h) * SEQ; const float ct = c[t];
        const bf16_t* Kb = p.hb + (size_t)b * SEQ * NMAIN + C_FK + h * 64;
        const bf16_t* Vb = p.hb + (size_t)b * SEQ * NMAIN + C_FV + h * 64;
        float mx = score_keys(q, Kb, NMAIN, 0, t + 1, sc, lane, [&](int s, float& bias) { bias = ct - c[s]; return true; });
        mx = wave_max(mx);
        const float sum = softmax_lds(sc, t + 1, mx, lane);
        const float o = pv_keys(Vb, NMAIN, 0, t + 1, sc, lane, 0.f);
        p.ob[(size_t)tok * DM + h * 64 + lane] = f2bf(o / sum);
        lds_wave_sync();
    }
    for (int u = gwv; u < NTOK * 6; u += nw) {
        const int hq = u % 6, tok = u / 6, b = tok >> 11, t = tok & 2047, kv = hq / 3;
        load_q(p.hb + (size_t)tok * NMAIN + C_SQ + hq * 64, q, lane);
        const float sl = slope_swa(hq), sink = p.sinks[l * 6 + hq];
        const bf16_t* Kb = p.hb + (size_t)b * SEQ * NMAIN + C_SK + kv * 64;
        const bf16_t* Vb = p.hb + (size_t)b * SEQ * NMAIN + C_SV + kv * 64;
        const int s_lo = max(0, t - 127), cnt = t - s_lo + 1;
        float mx = score_keys(q, Kb, NMAIN, s_lo, cnt, sc, lane, [&](int s, float& bias) { bias = -sl * (float)(t - s); return true; });
        mx = fmaxf(wave_max(mx), sink);
        const float sum = softmax_lds(sc, cnt, mx, lane) + __expf(sink - mx);
        const float o = pv_keys(Vb, NMAIN, s_lo, cnt, sc, lane, 0.f);
        p.ob[(size_t)tok * DM + 256 + hq * 64 + lane] = f2bf(o / sum);
        lds_wave_sync();
    }
    for (int u = gwv; u < NTOK * 2; u += nw) {
        const int kv = u & 1, tok = u >> 1, b = tok >> 11, t = tok & 2047;
        const int ncv = t >= 31 ? ((t - 31) >> 4) + 1 : 0, cur = t >> 6;
        const bf16_t* Kc = p.kc + ((size_t)b * 2 + kv) * 128 * 64;
        const bf16_t* Vc = p.vc + ((size_t)b * 2 + kv) * 128 * 64;
        float pslc = 0.f;
        for (int g = 0; g < 3; ++g) {
            const int hq = kv * 3 + g; const float sl = slope_nsa(hq);
            load_q(p.hb + (size_t)tok * NMAIN + C_NQ + hq * 64, q, lane);
            float mx = score_keys(q, Kc, 64, 0, ncv, sc, lane, [&](int c, float& bias) { bias = -sl * (float)(t - (16 * c + 31)); return true; });
            for (int i = ncv + lane; i < 132; i += 64) sc[i] = NEG_INF;
            mx = wave_max(mx);
            const float sum = softmax_lds(sc, 132, mx, lane);
            if (lane < 32 && ncv > 0) {
                const int n = lane; float a = sc[4 * n] + sc[4 * n + 1] + sc[4 * n + 2] + 0.5f * sc[4 * n + 3];
                if (n > 0) a += 0.5f * sc[4 * n - 1];
                pslc += a / sum;
            }
            lds_wave_sync();
        }
        unsigned mask = 1u | (1u << cur); if (cur >= 1) mask |= 1u << (cur - 1);
        if (cur >= 3) {
            const int ncand = cur - 2;
            if (ncand <= 5) { for (int j = 1; j <= cur - 2; ++j) mask |= 1u << j; }
            else {
                for (int r = 0; r < 5; ++r) {
                    const bool cand = lane >= 1 && lane <= cur - 2 && !((mask >> lane) & 1u);
                    const float v = cand ? pslc : -1.0f;
                    const float mxv = wave_max(v);
                    const unsigned long long bal = __ballot(cand && v == mxv);
                    const int pick = bal ? (int)__builtin_ctzll(bal) : 0;
                    mask |= 1u << pick;
                }
            }
        }
        for (int g = 0; g < 3; ++g) {
            const int hq = kv * 3 + g; const float sl = slope_nsa(hq);
            load_q(p.hb + (size_t)tok * NMAIN + C_NQ + hq * 64, q, lane);
            const float* gl = p.hs + (size_t)tok * HS_W + 4 + hq * 3;
            const float g0 = 1.f / (1.f + __expf(-gl[0])), g1 = 1.f / (1.f + __expf(-gl[1])), g2 = 1.f / (1.f + __expf(-gl[2]));
            float outv = 0.f;
            if (ncv > 0) {
                float mx = score_keys(q, Kc, 64, 0, ncv, sc, lane, [&](int c, float& bias) { bias = -sl * (float)(t - (16 * c + 31)); return true; });
                mx = wave_max(mx);
                const float sum = softmax_lds(sc, ncv, mx, lane);
                const float o = pv_keys(Vc, 64, 0, ncv, sc, lane, 0.f);
                outv += g0 * o / sum;
                lds_wave_sync();
            }
            {
                const bf16_t* Kb = p.hb + (size_t)b * SEQ * NMAIN + C_NKS + kv * 64;
                const bf16_t* Vb = p.hb + (size_t)b * SEQ * NMAIN + C_NVS + kv * 64;
                float mx = NEG_INF; int nb = 0;
                for (int j = 0; j <= cur; ++j) if ((mask >> j) & 1u) {
                    mx = fmaxf(mx, score_keys(q, Kb, NMAIN, j * 64, 64, sc + nb * 64, lane, [&](int s, float& bias) { bias = -sl * (float)(t - s); return s <= t; }));
                    ++nb;
                }
                mx = wave_max(mx);
                const float sum = softmax_lds(sc, nb * 64, mx, lane);
                float o = 0.f; nb = 0;
                for (int j = 0; j <= cur; ++j) if ((mask >> j) & 1u) { o = pv_keys(Vb, NMAIN, j * 64, 64, sc + nb * 64, lane, o); ++nb; }
                outv += g1 * o / sum;
                lds_wave_sync();
            }
            {
                const bf16_t* Kb = p.hb + (size_t)b * SEQ * NMAIN + C_NKW + kv * 64;
                const bf16_t* Vb = p.hb + (size_t)b * SEQ * NMAIN + C_NVW + kv * 64;
                const int s_lo = max(0, t - 511), cnt = t - s_lo + 1;
                float mx = score_keys(q, Kb, NMAIN, s_lo, cnt, sc, lane, [&](int s, float& bias) { bias = -sl * (float)(t - s); return true; });
                mx = wave_max(mx);
                const float sum = softmax_lds(sc, cnt, mx, lane);
                const float o = pv_keys(Vb, NMAIN, s_lo, cnt, sc, lane, 0.f);
                outv += g2 * o / sum;
                lds_wave_sync();
            }
            p.ob[(size_t)tok * DM + 640 + hq * 64 + lane] = f2bf(outv);
        }
    }
}

constexpr float L2E = 1.4426950408889634f, MASKV = -1e30f, SCL2 = QSCALE * L2E;
template <int NQT, class MB>
__device__ __forceinline__ void attn_chunk(const bf16_t* __restrict__ Kb, size_t ldk, const bf16_t* __restrict__ VTb, size_t ldv, int kc0,
                                           const bf16x8 (&qf)[NQT][2], f32x4 (&o)[NQT][4], float (&m)[NQT], float (&l)[NQT], int fr, int fq, const MB& mb) {
    const bf16_t* kp = Kb + (size_t)(kc0 + (fr >> 2) * 8 + (fr & 3)) * ldk + fq * 8;
    bf16x8 kf[2][2];
    kf[0][0] = *(const bf16x8*)(kp); kf[0][1] = *(const bf16x8*)(kp + 32);
    kf[1][0] = *(const bf16x8*)(kp + 4 * ldk); kf[1][1] = *(const bf16x8*)(kp + 4 * ldk + 32);
    const bf16_t* vp = VTb + (size_t)fr * ldv + kc0 + fq * 8;
    bf16x8 vf[4];
#pragma unroll
    for (int dt = 0; dt < 4; ++dt) vf[dt] = *(const bf16x8*)(vp + (size_t)dt * 16 * ldv);
#pragma unroll
    for (int qt = 0; qt < NQT; ++qt) {
        f32x4 s0 = (f32x4){0.f, 0.f, 0.f, 0.f}, s1 = s0;
        s0 = __builtin_amdgcn_mfma_f32_16x16x32_bf16(kf[0][0], qf[qt][0], s0, 0, 0, 0);
        s0 = __builtin_amdgcn_mfma_f32_16x16x32_bf16(kf[0][1], qf[qt][1], s0, 0, 0, 0);
        s1 = __builtin_amdgcn_mfma_f32_16x16x32_bf16(kf[1][0], qf[qt][0], s1, 0, 0, 0);
        s1 = __builtin_amdgcn_mfma_f32_16x16x32_bf16(kf[1][1], qf[qt][1], s1, 0, 0, 0);
        float v[8];
#pragma unroll
        for (int j = 0; j < 4; ++j) { v[j] = mb(qt, j, s0[j]); v[j + 4] = mb(qt, j + 4, s1[j]); }
        float mx = fmaxf(fmaxf(fmaxf(v[0], v[1]), fmaxf(v[2], v[3])), fmaxf(fmaxf(v[4], v[5]), fmaxf(v[6], v[7])));
        mx = fmaxf(mx, __shfl_xor(mx, 16)); mx = fmaxf(mx, __shfl_xor(mx, 32));
        const float mnew = fmaxf(m[qt], mx);
        const float alpha = __builtin_amdgcn_exp2f(m[qt] - mnew);
        m[qt] = mnew;
        float pr[8]; float ps = 0.f;
#pragma unroll
        for (int j = 0; j < 8; ++j) { pr[j] = v[j] > -1e29f ? __builtin_amdgcn_exp2f(v[j] - mnew) : 0.f; ps += pr[j]; }
        l[qt] = l[qt] * alpha + ps;
#pragma unroll
        for (int dt = 0; dt < 4; ++dt) o[qt][dt] *= alpha;
        union { bf16x8 v8; unsigned u[4]; } pf;
        pf.u[0] = pack2(pr[0], pr[1]); pf.u[1] = pack2(pr[2], pr[3]); pf.u[2] = pack2(pr[4], pr[5]); pf.u[3] = pack2(pr[6], pr[7]);
#pragma unroll
        for (int dt = 0; dt < 4; ++dt) o[qt][dt] = __builtin_amdgcn_mfma_f32_16x16x32_bf16(vf[dt], pf.v8, o[qt][dt], 0, 0, 0);
        __builtin_amdgcn_sched_barrier(0);
    }
}
template <int NQT>
__device__ __forceinline__ void attn_init(f32x4 (&o)[NQT][4], float (&m)[NQT], float (&l)[NQT]) {
#pragma unroll
    for (int qt = 0; qt < NQT; ++qt) { m[qt] = MASKV; l[qt] = 0.f;
#pragma unroll
        for (int dt = 0; dt < 4; ++dt) o[qt][dt] = (f32x4){0.f, 0.f, 0.f, 0.f}; }
}
__device__ __forceinline__ float lsum4(float l) { l += __shfl_xor(l, 16); l += __shfl_xor(l, 32); return l; }
__device__ __forceinline__ void store_o4(bf16_t* dst, const f32x4 v) { u32x2 w; w.x = pack2(v[0], v[1]); w.y = pack2(v[2], v[3]); *(u32x2*)dst = w; }

__device__ __forceinline__ void fox_unit(const Params& p, int b, int h, int qb, int fr, int fq) {
    const int t0 = qb * 64;
    const bf16_t* Qb = p.hb + ((size_t)b * SEQ + t0) * NMAIN + C_FQ + h * 64 + fq * 8;
    bf16x8 qf[4][2];
#pragma unroll
    for (int qt = 0; qt < 4; ++qt) { qf[qt][0] = *(const bf16x8*)(Qb + (size_t)(qt * 16 + fr) * NMAIN); qf[qt][1] = *(const bf16x8*)(Qb + (size_t)(qt * 16 + fr) * NMAIN + 32); }
    const float* cf = p.cF + ((size_t)b * 4 + h) * SEQ;
    float cq[4];
#pragma unroll
    for (int qt = 0; qt < 4; ++qt) cq[qt] = cf[t0 + qt * 16 + fr] * L2E;
    f32x4 o[4][4]; float m[4], l[4];
    attn_init<4>(o, m, l);
    const bf16_t* Kb = p.hb + (size_t)b * SEQ * NMAIN + C_FK + h * 64;
    const bf16_t* VTb = p.vT + ((size_t)b * NVH + h) * 64 * SEQ;
    const int nchunk = (t0 + 64) >> 5;
    for (int c = 0; c < nchunk; ++c) {
        const int kc0 = c * 32;
        const float4 ca = *(const float4*)(cf + kc0 + 8 * fq), cb = *(const float4*)(cf + kc0 + 8 * fq + 4);
        const float ck[8] = {ca.x * L2E, ca.y * L2E, ca.z * L2E, ca.w * L2E, cb.x * L2E, cb.y * L2E, cb.z * L2E, cb.w * L2E};
        const bool diag = kc0 + 31 > t0;
        const int kq = kc0 + 8 * fq - t0 - fr;
        attn_chunk<4>(Kb, NMAIN, VTb, SEQ, kc0, qf, o, m, l, fr, fq, [&](int qt, int j, float raw) {
            float v = raw * SCL2 + cq[qt] - ck[j];
            if (diag && (kq + j - 16 * qt) > 0) v = MASKV;
            return v; });
    }
#pragma unroll
    for (int qt = 0; qt < 4; ++qt) {
        const float inv = 1.0f / lsum4(l[qt]);
        bf16_t* dst = p.ob + ((size_t)b * SEQ + t0 + qt * 16 + fr) * DM + h * 64 + 4 * fq;
#pragma unroll
        for (int dt = 0; dt < 4; ++dt) store_o4(dst + dt * 16, o[qt][dt] * inv);
    }
}
__device__ __forceinline__ void swa_unit(const Params& p, int l_, int b, int kv, int pos, int fr, int fq) {
    const int t0 = pos * 16, t = t0 + fr;
    const bf16_t* Qb = p.hb + ((size_t)b * SEQ + t) * NMAIN + C_SQ + kv * 192 + fq * 8;
    bf16x8 qf[3][2];
#pragma unroll
    for (int g = 0; g < 3; ++g) { qf[g][0] = *(const bf16x8*)(Qb + g * 64); qf[g][1] = *(const bf16x8*)(Qb + g * 64 + 32); }
    float sl[3];
#pragma unroll
    for (int g = 0; g < 3; ++g) sl[g] = slope_swa(kv * 3 + g) * L2E;
    f32x4 o[3][4]; float m[3], l[3];
    attn_init<3>(o, m, l);
    const bf16_t* Kb = p.hb + (size_t)b * SEQ * NMAIN + C_SK + kv * 64;
    const bf16_t* VTb = p.vT + ((size_t)b * NVH + 4 + kv) * 64 * SEQ;
    const int c_lo = max(0, t0 - 127) >> 5, c_hi = (t0 + 15) >> 5;
    for (int c = c_lo; c <= c_hi; ++c) {
        const int kc0 = c * 32, dq = t - kc0 - 8 * fq;
        attn_chunk<3>(Kb, NMAIN, VTb, SEQ, kc0, qf, o, m, l, fr, fq, [&](int g, int j, float raw) {
            const int dist = dq - j;
            return (dist >= 0 && dist < 128) ? raw * SCL2 - sl[g] * (float)dist : MASKV; });
    }
#pragma unroll
    for (int g = 0; g < 3; ++g) {
        const float sink = p.sinks[l_ * 6 + kv * 3 + g] * L2E;
        const float inv = 1.0f / (lsum4(l[g]) + __builtin_amdgcn_exp2f(sink - m[g]));
        bf16_t* dst = p.ob + ((size_t)b * SEQ + t) * DM + 256 + (kv * 3 + g) * 64 + 4 * fq;
#pragma unroll
        for (int dt = 0; dt < 4; ++dt) store_o4(dst + dt * 16, o[g][dt] * inv);
    }
}
__device__ __forceinline__ void nsa_unit(const Params& p, int b, int kv, int pos, int fr, int fq, int lane, float* ps, unsigned* msk, float* otl) {
    const int t0 = pos * 16, t = t0 + fr, cur = t0 >> 6;
    const bf16_t* Qb = p.hb + ((size_t)b * SEQ + t) * NMAIN + C_NQ + kv * 192 + fq * 8;
    bf16x8 qf[3][2];
#pragma unroll
    for (int g = 0; g < 3; ++g) { qf[g][0] = *(const bf16x8*)(Qb + g * 64); qf[g][1] = *(const bf16x8*)(Qb + g * 64 + 32); }
    float sl[3];
#pragma unroll
    for (int g = 0; g < 3; ++g) sl[g] = slope_nsa(kv * 3 + g) * L2E;
    const float* gl = p.hs + ((size_t)b * SEQ + t) * HS_W + 4 + kv * 9;
    f32x4 o[3][4]; float m[3], l[3];
    f32x4* otv = (f32x4*)otl + lane;
#pragma unroll
    for (int i = 0; i < 8; ++i) ps[lane + 64 * i] = 0.f;
    {
        const bf16_t* Kb = p.kc + ((size_t)b * 2 + kv) * 128 * 64;
        const bf16_t* VTb = p.vcT + ((size_t)b * 2 + kv) * 64 * 128;
        const int ncv = (t0 + 15 >= 31) ? ((t0 + 15 - 31) >> 4) + 1 : 0;
        const int nch = (ncv + 31) >> 5;
        attn_init<3>(o, m, l);
        const int dq0 = t - 31 - 16 * 8 * fq;
        for (int c = 0; c < nch; ++c) {
            const int kc0 = c * 32, dq = dq0 - 16 * kc0;
            attn_chunk<3>(Kb, 64, VTb, 128, kc0, qf, o, m, l, fr, fq, [&](int g, int j, float raw) {
                const int dist = dq - 16 * j;
                return dist >= 0 ? raw * SCL2 - sl[g] * (float)dist : MASKV; });
        }
        float il[3];
#pragma unroll
        for (int g = 0; g < 3; ++g) {
            const float lt = lsum4(l[g]); il[g] = lt > 0.f ? 1.0f / lt : 0.f;
            const float gate = 1.0f / (1.0f + __expf(-gl[g * 3 + 0]));
#pragma unroll
            for (int dt = 0; dt < 4; ++dt) otv[(g * 4 + dt) * 64] = o[g][dt] * (il[g] * gate);
        }
        float carry_prev = 0.f;
        for (int c = 0; c < nch; ++c) {
            const int kc0 = c * 32, dq = dq0 - 16 * kc0;
            const bf16_t* kp = Kb + (size_t)(kc0 + (fr >> 2) * 8 + (fr & 3)) * 64 + fq * 8;
            const bf16x8 k00 = *(const bf16x8*)(kp), k01 = *(const bf16x8*)(kp + 32), k10 = *(const bf16x8*)(kp + 256), k11 = *(const bf16x8*)(kp + 256 + 32);
            float pc[8];
#pragma unroll
            for (int j = 0; j < 8; ++j) pc[j] = 0.f;
#pragma unroll
            for (int g = 0; g < 3; ++g) {
                f32x4 s0 = (f32x4){0.f, 0.f, 0.f, 0.f}, s1 = s0;
                s0 = __builtin_amdgcn_mfma_f32_16x16x32_bf16(k00, qf[g][0], s0, 0, 0, 0); s0 = __builtin_amdgcn_mfma_f32_16x16x32_bf16(k01, qf[g][1], s0, 0, 0, 0);
                s1 = __builtin_amdgcn_mfma_f32_16x16x32_bf16(k10, qf[g][0], s1, 0, 0, 0); s1 = __builtin_amdgcn_mfma_f32_16x16x32_bf16(k11, qf[g][1], s1, 0, 0, 0);
#pragma unroll
                for (int j = 0; j < 8; ++j) {
                    const int dist = dq - 16 * j; const float raw = j < 4 ? s0[j] : s1[j - 4];
                    if (dist >= 0) pc[j] += __builtin_amdgcn_exp2f(raw * SCL2 - sl[g] * (float)dist - m[g]) * il[g];
                }
            }
            const float cout = 0.5f * pc[7];
            float cin = __shfl_up(cout, 16);
            const float cwrap = __shfl(cout, fr + 48);
            if (fq == 0) cin = carry_prev;
            carry_prev = cwrap;
            const int n0 = (kc0 >> 2) + 2 * fq;
            ps[fr * 32 + n0] = cin + pc[0] + pc[1] + pc[2] + 0.5f * pc[3];
            ps[fr * 32 + n0 + 1] = 0.5f * pc[3] + pc[4] + pc[5] + pc[6] + 0.5f * pc[7];
        }
    }
    lds_wave_sync();
    if (lane < 16) {
        unsigned mask = 1u | (1u << cur); if (cur >= 1) mask |= 1u << (cur - 1);
        if (cur >= 3) {
            if (cur - 2 <= 5) mask |= (1u << (cur - 1)) - 2u;
            else {
                const float* my = ps + lane * 32;
                for (int r = 0; r < 5; ++r) {
                    float best = -1.0f; int bi = 1;
                    for (int j = 1; j <= cur - 2; ++j) { const float v = my[j]; if (!((mask >> j) & 1u) && v > best) { best = v; bi = j; } }
                    mask |= 1u << bi;
                }
            }
        }
        msk[lane] = mask;
    }
    lds_wave_sync();
    const unsigned qmask = msk[fr];
    lds_wave_sync();
    {
        const bf16_t* Kb = p.hb + (size_t)b * SEQ * NMAIN + C_NKS + kv * 64;
        const bf16_t* VTb = p.vT + ((size_t)b * NVH + 6 + kv) * 64 * SEQ;
        attn_init<3>(o, m, l);
        for (int kb = 0; kb <= cur; ++kb) {
            const bool mine = (qmask >> kb) & 1u;
            if (__ballot(mine) == 0ull) continue;
#pragma unroll 1
            for (int hc = 0; hc < 2; ++hc) {
                const int kc0 = kb * 64 + hc * 32, dq = t - kc0 - 8 * fq;
                attn_chunk<3>(Kb, NMAIN, VTb, SEQ, kc0, qf, o, m, l, fr, fq, [&](int g, int j, float raw) {
                    const int dist = dq - j;
                    return (mine && dist >= 0) ? raw * SCL2 - sl[g] * (float)dist : MASKV; });
            }
        }
#pragma unroll
        for (int g = 0; g < 3; ++g) {
            const float lt = lsum4(l[g]); const float sc = (lt > 0.f ? 1.0f / lt : 0.f) / (1.0f + __expf(-gl[g * 3 + 1]));
#pragma unroll
            for (int dt = 0; dt < 4; ++dt) otv[(g * 4 + dt) * 64] += o[g][dt] * sc;
        }
    }
    {
        const bf16_t* Kb = p.hb + (size_t)b * SEQ * NMAIN + C_NKW + kv * 64;
        const bf16_t* VTb = p.vT + ((size_t)b * NVH + 8 + kv) * 64 * SEQ;
        attn_init<3>(o, m, l);
        const int c_lo = max(0, t0 - 511) >> 5, c_hi = (t0 + 15) >> 5;
        for (int c = c_lo; c <= c_hi; ++c) {
            const int kc0 = c * 32, dq = t - kc0 - 8 * fq;
            attn_chunk<3>(Kb, NMAIN, VTb, SEQ, kc0, qf, o, m, l, fr, fq, [&](int g, int j, float raw) {
                const int dist = dq - j;
                return (dist >= 0 && dist < 512) ? raw * SCL2 - sl[g] * (float)dist : MASKV; });
        }
#pragma unroll
        for (int g = 0; g < 3; ++g) {
            const float lt = lsum4(l[g]); const float sc = (lt > 0.f ? 1.0f / lt : 0.f) / (1.0f + __expf(-gl[g * 3 + 2]));
            bf16_t* dst = p.ob + ((size_t)b * SEQ + t) * DM + 640 + (kv * 3 + g) * 64 + 4 * fq;
#pragma unroll
            for (int dt = 0; dt < 4; ++dt) store_o4(dst + dt * 16, otv[(g * 4 + dt) * 64] + o[g][dt] * sc);
        }
    }
}

__device__ void phase_attn(const Params& p, int l, char* lds) {
    int tid = threadIdx.x; asm volatile("" : "+v"(tid));
    const int wid = tid >> 6, lane = tid & 63, fr = lane & 15, fq = lane >> 4;
    float* ps = (float*)(lds + wid * 14592); unsigned* msk = (unsigned*)(ps + 512); float* otl = ps + 576;
    unsigned* ctr = p.ctrl + 16 + l;
    constexpr unsigned NU_NSA = NB * 2 * 128, NU_FOX = NB * 4 * 32, NU_SWA = NB * 2 * 128;
    for (;;) {
        unsigned u = 0;
        if (lane == 0) u = __hip_atomic_fetch_add(ctr, 1u, __ATOMIC_RELAXED, __HIP_MEMORY_SCOPE_AGENT);
        u = (unsigned)__builtin_amdgcn_readfirstlane((int)u);
        if (u >= NU_NSA + NU_FOX + NU_SWA) break;
        if (u < NU_NSA) { const int pos = 127 - (int)(u >> 5), r = u & 31; nsa_unit(p, r >> 1, r & 1, pos, fr, fq, lane, ps, msk, otl); }
        else if (u < NU_NSA + NU_FOX) { const unsigned v = u - NU_NSA; const int qb = 31 - (int)(v >> 6), r = v & 63; fox_unit(p, r >> 2, r & 3, qb, fr, fq); }
        else { const unsigned v = u - NU_NSA - NU_FOX; const int pos = 127 - (int)(v >> 5), r = v & 31; swa_unit(p, l, r >> 1, r & 1, pos, fr, fq); }
    }
}

__device__ void phase_ln1_router(const Params& p, int l, char* lds) {
    int tid = threadIdx.x; asm volatile("" : "+v"(tid));
    const int wid = tid >> 6, lane = tid & 63, fr = lane & 15, fq = lane >> 4;
    float* lg = (float*)lds + wid * 512;
    int* lcnt = (int*)(lds + 8192); int* lbase = lcnt + 32;
    const float* g1 = p.ln1_g + l * DM; const float* b1 = p.ln1_b + l * DM;
    const float* rw = p.rwT + (size_t)l * NE * 1024; const float* rb = p.router_b + l * NE;
    unsigned* gcount = p.ctrl + 64 + l * NE;
    for (int grp = blockIdx.x; grp < NTOK / 64; grp += gridDim.x) {
        const int tok0 = grp * 64 + wid * 16;
        if (tid < 32) lcnt[tid] = 0;
        for (int r = 0; r < 16; ++r) {
            const size_t row = (size_t)(tok0 + r);
            float4 v[4]; float s = 0.f;
#pragma unroll
            for (int j = 0; j < 4; ++j) { v[j] = *(const float4*)(p.tbuf + row * DM + j * 256 + lane * 4); s += (v[j].x + v[j].y) + (v[j].z + v[j].w); }
            const float mean = wave_sum(s) * (1.0f / 1024.0f);
            float qv = 0.f;
#pragma unroll
            for (int j = 0; j < 4; ++j) { v[j].x -= mean; v[j].y -= mean; v[j].z -= mean; v[j].w -= mean; qv += (v[j].x * v[j].x + v[j].y * v[j].y) + (v[j].z * v[j].z + v[j].w * v[j].w); }
            const float rstd = rsqrtf(wave_sum(qv) * (1.0f / 1024.0f) + LN_EPS);
#pragma unroll
            for (int j = 0; j < 4; ++j) {
                const int c = j * 256 + lane * 4;
                const float4 gg = *(const float4*)(g1 + c), bb = *(const float4*)(b1 + c);
                float4 y; y.x = v[j].x * rstd * gg.x + bb.x; y.y = v[j].y * rstd * gg.y + bb.y; y.z = v[j].z * rstd * gg.z + bb.z; y.w = v[j].w * rstd * gg.w + bb.w;
                *(float4*)(p.x1f + row * DM + c) = y;
                u32x2 w; w.x = pack2(y.x, y.y); w.y = pack2(y.z, y.w);
                *(u32x2*)(p.x1b + row * DM + c) = w;
            }
        }
        __syncthreads();
        f32x4 a0 = (f32x4){0.f, 0.f, 0.f, 0.f}, a1 = a0;
        const float* xr = p.x1f + (size_t)(tok0 + fr) * DM + 4 * fq;
        const float* w0 = rw + (size_t)fr * 1024 + 4 * fq; const float* w1 = rw + (size_t)(16 + fr) * 1024 + 4 * fq;
        for (int k0 = 0; k0 < 1024; k0 += 16) {
            const float4 xa = *(const float4*)(xr + k0), wb0 = *(const float4*)(w0 + k0), wb1 = *(const float4*)(w1 + k0);
            a0 = __builtin_amdgcn_mfma_f32_16x16x4f32(xa.x, wb0.x, a0, 0, 0, 0); a1 = __builtin_amdgcn_mfma_f32_16x16x4f32(xa.x, wb1.x, a1, 0, 0, 0);
            a0 = __builtin_amdgcn_mfma_f32_16x16x4f32(xa.y, wb0.y, a0, 0, 0, 0); a1 = __builtin_amdgcn_mfma_f32_16x16x4f32(xa.y, wb1.y, a1, 0, 0, 0);
            a0 = __builtin_amdgcn_mfma_f32_16x16x4f32(xa.z, wb0.z, a0, 0, 0, 0); a1 = __builtin_amdgcn_mfma_f32_16x16x4f32(xa.z, wb1.z, a1, 0, 0, 0);
            a0 = __builtin_amdgcn_mfma_f32_16x16x4f32(xa.w, wb0.w, a0, 0, 0, 0); a1 = __builtin_amdgcn_mfma_f32_16x16x4f32(xa.w, wb1.w, a1, 0, 0, 0);
        }
#pragma unroll
        for (int r = 0; r < 4; ++r) { lg[(fq * 4 + r) * 32 + fr] = a0[r] + rb[fr]; lg[(fq * 4 + r) * 32 + 16 + fr] = a1[r] + rb[16 + fr]; }
        lds_wave_sync();
        int e4[4] = {0, 0, 0, 0}; int rk[4] = {0, 0, 0, 0};
        if (lane < 16) {
            const float* my = lg + lane * 32; unsigned taken = 0u; float tv[4];
#pragma unroll
            for (int k = 0; k < 4; ++k) {
                float best = NEG_INF; int bi = 0;
                for (int e = 0; e < 32; ++e) { const float xv = my[e]; if (!((taken >> e) & 1u) && xv > best) { best = xv; bi = e; } }
                taken |= 1u << bi; e4[k] = bi; tv[k] = best;
            }
            const float e1 = __expf(tv[1] - tv[0]), e2 = __expf(tv[2] - tv[0]), e3 = __expf(tv[3] - tv[0]);
            const float inv = 1.0f / (1.0f + e1 + e2 + e3);
            const size_t row = (size_t)(tok0 + lane);
            *(int4*)(p.top_e + row * 4) = make_int4(e4[0], e4[1], e4[2], e4[3]);
            *(float4*)(p.gw + row * 4) = make_float4(inv, e1 * inv, e2 * inv, e3 * inv);
        }
        __syncthreads();
        if (lane < 16) {
#pragma unroll
            for (int k = 0; k < 4; ++k) rk[k] = atomicAdd(&lcnt[e4[k]], 1);
        }
        __syncthreads();
        if (tid < 32) { const int c = lcnt[tid]; lbase[tid] = c ? (int)__hip_atomic_fetch_add(gcount + tid, (unsigned)c, __ATOMIC_RELAXED, __HIP_MEMORY_SCOPE_AGENT) : 0; }
        __syncthreads();
        if (lane < 16) {
            const int row = tok0 + lane;
#pragma unroll
            for (int k = 0; k < 4; ++k) p.lists[(size_t)e4[k] * LIST_CAP + lbase[e4[k]] + rk[k]] = row * 4 + k;
        }
        __syncthreads();
    }
}

__device__ void phase_ln2(const Params& p, int l, float* xout) {
    int tid = threadIdx.x; asm volatile("" : "+v"(tid));
    const int wid = tid >> 6, lane = tid & 63;
    const float* g2 = p.ln2_g + l * DM; const float* b2 = p.ln2_b + l * DM;
    for (int row = blockIdx.x * 4 + wid; row < NTOK; row += gridDim.x * 4) {
        const float4 gwv = *(const float4*)(p.gw + (size_t)row * 4);
        const float gk[4] = {gwv.x, gwv.y, gwv.z, gwv.w};
        float4 v[4]; float s = 0.f;
#pragma unroll
        for (int j = 0; j < 4; ++j) {
            const int c = j * 256 + lane * 4;
            const float4 xv = *(const float4*)(p.x1f + (size_t)row * DM + c);
            float4 a; a.x = xv.x * ALPHA; a.y = xv.y * ALPHA; a.z = xv.z * ALPHA; a.w = xv.w * ALPHA;
#pragma unroll
            for (int k = 0; k < 4; ++k) {
                const u32x2 w = *(const u32x2*)(p.ybuf + ((size_t)row * 4 + k) * DM + c);
                a.x += gk[k] * __uint_as_float(w.x << 16); a.y += gk[k] * __uint_as_float(w.x & 0xffff0000u);
                a.z += gk[k] * __uint_as_float(w.y << 16); a.w += gk[k] * __uint_as_float(w.y & 0xffff0000u);
            }
            v[j] = a; s += (a.x + a.y) + (a.z + a.w);
        }
        const float mean = wave_sum(s) * (1.0f / 1024.0f);
        float qv = 0.f;
#pragma unroll
        for (int j = 0; j < 4; ++j) { v[j].x -= mean; v[j].y -= mean; v[j].z -= mean; v[j].w -= mean; qv += (v[j].x * v[j].x + v[j].y * v[j].y) + (v[j].z * v[j].z + v[j].w * v[j].w); }
        const float rstd = rsqrtf(wave_sum(qv) * (1.0f / 1024.0f) + LN_EPS);
#pragma unroll
        for (int j = 0; j < 4; ++j) {
            const int c = j * 256 + lane * 4;
            const float4 gg = *(const float4*)(g2 + c), bb = *(const float4*)(b2 + c);
            float4 y; y.x = v[j].x * rstd * gg.x + bb.x; y.y = v[j].y * rstd * gg.y + bb.y; y.z = v[j].z * rstd * gg.z + bb.z; y.w = v[j].w * rstd * gg.w + bb.w;
            *(float4*)(xout + (size_t)row * DM + c) = y;
            u32x2 w; w.x = pack2(y.x, y.y); w.y = pack2(y.z, y.w);
            *(u32x2*)(p.xb + (size_t)row * DM + c) = w;
        }
    }
}


#define XB_TMO      128
#define XB_XCNT(j)  (256  + 64 * (j))
#define XB_XSUB(j)  (1280 + 64 * (j))
#define XB_XGEN(j)  (2304 + 64 * (j))
#define XB_TOP      3328
#define XB_TOPGEN   3392
#define XCD_BAR_WORDS 3456
#define XB_SPIN_CAP (1u << 22)
#define LAS __attribute__((address_space(3)))
__device__ __forceinline__ unsigned xb_ld(unsigned* p)              { return __hip_atomic_load(p, __ATOMIC_RELAXED, __HIP_MEMORY_SCOPE_AGENT); }
__device__ __forceinline__ unsigned xb_add(unsigned* p, unsigned v) { return __hip_atomic_fetch_add(p, v, __ATOMIC_RELAXED, __HIP_MEMORY_SCOPE_AGENT); }
__device__ __forceinline__ unsigned xb_xcc_id() { return (unsigned)__builtin_amdgcn_s_getreg((3 << 11) | 20) & 0xFu; }
#define XB_SPIN(cond, bar) do { unsigned _sp = 0; while (cond) { __builtin_amdgcn_s_sleep(1); \
    if ((++_sp & 255u) == 0u) { if (xb_ld(&(bar)[XB_TMO])) break; if (_sp > XB_SPIN_CAP) { atomicAdd(&(bar)[XB_TMO], 1u); break; } } } } while (0)
struct XcdBarrier { unsigned* bar; unsigned x; volatile LAS unsigned* st; };
__device__ __forceinline__ XcdBarrier xcd_barrier_post(unsigned* bar, volatile LAS unsigned* st) {
    XcdBarrier b; b.bar = bar; b.x = xb_xcc_id(); b.st = st;
    if (threadIdx.x == 0) (void)xb_add(&bar[XB_XCNT(b.x)], 1u);
    return b;
}
__device__ __forceinline__ void xcd_barrier_complete(unsigned* bar, unsigned x, unsigned& nloc, unsigned& nx) {
    const unsigned G = gridDim.x * gridDim.y * gridDim.z;
    unsigned sum, cnt, mine, sp = 0u;
    for (;;) {
        sum = 0u; cnt = 0u; mine = 0u;
#pragma unroll
        for (unsigned j = 0; j < 16; ++j) { const unsigned c = xb_ld(&bar[XB_XCNT(j)]); sum += c; cnt += (c > 0u) ? 1u : 0u; mine = (j == x) ? c : mine; }
        if (sum == G) break;
        __builtin_amdgcn_s_sleep(1);
        if ((++sp & 255u) == 0u) { if (xb_ld(&bar[XB_TMO])) break; if (sp > XB_SPIN_CAP) { atomicAdd(&bar[XB_TMO], 1u); break; } }
    }
    nloc = mine > 0u ? mine : 1u; nx = cnt > 0u ? cnt : 1u;
}
__device__ __forceinline__ void xcd_barrier(const XcdBarrier& b) {
    asm volatile("s_waitcnt vmcnt(0)" ::: "memory");
    __syncthreads();
    if (threadIdx.x == 0) {
        unsigned* bar = b.bar;
        __builtin_amdgcn_s_waitcnt(0);
        unsigned nloc = b.st[0], nx = b.st[1];
        if (nloc == 0u) { xcd_barrier_complete(bar, b.x, nloc, nx); b.st[0] = nloc; b.st[1] = nx; }
        const unsigned old = xb_add(&bar[XB_XSUB(b.x)], 1u);
        const unsigned gen = old / nloc;
        if (old + 1u == (gen + 1u) * nloc) {
            __builtin_amdgcn_fence(__ATOMIC_RELEASE, "agent");
            asm volatile("s_waitcnt vmcnt(0)" ::: "memory");
            const unsigned og = xb_add(&bar[XB_TOP], 1u);
            const unsigned tg = og / nx;
            if (og + 1u == (tg + 1u) * nx) xb_add(&bar[XB_TOPGEN], 1u);
            else XB_SPIN(xb_ld(&bar[XB_TOPGEN]) == tg, bar);
            __builtin_amdgcn_fence(__ATOMIC_ACQUIRE, "agent");
            xb_add(&bar[XB_XGEN(b.x)], 1u);
            asm volatile("s_waitcnt vmcnt(0)" ::: "memory");
        } else {
            XB_SPIN(xb_ld(&bar[XB_XGEN(b.x)]) == gen, bar);
            __builtin_amdgcn_fence(__ATOMIC_ACQUIRE, "agent");
            asm volatile("s_waitcnt vmcnt(0)" ::: "memory");
        }
    }
    __syncthreads();
}

struct KArgs { const float* in[18]; float* out; char* ws; };
constexpr size_t al256(size_t v) { return (v + 255) / 256 * 256; }
struct WSL {
    static constexpr size_t ctrl = 0;
    static constexpr size_t WinT = al256(ctrl + 65536);
    static constexpr size_t WoT = al256(WinT + (size_t)NL * NPAD * 1024 * 2);
    static constexpr size_t W1T = al256(WoT + (size_t)NL * 1024 * 1024 * 2);
    static constexpr size_t W2T = al256(W1T + (size_t)NL * 2 * 64 * 2048 * 2);
    static constexpr size_t WguT = al256(W2T + (size_t)NL * 2 * 64 * 64 * 2);
    static constexpr size_t WdnT = al256(WguT + (size_t)NL * NE * 2048 * 1024 * 2);
    static constexpr size_t rwT = al256(WdnT + (size_t)NL * NE * 1024 * 1024 * 2);
    static constexpr size_t binp = al256(rwT + (size_t)NL * NE * 1024 * 4);
    static constexpr size_t bgup = al256(binp + (size_t)NL * NPAD * 4);
    static constexpr size_t b1c = al256(bgup + (size_t)NL * NE * 2048 * 4);
    static constexpr size_t xf = al256(b1c + 4 * 64 * 4);
    static constexpr size_t xb = al256(xf + (size_t)NTOK * DM * 4);
    static constexpr size_t hb = al256(xb + (size_t)NTOK * DM * 2);
    static constexpr size_t hs = al256(hb + (size_t)NTOK * NMAIN * 2);
    static constexpr size_t vT = al256(hs + (size_t)NTOK * HS_W * 4);
    static constexpr size_t cF = al256(vT + (size_t)NB * NVH * 64 * SEQ * 2);
    static constexpr size_t kc = al256(cF + (size_t)NB * 4 * SEQ * 4);
    static constexpr size_t vc = al256(kc + (size_t)NB * 2 * 128 * 64 * 2);
    static constexpr size_t vcT = al256(vc + (size_t)NB * 2 * 128 * 64 * 2);
    static constexpr size_t ob = al256(vcT + (size_t)NB * 2 * 128 * 64 * 2);
    static constexpr size_t tbuf = al256(ob + (size_t)NTOK * DM * 2);
    static constexpr size_t x1f = al256(tbuf + (size_t)NTOK * DM * 4);
    static constexpr size_t x1b = al256(x1f + (size_t)NTOK * DM * 4);
    static constexpr size_t top_e = al256(x1b + (size_t)NTOK * DM * 2);
    static constexpr size_t gw = al256(top_e + (size_t)NTOK * 4 * 4);
    static constexpr size_t lists = al256(gw + (size_t)NTOK * 4 * 4);
    static constexpr size_t act = al256(lists + (size_t)NE * LIST_CAP * 4);
    static constexpr size_t ybuf = al256(act + (size_t)MAXSLOT * DFF * 2);
    static constexpr size_t total = al256(ybuf + (size_t)NTOK * 4 * DM * 2);
};
__device__ __forceinline__ Params make_params(const KArgs& k) {
    Params p;
    p.x = k.in[0]; p.w_in = k.in[1]; p.b_in = k.in[2]; p.sinks = k.in[3]; p.cmp_pe = k.in[4]; p.cmp_w1 = k.in[5]; p.cmp_w2 = k.in[6]; p.w_out = k.in[7];
    p.ln1_g = k.in[8]; p.ln1_b = k.in[9]; p.router_w = k.in[10]; p.router_b = k.in[11]; p.w_gu = k.in[12]; p.b_gu = k.in[13]; p.w_dn = k.in[14]; p.b_dn = k.in[15];
    p.ln2_g = k.in[16]; p.ln2_b = k.in[17]; p.out = k.out;
    char* w = k.ws;
    p.ctrl = (unsigned*)(w + WSL::ctrl); p.WinT = (bf16_t*)(w + WSL::WinT); p.WoT = (bf16_t*)(w + WSL::WoT); p.W1T = (bf16_t*)(w + WSL::W1T); p.W2T = (bf16_t*)(w + WSL::W2T);
    p.WguT = (bf16_t*)(w + WSL::WguT); p.WdnT = (bf16_t*)(w + WSL::WdnT); p.rwT = (float*)(w + WSL::rwT); p.binp = (float*)(w + WSL::binp); p.bgup = (float*)(w + WSL::bgup);
    p.b1c = (float*)(w + WSL::b1c); p.xf = (float*)(w + WSL::xf); p.xb = (bf16_t*)(w + WSL::xb); p.hb = (bf16_t*)(w + WSL::hb); p.hs = (float*)(w + WSL::hs); p.vT = (bf16_t*)(w + WSL::vT);
    p.cF = (float*)(w + WSL::cF); p.kc = (bf16_t*)(w + WSL::kc); p.vc = (bf16_t*)(w + WSL::vc); p.vcT = (bf16_t*)(w + WSL::vcT); p.ob = (bf16_t*)(w + WSL::ob); p.tbuf = (float*)(w + WSL::tbuf);
    p.x1f = (float*)(w + WSL::x1f); p.x1b = (bf16_t*)(w + WSL::x1b); p.top_e = (int*)(w + WSL::top_e); p.gw = (float*)(w + WSL::gw); p.lists = (int*)(w + WSL::lists);
    p.act = (bf16_t*)(w + WSL::act); p.ybuf = (bf16_t*)(w + WSL::ybuf);
    return p;
}
__device__ __forceinline__ void grid_bar(const Params& p, char* lds) {
    XcdBarrier xb; xb.bar = p.ctrl + 1024; xb.x = xb_xcc_id(); xb.st = (volatile LAS unsigned*)(lds + LDS_BYTES - 16); xcd_barrier(xb);
}
template <int L>
__device__ __forceinline__ void layer_fwd(const Params& p, char* lds) {
    const float* xin = L == 0 ? p.x : p.xf;
    float* xout = L == NL - 1 ? p.out : p.xf;
    phase_inproj(p, L, lds);        grid_bar(p, lds);
    phase_prep(p, L, lds);          grid_bar(p, lds);
    phase_attn(p, L, lds);          grid_bar(p, lds);
    phase_outproj(p, L, xin, lds);  grid_bar(p, lds);
    phase_ln1_router(p, L, lds);    grid_bar(p, lds);
    phase_gateup(p, L, lds);        grid_bar(p, lds);
    phase_down(p, L, lds);          grid_bar(p, lds);
    phase_ln2(p, L, xout);
}
__global__ void __launch_bounds__(256, 2) fwd_kernel(KArgs ka) {
    extern __shared__ __attribute__((aligned(16))) char lds[];
    const Params p = make_params(ka);
    cg::grid_group grid = cg::this_grid();
    volatile LAS unsigned* xst = (volatile LAS unsigned*)(lds + LDS_BYTES - 16);
    if (threadIdx.x == 0) { xst[0] = 0u; xst[1] = 0u; }
    __syncthreads();
    (void)xcd_barrier_post(p.ctrl + 1024, xst);
    phase0(p, lds);
    grid.sync();
    layer_fwd<0>(p, lds);
    grid_bar(p, lds);
    layer_fwd<1>(p, lds);
}

extern "C" void kernel_launch(void* const* d_in, const int* in_sizes, int n_in, void* d_out, int out_size, void* d_ws, size_t ws_size, hipStream_t stream) {
    KArgs ka{};
    for (int i = 0; i < 18; ++i) ka.in[i] = (const float*)d_in[i];
    ka.out = (float*)d_out; ka.ws = (char*)d_ws;
    const size_t off = WSL::total;
    if (off > ws_size) { fprintf(stderr, "workspace too small: need %zu have %zu\n", off, ws_size); return; }

    static int grid_blocks = 0;
    if (!grid_blocks) {
        int dev = 0, cus = 0, per_cu = 0;
        hipGetDevice(&dev);
        hipDeviceGetAttribute(&cus, hipDeviceAttributeMultiprocessorCount, dev);
        hipFuncSetAttribute((const void*)fwd_kernel, hipFuncAttributeMaxDynamicSharedMemorySize, LDS_BYTES);
        hipOccupancyMaxActiveBlocksPerMultiprocessor(&per_cu, fwd_kernel, 256, LDS_BYTES);
        if (per_cu > 2) per_cu = 2;
        if (per_cu < 1) per_cu = 1;
        grid_blocks = cus * per_cu;
    }
    hipMemsetAsync(d_ws, 0, 65536, stream);
    void* args[] = {&ka};
    hipError_t e = hipLaunchCooperativeKernel((const void*)fwd_kernel, dim3(grid_blocks), dim3(256), args, LDS_BYTES, stream);
    if (e != hipSuccess) fprintf(stderr, "cooperative launch failed: %s (grid %d)\n", hipGetErrorString(e), grid_blocks);
}
```

```cpp
#include <hip/hip_runtime.h>
#include <hip/hip_cooperative_groups.h>
#include <cstdio>
#include <cstdint>
namespace cg = cooperative_groups;

typedef unsigned short bf16_t;
typedef short bf16x8 __attribute__((ext_vector_type(8)));
typedef float f32x4 __attribute__((ext_vector_type(4)));
typedef unsigned u32x4 __attribute__((ext_vector_type(4)));
typedef unsigned u32x2 __attribute__((ext_vector_type(2)));
#define LAS __attribute__((address_space(3)))
constexpr float NEG_INF = -__builtin_huge_valf();

constexpr int DM = 1024, NB = 16, SEQ = 2048, NTOK = NB * SEQ, NL = 2;
constexpr int NCOL = 2582, NMAIN = 2560, NPAD = 2688, NE = 32, DFF = 1024;
constexpr int C_FQ = 0, C_FK = 256, C_FV = 512, C_SQ = 768, C_SK = 1152, C_SV = 1280, C_NQ = 1408,
              C_NKC = 1792, C_NVC = 1920, C_NKS = 2048, C_NVS = 2176, C_NKW = 2304, C_NVW = 2432;
constexpr int HS_W = 32;
constexpr int NVH = 10;
constexpr int LIST_CAP = NTOK;
constexpr int MAXSLOT = NTOK * 4 + NE * 256;
constexpr float ALPHA = 1.41421356237f, LN_EPS = 1e-5f, QSCALE = 0.125f;
constexpr int NWV = 8, NTHR = NWV * 64;
constexpr int LDS_STAGE = 131072, LDS_TAB = LDS_STAGE, LDS_BYTES = LDS_STAGE + 2048;

struct Params {
    const float *x, *w_in, *b_in, *sinks, *cmp_pe, *cmp_w1, *cmp_w2, *w_out, *ln1_g, *ln1_b, *router_w, *router_b,
                *w_gu, *b_gu, *w_dn, *b_dn, *ln2_g, *ln2_b;
    float* out;
    unsigned* ctrl;
    bf16_t *WinT, *WoT, *W1T, *W2T, *WguT, *WdnT;
    float *rwT, *binp, *bgup, *b1c;
    float* xf; bf16_t* xb; bf16_t* hb; float* hs; bf16_t* vT; float* cF;
    bf16_t *kc, *vc, *vcT; bf16_t* ob; float* tbuf; float* x1f; bf16_t* x1b;
    int* top_e; float* gw; int* lists; bf16_t* act; bf16_t* ybuf;
};

__device__ __forceinline__ float bf2f(bf16_t h) { return __uint_as_float(((unsigned)h) << 16); }
__device__ __forceinline__ bf16_t f2bf(float f) { unsigned u = __float_as_uint(f); u += 0x7fffu + ((u >> 16) & 1u); return (bf16_t)(u >> 16); }
__device__ __forceinline__ unsigned pack2(float lo, float hi) { return (unsigned)f2bf(lo) | ((unsigned)f2bf(hi) << 16); }
__device__ __forceinline__ float wave_sum(float v) {
#pragma unroll
    for (int o = 32; o > 0; o >>= 1) v += __shfl_xor(v, o);
    return v;
}
__device__ __forceinline__ float wave_max(float v) {
#pragma unroll
    for (int o = 32; o > 0; o >>= 1) v = fmaxf(v, __shfl_xor(v, o));
    return v;
}
__device__ __forceinline__ void lds_wave_sync() { asm volatile("s_waitcnt lgkmcnt(0)" ::: "memory"); __builtin_amdgcn_wave_barrier(); }
__device__ __forceinline__ float slope_swa(int hq) { return exp2f(-8.0f * (float)(2 * hq + 1) / 12.0f); }
__device__ __forceinline__ float slope_nsa(int hq) { return exp2f(-8.0f * (float)(2 * hq + 2) / 12.0f); }

__device__ __forceinline__ int perm_row(int perm, int n) {
    if (perm == 1) { if (n < 768) return n; if (n < 772) return 2560 + (n - 768); if (n < 2564) return n - 4; return n; }
    if (perm == 2) { const int f = n >> 1, s = n & 1; return (f >> 7) * 256 + s * 128 + (f & 127); }
    return n;
}
struct ConvJob { const float* src; bf16_t* dst; int K, N, kt, nt, perm; };
__device__ __forceinline__ void phase0(const Params& p, char* ldsc) {
    int tid = threadIdx.x; asm volatile("" : "+v"(tid));
    const int G = gridDim.x, bid = blockIdx.x, half = tid >> 8, t256 = tid & 255;
    float* lds = (float*)ldsc + half * 4224;
    const size_t gtid = (size_t)bid * NTHR + tid, gthreads = (size_t)G * NTHR;
    for (size_t i = gtid; i < (size_t)NL * NPAD; i += gthreads) {
        const int l = (int)(i / NPAD), r = (int)(i % NPAD);
        float v = 0.f;
        if (r < 2560) { const int n = r < 768 ? r : r + 4; v = p.b_in[l * NCOL + n]; }
        else if (r < 2564) v = p.b_in[l * NCOL + 768 + (r - 2560)];
        else if (r < 2582) v = p.b_in[l * NCOL + r];
        p.binp[i] = v;
    }
    for (size_t i = gtid; i < (size_t)NL * NE * 2048; i += gthreads) {
        const int r = (int)(i % 2048); const size_t le = i / 2048;
        const int s = (r >> 7) & 1, f = (r >> 8) * 128 + (r & 127);
        p.bgup[i] = p.b_gu[le * 2048 + 2 * f + s];
    }
    for (size_t i = gtid; i < (size_t)NL * NE * 1024; i += gthreads) {
        const int k = (int)(i % 1024), e = (int)((i / 1024) % NE), l = (int)(i / (1024 * NE));
        p.rwT[i] = p.router_w[((size_t)l * 1024 + k) * NE + e];
    }
    for (size_t i = gtid; i < (size_t)NL * (NPAD - NCOL) * 1024; i += gthreads) {
        const int l = (int)(i / ((NPAD - NCOL) * 1024)); const size_t r = i % ((size_t)(NPAD - NCOL) * 1024);
        p.WinT[(size_t)l * NPAD * 1024 + (size_t)NCOL * 1024 + r] = 0;
    }
    for (size_t i = gtid; i < (size_t)NTOK * DM / 4; i += gthreads) {
        const float4 v = ((const float4*)p.x)[i];
        u32x2 w; w.x = pack2(v.x, v.y); w.y = pack2(v.z, v.w);
        ((u32x2*)p.xb)[i] = w;
    }
    if (bid < 2) {
        const int mat = bid * 2 + half, j = t256 & 63, part = t256 >> 6;
        const float* pe = p.cmp_pe + (size_t)mat * 2048; const float* w1 = p.cmp_w1 + (size_t)mat * 2048 * 64;
        float s = 0.f;
        for (int kk = part * 512; kk < part * 512 + 512; ++kk) s += pe[kk] * w1[(size_t)kk * 64 + j];
        lds[t256] = s; __syncthreads();
        if (t256 < 64) p.b1c[mat * 64 + t256] = lds[t256] + lds[t256 + 64] + lds[t256 + 128] + lds[t256 + 192];
        __syncthreads();
    }
    constexpr int T_WIN = NL * 16 * 41, T_WO = NL * 16 * 16, T_W1 = NL * 2 * 32, T_W2 = NL * 2, T_GU = NL * NE * 16 * 32, T_DN = NL * NE * 16 * 16;
    constexpr int TOT = T_WIN + T_WO + T_W1 + T_W2 + T_GU + T_DN;
    for (int base = bid * 2; base < TOT; base += G * 2) {
        const int t = base + half; const bool valid = t < TOT;
        ConvJob jb{nullptr, nullptr, 0, 0, 0, 0, 0};
        if (valid) {
            int u = t;
            if (u < T_GU) { const int m = u / 512, r = u % 512; jb = ConvJob{p.w_gu + (size_t)m * 1024 * 2048, p.WguT + (size_t)m * 2048 * 1024, 1024, 2048, r / 32, r % 32, 2}; }
            else if ((u -= T_GU) < T_DN) { const int m = u / 256, r = u % 256; jb = ConvJob{p.w_dn + (size_t)m * 1024 * 1024, p.WdnT + (size_t)m * 1024 * 1024, 1024, 1024, r / 16, r % 16, 0}; }
            else if ((u -= T_DN) < T_WIN) { const int m = u / 656, r = u % 656; jb = ConvJob{p.w_in + (size_t)m * 1024 * NCOL, p.WinT + (size_t)m * NPAD * 1024, 1024, NCOL, r / 41, r % 41, 1}; }
            else if ((u -= T_WIN) < T_WO) { const int m = u / 256, r = u % 256; jb = ConvJob{p.w_out + (size_t)m * 1024 * 1024, p.WoT + (size_t)m * 1024 * 1024, 1024, 1024, r / 16, r % 16, 0}; }
            else if ((u -= T_WO) < T_W1) { const int m = u / 32, r = u % 32; jb = ConvJob{p.cmp_w1 + (size_t)m * 2048 * 64, p.W1T + (size_t)m * 64 * 2048, 2048, 64, r, 0, 0}; }
            else { u -= T_W1; jb = ConvJob{p.cmp_w2 + (size_t)u * 64 * 64, p.W2T + (size_t)u * 64 * 64, 64, 64, 0, 0, 0}; }
        }
        if (valid) {
#pragma unroll
            for (int i = 0; i < 4; ++i) {
                const int kk = (t256 >> 4) + 16 * i, nn = (t256 & 15) * 4;
                const int k = jb.kt * 64 + kk, n = jb.nt * 64 + nn;
                const float* s = jb.src + (size_t)k * jb.N + n;
                float v0 = 0.f, v1 = 0.f, v2 = 0.f, v3 = 0.f;
                if (n + 3 < jb.N) { v0 = s[0]; v1 = s[1]; v2 = s[2]; v3 = s[3]; }
                else { if (n < jb.N) v0 = s[0]; if (n + 1 < jb.N) v1 = s[1]; if (n + 2 < jb.N) v2 = s[2]; }
                float* l = lds + kk * 65 + nn; l[0] = v0; l[1] = v1; l[2] = v2; l[3] = v3;
            }
        }
        __syncthreads();
        if (valid) {
#pragma unroll
            for (int i = 0; i < 2; ++i) {
                const int idx = t256 + 256 * i, nn = idx >> 3, kc = idx & 7, n = jb.nt * 64 + nn;
                if (n < jb.N) {
                    const float* l = lds + (kc * 8) * 65 + nn;
                    u32x4 w; w.x = pack2(l[0], l[65]); w.y = pack2(l[130], l[195]); w.z = pack2(l[260], l[325]); w.w = pack2(l[390], l[455]);
                    *(u32x4*)(jb.dst + (size_t)perm_row(jb.perm, n) * jb.K + jb.kt * 64 + kc * 8) = w;
                }
            }
        }
        __syncthreads();
    }
}

namespace pg8 {
constexpr int BM = 256, BK = 64, HALF = 128, HTB = HALF * BK * 2, NXCD = 8, WGM = 8;
__device__ __forceinline__ int lds_byte(int r, int c) { const int st = (r >> 4) * 2 + (c >> 5), rr = r & 15, cc = c & 31, ob = rr * 64 + cc * 2; return st * 1024 + (ob ^ (((ob >> 9) & 1) << 5)); }
__device__ __forceinline__ void stage_rc(int b, int& R, int& C) { const int st = b / 1024, sb = b % 1024, swz = sb ^ (((sb >> 9) & 1) << 5); R = (st >> 1) * 16 + swz / 64; C = (st & 1) * 32 + (swz % 64) / 2; }
__device__ __forceinline__ bool tile_order(int i, int G, int c, int nM, int nN, int& pm, int& pn) {
    const int nwg = nM * nN; const long L = (long)i * G + c; if (L >= nwg) return false;
    int wgid = (int)L; { const int q = nwg / NXCD, r = nwg % NXCD, xcd = wgid % NXCD, off = wgid / NXCD; wgid = (xcd < r ? xcd * (q + 1) : r * (q + 1) + (xcd - r) * q) + off; }
    const int nig = WGM * nN, gid = wgid / nig, fm = gid * WGM, gsz = (nM - fm) < WGM ? (nM - fm) : WGM;
    pm = fm + ((wgid % nig) % gsz); pn = (wgid % nig) / gsz; return true;
}
template <class Sched, class Epi>
__device__ __forceinline__ void gemm_phase(LAS unsigned char* lds, const char* Abase, int K, const Sched& S, const Epi& E) {
    int tid = threadIdx.x; asm volatile("" : "+v"(tid));
    const int wid = __builtin_amdgcn_readfirstlane(tid >> 6), lane = tid & 63, wr = wid >> 2, wc = wid & 3, fr = lane & 15, fq = lane >> 4;
    const int nt = K / BK;
    int R0, C0, R1, C1; stage_rc(tid * 16, R0, C0); stage_rc(tid * 16 + 8192, R1, C1);
    unsigned voffB[2]; voffB[0] = (unsigned)(R0 * K + C0) * 2u; voffB[1] = (unsigned)(R1 * K + C1) * 2u;
    const size_t kstep = (size_t)(BK * 2), hstep = (size_t)HALF * K * 2;
    const unsigned ldsw = (unsigned)wid * 1024u;
    const int aoff = lds_byte(wr * 64 + fr, fq * 8), boff = lds_byte(wc * 32 + fr, fq * 8);
#define PG8_SA(b, h) (((b) * 2 + (h)) * HTB)
#define PG8_SB(b, h) ((4 + (b) * 2 + (h)) * HTB)
#define PG8_STAGE_B(bufoff, gbase) do { _Pragma("unroll") for (int _i = 0; _i < 2; ++_i) \
        __builtin_amdgcn_global_load_lds((const unsigned*)((const char*)(gbase) + voffB[_i]), (LAS unsigned*)(lds + (bufoff) + ldsw + _i * 8192), 16, 0, 0); } while (0)
#define PG8_STAGE_A(bufoff, kbyte, o0, o1) do { \
        __builtin_amdgcn_global_load_lds((const unsigned*)(Abase + (kbyte) + (o0)), (LAS unsigned*)(lds + (bufoff) + ldsw), 16, 0, 0); \
        __builtin_amdgcn_global_load_lds((const unsigned*)(Abase + (kbyte) + (o1)), (LAS unsigned*)(lds + (bufoff) + ldsw + 8192), 16, 0, 0); } while (0)
#define PG8_LDA(dst, b, h) do { _Pragma("unroll") for (int m = 0; m < 4; ++m) _Pragma("unroll") for (int k = 0; k < 2; ++k) dst[m][k] = *(const LAS bf16x8*)(lds + PG8_SA(b, h) + aoff + m * 2048 + k * 1024); } while (0)
#define PG8_LDB(dst, b, h) do { _Pragma("unroll") for (int n = 0; n < 2; ++n) _Pragma("unroll") for (int k = 0; k < 2; ++k) dst[n][k] = *(const LAS bf16x8*)(lds + PG8_SB(b, h) + boff + n * 2048 + k * 1024); } while (0)
#define PG8_MMA(ai, bj, At, Bt) do { __builtin_amdgcn_s_setprio(1); _Pragma("unroll") for (int m = 0; m < 4; ++m) _Pragma("unroll") for (int n = 0; n < 2; ++n) _Pragma("unroll") for (int k = 0; k < 2; ++k) \
        acc[ai][bj][m][n] = __builtin_amdgcn_mfma_f32_16x16x32_bf16(Bt[n][k], At[m][k], acc[ai][bj][m][n], 0, 0, 0); __builtin_amdgcn_s_setprio(0); } while (0)
#define PG8_WAIT_V(n) asm volatile("s_waitcnt vmcnt(" #n ")" ::: "memory")
#define PG8_WAIT_L(n) asm volatile("s_waitcnt lgkmcnt(" #n ")" ::: "memory")
#define PG8_BAR __builtin_amdgcn_s_barrier()
#define PG8_SCHED __builtin_amdgcn_sched_barrier(0)
    typename Sched::Unit cur, nxt; int ui = 0;
    if (!S.next(0, cur)) return;
    f32x4 acc[2][2][4][2];
#pragma unroll
    for (int a = 0; a < 2; ++a)
#pragma unroll
        for (int b = 0; b < 2; ++b)
#pragma unroll
            for (int m = 0; m < 4; ++m)
#pragma unroll
                for (int n = 0; n < 2; ++n) acc[a][b][m][n] = (f32x4){0.f, 0.f, 0.f, 0.f};
    bf16x8 At[4][2], B0[2][2], B1[2][2];
    unsigned aC[2][2], aN[2][2];
    S.a_off(cur, R0, C0, R1, C1, aC);
    const char* cB = S.b_ptr(cur);
    PG8_STAGE_B(PG8_SB(0, 0), cB); PG8_STAGE_B(PG8_SB(0, 1), cB + hstep); PG8_STAGE_A(PG8_SA(0, 0), 0, aC[0][0], aC[0][1]); PG8_STAGE_A(PG8_SA(0, 1), 0, aC[1][0], aC[1][1]);
    if (wr == 1) PG8_BAR;
    PG8_WAIT_V(2); PG8_BAR;
    PG8_STAGE_B(PG8_SB(1, 0), cB + kstep); PG8_STAGE_A(PG8_SA(1, 0), kstep, aC[0][0], aC[0][1]); PG8_STAGE_B(PG8_SB(1, 1), cB + hstep + kstep);
    PG8_WAIT_V(6); PG8_BAR;
    for (;;) {
        const bool has_next = S.next(ui + 1, nxt);
        const char* nB = cB;
        if (has_next) { S.a_off(nxt, R0, C0, R1, C1, aN); nB = S.b_ptr(nxt); }
        else { aN[0][0] = aC[0][0]; aN[0][1] = aC[0][1]; aN[1][0] = aC[1][0]; aN[1][1] = aC[1][1]; }
        for (int t = 0; t < nt; t += 2) {
            const bool last = (t == nt - 2);
            const size_t ka1 = (size_t)(t + 1) * kstep, ka2 = last ? 0 : (size_t)(t + 2) * kstep, ka3 = ka2 + kstep;
            const char* b2 = last ? nB : cB + (size_t)(t + 2) * kstep; const char* b3 = b2 + kstep;
            const unsigned o00 = last ? aN[0][0] : aC[0][0], o01 = last ? aN[0][1] : aC[0][1], o10 = last ? aN[1][0] : aC[1][0], o11 = last ? aN[1][1] : aC[1][1];
            PG8_LDB(B0, 0, 0); PG8_LDB(B1, 0, 1); PG8_SCHED; PG8_LDA(At, 0, 0); PG8_STAGE_A(PG8_SA(1, 1), ka1, aC[1][0], aC[1][1]);
            PG8_WAIT_V(8); PG8_WAIT_L(0); PG8_BAR; PG8_MMA(0, 0, At, B0); PG8_MMA(0, 1, At, B1); PG8_BAR; PG8_SCHED;
            PG8_LDA(At, 0, 1); PG8_STAGE_B(PG8_SB(0, 0), b2); PG8_STAGE_B(PG8_SB(0, 1), b2 + hstep); PG8_STAGE_A(PG8_SA(0, 0), ka2, o00, o01);
            PG8_WAIT_V(8); PG8_WAIT_L(0); PG8_BAR; PG8_MMA(1, 0, At, B0); PG8_MMA(1, 1, At, B1); PG8_BAR; PG8_SCHED;
            PG8_LDB(B0, 1, 0); PG8_LDB(B1, 1, 1); PG8_SCHED; PG8_LDA(At, 1, 0); PG8_STAGE_A(PG8_SA(0, 1), ka2, o10, o11);
            PG8_WAIT_V(8); PG8_WAIT_L(0); PG8_BAR; PG8_MMA(0, 0, At, B0); PG8_MMA(0, 1, At, B1); PG8_BAR; PG8_SCHED;
            PG8_LDA(At, 1, 1); PG8_STAGE_B(PG8_SB(1, 0), b3); PG8_STAGE_B(PG8_SB(1, 1), b3 + hstep); PG8_STAGE_A(PG8_SA(1, 0), ka3, o00, o01);
            PG8_WAIT_V(8); PG8_WAIT_L(0); PG8_BAR; PG8_MMA(1, 0, At, B0); PG8_MMA(1, 1, At, B1); PG8_BAR; PG8_SCHED;
        }
        if (wr == 0) PG8_BAR;
        E(acc, cur, wr, wc, fr, fq);
        if (!has_next) break;
#pragma unroll
        for (int a = 0; a < 2; ++a)
#pragma unroll
            for (int b = 0; b < 2; ++b)
#pragma unroll
                for (int m = 0; m < 4; ++m)
#pragma unroll
                    for (int n = 0; n < 2; ++n) acc[a][b][m][n] = (f32x4){0.f, 0.f, 0.f, 0.f};
        cur = nxt; cB = nB; ++ui;
        aC[0][0] = aN[0][0]; aC[0][1] = aN[0][1]; aC[1][0] = aN[1][0]; aC[1][1] = aN[1][1];
        if (wr == 1) PG8_BAR;
    }
    PG8_WAIT_V(0);
    PG8_BAR;
#undef PG8_SA
#undef PG8_SB
#undef PG8_STAGE_A
#undef PG8_STAGE_B
#undef PG8_LDA
#undef PG8_LDB
#undef PG8_MMA
#undef PG8_WAIT_V
#undef PG8_WAIT_L
#undef PG8_BAR
#undef PG8_SCHED
}
}

struct DenseUnit { int pm, pn; };
struct DenseSched {
    typedef DenseUnit Unit;
    const char* Bt; int K, nM, nN;
    __device__ __forceinline__ bool next(int i, Unit& u) const { return pg8::tile_order(i, gridDim.x, blockIdx.x, nM, nN, u.pm, u.pn); }
    __device__ __forceinline__ void a_off(const Unit& u, int R0, int C0, int R1, int C1, unsigned (&off)[2][2]) const {
#pragma unroll
        for (int h = 0; h < 2; ++h) { off[h][0] = (unsigned)((u.pm * 256 + h * 128 + R0) * K + C0) * 2u; off[h][1] = (unsigned)((u.pm * 256 + h * 128 + R1) * K + C1) * 2u; }
    }
    __device__ __forceinline__ const char* b_ptr(const Unit& u) const { return Bt + (size_t)u.pn * 256 * K * 2; }
};
struct MoeUnit { int rbt, e, rb, cnt, pn; };
template <bool GATHER>
struct MoeSched {
    typedef MoeUnit Unit;
    const char* Bt; const int* lists; const int* ptile; const int* ecnt; int nN, nrows;
    __device__ __forceinline__ bool next(int i, Unit& u) const {
        int pm, pn; if (!pg8::tile_order(i, gridDim.x, blockIdx.x, ptile[NE], nN, pm, pn)) return false;
        int e = 0; while (ptile[e + 1] <= pm) ++e;
        u.rbt = pm; u.e = e; u.rb = pm - ptile[e]; u.cnt = ecnt[e]; u.pn = pn; return true;
    }
    __device__ __forceinline__ void a_off(const Unit& u, int R0, int C0, int R1, int C1, unsigned (&off)[2][2]) const {
        if (GATHER) {
            const int* lst = lists + (size_t)u.e * LIST_CAP;
#pragma unroll
            for (int h = 0; h < 2; ++h) {
                const int l0 = u.rb * 256 + h * 128 + R0, l1 = u.rb * 256 + h * 128 + R1;
                const int t0 = l0 < u.cnt ? (lst[l0] >> 2) : 0, t1 = l1 < u.cnt ? (lst[l1] >> 2) : 0;
                off[h][0] = (unsigned)(t0 * 1024 + C0) * 2u; off[h][1] = (unsigned)(t1 * 1024 + C1) * 2u;
            }
        } else {
#pragma unroll
            for (int h = 0; h < 2; ++h) { off[h][0] = (unsigned)((u.rbt * 256 + h * 128 + R0) * 1024 + C0) * 2u; off[h][1] = (unsigned)((u.rbt * 256 + h * 128 + R1) * 1024 + C1) * 2u; }
        }
    }
    __device__ __forceinline__ const char* b_ptr(const Unit& u) const { return Bt + ((size_t)u.e * nrows + (size_t)u.pn * 256) * 1024 * 2; }
};

struct EpiInProj {
    const Params* p; int l;
    __device__ __forceinline__ void operator()(const f32x4 (&acc)[2][2][4][2], const DenseUnit& u, int wr, int wc, int fr, int fq) const {
        const float* bias = p->binp + l * NPAD + u.pn * 256;
#pragma unroll
        for (int bj = 0; bj < 2; ++bj) {
            int vh = -1;
            if (u.pn == 2) vh = bj * 2; else if (u.pn == 5 && bj == 0) vh = 4; else if (u.pn == 8 && bj == 1) vh = 6; else if (u.pn == 9 && bj == 1) vh = 8;
#pragma unroll
            for (int n = 0; n < 2; ++n) {
                const int c = bj * 128 + wc * 32 + n * 16 + 4 * fq;
                const f32x4 bv = *(const f32x4*)(bias + c);
#pragma unroll
                for (int ai = 0; ai < 2; ++ai)
#pragma unroll
                    for (int m = 0; m < 4; ++m) {
                        const int row = u.pm * 256 + ai * 128 + wr * 64 + m * 16 + fr;
                        const f32x4 v = acc[ai][bj][m][n] + bv;
                        u32x2 w; w.x = pack2(v[0], v[1]); w.y = pack2(v[2], v[3]);
                        *(u32x2*)(p->hb + (size_t)row * NMAIN + u.pn * 256 + c) = w;
                        if (vh >= 0) {
                            const int b = row >> 11, s = row & 2047, hh = vh + ((c & 127) >> 6), d = c & 63;
                            bf16_t* vt = p->vT + (((size_t)b * NVH + hh) * 64 + d) * SEQ + s;
                            vt[0] = (bf16_t)(w.x & 0xffff); vt[SEQ] = (bf16_t)(w.x >> 16); vt[2 * SEQ] = (bf16_t)(w.y & 0xffff); vt[3 * SEQ] = (bf16_t)(w.y >> 16);
                        }
                    }
            }
        }
    }
};
struct EpiOutProj {
    const float* xin; float* t;
    __device__ __forceinline__ void operator()(const f32x4 (&acc)[2][2][4][2], const DenseUnit& u, int wr, int wc, int fr, int fq) const {
#pragma unroll
        for (int ai = 0; ai < 2; ++ai)
#pragma unroll
            for (int m = 0; m < 4; ++m) {
                const size_t rowoff = (size_t)(u.pm * 256 + ai * 128 + wr * 64 + m * 16 + fr) * DM + u.pn * 256 + wc * 32 + 4 * fq;
#pragma unroll
                for (int bj = 0; bj < 2; ++bj)
#pragma unroll
                    for (int n = 0; n < 2; ++n) {
                        const size_t off = rowoff + bj * 128 + n * 16;
                        const f32x4 xv = *(const f32x4*)(xin + off);
                        *(f32x4*)(t + off) = xv * ALPHA + acc[ai][bj][m][n];
                    }
            }
    }
};
struct EpiGateUp {
    bf16_t* act; const float* bgup;
    __device__ __forceinline__ void operator()(const f32x4 (&acc)[2][2][4][2], const MoeUnit& u, int wr, int wc, int fr, int fq) const {
        const float* bias = bgup + (size_t)u.e * 2048 + u.pn * 256;
#pragma unroll
        for (int n = 0; n < 2; ++n) {
            const int c = wc * 32 + n * 16 + 4 * fq;
            const f32x4 bg = *(const f32x4*)(bias + c), bu = *(const f32x4*)(bias + 128 + c);
#pragma unroll
            for (int ai = 0; ai < 2; ++ai)
#pragma unroll
                for (int m = 0; m < 4; ++m) {
                    const f32x4 g4 = acc[ai][0][m][n] + bg, u4 = acc[ai][1][m][n] + bu;
                    float o[4];
#pragma unroll
                    for (int j = 0; j < 4; ++j) {
                        const float g = fminf(g4[j], 7.0f), uu = fminf(fmaxf(u4[j], -7.0f), 7.0f);
                        const float glu = g / (1.0f + __expf(-1.702f * g));
                        o[j] = (uu + 1.0f) * glu;
                    }
                    u32x2 w; w.x = pack2(o[0], o[1]); w.y = pack2(o[2], o[3]);
                    *(u32x2*)(act + (size_t)(u.rbt * 256 + ai * 128 + wr * 64 + m * 16 + fr) * DFF + u.pn * 128 + c) = w;
                }
        }
    }
};
struct EpiDown {
    bf16_t* ybuf; const float* bdn; const int* lists;
    __device__ __forceinline__ void operator()(const f32x4 (&acc)[2][2][4][2], const MoeUnit& u, int wr, int wc, int fr, int fq) const {
        const float* bias = bdn + (size_t)u.e * 1024 + u.pn * 256;
        const int* lst = lists + (size_t)u.e * LIST_CAP;
#pragma unroll
        for (int ai = 0; ai < 2; ++ai)
#pragma unroll
            for (int m = 0; m < 4; ++m) {
                const int lr = u.rb * 256 + ai * 128 + wr * 64 + m * 16 + fr;
                if (lr < u.cnt) {
                    const int a = lst[lr];
#pragma unroll
                    for (int bj = 0; bj < 2; ++bj)
#pragma unroll
                        for (int n = 0; n < 2; ++n) {
                            const int c = bj * 128 + wc * 32 + n * 16 + 4 * fq;
                            const f32x4 v = acc[ai][bj][m][n] + *(const f32x4*)(bias + c);
                            u32x2 w; w.x = pack2(v[0], v[1]); w.y = pack2(v[2], v[3]);
                            *(u32x2*)(ybuf + (size_t)a * DM + u.pn * 256 + c) = w;
                        }
                }
            }
    }
};

__device__ __forceinline__ void phase_inproj(const Params& p, int l, char* lds) {
    DenseSched S{(const char*)(p.WinT + (size_t)l * NPAD * 1024), 1024, NTOK / 256, NMAIN / 256};
    EpiInProj E{&p, l};
    pg8::gemm_phase((LAS unsigned char*)lds, (const char*)p.xb, 1024, S, E);
    int tid = threadIdx.x; asm volatile("" : "+v"(tid));
    const int wid = tid >> 6, lane = tid & 63, fr = lane & 15, fq = lane >> 4;
    const bf16_t* W = p.WinT + ((size_t)l * NPAD + NMAIN) * 1024;
    const float* bias = p.binp + l * NPAD + NMAIN;
    for (int u = blockIdx.x * NWV + wid; u < NTOK / 16; u += gridDim.x * NWV) {
        const bf16_t* ar = p.xb + (size_t)(u * 16 + fr) * DM + fq * 8;
        const bf16_t* w0 = W + (size_t)fr * 1024 + fq * 8; const bf16_t* w1 = W + (size_t)(16 + fr) * 1024 + fq * 8;
        f32x4 a0 = (f32x4){0.f, 0.f, 0.f, 0.f}, a1 = a0;
#pragma unroll 4
        for (int ks = 0; ks < 32; ++ks) {
            const bf16x8 a = *(const bf16x8*)(ar + ks * 32);
            a0 = __builtin_amdgcn_mfma_f32_16x16x32_bf16(a, *(const bf16x8*)(w0 + ks * 32), a0, 0, 0, 0);
            a1 = __builtin_amdgcn_mfma_f32_16x16x32_bf16(a, *(const bf16x8*)(w1 + ks * 32), a1, 0, 0, 0);
        }
#pragma unroll
        for (int r = 0; r < 4; ++r) {
            float* dst = p.hs + (size_t)(u * 16 + fq * 4 + r) * HS_W;
            dst[fr] = a0[r] + bias[fr];
            if (fr < 6) dst[16 + fr] = a1[r] + bias[16 + fr];
        }
    }
}
__device__ __forceinline__ void phase_outproj(const Params& p, int l, const float* xin, char* lds) {
    DenseSched S{(const char*)(p.WoT + (size_t)l * 1024 * 1024), 1024, NTOK / 256, 4};
    EpiOutProj E{xin, p.tbuf};
    pg8::gemm_phase((LAS unsigned char*)lds, (const char*)p.ob, 1024, S, E);
}
__device__ __forceinline__ void build_tiles(const Params& p, int l, int* ptile, int* ecnt) {
    if (threadIdx.x < NE) ecnt[threadIdx.x] = (int)__hip_atomic_load(p.ctrl + 64 + l * NE + threadIdx.x, __ATOMIC_RELAXED, __HIP_MEMORY_SCOPE_AGENT);
    __syncthreads();
    if (threadIdx.x == 0) { int s = 0; for (int e = 0; e < NE; ++e) { ptile[e] = s; s += (ecnt[e] + 255) >> 8; } ptile[NE] = s; }
    __syncthreads();
}
__device__ __forceinline__ void phase_gateup(const Params& p, int l, char* lds) {
    int* ptile = (int*)(lds + LDS_TAB); int* ecnt = ptile + 40;
    build_tiles(p, l, ptile, ecnt);
    MoeSched<true> S{(const char*)(p.WguT + (size_t)l * NE * 2048 * 1024), p.lists, ptile, ecnt, 8, 2048};
    EpiGateUp E{p.act, p.bgup + (size_t)l * NE * 2048};
    pg8::gemm_phase((LAS unsigned char*)lds, (const char*)p.x1b, 1024, S, E);
}
__device__ __forceinline__ void phase_down(const Params& p, int l, char* lds) {
    int* ptile = (int*)(lds + LDS_TAB); int* ecnt = ptile + 40;
    build_tiles(p, l, ptile, ecnt);
    MoeSched<false> S{(const char*)(p.WdnT + (size_t)l * NE * 1024 * 1024), p.lists, ptile, ecnt, 4, 1024};
    EpiDown E{p.ybuf, p.b_dn + (size_t)l * NE * 1024, p.lists};
    pg8::gemm_phase((LAS unsigned char*)lds, (const char*)p.act, 1024, S, E);
}

__device__ __forceinline__ float gelu_tanh(float x) {
    const float u = 0.7978845608028654f * (x + 0.044715f * x * x * x);
    const float e = __expf(-2.0f * fabsf(u)); const float th = (1.0f - e) / (1.0f + e);
    return 0.5f * x * (1.0f + (u < 0.f ? -th : th));
}
__device__ __forceinline__ void phase_prep(const Params& p, int l, char* lds) {
    int tid = threadIdx.x; asm volatile("" : "+v"(tid));
    const int wid = tid >> 6, lane = tid & 63, fr = lane & 15, fq = lane >> 4;
    const int gw = blockIdx.x * NWV + wid, nw = gridDim.x * NWV;
    for (int u = gw; u < NB * 4; u += nw) {
        const int b = u >> 2, h = u & 3;
        const float* src = p.hs + (size_t)b * SEQ * HS_W + h;
        float* dst = p.cF + (size_t)u * SEQ;
        float tot = 0.f;
        for (int i = 0; i < 32; ++i) { const float f = src[(size_t)(lane * 32 + i) * HS_W]; tot += fminf(f, 0.f) - log1pf(__expf(-fabsf(f))); }
        float inc = tot;
#pragma unroll
        for (int o = 1; o < 64; o <<= 1) { const float v = __shfl_up(inc, o); if (lane >= o) inc += v; }
        float run = inc - tot;
        for (int i = 0; i < 32; ++i) { const float f = src[(size_t)(lane * 32 + i) * HS_W]; run += fminf(f, 0.f) - log1pf(__expf(-fabsf(f))); dst[lane * 32 + i] = run; }
    }
    bf16_t* h1 = (bf16_t*)(lds + wid * 2048);
    for (int u = gw; u < NB * 2 * 2 * 8; u += nw) {
        const int ct = u & 7, which = (u >> 3) & 1, kvh = (u >> 4) & 1, b = u >> 5;
        const int colo = (which ? C_NVC : C_NKC) + kvh * 64;
        const int c_lane = ct * 16 + fr;
        const int tokbase = min(c_lane, 126) * 16;
        const bf16_t* arow = p.hb + ((size_t)b * SEQ + tokbase) * NMAIN + colo + fq * 8;
        const bf16_t* w1 = p.W1T + ((size_t)(l * 2 + which) * 64 + fr) * 2048 + fq * 8;
        f32x4 acc[4];
#pragma unroll
        for (int n = 0; n < 4; ++n) acc[n] = (f32x4){0.f, 0.f, 0.f, 0.f};
        for (int ks = 0; ks < 64; ++ks) {
            const bf16x8 a = *(const bf16x8*)(arow + (size_t)(ks >> 1) * NMAIN + (ks & 1) * 32);
#pragma unroll
            for (int n = 0; n < 4; ++n) {
                const bf16x8 bb = *(const bf16x8*)(w1 + (size_t)n * 16 * 2048 + ks * 32);
                acc[n] = __builtin_amdgcn_mfma_f32_16x16x32_bf16(a, bb, acc[n], 0, 0, 0);
            }
        }
        const float* b1 = p.b1c + (l * 2 + which) * 64;
#pragma unroll
        for (int n = 0; n < 4; ++n)
#pragma unroll
            for (int r = 0; r < 4; ++r) h1[(fq * 4 + r) * 64 + n * 16 + fr] = f2bf(gelu_tanh(acc[n][r] + b1[n * 16 + fr]));
        lds_wave_sync();
        const bf16_t* w2 = p.W2T + ((size_t)(l * 2 + which) * 64 + fr) * 64 + fq * 8;
        f32x4 o2[4];
#pragma unroll
        for (int n = 0; n < 4; ++n) o2[n] = (f32x4){0.f, 0.f, 0.f, 0.f};
#pragma unroll
        for (int ks = 0; ks < 2; ++ks) {
            const bf16x8 a = *(const bf16x8*)(h1 + fr * 64 + ks * 32 + fq * 8);
#pragma unroll
            for (int n = 0; n < 4; ++n) {
                const bf16x8 bb = *(const bf16x8*)(w2 + (size_t)n * 16 * 64 + ks * 32);
                o2[n] = __builtin_amdgcn_mfma_f32_16x16x32_bf16(a, bb, o2[n], 0, 0, 0);
            }
        }
        lds_wave_sync();
        const size_t base = ((size_t)b * 2 + kvh) * 128 * 64;
#pragma unroll
        for (int n = 0; n < 4; ++n)
#pragma unroll
            for (int r = 0; r < 4; ++r) {
                const int c = ct * 16 + fq * 4 + r, j2 = n * 16 + fr;
                const bf16_t v = c < 127 ? f2bf(o2[n][r]) : (bf16_t)0;
                if (which == 0) p.kc[base + (size_t)c * 64 + j2] = v;
                else { p.vc[base + (size_t)c * 64 + j2] = v; p.vcT[base + (size_t)j2 * 128 + c] = v; }
            }
    }
}

constexpr float L2E = 1.4426950408889634f, MASKV = -1e30f, SCL2 = QSCALE * L2E;
template <int NQT, class MB>
__device__ __forceinline__ void attn_chunk(const bf16_t* __restrict__ Kb, size_t ldk, const bf16_t* __restrict__ VTb, size_t ldv, int kc0,
                                           const bf16x8 (&qf)[NQT][2], f32x4 (&o)[NQT][4], float (&m)[NQT], float (&l)[NQT], int fr, int fq, const MB& mb) {
    const bf16_t* kp = Kb + (size_t)(kc0 + (fr >> 2) * 8 + (fr & 3)) * ldk + fq * 8;
    bf16x8 kf[2][2];
    kf[0][0] = *(const bf16x8*)(kp); kf[0][1] = *(const bf16x8*)(kp + 32);
    kf[1][0] = *(const bf16x8*)(kp + 4 * ldk); kf[1][1] = *(const bf16x8*)(kp + 4 * ldk + 32);
    const bf16_t* vp = VTb + (size_t)fr * ldv + kc0 + fq * 8;
    bf16x8 vf[4];
#pragma unroll
    for (int dt = 0; dt < 4; ++dt) vf[dt] = *(const bf16x8*)(vp + (size_t)dt * 16 * ldv);
#pragma unroll
    for (int qt = 0; qt < NQT; ++qt) {
        f32x4 s0 = (f32x4){0.f, 0.f, 0.f, 0.f}, s1 = s0;
        s0 = __builtin_amdgcn_mfma_f32_16x16x32_bf16(kf[0][0], qf[qt][0], s0, 0, 0, 0);
        s0 = __builtin_amdgcn_mfma_f32_16x16x32_bf16(kf[0][1], qf[qt][1], s0, 0, 0, 0);
        s1 = __builtin_amdgcn_mfma_f32_16x16x32_bf16(kf[1][0], qf[qt][0], s1, 0, 0, 0);
        s1 = __builtin_amdgcn_mfma_f32_16x16x32_bf16(kf[1][1], qf[qt][1], s1, 0, 0, 0);
        float v[8];
#pragma unroll
        for (int j = 0; j < 4; ++j) { v[j] = mb(qt, j, s0[j]); v[j + 4] = mb(qt, j + 4, s1[j]); }
        float mx = fmaxf(fmaxf(fmaxf(v[0], v[1]), fmaxf(v[2], v[3])), fmaxf(fmaxf(v[4], v[5]), fmaxf(v[6], v[7])));
        mx = fmaxf(mx, __shfl_xor(mx, 16)); mx = fmaxf(mx, __shfl_xor(mx, 32));
        const float mnew = fmaxf(m[qt], mx);
        const float alpha = __builtin_amdgcn_exp2f(m[qt] - mnew);
        m[qt] = mnew;
        float pr[8]; float ps = 0.f;
#pragma unroll
        for (int j = 0; j < 8; ++j) { pr[j] = v[j] > -1e29f ? __builtin_amdgcn_exp2f(v[j] - mnew) : 0.f; ps += pr[j]; }
        l[qt] = l[qt] * alpha + ps;
#pragma unroll
        for (int dt = 0; dt < 4; ++dt) o[qt][dt] *= alpha;
        union { bf16x8 v8; unsigned u[4]; } pf;
        pf.u[0] = pack2(pr[0], pr[1]); pf.u[1] = pack2(pr[2], pr[3]); pf.u[2] = pack2(pr[4], pr[5]); pf.u[3] = pack2(pr[6], pr[7]);
#pragma unroll
        for (int dt = 0; dt < 4; ++dt) o[qt][dt] = __builtin_amdgcn_mfma_f32_16x16x32_bf16(vf[dt], pf.v8, o[qt][dt], 0, 0, 0);
        __builtin_amdgcn_sched_barrier(0);
    }
}
template <int NQT>
__device__ __forceinline__ void attn_init(f32x4 (&o)[NQT][4], float (&m)[NQT], float (&l)[NQT]) {
#pragma unroll
    for (int qt = 0; qt < NQT; ++qt) { m[qt] = MASKV; l[qt] = 0.f;
#pragma unroll
        for (int dt = 0; dt < 4; ++dt) o[qt][dt] = (f32x4){0.f, 0.f, 0.f, 0.f}; }
}
__device__ __forceinline__ float lsum4(float l) { l += __shfl_xor(l, 16); l += __shfl_xor(l, 32); return l; }
__device__ __forceinline__ void store_o4(bf16_t* dst, const f32x4 v) { u32x2 w; w.x = pack2(v[0], v[1]); w.y = pack2(v[2], v[3]); *(u32x2*)dst = w; }

__device__ __forceinline__ void fox_unit(const Params& p, int b, int h, int qb, int fr, int fq) {
    const int t0 = qb * 64;
    const bf16_t* Qb = p.hb + ((size_t)b * SEQ + t0) * NMAIN + C_FQ + h * 64 + fq * 8;
    bf16x8 qf[4][2];
#pragma unroll
    for (int qt = 0; qt < 4; ++qt) { qf[qt][0] = *(const bf16x8*)(Qb + (size_t)(qt * 16 + fr) * NMAIN); qf[qt][1] = *(const bf16x8*)(Qb + (size_t)(qt * 16 + fr) * NMAIN + 32); }
    const float* cf = p.cF + ((size_t)b * 4 + h) * SEQ;
    float cq[4];
#pragma unroll
    for (int qt = 0; qt < 4; ++qt) cq[qt] = cf[t0 + qt * 16 + fr] * L2E;
    f32x4 o[4][4]; float m[4], l[4];
    attn_init<4>(o, m, l);
    const bf16_t* Kb = p.hb + (size_t)b * SEQ * NMAIN + C_FK + h * 64;
    const bf16_t* VTb = p.vT + ((size_t)b * NVH + h) * 64 * SEQ;
    const int nchunk = (t0 + 64) >> 5;
    for (int c = 0; c < nchunk; ++c) {
        const int kc0 = c * 32;
        const float4 ca = *(const float4*)(cf + kc0 + 8 * fq), cb = *(const float4*)(cf + kc0 + 8 * fq + 4);
        const float ck[8] = {ca.x * L2E, ca.y * L2E, ca.z * L2E, ca.w * L2E, cb.x * L2E, cb.y * L2E, cb.z * L2E, cb.w * L2E};
        const bool diag = kc0 + 31 > t0;
        const int kq = kc0 + 8 * fq - t0 - fr;
        attn_chunk<4>(Kb, NMAIN, VTb, SEQ, kc0, qf, o, m, l, fr, fq, [&](int qt, int j, float raw) {
            float v = raw * SCL2 + cq[qt] - ck[j];
            if (diag && (kq + j - 16 * qt) > 0) v = MASKV;
            return v; });
    }
#pragma unroll
    for (int qt = 0; qt < 4; ++qt) {
        const float inv = 1.0f / lsum4(l[qt]);
        bf16_t* dst = p.ob + ((size_t)b * SEQ + t0 + qt * 16 + fr) * DM + h * 64 + 4 * fq;
#pragma unroll
        for (int dt = 0; dt < 4; ++dt) store_o4(dst + dt * 16, o[qt][dt] * inv);
    }
}
__device__ __forceinline__ void swa_unit(const Params& p, int l_, int b, int kv, int pos, int fr, int fq) {
    const int t0 = pos * 16, t = t0 + fr;
    const bf16_t* Qb = p.hb + ((size_t)b * SEQ + t) * NMAIN + C_SQ + kv * 192 + fq * 8;
    bf16x8 qf[3][2];
#pragma unroll
    for (int g = 0; g < 3; ++g) { qf[g][0] = *(const bf16x8*)(Qb + g * 64); qf[g][1] = *(const bf16x8*)(Qb + g * 64 + 32); }
    float sl[3];
#pragma unroll
    for (int g = 0; g < 3; ++g) sl[g] = slope_swa(kv * 3 + g) * L2E;
    f32x4 o[3][4]; float m[3], l[3];
    attn_init<3>(o, m, l);
    const bf16_t* Kb = p.hb + (size_t)b * SEQ * NMAIN + C_SK + kv * 64;
    const bf16_t* VTb = p.vT + ((size_t)b * NVH + 4 + kv) * 64 * SEQ;
    const int c_lo = max(0, t0 - 127) >> 5, c_hi = (t0 + 15) >> 5;
    for (int c = c_lo; c <= c_hi; ++c) {
        const int kc0 = c * 32, dq = t - kc0 - 8 * fq;
        attn_chunk<3>(Kb, NMAIN, VTb, SEQ, kc0, qf, o, m, l, fr, fq, [&](int g, int j, float raw) {
            const int dist = dq - j;
            return (dist >= 0 && dist < 128) ? raw * SCL2 - sl[g] * (float)dist : MASKV; });
    }
#pragma unroll
    for (int g = 0; g < 3; ++g) {
        const float sink = p.sinks[l_ * 6 + kv * 3 + g] * L2E;
        const float inv = 1.0f / (lsum4(l[g]) + __builtin_amdgcn_exp2f(sink - m[g]));
        bf16_t* dst = p.ob + ((size_t)b * SEQ + t) * DM + 256 + (kv * 3 + g) * 64 + 4 * fq;
#pragma unroll
        for (int dt = 0; dt < 4; ++dt) store_o4(dst + dt * 16, o[g][dt] * inv);
    }
}
__device__ __forceinline__ void nsa_unit(const Params& p, int b, int kv, int pos, int fr, int fq, int lane, float* ps, unsigned* msk, float* otl) {
    const int t0 = pos * 16, t = t0 + fr, cur = t0 >> 6;
    const bf16_t* Qb = p.hb + ((size_t)b * SEQ + t) * NMAIN + C_NQ + kv * 192 + fq * 8;
    bf16x8 qf[3][2];
#pragma unroll
    for (int g = 0; g < 3; ++g) { qf[g][0] = *(const bf16x8*)(Qb + g * 64); qf[g][1] = *(const bf16x8*)(Qb + g * 64 + 32); }
    float sl[3];
#pragma unroll
    for (int g = 0; g < 3; ++g) sl[g] = slope_nsa(kv * 3 + g) * L2E;
    const float* gl = p.hs + ((size_t)b * SEQ + t) * HS_W + 4 + kv * 9;
    f32x4 o[3][4]; float m[3], l[3];
    f32x4* otv = (f32x4*)otl + lane;
#pragma unroll
    for (int i = 0; i < 8; ++i) ps[lane + 64 * i] = 0.f;
    {
        const bf16_t* Kb = p.kc + ((size_t)b * 2 + kv) * 128 * 64;
        const bf16_t* VTb = p.vcT + ((size_t)b * 2 + kv) * 64 * 128;
        const int ncv = (t0 + 15 >= 31) ? ((t0 + 15 - 31) >> 4) + 1 : 0;
        const int nch = (ncv + 31) >> 5;
        attn_init<3>(o, m, l);
        const int dq0 = t - 31 - 16 * 8 * fq;
        for (int c = 0; c < nch; ++c) {
            const int kc0 = c * 32, dq = dq0 - 16 * kc0;
            attn_chunk<3>(Kb, 64, VTb, 128, kc0, qf, o, m, l, fr, fq, [&](int g, int j, float raw) {
                const int dist = dq - 16 * j;
                return dist >= 0 ? raw * SCL2 - sl[g] * (float)dist : MASKV; });
        }
        float il[3];
#pragma unroll
        for (int g = 0; g < 3; ++g) {
            const float lt = lsum4(l[g]); il[g] = lt > 0.f ? 1.0f / lt : 0.f;
            const float gate = 1.0f / (1.0f + __expf(-gl[g * 3 + 0]));
#pragma unroll
            for (int dt = 0; dt < 4; ++dt) otv[(g * 4 + dt) * 64] = o[g][dt] * (il[g] * gate);
        }
        float carry_prev = 0.f;
        for (int c = 0; c < nch; ++c) {
            const int kc0 = c * 32, dq = dq0 - 16 * kc0;
            const bf16_t* kp = Kb + (size_t)(kc0 + (fr >> 2) * 8 + (fr & 3)) * 64 + fq * 8;
            const bf16x8 k00 = *(const bf16x8*)(kp), k01 = *(const bf16x8*)(kp + 32), k10 = *(const bf16x8*)(kp + 256), k11 = *(const bf16x8*)(kp + 256 + 32);
            float pc[8];
#pragma unroll
            for (int j = 0; j < 8; ++j) pc[j] = 0.f;
#pragma unroll
            for (int g = 0; g < 3; ++g) {
                f32x4 s0 = (f32x4){0.f, 0.f, 0.f, 0.f}, s1 = s0;
                s0 = __builtin_amdgcn_mfma_f32_16x16x32_bf16(k00, qf[g][0], s0, 0, 0, 0); s0 = __builtin_amdgcn_mfma_f32_16x16x32_bf16(k01, qf[g][1], s0, 0, 0, 0);
                s1 = __builtin_amdgcn_mfma_f32_16x16x32_bf16(k10, qf[g][0], s1, 0, 0, 0); s1 = __builtin_amdgcn_mfma_f32_16x16x32_bf16(k11, qf[g][1], s1, 0, 0, 0);
#pragma unroll
                for (int j = 0; j < 8; ++j) {
                    const int dist = dq - 16 * j; const float raw = j < 4 ? s0[j] : s1[j - 4];
                    if (dist >= 0) pc[j] += __builtin_amdgcn_exp2f(raw * SCL2 - sl[g] * (float)dist - m[g]) * il[g];
                }
            }
            const float cout = 0.5f * pc[7];
            float cin = __shfl_up(cout, 16);
            const float cwrap = __shfl(cout, fr + 48);
            if (fq == 0) cin = carry_prev;
            carry_prev = cwrap;
            const int n0 = (kc0 >> 2) + 2 * fq;
            ps[fr * 32 + n0] = cin + pc[0] + pc[1] + pc[2] + 0.5f * pc[3];
            ps[fr * 32 + n0 + 1] = 0.5f * pc[3] + pc[4] + pc[5] + pc[6] + 0.5f * pc[7];
        }
    }
    lds_wave_sync();
    if (lane < 16) {
        unsigned mask = 1u | (1u << cur); if (cur >= 1) mask |= 1u << (cur - 1);
        if (cur >= 3) {
            if (cur - 2 <= 5) mask |= (1u << (cur - 1)) - 2u;
            else {
                const float* my = ps + lane * 32;
                for (int r = 0; r < 5; ++r) {
                    float best = -1.0f; int bi = 1;
                    for (int j = 1; j <= cur - 2; ++j) { const float v = my[j]; if (!((mask >> j) & 1u) && v > best) { best = v; bi = j; } }
                    mask |= 1u << bi;
                }
            }
        }
        msk[lane] = mask;
    }
    lds_wave_sync();
    const unsigned qmask = msk[fr];
    lds_wave_sync();
    {
        const bf16_t* Kb = p.hb + (size_t)b * SEQ * NMAIN + C_NKS + kv * 64;
        const bf16_t* VTb = p.vT + ((size_t)b * NVH + 6 + kv) * 64 * SEQ;
        attn_init<3>(o, m, l);
        for (int kb = 0; kb <= cur; ++kb) {
            const bool mine = (qmask >> kb) & 1u;
            if (__ballot(mine) == 0ull) continue;
#pragma unroll 1
            for (int hc = 0; hc < 2; ++hc) {
                const int kc0 = kb * 64 + hc * 32, dq = t - kc0 - 8 * fq;
                attn_chunk<3>(Kb, NMAIN, VTb, SEQ, kc0, qf, o, m, l, fr, fq, [&](int g, int j, float raw) {
                    const int dist = dq - j;
                    return (mine && dist >= 0) ? raw * SCL2 - sl[g] * (float)dist : MASKV; });
            }
        }
#pragma unroll
        for (int g = 0; g < 3; ++g) {
            const float lt = lsum4(l[g]); const float sc = (lt > 0.f ? 1.0f / lt : 0.f) / (1.0f + __expf(-gl[g * 3 + 1]));
#pragma unroll
            for (int dt = 0; dt < 4; ++dt) otv[(g * 4 + dt) * 64] += o[g][dt] * sc;
        }
    }
    {
        const bf16_t* Kb = p.hb + (size_t)b * SEQ * NMAIN + C_NKW + kv * 64;
        const bf16_t* VTb = p.vT + ((size_t)b * NVH + 8 + kv) * 64 * SEQ;
        attn_init<3>(o, m, l);
        const int c_lo = max(0, t0 - 511) >> 5, c_hi = (t0 + 15) >> 5;
        for (int c = c_lo; c <= c_hi; ++c) {
            const int kc0 = c * 32, dq = t - kc0 - 8 * fq;
            attn_chunk<3>(Kb, NMAIN, VTb, SEQ, kc0, qf, o, m, l, fr, fq, [&](int g, int j, float raw) {
                const int dist = dq - j;
                return (dist >= 0 && dist < 512) ? raw * SCL2 - sl[g] * (float)dist : MASKV; });
        }
#pragma unroll
        for (int g = 0; g < 3; ++g) {
            const float lt = lsum4(l[g]); const float sc = (lt > 0.f ? 1.0f / lt : 0.f) / (1.0f + __expf(-gl[g * 3 + 2]));
            bf16_t* dst = p.ob + ((size_t)b * SEQ + t) * DM + 640 + (kv * 3 + g) * 64 + 4 * fq;
#pragma unroll
            for (int dt = 0; dt < 4; ++dt) store_o4(dst + dt * 16, otv[(g * 4 + dt) * 64] + o[g][dt] * sc);
        }
    }
}

__device__ __forceinline__ void phase_attn(const Params& p, int l, char* lds) {
    int tid = threadIdx.x; asm volatile("" : "+v"(tid));
    const int wid = tid >> 6, lane = tid & 63, fr = lane & 15, fq = lane >> 4;
    float* ps = (float*)(lds + wid * 14592); unsigned* msk = (unsigned*)(ps + 512); float* otl = ps + 576;
    unsigned* ctr = p.ctrl + 16 + l;
    constexpr unsigned NU_NSA = NB * 2 * 128, NU_FOX = NB * 4 * 32, NU_SWA = NB * 2 * 128;
    for (;;) {
        unsigned u = 0;
        if (lane == 0) u = __hip_atomic_fetch_add(ctr, 1u, __ATOMIC_RELAXED, __HIP_MEMORY_SCOPE_AGENT);
        u = (unsigned)__builtin_amdgcn_readfirstlane((int)u);
        if (u >= NU_NSA + NU_FOX + NU_SWA) break;
        if (u < NU_NSA) { const int pos = 127 - (int)(u >> 5), r = u & 31; nsa_unit(p, r >> 1, r & 1, pos, fr, fq, lane, ps, msk, otl); }
        else if (u < NU_NSA + NU_FOX) { const unsigned v = u - NU_NSA; const int qb = 31 - (int)(v >> 6), r = v & 63; fox_unit(p, r >> 2, r & 3, qb, fr, fq); }
        else { const unsigned v = u - NU_NSA - NU_FOX; const int pos = 127 - (int)(v >> 5), r = v & 31; swa_unit(p, l, r >> 1, r & 1, pos, fr, fq); }
    }
}

__device__ __forceinline__ void phase_ln1_router(const Params& p, int l, char* lds) {
    int tid = threadIdx.x; asm volatile("" : "+v"(tid));
    const int wid = tid >> 6, lane = tid & 63, fr = lane & 15, fq = lane >> 4;
    float* lg = (float*)lds + wid * 512;
    int* lcnt = (int*)(lds + 16384); int* lbase = lcnt + 32;
    const float* g1 = p.ln1_g + l * DM; const float* b1 = p.ln1_b + l * DM;
    const float* rw = p.rwT + (size_t)l * NE * 1024; const float* rb = p.router_b + l * NE;
    unsigned* gcount = p.ctrl + 64 + l * NE;
    for (int grp = blockIdx.x; grp < NTOK / 128; grp += gridDim.x) {
        const int tok0 = grp * 128 + wid * 16;
        if (tid < 32) lcnt[tid] = 0;
        for (int r = 0; r < 16; ++r) {
            const size_t row = (size_t)(tok0 + r);
            float4 v[4]; float s = 0.f;
#pragma unroll
            for (int j = 0; j < 4; ++j) { v[j] = *(const float4*)(p.tbuf + row * DM + j * 256 + lane * 4); s += (v[j].x + v[j].y) + (v[j].z + v[j].w); }
            const float mean = wave_sum(s) * (1.0f / 1024.0f);
            float qv = 0.f;
#pragma unroll
            for (int j = 0; j < 4; ++j) { v[j].x -= mean; v[j].y -= mean; v[j].z -= mean; v[j].w -= mean; qv += (v[j].x * v[j].x + v[j].y * v[j].y) + (v[j].z * v[j].z + v[j].w * v[j].w); }
            const float rstd = rsqrtf(wave_sum(qv) * (1.0f / 1024.0f) + LN_EPS);
#pragma unroll
            for (int j = 0; j < 4; ++j) {
                const int c = j * 256 + lane * 4;
                const float4 gg = *(const float4*)(g1 + c), bb = *(const float4*)(b1 + c);
                float4 y; y.x = v[j].x * rstd * gg.x + bb.x; y.y = v[j].y * rstd * gg.y + bb.y; y.z = v[j].z * rstd * gg.z + bb.z; y.w = v[j].w * rstd * gg.w + bb.w;
                *(float4*)(p.x1f + row * DM + c) = y;
                u32x2 w; w.x = pack2(y.x, y.y); w.y = pack2(y.z, y.w);
                *(u32x2*)(p.x1b + row * DM + c) = w;
            }
        }
        __syncthreads();
        f32x4 a0 = (f32x4){0.f, 0.f, 0.f, 0.f}, a1 = a0;
        const float* xr = p.x1f + (size_t)(tok0 + fr) * DM + 4 * fq;
        const float* w0 = rw + (size_t)fr * 1024 + 4 * fq; const float* w1 = rw + (size_t)(16 + fr) * 1024 + 4 * fq;
        for (int k0 = 0; k0 < 1024; k0 += 16) {
            const float4 xa = *(const float4*)(xr + k0), wb0 = *(const float4*)(w0 + k0), wb1 = *(const float4*)(w1 + k0);
            a0 = __builtin_amdgcn_mfma_f32_16x16x4f32(xa.x, wb0.x, a0, 0, 0, 0); a1 = __builtin_amdgcn_mfma_f32_16x16x4f32(xa.x, wb1.x, a1, 0, 0, 0);
            a0 = __builtin_amdgcn_mfma_f32_16x16x4f32(xa.y, wb0.y, a0, 0, 0, 0); a1 = __builtin_amdgcn_mfma_f32_16x16x4f32(xa.y, wb1.y, a1, 0, 0, 0);
            a0 = __builtin_amdgcn_mfma_f32_16x16x4f32(xa.z, wb0.z, a0, 0, 0, 0); a1 = __builtin_amdgcn_mfma_f32_16x16x4f32(xa.z, wb1.z, a1, 0, 0, 0);
            a0 = __builtin_amdgcn_mfma_f32_16x16x4f32(xa.w, wb0.w, a0, 0, 0, 0); a1 = __builtin_amdgcn_mfma_f32_16x16x4f32(xa.w, wb1.w, a1, 0, 0, 0);
        }
#pragma unroll
        for (int r = 0; r < 4; ++r) { lg[(fq * 4 + r) * 32 + fr] = a0[r] + rb[fr]; lg[(fq * 4 + r) * 32 + 16 + fr] = a1[r] + rb[16 + fr]; }
        lds_wave_sync();
        int e4[4] = {0, 0, 0, 0}; int rk[4] = {0, 0, 0, 0};
        if (lane < 16) {
            const float* my = lg + lane * 32; unsigned taken = 0u; float tv[4];
#pragma unroll
            for (int k = 0; k < 4; ++k) {
                float best = NEG_INF; int bi = 0;
                for (int e = 0; e < 32; ++e) { const float xv = my[e]; if (!((taken >> e) & 1u) && xv > best) { best = xv; bi = e; } }
                taken |= 1u << bi; e4[k] = bi; tv[k] = best;
            }
            const float e1 = __expf(tv[1] - tv[0]), e2 = __expf(tv[2] - tv[0]), e3 = __expf(tv[3] - tv[0]);
            const float inv = 1.0f / (1.0f + e1 + e2 + e3);
            const size_t row = (size_t)(tok0 + lane);
            *(int4*)(p.top_e + row * 4) = make_int4(e4[0], e4[1], e4[2], e4[3]);
            *(float4*)(p.gw + row * 4) = make_float4(inv, e1 * inv, e2 * inv, e3 * inv);
        }
        __syncthreads();
        if (lane < 16) {
#pragma unroll
            for (int k = 0; k < 4; ++k) rk[k] = atomicAdd(&lcnt[e4[k]], 1);
        }
        __syncthreads();
        if (tid < 32) { const int c = lcnt[tid]; lbase[tid] = c ? (int)__hip_atomic_fetch_add(gcount + tid, (unsigned)c, __ATOMIC_RELAXED, __HIP_MEMORY_SCOPE_AGENT) : 0; }
        __syncthreads();
        if (lane < 16) {
            const int row = tok0 + lane;
#pragma unroll
            for (int k = 0; k < 4; ++k) p.lists[(size_t)e4[k] * LIST_CAP + lbase[e4[k]] + rk[k]] = row * 4 + k;
        }
        __syncthreads();
    }
}

__device__ __forceinline__ void phase_ln2(const Params& p, int l, float* xout) {
    int tid = threadIdx.x; asm volatile("" : "+v"(tid));
    const int wid = tid >> 6, lane = tid & 63;
    const float* g2 = p.ln2_g + l * DM; const float* b2 = p.ln2_b + l * DM;
    for (int row = blockIdx.x * NWV + wid; row < NTOK; row += gridDim.x * NWV) {
        const float4 gwv = *(const float4*)(p.gw + (size_t)row * 4);
        const float gk[4] = {gwv.x, gwv.y, gwv.z, gwv.w};
        float4 v[4]; float s = 0.f;
#pragma unroll
        for (int j = 0; j < 4; ++j) {
            const int c = j * 256 + lane * 4;
            const float4 xv = *(const float4*)(p.x1f + (size_t)row * DM + c);
            float4 a; a.x = xv.x * ALPHA; a.y = xv.y * ALPHA; a.z = xv.z * ALPHA; a.w = xv.w * ALPHA;
#pragma unroll
            for (int k = 0; k < 4; ++k) {
                const u32x2 w = *(const u32x2*)(p.ybuf + ((size_t)row * 4 + k) * DM + c);
                a.x += gk[k] * __uint_as_float(w.x << 16); a.y += gk[k] * __uint_as_float(w.x & 0xffff0000u);
                a.z += gk[k] * __uint_as_float(w.y << 16); a.w += gk[k] * __uint_as_float(w.y & 0xffff0000u);
            }
            v[j] = a; s += (a.x + a.y) + (a.z + a.w);
        }
        const float mean = wave_sum(s) * (1.0f / 1024.0f);
        float qv = 0.f;
#pragma unroll
        for (int j = 0; j < 4; ++j) { v[j].x -= mean; v[j].y -= mean; v[j].z -= mean; v[j].w -= mean; qv += (v[j].x * v[j].x + v[j].y * v[j].y) + (v[j].z * v[j].z + v[j].w * v[j].w); }
        const float rstd = rsqrtf(wave_sum(qv) * (1.0f / 1024.0f) + LN_EPS);
#pragma unroll
        for (int j = 0; j < 4; ++j) {
            const int c = j * 256 + lane * 4;
            const float4 gg = *(const float4*)(g2 + c), bb = *(const float4*)(b2 + c);
            float4 y; y.x = v[j].x * rstd * gg.x + bb.x; y.y = v[j].y * rstd * gg.y + bb.y; y.z = v[j].z * rstd * gg.z + bb.z; y.w = v[j].w * rstd * gg.w + bb.w;
            *(float4*)(xout + (size_t)row * DM + c) = y;
            u32x2 w; w.x = pack2(y.x, y.y); w.y = pack2(y.z, y.w);
            *(u32x2*)(p.xb + (size_t)row * DM + c) = w;
        }
    }
}


#define XB_TMO      128
#define XB_XCNT(j)  (256  + 64 * (j))
#define XB_XSUB(j)  (1280 + 64 * (j))
#define XB_XGEN(j)  (2304 + 64 * (j))
#define XB_TOP      3328
#define XB_TOPGEN   3392
#define XCD_BAR_WORDS 3456
#define XB_SPIN_CAP (1u << 22)
__device__ __forceinline__ unsigned xb_ld(unsigned* p)              { return __hip_atomic_load(p, __ATOMIC_RELAXED, __HIP_MEMORY_SCOPE_AGENT); }
__device__ __forceinline__ unsigned xb_add(unsigned* p, unsigned v) { return __hip_atomic_fetch_add(p, v, __ATOMIC_RELAXED, __HIP_MEMORY_SCOPE_AGENT); }
__device__ __forceinline__ unsigned xb_xcc_id() { return (unsigned)__builtin_amdgcn_s_getreg((3 << 11) | 20) & 0xFu; }
#define XB_SPIN(cond, bar) do { unsigned _sp = 0; while (cond) { __builtin_amdgcn_s_sleep(1); \
    if ((++_sp & 255u) == 0u) { if (xb_ld(&(bar)[XB_TMO])) break; if (_sp > XB_SPIN_CAP) { atomicAdd(&(bar)[XB_TMO], 1u); break; } } } } while (0)
struct XcdBarrier { unsigned* bar; unsigned x; volatile LAS unsigned* st; };
__device__ __forceinline__ XcdBarrier xcd_barrier_post(unsigned* bar, volatile LAS unsigned* st) {
    XcdBarrier b; b.bar = bar; b.x = xb_xcc_id(); b.st = st;
    if (threadIdx.x == 0) (void)xb_add(&bar[XB_XCNT(b.x)], 1u);
    return b;
}
__device__ __forceinline__ void xcd_barrier_complete(unsigned* bar, unsigned x, unsigned& nloc, unsigned& nx) {
    const unsigned G = gridDim.x * gridDim.y * gridDim.z;
    unsigned sum, cnt, mine, sp = 0u;
    for (;;) {
        sum = 0u; cnt = 0u; mine = 0u;
#pragma unroll
        for (unsigned j = 0; j < 16; ++j) { const unsigned c = xb_ld(&bar[XB_XCNT(j)]); sum += c; cnt += (c > 0u) ? 1u : 0u; mine = (j == x) ? c : mine; }
        if (sum == G) break;
        __builtin_amdgcn_s_sleep(1);
        if ((++sp & 255u) == 0u) { if (xb_ld(&bar[XB_TMO])) break; if (sp > XB_SPIN_CAP) { atomicAdd(&bar[XB_TMO], 1u); break; } }
    }
    nloc = mine > 0u ? mine : 1u; nx = cnt > 0u ? cnt : 1u;
}
__device__ __forceinline__ void xcd_barrier(const XcdBarrier& b) {
    asm volatile("s_waitcnt vmcnt(0)" ::: "memory");
    __syncthreads();
    if (threadIdx.x == 0) {
        unsigned* bar = b.bar;
        __builtin_amdgcn_s_waitcnt(0);
        unsigned nloc = b.st[0], nx = b.st[1];
        if (nloc == 0u) { xcd_barrier_complete(bar, b.x, nloc, nx); b.st[0] = nloc; b.st[1] = nx; }
        const unsigned old = xb_add(&bar[XB_XSUB(b.x)], 1u);
        const unsigned gen = old / nloc;
        if (old + 1u == (gen + 1u) * nloc) {
            __builtin_amdgcn_fence(__ATOMIC_RELEASE, "agent");
            asm volatile("s_waitcnt vmcnt(0)" ::: "memory");
            const unsigned og = xb_add(&bar[XB_TOP], 1u);
            const unsigned tg = og / nx;
            if (og + 1u == (tg + 1u) * nx) xb_add(&bar[XB_TOPGEN], 1u);
            else XB_SPIN(xb_ld(&bar[XB_TOPGEN]) == tg, bar);
            __builtin_amdgcn_fence(__ATOMIC_ACQUIRE, "agent");
            xb_add(&bar[XB_XGEN(b.x)], 1u);
            asm volatile("s_waitcnt vmcnt(0)" ::: "memory");
        } else {
            XB_SPIN(xb_ld(&bar[XB_XGEN(b.x)]) == gen, bar);
            __builtin_amdgcn_fence(__ATOMIC_ACQUIRE, "agent");
            asm volatile("s_waitcnt vmcnt(0)" ::: "memory");
        }
    }
    __syncthreads();
}

struct KArgs { const float* in[18]; float* out; char* ws; };
constexpr size_t al256(size_t v) { return (v + 255) / 256 * 256; }
struct WSL {
    static constexpr size_t ctrl = 0;
    static constexpr size_t WinT = al256(ctrl + 65536);
    static constexpr size_t WoT = al256(WinT + (size_t)NL * NPAD * 1024 * 2);
    static constexpr size_t W1T = al256(WoT + (size_t)NL * 1024 * 1024 * 2);
    static constexpr size_t W2T = al256(W1T + (size_t)NL * 2 * 64 * 2048 * 2);
    static constexpr size_t WguT = al256(W2T + (size_t)NL * 2 * 64 * 64 * 2);
    static constexpr size_t WdnT = al256(WguT + (size_t)NL * NE * 2048 * 1024 * 2);
    static constexpr size_t rwT = al256(WdnT + (size_t)NL * NE * 1024 * 1024 * 2);
    static constexpr size_t binp = al256(rwT + (size_t)NL * NE * 1024 * 4);
    static constexpr size_t bgup = al256(binp + (size_t)NL * NPAD * 4);
    static constexpr size_t b1c = al256(bgup + (size_t)NL * NE * 2048 * 4);
    static constexpr size_t xf = al256(b1c + 4 * 64 * 4);
    static constexpr size_t xb = al256(xf + (size_t)NTOK * DM * 4);
    static constexpr size_t hb = al256(xb + (size_t)NTOK * DM * 2);
    static constexpr size_t hs = al256(hb + (size_t)NTOK * NMAIN * 2);
    static constexpr size_t vT = al256(hs + (size_t)NTOK * HS_W * 4);
    static constexpr size_t cF = al256(vT + (size_t)NB * NVH * 64 * SEQ * 2);
    static constexpr size_t kc = al256(cF + (size_t)NB * 4 * SEQ * 4);
    static constexpr size_t vc = al256(kc + (size_t)NB * 2 * 128 * 64 * 2);
    static constexpr size_t vcT = al256(vc + (size_t)NB * 2 * 128 * 64 * 2);
    static constexpr size_t ob = al256(vcT + (size_t)NB * 2 * 128 * 64 * 2);
    static constexpr size_t tbuf = al256(ob + (size_t)NTOK * DM * 2);
    static constexpr size_t x1f = al256(tbuf + (size_t)NTOK * DM * 4);
    static constexpr size_t x1b = al256(x1f + (size_t)NTOK * DM * 4);
    static constexpr size_t top_e = al256(x1b + (size_t)NTOK * DM * 2);
    static constexpr size_t gw = al256(top_e + (size_t)NTOK * 4 * 4);
    static constexpr size_t lists = al256(gw + (size_t)NTOK * 4 * 4);
    static constexpr size_t act = al256(lists + (size_t)NE * LIST_CAP * 4);
    static constexpr size_t ybuf = al256(act + (size_t)MAXSLOT * DFF * 2);
    static constexpr size_t total = al256(ybuf + (size_t)NTOK * 4 * DM * 2);
};
__device__ __forceinline__ Params make_params(const KArgs& k) {
    Params p;
    p.x = k.in[0]; p.w_in = k.in[1]; p.b_in = k.in[2]; p.sinks = k.in[3]; p.cmp_pe = k.in[4]; p.cmp_w1 = k.in[5]; p.cmp_w2 = k.in[6]; p.w_out = k.in[7];
    p.ln1_g = k.in[8]; p.ln1_b = k.in[9]; p.router_w = k.in[10]; p.router_b = k.in[11]; p.w_gu = k.in[12]; p.b_gu = k.in[13]; p.w_dn = k.in[14]; p.b_dn = k.in[15];
    p.ln2_g = k.in[16]; p.ln2_b = k.in[17]; p.out = k.out;
    char* w = k.ws;
    p.ctrl = (unsigned*)(w + WSL::ctrl); p.WinT = (bf16_t*)(w + WSL::WinT); p.WoT = (bf16_t*)(w + WSL::WoT); p.W1T = (bf16_t*)(w + WSL::W1T); p.W2T = (bf16_t*)(w + WSL::W2T);
    p.WguT = (bf16_t*)(w + WSL::WguT); p.WdnT = (bf16_t*)(w + WSL::WdnT); p.rwT = (float*)(w + WSL::rwT); p.binp = (float*)(w + WSL::binp); p.bgup = (float*)(w + WSL::bgup);
    p.b1c = (float*)(w + WSL::b1c); p.xf = (float*)(w + WSL::xf); p.xb = (bf16_t*)(w + WSL::xb); p.hb = (bf16_t*)(w + WSL::hb); p.hs = (float*)(w + WSL::hs); p.vT = (bf16_t*)(w + WSL::vT);
    p.cF = (float*)(w + WSL::cF); p.kc = (bf16_t*)(w + WSL::kc); p.vc = (bf16_t*)(w + WSL::vc); p.vcT = (bf16_t*)(w + WSL::vcT); p.ob = (bf16_t*)(w + WSL::ob); p.tbuf = (float*)(w + WSL::tbuf);
    p.x1f = (float*)(w + WSL::x1f); p.x1b = (bf16_t*)(w + WSL::x1b); p.top_e = (int*)(w + WSL::top_e); p.gw = (float*)(w + WSL::gw); p.lists = (int*)(w + WSL::lists);
    p.act = (bf16_t*)(w + WSL::act); p.ybuf = (bf16_t*)(w + WSL::ybuf);
    return p;
}
__device__ __forceinline__ void grid_bar(const Params& p, char* lds) {
    XcdBarrier xb; xb.bar = p.ctrl + 1024; xb.x = xb_xcc_id(); xb.st = (volatile LAS unsigned*)(lds + LDS_BYTES - 16); xcd_barrier(xb);
}
template <int L>
__device__ __forceinline__ void layer_fwd(const Params& p, char* lds) {
    const float* xin = L == 0 ? p.x : p.xf;
    float* xout = L == NL - 1 ? p.out : p.xf;
    phase_inproj(p, L, lds);        grid_bar(p, lds);
    phase_prep(p, L, lds);          grid_bar(p, lds);
    phase_attn(p, L, lds);          grid_bar(p, lds);
    phase_outproj(p, L, xin, lds);  grid_bar(p, lds);
    phase_ln1_router(p, L, lds);    grid_bar(p, lds);
    phase_gateup(p, L, lds);        grid_bar(p, lds);
    phase_down(p, L, lds);          grid_bar(p, lds);
    phase_ln2(p, L, xout);
}
__global__ void __launch_bounds__(NTHR, 2) fwd_kernel(KArgs ka) {
    extern __shared__ __attribute__((aligned(16))) char lds[];
    const Params p = make_params(ka);
    cg::grid_group grid = cg::this_grid();
    volatile LAS unsigned* xst = (volatile LAS unsigned*)(lds + LDS_BYTES - 16);
    if (threadIdx.x == 0) { xst[0] = 0u; xst[1] = 0u; }
    __syncthreads();
    (void)xcd_barrier_post(p.ctrl + 1024, xst);
    phase0(p, lds);
    grid.sync();
    layer_fwd<0>(p, lds);
    grid_bar(p, lds);
    layer_fwd<1>(p, lds);
}

extern "C" void kernel_launch(void* const* d_in, const int* in_sizes, int n_in, void* d_out, int out_size, void* d_ws, size_t ws_size, hipStream_t stream) {
    KArgs ka{};
    for (int i = 0; i < 18; ++i) ka.in[i] = (const float*)d_in[i];
    ka.out = (float*)d_out; ka.ws = (char*)d_ws;
    if (WSL::total > ws_size) { fprintf(stderr, "workspace too small: need %zu have %zu\n", (size_t)WSL::total, ws_size); return; }
    static int grid_blocks = 0;
    if (!grid_blocks) {
        int dev = 0, cus = 0, per_cu = 0;
        (void)hipGetDevice(&dev);
        (void)hipDeviceGetAttribute(&cus, hipDeviceAttributeMultiprocessorCount, dev);
        (void)hipFuncSetAttribute((const void*)fwd_kernel, hipFuncAttributeMaxDynamicSharedMemorySize, LDS_BYTES);
        (void)hipOccupancyMaxActiveBlocksPerMultiprocessor(&per_cu, fwd_kernel, NTHR, LDS_BYTES);
        if (per_cu < 1) { fprintf(stderr, "occupancy query says 0 blocks per CU\n"); per_cu = 1; }
        grid_blocks = cus;
    }
    (void)hipMemsetAsync(d_ws, 0, 65536, stream);
    void* args[] = {&ka};
    hipError_t e = hipLaunchCooperativeKernel((const void*)fwd_kernel, dim3(grid_blocks), dim3(NTHR), args, LDS_BYTES, stream);
    if (e != hipSuccess) fprintf(stderr, "cooperative launch failed: %s (grid %d)\n", hipGetErrorString(e), grid_blocks);
}
```

```cpp
#include <hip/hip_runtime.h>
#include <hip/hip_cooperative_groups.h>
#include <cstdio>
#include <cstdint>
namespace cg = cooperative_groups;

typedef unsigned short bf16_t;
typedef short bf16x8 __attribute__((ext_vector_type(8)));
typedef float f32x4 __attribute__((ext_vector_type(4)));
typedef unsigned u32x4 __attribute__((ext_vector_type(4)));
typedef unsigned u32x2 __attribute__((ext_vector_type(2)));
#define LAS __attribute__((address_space(3)))
constexpr float NEG_INF = -__builtin_huge_valf();

constexpr int DM = 1024, NB = 16, SEQ = 2048, NTOK = NB * SEQ, NL = 2;
constexpr int NCOL = 2582, NMAIN = 2560, NPAD = 2688, NE = 32, DFF = 1024;
constexpr int C_FQ = 0, C_FK = 256, C_FV = 512, C_SQ = 768, C_SK = 1152, C_SV = 1280, C_NQ = 1408,
              C_NKC = 1792, C_NVC = 1920, C_NKS = 2048, C_NVS = 2176, C_NKW = 2304, C_NVW = 2432;
constexpr int HS_W = 32;
constexpr int NVH = 10;
constexpr int LIST_CAP = NTOK;
constexpr int MAXSLOT = NTOK * 4 + NE * 256;
constexpr float ALPHA = 1.41421356237f, LN_EPS = 1e-5f, QSCALE = 0.125f;
constexpr int NWV = 8, NTHR = NWV * 64;
constexpr int LDS_STAGE = 131072, LDS_TAB = LDS_STAGE, LDS_BYTES = LDS_STAGE + 2048;

struct Params {
    const float *x, *w_in, *b_in, *sinks, *cmp_pe, *cmp_w1, *cmp_w2, *w_out, *ln1_g, *ln1_b, *router_w, *router_b,
                *w_gu, *b_gu, *w_dn, *b_dn, *ln2_g, *ln2_b;
    float* out;
    unsigned* ctrl;
    bf16_t *WinT, *WoT, *W1T, *W2T, *WguT, *WdnT;
    float *rwT, *binp, *bgup, *b1c;
    float* xf; bf16_t* xb; bf16_t* hb; float* hs; bf16_t* vT; float* cF;
    bf16_t *kc, *vc, *vcT; bf16_t* ob; float* tbuf; float* x1f; bf16_t* x1b;
    int* top_e; float* gw; int* lists; bf16_t* act; bf16_t* ybuf;
};

__device__ __forceinline__ float bf2f(bf16_t h) { return __uint_as_float(((unsigned)h) << 16); }
__device__ __forceinline__ bf16_t f2bf(float f) { unsigned u = __float_as_uint(f); u += 0x7fffu + ((u >> 16) & 1u); return (bf16_t)(u >> 16); }
__device__ __forceinline__ unsigned pack2(float lo, float hi) { return (unsigned)f2bf(lo) | ((unsigned)f2bf(hi) << 16); }
__device__ __forceinline__ float wave_sum(float v) {
#pragma unroll
    for (int o = 32; o > 0; o >>= 1) v += __shfl_xor(v, o);
    return v;
}
__device__ __forceinline__ float wave_max(float v) {
#pragma unroll
    for (int o = 32; o > 0; o >>= 1) v = fmaxf(v, __shfl_xor(v, o));
    return v;
}
__device__ __forceinline__ void lds_wave_sync() { asm volatile("s_waitcnt lgkmcnt(0)" ::: "memory"); __builtin_amdgcn_wave_barrier(); }
__device__ __forceinline__ float slope_swa(int hq) { return exp2f(-8.0f * (float)(2 * hq + 1) / 12.0f); }
__device__ __forceinline__ float slope_nsa(int hq) { return exp2f(-8.0f * (float)(2 * hq + 2) / 12.0f); }

__device__ __forceinline__ int perm_row(int perm, int n) {
    if (perm == 1) { if (n < 768) return n; if (n < 772) return 2560 + (n - 768); if (n < 2564) return n - 4; return n; }
    if (perm == 2) { const int f = n >> 1, s = n & 1; return (f >> 7) * 256 + s * 128 + (f & 127); }
    return n;
}
struct ConvJob { const float* src; bf16_t* dst; int K, N, kt, nt, perm; };
__device__ __forceinline__ bool conv_job(const Params& p, int t, ConvJob& jb) {
    constexpr int T_GU = NL * NE * 8 * 16, T_DN = NL * NE * 8 * 8, T_WIN = NL * 8 * 21, T_WO = NL * 8 * 8;
    if (t < T_GU) { const int m = t / 128, r = t % 128; jb = ConvJob{p.w_gu + (size_t)m * 1024 * 2048, p.WguT + (size_t)m * 2048 * 1024, 1024, 2048, r / 16, r % 16, 2}; return true; }
    t -= T_GU;
    if (t < T_DN) { const int m = t / 64, r = t % 64; jb = ConvJob{p.w_dn + (size_t)m * 1024 * 1024, p.WdnT + (size_t)m * 1024 * 1024, 1024, 1024, r / 8, r % 8, 0}; return true; }
    t -= T_DN;
    if (t < T_WIN) { const int m = t / 168, r = t % 168; jb = ConvJob{p.w_in + (size_t)m * 1024 * NCOL, p.WinT + (size_t)m * NPAD * 1024, 1024, NCOL, r / 21, r % 21, 1}; return true; }
    t -= T_WIN;
    if (t < T_WO) { const int m = t / 64, r = t % 64; jb = ConvJob{p.w_out + (size_t)m * 1024 * 1024, p.WoT + (size_t)m * 1024 * 1024, 1024, 1024, r / 8, r % 8, 0}; return true; }
    return false;
}
__device__ __forceinline__ void conv_load(const ConvJob& jb, int tid, float2 (&v)[16]) {
    const int n = jb.nt * 128 + (tid & 31) * 4;
    const float* s = jb.src + (size_t)(jb.kt * 128 + (tid >> 5)) * jb.N + n;
#pragma unroll
    for (int i = 0; i < 8; ++i) {
        const float* r = s + (size_t)(16 * i) * jb.N;
        v[2 * i] = (n + 1 < jb.N) ? *(const float2*)r : make_float2(0.f, 0.f);
        v[2 * i + 1] = (n + 3 < jb.N) ? *(const float2*)(r + 2) : make_float2(0.f, 0.f);
    }
}
__device__ __forceinline__ void phase0(const Params& p, char* ldsc) {
    int tid = threadIdx.x; asm volatile("" : "+v"(tid));
    const int G = gridDim.x, bid = blockIdx.x;
    const size_t gtid = (size_t)bid * NTHR + tid, gthreads = (size_t)G * NTHR;
    {
        constexpr int TOT = NL * NE * 8 * 16 + NL * NE * 8 * 8 + NL * 8 * 21 + NL * 8 * 8;
        bf16_t* lt = (bf16_t*)ldsc;
        ConvJob jb, jn; float2 v[16], vn[16];
        int t = bid; bool have = t < TOT && conv_job(p, t, jb);
        if (have) conv_load(jb, tid, v);
        while (have) {
            const int tn = t + G; const bool hn = tn < TOT && conv_job(p, tn, jn);
            if (hn) conv_load(jn, tid, vn);
#pragma unroll
            for (int i = 0; i < 8; ++i) {
                u32x2 w; w.x = pack2(v[2 * i].x, v[2 * i].y); w.y = pack2(v[2 * i + 1].x, v[2 * i + 1].y);
                *(u32x2*)(lt + ((tid >> 5) + 16 * i) * 136 + (tid & 31) * 4) = w;
            }
            __syncthreads();
#pragma unroll
            for (int i = 0; i < 4; ++i) {
                const int idx = tid + NTHR * i, kc = idx & 15, nn = idx >> 4, n = jb.nt * 128 + nn;
                if (n < jb.N) {
                    const bf16_t* l = lt + (kc * 8) * 136 + nn;
                    u32x4 w;
                    w.x = (unsigned)l[0] | ((unsigned)l[136] << 16); w.y = (unsigned)l[272] | ((unsigned)l[408] << 16);
                    w.z = (unsigned)l[544] | ((unsigned)l[680] << 16); w.w = (unsigned)l[816] | ((unsigned)l[952] << 16);
                    *(u32x4*)(jb.dst + (size_t)perm_row(jb.perm, n) * jb.K + jb.kt * 128 + kc * 8) = w;
                }
            }
            __syncthreads();
            t = tn; have = hn; jb = jn;
#pragma unroll
            for (int i = 0; i < 16; ++i) v[i] = vn[i];
        }
    }
    for (size_t i = gtid; i < (size_t)NL * 2 * 2048 * 64; i += gthreads) {
        const int k = (int)(i % 2048), n = (int)((i / 2048) % 64), m = (int)(i / (2048 * 64));
        p.W1T[i] = f2bf(p.cmp_w1[((size_t)m * 2048 + k) * 64 + n]);
    }
    for (size_t i = gtid; i < (size_t)NL * 2 * 64 * 64; i += gthreads) {
        const int k = (int)(i % 64), n = (int)((i / 64) % 64), m = (int)(i / 4096);
        p.W2T[i] = f2bf(p.cmp_w2[((size_t)m * 64 + k) * 64 + n]);
    }
    for (size_t i = gtid; i < (size_t)NL * NPAD; i += gthreads) {
        const int l = (int)(i / NPAD), r = (int)(i % NPAD);
        float v = 0.f;
        if (r < 2560) { const int n = r < 768 ? r : r + 4; v = p.b_in[l * NCOL + n]; }
        else if (r < 2564) v = p.b_in[l * NCOL + 768 + (r - 2560)];
        else if (r < 2582) v = p.b_in[l * NCOL + r];
        p.binp[i] = v;
    }
    for (size_t i = gtid; i < (size_t)NL * NE * 2048; i += gthreads) {
        const int r = (int)(i % 2048); const size_t le = i / 2048;
        const int s = (r >> 7) & 1, f = (r >> 8) * 128 + (r & 127);
        p.bgup[i] = p.b_gu[le * 2048 + 2 * f + s];
    }
    for (size_t i = gtid; i < (size_t)NL * NE * 1024; i += gthreads) {
        const int k = (int)(i % 1024), e = (int)((i / 1024) % NE), l = (int)(i / (1024 * NE));
        p.rwT[i] = p.router_w[((size_t)l * 1024 + k) * NE + e];
    }
    for (size_t i = gtid; i < (size_t)NL * (NPAD - NCOL) * 1024; i += gthreads) {
        const int l = (int)(i / ((NPAD - NCOL) * 1024)); const size_t r = i % ((size_t)(NPAD - NCOL) * 1024);
        p.WinT[(size_t)l * NPAD * 1024 + (size_t)NCOL * 1024 + r] = 0;
    }
    for (size_t i = gtid; i < (size_t)NTOK * DM / 4; i += gthreads) {
        const float4 v4 = ((const float4*)p.x)[i];
        u32x2 w; w.x = pack2(v4.x, v4.y); w.y = pack2(v4.z, v4.w);
        ((u32x2*)p.xb)[i] = w;
    }
    if (bid < 4) {
        float* lf = (float*)ldsc;
        const int j = tid & 63, part = tid >> 6;
        const float* pe = p.cmp_pe + (size_t)bid * 2048; const float* w1 = p.cmp_w1 + (size_t)bid * 2048 * 64;
        float s = 0.f;
        for (int kk = part * 256; kk < part * 256 + 256; ++kk) s += pe[kk] * w1[(size_t)kk * 64 + j];
        lf[tid] = s; __syncthreads();
        if (tid < 64) { float a = 0.f; for (int q = 0; q < 8; ++q) a += lf[tid + 64 * q]; p.b1c[bid * 64 + tid] = a; }
        __syncthreads();
    }
}

namespace pg8 {
constexpr int BM = 256, BK = 64, HALF = 128, HTB = HALF * BK * 2, NXCD = 8, WGM = 8;
__device__ __forceinline__ int lds_byte(int r, int c) { const int st = (r >> 4) * 2 + (c >> 5), rr = r & 15, cc = c & 31, ob = rr * 64 + cc * 2; return st * 1024 + (ob ^ (((ob >> 9) & 1) << 5)); }
__device__ __forceinline__ void stage_rc(int b, int& R, int& C) { const int st = b / 1024, sb = b % 1024, swz = sb ^ (((sb >> 9) & 1) << 5); R = (st >> 1) * 16 + swz / 64; C = (st & 1) * 32 + (swz % 64) / 2; }
__device__ __forceinline__ bool tile_order(int i, int G, int c, int nM, int nN, int& pm, int& pn) {
    const int nwg = nM * nN; const long L = (long)i * G + c; if (L >= nwg) return false;
    int wgid = (int)L; { const int q = nwg / NXCD, r = nwg % NXCD, xcd = wgid % NXCD, off = wgid / NXCD; wgid = (xcd < r ? xcd * (q + 1) : r * (q + 1) + (xcd - r) * q) + off; }
    const int nig = WGM * nN, gid = wgid / nig, fm = gid * WGM, gsz = (nM - fm) < WGM ? (nM - fm) : WGM;
    pm = fm + ((wgid % nig) % gsz); pn = (wgid % nig) / gsz; return true;
}
template <class Sched, class Epi>
__device__ __forceinline__ void gemm_phase(LAS unsigned char* lds, const char* Abase, int K, const Sched& S, const Epi& E) {
    int tid = threadIdx.x; asm volatile("" : "+v"(tid));
    const int wid = __builtin_amdgcn_readfirstlane(tid >> 6), lane = tid & 63, wr = wid >> 2, wc = wid & 3, fr = lane & 15, fq = lane >> 4;
    const int nt = K / BK;
    int R0, C0, R1, C1; stage_rc(tid * 16, R0, C0); stage_rc(tid * 16 + 8192, R1, C1);
    unsigned voffB[2]; voffB[0] = (unsigned)(R0 * K + C0) * 2u; voffB[1] = (unsigned)(R1 * K + C1) * 2u;
    const size_t kstep = (size_t)(BK * 2), hstep = (size_t)HALF * K * 2;
    const unsigned ldsw = (unsigned)wid * 1024u;
    const int aoff = lds_byte(wr * 64 + fr, fq * 8), boff = lds_byte(wc * 32 + fr, fq * 8);
#define PG8_SA(b, h) (((b) * 2 + (h)) * HTB)
#define PG8_SB(b, h) ((4 + (b) * 2 + (h)) * HTB)
#define PG8_STAGE_B(bufoff, gbase) do { _Pragma("unroll") for (int _i = 0; _i < 2; ++_i) \
        __builtin_amdgcn_global_load_lds((const unsigned*)((const char*)(gbase) + voffB[_i]), (LAS unsigned*)(lds + (bufoff) + ldsw + _i * 8192), 16, 0, 0); } while (0)
#define PG8_STAGE_A(bufoff, kbyte, o0, o1) do { \
        __builtin_amdgcn_global_load_lds((const unsigned*)(Abase + (kbyte) + (o0)), (LAS unsigned*)(lds + (bufoff) + ldsw), 16, 0, 0); \
        __builtin_amdgcn_global_load_lds((const unsigned*)(Abase + (kbyte) + (o1)), (LAS unsigned*)(lds + (bufoff) + ldsw + 8192), 16, 0, 0); } while (0)
#define PG8_LDA(dst, b, h) do { _Pragma("unroll") for (int m = 0; m < 4; ++m) _Pragma("unroll") for (int k = 0; k < 2; ++k) dst[m][k] = *(const LAS bf16x8*)(lds + PG8_SA(b, h) + aoff + m * 2048 + k * 1024); } while (0)
#define PG8_LDB(dst, b, h) do { _Pragma("unroll") for (int n = 0; n < 2; ++n) _Pragma("unroll") for (int k = 0; k < 2; ++k) dst[n][k] = *(const LAS bf16x8*)(lds + PG8_SB(b, h) + boff + n * 2048 + k * 1024); } while (0)
#define PG8_MMA(ai, bj, At, Bt) do { __builtin_amdgcn_s_setprio(1); _Pragma("unroll") for (int m = 0; m < 4; ++m) _Pragma("unroll") for (int n = 0; n < 2; ++n) _Pragma("unroll") for (int k = 0; k < 2; ++k) \
        acc[ai][bj][m][n] = __builtin_amdgcn_mfma_f32_16x16x32_bf16(Bt[n][k], At[m][k], acc[ai][bj][m][n], 0, 0, 0); __builtin_amdgcn_s_setprio(0); } while (0)
#define PG8_WAIT_V(n) asm volatile("s_waitcnt vmcnt(" #n ")" ::: "memory")
#define PG8_WAIT_L(n) asm volatile("s_waitcnt lgkmcnt(" #n ")" ::: "memory")
#define PG8_BAR __builtin_amdgcn_s_barrier()
#define PG8_SCHED __builtin_amdgcn_sched_barrier(0)
    typename Sched::Unit cur, nxt; int ui = 0;
    if (!S.next(0, cur)) return;
    f32x4 acc[2][2][4][2];
#pragma unroll
    for (int a = 0; a < 2; ++a)
#pragma unroll
        for (int b = 0; b < 2; ++b)
#pragma unroll
            for (int m = 0; m < 4; ++m)
#pragma unroll
                for (int n = 0; n < 2; ++n) acc[a][b][m][n] = (f32x4){0.f, 0.f, 0.f, 0.f};
    bf16x8 At[4][2], B0[2][2], B1[2][2];
    unsigned aC[2][2], aN[2][2];
    S.a_off(cur, R0, C0, R1, C1, aC);
    const char* cB = S.b_ptr(cur);
    PG8_STAGE_B(PG8_SB(0, 0), cB); PG8_STAGE_B(PG8_SB(0, 1), cB + hstep); PG8_STAGE_A(PG8_SA(0, 0), 0, aC[0][0], aC[0][1]); PG8_STAGE_A(PG8_SA(0, 1), 0, aC[1][0], aC[1][1]);
    if (wr == 1) PG8_BAR;
    PG8_WAIT_V(2); PG8_BAR;
    PG8_STAGE_B(PG8_SB(1, 0), cB + kstep); PG8_STAGE_A(PG8_SA(1, 0), kstep, aC[0][0], aC[0][1]); PG8_STAGE_B(PG8_SB(1, 1), cB + hstep + kstep);
    PG8_WAIT_V(6); PG8_BAR;
    for (;;) {
        const bool has_next = S.next(ui + 1, nxt);
        const char* nB = cB;
        if (has_next) { S.a_off(nxt, R0, C0, R1, C1, aN); nB = S.b_ptr(nxt); }
        else { aN[0][0] = aC[0][0]; aN[0][1] = aC[0][1]; aN[1][0] = aC[1][0]; aN[1][1] = aC[1][1]; }
        for (int t = 0; t < nt; t += 2) {
            const bool last = (t == nt - 2);
            const size_t ka1 = (size_t)(t + 1) * kstep, ka2 = last ? 0 : (size_t)(t + 2) * kstep, ka3 = ka2 + kstep;
            const char* b2 = last ? nB : cB + (size_t)(t + 2) * kstep; const char* b3 = b2 + kstep;
            const unsigned o00 = last ? aN[0][0] : aC[0][0], o01 = last ? aN[0][1] : aC[0][1], o10 = last ? aN[1][0] : aC[1][0], o11 = last ? aN[1][1] : aC[1][1];
            PG8_LDB(B0, 0, 0); PG8_LDB(B1, 0, 1); PG8_SCHED; PG8_LDA(At, 0, 0); PG8_STAGE_A(PG8_SA(1, 1), ka1, aC[1][0], aC[1][1]);
            PG8_WAIT_V(8); PG8_WAIT_L(0); PG8_BAR; PG8_MMA(0, 0, At, B0); PG8_MMA(0, 1, At, B1); PG8_BAR; PG8_SCHED;
            PG8_LDA(At, 0, 1); PG8_STAGE_B(PG8_SB(0, 0), b2); PG8_STAGE_B(PG8_SB(0, 1), b2 + hstep); PG8_STAGE_A(PG8_SA(0, 0), ka2, o00, o01);
            PG8_WAIT_V(8); PG8_WAIT_L(0); PG8_BAR; PG8_MMA(1, 0, At, B0); PG8_MMA(1, 1, At, B1); PG8_BAR; PG8_SCHED;
            PG8_LDB(B0, 1, 0); PG8_LDB(B1, 1, 1); PG8_SCHED; PG8_LDA(At, 1, 0); PG8_STAGE_A(PG8_SA(0, 1), ka2, o10, o11);
            PG8_WAIT_V(8); PG8_WAIT_L(0); PG8_BAR; PG8_MMA(0, 0, At, B0); PG8_MMA(0, 1, At, B1); PG8_BAR; PG8_SCHED;
            PG8_LDA(At, 1, 1); PG8_STAGE_B(PG8_SB(1, 0), b3); PG8_STAGE_B(PG8_SB(1, 1), b3 + hstep); PG8_STAGE_A(PG8_SA(1, 0), ka3, o00, o01);
            PG8_WAIT_V(8); PG8_WAIT_L(0); PG8_BAR; PG8_MMA(1, 0, At, B0); PG8_MMA(1, 1, At, B1); PG8_BAR; PG8_SCHED;
        }
        if (wr == 0) PG8_BAR;
        E(acc, cur, wr, wc, fr, fq);
        if (!has_next) break;
#pragma unroll
        for (int a = 0; a < 2; ++a)
#pragma unroll
            for (int b = 0; b < 2; ++b)
#pragma unroll
                for (int m = 0; m < 4; ++m)
#pragma unroll
                    for (int n = 0; n < 2; ++n) acc[a][b][m][n] = (f32x4){0.f, 0.f, 0.f, 0.f};
        cur = nxt; cB = nB; ++ui;
        aC[0][0] = aN[0][0]; aC[0][1] = aN[0][1]; aC[1][0] = aN[1][0]; aC[1][1] = aN[1][1];
        if (wr == 1) PG8_BAR;
    }
    PG8_WAIT_V(0);
    PG8_BAR;
#undef PG8_SA
#undef PG8_SB
#undef PG8_STAGE_A
#undef PG8_STAGE_B
#undef PG8_LDA
#undef PG8_LDB
#undef PG8_MMA
#undef PG8_WAIT_V
#undef PG8_WAIT_L
#undef PG8_BAR
#undef PG8_SCHED
}
}

struct DenseUnit { int pm, pn; };
struct DenseSched {
    typedef DenseUnit Unit;
    const char* Bt; int K, nM, nN;
    __device__ __forceinline__ bool next(int i, Unit& u) const { return pg8::tile_order(i, gridDim.x, blockIdx.x, nM, nN, u.pm, u.pn); }
    __device__ __forceinline__ void a_off(const Unit& u, int R0, int C0, int R1, int C1, unsigned (&off)[2][2]) const {
#pragma unroll
        for (int h = 0; h < 2; ++h) { off[h][0] = (unsigned)((u.pm * 256 + h * 128 + R0) * K + C0) * 2u; off[h][1] = (unsigned)((u.pm * 256 + h * 128 + R1) * K + C1) * 2u; }
    }
    __device__ __forceinline__ const char* b_ptr(const Unit& u) const { return Bt + (size_t)u.pn * 256 * K * 2; }
};
struct MoeUnit { int rbt, e, rb, cnt, pn; };
template <bool GATHER>
struct MoeSched {
    typedef MoeUnit Unit;
    const char* Bt; const int* lists; const int* ptile; const int* ecnt; int nN, nrows;
    __device__ __forceinline__ bool next(int i, Unit& u) const {
        int pm, pn; if (!pg8::tile_order(i, gridDim.x, blockIdx.x, ptile[NE], nN, pm, pn)) return false;
        int e = 0; while (ptile[e + 1] <= pm) ++e;
        u.rbt = pm; u.e = e; u.rb = pm - ptile[e]; u.cnt = ecnt[e]; u.pn = pn; return true;
    }
    __device__ __forceinline__ void a_off(const Unit& u, int R0, int C0, int R1, int C1, unsigned (&off)[2][2]) const {
        if (GATHER) {
            const int* lst = lists + (size_t)u.e * LIST_CAP;
#pragma unroll
            for (int h = 0; h < 2; ++h) {
                const int l0 = u.rb * 256 + h * 128 + R0, l1 = u.rb * 256 + h * 128 + R1;
                const int t0 = l0 < u.cnt ? (lst[l0] >> 2) : 0, t1 = l1 < u.cnt ? (lst[l1] >> 2) : 0;
                off[h][0] = (unsigned)(t0 * 1024 + C0) * 2u; off[h][1] = (unsigned)(t1 * 1024 + C1) * 2u;
            }
        } else {
#pragma unroll
            for (int h = 0; h < 2; ++h) { off[h][0] = (unsigned)((u.rbt * 256 + h * 128 + R0) * 1024 + C0) * 2u; off[h][1] = (unsigned)((u.rbt * 256 + h * 128 + R1) * 1024 + C1) * 2u; }
        }
    }
    __device__ __forceinline__ const char* b_ptr(const Unit& u) const { return Bt + ((size_t)u.e * nrows + (size_t)u.pn * 256) * 1024 * 2; }
};

struct EpiInProj {
    const Params* p; int l;
    __device__ __forceinline__ void operator()(const f32x4 (&acc)[2][2][4][2], const DenseUnit& u, int wr, int wc, int fr, int fq) const {
        const float* bias = p->binp + l * NPAD + u.pn * 256;
#pragma unroll
        for (int bj = 0; bj < 2; ++bj) {
            int vh = -1;
            if (u.pn == 2) vh = bj * 2; else if (u.pn == 5 && bj == 0) vh = 4; else if (u.pn == 8 && bj == 1) vh = 6; else if (u.pn == 9 && bj == 1) vh = 8;
#pragma unroll
            for (int n = 0; n < 2; ++n) {
                const int c = bj * 128 + wc * 32 + n * 16 + 4 * fq;
                const f32x4 bv = *(const f32x4*)(bias + c);
#pragma unroll
                for (int ai = 0; ai < 2; ++ai)
#pragma unroll
                    for (int m = 0; m < 4; ++m) {
                        const int row = u.pm * 256 + ai * 128 + wr * 64 + m * 16 + fr;
                        const f32x4 v = acc[ai][bj][m][n] + bv;
                        u32x2 w; w.x = pack2(v[0], v[1]); w.y = pack2(v[2], v[3]);
                        *(u32x2*)(p->hb + (size_t)row * NMAIN + u.pn * 256 + c) = w;
                        if (vh >= 0) {
                            const int b = row >> 11, s = row & 2047, hh = vh + ((c & 127) >> 6), d = c & 63;
                            bf16_t* vt = p->vT + (((size_t)b * NVH + hh) * 64 + d) * SEQ + s;
                            vt[0] = (bf16_t)(w.x & 0xffff); vt[SEQ] = (bf16_t)(w.x >> 16); vt[2 * SEQ] = (bf16_t)(w.y & 0xffff); vt[3 * SEQ] = (bf16_t)(w.y >> 16);
                        }
                    }
            }
        }
    }
};
struct EpiOutProj {
    const float* xin; float* t;
    __device__ __forceinline__ void operator()(const f32x4 (&acc)[2][2][4][2], const DenseUnit& u, int wr, int wc, int fr, int fq) const {
#pragma unroll
        for (int ai = 0; ai < 2; ++ai)
#pragma unroll
            for (int m = 0; m < 4; ++m) {
                const size_t rowoff = (size_t)(u.pm * 256 + ai * 128 + wr * 64 + m * 16 + fr) * DM + u.pn * 256 + wc * 32 + 4 * fq;
#pragma unroll
                for (int bj = 0; bj < 2; ++bj)
#pragma unroll
                    for (int n = 0; n < 2; ++n) {
                        const size_t off = rowoff + bj * 128 + n * 16;
                        const f32x4 xv = *(const f32x4*)(xin + off);
                        *(f32x4*)(t + off) = xv * ALPHA + acc[ai][bj][m][n];
                    }
            }
    }
};
struct EpiGateUp {
    bf16_t* act; const float* bgup;
    __device__ __forceinline__ void operator()(const f32x4 (&acc)[2][2][4][2], const MoeUnit& u, int wr, int wc, int fr, int fq) const {
        const float* bias = bgup + (size_t)u.e * 2048 + u.pn * 256;
#pragma unroll
        for (int n = 0; n < 2; ++n) {
            const int c = wc * 32 + n * 16 + 4 * fq;
            const f32x4 bg = *(const f32x4*)(bias + c), bu = *(const f32x4*)(bias + 128 + c);
#pragma unroll
            for (int ai = 0; ai < 2; ++ai)
#pragma unroll
                for (int m = 0; m < 4; ++m) {
                    const f32x4 g4 = acc[ai][0][m][n] + bg, u4 = acc[ai][1][m][n] + bu;
                    float o[4];
#pragma unroll
                    for (int j = 0; j < 4; ++j) {
                        const float g = fminf(g4[j], 7.0f), uu = fminf(fmaxf(u4[j], -7.0f), 7.0f);
                        const float glu = g / (1.0f + __expf(-1.702f * g));
                        o[j] = (uu + 1.0f) * glu;
                    }
                    u32x2 w; w.x = pack2(o[0], o[1]); w.y = pack2(o[2], o[3]);
                    *(u32x2*)(act + (size_t)(u.rbt * 256 + ai * 128 + wr * 64 + m * 16 + fr) * DFF + u.pn * 128 + c) = w;
                }
        }
    }
};
struct EpiDown {
    bf16_t* ybuf; const float* bdn;
    __device__ __forceinline__ void operator()(const f32x4 (&acc)[2][2][4][2], const MoeUnit& u, int wr, int wc, int fr, int fq) const {
        const float* bias = bdn + (size_t)u.e * 1024 + u.pn * 256;
#pragma unroll
        for (int bj = 0; bj < 2; ++bj)
#pragma unroll
            for (int n = 0; n < 2; ++n) {
                const int c = bj * 128 + wc * 32 + n * 16 + 4 * fq;
                const f32x4 bv = *(const f32x4*)(bias + c);
#pragma unroll
                for (int ai = 0; ai < 2; ++ai)
#pragma unroll
                    for (int m = 0; m < 4; ++m) {
                        const f32x4 v = acc[ai][bj][m][n] + bv;
                        u32x2 w; w.x = pack2(v[0], v[1]); w.y = pack2(v[2], v[3]);
                        *(u32x2*)(ybuf + (size_t)(u.rbt * 256 + ai * 128 + wr * 64 + m * 16 + fr) * DM + u.pn * 256 + c) = w;
                    }
            }
    }
};

__device__ __forceinline__ void phase_inproj(const Params& p, int l, char* lds) {
    DenseSched S{(const char*)(p.WinT + (size_t)l * NPAD * 1024), 1024, NTOK / 256, NMAIN / 256};
    EpiInProj E{&p, l};
    pg8::gemm_phase((LAS unsigned char*)lds, (const char*)p.xb, 1024, S, E);
    int tid = threadIdx.x; asm volatile("" : "+v"(tid));
    const int wid = tid >> 6, lane = tid & 63, fr = lane & 15, fq = lane >> 4;
    const bf16_t* W = p.WinT + ((size_t)l * NPAD + NMAIN) * 1024;
    const float* bias = p.binp + l * NPAD + NMAIN;
    for (int u = blockIdx.x * NWV + wid; u < NTOK / 16; u += gridDim.x * NWV) {
        const bf16_t* ar = p.xb + (size_t)(u * 16 + fr) * DM + fq * 8;
        const bf16_t* w0 = W + (size_t)fr * 1024 + fq * 8; const bf16_t* w1 = W + (size_t)(16 + fr) * 1024 + fq * 8;
        f32x4 a0 = (f32x4){0.f, 0.f, 0.f, 0.f}, a1 = a0;
#pragma unroll 4
        for (int ks = 0; ks < 32; ++ks) {
            const bf16x8 a = *(const bf16x8*)(ar + ks * 32);
            a0 = __builtin_amdgcn_mfma_f32_16x16x32_bf16(a, *(const bf16x8*)(w0 + ks * 32), a0, 0, 0, 0);
            a1 = __builtin_amdgcn_mfma_f32_16x16x32_bf16(a, *(const bf16x8*)(w1 + ks * 32), a1, 0, 0, 0);
        }
#pragma unroll
        for (int r = 0; r < 4; ++r) {
            float* dst = p.hs + (size_t)(u * 16 + fq * 4 + r) * HS_W;
            dst[fr] = a0[r] + bias[fr];
            if (fr < 6) dst[16 + fr] = a1[r] + bias[16 + fr];
        }
    }
}
__device__ __forceinline__ void phase_outproj(const Params& p, int l, const float* xin, char* lds) {
    DenseSched S{(const char*)(p.WoT + (size_t)l * 1024 * 1024), 1024, NTOK / 256, 4};
    EpiOutProj E{xin, p.tbuf};
    pg8::gemm_phase((LAS unsigned char*)lds, (const char*)p.ob, 1024, S, E);
}
__device__ __forceinline__ void build_tiles(const Params& p, int l, int* ptile, int* ecnt) {
    if (threadIdx.x < NE) ecnt[threadIdx.x] = (int)__hip_atomic_load(p.ctrl + 64 + l * NE + threadIdx.x, __ATOMIC_RELAXED, __HIP_MEMORY_SCOPE_AGENT);
    __syncthreads();
    if (threadIdx.x == 0) { int s = 0; for (int e = 0; e < NE; ++e) { ptile[e] = s; s += (ecnt[e] + 255) >> 8; } ptile[NE] = s; }
    __syncthreads();
}
__device__ __forceinline__ void phase_gateup(const Params& p, int l, char* lds) {
    int* ptile = (int*)(lds + LDS_TAB); int* ecnt = ptile + 40;
    build_tiles(p, l, ptile, ecnt);
    MoeSched<true> S{(const char*)(p.WguT + (size_t)l * NE * 2048 * 1024), p.lists, ptile, ecnt, 8, 2048};
    EpiGateUp E{p.act, p.bgup + (size_t)l * NE * 2048};
    pg8::gemm_phase((LAS unsigned char*)lds, (const char*)p.x1b, 1024, S, E);
}
__device__ __forceinline__ void phase_down(const Params& p, int l, char* lds) {
    int* ptile = (int*)(lds + LDS_TAB); int* ecnt = ptile + 40;
    build_tiles(p, l, ptile, ecnt);
    MoeSched<false> S{(const char*)(p.WdnT + (size_t)l * NE * 1024 * 1024), p.lists, ptile, ecnt, 4, 1024};
    EpiDown E{p.ybuf, p.b_dn + (size_t)l * NE * 1024};
    pg8::gemm_phase((LAS unsigned char*)lds, (const char*)p.act, 1024, S, E);
}

__device__ __forceinline__ float gelu_tanh(float x) {
    const float u = 0.7978845608028654f * (x + 0.044715f * x * x * x);
    const float e = __expf(-2.0f * fabsf(u)); const float th = (1.0f - e) / (1.0f + e);
    return 0.5f * x * (1.0f + (u < 0.f ? -th : th));
}
__device__ __forceinline__ void phase_prep(const Params& p, int l, char* lds) {
    int tid = threadIdx.x; asm volatile("" : "+v"(tid));
    const int wid = tid >> 6, lane = tid & 63, fr = lane & 15, fq = lane >> 4;
    const int gw = blockIdx.x * NWV + wid, nw = gridDim.x * NWV;
    for (int u = blockIdx.x; u < NB * 4; u += gridDim.x) {
        const int b = u >> 2, h = u & 3;
        const float* srcp = p.hs + ((size_t)b * SEQ + tid * 4) * HS_W + h;
        float ls[4]; float tot = 0.f;
#pragma unroll
        for (int i = 0; i < 4; ++i) { const float f = srcp[(size_t)i * HS_W]; ls[i] = fminf(f, 0.f) - log1pf(__expf(-fabsf(f))); tot += ls[i]; }
        float inc = tot;
#pragma unroll
        for (int o = 1; o < 64; o <<= 1) { const float v = __shfl_up(inc, o); if (lane >= o) inc += v; }
        float* wtot = (float*)(lds + 65536);
        if (lane == 63) wtot[wid] = inc;
        __syncthreads();
        float base = inc - tot;
        for (int w = 0; w < wid; ++w) base += wtot[w];
        float4 o4; o4.x = base + ls[0]; o4.y = o4.x + ls[1]; o4.z = o4.y + ls[2]; o4.w = o4.z + ls[3];
        *(float4*)(p.cF + (size_t)u * SEQ + tid * 4) = o4;
        __syncthreads();
    }
    bf16_t* h1 = (bf16_t*)(lds + wid * 2048);
    for (int u = nw - 1 - gw; u < NB * 2 * 2 * 8; u += nw) {
        const int ct = u & 7, which = (u >> 3) & 1, kvh = (u >> 4) & 1, b = u >> 5;
        const int colo = (which ? C_NVC : C_NKC) + kvh * 64;
        const int c_lane = ct * 16 + fr;
        const int tokbase = min(c_lane, 126) * 16;
        const bf16_t* arow = p.hb + ((size_t)b * SEQ + tokbase) * NMAIN + colo + fq * 8;
        const bf16_t* w1 = p.W1T + ((size_t)(l * 2 + which) * 64 + fr) * 2048 + fq * 8;
        f32x4 acc[4];
#pragma unroll
        for (int n = 0; n < 4; ++n) acc[n] = (f32x4){0.f, 0.f, 0.f, 0.f};
#pragma unroll 8
        for (int ks = 0; ks < 64; ++ks) {
            const bf16x8 a = *(const bf16x8*)(arow + (size_t)(ks >> 1) * NMAIN + (ks & 1) * 32);
#pragma unroll
            for (int n = 0; n < 4; ++n) {
                const bf16x8 bb = *(const bf16x8*)(w1 + (size_t)n * 16 * 2048 + ks * 32);
                acc[n] = __builtin_amdgcn_mfma_f32_16x16x32_bf16(a, bb, acc[n], 0, 0, 0);
            }
        }
        const float* b1 = p.b1c + (l * 2 + which) * 64;
#pragma unroll
        for (int n = 0; n < 4; ++n)
#pragma unroll
            for (int r = 0; r < 4; ++r) h1[(fq * 4 + r) * 64 + n * 16 + fr] = f2bf(gelu_tanh(acc[n][r] + b1[n * 16 + fr]));
        lds_wave_sync();
        const bf16_t* w2 = p.W2T + ((size_t)(l * 2 + which) * 64 + fr) * 64 + fq * 8;
        f32x4 o2[4];
#pragma unroll
        for (int n = 0; n < 4; ++n) o2[n] = (f32x4){0.f, 0.f, 0.f, 0.f};
#pragma unroll
        for (int ks = 0; ks < 2; ++ks) {
            const bf16x8 a = *(const bf16x8*)(h1 + fr * 64 + ks * 32 + fq * 8);
#pragma unroll
            for (int n = 0; n < 4; ++n) {
                const bf16x8 bb = *(const bf16x8*)(w2 + (size_t)n * 16 * 64 + ks * 32);
                o2[n] = __builtin_amdgcn_mfma_f32_16x16x32_bf16(a, bb, o2[n], 0, 0, 0);
            }
        }
        lds_wave_sync();
        const size_t base = ((size_t)b * 2 + kvh) * 128 * 64;
#pragma unroll
        for (int n = 0; n < 4; ++n)
#pragma unroll
            for (int r = 0; r < 4; ++r) {
                const int c = ct * 16 + fq * 4 + r, j2 = n * 16 + fr;
                const bf16_t v = c < 127 ? f2bf(o2[n][r]) : (bf16_t)0;
                if (which == 0) p.kc[base + (size_t)c * 64 + j2] = v;
                else { p.vc[base + (size_t)c * 64 + j2] = v; p.vcT[base + (size_t)j2 * 128 + c] = v; }
            }
    }
}

constexpr float L2E = 1.4426950408889634f, MASKV = -1e30f, SCL2 = QSCALE * L2E;
template <int NQT, class MB>
__device__ __forceinline__ void attn_chunk(const bf16_t* __restrict__ Kb, size_t ldk, const bf16_t* __restrict__ VTb, size_t ldv, int kc0,
                                           const bf16x8 (&qf)[NQT][2], f32x4 (&o)[NQT][4], float (&m)[NQT], float (&l)[NQT], int fr, int fq, const MB& mb) {
    const bf16_t* kp = Kb + (size_t)(kc0 + (fr >> 2) * 8 + (fr & 3)) * ldk + fq * 8;
    bf16x8 kf[2][2];
    kf[0][0] = *(const bf16x8*)(kp); kf[0][1] = *(const bf16x8*)(kp + 32);
    kf[1][0] = *(const bf16x8*)(kp + 4 * ldk); kf[1][1] = *(const bf16x8*)(kp + 4 * ldk + 32);
    const bf16_t* vp = VTb + (size_t)fr * ldv + kc0 + fq * 8;
    bf16x8 vf[4];
#pragma unroll
    for (int dt = 0; dt < 4; ++dt) vf[dt] = *(const bf16x8*)(vp + (size_t)dt * 16 * ldv);
#pragma unroll
    for (int qt = 0; qt < NQT; ++qt) {
        f32x4 s0 = (f32x4){0.f, 0.f, 0.f, 0.f}, s1 = s0;
        s0 = __builtin_amdgcn_mfma_f32_16x16x32_bf16(kf[0][0], qf[qt][0], s0, 0, 0, 0);
        s0 = __builtin_amdgcn_mfma_f32_16x16x32_bf16(kf[0][1], qf[qt][1], s0, 0, 0, 0);
        s1 = __builtin_amdgcn_mfma_f32_16x16x32_bf16(kf[1][0], qf[qt][0], s1, 0, 0, 0);
        s1 = __builtin_amdgcn_mfma_f32_16x16x32_bf16(kf[1][1], qf[qt][1], s1, 0, 0, 0);
        float v[8];
#pragma unroll
        for (int j = 0; j < 4; ++j) { v[j] = mb(qt, j, s0[j]); v[j + 4] = mb(qt, j + 4, s1[j]); }
        float mx = fmaxf(fmaxf(fmaxf(v[0], v[1]), fmaxf(v[2], v[3])), fmaxf(fmaxf(v[4], v[5]), fmaxf(v[6], v[7])));
        mx = fmaxf(mx, __shfl_xor(mx, 16)); mx = fmaxf(mx, __shfl_xor(mx, 32));
        const float mnew = fmaxf(m[qt], mx);
        const float alpha = __builtin_amdgcn_exp2f(m[qt] - mnew);
        m[qt] = mnew;
        float pr[8]; float ps = 0.f;
#pragma unroll
        for (int j = 0; j < 8; ++j) { pr[j] = v[j] > -1e29f ? __builtin_amdgcn_exp2f(v[j] - mnew) : 0.f; ps += pr[j]; }
        l[qt] = l[qt] * alpha + ps;
#pragma unroll
        for (int dt = 0; dt < 4; ++dt) o[qt][dt] *= alpha;
        union { bf16x8 v8; unsigned u[4]; } pf;
        pf.u[0] = pack2(pr[0], pr[1]); pf.u[1] = pack2(pr[2], pr[3]); pf.u[2] = pack2(pr[4], pr[5]); pf.u[3] = pack2(pr[6], pr[7]);
#pragma unroll
        for (int dt = 0; dt < 4; ++dt) o[qt][dt] = __builtin_amdgcn_mfma_f32_16x16x32_bf16(vf[dt], pf.v8, o[qt][dt], 0, 0, 0);
        __builtin_amdgcn_sched_barrier(0);
    }
}
template <int NQT>
__device__ __forceinline__ void attn_init(f32x4 (&o)[NQT][4], float (&m)[NQT], float (&l)[NQT]) {
#pragma unroll
    for (int qt = 0; qt < NQT; ++qt) { m[qt] = MASKV; l[qt] = 0.f;
#pragma unroll
        for (int dt = 0; dt < 4; ++dt) o[qt][dt] = (f32x4){0.f, 0.f, 0.f, 0.f}; }
}
__device__ __forceinline__ float lsum4(float l) { l += __shfl_xor(l, 16); l += __shfl_xor(l, 32); return l; }
__device__ __forceinline__ void store_o4(bf16_t* dst, const f32x4 v) { u32x2 w; w.x = pack2(v[0], v[1]); w.y = pack2(v[2], v[3]); *(u32x2*)dst = w; }

__device__ __forceinline__ void fox_unit(const Params& p, int b, int h, int qb, int fr, int fq) {
    const int t0 = qb * 64;
    const bf16_t* Qb = p.hb + ((size_t)b * SEQ + t0) * NMAIN + C_FQ + h * 64 + fq * 8;
    bf16x8 qf[4][2];
#pragma unroll
    for (int qt = 0; qt < 4; ++qt) { qf[qt][0] = *(const bf16x8*)(Qb + (size_t)(qt * 16 + fr) * NMAIN); qf[qt][1] = *(const bf16x8*)(Qb + (size_t)(qt * 16 + fr) * NMAIN + 32); }
    const float* cf = p.cF + ((size_t)b * 4 + h) * SEQ;
    float cq[4];
#pragma unroll
    for (int qt = 0; qt < 4; ++qt) cq[qt] = cf[t0 + qt * 16 + fr] * L2E;
    f32x4 o[4][4]; float m[4], l[4];
    attn_init<4>(o, m, l);
    const bf16_t* Kb = p.hb + (size_t)b * SEQ * NMAIN + C_FK + h * 64;
    const bf16_t* VTb = p.vT + ((size_t)b * NVH + h) * 64 * SEQ;
    const int nchunk = (t0 + 64) >> 5;
    for (int c = 0; c < nchunk; ++c) {
        const int kc0 = c * 32;
        const float4 ca = *(const float4*)(cf + kc0 + 8 * fq), cb = *(const float4*)(cf + kc0 + 8 * fq + 4);
        const float ck[8] = {ca.x * L2E, ca.y * L2E, ca.z * L2E, ca.w * L2E, cb.x * L2E, cb.y * L2E, cb.z * L2E, cb.w * L2E};
        const bool diag = kc0 + 31 > t0;
        const int kq = kc0 + 8 * fq - t0 - fr;
        attn_chunk<4>(Kb, NMAIN, VTb, SEQ, kc0, qf, o, m, l, fr, fq, [&](int qt, int j, float raw) {
            float v = raw * SCL2 + cq[qt] - ck[j];
            if (diag && (kq + j - 16 * qt) > 0) v = MASKV;
            return v; });
    }
#pragma unroll
    for (int qt = 0; qt < 4; ++qt) {
        const float inv = 1.0f / lsum4(l[qt]);
        bf16_t* dst = p.ob + ((size_t)b * SEQ + t0 + qt * 16 + fr) * DM + h * 64 + 4 * fq;
#pragma unroll
        for (int dt = 0; dt < 4; ++dt) store_o4(dst + dt * 16, o[qt][dt] * inv);
    }
}
__device__ __forceinline__ void swa_unit(const Params& p, int l_, int b, int kv, int pos, int fr, int fq) {
    const int t0 = pos * 16, t = t0 + fr;
    const bf16_t* Qb = p.hb + ((size_t)b * SEQ + t) * NMAIN + C_SQ + kv * 192 + fq * 8;
    bf16x8 qf[3][2];
#pragma unroll
    for (int g = 0; g < 3; ++g) { qf[g][0] = *(const bf16x8*)(Qb + g * 64); qf[g][1] = *(const bf16x8*)(Qb + g * 64 + 32); }
    float sl[3];
#pragma unroll
    for (int g = 0; g < 3; ++g) sl[g] = slope_swa(kv * 3 + g) * L2E;
    f32x4 o[3][4]; float m[3], l[3];
    attn_init<3>(o, m, l);
    const bf16_t* Kb = p.hb + (size_t)b * SEQ * NMAIN + C_SK + kv * 64;
    const bf16_t* VTb = p.vT + ((size_t)b * NVH + 4 + kv) * 64 * SEQ;
    const int c_lo = max(0, t0 - 127) >> 5, c_hi = (t0 + 15) >> 5;
    for (int c = c_lo; c <= c_hi; ++c) {
        const int kc0 = c * 32, dq = t - kc0 - 8 * fq;
        attn_chunk<3>(Kb, NMAIN, VTb, SEQ, kc0, qf, o, m, l, fr, fq, [&](int g, int j, float raw) {
            const int dist = dq - j;
            return (dist >= 0 && dist < 128) ? raw * SCL2 - sl[g] * (float)dist : MASKV; });
    }
#pragma unroll
    for (int g = 0; g < 3; ++g) {
        const float sink = p.sinks[l_ * 6 + kv * 3 + g] * L2E;
        const float inv = 1.0f / (lsum4(l[g]) + __builtin_amdgcn_exp2f(sink - m[g]));
        bf16_t* dst = p.ob + ((size_t)b * SEQ + t) * DM + 256 + (kv * 3 + g) * 64 + 4 * fq;
#pragma unroll
        for (int dt = 0; dt < 4; ++dt) store_o4(dst + dt * 16, o[g][dt] * inv);
    }
}
__device__ __forceinline__ void nsa_unit(const Params& p, int b, int kv, int pos, int fr, int fq, int lane, float* ps, unsigned* msk, float* otl) {
    const int t0 = pos * 16, t = t0 + fr, cur = t0 >> 6;
    const bf16_t* Qb = p.hb + ((size_t)b * SEQ + t) * NMAIN + C_NQ + kv * 192 + fq * 8;
    bf16x8 qf[3][2];
#pragma unroll
    for (int g = 0; g < 3; ++g) { qf[g][0] = *(const bf16x8*)(Qb + g * 64); qf[g][1] = *(const bf16x8*)(Qb + g * 64 + 32); }
    float sl[3];
#pragma unroll
    for (int g = 0; g < 3; ++g) sl[g] = slope_nsa(kv * 3 + g) * L2E;
    const float* gl = p.hs + ((size_t)b * SEQ + t) * HS_W + 4 + kv * 9;
    f32x4 o[3][4]; float m[3], l[3];
    f32x4* otv = (f32x4*)otl + lane;
#pragma unroll
    for (int i = 0; i < 8; ++i) ps[lane + 64 * i] = 0.f;
    {
        const bf16_t* Kb = p.kc + ((size_t)b * 2 + kv) * 128 * 64;
        const bf16_t* VTb = p.vcT + ((size_t)b * 2 + kv) * 64 * 128;
        const int ncv = (t0 + 15 >= 31) ? ((t0 + 15 - 31) >> 4) + 1 : 0;
        const int nch = (ncv + 31) >> 5;
        attn_init<3>(o, m, l);
        const int dq0 = t - 31 - 16 * 8 * fq;
        for (int c = 0; c < nch; ++c) {
            const int kc0 = c * 32, dq = dq0 - 16 * kc0;
            attn_chunk<3>(Kb, 64, VTb, 128, kc0, qf, o, m, l, fr, fq, [&](int g, int j, float raw) {
                const int dist = dq - 16 * j;
                return dist >= 0 ? raw * SCL2 - sl[g] * (float)dist : MASKV; });
        }
        float il[3];
#pragma unroll
        for (int g = 0; g < 3; ++g) {
            const float lt = lsum4(l[g]); il[g] = lt > 0.f ? 1.0f / lt : 0.f;
            const float gate = 1.0f / (1.0f + __expf(-gl[g * 3 + 0]));
#pragma unroll
            for (int dt = 0; dt < 4; ++dt) otv[(g * 4 + dt) * 64] = o[g][dt] * (il[g] * gate);
        }
        float carry_prev = 0.f;
        for (int c = 0; c < nch; ++c) {
            const int kc0 = c * 32, dq = dq0 - 16 * kc0;
            const bf16_t* kp = Kb + (size_t)(kc0 + (fr >> 2) * 8 + (fr & 3)) * 64 + fq * 8;
            const bf16x8 k00 = *(const bf16x8*)(kp), k01 = *(const bf16x8*)(kp + 32), k10 = *(const bf16x8*)(kp + 256), k11 = *(const bf16x8*)(kp + 256 + 32);
            float pc[8];
#pragma unroll
            for (int j = 0; j < 8; ++j) pc[j] = 0.f;
#pragma unroll
            for (int g = 0; g < 3; ++g) {
                f32x4 s0 = (f32x4){0.f, 0.f, 0.f, 0.f}, s1 = s0;
                s0 = __builtin_amdgcn_mfma_f32_16x16x32_bf16(k00, qf[g][0], s0, 0, 0, 0); s0 = __builtin_amdgcn_mfma_f32_16x16x32_bf16(k01, qf[g][1], s0, 0, 0, 0);
                s1 = __builtin_amdgcn_mfma_f32_16x16x32_bf16(k10, qf[g][0], s1, 0, 0, 0); s1 = __builtin_amdgcn_mfma_f32_16x16x32_bf16(k11, qf[g][1], s1, 0, 0, 0);
#pragma unroll
                for (int j = 0; j < 8; ++j) {
                    const int dist = dq - 16 * j; const float raw = j < 4 ? s0[j] : s1[j - 4];
                    if (dist >= 0) pc[j] += __builtin_amdgcn_exp2f(raw * SCL2 - sl[g] * (float)dist - m[g]) * il[g];
                }
            }
            const float cout = 0.5f * pc[7];
            float cin = __shfl_up(cout, 16);
            const float cwrap = __shfl(cout, fr + 48);
            if (fq == 0) cin = carry_prev;
            carry_prev = cwrap;
            const int n0 = (kc0 >> 2) + 2 * fq;
            ps[fr * 32 + n0] = cin + pc[0] + pc[1] + pc[2] + 0.5f * pc[3];
            ps[fr * 32 + n0 + 1] = 0.5f * pc[3] + pc[4] + pc[5] + pc[6] + 0.5f * pc[7];
        }
    }
    lds_wave_sync();
    if (lane < 16) {
        unsigned mask = 1u | (1u << cur); if (cur >= 1) mask |= 1u << (cur - 1);
        if (cur >= 3) {
            if (cur - 2 <= 5) mask |= (1u << (cur - 1)) - 2u;
            else {
                const float* my = ps + lane * 32;
                for (int r = 0; r < 5; ++r) {
                    float best = -1.0f; int bi = 1;
                    for (int j = 1; j <= cur - 2; ++j) { const float v = my[j]; if (!((mask >> j) & 1u) && v > best) { best = v; bi = j; } }
                    mask |= 1u << bi;
                }
            }
        }
        msk[lane] = mask;
    }
    lds_wave_sync();
    const unsigned qmask = msk[fr];
    lds_wave_sync();
    {
        const bf16_t* Kb = p.hb + (size_t)b * SEQ * NMAIN + C_NKS + kv * 64;
        const bf16_t* VTb = p.vT + ((size_t)b * NVH + 6 + kv) * 64 * SEQ;
        attn_init<3>(o, m, l);
        for (int kb = 0; kb <= cur; ++kb) {
            const bool mine = (qmask >> kb) & 1u;
            if (__ballot(mine) == 0ull) continue;
#pragma unroll 1
            for (int hc = 0; hc < 2; ++hc) {
                const int kc0 = kb * 64 + hc * 32, dq = t - kc0 - 8 * fq;
                attn_chunk<3>(Kb, NMAIN, VTb, SEQ, kc0, qf, o, m, l, fr, fq, [&](int g, int j, float raw) {
                    const int dist = dq - j;
                    return (mine && dist >= 0) ? raw * SCL2 - sl[g] * (float)dist : MASKV; });
            }
        }
#pragma unroll
        for (int g = 0; g < 3; ++g) {
            const float lt = lsum4(l[g]); const float sc = (lt > 0.f ? 1.0f / lt : 0.f) / (1.0f + __expf(-gl[g * 3 + 1]));
#pragma unroll
            for (int dt = 0; dt < 4; ++dt) otv[(g * 4 + dt) * 64] += o[g][dt] * sc;
        }
    }
    {
        const bf16_t* Kb = p.hb + (size_t)b * SEQ * NMAIN + C_NKW + kv * 64;
        const bf16_t* VTb = p.vT + ((size_t)b * NVH + 8 + kv) * 64 * SEQ;
        attn_init<3>(o, m, l);
        const int c_lo = max(0, t0 - 511) >> 5, c_hi = (t0 + 15) >> 5;
        for (int c = c_lo; c <= c_hi; ++c) {
            const int kc0 = c * 32, dq = t - kc0 - 8 * fq;
            attn_chunk<3>(Kb, NMAIN, VTb, SEQ, kc0, qf, o, m, l, fr, fq, [&](int g, int j, float raw) {
                const int dist = dq - j;
                return (dist >= 0 && dist < 512) ? raw * SCL2 - sl[g] * (float)dist : MASKV; });
        }
#pragma unroll
        for (int g = 0; g < 3; ++g) {
            const float lt = lsum4(l[g]); const float sc = (lt > 0.f ? 1.0f / lt : 0.f) / (1.0f + __expf(-gl[g * 3 + 2]));
            bf16_t* dst = p.ob + ((size_t)b * SEQ + t) * DM + 640 + (kv * 3 + g) * 64 + 4 * fq;
#pragma unroll
            for (int dt = 0; dt < 4; ++dt) store_o4(dst + dt * 16, otv[(g * 4 + dt) * 64] + o[g][dt] * sc);
        }
    }
}

__device__ __forceinline__ void phase_attn(const Params& p, int l, char* lds, int cslot = 16) {
    int tid = threadIdx.x; asm volatile("" : "+v"(tid));
    const int wid = tid >> 6, lane = tid & 63, fr = lane & 15, fq = lane >> 4;
    float* ps = (float*)(lds + wid * 14592); unsigned* msk = (unsigned*)(ps + 512); float* otl = ps + 576;
    unsigned* ctr = p.ctrl + cslot + l;
    constexpr unsigned NU_NSA = NB * 2 * 128, NU_FOX = NB * 4 * 32, NU_SWA = NB * 2 * 128;
    for (;;) {
        unsigned u = 0;
        if (lane == 0) u = __hip_atomic_fetch_add(ctr, 1u, __ATOMIC_RELAXED, __HIP_MEMORY_SCOPE_AGENT);
        u = (unsigned)__builtin_amdgcn_readfirstlane((int)u);
        if (u >= NU_NSA + NU_FOX + NU_SWA) break;
        if (u < NU_NSA) { const int pos = 127 - (int)(u >> 5), r = u & 31; nsa_unit(p, r >> 1, r & 1, pos, fr, fq, lane, ps, msk, otl); }
        else if (u < NU_NSA + NU_FOX) { const unsigned v = u - NU_NSA; const int qb = 31 - (int)(v >> 6), r = v & 63; fox_unit(p, r >> 2, r & 3, qb, fr, fq); }
        else { const unsigned v = u - NU_NSA - NU_FOX; const int pos = 127 - (int)(v >> 5), r = v & 31; swa_unit(p, l, r >> 1, r & 1, pos, fr, fq); }
    }
}

__device__ __forceinline__ void phase_ln1_router(const Params& p, int l, char* lds) {
    int tid = threadIdx.x; asm volatile("" : "+v"(tid));
    const int wid = tid >> 6, lane = tid & 63, fr = lane & 15, fq = lane >> 4;
    float* lg = (float*)lds + wid * 512;
    int* lcnt = (int*)(lds + 16384); int* lbase = lcnt + 32;
    const float* g1 = p.ln1_g + l * DM; const float* b1 = p.ln1_b + l * DM;
    const float* rw = p.rwT + (size_t)l * NE * 1024; const float* rb = p.router_b + l * NE;
    unsigned* gcount = p.ctrl + 64 + l * NE;
    for (int grp = blockIdx.x; grp < NTOK / 128; grp += gridDim.x) {
        const int tok0 = grp * 128 + wid * 16;
        if (tid < 32) lcnt[tid] = 0;
        for (int r = 0; r < 16; ++r) {
            const size_t row = (size_t)(tok0 + r);
            float4 v[4]; float s = 0.f;
#pragma unroll
            for (int j = 0; j < 4; ++j) { v[j] = *(const float4*)(p.tbuf + row * DM + j * 256 + lane * 4); s += (v[j].x + v[j].y) + (v[j].z + v[j].w); }
            const float mean = wave_sum(s) * (1.0f / 1024.0f);
            float qv = 0.f;
#pragma unroll
            for (int j = 0; j < 4; ++j) { v[j].x -= mean; v[j].y -= mean; v[j].z -= mean; v[j].w -= mean; qv += (v[j].x * v[j].x + v[j].y * v[j].y) + (v[j].z * v[j].z + v[j].w * v[j].w); }
            const float rstd = rsqrtf(wave_sum(qv) * (1.0f / 1024.0f) + LN_EPS);
#pragma unroll
            for (int j = 0; j < 4; ++j) {
                const int c = j * 256 + lane * 4;
                const float4 gg = *(const float4*)(g1 + c), bb = *(const float4*)(b1 + c);
                float4 y; y.x = v[j].x * rstd * gg.x + bb.x; y.y = v[j].y * rstd * gg.y + bb.y; y.z = v[j].z * rstd * gg.z + bb.z; y.w = v[j].w * rstd * gg.w + bb.w;
                *(float4*)(p.x1f + row * DM + c) = y;
                u32x2 w; w.x = pack2(y.x, y.y); w.y = pack2(y.z, y.w);
                *(u32x2*)(p.x1b + row * DM + c) = w;
            }
        }
        __syncthreads();
        f32x4 a0 = (f32x4){0.f, 0.f, 0.f, 0.f}, a1 = a0;
        const float* xr = p.x1f + (size_t)(tok0 + fr) * DM + 4 * fq;
        const float* w0 = rw + (size_t)fr * 1024 + 4 * fq; const float* w1 = rw + (size_t)(16 + fr) * 1024 + 4 * fq;
        for (int k0 = 0; k0 < 1024; k0 += 16) {
            const float4 xa = *(const float4*)(xr + k0), wb0 = *(const float4*)(w0 + k0), wb1 = *(const float4*)(w1 + k0);
            a0 = __builtin_amdgcn_mfma_f32_16x16x4f32(xa.x, wb0.x, a0, 0, 0, 0); a1 = __builtin_amdgcn_mfma_f32_16x16x4f32(xa.x, wb1.x, a1, 0, 0, 0);
            a0 = __builtin_amdgcn_mfma_f32_16x16x4f32(xa.y, wb0.y, a0, 0, 0, 0); a1 = __builtin_amdgcn_mfma_f32_16x16x4f32(xa.y, wb1.y, a1, 0, 0, 0);
            a0 = __builtin_amdgcn_mfma_f32_16x16x4f32(xa.z, wb0.z, a0, 0, 0, 0); a1 = __builtin_amdgcn_mfma_f32_16x16x4f32(xa.z, wb1.z, a1, 0, 0, 0);
            a0 = __builtin_amdgcn_mfma_f32_16x16x4f32(xa.w, wb0.w, a0, 0, 0, 0); a1 = __builtin_amdgcn_mfma_f32_16x16x4f32(xa.w, wb1.w, a1, 0, 0, 0);
        }
#pragma unroll
        for (int r = 0; r < 4; ++r) { lg[(fq * 4 + r) * 32 + fr] = a0[r] + rb[fr]; lg[(fq * 4 + r) * 32 + 16 + fr] = a1[r] + rb[16 + fr]; }
        lds_wave_sync();
        int e4[4] = {0, 0, 0, 0}; int rk[4] = {0, 0, 0, 0};
        if (lane < 16) {
            const float* my = lg + lane * 32; unsigned taken = 0u; float tv[4];
#pragma unroll
            for (int k = 0; k < 4; ++k) {
                float best = NEG_INF; int bi = 0;
                for (int e = 0; e < 32; ++e) { const float xv = my[e]; if (!((taken >> e) & 1u) && xv > best) { best = xv; bi = e; } }
                taken |= 1u << bi; e4[k] = bi; tv[k] = best;
            }
            const float e1 = __expf(tv[1] - tv[0]), e2 = __expf(tv[2] - tv[0]), e3 = __expf(tv[3] - tv[0]);
            const float inv = 1.0f / (1.0f + e1 + e2 + e3);
            const size_t row = (size_t)(tok0 + lane);
            *(float4*)(p.gw + row * 4) = make_float4(inv, e1 * inv, e2 * inv, e3 * inv);
        }
        __syncthreads();
        if (lane < 16) {
#pragma unroll
            for (int k = 0; k < 4; ++k) rk[k] = atomicAdd(&lcnt[e4[k]], 1);
        }
        __syncthreads();
        if (tid < 32) { const int c = lcnt[tid]; lbase[tid] = c ? (int)__hip_atomic_fetch_add(gcount + tid, (unsigned)c, __ATOMIC_RELAXED, __HIP_MEMORY_SCOPE_AGENT) : 0; }
        __syncthreads();
        if (lane < 16) {
            const int row = tok0 + lane; int pk[4];
#pragma unroll
            for (int k = 0; k < 4; ++k) { const int pos = lbase[e4[k]] + rk[k]; p.lists[(size_t)e4[k] * LIST_CAP + pos] = row * 4 + k; pk[k] = (pos << 5) | e4[k]; }
            *(int4*)(p.top_e + (size_t)row * 4) = make_int4(pk[0], pk[1], pk[2], pk[3]);
        }
        __syncthreads();
    }
}

__device__ __forceinline__ void phase_ln2(const Params& p, int l, float* xout, char* lds) {
    int* ptile = (int*)(lds + LDS_TAB); int* ecnt = ptile + 40;
    build_tiles(p, l, ptile, ecnt);
    int tid = threadIdx.x; asm volatile("" : "+v"(tid));
    const int wid = tid >> 6, lane = tid & 63;
    const float* g2 = p.ln2_g + l * DM; const float* b2 = p.ln2_b + l * DM;
    for (int row = blockIdx.x * NWV + wid; row < NTOK; row += gridDim.x * NWV) {
        const float4 gwv = *(const float4*)(p.gw + (size_t)row * 4);
        const float gk[4] = {gwv.x, gwv.y, gwv.z, gwv.w};
        const int4 te = *(const int4*)(p.top_e + (size_t)row * 4);
        const int tk[4] = {te.x, te.y, te.z, te.w};
        const bf16_t* yr[4];
#pragma unroll
        for (int k = 0; k < 4; ++k) yr[k] = p.ybuf + (size_t)(ptile[tk[k] & 31] * 256 + (tk[k] >> 5)) * DM;
        float4 v[4]; float s = 0.f;
#pragma unroll
        for (int j = 0; j < 4; ++j) {
            const int c = j * 256 + lane * 4;
            const float4 xv = *(const float4*)(p.x1f + (size_t)row * DM + c);
            float4 a; a.x = xv.x * ALPHA; a.y = xv.y * ALPHA; a.z = xv.z * ALPHA; a.w = xv.w * ALPHA;
#pragma unroll
            for (int k = 0; k < 4; ++k) {
                const u32x2 w = *(const u32x2*)(yr[k] + c);
                a.x += gk[k] * __uint_as_float(w.x << 16); a.y += gk[k] * __uint_as_float(w.x & 0xffff0000u);
                a.z += gk[k] * __uint_as_float(w.y << 16); a.w += gk[k] * __uint_as_float(w.y & 0xffff0000u);
            }
            v[j] = a; s += (a.x + a.y) + (a.z + a.w);
        }
        const float mean = wave_sum(s) * (1.0f / 1024.0f);
        float qv = 0.f;
#pragma unroll
        for (int j = 0; j < 4; ++j) { v[j].x -= mean; v[j].y -= mean; v[j].z -= mean; v[j].w -= mean; qv += (v[j].x * v[j].x + v[j].y * v[j].y) + (v[j].z * v[j].z + v[j].w * v[j].w); }
        const float rstd = rsqrtf(wave_sum(qv) * (1.0f / 1024.0f) + LN_EPS);
#pragma unroll
        for (int j = 0; j < 4; ++j) {
            const int c = j * 256 + lane * 4;
            const float4 gg = *(const float4*)(g2 + c), bb = *(const float4*)(b2 + c);
            float4 y; y.x = v[j].x * rstd * gg.x + bb.x; y.y = v[j].y * rstd * gg.y + bb.y; y.z = v[j].z * rstd * gg.z + bb.z; y.w = v[j].w * rstd * gg.w + bb.w;
            *(float4*)(xout + (size_t)row * DM + c) = y;
            u32x2 w; w.x = pack2(y.x, y.y); w.y = pack2(y.z, y.w);
            *(u32x2*)(p.xb + (size_t)row * DM + c) = w;
        }
    }
}


#define XB_TMO      128
#define XB_XCNT(j)  (256  + 64 * (j))
#define XB_XSUB(j)  (1280 + 64 * (j))
#define XB_XGEN(j)  (2304 + 64 * (j))
#define XB_TOP      3328
#define XB_TOPGEN   3392
#define XCD_BAR_WORDS 3456
#define XB_SPIN_CAP (1u << 22)
__device__ __forceinline__ unsigned xb_ld(unsigned* p)              { return __hip_atomic_load(p, __ATOMIC_RELAXED, __HIP_MEMORY_SCOPE_AGENT); }
__device__ __forceinline__ unsigned xb_add(unsigned* p, unsigned v) { return __hip_atomic_fetch_add(p, v, __ATOMIC_RELAXED, __HIP_MEMORY_SCOPE_AGENT); }
__device__ __forceinline__ unsigned xb_xcc_id() { return (unsigned)__builtin_amdgcn_s_getreg((3 << 11) | 20) & 0xFu; }
#define XB_SPIN(cond, bar) do { unsigned _sp = 0; while (cond) { __builtin_amdgcn_s_sleep(1); \
    if ((++_sp & 255u) == 0u) { if (xb_ld(&(bar)[XB_TMO])) break; if (_sp > XB_SPIN_CAP) { atomicAdd(&(bar)[XB_TMO], 1u); break; } } } } while (0)
struct XcdBarrier { unsigned* bar; unsigned x; volatile LAS unsigned* st; };
__device__ __forceinline__ XcdBarrier xcd_barrier_post(unsigned* bar, volatile LAS unsigned* st) {
    XcdBarrier b; b.bar = bar; b.x = xb_xcc_id(); b.st = st;
    if (threadIdx.x == 0) (void)xb_add(&bar[XB_XCNT(b.x)], 1u);
    return b;
}
__device__ __forceinline__ void xcd_barrier_complete(unsigned* bar, unsigned x, unsigned& nloc, unsigned& nx) {
    const unsigned G = gridDim.x * gridDim.y * gridDim.z;
    unsigned sum, cnt, mine, sp = 0u;
    for (;;) {
        sum = 0u; cnt = 0u; mine = 0u;
#pragma unroll
        for (unsigned j = 0; j < 16; ++j) { const unsigned c = xb_ld(&bar[XB_XCNT(j)]); sum += c; cnt += (c > 0u) ? 1u : 0u; mine = (j == x) ? c : mine; }
        if (sum == G) break;
        __builtin_amdgcn_s_sleep(1);
        if ((++sp & 255u) == 0u) { if (xb_ld(&bar[XB_TMO])) break; if (sp > XB_SPIN_CAP) { atomicAdd(&bar[XB_TMO], 1u); break; } }
    }
    nloc = mine > 0u ? mine : 1u; nx = cnt > 0u ? cnt : 1u;
}
__device__ __forceinline__ void xcd_barrier(const XcdBarrier& b) {
    asm volatile("s_waitcnt vmcnt(0)" ::: "memory");
    __syncthreads();
    if (threadIdx.x == 0) {
        unsigned* bar = b.bar;
        __builtin_amdgcn_s_waitcnt(0);
        unsigned nloc = b.st[0], nx = b.st[1];
        if (nloc == 0u) { xcd_barrier_complete(bar, b.x, nloc, nx); b.st[0] = nloc; b.st[1] = nx; }
        const unsigned old = xb_add(&bar[XB_XSUB(b.x)], 1u);
        const unsigned gen = old / nloc;
        if (old + 1u == (gen + 1u) * nloc) {
            __builtin_amdgcn_fence(__ATOMIC_RELEASE, "agent");
            asm volatile("s_waitcnt vmcnt(0)" ::: "memory");
            const unsigned og = xb_add(&bar[XB_TOP], 1u);
            const unsigned tg = og / nx;
            if (og + 1u == (tg + 1u) * nx) xb_add(&bar[XB_TOPGEN], 1u);
            else XB_SPIN(xb_ld(&bar[XB_TOPGEN]) == tg, bar);
            __builtin_amdgcn_fence(__ATOMIC_ACQUIRE, "agent");
            xb_add(&bar[XB_XGEN(b.x)], 1u);
            asm volatile("s_waitcnt vmcnt(0)" ::: "memory");
        } else {
            XB_SPIN(xb_ld(&bar[XB_XGEN(b.x)]) == gen, bar);
            __builtin_amdgcn_fence(__ATOMIC_ACQUIRE, "agent");
            asm volatile("s_waitcnt vmcnt(0)" ::: "memory");
        }
    }
    __syncthreads();
}

struct KArgs { const float* in[18]; float* out; char* ws; };
constexpr size_t al256(size_t v) { return (v + 255) / 256 * 256; }
struct WSL {
    static constexpr size_t ctrl = 0;
    static constexpr size_t WinT = al256(ctrl + 65536);
    static constexpr size_t WoT = al256(WinT + (size_t)NL * NPAD * 1024 * 2);
    static constexpr size_t W1T = al256(WoT + (size_t)NL * 1024 * 1024 * 2);
    static constexpr size_t W2T = al256(W1T + (size_t)NL * 2 * 64 * 2048 * 2);
    static constexpr size_t WguT = al256(W2T + (size_t)NL * 2 * 64 * 64 * 2);
    static constexpr size_t WdnT = al256(WguT + (size_t)NL * NE * 2048 * 1024 * 2);
    static constexpr size_t rwT = al256(WdnT + (size_t)NL * NE * 1024 * 1024 * 2);
    static constexpr size_t binp = al256(rwT + (size_t)NL * NE * 1024 * 4);
    static constexpr size_t bgup = al256(binp + (size_t)NL * NPAD * 4);
    static constexpr size_t b1c = al256(bgup + (size_t)NL * NE * 2048 * 4);
    static constexpr size_t xf = al256(b1c + 4 * 64 * 4);
    static constexpr size_t xb = al256(xf + (size_t)NTOK * DM * 4);
    static constexpr size_t hb = al256(xb + (size_t)NTOK * DM * 2);
    static constexpr size_t hs = al256(hb + (size_t)NTOK * NMAIN * 2);
    static constexpr size_t vT = al256(hs + (size_t)NTOK * HS_W * 4);
    static constexpr size_t cF = al256(vT + (size_t)NB * NVH * 64 * SEQ * 2);
    static constexpr size_t kc = al256(cF + (size_t)NB * 4 * SEQ * 4);
    static constexpr size_t vc = al256(kc + (size_t)NB * 2 * 128 * 64 * 2);
    static constexpr size_t vcT = al256(vc + (size_t)NB * 2 * 128 * 64 * 2);
    static constexpr size_t ob = al256(vcT + (size_t)NB * 2 * 128 * 64 * 2);
    static constexpr size_t tbuf = al256(ob + (size_t)NTOK * DM * 2);
    static constexpr size_t x1f = al256(tbuf + (size_t)NTOK * DM * 4);
    static constexpr size_t x1b = al256(x1f + (size_t)NTOK * DM * 4);
    static constexpr size_t top_e = al256(x1b + (size_t)NTOK * DM * 2);
    static constexpr size_t gw = al256(top_e + (size_t)NTOK * 4 * 4);
    static constexpr size_t lists = al256(gw + (size_t)NTOK * 4 * 4);
    static constexpr size_t act = al256(lists + (size_t)NE * LIST_CAP * 4);
    static constexpr size_t ybuf = al256(act + (size_t)MAXSLOT * DFF * 2);
    static constexpr size_t total = al256(ybuf + (size_t)MAXSLOT * DM * 2);
};
__device__ __forceinline__ Params make_params(const KArgs& k) {
    Params p;
    p.x = k.in[0]; p.w_in = k.in[1]; p.b_in = k.in[2]; p.sinks = k.in[3]; p.cmp_pe = k.in[4]; p.cmp_w1 = k.in[5]; p.cmp_w2 = k.in[6]; p.w_out = k.in[7];
    p.ln1_g = k.in[8]; p.ln1_b = k.in[9]; p.router_w = k.in[10]; p.router_b = k.in[11]; p.w_gu = k.in[12]; p.b_gu = k.in[13]; p.w_dn = k.in[14]; p.b_dn = k.in[15];
    p.ln2_g = k.in[16]; p.ln2_b = k.in[17]; p.out = k.out;
    char* w = k.ws;
    p.ctrl = (unsigned*)(w + WSL::ctrl); p.WinT = (bf16_t*)(w + WSL::WinT); p.WoT = (bf16_t*)(w + WSL::WoT); p.W1T = (bf16_t*)(w + WSL::W1T); p.W2T = (bf16_t*)(w + WSL::W2T);
    p.WguT = (bf16_t*)(w + WSL::WguT); p.WdnT = (bf16_t*)(w + WSL::WdnT); p.rwT = (float*)(w + WSL::rwT); p.binp = (float*)(w + WSL::binp); p.bgup = (float*)(w + WSL::bgup);
    p.b1c = (float*)(w + WSL::b1c); p.xf = (float*)(w + WSL::xf); p.xb = (bf16_t*)(w + WSL::xb); p.hb = (bf16_t*)(w + WSL::hb); p.hs = (float*)(w + WSL::hs); p.vT = (bf16_t*)(w + WSL::vT);
    p.cF = (float*)(w + WSL::cF); p.kc = (bf16_t*)(w + WSL::kc); p.vc = (bf16_t*)(w + WSL::vc); p.vcT = (bf16_t*)(w + WSL::vcT); p.ob = (bf16_t*)(w + WSL::ob); p.tbuf = (float*)(w + WSL::tbuf);
    p.x1f = (float*)(w + WSL::x1f); p.x1b = (bf16_t*)(w + WSL::x1b); p.top_e = (int*)(w + WSL::top_e); p.gw = (float*)(w + WSL::gw); p.lists = (int*)(w + WSL::lists);
    p.act = (bf16_t*)(w + WSL::act); p.ybuf = (bf16_t*)(w + WSL::ybuf);
    return p;
}
__device__ __forceinline__ void grid_bar(const Params& p, char* lds) {
    XcdBarrier xb; xb.bar = p.ctrl + 1024; xb.x = xb_xcc_id(); xb.st = (volatile LAS unsigned*)(lds + LDS_BYTES - 16); xcd_barrier(xb);
}
template <int L>
__device__ __forceinline__ void layer_fwd(const Params& p, char* lds) {
    const float* xin = L == 0 ? p.x : p.xf;
    float* xout = L == NL - 1 ? p.out : p.xf;
#ifndef REP
#define REP 0
#endif
    phase_inproj(p, L, lds);        grid_bar(p, lds);
    if (REP & 1) { phase_inproj(p, L, lds);        grid_bar(p, lds); }
    phase_prep(p, L, lds);          grid_bar(p, lds);
    if (REP & 2) { phase_prep(p, L, lds);          grid_bar(p, lds); }
    phase_attn(p, L, lds);          grid_bar(p, lds);
    if (REP & 4) { phase_attn(p, L, lds, 24);      grid_bar(p, lds); }
    phase_outproj(p, L, xin, lds);  grid_bar(p, lds);
    if (REP & 8) { phase_outproj(p, L, xin, lds);  grid_bar(p, lds); }
    phase_ln1_router(p, L, lds);    grid_bar(p, lds);
    phase_gateup(p, L, lds);        grid_bar(p, lds);
    if (REP & 16) { phase_gateup(p, L, lds);       grid_bar(p, lds); }
    phase_down(p, L, lds);          grid_bar(p, lds);
    if (REP & 32) { phase_down(p, L, lds);         grid_bar(p, lds); }
    phase_ln2(p, L, xout, lds);
    if (REP & 64) { grid_bar(p, lds); phase_ln2(p, L, xout, lds); }
}
__global__ void __launch_bounds__(NTHR, 2) fwd_kernel(KArgs ka) {
    extern __shared__ __attribute__((aligned(16))) char lds[];
    const Params p = make_params(ka);
    cg::grid_group grid = cg::this_grid();
    volatile LAS unsigned* xst = (volatile LAS unsigned*)(lds + LDS_BYTES - 16);
    if (threadIdx.x == 0) { xst[0] = 0u; xst[1] = 0u; }
    __syncthreads();
    (void)xcd_barrier_post(p.ctrl + 1024, xst);
    phase0(p, lds);
    if (REP & 128) { grid_bar(p, lds); phase0(p, lds); }
    grid.sync();
    layer_fwd<0>(p, lds);
    grid_bar(p, lds);
    layer_fwd<1>(p, lds);
}

extern "C" void kernel_launch(void* const* d_in, const int* in_sizes, int n_in, void* d_out, int out_size, void* d_ws, size_t ws_size, hipStream_t stream) {
    KArgs ka{};
    for (int i = 0; i < 18; ++i) ka.in[i] = (const float*)d_in[i];
    ka.out = (float*)d_out; ka.ws = (char*)d_ws;
    if (WSL::total > ws_size) { fprintf(stderr, "workspace too small: need %zu have %zu\n", (size_t)WSL::total, ws_size); return; }
    static int grid_blocks = 0;
    if (!grid_blocks) {
        int dev = 0, cus = 0, per_cu = 0;
        (void)hipGetDevice(&dev);
        (void)hipDeviceGetAttribute(&cus, hipDeviceAttributeMultiprocessorCount, dev);
        (void)hipFuncSetAttribute((const void*)fwd_kernel, hipFuncAttributeMaxDynamicSharedMemorySize, LDS_BYTES);
        (void)hipOccupancyMaxActiveBlocksPerMultiprocessor(&per_cu, fwd_kernel, NTHR, LDS_BYTES);
        if (per_cu < 1) { fprintf(stderr, "occupancy query says 0 blocks per CU\n"); per_cu = 1; }
        grid_blocks = cus;
    }
    (void)hipMemsetAsync(d_ws, 0, 65536, stream);
    void* args[] = {&ka};
    hipError_t e = hipLaunchCooperativeKernel((const void*)fwd_kernel, dim3(grid_blocks), dim3(NTHR), args, LDS_BYTES, stream);
    if (e != hipSuccess) fprintf(stderr, "cooperative launch failed: %s (grid %d)\n", hipGetErrorString(e), grid_blocks);
}
```

```cpp
#include <hip/hip_runtime.h>
#include <hip/hip_cooperative_groups.h>
#include <cstdio>
#include <cstdint>
namespace cg = cooperative_groups;

typedef unsigned short bf16_t;
typedef short bf16x8 __attribute__((ext_vector_type(8)));
typedef float f32x4 __attribute__((ext_vector_type(4)));
typedef unsigned u32x4 __attribute__((ext_vector_type(4)));
typedef unsigned u32x2 __attribute__((ext_vector_type(2)));
#define LAS __attribute__((address_space(3)))
constexpr float NEG_INF = -__builtin_huge_valf();

constexpr int DM = 1024, NB = 16, SEQ = 2048, NTOK = NB * SEQ, NL = 2;
constexpr int NCOL = 2582, NMAIN = 2560, NPAD = 2688, NE = 32, DFF = 1024;
constexpr int C_FQ = 0, C_FK = 256, C_FV = 512, C_SQ = 768, C_SK = 1152, C_SV = 1280, C_NQ = 1408,
              C_NKC = 1792, C_NVC = 1920, C_NKS = 2048, C_NVS = 2176, C_NKW = 2304, C_NVW = 2432;
constexpr int HS_W = 32;
constexpr int NVH = 10;
constexpr int LIST_CAP = NTOK;
constexpr int MAXSLOT = NTOK * 4 + NE * 256;
constexpr float ALPHA = 1.41421356237f, LN_EPS = 1e-5f, QSCALE = 0.125f;
constexpr int NWV = 8, NTHR = NWV * 64;
constexpr int LDS_STAGE = 131072, LDS_TAB = LDS_STAGE, LDS_BYTES = LDS_STAGE + 2048;

struct Params {
    const float *x, *w_in, *b_in, *sinks, *cmp_pe, *cmp_w1, *cmp_w2, *w_out, *ln1_g, *ln1_b, *router_w, *router_b,
                *w_gu, *b_gu, *w_dn, *b_dn, *ln2_g, *ln2_b;
    float* out;
    unsigned* ctrl;
    bf16_t *WinT, *WoT, *W1T, *W2T, *WguT, *WdnT;
    float *rwT, *binp, *bgup, *b1c;
    float* xf; bf16_t* xb; bf16_t* hb; float* hs; bf16_t* vT; float* cF;
    bf16_t *kc, *vc, *vcT; bf16_t* ob; float* tbuf; float* x1f; bf16_t* x1b;
    int* top_e; float* gw; int* lists; bf16_t* act; bf16_t* ybuf;
};

__device__ __forceinline__ float bf2f(bf16_t h) { return __uint_as_float(((unsigned)h) << 16); }
typedef __bf16 bf16x2_t __attribute__((ext_vector_type(2)));
__device__ __forceinline__ bf16_t f2bf(float f) { return __builtin_bit_cast(bf16_t, (__bf16)f); }
__device__ __forceinline__ unsigned pack2(float lo, float hi) { bf16x2_t v = {(__bf16)lo, (__bf16)hi}; return __builtin_bit_cast(unsigned, v); }
__device__ __forceinline__ float wave_sum(float v) {
#pragma unroll
    for (int o = 32; o > 0; o >>= 1) v += __shfl_xor(v, o);
    return v;
}
__device__ __forceinline__ float wave_max(float v) {
#pragma unroll
    for (int o = 32; o > 0; o >>= 1) v = fmaxf(v, __shfl_xor(v, o));
    return v;
}
__device__ __forceinline__ void lds_wave_sync() { asm volatile("s_waitcnt lgkmcnt(0)" ::: "memory"); __builtin_amdgcn_wave_barrier(); }
__device__ __forceinline__ float slope_swa(int hq) { return exp2f(-8.0f * (float)(2 * hq + 1) / 12.0f); }
__device__ __forceinline__ float slope_nsa(int hq) { return exp2f(-8.0f * (float)(2 * hq + 2) / 12.0f); }

__device__ __forceinline__ int perm_row(int perm, int n) {
    if (perm == 1) { if (n < 768) return n; if (n < 772) return 2560 + (n - 768); if (n < 2564) return n - 4; return n; }
    if (perm == 2) { const int f = n >> 1, s = n & 1; return (f >> 7) * 256 + s * 128 + (f & 127); }
    return n;
}
struct ConvJob { const float* src; bf16_t* dst; int K, N, kt, nt, perm; };
__device__ __forceinline__ bool conv_job(const Params& p, int t, ConvJob& jb) {
    constexpr int T_GU = NL * NE * 8 * 16, T_DN = NL * NE * 8 * 8, T_WIN = NL * 8 * 21, T_WO = NL * 8 * 8;
    if (t < T_GU) { const int m = t / 128, r = t % 128; jb = ConvJob{p.w_gu + (size_t)m * 1024 * 2048, p.WguT + (size_t)m * 2048 * 1024, 1024, 2048, r / 16, r % 16, 2}; return true; }
    t -= T_GU;
    if (t < T_DN) { const int m = t / 64, r = t % 64; jb = ConvJob{p.w_dn + (size_t)m * 1024 * 1024, p.WdnT + (size_t)m * 1024 * 1024, 1024, 1024, r / 8, r % 8, 0}; return true; }
    t -= T_DN;
    if (t < T_WIN) { const int m = t / 168, r = t % 168; jb = ConvJob{p.w_in + (size_t)m * 1024 * NCOL, p.WinT + (size_t)m * NPAD * 1024, 1024, NCOL, r / 21, r % 21, 1}; return true; }
    t -= T_WIN;
    if (t < T_WO) { const int m = t / 64, r = t % 64; jb = ConvJob{p.w_out + (size_t)m * 1024 * 1024, p.WoT + (size_t)m * 1024 * 1024, 1024, 1024, r / 8, r % 8, 0}; return true; }
    return false;
}
__device__ __forceinline__ void conv_load(const ConvJob& jb, int tid, float2 (&v)[16]) {
    const int n = jb.nt * 128 + (tid & 31) * 4;
    const float* s = jb.src + (size_t)(jb.kt * 128 + (tid >> 5)) * jb.N + n;
#pragma unroll
    for (int i = 0; i < 8; ++i) {
        const float* r = s + (size_t)(16 * i) * jb.N;
        v[2 * i] = (n + 1 < jb.N) ? *(const float2*)r : make_float2(0.f, 0.f);
        v[2 * i + 1] = (n + 3 < jb.N) ? *(const float2*)(r + 2) : make_float2(0.f, 0.f);
    }
}
__device__ __forceinline__ void phase0(const Params& p, char* ldsc) {
    int tid = threadIdx.x; asm volatile("" : "+v"(tid));
    const int G = gridDim.x, bid = blockIdx.x;
    const size_t gtid = (size_t)bid * NTHR + tid, gthreads = (size_t)G * NTHR;
    {
        constexpr int TOT = NL * NE * 8 * 16 + NL * NE * 8 * 8 + NL * 8 * 21 + NL * 8 * 8;
        bf16_t* lt = (bf16_t*)ldsc;
        ConvJob jb, jn; float2 v[16], vn[16];
        int t = bid; bool have = t < TOT && conv_job(p, t, jb);
        if (have) conv_load(jb, tid, v);
        while (have) {
            const int tn = t + G; const bool hn = tn < TOT && conv_job(p, tn, jn);
            if (hn) conv_load(jn, tid, vn);
#pragma unroll
            for (int i = 0; i < 8; ++i) {
                u32x2 w; w.x = pack2(v[2 * i].x, v[2 * i].y); w.y = pack2(v[2 * i + 1].x, v[2 * i + 1].y);
                *(u32x2*)(lt + ((tid >> 5) + 16 * i) * 136 + (tid & 31) * 4) = w;
            }
            __syncthreads();
#pragma unroll
            for (int i = 0; i < 4; ++i) {
                const int idx = tid + NTHR * i, kc = idx & 15, nn = idx >> 4, n = jb.nt * 128 + nn;
                if (n < jb.N) {
                    const bf16_t* l = lt + (kc * 8) * 136 + nn;
                    u32x4 w;
                    w.x = (unsigned)l[0] | ((unsigned)l[136] << 16); w.y = (unsigned)l[272] | ((unsigned)l[408] << 16);
                    w.z = (unsigned)l[544] | ((unsigned)l[680] << 16); w.w = (unsigned)l[816] | ((unsigned)l[952] << 16);
                    *(u32x4*)(jb.dst + (size_t)perm_row(jb.perm, n) * jb.K + jb.kt * 128 + kc * 8) = w;
                }
            }
            __syncthreads();
            t = tn; have = hn; jb = jn;
#pragma unroll
            for (int i = 0; i < 16; ++i) v[i] = vn[i];
        }
    }
    for (size_t i = gtid; i < (size_t)NL * 2 * 2048 * 64; i += gthreads) {
        const int k = (int)(i % 2048), n = (int)((i / 2048) % 64), m = (int)(i / (2048 * 64));
        p.W1T[i] = f2bf(p.cmp_w1[((size_t)m * 2048 + k) * 64 + n]);
    }
    for (size_t i = gtid; i < (size_t)NL * 2 * 64 * 64; i += gthreads) {
        const int k = (int)(i % 64), n = (int)((i / 64) % 64), m = (int)(i / 4096);
        p.W2T[i] = f2bf(p.cmp_w2[((size_t)m * 64 + k) * 64 + n]);
    }
    for (size_t i = gtid; i < (size_t)NL * NPAD; i += gthreads) {
        const int l = (int)(i / NPAD), r = (int)(i % NPAD);
        float v = 0.f;
        if (r < 2560) { const int n = r < 768 ? r : r + 4; v = p.b_in[l * NCOL + n]; }
        else if (r < 2564) v = p.b_in[l * NCOL + 768 + (r - 2560)];
        else if (r < 2582) v = p.b_in[l * NCOL + r];
        p.binp[i] = v;
    }
    for (size_t i = gtid; i < (size_t)NL * NE * 2048; i += gthreads) {
        const int r = (int)(i % 2048); const size_t le = i / 2048;
        const int s = (r >> 7) & 1, f = (r >> 8) * 128 + (r & 127);
        p.bgup[i] = p.b_gu[le * 2048 + 2 * f + s];
    }
    for (size_t i = gtid; i < (size_t)NL * NE * 1024; i += gthreads) {
        const int k = (int)(i % 1024), e = (int)((i / 1024) % NE), l = (int)(i / (1024 * NE));
        p.rwT[i] = p.router_w[((size_t)l * 1024 + k) * NE + e];
    }
    for (size_t i = gtid; i < (size_t)NL * (NPAD - NCOL) * 1024; i += gthreads) {
        const int l = (int)(i / ((NPAD - NCOL) * 1024)); const size_t r = i % ((size_t)(NPAD - NCOL) * 1024);
        p.WinT[(size_t)l * NPAD * 1024 + (size_t)NCOL * 1024 + r] = 0;
    }
    for (size_t i = gtid; i < (size_t)NTOK * DM / 4; i += gthreads) {
        const float4 v4 = ((const float4*)p.x)[i];
        u32x2 w; w.x = pack2(v4.x, v4.y); w.y = pack2(v4.z, v4.w);
        ((u32x2*)p.xb)[i] = w;
    }
    if (bid < 4) {
        float* lf = (float*)ldsc;
        const int j = tid & 63, part = tid >> 6;
        const float* pe = p.cmp_pe + (size_t)bid * 2048; const float* w1 = p.cmp_w1 + (size_t)bid * 2048 * 64;
        float s = 0.f;
        for (int kk = part * 256; kk < part * 256 + 256; ++kk) s += pe[kk] * w1[(size_t)kk * 64 + j];
        lf[tid] = s; __syncthreads();
        if (tid < 64) { float a = 0.f; for (int q = 0; q < 8; ++q) a += lf[tid + 64 * q]; p.b1c[bid * 64 + tid] = a; }
        __syncthreads();
    }
}

namespace pg8 {
constexpr int BM = 256, BK = 64, HALF = 128, HTB = HALF * BK * 2, NXCD = 8, WGM = 8;
__device__ __forceinline__ int lds_byte(int r, int c) { const int st = (r >> 4) * 2 + (c >> 5), rr = r & 15, cc = c & 31, ob = rr * 64 + cc * 2; return st * 1024 + (ob ^ (((ob >> 9) & 1) << 5)); }
__device__ __forceinline__ void stage_rc(int b, int& R, int& C) { const int st = b / 1024, sb = b % 1024, swz = sb ^ (((sb >> 9) & 1) << 5); R = (st >> 1) * 16 + swz / 64; C = (st & 1) * 32 + (swz % 64) / 2; }
__device__ __forceinline__ bool tile_order(int i, int G, int c, int nM, int nN, int& pm, int& pn) {
    const int nwg = nM * nN; const long L = (long)i * G + c; if (L >= nwg) return false;
    int wgid = (int)L; { const int q = nwg / NXCD, r = nwg % NXCD, xcd = wgid % NXCD, off = wgid / NXCD; wgid = (xcd < r ? xcd * (q + 1) : r * (q + 1) + (xcd - r) * q) + off; }
    const int nig = WGM * nN, gid = wgid / nig, fm = gid * WGM, gsz = (nM - fm) < WGM ? (nM - fm) : WGM;
    pm = fm + ((wgid % nig) % gsz); pn = (wgid % nig) / gsz; return true;
}
template <class Sched, class Epi>
__device__ __forceinline__ void gemm_phase(LAS unsigned char* lds, const char* Abase, int K, const Sched& S, const Epi& E) {
    int tid = threadIdx.x; asm volatile("" : "+v"(tid));
    const int wid = __builtin_amdgcn_readfirstlane(tid >> 6), lane = tid & 63, wr = wid >> 2, wc = wid & 3, fr = lane & 15, fq = lane >> 4;
    const int nt = K / BK;
    int R0, C0, R1, C1; stage_rc(tid * 16, R0, C0); stage_rc(tid * 16 + 8192, R1, C1);
    unsigned voffB[2]; voffB[0] = (unsigned)(R0 * K + C0) * 2u; voffB[1] = (unsigned)(R1 * K + C1) * 2u;
    const size_t kstep = (size_t)(BK * 2), hstep = (size_t)HALF * K * 2;
    const unsigned ldsw = (unsigned)wid * 1024u;
    const int aoff = lds_byte(wr * 64 + fr, fq * 8), boff = lds_byte(wc * 32 + fr, fq * 8);
#define PG8_SA(b, h) (((b) * 2 + (h)) * HTB)
#define PG8_SB(b, h) ((4 + (b) * 2 + (h)) * HTB)
#define PG8_STAGE_B(bufoff, gbase) do { _Pragma("unroll") for (int _i = 0; _i < 2; ++_i) \
        __builtin_amdgcn_global_load_lds((const unsigned*)((const char*)(gbase) + voffB[_i]), (LAS unsigned*)(lds + (bufoff) + ldsw + _i * 8192), 16, 0, 0); } while (0)
#define PG8_STAGE_A(bufoff, kbyte, o0, o1) do { \
        __builtin_amdgcn_global_load_lds((const unsigned*)(Abase + (kbyte) + (o0)), (LAS unsigned*)(lds + (bufoff) + ldsw), 16, 0, 0); \
        __builtin_amdgcn_global_load_lds((const unsigned*)(Abase + (kbyte) + (o1)), (LAS unsigned*)(lds + (bufoff) + ldsw + 8192), 16, 0, 0); } while (0)
#define PG8_LDA(dst, b, h) do { _Pragma("unroll") for (int m = 0; m < 4; ++m) _Pragma("unroll") for (int k = 0; k < 2; ++k) dst[m][k] = *(const LAS bf16x8*)(lds + PG8_SA(b, h) + aoff + m * 2048 + k * 1024); } while (0)
#define PG8_LDB(dst, b, h) do { _Pragma("unroll") for (int n = 0; n < 2; ++n) _Pragma("unroll") for (int k = 0; k < 2; ++k) dst[n][k] = *(const LAS bf16x8*)(lds + PG8_SB(b, h) + boff + n * 2048 + k * 1024); } while (0)
#define PG8_MMA(ai, bj, At, Bt) do { __builtin_amdgcn_s_setprio(1); _Pragma("unroll") for (int m = 0; m < 4; ++m) _Pragma("unroll") for (int n = 0; n < 2; ++n) _Pragma("unroll") for (int k = 0; k < 2; ++k) \
        acc[ai][bj][m][n] = __builtin_amdgcn_mfma_f32_16x16x32_bf16(Bt[n][k], At[m][k], acc[ai][bj][m][n], 0, 0, 0); __builtin_amdgcn_s_setprio(0); } while (0)
#define PG8_WAIT_V(n) asm volatile("s_waitcnt vmcnt(" #n ")" ::: "memory")
#define PG8_WAIT_L(n) asm volatile("s_waitcnt lgkmcnt(" #n ")" ::: "memory")
#define PG8_BAR __builtin_amdgcn_s_barrier()
#define PG8_SCHED __builtin_amdgcn_sched_barrier(0)
    typename Sched::Unit cur, nxt; int ui = 0;
    if (!S.next(0, cur)) return;
    f32x4 acc[2][2][4][2];
#pragma unroll
    for (int a = 0; a < 2; ++a)
#pragma unroll
        for (int b = 0; b < 2; ++b)
#pragma unroll
            for (int m = 0; m < 4; ++m)
#pragma unroll
                for (int n = 0; n < 2; ++n) acc[a][b][m][n] = (f32x4){0.f, 0.f, 0.f, 0.f};
    bf16x8 At[4][2], B0[2][2], B1[2][2];
    unsigned aC[2][2], aN[2][2];
    S.a_off(cur, R0, C0, R1, C1, aC);
    const char* cB = S.b_ptr(cur);
    PG8_STAGE_B(PG8_SB(0, 0), cB); PG8_STAGE_B(PG8_SB(0, 1), cB + hstep); PG8_STAGE_A(PG8_SA(0, 0), 0, aC[0][0], aC[0][1]); PG8_STAGE_A(PG8_SA(0, 1), 0, aC[1][0], aC[1][1]);
    if (wr == 1) PG8_BAR;
    PG8_WAIT_V(2); PG8_BAR;
    PG8_STAGE_B(PG8_SB(1, 0), cB + kstep); PG8_STAGE_A(PG8_SA(1, 0), kstep, aC[0][0], aC[0][1]); PG8_STAGE_B(PG8_SB(1, 1), cB + hstep + kstep);
    PG8_WAIT_V(6); PG8_BAR;
    for (;;) {
        const bool has_next = S.next(ui + 1, nxt);
        const char* nB = cB;
        if (has_next) { S.a_off(nxt, R0, C0, R1, C1, aN); nB = S.b_ptr(nxt); }
        else { aN[0][0] = aC[0][0]; aN[0][1] = aC[0][1]; aN[1][0] = aC[1][0]; aN[1][1] = aC[1][1]; }
        for (int t = 0; t < nt; t += 2) {
            const bool last = (t == nt - 2);
            const size_t ka1 = (size_t)(t + 1) * kstep, ka2 = last ? 0 : (size_t)(t + 2) * kstep, ka3 = ka2 + kstep;
            const char* b2 = last ? nB : cB + (size_t)(t + 2) * kstep; const char* b3 = b2 + kstep;
            const unsigned o00 = last ? aN[0][0] : aC[0][0], o01 = last ? aN[0][1] : aC[0][1], o10 = last ? aN[1][0] : aC[1][0], o11 = last ? aN[1][1] : aC[1][1];
            PG8_LDB(B0, 0, 0); PG8_LDB(B1, 0, 1); PG8_SCHED; PG8_LDA(At, 0, 0); PG8_STAGE_A(PG8_SA(1, 1), ka1, aC[1][0], aC[1][1]);
            PG8_WAIT_V(8); PG8_WAIT_L(0); PG8_BAR; PG8_MMA(0, 0, At, B0); PG8_MMA(0, 1, At, B1); PG8_BAR; PG8_SCHED;
            PG8_LDA(At, 0, 1); PG8_STAGE_B(PG8_SB(0, 0), b2); PG8_STAGE_B(PG8_SB(0, 1), b2 + hstep); PG8_STAGE_A(PG8_SA(0, 0), ka2, o00, o01);
            PG8_WAIT_V(8); PG8_WAIT_L(0); PG8_BAR; PG8_MMA(1, 0, At, B0); PG8_MMA(1, 1, At, B1); PG8_BAR; PG8_SCHED;
            PG8_LDB(B0, 1, 0); PG8_LDB(B1, 1, 1); PG8_SCHED; PG8_LDA(At, 1, 0); PG8_STAGE_A(PG8_SA(0, 1), ka2, o10, o11);
            PG8_WAIT_V(8); PG8_WAIT_L(0); PG8_BAR; PG8_MMA(0, 0, At, B0); PG8_MMA(0, 1, At, B1); PG8_BAR; PG8_SCHED;
            PG8_LDA(At, 1, 1); PG8_STAGE_B(PG8_SB(1, 0), b3); PG8_STAGE_B(PG8_SB(1, 1), b3 + hstep); PG8_STAGE_A(PG8_SA(1, 0), ka3, o00, o01);
            PG8_WAIT_V(8); PG8_WAIT_L(0); PG8_BAR; PG8_MMA(1, 0, At, B0); PG8_MMA(1, 1, At, B1); PG8_BAR; PG8_SCHED;
        }
        if (wr == 0) PG8_BAR;
        E(acc, cur, wr, wc, fr, fq);
        if (!has_next) break;
#pragma unroll
        for (int a = 0; a < 2; ++a)
#pragma unroll
            for (int b = 0; b < 2; ++b)
#pragma unroll
                for (int m = 0; m < 4; ++m)
#pragma unroll
                    for (int n = 0; n < 2; ++n) acc[a][b][m][n] = (f32x4){0.f, 0.f, 0.f, 0.f};
        cur = nxt; cB = nB; ++ui;
        aC[0][0] = aN[0][0]; aC[0][1] = aN[0][1]; aC[1][0] = aN[1][0]; aC[1][1] = aN[1][1];
        if (wr == 1) PG8_BAR;
    }
    PG8_WAIT_V(0);
    PG8_BAR;
#undef PG8_SA
#undef PG8_SB
#undef PG8_STAGE_A
#undef PG8_STAGE_B
#undef PG8_LDA
#undef PG8_LDB
#undef PG8_MMA
#undef PG8_WAIT_V
#undef PG8_WAIT_L
#undef PG8_BAR
#undef PG8_SCHED
}
}

struct DenseUnit { int pm, pn; };
struct DenseSched {
    typedef DenseUnit Unit;
    const char* Bt; int K, nM, nN;
    __device__ __forceinline__ bool next(int i, Unit& u) const { return pg8::tile_order(i, gridDim.x, blockIdx.x, nM, nN, u.pm, u.pn); }
    __device__ __forceinline__ void a_off(const Unit& u, int R0, int C0, int R1, int C1, unsigned (&off)[2][2]) const {
#pragma unroll
        for (int h = 0; h < 2; ++h) { off[h][0] = (unsigned)((u.pm * 256 + h * 128 + R0) * K + C0) * 2u; off[h][1] = (unsigned)((u.pm * 256 + h * 128 + R1) * K + C1) * 2u; }
    }
    __device__ __forceinline__ const char* b_ptr(const Unit& u) const { return Bt + (size_t)u.pn * 256 * K * 2; }
};
struct MoeUnit { int rbt, e, rb, cnt, pn; };
template <bool GATHER>
struct MoeSched {
    typedef MoeUnit Unit;
    const char* Bt; const int* lists; const int* ptile; const int* ecnt; int nN, nrows;
    __device__ __forceinline__ bool next(int i, Unit& u) const {
        int pm, pn; if (!pg8::tile_order(i, gridDim.x, blockIdx.x, ptile[NE], nN, pm, pn)) return false;
        int e = 0; while (ptile[e + 1] <= pm) ++e;
        u.rbt = pm; u.e = e; u.rb = pm - ptile[e]; u.cnt = ecnt[e]; u.pn = pn; return true;
    }
    __device__ __forceinline__ void a_off(const Unit& u, int R0, int C0, int R1, int C1, unsigned (&off)[2][2]) const {
        if (GATHER) {
            const int* lst = lists + (size_t)u.e * LIST_CAP;
#pragma unroll
            for (int h = 0; h < 2; ++h) {
                const int l0 = u.rb * 256 + h * 128 + R0, l1 = u.rb * 256 + h * 128 + R1;
                const int t0 = l0 < u.cnt ? (lst[l0] >> 2) : 0, t1 = l1 < u.cnt ? (lst[l1] >> 2) : 0;
                off[h][0] = (unsigned)(t0 * 1024 + C0) * 2u; off[h][1] = (unsigned)(t1 * 1024 + C1) * 2u;
            }
        } else {
#pragma unroll
            for (int h = 0; h < 2; ++h) { off[h][0] = (unsigned)((u.rbt * 256 + h * 128 + R0) * 1024 + C0) * 2u; off[h][1] = (unsigned)((u.rbt * 256 + h * 128 + R1) * 1024 + C1) * 2u; }
        }
    }
    __device__ __forceinline__ const char* b_ptr(const Unit& u) const { return Bt + ((size_t)u.e * nrows + (size_t)u.pn * 256) * 1024 * 2; }
};

struct EpiInProj {
    const Params* p; int l;
    __device__ __forceinline__ void operator()(const f32x4 (&acc)[2][2][4][2], const DenseUnit& u, int wr, int wc, int fr, int fq) const {
        const float* bias = p->binp + l * NPAD + u.pn * 256;
#pragma unroll
        for (int bj = 0; bj < 2; ++bj) {
            int vh = -1;
            if (u.pn == 2) vh = bj * 2; else if (u.pn == 5 && bj == 0) vh = 4; else if (u.pn == 8 && bj == 1) vh = 6; else if (u.pn == 9 && bj == 1) vh = 8;
#pragma unroll
            for (int n = 0; n < 2; ++n) {
                const int c = bj * 128 + wc * 32 + n * 16 + 4 * fq;
                const f32x4 bv = *(const f32x4*)(bias + c);
#pragma unroll
                for (int ai = 0; ai < 2; ++ai)
#pragma unroll
                    for (int m = 0; m < 4; ++m) {
                        const int row = u.pm * 256 + ai * 128 + wr * 64 + m * 16 + fr;
                        const f32x4 v = acc[ai][bj][m][n] + bv;
                        u32x2 w; w.x = pack2(v[0], v[1]); w.y = pack2(v[2], v[3]);
                        *(u32x2*)(p->hb + (size_t)row * NMAIN + u.pn * 256 + c) = w;
                        if (vh >= 0) {
                            const int b = row >> 11, s = row & 2047, hh = vh + ((c & 127) >> 6), d = c & 63;
                            bf16_t* vt = p->vT + (((size_t)b * NVH + hh) * 64 + d) * SEQ + s;
                            vt[0] = (bf16_t)(w.x & 0xffff); vt[SEQ] = (bf16_t)(w.x >> 16); vt[2 * SEQ] = (bf16_t)(w.y & 0xffff); vt[3 * SEQ] = (bf16_t)(w.y >> 16);
                        }
                    }
            }
        }
    }
};
struct EpiOutProj {
    const float* xin; float* t;
    __device__ __forceinline__ void operator()(const f32x4 (&acc)[2][2][4][2], const DenseUnit& u, int wr, int wc, int fr, int fq) const {
#pragma unroll
        for (int ai = 0; ai < 2; ++ai)
#pragma unroll
            for (int m = 0; m < 4; ++m) {
                const size_t rowoff = (size_t)(u.pm * 256 + ai * 128 + wr * 64 + m * 16 + fr) * DM + u.pn * 256 + wc * 32 + 4 * fq;
#pragma unroll
                for (int bj = 0; bj < 2; ++bj)
#pragma unroll
                    for (int n = 0; n < 2; ++n) {
                        const size_t off = rowoff + bj * 128 + n * 16;
                        const f32x4 xv = *(const f32x4*)(xin + off);
                        *(f32x4*)(t + off) = xv * ALPHA + acc[ai][bj][m][n];
                    }
            }
    }
};
struct EpiGateUp {
    bf16_t* act; const float* bgup;
    __device__ __forceinline__ void operator()(const f32x4 (&acc)[2][2][4][2], const MoeUnit& u, int wr, int wc, int fr, int fq) const {
        const float* bias = bgup + (size_t)u.e * 2048 + u.pn * 256;
#pragma unroll
        for (int n = 0; n < 2; ++n) {
            const int c = wc * 32 + n * 16 + 4 * fq;
            const f32x4 bg = *(const f32x4*)(bias + c), bu = *(const f32x4*)(bias + 128 + c);
#pragma unroll
            for (int ai = 0; ai < 2; ++ai)
#pragma unroll
                for (int m = 0; m < 4; ++m) {
                    const f32x4 g4 = acc[ai][0][m][n] + bg, u4 = acc[ai][1][m][n] + bu;
                    float o[4];
#pragma unroll
                    for (int j = 0; j < 4; ++j) {
                        const float g = fminf(g4[j], 7.0f), uu = fminf(fmaxf(u4[j], -7.0f), 7.0f);
                        const float glu = g * __builtin_amdgcn_rcpf(1.0f + __builtin_amdgcn_exp2f(-2.455466929f * g));
                        o[j] = (uu + 1.0f) * glu;
                    }
                    u32x2 w; w.x = pack2(o[0], o[1]); w.y = pack2(o[2], o[3]);
                    *(u32x2*)(act + (size_t)(u.rbt * 256 + ai * 128 + wr * 64 + m * 16 + fr) * DFF + u.pn * 128 + c) = w;
                }
        }
    }
};
struct EpiDown {
    bf16_t* ybuf; const float* bdn;
    __device__ __forceinline__ void operator()(const f32x4 (&acc)[2][2][4][2], const MoeUnit& u, int wr, int wc, int fr, int fq) const {
        const float* bias = bdn + (size_t)u.e * 1024 + u.pn * 256;
#pragma unroll
        for (int bj = 0; bj < 2; ++bj)
#pragma unroll
            for (int n = 0; n < 2; ++n) {
                const int c = bj * 128 + wc * 32 + n * 16 + 4 * fq;
                const f32x4 bv = *(const f32x4*)(bias + c);
#pragma unroll
                for (int ai = 0; ai < 2; ++ai)
#pragma unroll
                    for (int m = 0; m < 4; ++m) {
                        const f32x4 v = acc[ai][bj][m][n] + bv;
                        u32x2 w; w.x = pack2(v[0], v[1]); w.y = pack2(v[2], v[3]);
                        *(u32x2*)(ybuf + (size_t)(u.rbt * 256 + ai * 128 + wr * 64 + m * 16 + fr) * DM + u.pn * 256 + c) = w;
                    }
            }
    }
};

__device__ __forceinline__ void phase_inproj(const Params& p, int l, char* lds) {
    DenseSched S{(const char*)(p.WinT + (size_t)l * NPAD * 1024), 1024, NTOK / 256, NMAIN / 256};
    EpiInProj E{&p, l};
    pg8::gemm_phase((LAS unsigned char*)lds, (const char*)p.xb, 1024, S, E);
    int tid = threadIdx.x; asm volatile("" : "+v"(tid));
    const int wid = tid >> 6, lane = tid & 63, fr = lane & 15, fq = lane >> 4;
    const bf16_t* W = p.WinT + ((size_t)l * NPAD + NMAIN) * 1024;
    const float* bias = p.binp + l * NPAD + NMAIN;
    for (int u = blockIdx.x * NWV + wid; u < NTOK / 16; u += gridDim.x * NWV) {
        const bf16_t* ar = p.xb + (size_t)(u * 16 + fr) * DM + fq * 8;
        const bf16_t* w0 = W + (size_t)fr * 1024 + fq * 8; const bf16_t* w1 = W + (size_t)(16 + fr) * 1024 + fq * 8;
        f32x4 a0 = (f32x4){0.f, 0.f, 0.f, 0.f}, a1 = a0;
#pragma unroll 4
        for (int ks = 0; ks < 32; ++ks) {
            const bf16x8 a = *(const bf16x8*)(ar + ks * 32);
            a0 = __builtin_amdgcn_mfma_f32_16x16x32_bf16(a, *(const bf16x8*)(w0 + ks * 32), a0, 0, 0, 0);
            a1 = __builtin_amdgcn_mfma_f32_16x16x32_bf16(a, *(const bf16x8*)(w1 + ks * 32), a1, 0, 0, 0);
        }
#pragma unroll
        for (int r = 0; r < 4; ++r) {
            float* dst = p.hs + (size_t)(u * 16 + fq * 4 + r) * HS_W;
            dst[fr] = a0[r] + bias[fr];
            if (fr < 6) dst[16 + fr] = a1[r] + bias[16 + fr];
        }
    }
}
__device__ __forceinline__ void phase_outproj(const Params& p, int l, const float* xin, char* lds) {
    DenseSched S{(const char*)(p.WoT + (size_t)l * 1024 * 1024), 1024, NTOK / 256, 4};
    EpiOutProj E{xin, p.tbuf};
    pg8::gemm_phase((LAS unsigned char*)lds, (const char*)p.ob, 1024, S, E);
}
__device__ __forceinline__ void build_tiles(const Params& p, int l, int* ptile, int* ecnt) {
    if (threadIdx.x < NE) ecnt[threadIdx.x] = (int)__hip_atomic_load(p.ctrl + 64 + l * NE + threadIdx.x, __ATOMIC_RELAXED, __HIP_MEMORY_SCOPE_AGENT);
    __syncthreads();
    if (threadIdx.x == 0) { int s = 0; for (int e = 0; e < NE; ++e) { ptile[e] = s; s += (ecnt[e] + 255) >> 8; } ptile[NE] = s; }
    __syncthreads();
}
__device__ __forceinline__ void phase_gateup(const Params& p, int l, char* lds) {
    int* ptile = (int*)(lds + LDS_TAB); int* ecnt = ptile + 40;
    build_tiles(p, l, ptile, ecnt);
    MoeSched<true> S{(const char*)(p.WguT + (size_t)l * NE * 2048 * 1024), p.lists, ptile, ecnt, 8, 2048};
    EpiGateUp E{p.act, p.bgup + (size_t)l * NE * 2048};
    pg8::gemm_phase((LAS unsigned char*)lds, (const char*)p.x1b, 1024, S, E);
}
__device__ __forceinline__ void phase_down(const Params& p, int l, char* lds) {
    int* ptile = (int*)(lds + LDS_TAB); int* ecnt = ptile + 40;
    build_tiles(p, l, ptile, ecnt);
    MoeSched<false> S{(const char*)(p.WdnT + (size_t)l * NE * 1024 * 1024), p.lists, ptile, ecnt, 4, 1024};
    EpiDown E{p.ybuf, p.b_dn + (size_t)l * NE * 1024};
    pg8::gemm_phase((LAS unsigned char*)lds, (const char*)p.act, 1024, S, E);
}

__device__ __forceinline__ float gelu_tanh(float x) {
    const float u = 0.7978845608028654f * (x + 0.044715f * x * x * x);
    const float e = __expf(-2.0f * fabsf(u)); const float th = (1.0f - e) / (1.0f + e);
    return 0.5f * x * (1.0f + (u < 0.f ? -th : th));
}
__device__ __forceinline__ void phase_prep(const Params& p, int l, char* lds) {
    int tid = threadIdx.x; asm volatile("" : "+v"(tid));
    const int wid = tid >> 6, lane = tid & 63, fr = lane & 15, fq = lane >> 4;
    const int gw = blockIdx.x * NWV + wid, nw = gridDim.x * NWV;
    for (int u = blockIdx.x; u < NB * 4; u += gridDim.x) {
        const int b = u >> 2, h = u & 3;
        const float* srcp = p.hs + ((size_t)b * SEQ + tid * 4) * HS_W + h;
        float ls[4]; float tot = 0.f;
#pragma unroll
        for (int i = 0; i < 4; ++i) { const float f = srcp[(size_t)i * HS_W]; ls[i] = fminf(f, 0.f) - log1pf(__expf(-fabsf(f))); tot += ls[i]; }
        float inc = tot;
#pragma unroll
        for (int o = 1; o < 64; o <<= 1) { const float v = __shfl_up(inc, o); if (lane >= o) inc += v; }
        float* wtot = (float*)(lds + 65536);
        if (lane == 63) wtot[wid] = inc;
        __syncthreads();
        float base = inc - tot;
        for (int w = 0; w < wid; ++w) base += wtot[w];
        float4 o4; o4.x = base + ls[0]; o4.y = o4.x + ls[1]; o4.z = o4.y + ls[2]; o4.w = o4.z + ls[3];
        *(float4*)(p.cF + (size_t)u * SEQ + tid * 4) = o4;
        __syncthreads();
    }
    bf16_t* h1 = (bf16_t*)(lds + wid * 2048);
    for (int u = nw - 1 - gw; u < NB * 2 * 2 * 8; u += nw) {
        const int ct = u & 7, which = (u >> 3) & 1, kvh = (u >> 4) & 1, b = u >> 5;
        const int colo = (which ? C_NVC : C_NKC) + kvh * 64;
        const int c_lane = ct * 16 + fr;
        const int tokbase = min(c_lane, 126) * 16;
        const bf16_t* arow = p.hb + ((size_t)b * SEQ + tokbase) * NMAIN + colo + fq * 8;
        const bf16_t* w1 = p.W1T + ((size_t)(l * 2 + which) * 64 + fr) * 2048 + fq * 8;
        f32x4 acc[4];
#pragma unroll
        for (int n = 0; n < 4; ++n) acc[n] = (f32x4){0.f, 0.f, 0.f, 0.f};
#pragma unroll 8
        for (int ks = 0; ks < 64; ++ks) {
            const bf16x8 a = *(const bf16x8*)(arow + (size_t)(ks >> 1) * NMAIN + (ks & 1) * 32);
#pragma unroll
            for (int n = 0; n < 4; ++n) {
                const bf16x8 bb = *(const bf16x8*)(w1 + (size_t)n * 16 * 2048 + ks * 32);
                acc[n] = __builtin_amdgcn_mfma_f32_16x16x32_bf16(a, bb, acc[n], 0, 0, 0);
            }
        }
        const float* b1 = p.b1c + (l * 2 + which) * 64;
#pragma unroll
        for (int n = 0; n < 4; ++n)
#pragma unroll
            for (int r = 0; r < 4; ++r) h1[(fq * 4 + r) * 64 + n * 16 + fr] = f2bf(gelu_tanh(acc[n][r] + b1[n * 16 + fr]));
        lds_wave_sync();
        const bf16_t* w2 = p.W2T + ((size_t)(l * 2 + which) * 64 + fr) * 64 + fq * 8;
        f32x4 o2[4];
#pragma unroll
        for (int n = 0; n < 4; ++n) o2[n] = (f32x4){0.f, 0.f, 0.f, 0.f};
#pragma unroll
        for (int ks = 0; ks < 2; ++ks) {
            const bf16x8 a = *(const bf16x8*)(h1 + fr * 64 + ks * 32 + fq * 8);
#pragma unroll
            for (int n = 0; n < 4; ++n) {
                const bf16x8 bb = *(const bf16x8*)(w2 + (size_t)n * 16 * 64 + ks * 32);
                o2[n] = __builtin_amdgcn_mfma_f32_16x16x32_bf16(a, bb, o2[n], 0, 0, 0);
            }
        }
        lds_wave_sync();
        const size_t base = ((size_t)b * 2 + kvh) * 128 * 64;
#pragma unroll
        for (int n = 0; n < 4; ++n)
#pragma unroll
            for (int r = 0; r < 4; ++r) {
                const int c = ct * 16 + fq * 4 + r, j2 = n * 16 + fr;
                const bf16_t v = c < 127 ? f2bf(o2[n][r]) : (bf16_t)0;
                if (which == 0) p.kc[base + (size_t)c * 64 + j2] = v;
                else { p.vc[base + (size_t)c * 64 + j2] = v; p.vcT[base + (size_t)j2 * 128 + c] = v; }
            }
    }
}

constexpr float L2E = 1.4426950408889634f, MASKV = -1e30f, SCL2 = QSCALE * L2E;
struct KVFrag { bf16x8 k[2][2]; bf16x8 v[4]; };
__device__ __forceinline__ void k_load(KVFrag& f, const bf16_t* __restrict__ Kb, size_t ldk, int kc0, int fr, int fq) {
    const bf16_t* kp = Kb + (size_t)(kc0 + (fr >> 2) * 8 + (fr & 3)) * ldk + fq * 8;
    f.k[0][0] = *(const bf16x8*)(kp); f.k[0][1] = *(const bf16x8*)(kp + 32);
    f.k[1][0] = *(const bf16x8*)(kp + 4 * ldk); f.k[1][1] = *(const bf16x8*)(kp + 4 * ldk + 32);
}
__device__ __forceinline__ void v_load(bf16x8 (&v)[4], const bf16_t* __restrict__ VTb, size_t ldv, int kc0, int fr, int fq) {
    const bf16_t* vp = VTb + (size_t)fr * ldv + kc0 + fq * 8;
#pragma unroll
    for (int dt = 0; dt < 4; ++dt) v[dt] = *(const bf16x8*)(vp + (size_t)dt * 16 * ldv);
}
template <int NQT, bool MASK, class MB>
__device__ __forceinline__ void attn_compute(const KVFrag& f, const bf16x8 (&qf)[NQT][2], f32x4 (&o)[NQT][4], float (&m)[NQT], float (&l)[NQT], const MB& mb) {
#pragma unroll
    for (int qt = 0; qt < NQT; ++qt) {
        f32x4 s0 = (f32x4){0.f, 0.f, 0.f, 0.f}, s1 = s0;
        s0 = __builtin_amdgcn_mfma_f32_16x16x32_bf16(f.k[0][0], qf[qt][0], s0, 0, 0, 0);
        s0 = __builtin_amdgcn_mfma_f32_16x16x32_bf16(f.k[0][1], qf[qt][1], s0, 0, 0, 0);
        s1 = __builtin_amdgcn_mfma_f32_16x16x32_bf16(f.k[1][0], qf[qt][0], s1, 0, 0, 0);
        s1 = __builtin_amdgcn_mfma_f32_16x16x32_bf16(f.k[1][1], qf[qt][1], s1, 0, 0, 0);
        float v[8];
#pragma unroll
        for (int j = 0; j < 4; ++j) { v[j] = mb(qt, j, s0[j]); v[j + 4] = mb(qt, j + 4, s1[j]); }
        float mx = fmaxf(fmaxf(fmaxf(v[0], v[1]), fmaxf(v[2], v[3])), fmaxf(fmaxf(v[4], v[5]), fmaxf(v[6], v[7])));
        mx = fmaxf(mx, __shfl_xor(mx, 16)); mx = fmaxf(mx, __shfl_xor(mx, 32));
        const float mold = m[qt], mnew = fmaxf(mold, mx);
        m[qt] = mnew;
        float pr[8]; float ps = 0.f;
#pragma unroll
        for (int j = 0; j < 8; ++j) { pr[j] = (!MASK || v[j] > -1e29f) ? __builtin_amdgcn_exp2f(v[j] - mnew) : 0.f; ps += pr[j]; }
        if (__ballot(mnew != mold) != 0ull) {
            const float alpha = __builtin_amdgcn_exp2f(mold - mnew);
            l[qt] *= alpha;
#pragma unroll
            for (int dt = 0; dt < 4; ++dt) o[qt][dt] *= alpha;
        }
        l[qt] += ps;
        union { bf16x8 v8; unsigned u[4]; } pf;
        pf.u[0] = pack2(pr[0], pr[1]); pf.u[1] = pack2(pr[2], pr[3]); pf.u[2] = pack2(pr[4], pr[5]); pf.u[3] = pack2(pr[6], pr[7]);
#pragma unroll
        for (int dt = 0; dt < 4; ++dt) o[qt][dt] = __builtin_amdgcn_mfma_f32_16x16x32_bf16(f.v[dt], pf.v8, o[qt][dt], 0, 0, 0);
        __builtin_amdgcn_sched_barrier(0);
    }
}
struct RangeIt { int c, c_hi; __device__ __forceinline__ int nxt() { if (c > c_hi) return -1; return (c++) * 32; } };
struct MaskIt { unsigned long long cm; __device__ __forceinline__ int nxt() { if (!cm) return -1; const int i = __builtin_ctzll(cm); cm &= cm - 1; return i * 32; } };
template <bool PFV, class It, class Gen>
__device__ __forceinline__ void attn_run(It& it, const bf16_t* Kb, size_t ldk, const bf16_t* VTb, size_t ldv, int fr, int fq, const Gen& gen) {
    KVFrag fa, fb;
    int ka = it.nxt(); if (ka < 0) return;
    k_load(fa, Kb, ldk, ka, fr, fq); if (PFV) v_load(fa.v, VTb, ldv, ka, fr, fq);
    for (;;) {
        const int kb = it.nxt(); if (kb >= 0) { k_load(fb, Kb, ldk, kb, fr, fq); if (PFV) v_load(fb.v, VTb, ldv, kb, fr, fq); }
        if (!PFV) v_load(fa.v, VTb, ldv, ka, fr, fq);
        gen(ka, fa);
        if (kb < 0) break;
        ka = it.nxt(); if (ka >= 0) { k_load(fa, Kb, ldk, ka, fr, fq); if (PFV) v_load(fa.v, VTb, ldv, ka, fr, fq); }
        if (!PFV) v_load(fb.v, VTb, ldv, kb, fr, fq);
        gen(kb, fb);
        if (ka < 0) break;
    }
}
template <int NQT>
__device__ __forceinline__ void attn_init(f32x4 (&o)[NQT][4], float (&m)[NQT], float (&l)[NQT]) {
#pragma unroll
    for (int qt = 0; qt < NQT; ++qt) { m[qt] = MASKV; l[qt] = 0.f;
#pragma unroll
        for (int dt = 0; dt < 4; ++dt) o[qt][dt] = (f32x4){0.f, 0.f, 0.f, 0.f}; }
}
__device__ __forceinline__ float lsum4(float l) { l += __shfl_xor(l, 16); l += __shfl_xor(l, 32); return l; }
__device__ __forceinline__ void store_o4(bf16_t* dst, const f32x4 v) { u32x2 w; w.x = pack2(v[0], v[1]); w.y = pack2(v[2], v[3]); *(u32x2*)dst = w; }
__device__ __forceinline__ float sigmoidf_fast(float x) { return __builtin_amdgcn_rcpf(1.0f + __builtin_amdgcn_exp2f(-L2E * x)); }

__device__ __forceinline__ void fox_unit(const Params& p, int b, int h, int qb, int fr, int fq) {
    asm volatile("" : "+v"(fr), "+v"(fq));
    const int t0 = qb * 32;
    const bf16_t* Qb = p.hb + ((size_t)b * SEQ + t0) * NMAIN + C_FQ + h * 64 + fq * 8;
    bf16x8 qf[2][2];
#pragma unroll
    for (int qt = 0; qt < 2; ++qt) { qf[qt][0] = *(const bf16x8*)(Qb + (size_t)(qt * 16 + fr) * NMAIN); qf[qt][1] = *(const bf16x8*)(Qb + (size_t)(qt * 16 + fr) * NMAIN + 32); }
    const float* cf = p.cF + ((size_t)b * 4 + h) * SEQ;
    float cq[2];
#pragma unroll
    for (int qt = 0; qt < 2; ++qt) cq[qt] = cf[t0 + qt * 16 + fr] * L2E;
    f32x4 o[2][4]; float m[2], l[2];
    attn_init<2>(o, m, l);
    const bf16_t* Kb = p.hb + (size_t)b * SEQ * NMAIN + C_FK + h * 64;
    const bf16_t* VTb = p.vT + ((size_t)b * NVH + h) * 64 * SEQ;
    RangeIt it{0, t0 >> 5};
    attn_run<true>(it, Kb, NMAIN, VTb, SEQ, fr, fq, [&](int kc0, const KVFrag& f) {
        const float4 ca = *(const float4*)(cf + kc0 + 8 * fq), cb = *(const float4*)(cf + kc0 + 8 * fq + 4);
        const float ck[8] = {ca.x * L2E, ca.y * L2E, ca.z * L2E, ca.w * L2E, cb.x * L2E, cb.y * L2E, cb.z * L2E, cb.w * L2E};
        const int kq = kc0 + 8 * fq - t0 - fr;
        attn_compute<2, true>(f, qf, o, m, l, [&](int qt, int j, float raw) { return (kq + j - 16 * qt) > 0 ? MASKV : raw * SCL2 + cq[qt] - ck[j]; });
    });
#pragma unroll
    for (int qt = 0; qt < 2; ++qt) {
        const float inv = __builtin_amdgcn_rcpf(lsum4(l[qt]));
        bf16_t* dst = p.ob + ((size_t)b * SEQ + t0 + qt * 16 + fr) * DM + h * 64 + 4 * fq;
#pragma unroll
        for (int dt = 0; dt < 4; ++dt) store_o4(dst + dt * 16, o[qt][dt] * inv);
    }
}
__device__ __forceinline__ void swa_unit(const Params& p, int l_, int b, int kv, int pos, int fr, int fq) {
    asm volatile("" : "+v"(fr), "+v"(fq));
    const int t0 = pos * 16, t = t0 + fr;
    const bf16_t* Qb = p.hb + ((size_t)b * SEQ + t) * NMAIN + C_SQ + kv * 192 + fq * 8;
    bf16x8 qf[3][2];
#pragma unroll
    for (int g = 0; g < 3; ++g) { qf[g][0] = *(const bf16x8*)(Qb + g * 64); qf[g][1] = *(const bf16x8*)(Qb + g * 64 + 32); }
    float sl[3];
#pragma unroll
    for (int g = 0; g < 3; ++g) sl[g] = slope_swa(kv * 3 + g) * L2E;
    f32x4 o[3][4]; float m[3], l[3];
    attn_init<3>(o, m, l);
    const bf16_t* Kb = p.hb + (size_t)b * SEQ * NMAIN + C_SK + kv * 64;
    const bf16_t* VTb = p.vT + ((size_t)b * NVH + 4 + kv) * 64 * SEQ;
    RangeIt it{max(0, t0 - 127) >> 5, (t0 + 15) >> 5};
    attn_run<true>(it, Kb, NMAIN, VTb, SEQ, fr, fq, [&](int kc0, const KVFrag& f) {
        const int dq = t - kc0 - 8 * fq;
        attn_compute<3, true>(f, qf, o, m, l, [&](int g, int j, float raw) { const int dist = dq - j; return (dist >= 0 && dist < 128) ? raw * SCL2 - sl[g] * (float)dist : MASKV; });
    });
#pragma unroll
    for (int g = 0; g < 3; ++g) {
        const float sink = p.sinks[l_ * 6 + kv * 3 + g] * L2E;
        const float inv = __builtin_amdgcn_rcpf(lsum4(l[g]) + __builtin_amdgcn_exp2f(sink - m[g]));
        bf16_t* dst = p.ob + ((size_t)b * SEQ + t) * DM + 256 + (kv * 3 + g) * 64 + 4 * fq;
#pragma unroll
        for (int dt = 0; dt < 4; ++dt) store_o4(dst + dt * 16, o[g][dt] * inv);
    }
}
__device__ __forceinline__ void nsa_unit(const Params& p, int b, int kv, int pos, int fr, int fq, int lane, float* ps, unsigned* msk, float* otl) {
    asm volatile("" : "+v"(fr), "+v"(fq), "+v"(lane));
    const int t0 = pos * 16, t = t0 + fr, cur = t0 >> 6;
    const bf16_t* Qb = p.hb + ((size_t)b * SEQ + t) * NMAIN + C_NQ + kv * 192 + fq * 8;
    bf16x8 qf[3][2];
#pragma unroll
    for (int g = 0; g < 3; ++g) { qf[g][0] = *(const bf16x8*)(Qb + g * 64); qf[g][1] = *(const bf16x8*)(Qb + g * 64 + 32); }
    float sl[3];
#pragma unroll
    for (int g = 0; g < 3; ++g) sl[g] = slope_nsa(kv * 3 + g) * L2E;
    const float* gl = p.hs + ((size_t)b * SEQ + t) * HS_W + 4 + kv * 9;
    f32x4 o[3][4]; float m[3], l[3];
    f32x4* otv = (f32x4*)otl + lane;
#pragma unroll
    for (int i = 0; i < 8; ++i) ps[lane + 64 * i] = 0.f;
    {
        const bf16_t* Kb = p.kc + ((size_t)b * 2 + kv) * 128 * 64;
        const bf16_t* VTb = p.vcT + ((size_t)b * 2 + kv) * 64 * 128;
        const int ncv = (t0 + 15 >= 31) ? ((t0 + 15 - 31) >> 4) + 1 : 0;
        const int nch = (ncv + 31) >> 5;
        attn_init<3>(o, m, l);
        const int dq0 = t - 31 - 16 * 8 * fq;
        RangeIt it{0, nch - 1};
        attn_run<false>(it, Kb, 64, VTb, 128, fr, fq, [&](int kc0, const KVFrag& f) {
            const int dq = dq0 - 16 * kc0;
            attn_compute<3, true>(f, qf, o, m, l, [&](int g, int j, float raw) { const int dist = dq - 16 * j; return dist >= 0 ? raw * SCL2 - sl[g] * (float)dist : MASKV; });
        });
        float il[3];
#pragma unroll
        for (int g = 0; g < 3; ++g) {
            const float lt = lsum4(l[g]); il[g] = lt > 0.f ? __builtin_amdgcn_rcpf(lt) : 0.f;
            const float gate = sigmoidf_fast(gl[g * 3 + 0]);
#pragma unroll
            for (int dt = 0; dt < 4; ++dt) otv[(g * 4 + dt) * 64] = o[g][dt] * (il[g] * gate);
        }
        float carry_prev = 0.f;
        for (int c = 0; c < nch; ++c) {
            const int kc0 = c * 32, dq = dq0 - 16 * kc0;
            const bf16_t* kp = Kb + (size_t)(kc0 + (fr >> 2) * 8 + (fr & 3)) * 64 + fq * 8;
            const bf16x8 k00 = *(const bf16x8*)(kp), k01 = *(const bf16x8*)(kp + 32), k10 = *(const bf16x8*)(kp + 256), k11 = *(const bf16x8*)(kp + 256 + 32);
            float pc[8];
#pragma unroll
            for (int j = 0; j < 8; ++j) pc[j] = 0.f;
#pragma unroll
            for (int g = 0; g < 3; ++g) {
                f32x4 s0 = (f32x4){0.f, 0.f, 0.f, 0.f}, s1 = s0;
                s0 = __builtin_amdgcn_mfma_f32_16x16x32_bf16(k00, qf[g][0], s0, 0, 0, 0); s0 = __builtin_amdgcn_mfma_f32_16x16x32_bf16(k01, qf[g][1], s0, 0, 0, 0);
                s1 = __builtin_amdgcn_mfma_f32_16x16x32_bf16(k10, qf[g][0], s1, 0, 0, 0); s1 = __builtin_amdgcn_mfma_f32_16x16x32_bf16(k11, qf[g][1], s1, 0, 0, 0);
#pragma unroll
                for (int j = 0; j < 8; ++j) {
                    const int dist = dq - 16 * j; const float raw = j < 4 ? s0[j] : s1[j - 4];
                    if (dist >= 0) pc[j] += __builtin_amdgcn_exp2f(raw * SCL2 - sl[g] * (float)dist - m[g]) * il[g];
                }
            }
            const float cout = 0.5f * pc[7];
            float cin = __shfl_up(cout, 16);
            const float cwrap = __shfl(cout, fr + 48);
            if (fq == 0) cin = carry_prev;
            carry_prev = cwrap;
            const int n0 = (kc0 >> 2) + 2 * fq;
            ps[fr * 32 + n0] = cin + pc[0] + pc[1] + pc[2] + 0.5f * pc[3];
            ps[fr * 32 + n0 + 1] = 0.5f * pc[3] + pc[4] + pc[5] + pc[6] + 0.5f * pc[7];
        }
    }
    lds_wave_sync();
    if (lane < 16) {
        unsigned mask = 1u | (1u << cur); if (cur >= 1) mask |= 1u << (cur - 1);
        if (cur >= 3) {
            if (cur - 2 <= 5) mask |= (1u << (cur - 1)) - 2u;
            else {
                const float* my = ps + lane * 32;
                for (int r = 0; r < 5; ++r) {
                    float best = -1.0f; int bi = 1;
                    for (int j = 1; j <= cur - 2; ++j) { const float v = my[j]; if (!((mask >> j) & 1u) && v > best) { best = v; bi = j; } }
                    mask |= 1u << bi;
                }
            }
        }
        msk[lane] = mask;
    }
    lds_wave_sync();
    const unsigned qmask = msk[fr];
    lds_wave_sync();
    {
        const bf16_t* Kb = p.hb + (size_t)b * SEQ * NMAIN + C_NKS + kv * 64;
        const bf16_t* VTb = p.vT + ((size_t)b * NVH + 6 + kv) * 64 * SEQ;
        attn_init<3>(o, m, l);
        unsigned um = qmask;
        um |= __shfl_xor(um, 1); um |= __shfl_xor(um, 2); um |= __shfl_xor(um, 4); um |= __shfl_xor(um, 8);
        um = (unsigned)__builtin_amdgcn_readfirstlane((int)um) & (cur >= 31 ? 0xffffffffu : ((2u << cur) - 1u));
        unsigned long long cm = 0ull;
        for (unsigned r = um; r; r &= r - 1) { const int kb = __builtin_ctz(r); cm |= 3ull << (2 * kb); }
        MaskIt it{cm};
        attn_run<false>(it, Kb, NMAIN, VTb, SEQ, fr, fq, [&](int kc0, const KVFrag& f) {
            const bool mine = (qmask >> (kc0 >> 6)) & 1u;
            const int dq = t - kc0 - 8 * fq;
            attn_compute<3, true>(f, qf, o, m, l, [&](int g, int j, float raw) { const int dist = dq - j; return (mine && dist >= 0) ? raw * SCL2 - sl[g] * (float)dist : MASKV; });
        });
#pragma unroll
        for (int g = 0; g < 3; ++g) {
            const float lt = lsum4(l[g]); const float sc = (lt > 0.f ? __builtin_amdgcn_rcpf(lt) : 0.f) * sigmoidf_fast(gl[g * 3 + 1]);
#pragma unroll
            for (int dt = 0; dt < 4; ++dt) otv[(g * 4 + dt) * 64] += o[g][dt] * sc;
        }
    }
    {
        const bf16_t* Kb = p.hb + (size_t)b * SEQ * NMAIN + C_NKW + kv * 64;
        const bf16_t* VTb = p.vT + ((size_t)b * NVH + 8 + kv) * 64 * SEQ;
        attn_init<3>(o, m, l);
        RangeIt it{max(0, t0 - 511) >> 5, (t0 + 15) >> 5};
        attn_run<false>(it, Kb, NMAIN, VTb, SEQ, fr, fq, [&](int kc0, const KVFrag& f) {
            const int dq = t - kc0 - 8 * fq;
            attn_compute<3, true>(f, qf, o, m, l, [&](int g, int j, float raw) { const int dist = dq - j; return (dist >= 0 && dist < 512) ? raw * SCL2 - sl[g] * (float)dist : MASKV; });
        });
#pragma unroll
        for (int g = 0; g < 3; ++g) {
            const float lt = lsum4(l[g]); const float sc = (lt > 0.f ? __builtin_amdgcn_rcpf(lt) : 0.f) * sigmoidf_fast(gl[g * 3 + 2]);
            bf16_t* dst = p.ob + ((size_t)b * SEQ + t) * DM + 640 + (kv * 3 + g) * 64 + 4 * fq;
#pragma unroll
            for (int dt = 0; dt < 4; ++dt) store_o4(dst + dt * 16, otv[(g * 4 + dt) * 64] + o[g][dt] * sc);
        }
    }
}

__device__ __forceinline__ void phase_attn(const Params& p, int l, char* lds, int cslot = 16) {
    int tid = threadIdx.x; asm volatile("" : "+v"(tid));
    const int wid = tid >> 6, lane = tid & 63, fr = lane & 15, fq = lane >> 4;
    float* ps = (float*)(lds + wid * 14592); unsigned* msk = (unsigned*)(ps + 512); float* otl = ps + 576;
    unsigned* ctr = p.ctrl + cslot + l;
    constexpr unsigned NU_NSA = NB * 2 * 128, NU_FOX = NB * 4 * 64, NU_SWA = NB * 2 * 128;
    for (;;) {
        unsigned u = 0;
        if (lane == 0) u = __hip_atomic_fetch_add(ctr, 1u, __ATOMIC_RELAXED, __HIP_MEMORY_SCOPE_AGENT);
        u = (unsigned)__builtin_amdgcn_readfirstlane((int)u);
        if (u >= NU_NSA + NU_FOX + NU_SWA) break;
        if (u < NU_NSA) { const int pos = 127 - (int)(u >> 5), r = u & 31; nsa_unit(p, r >> 1, r & 1, pos, fr, fq, lane, ps, msk, otl); }
        else if (u < NU_NSA + NU_FOX) { const unsigned v = u - NU_NSA; const int qb = 63 - (int)(v >> 6), r = v & 63; fox_unit(p, r >> 2, r & 3, qb, fr, fq); }
        else { const unsigned v = u - NU_NSA - NU_FOX; const int pos = 127 - (int)(v >> 5), r = v & 31; swa_unit(p, l, r >> 1, r & 1, pos, fr, fq); }
    }
}

__device__ __forceinline__ void phase_ln1_router(const Params& p, int l, char* lds) {
    int tid = threadIdx.x; asm volatile("" : "+v"(tid));
    const int wid = tid >> 6, lane = tid & 63, fr = lane & 15, fq = lane >> 4;
    float* lg = (float*)lds + wid * 512;
    int* lcnt = (int*)(lds + 16384); int* lbase = lcnt + 32;
    const float* g1 = p.ln1_g + l * DM; const float* b1 = p.ln1_b + l * DM;
    const float* rw = p.rwT + (size_t)l * NE * 1024; const float* rb = p.router_b + l * NE;
    unsigned* gcount = p.ctrl + 64 + l * NE;
    for (int grp = blockIdx.x; grp < NTOK / 128; grp += gridDim.x) {
        const int tok0 = grp * 128 + wid * 16;
        if (tid < 32) lcnt[tid] = 0;
        for (int r = 0; r < 16; ++r) {
            const size_t row = (size_t)(tok0 + r);
            float4 v[4]; float s = 0.f;
#pragma unroll
            for (int j = 0; j < 4; ++j) { v[j] = *(const float4*)(p.tbuf + row * DM + j * 256 + lane * 4); s += (v[j].x + v[j].y) + (v[j].z + v[j].w); }
            const float mean = wave_sum(s) * (1.0f / 1024.0f);
            float qv = 0.f;
#pragma unroll
            for (int j = 0; j < 4; ++j) { v[j].x -= mean; v[j].y -= mean; v[j].z -= mean; v[j].w -= mean; qv += (v[j].x * v[j].x + v[j].y * v[j].y) + (v[j].z * v[j].z + v[j].w * v[j].w); }
            const float rstd = rsqrtf(wave_sum(qv) * (1.0f / 1024.0f) + LN_EPS);
#pragma unroll
            for (int j = 0; j < 4; ++j) {
                const int c = j * 256 + lane * 4;
                const float4 gg = *(const float4*)(g1 + c), bb = *(const float4*)(b1 + c);
                float4 y; y.x = v[j].x * rstd * gg.x + bb.x; y.y = v[j].y * rstd * gg.y + bb.y; y.z = v[j].z * rstd * gg.z + bb.z; y.w = v[j].w * rstd * gg.w + bb.w;
                *(float4*)(p.x1f + row * DM + c) = y;
                u32x2 w; w.x = pack2(y.x, y.y); w.y = pack2(y.z, y.w);
                *(u32x2*)(p.x1b + row * DM + c) = w;
            }
        }
        __syncthreads();
        f32x4 a0 = (f32x4){0.f, 0.f, 0.f, 0.f}, a1 = a0;
        const float* xr = p.x1f + (size_t)(tok0 + fr) * DM + 4 * fq;
        const float* w0 = rw + (size_t)fr * 1024 + 4 * fq; const float* w1 = rw + (size_t)(16 + fr) * 1024 + 4 * fq;
        for (int k0 = 0; k0 < 1024; k0 += 16) {
            const float4 xa = *(const float4*)(xr + k0), wb0 = *(const float4*)(w0 + k0), wb1 = *(const float4*)(w1 + k0);
            a0 = __builtin_amdgcn_mfma_f32_16x16x4f32(xa.x, wb0.x, a0, 0, 0, 0); a1 = __builtin_amdgcn_mfma_f32_16x16x4f32(xa.x, wb1.x, a1, 0, 0, 0);
            a0 = __builtin_amdgcn_mfma_f32_16x16x4f32(xa.y, wb0.y, a0, 0, 0, 0); a1 = __builtin_amdgcn_mfma_f32_16x16x4f32(xa.y, wb1.y, a1, 0, 0, 0);
            a0 = __builtin_amdgcn_mfma_f32_16x16x4f32(xa.z, wb0.z, a0, 0, 0, 0); a1 = __builtin_amdgcn_mfma_f32_16x16x4f32(xa.z, wb1.z, a1, 0, 0, 0);
            a0 = __builtin_amdgcn_mfma_f32_16x16x4f32(xa.w, wb0.w, a0, 0, 0, 0); a1 = __builtin_amdgcn_mfma_f32_16x16x4f32(xa.w, wb1.w, a1, 0, 0, 0);
        }
#pragma unroll
        for (int r = 0; r < 4; ++r) { lg[(fq * 4 + r) * 32 + fr] = a0[r] + rb[fr]; lg[(fq * 4 + r) * 32 + 16 + fr] = a1[r] + rb[16 + fr]; }
        lds_wave_sync();
        int e4[4] = {0, 0, 0, 0}; int rk[4] = {0, 0, 0, 0};
        if (lane < 16) {
            const float* my = lg + lane * 32; unsigned taken = 0u; float tv[4];
#pragma unroll
            for (int k = 0; k < 4; ++k) {
                float best = NEG_INF; int bi = 0;
                for (int e = 0; e < 32; ++e) { const float xv = my[e]; if (!((taken >> e) & 1u) && xv > best) { best = xv; bi = e; } }
                taken |= 1u << bi; e4[k] = bi; tv[k] = best;
            }
            const float e1 = __expf(tv[1] - tv[0]), e2 = __expf(tv[2] - tv[0]), e3 = __expf(tv[3] - tv[0]);
            const float inv = 1.0f / (1.0f + e1 + e2 + e3);
            const size_t row = (size_t)(tok0 + lane);
            *(float4*)(p.gw + row * 4) = make_float4(inv, e1 * inv, e2 * inv, e3 * inv);
        }
        __syncthreads();
        if (lane < 16) {
#pragma unroll
            for (int k = 0; k < 4; ++k) rk[k] = atomicAdd(&lcnt[e4[k]], 1);
        }
        __syncthreads();
        if (tid < 32) { const int c = lcnt[tid]; lbase[tid] = c ? (int)__hip_atomic_fetch_add(gcount + tid, (unsigned)c, __ATOMIC_RELAXED, __HIP_MEMORY_SCOPE_AGENT) : 0; }
        __syncthreads();
        if (lane < 16) {
            const int row = tok0 + lane; int pk[4];
#pragma unroll
            for (int k = 0; k < 4; ++k) { const int pos = lbase[e4[k]] + rk[k]; p.lists[(size_t)e4[k] * LIST_CAP + pos] = row * 4 + k; pk[k] = (pos << 5) | e4[k]; }
            *(int4*)(p.top_e + (size_t)row * 4) = make_int4(pk[0], pk[1], pk[2], pk[3]);
        }
        __syncthreads();
    }
}

__device__ __forceinline__ void phase_ln2(const Params& p, int l, float* xout, char* lds) {
    int* ptile = (int*)(lds + LDS_TAB); int* ecnt = ptile + 40;
    build_tiles(p, l, ptile, ecnt);
    int tid = threadIdx.x; asm volatile("" : "+v"(tid));
    const int wid = tid >> 6, lane = tid & 63;
    const float* g2 = p.ln2_g + l * DM; const float* b2 = p.ln2_b + l * DM;
    for (int row = blockIdx.x * NWV + wid; row < NTOK; row += gridDim.x * NWV) {
        const float4 gwv = *(const float4*)(p.gw + (size_t)row * 4);
        const float gk[4] = {gwv.x, gwv.y, gwv.z, gwv.w};
        const int4 te = *(const int4*)(p.top_e + (size_t)row * 4);
        const int tk[4] = {te.x, te.y, te.z, te.w};
        const bf16_t* yr[4];
#pragma unroll
        for (int k = 0; k < 4; ++k) yr[k] = p.ybuf + (size_t)(ptile[tk[k] & 31] * 256 + (tk[k] >> 5)) * DM;
        float4 v[4]; float s = 0.f;
#pragma unroll
        for (int j = 0; j < 4; ++j) {
            const int c = j * 256 + lane * 4;
            const float4 xv = *(const float4*)(p.x1f + (size_t)row * DM + c);
            float4 a; a.x = xv.x * ALPHA; a.y = xv.y * ALPHA; a.z = xv.z * ALPHA; a.w = xv.w * ALPHA;
#pragma unroll
            for (int k = 0; k < 4; ++k) {
                const u32x2 w = *(const u32x2*)(yr[k] + c);
                a.x += gk[k] * __uint_as_float(w.x << 16); a.y += gk[k] * __uint_as_float(w.x & 0xffff0000u);
                a.z += gk[k] * __uint_as_float(w.y << 16); a.w += gk[k] * __uint_as_float(w.y & 0xffff0000u);
            }
            v[j] = a; s += (a.x + a.y) + (a.z + a.w);
        }
        const float mean = wave_sum(s) * (1.0f / 1024.0f);
        float qv = 0.f;
#pragma unroll
        for (int j = 0; j < 4; ++j) { v[j].x -= mean; v[j].y -= mean; v[j].z -= mean; v[j].w -= mean; qv += (v[j].x * v[j].x + v[j].y * v[j].y) + (v[j].z * v[j].z + v[j].w * v[j].w); }
        const float rstd = rsqrtf(wave_sum(qv) * (1.0f / 1024.0f) + LN_EPS);
#pragma unroll
        for (int j = 0; j < 4; ++j) {
            const int c = j * 256 + lane * 4;
            const float4 gg = *(const float4*)(g2 + c), bb = *(const float4*)(b2 + c);
            float4 y; y.x = v[j].x * rstd * gg.x + bb.x; y.y = v[j].y * rstd * gg.y + bb.y; y.z = v[j].z * rstd * gg.z + bb.z; y.w = v[j].w * rstd * gg.w + bb.w;
            *(float4*)(xout + (size_t)row * DM + c) = y;
            u32x2 w; w.x = pack2(y.x, y.y); w.y = pack2(y.z, y.w);
            *(u32x2*)(p.xb + (size_t)row * DM + c) = w;
        }
    }
}


#define XB_TMO      128
#define XB_XCNT(j)  (256  + 64 * (j))
#define XB_XSUB(j)  (1280 + 64 * (j))
#define XB_XGEN(j)  (2304 + 64 * (j))
#define XB_TOP      3328
#define XB_TOPGEN   3392
#define XCD_BAR_WORDS 3456
#define XB_SPIN_CAP (1u << 22)
__device__ __forceinline__ unsigned xb_ld(unsigned* p)              { return __hip_atomic_load(p, __ATOMIC_RELAXED, __HIP_MEMORY_SCOPE_AGENT); }
__device__ __forceinline__ unsigned xb_add(unsigned* p, unsigned v) { return __hip_atomic_fetch_add(p, v, __ATOMIC_RELAXED, __HIP_MEMORY_SCOPE_AGENT); }
__device__ __forceinline__ unsigned xb_xcc_id() { return (unsigned)__builtin_amdgcn_s_getreg((3 << 11) | 20) & 0xFu; }
#define XB_SPIN(cond, bar) do { unsigned _sp = 0; while (cond) { __builtin_amdgcn_s_sleep(1); \
    if ((++_sp & 255u) == 0u) { if (xb_ld(&(bar)[XB_TMO])) break; if (_sp > XB_SPIN_CAP) { atomicAdd(&(bar)[XB_TMO], 1u); break; } } } } while (0)
struct XcdBarrier { unsigned* bar; unsigned x; volatile LAS unsigned* st; };
__device__ __forceinline__ XcdBarrier xcd_barrier_post(unsigned* bar, volatile LAS unsigned* st) {
    XcdBarrier b; b.bar = bar; b.x = xb_xcc_id(); b.st = st;
    if (threadIdx.x == 0) (void)xb_add(&bar[XB_XCNT(b.x)], 1u);
    return b;
}
__device__ __forceinline__ void xcd_barrier_complete(unsigned* bar, unsigned x, unsigned& nloc, unsigned& nx) {
    const unsigned G = gridDim.x * gridDim.y * gridDim.z;
    unsigned sum, cnt, mine, sp = 0u;
    for (;;) {
        sum = 0u; cnt = 0u; mine = 0u;
#pragma unroll
        for (unsigned j = 0; j < 16; ++j) { const unsigned c = xb_ld(&bar[XB_XCNT(j)]); sum += c; cnt += (c > 0u) ? 1u : 0u; mine = (j == x) ? c : mine; }
        if (sum == G) break;
        __builtin_amdgcn_s_sleep(1);
        if ((++sp & 255u) == 0u) { if (xb_ld(&bar[XB_TMO])) break; if (sp > XB_SPIN_CAP) { atomicAdd(&bar[XB_TMO], 1u); break; } }
    }
    nloc = mine > 0u ? mine : 1u; nx = cnt > 0u ? cnt : 1u;
}
__device__ __forceinline__ void xcd_barrier(const XcdBarrier& b) {
    asm volatile("s_waitcnt vmcnt(0)" ::: "memory");
    __syncthreads();
    if (threadIdx.x == 0) {
        unsigned* bar = b.bar;
        __builtin_amdgcn_s_waitcnt(0);
        unsigned nloc = b.st[0], nx = b.st[1];
        if (nloc == 0u) { xcd_barrier_complete(bar, b.x, nloc, nx); b.st[0] = nloc; b.st[1] = nx; }
        const unsigned old = xb_add(&bar[XB_XSUB(b.x)], 1u);
        const unsigned gen = old / nloc;
        if (old + 1u == (gen + 1u) * nloc) {
            __builtin_amdgcn_fence(__ATOMIC_RELEASE, "agent");
            asm volatile("s_waitcnt vmcnt(0)" ::: "memory");
            const unsigned og = xb_add(&bar[XB_TOP], 1u);
            const unsigned tg = og / nx;
            if (og + 1u == (tg + 1u) * nx) xb_add(&bar[XB_TOPGEN], 1u);
            else XB_SPIN(xb_ld(&bar[XB_TOPGEN]) == tg, bar);
            __builtin_amdgcn_fence(__ATOMIC_ACQUIRE, "agent");
            xb_add(&bar[XB_XGEN(b.x)], 1u);
            asm volatile("s_waitcnt vmcnt(0)" ::: "memory");
        } else {
            XB_SPIN(xb_ld(&bar[XB_XGEN(b.x)]) == gen, bar);
            __builtin_amdgcn_fence(__ATOMIC_ACQUIRE, "agent");
            asm volatile("s_waitcnt vmcnt(0)" ::: "memory");
        }
    }
    __syncthreads();
}

struct KArgs { const float* in[18]; float* out; char* ws; };
constexpr size_t al256(size_t v) { return (v + 255) / 256 * 256; }
struct WSL {
    static constexpr size_t ctrl = 0;
    static constexpr size_t WinT = al256(ctrl + 65536);
    static constexpr size_t WoT = al256(WinT + (size_t)NL * NPAD * 1024 * 2);
    static constexpr size_t W1T = al256(WoT + (size_t)NL * 1024 * 1024 * 2);
    static constexpr size_t W2T = al256(W1T + (size_t)NL * 2 * 64 * 2048 * 2);
    static constexpr size_t WguT = al256(W2T + (size_t)NL * 2 * 64 * 64 * 2);
    static constexpr size_t WdnT = al256(WguT + (size_t)NL * NE * 2048 * 1024 * 2);
    static constexpr size_t rwT = al256(WdnT + (size_t)NL * NE * 1024 * 1024 * 2);
    static constexpr size_t binp = al256(rwT + (size_t)NL * NE * 1024 * 4);
    static constexpr size_t bgup = al256(binp + (size_t)NL * NPAD * 4);
    static constexpr size_t b1c = al256(bgup + (size_t)NL * NE * 2048 * 4);
    static constexpr size_t xf = al256(b1c + 4 * 64 * 4);
    static constexpr size_t xb = al256(xf + (size_t)NTOK * DM * 4);
    static constexpr size_t hb = al256(xb + (size_t)NTOK * DM * 2);
    static constexpr size_t hs = al256(hb + (size_t)NTOK * NMAIN * 2);
    static constexpr size_t vT = al256(hs + (size_t)NTOK * HS_W * 4);
    static constexpr size_t cF = al256(vT + (size_t)NB * NVH * 64 * SEQ * 2);
    static constexpr size_t kc = al256(cF + (size_t)NB * 4 * SEQ * 4);
    static constexpr size_t vc = al256(kc + (size_t)NB * 2 * 128 * 64 * 2);
    static constexpr size_t vcT = al256(vc + (size_t)NB * 2 * 128 * 64 * 2);
    static constexpr size_t ob = al256(vcT + (size_t)NB * 2 * 128 * 64 * 2);
    static constexpr size_t tbuf = al256(ob + (size_t)NTOK * DM * 2);
    static constexpr size_t x1f = al256(tbuf + (size_t)NTOK * DM * 4);
    static constexpr size_t x1b = al256(x1f + (size_t)NTOK * DM * 4);
    static constexpr size_t top_e = al256(x1b + (size_t)NTOK * DM * 2);
    static constexpr size_t gw = al256(top_e + (size_t)NTOK * 4 * 4);
    static constexpr size_t lists = al256(gw + (size_t)NTOK * 4 * 4);
    static constexpr size_t act = al256(lists + (size_t)NE * LIST_CAP * 4);
    static constexpr size_t ybuf = al256(act + (size_t)MAXSLOT * DFF * 2);
    static constexpr size_t total = al256(ybuf + (size_t)MAXSLOT * DM * 2);
};
__device__ __forceinline__ Params make_params(const KArgs& k) {
    Params p;
    p.x = k.in[0]; p.w_in = k.in[1]; p.b_in = k.in[2]; p.sinks = k.in[3]; p.cmp_pe = k.in[4]; p.cmp_w1 = k.in[5]; p.cmp_w2 = k.in[6]; p.w_out = k.in[7];
    p.ln1_g = k.in[8]; p.ln1_b = k.in[9]; p.router_w = k.in[10]; p.router_b = k.in[11]; p.w_gu = k.in[12]; p.b_gu = k.in[13]; p.w_dn = k.in[14]; p.b_dn = k.in[15];
    p.ln2_g = k.in[16]; p.ln2_b = k.in[17]; p.out = k.out;
    char* w = k.ws;
    p.ctrl = (unsigned*)(w + WSL::ctrl); p.WinT = (bf16_t*)(w + WSL::WinT); p.WoT = (bf16_t*)(w + WSL::WoT); p.W1T = (bf16_t*)(w + WSL::W1T); p.W2T = (bf16_t*)(w + WSL::W2T);
    p.WguT = (bf16_t*)(w + WSL::WguT); p.WdnT = (bf16_t*)(w + WSL::WdnT); p.rwT = (float*)(w + WSL::rwT); p.binp = (float*)(w + WSL::binp); p.bgup = (float*)(w + WSL::bgup);
    p.b1c = (float*)(w + WSL::b1c); p.xf = (float*)(w + WSL::xf); p.xb = (bf16_t*)(w + WSL::xb); p.hb = (bf16_t*)(w + WSL::hb); p.hs = (float*)(w + WSL::hs); p.vT = (bf16_t*)(w + WSL::vT);
    p.cF = (float*)(w + WSL::cF); p.kc = (bf16_t*)(w + WSL::kc); p.vc = (bf16_t*)(w + WSL::vc); p.vcT = (bf16_t*)(w + WSL::vcT); p.ob = (bf16_t*)(w + WSL::ob); p.tbuf = (float*)(w + WSL::tbuf);
    p.x1f = (float*)(w + WSL::x1f); p.x1b = (bf16_t*)(w + WSL::x1b); p.top_e = (int*)(w + WSL::top_e); p.gw = (float*)(w + WSL::gw); p.lists = (int*)(w + WSL::lists);
    p.act = (bf16_t*)(w + WSL::act); p.ybuf = (bf16_t*)(w + WSL::ybuf);
    return p;
}
__device__ __forceinline__ void grid_bar(const Params& p, char* lds) {
    XcdBarrier xb; xb.bar = p.ctrl + 1024; xb.x = xb_xcc_id(); xb.st = (volatile LAS unsigned*)(lds + LDS_BYTES - 16); xcd_barrier(xb);
}
template <int L>
__device__ __forceinline__ void layer_fwd(const Params& p, char* lds) {
    const float* xin = L == 0 ? p.x : p.xf;
    float* xout = L == NL - 1 ? p.out : p.xf;
#ifndef REP
#define REP 0
#endif
    phase_inproj(p, L, lds);        grid_bar(p, lds);
    if (REP & 1) { phase_inproj(p, L, lds);        grid_bar(p, lds); }
    phase_prep(p, L, lds);          grid_bar(p, lds);
    if (REP & 2) { phase_prep(p, L, lds);          grid_bar(p, lds); }
    phase_attn(p, L, lds);          grid_bar(p, lds);
    if (REP & 4) { phase_attn(p, L, lds, 24);      grid_bar(p, lds); }
    phase_outproj(p, L, xin, lds);  grid_bar(p, lds);
    if (REP & 8) { phase_outproj(p, L, xin, lds);  grid_bar(p, lds); }
    phase_ln1_router(p, L, lds);    grid_bar(p, lds);
    phase_gateup(p, L, lds);        grid_bar(p, lds);
    if (REP & 16) { phase_gateup(p, L, lds);       grid_bar(p, lds); }
    phase_down(p, L, lds);          grid_bar(p, lds);
    if (REP & 32) { phase_down(p, L, lds);         grid_bar(p, lds); }
    phase_ln2(p, L, xout, lds);
    if (REP & 64) { grid_bar(p, lds); phase_ln2(p, L, xout, lds); }
}
__global__ void __launch_bounds__(NTHR, 2) fwd_kernel(KArgs ka) {
    extern __shared__ __attribute__((aligned(16))) char lds[];
    const Params p = make_params(ka);
    cg::grid_group grid = cg::this_grid();
    volatile LAS unsigned* xst = (volatile LAS unsigned*)(lds + LDS_BYTES - 16);
    if (threadIdx.x == 0) { xst[0] = 0u; xst[1] = 0u; }
    __syncthreads();
    (void)xcd_barrier_post(p.ctrl + 1024, xst);
    phase0(p, lds);
    if (REP & 128) { grid_bar(p, lds); phase0(p, lds); }
    grid.sync();
    layer_fwd<0>(p, lds);
    grid_bar(p, lds);
    layer_fwd<1>(p, lds);
}

extern "C" void kernel_launch(void* const* d_in, const int* in_sizes, int n_in, void* d_out, int out_size, void* d_ws, size_t ws_size, hipStream_t stream) {
    KArgs ka{};
    for (int i = 0; i < 18; ++i) ka.in[i] = (const float*)d_in[i];
    ka.out = (float*)d_out; ka.ws = (char*)d_ws;
    if (WSL::total > ws_size) { fprintf(stderr, "workspace too small: need %zu have %zu\n", (size_t)WSL::total, ws_size); return; }
    static int grid_blocks = 0;
    if (!grid_blocks) {
        int dev = 0, cus = 0, per_cu = 0;
        (void)hipGetDevice(&dev);
        (void)hipDeviceGetAttribute(&cus, hipDeviceAttributeMultiprocessorCount, dev);
        (void)hipFuncSetAttribute((const void*)fwd_kernel, hipFuncAttributeMaxDynamicSharedMemorySize, LDS_BYTES);
        (void)hipOccupancyMaxActiveBlocksPerMultiprocessor(&per_cu, fwd_kernel, NTHR, LDS_BYTES);
        if (per_cu < 1) { fprintf(stderr, "occupancy query says 0 blocks per CU\n"); per_cu = 1; }
        grid_blocks = cus;
    }
    (void)hipMemsetAsync(d_ws, 0, 65536, stream);
    void* args[] = {&ka};
    hipError_t e = hipLaunchCooperativeKernel((const void*)fwd_kernel, dim3(grid_blocks), dim3(NTHR), args, LDS_BYTES, stream);
    if (e != hipSuccess) fprintf(stderr, "cooperative launch failed: %s (grid %d)\n", hipGetErrorString(e), grid_blocks);
}
```

```cpp
#include <hip/hip_runtime.h>
#include <hip/hip_cooperative_groups.h>
#include <cstdio>
#include <cstdint>
namespace cg = cooperative_groups;

typedef unsigned short bf16_t;
typedef short bf16x8 __attribute__((ext_vector_type(8)));
typedef float f32x4 __attribute__((ext_vector_type(4)));
typedef unsigned u32x4 __attribute__((ext_vector_type(4)));
typedef unsigned u32x2 __attribute__((ext_vector_type(2)));
#define LAS __attribute__((address_space(3)))
constexpr float NEG_INF = -__builtin_huge_valf();

constexpr int DM = 1024, NB = 16, SEQ = 2048, NTOK = NB * SEQ, NL = 2;
constexpr int NCOL = 2582, NMAIN = 2560, NPAD = 2688, NE = 32, DFF = 1024;
constexpr int C_FQ = 0, C_FK = 256, C_FV = 512, C_SQ = 768, C_SK = 1152, C_SV = 1280, C_NQ = 1408,
              C_NKC = 1792, C_NVC = 1920, C_NKS = 2048, C_NVS = 2176, C_NKW = 2304, C_NVW = 2432;
constexpr int HS_W = 32;
constexpr int NVH = 10;
constexpr int LIST_CAP = NTOK;
constexpr int MAXSLOT = NTOK * 4 + NE * 256;
constexpr float ALPHA = 1.41421356237f, LN_EPS = 1e-5f, QSCALE = 0.125f;
constexpr int NWV = 8, NTHR = NWV * 64;
constexpr int LDS_STAGE = 131072, LDS_TAB = LDS_STAGE, LDS_BYTES = LDS_STAGE + 2048;

struct Params {
    const float *x, *w_in, *b_in, *sinks, *cmp_pe, *cmp_w1, *cmp_w2, *w_out, *ln1_g, *ln1_b, *router_w, *router_b,
                *w_gu, *b_gu, *w_dn, *b_dn, *ln2_g, *ln2_b;
    float* out;
    unsigned* ctrl;
    bf16_t *WinT, *WoT, *W1T, *W2T, *WguT, *WdnT;
    float *rwT, *binp, *bgup, *b1c;
    float* xf; bf16_t* xb; bf16_t* hb; float* hs; bf16_t* vT; float* cF;
    bf16_t *kc, *vc, *vcT; bf16_t* ob; float* tbuf; float* x1f; bf16_t* x1b;
    int* top_e; float* gw; int* lists; bf16_t* act; bf16_t* ybuf;
};

__device__ __forceinline__ float bf2f(bf16_t h) { return __uint_as_float(((unsigned)h) << 16); }
typedef __bf16 bf16x2_t __attribute__((ext_vector_type(2)));
__device__ __forceinline__ bf16_t f2bf(float f) { return __builtin_bit_cast(bf16_t, (__bf16)f); }
__device__ __forceinline__ unsigned pack2(float lo, float hi) { bf16x2_t v = {(__bf16)lo, (__bf16)hi}; return __builtin_bit_cast(unsigned, v); }
__device__ __forceinline__ float wave_sum(float v) {
#pragma unroll
    for (int o = 32; o > 0; o >>= 1) v += __shfl_xor(v, o);
    return v;
}
__device__ __forceinline__ float wave_max(float v) {
#pragma unroll
    for (int o = 32; o > 0; o >>= 1) v = fmaxf(v, __shfl_xor(v, o));
    return v;
}
__device__ __forceinline__ void lds_wave_sync() { asm volatile("s_waitcnt lgkmcnt(0)" ::: "memory"); __builtin_amdgcn_wave_barrier(); }
__device__ __forceinline__ float slope_swa(int hq) { return exp2f(-8.0f * (float)(2 * hq + 1) / 12.0f); }
__device__ __forceinline__ float slope_nsa(int hq) { return exp2f(-8.0f * (float)(2 * hq + 2) / 12.0f); }

__device__ __forceinline__ int perm_row(int perm, int n) {
    if (perm == 1) { if (n < 768) return n; if (n < 772) return 2560 + (n - 768); if (n < 2564) return n - 4; return n; }
    if (perm == 2) { const int f = n >> 1, s = n & 1; return (f >> 7) * 256 + s * 128 + (f & 127); }
    return n;
}
struct ConvJob { const float* src; bf16_t* dst; int K, N, kt, nt, perm; };
__device__ __forceinline__ bool conv_job(const Params& p, int t, ConvJob& jb) {
    constexpr int T_GU = NL * NE * 8 * 16, T_DN = NL * NE * 8 * 8, T_WIN = NL * 8 * 21, T_WO = NL * 8 * 8;
    if (t < T_GU) { const int m = t / 128, r = t % 128; jb = ConvJob{p.w_gu + (size_t)m * 1024 * 2048, p.WguT + (size_t)m * 2048 * 1024, 1024, 2048, r / 16, r % 16, 2}; return true; }
    t -= T_GU;
    if (t < T_DN) { const int m = t / 64, r = t % 64; jb = ConvJob{p.w_dn + (size_t)m * 1024 * 1024, p.WdnT + (size_t)m * 1024 * 1024, 1024, 1024, r / 8, r % 8, 0}; return true; }
    t -= T_DN;
    if (t < T_WIN) { const int m = t / 168, r = t % 168; jb = ConvJob{p.w_in + (size_t)m * 1024 * NCOL, p.WinT + (size_t)m * NPAD * 1024, 1024, NCOL, r / 21, r % 21, 1}; return true; }
    t -= T_WIN;
    if (t < T_WO) { const int m = t / 64, r = t % 64; jb = ConvJob{p.w_out + (size_t)m * 1024 * 1024, p.WoT + (size_t)m * 1024 * 1024, 1024, 1024, r / 8, r % 8, 0}; return true; }
    return false;
}
__device__ __forceinline__ void conv_load(const ConvJob& jb, int tid, float2 (&v)[16]) {
    const int n = jb.nt * 128 + (tid & 31) * 4;
    const float* s = jb.src + (size_t)(jb.kt * 128 + (tid >> 5)) * jb.N + n;
#pragma unroll
    for (int i = 0; i < 8; ++i) {
        const float* r = s + (size_t)(16 * i) * jb.N;
        v[2 * i] = (n + 1 < jb.N) ? *(const float2*)r : make_float2(0.f, 0.f);
        v[2 * i + 1] = (n + 3 < jb.N) ? *(const float2*)(r + 2) : make_float2(0.f, 0.f);
    }
}
__device__ __forceinline__ void phase0(const Params& p, char* ldsc) {
    int tid = threadIdx.x; asm volatile("" : "+v"(tid));
    const int G = gridDim.x, bid = blockIdx.x;
    const size_t gtid = (size_t)bid * NTHR + tid, gthreads = (size_t)G * NTHR;
    {
        constexpr int TOT = NL * NE * 8 * 16 + NL * NE * 8 * 8 + NL * 8 * 21 + NL * 8 * 8;
        bf16_t* lt = (bf16_t*)ldsc;
        ConvJob jb, jn; float2 v[16], vn[16];
        int t = bid; bool have = t < TOT && conv_job(p, t, jb);
        if (have) conv_load(jb, tid, v);
        while (have) {
            const int tn = t + G; const bool hn = tn < TOT && conv_job(p, tn, jn);
            if (hn) conv_load(jn, tid, vn);
#pragma unroll
            for (int i = 0; i < 8; ++i) {
                u32x2 w; w.x = pack2(v[2 * i].x, v[2 * i].y); w.y = pack2(v[2 * i + 1].x, v[2 * i + 1].y);
                *(u32x2*)(lt + ((tid >> 5) + 16 * i) * 136 + (tid & 31) * 4) = w;
            }
            __syncthreads();
#pragma unroll
            for (int i = 0; i < 4; ++i) {
                const int idx = tid + NTHR * i, kc = idx & 15, nn = idx >> 4, n = jb.nt * 128 + nn;
                if (n < jb.N) {
                    const bf16_t* l = lt + (kc * 8) * 136 + nn;
                    u32x4 w;
                    w.x = (unsigned)l[0] | ((unsigned)l[136] << 16); w.y = (unsigned)l[272] | ((unsigned)l[408] << 16);
                    w.z = (unsigned)l[544] | ((unsigned)l[680] << 16); w.w = (unsigned)l[816] | ((unsigned)l[952] << 16);
                    *(u32x4*)(jb.dst + (size_t)perm_row(jb.perm, n) * jb.K + jb.kt * 128 + kc * 8) = w;
                }
            }
            __syncthreads();
            t = tn; have = hn; jb = jn;
#pragma unroll
            for (int i = 0; i < 16; ++i) v[i] = vn[i];
        }
    }
    for (size_t i = gtid; i < (size_t)NL * 2 * 2048 * 64; i += gthreads) {
        const int k = (int)(i % 2048), n = (int)((i / 2048) % 64), m = (int)(i / (2048 * 64));
        p.W1T[i] = f2bf(p.cmp_w1[((size_t)m * 2048 + k) * 64 + n]);
    }
    for (size_t i = gtid; i < (size_t)NL * 2 * 64 * 64; i += gthreads) {
        const int k = (int)(i % 64), n = (int)((i / 64) % 64), m = (int)(i / 4096);
        p.W2T[i] = f2bf(p.cmp_w2[((size_t)m * 64 + k) * 64 + n]);
    }
    for (size_t i = gtid; i < (size_t)NL * NPAD; i += gthreads) {
        const int l = (int)(i / NPAD), r = (int)(i % NPAD);
        float v = 0.f;
        if (r < 2560) { const int n = r < 768 ? r : r + 4; v = p.b_in[l * NCOL + n]; }
        else if (r < 2564) v = p.b_in[l * NCOL + 768 + (r - 2560)];
        else if (r < 2582) v = p.b_in[l * NCOL + r];
        p.binp[i] = v;
    }
    for (size_t i = gtid; i < (size_t)NL * NE * 2048; i += gthreads) {
        const int r = (int)(i % 2048); const size_t le = i / 2048;
        const int s = (r >> 7) & 1, f = (r >> 8) * 128 + (r & 127);
        p.bgup[i] = p.b_gu[le * 2048 + 2 * f + s];
    }
    for (size_t i = gtid; i < (size_t)NL * NE * 1024; i += gthreads) {
        const int k = (int)(i % 1024), e = (int)((i / 1024) % NE), l = (int)(i / (1024 * NE));
        p.rwT[i] = p.router_w[((size_t)l * 1024 + k) * NE + e];
    }
    for (size_t i = gtid; i < (size_t)NL * (NPAD - NCOL) * 1024; i += gthreads) {
        const int l = (int)(i / ((NPAD - NCOL) * 1024)); const size_t r = i % ((size_t)(NPAD - NCOL) * 1024);
        p.WinT[(size_t)l * NPAD * 1024 + (size_t)NCOL * 1024 + r] = 0;
    }
    for (size_t i = gtid; i < (size_t)NTOK * DM / 4; i += gthreads) {
        const float4 v4 = ((const float4*)p.x)[i];
        u32x2 w; w.x = pack2(v4.x, v4.y); w.y = pack2(v4.z, v4.w);
        ((u32x2*)p.xb)[i] = w;
    }
    if (bid < 4) {
        float* lf = (float*)ldsc;
        const int j = tid & 63, part = tid >> 6;
        const float* pe = p.cmp_pe + (size_t)bid * 2048; const float* w1 = p.cmp_w1 + (size_t)bid * 2048 * 64;
        float s = 0.f;
        for (int kk = part * 256; kk < part * 256 + 256; ++kk) s += pe[kk] * w1[(size_t)kk * 64 + j];
        lf[tid] = s; __syncthreads();
        if (tid < 64) { float a = 0.f; for (int q = 0; q < 8; ++q) a += lf[tid + 64 * q]; p.b1c[bid * 64 + tid] = a; }
        __syncthreads();
    }
}

namespace pg8 {
constexpr int BM = 256, BK = 64, HALF = 128, HTB = HALF * BK * 2, NXCD = 8, WGM = 8;
__device__ __forceinline__ int lds_byte(int r, int c) { const int st = (r >> 4) * 2 + (c >> 5), rr = r & 15, cc = c & 31, ob = rr * 64 + cc * 2; return st * 1024 + (ob ^ (((ob >> 9) & 1) << 5)); }
__device__ __forceinline__ void stage_rc(int b, int& R, int& C) { const int st = b / 1024, sb = b % 1024, swz = sb ^ (((sb >> 9) & 1) << 5); R = (st >> 1) * 16 + swz / 64; C = (st & 1) * 32 + (swz % 64) / 2; }
__device__ __forceinline__ bool tile_order(int i, int G, int c, int nM, int nN, int& pm, int& pn) {
    const int nwg = nM * nN; const long L = (long)i * G + c; if (L >= nwg) return false;
    int wgid = (int)L; { const int q = nwg / NXCD, r = nwg % NXCD, xcd = wgid % NXCD, off = wgid / NXCD; wgid = (xcd < r ? xcd * (q + 1) : r * (q + 1) + (xcd - r) * q) + off; }
    const int nig = WGM * nN, gid = wgid / nig, fm = gid * WGM, gsz = (nM - fm) < WGM ? (nM - fm) : WGM;
    pm = fm + ((wgid % nig) % gsz); pn = (wgid % nig) / gsz; return true;
}
template <class Sched, class Epi>
__device__ __forceinline__ void gemm_phase(LAS unsigned char* lds, const char* Abase, int K, const Sched& S, const Epi& E) {
    int tid = threadIdx.x; asm volatile("" : "+v"(tid));
    const int wid = __builtin_amdgcn_readfirstlane(tid >> 6), lane = tid & 63, wr = wid >> 2, wc = wid & 3, fr = lane & 15, fq = lane >> 4;
    const int nt = K / BK;
    int R0, C0, R1, C1; stage_rc(tid * 16, R0, C0); stage_rc(tid * 16 + 8192, R1, C1);
    unsigned voffB[2]; voffB[0] = (unsigned)(R0 * K + C0) * 2u; voffB[1] = (unsigned)(R1 * K + C1) * 2u;
    const size_t kstep = (size_t)(BK * 2), hstep = (size_t)HALF * K * 2;
    const unsigned ldsw = (unsigned)wid * 1024u;
    const int aoff = lds_byte(wr * 64 + fr, fq * 8), boff = lds_byte(wc * 32 + fr, fq * 8);
#define PG8_SA(b, h) (((b) * 2 + (h)) * HTB)
#define PG8_SB(b, h) ((4 + (b) * 2 + (h)) * HTB)
#define PG8_STAGE_B(bufoff, gbase) do { _Pragma("unroll") for (int _i = 0; _i < 2; ++_i) \
        __builtin_amdgcn_global_load_lds((const unsigned*)((const char*)(gbase) + voffB[_i]), (LAS unsigned*)(lds + (bufoff) + ldsw + _i * 8192), 16, 0, 0); } while (0)
#define PG8_STAGE_A(bufoff, kbyte, o0, o1) do { \
        __builtin_amdgcn_global_load_lds((const unsigned*)(Abase + (kbyte) + (o0)), (LAS unsigned*)(lds + (bufoff) + ldsw), 16, 0, 0); \
        __builtin_amdgcn_global_load_lds((const unsigned*)(Abase + (kbyte) + (o1)), (LAS unsigned*)(lds + (bufoff) + ldsw + 8192), 16, 0, 0); } while (0)
#define PG8_LDA(dst, b, h) do { _Pragma("unroll") for (int m = 0; m < 4; ++m) _Pragma("unroll") for (int k = 0; k < 2; ++k) dst[m][k] = *(const LAS bf16x8*)(lds + PG8_SA(b, h) + aoff + m * 2048 + k * 1024); } while (0)
#define PG8_LDB(dst, b, h) do { _Pragma("unroll") for (int n = 0; n < 2; ++n) _Pragma("unroll") for (int k = 0; k < 2; ++k) dst[n][k] = *(const LAS bf16x8*)(lds + PG8_SB(b, h) + boff + n * 2048 + k * 1024); } while (0)
#define PG8_MMA(ai, bj, At, Bt) do { __builtin_amdgcn_s_setprio(1); _Pragma("unroll") for (int m = 0; m < 4; ++m) _Pragma("unroll") for (int n = 0; n < 2; ++n) _Pragma("unroll") for (int k = 0; k < 2; ++k) \
        acc[ai][bj][m][n] = __builtin_amdgcn_mfma_f32_16x16x32_bf16(Bt[n][k], At[m][k], acc[ai][bj][m][n], 0, 0, 0); __builtin_amdgcn_s_setprio(0); } while (0)
#define PG8_WAIT_V(n) asm volatile("s_waitcnt vmcnt(" #n ")" ::: "memory")
#define PG8_WAIT_L(n) asm volatile("s_waitcnt lgkmcnt(" #n ")" ::: "memory")
#define PG8_BAR __builtin_amdgcn_s_barrier()
#define PG8_SCHED __builtin_amdgcn_sched_barrier(0)
    typename Sched::Unit cur, nxt; int ui = 0;
    if (!S.next(0, cur)) return;
    f32x4 acc[2][2][4][2];
#pragma unroll
    for (int a = 0; a < 2; ++a)
#pragma unroll
        for (int b = 0; b < 2; ++b)
#pragma unroll
            for (int m = 0; m < 4; ++m)
#pragma unroll
                for (int n = 0; n < 2; ++n) acc[a][b][m][n] = (f32x4){0.f, 0.f, 0.f, 0.f};
    bf16x8 At[4][2], B0[2][2], B1[2][2];
    unsigned aC[2][2], aN[2][2];
    S.a_off(cur, R0, C0, R1, C1, aC);
    const char* cB = S.b_ptr(cur);
    PG8_STAGE_B(PG8_SB(0, 0), cB); PG8_STAGE_B(PG8_SB(0, 1), cB + hstep); PG8_STAGE_A(PG8_SA(0, 0), 0, aC[0][0], aC[0][1]); PG8_STAGE_A(PG8_SA(0, 1), 0, aC[1][0], aC[1][1]);
    if (wr == 1) PG8_BAR;
    PG8_WAIT_V(2); PG8_BAR;
    PG8_STAGE_B(PG8_SB(1, 0), cB + kstep); PG8_STAGE_A(PG8_SA(1, 0), kstep, aC[0][0], aC[0][1]); PG8_STAGE_B(PG8_SB(1, 1), cB + hstep + kstep);
    PG8_WAIT_V(6); PG8_BAR;
    for (;;) {
        const bool has_next = S.next(ui + 1, nxt);
        const char* nB = cB;
        if (has_next) { S.a_off(nxt, R0, C0, R1, C1, aN); nB = S.b_ptr(nxt); }
        else { aN[0][0] = aC[0][0]; aN[0][1] = aC[0][1]; aN[1][0] = aC[1][0]; aN[1][1] = aC[1][1]; }
        for (int t = 0; t < nt; t += 2) {
            const bool last = (t == nt - 2);
            const size_t ka1 = (size_t)(t + 1) * kstep, ka2 = last ? 0 : (size_t)(t + 2) * kstep, ka3 = ka2 + kstep;
            const char* b2 = last ? nB : cB + (size_t)(t + 2) * kstep; const char* b3 = b2 + kstep;
            const unsigned o00 = last ? aN[0][0] : aC[0][0], o01 = last ? aN[0][1] : aC[0][1], o10 = last ? aN[1][0] : aC[1][0], o11 = last ? aN[1][1] : aC[1][1];
            PG8_LDB(B0, 0, 0); PG8_LDB(B1, 0, 1); PG8_SCHED; PG8_LDA(At, 0, 0); PG8_STAGE_A(PG8_SA(1, 1), ka1, aC[1][0], aC[1][1]);
            PG8_WAIT_V(8); PG8_WAIT_L(0); PG8_BAR; PG8_MMA(0, 0, At, B0); PG8_MMA(0, 1, At, B1); PG8_BAR; PG8_SCHED;
            PG8_LDA(At, 0, 1); PG8_STAGE_B(PG8_SB(0, 0), b2); PG8_STAGE_B(PG8_SB(0, 1), b2 + hstep); PG8_STAGE_A(PG8_SA(0, 0), ka2, o00, o01);
            PG8_WAIT_V(8); PG8_WAIT_L(0); PG8_BAR; PG8_MMA(1, 0, At, B0); PG8_MMA(1, 1, At, B1); PG8_BAR; PG8_SCHED;
            PG8_LDB(B0, 1, 0); PG8_LDB(B1, 1, 1); PG8_SCHED; PG8_LDA(At, 1, 0); PG8_STAGE_A(PG8_SA(0, 1), ka2, o10, o11);
            PG8_WAIT_V(8); PG8_WAIT_L(0); PG8_BAR; PG8_MMA(0, 0, At, B0); PG8_MMA(0, 1, At, B1); PG8_BAR; PG8_SCHED;
            PG8_LDA(At, 1, 1); PG8_STAGE_B(PG8_SB(1, 0), b3); PG8_STAGE_B(PG8_SB(1, 1), b3 + hstep); PG8_STAGE_A(PG8_SA(1, 0), ka3, o00, o01);
            PG8_WAIT_V(8); PG8_WAIT_L(0); PG8_BAR; PG8_MMA(1, 0, At, B0); PG8_MMA(1, 1, At, B1); PG8_BAR; PG8_SCHED;
        }
        if (wr == 0) PG8_BAR;
        E(acc, cur, wr, wc, fr, fq);
        if (!has_next) break;
#pragma unroll
        for (int a = 0; a < 2; ++a)
#pragma unroll
            for (int b = 0; b < 2; ++b)
#pragma unroll
                for (int m = 0; m < 4; ++m)
#pragma unroll
                    for (int n = 0; n < 2; ++n) acc[a][b][m][n] = (f32x4){0.f, 0.f, 0.f, 0.f};
        cur = nxt; cB = nB; ++ui;
        aC[0][0] = aN[0][0]; aC[0][1] = aN[0][1]; aC[1][0] = aN[1][0]; aC[1][1] = aN[1][1];
        if (wr == 1) PG8_BAR;
    }
    PG8_WAIT_V(0);
    PG8_BAR;
#undef PG8_SA
#undef PG8_SB
#undef PG8_STAGE_A
#undef PG8_STAGE_B
#undef PG8_LDA
#undef PG8_LDB
#undef PG8_MMA
#undef PG8_WAIT_V
#undef PG8_WAIT_L
#undef PG8_BAR
#undef PG8_SCHED
}
}

struct DenseUnit { int pm, pn; };
struct DenseSched {
    typedef DenseUnit Unit;
    const char* Bt; int K, nM, nN;
    __device__ __forceinline__ bool next(int i, Unit& u) const { return pg8::tile_order(i, gridDim.x, blockIdx.x, nM, nN, u.pm, u.pn); }
    __device__ __forceinline__ void a_off(const Unit& u, int R0, int C0, int R1, int C1, unsigned (&off)[2][2]) const {
#pragma unroll
        for (int h = 0; h < 2; ++h) { off[h][0] = (unsigned)((u.pm * 256 + h * 128 + R0) * K + C0) * 2u; off[h][1] = (unsigned)((u.pm * 256 + h * 128 + R1) * K + C1) * 2u; }
    }
    __device__ __forceinline__ const char* b_ptr(const Unit& u) const { return Bt + (size_t)u.pn * 256 * K * 2; }
};
struct MoeUnit { int rbt, e, rb, cnt, pn; };
template <bool GATHER>
struct MoeSched {
    typedef MoeUnit Unit;
    const char* Bt; const int* lists; const int* ptile; const int* ecnt; int nN, nrows;
    __device__ __forceinline__ bool next(int i, Unit& u) const {
        int pm, pn; if (!pg8::tile_order(i, gridDim.x, blockIdx.x, ptile[NE], nN, pm, pn)) return false;
        int e = 0; while (ptile[e + 1] <= pm) ++e;
        u.rbt = pm; u.e = e; u.rb = pm - ptile[e]; u.cnt = ecnt[e]; u.pn = pn; return true;
    }
    __device__ __forceinline__ void a_off(const Unit& u, int R0, int C0, int R1, int C1, unsigned (&off)[2][2]) const {
        if (GATHER) {
            const int* lst = lists + (size_t)u.e * LIST_CAP;
#pragma unroll
            for (int h = 0; h < 2; ++h) {
                const int l0 = u.rb * 256 + h * 128 + R0, l1 = u.rb * 256 + h * 128 + R1;
                const int t0 = l0 < u.cnt ? (lst[l0] >> 2) : 0, t1 = l1 < u.cnt ? (lst[l1] >> 2) : 0;
                off[h][0] = (unsigned)(t0 * 1024 + C0) * 2u; off[h][1] = (unsigned)(t1 * 1024 + C1) * 2u;
            }
        } else {
#pragma unroll
            for (int h = 0; h < 2; ++h) { off[h][0] = (unsigned)((u.rbt * 256 + h * 128 + R0) * 1024 + C0) * 2u; off[h][1] = (unsigned)((u.rbt * 256 + h * 128 + R1) * 1024 + C1) * 2u; }
        }
    }
    __device__ __forceinline__ const char* b_ptr(const Unit& u) const { return Bt + ((size_t)u.e * nrows + (size_t)u.pn * 256) * 1024 * 2; }
};

struct EpiInProj {
    const Params* p; int l;
    __device__ __forceinline__ void operator()(const f32x4 (&acc)[2][2][4][2], const DenseUnit& u, int wr, int wc, int fr, int fq) const {
        const float* bias = p->binp + l * NPAD + u.pn * 256;
#pragma unroll
        for (int bj = 0; bj < 2; ++bj) {
            int vh = -1;
            if (u.pn == 2) vh = bj * 2; else if (u.pn == 5 && bj == 0) vh = 4; else if (u.pn == 8 && bj == 1) vh = 6; else if (u.pn == 9 && bj == 1) vh = 8;
#pragma unroll
            for (int n = 0; n < 2; ++n) {
                const int c = bj * 128 + wc * 32 + n * 16 + 4 * fq;
                const f32x4 bv = *(const f32x4*)(bias + c);
#pragma unroll
                for (int ai = 0; ai < 2; ++ai)
#pragma unroll
                    for (int m = 0; m < 4; ++m) {
                        const int row = u.pm * 256 + ai * 128 + wr * 64 + m * 16 + fr;
                        const f32x4 v = acc[ai][bj][m][n] + bv;
                        u32x2 w; w.x = pack2(v[0], v[1]); w.y = pack2(v[2], v[3]);
                        *(u32x2*)(p->hb + (size_t)row * NMAIN + u.pn * 256 + c) = w;
                        if (vh >= 0) {
                            const int b = row >> 11, s = row & 2047, hh = vh + ((c & 127) >> 6), d = c & 63;
                            bf16_t* vt = p->vT + (((size_t)b * NVH + hh) * 64 + d) * SEQ + s;
                            vt[0] = (bf16_t)(w.x & 0xffff); vt[SEQ] = (bf16_t)(w.x >> 16); vt[2 * SEQ] = (bf16_t)(w.y & 0xffff); vt[3 * SEQ] = (bf16_t)(w.y >> 16);
                        }
                    }
            }
        }
    }
};
struct EpiOutProj {
    const float* xin; float* t;
    __device__ __forceinline__ void operator()(const f32x4 (&acc)[2][2][4][2], const DenseUnit& u, int wr, int wc, int fr, int fq) const {
#pragma unroll
        for (int ai = 0; ai < 2; ++ai)
#pragma unroll
            for (int m = 0; m < 4; ++m) {
                const size_t rowoff = (size_t)(u.pm * 256 + ai * 128 + wr * 64 + m * 16 + fr) * DM + u.pn * 256 + wc * 32 + 4 * fq;
#pragma unroll
                for (int bj = 0; bj < 2; ++bj)
#pragma unroll
                    for (int n = 0; n < 2; ++n) {
                        const size_t off = rowoff + bj * 128 + n * 16;
                        const f32x4 xv = *(const f32x4*)(xin + off);
                        *(f32x4*)(t + off) = xv * ALPHA + acc[ai][bj][m][n];
                    }
            }
    }
};
struct EpiGateUp {
    bf16_t* act; const float* bgup;
    __device__ __forceinline__ void operator()(const f32x4 (&acc)[2][2][4][2], const MoeUnit& u, int wr, int wc, int fr, int fq) const {
        const float* bias = bgup + (size_t)u.e * 2048 + u.pn * 256;
#pragma unroll
        for (int n = 0; n < 2; ++n) {
            const int c = wc * 32 + n * 16 + 4 * fq;
            const f32x4 bg = *(const f32x4*)(bias + c), bu = *(const f32x4*)(bias + 128 + c);
#pragma unroll
            for (int ai = 0; ai < 2; ++ai)
#pragma unroll
                for (int m = 0; m < 4; ++m) {
                    const f32x4 g4 = acc[ai][0][m][n] + bg, u4 = acc[ai][1][m][n] + bu;
                    float o[4];
#pragma unroll
                    for (int j = 0; j < 4; ++j) {
                        const float g = fminf(g4[j], 7.0f), uu = fminf(fmaxf(u4[j], -7.0f), 7.0f);
                        const float glu = g * __builtin_amdgcn_rcpf(1.0f + __builtin_amdgcn_exp2f(-2.455466929f * g));
                        o[j] = (uu + 1.0f) * glu;
                    }
                    u32x2 w; w.x = pack2(o[0], o[1]); w.y = pack2(o[2], o[3]);
                    *(u32x2*)(act + (size_t)(u.rbt * 256 + ai * 128 + wr * 64 + m * 16 + fr) * DFF + u.pn * 128 + c) = w;
                }
        }
    }
};
struct EpiDown {
    bf16_t* ybuf; const float* bdn;
    __device__ __forceinline__ void operator()(const f32x4 (&acc)[2][2][4][2], const MoeUnit& u, int wr, int wc, int fr, int fq) const {
        const float* bias = bdn + (size_t)u.e * 1024 + u.pn * 256;
#pragma unroll
        for (int bj = 0; bj < 2; ++bj)
#pragma unroll
            for (int n = 0; n < 2; ++n) {
                const int c = bj * 128 + wc * 32 + n * 16 + 4 * fq;
                const f32x4 bv = *(const f32x4*)(bias + c);
#pragma unroll
                for (int ai = 0; ai < 2; ++ai)
#pragma unroll
                    for (int m = 0; m < 4; ++m) {
                        const f32x4 v = acc[ai][bj][m][n] + bv;
                        u32x2 w; w.x = pack2(v[0], v[1]); w.y = pack2(v[2], v[3]);
                        *(u32x2*)(ybuf + (size_t)(u.rbt * 256 + ai * 128 + wr * 64 + m * 16 + fr) * DM + u.pn * 256 + c) = w;
                    }
            }
    }
};

__device__ __forceinline__ void phase_inproj(const Params& p, int l, char* lds) {
    DenseSched S{(const char*)(p.WinT + (size_t)l * NPAD * 1024), 1024, NTOK / 256, NMAIN / 256};
    EpiInProj E{&p, l};
    pg8::gemm_phase((LAS unsigned char*)lds, (const char*)p.xb, 1024, S, E);
    int tid = threadIdx.x; asm volatile("" : "+v"(tid));
    const int wid = tid >> 6, lane = tid & 63, fr = lane & 15, fq = lane >> 4;
    const bf16_t* W = p.WinT + ((size_t)l * NPAD + NMAIN) * 1024;
    const float* bias = p.binp + l * NPAD + NMAIN;
    for (int u = blockIdx.x * NWV + wid; u < NTOK / 16; u += gridDim.x * NWV) {
        const bf16_t* ar = p.xb + (size_t)(u * 16 + fr) * DM + fq * 8;
        const bf16_t* w0 = W + (size_t)fr * 1024 + fq * 8; const bf16_t* w1 = W + (size_t)(16 + fr) * 1024 + fq * 8;
        f32x4 a0 = (f32x4){0.f, 0.f, 0.f, 0.f}, a1 = a0;
#pragma unroll 4
        for (int ks = 0; ks < 32; ++ks) {
            const bf16x8 a = *(const bf16x8*)(ar + ks * 32);
            a0 = __builtin_amdgcn_mfma_f32_16x16x32_bf16(a, *(const bf16x8*)(w0 + ks * 32), a0, 0, 0, 0);
            a1 = __builtin_amdgcn_mfma_f32_16x16x32_bf16(a, *(const bf16x8*)(w1 + ks * 32), a1, 0, 0, 0);
        }
#pragma unroll
        for (int r = 0; r < 4; ++r) {
            float* dst = p.hs + (size_t)(u * 16 + fq * 4 + r) * HS_W;
            dst[fr] = a0[r] + bias[fr];
            if (fr < 6) dst[16 + fr] = a1[r] + bias[16 + fr];
        }
    }
}
__device__ __forceinline__ void phase_outproj(const Params& p, int l, const float* xin, char* lds) {
    DenseSched S{(const char*)(p.WoT + (size_t)l * 1024 * 1024), 1024, NTOK / 256, 4};
    EpiOutProj E{xin, p.tbuf};
    pg8::gemm_phase((LAS unsigned char*)lds, (const char*)p.ob, 1024, S, E);
}
__device__ __forceinline__ void build_tiles(const Params& p, int l, int* ptile, int* ecnt) {
    if (threadIdx.x < NE) ecnt[threadIdx.x] = (int)__hip_atomic_load(p.ctrl + 64 + l * NE + threadIdx.x, __ATOMIC_RELAXED, __HIP_MEMORY_SCOPE_AGENT);
    __syncthreads();
    if (threadIdx.x == 0) { int s = 0; for (int e = 0; e < NE; ++e) { ptile[e] = s; s += (ecnt[e] + 255) >> 8; } ptile[NE] = s; }
    __syncthreads();
}
__device__ __forceinline__ void phase_gateup(const Params& p, int l, char* lds) {
    int* ptile = (int*)(lds + LDS_TAB); int* ecnt = ptile + 40;
    build_tiles(p, l, ptile, ecnt);
    MoeSched<true> S{(const char*)(p.WguT + (size_t)l * NE * 2048 * 1024), p.lists, ptile, ecnt, 8, 2048};
    EpiGateUp E{p.act, p.bgup + (size_t)l * NE * 2048};
    pg8::gemm_phase((LAS unsigned char*)lds, (const char*)p.x1b, 1024, S, E);
}
__device__ __forceinline__ void phase_down(const Params& p, int l, char* lds) {
    int* ptile = (int*)(lds + LDS_TAB); int* ecnt = ptile + 40;
    build_tiles(p, l, ptile, ecnt);
    MoeSched<false> S{(const char*)(p.WdnT + (size_t)l * NE * 1024 * 1024), p.lists, ptile, ecnt, 4, 1024};
    EpiDown E{p.ybuf, p.b_dn + (size_t)l * NE * 1024};
    pg8::gemm_phase((LAS unsigned char*)lds, (const char*)p.act, 1024, S, E);
}

__device__ __forceinline__ float gelu_tanh(float x) {
    const float u = 0.7978845608028654f * (x + 0.044715f * x * x * x);
    const float e = __expf(-2.0f * fabsf(u)); const float th = (1.0f - e) / (1.0f + e);
    return 0.5f * x * (1.0f + (u < 0.f ? -th : th));
}
__device__ __forceinline__ void phase_prep(const Params& p, int l, char* lds) {
    int tid = threadIdx.x; asm volatile("" : "+v"(tid));
    const int wid = tid >> 6, lane = tid & 63, fr = lane & 15, fq = lane >> 4;
    const int gw = blockIdx.x * NWV + wid, nw = gridDim.x * NWV;
    for (int u = (int)gridDim.x - 1 - (int)blockIdx.x; u < NB * 4; u += gridDim.x) {
        const int b = u >> 2, h = u & 3;
        const float* srcp = p.hs + ((size_t)b * SEQ + tid * 4) * HS_W + h;
        float ls[4]; float tot = 0.f;
#pragma unroll
        for (int i = 0; i < 4; ++i) { const float f = srcp[(size_t)i * HS_W]; ls[i] = fminf(f, 0.f) - log1pf(__expf(-fabsf(f))); tot += ls[i]; }
        float inc = tot;
#pragma unroll
        for (int o = 1; o < 64; o <<= 1) { const float v = __shfl_up(inc, o); if (lane >= o) inc += v; }
        float* wtot = (float*)(lds + 65536);
        if (lane == 63) wtot[wid] = inc;
        __syncthreads();
        float base = inc - tot;
        for (int w = 0; w < wid; ++w) base += wtot[w];
        float4 o4; o4.x = base + ls[0]; o4.y = o4.x + ls[1]; o4.z = o4.y + ls[2]; o4.w = o4.z + ls[3];
        *(float4*)(p.cF + (size_t)u * SEQ + tid * 4) = o4;
        __syncthreads();
    }
    float* part = (float*)lds;
    bf16_t* h1 = (bf16_t*)(lds + 32768);
    for (int u = blockIdx.x; u < NB * 2 * 2 * 8; u += gridDim.x) {
        const int ct = u & 7, which = (u >> 3) & 1, kvh = (u >> 4) & 1, b = u >> 5;
        const int colo = (which ? C_NVC : C_NKC) + kvh * 64;
        const int c_lane = ct * 16 + fr;
        const int tokbase = min(c_lane, 126) * 16;
        const bf16_t* arow = p.hb + ((size_t)b * SEQ + tokbase) * NMAIN + colo + fq * 8;
        const bf16_t* w1 = p.W1T + ((size_t)(l * 2 + which) * 64 + fr) * 2048 + fq * 8;
        f32x4 acc[4];
#pragma unroll
        for (int n = 0; n < 4; ++n) acc[n] = (f32x4){0.f, 0.f, 0.f, 0.f};
#pragma unroll
        for (int kk = 0; kk < 8; ++kk) {
            const int ks = wid * 8 + kk;
            const bf16x8 a = *(const bf16x8*)(arow + (size_t)(ks >> 1) * NMAIN + (ks & 1) * 32);
#pragma unroll
            for (int n = 0; n < 4; ++n) {
                const bf16x8 bb = *(const bf16x8*)(w1 + (size_t)n * 16 * 2048 + ks * 32);
                acc[n] = __builtin_amdgcn_mfma_f32_16x16x32_bf16(a, bb, acc[n], 0, 0, 0);
            }
        }
#pragma unroll
        for (int n = 0; n < 4; ++n)
#pragma unroll
            for (int r = 0; r < 4; ++r) part[wid * 1024 + (fq * 4 + r) * 64 + n * 16 + fr] = acc[n][r];
        __syncthreads();
        const float* b1 = p.b1c + (l * 2 + which) * 64;
#pragma unroll
        for (int i = 0; i < 2; ++i) {
            const int e = tid + NTHR * i; float sum = 0.f;
#pragma unroll
            for (int w = 0; w < 8; ++w) sum += part[w * 1024 + e];
            h1[e] = f2bf(gelu_tanh(sum + b1[e & 63]));
        }
        __syncthreads();
        if (wid == 0) {
            const bf16_t* w2 = p.W2T + ((size_t)(l * 2 + which) * 64 + fr) * 64 + fq * 8;
            f32x4 o2[4];
#pragma unroll
            for (int n = 0; n < 4; ++n) o2[n] = (f32x4){0.f, 0.f, 0.f, 0.f};
#pragma unroll
            for (int ks = 0; ks < 2; ++ks) {
                const bf16x8 a = *(const bf16x8*)(h1 + fr * 64 + ks * 32 + fq * 8);
#pragma unroll
                for (int n = 0; n < 4; ++n) {
                    const bf16x8 bb = *(const bf16x8*)(w2 + (size_t)n * 16 * 64 + ks * 32);
                    o2[n] = __builtin_amdgcn_mfma_f32_16x16x32_bf16(a, bb, o2[n], 0, 0, 0);
                }
            }
            const size_t base = ((size_t)b * 2 + kvh) * 128 * 64;
#pragma unroll
            for (int n = 0; n < 4; ++n)
#pragma unroll
                for (int r = 0; r < 4; ++r) {
                    const int c = ct * 16 + fq * 4 + r, j2 = n * 16 + fr;
                    const bf16_t v = c < 127 ? f2bf(o2[n][r]) : (bf16_t)0;
                    if (which == 0) p.kc[base + (size_t)c * 64 + j2] = v;
                    else { p.vc[base + (size_t)c * 64 + j2] = v; p.vcT[base + (size_t)j2 * 128 + c] = v; }
                }
        }
        __syncthreads();
    }
}

constexpr float L2E = 1.4426950408889634f, MASKV = -1e30f, SCL2 = QSCALE * L2E;
struct KVFrag { bf16x8 k[2][2]; bf16x8 v[4]; };
__device__ __forceinline__ void k_load(KVFrag& f, const bf16_t* __restrict__ Kb, size_t ldk, int kc0, int fr, int fq) {
    const bf16_t* kp = Kb + (size_t)(kc0 + (fr >> 2) * 8 + (fr & 3)) * ldk + fq * 8;
    f.k[0][0] = *(const bf16x8*)(kp); f.k[0][1] = *(const bf16x8*)(kp + 32);
    f.k[1][0] = *(const bf16x8*)(kp + 4 * ldk); f.k[1][1] = *(const bf16x8*)(kp + 4 * ldk + 32);
}
__device__ __forceinline__ void v_load(bf16x8 (&v)[4], const bf16_t* __restrict__ VTb, size_t ldv, int kc0, int fr, int fq) {
    const bf16_t* vp = VTb + (size_t)fr * ldv + kc0 + fq * 8;
#pragma unroll
    for (int dt = 0; dt < 4; ++dt) v[dt] = *(const bf16x8*)(vp + (size_t)dt * 16 * ldv);
}
template <int NQT, bool MASK, class MB>
__device__ __forceinline__ void attn_compute(const KVFrag& f, const bf16x8 (&qf)[NQT][2], f32x4 (&o)[NQT][4], float (&m)[NQT], float (&l)[NQT], const MB& mb) {
#pragma unroll
    for (int qt = 0; qt < NQT; ++qt) {
        f32x4 s0 = (f32x4){0.f, 0.f, 0.f, 0.f}, s1 = s0;
        s0 = __builtin_amdgcn_mfma_f32_16x16x32_bf16(f.k[0][0], qf[qt][0], s0, 0, 0, 0);
        s0 = __builtin_amdgcn_mfma_f32_16x16x32_bf16(f.k[0][1], qf[qt][1], s0, 0, 0, 0);
        s1 = __builtin_amdgcn_mfma_f32_16x16x32_bf16(f.k[1][0], qf[qt][0], s1, 0, 0, 0);
        s1 = __builtin_amdgcn_mfma_f32_16x16x32_bf16(f.k[1][1], qf[qt][1], s1, 0, 0, 0);
        float v[8];
#pragma unroll
        for (int j = 0; j < 4; ++j) { v[j] = mb(qt, j, s0[j]); v[j + 4] = mb(qt, j + 4, s1[j]); }
        float mx = fmaxf(fmaxf(fmaxf(v[0], v[1]), fmaxf(v[2], v[3])), fmaxf(fmaxf(v[4], v[5]), fmaxf(v[6], v[7])));
        mx = fmaxf(mx, __shfl_xor(mx, 16)); mx = fmaxf(mx, __shfl_xor(mx, 32));
        const float mold = m[qt], mnew = fmaxf(mold, mx);
        m[qt] = mnew;
        float pr[8]; float ps = 0.f;
#pragma unroll
        for (int j = 0; j < 8; ++j) { pr[j] = (!MASK || v[j] > -1e29f) ? __builtin_amdgcn_exp2f(v[j] - mnew) : 0.f; ps += pr[j]; }
        if (__ballot(mnew != mold) != 0ull) {
            const float alpha = __builtin_amdgcn_exp2f(mold - mnew);
            l[qt] *= alpha;
#pragma unroll
            for (int dt = 0; dt < 4; ++dt) o[qt][dt] *= alpha;
        }
        l[qt] += ps;
        union { bf16x8 v8; unsigned u[4]; } pf;
        pf.u[0] = pack2(pr[0], pr[1]); pf.u[1] = pack2(pr[2], pr[3]); pf.u[2] = pack2(pr[4], pr[5]); pf.u[3] = pack2(pr[6], pr[7]);
#pragma unroll
        for (int dt = 0; dt < 4; ++dt) o[qt][dt] = __builtin_amdgcn_mfma_f32_16x16x32_bf16(f.v[dt], pf.v8, o[qt][dt], 0, 0, 0);
        __builtin_amdgcn_sched_barrier(0);
    }
}
struct RangeIt { int c, c_hi; __device__ __forceinline__ int nxt() { if (c > c_hi) return -1; return (c++) * 32; } };
struct MaskIt { unsigned long long cm; __device__ __forceinline__ int nxt() { if (!cm) return -1; const int i = __builtin_ctzll(cm); cm &= cm - 1; return i * 32; } };
template <bool PFV, class It, class Gen>
__device__ __forceinline__ void attn_run(It& it, const bf16_t* Kb, size_t ldk, const bf16_t* VTb, size_t ldv, int fr, int fq, const Gen& gen) {
    KVFrag fa, fb;
    int ka = it.nxt(); if (ka < 0) return;
    k_load(fa, Kb, ldk, ka, fr, fq); if (PFV) v_load(fa.v, VTb, ldv, ka, fr, fq);
    for (;;) {
        const int kb = it.nxt(); if (kb >= 0) { k_load(fb, Kb, ldk, kb, fr, fq); if (PFV) v_load(fb.v, VTb, ldv, kb, fr, fq); }
        if (!PFV) v_load(fa.v, VTb, ldv, ka, fr, fq);
        gen(ka, fa);
        if (kb < 0) break;
        ka = it.nxt(); if (ka >= 0) { k_load(fa, Kb, ldk, ka, fr, fq); if (PFV) v_load(fa.v, VTb, ldv, ka, fr, fq); }
        if (!PFV) v_load(fb.v, VTb, ldv, kb, fr, fq);
        gen(kb, fb);
        if (ka < 0) break;
    }
}
template <int NQT>
__device__ __forceinline__ void attn_init(f32x4 (&o)[NQT][4], float (&m)[NQT], float (&l)[NQT]) {
#pragma unroll
    for (int qt = 0; qt < NQT; ++qt) { m[qt] = MASKV; l[qt] = 0.f;
#pragma unroll
        for (int dt = 0; dt < 4; ++dt) o[qt][dt] = (f32x4){0.f, 0.f, 0.f, 0.f}; }
}
__device__ __forceinline__ float lsum4(float l) { l += __shfl_xor(l, 16); l += __shfl_xor(l, 32); return l; }
__device__ __forceinline__ void store_o4(bf16_t* dst, const f32x4 v) { u32x2 w; w.x = pack2(v[0], v[1]); w.y = pack2(v[2], v[3]); *(u32x2*)dst = w; }
__device__ __forceinline__ float sigmoidf_fast(float x) { return __builtin_amdgcn_rcpf(1.0f + __builtin_amdgcn_exp2f(-L2E * x)); }

__device__ __forceinline__ void fox_unit(const Params& p, int b, int h, int qb, int fr, int fq) {
    asm volatile("" : "+v"(fr), "+v"(fq));
    const int t0 = qb * 32;
    const bf16_t* Qb = p.hb + ((size_t)b * SEQ + t0) * NMAIN + C_FQ + h * 64 + fq * 8;
    bf16x8 qf[2][2];
#pragma unroll
    for (int qt = 0; qt < 2; ++qt) { qf[qt][0] = *(const bf16x8*)(Qb + (size_t)(qt * 16 + fr) * NMAIN); qf[qt][1] = *(const bf16x8*)(Qb + (size_t)(qt * 16 + fr) * NMAIN + 32); }
    const float* cf = p.cF + ((size_t)b * 4 + h) * SEQ;
    float cq[2];
#pragma unroll
    for (int qt = 0; qt < 2; ++qt) cq[qt] = cf[t0 + qt * 16 + fr] * L2E;
    f32x4 o[2][4]; float m[2], l[2];
    attn_init<2>(o, m, l);
    const bf16_t* Kb = p.hb + (size_t)b * SEQ * NMAIN + C_FK + h * 64;
    const bf16_t* VTb = p.vT + ((size_t)b * NVH + h) * 64 * SEQ;
    RangeIt it{0, t0 >> 5};
    attn_run<true>(it, Kb, NMAIN, VTb, SEQ, fr, fq, [&](int kc0, const KVFrag& f) {
        const float4 ca = *(const float4*)(cf + kc0 + 8 * fq), cb = *(const float4*)(cf + kc0 + 8 * fq + 4);
        const float ck[8] = {ca.x * L2E, ca.y * L2E, ca.z * L2E, ca.w * L2E, cb.x * L2E, cb.y * L2E, cb.z * L2E, cb.w * L2E};
        const int kq = kc0 + 8 * fq - t0 - fr;
        attn_compute<2, true>(f, qf, o, m, l, [&](int qt, int j, float raw) { return (kq + j - 16 * qt) > 0 ? MASKV : raw * SCL2 + cq[qt] - ck[j]; });
    });
#pragma unroll
    for (int qt = 0; qt < 2; ++qt) {
        const float inv = __builtin_amdgcn_rcpf(lsum4(l[qt]));
        bf16_t* dst = p.ob + ((size_t)b * SEQ + t0 + qt * 16 + fr) * DM + h * 64 + 4 * fq;
#pragma unroll
        for (int dt = 0; dt < 4; ++dt) store_o4(dst + dt * 16, o[qt][dt] * inv);
    }
}
__device__ __forceinline__ void swa_unit(const Params& p, int l_, int b, int kv, int pos, int fr, int fq) {
    asm volatile("" : "+v"(fr), "+v"(fq));
    const int t0 = pos * 16, t = t0 + fr;
    const bf16_t* Qb = p.hb + ((size_t)b * SEQ + t) * NMAIN + C_SQ + kv * 192 + fq * 8;
    bf16x8 qf[3][2];
#pragma unroll
    for (int g = 0; g < 3; ++g) { qf[g][0] = *(const bf16x8*)(Qb + g * 64); qf[g][1] = *(const bf16x8*)(Qb + g * 64 + 32); }
    float sl[3];
#pragma unroll
    for (int g = 0; g < 3; ++g) sl[g] = slope_swa(kv * 3 + g) * L2E;
    f32x4 o[3][4]; float m[3], l[3];
    attn_init<3>(o, m, l);
    const bf16_t* Kb = p.hb + (size_t)b * SEQ * NMAIN + C_SK + kv * 64;
    const bf16_t* VTb = p.vT + ((size_t)b * NVH + 4 + kv) * 64 * SEQ;
    RangeIt it{max(0, t0 - 127) >> 5, (t0 + 15) >> 5};
    attn_run<true>(it, Kb, NMAIN, VTb, SEQ, fr, fq, [&](int kc0, const KVFrag& f) {
        const int dq = t - kc0 - 8 * fq;
        attn_compute<3, true>(f, qf, o, m, l, [&](int g, int j, float raw) { const int dist = dq - j; return (dist >= 0 && dist < 128) ? raw * SCL2 - sl[g] * (float)dist : MASKV; });
    });
#pragma unroll
    for (int g = 0; g < 3; ++g) {
        const float sink = p.sinks[l_ * 6 + kv * 3 + g] * L2E;
        const float inv = __builtin_amdgcn_rcpf(lsum4(l[g]) + __builtin_amdgcn_exp2f(sink - m[g]));
        bf16_t* dst = p.ob + ((size_t)b * SEQ + t) * DM + 256 + (kv * 3 + g) * 64 + 4 * fq;
#pragma unroll
        for (int dt = 0; dt < 4; ++dt) store_o4(dst + dt * 16, o[g][dt] * inv);
    }
}
__device__ __forceinline__ void nsa_unit(const Params& p, int b, int kv, int pos, int fr, int fq, int lane, float* ps, unsigned* msk, float* otl) {
    asm volatile("" : "+v"(fr), "+v"(fq), "+v"(lane));
    const int t0 = pos * 16, t = t0 + fr, cur = t0 >> 6;
    const bf16_t* Qb = p.hb + ((size_t)b * SEQ + t) * NMAIN + C_NQ + kv * 192 + fq * 8;
    bf16x8 qf[3][2];
#pragma unroll
    for (int g = 0; g < 3; ++g) { qf[g][0] = *(const bf16x8*)(Qb + g * 64); qf[g][1] = *(const bf16x8*)(Qb + g * 64 + 32); }
    float sl[3];
#pragma unroll
    for (int g = 0; g < 3; ++g) sl[g] = slope_nsa(kv * 3 + g) * L2E;
    const float* gl = p.hs + ((size_t)b * SEQ + t) * HS_W + 4 + kv * 9;
    f32x4 o[3][4]; float m[3], l[3];
    f32x4* otv = (f32x4*)otl + lane;
#pragma unroll
    for (int i = 0; i < 8; ++i) ps[lane + 64 * i] = 0.f;
    {
        const bf16_t* Kb = p.kc + ((size_t)b * 2 + kv) * 128 * 64;
        const bf16_t* VTb = p.vcT + ((size_t)b * 2 + kv) * 64 * 128;
        const int ncv = (t0 + 15 >= 31) ? ((t0 + 15 - 31) >> 4) + 1 : 0;
        const int nch = (ncv + 31) >> 5;
        attn_init<3>(o, m, l);
        const int dq0 = t - 31 - 16 * 8 * fq;
        RangeIt it{0, nch - 1};
        attn_run<false>(it, Kb, 64, VTb, 128, fr, fq, [&](int kc0, const KVFrag& f) {
            const int dq = dq0 - 16 * kc0;
            attn_compute<3, true>(f, qf, o, m, l, [&](int g, int j, float raw) { const int dist = dq - 16 * j; return dist >= 0 ? raw * SCL2 - sl[g] * (float)dist : MASKV; });
        });
        float il[3];
#pragma unroll
        for (int g = 0; g < 3; ++g) {
            const float lt = lsum4(l[g]); il[g] = lt > 0.f ? __builtin_amdgcn_rcpf(lt) : 0.f;
            const float gate = sigmoidf_fast(gl[g * 3 + 0]);
#pragma unroll
            for (int dt = 0; dt < 4; ++dt) otv[(g * 4 + dt) * 64] = o[g][dt] * (il[g] * gate);
        }
        float carry_prev = 0.f;
        for (int c = 0; c < nch; ++c) {
            const int kc0 = c * 32, dq = dq0 - 16 * kc0;
            const bf16_t* kp = Kb + (size_t)(kc0 + (fr >> 2) * 8 + (fr & 3)) * 64 + fq * 8;
            const bf16x8 k00 = *(const bf16x8*)(kp), k01 = *(const bf16x8*)(kp + 32), k10 = *(const bf16x8*)(kp + 256), k11 = *(const bf16x8*)(kp + 256 + 32);
            float pc[8];
#pragma unroll
            for (int j = 0; j < 8; ++j) pc[j] = 0.f;
#pragma unroll
            for (int g = 0; g < 3; ++g) {
                f32x4 s0 = (f32x4){0.f, 0.f, 0.f, 0.f}, s1 = s0;
                s0 = __builtin_amdgcn_mfma_f32_16x16x32_bf16(k00, qf[g][0], s0, 0, 0, 0); s0 = __builtin_amdgcn_mfma_f32_16x16x32_bf16(k01, qf[g][1], s0, 0, 0, 0);
                s1 = __builtin_amdgcn_mfma_f32_16x16x32_bf16(k10, qf[g][0], s1, 0, 0, 0); s1 = __builtin_amdgcn_mfma_f32_16x16x32_bf16(k11, qf[g][1], s1, 0, 0, 0);
#pragma unroll
                for (int j = 0; j < 8; ++j) {
                    const int dist = dq - 16 * j; const float raw = j < 4 ? s0[j] : s1[j - 4];
                    if (dist >= 0) pc[j] += __builtin_amdgcn_exp2f(raw * SCL2 - sl[g] * (float)dist - m[g]) * il[g];
                }
            }
            const float cout = 0.5f * pc[7];
            float cin = __shfl_up(cout, 16);
            const float cwrap = __shfl(cout, fr + 48);
            if (fq == 0) cin = carry_prev;
            carry_prev = cwrap;
            const int n0 = (kc0 >> 2) + 2 * fq;
            ps[fr * 32 + n0] = cin + pc[0] + pc[1] + pc[2] + 0.5f * pc[3];
            ps[fr * 32 + n0 + 1] = 0.5f * pc[3] + pc[4] + pc[5] + pc[6] + 0.5f * pc[7];
        }
    }
    lds_wave_sync();
    if (lane < 16) {
        unsigned mask = 1u | (1u << cur); if (cur >= 1) mask |= 1u << (cur - 1);
        if (cur >= 3) {
            if (cur - 2 <= 5) mask |= (1u << (cur - 1)) - 2u;
            else {
                const float* my = ps + lane * 32;
                for (int r = 0; r < 5; ++r) {
                    float best = -1.0f; int bi = 1;
                    for (int j = 1; j <= cur - 2; ++j) { const float v = my[j]; if (!((mask >> j) & 1u) && v > best) { best = v; bi = j; } }
                    mask |= 1u << bi;
                }
            }
        }
        msk[lane] = mask;
    }
    lds_wave_sync();
    const unsigned qmask = msk[fr];
    lds_wave_sync();
    {
        const bf16_t* Kb = p.hb + (size_t)b * SEQ * NMAIN + C_NKS + kv * 64;
        const bf16_t* VTb = p.vT + ((size_t)b * NVH + 6 + kv) * 64 * SEQ;
        attn_init<3>(o, m, l);
        unsigned um = qmask;
        um |= __shfl_xor(um, 1); um |= __shfl_xor(um, 2); um |= __shfl_xor(um, 4); um |= __shfl_xor(um, 8);
        um = (unsigned)__builtin_amdgcn_readfirstlane((int)um) & (cur >= 31 ? 0xffffffffu : ((2u << cur) - 1u));
        unsigned long long cm = 0ull;
        for (unsigned r = um; r; r &= r - 1) { const int kb = __builtin_ctz(r); cm |= 3ull << (2 * kb); }
        MaskIt it{cm};
        attn_run<false>(it, Kb, NMAIN, VTb, SEQ, fr, fq, [&](int kc0, const KVFrag& f) {
            const bool mine = (qmask >> (kc0 >> 6)) & 1u;
            const int dq = t - kc0 - 8 * fq;
            attn_compute<3, true>(f, qf, o, m, l, [&](int g, int j, float raw) { const int dist = dq - j; return (mine && dist >= 0) ? raw * SCL2 - sl[g] * (float)dist : MASKV; });
        });
#pragma unroll
        for (int g = 0; g < 3; ++g) {
            const float lt = lsum4(l[g]); const float sc = (lt > 0.f ? __builtin_amdgcn_rcpf(lt) : 0.f) * sigmoidf_fast(gl[g * 3 + 1]);
#pragma unroll
            for (int dt = 0; dt < 4; ++dt) otv[(g * 4 + dt) * 64] += o[g][dt] * sc;
        }
    }
    {
        const bf16_t* Kb = p.hb + (size_t)b * SEQ * NMAIN + C_NKW + kv * 64;
        const bf16_t* VTb = p.vT + ((size_t)b * NVH + 8 + kv) * 64 * SEQ;
        attn_init<3>(o, m, l);
        RangeIt it{max(0, t0 - 511) >> 5, (t0 + 15) >> 5};
        attn_run<false>(it, Kb, NMAIN, VTb, SEQ, fr, fq, [&](int kc0, const KVFrag& f) {
            const int dq = t - kc0 - 8 * fq;
            attn_compute<3, true>(f, qf, o, m, l, [&](int g, int j, float raw) { const int dist = dq - j; return (dist >= 0 && dist < 512) ? raw * SCL2 - sl[g] * (float)dist : MASKV; });
        });
#pragma unroll
        for (int g = 0; g < 3; ++g) {
            const float lt = lsum4(l[g]); const float sc = (lt > 0.f ? __builtin_amdgcn_rcpf(lt) : 0.f) * sigmoidf_fast(gl[g * 3 + 2]);
            bf16_t* dst = p.ob + ((size_t)b * SEQ + t) * DM + 640 + (kv * 3 + g) * 64 + 4 * fq;
#pragma unroll
            for (int dt = 0; dt < 4; ++dt) store_o4(dst + dt * 16, otv[(g * 4 + dt) * 64] + o[g][dt] * sc);
        }
    }
}

__device__ __forceinline__ void phase_attn(const Params& p, int l, char* lds, int cslot = 16) {
    int tid = threadIdx.x; asm volatile("" : "+v"(tid));
    const int wid = tid >> 6, lane = tid & 63, fr = lane & 15, fq = lane >> 4;
    float* ps = (float*)(lds + wid * 14592); unsigned* msk = (unsigned*)(ps + 512); float* otl = ps + 576;
    unsigned* ctr = p.ctrl + cslot + l;
    constexpr unsigned NU_NSA = NB * 2 * 128, NU_FOX = NB * 4 * 64, NU_SWA = NB * 2 * 128;
    for (;;) {
        unsigned u = 0;
        if (lane == 0) u = __hip_atomic_fetch_add(ctr, 1u, __ATOMIC_RELAXED, __HIP_MEMORY_SCOPE_AGENT);
        u = (unsigned)__builtin_amdgcn_readfirstlane((int)u);
        if (u >= NU_NSA + NU_FOX + NU_SWA) break;
        if (u < NU_NSA) { const int pos = 127 - (int)(u >> 5), r = u & 31; nsa_unit(p, r >> 1, r & 1, pos, fr, fq, lane, ps, msk, otl); }
        else if (u < NU_NSA + NU_FOX) { const unsigned v = u - NU_NSA; const int qb = 63 - (int)(v >> 6), r = v & 63; fox_unit(p, r >> 2, r & 3, qb, fr, fq); }
        else { const unsigned v = u - NU_NSA - NU_FOX; const int pos = 127 - (int)(v >> 5), r = v & 31; swa_unit(p, l, r >> 1, r & 1, pos, fr, fq); }
    }
}

__device__ __forceinline__ void phase_ln1_router(const Params& p, int l, char* lds) {
    int tid = threadIdx.x; asm volatile("" : "+v"(tid));
    const int wid = tid >> 6, lane = tid & 63, fr = lane & 15, fq = lane >> 4;
    float* lg = (float*)lds + wid * 512;
    int* lcnt = (int*)(lds + 16384); int* lbase = lcnt + 32;
    const float* g1 = p.ln1_g + l * DM; const float* b1 = p.ln1_b + l * DM;
    const float* rw = p.rwT + (size_t)l * NE * 1024; const float* rb = p.router_b + l * NE;
    unsigned* gcount = p.ctrl + 64 + l * NE;
    for (int grp = blockIdx.x; grp < NTOK / 128; grp += gridDim.x) {
        const int tok0 = grp * 128 + wid * 16;
        if (tid < 32) lcnt[tid] = 0;
        float4 gg[4], bb[4];
#pragma unroll
        for (int j = 0; j < 4; ++j) { gg[j] = *(const float4*)(g1 + j * 256 + lane * 4); bb[j] = *(const float4*)(b1 + j * 256 + lane * 4); }
        for (int r0 = 0; r0 < 16; r0 += 4) {
            float4 v[4][4]; float s[4], qv[4];
#pragma unroll
            for (int i = 0; i < 4; ++i)
#pragma unroll
                for (int j = 0; j < 4; ++j) v[i][j] = *(const float4*)(p.tbuf + (size_t)(tok0 + r0 + i) * DM + j * 256 + lane * 4);
#pragma unroll
            for (int i = 0; i < 4; ++i) { s[i] = 0.f;
#pragma unroll
                for (int j = 0; j < 4; ++j) s[i] += (v[i][j].x + v[i][j].y) + (v[i][j].z + v[i][j].w); }
#pragma unroll
            for (int o = 32; o > 0; o >>= 1) {
#pragma unroll
                for (int i = 0; i < 4; ++i) s[i] += __shfl_xor(s[i], o); }
#pragma unroll
            for (int i = 0; i < 4; ++i) { const float mean = s[i] * (1.0f / 1024.0f); qv[i] = 0.f;
#pragma unroll
                for (int j = 0; j < 4; ++j) { v[i][j].x -= mean; v[i][j].y -= mean; v[i][j].z -= mean; v[i][j].w -= mean; qv[i] += (v[i][j].x * v[i][j].x + v[i][j].y * v[i][j].y) + (v[i][j].z * v[i][j].z + v[i][j].w * v[i][j].w); } }
#pragma unroll
            for (int o = 32; o > 0; o >>= 1) {
#pragma unroll
                for (int i = 0; i < 4; ++i) qv[i] += __shfl_xor(qv[i], o); }
#pragma unroll
            for (int i = 0; i < 4; ++i) {
                const float rstd = rsqrtf(qv[i] * (1.0f / 1024.0f) + LN_EPS);
                const size_t row = (size_t)(tok0 + r0 + i);
#pragma unroll
                for (int j = 0; j < 4; ++j) {
                    const int c = j * 256 + lane * 4;
                    float4 y; y.x = v[i][j].x * rstd * gg[j].x + bb[j].x; y.y = v[i][j].y * rstd * gg[j].y + bb[j].y; y.z = v[i][j].z * rstd * gg[j].z + bb[j].z; y.w = v[i][j].w * rstd * gg[j].w + bb[j].w;
                    *(float4*)(p.x1f + row * DM + c) = y;
                    u32x2 w; w.x = pack2(y.x, y.y); w.y = pack2(y.z, y.w);
                    *(u32x2*)(p.x1b + row * DM + c) = w;
                }
            }
        }
        __syncthreads();
        f32x4 a0 = (f32x4){0.f, 0.f, 0.f, 0.f}, a1 = a0;
        const float* xr = p.x1f + (size_t)(tok0 + fr) * DM + 4 * fq;
        const float* w0 = rw + (size_t)fr * 1024 + 4 * fq; const float* w1 = rw + (size_t)(16 + fr) * 1024 + 4 * fq;
#pragma unroll 4
        for (int k0 = 0; k0 < 1024; k0 += 16) {
            const float4 xa = *(const float4*)(xr + k0), wb0 = *(const float4*)(w0 + k0), wb1 = *(const float4*)(w1 + k0);
            a0 = __builtin_amdgcn_mfma_f32_16x16x4f32(xa.x, wb0.x, a0, 0, 0, 0); a1 = __builtin_amdgcn_mfma_f32_16x16x4f32(xa.x, wb1.x, a1, 0, 0, 0);
            a0 = __builtin_amdgcn_mfma_f32_16x16x4f32(xa.y, wb0.y, a0, 0, 0, 0); a1 = __builtin_amdgcn_mfma_f32_16x16x4f32(xa.y, wb1.y, a1, 0, 0, 0);
            a0 = __builtin_amdgcn_mfma_f32_16x16x4f32(xa.z, wb0.z, a0, 0, 0, 0); a1 = __builtin_amdgcn_mfma_f32_16x16x4f32(xa.z, wb1.z, a1, 0, 0, 0);
            a0 = __builtin_amdgcn_mfma_f32_16x16x4f32(xa.w, wb0.w, a0, 0, 0, 0); a1 = __builtin_amdgcn_mfma_f32_16x16x4f32(xa.w, wb1.w, a1, 0, 0, 0);
        }
#pragma unroll
        for (int r = 0; r < 4; ++r) { lg[(fq * 4 + r) * 32 + fr] = a0[r] + rb[fr]; lg[(fq * 4 + r) * 32 + 16 + fr] = a1[r] + rb[16 + fr]; }
        lds_wave_sync();
        int e4[4] = {0, 0, 0, 0}; int rk[4] = {0, 0, 0, 0};
        if (lane < 16) {
            const float* my = lg + lane * 32; unsigned taken = 0u; float tv[4];
#pragma unroll
            for (int k = 0; k < 4; ++k) {
                float best = NEG_INF; int bi = 0;
                for (int e = 0; e < 32; ++e) { const float xv = my[e]; if (!((taken >> e) & 1u) && xv > best) { best = xv; bi = e; } }
                taken |= 1u << bi; e4[k] = bi; tv[k] = best;
            }
            const float e1 = __expf(tv[1] - tv[0]), e2 = __expf(tv[2] - tv[0]), e3 = __expf(tv[3] - tv[0]);
            const float inv = 1.0f / (1.0f + e1 + e2 + e3);
            const size_t row = (size_t)(tok0 + lane);
            *(float4*)(p.gw + row * 4) = make_float4(inv, e1 * inv, e2 * inv, e3 * inv);
        }
        __syncthreads();
        if (lane < 16) {
#pragma unroll
            for (int k = 0; k < 4; ++k) rk[k] = atomicAdd(&lcnt[e4[k]], 1);
        }
        __syncthreads();
        if (tid < 32) { const int c = lcnt[tid]; lbase[tid] = c ? (int)__hip_atomic_fetch_add(gcount + tid, (unsigned)c, __ATOMIC_RELAXED, __HIP_MEMORY_SCOPE_AGENT) : 0; }
        __syncthreads();
        if (lane < 16) {
            const int row = tok0 + lane; int pk[4];
#pragma unroll
            for (int k = 0; k < 4; ++k) { const int pos = lbase[e4[k]] + rk[k]; p.lists[(size_t)e4[k] * LIST_CAP + pos] = row * 4 + k; pk[k] = (pos << 5) | e4[k]; }
            *(int4*)(p.top_e + (size_t)row * 4) = make_int4(pk[0], pk[1], pk[2], pk[3]);
        }
        __syncthreads();
    }
}

__device__ __forceinline__ void phase_ln2(const Params& p, int l, float* xout, char* lds) {
    int* ptile = (int*)(lds + LDS_TAB); int* ecnt = ptile + 40;
    build_tiles(p, l, ptile, ecnt);
    int tid = threadIdx.x; asm volatile("" : "+v"(tid));
    const int wid = tid >> 6, lane = tid & 63;
    const float* g2 = p.ln2_g + l * DM; const float* b2 = p.ln2_b + l * DM;
    float4 gg[4], bb[4];
#pragma unroll
    for (int j = 0; j < 4; ++j) { gg[j] = *(const float4*)(g2 + j * 256 + lane * 4); bb[j] = *(const float4*)(b2 + j * 256 + lane * 4); }
    for (int pr = blockIdx.x * NWV + wid; pr < NTOK / 2; pr += gridDim.x * NWV) {
        float4 v[2][4]; float s[2], qv[2];
        u32x2 yv[2][4][4]; float gk[2][4];
#pragma unroll
        for (int i = 0; i < 2; ++i) {
            const int row = pr * 2 + i;
            const float4 gwv = *(const float4*)(p.gw + (size_t)row * 4);
            gk[i][0] = gwv.x; gk[i][1] = gwv.y; gk[i][2] = gwv.z; gk[i][3] = gwv.w;
            const int4 te = *(const int4*)(p.top_e + (size_t)row * 4);
            const int tk[4] = {te.x, te.y, te.z, te.w};
#pragma unroll
            for (int j = 0; j < 4; ++j) v[i][j] = *(const float4*)(p.x1f + (size_t)row * DM + j * 256 + lane * 4);
#pragma unroll
            for (int k = 0; k < 4; ++k) {
                const bf16_t* yr = p.ybuf + (size_t)(ptile[tk[k] & 31] * 256 + (tk[k] >> 5)) * DM + lane * 4;
#pragma unroll
                for (int j = 0; j < 4; ++j) yv[i][k][j] = *(const u32x2*)(yr + j * 256);
            }
        }
#pragma unroll
        for (int i = 0; i < 2; ++i) { s[i] = 0.f;
#pragma unroll
            for (int j = 0; j < 4; ++j) {
                float4 a; a.x = v[i][j].x * ALPHA; a.y = v[i][j].y * ALPHA; a.z = v[i][j].z * ALPHA; a.w = v[i][j].w * ALPHA;
#pragma unroll
                for (int k = 0; k < 4; ++k) {
                    const u32x2 w = yv[i][k][j];
                    a.x += gk[i][k] * __uint_as_float(w.x << 16); a.y += gk[i][k] * __uint_as_float(w.x & 0xffff0000u);
                    a.z += gk[i][k] * __uint_as_float(w.y << 16); a.w += gk[i][k] * __uint_as_float(w.y & 0xffff0000u);
                }
                v[i][j] = a; s[i] += (a.x + a.y) + (a.z + a.w);
            } }
#pragma unroll
        for (int o = 32; o > 0; o >>= 1) { s[0] += __shfl_xor(s[0], o); s[1] += __shfl_xor(s[1], o); }
#pragma unroll
        for (int i = 0; i < 2; ++i) { const float mean = s[i] * (1.0f / 1024.0f); qv[i] = 0.f;
#pragma unroll
            for (int j = 0; j < 4; ++j) { v[i][j].x -= mean; v[i][j].y -= mean; v[i][j].z -= mean; v[i][j].w -= mean; qv[i] += (v[i][j].x * v[i][j].x + v[i][j].y * v[i][j].y) + (v[i][j].z * v[i][j].z + v[i][j].w * v[i][j].w); } }
#pragma unroll
        for (int o = 32; o > 0; o >>= 1) { qv[0] += __shfl_xor(qv[0], o); qv[1] += __shfl_xor(qv[1], o); }
#pragma unroll
        for (int i = 0; i < 2; ++i) {
            const float rstd = rsqrtf(qv[i] * (1.0f / 1024.0f) + LN_EPS);
            const size_t row = (size_t)(pr * 2 + i);
#pragma unroll
            for (int j = 0; j < 4; ++j) {
                const int c = j * 256 + lane * 4;
                float4 y; y.x = v[i][j].x * rstd * gg[j].x + bb[j].x; y.y = v[i][j].y * rstd * gg[j].y + bb[j].y; y.z = v[i][j].z * rstd * gg[j].z + bb[j].z; y.w = v[i][j].w * rstd * gg[j].w + bb[j].w;
                *(float4*)(xout + row * DM + c) = y;
                u32x2 w; w.x = pack2(y.x, y.y); w.y = pack2(y.z, y.w);
                *(u32x2*)(p.xb + row * DM + c) = w;
            }
        }
    }
}

#define XB_TMO      128
#define XB_XCNT(j)  (256  + 64 * (j))
#define XB_XSUB(j)  (1280 + 64 * (j))
#define XB_XGEN(j)  (2304 + 64 * (j))
#define XB_TOP      3328
#define XB_TOPGEN   3392
#define XCD_BAR_WORDS 3456
#define XB_SPIN_CAP (1u << 22)
__device__ __forceinline__ unsigned xb_ld(unsigned* p)              { return __hip_atomic_load(p, __ATOMIC_RELAXED, __HIP_MEMORY_SCOPE_AGENT); }
__device__ __forceinline__ unsigned xb_add(unsigned* p, unsigned v) { return __hip_atomic_fetch_add(p, v, __ATOMIC_RELAXED, __HIP_MEMORY_SCOPE_AGENT); }
__device__ __forceinline__ unsigned xb_xcc_id() { return (unsigned)__builtin_amdgcn_s_getreg((3 << 11) | 20) & 0xFu; }
#define XB_SPIN(cond, bar) do { unsigned _sp = 0; while (cond) { __builtin_amdgcn_s_sleep(1); \
    if ((++_sp & 255u) == 0u) { if (xb_ld(&(bar)[XB_TMO])) break; if (_sp > XB_SPIN_CAP) { atomicAdd(&(bar)[XB_TMO], 1u); break; } } } } while (0)
struct XcdBarrier { unsigned* bar; unsigned x; volatile LAS unsigned* st; };
__device__ __forceinline__ XcdBarrier xcd_barrier_post(unsigned* bar, volatile LAS unsigned* st) {
    XcdBarrier b; b.bar = bar; b.x = xb_xcc_id(); b.st = st;
    if (threadIdx.x == 0) (void)xb_add(&bar[XB_XCNT(b.x)], 1u);
    return b;
}
__device__ __forceinline__ void xcd_barrier_complete(unsigned* bar, unsigned x, unsigned& nloc, unsigned& nx) {
    const unsigned G = gridDim.x * gridDim.y * gridDim.z;
    unsigned sum, cnt, mine, sp = 0u;
    for (;;) {
        sum = 0u; cnt = 0u; mine = 0u;
#pragma unroll
        for (unsigned j = 0; j < 16; ++j) { const unsigned c = xb_ld(&bar[XB_XCNT(j)]); sum += c; cnt += (c > 0u) ? 1u : 0u; mine = (j == x) ? c : mine; }
        if (sum == G) break;
        __builtin_amdgcn_s_sleep(1);
        if ((++sp & 255u) == 0u) { if (xb_ld(&bar[XB_TMO])) break; if (sp > XB_SPIN_CAP) { atomicAdd(&bar[XB_TMO], 1u); break; } }
    }
    nloc = mine > 0u ? mine : 1u; nx = cnt > 0u ? cnt : 1u;
}
__device__ __forceinline__ void xcd_barrier(const XcdBarrier& b) {
    asm volatile("s_waitcnt vmcnt(0)" ::: "memory");
    __syncthreads();
    if (threadIdx.x == 0) {
        unsigned* bar = b.bar;
        __builtin_amdgcn_s_waitcnt(0);
        unsigned nloc = b.st[0], nx = b.st[1];
        if (nloc == 0u) { xcd_barrier_complete(bar, b.x, nloc, nx); b.st[0] = nloc; b.st[1] = nx; }
        const unsigned old = xb_add(&bar[XB_XSUB(b.x)], 1u);
        const unsigned gen = old / nloc;
        if (old + 1u == (gen + 1u) * nloc) {
            __builtin_amdgcn_fence(__ATOMIC_RELEASE, "agent");
            asm volatile("s_waitcnt vmcnt(0)" ::: "memory");
            const unsigned og = xb_add(&bar[XB_TOP], 1u);
            const unsigned tg = og / nx;
            if (og + 1u == (tg + 1u) * nx) xb_add(&bar[XB_TOPGEN], 1u);
            else XB_SPIN(xb_ld(&bar[XB_TOPGEN]) == tg, bar);
            __builtin_amdgcn_fence(__ATOMIC_ACQUIRE, "agent");
            xb_add(&bar[XB_XGEN(b.x)], 1u);
            asm volatile("s_waitcnt vmcnt(0)" ::: "memory");
        } else {
            XB_SPIN(xb_ld(&bar[XB_XGEN(b.x)]) == gen, bar);
            __builtin_amdgcn_fence(__ATOMIC_ACQUIRE, "agent");
            asm volatile("s_waitcnt vmcnt(0)" ::: "memory");
        }
    }
    __syncthreads();
}

struct KArgs { const float* in[18]; float* out; char* ws; };
constexpr size_t al256(size_t v) { return (v + 255) / 256 * 256; }
struct WSL {
    static constexpr size_t ctrl = 0;
    static constexpr size_t WinT = al256(ctrl + 65536);
    static constexpr size_t WoT = al256(WinT + (size_t)NL * NPAD * 1024 * 2);
    static constexpr size_t W1T = al256(WoT + (size_t)NL * 1024 * 1024 * 2);
    static constexpr size_t W2T = al256(W1T + (size_t)NL * 2 * 64 * 2048 * 2);
    static constexpr size_t WguT = al256(W2T + (size_t)NL * 2 * 64 * 64 * 2);
    static constexpr size_t WdnT = al256(WguT + (size_t)NL * NE * 2048 * 1024 * 2);
    static constexpr size_t rwT = al256(WdnT + (size_t)NL * NE * 1024 * 1024 * 2);
    static constexpr size_t binp = al256(rwT + (size_t)NL * NE * 1024 * 4);
    static constexpr size_t bgup = al256(binp + (size_t)NL * NPAD * 4);
    static constexpr size_t b1c = al256(bgup + (size_t)NL * NE * 2048 * 4);
    static constexpr size_t xf = al256(b1c + 4 * 64 * 4);
    static constexpr size_t xb = al256(xf + (size_t)NTOK * DM * 4);
    static constexpr size_t hb = al256(xb + (size_t)NTOK * DM * 2);
    static constexpr size_t hs = al256(hb + (size_t)NTOK * NMAIN * 2);
    static constexpr size_t vT = al256(hs + (size_t)NTOK * HS_W * 4);
    static constexpr size_t cF = al256(vT + (size_t)NB * NVH * 64 * SEQ * 2);
    static constexpr size_t kc = al256(cF + (size_t)NB * 4 * SEQ * 4);
    static constexpr size_t vc = al256(kc + (size_t)NB * 2 * 128 * 64 * 2);
    static constexpr size_t vcT = al256(vc + (size_t)NB * 2 * 128 * 64 * 2);
    static constexpr size_t ob = al256(vcT + (size_t)NB * 2 * 128 * 64 * 2);
    static constexpr size_t tbuf = al256(ob + (size_t)NTOK * DM * 2);
    static constexpr size_t x1f = al256(tbuf + (size_t)NTOK * DM * 4);
    static constexpr size_t x1b = al256(x1f + (size_t)NTOK * DM * 4);
    static constexpr size_t top_e = al256(x1b + (size_t)NTOK * DM * 2);
    static constexpr size_t gw = al256(top_e + (size_t)NTOK * 4 * 4);
    static constexpr size_t lists = al256(gw + (size_t)NTOK * 4 * 4);
    static constexpr size_t act = al256(lists + (size_t)NE * LIST_CAP * 4);
    static constexpr size_t ybuf = al256(act + (size_t)MAXSLOT * DFF * 2);
    static constexpr size_t total = al256(ybuf + (size_t)MAXSLOT * DM * 2);
};
__device__ __forceinline__ Params make_params(const KArgs& k) {
    Params p;
    p.x = k.in[0]; p.w_in = k.in[1]; p.b_in = k.in[2]; p.sinks = k.in[3]; p.cmp_pe = k.in[4]; p.cmp_w1 = k.in[5]; p.cmp_w2 = k.in[6]; p.w_out = k.in[7];
    p.ln1_g = k.in[8]; p.ln1_b = k.in[9]; p.router_w = k.in[10]; p.router_b = k.in[11]; p.w_gu = k.in[12]; p.b_gu = k.in[13]; p.w_dn = k.in[14]; p.b_dn = k.in[15];
    p.ln2_g = k.in[16]; p.ln2_b = k.in[17]; p.out = k.out;
    char* w = k.ws;
    p.ctrl = (unsigned*)(w + WSL::ctrl); p.WinT = (bf16_t*)(w + WSL::WinT); p.WoT = (bf16_t*)(w + WSL::WoT); p.W1T = (bf16_t*)(w + WSL::W1T); p.W2T = (bf16_t*)(w + WSL::W2T);
    p.WguT = (bf16_t*)(w + WSL::WguT); p.WdnT = (bf16_t*)(w + WSL::WdnT); p.rwT = (float*)(w + WSL::rwT); p.binp = (float*)(w + WSL::binp); p.bgup = (float*)(w + WSL::bgup);
    p.b1c = (float*)(w + WSL::b1c); p.xf = (float*)(w + WSL::xf); p.xb = (bf16_t*)(w + WSL::xb); p.hb = (bf16_t*)(w + WSL::hb); p.hs = (float*)(w + WSL::hs); p.vT = (bf16_t*)(w + WSL::vT);
    p.cF = (float*)(w + WSL::cF); p.kc = (bf16_t*)(w + WSL::kc); p.vc = (bf16_t*)(w + WSL::vc); p.vcT = (bf16_t*)(w + WSL::vcT); p.ob = (bf16_t*)(w + WSL::ob); p.tbuf = (float*)(w + WSL::tbuf);
    p.x1f = (float*)(w + WSL::x1f); p.x1b = (bf16_t*)(w + WSL::x1b); p.top_e = (int*)(w + WSL::top_e); p.gw = (float*)(w + WSL::gw); p.lists = (int*)(w + WSL::lists);
    p.act = (bf16_t*)(w + WSL::act); p.ybuf = (bf16_t*)(w + WSL::ybuf);
    return p;
}
__device__ __forceinline__ void grid_bar(const Params& p, char* lds) {
    XcdBarrier xb; xb.bar = p.ctrl + 1024; xb.x = xb_xcc_id(); xb.st = (volatile LAS unsigned*)(lds + LDS_BYTES - 16); xcd_barrier(xb);
}
template <int L>
__device__ __forceinline__ void layer_fwd(const Params& p, char* lds) {
    const float* xin = L == 0 ? p.x : p.xf;
    float* xout = L == NL - 1 ? p.out : p.xf;
#ifndef REP
#define REP 0
#endif
    phase_inproj(p, L, lds);        grid_bar(p, lds);
    if (REP & 1) { phase_inproj(p, L, lds);        grid_bar(p, lds); }
    phase_prep(p, L, lds);          grid_bar(p, lds);
    if (REP & 2) { phase_prep(p, L, lds);          grid_bar(p, lds); }
    phase_attn(p, L, lds);          grid_bar(p, lds);
    if (REP & 4) { phase_attn(p, L, lds, 24);      grid_bar(p, lds); }
    phase_outproj(p, L, xin, lds);  grid_bar(p, lds);
    if (REP & 8) { phase_outproj(p, L, xin, lds);  grid_bar(p, lds); }
    phase_ln1_router(p, L, lds);    grid_bar(p, lds);
    phase_gateup(p, L, lds);        grid_bar(p, lds);
    if (REP & 16) { phase_gateup(p, L, lds);       grid_bar(p, lds); }
    phase_down(p, L, lds);          grid_bar(p, lds);
    if (REP & 32) { phase_down(p, L, lds);         grid_bar(p, lds); }
    phase_ln2(p, L, xout, lds);
    if (REP & 64) { grid_bar(p, lds); phase_ln2(p, L, xout, lds); }
}
__global__ void __launch_bounds__(NTHR, 2) fwd_kernel(KArgs ka) {
    extern __shared__ __attribute__((aligned(16))) char lds[];
    const Params p = make_params(ka);
    cg::grid_group grid = cg::this_grid();
    volatile LAS unsigned* xst = (volatile LAS unsigned*)(lds + LDS_BYTES - 16);
    if (threadIdx.x == 0) { xst[0] = 0u; xst[1] = 0u; }
    __syncthreads();
    (void)xcd_barrier_post(p.ctrl + 1024, xst);
    phase0(p, lds);
    if (REP & 128) { grid_bar(p, lds); phase0(p, lds); }
    grid.sync();
    layer_fwd<0>(p, lds);
    grid_bar(p, lds);
    layer_fwd<1>(p, lds);
}

extern "C" void kernel_launch(void* const* d_in, const int* in_sizes, int n_in, void* d_out, int out_size, void* d_ws, size_t ws_size, hipStream_t stream) {
    KArgs ka{};
    for (int i = 0; i < 18; ++i) ka.in[i] = (const float*)d_in[i];
    ka.out = (float*)d_out; ka.ws = (char*)d_ws;
    if (WSL::total > ws_size) { fprintf(stderr, "workspace too small: need %zu have %zu\n", (size_t)WSL::total, ws_size); return; }
    static int grid_blocks = 0;
    if (!grid_blocks) {
        int dev = 0, cus = 0, per_cu = 0;
        (void)hipGetDevice(&dev);
        (void)hipDeviceGetAttribute(&cus, hipDeviceAttributeMultiprocessorCount, dev);
        (void)hipFuncSetAttribute((const void*)fwd_kernel, hipFuncAttributeMaxDynamicSharedMemorySize, LDS_BYTES);
        (void)hipOccupancyMaxActiveBlocksPerMultiprocessor(&per_cu, fwd_kernel, NTHR, LDS_BYTES);
        if (per_cu < 1) { fprintf(stderr, "occupancy query says 0 blocks per CU\n"); per_cu = 1; }
        grid_blocks = cus;
    }
    (void)hipMemsetAsync(d_ws, 0, 65536, stream);
    void* args[] = {&ka};
    hipError_t e = hipLaunchCooperativeKernel((const void*)fwd_kernel, dim3(grid_blocks), dim3(NTHR), args, LDS_BYTES, stream);
    if (e != hipSuccess) fprintf(stderr, "cooperative launch failed: %s (grid %d)\n", hipGetErrorString(e), grid_blocks);
}
```

```cpp
#include <hip/hip_runtime.h>
#include <hip/hip_cooperative_groups.h>
#include <cstdio>
#include <cstdint>
namespace cg = cooperative_groups;

typedef unsigned short bf16_t;
typedef short bf16x8 __attribute__((ext_vector_type(8)));
typedef float f32x4 __attribute__((ext_vector_type(4)));
typedef unsigned u32x4 __attribute__((ext_vector_type(4)));
typedef unsigned u32x2 __attribute__((ext_vector_type(2)));
typedef int v8i_t __attribute__((ext_vector_type(8)));
typedef int v4i_t __attribute__((ext_vector_type(4)));
#define LAS __attribute__((address_space(3)))
constexpr float NEG_INF = -__builtin_huge_valf();

constexpr int DM = 1024, NB = 16, SEQ = 2048, NTOK = NB * SEQ, NL = 2;
constexpr int NCOL = 2582, NMAIN = 2560, NPAD = 2688, NE = 32, DFF = 1024;
constexpr int C_FQ = 0, C_FK = 256, C_FV = 512, C_SQ = 768, C_SK = 1152, C_SV = 1280, C_NQ = 1408,
              C_NKC = 1792, C_NVC = 1920, C_NKS = 2048, C_NVS = 2176, C_NKW = 2304, C_NVW = 2432;
constexpr int HS_W = 32;
constexpr int NVH = 10;
constexpr int LIST_CAP = NTOK;
constexpr int MAXSLOT = NTOK * 4 + NE * 256;
constexpr float ALPHA = 1.41421356237f, LN_EPS = 1e-5f, QSCALE = 0.125f;
constexpr int NWV = 8, NTHR = NWV * 64;
constexpr int LDS_STAGE = 131072, LDS_TAB = LDS_STAGE, LDS_AOFF = LDS_STAGE + 2048, LDS_BYTES = LDS_AOFF + 20480 + 256;

struct Params {
    const float *x, *w_in, *b_in, *sinks, *cmp_pe, *cmp_w1, *cmp_w2, *w_out, *ln1_g, *ln1_b, *router_w, *router_b,
                *w_gu, *b_gu, *w_dn, *b_dn, *ln2_g, *ln2_b;
    float* out;
    unsigned* ctrl;
    bf16_t *WinT, *WoT, *W1T, *W2T, *WguT, *WdnT;
    float *rwT, *binp, *bgup, *b1c;
    float* xf; bf16_t* xb; bf16_t* hb; float* hs; bf16_t* vT; float* cF;
    bf16_t *kc, *vc, *vcT; bf16_t* ob; float* tbuf; float* x1f; bf16_t* x1b;
    int* top_e; float* gw; int* lists; bf16_t* act; bf16_t* ybuf;
};

__device__ __forceinline__ float bf2f(bf16_t h) { return __uint_as_float(((unsigned)h) << 16); }
typedef __bf16 bf16x2_t __attribute__((ext_vector_type(2)));
__device__ __forceinline__ bf16_t f2bf(float f) { return __builtin_bit_cast(bf16_t, (__bf16)f); }
__device__ __forceinline__ unsigned pack2(float lo, float hi) { bf16x2_t v = {(__bf16)lo, (__bf16)hi}; return __builtin_bit_cast(unsigned, v); }
__device__ __forceinline__ unsigned pack4_fp8(float a, float b, float c, float d) {
    unsigned w = 0u;
    w = __builtin_amdgcn_cvt_pk_fp8_f32(a, b, w, false);
    w = __builtin_amdgcn_cvt_pk_fp8_f32(c, d, w, true);
    return w;
}
__device__ __forceinline__ float wave_sum(float v) {
#pragma unroll
    for (int o = 32; o > 0; o >>= 1) v += __shfl_xor(v, o);
    return v;
}
__device__ __forceinline__ float wave_max(float v) {
#pragma unroll
    for (int o = 32; o > 0; o >>= 1) v = fmaxf(v, __shfl_xor(v, o));
    return v;
}
__device__ __forceinline__ void lds_wave_sync() { asm volatile("s_waitcnt lgkmcnt(0)" ::: "memory"); __builtin_amdgcn_wave_barrier(); }
__device__ __forceinline__ float slope_swa(int hq) { return exp2f(-8.0f * (float)(2 * hq + 1) / 12.0f); }
__device__ __forceinline__ float slope_nsa(int hq) { return exp2f(-8.0f * (float)(2 * hq + 2) / 12.0f); }

__device__ __forceinline__ int perm_row(int perm, int n) {
    if (perm == 1) { if (n < 768) return n; if (n < 772) return 2560 + (n - 768); if (n < 2564) return n - 4; return n; }
    if (perm == 2) { const int f = n >> 1, s = n & 1; return (f >> 7) * 256 + s * 128 + (f & 127); }
    return n;
}
struct ConvJob { const float* src; bf16_t* dst; int K, N, kt, nt, perm; float q8; };
__device__ __forceinline__ bool conv_job(const Params& p, int t, ConvJob& jb) {
    constexpr int T_GU = NL * NE * 8 * 16, T_DN = NL * NE * 8 * 8, T_WIN = NL * 8 * 21, T_WO = NL * 8 * 8;
    if (t < T_GU) { const int m = t / 128, r = t % 128; jb = ConvJob{p.w_gu + (size_t)m * 1024 * 2048, (bf16_t*)((char*)p.WguT + (size_t)m * 2048 * 1024), 1024, 2048, r / 16, r % 16, 2, 64.0f}; return true; }
    t -= T_GU;
    if (t < T_DN) { const int m = t / 64, r = t % 64; jb = ConvJob{p.w_dn + (size_t)m * 1024 * 1024, (bf16_t*)((char*)p.WdnT + (size_t)m * 1024 * 1024), 1024, 1024, r / 8, r % 8, 0, 64.0f}; return true; }
    t -= T_DN;
    if (t < T_WIN) { const int m = t / 168, r = t % 168; jb = ConvJob{p.w_in + (size_t)m * 1024 * NCOL, p.WinT + (size_t)m * NPAD * 1024, 1024, NCOL, r / 21, r % 21, 1, 0.f}; return true; }
    t -= T_WIN;
    if (t < T_WO) { const int m = t / 64, r = t % 64; jb = ConvJob{p.w_out + (size_t)m * 1024 * 1024, p.WoT + (size_t)m * 1024 * 1024, 1024, 1024, r / 8, r % 8, 0, 0.f}; return true; }
    return false;
}
__device__ __forceinline__ void conv_load(const ConvJob& jb, int tid, float2 (&v)[16]) {
    const int n = jb.nt * 128 + (tid & 31) * 4;
    const float* s = jb.src + (size_t)(jb.kt * 128 + (tid >> 5)) * jb.N + n;
#pragma unroll
    for (int i = 0; i < 8; ++i) {
        const float* r = s + (size_t)(16 * i) * jb.N;
        v[2 * i] = (n + 1 < jb.N) ? *(const float2*)r : make_float2(0.f, 0.f);
        v[2 * i + 1] = (n + 3 < jb.N) ? *(const float2*)(r + 2) : make_float2(0.f, 0.f);
    }
}
__device__ __forceinline__ void phase0(const Params& p, char* ldsc) {
    int tid = threadIdx.x; asm volatile("" : "+v"(tid));
    const int G = gridDim.x, bid = blockIdx.x;
    const size_t gtid = (size_t)bid * NTHR + tid, gthreads = (size_t)G * NTHR;
    {
        constexpr int TOT = NL * NE * 8 * 16 + NL * NE * 8 * 8 + NL * 8 * 21 + NL * 8 * 8;
        bf16_t* lt = (bf16_t*)ldsc;
        ConvJob jb, jn; float2 v[16], vn[16];
        int t = bid; bool have = t < TOT && conv_job(p, t, jb);
        if (have) conv_load(jb, tid, v);
        while (have) {
            const int tn = t + G; const bool hn = tn < TOT && conv_job(p, tn, jn);
            if (hn) conv_load(jn, tid, vn);
            if (jb.q8 != 0.f) {
                unsigned char* l8 = (unsigned char*)lt;
#pragma unroll
                for (int i = 0; i < 8; ++i)
                    *(unsigned*)(l8 + ((tid >> 5) + 16 * i) * 132 + (tid & 31) * 4) = pack4_fp8(v[2 * i].x * jb.q8, v[2 * i].y * jb.q8, v[2 * i + 1].x * jb.q8, v[2 * i + 1].y * jb.q8);
                __syncthreads();
#pragma unroll
                for (int i = 0; i < 2; ++i) {
                    const int idx = tid + NTHR * i, kc = idx & 7, nn = idx >> 3, n = jb.nt * 128 + nn;
                    const unsigned char* l = l8 + (kc * 16) * 132 + nn;
                    u32x4 w;
                    w.x = (unsigned)l[0] | ((unsigned)l[132] << 8) | ((unsigned)l[264] << 16) | ((unsigned)l[396] << 24);
                    w.y = (unsigned)l[528] | ((unsigned)l[660] << 8) | ((unsigned)l[792] << 16) | ((unsigned)l[924] << 24);
                    w.z = (unsigned)l[1056] | ((unsigned)l[1188] << 8) | ((unsigned)l[1320] << 16) | ((unsigned)l[1452] << 24);
                    w.w = (unsigned)l[1584] | ((unsigned)l[1716] << 8) | ((unsigned)l[1848] << 16) | ((unsigned)l[1980] << 24);
                    *(u32x4*)((char*)jb.dst + (size_t)perm_row(jb.perm, n) * jb.K + jb.kt * 128 + kc * 16) = w;
                }
            } else {
#pragma unroll
                for (int i = 0; i < 8; ++i) {
                    u32x2 w; w.x = pack2(v[2 * i].x, v[2 * i].y); w.y = pack2(v[2 * i + 1].x, v[2 * i + 1].y);
                    *(u32x2*)(lt + ((tid >> 5) + 16 * i) * 136 + (tid & 31) * 4) = w;
                }
                __syncthreads();
#pragma unroll
                for (int i = 0; i < 4; ++i) {
                    const int idx = tid + NTHR * i, kc = idx & 15, nn = idx >> 4, n = jb.nt * 128 + nn;
                    if (n < jb.N) {
                        const bf16_t* l = lt + (kc * 8) * 136 + nn;
                        u32x4 w;
                        w.x = (unsigned)l[0] | ((unsigned)l[136] << 16); w.y = (unsigned)l[272] | ((unsigned)l[408] << 16);
                        w.z = (unsigned)l[544] | ((unsigned)l[680] << 16); w.w = (unsigned)l[816] | ((unsigned)l[952] << 16);
                        *(u32x4*)(jb.dst + (size_t)perm_row(jb.perm, n) * jb.K + jb.kt * 128 + kc * 8) = w;
                    }
                }
            }
            __syncthreads();
            t = tn; have = hn; jb = jn;
#pragma unroll
            for (int i = 0; i < 16; ++i) v[i] = vn[i];
        }
    }
    for (size_t i = gtid; i < (size_t)NL * 2 * 2048 * 64; i += gthreads) {
        const int k = (int)(i % 2048), n = (int)((i / 2048) % 64), m = (int)(i / (2048 * 64));
        p.W1T[i] = f2bf(p.cmp_w1[((size_t)m * 2048 + k) * 64 + n]);
    }
    for (size_t i = gtid; i < (size_t)NL * 2 * 64 * 64; i += gthreads) {
        const int k = (int)(i % 64), n = (int)((i / 64) % 64), m = (int)(i / 4096);
        p.W2T[i] = f2bf(p.cmp_w2[((size_t)m * 64 + k) * 64 + n]);
    }
    for (size_t i = gtid; i < (size_t)NL * NPAD; i += gthreads) {
        const int l = (int)(i / NPAD), r = (int)(i % NPAD);
        float v = 0.f;
        if (r < 2560) { const int n = r < 768 ? r : r + 4; v = p.b_in[l * NCOL + n]; }
        else if (r < 2564) v = p.b_in[l * NCOL + 768 + (r - 2560)];
        else if (r < 2582) v = p.b_in[l * NCOL + r];
        p.binp[i] = v;
    }
    for (size_t i = gtid; i < (size_t)NL * NE * 2048; i += gthreads) {
        const int r = (int)(i % 2048); const size_t le = i / 2048;
        const int s = (r >> 7) & 1, f = (r >> 8) * 128 + (r & 127);
        p.bgup[i] = p.b_gu[le * 2048 + 2 * f + s];
    }
    for (size_t i = gtid; i < (size_t)NL * NE * 1024; i += gthreads) {
        const int k = (int)(i % 1024), e = (int)((i / 1024) % NE), l = (int)(i / (1024 * NE));
        p.rwT[i] = p.router_w[((size_t)l * 1024 + k) * NE + e];
    }
    for (size_t i = gtid; i < (size_t)NL * (NPAD - NCOL) * 1024; i += gthreads) {
        const int l = (int)(i / ((NPAD - NCOL) * 1024)); const size_t r = i % ((size_t)(NPAD - NCOL) * 1024);
        p.WinT[(size_t)l * NPAD * 1024 + (size_t)NCOL * 1024 + r] = 0;
    }
    for (size_t i = gtid; i < (size_t)NTOK * DM / 4; i += gthreads) {
        const float4 v4 = ((const float4*)p.x)[i];
        u32x2 w; w.x = pack2(v4.x, v4.y); w.y = pack2(v4.z, v4.w);
        ((u32x2*)p.xb)[i] = w;
    }
    if (bid < 4) {
        float* lf = (float*)ldsc;
        const int j = tid & 63, part = tid >> 6;
        const float* pe = p.cmp_pe + (size_t)bid * 2048; const float* w1 = p.cmp_w1 + (size_t)bid * 2048 * 64;
        float s = 0.f;
        for (int kk = part * 256; kk < part * 256 + 256; ++kk) s += pe[kk] * w1[(size_t)kk * 64 + j];
        lf[tid] = s; __syncthreads();
        if (tid < 64) { float a = 0.f; for (int q = 0; q < 8; ++q) a += lf[tid + 64 * q]; p.b1c[bid * 64 + tid] = a; }
        __syncthreads();
    }
}

namespace pg8 {
constexpr int BM = 256, BK = 64, HALF = 128, HTB = HALF * BK * 2, NXCD = 8, WGM = 8;
__device__ __forceinline__ int lds_byte(int r, int c) { const int st = (r >> 4) * 2 + (c >> 5), rr = r & 15, cc = c & 31, ob = rr * 64 + cc * 2; return st * 1024 + (ob ^ (((ob >> 9) & 1) << 5)); }
__device__ __forceinline__ void stage_rc(int b, int& R, int& C) { const int st = b / 1024, sb = b % 1024, swz = sb ^ (((sb >> 9) & 1) << 5); R = (st >> 1) * 16 + swz / 64; C = (st & 1) * 32 + (swz % 64) / 2; }
__device__ __forceinline__ bool tile_order(int i, int G, int c, int nM, int nN, int& pm, int& pn) {
    const int nwg = nM * nN; const long L = (long)i * G + c; if (L >= nwg) return false;
    int wgid = (int)L; { const int q = nwg / NXCD, r = nwg % NXCD, xcd = wgid % NXCD, off = wgid / NXCD; wgid = (xcd < r ? xcd * (q + 1) : r * (q + 1) + (xcd - r) * q) + off; }
    const int nig = WGM * nN, gid = wgid / nig, fm = gid * WGM, gsz = (nM - fm) < WGM ? (nM - fm) : WGM;
    pm = fm + ((wgid % nig) % gsz); pn = (wgid % nig) / gsz; return true;
}
template <bool FP8, int SCA, class Sched, class Epi>
__device__ __forceinline__ void gemm_phase(LAS unsigned char* lds, const char* Abase, int K, const Sched& S, const Epi& E) {
    int tid = threadIdx.x; asm volatile("" : "+v"(tid));
    const int wid = __builtin_amdgcn_readfirstlane(tid >> 6), lane = tid & 63, wr = wid >> 2, wc = wid & 3, fr = lane & 15, fq = lane >> 4;
    const int nt = K / BK;
    int R0, C0, R1, C1; stage_rc(tid * 16, R0, C0); stage_rc(tid * 16 + 8192, R1, C1);
    LAS unsigned* aofs = (LAS unsigned*)(lds + LDS_AOFF) + tid;
    aofs[8 * NTHR] = (unsigned)(R0 * K + C0) * 2u; aofs[9 * NTHR] = (unsigned)(R1 * K + C1) * 2u;
    const size_t kstep = (size_t)(BK * 2), hstep = (size_t)HALF * K * 2;
    const unsigned ldsw = (unsigned)wid * 1024u;
    const int aoff = lds_byte(wr * 64 + fr, fq * 8), boff = lds_byte(wc * 32 + fr, fq * 8);
#define PG8_SA(b, h) (((b) * 2 + (h)) * HTB)
#define PG8_SB(b, h) ((4 + (b) * 2 + (h)) * HTB)
#define PG8_STAGE_B(bufoff, gbase) do { _Pragma("unroll") for (int _i = 0; _i < 2; ++_i) \
        __builtin_amdgcn_global_load_lds((const unsigned*)((const char*)(gbase) + aofs[(8 + _i) * NTHR]), (LAS unsigned*)(lds + (bufoff) + ldsw + _i * 8192), 16, 0, 0); } while (0)
#define PG8_STAGE_A(bufoff, kbyte, sel, h) do { const unsigned o0_ = aofs[((sel) * 4 + (h) * 2) * NTHR], o1_ = aofs[((sel) * 4 + (h) * 2 + 1) * NTHR]; \
        __builtin_amdgcn_global_load_lds((const unsigned*)(Abase + (kbyte) + o0_), (LAS unsigned*)(lds + (bufoff) + ldsw), 16, 0, 0); \
        __builtin_amdgcn_global_load_lds((const unsigned*)(Abase + (kbyte) + o1_), (LAS unsigned*)(lds + (bufoff) + ldsw + 8192), 16, 0, 0); } while (0)
#define PG8_LDA(dst, b, h) do { _Pragma("unroll") for (int m = 0; m < 4; ++m) { \
        if constexpr (FP8) { const v4i_t lo_ = *(const LAS v4i_t*)(lds + PG8_SA(b, h) + aoff + m * 2048), hi_ = *(const LAS v4i_t*)(lds + PG8_SA(b, h) + aoff + m * 2048 + 1024); dst##8[m] = __builtin_shufflevector(lo_, hi_, 0, 1, 2, 3, 4, 5, 6, 7); } \
        else { _Pragma("unroll") for (int k = 0; k < 2; ++k) dst[m][k] = *(const LAS bf16x8*)(lds + PG8_SA(b, h) + aoff + m * 2048 + k * 1024); } } } while (0)
#define PG8_LDB(dst, b, h) do { _Pragma("unroll") for (int n = 0; n < 2; ++n) { \
        if constexpr (FP8) { const v4i_t lo_ = *(const LAS v4i_t*)(lds + PG8_SB(b, h) + boff + n * 2048), hi_ = *(const LAS v4i_t*)(lds + PG8_SB(b, h) + boff + n * 2048 + 1024); dst##8[n] = __builtin_shufflevector(lo_, hi_, 0, 1, 2, 3, 4, 5, 6, 7); } \
        else { _Pragma("unroll") for (int k = 0; k < 2; ++k) dst[n][k] = *(const LAS bf16x8*)(lds + PG8_SB(b, h) + boff + n * 2048 + k * 1024); } } } while (0)
#define PG8_MMA(ai, bj, At, Bt) do { __builtin_amdgcn_s_setprio(1); _Pragma("unroll") for (int m = 0; m < 4; ++m) _Pragma("unroll") for (int n = 0; n < 2; ++n) { \
        if constexpr (FP8) { acc[ai][bj][m][n] = __builtin_amdgcn_mfma_scale_f32_16x16x128_f8f6f4(Bt##8[n], At##8[m], acc[ai][bj][m][n], 0, 0, 0, SCA, 0, SCA); } \
        else { _Pragma("unroll") for (int k = 0; k < 2; ++k) acc[ai][bj][m][n] = __builtin_amdgcn_mfma_f32_16x16x32_bf16(Bt[n][k], At[m][k], acc[ai][bj][m][n], 0, 0, 0); } } \
        __builtin_amdgcn_s_setprio(0); } while (0)
#define PG8_WAIT_V(n) asm volatile("s_waitcnt vmcnt(" #n ")" ::: "memory")
#define PG8_WAIT_L(n) asm volatile("s_waitcnt lgkmcnt(" #n ")" ::: "memory")
#define PG8_BAR __builtin_amdgcn_s_barrier()
#define PG8_SCHED __builtin_amdgcn_sched_barrier(0)
    typename Sched::Unit cur, nxt; int ui = 0;
    if (!S.next(0, cur)) return;
    f32x4 acc[2][2][4][2];
#pragma unroll
    for (int a = 0; a < 2; ++a)
#pragma unroll
        for (int b = 0; b < 2; ++b)
#pragma unroll
            for (int m = 0; m < 4; ++m)
#pragma unroll
                for (int n = 0; n < 2; ++n) acc[a][b][m][n] = (f32x4){0.f, 0.f, 0.f, 0.f};
    bf16x8 At[4][2], B0[2][2], B1[2][2];
    v8i_t At8[4], B08[2], B18[2];
    { unsigned a4[2][2]; S.a_off(cur, R0, C0, R1, C1, a4); aofs[0] = a4[0][0]; aofs[NTHR] = a4[0][1]; aofs[2 * NTHR] = a4[1][0]; aofs[3 * NTHR] = a4[1][1]; }
    const char* cB = S.b_ptr(cur);
    PG8_STAGE_B(PG8_SB(0, 0), cB); PG8_STAGE_B(PG8_SB(0, 1), cB + hstep); PG8_STAGE_A(PG8_SA(0, 0), 0, 0, 0); PG8_STAGE_A(PG8_SA(0, 1), 0, 0, 1);
    if (wr == 1) PG8_BAR;
    PG8_WAIT_V(2); PG8_BAR;
    PG8_STAGE_B(PG8_SB(1, 0), cB + kstep); PG8_STAGE_A(PG8_SA(1, 0), kstep, 0, 0); PG8_STAGE_B(PG8_SB(1, 1), cB + hstep + kstep);
    PG8_WAIT_V(6); PG8_BAR;
    for (;;) {
        const bool has_next = S.next(ui + 1, nxt);
        const char* nB = cB;
        if (has_next) { int t2 = threadIdx.x; asm volatile("" : "+v"(t2)); int r0, c0, r1, c1; stage_rc(t2 * 16, r0, c0); stage_rc(t2 * 16 + 8192, r1, c1); unsigned a4[2][2]; S.a_off(nxt, r0, c0, r1, c1, a4); nB = S.b_ptr(nxt);
            aofs[4 * NTHR] = a4[0][0]; aofs[5 * NTHR] = a4[0][1]; aofs[6 * NTHR] = a4[1][0]; aofs[7 * NTHR] = a4[1][1]; }
        else { aofs[4 * NTHR] = aofs[0]; aofs[5 * NTHR] = aofs[NTHR]; aofs[6 * NTHR] = aofs[2 * NTHR]; aofs[7 * NTHR] = aofs[3 * NTHR]; }
#pragma unroll 1
        for (int t = 0; t < nt; t += 2) {
            const bool last = (t == nt - 2);
            const size_t ka1 = (size_t)(t + 1) * kstep, ka2 = last ? 0 : (size_t)(t + 2) * kstep, ka3 = ka2 + kstep;
            const char* b2 = last ? nB : cB + (size_t)(t + 2) * kstep; const char* b3 = b2 + kstep;
            const int sel = last ? 1 : 0;
            PG8_LDB(B0, 0, 0); PG8_LDB(B1, 0, 1); PG8_SCHED; PG8_LDA(At, 0, 0); PG8_STAGE_A(PG8_SA(1, 1), ka1, 0, 1);
            PG8_WAIT_V(8); PG8_WAIT_L(0); PG8_BAR; PG8_MMA(0, 0, At, B0); PG8_MMA(0, 1, At, B1); PG8_BAR; PG8_SCHED;
            PG8_LDA(At, 0, 1); PG8_STAGE_B(PG8_SB(0, 0), b2); PG8_STAGE_B(PG8_SB(0, 1), b2 + hstep); PG8_STAGE_A(PG8_SA(0, 0), ka2, sel, 0);
            PG8_WAIT_V(8); PG8_WAIT_L(0); PG8_BAR; PG8_MMA(1, 0, At, B0); PG8_MMA(1, 1, At, B1); PG8_BAR; PG8_SCHED;
            PG8_LDB(B0, 1, 0); PG8_LDB(B1, 1, 1); PG8_SCHED; PG8_LDA(At, 1, 0); PG8_STAGE_A(PG8_SA(0, 1), ka2, sel, 1);
            PG8_WAIT_V(8); PG8_WAIT_L(0); PG8_BAR; PG8_MMA(0, 0, At, B0); PG8_MMA(0, 1, At, B1); PG8_BAR; PG8_SCHED;
            PG8_LDA(At, 1, 1); PG8_STAGE_B(PG8_SB(1, 0), b3); PG8_STAGE_B(PG8_SB(1, 1), b3 + hstep); PG8_STAGE_A(PG8_SA(1, 0), ka3, sel, 0);
            PG8_WAIT_V(8); PG8_WAIT_L(0); PG8_BAR; PG8_MMA(1, 0, At, B0); PG8_MMA(1, 1, At, B1); PG8_BAR; PG8_SCHED;
        }
        if (wr == 0) PG8_BAR;
        { int t2 = threadIdx.x; asm volatile("" : "+v"(t2)); E(acc, cur, wr, wc, t2 & 15, (t2 & 63) >> 4); }
        if (!has_next) break;
#pragma unroll
        for (int a = 0; a < 2; ++a)
#pragma unroll
            for (int b = 0; b < 2; ++b)
#pragma unroll
                for (int m = 0; m < 4; ++m)
#pragma unroll
                    for (int n = 0; n < 2; ++n) acc[a][b][m][n] = (f32x4){0.f, 0.f, 0.f, 0.f};
        cur = nxt; cB = nB; ++ui;
        aofs[0] = aofs[4 * NTHR]; aofs[NTHR] = aofs[5 * NTHR]; aofs[2 * NTHR] = aofs[6 * NTHR]; aofs[3 * NTHR] = aofs[7 * NTHR];
        if (wr == 1) PG8_BAR;
    }
    PG8_WAIT_V(0);
    PG8_BAR;
#undef PG8_SA
#undef PG8_SB
#undef PG8_STAGE_A
#undef PG8_STAGE_B
#undef PG8_LDA
#undef PG8_LDB
#undef PG8_MMA
#undef PG8_WAIT_V
#undef PG8_WAIT_L
#undef PG8_BAR
#undef PG8_SCHED
}
}

struct DenseUnit { int pm, pn; };
struct DenseSched {
    typedef DenseUnit Unit;
    const char* Bt; int K, nM, nN;
    __device__ __forceinline__ bool next(int i, Unit& u) const { return pg8::tile_order(i, gridDim.x, blockIdx.x, nM, nN, u.pm, u.pn); }
    __device__ __forceinline__ void a_off(const Unit& u, int R0, int C0, int R1, int C1, unsigned (&off)[2][2]) const {
#pragma unroll
        for (int h = 0; h < 2; ++h) { off[h][0] = (unsigned)((u.pm * 256 + h * 128 + R0) * K + C0) * 2u; off[h][1] = (unsigned)((u.pm * 256 + h * 128 + R1) * K + C1) * 2u; }
    }
    __device__ __forceinline__ const char* b_ptr(const Unit& u) const { return Bt + (size_t)u.pn * 256 * K * 2; }
};
struct MoeUnit { int rbt, e, pn; };
template <bool GATHER>
struct MoeSched {
    typedef MoeUnit Unit;
    static constexpr int KP = 512;
    const char* Bt; const int* lists; const int* ptile; const int* ecnt; int nN, nrows;
    __device__ __forceinline__ bool next(int i, Unit& u) const {
        int pm, pn; if (!pg8::tile_order(i, gridDim.x, blockIdx.x, ptile[NE], nN, pm, pn)) return false;
        int e = 0; while (ptile[e + 1] <= pm) ++e;
        u.rbt = pm; u.e = e; u.pn = pn; return true;
    }
    __device__ __forceinline__ void a_off(const Unit& u, int R0, int C0, int R1, int C1, unsigned (&off)[2][2]) const {
        if (GATHER) {
            const int* lst = lists + (size_t)u.e * LIST_CAP; const int rb = u.rbt - ptile[u.e], cnt = ecnt[u.e];
#pragma unroll
            for (int h = 0; h < 2; ++h) {
                const int l0 = rb * 256 + h * 128 + R0, l1 = rb * 256 + h * 128 + R1;
                const int t0 = l0 < cnt ? (lst[l0] >> 2) : 0, t1 = l1 < cnt ? (lst[l1] >> 2) : 0;
                off[h][0] = (unsigned)(t0 * KP + C0) * 2u; off[h][1] = (unsigned)(t1 * KP + C1) * 2u;
            }
        } else {
#pragma unroll
            for (int h = 0; h < 2; ++h) { off[h][0] = (unsigned)((u.rbt * 256 + h * 128 + R0) * KP + C0) * 2u; off[h][1] = (unsigned)((u.rbt * 256 + h * 128 + R1) * KP + C1) * 2u; }
        }
    }
    __device__ __forceinline__ const char* b_ptr(const Unit& u) const { return Bt + ((size_t)u.e * nrows + (size_t)u.pn * 256) * KP * 2; }
};

struct EpiInProj {
    const Params* p; int l;
    __device__ __forceinline__ void operator()(const f32x4 (&acc)[2][2][4][2], const DenseUnit& u, int wr, int wc, int fr, int fq) const {
        const float* bias = p->binp + l * NPAD + u.pn * 256;
#pragma unroll
        for (int bj = 0; bj < 2; ++bj) {
            int vh = -1;
            if (u.pn == 2) vh = bj * 2; else if (u.pn == 5 && bj == 0) vh = 4; else if (u.pn == 8 && bj == 1) vh = 6; else if (u.pn == 9 && bj == 1) vh = 8;
#pragma unroll
            for (int n = 0; n < 2; ++n) {
                const int c = bj * 128 + wc * 32 + n * 16 + 4 * fq;
                const f32x4 bv = *(const f32x4*)(bias + c);
#pragma unroll
                for (int ai = 0; ai < 2; ++ai)
#pragma unroll
                    for (int m = 0; m < 4; ++m) {
                        const int row = u.pm * 256 + ai * 128 + wr * 64 + m * 16 + fr;
                        const f32x4 v = acc[ai][bj][m][n] + bv;
                        u32x2 w; w.x = pack2(v[0], v[1]); w.y = pack2(v[2], v[3]);
                        *(u32x2*)(p->hb + (size_t)row * NMAIN + u.pn * 256 + c) = w;
                        if (vh >= 0) {
                            const int b = row >> 11, s = row & 2047, hh = vh + ((c & 127) >> 6), d = c & 63;
                            bf16_t* vt = p->vT + (((size_t)b * NVH + hh) * 64 + d) * SEQ + s;
                            vt[0] = (bf16_t)(w.x & 0xffff); vt[SEQ] = (bf16_t)(w.x >> 16); vt[2 * SEQ] = (bf16_t)(w.y & 0xffff); vt[3 * SEQ] = (bf16_t)(w.y >> 16);
                        }
                    }
            }
        }
    }
};
struct EpiOutProj {
    const float* xin; float* t;
    __device__ __forceinline__ void operator()(const f32x4 (&acc)[2][2][4][2], const DenseUnit& u, int wr, int wc, int fr, int fq) const {
#pragma unroll
        for (int ai = 0; ai < 2; ++ai)
#pragma unroll
            for (int m = 0; m < 4; ++m) {
                const size_t rowoff = (size_t)(u.pm * 256 + ai * 128 + wr * 64 + m * 16 + fr) * DM + u.pn * 256 + wc * 32 + 4 * fq;
#pragma unroll
                for (int bj = 0; bj < 2; ++bj)
#pragma unroll
                    for (int n = 0; n < 2; ++n) {
                        const size_t off = rowoff + bj * 128 + n * 16;
                        const f32x4 xv = *(const f32x4*)(xin + off);
                        *(f32x4*)(t + off) = xv * ALPHA + acc[ai][bj][m][n];
                    }
            }
    }
};
struct EpiGateUp {
    bf16_t* act; const float* bgup;
    __device__ __forceinline__ void operator()(const f32x4 (&acc)[2][2][4][2], const MoeUnit& u, int wr, int wc, int fr, int fq) const {
        const float* bias = bgup + (size_t)u.e * 2048 + u.pn * 256;
#pragma unroll
        for (int n = 0; n < 2; ++n) {
            const int c = wc * 32 + n * 16 + 4 * fq;
            const f32x4 bg = *(const f32x4*)(bias + c), bu = *(const f32x4*)(bias + 128 + c);
#pragma unroll
            for (int ai = 0; ai < 2; ++ai)
#pragma unroll
                for (int m = 0; m < 4; ++m) {
                    const f32x4 g4 = acc[ai][0][m][n] + bg, u4 = acc[ai][1][m][n] + bu;
                    float o[4];
#pragma unroll
                    for (int j = 0; j < 4; ++j) {
                        const float g = fminf(g4[j], 7.0f), uu = fminf(fmaxf(u4[j], -7.0f), 7.0f);
                        const float glu = g * __builtin_amdgcn_rcpf(1.0f + __builtin_amdgcn_exp2f(-2.455466929f * g));
                        o[j] = (uu + 1.0f) * glu;
                    }
                    *(unsigned*)((char*)act + (size_t)(u.rbt * 256 + ai * 128 + wr * 64 + m * 16 + fr) * DFF + u.pn * 128 + c) = pack4_fp8(o[0], o[1], o[2], o[3]);
                }
        }
    }
};
struct EpiDown {
    bf16_t* ybuf; const float* bdn;
    __device__ __forceinline__ void operator()(const f32x4 (&acc)[2][2][4][2], const MoeUnit& u, int wr, int wc, int fr, int fq) const {
        const float* bias = bdn + (size_t)u.e * 1024 + u.pn * 256;
#pragma unroll
        for (int bj = 0; bj < 2; ++bj)
#pragma unroll
            for (int n = 0; n < 2; ++n) {
                const int c = bj * 128 + wc * 32 + n * 16 + 4 * fq;
                const f32x4 bv = *(const f32x4*)(bias + c);
#pragma unroll
                for (int ai = 0; ai < 2; ++ai)
#pragma unroll
                    for (int m = 0; m < 4; ++m) {
                        const f32x4 v = acc[ai][bj][m][n] + bv;
                        u32x2 w; w.x = pack2(v[0], v[1]); w.y = pack2(v[2], v[3]);
                        *(u32x2*)(ybuf + (size_t)(u.rbt * 256 + ai * 128 + wr * 64 + m * 16 + fr) * DM + u.pn * 256 + c) = w;
                    }
            }
    }
};

__device__ __forceinline__ void phase_inproj(const Params& p, int l, char* lds) {
    DenseSched S{(const char*)(p.WinT + (size_t)l * NPAD * 1024), 1024, NTOK / 256, NMAIN / 256};
    EpiInProj E{&p, l};
    pg8::gemm_phase<false, 0>((LAS unsigned char*)lds, (const char*)p.xb, 1024, S, E);
    int tid = threadIdx.x; asm volatile("" : "+v"(tid));
    const int wid = tid >> 6, lane = tid & 63, fr = lane & 15, fq = lane >> 4;
    const bf16_t* W = p.WinT + ((size_t)l * NPAD + NMAIN) * 1024;
    const float* bias = p.binp + l * NPAD + NMAIN;
    for (int u = blockIdx.x * NWV + wid; u < NTOK / 16; u += gridDim.x * NWV) {
        const bf16_t* ar = p.xb + (size_t)(u * 16 + fr) * DM + fq * 8;
        const bf16_t* w0 = W + (size_t)fr * 1024 + fq * 8; const bf16_t* w1 = W + (size_t)(16 + fr) * 1024 + fq * 8;
        f32x4 a0 = (f32x4){0.f, 0.f, 0.f, 0.f}, a1 = a0;
#pragma unroll 4
        for (int ks = 0; ks < 32; ++ks) {
            const bf16x8 a = *(const bf16x8*)(ar + ks * 32);
            a0 = __builtin_amdgcn_mfma_f32_16x16x32_bf16(a, *(const bf16x8*)(w0 + ks * 32), a0, 0, 0, 0);
            a1 = __builtin_amdgcn_mfma_f32_16x16x32_bf16(a, *(const bf16x8*)(w1 + ks * 32), a1, 0, 0, 0);
        }
#pragma unroll
        for (int r = 0; r < 4; ++r) {
            float* dst = p.hs + (size_t)(u * 16 + fq * 4 + r) * HS_W;
            dst[fr] = a0[r] + bias[fr];
            if (fr < 6) dst[16 + fr] = a1[r] + bias[16 + fr];
        }
    }
}
__device__ __forceinline__ void phase_outproj(const Params& p, int l, const float* xin, char* lds) {
    DenseSched S{(const char*)(p.WoT + (size_t)l * 1024 * 1024), 1024, NTOK / 256, 4};
    EpiOutProj E{xin, p.tbuf};
    pg8::gemm_phase<false, 0>((LAS unsigned char*)lds, (const char*)p.ob, 1024, S, E);
}
__device__ __forceinline__ void build_tiles(const Params& p, int l, int* ptile, int* ecnt) {
    if (threadIdx.x < NE) ecnt[threadIdx.x] = (int)__hip_atomic_load(p.ctrl + 64 + l * NE + threadIdx.x, __ATOMIC_RELAXED, __HIP_MEMORY_SCOPE_AGENT);
    __syncthreads();
    if (threadIdx.x == 0) { int s = 0; for (int e = 0; e < NE; ++e) { ptile[e] = s; s += (ecnt[e] + 255) >> 8; } ptile[NE] = s; }
    __syncthreads();
}
__device__ __forceinline__ void phase_gateup(const Params& p, int l, char* lds) {
    int* ptile = (int*)(lds + LDS_TAB); int* ecnt = ptile + 40;
    build_tiles(p, l, ptile, ecnt);
    MoeSched<true> S{(const char*)p.WguT + (size_t)l * NE * 2048 * 1024, p.lists, ptile, ecnt, 8, 2048};
    EpiGateUp E{p.act, p.bgup + (size_t)l * NE * 2048};
    pg8::gemm_phase<true, 0x7c7c7c7c>((LAS unsigned char*)lds, (const char*)p.x1b, 512, S, E);
}
__device__ __forceinline__ void phase_down(const Params& p, int l, char* lds) {
    int* ptile = (int*)(lds + LDS_TAB); int* ecnt = ptile + 40;
    build_tiles(p, l, ptile, ecnt);
    MoeSched<false> S{(const char*)p.WdnT + (size_t)l * NE * 1024 * 1024, p.lists, ptile, ecnt, 4, 1024};
    EpiDown E{p.ybuf, p.b_dn + (size_t)l * NE * 1024};
    pg8::gemm_phase<true, 0x7c7c7c7c>((LAS unsigned char*)lds, (const char*)p.act, 512, S, E);
}

__device__ __forceinline__ float gelu_tanh(float x) {
    const float u = 0.7978845608028654f * (x + 0.044715f * x * x * x);
    const float e = __expf(-2.0f * fabsf(u)); const float th = (1.0f - e) / (1.0f + e);
    return 0.5f * x * (1.0f + (u < 0.f ? -th : th));
}
__device__ __forceinline__ void phase_prep(const Params& p, int l, char* lds) {
    int tid = threadIdx.x; asm volatile("" : "+v"(tid));
    const int wid = tid >> 6, lane = tid & 63, fr = lane & 15, fq = lane >> 4;
    const int gw = blockIdx.x * NWV + wid, nw = gridDim.x * NWV;
    for (int u = (int)gridDim.x - 1 - (int)blockIdx.x; u < NB * 4; u += gridDim.x) {
        const int b = u >> 2, h = u & 3;
        const float* srcp = p.hs + ((size_t)b * SEQ + tid * 4) * HS_W + h;
        float ls[4]; float tot = 0.f;
#pragma unroll
        for (int i = 0; i < 4; ++i) { const float f = srcp[(size_t)i * HS_W]; ls[i] = fminf(f, 0.f) - log1pf(__expf(-fabsf(f))); tot += ls[i]; }
        float inc = tot;
#pragma unroll
        for (int o = 1; o < 64; o <<= 1) { const float v = __shfl_up(inc, o); if (lane >= o) inc += v; }
        float* wtot = (float*)(lds + 65536);
        if (lane == 63) wtot[wid] = inc;
        __syncthreads();
        float base = inc - tot;
        for (int w = 0; w < wid; ++w) base += wtot[w];
        float4 o4; o4.x = base + ls[0]; o4.y = o4.x + ls[1]; o4.z = o4.y + ls[2]; o4.w = o4.z + ls[3];
        *(float4*)(p.cF + (size_t)u * SEQ + tid * 4) = o4;
        __syncthreads();
    }
    float* part = (float*)lds;
    bf16_t* h1 = (bf16_t*)(lds + 32768);
    for (int u = blockIdx.x; u < NB * 2 * 2 * 8; u += gridDim.x) {
        const int ct = u & 7, which = (u >> 3) & 1, kvh = (u >> 4) & 1, b = u >> 5;
        const int colo = (which ? C_NVC : C_NKC) + kvh * 64;
        const int c_lane = ct * 16 + fr;
        const int tokbase = min(c_lane, 126) * 16;
        const bf16_t* arow = p.hb + ((size_t)b * SEQ + tokbase) * NMAIN + colo + fq * 8;
        const bf16_t* w1 = p.W1T + ((size_t)(l * 2 + which) * 64 + fr) * 2048 + fq * 8;
        f32x4 acc[4];
#pragma unroll
        for (int n = 0; n < 4; ++n) acc[n] = (f32x4){0.f, 0.f, 0.f, 0.f};
#pragma unroll
        for (int kk = 0; kk < 8; ++kk) {
            const int ks = wid * 8 + kk;
            const bf16x8 a = *(const bf16x8*)(arow + (size_t)(ks >> 1) * NMAIN + (ks & 1) * 32);
#pragma unroll
            for (int n = 0; n < 4; ++n) {
                const bf16x8 bb = *(const bf16x8*)(w1 + (size_t)n * 16 * 2048 + ks * 32);
                acc[n] = __builtin_amdgcn_mfma_f32_16x16x32_bf16(a, bb, acc[n], 0, 0, 0);
            }
        }
#pragma unroll
        for (int n = 0; n < 4; ++n)
#pragma unroll
            for (int r = 0; r < 4; ++r) part[wid * 1024 + (fq * 4 + r) * 64 + n * 16 + fr] = acc[n][r];
        __syncthreads();
        const float* b1 = p.b1c + (l * 2 + which) * 64;
#pragma unroll
        for (int i = 0; i < 2; ++i) {
            const int e = tid + NTHR * i; float sum = 0.f;
#pragma unroll
            for (int w = 0; w < 8; ++w) sum += part[w * 1024 + e];
            h1[e] = f2bf(gelu_tanh(sum + b1[e & 63]));
        }
        __syncthreads();
        if (wid == 0) {
            const bf16_t* w2 = p.W2T + ((size_t)(l * 2 + which) * 64 + fr) * 64 + fq * 8;
            f32x4 o2[4];
#pragma unroll
            for (int n = 0; n < 4; ++n) o2[n] = (f32x4){0.f, 0.f, 0.f, 0.f};
#pragma unroll
            for (int ks = 0; ks < 2; ++ks) {
                const bf16x8 a = *(const bf16x8*)(h1 + fr * 64 + ks * 32 + fq * 8);
#pragma unroll
                for (int n = 0; n < 4; ++n) {
                    const bf16x8 bb = *(const bf16x8*)(w2 + (size_t)n * 16 * 64 + ks * 32);
                    o2[n] = __builtin_amdgcn_mfma_f32_16x16x32_bf16(a, bb, o2[n], 0, 0, 0);
                }
            }
            const size_t base = ((size_t)b * 2 + kvh) * 128 * 64;
#pragma unroll
            for (int n = 0; n < 4; ++n)
#pragma unroll
                for (int r = 0; r < 4; ++r) {
                    const int c = ct * 16 + fq * 4 + r, j2 = n * 16 + fr;
                    const bf16_t v = c < 127 ? f2bf(o2[n][r]) : (bf16_t)0;
                    if (which == 0) p.kc[base + (size_t)c * 64 + j2] = v;
                    else { p.vc[base + (size_t)c * 64 + j2] = v; p.vcT[base + (size_t)j2 * 128 + c] = v; }
                }
        }
        __syncthreads();
    }
}

constexpr float L2E = 1.4426950408889634f, MASKV = -1e30f, SCL2 = QSCALE * L2E;
struct KVFrag { bf16x8 k[2][2]; bf16x8 v[4]; };
__device__ __forceinline__ void k_load(KVFrag& f, const bf16_t* __restrict__ Kb, size_t ldk, int kc0, int fr, int fq) {
    const bf16_t* kp = Kb + (size_t)(kc0 + (fr >> 2) * 8 + (fr & 3)) * ldk + fq * 8;
    f.k[0][0] = *(const bf16x8*)(kp); f.k[0][1] = *(const bf16x8*)(kp + 32);
    f.k[1][0] = *(const bf16x8*)(kp + 4 * ldk); f.k[1][1] = *(const bf16x8*)(kp + 4 * ldk + 32);
}
__device__ __forceinline__ void v_load(bf16x8 (&v)[4], const bf16_t* __restrict__ VTb, size_t ldv, int kc0, int fr, int fq) {
    const bf16_t* vp = VTb + (size_t)fr * ldv + kc0 + fq * 8;
#pragma unroll
    for (int dt = 0; dt < 4; ++dt) v[dt] = *(const bf16x8*)(vp + (size_t)dt * 16 * ldv);
}
template <int NQT, bool MASK, class MB>
__device__ __forceinline__ void attn_compute(const KVFrag& f, const bf16x8 (&qf)[NQT][2], f32x4 (&o)[NQT][4], float (&m)[NQT], float (&l)[NQT], const MB& mb) {
#pragma unroll
    for (int qt = 0; qt < NQT; ++qt) {
        f32x4 s0 = (f32x4){0.f, 0.f, 0.f, 0.f}, s1 = s0;
        s0 = __builtin_amdgcn_mfma_f32_16x16x32_bf16(f.k[0][0], qf[qt][0], s0, 0, 0, 0);
        s0 = __builtin_amdgcn_mfma_f32_16x16x32_bf16(f.k[0][1], qf[qt][1], s0, 0, 0, 0);
        s1 = __builtin_amdgcn_mfma_f32_16x16x32_bf16(f.k[1][0], qf[qt][0], s1, 0, 0, 0);
        s1 = __builtin_amdgcn_mfma_f32_16x16x32_bf16(f.k[1][1], qf[qt][1], s1, 0, 0, 0);
        float v[8];
#pragma unroll
        for (int j = 0; j < 4; ++j) { v[j] = mb(qt, j, s0[j]); v[j + 4] = mb(qt, j + 4, s1[j]); }
        float mx = fmaxf(fmaxf(fmaxf(v[0], v[1]), fmaxf(v[2], v[3])), fmaxf(fmaxf(v[4], v[5]), fmaxf(v[6], v[7])));
        mx = fmaxf(mx, __shfl_xor(mx, 16)); mx = fmaxf(mx, __shfl_xor(mx, 32));
        const float mold = m[qt], mnew = fmaxf(mold, mx);
        m[qt] = mnew;
        float pr[8]; float ps = 0.f;
#pragma unroll
        for (int j = 0; j < 8; ++j) { pr[j] = (!MASK || v[j] > -1e29f) ? __builtin_amdgcn_exp2f(v[j] - mnew) : 0.f; ps += pr[j]; }
        if (__ballot(mnew != mold) != 0ull) {
            const float alpha = __builtin_amdgcn_exp2f(mold - mnew);
            l[qt] *= alpha;
#pragma unroll
            for (int dt = 0; dt < 4; ++dt) o[qt][dt] *= alpha;
        }
        l[qt] += ps;
        union { bf16x8 v8; unsigned u[4]; } pf;
        pf.u[0] = pack2(pr[0], pr[1]); pf.u[1] = pack2(pr[2], pr[3]); pf.u[2] = pack2(pr[4], pr[5]); pf.u[3] = pack2(pr[6], pr[7]);
#pragma unroll
        for (int dt = 0; dt < 4; ++dt) o[qt][dt] = __builtin_amdgcn_mfma_f32_16x16x32_bf16(f.v[dt], pf.v8, o[qt][dt], 0, 0, 0);
        __builtin_amdgcn_sched_barrier(0);
    }
}
struct RangeIt { int c, c_hi; __device__ __forceinline__ int nxt() { if (c > c_hi) return -1; return (c++) * 32; } };
struct MaskIt { unsigned long long cm; __device__ __forceinline__ int nxt() { if (!cm) return -1; const int i = __builtin_ctzll(cm); cm &= cm - 1; return i * 32; } };
template <bool PFV, class It, class Gen>
__device__ __forceinline__ void attn_run(It& it, const bf16_t* Kb, size_t ldk, const bf16_t* VTb, size_t ldv, int fr, int fq, const Gen& gen) {
    KVFrag fa, fb;
    int ka = it.nxt(); if (ka < 0) return;
    k_load(fa, Kb, ldk, ka, fr, fq); if (PFV) v_load(fa.v, VTb, ldv, ka, fr, fq);
    for (;;) {
        const int kb = it.nxt(); if (kb >= 0) { k_load(fb, Kb, ldk, kb, fr, fq); if (PFV) v_load(fb.v, VTb, ldv, kb, fr, fq); }
        if (!PFV) v_load(fa.v, VTb, ldv, ka, fr, fq);
        gen(ka, fa);
        if (kb < 0) break;
        ka = it.nxt(); if (ka >= 0) { k_load(fa, Kb, ldk, ka, fr, fq); if (PFV) v_load(fa.v, VTb, ldv, ka, fr, fq); }
        if (!PFV) v_load(fb.v, VTb, ldv, kb, fr, fq);
        gen(kb, fb);
        if (ka < 0) break;
    }
}
template <int NQT>
__device__ __forceinline__ void attn_init(f32x4 (&o)[NQT][4], float (&m)[NQT], float (&l)[NQT]) {
#pragma unroll
    for (int qt = 0; qt < NQT; ++qt) { m[qt] = MASKV; l[qt] = 0.f;
#pragma unroll
        for (int dt = 0; dt < 4; ++dt) o[qt][dt] = (f32x4){0.f, 0.f, 0.f, 0.f}; }
}
__device__ __forceinline__ float lsum4(float l) { l += __shfl_xor(l, 16); l += __shfl_xor(l, 32); return l; }
__device__ __forceinline__ void store_o4(bf16_t* dst, const f32x4 v) { u32x2 w; w.x = pack2(v[0], v[1]); w.y = pack2(v[2], v[3]); *(u32x2*)dst = w; }
__device__ __forceinline__ float sigmoidf_fast(float x) { return __builtin_amdgcn_rcpf(1.0f + __builtin_amdgcn_exp2f(-L2E * x)); }

__device__ __forceinline__ void fox_unit(const Params& p, int b, int h, int qb, int fr, int fq) {
    asm volatile("" : "+v"(fr), "+v"(fq));
    const int t0 = qb * 32;
    const bf16_t* Qb = p.hb + ((size_t)b * SEQ + t0) * NMAIN + C_FQ + h * 64 + fq * 8;
    bf16x8 qf[2][2];
#pragma unroll
    for (int qt = 0; qt < 2; ++qt) { qf[qt][0] = *(const bf16x8*)(Qb + (size_t)(qt * 16 + fr) * NMAIN); qf[qt][1] = *(const bf16x8*)(Qb + (size_t)(qt * 16 + fr) * NMAIN + 32); }
    const float* cf = p.cF + ((size_t)b * 4 + h) * SEQ;
    float cq[2];
#pragma unroll
    for (int qt = 0; qt < 2; ++qt) cq[qt] = cf[t0 + qt * 16 + fr] * L2E;
    f32x4 o[2][4]; float m[2], l[2];
    attn_init<2>(o, m, l);
    const bf16_t* Kb = p.hb + (size_t)b * SEQ * NMAIN + C_FK + h * 64;
    const bf16_t* VTb = p.vT + ((size_t)b * NVH + h) * 64 * SEQ;
    RangeIt it{0, t0 >> 5};
    attn_run<true>(it, Kb, NMAIN, VTb, SEQ, fr, fq, [&](int kc0, const KVFrag& f) {
        const float4 ca = *(const float4*)(cf + kc0 + 8 * fq), cb = *(const float4*)(cf + kc0 + 8 * fq + 4);
        const float ck[8] = {ca.x * L2E, ca.y * L2E, ca.z * L2E, ca.w * L2E, cb.x * L2E, cb.y * L2E, cb.z * L2E, cb.w * L2E};
        const int kq = kc0 + 8 * fq - t0 - fr;
        attn_compute<2, true>(f, qf, o, m, l, [&](int qt, int j, float raw) { return (kq + j - 16 * qt) > 0 ? MASKV : raw * SCL2 + cq[qt] - ck[j]; });
    });
#pragma unroll
    for (int qt = 0; qt < 2; ++qt) {
        const float inv = __builtin_amdgcn_rcpf(lsum4(l[qt]));
        bf16_t* dst = p.ob + ((size_t)b * SEQ + t0 + qt * 16 + fr) * DM + h * 64 + 4 * fq;
#pragma unroll
        for (int dt = 0; dt < 4; ++dt) store_o4(dst + dt * 16, o[qt][dt] * inv);
    }
}
__device__ __forceinline__ void swa_unit(const Params& p, int l_, int b, int kv, int pos, int fr, int fq) {
    asm volatile("" : "+v"(fr), "+v"(fq));
    const int t0 = pos * 16, t = t0 + fr;
    const bf16_t* Qb = p.hb + ((size_t)b * SEQ + t) * NMAIN + C_SQ + kv * 192 + fq * 8;
    bf16x8 qf[3][2];
#pragma unroll
    for (int g = 0; g < 3; ++g) { qf[g][0] = *(const bf16x8*)(Qb + g * 64); qf[g][1] = *(const bf16x8*)(Qb + g * 64 + 32); }
    float sl[3];
#pragma unroll
    for (int g = 0; g < 3; ++g) sl[g] = slope_swa(kv * 3 + g) * L2E;
    f32x4 o[3][4]; float m[3], l[3];
    attn_init<3>(o, m, l);
    const bf16_t* Kb = p.hb + (size_t)b * SEQ * NMAIN + C_SK + kv * 64;
    const bf16_t* VTb = p.vT + ((size_t)b * NVH + 4 + kv) * 64 * SEQ;
    RangeIt it{max(0, t0 - 127) >> 5, (t0 + 15) >> 5};
    attn_run<true>(it, Kb, NMAIN, VTb, SEQ, fr, fq, [&](int kc0, const KVFrag& f) {
        const int dq = t - kc0 - 8 * fq;
        attn_compute<3, true>(f, qf, o, m, l, [&](int g, int j, float raw) { const int dist = dq - j; return (dist >= 0 && dist < 128) ? raw * SCL2 - sl[g] * (float)dist : MASKV; });
    });
#pragma unroll
    for (int g = 0; g < 3; ++g) {
        const float sink = p.sinks[l_ * 6 + kv * 3 + g] * L2E;
        const float inv = __builtin_amdgcn_rcpf(lsum4(l[g]) + __builtin_amdgcn_exp2f(sink - m[g]));
        bf16_t* dst = p.ob + ((size_t)b * SEQ + t) * DM + 256 + (kv * 3 + g) * 64 + 4 * fq;
#pragma unroll
        for (int dt = 0; dt < 4; ++dt) store_o4(dst + dt * 16, o[g][dt] * inv);
    }
}
__device__ __forceinline__ void nsa_unit(const Params& p, int b, int kv, int pos, int fr, int fq, int lane, float* ps, unsigned* msk, float* otl) {
    asm volatile("" : "+v"(fr), "+v"(fq), "+v"(lane));
    const int t0 = pos * 16, t = t0 + fr, cur = t0 >> 6;
    const bf16_t* Qb = p.hb + ((size_t)b * SEQ + t) * NMAIN + C_NQ + kv * 192 + fq * 8;
    bf16x8 qf[3][2];
#pragma unroll
    for (int g = 0; g < 3; ++g) { qf[g][0] = *(const bf16x8*)(Qb + g * 64); qf[g][1] = *(const bf16x8*)(Qb + g * 64 + 32); }
    float sl[3];
#pragma unroll
    for (int g = 0; g < 3; ++g) sl[g] = slope_nsa(kv * 3 + g) * L2E;
    const float* gl = p.hs + ((size_t)b * SEQ + t) * HS_W + 4 + kv * 9;
    f32x4 o[3][4]; float m[3], l[3];
    f32x4* otv = (f32x4*)otl + lane;
#pragma unroll
    for (int i = 0; i < 8; ++i) ps[lane + 64 * i] = 0.f;
    {
        const bf16_t* Kb = p.kc + ((size_t)b * 2 + kv) * 128 * 64;
        const bf16_t* VTb = p.vcT + ((size_t)b * 2 + kv) * 64 * 128;
        const int ncv = (t0 + 15 >= 31) ? ((t0 + 15 - 31) >> 4) + 1 : 0;
        const int nch = (ncv + 31) >> 5;
        attn_init<3>(o, m, l);
        const int dq0 = t - 31 - 16 * 8 * fq;
        RangeIt it{0, nch - 1};
        attn_run<false>(it, Kb, 64, VTb, 128, fr, fq, [&](int kc0, const KVFrag& f) {
            const int dq = dq0 - 16 * kc0;
            attn_compute<3, true>(f, qf, o, m, l, [&](int g, int j, float raw) { const int dist = dq - 16 * j; return dist >= 0 ? raw * SCL2 - sl[g] * (float)dist : MASKV; });
        });
        float il[3];
#pragma unroll
        for (int g = 0; g < 3; ++g) {
            const float lt = lsum4(l[g]); il[g] = lt > 0.f ? __builtin_amdgcn_rcpf(lt) : 0.f;
            const float gate = sigmoidf_fast(gl[g * 3 + 0]);
#pragma unroll
            for (int dt = 0; dt < 4; ++dt) otv[(g * 4 + dt) * 64] = o[g][dt] * (il[g] * gate);
        }
        float carry_prev = 0.f;
        for (int c = 0; c < nch; ++c) {
            const int kc0 = c * 32, dq = dq0 - 16 * kc0;
            const bf16_t* kp = Kb + (size_t)(kc0 + (fr >> 2) * 8 + (fr & 3)) * 64 + fq * 8;
            const bf16x8 k00 = *(const bf16x8*)(kp), k01 = *(const bf16x8*)(kp + 32), k10 = *(const bf16x8*)(kp + 256), k11 = *(const bf16x8*)(kp + 256 + 32);
            float pc[8];
#pragma unroll
            for (int j = 0; j < 8; ++j) pc[j] = 0.f;
#pragma unroll
            for (int g = 0; g < 3; ++g) {
                f32x4 s0 = (f32x4){0.f, 0.f, 0.f, 0.f}, s1 = s0;
                s0 = __builtin_amdgcn_mfma_f32_16x16x32_bf16(k00, qf[g][0], s0, 0, 0, 0); s0 = __builtin_amdgcn_mfma_f32_16x16x32_bf16(k01, qf[g][1], s0, 0, 0, 0);
                s1 = __builtin_amdgcn_mfma_f32_16x16x32_bf16(k10, qf[g][0], s1, 0, 0, 0); s1 = __builtin_amdgcn_mfma_f32_16x16x32_bf16(k11, qf[g][1], s1, 0, 0, 0);
#pragma unroll
                for (int j = 0; j < 8; ++j) {
                    const int dist = dq - 16 * j; const float raw = j < 4 ? s0[j] : s1[j - 4];
                    if (dist >= 0) pc[j] += __builtin_amdgcn_exp2f(raw * SCL2 - sl[g] * (float)dist - m[g]) * il[g];
                }
            }
            const float cout = 0.5f * pc[7];
            float cin = __shfl_up(cout, 16);
            const float cwrap = __shfl(cout, fr + 48);
            if (fq == 0) cin = carry_prev;
            carry_prev = cwrap;
            const int n0 = (kc0 >> 2) + 2 * fq;
            ps[fr * 32 + n0] = cin + pc[0] + pc[1] + pc[2] + 0.5f * pc[3];
            ps[fr * 32 + n0 + 1] = 0.5f * pc[3] + pc[4] + pc[5] + pc[6] + 0.5f * pc[7];
        }
    }
    lds_wave_sync();
    if (lane < 16) {
        unsigned mask = 1u | (1u << cur); if (cur >= 1) mask |= 1u << (cur - 1);
        if (cur >= 3) {
            if (cur - 2 <= 5) mask |= (1u << (cur - 1)) - 2u;
            else {
                const float* my = ps + lane * 32;
                for (int r = 0; r < 5; ++r) {
                    float best = -1.0f; int bi = 1;
                    for (int j = 1; j <= cur - 2; ++j) { const float v = my[j]; if (!((mask >> j) & 1u) && v > best) { best = v; bi = j; } }
                    mask |= 1u << bi;
                }
            }
        }
        msk[lane] = mask;
    }
    lds_wave_sync();
    const unsigned qmask = msk[fr];
    lds_wave_sync();
    {
        const bf16_t* Kb = p.hb + (size_t)b * SEQ * NMAIN + C_NKS + kv * 64;
        const bf16_t* VTb = p.vT + ((size_t)b * NVH + 6 + kv) * 64 * SEQ;
        attn_init<3>(o, m, l);
        unsigned um = qmask;
        um |= __shfl_xor(um, 1); um |= __shfl_xor(um, 2); um |= __shfl_xor(um, 4); um |= __shfl_xor(um, 8);
        um = (unsigned)__builtin_amdgcn_readfirstlane((int)um) & (cur >= 31 ? 0xffffffffu : ((2u << cur) - 1u));
        unsigned long long cm = 0ull;
        for (unsigned r = um; r; r &= r - 1) { const int kb = __builtin_ctz(r); cm |= 3ull << (2 * kb); }
        MaskIt it{cm};
        attn_run<false>(it, Kb, NMAIN, VTb, SEQ, fr, fq, [&](int kc0, const KVFrag& f) {
            const bool mine = (qmask >> (kc0 >> 6)) & 1u;
            const int dq = t - kc0 - 8 * fq;
            attn_compute<3, true>(f, qf, o, m, l, [&](int g, int j, float raw) { const int dist = dq - j; return (mine && dist >= 0) ? raw * SCL2 - sl[g] * (float)dist : MASKV; });
        });
#pragma unroll
        for (int g = 0; g < 3; ++g) {
            const float lt = lsum4(l[g]); const float sc = (lt > 0.f ? __builtin_amdgcn_rcpf(lt) : 0.f) * sigmoidf_fast(gl[g * 3 + 1]);
#pragma unroll
            for (int dt = 0; dt < 4; ++dt) otv[(g * 4 + dt) * 64] += o[g][dt] * sc;
        }
    }
    {
        const bf16_t* Kb = p.hb + (size_t)b * SEQ * NMAIN + C_NKW + kv * 64;
        const bf16_t* VTb = p.vT + ((size_t)b * NVH + 8 + kv) * 64 * SEQ;
        attn_init<3>(o, m, l);
        RangeIt it{max(0, t0 - 511) >> 5, (t0 + 15) >> 5};
        attn_run<false>(it, Kb, NMAIN, VTb, SEQ, fr, fq, [&](int kc0, const KVFrag& f) {
            const int dq = t - kc0 - 8 * fq;
            attn_compute<3, true>(f, qf, o, m, l, [&](int g, int j, float raw) { const int dist = dq - j; return (dist >= 0 && dist < 512) ? raw * SCL2 - sl[g] * (float)dist : MASKV; });
        });
#pragma unroll
        for (int g = 0; g < 3; ++g) {
            const float lt = lsum4(l[g]); const float sc = (lt > 0.f ? __builtin_amdgcn_rcpf(lt) : 0.f) * sigmoidf_fast(gl[g * 3 + 2]);
            bf16_t* dst = p.ob + ((size_t)b * SEQ + t) * DM + 640 + (kv * 3 + g) * 64 + 4 * fq;
#pragma unroll
            for (int dt = 0; dt < 4; ++dt) store_o4(dst + dt * 16, otv[(g * 4 + dt) * 64] + o[g][dt] * sc);
        }
    }
}

__device__ __forceinline__ void phase_attn(const Params& p, int l, char* lds, int cslot = 16) {
    int tid = threadIdx.x; asm volatile("" : "+v"(tid));
    const int wid = tid >> 6, lane = tid & 63, fr = lane & 15, fq = lane >> 4;
    float* ps = (float*)(lds + wid * 14592); unsigned* msk = (unsigned*)(ps + 512); float* otl = ps + 576;
    unsigned* ctr = p.ctrl + cslot + l;
    constexpr unsigned NU_NSA = NB * 2 * 128, NU_FOX = NB * 4 * 64, NU_SWA = NB * 2 * 128;
    for (;;) {
        unsigned u = 0;
        if (lane == 0) u = __hip_atomic_fetch_add(ctr, 1u, __ATOMIC_RELAXED, __HIP_MEMORY_SCOPE_AGENT);
        u = (unsigned)__builtin_amdgcn_readfirstlane((int)u);
        if (u >= NU_NSA + NU_FOX + NU_SWA) break;
        if (u < NU_NSA) { const int pos = 127 - (int)(u >> 5), r = u & 31; nsa_unit(p, r >> 1, r & 1, pos, fr, fq, lane, ps, msk, otl); }
        else if (u < NU_NSA + NU_FOX) { const unsigned v = u - NU_NSA; const int qb = 63 - (int)(v >> 6), r = v & 63; fox_unit(p, r >> 2, r & 3, qb, fr, fq); }
        else { const unsigned v = u - NU_NSA - NU_FOX; const int pos = 127 - (int)(v >> 5), r = v & 31; swa_unit(p, l, r >> 1, r & 1, pos, fr, fq); }
    }
}

__device__ __forceinline__ void phase_ln1_router(const Params& p, int l, char* lds) {
    int tid = threadIdx.x; asm volatile("" : "+v"(tid));
    const int wid = tid >> 6, lane = tid & 63, fr = lane & 15, fq = lane >> 4;
    float* lg = (float*)lds + wid * 512;
    int* lcnt = (int*)(lds + 16384); int* lbase = lcnt + 32;
    const float* g1 = p.ln1_g + l * DM; const float* b1 = p.ln1_b + l * DM;
    const float* rw = p.rwT + (size_t)l * NE * 1024; const float* rb = p.router_b + l * NE;
    unsigned* gcount = p.ctrl + 64 + l * NE;
    for (int grp = blockIdx.x; grp < NTOK / 128; grp += gridDim.x) {
        const int tok0 = grp * 128 + wid * 16;
        if (tid < 32) lcnt[tid] = 0;
        float4 gg[4], bb[4];
#pragma unroll
        for (int j = 0; j < 4; ++j) { gg[j] = *(const float4*)(g1 + j * 256 + lane * 4); bb[j] = *(const float4*)(b1 + j * 256 + lane * 4); }
        for (int r0 = 0; r0 < 16; r0 += 4) {
            float4 v[4][4]; float s[4], qv[4];
#pragma unroll
            for (int i = 0; i < 4; ++i)
#pragma unroll
                for (int j = 0; j < 4; ++j) v[i][j] = *(const float4*)(p.tbuf + (size_t)(tok0 + r0 + i) * DM + j * 256 + lane * 4);
#pragma unroll
            for (int i = 0; i < 4; ++i) { s[i] = 0.f;
#pragma unroll
                for (int j = 0; j < 4; ++j) s[i] += (v[i][j].x + v[i][j].y) + (v[i][j].z + v[i][j].w); }
#pragma unroll
            for (int o = 32; o > 0; o >>= 1) {
#pragma unroll
                for (int i = 0; i < 4; ++i) s[i] += __shfl_xor(s[i], o); }
#pragma unroll
            for (int i = 0; i < 4; ++i) { const float mean = s[i] * (1.0f / 1024.0f); qv[i] = 0.f;
#pragma unroll
                for (int j = 0; j < 4; ++j) { v[i][j].x -= mean; v[i][j].y -= mean; v[i][j].z -= mean; v[i][j].w -= mean; qv[i] += (v[i][j].x * v[i][j].x + v[i][j].y * v[i][j].y) + (v[i][j].z * v[i][j].z + v[i][j].w * v[i][j].w); } }
#pragma unroll
            for (int o = 32; o > 0; o >>= 1) {
#pragma unroll
                for (int i = 0; i < 4; ++i) qv[i] += __shfl_xor(qv[i], o); }
#pragma unroll
            for (int i = 0; i < 4; ++i) {
                const float rstd = rsqrtf(qv[i] * (1.0f / 1024.0f) + LN_EPS);
                const size_t row = (size_t)(tok0 + r0 + i);
#pragma unroll
                for (int j = 0; j < 4; ++j) {
                    const int c = j * 256 + lane * 4;
                    float4 y; y.x = v[i][j].x * rstd * gg[j].x + bb[j].x; y.y = v[i][j].y * rstd * gg[j].y + bb[j].y; y.z = v[i][j].z * rstd * gg[j].z + bb[j].z; y.w = v[i][j].w * rstd * gg[j].w + bb[j].w;
                    *(float4*)(p.x1f + row * DM + c) = y;
                    *(unsigned*)((char*)p.x1b + row * DM + c) = pack4_fp8(y.x, y.y, y.z, y.w);
                }
            }
        }
        __syncthreads();
        f32x4 a0 = (f32x4){0.f, 0.f, 0.f, 0.f}, a1 = a0;
        const float* xr = p.x1f + (size_t)(tok0 + fr) * DM + 4 * fq;
        const float* w0 = rw + (size_t)fr * 1024 + 4 * fq; const float* w1 = rw + (size_t)(16 + fr) * 1024 + 4 * fq;
#pragma unroll 4
        for (int k0 = 0; k0 < 1024; k0 += 16) {
            const float4 xa = *(const float4*)(xr + k0), wb0 = *(const float4*)(w0 + k0), wb1 = *(const float4*)(w1 + k0);
            a0 = __builtin_amdgcn_mfma_f32_16x16x4f32(xa.x, wb0.x, a0, 0, 0, 0); a1 = __builtin_amdgcn_mfma_f32_16x16x4f32(xa.x, wb1.x, a1, 0, 0, 0);
            a0 = __builtin_amdgcn_mfma_f32_16x16x4f32(xa.y, wb0.y, a0, 0, 0, 0); a1 = __builtin_amdgcn_mfma_f32_16x16x4f32(xa.y, wb1.y, a1, 0, 0, 0);
            a0 = __builtin_amdgcn_mfma_f32_16x16x4f32(xa.z, wb0.z, a0, 0, 0, 0); a1 = __builtin_amdgcn_mfma_f32_16x16x4f32(xa.z, wb1.z, a1, 0, 0, 0);
            a0 = __builtin_amdgcn_mfma_f32_16x16x4f32(xa.w, wb0.w, a0, 0, 0, 0); a1 = __builtin_amdgcn_mfma_f32_16x16x4f32(xa.w, wb1.w, a1, 0, 0, 0);
        }
#pragma unroll
        for (int r = 0; r < 4; ++r) { lg[(fq * 4 + r) * 32 + fr] = a0[r] + rb[fr]; lg[(fq * 4 + r) * 32 + 16 + fr] = a1[r] + rb[16 + fr]; }
        lds_wave_sync();
        int e4[4] = {0, 0, 0, 0}; int rk[4] = {0, 0, 0, 0};
        if (lane < 16) {
            const float* my = lg + lane * 32; unsigned taken = 0u; float tv[4];
#pragma unroll
            for (int k = 0; k < 4; ++k) {
                float best = NEG_INF; int bi = 0;
                for (int e = 0; e < 32; ++e) { const float xv = my[e]; if (!((taken >> e) & 1u) && xv > best) { best = xv; bi = e; } }
                taken |= 1u << bi; e4[k] = bi; tv[k] = best;
            }
            const float e1 = __expf(tv[1] - tv[0]), e2 = __expf(tv[2] - tv[0]), e3 = __expf(tv[3] - tv[0]);
            const float inv = 1.0f / (1.0f + e1 + e2 + e3);
            const size_t row = (size_t)(tok0 + lane);
            *(float4*)(p.gw + row * 4) = make_float4(inv, e1 * inv, e2 * inv, e3 * inv);
        }
        __syncthreads();
        if (lane < 16) {
#pragma unroll
            for (int k = 0; k < 4; ++k) rk[k] = atomicAdd(&lcnt[e4[k]], 1);
        }
        __syncthreads();
        if (tid < 32) { const int c = lcnt[tid]; lbase[tid] = c ? (int)__hip_atomic_fetch_add(gcount + tid, (unsigned)c, __ATOMIC_RELAXED, __HIP_MEMORY_SCOPE_AGENT) : 0; }
        __syncthreads();
        if (lane < 16) {
            const int row = tok0 + lane; int pk[4];
#pragma unroll
            for (int k = 0; k < 4; ++k) { const int pos = lbase[e4[k]] + rk[k]; p.lists[(size_t)e4[k] * LIST_CAP + pos] = row * 4 + k; pk[k] = (pos << 5) | e4[k]; }
            *(int4*)(p.top_e + (size_t)row * 4) = make_int4(pk[0], pk[1], pk[2], pk[3]);
        }
        __syncthreads();
    }
}

__device__ __forceinline__ void phase_ln2(const Params& p, int l, float* xout, char* lds) {
    int* ptile = (int*)(lds + LDS_TAB); int* ecnt = ptile + 40;
    build_tiles(p, l, ptile, ecnt);
    int tid = threadIdx.x; asm volatile("" : "+v"(tid));
    const int wid = tid >> 6, lane = tid & 63;
    const float* g2 = p.ln2_g + l * DM; const float* b2 = p.ln2_b + l * DM;
    float4 gg[4], bb[4];
#pragma unroll
    for (int j = 0; j < 4; ++j) { gg[j] = *(const float4*)(g2 + j * 256 + lane * 4); bb[j] = *(const float4*)(b2 + j * 256 + lane * 4); }
    for (int pr = blockIdx.x * NWV + wid; pr < NTOK / 2; pr += gridDim.x * NWV) {
        float4 v[2][4]; float s[2], qv[2];
        u32x2 yv[2][4][4]; float gk[2][4];
#pragma unroll
        for (int i = 0; i < 2; ++i) {
            const int row = pr * 2 + i;
            const float4 gwv = *(const float4*)(p.gw + (size_t)row * 4);
            gk[i][0] = gwv.x; gk[i][1] = gwv.y; gk[i][2] = gwv.z; gk[i][3] = gwv.w;
            const int4 te = *(const int4*)(p.top_e + (size_t)row * 4);
            const int tk[4] = {te.x, te.y, te.z, te.w};
#pragma unroll
            for (int j = 0; j < 4; ++j) v[i][j] = *(const float4*)(p.x1f + (size_t)row * DM + j * 256 + lane * 4);
#pragma unroll
            for (int k = 0; k < 4; ++k) {
                const bf16_t* yr = p.ybuf + (size_t)(ptile[tk[k] & 31] * 256 + (tk[k] >> 5)) * DM + lane * 4;
#pragma unroll
                for (int j = 0; j < 4; ++j) yv[i][k][j] = *(const u32x2*)(yr + j * 256);
            }
        }
#pragma unroll
        for (int i = 0; i < 2; ++i) { s[i] = 0.f;
#pragma unroll
            for (int j = 0; j < 4; ++j) {
                float4 a; a.x = v[i][j].x * ALPHA; a.y = v[i][j].y * ALPHA; a.z = v[i][j].z * ALPHA; a.w = v[i][j].w * ALPHA;
#pragma unroll
                for (int k = 0; k < 4; ++k) {
                    const u32x2 w = yv[i][k][j];
                    a.x += gk[i][k] * __uint_as_float(w.x << 16); a.y += gk[i][k] * __uint_as_float(w.x & 0xffff0000u);
                    a.z += gk[i][k] * __uint_as_float(w.y << 16); a.w += gk[i][k] * __uint_as_float(w.y & 0xffff0000u);
                }
                v[i][j] = a; s[i] += (a.x + a.y) + (a.z + a.w);
            } }
#pragma unroll
        for (int o = 32; o > 0; o >>= 1) { s[0] += __shfl_xor(s[0], o); s[1] += __shfl_xor(s[1], o); }
#pragma unroll
        for (int i = 0; i < 2; ++i) { const float mean = s[i] * (1.0f / 1024.0f); qv[i] = 0.f;
#pragma unroll
            for (int j = 0; j < 4; ++j) { v[i][j].x -= mean; v[i][j].y -= mean; v[i][j].z -= mean; v[i][j].w -= mean; qv[i] += (v[i][j].x * v[i][j].x + v[i][j].y * v[i][j].y) + (v[i][j].z * v[i][j].z + v[i][j].w * v[i][j].w); } }
#pragma unroll
        for (int o = 32; o > 0; o >>= 1) { qv[0] += __shfl_xor(qv[0], o); qv[1] += __shfl_xor(qv[1], o); }
#pragma unroll
        for (int i = 0; i < 2; ++i) {
            const float rstd = rsqrtf(qv[i] * (1.0f / 1024.0f) + LN_EPS);
            const size_t row = (size_t)(pr * 2 + i);
#pragma unroll
            for (int j = 0; j < 4; ++j) {
                const int c = j * 256 + lane * 4;
                float4 y; y.x = v[i][j].x * rstd * gg[j].x + bb[j].x; y.y = v[i][j].y * rstd * gg[j].y + bb[j].y; y.z = v[i][j].z * rstd * gg[j].z + bb[j].z; y.w = v[i][j].w * rstd * gg[j].w + bb[j].w;
                *(float4*)(xout + row * DM + c) = y;
                u32x2 w; w.x = pack2(y.x, y.y); w.y = pack2(y.z, y.w);
                *(u32x2*)(p.xb + row * DM + c) = w;
            }
        }
    }
}

#define XB_TMO      128
#define XB_XCNT(j)  (256  + 64 * (j))
#define XB_XSUB(j)  (1280 + 64 * (j))
#define XB_XGEN(j)  (2304 + 64 * (j))
#define XB_TOP      3328
#define XB_TOPGEN   3392
#define XCD_BAR_WORDS 3456
#define XB_SPIN_CAP (1u << 22)
__device__ __forceinline__ unsigned xb_ld(unsigned* p)              { return __hip_atomic_load(p, __ATOMIC_RELAXED, __HIP_MEMORY_SCOPE_AGENT); }
__device__ __forceinline__ unsigned xb_add(unsigned* p, unsigned v) { return __hip_atomic_fetch_add(p, v, __ATOMIC_RELAXED, __HIP_MEMORY_SCOPE_AGENT); }
__device__ __forceinline__ unsigned xb_xcc_id() { return (unsigned)__builtin_amdgcn_s_getreg((3 << 11) | 20) & 0xFu; }
#define XB_SPIN(cond, bar) do { unsigned _sp = 0; while (cond) { __builtin_amdgcn_s_sleep(1); \
    if ((++_sp & 255u) == 0u) { if (xb_ld(&(bar)[XB_TMO])) break; if (_sp > XB_SPIN_CAP) { atomicAdd(&(bar)[XB_TMO], 1u); break; } } } } while (0)
struct XcdBarrier { unsigned* bar; unsigned x; volatile LAS unsigned* st; };
__device__ __forceinline__ XcdBarrier xcd_barrier_post(unsigned* bar, volatile LAS unsigned* st) {
    XcdBarrier b; b.bar = bar; b.x = xb_xcc_id(); b.st = st;
    if (threadIdx.x == 0) (void)xb_add(&bar[XB_XCNT(b.x)], 1u);
    return b;
}
__device__ __forceinline__ void xcd_barrier_complete(unsigned* bar, unsigned x, unsigned& nloc, unsigned& nx) {
    const unsigned G = gridDim.x * gridDim.y * gridDim.z;
    unsigned sum, cnt, mine, sp = 0u;
    for (;;) {
        sum = 0u; cnt = 0u; mine = 0u;
#pragma unroll
        for (unsigned j = 0; j < 16; ++j) { const unsigned c = xb_ld(&bar[XB_XCNT(j)]); sum += c; cnt += (c > 0u) ? 1u : 0u; mine = (j == x) ? c : mine; }
        if (sum == G) break;
        __builtin_amdgcn_s_sleep(1);
        if ((++sp & 255u) == 0u) { if (xb_ld(&bar[XB_TMO])) break; if (sp > XB_SPIN_CAP) { atomicAdd(&bar[XB_TMO], 1u); break; } }
    }
    nloc = mine > 0u ? mine : 1u; nx = cnt > 0u ? cnt : 1u;
}
__device__ __forceinline__ void xcd_barrier(const XcdBarrier& b) {
    asm volatile("s_waitcnt vmcnt(0)" ::: "memory");
    __syncthreads();
    if (threadIdx.x == 0) {
        unsigned* bar = b.bar;
        __builtin_amdgcn_s_waitcnt(0);
        unsigned nloc = b.st[0], nx = b.st[1];
        if (nloc == 0u) { xcd_barrier_complete(bar, b.x, nloc, nx); b.st[0] = nloc; b.st[1] = nx; }
        const unsigned old = xb_add(&bar[XB_XSUB(b.x)], 1u);
        const unsigned gen = old / nloc;
        if (old + 1u == (gen + 1u) * nloc) {
            __builtin_amdgcn_fence(__ATOMIC_RELEASE, "agent");
            asm volatile("s_waitcnt vmcnt(0)" ::: "memory");
            const unsigned og = xb_add(&bar[XB_TOP], 1u);
            const unsigned tg = og / nx;
            if (og + 1u == (tg + 1u) * nx) xb_add(&bar[XB_TOPGEN], 1u);
            else XB_SPIN(xb_ld(&bar[XB_TOPGEN]) == tg, bar);
            __builtin_amdgcn_fence(__ATOMIC_ACQUIRE, "agent");
            xb_add(&bar[XB_XGEN(b.x)], 1u);
            asm volatile("s_waitcnt vmcnt(0)" ::: "memory");
        } else {
            XB_SPIN(xb_ld(&bar[XB_XGEN(b.x)]) == gen, bar);
            __builtin_amdgcn_fence(__ATOMIC_ACQUIRE, "agent");
            asm volatile("s_waitcnt vmcnt(0)" ::: "memory");
        }
    }
    __syncthreads();
}

struct KArgs { const float* in[18]; float* out; char* ws; };
constexpr size_t al256(size_t v) { return (v + 255) / 256 * 256; }
struct WSL {
    static constexpr size_t ctrl = 0;
    static constexpr size_t WinT = al256(ctrl + 65536);
    static constexpr size_t WoT = al256(WinT + (size_t)NL * NPAD * 1024 * 2);
    static constexpr size_t W1T = al256(WoT + (size_t)NL * 1024 * 1024 * 2);
    static constexpr size_t W2T = al256(W1T + (size_t)NL * 2 * 64 * 2048 * 2);
    static constexpr size_t WguT = al256(W2T + (size_t)NL * 2 * 64 * 64 * 2);
    static constexpr size_t WdnT = al256(WguT + (size_t)NL * NE * 2048 * 1024 * 2);
    static constexpr size_t rwT = al256(WdnT + (size_t)NL * NE * 1024 * 1024 * 2);
    static constexpr size_t binp = al256(rwT + (size_t)NL * NE * 1024 * 4);
    static constexpr size_t bgup = al256(binp + (size_t)NL * NPAD * 4);
    static constexpr size_t b1c = al256(bgup + (size_t)NL * NE * 2048 * 4);
    static constexpr size_t xf = al256(b1c + 4 * 64 * 4);
    static constexpr size_t xb = al256(xf + (size_t)NTOK * DM * 4);
    static constexpr size_t hb = al256(xb + (size_t)NTOK * DM * 2);
    static constexpr size_t hs = al256(hb + (size_t)NTOK * NMAIN * 2);
    static constexpr size_t vT = al256(hs + (size_t)NTOK * HS_W * 4);
    static constexpr size_t cF = al256(vT + (size_t)NB * NVH * 64 * SEQ * 2);
    static constexpr size_t kc = al256(cF + (size_t)NB * 4 * SEQ * 4);
    static constexpr size_t vc = al256(kc + (size_t)NB * 2 * 128 * 64 * 2);
    static constexpr size_t vcT = al256(vc + (size_t)NB * 2 * 128 * 64 * 2);
    static constexpr size_t ob = al256(vcT + (size_t)NB * 2 * 128 * 64 * 2);
    static constexpr size_t tbuf = al256(ob + (size_t)NTOK * DM * 2);
    static constexpr size_t x1f = al256(tbuf + (size_t)NTOK * DM * 4);
    static constexpr size_t x1b = al256(x1f + (size_t)NTOK * DM * 4);
    static constexpr size_t top_e = al256(x1b + (size_t)NTOK * DM * 2);
    static constexpr size_t gw = al256(top_e + (size_t)NTOK * 4 * 4);
    static constexpr size_t lists = al256(gw + (size_t)NTOK * 4 * 4);
    static constexpr size_t act = al256(lists + (size_t)NE * LIST_CAP * 4);
    static constexpr size_t ybuf = al256(act + (size_t)MAXSLOT * DFF * 2);
    static constexpr size_t total = al256(ybuf + (size_t)MAXSLOT * DM * 2);
};
__device__ __forceinline__ Params make_params(const KArgs& k) {
    Params p;
    p.x = k.in[0]; p.w_in = k.in[1]; p.b_in = k.in[2]; p.sinks = k.in[3]; p.cmp_pe = k.in[4]; p.cmp_w1 = k.in[5]; p.cmp_w2 = k.in[6]; p.w_out = k.in[7];
    p.ln1_g = k.in[8]; p.ln1_b = k.in[9]; p.router_w = k.in[10]; p.router_b = k.in[11]; p.w_gu = k.in[12]; p.b_gu = k.in[13]; p.w_dn = k.in[14]; p.b_dn = k.in[15];
    p.ln2_g = k.in[16]; p.ln2_b = k.in[17]; p.out = k.out;
    char* w = k.ws;
    p.ctrl = (unsigned*)(w + WSL::ctrl); p.WinT = (bf16_t*)(w + WSL::WinT); p.WoT = (bf16_t*)(w + WSL::WoT); p.W1T = (bf16_t*)(w + WSL::W1T); p.W2T = (bf16_t*)(w + WSL::W2T);
    p.WguT = (bf16_t*)(w + WSL::WguT); p.WdnT = (bf16_t*)(w + WSL::WdnT); p.rwT = (float*)(w + WSL::rwT); p.binp = (float*)(w + WSL::binp); p.bgup = (float*)(w + WSL::bgup);
    p.b1c = (float*)(w + WSL::b1c); p.xf = (float*)(w + WSL::xf); p.xb = (bf16_t*)(w + WSL::xb); p.hb = (bf16_t*)(w + WSL::hb); p.hs = (float*)(w + WSL::hs); p.vT = (bf16_t*)(w + WSL::vT);
    p.cF = (float*)(w + WSL::cF); p.kc = (bf16_t*)(w + WSL::kc); p.vc = (bf16_t*)(w + WSL::vc); p.vcT = (bf16_t*)(w + WSL::vcT); p.ob = (bf16_t*)(w + WSL::ob); p.tbuf = (float*)(w + WSL::tbuf);
    p.x1f = (float*)(w + WSL::x1f); p.x1b = (bf16_t*)(w + WSL::x1b); p.top_e = (int*)(w + WSL::top_e); p.gw = (float*)(w + WSL::gw); p.lists = (int*)(w + WSL::lists);
    p.act = (bf16_t*)(w + WSL::act); p.ybuf = (bf16_t*)(w + WSL::ybuf);
    return p;
}
__device__ __forceinline__ void grid_bar(const Params& p, char* lds) {
    XcdBarrier xb; xb.bar = p.ctrl + 1024; xb.x = xb_xcc_id(); xb.st = (volatile LAS unsigned*)(lds + LDS_BYTES - 16); xcd_barrier(xb);
}
template <int L>
__device__ __forceinline__ void layer_fwd(const Params& p, char* lds) {
    const float* xin = L == 0 ? p.x : p.xf;
    float* xout = L == NL - 1 ? p.out : p.xf;
#ifndef REP
#define REP 0
#endif
    phase_inproj(p, L, lds);        grid_bar(p, lds);
    if (REP & 1) { phase_inproj(p, L, lds);        grid_bar(p, lds); }
    phase_prep(p, L, lds);          grid_bar(p, lds);
    if (REP & 2) { phase_prep(p, L, lds);          grid_bar(p, lds); }
    phase_attn(p, L, lds);          grid_bar(p, lds);
    if (REP & 4) { phase_attn(p, L, lds, 24);      grid_bar(p, lds); }
    phase_outproj(p, L, xin, lds);  grid_bar(p, lds);
    if (REP & 8) { phase_outproj(p, L, xin, lds);  grid_bar(p, lds); }
    phase_ln1_router(p, L, lds);    grid_bar(p, lds);
    phase_gateup(p, L, lds);        grid_bar(p, lds);
    if (REP & 16) { phase_gateup(p, L, lds);       grid_bar(p, lds); }
    phase_down(p, L, lds);          grid_bar(p, lds);
    if (REP & 32) { phase_down(p, L, lds);         grid_bar(p, lds); }
    phase_ln2(p, L, xout, lds);
    if (REP & 64) { grid_bar(p, lds); phase_ln2(p, L, xout, lds); }
}
__global__ void __launch_bounds__(NTHR, 2) fwd_kernel(KArgs ka) {
    extern __shared__ __attribute__((aligned(16))) char lds[];
    const Params p = make_params(ka);
    cg::grid_group grid = cg::this_grid();
    volatile LAS unsigned* xst = (volatile LAS unsigned*)(lds + LDS_BYTES - 16);
    if (threadIdx.x == 0) { xst[0] = 0u; xst[1] = 0u; }
    __syncthreads();
    (void)xcd_barrier_post(p.ctrl + 1024, xst);
    phase0(p, lds);
    if (REP & 128) { grid_bar(p, lds); phase0(p, lds); }
    grid.sync();
    layer_fwd<0>(p, lds);
    grid_bar(p, lds);
    layer_fwd<1>(p, lds);
}

extern "C" void kernel_launch(void* const* d_in, const int* in_sizes, int n_in, void* d_out, int out_size, void* d_ws, size_t ws_size, hipStream_t stream) {
    KArgs ka{};
    for (int i = 0; i < 18; ++i) ka.in[i] = (const float*)d_in[i];
    ka.out = (float*)d_out; ka.ws = (char*)d_ws;
    if (WSL::total > ws_size) { fprintf(stderr, "workspace too small: need %zu have %zu\n", (size_t)WSL::total, ws_size); return; }
    static int grid_blocks = 0;
    if (!grid_blocks) {
        int dev = 0, cus = 0, per_cu = 0;
        (void)hipGetDevice(&dev);
        (void)hipDeviceGetAttribute(&cus, hipDeviceAttributeMultiprocessorCount, dev);
        (void)hipFuncSetAttribute((const void*)fwd_kernel, hipFuncAttributeMaxDynamicSharedMemorySize, LDS_BYTES);
        (void)hipOccupancyMaxActiveBlocksPerMultiprocessor(&per_cu, fwd_kernel, NTHR, LDS_BYTES);
        if (per_cu < 1) { fprintf(stderr, "occupancy query says 0 blocks per CU\n"); per_cu = 1; }
        grid_blocks = cus;
    }
    (void)hipMemsetAsync(d_ws, 0, 65536, stream);
    void* args[] = {&ka};
    hipError_t e = hipLaunchCooperativeKernel((const void*)fwd_kernel, dim3(grid_blocks), dim3(NTHR), args, LDS_BYTES, stream);
    if (e != hipSuccess) fprintf(stderr, "cooperative launch failed: %s (grid %d)\n", hipGetErrorString(e), grid_blocks);
}
```

```cpp
#include <hip/hip_runtime.h>
#include <hip/hip_cooperative_groups.h>
#include <cstdio>
#include <cstdint>
namespace cg = cooperative_groups;

typedef unsigned short bf16_t;
typedef short bf16x8 __attribute__((ext_vector_type(8)));
typedef float f32x4 __attribute__((ext_vector_type(4)));
typedef unsigned u32x4 __attribute__((ext_vector_type(4)));
typedef unsigned u32x2 __attribute__((ext_vector_type(2)));
typedef int v8i_t __attribute__((ext_vector_type(8)));
typedef int v4i_t __attribute__((ext_vector_type(4)));
#define LAS __attribute__((address_space(3)))
constexpr float NEG_INF = -__builtin_huge_valf();

constexpr int DM = 1024, NB = 16, SEQ = 2048, NTOK = NB * SEQ, NL = 2;
constexpr int NCOL = 2582, NMAIN = 2560, NPAD = 2688, NE = 32, DFF = 1024;
constexpr int C_FQ = 0, C_FK = 256, C_FV = 512, C_SQ = 768, C_SK = 1152, C_SV = 1280, C_NQ = 1408,
              C_NKC = 1792, C_NVC = 1920, C_NKS = 2048, C_NVS = 2176, C_NKW = 2304, C_NVW = 2432;
constexpr int HS_W = 32;
constexpr int NVH = 10;
constexpr int LIST_CAP = NTOK;
constexpr int MAXSLOT = NTOK * 4 + NE * 256;
constexpr float ALPHA = 1.41421356237f, LN_EPS = 1e-5f, QSCALE = 0.125f;
constexpr int NWV = 8, NTHR = NWV * 64;
constexpr int LDS_STAGE = 131072, LDS_TAB = LDS_STAGE, LDS_AOFF = LDS_STAGE + 2048, LDS_BYTES = LDS_AOFF + 20480 + 256;

struct Params {
    const float *x, *w_in, *b_in, *sinks, *cmp_pe, *cmp_w1, *cmp_w2, *w_out, *ln1_g, *ln1_b, *router_w, *router_b,
                *w_gu, *b_gu, *w_dn, *b_dn, *ln2_g, *ln2_b;
    float* out;
    unsigned* ctrl;
    bf16_t *WinT, *WoT, *W1T, *W2T, *WguT, *WdnT;
    float *rwT, *binp, *bgup, *b1c;
    float* xf; bf16_t* xb; bf16_t* hb; float* hs; bf16_t* vT; float* cF;
    bf16_t *kc, *vc, *vcT; bf16_t* ob; float* tbuf; float* x1f; bf16_t* x1b;
    int* top_e; float* gw; int* lists; bf16_t* act; bf16_t* ybuf;
};

__device__ __forceinline__ float bf2f(bf16_t h) { return __uint_as_float(((unsigned)h) << 16); }
typedef __bf16 bf16x2_t __attribute__((ext_vector_type(2)));
__device__ __forceinline__ bf16_t f2bf(float f) { return __builtin_bit_cast(bf16_t, (__bf16)f); }
__device__ __forceinline__ unsigned pack2(float lo, float hi) { bf16x2_t v = {(__bf16)lo, (__bf16)hi}; return __builtin_bit_cast(unsigned, v); }
__device__ __forceinline__ unsigned pack4_fp8(float a, float b, float c, float d) {
    unsigned w = 0u;
    w = __builtin_amdgcn_cvt_pk_fp8_f32(a, b, w, false);
    w = __builtin_amdgcn_cvt_pk_fp8_f32(c, d, w, true);
    return w;
}
__device__ __forceinline__ float wave_sum(float v) {
#pragma unroll
    for (int o = 32; o > 0; o >>= 1) v += __shfl_xor(v, o);
    return v;
}
__device__ __forceinline__ float wave_max(float v) {
#pragma unroll
    for (int o = 32; o > 0; o >>= 1) v = fmaxf(v, __shfl_xor(v, o));
    return v;
}
__device__ __forceinline__ void lds_wave_sync() { asm volatile("s_waitcnt lgkmcnt(0)" ::: "memory"); __builtin_amdgcn_wave_barrier(); }
__device__ __forceinline__ float slope_swa(int hq) { return exp2f(-8.0f * (float)(2 * hq + 1) / 12.0f); }
__device__ __forceinline__ float slope_nsa(int hq) { return exp2f(-8.0f * (float)(2 * hq + 2) / 12.0f); }

__device__ __forceinline__ int perm_row(int perm, int n) {
    if (perm == 1) { if (n < 768) return n; if (n < 772) return 2560 + (n - 768); if (n < 2564) return n - 4; return n; }
    if (perm == 2) { const int f = n >> 1, s = n & 1; return (f >> 7) * 256 + s * 128 + (f & 127); }
    return n;
}
struct ConvJob { const float* src; bf16_t* dst; int K, N, kt, nt, perm; float q8; };
__device__ __forceinline__ bool conv_job(const Params& p, int t, ConvJob& jb) {
    constexpr int T_GU = NL * NE * 8 * 16, T_DN = NL * NE * 8 * 8, T_WIN = NL * 8 * 21, T_WO = NL * 8 * 8;
    if (t < T_GU) { const int m = t / 128, r = t % 128; jb = ConvJob{p.w_gu + (size_t)m * 1024 * 2048, (bf16_t*)((char*)p.WguT + (size_t)m * 2048 * 1024), 1024, 2048, r / 16, r % 16, 2, 64.0f}; return true; }
    t -= T_GU;
    if (t < T_DN) { const int m = t / 64, r = t % 64; jb = ConvJob{p.w_dn + (size_t)m * 1024 * 1024, (bf16_t*)((char*)p.WdnT + (size_t)m * 1024 * 1024), 1024, 1024, r / 8, r % 8, 0, 64.0f}; return true; }
    t -= T_DN;
    if (t < T_WIN) { const int m = t / 168, r = t % 168; jb = ConvJob{p.w_in + (size_t)m * 1024 * NCOL, p.WinT + (size_t)m * NPAD * 1024, 1024, NCOL, r / 21, r % 21, 1, 0.f}; return true; }
    t -= T_WIN;
    if (t < T_WO) { const int m = t / 64, r = t % 64; jb = ConvJob{p.w_out + (size_t)m * 1024 * 1024, p.WoT + (size_t)m * 1024 * 1024, 1024, 1024, r / 8, r % 8, 0, 0.f}; return true; }
    return false;
}
__device__ __forceinline__ void conv_load(const ConvJob& jb, int tid, float2 (&v)[16]) {
    const int n = jb.nt * 128 + (tid & 31) * 4;
    const float* s = jb.src + (size_t)(jb.kt * 128 + (tid >> 5)) * jb.N + n;
#pragma unroll
    for (int i = 0; i < 8; ++i) {
        const float* r = s + (size_t)(16 * i) * jb.N;
        v[2 * i] = (n + 1 < jb.N) ? *(const float2*)r : make_float2(0.f, 0.f);
        v[2 * i + 1] = (n + 3 < jb.N) ? *(const float2*)(r + 2) : make_float2(0.f, 0.f);
    }
}
__device__ __forceinline__ void phase0(const Params& p, char* ldsc) {
    int tid = threadIdx.x; asm volatile("" : "+v"(tid));
    const int G = gridDim.x, bid = blockIdx.x;
    const size_t gtid = (size_t)bid * NTHR + tid, gthreads = (size_t)G * NTHR;
    {
        constexpr int TOT = NL * NE * 8 * 16 + NL * NE * 8 * 8 + NL * 8 * 21 + NL * 8 * 8;
        bf16_t* lt = (bf16_t*)ldsc;
        ConvJob jb, jn; float2 v[16], vn[16];
        int t = bid; bool have = t < TOT && conv_job(p, t, jb);
        if (have) conv_load(jb, tid, v);
        while (have) {
            const int tn = t + G; const bool hn = tn < TOT && conv_job(p, tn, jn);
            if (hn) conv_load(jn, tid, vn);
            if (jb.q8 != 0.f) {
                unsigned char* l8 = (unsigned char*)lt;
#pragma unroll
                for (int i = 0; i < 8; ++i)
                    *(unsigned*)(l8 + ((tid >> 5) + 16 * i) * 132 + (tid & 31) * 4) = pack4_fp8(v[2 * i].x * jb.q8, v[2 * i].y * jb.q8, v[2 * i + 1].x * jb.q8, v[2 * i + 1].y * jb.q8);
                __syncthreads();
#pragma unroll
                for (int i = 0; i < 2; ++i) {
                    const int idx = tid + NTHR * i, kc = idx & 7, nn = idx >> 3, n = jb.nt * 128 + nn;
                    const unsigned char* l = l8 + (kc * 16) * 132 + nn;
                    u32x4 w;
                    w.x = (unsigned)l[0] | ((unsigned)l[132] << 8) | ((unsigned)l[264] << 16) | ((unsigned)l[396] << 24);
                    w.y = (unsigned)l[528] | ((unsigned)l[660] << 8) | ((unsigned)l[792] << 16) | ((unsigned)l[924] << 24);
                    w.z = (unsigned)l[1056] | ((unsigned)l[1188] << 8) | ((unsigned)l[1320] << 16) | ((unsigned)l[1452] << 24);
                    w.w = (unsigned)l[1584] | ((unsigned)l[1716] << 8) | ((unsigned)l[1848] << 16) | ((unsigned)l[1980] << 24);
                    *(u32x4*)((char*)jb.dst + (size_t)perm_row(jb.perm, n) * jb.K + jb.kt * 128 + kc * 16) = w;
                }
            } else {
#pragma unroll
                for (int i = 0; i < 8; ++i) {
                    u32x2 w; w.x = pack2(v[2 * i].x, v[2 * i].y); w.y = pack2(v[2 * i + 1].x, v[2 * i + 1].y);
                    *(u32x2*)(lt + ((tid >> 5) + 16 * i) * 136 + (tid & 31) * 4) = w;
                }
                __syncthreads();
#pragma unroll
                for (int i = 0; i < 4; ++i) {
                    const int idx = tid + NTHR * i, kc = idx & 15, nn = idx >> 4, n = jb.nt * 128 + nn;
                    if (n < jb.N) {
                        const bf16_t* l = lt + (kc * 8) * 136 + nn;
                        u32x4 w;
                        w.x = (unsigned)l[0] | ((unsigned)l[136] << 16); w.y = (unsigned)l[272] | ((unsigned)l[408] << 16);
                        w.z = (unsigned)l[544] | ((unsigned)l[680] << 16); w.w = (unsigned)l[816] | ((unsigned)l[952] << 16);
                        *(u32x4*)(jb.dst + (size_t)perm_row(jb.perm, n) * jb.K + jb.kt * 128 + kc * 8) = w;
                    }
                }
            }
            __syncthreads();
            t = tn; have = hn; jb = jn;
#pragma unroll
            for (int i = 0; i < 16; ++i) v[i] = vn[i];
        }
    }
    for (size_t i = gtid; i < (size_t)NL * 2 * 2048 * 64; i += gthreads) {
        const int k = (int)(i % 2048), n = (int)((i / 2048) % 64), m = (int)(i / (2048 * 64));
        p.W1T[i] = f2bf(p.cmp_w1[((size_t)m * 2048 + k) * 64 + n]);
    }
    for (size_t i = gtid; i < (size_t)NL * 2 * 64 * 64; i += gthreads) {
        const int k = (int)(i % 64), n = (int)((i / 64) % 64), m = (int)(i / 4096);
        p.W2T[i] = f2bf(p.cmp_w2[((size_t)m * 64 + k) * 64 + n]);
    }
    for (size_t i = gtid; i < (size_t)NL * NPAD; i += gthreads) {
        const int l = (int)(i / NPAD), r = (int)(i % NPAD);
        float v = 0.f;
        if (r < 2560) { const int n = r < 768 ? r : r + 4; v = p.b_in[l * NCOL + n]; }
        else if (r < 2564) v = p.b_in[l * NCOL + 768 + (r - 2560)];
        else if (r < 2582) v = p.b_in[l * NCOL + r];
        p.binp[i] = v;
    }
    for (size_t i = gtid; i < (size_t)NL * NE * 2048; i += gthreads) {
        const int r = (int)(i % 2048); const size_t le = i / 2048;
        const int s = (r >> 7) & 1, f = (r >> 8) * 128 + (r & 127);
        p.bgup[i] = p.b_gu[le * 2048 + 2 * f + s];
    }
    for (size_t i = gtid; i < (size_t)NL * NE * 1024; i += gthreads) {
        const int k = (int)(i % 1024), e = (int)((i / 1024) % NE), l = (int)(i / (1024 * NE));
        p.rwT[i] = p.router_w[((size_t)l * 1024 + k) * NE + e];
    }
    for (size_t i = gtid; i < (size_t)NL * (NPAD - NCOL) * 1024; i += gthreads) {
        const int l = (int)(i / ((NPAD - NCOL) * 1024)); const size_t r = i % ((size_t)(NPAD - NCOL) * 1024);
        p.WinT[(size_t)l * NPAD * 1024 + (size_t)NCOL * 1024 + r] = 0;
    }
    for (size_t i = gtid; i < (size_t)NTOK * DM / 4; i += gthreads) {
        const float4 v4 = ((const float4*)p.x)[i];
        u32x2 w; w.x = pack2(v4.x, v4.y); w.y = pack2(v4.z, v4.w);
        ((u32x2*)p.xb)[i] = w;
    }
    if (bid < 4) {
        float* lf = (float*)ldsc;
        const int j = tid & 63, part = tid >> 6;
        const float* pe = p.cmp_pe + (size_t)bid * 2048; const float* w1 = p.cmp_w1 + (size_t)bid * 2048 * 64;
        float s = 0.f;
        for (int kk = part * 256; kk < part * 256 + 256; ++kk) s += pe[kk] * w1[(size_t)kk * 64 + j];
        lf[tid] = s; __syncthreads();
        if (tid < 64) { float a = 0.f; for (int q = 0; q < 8; ++q) a += lf[tid + 64 * q]; p.b1c[bid * 64 + tid] = a; }
        __syncthreads();
    }
}

namespace pg8 {
constexpr int BM = 256, BK = 64, HALF = 128, HTB = HALF * BK * 2, NXCD = 8, WGM = 8;
__device__ __forceinline__ int lds_byte(int r, int c) { const int st = (r >> 4) * 2 + (c >> 5), rr = r & 15, cc = c & 31, ob = rr * 64 + cc * 2; return st * 1024 + (ob ^ (((ob >> 9) & 1) << 5)); }
__device__ __forceinline__ void stage_rc(int b, int& R, int& C) { const int st = b / 1024, sb = b % 1024, swz = sb ^ (((sb >> 9) & 1) << 5); R = (st >> 1) * 16 + swz / 64; C = (st & 1) * 32 + (swz % 64) / 2; }
__device__ __forceinline__ bool tile_order(int i, int G, int c, int nM, int nN, int& pm, int& pn) {
    const int nwg = nM * nN; const long L = (long)i * G + c; if (L >= nwg) return false;
    int wgid = (int)L; { const int q = nwg / NXCD, r = nwg % NXCD, xcd = wgid % NXCD, off = wgid / NXCD; wgid = (xcd < r ? xcd * (q + 1) : r * (q + 1) + (xcd - r) * q) + off; }
    const int nig = WGM * nN, gid = wgid / nig, fm = gid * WGM, gsz = (nM - fm) < WGM ? (nM - fm) : WGM;
    pm = fm + ((wgid % nig) % gsz); pn = (wgid % nig) / gsz; return true;
}
template <bool FP8, int SCA, class Sched, class Epi>
__device__ __forceinline__ void gemm_phase(LAS unsigned char* lds, const char* Abase, int K, const Sched& S, const Epi& E) {
    int tid = threadIdx.x; asm volatile("" : "+v"(tid));
    const int wid = __builtin_amdgcn_readfirstlane(tid >> 6), lane = tid & 63, wr = wid >> 2, wc = wid & 3, fr = lane & 15, fq = lane >> 4;
    const int nt = K / BK;
    int R0, C0, R1, C1; stage_rc(tid * 16, R0, C0); stage_rc(tid * 16 + 8192, R1, C1);
    LAS unsigned* aofs = (LAS unsigned*)(lds + LDS_AOFF) + tid;
    unsigned rg[10];
    rg[8] = (unsigned)(R0 * K + C0) * 2u; rg[9] = (unsigned)(R1 * K + C1) * 2u;
    if constexpr (FP8) { aofs[8 * NTHR] = rg[8]; aofs[9 * NTHR] = rg[9]; }
    const size_t kstep = (size_t)(BK * 2), hstep = (size_t)HALF * K * 2;
    const unsigned ldsw = (unsigned)wid * 1024u;
    const int aoff = lds_byte(wr * 64 + fr, fq * 8), boff = lds_byte(wc * 32 + fr, fq * 8);
#define PG8_SA(b, h) (((b) * 2 + (h)) * HTB)
#define PG8_SB(b, h) ((4 + (b) * 2 + (h)) * HTB)
#define PG8_OFS(sel, j) (FP8 ? aofs[((sel) * 4 + (j)) * NTHR] : ((sel) ? rg[4 + (j)] : rg[(j)]))
#define PG8_STAGE_B(bufoff, gbase) do { _Pragma("unroll") for (int _i = 0; _i < 2; ++_i) { const unsigned ob_ = FP8 ? aofs[(8 + _i) * NTHR] : rg[8 + _i]; \
        __builtin_amdgcn_global_load_lds((const unsigned*)((const char*)(gbase) + ob_), (LAS unsigned*)(lds + (bufoff) + ldsw + _i * 8192), 16, 0, 0); } } while (0)
#define PG8_STAGE_A(bufoff, kbyte, sel, h) do { const unsigned o0_ = PG8_OFS(sel, (h) * 2), o1_ = PG8_OFS(sel, (h) * 2 + 1); \
        __builtin_amdgcn_global_load_lds((const unsigned*)(Abase + (kbyte) + o0_), (LAS unsigned*)(lds + (bufoff) + ldsw), 16, 0, 0); \
        __builtin_amdgcn_global_load_lds((const unsigned*)(Abase + (kbyte) + o1_), (LAS unsigned*)(lds + (bufoff) + ldsw + 8192), 16, 0, 0); } while (0)
#define PG8_LDA(dst, b, h) do { _Pragma("unroll") for (int m = 0; m < 4; ++m) { \
        if constexpr (FP8) { const v4i_t lo_ = *(const LAS v4i_t*)(lds + PG8_SA(b, h) + aoff + m * 2048), hi_ = *(const LAS v4i_t*)(lds + PG8_SA(b, h) + aoff + m * 2048 + 1024); dst##8[m] = __builtin_shufflevector(lo_, hi_, 0, 1, 2, 3, 4, 5, 6, 7); } \
        else { _Pragma("unroll") for (int k = 0; k < 2; ++k) dst[m][k] = *(const LAS bf16x8*)(lds + PG8_SA(b, h) + aoff + m * 2048 + k * 1024); } } } while (0)
#define PG8_LDB(dst, b, h) do { _Pragma("unroll") for (int n = 0; n < 2; ++n) { \
        if constexpr (FP8) { const v4i_t lo_ = *(const LAS v4i_t*)(lds + PG8_SB(b, h) + boff + n * 2048), hi_ = *(const LAS v4i_t*)(lds + PG8_SB(b, h) + boff + n * 2048 + 1024); dst##8[n] = __builtin_shufflevector(lo_, hi_, 0, 1, 2, 3, 4, 5, 6, 7); } \
        else { _Pragma("unroll") for (int k = 0; k < 2; ++k) dst[n][k] = *(const LAS bf16x8*)(lds + PG8_SB(b, h) + boff + n * 2048 + k * 1024); } } } while (0)
#define PG8_MMA(ai, bj, At, Bt) do { __builtin_amdgcn_s_setprio(1); _Pragma("unroll") for (int m = 0; m < 4; ++m) _Pragma("unroll") for (int n = 0; n < 2; ++n) { \
        if constexpr (FP8) { acc[ai][bj][m][n] = __builtin_amdgcn_mfma_scale_f32_16x16x128_f8f6f4(Bt##8[n], At##8[m], acc[ai][bj][m][n], 0, 0, 0, SCA, 0, SCA); } \
        else { _Pragma("unroll") for (int k = 0; k < 2; ++k) acc[ai][bj][m][n] = __builtin_amdgcn_mfma_f32_16x16x32_bf16(Bt[n][k], At[m][k], acc[ai][bj][m][n], 0, 0, 0); } } \
        __builtin_amdgcn_s_setprio(0); } while (0)
#define PG8_WAIT_V(n) asm volatile("s_waitcnt vmcnt(" #n ")" ::: "memory")
#define PG8_WAIT_L(n) asm volatile("s_waitcnt lgkmcnt(" #n ")" ::: "memory")
#define PG8_BAR __builtin_amdgcn_s_barrier()
#define PG8_SCHED __builtin_amdgcn_sched_barrier(0)
    typename Sched::Unit cur, nxt; int ui = 0;
    if (!S.next(0, cur)) return;
    f32x4 acc[2][2][4][2];
#pragma unroll
    for (int a = 0; a < 2; ++a)
#pragma unroll
        for (int b = 0; b < 2; ++b)
#pragma unroll
            for (int m = 0; m < 4; ++m)
#pragma unroll
                for (int n = 0; n < 2; ++n) acc[a][b][m][n] = (f32x4){0.f, 0.f, 0.f, 0.f};
    bf16x8 At[4][2], B0[2][2], B1[2][2];
    v8i_t At8[4], B08[2], B18[2];
    { unsigned a4[2][2]; S.a_off(cur, R0, C0, R1, C1, a4); rg[0] = a4[0][0]; rg[1] = a4[0][1]; rg[2] = a4[1][0]; rg[3] = a4[1][1];
      if constexpr (FP8) { aofs[0] = a4[0][0]; aofs[NTHR] = a4[0][1]; aofs[2 * NTHR] = a4[1][0]; aofs[3 * NTHR] = a4[1][1]; } }
    const char* cB = S.b_ptr(cur);
    PG8_STAGE_B(PG8_SB(0, 0), cB); PG8_STAGE_B(PG8_SB(0, 1), cB + hstep); PG8_STAGE_A(PG8_SA(0, 0), 0, 0, 0); PG8_STAGE_A(PG8_SA(0, 1), 0, 0, 1);
    if (wr == 1) PG8_BAR;
    PG8_WAIT_V(2); PG8_BAR;
    PG8_STAGE_B(PG8_SB(1, 0), cB + kstep); PG8_STAGE_A(PG8_SA(1, 0), kstep, 0, 0); PG8_STAGE_B(PG8_SB(1, 1), cB + hstep + kstep);
    PG8_WAIT_V(6); PG8_BAR;
    for (;;) {
        const bool has_next = S.next(ui + 1, nxt);
        const char* nB = cB;
        if (has_next) { int t2 = threadIdx.x; asm volatile("" : "+v"(t2)); int r0, c0, r1, c1; stage_rc(t2 * 16, r0, c0); stage_rc(t2 * 16 + 8192, r1, c1); unsigned a4[2][2]; S.a_off(nxt, r0, c0, r1, c1, a4); nB = S.b_ptr(nxt);
            rg[4] = a4[0][0]; rg[5] = a4[0][1]; rg[6] = a4[1][0]; rg[7] = a4[1][1];
            if constexpr (FP8) { aofs[4 * NTHR] = a4[0][0]; aofs[5 * NTHR] = a4[0][1]; aofs[6 * NTHR] = a4[1][0]; aofs[7 * NTHR] = a4[1][1]; } }
        else { rg[4] = rg[0]; rg[5] = rg[1]; rg[6] = rg[2]; rg[7] = rg[3];
            if constexpr (FP8) { aofs[4 * NTHR] = aofs[0]; aofs[5 * NTHR] = aofs[NTHR]; aofs[6 * NTHR] = aofs[2 * NTHR]; aofs[7 * NTHR] = aofs[3 * NTHR]; } }
#pragma unroll 1
        for (int t = 0; t < nt; t += 2) {
            const bool last = (t == nt - 2);
            const size_t ka1 = (size_t)(t + 1) * kstep, ka2 = last ? 0 : (size_t)(t + 2) * kstep, ka3 = ka2 + kstep;
            const char* b2 = last ? nB : cB + (size_t)(t + 2) * kstep; const char* b3 = b2 + kstep;
            const int sel = last ? 1 : 0;
            PG8_LDB(B0, 0, 0); PG8_LDB(B1, 0, 1); PG8_SCHED; PG8_LDA(At, 0, 0); PG8_STAGE_A(PG8_SA(1, 1), ka1, 0, 1);
            PG8_WAIT_V(8); PG8_WAIT_L(0); PG8_BAR; PG8_MMA(0, 0, At, B0); PG8_MMA(0, 1, At, B1); PG8_BAR; PG8_SCHED;
            PG8_LDA(At, 0, 1); PG8_STAGE_B(PG8_SB(0, 0), b2); PG8_STAGE_B(PG8_SB(0, 1), b2 + hstep); PG8_STAGE_A(PG8_SA(0, 0), ka2, sel, 0);
            PG8_WAIT_V(8); PG8_WAIT_L(0); PG8_BAR; PG8_MMA(1, 0, At, B0); PG8_MMA(1, 1, At, B1); PG8_BAR; PG8_SCHED;
            PG8_LDB(B0, 1, 0); PG8_LDB(B1, 1, 1); PG8_SCHED; PG8_LDA(At, 1, 0); PG8_STAGE_A(PG8_SA(0, 1), ka2, sel, 1);
            PG8_WAIT_V(8); PG8_WAIT_L(0); PG8_BAR; PG8_MMA(0, 0, At, B0); PG8_MMA(0, 1, At, B1); PG8_BAR; PG8_SCHED;
            PG8_LDA(At, 1, 1); PG8_STAGE_B(PG8_SB(1, 0), b3); PG8_STAGE_B(PG8_SB(1, 1), b3 + hstep); PG8_STAGE_A(PG8_SA(1, 0), ka3, sel, 0);
            PG8_WAIT_V(8); PG8_WAIT_L(0); PG8_BAR; PG8_MMA(1, 0, At, B0); PG8_MMA(1, 1, At, B1); PG8_BAR; PG8_SCHED;
        }
        if (wr == 0) PG8_BAR;
        { int t2 = threadIdx.x; asm volatile("" : "+v"(t2)); E(acc, cur, wr, wc, t2 & 15, (t2 & 63) >> 4); }
        if (!has_next) break;
#pragma unroll
        for (int a = 0; a < 2; ++a)
#pragma unroll
            for (int b = 0; b < 2; ++b)
#pragma unroll
                for (int m = 0; m < 4; ++m)
#pragma unroll
                    for (int n = 0; n < 2; ++n) acc[a][b][m][n] = (f32x4){0.f, 0.f, 0.f, 0.f};
        cur = nxt; cB = nB; ++ui;
        rg[0] = rg[4]; rg[1] = rg[5]; rg[2] = rg[6]; rg[3] = rg[7];
        if constexpr (FP8) { aofs[0] = aofs[4 * NTHR]; aofs[NTHR] = aofs[5 * NTHR]; aofs[2 * NTHR] = aofs[6 * NTHR]; aofs[3 * NTHR] = aofs[7 * NTHR]; }
        if (wr == 1) PG8_BAR;
    }
    PG8_WAIT_V(0);
    PG8_BAR;
#undef PG8_SA
#undef PG8_SB
#undef PG8_STAGE_A
#undef PG8_OFS
#undef PG8_STAGE_B
#undef PG8_LDA
#undef PG8_LDB
#undef PG8_MMA
#undef PG8_WAIT_V
#undef PG8_WAIT_L
#undef PG8_BAR
#undef PG8_SCHED
}
}

struct DenseUnit { int pm, pn; };
struct DenseSched {
    typedef DenseUnit Unit;
    const char* Bt; int K, nM, nN;
    __device__ __forceinline__ bool next(int i, Unit& u) const { return pg8::tile_order(i, gridDim.x, blockIdx.x, nM, nN, u.pm, u.pn); }
    __device__ __forceinline__ void a_off(const Unit& u, int R0, int C0, int R1, int C1, unsigned (&off)[2][2]) const {
#pragma unroll
        for (int h = 0; h < 2; ++h) { off[h][0] = (unsigned)((u.pm * 256 + h * 128 + R0) * K + C0) * 2u; off[h][1] = (unsigned)((u.pm * 256 + h * 128 + R1) * K + C1) * 2u; }
    }
    __device__ __forceinline__ const char* b_ptr(const Unit& u) const { return Bt + (size_t)u.pn * 256 * K * 2; }
};
struct MoeUnit { int rbt, e, pn; };
template <bool GATHER>
struct MoeSched {
    typedef MoeUnit Unit;
    static constexpr int KP = 512;
    const char* Bt; const int* lists; const int* ptile; const int* ecnt; int nN, nrows;
    __device__ __forceinline__ bool next(int i, Unit& u) const {
        int pm, pn; if (!pg8::tile_order(i, gridDim.x, blockIdx.x, ptile[NE], nN, pm, pn)) return false;
        int e = 0; while (ptile[e + 1] <= pm) ++e;
        u.rbt = pm; u.e = e; u.pn = pn; return true;
    }
    __device__ __forceinline__ void a_off(const Unit& u, int R0, int C0, int R1, int C1, unsigned (&off)[2][2]) const {
        if (GATHER) {
            const int* lst = lists + (size_t)u.e * LIST_CAP; const int rb = u.rbt - ptile[u.e], cnt = ecnt[u.e];
#pragma unroll
            for (int h = 0; h < 2; ++h) {
                const int l0 = rb * 256 + h * 128 + R0, l1 = rb * 256 + h * 128 + R1;
                const int t0 = l0 < cnt ? (lst[l0] >> 2) : 0, t1 = l1 < cnt ? (lst[l1] >> 2) : 0;
                off[h][0] = (unsigned)(t0 * KP + C0) * 2u; off[h][1] = (unsigned)(t1 * KP + C1) * 2u;
            }
        } else {
#pragma unroll
            for (int h = 0; h < 2; ++h) { off[h][0] = (unsigned)((u.rbt * 256 + h * 128 + R0) * KP + C0) * 2u; off[h][1] = (unsigned)((u.rbt * 256 + h * 128 + R1) * KP + C1) * 2u; }
        }
    }
    __device__ __forceinline__ const char* b_ptr(const Unit& u) const { return Bt + ((size_t)u.e * nrows + (size_t)u.pn * 256) * KP * 2; }
};

struct EpiInProj {
    const Params* p; int l;
    __device__ __forceinline__ void operator()(const f32x4 (&acc)[2][2][4][2], const DenseUnit& u, int wr, int wc, int fr, int fq) const {
        const float* bias = p->binp + l * NPAD + u.pn * 256;
#pragma unroll
        for (int bj = 0; bj < 2; ++bj) {
            int vh = -1;
            if (u.pn == 2) vh = bj * 2; else if (u.pn == 5 && bj == 0) vh = 4; else if (u.pn == 8 && bj == 1) vh = 6; else if (u.pn == 9 && bj == 1) vh = 8;
#pragma unroll
            for (int n = 0; n < 2; ++n) {
                const int c = bj * 128 + wc * 32 + n * 16 + 4 * fq;
                const f32x4 bv = *(const f32x4*)(bias + c);
#pragma unroll
                for (int ai = 0; ai < 2; ++ai)
#pragma unroll
                    for (int m = 0; m < 4; ++m) {
                        const int row = u.pm * 256 + ai * 128 + wr * 64 + m * 16 + fr;
                        const f32x4 v = acc[ai][bj][m][n] + bv;
                        u32x2 w; w.x = pack2(v[0], v[1]); w.y = pack2(v[2], v[3]);
                        *(u32x2*)(p->hb + (size_t)row * NMAIN + u.pn * 256 + c) = w;
                        if (vh >= 0) {
                            const int b = row >> 11, s = row & 2047, hh = vh + ((c & 127) >> 6), d = c & 63;
                            bf16_t* vt = p->vT + (((size_t)b * NVH + hh) * 64 + d) * SEQ + s;
                            vt[0] = (bf16_t)(w.x & 0xffff); vt[SEQ] = (bf16_t)(w.x >> 16); vt[2 * SEQ] = (bf16_t)(w.y & 0xffff); vt[3 * SEQ] = (bf16_t)(w.y >> 16);
                        }
                    }
            }
        }
    }
};
struct EpiOutProj {
    const float* xin; float* t;
    __device__ __forceinline__ void operator()(const f32x4 (&acc)[2][2][4][2], const DenseUnit& u, int wr, int wc, int fr, int fq) const {
#pragma unroll
        for (int ai = 0; ai < 2; ++ai)
#pragma unroll
            for (int m = 0; m < 4; ++m) {
                const size_t rowoff = (size_t)(u.pm * 256 + ai * 128 + wr * 64 + m * 16 + fr) * DM + u.pn * 256 + wc * 32 + 4 * fq;
#pragma unroll
                for (int bj = 0; bj < 2; ++bj)
#pragma unroll
                    for (int n = 0; n < 2; ++n) {
                        const size_t off = rowoff + bj * 128 + n * 16;
                        const f32x4 xv = *(const f32x4*)(xin + off);
                        *(f32x4*)(t + off) = xv * ALPHA + acc[ai][bj][m][n];
                    }
            }
    }
};
struct EpiGateUp {
    bf16_t* act; const float* bgup;
    __device__ __forceinline__ void operator()(const f32x4 (&acc)[2][2][4][2], const MoeUnit& u, int wr, int wc, int fr, int fq) const {
        const float* bias = bgup + (size_t)u.e * 2048 + u.pn * 256;
#pragma unroll
        for (int n = 0; n < 2; ++n) {
            const int c = wc * 32 + n * 16 + 4 * fq;
            const f32x4 bg = *(const f32x4*)(bias + c), bu = *(const f32x4*)(bias + 128 + c);
#pragma unroll
            for (int ai = 0; ai < 2; ++ai)
#pragma unroll
                for (int m = 0; m < 4; ++m) {
                    const f32x4 g4 = acc[ai][0][m][n] + bg, u4 = acc[ai][1][m][n] + bu;
                    float o[4];
#pragma unroll
                    for (int j = 0; j < 4; ++j) {
                        const float g = fminf(g4[j], 7.0f), uu = fminf(fmaxf(u4[j], -7.0f), 7.0f);
                        const float glu = g * __builtin_amdgcn_rcpf(1.0f + __builtin_amdgcn_exp2f(-2.455466929f * g));
                        o[j] = (uu + 1.0f) * glu;
                    }
                    *(unsigned*)((char*)act + (size_t)(u.rbt * 256 + ai * 128 + wr * 64 + m * 16 + fr) * DFF + u.pn * 128 + c) = pack4_fp8(o[0], o[1], o[2], o[3]);
                }
        }
    }
};
struct EpiDown {
    bf16_t* ybuf; const float* bdn;
    __device__ __forceinline__ void operator()(const f32x4 (&acc)[2][2][4][2], const MoeUnit& u, int wr, int wc, int fr, int fq) const {
        const float* bias = bdn + (size_t)u.e * 1024 + u.pn * 256;
#pragma unroll
        for (int bj = 0; bj < 2; ++bj)
#pragma unroll
            for (int n = 0; n < 2; ++n) {
                const int c = bj * 128 + wc * 32 + n * 16 + 4 * fq;
                const f32x4 bv = *(const f32x4*)(bias + c);
#pragma unroll
                for (int ai = 0; ai < 2; ++ai)
#pragma unroll
                    for (int m = 0; m < 4; ++m) {
                        const f32x4 v = acc[ai][bj][m][n] + bv;
                        u32x2 w; w.x = pack2(v[0], v[1]); w.y = pack2(v[2], v[3]);
                        *(u32x2*)(ybuf + (size_t)(u.rbt * 256 + ai * 128 + wr * 64 + m * 16 + fr) * DM + u.pn * 256 + c) = w;
                    }
            }
    }
};

__device__ __forceinline__ void phase_inproj(const Params& p, int l, char* lds) {
    DenseSched S{(const char*)(p.WinT + (size_t)l * NPAD * 1024), 1024, NTOK / 256, NMAIN / 256};
    EpiInProj E{&p, l};
    pg8::gemm_phase<false, 0>((LAS unsigned char*)lds, (const char*)p.xb, 1024, S, E);
    int tid = threadIdx.x; asm volatile("" : "+v"(tid));
    const int wid = tid >> 6, lane = tid & 63, fr = lane & 15, fq = lane >> 4;
    const bf16_t* W = p.WinT + ((size_t)l * NPAD + NMAIN) * 1024;
    const float* bias = p.binp + l * NPAD + NMAIN;
    for (int u = blockIdx.x * NWV + wid; u < NTOK / 16; u += gridDim.x * NWV) {
        const bf16_t* ar = p.xb + (size_t)(u * 16 + fr) * DM + fq * 8;
        const bf16_t* w0 = W + (size_t)fr * 1024 + fq * 8; const bf16_t* w1 = W + (size_t)(16 + fr) * 1024 + fq * 8;
        f32x4 a0 = (f32x4){0.f, 0.f, 0.f, 0.f}, a1 = a0;
#pragma unroll 4
        for (int ks = 0; ks < 32; ++ks) {
            const bf16x8 a = *(const bf16x8*)(ar + ks * 32);
            a0 = __builtin_amdgcn_mfma_f32_16x16x32_bf16(a, *(const bf16x8*)(w0 + ks * 32), a0, 0, 0, 0);
            a1 = __builtin_amdgcn_mfma_f32_16x16x32_bf16(a, *(const bf16x8*)(w1 + ks * 32), a1, 0, 0, 0);
        }
#pragma unroll
        for (int r = 0; r < 4; ++r) {
            float* dst = p.hs + (size_t)(u * 16 + fq * 4 + r) * HS_W;
            dst[fr] = a0[r] + bias[fr];
            if (fr < 6) dst[16 + fr] = a1[r] + bias[16 + fr];
        }
    }
}
__device__ __forceinline__ void phase_outproj(const Params& p, int l, const float* xin, char* lds) {
    DenseSched S{(const char*)(p.WoT + (size_t)l * 1024 * 1024), 1024, NTOK / 256, 4};
    EpiOutProj E{xin, p.tbuf};
    pg8::gemm_phase<false, 0>((LAS unsigned char*)lds, (const char*)p.ob, 1024, S, E);
}
__device__ __forceinline__ void build_tiles(const Params& p, int l, int* ptile, int* ecnt) {
    int tid = threadIdx.x; asm volatile("" : "+v"(tid));
    if (tid < NE) ecnt[tid] = (int)__hip_atomic_load(p.ctrl + 64 + l * NE + tid, __ATOMIC_RELAXED, __HIP_MEMORY_SCOPE_AGENT);
    __syncthreads();
    if (tid == 0) { int s = 0; for (int e = 0; e < NE; ++e) { ptile[e] = s; s += (ecnt[e] + 255) >> 8; } ptile[NE] = s; }
    __syncthreads();
}
__device__ __forceinline__ void phase_gateup(const Params& p, int l, char* lds) {
    int* ptile = (int*)(lds + LDS_TAB); int* ecnt = ptile + 40;
    build_tiles(p, l, ptile, ecnt);
    MoeSched<true> S{(const char*)p.WguT + (size_t)l * NE * 2048 * 1024, p.lists, ptile, ecnt, 8, 2048};
    EpiGateUp E{p.act, p.bgup + (size_t)l * NE * 2048};
    pg8::gemm_phase<true, 0x7c7c7c7c>((LAS unsigned char*)lds, (const char*)p.x1b, 512, S, E);
}
__device__ __forceinline__ void phase_down(const Params& p, int l, char* lds) {
    int* ptile = (int*)(lds + LDS_TAB); int* ecnt = ptile + 40;
    build_tiles(p, l, ptile, ecnt);
    MoeSched<false> S{(const char*)p.WdnT + (size_t)l * NE * 1024 * 1024, p.lists, ptile, ecnt, 4, 1024};
    EpiDown E{p.ybuf, p.b_dn + (size_t)l * NE * 1024};
    pg8::gemm_phase<true, 0x7c7c7c7c>((LAS unsigned char*)lds, (const char*)p.act, 512, S, E);
}

__device__ __forceinline__ float gelu_tanh(float x) {
    const float u = 0.7978845608028654f * (x + 0.044715f * x * x * x);
    const float e = __expf(-2.0f * fabsf(u)); const float th = (1.0f - e) / (1.0f + e);
    return 0.5f * x * (1.0f + (u < 0.f ? -th : th));
}
__device__ __forceinline__ void phase_prep(const Params& p, int l, char* lds) {
    int tid = threadIdx.x; asm volatile("" : "+v"(tid));
    const int wid = tid >> 6, lane = tid & 63, fr = lane & 15, fq = lane >> 4;
    const int gw = blockIdx.x * NWV + wid, nw = gridDim.x * NWV;
    for (int u = (int)gridDim.x - 1 - (int)blockIdx.x; u < NB * 4; u += gridDim.x) {
        const int b = u >> 2, h = u & 3;
        const float* srcp = p.hs + ((size_t)b * SEQ + tid * 4) * HS_W + h;
        float ls[4]; float tot = 0.f;
#pragma unroll
        for (int i = 0; i < 4; ++i) { const float f = srcp[(size_t)i * HS_W]; ls[i] = fminf(f, 0.f) - log1pf(__expf(-fabsf(f))); tot += ls[i]; }
        float inc = tot;
#pragma unroll
        for (int o = 1; o < 64; o <<= 1) { const float v = __shfl_up(inc, o); if (lane >= o) inc += v; }
        float* wtot = (float*)(lds + 65536);
        if (lane == 63) wtot[wid] = inc;
        __syncthreads();
        float base = inc - tot;
        for (int w = 0; w < wid; ++w) base += wtot[w];
        float4 o4; o4.x = base + ls[0]; o4.y = o4.x + ls[1]; o4.z = o4.y + ls[2]; o4.w = o4.z + ls[3];
        *(float4*)(p.cF + (size_t)u * SEQ + tid * 4) = o4;
        __syncthreads();
    }
    float* part = (float*)lds;
    bf16_t* h1 = (bf16_t*)(lds + 32768);
    for (int u = blockIdx.x; u < NB * 2 * 2 * 8; u += gridDim.x) {
        const int ct = u & 7, which = (u >> 3) & 1, kvh = (u >> 4) & 1, b = u >> 5;
        const int colo = (which ? C_NVC : C_NKC) + kvh * 64;
        const int c_lane = ct * 16 + fr;
        const int tokbase = min(c_lane, 126) * 16;
        const bf16_t* arow = p.hb + ((size_t)b * SEQ + tokbase) * NMAIN + colo + fq * 8;
        const bf16_t* w1 = p.W1T + ((size_t)(l * 2 + which) * 64 + fr) * 2048 + fq * 8;
        f32x4 acc[4];
#pragma unroll
        for (int n = 0; n < 4; ++n) acc[n] = (f32x4){0.f, 0.f, 0.f, 0.f};
#pragma unroll
        for (int kk = 0; kk < 8; ++kk) {
            const int ks = wid * 8 + kk;
            const bf16x8 a = *(const bf16x8*)(arow + (size_t)(ks >> 1) * NMAIN + (ks & 1) * 32);
#pragma unroll
            for (int n = 0; n < 4; ++n) {
                const bf16x8 bb = *(const bf16x8*)(w1 + (size_t)n * 16 * 2048 + ks * 32);
                acc[n] = __builtin_amdgcn_mfma_f32_16x16x32_bf16(a, bb, acc[n], 0, 0, 0);
            }
        }
#pragma unroll
        for (int n = 0; n < 4; ++n)
#pragma unroll
            for (int r = 0; r < 4; ++r) part[wid * 1024 + (fq * 4 + r) * 64 + n * 16 + fr] = acc[n][r];
        __syncthreads();
        const float* b1 = p.b1c + (l * 2 + which) * 64;
#pragma unroll
        for (int i = 0; i < 2; ++i) {
            const int e = tid + NTHR * i; float sum = 0.f;
#pragma unroll
            for (int w = 0; w < 8; ++w) sum += part[w * 1024 + e];
            h1[e] = f2bf(gelu_tanh(sum + b1[e & 63]));
        }
        __syncthreads();
        if (wid == 0) {
            const bf16_t* w2 = p.W2T + ((size_t)(l * 2 + which) * 64 + fr) * 64 + fq * 8;
            f32x4 o2[4];
#pragma unroll
            for (int n = 0; n < 4; ++n) o2[n] = (f32x4){0.f, 0.f, 0.f, 0.f};
#pragma unroll
            for (int ks = 0; ks < 2; ++ks) {
                const bf16x8 a = *(const bf16x8*)(h1 + fr * 64 + ks * 32 + fq * 8);
#pragma unroll
                for (int n = 0; n < 4; ++n) {
                    const bf16x8 bb = *(const bf16x8*)(w2 + (size_t)n * 16 * 64 + ks * 32);
                    o2[n] = __builtin_amdgcn_mfma_f32_16x16x32_bf16(a, bb, o2[n], 0, 0, 0);
                }
            }
            const size_t base = ((size_t)b * 2 + kvh) * 128 * 64;
#pragma unroll
            for (int n = 0; n < 4; ++n)
#pragma unroll
                for (int r = 0; r < 4; ++r) {
                    const int c = ct * 16 + fq * 4 + r, j2 = n * 16 + fr;
                    const bf16_t v = c < 127 ? f2bf(o2[n][r]) : (bf16_t)0;
                    if (which == 0) p.kc[base + (size_t)c * 64 + j2] = v;
                    else { p.vc[base + (size_t)c * 64 + j2] = v; p.vcT[base + (size_t)j2 * 128 + c] = v; }
                }
        }
        __syncthreads();
    }
}

constexpr float L2E = 1.4426950408889634f, MASKV = -1e30f, SCL2 = QSCALE * L2E;
struct KVFrag { bf16x8 k[2][2]; bf16x8 v[4]; };
__device__ __forceinline__ void k_load(KVFrag& f, const bf16_t* __restrict__ Kb, size_t ldk, int kc0, int fr, int fq) {
    const bf16_t* kp = Kb + (size_t)(kc0 + (fr >> 2) * 8 + (fr & 3)) * ldk + fq * 8;
    f.k[0][0] = *(const bf16x8*)(kp); f.k[0][1] = *(const bf16x8*)(kp + 32);
    f.k[1][0] = *(const bf16x8*)(kp + 4 * ldk); f.k[1][1] = *(const bf16x8*)(kp + 4 * ldk + 32);
}
__device__ __forceinline__ void v_load(bf16x8 (&v)[4], const bf16_t* __restrict__ VTb, size_t ldv, int kc0, int fr, int fq) {
    const bf16_t* vp = VTb + (size_t)fr * ldv + kc0 + fq * 8;
#pragma unroll
    for (int dt = 0; dt < 4; ++dt) v[dt] = *(const bf16x8*)(vp + (size_t)dt * 16 * ldv);
}
template <int NQT, bool MASK, class MB>
__device__ __forceinline__ void attn_compute(const KVFrag& f, const bf16x8 (&qf)[NQT][2], f32x4 (&o)[NQT][4], float (&m)[NQT], float (&l)[NQT], const MB& mb) {
#pragma unroll
    for (int qt = 0; qt < NQT; ++qt) {
        f32x4 s0 = (f32x4){0.f, 0.f, 0.f, 0.f}, s1 = s0;
        s0 = __builtin_amdgcn_mfma_f32_16x16x32_bf16(f.k[0][0], qf[qt][0], s0, 0, 0, 0);
        s0 = __builtin_amdgcn_mfma_f32_16x16x32_bf16(f.k[0][1], qf[qt][1], s0, 0, 0, 0);
        s1 = __builtin_amdgcn_mfma_f32_16x16x32_bf16(f.k[1][0], qf[qt][0], s1, 0, 0, 0);
        s1 = __builtin_amdgcn_mfma_f32_16x16x32_bf16(f.k[1][1], qf[qt][1], s1, 0, 0, 0);
        float v[8];
#pragma unroll
        for (int j = 0; j < 4; ++j) { v[j] = mb(qt, j, s0[j]); v[j + 4] = mb(qt, j + 4, s1[j]); }
        float mx = fmaxf(fmaxf(fmaxf(v[0], v[1]), fmaxf(v[2], v[3])), fmaxf(fmaxf(v[4], v[5]), fmaxf(v[6], v[7])));
        mx = fmaxf(mx, __shfl_xor(mx, 16)); mx = fmaxf(mx, __shfl_xor(mx, 32));
        const float mold = m[qt], mnew = fmaxf(mold, mx);
        m[qt] = mnew;
        float pr[8]; float ps = 0.f;
#pragma unroll
        for (int j = 0; j < 8; ++j) { pr[j] = (!MASK || v[j] > -1e29f) ? __builtin_amdgcn_exp2f(v[j] - mnew) : 0.f; ps += pr[j]; }
        if (__ballot(mnew != mold) != 0ull) {
            const float alpha = __builtin_amdgcn_exp2f(mold - mnew);
            l[qt] *= alpha;
#pragma unroll
            for (int dt = 0; dt < 4; ++dt) o[qt][dt] *= alpha;
        }
        l[qt] += ps;
        union { bf16x8 v8; unsigned u[4]; } pf;
        pf.u[0] = pack2(pr[0], pr[1]); pf.u[1] = pack2(pr[2], pr[3]); pf.u[2] = pack2(pr[4], pr[5]); pf.u[3] = pack2(pr[6], pr[7]);
#pragma unroll
        for (int dt = 0; dt < 4; ++dt) o[qt][dt] = __builtin_amdgcn_mfma_f32_16x16x32_bf16(f.v[dt], pf.v8, o[qt][dt], 0, 0, 0);
        __builtin_amdgcn_sched_barrier(0);
    }
}
struct RangeIt { int c, c_hi; __device__ __forceinline__ int nxt() { if (c > c_hi) return -1; return (c++) * 32; } };
struct MaskIt { unsigned long long cm; __device__ __forceinline__ int nxt() { if (!cm) return -1; const int i = __builtin_ctzll(cm); cm &= cm - 1; return i * 32; } };
template <bool PFV, class It, class Gen>
__device__ __forceinline__ void attn_run(It& it, const bf16_t* Kb, size_t ldk, const bf16_t* VTb, size_t ldv, int fr, int fq, const Gen& gen) {
    KVFrag fa, fb;
    int ka = it.nxt(); if (ka < 0) return;
    k_load(fa, Kb, ldk, ka, fr, fq); if (PFV) v_load(fa.v, VTb, ldv, ka, fr, fq);
    for (;;) {
        const int kb = it.nxt(); if (kb >= 0) { k_load(fb, Kb, ldk, kb, fr, fq); if (PFV) v_load(fb.v, VTb, ldv, kb, fr, fq); }
        if (!PFV) v_load(fa.v, VTb, ldv, ka, fr, fq);
        gen(ka, fa);
        if (kb < 0) break;
        ka = it.nxt(); if (ka >= 0) { k_load(fa, Kb, ldk, ka, fr, fq); if (PFV) v_load(fa.v, VTb, ldv, ka, fr, fq); }
        if (!PFV) v_load(fb.v, VTb, ldv, kb, fr, fq);
        gen(kb, fb);
        if (ka < 0) break;
    }
}
template <int NQT>
__device__ __forceinline__ void attn_init(f32x4 (&o)[NQT][4], float (&m)[NQT], float (&l)[NQT]) {
#pragma unroll
    for (int qt = 0; qt < NQT; ++qt) { m[qt] = MASKV; l[qt] = 0.f;
#pragma unroll
        for (int dt = 0; dt < 4; ++dt) o[qt][dt] = (f32x4){0.f, 0.f, 0.f, 0.f}; }
}
__device__ __forceinline__ float lsum4(float l) { l += __shfl_xor(l, 16); l += __shfl_xor(l, 32); return l; }
__device__ __forceinline__ void store_o4(bf16_t* dst, const f32x4 v) { u32x2 w; w.x = pack2(v[0], v[1]); w.y = pack2(v[2], v[3]); *(u32x2*)dst = w; }
__device__ __forceinline__ float sigmoidf_fast(float x) { return __builtin_amdgcn_rcpf(1.0f + __builtin_amdgcn_exp2f(-L2E * x)); }

__device__ __forceinline__ void fox_unit(const Params& p, int b, int h, int qb, int fr, int fq) {
    asm volatile("" : "+v"(fr), "+v"(fq));
    const int t0 = qb * 32;
    const bf16_t* Qb = p.hb + ((size_t)b * SEQ + t0) * NMAIN + C_FQ + h * 64 + fq * 8;
    bf16x8 qf[2][2];
#pragma unroll
    for (int qt = 0; qt < 2; ++qt) { qf[qt][0] = *(const bf16x8*)(Qb + (size_t)(qt * 16 + fr) * NMAIN); qf[qt][1] = *(const bf16x8*)(Qb + (size_t)(qt * 16 + fr) * NMAIN + 32); }
    const float* cf = p.cF + ((size_t)b * 4 + h) * SEQ;
    float cq[2];
#pragma unroll
    for (int qt = 0; qt < 2; ++qt) cq[qt] = cf[t0 + qt * 16 + fr] * L2E;
    f32x4 o[2][4]; float m[2], l[2];
    attn_init<2>(o, m, l);
    const bf16_t* Kb = p.hb + (size_t)b * SEQ * NMAIN + C_FK + h * 64;
    const bf16_t* VTb = p.vT + ((size_t)b * NVH + h) * 64 * SEQ;
    RangeIt it{0, t0 >> 5};
    attn_run<true>(it, Kb, NMAIN, VTb, SEQ, fr, fq, [&](int kc0, const KVFrag& f) {
        const float4 ca = *(const float4*)(cf + kc0 + 8 * fq), cb = *(const float4*)(cf + kc0 + 8 * fq + 4);
        const float ck[8] = {ca.x * L2E, ca.y * L2E, ca.z * L2E, ca.w * L2E, cb.x * L2E, cb.y * L2E, cb.z * L2E, cb.w * L2E};
        const int kq = kc0 + 8 * fq - t0 - fr;
        attn_compute<2, true>(f, qf, o, m, l, [&](int qt, int j, float raw) { return (kq + j - 16 * qt) > 0 ? MASKV : raw * SCL2 + cq[qt] - ck[j]; });
    });
#pragma unroll
    for (int qt = 0; qt < 2; ++qt) {
        const float inv = __builtin_amdgcn_rcpf(lsum4(l[qt]));
        bf16_t* dst = p.ob + ((size_t)b * SEQ + t0 + qt * 16 + fr) * DM + h * 64 + 4 * fq;
#pragma unroll
        for (int dt = 0; dt < 4; ++dt) store_o4(dst + dt * 16, o[qt][dt] * inv);
    }
}
__device__ __forceinline__ void swa_unit(const Params& p, int l_, int b, int kv, int pos, int fr, int fq) {
    asm volatile("" : "+v"(fr), "+v"(fq));
    const int t0 = pos * 16, t = t0 + fr;
    const bf16_t* Qb = p.hb + ((size_t)b * SEQ + t) * NMAIN + C_SQ + kv * 192 + fq * 8;
    bf16x8 qf[3][2];
#pragma unroll
    for (int g = 0; g < 3; ++g) { qf[g][0] = *(const bf16x8*)(Qb + g * 64); qf[g][1] = *(const bf16x8*)(Qb + g * 64 + 32); }
    float sl[3];
#pragma unroll
    for (int g = 0; g < 3; ++g) sl[g] = slope_swa(kv * 3 + g) * L2E;
    f32x4 o[3][4]; float m[3], l[3];
    attn_init<3>(o, m, l);
    const bf16_t* Kb = p.hb + (size_t)b * SEQ * NMAIN + C_SK + kv * 64;
    const bf16_t* VTb = p.vT + ((size_t)b * NVH + 4 + kv) * 64 * SEQ;
    RangeIt it{max(0, t0 - 127) >> 5, (t0 + 15) >> 5};
    attn_run<true>(it, Kb, NMAIN, VTb, SEQ, fr, fq, [&](int kc0, const KVFrag& f) {
        const int dq = t - kc0 - 8 * fq;
        attn_compute<3, true>(f, qf, o, m, l, [&](int g, int j, float raw) { const int dist = dq - j; return (dist >= 0 && dist < 128) ? raw * SCL2 - sl[g] * (float)dist : MASKV; });
    });
#pragma unroll
    for (int g = 0; g < 3; ++g) {
        const float sink = p.sinks[l_ * 6 + kv * 3 + g] * L2E;
        const float inv = __builtin_amdgcn_rcpf(lsum4(l[g]) + __builtin_amdgcn_exp2f(sink - m[g]));
        bf16_t* dst = p.ob + ((size_t)b * SEQ + t) * DM + 256 + (kv * 3 + g) * 64 + 4 * fq;
#pragma unroll
        for (int dt = 0; dt < 4; ++dt) store_o4(dst + dt * 16, o[g][dt] * inv);
    }
}
__device__ __forceinline__ void nsa_unit(const Params& p, int b, int kv, int pos, int fr, int fq, int lane, float* ps, unsigned* msk, float* otl) {
    asm volatile("" : "+v"(fr), "+v"(fq), "+v"(lane));
    const int t0 = pos * 16, t = t0 + fr, cur = t0 >> 6;
    const bf16_t* Qb = p.hb + ((size_t)b * SEQ + t) * NMAIN + C_NQ + kv * 192 + fq * 8;
    bf16x8 qf[3][2];
#pragma unroll
    for (int g = 0; g < 3; ++g) { qf[g][0] = *(const bf16x8*)(Qb + g * 64); qf[g][1] = *(const bf16x8*)(Qb + g * 64 + 32); }
    float sl[3];
#pragma unroll
    for (int g = 0; g < 3; ++g) sl[g] = slope_nsa(kv * 3 + g) * L2E;
    const float* gl = p.hs + ((size_t)b * SEQ + t) * HS_W + 4 + kv * 9;
    f32x4 o[3][4]; float m[3], l[3];
    f32x4* otv = (f32x4*)otl + lane;
#pragma unroll
    for (int i = 0; i < 8; ++i) ps[lane + 64 * i] = 0.f;
    {
        const bf16_t* Kb = p.kc + ((size_t)b * 2 + kv) * 128 * 64;
        const bf16_t* VTb = p.vcT + ((size_t)b * 2 + kv) * 64 * 128;
        const int ncv = (t0 + 15 >= 31) ? ((t0 + 15 - 31) >> 4) + 1 : 0;
        const int nch = (ncv + 31) >> 5;
        attn_init<3>(o, m, l);
        const int dq0 = t - 31 - 16 * 8 * fq;
        RangeIt it{0, nch - 1};
        attn_run<false>(it, Kb, 64, VTb, 128, fr, fq, [&](int kc0, const KVFrag& f) {
            const int dq = dq0 - 16 * kc0;
            attn_compute<3, true>(f, qf, o, m, l, [&](int g, int j, float raw) { const int dist = dq - 16 * j; return dist >= 0 ? raw * SCL2 - sl[g] * (float)dist : MASKV; });
        });
        float il[3];
#pragma unroll
        for (int g = 0; g < 3; ++g) {
            const float lt = lsum4(l[g]); il[g] = lt > 0.f ? __builtin_amdgcn_rcpf(lt) : 0.f;
            const float gate = sigmoidf_fast(gl[g * 3 + 0]);
#pragma unroll
            for (int dt = 0; dt < 4; ++dt) otv[(g * 4 + dt) * 64] = o[g][dt] * (il[g] * gate);
        }
        float carry_prev = 0.f;
        for (int c = 0; c < nch; ++c) {
            const int kc0 = c * 32, dq = dq0 - 16 * kc0;
            const bf16_t* kp = Kb + (size_t)(kc0 + (fr >> 2) * 8 + (fr & 3)) * 64 + fq * 8;
            const bf16x8 k00 = *(const bf16x8*)(kp), k01 = *(const bf16x8*)(kp + 32), k10 = *(const bf16x8*)(kp + 256), k11 = *(const bf16x8*)(kp + 256 + 32);
            float pc[8];
#pragma unroll
            for (int j = 0; j < 8; ++j) pc[j] = 0.f;
#pragma unroll
            for (int g = 0; g < 3; ++g) {
                f32x4 s0 = (f32x4){0.f, 0.f, 0.f, 0.f}, s1 = s0;
                s0 = __builtin_amdgcn_mfma_f32_16x16x32_bf16(k00, qf[g][0], s0, 0, 0, 0); s0 = __builtin_amdgcn_mfma_f32_16x16x32_bf16(k01, qf[g][1], s0, 0, 0, 0);
                s1 = __builtin_amdgcn_mfma_f32_16x16x32_bf16(k10, qf[g][0], s1, 0, 0, 0); s1 = __builtin_amdgcn_mfma_f32_16x16x32_bf16(k11, qf[g][1], s1, 0, 0, 0);
#pragma unroll
                for (int j = 0; j < 8; ++j) {
                    const int dist = dq - 16 * j; const float raw = j < 4 ? s0[j] : s1[j - 4];
                    if (dist >= 0) pc[j] += __builtin_amdgcn_exp2f(raw * SCL2 - sl[g] * (float)dist - m[g]) * il[g];
                }
            }
            const float cout = 0.5f * pc[7];
            float cin = __shfl_up(cout, 16);
            const float cwrap = __shfl(cout, fr + 48);
            if (fq == 0) cin = carry_prev;
            carry_prev = cwrap;
            const int n0 = (kc0 >> 2) + 2 * fq;
            ps[fr * 32 + n0] = cin + pc[0] + pc[1] + pc[2] + 0.5f * pc[3];
            ps[fr * 32 + n0 + 1] = 0.5f * pc[3] + pc[4] + pc[5] + pc[6] + 0.5f * pc[7];
        }
    }
    lds_wave_sync();
    if (lane < 16) {
        unsigned mask = 1u | (1u << cur); if (cur >= 1) mask |= 1u << (cur - 1);
        if (cur >= 3) {
            if (cur - 2 <= 5) mask |= (1u << (cur - 1)) - 2u;
            else {
                const float* my = ps + lane * 32;
                for (int r = 0; r < 5; ++r) {
                    float best = -1.0f; int bi = 1;
                    for (int j = 1; j <= cur - 2; ++j) { const float v = my[j]; if (!((mask >> j) & 1u) && v > best) { best = v; bi = j; } }
                    mask |= 1u << bi;
                }
            }
        }
        msk[lane] = mask;
    }
    lds_wave_sync();
    const unsigned qmask = msk[fr];
    lds_wave_sync();
    {
        const bf16_t* Kb = p.hb + (size_t)b * SEQ * NMAIN + C_NKS + kv * 64;
        const bf16_t* VTb = p.vT + ((size_t)b * NVH + 6 + kv) * 64 * SEQ;
        attn_init<3>(o, m, l);
        unsigned um = qmask;
        um |= __shfl_xor(um, 1); um |= __shfl_xor(um, 2); um |= __shfl_xor(um, 4); um |= __shfl_xor(um, 8);
        um = (unsigned)__builtin_amdgcn_readfirstlane((int)um) & (cur >= 31 ? 0xffffffffu : ((2u << cur) - 1u));
        unsigned long long cm = 0ull;
        for (unsigned r = um; r; r &= r - 1) { const int kb = __builtin_ctz(r); cm |= 3ull << (2 * kb); }
        MaskIt it{cm};
        attn_run<false>(it, Kb, NMAIN, VTb, SEQ, fr, fq, [&](int kc0, const KVFrag& f) {
            const bool mine = (qmask >> (kc0 >> 6)) & 1u;
            const int dq = t - kc0 - 8 * fq;
            attn_compute<3, true>(f, qf, o, m, l, [&](int g, int j, float raw) { const int dist = dq - j; return (mine && dist >= 0) ? raw * SCL2 - sl[g] * (float)dist : MASKV; });
        });
#pragma unroll
        for (int g = 0; g < 3; ++g) {
            const float lt = lsum4(l[g]); const float sc = (lt > 0.f ? __builtin_amdgcn_rcpf(lt) : 0.f) * sigmoidf_fast(gl[g * 3 + 1]);
#pragma unroll
            for (int dt = 0; dt < 4; ++dt) otv[(g * 4 + dt) * 64] += o[g][dt] * sc;
        }
    }
    {
        const bf16_t* Kb = p.hb + (size_t)b * SEQ * NMAIN + C_NKW + kv * 64;
        const bf16_t* VTb = p.vT + ((size_t)b * NVH + 8 + kv) * 64 * SEQ;
        attn_init<3>(o, m, l);
        RangeIt it{max(0, t0 - 511) >> 5, (t0 + 15) >> 5};
        attn_run<false>(it, Kb, NMAIN, VTb, SEQ, fr, fq, [&](int kc0, const KVFrag& f) {
            const int dq = t - kc0 - 8 * fq;
            attn_compute<3, true>(f, qf, o, m, l, [&](int g, int j, float raw) { const int dist = dq - j; return (dist >= 0 && dist < 512) ? raw * SCL2 - sl[g] * (float)dist : MASKV; });
        });
#pragma unroll
        for (int g = 0; g < 3; ++g) {
            const float lt = lsum4(l[g]); const float sc = (lt > 0.f ? __builtin_amdgcn_rcpf(lt) : 0.f) * sigmoidf_fast(gl[g * 3 + 2]);
            bf16_t* dst = p.ob + ((size_t)b * SEQ + t) * DM + 640 + (kv * 3 + g) * 64 + 4 * fq;
#pragma unroll
            for (int dt = 0; dt < 4; ++dt) store_o4(dst + dt * 16, otv[(g * 4 + dt) * 64] + o[g][dt] * sc);
        }
    }
}

__device__ __forceinline__ void phase_attn(const Params& p, int l, char* lds, int cslot = 16) {
    int tid = threadIdx.x; asm volatile("" : "+v"(tid));
    const int wid = tid >> 6, lane = tid & 63, fr = lane & 15, fq = lane >> 4;
    float* ps = (float*)(lds + wid * 14592); unsigned* msk = (unsigned*)(ps + 512); float* otl = ps + 576;
    unsigned* ctr = p.ctrl + cslot + l;
    constexpr unsigned NU_NSA = NB * 2 * 128, NU_FOX = NB * 4 * 64, NU_SWA = NB * 2 * 128;
    for (;;) {
        unsigned u = 0;
        if (lane == 0) u = __hip_atomic_fetch_add(ctr, 1u, __ATOMIC_RELAXED, __HIP_MEMORY_SCOPE_AGENT);
        u = (unsigned)__builtin_amdgcn_readfirstlane((int)u);
        if (u >= NU_NSA + NU_FOX + NU_SWA) break;
        if (u < NU_NSA) { const int pos = 127 - (int)(u >> 5), r = u & 31; nsa_unit(p, r >> 1, r & 1, pos, fr, fq, lane, ps, msk, otl); }
        else if (u < NU_NSA + NU_FOX) { const unsigned v = u - NU_NSA; const int qb = 63 - (int)(v >> 6), r = v & 63; fox_unit(p, r >> 2, r & 3, qb, fr, fq); }
        else { const unsigned v = u - NU_NSA - NU_FOX; const int pos = 127 - (int)(v >> 5), r = v & 31; swa_unit(p, l, r >> 1, r & 1, pos, fr, fq); }
    }
}

__device__ __forceinline__ void phase_ln1_router(const Params& p, int l, char* lds) {
    int tid = threadIdx.x; asm volatile("" : "+v"(tid));
    const int wid = tid >> 6, lane = tid & 63, fr = lane & 15, fq = lane >> 4;
    float* lg = (float*)lds + wid * 512;
    int* lcnt = (int*)(lds + 16384); int* lbase = lcnt + 32;
    const float* g1 = p.ln1_g + l * DM; const float* b1 = p.ln1_b + l * DM;
    const float* rw = p.rwT + (size_t)l * NE * 1024; const float* rb = p.router_b + l * NE;
    unsigned* gcount = p.ctrl + 64 + l * NE;
    for (int grp = blockIdx.x; grp < NTOK / 128; grp += gridDim.x) {
        const int tok0 = grp * 128 + wid * 16;
        if (tid < 32) lcnt[tid] = 0;
        float4 gg[4], bb[4];
#pragma unroll
        for (int j = 0; j < 4; ++j) { gg[j] = *(const float4*)(g1 + j * 256 + lane * 4); bb[j] = *(const float4*)(b1 + j * 256 + lane * 4); }
        for (int r0 = 0; r0 < 16; r0 += 4) {
            float4 v[4][4]; float s[4], qv[4];
#pragma unroll
            for (int i = 0; i < 4; ++i)
#pragma unroll
                for (int j = 0; j < 4; ++j) v[i][j] = *(const float4*)(p.tbuf + (size_t)(tok0 + r0 + i) * DM + j * 256 + lane * 4);
#pragma unroll
            for (int i = 0; i < 4; ++i) { s[i] = 0.f;
#pragma unroll
                for (int j = 0; j < 4; ++j) s[i] += (v[i][j].x + v[i][j].y) + (v[i][j].z + v[i][j].w); }
#pragma unroll
            for (int o = 32; o > 0; o >>= 1) {
#pragma unroll
                for (int i = 0; i < 4; ++i) s[i] += __shfl_xor(s[i], o); }
#pragma unroll
            for (int i = 0; i < 4; ++i) { const float mean = s[i] * (1.0f / 1024.0f); qv[i] = 0.f;
#pragma unroll
                for (int j = 0; j < 4; ++j) { v[i][j].x -= mean; v[i][j].y -= mean; v[i][j].z -= mean; v[i][j].w -= mean; qv[i] += (v[i][j].x * v[i][j].x + v[i][j].y * v[i][j].y) + (v[i][j].z * v[i][j].z + v[i][j].w * v[i][j].w); } }
#pragma unroll
            for (int o = 32; o > 0; o >>= 1) {
#pragma unroll
                for (int i = 0; i < 4; ++i) qv[i] += __shfl_xor(qv[i], o); }
#pragma unroll
            for (int i = 0; i < 4; ++i) {
                const float rstd = rsqrtf(qv[i] * (1.0f / 1024.0f) + LN_EPS);
                const size_t row = (size_t)(tok0 + r0 + i);
#pragma unroll
                for (int j = 0; j < 4; ++j) {
                    const int c = j * 256 + lane * 4;
                    float4 y; y.x = v[i][j].x * rstd * gg[j].x + bb[j].x; y.y = v[i][j].y * rstd * gg[j].y + bb[j].y; y.z = v[i][j].z * rstd * gg[j].z + bb[j].z; y.w = v[i][j].w * rstd * gg[j].w + bb[j].w;
                    *(float4*)(p.x1f + row * DM + c) = y;
                    *(unsigned*)((char*)p.x1b + row * DM + c) = pack4_fp8(y.x, y.y, y.z, y.w);
                }
            }
        }
        __syncthreads();
        f32x4 a0 = (f32x4){0.f, 0.f, 0.f, 0.f}, a1 = a0;
        const float* xr = p.x1f + (size_t)(tok0 + fr) * DM + 4 * fq;
        const float* w0 = rw + (size_t)fr * 1024 + 4 * fq; const float* w1 = rw + (size_t)(16 + fr) * 1024 + 4 * fq;
#pragma unroll 4
        for (int k0 = 0; k0 < 1024; k0 += 16) {
            const float4 xa = *(const float4*)(xr + k0), wb0 = *(const float4*)(w0 + k0), wb1 = *(const float4*)(w1 + k0);
            a0 = __builtin_amdgcn_mfma_f32_16x16x4f32(xa.x, wb0.x, a0, 0, 0, 0); a1 = __builtin_amdgcn_mfma_f32_16x16x4f32(xa.x, wb1.x, a1, 0, 0, 0);
            a0 = __builtin_amdgcn_mfma_f32_16x16x4f32(xa.y, wb0.y, a0, 0, 0, 0); a1 = __builtin_amdgcn_mfma_f32_16x16x4f32(xa.y, wb1.y, a1, 0, 0, 0);
            a0 = __builtin_amdgcn_mfma_f32_16x16x4f32(xa.z, wb0.z, a0, 0, 0, 0); a1 = __builtin_amdgcn_mfma_f32_16x16x4f32(xa.z, wb1.z, a1, 0, 0, 0);
            a0 = __builtin_amdgcn_mfma_f32_16x16x4f32(xa.w, wb0.w, a0, 0, 0, 0); a1 = __builtin_amdgcn_mfma_f32_16x16x4f32(xa.w, wb1.w, a1, 0, 0, 0);
        }
#pragma unroll
        for (int r = 0; r < 4; ++r) { lg[(fq * 4 + r) * 32 + fr] = a0[r] + rb[fr]; lg[(fq * 4 + r) * 32 + 16 + fr] = a1[r] + rb[16 + fr]; }
        lds_wave_sync();
        int e4[4] = {0, 0, 0, 0}; int rk[4] = {0, 0, 0, 0};
        if (lane < 16) {
            const float* my = lg + lane * 32; unsigned taken = 0u; float tv[4];
#pragma unroll
            for (int k = 0; k < 4; ++k) {
                float best = NEG_INF; int bi = 0;
                for (int e = 0; e < 32; ++e) { const float xv = my[e]; if (!((taken >> e) & 1u) && xv > best) { best = xv; bi = e; } }
                taken |= 1u << bi; e4[k] = bi; tv[k] = best;
            }
            const float e1 = __expf(tv[1] - tv[0]), e2 = __expf(tv[2] - tv[0]), e3 = __expf(tv[3] - tv[0]);
            const float inv = 1.0f / (1.0f + e1 + e2 + e3);
            const size_t row = (size_t)(tok0 + lane);
            *(float4*)(p.gw + row * 4) = make_float4(inv, e1 * inv, e2 * inv, e3 * inv);
        }
        __syncthreads();
        if (lane < 16) {
#pragma unroll
            for (int k = 0; k < 4; ++k) rk[k] = atomicAdd(&lcnt[e4[k]], 1);
        }
        __syncthreads();
        if (tid < 32) { const int c = lcnt[tid]; lbase[tid] = c ? (int)__hip_atomic_fetch_add(gcount + tid, (unsigned)c, __ATOMIC_RELAXED, __HIP_MEMORY_SCOPE_AGENT) : 0; }
        __syncthreads();
        if (lane < 16) {
            const int row = tok0 + lane; int pk[4];
#pragma unroll
            for (int k = 0; k < 4; ++k) { const int pos = lbase[e4[k]] + rk[k]; p.lists[(size_t)e4[k] * LIST_CAP + pos] = row * 4 + k; pk[k] = (pos << 5) | e4[k]; }
            *(int4*)(p.top_e + (size_t)row * 4) = make_int4(pk[0], pk[1], pk[2], pk[3]);
        }
        __syncthreads();
    }
}

__device__ __forceinline__ void phase_ln2(const Params& p, int l, float* xout, char* lds) {
    int* ptile = (int*)(lds + LDS_TAB); int* ecnt = ptile + 40;
    build_tiles(p, l, ptile, ecnt);
    int tid = threadIdx.x; asm volatile("" : "+v"(tid));
    const int wid = tid >> 6, lane = tid & 63;
    const float* g2 = p.ln2_g + l * DM; const float* b2 = p.ln2_b + l * DM;
    float4 gg[4], bb[4];
#pragma unroll
    for (int j = 0; j < 4; ++j) { gg[j] = *(const float4*)(g2 + j * 256 + lane * 4); bb[j] = *(const float4*)(b2 + j * 256 + lane * 4); }
    for (int pr = blockIdx.x * NWV + wid; pr < NTOK / 2; pr += gridDim.x * NWV) {
        float4 v[2][4]; float s[2], qv[2];
        u32x2 yv[2][4][4]; float gk[2][4];
#pragma unroll
        for (int i = 0; i < 2; ++i) {
            const int row = pr * 2 + i;
            const float4 gwv = *(const float4*)(p.gw + (size_t)row * 4);
            gk[i][0] = gwv.x; gk[i][1] = gwv.y; gk[i][2] = gwv.z; gk[i][3] = gwv.w;
            const int4 te = *(const int4*)(p.top_e + (size_t)row * 4);
            const int tk[4] = {te.x, te.y, te.z, te.w};
#pragma unroll
            for (int j = 0; j < 4; ++j) v[i][j] = *(const float4*)(p.x1f + (size_t)row * DM + j * 256 + lane * 4);
#pragma unroll
            for (int k = 0; k < 4; ++k) {
                const bf16_t* yr = p.ybuf + (size_t)(ptile[tk[k] & 31] * 256 + (tk[k] >> 5)) * DM + lane * 4;
#pragma unroll
                for (int j = 0; j < 4; ++j) yv[i][k][j] = *(const u32x2*)(yr + j * 256);
            }
        }
#pragma unroll
        for (int i = 0; i < 2; ++i) { s[i] = 0.f;
#pragma unroll
            for (int j = 0; j < 4; ++j) {
                float4 a; a.x = v[i][j].x * ALPHA; a.y = v[i][j].y * ALPHA; a.z = v[i][j].z * ALPHA; a.w = v[i][j].w * ALPHA;
#pragma unroll
                for (int k = 0; k < 4; ++k) {
                    const u32x2 w = yv[i][k][j];
                    a.x += gk[i][k] * __uint_as_float(w.x << 16); a.y += gk[i][k] * __uint_as_float(w.x & 0xffff0000u);
                    a.z += gk[i][k] * __uint_as_float(w.y << 16); a.w += gk[i][k] * __uint_as_float(w.y & 0xffff0000u);
                }
                v[i][j] = a; s[i] += (a.x + a.y) + (a.z + a.w);
            } }
#pragma unroll
        for (int o = 32; o > 0; o >>= 1) { s[0] += __shfl_xor(s[0], o); s[1] += __shfl_xor(s[1], o); }
#pragma unroll
        for (int i = 0; i < 2; ++i) { const float mean = s[i] * (1.0f / 1024.0f); qv[i] = 0.f;
#pragma unroll
            for (int j = 0; j < 4; ++j) { v[i][j].x -= mean; v[i][j].y -= mean; v[i][j].z -= mean; v[i][j].w -= mean; qv[i] += (v[i][j].x * v[i][j].x + v[i][j].y * v[i][j].y) + (v[i][j].z * v[i][j].z + v[i][j].w * v[i][j].w); } }
#pragma unroll
        for (int o = 32; o > 0; o >>= 1) { qv[0] += __shfl_xor(qv[0], o); qv[1] += __shfl_xor(qv[1], o); }
#pragma unroll
        for (int i = 0; i < 2; ++i) {
            const float rstd = rsqrtf(qv[i] * (1.0f / 1024.0f) + LN_EPS);
            const size_t row = (size_t)(pr * 2 + i);
#pragma unroll
            for (int j = 0; j < 4; ++j) {
                const int c = j * 256 + lane * 4;
                float4 y; y.x = v[i][j].x * rstd * gg[j].x + bb[j].x; y.y = v[i][j].y * rstd * gg[j].y + bb[j].y; y.z = v[i][j].z * rstd * gg[j].z + bb[j].z; y.w = v[i][j].w * rstd * gg[j].w + bb[j].w;
                *(float4*)(xout + row * DM + c) = y;
                u32x2 w; w.x = pack2(y.x, y.y); w.y = pack2(y.z, y.w);
                *(u32x2*)(p.xb + row * DM + c) = w;
            }
        }
    }
}

#define XB_TMO      128
#define XB_XCNT(j)  (256  + 64 * (j))
#define XB_XSUB(j)  (1280 + 64 * (j))
#define XB_XGEN(j)  (2304 + 64 * (j))
#define XB_TOP      3328
#define XB_TOPGEN   3392
#define XCD_BAR_WORDS 3456
#define XB_SPIN_CAP (1u << 22)
__device__ __forceinline__ unsigned xb_ld(unsigned* p)              { return __hip_atomic_load(p, __ATOMIC_RELAXED, __HIP_MEMORY_SCOPE_AGENT); }
__device__ __forceinline__ unsigned xb_add(unsigned* p, unsigned v) { return __hip_atomic_fetch_add(p, v, __ATOMIC_RELAXED, __HIP_MEMORY_SCOPE_AGENT); }
__device__ __forceinline__ unsigned xb_xcc_id() { return (unsigned)__builtin_amdgcn_s_getreg((3 << 11) | 20) & 0xFu; }
#define XB_SPIN(cond, bar) do { unsigned _sp = 0; while (cond) { __builtin_amdgcn_s_sleep(1); \
    if ((++_sp & 255u) == 0u) { if (xb_ld(&(bar)[XB_TMO])) break; if (_sp > XB_SPIN_CAP) { atomicAdd(&(bar)[XB_TMO], 1u); break; } } } } while (0)
struct XcdBarrier { unsigned* bar; unsigned x; volatile LAS unsigned* st; };
__device__ __forceinline__ XcdBarrier xcd_barrier_post(unsigned* bar, volatile LAS unsigned* st) {
    XcdBarrier b; b.bar = bar; b.x = xb_xcc_id(); b.st = st;
    if (threadIdx.x == 0) (void)xb_add(&bar[XB_XCNT(b.x)], 1u);
    return b;
}
__device__ __forceinline__ void xcd_barrier_complete(unsigned* bar, unsigned x, unsigned& nloc, unsigned& nx) {
    const unsigned G = gridDim.x * gridDim.y * gridDim.z;
    unsigned sum, cnt, mine, sp = 0u;
    for (;;) {
        sum = 0u; cnt = 0u; mine = 0u;
#pragma unroll
        for (unsigned j = 0; j < 16; ++j) { const unsigned c = xb_ld(&bar[XB_XCNT(j)]); sum += c; cnt += (c > 0u) ? 1u : 0u; mine = (j == x) ? c : mine; }
        if (sum == G) break;
        __builtin_amdgcn_s_sleep(1);
        if ((++sp & 255u) == 0u) { if (xb_ld(&bar[XB_TMO])) break; if (sp > XB_SPIN_CAP) { atomicAdd(&bar[XB_TMO], 1u); break; } }
    }
    nloc = mine > 0u ? mine : 1u; nx = cnt > 0u ? cnt : 1u;
}
__device__ __forceinline__ void xcd_barrier(const XcdBarrier& b) {
    asm volatile("s_waitcnt vmcnt(0)" ::: "memory");
    __syncthreads();
    if (threadIdx.x == 0) {
        unsigned* bar = b.bar;
        __builtin_amdgcn_s_waitcnt(0);
        unsigned nloc = b.st[0], nx = b.st[1];
        if (nloc == 0u) { xcd_barrier_complete(bar, b.x, nloc, nx); b.st[0] = nloc; b.st[1] = nx; }
        const unsigned old = xb_add(&bar[XB_XSUB(b.x)], 1u);
        const unsigned gen = old / nloc;
        if (old + 1u == (gen + 1u) * nloc) {
            __builtin_amdgcn_fence(__ATOMIC_RELEASE, "agent");
            asm volatile("s_waitcnt vmcnt(0)" ::: "memory");
            const unsigned og = xb_add(&bar[XB_TOP], 1u);
            const unsigned tg = og / nx;
            if (og + 1u == (tg + 1u) * nx) xb_add(&bar[XB_TOPGEN], 1u);
            else XB_SPIN(xb_ld(&bar[XB_TOPGEN]) == tg, bar);
            __builtin_amdgcn_fence(__ATOMIC_ACQUIRE, "agent");
            xb_add(&bar[XB_XGEN(b.x)], 1u);
            asm volatile("s_waitcnt vmcnt(0)" ::: "memory");
        } else {
            XB_SPIN(xb_ld(&bar[XB_XGEN(b.x)]) == gen, bar);
            __builtin_amdgcn_fence(__ATOMIC_ACQUIRE, "agent");
            asm volatile("s_waitcnt vmcnt(0)" ::: "memory");
        }
    }
    __syncthreads();
}

struct KArgs { const float* in[18]; float* out; char* ws; };
constexpr size_t al256(size_t v) { return (v + 255) / 256 * 256; }
struct WSL {
    static constexpr size_t ctrl = 0;
    static constexpr size_t WinT = al256(ctrl + 65536);
    static constexpr size_t WoT = al256(WinT + (size_t)NL * NPAD * 1024 * 2);
    static constexpr size_t W1T = al256(WoT + (size_t)NL * 1024 * 1024 * 2);
    static constexpr size_t W2T = al256(W1T + (size_t)NL * 2 * 64 * 2048 * 2);
    static constexpr size_t WguT = al256(W2T + (size_t)NL * 2 * 64 * 64 * 2);
    static constexpr size_t WdnT = al256(WguT + (size_t)NL * NE * 2048 * 1024 * 2);
    static constexpr size_t rwT = al256(WdnT + (size_t)NL * NE * 1024 * 1024 * 2);
    static constexpr size_t binp = al256(rwT + (size_t)NL * NE * 1024 * 4);
    static constexpr size_t bgup = al256(binp + (size_t)NL * NPAD * 4);
    static constexpr size_t b1c = al256(bgup + (size_t)NL * NE * 2048 * 4);
    static constexpr size_t xf = al256(b1c + 4 * 64 * 4);
    static constexpr size_t xb = al256(xf + (size_t)NTOK * DM * 4);
    static constexpr size_t hb = al256(xb + (size_t)NTOK * DM * 2);
    static constexpr size_t hs = al256(hb + (size_t)NTOK * NMAIN * 2);
    static constexpr size_t vT = al256(hs + (size_t)NTOK * HS_W * 4);
    static constexpr size_t cF = al256(vT + (size_t)NB * NVH * 64 * SEQ * 2);
    static constexpr size_t kc = al256(cF + (size_t)NB * 4 * SEQ * 4);
    static constexpr size_t vc = al256(kc + (size_t)NB * 2 * 128 * 64 * 2);
    static constexpr size_t vcT = al256(vc + (size_t)NB * 2 * 128 * 64 * 2);
    static constexpr size_t ob = al256(vcT + (size_t)NB * 2 * 128 * 64 * 2);
    static constexpr size_t tbuf = al256(ob + (size_t)NTOK * DM * 2);
    static constexpr size_t x1f = al256(tbuf + (size_t)NTOK * DM * 4);
    static constexpr size_t x1b = al256(x1f + (size_t)NTOK * DM * 4);
    static constexpr size_t top_e = al256(x1b + (size_t)NTOK * DM * 2);
    static constexpr size_t gw = al256(top_e + (size_t)NTOK * 4 * 4);
    static constexpr size_t lists = al256(gw + (size_t)NTOK * 4 * 4);
    static constexpr size_t act = al256(lists + (size_t)NE * LIST_CAP * 4);
    static constexpr size_t ybuf = al256(act + (size_t)MAXSLOT * DFF * 2);
    static constexpr size_t total = al256(ybuf + (size_t)MAXSLOT * DM * 2);
};
__device__ __forceinline__ Params make_params(const KArgs& k) {
    Params p;
    p.x = k.in[0]; p.w_in = k.in[1]; p.b_in = k.in[2]; p.sinks = k.in[3]; p.cmp_pe = k.in[4]; p.cmp_w1 = k.in[5]; p.cmp_w2 = k.in[6]; p.w_out = k.in[7];
    p.ln1_g = k.in[8]; p.ln1_b = k.in[9]; p.router_w = k.in[10]; p.router_b = k.in[11]; p.w_gu = k.in[12]; p.b_gu = k.in[13]; p.w_dn = k.in[14]; p.b_dn = k.in[15];
    p.ln2_g = k.in[16]; p.ln2_b = k.in[17]; p.out = k.out;
    char* w = k.ws;
    p.ctrl = (unsigned*)(w + WSL::ctrl); p.WinT = (bf16_t*)(w + WSL::WinT); p.WoT = (bf16_t*)(w + WSL::WoT); p.W1T = (bf16_t*)(w + WSL::W1T); p.W2T = (bf16_t*)(w + WSL::W2T);
    p.WguT = (bf16_t*)(w + WSL::WguT); p.WdnT = (bf16_t*)(w + WSL::WdnT); p.rwT = (float*)(w + WSL::rwT); p.binp = (float*)(w + WSL::binp); p.bgup = (float*)(w + WSL::bgup);
    p.b1c = (float*)(w + WSL::b1c); p.xf = (float*)(w + WSL::xf); p.xb = (bf16_t*)(w + WSL::xb); p.hb = (bf16_t*)(w + WSL::hb); p.hs = (float*)(w + WSL::hs); p.vT = (bf16_t*)(w + WSL::vT);
    p.cF = (float*)(w + WSL::cF); p.kc = (bf16_t*)(w + WSL::kc); p.vc = (bf16_t*)(w + WSL::vc); p.vcT = (bf16_t*)(w + WSL::vcT); p.ob = (bf16_t*)(w + WSL::ob); p.tbuf = (float*)(w + WSL::tbuf);
    p.x1f = (float*)(w + WSL::x1f); p.x1b = (bf16_t*)(w + WSL::x1b); p.top_e = (int*)(w + WSL::top_e); p.gw = (float*)(w + WSL::gw); p.lists = (int*)(w + WSL::lists);
    p.act = (bf16_t*)(w + WSL::act); p.ybuf = (bf16_t*)(w + WSL::ybuf);
    return p;
}
__device__ __forceinline__ void grid_bar(const Params& p, char* lds) {
    XcdBarrier xb; xb.bar = p.ctrl + 1024; xb.x = xb_xcc_id(); xb.st = (volatile LAS unsigned*)(lds + LDS_BYTES - 16); xcd_barrier(xb);
}
template <int L>
__device__ __forceinline__ void layer_fwd(const Params& p, char* lds) {
    const float* xin = L == 0 ? p.x : p.xf;
    float* xout = L == NL - 1 ? p.out : p.xf;
#ifndef REP
#define REP 0
#endif
    phase_inproj(p, L, lds);        grid_bar(p, lds);
    if (REP & 1) { phase_inproj(p, L, lds);        grid_bar(p, lds); }
    phase_prep(p, L, lds);          grid_bar(p, lds);
    if (REP & 2) { phase_prep(p, L, lds);          grid_bar(p, lds); }
    phase_attn(p, L, lds);          grid_bar(p, lds);
    if (REP & 4) { phase_attn(p, L, lds, 24);      grid_bar(p, lds); }
    phase_outproj(p, L, xin, lds);  grid_bar(p, lds);
    if (REP & 8) { phase_outproj(p, L, xin, lds);  grid_bar(p, lds); }
    phase_ln1_router(p, L, lds);    grid_bar(p, lds);
    phase_gateup(p, L, lds);        grid_bar(p, lds);
    if (REP & 16) { phase_gateup(p, L, lds);       grid_bar(p, lds); }
    phase_down(p, L, lds);          grid_bar(p, lds);
    if (REP & 32) { phase_down(p, L, lds);         grid_bar(p, lds); }
    phase_ln2(p, L, xout, lds);
    if (REP & 64) { grid_bar(p, lds); phase_ln2(p, L, xout, lds); }
}
__global__ void __launch_bounds__(NTHR, 2) fwd_kernel(KArgs ka) {
    extern __shared__ __attribute__((aligned(16))) char lds[];
    const Params p = make_params(ka);
    cg::grid_group grid = cg::this_grid();
    volatile LAS unsigned* xst = (volatile LAS unsigned*)(lds + LDS_BYTES - 16);
    if (threadIdx.x == 0) { xst[0] = 0u; xst[1] = 0u; }
    __syncthreads();
    (void)xcd_barrier_post(p.ctrl + 1024, xst);
    phase0(p, lds);
    if (REP & 128) { grid_bar(p, lds); phase0(p, lds); }
    grid.sync();
    layer_fwd<0>(p, lds);
    grid_bar(p, lds);
    layer_fwd<1>(p, lds);
}

extern "C" void kernel_launch(void* const* d_in, const int* in_sizes, int n_in, void* d_out, int out_size, void* d_ws, size_t ws_size, hipStream_t stream) {
    KArgs ka{};
    for (int i = 0; i < 18; ++i) ka.in[i] = (const float*)d_in[i];
    ka.out = (float*)d_out; ka.ws = (char*)d_ws;
    if (WSL::total > ws_size) { fprintf(stderr, "workspace too small: need %zu have %zu\n", (size_t)WSL::total, ws_size); return; }
    static int grid_blocks = 0;
    if (!grid_blocks) {
        int dev = 0, cus = 0, per_cu = 0;
        (void)hipGetDevice(&dev);
        (void)hipDeviceGetAttribute(&cus, hipDeviceAttributeMultiprocessorCount, dev);
        (void)hipFuncSetAttribute((const void*)fwd_kernel, hipFuncAttributeMaxDynamicSharedMemorySize, LDS_BYTES);
        (void)hipOccupancyMaxActiveBlocksPerMultiprocessor(&per_cu, fwd_kernel, NTHR, LDS_BYTES);
        if (per_cu < 1) { fprintf(stderr, "occupancy query says 0 blocks per CU\n"); per_cu = 1; }
        grid_blocks = cus;
    }
    (void)hipMemsetAsync(d_ws, 0, 65536, stream);
    void* args[] = {&ka};
    hipError_t e = hipLaunchCooperativeKernel((const void*)fwd_kernel, dim3(grid_blocks), dim3(NTHR), args, LDS_BYTES, stream);
    if (e != hipSuccess) fprintf(stderr, "cooperative launch failed: %s (grid %d)\n", hipGetErrorString(e), grid_blocks);
}
```

```cpp
#include <hip/hip_runtime.h>
#include <hip/hip_cooperative_groups.h>
#include <cstdio>
#include <cstdint>
namespace cg = cooperative_groups;

typedef unsigned short bf16_t;
typedef short bf16x8 __attribute__((ext_vector_type(8)));
typedef float f32x4 __attribute__((ext_vector_type(4)));
typedef unsigned u32x4 __attribute__((ext_vector_type(4)));
typedef unsigned u32x2 __attribute__((ext_vector_type(2)));
typedef int v8i_t __attribute__((ext_vector_type(8)));
typedef int v4i_t __attribute__((ext_vector_type(4)));
#define LAS __attribute__((address_space(3)))
constexpr float NEG_INF = -__builtin_huge_valf();

constexpr int DM = 1024, NB = 16, SEQ = 2048, NTOK = NB * SEQ, NL = 2;
constexpr int NCOL = 2582, NMAIN = 2560, NPAD = 2688, NE = 32, DFF = 1024;
constexpr int C_FQ = 0, C_FK = 256, C_FV = 512, C_SQ = 768, C_SK = 1152, C_SV = 1280, C_NQ = 1408,
              C_NKC = 1792, C_NVC = 1920, C_NKS = 2048, C_NVS = 2176, C_NKW = 2304, C_NVW = 2432;
constexpr int HS_W = 32;
constexpr int NVH = 10;
constexpr int LIST_CAP = NTOK;
constexpr int MAXSLOT = NTOK * 4 + NE * 256;
constexpr float ALPHA = 1.41421356237f, LN_EPS = 1e-5f, QSCALE = 0.125f;
constexpr int NWV = 8, NTHR = NWV * 64;
constexpr int LDS_STAGE = 131072, LDS_TAB = LDS_STAGE, LDS_AOFF = LDS_STAGE + 2048, LDS_BYTES = LDS_AOFF + 20480 + 256;

struct Params {
    const float *x, *w_in, *b_in, *sinks, *cmp_pe, *cmp_w1, *cmp_w2, *w_out, *ln1_g, *ln1_b, *router_w, *router_b,
                *w_gu, *b_gu, *w_dn, *b_dn, *ln2_g, *ln2_b;
    float* out;
    unsigned* ctrl;
    bf16_t *WinT, *WoT, *W1T, *W2T, *WguT, *WdnT;
    float *rwT, *binp, *bgup, *b1c;
    float* xf; bf16_t* xb; bf16_t* hb; float* hs; bf16_t* vT; float* cF;
    bf16_t *kc, *vc, *vcT; bf16_t* ob; float* tbuf; float* x1f; bf16_t* x1b;
    int* top_e; float* gw; int* lists; bf16_t* act; bf16_t* ybuf;
};

__device__ __forceinline__ float bf2f(bf16_t h) { return __uint_as_float(((unsigned)h) << 16); }
typedef __bf16 bf16x2_t __attribute__((ext_vector_type(2)));
__device__ __forceinline__ bf16_t f2bf(float f) { return __builtin_bit_cast(bf16_t, (__bf16)f); }
__device__ __forceinline__ unsigned pack2(float lo, float hi) { bf16x2_t v = {(__bf16)lo, (__bf16)hi}; return __builtin_bit_cast(unsigned, v); }
__device__ __forceinline__ unsigned pack4_fp8(float a, float b, float c, float d) {
    unsigned w = 0u;
    w = __builtin_amdgcn_cvt_pk_fp8_f32(a, b, w, false);
    w = __builtin_amdgcn_cvt_pk_fp8_f32(c, d, w, true);
    return w;
}
__device__ __forceinline__ float wave_sum(float v) {
#pragma unroll
    for (int o = 32; o > 0; o >>= 1) v += __shfl_xor(v, o);
    return v;
}
__device__ __forceinline__ float wave_max(float v) {
#pragma unroll
    for (int o = 32; o > 0; o >>= 1) v = fmaxf(v, __shfl_xor(v, o));
    return v;
}
__device__ __forceinline__ void lds_wave_sync() { asm volatile("s_waitcnt lgkmcnt(0)" ::: "memory"); __builtin_amdgcn_wave_barrier(); }
__device__ __forceinline__ float slope_swa(int hq) { return exp2f(-8.0f * (float)(2 * hq + 1) / 12.0f); }
__device__ __forceinline__ float slope_nsa(int hq) { return exp2f(-8.0f * (float)(2 * hq + 2) / 12.0f); }

__device__ __forceinline__ int perm_row(int perm, int n) {
    if (perm == 1) { if (n < 768) return n; if (n < 772) return 2560 + (n - 768); if (n < 2564) return n - 4; return n; }
    if (perm == 2) { const int f = n >> 1, s = n & 1; return (f >> 7) * 256 + s * 128 + (f & 127); }
    return n;
}
struct ConvJob { const float* src; bf16_t* dst; int K, N, kt, nt, perm; float q8; };
__device__ __forceinline__ bool conv_job(const Params& p, int t, ConvJob& jb) {
    constexpr int T_WIN = NL * 8 * 21, T_WO = NL * 8 * 8;
    if (t < T_WIN) { const int m = t / 168, r = t % 168; jb = ConvJob{p.w_in + (size_t)m * 1024 * NCOL, p.WinT + (size_t)m * NPAD * 1024, 1024, NCOL, r / 21, r % 21, 1, 0.f}; return true; }
    t -= T_WIN;
    if (t < T_WO) { const int m = t / 64, r = t % 64; jb = ConvJob{p.w_out + (size_t)m * 1024 * 1024, p.WoT + (size_t)m * 1024 * 1024, 1024, 1024, r / 8, r % 8, 0, 0.f}; return true; }
    return false;
}
constexpr int CONV_TILES = NL * NE * 192;
__device__ __forceinline__ void conv_tile_wave(const Params& p, int t, int lane, unsigned char* l8) {
    asm volatile("" : "+v"(lane));
    const int m = t / 192, r = t % 192;
    const float* src; unsigned char* dst; int N, kt, nt, perm;
    if (r < 128) { src = p.w_gu + (size_t)m * 1024 * 2048; dst = (unsigned char*)p.WguT + (size_t)m * 2048 * 1024; N = 2048; kt = r >> 4; nt = r & 15; perm = 2; }
    else { const int q = r - 128; src = p.w_dn + (size_t)m * 1024 * 1024; dst = (unsigned char*)p.WdnT + (size_t)m * 1024 * 1024; N = 1024; kt = q >> 3; nt = q & 7; perm = 0; }
    const float* s = src + (size_t)(kt * 128 + (lane >> 5)) * N + nt * 128 + (lane & 31) * 4;
    unsigned char* lw = l8 + (lane >> 5) * 132 + (lane & 31) * 4;
    float4 va[16], vb[16];
#pragma unroll
    for (int i = 0; i < 16; ++i) va[i] = *(const float4*)(s + (size_t)(2 * i) * N);
#pragma unroll
    for (int i = 0; i < 16; ++i) vb[i] = *(const float4*)(s + (size_t)(32 + 2 * i) * N);
#pragma unroll
    for (int i = 0; i < 16; ++i) *(unsigned*)(lw + (2 * i) * 132) = pack4_fp8(va[i].x * 64.0f, va[i].y * 64.0f, va[i].z * 64.0f, va[i].w * 64.0f);
#pragma unroll
    for (int i = 0; i < 16; ++i) va[i] = *(const float4*)(s + (size_t)(64 + 2 * i) * N);
#pragma unroll
    for (int i = 0; i < 16; ++i) *(unsigned*)(lw + (32 + 2 * i) * 132) = pack4_fp8(vb[i].x * 64.0f, vb[i].y * 64.0f, vb[i].z * 64.0f, vb[i].w * 64.0f);
#pragma unroll
    for (int i = 0; i < 16; ++i) vb[i] = *(const float4*)(s + (size_t)(96 + 2 * i) * N);
#pragma unroll
    for (int i = 0; i < 16; ++i) *(unsigned*)(lw + (64 + 2 * i) * 132) = pack4_fp8(va[i].x * 64.0f, va[i].y * 64.0f, va[i].z * 64.0f, va[i].w * 64.0f);
#pragma unroll
    for (int i = 0; i < 16; ++i) *(unsigned*)(lw + (96 + 2 * i) * 132) = pack4_fp8(vb[i].x * 64.0f, vb[i].y * 64.0f, vb[i].z * 64.0f, vb[i].w * 64.0f);
    lds_wave_sync();
#pragma unroll 4
    for (int i = 0; i < 16; ++i) {
        const int idx = lane + 64 * i, kc = idx & 7, nn = idx >> 3;
        const unsigned char* l = l8 + (kc * 16) * 132 + nn;
        u32x4 w;
        w.x = (unsigned)l[0] | ((unsigned)l[132] << 8) | ((unsigned)l[264] << 16) | ((unsigned)l[396] << 24);
        w.y = (unsigned)l[528] | ((unsigned)l[660] << 8) | ((unsigned)l[792] << 16) | ((unsigned)l[924] << 24);
        w.z = (unsigned)l[1056] | ((unsigned)l[1188] << 8) | ((unsigned)l[1320] << 16) | ((unsigned)l[1452] << 24);
        w.w = (unsigned)l[1584] | ((unsigned)l[1716] << 8) | ((unsigned)l[1848] << 16) | ((unsigned)l[1980] << 24);
        *(u32x4*)(dst + (size_t)perm_row(perm, nt * 128 + nn) * 1024 + kt * 128 + kc * 16) = w;
    }
    lds_wave_sync();
}
__device__ __forceinline__ void conv_load(const ConvJob& jb, int tid, float2 (&v)[16]) {
    const int n = jb.nt * 128 + (tid & 31) * 4;
    const float* s = jb.src + (size_t)(jb.kt * 128 + (tid >> 5)) * jb.N + n;
#pragma unroll
    for (int i = 0; i < 8; ++i) {
        const float* r = s + (size_t)(16 * i) * jb.N;
        v[2 * i] = (n + 1 < jb.N) ? *(const float2*)r : make_float2(0.f, 0.f);
        v[2 * i + 1] = (n + 3 < jb.N) ? *(const float2*)(r + 2) : make_float2(0.f, 0.f);
    }
}
__device__ __forceinline__ void phase0(const Params& p, char* ldsc) {
    int tid = threadIdx.x; asm volatile("" : "+v"(tid));
    const int G = gridDim.x, bid = blockIdx.x;
    const size_t gtid = (size_t)bid * NTHR + tid, gthreads = (size_t)G * NTHR;
    {
        constexpr int TOT = NL * 8 * 21 + NL * 8 * 8;
        bf16_t* lt = (bf16_t*)ldsc;
        ConvJob jb, jn; float2 v[16], vn[16];
        int t = bid; bool have = t < TOT && conv_job(p, t, jb);
        if (have) conv_load(jb, tid, v);
        while (have) {
            const int tn = t + G; const bool hn = tn < TOT && conv_job(p, tn, jn);
            if (hn) conv_load(jn, tid, vn);
            if (jb.q8 != 0.f) {
                unsigned char* l8 = (unsigned char*)lt;
#pragma unroll
                for (int i = 0; i < 8; ++i)
                    *(unsigned*)(l8 + ((tid >> 5) + 16 * i) * 132 + (tid & 31) * 4) = pack4_fp8(v[2 * i].x * jb.q8, v[2 * i].y * jb.q8, v[2 * i + 1].x * jb.q8, v[2 * i + 1].y * jb.q8);
                __syncthreads();
#pragma unroll
                for (int i = 0; i < 2; ++i) {
                    const int idx = tid + NTHR * i, kc = idx & 7, nn = idx >> 3, n = jb.nt * 128 + nn;
                    const unsigned char* l = l8 + (kc * 16) * 132 + nn;
                    u32x4 w;
                    w.x = (unsigned)l[0] | ((unsigned)l[132] << 8) | ((unsigned)l[264] << 16) | ((unsigned)l[396] << 24);
                    w.y = (unsigned)l[528] | ((unsigned)l[660] << 8) | ((unsigned)l[792] << 16) | ((unsigned)l[924] << 24);
                    w.z = (unsigned)l[1056] | ((unsigned)l[1188] << 8) | ((unsigned)l[1320] << 16) | ((unsigned)l[1452] << 24);
                    w.w = (unsigned)l[1584] | ((unsigned)l[1716] << 8) | ((unsigned)l[1848] << 16) | ((unsigned)l[1980] << 24);
                    *(u32x4*)((char*)jb.dst + (size_t)perm_row(jb.perm, n) * jb.K + jb.kt * 128 + kc * 16) = w;
                }
            } else {
#pragma unroll
                for (int i = 0; i < 8; ++i) {
                    u32x2 w; w.x = pack2(v[2 * i].x, v[2 * i].y); w.y = pack2(v[2 * i + 1].x, v[2 * i + 1].y);
                    *(u32x2*)(lt + ((tid >> 5) + 16 * i) * 136 + (tid & 31) * 4) = w;
                }
                __syncthreads();
#pragma unroll
                for (int i = 0; i < 4; ++i) {
                    const int idx = tid + NTHR * i, kc = idx & 15, nn = idx >> 4, n = jb.nt * 128 + nn;
                    if (n < jb.N) {
                        const bf16_t* l = lt + (kc * 8) * 136 + nn;
                        u32x4 w;
                        w.x = (unsigned)l[0] | ((unsigned)l[136] << 16); w.y = (unsigned)l[272] | ((unsigned)l[408] << 16);
                        w.z = (unsigned)l[544] | ((unsigned)l[680] << 16); w.w = (unsigned)l[816] | ((unsigned)l[952] << 16);
                        *(u32x4*)(jb.dst + (size_t)perm_row(jb.perm, n) * jb.K + jb.kt * 128 + kc * 8) = w;
                    }
                }
            }
            __syncthreads();
            t = tn; have = hn; jb = jn;
#pragma unroll
            for (int i = 0; i < 16; ++i) v[i] = vn[i];
        }
    }
    for (size_t i = gtid; i < (size_t)NL * 2 * 2048 * 64; i += gthreads) {
        const int k = (int)(i % 2048), n = (int)((i / 2048) % 64), m = (int)(i / (2048 * 64));
        p.W1T[i] = f2bf(p.cmp_w1[((size_t)m * 2048 + k) * 64 + n]);
    }
    for (size_t i = gtid; i < (size_t)NL * 2 * 64 * 64; i += gthreads) {
        const int k = (int)(i % 64), n = (int)((i / 64) % 64), m = (int)(i / 4096);
        p.W2T[i] = f2bf(p.cmp_w2[((size_t)m * 64 + k) * 64 + n]);
    }
    for (size_t i = gtid; i < (size_t)NL * NPAD; i += gthreads) {
        const int l = (int)(i / NPAD), r = (int)(i % NPAD);
        float v = 0.f;
        if (r < 2560) { const int n = r < 768 ? r : r + 4; v = p.b_in[l * NCOL + n]; }
        else if (r < 2564) v = p.b_in[l * NCOL + 768 + (r - 2560)];
        else if (r < 2582) v = p.b_in[l * NCOL + r];
        p.binp[i] = v;
    }
    for (size_t i = gtid; i < (size_t)NL * NE * 2048; i += gthreads) {
        const int r = (int)(i % 2048); const size_t le = i / 2048;
        const int s = (r >> 7) & 1, f = (r >> 8) * 128 + (r & 127);
        p.bgup[i] = p.b_gu[le * 2048 + 2 * f + s];
    }
    for (size_t i = gtid; i < (size_t)NL * NE * 1024; i += gthreads) {
        const int k = (int)(i % 1024), e = (int)((i / 1024) % NE), l = (int)(i / (1024 * NE));
        p.rwT[i] = p.router_w[((size_t)l * 1024 + k) * NE + e];
    }
    for (size_t i = gtid; i < (size_t)NL * (NPAD - NCOL) * 1024; i += gthreads) {
        const int l = (int)(i / ((NPAD - NCOL) * 1024)); const size_t r = i % ((size_t)(NPAD - NCOL) * 1024);
        p.WinT[(size_t)l * NPAD * 1024 + (size_t)NCOL * 1024 + r] = 0;
    }
    for (size_t i = gtid; i < (size_t)NTOK * DM / 4; i += gthreads) {
        const float4 v4 = ((const float4*)p.x)[i];
        u32x2 w; w.x = pack2(v4.x, v4.y); w.y = pack2(v4.z, v4.w);
        ((u32x2*)p.xb)[i] = w;
    }
    if (bid < 4) {
        float* lf = (float*)ldsc;
        const int j = tid & 63, part = tid >> 6;
        const float* pe = p.cmp_pe + (size_t)bid * 2048; const float* w1 = p.cmp_w1 + (size_t)bid * 2048 * 64;
        float s = 0.f;
        for (int kk = part * 256; kk < part * 256 + 256; ++kk) s += pe[kk] * w1[(size_t)kk * 64 + j];
        lf[tid] = s; __syncthreads();
        if (tid < 64) { float a = 0.f; for (int q = 0; q < 8; ++q) a += lf[tid + 64 * q]; p.b1c[bid * 64 + tid] = a; }
        __syncthreads();
    }
}

namespace pg8 {
constexpr int BM = 256, BK = 64, HALF = 128, HTB = HALF * BK * 2, NXCD = 8, WGM = 8;
__device__ __forceinline__ int lds_byte(int r, int c) { const int st = (r >> 4) * 2 + (c >> 5), rr = r & 15, cc = c & 31, ob = rr * 64 + cc * 2; return st * 1024 + (ob ^ (((ob >> 9) & 1) << 5)); }
__device__ __forceinline__ void stage_rc(int b, int& R, int& C) { const int st = b / 1024, sb = b % 1024, swz = sb ^ (((sb >> 9) & 1) << 5); R = (st >> 1) * 16 + swz / 64; C = (st & 1) * 32 + (swz % 64) / 2; }
__device__ __forceinline__ bool tile_order(int i, int G, int c, int nM, int nN, int& pm, int& pn) {
    const int nwg = nM * nN; const long L = (long)i * G + c; if (L >= nwg) return false;
    int wgid = (int)L; { const int q = nwg / NXCD, r = nwg % NXCD, xcd = wgid % NXCD, off = wgid / NXCD; wgid = (xcd < r ? xcd * (q + 1) : r * (q + 1) + (xcd - r) * q) + off; }
    const int nig = WGM * nN, gid = wgid / nig, fm = gid * WGM, gsz = (nM - fm) < WGM ? (nM - fm) : WGM;
    pm = fm + ((wgid % nig) % gsz); pn = (wgid % nig) / gsz; return true;
}
template <bool FP8, int SCA, class Sched, class Epi>
__device__ __forceinline__ void gemm_phase(LAS unsigned char* lds, const char* Abase, int K, const Sched& S, const Epi& E) {
    int tid = threadIdx.x; asm volatile("" : "+v"(tid));
    const int wid = __builtin_amdgcn_readfirstlane(tid >> 6), lane = tid & 63, wr = wid >> 2, wc = wid & 3, fr = lane & 15, fq = lane >> 4;
    const int nt = K / BK;
    int R0, C0, R1, C1; stage_rc(tid * 16, R0, C0); stage_rc(tid * 16 + 8192, R1, C1);
    LAS unsigned* aofs = (LAS unsigned*)(lds + LDS_AOFF) + tid;
    unsigned rg[10];
    rg[8] = (unsigned)(R0 * K + C0) * 2u; rg[9] = (unsigned)(R1 * K + C1) * 2u;
    if constexpr (FP8) { aofs[8 * NTHR] = rg[8]; aofs[9 * NTHR] = rg[9]; }
    const size_t kstep = (size_t)(BK * 2), hstep = (size_t)HALF * K * 2;
    const unsigned ldsw = (unsigned)wid * 1024u;
    const int aoff = lds_byte(wr * 64 + fr, fq * 8), boff = lds_byte(wc * 32 + fr, fq * 8);
#define PG8_SA(b, h) (((b) * 2 + (h)) * HTB)
#define PG8_SB(b, h) ((4 + (b) * 2 + (h)) * HTB)
#define PG8_OFS(sel, j) (FP8 ? aofs[((sel) * 4 + (j)) * NTHR] : ((sel) ? rg[4 + (j)] : rg[(j)]))
#define PG8_STAGE_B(bufoff, gbase) do { _Pragma("unroll") for (int _i = 0; _i < 2; ++_i) { const unsigned ob_ = FP8 ? aofs[(8 + _i) * NTHR] : rg[8 + _i]; \
        __builtin_amdgcn_global_load_lds((const unsigned*)((const char*)(gbase) + ob_), (LAS unsigned*)(lds + (bufoff) + ldsw + _i * 8192), 16, 0, 0); } } while (0)
#define PG8_STAGE_A(bufoff, kbyte, sel, h) do { const unsigned o0_ = PG8_OFS(sel, (h) * 2), o1_ = PG8_OFS(sel, (h) * 2 + 1); \
        __builtin_amdgcn_global_load_lds((const unsigned*)(Abase + (kbyte) + o0_), (LAS unsigned*)(lds + (bufoff) + ldsw), 16, 0, 0); \
        __builtin_amdgcn_global_load_lds((const unsigned*)(Abase + (kbyte) + o1_), (LAS unsigned*)(lds + (bufoff) + ldsw + 8192), 16, 0, 0); } while (0)
#define PG8_LDA(dst, b, h) do { _Pragma("unroll") for (int m = 0; m < 4; ++m) { \
        if constexpr (FP8) { const v4i_t lo_ = *(const LAS v4i_t*)(lds + PG8_SA(b, h) + aoff + m * 2048), hi_ = *(const LAS v4i_t*)(lds + PG8_SA(b, h) + aoff + m * 2048 + 1024); dst##8[m] = __builtin_shufflevector(lo_, hi_, 0, 1, 2, 3, 4, 5, 6, 7); } \
        else { _Pragma("unroll") for (int k = 0; k < 2; ++k) dst[m][k] = *(const LAS bf16x8*)(lds + PG8_SA(b, h) + aoff + m * 2048 + k * 1024); } } } while (0)
#define PG8_LDB(dst, b, h) do { _Pragma("unroll") for (int n = 0; n < 2; ++n) { \
        if constexpr (FP8) { const v4i_t lo_ = *(const LAS v4i_t*)(lds + PG8_SB(b, h) + boff + n * 2048), hi_ = *(const LAS v4i_t*)(lds + PG8_SB(b, h) + boff + n * 2048 + 1024); dst##8[n] = __builtin_shufflevector(lo_, hi_, 0, 1, 2, 3, 4, 5, 6, 7); } \
        else { _Pragma("unroll") for (int k = 0; k < 2; ++k) dst[n][k] = *(const LAS bf16x8*)(lds + PG8_SB(b, h) + boff + n * 2048 + k * 1024); } } } while (0)
#define PG8_MMA(ai, bj, At, Bt) do { __builtin_amdgcn_s_setprio(1); _Pragma("unroll") for (int m = 0; m < 4; ++m) _Pragma("unroll") for (int n = 0; n < 2; ++n) { \
        if constexpr (FP8) { acc[ai][bj][m][n] = __builtin_amdgcn_mfma_scale_f32_16x16x128_f8f6f4(Bt##8[n], At##8[m], acc[ai][bj][m][n], 0, 0, 0, SCA, 0, SCA); } \
        else { _Pragma("unroll") for (int k = 0; k < 2; ++k) acc[ai][bj][m][n] = __builtin_amdgcn_mfma_f32_16x16x32_bf16(Bt[n][k], At[m][k], acc[ai][bj][m][n], 0, 0, 0); } } \
        __builtin_amdgcn_s_setprio(0); } while (0)
#define PG8_WAIT_V(n) asm volatile("s_waitcnt vmcnt(" #n ")" ::: "memory")
#define PG8_WAIT_L(n) asm volatile("s_waitcnt lgkmcnt(" #n ")" ::: "memory")
#define PG8_BAR __builtin_amdgcn_s_barrier()
#define PG8_SCHED __builtin_amdgcn_sched_barrier(0)
    typename Sched::Unit cur, nxt; int ui = 0;
    if (!S.next(0, cur)) return;
    f32x4 acc[2][2][4][2];
#pragma unroll
    for (int a = 0; a < 2; ++a)
#pragma unroll
        for (int b = 0; b < 2; ++b)
#pragma unroll
            for (int m = 0; m < 4; ++m)
#pragma unroll
                for (int n = 0; n < 2; ++n) acc[a][b][m][n] = (f32x4){0.f, 0.f, 0.f, 0.f};
    bf16x8 At[4][2], B0[2][2], B1[2][2];
    v8i_t At8[4], B08[2], B18[2];
    { unsigned a4[2][2]; S.a_off(cur, R0, C0, R1, C1, a4); rg[0] = a4[0][0]; rg[1] = a4[0][1]; rg[2] = a4[1][0]; rg[3] = a4[1][1];
      if constexpr (FP8) { aofs[0] = a4[0][0]; aofs[NTHR] = a4[0][1]; aofs[2 * NTHR] = a4[1][0]; aofs[3 * NTHR] = a4[1][1]; } }
    const char* cB = S.b_ptr(cur);
    PG8_STAGE_B(PG8_SB(0, 0), cB); PG8_STAGE_B(PG8_SB(0, 1), cB + hstep); PG8_STAGE_A(PG8_SA(0, 0), 0, 0, 0); PG8_STAGE_A(PG8_SA(0, 1), 0, 0, 1);
    if (wr == 1) PG8_BAR;
    PG8_WAIT_V(2); PG8_BAR;
    PG8_STAGE_B(PG8_SB(1, 0), cB + kstep); PG8_STAGE_A(PG8_SA(1, 0), kstep, 0, 0); PG8_STAGE_B(PG8_SB(1, 1), cB + hstep + kstep);
    PG8_WAIT_V(6); PG8_BAR;
    for (;;) {
        const bool has_next = S.next(ui + 1, nxt);
        const char* nB = cB;
        if (has_next) { int t2 = threadIdx.x; asm volatile("" : "+v"(t2)); int r0, c0, r1, c1; stage_rc(t2 * 16, r0, c0); stage_rc(t2 * 16 + 8192, r1, c1); unsigned a4[2][2]; S.a_off(nxt, r0, c0, r1, c1, a4); nB = S.b_ptr(nxt);
            rg[4] = a4[0][0]; rg[5] = a4[0][1]; rg[6] = a4[1][0]; rg[7] = a4[1][1];
            if constexpr (FP8) { aofs[4 * NTHR] = a4[0][0]; aofs[5 * NTHR] = a4[0][1]; aofs[6 * NTHR] = a4[1][0]; aofs[7 * NTHR] = a4[1][1]; } }
        else { rg[4] = rg[0]; rg[5] = rg[1]; rg[6] = rg[2]; rg[7] = rg[3];
            if constexpr (FP8) { aofs[4 * NTHR] = aofs[0]; aofs[5 * NTHR] = aofs[NTHR]; aofs[6 * NTHR] = aofs[2 * NTHR]; aofs[7 * NTHR] = aofs[3 * NTHR]; } }
#pragma unroll 1
        for (int t = 0; t < nt; t += 2) {
            const bool last = (t == nt - 2);
            const size_t ka1 = (size_t)(t + 1) * kstep, ka2 = last ? 0 : (size_t)(t + 2) * kstep, ka3 = ka2 + kstep;
            const char* b2 = last ? nB : cB + (size_t)(t + 2) * kstep; const char* b3 = b2 + kstep;
            const int sel = last ? 1 : 0;
            PG8_LDB(B0, 0, 0); PG8_LDB(B1, 0, 1); PG8_SCHED; PG8_LDA(At, 0, 0); PG8_STAGE_A(PG8_SA(1, 1), ka1, 0, 1);
            PG8_WAIT_V(8); PG8_WAIT_L(0); PG8_BAR; PG8_MMA(0, 0, At, B0); PG8_MMA(0, 1, At, B1); PG8_BAR; PG8_SCHED;
            PG8_LDA(At, 0, 1); PG8_STAGE_B(PG8_SB(0, 0), b2); PG8_STAGE_B(PG8_SB(0, 1), b2 + hstep); PG8_STAGE_A(PG8_SA(0, 0), ka2, sel, 0);
            PG8_WAIT_V(8); PG8_WAIT_L(0); PG8_BAR; PG8_MMA(1, 0, At, B0); PG8_MMA(1, 1, At, B1); PG8_BAR; PG8_SCHED;
            PG8_LDB(B0, 1, 0); PG8_LDB(B1, 1, 1); PG8_SCHED; PG8_LDA(At, 1, 0); PG8_STAGE_A(PG8_SA(0, 1), ka2, sel, 1);
            PG8_WAIT_V(8); PG8_WAIT_L(0); PG8_BAR; PG8_MMA(0, 0, At, B0); PG8_MMA(0, 1, At, B1); PG8_BAR; PG8_SCHED;
            PG8_LDA(At, 1, 1); PG8_STAGE_B(PG8_SB(1, 0), b3); PG8_STAGE_B(PG8_SB(1, 1), b3 + hstep); PG8_STAGE_A(PG8_SA(1, 0), ka3, sel, 0);
            PG8_WAIT_V(8); PG8_WAIT_L(0); PG8_BAR; PG8_MMA(1, 0, At, B0); PG8_MMA(1, 1, At, B1); PG8_BAR; PG8_SCHED;
        }
        if (wr == 0) PG8_BAR;
        { int t2 = threadIdx.x; asm volatile("" : "+v"(t2)); E(acc, cur, wr, wc, t2 & 15, (t2 & 63) >> 4); }
        if (!has_next) break;
#pragma unroll
        for (int a = 0; a < 2; ++a)
#pragma unroll
            for (int b = 0; b < 2; ++b)
#pragma unroll
                for (int m = 0; m < 4; ++m)
#pragma unroll
                    for (int n = 0; n < 2; ++n) acc[a][b][m][n] = (f32x4){0.f, 0.f, 0.f, 0.f};
        cur = nxt; cB = nB; ++ui;
        rg[0] = rg[4]; rg[1] = rg[5]; rg[2] = rg[6]; rg[3] = rg[7];
        if constexpr (FP8) { aofs[0] = aofs[4 * NTHR]; aofs[NTHR] = aofs[5 * NTHR]; aofs[2 * NTHR] = aofs[6 * NTHR]; aofs[3 * NTHR] = aofs[7 * NTHR]; }
        if (wr == 1) PG8_BAR;
    }
    PG8_WAIT_V(0);
    PG8_BAR;
#undef PG8_SA
#undef PG8_SB
#undef PG8_STAGE_A
#undef PG8_OFS
#undef PG8_STAGE_B
#undef PG8_LDA
#undef PG8_LDB
#undef PG8_MMA
#undef PG8_WAIT_V
#undef PG8_WAIT_L
#undef PG8_BAR
#undef PG8_SCHED
}
}

struct DenseUnit { int pm, pn; };
struct DenseSched {
    typedef DenseUnit Unit;
    const char* Bt; int K, nM, nN;
    __device__ __forceinline__ bool next(int i, Unit& u) const { return pg8::tile_order(i, gridDim.x, blockIdx.x, nM, nN, u.pm, u.pn); }
    __device__ __forceinline__ void a_off(const Unit& u, int R0, int C0, int R1, int C1, unsigned (&off)[2][2]) const {
#pragma unroll
        for (int h = 0; h < 2; ++h) { off[h][0] = (unsigned)((u.pm * 256 + h * 128 + R0) * K + C0) * 2u; off[h][1] = (unsigned)((u.pm * 256 + h * 128 + R1) * K + C1) * 2u; }
    }
    __device__ __forceinline__ const char* b_ptr(const Unit& u) const { return Bt + (size_t)u.pn * 256 * K * 2; }
};
struct MoeUnit { int rbt, e, pn; };
template <bool GATHER>
struct MoeSched {
    typedef MoeUnit Unit;
    static constexpr int KP = 512;
    const char* Bt; const int* lists; const int* ptile; const int* ecnt; int nN, nrows;
    __device__ __forceinline__ bool next(int i, Unit& u) const {
        int pm, pn; if (!pg8::tile_order(i, gridDim.x, blockIdx.x, ptile[NE], nN, pm, pn)) return false;
        int e = 0; while (ptile[e + 1] <= pm) ++e;
        u.rbt = pm; u.e = e; u.pn = pn; return true;
    }
    __device__ __forceinline__ void a_off(const Unit& u, int R0, int C0, int R1, int C1, unsigned (&off)[2][2]) const {
        if (GATHER) {
            const int* lst = lists + (size_t)u.e * LIST_CAP; const int rb = u.rbt - ptile[u.e], cnt = ecnt[u.e];
#pragma unroll
            for (int h = 0; h < 2; ++h) {
                const int l0 = rb * 256 + h * 128 + R0, l1 = rb * 256 + h * 128 + R1;
                const int t0 = l0 < cnt ? (lst[l0] >> 2) : 0, t1 = l1 < cnt ? (lst[l1] >> 2) : 0;
                off[h][0] = (unsigned)(t0 * KP + C0) * 2u; off[h][1] = (unsigned)(t1 * KP + C1) * 2u;
            }
        } else {
#pragma unroll
            for (int h = 0; h < 2; ++h) { off[h][0] = (unsigned)((u.rbt * 256 + h * 128 + R0) * KP + C0) * 2u; off[h][1] = (unsigned)((u.rbt * 256 + h * 128 + R1) * KP + C1) * 2u; }
        }
    }
    __device__ __forceinline__ const char* b_ptr(const Unit& u) const { return Bt + ((size_t)u.e * nrows + (size_t)u.pn * 256) * KP * 2; }
};

struct EpiInProj {
    const Params* p; int l;
    __device__ __forceinline__ void operator()(const f32x4 (&acc)[2][2][4][2], const DenseUnit& u, int wr, int wc, int fr, int fq) const {
        const float* bias = p->binp + l * NPAD + u.pn * 256;
#pragma unroll
        for (int bj = 0; bj < 2; ++bj) {
            int vh = -1;
            if (u.pn == 2) vh = bj * 2; else if (u.pn == 5 && bj == 0) vh = 4; else if (u.pn == 8 && bj == 1) vh = 6; else if (u.pn == 9 && bj == 1) vh = 8;
#pragma unroll
            for (int n = 0; n < 2; ++n) {
                const int c = bj * 128 + wc * 32 + n * 16 + 4 * fq;
                const f32x4 bv = *(const f32x4*)(bias + c);
#pragma unroll
                for (int ai = 0; ai < 2; ++ai)
#pragma unroll
                    for (int m = 0; m < 4; ++m) {
                        const int row = u.pm * 256 + ai * 128 + wr * 64 + m * 16 + fr;
                        const f32x4 v = acc[ai][bj][m][n] + bv;
                        u32x2 w; w.x = pack2(v[0], v[1]); w.y = pack2(v[2], v[3]);
                        *(u32x2*)(p->hb + (size_t)row * NMAIN + u.pn * 256 + c) = w;
                        if (vh >= 0) {
                            const int b = row >> 11, s = row & 2047, hh = vh + ((c & 127) >> 6), d = c & 63;
                            bf16_t* vt = p->vT + (((size_t)b * NVH + hh) * 64 + d) * SEQ + s;
                            vt[0] = (bf16_t)(w.x & 0xffff); vt[SEQ] = (bf16_t)(w.x >> 16); vt[2 * SEQ] = (bf16_t)(w.y & 0xffff); vt[3 * SEQ] = (bf16_t)(w.y >> 16);
                        }
                    }
            }
        }
    }
};
struct EpiOutProj {
    const float* xin; float* t;
    __device__ __forceinline__ void operator()(const f32x4 (&acc)[2][2][4][2], const DenseUnit& u, int wr, int wc, int fr, int fq) const {
#pragma unroll
        for (int ai = 0; ai < 2; ++ai)
#pragma unroll
            for (int m = 0; m < 4; ++m) {
                const size_t rowoff = (size_t)(u.pm * 256 + ai * 128 + wr * 64 + m * 16 + fr) * DM + u.pn * 256 + wc * 32 + 4 * fq;
#pragma unroll
                for (int bj = 0; bj < 2; ++bj)
#pragma unroll
                    for (int n = 0; n < 2; ++n) {
                        const size_t off = rowoff + bj * 128 + n * 16;
                        const f32x4 xv = *(const f32x4*)(xin + off);
                        *(f32x4*)(t + off) = xv * ALPHA + acc[ai][bj][m][n];
                    }
            }
    }
};
struct EpiGateUp {
    bf16_t* act; const float* bgup;
    __device__ __forceinline__ void operator()(const f32x4 (&acc)[2][2][4][2], const MoeUnit& u, int wr, int wc, int fr, int fq) const {
        const float* bias = bgup + (size_t)u.e * 2048 + u.pn * 256;
#pragma unroll
        for (int n = 0; n < 2; ++n) {
            const int c = wc * 32 + n * 16 + 4 * fq;
            const f32x4 bg = *(const f32x4*)(bias + c), bu = *(const f32x4*)(bias + 128 + c);
#pragma unroll
            for (int ai = 0; ai < 2; ++ai)
#pragma unroll
                for (int m = 0; m < 4; ++m) {
                    const f32x4 g4 = acc[ai][0][m][n] + bg, u4 = acc[ai][1][m][n] + bu;
                    float o[4];
#pragma unroll
                    for (int j = 0; j < 4; ++j) {
                        const float g = fminf(g4[j], 7.0f), uu = fminf(fmaxf(u4[j], -7.0f), 7.0f);
                        const float glu = g * __builtin_amdgcn_rcpf(1.0f + __builtin_amdgcn_exp2f(-2.455466929f * g));
                        o[j] = (uu + 1.0f) * glu;
                    }
                    *(unsigned*)((char*)act + (size_t)(u.rbt * 256 + ai * 128 + wr * 64 + m * 16 + fr) * DFF + u.pn * 128 + c) = pack4_fp8(o[0], o[1], o[2], o[3]);
                }
        }
    }
};
struct EpiDown {
    bf16_t* ybuf; const float* bdn;
    __device__ __forceinline__ void operator()(const f32x4 (&acc)[2][2][4][2], const MoeUnit& u, int wr, int wc, int fr, int fq) const {
        const float* bias = bdn + (size_t)u.e * 1024 + u.pn * 256;
#pragma unroll
        for (int bj = 0; bj < 2; ++bj)
#pragma unroll
            for (int n = 0; n < 2; ++n) {
                const int c = bj * 128 + wc * 32 + n * 16 + 4 * fq;
                const f32x4 bv = *(const f32x4*)(bias + c);
#pragma unroll
                for (int ai = 0; ai < 2; ++ai)
#pragma unroll
                    for (int m = 0; m < 4; ++m) {
                        const f32x4 v = acc[ai][bj][m][n] + bv;
                        u32x2 w; w.x = pack2(v[0], v[1]); w.y = pack2(v[2], v[3]);
                        *(u32x2*)(ybuf + (size_t)(u.rbt * 256 + ai * 128 + wr * 64 + m * 16 + fr) * DM + u.pn * 256 + c) = w;
                    }
            }
    }
};

__device__ __forceinline__ void phase_inproj(const Params& p, int l, char* lds) {
    DenseSched S{(const char*)(p.WinT + (size_t)l * NPAD * 1024), 1024, NTOK / 256, NMAIN / 256};
    EpiInProj E{&p, l};
    pg8::gemm_phase<false, 0>((LAS unsigned char*)lds, (const char*)p.xb, 1024, S, E);
    int tid = threadIdx.x; asm volatile("" : "+v"(tid));
    const int wid = tid >> 6, lane = tid & 63, fr = lane & 15, fq = lane >> 4;
    const bf16_t* W = p.WinT + ((size_t)l * NPAD + NMAIN) * 1024;
    const float* bias = p.binp + l * NPAD + NMAIN;
    for (int u = blockIdx.x * NWV + wid; u < NTOK / 16; u += gridDim.x * NWV) {
        const bf16_t* ar = p.xb + (size_t)(u * 16 + fr) * DM + fq * 8;
        const bf16_t* w0 = W + (size_t)fr * 1024 + fq * 8; const bf16_t* w1 = W + (size_t)(16 + fr) * 1024 + fq * 8;
        f32x4 a0 = (f32x4){0.f, 0.f, 0.f, 0.f}, a1 = a0;
#pragma unroll 4
        for (int ks = 0; ks < 32; ++ks) {
            const bf16x8 a = *(const bf16x8*)(ar + ks * 32);
            a0 = __builtin_amdgcn_mfma_f32_16x16x32_bf16(a, *(const bf16x8*)(w0 + ks * 32), a0, 0, 0, 0);
            a1 = __builtin_amdgcn_mfma_f32_16x16x32_bf16(a, *(const bf16x8*)(w1 + ks * 32), a1, 0, 0, 0);
        }
#pragma unroll
        for (int r = 0; r < 4; ++r) {
            float* dst = p.hs + (size_t)(u * 16 + fq * 4 + r) * HS_W;
            dst[fr] = a0[r] + bias[fr];
            if (fr < 6) dst[16 + fr] = a1[r] + bias[16 + fr];
        }
    }
}
__device__ __forceinline__ void phase_outproj(const Params& p, int l, const float* xin, char* lds) {
    DenseSched S{(const char*)(p.WoT + (size_t)l * 1024 * 1024), 1024, NTOK / 256, 4};
    EpiOutProj E{xin, p.tbuf};
    pg8::gemm_phase<false, 0>((LAS unsigned char*)lds, (const char*)p.ob, 1024, S, E);
}
__device__ __forceinline__ void build_tiles(const Params& p, int l, int* ptile, int* ecnt) {
    int tid = threadIdx.x; asm volatile("" : "+v"(tid));
    if (tid < NE) ecnt[tid] = (int)__hip_atomic_load(p.ctrl + 64 + l * NE + tid, __ATOMIC_RELAXED, __HIP_MEMORY_SCOPE_AGENT);
    __syncthreads();
    if (tid == 0) { int s = 0; for (int e = 0; e < NE; ++e) { ptile[e] = s; s += (ecnt[e] + 255) >> 8; } ptile[NE] = s; }
    __syncthreads();
}
__device__ __forceinline__ void phase_gateup(const Params& p, int l, char* lds) {
    int* ptile = (int*)(lds + LDS_TAB); int* ecnt = ptile + 40;
    build_tiles(p, l, ptile, ecnt);
    MoeSched<true> S{(const char*)p.WguT + (size_t)l * NE * 2048 * 1024, p.lists, ptile, ecnt, 8, 2048};
    EpiGateUp E{p.act, p.bgup + (size_t)l * NE * 2048};
    pg8::gemm_phase<true, 0x7c7c7c7c>((LAS unsigned char*)lds, (const char*)p.x1b, 512, S, E);
}
__device__ __forceinline__ void phase_down(const Params& p, int l, char* lds) {
    int* ptile = (int*)(lds + LDS_TAB); int* ecnt = ptile + 40;
    build_tiles(p, l, ptile, ecnt);
    MoeSched<false> S{(const char*)p.WdnT + (size_t)l * NE * 1024 * 1024, p.lists, ptile, ecnt, 4, 1024};
    EpiDown E{p.ybuf, p.b_dn + (size_t)l * NE * 1024};
    pg8::gemm_phase<true, 0x7c7c7c7c>((LAS unsigned char*)lds, (const char*)p.act, 512, S, E);
}

__device__ __forceinline__ float gelu_tanh(float x) {
    const float u = 0.7978845608028654f * (x + 0.044715f * x * x * x);
    const float e = __expf(-2.0f * fabsf(u)); const float th = (1.0f - e) / (1.0f + e);
    return 0.5f * x * (1.0f + (u < 0.f ? -th : th));
}
__device__ __forceinline__ void phase_prep(const Params& p, int l, char* lds) {
    int tid = threadIdx.x; asm volatile("" : "+v"(tid));
    const int wid = tid >> 6, lane = tid & 63, fr = lane & 15, fq = lane >> 4;
    const int gw = blockIdx.x * NWV + wid, nw = gridDim.x * NWV;
    for (int u = (int)gridDim.x - 1 - (int)blockIdx.x; u < NB * 4; u += gridDim.x) {
        const int b = u >> 2, h = u & 3;
        const float* srcp = p.hs + ((size_t)b * SEQ + tid * 4) * HS_W + h;
        float ls[4]; float tot = 0.f;
#pragma unroll
        for (int i = 0; i < 4; ++i) { const float f = srcp[(size_t)i * HS_W]; ls[i] = fminf(f, 0.f) - log1pf(__expf(-fabsf(f))); tot += ls[i]; }
        float inc = tot;
#pragma unroll
        for (int o = 1; o < 64; o <<= 1) { const float v = __shfl_up(inc, o); if (lane >= o) inc += v; }
        float* wtot = (float*)(lds + 65536);
        if (lane == 63) wtot[wid] = inc;
        __syncthreads();
        float base = inc - tot;
        for (int w = 0; w < wid; ++w) base += wtot[w];
        float4 o4; o4.x = base + ls[0]; o4.y = o4.x + ls[1]; o4.z = o4.y + ls[2]; o4.w = o4.z + ls[3];
        *(float4*)(p.cF + (size_t)u * SEQ + tid * 4) = o4;
        __syncthreads();
    }
    float* part = (float*)lds;
    bf16_t* h1 = (bf16_t*)(lds + 32768);
    for (int u = blockIdx.x; u < NB * 2 * 2 * 8; u += gridDim.x) {
        const int ct = u & 7, which = (u >> 3) & 1, kvh = (u >> 4) & 1, b = u >> 5;
        const int colo = (which ? C_NVC : C_NKC) + kvh * 64;
        const int c_lane = ct * 16 + fr;
        const int tokbase = min(c_lane, 126) * 16;
        const bf16_t* arow = p.hb + ((size_t)b * SEQ + tokbase) * NMAIN + colo + fq * 8;
        const bf16_t* w1 = p.W1T + ((size_t)(l * 2 + which) * 64 + fr) * 2048 + fq * 8;
        f32x4 acc[4];
#pragma unroll
        for (int n = 0; n < 4; ++n) acc[n] = (f32x4){0.f, 0.f, 0.f, 0.f};
#pragma unroll
        for (int kk = 0; kk < 8; ++kk) {
            const int ks = wid * 8 + kk;
            const bf16x8 a = *(const bf16x8*)(arow + (size_t)(ks >> 1) * NMAIN + (ks & 1) * 32);
#pragma unroll
            for (int n = 0; n < 4; ++n) {
                const bf16x8 bb = *(const bf16x8*)(w1 + (size_t)n * 16 * 2048 + ks * 32);
                acc[n] = __builtin_amdgcn_mfma_f32_16x16x32_bf16(a, bb, acc[n], 0, 0, 0);
            }
        }
#pragma unroll
        for (int n = 0; n < 4; ++n)
#pragma unroll
            for (int r = 0; r < 4; ++r) part[wid * 1024 + (fq * 4 + r) * 64 + n * 16 + fr] = acc[n][r];
        __syncthreads();
        const float* b1 = p.b1c + (l * 2 + which) * 64;
#pragma unroll
        for (int i = 0; i < 2; ++i) {
            const int e = tid + NTHR * i; float sum = 0.f;
#pragma unroll
            for (int w = 0; w < 8; ++w) sum += part[w * 1024 + e];
            h1[e] = f2bf(gelu_tanh(sum + b1[e & 63]));
        }
        __syncthreads();
        if (wid == 0) {
            const bf16_t* w2 = p.W2T + ((size_t)(l * 2 + which) * 64 + fr) * 64 + fq * 8;
            f32x4 o2[4];
#pragma unroll
            for (int n = 0; n < 4; ++n) o2[n] = (f32x4){0.f, 0.f, 0.f, 0.f};
#pragma unroll
            for (int ks = 0; ks < 2; ++ks) {
                const bf16x8 a = *(const bf16x8*)(h1 + fr * 64 + ks * 32 + fq * 8);
#pragma unroll
                for (int n = 0; n < 4; ++n) {
                    const bf16x8 bb = *(const bf16x8*)(w2 + (size_t)n * 16 * 64 + ks * 32);
                    o2[n] = __builtin_amdgcn_mfma_f32_16x16x32_bf16(a, bb, o2[n], 0, 0, 0);
                }
            }
            const size_t base = ((size_t)b * 2 + kvh) * 128 * 64;
#pragma unroll
            for (int n = 0; n < 4; ++n)
#pragma unroll
                for (int r = 0; r < 4; ++r) {
                    const int c = ct * 16 + fq * 4 + r, j2 = n * 16 + fr;
                    const bf16_t v = c < 127 ? f2bf(o2[n][r]) : (bf16_t)0;
                    if (which == 0) p.kc[base + (size_t)c * 64 + j2] = v;
                    else { p.vc[base + (size_t)c * 64 + j2] = v; p.vcT[base + (size_t)j2 * 128 + c] = v; }
                }
        }
        __syncthreads();
    }
}

constexpr float L2E = 1.4426950408889634f, MASKV = -1e30f, SCL2 = QSCALE * L2E;
struct KVFrag { bf16x8 k[2][2]; bf16x8 v[4]; };
__device__ __forceinline__ void k_load(KVFrag& f, const bf16_t* __restrict__ Kb, size_t ldk, int kc0, int fr, int fq) {
    const bf16_t* kp = Kb + (size_t)(kc0 + (fr >> 2) * 8 + (fr & 3)) * ldk + fq * 8;
    f.k[0][0] = *(const bf16x8*)(kp); f.k[0][1] = *(const bf16x8*)(kp + 32);
    f.k[1][0] = *(const bf16x8*)(kp + 4 * ldk); f.k[1][1] = *(const bf16x8*)(kp + 4 * ldk + 32);
}
__device__ __forceinline__ void v_load(bf16x8 (&v)[4], const bf16_t* __restrict__ VTb, size_t ldv, int kc0, int fr, int fq) {
    const bf16_t* vp = VTb + (size_t)fr * ldv + kc0 + fq * 8;
#pragma unroll
    for (int dt = 0; dt < 4; ++dt) v[dt] = *(const bf16x8*)(vp + (size_t)dt * 16 * ldv);
}
__device__ __forceinline__ float rowmax4(float x) {
    auto r = __builtin_amdgcn_permlane32_swap(__float_as_uint(x), __float_as_uint(x), false, false);
    x = fmaxf(__uint_as_float(r[0]), __uint_as_float(r[1]));
    auto q = __builtin_amdgcn_permlane16_swap(__float_as_uint(x), __float_as_uint(x), false, false);
    return fmaxf(__uint_as_float(q[0]), __uint_as_float(q[1]));
}
__device__ __forceinline__ float rowsum4(float x) {
    auto r = __builtin_amdgcn_permlane32_swap(__float_as_uint(x), __float_as_uint(x), false, false);
    x = __uint_as_float(r[0]) + __uint_as_float(r[1]);
    auto q = __builtin_amdgcn_permlane16_swap(__float_as_uint(x), __float_as_uint(x), false, false);
    return __uint_as_float(q[0]) + __uint_as_float(q[1]);
}
template <int NQT, bool MASK, class MB>
__device__ __forceinline__ void attn_compute(const KVFrag& f, const bf16x8 (&qf)[NQT][2], f32x4 (&o)[NQT][4], float (&m)[NQT], float (&l)[NQT], const MB& mb) {
    f32x4 s0[NQT], s1[NQT];
#pragma unroll
    for (int qt = 0; qt < NQT; ++qt) {
        s0[qt] = __builtin_amdgcn_mfma_f32_16x16x32_bf16(f.k[0][0], qf[qt][0], (f32x4){0.f, 0.f, 0.f, 0.f}, 0, 0, 0);
        s1[qt] = __builtin_amdgcn_mfma_f32_16x16x32_bf16(f.k[1][0], qf[qt][0], (f32x4){0.f, 0.f, 0.f, 0.f}, 0, 0, 0);
    }
#pragma unroll
    for (int qt = 0; qt < NQT; ++qt) {
        s0[qt] = __builtin_amdgcn_mfma_f32_16x16x32_bf16(f.k[0][1], qf[qt][1], s0[qt], 0, 0, 0);
        s1[qt] = __builtin_amdgcn_mfma_f32_16x16x32_bf16(f.k[1][1], qf[qt][1], s1[qt], 0, 0, 0);
    }
    float mx[NQT];
#pragma unroll
    for (int qt = 0; qt < NQT; ++qt) {
#pragma unroll
        for (int j = 0; j < 4; ++j) { s0[qt][j] = mb(qt, j, s0[qt][j]); s1[qt][j] = mb(qt, j + 4, s1[qt][j]); }
        mx[qt] = fmaxf(fmaxf(fmaxf(s0[qt][0], s0[qt][1]), fmaxf(s0[qt][2], s0[qt][3])), fmaxf(fmaxf(s1[qt][0], s1[qt][1]), fmaxf(s1[qt][2], s1[qt][3])));
    }
#pragma unroll
    for (int qt = 0; qt < NQT; ++qt) mx[qt] = rowmax4(mx[qt]);
    bool moved = false;
#pragma unroll
    for (int qt = 0; qt < NQT; ++qt) { mx[qt] = fmaxf(m[qt], mx[qt]); moved |= (mx[qt] != m[qt]); }
    if (__ballot(moved) != 0ull) {
#pragma unroll
        for (int qt = 0; qt < NQT; ++qt) {
            const float alpha = __builtin_amdgcn_exp2f(m[qt] - mx[qt]);
            l[qt] *= alpha;
#pragma unroll
            for (int dt = 0; dt < 4; ++dt) o[qt][dt] *= alpha;
        }
    }
    bf16x8 pf[NQT];
#pragma unroll
    for (int qt = 0; qt < NQT; ++qt) {
        m[qt] = mx[qt];
        float pr[8]; float ps = 0.f;
#pragma unroll
        for (int j = 0; j < 4; ++j) {
            pr[j] = (!MASK || s0[qt][j] > -1e29f) ? __builtin_amdgcn_exp2f(s0[qt][j] - mx[qt]) : 0.f;
            pr[j + 4] = (!MASK || s1[qt][j] > -1e29f) ? __builtin_amdgcn_exp2f(s1[qt][j] - mx[qt]) : 0.f;
        }
#pragma unroll
        for (int j = 0; j < 8; ++j) ps += pr[j];
        l[qt] += ps;
        const u32x4 pk = {pack2(pr[0], pr[1]), pack2(pr[2], pr[3]), pack2(pr[4], pr[5]), pack2(pr[6], pr[7])};
        pf[qt] = __builtin_bit_cast(bf16x8, pk);
    }
#pragma unroll
    for (int dt = 0; dt < 4; ++dt)
#pragma unroll
        for (int qt = 0; qt < NQT; ++qt) o[qt][dt] = __builtin_amdgcn_mfma_f32_16x16x32_bf16(f.v[dt], pf[qt], o[qt][dt], 0, 0, 0);
    __builtin_amdgcn_sched_barrier(0);
}
struct RangeIt { int c, c_hi; __device__ __forceinline__ int nxt() { if (c > c_hi) return -1; return (c++) * 32; } };
struct MaskIt { unsigned long long cm; __device__ __forceinline__ int nxt() { if (!cm) return -1; const int i = __builtin_ctzll(cm); cm &= cm - 1; return i * 32; } };
template <bool PFV, class It, class Gen>
__device__ __forceinline__ void attn_run(It& it, const bf16_t* Kb, size_t ldk, const bf16_t* VTb, size_t ldv, int fr, int fq, const Gen& gen) {
    KVFrag fa, fb;
    int ka = it.nxt(); if (ka < 0) return;
    k_load(fa, Kb, ldk, ka, fr, fq); if (PFV) v_load(fa.v, VTb, ldv, ka, fr, fq);
    for (;;) {
        const int kb = it.nxt(); if (kb >= 0) { k_load(fb, Kb, ldk, kb, fr, fq); if (PFV) v_load(fb.v, VTb, ldv, kb, fr, fq); }
        if (!PFV) v_load(fa.v, VTb, ldv, ka, fr, fq);
        gen(ka, fa);
        if (kb < 0) break;
        ka = it.nxt(); if (ka >= 0) { k_load(fa, Kb, ldk, ka, fr, fq); if (PFV) v_load(fa.v, VTb, ldv, ka, fr, fq); }
        if (!PFV) v_load(fb.v, VTb, ldv, kb, fr, fq);
        gen(kb, fb);
        if (ka < 0) break;
    }
}
template <int NQT>
__device__ __forceinline__ void attn_init(f32x4 (&o)[NQT][4], float (&m)[NQT], float (&l)[NQT]) {
#pragma unroll
    for (int qt = 0; qt < NQT; ++qt) { m[qt] = MASKV; l[qt] = 0.f;
#pragma unroll
        for (int dt = 0; dt < 4; ++dt) o[qt][dt] = (f32x4){0.f, 0.f, 0.f, 0.f}; }
}
__device__ __forceinline__ float lsum4(float l) { return rowsum4(l); }
__device__ __forceinline__ void store_o4(bf16_t* dst, const f32x4 v) { u32x2 w; w.x = pack2(v[0], v[1]); w.y = pack2(v[2], v[3]); *(u32x2*)dst = w; }
__device__ __forceinline__ float sigmoidf_fast(float x) { return __builtin_amdgcn_rcpf(1.0f + __builtin_amdgcn_exp2f(-L2E * x)); }

__device__ __forceinline__ void fox_unit(const Params& p, int b, int h, int qb, int fr, int fq) {
    asm volatile("" : "+v"(fr), "+v"(fq));
    const int t0 = qb * 32;
    const bf16_t* Qb = p.hb + ((size_t)b * SEQ + t0) * NMAIN + C_FQ + h * 64 + fq * 8;
    bf16x8 qf[2][2];
#pragma unroll
    for (int qt = 0; qt < 2; ++qt) { qf[qt][0] = *(const bf16x8*)(Qb + (size_t)(qt * 16 + fr) * NMAIN); qf[qt][1] = *(const bf16x8*)(Qb + (size_t)(qt * 16 + fr) * NMAIN + 32); }
    const float* cf = p.cF + ((size_t)b * 4 + h) * SEQ;
    float cq[2];
#pragma unroll
    for (int qt = 0; qt < 2; ++qt) cq[qt] = cf[t0 + qt * 16 + fr] * L2E;
    f32x4 o[2][4]; float m[2], l[2];
    attn_init<2>(o, m, l);
    const bf16_t* Kb = p.hb + (size_t)b * SEQ * NMAIN + C_FK + h * 64;
    const bf16_t* VTb = p.vT + ((size_t)b * NVH + h) * 64 * SEQ;
    RangeIt it{0, t0 >> 5};
    attn_run<true>(it, Kb, NMAIN, VTb, SEQ, fr, fq, [&](int kc0, const KVFrag& f) {
        const float4 ca = *(const float4*)(cf + kc0 + 8 * fq), cb = *(const float4*)(cf + kc0 + 8 * fq + 4);
        const float ck[8] = {ca.x * L2E, ca.y * L2E, ca.z * L2E, ca.w * L2E, cb.x * L2E, cb.y * L2E, cb.z * L2E, cb.w * L2E};
        const int kq = kc0 + 8 * fq - t0 - fr;
        attn_compute<2, true>(f, qf, o, m, l, [&](int qt, int j, float raw) { return (kq + j - 16 * qt) > 0 ? MASKV : raw * SCL2 + cq[qt] - ck[j]; });
    });
#pragma unroll
    for (int qt = 0; qt < 2; ++qt) {
        const float inv = __builtin_amdgcn_rcpf(lsum4(l[qt]));
        bf16_t* dst = p.ob + ((size_t)b * SEQ + t0 + qt * 16 + fr) * DM + h * 64 + 4 * fq;
#pragma unroll
        for (int dt = 0; dt < 4; ++dt) store_o4(dst + dt * 16, o[qt][dt] * inv);
    }
}
__device__ __forceinline__ void swa_unit(const Params& p, int l_, int b, int kv, int pos, int fr, int fq) {
    asm volatile("" : "+v"(fr), "+v"(fq));
    const int t0 = pos * 16, t = t0 + fr;
    const bf16_t* Qb = p.hb + ((size_t)b * SEQ + t) * NMAIN + C_SQ + kv * 192 + fq * 8;
    bf16x8 qf[3][2];
#pragma unroll
    for (int g = 0; g < 3; ++g) { qf[g][0] = *(const bf16x8*)(Qb + g * 64); qf[g][1] = *(const bf16x8*)(Qb + g * 64 + 32); }
    float sl[3];
#pragma unroll
    for (int g = 0; g < 3; ++g) sl[g] = slope_swa(kv * 3 + g) * L2E;
    f32x4 o[3][4]; float m[3], l[3];
    attn_init<3>(o, m, l);
    const bf16_t* Kb = p.hb + (size_t)b * SEQ * NMAIN + C_SK + kv * 64;
    const bf16_t* VTb = p.vT + ((size_t)b * NVH + 4 + kv) * 64 * SEQ;
    RangeIt it{max(0, t0 - 127) >> 5, (t0 + 15) >> 5};
    attn_run<true>(it, Kb, NMAIN, VTb, SEQ, fr, fq, [&](int kc0, const KVFrag& f) {
        const int dq = t - kc0 - 8 * fq;
        attn_compute<3, true>(f, qf, o, m, l, [&](int g, int j, float raw) { const int dist = dq - j; return (dist >= 0 && dist < 128) ? raw * SCL2 - sl[g] * (float)dist : MASKV; });
    });
#pragma unroll
    for (int g = 0; g < 3; ++g) {
        const float sink = p.sinks[l_ * 6 + kv * 3 + g] * L2E;
        const float inv = __builtin_amdgcn_rcpf(lsum4(l[g]) + __builtin_amdgcn_exp2f(sink - m[g]));
        bf16_t* dst = p.ob + ((size_t)b * SEQ + t) * DM + 256 + (kv * 3 + g) * 64 + 4 * fq;
#pragma unroll
        for (int dt = 0; dt < 4; ++dt) store_o4(dst + dt * 16, o[g][dt] * inv);
    }
}
__device__ __forceinline__ void nsa_unit(const Params& p, int b, int kv, int pos, int fr, int fq, int lane, float* ps, unsigned* msk, float* otl) {
    asm volatile("" : "+v"(fr), "+v"(fq), "+v"(lane));
    const int t0 = pos * 16, t = t0 + fr, cur = t0 >> 6;
    const bf16_t* Qb = p.hb + ((size_t)b * SEQ + t) * NMAIN + C_NQ + kv * 192 + fq * 8;
    bf16x8 qf[3][2];
#pragma unroll
    for (int g = 0; g < 3; ++g) { qf[g][0] = *(const bf16x8*)(Qb + g * 64); qf[g][1] = *(const bf16x8*)(Qb + g * 64 + 32); }
    float sl[3];
#pragma unroll
    for (int g = 0; g < 3; ++g) sl[g] = slope_nsa(kv * 3 + g) * L2E;
    const float* gl = p.hs + ((size_t)b * SEQ + t) * HS_W + 4 + kv * 9;
    f32x4 o[3][4]; float m[3], l[3];
    f32x4* otv = (f32x4*)otl + lane;
#pragma unroll
    for (int i = 0; i < 8; ++i) ps[lane + 64 * i] = 0.f;
    {
        const bf16_t* Kb = p.kc + ((size_t)b * 2 + kv) * 128 * 64;
        const bf16_t* VTb = p.vcT + ((size_t)b * 2 + kv) * 64 * 128;
        const int ncv = (t0 + 15 >= 31) ? ((t0 + 15 - 31) >> 4) + 1 : 0;
        const int nch = (ncv + 31) >> 5;
        attn_init<3>(o, m, l);
        const int dq0 = t - 31 - 16 * 8 * fq;
        RangeIt it{0, nch - 1};
        attn_run<false>(it, Kb, 64, VTb, 128, fr, fq, [&](int kc0, const KVFrag& f) {
            const int dq = dq0 - 16 * kc0;
            attn_compute<3, true>(f, qf, o, m, l, [&](int g, int j, float raw) { const int dist = dq - 16 * j; return dist >= 0 ? raw * SCL2 - sl[g] * (float)dist : MASKV; });
        });
        float il[3];
#pragma unroll
        for (int g = 0; g < 3; ++g) {
            const float lt = lsum4(l[g]); il[g] = lt > 0.f ? __builtin_amdgcn_rcpf(lt) : 0.f;
            const float gate = sigmoidf_fast(gl[g * 3 + 0]);
#pragma unroll
            for (int dt = 0; dt < 4; ++dt) otv[(g * 4 + dt) * 64] = o[g][dt] * (il[g] * gate);
        }
        float carry_prev = 0.f;
        for (int c = 0; c < nch; ++c) {
            const int kc0 = c * 32, dq = dq0 - 16 * kc0;
            const bf16_t* kp = Kb + (size_t)(kc0 + (fr >> 2) * 8 + (fr & 3)) * 64 + fq * 8;
            const bf16x8 k00 = *(const bf16x8*)(kp), k01 = *(const bf16x8*)(kp + 32), k10 = *(const bf16x8*)(kp + 256), k11 = *(const bf16x8*)(kp + 256 + 32);
            float pc[8];
#pragma unroll
            for (int j = 0; j < 8; ++j) pc[j] = 0.f;
#pragma unroll
            for (int g = 0; g < 3; ++g) {
                f32x4 s0 = (f32x4){0.f, 0.f, 0.f, 0.f}, s1 = s0;
                s0 = __builtin_amdgcn_mfma_f32_16x16x32_bf16(k00, qf[g][0], s0, 0, 0, 0); s0 = __builtin_amdgcn_mfma_f32_16x16x32_bf16(k01, qf[g][1], s0, 0, 0, 0);
                s1 = __builtin_amdgcn_mfma_f32_16x16x32_bf16(k10, qf[g][0], s1, 0, 0, 0); s1 = __builtin_amdgcn_mfma_f32_16x16x32_bf16(k11, qf[g][1], s1, 0, 0, 0);
#pragma unroll
                for (int j = 0; j < 8; ++j) {
                    const int dist = dq - 16 * j; const float raw = j < 4 ? s0[j] : s1[j - 4];
                    if (dist >= 0) pc[j] += __builtin_amdgcn_exp2f(raw * SCL2 - sl[g] * (float)dist - m[g]) * il[g];
                }
            }
            const float cout = 0.5f * pc[7];
            float cin = __shfl_up(cout, 16);
            const float cwrap = __shfl(cout, fr + 48);
            if (fq == 0) cin = carry_prev;
            carry_prev = cwrap;
            const int n0 = (kc0 >> 2) + 2 * fq;
            ps[fr * 32 + n0] = cin + pc[0] + pc[1] + pc[2] + 0.5f * pc[3];
            ps[fr * 32 + n0 + 1] = 0.5f * pc[3] + pc[4] + pc[5] + pc[6] + 0.5f * pc[7];
        }
    }
    lds_wave_sync();
    if (lane < 16) {
        unsigned mask = 1u | (1u << cur); if (cur >= 1) mask |= 1u << (cur - 1);
        if (cur >= 3) {
            if (cur - 2 <= 5) mask |= (1u << (cur - 1)) - 2u;
            else {
                const float* my = ps + lane * 32;
                for (int r = 0; r < 5; ++r) {
                    float best = -1.0f; int bi = 1;
                    for (int j = 1; j <= cur - 2; ++j) { const float v = my[j]; if (!((mask >> j) & 1u) && v > best) { best = v; bi = j; } }
                    mask |= 1u << bi;
                }
            }
        }
        msk[lane] = mask;
    }
    lds_wave_sync();
    const unsigned qmask = msk[fr];
    lds_wave_sync();
    {
        const bf16_t* Kb = p.hb + (size_t)b * SEQ * NMAIN + C_NKS + kv * 64;
        const bf16_t* VTb = p.vT + ((size_t)b * NVH + 6 + kv) * 64 * SEQ;
        attn_init<3>(o, m, l);
        unsigned um = qmask;
        um |= __shfl_xor(um, 1); um |= __shfl_xor(um, 2); um |= __shfl_xor(um, 4); um |= __shfl_xor(um, 8);
        um = (unsigned)__builtin_amdgcn_readfirstlane((int)um) & (cur >= 31 ? 0xffffffffu : ((2u << cur) - 1u));
        unsigned long long cm = 0ull;
        for (unsigned r = um; r; r &= r - 1) { const int kb = __builtin_ctz(r); cm |= 3ull << (2 * kb); }
        MaskIt it{cm};
        attn_run<false>(it, Kb, NMAIN, VTb, SEQ, fr, fq, [&](int kc0, const KVFrag& f) {
            const bool mine = (qmask >> (kc0 >> 6)) & 1u;
            const int dq = t - kc0 - 8 * fq;
            attn_compute<3, true>(f, qf, o, m, l, [&](int g, int j, float raw) { const int dist = dq - j; return (mine && dist >= 0) ? raw * SCL2 - sl[g] * (float)dist : MASKV; });
        });
#pragma unroll
        for (int g = 0; g < 3; ++g) {
            const float lt = lsum4(l[g]); const float sc = (lt > 0.f ? __builtin_amdgcn_rcpf(lt) : 0.f) * sigmoidf_fast(gl[g * 3 + 1]);
#pragma unroll
            for (int dt = 0; dt < 4; ++dt) otv[(g * 4 + dt) * 64] += o[g][dt] * sc;
        }
    }
    {
        const bf16_t* Kb = p.hb + (size_t)b * SEQ * NMAIN + C_NKW + kv * 64;
        const bf16_t* VTb = p.vT + ((size_t)b * NVH + 8 + kv) * 64 * SEQ;
        attn_init<3>(o, m, l);
        RangeIt it{max(0, t0 - 511) >> 5, (t0 + 15) >> 5};
        attn_run<false>(it, Kb, NMAIN, VTb, SEQ, fr, fq, [&](int kc0, const KVFrag& f) {
            const int dq = t - kc0 - 8 * fq;
            attn_compute<3, true>(f, qf, o, m, l, [&](int g, int j, float raw) { const int dist = dq - j; return (dist >= 0 && dist < 512) ? raw * SCL2 - sl[g] * (float)dist : MASKV; });
        });
#pragma unroll
        for (int g = 0; g < 3; ++g) {
            const float lt = lsum4(l[g]); const float sc = (lt > 0.f ? __builtin_amdgcn_rcpf(lt) : 0.f) * sigmoidf_fast(gl[g * 3 + 2]);
            bf16_t* dst = p.ob + ((size_t)b * SEQ + t) * DM + 640 + (kv * 3 + g) * 64 + 4 * fq;
#pragma unroll
            for (int dt = 0; dt < 4; ++dt) store_o4(dst + dt * 16, otv[(g * 4 + dt) * 64] + o[g][dt] * sc);
        }
    }
}

template <bool WITH_CONV>
__device__ __forceinline__ void phase_attn(const Params& p, int l, char* lds, int cslot = 16) {
    int tid = threadIdx.x; asm volatile("" : "+v"(tid));
    const int wid = tid >> 6, lane = tid & 63, fr = lane & 15, fq = lane >> 4;
    float* ps = (float*)(lds + wid * 16896); unsigned* msk = (unsigned*)(ps + 512); float* otl = ps + 576;
    unsigned* ctr = p.ctrl + cslot + l;
    constexpr unsigned NU_NSA = NB * 2 * 128, NU_FOX = NB * 4 * 64, NU_SWA = NB * 2 * 128, NU_ATT = NU_NSA + NU_FOX + NU_SWA;
    static_assert(!WITH_CONV || CONV_TILES == (int)NU_ATT, "queue interleave: one conversion tile per attention unit");
    for (;;) {
        unsigned u = 0;
        if (lane == 0) u = __hip_atomic_fetch_add(ctr, 1u, __ATOMIC_RELAXED, __HIP_MEMORY_SCOPE_AGENT);
        u = (unsigned)__builtin_amdgcn_readfirstlane((int)u);
        if (WITH_CONV) {
            if (u >= 2 * NU_ATT) break;
            if (u & 1u) { conv_tile_wave(p, (int)(u >> 1), lane, (unsigned char*)ps); continue; }
            u >>= 1;
        } else {
#ifndef ATT_REP
#define ATT_REP 1
#endif
            if (u >= ATT_REP * NU_ATT) break;
            if (ATT_REP > 1) u %= NU_ATT;
        }
        if (u < NU_NSA) { const int pos = 127 - (int)(u >> 5), r = u & 31; nsa_unit(p, r >> 1, r & 1, pos, fr, fq, lane, ps, msk, otl); }
        else if (u < NU_NSA + NU_FOX) { const unsigned v = u - NU_NSA; const int qb = 63 - (int)(v >> 6), r = v & 63; fox_unit(p, r >> 2, r & 3, qb, fr, fq); }
        else { const unsigned v = u - NU_NSA - NU_FOX; const int pos = 127 - (int)(v >> 5), r = v & 31; swa_unit(p, l, r >> 1, r & 1, pos, fr, fq); }
    }
}

__device__ __forceinline__ void phase_ln1_router(const Params& p, int l, char* lds) {
    int tid = threadIdx.x; asm volatile("" : "+v"(tid));
    const int wid = tid >> 6, lane = tid & 63, fr = lane & 15, fq = lane >> 4;
    float* lg = (float*)lds + wid * 512;
    int* lcnt = (int*)(lds + 16384); int* lbase = lcnt + 32;
    const float* g1 = p.ln1_g + l * DM; const float* b1 = p.ln1_b + l * DM;
    const float* rw = p.rwT + (size_t)l * NE * 1024; const float* rb = p.router_b + l * NE;
    unsigned* gcount = p.ctrl + 64 + l * NE;
    for (int grp = blockIdx.x; grp < NTOK / 128; grp += gridDim.x) {
        const int tok0 = grp * 128 + wid * 16;
        if (tid < 32) lcnt[tid] = 0;
        float4 gg[4], bb[4];
#pragma unroll
        for (int j = 0; j < 4; ++j) { gg[j] = *(const float4*)(g1 + j * 256 + lane * 4); bb[j] = *(const float4*)(b1 + j * 256 + lane * 4); }
        for (int r0 = 0; r0 < 16; r0 += 4) {
            float4 v[4][4]; float s[4], qv[4];
#pragma unroll
            for (int i = 0; i < 4; ++i)
#pragma unroll
                for (int j = 0; j < 4; ++j) v[i][j] = *(const float4*)(p.tbuf + (size_t)(tok0 + r0 + i) * DM + j * 256 + lane * 4);
#pragma unroll
            for (int i = 0; i < 4; ++i) { s[i] = 0.f;
#pragma unroll
                for (int j = 0; j < 4; ++j) s[i] += (v[i][j].x + v[i][j].y) + (v[i][j].z + v[i][j].w); }
#pragma unroll
            for (int o = 32; o > 0; o >>= 1) {
#pragma unroll
                for (int i = 0; i < 4; ++i) s[i] += __shfl_xor(s[i], o); }
#pragma unroll
            for (int i = 0; i < 4; ++i) { const float mean = s[i] * (1.0f / 1024.0f); qv[i] = 0.f;
#pragma unroll
                for (int j = 0; j < 4; ++j) { v[i][j].x -= mean; v[i][j].y -= mean; v[i][j].z -= mean; v[i][j].w -= mean; qv[i] += (v[i][j].x * v[i][j].x + v[i][j].y * v[i][j].y) + (v[i][j].z * v[i][j].z + v[i][j].w * v[i][j].w); } }
#pragma unroll
            for (int o = 32; o > 0; o >>= 1) {
#pragma unroll
                for (int i = 0; i < 4; ++i) qv[i] += __shfl_xor(qv[i], o); }
#pragma unroll
            for (int i = 0; i < 4; ++i) {
                const float rstd = rsqrtf(qv[i] * (1.0f / 1024.0f) + LN_EPS);
                const size_t row = (size_t)(tok0 + r0 + i);
#pragma unroll
                for (int j = 0; j < 4; ++j) {
                    const int c = j * 256 + lane * 4;
                    float4 y; y.x = v[i][j].x * rstd * gg[j].x + bb[j].x; y.y = v[i][j].y * rstd * gg[j].y + bb[j].y; y.z = v[i][j].z * rstd * gg[j].z + bb[j].z; y.w = v[i][j].w * rstd * gg[j].w + bb[j].w;
                    *(float4*)(p.x1f + row * DM + c) = y;
                    *(unsigned*)((char*)p.x1b + row * DM + c) = pack4_fp8(y.x, y.y, y.z, y.w);
                }
            }
        }
        __syncthreads();
        f32x4 a0 = (f32x4){0.f, 0.f, 0.f, 0.f}, a1 = a0;
        const float* xr = p.x1f + (size_t)(tok0 + fr) * DM + 4 * fq;
        const float* w0 = rw + (size_t)fr * 1024 + 4 * fq; const float* w1 = rw + (size_t)(16 + fr) * 1024 + 4 * fq;
#pragma unroll 4
        for (int k0 = 0; k0 < 1024; k0 += 16) {
            const float4 xa = *(const float4*)(xr + k0), wb0 = *(const float4*)(w0 + k0), wb1 = *(const float4*)(w1 + k0);
            a0 = __builtin_amdgcn_mfma_f32_16x16x4f32(xa.x, wb0.x, a0, 0, 0, 0); a1 = __builtin_amdgcn_mfma_f32_16x16x4f32(xa.x, wb1.x, a1, 0, 0, 0);
            a0 = __builtin_amdgcn_mfma_f32_16x16x4f32(xa.y, wb0.y, a0, 0, 0, 0); a1 = __builtin_amdgcn_mfma_f32_16x16x4f32(xa.y, wb1.y, a1, 0, 0, 0);
            a0 = __builtin_amdgcn_mfma_f32_16x16x4f32(xa.z, wb0.z, a0, 0, 0, 0); a1 = __builtin_amdgcn_mfma_f32_16x16x4f32(xa.z, wb1.z, a1, 0, 0, 0);
            a0 = __builtin_amdgcn_mfma_f32_16x16x4f32(xa.w, wb0.w, a0, 0, 0, 0); a1 = __builtin_amdgcn_mfma_f32_16x16x4f32(xa.w, wb1.w, a1, 0, 0, 0);
        }
#pragma unroll
        for (int r = 0; r < 4; ++r) { lg[(fq * 4 + r) * 32 + fr] = a0[r] + rb[fr]; lg[(fq * 4 + r) * 32 + 16 + fr] = a1[r] + rb[16 + fr]; }
        lds_wave_sync();
        int e4[4] = {0, 0, 0, 0}; int rk[4] = {0, 0, 0, 0};
        if (lane < 16) {
            const float* my = lg + lane * 32; unsigned taken = 0u; float tv[4];
#pragma unroll
            for (int k = 0; k < 4; ++k) {
                float best = NEG_INF; int bi = 0;
                for (int e = 0; e < 32; ++e) { const float xv = my[e]; if (!((taken >> e) & 1u) && xv > best) { best = xv; bi = e; } }
                taken |= 1u << bi; e4[k] = bi; tv[k] = best;
            }
            const float e1 = __expf(tv[1] - tv[0]), e2 = __expf(tv[2] - tv[0]), e3 = __expf(tv[3] - tv[0]);
            const float inv = 1.0f / (1.0f + e1 + e2 + e3);
            const size_t row = (size_t)(tok0 + lane);
            *(float4*)(p.gw + row * 4) = make_float4(inv, e1 * inv, e2 * inv, e3 * inv);
        }
        __syncthreads();
        if (lane < 16) {
#pragma unroll
            for (int k = 0; k < 4; ++k) rk[k] = atomicAdd(&lcnt[e4[k]], 1);
        }
        __syncthreads();
        if (tid < 32) { const int c = lcnt[tid]; lbase[tid] = c ? (int)__hip_atomic_fetch_add(gcount + tid, (unsigned)c, __ATOMIC_RELAXED, __HIP_MEMORY_SCOPE_AGENT) : 0; }
        __syncthreads();
        if (lane < 16) {
            const int row = tok0 + lane; int pk[4];
#pragma unroll
            for (int k = 0; k < 4; ++k) { const int pos = lbase[e4[k]] + rk[k]; p.lists[(size_t)e4[k] * LIST_CAP + pos] = row * 4 + k; pk[k] = (pos << 5) | e4[k]; }
            *(int4*)(p.top_e + (size_t)row * 4) = make_int4(pk[0], pk[1], pk[2], pk[3]);
        }
        __syncthreads();
    }
}

__device__ __forceinline__ void phase_ln2(const Params& p, int l, float* xout, char* lds) {
    int* ptile = (int*)(lds + LDS_TAB); int* ecnt = ptile + 40;
    build_tiles(p, l, ptile, ecnt);
    int tid = threadIdx.x; asm volatile("" : "+v"(tid));
    const int wid = tid >> 6, lane = tid & 63;
    const float* g2 = p.ln2_g + l * DM; const float* b2 = p.ln2_b + l * DM;
    float4 gg[4], bb[4];
#pragma unroll
    for (int j = 0; j < 4; ++j) { gg[j] = *(const float4*)(g2 + j * 256 + lane * 4); bb[j] = *(const float4*)(b2 + j * 256 + lane * 4); }
    for (int pr = blockIdx.x * NWV + wid; pr < NTOK / 2; pr += gridDim.x * NWV) {
        float4 v[2][4]; float s[2], qv[2];
        u32x2 yv[2][4][4]; float gk[2][4];
#pragma unroll
        for (int i = 0; i < 2; ++i) {
            const int row = pr * 2 + i;
            const float4 gwv = *(const float4*)(p.gw + (size_t)row * 4);
            gk[i][0] = gwv.x; gk[i][1] = gwv.y; gk[i][2] = gwv.z; gk[i][3] = gwv.w;
            const int4 te = *(const int4*)(p.top_e + (size_t)row * 4);
            const int tk[4] = {te.x, te.y, te.z, te.w};
#pragma unroll
            for (int j = 0; j < 4; ++j) v[i][j] = *(const float4*)(p.x1f + (size_t)row * DM + j * 256 + lane * 4);
#pragma unroll
            for (int k = 0; k < 4; ++k) {
                const bf16_t* yr = p.ybuf + (size_t)(ptile[tk[k] & 31] * 256 + (tk[k] >> 5)) * DM + lane * 4;
#pragma unroll
                for (int j = 0; j < 4; ++j) yv[i][k][j] = *(const u32x2*)(yr + j * 256);
            }
        }
#pragma unroll
        for (int i = 0; i < 2; ++i) { s[i] = 0.f;
#pragma unroll
            for (int j = 0; j < 4; ++j) {
                float4 a; a.x = v[i][j].x * ALPHA; a.y = v[i][j].y * ALPHA; a.z = v[i][j].z * ALPHA; a.w = v[i][j].w * ALPHA;
#pragma unroll
                for (int k = 0; k < 4; ++k) {
                    const u32x2 w = yv[i][k][j];
                    a.x += gk[i][k] * __uint_as_float(w.x << 16); a.y += gk[i][k] * __uint_as_float(w.x & 0xffff0000u);
                    a.z += gk[i][k] * __uint_as_float(w.y << 16); a.w += gk[i][k] * __uint_as_float(w.y & 0xffff0000u);
                }
                v[i][j] = a; s[i] += (a.x + a.y) + (a.z + a.w);
            } }
#pragma unroll
        for (int o = 32; o > 0; o >>= 1) { s[0] += __shfl_xor(s[0], o); s[1] += __shfl_xor(s[1], o); }
#pragma unroll
        for (int i = 0; i < 2; ++i) { const float mean = s[i] * (1.0f / 1024.0f); qv[i] = 0.f;
#pragma unroll
            for (int j = 0; j < 4; ++j) { v[i][j].x -= mean; v[i][j].y -= mean; v[i][j].z -= mean; v[i][j].w -= mean; qv[i] += (v[i][j].x * v[i][j].x + v[i][j].y * v[i][j].y) + (v[i][j].z * v[i][j].z + v[i][j].w * v[i][j].w); } }
#pragma unroll
        for (int o = 32; o > 0; o >>= 1) { qv[0] += __shfl_xor(qv[0], o); qv[1] += __shfl_xor(qv[1], o); }
#pragma unroll
        for (int i = 0; i < 2; ++i) {
            const float rstd = rsqrtf(qv[i] * (1.0f / 1024.0f) + LN_EPS);
            const size_t row = (size_t)(pr * 2 + i);
#pragma unroll
            for (int j = 0; j < 4; ++j) {
                const int c = j * 256 + lane * 4;
                float4 y; y.x = v[i][j].x * rstd * gg[j].x + bb[j].x; y.y = v[i][j].y * rstd * gg[j].y + bb[j].y; y.z = v[i][j].z * rstd * gg[j].z + bb[j].z; y.w = v[i][j].w * rstd * gg[j].w + bb[j].w;
                *(float4*)(xout + row * DM + c) = y;
                u32x2 w; w.x = pack2(y.x, y.y); w.y = pack2(y.z, y.w);
                *(u32x2*)(p.xb + row * DM + c) = w;
            }
        }
    }
}

#define XB_TMO      128
#define XB_XCNT(j)  (256  + 64 * (j))
#define XB_XSUB(j)  (1280 + 64 * (j))
#define XB_XGEN(j)  (2304 + 64 * (j))
#define XB_TOP      3328
#define XB_TOPGEN   3392
#define XCD_BAR_WORDS 3456
#define XB_SPIN_CAP (1u << 22)
__device__ __forceinline__ unsigned xb_ld(unsigned* p)              { return __hip_atomic_load(p, __ATOMIC_RELAXED, __HIP_MEMORY_SCOPE_AGENT); }
__device__ __forceinline__ unsigned xb_add(unsigned* p, unsigned v) { return __hip_atomic_fetch_add(p, v, __ATOMIC_RELAXED, __HIP_MEMORY_SCOPE_AGENT); }
__device__ __forceinline__ unsigned xb_xcc_id() { return (unsigned)__builtin_amdgcn_s_getreg((3 << 11) | 20) & 0xFu; }
#define XB_SPIN(cond, bar) do { unsigned _sp = 0; while (cond) { __builtin_amdgcn_s_sleep(1); \
    if ((++_sp & 255u) == 0u) { if (xb_ld(&(bar)[XB_TMO])) break; if (_sp > XB_SPIN_CAP) { atomicAdd(&(bar)[XB_TMO], 1u); break; } } } } while (0)
struct XcdBarrier { unsigned* bar; unsigned x; volatile LAS unsigned* st; };
__device__ __forceinline__ XcdBarrier xcd_barrier_post(unsigned* bar, volatile LAS unsigned* st) {
    XcdBarrier b; b.bar = bar; b.x = xb_xcc_id(); b.st = st;
    if (threadIdx.x == 0) (void)xb_add(&bar[XB_XCNT(b.x)], 1u);
    return b;
}
__device__ __forceinline__ void xcd_barrier_complete(unsigned* bar, unsigned x, unsigned& nloc, unsigned& nx) {
    const unsigned G = gridDim.x * gridDim.y * gridDim.z;
    unsigned sum, cnt, mine, sp = 0u;
    for (;;) {
        sum = 0u; cnt = 0u; mine = 0u;
#pragma unroll
        for (unsigned j = 0; j < 16; ++j) { const unsigned c = xb_ld(&bar[XB_XCNT(j)]); sum += c; cnt += (c > 0u) ? 1u : 0u; mine = (j == x) ? c : mine; }
        if (sum == G) break;
        __builtin_amdgcn_s_sleep(1);
        if ((++sp & 255u) == 0u) { if (xb_ld(&bar[XB_TMO])) break; if (sp > XB_SPIN_CAP) { atomicAdd(&bar[XB_TMO], 1u); break; } }
    }
    nloc = mine > 0u ? mine : 1u; nx = cnt > 0u ? cnt : 1u;
}
__device__ __forceinline__ void xcd_barrier(const XcdBarrier& b) {
    asm volatile("s_waitcnt vmcnt(0)" ::: "memory");
    __syncthreads();
    if (threadIdx.x == 0) {
        unsigned* bar = b.bar;
        __builtin_amdgcn_s_waitcnt(0);
        unsigned nloc = b.st[0], nx = b.st[1];
        if (nloc == 0u) { xcd_barrier_complete(bar, b.x, nloc, nx); b.st[0] = nloc; b.st[1] = nx; }
        const unsigned old = xb_add(&bar[XB_XSUB(b.x)], 1u);
        const unsigned gen = old / nloc;
        if (old + 1u == (gen + 1u) * nloc) {
            __builtin_amdgcn_fence(__ATOMIC_RELEASE, "agent");
            asm volatile("s_waitcnt vmcnt(0)" ::: "memory");
            const unsigned og = xb_add(&bar[XB_TOP], 1u);
            const unsigned tg = og / nx;
            if (og + 1u == (tg + 1u) * nx) xb_add(&bar[XB_TOPGEN], 1u);
            else XB_SPIN(xb_ld(&bar[XB_TOPGEN]) == tg, bar);
            __builtin_amdgcn_fence(__ATOMIC_ACQUIRE, "agent");
            xb_add(&bar[XB_XGEN(b.x)], 1u);
            asm volatile("s_waitcnt vmcnt(0)" ::: "memory");
        } else {
            XB_SPIN(xb_ld(&bar[XB_XGEN(b.x)]) == gen, bar);
            __builtin_amdgcn_fence(__ATOMIC_ACQUIRE, "agent");
            asm volatile("s_waitcnt vmcnt(0)" ::: "memory");
        }
    }
    __syncthreads();
}

struct KArgs { const float* in[18]; float* out; char* ws; };
constexpr size_t al256(size_t v) { return (v + 255) / 256 * 256; }
struct WSL {
    static constexpr size_t ctrl = 0;
    static constexpr size_t WinT = al256(ctrl + 65536);
    static constexpr size_t WoT = al256(WinT + (size_t)NL * NPAD * 1024 * 2);
    static constexpr size_t W1T = al256(WoT + (size_t)NL * 1024 * 1024 * 2);
    static constexpr size_t W2T = al256(W1T + (size_t)NL * 2 * 64 * 2048 * 2);
    static constexpr size_t WguT = al256(W2T + (size_t)NL * 2 * 64 * 64 * 2);
    static constexpr size_t WdnT = al256(WguT + (size_t)NL * NE * 2048 * 1024 * 2);
    static constexpr size_t rwT = al256(WdnT + (size_t)NL * NE * 1024 * 1024 * 2);
    static constexpr size_t binp = al256(rwT + (size_t)NL * NE * 1024 * 4);
    static constexpr size_t bgup = al256(binp + (size_t)NL * NPAD * 4);
    static constexpr size_t b1c = al256(bgup + (size_t)NL * NE * 2048 * 4);
    static constexpr size_t xf = al256(b1c + 4 * 64 * 4);
    static constexpr size_t xb = al256(xf + (size_t)NTOK * DM * 4);
    static constexpr size_t hb = al256(xb + (size_t)NTOK * DM * 2);
    static constexpr size_t hs = al256(hb + (size_t)NTOK * NMAIN * 2);
    static constexpr size_t vT = al256(hs + (size_t)NTOK * HS_W * 4);
    static constexpr size_t cF = al256(vT + (size_t)NB * NVH * 64 * SEQ * 2);
    static constexpr size_t kc = al256(cF + (size_t)NB * 4 * SEQ * 4);
    static constexpr size_t vc = al256(kc + (size_t)NB * 2 * 128 * 64 * 2);
    static constexpr size_t vcT = al256(vc + (size_t)NB * 2 * 128 * 64 * 2);
    static constexpr size_t ob = al256(vcT + (size_t)NB * 2 * 128 * 64 * 2);
    static constexpr size_t tbuf = al256(ob + (size_t)NTOK * DM * 2);
    static constexpr size_t x1f = al256(tbuf + (size_t)NTOK * DM * 4);
    static constexpr size_t x1b = al256(x1f + (size_t)NTOK * DM * 4);
    static constexpr size_t top_e = al256(x1b + (size_t)NTOK * DM * 2);
    static constexpr size_t gw = al256(top_e + (size_t)NTOK * 4 * 4);
    static constexpr size_t lists = al256(gw + (size_t)NTOK * 4 * 4);
    static constexpr size_t act = al256(lists + (size_t)NE * LIST_CAP * 4);
    static constexpr size_t ybuf = al256(act + (size_t)MAXSLOT * DFF * 2);
    static constexpr size_t total = al256(ybuf + (size_t)MAXSLOT * DM * 2);
};
__device__ __forceinline__ Params make_params(const KArgs& k) {
    Params p;
    p.x = k.in[0]; p.w_in = k.in[1]; p.b_in = k.in[2]; p.sinks = k.in[3]; p.cmp_pe = k.in[4]; p.cmp_w1 = k.in[5]; p.cmp_w2 = k.in[6]; p.w_out = k.in[7];
    p.ln1_g = k.in[8]; p.ln1_b = k.in[9]; p.router_w = k.in[10]; p.router_b = k.in[11]; p.w_gu = k.in[12]; p.b_gu = k.in[13]; p.w_dn = k.in[14]; p.b_dn = k.in[15];
    p.ln2_g = k.in[16]; p.ln2_b = k.in[17]; p.out = k.out;
    char* w = k.ws;
    p.ctrl = (unsigned*)(w + WSL::ctrl); p.WinT = (bf16_t*)(w + WSL::WinT); p.WoT = (bf16_t*)(w + WSL::WoT); p.W1T = (bf16_t*)(w + WSL::W1T); p.W2T = (bf16_t*)(w + WSL::W2T);
    p.WguT = (bf16_t*)(w + WSL::WguT); p.WdnT = (bf16_t*)(w + WSL::WdnT); p.rwT = (float*)(w + WSL::rwT); p.binp = (float*)(w + WSL::binp); p.bgup = (float*)(w + WSL::bgup);
    p.b1c = (float*)(w + WSL::b1c); p.xf = (float*)(w + WSL::xf); p.xb = (bf16_t*)(w + WSL::xb); p.hb = (bf16_t*)(w + WSL::hb); p.hs = (float*)(w + WSL::hs); p.vT = (bf16_t*)(w + WSL::vT);
    p.cF = (float*)(w + WSL::cF); p.kc = (bf16_t*)(w + WSL::kc); p.vc = (bf16_t*)(w + WSL::vc); p.vcT = (bf16_t*)(w + WSL::vcT); p.ob = (bf16_t*)(w + WSL::ob); p.tbuf = (float*)(w + WSL::tbuf);
    p.x1f = (float*)(w + WSL::x1f); p.x1b = (bf16_t*)(w + WSL::x1b); p.top_e = (int*)(w + WSL::top_e); p.gw = (float*)(w + WSL::gw); p.lists = (int*)(w + WSL::lists);
    p.act = (bf16_t*)(w + WSL::act); p.ybuf = (bf16_t*)(w + WSL::ybuf);
    return p;
}
__device__ __forceinline__ void grid_bar(const Params& p, char* lds) {
    XcdBarrier xb; xb.bar = p.ctrl + 1024; xb.x = xb_xcc_id(); xb.st = (volatile LAS unsigned*)(lds + LDS_BYTES - 16); xcd_barrier(xb);
}
template <int L>
__device__ __forceinline__ void layer_fwd(const Params& p, char* lds) {
    const float* xin = L == 0 ? p.x : p.xf;
    float* xout = L == NL - 1 ? p.out : p.xf;
#ifndef REP
#define REP 0
#endif
    phase_inproj(p, L, lds);        grid_bar(p, lds);
    if (REP & 1) { phase_inproj(p, L, lds);        grid_bar(p, lds); }
    phase_prep(p, L, lds);          grid_bar(p, lds);
    if (REP & 2) { phase_prep(p, L, lds);          grid_bar(p, lds); }
    phase_attn<L == 0>(p, L, lds);  grid_bar(p, lds);
    if (REP & 4) { phase_attn<false>(p, L, lds, 24); grid_bar(p, lds); }
    phase_outproj(p, L, xin, lds);  grid_bar(p, lds);
    if (REP & 8) { phase_outproj(p, L, xin, lds);  grid_bar(p, lds); }
    phase_ln1_router(p, L, lds);    grid_bar(p, lds);
    phase_gateup(p, L, lds);        grid_bar(p, lds);
    if (REP & 16) { phase_gateup(p, L, lds);       grid_bar(p, lds); }
    phase_down(p, L, lds);          grid_bar(p, lds);
    if (REP & 32) { phase_down(p, L, lds);         grid_bar(p, lds); }
    phase_ln2(p, L, xout, lds);
    if (REP & 64) { grid_bar(p, lds); phase_ln2(p, L, xout, lds); }
}
__global__ void __launch_bounds__(NTHR, 2) fwd_kernel(KArgs ka) {
    extern __shared__ __attribute__((aligned(16))) char lds[];
    const Params p = make_params(ka);
    cg::grid_group grid = cg::this_grid();
    volatile LAS unsigned* xst = (volatile LAS unsigned*)(lds + LDS_BYTES - 16);
    if (threadIdx.x == 0) { xst[0] = 0u; xst[1] = 0u; }
    __syncthreads();
    (void)xcd_barrier_post(p.ctrl + 1024, xst);
    phase0(p, lds);
    if (REP & 128) { grid_bar(p, lds); phase0(p, lds); }
    grid.sync();
    layer_fwd<0>(p, lds);
    grid_bar(p, lds);
    layer_fwd<1>(p, lds);
}

extern "C" void kernel_launch(void* const* d_in, const int* in_sizes, int n_in, void* d_out, int out_size, void* d_ws, size_t ws_size, hipStream_t stream) {
    KArgs ka{};
    for (int i = 0; i < 18; ++i) ka.in[i] = (const float*)d_in[i];
    ka.out = (float*)d_out; ka.ws = (char*)d_ws;
    if (WSL::total > ws_size) { fprintf(stderr, "workspace too small: need %zu have %zu\n", (size_t)WSL::total, ws_size); return; }
    static int grid_blocks = 0;
    if (!grid_blocks) {
        int dev = 0, cus = 0, per_cu = 0;
        (void)hipGetDevice(&dev);
        (void)hipDeviceGetAttribute(&cus, hipDeviceAttributeMultiprocessorCount, dev);
        (void)hipFuncSetAttribute((const void*)fwd_kernel, hipFuncAttributeMaxDynamicSharedMemorySize, LDS_BYTES);
        (void)hipOccupancyMaxActiveBlocksPerMultiprocessor(&per_cu, fwd_kernel, NTHR, LDS_BYTES);
        if (per_cu < 1) { fprintf(stderr, "occupancy query says 0 blocks per CU\n"); per_cu = 1; }
        grid_blocks = cus;
    }
    (void)hipMemsetAsync(d_ws, 0, 65536, stream);
    void* args[] = {&ka};
    hipError_t e = hipLaunchCooperativeKernel((const void*)fwd_kernel, dim3(grid_blocks), dim3(NTHR), args, LDS_BYTES, stream);
    if (e != hipSuccess) fprintf(stderr, "cooperative launch failed: %s (grid %d)\n", hipGetErrorString(e), grid_blocks);
}
```

```cpp
#include <hip/hip_runtime.h>
#include <hip/hip_cooperative_groups.h>
#include <cstdio>
#include <cstdint>
namespace cg = cooperative_groups;

typedef unsigned short bf16_t;
typedef short bf16x8 __attribute__((ext_vector_type(8)));
typedef float f32x4 __attribute__((ext_vector_type(4)));
typedef unsigned u32x4 __attribute__((ext_vector_type(4)));
typedef unsigned u32x2 __attribute__((ext_vector_type(2)));
typedef int v8i_t __attribute__((ext_vector_type(8)));
typedef int v4i_t __attribute__((ext_vector_type(4)));
#define LAS __attribute__((address_space(3)))
constexpr float NEG_INF = -__builtin_huge_valf();

constexpr int DM = 1024, NB = 16, SEQ = 2048, NTOK = NB * SEQ, NL = 2;
constexpr int NCOL = 2582, NMAIN = 2560, NPAD = 2688, NE = 32, DFF = 1024;
constexpr int C_FQ = 0, C_FK = 256, C_FV = 512, C_SQ = 768, C_SK = 1152, C_SV = 1280, C_NQ = 1408,
              C_NKC = 1792, C_NVC = 1920, C_NKS = 2048, C_NVS = 2176, C_NKW = 2304, C_NVW = 2432;
constexpr int HS_W = 32;
constexpr int NVH = 10;
constexpr int LIST_CAP = NTOK;
constexpr int MAXSLOT = NTOK * 4 + NE * 256;
constexpr float ALPHA = 1.41421356237f, LN_EPS = 1e-5f, QSCALE = 0.125f;
constexpr int NWV = 8, NTHR = NWV * 64;
constexpr int LDS_STAGE = 131072, LDS_TAB = LDS_STAGE, LDS_AOFF = LDS_STAGE + 2048, LDS_BYTES = LDS_AOFF + 20480 + 256;

struct Params {
    const float *x, *w_in, *b_in, *sinks, *cmp_pe, *cmp_w1, *cmp_w2, *w_out, *ln1_g, *ln1_b, *router_w, *router_b,
                *w_gu, *b_gu, *w_dn, *b_dn, *ln2_g, *ln2_b;
    float* out;
    unsigned* ctrl;
    bf16_t *WinT, *WoT, *W1T, *W2T, *WguT, *WdnT;
    float *rwT, *binp, *bgup, *b1c;
    float* xf; bf16_t* xb; bf16_t* hb; float* hs; bf16_t* vT; bf16_t* kF; float* cF;
    bf16_t *kc, *vc, *vcT; bf16_t* ob; float* tbuf; float* x1f; bf16_t* x1b;
    int* top_e; float* gw; int* lists; bf16_t* act; bf16_t* ybuf;
};

__device__ __forceinline__ float bf2f(bf16_t h) { return __uint_as_float(((unsigned)h) << 16); }
typedef __bf16 bf16x2_t __attribute__((ext_vector_type(2)));
__device__ __forceinline__ bf16_t f2bf(float f) { return __builtin_bit_cast(bf16_t, (__bf16)f); }
__device__ __forceinline__ unsigned pack2(float lo, float hi) { bf16x2_t v = {(__bf16)lo, (__bf16)hi}; return __builtin_bit_cast(unsigned, v); }
__device__ __forceinline__ unsigned pack4_fp8(float a, float b, float c, float d) {
    unsigned w = 0u;
    w = __builtin_amdgcn_cvt_pk_fp8_f32(a, b, w, false);
    w = __builtin_amdgcn_cvt_pk_fp8_f32(c, d, w, true);
    return w;
}
__device__ __forceinline__ float wave_sum(float v) {
#pragma unroll
    for (int o = 32; o > 0; o >>= 1) v += __shfl_xor(v, o);
    return v;
}
__device__ __forceinline__ float wave_max(float v) {
#pragma unroll
    for (int o = 32; o > 0; o >>= 1) v = fmaxf(v, __shfl_xor(v, o));
    return v;
}
__device__ __forceinline__ void lds_wave_sync() { asm volatile("s_waitcnt lgkmcnt(0)" ::: "memory"); __builtin_amdgcn_wave_barrier(); }
__device__ __forceinline__ float slope_swa(int hq) { return exp2f(-8.0f * (float)(2 * hq + 1) / 12.0f); }
__device__ __forceinline__ float slope_nsa(int hq) { return exp2f(-8.0f * (float)(2 * hq + 2) / 12.0f); }

__device__ __forceinline__ int perm_row(int perm, int n) {
    if (perm == 1) { if (n < 768) return n; if (n < 772) return 2560 + (n - 768); if (n < 2564) return n - 4; return n; }
    if (perm == 2) { const int f = n >> 1, s = n & 1; return (f >> 7) * 256 + s * 128 + (f & 127); }
    return n;
}
struct ConvJob { const float* src; bf16_t* dst; int K, N, kt, nt, perm; float q8; };
__device__ __forceinline__ bool conv_job(const Params& p, int t, ConvJob& jb) {
    constexpr int T_WIN = NL * 8 * 21, T_WO = NL * 8 * 8;
    if (t < T_WIN) { const int m = t / 168, r = t % 168; jb = ConvJob{p.w_in + (size_t)m * 1024 * NCOL, p.WinT + (size_t)m * NPAD * 1024, 1024, NCOL, r / 21, r % 21, 1, 0.f}; return true; }
    t -= T_WIN;
    if (t < T_WO) { const int m = t / 64, r = t % 64; jb = ConvJob{p.w_out + (size_t)m * 1024 * 1024, p.WoT + (size_t)m * 1024 * 1024, 1024, 1024, r / 8, r % 8, 0, 0.f}; return true; }
    return false;
}
constexpr int CONV_TILES = NL * NE * 192;
__device__ __forceinline__ void conv_tile_wave(const Params& p, int t, int lane, unsigned char* l8) {
    asm volatile("" : "+v"(lane));
    const int m = t / 192, r = t % 192;
    const float* src; unsigned char* dst; int N, kt, nt, perm;
    if (r < 128) { src = p.w_gu + (size_t)m * 1024 * 2048; dst = (unsigned char*)p.WguT + (size_t)m * 2048 * 1024; N = 2048; kt = r >> 4; nt = r & 15; perm = 2; }
    else { const int q = r - 128; src = p.w_dn + (size_t)m * 1024 * 1024; dst = (unsigned char*)p.WdnT + (size_t)m * 1024 * 1024; N = 1024; kt = q >> 3; nt = q & 7; perm = 0; }
    const float* s = src + (size_t)(kt * 128 + (lane >> 5)) * N + nt * 128 + (lane & 31) * 4;
    unsigned char* lw = l8 + (lane >> 5) * 132 + (lane & 31) * 4;
    float4 va[16], vb[16];
#pragma unroll
    for (int i = 0; i < 16; ++i) va[i] = *(const float4*)(s + (size_t)(2 * i) * N);
#pragma unroll
    for (int i = 0; i < 16; ++i) vb[i] = *(const float4*)(s + (size_t)(32 + 2 * i) * N);
#pragma unroll
    for (int i = 0; i < 16; ++i) *(unsigned*)(lw + (2 * i) * 132) = pack4_fp8(va[i].x * 64.0f, va[i].y * 64.0f, va[i].z * 64.0f, va[i].w * 64.0f);
#pragma unroll
    for (int i = 0; i < 16; ++i) va[i] = *(const float4*)(s + (size_t)(64 + 2 * i) * N);
#pragma unroll
    for (int i = 0; i < 16; ++i) *(unsigned*)(lw + (32 + 2 * i) * 132) = pack4_fp8(vb[i].x * 64.0f, vb[i].y * 64.0f, vb[i].z * 64.0f, vb[i].w * 64.0f);
#pragma unroll
    for (int i = 0; i < 16; ++i) vb[i] = *(const float4*)(s + (size_t)(96 + 2 * i) * N);
#pragma unroll
    for (int i = 0; i < 16; ++i) *(unsigned*)(lw + (64 + 2 * i) * 132) = pack4_fp8(va[i].x * 64.0f, va[i].y * 64.0f, va[i].z * 64.0f, va[i].w * 64.0f);
#pragma unroll
    for (int i = 0; i < 16; ++i) *(unsigned*)(lw + (96 + 2 * i) * 132) = pack4_fp8(vb[i].x * 64.0f, vb[i].y * 64.0f, vb[i].z * 64.0f, vb[i].w * 64.0f);
    lds_wave_sync();
#pragma unroll 4
    for (int i = 0; i < 16; ++i) {
        const int idx = lane + 64 * i, kc = idx & 7, nn = idx >> 3;
        const unsigned char* l = l8 + (kc * 16) * 132 + nn;
        u32x4 w;
        w.x = (unsigned)l[0] | ((unsigned)l[132] << 8) | ((unsigned)l[264] << 16) | ((unsigned)l[396] << 24);
        w.y = (unsigned)l[528] | ((unsigned)l[660] << 8) | ((unsigned)l[792] << 16) | ((unsigned)l[924] << 24);
        w.z = (unsigned)l[1056] | ((unsigned)l[1188] << 8) | ((unsigned)l[1320] << 16) | ((unsigned)l[1452] << 24);
        w.w = (unsigned)l[1584] | ((unsigned)l[1716] << 8) | ((unsigned)l[1848] << 16) | ((unsigned)l[1980] << 24);
        *(u32x4*)(dst + (size_t)perm_row(perm, nt * 128 + nn) * 1024 + kt * 128 + kc * 16) = w;
    }
    lds_wave_sync();
}
__device__ __forceinline__ void conv_load(const ConvJob& jb, int tid, float2 (&v)[16]) {
    const int n = jb.nt * 128 + (tid & 31) * 4;
    const float* s = jb.src + (size_t)(jb.kt * 128 + (tid >> 5)) * jb.N + n;
#pragma unroll
    for (int i = 0; i < 8; ++i) {
        const float* r = s + (size_t)(16 * i) * jb.N;
        v[2 * i] = (n + 1 < jb.N) ? *(const float2*)r : make_float2(0.f, 0.f);
        v[2 * i + 1] = (n + 3 < jb.N) ? *(const float2*)(r + 2) : make_float2(0.f, 0.f);
    }
}
__device__ __forceinline__ void phase0(const Params& p, char* ldsc) {
    int tid = threadIdx.x; asm volatile("" : "+v"(tid));
    const int G = gridDim.x, bid = blockIdx.x;
    const size_t gtid = (size_t)bid * NTHR + tid, gthreads = (size_t)G * NTHR;
    {
        constexpr int TOT = NL * 8 * 21 + NL * 8 * 8;
        bf16_t* lt = (bf16_t*)ldsc;
        ConvJob jb, jn; float2 v[16], vn[16];
        int t = bid; bool have = t < TOT && conv_job(p, t, jb);
        if (have) conv_load(jb, tid, v);
        while (have) {
            const int tn = t + G; const bool hn = tn < TOT && conv_job(p, tn, jn);
            if (hn) conv_load(jn, tid, vn);
            if (jb.q8 != 0.f) {
                unsigned char* l8 = (unsigned char*)lt;
#pragma unroll
                for (int i = 0; i < 8; ++i)
                    *(unsigned*)(l8 + ((tid >> 5) + 16 * i) * 132 + (tid & 31) * 4) = pack4_fp8(v[2 * i].x * jb.q8, v[2 * i].y * jb.q8, v[2 * i + 1].x * jb.q8, v[2 * i + 1].y * jb.q8);
                __syncthreads();
#pragma unroll
                for (int i = 0; i < 2; ++i) {
                    const int idx = tid + NTHR * i, kc = idx & 7, nn = idx >> 3, n = jb.nt * 128 + nn;
                    const unsigned char* l = l8 + (kc * 16) * 132 + nn;
                    u32x4 w;
                    w.x = (unsigned)l[0] | ((unsigned)l[132] << 8) | ((unsigned)l[264] << 16) | ((unsigned)l[396] << 24);
                    w.y = (unsigned)l[528] | ((unsigned)l[660] << 8) | ((unsigned)l[792] << 16) | ((unsigned)l[924] << 24);
                    w.z = (unsigned)l[1056] | ((unsigned)l[1188] << 8) | ((unsigned)l[1320] << 16) | ((unsigned)l[1452] << 24);
                    w.w = (unsigned)l[1584] | ((unsigned)l[1716] << 8) | ((unsigned)l[1848] << 16) | ((unsigned)l[1980] << 24);
                    *(u32x4*)((char*)jb.dst + (size_t)perm_row(jb.perm, n) * jb.K + jb.kt * 128 + kc * 16) = w;
                }
            } else {
#pragma unroll
                for (int i = 0; i < 8; ++i) {
                    u32x2 w; w.x = pack2(v[2 * i].x, v[2 * i].y); w.y = pack2(v[2 * i + 1].x, v[2 * i + 1].y);
                    *(u32x2*)(lt + ((tid >> 5) + 16 * i) * 136 + (tid & 31) * 4) = w;
                }
                __syncthreads();
#pragma unroll
                for (int i = 0; i < 4; ++i) {
                    const int idx = tid + NTHR * i, kc = idx & 15, nn = idx >> 4, n = jb.nt * 128 + nn;
                    if (n < jb.N) {
                        const bf16_t* l = lt + (kc * 8) * 136 + nn;
                        u32x4 w;
                        w.x = (unsigned)l[0] | ((unsigned)l[136] << 16); w.y = (unsigned)l[272] | ((unsigned)l[408] << 16);
                        w.z = (unsigned)l[544] | ((unsigned)l[680] << 16); w.w = (unsigned)l[816] | ((unsigned)l[952] << 16);
                        *(u32x4*)(jb.dst + (size_t)perm_row(jb.perm, n) * jb.K + jb.kt * 128 + kc * 8) = w;
                    }
                }
            }
            __syncthreads();
            t = tn; have = hn; jb = jn;
#pragma unroll
            for (int i = 0; i < 16; ++i) v[i] = vn[i];
        }
    }
    for (size_t i = gtid; i < (size_t)NL * 2 * 2048 * 64; i += gthreads) {
        const int k = (int)(i % 2048), n = (int)((i / 2048) % 64), m = (int)(i / (2048 * 64));
        p.W1T[i] = f2bf(p.cmp_w1[((size_t)m * 2048 + k) * 64 + n]);
    }
    for (size_t i = gtid; i < (size_t)NL * 2 * 64 * 64; i += gthreads) {
        const int k = (int)(i % 64), n = (int)((i / 64) % 64), m = (int)(i / 4096);
        p.W2T[i] = f2bf(p.cmp_w2[((size_t)m * 64 + k) * 64 + n]);
    }
    for (size_t i = gtid; i < (size_t)NL * NPAD; i += gthreads) {
        const int l = (int)(i / NPAD), r = (int)(i % NPAD);
        float v = 0.f;
        if (r < 2560) { const int n = r < 768 ? r : r + 4; v = p.b_in[l * NCOL + n]; }
        else if (r < 2564) v = p.b_in[l * NCOL + 768 + (r - 2560)];
        else if (r < 2582) v = p.b_in[l * NCOL + r];
        p.binp[i] = v;
    }
    for (size_t i = gtid; i < (size_t)NL * NE * 2048; i += gthreads) {
        const int r = (int)(i % 2048); const size_t le = i / 2048;
        const int s = (r >> 7) & 1, f = (r >> 8) * 128 + (r & 127);
        p.bgup[i] = p.b_gu[le * 2048 + 2 * f + s];
    }
    for (size_t i = gtid; i < (size_t)NL * NE * 1024; i += gthreads) {
        const int k = (int)(i % 1024), e = (int)((i / 1024) % NE), l = (int)(i / (1024 * NE));
        p.rwT[i] = p.router_w[((size_t)l * 1024 + k) * NE + e];
    }
    for (size_t i = gtid; i < (size_t)NL * (NPAD - NCOL) * 1024; i += gthreads) {
        const int l = (int)(i / ((NPAD - NCOL) * 1024)); const size_t r = i % ((size_t)(NPAD - NCOL) * 1024);
        p.WinT[(size_t)l * NPAD * 1024 + (size_t)NCOL * 1024 + r] = 0;
    }
    for (size_t i = gtid; i < (size_t)NTOK * DM / 4; i += gthreads) {
        const float4 v4 = ((const float4*)p.x)[i];
        u32x2 w; w.x = pack2(v4.x, v4.y); w.y = pack2(v4.z, v4.w);
        ((u32x2*)p.xb)[i] = w;
    }
    if (bid < 4) {
        float* lf = (float*)ldsc;
        const int j = tid & 63, part = tid >> 6;
        const float* pe = p.cmp_pe + (size_t)bid * 2048; const float* w1 = p.cmp_w1 + (size_t)bid * 2048 * 64;
        float s = 0.f;
        for (int kk = part * 256; kk < part * 256 + 256; ++kk) s += pe[kk] * w1[(size_t)kk * 64 + j];
        lf[tid] = s; __syncthreads();
        if (tid < 64) { float a = 0.f; for (int q = 0; q < 8; ++q) a += lf[tid + 64 * q]; p.b1c[bid * 64 + tid] = a; }
        __syncthreads();
    }
}

namespace pg8 {
constexpr int BM = 256, BK = 64, HALF = 128, HTB = HALF * BK * 2, NXCD = 8, WGM = 8;
__device__ __forceinline__ int lds_byte(int r, int c) { const int st = (r >> 4) * 2 + (c >> 5), rr = r & 15, cc = c & 31, ob = rr * 64 + cc * 2; return st * 1024 + (ob ^ (((ob >> 9) & 1) << 5)); }
__device__ __forceinline__ void stage_rc(int b, int& R, int& C) { const int st = b / 1024, sb = b % 1024, swz = sb ^ (((sb >> 9) & 1) << 5); R = (st >> 1) * 16 + swz / 64; C = (st & 1) * 32 + (swz % 64) / 2; }
__device__ __forceinline__ bool tile_order(int i, int G, int c, int nM, int nN, int& pm, int& pn) {
    const int nwg = nM * nN; const long L = (long)i * G + c; if (L >= nwg) return false;
    int wgid = (int)L; { const int q = nwg / NXCD, r = nwg % NXCD, xcd = wgid % NXCD, off = wgid / NXCD; wgid = (xcd < r ? xcd * (q + 1) : r * (q + 1) + (xcd - r) * q) + off; }
    const int nig = WGM * nN, gid = wgid / nig, fm = gid * WGM, gsz = (nM - fm) < WGM ? (nM - fm) : WGM;
    pm = fm + ((wgid % nig) % gsz); pn = (wgid % nig) / gsz; return true;
}
template <bool FP8, int SCA, class Sched, class Epi>
__device__ __forceinline__ void gemm_phase(LAS unsigned char* lds, const char* Abase, int K, const Sched& S, const Epi& E) {
    int tid = threadIdx.x; asm volatile("" : "+v"(tid));
    const int wid = __builtin_amdgcn_readfirstlane(tid >> 6), lane = tid & 63, wr = wid >> 2, wc = wid & 3, fr = lane & 15, fq = lane >> 4;
    const int nt = K / BK;
    int R0, C0, R1, C1; stage_rc(tid * 16, R0, C0); stage_rc(tid * 16 + 8192, R1, C1);
    LAS unsigned* aofs = (LAS unsigned*)(lds + LDS_AOFF) + tid;
    unsigned rg[10];
    rg[8] = (unsigned)(R0 * K + C0) * 2u; rg[9] = (unsigned)(R1 * K + C1) * 2u;
    if constexpr (FP8) { aofs[8 * NTHR] = rg[8]; aofs[9 * NTHR] = rg[9]; }
    const size_t kstep = (size_t)(BK * 2), hstep = (size_t)HALF * K * 2;
    const unsigned ldsw = (unsigned)wid * 1024u;
    const int aoff = lds_byte(wr * 64 + fr, fq * 8), boff = lds_byte(wc * 32 + fr, fq * 8);
#define PG8_SA(b, h) (((b) * 2 + (h)) * HTB)
#define PG8_SB(b, h) ((4 + (b) * 2 + (h)) * HTB)
#define PG8_OFS(sel, j) (FP8 ? aofs[((sel) * 4 + (j)) * NTHR] : ((sel) ? rg[4 + (j)] : rg[(j)]))
#define PG8_STAGE_B(bufoff, gbase) do { _Pragma("unroll") for (int _i = 0; _i < 2; ++_i) { const unsigned ob_ = FP8 ? aofs[(8 + _i) * NTHR] : rg[8 + _i]; \
        __builtin_amdgcn_global_load_lds((const unsigned*)((const char*)(gbase) + ob_), (LAS unsigned*)(lds + (bufoff) + ldsw + _i * 8192), 16, 0, 0); } } while (0)
#define PG8_STAGE_A(bufoff, kbyte, sel, h) do { const unsigned o0_ = PG8_OFS(sel, (h) * 2), o1_ = PG8_OFS(sel, (h) * 2 + 1); \
        __builtin_amdgcn_global_load_lds((const unsigned*)(Abase + (kbyte) + o0_), (LAS unsigned*)(lds + (bufoff) + ldsw), 16, 0, 0); \
        __builtin_amdgcn_global_load_lds((const unsigned*)(Abase + (kbyte) + o1_), (LAS unsigned*)(lds + (bufoff) + ldsw + 8192), 16, 0, 0); } while (0)
#define PG8_LDA(dst, b, h) do { _Pragma("unroll") for (int m = 0; m < 4; ++m) { \
        if constexpr (FP8) { const v4i_t lo_ = *(const LAS v4i_t*)(lds + PG8_SA(b, h) + aoff + m * 2048), hi_ = *(const LAS v4i_t*)(lds + PG8_SA(b, h) + aoff + m * 2048 + 1024); dst##8[m] = __builtin_shufflevector(lo_, hi_, 0, 1, 2, 3, 4, 5, 6, 7); } \
        else { _Pragma("unroll") for (int k = 0; k < 2; ++k) dst[m][k] = *(const LAS bf16x8*)(lds + PG8_SA(b, h) + aoff + m * 2048 + k * 1024); } } } while (0)
#define PG8_LDB(dst, b, h) do { _Pragma("unroll") for (int n = 0; n < 2; ++n) { \
        if constexpr (FP8) { const v4i_t lo_ = *(const LAS v4i_t*)(lds + PG8_SB(b, h) + boff + n * 2048), hi_ = *(const LAS v4i_t*)(lds + PG8_SB(b, h) + boff + n * 2048 + 1024); dst##8[n] = __builtin_shufflevector(lo_, hi_, 0, 1, 2, 3, 4, 5, 6, 7); } \
        else { _Pragma("unroll") for (int k = 0; k < 2; ++k) dst[n][k] = *(const LAS bf16x8*)(lds + PG8_SB(b, h) + boff + n * 2048 + k * 1024); } } } while (0)
#define PG8_MMA(ai, bj, At, Bt) do { __builtin_amdgcn_s_setprio(1); _Pragma("unroll") for (int m = 0; m < 4; ++m) _Pragma("unroll") for (int n = 0; n < 2; ++n) { \
        if constexpr (FP8) { acc[ai][bj][m][n] = __builtin_amdgcn_mfma_scale_f32_16x16x128_f8f6f4(Bt##8[n], At##8[m], acc[ai][bj][m][n], 0, 0, 0, SCA, 0, SCA); } \
        else { _Pragma("unroll") for (int k = 0; k < 2; ++k) acc[ai][bj][m][n] = __builtin_amdgcn_mfma_f32_16x16x32_bf16(Bt[n][k], At[m][k], acc[ai][bj][m][n], 0, 0, 0); } } \
        __builtin_amdgcn_s_setprio(0); } while (0)
#define PG8_WAIT_V(n) asm volatile("s_waitcnt vmcnt(" #n ")" ::: "memory")
#define PG8_WAIT_L(n) asm volatile("s_waitcnt lgkmcnt(" #n ")" ::: "memory")
#define PG8_BAR __builtin_amdgcn_s_barrier()
#define PG8_SCHED __builtin_amdgcn_sched_barrier(0)
    typename Sched::Unit cur, nxt; int ui = 0;
    if (!S.next(0, cur)) return;
    f32x4 acc[2][2][4][2];
#pragma unroll
    for (int a = 0; a < 2; ++a)
#pragma unroll
        for (int b = 0; b < 2; ++b)
#pragma unroll
            for (int m = 0; m < 4; ++m)
#pragma unroll
                for (int n = 0; n < 2; ++n) acc[a][b][m][n] = (f32x4){0.f, 0.f, 0.f, 0.f};
    bf16x8 At[4][2], B0[2][2], B1[2][2];
    v8i_t At8[4], B08[2], B18[2];
    { unsigned a4[2][2]; S.a_off(cur, R0, C0, R1, C1, a4); rg[0] = a4[0][0]; rg[1] = a4[0][1]; rg[2] = a4[1][0]; rg[3] = a4[1][1];
      if constexpr (FP8) { aofs[0] = a4[0][0]; aofs[NTHR] = a4[0][1]; aofs[2 * NTHR] = a4[1][0]; aofs[3 * NTHR] = a4[1][1]; } }
    const char* cB = S.b_ptr(cur);
    PG8_STAGE_B(PG8_SB(0, 0), cB); PG8_STAGE_B(PG8_SB(0, 1), cB + hstep); PG8_STAGE_A(PG8_SA(0, 0), 0, 0, 0); PG8_STAGE_A(PG8_SA(0, 1), 0, 0, 1);
    if (wr == 1) PG8_BAR;
    PG8_WAIT_V(2); PG8_BAR;
    PG8_STAGE_B(PG8_SB(1, 0), cB + kstep); PG8_STAGE_A(PG8_SA(1, 0), kstep, 0, 0); PG8_STAGE_B(PG8_SB(1, 1), cB + hstep + kstep);
    PG8_WAIT_V(6); PG8_BAR;
    for (;;) {
        const bool has_next = S.next(ui + 1, nxt);
        const char* nB = cB;
        if (has_next) { int t2 = threadIdx.x; asm volatile("" : "+v"(t2)); int r0, c0, r1, c1; stage_rc(t2 * 16, r0, c0); stage_rc(t2 * 16 + 8192, r1, c1); unsigned a4[2][2]; S.a_off(nxt, r0, c0, r1, c1, a4); nB = S.b_ptr(nxt);
            rg[4] = a4[0][0]; rg[5] = a4[0][1]; rg[6] = a4[1][0]; rg[7] = a4[1][1];
            if constexpr (FP8) { aofs[4 * NTHR] = a4[0][0]; aofs[5 * NTHR] = a4[0][1]; aofs[6 * NTHR] = a4[1][0]; aofs[7 * NTHR] = a4[1][1]; } }
        else { rg[4] = rg[0]; rg[5] = rg[1]; rg[6] = rg[2]; rg[7] = rg[3];
            if constexpr (FP8) { aofs[4 * NTHR] = aofs[0]; aofs[5 * NTHR] = aofs[NTHR]; aofs[6 * NTHR] = aofs[2 * NTHR]; aofs[7 * NTHR] = aofs[3 * NTHR]; } }
#pragma unroll 1
        for (int t = 0; t < nt; t += 2) {
            const bool last = (t == nt - 2);
            const size_t ka1 = (size_t)(t + 1) * kstep, ka2 = last ? 0 : (size_t)(t + 2) * kstep, ka3 = ka2 + kstep;
            const char* b2 = last ? nB : cB + (size_t)(t + 2) * kstep; const char* b3 = b2 + kstep;
            const int sel = last ? 1 : 0;
            PG8_LDB(B0, 0, 0); PG8_LDB(B1, 0, 1); PG8_SCHED; PG8_LDA(At, 0, 0); PG8_STAGE_A(PG8_SA(1, 1), ka1, 0, 1);
            PG8_WAIT_V(8); PG8_WAIT_L(0); PG8_BAR; PG8_MMA(0, 0, At, B0); PG8_MMA(0, 1, At, B1); PG8_BAR; PG8_SCHED;
            PG8_LDA(At, 0, 1); PG8_STAGE_B(PG8_SB(0, 0), b2); PG8_STAGE_B(PG8_SB(0, 1), b2 + hstep); PG8_STAGE_A(PG8_SA(0, 0), ka2, sel, 0);
            PG8_WAIT_V(8); PG8_WAIT_L(0); PG8_BAR; PG8_MMA(1, 0, At, B0); PG8_MMA(1, 1, At, B1); PG8_BAR; PG8_SCHED;
            PG8_LDB(B0, 1, 0); PG8_LDB(B1, 1, 1); PG8_SCHED; PG8_LDA(At, 1, 0); PG8_STAGE_A(PG8_SA(0, 1), ka2, sel, 1);
            PG8_WAIT_V(8); PG8_WAIT_L(0); PG8_BAR; PG8_MMA(0, 0, At, B0); PG8_MMA(0, 1, At, B1); PG8_BAR; PG8_SCHED;
            PG8_LDA(At, 1, 1); PG8_STAGE_B(PG8_SB(1, 0), b3); PG8_STAGE_B(PG8_SB(1, 1), b3 + hstep); PG8_STAGE_A(PG8_SA(1, 0), ka3, sel, 0);
            PG8_WAIT_V(8); PG8_WAIT_L(0); PG8_BAR; PG8_MMA(1, 0, At, B0); PG8_MMA(1, 1, At, B1); PG8_BAR; PG8_SCHED;
        }
        if (wr == 0) PG8_BAR;
        { int t2 = threadIdx.x; asm volatile("" : "+v"(t2)); E(acc, cur, wr, wc, t2 & 15, (t2 & 63) >> 4); }
        if (!has_next) break;
#pragma unroll
        for (int a = 0; a < 2; ++a)
#pragma unroll
            for (int b = 0; b < 2; ++b)
#pragma unroll
                for (int m = 0; m < 4; ++m)
#pragma unroll
                    for (int n = 0; n < 2; ++n) acc[a][b][m][n] = (f32x4){0.f, 0.f, 0.f, 0.f};
        cur = nxt; cB = nB; ++ui;
        rg[0] = rg[4]; rg[1] = rg[5]; rg[2] = rg[6]; rg[3] = rg[7];
        if constexpr (FP8) { aofs[0] = aofs[4 * NTHR]; aofs[NTHR] = aofs[5 * NTHR]; aofs[2 * NTHR] = aofs[6 * NTHR]; aofs[3 * NTHR] = aofs[7 * NTHR]; }
        if (wr == 1) PG8_BAR;
    }
    PG8_WAIT_V(0);
    PG8_BAR;
#undef PG8_SA
#undef PG8_SB
#undef PG8_STAGE_A
#undef PG8_OFS
#undef PG8_STAGE_B
#undef PG8_LDA
#undef PG8_LDB
#undef PG8_MMA
#undef PG8_WAIT_V
#undef PG8_WAIT_L
#undef PG8_BAR
#undef PG8_SCHED
}
}

struct DenseUnit { int pm, pn; };
struct DenseSched {
    typedef DenseUnit Unit;
    const char* Bt; int K, nM, nN;
    __device__ __forceinline__ bool next(int i, Unit& u) const { return pg8::tile_order(i, gridDim.x, blockIdx.x, nM, nN, u.pm, u.pn); }
    __device__ __forceinline__ void a_off(const Unit& u, int R0, int C0, int R1, int C1, unsigned (&off)[2][2]) const {
#pragma unroll
        for (int h = 0; h < 2; ++h) { off[h][0] = (unsigned)((u.pm * 256 + h * 128 + R0) * K + C0) * 2u; off[h][1] = (unsigned)((u.pm * 256 + h * 128 + R1) * K + C1) * 2u; }
    }
    __device__ __forceinline__ const char* b_ptr(const Unit& u) const { return Bt + (size_t)u.pn * 256 * K * 2; }
};
struct MoeUnit { int rbt, e, pn; };
template <bool GATHER>
struct MoeSched {
    typedef MoeUnit Unit;
    static constexpr int KP = 512;
    const char* Bt; const int* lists; const int* ptile; const int* ecnt; int nN, nrows;
    __device__ __forceinline__ bool next(int i, Unit& u) const {
        int pm, pn; if (!pg8::tile_order(i, gridDim.x, blockIdx.x, ptile[NE], nN, pm, pn)) return false;
        int e = 0; while (ptile[e + 1] <= pm) ++e;
        u.rbt = pm; u.e = e; u.pn = pn; return true;
    }
    __device__ __forceinline__ void a_off(const Unit& u, int R0, int C0, int R1, int C1, unsigned (&off)[2][2]) const {
        if (GATHER) {
            const int* lst = lists + (size_t)u.e * LIST_CAP; const int rb = u.rbt - ptile[u.e], cnt = ecnt[u.e];
#pragma unroll
            for (int h = 0; h < 2; ++h) {
                const int l0 = rb * 256 + h * 128 + R0, l1 = rb * 256 + h * 128 + R1;
                const int t0 = l0 < cnt ? (lst[l0] >> 2) : 0, t1 = l1 < cnt ? (lst[l1] >> 2) : 0;
                off[h][0] = (unsigned)(t0 * KP + C0) * 2u; off[h][1] = (unsigned)(t1 * KP + C1) * 2u;
            }
        } else {
#pragma unroll
            for (int h = 0; h < 2; ++h) { off[h][0] = (unsigned)((u.rbt * 256 + h * 128 + R0) * KP + C0) * 2u; off[h][1] = (unsigned)((u.rbt * 256 + h * 128 + R1) * KP + C1) * 2u; }
        }
    }
    __device__ __forceinline__ const char* b_ptr(const Unit& u) const { return Bt + ((size_t)u.e * nrows + (size_t)u.pn * 256) * KP * 2; }
};

struct EpiInProj {
    const Params* p; int l;
    __device__ __forceinline__ void operator()(const f32x4 (&acc)[2][2][4][2], const DenseUnit& u, int wr, int wc, int fr, int fq) const {
        const float* bias = p->binp + l * NPAD + u.pn * 256;
#pragma unroll
        for (int bj = 0; bj < 2; ++bj) {
            int kind = 0, hb0 = 0;
            if (u.pn == 1) { kind = 1; hb0 = bj * 2; } else if (u.pn == 4 && bj == 1) { kind = 1; hb0 = 4; } else if (u.pn == 8 && bj == 0) { kind = 1; hb0 = 6; } else if (u.pn == 9 && bj == 0) { kind = 1; hb0 = 8; }
            else if (u.pn == 2) { kind = 2; hb0 = bj * 2; } else if (u.pn == 5 && bj == 0) { kind = 2; hb0 = 4; } else if (u.pn == 8 && bj == 1) { kind = 2; hb0 = 6; } else if (u.pn == 9 && bj == 1) { kind = 2; hb0 = 8; }
#pragma unroll
            for (int n = 0; n < 2; ++n) {
                const int c = bj * 128 + wc * 32 + n * 16 + 4 * fq;
                const f32x4 bv = *(const f32x4*)(bias + c);
                const int hh = hb0 + ((c & 127) >> 6), d = c & 63;
#pragma unroll
                for (int ai = 0; ai < 2; ++ai)
#pragma unroll
                    for (int m = 0; m < 4; ++m) {
                        const int row = u.pm * 256 + ai * 128 + wr * 64 + m * 16 + fr;
                        const f32x4 v = acc[ai][bj][m][n] + bv;
                        u32x2 w; w.x = pack2(v[0], v[1]); w.y = pack2(v[2], v[3]);
                        if (kind == 0) *(u32x2*)(p->hb + (size_t)row * NMAIN + u.pn * 256 + c) = w;
                        else {
                            const int b = row >> 11, s = row & 2047, kk = s & 31;
                            bf16_t* blk = (kind == 1 ? p->kF : p->vT) + (((size_t)b * NVH + hh) * 64 + (s >> 5)) * 2048;
                            if (kind == 1) {
                                const int frk = (kk >> 3) * 4 + (kk & 3), t = (kk >> 2) & 1;
                                *(u32x2*)(blk + ((t * 2 + (d >> 5)) * 64 + ((d & 31) >> 3) * 16 + frk) * 8 + (d & 7)) = w;
                            } else {
                                bf16_t* vt = blk + (((d >> 4) * 64) + (kk >> 3) * 16 + (d & 15)) * 8 + (kk & 7);
                                vt[0] = (bf16_t)(w.x & 0xffff); vt[8] = (bf16_t)(w.x >> 16); vt[16] = (bf16_t)(w.y & 0xffff); vt[24] = (bf16_t)(w.y >> 16);
                            }
                        }
                    }
            }
        }
    }
};
struct EpiOutProj {
    const float* xin; float* t;
    __device__ __forceinline__ void operator()(const f32x4 (&acc)[2][2][4][2], const DenseUnit& u, int wr, int wc, int fr, int fq) const {
#pragma unroll
        for (int ai = 0; ai < 2; ++ai)
#pragma unroll
            for (int m = 0; m < 4; ++m) {
                const size_t rowoff = (size_t)(u.pm * 256 + ai * 128 + wr * 64 + m * 16 + fr) * DM + u.pn * 256 + wc * 32 + 4 * fq;
#pragma unroll
                for (int bj = 0; bj < 2; ++bj)
#pragma unroll
                    for (int n = 0; n < 2; ++n) {
                        const size_t off = rowoff + bj * 128 + n * 16;
                        const f32x4 xv = *(const f32x4*)(xin + off);
                        *(f32x4*)(t + off) = xv * ALPHA + acc[ai][bj][m][n];
                    }
            }
    }
};
struct EpiGateUp {
    bf16_t* act; const float* bgup;
    __device__ __forceinline__ void operator()(const f32x4 (&acc)[2][2][4][2], const MoeUnit& u, int wr, int wc, int fr, int fq) const {
        const float* bias = bgup + (size_t)u.e * 2048 + u.pn * 256;
#pragma unroll
        for (int n = 0; n < 2; ++n) {
            const int c = wc * 32 + n * 16 + 4 * fq;
            const f32x4 bg = *(const f32x4*)(bias + c), bu = *(const f32x4*)(bias + 128 + c);
#pragma unroll
            for (int ai = 0; ai < 2; ++ai)
#pragma unroll
                for (int m = 0; m < 4; ++m) {
                    const f32x4 g4 = acc[ai][0][m][n] + bg, u4 = acc[ai][1][m][n] + bu;
                    float o[4];
#pragma unroll
                    for (int j = 0; j < 4; ++j) {
                        const float g = fminf(g4[j], 7.0f), uu = fminf(fmaxf(u4[j], -7.0f), 7.0f);
                        const float glu = g * __builtin_amdgcn_rcpf(1.0f + __builtin_amdgcn_exp2f(-2.455466929f * g));
                        o[j] = (uu + 1.0f) * glu;
                    }
                    *(unsigned*)((char*)act + (size_t)(u.rbt * 256 + ai * 128 + wr * 64 + m * 16 + fr) * DFF + u.pn * 128 + c) = pack4_fp8(o[0], o[1], o[2], o[3]);
                }
        }
    }
};
struct EpiDown {
    bf16_t* ybuf; const float* bdn;
    __device__ __forceinline__ void operator()(const f32x4 (&acc)[2][2][4][2], const MoeUnit& u, int wr, int wc, int fr, int fq) const {
        const float* bias = bdn + (size_t)u.e * 1024 + u.pn * 256;
#pragma unroll
        for (int bj = 0; bj < 2; ++bj)
#pragma unroll
            for (int n = 0; n < 2; ++n) {
                const int c = bj * 128 + wc * 32 + n * 16 + 4 * fq;
                const f32x4 bv = *(const f32x4*)(bias + c);
#pragma unroll
                for (int ai = 0; ai < 2; ++ai)
#pragma unroll
                    for (int m = 0; m < 4; ++m) {
                        const f32x4 v = acc[ai][bj][m][n] + bv;
                        u32x2 w; w.x = pack2(v[0], v[1]); w.y = pack2(v[2], v[3]);
                        *(u32x2*)(ybuf + (size_t)(u.rbt * 256 + ai * 128 + wr * 64 + m * 16 + fr) * DM + u.pn * 256 + c) = w;
                    }
            }
    }
};

__device__ __forceinline__ void phase_inproj(const Params& p, int l, char* lds) {
    DenseSched S{(const char*)(p.WinT + (size_t)l * NPAD * 1024), 1024, NTOK / 256, NMAIN / 256};
    EpiInProj E{&p, l};
    pg8::gemm_phase<false, 0>((LAS unsigned char*)lds, (const char*)p.xb, 1024, S, E);
    int tid = threadIdx.x; asm volatile("" : "+v"(tid));
    const int wid = tid >> 6, lane = tid & 63, fr = lane & 15, fq = lane >> 4;
    const bf16_t* W = p.WinT + ((size_t)l * NPAD + NMAIN) * 1024;
    const float* bias = p.binp + l * NPAD + NMAIN;
    for (int u = blockIdx.x * NWV + wid; u < NTOK / 16; u += gridDim.x * NWV) {
        const bf16_t* ar = p.xb + (size_t)(u * 16 + fr) * DM + fq * 8;
        const bf16_t* w0 = W + (size_t)fr * 1024 + fq * 8; const bf16_t* w1 = W + (size_t)(16 + fr) * 1024 + fq * 8;
        f32x4 a0 = (f32x4){0.f, 0.f, 0.f, 0.f}, a1 = a0;
#pragma unroll 4
        for (int ks = 0; ks < 32; ++ks) {
            const bf16x8 a = *(const bf16x8*)(ar + ks * 32);
            a0 = __builtin_amdgcn_mfma_f32_16x16x32_bf16(a, *(const bf16x8*)(w0 + ks * 32), a0, 0, 0, 0);
            a1 = __builtin_amdgcn_mfma_f32_16x16x32_bf16(a, *(const bf16x8*)(w1 + ks * 32), a1, 0, 0, 0);
        }
#pragma unroll
        for (int r = 0; r < 4; ++r) {
            float* dst = p.hs + (size_t)(u * 16 + fq * 4 + r) * HS_W;
            dst[fr] = a0[r] + bias[fr];
            if (fr < 6) dst[16 + fr] = a1[r] + bias[16 + fr];
        }
    }
}
__device__ __forceinline__ void phase_outproj(const Params& p, int l, const float* xin, char* lds) {
    DenseSched S{(const char*)(p.WoT + (size_t)l * 1024 * 1024), 1024, NTOK / 256, 4};
    EpiOutProj E{xin, p.tbuf};
    pg8::gemm_phase<false, 0>((LAS unsigned char*)lds, (const char*)p.ob, 1024, S, E);
}
__device__ __forceinline__ void build_tiles(const Params& p, int l, int* ptile, int* ecnt) {
    int tid = threadIdx.x; asm volatile("" : "+v"(tid));
    if (tid < NE) ecnt[tid] = (int)__hip_atomic_load(p.ctrl + 64 + l * NE + tid, __ATOMIC_RELAXED, __HIP_MEMORY_SCOPE_AGENT);
    __syncthreads();
    if (tid == 0) { int s = 0; for (int e = 0; e < NE; ++e) { ptile[e] = s; s += (ecnt[e] + 255) >> 8; } ptile[NE] = s; }
    __syncthreads();
}
__device__ __forceinline__ void phase_gateup(const Params& p, int l, char* lds) {
    int* ptile = (int*)(lds + LDS_TAB); int* ecnt = ptile + 40;
    build_tiles(p, l, ptile, ecnt);
    MoeSched<true> S{(const char*)p.WguT + (size_t)l * NE * 2048 * 1024, p.lists, ptile, ecnt, 8, 2048};
    EpiGateUp E{p.act, p.bgup + (size_t)l * NE * 2048};
    pg8::gemm_phase<true, 0x7c7c7c7c>((LAS unsigned char*)lds, (const char*)p.x1b, 512, S, E);
}
__device__ __forceinline__ void phase_down(const Params& p, int l, char* lds) {
    int* ptile = (int*)(lds + LDS_TAB); int* ecnt = ptile + 40;
    build_tiles(p, l, ptile, ecnt);
    MoeSched<false> S{(const char*)p.WdnT + (size_t)l * NE * 1024 * 1024, p.lists, ptile, ecnt, 4, 1024};
    EpiDown E{p.ybuf, p.b_dn + (size_t)l * NE * 1024};
    pg8::gemm_phase<true, 0x7c7c7c7c>((LAS unsigned char*)lds, (const char*)p.act, 512, S, E);
}

__device__ __forceinline__ float gelu_tanh(float x) {
    const float u = 0.7978845608028654f * (x + 0.044715f * x * x * x);
    const float e = __expf(-2.0f * fabsf(u)); const float th = (1.0f - e) / (1.0f + e);
    return 0.5f * x * (1.0f + (u < 0.f ? -th : th));
}
__device__ __forceinline__ void phase_prep(const Params& p, int l, char* lds) {
    int tid = threadIdx.x; asm volatile("" : "+v"(tid));
    const int wid = tid >> 6, lane = tid & 63, fr = lane & 15, fq = lane >> 4;
    const int gw = blockIdx.x * NWV + wid, nw = gridDim.x * NWV;
    for (int u = (int)gridDim.x - 1 - (int)blockIdx.x; u < NB * 4; u += gridDim.x) {
        const int b = u >> 2, h = u & 3;
        const float* srcp = p.hs + ((size_t)b * SEQ + tid * 4) * HS_W + h;
        float ls[4]; float tot = 0.f;
#pragma unroll
        for (int i = 0; i < 4; ++i) { const float f = srcp[(size_t)i * HS_W]; ls[i] = fminf(f, 0.f) - log1pf(__expf(-fabsf(f))); tot += ls[i]; }
        float inc = tot;
#pragma unroll
        for (int o = 1; o < 64; o <<= 1) { const float v = __shfl_up(inc, o); if (lane >= o) inc += v; }
        float* wtot = (float*)(lds + 65536);
        if (lane == 63) wtot[wid] = inc;
        __syncthreads();
        float base = inc - tot;
        for (int w = 0; w < wid; ++w) base += wtot[w];
        float4 o4; o4.x = base + ls[0]; o4.y = o4.x + ls[1]; o4.z = o4.y + ls[2]; o4.w = o4.z + ls[3];
        *(float4*)(p.cF + (size_t)u * SEQ + tid * 4) = o4;
        __syncthreads();
    }
    float* part = (float*)lds;
    bf16_t* h1 = (bf16_t*)(lds + 32768);
    for (int u = blockIdx.x; u < NB * 2 * 2 * 8; u += gridDim.x) {
        const int ct = u & 7, which = (u >> 3) & 1, kvh = (u >> 4) & 1, b = u >> 5;
        const int colo = (which ? C_NVC : C_NKC) + kvh * 64;
        const int c_lane = ct * 16 + fr;
        const int tokbase = min(c_lane, 126) * 16;
        const bf16_t* arow = p.hb + ((size_t)b * SEQ + tokbase) * NMAIN + colo + fq * 8;
        const bf16_t* w1 = p.W1T + ((size_t)(l * 2 + which) * 64 + fr) * 2048 + fq * 8;
        f32x4 acc[4];
#pragma unroll
        for (int n = 0; n < 4; ++n) acc[n] = (f32x4){0.f, 0.f, 0.f, 0.f};
#pragma unroll
        for (int kk = 0; kk < 8; ++kk) {
            const int ks = wid * 8 + kk;
            const bf16x8 a = *(const bf16x8*)(arow + (size_t)(ks >> 1) * NMAIN + (ks & 1) * 32);
#pragma unroll
            for (int n = 0; n < 4; ++n) {
                const bf16x8 bb = *(const bf16x8*)(w1 + (size_t)n * 16 * 2048 + ks * 32);
                acc[n] = __builtin_amdgcn_mfma_f32_16x16x32_bf16(a, bb, acc[n], 0, 0, 0);
            }
        }
#pragma unroll
        for (int n = 0; n < 4; ++n)
#pragma unroll
            for (int r = 0; r < 4; ++r) part[wid * 1024 + (fq * 4 + r) * 64 + n * 16 + fr] = acc[n][r];
        __syncthreads();
        const float* b1 = p.b1c + (l * 2 + which) * 64;
#pragma unroll
        for (int i = 0; i < 2; ++i) {
            const int e = tid + NTHR * i; float sum = 0.f;
#pragma unroll
            for (int w = 0; w < 8; ++w) sum += part[w * 1024 + e];
            h1[e] = f2bf(gelu_tanh(sum + b1[e & 63]));
        }
        __syncthreads();
        if (wid == 0) {
            const bf16_t* w2 = p.W2T + ((size_t)(l * 2 + which) * 64 + fr) * 64 + fq * 8;
            f32x4 o2[4];
#pragma unroll
            for (int n = 0; n < 4; ++n) o2[n] = (f32x4){0.f, 0.f, 0.f, 0.f};
#pragma unroll
            for (int ks = 0; ks < 2; ++ks) {
                const bf16x8 a = *(const bf16x8*)(h1 + fr * 64 + ks * 32 + fq * 8);
#pragma unroll
                for (int n = 0; n < 4; ++n) {
                    const bf16x8 bb = *(const bf16x8*)(w2 + (size_t)n * 16 * 64 + ks * 32);
                    o2[n] = __builtin_amdgcn_mfma_f32_16x16x32_bf16(a, bb, o2[n], 0, 0, 0);
                }
            }
            const size_t base = ((size_t)b * 2 + kvh) * 128 * 64;
#pragma unroll
            for (int n = 0; n < 4; ++n)
#pragma unroll
                for (int r = 0; r < 4; ++r) {
                    const int c = ct * 16 + fq * 4 + r, j2 = n * 16 + fr;
                    const bf16_t v = c < 127 ? f2bf(o2[n][r]) : (bf16_t)0;
                    if (which == 0) p.kc[base + (size_t)c * 64 + j2] = v;
                    else { p.vc[base + (size_t)c * 64 + j2] = v; p.vcT[base + (size_t)j2 * 128 + c] = v; }
                }
        }
        __syncthreads();
    }
}

constexpr float L2E = 1.4426950408889634f, MASKV = -1e30f, SCL2 = QSCALE * L2E;
struct KVFrag { bf16x8 k[2][2]; bf16x8 v[4]; };
template <bool FM>
__device__ __forceinline__ void k_load(KVFrag& f, const bf16_t* __restrict__ Kb, size_t ldk, int kc0, int fr, int fq) {
    if (FM) {
        const bf16_t* kp = Kb + (size_t)(kc0 >> 5) * 2048 + (fq * 16 + fr) * 8;
        f.k[0][0] = *(const bf16x8*)(kp); f.k[0][1] = *(const bf16x8*)(kp + 512); f.k[1][0] = *(const bf16x8*)(kp + 1024); f.k[1][1] = *(const bf16x8*)(kp + 1536);
    } else {
        const bf16_t* kp = Kb + (size_t)(kc0 + (fr >> 2) * 8 + (fr & 3)) * ldk + fq * 8;
        f.k[0][0] = *(const bf16x8*)(kp); f.k[0][1] = *(const bf16x8*)(kp + 32);
        f.k[1][0] = *(const bf16x8*)(kp + 4 * ldk); f.k[1][1] = *(const bf16x8*)(kp + 4 * ldk + 32);
    }
}
template <bool FM>
__device__ __forceinline__ void v_load(bf16x8 (&v)[4], const bf16_t* __restrict__ VTb, size_t ldv, int kc0, int fr, int fq) {
    if (FM) {
        const bf16_t* vp = VTb + (size_t)(kc0 >> 5) * 2048 + (fq * 16 + fr) * 8;
#pragma unroll
        for (int dt = 0; dt < 4; ++dt) v[dt] = *(const bf16x8*)(vp + dt * 512);
    } else {
        const bf16_t* vp = VTb + (size_t)fr * ldv + kc0 + fq * 8;
#pragma unroll
        for (int dt = 0; dt < 4; ++dt) v[dt] = *(const bf16x8*)(vp + (size_t)dt * 16 * ldv);
    }
}
__device__ __forceinline__ float rowmax4(float x) {
    auto r = __builtin_amdgcn_permlane32_swap(__float_as_uint(x), __float_as_uint(x), false, false);
    x = fmaxf(__uint_as_float(r[0]), __uint_as_float(r[1]));
    auto q = __builtin_amdgcn_permlane16_swap(__float_as_uint(x), __float_as_uint(x), false, false);
    return fmaxf(__uint_as_float(q[0]), __uint_as_float(q[1]));
}
__device__ __forceinline__ float rowsum4(float x) {
    auto r = __builtin_amdgcn_permlane32_swap(__float_as_uint(x), __float_as_uint(x), false, false);
    x = __uint_as_float(r[0]) + __uint_as_float(r[1]);
    auto q = __builtin_amdgcn_permlane16_swap(__float_as_uint(x), __float_as_uint(x), false, false);
    return __uint_as_float(q[0]) + __uint_as_float(q[1]);
}
template <int NQT, bool MASK, class MB>
__device__ __forceinline__ void attn_compute(const KVFrag& f, const bf16x8 (&qf)[NQT][2], f32x4 (&o)[NQT][4], float (&m)[NQT], float (&l)[NQT], const MB& mb) {
    f32x4 s0[NQT], s1[NQT];
#pragma unroll
    for (int qt = 0; qt < NQT; ++qt) {
        s0[qt] = __builtin_amdgcn_mfma_f32_16x16x32_bf16(f.k[0][0], qf[qt][0], (f32x4){0.f, 0.f, 0.f, 0.f}, 0, 0, 0);
        s1[qt] = __builtin_amdgcn_mfma_f32_16x16x32_bf16(f.k[1][0], qf[qt][0], (f32x4){0.f, 0.f, 0.f, 0.f}, 0, 0, 0);
    }
#pragma unroll
    for (int qt = 0; qt < NQT; ++qt) {
        s0[qt] = __builtin_amdgcn_mfma_f32_16x16x32_bf16(f.k[0][1], qf[qt][1], s0[qt], 0, 0, 0);
        s1[qt] = __builtin_amdgcn_mfma_f32_16x16x32_bf16(f.k[1][1], qf[qt][1], s1[qt], 0, 0, 0);
    }
    float mx[NQT];
#pragma unroll
    for (int qt = 0; qt < NQT; ++qt) {
#pragma unroll
        for (int j = 0; j < 4; ++j) { s0[qt][j] = mb(qt, j, s0[qt][j]); s1[qt][j] = mb(qt, j + 4, s1[qt][j]); }
        mx[qt] = fmaxf(fmaxf(fmaxf(s0[qt][0], s0[qt][1]), fmaxf(s0[qt][2], s0[qt][3])), fmaxf(fmaxf(s1[qt][0], s1[qt][1]), fmaxf(s1[qt][2], s1[qt][3])));
    }
#pragma unroll
    for (int qt = 0; qt < NQT; ++qt) mx[qt] = rowmax4(mx[qt]);
    bool moved = false;
#pragma unroll
    for (int qt = 0; qt < NQT; ++qt) { mx[qt] = fmaxf(m[qt], mx[qt]); moved |= (mx[qt] != m[qt]); }
    if (__ballot(moved) != 0ull) {
#pragma unroll
        for (int qt = 0; qt < NQT; ++qt) {
            const float alpha = __builtin_amdgcn_exp2f(m[qt] - mx[qt]);
            l[qt] *= alpha;
#pragma unroll
            for (int dt = 0; dt < 4; ++dt) o[qt][dt] *= alpha;
        }
    }
    bf16x8 pf[NQT];
#pragma unroll
    for (int qt = 0; qt < NQT; ++qt) {
        m[qt] = mx[qt];
        float pr[8]; float ps = 0.f;
#pragma unroll
        for (int j = 0; j < 4; ++j) {
            pr[j] = (!MASK || s0[qt][j] > -1e29f) ? __builtin_amdgcn_exp2f(s0[qt][j] - mx[qt]) : 0.f;
            pr[j + 4] = (!MASK || s1[qt][j] > -1e29f) ? __builtin_amdgcn_exp2f(s1[qt][j] - mx[qt]) : 0.f;
        }
#pragma unroll
        for (int j = 0; j < 8; ++j) ps += pr[j];
        l[qt] += ps;
        const u32x4 pk = {pack2(pr[0], pr[1]), pack2(pr[2], pr[3]), pack2(pr[4], pr[5]), pack2(pr[6], pr[7])};
        pf[qt] = __builtin_bit_cast(bf16x8, pk);
    }
#pragma unroll
    for (int dt = 0; dt < 4; ++dt)
#pragma unroll
        for (int qt = 0; qt < NQT; ++qt) o[qt][dt] = __builtin_amdgcn_mfma_f32_16x16x32_bf16(f.v[dt], pf[qt], o[qt][dt], 0, 0, 0);
    __builtin_amdgcn_sched_barrier(0);
}
struct RangeIt { int c, c_hi; __device__ __forceinline__ int nxt() { if (c > c_hi) return -1; return (c++) * 32; } };
struct MaskIt { unsigned long long cm; __device__ __forceinline__ int nxt() { if (!cm) return -1; const int i = __builtin_ctzll(cm); cm &= cm - 1; return i * 32; } };
template <bool PFV, bool FM, class It, class Gen>
__device__ __forceinline__ void attn_run(It& it, const bf16_t* Kb, size_t ldk, const bf16_t* VTb, size_t ldv, int fr, int fq, const Gen& gen) {
    KVFrag fa, fb;
    int ka = it.nxt(); if (ka < 0) return;
    k_load<FM>(fa, Kb, ldk, ka, fr, fq); if (PFV) v_load<FM>(fa.v, VTb, ldv, ka, fr, fq);
    for (;;) {
        const int kb = it.nxt(); if (kb >= 0) { k_load<FM>(fb, Kb, ldk, kb, fr, fq); if (PFV) v_load<FM>(fb.v, VTb, ldv, kb, fr, fq); }
        if (!PFV) v_load<FM>(fa.v, VTb, ldv, ka, fr, fq);
        gen(ka, fa);
        if (kb < 0) break;
        ka = it.nxt(); if (ka >= 0) { k_load<FM>(fa, Kb, ldk, ka, fr, fq); if (PFV) v_load<FM>(fa.v, VTb, ldv, ka, fr, fq); }
        if (!PFV) v_load<FM>(fb.v, VTb, ldv, kb, fr, fq);
        gen(kb, fb);
        if (ka < 0) break;
    }
}
template <int NQT>
__device__ __forceinline__ void attn_init(f32x4 (&o)[NQT][4], float (&m)[NQT], float (&l)[NQT]) {
#pragma unroll
    for (int qt = 0; qt < NQT; ++qt) { m[qt] = MASKV; l[qt] = 0.f;
#pragma unroll
        for (int dt = 0; dt < 4; ++dt) o[qt][dt] = (f32x4){0.f, 0.f, 0.f, 0.f}; }
}
__device__ __forceinline__ float lsum4(float l) { return rowsum4(l); }
__device__ __forceinline__ void store_o4(bf16_t* dst, const f32x4 v) { u32x2 w; w.x = pack2(v[0], v[1]); w.y = pack2(v[2], v[3]); *(u32x2*)dst = w; }
__device__ __forceinline__ float sigmoidf_fast(float x) { return __builtin_amdgcn_rcpf(1.0f + __builtin_amdgcn_exp2f(-L2E * x)); }

__device__ __forceinline__ void fox_unit(const Params& p, int b, int h, int qb, int fr, int fq) {
    asm volatile("" : "+v"(fr), "+v"(fq));
    const int t0 = qb * 32;
    const bf16_t* Qb = p.hb + ((size_t)b * SEQ + t0) * NMAIN + C_FQ + h * 64 + fq * 8;
    bf16x8 qf[2][2];
#pragma unroll
    for (int qt = 0; qt < 2; ++qt) { qf[qt][0] = *(const bf16x8*)(Qb + (size_t)(qt * 16 + fr) * NMAIN); qf[qt][1] = *(const bf16x8*)(Qb + (size_t)(qt * 16 + fr) * NMAIN + 32); }
    const float* cf = p.cF + ((size_t)b * 4 + h) * SEQ;
    float cq[2];
#pragma unroll
    for (int qt = 0; qt < 2; ++qt) cq[qt] = cf[t0 + qt * 16 + fr] * L2E;
    f32x4 o[2][4]; float m[2], l[2];
    attn_init<2>(o, m, l);
    const bf16_t* Kb = p.kF + ((size_t)b * NVH + h) * 64 * SEQ;
    const bf16_t* VTb = p.vT + ((size_t)b * NVH + h) * 64 * SEQ;
    RangeIt it{0, t0 >> 5};
    attn_run<true, true>(it, Kb, NMAIN, VTb, SEQ, fr, fq, [&](int kc0, const KVFrag& f) {
        const float4 ca = *(const float4*)(cf + kc0 + 8 * fq), cb = *(const float4*)(cf + kc0 + 8 * fq + 4);
        const float ck[8] = {ca.x * L2E, ca.y * L2E, ca.z * L2E, ca.w * L2E, cb.x * L2E, cb.y * L2E, cb.z * L2E, cb.w * L2E};
        const int kq = kc0 + 8 * fq - t0 - fr;
        attn_compute<2, true>(f, qf, o, m, l, [&](int qt, int j, float raw) { return (kq + j - 16 * qt) > 0 ? MASKV : raw * SCL2 + cq[qt] - ck[j]; });
    });
#pragma unroll
    for (int qt = 0; qt < 2; ++qt) {
        const float inv = __builtin_amdgcn_rcpf(lsum4(l[qt]));
        bf16_t* dst = p.ob + ((size_t)b * SEQ + t0 + qt * 16 + fr) * DM + h * 64 + 4 * fq;
#pragma unroll
        for (int dt = 0; dt < 4; ++dt) store_o4(dst + dt * 16, o[qt][dt] * inv);
    }
}
__device__ __forceinline__ void swa_unit(const Params& p, int l_, int b, int kv, int pos, int fr, int fq) {
    asm volatile("" : "+v"(fr), "+v"(fq));
    const int t0 = pos * 16, t = t0 + fr;
    const bf16_t* Qb = p.hb + ((size_t)b * SEQ + t) * NMAIN + C_SQ + kv * 192 + fq * 8;
    bf16x8 qf[3][2];
#pragma unroll
    for (int g = 0; g < 3; ++g) { qf[g][0] = *(const bf16x8*)(Qb + g * 64); qf[g][1] = *(const bf16x8*)(Qb + g * 64 + 32); }
    float sl[3];
#pragma unroll
    for (int g = 0; g < 3; ++g) sl[g] = slope_swa(kv * 3 + g) * L2E;
    f32x4 o[3][4]; float m[3], l[3];
    attn_init<3>(o, m, l);
    const bf16_t* Kb = p.kF + ((size_t)b * NVH + 4 + kv) * 64 * SEQ;
    const bf16_t* VTb = p.vT + ((size_t)b * NVH + 4 + kv) * 64 * SEQ;
    RangeIt it{max(0, t0 - 127) >> 5, (t0 + 15) >> 5};
    attn_run<true, true>(it, Kb, NMAIN, VTb, SEQ, fr, fq, [&](int kc0, const KVFrag& f) {
        const int dq = t - kc0 - 8 * fq;
        attn_compute<3, true>(f, qf, o, m, l, [&](int g, int j, float raw) { const int dist = dq - j; return (dist >= 0 && dist < 128) ? raw * SCL2 - sl[g] * (float)dist : MASKV; });
    });
#pragma unroll
    for (int g = 0; g < 3; ++g) {
        const float sink = p.sinks[l_ * 6 + kv * 3 + g] * L2E;
        const float inv = __builtin_amdgcn_rcpf(lsum4(l[g]) + __builtin_amdgcn_exp2f(sink - m[g]));
        bf16_t* dst = p.ob + ((size_t)b * SEQ + t) * DM + 256 + (kv * 3 + g) * 64 + 4 * fq;
#pragma unroll
        for (int dt = 0; dt < 4; ++dt) store_o4(dst + dt * 16, o[g][dt] * inv);
    }
}
__device__ __forceinline__ void nsa_unit(const Params& p, int b, int kv, int pos, int fr, int fq, int lane, float* ps, unsigned* msk, float* otl) {
    asm volatile("" : "+v"(fr), "+v"(fq), "+v"(lane));
    const int t0 = pos * 16, t = t0 + fr, cur = t0 >> 6;
    const bf16_t* Qb = p.hb + ((size_t)b * SEQ + t) * NMAIN + C_NQ + kv * 192 + fq * 8;
    bf16x8 qf[3][2];
#pragma unroll
    for (int g = 0; g < 3; ++g) { qf[g][0] = *(const bf16x8*)(Qb + g * 64); qf[g][1] = *(const bf16x8*)(Qb + g * 64 + 32); }
    float sl[3];
#pragma unroll
    for (int g = 0; g < 3; ++g) sl[g] = slope_nsa(kv * 3 + g) * L2E;
    const float* gl = p.hs + ((size_t)b * SEQ + t) * HS_W + 4 + kv * 9;
    f32x4 o[3][4]; float m[3], l[3];
    f32x4* otv = (f32x4*)otl + lane;
#pragma unroll
    for (int i = 0; i < 8; ++i) ps[lane + 64 * i] = 0.f;
    {
        const bf16_t* Kb = p.kc + ((size_t)b * 2 + kv) * 128 * 64;
        const bf16_t* VTb = p.vcT + ((size_t)b * 2 + kv) * 64 * 128;
        const int ncv = (t0 + 15 >= 31) ? ((t0 + 15 - 31) >> 4) + 1 : 0;
        const int nch = (ncv + 31) >> 5;
        attn_init<3>(o, m, l);
        const int dq0 = t - 31 - 16 * 8 * fq;
        RangeIt it{0, nch - 1};
        attn_run<false, false>(it, Kb, 64, VTb, 128, fr, fq, [&](int kc0, const KVFrag& f) {
            const int dq = dq0 - 16 * kc0;
            attn_compute<3, true>(f, qf, o, m, l, [&](int g, int j, float raw) { const int dist = dq - 16 * j; return dist >= 0 ? raw * SCL2 - sl[g] * (float)dist : MASKV; });
        });
        float il[3];
#pragma unroll
        for (int g = 0; g < 3; ++g) {
            const float lt = lsum4(l[g]); il[g] = lt > 0.f ? __builtin_amdgcn_rcpf(lt) : 0.f;
            const float gate = sigmoidf_fast(gl[g * 3 + 0]);
#pragma unroll
            for (int dt = 0; dt < 4; ++dt) otv[(g * 4 + dt) * 64] = o[g][dt] * (il[g] * gate);
        }
        float carry_prev = 0.f;
        for (int c = 0; c < nch; ++c) {
            const int kc0 = c * 32, dq = dq0 - 16 * kc0;
            const bf16_t* kp = Kb + (size_t)(kc0 + (fr >> 2) * 8 + (fr & 3)) * 64 + fq * 8;
            const bf16x8 k00 = *(const bf16x8*)(kp), k01 = *(const bf16x8*)(kp + 32), k10 = *(const bf16x8*)(kp + 256), k11 = *(const bf16x8*)(kp + 256 + 32);
            float pc[8];
#pragma unroll
            for (int j = 0; j < 8; ++j) pc[j] = 0.f;
#pragma unroll
            for (int g = 0; g < 3; ++g) {
                f32x4 s0 = (f32x4){0.f, 0.f, 0.f, 0.f}, s1 = s0;
                s0 = __builtin_amdgcn_mfma_f32_16x16x32_bf16(k00, qf[g][0], s0, 0, 0, 0); s0 = __builtin_amdgcn_mfma_f32_16x16x32_bf16(k01, qf[g][1], s0, 0, 0, 0);
                s1 = __builtin_amdgcn_mfma_f32_16x16x32_bf16(k10, qf[g][0], s1, 0, 0, 0); s1 = __builtin_amdgcn_mfma_f32_16x16x32_bf16(k11, qf[g][1], s1, 0, 0, 0);
#pragma unroll
                for (int j = 0; j < 8; ++j) {
                    const int dist = dq - 16 * j; const float raw = j < 4 ? s0[j] : s1[j - 4];
                    if (dist >= 0) pc[j] += __builtin_amdgcn_exp2f(raw * SCL2 - sl[g] * (float)dist - m[g]) * il[g];
                }
            }
            const float cout = 0.5f * pc[7];
            float cin = __shfl_up(cout, 16);
            const float cwrap = __shfl(cout, fr + 48);
            if (fq == 0) cin = carry_prev;
            carry_prev = cwrap;
            const int n0 = (kc0 >> 2) + 2 * fq;
            ps[fr * 32 + n0] = cin + pc[0] + pc[1] + pc[2] + 0.5f * pc[3];
            ps[fr * 32 + n0 + 1] = 0.5f * pc[3] + pc[4] + pc[5] + pc[6] + 0.5f * pc[7];
        }
    }
    lds_wave_sync();
    if (lane < 16) {
        unsigned mask = 1u | (1u << cur); if (cur >= 1) mask |= 1u << (cur - 1);
        if (cur >= 3) {
            if (cur - 2 <= 5) mask |= (1u << (cur - 1)) - 2u;
            else {
                const float* my = ps + lane * 32;
                for (int r = 0; r < 5; ++r) {
                    float best = -1.0f; int bi = 1;
                    for (int j = 1; j <= cur - 2; ++j) { const float v = my[j]; if (!((mask >> j) & 1u) && v > best) { best = v; bi = j; } }
                    mask |= 1u << bi;
                }
            }
        }
        msk[lane] = mask;
    }
    lds_wave_sync();
    const unsigned qmask = msk[fr];
    lds_wave_sync();
    {
        const bf16_t* Kb = p.kF + ((size_t)b * NVH + 6 + kv) * 64 * SEQ;
        const bf16_t* VTb = p.vT + ((size_t)b * NVH + 6 + kv) * 64 * SEQ;
        attn_init<3>(o, m, l);
        unsigned um = qmask;
        um |= __shfl_xor(um, 1); um |= __shfl_xor(um, 2); um |= __shfl_xor(um, 4); um |= __shfl_xor(um, 8);
        um = (unsigned)__builtin_amdgcn_readfirstlane((int)um) & (cur >= 31 ? 0xffffffffu : ((2u << cur) - 1u));
        unsigned long long cm = 0ull;
        for (unsigned r = um; r; r &= r - 1) { const int kb = __builtin_ctz(r); cm |= 3ull << (2 * kb); }
        MaskIt it{cm};
        attn_run<false, true>(it, Kb, NMAIN, VTb, SEQ, fr, fq, [&](int kc0, const KVFrag& f) {
            const bool mine = (qmask >> (kc0 >> 6)) & 1u;
            const int dq = t - kc0 - 8 * fq;
            attn_compute<3, true>(f, qf, o, m, l, [&](int g, int j, float raw) { const int dist = dq - j; return (mine && dist >= 0) ? raw * SCL2 - sl[g] * (float)dist : MASKV; });
        });
#pragma unroll
        for (int g = 0; g < 3; ++g) {
            const float lt = lsum4(l[g]); const float sc = (lt > 0.f ? __builtin_amdgcn_rcpf(lt) : 0.f) * sigmoidf_fast(gl[g * 3 + 1]);
#pragma unroll
            for (int dt = 0; dt < 4; ++dt) otv[(g * 4 + dt) * 64] += o[g][dt] * sc;
        }
    }
    {
        const bf16_t* Kb = p.kF + ((size_t)b * NVH + 8 + kv) * 64 * SEQ;
        const bf16_t* VTb = p.vT + ((size_t)b * NVH + 8 + kv) * 64 * SEQ;
        attn_init<3>(o, m, l);
        RangeIt it{max(0, t0 - 511) >> 5, (t0 + 15) >> 5};
        attn_run<false, true>(it, Kb, NMAIN, VTb, SEQ, fr, fq, [&](int kc0, const KVFrag& f) {
            const int dq = t - kc0 - 8 * fq;
            attn_compute<3, true>(f, qf, o, m, l, [&](int g, int j, float raw) { const int dist = dq - j; return (dist >= 0 && dist < 512) ? raw * SCL2 - sl[g] * (float)dist : MASKV; });
        });
#pragma unroll
        for (int g = 0; g < 3; ++g) {
            const float lt = lsum4(l[g]); const float sc = (lt > 0.f ? __builtin_amdgcn_rcpf(lt) : 0.f) * sigmoidf_fast(gl[g * 3 + 2]);
            bf16_t* dst = p.ob + ((size_t)b * SEQ + t) * DM + 640 + (kv * 3 + g) * 64 + 4 * fq;
#pragma unroll
            for (int dt = 0; dt < 4; ++dt) store_o4(dst + dt * 16, otv[(g * 4 + dt) * 64] + o[g][dt] * sc);
        }
    }
}

template <bool WITH_CONV>
__device__ __forceinline__ void phase_attn(const Params& p, int l, char* lds, int cslot = 16) {
    int tid = threadIdx.x; asm volatile("" : "+v"(tid));
    const int wid = tid >> 6, lane = tid & 63, fr = lane & 15, fq = lane >> 4;
    float* ps = (float*)(lds + wid * 16896); unsigned* msk = (unsigned*)(ps + 512); float* otl = ps + 576;
    unsigned* ctr = p.ctrl + cslot + l;
    constexpr unsigned NU_NSA = NB * 2 * 128, NU_FOX = NB * 4 * 64, NU_SWA = NB * 2 * 128, NU_ATT = NU_NSA + NU_FOX + NU_SWA;
    static_assert(!WITH_CONV || CONV_TILES == (int)NU_ATT, "queue interleave: one conversion tile per attention unit");
    for (;;) {
        unsigned u = 0;
        if (lane == 0) u = __hip_atomic_fetch_add(ctr, 1u, __ATOMIC_RELAXED, __HIP_MEMORY_SCOPE_AGENT);
        u = (unsigned)__builtin_amdgcn_readfirstlane((int)u);
        if (WITH_CONV) {
            if (u >= 2 * NU_ATT) break;
            if (u & 1u) { conv_tile_wave(p, (int)(u >> 1), lane, (unsigned char*)ps); continue; }
            u >>= 1;
        } else {
#ifndef ATT_REP
#define ATT_REP 1
#endif
            if (u >= ATT_REP * NU_ATT) break;
            if (ATT_REP > 1) u %= NU_ATT;
        }
        if (u < NU_NSA) { const int pos = 127 - (int)(u >> 5), r = u & 31; nsa_unit(p, r >> 1, r & 1, pos, fr, fq, lane, ps, msk, otl); }
        else if (u < NU_NSA + NU_FOX) { const unsigned v = u - NU_NSA; const int qb = 63 - (int)(v >> 6), r = v & 63; fox_unit(p, r >> 2, r & 3, qb, fr, fq); }
        else { const unsigned v = u - NU_NSA - NU_FOX; const int pos = 127 - (int)(v >> 5), r = v & 31; swa_unit(p, l, r >> 1, r & 1, pos, fr, fq); }
    }
}

__device__ __forceinline__ void phase_ln1_router(const Params& p, int l, char* lds) {
    int tid = threadIdx.x; asm volatile("" : "+v"(tid));
    const int wid = tid >> 6, lane = tid & 63, fr = lane & 15, fq = lane >> 4;
    float* lg = (float*)lds + wid * 512;
    int* lcnt = (int*)(lds + 16384); int* lbase = lcnt + 32;
    const float* g1 = p.ln1_g + l * DM; const float* b1 = p.ln1_b + l * DM;
    const float* rw = p.rwT + (size_t)l * NE * 1024; const float* rb = p.router_b + l * NE;
    unsigned* gcount = p.ctrl + 64 + l * NE;
    for (int grp = blockIdx.x; grp < NTOK / 128; grp += gridDim.x) {
        const int tok0 = grp * 128 + wid * 16;
        if (tid < 32) lcnt[tid] = 0;
        float4 gg[4], bb[4];
#pragma unroll
        for (int j = 0; j < 4; ++j) { gg[j] = *(const float4*)(g1 + j * 256 + lane * 4); bb[j] = *(const float4*)(b1 + j * 256 + lane * 4); }
        for (int r0 = 0; r0 < 16; r0 += 4) {
            float4 v[4][4]; float s[4], qv[4];
#pragma unroll
            for (int i = 0; i < 4; ++i)
#pragma unroll
                for (int j = 0; j < 4; ++j) v[i][j] = *(const float4*)(p.tbuf + (size_t)(tok0 + r0 + i) * DM + j * 256 + lane * 4);
#pragma unroll
            for (int i = 0; i < 4; ++i) { s[i] = 0.f;
#pragma unroll
                for (int j = 0; j < 4; ++j) s[i] += (v[i][j].x + v[i][j].y) + (v[i][j].z + v[i][j].w); }
#pragma unroll
            for (int o = 32; o > 0; o >>= 1) {
#pragma unroll
                for (int i = 0; i < 4; ++i) s[i] += __shfl_xor(s[i], o); }
#pragma unroll
            for (int i = 0; i < 4; ++i) { const float mean = s[i] * (1.0f / 1024.0f); qv[i] = 0.f;
#pragma unroll
                for (int j = 0; j < 4; ++j) { v[i][j].x -= mean; v[i][j].y -= mean; v[i][j].z -= mean; v[i][j].w -= mean; qv[i] += (v[i][j].x * v[i][j].x + v[i][j].y * v[i][j].y) + (v[i][j].z * v[i][j].z + v[i][j].w * v[i][j].w); } }
#pragma unroll
            for (int o = 32; o > 0; o >>= 1) {
#pragma unroll
                for (int i = 0; i < 4; ++i) qv[i] += __shfl_xor(qv[i], o); }
#pragma unroll
            for (int i = 0; i < 4; ++i) {
                const float rstd = rsqrtf(qv[i] * (1.0f / 1024.0f) + LN_EPS);
                const size_t row = (size_t)(tok0 + r0 + i);
#pragma unroll
                for (int j = 0; j < 4; ++j) {
                    const int c = j * 256 + lane * 4;
                    float4 y; y.x = v[i][j].x * rstd * gg[j].x + bb[j].x; y.y = v[i][j].y * rstd * gg[j].y + bb[j].y; y.z = v[i][j].z * rstd * gg[j].z + bb[j].z; y.w = v[i][j].w * rstd * gg[j].w + bb[j].w;
                    *(float4*)(p.x1f + row * DM + c) = y;
                    *(unsigned*)((char*)p.x1b + row * DM + c) = pack4_fp8(y.x, y.y, y.z, y.w);
                }
            }
        }
        __syncthreads();
        f32x4 a0 = (f32x4){0.f, 0.f, 0.f, 0.f}, a1 = a0;
        const float* xr = p.x1f + (size_t)(tok0 + fr) * DM + 4 * fq;
        const float* w0 = rw + (size_t)fr * 1024 + 4 * fq; const float* w1 = rw + (size_t)(16 + fr) * 1024 + 4 * fq;
#pragma unroll 4
        for (int k0 = 0; k0 < 1024; k0 += 16) {
            const float4 xa = *(const float4*)(xr + k0), wb0 = *(const float4*)(w0 + k0), wb1 = *(const float4*)(w1 + k0);
            a0 = __builtin_amdgcn_mfma_f32_16x16x4f32(xa.x, wb0.x, a0, 0, 0, 0); a1 = __builtin_amdgcn_mfma_f32_16x16x4f32(xa.x, wb1.x, a1, 0, 0, 0);
            a0 = __builtin_amdgcn_mfma_f32_16x16x4f32(xa.y, wb0.y, a0, 0, 0, 0); a1 = __builtin_amdgcn_mfma_f32_16x16x4f32(xa.y, wb1.y, a1, 0, 0, 0);
            a0 = __builtin_amdgcn_mfma_f32_16x16x4f32(xa.z, wb0.z, a0, 0, 0, 0); a1 = __builtin_amdgcn_mfma_f32_16x16x4f32(xa.z, wb1.z, a1, 0, 0, 0);
            a0 = __builtin_amdgcn_mfma_f32_16x16x4f32(xa.w, wb0.w, a0, 0, 0, 0); a1 = __builtin_amdgcn_mfma_f32_16x16x4f32(xa.w, wb1.w, a1, 0, 0, 0);
        }
#pragma unroll
        for (int r = 0; r < 4; ++r) { lg[(fq * 4 + r) * 32 + fr] = a0[r] + rb[fr]; lg[(fq * 4 + r) * 32 + 16 + fr] = a1[r] + rb[16 + fr]; }
        lds_wave_sync();
        int e4[4] = {0, 0, 0, 0}; int rk[4] = {0, 0, 0, 0};
        if (lane < 16) {
            const float* my = lg + lane * 32; unsigned taken = 0u; float tv[4];
#pragma unroll
            for (int k = 0; k < 4; ++k) {
                float best = NEG_INF; int bi = 0;
                for (int e = 0; e < 32; ++e) { const float xv = my[e]; if (!((taken >> e) & 1u) && xv > best) { best = xv; bi = e; } }
                taken |= 1u << bi; e4[k] = bi; tv[k] = best;
            }
            const float e1 = __expf(tv[1] - tv[0]), e2 = __expf(tv[2] - tv[0]), e3 = __expf(tv[3] - tv[0]);
            const float inv = 1.0f / (1.0f + e1 + e2 + e3);
            const size_t row = (size_t)(tok0 + lane);
            *(float4*)(p.gw + row * 4) = make_float4(inv, e1 * inv, e2 * inv, e3 * inv);
        }
        __syncthreads();
        if (lane < 16) {
#pragma unroll
            for (int k = 0; k < 4; ++k) rk[k] = atomicAdd(&lcnt[e4[k]], 1);
        }
        __syncthreads();
        if (tid < 32) { const int c = lcnt[tid]; lbase[tid] = c ? (int)__hip_atomic_fetch_add(gcount + tid, (unsigned)c, __ATOMIC_RELAXED, __HIP_MEMORY_SCOPE_AGENT) : 0; }
        __syncthreads();
        if (lane < 16) {
            const int row = tok0 + lane; int pk[4];
#pragma unroll
            for (int k = 0; k < 4; ++k) { const int pos = lbase[e4[k]] + rk[k]; p.lists[(size_t)e4[k] * LIST_CAP + pos] = row * 4 + k; pk[k] = (pos << 5) | e4[k]; }
            *(int4*)(p.top_e + (size_t)row * 4) = make_int4(pk[0], pk[1], pk[2], pk[3]);
        }
        __syncthreads();
    }
}

__device__ __forceinline__ void phase_ln2(const Params& p, int l, float* xout, char* lds) {
    int* ptile = (int*)(lds + LDS_TAB); int* ecnt = ptile + 40;
    build_tiles(p, l, ptile, ecnt);
    int tid = threadIdx.x; asm volatile("" : "+v"(tid));
    const int wid = tid >> 6, lane = tid & 63;
    const float* g2 = p.ln2_g + l * DM; const float* b2 = p.ln2_b + l * DM;
    float4 gg[4], bb[4];
#pragma unroll
    for (int j = 0; j < 4; ++j) { gg[j] = *(const float4*)(g2 + j * 256 + lane * 4); bb[j] = *(const float4*)(b2 + j * 256 + lane * 4); }
    for (int pr = blockIdx.x * NWV + wid; pr < NTOK / 2; pr += gridDim.x * NWV) {
        float4 v[2][4]; float s[2], qv[2];
        u32x2 yv[2][4][4]; float gk[2][4];
#pragma unroll
        for (int i = 0; i < 2; ++i) {
            const int row = pr * 2 + i;
            const float4 gwv = *(const float4*)(p.gw + (size_t)row * 4);
            gk[i][0] = gwv.x; gk[i][1] = gwv.y; gk[i][2] = gwv.z; gk[i][3] = gwv.w;
            const int4 te = *(const int4*)(p.top_e + (size_t)row * 4);
            const int tk[4] = {te.x, te.y, te.z, te.w};
#pragma unroll
            for (int j = 0; j < 4; ++j) v[i][j] = *(const float4*)(p.x1f + (size_t)row * DM + j * 256 + lane * 4);
#pragma unroll
            for (int k = 0; k < 4; ++k) {
                const bf16_t* yr = p.ybuf + (size_t)(ptile[tk[k] & 31] * 256 + (tk[k] >> 5)) * DM + lane * 4;
#pragma unroll
                for (int j = 0; j < 4; ++j) yv[i][k][j] = *(const u32x2*)(yr + j * 256);
            }
        }
#pragma unroll
        for (int i = 0; i < 2; ++i) { s[i] = 0.f;
#pragma unroll
            for (int j = 0; j < 4; ++j) {
                float4 a; a.x = v[i][j].x * ALPHA; a.y = v[i][j].y * ALPHA; a.z = v[i][j].z * ALPHA; a.w = v[i][j].w * ALPHA;
#pragma unroll
                for (int k = 0; k < 4; ++k) {
                    const u32x2 w = yv[i][k][j];
                    a.x += gk[i][k] * __uint_as_float(w.x << 16); a.y += gk[i][k] * __uint_as_float(w.x & 0xffff0000u);
                    a.z += gk[i][k] * __uint_as_float(w.y << 16); a.w += gk[i][k] * __uint_as_float(w.y & 0xffff0000u);
                }
                v[i][j] = a; s[i] += (a.x + a.y) + (a.z + a.w);
            } }
#pragma unroll
        for (int o = 32; o > 0; o >>= 1) { s[0] += __shfl_xor(s[0], o); s[1] += __shfl_xor(s[1], o); }
#pragma unroll
        for (int i = 0; i < 2; ++i) { const float mean = s[i] * (1.0f / 1024.0f); qv[i] = 0.f;
#pragma unroll
            for (int j = 0; j < 4; ++j) { v[i][j].x -= mean; v[i][j].y -= mean; v[i][j].z -= mean; v[i][j].w -= mean; qv[i] += (v[i][j].x * v[i][j].x + v[i][j].y * v[i][j].y) + (v[i][j].z * v[i][j].z + v[i][j].w * v[i][j].w); } }
#pragma unroll
        for (int o = 32; o > 0; o >>= 1) { qv[0] += __shfl_xor(qv[0], o); qv[1] += __shfl_xor(qv[1], o); }
#pragma unroll
        for (int i = 0; i < 2; ++i) {
            const float rstd = rsqrtf(qv[i] * (1.0f / 1024.0f) + LN_EPS);
            const size_t row = (size_t)(pr * 2 + i);
#pragma unroll
            for (int j = 0; j < 4; ++j) {
                const int c = j * 256 + lane * 4;
                float4 y; y.x = v[i][j].x * rstd * gg[j].x + bb[j].x; y.y = v[i][j].y * rstd * gg[j].y + bb[j].y; y.z = v[i][j].z * rstd * gg[j].z + bb[j].z; y.w = v[i][j].w * rstd * gg[j].w + bb[j].w;
                *(float4*)(xout + row * DM + c) = y;
                u32x2 w; w.x = pack2(y.x, y.y); w.y = pack2(y.z, y.w);
                *(u32x2*)(p.xb + row * DM + c) = w;
            }
        }
    }
}

#define XB_TMO      128
#define XB_XCNT(j)  (256  + 64 * (j))
#define XB_XSUB(j)  (1280 + 64 * (j))
#define XB_XGEN(j)  (2304 + 64 * (j))
#define XB_TOP      3328
#define XB_TOPGEN   3392
#define XCD_BAR_WORDS 3456
#define XB_SPIN_CAP (1u << 22)
__device__ __forceinline__ unsigned xb_ld(unsigned* p)              { return __hip_atomic_load(p, __ATOMIC_RELAXED, __HIP_MEMORY_SCOPE_AGENT); }
__device__ __forceinline__ unsigned xb_add(unsigned* p, unsigned v) { return __hip_atomic_fetch_add(p, v, __ATOMIC_RELAXED, __HIP_MEMORY_SCOPE_AGENT); }
__device__ __forceinline__ unsigned xb_xcc_id() { return (unsigned)__builtin_amdgcn_s_getreg((3 << 11) | 20) & 0xFu; }
#define XB_SPIN(cond, bar) do { unsigned _sp = 0; while (cond) { __builtin_amdgcn_s_sleep(1); \
    if ((++_sp & 255u) == 0u) { if (xb_ld(&(bar)[XB_TMO])) break; if (_sp > XB_SPIN_CAP) { atomicAdd(&(bar)[XB_TMO], 1u); break; } } } } while (0)
struct XcdBarrier { unsigned* bar; unsigned x; volatile LAS unsigned* st; };
__device__ __forceinline__ XcdBarrier xcd_barrier_post(unsigned* bar, volatile LAS unsigned* st) {
    XcdBarrier b; b.bar = bar; b.x = xb_xcc_id(); b.st = st;
    if (threadIdx.x == 0) (void)xb_add(&bar[XB_XCNT(b.x)], 1u);
    return b;
}
__device__ __forceinline__ void xcd_barrier_complete(unsigned* bar, unsigned x, unsigned& nloc, unsigned& nx) {
    const unsigned G = gridDim.x * gridDim.y * gridDim.z;
    unsigned sum, cnt, mine, sp = 0u;
    for (;;) {
        sum = 0u; cnt = 0u; mine = 0u;
#pragma unroll
        for (unsigned j = 0; j < 16; ++j) { const unsigned c = xb_ld(&bar[XB_XCNT(j)]); sum += c; cnt += (c > 0u) ? 1u : 0u; mine = (j == x) ? c : mine; }
        if (sum == G) break;
        __builtin_amdgcn_s_sleep(1);
        if ((++sp & 255u) == 0u) { if (xb_ld(&bar[XB_TMO])) break; if (sp > XB_SPIN_CAP) { atomicAdd(&bar[XB_TMO], 1u); break; } }
    }
    nloc = mine > 0u ? mine : 1u; nx = cnt > 0u ? cnt : 1u;
}
__device__ __forceinline__ void xcd_barrier(const XcdBarrier& b) {
    asm volatile("s_waitcnt vmcnt(0)" ::: "memory");
    __syncthreads();
    if (threadIdx.x == 0) {
        unsigned* bar = b.bar;
        __builtin_amdgcn_s_waitcnt(0);
        unsigned nloc = b.st[0], nx = b.st[1];
        if (nloc == 0u) { xcd_barrier_complete(bar, b.x, nloc, nx); b.st[0] = nloc; b.st[1] = nx; }
        const unsigned old = xb_add(&bar[XB_XSUB(b.x)], 1u);
        const unsigned gen = old / nloc;
        if (old + 1u == (gen + 1u) * nloc) {
            __builtin_amdgcn_fence(__ATOMIC_RELEASE, "agent");
            asm volatile("s_waitcnt vmcnt(0)" ::: "memory");
            const unsigned og = xb_add(&bar[XB_TOP], 1u);
            const unsigned tg = og / nx;
            if (og + 1u == (tg + 1u) * nx) xb_add(&bar[XB_TOPGEN], 1u);
            else XB_SPIN(xb_ld(&bar[XB_TOPGEN]) == tg, bar);
            __builtin_amdgcn_fence(__ATOMIC_ACQUIRE, "agent");
            xb_add(&bar[XB_XGEN(b.x)], 1u);
            asm volatile("s_waitcnt vmcnt(0)" ::: "memory");
        } else {
            XB_SPIN(xb_ld(&bar[XB_XGEN(b.x)]) == gen, bar);
            __builtin_amdgcn_fence(__ATOMIC_ACQUIRE, "agent");
            asm volatile("s_waitcnt vmcnt(0)" ::: "memory");
        }
    }
    __syncthreads();
}

struct KArgs { const float* in[18]; float* out; char* ws; };
constexpr size_t al256(size_t v) { return (v + 255) / 256 * 256; }
struct WSL {
    static constexpr size_t ctrl = 0;
    static constexpr size_t WinT = al256(ctrl + 65536);
    static constexpr size_t WoT = al256(WinT + (size_t)NL * NPAD * 1024 * 2);
    static constexpr size_t W1T = al256(WoT + (size_t)NL * 1024 * 1024 * 2);
    static constexpr size_t W2T = al256(W1T + (size_t)NL * 2 * 64 * 2048 * 2);
    static constexpr size_t WguT = al256(W2T + (size_t)NL * 2 * 64 * 64 * 2);
    static constexpr size_t WdnT = al256(WguT + (size_t)NL * NE * 2048 * 1024 * 2);
    static constexpr size_t rwT = al256(WdnT + (size_t)NL * NE * 1024 * 1024 * 2);
    static constexpr size_t binp = al256(rwT + (size_t)NL * NE * 1024 * 4);
    static constexpr size_t bgup = al256(binp + (size_t)NL * NPAD * 4);
    static constexpr size_t b1c = al256(bgup + (size_t)NL * NE * 2048 * 4);
    static constexpr size_t xf = al256(b1c + 4 * 64 * 4);
    static constexpr size_t xb = al256(xf + (size_t)NTOK * DM * 4);
    static constexpr size_t hb = al256(xb + (size_t)NTOK * DM * 2);
    static constexpr size_t hs = al256(hb + (size_t)NTOK * NMAIN * 2);
    static constexpr size_t vT = al256(hs + (size_t)NTOK * HS_W * 4);
    static constexpr size_t kF = al256(vT + (size_t)NB * NVH * 64 * SEQ * 2);
    static constexpr size_t cF = al256(kF + (size_t)NB * NVH * 64 * SEQ * 2);
    static constexpr size_t kc = al256(cF + (size_t)NB * 4 * SEQ * 4);
    static constexpr size_t vc = al256(kc + (size_t)NB * 2 * 128 * 64 * 2);
    static constexpr size_t vcT = al256(vc + (size_t)NB * 2 * 128 * 64 * 2);
    static constexpr size_t ob = al256(vcT + (size_t)NB * 2 * 128 * 64 * 2);
    static constexpr size_t tbuf = al256(ob + (size_t)NTOK * DM * 2);
    static constexpr size_t x1f = al256(tbuf + (size_t)NTOK * DM * 4);
    static constexpr size_t x1b = al256(x1f + (size_t)NTOK * DM * 4);
    static constexpr size_t top_e = al256(x1b + (size_t)NTOK * DM * 2);
    static constexpr size_t gw = al256(top_e + (size_t)NTOK * 4 * 4);
    static constexpr size_t lists = al256(gw + (size_t)NTOK * 4 * 4);
    static constexpr size_t act = al256(lists + (size_t)NE * LIST_CAP * 4);
    static constexpr size_t ybuf = al256(act + (size_t)MAXSLOT * DFF * 2);
    static constexpr size_t total = al256(ybuf + (size_t)MAXSLOT * DM * 2);
};
__device__ __forceinline__ Params make_params(const KArgs& k) {
    Params p;
    p.x = k.in[0]; p.w_in = k.in[1]; p.b_in = k.in[2]; p.sinks = k.in[3]; p.cmp_pe = k.in[4]; p.cmp_w1 = k.in[5]; p.cmp_w2 = k.in[6]; p.w_out = k.in[7];
    p.ln1_g = k.in[8]; p.ln1_b = k.in[9]; p.router_w = k.in[10]; p.router_b = k.in[11]; p.w_gu = k.in[12]; p.b_gu = k.in[13]; p.w_dn = k.in[14]; p.b_dn = k.in[15];
    p.ln2_g = k.in[16]; p.ln2_b = k.in[17]; p.out = k.out;
    char* w = k.ws;
    p.ctrl = (unsigned*)(w + WSL::ctrl); p.WinT = (bf16_t*)(w + WSL::WinT); p.WoT = (bf16_t*)(w + WSL::WoT); p.W1T = (bf16_t*)(w + WSL::W1T); p.W2T = (bf16_t*)(w + WSL::W2T);
    p.WguT = (bf16_t*)(w + WSL::WguT); p.WdnT = (bf16_t*)(w + WSL::WdnT); p.rwT = (float*)(w + WSL::rwT); p.binp = (float*)(w + WSL::binp); p.bgup = (float*)(w + WSL::bgup);
    p.b1c = (float*)(w + WSL::b1c); p.xf = (float*)(w + WSL::xf); p.xb = (bf16_t*)(w + WSL::xb); p.hb = (bf16_t*)(w + WSL::hb); p.hs = (float*)(w + WSL::hs); p.vT = (bf16_t*)(w + WSL::vT); p.kF = (bf16_t*)(w + WSL::kF);
    p.cF = (float*)(w + WSL::cF); p.kc = (bf16_t*)(w + WSL::kc); p.vc = (bf16_t*)(w + WSL::vc); p.vcT = (bf16_t*)(w + WSL::vcT); p.ob = (bf16_t*)(w + WSL::ob); p.tbuf = (float*)(w + WSL::tbuf);
    p.x1f = (float*)(w + WSL::x1f); p.x1b = (bf16_t*)(w + WSL::x1b); p.top_e = (int*)(w + WSL::top_e); p.gw = (float*)(w + WSL::gw); p.lists = (int*)(w + WSL::lists);
    p.act = (bf16_t*)(w + WSL::act); p.ybuf = (bf16_t*)(w + WSL::ybuf);
    return p;
}
__device__ __forceinline__ void grid_bar(const Params& p, char* lds) {
    XcdBarrier xb; xb.bar = p.ctrl + 1024; xb.x = xb_xcc_id(); xb.st = (volatile LAS unsigned*)(lds + LDS_BYTES - 16); xcd_barrier(xb);
}
template <int L>
__device__ __forceinline__ void layer_fwd(const Params& p, char* lds) {
    const float* xin = L == 0 ? p.x : p.xf;
    float* xout = L == NL - 1 ? p.out : p.xf;
#ifndef REP
#define REP 0
#endif
    phase_inproj(p, L, lds);        grid_bar(p, lds);
    if (REP & 1) { phase_inproj(p, L, lds);        grid_bar(p, lds); }
    phase_prep(p, L, lds);          grid_bar(p, lds);
    if (REP & 2) { phase_prep(p, L, lds);          grid_bar(p, lds); }
    phase_attn<L == 0>(p, L, lds);  grid_bar(p, lds);
    if (REP & 4) { phase_attn<false>(p, L, lds, 24); grid_bar(p, lds); }
    phase_outproj(p, L, xin, lds);  grid_bar(p, lds);
    if (REP & 8) { phase_outproj(p, L, xin, lds);  grid_bar(p, lds); }
    phase_ln1_router(p, L, lds);    grid_bar(p, lds);
    phase_gateup(p, L, lds);        grid_bar(p, lds);
    if (REP & 16) { phase_gateup(p, L, lds);       grid_bar(p, lds); }
    phase_down(p, L, lds);          grid_bar(p, lds);
    if (REP & 32) { phase_down(p, L, lds);         grid_bar(p, lds); }
    phase_ln2(p, L, xout, lds);
    if (REP & 64) { grid_bar(p, lds); phase_ln2(p, L, xout, lds); }
}
__global__ void __launch_bounds__(NTHR, 2) fwd_kernel(KArgs ka) {
    extern __shared__ __attribute__((aligned(16))) char lds[];
    const Params p = make_params(ka);
    cg::grid_group grid = cg::this_grid();
    volatile LAS unsigned* xst = (volatile LAS unsigned*)(lds + LDS_BYTES - 16);
    if (threadIdx.x == 0) { xst[0] = 0u; xst[1] = 0u; }
    __syncthreads();
    (void)xcd_barrier_post(p.ctrl + 1024, xst);
    phase0(p, lds);
    if (REP & 128) { grid_bar(p, lds); phase0(p, lds); }
    grid.sync();
    layer_fwd<0>(p, lds);
    grid_bar(p, lds);
    layer_fwd<1>(p, lds);
}

extern "C" void kernel_launch(void* const* d_in, const int* in_sizes, int n_in, void* d_out, int out_size, void* d_ws, size_t ws_size, hipStream_t stream) {
    KArgs ka{};
    for (int i = 0; i < 18; ++i) ka.in[i] = (const float*)d_in[i];
    ka.out = (float*)d_out; ka.ws = (char*)d_ws;
    if (WSL::total > ws_size) { fprintf(stderr, "workspace too small: need %zu have %zu\n", (size_t)WSL::total, ws_size); return; }
    static int grid_blocks = 0;
    if (!grid_blocks) {
        int dev = 0, cus = 0, per_cu = 0;
        (void)hipGetDevice(&dev);
        (void)hipDeviceGetAttribute(&cus, hipDeviceAttributeMultiprocessorCount, dev);
        (void)hipFuncSetAttribute((const void*)fwd_kernel, hipFuncAttributeMaxDynamicSharedMemorySize, LDS_BYTES);
        (void)hipOccupancyMaxActiveBlocksPerMultiprocessor(&per_cu, fwd_kernel, NTHR, LDS_BYTES);
        if (per_cu < 1) { fprintf(stderr, "occupancy query says 0 blocks per CU\n"); per_cu = 1; }
        grid_blocks = cus;
    }
    (void)hipMemsetAsync(d_ws, 0, 65536, stream);
    void* args[] = {&ka};
    hipError_t e = hipLaunchCooperativeKernel((const void*)fwd_kernel, dim3(grid_blocks), dim3(NTHR), args, LDS_BYTES, stream);
    if (e != hipSuccess) fprintf(stderr, "cooperative launch failed: %s (grid %d)\n", hipGetErrorString(e), grid_blocks);
}
```

```cpp
#include <hip/hip_runtime.h>
#include <hip/hip_cooperative_groups.h>
#include <cstdio>
#include <cstdint>
namespace cg = cooperative_groups;

typedef unsigned short bf16_t;
typedef short bf16x8 __attribute__((ext_vector_type(8)));
typedef float f32x4 __attribute__((ext_vector_type(4)));
typedef unsigned u32x4 __attribute__((ext_vector_type(4)));
typedef unsigned u32x2 __attribute__((ext_vector_type(2)));
typedef int v8i_t __attribute__((ext_vector_type(8)));
typedef int v4i_t __attribute__((ext_vector_type(4)));
#define LAS __attribute__((address_space(3)))
constexpr float NEG_INF = -__builtin_huge_valf();

constexpr int DM = 1024, NB = 16, SEQ = 2048, NTOK = NB * SEQ, NL = 2;
constexpr int NCOL = 2582, NMAIN = 2560, NPAD = 2688, NE = 32, DFF = 1024;
constexpr int C_FQ = 0, C_FK = 256, C_FV = 512, C_SQ = 768, C_SK = 1152, C_SV = 1280, C_NQ = 1408,
              C_NKC = 1792, C_NVC = 1920, C_NKS = 2048, C_NVS = 2176, C_NKW = 2304, C_NVW = 2432;
constexpr int HS_W = 32;
constexpr int NVH = 10;
constexpr int LIST_CAP = NTOK;
constexpr int MAXSLOT = NTOK * 4 + NE * 256;
constexpr float ALPHA = 1.41421356237f, LN_EPS = 1e-5f, QSCALE = 0.125f;
constexpr int NWV = 8, NTHR = NWV * 64;
constexpr int LDS_STAGE = 131072, LDS_TAB = LDS_STAGE, LDS_AOFF = LDS_STAGE + 2048, LDS_BYTES = LDS_AOFF + 20480 + 256;

struct Params {
    const float *x, *w_in, *b_in, *sinks, *cmp_pe, *cmp_w1, *cmp_w2, *w_out, *ln1_g, *ln1_b, *router_w, *router_b,
                *w_gu, *b_gu, *w_dn, *b_dn, *ln2_g, *ln2_b;
    float* out;
    unsigned* ctrl;
    bf16_t *WinT, *WoT, *W1T, *W2T, *WguT, *WdnT;
    float *rwT, *binp, *bgup, *b1c;
    float* xf; bf16_t* xb; bf16_t* hb; float* hs; bf16_t* vT; bf16_t* kF; float* cF;
    bf16_t *kc, *vc, *vcT; bf16_t* ob; float* tbuf; float* x1f; bf16_t* x1b;
    int* top_e; float* gw; int* lists; bf16_t* act; bf16_t* ybuf;
};

__device__ __forceinline__ float bf2f(bf16_t h) { return __uint_as_float(((unsigned)h) << 16); }
typedef __bf16 bf16x2_t __attribute__((ext_vector_type(2)));
__device__ __forceinline__ bf16_t f2bf(float f) { return __builtin_bit_cast(bf16_t, (__bf16)f); }
__device__ __forceinline__ unsigned pack2(float lo, float hi) { bf16x2_t v = {(__bf16)lo, (__bf16)hi}; return __builtin_bit_cast(unsigned, v); }
__device__ __forceinline__ unsigned pack4_fp8(float a, float b, float c, float d) {
    unsigned w = 0u;
    w = __builtin_amdgcn_cvt_pk_fp8_f32(a, b, w, false);
    w = __builtin_amdgcn_cvt_pk_fp8_f32(c, d, w, true);
    return w;
}
__device__ __forceinline__ float wave_sum(float v) {
#pragma unroll
    for (int o = 32; o > 0; o >>= 1) v += __shfl_xor(v, o);
    return v;
}
__device__ __forceinline__ float wave_max(float v) {
#pragma unroll
    for (int o = 32; o > 0; o >>= 1) v = fmaxf(v, __shfl_xor(v, o));
    return v;
}
__device__ __forceinline__ void lds_wave_sync() { asm volatile("s_waitcnt lgkmcnt(0)" ::: "memory"); __builtin_amdgcn_wave_barrier(); }
__device__ __forceinline__ float slope_swa(int hq) { return exp2f(-8.0f * (float)(2 * hq + 1) / 12.0f); }
__device__ __forceinline__ float slope_nsa(int hq) { return exp2f(-8.0f * (float)(2 * hq + 2) / 12.0f); }

__device__ __forceinline__ int perm_row(int perm, int n) {
    if (perm == 1) { if (n < 768) return n; if (n < 772) return 2560 + (n - 768); if (n < 2564) return n - 4; return n; }
    if (perm == 2) { const int f = n >> 1, s = n & 1; return (f >> 7) * 256 + s * 128 + (f & 127); }
    return n;
}
struct ConvJob { const float* src; bf16_t* dst; int K, N, kt, nt, perm; float q8; };
__device__ __forceinline__ bool conv_job(const Params& p, int t, ConvJob& jb) {
    constexpr int T_WIN = NL * 8 * 21, T_WO = NL * 8 * 8;
    if (t < T_WIN) { const int m = t / 168, r = t % 168; jb = ConvJob{p.w_in + (size_t)m * 1024 * NCOL, p.WinT + (size_t)m * NPAD * 1024, 1024, NCOL, r / 21, r % 21, 1, 0.f}; return true; }
    t -= T_WIN;
    if (t < T_WO) { const int m = t / 64, r = t % 64; jb = ConvJob{p.w_out + (size_t)m * 1024 * 1024, p.WoT + (size_t)m * 1024 * 1024, 1024, 1024, r / 8, r % 8, 0, 0.f}; return true; }
    return false;
}
constexpr int CONV_TILES = NL * NE * 192;
__device__ __forceinline__ void conv_tile_wave(const Params& p, int t, int lane, unsigned char* l8) {
    asm volatile("" : "+v"(lane));
    const int m = t / 192, r = t % 192;
    const float* src; unsigned char* dst; int N, kt, nt, perm;
    if (r < 128) { src = p.w_gu + (size_t)m * 1024 * 2048; dst = (unsigned char*)p.WguT + (size_t)m * 2048 * 1024; N = 2048; kt = r >> 4; nt = r & 15; perm = 2; }
    else { const int q = r - 128; src = p.w_dn + (size_t)m * 1024 * 1024; dst = (unsigned char*)p.WdnT + (size_t)m * 1024 * 1024; N = 1024; kt = q >> 3; nt = q & 7; perm = 0; }
    const float* s = src + (size_t)(kt * 128 + (lane >> 5)) * N + nt * 128 + (lane & 31) * 4;
    unsigned char* lw = l8 + (lane >> 5) * 132 + (lane & 31) * 4;
    float4 va[16], vb[16];
#pragma unroll
    for (int i = 0; i < 16; ++i) va[i] = *(const float4*)(s + (size_t)(2 * i) * N);
#pragma unroll
    for (int i = 0; i < 16; ++i) vb[i] = *(const float4*)(s + (size_t)(32 + 2 * i) * N);
#pragma unroll
    for (int i = 0; i < 16; ++i) *(unsigned*)(lw + (2 * i) * 132) = pack4_fp8(va[i].x * 64.0f, va[i].y * 64.0f, va[i].z * 64.0f, va[i].w * 64.0f);
#pragma unroll
    for (int i = 0; i < 16; ++i) va[i] = *(const float4*)(s + (size_t)(64 + 2 * i) * N);
#pragma unroll
    for (int i = 0; i < 16; ++i) *(unsigned*)(lw + (32 + 2 * i) * 132) = pack4_fp8(vb[i].x * 64.0f, vb[i].y * 64.0f, vb[i].z * 64.0f, vb[i].w * 64.0f);
#pragma unroll
    for (int i = 0; i < 16; ++i) vb[i] = *(const float4*)(s + (size_t)(96 + 2 * i) * N);
#pragma unroll
    for (int i = 0; i < 16; ++i) *(unsigned*)(lw + (64 + 2 * i) * 132) = pack4_fp8(va[i].x * 64.0f, va[i].y * 64.0f, va[i].z * 64.0f, va[i].w * 64.0f);
#pragma unroll
    for (int i = 0; i < 16; ++i) *(unsigned*)(lw + (96 + 2 * i) * 132) = pack4_fp8(vb[i].x * 64.0f, vb[i].y * 64.0f, vb[i].z * 64.0f, vb[i].w * 64.0f);
    lds_wave_sync();
#pragma unroll 4
    for (int i = 0; i < 16; ++i) {
        const int idx = lane + 64 * i, kc = idx & 7, nn = idx >> 3;
        const unsigned char* l = l8 + (kc * 16) * 132 + nn;
        u32x4 w;
        w.x = (unsigned)l[0] | ((unsigned)l[132] << 8) | ((unsigned)l[264] << 16) | ((unsigned)l[396] << 24);
        w.y = (unsigned)l[528] | ((unsigned)l[660] << 8) | ((unsigned)l[792] << 16) | ((unsigned)l[924] << 24);
        w.z = (unsigned)l[1056] | ((unsigned)l[1188] << 8) | ((unsigned)l[1320] << 16) | ((unsigned)l[1452] << 24);
        w.w = (unsigned)l[1584] | ((unsigned)l[1716] << 8) | ((unsigned)l[1848] << 16) | ((unsigned)l[1980] << 24);
        *(u32x4*)(dst + (size_t)perm_row(perm, nt * 128 + nn) * 1024 + kt * 128 + kc * 16) = w;
    }
    lds_wave_sync();
}
__device__ __forceinline__ void conv_load(const ConvJob& jb, int tid, float2 (&v)[16]) {
    const int n = jb.nt * 128 + (tid & 31) * 4;
    const float* s = jb.src + (size_t)(jb.kt * 128 + (tid >> 5)) * jb.N + n;
#pragma unroll
    for (int i = 0; i < 8; ++i) {
        const float* r = s + (size_t)(16 * i) * jb.N;
        v[2 * i] = (n + 1 < jb.N) ? *(const float2*)r : make_float2(0.f, 0.f);
        v[2 * i + 1] = (n + 3 < jb.N) ? *(const float2*)(r + 2) : make_float2(0.f, 0.f);
    }
}
__device__ __forceinline__ void phase0(const Params& p, char* ldsc) {
    int tid = threadIdx.x; asm volatile("" : "+v"(tid));
    const int G = gridDim.x, bid = blockIdx.x;
    const size_t gtid = (size_t)bid * NTHR + tid, gthreads = (size_t)G * NTHR;
    {
        constexpr int TOT = NL * 8 * 21 + NL * 8 * 8;
        bf16_t* lt = (bf16_t*)ldsc;
        ConvJob jb, jn; float2 v[16], vn[16];
        int t = bid; bool have = t < TOT && conv_job(p, t, jb);
        if (have) conv_load(jb, tid, v);
        while (have) {
            const int tn = t + G; const bool hn = tn < TOT && conv_job(p, tn, jn);
            if (hn) conv_load(jn, tid, vn);
            if (jb.q8 != 0.f) {
                unsigned char* l8 = (unsigned char*)lt;
#pragma unroll
                for (int i = 0; i < 8; ++i)
                    *(unsigned*)(l8 + ((tid >> 5) + 16 * i) * 132 + (tid & 31) * 4) = pack4_fp8(v[2 * i].x * jb.q8, v[2 * i].y * jb.q8, v[2 * i + 1].x * jb.q8, v[2 * i + 1].y * jb.q8);
                __syncthreads();
#pragma unroll
                for (int i = 0; i < 2; ++i) {
                    const int idx = tid + NTHR * i, kc = idx & 7, nn = idx >> 3, n = jb.nt * 128 + nn;
                    const unsigned char* l = l8 + (kc * 16) * 132 + nn;
                    u32x4 w;
                    w.x = (unsigned)l[0] | ((unsigned)l[132] << 8) | ((unsigned)l[264] << 16) | ((unsigned)l[396] << 24);
                    w.y = (unsigned)l[528] | ((unsigned)l[660] << 8) | ((unsigned)l[792] << 16) | ((unsigned)l[924] << 24);
                    w.z = (unsigned)l[1056] | ((unsigned)l[1188] << 8) | ((unsigned)l[1320] << 16) | ((unsigned)l[1452] << 24);
                    w.w = (unsigned)l[1584] | ((unsigned)l[1716] << 8) | ((unsigned)l[1848] << 16) | ((unsigned)l[1980] << 24);
                    *(u32x4*)((char*)jb.dst + (size_t)perm_row(jb.perm, n) * jb.K + jb.kt * 128 + kc * 16) = w;
                }
            } else {
#pragma unroll
                for (int i = 0; i < 8; ++i) {
                    u32x2 w; w.x = pack2(v[2 * i].x, v[2 * i].y); w.y = pack2(v[2 * i + 1].x, v[2 * i + 1].y);
                    *(u32x2*)(lt + ((tid >> 5) + 16 * i) * 136 + (tid & 31) * 4) = w;
                }
                __syncthreads();
#pragma unroll
                for (int i = 0; i < 4; ++i) {
                    const int idx = tid + NTHR * i, kc = idx & 15, nn = idx >> 4, n = jb.nt * 128 + nn;
                    if (n < jb.N) {
                        const bf16_t* l = lt + (kc * 8) * 136 + nn;
                        u32x4 w;
                        w.x = (unsigned)l[0] | ((unsigned)l[136] << 16); w.y = (unsigned)l[272] | ((unsigned)l[408] << 16);
                        w.z = (unsigned)l[544] | ((unsigned)l[680] << 16); w.w = (unsigned)l[816] | ((unsigned)l[952] << 16);
                        *(u32x4*)(jb.dst + (size_t)perm_row(jb.perm, n) * jb.K + jb.kt * 128 + kc * 8) = w;
                    }
                }
            }
            __syncthreads();
            t = tn; have = hn; jb = jn;
#pragma unroll
            for (int i = 0; i < 16; ++i) v[i] = vn[i];
        }
    }
    for (size_t i = gtid; i < (size_t)NL * 2 * 2048 * 64; i += gthreads) {
        const int k = (int)(i % 2048), n = (int)((i / 2048) % 64), m = (int)(i / (2048 * 64));
        p.W1T[i] = f2bf(p.cmp_w1[((size_t)m * 2048 + k) * 64 + n]);
    }
    for (size_t i = gtid; i < (size_t)NL * 2 * 64 * 64; i += gthreads) {
        const int k = (int)(i % 64), n = (int)((i / 64) % 64), m = (int)(i / 4096);
        p.W2T[i] = f2bf(p.cmp_w2[((size_t)m * 64 + k) * 64 + n]);
    }
    for (size_t i = gtid; i < (size_t)NL * NPAD; i += gthreads) {
        const int l = (int)(i / NPAD), r = (int)(i % NPAD);
        float v = 0.f;
        if (r < 2560) { const int n = r < 768 ? r : r + 4; v = p.b_in[l * NCOL + n]; }
        else if (r < 2564) v = p.b_in[l * NCOL + 768 + (r - 2560)];
        else if (r < 2582) v = p.b_in[l * NCOL + r];
        p.binp[i] = v;
    }
    for (size_t i = gtid; i < (size_t)NL * NE * 2048; i += gthreads) {
        const int r = (int)(i % 2048); const size_t le = i / 2048;
        const int s = (r >> 7) & 1, f = (r >> 8) * 128 + (r & 127);
        p.bgup[i] = p.b_gu[le * 2048 + 2 * f + s];
    }
    for (size_t i = gtid; i < (size_t)NL * NE * 1024; i += gthreads) {
        const int k = (int)(i % 1024), e = (int)((i / 1024) % NE), l = (int)(i / (1024 * NE));
        p.rwT[i] = p.router_w[((size_t)l * 1024 + k) * NE + e];
    }
    for (size_t i = gtid; i < (size_t)NL * (NPAD - NCOL) * 1024; i += gthreads) {
        const int l = (int)(i / ((NPAD - NCOL) * 1024)); const size_t r = i % ((size_t)(NPAD - NCOL) * 1024);
        p.WinT[(size_t)l * NPAD * 1024 + (size_t)NCOL * 1024 + r] = 0;
    }
    for (size_t i = gtid; i < (size_t)NTOK * DM / 4; i += gthreads) {
        const float4 v4 = ((const float4*)p.x)[i];
        u32x2 w; w.x = pack2(v4.x, v4.y); w.y = pack2(v4.z, v4.w);
        ((u32x2*)p.xb)[i] = w;
    }
    if (bid < 4) {
        float* lf = (float*)ldsc;
        const int j = tid & 63, part = tid >> 6;
        const float* pe = p.cmp_pe + (size_t)bid * 2048; const float* w1 = p.cmp_w1 + (size_t)bid * 2048 * 64;
        float s = 0.f;
        for (int kk = part * 256; kk < part * 256 + 256; ++kk) s += pe[kk] * w1[(size_t)kk * 64 + j];
        lf[tid] = s; __syncthreads();
        if (tid < 64) { float a = 0.f; for (int q = 0; q < 8; ++q) a += lf[tid + 64 * q]; p.b1c[bid * 64 + tid] = a; }
        __syncthreads();
    }
}

namespace pg8 {
constexpr int BM = 256, BK = 64, HALF = 128, HTB = HALF * BK * 2, NXCD = 8, WGM = 8;
__device__ __forceinline__ int lds_byte(int r, int c) { const int st = (r >> 4) * 2 + (c >> 5), rr = r & 15, cc = c & 31, ob = rr * 64 + cc * 2; return st * 1024 + (ob ^ (((ob >> 9) & 1) << 5)); }
__device__ __forceinline__ void stage_rc(int b, int& R, int& C) { const int st = b / 1024, sb = b % 1024, swz = sb ^ (((sb >> 9) & 1) << 5); R = (st >> 1) * 16 + swz / 64; C = (st & 1) * 32 + (swz % 64) / 2; }
__device__ __forceinline__ bool tile_order(int i, int G, int c, int nM, int nN, int& pm, int& pn) {
    const int nwg = nM * nN; const long L = (long)i * G + c; if (L >= nwg) return false;
    int wgid = (int)L; { const int q = nwg / NXCD, r = nwg % NXCD, xcd = wgid % NXCD, off = wgid / NXCD; wgid = (xcd < r ? xcd * (q + 1) : r * (q + 1) + (xcd - r) * q) + off; }
    const int nig = WGM * nN, gid = wgid / nig, fm = gid * WGM, gsz = (nM - fm) < WGM ? (nM - fm) : WGM;
    pm = fm + ((wgid % nig) % gsz); pn = (wgid % nig) / gsz; return true;
}
template <bool FP8, int SCA, class Sched, class Epi>
__device__ __forceinline__ void gemm_phase(LAS unsigned char* lds, const char* Abase, int K, const Sched& S, const Epi& E) {
    int tid = threadIdx.x; asm volatile("" : "+v"(tid));
    const int wid = __builtin_amdgcn_readfirstlane(tid >> 6), lane = tid & 63, wr = wid >> 2, wc = wid & 3, fr = lane & 15, fq = lane >> 4;
    const int nt = K / BK;
    int R0, C0, R1, C1; stage_rc(tid * 16, R0, C0); stage_rc(tid * 16 + 8192, R1, C1);
    LAS unsigned* aofs = (LAS unsigned*)(lds + LDS_AOFF) + tid;
    unsigned rg[10];
    rg[8] = (unsigned)(R0 * K + C0) * 2u; rg[9] = (unsigned)(R1 * K + C1) * 2u;
    if constexpr (FP8) { aofs[8 * NTHR] = rg[8]; aofs[9 * NTHR] = rg[9]; }
    const size_t kstep = (size_t)(BK * 2), hstep = (size_t)HALF * K * 2;
    const unsigned ldsw = (unsigned)wid * 1024u;
    const int aoff = lds_byte(wr * 64 + fr, fq * 8), boff = lds_byte(wc * 32 + fr, fq * 8);
#define PG8_SA(b, h) (((b) * 2 + (h)) * HTB)
#define PG8_SB(b, h) ((4 + (b) * 2 + (h)) * HTB)
#define PG8_OFS(sel, j) (FP8 ? aofs[((sel) * 4 + (j)) * NTHR] : ((sel) ? rg[4 + (j)] : rg[(j)]))
#define PG8_STAGE_B(bufoff, gbase) do { _Pragma("unroll") for (int _i = 0; _i < 2; ++_i) { const unsigned ob_ = FP8 ? aofs[(8 + _i) * NTHR] : rg[8 + _i]; \
        __builtin_amdgcn_global_load_lds((const unsigned*)((const char*)(gbase) + ob_), (LAS unsigned*)(lds + (bufoff) + ldsw + _i * 8192), 16, 0, 0); } } while (0)
#define PG8_STAGE_A(bufoff, kbyte, sel, h) do { const unsigned o0_ = PG8_OFS(sel, (h) * 2), o1_ = PG8_OFS(sel, (h) * 2 + 1); \
        __builtin_amdgcn_global_load_lds((const unsigned*)(Abase + (kbyte) + o0_), (LAS unsigned*)(lds + (bufoff) + ldsw), 16, 0, 0); \
        __builtin_amdgcn_global_load_lds((const unsigned*)(Abase + (kbyte) + o1_), (LAS unsigned*)(lds + (bufoff) + ldsw + 8192), 16, 0, 0); } while (0)
#define PG8_LDA(dst, b, h) do { _Pragma("unroll") for (int m = 0; m < 4; ++m) { \
        if constexpr (FP8) { const v4i_t lo_ = *(const LAS v4i_t*)(lds + PG8_SA(b, h) + aoff + m * 2048), hi_ = *(const LAS v4i_t*)(lds + PG8_SA(b, h) + aoff + m * 2048 + 1024); dst##8[m] = __builtin_shufflevector(lo_, hi_, 0, 1, 2, 3, 4, 5, 6, 7); } \
        else { _Pragma("unroll") for (int k = 0; k < 2; ++k) dst[m][k] = *(const LAS bf16x8*)(lds + PG8_SA(b, h) + aoff + m * 2048 + k * 1024); } } } while (0)
#define PG8_LDB(dst, b, h) do { _Pragma("unroll") for (int n = 0; n < 2; ++n) { \
        if constexpr (FP8) { const v4i_t lo_ = *(const LAS v4i_t*)(lds + PG8_SB(b, h) + boff + n * 2048), hi_ = *(const LAS v4i_t*)(lds + PG8_SB(b, h) + boff + n * 2048 + 1024); dst##8[n] = __builtin_shufflevector(lo_, hi_, 0, 1, 2, 3, 4, 5, 6, 7); } \
        else { _Pragma("unroll") for (int k = 0; k < 2; ++k) dst[n][k] = *(const LAS bf16x8*)(lds + PG8_SB(b, h) + boff + n * 2048 + k * 1024); } } } while (0)
#define PG8_MMA(ai, bj, At, Bt) do { __builtin_amdgcn_s_setprio(1); _Pragma("unroll") for (int m = 0; m < 4; ++m) _Pragma("unroll") for (int n = 0; n < 2; ++n) { \
        if constexpr (FP8) { acc[ai][bj][m][n] = __builtin_amdgcn_mfma_scale_f32_16x16x128_f8f6f4(Bt##8[n], At##8[m], acc[ai][bj][m][n], 0, 0, 0, SCA, 0, SCA); } \
        else { _Pragma("unroll") for (int k = 0; k < 2; ++k) acc[ai][bj][m][n] = __builtin_amdgcn_mfma_f32_16x16x32_bf16(Bt[n][k], At[m][k], acc[ai][bj][m][n], 0, 0, 0); } } \
        __builtin_amdgcn_s_setprio(0); } while (0)
#define PG8_WAIT_V(n) asm volatile("s_waitcnt vmcnt(" #n ")" ::: "memory")
#define PG8_WAIT_L(n) asm volatile("s_waitcnt lgkmcnt(" #n ")" ::: "memory")
#define PG8_BAR __builtin_amdgcn_s_barrier()
#define PG8_SCHED __builtin_amdgcn_sched_barrier(0)
    typename Sched::Unit cur, nxt; int ui = 0;
    if (!S.next(0, cur)) return;
    f32x4 acc[2][2][4][2];
#pragma unroll
    for (int a = 0; a < 2; ++a)
#pragma unroll
        for (int b = 0; b < 2; ++b)
#pragma unroll
            for (int m = 0; m < 4; ++m)
#pragma unroll
                for (int n = 0; n < 2; ++n) acc[a][b][m][n] = (f32x4){0.f, 0.f, 0.f, 0.f};
    bf16x8 At[4][2], B0[2][2], B1[2][2];
    v8i_t At8[4], B08[2], B18[2];
    { unsigned a4[2][2]; S.a_off(cur, R0, C0, R1, C1, a4); rg[0] = a4[0][0]; rg[1] = a4[0][1]; rg[2] = a4[1][0]; rg[3] = a4[1][1];
      if constexpr (FP8) { aofs[0] = a4[0][0]; aofs[NTHR] = a4[0][1]; aofs[2 * NTHR] = a4[1][0]; aofs[3 * NTHR] = a4[1][1]; } }
    const char* cB = S.b_ptr(cur);
    PG8_STAGE_B(PG8_SB(0, 0), cB); PG8_STAGE_B(PG8_SB(0, 1), cB + hstep); PG8_STAGE_A(PG8_SA(0, 0), 0, 0, 0); PG8_STAGE_A(PG8_SA(0, 1), 0, 0, 1);
    if (wr == 1) PG8_BAR;
    PG8_WAIT_V(2); PG8_BAR;
    PG8_STAGE_B(PG8_SB(1, 0), cB + kstep); PG8_STAGE_A(PG8_SA(1, 0), kstep, 0, 0); PG8_STAGE_B(PG8_SB(1, 1), cB + hstep + kstep);
    PG8_WAIT_V(6); PG8_BAR;
    for (;;) {
        const bool has_next = S.next(ui + 1, nxt);
        const char* nB = cB;
        if (has_next) { int t2 = threadIdx.x; asm volatile("" : "+v"(t2)); int r0, c0, r1, c1; stage_rc(t2 * 16, r0, c0); stage_rc(t2 * 16 + 8192, r1, c1); unsigned a4[2][2]; S.a_off(nxt, r0, c0, r1, c1, a4); nB = S.b_ptr(nxt);
            rg[4] = a4[0][0]; rg[5] = a4[0][1]; rg[6] = a4[1][0]; rg[7] = a4[1][1];
            if constexpr (FP8) { aofs[4 * NTHR] = a4[0][0]; aofs[5 * NTHR] = a4[0][1]; aofs[6 * NTHR] = a4[1][0]; aofs[7 * NTHR] = a4[1][1]; } }
        else { rg[4] = rg[0]; rg[5] = rg[1]; rg[6] = rg[2]; rg[7] = rg[3];
            if constexpr (FP8) { aofs[4 * NTHR] = aofs[0]; aofs[5 * NTHR] = aofs[NTHR]; aofs[6 * NTHR] = aofs[2 * NTHR]; aofs[7 * NTHR] = aofs[3 * NTHR]; } }
#pragma unroll 1
        for (int t = 0; t < nt; t += 2) {
            const bool last = (t == nt - 2);
            const size_t ka1 = (size_t)(t + 1) * kstep, ka2 = last ? 0 : (size_t)(t + 2) * kstep, ka3 = ka2 + kstep;
            const char* b2 = last ? nB : cB + (size_t)(t + 2) * kstep; const char* b3 = b2 + kstep;
            const int sel = last ? 1 : 0;
            PG8_LDB(B0, 0, 0); PG8_LDB(B1, 0, 1); PG8_SCHED; PG8_LDA(At, 0, 0); PG8_STAGE_A(PG8_SA(1, 1), ka1, 0, 1);
            PG8_WAIT_V(8); PG8_WAIT_L(0); PG8_BAR; PG8_MMA(0, 0, At, B0); PG8_MMA(0, 1, At, B1); PG8_BAR; PG8_SCHED;
            PG8_LDA(At, 0, 1); PG8_STAGE_B(PG8_SB(0, 0), b2); PG8_STAGE_B(PG8_SB(0, 1), b2 + hstep); PG8_STAGE_A(PG8_SA(0, 0), ka2, sel, 0);
            PG8_WAIT_V(8); PG8_WAIT_L(0); PG8_BAR; PG8_MMA(1, 0, At, B0); PG8_MMA(1, 1, At, B1); PG8_BAR; PG8_SCHED;
            PG8_LDB(B0, 1, 0); PG8_LDB(B1, 1, 1); PG8_SCHED; PG8_LDA(At, 1, 0); PG8_STAGE_A(PG8_SA(0, 1), ka2, sel, 1);
            PG8_WAIT_V(8); PG8_WAIT_L(0); PG8_BAR; PG8_MMA(0, 0, At, B0); PG8_MMA(0, 1, At, B1); PG8_BAR; PG8_SCHED;
            PG8_LDA(At, 1, 1); PG8_STAGE_B(PG8_SB(1, 0), b3); PG8_STAGE_B(PG8_SB(1, 1), b3 + hstep); PG8_STAGE_A(PG8_SA(1, 0), ka3, sel, 0);
            PG8_WAIT_V(8); PG8_WAIT_L(0); PG8_BAR; PG8_MMA(1, 0, At, B0); PG8_MMA(1, 1, At, B1); PG8_BAR; PG8_SCHED;
        }
        if (wr == 0) PG8_BAR;
        { int t2 = threadIdx.x; asm volatile("" : "+v"(t2)); E(acc, cur, wr, wc, t2 & 15, (t2 & 63) >> 4); }
        if (!has_next) break;
#pragma unroll
        for (int a = 0; a < 2; ++a)
#pragma unroll
            for (int b = 0; b < 2; ++b)
#pragma unroll
                for (int m = 0; m < 4; ++m)
#pragma unroll
                    for (int n = 0; n < 2; ++n) acc[a][b][m][n] = (f32x4){0.f, 0.f, 0.f, 0.f};
        cur = nxt; cB = nB; ++ui;
        rg[0] = rg[4]; rg[1] = rg[5]; rg[2] = rg[6]; rg[3] = rg[7];
        if constexpr (FP8) { aofs[0] = aofs[4 * NTHR]; aofs[NTHR] = aofs[5 * NTHR]; aofs[2 * NTHR] = aofs[6 * NTHR]; aofs[3 * NTHR] = aofs[7 * NTHR]; }
        if (wr == 1) PG8_BAR;
    }
    PG8_WAIT_V(0);
    PG8_BAR;
#undef PG8_SA
#undef PG8_SB
#undef PG8_STAGE_A
#undef PG8_OFS
#undef PG8_STAGE_B
#undef PG8_LDA
#undef PG8_LDB
#undef PG8_MMA
#undef PG8_WAIT_V
#undef PG8_WAIT_L
#undef PG8_BAR
#undef PG8_SCHED
}
}

struct DenseUnit { int pm, pn; };
struct DenseSched {
    typedef DenseUnit Unit;
    const char* Bt; int K, nM, nN;
    __device__ __forceinline__ bool next(int i, Unit& u) const { return pg8::tile_order(i, gridDim.x, blockIdx.x, nM, nN, u.pm, u.pn); }
    __device__ __forceinline__ void a_off(const Unit& u, int R0, int C0, int R1, int C1, unsigned (&off)[2][2]) const {
#pragma unroll
        for (int h = 0; h < 2; ++h) { off[h][0] = (unsigned)((u.pm * 256 + h * 128 + R0) * K + C0) * 2u; off[h][1] = (unsigned)((u.pm * 256 + h * 128 + R1) * K + C1) * 2u; }
    }
    __device__ __forceinline__ const char* b_ptr(const Unit& u) const { return Bt + (size_t)u.pn * 256 * K * 2; }
};
struct MoeUnit { int rbt, e, pn; };
template <bool GATHER>
struct MoeSched {
    typedef MoeUnit Unit;
    static constexpr int KP = 512;
    const char* Bt; const int* lists; const int* ptile; const int* ecnt; int nN, nrows;
    __device__ __forceinline__ bool next(int i, Unit& u) const {
        int pm, pn; if (!pg8::tile_order(i, gridDim.x, blockIdx.x, ptile[NE], nN, pm, pn)) return false;
        int e = 0; while (ptile[e + 1] <= pm) ++e;
        u.rbt = pm; u.e = e; u.pn = pn; return true;
    }
    __device__ __forceinline__ void a_off(const Unit& u, int R0, int C0, int R1, int C1, unsigned (&off)[2][2]) const {
        if (GATHER) {
            const int* lst = lists + (size_t)u.e * LIST_CAP; const int rb = u.rbt - ptile[u.e], cnt = ecnt[u.e];
#pragma unroll
            for (int h = 0; h < 2; ++h) {
                const int l0 = rb * 256 + h * 128 + R0, l1 = rb * 256 + h * 128 + R1;
                const int t0 = l0 < cnt ? (lst[l0] >> 2) : 0, t1 = l1 < cnt ? (lst[l1] >> 2) : 0;
                off[h][0] = (unsigned)(t0 * KP + C0) * 2u; off[h][1] = (unsigned)(t1 * KP + C1) * 2u;
            }
        } else {
#pragma unroll
            for (int h = 0; h < 2; ++h) { off[h][0] = (unsigned)((u.rbt * 256 + h * 128 + R0) * KP + C0) * 2u; off[h][1] = (unsigned)((u.rbt * 256 + h * 128 + R1) * KP + C1) * 2u; }
        }
    }
    __device__ __forceinline__ const char* b_ptr(const Unit& u) const { return Bt + ((size_t)u.e * nrows + (size_t)u.pn * 256) * KP * 2; }
};

struct EpiInProj {
    const Params* p; int l;
    __device__ __forceinline__ void operator()(const f32x4 (&acc)[2][2][4][2], const DenseUnit& u, int wr, int wc, int fr, int fq) const {
        const float* bias = p->binp + l * NPAD + u.pn * 256;
#pragma unroll
        for (int bj = 0; bj < 2; ++bj) {
            int kind = 0, hb0 = 0;
            if (u.pn == 1) { kind = 1; hb0 = bj * 2; } else if (u.pn == 4 && bj == 1) { kind = 1; hb0 = 4; } else if (u.pn == 8 && bj == 0) { kind = 1; hb0 = 6; } else if (u.pn == 9 && bj == 0) { kind = 1; hb0 = 8; }
            else if (u.pn == 2) { kind = 2; hb0 = bj * 2; } else if (u.pn == 5 && bj == 0) { kind = 2; hb0 = 4; } else if (u.pn == 8 && bj == 1) { kind = 2; hb0 = 6; } else if (u.pn == 9 && bj == 1) { kind = 2; hb0 = 8; }
#pragma unroll
            for (int n = 0; n < 2; ++n) {
                const int c = bj * 128 + wc * 32 + n * 16 + 4 * fq;
                const f32x4 bv = *(const f32x4*)(bias + c);
                const int hh = hb0 + ((c & 127) >> 6), d = c & 63;
#pragma unroll
                for (int ai = 0; ai < 2; ++ai)
#pragma unroll
                    for (int m = 0; m < 4; ++m) {
                        const int row = u.pm * 256 + ai * 128 + wr * 64 + m * 16 + fr;
                        const f32x4 v = acc[ai][bj][m][n] + bv;
                        u32x2 w; w.x = pack2(v[0], v[1]); w.y = pack2(v[2], v[3]);
                        if (kind == 0) *(u32x2*)(p->hb + (size_t)row * NMAIN + u.pn * 256 + c) = w;
                        else {
                            const int b = row >> 11, s = row & 2047, kk = s & 31;
                            bf16_t* blk = (kind == 1 ? p->kF : p->vT) + (((size_t)b * NVH + hh) * 64 + (s >> 5)) * 2048;
                            if (kind == 1) {
                                const int frk = (kk >> 3) * 4 + (kk & 3), t = (kk >> 2) & 1;
                                *(u32x2*)(blk + ((t * 2 + (d >> 5)) * 64 + ((d & 31) >> 3) * 16 + frk) * 8 + (d & 7)) = w;
                            } else {
                                bf16_t* vt = blk + (((d >> 4) * 64) + (kk >> 3) * 16 + (d & 15)) * 8 + (kk & 7);
                                vt[0] = (bf16_t)(w.x & 0xffff); vt[8] = (bf16_t)(w.x >> 16); vt[16] = (bf16_t)(w.y & 0xffff); vt[24] = (bf16_t)(w.y >> 16);
                            }
                        }
                    }
            }
        }
    }
};
struct EpiOutProj {
    const float* xin; float* t;
    __device__ __forceinline__ void operator()(const f32x4 (&acc)[2][2][4][2], const DenseUnit& u, int wr, int wc, int fr, int fq) const {
#pragma unroll
        for (int ai = 0; ai < 2; ++ai)
#pragma unroll
            for (int m = 0; m < 4; ++m) {
                const size_t rowoff = (size_t)(u.pm * 256 + ai * 128 + wr * 64 + m * 16 + fr) * DM + u.pn * 256 + wc * 32 + 4 * fq;
#pragma unroll
                for (int bj = 0; bj < 2; ++bj)
#pragma unroll
                    for (int n = 0; n < 2; ++n) {
                        const size_t off = rowoff + bj * 128 + n * 16;
                        const f32x4 xv = *(const f32x4*)(xin + off);
                        *(f32x4*)(t + off) = xv * ALPHA + acc[ai][bj][m][n];
                    }
            }
    }
};
struct EpiGateUp {
    bf16_t* act; const float* bgup;
    __device__ __forceinline__ void operator()(const f32x4 (&acc)[2][2][4][2], const MoeUnit& u, int wr, int wc, int fr, int fq) const {
        const float* bias = bgup + (size_t)u.e * 2048 + u.pn * 256;
#pragma unroll
        for (int n = 0; n < 2; ++n) {
            const int c = wc * 32 + n * 16 + 4 * fq;
            const f32x4 bg = *(const f32x4*)(bias + c), bu = *(const f32x4*)(bias + 128 + c);
#pragma unroll
            for (int ai = 0; ai < 2; ++ai)
#pragma unroll
                for (int m = 0; m < 4; ++m) {
                    const f32x4 g4 = acc[ai][0][m][n] + bg, u4 = acc[ai][1][m][n] + bu;
                    float o[4];
#pragma unroll
                    for (int j = 0; j < 4; ++j) {
                        const float g = fminf(g4[j], 7.0f), uu = fminf(fmaxf(u4[j], -7.0f), 7.0f);
                        const float glu = g * __builtin_amdgcn_rcpf(1.0f + __builtin_amdgcn_exp2f(-2.455466929f * g));
                        o[j] = (uu + 1.0f) * glu;
                    }
                    *(unsigned*)((char*)act + (size_t)(u.rbt * 256 + ai * 128 + wr * 64 + m * 16 + fr) * DFF + u.pn * 128 + c) = pack4_fp8(o[0], o[1], o[2], o[3]);
                }
        }
    }
};
struct EpiDown {
    bf16_t* ybuf; const float* bdn;
    __device__ __forceinline__ void operator()(const f32x4 (&acc)[2][2][4][2], const MoeUnit& u, int wr, int wc, int fr, int fq) const {
        const float* bias = bdn + (size_t)u.e * 1024 + u.pn * 256;
#pragma unroll
        for (int bj = 0; bj < 2; ++bj)
#pragma unroll
            for (int n = 0; n < 2; ++n) {
                const int c = bj * 128 + wc * 32 + n * 16 + 4 * fq;
                const f32x4 bv = *(const f32x4*)(bias + c);
#pragma unroll
                for (int ai = 0; ai < 2; ++ai)
#pragma unroll
                    for (int m = 0; m < 4; ++m) {
                        const f32x4 v = acc[ai][bj][m][n] + bv;
                        u32x2 w; w.x = pack2(v[0], v[1]); w.y = pack2(v[2], v[3]);
                        *(u32x2*)(ybuf + (size_t)(u.rbt * 256 + ai * 128 + wr * 64 + m * 16 + fr) * DM + u.pn * 256 + c) = w;
                    }
            }
    }
};

__device__ __forceinline__ void phase_inproj(const Params& p, int l, char* lds) {
    DenseSched S{(const char*)(p.WinT + (size_t)l * NPAD * 1024), 1024, NTOK / 256, NMAIN / 256};
    EpiInProj E{&p, l};
    pg8::gemm_phase<false, 0>((LAS unsigned char*)lds, (const char*)p.xb, 1024, S, E);
    int tid = threadIdx.x; asm volatile("" : "+v"(tid));
    const int wid = tid >> 6, lane = tid & 63, fr = lane & 15, fq = lane >> 4;
    const bf16_t* W = p.WinT + ((size_t)l * NPAD + NMAIN) * 1024;
    const float* bias = p.binp + l * NPAD + NMAIN;
    for (int u = blockIdx.x * NWV + wid; u < NTOK / 16; u += gridDim.x * NWV) {
        const bf16_t* ar = p.xb + (size_t)(u * 16 + fr) * DM + fq * 8;
        const bf16_t* w0 = W + (size_t)fr * 1024 + fq * 8; const bf16_t* w1 = W + (size_t)(16 + fr) * 1024 + fq * 8;
        f32x4 a0 = (f32x4){0.f, 0.f, 0.f, 0.f}, a1 = a0;
#pragma unroll 4
        for (int ks = 0; ks < 32; ++ks) {
            const bf16x8 a = *(const bf16x8*)(ar + ks * 32);
            a0 = __builtin_amdgcn_mfma_f32_16x16x32_bf16(a, *(const bf16x8*)(w0 + ks * 32), a0, 0, 0, 0);
            a1 = __builtin_amdgcn_mfma_f32_16x16x32_bf16(a, *(const bf16x8*)(w1 + ks * 32), a1, 0, 0, 0);
        }
#pragma unroll
        for (int r = 0; r < 4; ++r) {
            float* dst = p.hs + (size_t)(u * 16 + fq * 4 + r) * HS_W;
            dst[fr] = a0[r] + bias[fr];
            if (fr < 6) dst[16 + fr] = a1[r] + bias[16 + fr];
        }
    }
}
__device__ __forceinline__ void phase_outproj(const Params& p, int l, const float* xin, char* lds) {
    DenseSched S{(const char*)(p.WoT + (size_t)l * 1024 * 1024), 1024, NTOK / 256, 4};
    EpiOutProj E{xin, p.tbuf};
    pg8::gemm_phase<false, 0>((LAS unsigned char*)lds, (const char*)p.ob, 1024, S, E);
}
__device__ __forceinline__ void build_tiles(const Params& p, int l, int* ptile, int* ecnt) {
    int tid = threadIdx.x; asm volatile("" : "+v"(tid));
    if (tid < NE) ecnt[tid] = (int)__hip_atomic_load(p.ctrl + 64 + l * NE + tid, __ATOMIC_RELAXED, __HIP_MEMORY_SCOPE_AGENT);
    __syncthreads();
    if (tid == 0) { int s = 0; for (int e = 0; e < NE; ++e) { ptile[e] = s; s += (ecnt[e] + 255) >> 8; } ptile[NE] = s; }
    __syncthreads();
}
__device__ __forceinline__ void phase_gateup(const Params& p, int l, char* lds) {
    int* ptile = (int*)(lds + LDS_TAB); int* ecnt = ptile + 40;
    build_tiles(p, l, ptile, ecnt);
    MoeSched<true> S{(const char*)p.WguT + (size_t)l * NE * 2048 * 1024, p.lists, ptile, ecnt, 8, 2048};
    EpiGateUp E{p.act, p.bgup + (size_t)l * NE * 2048};
    pg8::gemm_phase<true, 0x7c7c7c7c>((LAS unsigned char*)lds, (const char*)p.x1b, 512, S, E);
}
__device__ __forceinline__ void phase_down(const Params& p, int l, char* lds) {
    int* ptile = (int*)(lds + LDS_TAB); int* ecnt = ptile + 40;
    build_tiles(p, l, ptile, ecnt);
    MoeSched<false> S{(const char*)p.WdnT + (size_t)l * NE * 1024 * 1024, p.lists, ptile, ecnt, 4, 1024};
    EpiDown E{p.ybuf, p.b_dn + (size_t)l * NE * 1024};
    pg8::gemm_phase<true, 0x7c7c7c7c>((LAS unsigned char*)lds, (const char*)p.act, 512, S, E);
}

__device__ __forceinline__ float gelu_tanh(float x) {
    const float u = 0.7978845608028654f * (x + 0.044715f * x * x * x);
    const float e = __expf(-2.0f * fabsf(u)); const float th = (1.0f - e) / (1.0f + e);
    return 0.5f * x * (1.0f + (u < 0.f ? -th : th));
}
__device__ __forceinline__ void phase_prep(const Params& p, int l, char* lds) {
    int tid = threadIdx.x; asm volatile("" : "+v"(tid));
    const int wid = tid >> 6, lane = tid & 63, fr = lane & 15, fq = lane >> 4;
    const int gw = blockIdx.x * NWV + wid, nw = gridDim.x * NWV;
    for (int u = (int)gridDim.x - 1 - (int)blockIdx.x; u < NB * 4; u += gridDim.x) {
        const int b = u >> 2, h = u & 3;
        const float* srcp = p.hs + ((size_t)b * SEQ + tid * 4) * HS_W + h;
        float ls[4]; float tot = 0.f;
#pragma unroll
        for (int i = 0; i < 4; ++i) { const float f = srcp[(size_t)i * HS_W]; ls[i] = fminf(f, 0.f) - log1pf(__expf(-fabsf(f))); tot += ls[i]; }
        float inc = tot;
#pragma unroll
        for (int o = 1; o < 64; o <<= 1) { const float v = __shfl_up(inc, o); if (lane >= o) inc += v; }
        float* wtot = (float*)(lds + 65536);
        if (lane == 63) wtot[wid] = inc;
        __syncthreads();
        float base = inc - tot;
        for (int w = 0; w < wid; ++w) base += wtot[w];
        float4 o4; o4.x = base + ls[0]; o4.y = o4.x + ls[1]; o4.z = o4.y + ls[2]; o4.w = o4.z + ls[3];
        *(float4*)(p.cF + (size_t)u * SEQ + tid * 4) = o4;
        __syncthreads();
    }
    float* part = (float*)lds;
    bf16_t* h1 = (bf16_t*)(lds + 32768);
    for (int u = blockIdx.x; u < NB * 2 * 2 * 8; u += gridDim.x) {
        const int ct = u & 7, which = (u >> 3) & 1, kvh = (u >> 4) & 1, b = u >> 5;
        const int colo = (which ? C_NVC : C_NKC) + kvh * 64;
        const int c_lane = ct * 16 + fr;
        const int tokbase = min(c_lane, 126) * 16;
        const bf16_t* arow = p.hb + ((size_t)b * SEQ + tokbase) * NMAIN + colo + fq * 8;
        const bf16_t* w1 = p.W1T + ((size_t)(l * 2 + which) * 64 + fr) * 2048 + fq * 8;
        f32x4 acc[4];
#pragma unroll
        for (int n = 0; n < 4; ++n) acc[n] = (f32x4){0.f, 0.f, 0.f, 0.f};
#pragma unroll
        for (int kk = 0; kk < 8; ++kk) {
            const int ks = wid * 8 + kk;
            const bf16x8 a = *(const bf16x8*)(arow + (size_t)(ks >> 1) * NMAIN + (ks & 1) * 32);
#pragma unroll
            for (int n = 0; n < 4; ++n) {
                const bf16x8 bb = *(const bf16x8*)(w1 + (size_t)n * 16 * 2048 + ks * 32);
                acc[n] = __builtin_amdgcn_mfma_f32_16x16x32_bf16(a, bb, acc[n], 0, 0, 0);
            }
        }
#pragma unroll
        for (int n = 0; n < 4; ++n)
#pragma unroll
            for (int r = 0; r < 4; ++r) part[wid * 1024 + (fq * 4 + r) * 64 + n * 16 + fr] = acc[n][r];
        __syncthreads();
        const float* b1 = p.b1c + (l * 2 + which) * 64;
#pragma unroll
        for (int i = 0; i < 2; ++i) {
            const int e = tid + NTHR * i; float sum = 0.f;
#pragma unroll
            for (int w = 0; w < 8; ++w) sum += part[w * 1024 + e];
            h1[e] = f2bf(gelu_tanh(sum + b1[e & 63]));
        }
        __syncthreads();
        if (wid == 0) {
            const bf16_t* w2 = p.W2T + ((size_t)(l * 2 + which) * 64 + fr) * 64 + fq * 8;
            f32x4 o2[4];
#pragma unroll
            for (int n = 0; n < 4; ++n) o2[n] = (f32x4){0.f, 0.f, 0.f, 0.f};
#pragma unroll
            for (int ks = 0; ks < 2; ++ks) {
                const bf16x8 a = *(const bf16x8*)(h1 + fr * 64 + ks * 32 + fq * 8);
#pragma unroll
                for (int n = 0; n < 4; ++n) {
                    const bf16x8 bb = *(const bf16x8*)(w2 + (size_t)n * 16 * 64 + ks * 32);
                    o2[n] = __builtin_amdgcn_mfma_f32_16x16x32_bf16(a, bb, o2[n], 0, 0, 0);
                }
            }
            const size_t base = ((size_t)b * 2 + kvh) * 128 * 64;
#pragma unroll
            for (int n = 0; n < 4; ++n)
#pragma unroll
                for (int r = 0; r < 4; ++r) {
                    const int c = ct * 16 + fq * 4 + r, j2 = n * 16 + fr;
                    const bf16_t v = c < 127 ? f2bf(o2[n][r]) : (bf16_t)0;
                    if (which == 0) p.kc[base + (size_t)c * 64 + j2] = v;
                    else { p.vc[base + (size_t)c * 64 + j2] = v; p.vcT[base + (size_t)j2 * 128 + c] = v; }
                }
        }
        __syncthreads();
    }
}

constexpr float L2E = 1.4426950408889634f, MASKV = -1e30f, SCL2 = QSCALE * L2E;
struct KVFrag { bf16x8 k[2][2]; bf16x8 v[4]; };
template <bool FM>
__device__ __forceinline__ void k_load(KVFrag& f, const bf16_t* __restrict__ Kb, size_t ldk, int kc0, int fr, int fq) {
    if (FM) {
        const bf16_t* kp = Kb + (size_t)(kc0 >> 5) * 2048 + (fq * 16 + fr) * 8;
        f.k[0][0] = *(const bf16x8*)(kp); f.k[0][1] = *(const bf16x8*)(kp + 512); f.k[1][0] = *(const bf16x8*)(kp + 1024); f.k[1][1] = *(const bf16x8*)(kp + 1536);
    } else {
        const bf16_t* kp = Kb + (size_t)(kc0 + (fr >> 2) * 8 + (fr & 3)) * ldk + fq * 8;
        f.k[0][0] = *(const bf16x8*)(kp); f.k[0][1] = *(const bf16x8*)(kp + 32);
        f.k[1][0] = *(const bf16x8*)(kp + 4 * ldk); f.k[1][1] = *(const bf16x8*)(kp + 4 * ldk + 32);
    }
}
template <bool FM>
__device__ __forceinline__ void v_load(bf16x8 (&v)[4], const bf16_t* __restrict__ VTb, size_t ldv, int kc0, int fr, int fq) {
    if (FM) {
        const bf16_t* vp = VTb + (size_t)(kc0 >> 5) * 2048 + (fq * 16 + fr) * 8;
#pragma unroll
        for (int dt = 0; dt < 4; ++dt) v[dt] = *(const bf16x8*)(vp + dt * 512);
    } else {
        const bf16_t* vp = VTb + (size_t)fr * ldv + kc0 + fq * 8;
#pragma unroll
        for (int dt = 0; dt < 4; ++dt) v[dt] = *(const bf16x8*)(vp + (size_t)dt * 16 * ldv);
    }
}
__device__ __forceinline__ float rowmax4(float x) {
    auto r = __builtin_amdgcn_permlane32_swap(__float_as_uint(x), __float_as_uint(x), false, false);
    x = fmaxf(__uint_as_float(r[0]), __uint_as_float(r[1]));
    auto q = __builtin_amdgcn_permlane16_swap(__float_as_uint(x), __float_as_uint(x), false, false);
    return fmaxf(__uint_as_float(q[0]), __uint_as_float(q[1]));
}
__device__ __forceinline__ float rowsum4(float x) {
    auto r = __builtin_amdgcn_permlane32_swap(__float_as_uint(x), __float_as_uint(x), false, false);
    x = __uint_as_float(r[0]) + __uint_as_float(r[1]);
    auto q = __builtin_amdgcn_permlane16_swap(__float_as_uint(x), __float_as_uint(x), false, false);
    return __uint_as_float(q[0]) + __uint_as_float(q[1]);
}
template <int NQT, bool MASK, class MB>
__device__ __forceinline__ void attn_compute(const KVFrag& f, const bf16x8 (&qf)[NQT][2], f32x4 (&o)[NQT][4], float (&m)[NQT], float (&l)[NQT], const MB& mb) {
    f32x4 s0[NQT], s1[NQT];
#pragma unroll
    for (int qt = 0; qt < NQT; ++qt) {
        s0[qt] = __builtin_amdgcn_mfma_f32_16x16x32_bf16(f.k[0][0], qf[qt][0], (f32x4){0.f, 0.f, 0.f, 0.f}, 0, 0, 0);
        s1[qt] = __builtin_amdgcn_mfma_f32_16x16x32_bf16(f.k[1][0], qf[qt][0], (f32x4){0.f, 0.f, 0.f, 0.f}, 0, 0, 0);
    }
#pragma unroll
    for (int qt = 0; qt < NQT; ++qt) {
        s0[qt] = __builtin_amdgcn_mfma_f32_16x16x32_bf16(f.k[0][1], qf[qt][1], s0[qt], 0, 0, 0);
        s1[qt] = __builtin_amdgcn_mfma_f32_16x16x32_bf16(f.k[1][1], qf[qt][1], s1[qt], 0, 0, 0);
    }
    float mx[NQT];
#pragma unroll
    for (int qt = 0; qt < NQT; ++qt) {
#pragma unroll
        for (int j = 0; j < 4; ++j) { s0[qt][j] = mb(qt, j, s0[qt][j]); s1[qt][j] = mb(qt, j + 4, s1[qt][j]); }
        mx[qt] = fmaxf(fmaxf(fmaxf(s0[qt][0], s0[qt][1]), fmaxf(s0[qt][2], s0[qt][3])), fmaxf(fmaxf(s1[qt][0], s1[qt][1]), fmaxf(s1[qt][2], s1[qt][3])));
    }
#pragma unroll
    for (int qt = 0; qt < NQT; ++qt) mx[qt] = rowmax4(mx[qt]);
    bool moved = false;
#pragma unroll
    for (int qt = 0; qt < NQT; ++qt) { mx[qt] = fmaxf(m[qt], mx[qt]); moved |= (mx[qt] != m[qt]); }
    if (__ballot(moved) != 0ull) {
#pragma unroll
        for (int qt = 0; qt < NQT; ++qt) {
            const float alpha = __builtin_amdgcn_exp2f(m[qt] - mx[qt]);
            l[qt] *= alpha;
#pragma unroll
            for (int dt = 0; dt < 4; ++dt) o[qt][dt] *= alpha;
        }
    }
    bf16x8 pf[NQT];
#pragma unroll
    for (int qt = 0; qt < NQT; ++qt) {
        m[qt] = mx[qt];
        float pr[8]; float ps = 0.f;
#pragma unroll
        for (int j = 0; j < 4; ++j) {
            pr[j] = (!MASK || s0[qt][j] > -1e29f) ? __builtin_amdgcn_exp2f(s0[qt][j] - mx[qt]) : 0.f;
            pr[j + 4] = (!MASK || s1[qt][j] > -1e29f) ? __builtin_amdgcn_exp2f(s1[qt][j] - mx[qt]) : 0.f;
        }
#pragma unroll
        for (int j = 0; j < 8; ++j) ps += pr[j];
        l[qt] += ps;
        const u32x4 pk = {pack2(pr[0], pr[1]), pack2(pr[2], pr[3]), pack2(pr[4], pr[5]), pack2(pr[6], pr[7])};
        pf[qt] = __builtin_bit_cast(bf16x8, pk);
    }
#pragma unroll
    for (int dt = 0; dt < 4; ++dt)
#pragma unroll
        for (int qt = 0; qt < NQT; ++qt) o[qt][dt] = __builtin_amdgcn_mfma_f32_16x16x32_bf16(f.v[dt], pf[qt], o[qt][dt], 0, 0, 0);
    __builtin_amdgcn_sched_barrier(0);
}
struct RangeIt { int c, c_hi; __device__ __forceinline__ int nxt() { if (c > c_hi) return -1; return (c++) * 32; } };
struct MaskIt { unsigned long long cm; __device__ __forceinline__ int nxt() { if (!cm) return -1; const int i = __builtin_ctzll(cm); cm &= cm - 1; return i * 32; } };
template <bool PFV, bool FM, class It, class Gen>
__device__ __forceinline__ void attn_run(It& it, const bf16_t* Kb, size_t ldk, const bf16_t* VTb, size_t ldv, int fr, int fq, const Gen& gen) {
    KVFrag fa, fb;
    int ka = it.nxt(); if (ka < 0) return;
    k_load<FM>(fa, Kb, ldk, ka, fr, fq); if (PFV) v_load<FM>(fa.v, VTb, ldv, ka, fr, fq);
    for (;;) {
        const int kb = it.nxt(); if (kb >= 0) { k_load<FM>(fb, Kb, ldk, kb, fr, fq); if (PFV) v_load<FM>(fb.v, VTb, ldv, kb, fr, fq); }
        if (!PFV) v_load<FM>(fa.v, VTb, ldv, ka, fr, fq);
        gen(ka, fa);
        if (kb < 0) break;
        ka = it.nxt(); if (ka >= 0) { k_load<FM>(fa, Kb, ldk, ka, fr, fq); if (PFV) v_load<FM>(fa.v, VTb, ldv, ka, fr, fq); }
        if (!PFV) v_load<FM>(fb.v, VTb, ldv, kb, fr, fq);
        gen(kb, fb);
        if (ka < 0) break;
    }
}
template <int NQT>
__device__ __forceinline__ void attn_init(f32x4 (&o)[NQT][4], float (&m)[NQT], float (&l)[NQT]) {
#pragma unroll
    for (int qt = 0; qt < NQT; ++qt) { m[qt] = MASKV; l[qt] = 0.f;
#pragma unroll
        for (int dt = 0; dt < 4; ++dt) o[qt][dt] = (f32x4){0.f, 0.f, 0.f, 0.f}; }
}
__device__ __forceinline__ float lsum4(float l) { return rowsum4(l); }
__device__ __forceinline__ void store_o4(bf16_t* dst, const f32x4 v) { u32x2 w; w.x = pack2(v[0], v[1]); w.y = pack2(v[2], v[3]); *(u32x2*)dst = w; }
__device__ __forceinline__ float sigmoidf_fast(float x) { return __builtin_amdgcn_rcpf(1.0f + __builtin_amdgcn_exp2f(-L2E * x)); }

__device__ __forceinline__ void fox_unit(const Params& p, int b, int h, int qb, int fr, int fq) {
    asm volatile("" : "+v"(fr), "+v"(fq));
    const int t0 = qb * 32;
    const bf16_t* Qb = p.hb + ((size_t)b * SEQ + t0) * NMAIN + C_FQ + h * 64 + fq * 8;
    bf16x8 qf[2][2];
#pragma unroll
    for (int qt = 0; qt < 2; ++qt) { qf[qt][0] = *(const bf16x8*)(Qb + (size_t)(qt * 16 + fr) * NMAIN); qf[qt][1] = *(const bf16x8*)(Qb + (size_t)(qt * 16 + fr) * NMAIN + 32); }
    const float* cf = p.cF + ((size_t)b * 4 + h) * SEQ;
    float cq[2];
#pragma unroll
    for (int qt = 0; qt < 2; ++qt) cq[qt] = cf[t0 + qt * 16 + fr] * L2E;
    f32x4 o[2][4]; float m[2], l[2];
    attn_init<2>(o, m, l);
    const bf16_t* Kb = p.kF + ((size_t)b * NVH + h) * 64 * SEQ;
    const bf16_t* VTb = p.vT + ((size_t)b * NVH + h) * 64 * SEQ;
    RangeIt it{0, t0 >> 5};
    attn_run<true, true>(it, Kb, NMAIN, VTb, SEQ, fr, fq, [&](int kc0, const KVFrag& f) {
        const float4 ca = *(const float4*)(cf + kc0 + 8 * fq), cb = *(const float4*)(cf + kc0 + 8 * fq + 4);
        const float ck[8] = {ca.x * L2E, ca.y * L2E, ca.z * L2E, ca.w * L2E, cb.x * L2E, cb.y * L2E, cb.z * L2E, cb.w * L2E};
        const int kq = kc0 + 8 * fq - t0 - fr;
        attn_compute<2, true>(f, qf, o, m, l, [&](int qt, int j, float raw) { return (kq + j - 16 * qt) > 0 ? MASKV : raw * SCL2 + cq[qt] - ck[j]; });
    });
#pragma unroll
    for (int qt = 0; qt < 2; ++qt) {
        const float inv = __builtin_amdgcn_rcpf(lsum4(l[qt]));
        bf16_t* dst = p.ob + ((size_t)b * SEQ + t0 + qt * 16 + fr) * DM + h * 64 + 4 * fq;
#pragma unroll
        for (int dt = 0; dt < 4; ++dt) store_o4(dst + dt * 16, o[qt][dt] * inv);
    }
}
__device__ __forceinline__ void swa_unit(const Params& p, int l_, int b, int kv, int pos, int fr, int fq) {
    asm volatile("" : "+v"(fr), "+v"(fq));
    const int t0 = pos * 16, t = t0 + fr;
    const bf16_t* Qb = p.hb + ((size_t)b * SEQ + t) * NMAIN + C_SQ + kv * 192 + fq * 8;
    bf16x8 qf[3][2];
#pragma unroll
    for (int g = 0; g < 3; ++g) { qf[g][0] = *(const bf16x8*)(Qb + g * 64); qf[g][1] = *(const bf16x8*)(Qb + g * 64 + 32); }
    float sl[3];
#pragma unroll
    for (int g = 0; g < 3; ++g) sl[g] = slope_swa(kv * 3 + g) * L2E;
    f32x4 o[3][4]; float m[3], l[3];
    attn_init<3>(o, m, l);
    const bf16_t* Kb = p.kF + ((size_t)b * NVH + 4 + kv) * 64 * SEQ;
    const bf16_t* VTb = p.vT + ((size_t)b * NVH + 4 + kv) * 64 * SEQ;
    RangeIt it{max(0, t0 - 127) >> 5, (t0 + 15) >> 5};
    attn_run<true, true>(it, Kb, NMAIN, VTb, SEQ, fr, fq, [&](int kc0, const KVFrag& f) {
        const int dq = t - kc0 - 8 * fq;
        attn_compute<3, true>(f, qf, o, m, l, [&](int g, int j, float raw) { const int dist = dq - j; return (dist >= 0 && dist < 128) ? raw * SCL2 - sl[g] * (float)dist : MASKV; });
    });
#pragma unroll
    for (int g = 0; g < 3; ++g) {
        const float sink = p.sinks[l_ * 6 + kv * 3 + g] * L2E;
        const float inv = __builtin_amdgcn_rcpf(lsum4(l[g]) + __builtin_amdgcn_exp2f(sink - m[g]));
        bf16_t* dst = p.ob + ((size_t)b * SEQ + t) * DM + 256 + (kv * 3 + g) * 64 + 4 * fq;
#pragma unroll
        for (int dt = 0; dt < 4; ++dt) store_o4(dst + dt * 16, o[g][dt] * inv);
    }
}
__device__ __forceinline__ void nsa_unit(const Params& p, int b, int kv, int pos, int fr, int fq, int lane, float* ps, unsigned* msk, float* otl) {
    asm volatile("" : "+v"(fr), "+v"(fq), "+v"(lane));
    const int t0 = pos * 16, t = t0 + fr, cur = t0 >> 6;
    const bf16_t* Qb = p.hb + ((size_t)b * SEQ + t) * NMAIN + C_NQ + kv * 192 + fq * 8;
    bf16x8 qf[3][2];
#pragma unroll
    for (int g = 0; g < 3; ++g) { qf[g][0] = *(const bf16x8*)(Qb + g * 64); qf[g][1] = *(const bf16x8*)(Qb + g * 64 + 32); }
    float sl[3];
#pragma unroll
    for (int g = 0; g < 3; ++g) sl[g] = slope_nsa(kv * 3 + g) * L2E;
    const float* gl = p.hs + ((size_t)b * SEQ + t) * HS_W + 4 + kv * 9;
    f32x4 o[3][4]; float m[3], l[3];
    f32x4* otv = (f32x4*)otl + lane;
#pragma unroll
    for (int i = 0; i < 8; ++i) ps[lane + 64 * i] = 0.f;
    {
        const bf16_t* Kb = p.kc + ((size_t)b * 2 + kv) * 128 * 64;
        const bf16_t* VTb = p.vcT + ((size_t)b * 2 + kv) * 64 * 128;
        const int ncv = (t0 + 15 >= 31) ? ((t0 + 15 - 31) >> 4) + 1 : 0;
        const int nch = (ncv + 31) >> 5;
        attn_init<3>(o, m, l);
        const int dq0 = t - 31 - 16 * 8 * fq;
        RangeIt it{0, nch - 1};
        attn_run<false, false>(it, Kb, 64, VTb, 128, fr, fq, [&](int kc0, const KVFrag& f) {
            const int dq = dq0 - 16 * kc0;
            attn_compute<3, true>(f, qf, o, m, l, [&](int g, int j, float raw) { const int dist = dq - 16 * j; return dist >= 0 ? raw * SCL2 - sl[g] * (float)dist : MASKV; });
        });
        float il[3];
#pragma unroll
        for (int g = 0; g < 3; ++g) {
            const float lt = lsum4(l[g]); il[g] = lt > 0.f ? __builtin_amdgcn_rcpf(lt) : 0.f;
            const float gate = sigmoidf_fast(gl[g * 3 + 0]);
#pragma unroll
            for (int dt = 0; dt < 4; ++dt) otv[(g * 4 + dt) * 64] = o[g][dt] * (il[g] * gate);
        }
        float carry_prev = 0.f;
        for (int c = 0; c < nch; ++c) {
            const int kc0 = c * 32, dq = dq0 - 16 * kc0;
            const bf16_t* kp = Kb + (size_t)(kc0 + (fr >> 2) * 8 + (fr & 3)) * 64 + fq * 8;
            const bf16x8 k00 = *(const bf16x8*)(kp), k01 = *(const bf16x8*)(kp + 32), k10 = *(const bf16x8*)(kp + 256), k11 = *(const bf16x8*)(kp + 256 + 32);
            float pc[8];
#pragma unroll
            for (int j = 0; j < 8; ++j) pc[j] = 0.f;
#pragma unroll
            for (int g = 0; g < 3; ++g) {
                f32x4 s0 = (f32x4){0.f, 0.f, 0.f, 0.f}, s1 = s0;
                s0 = __builtin_amdgcn_mfma_f32_16x16x32_bf16(k00, qf[g][0], s0, 0, 0, 0); s0 = __builtin_amdgcn_mfma_f32_16x16x32_bf16(k01, qf[g][1], s0, 0, 0, 0);
                s1 = __builtin_amdgcn_mfma_f32_16x16x32_bf16(k10, qf[g][0], s1, 0, 0, 0); s1 = __builtin_amdgcn_mfma_f32_16x16x32_bf16(k11, qf[g][1], s1, 0, 0, 0);
#pragma unroll
                for (int j = 0; j < 8; ++j) {
                    const int dist = dq - 16 * j; const float raw = j < 4 ? s0[j] : s1[j - 4];
                    if (dist >= 0) pc[j] += __builtin_amdgcn_exp2f(raw * SCL2 - sl[g] * (float)dist - m[g]) * il[g];
                }
            }
            const float cout = 0.5f * pc[7];
            float cin = __shfl_up(cout, 16);
            const float cwrap = __shfl(cout, fr + 48);
            if (fq == 0) cin = carry_prev;
            carry_prev = cwrap;
            const int n0 = (kc0 >> 2) + 2 * fq;
            ps[fr * 32 + n0] = cin + pc[0] + pc[1] + pc[2] + 0.5f * pc[3];
            ps[fr * 32 + n0 + 1] = 0.5f * pc[3] + pc[4] + pc[5] + pc[6] + 0.5f * pc[7];
        }
    }
    lds_wave_sync();
    if (lane < 16) {
        unsigned mask = 1u | (1u << cur); if (cur >= 1) mask |= 1u << (cur - 1);
        if (cur >= 3) {
            if (cur - 2 <= 5) mask |= (1u << (cur - 1)) - 2u;
            else {
                const float* my = ps + lane * 32;
                for (int r = 0; r < 5; ++r) {
                    float best = -1.0f; int bi = 1;
                    for (int j = 1; j <= cur - 2; ++j) { const float v = my[j]; if (!((mask >> j) & 1u) && v > best) { best = v; bi = j; } }
                    mask |= 1u << bi;
                }
            }
        }
        msk[lane] = mask;
    }
    lds_wave_sync();
    const unsigned qmask = msk[fr];
    lds_wave_sync();
    {
        const bf16_t* Kb = p.kF + ((size_t)b * NVH + 6 + kv) * 64 * SEQ;
        const bf16_t* VTb = p.vT + ((size_t)b * NVH + 6 + kv) * 64 * SEQ;
        attn_init<3>(o, m, l);
        unsigned um = qmask;
        um |= __shfl_xor(um, 1); um |= __shfl_xor(um, 2); um |= __shfl_xor(um, 4); um |= __shfl_xor(um, 8);
        um = (unsigned)__builtin_amdgcn_readfirstlane((int)um) & (cur >= 31 ? 0xffffffffu : ((2u << cur) - 1u));
        unsigned long long cm = 0ull;
        for (unsigned r = um; r; r &= r - 1) { const int kb = __builtin_ctz(r); cm |= 3ull << (2 * kb); }
        MaskIt it{cm};
        attn_run<false, true>(it, Kb, NMAIN, VTb, SEQ, fr, fq, [&](int kc0, const KVFrag& f) {
            const bool mine = (qmask >> (kc0 >> 6)) & 1u;
            const int dq = t - kc0 - 8 * fq;
            attn_compute<3, true>(f, qf, o, m, l, [&](int g, int j, float raw) { const int dist = dq - j; return (mine && dist >= 0) ? raw * SCL2 - sl[g] * (float)dist : MASKV; });
        });
#pragma unroll
        for (int g = 0; g < 3; ++g) {
            const float lt = lsum4(l[g]); const float sc = (lt > 0.f ? __builtin_amdgcn_rcpf(lt) : 0.f) * sigmoidf_fast(gl[g * 3 + 1]);
#pragma unroll
            for (int dt = 0; dt < 4; ++dt) otv[(g * 4 + dt) * 64] += o[g][dt] * sc;
        }
    }
    {
        const bf16_t* Kb = p.kF + ((size_t)b * NVH + 8 + kv) * 64 * SEQ;
        const bf16_t* VTb = p.vT + ((size_t)b * NVH + 8 + kv) * 64 * SEQ;
        attn_init<3>(o, m, l);
        RangeIt it{max(0, t0 - 511) >> 5, (t0 + 15) >> 5};
        attn_run<false, true>(it, Kb, NMAIN, VTb, SEQ, fr, fq, [&](int kc0, const KVFrag& f) {
            const int dq = t - kc0 - 8 * fq;
            attn_compute<3, true>(f, qf, o, m, l, [&](int g, int j, float raw) { const int dist = dq - j; return (dist >= 0 && dist < 512) ? raw * SCL2 - sl[g] * (float)dist : MASKV; });
        });
#pragma unroll
        for (int g = 0; g < 3; ++g) {
            const float lt = lsum4(l[g]); const float sc = (lt > 0.f ? __builtin_amdgcn_rcpf(lt) : 0.f) * sigmoidf_fast(gl[g * 3 + 2]);
            bf16_t* dst = p.ob + ((size_t)b * SEQ + t) * DM + 640 + (kv * 3 + g) * 64 + 4 * fq;
#pragma unroll
            for (int dt = 0; dt < 4; ++dt) store_o4(dst + dt * 16, otv[(g * 4 + dt) * 64] + o[g][dt] * sc);
        }
    }
}

template <bool WITH_CONV>
__device__ __forceinline__ void phase_attn(const Params& p, int l, char* lds, int cslot = 16) {
    int tid = threadIdx.x; asm volatile("" : "+v"(tid));
    const int wid = tid >> 6, lane = tid & 63, fr = lane & 15, fq = lane >> 4;
    float* ps = (float*)(lds + wid * 16896); unsigned* msk = (unsigned*)(ps + 512); float* otl = ps + 576;
    unsigned* ctr = p.ctrl + cslot + l;
    constexpr unsigned NU_NSA = NB * 2 * 128, NU_FOX = NB * 4 * 64, NU_SWA = NB * 2 * 128, NU_ATT = NU_NSA + NU_FOX + NU_SWA;
    static_assert(!WITH_CONV || CONV_TILES == (int)NU_ATT, "queue interleave: one conversion tile per attention unit");
    for (;;) {
        unsigned u = 0;
        if (lane == 0) u = __hip_atomic_fetch_add(ctr, 1u, __ATOMIC_RELAXED, __HIP_MEMORY_SCOPE_AGENT);
        u = (unsigned)__builtin_amdgcn_readfirstlane((int)u);
        if (WITH_CONV) {
            if (u >= 2 * NU_ATT) break;
            if (u & 1u) { conv_tile_wave(p, (int)(u >> 1), lane, (unsigned char*)ps); continue; }
            u >>= 1;
        } else {
#ifndef ATT_REP
#define ATT_REP 1
#endif
            if (u >= ATT_REP * NU_ATT) break;
            if (ATT_REP > 1) u %= NU_ATT;
        }
        if (u < NU_NSA) { const int pos = 127 - (int)(u & 127), r = u >> 7; nsa_unit(p, r >> 1, r & 1, pos, fr, fq, lane, ps, msk, otl); }
        else if (u < NU_NSA + NU_FOX) { const unsigned v = u - NU_NSA; const int qb = 63 - (int)(v & 63), r = v >> 6; fox_unit(p, r >> 2, r & 3, qb, fr, fq); }
        else { const unsigned v = u - NU_NSA - NU_FOX; const int pos = 127 - (int)(v & 127), r = v >> 7; swa_unit(p, l, r >> 1, r & 1, pos, fr, fq); }
    }
}

__device__ __forceinline__ void phase_ln1_router(const Params& p, int l, char* lds) {
    int tid = threadIdx.x; asm volatile("" : "+v"(tid));
    const int wid = tid >> 6, lane = tid & 63, fr = lane & 15, fq = lane >> 4;
    float* lg = (float*)lds + wid * 512;
    int* lcnt = (int*)(lds + 16384); int* lbase = lcnt + 32;
    const float* g1 = p.ln1_g + l * DM; const float* b1 = p.ln1_b + l * DM;
    const float* rw = p.rwT + (size_t)l * NE * 1024; const float* rb = p.router_b + l * NE;
    unsigned* gcount = p.ctrl + 64 + l * NE;
    for (int grp = blockIdx.x; grp < NTOK / 128; grp += gridDim.x) {
        const int tok0 = grp * 128 + wid * 16;
        if (tid < 32) lcnt[tid] = 0;
        float4 gg[4], bb[4];
#pragma unroll
        for (int j = 0; j < 4; ++j) { gg[j] = *(const float4*)(g1 + j * 256 + lane * 4); bb[j] = *(const float4*)(b1 + j * 256 + lane * 4); }
        for (int r0 = 0; r0 < 16; r0 += 4) {
            float4 v[4][4]; float s[4], qv[4];
#pragma unroll
            for (int i = 0; i < 4; ++i)
#pragma unroll
                for (int j = 0; j < 4; ++j) v[i][j] = *(const float4*)(p.tbuf + (size_t)(tok0 + r0 + i) * DM + j * 256 + lane * 4);
#pragma unroll
            for (int i = 0; i < 4; ++i) { s[i] = 0.f;
#pragma unroll
                for (int j = 0; j < 4; ++j) s[i] += (v[i][j].x + v[i][j].y) + (v[i][j].z + v[i][j].w); }
#pragma unroll
            for (int o = 32; o > 0; o >>= 1) {
#pragma unroll
                for (int i = 0; i < 4; ++i) s[i] += __shfl_xor(s[i], o); }
#pragma unroll
            for (int i = 0; i < 4; ++i) { const float mean = s[i] * (1.0f / 1024.0f); qv[i] = 0.f;
#pragma unroll
                for (int j = 0; j < 4; ++j) { v[i][j].x -= mean; v[i][j].y -= mean; v[i][j].z -= mean; v[i][j].w -= mean; qv[i] += (v[i][j].x * v[i][j].x + v[i][j].y * v[i][j].y) + (v[i][j].z * v[i][j].z + v[i][j].w * v[i][j].w); } }
#pragma unroll
            for (int o = 32; o > 0; o >>= 1) {
#pragma unroll
                for (int i = 0; i < 4; ++i) qv[i] += __shfl_xor(qv[i], o); }
#pragma unroll
            for (int i = 0; i < 4; ++i) {
                const float rstd = rsqrtf(qv[i] * (1.0f / 1024.0f) + LN_EPS);
                const size_t row = (size_t)(tok0 + r0 + i);
#pragma unroll
                for (int j = 0; j < 4; ++j) {
                    const int c = j * 256 + lane * 4;
                    float4 y; y.x = v[i][j].x * rstd * gg[j].x + bb[j].x; y.y = v[i][j].y * rstd * gg[j].y + bb[j].y; y.z = v[i][j].z * rstd * gg[j].z + bb[j].z; y.w = v[i][j].w * rstd * gg[j].w + bb[j].w;
                    *(float4*)(p.x1f + row * DM + c) = y;
                    *(unsigned*)((char*)p.x1b + row * DM + c) = pack4_fp8(y.x, y.y, y.z, y.w);
                }
            }
        }
        __syncthreads();
        f32x4 a0 = (f32x4){0.f, 0.f, 0.f, 0.f}, a1 = a0;
        const float* xr = p.x1f + (size_t)(tok0 + fr) * DM + 4 * fq;
        const float* w0 = rw + (size_t)fr * 1024 + 4 * fq; const float* w1 = rw + (size_t)(16 + fr) * 1024 + 4 * fq;
#pragma unroll 4
        for (int k0 = 0; k0 < 1024; k0 += 16) {
            const float4 xa = *(const float4*)(xr + k0), wb0 = *(const float4*)(w0 + k0), wb1 = *(const float4*)(w1 + k0);
            a0 = __builtin_amdgcn_mfma_f32_16x16x4f32(xa.x, wb0.x, a0, 0, 0, 0); a1 = __builtin_amdgcn_mfma_f32_16x16x4f32(xa.x, wb1.x, a1, 0, 0, 0);
            a0 = __builtin_amdgcn_mfma_f32_16x16x4f32(xa.y, wb0.y, a0, 0, 0, 0); a1 = __builtin_amdgcn_mfma_f32_16x16x4f32(xa.y, wb1.y, a1, 0, 0, 0);
            a0 = __builtin_amdgcn_mfma_f32_16x16x4f32(xa.z, wb0.z, a0, 0, 0, 0); a1 = __builtin_amdgcn_mfma_f32_16x16x4f32(xa.z, wb1.z, a1, 0, 0, 0);
            a0 = __builtin_amdgcn_mfma_f32_16x16x4f32(xa.w, wb0.w, a0, 0, 0, 0); a1 = __builtin_amdgcn_mfma_f32_16x16x4f32(xa.w, wb1.w, a1, 0, 0, 0);
        }
#pragma unroll
        for (int r = 0; r < 4; ++r) { lg[(fq * 4 + r) * 32 + fr] = a0[r] + rb[fr]; lg[(fq * 4 + r) * 32 + 16 + fr] = a1[r] + rb[16 + fr]; }
        lds_wave_sync();
        int e4[4] = {0, 0, 0, 0}; int rk[4] = {0, 0, 0, 0};
        if (lane < 16) {
            const float* my = lg + lane * 32; unsigned taken = 0u; float tv[4];
#pragma unroll
            for (int k = 0; k < 4; ++k) {
                float best = NEG_INF; int bi = 0;
                for (int e = 0; e < 32; ++e) { const float xv = my[e]; if (!((taken >> e) & 1u) && xv > best) { best = xv; bi = e; } }
                taken |= 1u << bi; e4[k] = bi; tv[k] = best;
            }
            const float e1 = __expf(tv[1] - tv[0]), e2 = __expf(tv[2] - tv[0]), e3 = __expf(tv[3] - tv[0]);
            const float inv = 1.0f / (1.0f + e1 + e2 + e3);
            const size_t row = (size_t)(tok0 + lane);
            *(float4*)(p.gw + row * 4) = make_float4(inv, e1 * inv, e2 * inv, e3 * inv);
        }
        __syncthreads();
        if (lane < 16) {
#pragma unroll
            for (int k = 0; k < 4; ++k) rk[k] = atomicAdd(&lcnt[e4[k]], 1);
        }
        __syncthreads();
        if (tid < 32) { const int c = lcnt[tid]; lbase[tid] = c ? (int)__hip_atomic_fetch_add(gcount + tid, (unsigned)c, __ATOMIC_RELAXED, __HIP_MEMORY_SCOPE_AGENT) : 0; }
        __syncthreads();
        if (lane < 16) {
            const int row = tok0 + lane; int pk[4];
#pragma unroll
            for (int k = 0; k < 4; ++k) { const int pos = lbase[e4[k]] + rk[k]; p.lists[(size_t)e4[k] * LIST_CAP + pos] = row * 4 + k; pk[k] = (pos << 5) | e4[k]; }
            *(int4*)(p.top_e + (size_t)row * 4) = make_int4(pk[0], pk[1], pk[2], pk[3]);
        }
        __syncthreads();
    }
}

__device__ __forceinline__ void phase_ln2(const Params& p, int l, float* xout, char* lds) {
    int* ptile = (int*)(lds + LDS_TAB); int* ecnt = ptile + 40;
    build_tiles(p, l, ptile, ecnt);
    int tid = threadIdx.x; asm volatile("" : "+v"(tid));
    const int wid = tid >> 6, lane = tid & 63;
    const float* g2 = p.ln2_g + l * DM; const float* b2 = p.ln2_b + l * DM;
    float4 gg[4], bb[4];
#pragma unroll
    for (int j = 0; j < 4; ++j) { gg[j] = *(const float4*)(g2 + j * 256 + lane * 4); bb[j] = *(const float4*)(b2 + j * 256 + lane * 4); }
    for (int pr = blockIdx.x * NWV + wid; pr < NTOK / 2; pr += gridDim.x * NWV) {
        float4 v[2][4]; float s[2], qv[2];
        u32x2 yv[2][4][4]; float gk[2][4];
#pragma unroll
        for (int i = 0; i < 2; ++i) {
            const int row = pr * 2 + i;
            const float4 gwv = *(const float4*)(p.gw + (size_t)row * 4);
            gk[i][0] = gwv.x; gk[i][1] = gwv.y; gk[i][2] = gwv.z; gk[i][3] = gwv.w;
            const int4 te = *(const int4*)(p.top_e + (size_t)row * 4);
            const int tk[4] = {te.x, te.y, te.z, te.w};
#pragma unroll
            for (int j = 0; j < 4; ++j) v[i][j] = *(const float4*)(p.x1f + (size_t)row * DM + j * 256 + lane * 4);
#pragma unroll
            for (int k = 0; k < 4; ++k) {
                const bf16_t* yr = p.ybuf + (size_t)(ptile[tk[k] & 31] * 256 + (tk[k] >> 5)) * DM + lane * 4;
#pragma unroll
                for (int j = 0; j < 4; ++j) yv[i][k][j] = *(const u32x2*)(yr + j * 256);
            }
        }
#pragma unroll
        for (int i = 0; i < 2; ++i) { s[i] = 0.f;
#pragma unroll
            for (int j = 0; j < 4; ++j) {
                float4 a; a.x = v[i][j].x * ALPHA; a.y = v[i][j].y * ALPHA; a.z = v[i][j].z * ALPHA; a.w = v[i][j].w * ALPHA;
#pragma unroll
                for (int k = 0; k < 4; ++k) {
                    const u32x2 w = yv[i][k][j];
                    a.x += gk[i][k] * __uint_as_float(w.x << 16); a.y += gk[i][k] * __uint_as_float(w.x & 0xffff0000u);
                    a.z += gk[i][k] * __uint_as_float(w.y << 16); a.w += gk[i][k] * __uint_as_float(w.y & 0xffff0000u);
                }
                v[i][j] = a; s[i] += (a.x + a.y) + (a.z + a.w);
            } }
#pragma unroll
        for (int o = 32; o > 0; o >>= 1) { s[0] += __shfl_xor(s[0], o); s[1] += __shfl_xor(s[1], o); }
#pragma unroll
        for (int i = 0; i < 2; ++i) { const float mean = s[i] * (1.0f / 1024.0f); qv[i] = 0.f;
#pragma unroll
            for (int j = 0; j < 4; ++j) { v[i][j].x -= mean; v[i][j].y -= mean; v[i][j].z -= mean; v[i][j].w -= mean; qv[i] += (v[i][j].x * v[i][j].x + v[i][j].y * v[i][j].y) + (v[i][j].z * v[i][j].z + v[i][j].w * v[i][j].w); } }
#pragma unroll
        for (int o = 32; o > 0; o >>= 1) { qv[0] += __shfl_xor(qv[0], o); qv[1] += __shfl_xor(qv[1], o); }
#pragma unroll
        for (int i = 0; i < 2; ++i) {
            const float rstd = rsqrtf(qv[i] * (1.0f / 1024.0f) + LN_EPS);
            const size_t row = (size_t)(pr * 2 + i);
#pragma unroll
            for (int j = 0; j < 4; ++j) {
                const int c = j * 256 + lane * 4;
                float4 y; y.x = v[i][j].x * rstd * gg[j].x + bb[j].x; y.y = v[i][j].y * rstd * gg[j].y + bb[j].y; y.z = v[i][j].z * rstd * gg[j].z + bb[j].z; y.w = v[i][j].w * rstd * gg[j].w + bb[j].w;
                *(float4*)(xout + row * DM + c) = y;
                u32x2 w; w.x = pack2(y.x, y.y); w.y = pack2(y.z, y.w);
                *(u32x2*)(p.xb + row * DM + c) = w;
            }
        }
    }
}

#define XB_TMO      128
#define XB_XCNT(j)  (256  + 64 * (j))
#define XB_XSUB(j)  (1280 + 64 * (j))
#define XB_XGEN(j)  (2304 + 64 * (j))
#define XB_TOP      3328
#define XB_TOPGEN   3392
#define XCD_BAR_WORDS 3456
#define XB_SPIN_CAP (1u << 22)
__device__ __forceinline__ unsigned xb_ld(unsigned* p)              { return __hip_atomic_load(p, __ATOMIC_RELAXED, __HIP_MEMORY_SCOPE_AGENT); }
__device__ __forceinline__ unsigned xb_add(unsigned* p, unsigned v) { return __hip_atomic_fetch_add(p, v, __ATOMIC_RELAXED, __HIP_MEMORY_SCOPE_AGENT); }
__device__ __forceinline__ unsigned xb_xcc_id() { return (unsigned)__builtin_amdgcn_s_getreg((3 << 11) | 20) & 0xFu; }
#define XB_SPIN(cond, bar) do { unsigned _sp = 0; while (cond) { __builtin_amdgcn_s_sleep(1); \
    if ((++_sp & 255u) == 0u) { if (xb_ld(&(bar)[XB_TMO])) break; if (_sp > XB_SPIN_CAP) { atomicAdd(&(bar)[XB_TMO], 1u); break; } } } } while (0)
struct XcdBarrier { unsigned* bar; unsigned x; volatile LAS unsigned* st; };
__device__ __forceinline__ XcdBarrier xcd_barrier_post(unsigned* bar, volatile LAS unsigned* st) {
    XcdBarrier b; b.bar = bar; b.x = xb_xcc_id(); b.st = st;
    if (threadIdx.x == 0) (void)xb_add(&bar[XB_XCNT(b.x)], 1u);
    return b;
}
__device__ __forceinline__ void xcd_barrier_complete(unsigned* bar, unsigned x, unsigned& nloc, unsigned& nx) {
    const unsigned G = gridDim.x * gridDim.y * gridDim.z;
    unsigned sum, cnt, mine, sp = 0u;
    for (;;) {
        sum = 0u; cnt = 0u; mine = 0u;
#pragma unroll
        for (unsigned j = 0; j < 16; ++j) { const unsigned c = xb_ld(&bar[XB_XCNT(j)]); sum += c; cnt += (c > 0u) ? 1u : 0u; mine = (j == x) ? c : mine; }
        if (sum == G) break;
        __builtin_amdgcn_s_sleep(1);
        if ((++sp & 255u) == 0u) { if (xb_ld(&bar[XB_TMO])) break; if (sp > XB_SPIN_CAP) { atomicAdd(&bar[XB_TMO], 1u); break; } }
    }
    nloc = mine > 0u ? mine : 1u; nx = cnt > 0u ? cnt : 1u;
}
__device__ __forceinline__ void xcd_barrier(const XcdBarrier& b) {
    asm volatile("s_waitcnt vmcnt(0)" ::: "memory");
    __syncthreads();
    if (threadIdx.x == 0) {
        unsigned* bar = b.bar;
        __builtin_amdgcn_s_waitcnt(0);
        unsigned nloc = b.st[0], nx = b.st[1];
        if (nloc == 0u) { xcd_barrier_complete(bar, b.x, nloc, nx); b.st[0] = nloc; b.st[1] = nx; }
        const unsigned old = xb_add(&bar[XB_XSUB(b.x)], 1u);
        const unsigned gen = old / nloc;
        if (old + 1u == (gen + 1u) * nloc) {
            __builtin_amdgcn_fence(__ATOMIC_RELEASE, "agent");
            asm volatile("s_waitcnt vmcnt(0)" ::: "memory");
            const unsigned og = xb_add(&bar[XB_TOP], 1u);
            const unsigned tg = og / nx;
            if (og + 1u == (tg + 1u) * nx) xb_add(&bar[XB_TOPGEN], 1u);
            else XB_SPIN(xb_ld(&bar[XB_TOPGEN]) == tg, bar);
            __builtin_amdgcn_fence(__ATOMIC_ACQUIRE, "agent");
            xb_add(&bar[XB_XGEN(b.x)], 1u);
            asm volatile("s_waitcnt vmcnt(0)" ::: "memory");
        } else {
            XB_SPIN(xb_ld(&bar[XB_XGEN(b.x)]) == gen, bar);
            __builtin_amdgcn_fence(__ATOMIC_ACQUIRE, "agent");
            asm volatile("s_waitcnt vmcnt(0)" ::: "memory");
        }
    }
    __syncthreads();
}

struct KArgs { const float* in[18]; float* out; char* ws; };
constexpr size_t al256(size_t v) { return (v + 255) / 256 * 256; }
struct WSL {
    static constexpr size_t ctrl = 0;
    static constexpr size_t WinT = al256(ctrl + 65536);
    static constexpr size_t WoT = al256(WinT + (size_t)NL * NPAD * 1024 * 2);
    static constexpr size_t W1T = al256(WoT + (size_t)NL * 1024 * 1024 * 2);
    static constexpr size_t W2T = al256(W1T + (size_t)NL * 2 * 64 * 2048 * 2);
    static constexpr size_t WguT = al256(W2T + (size_t)NL * 2 * 64 * 64 * 2);
    static constexpr size_t WdnT = al256(WguT + (size_t)NL * NE * 2048 * 1024 * 2);
    static constexpr size_t rwT = al256(WdnT + (size_t)NL * NE * 1024 * 1024 * 2);
    static constexpr size_t binp = al256(rwT + (size_t)NL * NE * 1024 * 4);
    static constexpr size_t bgup = al256(binp + (size_t)NL * NPAD * 4);
    static constexpr size_t b1c = al256(bgup + (size_t)NL * NE * 2048 * 4);
    static constexpr size_t xf = al256(b1c + 4 * 64 * 4);
    static constexpr size_t xb = al256(xf + (size_t)NTOK * DM * 4);
    static constexpr size_t hb = al256(xb + (size_t)NTOK * DM * 2);
    static constexpr size_t hs = al256(hb + (size_t)NTOK * NMAIN * 2);
    static constexpr size_t vT = al256(hs + (size_t)NTOK * HS_W * 4);
    static constexpr size_t kF = al256(vT + (size_t)NB * NVH * 64 * SEQ * 2);
    static constexpr size_t cF = al256(kF + (size_t)NB * NVH * 64 * SEQ * 2);
    static constexpr size_t kc = al256(cF + (size_t)NB * 4 * SEQ * 4);
    static constexpr size_t vc = al256(kc + (size_t)NB * 2 * 128 * 64 * 2);
    static constexpr size_t vcT = al256(vc + (size_t)NB * 2 * 128 * 64 * 2);
    static constexpr size_t ob = al256(vcT + (size_t)NB * 2 * 128 * 64 * 2);
    static constexpr size_t tbuf = al256(ob + (size_t)NTOK * DM * 2);
    static constexpr size_t x1f = al256(tbuf + (size_t)NTOK * DM * 4);
    static constexpr size_t x1b = al256(x1f + (size_t)NTOK * DM * 4);
    static constexpr size_t top_e = al256(x1b + (size_t)NTOK * DM * 2);
    static constexpr size_t gw = al256(top_e + (size_t)NTOK * 4 * 4);
    static constexpr size_t lists = al256(gw + (size_t)NTOK * 4 * 4);
    static constexpr size_t act = al256(lists + (size_t)NE * LIST_CAP * 4);
    static constexpr size_t ybuf = al256(act + (size_t)MAXSLOT * DFF * 2);
    static constexpr size_t total = al256(ybuf + (size_t)MAXSLOT * DM * 2);
};
__device__ __forceinline__ Params make_params(const KArgs& k) {
    Params p;
    p.x = k.in[0]; p.w_in = k.in[1]; p.b_in = k.in[2]; p.sinks = k.in[3]; p.cmp_pe = k.in[4]; p.cmp_w1 = k.in[5]; p.cmp_w2 = k.in[6]; p.w_out = k.in[7];
    p.ln1_g = k.in[8]; p.ln1_b = k.in[9]; p.router_w = k.in[10]; p.router_b = k.in[11]; p.w_gu = k.in[12]; p.b_gu = k.in[13]; p.w_dn = k.in[14]; p.b_dn = k.in[15];
    p.ln2_g = k.in[16]; p.ln2_b = k.in[17]; p.out = k.out;
    char* w = k.ws;
    p.ctrl = (unsigned*)(w + WSL::ctrl); p.WinT = (bf16_t*)(w + WSL::WinT); p.WoT = (bf16_t*)(w + WSL::WoT); p.W1T = (bf16_t*)(w + WSL::W1T); p.W2T = (bf16_t*)(w + WSL::W2T);
    p.WguT = (bf16_t*)(w + WSL::WguT); p.WdnT = (bf16_t*)(w + WSL::WdnT); p.rwT = (float*)(w + WSL::rwT); p.binp = (float*)(w + WSL::binp); p.bgup = (float*)(w + WSL::bgup);
    p.b1c = (float*)(w + WSL::b1c); p.xf = (float*)(w + WSL::xf); p.xb = (bf16_t*)(w + WSL::xb); p.hb = (bf16_t*)(w + WSL::hb); p.hs = (float*)(w + WSL::hs); p.vT = (bf16_t*)(w + WSL::vT); p.kF = (bf16_t*)(w + WSL::kF);
    p.cF = (float*)(w + WSL::cF); p.kc = (bf16_t*)(w + WSL::kc); p.vc = (bf16_t*)(w + WSL::vc); p.vcT = (bf16_t*)(w + WSL::vcT); p.ob = (bf16_t*)(w + WSL::ob); p.tbuf = (float*)(w + WSL::tbuf);
    p.x1f = (float*)(w + WSL::x1f); p.x1b = (bf16_t*)(w + WSL::x1b); p.top_e = (int*)(w + WSL::top_e); p.gw = (float*)(w + WSL::gw); p.lists = (int*)(w + WSL::lists);
    p.act = (bf16_t*)(w + WSL::act); p.ybuf = (bf16_t*)(w + WSL::ybuf);
    return p;
}
__device__ __forceinline__ void grid_bar(const Params& p, char* lds) {
    XcdBarrier xb; xb.bar = p.ctrl + 1024; xb.x = xb_xcc_id(); xb.st = (volatile LAS unsigned*)(lds + LDS_BYTES - 16); xcd_barrier(xb);
}
template <int L>
__device__ __forceinline__ void layer_fwd(const Params& p, char* lds) {
    const float* xin = L == 0 ? p.x : p.xf;
    float* xout = L == NL - 1 ? p.out : p.xf;
#ifndef REP
#define REP 0
#endif
    phase_inproj(p, L, lds);        grid_bar(p, lds);
    if (REP & 1) { phase_inproj(p, L, lds);        grid_bar(p, lds); }
    phase_prep(p, L, lds);          grid_bar(p, lds);
    if (REP & 2) { phase_prep(p, L, lds);          grid_bar(p, lds); }
    phase_attn<L == 0>(p, L, lds);  grid_bar(p, lds);
    if (REP & 4) { phase_attn<false>(p, L, lds, 24); grid_bar(p, lds); }
    phase_outproj(p, L, xin, lds);  grid_bar(p, lds);
    if (REP & 8) { phase_outproj(p, L, xin, lds);  grid_bar(p, lds); }
    phase_ln1_router(p, L, lds);    grid_bar(p, lds);
    phase_gateup(p, L, lds);        grid_bar(p, lds);
    if (REP & 16) { phase_gateup(p, L, lds);       grid_bar(p, lds); }
    phase_down(p, L, lds);          grid_bar(p, lds);
    if (REP & 32) { phase_down(p, L, lds);         grid_bar(p, lds); }
    phase_ln2(p, L, xout, lds);
    if (REP & 64) { grid_bar(p, lds); phase_ln2(p, L, xout, lds); }
}
__global__ void __launch_bounds__(NTHR, 2) fwd_kernel(KArgs ka) {
    extern __shared__ __attribute__((aligned(16))) char lds[];
    const Params p = make_params(ka);
    cg::grid_group grid = cg::this_grid();
    volatile LAS unsigned* xst = (volatile LAS unsigned*)(lds + LDS_BYTES - 16);
    if (threadIdx.x == 0) { xst[0] = 0u; xst[1] = 0u; }
    __syncthreads();
    (void)xcd_barrier_post(p.ctrl + 1024, xst);
    phase0(p, lds);
    if (REP & 128) { grid_bar(p, lds); phase0(p, lds); }
    grid.sync();
    layer_fwd<0>(p, lds);
    grid_bar(p, lds);
    layer_fwd<1>(p, lds);
}

extern "C" void kernel_launch(void* const* d_in, const int* in_sizes, int n_in, void* d_out, int out_size, void* d_ws, size_t ws_size, hipStream_t stream) {
    KArgs ka{};
    for (int i = 0; i < 18; ++i) ka.in[i] = (const float*)d_in[i];
    ka.out = (float*)d_out; ka.ws = (char*)d_ws;
    if (WSL::total > ws_size) { fprintf(stderr, "workspace too small: need %zu have %zu\n", (size_t)WSL::total, ws_size); return; }
    static int grid_blocks = 0;
    if (!grid_blocks) {
        int dev = 0, cus = 0, per_cu = 0;
        (void)hipGetDevice(&dev);
        (void)hipDeviceGetAttribute(&cus, hipDeviceAttributeMultiprocessorCount, dev);
        (void)hipFuncSetAttribute((const void*)fwd_kernel, hipFuncAttributeMaxDynamicSharedMemorySize, LDS_BYTES);
        (void)hipOccupancyMaxActiveBlocksPerMultiprocessor(&per_cu, fwd_kernel, NTHR, LDS_BYTES);
        if (per_cu < 1) { fprintf(stderr, "occupancy query says 0 blocks per CU\n"); per_cu = 1; }
        grid_blocks = cus;
    }
    (void)hipMemsetAsync(d_ws, 0, 65536, stream);
    void* args[] = {&ka};
    hipError_t e = hipLaunchCooperativeKernel((const void*)fwd_kernel, dim3(grid_blocks), dim3(NTHR), args, LDS_BYTES, stream);
    if (e != hipSuccess) fprintf(stderr, "cooperative launch failed: %s (grid %d)\n", hipGetErrorString(e), grid_blocks);
}
```

```cpp
#include <hip/hip_runtime.h>
#include <hip/hip_cooperative_groups.h>
#include <cstdio>
#include <cstdint>
namespace cg = cooperative_groups;

typedef unsigned short bf16_t;
typedef short bf16x8 __attribute__((ext_vector_type(8)));
typedef float f32x4 __attribute__((ext_vector_type(4)));
typedef unsigned u32x4 __attribute__((ext_vector_type(4)));
typedef unsigned u32x2 __attribute__((ext_vector_type(2)));
typedef int v8i_t __attribute__((ext_vector_type(8)));
typedef int v4i_t __attribute__((ext_vector_type(4)));
#define LAS __attribute__((address_space(3)))
constexpr float NEG_INF = -__builtin_huge_valf();

constexpr int DM = 1024, NB = 16, SEQ = 2048, NTOK = NB * SEQ, NL = 2;
constexpr int NCOL = 2582, NMAIN = 2560, NPAD = 2688, NE = 32, DFF = 1024;
constexpr int C_FQ = 0, C_FK = 256, C_FV = 512, C_SQ = 768, C_SK = 1152, C_SV = 1280, C_NQ = 1408,
              C_NKC = 1792, C_NVC = 1920, C_NKS = 2048, C_NVS = 2176, C_NKW = 2304, C_NVW = 2432;
constexpr int HS_W = 32;
constexpr int NVH = 10;
constexpr int LIST_CAP = NTOK;
constexpr int MAXSLOT = NTOK * 4 + NE * 256;
constexpr float ALPHA = 1.41421356237f, LN_EPS = 1e-5f, QSCALE = 0.125f;
constexpr int NWV = 8, NTHR = NWV * 64;
constexpr int LDS_STAGE = 131072, LDS_TAB = LDS_STAGE, LDS_AOFF = LDS_STAGE + 2048, LDS_BYTES = LDS_AOFF + 20480 + 256;

struct Params {
    const float *x, *w_in, *b_in, *sinks, *cmp_pe, *cmp_w1, *cmp_w2, *w_out, *ln1_g, *ln1_b, *router_w, *router_b,
                *w_gu, *b_gu, *w_dn, *b_dn, *ln2_g, *ln2_b;
    float* out;
    unsigned* ctrl;
    bf16_t *WinT, *WoT, *W1T, *W2T, *WguT, *WdnT;
    float *rwT, *binp, *bgup, *b1c;
    float* xf; bf16_t* xb; bf16_t* hb; float* hs; bf16_t* vT; bf16_t* kF; float* cF;
    bf16_t *kc, *vc, *vcT; bf16_t* ob; float* tbuf; float* x1f; bf16_t* x1b;
    int* top_e; float* gw; int* lists; bf16_t* act; bf16_t* ybuf;
};

__device__ __forceinline__ float bf2f(bf16_t h) { return __uint_as_float(((unsigned)h) << 16); }
typedef __bf16 bf16x2_t __attribute__((ext_vector_type(2)));
__device__ __forceinline__ bf16_t f2bf(float f) { return __builtin_bit_cast(bf16_t, (__bf16)f); }
__device__ __forceinline__ unsigned pack2(float lo, float hi) { bf16x2_t v = {(__bf16)lo, (__bf16)hi}; return __builtin_bit_cast(unsigned, v); }
__device__ __forceinline__ unsigned pack4_fp8(float a, float b, float c, float d) {
    unsigned w = 0u;
    w = __builtin_amdgcn_cvt_pk_fp8_f32(a, b, w, false);
    w = __builtin_amdgcn_cvt_pk_fp8_f32(c, d, w, true);
    return w;
}
__device__ __forceinline__ float wave_sum(float v) {
#pragma unroll
    for (int o = 32; o > 0; o >>= 1) v += __shfl_xor(v, o);
    return v;
}
__device__ __forceinline__ float wave_max(float v) {
#pragma unroll
    for (int o = 32; o > 0; o >>= 1) v = fmaxf(v, __shfl_xor(v, o));
    return v;
}
__device__ __forceinline__ void lds_wave_sync() { asm volatile("s_waitcnt lgkmcnt(0)" ::: "memory"); __builtin_amdgcn_wave_barrier(); }
__device__ __forceinline__ float slope_swa(int hq) { return exp2f(-8.0f * (float)(2 * hq + 1) / 12.0f); }
__device__ __forceinline__ float slope_nsa(int hq) { return exp2f(-8.0f * (float)(2 * hq + 2) / 12.0f); }

__device__ __forceinline__ int perm_row(int perm, int n) {
    if (perm == 1) { if (n < 768) return n; if (n < 772) return 2560 + (n - 768); if (n < 2564) return n - 4; return n; }
    if (perm == 2) { const int f = n >> 1, s = n & 1; return (f >> 7) * 256 + s * 128 + (f & 127); }
    return n;
}
struct ConvJob { const float* src; bf16_t* dst; int K, N, kt, nt, perm; float q8; };
__device__ __forceinline__ bool conv_job(const Params& p, int t, ConvJob& jb) {
    constexpr int T_WIN = NL * 8 * 21, T_WO = NL * 8 * 8;
    if (t < T_WIN) { const int m = t / 168, r = t % 168; jb = ConvJob{p.w_in + (size_t)m * 1024 * NCOL, p.WinT + (size_t)m * NPAD * 1024, 1024, NCOL, r / 21, r % 21, 1, 0.f}; return true; }
    t -= T_WIN;
    if (t < T_WO) { const int m = t / 64, r = t % 64; jb = ConvJob{p.w_out + (size_t)m * 1024 * 1024, p.WoT + (size_t)m * 1024 * 1024, 1024, 1024, r / 8, r % 8, 0, 0.f}; return true; }
    return false;
}
constexpr int CONV_TILES = NL * NE * 192;
__device__ __forceinline__ void conv_tile_wave(const Params& p, int t, int lane, unsigned char* l8) {
    asm volatile("" : "+v"(lane));
    const int m = t / 192, r = t % 192;
    const float* src; unsigned char* dst; int N, kt, nt, perm;
    if (r < 128) { src = p.w_gu + (size_t)m * 1024 * 2048; dst = (unsigned char*)p.WguT + (size_t)m * 2048 * 1024; N = 2048; kt = r >> 4; nt = r & 15; perm = 2; }
    else { const int q = r - 128; src = p.w_dn + (size_t)m * 1024 * 1024; dst = (unsigned char*)p.WdnT + (size_t)m * 1024 * 1024; N = 1024; kt = q >> 3; nt = q & 7; perm = 0; }
    const float* s = src + (size_t)(kt * 128 + (lane >> 5)) * N + nt * 128 + (lane & 31) * 4;
    unsigned char* lw = l8 + (lane >> 5) * 132 + (lane & 31) * 4;
    float4 va[16], vb[16];
#pragma unroll
    for (int i = 0; i < 16; ++i) va[i] = *(const float4*)(s + (size_t)(2 * i) * N);
#pragma unroll
    for (int i = 0; i < 16; ++i) vb[i] = *(const float4*)(s + (size_t)(32 + 2 * i) * N);
#pragma unroll
    for (int i = 0; i < 16; ++i) *(unsigned*)(lw + (2 * i) * 132) = pack4_fp8(va[i].x * 64.0f, va[i].y * 64.0f, va[i].z * 64.0f, va[i].w * 64.0f);
#pragma unroll
    for (int i = 0; i < 16; ++i) va[i] = *(const float4*)(s + (size_t)(64 + 2 * i) * N);
#pragma unroll
    for (int i = 0; i < 16; ++i) *(unsigned*)(lw + (32 + 2 * i) * 132) = pack4_fp8(vb[i].x * 64.0f, vb[i].y * 64.0f, vb[i].z * 64.0f, vb[i].w * 64.0f);
#pragma unroll
    for (int i = 0; i < 16; ++i) vb[i] = *(const float4*)(s + (size_t)(96 + 2 * i) * N);
#pragma unroll
    for (int i = 0; i < 16; ++i) *(unsigned*)(lw + (64 + 2 * i) * 132) = pack4_fp8(va[i].x * 64.0f, va[i].y * 64.0f, va[i].z * 64.0f, va[i].w * 64.0f);
#pragma unroll
    for (int i = 0; i < 16; ++i) *(unsigned*)(lw + (96 + 2 * i) * 132) = pack4_fp8(vb[i].x * 64.0f, vb[i].y * 64.0f, vb[i].z * 64.0f, vb[i].w * 64.0f);
    lds_wave_sync();
#pragma unroll 4
    for (int i = 0; i < 16; ++i) {
        const int idx = lane + 64 * i, kc = idx & 7, nn = idx >> 3;
        const unsigned char* l = l8 + (kc * 16) * 132 + nn;
        u32x4 w;
        w.x = (unsigned)l[0] | ((unsigned)l[132] << 8) | ((unsigned)l[264] << 16) | ((unsigned)l[396] << 24);
        w.y = (unsigned)l[528] | ((unsigned)l[660] << 8) | ((unsigned)l[792] << 16) | ((unsigned)l[924] << 24);
        w.z = (unsigned)l[1056] | ((unsigned)l[1188] << 8) | ((unsigned)l[1320] << 16) | ((unsigned)l[1452] << 24);
        w.w = (unsigned)l[1584] | ((unsigned)l[1716] << 8) | ((unsigned)l[1848] << 16) | ((unsigned)l[1980] << 24);
        *(u32x4*)(dst + (size_t)perm_row(perm, nt * 128 + nn) * 1024 + kt * 128 + kc * 16) = w;
    }
    lds_wave_sync();
}
__device__ __forceinline__ void conv_load(const ConvJob& jb, int tid, float2 (&v)[16]) {
    const int n = jb.nt * 128 + (tid & 31) * 4;
    const float* s = jb.src + (size_t)(jb.kt * 128 + (tid >> 5)) * jb.N + n;
#pragma unroll
    for (int i = 0; i < 8; ++i) {
        const float* r = s + (size_t)(16 * i) * jb.N;
        v[2 * i] = (n + 1 < jb.N) ? *(const float2*)r : make_float2(0.f, 0.f);
        v[2 * i + 1] = (n + 3 < jb.N) ? *(const float2*)(r + 2) : make_float2(0.f, 0.f);
    }
}
__device__ __forceinline__ void phase0(const Params& p, char* ldsc) {
    int tid = threadIdx.x; asm volatile("" : "+v"(tid));
    const int G = gridDim.x, bid = blockIdx.x;
    const size_t gtid = (size_t)bid * NTHR + tid, gthreads = (size_t)G * NTHR;
    {
        constexpr int TOT = NL * 8 * 21 + NL * 8 * 8;
        bf16_t* lt = (bf16_t*)ldsc;
        ConvJob jb, jn; float2 v[16], vn[16];
        int t = bid; bool have = t < TOT && conv_job(p, t, jb);
        if (have) conv_load(jb, tid, v);
        while (have) {
            const int tn = t + G; const bool hn = tn < TOT && conv_job(p, tn, jn);
            if (hn) conv_load(jn, tid, vn);
            if (jb.q8 != 0.f) {
                unsigned char* l8 = (unsigned char*)lt;
#pragma unroll
                for (int i = 0; i < 8; ++i)
                    *(unsigned*)(l8 + ((tid >> 5) + 16 * i) * 132 + (tid & 31) * 4) = pack4_fp8(v[2 * i].x * jb.q8, v[2 * i].y * jb.q8, v[2 * i + 1].x * jb.q8, v[2 * i + 1].y * jb.q8);
                __syncthreads();
#pragma unroll
                for (int i = 0; i < 2; ++i) {
                    const int idx = tid + NTHR * i, kc = idx & 7, nn = idx >> 3, n = jb.nt * 128 + nn;
                    const unsigned char* l = l8 + (kc * 16) * 132 + nn;
                    u32x4 w;
                    w.x = (unsigned)l[0] | ((unsigned)l[132] << 8) | ((unsigned)l[264] << 16) | ((unsigned)l[396] << 24);
                    w.y = (unsigned)l[528] | ((unsigned)l[660] << 8) | ((unsigned)l[792] << 16) | ((unsigned)l[924] << 24);
                    w.z = (unsigned)l[1056] | ((unsigned)l[1188] << 8) | ((unsigned)l[1320] << 16) | ((unsigned)l[1452] << 24);
                    w.w = (unsigned)l[1584] | ((unsigned)l[1716] << 8) | ((unsigned)l[1848] << 16) | ((unsigned)l[1980] << 24);
                    *(u32x4*)((char*)jb.dst + (size_t)perm_row(jb.perm, n) * jb.K + jb.kt * 128 + kc * 16) = w;
                }
            } else {
#pragma unroll
                for (int i = 0; i < 8; ++i) {
                    u32x2 w; w.x = pack2(v[2 * i].x, v[2 * i].y); w.y = pack2(v[2 * i + 1].x, v[2 * i + 1].y);
                    *(u32x2*)(lt + ((tid >> 5) + 16 * i) * 136 + (tid & 31) * 4) = w;
                }
                __syncthreads();
#pragma unroll
                for (int i = 0; i < 4; ++i) {
                    const int idx = tid + NTHR * i, kc = idx & 15, nn = idx >> 4, n = jb.nt * 128 + nn;
                    if (n < jb.N) {
                        const bf16_t* l = lt + (kc * 8) * 136 + nn;
                        u32x4 w;
                        w.x = (unsigned)l[0] | ((unsigned)l[136] << 16); w.y = (unsigned)l[272] | ((unsigned)l[408] << 16);
                        w.z = (unsigned)l[544] | ((unsigned)l[680] << 16); w.w = (unsigned)l[816] | ((unsigned)l[952] << 16);
                        *(u32x4*)(jb.dst + (size_t)perm_row(jb.perm, n) * jb.K + jb.kt * 128 + kc * 8) = w;
                    }
                }
            }
            __syncthreads();
            t = tn; have = hn; jb = jn;
#pragma unroll
            for (int i = 0; i < 16; ++i) v[i] = vn[i];
        }
    }
    for (size_t i = gtid; i < (size_t)NL * 2 * 2048 * 64; i += gthreads) {
        const int k = (int)(i % 2048), n = (int)((i / 2048) % 64), m = (int)(i / (2048 * 64));
        p.W1T[i] = f2bf(p.cmp_w1[((size_t)m * 2048 + k) * 64 + n]);
    }
    for (size_t i = gtid; i < (size_t)NL * 2 * 64 * 64; i += gthreads) {
        const int k = (int)(i % 64), n = (int)((i / 64) % 64), m = (int)(i / 4096);
        p.W2T[i] = f2bf(p.cmp_w2[((size_t)m * 64 + k) * 64 + n]);
    }
    for (size_t i = gtid; i < (size_t)NL * NPAD; i += gthreads) {
        const int l = (int)(i / NPAD), r = (int)(i % NPAD);
        float v = 0.f;
        if (r < 2560) { const int n = r < 768 ? r : r + 4; v = p.b_in[l * NCOL + n]; }
        else if (r < 2564) v = p.b_in[l * NCOL + 768 + (r - 2560)];
        else if (r < 2582) v = p.b_in[l * NCOL + r];
        p.binp[i] = v;
    }
    for (size_t i = gtid; i < (size_t)NL * NE * 2048; i += gthreads) {
        const int r = (int)(i % 2048); const size_t le = i / 2048;
        const int s = (r >> 7) & 1, f = (r >> 8) * 128 + (r & 127);
        p.bgup[i] = p.b_gu[le * 2048 + 2 * f + s];
    }
    for (size_t i = gtid; i < (size_t)NL * NE * 1024; i += gthreads) {
        const int k = (int)(i % 1024), e = (int)((i / 1024) % NE), l = (int)(i / (1024 * NE));
        p.rwT[i] = p.router_w[((size_t)l * 1024 + k) * NE + e];
    }
    for (size_t i = gtid; i < (size_t)NL * (NPAD - NCOL) * 1024; i += gthreads) {
        const int l = (int)(i / ((NPAD - NCOL) * 1024)); const size_t r = i % ((size_t)(NPAD - NCOL) * 1024);
        p.WinT[(size_t)l * NPAD * 1024 + (size_t)NCOL * 1024 + r] = 0;
    }
    for (size_t i = gtid; i < (size_t)NTOK * DM / 4; i += gthreads) {
        const float4 v4 = ((const float4*)p.x)[i];
        u32x2 w; w.x = pack2(v4.x, v4.y); w.y = pack2(v4.z, v4.w);
        ((u32x2*)p.xb)[i] = w;
    }
    if (bid < 4) {
        float* lf = (float*)ldsc;
        const int j = tid & 63, part = tid >> 6;
        const float* pe = p.cmp_pe + (size_t)bid * 2048; const float* w1 = p.cmp_w1 + (size_t)bid * 2048 * 64;
        float s = 0.f;
        for (int kk = part * 256; kk < part * 256 + 256; ++kk) s += pe[kk] * w1[(size_t)kk * 64 + j];
        lf[tid] = s; __syncthreads();
        if (tid < 64) { float a = 0.f; for (int q = 0; q < 8; ++q) a += lf[tid + 64 * q]; p.b1c[bid * 64 + tid] = a; }
        __syncthreads();
    }
}

namespace pg8 {
constexpr int BM = 256, BK = 64, HALF = 128, HTB = HALF * BK * 2, NXCD = 8, WGM = 8;
__device__ __forceinline__ int lds_byte(int r, int c) { const int st = (r >> 4) * 2 + (c >> 5), rr = r & 15, cc = c & 31, ob = rr * 64 + cc * 2; return st * 1024 + (ob ^ (((ob >> 9) & 1) << 5)); }
__device__ __forceinline__ void stage_rc(int b, int& R, int& C) { const int st = b / 1024, sb = b % 1024, swz = sb ^ (((sb >> 9) & 1) << 5); R = (st >> 1) * 16 + swz / 64; C = (st & 1) * 32 + (swz % 64) / 2; }
__device__ __forceinline__ bool tile_order(int i, int G, int c, int nM, int nN, int& pm, int& pn) {
    const int nwg = nM * nN; const long L = (long)i * G + c; if (L >= nwg) return false;
    int wgid = (int)L; { const int q = nwg / NXCD, r = nwg % NXCD, xcd = wgid % NXCD, off = wgid / NXCD; wgid = (xcd < r ? xcd * (q + 1) : r * (q + 1) + (xcd - r) * q) + off; }
    const int nig = WGM * nN, gid = wgid / nig, fm = gid * WGM, gsz = (nM - fm) < WGM ? (nM - fm) : WGM;
    pm = fm + ((wgid % nig) % gsz); pn = (wgid % nig) / gsz; return true;
}
template <bool FP8, int SCA, class Sched, class Epi>
__device__ __forceinline__ void gemm_phase(LAS unsigned char* lds, const char* Abase, int K, const Sched& S, const Epi& E) {
    int tid = threadIdx.x; asm volatile("" : "+v"(tid));
    const int wid = __builtin_amdgcn_readfirstlane(tid >> 6), lane = tid & 63, wr = wid >> 2, wc = wid & 3, fr = lane & 15, fq = lane >> 4;
    const int nt = K / BK;
    int R0, C0, R1, C1; stage_rc(tid * 16, R0, C0); stage_rc(tid * 16 + 8192, R1, C1);
    LAS unsigned* aofs = (LAS unsigned*)(lds + LDS_AOFF) + tid;
    unsigned rg[10];
    rg[8] = (unsigned)(R0 * K + C0) * 2u; rg[9] = (unsigned)(R1 * K + C1) * 2u;
    if constexpr (FP8) { aofs[8 * NTHR] = rg[8]; aofs[9 * NTHR] = rg[9]; }
    const size_t kstep = (size_t)(BK * 2), hstep = (size_t)HALF * K * 2;
    const unsigned ldsw = (unsigned)wid * 1024u;
    const int aoff = lds_byte(wr * 64 + fr, fq * 8), boff = lds_byte(wc * 32 + fr, fq * 8);
#define PG8_SA(b, h) (((b) * 2 + (h)) * HTB)
#define PG8_SB(b, h) ((4 + (b) * 2 + (h)) * HTB)
#define PG8_OFS(sel, j) (FP8 ? aofs[((sel) * 4 + (j)) * NTHR] : ((sel) ? rg[4 + (j)] : rg[(j)]))
#define PG8_STAGE_B(bufoff, gbase) do { _Pragma("unroll") for (int _i = 0; _i < 2; ++_i) { const unsigned ob_ = FP8 ? aofs[(8 + _i) * NTHR] : rg[8 + _i]; \
        __builtin_amdgcn_global_load_lds((const unsigned*)((const char*)(gbase) + ob_), (LAS unsigned*)(lds + (bufoff) + ldsw + _i * 8192), 16, 0, 0); } } while (0)
#define PG8_STAGE_A(bufoff, kbyte, sel, h) do { const unsigned o0_ = PG8_OFS(sel, (h) * 2), o1_ = PG8_OFS(sel, (h) * 2 + 1); \
        __builtin_amdgcn_global_load_lds((const unsigned*)(Abase + (kbyte) + o0_), (LAS unsigned*)(lds + (bufoff) + ldsw), 16, 0, 0); \
        __builtin_amdgcn_global_load_lds((const unsigned*)(Abase + (kbyte) + o1_), (LAS unsigned*)(lds + (bufoff) + ldsw + 8192), 16, 0, 0); } while (0)
#define PG8_LDA(dst, b, h) do { _Pragma("unroll") for (int m = 0; m < 4; ++m) { \
        if constexpr (FP8) { const v4i_t lo_ = *(const LAS v4i_t*)(lds + PG8_SA(b, h) + aoff + m * 2048), hi_ = *(const LAS v4i_t*)(lds + PG8_SA(b, h) + aoff + m * 2048 + 1024); dst##8[m] = __builtin_shufflevector(lo_, hi_, 0, 1, 2, 3, 4, 5, 6, 7); } \
        else { _Pragma("unroll") for (int k = 0; k < 2; ++k) dst[m][k] = *(const LAS bf16x8*)(lds + PG8_SA(b, h) + aoff + m * 2048 + k * 1024); } } } while (0)
#define PG8_LDB(dst, b, h) do { _Pragma("unroll") for (int n = 0; n < 2; ++n) { \
        if constexpr (FP8) { const v4i_t lo_ = *(const LAS v4i_t*)(lds + PG8_SB(b, h) + boff + n * 2048), hi_ = *(const LAS v4i_t*)(lds + PG8_SB(b, h) + boff + n * 2048 + 1024); dst##8[n] = __builtin_shufflevector(lo_, hi_, 0, 1, 2, 3, 4, 5, 6, 7); } \
        else { _Pragma("unroll") for (int k = 0; k < 2; ++k) dst[n][k] = *(const LAS bf16x8*)(lds + PG8_SB(b, h) + boff + n * 2048 + k * 1024); } } } while (0)
#define PG8_MMA(ai, bj, At, Bt) do { __builtin_amdgcn_s_setprio(1); _Pragma("unroll") for (int m = 0; m < 4; ++m) _Pragma("unroll") for (int n = 0; n < 2; ++n) { \
        if constexpr (FP8) { acc[ai][bj][m][n] = __builtin_amdgcn_mfma_scale_f32_16x16x128_f8f6f4(Bt##8[n], At##8[m], acc[ai][bj][m][n], 0, 0, 0, SCA, 0, SCA); } \
        else { _Pragma("unroll") for (int k = 0; k < 2; ++k) acc[ai][bj][m][n] = __builtin_amdgcn_mfma_f32_16x16x32_bf16(Bt[n][k], At[m][k], acc[ai][bj][m][n], 0, 0, 0); } } \
        __builtin_amdgcn_s_setprio(0); } while (0)
#define PG8_WAIT_V(n) asm volatile("s_waitcnt vmcnt(" #n ")" ::: "memory")
#define PG8_WAIT_L(n) asm volatile("s_waitcnt lgkmcnt(" #n ")" ::: "memory")
#define PG8_BAR __builtin_amdgcn_s_barrier()
#define PG8_SCHED __builtin_amdgcn_sched_barrier(0)
    typename Sched::Unit cur, nxt; int ui = 0;
    if (!S.next(0, cur)) return;
    f32x4 acc[2][2][4][2];
#pragma unroll
    for (int a = 0; a < 2; ++a)
#pragma unroll
        for (int b = 0; b < 2; ++b)
#pragma unroll
            for (int m = 0; m < 4; ++m)
#pragma unroll
                for (int n = 0; n < 2; ++n) acc[a][b][m][n] = (f32x4){0.f, 0.f, 0.f, 0.f};
    bf16x8 At[4][2], B0[2][2], B1[2][2];
    v8i_t At8[4], B08[2], B18[2];
    { unsigned a4[2][2]; S.a_off(cur, R0, C0, R1, C1, a4); rg[0] = a4[0][0]; rg[1] = a4[0][1]; rg[2] = a4[1][0]; rg[3] = a4[1][1];
      if constexpr (FP8) { aofs[0] = a4[0][0]; aofs[NTHR] = a4[0][1]; aofs[2 * NTHR] = a4[1][0]; aofs[3 * NTHR] = a4[1][1]; } }
    const char* cB = S.b_ptr(cur);
    PG8_STAGE_B(PG8_SB(0, 0), cB); PG8_STAGE_B(PG8_SB(0, 1), cB + hstep); PG8_STAGE_A(PG8_SA(0, 0), 0, 0, 0); PG8_STAGE_A(PG8_SA(0, 1), 0, 0, 1);
    if (wr == 1) PG8_BAR;
    PG8_WAIT_V(2); PG8_BAR;
    PG8_STAGE_B(PG8_SB(1, 0), cB + kstep); PG8_STAGE_A(PG8_SA(1, 0), kstep, 0, 0); PG8_STAGE_B(PG8_SB(1, 1), cB + hstep + kstep);
    PG8_WAIT_V(6); PG8_BAR;
    for (;;) {
        const bool has_next = S.next(ui + 1, nxt);
        const char* nB = cB;
        if (has_next) { int t2 = threadIdx.x; asm volatile("" : "+v"(t2)); int r0, c0, r1, c1; stage_rc(t2 * 16, r0, c0); stage_rc(t2 * 16 + 8192, r1, c1); unsigned a4[2][2]; S.a_off(nxt, r0, c0, r1, c1, a4); nB = S.b_ptr(nxt);
            rg[4] = a4[0][0]; rg[5] = a4[0][1]; rg[6] = a4[1][0]; rg[7] = a4[1][1];
            if constexpr (FP8) { aofs[4 * NTHR] = a4[0][0]; aofs[5 * NTHR] = a4[0][1]; aofs[6 * NTHR] = a4[1][0]; aofs[7 * NTHR] = a4[1][1]; } }
        else { rg[4] = rg[0]; rg[5] = rg[1]; rg[6] = rg[2]; rg[7] = rg[3];
            if constexpr (FP8) { aofs[4 * NTHR] = aofs[0]; aofs[5 * NTHR] = aofs[NTHR]; aofs[6 * NTHR] = aofs[2 * NTHR]; aofs[7 * NTHR] = aofs[3 * NTHR]; } }
#pragma unroll 1
        for (int t = 0; t < nt; t += 2) {
            const bool last = (t == nt - 2);
            const size_t ka1 = (size_t)(t + 1) * kstep, ka2 = last ? 0 : (size_t)(t + 2) * kstep, ka3 = ka2 + kstep;
            const char* b2 = last ? nB : cB + (size_t)(t + 2) * kstep; const char* b3 = b2 + kstep;
            const int sel = last ? 1 : 0;
            PG8_LDB(B0, 0, 0); PG8_LDB(B1, 0, 1); PG8_SCHED; PG8_LDA(At, 0, 0); PG8_STAGE_A(PG8_SA(1, 1), ka1, 0, 1);
            PG8_WAIT_V(8); PG8_WAIT_L(0); PG8_BAR; PG8_MMA(0, 0, At, B0); PG8_MMA(0, 1, At, B1); PG8_BAR; PG8_SCHED;
            PG8_LDA(At, 0, 1); PG8_STAGE_B(PG8_SB(0, 0), b2); PG8_STAGE_B(PG8_SB(0, 1), b2 + hstep); PG8_STAGE_A(PG8_SA(0, 0), ka2, sel, 0);
            PG8_WAIT_V(8); PG8_WAIT_L(0); PG8_BAR; PG8_MMA(1, 0, At, B0); PG8_MMA(1, 1, At, B1); PG8_BAR; PG8_SCHED;
            PG8_LDB(B0, 1, 0); PG8_LDB(B1, 1, 1); PG8_SCHED; PG8_LDA(At, 1, 0); PG8_STAGE_A(PG8_SA(0, 1), ka2, sel, 1);
            PG8_WAIT_V(8); PG8_WAIT_L(0); PG8_BAR; PG8_MMA(0, 0, At, B0); PG8_MMA(0, 1, At, B1); PG8_BAR; PG8_SCHED;
            PG8_LDA(At, 1, 1); PG8_STAGE_B(PG8_SB(1, 0), b3); PG8_STAGE_B(PG8_SB(1, 1), b3 + hstep); PG8_STAGE_A(PG8_SA(1, 0), ka3, sel, 0);
            PG8_WAIT_V(8); PG8_WAIT_L(0); PG8_BAR; PG8_MMA(1, 0, At, B0); PG8_MMA(1, 1, At, B1); PG8_BAR; PG8_SCHED;
        }
        if (wr == 0) PG8_BAR;
        { int t2 = threadIdx.x; asm volatile("" : "+v"(t2)); E(acc, cur, wr, wc, t2 & 15, (t2 & 63) >> 4); }
        if (!has_next) break;
#pragma unroll
        for (int a = 0; a < 2; ++a)
#pragma unroll
            for (int b = 0; b < 2; ++b)
#pragma unroll
                for (int m = 0; m < 4; ++m)
#pragma unroll
                    for (int n = 0; n < 2; ++n) acc[a][b][m][n] = (f32x4){0.f, 0.f, 0.f, 0.f};
        cur = nxt; cB = nB; ++ui;
        rg[0] = rg[4]; rg[1] = rg[5]; rg[2] = rg[6]; rg[3] = rg[7];
        if constexpr (FP8) { aofs[0] = aofs[4 * NTHR]; aofs[NTHR] = aofs[5 * NTHR]; aofs[2 * NTHR] = aofs[6 * NTHR]; aofs[3 * NTHR] = aofs[7 * NTHR]; }
        if (wr == 1) PG8_BAR;
    }
    PG8_WAIT_V(0);
    PG8_BAR;
#undef PG8_SA
#undef PG8_SB
#undef PG8_STAGE_A
#undef PG8_OFS
#undef PG8_STAGE_B
#undef PG8_LDA
#undef PG8_LDB
#undef PG8_MMA
#undef PG8_WAIT_V
#undef PG8_WAIT_L
#undef PG8_BAR
#undef PG8_SCHED
}
}

struct DenseUnit { int pm, pn; };
struct DenseSched {
    typedef DenseUnit Unit;
    const char* Bt; int K, nM, nN;
    __device__ __forceinline__ bool next(int i, Unit& u) const { return pg8::tile_order(i, gridDim.x, blockIdx.x, nM, nN, u.pm, u.pn); }
    __device__ __forceinline__ void a_off(const Unit& u, int R0, int C0, int R1, int C1, unsigned (&off)[2][2]) const {
#pragma unroll
        for (int h = 0; h < 2; ++h) { off[h][0] = (unsigned)((u.pm * 256 + h * 128 + R0) * K + C0) * 2u; off[h][1] = (unsigned)((u.pm * 256 + h * 128 + R1) * K + C1) * 2u; }
    }
    __device__ __forceinline__ const char* b_ptr(const Unit& u) const { return Bt + (size_t)u.pn * 256 * K * 2; }
};
struct MoeUnit { int rbt, e, pn; };
template <bool GATHER>
struct MoeSched {
    typedef MoeUnit Unit;
    static constexpr int KP = 512;
    const char* Bt; const int* lists; const int* ptile; const int* ecnt; int nN, nrows;
    __device__ __forceinline__ bool next(int i, Unit& u) const {
        int pm, pn; if (!pg8::tile_order(i, gridDim.x, blockIdx.x, ptile[NE], nN, pm, pn)) return false;
        int e = 0; while (ptile[e + 1] <= pm) ++e;
        u.rbt = pm; u.e = e; u.pn = pn; return true;
    }
    __device__ __forceinline__ void a_off(const Unit& u, int R0, int C0, int R1, int C1, unsigned (&off)[2][2]) const {
        if (GATHER) {
            const int* lst = lists + (size_t)u.e * LIST_CAP; const int rb = u.rbt - ptile[u.e], cnt = ecnt[u.e];
#pragma unroll
            for (int h = 0; h < 2; ++h) {
                const int l0 = rb * 256 + h * 128 + R0, l1 = rb * 256 + h * 128 + R1;
                const int t0 = l0 < cnt ? (lst[l0] >> 2) : 0, t1 = l1 < cnt ? (lst[l1] >> 2) : 0;
                off[h][0] = (unsigned)(t0 * KP + C0) * 2u; off[h][1] = (unsigned)(t1 * KP + C1) * 2u;
            }
        } else {
#pragma unroll
            for (int h = 0; h < 2; ++h) { off[h][0] = (unsigned)((u.rbt * 256 + h * 128 + R0) * KP + C0) * 2u; off[h][1] = (unsigned)((u.rbt * 256 + h * 128 + R1) * KP + C1) * 2u; }
        }
    }
    __device__ __forceinline__ const char* b_ptr(const Unit& u) const { return Bt + ((size_t)u.e * nrows + (size_t)u.pn * 256) * KP * 2; }
};

struct EpiInProj {
    const Params* p; int l;
    __device__ __forceinline__ void operator()(const f32x4 (&acc)[2][2][4][2], const DenseUnit& u, int wr, int wc, int fr, int fq) const {
        const float* bias = p->binp + l * NPAD + u.pn * 256;
#pragma unroll
        for (int bj = 0; bj < 2; ++bj) {
            int kind = 0, hb0 = 0;
            if (u.pn == 1) { kind = 1; hb0 = bj * 2; } else if (u.pn == 4 && bj == 1) { kind = 1; hb0 = 4; } else if (u.pn == 8 && bj == 0) { kind = 1; hb0 = 6; } else if (u.pn == 9 && bj == 0) { kind = 1; hb0 = 8; }
            else if (u.pn == 2) { kind = 2; hb0 = bj * 2; } else if (u.pn == 5 && bj == 0) { kind = 2; hb0 = 4; } else if (u.pn == 8 && bj == 1) { kind = 2; hb0 = 6; } else if (u.pn == 9 && bj == 1) { kind = 2; hb0 = 8; }
#pragma unroll
            for (int n = 0; n < 2; ++n) {
                const int c = bj * 128 + wc * 32 + n * 16 + 4 * fq;
                const f32x4 bv = *(const f32x4*)(bias + c);
                const int hh = hb0 + ((c & 127) >> 6), d = c & 63;
#pragma unroll
                for (int ai = 0; ai < 2; ++ai)
#pragma unroll
                    for (int m = 0; m < 4; ++m) {
                        const int row = u.pm * 256 + ai * 128 + wr * 64 + m * 16 + fr;
                        const f32x4 v = acc[ai][bj][m][n] + bv;
                        u32x2 w; w.x = pack2(v[0], v[1]); w.y = pack2(v[2], v[3]);
                        if (kind == 0) *(u32x2*)(p->hb + (size_t)row * NMAIN + u.pn * 256 + c) = w;
                        else {
                            const int b = row >> 11, s = row & 2047, kk = s & 31;
                            bf16_t* blk = (kind == 1 ? p->kF : p->vT) + (((size_t)b * NVH + hh) * 64 + (s >> 5)) * 2048;
                            if (kind == 1) {
                                const int frk = (kk >> 3) * 4 + (kk & 3), t = (kk >> 2) & 1;
                                *(u32x2*)(blk + ((t * 2 + (d >> 5)) * 64 + ((d & 31) >> 3) * 16 + frk) * 8 + (d & 7)) = w;
                            } else {
                                bf16_t* vt = blk + (((d >> 4) * 64) + (kk >> 3) * 16 + (d & 15)) * 8 + (kk & 7);
                                vt[0] = (bf16_t)(w.x & 0xffff); vt[8] = (bf16_t)(w.x >> 16); vt[16] = (bf16_t)(w.y & 0xffff); vt[24] = (bf16_t)(w.y >> 16);
                            }
                        }
                    }
            }
        }
    }
};
struct EpiOutProj {
    const float* xin; float* t;
    __device__ __forceinline__ void operator()(const f32x4 (&acc)[2][2][4][2], const DenseUnit& u, int wr, int wc, int fr, int fq) const {
#pragma unroll
        for (int ai = 0; ai < 2; ++ai)
#pragma unroll
            for (int m = 0; m < 4; ++m) {
                const size_t rowoff = (size_t)(u.pm * 256 + ai * 128 + wr * 64 + m * 16 + fr) * DM + u.pn * 256 + wc * 32 + 4 * fq;
#pragma unroll
                for (int bj = 0; bj < 2; ++bj)
#pragma unroll
                    for (int n = 0; n < 2; ++n) {
                        const size_t off = rowoff + bj * 128 + n * 16;
                        const f32x4 xv = *(const f32x4*)(xin + off);
                        *(f32x4*)(t + off) = xv * ALPHA + acc[ai][bj][m][n];
                    }
            }
    }
};
struct EpiGateUp {
    bf16_t* act; const float* bgup;
    __device__ __forceinline__ void operator()(const f32x4 (&acc)[2][2][4][2], const MoeUnit& u, int wr, int wc, int fr, int fq) const {
        const float* bias = bgup + (size_t)u.e * 2048 + u.pn * 256;
#pragma unroll
        for (int n = 0; n < 2; ++n) {
            const int c = wc * 32 + n * 16 + 4 * fq;
            const f32x4 bg = *(const f32x4*)(bias + c), bu = *(const f32x4*)(bias + 128 + c);
#pragma unroll
            for (int ai = 0; ai < 2; ++ai)
#pragma unroll
                for (int m = 0; m < 4; ++m) {
                    const f32x4 g4 = acc[ai][0][m][n] + bg, u4 = acc[ai][1][m][n] + bu;
                    float o[4];
#pragma unroll
                    for (int j = 0; j < 4; ++j) {
                        const float g = fminf(g4[j], 7.0f), uu = fminf(fmaxf(u4[j], -7.0f), 7.0f);
                        const float glu = g * __builtin_amdgcn_rcpf(1.0f + __builtin_amdgcn_exp2f(-2.455466929f * g));
                        o[j] = (uu + 1.0f) * glu;
                    }
                    *(unsigned*)((char*)act + (size_t)(u.rbt * 256 + ai * 128 + wr * 64 + m * 16 + fr) * DFF + u.pn * 128 + c) = pack4_fp8(o[0], o[1], o[2], o[3]);
                }
        }
    }
};
struct EpiDown {
    bf16_t* ybuf; const float* bdn;
    __device__ __forceinline__ void operator()(const f32x4 (&acc)[2][2][4][2], const MoeUnit& u, int wr, int wc, int fr, int fq) const {
        const float* bias = bdn + (size_t)u.e * 1024 + u.pn * 256;
#pragma unroll
        for (int bj = 0; bj < 2; ++bj)
#pragma unroll
            for (int n = 0; n < 2; ++n) {
                const int c = bj * 128 + wc * 32 + n * 16 + 4 * fq;
                const f32x4 bv = *(const f32x4*)(bias + c);
#pragma unroll
                for (int ai = 0; ai < 2; ++ai)
#pragma unroll
                    for (int m = 0; m < 4; ++m) {
                        const f32x4 v = acc[ai][bj][m][n] + bv;
                        u32x2 w; w.x = pack2(v[0], v[1]); w.y = pack2(v[2], v[3]);
                        *(u32x2*)(ybuf + (size_t)(u.rbt * 256 + ai * 128 + wr * 64 + m * 16 + fr) * DM + u.pn * 256 + c) = w;
                    }
            }
    }
};

__device__ __forceinline__ void phase_inproj(const Params& p, int l, char* lds) {
    DenseSched S{(const char*)(p.WinT + (size_t)l * NPAD * 1024), 1024, NTOK / 256, NMAIN / 256};
    EpiInProj E{&p, l};
    pg8::gemm_phase<false, 0>((LAS unsigned char*)lds, (const char*)p.xb, 1024, S, E);
    int tid = threadIdx.x; asm volatile("" : "+v"(tid));
    const int wid = tid >> 6, lane = tid & 63, fr = lane & 15, fq = lane >> 4;
    const bf16_t* W = p.WinT + ((size_t)l * NPAD + NMAIN) * 1024;
    const float* bias = p.binp + l * NPAD + NMAIN;
    for (int u = blockIdx.x * NWV + wid; u < NTOK / 16; u += gridDim.x * NWV) {
        const bf16_t* ar = p.xb + (size_t)(u * 16 + fr) * DM + fq * 8;
        const bf16_t* w0 = W + (size_t)fr * 1024 + fq * 8; const bf16_t* w1 = W + (size_t)(16 + fr) * 1024 + fq * 8;
        f32x4 a0 = (f32x4){0.f, 0.f, 0.f, 0.f}, a1 = a0;
#pragma unroll 4
        for (int ks = 0; ks < 32; ++ks) {
            const bf16x8 a = *(const bf16x8*)(ar + ks * 32);
            a0 = __builtin_amdgcn_mfma_f32_16x16x32_bf16(a, *(const bf16x8*)(w0 + ks * 32), a0, 0, 0, 0);
            a1 = __builtin_amdgcn_mfma_f32_16x16x32_bf16(a, *(const bf16x8*)(w1 + ks * 32), a1, 0, 0, 0);
        }
#pragma unroll
        for (int r = 0; r < 4; ++r) {
            float* dst = p.hs + (size_t)(u * 16 + fq * 4 + r) * HS_W;
            dst[fr] = a0[r] + bias[fr];
            if (fr < 6) dst[16 + fr] = a1[r] + bias[16 + fr];
        }
    }
}
__device__ __forceinline__ void phase_outproj(const Params& p, int l, const float* xin, char* lds) {
    DenseSched S{(const char*)(p.WoT + (size_t)l * 1024 * 1024), 1024, NTOK / 256, 4};
    EpiOutProj E{xin, p.tbuf};
    pg8::gemm_phase<false, 0>((LAS unsigned char*)lds, (const char*)p.ob, 1024, S, E);
}
__device__ __forceinline__ void build_tiles(const Params& p, int l, int* ptile, int* ecnt) {
    int tid = threadIdx.x; asm volatile("" : "+v"(tid));
    if (tid < NE) ecnt[tid] = (int)__hip_atomic_load(p.ctrl + 64 + l * NE + tid, __ATOMIC_RELAXED, __HIP_MEMORY_SCOPE_AGENT);
    __syncthreads();
    if (tid == 0) { int s = 0; for (int e = 0; e < NE; ++e) { ptile[e] = s; s += (ecnt[e] + 255) >> 8; } ptile[NE] = s; }
    __syncthreads();
}
__device__ __forceinline__ void phase_gateup(const Params& p, int l, char* lds) {
    int* ptile = (int*)(lds + LDS_TAB); int* ecnt = ptile + 40;
    build_tiles(p, l, ptile, ecnt);
    MoeSched<true> S{(const char*)p.WguT + (size_t)l * NE * 2048 * 1024, p.lists, ptile, ecnt, 8, 2048};
    EpiGateUp E{p.act, p.bgup + (size_t)l * NE * 2048};
    pg8::gemm_phase<true, 0x7c7c7c7c>((LAS unsigned char*)lds, (const char*)p.x1b, 512, S, E);
}
__device__ __forceinline__ void phase_down(const Params& p, int l, char* lds) {
    int* ptile = (int*)(lds + LDS_TAB); int* ecnt = ptile + 40;
    build_tiles(p, l, ptile, ecnt);
    MoeSched<false> S{(const char*)p.WdnT + (size_t)l * NE * 1024 * 1024, p.lists, ptile, ecnt, 4, 1024};
    EpiDown E{p.ybuf, p.b_dn + (size_t)l * NE * 1024};
    pg8::gemm_phase<true, 0x7c7c7c7c>((LAS unsigned char*)lds, (const char*)p.act, 512, S, E);
}

__device__ __forceinline__ float gelu_tanh(float x) {
    const float u = 0.7978845608028654f * (x + 0.044715f * x * x * x);
    const float e = __expf(-2.0f * fabsf(u)); const float th = (1.0f - e) / (1.0f + e);
    return 0.5f * x * (1.0f + (u < 0.f ? -th : th));
}
__device__ __forceinline__ void phase_prep(const Params& p, int l, char* lds) {
    int tid = threadIdx.x; asm volatile("" : "+v"(tid));
    const int wid = tid >> 6, lane = tid & 63, fr = lane & 15, fq = lane >> 4;
    const int gw = blockIdx.x * NWV + wid, nw = gridDim.x * NWV;
    for (int u = (int)gridDim.x - 1 - (int)blockIdx.x; u < NB * 4; u += gridDim.x) {
        const int b = u >> 2, h = u & 3;
        const float* srcp = p.hs + ((size_t)b * SEQ + tid * 4) * HS_W + h;
        float ls[4]; float tot = 0.f;
#pragma unroll
        for (int i = 0; i < 4; ++i) { const float f = srcp[(size_t)i * HS_W]; ls[i] = fminf(f, 0.f) - log1pf(__expf(-fabsf(f))); tot += ls[i]; }
        float inc = tot;
#pragma unroll
        for (int o = 1; o < 64; o <<= 1) { const float v = __shfl_up(inc, o); if (lane >= o) inc += v; }
        float* wtot = (float*)(lds + 65536);
        if (lane == 63) wtot[wid] = inc;
        __syncthreads();
        float base = inc - tot;
        for (int w = 0; w < wid; ++w) base += wtot[w];
        float4 o4; o4.x = base + ls[0]; o4.y = o4.x + ls[1]; o4.z = o4.y + ls[2]; o4.w = o4.z + ls[3];
        *(float4*)(p.cF + (size_t)u * SEQ + tid * 4) = o4;
        __syncthreads();
    }
    float* part = (float*)lds;
    bf16_t* h1 = (bf16_t*)(lds + 32768);
    for (int u = blockIdx.x; u < NB * 2 * 2 * 8; u += gridDim.x) {
        const int ct = u & 7, which = (u >> 3) & 1, kvh = (u >> 4) & 1, b = u >> 5;
        const int colo = (which ? C_NVC : C_NKC) + kvh * 64;
        const int c_lane = ct * 16 + fr;
        const int tokbase = min(c_lane, 126) * 16;
        const bf16_t* arow = p.hb + ((size_t)b * SEQ + tokbase) * NMAIN + colo + fq * 8;
        const bf16_t* w1 = p.W1T + ((size_t)(l * 2 + which) * 64 + fr) * 2048 + fq * 8;
        f32x4 acc[4];
#pragma unroll
        for (int n = 0; n < 4; ++n) acc[n] = (f32x4){0.f, 0.f, 0.f, 0.f};
#pragma unroll
        for (int kk = 0; kk < 8; ++kk) {
            const int ks = wid * 8 + kk;
            const bf16x8 a = *(const bf16x8*)(arow + (size_t)(ks >> 1) * NMAIN + (ks & 1) * 32);
#pragma unroll
            for (int n = 0; n < 4; ++n) {
                const bf16x8 bb = *(const bf16x8*)(w1 + (size_t)n * 16 * 2048 + ks * 32);
                acc[n] = __builtin_amdgcn_mfma_f32_16x16x32_bf16(a, bb, acc[n], 0, 0, 0);
            }
        }
#pragma unroll
        for (int n = 0; n < 4; ++n)
#pragma unroll
            for (int r = 0; r < 4; ++r) part[wid * 1024 + (fq * 4 + r) * 64 + n * 16 + fr] = acc[n][r];
        __syncthreads();
        const float* b1 = p.b1c + (l * 2 + which) * 64;
#pragma unroll
        for (int i = 0; i < 2; ++i) {
            const int e = tid + NTHR * i; float sum = 0.f;
#pragma unroll
            for (int w = 0; w < 8; ++w) sum += part[w * 1024 + e];
            h1[e] = f2bf(gelu_tanh(sum + b1[e & 63]));
        }
        __syncthreads();
        if (wid == 0) {
            const bf16_t* w2 = p.W2T + ((size_t)(l * 2 + which) * 64 + fr) * 64 + fq * 8;
            f32x4 o2[4];
#pragma unroll
            for (int n = 0; n < 4; ++n) o2[n] = (f32x4){0.f, 0.f, 0.f, 0.f};
#pragma unroll
            for (int ks = 0; ks < 2; ++ks) {
                const bf16x8 a = *(const bf16x8*)(h1 + fr * 64 + ks * 32 + fq * 8);
#pragma unroll
                for (int n = 0; n < 4; ++n) {
                    const bf16x8 bb = *(const bf16x8*)(w2 + (size_t)n * 16 * 64 + ks * 32);
                    o2[n] = __builtin_amdgcn_mfma_f32_16x16x32_bf16(a, bb, o2[n], 0, 0, 0);
                }
            }
            const size_t base = ((size_t)b * 2 + kvh) * 128 * 64;
#pragma unroll
            for (int n = 0; n < 4; ++n)
#pragma unroll
                for (int r = 0; r < 4; ++r) {
                    const int c = ct * 16 + fq * 4 + r, j2 = n * 16 + fr;
                    const bf16_t v = c < 127 ? f2bf(o2[n][r]) : (bf16_t)0;
                    if (which == 0) p.kc[base + (size_t)c * 64 + j2] = v;
                    else { p.vc[base + (size_t)c * 64 + j2] = v; p.vcT[base + (size_t)j2 * 128 + c] = v; }
                }
        }
        __syncthreads();
    }
}

constexpr float L2E = 1.4426950408889634f, MASKV = -1e30f, SCL2 = QSCALE * L2E;
struct KVFrag { bf16x8 k[2][2]; bf16x8 v[4]; };
template <bool FM>
__device__ __forceinline__ void k_load(KVFrag& f, const bf16_t* __restrict__ Kb, size_t ldk, int kc0, int fr, int fq) {
    if (FM) {
        const bf16_t* kp = Kb + (size_t)(kc0 >> 5) * 2048 + (fq * 16 + fr) * 8;
        f.k[0][0] = *(const bf16x8*)(kp); f.k[0][1] = *(const bf16x8*)(kp + 512); f.k[1][0] = *(const bf16x8*)(kp + 1024); f.k[1][1] = *(const bf16x8*)(kp + 1536);
    } else {
        const bf16_t* kp = Kb + (size_t)(kc0 + (fr >> 2) * 8 + (fr & 3)) * ldk + fq * 8;
        f.k[0][0] = *(const bf16x8*)(kp); f.k[0][1] = *(const bf16x8*)(kp + 32);
        f.k[1][0] = *(const bf16x8*)(kp + 4 * ldk); f.k[1][1] = *(const bf16x8*)(kp + 4 * ldk + 32);
    }
}
template <bool FM>
__device__ __forceinline__ void v_load(bf16x8 (&v)[4], const bf16_t* __restrict__ VTb, size_t ldv, int kc0, int fr, int fq) {
    if (FM) {
        const bf16_t* vp = VTb + (size_t)(kc0 >> 5) * 2048 + (fq * 16 + fr) * 8;
#pragma unroll
        for (int dt = 0; dt < 4; ++dt) v[dt] = *(const bf16x8*)(vp + dt * 512);
    } else {
        const bf16_t* vp = VTb + (size_t)fr * ldv + kc0 + fq * 8;
#pragma unroll
        for (int dt = 0; dt < 4; ++dt) v[dt] = *(const bf16x8*)(vp + (size_t)dt * 16 * ldv);
    }
}
__device__ __forceinline__ float rowmax4(float x) {
    auto r = __builtin_amdgcn_permlane32_swap(__float_as_uint(x), __float_as_uint(x), false, false);
    x = fmaxf(__uint_as_float(r[0]), __uint_as_float(r[1]));
    auto q = __builtin_amdgcn_permlane16_swap(__float_as_uint(x), __float_as_uint(x), false, false);
    return fmaxf(__uint_as_float(q[0]), __uint_as_float(q[1]));
}
__device__ __forceinline__ float rowsum4(float x) {
    auto r = __builtin_amdgcn_permlane32_swap(__float_as_uint(x), __float_as_uint(x), false, false);
    x = __uint_as_float(r[0]) + __uint_as_float(r[1]);
    auto q = __builtin_amdgcn_permlane16_swap(__float_as_uint(x), __float_as_uint(x), false, false);
    return __uint_as_float(q[0]) + __uint_as_float(q[1]);
}
template <int NQT, bool MASK, class MB>
__device__ __forceinline__ void attn_compute(const KVFrag& f, const bf16x8 (&qf)[NQT][2], f32x4 (&o)[NQT][4], float (&m)[NQT], float (&l)[NQT], const MB& mb) {
    f32x4 s0[NQT], s1[NQT];
#pragma unroll
    for (int qt = 0; qt < NQT; ++qt) {
        s0[qt] = __builtin_amdgcn_mfma_f32_16x16x32_bf16(f.k[0][0], qf[qt][0], (f32x4){0.f, 0.f, 0.f, 0.f}, 0, 0, 0);
        s1[qt] = __builtin_amdgcn_mfma_f32_16x16x32_bf16(f.k[1][0], qf[qt][0], (f32x4){0.f, 0.f, 0.f, 0.f}, 0, 0, 0);
    }
#pragma unroll
    for (int qt = 0; qt < NQT; ++qt) {
        s0[qt] = __builtin_amdgcn_mfma_f32_16x16x32_bf16(f.k[0][1], qf[qt][1], s0[qt], 0, 0, 0);
        s1[qt] = __builtin_amdgcn_mfma_f32_16x16x32_bf16(f.k[1][1], qf[qt][1], s1[qt], 0, 0, 0);
    }
    float mx[NQT];
#pragma unroll
    for (int qt = 0; qt < NQT; ++qt) {
#pragma unroll
        for (int j = 0; j < 4; ++j) { s0[qt][j] = mb(qt, j, s0[qt][j]); s1[qt][j] = mb(qt, j + 4, s1[qt][j]); }
        mx[qt] = fmaxf(fmaxf(fmaxf(s0[qt][0], s0[qt][1]), fmaxf(s0[qt][2], s0[qt][3])), fmaxf(fmaxf(s1[qt][0], s1[qt][1]), fmaxf(s1[qt][2], s1[qt][3])));
    }
#pragma unroll
    for (int qt = 0; qt < NQT; ++qt) mx[qt] = rowmax4(mx[qt]);
    bool moved = false;
#pragma unroll
    for (int qt = 0; qt < NQT; ++qt) { mx[qt] = fmaxf(m[qt], mx[qt]); moved |= (mx[qt] != m[qt]); }
    if (__ballot(moved) != 0ull) {
#pragma unroll
        for (int qt = 0; qt < NQT; ++qt) {
            const float alpha = __builtin_amdgcn_exp2f(m[qt] - mx[qt]);
            l[qt] *= alpha;
#pragma unroll
            for (int dt = 0; dt < 4; ++dt) o[qt][dt] *= alpha;
        }
    }
    bf16x8 pf[NQT];
#pragma unroll
    for (int qt = 0; qt < NQT; ++qt) {
        m[qt] = mx[qt];
        float pr[8]; float ps = 0.f;
#pragma unroll
        for (int j = 0; j < 4; ++j) {
            pr[j] = (!MASK || s0[qt][j] > -1e29f) ? __builtin_amdgcn_exp2f(s0[qt][j] - mx[qt]) : 0.f;
            pr[j + 4] = (!MASK || s1[qt][j] > -1e29f) ? __builtin_amdgcn_exp2f(s1[qt][j] - mx[qt]) : 0.f;
        }
#pragma unroll
        for (int j = 0; j < 8; ++j) ps += pr[j];
        l[qt] += ps;
        const u32x4 pk = {pack2(pr[0], pr[1]), pack2(pr[2], pr[3]), pack2(pr[4], pr[5]), pack2(pr[6], pr[7])};
        pf[qt] = __builtin_bit_cast(bf16x8, pk);
    }
#pragma unroll
    for (int dt = 0; dt < 4; ++dt)
#pragma unroll
        for (int qt = 0; qt < NQT; ++qt) o[qt][dt] = __builtin_amdgcn_mfma_f32_16x16x32_bf16(f.v[dt], pf[qt], o[qt][dt], 0, 0, 0);
    __builtin_amdgcn_sched_barrier(0);
}
struct RangeIt { int c, c_hi; __device__ __forceinline__ int nxt() { if (c > c_hi) return -1; return (c++) * 32; } };
struct MaskIt { unsigned long long cm; __device__ __forceinline__ int nxt() { if (!cm) return -1; const int i = __builtin_ctzll(cm); cm &= cm - 1; return i * 32; } };
template <bool PFV, bool FM, class It, class Gen>
__device__ __forceinline__ void attn_run(It& it, const bf16_t* Kb, size_t ldk, const bf16_t* VTb, size_t ldv, int fr, int fq, const Gen& gen) {
    KVFrag fa, fb;
    int ka = it.nxt(); if (ka < 0) return;
    k_load<FM>(fa, Kb, ldk, ka, fr, fq); if (PFV) v_load<FM>(fa.v, VTb, ldv, ka, fr, fq);
    for (;;) {
        const int kb = it.nxt(); if (kb >= 0) { k_load<FM>(fb, Kb, ldk, kb, fr, fq); if (PFV) v_load<FM>(fb.v, VTb, ldv, kb, fr, fq); }
        if (!PFV) v_load<FM>(fa.v, VTb, ldv, ka, fr, fq);
        gen(ka, fa);
        if (kb < 0) break;
        ka = it.nxt(); if (ka >= 0) { k_load<FM>(fa, Kb, ldk, ka, fr, fq); if (PFV) v_load<FM>(fa.v, VTb, ldv, ka, fr, fq); }
        if (!PFV) v_load<FM>(fb.v, VTb, ldv, kb, fr, fq);
        gen(kb, fb);
        if (ka < 0) break;
    }
}
template <int NQT>
__device__ __forceinline__ void attn_init(f32x4 (&o)[NQT][4], float (&m)[NQT], float (&l)[NQT]) {
#pragma unroll
    for (int qt = 0; qt < NQT; ++qt) { m[qt] = MASKV; l[qt] = 0.f;
#pragma unroll
        for (int dt = 0; dt < 4; ++dt) o[qt][dt] = (f32x4){0.f, 0.f, 0.f, 0.f}; }
}
__device__ __forceinline__ float lsum4(float l) { return rowsum4(l); }
__device__ __forceinline__ void store_o4(bf16_t* dst, const f32x4 v) { u32x2 w; w.x = pack2(v[0], v[1]); w.y = pack2(v[2], v[3]); *(u32x2*)dst = w; }
__device__ __forceinline__ float sigmoidf_fast(float x) { return __builtin_amdgcn_rcpf(1.0f + __builtin_amdgcn_exp2f(-L2E * x)); }

__device__ __forceinline__ void fox_unit(const Params& p, int b, int h, int qb, int fr, int fq) {
    asm volatile("" : "+v"(fr), "+v"(fq));
    const int t0 = qb * 64;
    const bf16_t* Qb = p.hb + ((size_t)b * SEQ + t0) * NMAIN + C_FQ + h * 64 + fq * 8;
    bf16x8 qf[4][2];
#pragma unroll
    for (int qt = 0; qt < 4; ++qt) { qf[qt][0] = *(const bf16x8*)(Qb + (size_t)(qt * 16 + fr) * NMAIN); qf[qt][1] = *(const bf16x8*)(Qb + (size_t)(qt * 16 + fr) * NMAIN + 32); }
    const float* cf = p.cF + ((size_t)b * 4 + h) * SEQ;
    float cq[4];
#pragma unroll
    for (int qt = 0; qt < 4; ++qt) cq[qt] = cf[t0 + qt * 16 + fr] * L2E;
    f32x4 o[4][4]; float m[4], l[4];
    attn_init<4>(o, m, l);
    const bf16_t* Kb = p.kF + ((size_t)b * NVH + h) * 64 * SEQ;
    const bf16_t* VTb = p.vT + ((size_t)b * NVH + h) * 64 * SEQ;
    RangeIt it{0, (t0 >> 5) + 1};
    attn_run<false, true>(it, Kb, NMAIN, VTb, SEQ, fr, fq, [&](int kc0, const KVFrag& f) {
        const float4 ca = *(const float4*)(cf + kc0 + 8 * fq), cb = *(const float4*)(cf + kc0 + 8 * fq + 4);
        const float ck[8] = {ca.x * L2E, ca.y * L2E, ca.z * L2E, ca.w * L2E, cb.x * L2E, cb.y * L2E, cb.z * L2E, cb.w * L2E};
        const int kq = kc0 + 8 * fq - t0 - fr;
        attn_compute<4, true>(f, qf, o, m, l, [&](int qt, int j, float raw) { return (kq + j - 16 * qt) > 0 ? MASKV : raw * SCL2 + cq[qt] - ck[j]; });
    });
#pragma unroll
    for (int qt = 0; qt < 4; ++qt) {
        const float inv = __builtin_amdgcn_rcpf(lsum4(l[qt]));
        bf16_t* dst = p.ob + ((size_t)b * SEQ + t0 + qt * 16 + fr) * DM + h * 64 + 4 * fq;
#pragma unroll
        for (int dt = 0; dt < 4; ++dt) store_o4(dst + dt * 16, o[qt][dt] * inv);
    }
}
__device__ __forceinline__ void swa_unit(const Params& p, int l_, int b, int kv, int pos, int fr, int fq) {
    asm volatile("" : "+v"(fr), "+v"(fq));
    const int t0 = pos * 16, t = t0 + fr;
    const bf16_t* Qb = p.hb + ((size_t)b * SEQ + t) * NMAIN + C_SQ + kv * 192 + fq * 8;
    bf16x8 qf[3][2];
#pragma unroll
    for (int g = 0; g < 3; ++g) { qf[g][0] = *(const bf16x8*)(Qb + g * 64); qf[g][1] = *(const bf16x8*)(Qb + g * 64 + 32); }
    float sl[3];
#pragma unroll
    for (int g = 0; g < 3; ++g) sl[g] = slope_swa(kv * 3 + g) * L2E;
    f32x4 o[3][4]; float m[3], l[3];
    attn_init<3>(o, m, l);
    const bf16_t* Kb = p.kF + ((size_t)b * NVH + 4 + kv) * 64 * SEQ;
    const bf16_t* VTb = p.vT + ((size_t)b * NVH + 4 + kv) * 64 * SEQ;
    RangeIt it{max(0, t0 - 127) >> 5, (t0 + 15) >> 5};
    attn_run<true, true>(it, Kb, NMAIN, VTb, SEQ, fr, fq, [&](int kc0, const KVFrag& f) {
        const int dq = t - kc0 - 8 * fq;
        attn_compute<3, true>(f, qf, o, m, l, [&](int g, int j, float raw) { const int dist = dq - j; return (dist >= 0 && dist < 128) ? raw * SCL2 - sl[g] * (float)dist : MASKV; });
    });
#pragma unroll
    for (int g = 0; g < 3; ++g) {
        const float sink = p.sinks[l_ * 6 + kv * 3 + g] * L2E;
        const float inv = __builtin_amdgcn_rcpf(lsum4(l[g]) + __builtin_amdgcn_exp2f(sink - m[g]));
        bf16_t* dst = p.ob + ((size_t)b * SEQ + t) * DM + 256 + (kv * 3 + g) * 64 + 4 * fq;
#pragma unroll
        for (int dt = 0; dt < 4; ++dt) store_o4(dst + dt * 16, o[g][dt] * inv);
    }
}
__device__ __forceinline__ void nsa_unit(const Params& p, int b, int kv, int pos, int fr, int fq, int lane, float* ps, unsigned* msk, float* otl) {
    asm volatile("" : "+v"(fr), "+v"(fq), "+v"(lane));
    const int t0 = pos * 16, t = t0 + fr, cur = t0 >> 6;
    const bf16_t* Qb = p.hb + ((size_t)b * SEQ + t) * NMAIN + C_NQ + kv * 192 + fq * 8;
    bf16x8 qf[3][2];
#pragma unroll
    for (int g = 0; g < 3; ++g) { qf[g][0] = *(const bf16x8*)(Qb + g * 64); qf[g][1] = *(const bf16x8*)(Qb + g * 64 + 32); }
    float sl[3];
#pragma unroll
    for (int g = 0; g < 3; ++g) sl[g] = slope_nsa(kv * 3 + g) * L2E;
    const float* gl = p.hs + ((size_t)b * SEQ + t) * HS_W + 4 + kv * 9;
    f32x4 o[3][4]; float m[3], l[3];
    f32x4* otv = (f32x4*)otl + lane;
#pragma unroll
    for (int i = 0; i < 8; ++i) ps[lane + 64 * i] = 0.f;
    {
        const bf16_t* Kb = p.kc + ((size_t)b * 2 + kv) * 128 * 64;
        const bf16_t* VTb = p.vcT + ((size_t)b * 2 + kv) * 64 * 128;
        const int ncv = (t0 + 15 >= 31) ? ((t0 + 15 - 31) >> 4) + 1 : 0;
        const int nch = (ncv + 31) >> 5;
        attn_init<3>(o, m, l);
        const int dq0 = t - 31 - 16 * 8 * fq;
        RangeIt it{0, nch - 1};
        attn_run<false, false>(it, Kb, 64, VTb, 128, fr, fq, [&](int kc0, const KVFrag& f) {
            const int dq = dq0 - 16 * kc0;
            attn_compute<3, true>(f, qf, o, m, l, [&](int g, int j, float raw) { const int dist = dq - 16 * j; return dist >= 0 ? raw * SCL2 - sl[g] * (float)dist : MASKV; });
        });
        float il[3];
#pragma unroll
        for (int g = 0; g < 3; ++g) {
            const float lt = lsum4(l[g]); il[g] = lt > 0.f ? __builtin_amdgcn_rcpf(lt) : 0.f;
            const float gate = sigmoidf_fast(gl[g * 3 + 0]);
#pragma unroll
            for (int dt = 0; dt < 4; ++dt) otv[(g * 4 + dt) * 64] = o[g][dt] * (il[g] * gate);
        }
        float carry_prev = 0.f;
        for (int c = 0; c < nch; ++c) {
            const int kc0 = c * 32, dq = dq0 - 16 * kc0;
            const bf16_t* kp = Kb + (size_t)(kc0 + (fr >> 2) * 8 + (fr & 3)) * 64 + fq * 8;
            const bf16x8 k00 = *(const bf16x8*)(kp), k01 = *(const bf16x8*)(kp + 32), k10 = *(const bf16x8*)(kp + 256), k11 = *(const bf16x8*)(kp + 256 + 32);
            float pc[8];
#pragma unroll
            for (int j = 0; j < 8; ++j) pc[j] = 0.f;
#pragma unroll
            for (int g = 0; g < 3; ++g) {
                f32x4 s0 = (f32x4){0.f, 0.f, 0.f, 0.f}, s1 = s0;
                s0 = __builtin_amdgcn_mfma_f32_16x16x32_bf16(k00, qf[g][0], s0, 0, 0, 0); s0 = __builtin_amdgcn_mfma_f32_16x16x32_bf16(k01, qf[g][1], s0, 0, 0, 0);
                s1 = __builtin_amdgcn_mfma_f32_16x16x32_bf16(k10, qf[g][0], s1, 0, 0, 0); s1 = __builtin_amdgcn_mfma_f32_16x16x32_bf16(k11, qf[g][1], s1, 0, 0, 0);
#pragma unroll
                for (int j = 0; j < 8; ++j) {
                    const int dist = dq - 16 * j; const float raw = j < 4 ? s0[j] : s1[j - 4];
                    if (dist >= 0) pc[j] += __builtin_amdgcn_exp2f(raw * SCL2 - sl[g] * (float)dist - m[g]) * il[g];
                }
            }
            const float cout = 0.5f * pc[7];
            float cin = __shfl_up(cout, 16);
            const float cwrap = __shfl(cout, fr + 48);
            if (fq == 0) cin = carry_prev;
            carry_prev = cwrap;
            const int n0 = (kc0 >> 2) + 2 * fq;
            ps[fr * 32 + n0] = cin + pc[0] + pc[1] + pc[2] + 0.5f * pc[3];
            ps[fr * 32 + n0 + 1] = 0.5f * pc[3] + pc[4] + pc[5] + pc[6] + 0.5f * pc[7];
        }
    }
    lds_wave_sync();
    if (lane < 16) {
        unsigned mask = 1u | (1u << cur); if (cur >= 1) mask |= 1u << (cur - 1);
        if (cur >= 3) {
            if (cur - 2 <= 5) mask |= (1u << (cur - 1)) - 2u;
            else {
                const float* my = ps + lane * 32;
                for (int r = 0; r < 5; ++r) {
                    float best = -1.0f; int bi = 1;
                    for (int j = 1; j <= cur - 2; ++j) { const float v = my[j]; if (!((mask >> j) & 1u) && v > best) { best = v; bi = j; } }
                    mask |= 1u << bi;
                }
            }
        }
        msk[lane] = mask;
    }
    lds_wave_sync();
    const unsigned qmask = msk[fr];
    lds_wave_sync();
    {
        const bf16_t* Kb = p.kF + ((size_t)b * NVH + 6 + kv) * 64 * SEQ;
        const bf16_t* VTb = p.vT + ((size_t)b * NVH + 6 + kv) * 64 * SEQ;
        attn_init<3>(o, m, l);
        unsigned um = qmask;
        um |= __shfl_xor(um, 1); um |= __shfl_xor(um, 2); um |= __shfl_xor(um, 4); um |= __shfl_xor(um, 8);
        um = (unsigned)__builtin_amdgcn_readfirstlane((int)um) & (cur >= 31 ? 0xffffffffu : ((2u << cur) - 1u));
        unsigned long long cm = 0ull;
        for (unsigned r = um; r; r &= r - 1) { const int kb = __builtin_ctz(r); cm |= 3ull << (2 * kb); }
        MaskIt it{cm};
        attn_run<true, true>(it, Kb, NMAIN, VTb, SEQ, fr, fq, [&](int kc0, const KVFrag& f) {
            const bool mine = (qmask >> (kc0 >> 6)) & 1u;
            const int dq = t - kc0 - 8 * fq;
            attn_compute<3, true>(f, qf, o, m, l, [&](int g, int j, float raw) { const int dist = dq - j; return (mine && dist >= 0) ? raw * SCL2 - sl[g] * (float)dist : MASKV; });
        });
#pragma unroll
        for (int g = 0; g < 3; ++g) {
            const float lt = lsum4(l[g]); const float sc = (lt > 0.f ? __builtin_amdgcn_rcpf(lt) : 0.f) * sigmoidf_fast(gl[g * 3 + 1]);
#pragma unroll
            for (int dt = 0; dt < 4; ++dt) otv[(g * 4 + dt) * 64] += o[g][dt] * sc;
        }
    }
    {
        const bf16_t* Kb = p.kF + ((size_t)b * NVH + 8 + kv) * 64 * SEQ;
        const bf16_t* VTb = p.vT + ((size_t)b * NVH + 8 + kv) * 64 * SEQ;
        attn_init<3>(o, m, l);
        RangeIt it{max(0, t0 - 511) >> 5, (t0 + 15) >> 5};
        attn_run<true, true>(it, Kb, NMAIN, VTb, SEQ, fr, fq, [&](int kc0, const KVFrag& f) {
            const int dq = t - kc0 - 8 * fq;
            attn_compute<3, true>(f, qf, o, m, l, [&](int g, int j, float raw) { const int dist = dq - j; return (dist >= 0 && dist < 512) ? raw * SCL2 - sl[g] * (float)dist : MASKV; });
        });
#pragma unroll
        for (int g = 0; g < 3; ++g) {
            const float lt = lsum4(l[g]); const float sc = (lt > 0.f ? __builtin_amdgcn_rcpf(lt) : 0.f) * sigmoidf_fast(gl[g * 3 + 2]);
            bf16_t* dst = p.ob + ((size_t)b * SEQ + t) * DM + 640 + (kv * 3 + g) * 64 + 4 * fq;
#pragma unroll
            for (int dt = 0; dt < 4; ++dt) store_o4(dst + dt * 16, otv[(g * 4 + dt) * 64] + o[g][dt] * sc);
        }
    }
}

template <bool WITH_CONV>
__device__ __forceinline__ void phase_attn(const Params& p, int l, char* lds, int cslot = 16) {
    int tid = threadIdx.x; asm volatile("" : "+v"(tid));
    const int wid = tid >> 6, lane = tid & 63, fr = lane & 15, fq = lane >> 4;
    float* ps = (float*)(lds + wid * 16896); unsigned* msk = (unsigned*)(ps + 512); float* otl = ps + 576;
    unsigned* ctr = p.ctrl + cslot + l;
    constexpr unsigned NU_NSA = NB * 2 * 128, NU_FOX = NB * 4 * 32, NU_SWA = NB * 2 * 128, NU_ATT = NU_NSA + NU_FOX + NU_SWA;
    for (;;) {
        unsigned u = 0;
        if (lane == 0) u = __hip_atomic_fetch_add(ctr, 1u, __ATOMIC_RELAXED, __HIP_MEMORY_SCOPE_AGENT);
        u = (unsigned)__builtin_amdgcn_readfirstlane((int)u);
        if (WITH_CONV) {
            constexpr unsigned TOTQ = NU_ATT + (unsigned)CONV_TILES;
            if (u >= TOTQ) break;
            const unsigned a0 = (unsigned)(((unsigned long long)u * NU_ATT) / TOTQ), a1 = (unsigned)(((unsigned long long)(u + 1) * NU_ATT) / TOTQ);
            if (a1 == a0) { conv_tile_wave(p, (int)(u - a0), lane, (unsigned char*)ps); continue; }
            u = a0;
        } else {
#ifndef ATT_REP
#define ATT_REP 1
#endif
            if (u >= ATT_REP * NU_ATT) break;
            if (ATT_REP > 1) u %= NU_ATT;
        }
        if (u < NU_NSA) { const int pos = 127 - (int)(u & 127), r = u >> 7; nsa_unit(p, r >> 1, r & 1, pos, fr, fq, lane, ps, msk, otl); }
        else if (u < NU_NSA + NU_FOX) { const unsigned v = u - NU_NSA; const int qb = 31 - (int)(v & 31), r = v >> 5; fox_unit(p, r >> 2, r & 3, qb, fr, fq); }
        else { const unsigned v = u - NU_NSA - NU_FOX; const int pos = 127 - (int)(v & 127), r = v >> 7; swa_unit(p, l, r >> 1, r & 1, pos, fr, fq); }
    }
}

__device__ __forceinline__ void phase_ln1_router(const Params& p, int l, char* lds) {
    int tid = threadIdx.x; asm volatile("" : "+v"(tid));
    const int wid = tid >> 6, lane = tid & 63, fr = lane & 15, fq = lane >> 4;
    float* lg = (float*)lds + wid * 512;
    int* lcnt = (int*)(lds + 16384); int* lbase = lcnt + 32;
    const float* g1 = p.ln1_g + l * DM; const float* b1 = p.ln1_b + l * DM;
    const float* rw = p.rwT + (size_t)l * NE * 1024; const float* rb = p.router_b + l * NE;
    unsigned* gcount = p.ctrl + 64 + l * NE;
    for (int grp = blockIdx.x; grp < NTOK / 128; grp += gridDim.x) {
        const int tok0 = grp * 128 + wid * 16;
        if (tid < 32) lcnt[tid] = 0;
        float4 gg[4], bb[4];
#pragma unroll
        for (int j = 0; j < 4; ++j) { gg[j] = *(const float4*)(g1 + j * 256 + lane * 4); bb[j] = *(const float4*)(b1 + j * 256 + lane * 4); }
        for (int r0 = 0; r0 < 16; r0 += 4) {
            float4 v[4][4]; float s[4], qv[4];
#pragma unroll
            for (int i = 0; i < 4; ++i)
#pragma unroll
                for (int j = 0; j < 4; ++j) v[i][j] = *(const float4*)(p.tbuf + (size_t)(tok0 + r0 + i) * DM + j * 256 + lane * 4);
#pragma unroll
            for (int i = 0; i < 4; ++i) { s[i] = 0.f;
#pragma unroll
                for (int j = 0; j < 4; ++j) s[i] += (v[i][j].x + v[i][j].y) + (v[i][j].z + v[i][j].w); }
#pragma unroll
            for (int o = 32; o > 0; o >>= 1) {
#pragma unroll
                for (int i = 0; i < 4; ++i) s[i] += __shfl_xor(s[i], o); }
#pragma unroll
            for (int i = 0; i < 4; ++i) { const float mean = s[i] * (1.0f / 1024.0f); qv[i] = 0.f;
#pragma unroll
                for (int j = 0; j < 4; ++j) { v[i][j].x -= mean; v[i][j].y -= mean; v[i][j].z -= mean; v[i][j].w -= mean; qv[i] += (v[i][j].x * v[i][j].x + v[i][j].y * v[i][j].y) + (v[i][j].z * v[i][j].z + v[i][j].w * v[i][j].w); } }
#pragma unroll
            for (int o = 32; o > 0; o >>= 1) {
#pragma unroll
                for (int i = 0; i < 4; ++i) qv[i] += __shfl_xor(qv[i], o); }
#pragma unroll
            for (int i = 0; i < 4; ++i) {
                const float rstd = rsqrtf(qv[i] * (1.0f / 1024.0f) + LN_EPS);
                const size_t row = (size_t)(tok0 + r0 + i);
#pragma unroll
                for (int j = 0; j < 4; ++j) {
                    const int c = j * 256 + lane * 4;
                    float4 y; y.x = v[i][j].x * rstd * gg[j].x + bb[j].x; y.y = v[i][j].y * rstd * gg[j].y + bb[j].y; y.z = v[i][j].z * rstd * gg[j].z + bb[j].z; y.w = v[i][j].w * rstd * gg[j].w + bb[j].w;
                    *(float4*)(p.x1f + row * DM + c) = y;
                    *(unsigned*)((char*)p.x1b + row * DM + c) = pack4_fp8(y.x, y.y, y.z, y.w);
                }
            }
        }
        __syncthreads();
        f32x4 a0 = (f32x4){0.f, 0.f, 0.f, 0.f}, a1 = a0;
        const float* xr = p.x1f + (size_t)(tok0 + fr) * DM + 4 * fq;
        const float* w0 = rw + (size_t)fr * 1024 + 4 * fq; const float* w1 = rw + (size_t)(16 + fr) * 1024 + 4 * fq;
#pragma unroll 4
        for (int k0 = 0; k0 < 1024; k0 += 16) {
            const float4 xa = *(const float4*)(xr + k0), wb0 = *(const float4*)(w0 + k0), wb1 = *(const float4*)(w1 + k0);
            a0 = __builtin_amdgcn_mfma_f32_16x16x4f32(xa.x, wb0.x, a0, 0, 0, 0); a1 = __builtin_amdgcn_mfma_f32_16x16x4f32(xa.x, wb1.x, a1, 0, 0, 0);
            a0 = __builtin_amdgcn_mfma_f32_16x16x4f32(xa.y, wb0.y, a0, 0, 0, 0); a1 = __builtin_amdgcn_mfma_f32_16x16x4f32(xa.y, wb1.y, a1, 0, 0, 0);
            a0 = __builtin_amdgcn_mfma_f32_16x16x4f32(xa.z, wb0.z, a0, 0, 0, 0); a1 = __builtin_amdgcn_mfma_f32_16x16x4f32(xa.z, wb1.z, a1, 0, 0, 0);
            a0 = __builtin_amdgcn_mfma_f32_16x16x4f32(xa.w, wb0.w, a0, 0, 0, 0); a1 = __builtin_amdgcn_mfma_f32_16x16x4f32(xa.w, wb1.w, a1, 0, 0, 0);
        }
#pragma unroll
        for (int r = 0; r < 4; ++r) { lg[(fq * 4 + r) * 32 + fr] = a0[r] + rb[fr]; lg[(fq * 4 + r) * 32 + 16 + fr] = a1[r] + rb[16 + fr]; }
        lds_wave_sync();
        int e4[4] = {0, 0, 0, 0}; int rk[4] = {0, 0, 0, 0};
        if (lane < 16) {
            const float* my = lg + lane * 32; unsigned taken = 0u; float tv[4];
#pragma unroll
            for (int k = 0; k < 4; ++k) {
                float best = NEG_INF; int bi = 0;
                for (int e = 0; e < 32; ++e) { const float xv = my[e]; if (!((taken >> e) & 1u) && xv > best) { best = xv; bi = e; } }
                taken |= 1u << bi; e4[k] = bi; tv[k] = best;
            }
            const float e1 = __expf(tv[1] - tv[0]), e2 = __expf(tv[2] - tv[0]), e3 = __expf(tv[3] - tv[0]);
            const float inv = 1.0f / (1.0f + e1 + e2 + e3);
            const size_t row = (size_t)(tok0 + lane);
            *(float4*)(p.gw + row * 4) = make_float4(inv, e1 * inv, e2 * inv, e3 * inv);
        }
        __syncthreads();
        if (lane < 16) {
#pragma unroll
            for (int k = 0; k < 4; ++k) rk[k] = atomicAdd(&lcnt[e4[k]], 1);
        }
        __syncthreads();
        if (tid < 32) { const int c = lcnt[tid]; lbase[tid] = c ? (int)__hip_atomic_fetch_add(gcount + tid, (unsigned)c, __ATOMIC_RELAXED, __HIP_MEMORY_SCOPE_AGENT) : 0; }
        __syncthreads();
        if (lane < 16) {
            const int row = tok0 + lane; int pk[4];
#pragma unroll
            for (int k = 0; k < 4; ++k) { const int pos = lbase[e4[k]] + rk[k]; p.lists[(size_t)e4[k] * LIST_CAP + pos] = row * 4 + k; pk[k] = (pos << 5) | e4[k]; }
            *(int4*)(p.top_e + (size_t)row * 4) = make_int4(pk[0], pk[1], pk[2], pk[3]);
        }
        __syncthreads();
    }
}

__device__ __forceinline__ void phase_ln2(const Params& p, int l, float* xout, char* lds) {
    int* ptile = (int*)(lds + LDS_TAB); int* ecnt = ptile + 40;
    build_tiles(p, l, ptile, ecnt);
    int tid = threadIdx.x; asm volatile("" : "+v"(tid));
    const int wid = tid >> 6, lane = tid & 63;
    const float* g2 = p.ln2_g + l * DM; const float* b2 = p.ln2_b + l * DM;
    float4 gg[4], bb[4];
#pragma unroll
    for (int j = 0; j < 4; ++j) { gg[j] = *(const float4*)(g2 + j * 256 + lane * 4); bb[j] = *(const float4*)(b2 + j * 256 + lane * 4); }
    for (int pr = blockIdx.x * NWV + wid; pr < NTOK / 2; pr += gridDim.x * NWV) {
        float4 v[2][4]; float s[2], qv[2];
        u32x2 yv[2][4][4]; float gk[2][4];
#pragma unroll
        for (int i = 0; i < 2; ++i) {
            const int row = pr * 2 + i;
            const float4 gwv = *(const float4*)(p.gw + (size_t)row * 4);
            gk[i][0] = gwv.x; gk[i][1] = gwv.y; gk[i][2] = gwv.z; gk[i][3] = gwv.w;
            const int4 te = *(const int4*)(p.top_e + (size_t)row * 4);
            const int tk[4] = {te.x, te.y, te.z, te.w};
#pragma unroll
            for (int j = 0; j < 4; ++j) v[i][j] = *(const float4*)(p.x1f + (size_t)row * DM + j * 256 + lane * 4);
#pragma unroll
            for (int k = 0; k < 4; ++k) {
                const bf16_t* yr = p.ybuf + (size_t)(ptile[tk[k] & 31] * 256 + (tk[k] >> 5)) * DM + lane * 4;
#pragma unroll
                for (int j = 0; j < 4; ++j) yv[i][k][j] = *(const u32x2*)(yr + j * 256);
            }
        }
#pragma unroll
        for (int i = 0; i < 2; ++i) { s[i] = 0.f;
#pragma unroll
            for (int j = 0; j < 4; ++j) {
                float4 a; a.x = v[i][j].x * ALPHA; a.y = v[i][j].y * ALPHA; a.z = v[i][j].z * ALPHA; a.w = v[i][j].w * ALPHA;
#pragma unroll
                for (int k = 0; k < 4; ++k) {
                    const u32x2 w = yv[i][k][j];
                    a.x += gk[i][k] * __uint_as_float(w.x << 16); a.y += gk[i][k] * __uint_as_float(w.x & 0xffff0000u);
                    a.z += gk[i][k] * __uint_as_float(w.y << 16); a.w += gk[i][k] * __uint_as_float(w.y & 0xffff0000u);
                }
                v[i][j] = a; s[i] += (a.x + a.y) + (a.z + a.w);
            } }
#pragma unroll
        for (int o = 32; o > 0; o >>= 1) { s[0] += __shfl_xor(s[0], o); s[1] += __shfl_xor(s[1], o); }
#pragma unroll
        for (int i = 0; i < 2; ++i) { const float mean = s[i] * (1.0f / 1024.0f); qv[i] = 0.f;
#pragma unroll
            for (int j = 0; j < 4; ++j) { v[i][j].x -= mean; v[i][j].y -= mean; v[i][j].z -= mean; v[i][j].w -= mean; qv[i] += (v[i][j].x * v[i][j].x + v[i][j].y * v[i][j].y) + (v[i][j].z * v[i][j].z + v[i][j].w * v[i][j].w); } }
#pragma unroll
        for (int o = 32; o > 0; o >>= 1) { qv[0] += __shfl_xor(qv[0], o); qv[1] += __shfl_xor(qv[1], o); }
#pragma unroll
        for (int i = 0; i < 2; ++i) {
            const float rstd = rsqrtf(qv[i] * (1.0f / 1024.0f) + LN_EPS);
            const size_t row = (size_t)(pr * 2 + i);
#pragma unroll
            for (int j = 0; j < 4; ++j) {
                const int c = j * 256 + lane * 4;
                float4 y; y.x = v[i][j].x * rstd * gg[j].x + bb[j].x; y.y = v[i][j].y * rstd * gg[j].y + bb[j].y; y.z = v[i][j].z * rstd * gg[j].z + bb[j].z; y.w = v[i][j].w * rstd * gg[j].w + bb[j].w;
                *(float4*)(xout + row * DM + c) = y;
                u32x2 w; w.x = pack2(y.x, y.y); w.y = pack2(y.z, y.w);
                *(u32x2*)(p.xb + row * DM + c) = w;
            }
        }
    }
}

#define XB_TMO      128
#define XB_XCNT(j)  (256  + 64 * (j))
#define XB_XSUB(j)  (1280 + 64 * (j))
#define XB_XGEN(j)  (2304 + 64 * (j))
#define XB_TOP      3328
#define XB_TOPGEN   3392
#define XCD_BAR_WORDS 3456
#define XB_SPIN_CAP (1u << 22)
__device__ __forceinline__ unsigned xb_ld(unsigned* p)              { return __hip_atomic_load(p, __ATOMIC_RELAXED, __HIP_MEMORY_SCOPE_AGENT); }
__device__ __forceinline__ unsigned xb_add(unsigned* p, unsigned v) { return __hip_atomic_fetch_add(p, v, __ATOMIC_RELAXED, __HIP_MEMORY_SCOPE_AGENT); }
__device__ __forceinline__ unsigned xb_xcc_id() { return (unsigned)__builtin_amdgcn_s_getreg((3 << 11) | 20) & 0xFu; }
#define XB_SPIN(cond, bar) do { unsigned _sp = 0; while (cond) { __builtin_amdgcn_s_sleep(1); \
    if ((++_sp & 255u) == 0u) { if (xb_ld(&(bar)[XB_TMO])) break; if (_sp > XB_SPIN_CAP) { atomicAdd(&(bar)[XB_TMO], 1u); break; } } } } while (0)
struct XcdBarrier { unsigned* bar; unsigned x; volatile LAS unsigned* st; };
__device__ __forceinline__ XcdBarrier xcd_barrier_post(unsigned* bar, volatile LAS unsigned* st) {
    XcdBarrier b; b.bar = bar; b.x = xb_xcc_id(); b.st = st;
    if (threadIdx.x == 0) (void)xb_add(&bar[XB_XCNT(b.x)], 1u);
    return b;
}
__device__ __forceinline__ void xcd_barrier_complete(unsigned* bar, unsigned x, unsigned& nloc, unsigned& nx) {
    const unsigned G = gridDim.x * gridDim.y * gridDim.z;
    unsigned sum, cnt, mine, sp = 0u;
    for (;;) {
        sum = 0u; cnt = 0u; mine = 0u;
#pragma unroll
        for (unsigned j = 0; j < 16; ++j) { const unsigned c = xb_ld(&bar[XB_XCNT(j)]); sum += c; cnt += (c > 0u) ? 1u : 0u; mine = (j == x) ? c : mine; }
        if (sum == G) break;
        __builtin_amdgcn_s_sleep(1);
        if ((++sp & 255u) == 0u) { if (xb_ld(&bar[XB_TMO])) break; if (sp > XB_SPIN_CAP) { atomicAdd(&bar[XB_TMO], 1u); break; } }
    }
    nloc = mine > 0u ? mine : 1u; nx = cnt > 0u ? cnt : 1u;
}
__device__ __forceinline__ void xcd_barrier(const XcdBarrier& b) {
    asm volatile("s_waitcnt vmcnt(0)" ::: "memory");
    __syncthreads();
    if (threadIdx.x == 0) {
        unsigned* bar = b.bar;
        __builtin_amdgcn_s_waitcnt(0);
        unsigned nloc = b.st[0], nx = b.st[1];
        if (nloc == 0u) { xcd_barrier_complete(bar, b.x, nloc, nx); b.st[0] = nloc; b.st[1] = nx; }
        const unsigned old = xb_add(&bar[XB_XSUB(b.x)], 1u);
        const unsigned gen = old / nloc;
        if (old + 1u == (gen + 1u) * nloc) {
            __builtin_amdgcn_fence(__ATOMIC_RELEASE, "agent");
            asm volatile("s_waitcnt vmcnt(0)" ::: "memory");
            const unsigned og = xb_add(&bar[XB_TOP], 1u);
            const unsigned tg = og / nx;
            if (og + 1u == (tg + 1u) * nx) xb_add(&bar[XB_TOPGEN], 1u);
            else XB_SPIN(xb_ld(&bar[XB_TOPGEN]) == tg, bar);
            __builtin_amdgcn_fence(__ATOMIC_ACQUIRE, "agent");
            xb_add(&bar[XB_XGEN(b.x)], 1u);
            asm volatile("s_waitcnt vmcnt(0)" ::: "memory");
        } else {
            XB_SPIN(xb_ld(&bar[XB_XGEN(b.x)]) == gen, bar);
            __builtin_amdgcn_fence(__ATOMIC_ACQUIRE, "agent");
            asm volatile("s_waitcnt vmcnt(0)" ::: "memory");
        }
    }
    __syncthreads();
}

struct KArgs { const float* in[18]; float* out; char* ws; };
constexpr size_t al256(size_t v) { return (v + 255) / 256 * 256; }
struct WSL {
    static constexpr size_t ctrl = 0;
    static constexpr size_t WinT = al256(ctrl + 65536);
    static constexpr size_t WoT = al256(WinT + (size_t)NL * NPAD * 1024 * 2);
    static constexpr size_t W1T = al256(WoT + (size_t)NL * 1024 * 1024 * 2);
    static constexpr size_t W2T = al256(W1T + (size_t)NL * 2 * 64 * 2048 * 2);
    static constexpr size_t WguT = al256(W2T + (size_t)NL * 2 * 64 * 64 * 2);
    static constexpr size_t WdnT = al256(WguT + (size_t)NL * NE * 2048 * 1024 * 2);
    static constexpr size_t rwT = al256(WdnT + (size_t)NL * NE * 1024 * 1024 * 2);
    static constexpr size_t binp = al256(rwT + (size_t)NL * NE * 1024 * 4);
    static constexpr size_t bgup = al256(binp + (size_t)NL * NPAD * 4);
    static constexpr size_t b1c = al256(bgup + (size_t)NL * NE * 2048 * 4);
    static constexpr size_t xf = al256(b1c + 4 * 64 * 4);
    static constexpr size_t xb = al256(xf + (size_t)NTOK * DM * 4);
    static constexpr size_t hb = al256(xb + (size_t)NTOK * DM * 2);
    static constexpr size_t hs = al256(hb + (size_t)NTOK * NMAIN * 2);
    static constexpr size_t vT = al256(hs + (size_t)NTOK * HS_W * 4);
    static constexpr size_t kF = al256(vT + (size_t)NB * NVH * 64 * SEQ * 2);
    static constexpr size_t cF = al256(kF + (size_t)NB * NVH * 64 * SEQ * 2);
    static constexpr size_t kc = al256(cF + (size_t)NB * 4 * SEQ * 4);
    static constexpr size_t vc = al256(kc + (size_t)NB * 2 * 128 * 64 * 2);
    static constexpr size_t vcT = al256(vc + (size_t)NB * 2 * 128 * 64 * 2);
    static constexpr size_t ob = al256(vcT + (size_t)NB * 2 * 128 * 64 * 2);
    static constexpr size_t tbuf = al256(ob + (size_t)NTOK * DM * 2);
    static constexpr size_t x1f = al256(tbuf + (size_t)NTOK * DM * 4);
    static constexpr size_t x1b = al256(x1f + (size_t)NTOK * DM * 4);
    static constexpr size_t top_e = al256(x1b + (size_t)NTOK * DM * 2);
    static constexpr size_t gw = al256(top_e + (size_t)NTOK * 4 * 4);
    static constexpr size_t lists = al256(gw + (size_t)NTOK * 4 * 4);
    static constexpr size_t act = al256(lists + (size_t)NE * LIST_CAP * 4);
    static constexpr size_t ybuf = al256(act + (size_t)MAXSLOT * DFF * 2);
    static constexpr size_t total = al256(ybuf + (size_t)MAXSLOT * DM * 2);
};
__device__ __forceinline__ Params make_params(const KArgs& k) {
    Params p;
    p.x = k.in[0]; p.w_in = k.in[1]; p.b_in = k.in[2]; p.sinks = k.in[3]; p.cmp_pe = k.in[4]; p.cmp_w1 = k.in[5]; p.cmp_w2 = k.in[6]; p.w_out = k.in[7];
    p.ln1_g = k.in[8]; p.ln1_b = k.in[9]; p.router_w = k.in[10]; p.router_b = k.in[11]; p.w_gu = k.in[12]; p.b_gu = k.in[13]; p.w_dn = k.in[14]; p.b_dn = k.in[15];
    p.ln2_g = k.in[16]; p.ln2_b = k.in[17]; p.out = k.out;
    char* w = k.ws;
    p.ctrl = (unsigned*)(w + WSL::ctrl); p.WinT = (bf16_t*)(w + WSL::WinT); p.WoT = (bf16_t*)(w + WSL::WoT); p.W1T = (bf16_t*)(w + WSL::W1T); p.W2T = (bf16_t*)(w + WSL::W2T);
    p.WguT = (bf16_t*)(w + WSL::WguT); p.WdnT = (bf16_t*)(w + WSL::WdnT); p.rwT = (float*)(w + WSL::rwT); p.binp = (float*)(w + WSL::binp); p.bgup = (float*)(w + WSL::bgup);
    p.b1c = (float*)(w + WSL::b1c); p.xf = (float*)(w + WSL::xf); p.xb = (bf16_t*)(w + WSL::xb); p.hb = (bf16_t*)(w + WSL::hb); p.hs = (float*)(w + WSL::hs); p.vT = (bf16_t*)(w + WSL::vT); p.kF = (bf16_t*)(w + WSL::kF);
    p.cF = (float*)(w + WSL::cF); p.kc = (bf16_t*)(w + WSL::kc); p.vc = (bf16_t*)(w + WSL::vc); p.vcT = (bf16_t*)(w + WSL::vcT); p.ob = (bf16_t*)(w + WSL::ob); p.tbuf = (float*)(w + WSL::tbuf);
    p.x1f = (float*)(w + WSL::x1f); p.x1b = (bf16_t*)(w + WSL::x1b); p.top_e = (int*)(w + WSL::top_e); p.gw = (float*)(w + WSL::gw); p.lists = (int*)(w + WSL::lists);
    p.act = (bf16_t*)(w + WSL::act); p.ybuf = (bf16_t*)(w + WSL::ybuf);
    return p;
}
__device__ __forceinline__ void grid_bar(const Params& p, char* lds) {
    XcdBarrier xb; xb.bar = p.ctrl + 1024; xb.x = xb_xcc_id(); xb.st = (volatile LAS unsigned*)(lds + LDS_BYTES - 16); xcd_barrier(xb);
}
__device__ __forceinline__ Params fresh_params(const KArgs& ka) {
    KArgs k2 = ka; asm volatile("" : "+s"(k2.ws));
    return make_params(k2);
}
#ifndef REP
#define REP 0
#endif
template <int L>
__device__ __forceinline__ void layer_fwd(const KArgs& ka, char* lds) {
    { const Params p = fresh_params(ka); phase_inproj(p, L, lds);        grid_bar(p, lds); }
    { const Params p = fresh_params(ka); phase_prep(p, L, lds);          grid_bar(p, lds); }
    { const Params p = fresh_params(ka); phase_attn<L == 0>(p, L, lds);  grid_bar(p, lds); }
    { const Params p = fresh_params(ka); phase_outproj(p, L, L == 0 ? p.x : p.xf, lds);  grid_bar(p, lds); }
    { const Params p = fresh_params(ka); phase_ln1_router(p, L, lds);    grid_bar(p, lds); }
    { const Params p = fresh_params(ka); phase_gateup(p, L, lds);        grid_bar(p, lds); }
    { const Params p = fresh_params(ka); phase_down(p, L, lds);          grid_bar(p, lds); }
    { const Params p = fresh_params(ka); phase_ln2(p, L, L == NL - 1 ? p.out : p.xf, lds); }
}
__global__ void __launch_bounds__(NTHR, 2) fwd_kernel(KArgs ka) {
    extern __shared__ __attribute__((aligned(16))) char lds[];
    const Params p = make_params(ka);
    cg::grid_group grid = cg::this_grid();
    volatile LAS unsigned* xst = (volatile LAS unsigned*)(lds + LDS_BYTES - 16);
    if (threadIdx.x == 0) { xst[0] = 0u; xst[1] = 0u; }
    __syncthreads();
    (void)xcd_barrier_post(p.ctrl + 1024, xst);
    phase0(p, lds);
    if (REP & 128) { grid_bar(p, lds); phase0(p, lds); }
    grid.sync();
    layer_fwd<0>(ka, lds);
    grid_bar(p, lds);
    layer_fwd<1>(ka, lds);
}

extern "C" void kernel_launch(void* const* d_in, const int* in_sizes, int n_in, void* d_out, int out_size, void* d_ws, size_t ws_size, hipStream_t stream) {
    KArgs ka{};
    for (int i = 0; i < 18; ++i) ka.in[i] = (const float*)d_in[i];
    ka.out = (float*)d_out; ka.ws = (char*)d_ws;
    if (WSL::total > ws_size) { fprintf(stderr, "workspace too small: need %zu have %zu\n", (size_t)WSL::total, ws_size); return; }
    static int grid_blocks = 0;
    if (!grid_blocks) {
        int dev = 0, cus = 0, per_cu = 0;
        (void)hipGetDevice(&dev);
        (void)hipDeviceGetAttribute(&cus, hipDeviceAttributeMultiprocessorCount, dev);
        (void)hipFuncSetAttribute((const void*)fwd_kernel, hipFuncAttributeMaxDynamicSharedMemorySize, LDS_BYTES);
        (void)hipOccupancyMaxActiveBlocksPerMultiprocessor(&per_cu, fwd_kernel, NTHR, LDS_BYTES);
        if (per_cu < 1) { fprintf(stderr, "occupancy query says 0 blocks per CU\n"); per_cu = 1; }
        grid_blocks = cus;
    }
    (void)hipMemsetAsync(d_ws, 0, 65536, stream);
    void* args[] = {&ka};
    hipError_t e = hipLaunchCooperativeKernel((const void*)fwd_kernel, dim3(grid_blocks), dim3(NTHR), args, LDS_BYTES, stream);
    if (e != hipSuccess) fprintf(stderr, "cooperative launch failed: %s (grid %d)\n", hipGetErrorString(e), grid_blocks);
}
```

```cpp
#include <hip/hip_runtime.h>
#include <hip/hip_cooperative_groups.h>
#include <cstdio>
#include <cstdint>
namespace cg = cooperative_groups;

typedef unsigned short bf16_t;
typedef short bf16x8 __attribute__((ext_vector_type(8)));
typedef float f32x4 __attribute__((ext_vector_type(4)));
typedef unsigned u32x4 __attribute__((ext_vector_type(4)));
typedef unsigned u32x2 __attribute__((ext_vector_type(2)));
typedef int v8i_t __attribute__((ext_vector_type(8)));
typedef int v4i_t __attribute__((ext_vector_type(4)));
#define LAS __attribute__((address_space(3)))
constexpr float NEG_INF = -__builtin_huge_valf();

constexpr int DM = 1024, NB = 16, SEQ = 2048, NTOK = NB * SEQ, NL = 2;
constexpr int NCOL = 2582, NMAIN = 2560, NPAD = 2688, NE = 32, DFF = 1024;
constexpr int C_FQ = 0, C_FK = 256, C_FV = 512, C_SQ = 768, C_SK = 1152, C_SV = 1280, C_NQ = 1408,
              C_NKC = 1792, C_NVC = 1920, C_NKS = 2048, C_NVS = 2176, C_NKW = 2304, C_NVW = 2432;
constexpr int HS_W = 32;
constexpr int NVH = 10;
constexpr int LIST_CAP = NTOK;
constexpr int MAXSLOT = NTOK * 4 + NE * 256;
constexpr float ALPHA = 1.41421356237f, LN_EPS = 1e-5f, QSCALE = 0.125f;
constexpr int NWV = 8, NTHR = NWV * 64;
constexpr int LDS_STAGE = 131072, LDS_TAB = LDS_STAGE, LDS_AOFF = LDS_STAGE + 2048, LDS_BYTES = LDS_AOFF + 20480 + 256;

struct Params {
    const float *x, *w_in, *b_in, *sinks, *cmp_pe, *cmp_w1, *cmp_w2, *w_out, *ln1_g, *ln1_b, *router_w, *router_b,
                *w_gu, *b_gu, *w_dn, *b_dn, *ln2_g, *ln2_b;
    float* out;
    unsigned* ctrl;
    bf16_t *WinT, *WoT, *W1T, *W2T, *WguT, *WdnT;
    float *rwT, *binp, *bgup, *b1c;
    float* xf; bf16_t* xb; bf16_t* hb; float* hs; bf16_t* vT; bf16_t* kF; float* cF;
    bf16_t *kc, *vc, *vcT; bf16_t* ob; float* tbuf; float* x1f; bf16_t* x1b;
    int* top_e; float* gw; int* lists; bf16_t* act; bf16_t* ybuf;
};

__device__ __forceinline__ float bf2f(bf16_t h) { return __uint_as_float(((unsigned)h) << 16); }
typedef __bf16 bf16x2_t __attribute__((ext_vector_type(2)));
__device__ __forceinline__ bf16_t f2bf(float f) { return __builtin_bit_cast(bf16_t, (__bf16)f); }
__device__ __forceinline__ unsigned pack2(float lo, float hi) { bf16x2_t v = {(__bf16)lo, (__bf16)hi}; return __builtin_bit_cast(unsigned, v); }
__device__ __forceinline__ unsigned pack4_fp8(float a, float b, float c, float d) {
    unsigned w = 0u;
    w = __builtin_amdgcn_cvt_pk_fp8_f32(a, b, w, false);
    w = __builtin_amdgcn_cvt_pk_fp8_f32(c, d, w, true);
    return w;
}
__device__ __forceinline__ float shfl_f(float v, int src_lane) { return __int_as_float(__builtin_amdgcn_ds_bpermute(src_lane << 2, __float_as_int(v))); }
__device__ __forceinline__ unsigned shfl_u(unsigned v, int src_lane) { return (unsigned)__builtin_amdgcn_ds_bpermute(src_lane << 2, (int)v); }
__device__ __forceinline__ float wave_sum(float v) {
#pragma unroll
    for (int o = 32; o > 0; o >>= 1) v += __shfl_xor(v, o);
    return v;
}
__device__ __forceinline__ float wave_max(float v) {
#pragma unroll
    for (int o = 32; o > 0; o >>= 1) v = fmaxf(v, __shfl_xor(v, o));
    return v;
}
__device__ __forceinline__ void lds_wave_sync() { asm volatile("s_waitcnt lgkmcnt(0)" ::: "memory"); __builtin_amdgcn_wave_barrier(); }
__device__ __forceinline__ float slope_swa(int hq) { return exp2f(-8.0f * (float)(2 * hq + 1) / 12.0f); }
__device__ __forceinline__ float slope_nsa(int hq) { return exp2f(-8.0f * (float)(2 * hq + 2) / 12.0f); }

__device__ __forceinline__ int perm_row(int perm, int n) {
    if (perm == 1) { if (n < 768) return n; if (n < 772) return 2560 + (n - 768); if (n < 2564) return n - 4; return n; }
    if (perm == 2) { const int f = n >> 1, s = n & 1; return (f >> 7) * 256 + s * 128 + (f & 127); }
    return n;
}
struct ConvJob { const float* src; bf16_t* dst; int K, N, kt, nt, perm; float q8; };
__device__ __forceinline__ bool conv_job(const Params& p, int t, ConvJob& jb) {
    constexpr int T_WIN = NL * 8 * 21, T_WO = NL * 8 * 8;
    if (t < T_WIN) { const int m = t / 168, r = t % 168; jb = ConvJob{p.w_in + (size_t)m * 1024 * NCOL, p.WinT + (size_t)m * NPAD * 1024, 1024, NCOL, r / 21, r % 21, 1, 0.f}; return true; }
    t -= T_WIN;
    if (t < T_WO) { const int m = t / 64, r = t % 64; jb = ConvJob{p.w_out + (size_t)m * 1024 * 1024, (bf16_t*)((char*)p.WoT + (size_t)m * 1024 * 1024), 1024, 1024, r / 8, r % 8, 0, 64.0f}; return true; }
    return false;
}
constexpr int CONV_TILES = NL * NE * 192;
__device__ __forceinline__ void conv_tile_wave(const Params& p, int t, int lane, unsigned char* l8) {
    asm volatile("" : "+v"(lane));
    const int m = t / 192, r = t % 192;
    const float* src; unsigned char* dst; int N, kt, nt, perm;
    if (r < 128) { src = p.w_gu + (size_t)m * 1024 * 2048; dst = (unsigned char*)p.WguT + (size_t)m * 2048 * 1024; N = 2048; kt = r >> 4; nt = r & 15; perm = 2; }
    else { const int q = r - 128; src = p.w_dn + (size_t)m * 1024 * 1024; dst = (unsigned char*)p.WdnT + (size_t)m * 1024 * 1024; N = 1024; kt = q >> 3; nt = q & 7; perm = 0; }
    const float* s = src + (size_t)(kt * 128 + (lane >> 5)) * N + nt * 128 + (lane & 31) * 4;
    unsigned char* lw = l8 + (lane >> 5) * 132 + (lane & 31) * 4;
    float4 va[16], vb[16];
#pragma unroll
    for (int i = 0; i < 16; ++i) va[i] = *(const float4*)(s + (size_t)(2 * i) * N);
#pragma unroll
    for (int i = 0; i < 16; ++i) vb[i] = *(const float4*)(s + (size_t)(32 + 2 * i) * N);
#pragma unroll
    for (int i = 0; i < 16; ++i) *(unsigned*)(lw + (2 * i) * 132) = pack4_fp8(va[i].x * 64.0f, va[i].y * 64.0f, va[i].z * 64.0f, va[i].w * 64.0f);
#pragma unroll
    for (int i = 0; i < 16; ++i) va[i] = *(const float4*)(s + (size_t)(64 + 2 * i) * N);
#pragma unroll
    for (int i = 0; i < 16; ++i) *(unsigned*)(lw + (32 + 2 * i) * 132) = pack4_fp8(vb[i].x * 64.0f, vb[i].y * 64.0f, vb[i].z * 64.0f, vb[i].w * 64.0f);
#pragma unroll
    for (int i = 0; i < 16; ++i) vb[i] = *(const float4*)(s + (size_t)(96 + 2 * i) * N);
#pragma unroll
    for (int i = 0; i < 16; ++i) *(unsigned*)(lw + (64 + 2 * i) * 132) = pack4_fp8(va[i].x * 64.0f, va[i].y * 64.0f, va[i].z * 64.0f, va[i].w * 64.0f);
#pragma unroll
    for (int i = 0; i < 16; ++i) *(unsigned*)(lw + (96 + 2 * i) * 132) = pack4_fp8(vb[i].x * 64.0f, vb[i].y * 64.0f, vb[i].z * 64.0f, vb[i].w * 64.0f);
    lds_wave_sync();
#pragma unroll 4
    for (int i = 0; i < 16; ++i) {
        const int idx = lane + 64 * i, kc = idx & 7, nn = idx >> 3;
        const unsigned char* l = l8 + (kc * 16) * 132 + nn;
        u32x4 w;
        w.x = (unsigned)l[0] | ((unsigned)l[132] << 8) | ((unsigned)l[264] << 16) | ((unsigned)l[396] << 24);
        w.y = (unsigned)l[528] | ((unsigned)l[660] << 8) | ((unsigned)l[792] << 16) | ((unsigned)l[924] << 24);
        w.z = (unsigned)l[1056] | ((unsigned)l[1188] << 8) | ((unsigned)l[1320] << 16) | ((unsigned)l[1452] << 24);
        w.w = (unsigned)l[1584] | ((unsigned)l[1716] << 8) | ((unsigned)l[1848] << 16) | ((unsigned)l[1980] << 24);
        *(u32x4*)(dst + (size_t)perm_row(perm, nt * 128 + nn) * 1024 + kt * 128 + kc * 16) = w;
    }
    lds_wave_sync();
}
__device__ __forceinline__ void conv_load(const ConvJob& jb, int tid, float2 (&v)[16]) {
    const int n = jb.nt * 128 + (tid & 31) * 4;
    const float* s = jb.src + (size_t)(jb.kt * 128 + (tid >> 5)) * jb.N + n;
#pragma unroll
    for (int i = 0; i < 8; ++i) {
        const float* r = s + (size_t)(16 * i) * jb.N;
        v[2 * i] = (n + 1 < jb.N) ? *(const float2*)r : make_float2(0.f, 0.f);
        v[2 * i + 1] = (n + 3 < jb.N) ? *(const float2*)(r + 2) : make_float2(0.f, 0.f);
    }
}
__device__ __forceinline__ void phase0(const Params& p, char* ldsc) {
    int tid = threadIdx.x; asm volatile("" : "+v"(tid));
    const int G = gridDim.x, bid = blockIdx.x;
    const size_t gtid = (size_t)bid * NTHR + tid, gthreads = (size_t)G * NTHR;
    {
        constexpr int TOT = NL * 8 * 21 + NL * 8 * 8;
        bf16_t* lt = (bf16_t*)ldsc;
        ConvJob jb, jn; float2 v[16], vn[16];
        int t = bid; bool have = t < TOT && conv_job(p, t, jb);
        if (have) conv_load(jb, tid, v);
        while (have) {
            const int tn = t + G; const bool hn = tn < TOT && conv_job(p, tn, jn);
            if (hn) conv_load(jn, tid, vn);
            if (jb.q8 != 0.f) {
                unsigned char* l8 = (unsigned char*)lt;
#pragma unroll
                for (int i = 0; i < 8; ++i)
                    *(unsigned*)(l8 + ((tid >> 5) + 16 * i) * 132 + (tid & 31) * 4) = pack4_fp8(v[2 * i].x * jb.q8, v[2 * i].y * jb.q8, v[2 * i + 1].x * jb.q8, v[2 * i + 1].y * jb.q8);
                __syncthreads();
#pragma unroll
                for (int i = 0; i < 2; ++i) {
                    const int idx = tid + NTHR * i, kc = idx & 7, nn = idx >> 3, n = jb.nt * 128 + nn;
                    const unsigned char* l = l8 + (kc * 16) * 132 + nn;
                    u32x4 w;
                    w.x = (unsigned)l[0] | ((unsigned)l[132] << 8) | ((unsigned)l[264] << 16) | ((unsigned)l[396] << 24);
                    w.y = (unsigned)l[528] | ((unsigned)l[660] << 8) | ((unsigned)l[792] << 16) | ((unsigned)l[924] << 24);
                    w.z = (unsigned)l[1056] | ((unsigned)l[1188] << 8) | ((unsigned)l[1320] << 16) | ((unsigned)l[1452] << 24);
                    w.w = (unsigned)l[1584] | ((unsigned)l[1716] << 8) | ((unsigned)l[1848] << 16) | ((unsigned)l[1980] << 24);
                    *(u32x4*)((char*)jb.dst + (size_t)perm_row(jb.perm, n) * jb.K + jb.kt * 128 + kc * 16) = w;
                }
            } else {
#pragma unroll
                for (int i = 0; i < 8; ++i) {
                    u32x2 w; w.x = pack2(v[2 * i].x, v[2 * i].y); w.y = pack2(v[2 * i + 1].x, v[2 * i + 1].y);
                    *(u32x2*)(lt + ((tid >> 5) + 16 * i) * 136 + (tid & 31) * 4) = w;
                }
                __syncthreads();
#pragma unroll
                for (int i = 0; i < 4; ++i) {
                    const int idx = tid + NTHR * i, kc = idx & 15, nn = idx >> 4, n = jb.nt * 128 + nn;
                    if (n < jb.N) {
                        const bf16_t* l = lt + (kc * 8) * 136 + nn;
                        u32x4 w;
                        w.x = (unsigned)l[0] | ((unsigned)l[136] << 16); w.y = (unsigned)l[272] | ((unsigned)l[408] << 16);
                        w.z = (unsigned)l[544] | ((unsigned)l[680] << 16); w.w = (unsigned)l[816] | ((unsigned)l[952] << 16);
                        *(u32x4*)(jb.dst + (size_t)perm_row(jb.perm, n) * jb.K + jb.kt * 128 + kc * 8) = w;
                    }
                }
            }
            __syncthreads();
            t = tn; have = hn; jb = jn;
#pragma unroll
            for (int i = 0; i < 16; ++i) v[i] = vn[i];
        }
    }
    for (size_t i = gtid; i < (size_t)NL * 2 * 2048 * 64; i += gthreads) {
        const int k = (int)(i % 2048), n = (int)((i / 2048) % 64), m = (int)(i / (2048 * 64));
        p.W1T[i] = f2bf(p.cmp_w1[((size_t)m * 2048 + k) * 64 + n]);
    }
    for (size_t i = gtid; i < (size_t)NL * 2 * 64 * 64; i += gthreads) {
        const int k = (int)(i % 64), n = (int)((i / 64) % 64), m = (int)(i / 4096);
        p.W2T[i] = f2bf(p.cmp_w2[((size_t)m * 64 + k) * 64 + n]);
    }
    for (size_t i = gtid; i < (size_t)NL * NPAD; i += gthreads) {
        const int l = (int)(i / NPAD), r = (int)(i % NPAD);
        float v = 0.f;
        if (r < 2560) { const int n = r < 768 ? r : r + 4; v = p.b_in[l * NCOL + n]; }
        else if (r < 2564) v = p.b_in[l * NCOL + 768 + (r - 2560)];
        else if (r < 2582) v = p.b_in[l * NCOL + r];
        p.binp[i] = v;
    }
    for (size_t i = gtid; i < (size_t)NL * NE * 2048; i += gthreads) {
        const int r = (int)(i % 2048); const size_t le = i / 2048;
        const int s = (r >> 7) & 1, f = (r >> 8) * 128 + (r & 127);
        p.bgup[i] = p.b_gu[le * 2048 + 2 * f + s];
    }
    for (size_t i = gtid; i < (size_t)NL * NE * 1024; i += gthreads) {
        const int k = (int)(i % 1024), e = (int)((i / 1024) % NE), l = (int)(i / (1024 * NE));
        p.rwT[i] = p.router_w[((size_t)l * 1024 + k) * NE + e];
    }
    for (size_t i = gtid; i < (size_t)NL * (NPAD - NCOL) * 1024; i += gthreads) {
        const int l = (int)(i / ((NPAD - NCOL) * 1024)); const size_t r = i % ((size_t)(NPAD - NCOL) * 1024);
        p.WinT[(size_t)l * NPAD * 1024 + (size_t)NCOL * 1024 + r] = 0;
    }
    for (size_t i = gtid; i < (size_t)NTOK * DM / 4; i += gthreads) {
        const float4 v4 = ((const float4*)p.x)[i];
        u32x2 w; w.x = pack2(v4.x, v4.y); w.y = pack2(v4.z, v4.w);
        ((u32x2*)p.xb)[i] = w;
    }
    if (bid < 4) {
        float* lf = (float*)ldsc;
        const int j = tid & 63, part = tid >> 6;
        const float* pe = p.cmp_pe + (size_t)bid * 2048; const float* w1 = p.cmp_w1 + (size_t)bid * 2048 * 64;
        float s = 0.f;
        for (int kk = part * 256; kk < part * 256 + 256; ++kk) s += pe[kk] * w1[(size_t)kk * 64 + j];
        lf[tid] = s; __syncthreads();
        if (tid < 64) { float a = 0.f; for (int q = 0; q < 8; ++q) a += lf[tid + 64 * q]; p.b1c[bid * 64 + tid] = a; }
        __syncthreads();
    }
}

namespace pg8 {
constexpr int BM = 256, BK = 64, HALF = 128, HTB = HALF * BK * 2, NXCD = 8, WGM = 8;
__device__ __forceinline__ int lds_byte(int r, int c) { const int st = (r >> 4) * 2 + (c >> 5), rr = r & 15, cc = c & 31, ob = rr * 64 + cc * 2; return st * 1024 + (ob ^ (((ob >> 9) & 1) << 5)); }
__device__ __forceinline__ void stage_rc(int b, int& R, int& C) { const int st = b / 1024, sb = b % 1024, swz = sb ^ (((sb >> 9) & 1) << 5); R = (st >> 1) * 16 + swz / 64; C = (st & 1) * 32 + (swz % 64) / 2; }
__device__ __forceinline__ bool tile_order(int i, int G, int c, int nM, int nN, int& pm, int& pn) {
    const int nwg = nM * nN; const long L = (long)i * G + c; if (L >= nwg) return false;
    int wgid = (int)L; { const int q = nwg / NXCD, r = nwg % NXCD, xcd = wgid % NXCD, off = wgid / NXCD; wgid = (xcd < r ? xcd * (q + 1) : r * (q + 1) + (xcd - r) * q) + off; }
    const int nig = WGM * nN, gid = wgid / nig, fm = gid * WGM, gsz = (nM - fm) < WGM ? (nM - fm) : WGM;
    pm = fm + ((wgid % nig) % gsz); pn = (wgid % nig) / gsz; return true;
}
template <bool FP8, int SCA, class Sched, class Epi>
__device__ __forceinline__ void gemm_phase(LAS unsigned char* lds, const char* Abase, int K, const Sched& S, const Epi& E) {
    int tid = threadIdx.x; asm volatile("" : "+v"(tid));
    const int wid = __builtin_amdgcn_readfirstlane(tid >> 6), lane = tid & 63, wr = wid >> 2, wc = wid & 3, fr = lane & 15, fq = lane >> 4;
    const int nt = K / BK;
    int R0, C0, R1, C1; stage_rc(tid * 16, R0, C0); stage_rc(tid * 16 + 8192, R1, C1);
    LAS unsigned* aofs = (LAS unsigned*)(lds + LDS_AOFF) + tid;
    unsigned rg[10];
    rg[8] = (unsigned)(R0 * K + C0) * 2u; rg[9] = (unsigned)(R1 * K + C1) * 2u;
    if constexpr (FP8) { aofs[8 * NTHR] = rg[8]; aofs[9 * NTHR] = rg[9]; }
    const size_t kstep = (size_t)(BK * 2), hstep = (size_t)HALF * K * 2;
    const unsigned ldsw = (unsigned)wid * 1024u;
    const int aoff = lds_byte(wr * 64 + fr, fq * 8), boff = lds_byte(wc * 32 + fr, fq * 8);
#define PG8_SA(b, h) (((b) * 2 + (h)) * HTB)
#define PG8_SB(b, h) ((4 + (b) * 2 + (h)) * HTB)
#define PG8_OFS(sel, j) (FP8 ? aofs[((sel) * 4 + (j)) * NTHR] : ((sel) ? rg[4 + (j)] : rg[(j)]))
#define PG8_STAGE_B(bufoff, gbase) do { _Pragma("unroll") for (int _i = 0; _i < 2; ++_i) { const unsigned ob_ = FP8 ? aofs[(8 + _i) * NTHR] : rg[8 + _i]; \
        __builtin_amdgcn_global_load_lds((const unsigned*)((const char*)(gbase) + ob_), (LAS unsigned*)(lds + (bufoff) + ldsw + _i * 8192), 16, 0, 0); } } while (0)
#define PG8_STAGE_A(bufoff, kbyte, sel, h) do { const unsigned o0_ = PG8_OFS(sel, (h) * 2), o1_ = PG8_OFS(sel, (h) * 2 + 1); \
        __builtin_amdgcn_global_load_lds((const unsigned*)(Abase + (kbyte) + o0_), (LAS unsigned*)(lds + (bufoff) + ldsw), 16, 0, 0); \
        __builtin_amdgcn_global_load_lds((const unsigned*)(Abase + (kbyte) + o1_), (LAS unsigned*)(lds + (bufoff) + ldsw + 8192), 16, 0, 0); } while (0)
#define PG8_LDA(dst, b, h) do { _Pragma("unroll") for (int m = 0; m < 4; ++m) { \
        if constexpr (FP8) { const v4i_t lo_ = *(const LAS v4i_t*)(lds + PG8_SA(b, h) + aoff + m * 2048), hi_ = *(const LAS v4i_t*)(lds + PG8_SA(b, h) + aoff + m * 2048 + 1024); dst##8[m] = __builtin_shufflevector(lo_, hi_, 0, 1, 2, 3, 4, 5, 6, 7); } \
        else { _Pragma("unroll") for (int k = 0; k < 2; ++k) dst[m][k] = *(const LAS bf16x8*)(lds + PG8_SA(b, h) + aoff + m * 2048 + k * 1024); } } } while (0)
#define PG8_LDB(dst, b, h) do { _Pragma("unroll") for (int n = 0; n < 2; ++n) { \
        if constexpr (FP8) { const v4i_t lo_ = *(const LAS v4i_t*)(lds + PG8_SB(b, h) + boff + n * 2048), hi_ = *(const LAS v4i_t*)(lds + PG8_SB(b, h) + boff + n * 2048 + 1024); dst##8[n] = __builtin_shufflevector(lo_, hi_, 0, 1, 2, 3, 4, 5, 6, 7); } \
        else { _Pragma("unroll") for (int k = 0; k < 2; ++k) dst[n][k] = *(const LAS bf16x8*)(lds + PG8_SB(b, h) + boff + n * 2048 + k * 1024); } } } while (0)
#define PG8_MMA(ai, bj, At, Bt) do { __builtin_amdgcn_s_setprio(1); _Pragma("unroll") for (int m = 0; m < 4; ++m) _Pragma("unroll") for (int n = 0; n < 2; ++n) { \
        if constexpr (FP8) { acc[ai][bj][m][n] = __builtin_amdgcn_mfma_scale_f32_16x16x128_f8f6f4(Bt##8[n], At##8[m], acc[ai][bj][m][n], 0, 0, 0, SCA, 0, SCA); } \
        else { _Pragma("unroll") for (int k = 0; k < 2; ++k) acc[ai][bj][m][n] = __builtin_amdgcn_mfma_f32_16x16x32_bf16(Bt[n][k], At[m][k], acc[ai][bj][m][n], 0, 0, 0); } } \
        __builtin_amdgcn_s_setprio(0); } while (0)
#define PG8_WAIT_V(n) asm volatile("s_waitcnt vmcnt(" #n ")" ::: "memory")
#define PG8_WAIT_L(n) asm volatile("s_waitcnt lgkmcnt(" #n ")" ::: "memory")
#define PG8_BAR __builtin_amdgcn_s_barrier()
#define PG8_SCHED __builtin_amdgcn_sched_barrier(0)
    typename Sched::Unit cur, nxt; int ui = 0;
    if (!S.next(0, cur)) return;
    f32x4 acc[2][2][4][2];
#pragma unroll
    for (int a = 0; a < 2; ++a)
#pragma unroll
        for (int b = 0; b < 2; ++b)
#pragma unroll
            for (int m = 0; m < 4; ++m)
#pragma unroll
                for (int n = 0; n < 2; ++n) acc[a][b][m][n] = (f32x4){0.f, 0.f, 0.f, 0.f};
    bf16x8 At[4][2], B0[2][2], B1[2][2];
    v8i_t At8[4], B08[2], B18[2];
    { unsigned a4[2][2]; S.a_off(cur, R0, C0, R1, C1, a4); rg[0] = a4[0][0]; rg[1] = a4[0][1]; rg[2] = a4[1][0]; rg[3] = a4[1][1];
      if constexpr (FP8) { aofs[0] = a4[0][0]; aofs[NTHR] = a4[0][1]; aofs[2 * NTHR] = a4[1][0]; aofs[3 * NTHR] = a4[1][1]; } }
    const char* cB = S.b_ptr(cur);
    PG8_STAGE_B(PG8_SB(0, 0), cB); PG8_STAGE_B(PG8_SB(0, 1), cB + hstep); PG8_STAGE_A(PG8_SA(0, 0), 0, 0, 0); PG8_STAGE_A(PG8_SA(0, 1), 0, 0, 1);
    if (wr == 1) PG8_BAR;
    PG8_WAIT_V(2); PG8_BAR;
    PG8_STAGE_B(PG8_SB(1, 0), cB + kstep); PG8_STAGE_A(PG8_SA(1, 0), kstep, 0, 0); PG8_STAGE_B(PG8_SB(1, 1), cB + hstep + kstep);
    PG8_WAIT_V(6); PG8_BAR;
    for (;;) {
        const bool has_next = S.next(ui + 1, nxt);
        const char* nB = cB;
        if (has_next) { int t2 = threadIdx.x; asm volatile("" : "+v"(t2)); int r0, c0, r1, c1; stage_rc(t2 * 16, r0, c0); stage_rc(t2 * 16 + 8192, r1, c1); unsigned a4[2][2]; S.a_off(nxt, r0, c0, r1, c1, a4); nB = S.b_ptr(nxt);
            rg[4] = a4[0][0]; rg[5] = a4[0][1]; rg[6] = a4[1][0]; rg[7] = a4[1][1];
            if constexpr (FP8) { aofs[4 * NTHR] = a4[0][0]; aofs[5 * NTHR] = a4[0][1]; aofs[6 * NTHR] = a4[1][0]; aofs[7 * NTHR] = a4[1][1]; } }
        else { rg[4] = rg[0]; rg[5] = rg[1]; rg[6] = rg[2]; rg[7] = rg[3];
            if constexpr (FP8) { aofs[4 * NTHR] = aofs[0]; aofs[5 * NTHR] = aofs[NTHR]; aofs[6 * NTHR] = aofs[2 * NTHR]; aofs[7 * NTHR] = aofs[3 * NTHR]; } }
#pragma unroll 1
        for (int t = 0; t < nt; t += 2) {
            const bool last = (t == nt - 2);
            const size_t ka1 = (size_t)(t + 1) * kstep, ka2 = last ? 0 : (size_t)(t + 2) * kstep, ka3 = ka2 + kstep;
            const char* b2 = last ? nB : cB + (size_t)(t + 2) * kstep; const char* b3 = b2 + kstep;
            const int sel = last ? 1 : 0;
            PG8_LDB(B0, 0, 0); PG8_LDB(B1, 0, 1); PG8_SCHED; PG8_LDA(At, 0, 0); PG8_STAGE_A(PG8_SA(1, 1), ka1, 0, 1);
            PG8_WAIT_V(8); PG8_WAIT_L(0); PG8_BAR; PG8_MMA(0, 0, At, B0); PG8_MMA(0, 1, At, B1); PG8_BAR; PG8_SCHED;
            PG8_LDA(At, 0, 1); PG8_STAGE_B(PG8_SB(0, 0), b2); PG8_STAGE_B(PG8_SB(0, 1), b2 + hstep); PG8_STAGE_A(PG8_SA(0, 0), ka2, sel, 0);
            PG8_WAIT_V(8); PG8_WAIT_L(0); PG8_BAR; PG8_MMA(1, 0, At, B0); PG8_MMA(1, 1, At, B1); PG8_BAR; PG8_SCHED;
            PG8_LDB(B0, 1, 0); PG8_LDB(B1, 1, 1); PG8_SCHED; PG8_LDA(At, 1, 0); PG8_STAGE_A(PG8_SA(0, 1), ka2, sel, 1);
            PG8_WAIT_V(8); PG8_WAIT_L(0); PG8_BAR; PG8_MMA(0, 0, At, B0); PG8_MMA(0, 1, At, B1); PG8_BAR; PG8_SCHED;
            PG8_LDA(At, 1, 1); PG8_STAGE_B(PG8_SB(1, 0), b3); PG8_STAGE_B(PG8_SB(1, 1), b3 + hstep); PG8_STAGE_A(PG8_SA(1, 0), ka3, sel, 0);
            PG8_WAIT_V(8); PG8_WAIT_L(0); PG8_BAR; PG8_MMA(1, 0, At, B0); PG8_MMA(1, 1, At, B1); PG8_BAR; PG8_SCHED;
        }
        if (wr == 0) PG8_BAR;
        { int t2 = threadIdx.x; asm volatile("" : "+v"(t2)); E(acc, cur, wr, wc, t2 & 15, (t2 & 63) >> 4); }
        if (!has_next) break;
#pragma unroll
        for (int a = 0; a < 2; ++a)
#pragma unroll
            for (int b = 0; b < 2; ++b)
#pragma unroll
                for (int m = 0; m < 4; ++m)
#pragma unroll
                    for (int n = 0; n < 2; ++n) acc[a][b][m][n] = (f32x4){0.f, 0.f, 0.f, 0.f};
        cur = nxt; cB = nB; ++ui;
        rg[0] = rg[4]; rg[1] = rg[5]; rg[2] = rg[6]; rg[3] = rg[7];
        if constexpr (FP8) { aofs[0] = aofs[4 * NTHR]; aofs[NTHR] = aofs[5 * NTHR]; aofs[2 * NTHR] = aofs[6 * NTHR]; aofs[3 * NTHR] = aofs[7 * NTHR]; }
        if (wr == 1) PG8_BAR;
    }
    PG8_WAIT_V(0);
    PG8_BAR;
#undef PG8_SA
#undef PG8_SB
#undef PG8_STAGE_A
#undef PG8_OFS
#undef PG8_STAGE_B
#undef PG8_LDA
#undef PG8_LDB
#undef PG8_MMA
#undef PG8_WAIT_V
#undef PG8_WAIT_L
#undef PG8_BAR
#undef PG8_SCHED
}
}

struct DenseUnit { int pm, pn; };
struct DenseSched {
    typedef DenseUnit Unit;
    const char* Bt; int K, nM, nN;
    __device__ __forceinline__ bool next(int i, Unit& u) const { return pg8::tile_order(i, gridDim.x, blockIdx.x, nM, nN, u.pm, u.pn); }
    __device__ __forceinline__ void a_off(const Unit& u, int R0, int C0, int R1, int C1, unsigned (&off)[2][2]) const {
#pragma unroll
        for (int h = 0; h < 2; ++h) { off[h][0] = (unsigned)((u.pm * 256 + h * 128 + R0) * K + C0) * 2u; off[h][1] = (unsigned)((u.pm * 256 + h * 128 + R1) * K + C1) * 2u; }
    }
    __device__ __forceinline__ const char* b_ptr(const Unit& u) const { return Bt + (size_t)u.pn * 256 * K * 2; }
};
struct MoeUnit { int rbt, e, pn; };
template <bool GATHER>
struct MoeSched {
    typedef MoeUnit Unit;
    static constexpr int KP = 512;
    const char* Bt; const int* lists; const int* ptile; const int* ecnt; int nN, nrows;
    __device__ __forceinline__ bool next(int i, Unit& u) const {
        int pm, pn; if (!pg8::tile_order(i, gridDim.x, blockIdx.x, ptile[NE], nN, pm, pn)) return false;
        int e = 0; while (ptile[e + 1] <= pm) ++e;
        u.rbt = pm; u.e = e; u.pn = pn; return true;
    }
    __device__ __forceinline__ void a_off(const Unit& u, int R0, int C0, int R1, int C1, unsigned (&off)[2][2]) const {
        if (GATHER) {
            const int* lst = lists + (size_t)u.e * LIST_CAP; const int rb = u.rbt - ptile[u.e], cnt = ecnt[u.e];
#pragma unroll
            for (int h = 0; h < 2; ++h) {
                const int l0 = rb * 256 + h * 128 + R0, l1 = rb * 256 + h * 128 + R1;
                const int t0 = l0 < cnt ? (lst[l0] >> 2) : 0, t1 = l1 < cnt ? (lst[l1] >> 2) : 0;
                off[h][0] = (unsigned)(t0 * KP + C0) * 2u; off[h][1] = (unsigned)(t1 * KP + C1) * 2u;
            }
        } else {
#pragma unroll
            for (int h = 0; h < 2; ++h) { off[h][0] = (unsigned)((u.rbt * 256 + h * 128 + R0) * KP + C0) * 2u; off[h][1] = (unsigned)((u.rbt * 256 + h * 128 + R1) * KP + C1) * 2u; }
        }
    }
    __device__ __forceinline__ const char* b_ptr(const Unit& u) const { return Bt + ((size_t)u.e * nrows + (size_t)u.pn * 256) * KP * 2; }
};

struct EpiInProj {
    const Params* p; int l;
    __device__ __forceinline__ void operator()(const f32x4 (&acc)[2][2][4][2], const DenseUnit& u, int wr, int wc, int fr, int fq) const {
        const float* bias = p->binp + l * NPAD + u.pn * 256;
#pragma unroll
        for (int bj = 0; bj < 2; ++bj) {
            int kind = 0, hb0 = 0;
            if (u.pn == 1) { kind = 1; hb0 = bj * 2; } else if (u.pn == 4 && bj == 1) { kind = 1; hb0 = 4; } else if (u.pn == 8 && bj == 0) { kind = 1; hb0 = 6; } else if (u.pn == 9 && bj == 0) { kind = 1; hb0 = 8; }
            else if (u.pn == 2) { kind = 2; hb0 = bj * 2; } else if (u.pn == 5 && bj == 0) { kind = 2; hb0 = 4; } else if (u.pn == 8 && bj == 1) { kind = 2; hb0 = 6; } else if (u.pn == 9 && bj == 1) { kind = 2; hb0 = 8; }
#pragma unroll
            for (int n = 0; n < 2; ++n) {
                const int c = bj * 128 + wc * 32 + n * 16 + 4 * fq;
                const f32x4 bv = *(const f32x4*)(bias + c);
                const int hh = hb0 + ((c & 127) >> 6), d = c & 63;
#pragma unroll
                for (int ai = 0; ai < 2; ++ai)
#pragma unroll
                    for (int m = 0; m < 4; ++m) {
                        const int row = u.pm * 256 + ai * 128 + wr * 64 + m * 16 + fr;
                        const f32x4 v = acc[ai][bj][m][n] + bv;
                        u32x2 w; w.x = pack2(v[0], v[1]); w.y = pack2(v[2], v[3]);
                        if (kind == 0) *(u32x2*)(p->hb + (size_t)row * NMAIN + u.pn * 256 + c) = w;
                        else {
                            const int b = row >> 11, s = row & 2047, kk = s & 31;
                            bf16_t* blk = (kind == 1 ? p->kF : p->vT) + (((size_t)b * NVH + hh) * 64 + (s >> 5)) * 2048;
                            if (kind == 1) {
                                const int frk = (kk >> 3) * 4 + (kk & 3), t = (kk >> 2) & 1;
                                *(u32x2*)(blk + ((t * 2 + (d >> 5)) * 64 + ((d & 31) >> 3) * 16 + frk) * 8 + (d & 7)) = w;
                            } else {
                                bf16_t* vt = blk + (((d >> 4) * 64) + (kk >> 3) * 16 + (d & 15)) * 8 + (kk & 7);
                                vt[0] = (bf16_t)(w.x & 0xffff); vt[8] = (bf16_t)(w.x >> 16); vt[16] = (bf16_t)(w.y & 0xffff); vt[24] = (bf16_t)(w.y >> 16);
                            }
                        }
                    }
            }
        }
    }
};
struct EpiOutProj {
    const float* xin; float* t;
    __device__ __forceinline__ void operator()(const f32x4 (&acc)[2][2][4][2], const DenseUnit& u, int wr, int wc, int fr, int fq) const {
#pragma unroll
        for (int ai = 0; ai < 2; ++ai)
#pragma unroll
            for (int m = 0; m < 4; ++m) {
                const size_t rowoff = (size_t)(u.pm * 256 + ai * 128 + wr * 64 + m * 16 + fr) * DM + u.pn * 256 + wc * 32 + 4 * fq;
#pragma unroll
                for (int bj = 0; bj < 2; ++bj)
#pragma unroll
                    for (int n = 0; n < 2; ++n) {
                        const size_t off = rowoff + bj * 128 + n * 16;
                        const f32x4 xv = *(const f32x4*)(xin + off);
                        *(f32x4*)(t + off) = xv * ALPHA + acc[ai][bj][m][n];
                    }
            }
    }
};
struct EpiGateUp {
    bf16_t* act; const float* bgup;
    __device__ __forceinline__ void operator()(const f32x4 (&acc)[2][2][4][2], const MoeUnit& u, int wr, int wc, int fr, int fq) const {
        const float* bias = bgup + (size_t)u.e * 2048 + u.pn * 256;
#pragma unroll
        for (int n = 0; n < 2; ++n) {
            const int c = wc * 32 + n * 16 + 4 * fq;
            const f32x4 bg = *(const f32x4*)(bias + c), bu = *(const f32x4*)(bias + 128 + c);
#pragma unroll
            for (int ai = 0; ai < 2; ++ai)
#pragma unroll
                for (int m = 0; m < 4; ++m) {
                    const f32x4 g4 = acc[ai][0][m][n] + bg, u4 = acc[ai][1][m][n] + bu;
                    float o[4];
#pragma unroll
                    for (int j = 0; j < 4; ++j) {
                        const float g = fminf(g4[j], 7.0f), uu = fminf(fmaxf(u4[j], -7.0f), 7.0f);
                        const float glu = g * __builtin_amdgcn_rcpf(1.0f + __builtin_amdgcn_exp2f(-2.455466929f * g));
                        o[j] = (uu + 1.0f) * glu;
                    }
                    *(unsigned*)((char*)act + (size_t)(u.rbt * 256 + ai * 128 + wr * 64 + m * 16 + fr) * DFF + u.pn * 128 + c) = pack4_fp8(o[0], o[1], o[2], o[3]);
                }
        }
    }
};
struct EpiDown {
    bf16_t* ybuf; const float* bdn;
    __device__ __forceinline__ void operator()(const f32x4 (&acc)[2][2][4][2], const MoeUnit& u, int wr, int wc, int fr, int fq) const {
        const float* bias = bdn + (size_t)u.e * 1024 + u.pn * 256;
#pragma unroll
        for (int bj = 0; bj < 2; ++bj)
#pragma unroll
            for (int n = 0; n < 2; ++n) {
                const int c = bj * 128 + wc * 32 + n * 16 + 4 * fq;
                const f32x4 bv = *(const f32x4*)(bias + c);
#pragma unroll
                for (int ai = 0; ai < 2; ++ai)
#pragma unroll
                    for (int m = 0; m < 4; ++m) {
                        const f32x4 v = acc[ai][bj][m][n] + bv;
                        u32x2 w; w.x = pack2(v[0], v[1]); w.y = pack2(v[2], v[3]);
                        *(u32x2*)(ybuf + (size_t)(u.rbt * 256 + ai * 128 + wr * 64 + m * 16 + fr) * DM + u.pn * 256 + c) = w;
                    }
            }
    }
};

__device__ __forceinline__ void phase_inproj(const Params& p, int l, char* lds) {
    DenseSched S{(const char*)(p.WinT + (size_t)l * NPAD * 1024), 1024, NTOK / 256, NMAIN / 256};
    EpiInProj E{&p, l};
    pg8::gemm_phase<false, 0>((LAS unsigned char*)lds, (const char*)p.xb, 1024, S, E);
    int tid = threadIdx.x; asm volatile("" : "+v"(tid));
    const int wid = tid >> 6, lane = tid & 63, fr = lane & 15, fq = lane >> 4;
    const bf16_t* W = p.WinT + ((size_t)l * NPAD + NMAIN) * 1024;
    const float* bias = p.binp + l * NPAD + NMAIN;
    for (int u = blockIdx.x * NWV + wid; u < NTOK / 16; u += gridDim.x * NWV) {
        const bf16_t* ar = p.xb + (size_t)(u * 16 + fr) * DM + fq * 8;
        const bf16_t* w0 = W + (size_t)fr * 1024 + fq * 8; const bf16_t* w1 = W + (size_t)(16 + fr) * 1024 + fq * 8;
        f32x4 a0 = (f32x4){0.f, 0.f, 0.f, 0.f}, a1 = a0;
#pragma unroll 4
        for (int ks = 0; ks < 32; ++ks) {
            const bf16x8 a = *(const bf16x8*)(ar + ks * 32);
            a0 = __builtin_amdgcn_mfma_f32_16x16x32_bf16(a, *(const bf16x8*)(w0 + ks * 32), a0, 0, 0, 0);
            a1 = __builtin_amdgcn_mfma_f32_16x16x32_bf16(a, *(const bf16x8*)(w1 + ks * 32), a1, 0, 0, 0);
        }
#pragma unroll
        for (int r = 0; r < 4; ++r) {
            float* dst = p.hs + (size_t)(u * 16 + fq * 4 + r) * HS_W;
            dst[fr] = a0[r] + bias[fr];
            if (fr < 6) dst[16 + fr] = a1[r] + bias[16 + fr];
        }
    }
}
__device__ __forceinline__ void phase_outproj(const Params& p, int l, const float* xin, char* lds) {
    DenseSched S{(const char*)p.WoT + (size_t)l * 1024 * 1024, 512, NTOK / 256, 4};
    EpiOutProj E{xin, p.tbuf};
    pg8::gemm_phase<true, 0x7c7c7c7c>((LAS unsigned char*)lds, (const char*)p.ob, 512, S, E);
}
__device__ __forceinline__ void build_tiles(const Params& p, int l, int* ptile, int* ecnt) {
    int tid = threadIdx.x; asm volatile("" : "+v"(tid));
    if (tid < NE) ecnt[tid] = (int)__hip_atomic_load(p.ctrl + 64 + l * NE + tid, __ATOMIC_RELAXED, __HIP_MEMORY_SCOPE_AGENT);
    __syncthreads();
    if (tid == 0) { int s = 0; for (int e = 0; e < NE; ++e) { ptile[e] = s; s += (ecnt[e] + 255) >> 8; } ptile[NE] = s; }
    __syncthreads();
}
__device__ __forceinline__ void phase_gateup(const Params& p, int l, char* lds) {
    int* ptile = (int*)(lds + LDS_TAB); int* ecnt = ptile + 40;
    build_tiles(p, l, ptile, ecnt);
    MoeSched<true> S{(const char*)p.WguT + (size_t)l * NE * 2048 * 1024, p.lists, ptile, ecnt, 8, 2048};
    EpiGateUp E{p.act, p.bgup + (size_t)l * NE * 2048};
    pg8::gemm_phase<true, 0x7c7c7c7c>((LAS unsigned char*)lds, (const char*)p.x1b, 512, S, E);
}
__device__ __forceinline__ void phase_down(const Params& p, int l, char* lds) {
    int* ptile = (int*)(lds + LDS_TAB); int* ecnt = ptile + 40;
    build_tiles(p, l, ptile, ecnt);
    MoeSched<false> S{(const char*)p.WdnT + (size_t)l * NE * 1024 * 1024, p.lists, ptile, ecnt, 4, 1024};
    EpiDown E{p.ybuf, p.b_dn + (size_t)l * NE * 1024};
    pg8::gemm_phase<true, 0x7c7c7c7c>((LAS unsigned char*)lds, (const char*)p.act, 512, S, E);
}

__device__ __forceinline__ float gelu_tanh(float x) {
    const float u = 0.7978845608028654f * (x + 0.044715f * x * x * x);
    const float e = __expf(-2.0f * fabsf(u)); const float th = (1.0f - e) / (1.0f + e);
    return 0.5f * x * (1.0f + (u < 0.f ? -th : th));
}
__device__ __forceinline__ void phase_prep(const Params& p, int l, char* lds) {
    int tid = threadIdx.x; asm volatile("" : "+v"(tid));
    const int wid = tid >> 6, lane = tid & 63, fr = lane & 15, fq = lane >> 4;
    const int gw = blockIdx.x * NWV + wid, nw = gridDim.x * NWV;
    for (int u = (int)gridDim.x - 1 - (int)blockIdx.x; u < NB * 4; u += gridDim.x) {
        const int b = u >> 2, h = u & 3;
        const float* srcp = p.hs + ((size_t)b * SEQ + tid * 4) * HS_W + h;
        float ls[4]; float tot = 0.f;
#pragma unroll
        for (int i = 0; i < 4; ++i) { const float f = srcp[(size_t)i * HS_W]; ls[i] = fminf(f, 0.f) - log1pf(__expf(-fabsf(f))); tot += ls[i]; }
        float inc = tot;
#pragma unroll
        for (int o = 1; o < 64; o <<= 1) { const float v = shfl_f(inc, lane - o); if (lane >= o) inc += v; }
        float* wtot = (float*)(lds + 65536);
        if (lane == 63) wtot[wid] = inc;
        __syncthreads();
        float base = inc - tot;
        for (int w = 0; w < wid; ++w) base += wtot[w];
        float4 o4; o4.x = base + ls[0]; o4.y = o4.x + ls[1]; o4.z = o4.y + ls[2]; o4.w = o4.z + ls[3];
        *(float4*)(p.cF + (size_t)u * SEQ + tid * 4) = o4;
        __syncthreads();
    }
    float* part = (float*)lds;
    bf16_t* h1 = (bf16_t*)(lds + 32768);
    for (int u = blockIdx.x; u < NB * 2 * 2 * 8; u += gridDim.x) {
        const int ct = u & 7, which = (u >> 3) & 1, kvh = (u >> 4) & 1, b = u >> 5;
        const int colo = (which ? C_NVC : C_NKC) + kvh * 64;
        const int c_lane = ct * 16 + fr;
        const int tokbase = min(c_lane, 126) * 16;
        const bf16_t* arow = p.hb + ((size_t)b * SEQ + tokbase) * NMAIN + colo + fq * 8;
        const bf16_t* w1 = p.W1T + ((size_t)(l * 2 + which) * 64 + fr) * 2048 + fq * 8;
        f32x4 acc[4];
#pragma unroll
        for (int n = 0; n < 4; ++n) acc[n] = (f32x4){0.f, 0.f, 0.f, 0.f};
#pragma unroll
        for (int kk = 0; kk < 8; ++kk) {
            const int ks = wid * 8 + kk;
            const bf16x8 a = *(const bf16x8*)(arow + (size_t)(ks >> 1) * NMAIN + (ks & 1) * 32);
#pragma unroll
            for (int n = 0; n < 4; ++n) {
                const bf16x8 bb = *(const bf16x8*)(w1 + (size_t)n * 16 * 2048 + ks * 32);
                acc[n] = __builtin_amdgcn_mfma_f32_16x16x32_bf16(a, bb, acc[n], 0, 0, 0);
            }
        }
#pragma unroll
        for (int n = 0; n < 4; ++n)
#pragma unroll
            for (int r = 0; r < 4; ++r) part[wid * 1024 + (fq * 4 + r) * 64 + n * 16 + fr] = acc[n][r];
        __syncthreads();
        const float* b1 = p.b1c + (l * 2 + which) * 64;
#pragma unroll
        for (int i = 0; i < 2; ++i) {
            const int e = tid + NTHR * i; float sum = 0.f;
#pragma unroll
            for (int w = 0; w < 8; ++w) sum += part[w * 1024 + e];
            h1[e] = f2bf(gelu_tanh(sum + b1[e & 63]));
        }
        __syncthreads();
        if (wid == 0) {
            const bf16_t* w2 = p.W2T + ((size_t)(l * 2 + which) * 64 + fr) * 64 + fq * 8;
            f32x4 o2[4];
#pragma unroll
            for (int n = 0; n < 4; ++n) o2[n] = (f32x4){0.f, 0.f, 0.f, 0.f};
#pragma unroll
            for (int ks = 0; ks < 2; ++ks) {
                const bf16x8 a = *(const bf16x8*)(h1 + fr * 64 + ks * 32 + fq * 8);
#pragma unroll
                for (int n = 0; n < 4; ++n) {
                    const bf16x8 bb = *(const bf16x8*)(w2 + (size_t)n * 16 * 64 + ks * 32);
                    o2[n] = __builtin_amdgcn_mfma_f32_16x16x32_bf16(a, bb, o2[n], 0, 0, 0);
                }
            }
            const size_t base = ((size_t)b * 2 + kvh) * 128 * 64;
#pragma unroll
            for (int n = 0; n < 4; ++n)
#pragma unroll
                for (int r = 0; r < 4; ++r) {
                    const int c = ct * 16 + fq * 4 + r, j2 = n * 16 + fr;
                    const bf16_t v = c < 127 ? f2bf(o2[n][r]) : (bf16_t)0;
                    if (which == 0) p.kc[base + (size_t)c * 64 + j2] = v;
                    else { p.vc[base + (size_t)c * 64 + j2] = v; p.vcT[base + (size_t)j2 * 128 + c] = v; }
                }
        }
        __syncthreads();
    }
}

constexpr float L2E = 1.4426950408889634f, MASKV = -1e30f, SCL2 = QSCALE * L2E;
struct KVFrag { bf16x8 k[2][2]; bf16x8 v[4]; };
template <bool FM>
__device__ __forceinline__ void k_load(KVFrag& f, const bf16_t* __restrict__ Kb, size_t ldk, int kc0, int fr, int fq) {
    if (FM) {
        const bf16_t* kp = Kb + (size_t)(kc0 >> 5) * 2048 + (fq * 16 + fr) * 8;
        f.k[0][0] = *(const bf16x8*)(kp); f.k[0][1] = *(const bf16x8*)(kp + 512); f.k[1][0] = *(const bf16x8*)(kp + 1024); f.k[1][1] = *(const bf16x8*)(kp + 1536);
    } else {
        const bf16_t* kp = Kb + (size_t)(kc0 + (fr >> 2) * 8 + (fr & 3)) * ldk + fq * 8;
        f.k[0][0] = *(const bf16x8*)(kp); f.k[0][1] = *(const bf16x8*)(kp + 32);
        f.k[1][0] = *(const bf16x8*)(kp + 4 * ldk); f.k[1][1] = *(const bf16x8*)(kp + 4 * ldk + 32);
    }
}
template <bool FM>
__device__ __forceinline__ void v_load(bf16x8 (&v)[4], const bf16_t* __restrict__ VTb, size_t ldv, int kc0, int fr, int fq) {
    if (FM) {
        const bf16_t* vp = VTb + (size_t)(kc0 >> 5) * 2048 + (fq * 16 + fr) * 8;
#pragma unroll
        for (int dt = 0; dt < 4; ++dt) v[dt] = *(const bf16x8*)(vp + dt * 512);
    } else {
        const bf16_t* vp = VTb + (size_t)fr * ldv + kc0 + fq * 8;
#pragma unroll
        for (int dt = 0; dt < 4; ++dt) v[dt] = *(const bf16x8*)(vp + (size_t)dt * 16 * ldv);
    }
}
__device__ __forceinline__ float rowmax4(float x) {
    auto r = __builtin_amdgcn_permlane32_swap(__float_as_uint(x), __float_as_uint(x), false, false);
    x = fmaxf(__uint_as_float(r[0]), __uint_as_float(r[1]));
    auto q = __builtin_amdgcn_permlane16_swap(__float_as_uint(x), __float_as_uint(x), false, false);
    return fmaxf(__uint_as_float(q[0]), __uint_as_float(q[1]));
}
__device__ __forceinline__ float rowsum4(float x) {
    auto r = __builtin_amdgcn_permlane32_swap(__float_as_uint(x), __float_as_uint(x), false, false);
    x = __uint_as_float(r[0]) + __uint_as_float(r[1]);
    auto q = __builtin_amdgcn_permlane16_swap(__float_as_uint(x), __float_as_uint(x), false, false);
    return __uint_as_float(q[0]) + __uint_as_float(q[1]);
}
template <int NQT, bool MASK, class MB>
__device__ __forceinline__ void attn_compute(const KVFrag& f, const bf16x8 (&qf)[NQT][2], f32x4 (&o)[NQT][4], float (&m)[NQT], float (&l)[NQT], const MB& mb) {
    f32x4 s0[NQT], s1[NQT];
#pragma unroll
    for (int qt = 0; qt < NQT; ++qt) {
        s0[qt] = __builtin_amdgcn_mfma_f32_16x16x32_bf16(f.k[0][0], qf[qt][0], (f32x4){0.f, 0.f, 0.f, 0.f}, 0, 0, 0);
        s1[qt] = __builtin_amdgcn_mfma_f32_16x16x32_bf16(f.k[1][0], qf[qt][0], (f32x4){0.f, 0.f, 0.f, 0.f}, 0, 0, 0);
    }
#pragma unroll
    for (int qt = 0; qt < NQT; ++qt) {
        s0[qt] = __builtin_amdgcn_mfma_f32_16x16x32_bf16(f.k[0][1], qf[qt][1], s0[qt], 0, 0, 0);
        s1[qt] = __builtin_amdgcn_mfma_f32_16x16x32_bf16(f.k[1][1], qf[qt][1], s1[qt], 0, 0, 0);
    }
    float mx[NQT];
#pragma unroll
    for (int qt = 0; qt < NQT; ++qt) {
#pragma unroll
        for (int j = 0; j < 4; ++j) { s0[qt][j] = mb(qt, j, s0[qt][j]); s1[qt][j] = mb(qt, j + 4, s1[qt][j]); }
        mx[qt] = fmaxf(fmaxf(fmaxf(s0[qt][0], s0[qt][1]), fmaxf(s0[qt][2], s0[qt][3])), fmaxf(fmaxf(s1[qt][0], s1[qt][1]), fmaxf(s1[qt][2], s1[qt][3])));
    }
#pragma unroll
    for (int qt = 0; qt < NQT; ++qt) mx[qt] = rowmax4(mx[qt]);
    bool moved = false;
#pragma unroll
    for (int qt = 0; qt < NQT; ++qt) { mx[qt] = fmaxf(m[qt], mx[qt]); moved |= (mx[qt] != m[qt]); }
    if (__ballot(moved) != 0ull) {
#pragma unroll
        for (int qt = 0; qt < NQT; ++qt) {
            const float alpha = __builtin_amdgcn_exp2f(m[qt] - mx[qt]);
            l[qt] *= alpha;
#pragma unroll
            for (int dt = 0; dt < 4; ++dt) o[qt][dt] *= alpha;
        }
    }
    bf16x8 pf[NQT];
#pragma unroll
    for (int qt = 0; qt < NQT; ++qt) {
        m[qt] = mx[qt];
        float pr[8]; float ps = 0.f;
#pragma unroll
        for (int j = 0; j < 4; ++j) {
            pr[j] = (!MASK || s0[qt][j] > -1e29f) ? __builtin_amdgcn_exp2f(s0[qt][j] - mx[qt]) : 0.f;
            pr[j + 4] = (!MASK || s1[qt][j] > -1e29f) ? __builtin_amdgcn_exp2f(s1[qt][j] - mx[qt]) : 0.f;
        }
#pragma unroll
        for (int j = 0; j < 8; ++j) ps += pr[j];
        l[qt] += ps;
        const u32x4 pk = {pack2(pr[0], pr[1]), pack2(pr[2], pr[3]), pack2(pr[4], pr[5]), pack2(pr[6], pr[7])};
        pf[qt] = __builtin_bit_cast(bf16x8, pk);
    }
#pragma unroll
    for (int dt = 0; dt < 4; ++dt)
#pragma unroll
        for (int qt = 0; qt < NQT; ++qt) o[qt][dt] = __builtin_amdgcn_mfma_f32_16x16x32_bf16(f.v[dt], pf[qt], o[qt][dt], 0, 0, 0);
    __builtin_amdgcn_sched_barrier(0);
}
struct RangeIt { int c, c_hi; __device__ __forceinline__ int nxt() { if (c > c_hi) return -1; return (c++) * 32; } };
struct MaskIt { unsigned long long cm; __device__ __forceinline__ int nxt() { if (!cm) return -1; const int i = __builtin_ctzll(cm); cm &= cm - 1; return i * 32; } };
template <bool PFV, bool FM, class It, class Gen>
__device__ __forceinline__ void attn_run(It& it, const bf16_t* Kb, size_t ldk, const bf16_t* VTb, size_t ldv, int fr, int fq, const Gen& gen) {
    KVFrag fa, fb;
    int ka = it.nxt(); if (ka < 0) return;
    k_load<FM>(fa, Kb, ldk, ka, fr, fq); if (PFV) v_load<FM>(fa.v, VTb, ldv, ka, fr, fq);
    for (;;) {
        const int kb = it.nxt(); if (kb >= 0) { k_load<FM>(fb, Kb, ldk, kb, fr, fq); if (PFV) v_load<FM>(fb.v, VTb, ldv, kb, fr, fq); }
        if (!PFV) v_load<FM>(fa.v, VTb, ldv, ka, fr, fq);
        gen(ka, fa);
        if (kb < 0) break;
        ka = it.nxt(); if (ka >= 0) { k_load<FM>(fa, Kb, ldk, ka, fr, fq); if (PFV) v_load<FM>(fa.v, VTb, ldv, ka, fr, fq); }
        if (!PFV) v_load<FM>(fb.v, VTb, ldv, kb, fr, fq);
        gen(kb, fb);
        if (ka < 0) break;
    }
}
template <int NQT>
__device__ __forceinline__ void attn_init(f32x4 (&o)[NQT][4], float (&m)[NQT], float (&l)[NQT]) {
#pragma unroll
    for (int qt = 0; qt < NQT; ++qt) { m[qt] = MASKV; l[qt] = 0.f;
#pragma unroll
        for (int dt = 0; dt < 4; ++dt) o[qt][dt] = (f32x4){0.f, 0.f, 0.f, 0.f}; }
}
__device__ __forceinline__ float lsum4(float l) { return rowsum4(l); }
__device__ __forceinline__ void store_o4(unsigned char* dst, const f32x4 v) { *(unsigned*)dst = pack4_fp8(v[0], v[1], v[2], v[3]); }
__device__ __forceinline__ float sigmoidf_fast(float x) { return __builtin_amdgcn_rcpf(1.0f + __builtin_amdgcn_exp2f(-L2E * x)); }

__device__ __forceinline__ void fox_unit(const Params& p, int b, int h, int qb, int fr, int fq) {
    asm volatile("" : "+v"(fr), "+v"(fq));
    const int t0 = qb * 64;
    const bf16_t* Qb = p.hb + ((size_t)b * SEQ + t0) * NMAIN + C_FQ + h * 64 + fq * 8;
    bf16x8 qf[4][2];
#pragma unroll
    for (int qt = 0; qt < 4; ++qt) { qf[qt][0] = *(const bf16x8*)(Qb + (size_t)(qt * 16 + fr) * NMAIN); qf[qt][1] = *(const bf16x8*)(Qb + (size_t)(qt * 16 + fr) * NMAIN + 32); }
    const float* cf = p.cF + ((size_t)b * 4 + h) * SEQ;
    float cq[4];
#pragma unroll
    for (int qt = 0; qt < 4; ++qt) cq[qt] = cf[t0 + qt * 16 + fr] * L2E;
    f32x4 o[4][4]; float m[4], l[4];
    attn_init<4>(o, m, l);
    const bf16_t* Kb = p.kF + ((size_t)b * NVH + h) * 64 * SEQ;
    const bf16_t* VTb = p.vT + ((size_t)b * NVH + h) * 64 * SEQ;
    RangeIt it{0, (t0 >> 5) + 1};
    attn_run<false, true>(it, Kb, NMAIN, VTb, SEQ, fr, fq, [&](int kc0, const KVFrag& f) {
        const float4 ca = *(const float4*)(cf + kc0 + 8 * fq), cb = *(const float4*)(cf + kc0 + 8 * fq + 4);
        const float ck[8] = {ca.x * L2E, ca.y * L2E, ca.z * L2E, ca.w * L2E, cb.x * L2E, cb.y * L2E, cb.z * L2E, cb.w * L2E};
        const int kq = kc0 + 8 * fq - t0 - fr;
        attn_compute<4, true>(f, qf, o, m, l, [&](int qt, int j, float raw) { return (kq + j - 16 * qt) > 0 ? MASKV : raw * SCL2 + cq[qt] - ck[j]; });
    });
#pragma unroll
    for (int qt = 0; qt < 4; ++qt) {
        const float inv = __builtin_amdgcn_rcpf(lsum4(l[qt]));
        unsigned char* dst = (unsigned char*)p.ob + ((size_t)b * SEQ + t0 + qt * 16 + fr) * DM + h * 64 + 4 * fq;
#pragma unroll
        for (int dt = 0; dt < 4; ++dt) store_o4(dst + dt * 16, o[qt][dt] * inv);
    }
}
__device__ __forceinline__ void swa_unit(const Params& p, int l_, int b, int kv, int pos, int fr, int fq) {
    asm volatile("" : "+v"(fr), "+v"(fq));
    const int t0 = pos * 16, t = t0 + fr;
    const bf16_t* Qb = p.hb + ((size_t)b * SEQ + t) * NMAIN + C_SQ + kv * 192 + fq * 8;
    bf16x8 qf[3][2];
#pragma unroll
    for (int g = 0; g < 3; ++g) { qf[g][0] = *(const bf16x8*)(Qb + g * 64); qf[g][1] = *(const bf16x8*)(Qb + g * 64 + 32); }
    float sl[3];
#pragma unroll
    for (int g = 0; g < 3; ++g) sl[g] = slope_swa(kv * 3 + g) * L2E;
    f32x4 o[3][4]; float m[3], l[3];
    attn_init<3>(o, m, l);
    const bf16_t* Kb = p.kF + ((size_t)b * NVH + 4 + kv) * 64 * SEQ;
    const bf16_t* VTb = p.vT + ((size_t)b * NVH + 4 + kv) * 64 * SEQ;
    RangeIt it{max(0, t0 - 127) >> 5, (t0 + 15) >> 5};
    attn_run<true, true>(it, Kb, NMAIN, VTb, SEQ, fr, fq, [&](int kc0, const KVFrag& f) {
        const int dq = t - kc0 - 8 * fq;
        attn_compute<3, true>(f, qf, o, m, l, [&](int g, int j, float raw) { const int dist = dq - j; return (dist >= 0 && dist < 128) ? raw * SCL2 - sl[g] * (float)dist : MASKV; });
    });
#pragma unroll
    for (int g = 0; g < 3; ++g) {
        const float sink = p.sinks[l_ * 6 + kv * 3 + g] * L2E;
        const float inv = __builtin_amdgcn_rcpf(lsum4(l[g]) + __builtin_amdgcn_exp2f(sink - m[g]));
        unsigned char* dst = (unsigned char*)p.ob + ((size_t)b * SEQ + t) * DM + 256 + (kv * 3 + g) * 64 + 4 * fq;
#pragma unroll
        for (int dt = 0; dt < 4; ++dt) store_o4(dst + dt * 16, o[g][dt] * inv);
    }
}
__device__ __forceinline__ void nsa_unit(const Params& p, int b, int kv, int pos, int fr, int fq, int lane, float* ps, unsigned* msk, float* otl) {
    asm volatile("" : "+v"(fr), "+v"(fq), "+v"(lane));
    const int t0 = pos * 16, t = t0 + fr, cur = t0 >> 6;
    const bf16_t* Qb = p.hb + ((size_t)b * SEQ + t) * NMAIN + C_NQ + kv * 192 + fq * 8;
    bf16x8 qf[3][2];
#pragma unroll
    for (int g = 0; g < 3; ++g) { qf[g][0] = *(const bf16x8*)(Qb + g * 64); qf[g][1] = *(const bf16x8*)(Qb + g * 64 + 32); }
    float sl[3];
#pragma unroll
    for (int g = 0; g < 3; ++g) sl[g] = slope_nsa(kv * 3 + g) * L2E;
    const float* gl = p.hs + ((size_t)b * SEQ + t) * HS_W + 4 + kv * 9;
    f32x4 o[3][4]; float m[3], l[3];
    f32x4* otv = (f32x4*)otl + lane;
#pragma unroll
    for (int i = 0; i < 8; ++i) ps[lane + 64 * i] = 0.f;
    {
        const bf16_t* Kb = p.kc + ((size_t)b * 2 + kv) * 128 * 64;
        const bf16_t* VTb = p.vcT + ((size_t)b * 2 + kv) * 64 * 128;
        const int ncv = (t0 + 15 >= 31) ? ((t0 + 15 - 31) >> 4) + 1 : 0;
        const int nch = (ncv + 31) >> 5;
        attn_init<3>(o, m, l);
        const int dq0 = t - 31 - 16 * 8 * fq;
        RangeIt it{0, nch - 1};
        attn_run<false, false>(it, Kb, 64, VTb, 128, fr, fq, [&](int kc0, const KVFrag& f) {
            const int dq = dq0 - 16 * kc0;
            attn_compute<3, true>(f, qf, o, m, l, [&](int g, int j, float raw) { const int dist = dq - 16 * j; return dist >= 0 ? raw * SCL2 - sl[g] * (float)dist : MASKV; });
        });
        float il[3];
#pragma unroll
        for (int g = 0; g < 3; ++g) {
            const float lt = lsum4(l[g]); il[g] = lt > 0.f ? __builtin_amdgcn_rcpf(lt) : 0.f;
            const float gate = sigmoidf_fast(gl[g * 3 + 0]);
#pragma unroll
            for (int dt = 0; dt < 4; ++dt) otv[(g * 4 + dt) * 64] = o[g][dt] * (il[g] * gate);
        }
        float carry_prev = 0.f;
        for (int c = 0; c < nch; ++c) {
            const int kc0 = c * 32, dq = dq0 - 16 * kc0;
            const bf16_t* kp = Kb + (size_t)(kc0 + (fr >> 2) * 8 + (fr & 3)) * 64 + fq * 8;
            const bf16x8 k00 = *(const bf16x8*)(kp), k01 = *(const bf16x8*)(kp + 32), k10 = *(const bf16x8*)(kp + 256), k11 = *(const bf16x8*)(kp + 256 + 32);
            float pc[8];
#pragma unroll
            for (int j = 0; j < 8; ++j) pc[j] = 0.f;
#pragma unroll
            for (int g = 0; g < 3; ++g) {
                f32x4 s0 = (f32x4){0.f, 0.f, 0.f, 0.f}, s1 = s0;
                s0 = __builtin_amdgcn_mfma_f32_16x16x32_bf16(k00, qf[g][0], s0, 0, 0, 0); s0 = __builtin_amdgcn_mfma_f32_16x16x32_bf16(k01, qf[g][1], s0, 0, 0, 0);
                s1 = __builtin_amdgcn_mfma_f32_16x16x32_bf16(k10, qf[g][0], s1, 0, 0, 0); s1 = __builtin_amdgcn_mfma_f32_16x16x32_bf16(k11, qf[g][1], s1, 0, 0, 0);
#pragma unroll
                for (int j = 0; j < 8; ++j) {
                    const int dist = dq - 16 * j; const float raw = j < 4 ? s0[j] : s1[j - 4];
                    if (dist >= 0) pc[j] += __builtin_amdgcn_exp2f(raw * SCL2 - sl[g] * (float)dist - m[g]) * il[g];
                }
            }
            const float cout = 0.5f * pc[7];
            float cin = shfl_f(cout, lane - 16);
            const float cwrap = shfl_f(cout, fr + 48);
            if (fq == 0) cin = carry_prev;
            carry_prev = cwrap;
            const int n0 = (kc0 >> 2) + 2 * fq;
            ps[fr * 32 + n0] = cin + pc[0] + pc[1] + pc[2] + 0.5f * pc[3];
            ps[fr * 32 + n0 + 1] = 0.5f * pc[3] + pc[4] + pc[5] + pc[6] + 0.5f * pc[7];
        }
    }
    lds_wave_sync();
    if (lane < 16) {
        unsigned mask = 1u | (1u << cur); if (cur >= 1) mask |= 1u << (cur - 1);
        if (cur >= 3) {
            if (cur - 2 <= 5) mask |= (1u << (cur - 1)) - 2u;
            else {
                const float* my = ps + lane * 32;
                for (int r = 0; r < 5; ++r) {
                    float best = -1.0f; int bi = 1;
                    for (int j = 1; j <= cur - 2; ++j) { const float v = my[j]; if (!((mask >> j) & 1u) && v > best) { best = v; bi = j; } }
                    mask |= 1u << bi;
                }
            }
        }
        msk[lane] = mask;
    }
    lds_wave_sync();
    const unsigned qmask = msk[fr];
    lds_wave_sync();
    {
        const bf16_t* Kb = p.kF + ((size_t)b * NVH + 6 + kv) * 64 * SEQ;
        const bf16_t* VTb = p.vT + ((size_t)b * NVH + 6 + kv) * 64 * SEQ;
        attn_init<3>(o, m, l);
        unsigned um = qmask;
        um |= shfl_u(um, lane ^ 1); um |= shfl_u(um, lane ^ 2); um |= shfl_u(um, lane ^ 4); um |= shfl_u(um, lane ^ 8);
        um = (unsigned)__builtin_amdgcn_readfirstlane((int)um) & (cur >= 31 ? 0xffffffffu : ((2u << cur) - 1u));
        unsigned long long cm = 0ull;
        for (unsigned r = um; r; r &= r - 1) { const int kb = __builtin_ctz(r); cm |= 3ull << (2 * kb); }
        MaskIt it{cm};
        attn_run<false, true>(it, Kb, NMAIN, VTb, SEQ, fr, fq, [&](int kc0, const KVFrag& f) {
            const bool mine = (qmask >> (kc0 >> 6)) & 1u;
            const int dq = t - kc0 - 8 * fq;
            attn_compute<3, true>(f, qf, o, m, l, [&](int g, int j, float raw) { const int dist = dq - j; return (mine && dist >= 0) ? raw * SCL2 - sl[g] * (float)dist : MASKV; });
        });
#pragma unroll
        for (int g = 0; g < 3; ++g) {
            const float lt = lsum4(l[g]); const float sc = (lt > 0.f ? __builtin_amdgcn_rcpf(lt) : 0.f) * sigmoidf_fast(gl[g * 3 + 1]);
#pragma unroll
            for (int dt = 0; dt < 4; ++dt) otv[(g * 4 + dt) * 64] += o[g][dt] * sc;
        }
    }
    {
        const bf16_t* Kb = p.kF + ((size_t)b * NVH + 8 + kv) * 64 * SEQ;
        const bf16_t* VTb = p.vT + ((size_t)b * NVH + 8 + kv) * 64 * SEQ;
        attn_init<3>(o, m, l);
        RangeIt it{max(0, t0 - 511) >> 5, (t0 + 15) >> 5};
        attn_run<false, true>(it, Kb, NMAIN, VTb, SEQ, fr, fq, [&](int kc0, const KVFrag& f) {
            const int dq = t - kc0 - 8 * fq;
            attn_compute<3, true>(f, qf, o, m, l, [&](int g, int j, float raw) { const int dist = dq - j; return (dist >= 0 && dist < 512) ? raw * SCL2 - sl[g] * (float)dist : MASKV; });
        });
#pragma unroll
        for (int g = 0; g < 3; ++g) {
            const float lt = lsum4(l[g]); const float sc = (lt > 0.f ? __builtin_amdgcn_rcpf(lt) : 0.f) * sigmoidf_fast(gl[g * 3 + 2]);
            unsigned char* dst = (unsigned char*)p.ob + ((size_t)b * SEQ + t) * DM + 640 + (kv * 3 + g) * 64 + 4 * fq;
#pragma unroll
            for (int dt = 0; dt < 4; ++dt) store_o4(dst + dt * 16, otv[(g * 4 + dt) * 64] + o[g][dt] * sc);
        }
    }
}

template <bool WITH_CONV>
__device__ __forceinline__ void phase_attn(const Params& p, int l, char* lds, int cslot = 16) {
    int tid = threadIdx.x; asm volatile("" : "+v"(tid));
    const int wid = tid >> 6, lane = tid & 63, fr = lane & 15, fq = lane >> 4;
    float* ps = (float*)(lds + wid * 16896); unsigned* msk = (unsigned*)(ps + 512); float* otl = ps + 576;
    unsigned* ctr = p.ctrl + cslot + l;
    constexpr unsigned NU_NSA = NB * 2 * 128, NU_FOX = NB * 4 * 32, NU_SWA = NB * 2 * 128, NU_ATT = NU_NSA + NU_FOX + NU_SWA;
    for (;;) {
        unsigned u = 0;
        if (lane == 0) u = __hip_atomic_fetch_add(ctr, 1u, __ATOMIC_RELAXED, __HIP_MEMORY_SCOPE_AGENT);
        u = (unsigned)__builtin_amdgcn_readfirstlane((int)u);
        if (WITH_CONV) {
            constexpr unsigned TOTQ = NU_ATT + (unsigned)CONV_TILES;
            if (u >= TOTQ) break;
            const unsigned a0 = (unsigned)(((unsigned long long)u * NU_ATT) / TOTQ), a1 = (unsigned)(((unsigned long long)(u + 1) * NU_ATT) / TOTQ);
            if (a1 == a0) { conv_tile_wave(p, (int)(u - a0), lane, (unsigned char*)ps); continue; }
            u = a0;
        } else {
#ifndef ATT_REP
#define ATT_REP 1
#endif
            if (u >= ATT_REP * NU_ATT) break;
            if (ATT_REP > 1) u %= NU_ATT;
        }
        if (u < NU_NSA) { const int pos = 127 - (int)(u & 127), r = u >> 7; nsa_unit(p, r >> 1, r & 1, pos, fr, fq, lane, ps, msk, otl); }
        else if (u < NU_NSA + NU_FOX) { const unsigned v = u - NU_NSA; const int qb = 31 - (int)(v & 31), r = v >> 5; fox_unit(p, r >> 2, r & 3, qb, fr, fq); }
        else { const unsigned v = u - NU_NSA - NU_FOX; const int pos = 127 - (int)(v & 127), r = v >> 7; swa_unit(p, l, r >> 1, r & 1, pos, fr, fq); }
    }
}

__device__ __forceinline__ void phase_ln1_router(const Params& p, int l, char* lds) {
    int tid = threadIdx.x; asm volatile("" : "+v"(tid));
    const int wid = tid >> 6, lane = tid & 63, fr = lane & 15, fq = lane >> 4;
    float* lg = (float*)lds + wid * 512;
    int* lcnt = (int*)(lds + 16384); int* lbase = lcnt + 32;
    const float* g1 = p.ln1_g + l * DM; const float* b1 = p.ln1_b + l * DM;
    const float* rw = p.rwT + (size_t)l * NE * 1024; const float* rb = p.router_b + l * NE;
    unsigned* gcount = p.ctrl + 64 + l * NE;
    for (int grp = blockIdx.x; grp < NTOK / 128; grp += gridDim.x) {
        const int tok0 = grp * 128 + wid * 16;
        if (tid < 32) lcnt[tid] = 0;
        float4 gg[4], bb[4];
#pragma unroll
        for (int j = 0; j < 4; ++j) { gg[j] = *(const float4*)(g1 + j * 256 + lane * 4); bb[j] = *(const float4*)(b1 + j * 256 + lane * 4); }
        for (int r0 = 0; r0 < 16; r0 += 4) {
            float4 v[4][4]; float s[4], qv[4];
#pragma unroll
            for (int i = 0; i < 4; ++i)
#pragma unroll
                for (int j = 0; j < 4; ++j) v[i][j] = *(const float4*)(p.tbuf + (size_t)(tok0 + r0 + i) * DM + j * 256 + lane * 4);
#pragma unroll
            for (int i = 0; i < 4; ++i) { s[i] = 0.f;
#pragma unroll
                for (int j = 0; j < 4; ++j) s[i] += (v[i][j].x + v[i][j].y) + (v[i][j].z + v[i][j].w); }
#pragma unroll
            for (int o = 32; o > 0; o >>= 1) {
#pragma unroll
                for (int i = 0; i < 4; ++i) s[i] += shfl_f(s[i], lane ^ o); }
#pragma unroll
            for (int i = 0; i < 4; ++i) { const float mean = s[i] * (1.0f / 1024.0f); qv[i] = 0.f;
#pragma unroll
                for (int j = 0; j < 4; ++j) { v[i][j].x -= mean; v[i][j].y -= mean; v[i][j].z -= mean; v[i][j].w -= mean; qv[i] += (v[i][j].x * v[i][j].x + v[i][j].y * v[i][j].y) + (v[i][j].z * v[i][j].z + v[i][j].w * v[i][j].w); } }
#pragma unroll
            for (int o = 32; o > 0; o >>= 1) {
#pragma unroll
                for (int i = 0; i < 4; ++i) qv[i] += shfl_f(qv[i], lane ^ o); }
#pragma unroll
            for (int i = 0; i < 4; ++i) {
                const float rstd = rsqrtf(qv[i] * (1.0f / 1024.0f) + LN_EPS);
                const size_t row = (size_t)(tok0 + r0 + i);
#pragma unroll
                for (int j = 0; j < 4; ++j) {
                    const int c = j * 256 + lane * 4;
                    float4 y; y.x = v[i][j].x * rstd * gg[j].x + bb[j].x; y.y = v[i][j].y * rstd * gg[j].y + bb[j].y; y.z = v[i][j].z * rstd * gg[j].z + bb[j].z; y.w = v[i][j].w * rstd * gg[j].w + bb[j].w;
                    *(float4*)(p.x1f + row * DM + c) = y;
                    *(unsigned*)((char*)p.x1b + row * DM + c) = pack4_fp8(y.x, y.y, y.z, y.w);
                }
            }
        }
        __syncthreads();
        f32x4 a0 = (f32x4){0.f, 0.f, 0.f, 0.f}, a1 = a0;
        const float* xr = p.x1f + (size_t)(tok0 + fr) * DM + 4 * fq;
        const float* w0 = rw + (size_t)fr * 1024 + 4 * fq; const float* w1 = rw + (size_t)(16 + fr) * 1024 + 4 * fq;
#pragma unroll 4
        for (int k0 = 0; k0 < 1024; k0 += 16) {
            const float4 xa = *(const float4*)(xr + k0), wb0 = *(const float4*)(w0 + k0), wb1 = *(const float4*)(w1 + k0);
            a0 = __builtin_amdgcn_mfma_f32_16x16x4f32(xa.x, wb0.x, a0, 0, 0, 0); a1 = __builtin_amdgcn_mfma_f32_16x16x4f32(xa.x, wb1.x, a1, 0, 0, 0);
            a0 = __builtin_amdgcn_mfma_f32_16x16x4f32(xa.y, wb0.y, a0, 0, 0, 0); a1 = __builtin_amdgcn_mfma_f32_16x16x4f32(xa.y, wb1.y, a1, 0, 0, 0);
            a0 = __builtin_amdgcn_mfma_f32_16x16x4f32(xa.z, wb0.z, a0, 0, 0, 0); a1 = __builtin_amdgcn_mfma_f32_16x16x4f32(xa.z, wb1.z, a1, 0, 0, 0);
            a0 = __builtin_amdgcn_mfma_f32_16x16x4f32(xa.w, wb0.w, a0, 0, 0, 0); a1 = __builtin_amdgcn_mfma_f32_16x16x4f32(xa.w, wb1.w, a1, 0, 0, 0);
        }
#pragma unroll
        for (int r = 0; r < 4; ++r) { lg[(fq * 4 + r) * 32 + fr] = a0[r] + rb[fr]; lg[(fq * 4 + r) * 32 + 16 + fr] = a1[r] + rb[16 + fr]; }
        lds_wave_sync();
        int e4[4] = {0, 0, 0, 0}; int rk[4] = {0, 0, 0, 0};
        if (lane < 16) {
            const float* my = lg + lane * 32; unsigned taken = 0u; float tv[4];
#pragma unroll
            for (int k = 0; k < 4; ++k) {
                float best = NEG_INF; int bi = 0;
                for (int e = 0; e < 32; ++e) { const float xv = my[e]; if (!((taken >> e) & 1u) && xv > best) { best = xv; bi = e; } }
                taken |= 1u << bi; e4[k] = bi; tv[k] = best;
            }
            const float e1 = __expf(tv[1] - tv[0]), e2 = __expf(tv[2] - tv[0]), e3 = __expf(tv[3] - tv[0]);
            const float inv = 1.0f / (1.0f + e1 + e2 + e3);
            const size_t row = (size_t)(tok0 + lane);
            *(float4*)(p.gw + row * 4) = make_float4(inv, e1 * inv, e2 * inv, e3 * inv);
        }
        __syncthreads();
        if (lane < 16) {
#pragma unroll
            for (int k = 0; k < 4; ++k) rk[k] = atomicAdd(&lcnt[e4[k]], 1);
        }
        __syncthreads();
        if (tid < 32) { const int c = lcnt[tid]; lbase[tid] = c ? (int)__hip_atomic_fetch_add(gcount + tid, (unsigned)c, __ATOMIC_RELAXED, __HIP_MEMORY_SCOPE_AGENT) : 0; }
        __syncthreads();
        if (lane < 16) {
            const int row = tok0 + lane; int pk[4];
#pragma unroll
            for (int k = 0; k < 4; ++k) { const int pos = lbase[e4[k]] + rk[k]; p.lists[(size_t)e4[k] * LIST_CAP + pos] = row * 4 + k; pk[k] = (pos << 5) | e4[k]; }
            *(int4*)(p.top_e + (size_t)row * 4) = make_int4(pk[0], pk[1], pk[2], pk[3]);
        }
        __syncthreads();
    }
}

__device__ __forceinline__ void phase_ln2(const Params& p, int l, float* xout, char* lds) {
    int* ptile = (int*)(lds + LDS_TAB); int* ecnt = ptile + 40;
    build_tiles(p, l, ptile, ecnt);
    int tid = threadIdx.x; asm volatile("" : "+v"(tid));
    const int wid = tid >> 6, lane = tid & 63;
    const float* g2 = p.ln2_g + l * DM; const float* b2 = p.ln2_b + l * DM;
    float4 gg[4], bb[4];
#pragma unroll
    for (int j = 0; j < 4; ++j) { gg[j] = *(const float4*)(g2 + j * 256 + lane * 4); bb[j] = *(const float4*)(b2 + j * 256 + lane * 4); }
    for (int pr = blockIdx.x * NWV + wid; pr < NTOK / 2; pr += gridDim.x * NWV) {
        float4 v[2][4]; float s[2], qv[2];
        u32x2 yv[2][4][4]; float gk[2][4];
#pragma unroll
        for (int i = 0; i < 2; ++i) {
            const int row = pr * 2 + i;
            const float4 gwv = *(const float4*)(p.gw + (size_t)row * 4);
            gk[i][0] = gwv.x; gk[i][1] = gwv.y; gk[i][2] = gwv.z; gk[i][3] = gwv.w;
            const int4 te = *(const int4*)(p.top_e + (size_t)row * 4);
            const int tk[4] = {te.x, te.y, te.z, te.w};
#pragma unroll
            for (int j = 0; j < 4; ++j) v[i][j] = *(const float4*)(p.x1f + (size_t)row * DM + j * 256 + lane * 4);
#pragma unroll
            for (int k = 0; k < 4; ++k) {
                const bf16_t* yr = p.ybuf + (size_t)(ptile[tk[k] & 31] * 256 + (tk[k] >> 5)) * DM + lane * 4;
#pragma unroll
                for (int j = 0; j < 4; ++j) yv[i][k][j] = *(const u32x2*)(yr + j * 256);
            }
        }
#pragma unroll
        for (int i = 0; i < 2; ++i) { s[i] = 0.f;
#pragma unroll
            for (int j = 0; j < 4; ++j) {
                float4 a; a.x = v[i][j].x * ALPHA; a.y = v[i][j].y * ALPHA; a.z = v[i][j].z * ALPHA; a.w = v[i][j].w * ALPHA;
#pragma unroll
                for (int k = 0; k < 4; ++k) {
                    const u32x2 w = yv[i][k][j];
                    a.x += gk[i][k] * __uint_as_float(w.x << 16); a.y += gk[i][k] * __uint_as_float(w.x & 0xffff0000u);
                    a.z += gk[i][k] * __uint_as_float(w.y << 16); a.w += gk[i][k] * __uint_as_float(w.y & 0xffff0000u);
                }
                v[i][j] = a; s[i] += (a.x + a.y) + (a.z + a.w);
            } }
#pragma unroll
        for (int o = 32; o > 0; o >>= 1) { s[0] += shfl_f(s[0], lane ^ o); s[1] += shfl_f(s[1], lane ^ o); }
#pragma unroll
        for (int i = 0; i < 2; ++i) { const float mean = s[i] * (1.0f / 1024.0f); qv[i] = 0.f;
#pragma unroll
            for (int j = 0; j < 4; ++j) { v[i][j].x -= mean; v[i][j].y -= mean; v[i][j].z -= mean; v[i][j].w -= mean; qv[i] += (v[i][j].x * v[i][j].x + v[i][j].y * v[i][j].y) + (v[i][j].z * v[i][j].z + v[i][j].w * v[i][j].w); } }
#pragma unroll
        for (int o = 32; o > 0; o >>= 1) { qv[0] += shfl_f(qv[0], lane ^ o); qv[1] += shfl_f(qv[1], lane ^ o); }
#pragma unroll
        for (int i = 0; i < 2; ++i) {
            const float rstd = rsqrtf(qv[i] * (1.0f / 1024.0f) + LN_EPS);
            const size_t row = (size_t)(pr * 2 + i);
#pragma unroll
            for (int j = 0; j < 4; ++j) {
                const int c = j * 256 + lane * 4;
                float4 y; y.x = v[i][j].x * rstd * gg[j].x + bb[j].x; y.y = v[i][j].y * rstd * gg[j].y + bb[j].y; y.z = v[i][j].z * rstd * gg[j].z + bb[j].z; y.w = v[i][j].w * rstd * gg[j].w + bb[j].w;
                *(float4*)(xout + row * DM + c) = y;
                u32x2 w; w.x = pack2(y.x, y.y); w.y = pack2(y.z, y.w);
                *(u32x2*)(p.xb + row * DM + c) = w;
            }
        }
    }
}

#define XB_TMO      128
#define XB_XCNT(j)  (256  + 64 * (j))
#define XB_XSUB(j)  (1280 + 64 * (j))
#define XB_XGEN(j)  (2304 + 64 * (j))
#define XB_TOP      3328
#define XB_TOPGEN   3392
#define XCD_BAR_WORDS 3456
#define XB_SPIN_CAP (1u << 22)
__device__ __forceinline__ unsigned xb_ld(unsigned* p)              { return __hip_atomic_load(p, __ATOMIC_RELAXED, __HIP_MEMORY_SCOPE_AGENT); }
__device__ __forceinline__ unsigned xb_add(unsigned* p, unsigned v) { return __hip_atomic_fetch_add(p, v, __ATOMIC_RELAXED, __HIP_MEMORY_SCOPE_AGENT); }
__device__ __forceinline__ unsigned xb_xcc_id() { return (unsigned)__builtin_amdgcn_s_getreg((3 << 11) | 20) & 0xFu; }
#define XB_SPIN(cond, bar) do { unsigned _sp = 0; while (cond) { __builtin_amdgcn_s_sleep(1); \
    if ((++_sp & 255u) == 0u) { if (xb_ld(&(bar)[XB_TMO])) break; if (_sp > XB_SPIN_CAP) { atomicAdd(&(bar)[XB_TMO], 1u); break; } } } } while (0)
struct XcdBarrier { unsigned* bar; unsigned x; volatile LAS unsigned* st; };
__device__ __forceinline__ XcdBarrier xcd_barrier_post(unsigned* bar, volatile LAS unsigned* st) {
    XcdBarrier b; b.bar = bar; b.x = xb_xcc_id(); b.st = st;
    if (threadIdx.x == 0) (void)xb_add(&bar[XB_XCNT(b.x)], 1u);
    return b;
}
__device__ __forceinline__ void xcd_barrier_complete(unsigned* bar, unsigned x, unsigned& nloc, unsigned& nx) {
    const unsigned G = gridDim.x * gridDim.y * gridDim.z;
    unsigned sum, cnt, mine, sp = 0u;
    for (;;) {
        sum = 0u; cnt = 0u; mine = 0u;
#pragma unroll
        for (unsigned j = 0; j < 16; ++j) { const unsigned c = xb_ld(&bar[XB_XCNT(j)]); sum += c; cnt += (c > 0u) ? 1u : 0u; mine = (j == x) ? c : mine; }
        if (sum == G) break;
        __builtin_amdgcn_s_sleep(1);
        if ((++sp & 255u) == 0u) { if (xb_ld(&bar[XB_TMO])) break; if (sp > XB_SPIN_CAP) { atomicAdd(&bar[XB_TMO], 1u); break; } }
    }
    nloc = mine > 0u ? mine : 1u; nx = cnt > 0u ? cnt : 1u;
}
__device__ __forceinline__ void xcd_barrier(const XcdBarrier& b) {
    asm volatile("s_waitcnt vmcnt(0)" ::: "memory");
    __syncthreads();
    if (threadIdx.x == 0) {
        unsigned* bar = b.bar;
        __builtin_amdgcn_s_waitcnt(0);
        unsigned nloc = b.st[0], nx = b.st[1];
        if (nloc == 0u) { xcd_barrier_complete(bar, b.x, nloc, nx); b.st[0] = nloc; b.st[1] = nx; }
        const unsigned old = xb_add(&bar[XB_XSUB(b.x)], 1u);
        const unsigned gen = old / nloc;
        if (old + 1u == (gen + 1u) * nloc) {
            __builtin_amdgcn_fence(__ATOMIC_RELEASE, "agent");
            asm volatile("s_waitcnt vmcnt(0)" ::: "memory");
            const unsigned og = xb_add(&bar[XB_TOP], 1u);
            const unsigned tg = og / nx;
            if (og + 1u == (tg + 1u) * nx) xb_add(&bar[XB_TOPGEN], 1u);
            else XB_SPIN(xb_ld(&bar[XB_TOPGEN]) == tg, bar);
            __builtin_amdgcn_fence(__ATOMIC_ACQUIRE, "agent");
            xb_add(&bar[XB_XGEN(b.x)], 1u);
            asm volatile("s_waitcnt vmcnt(0)" ::: "memory");
        } else {
            XB_SPIN(xb_ld(&bar[XB_XGEN(b.x)]) == gen, bar);
            __builtin_amdgcn_fence(__ATOMIC_ACQUIRE, "agent");
            asm volatile("s_waitcnt vmcnt(0)" ::: "memory");
        }
    }
    __syncthreads();
}

struct KArgs { const float* in[18]; float* out; char* ws; };
constexpr size_t al256(size_t v) { return (v + 255) / 256 * 256; }
struct WSL {
    static constexpr size_t ctrl = 0;
    static constexpr size_t WinT = al256(ctrl + 65536);
    static constexpr size_t WoT = al256(WinT + (size_t)NL * NPAD * 1024 * 2);
    static constexpr size_t W1T = al256(WoT + (size_t)NL * 1024 * 1024 * 2);
    static constexpr size_t W2T = al256(W1T + (size_t)NL * 2 * 64 * 2048 * 2);
    static constexpr size_t WguT = al256(W2T + (size_t)NL * 2 * 64 * 64 * 2);
    static constexpr size_t WdnT = al256(WguT + (size_t)NL * NE * 2048 * 1024 * 2);
    static constexpr size_t rwT = al256(WdnT + (size_t)NL * NE * 1024 * 1024 * 2);
    static constexpr size_t binp = al256(rwT + (size_t)NL * NE * 1024 * 4);
    static constexpr size_t bgup = al256(binp + (size_t)NL * NPAD * 4);
    static constexpr size_t b1c = al256(bgup + (size_t)NL * NE * 2048 * 4);
    static constexpr size_t xf = al256(b1c + 4 * 64 * 4);
    static constexpr size_t xb = al256(xf + (size_t)NTOK * DM * 4);
    static constexpr size_t hb = al256(xb + (size_t)NTOK * DM * 2);
    static constexpr size_t hs = al256(hb + (size_t)NTOK * NMAIN * 2);
    static constexpr size_t vT = al256(hs + (size_t)NTOK * HS_W * 4);
    static constexpr size_t kF = al256(vT + (size_t)NB * NVH * 64 * SEQ * 2);
    static constexpr size_t cF = al256(kF + (size_t)NB * NVH * 64 * SEQ * 2);
    static constexpr size_t kc = al256(cF + (size_t)NB * 4 * SEQ * 4);
    static constexpr size_t vc = al256(kc + (size_t)NB * 2 * 128 * 64 * 2);
    static constexpr size_t vcT = al256(vc + (size_t)NB * 2 * 128 * 64 * 2);
    static constexpr size_t ob = al256(vcT + (size_t)NB * 2 * 128 * 64 * 2);
    static constexpr size_t tbuf = al256(ob + (size_t)NTOK * DM * 2);
    static constexpr size_t x1f = al256(tbuf + (size_t)NTOK * DM * 4);
    static constexpr size_t x1b = al256(x1f + (size_t)NTOK * DM * 4);
    static constexpr size_t top_e = al256(x1b + (size_t)NTOK * DM * 2);
    static constexpr size_t gw = al256(top_e + (size_t)NTOK * 4 * 4);
    static constexpr size_t lists = al256(gw + (size_t)NTOK * 4 * 4);
    static constexpr size_t act = al256(lists + (size_t)NE * LIST_CAP * 4);
    static constexpr size_t ybuf = al256(act + (size_t)MAXSLOT * DFF * 2);
    static constexpr size_t total = al256(ybuf + (size_t)MAXSLOT * DM * 2);
};
__device__ __forceinline__ Params make_params(const KArgs& k) {
    Params p;
    p.x = k.in[0]; p.w_in = k.in[1]; p.b_in = k.in[2]; p.sinks = k.in[3]; p.cmp_pe = k.in[4]; p.cmp_w1 = k.in[5]; p.cmp_w2 = k.in[6]; p.w_out = k.in[7];
    p.ln1_g = k.in[8]; p.ln1_b = k.in[9]; p.router_w = k.in[10]; p.router_b = k.in[11]; p.w_gu = k.in[12]; p.b_gu = k.in[13]; p.w_dn = k.in[14]; p.b_dn = k.in[15];
    p.ln2_g = k.in[16]; p.ln2_b = k.in[17]; p.out = k.out;
    char* w = k.ws;
    p.ctrl = (unsigned*)(w + WSL::ctrl); p.WinT = (bf16_t*)(w + WSL::WinT); p.WoT = (bf16_t*)(w + WSL::WoT); p.W1T = (bf16_t*)(w + WSL::W1T); p.W2T = (bf16_t*)(w + WSL::W2T);
    p.WguT = (bf16_t*)(w + WSL::WguT); p.WdnT = (bf16_t*)(w + WSL::WdnT); p.rwT = (float*)(w + WSL::rwT); p.binp = (float*)(w + WSL::binp); p.bgup = (float*)(w + WSL::bgup);
    p.b1c = (float*)(w + WSL::b1c); p.xf = (float*)(w + WSL::xf); p.xb = (bf16_t*)(w + WSL::xb); p.hb = (bf16_t*)(w + WSL::hb); p.hs = (float*)(w + WSL::hs); p.vT = (bf16_t*)(w + WSL::vT); p.kF = (bf16_t*)(w + WSL::kF);
    p.cF = (float*)(w + WSL::cF); p.kc = (bf16_t*)(w + WSL::kc); p.vc = (bf16_t*)(w + WSL::vc); p.vcT = (bf16_t*)(w + WSL::vcT); p.ob = (bf16_t*)(w + WSL::ob); p.tbuf = (float*)(w + WSL::tbuf);
    p.x1f = (float*)(w + WSL::x1f); p.x1b = (bf16_t*)(w + WSL::x1b); p.top_e = (int*)(w + WSL::top_e); p.gw = (float*)(w + WSL::gw); p.lists = (int*)(w + WSL::lists);
    p.act = (bf16_t*)(w + WSL::act); p.ybuf = (bf16_t*)(w + WSL::ybuf);
    return p;
}
__device__ __forceinline__ void grid_bar(const Params& p, char* lds) {
    XcdBarrier xb; xb.bar = p.ctrl + 1024; xb.x = xb_xcc_id(); xb.st = (volatile LAS unsigned*)(lds + LDS_BYTES - 16); xcd_barrier(xb);
}
__device__ __forceinline__ Params fresh_params(const KArgs& ka) {
    KArgs k2 = ka; asm volatile("" : "+s"(k2.ws));
    return make_params(k2);
}
#ifndef REP
#define REP 0
#endif
template <int L>
__device__ __forceinline__ void layer_fwd(const KArgs& ka, char* lds) {
    { const Params p = fresh_params(ka); phase_inproj(p, L, lds);        grid_bar(p, lds); }
    { const Params p = fresh_params(ka); phase_prep(p, L, lds);          grid_bar(p, lds); }
    { const Params p = fresh_params(ka); phase_attn<L == 0>(p, L, lds);  grid_bar(p, lds); }
    { const Params p = fresh_params(ka); phase_outproj(p, L, L == 0 ? p.x : p.xf, lds);  grid_bar(p, lds); }
    { const Params p = fresh_params(ka); phase_ln1_router(p, L, lds);    grid_bar(p, lds); }
    { const Params p = fresh_params(ka); phase_gateup(p, L, lds);        grid_bar(p, lds); }
    { const Params p = fresh_params(ka); phase_down(p, L, lds);          grid_bar(p, lds); }
    { const Params p = fresh_params(ka); phase_ln2(p, L, L == NL - 1 ? p.out : p.xf, lds); }
}
__global__ void __launch_bounds__(NTHR, 2) fwd_kernel(KArgs ka) {
    extern __shared__ __attribute__((aligned(16))) char lds[];
    const Params p = make_params(ka);
    cg::grid_group grid = cg::this_grid();
    volatile LAS unsigned* xst = (volatile LAS unsigned*)(lds + LDS_BYTES - 16);
    if (threadIdx.x == 0) { xst[0] = 0u; xst[1] = 0u; }
    __syncthreads();
    (void)xcd_barrier_post(p.ctrl + 1024, xst);
    phase0(p, lds);
    if (REP & 128) { grid_bar(p, lds); phase0(p, lds); }
    grid.sync();
    layer_fwd<0>(ka, lds);
    grid_bar(p, lds);
    layer_fwd<1>(ka, lds);
}

extern "C" void kernel_launch(void* const* d_in, const int* in_sizes, int n_in, void* d_out, int out_size, void* d_ws, size_t ws_size, hipStream_t stream) {
    KArgs ka{};
    for (int i = 0; i < 18; ++i) ka.in[i] = (const float*)d_in[i];
    ka.out = (float*)d_out; ka.ws = (char*)d_ws;
    if (WSL::total > ws_size) { fprintf(stderr, "workspace too small: need %zu have %zu\n", (size_t)WSL::total, ws_size); return; }
    static int grid_blocks = 0;
    if (!grid_blocks) {
        int dev = 0, cus = 0, per_cu = 0;
        (void)hipGetDevice(&dev);
        (void)hipDeviceGetAttribute(&cus, hipDeviceAttributeMultiprocessorCount, dev);
        (void)hipFuncSetAttribute((const void*)fwd_kernel, hipFuncAttributeMaxDynamicSharedMemorySize, LDS_BYTES);
        (void)hipOccupancyMaxActiveBlocksPerMultiprocessor(&per_cu, fwd_kernel, NTHR, LDS_BYTES);
        if (per_cu < 1) { fprintf(stderr, "occupancy query says 0 blocks per CU\n"); per_cu = 1; }
        grid_blocks = cus;
    }
    (void)hipMemsetAsync(d_ws, 0, 65536, stream);
    void* args[] = {&ka};
    hipError_t e = hipLaunchCooperativeKernel((const void*)fwd_kernel, dim3(grid_blocks), dim3(NTHR), args, LDS_BYTES, stream);
    if (e != hipSuccess) fprintf(stderr, "cooperative launch failed: %s (grid %d)\n", hipGetErrorString(e), grid_blocks);
}
```

```cpp
#include <hip/hip_runtime.h>
#include <hip/hip_cooperative_groups.h>
#include <cstdio>
#include <cstdint>
namespace cg = cooperative_groups;

typedef unsigned short bf16_t;
typedef short bf16x8 __attribute__((ext_vector_type(8)));
typedef float f32x4 __attribute__((ext_vector_type(4)));
typedef unsigned u32x4 __attribute__((ext_vector_type(4)));
typedef unsigned u32x2 __attribute__((ext_vector_type(2)));
typedef int v8i_t __attribute__((ext_vector_type(8)));
typedef int v4i_t __attribute__((ext_vector_type(4)));
#define LAS __attribute__((address_space(3)))
constexpr float NEG_INF = -__builtin_huge_valf();

constexpr int DM = 1024, NB = 16, SEQ = 2048, NTOK = NB * SEQ, NL = 2;
constexpr int NCOL = 2582, NMAIN = 2560, NPAD = 2688, NE = 32, DFF = 1024;
constexpr int C_FQ = 0, C_FK = 256, C_FV = 512, C_SQ = 768, C_SK = 1152, C_SV = 1280, C_NQ = 1408,
              C_NKC = 1792, C_NVC = 1920, C_NKS = 2048, C_NVS = 2176, C_NKW = 2304, C_NVW = 2432;
constexpr int HS_W = 32;
constexpr int NVH = 10;
constexpr int LIST_CAP = NTOK;
constexpr int MAXSLOT = NTOK * 4 + NE * 256;
constexpr float ALPHA = 1.41421356237f, LN_EPS = 1e-5f, QSCALE = 0.125f;
constexpr int NWV = 8, NTHR = NWV * 64;
constexpr int LDS_STAGE = 131072, LDS_TAB = LDS_STAGE, LDS_AOFF = LDS_STAGE + 2048, LDS_BYTES = LDS_AOFF + 20480 + 256;

struct Params {
    const float *x, *w_in, *b_in, *sinks, *cmp_pe, *cmp_w1, *cmp_w2, *w_out, *ln1_g, *ln1_b, *router_w, *router_b,
                *w_gu, *b_gu, *w_dn, *b_dn, *ln2_g, *ln2_b;
    float* out;
    unsigned* ctrl;
    bf16_t *WinT, *WoT, *W1T, *W2T, *WguT, *WdnT;
    float *rwT, *binp, *bgup, *b1c;
    float* xf; bf16_t* xb; bf16_t* hb; float* hs; bf16_t* vT; bf16_t* kF; float* cF;
    bf16_t *kc, *vc, *vcT; bf16_t* ob; float* tbuf; float* x1f; bf16_t* x1b;
    int* top_e; float* gw; int* lists; bf16_t* act; bf16_t* ybuf;
};

__device__ __forceinline__ float bf2f(bf16_t h) { return __uint_as_float(((unsigned)h) << 16); }
typedef __bf16 bf16x2_t __attribute__((ext_vector_type(2)));
__device__ __forceinline__ bf16_t f2bf(float f) { return __builtin_bit_cast(bf16_t, (__bf16)f); }
__device__ __forceinline__ unsigned pack2(float lo, float hi) { bf16x2_t v = {(__bf16)lo, (__bf16)hi}; return __builtin_bit_cast(unsigned, v); }
__device__ __forceinline__ unsigned pack4_fp8(float a, float b, float c, float d) {
    unsigned w = 0u;
    w = __builtin_amdgcn_cvt_pk_fp8_f32(a, b, w, false);
    w = __builtin_amdgcn_cvt_pk_fp8_f32(c, d, w, true);
    return w;
}
__device__ __forceinline__ float shfl_f(float v, int src_lane) { return __int_as_float(__builtin_amdgcn_ds_bpermute(src_lane << 2, __float_as_int(v))); }
__device__ __forceinline__ unsigned shfl_u(unsigned v, int src_lane) { return (unsigned)__builtin_amdgcn_ds_bpermute(src_lane << 2, (int)v); }
__device__ __forceinline__ float wave_sum(float v) {
#pragma unroll
    for (int o = 32; o > 0; o >>= 1) v += __shfl_xor(v, o);
    return v;
}
__device__ __forceinline__ float wave_max(float v) {
#pragma unroll
    for (int o = 32; o > 0; o >>= 1) v = fmaxf(v, __shfl_xor(v, o));
    return v;
}
__device__ __forceinline__ void lds_wave_sync() { asm volatile("s_waitcnt lgkmcnt(0)" ::: "memory"); __builtin_amdgcn_wave_barrier(); }
__device__ __forceinline__ float slope_swa(int hq) { return exp2f(-8.0f * (float)(2 * hq + 1) / 12.0f); }
__device__ __forceinline__ float slope_nsa(int hq) { return exp2f(-8.0f * (float)(2 * hq + 2) / 12.0f); }

__device__ __forceinline__ int perm_row(int perm, int n) {
    if (perm == 1) { if (n < 768) return n; if (n < 772) return 2560 + (n - 768); if (n < 2564) return n - 4; return n; }
    if (perm == 2) { const int f = n >> 1, s = n & 1; return (f >> 7) * 256 + s * 128 + (f & 127); }
    return n;
}
struct ConvJob { const float* src; bf16_t* dst; int K, N, kt, nt, perm; float q8; };
__device__ __forceinline__ bool conv_job(const Params& p, int t, ConvJob& jb) {
    constexpr int T_WIN = NL * 8 * 21, T_WO = NL * 8 * 8;
    if (t < T_WIN) { const int m = t / 168, r = t % 168; jb = ConvJob{p.w_in + (size_t)m * 1024 * NCOL, p.WinT + (size_t)m * NPAD * 1024, 1024, NCOL, r / 21, r % 21, 1, 0.f}; return true; }
    t -= T_WIN;
    if (t < T_WO) { const int m = t / 64, r = t % 64; jb = ConvJob{p.w_out + (size_t)m * 1024 * 1024, (bf16_t*)((char*)p.WoT + (size_t)m * 1024 * 1024), 1024, 1024, r / 8, r % 8, 0, 64.0f}; return true; }
    return false;
}
constexpr int CONV_TILES = NL * NE * 192;
__device__ __forceinline__ void conv_tile_wave(const Params& p, int t, int lane, unsigned char* l8) {
    asm volatile("" : "+v"(lane));
    const int m = t / 192, r = t % 192;
    const float* src; unsigned char* dst; int N, kt, nt, perm;
    if (r < 128) { src = p.w_gu + (size_t)m * 1024 * 2048; dst = (unsigned char*)p.WguT + (size_t)m * 2048 * 1024; N = 2048; kt = r >> 4; nt = r & 15; perm = 2; }
    else { const int q = r - 128; src = p.w_dn + (size_t)m * 1024 * 1024; dst = (unsigned char*)p.WdnT + (size_t)m * 1024 * 1024; N = 1024; kt = q >> 3; nt = q & 7; perm = 0; }
    const float* s = src + (size_t)(kt * 128 + (lane >> 5)) * N + nt * 128 + (lane & 31) * 4;
    unsigned char* lw = l8 + (lane >> 5) * 132 + (lane & 31) * 4;
    float4 va[16], vb[16];
#pragma unroll
    for (int i = 0; i < 16; ++i) va[i] = *(const float4*)(s + (size_t)(2 * i) * N);
#pragma unroll
    for (int i = 0; i < 16; ++i) vb[i] = *(const float4*)(s + (size_t)(32 + 2 * i) * N);
#pragma unroll
    for (int i = 0; i < 16; ++i) *(unsigned*)(lw + (2 * i) * 132) = pack4_fp8(va[i].x * 64.0f, va[i].y * 64.0f, va[i].z * 64.0f, va[i].w * 64.0f);
#pragma unroll
    for (int i = 0; i < 16; ++i) va[i] = *(const float4*)(s + (size_t)(64 + 2 * i) * N);
#pragma unroll
    for (int i = 0; i < 16; ++i) *(unsigned*)(lw + (32 + 2 * i) * 132) = pack4_fp8(vb[i].x * 64.0f, vb[i].y * 64.0f, vb[i].z * 64.0f, vb[i].w * 64.0f);
#pragma unroll
    for (int i = 0; i < 16; ++i) vb[i] = *(const float4*)(s + (size_t)(96 + 2 * i) * N);
#pragma unroll
    for (int i = 0; i < 16; ++i) *(unsigned*)(lw + (64 + 2 * i) * 132) = pack4_fp8(va[i].x * 64.0f, va[i].y * 64.0f, va[i].z * 64.0f, va[i].w * 64.0f);
#pragma unroll
    for (int i = 0; i < 16; ++i) *(unsigned*)(lw + (96 + 2 * i) * 132) = pack4_fp8(vb[i].x * 64.0f, vb[i].y * 64.0f, vb[i].z * 64.0f, vb[i].w * 64.0f);
    lds_wave_sync();
#pragma unroll 4
    for (int i = 0; i < 16; ++i) {
        const int idx = lane + 64 * i, kc = idx & 7, nn = idx >> 3;
        const unsigned char* l = l8 + (kc * 16) * 132 + nn;
        u32x4 w;
        w.x = (unsigned)l[0] | ((unsigned)l[132] << 8) | ((unsigned)l[264] << 16) | ((unsigned)l[396] << 24);
        w.y = (unsigned)l[528] | ((unsigned)l[660] << 8) | ((unsigned)l[792] << 16) | ((unsigned)l[924] << 24);
        w.z = (unsigned)l[1056] | ((unsigned)l[1188] << 8) | ((unsigned)l[1320] << 16) | ((unsigned)l[1452] << 24);
        w.w = (unsigned)l[1584] | ((unsigned)l[1716] << 8) | ((unsigned)l[1848] << 16) | ((unsigned)l[1980] << 24);
        *(u32x4*)(dst + (size_t)perm_row(perm, nt * 128 + nn) * 1024 + kt * 128 + kc * 16) = w;
    }
    lds_wave_sync();
}
__device__ __forceinline__ void conv_load(const ConvJob& jb, int tid, float2 (&v)[16]) {
    const int n = jb.nt * 128 + (tid & 31) * 4;
    const float* s = jb.src + (size_t)(jb.kt * 128 + (tid >> 5)) * jb.N + n;
#pragma unroll
    for (int i = 0; i < 8; ++i) {
        const float* r = s + (size_t)(16 * i) * jb.N;
        v[2 * i] = (n + 1 < jb.N) ? *(const float2*)r : make_float2(0.f, 0.f);
        v[2 * i + 1] = (n + 3 < jb.N) ? *(const float2*)(r + 2) : make_float2(0.f, 0.f);
    }
}
__device__ __forceinline__ void phase0(const Params& p, char* ldsc) {
    int tid = threadIdx.x; asm volatile("" : "+v"(tid));
    const int G = gridDim.x, bid = blockIdx.x;
    const size_t gtid = (size_t)bid * NTHR + tid, gthreads = (size_t)G * NTHR;
    {
        constexpr int TOT = NL * 8 * 21 + NL * 8 * 8;
        bf16_t* lt = (bf16_t*)ldsc;
        ConvJob jb, jn; float2 v[16], vn[16];
        int t = bid; bool have = t < TOT && conv_job(p, t, jb);
        if (have) conv_load(jb, tid, v);
        while (have) {
            const int tn = t + G; const bool hn = tn < TOT && conv_job(p, tn, jn);
            if (hn) conv_load(jn, tid, vn);
            if (jb.q8 != 0.f) {
                unsigned char* l8 = (unsigned char*)lt;
#pragma unroll
                for (int i = 0; i < 8; ++i)
                    *(unsigned*)(l8 + ((tid >> 5) + 16 * i) * 132 + (tid & 31) * 4) = pack4_fp8(v[2 * i].x * jb.q8, v[2 * i].y * jb.q8, v[2 * i + 1].x * jb.q8, v[2 * i + 1].y * jb.q8);
                __syncthreads();
#pragma unroll
                for (int i = 0; i < 2; ++i) {
                    const int idx = tid + NTHR * i, kc = idx & 7, nn = idx >> 3, n = jb.nt * 128 + nn;
                    const unsigned char* l = l8 + (kc * 16) * 132 + nn;
                    u32x4 w;
                    w.x = (unsigned)l[0] | ((unsigned)l[132] << 8) | ((unsigned)l[264] << 16) | ((unsigned)l[396] << 24);
                    w.y = (unsigned)l[528] | ((unsigned)l[660] << 8) | ((unsigned)l[792] << 16) | ((unsigned)l[924] << 24);
                    w.z = (unsigned)l[1056] | ((unsigned)l[1188] << 8) | ((unsigned)l[1320] << 16) | ((unsigned)l[1452] << 24);
                    w.w = (unsigned)l[1584] | ((unsigned)l[1716] << 8) | ((unsigned)l[1848] << 16) | ((unsigned)l[1980] << 24);
                    *(u32x4*)((char*)jb.dst + (size_t)perm_row(jb.perm, n) * jb.K + jb.kt * 128 + kc * 16) = w;
                }
            } else {
#pragma unroll
                for (int i = 0; i < 8; ++i) {
                    u32x2 w; w.x = pack2(v[2 * i].x, v[2 * i].y); w.y = pack2(v[2 * i + 1].x, v[2 * i + 1].y);
                    *(u32x2*)(lt + ((tid >> 5) + 16 * i) * 136 + (tid & 31) * 4) = w;
                }
                __syncthreads();
#pragma unroll
                for (int i = 0; i < 4; ++i) {
                    const int idx = tid + NTHR * i, kc = idx & 15, nn = idx >> 4, n = jb.nt * 128 + nn;
                    if (n < jb.N) {
                        const bf16_t* l = lt + (kc * 8) * 136 + nn;
                        u32x4 w;
                        w.x = (unsigned)l[0] | ((unsigned)l[136] << 16); w.y = (unsigned)l[272] | ((unsigned)l[408] << 16);
                        w.z = (unsigned)l[544] | ((unsigned)l[680] << 16); w.w = (unsigned)l[816] | ((unsigned)l[952] << 16);
                        *(u32x4*)(jb.dst + (size_t)perm_row(jb.perm, n) * jb.K + jb.kt * 128 + kc * 8) = w;
                    }
                }
            }
            __syncthreads();
            t = tn; have = hn; jb = jn;
#pragma unroll
            for (int i = 0; i < 16; ++i) v[i] = vn[i];
        }
    }
    for (size_t i = gtid; i < (size_t)NL * 2 * 2048 * 64; i += gthreads) {
        const int k = (int)(i % 2048), n = (int)((i / 2048) % 64), m = (int)(i / (2048 * 64));
        p.W1T[i] = f2bf(p.cmp_w1[((size_t)m * 2048 + k) * 64 + n]);
    }
    for (size_t i = gtid; i < (size_t)NL * 2 * 64 * 64; i += gthreads) {
        const int k = (int)(i % 64), n = (int)((i / 64) % 64), m = (int)(i / 4096);
        p.W2T[i] = f2bf(p.cmp_w2[((size_t)m * 64 + k) * 64 + n]);
    }
    for (size_t i = gtid; i < (size_t)NL * NPAD; i += gthreads) {
        const int l = (int)(i / NPAD), r = (int)(i % NPAD);
        float v = 0.f;
        if (r < 2560) { const int n = r < 768 ? r : r + 4; v = p.b_in[l * NCOL + n]; }
        else if (r < 2564) v = p.b_in[l * NCOL + 768 + (r - 2560)];
        else if (r < 2582) v = p.b_in[l * NCOL + r];
        p.binp[i] = v;
    }
    for (size_t i = gtid; i < (size_t)NL * NE * 2048; i += gthreads) {
        const int r = (int)(i % 2048); const size_t le = i / 2048;
        const int s = (r >> 7) & 1, f = (r >> 8) * 128 + (r & 127);
        p.bgup[i] = p.b_gu[le * 2048 + 2 * f + s];
    }
    for (size_t i = gtid; i < (size_t)NL * NE * 1024; i += gthreads) {
        const int k = (int)(i % 1024), e = (int)((i / 1024) % NE), l = (int)(i / (1024 * NE));
        p.rwT[i] = p.router_w[((size_t)l * 1024 + k) * NE + e];
    }
    for (size_t i = gtid; i < (size_t)NL * (NPAD - NCOL) * 1024; i += gthreads) {
        const int l = (int)(i / ((NPAD - NCOL) * 1024)); const size_t r = i % ((size_t)(NPAD - NCOL) * 1024);
        p.WinT[(size_t)l * NPAD * 1024 + (size_t)NCOL * 1024 + r] = 0;
    }
    for (size_t i = gtid; i < (size_t)NTOK * DM / 4; i += gthreads) {
        const float4 v4 = ((const float4*)p.x)[i];
        u32x2 w; w.x = pack2(v4.x, v4.y); w.y = pack2(v4.z, v4.w);
        ((u32x2*)p.xb)[i] = w;
    }
    if (bid < 4) {
        float* lf = (float*)ldsc;
        const int j = tid & 63, part = tid >> 6;
        const float* pe = p.cmp_pe + (size_t)bid * 2048; const float* w1 = p.cmp_w1 + (size_t)bid * 2048 * 64;
        float s = 0.f;
        for (int kk = part * 256; kk < part * 256 + 256; ++kk) s += pe[kk] * w1[(size_t)kk * 64 + j];
        lf[tid] = s; __syncthreads();
        if (tid < 64) { float a = 0.f; for (int q = 0; q < 8; ++q) a += lf[tid + 64 * q]; p.b1c[bid * 64 + tid] = a; }
        __syncthreads();
    }
}

namespace pg8 {
constexpr int BM = 256, BK = 64, HALF = 128, HTB = HALF * BK * 2, NXCD = 8, WGM = 8;
__device__ __forceinline__ int lds_byte(int r, int c) { const int st = (r >> 4) * 2 + (c >> 5), rr = r & 15, cc = c & 31, ob = rr * 64 + cc * 2; return st * 1024 + (ob ^ (((ob >> 9) & 1) << 5)); }
__device__ __forceinline__ void stage_rc(int b, int& R, int& C) { const int st = b / 1024, sb = b % 1024, swz = sb ^ (((sb >> 9) & 1) << 5); R = (st >> 1) * 16 + swz / 64; C = (st & 1) * 32 + (swz % 64) / 2; }
__device__ __forceinline__ bool tile_order(int i, int G, int c, int nM, int nN, int& pm, int& pn) {
    const int nwg = nM * nN; const long L = (long)i * G + c; if (L >= nwg) return false;
    int wgid = (int)L; { const int q = nwg / NXCD, r = nwg % NXCD, xcd = wgid % NXCD, off = wgid / NXCD; wgid = (xcd < r ? xcd * (q + 1) : r * (q + 1) + (xcd - r) * q) + off; }
    const int nig = WGM * nN, gid = wgid / nig, fm = gid * WGM, gsz = (nM - fm) < WGM ? (nM - fm) : WGM;
    pm = fm + ((wgid % nig) % gsz); pn = (wgid % nig) / gsz; return true;
}
template <bool FP8, int SCA, class Sched, class Epi>
__device__ __forceinline__ void gemm_phase(LAS unsigned char* lds, const char* Abase, int K, const Sched& S, const Epi& E) {
    int tid = threadIdx.x; asm volatile("" : "+v"(tid));
    const int wid = __builtin_amdgcn_readfirstlane(tid >> 6), lane = tid & 63, wr = wid >> 2, wc = wid & 3, fr = lane & 15, fq = lane >> 4;
    const int nt = K / BK;
    int R0, C0, R1, C1; stage_rc(tid * 16, R0, C0); stage_rc(tid * 16 + 8192, R1, C1);
    LAS unsigned* aofs = (LAS unsigned*)(lds + LDS_AOFF) + tid;
    unsigned rg[10];
    rg[8] = (unsigned)(R0 * K + C0) * 2u; rg[9] = (unsigned)(R1 * K + C1) * 2u;
    if constexpr (FP8) { aofs[8 * NTHR] = rg[8]; aofs[9 * NTHR] = rg[9]; }
    const size_t kstep = (size_t)(BK * 2), hstep = (size_t)HALF * K * 2;
    const unsigned ldsw = (unsigned)wid * 1024u;
    const int aoff = lds_byte(wr * 64 + fr, fq * 8), boff = lds_byte(wc * 32 + fr, fq * 8);
#define PG8_SA(b, h) (((b) * 2 + (h)) * HTB)
#define PG8_SB(b, h) ((4 + (b) * 2 + (h)) * HTB)
#define PG8_OFS(sel, j) (FP8 ? aofs[((sel) * 4 + (j)) * NTHR] : ((sel) ? rg[4 + (j)] : rg[(j)]))
#define PG8_STAGE_B(bufoff, gbase) do { _Pragma("unroll") for (int _i = 0; _i < 2; ++_i) { const unsigned ob_ = FP8 ? aofs[(8 + _i) * NTHR] : rg[8 + _i]; \
        __builtin_amdgcn_global_load_lds((const unsigned*)((const char*)(gbase) + ob_), (LAS unsigned*)(lds + (bufoff) + ldsw + _i * 8192), 16, 0, 0); } } while (0)
#define PG8_STAGE_A(bufoff, kbyte, sel, h) do { const unsigned o0_ = PG8_OFS(sel, (h) * 2), o1_ = PG8_OFS(sel, (h) * 2 + 1); \
        __builtin_amdgcn_global_load_lds((const unsigned*)(Abase + (kbyte) + o0_), (LAS unsigned*)(lds + (bufoff) + ldsw), 16, 0, 0); \
        __builtin_amdgcn_global_load_lds((const unsigned*)(Abase + (kbyte) + o1_), (LAS unsigned*)(lds + (bufoff) + ldsw + 8192), 16, 0, 0); } while (0)
#define PG8_LDA(dst, b, h) do { _Pragma("unroll") for (int m = 0; m < 4; ++m) { \
        if constexpr (FP8) { const v4i_t lo_ = *(const LAS v4i_t*)(lds + PG8_SA(b, h) + aoff + m * 2048), hi_ = *(const LAS v4i_t*)(lds + PG8_SA(b, h) + aoff + m * 2048 + 1024); dst##8[m] = __builtin_shufflevector(lo_, hi_, 0, 1, 2, 3, 4, 5, 6, 7); } \
        else { _Pragma("unroll") for (int k = 0; k < 2; ++k) dst[m][k] = *(const LAS bf16x8*)(lds + PG8_SA(b, h) + aoff + m * 2048 + k * 1024); } } } while (0)
#define PG8_LDB(dst, b, h) do { _Pragma("unroll") for (int n = 0; n < 2; ++n) { \
        if constexpr (FP8) { const v4i_t lo_ = *(const LAS v4i_t*)(lds + PG8_SB(b, h) + boff + n * 2048), hi_ = *(const LAS v4i_t*)(lds + PG8_SB(b, h) + boff + n * 2048 + 1024); dst##8[n] = __builtin_shufflevector(lo_, hi_, 0, 1, 2, 3, 4, 5, 6, 7); } \
        else { _Pragma("unroll") for (int k = 0; k < 2; ++k) dst[n][k] = *(const LAS bf16x8*)(lds + PG8_SB(b, h) + boff + n * 2048 + k * 1024); } } } while (0)
#define PG8_MMA(ai, bj, At, Bt) do { __builtin_amdgcn_s_setprio(1); _Pragma("unroll") for (int m = 0; m < 4; ++m) _Pragma("unroll") for (int n = 0; n < 2; ++n) { \
        if constexpr (FP8) { acc[ai][bj][m][n] = __builtin_amdgcn_mfma_scale_f32_16x16x128_f8f6f4(Bt##8[n], At##8[m], acc[ai][bj][m][n], 0, 0, 0, SCA, 0, SCA); } \
        else { _Pragma("unroll") for (int k = 0; k < 2; ++k) acc[ai][bj][m][n] = __builtin_amdgcn_mfma_f32_16x16x32_bf16(Bt[n][k], At[m][k], acc[ai][bj][m][n], 0, 0, 0); } } \
        __builtin_amdgcn_s_setprio(0); } while (0)
#define PG8_WAIT_V(n) asm volatile("s_waitcnt vmcnt(" #n ")" ::: "memory")
#define PG8_WAIT_L(n) asm volatile("s_waitcnt lgkmcnt(" #n ")" ::: "memory")
#define PG8_BAR __builtin_amdgcn_s_barrier()
#define PG8_SCHED __builtin_amdgcn_sched_barrier(0)
    typename Sched::Unit cur, nxt; int ui = 0;
    if (!S.next(0, cur)) return;
    f32x4 acc[2][2][4][2];
#pragma unroll
    for (int a = 0; a < 2; ++a)
#pragma unroll
        for (int b = 0; b < 2; ++b)
#pragma unroll
            for (int m = 0; m < 4; ++m)
#pragma unroll
                for (int n = 0; n < 2; ++n) acc[a][b][m][n] = (f32x4){0.f, 0.f, 0.f, 0.f};
    bf16x8 At[4][2], B0[2][2], B1[2][2];
    v8i_t At8[4], B08[2], B18[2];
    { unsigned a4[2][2]; S.a_off(cur, R0, C0, R1, C1, a4); rg[0] = a4[0][0]; rg[1] = a4[0][1]; rg[2] = a4[1][0]; rg[3] = a4[1][1];
      if constexpr (FP8) { aofs[0] = a4[0][0]; aofs[NTHR] = a4[0][1]; aofs[2 * NTHR] = a4[1][0]; aofs[3 * NTHR] = a4[1][1]; } }
    const char* cB = S.b_ptr(cur);
    PG8_STAGE_B(PG8_SB(0, 0), cB); PG8_STAGE_B(PG8_SB(0, 1), cB + hstep); PG8_STAGE_A(PG8_SA(0, 0), 0, 0, 0); PG8_STAGE_A(PG8_SA(0, 1), 0, 0, 1);
    if (wr == 1) PG8_BAR;
    PG8_WAIT_V(2); PG8_BAR;
    PG8_STAGE_B(PG8_SB(1, 0), cB + kstep); PG8_STAGE_A(PG8_SA(1, 0), kstep, 0, 0); PG8_STAGE_B(PG8_SB(1, 1), cB + hstep + kstep);
    PG8_WAIT_V(6); PG8_BAR;
    for (;;) {
        const bool has_next = S.next(ui + 1, nxt);
        const char* nB = cB;
        if (has_next) { int t2 = threadIdx.x; asm volatile("" : "+v"(t2)); int r0, c0, r1, c1; stage_rc(t2 * 16, r0, c0); stage_rc(t2 * 16 + 8192, r1, c1); unsigned a4[2][2]; S.a_off(nxt, r0, c0, r1, c1, a4); nB = S.b_ptr(nxt);
            rg[4] = a4[0][0]; rg[5] = a4[0][1]; rg[6] = a4[1][0]; rg[7] = a4[1][1];
            if constexpr (FP8) { aofs[4 * NTHR] = a4[0][0]; aofs[5 * NTHR] = a4[0][1]; aofs[6 * NTHR] = a4[1][0]; aofs[7 * NTHR] = a4[1][1]; } }
        else { rg[4] = rg[0]; rg[5] = rg[1]; rg[6] = rg[2]; rg[7] = rg[3];
            if constexpr (FP8) { aofs[4 * NTHR] = aofs[0]; aofs[5 * NTHR] = aofs[NTHR]; aofs[6 * NTHR] = aofs[2 * NTHR]; aofs[7 * NTHR] = aofs[3 * NTHR]; } }
#pragma unroll 1
        for (int t = 0; t < nt; t += 2) {
            const bool last = (t == nt - 2);
            const size_t ka1 = (size_t)(t + 1) * kstep, ka2 = last ? 0 : (size_t)(t + 2) * kstep, ka3 = ka2 + kstep;
            const char* b2 = last ? nB : cB + (size_t)(t + 2) * kstep; const char* b3 = b2 + kstep;
            const int sel = last ? 1 : 0;
            PG8_LDB(B0, 0, 0); PG8_LDB(B1, 0, 1); PG8_SCHED; PG8_LDA(At, 0, 0); PG8_STAGE_A(PG8_SA(1, 1), ka1, 0, 1);
            PG8_WAIT_V(8); PG8_WAIT_L(0); PG8_BAR; PG8_MMA(0, 0, At, B0); PG8_MMA(0, 1, At, B1); PG8_BAR; PG8_SCHED;
            PG8_LDA(At, 0, 1); PG8_STAGE_B(PG8_SB(0, 0), b2); PG8_STAGE_B(PG8_SB(0, 1), b2 + hstep); PG8_STAGE_A(PG8_SA(0, 0), ka2, sel, 0);
            PG8_WAIT_V(8); PG8_WAIT_L(0); PG8_BAR; PG8_MMA(1, 0, At, B0); PG8_MMA(1, 1, At, B1); PG8_BAR; PG8_SCHED;
            PG8_LDB(B0, 1, 0); PG8_LDB(B1, 1, 1); PG8_SCHED; PG8_LDA(At, 1, 0); PG8_STAGE_A(PG8_SA(0, 1), ka2, sel, 1);
            PG8_WAIT_V(8); PG8_WAIT_L(0); PG8_BAR; PG8_MMA(0, 0, At, B0); PG8_MMA(0, 1, At, B1); PG8_BAR; PG8_SCHED;
            PG8_LDA(At, 1, 1); PG8_STAGE_B(PG8_SB(1, 0), b3); PG8_STAGE_B(PG8_SB(1, 1), b3 + hstep); PG8_STAGE_A(PG8_SA(1, 0), ka3, sel, 0);
            PG8_WAIT_V(8); PG8_WAIT_L(0); PG8_BAR; PG8_MMA(1, 0, At, B0); PG8_MMA(1, 1, At, B1); PG8_BAR; PG8_SCHED;
        }
        if (wr == 0) PG8_BAR;
        { int t2 = threadIdx.x; asm volatile("" : "+v"(t2)); E(acc, cur, wr, wc, t2 & 15, (t2 & 63) >> 4); }
        if (!has_next) break;
#pragma unroll
        for (int a = 0; a < 2; ++a)
#pragma unroll
            for (int b = 0; b < 2; ++b)
#pragma unroll
                for (int m = 0; m < 4; ++m)
#pragma unroll
                    for (int n = 0; n < 2; ++n) acc[a][b][m][n] = (f32x4){0.f, 0.f, 0.f, 0.f};
        cur = nxt; cB = nB; ++ui;
        rg[0] = rg[4]; rg[1] = rg[5]; rg[2] = rg[6]; rg[3] = rg[7];
        if constexpr (FP8) { aofs[0] = aofs[4 * NTHR]; aofs[NTHR] = aofs[5 * NTHR]; aofs[2 * NTHR] = aofs[6 * NTHR]; aofs[3 * NTHR] = aofs[7 * NTHR]; }
        if (wr == 1) PG8_BAR;
    }
    PG8_WAIT_V(0);
    PG8_BAR;
#undef PG8_SA
#undef PG8_SB
#undef PG8_STAGE_A
#undef PG8_OFS
#undef PG8_STAGE_B
#undef PG8_LDA
#undef PG8_LDB
#undef PG8_MMA
#undef PG8_WAIT_V
#undef PG8_WAIT_L
#undef PG8_BAR
#undef PG8_SCHED
}
}

struct DenseUnit { int pm, pn; };
struct DenseSched {
    typedef DenseUnit Unit;
    const char* Bt; int K, nM, nN;
    __device__ __forceinline__ bool next(int i, Unit& u) const { return pg8::tile_order(i, gridDim.x, blockIdx.x, nM, nN, u.pm, u.pn); }
    __device__ __forceinline__ void a_off(const Unit& u, int R0, int C0, int R1, int C1, unsigned (&off)[2][2]) const {
#pragma unroll
        for (int h = 0; h < 2; ++h) { off[h][0] = (unsigned)((u.pm * 256 + h * 128 + R0) * K + C0) * 2u; off[h][1] = (unsigned)((u.pm * 256 + h * 128 + R1) * K + C1) * 2u; }
    }
    __device__ __forceinline__ const char* b_ptr(const Unit& u) const { return Bt + (size_t)u.pn * 256 * K * 2; }
};
struct MoeUnit { int rbt, e, pn; };
template <bool GATHER>
struct MoeSched {
    typedef MoeUnit Unit;
    static constexpr int KP = 512;
    const char* Bt; const int* lists; const int* ptile; const int* ecnt; int nN, nrows;
    __device__ __forceinline__ bool next(int i, Unit& u) const {
        int pm, pn; if (!pg8::tile_order(i, gridDim.x, blockIdx.x, ptile[NE], nN, pm, pn)) return false;
        int e = 0; while (ptile[e + 1] <= pm) ++e;
        u.rbt = pm; u.e = e; u.pn = pn; return true;
    }
    __device__ __forceinline__ void a_off(const Unit& u, int R0, int C0, int R1, int C1, unsigned (&off)[2][2]) const {
        if (GATHER) {
            const int* lst = lists + (size_t)u.e * LIST_CAP; const int rb = u.rbt - ptile[u.e], cnt = ecnt[u.e];
#pragma unroll
            for (int h = 0; h < 2; ++h) {
                const int l0 = rb * 256 + h * 128 + R0, l1 = rb * 256 + h * 128 + R1;
                const int t0 = l0 < cnt ? (lst[l0] >> 2) : 0, t1 = l1 < cnt ? (lst[l1] >> 2) : 0;
                off[h][0] = (unsigned)(t0 * KP + C0) * 2u; off[h][1] = (unsigned)(t1 * KP + C1) * 2u;
            }
        } else {
#pragma unroll
            for (int h = 0; h < 2; ++h) { off[h][0] = (unsigned)((u.rbt * 256 + h * 128 + R0) * KP + C0) * 2u; off[h][1] = (unsigned)((u.rbt * 256 + h * 128 + R1) * KP + C1) * 2u; }
        }
    }
    __device__ __forceinline__ const char* b_ptr(const Unit& u) const { return Bt + ((size_t)u.e * nrows + (size_t)u.pn * 256) * KP * 2; }
};

struct EpiInProj {
    const Params* p; int l;
    __device__ __forceinline__ void operator()(const f32x4 (&acc)[2][2][4][2], const DenseUnit& u, int wr, int wc, int fr, int fq) const {
        const float* bias = p->binp + l * NPAD + u.pn * 256;
#pragma unroll
        for (int bj = 0; bj < 2; ++bj) {
            int kind = 0, hb0 = 0;
            if (u.pn == 1) { kind = 1; hb0 = bj * 2; } else if (u.pn == 4 && bj == 1) { kind = 1; hb0 = 4; } else if (u.pn == 8 && bj == 0) { kind = 1; hb0 = 6; } else if (u.pn == 9 && bj == 0) { kind = 1; hb0 = 8; }
            else if (u.pn == 2) { kind = 2; hb0 = bj * 2; } else if (u.pn == 5 && bj == 0) { kind = 2; hb0 = 4; } else if (u.pn == 8 && bj == 1) { kind = 2; hb0 = 6; } else if (u.pn == 9 && bj == 1) { kind = 2; hb0 = 8; }
#pragma unroll
            for (int n = 0; n < 2; ++n) {
                const int c = bj * 128 + wc * 32 + n * 16 + 4 * fq;
                const f32x4 bv = *(const f32x4*)(bias + c);
                const int hh = hb0 + ((c & 127) >> 6), d = c & 63;
#pragma unroll
                for (int ai = 0; ai < 2; ++ai)
#pragma unroll
                    for (int m = 0; m < 4; ++m) {
                        const int row = u.pm * 256 + ai * 128 + wr * 64 + m * 16 + fr;
                        const f32x4 v = acc[ai][bj][m][n] + bv;
                        u32x2 w; w.x = pack2(v[0], v[1]); w.y = pack2(v[2], v[3]);
                        if (kind == 0) *(u32x2*)(p->hb + (size_t)row * NMAIN + u.pn * 256 + c) = w;
                        else {
                            const int b = row >> 11, s = row & 2047, kk = s & 31;
                            bf16_t* blk = (kind == 1 ? p->kF : p->vT) + (((size_t)b * NVH + hh) * 64 + (s >> 5)) * 2048;
                            if (kind == 1) {
                                const int frk = (kk >> 3) * 4 + (kk & 3), t = (kk >> 2) & 1;
                                *(u32x2*)(blk + ((t * 2 + (d >> 5)) * 64 + ((d & 31) >> 3) * 16 + frk) * 8 + (d & 7)) = w;
                            } else {
                                bf16_t* vt = blk + (((d >> 4) * 64) + (kk >> 3) * 16 + (d & 15)) * 8 + (kk & 7);
                                vt[0] = (bf16_t)(w.x & 0xffff); vt[8] = (bf16_t)(w.x >> 16); vt[16] = (bf16_t)(w.y & 0xffff); vt[24] = (bf16_t)(w.y >> 16);
                            }
                        }
                    }
            }
        }
    }
};
struct EpiOutProj {
    const float* xin; float* t;
    __device__ __forceinline__ void operator()(const f32x4 (&acc)[2][2][4][2], const DenseUnit& u, int wr, int wc, int fr, int fq) const {
#pragma unroll
        for (int ai = 0; ai < 2; ++ai)
#pragma unroll
            for (int m = 0; m < 4; ++m) {
                const size_t rowoff = (size_t)(u.pm * 256 + ai * 128 + wr * 64 + m * 16 + fr) * DM + u.pn * 256 + wc * 32 + 4 * fq;
#pragma unroll
                for (int bj = 0; bj < 2; ++bj)
#pragma unroll
                    for (int n = 0; n < 2; ++n) {
                        const size_t off = rowoff + bj * 128 + n * 16;
                        const f32x4 xv = *(const f32x4*)(xin + off);
                        *(f32x4*)(t + off) = xv * ALPHA + acc[ai][bj][m][n];
                    }
            }
    }
};
struct EpiGateUp {
    bf16_t* act; const float* bgup;
    __device__ __forceinline__ void operator()(const f32x4 (&acc)[2][2][4][2], const MoeUnit& u, int wr, int wc, int fr, int fq) const {
        const float* bias = bgup + (size_t)u.e * 2048 + u.pn * 256;
#pragma unroll
        for (int n = 0; n < 2; ++n) {
            const int c = wc * 32 + n * 16 + 4 * fq;
            const f32x4 bg = *(const f32x4*)(bias + c), bu = *(const f32x4*)(bias + 128 + c);
#pragma unroll
            for (int ai = 0; ai < 2; ++ai)
#pragma unroll
                for (int m = 0; m < 4; ++m) {
                    const f32x4 g4 = acc[ai][0][m][n] + bg, u4 = acc[ai][1][m][n] + bu;
                    float o[4];
#pragma unroll
                    for (int j = 0; j < 4; ++j) {
                        const float g = fminf(g4[j], 7.0f), uu = fminf(fmaxf(u4[j], -7.0f), 7.0f);
                        const float glu = g * __builtin_amdgcn_rcpf(1.0f + __builtin_amdgcn_exp2f(-2.455466929f * g));
                        o[j] = (uu + 1.0f) * glu;
                    }
                    *(unsigned*)((char*)act + (size_t)(u.rbt * 256 + ai * 128 + wr * 64 + m * 16 + fr) * DFF + u.pn * 128 + c) = pack4_fp8(o[0], o[1], o[2], o[3]);
                }
        }
    }
};
struct EpiDown {
    bf16_t* ybuf; const float* bdn;
    __device__ __forceinline__ void operator()(const f32x4 (&acc)[2][2][4][2], const MoeUnit& u, int wr, int wc, int fr, int fq) const {
        const float* bias = bdn + (size_t)u.e * 1024 + u.pn * 256;
#pragma unroll
        for (int bj = 0; bj < 2; ++bj)
#pragma unroll
            for (int n = 0; n < 2; ++n) {
                const int c = bj * 128 + wc * 32 + n * 16 + 4 * fq;
                const f32x4 bv = *(const f32x4*)(bias + c);
#pragma unroll
                for (int ai = 0; ai < 2; ++ai)
#pragma unroll
                    for (int m = 0; m < 4; ++m) {
                        const f32x4 v = acc[ai][bj][m][n] + bv;
                        u32x2 w; w.x = pack2(v[0], v[1]); w.y = pack2(v[2], v[3]);
                        *(u32x2*)(ybuf + (size_t)(u.rbt * 256 + ai * 128 + wr * 64 + m * 16 + fr) * DM + u.pn * 256 + c) = w;
                    }
            }
    }
};

__device__ __forceinline__ void phase_inproj(const Params& p, int l, char* lds) {
    DenseSched S{(const char*)(p.WinT + (size_t)l * NPAD * 1024), 1024, NTOK / 256, NMAIN / 256};
    EpiInProj E{&p, l};
    pg8::gemm_phase<false, 0>((LAS unsigned char*)lds, (const char*)p.xb, 1024, S, E);
    int tid = threadIdx.x; asm volatile("" : "+v"(tid));
    const int wid = tid >> 6, lane = tid & 63, fr = lane & 15, fq = lane >> 4;
    const bf16_t* W = p.WinT + ((size_t)l * NPAD + NMAIN) * 1024;
    const float* bias = p.binp + l * NPAD + NMAIN;
    for (int u = blockIdx.x * NWV + wid; u < NTOK / 16; u += gridDim.x * NWV) {
        const bf16_t* ar = p.xb + (size_t)(u * 16 + fr) * DM + fq * 8;
        const bf16_t* w0 = W + (size_t)fr * 1024 + fq * 8; const bf16_t* w1 = W + (size_t)(16 + fr) * 1024 + fq * 8;
        f32x4 a0 = (f32x4){0.f, 0.f, 0.f, 0.f}, a1 = a0;
#pragma unroll 4
        for (int ks = 0; ks < 32; ++ks) {
            const bf16x8 a = *(const bf16x8*)(ar + ks * 32);
            a0 = __builtin_amdgcn_mfma_f32_16x16x32_bf16(a, *(const bf16x8*)(w0 + ks * 32), a0, 0, 0, 0);
            a1 = __builtin_amdgcn_mfma_f32_16x16x32_bf16(a, *(const bf16x8*)(w1 + ks * 32), a1, 0, 0, 0);
        }
#pragma unroll
        for (int r = 0; r < 4; ++r) {
            float* dst = p.hs + (size_t)(u * 16 + fq * 4 + r) * HS_W;
            dst[fr] = a0[r] + bias[fr];
            if (fr < 6) dst[16 + fr] = a1[r] + bias[16 + fr];
        }
    }
}
__device__ __forceinline__ void phase_outproj(const Params& p, int l, const float* xin, char* lds) {
    DenseSched S{(const char*)p.WoT + (size_t)l * 1024 * 1024, 512, NTOK / 256, 4};
    EpiOutProj E{xin, p.tbuf};
    pg8::gemm_phase<true, 0x7c7c7c7c>((LAS unsigned char*)lds, (const char*)p.ob, 512, S, E);
}
__device__ __forceinline__ void build_tiles(const Params& p, int l, int* ptile, int* ecnt) {
    int tid = threadIdx.x; asm volatile("" : "+v"(tid));
    if (tid < NE) ecnt[tid] = (int)__hip_atomic_load(p.ctrl + 64 + l * NE + tid, __ATOMIC_RELAXED, __HIP_MEMORY_SCOPE_AGENT);
    __syncthreads();
    if (tid == 0) { int s = 0; for (int e = 0; e < NE; ++e) { ptile[e] = s; s += (ecnt[e] + 255) >> 8; } ptile[NE] = s; }
    __syncthreads();
}
__device__ __forceinline__ void phase_gateup(const Params& p, int l, char* lds) {
    int* ptile = (int*)(lds + LDS_TAB); int* ecnt = ptile + 40;
    build_tiles(p, l, ptile, ecnt);
    MoeSched<true> S{(const char*)p.WguT + (size_t)l * NE * 2048 * 1024, p.lists, ptile, ecnt, 8, 2048};
    EpiGateUp E{p.act, p.bgup + (size_t)l * NE * 2048};
    pg8::gemm_phase<true, 0x7c7c7c7c>((LAS unsigned char*)lds, (const char*)p.x1b, 512, S, E);
}
__device__ __forceinline__ void phase_down(const Params& p, int l, char* lds) {
    int* ptile = (int*)(lds + LDS_TAB); int* ecnt = ptile + 40;
    build_tiles(p, l, ptile, ecnt);
    MoeSched<false> S{(const char*)p.WdnT + (size_t)l * NE * 1024 * 1024, p.lists, ptile, ecnt, 4, 1024};
    EpiDown E{p.ybuf, p.b_dn + (size_t)l * NE * 1024};
    pg8::gemm_phase<true, 0x7c7c7c7c>((LAS unsigned char*)lds, (const char*)p.act, 512, S, E);
}

__device__ __forceinline__ float gelu_tanh(float x) {
    const float u = 0.7978845608028654f * (x + 0.044715f * x * x * x);
    const float e = __expf(-2.0f * fabsf(u)); const float th = (1.0f - e) / (1.0f + e);
    return 0.5f * x * (1.0f + (u < 0.f ? -th : th));
}
__device__ __forceinline__ void phase_prep(const Params& p, int l, char* lds) {
    int tid = threadIdx.x; asm volatile("" : "+v"(tid));
    const int wid = tid >> 6, lane = tid & 63, fr = lane & 15, fq = lane >> 4;
    const int gw = blockIdx.x * NWV + wid, nw = gridDim.x * NWV;
    for (int u = (int)gridDim.x - 1 - (int)blockIdx.x; u < NB * 4; u += gridDim.x) {
        const int b = u >> 2, h = u & 3;
        const float* srcp = p.hs + ((size_t)b * SEQ + tid * 4) * HS_W + h;
        float ls[4]; float tot = 0.f;
#pragma unroll
        for (int i = 0; i < 4; ++i) { const float f = srcp[(size_t)i * HS_W]; ls[i] = fminf(f, 0.f) - log1pf(__expf(-fabsf(f))); tot += ls[i]; }
        float inc = tot;
#pragma unroll
        for (int o = 1; o < 64; o <<= 1) { const float v = shfl_f(inc, lane - o); if (lane >= o) inc += v; }
        float* wtot = (float*)(lds + 65536);
        if (lane == 63) wtot[wid] = inc;
        __syncthreads();
        float base = inc - tot;
        for (int w = 0; w < wid; ++w) base += wtot[w];
        float4 o4; o4.x = base + ls[0]; o4.y = o4.x + ls[1]; o4.z = o4.y + ls[2]; o4.w = o4.z + ls[3];
        *(float4*)(p.cF + (size_t)u * SEQ + tid * 4) = o4;
        __syncthreads();
    }
    float* part = (float*)lds;
    bf16_t* h1 = (bf16_t*)(lds + 32768);
    for (int u = blockIdx.x; u < NB * 2 * 2 * 8; u += gridDim.x) {
        const int ct = u & 7, which = (u >> 3) & 1, kvh = (u >> 4) & 1, b = u >> 5;
        const int colo = (which ? C_NVC : C_NKC) + kvh * 64;
        const int c_lane = ct * 16 + fr;
        const int tokbase = min(c_lane, 126) * 16;
        const bf16_t* arow = p.hb + ((size_t)b * SEQ + tokbase) * NMAIN + colo + fq * 8;
        const bf16_t* w1 = p.W1T + ((size_t)(l * 2 + which) * 64 + fr) * 2048 + fq * 8;
        f32x4 acc[4];
#pragma unroll
        for (int n = 0; n < 4; ++n) acc[n] = (f32x4){0.f, 0.f, 0.f, 0.f};
#pragma unroll
        for (int kk = 0; kk < 8; ++kk) {
            const int ks = wid * 8 + kk;
            const bf16x8 a = *(const bf16x8*)(arow + (size_t)(ks >> 1) * NMAIN + (ks & 1) * 32);
#pragma unroll
            for (int n = 0; n < 4; ++n) {
                const bf16x8 bb = *(const bf16x8*)(w1 + (size_t)n * 16 * 2048 + ks * 32);
                acc[n] = __builtin_amdgcn_mfma_f32_16x16x32_bf16(a, bb, acc[n], 0, 0, 0);
            }
        }
#pragma unroll
        for (int n = 0; n < 4; ++n)
#pragma unroll
            for (int r = 0; r < 4; ++r) part[wid * 1024 + (fq * 4 + r) * 64 + n * 16 + fr] = acc[n][r];
        __syncthreads();
        const float* b1 = p.b1c + (l * 2 + which) * 64;
#pragma unroll
        for (int i = 0; i < 2; ++i) {
            const int e = tid + NTHR * i; float sum = 0.f;
#pragma unroll
            for (int w = 0; w < 8; ++w) sum += part[w * 1024 + e];
            h1[e] = f2bf(gelu_tanh(sum + b1[e & 63]));
        }
        __syncthreads();
        if (wid == 0) {
            const bf16_t* w2 = p.W2T + ((size_t)(l * 2 + which) * 64 + fr) * 64 + fq * 8;
            f32x4 o2[4];
#pragma unroll
            for (int n = 0; n < 4; ++n) o2[n] = (f32x4){0.f, 0.f, 0.f, 0.f};
#pragma unroll
            for (int ks = 0; ks < 2; ++ks) {
                const bf16x8 a = *(const bf16x8*)(h1 + fr * 64 + ks * 32 + fq * 8);
#pragma unroll
                for (int n = 0; n < 4; ++n) {
                    const bf16x8 bb = *(const bf16x8*)(w2 + (size_t)n * 16 * 64 + ks * 32);
                    o2[n] = __builtin_amdgcn_mfma_f32_16x16x32_bf16(a, bb, o2[n], 0, 0, 0);
                }
            }
            const size_t base = ((size_t)b * 2 + kvh) * 128 * 64;
#pragma unroll
            for (int n = 0; n < 4; ++n)
#pragma unroll
                for (int r = 0; r < 4; ++r) {
                    const int c = ct * 16 + fq * 4 + r, j2 = n * 16 + fr;
                    const bf16_t v = c < 127 ? f2bf(o2[n][r]) : (bf16_t)0;
                    if (which == 0) p.kc[base + (size_t)c * 64 + j2] = v;
                    else { p.vc[base + (size_t)c * 64 + j2] = v; p.vcT[base + (size_t)j2 * 128 + c] = v; }
                }
        }
        __syncthreads();
    }
}

constexpr float L2E = 1.4426950408889634f, MASKV = -__builtin_huge_valf(), MINIT = -1e30f, SCL2 = QSCALE * L2E;
struct KVFrag { bf16x8 k[2][2]; bf16x8 v[4]; };
template <bool FM>
__device__ __forceinline__ void k_load(KVFrag& f, const bf16_t* __restrict__ Kb, size_t ldk, int kc0, int fr, int fq) {
    if (FM) {
        const bf16_t* kp = Kb + (size_t)(kc0 >> 5) * 2048 + (fq * 16 + fr) * 8;
        f.k[0][0] = *(const bf16x8*)(kp); f.k[0][1] = *(const bf16x8*)(kp + 512); f.k[1][0] = *(const bf16x8*)(kp + 1024); f.k[1][1] = *(const bf16x8*)(kp + 1536);
    } else {
        const bf16_t* kp = Kb + (size_t)(kc0 + (fr >> 2) * 8 + (fr & 3)) * ldk + fq * 8;
        f.k[0][0] = *(const bf16x8*)(kp); f.k[0][1] = *(const bf16x8*)(kp + 32);
        f.k[1][0] = *(const bf16x8*)(kp + 4 * ldk); f.k[1][1] = *(const bf16x8*)(kp + 4 * ldk + 32);
    }
}
template <bool FM>
__device__ __forceinline__ void v_load(bf16x8 (&v)[4], const bf16_t* __restrict__ VTb, size_t ldv, int kc0, int fr, int fq) {
    if (FM) {
        const bf16_t* vp = VTb + (size_t)(kc0 >> 5) * 2048 + (fq * 16 + fr) * 8;
#pragma unroll
        for (int dt = 0; dt < 4; ++dt) v[dt] = *(const bf16x8*)(vp + dt * 512);
    } else {
        const bf16_t* vp = VTb + (size_t)fr * ldv + kc0 + fq * 8;
#pragma unroll
        for (int dt = 0; dt < 4; ++dt) v[dt] = *(const bf16x8*)(vp + (size_t)dt * 16 * ldv);
    }
}
__device__ __forceinline__ float rowmax4(float x) {
    auto r = __builtin_amdgcn_permlane32_swap(__float_as_uint(x), __float_as_uint(x), false, false);
    x = fmaxf(__uint_as_float(r[0]), __uint_as_float(r[1]));
    auto q = __builtin_amdgcn_permlane16_swap(__float_as_uint(x), __float_as_uint(x), false, false);
    return fmaxf(__uint_as_float(q[0]), __uint_as_float(q[1]));
}
__device__ __forceinline__ float rowsum4(float x) {
    auto r = __builtin_amdgcn_permlane32_swap(__float_as_uint(x), __float_as_uint(x), false, false);
    x = __uint_as_float(r[0]) + __uint_as_float(r[1]);
    auto q = __builtin_amdgcn_permlane16_swap(__float_as_uint(x), __float_as_uint(x), false, false);
    return __uint_as_float(q[0]) + __uint_as_float(q[1]);
}
template <int NQT, bool MASK, class MB>
__device__ __forceinline__ void attn_compute(const KVFrag& f, const bf16x8 (&qf)[NQT][2], f32x4 (&o)[NQT][4], float (&m)[NQT], float (&l)[NQT], const MB& mb) {
    f32x4 s0[NQT], s1[NQT];
#pragma unroll
    for (int qt = 0; qt < NQT; ++qt) {
        s0[qt] = __builtin_amdgcn_mfma_f32_16x16x32_bf16(f.k[0][0], qf[qt][0], (f32x4){0.f, 0.f, 0.f, 0.f}, 0, 0, 0);
        s1[qt] = __builtin_amdgcn_mfma_f32_16x16x32_bf16(f.k[1][0], qf[qt][0], (f32x4){0.f, 0.f, 0.f, 0.f}, 0, 0, 0);
    }
#pragma unroll
    for (int qt = 0; qt < NQT; ++qt) {
        s0[qt] = __builtin_amdgcn_mfma_f32_16x16x32_bf16(f.k[0][1], qf[qt][1], s0[qt], 0, 0, 0);
        s1[qt] = __builtin_amdgcn_mfma_f32_16x16x32_bf16(f.k[1][1], qf[qt][1], s1[qt], 0, 0, 0);
    }
    float mx[NQT];
#pragma unroll
    for (int qt = 0; qt < NQT; ++qt) {
#pragma unroll
        for (int j = 0; j < 4; ++j) { s0[qt][j] = mb(qt, j, s0[qt][j]); s1[qt][j] = mb(qt, j + 4, s1[qt][j]); }
        mx[qt] = fmaxf(fmaxf(fmaxf(s0[qt][0], s0[qt][1]), fmaxf(s0[qt][2], s0[qt][3])), fmaxf(fmaxf(s1[qt][0], s1[qt][1]), fmaxf(s1[qt][2], s1[qt][3])));
    }
#pragma unroll
    for (int qt = 0; qt < NQT; ++qt) mx[qt] = rowmax4(mx[qt]);
    bool moved = false;
#pragma unroll
    for (int qt = 0; qt < NQT; ++qt) { mx[qt] = fmaxf(m[qt], mx[qt]); moved |= (mx[qt] != m[qt]); }
    if (__ballot(moved) != 0ull) {
#pragma unroll
        for (int qt = 0; qt < NQT; ++qt) {
            const float alpha = __builtin_amdgcn_exp2f(m[qt] - mx[qt]);
            l[qt] *= alpha;
#pragma unroll
            for (int dt = 0; dt < 4; ++dt) o[qt][dt] *= alpha;
        }
    }
    bf16x8 pf[NQT];
#pragma unroll
    for (int qt = 0; qt < NQT; ++qt) {
        m[qt] = mx[qt];
        float pr[8]; float ps = 0.f;
#pragma unroll
        for (int j = 0; j < 4; ++j) {
            pr[j] = __builtin_amdgcn_exp2f(s0[qt][j] - mx[qt]);
            pr[j + 4] = __builtin_amdgcn_exp2f(s1[qt][j] - mx[qt]);
        }
#pragma unroll
        for (int j = 0; j < 8; ++j) ps += pr[j];
        l[qt] += ps;
        const u32x4 pk = {pack2(pr[0], pr[1]), pack2(pr[2], pr[3]), pack2(pr[4], pr[5]), pack2(pr[6], pr[7])};
        pf[qt] = __builtin_bit_cast(bf16x8, pk);
    }
#pragma unroll
    for (int dt = 0; dt < 4; ++dt)
#pragma unroll
        for (int qt = 0; qt < NQT; ++qt) o[qt][dt] = __builtin_amdgcn_mfma_f32_16x16x32_bf16(f.v[dt], pf[qt], o[qt][dt], 0, 0, 0);
    __builtin_amdgcn_sched_barrier(0);
}
struct RangeIt { int c, c_hi; __device__ __forceinline__ int nxt() { if (c > c_hi) return -1; return (c++) * 32; } };
struct MaskIt { unsigned long long cm; __device__ __forceinline__ int nxt() { if (!cm) return -1; const int i = __builtin_ctzll(cm); cm &= cm - 1; return i * 32; } };
template <bool PFV, bool FM, class It, class Gen>
__device__ __forceinline__ void attn_run(It& it, const bf16_t* Kb, size_t ldk, const bf16_t* VTb, size_t ldv, int fr, int fq, const Gen& gen) {
    KVFrag fa, fb;
    int ka = it.nxt(); if (ka < 0) return;
    k_load<FM>(fa, Kb, ldk, ka, fr, fq); if (PFV) v_load<FM>(fa.v, VTb, ldv, ka, fr, fq);
    for (;;) {
        const int kb = it.nxt(); if (kb >= 0) { k_load<FM>(fb, Kb, ldk, kb, fr, fq); if (PFV) v_load<FM>(fb.v, VTb, ldv, kb, fr, fq); }
        if (!PFV) v_load<FM>(fa.v, VTb, ldv, ka, fr, fq);
        gen(ka, fa);
        if (kb < 0) break;
        ka = it.nxt(); if (ka >= 0) { k_load<FM>(fa, Kb, ldk, ka, fr, fq); if (PFV) v_load<FM>(fa.v, VTb, ldv, ka, fr, fq); }
        if (!PFV) v_load<FM>(fb.v, VTb, ldv, kb, fr, fq);
        gen(kb, fb);
        if (ka < 0) break;
    }
}
template <int NQT>
__device__ __forceinline__ void attn_init(f32x4 (&o)[NQT][4], float (&m)[NQT], float (&l)[NQT]) {
#pragma unroll
    for (int qt = 0; qt < NQT; ++qt) { m[qt] = MINIT; l[qt] = 0.f;
#pragma unroll
        for (int dt = 0; dt < 4; ++dt) o[qt][dt] = (f32x4){0.f, 0.f, 0.f, 0.f}; }
}
__device__ __forceinline__ float lsum4(float l) { return rowsum4(l); }
__device__ __forceinline__ void store_o4(unsigned char* dst, const f32x4 v) { *(unsigned*)dst = pack4_fp8(v[0], v[1], v[2], v[3]); }
__device__ __forceinline__ float sigmoidf_fast(float x) { return __builtin_amdgcn_rcpf(1.0f + __builtin_amdgcn_exp2f(-L2E * x)); }

__device__ __forceinline__ void fox_unit(const Params& p, int b, int h, int qb, int fr, int fq) {
    asm volatile("" : "+v"(fr), "+v"(fq));
    const int t0 = qb * 64;
    const bf16_t* Qb = p.hb + ((size_t)b * SEQ + t0) * NMAIN + C_FQ + h * 64 + fq * 8;
    bf16x8 qf[4][2];
#pragma unroll
    for (int qt = 0; qt < 4; ++qt) { qf[qt][0] = *(const bf16x8*)(Qb + (size_t)(qt * 16 + fr) * NMAIN); qf[qt][1] = *(const bf16x8*)(Qb + (size_t)(qt * 16 + fr) * NMAIN + 32); }
    const float* cf = p.cF + ((size_t)b * 4 + h) * SEQ;
    float cq[4];
#pragma unroll
    for (int qt = 0; qt < 4; ++qt) cq[qt] = cf[t0 + qt * 16 + fr] * L2E;
    f32x4 o[4][4]; float m[4], l[4];
    attn_init<4>(o, m, l);
    const bf16_t* Kb = p.kF + ((size_t)b * NVH + h) * 64 * SEQ;
    const bf16_t* VTb = p.vT + ((size_t)b * NVH + h) * 64 * SEQ;
    RangeIt it{0, (t0 >> 5) + 1};
    attn_run<false, true>(it, Kb, NMAIN, VTb, SEQ, fr, fq, [&](int kc0, const KVFrag& f) {
        const float4 ca = *(const float4*)(cf + kc0 + 8 * fq), cb = *(const float4*)(cf + kc0 + 8 * fq + 4);
        const float ck[8] = {ca.x * L2E, ca.y * L2E, ca.z * L2E, ca.w * L2E, cb.x * L2E, cb.y * L2E, cb.z * L2E, cb.w * L2E};
        const int kq = kc0 + 8 * fq - t0 - fr;
        attn_compute<4, true>(f, qf, o, m, l, [&](int qt, int j, float raw) { return (kq + j - 16 * qt) > 0 ? MASKV : raw * SCL2 + cq[qt] - ck[j]; });
    });
#pragma unroll
    for (int qt = 0; qt < 4; ++qt) {
        const float inv = __builtin_amdgcn_rcpf(lsum4(l[qt]));
        unsigned char* dst = (unsigned char*)p.ob + ((size_t)b * SEQ + t0 + qt * 16 + fr) * DM + h * 64 + 4 * fq;
#pragma unroll
        for (int dt = 0; dt < 4; ++dt) store_o4(dst + dt * 16, o[qt][dt] * inv);
    }
}
__device__ __forceinline__ void swa_unit(const Params& p, int l_, int b, int kv, int pos, int fr, int fq) {
    asm volatile("" : "+v"(fr), "+v"(fq));
    const int t0 = pos * 16, t = t0 + fr;
    const bf16_t* Qb = p.hb + ((size_t)b * SEQ + t) * NMAIN + C_SQ + kv * 192 + fq * 8;
    bf16x8 qf[3][2];
#pragma unroll
    for (int g = 0; g < 3; ++g) { qf[g][0] = *(const bf16x8*)(Qb + g * 64); qf[g][1] = *(const bf16x8*)(Qb + g * 64 + 32); }
    float sl[3];
#pragma unroll
    for (int g = 0; g < 3; ++g) sl[g] = slope_swa(kv * 3 + g) * L2E;
    f32x4 o[3][4]; float m[3], l[3];
    attn_init<3>(o, m, l);
    const bf16_t* Kb = p.kF + ((size_t)b * NVH + 4 + kv) * 64 * SEQ;
    const bf16_t* VTb = p.vT + ((size_t)b * NVH + 4 + kv) * 64 * SEQ;
    RangeIt it{max(0, t0 - 127) >> 5, (t0 + 15) >> 5};
    attn_run<true, true>(it, Kb, NMAIN, VTb, SEQ, fr, fq, [&](int kc0, const KVFrag& f) {
        const int dq = t - kc0 - 8 * fq;
        attn_compute<3, true>(f, qf, o, m, l, [&](int g, int j, float raw) { const int dist = dq - j; return ((unsigned)dist < 128u) ? raw * SCL2 - sl[g] * (float)dist : MASKV; });
    });
#pragma unroll
    for (int g = 0; g < 3; ++g) {
        const float sink = p.sinks[l_ * 6 + kv * 3 + g] * L2E;
        const float inv = __builtin_amdgcn_rcpf(lsum4(l[g]) + __builtin_amdgcn_exp2f(sink - m[g]));
        unsigned char* dst = (unsigned char*)p.ob + ((size_t)b * SEQ + t) * DM + 256 + (kv * 3 + g) * 64 + 4 * fq;
#pragma unroll
        for (int dt = 0; dt < 4; ++dt) store_o4(dst + dt * 16, o[g][dt] * inv);
    }
}
__device__ __forceinline__ void nsa_unit(const Params& p, int b, int kv, int pos, int fr, int fq, int lane, float* ps, unsigned* msk, float* otl) {
    asm volatile("" : "+v"(fr), "+v"(fq), "+v"(lane));
    const int t0 = pos * 16, t = t0 + fr, cur = t0 >> 6;
    const bf16_t* Qb = p.hb + ((size_t)b * SEQ + t) * NMAIN + C_NQ + kv * 192 + fq * 8;
    bf16x8 qf[3][2];
#pragma unroll
    for (int g = 0; g < 3; ++g) { qf[g][0] = *(const bf16x8*)(Qb + g * 64); qf[g][1] = *(const bf16x8*)(Qb + g * 64 + 32); }
    float sl[3];
#pragma unroll
    for (int g = 0; g < 3; ++g) sl[g] = slope_nsa(kv * 3 + g) * L2E;
    const float* gl = p.hs + ((size_t)b * SEQ + t) * HS_W + 4 + kv * 9;
    f32x4 o[3][4]; float m[3], l[3];
    f32x4* otv = (f32x4*)otl + lane;
#pragma unroll
    for (int i = 0; i < 8; ++i) ps[lane + 64 * i] = 0.f;
    {
        const bf16_t* Kb = p.kc + ((size_t)b * 2 + kv) * 128 * 64;
        const bf16_t* VTb = p.vcT + ((size_t)b * 2 + kv) * 64 * 128;
        const int ncv = (t0 + 15 >= 31) ? ((t0 + 15 - 31) >> 4) + 1 : 0;
        const int nch = (ncv + 31) >> 5;
        attn_init<3>(o, m, l);
        const int dq0 = t - 31 - 16 * 8 * fq;
        RangeIt it{0, nch - 1};
        attn_run<false, false>(it, Kb, 64, VTb, 128, fr, fq, [&](int kc0, const KVFrag& f) {
            const int dq = dq0 - 16 * kc0;
            attn_compute<3, true>(f, qf, o, m, l, [&](int g, int j, float raw) { const int dist = dq - 16 * j; return dist >= 0 ? raw * SCL2 - sl[g] * (float)dist : MASKV; });
        });
        float il[3];
#pragma unroll
        for (int g = 0; g < 3; ++g) {
            const float lt = lsum4(l[g]); il[g] = lt > 0.f ? __builtin_amdgcn_rcpf(lt) : 0.f;
            const float gate = sigmoidf_fast(gl[g * 3 + 0]);
#pragma unroll
            for (int dt = 0; dt < 4; ++dt) otv[(g * 4 + dt) * 64] = o[g][dt] * (il[g] * gate);
        }
        float carry_prev = 0.f;
        for (int c = 0; c < nch; ++c) {
            const int kc0 = c * 32, dq = dq0 - 16 * kc0;
            const bf16_t* kp = Kb + (size_t)(kc0 + (fr >> 2) * 8 + (fr & 3)) * 64 + fq * 8;
            const bf16x8 k00 = *(const bf16x8*)(kp), k01 = *(const bf16x8*)(kp + 32), k10 = *(const bf16x8*)(kp + 256), k11 = *(const bf16x8*)(kp + 256 + 32);
            float pc[8];
#pragma unroll
            for (int j = 0; j < 8; ++j) pc[j] = 0.f;
#pragma unroll
            for (int g = 0; g < 3; ++g) {
                f32x4 s0 = (f32x4){0.f, 0.f, 0.f, 0.f}, s1 = s0;
                s0 = __builtin_amdgcn_mfma_f32_16x16x32_bf16(k00, qf[g][0], s0, 0, 0, 0); s0 = __builtin_amdgcn_mfma_f32_16x16x32_bf16(k01, qf[g][1], s0, 0, 0, 0);
                s1 = __builtin_amdgcn_mfma_f32_16x16x32_bf16(k10, qf[g][0], s1, 0, 0, 0); s1 = __builtin_amdgcn_mfma_f32_16x16x32_bf16(k11, qf[g][1], s1, 0, 0, 0);
#pragma unroll
                for (int j = 0; j < 8; ++j) {
                    const int dist = dq - 16 * j; const float raw = j < 4 ? s0[j] : s1[j - 4];
                    if (dist >= 0) pc[j] += __builtin_amdgcn_exp2f(raw * SCL2 - sl[g] * (float)dist - m[g]) * il[g];
                }
            }
            const float cout = 0.5f * pc[7];
            float cin = shfl_f(cout, lane - 16);
            const float cwrap = shfl_f(cout, fr + 48);
            if (fq == 0) cin = carry_prev;
            carry_prev = cwrap;
            const int n0 = (kc0 >> 2) + 2 * fq;
            ps[fr * 32 + n0] = cin + pc[0] + pc[1] + pc[2] + 0.5f * pc[3];
            ps[fr * 32 + n0 + 1] = 0.5f * pc[3] + pc[4] + pc[5] + pc[6] + 0.5f * pc[7];
        }
    }
    lds_wave_sync();
    if (lane < 16) {
        unsigned mask = 1u | (1u << cur); if (cur >= 1) mask |= 1u << (cur - 1);
        if (cur >= 3) {
            if (cur - 2 <= 5) mask |= (1u << (cur - 1)) - 2u;
            else {
                const float* my = ps + lane * 32;
                for (int r = 0; r < 5; ++r) {
                    float best = -1.0f; int bi = 1;
                    for (int j = 1; j <= cur - 2; ++j) { const float v = my[j]; if (!((mask >> j) & 1u) && v > best) { best = v; bi = j; } }
                    mask |= 1u << bi;
                }
            }
        }
        msk[lane] = mask;
    }
    lds_wave_sync();
    const unsigned qmask = msk[fr];
    lds_wave_sync();
    {
        const bf16_t* Kb = p.kF + ((size_t)b * NVH + 6 + kv) * 64 * SEQ;
        const bf16_t* VTb = p.vT + ((size_t)b * NVH + 6 + kv) * 64 * SEQ;
        attn_init<3>(o, m, l);
        unsigned um = qmask;
        um |= shfl_u(um, lane ^ 1); um |= shfl_u(um, lane ^ 2); um |= shfl_u(um, lane ^ 4); um |= shfl_u(um, lane ^ 8);
        um = (unsigned)__builtin_amdgcn_readfirstlane((int)um) & (cur >= 31 ? 0xffffffffu : ((2u << cur) - 1u));
        unsigned long long cm = 0ull;
        for (unsigned r = um; r; r &= r - 1) { const int kb = __builtin_ctz(r); cm |= 3ull << (2 * kb); }
        MaskIt it{cm};
        attn_run<false, true>(it, Kb, NMAIN, VTb, SEQ, fr, fq, [&](int kc0, const KVFrag& f) {
            const bool mine = (qmask >> (kc0 >> 6)) & 1u;
            const int dq = t - kc0 - 8 * fq;
            attn_compute<3, true>(f, qf, o, m, l, [&](int g, int j, float raw) { const int dist = dq - j; return (mine && dist >= 0) ? raw * SCL2 - sl[g] * (float)dist : MASKV; });
        });
#pragma unroll
        for (int g = 0; g < 3; ++g) {
            const float lt = lsum4(l[g]); const float sc = (lt > 0.f ? __builtin_amdgcn_rcpf(lt) : 0.f) * sigmoidf_fast(gl[g * 3 + 1]);
#pragma unroll
            for (int dt = 0; dt < 4; ++dt) otv[(g * 4 + dt) * 64] += o[g][dt] * sc;
        }
    }
    {
        const bf16_t* Kb = p.kF + ((size_t)b * NVH + 8 + kv) * 64 * SEQ;
        const bf16_t* VTb = p.vT + ((size_t)b * NVH + 8 + kv) * 64 * SEQ;
        attn_init<3>(o, m, l);
        RangeIt it{max(0, t0 - 511) >> 5, (t0 + 15) >> 5};
        attn_run<false, true>(it, Kb, NMAIN, VTb, SEQ, fr, fq, [&](int kc0, const KVFrag& f) {
            const int dq = t - kc0 - 8 * fq;
            attn_compute<3, true>(f, qf, o, m, l, [&](int g, int j, float raw) { const int dist = dq - j; return ((unsigned)dist < 512u) ? raw * SCL2 - sl[g] * (float)dist : MASKV; });
        });
#pragma unroll
        for (int g = 0; g < 3; ++g) {
            const float lt = lsum4(l[g]); const float sc = (lt > 0.f ? __builtin_amdgcn_rcpf(lt) : 0.f) * sigmoidf_fast(gl[g * 3 + 2]);
            unsigned char* dst = (unsigned char*)p.ob + ((size_t)b * SEQ + t) * DM + 640 + (kv * 3 + g) * 64 + 4 * fq;
#pragma unroll
            for (int dt = 0; dt < 4; ++dt) store_o4(dst + dt * 16, otv[(g * 4 + dt) * 64] + o[g][dt] * sc);
        }
    }
}

template <bool WITH_CONV>
__device__ __forceinline__ void phase_attn(const Params& p, int l, char* lds, int cslot = 16) {
    int tid = threadIdx.x; asm volatile("" : "+v"(tid));
    const int wid = tid >> 6, lane = tid & 63, fr = lane & 15, fq = lane >> 4;
    float* ps = (float*)(lds + wid * 16896); unsigned* msk = (unsigned*)(ps + 512); float* otl = ps + 576;
    unsigned* ctr = p.ctrl + cslot + l;
    constexpr unsigned NU_NSA = NB * 2 * 128, NU_FOX = NB * 4 * 32, NU_SWA = NB * 2 * 128, NU_ATT = NU_NSA + NU_FOX + NU_SWA;
    for (;;) {
        unsigned u = 0;
        if (lane == 0) u = __hip_atomic_fetch_add(ctr, 1u, __ATOMIC_RELAXED, __HIP_MEMORY_SCOPE_AGENT);
        u = (unsigned)__builtin_amdgcn_readfirstlane((int)u);
        if (WITH_CONV) {
            constexpr unsigned TOTQ = NU_ATT + (unsigned)CONV_TILES;
            if (u >= TOTQ) break;
            const unsigned a0 = (unsigned)(((unsigned long long)u * NU_ATT) / TOTQ), a1 = (unsigned)(((unsigned long long)(u + 1) * NU_ATT) / TOTQ);
            if (a1 == a0) { conv_tile_wave(p, (int)(u - a0), lane, (unsigned char*)ps); continue; }
            u = a0;
        } else {
#ifndef ATT_REP
#define ATT_REP 1
#endif
            if (u >= ATT_REP * NU_ATT) break;
            if (ATT_REP > 1) u %= NU_ATT;
        }
        if (u < NU_NSA) { const int pos = 127 - (int)(u & 127), r = u >> 7; nsa_unit(p, r >> 1, r & 1, pos, fr, fq, lane, ps, msk, otl); }
        else if (u < NU_NSA + NU_FOX) { const unsigned v = u - NU_NSA; const int qb = 31 - (int)(v & 31), r = v >> 5; fox_unit(p, r >> 2, r & 3, qb, fr, fq); }
        else { const unsigned v = u - NU_NSA - NU_FOX; const int pos = 127 - (int)(v & 127), r = v >> 7; swa_unit(p, l, r >> 1, r & 1, pos, fr, fq); }
    }
}

__device__ __forceinline__ void phase_ln1_router(const Params& p, int l, char* lds) {
    int tid = threadIdx.x; asm volatile("" : "+v"(tid));
    const int wid = tid >> 6, lane = tid & 63, fr = lane & 15, fq = lane >> 4;
    float* lg = (float*)lds + wid * 512;
    int* lcnt = (int*)(lds + 16384); int* lbase = lcnt + 32;
    const float* g1 = p.ln1_g + l * DM; const float* b1 = p.ln1_b + l * DM;
    const float* rw = p.rwT + (size_t)l * NE * 1024; const float* rb = p.router_b + l * NE;
    unsigned* gcount = p.ctrl + 64 + l * NE;
    for (int grp = blockIdx.x; grp < NTOK / 128; grp += gridDim.x) {
        const int tok0 = grp * 128 + wid * 16;
        if (tid < 32) lcnt[tid] = 0;
        float4 gg[4], bb[4];
#pragma unroll
        for (int j = 0; j < 4; ++j) { gg[j] = *(const float4*)(g1 + j * 256 + lane * 4); bb[j] = *(const float4*)(b1 + j * 256 + lane * 4); }
        for (int r0 = 0; r0 < 16; r0 += 4) {
            float4 v[4][4]; float s[4], qv[4];
#pragma unroll
            for (int i = 0; i < 4; ++i)
#pragma unroll
                for (int j = 0; j < 4; ++j) v[i][j] = *(const float4*)(p.tbuf + (size_t)(tok0 + r0 + i) * DM + j * 256 + lane * 4);
#pragma unroll
            for (int i = 0; i < 4; ++i) { s[i] = 0.f;
#pragma unroll
                for (int j = 0; j < 4; ++j) s[i] += (v[i][j].x + v[i][j].y) + (v[i][j].z + v[i][j].w); }
#pragma unroll
            for (int o = 32; o > 0; o >>= 1) {
#pragma unroll
                for (int i = 0; i < 4; ++i) s[i] += shfl_f(s[i], lane ^ o); }
#pragma unroll
            for (int i = 0; i < 4; ++i) { const float mean = s[i] * (1.0f / 1024.0f); qv[i] = 0.f;
#pragma unroll
                for (int j = 0; j < 4; ++j) { v[i][j].x -= mean; v[i][j].y -= mean; v[i][j].z -= mean; v[i][j].w -= mean; qv[i] += (v[i][j].x * v[i][j].x + v[i][j].y * v[i][j].y) + (v[i][j].z * v[i][j].z + v[i][j].w * v[i][j].w); } }
#pragma unroll
            for (int o = 32; o > 0; o >>= 1) {
#pragma unroll
                for (int i = 0; i < 4; ++i) qv[i] += shfl_f(qv[i], lane ^ o); }
#pragma unroll
            for (int i = 0; i < 4; ++i) {
                const float rstd = rsqrtf(qv[i] * (1.0f / 1024.0f) + LN_EPS);
                const size_t row = (size_t)(tok0 + r0 + i);
#pragma unroll
                for (int j = 0; j < 4; ++j) {
                    const int c = j * 256 + lane * 4;
                    float4 y; y.x = v[i][j].x * rstd * gg[j].x + bb[j].x; y.y = v[i][j].y * rstd * gg[j].y + bb[j].y; y.z = v[i][j].z * rstd * gg[j].z + bb[j].z; y.w = v[i][j].w * rstd * gg[j].w + bb[j].w;
                    *(float4*)(p.x1f + row * DM + c) = y;
                    *(unsigned*)((char*)p.x1b + row * DM + c) = pack4_fp8(y.x, y.y, y.z, y.w);
                }
            }
        }
        __syncthreads();
        f32x4 a0 = (f32x4){0.f, 0.f, 0.f, 0.f}, a1 = a0;
        const float* xr = p.x1f + (size_t)(tok0 + fr) * DM + 4 * fq;
        const float* w0 = rw + (size_t)fr * 1024 + 4 * fq; const float* w1 = rw + (size_t)(16 + fr) * 1024 + 4 * fq;
#pragma unroll 4
        for (int k0 = 0; k0 < 1024; k0 += 16) {
            const float4 xa = *(const float4*)(xr + k0), wb0 = *(const float4*)(w0 + k0), wb1 = *(const float4*)(w1 + k0);
            a0 = __builtin_amdgcn_mfma_f32_16x16x4f32(xa.x, wb0.x, a0, 0, 0, 0); a1 = __builtin_amdgcn_mfma_f32_16x16x4f32(xa.x, wb1.x, a1, 0, 0, 0);
            a0 = __builtin_amdgcn_mfma_f32_16x16x4f32(xa.y, wb0.y, a0, 0, 0, 0); a1 = __builtin_amdgcn_mfma_f32_16x16x4f32(xa.y, wb1.y, a1, 0, 0, 0);
            a0 = __builtin_amdgcn_mfma_f32_16x16x4f32(xa.z, wb0.z, a0, 0, 0, 0); a1 = __builtin_amdgcn_mfma_f32_16x16x4f32(xa.z, wb1.z, a1, 0, 0, 0);
            a0 = __builtin_amdgcn_mfma_f32_16x16x4f32(xa.w, wb0.w, a0, 0, 0, 0); a1 = __builtin_amdgcn_mfma_f32_16x16x4f32(xa.w, wb1.w, a1, 0, 0, 0);
        }
#pragma unroll
        for (int r = 0; r < 4; ++r) { lg[(fq * 4 + r) * 32 + fr] = a0[r] + rb[fr]; lg[(fq * 4 + r) * 32 + 16 + fr] = a1[r] + rb[16 + fr]; }
        lds_wave_sync();
        int e4[4] = {0, 0, 0, 0}; int rk[4] = {0, 0, 0, 0};
        if (lane < 16) {
            const float* my = lg + lane * 32; unsigned taken = 0u; float tv[4];
#pragma unroll
            for (int k = 0; k < 4; ++k) {
                float best = NEG_INF; int bi = 0;
                for (int e = 0; e < 32; ++e) { const float xv = my[e]; if (!((taken >> e) & 1u) && xv > best) { best = xv; bi = e; } }
                taken |= 1u << bi; e4[k] = bi; tv[k] = best;
            }
            const float e1 = __expf(tv[1] - tv[0]), e2 = __expf(tv[2] - tv[0]), e3 = __expf(tv[3] - tv[0]);
            const float inv = 1.0f / (1.0f + e1 + e2 + e3);
            const size_t row = (size_t)(tok0 + lane);
            *(float4*)(p.gw + row * 4) = make_float4(inv, e1 * inv, e2 * inv, e3 * inv);
        }
        __syncthreads();
        if (lane < 16) {
#pragma unroll
            for (int k = 0; k < 4; ++k) rk[k] = atomicAdd(&lcnt[e4[k]], 1);
        }
        __syncthreads();
        if (tid < 32) { const int c = lcnt[tid]; lbase[tid] = c ? (int)__hip_atomic_fetch_add(gcount + tid, (unsigned)c, __ATOMIC_RELAXED, __HIP_MEMORY_SCOPE_AGENT) : 0; }
        __syncthreads();
        if (lane < 16) {
            const int row = tok0 + lane; int pk[4];
#pragma unroll
            for (int k = 0; k < 4; ++k) { const int pos = lbase[e4[k]] + rk[k]; p.lists[(size_t)e4[k] * LIST_CAP + pos] = row * 4 + k; pk[k] = (pos << 5) | e4[k]; }
            *(int4*)(p.top_e + (size_t)row * 4) = make_int4(pk[0], pk[1], pk[2], pk[3]);
        }
        __syncthreads();
    }
}

__device__ __forceinline__ void phase_ln2(const Params& p, int l, float* xout, char* lds) {
    int* ptile = (int*)(lds + LDS_TAB); int* ecnt = ptile + 40;
    build_tiles(p, l, ptile, ecnt);
    int tid = threadIdx.x; asm volatile("" : "+v"(tid));
    const int wid = tid >> 6, lane = tid & 63;
    const float* g2 = p.ln2_g + l * DM; const float* b2 = p.ln2_b + l * DM;
    float4 gg[4], bb[4];
#pragma unroll
    for (int j = 0; j < 4; ++j) { gg[j] = *(const float4*)(g2 + j * 256 + lane * 4); bb[j] = *(const float4*)(b2 + j * 256 + lane * 4); }
    for (int pr = blockIdx.x * NWV + wid; pr < NTOK / 2; pr += gridDim.x * NWV) {
        float4 v[2][4]; float s[2], qv[2];
        u32x2 yv[2][4][4]; float gk[2][4];
#pragma unroll
        for (int i = 0; i < 2; ++i) {
            const int row = pr * 2 + i;
            const float4 gwv = *(const float4*)(p.gw + (size_t)row * 4);
            gk[i][0] = gwv.x; gk[i][1] = gwv.y; gk[i][2] = gwv.z; gk[i][3] = gwv.w;
            const int4 te = *(const int4*)(p.top_e + (size_t)row * 4);
            const int tk[4] = {te.x, te.y, te.z, te.w};
#pragma unroll
            for (int j = 0; j < 4; ++j) v[i][j] = *(const float4*)(p.x1f + (size_t)row * DM + j * 256 + lane * 4);
#pragma unroll
            for (int k = 0; k < 4; ++k) {
                const bf16_t* yr = p.ybuf + (size_t)(ptile[tk[k] & 31] * 256 + (tk[k] >> 5)) * DM + lane * 4;
#pragma unroll
                for (int j = 0; j < 4; ++j) yv[i][k][j] = *(const u32x2*)(yr + j * 256);
            }
        }
#pragma unroll
        for (int i = 0; i < 2; ++i) { s[i] = 0.f;
#pragma unroll
            for (int j = 0; j < 4; ++j) {
                float4 a; a.x = v[i][j].x * ALPHA; a.y = v[i][j].y * ALPHA; a.z = v[i][j].z * ALPHA; a.w = v[i][j].w * ALPHA;
#pragma unroll
                for (int k = 0; k < 4; ++k) {
                    const u32x2 w = yv[i][k][j];
                    a.x += gk[i][k] * __uint_as_float(w.x << 16); a.y += gk[i][k] * __uint_as_float(w.x & 0xffff0000u);
                    a.z += gk[i][k] * __uint_as_float(w.y << 16); a.w += gk[i][k] * __uint_as_float(w.y & 0xffff0000u);
                }
                v[i][j] = a; s[i] += (a.x + a.y) + (a.z + a.w);
            } }
#pragma unroll
        for (int o = 32; o > 0; o >>= 1) { s[0] += shfl_f(s[0], lane ^ o); s[1] += shfl_f(s[1], lane ^ o); }
#pragma unroll
        for (int i = 0; i < 2; ++i) { const float mean = s[i] * (1.0f / 1024.0f); qv[i] = 0.f;
#pragma unroll
            for (int j = 0; j < 4; ++j) { v[i][j].x -= mean; v[i][j].y -= mean; v[i][j].z -= mean; v[i][j].w -= mean; qv[i] += (v[i][j].x * v[i][j].x + v[i][j].y * v[i][j].y) + (v[i][j].z * v[i][j].z + v[i][j].w * v[i][j].w); } }
#pragma unroll
        for (int o = 32; o > 0; o >>= 1) { qv[0] += shfl_f(qv[0], lane ^ o); qv[1] += shfl_f(qv[1], lane ^ o); }
#pragma unroll
        for (int i = 0; i < 2; ++i) {
            const float rstd = rsqrtf(qv[i] * (1.0f / 1024.0f) + LN_EPS);
            const size_t row = (size_t)(pr * 2 + i);
#pragma unroll
            for (int j = 0; j < 4; ++j) {
                const int c = j * 256 + lane * 4;
                float4 y; y.x = v[i][j].x * rstd * gg[j].x + bb[j].x; y.y = v[i][j].y * rstd * gg[j].y + bb[j].y; y.z = v[i][j].z * rstd * gg[j].z + bb[j].z; y.w = v[i][j].w * rstd * gg[j].w + bb[j].w;
                *(float4*)(xout + row * DM + c) = y;
                u32x2 w; w.x = pack2(y.x, y.y); w.y = pack2(y.z, y.w);
                *(u32x2*)(p.xb + row * DM + c) = w;
            }
        }
    }
}

#define XB_TMO      128
#define XB_XCNT(j)  (256  + 64 * (j))
#define XB_XSUB(j)  (1280 + 64 * (j))
#define XB_XGEN(j)  (2304 + 64 * (j))
#define XB_TOP      3328
#define XB_TOPGEN   3392
#define XCD_BAR_WORDS 3456
#define XB_SPIN_CAP (1u << 22)
__device__ __forceinline__ unsigned xb_ld(unsigned* p)              { return __hip_atomic_load(p, __ATOMIC_RELAXED, __HIP_MEMORY_SCOPE_AGENT); }
__device__ __forceinline__ unsigned xb_add(unsigned* p, unsigned v) { return __hip_atomic_fetch_add(p, v, __ATOMIC_RELAXED, __HIP_MEMORY_SCOPE_AGENT); }
__device__ __forceinline__ unsigned xb_xcc_id() { return (unsigned)__builtin_amdgcn_s_getreg((3 << 11) | 20) & 0xFu; }
#define XB_SPIN(cond, bar) do { unsigned _sp = 0; while (cond) { __builtin_amdgcn_s_sleep(1); \
    if ((++_sp & 255u) == 0u) { if (xb_ld(&(bar)[XB_TMO])) break; if (_sp > XB_SPIN_CAP) { atomicAdd(&(bar)[XB_TMO], 1u); break; } } } } while (0)
struct XcdBarrier { unsigned* bar; unsigned x; volatile LAS unsigned* st; };
__device__ __forceinline__ XcdBarrier xcd_barrier_post(unsigned* bar, volatile LAS unsigned* st) {
    XcdBarrier b; b.bar = bar; b.x = xb_xcc_id(); b.st = st;
    if (threadIdx.x == 0) (void)xb_add(&bar[XB_XCNT(b.x)], 1u);
    return b;
}
__device__ __forceinline__ void xcd_barrier_complete(unsigned* bar, unsigned x, unsigned& nloc, unsigned& nx) {
    const unsigned G = gridDim.x * gridDim.y * gridDim.z;
    unsigned sum, cnt, mine, sp = 0u;
    for (;;) {
        sum = 0u; cnt = 0u; mine = 0u;
#pragma unroll
        for (unsigned j = 0; j < 16; ++j) { const unsigned c = xb_ld(&bar[XB_XCNT(j)]); sum += c; cnt += (c > 0u) ? 1u : 0u; mine = (j == x) ? c : mine; }
        if (sum == G) break;
        __builtin_amdgcn_s_sleep(1);
        if ((++sp & 255u) == 0u) { if (xb_ld(&bar[XB_TMO])) break; if (sp > XB_SPIN_CAP) { atomicAdd(&bar[XB_TMO], 1u); break; } }
    }
    nloc = mine > 0u ? mine : 1u; nx = cnt > 0u ? cnt : 1u;
}
__device__ __forceinline__ void xcd_barrier(const XcdBarrier& b) {
    asm volatile("s_waitcnt vmcnt(0)" ::: "memory");
    __syncthreads();
    if (threadIdx.x == 0) {
        unsigned* bar = b.bar;
        __builtin_amdgcn_s_waitcnt(0);
        unsigned nloc = b.st[0], nx = b.st[1];
        if (nloc == 0u) { xcd_barrier_complete(bar, b.x, nloc, nx); b.st[0] = nloc; b.st[1] = nx; }
        const unsigned old = xb_add(&bar[XB_XSUB(b.x)], 1u);
        const unsigned gen = old / nloc;
        if (old + 1u == (gen + 1u) * nloc) {
            __builtin_amdgcn_fence(__ATOMIC_RELEASE, "agent");
            asm volatile("s_waitcnt vmcnt(0)" ::: "memory");
            const unsigned og = xb_add(&bar[XB_TOP], 1u);
            const unsigned tg = og / nx;
            if (og + 1u == (tg + 1u) * nx) xb_add(&bar[XB_TOPGEN], 1u);
            else XB_SPIN(xb_ld(&bar[XB_TOPGEN]) == tg, bar);
            __builtin_amdgcn_fence(__ATOMIC_ACQUIRE, "agent");
            xb_add(&bar[XB_XGEN(b.x)], 1u);
            asm volatile("s_waitcnt vmcnt(0)" ::: "memory");
        } else {
            XB_SPIN(xb_ld(&bar[XB_XGEN(b.x)]) == gen, bar);
            __builtin_amdgcn_fence(__ATOMIC_ACQUIRE, "agent");
            asm volatile("s_waitcnt vmcnt(0)" ::: "memory");
        }
    }
    __syncthreads();
}

struct KArgs { const float* in[18]; float* out; char* ws; };
constexpr size_t al256(size_t v) { return (v + 255) / 256 * 256; }
struct WSL {
    static constexpr size_t ctrl = 0;
    static constexpr size_t WinT = al256(ctrl + 65536);
    static constexpr size_t WoT = al256(WinT + (size_t)NL * NPAD * 1024 * 2);
    static constexpr size_t W1T = al256(WoT + (size_t)NL * 1024 * 1024 * 2);
    static constexpr size_t W2T = al256(W1T + (size_t)NL * 2 * 64 * 2048 * 2);
    static constexpr size_t WguT = al256(W2T + (size_t)NL * 2 * 64 * 64 * 2);
    static constexpr size_t WdnT = al256(WguT + (size_t)NL * NE * 2048 * 1024 * 2);
    static constexpr size_t rwT = al256(WdnT + (size_t)NL * NE * 1024 * 1024 * 2);
    static constexpr size_t binp = al256(rwT + (size_t)NL * NE * 1024 * 4);
    static constexpr size_t bgup = al256(binp + (size_t)NL * NPAD * 4);
    static constexpr size_t b1c = al256(bgup + (size_t)NL * NE * 2048 * 4);
    static constexpr size_t xf = al256(b1c + 4 * 64 * 4);
    static constexpr size_t xb = al256(xf + (size_t)NTOK * DM * 4);
    static constexpr size_t hb = al256(xb + (size_t)NTOK * DM * 2);
    static constexpr size_t hs = al256(hb + (size_t)NTOK * NMAIN * 2);
    static constexpr size_t vT = al256(hs + (size_t)NTOK * HS_W * 4);
    static constexpr size_t kF = al256(vT + (size_t)NB * NVH * 64 * SEQ * 2);
    static constexpr size_t cF = al256(kF + (size_t)NB * NVH * 64 * SEQ * 2);
    static constexpr size_t kc = al256(cF + (size_t)NB * 4 * SEQ * 4);
    static constexpr size_t vc = al256(kc + (size_t)NB * 2 * 128 * 64 * 2);
    static constexpr size_t vcT = al256(vc + (size_t)NB * 2 * 128 * 64 * 2);
    static constexpr size_t ob = al256(vcT + (size_t)NB * 2 * 128 * 64 * 2);
    static constexpr size_t tbuf = al256(ob + (size_t)NTOK * DM * 2);
    static constexpr size_t x1f = al256(tbuf + (size_t)NTOK * DM * 4);
    static constexpr size_t x1b = al256(x1f + (size_t)NTOK * DM * 4);
    static constexpr size_t top_e = al256(x1b + (size_t)NTOK * DM * 2);
    static constexpr size_t gw = al256(top_e + (size_t)NTOK * 4 * 4);
    static constexpr size_t lists = al256(gw + (size_t)NTOK * 4 * 4);
    static constexpr size_t act = al256(lists + (size_t)NE * LIST_CAP * 4);
    static constexpr size_t ybuf = al256(act + (size_t)MAXSLOT * DFF * 2);
    static constexpr size_t total = al256(ybuf + (size_t)MAXSLOT * DM * 2);
};
__device__ __forceinline__ Params make_params(const KArgs& k) {
    Params p;
    p.x = k.in[0]; p.w_in = k.in[1]; p.b_in = k.in[2]; p.sinks = k.in[3]; p.cmp_pe = k.in[4]; p.cmp_w1 = k.in[5]; p.cmp_w2 = k.in[6]; p.w_out = k.in[7];
    p.ln1_g = k.in[8]; p.ln1_b = k.in[9]; p.router_w = k.in[10]; p.router_b = k.in[11]; p.w_gu = k.in[12]; p.b_gu = k.in[13]; p.w_dn = k.in[14]; p.b_dn = k.in[15];
    p.ln2_g = k.in[16]; p.ln2_b = k.in[17]; p.out = k.out;
    char* w = k.ws;
    p.ctrl = (unsigned*)(w + WSL::ctrl); p.WinT = (bf16_t*)(w + WSL::WinT); p.WoT = (bf16_t*)(w + WSL::WoT); p.W1T = (bf16_t*)(w + WSL::W1T); p.W2T = (bf16_t*)(w + WSL::W2T);
    p.WguT = (bf16_t*)(w + WSL::WguT); p.WdnT = (bf16_t*)(w + WSL::WdnT); p.rwT = (float*)(w + WSL::rwT); p.binp = (float*)(w + WSL::binp); p.bgup = (float*)(w + WSL::bgup);
    p.b1c = (float*)(w + WSL::b1c); p.xf = (float*)(w + WSL::xf); p.xb = (bf16_t*)(w + WSL::xb); p.hb = (bf16_t*)(w + WSL::hb); p.hs = (float*)(w + WSL::hs); p.vT = (bf16_t*)(w + WSL::vT); p.kF = (bf16_t*)(w + WSL::kF);
    p.cF = (float*)(w + WSL::cF); p.kc = (bf16_t*)(w + WSL::kc); p.vc = (bf16_t*)(w + WSL::vc); p.vcT = (bf16_t*)(w + WSL::vcT); p.ob = (bf16_t*)(w + WSL::ob); p.tbuf = (float*)(w + WSL::tbuf);
    p.x1f = (float*)(w + WSL::x1f); p.x1b = (bf16_t*)(w + WSL::x1b); p.top_e = (int*)(w + WSL::top_e); p.gw = (float*)(w + WSL::gw); p.lists = (int*)(w + WSL::lists);
    p.act = (bf16_t*)(w + WSL::act); p.ybuf = (bf16_t*)(w + WSL::ybuf);
    return p;
}
__device__ __forceinline__ void grid_bar(const Params& p, char* lds) {
    XcdBarrier xb; xb.bar = p.ctrl + 1024; xb.x = xb_xcc_id(); xb.st = (volatile LAS unsigned*)(lds + LDS_BYTES - 16); xcd_barrier(xb);
}
__device__ __forceinline__ Params fresh_params(const KArgs& ka) {
    KArgs k2 = ka; asm volatile("" : "+s"(k2.ws));
    return make_params(k2);
}
#ifndef REP
#define REP 0
#endif
template <int L>
__device__ __forceinline__ void layer_fwd(const KArgs& ka, char* lds) {
    { const Params p = fresh_params(ka); phase_inproj(p, L, lds);        grid_bar(p, lds); }
    { const Params p = fresh_params(ka); phase_prep(p, L, lds);          grid_bar(p, lds); }
    { const Params p = fresh_params(ka); phase_attn<L == 0>(p, L, lds);  grid_bar(p, lds); }
    { const Params p = fresh_params(ka); phase_outproj(p, L, L == 0 ? p.x : p.xf, lds);  grid_bar(p, lds); }
    { const Params p = fresh_params(ka); phase_ln1_router(p, L, lds);    grid_bar(p, lds); }
    { const Params p = fresh_params(ka); phase_gateup(p, L, lds);        grid_bar(p, lds); }
    { const Params p = fresh_params(ka); phase_down(p, L, lds);          grid_bar(p, lds); }
    { const Params p = fresh_params(ka); phase_ln2(p, L, L == NL - 1 ? p.out : p.xf, lds); }
}
__global__ void __launch_bounds__(NTHR, 2) fwd_kernel(KArgs ka) {
    extern __shared__ __attribute__((aligned(16))) char lds[];
    const Params p = make_params(ka);
    cg::grid_group grid = cg::this_grid();
    volatile LAS unsigned* xst = (volatile LAS unsigned*)(lds + LDS_BYTES - 16);
    if (threadIdx.x == 0) { xst[0] = 0u; xst[1] = 0u; }
    __syncthreads();
    (void)xcd_barrier_post(p.ctrl + 1024, xst);
    phase0(p, lds);
    if (REP & 128) { grid_bar(p, lds); phase0(p, lds); }
    grid.sync();
    layer_fwd<0>(ka, lds);
    grid_bar(p, lds);
    layer_fwd<1>(ka, lds);
}

extern "C" void kernel_launch(void* const* d_in, const int* in_sizes, int n_in, void* d_out, int out_size, void* d_ws, size_t ws_size, hipStream_t stream) {
    KArgs ka{};
    for (int i = 0; i < 18; ++i) ka.in[i] = (const float*)d_in[i];
    ka.out = (float*)d_out; ka.ws = (char*)d_ws;
    if (WSL::total > ws_size) { fprintf(stderr, "workspace too small: need %zu have %zu\n", (size_t)WSL::total, ws_size); return; }
    static int grid_blocks = 0;
    if (!grid_blocks) {
        int dev = 0, cus = 0, per_cu = 0;
        (void)hipGetDevice(&dev);
        (void)hipDeviceGetAttribute(&cus, hipDeviceAttributeMultiprocessorCount, dev);
        (void)hipFuncSetAttribute((const void*)fwd_kernel, hipFuncAttributeMaxDynamicSharedMemorySize, LDS_BYTES);
        (void)hipOccupancyMaxActiveBlocksPerMultiprocessor(&per_cu, fwd_kernel, NTHR, LDS_BYTES);
        if (per_cu < 1) { fprintf(stderr, "occupancy query says 0 blocks per CU\n"); per_cu = 1; }
        grid_blocks = cus;
    }
    (void)hipMemsetAsync(d_ws, 0, 65536, stream);
    void* args[] = {&ka};
    hipError_t e = hipLaunchCooperativeKernel((const void*)fwd_kernel, dim3(grid_blocks), dim3(NTHR), args, LDS_BYTES, stream);
    if (e != hipSuccess) fprintf(stderr, "cooperative launch failed: %s (grid %d)\n", hipGetErrorString(e), grid_blocks);
}
```

```cpp
#include <hip/hip_runtime.h>
#include <hip/hip_cooperative_groups.h>
#include <cstdio>
#include <cstdint>
namespace cg = cooperative_groups;

typedef unsigned short bf16_t;
typedef short bf16x8 __attribute__((ext_vector_type(8)));
typedef float f32x4 __attribute__((ext_vector_type(4)));
typedef unsigned u32x4 __attribute__((ext_vector_type(4)));
typedef unsigned u32x2 __attribute__((ext_vector_type(2)));
typedef int v8i_t __attribute__((ext_vector_type(8)));
typedef int v4i_t __attribute__((ext_vector_type(4)));
#define LAS __attribute__((address_space(3)))
constexpr float NEG_INF = -__builtin_huge_valf();

constexpr int DM = 1024, NB = 16, SEQ = 2048, NTOK = NB * SEQ, NL = 2;
constexpr int NCOL = 2582, NMAIN = 2560, NPAD = 2688, NE = 32, DFF = 1024;
constexpr int C_FQ = 0, C_FK = 256, C_FV = 512, C_SQ = 768, C_SK = 1152, C_SV = 1280, C_NQ = 1408,
              C_NKC = 1792, C_NVC = 1920, C_NKS = 2048, C_NVS = 2176, C_NKW = 2304, C_NVW = 2432;
constexpr int HS_W = 32;
constexpr int NVH = 10;
constexpr int LIST_CAP = NTOK;
constexpr int MAXSLOT = NTOK * 4 + NE * 256;
constexpr float ALPHA = 1.41421356237f, LN_EPS = 1e-5f, QSCALE = 0.125f;
constexpr int NWV = 8, NTHR = NWV * 64;
constexpr int LDS_STAGE = 131072, LDS_TAB = LDS_STAGE, LDS_AOFF = LDS_STAGE + 2048, LDS_BYTES = LDS_AOFF + 20480 + 256;

struct Params {
    const float *x, *w_in, *b_in, *sinks, *cmp_pe, *cmp_w1, *cmp_w2, *w_out, *ln1_g, *ln1_b, *router_w, *router_b,
                *w_gu, *b_gu, *w_dn, *b_dn, *ln2_g, *ln2_b;
    float* out;
    unsigned* ctrl;
    bf16_t *WinT, *WoT, *W1T, *W2T, *WguT, *WdnT;
    float *rwT, *binp, *bgup, *b1c;
    float* xf; bf16_t* xb; bf16_t* hb; float* hs; bf16_t* vT; bf16_t* kF; float* cF;
    bf16_t *kc, *vc, *vcT; bf16_t* ob; float* tbuf; float* x1f; bf16_t* x1b;
    int* top_e; float* gw; int* lists; bf16_t* act; bf16_t* ybuf;
};

__device__ __forceinline__ float bf2f(bf16_t h) { return __uint_as_float(((unsigned)h) << 16); }
typedef __bf16 bf16x2_t __attribute__((ext_vector_type(2)));
__device__ __forceinline__ bf16_t f2bf(float f) { return __builtin_bit_cast(bf16_t, (__bf16)f); }
__device__ __forceinline__ unsigned pack2(float lo, float hi) { bf16x2_t v = {(__bf16)lo, (__bf16)hi}; return __builtin_bit_cast(unsigned, v); }
__device__ __forceinline__ unsigned pack4_fp8(float a, float b, float c, float d) {
    unsigned w = 0u;
    w = __builtin_amdgcn_cvt_pk_fp8_f32(a, b, w, false);
    w = __builtin_amdgcn_cvt_pk_fp8_f32(c, d, w, true);
    return w;
}
__device__ __forceinline__ float shfl_f(float v, int src_lane) { return __int_as_float(__builtin_amdgcn_ds_bpermute(src_lane << 2, __float_as_int(v))); }
__device__ __forceinline__ unsigned shfl_u(unsigned v, int src_lane) { return (unsigned)__builtin_amdgcn_ds_bpermute(src_lane << 2, (int)v); }
__device__ __forceinline__ float wave_sum(float v) {
#pragma unroll
    for (int o = 32; o > 0; o >>= 1) v += __shfl_xor(v, o);
    return v;
}
__device__ __forceinline__ float wave_max(float v) {
#pragma unroll
    for (int o = 32; o > 0; o >>= 1) v = fmaxf(v, __shfl_xor(v, o));
    return v;
}
__device__ __forceinline__ void lds_wave_sync() { asm volatile("s_waitcnt lgkmcnt(0)" ::: "memory"); __builtin_amdgcn_wave_barrier(); }
__device__ __forceinline__ float slope_swa(int hq) { return exp2f(-8.0f * (float)(2 * hq + 1) / 12.0f); }
__device__ __forceinline__ float slope_nsa(int hq) { return exp2f(-8.0f * (float)(2 * hq + 2) / 12.0f); }

__device__ __forceinline__ int perm_row(int perm, int n) {
    if (perm == 1) { if (n < 768) return n; if (n < 772) return 2560 + (n - 768); if (n < 2564) return n - 4; return n; }
    if (perm == 2) { const int f = n >> 1, s = n & 1; return (f >> 7) * 256 + s * 128 + (f & 127); }
    return n;
}
struct ConvJob { const float* src; bf16_t* dst; int K, N, kt, nt, perm; float q8; };
__device__ __forceinline__ bool conv_job(const Params& p, int t, ConvJob& jb) {
    constexpr int T_WIN = NL * 8 * 21, T_WO = NL * 8 * 8;
    if (t < T_WIN) { const int m = t / 168, r = t % 168; jb = ConvJob{p.w_in + (size_t)m * 1024 * NCOL, p.WinT + (size_t)m * NPAD * 1024, 1024, NCOL, r / 21, r % 21, 1, 0.f}; return true; }
    t -= T_WIN;
    if (t < T_WO) { const int m = t / 64, r = t % 64; jb = ConvJob{p.w_out + (size_t)m * 1024 * 1024, (bf16_t*)((char*)p.WoT + (size_t)m * 1024 * 1024), 1024, 1024, r / 8, r % 8, 0, 64.0f}; return true; }
    return false;
}
constexpr int CONV_TILES = NL * NE * 192;
__device__ __forceinline__ void conv_tile_wave(const Params& p, int t, int lane, unsigned char* l8) {
    asm volatile("" : "+v"(lane));
    const int m = t / 192, r = t % 192;
    const float* src; unsigned char* dst; int N, kt, nt, perm;
    if (r < 128) { src = p.w_gu + (size_t)m * 1024 * 2048; dst = (unsigned char*)p.WguT + (size_t)m * 2048 * 1024; N = 2048; kt = r >> 4; nt = r & 15; perm = 2; }
    else { const int q = r - 128; src = p.w_dn + (size_t)m * 1024 * 1024; dst = (unsigned char*)p.WdnT + (size_t)m * 1024 * 1024; N = 1024; kt = q >> 3; nt = q & 7; perm = 0; }
    const float* s = src + (size_t)(kt * 128 + (lane >> 5)) * N + nt * 128 + (lane & 31) * 4;
    unsigned char* lw = l8 + (lane >> 5) * 132 + (lane & 31) * 4;
    float4 va[16], vb[16];
#pragma unroll
    for (int i = 0; i < 16; ++i) va[i] = *(const float4*)(s + (size_t)(2 * i) * N);
#pragma unroll
    for (int i = 0; i < 16; ++i) vb[i] = *(const float4*)(s + (size_t)(32 + 2 * i) * N);
#pragma unroll
    for (int i = 0; i < 16; ++i) *(unsigned*)(lw + (2 * i) * 132) = pack4_fp8(va[i].x * 64.0f, va[i].y * 64.0f, va[i].z * 64.0f, va[i].w * 64.0f);
#pragma unroll
    for (int i = 0; i < 16; ++i) va[i] = *(const float4*)(s + (size_t)(64 + 2 * i) * N);
#pragma unroll
    for (int i = 0; i < 16; ++i) *(unsigned*)(lw + (32 + 2 * i) * 132) = pack4_fp8(vb[i].x * 64.0f, vb[i].y * 64.0f, vb[i].z * 64.0f, vb[i].w * 64.0f);
#pragma unroll
    for (int i = 0; i < 16; ++i) vb[i] = *(const float4*)(s + (size_t)(96 + 2 * i) * N);
#pragma unroll
    for (int i = 0; i < 16; ++i) *(unsigned*)(lw + (64 + 2 * i) * 132) = pack4_fp8(va[i].x * 64.0f, va[i].y * 64.0f, va[i].z * 64.0f, va[i].w * 64.0f);
#pragma unroll
    for (int i = 0; i < 16; ++i) *(unsigned*)(lw + (96 + 2 * i) * 132) = pack4_fp8(vb[i].x * 64.0f, vb[i].y * 64.0f, vb[i].z * 64.0f, vb[i].w * 64.0f);
    lds_wave_sync();
#pragma unroll 4
    for (int i = 0; i < 16; ++i) {
        const int idx = lane + 64 * i, kc = idx & 7, nn = idx >> 3;
        const unsigned char* l = l8 + (kc * 16) * 132 + nn;
        u32x4 w;
        w.x = (unsigned)l[0] | ((unsigned)l[132] << 8) | ((unsigned)l[264] << 16) | ((unsigned)l[396] << 24);
        w.y = (unsigned)l[528] | ((unsigned)l[660] << 8) | ((unsigned)l[792] << 16) | ((unsigned)l[924] << 24);
        w.z = (unsigned)l[1056] | ((unsigned)l[1188] << 8) | ((unsigned)l[1320] << 16) | ((unsigned)l[1452] << 24);
        w.w = (unsigned)l[1584] | ((unsigned)l[1716] << 8) | ((unsigned)l[1848] << 16) | ((unsigned)l[1980] << 24);
        *(u32x4*)(dst + (size_t)perm_row(perm, nt * 128 + nn) * 1024 + kt * 128 + kc * 16) = w;
    }
    lds_wave_sync();
}
__device__ __forceinline__ void conv_load(const ConvJob& jb, int tid, float2 (&v)[16]) {
    const int n = jb.nt * 128 + (tid & 31) * 4;
    const float* s = jb.src + (size_t)(jb.kt * 128 + (tid >> 5)) * jb.N + n;
#pragma unroll
    for (int i = 0; i < 8; ++i) {
        const float* r = s + (size_t)(16 * i) * jb.N;
        v[2 * i] = (n + 1 < jb.N) ? *(const float2*)r : make_float2(0.f, 0.f);
        v[2 * i + 1] = (n + 3 < jb.N) ? *(const float2*)(r + 2) : make_float2(0.f, 0.f);
    }
}
__device__ __forceinline__ void phase0(const Params& p, char* ldsc) {
    int tid = threadIdx.x; asm volatile("" : "+v"(tid));
    const int G = gridDim.x, bid = blockIdx.x;
    const size_t gtid = (size_t)bid * NTHR + tid, gthreads = (size_t)G * NTHR;
    {
        constexpr int TOT = NL * 8 * 21 + NL * 8 * 8;
        bf16_t* lt = (bf16_t*)ldsc;
        ConvJob jb, jn; float2 v[16], vn[16];
        int t = bid; bool have = t < TOT && conv_job(p, t, jb);
        if (have) conv_load(jb, tid, v);
        while (have) {
            const int tn = t + G; const bool hn = tn < TOT && conv_job(p, tn, jn);
            if (hn) conv_load(jn, tid, vn);
            if (jb.q8 != 0.f) {
                unsigned char* l8 = (unsigned char*)lt;
#pragma unroll
                for (int i = 0; i < 8; ++i)
                    *(unsigned*)(l8 + ((tid >> 5) + 16 * i) * 132 + (tid & 31) * 4) = pack4_fp8(v[2 * i].x * jb.q8, v[2 * i].y * jb.q8, v[2 * i + 1].x * jb.q8, v[2 * i + 1].y * jb.q8);
                __syncthreads();
#pragma unroll
                for (int i = 0; i < 2; ++i) {
                    const int idx = tid + NTHR * i, kc = idx & 7, nn = idx >> 3, n = jb.nt * 128 + nn;
                    const unsigned char* l = l8 + (kc * 16) * 132 + nn;
                    u32x4 w;
                    w.x = (unsigned)l[0] | ((unsigned)l[132] << 8) | ((unsigned)l[264] << 16) | ((unsigned)l[396] << 24);
                    w.y = (unsigned)l[528] | ((unsigned)l[660] << 8) | ((unsigned)l[792] << 16) | ((unsigned)l[924] << 24);
                    w.z = (unsigned)l[1056] | ((unsigned)l[1188] << 8) | ((unsigned)l[1320] << 16) | ((unsigned)l[1452] << 24);
                    w.w = (unsigned)l[1584] | ((unsigned)l[1716] << 8) | ((unsigned)l[1848] << 16) | ((unsigned)l[1980] << 24);
                    *(u32x4*)((char*)jb.dst + (size_t)perm_row(jb.perm, n) * jb.K + jb.kt * 128 + kc * 16) = w;
                }
            } else {
#pragma unroll
                for (int i = 0; i < 8; ++i) {
                    u32x2 w; w.x = pack2(v[2 * i].x, v[2 * i].y); w.y = pack2(v[2 * i + 1].x, v[2 * i + 1].y);
                    *(u32x2*)(lt + ((tid >> 5) + 16 * i) * 136 + (tid & 31) * 4) = w;
                }
                __syncthreads();
#pragma unroll
                for (int i = 0; i < 4; ++i) {
                    const int idx = tid + NTHR * i, kc = idx & 15, nn = idx >> 4, n = jb.nt * 128 + nn;
                    if (n < jb.N) {
                        const bf16_t* l = lt + (kc * 8) * 136 + nn;
                        u32x4 w;
                        w.x = (unsigned)l[0] | ((unsigned)l[136] << 16); w.y = (unsigned)l[272] | ((unsigned)l[408] << 16);
                        w.z = (unsigned)l[544] | ((unsigned)l[680] << 16); w.w = (unsigned)l[816] | ((unsigned)l[952] << 16);
                        *(u32x4*)(jb.dst + (size_t)perm_row(jb.perm, n) * jb.K + jb.kt * 128 + kc * 8) = w;
                    }
                }
            }
            __syncthreads();
            t = tn; have = hn; jb = jn;
#pragma unroll
            for (int i = 0; i < 16; ++i) v[i] = vn[i];
        }
    }
    for (size_t i = gtid; i < (size_t)NL * 2 * 2048 * 64; i += gthreads) {
        const int k = (int)(i % 2048), n = (int)((i / 2048) % 64), m = (int)(i / (2048 * 64));
        p.W1T[i] = f2bf(p.cmp_w1[((size_t)m * 2048 + k) * 64 + n]);
    }
    for (size_t i = gtid; i < (size_t)NL * 2 * 64 * 64; i += gthreads) {
        const int k = (int)(i % 64), n = (int)((i / 64) % 64), m = (int)(i / 4096);
        p.W2T[i] = f2bf(p.cmp_w2[((size_t)m * 64 + k) * 64 + n]);
    }
    for (size_t i = gtid; i < (size_t)NL * NPAD; i += gthreads) {
        const int l = (int)(i / NPAD), r = (int)(i % NPAD);
        float v = 0.f;
        if (r < 2560) { const int n = r < 768 ? r : r + 4; v = p.b_in[l * NCOL + n]; }
        else if (r < 2564) v = p.b_in[l * NCOL + 768 + (r - 2560)];
        else if (r < 2582) v = p.b_in[l * NCOL + r];
        p.binp[i] = v;
    }
    for (size_t i = gtid; i < (size_t)NL * NE * 2048; i += gthreads) {
        const int r = (int)(i % 2048); const size_t le = i / 2048;
        const int s = (r >> 7) & 1, f = (r >> 8) * 128 + (r & 127);
        p.bgup[i] = p.b_gu[le * 2048 + 2 * f + s];
    }
    for (size_t i = gtid; i < (size_t)NL * NE * 1024; i += gthreads) {
        const int k = (int)(i % 1024), e = (int)((i / 1024) % NE), l = (int)(i / (1024 * NE));
        p.rwT[i] = p.router_w[((size_t)l * 1024 + k) * NE + e];
    }
    for (size_t i = gtid; i < (size_t)NL * (NPAD - NCOL) * 1024; i += gthreads) {
        const int l = (int)(i / ((NPAD - NCOL) * 1024)); const size_t r = i % ((size_t)(NPAD - NCOL) * 1024);
        p.WinT[(size_t)l * NPAD * 1024 + (size_t)NCOL * 1024 + r] = 0;
    }
    for (size_t i = gtid; i < (size_t)NTOK * DM / 4; i += gthreads) {
        const float4 v4 = ((const float4*)p.x)[i];
        u32x2 w; w.x = pack2(v4.x, v4.y); w.y = pack2(v4.z, v4.w);
        ((u32x2*)p.xb)[i] = w;
    }
    if (bid < 4) {
        float* lf = (float*)ldsc;
        const int j = tid & 63, part = tid >> 6;
        const float* pe = p.cmp_pe + (size_t)bid * 2048; const float* w1 = p.cmp_w1 + (size_t)bid * 2048 * 64;
        float s = 0.f;
        for (int kk = part * 256; kk < part * 256 + 256; ++kk) s += pe[kk] * w1[(size_t)kk * 64 + j];
        lf[tid] = s; __syncthreads();
        if (tid < 64) { float a = 0.f; for (int q = 0; q < 8; ++q) a += lf[tid + 64 * q]; p.b1c[bid * 64 + tid] = a; }
        __syncthreads();
    }
}

namespace pg8 {
constexpr int BM = 256, BK = 64, HALF = 128, HTB = HALF * BK * 2, NXCD = 8, WGM = 8;
__device__ __forceinline__ int lds_byte(int r, int c) { const int st = (r >> 4) * 2 + (c >> 5), rr = r & 15, cc = c & 31, ob = rr * 64 + cc * 2; return st * 1024 + (ob ^ (((ob >> 9) & 1) << 5)); }
__device__ __forceinline__ void stage_rc(int b, int& R, int& C) { const int st = b / 1024, sb = b % 1024, swz = sb ^ (((sb >> 9) & 1) << 5); R = (st >> 1) * 16 + swz / 64; C = (st & 1) * 32 + (swz % 64) / 2; }
__device__ __forceinline__ bool tile_order(int i, int G, int c, int nM, int nN, int& pm, int& pn) {
    const int nwg = nM * nN; const long L = (long)i * G + c; if (L >= nwg) return false;
    int wgid = (int)L; { const int q = nwg / NXCD, r = nwg % NXCD, xcd = wgid % NXCD, off = wgid / NXCD; wgid = (xcd < r ? xcd * (q + 1) : r * (q + 1) + (xcd - r) * q) + off; }
    const int nig = WGM * nN, gid = wgid / nig, fm = gid * WGM, gsz = (nM - fm) < WGM ? (nM - fm) : WGM;
    pm = fm + ((wgid % nig) % gsz); pn = (wgid % nig) / gsz; return true;
}
template <bool FP8, int SCA, class Sched, class Epi>
__device__ __forceinline__ void gemm_phase(LAS unsigned char* lds, const char* Abase, int K, const Sched& S, const Epi& E) {
    int tid = threadIdx.x; asm volatile("" : "+v"(tid));
    const int wid = __builtin_amdgcn_readfirstlane(tid >> 6), lane = tid & 63, wr = wid >> 2, wc = wid & 3, fr = lane & 15, fq = lane >> 4;
    const int nt = K / BK;
    int R0, C0, R1, C1; stage_rc(tid * 16, R0, C0); stage_rc(tid * 16 + 8192, R1, C1);
    LAS unsigned* aofs = (LAS unsigned*)(lds + LDS_AOFF) + tid;
    unsigned rg[10];
    rg[8] = (unsigned)(R0 * K + C0) * 2u; rg[9] = (unsigned)(R1 * K + C1) * 2u;
    if constexpr (FP8) { aofs[8 * NTHR] = rg[8]; aofs[9 * NTHR] = rg[9]; }
    const size_t kstep = (size_t)(BK * 2), hstep = (size_t)HALF * K * 2;
    const unsigned ldsw = (unsigned)wid * 1024u;
    const int aoff = lds_byte(wr * 64 + fr, fq * 8), boff = lds_byte(wc * 32 + fr, fq * 8);
#define PG8_SA(b, h) (((b) * 2 + (h)) * HTB)
#define PG8_SB(b, h) ((4 + (b) * 2 + (h)) * HTB)
#define PG8_OFS(sel, j) (FP8 ? aofs[((sel) * 4 + (j)) * NTHR] : ((sel) ? rg[4 + (j)] : rg[(j)]))
#define PG8_STAGE_B(bufoff, gbase) do { _Pragma("unroll") for (int _i = 0; _i < 2; ++_i) { const unsigned ob_ = FP8 ? aofs[(8 + _i) * NTHR] : rg[8 + _i]; \
        __builtin_amdgcn_global_load_lds((const unsigned*)((const char*)(gbase) + ob_), (LAS unsigned*)(lds + (bufoff) + ldsw + _i * 8192), 16, 0, 0); } } while (0)
#define PG8_STAGE_A(bufoff, kbyte, sel, h) do { const unsigned o0_ = PG8_OFS(sel, (h) * 2), o1_ = PG8_OFS(sel, (h) * 2 + 1); \
        __builtin_amdgcn_global_load_lds((const unsigned*)(Abase + (kbyte) + o0_), (LAS unsigned*)(lds + (bufoff) + ldsw), 16, 0, 0); \
        __builtin_amdgcn_global_load_lds((const unsigned*)(Abase + (kbyte) + o1_), (LAS unsigned*)(lds + (bufoff) + ldsw + 8192), 16, 0, 0); } while (0)
#define PG8_LDA(dst, b, h) do { _Pragma("unroll") for (int m = 0; m < 4; ++m) { \
        if constexpr (FP8) { const v4i_t lo_ = *(const LAS v4i_t*)(lds + PG8_SA(b, h) + aoff + m * 2048), hi_ = *(const LAS v4i_t*)(lds + PG8_SA(b, h) + aoff + m * 2048 + 1024); dst##8[m] = __builtin_shufflevector(lo_, hi_, 0, 1, 2, 3, 4, 5, 6, 7); } \
        else { _Pragma("unroll") for (int k = 0; k < 2; ++k) dst[m][k] = *(const LAS bf16x8*)(lds + PG8_SA(b, h) + aoff + m * 2048 + k * 1024); } } } while (0)
#define PG8_LDB(dst, b, h) do { _Pragma("unroll") for (int n = 0; n < 2; ++n) { \
        if constexpr (FP8) { const v4i_t lo_ = *(const LAS v4i_t*)(lds + PG8_SB(b, h) + boff + n * 2048), hi_ = *(const LAS v4i_t*)(lds + PG8_SB(b, h) + boff + n * 2048 + 1024); dst##8[n] = __builtin_shufflevector(lo_, hi_, 0, 1, 2, 3, 4, 5, 6, 7); } \
        else { _Pragma("unroll") for (int k = 0; k < 2; ++k) dst[n][k] = *(const LAS bf16x8*)(lds + PG8_SB(b, h) + boff + n * 2048 + k * 1024); } } } while (0)
#define PG8_MMA(ai, bj, At, Bt) do { __builtin_amdgcn_s_setprio(1); _Pragma("unroll") for (int m = 0; m < 4; ++m) _Pragma("unroll") for (int n = 0; n < 2; ++n) { \
        if constexpr (FP8) { acc[ai][bj][m][n] = __builtin_amdgcn_mfma_scale_f32_16x16x128_f8f6f4(Bt##8[n], At##8[m], acc[ai][bj][m][n], 0, 0, 0, SCA, 0, SCA); } \
        else { _Pragma("unroll") for (int k = 0; k < 2; ++k) acc[ai][bj][m][n] = __builtin_amdgcn_mfma_f32_16x16x32_bf16(Bt[n][k], At[m][k], acc[ai][bj][m][n], 0, 0, 0); } } \
        __builtin_amdgcn_s_setprio(0); } while (0)
#define PG8_WAIT_V(n) asm volatile("s_waitcnt vmcnt(" #n ")" ::: "memory")
#define PG8_WAIT_L(n) asm volatile("s_waitcnt lgkmcnt(" #n ")" ::: "memory")
#define PG8_BAR __builtin_amdgcn_s_barrier()
#define PG8_SCHED __builtin_amdgcn_sched_barrier(0)
    typename Sched::Unit cur, nxt; int ui = 0;
    if (!S.next(0, cur)) return;
    f32x4 acc[2][2][4][2];
#pragma unroll
    for (int a = 0; a < 2; ++a)
#pragma unroll
        for (int b = 0; b < 2; ++b)
#pragma unroll
            for (int m = 0; m < 4; ++m)
#pragma unroll
                for (int n = 0; n < 2; ++n) acc[a][b][m][n] = (f32x4){0.f, 0.f, 0.f, 0.f};
    bf16x8 At[4][2], B0[2][2], B1[2][2];
    v8i_t At8[4], B08[2], B18[2];
    { unsigned a4[2][2]; S.a_off(cur, R0, C0, R1, C1, a4); rg[0] = a4[0][0]; rg[1] = a4[0][1]; rg[2] = a4[1][0]; rg[3] = a4[1][1];
      if constexpr (FP8) { aofs[0] = a4[0][0]; aofs[NTHR] = a4[0][1]; aofs[2 * NTHR] = a4[1][0]; aofs[3 * NTHR] = a4[1][1]; } }
    const char* cB = S.b_ptr(cur);
    PG8_STAGE_B(PG8_SB(0, 0), cB); PG8_STAGE_B(PG8_SB(0, 1), cB + hstep); PG8_STAGE_A(PG8_SA(0, 0), 0, 0, 0); PG8_STAGE_A(PG8_SA(0, 1), 0, 0, 1);
    if (wr == 1) PG8_BAR;
    PG8_WAIT_V(2); PG8_BAR;
    PG8_STAGE_B(PG8_SB(1, 0), cB + kstep); PG8_STAGE_A(PG8_SA(1, 0), kstep, 0, 0); PG8_STAGE_B(PG8_SB(1, 1), cB + hstep + kstep);
    PG8_WAIT_V(6); PG8_BAR;
    for (;;) {
        const bool has_next = S.next(ui + 1, nxt);
        const char* nB = cB;
        if (has_next) { int t2 = threadIdx.x; asm volatile("" : "+v"(t2)); int r0, c0, r1, c1; stage_rc(t2 * 16, r0, c0); stage_rc(t2 * 16 + 8192, r1, c1); unsigned a4[2][2]; S.a_off(nxt, r0, c0, r1, c1, a4); nB = S.b_ptr(nxt);
            rg[4] = a4[0][0]; rg[5] = a4[0][1]; rg[6] = a4[1][0]; rg[7] = a4[1][1];
            if constexpr (FP8) { aofs[4 * NTHR] = a4[0][0]; aofs[5 * NTHR] = a4[0][1]; aofs[6 * NTHR] = a4[1][0]; aofs[7 * NTHR] = a4[1][1]; } }
        else { rg[4] = rg[0]; rg[5] = rg[1]; rg[6] = rg[2]; rg[7] = rg[3];
            if constexpr (FP8) { aofs[4 * NTHR] = aofs[0]; aofs[5 * NTHR] = aofs[NTHR]; aofs[6 * NTHR] = aofs[2 * NTHR]; aofs[7 * NTHR] = aofs[3 * NTHR]; } }
#pragma unroll 1
        for (int t = 0; t < nt; t += 2) {
            const bool last = (t == nt - 2);
            const size_t ka1 = (size_t)(t + 1) * kstep, ka2 = last ? 0 : (size_t)(t + 2) * kstep, ka3 = ka2 + kstep;
            const char* b2 = last ? nB : cB + (size_t)(t + 2) * kstep; const char* b3 = b2 + kstep;
            const int sel = last ? 1 : 0;
            PG8_LDB(B0, 0, 0); PG8_LDB(B1, 0, 1); PG8_SCHED; PG8_LDA(At, 0, 0); PG8_STAGE_A(PG8_SA(1, 1), ka1, 0, 1);
            PG8_WAIT_V(8); PG8_WAIT_L(0); PG8_BAR; PG8_MMA(0, 0, At, B0); PG8_MMA(0, 1, At, B1); PG8_BAR; PG8_SCHED;
            PG8_LDA(At, 0, 1); PG8_STAGE_B(PG8_SB(0, 0), b2); PG8_STAGE_B(PG8_SB(0, 1), b2 + hstep); PG8_STAGE_A(PG8_SA(0, 0), ka2, sel, 0);
            PG8_WAIT_V(8); PG8_WAIT_L(0); PG8_BAR; PG8_MMA(1, 0, At, B0); PG8_MMA(1, 1, At, B1); PG8_BAR; PG8_SCHED;
            PG8_LDB(B0, 1, 0); PG8_LDB(B1, 1, 1); PG8_SCHED; PG8_LDA(At, 1, 0); PG8_STAGE_A(PG8_SA(0, 1), ka2, sel, 1);
            PG8_WAIT_V(8); PG8_WAIT_L(0); PG8_BAR; PG8_MMA(0, 0, At, B0); PG8_MMA(0, 1, At, B1); PG8_BAR; PG8_SCHED;
            PG8_LDA(At, 1, 1); PG8_STAGE_B(PG8_SB(1, 0), b3); PG8_STAGE_B(PG8_SB(1, 1), b3 + hstep); PG8_STAGE_A(PG8_SA(1, 0), ka3, sel, 0);
            PG8_WAIT_V(8); PG8_WAIT_L(0); PG8_BAR; PG8_MMA(1, 0, At, B0); PG8_MMA(1, 1, At, B1); PG8_BAR; PG8_SCHED;
        }
        if (wr == 0) PG8_BAR;
        { int t2 = threadIdx.x; asm volatile("" : "+v"(t2)); E(acc, cur, wr, wc, t2 & 15, (t2 & 63) >> 4); }
        if (!has_next) break;
#pragma unroll
        for (int a = 0; a < 2; ++a)
#pragma unroll
            for (int b = 0; b < 2; ++b)
#pragma unroll
                for (int m = 0; m < 4; ++m)
#pragma unroll
                    for (int n = 0; n < 2; ++n) acc[a][b][m][n] = (f32x4){0.f, 0.f, 0.f, 0.f};
        cur = nxt; cB = nB; ++ui;
        rg[0] = rg[4]; rg[1] = rg[5]; rg[2] = rg[6]; rg[3] = rg[7];
        if constexpr (FP8) { aofs[0] = aofs[4 * NTHR]; aofs[NTHR] = aofs[5 * NTHR]; aofs[2 * NTHR] = aofs[6 * NTHR]; aofs[3 * NTHR] = aofs[7 * NTHR]; }
        if (wr == 1) PG8_BAR;
    }
    PG8_WAIT_V(0);
    PG8_BAR;
#undef PG8_SA
#undef PG8_SB
#undef PG8_STAGE_A
#undef PG8_OFS
#undef PG8_STAGE_B
#undef PG8_LDA
#undef PG8_LDB
#undef PG8_MMA
#undef PG8_WAIT_V
#undef PG8_WAIT_L
#undef PG8_BAR
#undef PG8_SCHED
}
}

struct DenseUnit { int pm, pn; };
struct DenseSched {
    typedef DenseUnit Unit;
    const char* Bt; int K, nM, nN;
    __device__ __forceinline__ bool next(int i, Unit& u) const { return pg8::tile_order(i, gridDim.x, blockIdx.x, nM, nN, u.pm, u.pn); }
    __device__ __forceinline__ void a_off(const Unit& u, int R0, int C0, int R1, int C1, unsigned (&off)[2][2]) const {
#pragma unroll
        for (int h = 0; h < 2; ++h) { off[h][0] = (unsigned)((u.pm * 256 + h * 128 + R0) * K + C0) * 2u; off[h][1] = (unsigned)((u.pm * 256 + h * 128 + R1) * K + C1) * 2u; }
    }
    __device__ __forceinline__ const char* b_ptr(const Unit& u) const { return Bt + (size_t)u.pn * 256 * K * 2; }
};
struct MoeUnit { int rbt, e, pn; };
template <bool GATHER>
struct MoeSched {
    typedef MoeUnit Unit;
    static constexpr int KP = 512;
    const char* Bt; const int* lists; const int* ptile; const int* ecnt; int nN, nrows;
    __device__ __forceinline__ bool next(int i, Unit& u) const {
        int pm, pn; if (!pg8::tile_order(i, gridDim.x, blockIdx.x, ptile[NE], nN, pm, pn)) return false;
        int e = 0; while (ptile[e + 1] <= pm) ++e;
        u.rbt = pm; u.e = e; u.pn = pn; return true;
    }
    __device__ __forceinline__ void a_off(const Unit& u, int R0, int C0, int R1, int C1, unsigned (&off)[2][2]) const {
        if (GATHER) {
            const int* lst = lists + (size_t)u.e * LIST_CAP; const int rb = u.rbt - ptile[u.e], cnt = ecnt[u.e];
#pragma unroll
            for (int h = 0; h < 2; ++h) {
                const int l0 = rb * 256 + h * 128 + R0, l1 = rb * 256 + h * 128 + R1;
                const int t0 = l0 < cnt ? (lst[l0] >> 2) : 0, t1 = l1 < cnt ? (lst[l1] >> 2) : 0;
                off[h][0] = (unsigned)(t0 * KP + C0) * 2u; off[h][1] = (unsigned)(t1 * KP + C1) * 2u;
            }
        } else {
#pragma unroll
            for (int h = 0; h < 2; ++h) { off[h][0] = (unsigned)((u.rbt * 256 + h * 128 + R0) * KP + C0) * 2u; off[h][1] = (unsigned)((u.rbt * 256 + h * 128 + R1) * KP + C1) * 2u; }
        }
    }
    __device__ __forceinline__ const char* b_ptr(const Unit& u) const { return Bt + ((size_t)u.e * nrows + (size_t)u.pn * 256) * KP * 2; }
};

struct EpiInProj {
    const Params* p; int l;
    __device__ __forceinline__ void operator()(const f32x4 (&acc)[2][2][4][2], const DenseUnit& u, int wr, int wc, int fr, int fq) const {
        const float* bias = p->binp + l * NPAD + u.pn * 256;
#pragma unroll
        for (int bj = 0; bj < 2; ++bj) {
            int kind = 0, hb0 = 0;
            if (u.pn == 1) { kind = 1; hb0 = bj * 2; } else if (u.pn == 4 && bj == 1) { kind = 1; hb0 = 4; } else if (u.pn == 8 && bj == 0) { kind = 1; hb0 = 6; } else if (u.pn == 9 && bj == 0) { kind = 1; hb0 = 8; }
            else if (u.pn == 2) { kind = 2; hb0 = bj * 2; } else if (u.pn == 5 && bj == 0) { kind = 2; hb0 = 4; } else if (u.pn == 8 && bj == 1) { kind = 2; hb0 = 6; } else if (u.pn == 9 && bj == 1) { kind = 2; hb0 = 8; }
#pragma unroll
            for (int n = 0; n < 2; ++n) {
                const int c = bj * 128 + wc * 32 + n * 16 + 4 * fq;
                const f32x4 bv = *(const f32x4*)(bias + c);
                const int hh = hb0 + ((c & 127) >> 6), d = c & 63;
#pragma unroll
                for (int ai = 0; ai < 2; ++ai)
#pragma unroll
                    for (int m = 0; m < 4; ++m) {
                        const int row = u.pm * 256 + ai * 128 + wr * 64 + m * 16 + fr;
                        const f32x4 v = acc[ai][bj][m][n] + bv;
                        u32x2 w; w.x = pack2(v[0], v[1]); w.y = pack2(v[2], v[3]);
                        if (kind == 0) *(u32x2*)(p->hb + (size_t)row * NMAIN + u.pn * 256 + c) = w;
                        else {
                            const int b = row >> 11, s = row & 2047, kk = s & 31;
                            bf16_t* blk = (kind == 1 ? p->kF : p->vT) + (((size_t)b * NVH + hh) * 64 + (s >> 5)) * 2048;
                            if (kind == 1) {
                                const int frk = (kk >> 3) * 4 + (kk & 3), t = (kk >> 2) & 1;
                                *(u32x2*)(blk + ((t * 2 + (d >> 5)) * 64 + ((d & 31) >> 3) * 16 + frk) * 8 + (d & 7)) = w;
                            } else {
                                bf16_t* vt = blk + (((d >> 4) * 64) + (kk >> 3) * 16 + (d & 15)) * 8 + (kk & 7);
                                vt[0] = (bf16_t)(w.x & 0xffff); vt[8] = (bf16_t)(w.x >> 16); vt[16] = (bf16_t)(w.y & 0xffff); vt[24] = (bf16_t)(w.y >> 16);
                            }
                        }
                    }
            }
        }
    }
};
struct EpiOutProj {
    const float* xin; float* t;
    __device__ __forceinline__ void operator()(const f32x4 (&acc)[2][2][4][2], const DenseUnit& u, int wr, int wc, int fr, int fq) const {
#pragma unroll
        for (int ai = 0; ai < 2; ++ai)
#pragma unroll
            for (int m = 0; m < 4; ++m) {
                const size_t rowoff = (size_t)(u.pm * 256 + ai * 128 + wr * 64 + m * 16 + fr) * DM + u.pn * 256 + wc * 32 + 4 * fq;
#pragma unroll
                for (int bj = 0; bj < 2; ++bj)
#pragma unroll
                    for (int n = 0; n < 2; ++n) {
                        const size_t off = rowoff + bj * 128 + n * 16;
                        const f32x4 xv = *(const f32x4*)(xin + off);
                        const f32x4 tv = xv * ALPHA + acc[ai][bj][m][n];
                        u32x2 w; w.x = pack2(tv[0], tv[1]); w.y = pack2(tv[2], tv[3]);
                        *(u32x2*)((bf16_t*)t + off) = w;
                    }
            }
    }
};
struct EpiGateUp {
    bf16_t* act; const float* bgup;
    __device__ __forceinline__ void operator()(const f32x4 (&acc)[2][2][4][2], const MoeUnit& u, int wr, int wc, int fr, int fq) const {
        const float* bias = bgup + (size_t)u.e * 2048 + u.pn * 256;
#pragma unroll
        for (int n = 0; n < 2; ++n) {
            const int c = wc * 32 + n * 16 + 4 * fq;
            const f32x4 bg = *(const f32x4*)(bias + c), bu = *(const f32x4*)(bias + 128 + c);
#pragma unroll
            for (int ai = 0; ai < 2; ++ai)
#pragma unroll
                for (int m = 0; m < 4; ++m) {
                    const f32x4 g4 = acc[ai][0][m][n] + bg, u4 = acc[ai][1][m][n] + bu;
                    float o[4];
#pragma unroll
                    for (int j = 0; j < 4; ++j) {
                        const float g = fminf(g4[j], 7.0f), uu = fminf(fmaxf(u4[j], -7.0f), 7.0f);
                        const float glu = g * __builtin_amdgcn_rcpf(1.0f + __builtin_amdgcn_exp2f(-2.455466929f * g));
                        o[j] = (uu + 1.0f) * glu;
                    }
                    *(unsigned*)((char*)act + (size_t)(u.rbt * 256 + ai * 128 + wr * 64 + m * 16 + fr) * DFF + u.pn * 128 + c) = pack4_fp8(o[0], o[1], o[2], o[3]);
                }
        }
    }
};
struct EpiDown {
    bf16_t* ybuf; const float* bdn;
    __device__ __forceinline__ void operator()(const f32x4 (&acc)[2][2][4][2], const MoeUnit& u, int wr, int wc, int fr, int fq) const {
        const float* bias = bdn + (size_t)u.e * 1024 + u.pn * 256;
#pragma unroll
        for (int bj = 0; bj < 2; ++bj)
#pragma unroll
            for (int n = 0; n < 2; ++n) {
                const int c = bj * 128 + wc * 32 + n * 16 + 4 * fq;
                const f32x4 bv = *(const f32x4*)(bias + c);
#pragma unroll
                for (int ai = 0; ai < 2; ++ai)
#pragma unroll
                    for (int m = 0; m < 4; ++m) {
                        const f32x4 v = acc[ai][bj][m][n] + bv;
                        u32x2 w; w.x = pack2(v[0], v[1]); w.y = pack2(v[2], v[3]);
                        *(u32x2*)(ybuf + (size_t)(u.rbt * 256 + ai * 128 + wr * 64 + m * 16 + fr) * DM + u.pn * 256 + c) = w;
                    }
            }
    }
};

__device__ __forceinline__ void phase_inproj(const Params& p, int l, char* lds) {
    DenseSched S{(const char*)(p.WinT + (size_t)l * NPAD * 1024), 1024, NTOK / 256, NMAIN / 256};
    EpiInProj E{&p, l};
    pg8::gemm_phase<false, 0>((LAS unsigned char*)lds, (const char*)p.xb, 1024, S, E);
    int tid = threadIdx.x; asm volatile("" : "+v"(tid));
    const int wid = tid >> 6, lane = tid & 63, fr = lane & 15, fq = lane >> 4;
    const bf16_t* W = p.WinT + ((size_t)l * NPAD + NMAIN) * 1024;
    const float* bias = p.binp + l * NPAD + NMAIN;
    for (int u = blockIdx.x * NWV + wid; u < NTOK / 16; u += gridDim.x * NWV) {
        const bf16_t* ar = p.xb + (size_t)(u * 16 + fr) * DM + fq * 8;
        const bf16_t* w0 = W + (size_t)fr * 1024 + fq * 8; const bf16_t* w1 = W + (size_t)(16 + fr) * 1024 + fq * 8;
        f32x4 a0 = (f32x4){0.f, 0.f, 0.f, 0.f}, a1 = a0;
#pragma unroll 4
        for (int ks = 0; ks < 32; ++ks) {
            const bf16x8 a = *(const bf16x8*)(ar + ks * 32);
            a0 = __builtin_amdgcn_mfma_f32_16x16x32_bf16(a, *(const bf16x8*)(w0 + ks * 32), a0, 0, 0, 0);
            a1 = __builtin_amdgcn_mfma_f32_16x16x32_bf16(a, *(const bf16x8*)(w1 + ks * 32), a1, 0, 0, 0);
        }
#pragma unroll
        for (int r = 0; r < 4; ++r) {
            float* dst = p.hs + (size_t)(u * 16 + fq * 4 + r) * HS_W;
            dst[fr] = a0[r] + bias[fr];
            if (fr < 6) dst[16 + fr] = a1[r] + bias[16 + fr];
        }
    }
}
__device__ __forceinline__ void phase_outproj(const Params& p, int l, const float* xin, char* lds) {
    DenseSched S{(const char*)p.WoT + (size_t)l * 1024 * 1024, 512, NTOK / 256, 4};
    EpiOutProj E{xin, p.tbuf};
    pg8::gemm_phase<true, 0x7c7c7c7c>((LAS unsigned char*)lds, (const char*)p.ob, 512, S, E);
}
__device__ __forceinline__ void build_tiles(const Params& p, int l, int* ptile, int* ecnt) {
    int tid = threadIdx.x; asm volatile("" : "+v"(tid));
    if (tid < NE) ecnt[tid] = (int)__hip_atomic_load(p.ctrl + 64 + l * NE + tid, __ATOMIC_RELAXED, __HIP_MEMORY_SCOPE_AGENT);
    __syncthreads();
    if (tid == 0) { int s = 0; for (int e = 0; e < NE; ++e) { ptile[e] = s; s += (ecnt[e] + 255) >> 8; } ptile[NE] = s; }
    __syncthreads();
}
__device__ __forceinline__ void phase_gateup(const Params& p, int l, char* lds) {
    int* ptile = (int*)(lds + LDS_TAB); int* ecnt = ptile + 40;
    build_tiles(p, l, ptile, ecnt);
    MoeSched<true> S{(const char*)p.WguT + (size_t)l * NE * 2048 * 1024, p.lists, ptile, ecnt, 8, 2048};
    EpiGateUp E{p.act, p.bgup + (size_t)l * NE * 2048};
    pg8::gemm_phase<true, 0x7c7c7c7c>((LAS unsigned char*)lds, (const char*)p.x1b, 512, S, E);
}
__device__ __forceinline__ void phase_down(const Params& p, int l, char* lds) {
    int* ptile = (int*)(lds + LDS_TAB); int* ecnt = ptile + 40;
    build_tiles(p, l, ptile, ecnt);
    MoeSched<false> S{(const char*)p.WdnT + (size_t)l * NE * 1024 * 1024, p.lists, ptile, ecnt, 4, 1024};
    EpiDown E{p.ybuf, p.b_dn + (size_t)l * NE * 1024};
    pg8::gemm_phase<true, 0x7c7c7c7c>((LAS unsigned char*)lds, (const char*)p.act, 512, S, E);
}

__device__ __forceinline__ float gelu_tanh(float x) {
    const float u = 0.7978845608028654f * (x + 0.044715f * x * x * x);
    const float e = __expf(-2.0f * fabsf(u)); const float th = (1.0f - e) / (1.0f + e);
    return 0.5f * x * (1.0f + (u < 0.f ? -th : th));
}
__device__ __forceinline__ void phase_prep(const Params& p, int l, char* lds) {
    int tid = threadIdx.x; asm volatile("" : "+v"(tid));
    const int wid = tid >> 6, lane = tid & 63, fr = lane & 15, fq = lane >> 4;
    const int gw = blockIdx.x * NWV + wid, nw = gridDim.x * NWV;
    for (int u = (int)gridDim.x - 1 - (int)blockIdx.x; u < NB * 4; u += gridDim.x) {
        const int b = u >> 2, h = u & 3;
        const float* srcp = p.hs + ((size_t)b * SEQ + tid * 4) * HS_W + h;
        float ls[4]; float tot = 0.f;
#pragma unroll
        for (int i = 0; i < 4; ++i) { const float f = srcp[(size_t)i * HS_W]; ls[i] = fminf(f, 0.f) - log1pf(__expf(-fabsf(f))); tot += ls[i]; }
        float inc = tot;
#pragma unroll
        for (int o = 1; o < 64; o <<= 1) { const float v = shfl_f(inc, lane - o); if (lane >= o) inc += v; }
        float* wtot = (float*)(lds + 65536);
        if (lane == 63) wtot[wid] = inc;
        __syncthreads();
        float base = inc - tot;
        for (int w = 0; w < wid; ++w) base += wtot[w];
        float4 o4; o4.x = base + ls[0]; o4.y = o4.x + ls[1]; o4.z = o4.y + ls[2]; o4.w = o4.z + ls[3];
        *(float4*)(p.cF + (size_t)u * SEQ + tid * 4) = o4;
        __syncthreads();
    }
    float* part = (float*)lds;
    bf16_t* h1 = (bf16_t*)(lds + 32768);
    for (int u = blockIdx.x; u < NB * 2 * 2 * 8; u += gridDim.x) {
        const int ct = u & 7, which = (u >> 3) & 1, kvh = (u >> 4) & 1, b = u >> 5;
        const int colo = (which ? C_NVC : C_NKC) + kvh * 64;
        const int c_lane = ct * 16 + fr;
        const int tokbase = min(c_lane, 126) * 16;
        const bf16_t* arow = p.hb + ((size_t)b * SEQ + tokbase) * NMAIN + colo + fq * 8;
        const bf16_t* w1 = p.W1T + ((size_t)(l * 2 + which) * 64 + fr) * 2048 + fq * 8;
        f32x4 acc[4];
#pragma unroll
        for (int n = 0; n < 4; ++n) acc[n] = (f32x4){0.f, 0.f, 0.f, 0.f};
#pragma unroll
        for (int kk = 0; kk < 8; ++kk) {
            const int ks = wid * 8 + kk;
            const bf16x8 a = *(const bf16x8*)(arow + (size_t)(ks >> 1) * NMAIN + (ks & 1) * 32);
#pragma unroll
            for (int n = 0; n < 4; ++n) {
                const bf16x8 bb = *(const bf16x8*)(w1 + (size_t)n * 16 * 2048 + ks * 32);
                acc[n] = __builtin_amdgcn_mfma_f32_16x16x32_bf16(a, bb, acc[n], 0, 0, 0);
            }
        }
#pragma unroll
        for (int n = 0; n < 4; ++n)
#pragma unroll
            for (int r = 0; r < 4; ++r) part[wid * 1024 + (fq * 4 + r) * 64 + n * 16 + fr] = acc[n][r];
        __syncthreads();
        const float* b1 = p.b1c + (l * 2 + which) * 64;
#pragma unroll
        for (int i = 0; i < 2; ++i) {
            const int e = tid + NTHR * i; float sum = 0.f;
#pragma unroll
            for (int w = 0; w < 8; ++w) sum += part[w * 1024 + e];
            h1[e] = f2bf(gelu_tanh(sum + b1[e & 63]));
        }
        __syncthreads();
        if (wid == 0) {
            const bf16_t* w2 = p.W2T + ((size_t)(l * 2 + which) * 64 + fr) * 64 + fq * 8;
            f32x4 o2[4];
#pragma unroll
            for (int n = 0; n < 4; ++n) o2[n] = (f32x4){0.f, 0.f, 0.f, 0.f};
#pragma unroll
            for (int ks = 0; ks < 2; ++ks) {
                const bf16x8 a = *(const bf16x8*)(h1 + fr * 64 + ks * 32 + fq * 8);
#pragma unroll
                for (int n = 0; n < 4; ++n) {
                    const bf16x8 bb = *(const bf16x8*)(w2 + (size_t)n * 16 * 64 + ks * 32);
                    o2[n] = __builtin_amdgcn_mfma_f32_16x16x32_bf16(a, bb, o2[n], 0, 0, 0);
                }
            }
            const size_t base = ((size_t)b * 2 + kvh) * 128 * 64;
#pragma unroll
            for (int n = 0; n < 4; ++n)
#pragma unroll
                for (int r = 0; r < 4; ++r) {
                    const int c = ct * 16 + fq * 4 + r, j2 = n * 16 + fr;
                    const bf16_t v = c < 127 ? f2bf(o2[n][r]) : (bf16_t)0;
                    if (which == 0) p.kc[base + (size_t)c * 64 + j2] = v;
                    else { p.vc[base + (size_t)c * 64 + j2] = v; p.vcT[base + (size_t)j2 * 128 + c] = v; }
                }
        }
        __syncthreads();
    }
}

constexpr float L2E = 1.4426950408889634f, MASKV = -__builtin_huge_valf(), MINIT = -1e30f, SCL2 = QSCALE * L2E;
struct KVFrag { bf16x8 k[2][2]; bf16x8 v[4]; };
template <bool FM>
__device__ __forceinline__ void k_load(KVFrag& f, const bf16_t* __restrict__ Kb, size_t ldk, int kc0, int fr, int fq) {
    if (FM) {
        const bf16_t* kp = Kb + (size_t)(kc0 >> 5) * 2048 + (fq * 16 + fr) * 8;
        f.k[0][0] = *(const bf16x8*)(kp); f.k[0][1] = *(const bf16x8*)(kp + 512); f.k[1][0] = *(const bf16x8*)(kp + 1024); f.k[1][1] = *(const bf16x8*)(kp + 1536);
    } else {
        const bf16_t* kp = Kb + (size_t)(kc0 + (fr >> 2) * 8 + (fr & 3)) * ldk + fq * 8;
        f.k[0][0] = *(const bf16x8*)(kp); f.k[0][1] = *(const bf16x8*)(kp + 32);
        f.k[1][0] = *(const bf16x8*)(kp + 4 * ldk); f.k[1][1] = *(const bf16x8*)(kp + 4 * ldk + 32);
    }
}
template <bool FM>
__device__ __forceinline__ void v_load(bf16x8 (&v)[4], const bf16_t* __restrict__ VTb, size_t ldv, int kc0, int fr, int fq) {
    if (FM) {
        const bf16_t* vp = VTb + (size_t)(kc0 >> 5) * 2048 + (fq * 16 + fr) * 8;
#pragma unroll
        for (int dt = 0; dt < 4; ++dt) v[dt] = *(const bf16x8*)(vp + dt * 512);
    } else {
        const bf16_t* vp = VTb + (size_t)fr * ldv + kc0 + fq * 8;
#pragma unroll
        for (int dt = 0; dt < 4; ++dt) v[dt] = *(const bf16x8*)(vp + (size_t)dt * 16 * ldv);
    }
}
__device__ __forceinline__ float rowmax4(float x) {
    auto r = __builtin_amdgcn_permlane32_swap(__float_as_uint(x), __float_as_uint(x), false, false);
    x = fmaxf(__uint_as_float(r[0]), __uint_as_float(r[1]));
    auto q = __builtin_amdgcn_permlane16_swap(__float_as_uint(x), __float_as_uint(x), false, false);
    return fmaxf(__uint_as_float(q[0]), __uint_as_float(q[1]));
}
__device__ __forceinline__ float rowsum4(float x) {
    auto r = __builtin_amdgcn_permlane32_swap(__float_as_uint(x), __float_as_uint(x), false, false);
    x = __uint_as_float(r[0]) + __uint_as_float(r[1]);
    auto q = __builtin_amdgcn_permlane16_swap(__float_as_uint(x), __float_as_uint(x), false, false);
    return __uint_as_float(q[0]) + __uint_as_float(q[1]);
}
template <int NQT, bool MASK, class MB>
__device__ __forceinline__ void attn_compute(const KVFrag& f, const bf16x8 (&qf)[NQT][2], f32x4 (&o)[NQT][4], float (&m)[NQT], float (&l)[NQT], const MB& mb) {
    f32x4 s0[NQT], s1[NQT];
#pragma unroll
    for (int qt = 0; qt < NQT; ++qt) {
        s0[qt] = __builtin_amdgcn_mfma_f32_16x16x32_bf16(f.k[0][0], qf[qt][0], (f32x4){0.f, 0.f, 0.f, 0.f}, 0, 0, 0);
        s1[qt] = __builtin_amdgcn_mfma_f32_16x16x32_bf16(f.k[1][0], qf[qt][0], (f32x4){0.f, 0.f, 0.f, 0.f}, 0, 0, 0);
    }
#pragma unroll
    for (int qt = 0; qt < NQT; ++qt) {
        s0[qt] = __builtin_amdgcn_mfma_f32_16x16x32_bf16(f.k[0][1], qf[qt][1], s0[qt], 0, 0, 0);
        s1[qt] = __builtin_amdgcn_mfma_f32_16x16x32_bf16(f.k[1][1], qf[qt][1], s1[qt], 0, 0, 0);
    }
    float mx[NQT];
#pragma unroll
    for (int qt = 0; qt < NQT; ++qt) {
#pragma unroll
        for (int j = 0; j < 4; ++j) { s0[qt][j] = mb(qt, j, s0[qt][j]); s1[qt][j] = mb(qt, j + 4, s1[qt][j]); }
        mx[qt] = fmaxf(fmaxf(fmaxf(s0[qt][0], s0[qt][1]), fmaxf(s0[qt][2], s0[qt][3])), fmaxf(fmaxf(s1[qt][0], s1[qt][1]), fmaxf(s1[qt][2], s1[qt][3])));
    }
#pragma unroll
    for (int qt = 0; qt < NQT; ++qt) mx[qt] = rowmax4(mx[qt]);
    bool moved = false;
#pragma unroll
    for (int qt = 0; qt < NQT; ++qt) { mx[qt] = fmaxf(m[qt], mx[qt]); moved |= (mx[qt] != m[qt]); }
    if (__ballot(moved) != 0ull) {
#pragma unroll
        for (int qt = 0; qt < NQT; ++qt) {
            const float alpha = __builtin_amdgcn_exp2f(m[qt] - mx[qt]);
            l[qt] *= alpha;
#pragma unroll
            for (int dt = 0; dt < 4; ++dt) o[qt][dt] *= alpha;
        }
    }
    bf16x8 pf[NQT];
#pragma unroll
    for (int qt = 0; qt < NQT; ++qt) {
        m[qt] = mx[qt];
        float pr[8]; float ps = 0.f;
#pragma unroll
        for (int j = 0; j < 4; ++j) {
            pr[j] = __builtin_amdgcn_exp2f(s0[qt][j] - mx[qt]);
            pr[j + 4] = __builtin_amdgcn_exp2f(s1[qt][j] - mx[qt]);
        }
#pragma unroll
        for (int j = 0; j < 8; ++j) ps += pr[j];
        l[qt] += ps;
        const u32x4 pk = {pack2(pr[0], pr[1]), pack2(pr[2], pr[3]), pack2(pr[4], pr[5]), pack2(pr[6], pr[7])};
        pf[qt] = __builtin_bit_cast(bf16x8, pk);
    }
#pragma unroll
    for (int dt = 0; dt < 4; ++dt)
#pragma unroll
        for (int qt = 0; qt < NQT; ++qt) o[qt][dt] = __builtin_amdgcn_mfma_f32_16x16x32_bf16(f.v[dt], pf[qt], o[qt][dt], 0, 0, 0);
    __builtin_amdgcn_sched_barrier(0);
}
struct RangeIt { int c, c_hi; __device__ __forceinline__ int nxt() { if (c > c_hi) return -1; return (c++) * 32; } };
struct MaskIt { unsigned long long cm; __device__ __forceinline__ int nxt() { if (!cm) return -1; const int i = __builtin_ctzll(cm); cm &= cm - 1; return i * 32; } };
template <bool PFV, bool FM, class It, class Gen>
__device__ __forceinline__ void attn_run(It& it, const bf16_t* Kb, size_t ldk, const bf16_t* VTb, size_t ldv, int fr, int fq, const Gen& gen) {
    KVFrag fa, fb;
    int ka = it.nxt(); if (ka < 0) return;
    k_load<FM>(fa, Kb, ldk, ka, fr, fq); if (PFV) v_load<FM>(fa.v, VTb, ldv, ka, fr, fq);
    for (;;) {
        const int kb = it.nxt(); if (kb >= 0) { k_load<FM>(fb, Kb, ldk, kb, fr, fq); if (PFV) v_load<FM>(fb.v, VTb, ldv, kb, fr, fq); }
        if (!PFV) v_load<FM>(fa.v, VTb, ldv, ka, fr, fq);
        gen(ka, fa);
        if (kb < 0) break;
        ka = it.nxt(); if (ka >= 0) { k_load<FM>(fa, Kb, ldk, ka, fr, fq); if (PFV) v_load<FM>(fa.v, VTb, ldv, ka, fr, fq); }
        if (!PFV) v_load<FM>(fb.v, VTb, ldv, kb, fr, fq);
        gen(kb, fb);
        if (ka < 0) break;
    }
}
template <int NQT>
__device__ __forceinline__ void attn_init(f32x4 (&o)[NQT][4], float (&m)[NQT], float (&l)[NQT]) {
#pragma unroll
    for (int qt = 0; qt < NQT; ++qt) { m[qt] = MINIT; l[qt] = 0.f;
#pragma unroll
        for (int dt = 0; dt < 4; ++dt) o[qt][dt] = (f32x4){0.f, 0.f, 0.f, 0.f}; }
}
__device__ __forceinline__ float lsum4(float l) { return rowsum4(l); }
__device__ __forceinline__ void store_o4(unsigned char* dst, const f32x4 v) { *(unsigned*)dst = pack4_fp8(v[0], v[1], v[2], v[3]); }
__device__ __forceinline__ float sigmoidf_fast(float x) { return __builtin_amdgcn_rcpf(1.0f + __builtin_amdgcn_exp2f(-L2E * x)); }

__device__ __forceinline__ void fox_unit(const Params& p, int b, int h, int qb, int fr, int fq) {
    asm volatile("" : "+v"(fr), "+v"(fq));
    const int t0 = qb * 64;
    const bf16_t* Qb = p.hb + ((size_t)b * SEQ + t0) * NMAIN + C_FQ + h * 64 + fq * 8;
    bf16x8 qf[4][2];
#pragma unroll
    for (int qt = 0; qt < 4; ++qt) { qf[qt][0] = *(const bf16x8*)(Qb + (size_t)(qt * 16 + fr) * NMAIN); qf[qt][1] = *(const bf16x8*)(Qb + (size_t)(qt * 16 + fr) * NMAIN + 32); }
    const float* cf = p.cF + ((size_t)b * 4 + h) * SEQ;
    float cq[4];
#pragma unroll
    for (int qt = 0; qt < 4; ++qt) cq[qt] = cf[t0 + qt * 16 + fr] * L2E;
    f32x4 o[4][4]; float m[4], l[4];
    attn_init<4>(o, m, l);
    const bf16_t* Kb = p.kF + ((size_t)b * NVH + h) * 64 * SEQ;
    const bf16_t* VTb = p.vT + ((size_t)b * NVH + h) * 64 * SEQ;
    RangeIt it{0, (t0 >> 5) + 1};
    attn_run<false, true>(it, Kb, NMAIN, VTb, SEQ, fr, fq, [&](int kc0, const KVFrag& f) {
        const float4 ca = *(const float4*)(cf + kc0 + 8 * fq), cb = *(const float4*)(cf + kc0 + 8 * fq + 4);
        const float ck[8] = {ca.x * L2E, ca.y * L2E, ca.z * L2E, ca.w * L2E, cb.x * L2E, cb.y * L2E, cb.z * L2E, cb.w * L2E};
        const int kq = kc0 + 8 * fq - t0 - fr;
        attn_compute<4, true>(f, qf, o, m, l, [&](int qt, int j, float raw) { return (kq + j - 16 * qt) > 0 ? MASKV : raw * SCL2 + cq[qt] - ck[j]; });
    });
#pragma unroll
    for (int qt = 0; qt < 4; ++qt) {
        const float inv = __builtin_amdgcn_rcpf(lsum4(l[qt]));
        unsigned char* dst = (unsigned char*)p.ob + ((size_t)b * SEQ + t0 + qt * 16 + fr) * DM + h * 64 + 4 * fq;
#pragma unroll
        for (int dt = 0; dt < 4; ++dt) store_o4(dst + dt * 16, o[qt][dt] * inv);
    }
}
__device__ __forceinline__ void swa_unit(const Params& p, int l_, int b, int kv, int pos, int fr, int fq) {
    asm volatile("" : "+v"(fr), "+v"(fq));
    const int t0 = pos * 16, t = t0 + fr;
    const bf16_t* Qb = p.hb + ((size_t)b * SEQ + t) * NMAIN + C_SQ + kv * 192 + fq * 8;
    bf16x8 qf[3][2];
#pragma unroll
    for (int g = 0; g < 3; ++g) { qf[g][0] = *(const bf16x8*)(Qb + g * 64); qf[g][1] = *(const bf16x8*)(Qb + g * 64 + 32); }
    float sl[3];
#pragma unroll
    for (int g = 0; g < 3; ++g) sl[g] = slope_swa(kv * 3 + g) * L2E;
    f32x4 o[3][4]; float m[3], l[3];
    attn_init<3>(o, m, l);
    const bf16_t* Kb = p.kF + ((size_t)b * NVH + 4 + kv) * 64 * SEQ;
    const bf16_t* VTb = p.vT + ((size_t)b * NVH + 4 + kv) * 64 * SEQ;
    RangeIt it{max(0, t0 - 127) >> 5, (t0 + 15) >> 5};
    attn_run<true, true>(it, Kb, NMAIN, VTb, SEQ, fr, fq, [&](int kc0, const KVFrag& f) {
        const int dq = t - kc0 - 8 * fq;
        attn_compute<3, true>(f, qf, o, m, l, [&](int g, int j, float raw) { const int dist = dq - j; return ((unsigned)dist < 128u) ? raw * SCL2 - sl[g] * (float)dist : MASKV; });
    });
#pragma unroll
    for (int g = 0; g < 3; ++g) {
        const float sink = p.sinks[l_ * 6 + kv * 3 + g] * L2E;
        const float inv = __builtin_amdgcn_rcpf(lsum4(l[g]) + __builtin_amdgcn_exp2f(sink - m[g]));
        unsigned char* dst = (unsigned char*)p.ob + ((size_t)b * SEQ + t) * DM + 256 + (kv * 3 + g) * 64 + 4 * fq;
#pragma unroll
        for (int dt = 0; dt < 4; ++dt) store_o4(dst + dt * 16, o[g][dt] * inv);
    }
}
__device__ __forceinline__ void nsa_unit(const Params& p, int b, int kv, int pos, int fr, int fq, int lane, float* ps, unsigned* msk, float* otl) {
    asm volatile("" : "+v"(fr), "+v"(fq), "+v"(lane));
    const int t0 = pos * 16, t = t0 + fr, cur = t0 >> 6;
    const bf16_t* Qb = p.hb + ((size_t)b * SEQ + t) * NMAIN + C_NQ + kv * 192 + fq * 8;
    bf16x8 qf[3][2];
#pragma unroll
    for (int g = 0; g < 3; ++g) { qf[g][0] = *(const bf16x8*)(Qb + g * 64); qf[g][1] = *(const bf16x8*)(Qb + g * 64 + 32); }
    float sl[3];
#pragma unroll
    for (int g = 0; g < 3; ++g) sl[g] = slope_nsa(kv * 3 + g) * L2E;
    const float* gl = p.hs + ((size_t)b * SEQ + t) * HS_W + 4 + kv * 9;
    f32x4 o[3][4]; float m[3], l[3];
    f32x4* otv = (f32x4*)otl + lane;
#pragma unroll
    for (int i = 0; i < 8; ++i) ps[lane + 64 * i] = 0.f;
    {
        const bf16_t* Kb = p.kc + ((size_t)b * 2 + kv) * 128 * 64;
        const bf16_t* VTb = p.vcT + ((size_t)b * 2 + kv) * 64 * 128;
        const int ncv = (t0 + 15 >= 31) ? ((t0 + 15 - 31) >> 4) + 1 : 0;
        const int nch = (ncv + 31) >> 5;
        attn_init<3>(o, m, l);
        const int dq0 = t - 31 - 16 * 8 * fq;
        RangeIt it{0, nch - 1};
        attn_run<false, false>(it, Kb, 64, VTb, 128, fr, fq, [&](int kc0, const KVFrag& f) {
            const int dq = dq0 - 16 * kc0;
            attn_compute<3, true>(f, qf, o, m, l, [&](int g, int j, float raw) { const int dist = dq - 16 * j; return dist >= 0 ? raw * SCL2 - sl[g] * (float)dist : MASKV; });
        });
        float il[3];
#pragma unroll
        for (int g = 0; g < 3; ++g) {
            const float lt = lsum4(l[g]); il[g] = lt > 0.f ? __builtin_amdgcn_rcpf(lt) : 0.f;
            const float gate = sigmoidf_fast(gl[g * 3 + 0]);
#pragma unroll
            for (int dt = 0; dt < 4; ++dt) otv[(g * 4 + dt) * 64] = o[g][dt] * (il[g] * gate);
        }
        float carry_prev = 0.f;
        for (int c = 0; c < nch; ++c) {
            const int kc0 = c * 32, dq = dq0 - 16 * kc0;
            const bf16_t* kp = Kb + (size_t)(kc0 + (fr >> 2) * 8 + (fr & 3)) * 64 + fq * 8;
            const bf16x8 k00 = *(const bf16x8*)(kp), k01 = *(const bf16x8*)(kp + 32), k10 = *(const bf16x8*)(kp + 256), k11 = *(const bf16x8*)(kp + 256 + 32);
            float pc[8];
#pragma unroll
            for (int j = 0; j < 8; ++j) pc[j] = 0.f;
#pragma unroll
            for (int g = 0; g < 3; ++g) {
                f32x4 s0 = (f32x4){0.f, 0.f, 0.f, 0.f}, s1 = s0;
                s0 = __builtin_amdgcn_mfma_f32_16x16x32_bf16(k00, qf[g][0], s0, 0, 0, 0); s0 = __builtin_amdgcn_mfma_f32_16x16x32_bf16(k01, qf[g][1], s0, 0, 0, 0);
                s1 = __builtin_amdgcn_mfma_f32_16x16x32_bf16(k10, qf[g][0], s1, 0, 0, 0); s1 = __builtin_amdgcn_mfma_f32_16x16x32_bf16(k11, qf[g][1], s1, 0, 0, 0);
#pragma unroll
                for (int j = 0; j < 8; ++j) {
                    const int dist = dq - 16 * j; const float raw = j < 4 ? s0[j] : s1[j - 4];
                    if (dist >= 0) pc[j] += __builtin_amdgcn_exp2f(raw * SCL2 - sl[g] * (float)dist - m[g]) * il[g];
                }
            }
            const float cout = 0.5f * pc[7];
            float cin = shfl_f(cout, lane - 16);
            const float cwrap = shfl_f(cout, fr + 48);
            if (fq == 0) cin = carry_prev;
            carry_prev = cwrap;
            const int n0 = (kc0 >> 2) + 2 * fq;
            ps[fr * 32 + n0] = cin + pc[0] + pc[1] + pc[2] + 0.5f * pc[3];
            ps[fr * 32 + n0 + 1] = 0.5f * pc[3] + pc[4] + pc[5] + pc[6] + 0.5f * pc[7];
        }
    }
    lds_wave_sync();
    if (lane < 16) {
        unsigned mask = 1u | (1u << cur); if (cur >= 1) mask |= 1u << (cur - 1);
        if (cur >= 3) {
            if (cur - 2 <= 5) mask |= (1u << (cur - 1)) - 2u;
            else {
                const float* my = ps + lane * 32;
                for (int r = 0; r < 5; ++r) {
                    float best = -1.0f; int bi = 1;
                    for (int j = 1; j <= cur - 2; ++j) { const float v = my[j]; if (!((mask >> j) & 1u) && v > best) { best = v; bi = j; } }
                    mask |= 1u << bi;
                }
            }
        }
        msk[lane] = mask;
    }
    lds_wave_sync();
    const unsigned qmask = msk[fr];
    lds_wave_sync();
    {
        const bf16_t* Kb = p.kF + ((size_t)b * NVH + 6 + kv) * 64 * SEQ;
        const bf16_t* VTb = p.vT + ((size_t)b * NVH + 6 + kv) * 64 * SEQ;
        attn_init<3>(o, m, l);
        unsigned um = qmask;
        um |= shfl_u(um, lane ^ 1); um |= shfl_u(um, lane ^ 2); um |= shfl_u(um, lane ^ 4); um |= shfl_u(um, lane ^ 8);
        um = (unsigned)__builtin_amdgcn_readfirstlane((int)um) & (cur >= 31 ? 0xffffffffu : ((2u << cur) - 1u));
        unsigned long long cm = 0ull;
        for (unsigned r = um; r; r &= r - 1) { const int kb = __builtin_ctz(r); cm |= 3ull << (2 * kb); }
        MaskIt it{cm};
        attn_run<false, true>(it, Kb, NMAIN, VTb, SEQ, fr, fq, [&](int kc0, const KVFrag& f) {
            const bool mine = (qmask >> (kc0 >> 6)) & 1u;
            const int dq = t - kc0 - 8 * fq;
            attn_compute<3, true>(f, qf, o, m, l, [&](int g, int j, float raw) { const int dist = dq - j; return (mine && dist >= 0) ? raw * SCL2 - sl[g] * (float)dist : MASKV; });
        });
#pragma unroll
        for (int g = 0; g < 3; ++g) {
            const float lt = lsum4(l[g]); const float sc = (lt > 0.f ? __builtin_amdgcn_rcpf(lt) : 0.f) * sigmoidf_fast(gl[g * 3 + 1]);
#pragma unroll
            for (int dt = 0; dt < 4; ++dt) otv[(g * 4 + dt) * 64] += o[g][dt] * sc;
        }
    }
    {
        const bf16_t* Kb = p.kF + ((size_t)b * NVH + 8 + kv) * 64 * SEQ;
        const bf16_t* VTb = p.vT + ((size_t)b * NVH + 8 + kv) * 64 * SEQ;
        attn_init<3>(o, m, l);
        RangeIt it{max(0, t0 - 511) >> 5, (t0 + 15) >> 5};
        attn_run<false, true>(it, Kb, NMAIN, VTb, SEQ, fr, fq, [&](int kc0, const KVFrag& f) {
            const int dq = t - kc0 - 8 * fq;
            attn_compute<3, true>(f, qf, o, m, l, [&](int g, int j, float raw) { const int dist = dq - j; return ((unsigned)dist < 512u) ? raw * SCL2 - sl[g] * (float)dist : MASKV; });
        });
#pragma unroll
        for (int g = 0; g < 3; ++g) {
            const float lt = lsum4(l[g]); const float sc = (lt > 0.f ? __builtin_amdgcn_rcpf(lt) : 0.f) * sigmoidf_fast(gl[g * 3 + 2]);
            unsigned char* dst = (unsigned char*)p.ob + ((size_t)b * SEQ + t) * DM + 640 + (kv * 3 + g) * 64 + 4 * fq;
#pragma unroll
            for (int dt = 0; dt < 4; ++dt) store_o4(dst + dt * 16, otv[(g * 4 + dt) * 64] + o[g][dt] * sc);
        }
    }
}

template <bool WITH_CONV>
__device__ __forceinline__ void phase_attn(const Params& p, int l, char* lds, int cslot = 16) {
    int tid = threadIdx.x; asm volatile("" : "+v"(tid));
    const int wid = tid >> 6, lane = tid & 63, fr = lane & 15, fq = lane >> 4;
    float* ps = (float*)(lds + wid * 16896); unsigned* msk = (unsigned*)(ps + 512); float* otl = ps + 576;
    unsigned* ctr = p.ctrl + cslot + l;
    constexpr unsigned NU_NSA = NB * 2 * 128, NU_FOX = NB * 4 * 32, NU_SWA = NB * 2 * 128, NU_ATT = NU_NSA + NU_FOX + NU_SWA;
    for (;;) {
        unsigned u = 0;
        if (lane == 0) u = __hip_atomic_fetch_add(ctr, 1u, __ATOMIC_RELAXED, __HIP_MEMORY_SCOPE_AGENT);
        u = (unsigned)__builtin_amdgcn_readfirstlane((int)u);
        if (WITH_CONV) {
            constexpr unsigned TOTQ = NU_ATT + (unsigned)CONV_TILES;
            if (u >= TOTQ) break;
            const unsigned a0 = (unsigned)(((unsigned long long)u * NU_ATT) / TOTQ), a1 = (unsigned)(((unsigned long long)(u + 1) * NU_ATT) / TOTQ);
            if (a1 == a0) { conv_tile_wave(p, (int)(u - a0), lane, (unsigned char*)ps); continue; }
            u = a0;
        } else {
#ifndef ATT_REP
#define ATT_REP 1
#endif
            if (u >= ATT_REP * NU_ATT) break;
            if (ATT_REP > 1) u %= NU_ATT;
        }
        if (u < NU_NSA) { const int pos = 127 - (int)(u & 127), r = u >> 7; nsa_unit(p, r >> 1, r & 1, pos, fr, fq, lane, ps, msk, otl); }
        else if (u < NU_NSA + NU_FOX) { const unsigned v = u - NU_NSA; const int qb = 31 - (int)(v & 31), r = v >> 5; fox_unit(p, r >> 2, r & 3, qb, fr, fq); }
        else { const unsigned v = u - NU_NSA - NU_FOX; const int pos = 127 - (int)(v & 127), r = v >> 7; swa_unit(p, l, r >> 1, r & 1, pos, fr, fq); }
    }
}

__device__ __forceinline__ void phase_ln1_router(const Params& p, int l, char* lds) {
    int tid = threadIdx.x; asm volatile("" : "+v"(tid));
    const int wid = tid >> 6, lane = tid & 63, fr = lane & 15, fq = lane >> 4;
    float* lg = (float*)lds + wid * 512;
    int* lcnt = (int*)(lds + 16384); int* lbase = lcnt + 32;
    const float* g1 = p.ln1_g + l * DM; const float* b1 = p.ln1_b + l * DM;
    const float* rw = p.rwT + (size_t)l * NE * 1024; const float* rb = p.router_b + l * NE;
    unsigned* gcount = p.ctrl + 64 + l * NE;
    for (int grp = blockIdx.x; grp < NTOK / 128; grp += gridDim.x) {
        const int tok0 = grp * 128 + wid * 16;
        if (tid < 32) lcnt[tid] = 0;
        float4 gg[4], bb[4];
#pragma unroll
        for (int j = 0; j < 4; ++j) { gg[j] = *(const float4*)(g1 + j * 256 + lane * 4); bb[j] = *(const float4*)(b1 + j * 256 + lane * 4); }
        for (int r0 = 0; r0 < 16; r0 += 4) {
            float4 v[4][4]; float s[4], qv[4];
#pragma unroll
            for (int i = 0; i < 4; ++i)
#pragma unroll
                for (int j = 0; j < 4; ++j) { const u32x2 w = *(const u32x2*)((const bf16_t*)p.tbuf + (size_t)(tok0 + r0 + i) * DM + j * 256 + lane * 4);
                    v[i][j] = make_float4(__uint_as_float(w.x << 16), __uint_as_float(w.x & 0xffff0000u), __uint_as_float(w.y << 16), __uint_as_float(w.y & 0xffff0000u)); }
#pragma unroll
            for (int i = 0; i < 4; ++i) { s[i] = 0.f;
#pragma unroll
                for (int j = 0; j < 4; ++j) s[i] += (v[i][j].x + v[i][j].y) + (v[i][j].z + v[i][j].w); }
#pragma unroll
            for (int o = 32; o > 0; o >>= 1) {
#pragma unroll
                for (int i = 0; i < 4; ++i) s[i] += shfl_f(s[i], lane ^ o); }
#pragma unroll
            for (int i = 0; i < 4; ++i) { const float mean = s[i] * (1.0f / 1024.0f); qv[i] = 0.f;
#pragma unroll
                for (int j = 0; j < 4; ++j) { v[i][j].x -= mean; v[i][j].y -= mean; v[i][j].z -= mean; v[i][j].w -= mean; qv[i] += (v[i][j].x * v[i][j].x + v[i][j].y * v[i][j].y) + (v[i][j].z * v[i][j].z + v[i][j].w * v[i][j].w); } }
#pragma unroll
            for (int o = 32; o > 0; o >>= 1) {
#pragma unroll
                for (int i = 0; i < 4; ++i) qv[i] += shfl_f(qv[i], lane ^ o); }
#pragma unroll
            for (int i = 0; i < 4; ++i) {
                const float rstd = rsqrtf(qv[i] * (1.0f / 1024.0f) + LN_EPS);
                const size_t row = (size_t)(tok0 + r0 + i);
#pragma unroll
                for (int j = 0; j < 4; ++j) {
                    const int c = j * 256 + lane * 4;
                    float4 y; y.x = v[i][j].x * rstd * gg[j].x + bb[j].x; y.y = v[i][j].y * rstd * gg[j].y + bb[j].y; y.z = v[i][j].z * rstd * gg[j].z + bb[j].z; y.w = v[i][j].w * rstd * gg[j].w + bb[j].w;
                    { u32x2 w; w.x = pack2(y.x, y.y); w.y = pack2(y.z, y.w); *(u32x2*)((bf16_t*)p.x1f + row * DM + c) = w; }
                    *(unsigned*)((char*)p.x1b + row * DM + c) = pack4_fp8(y.x, y.y, y.z, y.w);
                }
            }
        }
        __syncthreads();
        f32x4 a0 = (f32x4){0.f, 0.f, 0.f, 0.f}, a1 = a0;
        const bf16_t* xr = (const bf16_t*)p.x1f + (size_t)(tok0 + fr) * DM + 4 * fq;
        const float* w0 = rw + (size_t)fr * 1024 + 4 * fq; const float* w1 = rw + (size_t)(16 + fr) * 1024 + 4 * fq;
#pragma unroll 4
        for (int k0 = 0; k0 < 1024; k0 += 16) {
            const u32x2 xw = *(const u32x2*)(xr + k0); const float4 wb0 = *(const float4*)(w0 + k0), wb1 = *(const float4*)(w1 + k0);
            const float4 xa = make_float4(__uint_as_float(xw.x << 16), __uint_as_float(xw.x & 0xffff0000u), __uint_as_float(xw.y << 16), __uint_as_float(xw.y & 0xffff0000u));
            a0 = __builtin_amdgcn_mfma_f32_16x16x4f32(xa.x, wb0.x, a0, 0, 0, 0); a1 = __builtin_amdgcn_mfma_f32_16x16x4f32(xa.x, wb1.x, a1, 0, 0, 0);
            a0 = __builtin_amdgcn_mfma_f32_16x16x4f32(xa.y, wb0.y, a0, 0, 0, 0); a1 = __builtin_amdgcn_mfma_f32_16x16x4f32(xa.y, wb1.y, a1, 0, 0, 0);
            a0 = __builtin_amdgcn_mfma_f32_16x16x4f32(xa.z, wb0.z, a0, 0, 0, 0); a1 = __builtin_amdgcn_mfma_f32_16x16x4f32(xa.z, wb1.z, a1, 0, 0, 0);
            a0 = __builtin_amdgcn_mfma_f32_16x16x4f32(xa.w, wb0.w, a0, 0, 0, 0); a1 = __builtin_amdgcn_mfma_f32_16x16x4f32(xa.w, wb1.w, a1, 0, 0, 0);
        }
#pragma unroll
        for (int r = 0; r < 4; ++r) { lg[(fq * 4 + r) * 32 + fr] = a0[r] + rb[fr]; lg[(fq * 4 + r) * 32 + 16 + fr] = a1[r] + rb[16 + fr]; }
        lds_wave_sync();
        int e4[4] = {0, 0, 0, 0}; int rk[4] = {0, 0, 0, 0};
        if (lane < 16) {
            const float* my = lg + lane * 32; unsigned taken = 0u; float tv[4];
#pragma unroll
            for (int k = 0; k < 4; ++k) {
                float best = NEG_INF; int bi = 0;
                for (int e = 0; e < 32; ++e) { const float xv = my[e]; if (!((taken >> e) & 1u) && xv > best) { best = xv; bi = e; } }
                taken |= 1u << bi; e4[k] = bi; tv[k] = best;
            }
            const float e1 = __expf(tv[1] - tv[0]), e2 = __expf(tv[2] - tv[0]), e3 = __expf(tv[3] - tv[0]);
            const float inv = 1.0f / (1.0f + e1 + e2 + e3);
            const size_t row = (size_t)(tok0 + lane);
            *(float4*)(p.gw + row * 4) = make_float4(inv, e1 * inv, e2 * inv, e3 * inv);
        }
        __syncthreads();
        if (lane < 16) {
#pragma unroll
            for (int k = 0; k < 4; ++k) rk[k] = atomicAdd(&lcnt[e4[k]], 1);
        }
        __syncthreads();
        if (tid < 32) { const int c = lcnt[tid]; lbase[tid] = c ? (int)__hip_atomic_fetch_add(gcount + tid, (unsigned)c, __ATOMIC_RELAXED, __HIP_MEMORY_SCOPE_AGENT) : 0; }
        __syncthreads();
        if (lane < 16) {
            const int row = tok0 + lane; int pk[4];
#pragma unroll
            for (int k = 0; k < 4; ++k) { const int pos = lbase[e4[k]] + rk[k]; p.lists[(size_t)e4[k] * LIST_CAP + pos] = row * 4 + k; pk[k] = (pos << 5) | e4[k]; }
            *(int4*)(p.top_e + (size_t)row * 4) = make_int4(pk[0], pk[1], pk[2], pk[3]);
        }
        __syncthreads();
    }
}

__device__ __forceinline__ void phase_ln2(const Params& p, int l, float* xout, char* lds) {
    int* ptile = (int*)(lds + LDS_TAB); int* ecnt = ptile + 40;
    build_tiles(p, l, ptile, ecnt);
    int tid = threadIdx.x; asm volatile("" : "+v"(tid));
    const int wid = tid >> 6, lane = tid & 63;
    const float* g2 = p.ln2_g + l * DM; const float* b2 = p.ln2_b + l * DM;
    float4 gg[4], bb[4];
#pragma unroll
    for (int j = 0; j < 4; ++j) { gg[j] = *(const float4*)(g2 + j * 256 + lane * 4); bb[j] = *(const float4*)(b2 + j * 256 + lane * 4); }
    for (int pr = blockIdx.x * NWV + wid; pr < NTOK / 2; pr += gridDim.x * NWV) {
        float4 v[2][4]; float s[2], qv[2];
        u32x2 yv[2][4][4]; float gk[2][4];
#pragma unroll
        for (int i = 0; i < 2; ++i) {
            const int row = pr * 2 + i;
            const float4 gwv = *(const float4*)(p.gw + (size_t)row * 4);
            gk[i][0] = gwv.x; gk[i][1] = gwv.y; gk[i][2] = gwv.z; gk[i][3] = gwv.w;
            const int4 te = *(const int4*)(p.top_e + (size_t)row * 4);
            const int tk[4] = {te.x, te.y, te.z, te.w};
#pragma unroll
            for (int j = 0; j < 4; ++j) { const u32x2 w = *(const u32x2*)((const bf16_t*)p.x1f + (size_t)row * DM + j * 256 + lane * 4);
                v[i][j] = make_float4(__uint_as_float(w.x << 16), __uint_as_float(w.x & 0xffff0000u), __uint_as_float(w.y << 16), __uint_as_float(w.y & 0xffff0000u)); }
#pragma unroll
            for (int k = 0; k < 4; ++k) {
                const bf16_t* yr = p.ybuf + (size_t)(ptile[tk[k] & 31] * 256 + (tk[k] >> 5)) * DM + lane * 4;
#pragma unroll
                for (int j = 0; j < 4; ++j) yv[i][k][j] = *(const u32x2*)(yr + j * 256);
            }
        }
#pragma unroll
        for (int i = 0; i < 2; ++i) { s[i] = 0.f;
#pragma unroll
            for (int j = 0; j < 4; ++j) {
                float4 a; a.x = v[i][j].x * ALPHA; a.y = v[i][j].y * ALPHA; a.z = v[i][j].z * ALPHA; a.w = v[i][j].w * ALPHA;
#pragma unroll
                for (int k = 0; k < 4; ++k) {
                    const u32x2 w = yv[i][k][j];
                    a.x += gk[i][k] * __uint_as_float(w.x << 16); a.y += gk[i][k] * __uint_as_float(w.x & 0xffff0000u);
                    a.z += gk[i][k] * __uint_as_float(w.y << 16); a.w += gk[i][k] * __uint_as_float(w.y & 0xffff0000u);
                }
                v[i][j] = a; s[i] += (a.x + a.y) + (a.z + a.w);
            } }
#pragma unroll
        for (int o = 32; o > 0; o >>= 1) { s[0] += shfl_f(s[0], lane ^ o); s[1] += shfl_f(s[1], lane ^ o); }
#pragma unroll
        for (int i = 0; i < 2; ++i) { const float mean = s[i] * (1.0f / 1024.0f); qv[i] = 0.f;
#pragma unroll
            for (int j = 0; j < 4; ++j) { v[i][j].x -= mean; v[i][j].y -= mean; v[i][j].z -= mean; v[i][j].w -= mean; qv[i] += (v[i][j].x * v[i][j].x + v[i][j].y * v[i][j].y) + (v[i][j].z * v[i][j].z + v[i][j].w * v[i][j].w); } }
#pragma unroll
        for (int o = 32; o > 0; o >>= 1) { qv[0] += shfl_f(qv[0], lane ^ o); qv[1] += shfl_f(qv[1], lane ^ o); }
#pragma unroll
        for (int i = 0; i < 2; ++i) {
            const float rstd = rsqrtf(qv[i] * (1.0f / 1024.0f) + LN_EPS);
            const size_t row = (size_t)(pr * 2 + i);
#pragma unroll
            for (int j = 0; j < 4; ++j) {
                const int c = j * 256 + lane * 4;
                float4 y; y.x = v[i][j].x * rstd * gg[j].x + bb[j].x; y.y = v[i][j].y * rstd * gg[j].y + bb[j].y; y.z = v[i][j].z * rstd * gg[j].z + bb[j].z; y.w = v[i][j].w * rstd * gg[j].w + bb[j].w;
                *(float4*)(xout + row * DM + c) = y;
                u32x2 w; w.x = pack2(y.x, y.y); w.y = pack2(y.z, y.w);
                *(u32x2*)(p.xb + row * DM + c) = w;
            }
        }
    }
}

#define XB_TMO      128
#define XB_XCNT(j)  (256  + 64 * (j))
#define XB_XSUB(j)  (1280 + 64 * (j))
#define XB_XGEN(j)  (2304 + 64 * (j))
#define XB_TOP      3328
#define XB_TOPGEN   3392
#define XCD_BAR_WORDS 3456
#define XB_SPIN_CAP (1u << 22)
__device__ __forceinline__ unsigned xb_ld(unsigned* p)              { return __hip_atomic_load(p, __ATOMIC_RELAXED, __HIP_MEMORY_SCOPE_AGENT); }
__device__ __forceinline__ unsigned xb_add(unsigned* p, unsigned v) { return __hip_atomic_fetch_add(p, v, __ATOMIC_RELAXED, __HIP_MEMORY_SCOPE_AGENT); }
__device__ __forceinline__ unsigned xb_xcc_id() { return (unsigned)__builtin_amdgcn_s_getreg((3 << 11) | 20) & 0xFu; }
#define XB_SPIN(cond, bar) do { unsigned _sp = 0; while (cond) { __builtin_amdgcn_s_sleep(1); \
    if ((++_sp & 255u) == 0u) { if (xb_ld(&(bar)[XB_TMO])) break; if (_sp > XB_SPIN_CAP) { atomicAdd(&(bar)[XB_TMO], 1u); break; } } } } while (0)
struct XcdBarrier { unsigned* bar; unsigned x; volatile LAS unsigned* st; };
__device__ __forceinline__ XcdBarrier xcd_barrier_post(unsigned* bar, volatile LAS unsigned* st) {
    XcdBarrier b; b.bar = bar; b.x = xb_xcc_id(); b.st = st;
    if (threadIdx.x == 0) (void)xb_add(&bar[XB_XCNT(b.x)], 1u);
    return b;
}
__device__ __forceinline__ void xcd_barrier_complete(unsigned* bar, unsigned x, unsigned& nloc, unsigned& nx) {
    const unsigned G = gridDim.x * gridDim.y * gridDim.z;
    unsigned sum, cnt, mine, sp = 0u;
    for (;;) {
        sum = 0u; cnt = 0u; mine = 0u;
#pragma unroll
        for (unsigned j = 0; j < 16; ++j) { const unsigned c = xb_ld(&bar[XB_XCNT(j)]); sum += c; cnt += (c > 0u) ? 1u : 0u; mine = (j == x) ? c : mine; }
        if (sum == G) break;
        __builtin_amdgcn_s_sleep(1);
        if ((++sp & 255u) == 0u) { if (xb_ld(&bar[XB_TMO])) break; if (sp > XB_SPIN_CAP) { atomicAdd(&bar[XB_TMO], 1u); break; } }
    }
    nloc = mine > 0u ? mine : 1u; nx = cnt > 0u ? cnt : 1u;
}
__device__ __forceinline__ void xcd_barrier(const XcdBarrier& b) {
    asm volatile("s_waitcnt vmcnt(0)" ::: "memory");
    __syncthreads();
    if (threadIdx.x == 0) {
        unsigned* bar = b.bar;
        __builtin_amdgcn_s_waitcnt(0);
        unsigned nloc = b.st[0], nx = b.st[1];
        if (nloc == 0u) { xcd_barrier_complete(bar, b.x, nloc, nx); b.st[0] = nloc; b.st[1] = nx; }
        const unsigned old = xb_add(&bar[XB_XSUB(b.x)], 1u);
        const unsigned gen = old / nloc;
        if (old + 1u == (gen + 1u) * nloc) {
            __builtin_amdgcn_fence(__ATOMIC_RELEASE, "agent");
            asm volatile("s_waitcnt vmcnt(0)" ::: "memory");
            const unsigned og = xb_add(&bar[XB_TOP], 1u);
            const unsigned tg = og / nx;
            if (og + 1u == (tg + 1u) * nx) xb_add(&bar[XB_TOPGEN], 1u);
            else XB_SPIN(xb_ld(&bar[XB_TOPGEN]) == tg, bar);
            __builtin_amdgcn_fence(__ATOMIC_ACQUIRE, "agent");
            xb_add(&bar[XB_XGEN(b.x)], 1u);
            asm volatile("s_waitcnt vmcnt(0)" ::: "memory");
        } else {
            XB_SPIN(xb_ld(&bar[XB_XGEN(b.x)]) == gen, bar);
            __builtin_amdgcn_fence(__ATOMIC_ACQUIRE, "agent");
            asm volatile("s_waitcnt vmcnt(0)" ::: "memory");
        }
    }
    __syncthreads();
}

struct KArgs { const float* in[18]; float* out; char* ws; };
constexpr size_t al256(size_t v) { return (v + 255) / 256 * 256; }
struct WSL {
    static constexpr size_t ctrl = 0;
    static constexpr size_t WinT = al256(ctrl + 65536);
    static constexpr size_t WoT = al256(WinT + (size_t)NL * NPAD * 1024 * 2);
    static constexpr size_t W1T = al256(WoT + (size_t)NL * 1024 * 1024 * 2);
    static constexpr size_t W2T = al256(W1T + (size_t)NL * 2 * 64 * 2048 * 2);
    static constexpr size_t WguT = al256(W2T + (size_t)NL * 2 * 64 * 64 * 2);
    static constexpr size_t WdnT = al256(WguT + (size_t)NL * NE * 2048 * 1024 * 2);
    static constexpr size_t rwT = al256(WdnT + (size_t)NL * NE * 1024 * 1024 * 2);
    static constexpr size_t binp = al256(rwT + (size_t)NL * NE * 1024 * 4);
    static constexpr size_t bgup = al256(binp + (size_t)NL * NPAD * 4);
    static constexpr size_t b1c = al256(bgup + (size_t)NL * NE * 2048 * 4);
    static constexpr size_t xf = al256(b1c + 4 * 64 * 4);
    static constexpr size_t xb = al256(xf + (size_t)NTOK * DM * 4);
    static constexpr size_t hb = al256(xb + (size_t)NTOK * DM * 2);
    static constexpr size_t hs = al256(hb + (size_t)NTOK * NMAIN * 2);
    static constexpr size_t vT = al256(hs + (size_t)NTOK * HS_W * 4);
    static constexpr size_t kF = al256(vT + (size_t)NB * NVH * 64 * SEQ * 2);
    static constexpr size_t cF = al256(kF + (size_t)NB * NVH * 64 * SEQ * 2);
    static constexpr size_t kc = al256(cF + (size_t)NB * 4 * SEQ * 4);
    static constexpr size_t vc = al256(kc + (size_t)NB * 2 * 128 * 64 * 2);
    static constexpr size_t vcT = al256(vc + (size_t)NB * 2 * 128 * 64 * 2);
    static constexpr size_t ob = al256(vcT + (size_t)NB * 2 * 128 * 64 * 2);
    static constexpr size_t tbuf = al256(ob + (size_t)NTOK * DM * 2);
    static constexpr size_t x1f = al256(tbuf + (size_t)NTOK * DM * 4);
    static constexpr size_t x1b = al256(x1f + (size_t)NTOK * DM * 4);
    static constexpr size_t top_e = al256(x1b + (size_t)NTOK * DM * 2);
    static constexpr size_t gw = al256(top_e + (size_t)NTOK * 4 * 4);
    static constexpr size_t lists = al256(gw + (size_t)NTOK * 4 * 4);
    static constexpr size_t act = al256(lists + (size_t)NE * LIST_CAP * 4);
    static constexpr size_t ybuf = al256(act + (size_t)MAXSLOT * DFF * 2);
    static constexpr size_t total = al256(ybuf + (size_t)MAXSLOT * DM * 2);
};
__device__ __forceinline__ Params make_params(const KArgs& k) {
    Params p;
    p.x = k.in[0]; p.w_in = k.in[1]; p.b_in = k.in[2]; p.sinks = k.in[3]; p.cmp_pe = k.in[4]; p.cmp_w1 = k.in[5]; p.cmp_w2 = k.in[6]; p.w_out = k.in[7];
    p.ln1_g = k.in[8]; p.ln1_b = k.in[9]; p.router_w = k.in[10]; p.router_b = k.in[11]; p.w_gu = k.in[12]; p.b_gu = k.in[13]; p.w_dn = k.in[14]; p.b_dn = k.in[15];
    p.ln2_g = k.in[16]; p.ln2_b = k.in[17]; p.out = k.out;
    char* w = k.ws;
    p.ctrl = (unsigned*)(w + WSL::ctrl); p.WinT = (bf16_t*)(w + WSL::WinT); p.WoT = (bf16_t*)(w + WSL::WoT); p.W1T = (bf16_t*)(w + WSL::W1T); p.W2T = (bf16_t*)(w + WSL::W2T);
    p.WguT = (bf16_t*)(w + WSL::WguT); p.WdnT = (bf16_t*)(w + WSL::WdnT); p.rwT = (float*)(w + WSL::rwT); p.binp = (float*)(w + WSL::binp); p.bgup = (float*)(w + WSL::bgup);
    p.b1c = (float*)(w + WSL::b1c); p.xf = (float*)(w + WSL::xf); p.xb = (bf16_t*)(w + WSL::xb); p.hb = (bf16_t*)(w + WSL::hb); p.hs = (float*)(w + WSL::hs); p.vT = (bf16_t*)(w + WSL::vT); p.kF = (bf16_t*)(w + WSL::kF);
    p.cF = (float*)(w + WSL::cF); p.kc = (bf16_t*)(w + WSL::kc); p.vc = (bf16_t*)(w + WSL::vc); p.vcT = (bf16_t*)(w + WSL::vcT); p.ob = (bf16_t*)(w + WSL::ob); p.tbuf = (float*)(w + WSL::tbuf);
    p.x1f = (float*)(w + WSL::x1f); p.x1b = (bf16_t*)(w + WSL::x1b); p.top_e = (int*)(w + WSL::top_e); p.gw = (float*)(w + WSL::gw); p.lists = (int*)(w + WSL::lists);
    p.act = (bf16_t*)(w + WSL::act); p.ybuf = (bf16_t*)(w + WSL::ybuf);
    return p;
}
__device__ __forceinline__ void grid_bar(const Params& p, char* lds) {
    XcdBarrier xb; xb.bar = p.ctrl + 1024; xb.x = xb_xcc_id(); xb.st = (volatile LAS unsigned*)(lds + LDS_BYTES - 16); xcd_barrier(xb);
}
__device__ __forceinline__ Params fresh_params(const KArgs& ka) {
    KArgs k2 = ka; asm volatile("" : "+s"(k2.ws));
    return make_params(k2);
}
#ifndef REP
#define REP 0
#endif
template <int L>
__device__ __forceinline__ void layer_fwd(const KArgs& ka, char* lds) {
    { const Params p = fresh_params(ka); phase_inproj(p, L, lds);        grid_bar(p, lds); }
    { const Params p = fresh_params(ka); phase_prep(p, L, lds);          grid_bar(p, lds); }
    { const Params p = fresh_params(ka); phase_attn<L == 0>(p, L, lds);  grid_bar(p, lds); }
    { const Params p = fresh_params(ka); phase_outproj(p, L, L == 0 ? p.x : p.xf, lds);  grid_bar(p, lds); }
    { const Params p = fresh_params(ka); phase_ln1_router(p, L, lds);    grid_bar(p, lds); }
    { const Params p = fresh_params(ka); phase_gateup(p, L, lds);        grid_bar(p, lds); }
    { const Params p = fresh_params(ka); phase_down(p, L, lds);          grid_bar(p, lds); }
    { const Params p = fresh_params(ka); phase_ln2(p, L, L == NL - 1 ? p.out : p.xf, lds); }
}
__global__ void __launch_bounds__(NTHR, 2) fwd_kernel(KArgs ka) {
    extern __shared__ __attribute__((aligned(16))) char lds[];
    const Params p = make_params(ka);
    cg::grid_group grid = cg::this_grid();
    volatile LAS unsigned* xst = (volatile LAS unsigned*)(lds + LDS_BYTES - 16);
    if (threadIdx.x == 0) { xst[0] = 0u; xst[1] = 0u; }
    __syncthreads();
    (void)xcd_barrier_post(p.ctrl + 1024, xst);
    phase0(p, lds);
    if (REP & 128) { grid_bar(p, lds); phase0(p, lds); }
    grid.sync();
    layer_fwd<0>(ka, lds);
    grid_bar(p, lds);
    layer_fwd<1>(ka, lds);
}

extern "C" void kernel_launch(void* const* d_in, const int* in_sizes, int n_in, void* d_out, int out_size, void* d_ws, size_t ws_size, hipStream_t stream) {
    KArgs ka{};
    for (int i = 0; i < 18; ++i) ka.in[i] = (const float*)d_in[i];
    ka.out = (float*)d_out; ka.ws = (char*)d_ws;
    if (WSL::total > ws_size) { fprintf(stderr, "workspace too small: need %zu have %zu\n", (size_t)WSL::total, ws_size); return; }
    static int grid_blocks = 0;
    if (!grid_blocks) {
        int dev = 0, cus = 0, per_cu = 0;
        (void)hipGetDevice(&dev);
        (void)hipDeviceGetAttribute(&cus, hipDeviceAttributeMultiprocessorCount, dev);
        (void)hipFuncSetAttribute((const void*)fwd_kernel, hipFuncAttributeMaxDynamicSharedMemorySize, LDS_BYTES);
        (void)hipOccupancyMaxActiveBlocksPerMultiprocessor(&per_cu, fwd_kernel, NTHR, LDS_BYTES);
        if (per_cu < 1) { fprintf(stderr, "occupancy query says 0 blocks per CU\n"); per_cu = 1; }
        grid_blocks = cus;
    }
    (void)hipMemsetAsync(d_ws, 0, 65536, stream);
    void* args[] = {&ka};
    hipError_t e = hipLaunchCooperativeKernel((const void*)fwd_kernel, dim3(grid_blocks), dim3(NTHR), args, LDS_BYTES, stream);
    if (e != hipSuccess) fprintf(stderr, "cooperative launch failed: %s (grid %d)\n", hipGetErrorString(e), grid_blocks);
}
```

```cpp
#include <hip/hip_runtime.h>
#include <hip/hip_cooperative_groups.h>
#include <cstdio>
#include <cstdint>
namespace cg = cooperative_groups;

typedef unsigned short bf16_t;
typedef short bf16x8 __attribute__((ext_vector_type(8)));
typedef float f32x4 __attribute__((ext_vector_type(4)));
typedef unsigned u32x4 __attribute__((ext_vector_type(4)));
typedef unsigned u32x2 __attribute__((ext_vector_type(2)));
typedef int v8i_t __attribute__((ext_vector_type(8)));
typedef float f32x2_t __attribute__((ext_vector_type(2)));
typedef int v4i_t __attribute__((ext_vector_type(4)));
#define LAS __attribute__((address_space(3)))
constexpr float NEG_INF = -__builtin_huge_valf();

constexpr int DM = 1024, NB = 16, SEQ = 2048, NTOK = NB * SEQ, NL = 2;
constexpr int NCOL = 2582, NMAIN = 2560, NPAD = 2688, NE = 32, DFF = 1024;
constexpr int C_FQ = 0, C_FK = 256, C_FV = 512, C_SQ = 768, C_SK = 1152, C_SV = 1280, C_NQ = 1408,
              C_NKC = 1792, C_NVC = 1920, C_NKS = 2048, C_NVS = 2176, C_NKW = 2304, C_NVW = 2432;
constexpr int HS_W = 32;
constexpr int NVH = 10;
constexpr int LIST_CAP = NTOK;
constexpr int MAXSLOT = NTOK * 4 + NE * 256;
constexpr float ALPHA = 1.41421356237f, LN_EPS = 1e-5f, QSCALE = 0.125f;
constexpr int NWV = 8, NTHR = NWV * 64;
constexpr int LDS_STAGE = 131072, LDS_TAB = LDS_STAGE, LDS_AOFF = LDS_STAGE + 2048, LDS_BYTES = LDS_AOFF + 20480 + 256;

struct Params {
    const float *x, *w_in, *b_in, *sinks, *cmp_pe, *cmp_w1, *cmp_w2, *w_out, *ln1_g, *ln1_b, *router_w, *router_b,
                *w_gu, *b_gu, *w_dn, *b_dn, *ln2_g, *ln2_b;
    float* out;
    unsigned* ctrl;
    bf16_t *WinT, *WoT, *W1T, *W2T, *WguT, *WdnT;
    float *rwT, *binp, *bgup, *b1c;
    float* xf; bf16_t* xb; bf16_t* hb; float* hs; bf16_t* vT; bf16_t* kF; float* cF;
    bf16_t *kc, *vc, *vcT; bf16_t* ob; float* tbuf; float* x1f; bf16_t* x1b;
    int* top_e; float* gw; int* lists; bf16_t* act; bf16_t* ybuf;
};

__device__ __forceinline__ float bf2f(bf16_t h) { return __uint_as_float(((unsigned)h) << 16); }
typedef __bf16 bf16x2_t __attribute__((ext_vector_type(2)));
__device__ __forceinline__ bf16_t f2bf(float f) { return __builtin_bit_cast(bf16_t, (__bf16)f); }
__device__ __forceinline__ unsigned pack2(float lo, float hi) { bf16x2_t v = {(__bf16)lo, (__bf16)hi}; return __builtin_bit_cast(unsigned, v); }
__device__ __forceinline__ unsigned pack4_fp8(float a, float b, float c, float d) {
    unsigned w = 0u;
    w = __builtin_amdgcn_cvt_pk_fp8_f32(a, b, w, false);
    w = __builtin_amdgcn_cvt_pk_fp8_f32(c, d, w, true);
    return w;
}
__device__ __forceinline__ float shfl_f(float v, int src_lane) { return __int_as_float(__builtin_amdgcn_ds_bpermute(src_lane << 2, __float_as_int(v))); }
__device__ __forceinline__ unsigned shfl_u(unsigned v, int src_lane) { return (unsigned)__builtin_amdgcn_ds_bpermute(src_lane << 2, (int)v); }
__device__ __forceinline__ float wave_sum(float v) {
#pragma unroll
    for (int o = 32; o > 0; o >>= 1) v += __shfl_xor(v, o);
    return v;
}
__device__ __forceinline__ float wave_max(float v) {
#pragma unroll
    for (int o = 32; o > 0; o >>= 1) v = fmaxf(v, __shfl_xor(v, o));
    return v;
}
__device__ __forceinline__ void lds_wave_sync() { asm volatile("s_waitcnt lgkmcnt(0)" ::: "memory"); __builtin_amdgcn_wave_barrier(); }
__device__ __forceinline__ float slope_swa(int hq) { return exp2f(-8.0f * (float)(2 * hq + 1) / 12.0f); }
__device__ __forceinline__ float slope_nsa(int hq) { return exp2f(-8.0f * (float)(2 * hq + 2) / 12.0f); }

__device__ __forceinline__ int perm_row(int perm, int n) {
    if (perm == 1) { if (n < 768) return n; if (n < 772) return 2560 + (n - 768); if (n < 2564) return n - 4; return n; }
    if (perm == 2) { const int f = n >> 1, s = n & 1; return (f >> 7) * 256 + s * 128 + (f & 127); }
    return n;
}
struct ConvJob { const float* src; bf16_t* dst; int K, N, kt, nt, perm; float q8; };
__device__ __forceinline__ bool conv_job(const Params& p, int t, ConvJob& jb) {
    constexpr int T_WIN = NL * 8 * 21, T_WO = NL * 8 * 8;
    if (t < T_WIN) { const int m = t / 168, r = t % 168; jb = ConvJob{p.w_in + (size_t)m * 1024 * NCOL, p.WinT + (size_t)m * NPAD * 1024, 1024, NCOL, r / 21, r % 21, 1, 0.f}; return true; }
    t -= T_WIN;
    if (t < T_WO) { const int m = t / 64, r = t % 64; jb = ConvJob{p.w_out + (size_t)m * 1024 * 1024, (bf16_t*)((char*)p.WoT + (size_t)m * 1024 * 1024), 1024, 1024, r / 8, r % 8, 0, 64.0f}; return true; }
    return false;
}
constexpr int CONV_TILES = NL * NE * 192;
__device__ __forceinline__ void conv_tile_wave(const Params& p, int t, int lane, unsigned char* l8) {
    asm volatile("" : "+v"(lane));
    const int m = t / 192, r = t % 192;
    const float* src; unsigned char* dst; int N, kt, nt, perm;
    if (r < 128) { src = p.w_gu + (size_t)m * 1024 * 2048; dst = (unsigned char*)p.WguT + (size_t)m * 2048 * 1024; N = 2048; kt = r >> 4; nt = r & 15; perm = 2; }
    else { const int q = r - 128; src = p.w_dn + (size_t)m * 1024 * 1024; dst = (unsigned char*)p.WdnT + (size_t)m * 1024 * 1024; N = 1024; kt = q >> 3; nt = q & 7; perm = 0; }
    const float* s = src + (size_t)(kt * 128 + (lane >> 5)) * N + nt * 128 + (lane & 31) * 4;
    unsigned char* lw = l8 + (lane >> 5) * 132 + (lane & 31) * 4;
    float4 va[16], vb[16];
#pragma unroll
    for (int i = 0; i < 16; ++i) va[i] = *(const float4*)(s + (size_t)(2 * i) * N);
#pragma unroll
    for (int i = 0; i < 16; ++i) vb[i] = *(const float4*)(s + (size_t)(32 + 2 * i) * N);
#pragma unroll
    for (int i = 0; i < 16; ++i) *(unsigned*)(lw + (2 * i) * 132) = pack4_fp8(va[i].x * 64.0f, va[i].y * 64.0f, va[i].z * 64.0f, va[i].w * 64.0f);
#pragma unroll
    for (int i = 0; i < 16; ++i) va[i] = *(const float4*)(s + (size_t)(64 + 2 * i) * N);
#pragma unroll
    for (int i = 0; i < 16; ++i) *(unsigned*)(lw + (32 + 2 * i) * 132) = pack4_fp8(vb[i].x * 64.0f, vb[i].y * 64.0f, vb[i].z * 64.0f, vb[i].w * 64.0f);
#pragma unroll
    for (int i = 0; i < 16; ++i) vb[i] = *(const float4*)(s + (size_t)(96 + 2 * i) * N);
#pragma unroll
    for (int i = 0; i < 16; ++i) *(unsigned*)(lw + (64 + 2 * i) * 132) = pack4_fp8(va[i].x * 64.0f, va[i].y * 64.0f, va[i].z * 64.0f, va[i].w * 64.0f);
#pragma unroll
    for (int i = 0; i < 16; ++i) *(unsigned*)(lw + (96 + 2 * i) * 132) = pack4_fp8(vb[i].x * 64.0f, vb[i].y * 64.0f, vb[i].z * 64.0f, vb[i].w * 64.0f);
    lds_wave_sync();
#pragma unroll 4
    for (int i = 0; i < 16; ++i) {
        const int idx = lane + 64 * i, kc = idx & 7, nn = idx >> 3;
        const unsigned char* l = l8 + (kc * 16) * 132 + nn;
        u32x4 w;
        w.x = (unsigned)l[0] | ((unsigned)l[132] << 8) | ((unsigned)l[264] << 16) | ((unsigned)l[396] << 24);
        w.y = (unsigned)l[528] | ((unsigned)l[660] << 8) | ((unsigned)l[792] << 16) | ((unsigned)l[924] << 24);
        w.z = (unsigned)l[1056] | ((unsigned)l[1188] << 8) | ((unsigned)l[1320] << 16) | ((unsigned)l[1452] << 24);
        w.w = (unsigned)l[1584] | ((unsigned)l[1716] << 8) | ((unsigned)l[1848] << 16) | ((unsigned)l[1980] << 24);
        *(u32x4*)(dst + (size_t)perm_row(perm, nt * 128 + nn) * 1024 + kt * 128 + kc * 16) = w;
    }
    lds_wave_sync();
}
__device__ __forceinline__ void conv_load(const ConvJob& jb, int tid, float2 (&v)[16]) {
    const int n = jb.nt * 128 + (tid & 31) * 4;
    const float* s = jb.src + (size_t)(jb.kt * 128 + (tid >> 5)) * jb.N + n;
#pragma unroll
    for (int i = 0; i < 8; ++i) {
        const float* r = s + (size_t)(16 * i) * jb.N;
        v[2 * i] = (n + 1 < jb.N) ? *(const float2*)r : make_float2(0.f, 0.f);
        v[2 * i + 1] = (n + 3 < jb.N) ? *(const float2*)(r + 2) : make_float2(0.f, 0.f);
    }
}
__device__ __forceinline__ void phase0(const Params& p, char* ldsc) {
    int tid = threadIdx.x; asm volatile("" : "+v"(tid));
    const int G = gridDim.x, bid = blockIdx.x;
    const size_t gtid = (size_t)bid * NTHR + tid, gthreads = (size_t)G * NTHR;
    {
        constexpr int TOT = NL * 8 * 21 + NL * 8 * 8;
        bf16_t* lt = (bf16_t*)ldsc;
        ConvJob jb, jn; float2 v[16], vn[16];
        int t = bid; bool have = t < TOT && conv_job(p, t, jb);
        if (have) conv_load(jb, tid, v);
        while (have) {
            const int tn = t + G; const bool hn = tn < TOT && conv_job(p, tn, jn);
            if (hn) conv_load(jn, tid, vn);
            if (jb.q8 != 0.f) {
                unsigned char* l8 = (unsigned char*)lt;
#pragma unroll
                for (int i = 0; i < 8; ++i)
                    *(unsigned*)(l8 + ((tid >> 5) + 16 * i) * 132 + (tid & 31) * 4) = pack4_fp8(v[2 * i].x * jb.q8, v[2 * i].y * jb.q8, v[2 * i + 1].x * jb.q8, v[2 * i + 1].y * jb.q8);
                __syncthreads();
#pragma unroll
                for (int i = 0; i < 2; ++i) {
                    const int idx = tid + NTHR * i, kc = idx & 7, nn = idx >> 3, n = jb.nt * 128 + nn;
                    const unsigned char* l = l8 + (kc * 16) * 132 + nn;
                    u32x4 w;
                    w.x = (unsigned)l[0] | ((unsigned)l[132] << 8) | ((unsigned)l[264] << 16) | ((unsigned)l[396] << 24);
                    w.y = (unsigned)l[528] | ((unsigned)l[660] << 8) | ((unsigned)l[792] << 16) | ((unsigned)l[924] << 24);
                    w.z = (unsigned)l[1056] | ((unsigned)l[1188] << 8) | ((unsigned)l[1320] << 16) | ((unsigned)l[1452] << 24);
                    w.w = (unsigned)l[1584] | ((unsigned)l[1716] << 8) | ((unsigned)l[1848] << 16) | ((unsigned)l[1980] << 24);
                    *(u32x4*)((char*)jb.dst + (size_t)perm_row(jb.perm, n) * jb.K + jb.kt * 128 + kc * 16) = w;
                }
            } else {
#pragma unroll
                for (int i = 0; i < 8; ++i) {
                    u32x2 w; w.x = pack2(v[2 * i].x, v[2 * i].y); w.y = pack2(v[2 * i + 1].x, v[2 * i + 1].y);
                    *(u32x2*)(lt + ((tid >> 5) + 16 * i) * 136 + (tid & 31) * 4) = w;
                }
                __syncthreads();
#pragma unroll
                for (int i = 0; i < 4; ++i) {
                    const int idx = tid + NTHR * i, kc = idx & 15, nn = idx >> 4, n = jb.nt * 128 + nn;
                    if (n < jb.N) {
                        const bf16_t* l = lt + (kc * 8) * 136 + nn;
                        u32x4 w;
                        w.x = (unsigned)l[0] | ((unsigned)l[136] << 16); w.y = (unsigned)l[272] | ((unsigned)l[408] << 16);
                        w.z = (unsigned)l[544] | ((unsigned)l[680] << 16); w.w = (unsigned)l[816] | ((unsigned)l[952] << 16);
                        *(u32x4*)(jb.dst + (size_t)perm_row(jb.perm, n) * jb.K + jb.kt * 128 + kc * 8) = w;
                    }
                }
            }
            __syncthreads();
            t = tn; have = hn; jb = jn;
#pragma unroll
            for (int i = 0; i < 16; ++i) v[i] = vn[i];
        }
    }
    for (size_t i = gtid; i < (size_t)NL * 2 * 2048 * 64; i += gthreads) {
        const int k = (int)(i % 2048), n = (int)((i / 2048) % 64), m = (int)(i / (2048 * 64));
        p.W1T[i] = f2bf(p.cmp_w1[((size_t)m * 2048 + k) * 64 + n]);
    }
    for (size_t i = gtid; i < (size_t)NL * 2 * 64 * 64; i += gthreads) {
        const int k = (int)(i % 64), n = (int)((i / 64) % 64), m = (int)(i / 4096);
        p.W2T[i] = f2bf(p.cmp_w2[((size_t)m * 64 + k) * 64 + n]);
    }
    for (size_t i = gtid; i < (size_t)NL * NPAD; i += gthreads) {
        const int l = (int)(i / NPAD), r = (int)(i % NPAD);
        float v = 0.f;
        if (r < 2560) { const int n = r < 768 ? r : r + 4; v = p.b_in[l * NCOL + n]; }
        else if (r < 2564) v = p.b_in[l * NCOL + 768 + (r - 2560)];
        else if (r < 2582) v = p.b_in[l * NCOL + r];
        p.binp[i] = v;
    }
    for (size_t i = gtid; i < (size_t)NL * NE * 2048; i += gthreads) {
        const int r = (int)(i % 2048); const size_t le = i / 2048;
        const int s = (r >> 7) & 1, f = (r >> 8) * 128 + (r & 127);
        p.bgup[i] = p.b_gu[le * 2048 + 2 * f + s];
    }
    for (size_t i = gtid; i < (size_t)NL * NE * 1024; i += gthreads) {
        const int k = (int)(i % 1024), e = (int)((i / 1024) % NE), l = (int)(i / (1024 * NE));
        p.rwT[i] = p.router_w[((size_t)l * 1024 + k) * NE + e];
    }
    for (size_t i = gtid; i < (size_t)NL * (NPAD - NCOL) * 1024; i += gthreads) {
        const int l = (int)(i / ((NPAD - NCOL) * 1024)); const size_t r = i % ((size_t)(NPAD - NCOL) * 1024);
        p.WinT[(size_t)l * NPAD * 1024 + (size_t)NCOL * 1024 + r] = 0;
    }
    for (size_t i = gtid; i < (size_t)NTOK * DM / 4; i += gthreads) {
        const float4 v4 = ((const float4*)p.x)[i];
        u32x2 w; w.x = pack2(v4.x, v4.y); w.y = pack2(v4.z, v4.w);
        ((u32x2*)p.xb)[i] = w;
    }
    if (bid < 4) {
        float* lf = (float*)ldsc;
        const int j = tid & 63, part = tid >> 6;
        const float* pe = p.cmp_pe + (size_t)bid * 2048; const float* w1 = p.cmp_w1 + (size_t)bid * 2048 * 64;
        float s = 0.f;
        for (int kk = part * 256; kk < part * 256 + 256; ++kk) s += pe[kk] * w1[(size_t)kk * 64 + j];
        lf[tid] = s; __syncthreads();
        if (tid < 64) { float a = 0.f; for (int q = 0; q < 8; ++q) a += lf[tid + 64 * q]; p.b1c[bid * 64 + tid] = a; }
        __syncthreads();
    }
}

namespace pg8 {
constexpr int BM = 256, BK = 64, HALF = 128, HTB = HALF * BK * 2, NXCD = 8, WGM = 8;
__device__ __forceinline__ int lds_byte(int r, int c) { const int st = (r >> 4) * 2 + (c >> 5), rr = r & 15, cc = c & 31, ob = rr * 64 + cc * 2; return st * 1024 + (ob ^ (((ob >> 9) & 1) << 5)); }
__device__ __forceinline__ void stage_rc(int b, int& R, int& C) { const int st = b / 1024, sb = b % 1024, swz = sb ^ (((sb >> 9) & 1) << 5); R = (st >> 1) * 16 + swz / 64; C = (st & 1) * 32 + (swz % 64) / 2; }
__device__ __forceinline__ bool tile_order(int i, int G, int c, int nM, int nN, int& pm, int& pn) {
    const int nwg = nM * nN; const long L = (long)i * G + c; if (L >= nwg) return false;
    int wgid = (int)L; { const int q = nwg / NXCD, r = nwg % NXCD, xcd = wgid % NXCD, off = wgid / NXCD; wgid = (xcd < r ? xcd * (q + 1) : r * (q + 1) + (xcd - r) * q) + off; }
    const int nig = WGM * nN, gid = wgid / nig, fm = gid * WGM, gsz = (nM - fm) < WGM ? (nM - fm) : WGM;
    pm = fm + ((wgid % nig) % gsz); pn = (wgid % nig) / gsz; return true;
}
template <bool FP8, int SCA, class Sched, class Epi>
__device__ __forceinline__ void gemm_phase(LAS unsigned char* lds, const char* Abase, int K, const Sched& S, const Epi& E) {
    int tid = threadIdx.x; asm volatile("" : "+v"(tid));
    const int wid = __builtin_amdgcn_readfirstlane(tid >> 6), lane = tid & 63, wr = wid >> 2, wc = wid & 3, fr = lane & 15, fq = lane >> 4;
    const int nt = K / BK;
    int R0, C0, R1, C1; stage_rc(tid * 16, R0, C0); stage_rc(tid * 16 + 8192, R1, C1);
    LAS unsigned* aofs = (LAS unsigned*)(lds + LDS_AOFF) + tid;
    unsigned rg[10];
    rg[8] = (unsigned)(R0 * K + C0) * 2u; rg[9] = (unsigned)(R1 * K + C1) * 2u;
    if constexpr (FP8) { aofs[8 * NTHR] = rg[8]; aofs[9 * NTHR] = rg[9]; }
    const size_t kstep = (size_t)(BK * 2), hstep = (size_t)HALF * K * 2;
    const unsigned ldsw = (unsigned)wid * 1024u;
    const int aoff = lds_byte(wr * 64 + fr, fq * 8), boff = lds_byte(wc * 32 + fr, fq * 8);
#define PG8_SA(b, h) (((b) * 2 + (h)) * HTB)
#define PG8_SB(b, h) ((4 + (b) * 2 + (h)) * HTB)
#define PG8_OFS(sel, j) (FP8 ? aofs[((sel) * 4 + (j)) * NTHR] : ((sel) ? rg[4 + (j)] : rg[(j)]))
#define PG8_STAGE_B(bufoff, gbase) do { _Pragma("unroll") for (int _i = 0; _i < 2; ++_i) { const unsigned ob_ = FP8 ? aofs[(8 + _i) * NTHR] : rg[8 + _i]; \
        __builtin_amdgcn_global_load_lds((const unsigned*)((const char*)(gbase) + ob_), (LAS unsigned*)(lds + (bufoff) + ldsw + _i * 8192), 16, 0, 0); } } while (0)
#define PG8_STAGE_A(bufoff, kbyte, sel, h) do { const unsigned o0_ = PG8_OFS(sel, (h) * 2), o1_ = PG8_OFS(sel, (h) * 2 + 1); \
        __builtin_amdgcn_global_load_lds((const unsigned*)(Abase + (kbyte) + o0_), (LAS unsigned*)(lds + (bufoff) + ldsw), 16, 0, 0); \
        __builtin_amdgcn_global_load_lds((const unsigned*)(Abase + (kbyte) + o1_), (LAS unsigned*)(lds + (bufoff) + ldsw + 8192), 16, 0, 0); } while (0)
#define PG8_LDA(dst, b, h) do { _Pragma("unroll") for (int m = 0; m < 4; ++m) { \
        if constexpr (FP8) { const v4i_t lo_ = *(const LAS v4i_t*)(lds + PG8_SA(b, h) + aoff + m * 2048), hi_ = *(const LAS v4i_t*)(lds + PG8_SA(b, h) + aoff + m * 2048 + 1024); dst##8[m] = __builtin_shufflevector(lo_, hi_, 0, 1, 2, 3, 4, 5, 6, 7); } \
        else { _Pragma("unroll") for (int k = 0; k < 2; ++k) dst[m][k] = *(const LAS bf16x8*)(lds + PG8_SA(b, h) + aoff + m * 2048 + k * 1024); } } } while (0)
#define PG8_LDB(dst, b, h) do { _Pragma("unroll") for (int n = 0; n < 2; ++n) { \
        if constexpr (FP8) { const v4i_t lo_ = *(const LAS v4i_t*)(lds + PG8_SB(b, h) + boff + n * 2048), hi_ = *(const LAS v4i_t*)(lds + PG8_SB(b, h) + boff + n * 2048 + 1024); dst##8[n] = __builtin_shufflevector(lo_, hi_, 0, 1, 2, 3, 4, 5, 6, 7); } \
        else { _Pragma("unroll") for (int k = 0; k < 2; ++k) dst[n][k] = *(const LAS bf16x8*)(lds + PG8_SB(b, h) + boff + n * 2048 + k * 1024); } } } while (0)
#define PG8_MMA(ai, bj, At, Bt) do { __builtin_amdgcn_s_setprio(1); _Pragma("unroll") for (int m = 0; m < 4; ++m) _Pragma("unroll") for (int n = 0; n < 2; ++n) { \
        if constexpr (FP8) { acc[ai][bj][m][n] = __builtin_amdgcn_mfma_scale_f32_16x16x128_f8f6f4(Bt##8[n], At##8[m], acc[ai][bj][m][n], 0, 0, 0, SCA, 0, SCA); } \
        else { _Pragma("unroll") for (int k = 0; k < 2; ++k) acc[ai][bj][m][n] = __builtin_amdgcn_mfma_f32_16x16x32_bf16(Bt[n][k], At[m][k], acc[ai][bj][m][n], 0, 0, 0); } } \
        __builtin_amdgcn_s_setprio(0); } while (0)
#define PG8_WAIT_V(n) asm volatile("s_waitcnt vmcnt(" #n ")" ::: "memory")
#define PG8_WAIT_L(n) asm volatile("s_waitcnt lgkmcnt(" #n ")" ::: "memory")
#define PG8_BAR __builtin_amdgcn_s_barrier()
#define PG8_SCHED __builtin_amdgcn_sched_barrier(0)
    typename Sched::Unit cur, nxt; int ui = 0;
    if (!S.next(0, cur)) return;
    f32x4 acc[2][2][4][2];
#pragma unroll
    for (int a = 0; a < 2; ++a)
#pragma unroll
        for (int b = 0; b < 2; ++b)
#pragma unroll
            for (int m = 0; m < 4; ++m)
#pragma unroll
                for (int n = 0; n < 2; ++n) acc[a][b][m][n] = (f32x4){0.f, 0.f, 0.f, 0.f};
    bf16x8 At[4][2], B0[2][2], B1[2][2];
    v8i_t At8[4], B08[2], B18[2];
    { unsigned a4[2][2]; S.a_off(cur, R0, C0, R1, C1, a4); rg[0] = a4[0][0]; rg[1] = a4[0][1]; rg[2] = a4[1][0]; rg[3] = a4[1][1];
      if constexpr (FP8) { aofs[0] = a4[0][0]; aofs[NTHR] = a4[0][1]; aofs[2 * NTHR] = a4[1][0]; aofs[3 * NTHR] = a4[1][1]; } }
    const char* cB = S.b_ptr(cur);
    PG8_STAGE_B(PG8_SB(0, 0), cB); PG8_STAGE_B(PG8_SB(0, 1), cB + hstep); PG8_STAGE_A(PG8_SA(0, 0), 0, 0, 0); PG8_STAGE_A(PG8_SA(0, 1), 0, 0, 1);
    if (wr == 1) PG8_BAR;
    PG8_WAIT_V(2); PG8_BAR;
    PG8_STAGE_B(PG8_SB(1, 0), cB + kstep); PG8_STAGE_A(PG8_SA(1, 0), kstep, 0, 0); PG8_STAGE_B(PG8_SB(1, 1), cB + hstep + kstep);
    PG8_WAIT_V(6); PG8_BAR;
    for (;;) {
        const bool has_next = S.next(ui + 1, nxt);
        const char* nB = cB;
        if (has_next) { int t2 = threadIdx.x; asm volatile("" : "+v"(t2)); int r0, c0, r1, c1; stage_rc(t2 * 16, r0, c0); stage_rc(t2 * 16 + 8192, r1, c1); unsigned a4[2][2]; S.a_off(nxt, r0, c0, r1, c1, a4); nB = S.b_ptr(nxt);
            rg[4] = a4[0][0]; rg[5] = a4[0][1]; rg[6] = a4[1][0]; rg[7] = a4[1][1];
            if constexpr (FP8) { aofs[4 * NTHR] = a4[0][0]; aofs[5 * NTHR] = a4[0][1]; aofs[6 * NTHR] = a4[1][0]; aofs[7 * NTHR] = a4[1][1]; } }
        else { rg[4] = rg[0]; rg[5] = rg[1]; rg[6] = rg[2]; rg[7] = rg[3];
            if constexpr (FP8) { aofs[4 * NTHR] = aofs[0]; aofs[5 * NTHR] = aofs[NTHR]; aofs[6 * NTHR] = aofs[2 * NTHR]; aofs[7 * NTHR] = aofs[3 * NTHR]; } }
#pragma unroll 1
        for (int t = 0; t < nt; t += 2) {
            const bool last = (t == nt - 2);
            const size_t ka1 = (size_t)(t + 1) * kstep, ka2 = last ? 0 : (size_t)(t + 2) * kstep, ka3 = ka2 + kstep;
            const char* b2 = last ? nB : cB + (size_t)(t + 2) * kstep; const char* b3 = b2 + kstep;
            const int sel = last ? 1 : 0;
            PG8_LDB(B0, 0, 0); PG8_LDB(B1, 0, 1); PG8_SCHED; PG8_LDA(At, 0, 0); PG8_STAGE_A(PG8_SA(1, 1), ka1, 0, 1);
            PG8_WAIT_V(8); PG8_WAIT_L(0); PG8_BAR; PG8_MMA(0, 0, At, B0); PG8_MMA(0, 1, At, B1); PG8_BAR; PG8_SCHED;
            PG8_LDA(At, 0, 1); PG8_STAGE_B(PG8_SB(0, 0), b2); PG8_STAGE_B(PG8_SB(0, 1), b2 + hstep); PG8_STAGE_A(PG8_SA(0, 0), ka2, sel, 0);
            PG8_WAIT_V(8); PG8_WAIT_L(0); PG8_BAR; PG8_MMA(1, 0, At, B0); PG8_MMA(1, 1, At, B1); PG8_BAR; PG8_SCHED;
            PG8_LDB(B0, 1, 0); PG8_LDB(B1, 1, 1); PG8_SCHED; PG8_LDA(At, 1, 0); PG8_STAGE_A(PG8_SA(0, 1), ka2, sel, 1);
            PG8_WAIT_V(8); PG8_WAIT_L(0); PG8_BAR; PG8_MMA(0, 0, At, B0); PG8_MMA(0, 1, At, B1); PG8_BAR; PG8_SCHED;
            PG8_LDA(At, 1, 1); PG8_STAGE_B(PG8_SB(1, 0), b3); PG8_STAGE_B(PG8_SB(1, 1), b3 + hstep); PG8_STAGE_A(PG8_SA(1, 0), ka3, sel, 0);
            PG8_WAIT_V(8); PG8_WAIT_L(0); PG8_BAR; PG8_MMA(1, 0, At, B0); PG8_MMA(1, 1, At, B1); PG8_BAR; PG8_SCHED;
        }
        if (wr == 0) PG8_BAR;
        { int t2 = threadIdx.x; asm volatile("" : "+v"(t2)); E(acc, cur, wr, wc, t2 & 15, (t2 & 63) >> 4); }
        if (!has_next) break;
#pragma unroll
        for (int a = 0; a < 2; ++a)
#pragma unroll
            for (int b = 0; b < 2; ++b)
#pragma unroll
                for (int m = 0; m < 4; ++m)
#pragma unroll
                    for (int n = 0; n < 2; ++n) acc[a][b][m][n] = (f32x4){0.f, 0.f, 0.f, 0.f};
        cur = nxt; cB = nB; ++ui;
        rg[0] = rg[4]; rg[1] = rg[5]; rg[2] = rg[6]; rg[3] = rg[7];
        if constexpr (FP8) { aofs[0] = aofs[4 * NTHR]; aofs[NTHR] = aofs[5 * NTHR]; aofs[2 * NTHR] = aofs[6 * NTHR]; aofs[3 * NTHR] = aofs[7 * NTHR]; }
        if (wr == 1) PG8_BAR;
    }
    PG8_WAIT_V(0);
    PG8_BAR;
#undef PG8_SA
#undef PG8_SB
#undef PG8_STAGE_A
#undef PG8_OFS
#undef PG8_STAGE_B
#undef PG8_LDA
#undef PG8_LDB
#undef PG8_MMA
#undef PG8_WAIT_V
#undef PG8_WAIT_L
#undef PG8_BAR
#undef PG8_SCHED
}
}

struct DenseUnit { int pm, pn; };
struct DenseSched {
    typedef DenseUnit Unit;
    const char* Bt; int K, nM, nN;
    __device__ __forceinline__ bool next(int i, Unit& u) const { return pg8::tile_order(i, gridDim.x, blockIdx.x, nM, nN, u.pm, u.pn); }
    __device__ __forceinline__ void a_off(const Unit& u, int R0, int C0, int R1, int C1, unsigned (&off)[2][2]) const {
#pragma unroll
        for (int h = 0; h < 2; ++h) { off[h][0] = (unsigned)((u.pm * 256 + h * 128 + R0) * K + C0) * 2u; off[h][1] = (unsigned)((u.pm * 256 + h * 128 + R1) * K + C1) * 2u; }
    }
    __device__ __forceinline__ const char* b_ptr(const Unit& u) const { return Bt + (size_t)u.pn * 256 * K * 2; }
};
struct MoeUnit { int rbt, e, pn; };
template <bool GATHER>
struct MoeSched {
    typedef MoeUnit Unit;
    static constexpr int KP = 512;
    const char* Bt; const int* lists; const int* ptile; const int* ecnt; int nN, nrows;
    __device__ __forceinline__ bool next(int i, Unit& u) const {
        int pm, pn; if (!pg8::tile_order(i, gridDim.x, blockIdx.x, ptile[NE], nN, pm, pn)) return false;
        int e = 0; while (ptile[e + 1] <= pm) ++e;
        u.rbt = pm; u.e = e; u.pn = pn; return true;
    }
    __device__ __forceinline__ void a_off(const Unit& u, int R0, int C0, int R1, int C1, unsigned (&off)[2][2]) const {
        if (GATHER) {
            const int* lst = lists + (size_t)u.e * LIST_CAP; const int rb = u.rbt - ptile[u.e], cnt = ecnt[u.e];
#pragma unroll
            for (int h = 0; h < 2; ++h) {
                const int l0 = rb * 256 + h * 128 + R0, l1 = rb * 256 + h * 128 + R1;
                const int t0 = l0 < cnt ? (lst[l0] >> 2) : 0, t1 = l1 < cnt ? (lst[l1] >> 2) : 0;
                off[h][0] = (unsigned)(t0 * KP + C0) * 2u; off[h][1] = (unsigned)(t1 * KP + C1) * 2u;
            }
        } else {
#pragma unroll
            for (int h = 0; h < 2; ++h) { off[h][0] = (unsigned)((u.rbt * 256 + h * 128 + R0) * KP + C0) * 2u; off[h][1] = (unsigned)((u.rbt * 256 + h * 128 + R1) * KP + C1) * 2u; }
        }
    }
    __device__ __forceinline__ const char* b_ptr(const Unit& u) const { return Bt + ((size_t)u.e * nrows + (size_t)u.pn * 256) * KP * 2; }
};

struct EpiInProj {
    const Params* p; int l;
    __device__ __forceinline__ void operator()(const f32x4 (&acc)[2][2][4][2], const DenseUnit& u, int wr, int wc, int fr, int fq) const {
        const float* bias = p->binp + l * NPAD + u.pn * 256;
#pragma unroll
        for (int bj = 0; bj < 2; ++bj) {
            int kind = 0, hb0 = 0;
            if (u.pn == 1) { kind = 1; hb0 = bj * 2; } else if (u.pn == 4 && bj == 1) { kind = 1; hb0 = 4; } else if (u.pn == 8 && bj == 0) { kind = 1; hb0 = 6; } else if (u.pn == 9 && bj == 0) { kind = 1; hb0 = 8; }
            else if (u.pn == 2) { kind = 2; hb0 = bj * 2; } else if (u.pn == 5 && bj == 0) { kind = 2; hb0 = 4; } else if (u.pn == 8 && bj == 1) { kind = 2; hb0 = 6; } else if (u.pn == 9 && bj == 1) { kind = 2; hb0 = 8; }
#pragma unroll
            for (int n = 0; n < 2; ++n) {
                const int c = bj * 128 + wc * 32 + n * 16 + 4 * fq;
                const f32x4 bv = *(const f32x4*)(bias + c);
                const int hh = hb0 + ((c & 127) >> 6), d = c & 63;
#pragma unroll
                for (int ai = 0; ai < 2; ++ai)
#pragma unroll
                    for (int m = 0; m < 4; ++m) {
                        const int row = u.pm * 256 + ai * 128 + wr * 64 + m * 16 + fr;
                        const f32x4 v = acc[ai][bj][m][n] + bv;
                        u32x2 w; w.x = pack2(v[0], v[1]); w.y = pack2(v[2], v[3]);
                        if (kind == 0) *(u32x2*)(p->hb + (size_t)row * NMAIN + u.pn * 256 + c) = w;
                        else {
                            const int b = row >> 11, s = row & 2047, kk = s & 31;
                            bf16_t* blk = (kind == 1 ? p->kF : p->vT) + (((size_t)b * NVH + hh) * 64 + (s >> 5)) * 2048;
                            if (kind == 1) {
                                const int frk = (kk >> 3) * 4 + (kk & 3), t = (kk >> 2) & 1;
                                *(u32x2*)(blk + ((t * 2 + (d >> 5)) * 64 + ((d & 31) >> 3) * 16 + frk) * 8 + (d & 7)) = w;
                            } else {
                                bf16_t* vt = blk + (((d >> 4) * 64) + (kk >> 3) * 16 + (d & 15)) * 8 + (kk & 7);
                                vt[0] = (bf16_t)(w.x & 0xffff); vt[8] = (bf16_t)(w.x >> 16); vt[16] = (bf16_t)(w.y & 0xffff); vt[24] = (bf16_t)(w.y >> 16);
                            }
                        }
                    }
            }
        }
    }
};
struct EpiOutProj {
    const float* xin; float* t;
    __device__ __forceinline__ void operator()(const f32x4 (&acc)[2][2][4][2], const DenseUnit& u, int wr, int wc, int fr, int fq) const {
#pragma unroll
        for (int ai = 0; ai < 2; ++ai)
#pragma unroll
            for (int m = 0; m < 4; ++m) {
                const size_t rowoff = (size_t)(u.pm * 256 + ai * 128 + wr * 64 + m * 16 + fr) * DM + u.pn * 256 + wc * 32 + 4 * fq;
#pragma unroll
                for (int bj = 0; bj < 2; ++bj)
#pragma unroll
                    for (int n = 0; n < 2; ++n) {
                        const size_t off = rowoff + bj * 128 + n * 16;
                        const f32x4 xv = *(const f32x4*)(xin + off);
                        const f32x4 tv = xv * ALPHA + acc[ai][bj][m][n];
                        u32x2 w; w.x = pack2(tv[0], tv[1]); w.y = pack2(tv[2], tv[3]);
                        *(u32x2*)((bf16_t*)t + off) = w;
                    }
            }
    }
};
struct EpiGateUp {
    bf16_t* act; const float* bgup;
    __device__ __forceinline__ void operator()(const f32x4 (&acc)[2][2][4][2], const MoeUnit& u, int wr, int wc, int fr, int fq) const {
        const float* bias = bgup + (size_t)u.e * 2048 + u.pn * 256;
#pragma unroll
        for (int n = 0; n < 2; ++n) {
            const int c = wc * 32 + n * 16 + 4 * fq;
            const f32x4 bg = *(const f32x4*)(bias + c), bu = *(const f32x4*)(bias + 128 + c);
#pragma unroll
            for (int ai = 0; ai < 2; ++ai)
#pragma unroll
                for (int m = 0; m < 4; ++m) {
                    const f32x4 g4 = acc[ai][0][m][n] + bg, u4 = acc[ai][1][m][n] + bu;
                    float o[4];
#pragma unroll
                    for (int j = 0; j < 4; ++j) {
                        const float g = fminf(g4[j], 7.0f), uu = fminf(fmaxf(u4[j], -7.0f), 7.0f);
                        const float glu = g * __builtin_amdgcn_rcpf(1.0f + __builtin_amdgcn_exp2f(-2.455466929f * g));
                        o[j] = (uu + 1.0f) * glu;
                    }
                    *(unsigned*)((char*)act + (size_t)(u.rbt * 256 + ai * 128 + wr * 64 + m * 16 + fr) * DFF + u.pn * 128 + c) = pack4_fp8(o[0], o[1], o[2], o[3]);
                }
        }
    }
};
struct EpiDown {
    bf16_t* ybuf; const float* bdn;
    __device__ __forceinline__ void operator()(const f32x4 (&acc)[2][2][4][2], const MoeUnit& u, int wr, int wc, int fr, int fq) const {
        const float* bias = bdn + (size_t)u.e * 1024 + u.pn * 256;
#pragma unroll
        for (int bj = 0; bj < 2; ++bj)
#pragma unroll
            for (int n = 0; n < 2; ++n) {
                const int c = bj * 128 + wc * 32 + n * 16 + 4 * fq;
                const f32x4 bv = *(const f32x4*)(bias + c);
#pragma unroll
                for (int ai = 0; ai < 2; ++ai)
#pragma unroll
                    for (int m = 0; m < 4; ++m) {
                        const f32x4 v = acc[ai][bj][m][n] + bv;
                        *(unsigned*)((unsigned char*)ybuf + (size_t)(u.rbt * 256 + ai * 128 + wr * 64 + m * 16 + fr) * DM + u.pn * 256 + c) = pack4_fp8(v[0], v[1], v[2], v[3]);
                    }
            }
    }
};

__device__ __forceinline__ void phase_inproj(const Params& p, int l, char* lds) {
    DenseSched S{(const char*)(p.WinT + (size_t)l * NPAD * 1024), 1024, NTOK / 256, NMAIN / 256};
    EpiInProj E{&p, l};
    pg8::gemm_phase<false, 0>((LAS unsigned char*)lds, (const char*)p.xb, 1024, S, E);
    int tid = threadIdx.x; asm volatile("" : "+v"(tid));
    const int wid = tid >> 6, lane = tid & 63, fr = lane & 15, fq = lane >> 4;
    const bf16_t* W = p.WinT + ((size_t)l * NPAD + NMAIN) * 1024;
    const float* bias = p.binp + l * NPAD + NMAIN;
    for (int u = blockIdx.x * NWV + wid; u < NTOK / 16; u += gridDim.x * NWV) {
        const bf16_t* ar = p.xb + (size_t)(u * 16 + fr) * DM + fq * 8;
        const bf16_t* w0 = W + (size_t)fr * 1024 + fq * 8; const bf16_t* w1 = W + (size_t)(16 + fr) * 1024 + fq * 8;
        f32x4 a0 = (f32x4){0.f, 0.f, 0.f, 0.f}, a1 = a0;
#pragma unroll 4
        for (int ks = 0; ks < 32; ++ks) {
            const bf16x8 a = *(const bf16x8*)(ar + ks * 32);
            a0 = __builtin_amdgcn_mfma_f32_16x16x32_bf16(a, *(const bf16x8*)(w0 + ks * 32), a0, 0, 0, 0);
            a1 = __builtin_amdgcn_mfma_f32_16x16x32_bf16(a, *(const bf16x8*)(w1 + ks * 32), a1, 0, 0, 0);
        }
#pragma unroll
        for (int r = 0; r < 4; ++r) {
            float* dst = p.hs + (size_t)(u * 16 + fq * 4 + r) * HS_W;
            dst[fr] = a0[r] + bias[fr];
            if (fr < 6) dst[16 + fr] = a1[r] + bias[16 + fr];
        }
    }
}
__device__ __forceinline__ void phase_outproj(const Params& p, int l, const float* xin, char* lds) {
    DenseSched S{(const char*)p.WoT + (size_t)l * 1024 * 1024, 512, NTOK / 256, 4};
    EpiOutProj E{xin, p.tbuf};
    pg8::gemm_phase<true, 0x7c7c7c7c>((LAS unsigned char*)lds, (const char*)p.ob, 512, S, E);
}
__device__ __forceinline__ void build_tiles(const Params& p, int l, int* ptile, int* ecnt) {
    int tid = threadIdx.x; asm volatile("" : "+v"(tid));
    if (tid < NE) ecnt[tid] = (int)__hip_atomic_load(p.ctrl + 64 + l * NE + tid, __ATOMIC_RELAXED, __HIP_MEMORY_SCOPE_AGENT);
    __syncthreads();
    if (tid == 0) { int s = 0; for (int e = 0; e < NE; ++e) { ptile[e] = s; s += (ecnt[e] + 255) >> 8; } ptile[NE] = s; }
    __syncthreads();
}
__device__ __forceinline__ void phase_gateup(const Params& p, int l, char* lds) {
    int* ptile = (int*)(lds + LDS_TAB); int* ecnt = ptile + 40;
    build_tiles(p, l, ptile, ecnt);
    MoeSched<true> S{(const char*)p.WguT + (size_t)l * NE * 2048 * 1024, p.lists, ptile, ecnt, 8, 2048};
    EpiGateUp E{p.act, p.bgup + (size_t)l * NE * 2048};
    pg8::gemm_phase<true, 0x7c7c7c7c>((LAS unsigned char*)lds, (const char*)p.x1b, 512, S, E);
}
__device__ __forceinline__ void phase_down(const Params& p, int l, char* lds) {
    int* ptile = (int*)(lds + LDS_TAB); int* ecnt = ptile + 40;
    build_tiles(p, l, ptile, ecnt);
    MoeSched<false> S{(const char*)p.WdnT + (size_t)l * NE * 1024 * 1024, p.lists, ptile, ecnt, 4, 1024};
    EpiDown E{p.ybuf, p.b_dn + (size_t)l * NE * 1024};
    pg8::gemm_phase<true, 0x7c7c7c7c>((LAS unsigned char*)lds, (const char*)p.act, 512, S, E);
}

__device__ __forceinline__ float gelu_tanh(float x) {
    const float u = 0.7978845608028654f * (x + 0.044715f * x * x * x);
    const float e = __expf(-2.0f * fabsf(u)); const float th = (1.0f - e) / (1.0f + e);
    return 0.5f * x * (1.0f + (u < 0.f ? -th : th));
}
__device__ __forceinline__ void phase_prep(const Params& p, int l, char* lds) {
    int tid = threadIdx.x; asm volatile("" : "+v"(tid));
    const int wid = tid >> 6, lane = tid & 63, fr = lane & 15, fq = lane >> 4;
    const int gw = blockIdx.x * NWV + wid, nw = gridDim.x * NWV;
    for (int u = (int)gridDim.x - 1 - (int)blockIdx.x; u < NB * 4; u += gridDim.x) {
        const int b = u >> 2, h = u & 3;
        const float* srcp = p.hs + ((size_t)b * SEQ + tid * 4) * HS_W + h;
        float ls[4]; float tot = 0.f;
#pragma unroll
        for (int i = 0; i < 4; ++i) { const float f = srcp[(size_t)i * HS_W]; ls[i] = fminf(f, 0.f) - log1pf(__expf(-fabsf(f))); tot += ls[i]; }
        float inc = tot;
#pragma unroll
        for (int o = 1; o < 64; o <<= 1) { const float v = shfl_f(inc, lane - o); if (lane >= o) inc += v; }
        float* wtot = (float*)(lds + 65536);
        if (lane == 63) wtot[wid] = inc;
        __syncthreads();
        float base = inc - tot;
        for (int w = 0; w < wid; ++w) base += wtot[w];
        float4 o4; o4.x = base + ls[0]; o4.y = o4.x + ls[1]; o4.z = o4.y + ls[2]; o4.w = o4.z + ls[3];
        *(float4*)(p.cF + (size_t)u * SEQ + tid * 4) = o4;
        __syncthreads();
    }
    float* part = (float*)lds;
    bf16_t* h1 = (bf16_t*)(lds + 32768);
    for (int u = blockIdx.x; u < NB * 2 * 2 * 8; u += gridDim.x) {
        const int ct = u & 7, which = (u >> 3) & 1, kvh = (u >> 4) & 1, b = u >> 5;
        const int colo = (which ? C_NVC : C_NKC) + kvh * 64;
        const int c_lane = ct * 16 + fr;
        const int tokbase = min(c_lane, 126) * 16;
        const bf16_t* arow = p.hb + ((size_t)b * SEQ + tokbase) * NMAIN + colo + fq * 8;
        const bf16_t* w1 = p.W1T + ((size_t)(l * 2 + which) * 64 + fr) * 2048 + fq * 8;
        f32x4 acc[4];
#pragma unroll
        for (int n = 0; n < 4; ++n) acc[n] = (f32x4){0.f, 0.f, 0.f, 0.f};
#pragma unroll
        for (int kk = 0; kk < 8; ++kk) {
            const int ks = wid * 8 + kk;
            const bf16x8 a = *(const bf16x8*)(arow + (size_t)(ks >> 1) * NMAIN + (ks & 1) * 32);
#pragma unroll
            for (int n = 0; n < 4; ++n) {
                const bf16x8 bb = *(const bf16x8*)(w1 + (size_t)n * 16 * 2048 + ks * 32);
                acc[n] = __builtin_amdgcn_mfma_f32_16x16x32_bf16(a, bb, acc[n], 0, 0, 0);
            }
        }
#pragma unroll
        for (int n = 0; n < 4; ++n)
#pragma unroll
            for (int r = 0; r < 4; ++r) part[wid * 1024 + (fq * 4 + r) * 64 + n * 16 + fr] = acc[n][r];
        __syncthreads();
        const float* b1 = p.b1c + (l * 2 + which) * 64;
#pragma unroll
        for (int i = 0; i < 2; ++i) {
            const int e = tid + NTHR * i; float sum = 0.f;
#pragma unroll
            for (int w = 0; w < 8; ++w) sum += part[w * 1024 + e];
            h1[e] = f2bf(gelu_tanh(sum + b1[e & 63]));
        }
        __syncthreads();
        if (wid == 0) {
            const bf16_t* w2 = p.W2T + ((size_t)(l * 2 + which) * 64 + fr) * 64 + fq * 8;
            f32x4 o2[4];
#pragma unroll
            for (int n = 0; n < 4; ++n) o2[n] = (f32x4){0.f, 0.f, 0.f, 0.f};
#pragma unroll
            for (int ks = 0; ks < 2; ++ks) {
                const bf16x8 a = *(const bf16x8*)(h1 + fr * 64 + ks * 32 + fq * 8);
#pragma unroll
                for (int n = 0; n < 4; ++n) {
                    const bf16x8 bb = *(const bf16x8*)(w2 + (size_t)n * 16 * 64 + ks * 32);
                    o2[n] = __builtin_amdgcn_mfma_f32_16x16x32_bf16(a, bb, o2[n], 0, 0, 0);
                }
            }
            const size_t base = ((size_t)b * 2 + kvh) * 128 * 64;
#pragma unroll
            for (int n = 0; n < 4; ++n)
#pragma unroll
                for (int r = 0; r < 4; ++r) {
                    const int c = ct * 16 + fq * 4 + r, j2 = n * 16 + fr;
                    const bf16_t v = c < 127 ? f2bf(o2[n][r]) : (bf16_t)0;
                    if (which == 0) p.kc[base + (size_t)c * 64 + j2] = v;
                    else { p.vc[base + (size_t)c * 64 + j2] = v; p.vcT[base + (size_t)j2 * 128 + c] = v; }
                }
        }
        __syncthreads();
    }
}

constexpr float L2E = 1.4426950408889634f, MASKV = -__builtin_huge_valf(), MINIT = -1e30f, SCL2 = QSCALE * L2E;
struct KVFrag { bf16x8 k[2][2]; bf16x8 v[4]; };
template <bool FM>
__device__ __forceinline__ void k_load(KVFrag& f, const bf16_t* __restrict__ Kb, size_t ldk, int kc0, int fr, int fq) {
    if (FM) {
        const bf16_t* kp = Kb + (size_t)(kc0 >> 5) * 2048 + (fq * 16 + fr) * 8;
        f.k[0][0] = *(const bf16x8*)(kp); f.k[0][1] = *(const bf16x8*)(kp + 512); f.k[1][0] = *(const bf16x8*)(kp + 1024); f.k[1][1] = *(const bf16x8*)(kp + 1536);
    } else {
        const bf16_t* kp = Kb + (size_t)(kc0 + (fr >> 2) * 8 + (fr & 3)) * ldk + fq * 8;
        f.k[0][0] = *(const bf16x8*)(kp); f.k[0][1] = *(const bf16x8*)(kp + 32);
        f.k[1][0] = *(const bf16x8*)(kp + 4 * ldk); f.k[1][1] = *(const bf16x8*)(kp + 4 * ldk + 32);
    }
}
template <bool FM>
__device__ __forceinline__ void v_load(bf16x8 (&v)[4], const bf16_t* __restrict__ VTb, size_t ldv, int kc0, int fr, int fq) {
    if (FM) {
        const bf16_t* vp = VTb + (size_t)(kc0 >> 5) * 2048 + (fq * 16 + fr) * 8;
#pragma unroll
        for (int dt = 0; dt < 4; ++dt) v[dt] = *(const bf16x8*)(vp + dt * 512);
    } else {
        const bf16_t* vp = VTb + (size_t)fr * ldv + kc0 + fq * 8;
#pragma unroll
        for (int dt = 0; dt < 4; ++dt) v[dt] = *(const bf16x8*)(vp + (size_t)dt * 16 * ldv);
    }
}
__device__ __forceinline__ float rowmax4(float x) {
    auto r = __builtin_amdgcn_permlane32_swap(__float_as_uint(x), __float_as_uint(x), false, false);
    x = fmaxf(__uint_as_float(r[0]), __uint_as_float(r[1]));
    auto q = __builtin_amdgcn_permlane16_swap(__float_as_uint(x), __float_as_uint(x), false, false);
    return fmaxf(__uint_as_float(q[0]), __uint_as_float(q[1]));
}
__device__ __forceinline__ float rowsum4(float x) {
    auto r = __builtin_amdgcn_permlane32_swap(__float_as_uint(x), __float_as_uint(x), false, false);
    x = __uint_as_float(r[0]) + __uint_as_float(r[1]);
    auto q = __builtin_amdgcn_permlane16_swap(__float_as_uint(x), __float_as_uint(x), false, false);
    return __uint_as_float(q[0]) + __uint_as_float(q[1]);
}
template <int NQT, bool MASK, class MB>
__device__ __forceinline__ void attn_compute(const KVFrag& f, const bf16x8 (&qf)[NQT][2], f32x4 (&o)[NQT][4], float (&m)[NQT], float (&l)[NQT], const MB& mb) {
    f32x4 s0[NQT], s1[NQT];
#pragma unroll
    for (int qt = 0; qt < NQT; ++qt) {
        s0[qt] = __builtin_amdgcn_mfma_f32_16x16x32_bf16(f.k[0][0], qf[qt][0], (f32x4){0.f, 0.f, 0.f, 0.f}, 0, 0, 0);
        s1[qt] = __builtin_amdgcn_mfma_f32_16x16x32_bf16(f.k[1][0], qf[qt][0], (f32x4){0.f, 0.f, 0.f, 0.f}, 0, 0, 0);
    }
#pragma unroll
    for (int qt = 0; qt < NQT; ++qt) {
        s0[qt] = __builtin_amdgcn_mfma_f32_16x16x32_bf16(f.k[0][1], qf[qt][1], s0[qt], 0, 0, 0);
        s1[qt] = __builtin_amdgcn_mfma_f32_16x16x32_bf16(f.k[1][1], qf[qt][1], s1[qt], 0, 0, 0);
    }
    float mx[NQT];
#pragma unroll
    for (int qt = 0; qt < NQT; ++qt) {
#pragma unroll
        for (int j = 0; j < 4; ++j) { s0[qt][j] = mb(qt, j, s0[qt][j]); s1[qt][j] = mb(qt, j + 4, s1[qt][j]); }
        mx[qt] = fmaxf(fmaxf(fmaxf(s0[qt][0], s0[qt][1]), fmaxf(s0[qt][2], s0[qt][3])), fmaxf(fmaxf(s1[qt][0], s1[qt][1]), fmaxf(s1[qt][2], s1[qt][3])));
    }
#pragma unroll
    for (int qt = 0; qt < NQT; ++qt) mx[qt] = rowmax4(mx[qt]);
    bool moved = false;
#pragma unroll
    for (int qt = 0; qt < NQT; ++qt) { mx[qt] = fmaxf(m[qt], mx[qt]); moved |= (mx[qt] != m[qt]); }
    if (__ballot(moved) != 0ull) {
#pragma unroll
        for (int qt = 0; qt < NQT; ++qt) {
            const float alpha = __builtin_amdgcn_exp2f(m[qt] - mx[qt]);
            l[qt] *= alpha;
#pragma unroll
            for (int dt = 0; dt < 4; ++dt) o[qt][dt] *= alpha;
        }
    }
    bf16x8 pf[NQT];
#pragma unroll
    for (int qt = 0; qt < NQT; ++qt) {
        m[qt] = mx[qt];
        float pr[8]; float ps = 0.f;
#pragma unroll
        for (int j = 0; j < 4; ++j) {
            pr[j] = __builtin_amdgcn_exp2f(s0[qt][j] - mx[qt]);
            pr[j + 4] = __builtin_amdgcn_exp2f(s1[qt][j] - mx[qt]);
        }
#pragma unroll
        for (int j = 0; j < 8; ++j) ps += pr[j];
        l[qt] += ps;
        const u32x4 pk = {pack2(pr[0], pr[1]), pack2(pr[2], pr[3]), pack2(pr[4], pr[5]), pack2(pr[6], pr[7])};
        pf[qt] = __builtin_bit_cast(bf16x8, pk);
    }
#pragma unroll
    for (int dt = 0; dt < 4; ++dt)
#pragma unroll
        for (int qt = 0; qt < NQT; ++qt) o[qt][dt] = __builtin_amdgcn_mfma_f32_16x16x32_bf16(f.v[dt], pf[qt], o[qt][dt], 0, 0, 0);
    __builtin_amdgcn_sched_barrier(0);
}
struct RangeIt { int c, c_hi; __device__ __forceinline__ int nxt() { if (c > c_hi) return -1; return (c++) * 32; } };
struct MaskIt { unsigned long long cm; __device__ __forceinline__ int nxt() { if (!cm) return -1; const int i = __builtin_ctzll(cm); cm &= cm - 1; return i * 32; } };
template <bool PFV, bool FM, class It, class Gen>
__device__ __forceinline__ void attn_run(It& it, const bf16_t* Kb, size_t ldk, const bf16_t* VTb, size_t ldv, int fr, int fq, const Gen& gen) {
    KVFrag fa, fb;
    int ka = it.nxt(); if (ka < 0) return;
    k_load<FM>(fa, Kb, ldk, ka, fr, fq); if (PFV) v_load<FM>(fa.v, VTb, ldv, ka, fr, fq);
    for (;;) {
        const int kb = it.nxt(); if (kb >= 0) { k_load<FM>(fb, Kb, ldk, kb, fr, fq); if (PFV) v_load<FM>(fb.v, VTb, ldv, kb, fr, fq); }
        if (!PFV) v_load<FM>(fa.v, VTb, ldv, ka, fr, fq);
        gen(ka, fa);
        if (kb < 0) break;
        ka = it.nxt(); if (ka >= 0) { k_load<FM>(fa, Kb, ldk, ka, fr, fq); if (PFV) v_load<FM>(fa.v, VTb, ldv, ka, fr, fq); }
        if (!PFV) v_load<FM>(fb.v, VTb, ldv, kb, fr, fq);
        gen(kb, fb);
        if (ka < 0) break;
    }
}
template <int NQT>
__device__ __forceinline__ void attn_init(f32x4 (&o)[NQT][4], float (&m)[NQT], float (&l)[NQT]) {
#pragma unroll
    for (int qt = 0; qt < NQT; ++qt) { m[qt] = MINIT; l[qt] = 0.f;
#pragma unroll
        for (int dt = 0; dt < 4; ++dt) o[qt][dt] = (f32x4){0.f, 0.f, 0.f, 0.f}; }
}
__device__ __forceinline__ float lsum4(float l) { return rowsum4(l); }
__device__ __forceinline__ void store_o4(unsigned char* dst, const f32x4 v) { *(unsigned*)dst = pack4_fp8(v[0], v[1], v[2], v[3]); }
__device__ __forceinline__ float sigmoidf_fast(float x) { return __builtin_amdgcn_rcpf(1.0f + __builtin_amdgcn_exp2f(-L2E * x)); }

__device__ __forceinline__ void fox_unit(const Params& p, int b, int h, int qb, int fr, int fq) {
    asm volatile("" : "+v"(fr), "+v"(fq));
    const int t0 = qb * 64;
    const bf16_t* Qb = p.hb + ((size_t)b * SEQ + t0) * NMAIN + C_FQ + h * 64 + fq * 8;
    bf16x8 qf[4][2];
#pragma unroll
    for (int qt = 0; qt < 4; ++qt) { qf[qt][0] = *(const bf16x8*)(Qb + (size_t)(qt * 16 + fr) * NMAIN); qf[qt][1] = *(const bf16x8*)(Qb + (size_t)(qt * 16 + fr) * NMAIN + 32); }
    const float* cf = p.cF + ((size_t)b * 4 + h) * SEQ;
    float cq[4];
#pragma unroll
    for (int qt = 0; qt < 4; ++qt) cq[qt] = cf[t0 + qt * 16 + fr] * L2E;
    f32x4 o[4][4]; float m[4], l[4];
    attn_init<4>(o, m, l);
    const bf16_t* Kb = p.kF + ((size_t)b * NVH + h) * 64 * SEQ;
    const bf16_t* VTb = p.vT + ((size_t)b * NVH + h) * 64 * SEQ;
    RangeIt it{0, (t0 >> 5) + 1};
    attn_run<false, true>(it, Kb, NMAIN, VTb, SEQ, fr, fq, [&](int kc0, const KVFrag& f) {
        const float4 ca = *(const float4*)(cf + kc0 + 8 * fq), cb = *(const float4*)(cf + kc0 + 8 * fq + 4);
        const float ck[8] = {ca.x * L2E, ca.y * L2E, ca.z * L2E, ca.w * L2E, cb.x * L2E, cb.y * L2E, cb.z * L2E, cb.w * L2E};
        const int kq = kc0 + 8 * fq - t0 - fr;
        attn_compute<4, true>(f, qf, o, m, l, [&](int qt, int j, float raw) { return (kq + j - 16 * qt) > 0 ? MASKV : raw * SCL2 + cq[qt] - ck[j]; });
    });
#pragma unroll
    for (int qt = 0; qt < 4; ++qt) {
        const float inv = __builtin_amdgcn_rcpf(lsum4(l[qt]));
        unsigned char* dst = (unsigned char*)p.ob + ((size_t)b * SEQ + t0 + qt * 16 + fr) * DM + h * 64 + 4 * fq;
#pragma unroll
        for (int dt = 0; dt < 4; ++dt) store_o4(dst + dt * 16, o[qt][dt] * inv);
    }
}
__device__ __forceinline__ void swa_unit(const Params& p, int l_, int b, int kv, int pos, int fr, int fq) {
    asm volatile("" : "+v"(fr), "+v"(fq));
    const int t0 = pos * 16, t = t0 + fr;
    const bf16_t* Qb = p.hb + ((size_t)b * SEQ + t) * NMAIN + C_SQ + kv * 192 + fq * 8;
    bf16x8 qf[3][2];
#pragma unroll
    for (int g = 0; g < 3; ++g) { qf[g][0] = *(const bf16x8*)(Qb + g * 64); qf[g][1] = *(const bf16x8*)(Qb + g * 64 + 32); }
    float sl[3];
#pragma unroll
    for (int g = 0; g < 3; ++g) sl[g] = slope_swa(kv * 3 + g) * L2E;
    f32x4 o[3][4]; float m[3], l[3];
    attn_init<3>(o, m, l);
    const bf16_t* Kb = p.kF + ((size_t)b * NVH + 4 + kv) * 64 * SEQ;
    const bf16_t* VTb = p.vT + ((size_t)b * NVH + 4 + kv) * 64 * SEQ;
    RangeIt it{max(0, t0 - 127) >> 5, (t0 + 15) >> 5};
    attn_run<true, true>(it, Kb, NMAIN, VTb, SEQ, fr, fq, [&](int kc0, const KVFrag& f) {
        const int dq = t - kc0 - 8 * fq;
        attn_compute<3, true>(f, qf, o, m, l, [&](int g, int j, float raw) { const int dist = dq - j; return ((unsigned)dist < 128u) ? raw * SCL2 - sl[g] * (float)dist : MASKV; });
    });
#pragma unroll
    for (int g = 0; g < 3; ++g) {
        const float sink = p.sinks[l_ * 6 + kv * 3 + g] * L2E;
        const float inv = __builtin_amdgcn_rcpf(lsum4(l[g]) + __builtin_amdgcn_exp2f(sink - m[g]));
        unsigned char* dst = (unsigned char*)p.ob + ((size_t)b * SEQ + t) * DM + 256 + (kv * 3 + g) * 64 + 4 * fq;
#pragma unroll
        for (int dt = 0; dt < 4; ++dt) store_o4(dst + dt * 16, o[g][dt] * inv);
    }
}
__device__ __forceinline__ void nsa_unit(const Params& p, int b, int kv, int pos, int fr, int fq, int lane, float* ps, unsigned* msk, float* otl) {
    asm volatile("" : "+v"(fr), "+v"(fq), "+v"(lane));
    const int t0 = pos * 16, t = t0 + fr, cur = t0 >> 6;
    const bf16_t* Qb = p.hb + ((size_t)b * SEQ + t) * NMAIN + C_NQ + kv * 192 + fq * 8;
    bf16x8 qf[3][2];
#pragma unroll
    for (int g = 0; g < 3; ++g) { qf[g][0] = *(const bf16x8*)(Qb + g * 64); qf[g][1] = *(const bf16x8*)(Qb + g * 64 + 32); }
    float sl[3];
#pragma unroll
    for (int g = 0; g < 3; ++g) sl[g] = slope_nsa(kv * 3 + g) * L2E;
    const float* gl = p.hs + ((size_t)b * SEQ + t) * HS_W + 4 + kv * 9;
    f32x4 o[3][4]; float m[3], l[3];
    f32x4* otv = (f32x4*)otl + lane;
#pragma unroll
    for (int i = 0; i < 8; ++i) ps[lane + 64 * i] = 0.f;
    {
        const bf16_t* Kb = p.kc + ((size_t)b * 2 + kv) * 128 * 64;
        const bf16_t* VTb = p.vcT + ((size_t)b * 2 + kv) * 64 * 128;
        const int ncv = (t0 + 15 >= 31) ? ((t0 + 15 - 31) >> 4) + 1 : 0;
        const int nch = (ncv + 31) >> 5;
        attn_init<3>(o, m, l);
        const int dq0 = t - 31 - 16 * 8 * fq;
        RangeIt it{0, nch - 1};
        attn_run<false, false>(it, Kb, 64, VTb, 128, fr, fq, [&](int kc0, const KVFrag& f) {
            const int dq = dq0 - 16 * kc0;
            attn_compute<3, true>(f, qf, o, m, l, [&](int g, int j, float raw) { const int dist = dq - 16 * j; return dist >= 0 ? raw * SCL2 - sl[g] * (float)dist : MASKV; });
        });
        float il[3];
#pragma unroll
        for (int g = 0; g < 3; ++g) {
            const float lt = lsum4(l[g]); il[g] = lt > 0.f ? __builtin_amdgcn_rcpf(lt) : 0.f;
            const float gate = sigmoidf_fast(gl[g * 3 + 0]);
#pragma unroll
            for (int dt = 0; dt < 4; ++dt) otv[(g * 4 + dt) * 64] = o[g][dt] * (il[g] * gate);
        }
        float carry_prev = 0.f;
        for (int c = 0; c < nch; ++c) {
            const int kc0 = c * 32, dq = dq0 - 16 * kc0;
            const bf16_t* kp = Kb + (size_t)(kc0 + (fr >> 2) * 8 + (fr & 3)) * 64 + fq * 8;
            const bf16x8 k00 = *(const bf16x8*)(kp), k01 = *(const bf16x8*)(kp + 32), k10 = *(const bf16x8*)(kp + 256), k11 = *(const bf16x8*)(kp + 256 + 32);
            float pc[8];
#pragma unroll
            for (int j = 0; j < 8; ++j) pc[j] = 0.f;
#pragma unroll
            for (int g = 0; g < 3; ++g) {
                f32x4 s0 = (f32x4){0.f, 0.f, 0.f, 0.f}, s1 = s0;
                s0 = __builtin_amdgcn_mfma_f32_16x16x32_bf16(k00, qf[g][0], s0, 0, 0, 0); s0 = __builtin_amdgcn_mfma_f32_16x16x32_bf16(k01, qf[g][1], s0, 0, 0, 0);
                s1 = __builtin_amdgcn_mfma_f32_16x16x32_bf16(k10, qf[g][0], s1, 0, 0, 0); s1 = __builtin_amdgcn_mfma_f32_16x16x32_bf16(k11, qf[g][1], s1, 0, 0, 0);
#pragma unroll
                for (int j = 0; j < 8; ++j) {
                    const int dist = dq - 16 * j; const float raw = j < 4 ? s0[j] : s1[j - 4];
                    if (dist >= 0) pc[j] += __builtin_amdgcn_exp2f(raw * SCL2 - sl[g] * (float)dist - m[g]) * il[g];
                }
            }
            const float cout = 0.5f * pc[7];
            float cin = shfl_f(cout, lane - 16);
            const float cwrap = shfl_f(cout, fr + 48);
            if (fq == 0) cin = carry_prev;
            carry_prev = cwrap;
            const int n0 = (kc0 >> 2) + 2 * fq;
            ps[fr * 32 + n0] = cin + pc[0] + pc[1] + pc[2] + 0.5f * pc[3];
            ps[fr * 32 + n0 + 1] = 0.5f * pc[3] + pc[4] + pc[5] + pc[6] + 0.5f * pc[7];
        }
    }
    lds_wave_sync();
    if (lane < 16) {
        unsigned mask = 1u | (1u << cur); if (cur >= 1) mask |= 1u << (cur - 1);
        if (cur >= 3) {
            if (cur - 2 <= 5) mask |= (1u << (cur - 1)) - 2u;
            else {
                const float* my = ps + lane * 32;
                for (int r = 0; r < 5; ++r) {
                    float best = -1.0f; int bi = 1;
                    for (int j = 1; j <= cur - 2; ++j) { const float v = my[j]; if (!((mask >> j) & 1u) && v > best) { best = v; bi = j; } }
                    mask |= 1u << bi;
                }
            }
        }
        msk[lane] = mask;
    }
    lds_wave_sync();
    const unsigned qmask = msk[fr];
    lds_wave_sync();
    {
        const bf16_t* Kb = p.kF + ((size_t)b * NVH + 6 + kv) * 64 * SEQ;
        const bf16_t* VTb = p.vT + ((size_t)b * NVH + 6 + kv) * 64 * SEQ;
        attn_init<3>(o, m, l);
        unsigned um = qmask;
        um |= shfl_u(um, lane ^ 1); um |= shfl_u(um, lane ^ 2); um |= shfl_u(um, lane ^ 4); um |= shfl_u(um, lane ^ 8);
        um = (unsigned)__builtin_amdgcn_readfirstlane((int)um) & (cur >= 31 ? 0xffffffffu : ((2u << cur) - 1u));
        unsigned long long cm = 0ull;
        for (unsigned r = um; r; r &= r - 1) { const int kb = __builtin_ctz(r); cm |= 3ull << (2 * kb); }
        MaskIt it{cm};
        attn_run<false, true>(it, Kb, NMAIN, VTb, SEQ, fr, fq, [&](int kc0, const KVFrag& f) {
            const bool mine = (qmask >> (kc0 >> 6)) & 1u;
            const int dq = t - kc0 - 8 * fq;
            attn_compute<3, true>(f, qf, o, m, l, [&](int g, int j, float raw) { const int dist = dq - j; return (mine && dist >= 0) ? raw * SCL2 - sl[g] * (float)dist : MASKV; });
        });
#pragma unroll
        for (int g = 0; g < 3; ++g) {
            const float lt = lsum4(l[g]); const float sc = (lt > 0.f ? __builtin_amdgcn_rcpf(lt) : 0.f) * sigmoidf_fast(gl[g * 3 + 1]);
#pragma unroll
            for (int dt = 0; dt < 4; ++dt) otv[(g * 4 + dt) * 64] += o[g][dt] * sc;
        }
    }
    {
        const bf16_t* Kb = p.kF + ((size_t)b * NVH + 8 + kv) * 64 * SEQ;
        const bf16_t* VTb = p.vT + ((size_t)b * NVH + 8 + kv) * 64 * SEQ;
        attn_init<3>(o, m, l);
        RangeIt it{max(0, t0 - 511) >> 5, (t0 + 15) >> 5};
        attn_run<false, true>(it, Kb, NMAIN, VTb, SEQ, fr, fq, [&](int kc0, const KVFrag& f) {
            const int dq = t - kc0 - 8 * fq;
            attn_compute<3, true>(f, qf, o, m, l, [&](int g, int j, float raw) { const int dist = dq - j; return ((unsigned)dist < 512u) ? raw * SCL2 - sl[g] * (float)dist : MASKV; });
        });
#pragma unroll
        for (int g = 0; g < 3; ++g) {
            const float lt = lsum4(l[g]); const float sc = (lt > 0.f ? __builtin_amdgcn_rcpf(lt) : 0.f) * sigmoidf_fast(gl[g * 3 + 2]);
            unsigned char* dst = (unsigned char*)p.ob + ((size_t)b * SEQ + t) * DM + 640 + (kv * 3 + g) * 64 + 4 * fq;
#pragma unroll
            for (int dt = 0; dt < 4; ++dt) store_o4(dst + dt * 16, otv[(g * 4 + dt) * 64] + o[g][dt] * sc);
        }
    }
}

template <bool WITH_CONV>
__device__ __forceinline__ void phase_attn(const Params& p, int l, char* lds, int cslot = 16) {
    int tid = threadIdx.x; asm volatile("" : "+v"(tid));
    const int wid = tid >> 6, lane = tid & 63, fr = lane & 15, fq = lane >> 4;
    float* ps = (float*)(lds + wid * 16896); unsigned* msk = (unsigned*)(ps + 512); float* otl = ps + 576;
    unsigned* ctr = p.ctrl + cslot + l;
    constexpr unsigned NU_NSA = NB * 2 * 128, NU_FOX = NB * 4 * 32, NU_SWA = NB * 2 * 128, NU_ATT = NU_NSA + NU_FOX + NU_SWA;
    for (;;) {
        unsigned u = 0;
        if (lane == 0) u = __hip_atomic_fetch_add(ctr, 1u, __ATOMIC_RELAXED, __HIP_MEMORY_SCOPE_AGENT);
        u = (unsigned)__builtin_amdgcn_readfirstlane((int)u);
        if (WITH_CONV) {
            constexpr unsigned TOTQ = NU_ATT + (unsigned)CONV_TILES;
            if (u >= TOTQ) break;
            const unsigned a0 = (unsigned)(((unsigned long long)u * NU_ATT) / TOTQ), a1 = (unsigned)(((unsigned long long)(u + 1) * NU_ATT) / TOTQ);
            if (a1 == a0) { conv_tile_wave(p, (int)(u - a0), lane, (unsigned char*)ps); continue; }
            u = a0;
        } else {
#ifndef ATT_REP
#define ATT_REP 1
#endif
            if (u >= ATT_REP * NU_ATT) break;
            if (ATT_REP > 1) u %= NU_ATT;
        }
        if (u < NU_NSA) { const int pos = 127 - (int)(u & 127), r = u >> 7; nsa_unit(p, r >> 1, r & 1, pos, fr, fq, lane, ps, msk, otl); }
        else if (u < NU_NSA + NU_FOX) { const unsigned v = u - NU_NSA; const int qb = 31 - (int)(v & 31), r = v >> 5; fox_unit(p, r >> 2, r & 3, qb, fr, fq); }
        else { const unsigned v = u - NU_NSA - NU_FOX; const int pos = 127 - (int)(v & 127), r = v >> 7; swa_unit(p, l, r >> 1, r & 1, pos, fr, fq); }
    }
}

__device__ __forceinline__ void phase_ln1_router(const Params& p, int l, char* lds) {
    int tid = threadIdx.x; asm volatile("" : "+v"(tid));
    const int wid = tid >> 6, lane = tid & 63, fr = lane & 15, fq = lane >> 4;
    float* lg = (float*)lds + wid * 512;
    int* lcnt = (int*)(lds + 16384); int* lbase = lcnt + 32;
    const float* g1 = p.ln1_g + l * DM; const float* b1 = p.ln1_b + l * DM;
    const float* rw = p.rwT + (size_t)l * NE * 1024; const float* rb = p.router_b + l * NE;
    unsigned* gcount = p.ctrl + 64 + l * NE;
    for (int grp = blockIdx.x; grp < NTOK / 128; grp += gridDim.x) {
        const int tok0 = grp * 128 + wid * 16;
        if (tid < 32) lcnt[tid] = 0;
        float4 gg[4], bb[4];
#pragma unroll
        for (int j = 0; j < 4; ++j) { gg[j] = *(const float4*)(g1 + j * 256 + lane * 4); bb[j] = *(const float4*)(b1 + j * 256 + lane * 4); }
        for (int r0 = 0; r0 < 16; r0 += 4) {
            float4 v[4][4]; float s[4], qv[4];
#pragma unroll
            for (int i = 0; i < 4; ++i)
#pragma unroll
                for (int j = 0; j < 4; ++j) { const u32x2 w = *(const u32x2*)((const bf16_t*)p.tbuf + (size_t)(tok0 + r0 + i) * DM + j * 256 + lane * 4);
                    v[i][j] = make_float4(__uint_as_float(w.x << 16), __uint_as_float(w.x & 0xffff0000u), __uint_as_float(w.y << 16), __uint_as_float(w.y & 0xffff0000u)); }
#pragma unroll
            for (int i = 0; i < 4; ++i) { s[i] = 0.f;
#pragma unroll
                for (int j = 0; j < 4; ++j) s[i] += (v[i][j].x + v[i][j].y) + (v[i][j].z + v[i][j].w); }
#pragma unroll
            for (int o = 32; o > 0; o >>= 1) {
#pragma unroll
                for (int i = 0; i < 4; ++i) s[i] += shfl_f(s[i], lane ^ o); }
#pragma unroll
            for (int i = 0; i < 4; ++i) { const float mean = s[i] * (1.0f / 1024.0f); qv[i] = 0.f;
#pragma unroll
                for (int j = 0; j < 4; ++j) { v[i][j].x -= mean; v[i][j].y -= mean; v[i][j].z -= mean; v[i][j].w -= mean; qv[i] += (v[i][j].x * v[i][j].x + v[i][j].y * v[i][j].y) + (v[i][j].z * v[i][j].z + v[i][j].w * v[i][j].w); } }
#pragma unroll
            for (int o = 32; o > 0; o >>= 1) {
#pragma unroll
                for (int i = 0; i < 4; ++i) qv[i] += shfl_f(qv[i], lane ^ o); }
#pragma unroll
            for (int i = 0; i < 4; ++i) {
                const float rstd = rsqrtf(qv[i] * (1.0f / 1024.0f) + LN_EPS);
                const size_t row = (size_t)(tok0 + r0 + i);
#pragma unroll
                for (int j = 0; j < 4; ++j) {
                    const int c = j * 256 + lane * 4;
                    float4 y; y.x = v[i][j].x * rstd * gg[j].x + bb[j].x; y.y = v[i][j].y * rstd * gg[j].y + bb[j].y; y.z = v[i][j].z * rstd * gg[j].z + bb[j].z; y.w = v[i][j].w * rstd * gg[j].w + bb[j].w;
                    { u32x2 w; w.x = pack2(y.x, y.y); w.y = pack2(y.z, y.w); *(u32x2*)((bf16_t*)p.x1f + row * DM + c) = w; }
                    *(unsigned*)((char*)p.x1b + row * DM + c) = pack4_fp8(y.x, y.y, y.z, y.w);
                }
            }
        }
        __syncthreads();
        f32x4 a0 = (f32x4){0.f, 0.f, 0.f, 0.f}, a1 = a0;
        const bf16_t* xr = (const bf16_t*)p.x1f + (size_t)(tok0 + fr) * DM + 4 * fq;
        const float* w0 = rw + (size_t)fr * 1024 + 4 * fq; const float* w1 = rw + (size_t)(16 + fr) * 1024 + 4 * fq;
#pragma unroll 4
        for (int k0 = 0; k0 < 1024; k0 += 16) {
            const u32x2 xw = *(const u32x2*)(xr + k0); const float4 wb0 = *(const float4*)(w0 + k0), wb1 = *(const float4*)(w1 + k0);
            const float4 xa = make_float4(__uint_as_float(xw.x << 16), __uint_as_float(xw.x & 0xffff0000u), __uint_as_float(xw.y << 16), __uint_as_float(xw.y & 0xffff0000u));
            a0 = __builtin_amdgcn_mfma_f32_16x16x4f32(xa.x, wb0.x, a0, 0, 0, 0); a1 = __builtin_amdgcn_mfma_f32_16x16x4f32(xa.x, wb1.x, a1, 0, 0, 0);
            a0 = __builtin_amdgcn_mfma_f32_16x16x4f32(xa.y, wb0.y, a0, 0, 0, 0); a1 = __builtin_amdgcn_mfma_f32_16x16x4f32(xa.y, wb1.y, a1, 0, 0, 0);
            a0 = __builtin_amdgcn_mfma_f32_16x16x4f32(xa.z, wb0.z, a0, 0, 0, 0); a1 = __builtin_amdgcn_mfma_f32_16x16x4f32(xa.z, wb1.z, a1, 0, 0, 0);
            a0 = __builtin_amdgcn_mfma_f32_16x16x4f32(xa.w, wb0.w, a0, 0, 0, 0); a1 = __builtin_amdgcn_mfma_f32_16x16x4f32(xa.w, wb1.w, a1, 0, 0, 0);
        }
#pragma unroll
        for (int r = 0; r < 4; ++r) { lg[(fq * 4 + r) * 32 + fr] = a0[r] + rb[fr]; lg[(fq * 4 + r) * 32 + 16 + fr] = a1[r] + rb[16 + fr]; }
        lds_wave_sync();
        int e4[4] = {0, 0, 0, 0}; int rk[4] = {0, 0, 0, 0};
        if (lane < 16) {
            const float* my = lg + lane * 32; unsigned taken = 0u; float tv[4];
#pragma unroll
            for (int k = 0; k < 4; ++k) {
                float best = NEG_INF; int bi = 0;
                for (int e = 0; e < 32; ++e) { const float xv = my[e]; if (!((taken >> e) & 1u) && xv > best) { best = xv; bi = e; } }
                taken |= 1u << bi; e4[k] = bi; tv[k] = best;
            }
            const float e1 = __expf(tv[1] - tv[0]), e2 = __expf(tv[2] - tv[0]), e3 = __expf(tv[3] - tv[0]);
            const float inv = 1.0f / (1.0f + e1 + e2 + e3);
            const size_t row = (size_t)(tok0 + lane);
            *(float4*)(p.gw + row * 4) = make_float4(inv, e1 * inv, e2 * inv, e3 * inv);
        }
        __syncthreads();
        if (lane < 16) {
#pragma unroll
            for (int k = 0; k < 4; ++k) rk[k] = atomicAdd(&lcnt[e4[k]], 1);
        }
        __syncthreads();
        if (tid < 32) { const int c = lcnt[tid]; lbase[tid] = c ? (int)__hip_atomic_fetch_add(gcount + tid, (unsigned)c, __ATOMIC_RELAXED, __HIP_MEMORY_SCOPE_AGENT) : 0; }
        __syncthreads();
        if (lane < 16) {
            const int row = tok0 + lane; int pk[4];
#pragma unroll
            for (int k = 0; k < 4; ++k) { const int pos = lbase[e4[k]] + rk[k]; p.lists[(size_t)e4[k] * LIST_CAP + pos] = row * 4 + k; pk[k] = (pos << 5) | e4[k]; }
            *(int4*)(p.top_e + (size_t)row * 4) = make_int4(pk[0], pk[1], pk[2], pk[3]);
        }
        __syncthreads();
    }
}

__device__ __forceinline__ void phase_ln2(const Params& p, int l, float* xout, char* lds) {
    int* ptile = (int*)(lds + LDS_TAB); int* ecnt = ptile + 40;
    build_tiles(p, l, ptile, ecnt);
    int tid = threadIdx.x; asm volatile("" : "+v"(tid));
    const int wid = tid >> 6, lane = tid & 63;
    const float* g2 = p.ln2_g + l * DM; const float* b2 = p.ln2_b + l * DM;
    float4 gg[4], bb[4];
#pragma unroll
    for (int j = 0; j < 4; ++j) { gg[j] = *(const float4*)(g2 + j * 256 + lane * 4); bb[j] = *(const float4*)(b2 + j * 256 + lane * 4); }
    for (int pr = blockIdx.x * NWV + wid; pr < NTOK / 2; pr += gridDim.x * NWV) {
        float4 v[2][4]; float s[2], qv[2];
        unsigned yv[2][4][4]; float gk[2][4];
#pragma unroll
        for (int i = 0; i < 2; ++i) {
            const int row = pr * 2 + i;
            const float4 gwv = *(const float4*)(p.gw + (size_t)row * 4);
            gk[i][0] = gwv.x; gk[i][1] = gwv.y; gk[i][2] = gwv.z; gk[i][3] = gwv.w;
            const int4 te = *(const int4*)(p.top_e + (size_t)row * 4);
            const int tk[4] = {te.x, te.y, te.z, te.w};
#pragma unroll
            for (int j = 0; j < 4; ++j) { const u32x2 w = *(const u32x2*)((const bf16_t*)p.x1f + (size_t)row * DM + j * 256 + lane * 4);
                v[i][j] = make_float4(__uint_as_float(w.x << 16), __uint_as_float(w.x & 0xffff0000u), __uint_as_float(w.y << 16), __uint_as_float(w.y & 0xffff0000u)); }
#pragma unroll
            for (int k = 0; k < 4; ++k) {
                const unsigned char* yr = (const unsigned char*)p.ybuf + (size_t)(ptile[tk[k] & 31] * 256 + (tk[k] >> 5)) * DM + lane * 4;
#pragma unroll
                for (int j = 0; j < 4; ++j) yv[i][k][j] = *(const unsigned*)(yr + j * 256);
            }
        }
#pragma unroll
        for (int i = 0; i < 2; ++i) { s[i] = 0.f;
#pragma unroll
            for (int j = 0; j < 4; ++j) {
                float4 a; a.x = v[i][j].x * ALPHA; a.y = v[i][j].y * ALPHA; a.z = v[i][j].z * ALPHA; a.w = v[i][j].w * ALPHA;
#pragma unroll
                for (int k = 0; k < 4; ++k) {
                    const unsigned w = yv[i][k][j];
                    const f32x2_t lo = __builtin_amdgcn_cvt_pk_f32_fp8(w, false), hi = __builtin_amdgcn_cvt_pk_f32_fp8(w, true);
                    a.x += gk[i][k] * lo.x; a.y += gk[i][k] * lo.y; a.z += gk[i][k] * hi.x; a.w += gk[i][k] * hi.y;
                }
                v[i][j] = a; s[i] += (a.x + a.y) + (a.z + a.w);
            } }
#pragma unroll
        for (int o = 32; o > 0; o >>= 1) { s[0] += shfl_f(s[0], lane ^ o); s[1] += shfl_f(s[1], lane ^ o); }
#pragma unroll
        for (int i = 0; i < 2; ++i) { const float mean = s[i] * (1.0f / 1024.0f); qv[i] = 0.f;
#pragma unroll
            for (int j = 0; j < 4; ++j) { v[i][j].x -= mean; v[i][j].y -= mean; v[i][j].z -= mean; v[i][j].w -= mean; qv[i] += (v[i][j].x * v[i][j].x + v[i][j].y * v[i][j].y) + (v[i][j].z * v[i][j].z + v[i][j].w * v[i][j].w); } }
#pragma unroll
        for (int o = 32; o > 0; o >>= 1) { qv[0] += shfl_f(qv[0], lane ^ o); qv[1] += shfl_f(qv[1], lane ^ o); }
#pragma unroll
        for (int i = 0; i < 2; ++i) {
            const float rstd = rsqrtf(qv[i] * (1.0f / 1024.0f) + LN_EPS);
            const size_t row = (size_t)(pr * 2 + i);
#pragma unroll
            for (int j = 0; j < 4; ++j) {
                const int c = j * 256 + lane * 4;
                float4 y; y.x = v[i][j].x * rstd * gg[j].x + bb[j].x; y.y = v[i][j].y * rstd * gg[j].y + bb[j].y; y.z = v[i][j].z * rstd * gg[j].z + bb[j].z; y.w = v[i][j].w * rstd * gg[j].w + bb[j].w;
                *(float4*)(xout + row * DM + c) = y;
                u32x2 w; w.x = pack2(y.x, y.y); w.y = pack2(y.z, y.w);
                *(u32x2*)(p.xb + row * DM + c) = w;
            }
        }
    }
}

#define XB_TMO      128
#define XB_XCNT(j)  (256  + 64 * (j))
#define XB_XSUB(j)  (1280 + 64 * (j))
#define XB_XGEN(j)  (2304 + 64 * (j))
#define XB_TOP      3328
#define XB_TOPGEN   3392
#define XCD_BAR_WORDS 3456
#define XB_SPIN_CAP (1u << 22)
__device__ __forceinline__ unsigned xb_ld(unsigned* p)              { return __hip_atomic_load(p, __ATOMIC_RELAXED, __HIP_MEMORY_SCOPE_AGENT); }
__device__ __forceinline__ unsigned xb_add(unsigned* p, unsigned v) { return __hip_atomic_fetch_add(p, v, __ATOMIC_RELAXED, __HIP_MEMORY_SCOPE_AGENT); }
__device__ __forceinline__ unsigned xb_xcc_id() { return (unsigned)__builtin_amdgcn_s_getreg((3 << 11) | 20) & 0xFu; }
#define XB_SPIN(cond, bar) do { unsigned _sp = 0; while (cond) { __builtin_amdgcn_s_sleep(1); \
    if ((++_sp & 255u) == 0u) { if (xb_ld(&(bar)[XB_TMO])) break; if (_sp > XB_SPIN_CAP) { atomicAdd(&(bar)[XB_TMO], 1u); break; } } } } while (0)
struct XcdBarrier { unsigned* bar; unsigned x; volatile LAS unsigned* st; };
__device__ __forceinline__ XcdBarrier xcd_barrier_post(unsigned* bar, volatile LAS unsigned* st) {
    XcdBarrier b; b.bar = bar; b.x = xb_xcc_id(); b.st = st;
    if (threadIdx.x == 0) (void)xb_add(&bar[XB_XCNT(b.x)], 1u);
    return b;
}
__device__ __forceinline__ void xcd_barrier_complete(unsigned* bar, unsigned x, unsigned& nloc, unsigned& nx) {
    const unsigned G = gridDim.x * gridDim.y * gridDim.z;
    unsigned sum, cnt, mine, sp = 0u;
    for (;;) {
        sum = 0u; cnt = 0u; mine = 0u;
#pragma unroll
        for (unsigned j = 0; j < 16; ++j) { const unsigned c = xb_ld(&bar[XB_XCNT(j)]); sum += c; cnt += (c > 0u) ? 1u : 0u; mine = (j == x) ? c : mine; }
        if (sum == G) break;
        __builtin_amdgcn_s_sleep(1);
        if ((++sp & 255u) == 0u) { if (xb_ld(&bar[XB_TMO])) break; if (sp > XB_SPIN_CAP) { atomicAdd(&bar[XB_TMO], 1u); break; } }
    }
    nloc = mine > 0u ? mine : 1u; nx = cnt > 0u ? cnt : 1u;
}
__device__ __forceinline__ void xcd_barrier(const XcdBarrier& b) {
    asm volatile("s_waitcnt vmcnt(0)" ::: "memory");
    __syncthreads();
    if (threadIdx.x == 0) {
        unsigned* bar = b.bar;
        __builtin_amdgcn_s_waitcnt(0);
        unsigned nloc = b.st[0], nx = b.st[1];
        if (nloc == 0u) { xcd_barrier_complete(bar, b.x, nloc, nx); b.st[0] = nloc; b.st[1] = nx; }
        const unsigned old = xb_add(&bar[XB_XSUB(b.x)], 1u);
        const unsigned gen = old / nloc;
        if (old + 1u == (gen + 1u) * nloc) {
            __builtin_amdgcn_fence(__ATOMIC_RELEASE, "agent");
            asm volatile("s_waitcnt vmcnt(0)" ::: "memory");
            const unsigned og = xb_add(&bar[XB_TOP], 1u);
            const unsigned tg = og / nx;
            if (og + 1u == (tg + 1u) * nx) xb_add(&bar[XB_TOPGEN], 1u);
            else XB_SPIN(xb_ld(&bar[XB_TOPGEN]) == tg, bar);
            __builtin_amdgcn_fence(__ATOMIC_ACQUIRE, "agent");
            xb_add(&bar[XB_XGEN(b.x)], 1u);
            asm volatile("s_waitcnt vmcnt(0)" ::: "memory");
        } else {
            XB_SPIN(xb_ld(&bar[XB_XGEN(b.x)]) == gen, bar);
            __builtin_amdgcn_fence(__ATOMIC_ACQUIRE, "agent");
            asm volatile("s_waitcnt vmcnt(0)" ::: "memory");
        }
    }
    __syncthreads();
}

struct KArgs { const float* in[18]; float* out; char* ws; };
constexpr size_t al256(size_t v) { return (v + 255) / 256 * 256; }
struct WSL {
    static constexpr size_t ctrl = 0;
    static constexpr size_t WinT = al256(ctrl + 65536);
    static constexpr size_t WoT = al256(WinT + (size_t)NL * NPAD * 1024 * 2);
    static constexpr size_t W1T = al256(WoT + (size_t)NL * 1024 * 1024 * 2);
    static constexpr size_t W2T = al256(W1T + (size_t)NL * 2 * 64 * 2048 * 2);
    static constexpr size_t WguT = al256(W2T + (size_t)NL * 2 * 64 * 64 * 2);
    static constexpr size_t WdnT = al256(WguT + (size_t)NL * NE * 2048 * 1024 * 2);
    static constexpr size_t rwT = al256(WdnT + (size_t)NL * NE * 1024 * 1024 * 2);
    static constexpr size_t binp = al256(rwT + (size_t)NL * NE * 1024 * 4);
    static constexpr size_t bgup = al256(binp + (size_t)NL * NPAD * 4);
    static constexpr size_t b1c = al256(bgup + (size_t)NL * NE * 2048 * 4);
    static constexpr size_t xf = al256(b1c + 4 * 64 * 4);
    static constexpr size_t xb = al256(xf + (size_t)NTOK * DM * 4);
    static constexpr size_t hb = al256(xb + (size_t)NTOK * DM * 2);
    static constexpr size_t hs = al256(hb + (size_t)NTOK * NMAIN * 2);
    static constexpr size_t vT = al256(hs + (size_t)NTOK * HS_W * 4);
    static constexpr size_t kF = al256(vT + (size_t)NB * NVH * 64 * SEQ * 2);
    static constexpr size_t cF = al256(kF + (size_t)NB * NVH * 64 * SEQ * 2);
    static constexpr size_t kc = al256(cF + (size_t)NB * 4 * SEQ * 4);
    static constexpr size_t vc = al256(kc + (size_t)NB * 2 * 128 * 64 * 2);
    static constexpr size_t vcT = al256(vc + (size_t)NB * 2 * 128 * 64 * 2);
    static constexpr size_t ob = al256(vcT + (size_t)NB * 2 * 128 * 64 * 2);
    static constexpr size_t tbuf = al256(ob + (size_t)NTOK * DM * 2);
    static constexpr size_t x1f = al256(tbuf + (size_t)NTOK * DM * 4);
    static constexpr size_t x1b = al256(x1f + (size_t)NTOK * DM * 4);
    static constexpr size_t top_e = al256(x1b + (size_t)NTOK * DM * 2);
    static constexpr size_t gw = al256(top_e + (size_t)NTOK * 4 * 4);
    static constexpr size_t lists = al256(gw + (size_t)NTOK * 4 * 4);
    static constexpr size_t act = al256(lists + (size_t)NE * LIST_CAP * 4);
    static constexpr size_t ybuf = al256(act + (size_t)MAXSLOT * DFF * 2);
    static constexpr size_t total = al256(ybuf + (size_t)MAXSLOT * DM * 2);
};
__device__ __forceinline__ Params make_params(const KArgs& k) {
    Params p;
    p.x = k.in[0]; p.w_in = k.in[1]; p.b_in = k.in[2]; p.sinks = k.in[3]; p.cmp_pe = k.in[4]; p.cmp_w1 = k.in[5]; p.cmp_w2 = k.in[6]; p.w_out = k.in[7];
    p.ln1_g = k.in[8]; p.ln1_b = k.in[9]; p.router_w = k.in[10]; p.router_b = k.in[11]; p.w_gu = k.in[12]; p.b_gu = k.in[13]; p.w_dn = k.in[14]; p.b_dn = k.in[15];
    p.ln2_g = k.in[16]; p.ln2_b = k.in[17]; p.out = k.out;
    char* w = k.ws;
    p.ctrl = (unsigned*)(w + WSL::ctrl); p.WinT = (bf16_t*)(w + WSL::WinT); p.WoT = (bf16_t*)(w + WSL::WoT); p.W1T = (bf16_t*)(w + WSL::W1T); p.W2T = (bf16_t*)(w + WSL::W2T);
    p.WguT = (bf16_t*)(w + WSL::WguT); p.WdnT = (bf16_t*)(w + WSL::WdnT); p.rwT = (float*)(w + WSL::rwT); p.binp = (float*)(w + WSL::binp); p.bgup = (float*)(w + WSL::bgup);
    p.b1c = (float*)(w + WSL::b1c); p.xf = (float*)(w + WSL::xf); p.xb = (bf16_t*)(w + WSL::xb); p.hb = (bf16_t*)(w + WSL::hb); p.hs = (float*)(w + WSL::hs); p.vT = (bf16_t*)(w + WSL::vT); p.kF = (bf16_t*)(w + WSL::kF);
    p.cF = (float*)(w + WSL::cF); p.kc = (bf16_t*)(w + WSL::kc); p.vc = (bf16_t*)(w + WSL::vc); p.vcT = (bf16_t*)(w + WSL::vcT); p.ob = (bf16_t*)(w + WSL::ob); p.tbuf = (float*)(w + WSL::tbuf);
    p.x1f = (float*)(w + WSL::x1f); p.x1b = (bf16_t*)(w + WSL::x1b); p.top_e = (int*)(w + WSL::top_e); p.gw = (float*)(w + WSL::gw); p.lists = (int*)(w + WSL::lists);
    p.act = (bf16_t*)(w + WSL::act); p.ybuf = (bf16_t*)(w + WSL::ybuf);
    return p;
}
__device__ __forceinline__ void grid_bar(const Params& p, char* lds) {
    XcdBarrier xb; xb.bar = p.ctrl + 1024; xb.x = xb_xcc_id(); xb.st = (volatile LAS unsigned*)(lds + LDS_BYTES - 16); xcd_barrier(xb);
}
__device__ __forceinline__ Params fresh_params(const KArgs& ka) {
    KArgs k2 = ka; asm volatile("" : "+s"(k2.ws));
    return make_params(k2);
}
#ifndef REP
#define REP 0
#endif
template <int L>
__device__ __forceinline__ void layer_fwd(const KArgs& ka, char* lds) {
    { const Params p = fresh_params(ka); phase_inproj(p, L, lds);        grid_bar(p, lds); }
    { const Params p = fresh_params(ka); phase_prep(p, L, lds);          grid_bar(p, lds); }
    { const Params p = fresh_params(ka); phase_attn<L == 0>(p, L, lds);  grid_bar(p, lds); }
    { const Params p = fresh_params(ka); phase_outproj(p, L, L == 0 ? p.x : p.xf, lds);  grid_bar(p, lds); }
    { const Params p = fresh_params(ka); phase_ln1_router(p, L, lds);    grid_bar(p, lds); }
    { const Params p = fresh_params(ka); phase_gateup(p, L, lds);        grid_bar(p, lds); }
    { const Params p = fresh_params(ka); phase_down(p, L, lds);          grid_bar(p, lds); }
    { const Params p = fresh_params(ka); phase_ln2(p, L, L == NL - 1 ? p.out : p.xf, lds); }
}
__global__ void __launch_bounds__(NTHR, 2) fwd_kernel(KArgs ka) {
    extern __shared__ __attribute__((aligned(16))) char lds[];
    const Params p = make_params(ka);
    cg::grid_group grid = cg::this_grid();
    volatile LAS unsigned* xst = (volatile LAS unsigned*)(lds + LDS_BYTES - 16);
    if (threadIdx.x == 0) { xst[0] = 0u; xst[1] = 0u; }
    __syncthreads();
    (void)xcd_barrier_post(p.ctrl + 1024, xst);
    phase0(p, lds);
    if (REP & 128) { grid_bar(p, lds); phase0(p, lds); }
    grid.sync();
    layer_fwd<0>(ka, lds);
    grid_bar(p, lds);
    layer_fwd<1>(ka, lds);
}

extern "C" void kernel_launch(void* const* d_in, const int* in_sizes, int n_in, void* d_out, int out_size, void* d_ws, size_t ws_size, hipStream_t stream) {
    KArgs ka{};
    for (int i = 0; i < 18; ++i) ka.in[i] = (const float*)d_in[i];
    ka.out = (float*)d_out; ka.ws = (char*)d_ws;
    if (WSL::total > ws_size) { fprintf(stderr, "workspace too small: need %zu have %zu\n", (size_t)WSL::total, ws_size); return; }
    static int grid_blocks = 0;
    if (!grid_blocks) {
        int dev = 0, cus = 0, per_cu = 0;
        (void)hipGetDevice(&dev);
        (void)hipDeviceGetAttribute(&cus, hipDeviceAttributeMultiprocessorCount, dev);
        (void)hipFuncSetAttribute((const void*)fwd_kernel, hipFuncAttributeMaxDynamicSharedMemorySize, LDS_BYTES);
        (void)hipOccupancyMaxActiveBlocksPerMultiprocessor(&per_cu, fwd_kernel, NTHR, LDS_BYTES);
        if (per_cu < 1) { fprintf(stderr, "occupancy query says 0 blocks per CU\n"); per_cu = 1; }
        grid_blocks = cus;
    }
    (void)hipMemsetAsync(d_ws, 0, 65536, stream);
    void* args[] = {&ka};
    hipError_t e = hipLaunchCooperativeKernel((const void*)fwd_kernel, dim3(grid_blocks), dim3(NTHR), args, LDS_BYTES, stream);
    if (e != hipSuccess) fprintf(stderr, "cooperative launch failed: %s (grid %d)\n", hipGetErrorString(e), grid_blocks);
}
```

```cpp
#include <hip/hip_runtime.h>
#include <hip/hip_cooperative_groups.h>
#include <cstdio>
#include <cstdint>
namespace cg = cooperative_groups;

typedef unsigned short bf16_t;
typedef short bf16x8 __attribute__((ext_vector_type(8)));
typedef float f32x4 __attribute__((ext_vector_type(4)));
typedef unsigned u32x4 __attribute__((ext_vector_type(4)));
typedef unsigned u32x2 __attribute__((ext_vector_type(2)));
typedef int v8i_t __attribute__((ext_vector_type(8)));
typedef float f32x2_t __attribute__((ext_vector_type(2)));
typedef int v4i_t __attribute__((ext_vector_type(4)));
#define LAS __attribute__((address_space(3)))
constexpr float NEG_INF = -__builtin_huge_valf();

constexpr int DM = 1024, NB = 16, SEQ = 2048, NTOK = NB * SEQ, NL = 2;
constexpr int NCOL = 2582, NMAIN = 2560, NPAD = 2688, NE = 32, DFF = 1024;
constexpr int C_FQ = 0, C_FK = 256, C_FV = 512, C_SQ = 768, C_SK = 1152, C_SV = 1280, C_NQ = 1408,
              C_NKC = 1792, C_NVC = 1920, C_NKS = 2048, C_NVS = 2176, C_NKW = 2304, C_NVW = 2432;
constexpr int HS_W = 32;
constexpr int NVH = 10;
constexpr int LIST_CAP = NTOK;
constexpr int MAXSLOT = NTOK * 4 + NE * 256;
constexpr float ALPHA = 1.41421356237f, LN_EPS = 1e-5f, QSCALE = 0.125f;
constexpr int NWV = 8, NTHR = NWV * 64;
constexpr int LDS_STAGE = 131072, LDS_TAB = LDS_STAGE, LDS_AOFF = LDS_STAGE + 2048, LDS_BYTES = LDS_AOFF + 20480 + 256;

struct Params {
    const float *x, *w_in, *b_in, *sinks, *cmp_pe, *cmp_w1, *cmp_w2, *w_out, *ln1_g, *ln1_b, *router_w, *router_b,
                *w_gu, *b_gu, *w_dn, *b_dn, *ln2_g, *ln2_b;
    float* out;
    unsigned* ctrl;
    bf16_t *WinT, *WoT, *W1T, *W2T, *WguT, *WdnT;
    float *rwT, *binp, *bgup, *b1c;
    unsigned char* xq; unsigned char* WinQ;
    float* xf; bf16_t* xb; bf16_t* hb; float* hs; bf16_t* vT; bf16_t* kF; float* cF;
    bf16_t *kc, *vc, *vcT; bf16_t* ob; float* tbuf; float* x1f; bf16_t* x1b;
    int* top_e; float* gw; int* lists; bf16_t* act; bf16_t* ybuf;
};

__device__ __forceinline__ float bf2f(bf16_t h) { return __uint_as_float(((unsigned)h) << 16); }
typedef __bf16 bf16x2_t __attribute__((ext_vector_type(2)));
__device__ __forceinline__ bf16_t f2bf(float f) { return __builtin_bit_cast(bf16_t, (__bf16)f); }
__device__ __forceinline__ unsigned pack2(float lo, float hi) { bf16x2_t v = {(__bf16)lo, (__bf16)hi}; return __builtin_bit_cast(unsigned, v); }
__device__ __forceinline__ unsigned pack4_fp8(float a, float b, float c, float d) {
    unsigned w = 0u;
    w = __builtin_amdgcn_cvt_pk_fp8_f32(a, b, w, false);
    w = __builtin_amdgcn_cvt_pk_fp8_f32(c, d, w, true);
    return w;
}
__device__ __forceinline__ float shfl_f(float v, int src_lane) { return __int_as_float(__builtin_amdgcn_ds_bpermute(src_lane << 2, __float_as_int(v))); }
__device__ __forceinline__ unsigned shfl_u(unsigned v, int src_lane) { return (unsigned)__builtin_amdgcn_ds_bpermute(src_lane << 2, (int)v); }
__device__ __forceinline__ float wave_sum(float v) {
#pragma unroll
    for (int o = 32; o > 0; o >>= 1) v += __shfl_xor(v, o);
    return v;
}
__device__ __forceinline__ float wave_max(float v) {
#pragma unroll
    for (int o = 32; o > 0; o >>= 1) v = fmaxf(v, __shfl_xor(v, o));
    return v;
}
__device__ __forceinline__ void lds_wave_sync() { asm volatile("s_waitcnt lgkmcnt(0)" ::: "memory"); __builtin_amdgcn_wave_barrier(); }
__device__ __forceinline__ float slope_swa(int hq) { return exp2f(-8.0f * (float)(2 * hq + 1) / 12.0f); }
__device__ __forceinline__ float slope_nsa(int hq) { return exp2f(-8.0f * (float)(2 * hq + 2) / 12.0f); }

__device__ __forceinline__ int perm_row(int perm, int n) {
    if (perm == 1) { if (n < 768) return n; if (n < 772) return 2560 + (n - 768); if (n < 2564) return n - 4; return n; }
    if (perm == 2) { const int f = n >> 1, s = n & 1; return (f >> 7) * 256 + s * 128 + (f & 127); }
    return n;
}
struct ConvJob { const float* src; bf16_t* dst; int K, N, kt, nt, perm; float q8; };
__device__ __forceinline__ bool conv_job(const Params& p, int t, ConvJob& jb) {
    constexpr int T_WIN = NL * 8 * 21, T_WO = NL * 8 * 8;
    if (t < T_WIN) { const int m = t / 168, r = t % 168; jb = ConvJob{p.w_in + (size_t)m * 1024 * NCOL, p.WinT + (size_t)m * NPAD * 1024, 1024, NCOL, r / 21, r % 21, 1, 0.f}; return true; }
    t -= T_WIN;
    if (t < T_WO) { const int m = t / 64, r = t % 64; jb = ConvJob{p.w_out + (size_t)m * 1024 * 1024, (bf16_t*)((char*)p.WoT + (size_t)m * 1024 * 1024), 1024, 1024, r / 8, r % 8, 0, 64.0f}; return true; }
    t -= T_WO;
    if (t < T_WIN) { const int m = t / 168, r = t % 168; jb = ConvJob{p.w_in + (size_t)m * 1024 * NCOL, (bf16_t*)(p.WinQ + (size_t)m * NMAIN * 1024), 1024, NCOL, r / 21, r % 21, 1, 64.0f}; return true; }
    return false;
}
constexpr int CONV_TILES = NL * NE * 192;
__device__ __forceinline__ void conv_tile_wave(const Params& p, int t, int lane, unsigned char* l8) {
    asm volatile("" : "+v"(lane));
    const int m = t / 192, r = t % 192;
    const float* src; unsigned char* dst; int N, kt, nt, perm;
    if (r < 128) { src = p.w_gu + (size_t)m * 1024 * 2048; dst = (unsigned char*)p.WguT + (size_t)m * 2048 * 1024; N = 2048; kt = r >> 4; nt = r & 15; perm = 2; }
    else { const int q = r - 128; src = p.w_dn + (size_t)m * 1024 * 1024; dst = (unsigned char*)p.WdnT + (size_t)m * 1024 * 1024; N = 1024; kt = q >> 3; nt = q & 7; perm = 0; }
    const float* s = src + (size_t)(kt * 128 + (lane >> 5)) * N + nt * 128 + (lane & 31) * 4;
    unsigned char* lw = l8 + (lane >> 5) * 132 + (lane & 31) * 4;
    float4 va[16], vb[16];
#pragma unroll
    for (int i = 0; i < 16; ++i) va[i] = *(const float4*)(s + (size_t)(2 * i) * N);
#pragma unroll
    for (int i = 0; i < 16; ++i) vb[i] = *(const float4*)(s + (size_t)(32 + 2 * i) * N);
#pragma unroll
    for (int i = 0; i < 16; ++i) *(unsigned*)(lw + (2 * i) * 132) = pack4_fp8(va[i].x * 64.0f, va[i].y * 64.0f, va[i].z * 64.0f, va[i].w * 64.0f);
#pragma unroll
    for (int i = 0; i < 16; ++i) va[i] = *(const float4*)(s + (size_t)(64 + 2 * i) * N);
#pragma unroll
    for (int i = 0; i < 16; ++i) *(unsigned*)(lw + (32 + 2 * i) * 132) = pack4_fp8(vb[i].x * 64.0f, vb[i].y * 64.0f, vb[i].z * 64.0f, vb[i].w * 64.0f);
#pragma unroll
    for (int i = 0; i < 16; ++i) vb[i] = *(const float4*)(s + (size_t)(96 + 2 * i) * N);
#pragma unroll
    for (int i = 0; i < 16; ++i) *(unsigned*)(lw + (64 + 2 * i) * 132) = pack4_fp8(va[i].x * 64.0f, va[i].y * 64.0f, va[i].z * 64.0f, va[i].w * 64.0f);
#pragma unroll
    for (int i = 0; i < 16; ++i) *(unsigned*)(lw + (96 + 2 * i) * 132) = pack4_fp8(vb[i].x * 64.0f, vb[i].y * 64.0f, vb[i].z * 64.0f, vb[i].w * 64.0f);
    lds_wave_sync();
#pragma unroll 4
    for (int i = 0; i < 16; ++i) {
        const int idx = lane + 64 * i, kc = idx & 7, nn = idx >> 3;
        const unsigned char* l = l8 + (kc * 16) * 132 + nn;
        u32x4 w;
        w.x = (unsigned)l[0] | ((unsigned)l[132] << 8) | ((unsigned)l[264] << 16) | ((unsigned)l[396] << 24);
        w.y = (unsigned)l[528] | ((unsigned)l[660] << 8) | ((unsigned)l[792] << 16) | ((unsigned)l[924] << 24);
        w.z = (unsigned)l[1056] | ((unsigned)l[1188] << 8) | ((unsigned)l[1320] << 16) | ((unsigned)l[1452] << 24);
        w.w = (unsigned)l[1584] | ((unsigned)l[1716] << 8) | ((unsigned)l[1848] << 16) | ((unsigned)l[1980] << 24);
        *(u32x4*)(dst + (size_t)perm_row(perm, nt * 128 + nn) * 1024 + kt * 128 + kc * 16) = w;
    }
    lds_wave_sync();
}
__device__ __forceinline__ void conv_load(const ConvJob& jb, int tid, float2 (&v)[16]) {
    const int n = jb.nt * 128 + (tid & 31) * 4;
    const float* s = jb.src + (size_t)(jb.kt * 128 + (tid >> 5)) * jb.N + n;
#pragma unroll
    for (int i = 0; i < 8; ++i) {
        const float* r = s + (size_t)(16 * i) * jb.N;
        v[2 * i] = (n + 1 < jb.N) ? *(const float2*)r : make_float2(0.f, 0.f);
        v[2 * i + 1] = (n + 3 < jb.N) ? *(const float2*)(r + 2) : make_float2(0.f, 0.f);
    }
}
__device__ __forceinline__ void phase0(const Params& p, char* ldsc) {
    int tid = threadIdx.x; asm volatile("" : "+v"(tid));
    const int G = gridDim.x, bid = blockIdx.x;
    const size_t gtid = (size_t)bid * NTHR + tid, gthreads = (size_t)G * NTHR;
    {
        constexpr int TOT = 2 * NL * 8 * 21 + NL * 8 * 8;
        bf16_t* lt = (bf16_t*)ldsc;
        ConvJob jb, jn; float2 v[16], vn[16];
        int t = bid; bool have = t < TOT && conv_job(p, t, jb);
        if (have) conv_load(jb, tid, v);
        while (have) {
            const int tn = t + G; const bool hn = tn < TOT && conv_job(p, tn, jn);
            if (hn) conv_load(jn, tid, vn);
            if (jb.q8 != 0.f) {
                unsigned char* l8 = (unsigned char*)lt;
#pragma unroll
                for (int i = 0; i < 8; ++i)
                    *(unsigned*)(l8 + ((tid >> 5) + 16 * i) * 132 + (tid & 31) * 4) = pack4_fp8(v[2 * i].x * jb.q8, v[2 * i].y * jb.q8, v[2 * i + 1].x * jb.q8, v[2 * i + 1].y * jb.q8);
                __syncthreads();
#pragma unroll
                for (int i = 0; i < 2; ++i) {
                    const int idx = tid + NTHR * i, kc = idx & 7, nn = idx >> 3, n = jb.nt * 128 + nn;
                    const unsigned char* l = l8 + (kc * 16) * 132 + nn;
                    u32x4 w;
                    w.x = (unsigned)l[0] | ((unsigned)l[132] << 8) | ((unsigned)l[264] << 16) | ((unsigned)l[396] << 24);
                    w.y = (unsigned)l[528] | ((unsigned)l[660] << 8) | ((unsigned)l[792] << 16) | ((unsigned)l[924] << 24);
                    w.z = (unsigned)l[1056] | ((unsigned)l[1188] << 8) | ((unsigned)l[1320] << 16) | ((unsigned)l[1452] << 24);
                    w.w = (unsigned)l[1584] | ((unsigned)l[1716] << 8) | ((unsigned)l[1848] << 16) | ((unsigned)l[1980] << 24);
                    const int pr = perm_row(jb.perm, n);
                    if (n < jb.N && !(jb.perm == 1 && pr >= NMAIN)) *(u32x4*)((char*)jb.dst + (size_t)pr * jb.K + jb.kt * 128 + kc * 16) = w;
                }
            } else {
#pragma unroll
                for (int i = 0; i < 8; ++i) {
                    u32x2 w; w.x = pack2(v[2 * i].x, v[2 * i].y); w.y = pack2(v[2 * i + 1].x, v[2 * i + 1].y);
                    *(u32x2*)(lt + ((tid >> 5) + 16 * i) * 136 + (tid & 31) * 4) = w;
                }
                __syncthreads();
#pragma unroll
                for (int i = 0; i < 4; ++i) {
                    const int idx = tid + NTHR * i, kc = idx & 15, nn = idx >> 4, n = jb.nt * 128 + nn;
                    if (n < jb.N) {
                        const bf16_t* l = lt + (kc * 8) * 136 + nn;
                        u32x4 w;
                        w.x = (unsigned)l[0] | ((unsigned)l[136] << 16); w.y = (unsigned)l[272] | ((unsigned)l[408] << 16);
                        w.z = (unsigned)l[544] | ((unsigned)l[680] << 16); w.w = (unsigned)l[816] | ((unsigned)l[952] << 16);
                        *(u32x4*)(jb.dst + (size_t)perm_row(jb.perm, n) * jb.K + jb.kt * 128 + kc * 8) = w;
                    }
                }
            }
            __syncthreads();
            t = tn; have = hn; jb = jn;
#pragma unroll
            for (int i = 0; i < 16; ++i) v[i] = vn[i];
        }
    }
    for (size_t i = gtid; i < (size_t)NL * 2 * 2048 * 64; i += gthreads) {
        const int k = (int)(i % 2048), n = (int)((i / 2048) % 64), m = (int)(i / (2048 * 64));
        p.W1T[i] = f2bf(p.cmp_w1[((size_t)m * 2048 + k) * 64 + n]);
    }
    for (size_t i = gtid; i < (size_t)NL * 2 * 64 * 64; i += gthreads) {
        const int k = (int)(i % 64), n = (int)((i / 64) % 64), m = (int)(i / 4096);
        p.W2T[i] = f2bf(p.cmp_w2[((size_t)m * 64 + k) * 64 + n]);
    }
    for (size_t i = gtid; i < (size_t)NL * NPAD; i += gthreads) {
        const int l = (int)(i / NPAD), r = (int)(i % NPAD);
        float v = 0.f;
        if (r < 2560) { const int n = r < 768 ? r : r + 4; v = p.b_in[l * NCOL + n]; }
        else if (r < 2564) v = p.b_in[l * NCOL + 768 + (r - 2560)];
        else if (r < 2582) v = p.b_in[l * NCOL + r];
        p.binp[i] = v;
    }
    for (size_t i = gtid; i < (size_t)NL * NE * 2048; i += gthreads) {
        const int r = (int)(i % 2048); const size_t le = i / 2048;
        const int s = (r >> 7) & 1, f = (r >> 8) * 128 + (r & 127);
        p.bgup[i] = p.b_gu[le * 2048 + 2 * f + s];
    }
    for (size_t i = gtid; i < (size_t)NL * NE * 1024; i += gthreads) {
        const int k = (int)(i % 1024), e = (int)((i / 1024) % NE), l = (int)(i / (1024 * NE));
        p.rwT[i] = p.router_w[((size_t)l * 1024 + k) * NE + e];
    }
    for (size_t i = gtid; i < (size_t)NL * (NPAD - NCOL) * 1024; i += gthreads) {
        const int l = (int)(i / ((NPAD - NCOL) * 1024)); const size_t r = i % ((size_t)(NPAD - NCOL) * 1024);
        p.WinT[(size_t)l * NPAD * 1024 + (size_t)NCOL * 1024 + r] = 0;
    }
    for (size_t i = gtid; i < (size_t)NTOK * DM / 4; i += gthreads) {
        const float4 v4 = ((const float4*)p.x)[i];
        u32x2 w; w.x = pack2(v4.x, v4.y); w.y = pack2(v4.z, v4.w);
        ((u32x2*)p.xb)[i] = w;
        ((unsigned*)p.xq)[i] = pack4_fp8(v4.x, v4.y, v4.z, v4.w);
    }
    if (bid < 4) {
        float* lf = (float*)ldsc;
        const int j = tid & 63, part = tid >> 6;
        const float* pe = p.cmp_pe + (size_t)bid * 2048; const float* w1 = p.cmp_w1 + (size_t)bid * 2048 * 64;
        float s = 0.f;
        for (int kk = part * 256; kk < part * 256 + 256; ++kk) s += pe[kk] * w1[(size_t)kk * 64 + j];
        lf[tid] = s; __syncthreads();
        if (tid < 64) { float a = 0.f; for (int q = 0; q < 8; ++q) a += lf[tid + 64 * q]; p.b1c[bid * 64 + tid] = a; }
        __syncthreads();
    }
}

__device__ __forceinline__ int vcu_id() { return __builtin_amdgcn_readfirstlane(*(const volatile LAS int*)(LDS_BYTES - 32)); }
namespace pg8 {
constexpr int BM = 256, BK = 64, HALF = 128, HTB = HALF * BK * 2, NXCD = 8, WGM = 8;
__device__ __forceinline__ int lds_byte(int r, int c) { const int st = (r >> 4) * 2 + (c >> 5), rr = r & 15, cc = c & 31, ob = rr * 64 + cc * 2; return st * 1024 + (ob ^ (((ob >> 9) & 1) << 5)); }
__device__ __forceinline__ void stage_rc(int b, int& R, int& C) { const int st = b / 1024, sb = b % 1024, swz = sb ^ (((sb >> 9) & 1) << 5); R = (st >> 1) * 16 + swz / 64; C = (st & 1) * 32 + (swz % 64) / 2; }
__device__ __forceinline__ bool tile_order(int i, int G, int c, int nM, int nN, int& pm, int& pn) {
    const int nwg = nM * nN; const long L = (long)i * G + c; if (L >= nwg) return false;
    const int wgid = (int)L;
    const int nig = WGM * nN, gid = wgid / nig, fm = gid * WGM, gsz = (nM - fm) < WGM ? (nM - fm) : WGM;
    pm = fm + ((wgid % nig) % gsz); pn = (wgid % nig) / gsz; return true;
}
template <bool FP8, int SCA, class Sched, class Epi>
__device__ __forceinline__ void gemm_phase(LAS unsigned char* lds, const char* Abase, int K, const Sched& S, const Epi& E) {
    int tid = threadIdx.x; asm volatile("" : "+v"(tid));
    const int wid = __builtin_amdgcn_readfirstlane(tid >> 6), lane = tid & 63, wr = wid >> 2, wc = wid & 3, fr = lane & 15, fq = lane >> 4;
    const int nt = K / BK;
    int R0, C0, R1, C1; stage_rc(tid * 16, R0, C0); stage_rc(tid * 16 + 8192, R1, C1);
    LAS unsigned* aofs = (LAS unsigned*)(lds + LDS_AOFF) + tid;
    unsigned rg[10];
    rg[8] = (unsigned)(R0 * K + C0) * 2u; rg[9] = (unsigned)(R1 * K + C1) * 2u;
    if constexpr (FP8) { aofs[8 * NTHR] = rg[8]; aofs[9 * NTHR] = rg[9]; }
    const size_t kstep = (size_t)(BK * 2), hstep = (size_t)HALF * K * 2;
    const unsigned ldsw = (unsigned)wid * 1024u;
    const int aoff = lds_byte(wr * 64 + fr, fq * 8), boff = lds_byte(wc * 32 + fr, fq * 8);
#define PG8_SA(b, h) (((b) * 2 + (h)) * HTB)
#define PG8_SB(b, h) ((4 + (b) * 2 + (h)) * HTB)
#define PG8_OFS(sel, j) (FP8 ? aofs[((sel) * 4 + (j)) * NTHR] : ((sel) ? rg[4 + (j)] : rg[(j)]))
#define PG8_STAGE_B(bufoff, gbase) do { _Pragma("unroll") for (int _i = 0; _i < 2; ++_i) { const unsigned ob_ = FP8 ? aofs[(8 + _i) * NTHR] : rg[8 + _i]; \
        __builtin_amdgcn_global_load_lds((const unsigned*)((const char*)(gbase) + ob_), (LAS unsigned*)(lds + (bufoff) + ldsw + _i * 8192), 16, 0, 0); } } while (0)
#define PG8_STAGE_A(bufoff, kbyte, sel, h) do { const unsigned o0_ = PG8_OFS(sel, (h) * 2), o1_ = PG8_OFS(sel, (h) * 2 + 1); \
        __builtin_amdgcn_global_load_lds((const unsigned*)(Abase + (kbyte) + o0_), (LAS unsigned*)(lds + (bufoff) + ldsw), 16, 0, 0); \
        __builtin_amdgcn_global_load_lds((const unsigned*)(Abase + (kbyte) + o1_), (LAS unsigned*)(lds + (bufoff) + ldsw + 8192), 16, 0, 0); } while (0)
#define PG8_LDA(dst, b, h) do { _Pragma("unroll") for (int m = 0; m < 4; ++m) { \
        if constexpr (FP8) { const v4i_t lo_ = *(const LAS v4i_t*)(lds + PG8_SA(b, h) + aoff + m * 2048), hi_ = *(const LAS v4i_t*)(lds + PG8_SA(b, h) + aoff + m * 2048 + 1024); dst##8[m] = __builtin_shufflevector(lo_, hi_, 0, 1, 2, 3, 4, 5, 6, 7); } \
        else { _Pragma("unroll") for (int k = 0; k < 2; ++k) dst[m][k] = *(const LAS bf16x8*)(lds + PG8_SA(b, h) + aoff + m * 2048 + k * 1024); } } } while (0)
#define PG8_LDB(dst, b, h) do { _Pragma("unroll") for (int n = 0; n < 2; ++n) { \
        if constexpr (FP8) { const v4i_t lo_ = *(const LAS v4i_t*)(lds + PG8_SB(b, h) + boff + n * 2048), hi_ = *(const LAS v4i_t*)(lds + PG8_SB(b, h) + boff + n * 2048 + 1024); dst##8[n] = __builtin_shufflevector(lo_, hi_, 0, 1, 2, 3, 4, 5, 6, 7); } \
        else { _Pragma("unroll") for (int k = 0; k < 2; ++k) dst[n][k] = *(const LAS bf16x8*)(lds + PG8_SB(b, h) + boff + n * 2048 + k * 1024); } } } while (0)
#define PG8_MMA(ai, bj, At, Bt) do { __builtin_amdgcn_s_setprio(1); _Pragma("unroll") for (int m = 0; m < 4; ++m) _Pragma("unroll") for (int n = 0; n < 2; ++n) { \
        if constexpr (FP8) { acc[ai][bj][m][n] = __builtin_amdgcn_mfma_scale_f32_16x16x128_f8f6f4(Bt##8[n], At##8[m], acc[ai][bj][m][n], 0, 0, 0, SCA, 0, SCA); } \
        else { _Pragma("unroll") for (int k = 0; k < 2; ++k) acc[ai][bj][m][n] = __builtin_amdgcn_mfma_f32_16x16x32_bf16(Bt[n][k], At[m][k], acc[ai][bj][m][n], 0, 0, 0); } } \
        __builtin_amdgcn_s_setprio(0); } while (0)
#define PG8_WAIT_V(n) asm volatile("s_waitcnt vmcnt(" #n ")" ::: "memory")
#define PG8_WAIT_L(n) asm volatile("s_waitcnt lgkmcnt(" #n ")" ::: "memory")
#define PG8_BAR __builtin_amdgcn_s_barrier()
#define PG8_SCHED __builtin_amdgcn_sched_barrier(0)
    typename Sched::Unit cur, nxt; int ui = 0;
    if (!S.next(0, cur)) return;
    f32x4 acc[2][2][4][2];
#pragma unroll
    for (int a = 0; a < 2; ++a)
#pragma unroll
        for (int b = 0; b < 2; ++b)
#pragma unroll
            for (int m = 0; m < 4; ++m)
#pragma unroll
                for (int n = 0; n < 2; ++n) acc[a][b][m][n] = (f32x4){0.f, 0.f, 0.f, 0.f};
    bf16x8 At[4][2], B0[2][2], B1[2][2];
    v8i_t At8[4], B08[2], B18[2];
    { unsigned a4[2][2]; S.a_off(cur, R0, C0, R1, C1, a4); rg[0] = a4[0][0]; rg[1] = a4[0][1]; rg[2] = a4[1][0]; rg[3] = a4[1][1];
      if constexpr (FP8) { aofs[0] = a4[0][0]; aofs[NTHR] = a4[0][1]; aofs[2 * NTHR] = a4[1][0]; aofs[3 * NTHR] = a4[1][1]; } }
    const char* cB = S.b_ptr(cur);
    PG8_STAGE_B(PG8_SB(0, 0), cB); PG8_STAGE_B(PG8_SB(0, 1), cB + hstep); PG8_STAGE_A(PG8_SA(0, 0), 0, 0, 0); PG8_STAGE_A(PG8_SA(0, 1), 0, 0, 1);
    if (wr == 1) PG8_BAR;
    PG8_WAIT_V(2); PG8_BAR;
    PG8_STAGE_B(PG8_SB(1, 0), cB + kstep); PG8_STAGE_A(PG8_SA(1, 0), kstep, 0, 0); PG8_STAGE_B(PG8_SB(1, 1), cB + hstep + kstep);
    PG8_WAIT_V(6); PG8_BAR;
    for (;;) {
        const bool has_next = S.next(ui + 1, nxt);
        const char* nB = cB;
        if (has_next) { int t2 = threadIdx.x; asm volatile("" : "+v"(t2)); int r0, c0, r1, c1; stage_rc(t2 * 16, r0, c0); stage_rc(t2 * 16 + 8192, r1, c1); unsigned a4[2][2]; S.a_off(nxt, r0, c0, r1, c1, a4); nB = S.b_ptr(nxt);
            rg[4] = a4[0][0]; rg[5] = a4[0][1]; rg[6] = a4[1][0]; rg[7] = a4[1][1];
            if constexpr (FP8) { aofs[4 * NTHR] = a4[0][0]; aofs[5 * NTHR] = a4[0][1]; aofs[6 * NTHR] = a4[1][0]; aofs[7 * NTHR] = a4[1][1]; } }
        else { rg[4] = rg[0]; rg[5] = rg[1]; rg[6] = rg[2]; rg[7] = rg[3];
            if constexpr (FP8) { aofs[4 * NTHR] = aofs[0]; aofs[5 * NTHR] = aofs[NTHR]; aofs[6 * NTHR] = aofs[2 * NTHR]; aofs[7 * NTHR] = aofs[3 * NTHR]; } }
#pragma unroll 1
        for (int t = 0; t < nt; t += 2) {
            const bool last = (t == nt - 2);
            const size_t ka1 = (size_t)(t + 1) * kstep, ka2 = last ? 0 : (size_t)(t + 2) * kstep, ka3 = ka2 + kstep;
            const char* b2 = last ? nB : cB + (size_t)(t + 2) * kstep; const char* b3 = b2 + kstep;
            const int sel = last ? 1 : 0;
            PG8_LDB(B0, 0, 0); PG8_LDB(B1, 0, 1); PG8_SCHED; PG8_LDA(At, 0, 0); PG8_STAGE_A(PG8_SA(1, 1), ka1, 0, 1);
            PG8_WAIT_V(8); PG8_WAIT_L(0); PG8_BAR; PG8_MMA(0, 0, At, B0); PG8_MMA(0, 1, At, B1); PG8_BAR; PG8_SCHED;
            PG8_LDA(At, 0, 1); PG8_STAGE_B(PG8_SB(0, 0), b2); PG8_STAGE_B(PG8_SB(0, 1), b2 + hstep); PG8_STAGE_A(PG8_SA(0, 0), ka2, sel, 0);
            PG8_WAIT_V(8); PG8_WAIT_L(0); PG8_BAR; PG8_MMA(1, 0, At, B0); PG8_MMA(1, 1, At, B1); PG8_BAR; PG8_SCHED;
            PG8_LDB(B0, 1, 0); PG8_LDB(B1, 1, 1); PG8_SCHED; PG8_LDA(At, 1, 0); PG8_STAGE_A(PG8_SA(0, 1), ka2, sel, 1);
            PG8_WAIT_V(8); PG8_WAIT_L(0); PG8_BAR; PG8_MMA(0, 0, At, B0); PG8_MMA(0, 1, At, B1); PG8_BAR; PG8_SCHED;
            PG8_LDA(At, 1, 1); PG8_STAGE_B(PG8_SB(1, 0), b3); PG8_STAGE_B(PG8_SB(1, 1), b3 + hstep); PG8_STAGE_A(PG8_SA(1, 0), ka3, sel, 0);
            PG8_WAIT_V(8); PG8_WAIT_L(0); PG8_BAR; PG8_MMA(1, 0, At, B0); PG8_MMA(1, 1, At, B1); PG8_BAR; PG8_SCHED;
        }
        if (wr == 0) PG8_BAR;
        { int t2 = threadIdx.x; asm volatile("" : "+v"(t2)); E(acc, cur, wr, wc, t2 & 15, (t2 & 63) >> 4); }
        if (!has_next) break;
#pragma unroll
        for (int a = 0; a < 2; ++a)
#pragma unroll
            for (int b = 0; b < 2; ++b)
#pragma unroll
                for (int m = 0; m < 4; ++m)
#pragma unroll
                    for (int n = 0; n < 2; ++n) acc[a][b][m][n] = (f32x4){0.f, 0.f, 0.f, 0.f};
        cur = nxt; cB = nB; ++ui;
        rg[0] = rg[4]; rg[1] = rg[5]; rg[2] = rg[6]; rg[3] = rg[7];
        if constexpr (FP8) { aofs[0] = aofs[4 * NTHR]; aofs[NTHR] = aofs[5 * NTHR]; aofs[2 * NTHR] = aofs[6 * NTHR]; aofs[3 * NTHR] = aofs[7 * NTHR]; }
        if (wr == 1) PG8_BAR;
    }
    PG8_WAIT_V(0);
    PG8_BAR;
#undef PG8_SA
#undef PG8_SB
#undef PG8_STAGE_A
#undef PG8_OFS
#undef PG8_STAGE_B
#undef PG8_LDA
#undef PG8_LDB
#undef PG8_MMA
#undef PG8_WAIT_V
#undef PG8_WAIT_L
#undef PG8_BAR
#undef PG8_SCHED
}
}

struct DenseUnit { int pm, pn; };
struct DenseSched {
    typedef DenseUnit Unit;
    const char* Bt; int K, nM, nN, vc;
    __device__ __forceinline__ bool next(int i, Unit& u) const { return pg8::tile_order(i, gridDim.x, vc, nM, nN, u.pm, u.pn); }
    __device__ __forceinline__ void a_off(const Unit& u, int R0, int C0, int R1, int C1, unsigned (&off)[2][2]) const {
#pragma unroll
        for (int h = 0; h < 2; ++h) { off[h][0] = (unsigned)((u.pm * 256 + h * 128 + R0) * K + C0) * 2u; off[h][1] = (unsigned)((u.pm * 256 + h * 128 + R1) * K + C1) * 2u; }
    }
    __device__ __forceinline__ const char* b_ptr(const Unit& u) const { return Bt + (size_t)u.pn * 256 * K * 2; }
};
struct MoeUnit { int rbt, e, pn; };
template <bool GATHER>
struct MoeSched {
    typedef MoeUnit Unit;
    static constexpr int KP = 512;
    const char* Bt; const int* lists; const int* ptile; const int* ecnt; int nN, nrows, vc;
    __device__ __forceinline__ bool next(int i, Unit& u) const {
        int pm, pn; if (!pg8::tile_order(i, gridDim.x, vc, ptile[NE], nN, pm, pn)) return false;
        int e = 0; while (ptile[e + 1] <= pm) ++e;
        u.rbt = pm; u.e = e; u.pn = pn; return true;
    }
    __device__ __forceinline__ void a_off(const Unit& u, int R0, int C0, int R1, int C1, unsigned (&off)[2][2]) const {
        if (GATHER) {
            const int* lst = lists + (size_t)u.e * LIST_CAP; const int rb = u.rbt - ptile[u.e], cnt = ecnt[u.e];
#pragma unroll
            for (int h = 0; h < 2; ++h) {
                const int l0 = rb * 256 + h * 128 + R0, l1 = rb * 256 + h * 128 + R1;
                const int t0 = l0 < cnt ? (lst[l0] >> 2) : 0, t1 = l1 < cnt ? (lst[l1] >> 2) : 0;
                off[h][0] = (unsigned)(t0 * KP + C0) * 2u; off[h][1] = (unsigned)(t1 * KP + C1) * 2u;
            }
        } else {
#pragma unroll
            for (int h = 0; h < 2; ++h) { off[h][0] = (unsigned)((u.rbt * 256 + h * 128 + R0) * KP + C0) * 2u; off[h][1] = (unsigned)((u.rbt * 256 + h * 128 + R1) * KP + C1) * 2u; }
        }
    }
    __device__ __forceinline__ const char* b_ptr(const Unit& u) const { return Bt + ((size_t)u.e * nrows + (size_t)u.pn * 256) * KP * 2; }
};

struct EpiInProj {
    const Params* p; int l;
    __device__ __forceinline__ void operator()(const f32x4 (&acc)[2][2][4][2], const DenseUnit& u, int wr, int wc, int fr, int fq) const {
        const float* bias = p->binp + l * NPAD + u.pn * 256;
#pragma unroll
        for (int bj = 0; bj < 2; ++bj) {
            int kind = 0, hb0 = 0;
            if (u.pn == 1) { kind = 1; hb0 = bj * 2; } else if (u.pn == 4 && bj == 1) { kind = 1; hb0 = 4; } else if (u.pn == 8 && bj == 0) { kind = 1; hb0 = 6; } else if (u.pn == 9 && bj == 0) { kind = 1; hb0 = 8; }
            else if (u.pn == 2) { kind = 2; hb0 = bj * 2; } else if (u.pn == 5 && bj == 0) { kind = 2; hb0 = 4; } else if (u.pn == 8 && bj == 1) { kind = 2; hb0 = 6; } else if (u.pn == 9 && bj == 1) { kind = 2; hb0 = 8; }
#pragma unroll
            for (int n = 0; n < 2; ++n) {
                const int c = bj * 128 + wc * 32 + n * 16 + 4 * fq;
                const f32x4 bv = *(const f32x4*)(bias + c);
                const int hh = hb0 + ((c & 127) >> 6), d = c & 63;
#pragma unroll
                for (int ai = 0; ai < 2; ++ai)
#pragma unroll
                    for (int m = 0; m < 4; ++m) {
                        const int row = u.pm * 256 + ai * 128 + wr * 64 + m * 16 + fr;
                        const f32x4 v = acc[ai][bj][m][n] + bv;
                        u32x2 w; w.x = pack2(v[0], v[1]); w.y = pack2(v[2], v[3]);
                        if (kind == 0) *(u32x2*)(p->hb + (size_t)row * NMAIN + u.pn * 256 + c) = w;
                        else {
                            const int b = row >> 11, s = row & 2047, kk = s & 31;
                            bf16_t* blk = (kind == 1 ? p->kF : p->vT) + (((size_t)b * NVH + hh) * 64 + (s >> 5)) * 2048;
                            if (kind == 1) {
                                const int frk = (kk >> 3) * 4 + (kk & 3), t = (kk >> 2) & 1;
                                *(u32x2*)(blk + ((t * 2 + (d >> 5)) * 64 + ((d & 31) >> 3) * 16 + frk) * 8 + (d & 7)) = w;
                            } else {
                                bf16_t* vt = blk + (((d >> 4) * 64) + (kk >> 3) * 16 + (d & 15)) * 8 + (kk & 7);
                                vt[0] = (bf16_t)(w.x & 0xffff); vt[8] = (bf16_t)(w.x >> 16); vt[16] = (bf16_t)(w.y & 0xffff); vt[24] = (bf16_t)(w.y >> 16);
                            }
                        }
                    }
            }
        }
    }
};
struct EpiOutProj {
    const float* xin; float* t;
    __device__ __forceinline__ void operator()(const f32x4 (&acc)[2][2][4][2], const DenseUnit& u, int wr, int wc, int fr, int fq) const {
#pragma unroll
        for (int ai = 0; ai < 2; ++ai)
#pragma unroll
            for (int m = 0; m < 4; ++m) {
                const size_t rowoff = (size_t)(u.pm * 256 + ai * 128 + wr * 64 + m * 16 + fr) * DM + u.pn * 256 + wc * 32 + 4 * fq;
#pragma unroll
                for (int bj = 0; bj < 2; ++bj)
#pragma unroll
                    for (int n = 0; n < 2; ++n) {
                        const size_t off = rowoff + bj * 128 + n * 16;
                        const f32x4 xv = *(const f32x4*)(xin + off);
                        const f32x4 tv = xv * ALPHA + acc[ai][bj][m][n];
                        u32x2 w; w.x = pack2(tv[0], tv[1]); w.y = pack2(tv[2], tv[3]);
                        *(u32x2*)((bf16_t*)t + off) = w;
                    }
            }
    }
};
struct EpiGateUp {
    bf16_t* act; const float* bgup;
    __device__ __forceinline__ void operator()(const f32x4 (&acc)[2][2][4][2], const MoeUnit& u, int wr, int wc, int fr, int fq) const {
        const float* bias = bgup + (size_t)u.e * 2048 + u.pn * 256;
#pragma unroll
        for (int n = 0; n < 2; ++n) {
            const int c = wc * 32 + n * 16 + 4 * fq;
            const f32x4 bg = *(const f32x4*)(bias + c), bu = *(const f32x4*)(bias + 128 + c);
#pragma unroll
            for (int ai = 0; ai < 2; ++ai)
#pragma unroll
                for (int m = 0; m < 4; ++m) {
                    const f32x4 g4 = acc[ai][0][m][n] + bg, u4 = acc[ai][1][m][n] + bu;
                    float o[4];
#pragma unroll
                    for (int j = 0; j < 4; ++j) {
                        const float g = fminf(g4[j], 7.0f), uu = fminf(fmaxf(u4[j], -7.0f), 7.0f);
                        const float glu = g * __builtin_amdgcn_rcpf(1.0f + __builtin_amdgcn_exp2f(-2.455466929f * g));
                        o[j] = (uu + 1.0f) * glu;
                    }
                    *(unsigned*)((char*)act + (size_t)(u.rbt * 256 + ai * 128 + wr * 64 + m * 16 + fr) * DFF + u.pn * 128 + c) = pack4_fp8(o[0], o[1], o[2], o[3]);
                }
        }
    }
};
struct EpiDown {
    bf16_t* ybuf; const float* bdn;
    __device__ __forceinline__ void operator()(const f32x4 (&acc)[2][2][4][2], const MoeUnit& u, int wr, int wc, int fr, int fq) const {
        const float* bias = bdn + (size_t)u.e * 1024 + u.pn * 256;
#pragma unroll
        for (int bj = 0; bj < 2; ++bj)
#pragma unroll
            for (int n = 0; n < 2; ++n) {
                const int c = bj * 128 + wc * 32 + n * 16 + 4 * fq;
                const f32x4 bv = *(const f32x4*)(bias + c);
#pragma unroll
                for (int ai = 0; ai < 2; ++ai)
#pragma unroll
                    for (int m = 0; m < 4; ++m) {
                        const f32x4 v = acc[ai][bj][m][n] + bv;
                        *(unsigned*)((unsigned char*)ybuf + (size_t)(u.rbt * 256 + ai * 128 + wr * 64 + m * 16 + fr) * DM + u.pn * 256 + c) = pack4_fp8(v[0], v[1], v[2], v[3]);
                    }
            }
    }
};

__device__ __forceinline__ void phase_inproj(const Params& p, int l, char* lds) {
    DenseSched S{(const char*)p.WinQ + (size_t)l * NMAIN * 1024, 512, NTOK / 256, NMAIN / 256, vcu_id()};
    EpiInProj E{&p, l};
    pg8::gemm_phase<true, 0x7c7c7c7c>((LAS unsigned char*)lds, (const char*)p.xq, 512, S, E);
    int tid = threadIdx.x; asm volatile("" : "+v"(tid));
    const int wid = tid >> 6, lane = tid & 63, fr = lane & 15, fq = lane >> 4;
    const bf16_t* W = p.WinT + ((size_t)l * NPAD + NMAIN) * 1024;
    const float* bias = p.binp + l * NPAD + NMAIN;
    for (int u = blockIdx.x * NWV + wid; u < NTOK / 16; u += gridDim.x * NWV) {
        const bf16_t* ar = p.xb + (size_t)(u * 16 + fr) * DM + fq * 8;
        const bf16_t* w0 = W + (size_t)fr * 1024 + fq * 8; const bf16_t* w1 = W + (size_t)(16 + fr) * 1024 + fq * 8;
        f32x4 a0 = (f32x4){0.f, 0.f, 0.f, 0.f}, a1 = a0;
#pragma unroll 4
        for (int ks = 0; ks < 32; ++ks) {
            const bf16x8 a = *(const bf16x8*)(ar + ks * 32);
            a0 = __builtin_amdgcn_mfma_f32_16x16x32_bf16(a, *(const bf16x8*)(w0 + ks * 32), a0, 0, 0, 0);
            a1 = __builtin_amdgcn_mfma_f32_16x16x32_bf16(a, *(const bf16x8*)(w1 + ks * 32), a1, 0, 0, 0);
        }
#pragma unroll
        for (int r = 0; r < 4; ++r) {
            float* dst = p.hs + (size_t)(u * 16 + fq * 4 + r) * HS_W;
            dst[fr] = a0[r] + bias[fr];
            if (fr < 6) dst[16 + fr] = a1[r] + bias[16 + fr];
        }
    }
}
__device__ __forceinline__ void phase_outproj(const Params& p, int l, const float* xin, char* lds) {
    DenseSched S{(const char*)p.WoT + (size_t)l * 1024 * 1024, 512, NTOK / 256, 4, vcu_id()};
    EpiOutProj E{xin, p.tbuf};
    pg8::gemm_phase<true, 0x7c7c7c7c>((LAS unsigned char*)lds, (const char*)p.ob, 512, S, E);
}
__device__ __forceinline__ void build_tiles(const Params& p, int l, int* ptile, int* ecnt) {
    int tid = threadIdx.x; asm volatile("" : "+v"(tid));
    if (tid < NE) ecnt[tid] = (int)__hip_atomic_load(p.ctrl + 64 + l * NE + tid, __ATOMIC_RELAXED, __HIP_MEMORY_SCOPE_AGENT);
    __syncthreads();
    if (tid == 0) { int s = 0; for (int e = 0; e < NE; ++e) { ptile[e] = s; s += (ecnt[e] + 255) >> 8; } ptile[NE] = s; }
    __syncthreads();
}
__device__ __forceinline__ void phase_gateup(const Params& p, int l, char* lds) {
    int* ptile = (int*)(lds + LDS_TAB); int* ecnt = ptile + 40;
    build_tiles(p, l, ptile, ecnt);
    MoeSched<true> S{(const char*)p.WguT + (size_t)l * NE * 2048 * 1024, p.lists, ptile, ecnt, 8, 2048, vcu_id()};
    EpiGateUp E{p.act, p.bgup + (size_t)l * NE * 2048};
    pg8::gemm_phase<true, 0x7c7c7c7c>((LAS unsigned char*)lds, (const char*)p.x1b, 512, S, E);
}
__device__ __forceinline__ void phase_down(const Params& p, int l, char* lds) {
    int* ptile = (int*)(lds + LDS_TAB); int* ecnt = ptile + 40;
    build_tiles(p, l, ptile, ecnt);
    MoeSched<false> S{(const char*)p.WdnT + (size_t)l * NE * 1024 * 1024, p.lists, ptile, ecnt, 4, 1024, vcu_id()};
    EpiDown E{p.ybuf, p.b_dn + (size_t)l * NE * 1024};
    pg8::gemm_phase<true, 0x7c7c7c7c>((LAS unsigned char*)lds, (const char*)p.act, 512, S, E);
}

__device__ __forceinline__ float gelu_tanh(float x) {
    const float u = 0.7978845608028654f * (x + 0.044715f * x * x * x);
    const float e = __expf(-2.0f * fabsf(u)); const float th = (1.0f - e) / (1.0f + e);
    return 0.5f * x * (1.0f + (u < 0.f ? -th : th));
}
__device__ __forceinline__ void phase_prep(const Params& p, int l, char* lds) {
    int tid = threadIdx.x; asm volatile("" : "+v"(tid));
    const int wid = tid >> 6, lane = tid & 63, fr = lane & 15, fq = lane >> 4;
    const int gw = blockIdx.x * NWV + wid, nw = gridDim.x * NWV;
    for (int u = (int)gridDim.x - 1 - (int)blockIdx.x; u < NB * 4; u += gridDim.x) {
        const int b = u >> 2, h = u & 3;
        const float* srcp = p.hs + ((size_t)b * SEQ + tid * 4) * HS_W + h;
        float ls[4]; float tot = 0.f;
#pragma unroll
        for (int i = 0; i < 4; ++i) { const float f = srcp[(size_t)i * HS_W]; ls[i] = fminf(f, 0.f) - log1pf(__expf(-fabsf(f))); tot += ls[i]; }
        float inc = tot;
#pragma unroll
        for (int o = 1; o < 64; o <<= 1) { const float v = shfl_f(inc, lane - o); if (lane >= o) inc += v; }
        float* wtot = (float*)(lds + 65536);
        if (lane == 63) wtot[wid] = inc;
        __syncthreads();
        float base = inc - tot;
        for (int w = 0; w < wid; ++w) base += wtot[w];
        float4 o4; o4.x = base + ls[0]; o4.y = o4.x + ls[1]; o4.z = o4.y + ls[2]; o4.w = o4.z + ls[3];
        *(float4*)(p.cF + (size_t)u * SEQ + tid * 4) = o4;
        __syncthreads();
    }
    float* part = (float*)lds;
    bf16_t* h1 = (bf16_t*)(lds + 32768);
    for (int u = blockIdx.x; u < NB * 2 * 2 * 8; u += gridDim.x) {
        const int ct = u & 7, which = (u >> 3) & 1, kvh = (u >> 4) & 1, b = u >> 5;
        const int colo = (which ? C_NVC : C_NKC) + kvh * 64;
        const int c_lane = ct * 16 + fr;
        const int tokbase = min(c_lane, 126) * 16;
        const bf16_t* arow = p.hb + ((size_t)b * SEQ + tokbase) * NMAIN + colo + fq * 8;
        const bf16_t* w1 = p.W1T + ((size_t)(l * 2 + which) * 64 + fr) * 2048 + fq * 8;
        f32x4 acc[4];
#pragma unroll
        for (int n = 0; n < 4; ++n) acc[n] = (f32x4){0.f, 0.f, 0.f, 0.f};
#pragma unroll
        for (int kk = 0; kk < 8; ++kk) {
            const int ks = wid * 8 + kk;
            const bf16x8 a = *(const bf16x8*)(arow + (size_t)(ks >> 1) * NMAIN + (ks & 1) * 32);
#pragma unroll
            for (int n = 0; n < 4; ++n) {
                const bf16x8 bb = *(const bf16x8*)(w1 + (size_t)n * 16 * 2048 + ks * 32);
                acc[n] = __builtin_amdgcn_mfma_f32_16x16x32_bf16(a, bb, acc[n], 0, 0, 0);
            }
        }
#pragma unroll
        for (int n = 0; n < 4; ++n)
#pragma unroll
            for (int r = 0; r < 4; ++r) part[wid * 1024 + (fq * 4 + r) * 64 + n * 16 + fr] = acc[n][r];
        __syncthreads();
        const float* b1 = p.b1c + (l * 2 + which) * 64;
#pragma unroll
        for (int i = 0; i < 2; ++i) {
            const int e = tid + NTHR * i; float sum = 0.f;
#pragma unroll
            for (int w = 0; w < 8; ++w) sum += part[w * 1024 + e];
            h1[e] = f2bf(gelu_tanh(sum + b1[e & 63]));
        }
        __syncthreads();
        if (wid == 0) {
            const bf16_t* w2 = p.W2T + ((size_t)(l * 2 + which) * 64 + fr) * 64 + fq * 8;
            f32x4 o2[4];
#pragma unroll
            for (int n = 0; n < 4; ++n) o2[n] = (f32x4){0.f, 0.f, 0.f, 0.f};
#pragma unroll
            for (int ks = 0; ks < 2; ++ks) {
                const bf16x8 a = *(const bf16x8*)(h1 + fr * 64 + ks * 32 + fq * 8);
#pragma unroll
                for (int n = 0; n < 4; ++n) {
                    const bf16x8 bb = *(const bf16x8*)(w2 + (size_t)n * 16 * 64 + ks * 32);
                    o2[n] = __builtin_amdgcn_mfma_f32_16x16x32_bf16(a, bb, o2[n], 0, 0, 0);
                }
            }
            const size_t base = ((size_t)b * 2 + kvh) * 128 * 64;
#pragma unroll
            for (int n = 0; n < 4; ++n)
#pragma unroll
                for (int r = 0; r < 4; ++r) {
                    const int c = ct * 16 + fq * 4 + r, j2 = n * 16 + fr;
                    const bf16_t v = c < 127 ? f2bf(o2[n][r]) : (bf16_t)0;
                    if (which == 0) p.kc[base + (size_t)c * 64 + j2] = v;
                    else { p.vc[base + (size_t)c * 64 + j2] = v; p.vcT[base + (size_t)j2 * 128 + c] = v; }
                }
        }
        __syncthreads();
    }
}

constexpr float L2E = 1.4426950408889634f, MASKV = -__builtin_huge_valf(), MINIT = -1e30f, SCL2 = QSCALE * L2E;
struct KVFrag { bf16x8 k[2][2]; bf16x8 v[4]; };
template <bool FM>
__device__ __forceinline__ void k_load(KVFrag& f, const bf16_t* __restrict__ Kb, size_t ldk, int kc0, int fr, int fq) {
    if (FM) {
        const bf16_t* kp = Kb + (size_t)(kc0 >> 5) * 2048 + (fq * 16 + fr) * 8;
        f.k[0][0] = *(const bf16x8*)(kp); f.k[0][1] = *(const bf16x8*)(kp + 512); f.k[1][0] = *(const bf16x8*)(kp + 1024); f.k[1][1] = *(const bf16x8*)(kp + 1536);
    } else {
        const bf16_t* kp = Kb + (size_t)(kc0 + (fr >> 2) * 8 + (fr & 3)) * ldk + fq * 8;
        f.k[0][0] = *(const bf16x8*)(kp); f.k[0][1] = *(const bf16x8*)(kp + 32);
        f.k[1][0] = *(const bf16x8*)(kp + 4 * ldk); f.k[1][1] = *(const bf16x8*)(kp + 4 * ldk + 32);
    }
}
template <bool FM>
__device__ __forceinline__ void v_load(bf16x8 (&v)[4], const bf16_t* __restrict__ VTb, size_t ldv, int kc0, int fr, int fq) {
    if (FM) {
        const bf16_t* vp = VTb + (size_t)(kc0 >> 5) * 2048 + (fq * 16 + fr) * 8;
#pragma unroll
        for (int dt = 0; dt < 4; ++dt) v[dt] = *(const bf16x8*)(vp + dt * 512);
    } else {
        const bf16_t* vp = VTb + (size_t)fr * ldv + kc0 + fq * 8;
#pragma unroll
        for (int dt = 0; dt < 4; ++dt) v[dt] = *(const bf16x8*)(vp + (size_t)dt * 16 * ldv);
    }
}
__device__ __forceinline__ float rowmax4(float x) {
    auto r = __builtin_amdgcn_permlane32_swap(__float_as_uint(x), __float_as_uint(x), false, false);
    x = fmaxf(__uint_as_float(r[0]), __uint_as_float(r[1]));
    auto q = __builtin_amdgcn_permlane16_swap(__float_as_uint(x), __float_as_uint(x), false, false);
    return fmaxf(__uint_as_float(q[0]), __uint_as_float(q[1]));
}
__device__ __forceinline__ float rowsum4(float x) {
    auto r = __builtin_amdgcn_permlane32_swap(__float_as_uint(x), __float_as_uint(x), false, false);
    x = __uint_as_float(r[0]) + __uint_as_float(r[1]);
    auto q = __builtin_amdgcn_permlane16_swap(__float_as_uint(x), __float_as_uint(x), false, false);
    return __uint_as_float(q[0]) + __uint_as_float(q[1]);
}
template <int NQT, bool MASK, class MB>
__device__ __forceinline__ void attn_compute(const KVFrag& f, const bf16x8 (&qf)[NQT][2], f32x4 (&o)[NQT][4], float (&m)[NQT], float (&l)[NQT], const MB& mb) {
    f32x4 s0[NQT], s1[NQT];
#pragma unroll
    for (int qt = 0; qt < NQT; ++qt) {
        s0[qt] = __builtin_amdgcn_mfma_f32_16x16x32_bf16(f.k[0][0], qf[qt][0], (f32x4){0.f, 0.f, 0.f, 0.f}, 0, 0, 0);
        s1[qt] = __builtin_amdgcn_mfma_f32_16x16x32_bf16(f.k[1][0], qf[qt][0], (f32x4){0.f, 0.f, 0.f, 0.f}, 0, 0, 0);
    }
#pragma unroll
    for (int qt = 0; qt < NQT; ++qt) {
        s0[qt] = __builtin_amdgcn_mfma_f32_16x16x32_bf16(f.k[0][1], qf[qt][1], s0[qt], 0, 0, 0);
        s1[qt] = __builtin_amdgcn_mfma_f32_16x16x32_bf16(f.k[1][1], qf[qt][1], s1[qt], 0, 0, 0);
    }
    float mx[NQT];
#pragma unroll
    for (int qt = 0; qt < NQT; ++qt) {
#pragma unroll
        for (int j = 0; j < 4; ++j) { s0[qt][j] = mb(qt, j, s0[qt][j]); s1[qt][j] = mb(qt, j + 4, s1[qt][j]); }
        mx[qt] = fmaxf(fmaxf(fmaxf(s0[qt][0], s0[qt][1]), fmaxf(s0[qt][2], s0[qt][3])), fmaxf(fmaxf(s1[qt][0], s1[qt][1]), fmaxf(s1[qt][2], s1[qt][3])));
    }
#pragma unroll
    for (int qt = 0; qt < NQT; ++qt) mx[qt] = rowmax4(mx[qt]);
    bool moved = false;
#pragma unroll
    for (int qt = 0; qt < NQT; ++qt) { mx[qt] = fmaxf(m[qt], mx[qt]); moved |= (mx[qt] != m[qt]); }
    if (__ballot(moved) != 0ull) {
#pragma unroll
        for (int qt = 0; qt < NQT; ++qt) {
            const float alpha = __builtin_amdgcn_exp2f(m[qt] - mx[qt]);
            l[qt] *= alpha;
#pragma unroll
            for (int dt = 0; dt < 4; ++dt) o[qt][dt] *= alpha;
        }
    }
    bf16x8 pf[NQT];
#pragma unroll
    for (int qt = 0; qt < NQT; ++qt) {
        m[qt] = mx[qt];
        float pr[8]; float ps = 0.f;
#pragma unroll
        for (int j = 0; j < 4; ++j) {
            pr[j] = __builtin_amdgcn_exp2f(s0[qt][j] - mx[qt]);
            pr[j + 4] = __builtin_amdgcn_exp2f(s1[qt][j] - mx[qt]);
        }
#pragma unroll
        for (int j = 0; j < 8; ++j) ps += pr[j];
        l[qt] += ps;
        const u32x4 pk = {pack2(pr[0], pr[1]), pack2(pr[2], pr[3]), pack2(pr[4], pr[5]), pack2(pr[6], pr[7])};
        pf[qt] = __builtin_bit_cast(bf16x8, pk);
    }
#pragma unroll
    for (int dt = 0; dt < 4; ++dt)
#pragma unroll
        for (int qt = 0; qt < NQT; ++qt) o[qt][dt] = __builtin_amdgcn_mfma_f32_16x16x32_bf16(f.v[dt], pf[qt], o[qt][dt], 0, 0, 0);
    __builtin_amdgcn_sched_barrier(0);
}
struct RangeIt { int c, c_hi; __device__ __forceinline__ int nxt() { if (c > c_hi) return -1; return (c++) * 32; } };
struct MaskIt { unsigned long long cm; __device__ __forceinline__ int nxt() { if (!cm) return -1; const int i = __builtin_ctzll(cm); cm &= cm - 1; return i * 32; } };
template <bool PFV, bool FM, class It, class Gen>
__device__ __forceinline__ void attn_run(It& it, const bf16_t* Kb, size_t ldk, const bf16_t* VTb, size_t ldv, int fr, int fq, const Gen& gen) {
    KVFrag fa, fb;
    int ka = it.nxt(); if (ka < 0) return;
    k_load<FM>(fa, Kb, ldk, ka, fr, fq); if (PFV) v_load<FM>(fa.v, VTb, ldv, ka, fr, fq);
    for (;;) {
        const int kb = it.nxt(); if (kb >= 0) { k_load<FM>(fb, Kb, ldk, kb, fr, fq); if (PFV) v_load<FM>(fb.v, VTb, ldv, kb, fr, fq); }
        if (!PFV) v_load<FM>(fa.v, VTb, ldv, ka, fr, fq);
        gen(ka, fa);
        if (kb < 0) break;
        ka = it.nxt(); if (ka >= 0) { k_load<FM>(fa, Kb, ldk, ka, fr, fq); if (PFV) v_load<FM>(fa.v, VTb, ldv, ka, fr, fq); }
        if (!PFV) v_load<FM>(fb.v, VTb, ldv, kb, fr, fq);
        gen(kb, fb);
        if (ka < 0) break;
    }
}
template <int NQT>
__device__ __forceinline__ void attn_init(f32x4 (&o)[NQT][4], float (&m)[NQT], float (&l)[NQT]) {
#pragma unroll
    for (int qt = 0; qt < NQT; ++qt) { m[qt] = MINIT; l[qt] = 0.f;
#pragma unroll
        for (int dt = 0; dt < 4; ++dt) o[qt][dt] = (f32x4){0.f, 0.f, 0.f, 0.f}; }
}
__device__ __forceinline__ float lsum4(float l) { return rowsum4(l); }
__device__ __forceinline__ void store_o4(unsigned char* dst, const f32x4 v) { *(unsigned*)dst = pack4_fp8(v[0], v[1], v[2], v[3]); }
__device__ __forceinline__ float sigmoidf_fast(float x) { return __builtin_amdgcn_rcpf(1.0f + __builtin_amdgcn_exp2f(-L2E * x)); }

__device__ __forceinline__ void fox_unit(const Params& p, int b, int h, int qb, int fr, int fq) {
    asm volatile("" : "+v"(fr), "+v"(fq));
    const int t0 = qb * 64;
    const bf16_t* Qb = p.hb + ((size_t)b * SEQ + t0) * NMAIN + C_FQ + h * 64 + fq * 8;
    bf16x8 qf[4][2];
#pragma unroll
    for (int qt = 0; qt < 4; ++qt) { qf[qt][0] = *(const bf16x8*)(Qb + (size_t)(qt * 16 + fr) * NMAIN); qf[qt][1] = *(const bf16x8*)(Qb + (size_t)(qt * 16 + fr) * NMAIN + 32); }
    const float* cf = p.cF + ((size_t)b * 4 + h) * SEQ;
    float cq[4];
#pragma unroll
    for (int qt = 0; qt < 4; ++qt) cq[qt] = cf[t0 + qt * 16 + fr] * L2E;
    f32x4 o[4][4]; float m[4], l[4];
    attn_init<4>(o, m, l);
    const bf16_t* Kb = p.kF + ((size_t)b * NVH + h) * 64 * SEQ;
    const bf16_t* VTb = p.vT + ((size_t)b * NVH + h) * 64 * SEQ;
    RangeIt it{0, (t0 >> 5) + 1};
    attn_run<false, true>(it, Kb, NMAIN, VTb, SEQ, fr, fq, [&](int kc0, const KVFrag& f) {
        const float4 ca = *(const float4*)(cf + kc0 + 8 * fq), cb = *(const float4*)(cf + kc0 + 8 * fq + 4);
        const float ck[8] = {ca.x * L2E, ca.y * L2E, ca.z * L2E, ca.w * L2E, cb.x * L2E, cb.y * L2E, cb.z * L2E, cb.w * L2E};
        const int kq = kc0 + 8 * fq - t0 - fr;
        attn_compute<4, true>(f, qf, o, m, l, [&](int qt, int j, float raw) { return (kq + j - 16 * qt) > 0 ? MASKV : raw * SCL2 + cq[qt] - ck[j]; });
    });
#pragma unroll
    for (int qt = 0; qt < 4; ++qt) {
        const float inv = __builtin_amdgcn_rcpf(lsum4(l[qt]));
        unsigned char* dst = (unsigned char*)p.ob + ((size_t)b * SEQ + t0 + qt * 16 + fr) * DM + h * 64 + 4 * fq;
#pragma unroll
        for (int dt = 0; dt < 4; ++dt) store_o4(dst + dt * 16, o[qt][dt] * inv);
    }
}
__device__ __forceinline__ void swa_unit(const Params& p, int l_, int b, int kv, int pos, int fr, int fq) {
    asm volatile("" : "+v"(fr), "+v"(fq));
    const int t0 = pos * 16, t = t0 + fr;
    const bf16_t* Qb = p.hb + ((size_t)b * SEQ + t) * NMAIN + C_SQ + kv * 192 + fq * 8;
    bf16x8 qf[3][2];
#pragma unroll
    for (int g = 0; g < 3; ++g) { qf[g][0] = *(const bf16x8*)(Qb + g * 64); qf[g][1] = *(const bf16x8*)(Qb + g * 64 + 32); }
    float sl[3];
#pragma unroll
    for (int g = 0; g < 3; ++g) sl[g] = slope_swa(kv * 3 + g) * L2E;
    f32x4 o[3][4]; float m[3], l[3];
    attn_init<3>(o, m, l);
    const bf16_t* Kb = p.kF + ((size_t)b * NVH + 4 + kv) * 64 * SEQ;
    const bf16_t* VTb = p.vT + ((size_t)b * NVH + 4 + kv) * 64 * SEQ;
    RangeIt it{max(0, t0 - 127) >> 5, (t0 + 15) >> 5};
    attn_run<true, true>(it, Kb, NMAIN, VTb, SEQ, fr, fq, [&](int kc0, const KVFrag& f) {
        const int dq = t - kc0 - 8 * fq;
        attn_compute<3, true>(f, qf, o, m, l, [&](int g, int j, float raw) { const int dist = dq - j; return ((unsigned)dist < 128u) ? raw * SCL2 - sl[g] * (float)dist : MASKV; });
    });
#pragma unroll
    for (int g = 0; g < 3; ++g) {
        const float sink = p.sinks[l_ * 6 + kv * 3 + g] * L2E;
        const float inv = __builtin_amdgcn_rcpf(lsum4(l[g]) + __builtin_amdgcn_exp2f(sink - m[g]));
        unsigned char* dst = (unsigned char*)p.ob + ((size_t)b * SEQ + t) * DM + 256 + (kv * 3 + g) * 64 + 4 * fq;
#pragma unroll
        for (int dt = 0; dt < 4; ++dt) store_o4(dst + dt * 16, o[g][dt] * inv);
    }
}
__device__ __forceinline__ void nsa_unit(const Params& p, int b, int kv, int pos, int fr, int fq, int lane, float* ps, unsigned* msk, float* otl) {
    asm volatile("" : "+v"(fr), "+v"(fq), "+v"(lane));
    const int t0 = pos * 16, t = t0 + fr, cur = t0 >> 6;
    const bf16_t* Qb = p.hb + ((size_t)b * SEQ + t) * NMAIN + C_NQ + kv * 192 + fq * 8;
    bf16x8 qf[3][2];
#pragma unroll
    for (int g = 0; g < 3; ++g) { qf[g][0] = *(const bf16x8*)(Qb + g * 64); qf[g][1] = *(const bf16x8*)(Qb + g * 64 + 32); }
    float sl[3];
#pragma unroll
    for (int g = 0; g < 3; ++g) sl[g] = slope_nsa(kv * 3 + g) * L2E;
    const float* gl = p.hs + ((size_t)b * SEQ + t) * HS_W + 4 + kv * 9;
    f32x4 o[3][4]; float m[3], l[3];
    f32x4* otv = (f32x4*)otl + lane;
#pragma unroll
    for (int i = 0; i < 8; ++i) ps[lane + 64 * i] = 0.f;
    {
        const bf16_t* Kb = p.kc + ((size_t)b * 2 + kv) * 128 * 64;
        const bf16_t* VTb = p.vcT + ((size_t)b * 2 + kv) * 64 * 128;
        const int ncv = (t0 + 15 >= 31) ? ((t0 + 15 - 31) >> 4) + 1 : 0;
        const int nch = (ncv + 31) >> 5;
        attn_init<3>(o, m, l);
        const int dq0 = t - 31 - 16 * 8 * fq;
        RangeIt it{0, nch - 1};
        attn_run<false, false>(it, Kb, 64, VTb, 128, fr, fq, [&](int kc0, const KVFrag& f) {
            const int dq = dq0 - 16 * kc0;
            attn_compute<3, true>(f, qf, o, m, l, [&](int g, int j, float raw) { const int dist = dq - 16 * j; return dist >= 0 ? raw * SCL2 - sl[g] * (float)dist : MASKV; });
        });
        float il[3];
#pragma unroll
        for (int g = 0; g < 3; ++g) {
            const float lt = lsum4(l[g]); il[g] = lt > 0.f ? __builtin_amdgcn_rcpf(lt) : 0.f;
            const float gate = sigmoidf_fast(gl[g * 3 + 0]);
#pragma unroll
            for (int dt = 0; dt < 4; ++dt) otv[(g * 4 + dt) * 64] = o[g][dt] * (il[g] * gate);
        }
        float carry_prev = 0.f;
        for (int c = 0; c < nch; ++c) {
            const int kc0 = c * 32, dq = dq0 - 16 * kc0;
            const bf16_t* kp = Kb + (size_t)(kc0 + (fr >> 2) * 8 + (fr & 3)) * 64 + fq * 8;
            const bf16x8 k00 = *(const bf16x8*)(kp), k01 = *(const bf16x8*)(kp + 32), k10 = *(const bf16x8*)(kp + 256), k11 = *(const bf16x8*)(kp + 256 + 32);
            float pc[8];
#pragma unroll
            for (int j = 0; j < 8; ++j) pc[j] = 0.f;
#pragma unroll
            for (int g = 0; g < 3; ++g) {
                f32x4 s0 = (f32x4){0.f, 0.f, 0.f, 0.f}, s1 = s0;
                s0 = __builtin_amdgcn_mfma_f32_16x16x32_bf16(k00, qf[g][0], s0, 0, 0, 0); s0 = __builtin_amdgcn_mfma_f32_16x16x32_bf16(k01, qf[g][1], s0, 0, 0, 0);
                s1 = __builtin_amdgcn_mfma_f32_16x16x32_bf16(k10, qf[g][0], s1, 0, 0, 0); s1 = __builtin_amdgcn_mfma_f32_16x16x32_bf16(k11, qf[g][1], s1, 0, 0, 0);
#pragma unroll
                for (int j = 0; j < 8; ++j) {
                    const int dist = dq - 16 * j; const float raw = j < 4 ? s0[j] : s1[j - 4];
                    if (dist >= 0) pc[j] += __builtin_amdgcn_exp2f(raw * SCL2 - sl[g] * (float)dist - m[g]) * il[g];
                }
            }
            const float cout = 0.5f * pc[7];
            float cin = shfl_f(cout, lane - 16);
            const float cwrap = shfl_f(cout, fr + 48);
            if (fq == 0) cin = carry_prev;
            carry_prev = cwrap;
            const int n0 = (kc0 >> 2) + 2 * fq;
            ps[fr * 32 + n0] = cin + pc[0] + pc[1] + pc[2] + 0.5f * pc[3];
            ps[fr * 32 + n0 + 1] = 0.5f * pc[3] + pc[4] + pc[5] + pc[6] + 0.5f * pc[7];
        }
    }
    lds_wave_sync();
    if (lane < 16) {
        unsigned mask = 1u | (1u << cur); if (cur >= 1) mask |= 1u << (cur - 1);
        if (cur >= 3) {
            if (cur - 2 <= 5) mask |= (1u << (cur - 1)) - 2u;
            else {
                const float* my = ps + lane * 32;
                for (int r = 0; r < 5; ++r) {
                    float best = -1.0f; int bi = 1;
                    for (int j = 1; j <= cur - 2; ++j) { const float v = my[j]; if (!((mask >> j) & 1u) && v > best) { best = v; bi = j; } }
                    mask |= 1u << bi;
                }
            }
        }
        msk[lane] = mask;
    }
    lds_wave_sync();
    const unsigned qmask = msk[fr];
    lds_wave_sync();
    {
        const bf16_t* Kb = p.kF + ((size_t)b * NVH + 6 + kv) * 64 * SEQ;
        const bf16_t* VTb = p.vT + ((size_t)b * NVH + 6 + kv) * 64 * SEQ;
        attn_init<3>(o, m, l);
        unsigned um = qmask;
        um |= shfl_u(um, lane ^ 1); um |= shfl_u(um, lane ^ 2); um |= shfl_u(um, lane ^ 4); um |= shfl_u(um, lane ^ 8);
        um = (unsigned)__builtin_amdgcn_readfirstlane((int)um) & (cur >= 31 ? 0xffffffffu : ((2u << cur) - 1u));
        unsigned long long cm = 0ull;
        for (unsigned r = um; r; r &= r - 1) { const int kb = __builtin_ctz(r); cm |= 3ull << (2 * kb); }
        MaskIt it{cm};
        attn_run<false, true>(it, Kb, NMAIN, VTb, SEQ, fr, fq, [&](int kc0, const KVFrag& f) {
            const bool mine = (qmask >> (kc0 >> 6)) & 1u;
            const int dq = t - kc0 - 8 * fq;
            attn_compute<3, true>(f, qf, o, m, l, [&](int g, int j, float raw) { const int dist = dq - j; return (mine && dist >= 0) ? raw * SCL2 - sl[g] * (float)dist : MASKV; });
        });
#pragma unroll
        for (int g = 0; g < 3; ++g) {
            const float lt = lsum4(l[g]); const float sc = (lt > 0.f ? __builtin_amdgcn_rcpf(lt) : 0.f) * sigmoidf_fast(gl[g * 3 + 1]);
#pragma unroll
            for (int dt = 0; dt < 4; ++dt) otv[(g * 4 + dt) * 64] += o[g][dt] * sc;
        }
    }
    {
        const bf16_t* Kb = p.kF + ((size_t)b * NVH + 8 + kv) * 64 * SEQ;
        const bf16_t* VTb = p.vT + ((size_t)b * NVH + 8 + kv) * 64 * SEQ;
        attn_init<3>(o, m, l);
        RangeIt it{max(0, t0 - 511) >> 5, (t0 + 15) >> 5};
        attn_run<false, true>(it, Kb, NMAIN, VTb, SEQ, fr, fq, [&](int kc0, const KVFrag& f) {
            const int dq = t - kc0 - 8 * fq;
            attn_compute<3, true>(f, qf, o, m, l, [&](int g, int j, float raw) { const int dist = dq - j; return ((unsigned)dist < 512u) ? raw * SCL2 - sl[g] * (float)dist : MASKV; });
        });
#pragma unroll
        for (int g = 0; g < 3; ++g) {
            const float lt = lsum4(l[g]); const float sc = (lt > 0.f ? __builtin_amdgcn_rcpf(lt) : 0.f) * sigmoidf_fast(gl[g * 3 + 2]);
            unsigned char* dst = (unsigned char*)p.ob + ((size_t)b * SEQ + t) * DM + 640 + (kv * 3 + g) * 64 + 4 * fq;
#pragma unroll
            for (int dt = 0; dt < 4; ++dt) store_o4(dst + dt * 16, otv[(g * 4 + dt) * 64] + o[g][dt] * sc);
        }
    }
}

template <bool WITH_CONV>
__device__ __forceinline__ void phase_attn(const Params& p, int l, char* lds, int cslot = 16) {
    int tid = threadIdx.x; asm volatile("" : "+v"(tid));
    const int wid = tid >> 6, lane = tid & 63, fr = lane & 15, fq = lane >> 4;
    float* ps = (float*)(lds + wid * 16896); unsigned* msk = (unsigned*)(ps + 512); float* otl = ps + 576;
    unsigned* ctr = p.ctrl + cslot + l;
    constexpr unsigned NU_NSA = NB * 2 * 128, NU_FOX = NB * 4 * 32, NU_SWA = NB * 2 * 128, NU_ATT = NU_NSA + NU_FOX + NU_SWA;
    for (;;) {
        unsigned u = 0;
        if (lane == 0) u = __hip_atomic_fetch_add(ctr, 1u, __ATOMIC_RELAXED, __HIP_MEMORY_SCOPE_AGENT);
        u = (unsigned)__builtin_amdgcn_readfirstlane((int)u);
        if (WITH_CONV) {
            constexpr unsigned TOTQ = NU_ATT + (unsigned)CONV_TILES;
            if (u >= TOTQ) break;
            const unsigned a0 = (unsigned)(((unsigned long long)u * NU_ATT) / TOTQ), a1 = (unsigned)(((unsigned long long)(u + 1) * NU_ATT) / TOTQ);
            if (a1 == a0) { conv_tile_wave(p, (int)(u - a0), lane, (unsigned char*)ps); continue; }
            u = a0;
        } else {
#ifndef ATT_REP
#define ATT_REP 1
#endif
            if (u >= ATT_REP * NU_ATT) break;
            if (ATT_REP > 1) u %= NU_ATT;
        }
        if (u < NU_NSA) { const int pos = 127 - (int)(u & 127), r = u >> 7; nsa_unit(p, r >> 1, r & 1, pos, fr, fq, lane, ps, msk, otl); }
        else if (u < NU_NSA + NU_FOX) { const unsigned v = u - NU_NSA; const int qb = 31 - (int)(v & 31), r = v >> 5; fox_unit(p, r >> 2, r & 3, qb, fr, fq); }
        else { const unsigned v = u - NU_NSA - NU_FOX; const int pos = 127 - (int)(v & 127), r = v >> 7; swa_unit(p, l, r >> 1, r & 1, pos, fr, fq); }
    }
}

__device__ __forceinline__ void phase_ln1_router(const Params& p, int l, char* lds) {
    int tid = threadIdx.x; asm volatile("" : "+v"(tid));
    const int wid = tid >> 6, lane = tid & 63, fr = lane & 15, fq = lane >> 4;
    float* lg = (float*)lds + wid * 512;
    int* lcnt = (int*)(lds + 16384); int* lbase = lcnt + 32;
    const float* g1 = p.ln1_g + l * DM; const float* b1 = p.ln1_b + l * DM;
    const float* rw = p.rwT + (size_t)l * NE * 1024; const float* rb = p.router_b + l * NE;
    unsigned* gcount = p.ctrl + 64 + l * NE;
    for (int grp = blockIdx.x; grp < NTOK / 128; grp += gridDim.x) {
        const int tok0 = grp * 128 + wid * 16;
        if (tid < 32) lcnt[tid] = 0;
        float4 gg[4], bb[4];
#pragma unroll
        for (int j = 0; j < 4; ++j) { gg[j] = *(const float4*)(g1 + j * 256 + lane * 4); bb[j] = *(const float4*)(b1 + j * 256 + lane * 4); }
        for (int r0 = 0; r0 < 16; r0 += 4) {
            float4 v[4][4]; float s[4], qv[4];
#pragma unroll
            for (int i = 0; i < 4; ++i)
#pragma unroll
                for (int j = 0; j < 4; ++j) { const u32x2 w = *(const u32x2*)((const bf16_t*)p.tbuf + (size_t)(tok0 + r0 + i) * DM + j * 256 + lane * 4);
                    v[i][j] = make_float4(__uint_as_float(w.x << 16), __uint_as_float(w.x & 0xffff0000u), __uint_as_float(w.y << 16), __uint_as_float(w.y & 0xffff0000u)); }
#pragma unroll
            for (int i = 0; i < 4; ++i) { s[i] = 0.f;
#pragma unroll
                for (int j = 0; j < 4; ++j) s[i] += (v[i][j].x + v[i][j].y) + (v[i][j].z + v[i][j].w); }
#pragma unroll
            for (int o = 32; o > 0; o >>= 1) {
#pragma unroll
                for (int i = 0; i < 4; ++i) s[i] += shfl_f(s[i], lane ^ o); }
#pragma unroll
            for (int i = 0; i < 4; ++i) { const float mean = s[i] * (1.0f / 1024.0f); qv[i] = 0.f;
#pragma unroll
                for (int j = 0; j < 4; ++j) { v[i][j].x -= mean; v[i][j].y -= mean; v[i][j].z -= mean; v[i][j].w -= mean; qv[i] += (v[i][j].x * v[i][j].x + v[i][j].y * v[i][j].y) + (v[i][j].z * v[i][j].z + v[i][j].w * v[i][j].w); } }
#pragma unroll
            for (int o = 32; o > 0; o >>= 1) {
#pragma unroll
                for (int i = 0; i < 4; ++i) qv[i] += shfl_f(qv[i], lane ^ o); }
#pragma unroll
            for (int i = 0; i < 4; ++i) {
                const float rstd = rsqrtf(qv[i] * (1.0f / 1024.0f) + LN_EPS);
                const size_t row = (size_t)(tok0 + r0 + i);
#pragma unroll
                for (int j = 0; j < 4; ++j) {
                    const int c = j * 256 + lane * 4;
                    float4 y; y.x = v[i][j].x * rstd * gg[j].x + bb[j].x; y.y = v[i][j].y * rstd * gg[j].y + bb[j].y; y.z = v[i][j].z * rstd * gg[j].z + bb[j].z; y.w = v[i][j].w * rstd * gg[j].w + bb[j].w;
                    { u32x2 w; w.x = pack2(y.x, y.y); w.y = pack2(y.z, y.w); *(u32x2*)((bf16_t*)p.x1f + row * DM + c) = w; }
                    *(unsigned*)((char*)p.x1b + row * DM + c) = pack4_fp8(y.x, y.y, y.z, y.w);
                }
            }
        }
        __syncthreads();
        f32x4 a0 = (f32x4){0.f, 0.f, 0.f, 0.f}, a1 = a0;
        const bf16_t* xr = (const bf16_t*)p.x1f + (size_t)(tok0 + fr) * DM + 4 * fq;
        const float* w0 = rw + (size_t)fr * 1024 + 4 * fq; const float* w1 = rw + (size_t)(16 + fr) * 1024 + 4 * fq;
#pragma unroll 4
        for (int k0 = 0; k0 < 1024; k0 += 16) {
            const u32x2 xw = *(const u32x2*)(xr + k0); const float4 wb0 = *(const float4*)(w0 + k0), wb1 = *(const float4*)(w1 + k0);
            const float4 xa = make_float4(__uint_as_float(xw.x << 16), __uint_as_float(xw.x & 0xffff0000u), __uint_as_float(xw.y << 16), __uint_as_float(xw.y & 0xffff0000u));
            a0 = __builtin_amdgcn_mfma_f32_16x16x4f32(xa.x, wb0.x, a0, 0, 0, 0); a1 = __builtin_amdgcn_mfma_f32_16x16x4f32(xa.x, wb1.x, a1, 0, 0, 0);
            a0 = __builtin_amdgcn_mfma_f32_16x16x4f32(xa.y, wb0.y, a0, 0, 0, 0); a1 = __builtin_amdgcn_mfma_f32_16x16x4f32(xa.y, wb1.y, a1, 0, 0, 0);
            a0 = __builtin_amdgcn_mfma_f32_16x16x4f32(xa.z, wb0.z, a0, 0, 0, 0); a1 = __builtin_amdgcn_mfma_f32_16x16x4f32(xa.z, wb1.z, a1, 0, 0, 0);
            a0 = __builtin_amdgcn_mfma_f32_16x16x4f32(xa.w, wb0.w, a0, 0, 0, 0); a1 = __builtin_amdgcn_mfma_f32_16x16x4f32(xa.w, wb1.w, a1, 0, 0, 0);
        }
#pragma unroll
        for (int r = 0; r < 4; ++r) { lg[(fq * 4 + r) * 32 + fr] = a0[r] + rb[fr]; lg[(fq * 4 + r) * 32 + 16 + fr] = a1[r] + rb[16 + fr]; }
        lds_wave_sync();
        int e4[4] = {0, 0, 0, 0}; int rk[4] = {0, 0, 0, 0};
        if (lane < 16) {
            const float* my = lg + lane * 32; unsigned taken = 0u; float tv[4];
#pragma unroll
            for (int k = 0; k < 4; ++k) {
                float best = NEG_INF; int bi = 0;
                for (int e = 0; e < 32; ++e) { const float xv = my[e]; if (!((taken >> e) & 1u) && xv > best) { best = xv; bi = e; } }
                taken |= 1u << bi; e4[k] = bi; tv[k] = best;
            }
            const float e1 = __expf(tv[1] - tv[0]), e2 = __expf(tv[2] - tv[0]), e3 = __expf(tv[3] - tv[0]);
            const float inv = 1.0f / (1.0f + e1 + e2 + e3);
            const size_t row = (size_t)(tok0 + lane);
            *(float4*)(p.gw + row * 4) = make_float4(inv, e1 * inv, e2 * inv, e3 * inv);
        }
        __syncthreads();
        if (lane < 16) {
#pragma unroll
            for (int k = 0; k < 4; ++k) rk[k] = atomicAdd(&lcnt[e4[k]], 1);
        }
        __syncthreads();
        if (tid < 32) { const int c = lcnt[tid]; lbase[tid] = c ? (int)__hip_atomic_fetch_add(gcount + tid, (unsigned)c, __ATOMIC_RELAXED, __HIP_MEMORY_SCOPE_AGENT) : 0; }
        __syncthreads();
        if (lane < 16) {
            const int row = tok0 + lane; int pk[4];
#pragma unroll
            for (int k = 0; k < 4; ++k) { const int pos = lbase[e4[k]] + rk[k]; p.lists[(size_t)e4[k] * LIST_CAP + pos] = row * 4 + k; pk[k] = (pos << 5) | e4[k]; }
            *(int4*)(p.top_e + (size_t)row * 4) = make_int4(pk[0], pk[1], pk[2], pk[3]);
        }
        __syncthreads();
    }
}

__device__ __forceinline__ void phase_ln2(const Params& p, int l, float* xout, char* lds) {
    int* ptile = (int*)(lds + LDS_TAB); int* ecnt = ptile + 40;
    build_tiles(p, l, ptile, ecnt);
    int tid = threadIdx.x; asm volatile("" : "+v"(tid));
    const int wid = tid >> 6, lane = tid & 63;
    const float* g2 = p.ln2_g + l * DM; const float* b2 = p.ln2_b + l * DM;
    float4 gg[4], bb[4];
#pragma unroll
    for (int j = 0; j < 4; ++j) { gg[j] = *(const float4*)(g2 + j * 256 + lane * 4); bb[j] = *(const float4*)(b2 + j * 256 + lane * 4); }
    for (int pr = blockIdx.x * NWV + wid; pr < NTOK / 2; pr += gridDim.x * NWV) {
        float4 v[2][4]; float s[2], qv[2];
        unsigned yv[2][4][4]; float gk[2][4];
#pragma unroll
        for (int i = 0; i < 2; ++i) {
            const int row = pr * 2 + i;
            const float4 gwv = *(const float4*)(p.gw + (size_t)row * 4);
            gk[i][0] = gwv.x; gk[i][1] = gwv.y; gk[i][2] = gwv.z; gk[i][3] = gwv.w;
            const int4 te = *(const int4*)(p.top_e + (size_t)row * 4);
            const int tk[4] = {te.x, te.y, te.z, te.w};
#pragma unroll
            for (int j = 0; j < 4; ++j) { const u32x2 w = *(const u32x2*)((const bf16_t*)p.x1f + (size_t)row * DM + j * 256 + lane * 4);
                v[i][j] = make_float4(__uint_as_float(w.x << 16), __uint_as_float(w.x & 0xffff0000u), __uint_as_float(w.y << 16), __uint_as_float(w.y & 0xffff0000u)); }
#pragma unroll
            for (int k = 0; k < 4; ++k) {
                const unsigned char* yr = (const unsigned char*)p.ybuf + (size_t)(ptile[tk[k] & 31] * 256 + (tk[k] >> 5)) * DM + lane * 4;
#pragma unroll
                for (int j = 0; j < 4; ++j) yv[i][k][j] = *(const unsigned*)(yr + j * 256);
            }
        }
#pragma unroll
        for (int i = 0; i < 2; ++i) { s[i] = 0.f;
#pragma unroll
            for (int j = 0; j < 4; ++j) {
                float4 a; a.x = v[i][j].x * ALPHA; a.y = v[i][j].y * ALPHA; a.z = v[i][j].z * ALPHA; a.w = v[i][j].w * ALPHA;
#pragma unroll
                for (int k = 0; k < 4; ++k) {
                    const unsigned w = yv[i][k][j];
                    const f32x2_t lo = __builtin_amdgcn_cvt_pk_f32_fp8(w, false), hi = __builtin_amdgcn_cvt_pk_f32_fp8(w, true);
                    a.x += gk[i][k] * lo.x; a.y += gk[i][k] * lo.y; a.z += gk[i][k] * hi.x; a.w += gk[i][k] * hi.y;
                }
                v[i][j] = a; s[i] += (a.x + a.y) + (a.z + a.w);
            } }
#pragma unroll
        for (int o = 32; o > 0; o >>= 1) { s[0] += shfl_f(s[0], lane ^ o); s[1] += shfl_f(s[1], lane ^ o); }
#pragma unroll
        for (int i = 0; i < 2; ++i) { const float mean = s[i] * (1.0f / 1024.0f); qv[i] = 0.f;
#pragma unroll
            for (int j = 0; j < 4; ++j) { v[i][j].x -= mean; v[i][j].y -= mean; v[i][j].z -= mean; v[i][j].w -= mean; qv[i] += (v[i][j].x * v[i][j].x + v[i][j].y * v[i][j].y) + (v[i][j].z * v[i][j].z + v[i][j].w * v[i][j].w); } }
#pragma unroll
        for (int o = 32; o > 0; o >>= 1) { qv[0] += shfl_f(qv[0], lane ^ o); qv[1] += shfl_f(qv[1], lane ^ o); }
#pragma unroll
        for (int i = 0; i < 2; ++i) {
            const float rstd = rsqrtf(qv[i] * (1.0f / 1024.0f) + LN_EPS);
            const size_t row = (size_t)(pr * 2 + i);
#pragma unroll
            for (int j = 0; j < 4; ++j) {
                const int c = j * 256 + lane * 4;
                float4 y; y.x = v[i][j].x * rstd * gg[j].x + bb[j].x; y.y = v[i][j].y * rstd * gg[j].y + bb[j].y; y.z = v[i][j].z * rstd * gg[j].z + bb[j].z; y.w = v[i][j].w * rstd * gg[j].w + bb[j].w;
                *(float4*)(xout + row * DM + c) = y;
                u32x2 w; w.x = pack2(y.x, y.y); w.y = pack2(y.z, y.w);
                *(u32x2*)(p.xb + row * DM + c) = w;
                *(unsigned*)(p.xq + row * DM + c) = pack4_fp8(y.x, y.y, y.z, y.w);
            }
        }
    }
}

#define XB_TMO      128
#define XB_XCNT(j)  (256  + 64 * (j))
#define XB_XSUB(j)  (1280 + 64 * (j))
#define XB_XGEN(j)  (2304 + 64 * (j))
#define XB_TOP      3328
#define XB_TOPGEN   3392
#define XCD_BAR_WORDS 3456
#define XB_SPIN_CAP (1u << 22)
__device__ __forceinline__ unsigned xb_ld(unsigned* p)              { return __hip_atomic_load(p, __ATOMIC_RELAXED, __HIP_MEMORY_SCOPE_AGENT); }
__device__ __forceinline__ unsigned xb_add(unsigned* p, unsigned v) { return __hip_atomic_fetch_add(p, v, __ATOMIC_RELAXED, __HIP_MEMORY_SCOPE_AGENT); }
__device__ __forceinline__ unsigned xb_xcc_id() { return (unsigned)__builtin_amdgcn_s_getreg((3 << 11) | 20) & 0xFu; }
#define XB_SPIN(cond, bar) do { unsigned _sp = 0; while (cond) { __builtin_amdgcn_s_sleep(1); \
    if ((++_sp & 255u) == 0u) { if (xb_ld(&(bar)[XB_TMO])) break; if (_sp > XB_SPIN_CAP) { atomicAdd(&(bar)[XB_TMO], 1u); break; } } } } while (0)
struct XcdBarrier { unsigned* bar; unsigned x; volatile LAS unsigned* st; };
__device__ __forceinline__ XcdBarrier xcd_barrier_post(unsigned* bar, volatile LAS unsigned* st) {
    XcdBarrier b; b.bar = bar; b.x = xb_xcc_id(); b.st = st;
    if (threadIdx.x == 0) (void)xb_add(&bar[XB_XCNT(b.x)], 1u);
    return b;
}
__device__ __forceinline__ void xcd_barrier_complete(unsigned* bar, unsigned x, unsigned& nloc, unsigned& nx) {
    const unsigned G = gridDim.x * gridDim.y * gridDim.z;
    unsigned sum, cnt, mine, sp = 0u;
    for (;;) {
        sum = 0u; cnt = 0u; mine = 0u;
#pragma unroll
        for (unsigned j = 0; j < 16; ++j) { const unsigned c = xb_ld(&bar[XB_XCNT(j)]); sum += c; cnt += (c > 0u) ? 1u : 0u; mine = (j == x) ? c : mine; }
        if (sum == G) break;
        __builtin_amdgcn_s_sleep(1);
        if ((++sp & 255u) == 0u) { if (xb_ld(&bar[XB_TMO])) break; if (sp > XB_SPIN_CAP) { atomicAdd(&bar[XB_TMO], 1u); break; } }
    }
    nloc = mine > 0u ? mine : 1u; nx = cnt > 0u ? cnt : 1u;
}
__device__ __forceinline__ void xcd_barrier(const XcdBarrier& b) {
    asm volatile("s_waitcnt vmcnt(0)" ::: "memory");
    __syncthreads();
    if (threadIdx.x == 0) {
        unsigned* bar = b.bar;
        __builtin_amdgcn_s_waitcnt(0);
        unsigned nloc = b.st[0], nx = b.st[1];
        if (nloc == 0u) { xcd_barrier_complete(bar, b.x, nloc, nx); b.st[0] = nloc; b.st[1] = nx; }
        const unsigned old = xb_add(&bar[XB_XSUB(b.x)], 1u);
        const unsigned gen = old / nloc;
        if (old + 1u == (gen + 1u) * nloc) {
            __builtin_amdgcn_fence(__ATOMIC_RELEASE, "agent");
            asm volatile("s_waitcnt vmcnt(0)" ::: "memory");
            const unsigned og = xb_add(&bar[XB_TOP], 1u);
            const unsigned tg = og / nx;
            if (og + 1u == (tg + 1u) * nx) xb_add(&bar[XB_TOPGEN], 1u);
            else XB_SPIN(xb_ld(&bar[XB_TOPGEN]) == tg, bar);
            __builtin_amdgcn_fence(__ATOMIC_ACQUIRE, "agent");
            xb_add(&bar[XB_XGEN(b.x)], 1u);
            asm volatile("s_waitcnt vmcnt(0)" ::: "memory");
        } else {
            XB_SPIN(xb_ld(&bar[XB_XGEN(b.x)]) == gen, bar);
            __builtin_amdgcn_fence(__ATOMIC_ACQUIRE, "agent");
            asm volatile("s_waitcnt vmcnt(0)" ::: "memory");
        }
    }
    __syncthreads();
}

struct KArgs { const float* in[18]; float* out; char* ws; };
constexpr size_t al256(size_t v) { return (v + 255) / 256 * 256; }
struct WSL {
    static constexpr size_t ctrl = 0;
    static constexpr size_t WinT = al256(ctrl + 65536);
    static constexpr size_t WoT = al256(WinT + (size_t)NL * NPAD * 1024 * 2);
    static constexpr size_t W1T = al256(WoT + (size_t)NL * 1024 * 1024 * 2);
    static constexpr size_t W2T = al256(W1T + (size_t)NL * 2 * 64 * 2048 * 2);
    static constexpr size_t WguT = al256(W2T + (size_t)NL * 2 * 64 * 64 * 2);
    static constexpr size_t WdnT = al256(WguT + (size_t)NL * NE * 2048 * 1024 * 2);
    static constexpr size_t rwT = al256(WdnT + (size_t)NL * NE * 1024 * 1024 * 2);
    static constexpr size_t binp = al256(rwT + (size_t)NL * NE * 1024 * 4);
    static constexpr size_t bgup = al256(binp + (size_t)NL * NPAD * 4);
    static constexpr size_t b1c = al256(bgup + (size_t)NL * NE * 2048 * 4);
    static constexpr size_t xf = al256(b1c + 4 * 64 * 4);
    static constexpr size_t xb = al256(xf + (size_t)NTOK * DM * 4);
    static constexpr size_t hb = al256(xb + (size_t)NTOK * DM * 2);
    static constexpr size_t hs = al256(hb + (size_t)NTOK * NMAIN * 2);
    static constexpr size_t vT = al256(hs + (size_t)NTOK * HS_W * 4);
    static constexpr size_t kF = al256(vT + (size_t)NB * NVH * 64 * SEQ * 2);
    static constexpr size_t cF = al256(kF + (size_t)NB * NVH * 64 * SEQ * 2);
    static constexpr size_t kc = al256(cF + (size_t)NB * 4 * SEQ * 4);
    static constexpr size_t vc = al256(kc + (size_t)NB * 2 * 128 * 64 * 2);
    static constexpr size_t vcT = al256(vc + (size_t)NB * 2 * 128 * 64 * 2);
    static constexpr size_t ob = al256(vcT + (size_t)NB * 2 * 128 * 64 * 2);
    static constexpr size_t tbuf = al256(ob + (size_t)NTOK * DM * 2);
    static constexpr size_t x1f = al256(tbuf + (size_t)NTOK * DM * 4);
    static constexpr size_t x1b = al256(x1f + (size_t)NTOK * DM * 4);
    static constexpr size_t top_e = al256(x1b + (size_t)NTOK * DM * 2);
    static constexpr size_t gw = al256(top_e + (size_t)NTOK * 4 * 4);
    static constexpr size_t lists = al256(gw + (size_t)NTOK * 4 * 4);
    static constexpr size_t act = al256(lists + (size_t)NE * LIST_CAP * 4);
    static constexpr size_t ybuf = al256(act + (size_t)MAXSLOT * DFF * 2);
    static constexpr size_t xq = al256(ybuf + (size_t)MAXSLOT * DM * 2);
    static constexpr size_t WinQ = al256(xq + (size_t)NTOK * DM);
    static constexpr size_t total = al256(WinQ + (size_t)NL * NMAIN * 1024);
};
__device__ __forceinline__ Params make_params(const KArgs& k) {
    Params p;
    p.x = k.in[0]; p.w_in = k.in[1]; p.b_in = k.in[2]; p.sinks = k.in[3]; p.cmp_pe = k.in[4]; p.cmp_w1 = k.in[5]; p.cmp_w2 = k.in[6]; p.w_out = k.in[7];
    p.ln1_g = k.in[8]; p.ln1_b = k.in[9]; p.router_w = k.in[10]; p.router_b = k.in[11]; p.w_gu = k.in[12]; p.b_gu = k.in[13]; p.w_dn = k.in[14]; p.b_dn = k.in[15];
    p.ln2_g = k.in[16]; p.ln2_b = k.in[17]; p.out = k.out;
    char* w = k.ws;
    p.ctrl = (unsigned*)(w + WSL::ctrl); p.WinT = (bf16_t*)(w + WSL::WinT); p.WoT = (bf16_t*)(w + WSL::WoT); p.W1T = (bf16_t*)(w + WSL::W1T); p.W2T = (bf16_t*)(w + WSL::W2T);
    p.WguT = (bf16_t*)(w + WSL::WguT); p.WdnT = (bf16_t*)(w + WSL::WdnT); p.rwT = (float*)(w + WSL::rwT); p.binp = (float*)(w + WSL::binp); p.bgup = (float*)(w + WSL::bgup);
    p.b1c = (float*)(w + WSL::b1c); p.xf = (float*)(w + WSL::xf); p.xb = (bf16_t*)(w + WSL::xb); p.hb = (bf16_t*)(w + WSL::hb); p.hs = (float*)(w + WSL::hs); p.vT = (bf16_t*)(w + WSL::vT); p.kF = (bf16_t*)(w + WSL::kF);
    p.cF = (float*)(w + WSL::cF); p.kc = (bf16_t*)(w + WSL::kc); p.vc = (bf16_t*)(w + WSL::vc); p.vcT = (bf16_t*)(w + WSL::vcT); p.ob = (bf16_t*)(w + WSL::ob); p.tbuf = (float*)(w + WSL::tbuf);
    p.x1f = (float*)(w + WSL::x1f); p.x1b = (bf16_t*)(w + WSL::x1b); p.top_e = (int*)(w + WSL::top_e); p.gw = (float*)(w + WSL::gw); p.lists = (int*)(w + WSL::lists);
    p.act = (bf16_t*)(w + WSL::act); p.ybuf = (bf16_t*)(w + WSL::ybuf); p.xq = (unsigned char*)(w + WSL::xq); p.WinQ = (unsigned char*)(w + WSL::WinQ);
    return p;
}
__device__ __forceinline__ void grid_bar(const Params& p, char* lds) {
    XcdBarrier xb; xb.bar = p.ctrl + 1024; xb.x = xb_xcc_id(); xb.st = (volatile LAS unsigned*)(lds + LDS_BYTES - 16); xcd_barrier(xb);
}
__device__ __forceinline__ Params fresh_params(const KArgs& ka) {
    KArgs k2 = ka; asm volatile("" : "+s"(k2.ws));
    return make_params(k2);
}
#ifndef REP
#define REP 0
#endif
template <int L>
__device__ __forceinline__ void layer_fwd(const KArgs& ka, char* lds) {
    { const Params p = fresh_params(ka); phase_inproj(p, L, lds);        grid_bar(p, lds); }
    { const Params p = fresh_params(ka); phase_prep(p, L, lds);          grid_bar(p, lds); }
    { const Params p = fresh_params(ka); phase_attn<L == 0>(p, L, lds);  grid_bar(p, lds); }
    { const Params p = fresh_params(ka); phase_outproj(p, L, L == 0 ? p.x : p.xf, lds);  grid_bar(p, lds); }
    { const Params p = fresh_params(ka); phase_ln1_router(p, L, lds);    grid_bar(p, lds); }
    { const Params p = fresh_params(ka); phase_gateup(p, L, lds);        grid_bar(p, lds); }
    { const Params p = fresh_params(ka); phase_down(p, L, lds);          grid_bar(p, lds); }
    { const Params p = fresh_params(ka); phase_ln2(p, L, L == NL - 1 ? p.out : p.xf, lds); }
}
__global__ void __launch_bounds__(NTHR, 2) fwd_kernel(KArgs ka) {
    extern __shared__ __attribute__((aligned(16))) char lds[];
    const Params p = make_params(ka);
    cg::grid_group grid = cg::this_grid();
    volatile LAS unsigned* xst = (volatile LAS unsigned*)(lds + LDS_BYTES - 16);
    if (threadIdx.x == 0) { xst[0] = 0u; xst[1] = 0u; }
    __syncthreads();
    (void)xcd_barrier_post(p.ctrl + 1024, xst);
    volatile LAS int* vcu = (volatile LAS int*)(lds + LDS_BYTES - 32);
    const unsigned myx = xb_xcc_id() & 7u;
    if (threadIdx.x == 0) vcu[1] = (int)__hip_atomic_fetch_add(p.ctrl + 32 + myx, 1u, __ATOMIC_RELAXED, __HIP_MEMORY_SCOPE_AGENT);
    phase0(p, lds);
    if (REP & 128) { grid_bar(p, lds); phase0(p, lds); }
    grid.sync();
    if (threadIdx.x == 0) {
        int base = 0, tot = 0;
        for (unsigned x = 0; x < 8; ++x) { const int n = (int)__hip_atomic_load(p.ctrl + 32 + x, __ATOMIC_RELAXED, __HIP_MEMORY_SCOPE_AGENT); if (x < myx) base += n; tot += n; }
        vcu[0] = (tot == (int)gridDim.x) ? base + vcu[1] : (int)blockIdx.x;
    }
    __syncthreads();
    layer_fwd<0>(ka, lds);
    grid_bar(p, lds);
    layer_fwd<1>(ka, lds);
}

extern "C" void kernel_launch(void* const* d_in, const int* in_sizes, int n_in, void* d_out, int out_size, void* d_ws, size_t ws_size, hipStream_t stream) {
    KArgs ka{};
    for (int i = 0; i < 18; ++i) ka.in[i] = (const float*)d_in[i];
    ka.out = (float*)d_out; ka.ws = (char*)d_ws;
    if (WSL::total > ws_size) { fprintf(stderr, "workspace too small: need %zu have %zu\n", (size_t)WSL::total, ws_size); return; }
    static int grid_blocks = 0;
    if (!grid_blocks) {
        int dev = 0, cus = 0, per_cu = 0;
        (void)hipGetDevice(&dev);
        (void)hipDeviceGetAttribute(&cus, hipDeviceAttributeMultiprocessorCount, dev);
        (void)hipFuncSetAttribute((const void*)fwd_kernel, hipFuncAttributeMaxDynamicSharedMemorySize, LDS_BYTES);
        (void)hipOccupancyMaxActiveBlocksPerMultiprocessor(&per_cu, fwd_kernel, NTHR, LDS_BYTES);
        if (per_cu < 1) { fprintf(stderr, "occupancy query says 0 blocks per CU\n"); per_cu = 1; }
        grid_blocks = cus;
    }
    (void)hipMemsetAsync(d_ws, 0, 65536, stream);
    void* args[] = {&ka};
    hipError_t e = hipLaunchCooperativeKernel((const void*)fwd_kernel, dim3(grid_blocks), dim3(NTHR), args, LDS_BYTES, stream);
    if (e != hipSuccess) fprintf(stderr, "cooperative launch failed: %s (grid %d)\n", hipGetErrorString(e), grid_blocks);
}
```

```cpp
#include <hip/hip_runtime.h>
#include <hip/hip_cooperative_groups.h>
#include <cstdio>
#include <cstdint>
namespace cg = cooperative_groups;

typedef unsigned short bf16_t;
typedef short bf16x8 __attribute__((ext_vector_type(8)));
typedef float f32x4 __attribute__((ext_vector_type(4)));
typedef unsigned u32x4 __attribute__((ext_vector_type(4)));
typedef unsigned u32x2 __attribute__((ext_vector_type(2)));
typedef int v8i_t __attribute__((ext_vector_type(8)));
typedef float f32x2_t __attribute__((ext_vector_type(2)));
typedef int v4i_t __attribute__((ext_vector_type(4)));
#define LAS __attribute__((address_space(3)))
constexpr float NEG_INF = -__builtin_huge_valf();

constexpr int DM = 1024, NB = 16, SEQ = 2048, NTOK = NB * SEQ, NL = 2;
constexpr int NCOL = 2582, NMAIN = 2560, NPAD = 2688, NE = 32, DFF = 1024;
constexpr int C_FQ = 0, C_FK = 256, C_FV = 512, C_SQ = 768, C_SK = 1152, C_SV = 1280, C_NQ = 1408,
              C_NKC = 1792, C_NVC = 1920, C_NKS = 2048, C_NVS = 2176, C_NKW = 2304, C_NVW = 2432;
constexpr int HS_W = 32;
constexpr int NVH = 10;
constexpr int LIST_CAP = NTOK;
constexpr int MAXSLOT = NTOK * 4 + NE * 256;
constexpr float ALPHA = 1.41421356237f, LN_EPS = 1e-5f, QSCALE = 0.125f;
constexpr int NWV = 8, NTHR = NWV * 64;
constexpr int LDS_STAGE = 131072, LDS_TAB = LDS_STAGE, LDS_AOFF = LDS_STAGE + 2048, LDS_BYTES = LDS_AOFF + 20480 + 256;

struct Params {
    const float *x, *w_in, *b_in, *sinks, *cmp_pe, *cmp_w1, *cmp_w2, *w_out, *ln1_g, *ln1_b, *router_w, *router_b,
                *w_gu, *b_gu, *w_dn, *b_dn, *ln2_g, *ln2_b;
    float* out;
    unsigned* ctrl;
    bf16_t *WinT, *WoT, *W1T, *W2T, *WguT, *WdnT;
    float *rwT, *binp, *bgup, *b1c;
    unsigned char* xq; unsigned char* WinQ;
    float* xf; bf16_t* xb; bf16_t* hb; float* hs; bf16_t* vT; bf16_t* kF; float* cF;
    bf16_t *kc, *vc, *vcT; bf16_t* ob; float* tbuf; float* x1f; bf16_t* x1b;
    int* top_e; float* gw; int* lists; bf16_t* act; bf16_t* ybuf;
};

__device__ __forceinline__ float bf2f(bf16_t h) { return __uint_as_float(((unsigned)h) << 16); }
typedef __bf16 bf16x2_t __attribute__((ext_vector_type(2)));
__device__ __forceinline__ bf16_t f2bf(float f) { return __builtin_bit_cast(bf16_t, (__bf16)f); }
__device__ __forceinline__ unsigned pack2(float lo, float hi) { bf16x2_t v = {(__bf16)lo, (__bf16)hi}; return __builtin_bit_cast(unsigned, v); }
__device__ __forceinline__ unsigned pack4_fp8(float a, float b, float c, float d) {
    unsigned w = 0u;
    w = __builtin_amdgcn_cvt_pk_fp8_f32(a, b, w, false);
    w = __builtin_amdgcn_cvt_pk_fp8_f32(c, d, w, true);
    return w;
}
__device__ __forceinline__ float shfl_f(float v, int src_lane) { return __int_as_float(__builtin_amdgcn_ds_bpermute(src_lane << 2, __float_as_int(v))); }
__device__ __forceinline__ unsigned shfl_u(unsigned v, int src_lane) { return (unsigned)__builtin_amdgcn_ds_bpermute(src_lane << 2, (int)v); }
__device__ __forceinline__ float wave_sum(float v) {
#pragma unroll
    for (int o = 32; o > 0; o >>= 1) v += __shfl_xor(v, o);
    return v;
}
__device__ __forceinline__ float wave_max(float v) {
#pragma unroll
    for (int o = 32; o > 0; o >>= 1) v = fmaxf(v, __shfl_xor(v, o));
    return v;
}
__device__ __forceinline__ void lds_wave_sync() { asm volatile("s_waitcnt lgkmcnt(0)" ::: "memory"); __builtin_amdgcn_wave_barrier(); }
__device__ __forceinline__ float slope_swa(int hq) { return exp2f(-8.0f * (float)(2 * hq + 1) / 12.0f); }
__device__ __forceinline__ float slope_nsa(int hq) { return exp2f(-8.0f * (float)(2 * hq + 2) / 12.0f); }

__device__ __forceinline__ int perm_row(int perm, int n) {
    if (perm == 1) { if (n < 768) return n; if (n < 772) return 2560 + (n - 768); if (n < 2564) return n - 4; return n; }
    if (perm == 2) { const int f = n >> 1, s = n & 1; return (f >> 7) * 256 + s * 128 + (f & 127); }
    return n;
}
struct ConvJob { const float* src; bf16_t* dst; int K, N, kt, nt, perm; float q8; };
__device__ __forceinline__ bool conv_job(const Params& p, int t, ConvJob& jb) {
    constexpr int T_WIN = NL * 8 * 21, T_WO = NL * 8 * 8;
    if (t < T_WIN) { const int m = t / 168, r = t % 168; jb = ConvJob{p.w_in + (size_t)m * 1024 * NCOL, p.WinT + (size_t)m * NPAD * 1024, 1024, NCOL, r / 21, r % 21, 1, 0.f}; return true; }
    t -= T_WIN;
    if (t < T_WO) { const int m = t / 64, r = t % 64; jb = ConvJob{p.w_out + (size_t)m * 1024 * 1024, (bf16_t*)((char*)p.WoT + (size_t)m * 1024 * 1024), 1024, 1024, r / 8, r % 8, 0, 64.0f}; return true; }
    t -= T_WO;
    if (t < T_WIN) { const int m = t / 168, r = t % 168; jb = ConvJob{p.w_in + (size_t)m * 1024 * NCOL, (bf16_t*)(p.WinQ + (size_t)m * NMAIN * 1024), 1024, NCOL, r / 21, r % 21, 1, 64.0f}; return true; }
    return false;
}
constexpr int CONV_TILES = NL * NE * 192;
__device__ __forceinline__ void conv_tile_wave(const Params& p, int t, int lane, unsigned char* l8) {
    asm volatile("" : "+v"(lane));
    const int m = t / 192, r = t % 192;
    const float* src; unsigned char* dst; int N, kt, nt, perm;
    if (r < 128) { src = p.w_gu + (size_t)m * 1024 * 2048; dst = (unsigned char*)p.WguT + (size_t)m * 2048 * 1024; N = 2048; kt = r >> 4; nt = r & 15; perm = 2; }
    else { const int q = r - 128; src = p.w_dn + (size_t)m * 1024 * 1024; dst = (unsigned char*)p.WdnT + (size_t)m * 1024 * 1024; N = 1024; kt = q >> 3; nt = q & 7; perm = 0; }
    const float* s = src + (size_t)(kt * 128 + (lane >> 5)) * N + nt * 128 + (lane & 31) * 4;
    unsigned char* lw = l8 + (lane >> 5) * 132 + (lane & 31) * 4;
    float4 va[16], vb[16];
#pragma unroll
    for (int i = 0; i < 16; ++i) va[i] = *(const float4*)(s + (size_t)(2 * i) * N);
#pragma unroll
    for (int i = 0; i < 16; ++i) vb[i] = *(const float4*)(s + (size_t)(32 + 2 * i) * N);
#pragma unroll
    for (int i = 0; i < 16; ++i) *(unsigned*)(lw + (2 * i) * 132) = pack4_fp8(va[i].x * 64.0f, va[i].y * 64.0f, va[i].z * 64.0f, va[i].w * 64.0f);
#pragma unroll
    for (int i = 0; i < 16; ++i) va[i] = *(const float4*)(s + (size_t)(64 + 2 * i) * N);
#pragma unroll
    for (int i = 0; i < 16; ++i) *(unsigned*)(lw + (32 + 2 * i) * 132) = pack4_fp8(vb[i].x * 64.0f, vb[i].y * 64.0f, vb[i].z * 64.0f, vb[i].w * 64.0f);
#pragma unroll
    for (int i = 0; i < 16; ++i) vb[i] = *(const float4*)(s + (size_t)(96 + 2 * i) * N);
#pragma unroll
    for (int i = 0; i < 16; ++i) *(unsigned*)(lw + (64 + 2 * i) * 132) = pack4_fp8(va[i].x * 64.0f, va[i].y * 64.0f, va[i].z * 64.0f, va[i].w * 64.0f);
#pragma unroll
    for (int i = 0; i < 16; ++i) *(unsigned*)(lw + (96 + 2 * i) * 132) = pack4_fp8(vb[i].x * 64.0f, vb[i].y * 64.0f, vb[i].z * 64.0f, vb[i].w * 64.0f);
    lds_wave_sync();
#pragma unroll 4
    for (int i = 0; i < 16; ++i) {
        const int idx = lane + 64 * i, kc = idx & 7, nn = idx >> 3;
        const unsigned char* l = l8 + (kc * 16) * 132 + nn;
        u32x4 w;
        w.x = (unsigned)l[0] | ((unsigned)l[132] << 8) | ((unsigned)l[264] << 16) | ((unsigned)l[396] << 24);
        w.y = (unsigned)l[528] | ((unsigned)l[660] << 8) | ((unsigned)l[792] << 16) | ((unsigned)l[924] << 24);
        w.z = (unsigned)l[1056] | ((unsigned)l[1188] << 8) | ((unsigned)l[1320] << 16) | ((unsigned)l[1452] << 24);
        w.w = (unsigned)l[1584] | ((unsigned)l[1716] << 8) | ((unsigned)l[1848] << 16) | ((unsigned)l[1980] << 24);
        *(u32x4*)(dst + (size_t)perm_row(perm, nt * 128 + nn) * 1024 + kt * 128 + kc * 16) = w;
    }
    lds_wave_sync();
}
__device__ __forceinline__ void conv_load(const ConvJob& jb, int tid, float2 (&v)[16]) {
    const int n = jb.nt * 128 + (tid & 31) * 4;
    const float* s = jb.src + (size_t)(jb.kt * 128 + (tid >> 5)) * jb.N + n;
#pragma unroll
    for (int i = 0; i < 8; ++i) {
        const float* r = s + (size_t)(16 * i) * jb.N;
        v[2 * i] = (n + 1 < jb.N) ? *(const float2*)r : make_float2(0.f, 0.f);
        v[2 * i + 1] = (n + 3 < jb.N) ? *(const float2*)(r + 2) : make_float2(0.f, 0.f);
    }
}
__device__ __forceinline__ void phase0(const Params& p, char* ldsc) {
    int tid = threadIdx.x; asm volatile("" : "+v"(tid));
    const int G = gridDim.x, bid = blockIdx.x;
    const size_t gtid = (size_t)bid * NTHR + tid, gthreads = (size_t)G * NTHR;
    {
        constexpr int TOT = 2 * NL * 8 * 21 + NL * 8 * 8;
        bf16_t* lt = (bf16_t*)ldsc;
        ConvJob jb, jn; float2 v[16], vn[16];
        int t = bid; bool have = t < TOT && conv_job(p, t, jb);
        if (have) conv_load(jb, tid, v);
        while (have) {
            const int tn = t + G; const bool hn = tn < TOT && conv_job(p, tn, jn);
            if (hn) conv_load(jn, tid, vn);
            if (jb.q8 != 0.f) {
                unsigned char* l8 = (unsigned char*)lt;
#pragma unroll
                for (int i = 0; i < 8; ++i)
                    *(unsigned*)(l8 + ((tid >> 5) + 16 * i) * 132 + (tid & 31) * 4) = pack4_fp8(v[2 * i].x * jb.q8, v[2 * i].y * jb.q8, v[2 * i + 1].x * jb.q8, v[2 * i + 1].y * jb.q8);
                __syncthreads();
#pragma unroll
                for (int i = 0; i < 2; ++i) {
                    const int idx = tid + NTHR * i, kc = idx & 7, nn = idx >> 3, n = jb.nt * 128 + nn;
                    const unsigned char* l = l8 + (kc * 16) * 132 + nn;
                    u32x4 w;
                    w.x = (unsigned)l[0] | ((unsigned)l[132] << 8) | ((unsigned)l[264] << 16) | ((unsigned)l[396] << 24);
                    w.y = (unsigned)l[528] | ((unsigned)l[660] << 8) | ((unsigned)l[792] << 16) | ((unsigned)l[924] << 24);
                    w.z = (unsigned)l[1056] | ((unsigned)l[1188] << 8) | ((unsigned)l[1320] << 16) | ((unsigned)l[1452] << 24);
                    w.w = (unsigned)l[1584] | ((unsigned)l[1716] << 8) | ((unsigned)l[1848] << 16) | ((unsigned)l[1980] << 24);
                    const int pr = perm_row(jb.perm, n);
                    if (n < jb.N && !(jb.perm == 1 && pr >= NMAIN)) *(u32x4*)((char*)jb.dst + (size_t)pr * jb.K + jb.kt * 128 + kc * 16) = w;
                }
            } else {
#pragma unroll
                for (int i = 0; i < 8; ++i) {
                    u32x2 w; w.x = pack2(v[2 * i].x, v[2 * i].y); w.y = pack2(v[2 * i + 1].x, v[2 * i + 1].y);
                    *(u32x2*)(lt + ((tid >> 5) + 16 * i) * 136 + (tid & 31) * 4) = w;
                }
                __syncthreads();
#pragma unroll
                for (int i = 0; i < 4; ++i) {
                    const int idx = tid + NTHR * i, kc = idx & 15, nn = idx >> 4, n = jb.nt * 128 + nn;
                    if (n < jb.N) {
                        const bf16_t* l = lt + (kc * 8) * 136 + nn;
                        u32x4 w;
                        w.x = (unsigned)l[0] | ((unsigned)l[136] << 16); w.y = (unsigned)l[272] | ((unsigned)l[408] << 16);
                        w.z = (unsigned)l[544] | ((unsigned)l[680] << 16); w.w = (unsigned)l[816] | ((unsigned)l[952] << 16);
                        *(u32x4*)(jb.dst + (size_t)perm_row(jb.perm, n) * jb.K + jb.kt * 128 + kc * 8) = w;
                    }
                }
            }
            __syncthreads();
            t = tn; have = hn; jb = jn;
#pragma unroll
            for (int i = 0; i < 16; ++i) v[i] = vn[i];
        }
    }
    for (size_t i = gtid; i < (size_t)NL * 2 * 2048 * 64; i += gthreads) {
        const int k = (int)(i % 2048), n = (int)((i / 2048) % 64), m = (int)(i / (2048 * 64));
        p.W1T[i] = f2bf(p.cmp_w1[((size_t)m * 2048 + k) * 64 + n]);
    }
    for (size_t i = gtid; i < (size_t)NL * 2 * 64 * 64; i += gthreads) {
        const int k = (int)(i % 64), n = (int)((i / 64) % 64), m = (int)(i / 4096);
        p.W2T[i] = f2bf(p.cmp_w2[((size_t)m * 64 + k) * 64 + n]);
    }
    for (size_t i = gtid; i < (size_t)NL * NPAD; i += gthreads) {
        const int l = (int)(i / NPAD), r = (int)(i % NPAD);
        float v = 0.f;
        if (r < 2560) { const int n = r < 768 ? r : r + 4; v = p.b_in[l * NCOL + n]; }
        else if (r < 2564) v = p.b_in[l * NCOL + 768 + (r - 2560)];
        else if (r < 2582) v = p.b_in[l * NCOL + r];
        p.binp[i] = v;
    }
    for (size_t i = gtid; i < (size_t)NL * NE * 2048; i += gthreads) {
        const int r = (int)(i % 2048); const size_t le = i / 2048;
        const int s = (r >> 7) & 1, f = (r >> 8) * 128 + (r & 127);
        p.bgup[i] = p.b_gu[le * 2048 + 2 * f + s];
    }
    for (size_t i = gtid; i < (size_t)NL * NE * 1024; i += gthreads) {
        const int k = (int)(i % 1024), e = (int)((i / 1024) % NE), l = (int)(i / (1024 * NE));
        p.rwT[i] = p.router_w[((size_t)l * 1024 + k) * NE + e];
    }
    for (size_t i = gtid; i < (size_t)NL * (NPAD - NCOL) * 1024; i += gthreads) {
        const int l = (int)(i / ((NPAD - NCOL) * 1024)); const size_t r = i % ((size_t)(NPAD - NCOL) * 1024);
        p.WinT[(size_t)l * NPAD * 1024 + (size_t)NCOL * 1024 + r] = 0;
    }
    for (size_t i = gtid; i < (size_t)NTOK * DM / 4; i += gthreads) {
        const float4 v4 = ((const float4*)p.x)[i];
        u32x2 w; w.x = pack2(v4.x, v4.y); w.y = pack2(v4.z, v4.w);
        ((u32x2*)p.xb)[i] = w;
        ((unsigned*)p.xq)[i] = pack4_fp8(v4.x, v4.y, v4.z, v4.w);
    }
    if (bid < 4) {
        float* lf = (float*)ldsc;
        const int j = tid & 63, part = tid >> 6;
        const float* pe = p.cmp_pe + (size_t)bid * 2048; const float* w1 = p.cmp_w1 + (size_t)bid * 2048 * 64;
        float s = 0.f;
        for (int kk = part * 256; kk < part * 256 + 256; ++kk) s += pe[kk] * w1[(size_t)kk * 64 + j];
        lf[tid] = s; __syncthreads();
        if (tid < 64) { float a = 0.f; for (int q = 0; q < 8; ++q) a += lf[tid + 64 * q]; p.b1c[bid * 64 + tid] = a; }
        __syncthreads();
    }
}

__device__ __forceinline__ int vcu_id() { return __builtin_amdgcn_readfirstlane(*(const volatile LAS int*)(LDS_BYTES - 32)); }
namespace pg8 {
constexpr int BM = 256, BK = 64, HALF = 128, HTB = HALF * BK * 2, NXCD = 8, WGM = 8;
__device__ __forceinline__ int lds_byte(int r, int c) { const int st = (r >> 4) * 2 + (c >> 5), rr = r & 15, cc = c & 31, ob = rr * 64 + cc * 2; return st * 1024 + (ob ^ (((ob >> 9) & 1) << 5)); }
__device__ __forceinline__ void stage_rc(int b, int& R, int& C) { const int st = b / 1024, sb = b % 1024, swz = sb ^ (((sb >> 9) & 1) << 5); R = (st >> 1) * 16 + swz / 64; C = (st & 1) * 32 + (swz % 64) / 2; }
__device__ __forceinline__ bool tile_order(int i, int G, int c, int nM, int nN, int& pm, int& pn) {
    const int nwg = nM * nN; const long L = (long)i * G + c; if (L >= nwg) return false;
    const int wgid = (int)L;
    const int nig = WGM * nN, gid = wgid / nig, fm = gid * WGM, gsz = (nM - fm) < WGM ? (nM - fm) : WGM;
    pm = fm + ((wgid % nig) % gsz); pn = (wgid % nig) / gsz; return true;
}
template <bool FP8, int SCA, class Sched, class Epi>
__device__ __forceinline__ void gemm_phase(LAS unsigned char* lds, const char* Abase, int K, const Sched& S, const Epi& E) {
    int tid = threadIdx.x; asm volatile("" : "+v"(tid));
    const int wid = __builtin_amdgcn_readfirstlane(tid >> 6), lane = tid & 63, wr = wid >> 2, wc = wid & 3, fr = lane & 15, fq = lane >> 4;
    const int nt = K / BK;
    int R0, C0, R1, C1; stage_rc(tid * 16, R0, C0); stage_rc(tid * 16 + 8192, R1, C1);
    LAS unsigned* aofs = (LAS unsigned*)(lds + LDS_AOFF) + tid;
    unsigned rg[10];
    rg[8] = (unsigned)(R0 * K + C0) * 2u; rg[9] = (unsigned)(R1 * K + C1) * 2u;
    if constexpr (FP8) { aofs[8 * NTHR] = rg[8]; aofs[9 * NTHR] = rg[9]; }
    const size_t kstep = (size_t)(BK * 2), hstep = (size_t)HALF * K * 2;
    const unsigned ldsw = (unsigned)wid * 1024u;
    const int aoff = lds_byte(wr * 64 + fr, fq * 8), boff = lds_byte(wc * 32 + fr, fq * 8);
#define PG8_SA(b, h) (((b) * 2 + (h)) * HTB)
#define PG8_SB(b, h) ((4 + (b) * 2 + (h)) * HTB)
#define PG8_OFS(sel, j) (FP8 ? aofs[((sel) * 4 + (j)) * NTHR] : ((sel) ? rg[4 + (j)] : rg[(j)]))
#define PG8_STAGE_B(bufoff, gbase) do { _Pragma("unroll") for (int _i = 0; _i < 2; ++_i) { const unsigned ob_ = FP8 ? aofs[(8 + _i) * NTHR] : rg[8 + _i]; \
        __builtin_amdgcn_global_load_lds((const unsigned*)((const char*)(gbase) + ob_), (LAS unsigned*)(lds + (bufoff) + ldsw + _i * 8192), 16, 0, 0); } } while (0)
#define PG8_STAGE_A(bufoff, kbyte, sel, h) do { const unsigned o0_ = PG8_OFS(sel, (h) * 2), o1_ = PG8_OFS(sel, (h) * 2 + 1); \
        __builtin_amdgcn_global_load_lds((const unsigned*)(Abase + (kbyte) + o0_), (LAS unsigned*)(lds + (bufoff) + ldsw), 16, 0, 0); \
        __builtin_amdgcn_global_load_lds((const unsigned*)(Abase + (kbyte) + o1_), (LAS unsigned*)(lds + (bufoff) + ldsw + 8192), 16, 0, 0); } while (0)
#define PG8_LDA(dst, b, h) do { _Pragma("unroll") for (int m = 0; m < 4; ++m) { \
        if constexpr (FP8) { const v4i_t lo_ = *(const LAS v4i_t*)(lds + PG8_SA(b, h) + aoff + m * 2048), hi_ = *(const LAS v4i_t*)(lds + PG8_SA(b, h) + aoff + m * 2048 + 1024); dst##8[m] = __builtin_shufflevector(lo_, hi_, 0, 1, 2, 3, 4, 5, 6, 7); } \
        else { _Pragma("unroll") for (int k = 0; k < 2; ++k) dst[m][k] = *(const LAS bf16x8*)(lds + PG8_SA(b, h) + aoff + m * 2048 + k * 1024); } } } while (0)
#define PG8_LDB(dst, b, h) do { _Pragma("unroll") for (int n = 0; n < 2; ++n) { \
        if constexpr (FP8) { const v4i_t lo_ = *(const LAS v4i_t*)(lds + PG8_SB(b, h) + boff + n * 2048), hi_ = *(const LAS v4i_t*)(lds + PG8_SB(b, h) + boff + n * 2048 + 1024); dst##8[n] = __builtin_shufflevector(lo_, hi_, 0, 1, 2, 3, 4, 5, 6, 7); } \
        else { _Pragma("unroll") for (int k = 0; k < 2; ++k) dst[n][k] = *(const LAS bf16x8*)(lds + PG8_SB(b, h) + boff + n * 2048 + k * 1024); } } } while (0)
#define PG8_MMA(ai, bj, At, Bt) do { __builtin_amdgcn_s_setprio(1); _Pragma("unroll") for (int m = 0; m < 4; ++m) _Pragma("unroll") for (int n = 0; n < 2; ++n) { \
        if constexpr (FP8) { acc[ai][bj][m][n] = __builtin_amdgcn_mfma_scale_f32_16x16x128_f8f6f4(Bt##8[n], At##8[m], acc[ai][bj][m][n], 0, 0, 0, SCA, 0, SCA); } \
        else { _Pragma("unroll") for (int k = 0; k < 2; ++k) acc[ai][bj][m][n] = __builtin_amdgcn_mfma_f32_16x16x32_bf16(Bt[n][k], At[m][k], acc[ai][bj][m][n], 0, 0, 0); } } \
        __builtin_amdgcn_s_setprio(0); } while (0)
#define PG8_WAIT_V(n) asm volatile("s_waitcnt vmcnt(" #n ")" ::: "memory")
#define PG8_WAIT_L(n) asm volatile("s_waitcnt lgkmcnt(" #n ")" ::: "memory")
#define PG8_BAR __builtin_amdgcn_s_barrier()
#define PG8_SCHED __builtin_amdgcn_sched_barrier(0)
    typename Sched::Unit cur, nxt; int ui = 0;
    if (!S.next(0, cur)) return;
    f32x4 acc[2][2][4][2];
#pragma unroll
    for (int a = 0; a < 2; ++a)
#pragma unroll
        for (int b = 0; b < 2; ++b)
#pragma unroll
            for (int m = 0; m < 4; ++m)
#pragma unroll
                for (int n = 0; n < 2; ++n) acc[a][b][m][n] = (f32x4){0.f, 0.f, 0.f, 0.f};
    bf16x8 At[4][2], B0[2][2], B1[2][2];
    v8i_t At8[4], B08[2], B18[2];
    { unsigned a4[2][2]; S.a_off(cur, R0, C0, R1, C1, a4); rg[0] = a4[0][0]; rg[1] = a4[0][1]; rg[2] = a4[1][0]; rg[3] = a4[1][1];
      if constexpr (FP8) { aofs[0] = a4[0][0]; aofs[NTHR] = a4[0][1]; aofs[2 * NTHR] = a4[1][0]; aofs[3 * NTHR] = a4[1][1]; } }
    const char* cB = S.b_ptr(cur);
    PG8_STAGE_B(PG8_SB(0, 0), cB); PG8_STAGE_B(PG8_SB(0, 1), cB + hstep); PG8_STAGE_A(PG8_SA(0, 0), 0, 0, 0); PG8_STAGE_A(PG8_SA(0, 1), 0, 0, 1);
    if (wr == 1) PG8_BAR;
    PG8_WAIT_V(2); PG8_BAR;
    PG8_STAGE_B(PG8_SB(1, 0), cB + kstep); PG8_STAGE_A(PG8_SA(1, 0), kstep, 0, 0); PG8_STAGE_B(PG8_SB(1, 1), cB + hstep + kstep);
    PG8_WAIT_V(6); PG8_BAR;
    for (;;) {
        const bool has_next = S.next(ui + 1, nxt);
        const char* nB = cB;
        if (has_next) { int t2 = threadIdx.x; asm volatile("" : "+v"(t2)); int r0, c0, r1, c1; stage_rc(t2 * 16, r0, c0); stage_rc(t2 * 16 + 8192, r1, c1); unsigned a4[2][2]; S.a_off(nxt, r0, c0, r1, c1, a4); nB = S.b_ptr(nxt);
            rg[4] = a4[0][0]; rg[5] = a4[0][1]; rg[6] = a4[1][0]; rg[7] = a4[1][1];
            if constexpr (FP8) { aofs[4 * NTHR] = a4[0][0]; aofs[5 * NTHR] = a4[0][1]; aofs[6 * NTHR] = a4[1][0]; aofs[7 * NTHR] = a4[1][1]; } }
        else { rg[4] = rg[0]; rg[5] = rg[1]; rg[6] = rg[2]; rg[7] = rg[3];
            if constexpr (FP8) { aofs[4 * NTHR] = aofs[0]; aofs[5 * NTHR] = aofs[NTHR]; aofs[6 * NTHR] = aofs[2 * NTHR]; aofs[7 * NTHR] = aofs[3 * NTHR]; } }
#pragma unroll 1
        for (int t = 0; t < nt; t += 2) {
            const bool last = (t == nt - 2);
            const size_t ka1 = (size_t)(t + 1) * kstep, ka2 = last ? 0 : (size_t)(t + 2) * kstep, ka3 = ka2 + kstep;
            const char* b2 = last ? nB : cB + (size_t)(t + 2) * kstep; const char* b3 = b2 + kstep;
            const int sel = last ? 1 : 0;
            PG8_LDB(B0, 0, 0); PG8_LDB(B1, 0, 1); PG8_SCHED; PG8_LDA(At, 0, 0); PG8_STAGE_A(PG8_SA(1, 1), ka1, 0, 1);
            PG8_WAIT_V(8); PG8_WAIT_L(0); PG8_BAR; PG8_MMA(0, 0, At, B0); PG8_MMA(0, 1, At, B1); PG8_BAR; PG8_SCHED;
            PG8_LDA(At, 0, 1); PG8_STAGE_B(PG8_SB(0, 0), b2); PG8_STAGE_B(PG8_SB(0, 1), b2 + hstep); PG8_STAGE_A(PG8_SA(0, 0), ka2, sel, 0);
            PG8_WAIT_V(8); PG8_WAIT_L(0); PG8_BAR; PG8_MMA(1, 0, At, B0); PG8_MMA(1, 1, At, B1); PG8_BAR; PG8_SCHED;
            PG8_LDB(B0, 1, 0); PG8_LDB(B1, 1, 1); PG8_SCHED; PG8_LDA(At, 1, 0); PG8_STAGE_A(PG8_SA(0, 1), ka2, sel, 1);
            PG8_WAIT_V(8); PG8_WAIT_L(0); PG8_BAR; PG8_MMA(0, 0, At, B0); PG8_MMA(0, 1, At, B1); PG8_BAR; PG8_SCHED;
            PG8_LDA(At, 1, 1); PG8_STAGE_B(PG8_SB(1, 0), b3); PG8_STAGE_B(PG8_SB(1, 1), b3 + hstep); PG8_STAGE_A(PG8_SA(1, 0), ka3, sel, 0);
            PG8_WAIT_V(8); PG8_WAIT_L(0); PG8_BAR; PG8_MMA(1, 0, At, B0); PG8_MMA(1, 1, At, B1); PG8_BAR; PG8_SCHED;
        }
        if (wr == 0) PG8_BAR;
        { int t2 = threadIdx.x; asm volatile("" : "+v"(t2)); E(acc, cur, wr, wc, t2 & 15, (t2 & 63) >> 4); }
        if (!has_next) break;
#pragma unroll
        for (int a = 0; a < 2; ++a)
#pragma unroll
            for (int b = 0; b < 2; ++b)
#pragma unroll
                for (int m = 0; m < 4; ++m)
#pragma unroll
                    for (int n = 0; n < 2; ++n) acc[a][b][m][n] = (f32x4){0.f, 0.f, 0.f, 0.f};
        cur = nxt; cB = nB; ++ui;
        rg[0] = rg[4]; rg[1] = rg[5]; rg[2] = rg[6]; rg[3] = rg[7];
        if constexpr (FP8) { aofs[0] = aofs[4 * NTHR]; aofs[NTHR] = aofs[5 * NTHR]; aofs[2 * NTHR] = aofs[6 * NTHR]; aofs[3 * NTHR] = aofs[7 * NTHR]; }
        if (wr == 1) PG8_BAR;
    }
    PG8_WAIT_V(0);
    PG8_BAR;
#undef PG8_SA
#undef PG8_SB
#undef PG8_STAGE_A
#undef PG8_OFS
#undef PG8_STAGE_B
#undef PG8_LDA
#undef PG8_LDB
#undef PG8_MMA
#undef PG8_WAIT_V
#undef PG8_WAIT_L
#undef PG8_BAR
#undef PG8_SCHED
}
}

struct DenseUnit { int pm, pn; };
struct DenseSched {
    typedef DenseUnit Unit;
    const char* Bt; int K, nM, nN, vc;
    __device__ __forceinline__ bool next(int i, Unit& u) const { return pg8::tile_order(i, gridDim.x, vc, nM, nN, u.pm, u.pn); }
    __device__ __forceinline__ void a_off(const Unit& u, int R0, int C0, int R1, int C1, unsigned (&off)[2][2]) const {
#pragma unroll
        for (int h = 0; h < 2; ++h) { off[h][0] = (unsigned)((u.pm * 256 + h * 128 + R0) * K + C0) * 2u; off[h][1] = (unsigned)((u.pm * 256 + h * 128 + R1) * K + C1) * 2u; }
    }
    __device__ __forceinline__ const char* b_ptr(const Unit& u) const { return Bt + (size_t)u.pn * 256 * K * 2; }
};
struct MoeUnit { int rbt, e, pn; };
template <bool GATHER>
struct MoeSched {
    typedef MoeUnit Unit;
    static constexpr int KP = 512;
    const char* Bt; const int* lists; const int* ptile; const int* ecnt; int nN, nrows, vc;
    __device__ __forceinline__ bool next(int i, Unit& u) const {
        int pm, pn; if (!pg8::tile_order(i, gridDim.x, vc, ptile[NE], nN, pm, pn)) return false;
        int e = 0; while (ptile[e + 1] <= pm) ++e;
        u.rbt = pm; u.e = e; u.pn = pn; return true;
    }
    __device__ __forceinline__ void a_off(const Unit& u, int R0, int C0, int R1, int C1, unsigned (&off)[2][2]) const {
        if (GATHER) {
            const int* lst = lists + (size_t)u.e * LIST_CAP; const int rb = u.rbt - ptile[u.e], cnt = ecnt[u.e];
#pragma unroll
            for (int h = 0; h < 2; ++h) {
                const int l0 = rb * 256 + h * 128 + R0, l1 = rb * 256 + h * 128 + R1;
                const int t0 = l0 < cnt ? (lst[l0] >> 2) : 0, t1 = l1 < cnt ? (lst[l1] >> 2) : 0;
                off[h][0] = (unsigned)(t0 * KP + C0) * 2u; off[h][1] = (unsigned)(t1 * KP + C1) * 2u;
            }
        } else {
#pragma unroll
            for (int h = 0; h < 2; ++h) { off[h][0] = (unsigned)((u.rbt * 256 + h * 128 + R0) * KP + C0) * 2u; off[h][1] = (unsigned)((u.rbt * 256 + h * 128 + R1) * KP + C1) * 2u; }
        }
    }
    __device__ __forceinline__ const char* b_ptr(const Unit& u) const { return Bt + ((size_t)u.e * nrows + (size_t)u.pn * 256) * KP * 2; }
};

struct EpiInProj {
    const Params* p; int l;
    __device__ __forceinline__ void operator()(const f32x4 (&acc)[2][2][4][2], const DenseUnit& u, int wr, int wc, int fr, int fq) const {
        const float* bias = p->binp + l * NPAD + u.pn * 256;
#pragma unroll
        for (int bj = 0; bj < 2; ++bj) {
            int kind = 0, hb0 = 0;
            if (u.pn == 1) { kind = 1; hb0 = bj * 2; } else if (u.pn == 4 && bj == 1) { kind = 1; hb0 = 4; } else if (u.pn == 8 && bj == 0) { kind = 1; hb0 = 6; } else if (u.pn == 9 && bj == 0) { kind = 1; hb0 = 8; }
            else if (u.pn == 2) { kind = 2; hb0 = bj * 2; } else if (u.pn == 5 && bj == 0) { kind = 2; hb0 = 4; } else if (u.pn == 8 && bj == 1) { kind = 2; hb0 = 6; } else if (u.pn == 9 && bj == 1) { kind = 2; hb0 = 8; }
#pragma unroll
            for (int n = 0; n < 2; ++n) {
                const int c = bj * 128 + wc * 32 + n * 16 + 4 * fq;
                const f32x4 bv = *(const f32x4*)(bias + c);
                const int hh = hb0 + ((c & 127) >> 6), d = c & 63;
#pragma unroll
                for (int ai = 0; ai < 2; ++ai)
#pragma unroll
                    for (int m = 0; m < 4; ++m) {
                        const int row = u.pm * 256 + ai * 128 + wr * 64 + m * 16 + fr;
                        const f32x4 v = acc[ai][bj][m][n] + bv;
                        u32x2 w; w.x = pack2(v[0], v[1]); w.y = pack2(v[2], v[3]);
                        if (kind == 0) *(u32x2*)(p->hb + (size_t)row * NMAIN + u.pn * 256 + c) = w;
                        else {
                            const int b = row >> 11, s = row & 2047, kk = s & 31;
                            bf16_t* blk = (kind == 1 ? p->kF : p->vT) + (((size_t)b * NVH + hh) * 64 + (s >> 5)) * 2048;
                            if (kind == 1) {
                                const int frk = (kk >> 3) * 4 + (kk & 3), t = (kk >> 2) & 1;
                                *(u32x2*)(blk + ((t * 2 + (d >> 5)) * 64 + ((d & 31) >> 3) * 16 + frk) * 8 + (d & 7)) = w;
                            } else {
                                bf16_t* vt = blk + (((d >> 4) * 64) + (kk >> 3) * 16 + (d & 15)) * 8 + (kk & 7);
                                vt[0] = (bf16_t)(w.x & 0xffff); vt[8] = (bf16_t)(w.x >> 16); vt[16] = (bf16_t)(w.y & 0xffff); vt[24] = (bf16_t)(w.y >> 16);
                            }
                        }
                    }
            }
        }
    }
};
struct EpiOutProj {
    const float* xin; float* t;
    __device__ __forceinline__ void operator()(const f32x4 (&acc)[2][2][4][2], const DenseUnit& u, int wr, int wc, int fr, int fq) const {
#pragma unroll
        for (int ai = 0; ai < 2; ++ai)
#pragma unroll
            for (int m = 0; m < 4; ++m) {
                const size_t rowoff = (size_t)(u.pm * 256 + ai * 128 + wr * 64 + m * 16 + fr) * DM + u.pn * 256 + wc * 32 + 4 * fq;
#pragma unroll
                for (int bj = 0; bj < 2; ++bj)
#pragma unroll
                    for (int n = 0; n < 2; ++n) {
                        const size_t off = rowoff + bj * 128 + n * 16;
                        const f32x4 xv = *(const f32x4*)(xin + off);
                        const f32x4 tv = xv * ALPHA + acc[ai][bj][m][n];
                        u32x2 w; w.x = pack2(tv[0], tv[1]); w.y = pack2(tv[2], tv[3]);
                        *(u32x2*)((bf16_t*)t + off) = w;
                    }
            }
    }
};
struct EpiGateUp {
    bf16_t* act; const float* bgup;
    __device__ __forceinline__ void operator()(const f32x4 (&acc)[2][2][4][2], const MoeUnit& u, int wr, int wc, int fr, int fq) const {
        const float* bias = bgup + (size_t)u.e * 2048 + u.pn * 256;
#pragma unroll
        for (int n = 0; n < 2; ++n) {
            const int c = wc * 32 + n * 16 + 4 * fq;
            const f32x4 bg = *(const f32x4*)(bias + c), bu = *(const f32x4*)(bias + 128 + c);
#pragma unroll
            for (int ai = 0; ai < 2; ++ai)
#pragma unroll
                for (int m = 0; m < 4; ++m) {
                    const f32x4 g4 = acc[ai][0][m][n] + bg, u4 = acc[ai][1][m][n] + bu;
                    float o[4];
#pragma unroll
                    for (int j = 0; j < 4; ++j) {
                        const float g = fminf(g4[j], 7.0f), uu = fminf(fmaxf(u4[j], -7.0f), 7.0f);
                        const float glu = g * __builtin_amdgcn_rcpf(1.0f + __builtin_amdgcn_exp2f(-2.455466929f * g));
                        o[j] = (uu + 1.0f) * glu;
                    }
                    *(unsigned*)((char*)act + (size_t)(u.rbt * 256 + ai * 128 + wr * 64 + m * 16 + fr) * DFF + u.pn * 128 + c) = pack4_fp8(o[0], o[1], o[2], o[3]);
                }
        }
    }
};
struct EpiDown {
    bf16_t* ybuf; const float* bdn;
    __device__ __forceinline__ void operator()(const f32x4 (&acc)[2][2][4][2], const MoeUnit& u, int wr, int wc, int fr, int fq) const {
        const float* bias = bdn + (size_t)u.e * 1024 + u.pn * 256;
#pragma unroll
        for (int bj = 0; bj < 2; ++bj)
#pragma unroll
            for (int n = 0; n < 2; ++n) {
                const int c = bj * 128 + wc * 32 + n * 16 + 4 * fq;
                const f32x4 bv = *(const f32x4*)(bias + c);
#pragma unroll
                for (int ai = 0; ai < 2; ++ai)
#pragma unroll
                    for (int m = 0; m < 4; ++m) {
                        const f32x4 v = acc[ai][bj][m][n] + bv;
                        *(unsigned*)((unsigned char*)ybuf + (size_t)(u.rbt * 256 + ai * 128 + wr * 64 + m * 16 + fr) * DM + u.pn * 256 + c) = pack4_fp8(v[0], v[1], v[2], v[3]);
                    }
            }
    }
};

__device__ __forceinline__ void phase_inproj(const Params& p, int l, char* lds) {
    DenseSched S{(const char*)p.WinQ + (size_t)l * NMAIN * 1024, 512, NTOK / 256, NMAIN / 256, vcu_id()};
    EpiInProj E{&p, l};
    pg8::gemm_phase<true, 0x7c7c7c7c>((LAS unsigned char*)lds, (const char*)p.xq, 512, S, E);
    int tid = threadIdx.x; asm volatile("" : "+v"(tid));
    const int wid = tid >> 6, lane = tid & 63, fr = lane & 15, fq = lane >> 4;
    const bf16_t* W = p.WinT + ((size_t)l * NPAD + NMAIN) * 1024;
    const float* bias = p.binp + l * NPAD + NMAIN;
    for (int u = blockIdx.x * NWV + wid; u < NTOK / 16; u += gridDim.x * NWV) {
        const bf16_t* ar = p.xb + (size_t)(u * 16 + fr) * DM + fq * 8;
        const bf16_t* w0 = W + (size_t)fr * 1024 + fq * 8; const bf16_t* w1 = W + (size_t)(16 + fr) * 1024 + fq * 8;
        f32x4 a0 = (f32x4){0.f, 0.f, 0.f, 0.f}, a1 = a0;
#pragma unroll 4
        for (int ks = 0; ks < 32; ++ks) {
            const bf16x8 a = *(const bf16x8*)(ar + ks * 32);
            a0 = __builtin_amdgcn_mfma_f32_16x16x32_bf16(a, *(const bf16x8*)(w0 + ks * 32), a0, 0, 0, 0);
            a1 = __builtin_amdgcn_mfma_f32_16x16x32_bf16(a, *(const bf16x8*)(w1 + ks * 32), a1, 0, 0, 0);
        }
#pragma unroll
        for (int r = 0; r < 4; ++r) {
            float* dst = p.hs + (size_t)(u * 16 + fq * 4 + r) * HS_W;
            dst[fr] = a0[r] + bias[fr];
            if (fr < 6) dst[16 + fr] = a1[r] + bias[16 + fr];
        }
    }
}
__device__ __forceinline__ void phase_outproj(const Params& p, int l, const float* xin, char* lds) {
    DenseSched S{(const char*)p.WoT + (size_t)l * 1024 * 1024, 512, NTOK / 256, 4, vcu_id()};
    EpiOutProj E{xin, p.tbuf};
    pg8::gemm_phase<true, 0x7c7c7c7c>((LAS unsigned char*)lds, (const char*)p.ob, 512, S, E);
}
__device__ __forceinline__ void build_tiles(const Params& p, int l, int* ptile, int* ecnt) {
    int tid = threadIdx.x; asm volatile("" : "+v"(tid));
    if (tid < NE) ecnt[tid] = (int)__hip_atomic_load(p.ctrl + 64 + l * NE + tid, __ATOMIC_RELAXED, __HIP_MEMORY_SCOPE_AGENT);
    __syncthreads();
    if (tid == 0) { int s = 0; for (int e = 0; e < NE; ++e) { ptile[e] = s; s += (ecnt[e] + 255) >> 8; } ptile[NE] = s; }
    __syncthreads();
}
__device__ __forceinline__ void phase_gateup(const Params& p, int l, char* lds) {
    int* ptile = (int*)(lds + LDS_TAB); int* ecnt = ptile + 40;
    build_tiles(p, l, ptile, ecnt);
    MoeSched<true> S{(const char*)p.WguT + (size_t)l * NE * 2048 * 1024, p.lists, ptile, ecnt, 8, 2048, vcu_id()};
    EpiGateUp E{p.act, p.bgup + (size_t)l * NE * 2048};
    pg8::gemm_phase<true, 0x7c7c7c7c>((LAS unsigned char*)lds, (const char*)p.x1b, 512, S, E);
}
__device__ __forceinline__ void phase_down(const Params& p, int l, char* lds) {
    int* ptile = (int*)(lds + LDS_TAB); int* ecnt = ptile + 40;
    build_tiles(p, l, ptile, ecnt);
    MoeSched<false> S{(const char*)p.WdnT + (size_t)l * NE * 1024 * 1024, p.lists, ptile, ecnt, 4, 1024, vcu_id()};
    EpiDown E{p.ybuf, p.b_dn + (size_t)l * NE * 1024};
    pg8::gemm_phase<true, 0x7c7c7c7c>((LAS unsigned char*)lds, (const char*)p.act, 512, S, E);
}

__device__ __forceinline__ float gelu_tanh(float x) {
    const float u = 0.7978845608028654f * (x + 0.044715f * x * x * x);
    const float e = __expf(-2.0f * fabsf(u)); const float th = (1.0f - e) / (1.0f + e);
    return 0.5f * x * (1.0f + (u < 0.f ? -th : th));
}
__device__ __forceinline__ void phase_prep(const Params& p, int l, char* lds) {
    int tid = threadIdx.x; asm volatile("" : "+v"(tid));
    const int wid = tid >> 6, lane = tid & 63, fr = lane & 15, fq = lane >> 4;
    const int gw = blockIdx.x * NWV + wid, nw = gridDim.x * NWV;
    for (int u = (int)gridDim.x - 1 - (int)blockIdx.x; u < NB * 4; u += gridDim.x) {
        const int b = u >> 2, h = u & 3;
        const float* srcp = p.hs + ((size_t)b * SEQ + tid * 4) * HS_W + h;
        float ls[4]; float tot = 0.f;
#pragma unroll
        for (int i = 0; i < 4; ++i) { const float f = srcp[(size_t)i * HS_W]; ls[i] = fminf(f, 0.f) - log1pf(__expf(-fabsf(f))); tot += ls[i]; }
        float inc = tot;
#pragma unroll
        for (int o = 1; o < 64; o <<= 1) { const float v = shfl_f(inc, lane - o); if (lane >= o) inc += v; }
        float* wtot = (float*)(lds + 65536);
        if (lane == 63) wtot[wid] = inc;
        __syncthreads();
        float base = inc - tot;
        for (int w = 0; w < wid; ++w) base += wtot[w];
        float4 o4; o4.x = base + ls[0]; o4.y = o4.x + ls[1]; o4.z = o4.y + ls[2]; o4.w = o4.z + ls[3];
        *(float4*)(p.cF + (size_t)u * SEQ + tid * 4) = o4;
        __syncthreads();
    }
    float* part = (float*)lds;
    bf16_t* h1 = (bf16_t*)(lds + 32768);
    for (int u = blockIdx.x; u < NB * 2 * 2 * 8; u += gridDim.x) {
        const int ct = u & 7, which = (u >> 3) & 1, kvh = (u >> 4) & 1, b = u >> 5;
        const int colo = (which ? C_NVC : C_NKC) + kvh * 64;
        const int c_lane = ct * 16 + fr;
        const int tokbase = min(c_lane, 126) * 16;
        const bf16_t* arow = p.hb + ((size_t)b * SEQ + tokbase) * NMAIN + colo + fq * 8;
        const bf16_t* w1 = p.W1T + ((size_t)(l * 2 + which) * 64 + fr) * 2048 + fq * 8;
        f32x4 acc[4];
#pragma unroll
        for (int n = 0; n < 4; ++n) acc[n] = (f32x4){0.f, 0.f, 0.f, 0.f};
#pragma unroll
        for (int kk = 0; kk < 8; ++kk) {
            const int ks = wid * 8 + kk;
            const bf16x8 a = *(const bf16x8*)(arow + (size_t)(ks >> 1) * NMAIN + (ks & 1) * 32);
#pragma unroll
            for (int n = 0; n < 4; ++n) {
                const bf16x8 bb = *(const bf16x8*)(w1 + (size_t)n * 16 * 2048 + ks * 32);
                acc[n] = __builtin_amdgcn_mfma_f32_16x16x32_bf16(a, bb, acc[n], 0, 0, 0);
            }
        }
#pragma unroll
        for (int n = 0; n < 4; ++n)
#pragma unroll
            for (int r = 0; r < 4; ++r) part[wid * 1024 + (fq * 4 + r) * 64 + n * 16 + fr] = acc[n][r];
        __syncthreads();
        const float* b1 = p.b1c + (l * 2 + which) * 64;
#pragma unroll
        for (int i = 0; i < 2; ++i) {
            const int e = tid + NTHR * i; float sum = 0.f;
#pragma unroll
            for (int w = 0; w < 8; ++w) sum += part[w * 1024 + e];
            h1[e] = f2bf(gelu_tanh(sum + b1[e & 63]));
        }
        __syncthreads();
        if (wid == 0) {
            const bf16_t* w2 = p.W2T + ((size_t)(l * 2 + which) * 64 + fr) * 64 + fq * 8;
            f32x4 o2[4];
#pragma unroll
            for (int n = 0; n < 4; ++n) o2[n] = (f32x4){0.f, 0.f, 0.f, 0.f};
#pragma unroll
            for (int ks = 0; ks < 2; ++ks) {
                const bf16x8 a = *(const bf16x8*)(h1 + fr * 64 + ks * 32 + fq * 8);
#pragma unroll
                for (int n = 0; n < 4; ++n) {
                    const bf16x8 bb = *(const bf16x8*)(w2 + (size_t)n * 16 * 64 + ks * 32);
                    o2[n] = __builtin_amdgcn_mfma_f32_16x16x32_bf16(a, bb, o2[n], 0, 0, 0);
                }
            }
            const size_t base = ((size_t)b * 2 + kvh) * 128 * 64;
#pragma unroll
            for (int n = 0; n < 4; ++n)
#pragma unroll
                for (int r = 0; r < 4; ++r) {
                    const int c = ct * 16 + fq * 4 + r, j2 = n * 16 + fr;
                    const bf16_t v = c < 127 ? f2bf(o2[n][r]) : (bf16_t)0;
                    if (which == 0) p.kc[base + (size_t)c * 64 + j2] = v;
                    else { p.vc[base + (size_t)c * 64 + j2] = v; p.vcT[base + (size_t)j2 * 128 + c] = v; }
                }
        }
        __syncthreads();
    }
}

constexpr float L2E = 1.4426950408889634f, MASKV = -__builtin_huge_valf(), MINIT = -1e30f, SCL2 = QSCALE * L2E;
struct KVFrag { bf16x8 k[2][2]; bf16x8 v[4]; };
template <bool FM>
__device__ __forceinline__ void k_load(KVFrag& f, const bf16_t* __restrict__ Kb, size_t ldk, int kc0, int fr, int fq) {
    if (FM) {
        const bf16_t* kp = Kb + (size_t)(kc0 >> 5) * 2048 + (fq * 16 + fr) * 8;
        f.k[0][0] = *(const bf16x8*)(kp); f.k[0][1] = *(const bf16x8*)(kp + 512); f.k[1][0] = *(const bf16x8*)(kp + 1024); f.k[1][1] = *(const bf16x8*)(kp + 1536);
    } else {
        const bf16_t* kp = Kb + (size_t)(kc0 + (fr >> 2) * 8 + (fr & 3)) * ldk + fq * 8;
        f.k[0][0] = *(const bf16x8*)(kp); f.k[0][1] = *(const bf16x8*)(kp + 32);
        f.k[1][0] = *(const bf16x8*)(kp + 4 * ldk); f.k[1][1] = *(const bf16x8*)(kp + 4 * ldk + 32);
    }
}
template <bool FM>
__device__ __forceinline__ void v_load(bf16x8 (&v)[4], const bf16_t* __restrict__ VTb, size_t ldv, int kc0, int fr, int fq) {
    if (FM) {
        const bf16_t* vp = VTb + (size_t)(kc0 >> 5) * 2048 + (fq * 16 + fr) * 8;
#pragma unroll
        for (int dt = 0; dt < 4; ++dt) v[dt] = *(const bf16x8*)(vp + dt * 512);
    } else {
        const bf16_t* vp = VTb + (size_t)fr * ldv + kc0 + fq * 8;
#pragma unroll
        for (int dt = 0; dt < 4; ++dt) v[dt] = *(const bf16x8*)(vp + (size_t)dt * 16 * ldv);
    }
}
__device__ __forceinline__ float rowmax4(float x) {
    auto r = __builtin_amdgcn_permlane32_swap(__float_as_uint(x), __float_as_uint(x), false, false);
    x = fmaxf(__uint_as_float(r[0]), __uint_as_float(r[1]));
    auto q = __builtin_amdgcn_permlane16_swap(__float_as_uint(x), __float_as_uint(x), false, false);
    return fmaxf(__uint_as_float(q[0]), __uint_as_float(q[1]));
}
__device__ __forceinline__ float rowsum4(float x) {
    auto r = __builtin_amdgcn_permlane32_swap(__float_as_uint(x), __float_as_uint(x), false, false);
    x = __uint_as_float(r[0]) + __uint_as_float(r[1]);
    auto q = __builtin_amdgcn_permlane16_swap(__float_as_uint(x), __float_as_uint(x), false, false);
    return __uint_as_float(q[0]) + __uint_as_float(q[1]);
}
template <int NQT, bool MASK, class MB>
__device__ __forceinline__ void attn_compute(const KVFrag& f, const bf16x8 (&qf)[NQT][2], f32x4 (&o)[NQT][4], float (&m)[NQT], float (&l)[NQT], const MB& mb) {
    f32x4 s0[NQT], s1[NQT];
#pragma unroll
    for (int qt = 0; qt < NQT; ++qt) {
        s0[qt] = __builtin_amdgcn_mfma_f32_16x16x32_bf16(f.k[0][0], qf[qt][0], (f32x4){0.f, 0.f, 0.f, 0.f}, 0, 0, 0);
        s1[qt] = __builtin_amdgcn_mfma_f32_16x16x32_bf16(f.k[1][0], qf[qt][0], (f32x4){0.f, 0.f, 0.f, 0.f}, 0, 0, 0);
    }
#pragma unroll
    for (int qt = 0; qt < NQT; ++qt) {
        s0[qt] = __builtin_amdgcn_mfma_f32_16x16x32_bf16(f.k[0][1], qf[qt][1], s0[qt], 0, 0, 0);
        s1[qt] = __builtin_amdgcn_mfma_f32_16x16x32_bf16(f.k[1][1], qf[qt][1], s1[qt], 0, 0, 0);
    }
    float mx[NQT];
#pragma unroll
    for (int qt = 0; qt < NQT; ++qt) {
#pragma unroll
        for (int j = 0; j < 4; ++j) { s0[qt][j] = mb(qt, j, s0[qt][j]); s1[qt][j] = mb(qt, j + 4, s1[qt][j]); }
        mx[qt] = fmaxf(fmaxf(fmaxf(s0[qt][0], s0[qt][1]), fmaxf(s0[qt][2], s0[qt][3])), fmaxf(fmaxf(s1[qt][0], s1[qt][1]), fmaxf(s1[qt][2], s1[qt][3])));
    }
#pragma unroll
    for (int qt = 0; qt < NQT; ++qt) mx[qt] = rowmax4(mx[qt]);
    bool moved = false;
#pragma unroll
    for (int qt = 0; qt < NQT; ++qt) { mx[qt] = fmaxf(m[qt], mx[qt]); moved |= (mx[qt] != m[qt]); }
    if (__ballot(moved) != 0ull) {
#pragma unroll
        for (int qt = 0; qt < NQT; ++qt) {
            const float alpha = __builtin_amdgcn_exp2f(m[qt] - mx[qt]);
            l[qt] *= alpha;
#pragma unroll
            for (int dt = 0; dt < 4; ++dt) o[qt][dt] *= alpha;
        }
    }
    bf16x8 pf[NQT];
#pragma unroll
    for (int qt = 0; qt < NQT; ++qt) {
        m[qt] = mx[qt];
        float pr[8]; float ps = 0.f;
#pragma unroll
        for (int j = 0; j < 4; ++j) {
            pr[j] = __builtin_amdgcn_exp2f(s0[qt][j] - mx[qt]);
            pr[j + 4] = __builtin_amdgcn_exp2f(s1[qt][j] - mx[qt]);
        }
#pragma unroll
        for (int j = 0; j < 8; ++j) ps += pr[j];
        l[qt] += ps;
        const u32x4 pk = {pack2(pr[0], pr[1]), pack2(pr[2], pr[3]), pack2(pr[4], pr[5]), pack2(pr[6], pr[7])};
        pf[qt] = __builtin_bit_cast(bf16x8, pk);
    }
#pragma unroll
    for (int dt = 0; dt < 4; ++dt)
#pragma unroll
        for (int qt = 0; qt < NQT; ++qt) o[qt][dt] = __builtin_amdgcn_mfma_f32_16x16x32_bf16(f.v[dt], pf[qt], o[qt][dt], 0, 0, 0);
    __builtin_amdgcn_sched_barrier(0);
}
struct RangeIt { int c, c_hi; __device__ __forceinline__ int nxt() { if (c > c_hi) return -1; return (c++) * 32; } };
struct MaskIt { unsigned long long cm; __device__ __forceinline__ int nxt() { if (!cm) return -1; const int i = __builtin_ctzll(cm); cm &= cm - 1; return i * 32; } };
template <bool PFV, bool FM, class It, class Gen>
__device__ __forceinline__ void attn_run(It& it, const bf16_t* Kb, size_t ldk, const bf16_t* VTb, size_t ldv, int fr, int fq, const Gen& gen) {
    KVFrag fa, fb;
    int ka = it.nxt(); if (ka < 0) return;
    k_load<FM>(fa, Kb, ldk, ka, fr, fq); if (PFV) v_load<FM>(fa.v, VTb, ldv, ka, fr, fq);
    for (;;) {
        const int kb = it.nxt(); if (kb >= 0) { k_load<FM>(fb, Kb, ldk, kb, fr, fq); if (PFV) v_load<FM>(fb.v, VTb, ldv, kb, fr, fq); }
        if (!PFV) v_load<FM>(fa.v, VTb, ldv, ka, fr, fq);
        gen(ka, fa);
        if (kb < 0) break;
        ka = it.nxt(); if (ka >= 0) { k_load<FM>(fa, Kb, ldk, ka, fr, fq); if (PFV) v_load<FM>(fa.v, VTb, ldv, ka, fr, fq); }
        if (!PFV) v_load<FM>(fb.v, VTb, ldv, kb, fr, fq);
        gen(kb, fb);
        if (ka < 0) break;
    }
}
template <int NQT>
__device__ __forceinline__ void attn_init(f32x4 (&o)[NQT][4], float (&m)[NQT], float (&l)[NQT]) {
#pragma unroll
    for (int qt = 0; qt < NQT; ++qt) { m[qt] = MINIT; l[qt] = 0.f;
#pragma unroll
        for (int dt = 0; dt < 4; ++dt) o[qt][dt] = (f32x4){0.f, 0.f, 0.f, 0.f}; }
}
__device__ __forceinline__ float lsum4(float l) { return rowsum4(l); }
__device__ __forceinline__ void store_o4(unsigned char* dst, const f32x4 v) { *(unsigned*)dst = pack4_fp8(v[0], v[1], v[2], v[3]); }
__device__ __forceinline__ float sigmoidf_fast(float x) { return __builtin_amdgcn_rcpf(1.0f + __builtin_amdgcn_exp2f(-L2E * x)); }

__device__ __forceinline__ void fox_unit(const Params& p, int b, int h, int qb, int fr, int fq) {
    asm volatile("" : "+v"(fr), "+v"(fq));
    const int t0 = qb * 64;
    const bf16_t* Qb = p.hb + ((size_t)b * SEQ + t0) * NMAIN + C_FQ + h * 64 + fq * 8;
    bf16x8 qf[4][2];
#pragma unroll
    for (int qt = 0; qt < 4; ++qt) { qf[qt][0] = *(const bf16x8*)(Qb + (size_t)(qt * 16 + fr) * NMAIN); qf[qt][1] = *(const bf16x8*)(Qb + (size_t)(qt * 16 + fr) * NMAIN + 32); }
    const float* cf = p.cF + ((size_t)b * 4 + h) * SEQ;
    float cq[4];
#pragma unroll
    for (int qt = 0; qt < 4; ++qt) cq[qt] = cf[t0 + qt * 16 + fr] * L2E;
    f32x4 o[4][4]; float m[4], l[4];
    attn_init<4>(o, m, l);
    const bf16_t* Kb = p.kF + ((size_t)b * NVH + h) * 64 * SEQ;
    const bf16_t* VTb = p.vT + ((size_t)b * NVH + h) * 64 * SEQ;
    RangeIt it{0, (t0 >> 5) + 1};
    attn_run<false, true>(it, Kb, NMAIN, VTb, SEQ, fr, fq, [&](int kc0, const KVFrag& f) {
        const float4 ca = *(const float4*)(cf + kc0 + 8 * fq), cb = *(const float4*)(cf + kc0 + 8 * fq + 4);
        const float ck[8] = {ca.x * L2E, ca.y * L2E, ca.z * L2E, ca.w * L2E, cb.x * L2E, cb.y * L2E, cb.z * L2E, cb.w * L2E};
        const int kq = kc0 + 8 * fq - t0 - fr;
        attn_compute<4, true>(f, qf, o, m, l, [&](int qt, int j, float raw) { return (kq + j - 16 * qt) > 0 ? MASKV : raw * SCL2 + cq[qt] - ck[j]; });
    });
#pragma unroll
    for (int qt = 0; qt < 4; ++qt) {
        const float inv = __builtin_amdgcn_rcpf(lsum4(l[qt]));
        unsigned char* dst = (unsigned char*)p.ob + ((size_t)b * SEQ + t0 + qt * 16 + fr) * DM + h * 64 + 4 * fq;
#pragma unroll
        for (int dt = 0; dt < 4; ++dt) store_o4(dst + dt * 16, o[qt][dt] * inv);
    }
}
__device__ __forceinline__ void swa_unit(const Params& p, int l_, int b, int kv, int pos, int fr, int fq) {
    asm volatile("" : "+v"(fr), "+v"(fq));
    const int t0 = pos * 16, t = t0 + fr;
    const bf16_t* Qb = p.hb + ((size_t)b * SEQ + t) * NMAIN + C_SQ + kv * 192 + fq * 8;
    bf16x8 qf[3][2];
#pragma unroll
    for (int g = 0; g < 3; ++g) { qf[g][0] = *(const bf16x8*)(Qb + g * 64); qf[g][1] = *(const bf16x8*)(Qb + g * 64 + 32); }
    float sl[3];
#pragma unroll
    for (int g = 0; g < 3; ++g) sl[g] = slope_swa(kv * 3 + g) * L2E;
    f32x4 o[3][4]; float m[3], l[3];
    attn_init<3>(o, m, l);
    const bf16_t* Kb = p.kF + ((size_t)b * NVH + 4 + kv) * 64 * SEQ;
    const bf16_t* VTb = p.vT + ((size_t)b * NVH + 4 + kv) * 64 * SEQ;
    RangeIt it{max(0, t0 - 127) >> 5, (t0 + 15) >> 5};
    attn_run<true, true>(it, Kb, NMAIN, VTb, SEQ, fr, fq, [&](int kc0, const KVFrag& f) {
        const int dq = t - kc0 - 8 * fq;
        attn_compute<3, true>(f, qf, o, m, l, [&](int g, int j, float raw) { const int dist = dq - j; return ((unsigned)dist < 128u) ? raw * SCL2 - sl[g] * (float)dist : MASKV; });
    });
#pragma unroll
    for (int g = 0; g < 3; ++g) {
        const float sink = p.sinks[l_ * 6 + kv * 3 + g] * L2E;
        const float inv = __builtin_amdgcn_rcpf(lsum4(l[g]) + __builtin_amdgcn_exp2f(sink - m[g]));
        unsigned char* dst = (unsigned char*)p.ob + ((size_t)b * SEQ + t) * DM + 256 + (kv * 3 + g) * 64 + 4 * fq;
#pragma unroll
        for (int dt = 0; dt < 4; ++dt) store_o4(dst + dt * 16, o[g][dt] * inv);
    }
}
__device__ __forceinline__ void nsa_unit(const Params& p, int b, int kv, int pos, int fr, int fq, int lane, float* ps, unsigned* msk, float* otl) {
    asm volatile("" : "+v"(fr), "+v"(fq), "+v"(lane));
    const int t0 = pos * 16, t = t0 + fr, cur = t0 >> 6;
    const bf16_t* Qb = p.hb + ((size_t)b * SEQ + t) * NMAIN + C_NQ + kv * 192 + fq * 8;
    bf16x8 qf[3][2];
#pragma unroll
    for (int g = 0; g < 3; ++g) { qf[g][0] = *(const bf16x8*)(Qb + g * 64); qf[g][1] = *(const bf16x8*)(Qb + g * 64 + 32); }
    float sl[3];
#pragma unroll
    for (int g = 0; g < 3; ++g) sl[g] = slope_nsa(kv * 3 + g) * L2E;
    const float* gl = p.hs + ((size_t)b * SEQ + t) * HS_W + 4 + kv * 9;
    f32x4 o[3][4]; float m[3], l[3];
    f32x4* otv = (f32x4*)otl + lane;
#pragma unroll
    for (int i = 0; i < 8; ++i) ps[lane + 64 * i] = 0.f;
    {
        const bf16_t* Kb = p.kc + ((size_t)b * 2 + kv) * 128 * 64;
        const bf16_t* VTb = p.vcT + ((size_t)b * 2 + kv) * 64 * 128;
        const int ncv = (t0 + 15 >= 31) ? ((t0 + 15 - 31) >> 4) + 1 : 0;
        const int nch = (ncv + 31) >> 5;
        attn_init<3>(o, m, l);
        const int dq0 = t - 31 - 16 * 8 * fq;
        RangeIt it{0, nch - 1};
        attn_run<false, false>(it, Kb, 64, VTb, 128, fr, fq, [&](int kc0, const KVFrag& f) {
            const int dq = dq0 - 16 * kc0;
            attn_compute<3, true>(f, qf, o, m, l, [&](int g, int j, float raw) { const int dist = dq - 16 * j; return dist >= 0 ? raw * SCL2 - sl[g] * (float)dist : MASKV; });
        });
        float il[3];
#pragma unroll
        for (int g = 0; g < 3; ++g) {
            const float lt = lsum4(l[g]); il[g] = lt > 0.f ? __builtin_amdgcn_rcpf(lt) : 0.f;
            const float gate = sigmoidf_fast(gl[g * 3 + 0]);
#pragma unroll
            for (int dt = 0; dt < 4; ++dt) otv[(g * 4 + dt) * 64] = o[g][dt] * (il[g] * gate);
        }
        float carry_prev = 0.f;
        for (int c = 0; c < nch; ++c) {
            const int kc0 = c * 32, dq = dq0 - 16 * kc0;
            const bf16_t* kp = Kb + (size_t)(kc0 + (fr >> 2) * 8 + (fr & 3)) * 64 + fq * 8;
            const bf16x8 k00 = *(const bf16x8*)(kp), k01 = *(const bf16x8*)(kp + 32), k10 = *(const bf16x8*)(kp + 256), k11 = *(const bf16x8*)(kp + 256 + 32);
            float pc[8];
#pragma unroll
            for (int j = 0; j < 8; ++j) pc[j] = 0.f;
#pragma unroll
            for (int g = 0; g < 3; ++g) {
                f32x4 s0 = (f32x4){0.f, 0.f, 0.f, 0.f}, s1 = s0;
                s0 = __builtin_amdgcn_mfma_f32_16x16x32_bf16(k00, qf[g][0], s0, 0, 0, 0); s0 = __builtin_amdgcn_mfma_f32_16x16x32_bf16(k01, qf[g][1], s0, 0, 0, 0);
                s1 = __builtin_amdgcn_mfma_f32_16x16x32_bf16(k10, qf[g][0], s1, 0, 0, 0); s1 = __builtin_amdgcn_mfma_f32_16x16x32_bf16(k11, qf[g][1], s1, 0, 0, 0);
#pragma unroll
                for (int j = 0; j < 8; ++j) {
                    const int dist = dq - 16 * j; const float raw = j < 4 ? s0[j] : s1[j - 4];
                    if (dist >= 0) pc[j] += __builtin_amdgcn_exp2f(raw * SCL2 - sl[g] * (float)dist - m[g]) * il[g];
                }
            }
            const float cout = 0.5f * pc[7];
            float cin = shfl_f(cout, lane - 16);
            const float cwrap = shfl_f(cout, fr + 48);
            if (fq == 0) cin = carry_prev;
            carry_prev = cwrap;
            const int n0 = (kc0 >> 2) + 2 * fq;
            ps[fr * 32 + n0] = cin + pc[0] + pc[1] + pc[2] + 0.5f * pc[3];
            ps[fr * 32 + n0 + 1] = 0.5f * pc[3] + pc[4] + pc[5] + pc[6] + 0.5f * pc[7];
        }
    }
    lds_wave_sync();
    if (lane < 16) {
        unsigned mask = 1u | (1u << cur); if (cur >= 1) mask |= 1u << (cur - 1);
        if (cur >= 3) {
            if (cur - 2 <= 5) mask |= (1u << (cur - 1)) - 2u;
            else {
                const float* my = ps + lane * 32;
                for (int r = 0; r < 5; ++r) {
                    float best = -1.0f; int bi = 1;
                    for (int j = 1; j <= cur - 2; ++j) { const float v = my[j]; if (!((mask >> j) & 1u) && v > best) { best = v; bi = j; } }
                    mask |= 1u << bi;
                }
            }
        }
        msk[lane] = mask;
    }
    lds_wave_sync();
    const unsigned qmask = msk[fr];
    lds_wave_sync();
    {
        const bf16_t* Kb = p.kF + ((size_t)b * NVH + 6 + kv) * 64 * SEQ;
        const bf16_t* VTb = p.vT + ((size_t)b * NVH + 6 + kv) * 64 * SEQ;
        attn_init<3>(o, m, l);
        unsigned um = qmask;
        um |= shfl_u(um, lane ^ 1); um |= shfl_u(um, lane ^ 2); um |= shfl_u(um, lane ^ 4); um |= shfl_u(um, lane ^ 8);
        um = (unsigned)__builtin_amdgcn_readfirstlane((int)um) & (cur >= 31 ? 0xffffffffu : ((2u << cur) - 1u));
        unsigned long long cm = 0ull;
        for (unsigned r = um; r; r &= r - 1) { const int kb = __builtin_ctz(r); cm |= 3ull << (2 * kb); }
        MaskIt it{cm};
        attn_run<false, true>(it, Kb, NMAIN, VTb, SEQ, fr, fq, [&](int kc0, const KVFrag& f) {
            const bool mine = (qmask >> (kc0 >> 6)) & 1u;
            const int dq = t - kc0 - 8 * fq;
            attn_compute<3, true>(f, qf, o, m, l, [&](int g, int j, float raw) { const int dist = dq - j; return (mine && dist >= 0) ? raw * SCL2 - sl[g] * (float)dist : MASKV; });
        });
#pragma unroll
        for (int g = 0; g < 3; ++g) {
            const float lt = lsum4(l[g]); const float sc = (lt > 0.f ? __builtin_amdgcn_rcpf(lt) : 0.f) * sigmoidf_fast(gl[g * 3 + 1]);
#pragma unroll
            for (int dt = 0; dt < 4; ++dt) otv[(g * 4 + dt) * 64] += o[g][dt] * sc;
        }
    }
    {
        const bf16_t* Kb = p.kF + ((size_t)b * NVH + 8 + kv) * 64 * SEQ;
        const bf16_t* VTb = p.vT + ((size_t)b * NVH + 8 + kv) * 64 * SEQ;
        attn_init<3>(o, m, l);
        RangeIt it{max(0, t0 - 511) >> 5, (t0 + 15) >> 5};
        attn_run<false, true>(it, Kb, NMAIN, VTb, SEQ, fr, fq, [&](int kc0, const KVFrag& f) {
            const int dq = t - kc0 - 8 * fq;
            attn_compute<3, true>(f, qf, o, m, l, [&](int g, int j, float raw) { const int dist = dq - j; return ((unsigned)dist < 512u) ? raw * SCL2 - sl[g] * (float)dist : MASKV; });
        });
#pragma unroll
        for (int g = 0; g < 3; ++g) {
            const float lt = lsum4(l[g]); const float sc = (lt > 0.f ? __builtin_amdgcn_rcpf(lt) : 0.f) * sigmoidf_fast(gl[g * 3 + 2]);
            unsigned char* dst = (unsigned char*)p.ob + ((size_t)b * SEQ + t) * DM + 640 + (kv * 3 + g) * 64 + 4 * fq;
#pragma unroll
            for (int dt = 0; dt < 4; ++dt) store_o4(dst + dt * 16, otv[(g * 4 + dt) * 64] + o[g][dt] * sc);
        }
    }
}

template <bool WITH_CONV>
__device__ __forceinline__ void phase_attn(const Params& p, int l, char* lds, int cslot = 16) {
    int tid = threadIdx.x; asm volatile("" : "+v"(tid));
    const int wid = tid >> 6, lane = tid & 63, fr = lane & 15, fq = lane >> 4;
    float* ps = (float*)(lds + wid * 16896); unsigned* msk = (unsigned*)(ps + 512); float* otl = ps + 576;
    unsigned* ctr = p.ctrl + cslot + l;
    constexpr unsigned NU_NSA = NB * 2 * 128, NU_FOX = NB * 4 * 32, NU_SWA = NB * 2 * 128, NU_ATT = NU_NSA + NU_FOX + NU_SWA;
    for (;;) {
        unsigned u = 0;
        if (lane == 0) u = __hip_atomic_fetch_add(ctr, 1u, __ATOMIC_RELAXED, __HIP_MEMORY_SCOPE_AGENT);
        u = (unsigned)__builtin_amdgcn_readfirstlane((int)u);
        if (WITH_CONV) {
            constexpr unsigned TOTQ = NU_ATT + (unsigned)CONV_TILES;
            if (u >= TOTQ) break;
            const unsigned a0 = (unsigned)(((unsigned long long)u * NU_ATT) / TOTQ), a1 = (unsigned)(((unsigned long long)(u + 1) * NU_ATT) / TOTQ);
            if (a1 == a0) { conv_tile_wave(p, (int)(u - a0), lane, (unsigned char*)ps); continue; }
            u = a0;
        } else {
#ifndef ATT_REP
#define ATT_REP 1
#endif
            if (u >= ATT_REP * NU_ATT) break;
            if (ATT_REP > 1) u %= NU_ATT;
        }
        if (u < NU_NSA) { const int pos = 127 - (int)(u & 127), r = u >> 7; nsa_unit(p, r >> 1, r & 1, pos, fr, fq, lane, ps, msk, otl); }
        else if (u < NU_NSA + NU_FOX) { const unsigned v = u - NU_NSA; const int qb = 31 - (int)(v & 31), r = v >> 5; fox_unit(p, r >> 2, r & 3, qb, fr, fq); }
        else { const unsigned v = u - NU_NSA - NU_FOX; const int pos = 127 - (int)(v & 127), r = v >> 7; swa_unit(p, l, r >> 1, r & 1, pos, fr, fq); }
    }
}

__device__ __forceinline__ void phase_ln1_router(const Params& p, int l, char* lds) {
    int tid = threadIdx.x; asm volatile("" : "+v"(tid));
    const int wid = tid >> 6, lane = tid & 63, fr = lane & 15, fq = lane >> 4;
    float* lg = (float*)lds + wid * 512;
    int* lcnt = (int*)(lds + 16384); int* lbase = lcnt + 32;
    const float* g1 = p.ln1_g + l * DM; const float* b1 = p.ln1_b + l * DM;
    const float* rw = p.rwT + (size_t)l * NE * 1024; const float* rb = p.router_b + l * NE;
    unsigned* gcount = p.ctrl + 64 + l * NE;
    for (int grp = blockIdx.x; grp < NTOK / 128; grp += gridDim.x) {
        const int tok0 = grp * 128 + wid * 16;
        if (tid < 32) lcnt[tid] = 0;
        float4 gg[4], bb[4];
#pragma unroll
        for (int j = 0; j < 4; ++j) { gg[j] = *(const float4*)(g1 + j * 256 + lane * 4); bb[j] = *(const float4*)(b1 + j * 256 + lane * 4); }
        for (int r0 = 0; r0 < 16; r0 += 4) {
            float4 v[4][4]; float s[4], qv[4];
#pragma unroll
            for (int i = 0; i < 4; ++i)
#pragma unroll
                for (int j = 0; j < 4; ++j) { const u32x2 w = *(const u32x2*)((const bf16_t*)p.tbuf + (size_t)(tok0 + r0 + i) * DM + j * 256 + lane * 4);
                    v[i][j] = make_float4(__uint_as_float(w.x << 16), __uint_as_float(w.x & 0xffff0000u), __uint_as_float(w.y << 16), __uint_as_float(w.y & 0xffff0000u)); }
#pragma unroll
            for (int i = 0; i < 4; ++i) { s[i] = 0.f;
#pragma unroll
                for (int j = 0; j < 4; ++j) s[i] += (v[i][j].x + v[i][j].y) + (v[i][j].z + v[i][j].w); }
#pragma unroll
            for (int o = 32; o > 0; o >>= 1) {
#pragma unroll
                for (int i = 0; i < 4; ++i) s[i] += shfl_f(s[i], lane ^ o); }
#pragma unroll
            for (int i = 0; i < 4; ++i) { const float mean = s[i] * (1.0f / 1024.0f); qv[i] = 0.f;
#pragma unroll
                for (int j = 0; j < 4; ++j) { v[i][j].x -= mean; v[i][j].y -= mean; v[i][j].z -= mean; v[i][j].w -= mean; qv[i] += (v[i][j].x * v[i][j].x + v[i][j].y * v[i][j].y) + (v[i][j].z * v[i][j].z + v[i][j].w * v[i][j].w); } }
#pragma unroll
            for (int o = 32; o > 0; o >>= 1) {
#pragma unroll
                for (int i = 0; i < 4; ++i) qv[i] += shfl_f(qv[i], lane ^ o); }
#pragma unroll
            for (int i = 0; i < 4; ++i) {
                const float rstd = rsqrtf(qv[i] * (1.0f / 1024.0f) + LN_EPS);
                const size_t row = (size_t)(tok0 + r0 + i);
#pragma unroll
                for (int j = 0; j < 4; ++j) {
                    const int c = j * 256 + lane * 4;
                    float4 y; y.x = v[i][j].x * rstd * gg[j].x + bb[j].x; y.y = v[i][j].y * rstd * gg[j].y + bb[j].y; y.z = v[i][j].z * rstd * gg[j].z + bb[j].z; y.w = v[i][j].w * rstd * gg[j].w + bb[j].w;
                    { u32x2 w; w.x = pack2(y.x, y.y); w.y = pack2(y.z, y.w); *(u32x2*)((bf16_t*)p.x1f + row * DM + c) = w; }
                    *(unsigned*)((char*)p.x1b + row * DM + c) = pack4_fp8(y.x, y.y, y.z, y.w);
                }
            }
        }
        __syncthreads();
        f32x4 a0 = (f32x4){0.f, 0.f, 0.f, 0.f}, a1 = a0;
        const bf16_t* xr = (const bf16_t*)p.x1f + (size_t)(tok0 + fr) * DM + 4 * fq;
        const float* w0 = rw + (size_t)fr * 1024 + 4 * fq; const float* w1 = rw + (size_t)(16 + fr) * 1024 + 4 * fq;
#pragma unroll 4
        for (int k0 = 0; k0 < 1024; k0 += 16) {
            const u32x2 xw = *(const u32x2*)(xr + k0); const float4 wb0 = *(const float4*)(w0 + k0), wb1 = *(const float4*)(w1 + k0);
            const float4 xa = make_float4(__uint_as_float(xw.x << 16), __uint_as_float(xw.x & 0xffff0000u), __uint_as_float(xw.y << 16), __uint_as_float(xw.y & 0xffff0000u));
            a0 = __builtin_amdgcn_mfma_f32_16x16x4f32(xa.x, wb0.x, a0, 0, 0, 0); a1 = __builtin_amdgcn_mfma_f32_16x16x4f32(xa.x, wb1.x, a1, 0, 0, 0);
            a0 = __builtin_amdgcn_mfma_f32_16x16x4f32(xa.y, wb0.y, a0, 0, 0, 0); a1 = __builtin_amdgcn_mfma_f32_16x16x4f32(xa.y, wb1.y, a1, 0, 0, 0);
            a0 = __builtin_amdgcn_mfma_f32_16x16x4f32(xa.z, wb0.z, a0, 0, 0, 0); a1 = __builtin_amdgcn_mfma_f32_16x16x4f32(xa.z, wb1.z, a1, 0, 0, 0);
            a0 = __builtin_amdgcn_mfma_f32_16x16x4f32(xa.w, wb0.w, a0, 0, 0, 0); a1 = __builtin_amdgcn_mfma_f32_16x16x4f32(xa.w, wb1.w, a1, 0, 0, 0);
        }
#pragma unroll
        for (int r = 0; r < 4; ++r) { lg[(fq * 4 + r) * 32 + fr] = a0[r] + rb[fr]; lg[(fq * 4 + r) * 32 + 16 + fr] = a1[r] + rb[16 + fr]; }
        lds_wave_sync();
        int e4[4] = {0, 0, 0, 0}; int rk[4] = {0, 0, 0, 0};
        if (lane < 16) {
            const float* my = lg + lane * 32; unsigned taken = 0u; float tv[4];
#pragma unroll
            for (int k = 0; k < 4; ++k) {
                float best = NEG_INF; int bi = 0;
                for (int e = 0; e < 32; ++e) { const float xv = my[e]; if (!((taken >> e) & 1u) && xv > best) { best = xv; bi = e; } }
                taken |= 1u << bi; e4[k] = bi; tv[k] = best;
            }
            const float e1 = __expf(tv[1] - tv[0]), e2 = __expf(tv[2] - tv[0]), e3 = __expf(tv[3] - tv[0]);
            const float inv = 1.0f / (1.0f + e1 + e2 + e3);
            const size_t row = (size_t)(tok0 + lane);
            *(float4*)(p.gw + row * 4) = make_float4(inv, e1 * inv, e2 * inv, e3 * inv);
        }
        __syncthreads();
        if (lane < 16) {
#pragma unroll
            for (int k = 0; k < 4; ++k) rk[k] = atomicAdd(&lcnt[e4[k]], 1);
        }
        __syncthreads();
        if (tid < 32) { const int c = lcnt[tid]; lbase[tid] = c ? (int)__hip_atomic_fetch_add(gcount + tid, (unsigned)c, __ATOMIC_RELAXED, __HIP_MEMORY_SCOPE_AGENT) : 0; }
        __syncthreads();
        if (lane < 16) {
            const int row = tok0 + lane; int pk[4];
#pragma unroll
            for (int k = 0; k < 4; ++k) { const int pos = lbase[e4[k]] + rk[k]; p.lists[(size_t)e4[k] * LIST_CAP + pos] = row * 4 + k; pk[k] = (pos << 5) | e4[k]; }
            *(int4*)(p.top_e + (size_t)row * 4) = make_int4(pk[0], pk[1], pk[2], pk[3]);
        }
        __syncthreads();
    }
}

__device__ __forceinline__ void phase_ln2(const Params& p, int l, float* xout, char* lds) {
    int* ptile = (int*)(lds + LDS_TAB); int* ecnt = ptile + 40;
    build_tiles(p, l, ptile, ecnt);
    int tid = threadIdx.x; asm volatile("" : "+v"(tid));
    const int wid = tid >> 6, lane = tid & 63;
    const float* g2 = p.ln2_g + l * DM; const float* b2 = p.ln2_b + l * DM;
    float4 gg[4], bb[4];
#pragma unroll
    for (int j = 0; j < 4; ++j) { gg[j] = *(const float4*)(g2 + j * 256 + lane * 4); bb[j] = *(const float4*)(b2 + j * 256 + lane * 4); }
    for (int pr = blockIdx.x * NWV + wid; pr < NTOK / 2; pr += gridDim.x * NWV) {
        float4 v[2][4]; float s[2], qv[2];
        unsigned yv[2][4][4]; float gk[2][4];
#pragma unroll
        for (int i = 0; i < 2; ++i) {
            const int row = pr * 2 + i;
            const float4 gwv = *(const float4*)(p.gw + (size_t)row * 4);
            gk[i][0] = gwv.x; gk[i][1] = gwv.y; gk[i][2] = gwv.z; gk[i][3] = gwv.w;
            const int4 te = *(const int4*)(p.top_e + (size_t)row * 4);
            const int tk[4] = {te.x, te.y, te.z, te.w};
#pragma unroll
            for (int j = 0; j < 4; ++j) { const u32x2 w = *(const u32x2*)((const bf16_t*)p.x1f + (size_t)row * DM + j * 256 + lane * 4);
                v[i][j] = make_float4(__uint_as_float(w.x << 16), __uint_as_float(w.x & 0xffff0000u), __uint_as_float(w.y << 16), __uint_as_float(w.y & 0xffff0000u)); }
#pragma unroll
            for (int k = 0; k < 4; ++k) {
                const unsigned char* yr = (const unsigned char*)p.ybuf + (size_t)(ptile[tk[k] & 31] * 256 + (tk[k] >> 5)) * DM + lane * 4;
#pragma unroll
                for (int j = 0; j < 4; ++j) yv[i][k][j] = *(const unsigned*)(yr + j * 256);
            }
        }
#pragma unroll
        for (int i = 0; i < 2; ++i) { s[i] = 0.f;
#pragma unroll
            for (int j = 0; j < 4; ++j) {
                float4 a; a.x = v[i][j].x * ALPHA; a.y = v[i][j].y * ALPHA; a.z = v[i][j].z * ALPHA; a.w = v[i][j].w * ALPHA;
#pragma unroll
                for (int k = 0; k < 4; ++k) {
                    const unsigned w = yv[i][k][j];
                    const f32x2_t lo = __builtin_amdgcn_cvt_pk_f32_fp8(w, false), hi = __builtin_amdgcn_cvt_pk_f32_fp8(w, true);
                    a.x += gk[i][k] * lo.x; a.y += gk[i][k] * lo.y; a.z += gk[i][k] * hi.x; a.w += gk[i][k] * hi.y;
                }
                v[i][j] = a; s[i] += (a.x + a.y) + (a.z + a.w);
            } }
#pragma unroll
        for (int o = 32; o > 0; o >>= 1) { s[0] += shfl_f(s[0], lane ^ o); s[1] += shfl_f(s[1], lane ^ o); }
#pragma unroll
        for (int i = 0; i < 2; ++i) { const float mean = s[i] * (1.0f / 1024.0f); qv[i] = 0.f;
#pragma unroll
            for (int j = 0; j < 4; ++j) { v[i][j].x -= mean; v[i][j].y -= mean; v[i][j].z -= mean; v[i][j].w -= mean; qv[i] += (v[i][j].x * v[i][j].x + v[i][j].y * v[i][j].y) + (v[i][j].z * v[i][j].z + v[i][j].w * v[i][j].w); } }
#pragma unroll
        for (int o = 32; o > 0; o >>= 1) { qv[0] += shfl_f(qv[0], lane ^ o); qv[1] += shfl_f(qv[1], lane ^ o); }
#pragma unroll
        for (int i = 0; i < 2; ++i) {
            const float rstd = rsqrtf(qv[i] * (1.0f / 1024.0f) + LN_EPS);
            const size_t row = (size_t)(pr * 2 + i);
#pragma unroll
            for (int j = 0; j < 4; ++j) {
                const int c = j * 256 + lane * 4;
                float4 y; y.x = v[i][j].x * rstd * gg[j].x + bb[j].x; y.y = v[i][j].y * rstd * gg[j].y + bb[j].y; y.z = v[i][j].z * rstd * gg[j].z + bb[j].z; y.w = v[i][j].w * rstd * gg[j].w + bb[j].w;
                *(float4*)(xout + row * DM + c) = y;
                if (l + 1 < NL) {
                    u32x2 w; w.x = pack2(y.x, y.y); w.y = pack2(y.z, y.w);
                    *(u32x2*)(p.xb + row * DM + c) = w;
                    *(unsigned*)(p.xq + row * DM + c) = pack4_fp8(y.x, y.y, y.z, y.w);
                }
            }
        }
    }
}

#define XB_TMO      128
#define XB_XCNT(j)  (256  + 64 * (j))
#define XB_XSUB(j)  (1280 + 64 * (j))
#define XB_XGEN(j)  (2304 + 64 * (j))
#define XB_TOP      3328
#define XB_TOPGEN   3392
#define XCD_BAR_WORDS 3456
#define XB_SPIN_CAP (1u << 22)
__device__ __forceinline__ unsigned xb_ld(unsigned* p)              { return __hip_atomic_load(p, __ATOMIC_RELAXED, __HIP_MEMORY_SCOPE_AGENT); }
__device__ __forceinline__ unsigned xb_add(unsigned* p, unsigned v) { return __hip_atomic_fetch_add(p, v, __ATOMIC_RELAXED, __HIP_MEMORY_SCOPE_AGENT); }
__device__ __forceinline__ unsigned xb_xcc_id() { return (unsigned)__builtin_amdgcn_s_getreg((3 << 11) | 20) & 0xFu; }
#define XB_SPIN(cond, bar) do { unsigned _sp = 0; while (cond) { __builtin_amdgcn_s_sleep(1); \
    if ((++_sp & 255u) == 0u) { if (xb_ld(&(bar)[XB_TMO])) break; if (_sp > XB_SPIN_CAP) { atomicAdd(&(bar)[XB_TMO], 1u); break; } } } } while (0)
struct XcdBarrier { unsigned* bar; unsigned x; volatile LAS unsigned* st; };
__device__ __forceinline__ XcdBarrier xcd_barrier_post(unsigned* bar, volatile LAS unsigned* st) {
    XcdBarrier b; b.bar = bar; b.x = xb_xcc_id(); b.st = st;
    if (threadIdx.x == 0) (void)xb_add(&bar[XB_XCNT(b.x)], 1u);
    return b;
}
__device__ __forceinline__ void xcd_barrier_complete(unsigned* bar, unsigned x, unsigned& nloc, unsigned& nx) {
    const unsigned G = gridDim.x * gridDim.y * gridDim.z;
    unsigned sum, cnt, mine, sp = 0u;
    for (;;) {
        sum = 0u; cnt = 0u; mine = 0u;
#pragma unroll
        for (unsigned j = 0; j < 16; ++j) { const unsigned c = xb_ld(&bar[XB_XCNT(j)]); sum += c; cnt += (c > 0u) ? 1u : 0u; mine = (j == x) ? c : mine; }
        if (sum == G) break;
        __builtin_amdgcn_s_sleep(1);
        if ((++sp & 255u) == 0u) { if (xb_ld(&bar[XB_TMO])) break; if (sp > XB_SPIN_CAP) { atomicAdd(&bar[XB_TMO], 1u); break; } }
    }
    nloc = mine > 0u ? mine : 1u; nx = cnt > 0u ? cnt : 1u;
}
__device__ __forceinline__ void xcd_barrier(const XcdBarrier& b) {
    asm volatile("s_waitcnt vmcnt(0)" ::: "memory");
    __syncthreads();
    if (threadIdx.x == 0) {
        unsigned* bar = b.bar;
        __builtin_amdgcn_s_waitcnt(0);
        unsigned nloc = b.st[0], nx = b.st[1];
        if (nloc == 0u) { xcd_barrier_complete(bar, b.x, nloc, nx); b.st[0] = nloc; b.st[1] = nx; }
        const unsigned old = xb_add(&bar[XB_XSUB(b.x)], 1u);
        const unsigned gen = old / nloc;
        if (old + 1u == (gen + 1u) * nloc) {
            __builtin_amdgcn_fence(__ATOMIC_RELEASE, "agent");
            asm volatile("s_waitcnt vmcnt(0)" ::: "memory");
            const unsigned og = xb_add(&bar[XB_TOP], 1u);
            const unsigned tg = og / nx;
            if (og + 1u == (tg + 1u) * nx) xb_add(&bar[XB_TOPGEN], 1u);
            else XB_SPIN(xb_ld(&bar[XB_TOPGEN]) == tg, bar);
            __builtin_amdgcn_fence(__ATOMIC_ACQUIRE, "agent");
            xb_add(&bar[XB_XGEN(b.x)], 1u);
            asm volatile("s_waitcnt vmcnt(0)" ::: "memory");
        } else {
            XB_SPIN(xb_ld(&bar[XB_XGEN(b.x)]) == gen, bar);
            __builtin_amdgcn_fence(__ATOMIC_ACQUIRE, "agent");
            asm volatile("s_waitcnt vmcnt(0)" ::: "memory");
        }
    }
    __syncthreads();
}

struct KArgs { const float* in[18]; float* out; char* ws; };
constexpr size_t al256(size_t v) { return (v + 255) / 256 * 256; }
struct WSL {
    static constexpr size_t ctrl = 0;
    static constexpr size_t WinT = al256(ctrl + 65536);
    static constexpr size_t WoT = al256(WinT + (size_t)NL * NPAD * 1024 * 2);
    static constexpr size_t W1T = al256(WoT + (size_t)NL * 1024 * 1024 * 2);
    static constexpr size_t W2T = al256(W1T + (size_t)NL * 2 * 64 * 2048 * 2);
    static constexpr size_t WguT = al256(W2T + (size_t)NL * 2 * 64 * 64 * 2);
    static constexpr size_t WdnT = al256(WguT + (size_t)NL * NE * 2048 * 1024 * 2);
    static constexpr size_t rwT = al256(WdnT + (size_t)NL * NE * 1024 * 1024 * 2);
    static constexpr size_t binp = al256(rwT + (size_t)NL * NE * 1024 * 4);
    static constexpr size_t bgup = al256(binp + (size_t)NL * NPAD * 4);
    static constexpr size_t b1c = al256(bgup + (size_t)NL * NE * 2048 * 4);
    static constexpr size_t xf = al256(b1c + 4 * 64 * 4);
    static constexpr size_t xb = al256(xf + (size_t)NTOK * DM * 4);
    static constexpr size_t hb = al256(xb + (size_t)NTOK * DM * 2);
    static constexpr size_t hs = al256(hb + (size_t)NTOK * NMAIN * 2);
    static constexpr size_t vT = al256(hs + (size_t)NTOK * HS_W * 4);
    static constexpr size_t kF = al256(vT + (size_t)NB * NVH * 64 * SEQ * 2);
    static constexpr size_t cF = al256(kF + (size_t)NB * NVH * 64 * SEQ * 2);
    static constexpr size_t kc = al256(cF + (size_t)NB * 4 * SEQ * 4);
    static constexpr size_t vc = al256(kc + (size_t)NB * 2 * 128 * 64 * 2);
    static constexpr size_t vcT = al256(vc + (size_t)NB * 2 * 128 * 64 * 2);
    static constexpr size_t ob = al256(vcT + (size_t)NB * 2 * 128 * 64 * 2);
    static constexpr size_t tbuf = al256(ob + (size_t)NTOK * DM * 2);
    static constexpr size_t x1f = al256(tbuf + (size_t)NTOK * DM * 4);
    static constexpr size_t x1b = al256(x1f + (size_t)NTOK * DM * 4);
    static constexpr size_t top_e = al256(x1b + (size_t)NTOK * DM * 2);
    static constexpr size_t gw = al256(top_e + (size_t)NTOK * 4 * 4);
    static constexpr size_t lists = al256(gw + (size_t)NTOK * 4 * 4);
    static constexpr size_t act = al256(lists + (size_t)NE * LIST_CAP * 4);
    static constexpr size_t ybuf = al256(act + (size_t)MAXSLOT * DFF * 2);
    static constexpr size_t xq = al256(ybuf + (size_t)MAXSLOT * DM * 2);
    static constexpr size_t WinQ = al256(xq + (size_t)NTOK * DM);
    static constexpr size_t total = al256(WinQ + (size_t)NL * NMAIN * 1024);
};
__device__ __forceinline__ Params make_params(const KArgs& k) {
    Params p;
    p.x = k.in[0]; p.w_in = k.in[1]; p.b_in = k.in[2]; p.sinks = k.in[3]; p.cmp_pe = k.in[4]; p.cmp_w1 = k.in[5]; p.cmp_w2 = k.in[6]; p.w_out = k.in[7];
    p.ln1_g = k.in[8]; p.ln1_b = k.in[9]; p.router_w = k.in[10]; p.router_b = k.in[11]; p.w_gu = k.in[12]; p.b_gu = k.in[13]; p.w_dn = k.in[14]; p.b_dn = k.in[15];
    p.ln2_g = k.in[16]; p.ln2_b = k.in[17]; p.out = k.out;
    char* w = k.ws;
    p.ctrl = (unsigned*)(w + WSL::ctrl); p.WinT = (bf16_t*)(w + WSL::WinT); p.WoT = (bf16_t*)(w + WSL::WoT); p.W1T = (bf16_t*)(w + WSL::W1T); p.W2T = (bf16_t*)(w + WSL::W2T);
    p.WguT = (bf16_t*)(w + WSL::WguT); p.WdnT = (bf16_t*)(w + WSL::WdnT); p.rwT = (float*)(w + WSL::rwT); p.binp = (float*)(w + WSL::binp); p.bgup = (float*)(w + WSL::bgup);
    p.b1c = (float*)(w + WSL::b1c); p.xf = (float*)(w + WSL::xf); p.xb = (bf16_t*)(w + WSL::xb); p.hb = (bf16_t*)(w + WSL::hb); p.hs = (float*)(w + WSL::hs); p.vT = (bf16_t*)(w + WSL::vT); p.kF = (bf16_t*)(w + WSL::kF);
    p.cF = (float*)(w + WSL::cF); p.kc = (bf16_t*)(w + WSL::kc); p.vc = (bf16_t*)(w + WSL::vc); p.vcT = (bf16_t*)(w + WSL::vcT); p.ob = (bf16_t*)(w + WSL::ob); p.tbuf = (float*)(w + WSL::tbuf);
    p.x1f = (float*)(w + WSL::x1f); p.x1b = (bf16_t*)(w + WSL::x1b); p.top_e = (int*)(w + WSL::top_e); p.gw = (float*)(w + WSL::gw); p.lists = (int*)(w + WSL::lists);
    p.act = (bf16_t*)(w + WSL::act); p.ybuf = (bf16_t*)(w + WSL::ybuf); p.xq = (unsigned char*)(w + WSL::xq); p.WinQ = (unsigned char*)(w + WSL::WinQ);
    return p;
}
__device__ __forceinline__ void grid_bar(const Params& p, char* lds) {
    XcdBarrier xb; xb.bar = p.ctrl + 1024; xb.x = xb_xcc_id(); xb.st = (volatile LAS unsigned*)(lds + LDS_BYTES - 16); xcd_barrier(xb);
}
__device__ __forceinline__ Params fresh_params(const KArgs& ka) {
    KArgs k2 = ka; asm volatile("" : "+s"(k2.ws));
    return make_params(k2);
}
#ifndef REP
#define REP 0
#endif
template <int L>
__device__ __forceinline__ void layer_fwd(const KArgs& ka, char* lds) {
    { const Params p = fresh_params(ka); phase_inproj(p, L, lds);        grid_bar(p, lds); }
    { const Params p = fresh_params(ka); phase_prep(p, L, lds);          grid_bar(p, lds); }
    { const Params p = fresh_params(ka); phase_attn<L == 0>(p, L, lds);  grid_bar(p, lds); }
    { const Params p = fresh_params(ka); phase_outproj(p, L, L == 0 ? p.x : p.xf, lds);  grid_bar(p, lds); }
    { const Params p = fresh_params(ka); phase_ln1_router(p, L, lds);    grid_bar(p, lds); }
    { const Params p = fresh_params(ka); phase_gateup(p, L, lds);        grid_bar(p, lds); }
    { const Params p = fresh_params(ka); phase_down(p, L, lds);          grid_bar(p, lds); }
    { const Params p = fresh_params(ka); phase_ln2(p, L, L == NL - 1 ? p.out : p.xf, lds); }
}
__global__ void __launch_bounds__(NTHR, 2) fwd_kernel(KArgs ka) {
    extern __shared__ __attribute__((aligned(16))) char lds[];
    const Params p = make_params(ka);
    cg::grid_group grid = cg::this_grid();
    volatile LAS unsigned* xst = (volatile LAS unsigned*)(lds + LDS_BYTES - 16);
    if (threadIdx.x == 0) { xst[0] = 0u; xst[1] = 0u; }
    __syncthreads();
    (void)xcd_barrier_post(p.ctrl + 1024, xst);
    volatile LAS int* vcu = (volatile LAS int*)(lds + LDS_BYTES - 32);
    const unsigned myx = xb_xcc_id() & 7u;
    if (threadIdx.x == 0) vcu[1] = (int)__hip_atomic_fetch_add(p.ctrl + 32 + myx, 1u, __ATOMIC_RELAXED, __HIP_MEMORY_SCOPE_AGENT);
    phase0(p, lds);
    if (REP & 128) { grid_bar(p, lds); phase0(p, lds); }
    grid.sync();
    if (threadIdx.x == 0) {
        int base = 0, tot = 0;
        for (unsigned x = 0; x < 8; ++x) { const int n = (int)__hip_atomic_load(p.ctrl + 32 + x, __ATOMIC_RELAXED, __HIP_MEMORY_SCOPE_AGENT); if (x < myx) base += n; tot += n; }
        vcu[0] = (tot == (int)gridDim.x) ? base + vcu[1] : (int)blockIdx.x;
    }
    __syncthreads();
    layer_fwd<0>(ka, lds);
    grid_bar(p, lds);
    layer_fwd<1>(ka, lds);
}

extern "C" void kernel_launch(void* const* d_in, const int* in_sizes, int n_in, void* d_out, int out_size, void* d_ws, size_t ws_size, hipStream_t stream) {
    KArgs ka{};
    for (int i = 0; i < 18; ++i) ka.in[i] = (const float*)d_in[i];
    ka.out = (float*)d_out; ka.ws = (char*)d_ws;
    if (WSL::total > ws_size) { fprintf(stderr, "workspace too small: need %zu have %zu\n", (size_t)WSL::total, ws_size); return; }
    static int grid_blocks = 0;
    if (!grid_blocks) {
        int dev = 0, cus = 0, per_cu = 0;
        (void)hipGetDevice(&dev);
        (void)hipDeviceGetAttribute(&cus, hipDeviceAttributeMultiprocessorCount, dev);
        (void)hipFuncSetAttribute((const void*)fwd_kernel, hipFuncAttributeMaxDynamicSharedMemorySize, LDS_BYTES);
        (void)hipOccupancyMaxActiveBlocksPerMultiprocessor(&per_cu, fwd_kernel, NTHR, LDS_BYTES);
        if (per_cu < 1) { fprintf(stderr, "occupancy query says 0 blocks per CU\n"); per_cu = 1; }
        grid_blocks = cus;
    }
    (void)hipMemsetAsync(d_ws, 0, 65536, stream);
    void* args[] = {&ka};
    hipError_t e = hipLaunchCooperativeKernel((const void*)fwd_kernel, dim3(grid_blocks), dim3(NTHR), args, LDS_BYTES, stream);
    if (e != hipSuccess) fprintf(stderr, "cooperative launch failed: %s (grid %d)\n", hipGetErrorString(e), grid_blocks);
}
```

```cpp
#include <hip/hip_runtime.h>
#include <hip/hip_cooperative_groups.h>
#include <cstdio>
#include <cstdint>
namespace cg = cooperative_groups;

typedef unsigned short bf16_t;
typedef short bf16x8 __attribute__((ext_vector_type(8)));
typedef float f32x4 __attribute__((ext_vector_type(4)));
typedef unsigned u32x4 __attribute__((ext_vector_type(4)));
typedef unsigned u32x2 __attribute__((ext_vector_type(2)));
typedef int v8i_t __attribute__((ext_vector_type(8)));
typedef float f32x2_t __attribute__((ext_vector_type(2)));
typedef int v4i_t __attribute__((ext_vector_type(4)));
#define LAS __attribute__((address_space(3)))
constexpr float NEG_INF = -__builtin_huge_valf();

constexpr int DM = 1024, NB = 16, SEQ = 2048, NTOK = NB * SEQ, NL = 2;
constexpr int NCOL = 2582, NMAIN = 2560, NPAD = 2688, NE = 32, DFF = 1024;
constexpr int C_FQ = 0, C_FK = 256, C_FV = 512, C_SQ = 768, C_SK = 1152, C_SV = 1280, C_NQ = 1408,
              C_NKC = 1792, C_NVC = 1920, C_NKS = 2048, C_NVS = 2176, C_NKW = 2304, C_NVW = 2432;
constexpr int HS_W = 32;
constexpr int NVH = 10;
constexpr int LIST_CAP = NTOK;
constexpr int MAXSLOT = NTOK * 4 + NE * 256;
constexpr float ALPHA = 1.41421356237f, LN_EPS = 1e-5f, QSCALE = 0.125f;
constexpr int NWV = 8, NTHR = NWV * 64;
constexpr int LDS_STAGE = 131072, LDS_TAB = LDS_STAGE, LDS_AOFF = LDS_STAGE + 2048, LDS_BYTES = LDS_AOFF + 20480 + 256;

struct Params {
    const float *x, *w_in, *b_in, *sinks, *cmp_pe, *cmp_w1, *cmp_w2, *w_out, *ln1_g, *ln1_b, *router_w, *router_b,
                *w_gu, *b_gu, *w_dn, *b_dn, *ln2_g, *ln2_b;
    float* out;
    unsigned* ctrl;
    bf16_t *WinT, *WoT, *W1T, *W2T, *WguT, *WdnT;
    float *rwT, *binp, *bgup, *b1c;
    unsigned char* xq; unsigned char* WinQ;
    float* xf; bf16_t* xb; bf16_t* hb; float* hs; bf16_t* vT; bf16_t* kF; float* cF;
    bf16_t *kc, *vc, *vcT; bf16_t* ob; float* tbuf; float* x1f; bf16_t* x1b;
    int* top_e; float* gw; int* lists; bf16_t* act; bf16_t* ybuf;
};

__device__ __forceinline__ float bf2f(bf16_t h) { return __uint_as_float(((unsigned)h) << 16); }
typedef __bf16 bf16x2_t __attribute__((ext_vector_type(2)));
__device__ __forceinline__ bf16_t f2bf(float f) { return __builtin_bit_cast(bf16_t, (__bf16)f); }
__device__ __forceinline__ unsigned pack2(float lo, float hi) { bf16x2_t v = {(__bf16)lo, (__bf16)hi}; return __builtin_bit_cast(unsigned, v); }
__device__ __forceinline__ unsigned pack4_fp8(float a, float b, float c, float d) {
    unsigned w = 0u;
    w = __builtin_amdgcn_cvt_pk_fp8_f32(a, b, w, false);
    w = __builtin_amdgcn_cvt_pk_fp8_f32(c, d, w, true);
    return w;
}
__device__ __forceinline__ float shfl_f(float v, int src_lane) { return __int_as_float(__builtin_amdgcn_ds_bpermute(src_lane << 2, __float_as_int(v))); }
__device__ __forceinline__ unsigned shfl_u(unsigned v, int src_lane) { return (unsigned)__builtin_amdgcn_ds_bpermute(src_lane << 2, (int)v); }
__device__ __forceinline__ float wave_sum(float v) {
#pragma unroll
    for (int o = 32; o > 0; o >>= 1) v += __shfl_xor(v, o);
    return v;
}
__device__ __forceinline__ float wave_max(float v) {
#pragma unroll
    for (int o = 32; o > 0; o >>= 1) v = fmaxf(v, __shfl_xor(v, o));
    return v;
}
__device__ __forceinline__ void lds_wave_sync() { asm volatile("s_waitcnt lgkmcnt(0)" ::: "memory"); __builtin_amdgcn_wave_barrier(); }
__device__ __forceinline__ float slope_swa(int hq) { return exp2f(-8.0f * (float)(2 * hq + 1) / 12.0f); }
__device__ __forceinline__ float slope_nsa(int hq) { return exp2f(-8.0f * (float)(2 * hq + 2) / 12.0f); }

__device__ __forceinline__ int perm_row(int perm, int n) {
    if (perm == 1) { if (n < 768) return n; if (n < 772) return 2560 + (n - 768); if (n < 2564) return n - 4; return n; }
    if (perm == 2) { const int f = n >> 1, s = n & 1; return (f >> 7) * 256 + s * 128 + (f & 127); }
    return n;
}
struct ConvJob { const float* src; bf16_t* dst; int K, N, kt, nt, perm; float q8; };
__device__ __forceinline__ bool conv_job(const Params& p, int t, ConvJob& jb) {
    constexpr int T_WIN = NL * 8 * 21, T_WO = NL * 8 * 8;
    if (t < T_WIN) { const int m = t / 168, r = t % 168; jb = ConvJob{p.w_in + (size_t)m * 1024 * NCOL, p.WinT + (size_t)m * NPAD * 1024, 1024, NCOL, r / 21, r % 21, 1, 0.f}; return true; }
    t -= T_WIN;
    if (t < T_WO) { const int m = t / 64, r = t % 64; jb = ConvJob{p.w_out + (size_t)m * 1024 * 1024, (bf16_t*)((char*)p.WoT + (size_t)m * 1024 * 1024), 1024, 1024, r / 8, r % 8, 0, 64.0f}; return true; }
    t -= T_WO;
    if (t < T_WIN) { const int m = t / 168, r = t % 168; jb = ConvJob{p.w_in + (size_t)m * 1024 * NCOL, (bf16_t*)(p.WinQ + (size_t)m * NMAIN * 1024), 1024, NCOL, r / 21, r % 21, 1, 64.0f}; return true; }
    return false;
}
constexpr int CONV_TILES = NL * NE * 192;
__device__ __forceinline__ void conv_tile_wave(const Params& p, int t, int lane, unsigned char* l8) {
    asm volatile("" : "+v"(lane));
    const int m = t / 192, r = t % 192;
    const float* src; unsigned char* dst; int N, kt, nt, perm;
    if (r < 128) { src = p.w_gu + (size_t)m * 1024 * 2048; dst = (unsigned char*)p.WguT + (size_t)m * 2048 * 1024; N = 2048; kt = r >> 4; nt = r & 15; perm = 2; }
    else { const int q = r - 128; src = p.w_dn + (size_t)m * 1024 * 1024; dst = (unsigned char*)p.WdnT + (size_t)m * 1024 * 1024; N = 1024; kt = q >> 3; nt = q & 7; perm = 0; }
    const float* s = src + (size_t)(kt * 128 + (lane >> 5)) * N + nt * 128 + (lane & 31) * 4;
    unsigned char* lw = l8 + (lane >> 5) * 132 + (lane & 31) * 4;
    float4 va[16], vb[16];
#pragma unroll
    for (int i = 0; i < 16; ++i) va[i] = *(const float4*)(s + (size_t)(2 * i) * N);
#pragma unroll
    for (int i = 0; i < 16; ++i) vb[i] = *(const float4*)(s + (size_t)(32 + 2 * i) * N);
#pragma unroll
    for (int i = 0; i < 16; ++i) *(unsigned*)(lw + (2 * i) * 132) = pack4_fp8(va[i].x * 64.0f, va[i].y * 64.0f, va[i].z * 64.0f, va[i].w * 64.0f);
#pragma unroll
    for (int i = 0; i < 16; ++i) va[i] = *(const float4*)(s + (size_t)(64 + 2 * i) * N);
#pragma unroll
    for (int i = 0; i < 16; ++i) *(unsigned*)(lw + (32 + 2 * i) * 132) = pack4_fp8(vb[i].x * 64.0f, vb[i].y * 64.0f, vb[i].z * 64.0f, vb[i].w * 64.0f);
#pragma unroll
    for (int i = 0; i < 16; ++i) vb[i] = *(const float4*)(s + (size_t)(96 + 2 * i) * N);
#pragma unroll
    for (int i = 0; i < 16; ++i) *(unsigned*)(lw + (64 + 2 * i) * 132) = pack4_fp8(va[i].x * 64.0f, va[i].y * 64.0f, va[i].z * 64.0f, va[i].w * 64.0f);
#pragma unroll
    for (int i = 0; i < 16; ++i) *(unsigned*)(lw + (96 + 2 * i) * 132) = pack4_fp8(vb[i].x * 64.0f, vb[i].y * 64.0f, vb[i].z * 64.0f, vb[i].w * 64.0f);
    lds_wave_sync();
#pragma unroll 4
    for (int i = 0; i < 16; ++i) {
        const int idx = lane + 64 * i, kc = idx & 7, nn = idx >> 3;
        const unsigned char* l = l8 + (kc * 16) * 132 + nn;
        u32x4 w;
        w.x = (unsigned)l[0] | ((unsigned)l[132] << 8) | ((unsigned)l[264] << 16) | ((unsigned)l[396] << 24);
        w.y = (unsigned)l[528] | ((unsigned)l[660] << 8) | ((unsigned)l[792] << 16) | ((unsigned)l[924] << 24);
        w.z = (unsigned)l[1056] | ((unsigned)l[1188] << 8) | ((unsigned)l[1320] << 16) | ((unsigned)l[1452] << 24);
        w.w = (unsigned)l[1584] | ((unsigned)l[1716] << 8) | ((unsigned)l[1848] << 16) | ((unsigned)l[1980] << 24);
        *(u32x4*)(dst + (size_t)perm_row(perm, nt * 128 + nn) * 1024 + kt * 128 + kc * 16) = w;
    }
    lds_wave_sync();
}
__device__ __forceinline__ void conv_load(const ConvJob& jb, int tid, float2 (&v)[16]) {
    const int n = jb.nt * 128 + (tid & 31) * 4;
    const float* s = jb.src + (size_t)(jb.kt * 128 + (tid >> 5)) * jb.N + n;
#pragma unroll
    for (int i = 0; i < 8; ++i) {
        const float* r = s + (size_t)(16 * i) * jb.N;
        v[2 * i] = (n + 1 < jb.N) ? *(const float2*)r : make_float2(0.f, 0.f);
        v[2 * i + 1] = (n + 3 < jb.N) ? *(const float2*)(r + 2) : make_float2(0.f, 0.f);
    }
}
__device__ __forceinline__ void phase0(const Params& p, char* ldsc) {
    int tid = threadIdx.x; asm volatile("" : "+v"(tid));
    const int G = gridDim.x, bid = blockIdx.x;
    const size_t gtid = (size_t)bid * NTHR + tid, gthreads = (size_t)G * NTHR;
    {
        constexpr int TOT = 2 * NL * 8 * 21 + NL * 8 * 8;
        bf16_t* lt = (bf16_t*)ldsc;
        ConvJob jb, jn; float2 v[16], vn[16];
        int t = bid; bool have = t < TOT && conv_job(p, t, jb);
        if (have) conv_load(jb, tid, v);
        while (have) {
            const int tn = t + G; const bool hn = tn < TOT && conv_job(p, tn, jn);
            if (hn) conv_load(jn, tid, vn);
            if (jb.q8 != 0.f) {
                unsigned char* l8 = (unsigned char*)lt;
#pragma unroll
                for (int i = 0; i < 8; ++i)
                    *(unsigned*)(l8 + ((tid >> 5) + 16 * i) * 132 + (tid & 31) * 4) = pack4_fp8(v[2 * i].x * jb.q8, v[2 * i].y * jb.q8, v[2 * i + 1].x * jb.q8, v[2 * i + 1].y * jb.q8);
                __syncthreads();
#pragma unroll
                for (int i = 0; i < 2; ++i) {
                    const int idx = tid + NTHR * i, kc = idx & 7, nn = idx >> 3, n = jb.nt * 128 + nn;
                    const unsigned char* l = l8 + (kc * 16) * 132 + nn;
                    u32x4 w;
                    w.x = (unsigned)l[0] | ((unsigned)l[132] << 8) | ((unsigned)l[264] << 16) | ((unsigned)l[396] << 24);
                    w.y = (unsigned)l[528] | ((unsigned)l[660] << 8) | ((unsigned)l[792] << 16) | ((unsigned)l[924] << 24);
                    w.z = (unsigned)l[1056] | ((unsigned)l[1188] << 8) | ((unsigned)l[1320] << 16) | ((unsigned)l[1452] << 24);
                    w.w = (unsigned)l[1584] | ((unsigned)l[1716] << 8) | ((unsigned)l[1848] << 16) | ((unsigned)l[1980] << 24);
                    const int pr = perm_row(jb.perm, n);
                    if (n < jb.N && !(jb.perm == 1 && pr >= NMAIN)) *(u32x4*)((char*)jb.dst + (size_t)pr * jb.K + jb.kt * 128 + kc * 16) = w;
                }
            } else {
#pragma unroll
                for (int i = 0; i < 8; ++i) {
                    u32x2 w; w.x = pack2(v[2 * i].x, v[2 * i].y); w.y = pack2(v[2 * i + 1].x, v[2 * i + 1].y);
                    *(u32x2*)(lt + ((tid >> 5) + 16 * i) * 136 + (tid & 31) * 4) = w;
                }
                __syncthreads();
#pragma unroll
                for (int i = 0; i < 4; ++i) {
                    const int idx = tid + NTHR * i, kc = idx & 15, nn = idx >> 4, n = jb.nt * 128 + nn;
                    if (n < jb.N) {
                        const bf16_t* l = lt + (kc * 8) * 136 + nn;
                        u32x4 w;
                        w.x = (unsigned)l[0] | ((unsigned)l[136] << 16); w.y = (unsigned)l[272] | ((unsigned)l[408] << 16);
                        w.z = (unsigned)l[544] | ((unsigned)l[680] << 16); w.w = (unsigned)l[816] | ((unsigned)l[952] << 16);
                        *(u32x4*)(jb.dst + (size_t)perm_row(jb.perm, n) * jb.K + jb.kt * 128 + kc * 8) = w;
                    }
                }
            }
            __syncthreads();
            t = tn; have = hn; jb = jn;
#pragma unroll
            for (int i = 0; i < 16; ++i) v[i] = vn[i];
        }
    }
    for (size_t i = gtid; i < (size_t)NL * 2 * 2048 * 64; i += gthreads) {
        const int k = (int)(i % 2048), n = (int)((i / 2048) % 64), m = (int)(i / (2048 * 64));
        p.W1T[i] = f2bf(p.cmp_w1[((size_t)m * 2048 + k) * 64 + n]);
    }
    for (size_t i = gtid; i < (size_t)NL * 2 * 64 * 64; i += gthreads) {
        const int k = (int)(i % 64), n = (int)((i / 64) % 64), m = (int)(i / 4096);
        p.W2T[i] = f2bf(p.cmp_w2[((size_t)m * 64 + k) * 64 + n]);
    }
    for (size_t i = gtid; i < (size_t)NL * NPAD; i += gthreads) {
        const int l = (int)(i / NPAD), r = (int)(i % NPAD);
        float v = 0.f;
        if (r < 2560) { const int n = r < 768 ? r : r + 4; v = p.b_in[l * NCOL + n]; }
        else if (r < 2564) v = p.b_in[l * NCOL + 768 + (r - 2560)];
        else if (r < 2582) v = p.b_in[l * NCOL + r];
        p.binp[i] = v;
    }
    for (size_t i = gtid; i < (size_t)NL * NE * 2048; i += gthreads) {
        const int r = (int)(i % 2048); const size_t le = i / 2048;
        const int s = (r >> 7) & 1, f = (r >> 8) * 128 + (r & 127);
        p.bgup[i] = p.b_gu[le * 2048 + 2 * f + s];
    }
    for (size_t i = gtid; i < (size_t)NL * NE * 1024; i += gthreads) {
        const int k = (int)(i % 1024), e = (int)((i / 1024) % NE), l = (int)(i / (1024 * NE));
        p.rwT[i] = p.router_w[((size_t)l * 1024 + k) * NE + e];
    }
    for (size_t i = gtid; i < (size_t)NL * (NPAD - NCOL) * 1024; i += gthreads) {
        const int l = (int)(i / ((NPAD - NCOL) * 1024)); const size_t r = i % ((size_t)(NPAD - NCOL) * 1024);
        p.WinT[(size_t)l * NPAD * 1024 + (size_t)NCOL * 1024 + r] = 0;
    }
    for (size_t i = gtid; i < (size_t)NTOK * DM / 4; i += gthreads) {
        const float4 v4 = ((const float4*)p.x)[i];
        u32x2 w; w.x = pack2(v4.x, v4.y); w.y = pack2(v4.z, v4.w);
        ((u32x2*)p.xb)[i] = w;
        ((unsigned*)p.xq)[i] = pack4_fp8(v4.x, v4.y, v4.z, v4.w);
    }
    if (bid < 4) {
        float* lf = (float*)ldsc;
        const int j = tid & 63, part = tid >> 6;
        const float* pe = p.cmp_pe + (size_t)bid * 2048; const float* w1 = p.cmp_w1 + (size_t)bid * 2048 * 64;
        float s = 0.f;
        for (int kk = part * 256; kk < part * 256 + 256; ++kk) s += pe[kk] * w1[(size_t)kk * 64 + j];
        lf[tid] = s; __syncthreads();
        if (tid < 64) { float a = 0.f; for (int q = 0; q < 8; ++q) a += lf[tid + 64 * q]; p.b1c[bid * 64 + tid] = a; }
        __syncthreads();
    }
}

__device__ __forceinline__ int vcu_id() { return __builtin_amdgcn_readfirstlane(*(const volatile LAS int*)(LDS_BYTES - 32)); }
namespace pg8 {
constexpr int BM = 256, BK = 64, HALF = 128, HTB = HALF * BK * 2, NXCD = 8, WGM = 8;
__device__ __forceinline__ int lds_byte(int r, int c) { const int st = (r >> 4) * 2 + (c >> 5), rr = r & 15, cc = c & 31, ob = rr * 64 + cc * 2; return st * 1024 + (ob ^ (((ob >> 9) & 1) << 5)); }
__device__ __forceinline__ void stage_rc(int b, int& R, int& C) { const int st = b / 1024, sb = b % 1024, swz = sb ^ (((sb >> 9) & 1) << 5); R = (st >> 1) * 16 + swz / 64; C = (st & 1) * 32 + (swz % 64) / 2; }
__device__ __forceinline__ bool tile_order(int i, int G, int c, int nM, int nN, int& pm, int& pn) {
    const int nwg = nM * nN; const long L = (long)i * G + c; if (L >= nwg) return false;
    const int wgid = (int)L;
    const int nig = WGM * nN, gid = wgid / nig, fm = gid * WGM, gsz = (nM - fm) < WGM ? (nM - fm) : WGM;
    pm = fm + ((wgid % nig) % gsz); pn = (wgid % nig) / gsz; return true;
}
template <bool FP8, int SCA, class Sched, class Epi>
__device__ __forceinline__ void gemm_phase(LAS unsigned char* lds, const char* Abase, int K, const Sched& S, const Epi& E) {
    int tid = threadIdx.x; asm volatile("" : "+v"(tid));
    const int wid = __builtin_amdgcn_readfirstlane(tid >> 6), lane = tid & 63, wr = wid >> 2, wc = wid & 3, fr = lane & 15, fq = lane >> 4;
    const int nt = K / BK;
    int R0, C0, R1, C1; stage_rc(tid * 16, R0, C0); stage_rc(tid * 16 + 8192, R1, C1);
    LAS unsigned* aofs = (LAS unsigned*)(lds + LDS_AOFF) + tid;
    unsigned rg[10];
    rg[8] = (unsigned)(R0 * K + C0) * 2u; rg[9] = (unsigned)(R1 * K + C1) * 2u;
    if constexpr (FP8) { aofs[8 * NTHR] = rg[8]; aofs[9 * NTHR] = rg[9]; }
    const size_t kstep = (size_t)(BK * 2), hstep = (size_t)HALF * K * 2;
    const unsigned ldsw = (unsigned)wid * 1024u;
    const int aoff = lds_byte(wr * 64 + fr, fq * 8), boff = lds_byte(wc * 32 + fr, fq * 8);
#define PG8_SA(b, h) (((b) * 2 + (h)) * HTB)
#define PG8_SB(b, h) ((4 + (b) * 2 + (h)) * HTB)
#define PG8_OFS(sel, j) (FP8 ? aofs[((sel) * 4 + (j)) * NTHR] : ((sel) ? rg[4 + (j)] : rg[(j)]))
#define PG8_STAGE_B(bufoff, gbase) do { _Pragma("unroll") for (int _i = 0; _i < 2; ++_i) { const unsigned ob_ = FP8 ? aofs[(8 + _i) * NTHR] : rg[8 + _i]; \
        __builtin_amdgcn_global_load_lds((const unsigned*)((const char*)(gbase) + ob_), (LAS unsigned*)(lds + (bufoff) + ldsw + _i * 8192), 16, 0, 0); } } while (0)
#define PG8_STAGE_A(bufoff, kbyte, sel, h) do { const unsigned o0_ = PG8_OFS(sel, (h) * 2), o1_ = PG8_OFS(sel, (h) * 2 + 1); \
        __builtin_amdgcn_global_load_lds((const unsigned*)(Abase + (kbyte) + o0_), (LAS unsigned*)(lds + (bufoff) + ldsw), 16, 0, 0); \
        __builtin_amdgcn_global_load_lds((const unsigned*)(Abase + (kbyte) + o1_), (LAS unsigned*)(lds + (bufoff) + ldsw + 8192), 16, 0, 0); } while (0)
#define PG8_LDA(dst, b, h) do { _Pragma("unroll") for (int m = 0; m < 4; ++m) { \
        if constexpr (FP8) { const v4i_t lo_ = *(const LAS v4i_t*)(lds + PG8_SA(b, h) + aoff + m * 2048), hi_ = *(const LAS v4i_t*)(lds + PG8_SA(b, h) + aoff + m * 2048 + 1024); dst##8[m] = __builtin_shufflevector(lo_, hi_, 0, 1, 2, 3, 4, 5, 6, 7); } \
        else { _Pragma("unroll") for (int k = 0; k < 2; ++k) dst[m][k] = *(const LAS bf16x8*)(lds + PG8_SA(b, h) + aoff + m * 2048 + k * 1024); } } } while (0)
#define PG8_LDB(dst, b, h) do { _Pragma("unroll") for (int n = 0; n < 2; ++n) { \
        if constexpr (FP8) { const v4i_t lo_ = *(const LAS v4i_t*)(lds + PG8_SB(b, h) + boff + n * 2048), hi_ = *(const LAS v4i_t*)(lds + PG8_SB(b, h) + boff + n * 2048 + 1024); dst##8[n] = __builtin_shufflevector(lo_, hi_, 0, 1, 2, 3, 4, 5, 6, 7); } \
        else { _Pragma("unroll") for (int k = 0; k < 2; ++k) dst[n][k] = *(const LAS bf16x8*)(lds + PG8_SB(b, h) + boff + n * 2048 + k * 1024); } } } while (0)
#define PG8_MMA(ai, bj, At, Bt) do { __builtin_amdgcn_s_setprio(1); _Pragma("unroll") for (int m = 0; m < 4; ++m) _Pragma("unroll") for (int n = 0; n < 2; ++n) { \
        if constexpr (FP8) { acc[ai][bj][m][n] = __builtin_amdgcn_mfma_scale_f32_16x16x128_f8f6f4(Bt##8[n], At##8[m], acc[ai][bj][m][n], 0, 0, 0, SCA, 0, SCA); } \
        else { _Pragma("unroll") for (int k = 0; k < 2; ++k) acc[ai][bj][m][n] = __builtin_amdgcn_mfma_f32_16x16x32_bf16(Bt[n][k], At[m][k], acc[ai][bj][m][n], 0, 0, 0); } } \
        __builtin_amdgcn_s_setprio(0); } while (0)
#define PG8_WAIT_V(n) asm volatile("s_waitcnt vmcnt(" #n ")" ::: "memory")
#define PG8_WAIT_L(n) asm volatile("s_waitcnt lgkmcnt(" #n ")" ::: "memory")
#define PG8_BAR __builtin_amdgcn_s_barrier()
#define PG8_SCHED __builtin_amdgcn_sched_barrier(0)
    typename Sched::Unit cur, nxt; int ui = 0;
    if (!S.next(0, cur)) return;
    f32x4 acc[2][2][4][2];
#pragma unroll
    for (int a = 0; a < 2; ++a)
#pragma unroll
        for (int b = 0; b < 2; ++b)
#pragma unroll
            for (int m = 0; m < 4; ++m)
#pragma unroll
                for (int n = 0; n < 2; ++n) acc[a][b][m][n] = (f32x4){0.f, 0.f, 0.f, 0.f};
    bf16x8 At[4][2], B0[2][2], B1[2][2];
    v8i_t At8[4], B08[2], B18[2];
    { unsigned a4[2][2]; S.a_off(cur, R0, C0, R1, C1, a4); rg[0] = a4[0][0]; rg[1] = a4[0][1]; rg[2] = a4[1][0]; rg[3] = a4[1][1];
      if constexpr (FP8) { aofs[0] = a4[0][0]; aofs[NTHR] = a4[0][1]; aofs[2 * NTHR] = a4[1][0]; aofs[3 * NTHR] = a4[1][1]; } }
    const char* cB = S.b_ptr(cur);
    PG8_STAGE_B(PG8_SB(0, 0), cB); PG8_STAGE_B(PG8_SB(0, 1), cB + hstep); PG8_STAGE_A(PG8_SA(0, 0), 0, 0, 0); PG8_STAGE_A(PG8_SA(0, 1), 0, 0, 1);
    if (wr == 1) PG8_BAR;
    PG8_WAIT_V(2); PG8_BAR;
    PG8_STAGE_B(PG8_SB(1, 0), cB + kstep); PG8_STAGE_A(PG8_SA(1, 0), kstep, 0, 0); PG8_STAGE_B(PG8_SB(1, 1), cB + hstep + kstep);
    PG8_WAIT_V(6); PG8_BAR;
    for (;;) {
        const bool has_next = S.next(ui + 1, nxt);
        const char* nB = cB;
        if (has_next) { int t2 = threadIdx.x; asm volatile("" : "+v"(t2)); int r0, c0, r1, c1; stage_rc(t2 * 16, r0, c0); stage_rc(t2 * 16 + 8192, r1, c1); unsigned a4[2][2]; S.a_off(nxt, r0, c0, r1, c1, a4); nB = S.b_ptr(nxt);
            rg[4] = a4[0][0]; rg[5] = a4[0][1]; rg[6] = a4[1][0]; rg[7] = a4[1][1];
            if constexpr (FP8) { aofs[4 * NTHR] = a4[0][0]; aofs[5 * NTHR] = a4[0][1]; aofs[6 * NTHR] = a4[1][0]; aofs[7 * NTHR] = a4[1][1]; } }
        else { rg[4] = rg[0]; rg[5] = rg[1]; rg[6] = rg[2]; rg[7] = rg[3];
            if constexpr (FP8) { aofs[4 * NTHR] = aofs[0]; aofs[5 * NTHR] = aofs[NTHR]; aofs[6 * NTHR] = aofs[2 * NTHR]; aofs[7 * NTHR] = aofs[3 * NTHR]; } }
#pragma unroll 1
        for (int t = 0; t < nt; t += 2) {
            const bool last = (t == nt - 2);
            const size_t ka1 = (size_t)(t + 1) * kstep, ka2 = last ? 0 : (size_t)(t + 2) * kstep, ka3 = ka2 + kstep;
            const char* b2 = last ? nB : cB + (size_t)(t + 2) * kstep; const char* b3 = b2 + kstep;
            const int sel = last ? 1 : 0;
            PG8_LDB(B0, 0, 0); PG8_LDB(B1, 0, 1); PG8_SCHED; PG8_LDA(At, 0, 0); PG8_STAGE_A(PG8_SA(1, 1), ka1, 0, 1);
            PG8_WAIT_V(8); PG8_WAIT_L(0); PG8_BAR; PG8_MMA(0, 0, At, B0); PG8_MMA(0, 1, At, B1); PG8_BAR; PG8_SCHED;
            PG8_LDA(At, 0, 1); PG8_STAGE_B(PG8_SB(0, 0), b2); PG8_STAGE_B(PG8_SB(0, 1), b2 + hstep); PG8_STAGE_A(PG8_SA(0, 0), ka2, sel, 0);
            PG8_WAIT_V(8); PG8_WAIT_L(0); PG8_BAR; PG8_MMA(1, 0, At, B0); PG8_MMA(1, 1, At, B1); PG8_BAR; PG8_SCHED;
            PG8_LDB(B0, 1, 0); PG8_LDB(B1, 1, 1); PG8_SCHED; PG8_LDA(At, 1, 0); PG8_STAGE_A(PG8_SA(0, 1), ka2, sel, 1);
            PG8_WAIT_V(8); PG8_WAIT_L(0); PG8_BAR; PG8_MMA(0, 0, At, B0); PG8_MMA(0, 1, At, B1); PG8_BAR; PG8_SCHED;
            PG8_LDA(At, 1, 1); PG8_STAGE_B(PG8_SB(1, 0), b3); PG8_STAGE_B(PG8_SB(1, 1), b3 + hstep); PG8_STAGE_A(PG8_SA(1, 0), ka3, sel, 0);
            PG8_WAIT_V(8); PG8_WAIT_L(0); PG8_BAR; PG8_MMA(1, 0, At, B0); PG8_MMA(1, 1, At, B1); PG8_BAR; PG8_SCHED;
        }
        if (wr == 0) PG8_BAR;
        { int t2 = threadIdx.x; asm volatile("" : "+v"(t2)); E(acc, cur, wr, wc, t2 & 15, (t2 & 63) >> 4); }
        if (!has_next) break;
#pragma unroll
        for (int a = 0; a < 2; ++a)
#pragma unroll
            for (int b = 0; b < 2; ++b)
#pragma unroll
                for (int m = 0; m < 4; ++m)
#pragma unroll
                    for (int n = 0; n < 2; ++n) acc[a][b][m][n] = (f32x4){0.f, 0.f, 0.f, 0.f};
        cur = nxt; cB = nB; ++ui;
        rg[0] = rg[4]; rg[1] = rg[5]; rg[2] = rg[6]; rg[3] = rg[7];
        if constexpr (FP8) { aofs[0] = aofs[4 * NTHR]; aofs[NTHR] = aofs[5 * NTHR]; aofs[2 * NTHR] = aofs[6 * NTHR]; aofs[3 * NTHR] = aofs[7 * NTHR]; }
        if (wr == 1) PG8_BAR;
    }
    PG8_WAIT_V(0);
    PG8_BAR;
#undef PG8_SA
#undef PG8_SB
#undef PG8_STAGE_A
#undef PG8_OFS
#undef PG8_STAGE_B
#undef PG8_LDA
#undef PG8_LDB
#undef PG8_MMA
#undef PG8_WAIT_V
#undef PG8_WAIT_L
#undef PG8_BAR
#undef PG8_SCHED
}
}

struct DenseUnit { int pm, pn; };
struct DenseSched {
    typedef DenseUnit Unit;
    const char* Bt; int K, nM, nN, vc;
    __device__ __forceinline__ bool next(int i, Unit& u) const { return pg8::tile_order(i, gridDim.x, vc, nM, nN, u.pm, u.pn); }
    __device__ __forceinline__ void a_off(const Unit& u, int R0, int C0, int R1, int C1, unsigned (&off)[2][2]) const {
#pragma unroll
        for (int h = 0; h < 2; ++h) { off[h][0] = (unsigned)((u.pm * 256 + h * 128 + R0) * K + C0) * 2u; off[h][1] = (unsigned)((u.pm * 256 + h * 128 + R1) * K + C1) * 2u; }
    }
    __device__ __forceinline__ const char* b_ptr(const Unit& u) const { return Bt + (size_t)u.pn * 256 * K * 2; }
};
struct MoeUnit { int rbt, e, pn; };
template <bool GATHER>
struct MoeSched {
    typedef MoeUnit Unit;
    static constexpr int KP = 512;
    const char* Bt; const int* lists; const int* ptile; const int* ecnt; int nN, nrows, vc;
    __device__ __forceinline__ bool next(int i, Unit& u) const {
        int pm, pn; if (!pg8::tile_order(i, gridDim.x, vc, ptile[NE], nN, pm, pn)) return false;
        int e = 0; while (ptile[e + 1] <= pm) ++e;
        u.rbt = pm; u.e = e; u.pn = pn; return true;
    }
    __device__ __forceinline__ void a_off(const Unit& u, int R0, int C0, int R1, int C1, unsigned (&off)[2][2]) const {
        if (GATHER) {
            const int* lst = lists + (size_t)u.e * LIST_CAP; const int rb = u.rbt - ptile[u.e], cnt = ecnt[u.e];
#pragma unroll
            for (int h = 0; h < 2; ++h) {
                const int l0 = rb * 256 + h * 128 + R0, l1 = rb * 256 + h * 128 + R1;
                const int t0 = l0 < cnt ? (lst[l0] >> 2) : 0, t1 = l1 < cnt ? (lst[l1] >> 2) : 0;
                off[h][0] = (unsigned)(t0 * KP + C0) * 2u; off[h][1] = (unsigned)(t1 * KP + C1) * 2u;
            }
        } else {
#pragma unroll
            for (int h = 0; h < 2; ++h) { off[h][0] = (unsigned)((u.rbt * 256 + h * 128 + R0) * KP + C0) * 2u; off[h][1] = (unsigned)((u.rbt * 256 + h * 128 + R1) * KP + C1) * 2u; }
        }
    }
    __device__ __forceinline__ const char* b_ptr(const Unit& u) const { return Bt + ((size_t)u.e * nrows + (size_t)u.pn * 256) * KP * 2; }
};

struct EpiInProj {
    const Params* p; int l;
    __device__ __forceinline__ void operator()(const f32x4 (&acc)[2][2][4][2], const DenseUnit& u, int wr, int wc, int fr, int fq) const {
        const float* bias = p->binp + l * NPAD + u.pn * 256;
#pragma unroll
        for (int bj = 0; bj < 2; ++bj) {
            int kind = 0, hb0 = 0;
            if (u.pn == 1) { kind = 1; hb0 = bj * 2; } else if (u.pn == 4 && bj == 1) { kind = 1; hb0 = 4; } else if (u.pn == 8 && bj == 0) { kind = 1; hb0 = 6; } else if (u.pn == 9 && bj == 0) { kind = 1; hb0 = 8; }
            else if (u.pn == 2) { kind = 2; hb0 = bj * 2; } else if (u.pn == 5 && bj == 0) { kind = 2; hb0 = 4; } else if (u.pn == 8 && bj == 1) { kind = 2; hb0 = 6; } else if (u.pn == 9 && bj == 1) { kind = 2; hb0 = 8; }
#pragma unroll
            for (int n = 0; n < 2; ++n) {
                const int c = bj * 128 + wc * 32 + n * 16 + 4 * fq;
                const f32x4 bv = *(const f32x4*)(bias + c);
                const int hh = hb0 + ((c & 127) >> 6), d = c & 63;
#pragma unroll
                for (int ai = 0; ai < 2; ++ai)
#pragma unroll
                    for (int m = 0; m < 4; ++m) {
                        const int row = u.pm * 256 + ai * 128 + wr * 64 + m * 16 + fr;
                        const f32x4 v = acc[ai][bj][m][n] + bv;
                        u32x2 w; w.x = pack2(v[0], v[1]); w.y = pack2(v[2], v[3]);
                        if (kind == 0) *(u32x2*)(p->hb + (size_t)row * NMAIN + u.pn * 256 + c) = w;
                        else {
                            const int b = row >> 11, s = row & 2047, kk = s & 31;
                            bf16_t* blk = (kind == 1 ? p->kF : p->vT) + (((size_t)b * NVH + hh) * 64 + (s >> 5)) * 2048;
                            if (kind == 1) {
                                const int frk = (kk >> 3) * 4 + (kk & 3), t = (kk >> 2) & 1;
                                *(u32x2*)(blk + ((t * 2 + (d >> 5)) * 64 + ((d & 31) >> 3) * 16 + frk) * 8 + (d & 7)) = w;
                            } else {
                                bf16_t* vt = blk + (((d >> 4) * 64) + (kk >> 3) * 16 + (d & 15)) * 8 + (kk & 7);
                                vt[0] = (bf16_t)(w.x & 0xffff); vt[8] = (bf16_t)(w.x >> 16); vt[16] = (bf16_t)(w.y & 0xffff); vt[24] = (bf16_t)(w.y >> 16);
                            }
                        }
                    }
            }
        }
    }
};
struct EpiOutProj {
    const float* xin; float* t;
    __device__ __forceinline__ void operator()(const f32x4 (&acc)[2][2][4][2], const DenseUnit& u, int wr, int wc, int fr, int fq) const {
#pragma unroll
        for (int ai = 0; ai < 2; ++ai)
#pragma unroll
            for (int m = 0; m < 4; ++m) {
                const size_t rowoff = (size_t)(u.pm * 256 + ai * 128 + wr * 64 + m * 16 + fr) * DM + u.pn * 256 + wc * 32 + 4 * fq;
#pragma unroll
                for (int bj = 0; bj < 2; ++bj)
#pragma unroll
                    for (int n = 0; n < 2; ++n) {
                        const size_t off = rowoff + bj * 128 + n * 16;
                        const f32x4 xv = *(const f32x4*)(xin + off);
                        const f32x4 tv = xv * ALPHA + acc[ai][bj][m][n];
                        u32x2 w; w.x = pack2(tv[0], tv[1]); w.y = pack2(tv[2], tv[3]);
                        *(u32x2*)((bf16_t*)t + off) = w;
                    }
            }
    }
};
struct EpiGateUp {
    bf16_t* act; const float* bgup;
    __device__ __forceinline__ void operator()(const f32x4 (&acc)[2][2][4][2], const MoeUnit& u, int wr, int wc, int fr, int fq) const {
        const float* bias = bgup + (size_t)u.e * 2048 + u.pn * 256;
#pragma unroll
        for (int n = 0; n < 2; ++n) {
            const int c = wc * 32 + n * 16 + 4 * fq;
            const f32x4 bg = *(const f32x4*)(bias + c), bu = *(const f32x4*)(bias + 128 + c);
#pragma unroll
            for (int ai = 0; ai < 2; ++ai)
#pragma unroll
                for (int m = 0; m < 4; ++m) {
                    const f32x4 g4 = acc[ai][0][m][n] + bg, u4 = acc[ai][1][m][n] + bu;
                    float o[4];
#pragma unroll
                    for (int j = 0; j < 4; ++j) {
                        const float g = fminf(g4[j], 7.0f), uu = fminf(fmaxf(u4[j], -7.0f), 7.0f);
                        const float glu = g * __builtin_amdgcn_rcpf(1.0f + __builtin_amdgcn_exp2f(-2.455466929f * g));
                        o[j] = (uu + 1.0f) * glu;
                    }
                    *(unsigned*)((char*)act + (size_t)(u.rbt * 256 + ai * 128 + wr * 64 + m * 16 + fr) * DFF + u.pn * 128 + c) = pack4_fp8(o[0], o[1], o[2], o[3]);
                }
        }
    }
};
struct EpiDown {
    bf16_t* ybuf; const float* bdn;
    __device__ __forceinline__ void operator()(const f32x4 (&acc)[2][2][4][2], const MoeUnit& u, int wr, int wc, int fr, int fq) const {
        const float* bias = bdn + (size_t)u.e * 1024 + u.pn * 256;
#pragma unroll
        for (int bj = 0; bj < 2; ++bj)
#pragma unroll
            for (int n = 0; n < 2; ++n) {
                const int c = bj * 128 + wc * 32 + n * 16 + 4 * fq;
                const f32x4 bv = *(const f32x4*)(bias + c);
#pragma unroll
                for (int ai = 0; ai < 2; ++ai)
#pragma unroll
                    for (int m = 0; m < 4; ++m) {
                        const f32x4 v = acc[ai][bj][m][n] + bv;
                        *(unsigned*)((unsigned char*)ybuf + (size_t)(u.rbt * 256 + ai * 128 + wr * 64 + m * 16 + fr) * DM + u.pn * 256 + c) = pack4_fp8(v[0], v[1], v[2], v[3]);
                    }
            }
    }
};

__device__ __forceinline__ void phase_inproj(const Params& p, int l, char* lds) {
    DenseSched S{(const char*)p.WinQ + (size_t)l * NMAIN * 1024, 512, NTOK / 256, NMAIN / 256, vcu_id()};
    EpiInProj E{&p, l};
    pg8::gemm_phase<true, 0x7c7c7c7c>((LAS unsigned char*)lds, (const char*)p.xq, 512, S, E);
    int tid = threadIdx.x; asm volatile("" : "+v"(tid));
    const int wid = tid >> 6, lane = tid & 63, fr = lane & 15, fq = lane >> 4;
    const bf16_t* W = p.WinT + ((size_t)l * NPAD + NMAIN) * 1024;
    const float* bias = p.binp + l * NPAD + NMAIN;
    for (int u = blockIdx.x * NWV + wid; u < NTOK / 16; u += gridDim.x * NWV) {
        const bf16_t* ar = p.xb + (size_t)(u * 16 + fr) * DM + fq * 8;
        const bf16_t* w0 = W + (size_t)fr * 1024 + fq * 8; const bf16_t* w1 = W + (size_t)(16 + fr) * 1024 + fq * 8;
        f32x4 a0 = (f32x4){0.f, 0.f, 0.f, 0.f}, a1 = a0;
#pragma unroll 4
        for (int ks = 0; ks < 32; ++ks) {
            const bf16x8 a = *(const bf16x8*)(ar + ks * 32);
            a0 = __builtin_amdgcn_mfma_f32_16x16x32_bf16(a, *(const bf16x8*)(w0 + ks * 32), a0, 0, 0, 0);
            a1 = __builtin_amdgcn_mfma_f32_16x16x32_bf16(a, *(const bf16x8*)(w1 + ks * 32), a1, 0, 0, 0);
        }
#pragma unroll
        for (int r = 0; r < 4; ++r) {
            float* dst = p.hs + (size_t)(u * 16 + fq * 4 + r) * HS_W;
            dst[fr] = a0[r] + bias[fr];
            if (fr < 6) dst[16 + fr] = a1[r] + bias[16 + fr];
        }
    }
}
__device__ __forceinline__ void phase_outproj(const Params& p, int l, const float* xin, char* lds) {
    DenseSched S{(const char*)p.WoT + (size_t)l * 1024 * 1024, 512, NTOK / 256, 4, vcu_id()};
    EpiOutProj E{xin, p.tbuf};
    pg8::gemm_phase<true, 0x7c7c7c7c>((LAS unsigned char*)lds, (const char*)p.ob, 512, S, E);
}
__device__ __forceinline__ void build_tiles(const Params& p, int l, int* ptile, int* ecnt) {
    int tid = threadIdx.x; asm volatile("" : "+v"(tid));
    if (tid < NE) ecnt[tid] = (int)__hip_atomic_load(p.ctrl + 64 + l * NE + tid, __ATOMIC_RELAXED, __HIP_MEMORY_SCOPE_AGENT);
    __syncthreads();
    if (tid == 0) { int s = 0; for (int e = 0; e < NE; ++e) { ptile[e] = s; s += (ecnt[e] + 255) >> 8; } ptile[NE] = s; }
    __syncthreads();
}
__device__ __forceinline__ void phase_gateup(const Params& p, int l, char* lds) {
    int* ptile = (int*)(lds + LDS_TAB); int* ecnt = ptile + 40;
    build_tiles(p, l, ptile, ecnt);
    MoeSched<true> S{(const char*)p.WguT + (size_t)l * NE * 2048 * 1024, p.lists, ptile, ecnt, 8, 2048, vcu_id()};
    EpiGateUp E{p.act, p.bgup + (size_t)l * NE * 2048};
    pg8::gemm_phase<true, 0x7c7c7c7c>((LAS unsigned char*)lds, (const char*)p.x1b, 512, S, E);
}
__device__ __forceinline__ void phase_down(const Params& p, int l, char* lds) {
    int* ptile = (int*)(lds + LDS_TAB); int* ecnt = ptile + 40;
    build_tiles(p, l, ptile, ecnt);
    MoeSched<false> S{(const char*)p.WdnT + (size_t)l * NE * 1024 * 1024, p.lists, ptile, ecnt, 4, 1024, vcu_id()};
    EpiDown E{p.ybuf, p.b_dn + (size_t)l * NE * 1024};
    pg8::gemm_phase<true, 0x7c7c7c7c>((LAS unsigned char*)lds, (const char*)p.act, 512, S, E);
}

__device__ __forceinline__ float gelu_tanh(float x) {
    const float u = 0.7978845608028654f * (x + 0.044715f * x * x * x);
    const float e = __expf(-2.0f * fabsf(u)); const float th = (1.0f - e) / (1.0f + e);
    return 0.5f * x * (1.0f + (u < 0.f ? -th : th));
}
__device__ __forceinline__ void phase_prep(const Params& p, int l, char* lds) {
    int tid = threadIdx.x; asm volatile("" : "+v"(tid));
    const int wid = tid >> 6, lane = tid & 63, fr = lane & 15, fq = lane >> 4;
    const int gw = blockIdx.x * NWV + wid, nw = gridDim.x * NWV;
    for (int u = (int)gridDim.x - 1 - (int)blockIdx.x; u < NB * 4; u += gridDim.x) {
        const int b = u >> 2, h = u & 3;
        const float* srcp = p.hs + ((size_t)b * SEQ + tid * 4) * HS_W + h;
        float ls[4]; float tot = 0.f;
#pragma unroll
        for (int i = 0; i < 4; ++i) { const float f = srcp[(size_t)i * HS_W]; ls[i] = fminf(f, 0.f) - log1pf(__expf(-fabsf(f))); tot += ls[i]; }
        float inc = tot;
#pragma unroll
        for (int o = 1; o < 64; o <<= 1) { const float v = shfl_f(inc, lane - o); if (lane >= o) inc += v; }
        float* wtot = (float*)(lds + 65536);
        if (lane == 63) wtot[wid] = inc;
        __syncthreads();
        float base = inc - tot;
        for (int w = 0; w < wid; ++w) base += wtot[w];
        float4 o4; o4.x = base + ls[0]; o4.y = o4.x + ls[1]; o4.z = o4.y + ls[2]; o4.w = o4.z + ls[3];
        *(float4*)(p.cF + (size_t)u * SEQ + tid * 4) = o4;
        __syncthreads();
    }
    float* part = (float*)lds;
    bf16_t* h1 = (bf16_t*)(lds + 32768);
    for (int u = blockIdx.x; u < NB * 2 * 2 * 8; u += gridDim.x) {
        const int ct = u & 7, which = (u >> 3) & 1, kvh = (u >> 4) & 1, b = u >> 5;
        const int colo = (which ? C_NVC : C_NKC) + kvh * 64;
        const int c_lane = ct * 16 + fr;
        const int tokbase = min(c_lane, 126) * 16;
        const bf16_t* arow = p.hb + ((size_t)b * SEQ + tokbase) * NMAIN + colo + fq * 8;
        const bf16_t* w1 = p.W1T + ((size_t)(l * 2 + which) * 64 + fr) * 2048 + fq * 8;
        f32x4 acc[4];
#pragma unroll
        for (int n = 0; n < 4; ++n) acc[n] = (f32x4){0.f, 0.f, 0.f, 0.f};
#pragma unroll
        for (int kk = 0; kk < 8; ++kk) {
            const int ks = wid * 8 + kk;
            const bf16x8 a = *(const bf16x8*)(arow + (size_t)(ks >> 1) * NMAIN + (ks & 1) * 32);
#pragma unroll
            for (int n = 0; n < 4; ++n) {
                const bf16x8 bb = *(const bf16x8*)(w1 + (size_t)n * 16 * 2048 + ks * 32);
                acc[n] = __builtin_amdgcn_mfma_f32_16x16x32_bf16(a, bb, acc[n], 0, 0, 0);
            }
        }
#pragma unroll
        for (int n = 0; n < 4; ++n)
#pragma unroll
            for (int r = 0; r < 4; ++r) part[wid * 1024 + (fq * 4 + r) * 64 + n * 16 + fr] = acc[n][r];
        __syncthreads();
        const float* b1 = p.b1c + (l * 2 + which) * 64;
#pragma unroll
        for (int i = 0; i < 2; ++i) {
            const int e = tid + NTHR * i; float sum = 0.f;
#pragma unroll
            for (int w = 0; w < 8; ++w) sum += part[w * 1024 + e];
            h1[e] = f2bf(gelu_tanh(sum + b1[e & 63]));
        }
        __syncthreads();
        if (wid == 0) {
            const bf16_t* w2 = p.W2T + ((size_t)(l * 2 + which) * 64 + fr) * 64 + fq * 8;
            f32x4 o2[4];
#pragma unroll
            for (int n = 0; n < 4; ++n) o2[n] = (f32x4){0.f, 0.f, 0.f, 0.f};
#pragma unroll
            for (int ks = 0; ks < 2; ++ks) {
                const bf16x8 a = *(const bf16x8*)(h1 + fr * 64 + ks * 32 + fq * 8);
#pragma unroll
                for (int n = 0; n < 4; ++n) {
                    const bf16x8 bb = *(const bf16x8*)(w2 + (size_t)n * 16 * 64 + ks * 32);
                    o2[n] = __builtin_amdgcn_mfma_f32_16x16x32_bf16(a, bb, o2[n], 0, 0, 0);
                }
            }
            const size_t base = ((size_t)b * 2 + kvh) * 128 * 64;
#pragma unroll
            for (int n = 0; n < 4; ++n)
#pragma unroll
                for (int r = 0; r < 4; ++r) {
                    const int c = ct * 16 + fq * 4 + r, j2 = n * 16 + fr;
                    const bf16_t v = c < 127 ? f2bf(o2[n][r]) : (bf16_t)0;
                    if (which == 0) p.kc[base + (size_t)c * 64 + j2] = v;
                    else { p.vc[base + (size_t)c * 64 + j2] = v; p.vcT[base + (size_t)j2 * 128 + c] = v; }
                }
        }
        __syncthreads();
    }
}

constexpr float L2E = 1.4426950408889634f, MASKV = -__builtin_huge_valf(), MINIT = -1e30f, SCL2 = QSCALE * L2E;
struct KVFrag { bf16x8 k[2][2]; bf16x8 v[4]; };
template <bool FM>
__device__ __forceinline__ void k_load(KVFrag& f, const bf16_t* __restrict__ Kb, size_t ldk, int kc0, int fr, int fq) {
    if (FM) {
        const bf16_t* kp = Kb + (size_t)(kc0 >> 5) * 2048 + (fq * 16 + fr) * 8;
        f.k[0][0] = *(const bf16x8*)(kp); f.k[0][1] = *(const bf16x8*)(kp + 512); f.k[1][0] = *(const bf16x8*)(kp + 1024); f.k[1][1] = *(const bf16x8*)(kp + 1536);
    } else {
        const bf16_t* kp = Kb + (size_t)(kc0 + (fr >> 2) * 8 + (fr & 3)) * ldk + fq * 8;
        f.k[0][0] = *(const bf16x8*)(kp); f.k[0][1] = *(const bf16x8*)(kp + 32);
        f.k[1][0] = *(const bf16x8*)(kp + 4 * ldk); f.k[1][1] = *(const bf16x8*)(kp + 4 * ldk + 32);
    }
}
template <bool FM>
__device__ __forceinline__ void v_load(bf16x8 (&v)[4], const bf16_t* __restrict__ VTb, size_t ldv, int kc0, int fr, int fq) {
    if (FM) {
        const bf16_t* vp = VTb + (size_t)(kc0 >> 5) * 2048 + (fq * 16 + fr) * 8;
#pragma unroll
        for (int dt = 0; dt < 4; ++dt) v[dt] = *(const bf16x8*)(vp + dt * 512);
    } else {
        const bf16_t* vp = VTb + (size_t)fr * ldv + kc0 + fq * 8;
#pragma unroll
        for (int dt = 0; dt < 4; ++dt) v[dt] = *(const bf16x8*)(vp + (size_t)dt * 16 * ldv);
    }
}
__device__ __forceinline__ float rowmax4(float x) {
    auto r = __builtin_amdgcn_permlane32_swap(__float_as_uint(x), __float_as_uint(x), false, false);
    x = fmaxf(__uint_as_float(r[0]), __uint_as_float(r[1]));
    auto q = __builtin_amdgcn_permlane16_swap(__float_as_uint(x), __float_as_uint(x), false, false);
    return fmaxf(__uint_as_float(q[0]), __uint_as_float(q[1]));
}
__device__ __forceinline__ float rowsum4(float x) {
    auto r = __builtin_amdgcn_permlane32_swap(__float_as_uint(x), __float_as_uint(x), false, false);
    x = __uint_as_float(r[0]) + __uint_as_float(r[1]);
    auto q = __builtin_amdgcn_permlane16_swap(__float_as_uint(x), __float_as_uint(x), false, false);
    return __uint_as_float(q[0]) + __uint_as_float(q[1]);
}
template <int NQT, bool MASK, class MB>
__device__ __forceinline__ void attn_compute(const KVFrag& f, const bf16x8 (&qf)[NQT][2], f32x4 (&o)[NQT][4], float (&m)[NQT], float (&l)[NQT], const MB& mb) {
    f32x4 s0[NQT], s1[NQT];
#pragma unroll
    for (int qt = 0; qt < NQT; ++qt) {
        s0[qt] = __builtin_amdgcn_mfma_f32_16x16x32_bf16(f.k[0][0], qf[qt][0], (f32x4){0.f, 0.f, 0.f, 0.f}, 0, 0, 0);
        s1[qt] = __builtin_amdgcn_mfma_f32_16x16x32_bf16(f.k[1][0], qf[qt][0], (f32x4){0.f, 0.f, 0.f, 0.f}, 0, 0, 0);
    }
#pragma unroll
    for (int qt = 0; qt < NQT; ++qt) {
        s0[qt] = __builtin_amdgcn_mfma_f32_16x16x32_bf16(f.k[0][1], qf[qt][1], s0[qt], 0, 0, 0);
        s1[qt] = __builtin_amdgcn_mfma_f32_16x16x32_bf16(f.k[1][1], qf[qt][1], s1[qt], 0, 0, 0);
    }
    float mx[NQT];
#pragma unroll
    for (int qt = 0; qt < NQT; ++qt) {
#pragma unroll
        for (int j = 0; j < 4; ++j) { s0[qt][j] = mb(qt, j, s0[qt][j]); s1[qt][j] = mb(qt, j + 4, s1[qt][j]); }
        mx[qt] = fmaxf(fmaxf(fmaxf(s0[qt][0], s0[qt][1]), fmaxf(s0[qt][2], s0[qt][3])), fmaxf(fmaxf(s1[qt][0], s1[qt][1]), fmaxf(s1[qt][2], s1[qt][3])));
    }
#pragma unroll
    for (int qt = 0; qt < NQT; ++qt) mx[qt] = rowmax4(mx[qt]);
    bool moved = false;
#pragma unroll
    for (int qt = 0; qt < NQT; ++qt) { mx[qt] = fmaxf(m[qt], mx[qt]); moved |= (mx[qt] != m[qt]); }
    if (__ballot(moved) != 0ull) {
#pragma unroll
        for (int qt = 0; qt < NQT; ++qt) {
            const float alpha = __builtin_amdgcn_exp2f(m[qt] - mx[qt]);
            l[qt] *= alpha;
#pragma unroll
            for (int dt = 0; dt < 4; ++dt) o[qt][dt] *= alpha;
        }
    }
    bf16x8 pf[NQT];
#pragma unroll
    for (int qt = 0; qt < NQT; ++qt) {
        m[qt] = mx[qt];
        float pr[8]; float ps = 0.f;
#pragma unroll
        for (int j = 0; j < 4; ++j) {
            pr[j] = __builtin_amdgcn_exp2f(s0[qt][j] - mx[qt]);
            pr[j + 4] = __builtin_amdgcn_exp2f(s1[qt][j] - mx[qt]);
        }
#pragma unroll
        for (int j = 0; j < 8; ++j) ps += pr[j];
        l[qt] += ps;
        const u32x4 pk = {pack2(pr[0], pr[1]), pack2(pr[2], pr[3]), pack2(pr[4], pr[5]), pack2(pr[6], pr[7])};
        pf[qt] = __builtin_bit_cast(bf16x8, pk);
    }
#pragma unroll
    for (int dt = 0; dt < 4; ++dt)
#pragma unroll
        for (int qt = 0; qt < NQT; ++qt) o[qt][dt] = __builtin_amdgcn_mfma_f32_16x16x32_bf16(f.v[dt], pf[qt], o[qt][dt], 0, 0, 0);
    __builtin_amdgcn_sched_barrier(0);
}
struct RangeIt { int c, c_hi; __device__ __forceinline__ int nxt() { if (c > c_hi) return -1; return (c++) * 32; } };
struct MaskIt { unsigned long long cm; __device__ __forceinline__ int nxt() { if (!cm) return -1; const int i = __builtin_ctzll(cm); cm &= cm - 1; return i * 32; } };
template <bool PFV, bool FM, class It, class Gen>
__device__ __forceinline__ void attn_run(It& it, const bf16_t* Kb, size_t ldk, const bf16_t* VTb, size_t ldv, int fr, int fq, const Gen& gen) {
    KVFrag fa, fb;
    int ka = it.nxt(); if (ka < 0) return;
    k_load<FM>(fa, Kb, ldk, ka, fr, fq); if (PFV) v_load<FM>(fa.v, VTb, ldv, ka, fr, fq);
    for (;;) {
        const int kb = it.nxt(); if (kb >= 0) { k_load<FM>(fb, Kb, ldk, kb, fr, fq); if (PFV) v_load<FM>(fb.v, VTb, ldv, kb, fr, fq); }
        if (!PFV) v_load<FM>(fa.v, VTb, ldv, ka, fr, fq);
        gen(ka, fa);
        if (kb < 0) break;
        ka = it.nxt(); if (ka >= 0) { k_load<FM>(fa, Kb, ldk, ka, fr, fq); if (PFV) v_load<FM>(fa.v, VTb, ldv, ka, fr, fq); }
        if (!PFV) v_load<FM>(fb.v, VTb, ldv, kb, fr, fq);
        gen(kb, fb);
        if (ka < 0) break;
    }
}
template <int NQT>
__device__ __forceinline__ void attn_init(f32x4 (&o)[NQT][4], float (&m)[NQT], float (&l)[NQT]) {
#pragma unroll
    for (int qt = 0; qt < NQT; ++qt) { m[qt] = MINIT; l[qt] = 0.f;
#pragma unroll
        for (int dt = 0; dt < 4; ++dt) o[qt][dt] = (f32x4){0.f, 0.f, 0.f, 0.f}; }
}
__device__ __forceinline__ float lsum4(float l) { return rowsum4(l); }
__device__ __forceinline__ void store_o4(unsigned char* dst, const f32x4 v) { *(unsigned*)dst = pack4_fp8(v[0], v[1], v[2], v[3]); }
__device__ __forceinline__ float sigmoidf_fast(float x) { return __builtin_amdgcn_rcpf(1.0f + __builtin_amdgcn_exp2f(-L2E * x)); }

__device__ __forceinline__ void fox_unit(const Params& p, int b, int h, int qb, int fr, int fq) {
    asm volatile("" : "+v"(fr), "+v"(fq));
    const int t0 = qb * 64;
    const bf16_t* Qb = p.hb + ((size_t)b * SEQ + t0) * NMAIN + C_FQ + h * 64 + fq * 8;
    bf16x8 qf[4][2];
#pragma unroll
    for (int qt = 0; qt < 4; ++qt) { qf[qt][0] = *(const bf16x8*)(Qb + (size_t)(qt * 16 + fr) * NMAIN); qf[qt][1] = *(const bf16x8*)(Qb + (size_t)(qt * 16 + fr) * NMAIN + 32); }
    const float* cf = p.cF + ((size_t)b * 4 + h) * SEQ;
    float cq[4];
#pragma unroll
    for (int qt = 0; qt < 4; ++qt) cq[qt] = cf[t0 + qt * 16 + fr] * L2E;
    f32x4 o[4][4]; float m[4], l[4];
    attn_init<4>(o, m, l);
    const bf16_t* Kb = p.kF + ((size_t)b * NVH + h) * 64 * SEQ;
    const bf16_t* VTb = p.vT + ((size_t)b * NVH + h) * 64 * SEQ;
    RangeIt it{0, (t0 >> 5) + 1};
    attn_run<false, true>(it, Kb, NMAIN, VTb, SEQ, fr, fq, [&](int kc0, const KVFrag& f) {
        const float4 ca = *(const float4*)(cf + kc0 + 8 * fq), cb = *(const float4*)(cf + kc0 + 8 * fq + 4);
        const float ck[8] = {ca.x * L2E, ca.y * L2E, ca.z * L2E, ca.w * L2E, cb.x * L2E, cb.y * L2E, cb.z * L2E, cb.w * L2E};
        const int kq = kc0 + 8 * fq - t0 - fr;
        attn_compute<4, true>(f, qf, o, m, l, [&](int qt, int j, float raw) { return (kq + j - 16 * qt) > 0 ? MASKV : raw * SCL2 + cq[qt] - ck[j]; });
    });
#pragma unroll
    for (int qt = 0; qt < 4; ++qt) {
        const float inv = __builtin_amdgcn_rcpf(lsum4(l[qt]));
        unsigned char* dst = (unsigned char*)p.ob + ((size_t)b * SEQ + t0 + qt * 16 + fr) * DM + h * 64 + 4 * fq;
#pragma unroll
        for (int dt = 0; dt < 4; ++dt) store_o4(dst + dt * 16, o[qt][dt] * inv);
    }
}
__device__ __forceinline__ void swa_unit(const Params& p, int l_, int b, int kv, int pos, int fr, int fq) {
    asm volatile("" : "+v"(fr), "+v"(fq));
    const int t0 = pos * 16, t = t0 + fr;
    const bf16_t* Qb = p.hb + ((size_t)b * SEQ + t) * NMAIN + C_SQ + kv * 192 + fq * 8;
    bf16x8 qf[3][2];
#pragma unroll
    for (int g = 0; g < 3; ++g) { qf[g][0] = *(const bf16x8*)(Qb + g * 64); qf[g][1] = *(const bf16x8*)(Qb + g * 64 + 32); }
    float sl[3];
#pragma unroll
    for (int g = 0; g < 3; ++g) sl[g] = slope_swa(kv * 3 + g) * L2E;
    f32x4 o[3][4]; float m[3], l[3];
    attn_init<3>(o, m, l);
    const bf16_t* Kb = p.kF + ((size_t)b * NVH + 4 + kv) * 64 * SEQ;
    const bf16_t* VTb = p.vT + ((size_t)b * NVH + 4 + kv) * 64 * SEQ;
    RangeIt it{max(0, t0 - 127) >> 5, (t0 + 15) >> 5};
    attn_run<true, true>(it, Kb, NMAIN, VTb, SEQ, fr, fq, [&](int kc0, const KVFrag& f) {
        const int dq = t - kc0 - 8 * fq;
        attn_compute<3, true>(f, qf, o, m, l, [&](int g, int j, float raw) { const int dist = dq - j; return ((unsigned)dist < 128u) ? raw * SCL2 - sl[g] * (float)dist : MASKV; });
    });
#pragma unroll
    for (int g = 0; g < 3; ++g) {
        const float sink = p.sinks[l_ * 6 + kv * 3 + g] * L2E;
        const float inv = __builtin_amdgcn_rcpf(lsum4(l[g]) + __builtin_amdgcn_exp2f(sink - m[g]));
        unsigned char* dst = (unsigned char*)p.ob + ((size_t)b * SEQ + t) * DM + 256 + (kv * 3 + g) * 64 + 4 * fq;
#pragma unroll
        for (int dt = 0; dt < 4; ++dt) store_o4(dst + dt * 16, o[g][dt] * inv);
    }
}
__device__ __forceinline__ void nsa_unit(const Params& p, int b, int kv, int pos, int fr, int fq, int lane, float* ps, unsigned* msk, float* otl) {
    asm volatile("" : "+v"(fr), "+v"(fq), "+v"(lane));
    const int t0 = pos * 16, t = t0 + fr, cur = t0 >> 6;
    const bf16_t* Qb = p.hb + ((size_t)b * SEQ + t) * NMAIN + C_NQ + kv * 192 + fq * 8;
    bf16x8 qf[3][2];
#pragma unroll
    for (int g = 0; g < 3; ++g) { qf[g][0] = *(const bf16x8*)(Qb + g * 64); qf[g][1] = *(const bf16x8*)(Qb + g * 64 + 32); }
    float sl[3];
#pragma unroll
    for (int g = 0; g < 3; ++g) sl[g] = slope_nsa(kv * 3 + g) * L2E;
    const float* gl = p.hs + ((size_t)b * SEQ + t) * HS_W + 4 + kv * 9;
    f32x4 o[3][4]; float m[3], l[3];
    f32x4* otv = (f32x4*)otl + lane;
#pragma unroll
    for (int i = 0; i < 8; ++i) ps[lane + 64 * i] = 0.f;
    {
        const bf16_t* Kb = p.kc + ((size_t)b * 2 + kv) * 128 * 64;
        const bf16_t* VTb = p.vcT + ((size_t)b * 2 + kv) * 64 * 128;
        const int ncv = (t0 + 15 >= 31) ? ((t0 + 15 - 31) >> 4) + 1 : 0;
        const int nch = (ncv + 31) >> 5;
        attn_init<3>(o, m, l);
        const int dq0 = t - 31 - 16 * 8 * fq;
        RangeIt it{0, nch - 1};
        attn_run<false, false>(it, Kb, 64, VTb, 128, fr, fq, [&](int kc0, const KVFrag& f) {
            const int dq = dq0 - 16 * kc0;
            attn_compute<3, true>(f, qf, o, m, l, [&](int g, int j, float raw) { const int dist = dq - 16 * j; return dist >= 0 ? raw * SCL2 - sl[g] * (float)dist : MASKV; });
        });
        float il[3];
#pragma unroll
        for (int g = 0; g < 3; ++g) {
            const float lt = lsum4(l[g]); il[g] = lt > 0.f ? __builtin_amdgcn_rcpf(lt) : 0.f;
            const float gate = sigmoidf_fast(gl[g * 3 + 0]);
#pragma unroll
            for (int dt = 0; dt < 4; ++dt) otv[(g * 4 + dt) * 64] = o[g][dt] * (il[g] * gate);
        }
        float carry_prev = 0.f;
        for (int c = 0; c < nch; ++c) {
            const int kc0 = c * 32, dq = dq0 - 16 * kc0;
            const bf16_t* kp = Kb + (size_t)(kc0 + (fr >> 2) * 8 + (fr & 3)) * 64 + fq * 8;
            const bf16x8 k00 = *(const bf16x8*)(kp), k01 = *(const bf16x8*)(kp + 32), k10 = *(const bf16x8*)(kp + 256), k11 = *(const bf16x8*)(kp + 256 + 32);
            float pc[8];
#pragma unroll
            for (int j = 0; j < 8; ++j) pc[j] = 0.f;
#pragma unroll
            for (int g = 0; g < 3; ++g) {
                f32x4 s0 = (f32x4){0.f, 0.f, 0.f, 0.f}, s1 = s0;
                s0 = __builtin_amdgcn_mfma_f32_16x16x32_bf16(k00, qf[g][0], s0, 0, 0, 0); s0 = __builtin_amdgcn_mfma_f32_16x16x32_bf16(k01, qf[g][1], s0, 0, 0, 0);
                s1 = __builtin_amdgcn_mfma_f32_16x16x32_bf16(k10, qf[g][0], s1, 0, 0, 0); s1 = __builtin_amdgcn_mfma_f32_16x16x32_bf16(k11, qf[g][1], s1, 0, 0, 0);
#pragma unroll
                for (int j = 0; j < 8; ++j) {
                    const int dist = dq - 16 * j; const float raw = j < 4 ? s0[j] : s1[j - 4];
                    if (dist >= 0) pc[j] += __builtin_amdgcn_exp2f(raw * SCL2 - sl[g] * (float)dist - m[g]) * il[g];
                }
            }
            const float cout = 0.5f * pc[7];
            float cin = shfl_f(cout, lane - 16);
            const float cwrap = shfl_f(cout, fr + 48);
            if (fq == 0) cin = carry_prev;
            carry_prev = cwrap;
            const int n0 = (kc0 >> 2) + 2 * fq;
            ps[fr * 32 + n0] = cin + pc[0] + pc[1] + pc[2] + 0.5f * pc[3];
            ps[fr * 32 + n0 + 1] = 0.5f * pc[3] + pc[4] + pc[5] + pc[6] + 0.5f * pc[7];
        }
    }
    lds_wave_sync();
    if (lane < 16) {
        unsigned mask = 1u | (1u << cur); if (cur >= 1) mask |= 1u << (cur - 1);
        if (cur >= 3) {
            if (cur - 2 <= 5) mask |= (1u << (cur - 1)) - 2u;
            else {
                const float* my = ps + lane * 32;
                for (int r = 0; r < 5; ++r) {
                    float best = -1.0f; int bi = 1;
                    for (int j = 1; j <= cur - 2; ++j) { const float v = my[j]; if (!((mask >> j) & 1u) && v > best) { best = v; bi = j; } }
                    mask |= 1u << bi;
                }
            }
        }
        msk[lane] = mask;
    }
    lds_wave_sync();
    const unsigned qmask = msk[fr];
    lds_wave_sync();
    {
        const bf16_t* Kb = p.kF + ((size_t)b * NVH + 6 + kv) * 64 * SEQ;
        const bf16_t* VTb = p.vT + ((size_t)b * NVH + 6 + kv) * 64 * SEQ;
        attn_init<3>(o, m, l);
        unsigned um = qmask;
        um |= shfl_u(um, lane ^ 1); um |= shfl_u(um, lane ^ 2); um |= shfl_u(um, lane ^ 4); um |= shfl_u(um, lane ^ 8);
        um = (unsigned)__builtin_amdgcn_readfirstlane((int)um) & (cur >= 31 ? 0xffffffffu : ((2u << cur) - 1u));
        unsigned long long cm = 0ull;
        for (unsigned r = um; r; r &= r - 1) { const int kb = __builtin_ctz(r); cm |= 3ull << (2 * kb); }
        MaskIt it{cm};
        attn_run<true, true>(it, Kb, NMAIN, VTb, SEQ, fr, fq, [&](int kc0, const KVFrag& f) {
            const bool mine = (qmask >> (kc0 >> 6)) & 1u;
            const int dq = t - kc0 - 8 * fq;
            attn_compute<3, true>(f, qf, o, m, l, [&](int g, int j, float raw) { const int dist = dq - j; return (mine && dist >= 0) ? raw * SCL2 - sl[g] * (float)dist : MASKV; });
        });
#pragma unroll
        for (int g = 0; g < 3; ++g) {
            const float lt = lsum4(l[g]); const float sc = (lt > 0.f ? __builtin_amdgcn_rcpf(lt) : 0.f) * sigmoidf_fast(gl[g * 3 + 1]);
#pragma unroll
            for (int dt = 0; dt < 4; ++dt) otv[(g * 4 + dt) * 64] += o[g][dt] * sc;
        }
    }
    {
        const bf16_t* Kb = p.kF + ((size_t)b * NVH + 8 + kv) * 64 * SEQ;
        const bf16_t* VTb = p.vT + ((size_t)b * NVH + 8 + kv) * 64 * SEQ;
        attn_init<3>(o, m, l);
        RangeIt it{max(0, t0 - 511) >> 5, (t0 + 15) >> 5};
        attn_run<true, true>(it, Kb, NMAIN, VTb, SEQ, fr, fq, [&](int kc0, const KVFrag& f) {
            const int dq = t - kc0 - 8 * fq;
            attn_compute<3, true>(f, qf, o, m, l, [&](int g, int j, float raw) { const int dist = dq - j; return ((unsigned)dist < 512u) ? raw * SCL2 - sl[g] * (float)dist : MASKV; });
        });
#pragma unroll
        for (int g = 0; g < 3; ++g) {
            const float lt = lsum4(l[g]); const float sc = (lt > 0.f ? __builtin_amdgcn_rcpf(lt) : 0.f) * sigmoidf_fast(gl[g * 3 + 2]);
            unsigned char* dst = (unsigned char*)p.ob + ((size_t)b * SEQ + t) * DM + 640 + (kv * 3 + g) * 64 + 4 * fq;
#pragma unroll
            for (int dt = 0; dt < 4; ++dt) store_o4(dst + dt * 16, otv[(g * 4 + dt) * 64] + o[g][dt] * sc);
        }
    }
}

template <bool WITH_CONV>
__device__ __forceinline__ void phase_attn(const Params& p, int l, char* lds, int cslot = 16) {
    int tid = threadIdx.x; asm volatile("" : "+v"(tid));
    const int wid = tid >> 6, lane = tid & 63, fr = lane & 15, fq = lane >> 4;
    float* ps = (float*)(lds + wid * 16896); unsigned* msk = (unsigned*)(ps + 512); float* otl = ps + 576;
    unsigned* ctr = p.ctrl + cslot + l;
    constexpr unsigned NU_NSA = NB * 2 * 128, NU_FOX = NB * 4 * 32, NU_SWA = NB * 2 * 128, NU_ATT = NU_NSA + NU_FOX + NU_SWA;
    for (;;) {
        unsigned u = 0;
        if (lane == 0) u = __hip_atomic_fetch_add(ctr, 1u, __ATOMIC_RELAXED, __HIP_MEMORY_SCOPE_AGENT);
        u = (unsigned)__builtin_amdgcn_readfirstlane((int)u);
        if (WITH_CONV) {
            constexpr unsigned TOTQ = NU_ATT + (unsigned)CONV_TILES;
            if (u >= TOTQ) break;
            const unsigned a0 = (unsigned)(((unsigned long long)u * NU_ATT) / TOTQ), a1 = (unsigned)(((unsigned long long)(u + 1) * NU_ATT) / TOTQ);
            if (a1 == a0) { conv_tile_wave(p, (int)(u - a0), lane, (unsigned char*)ps); continue; }
            u = a0;
        } else {
#ifndef ATT_REP
#define ATT_REP 1
#endif
            if (u >= ATT_REP * NU_ATT) break;
            if (ATT_REP > 1) u %= NU_ATT;
        }
        if (u < NU_NSA) { const int pos = 127 - (int)(u & 127), r = u >> 7; nsa_unit(p, r >> 1, r & 1, pos, fr, fq, lane, ps, msk, otl); }
        else if (u < NU_NSA + NU_FOX) { const unsigned v = u - NU_NSA; const int qb = 31 - (int)(v & 31), r = v >> 5; fox_unit(p, r >> 2, r & 3, qb, fr, fq); }
        else { const unsigned v = u - NU_NSA - NU_FOX; const int pos = 127 - (int)(v & 127), r = v >> 7; swa_unit(p, l, r >> 1, r & 1, pos, fr, fq); }
    }
}

__device__ __forceinline__ void phase_ln1_router(const Params& p, int l, char* lds) {
    int tid = threadIdx.x; asm volatile("" : "+v"(tid));
    const int wid = tid >> 6, lane = tid & 63, fr = lane & 15, fq = lane >> 4;
    float* lg = (float*)lds + wid * 512;
    int* lcnt = (int*)(lds + 16384); int* lbase = lcnt + 32;
    const float* g1 = p.ln1_g + l * DM; const float* b1 = p.ln1_b + l * DM;
    const float* rw = p.rwT + (size_t)l * NE * 1024; const float* rb = p.router_b + l * NE;
    unsigned* gcount = p.ctrl + 64 + l * NE;
    for (int grp = blockIdx.x; grp < NTOK / 128; grp += gridDim.x) {
        const int tok0 = grp * 128 + wid * 16;
        if (tid < 32) lcnt[tid] = 0;
        float4 gg[4], bb[4];
#pragma unroll
        for (int j = 0; j < 4; ++j) { gg[j] = *(const float4*)(g1 + j * 256 + lane * 4); bb[j] = *(const float4*)(b1 + j * 256 + lane * 4); }
        for (int r0 = 0; r0 < 16; r0 += 4) {
            float4 v[4][4]; float s[4], qv[4];
#pragma unroll
            for (int i = 0; i < 4; ++i)
#pragma unroll
                for (int j = 0; j < 4; ++j) { const u32x2 w = *(const u32x2*)((const bf16_t*)p.tbuf + (size_t)(tok0 + r0 + i) * DM + j * 256 + lane * 4);
                    v[i][j] = make_float4(__uint_as_float(w.x << 16), __uint_as_float(w.x & 0xffff0000u), __uint_as_float(w.y << 16), __uint_as_float(w.y & 0xffff0000u)); }
#pragma unroll
            for (int i = 0; i < 4; ++i) { s[i] = 0.f;
#pragma unroll
                for (int j = 0; j < 4; ++j) s[i] += (v[i][j].x + v[i][j].y) + (v[i][j].z + v[i][j].w); }
#pragma unroll
            for (int o = 32; o > 0; o >>= 1) {
#pragma unroll
                for (int i = 0; i < 4; ++i) s[i] += shfl_f(s[i], lane ^ o); }
#pragma unroll
            for (int i = 0; i < 4; ++i) { const float mean = s[i] * (1.0f / 1024.0f); qv[i] = 0.f;
#pragma unroll
                for (int j = 0; j < 4; ++j) { v[i][j].x -= mean; v[i][j].y -= mean; v[i][j].z -= mean; v[i][j].w -= mean; qv[i] += (v[i][j].x * v[i][j].x + v[i][j].y * v[i][j].y) + (v[i][j].z * v[i][j].z + v[i][j].w * v[i][j].w); } }
#pragma unroll
            for (int o = 32; o > 0; o >>= 1) {
#pragma unroll
                for (int i = 0; i < 4; ++i) qv[i] += shfl_f(qv[i], lane ^ o); }
#pragma unroll
            for (int i = 0; i < 4; ++i) {
                const float rstd = rsqrtf(qv[i] * (1.0f / 1024.0f) + LN_EPS);
                const size_t row = (size_t)(tok0 + r0 + i);
#pragma unroll
                for (int j = 0; j < 4; ++j) {
                    const int c = j * 256 + lane * 4;
                    float4 y; y.x = v[i][j].x * rstd * gg[j].x + bb[j].x; y.y = v[i][j].y * rstd * gg[j].y + bb[j].y; y.z = v[i][j].z * rstd * gg[j].z + bb[j].z; y.w = v[i][j].w * rstd * gg[j].w + bb[j].w;
                    { u32x2 w; w.x = pack2(y.x, y.y); w.y = pack2(y.z, y.w); *(u32x2*)((bf16_t*)p.x1f + row * DM + c) = w; }
                    *(unsigned*)((char*)p.x1b + row * DM + c) = pack4_fp8(y.x, y.y, y.z, y.w);
                }
            }
        }
        __syncthreads();
        f32x4 a0 = (f32x4){0.f, 0.f, 0.f, 0.f}, a1 = a0;
        const bf16_t* xr = (const bf16_t*)p.x1f + (size_t)(tok0 + fr) * DM + 4 * fq;
        const float* w0 = rw + (size_t)fr * 1024 + 4 * fq; const float* w1 = rw + (size_t)(16 + fr) * 1024 + 4 * fq;
#pragma unroll 4
        for (int k0 = 0; k0 < 1024; k0 += 16) {
            const u32x2 xw = *(const u32x2*)(xr + k0); const float4 wb0 = *(const float4*)(w0 + k0), wb1 = *(const float4*)(w1 + k0);
            const float4 xa = make_float4(__uint_as_float(xw.x << 16), __uint_as_float(xw.x & 0xffff0000u), __uint_as_float(xw.y << 16), __uint_as_float(xw.y & 0xffff0000u));
            a0 = __builtin_amdgcn_mfma_f32_16x16x4f32(xa.x, wb0.x, a0, 0, 0, 0); a1 = __builtin_amdgcn_mfma_f32_16x16x4f32(xa.x, wb1.x, a1, 0, 0, 0);
            a0 = __builtin_amdgcn_mfma_f32_16x16x4f32(xa.y, wb0.y, a0, 0, 0, 0); a1 = __builtin_amdgcn_mfma_f32_16x16x4f32(xa.y, wb1.y, a1, 0, 0, 0);
            a0 = __builtin_amdgcn_mfma_f32_16x16x4f32(xa.z, wb0.z, a0, 0, 0, 0); a1 = __builtin_amdgcn_mfma_f32_16x16x4f32(xa.z, wb1.z, a1, 0, 0, 0);
            a0 = __builtin_amdgcn_mfma_f32_16x16x4f32(xa.w, wb0.w, a0, 0, 0, 0); a1 = __builtin_amdgcn_mfma_f32_16x16x4f32(xa.w, wb1.w, a1, 0, 0, 0);
        }
#pragma unroll
        for (int r = 0; r < 4; ++r) { lg[(fq * 4 + r) * 32 + fr] = a0[r] + rb[fr]; lg[(fq * 4 + r) * 32 + 16 + fr] = a1[r] + rb[16 + fr]; }
        lds_wave_sync();
        int e4[4] = {0, 0, 0, 0}; int rk[4] = {0, 0, 0, 0};
        if (lane < 16) {
            const float* my = lg + lane * 32; unsigned taken = 0u; float tv[4];
#pragma unroll
            for (int k = 0; k < 4; ++k) {
                float best = NEG_INF; int bi = 0;
                for (int e = 0; e < 32; ++e) { const float xv = my[e]; if (!((taken >> e) & 1u) && xv > best) { best = xv; bi = e; } }
                taken |= 1u << bi; e4[k] = bi; tv[k] = best;
            }
            const float e1 = __expf(tv[1] - tv[0]), e2 = __expf(tv[2] - tv[0]), e3 = __expf(tv[3] - tv[0]);
            const float inv = 1.0f / (1.0f + e1 + e2 + e3);
            const size_t row = (size_t)(tok0 + lane);
            *(float4*)(p.gw + row * 4) = make_float4(inv, e1 * inv, e2 * inv, e3 * inv);
        }
        __syncthreads();
        if (lane < 16) {
#pragma unroll
            for (int k = 0; k < 4; ++k) rk[k] = atomicAdd(&lcnt[e4[k]], 1);
        }
        __syncthreads();
        if (tid < 32) { const int c = lcnt[tid]; lbase[tid] = c ? (int)__hip_atomic_fetch_add(gcount + tid, (unsigned)c, __ATOMIC_RELAXED, __HIP_MEMORY_SCOPE_AGENT) : 0; }
        __syncthreads();
        if (lane < 16) {
            const int row = tok0 + lane; int pk[4];
#pragma unroll
            for (int k = 0; k < 4; ++k) { const int pos = lbase[e4[k]] + rk[k]; p.lists[(size_t)e4[k] * LIST_CAP + pos] = row * 4 + k; pk[k] = (pos << 5) | e4[k]; }
            *(int4*)(p.top_e + (size_t)row * 4) = make_int4(pk[0], pk[1], pk[2], pk[3]);
        }
        __syncthreads();
    }
}

__device__ __forceinline__ void phase_ln2(const Params& p, int l, float* xout, char* lds) {
    int* ptile = (int*)(lds + LDS_TAB); int* ecnt = ptile + 40;
    build_tiles(p, l, ptile, ecnt);
    int tid = threadIdx.x; asm volatile("" : "+v"(tid));
    const int wid = tid >> 6, lane = tid & 63;
    const float* g2 = p.ln2_g + l * DM; const float* b2 = p.ln2_b + l * DM;
    float4 gg[4], bb[4];
#pragma unroll
    for (int j = 0; j < 4; ++j) { gg[j] = *(const float4*)(g2 + j * 256 + lane * 4); bb[j] = *(const float4*)(b2 + j * 256 + lane * 4); }
    for (int pr = blockIdx.x * NWV + wid; pr < NTOK / 2; pr += gridDim.x * NWV) {
        float4 v[2][4]; float s[2], qv[2];
        unsigned yv[2][4][4]; float gk[2][4];
#pragma unroll
        for (int i = 0; i < 2; ++i) {
            const int row = pr * 2 + i;
            const float4 gwv = *(const float4*)(p.gw + (size_t)row * 4);
            gk[i][0] = gwv.x; gk[i][1] = gwv.y; gk[i][2] = gwv.z; gk[i][3] = gwv.w;
            const int4 te = *(const int4*)(p.top_e + (size_t)row * 4);
            const int tk[4] = {te.x, te.y, te.z, te.w};
#pragma unroll
            for (int j = 0; j < 4; ++j) { const u32x2 w = *(const u32x2*)((const bf16_t*)p.x1f + (size_t)row * DM + j * 256 + lane * 4);
                v[i][j] = make_float4(__uint_as_float(w.x << 16), __uint_as_float(w.x & 0xffff0000u), __uint_as_float(w.y << 16), __uint_as_float(w.y & 0xffff0000u)); }
#pragma unroll
            for (int k = 0; k < 4; ++k) {
                const unsigned char* yr = (const unsigned char*)p.ybuf + (size_t)(ptile[tk[k] & 31] * 256 + (tk[k] >> 5)) * DM + lane * 4;
#pragma unroll
                for (int j = 0; j < 4; ++j) yv[i][k][j] = *(const unsigned*)(yr + j * 256);
            }
        }
#pragma unroll
        for (int i = 0; i < 2; ++i) { s[i] = 0.f;
#pragma unroll
            for (int j = 0; j < 4; ++j) {
                float4 a; a.x = v[i][j].x * ALPHA; a.y = v[i][j].y * ALPHA; a.z = v[i][j].z * ALPHA; a.w = v[i][j].w * ALPHA;
#pragma unroll
                for (int k = 0; k < 4; ++k) {
                    const unsigned w = yv[i][k][j];
                    const f32x2_t lo = __builtin_amdgcn_cvt_pk_f32_fp8(w, false), hi = __builtin_amdgcn_cvt_pk_f32_fp8(w, true);
                    a.x += gk[i][k] * lo.x; a.y += gk[i][k] * lo.y; a.z += gk[i][k] * hi.x; a.w += gk[i][k] * hi.y;
                }
                v[i][j] = a; s[i] += (a.x + a.y) + (a.z + a.w);
            } }
#pragma unroll
        for (int o = 32; o > 0; o >>= 1) { s[0] += shfl_f(s[0], lane ^ o); s[1] += shfl_f(s[1], lane ^ o); }
#pragma unroll
        for (int i = 0; i < 2; ++i) { const float mean = s[i] * (1.0f / 1024.0f); qv[i] = 0.f;
#pragma unroll
            for (int j = 0; j < 4; ++j) { v[i][j].x -= mean; v[i][j].y -= mean; v[i][j].z -= mean; v[i][j].w -= mean; qv[i] += (v[i][j].x * v[i][j].x + v[i][j].y * v[i][j].y) + (v[i][j].z * v[i][j].z + v[i][j].w * v[i][j].w); } }
#pragma unroll
        for (int o = 32; o > 0; o >>= 1) { qv[0] += shfl_f(qv[0], lane ^ o); qv[1] += shfl_f(qv[1], lane ^ o); }
#pragma unroll
        for (int i = 0; i < 2; ++i) {
            const float rstd = rsqrtf(qv[i] * (1.0f / 1024.0f) + LN_EPS);
            const size_t row = (size_t)(pr * 2 + i);
#pragma unroll
            for (int j = 0; j < 4; ++j) {
                const int c = j * 256 + lane * 4;
                float4 y; y.x = v[i][j].x * rstd * gg[j].x + bb[j].x; y.y = v[i][j].y * rstd * gg[j].y + bb[j].y; y.z = v[i][j].z * rstd * gg[j].z + bb[j].z; y.w = v[i][j].w * rstd * gg[j].w + bb[j].w;
                *(float4*)(xout + row * DM + c) = y;
                if (l + 1 < NL) {
                    u32x2 w; w.x = pack2(y.x, y.y); w.y = pack2(y.z, y.w);
                    *(u32x2*)(p.xb + row * DM + c) = w;
                    *(unsigned*)(p.xq + row * DM + c) = pack4_fp8(y.x, y.y, y.z, y.w);
                }
            }
        }
    }
}

#define XB_TMO      128
#define XB_XCNT(j)  (256  + 64 * (j))
#define XB_XSUB(j)  (1280 + 64 * (j))
#define XB_XGEN(j)  (2304 + 64 * (j))
#define XB_TOP      3328
#define XB_TOPGEN   3392
#define XCD_BAR_WORDS 3456
#define XB_SPIN_CAP (1u << 22)
__device__ __forceinline__ unsigned xb_ld(unsigned* p)              { return __hip_atomic_load(p, __ATOMIC_RELAXED, __HIP_MEMORY_SCOPE_AGENT); }
__device__ __forceinline__ unsigned xb_add(unsigned* p, unsigned v) { return __hip_atomic_fetch_add(p, v, __ATOMIC_RELAXED, __HIP_MEMORY_SCOPE_AGENT); }
__device__ __forceinline__ unsigned xb_xcc_id() { return (unsigned)__builtin_amdgcn_s_getreg((3 << 11) | 20) & 0xFu; }
#define XB_SPIN(cond, bar) do { unsigned _sp = 0; while (cond) { __builtin_amdgcn_s_sleep(1); \
    if ((++_sp & 255u) == 0u) { if (xb_ld(&(bar)[XB_TMO])) break; if (_sp > XB_SPIN_CAP) { atomicAdd(&(bar)[XB_TMO], 1u); break; } } } } while (0)
struct XcdBarrier { unsigned* bar; unsigned x; volatile LAS unsigned* st; };
__device__ __forceinline__ XcdBarrier xcd_barrier_post(unsigned* bar, volatile LAS unsigned* st) {
    XcdBarrier b; b.bar = bar; b.x = xb_xcc_id(); b.st = st;
    if (threadIdx.x == 0) (void)xb_add(&bar[XB_XCNT(b.x)], 1u);
    return b;
}
__device__ __forceinline__ void xcd_barrier_complete(unsigned* bar, unsigned x, unsigned& nloc, unsigned& nx) {
    const unsigned G = gridDim.x * gridDim.y * gridDim.z;
    unsigned sum, cnt, mine, sp = 0u;
    for (;;) {
        sum = 0u; cnt = 0u; mine = 0u;
#pragma unroll
        for (unsigned j = 0; j < 16; ++j) { const unsigned c = xb_ld(&bar[XB_XCNT(j)]); sum += c; cnt += (c > 0u) ? 1u : 0u; mine = (j == x) ? c : mine; }
        if (sum == G) break;
        __builtin_amdgcn_s_sleep(1);
        if ((++sp & 255u) == 0u) { if (xb_ld(&bar[XB_TMO])) break; if (sp > XB_SPIN_CAP) { atomicAdd(&bar[XB_TMO], 1u); break; } }
    }
    nloc = mine > 0u ? mine : 1u; nx = cnt > 0u ? cnt : 1u;
}
__device__ __forceinline__ void xcd_barrier(const XcdBarrier& b) {
    asm volatile("s_waitcnt vmcnt(0)" ::: "memory");
    __syncthreads();
    if (threadIdx.x == 0) {
        unsigned* bar = b.bar;
        __builtin_amdgcn_s_waitcnt(0);
        unsigned nloc = b.st[0], nx = b.st[1];
        if (nloc == 0u) { xcd_barrier_complete(bar, b.x, nloc, nx); b.st[0] = nloc; b.st[1] = nx; }
        const unsigned old = xb_add(&bar[XB_XSUB(b.x)], 1u);
        const unsigned gen = old / nloc;
        if (old + 1u == (gen + 1u) * nloc) {
            __builtin_amdgcn_fence(__ATOMIC_RELEASE, "agent");
            asm volatile("s_waitcnt vmcnt(0)" ::: "memory");
            const unsigned og = xb_add(&bar[XB_TOP], 1u);
            const unsigned tg = og / nx;
            if (og + 1u == (tg + 1u) * nx) xb_add(&bar[XB_TOPGEN], 1u);
            else XB_SPIN(xb_ld(&bar[XB_TOPGEN]) == tg, bar);
            __builtin_amdgcn_fence(__ATOMIC_ACQUIRE, "agent");
            xb_add(&bar[XB_XGEN(b.x)], 1u);
            asm volatile("s_waitcnt vmcnt(0)" ::: "memory");
        } else {
            XB_SPIN(xb_ld(&bar[XB_XGEN(b.x)]) == gen, bar);
            __builtin_amdgcn_fence(__ATOMIC_ACQUIRE, "agent");
            asm volatile("s_waitcnt vmcnt(0)" ::: "memory");
        }
    }
    __syncthreads();
}

struct KArgs { const float* in[18]; float* out; char* ws; };
constexpr size_t al256(size_t v) { return (v + 255) / 256 * 256; }
struct WSL {
    static constexpr size_t ctrl = 0;
    static constexpr size_t WinT = al256(ctrl + 65536);
    static constexpr size_t WoT = al256(WinT + (size_t)NL * NPAD * 1024 * 2);
    static constexpr size_t W1T = al256(WoT + (size_t)NL * 1024 * 1024 * 2);
    static constexpr size_t W2T = al256(W1T + (size_t)NL * 2 * 64 * 2048 * 2);
    static constexpr size_t WguT = al256(W2T + (size_t)NL * 2 * 64 * 64 * 2);
    static constexpr size_t WdnT = al256(WguT + (size_t)NL * NE * 2048 * 1024 * 2);
    static constexpr size_t rwT = al256(WdnT + (size_t)NL * NE * 1024 * 1024 * 2);
    static constexpr size_t binp = al256(rwT + (size_t)NL * NE * 1024 * 4);
    static constexpr size_t bgup = al256(binp + (size_t)NL * NPAD * 4);
    static constexpr size_t b1c = al256(bgup + (size_t)NL * NE * 2048 * 4);
    static constexpr size_t xf = al256(b1c + 4 * 64 * 4);
    static constexpr size_t xb = al256(xf + (size_t)NTOK * DM * 4);
    static constexpr size_t hb = al256(xb + (size_t)NTOK * DM * 2);
    static constexpr size_t hs = al256(hb + (size_t)NTOK * NMAIN * 2);
    static constexpr size_t vT = al256(hs + (size_t)NTOK * HS_W * 4);
    static constexpr size_t kF = al256(vT + (size_t)NB * NVH * 64 * SEQ * 2);
    static constexpr size_t cF = al256(kF + (size_t)NB * NVH * 64 * SEQ * 2);
    static constexpr size_t kc = al256(cF + (size_t)NB * 4 * SEQ * 4);
    static constexpr size_t vc = al256(kc + (size_t)NB * 2 * 128 * 64 * 2);
    static constexpr size_t vcT = al256(vc + (size_t)NB * 2 * 128 * 64 * 2);
    static constexpr size_t ob = al256(vcT + (size_t)NB * 2 * 128 * 64 * 2);
    static constexpr size_t tbuf = al256(ob + (size_t)NTOK * DM * 2);
    static constexpr size_t x1f = al256(tbuf + (size_t)NTOK * DM * 4);
    static constexpr size_t x1b = al256(x1f + (size_t)NTOK * DM * 4);
    static constexpr size_t top_e = al256(x1b + (size_t)NTOK * DM * 2);
    static constexpr size_t gw = al256(top_e + (size_t)NTOK * 4 * 4);
    static constexpr size_t lists = al256(gw + (size_t)NTOK * 4 * 4);
    static constexpr size_t act = al256(lists + (size_t)NE * LIST_CAP * 4);
    static constexpr size_t ybuf = al256(act + (size_t)MAXSLOT * DFF * 2);
    static constexpr size_t xq = al256(ybuf + (size_t)MAXSLOT * DM * 2);
    static constexpr size_t WinQ = al256(xq + (size_t)NTOK * DM);
    static constexpr size_t total = al256(WinQ + (size_t)NL * NMAIN * 1024);
};
__device__ __forceinline__ Params make_params(const KArgs& k) {
    Params p;
    p.x = k.in[0]; p.w_in = k.in[1]; p.b_in = k.in[2]; p.sinks = k.in[3]; p.cmp_pe = k.in[4]; p.cmp_w1 = k.in[5]; p.cmp_w2 = k.in[6]; p.w_out = k.in[7];
    p.ln1_g = k.in[8]; p.ln1_b = k.in[9]; p.router_w = k.in[10]; p.router_b = k.in[11]; p.w_gu = k.in[12]; p.b_gu = k.in[13]; p.w_dn = k.in[14]; p.b_dn = k.in[15];
    p.ln2_g = k.in[16]; p.ln2_b = k.in[17]; p.out = k.out;
    char* w = k.ws;
    p.ctrl = (unsigned*)(w + WSL::ctrl); p.WinT = (bf16_t*)(w + WSL::WinT); p.WoT = (bf16_t*)(w + WSL::WoT); p.W1T = (bf16_t*)(w + WSL::W1T); p.W2T = (bf16_t*)(w + WSL::W2T);
    p.WguT = (bf16_t*)(w + WSL::WguT); p.WdnT = (bf16_t*)(w + WSL::WdnT); p.rwT = (float*)(w + WSL::rwT); p.binp = (float*)(w + WSL::binp); p.bgup = (float*)(w + WSL::bgup);
    p.b1c = (float*)(w + WSL::b1c); p.xf = (float*)(w + WSL::xf); p.xb = (bf16_t*)(w + WSL::xb); p.hb = (bf16_t*)(w + WSL::hb); p.hs = (float*)(w + WSL::hs); p.vT = (bf16_t*)(w + WSL::vT); p.kF = (bf16_t*)(w + WSL::kF);
    p.cF = (float*)(w + WSL::cF); p.kc = (bf16_t*)(w + WSL::kc); p.vc = (bf16_t*)(w + WSL::vc); p.vcT = (bf16_t*)(w + WSL::vcT); p.ob = (bf16_t*)(w + WSL::ob); p.tbuf = (float*)(w + WSL::tbuf);
    p.x1f = (float*)(w + WSL::x1f); p.x1b = (bf16_t*)(w + WSL::x1b); p.top_e = (int*)(w + WSL::top_e); p.gw = (float*)(w + WSL::gw); p.lists = (int*)(w + WSL::lists);
    p.act = (bf16_t*)(w + WSL::act); p.ybuf = (bf16_t*)(w + WSL::ybuf); p.xq = (unsigned char*)(w + WSL::xq); p.WinQ = (unsigned char*)(w + WSL::WinQ);
    return p;
}
__device__ __forceinline__ void grid_bar(const Params& p, char* lds) {
    XcdBarrier xb; xb.bar = p.ctrl + 1024; xb.x = xb_xcc_id(); xb.st = (volatile LAS unsigned*)(lds + LDS_BYTES - 16); xcd_barrier(xb);
}
__device__ __forceinline__ Params fresh_params(const KArgs& ka) {
    KArgs k2 = ka; size_t z = 0; asm volatile("" : "+s"(z));
    k2.ws = ka.ws + z;
    return make_params(k2);
}
#ifndef REP
#define REP 0
#endif
template <int L>
__device__ __forceinline__ void layer_fwd(const KArgs& ka, char* lds) {
    { const Params p = fresh_params(ka); phase_inproj(p, L, lds);        grid_bar(p, lds); }
    { const Params p = fresh_params(ka); phase_prep(p, L, lds);          grid_bar(p, lds); }
    { const Params p = fresh_params(ka); phase_attn<L == 0>(p, L, lds);  grid_bar(p, lds); }
    { const Params p = fresh_params(ka); phase_outproj(p, L, L == 0 ? p.x : p.xf, lds);  grid_bar(p, lds); }
    { const Params p = fresh_params(ka); phase_ln1_router(p, L, lds);    grid_bar(p, lds); }
    { const Params p = fresh_params(ka); phase_gateup(p, L, lds);        grid_bar(p, lds); }
    { const Params p = fresh_params(ka); phase_down(p, L, lds);          grid_bar(p, lds); }
    { const Params p = fresh_params(ka); phase_ln2(p, L, L == NL - 1 ? p.out : p.xf, lds); }
}
__global__ void __launch_bounds__(NTHR, 2) fwd_kernel(KArgs ka) {
    extern __shared__ __attribute__((aligned(16))) char lds[];
    const Params p = make_params(ka);
    cg::grid_group grid = cg::this_grid();
    volatile LAS unsigned* xst = (volatile LAS unsigned*)(lds + LDS_BYTES - 16);
    if (threadIdx.x == 0) { xst[0] = 0u; xst[1] = 0u; }
    __syncthreads();
    (void)xcd_barrier_post(p.ctrl + 1024, xst);
    volatile LAS int* vcu = (volatile LAS int*)(lds + LDS_BYTES - 32);
    const unsigned myx = xb_xcc_id() & 7u;
    if (threadIdx.x == 0) vcu[1] = (int)__hip_atomic_fetch_add(p.ctrl + 32 + myx, 1u, __ATOMIC_RELAXED, __HIP_MEMORY_SCOPE_AGENT);
    phase0(p, lds);
    grid.sync();
    if (threadIdx.x == 0) {
        int base = 0, tot = 0;
        for (unsigned x = 0; x < 8; ++x) { const int n = (int)__hip_atomic_load(p.ctrl + 32 + x, __ATOMIC_RELAXED, __HIP_MEMORY_SCOPE_AGENT); if (x < myx) base += n; tot += n; }
        vcu[0] = (tot == (int)gridDim.x) ? base + vcu[1] : (int)blockIdx.x;
    }
    __syncthreads();
    layer_fwd<0>(ka, lds);
    grid_bar(p, lds);
    layer_fwd<1>(ka, lds);
}

extern "C" void kernel_launch(void* const* d_in, const int* in_sizes, int n_in, void* d_out, int out_size, void* d_ws, size_t ws_size, hipStream_t stream) {
    KArgs ka{};
    for (int i = 0; i < 18; ++i) ka.in[i] = (const float*)d_in[i];
    ka.out = (float*)d_out; ka.ws = (char*)d_ws;
    if (WSL::total > ws_size) { fprintf(stderr, "workspace too small: need %zu have %zu\n", (size_t)WSL::total, ws_size); return; }
    static int grid_blocks = 0;
    if (!grid_blocks) {
        int dev = 0, cus = 0, per_cu = 0;
        (void)hipGetDevice(&dev);
        (void)hipDeviceGetAttribute(&cus, hipDeviceAttributeMultiprocessorCount, dev);
        (void)hipFuncSetAttribute((const void*)fwd_kernel, hipFuncAttributeMaxDynamicSharedMemorySize, LDS_BYTES);
        (void)hipOccupancyMaxActiveBlocksPerMultiprocessor(&per_cu, fwd_kernel, NTHR, LDS_BYTES);
        if (per_cu < 1) { fprintf(stderr, "occupancy query says 0 blocks per CU\n"); per_cu = 1; }
        grid_blocks = cus;
    }
    (void)hipMemsetAsync(d_ws, 0, 65536, stream);
    void* args[] = {&ka};
    hipError_t e = hipLaunchCooperativeKernel((const void*)fwd_kernel, dim3(grid_blocks), dim3(NTHR), args, LDS_BYTES, stream);
    if (e != hipSuccess) fprintf(stderr, "cooperative launch failed: %s (grid %d)\n", hipGetErrorString(e), grid_blocks);
}
```

```cpp
#include <hip/hip_runtime.h>
#include <hip/hip_cooperative_groups.h>
#include <cstdio>
#include <cstdint>
namespace cg = cooperative_groups;

typedef unsigned short bf16_t;
typedef short bf16x8 __attribute__((ext_vector_type(8)));
typedef float f32x4 __attribute__((ext_vector_type(4)));
typedef unsigned u32x4 __attribute__((ext_vector_type(4)));
typedef unsigned u32x2 __attribute__((ext_vector_type(2)));
typedef int v8i_t __attribute__((ext_vector_type(8)));
typedef float f32x2_t __attribute__((ext_vector_type(2)));
typedef int v4i_t __attribute__((ext_vector_type(4)));
#define LAS __attribute__((address_space(3)))
constexpr float NEG_INF = -__builtin_huge_valf();

constexpr int DM = 1024, NB = 16, SEQ = 2048, NTOK = NB * SEQ, NL = 2;
constexpr int NCOL = 2582, NMAIN = 2560, NPAD = 2688, NE = 32, DFF = 1024;
constexpr int C_FQ = 0, C_FK = 256, C_FV = 512, C_SQ = 768, C_SK = 1152, C_SV = 1280, C_NQ = 1408,
              C_NKC = 1792, C_NVC = 1920, C_NKS = 2048, C_NVS = 2176, C_NKW = 2304, C_NVW = 2432;
constexpr int HS_W = 32;
constexpr int NVH = 10;
constexpr int LIST_CAP = NTOK;
constexpr int MAXSLOT = NTOK * 4 + NE * 256;
constexpr float ALPHA = 1.41421356237f, LN_EPS = 1e-5f, QSCALE = 0.125f;
constexpr int NWV = 8, NTHR = NWV * 64;
constexpr int LDS_STAGE = 131072, LDS_TAB = LDS_STAGE, LDS_AOFF = LDS_STAGE + 2048, LDS_BYTES = LDS_AOFF + 20480 + 256;

struct Params {
    const float *x, *w_in, *b_in, *sinks, *cmp_pe, *cmp_w1, *cmp_w2, *w_out, *ln1_g, *ln1_b, *router_w, *router_b,
                *w_gu, *b_gu, *w_dn, *b_dn, *ln2_g, *ln2_b;
    float* out;
    unsigned* ctrl;
    bf16_t *WinT, *WoT, *W1T, *W2T, *WguT, *WdnT;
    float *rwT, *binp, *bgup, *b1c;
    unsigned char* xq; unsigned char* WinQ;
    float* xf; bf16_t* xb; bf16_t* hb; float* hs; bf16_t* vT; bf16_t* kF; float* cF;
    bf16_t *kc, *vc, *vcT; bf16_t* ob; float* tbuf; float* x1f; bf16_t* x1b;
    int* top_e; float* gw; int* lists; bf16_t* act; bf16_t* ybuf;
};

__device__ __forceinline__ float bf2f(bf16_t h) { return __uint_as_float(((unsigned)h) << 16); }
typedef __bf16 bf16x2_t __attribute__((ext_vector_type(2)));
__device__ __forceinline__ bf16_t f2bf(float f) { return __builtin_bit_cast(bf16_t, (__bf16)f); }
__device__ __forceinline__ unsigned pack2(float lo, float hi) { bf16x2_t v = {(__bf16)lo, (__bf16)hi}; return __builtin_bit_cast(unsigned, v); }
__device__ __forceinline__ unsigned pack4_fp8(float a, float b, float c, float d) {
    unsigned w = 0u;
    w = __builtin_amdgcn_cvt_pk_fp8_f32(a, b, w, false);
    w = __builtin_amdgcn_cvt_pk_fp8_f32(c, d, w, true);
    return w;
}
__device__ __forceinline__ float shfl_f(float v, int src_lane) { return __int_as_float(__builtin_amdgcn_ds_bpermute(src_lane << 2, __float_as_int(v))); }
__device__ __forceinline__ unsigned shfl_u(unsigned v, int src_lane) { return (unsigned)__builtin_amdgcn_ds_bpermute(src_lane << 2, (int)v); }
__device__ __forceinline__ float wave_sum(float v) {
#pragma unroll
    for (int o = 32; o > 0; o >>= 1) v += __shfl_xor(v, o);
    return v;
}
__device__ __forceinline__ float wave_max(float v) {
#pragma unroll
    for (int o = 32; o > 0; o >>= 1) v = fmaxf(v, __shfl_xor(v, o));
    return v;
}
__device__ __forceinline__ void lds_wave_sync() { asm volatile("s_waitcnt lgkmcnt(0)" ::: "memory"); __builtin_amdgcn_wave_barrier(); }
__device__ __forceinline__ float slope_swa(int hq) { return exp2f(-8.0f * (float)(2 * hq + 1) / 12.0f); }
__device__ __forceinline__ float slope_nsa(int hq) { return exp2f(-8.0f * (float)(2 * hq + 2) / 12.0f); }

__device__ __forceinline__ int perm_row(int perm, int n) {
    if (perm == 1) { if (n < 768) return n; if (n < 772) return 2560 + (n - 768); if (n < 2564) return n - 4; return n; }
    if (perm == 2) { const int f = n >> 1, s = n & 1; return (f >> 7) * 256 + s * 128 + (f & 127); }
    return n;
}
struct ConvJob { const float* src; bf16_t* dst; int K, N, kt, nt, perm; float q8; };
__device__ __forceinline__ bool conv_job(const Params& p, int t, ConvJob& jb) {
    constexpr int T_WIN = NL * 8 * 21, T_WO = NL * 8 * 8;
    if (t < T_WIN) { const int m = t / 168, r = t % 168; jb = ConvJob{p.w_in + (size_t)m * 1024 * NCOL, p.WinT + (size_t)m * NPAD * 1024, 1024, NCOL, r / 21, r % 21, 1, 0.f}; return true; }
    t -= T_WIN;
    if (t < T_WO) { const int m = t / 64, r = t % 64; jb = ConvJob{p.w_out + (size_t)m * 1024 * 1024, (bf16_t*)((char*)p.WoT + (size_t)m * 1024 * 1024), 1024, 1024, r / 8, r % 8, 0, 64.0f}; return true; }
    t -= T_WO;
    if (t < T_WIN) { const int m = t / 168, r = t % 168; jb = ConvJob{p.w_in + (size_t)m * 1024 * NCOL, (bf16_t*)(p.WinQ + (size_t)m * NMAIN * 1024), 1024, NCOL, r / 21, r % 21, 1, 64.0f}; return true; }
    return false;
}
constexpr int CONV_TILES = NL * NE * 192;
__device__ __forceinline__ void conv_tile_wave(const Params& p, int t, int lane, unsigned char* l8) {
    asm volatile("" : "+v"(lane));
    const int m = t / 192, r = t % 192;
    const float* src; unsigned char* dst; int N, kt, nt, perm;
    if (r < 128) { src = p.w_gu + (size_t)m * 1024 * 2048; dst = (unsigned char*)p.WguT + (size_t)m * 2048 * 1024; N = 2048; kt = r >> 4; nt = r & 15; perm = 2; }
    else { const int q = r - 128; src = p.w_dn + (size_t)m * 1024 * 1024; dst = (unsigned char*)p.WdnT + (size_t)m * 1024 * 1024; N = 1024; kt = q >> 3; nt = q & 7; perm = 0; }
    const float* s = src + (size_t)(kt * 128 + (lane >> 5)) * N + nt * 128 + (lane & 31) * 4;
    unsigned char* lw = l8 + (lane >> 5) * 132 + (lane & 31) * 4;
    float4 va[16], vb[16];
#pragma unroll
    for (int i = 0; i < 16; ++i) va[i] = *(const float4*)(s + (size_t)(2 * i) * N);
#pragma unroll
    for (int i = 0; i < 16; ++i) vb[i] = *(const float4*)(s + (size_t)(32 + 2 * i) * N);
#pragma unroll
    for (int i = 0; i < 16; ++i) *(unsigned*)(lw + (2 * i) * 132) = pack4_fp8(va[i].x * 64.0f, va[i].y * 64.0f, va[i].z * 64.0f, va[i].w * 64.0f);
#pragma unroll
    for (int i = 0; i < 16; ++i) va[i] = *(const float4*)(s + (size_t)(64 + 2 * i) * N);
#pragma unroll
    for (int i = 0; i < 16; ++i) *(unsigned*)(lw + (32 + 2 * i) * 132) = pack4_fp8(vb[i].x * 64.0f, vb[i].y * 64.0f, vb[i].z * 64.0f, vb[i].w * 64.0f);
#pragma unroll
    for (int i = 0; i < 16; ++i) vb[i] = *(const float4*)(s + (size_t)(96 + 2 * i) * N);
#pragma unroll
    for (int i = 0; i < 16; ++i) *(unsigned*)(lw + (64 + 2 * i) * 132) = pack4_fp8(va[i].x * 64.0f, va[i].y * 64.0f, va[i].z * 64.0f, va[i].w * 64.0f);
#pragma unroll
    for (int i = 0; i < 16; ++i) *(unsigned*)(lw + (96 + 2 * i) * 132) = pack4_fp8(vb[i].x * 64.0f, vb[i].y * 64.0f, vb[i].z * 64.0f, vb[i].w * 64.0f);
    lds_wave_sync();
#pragma unroll 4
    for (int i = 0; i < 16; ++i) {
        const int idx = lane + 64 * i, kc = idx & 7, nn = idx >> 3;
        const unsigned char* l = l8 + (kc * 16) * 132 + nn;
        u32x4 w;
        w.x = (unsigned)l[0] | ((unsigned)l[132] << 8) | ((unsigned)l[264] << 16) | ((unsigned)l[396] << 24);
        w.y = (unsigned)l[528] | ((unsigned)l[660] << 8) | ((unsigned)l[792] << 16) | ((unsigned)l[924] << 24);
        w.z = (unsigned)l[1056] | ((unsigned)l[1188] << 8) | ((unsigned)l[1320] << 16) | ((unsigned)l[1452] << 24);
        w.w = (unsigned)l[1584] | ((unsigned)l[1716] << 8) | ((unsigned)l[1848] << 16) | ((unsigned)l[1980] << 24);
        *(u32x4*)(dst + (size_t)perm_row(perm, nt * 128 + nn) * 1024 + kt * 128 + kc * 16) = w;
    }
    lds_wave_sync();
}
__device__ __forceinline__ void conv_load(const ConvJob& jb, int tid, float2 (&v)[16]) {
    const int n = jb.nt * 128 + (tid & 31) * 4;
    const float* s = jb.src + (size_t)(jb.kt * 128 + (tid >> 5)) * jb.N + n;
#pragma unroll
    for (int i = 0; i < 8; ++i) {
        const float* r = s + (size_t)(16 * i) * jb.N;
        v[2 * i] = (n + 1 < jb.N) ? *(const float2*)r : make_float2(0.f, 0.f);
        v[2 * i + 1] = (n + 3 < jb.N) ? *(const float2*)(r + 2) : make_float2(0.f, 0.f);
    }
}
__device__ __forceinline__ void phase0(const Params& p, char* ldsc) {
    int tid = threadIdx.x; asm volatile("" : "+v"(tid));
    const int G = gridDim.x, bid = blockIdx.x;
    const size_t gtid = (size_t)bid * NTHR + tid, gthreads = (size_t)G * NTHR;
    {
        constexpr int TOT = 2 * NL * 8 * 21 + NL * 8 * 8;
        bf16_t* lt = (bf16_t*)ldsc;
        ConvJob jb, jn; float2 v[16], vn[16];
        int t = bid; bool have = t < TOT && conv_job(p, t, jb);
        if (have) conv_load(jb, tid, v);
        while (have) {
            const int tn = t + G; const bool hn = tn < TOT && conv_job(p, tn, jn);
            if (hn) conv_load(jn, tid, vn);
            if (jb.q8 != 0.f) {
                unsigned char* l8 = (unsigned char*)lt;
#pragma unroll
                for (int i = 0; i < 8; ++i)
                    *(unsigned*)(l8 + ((tid >> 5) + 16 * i) * 132 + (tid & 31) * 4) = pack4_fp8(v[2 * i].x * jb.q8, v[2 * i].y * jb.q8, v[2 * i + 1].x * jb.q8, v[2 * i + 1].y * jb.q8);
                __syncthreads();
#pragma unroll
                for (int i = 0; i < 2; ++i) {
                    const int idx = tid + NTHR * i, kc = idx & 7, nn = idx >> 3, n = jb.nt * 128 + nn;
                    const unsigned char* l = l8 + (kc * 16) * 132 + nn;
                    u32x4 w;
                    w.x = (unsigned)l[0] | ((unsigned)l[132] << 8) | ((unsigned)l[264] << 16) | ((unsigned)l[396] << 24);
                    w.y = (unsigned)l[528] | ((unsigned)l[660] << 8) | ((unsigned)l[792] << 16) | ((unsigned)l[924] << 24);
                    w.z = (unsigned)l[1056] | ((unsigned)l[1188] << 8) | ((unsigned)l[1320] << 16) | ((unsigned)l[1452] << 24);
                    w.w = (unsigned)l[1584] | ((unsigned)l[1716] << 8) | ((unsigned)l[1848] << 16) | ((unsigned)l[1980] << 24);
                    const int pr = perm_row(jb.perm, n);
                    if (n < jb.N && !(jb.perm == 1 && pr >= NMAIN)) *(u32x4*)((char*)jb.dst + (size_t)pr * jb.K + jb.kt * 128 + kc * 16) = w;
                }
            } else {
#pragma unroll
                for (int i = 0; i < 8; ++i) {
                    u32x2 w; w.x = pack2(v[2 * i].x, v[2 * i].y); w.y = pack2(v[2 * i + 1].x, v[2 * i + 1].y);
                    *(u32x2*)(lt + ((tid >> 5) + 16 * i) * 136 + (tid & 31) * 4) = w;
                }
                __syncthreads();
#pragma unroll
                for (int i = 0; i < 4; ++i) {
                    const int idx = tid + NTHR * i, kc = idx & 15, nn = idx >> 4, n = jb.nt * 128 + nn;
                    if (n < jb.N) {
                        const bf16_t* l = lt + (kc * 8) * 136 + nn;
                        u32x4 w;
                        w.x = (unsigned)l[0] | ((unsigned)l[136] << 16); w.y = (unsigned)l[272] | ((unsigned)l[408] << 16);
                        w.z = (unsigned)l[544] | ((unsigned)l[680] << 16); w.w = (unsigned)l[816] | ((unsigned)l[952] << 16);
                        *(u32x4*)(jb.dst + (size_t)perm_row(jb.perm, n) * jb.K + jb.kt * 128 + kc * 8) = w;
                    }
                }
            }
            __syncthreads();
            t = tn; have = hn; jb = jn;
#pragma unroll
            for (int i = 0; i < 16; ++i) v[i] = vn[i];
        }
    }
    for (size_t i = gtid; i < (size_t)NL * 2 * 2048 * 64; i += gthreads) {
        const int k = (int)(i % 2048), n = (int)((i / 2048) % 64), m = (int)(i / (2048 * 64));
        p.W1T[i] = f2bf(p.cmp_w1[((size_t)m * 2048 + k) * 64 + n]);
    }
    for (size_t i = gtid; i < (size_t)NL * 2 * 64 * 64; i += gthreads) {
        const int k = (int)(i % 64), n = (int)((i / 64) % 64), m = (int)(i / 4096);
        p.W2T[i] = f2bf(p.cmp_w2[((size_t)m * 64 + k) * 64 + n]);
    }
    for (size_t i = gtid; i < (size_t)NL * NPAD; i += gthreads) {
        const int l = (int)(i / NPAD), r = (int)(i % NPAD);
        float v = 0.f;
        if (r < 2560) { const int n = r < 768 ? r : r + 4; v = p.b_in[l * NCOL + n]; }
        else if (r < 2564) v = p.b_in[l * NCOL + 768 + (r - 2560)];
        else if (r < 2582) v = p.b_in[l * NCOL + r];
        p.binp[i] = v;
    }
    for (size_t i = gtid; i < (size_t)NL * NE * 2048; i += gthreads) {
        const int r = (int)(i % 2048); const size_t le = i / 2048;
        const int s = (r >> 7) & 1, f = (r >> 8) * 128 + (r & 127);
        p.bgup[i] = p.b_gu[le * 2048 + 2 * f + s];
    }
    for (size_t i = gtid; i < (size_t)NL * NE * 1024; i += gthreads) {
        const int k = (int)(i % 1024), e = (int)((i / 1024) % NE), l = (int)(i / (1024 * NE));
        p.rwT[i] = p.router_w[((size_t)l * 1024 + k) * NE + e];
    }
    for (size_t i = gtid; i < (size_t)NL * (NPAD - NCOL) * 1024; i += gthreads) {
        const int l = (int)(i / ((NPAD - NCOL) * 1024)); const size_t r = i % ((size_t)(NPAD - NCOL) * 1024);
        p.WinT[(size_t)l * NPAD * 1024 + (size_t)NCOL * 1024 + r] = 0;
    }
    for (size_t i = gtid; i < (size_t)NTOK * DM / 4; i += gthreads) {
        const float4 v4 = ((const float4*)p.x)[i];
        u32x2 w; w.x = pack2(v4.x, v4.y); w.y = pack2(v4.z, v4.w);
        ((u32x2*)p.xb)[i] = w;
        ((unsigned*)p.xq)[i] = pack4_fp8(v4.x, v4.y, v4.z, v4.w);
    }
    if (bid < 4) {
        float* lf = (float*)ldsc;
        const int j = tid & 63, part = tid >> 6;
        const float* pe = p.cmp_pe + (size_t)bid * 2048; const float* w1 = p.cmp_w1 + (size_t)bid * 2048 * 64;
        float s = 0.f;
        for (int kk = part * 256; kk < part * 256 + 256; ++kk) s += pe[kk] * w1[(size_t)kk * 64 + j];
        lf[tid] = s; __syncthreads();
        if (tid < 64) { float a = 0.f; for (int q = 0; q < 8; ++q) a += lf[tid + 64 * q]; p.b1c[bid * 64 + tid] = a; }
        __syncthreads();
    }
}

__device__ __forceinline__ int vcu_id() { return __builtin_amdgcn_readfirstlane(*(const volatile LAS int*)(LDS_BYTES - 32)); }
namespace pg8 {
constexpr int BM = 256, BK = 64, HALF = 128, HTB = HALF * BK * 2, NXCD = 8, WGM = 8;
__device__ __forceinline__ int lds_byte(int r, int c) { const int st = (r >> 4) * 2 + (c >> 5), rr = r & 15, cc = c & 31, ob = rr * 64 + cc * 2; return st * 1024 + (ob ^ (((ob >> 9) & 1) << 5)); }
__device__ __forceinline__ void stage_rc(int b, int& R, int& C) { const int st = b / 1024, sb = b % 1024, swz = sb ^ (((sb >> 9) & 1) << 5); R = (st >> 1) * 16 + swz / 64; C = (st & 1) * 32 + (swz % 64) / 2; }
__device__ __forceinline__ bool tile_order(int i, int G, int c, int nM, int nN, int& pm, int& pn) {
    const int nwg = nM * nN; const long L = (long)i * G + c; if (L >= nwg) return false;
    const int wgid = (int)L;
    const int nig = WGM * nN, gid = wgid / nig, fm = gid * WGM, gsz = (nM - fm) < WGM ? (nM - fm) : WGM;
    pm = fm + ((wgid % nig) % gsz); pn = (wgid % nig) / gsz; return true;
}
template <bool FP8, int SCA, class Sched, class Epi>
__device__ __forceinline__ void gemm_phase(LAS unsigned char* lds, const char* Abase, int K, const Sched& S, const Epi& E) {
    int tid = threadIdx.x; asm volatile("" : "+v"(tid));
    const int wid = __builtin_amdgcn_readfirstlane(tid >> 6), lane = tid & 63, wr = wid >> 2, wc = wid & 3, fr = lane & 15, fq = lane >> 4;
    const int nt = K / BK;
    int R0, C0, R1, C1; stage_rc(tid * 16, R0, C0); stage_rc(tid * 16 + 8192, R1, C1);
    LAS unsigned* aofs = (LAS unsigned*)(lds + LDS_AOFF) + tid;
    unsigned rg[10];
    rg[8] = (unsigned)(R0 * K + C0) * 2u; rg[9] = (unsigned)(R1 * K + C1) * 2u;
    if constexpr (FP8) { aofs[8 * NTHR] = rg[8]; aofs[9 * NTHR] = rg[9]; }
    const size_t kstep = (size_t)(BK * 2), hstep = (size_t)HALF * K * 2;
    const unsigned ldsw = (unsigned)wid * 1024u;
    const int aoff = lds_byte(wr * 64 + fr, fq * 8), boff = lds_byte(wc * 32 + fr, fq * 8);
#define PG8_SA(b, h) (((b) * 2 + (h)) * HTB)
#define PG8_SB(b, h) ((4 + (b) * 2 + (h)) * HTB)
#define PG8_OFS(sel, j) (FP8 ? aofs[((sel) * 4 + (j)) * NTHR] : ((sel) ? rg[4 + (j)] : rg[(j)]))
#define PG8_STAGE_B(bufoff, gbase) do { _Pragma("unroll") for (int _i = 0; _i < 2; ++_i) { const unsigned ob_ = FP8 ? aofs[(8 + _i) * NTHR] : rg[8 + _i]; \
        __builtin_amdgcn_global_load_lds((const unsigned*)((const char*)(gbase) + ob_), (LAS unsigned*)(lds + (bufoff) + ldsw + _i * 8192), 16, 0, 0); } } while (0)
#define PG8_STAGE_A(bufoff, kbyte, sel, h) do { const unsigned o0_ = PG8_OFS(sel, (h) * 2), o1_ = PG8_OFS(sel, (h) * 2 + 1); \
        __builtin_amdgcn_global_load_lds((const unsigned*)(Abase + (kbyte) + o0_), (LAS unsigned*)(lds + (bufoff) + ldsw), 16, 0, 0); \
        __builtin_amdgcn_global_load_lds((const unsigned*)(Abase + (kbyte) + o1_), (LAS unsigned*)(lds + (bufoff) + ldsw + 8192), 16, 0, 0); } while (0)
#define PG8_LDA(dst, b, h) do { _Pragma("unroll") for (int m = 0; m < 4; ++m) { \
        if constexpr (FP8) { const v4i_t lo_ = *(const LAS v4i_t*)(lds + PG8_SA(b, h) + aoff + m * 2048), hi_ = *(const LAS v4i_t*)(lds + PG8_SA(b, h) + aoff + m * 2048 + 1024); dst##8[m] = __builtin_shufflevector(lo_, hi_, 0, 1, 2, 3, 4, 5, 6, 7); } \
        else { _Pragma("unroll") for (int k = 0; k < 2; ++k) dst[m][k] = *(const LAS bf16x8*)(lds + PG8_SA(b, h) + aoff + m * 2048 + k * 1024); } } } while (0)
#define PG8_LDB(dst, b, h) do { _Pragma("unroll") for (int n = 0; n < 2; ++n) { \
        if constexpr (FP8) { const v4i_t lo_ = *(const LAS v4i_t*)(lds + PG8_SB(b, h) + boff + n * 2048), hi_ = *(const LAS v4i_t*)(lds + PG8_SB(b, h) + boff + n * 2048 + 1024); dst##8[n] = __builtin_shufflevector(lo_, hi_, 0, 1, 2, 3, 4, 5, 6, 7); } \
        else { _Pragma("unroll") for (int k = 0; k < 2; ++k) dst[n][k] = *(const LAS bf16x8*)(lds + PG8_SB(b, h) + boff + n * 2048 + k * 1024); } } } while (0)
#define PG8_MMA(ai, bj, At, Bt) do { __builtin_amdgcn_s_setprio(1); _Pragma("unroll") for (int m = 0; m < 4; ++m) _Pragma("unroll") for (int n = 0; n < 2; ++n) { \
        if constexpr (FP8) { acc[ai][bj][m][n] = __builtin_amdgcn_mfma_scale_f32_16x16x128_f8f6f4(Bt##8[n], At##8[m], acc[ai][bj][m][n], 0, 0, 0, SCA, 0, SCA); } \
        else { _Pragma("unroll") for (int k = 0; k < 2; ++k) acc[ai][bj][m][n] = __builtin_amdgcn_mfma_f32_16x16x32_bf16(Bt[n][k], At[m][k], acc[ai][bj][m][n], 0, 0, 0); } } \
        __builtin_amdgcn_s_setprio(0); } while (0)
#define PG8_WAIT_V(n) asm volatile("s_waitcnt vmcnt(" #n ")" ::: "memory")
#define PG8_WAIT_L(n) asm volatile("s_waitcnt lgkmcnt(" #n ")" ::: "memory")
#define PG8_BAR __builtin_amdgcn_s_barrier()
#define PG8_SCHED __builtin_amdgcn_sched_barrier(0)
    typename Sched::Unit cur, nxt; int ui = 0;
    if (!S.next(0, cur)) return;
    f32x4 acc[2][2][4][2];
#pragma unroll
    for (int a = 0; a < 2; ++a)
#pragma unroll
        for (int b = 0; b < 2; ++b)
#pragma unroll
            for (int m = 0; m < 4; ++m)
#pragma unroll
                for (int n = 0; n < 2; ++n) acc[a][b][m][n] = (f32x4){0.f, 0.f, 0.f, 0.f};
    bf16x8 At[4][2], B0[2][2], B1[2][2];
    v8i_t At8[4], B08[2], B18[2];
    { unsigned a4[2][2]; S.a_off(cur, R0, C0, R1, C1, a4); rg[0] = a4[0][0]; rg[1] = a4[0][1]; rg[2] = a4[1][0]; rg[3] = a4[1][1];
      if constexpr (FP8) { aofs[0] = a4[0][0]; aofs[NTHR] = a4[0][1]; aofs[2 * NTHR] = a4[1][0]; aofs[3 * NTHR] = a4[1][1]; } }
    const char* cB = S.b_ptr(cur);
    PG8_STAGE_B(PG8_SB(0, 0), cB); PG8_STAGE_B(PG8_SB(0, 1), cB + hstep); PG8_STAGE_A(PG8_SA(0, 0), 0, 0, 0); PG8_STAGE_A(PG8_SA(0, 1), 0, 0, 1);
    if (wr == 1) PG8_BAR;
    PG8_WAIT_V(2); PG8_BAR;
    PG8_STAGE_B(PG8_SB(1, 0), cB + kstep); PG8_STAGE_A(PG8_SA(1, 0), kstep, 0, 0); PG8_STAGE_B(PG8_SB(1, 1), cB + hstep + kstep);
    PG8_WAIT_V(6); PG8_BAR;
    for (;;) {
        const bool has_next = S.next(ui + 1, nxt);
        const char* nB = cB;
        if (has_next) { int t2 = threadIdx.x; asm volatile("" : "+v"(t2)); int r0, c0, r1, c1; stage_rc(t2 * 16, r0, c0); stage_rc(t2 * 16 + 8192, r1, c1); unsigned a4[2][2]; S.a_off(nxt, r0, c0, r1, c1, a4); nB = S.b_ptr(nxt);
            rg[4] = a4[0][0]; rg[5] = a4[0][1]; rg[6] = a4[1][0]; rg[7] = a4[1][1];
            if constexpr (FP8) { aofs[4 * NTHR] = a4[0][0]; aofs[5 * NTHR] = a4[0][1]; aofs[6 * NTHR] = a4[1][0]; aofs[7 * NTHR] = a4[1][1]; } }
        else { rg[4] = rg[0]; rg[5] = rg[1]; rg[6] = rg[2]; rg[7] = rg[3];
            if constexpr (FP8) { aofs[4 * NTHR] = aofs[0]; aofs[5 * NTHR] = aofs[NTHR]; aofs[6 * NTHR] = aofs[2 * NTHR]; aofs[7 * NTHR] = aofs[3 * NTHR]; } }
#pragma unroll 1
        for (int t = 0; t < nt; t += 2) {
            const bool last = (t == nt - 2);
            const size_t ka1 = (size_t)(t + 1) * kstep, ka2 = last ? 0 : (size_t)(t + 2) * kstep, ka3 = ka2 + kstep;
            const char* b2 = last ? nB : cB + (size_t)(t + 2) * kstep; const char* b3 = b2 + kstep;
            const int sel = last ? 1 : 0;
            PG8_LDB(B0, 0, 0); PG8_LDB(B1, 0, 1); PG8_SCHED; PG8_LDA(At, 0, 0); PG8_STAGE_A(PG8_SA(1, 1), ka1, 0, 1);
            PG8_WAIT_V(8); PG8_WAIT_L(0); PG8_BAR; PG8_MMA(0, 0, At, B0); PG8_MMA(0, 1, At, B1); PG8_BAR; PG8_SCHED;
            PG8_LDA(At, 0, 1); PG8_STAGE_B(PG8_SB(0, 0), b2); PG8_STAGE_B(PG8_SB(0, 1), b2 + hstep); PG8_STAGE_A(PG8_SA(0, 0), ka2, sel, 0);
            PG8_WAIT_V(8); PG8_WAIT_L(0); PG8_BAR; PG8_MMA(1, 0, At, B0); PG8_MMA(1, 1, At, B1); PG8_BAR; PG8_SCHED;
            PG8_LDB(B0, 1, 0); PG8_LDB(B1, 1, 1); PG8_SCHED; PG8_LDA(At, 1, 0); PG8_STAGE_A(PG8_SA(0, 1), ka2, sel, 1);
            PG8_WAIT_V(8); PG8_WAIT_L(0); PG8_BAR; PG8_MMA(0, 0, At, B0); PG8_MMA(0, 1, At, B1); PG8_BAR; PG8_SCHED;
            PG8_LDA(At, 1, 1); PG8_STAGE_B(PG8_SB(1, 0), b3); PG8_STAGE_B(PG8_SB(1, 1), b3 + hstep); PG8_STAGE_A(PG8_SA(1, 0), ka3, sel, 0);
            PG8_WAIT_V(8); PG8_WAIT_L(0); PG8_BAR; PG8_MMA(1, 0, At, B0); PG8_MMA(1, 1, At, B1); PG8_BAR; PG8_SCHED;
        }
        if (wr == 0) PG8_BAR;
        { int t2 = threadIdx.x; asm volatile("" : "+v"(t2)); E(acc, cur, wr, wc, t2 & 15, (t2 & 63) >> 4); }
        if (!has_next) break;
#pragma unroll
        for (int a = 0; a < 2; ++a)
#pragma unroll
            for (int b = 0; b < 2; ++b)
#pragma unroll
                for (int m = 0; m < 4; ++m)
#pragma unroll
                    for (int n = 0; n < 2; ++n) acc[a][b][m][n] = (f32x4){0.f, 0.f, 0.f, 0.f};
        cur = nxt; cB = nB; ++ui;
        rg[0] = rg[4]; rg[1] = rg[5]; rg[2] = rg[6]; rg[3] = rg[7];
        if constexpr (FP8) { aofs[0] = aofs[4 * NTHR]; aofs[NTHR] = aofs[5 * NTHR]; aofs[2 * NTHR] = aofs[6 * NTHR]; aofs[3 * NTHR] = aofs[7 * NTHR]; }
        if (wr == 1) PG8_BAR;
    }
    PG8_WAIT_V(0);
    PG8_BAR;
#undef PG8_SA
#undef PG8_SB
#undef PG8_STAGE_A
#undef PG8_OFS
#undef PG8_STAGE_B
#undef PG8_LDA
#undef PG8_LDB
#undef PG8_MMA
#undef PG8_WAIT_V
#undef PG8_WAIT_L
#undef PG8_BAR
#undef PG8_SCHED
}
}

struct DenseUnit { int pm, pn; };
struct DenseSched {
    typedef DenseUnit Unit;
    const char* Bt; int K, nM, nN, vc;
    __device__ __forceinline__ bool next(int i, Unit& u) const { return pg8::tile_order(i, gridDim.x, vc, nM, nN, u.pm, u.pn); }
    __device__ __forceinline__ void a_off(const Unit& u, int R0, int C0, int R1, int C1, unsigned (&off)[2][2]) const {
#pragma unroll
        for (int h = 0; h < 2; ++h) { off[h][0] = (unsigned)((u.pm * 256 + h * 128 + R0) * K + C0) * 2u; off[h][1] = (unsigned)((u.pm * 256 + h * 128 + R1) * K + C1) * 2u; }
    }
    __device__ __forceinline__ const char* b_ptr(const Unit& u) const { return Bt + (size_t)u.pn * 256 * K * 2; }
};
struct MoeUnit { int rbt, e, pn; };
template <bool GATHER>
struct MoeSched {
    typedef MoeUnit Unit;
    static constexpr int KP = 512;
    const char* Bt; const int* lists; const int* ptile; const int* ecnt; int nN, nrows, vc;
    __device__ __forceinline__ bool next(int i, Unit& u) const {
        int pm, pn; if (!pg8::tile_order(i, gridDim.x, vc, ptile[NE], nN, pm, pn)) return false;
        int e = 0; while (ptile[e + 1] <= pm) ++e;
        u.rbt = pm; u.e = e; u.pn = pn; return true;
    }
    __device__ __forceinline__ void a_off(const Unit& u, int R0, int C0, int R1, int C1, unsigned (&off)[2][2]) const {
        if (GATHER) {
            const int* lst = lists + (size_t)u.e * LIST_CAP; const int rb = u.rbt - ptile[u.e], cnt = ecnt[u.e];
#pragma unroll
            for (int h = 0; h < 2; ++h) {
                const int l0 = rb * 256 + h * 128 + R0, l1 = rb * 256 + h * 128 + R1;
                const int t0 = l0 < cnt ? (lst[l0] >> 2) : 0, t1 = l1 < cnt ? (lst[l1] >> 2) : 0;
                off[h][0] = (unsigned)(t0 * KP + C0) * 2u; off[h][1] = (unsigned)(t1 * KP + C1) * 2u;
            }
        } else {
#pragma unroll
            for (int h = 0; h < 2; ++h) { off[h][0] = (unsigned)((u.rbt * 256 + h * 128 + R0) * KP + C0) * 2u; off[h][1] = (unsigned)((u.rbt * 256 + h * 128 + R1) * KP + C1) * 2u; }
        }
    }
    __device__ __forceinline__ const char* b_ptr(const Unit& u) const { return Bt + ((size_t)u.e * nrows + (size_t)u.pn * 256) * KP * 2; }
};

struct EpiInProj {
    const Params* p; int l;
    __device__ __forceinline__ void operator()(const f32x4 (&acc)[2][2][4][2], const DenseUnit& u, int wr, int wc, int fr, int fq) const {
        const float* bias = p->binp + l * NPAD + u.pn * 256;
#pragma unroll
        for (int bj = 0; bj < 2; ++bj) {
            int kind = 0, hb0 = 0;
            if (u.pn == 1) { kind = 1; hb0 = bj * 2; } else if (u.pn == 4 && bj == 1) { kind = 1; hb0 = 4; } else if (u.pn == 8 && bj == 0) { kind = 1; hb0 = 6; } else if (u.pn == 9 && bj == 0) { kind = 1; hb0 = 8; }
            else if (u.pn == 2) { kind = 2; hb0 = bj * 2; } else if (u.pn == 5 && bj == 0) { kind = 2; hb0 = 4; } else if (u.pn == 8 && bj == 1) { kind = 2; hb0 = 6; } else if (u.pn == 9 && bj == 1) { kind = 2; hb0 = 8; }
#pragma unroll
            for (int n = 0; n < 2; ++n) {
                const int c = bj * 128 + wc * 32 + n * 16 + 4 * fq;
                const f32x4 bv = *(const f32x4*)(bias + c);
                const int hh = hb0 + ((c & 127) >> 6), d = c & 63;
#pragma unroll
                for (int ai = 0; ai < 2; ++ai)
#pragma unroll
                    for (int m = 0; m < 4; ++m) {
                        const int row = u.pm * 256 + ai * 128 + wr * 64 + m * 16 + fr;
                        const f32x4 v = acc[ai][bj][m][n] + bv;
                        u32x2 w; w.x = pack2(v[0], v[1]); w.y = pack2(v[2], v[3]);
                        if (kind == 0) *(u32x2*)(p->hb + (size_t)row * NMAIN + u.pn * 256 + c) = w;
                        else {
                            const int b = row >> 11, s = row & 2047, kk = s & 31;
                            bf16_t* blk = (kind == 1 ? p->kF : p->vT) + (((size_t)b * NVH + hh) * 64 + (s >> 5)) * 2048;
                            if (kind == 1) {
                                const int frk = (kk >> 3) * 4 + (kk & 3), t = (kk >> 2) & 1;
                                *(u32x2*)(blk + ((t * 2 + (d >> 5)) * 64 + ((d & 31) >> 3) * 16 + frk) * 8 + (d & 7)) = w;
                            } else {
                                bf16_t* vt = blk + (((d >> 4) * 64) + (kk >> 3) * 16 + (d & 15)) * 8 + (kk & 7);
                                vt[0] = (bf16_t)(w.x & 0xffff); vt[8] = (bf16_t)(w.x >> 16); vt[16] = (bf16_t)(w.y & 0xffff); vt[24] = (bf16_t)(w.y >> 16);
                            }
                        }
                    }
            }
        }
    }
};
struct EpiOutProj {
    const float* xin; float* t;
    __device__ __forceinline__ void operator()(const f32x4 (&acc)[2][2][4][2], const DenseUnit& u, int wr, int wc, int fr, int fq) const {
#pragma unroll
        for (int ai = 0; ai < 2; ++ai)
#pragma unroll
            for (int m = 0; m < 4; ++m) {
                const size_t rowoff = (size_t)(u.pm * 256 + ai * 128 + wr * 64 + m * 16 + fr) * DM + u.pn * 256 + wc * 32 + 4 * fq;
#pragma unroll
                for (int bj = 0; bj < 2; ++bj)
#pragma unroll
                    for (int n = 0; n < 2; ++n) {
                        const size_t off = rowoff + bj * 128 + n * 16;
                        const f32x4 xv = *(const f32x4*)(xin + off);
                        const f32x4 tv = xv * ALPHA + acc[ai][bj][m][n];
                        u32x2 w; w.x = pack2(tv[0], tv[1]); w.y = pack2(tv[2], tv[3]);
                        *(u32x2*)((bf16_t*)t + off) = w;
                    }
            }
    }
};
struct EpiGateUp {
    bf16_t* act; const float* bgup;
    __device__ __forceinline__ void operator()(const f32x4 (&acc)[2][2][4][2], const MoeUnit& u, int wr, int wc, int fr, int fq) const {
        const float* bias = bgup + (size_t)u.e * 2048 + u.pn * 256;
#pragma unroll
        for (int n = 0; n < 2; ++n) {
            const int c = wc * 32 + n * 16 + 4 * fq;
            const f32x4 bg = *(const f32x4*)(bias + c), bu = *(const f32x4*)(bias + 128 + c);
#pragma unroll
            for (int ai = 0; ai < 2; ++ai)
#pragma unroll
                for (int m = 0; m < 4; ++m) {
                    const f32x4 g4 = acc[ai][0][m][n] + bg, u4 = acc[ai][1][m][n] + bu;
                    float o[4];
#pragma unroll
                    for (int j = 0; j < 4; ++j) {
                        const float g = fminf(g4[j], 7.0f), uu = fminf(fmaxf(u4[j], -7.0f), 7.0f);
                        const float glu = g * __builtin_amdgcn_rcpf(1.0f + __builtin_amdgcn_exp2f(-2.455466929f * g));
                        o[j] = (uu + 1.0f) * glu;
                    }
                    *(unsigned*)((char*)act + (size_t)(u.rbt * 256 + ai * 128 + wr * 64 + m * 16 + fr) * DFF + u.pn * 128 + c) = pack4_fp8(o[0], o[1], o[2], o[3]);
                }
        }
    }
};
struct EpiDown {
    bf16_t* ybuf; const float* bdn;
    __device__ __forceinline__ void operator()(const f32x4 (&acc)[2][2][4][2], const MoeUnit& u, int wr, int wc, int fr, int fq) const {
        const float* bias = bdn + (size_t)u.e * 1024 + u.pn * 256;
#pragma unroll
        for (int bj = 0; bj < 2; ++bj)
#pragma unroll
            for (int n = 0; n < 2; ++n) {
                const int c = bj * 128 + wc * 32 + n * 16 + 4 * fq;
                const f32x4 bv = *(const f32x4*)(bias + c);
#pragma unroll
                for (int ai = 0; ai < 2; ++ai)
#pragma unroll
                    for (int m = 0; m < 4; ++m) {
                        const f32x4 v = acc[ai][bj][m][n] + bv;
                        *(unsigned*)((unsigned char*)ybuf + (size_t)(u.rbt * 256 + ai * 128 + wr * 64 + m * 16 + fr) * DM + u.pn * 256 + c) = pack4_fp8(v[0], v[1], v[2], v[3]);
                    }
            }
    }
};

__device__ __forceinline__ void phase_inproj(const Params& p, int l, char* lds) {
    DenseSched S{(const char*)p.WinQ + (size_t)l * NMAIN * 1024, 512, NTOK / 256, NMAIN / 256, vcu_id()};
    EpiInProj E{&p, l};
    pg8::gemm_phase<true, 0x7c7c7c7c>((LAS unsigned char*)lds, (const char*)p.xq, 512, S, E);
    int tid = threadIdx.x; asm volatile("" : "+v"(tid));
    const int wid = tid >> 6, lane = tid & 63, fr = lane & 15, fq = lane >> 4;
    const bf16_t* W = p.WinT + ((size_t)l * NPAD + NMAIN) * 1024;
    const float* bias = p.binp + l * NPAD + NMAIN;
    for (int u = blockIdx.x * NWV + wid; u < NTOK / 16; u += gridDim.x * NWV) {
        const bf16_t* ar = p.xb + (size_t)(u * 16 + fr) * DM + fq * 8;
        const bf16_t* w0 = W + (size_t)fr * 1024 + fq * 8; const bf16_t* w1 = W + (size_t)(16 + fr) * 1024 + fq * 8;
        f32x4 a0 = (f32x4){0.f, 0.f, 0.f, 0.f}, a1 = a0;
#pragma unroll 4
        for (int ks = 0; ks < 32; ++ks) {
            const bf16x8 a = *(const bf16x8*)(ar + ks * 32);
            a0 = __builtin_amdgcn_mfma_f32_16x16x32_bf16(a, *(const bf16x8*)(w0 + ks * 32), a0, 0, 0, 0);
            a1 = __builtin_amdgcn_mfma_f32_16x16x32_bf16(a, *(const bf16x8*)(w1 + ks * 32), a1, 0, 0, 0);
        }
#pragma unroll
        for (int r = 0; r < 4; ++r) {
            float* dst = p.hs + (size_t)(u * 16 + fq * 4 + r) * HS_W;
            dst[fr] = a0[r] + bias[fr];
            if (fr < 6) dst[16 + fr] = a1[r] + bias[16 + fr];
        }
    }
}
__device__ __forceinline__ void phase_outproj(const Params& p, int l, const float* xin, char* lds) {
    DenseSched S{(const char*)p.WoT + (size_t)l * 1024 * 1024, 512, NTOK / 256, 4, vcu_id()};
    EpiOutProj E{xin, p.tbuf};
    pg8::gemm_phase<true, 0x7c7c7c7c>((LAS unsigned char*)lds, (const char*)p.ob, 512, S, E);
}
__device__ __forceinline__ void build_tiles(const Params& p, int l, int* ptile, int* ecnt) {
    int tid = threadIdx.x; asm volatile("" : "+v"(tid));
    if (tid < NE) ecnt[tid] = (int)__hip_atomic_load(p.ctrl + 64 + l * NE + tid, __ATOMIC_RELAXED, __HIP_MEMORY_SCOPE_AGENT);
    __syncthreads();
    if (tid == 0) { int s = 0; for (int e = 0; e < NE; ++e) { ptile[e] = s; s += (ecnt[e] + 255) >> 8; } ptile[NE] = s; }
    __syncthreads();
}
__device__ __forceinline__ void phase_gateup(const Params& p, int l, char* lds) {
    int* ptile = (int*)(lds + LDS_TAB); int* ecnt = ptile + 40;
    build_tiles(p, l, ptile, ecnt);
    MoeSched<true> S{(const char*)p.WguT + (size_t)l * NE * 2048 * 1024, p.lists, ptile, ecnt, 8, 2048, vcu_id()};
    EpiGateUp E{p.act, p.bgup + (size_t)l * NE * 2048};
    pg8::gemm_phase<true, 0x7c7c7c7c>((LAS unsigned char*)lds, (const char*)p.x1b, 512, S, E);
}
__device__ __forceinline__ void phase_down(const Params& p, int l, char* lds) {
    int* ptile = (int*)(lds + LDS_TAB); int* ecnt = ptile + 40;
    build_tiles(p, l, ptile, ecnt);
    MoeSched<false> S{(const char*)p.WdnT + (size_t)l * NE * 1024 * 1024, p.lists, ptile, ecnt, 4, 1024, vcu_id()};
    EpiDown E{p.ybuf, p.b_dn + (size_t)l * NE * 1024};
    pg8::gemm_phase<true, 0x7c7c7c7c>((LAS unsigned char*)lds, (const char*)p.act, 512, S, E);
}

__device__ __forceinline__ float gelu_tanh(float x) {
    const float u = 0.7978845608028654f * (x + 0.044715f * x * x * x);
    const float e = __expf(-2.0f * fabsf(u)); const float th = (1.0f - e) / (1.0f + e);
    return 0.5f * x * (1.0f + (u < 0.f ? -th : th));
}
__device__ __forceinline__ void phase_prep(const Params& p, int l, char* lds) {
    int tid = threadIdx.x; asm volatile("" : "+v"(tid));
    const int wid = tid >> 6, lane = tid & 63, fr = lane & 15, fq = lane >> 4;
    const int gw = blockIdx.x * NWV + wid, nw = gridDim.x * NWV;
    for (int u = (int)gridDim.x - 1 - (int)blockIdx.x; u < NB * 4; u += gridDim.x) {
        const int b = u >> 2, h = u & 3;
        const float* srcp = p.hs + ((size_t)b * SEQ + tid * 4) * HS_W + h;
        float ls[4]; float tot = 0.f;
#pragma unroll
        for (int i = 0; i < 4; ++i) { const float f = srcp[(size_t)i * HS_W]; ls[i] = fminf(f, 0.f) - log1pf(__expf(-fabsf(f))); tot += ls[i]; }
        float inc = tot;
#pragma unroll
        for (int o = 1; o < 64; o <<= 1) { const float v = shfl_f(inc, lane - o); if (lane >= o) inc += v; }
        float* wtot = (float*)(lds + 65536);
        if (lane == 63) wtot[wid] = inc;
        __syncthreads();
        float base = inc - tot;
        for (int w = 0; w < wid; ++w) base += wtot[w];
        float4 o4; o4.x = base + ls[0]; o4.y = o4.x + ls[1]; o4.z = o4.y + ls[2]; o4.w = o4.z + ls[3];
        *(float4*)(p.cF + (size_t)u * SEQ + tid * 4) = o4;
        __syncthreads();
    }
    float* part = (float*)lds;
    bf16_t* h1 = (bf16_t*)(lds + 32768);
    for (int u = blockIdx.x; u < NB * 2 * 2 * 8; u += gridDim.x) {
        const int ct = u & 7, which = (u >> 3) & 1, kvh = (u >> 4) & 1, b = u >> 5;
        const int colo = (which ? C_NVC : C_NKC) + kvh * 64;
        const int c_lane = ct * 16 + fr;
        const int tokbase = min(c_lane, 126) * 16;
        const bf16_t* arow = p.hb + ((size_t)b * SEQ + tokbase) * NMAIN + colo + fq * 8;
        const bf16_t* w1 = p.W1T + ((size_t)(l * 2 + which) * 64 + fr) * 2048 + fq * 8;
        f32x4 acc[4];
#pragma unroll
        for (int n = 0; n < 4; ++n) acc[n] = (f32x4){0.f, 0.f, 0.f, 0.f};
#pragma unroll
        for (int kk = 0; kk < 8; ++kk) {
            const int ks = wid * 8 + kk;
            const bf16x8 a = *(const bf16x8*)(arow + (size_t)(ks >> 1) * NMAIN + (ks & 1) * 32);
#pragma unroll
            for (int n = 0; n < 4; ++n) {
                const bf16x8 bb = *(const bf16x8*)(w1 + (size_t)n * 16 * 2048 + ks * 32);
                acc[n] = __builtin_amdgcn_mfma_f32_16x16x32_bf16(a, bb, acc[n], 0, 0, 0);
            }
        }
#pragma unroll
        for (int n = 0; n < 4; ++n)
#pragma unroll
            for (int r = 0; r < 4; ++r) part[wid * 1024 + (fq * 4 + r) * 64 + n * 16 + fr] = acc[n][r];
        __syncthreads();
        const float* b1 = p.b1c + (l * 2 + which) * 64;
#pragma unroll
        for (int i = 0; i < 2; ++i) {
            const int e = tid + NTHR * i; float sum = 0.f;
#pragma unroll
            for (int w = 0; w < 8; ++w) sum += part[w * 1024 + e];
            h1[e] = f2bf(gelu_tanh(sum + b1[e & 63]));
        }
        __syncthreads();
        if (wid == 0) {
            const bf16_t* w2 = p.W2T + ((size_t)(l * 2 + which) * 64 + fr) * 64 + fq * 8;
            f32x4 o2[4];
#pragma unroll
            for (int n = 0; n < 4; ++n) o2[n] = (f32x4){0.f, 0.f, 0.f, 0.f};
#pragma unroll
            for (int ks = 0; ks < 2; ++ks) {
                const bf16x8 a = *(const bf16x8*)(h1 + fr * 64 + ks * 32 + fq * 8);
#pragma unroll
                for (int n = 0; n < 4; ++n) {
                    const bf16x8 bb = *(const bf16x8*)(w2 + (size_t)n * 16 * 64 + ks * 32);
                    o2[n] = __builtin_amdgcn_mfma_f32_16x16x32_bf16(a, bb, o2[n], 0, 0, 0);
                }
            }
            const size_t base = ((size_t)b * 2 + kvh) * 128 * 64;
#pragma unroll
            for (int n = 0; n < 4; ++n)
#pragma unroll
                for (int r = 0; r < 4; ++r) {
                    const int c = ct * 16 + fq * 4 + r, j2 = n * 16 + fr;
                    const bf16_t v = c < 127 ? f2bf(o2[n][r]) : (bf16_t)0;
                    if (which == 0) p.kc[base + (size_t)c * 64 + j2] = v;
                    else { p.vc[base + (size_t)c * 64 + j2] = v; p.vcT[base + (size_t)j2 * 128 + c] = v; }
                }
        }
        __syncthreads();
    }
}

constexpr float L2E = 1.4426950408889634f, MASKV = -__builtin_huge_valf(), MINIT = -1e30f, SCL2 = QSCALE * L2E;
struct KVFrag { bf16x8 k[2][2]; bf16x8 v[4]; };
template <bool FM>
__device__ __forceinline__ void k_load(KVFrag& f, const bf16_t* __restrict__ Kb, size_t ldk, int kc0, int fr, int fq) {
    if (FM) {
        const bf16_t* kp = Kb + (size_t)(kc0 >> 5) * 2048 + (fq * 16 + fr) * 8;
        f.k[0][0] = *(const bf16x8*)(kp); f.k[0][1] = *(const bf16x8*)(kp + 512); f.k[1][0] = *(const bf16x8*)(kp + 1024); f.k[1][1] = *(const bf16x8*)(kp + 1536);
    } else {
        const bf16_t* kp = Kb + (size_t)(kc0 + (fr >> 2) * 8 + (fr & 3)) * ldk + fq * 8;
        f.k[0][0] = *(const bf16x8*)(kp); f.k[0][1] = *(const bf16x8*)(kp + 32);
        f.k[1][0] = *(const bf16x8*)(kp + 4 * ldk); f.k[1][1] = *(const bf16x8*)(kp + 4 * ldk + 32);
    }
}
template <bool FM>
__device__ __forceinline__ void v_load(bf16x8 (&v)[4], const bf16_t* __restrict__ VTb, size_t ldv, int kc0, int fr, int fq) {
    if (FM) {
        const bf16_t* vp = VTb + (size_t)(kc0 >> 5) * 2048 + (fq * 16 + fr) * 8;
#pragma unroll
        for (int dt = 0; dt < 4; ++dt) v[dt] = *(const bf16x8*)(vp + dt * 512);
    } else {
        const bf16_t* vp = VTb + (size_t)fr * ldv + kc0 + fq * 8;
#pragma unroll
        for (int dt = 0; dt < 4; ++dt) v[dt] = *(const bf16x8*)(vp + (size_t)dt * 16 * ldv);
    }
}
__device__ __forceinline__ float rowmax4(float x) {
    auto r = __builtin_amdgcn_permlane32_swap(__float_as_uint(x), __float_as_uint(x), false, false);
    x = fmaxf(__uint_as_float(r[0]), __uint_as_float(r[1]));
    auto q = __builtin_amdgcn_permlane16_swap(__float_as_uint(x), __float_as_uint(x), false, false);
    return fmaxf(__uint_as_float(q[0]), __uint_as_float(q[1]));
}
__device__ __forceinline__ float rowsum4(float x) {
    auto r = __builtin_amdgcn_permlane32_swap(__float_as_uint(x), __float_as_uint(x), false, false);
    x = __uint_as_float(r[0]) + __uint_as_float(r[1]);
    auto q = __builtin_amdgcn_permlane16_swap(__float_as_uint(x), __float_as_uint(x), false, false);
    return __uint_as_float(q[0]) + __uint_as_float(q[1]);
}
template <int NQT, bool MASK, class MB>
__device__ __forceinline__ void attn_compute(const KVFrag& f, const bf16x8 (&qf)[NQT][2], f32x4 (&o)[NQT][4], float (&m)[NQT], float (&l)[NQT], const MB& mb) {
    f32x4 s0[NQT], s1[NQT];
#pragma unroll
    for (int qt = 0; qt < NQT; ++qt) {
        s0[qt] = __builtin_amdgcn_mfma_f32_16x16x32_bf16(f.k[0][0], qf[qt][0], (f32x4){0.f, 0.f, 0.f, 0.f}, 0, 0, 0);
        s1[qt] = __builtin_amdgcn_mfma_f32_16x16x32_bf16(f.k[1][0], qf[qt][0], (f32x4){0.f, 0.f, 0.f, 0.f}, 0, 0, 0);
    }
#pragma unroll
    for (int qt = 0; qt < NQT; ++qt) {
        s0[qt] = __builtin_amdgcn_mfma_f32_16x16x32_bf16(f.k[0][1], qf[qt][1], s0[qt], 0, 0, 0);
        s1[qt] = __builtin_amdgcn_mfma_f32_16x16x32_bf16(f.k[1][1], qf[qt][1], s1[qt], 0, 0, 0);
    }
    float mx[NQT];
#pragma unroll
    for (int qt = 0; qt < NQT; ++qt) {
#pragma unroll
        for (int j = 0; j < 4; ++j) { s0[qt][j] = mb(qt, j, s0[qt][j]); s1[qt][j] = mb(qt, j + 4, s1[qt][j]); }
        mx[qt] = fmaxf(fmaxf(fmaxf(s0[qt][0], s0[qt][1]), fmaxf(s0[qt][2], s0[qt][3])), fmaxf(fmaxf(s1[qt][0], s1[qt][1]), fmaxf(s1[qt][2], s1[qt][3])));
    }
#pragma unroll
    for (int qt = 0; qt < NQT; ++qt) mx[qt] = rowmax4(mx[qt]);
    bool moved = false;
#pragma unroll
    for (int qt = 0; qt < NQT; ++qt) { mx[qt] = fmaxf(m[qt], mx[qt]); moved |= (mx[qt] != m[qt]); }
    if (__ballot(moved) != 0ull) {
#pragma unroll
        for (int qt = 0; qt < NQT; ++qt) {
            const float alpha = __builtin_amdgcn_exp2f(m[qt] - mx[qt]);
            l[qt] *= alpha;
#pragma unroll
            for (int dt = 0; dt < 4; ++dt) o[qt][dt] *= alpha;
        }
    }
    bf16x8 pf[NQT];
#pragma unroll
    for (int qt = 0; qt < NQT; ++qt) {
        m[qt] = mx[qt];
        float pr[8]; float ps = 0.f;
#pragma unroll
        for (int j = 0; j < 4; ++j) {
            pr[j] = __builtin_amdgcn_exp2f(s0[qt][j] - mx[qt]);
            pr[j + 4] = __builtin_amdgcn_exp2f(s1[qt][j] - mx[qt]);
        }
#pragma unroll
        for (int j = 0; j < 8; ++j) ps += pr[j];
        l[qt] += ps;
        const u32x4 pk = {pack2(pr[0], pr[1]), pack2(pr[2], pr[3]), pack2(pr[4], pr[5]), pack2(pr[6], pr[7])};
        pf[qt] = __builtin_bit_cast(bf16x8, pk);
    }
#pragma unroll
    for (int dt = 0; dt < 4; ++dt)
#pragma unroll
        for (int qt = 0; qt < NQT; ++qt) o[qt][dt] = __builtin_amdgcn_mfma_f32_16x16x32_bf16(f.v[dt], pf[qt], o[qt][dt], 0, 0, 0);
    __builtin_amdgcn_sched_barrier(0);
}
struct RangeIt { int c, c_hi; __device__ __forceinline__ int nxt() { if (c > c_hi) return -1; return (c_hi--) * 32; } };
struct MaskIt { unsigned long long cm; __device__ __forceinline__ int nxt() { if (!cm) return -1; const int i = 63 - __builtin_clzll(cm); cm &= ~(1ull << i); return i * 32; } };
template <bool PFV, bool FM, class It, class Gen>
__device__ __forceinline__ void attn_run(It& it, const bf16_t* Kb, size_t ldk, const bf16_t* VTb, size_t ldv, int fr, int fq, const Gen& gen) {
    KVFrag fa, fb;
    int ka = it.nxt(); if (ka < 0) return;
    k_load<FM>(fa, Kb, ldk, ka, fr, fq); if (PFV) v_load<FM>(fa.v, VTb, ldv, ka, fr, fq);
    for (;;) {
        const int kb = it.nxt(); if (kb >= 0) { k_load<FM>(fb, Kb, ldk, kb, fr, fq); if (PFV) v_load<FM>(fb.v, VTb, ldv, kb, fr, fq); }
        if (!PFV) v_load<FM>(fa.v, VTb, ldv, ka, fr, fq);
        gen(ka, fa);
        if (kb < 0) break;
        ka = it.nxt(); if (ka >= 0) { k_load<FM>(fa, Kb, ldk, ka, fr, fq); if (PFV) v_load<FM>(fa.v, VTb, ldv, ka, fr, fq); }
        if (!PFV) v_load<FM>(fb.v, VTb, ldv, kb, fr, fq);
        gen(kb, fb);
        if (ka < 0) break;
    }
}
template <int NQT>
__device__ __forceinline__ void attn_init(f32x4 (&o)[NQT][4], float (&m)[NQT], float (&l)[NQT]) {
#pragma unroll
    for (int qt = 0; qt < NQT; ++qt) { m[qt] = MINIT; l[qt] = 0.f;
#pragma unroll
        for (int dt = 0; dt < 4; ++dt) o[qt][dt] = (f32x4){0.f, 0.f, 0.f, 0.f}; }
}
__device__ __forceinline__ float lsum4(float l) { return rowsum4(l); }
__device__ __forceinline__ void store_o4(unsigned char* dst, const f32x4 v) { *(unsigned*)dst = pack4_fp8(v[0], v[1], v[2], v[3]); }
__device__ __forceinline__ float sigmoidf_fast(float x) { return __builtin_amdgcn_rcpf(1.0f + __builtin_amdgcn_exp2f(-L2E * x)); }

__device__ __forceinline__ void fox_unit(const Params& p, int b, int h, int qb, int fr, int fq) {
    asm volatile("" : "+v"(fr), "+v"(fq));
    const int t0 = qb * 64;
    const bf16_t* Qb = p.hb + ((size_t)b * SEQ + t0) * NMAIN + C_FQ + h * 64 + fq * 8;
    bf16x8 qf[4][2];
#pragma unroll
    for (int qt = 0; qt < 4; ++qt) { qf[qt][0] = *(const bf16x8*)(Qb + (size_t)(qt * 16 + fr) * NMAIN); qf[qt][1] = *(const bf16x8*)(Qb + (size_t)(qt * 16 + fr) * NMAIN + 32); }
    const float* cf = p.cF + ((size_t)b * 4 + h) * SEQ;
    float cq[4];
#pragma unroll
    for (int qt = 0; qt < 4; ++qt) cq[qt] = cf[t0 + qt * 16 + fr] * L2E;
    f32x4 o[4][4]; float m[4], l[4];
    attn_init<4>(o, m, l);
    const bf16_t* Kb = p.kF + ((size_t)b * NVH + h) * 64 * SEQ;
    const bf16_t* VTb = p.vT + ((size_t)b * NVH + h) * 64 * SEQ;
    RangeIt it{0, (t0 >> 5) + 1};
    attn_run<false, true>(it, Kb, NMAIN, VTb, SEQ, fr, fq, [&](int kc0, const KVFrag& f) {
        const float4 ca = *(const float4*)(cf + kc0 + 8 * fq), cb = *(const float4*)(cf + kc0 + 8 * fq + 4);
        const float ck[8] = {ca.x * L2E, ca.y * L2E, ca.z * L2E, ca.w * L2E, cb.x * L2E, cb.y * L2E, cb.z * L2E, cb.w * L2E};
        const int kq = kc0 + 8 * fq - t0 - fr;
        attn_compute<4, true>(f, qf, o, m, l, [&](int qt, int j, float raw) { return (kq + j - 16 * qt) > 0 ? MASKV : raw * SCL2 + cq[qt] - ck[j]; });
    });
#pragma unroll
    for (int qt = 0; qt < 4; ++qt) {
        const float inv = __builtin_amdgcn_rcpf(lsum4(l[qt]));
        unsigned char* dst = (unsigned char*)p.ob + ((size_t)b * SEQ + t0 + qt * 16 + fr) * DM + h * 64 + 4 * fq;
#pragma unroll
        for (int dt = 0; dt < 4; ++dt) store_o4(dst + dt * 16, o[qt][dt] * inv);
    }
}
__device__ __forceinline__ void swa_unit(const Params& p, int l_, int b, int kv, int pos, int fr, int fq) {
    asm volatile("" : "+v"(fr), "+v"(fq));
    const int t0 = pos * 16, t = t0 + fr;
    const bf16_t* Qb = p.hb + ((size_t)b * SEQ + t) * NMAIN + C_SQ + kv * 192 + fq * 8;
    bf16x8 qf[3][2];
#pragma unroll
    for (int g = 0; g < 3; ++g) { qf[g][0] = *(const bf16x8*)(Qb + g * 64); qf[g][1] = *(const bf16x8*)(Qb + g * 64 + 32); }
    float sl[3];
#pragma unroll
    for (int g = 0; g < 3; ++g) sl[g] = slope_swa(kv * 3 + g) * L2E;
    f32x4 o[3][4]; float m[3], l[3];
    attn_init<3>(o, m, l);
    const bf16_t* Kb = p.kF + ((size_t)b * NVH + 4 + kv) * 64 * SEQ;
    const bf16_t* VTb = p.vT + ((size_t)b * NVH + 4 + kv) * 64 * SEQ;
    RangeIt it{max(0, t0 - 127) >> 5, (t0 + 15) >> 5};
    attn_run<true, true>(it, Kb, NMAIN, VTb, SEQ, fr, fq, [&](int kc0, const KVFrag& f) {
        const int dq = t - kc0 - 8 * fq;
        attn_compute<3, true>(f, qf, o, m, l, [&](int g, int j, float raw) { const int dist = dq - j; return ((unsigned)dist < 128u) ? raw * SCL2 - sl[g] * (float)dist : MASKV; });
    });
#pragma unroll
    for (int g = 0; g < 3; ++g) {
        const float sink = p.sinks[l_ * 6 + kv * 3 + g] * L2E;
        const float inv = __builtin_amdgcn_rcpf(lsum4(l[g]) + __builtin_amdgcn_exp2f(sink - m[g]));
        unsigned char* dst = (unsigned char*)p.ob + ((size_t)b * SEQ + t) * DM + 256 + (kv * 3 + g) * 64 + 4 * fq;
#pragma unroll
        for (int dt = 0; dt < 4; ++dt) store_o4(dst + dt * 16, o[g][dt] * inv);
    }
}
__device__ __forceinline__ void nsa_unit(const Params& p, int b, int kv, int pos, int fr, int fq, int lane, float* ps, unsigned* msk, float* otl) {
    asm volatile("" : "+v"(fr), "+v"(fq), "+v"(lane));
    const int t0 = pos * 16, t = t0 + fr, cur = t0 >> 6;
    const bf16_t* Qb = p.hb + ((size_t)b * SEQ + t) * NMAIN + C_NQ + kv * 192 + fq * 8;
    bf16x8 qf[3][2];
#pragma unroll
    for (int g = 0; g < 3; ++g) { qf[g][0] = *(const bf16x8*)(Qb + g * 64); qf[g][1] = *(const bf16x8*)(Qb + g * 64 + 32); }
    float sl[3];
#pragma unroll
    for (int g = 0; g < 3; ++g) sl[g] = slope_nsa(kv * 3 + g) * L2E;
    const float* gl = p.hs + ((size_t)b * SEQ + t) * HS_W + 4 + kv * 9;
    f32x4 o[3][4]; float m[3], l[3];
    f32x4* otv = (f32x4*)otl + lane;
#pragma unroll
    for (int i = 0; i < 8; ++i) ps[lane + 64 * i] = 0.f;
    {
        const bf16_t* Kb = p.kc + ((size_t)b * 2 + kv) * 128 * 64;
        const bf16_t* VTb = p.vcT + ((size_t)b * 2 + kv) * 64 * 128;
        const int ncv = (t0 + 15 >= 31) ? ((t0 + 15 - 31) >> 4) + 1 : 0;
        const int nch = (ncv + 31) >> 5;
        attn_init<3>(o, m, l);
        const int dq0 = t - 31 - 16 * 8 * fq;
        RangeIt it{0, nch - 1};
        attn_run<false, false>(it, Kb, 64, VTb, 128, fr, fq, [&](int kc0, const KVFrag& f) {
            const int dq = dq0 - 16 * kc0;
            attn_compute<3, true>(f, qf, o, m, l, [&](int g, int j, float raw) { const int dist = dq - 16 * j; return dist >= 0 ? raw * SCL2 - sl[g] * (float)dist : MASKV; });
        });
        float il[3];
#pragma unroll
        for (int g = 0; g < 3; ++g) {
            const float lt = lsum4(l[g]); il[g] = lt > 0.f ? __builtin_amdgcn_rcpf(lt) : 0.f;
            const float gate = sigmoidf_fast(gl[g * 3 + 0]);
#pragma unroll
            for (int dt = 0; dt < 4; ++dt) otv[(g * 4 + dt) * 64] = o[g][dt] * (il[g] * gate);
        }
        float carry_prev = 0.f;
        for (int c = 0; c < nch; ++c) {
            const int kc0 = c * 32, dq = dq0 - 16 * kc0;
            const bf16_t* kp = Kb + (size_t)(kc0 + (fr >> 2) * 8 + (fr & 3)) * 64 + fq * 8;
            const bf16x8 k00 = *(const bf16x8*)(kp), k01 = *(const bf16x8*)(kp + 32), k10 = *(const bf16x8*)(kp + 256), k11 = *(const bf16x8*)(kp + 256 + 32);
            float pc[8];
#pragma unroll
            for (int j = 0; j < 8; ++j) pc[j] = 0.f;
#pragma unroll
            for (int g = 0; g < 3; ++g) {
                f32x4 s0 = (f32x4){0.f, 0.f, 0.f, 0.f}, s1 = s0;
                s0 = __builtin_amdgcn_mfma_f32_16x16x32_bf16(k00, qf[g][0], s0, 0, 0, 0); s0 = __builtin_amdgcn_mfma_f32_16x16x32_bf16(k01, qf[g][1], s0, 0, 0, 0);
                s1 = __builtin_amdgcn_mfma_f32_16x16x32_bf16(k10, qf[g][0], s1, 0, 0, 0); s1 = __builtin_amdgcn_mfma_f32_16x16x32_bf16(k11, qf[g][1], s1, 0, 0, 0);
#pragma unroll
                for (int j = 0; j < 8; ++j) {
                    const int dist = dq - 16 * j; const float raw = j < 4 ? s0[j] : s1[j - 4];
                    if (dist >= 0) pc[j] += __builtin_amdgcn_exp2f(raw * SCL2 - sl[g] * (float)dist - m[g]) * il[g];
                }
            }
            const float cout = 0.5f * pc[7];
            float cin = shfl_f(cout, lane - 16);
            const float cwrap = shfl_f(cout, fr + 48);
            if (fq == 0) cin = carry_prev;
            carry_prev = cwrap;
            const int n0 = (kc0 >> 2) + 2 * fq;
            ps[fr * 32 + n0] = cin + pc[0] + pc[1] + pc[2] + 0.5f * pc[3];
            ps[fr * 32 + n0 + 1] = 0.5f * pc[3] + pc[4] + pc[5] + pc[6] + 0.5f * pc[7];
        }
    }
    lds_wave_sync();
    if (lane < 16) {
        unsigned mask = 1u | (1u << cur); if (cur >= 1) mask |= 1u << (cur - 1);
        if (cur >= 3) {
            if (cur - 2 <= 5) mask |= (1u << (cur - 1)) - 2u;
            else {
                const float* my = ps + lane * 32;
                for (int r = 0; r < 5; ++r) {
                    float best = -1.0f; int bi = 1;
                    for (int j = 1; j <= cur - 2; ++j) { const float v = my[j]; if (!((mask >> j) & 1u) && v > best) { best = v; bi = j; } }
                    mask |= 1u << bi;
                }
            }
        }
        msk[lane] = mask;
    }
    lds_wave_sync();
    const unsigned qmask = msk[fr];
    lds_wave_sync();
    {
        const bf16_t* Kb = p.kF + ((size_t)b * NVH + 6 + kv) * 64 * SEQ;
        const bf16_t* VTb = p.vT + ((size_t)b * NVH + 6 + kv) * 64 * SEQ;
        attn_init<3>(o, m, l);
        unsigned um = qmask;
        um |= shfl_u(um, lane ^ 1); um |= shfl_u(um, lane ^ 2); um |= shfl_u(um, lane ^ 4); um |= shfl_u(um, lane ^ 8);
        um = (unsigned)__builtin_amdgcn_readfirstlane((int)um) & (cur >= 31 ? 0xffffffffu : ((2u << cur) - 1u));
        unsigned long long cm = 0ull;
        for (unsigned r = um; r; r &= r - 1) { const int kb = __builtin_ctz(r); cm |= 3ull << (2 * kb); }
        MaskIt it{cm};
        attn_run<true, true>(it, Kb, NMAIN, VTb, SEQ, fr, fq, [&](int kc0, const KVFrag& f) {
            const bool mine = (qmask >> (kc0 >> 6)) & 1u;
            const int dq = t - kc0 - 8 * fq;
            attn_compute<3, true>(f, qf, o, m, l, [&](int g, int j, float raw) { const int dist = dq - j; return (mine && dist >= 0) ? raw * SCL2 - sl[g] * (float)dist : MASKV; });
        });
#pragma unroll
        for (int g = 0; g < 3; ++g) {
            const float lt = lsum4(l[g]); const float sc = (lt > 0.f ? __builtin_amdgcn_rcpf(lt) : 0.f) * sigmoidf_fast(gl[g * 3 + 1]);
#pragma unroll
            for (int dt = 0; dt < 4; ++dt) otv[(g * 4 + dt) * 64] += o[g][dt] * sc;
        }
    }
    {
        const bf16_t* Kb = p.kF + ((size_t)b * NVH + 8 + kv) * 64 * SEQ;
        const bf16_t* VTb = p.vT + ((size_t)b * NVH + 8 + kv) * 64 * SEQ;
        attn_init<3>(o, m, l);
        RangeIt it{max(0, t0 - 511) >> 5, (t0 + 15) >> 5};
        attn_run<true, true>(it, Kb, NMAIN, VTb, SEQ, fr, fq, [&](int kc0, const KVFrag& f) {
            const int dq = t - kc0 - 8 * fq;
            attn_compute<3, true>(f, qf, o, m, l, [&](int g, int j, float raw) { const int dist = dq - j; return ((unsigned)dist < 512u) ? raw * SCL2 - sl[g] * (float)dist : MASKV; });
        });
#pragma unroll
        for (int g = 0; g < 3; ++g) {
            const float lt = lsum4(l[g]); const float sc = (lt > 0.f ? __builtin_amdgcn_rcpf(lt) : 0.f) * sigmoidf_fast(gl[g * 3 + 2]);
            unsigned char* dst = (unsigned char*)p.ob + ((size_t)b * SEQ + t) * DM + 640 + (kv * 3 + g) * 64 + 4 * fq;
#pragma unroll
            for (int dt = 0; dt < 4; ++dt) store_o4(dst + dt * 16, otv[(g * 4 + dt) * 64] + o[g][dt] * sc);
        }
    }
}

template <bool WITH_CONV>
__device__ __forceinline__ void phase_attn(const Params& p, int l, char* lds, int cslot = 16) {
    int tid = threadIdx.x; asm volatile("" : "+v"(tid));
    const int wid = tid >> 6, lane = tid & 63, fr = lane & 15, fq = lane >> 4;
    float* ps = (float*)(lds + wid * 16896); unsigned* msk = (unsigned*)(ps + 512); float* otl = ps + 576;
    unsigned* ctr = p.ctrl + cslot + l;
    constexpr unsigned NU_NSA = NB * 2 * 128, NU_FOX = NB * 4 * 32, NU_SWA = NB * 2 * 128, NU_ATT = NU_NSA + NU_FOX + NU_SWA;
    for (;;) {
        unsigned u = 0;
        if (lane == 0) u = __hip_atomic_fetch_add(ctr, 1u, __ATOMIC_RELAXED, __HIP_MEMORY_SCOPE_AGENT);
        u = (unsigned)__builtin_amdgcn_readfirstlane((int)u);
        if (WITH_CONV) {
            constexpr unsigned TOTQ = NU_ATT + (unsigned)CONV_TILES;
            if (u >= TOTQ) break;
            const unsigned a0 = (unsigned)(((unsigned long long)u * NU_ATT) / TOTQ), a1 = (unsigned)(((unsigned long long)(u + 1) * NU_ATT) / TOTQ);
            if (a1 == a0) { conv_tile_wave(p, (int)(u - a0), lane, (unsigned char*)ps); continue; }
            u = a0;
        } else {
#ifndef ATT_REP
#define ATT_REP 1
#endif
            if (u >= ATT_REP * NU_ATT) break;
            if (ATT_REP > 1) u %= NU_ATT;
        }
        if (u < NU_NSA) { const int pos = 127 - (int)(u & 127), r = u >> 7; nsa_unit(p, r >> 1, r & 1, pos, fr, fq, lane, ps, msk, otl); }
        else if (u < NU_NSA + NU_FOX) { const unsigned v = u - NU_NSA; const int qb = 31 - (int)(v & 31), r = v >> 5; fox_unit(p, r >> 2, r & 3, qb, fr, fq); }
        else { const unsigned v = u - NU_NSA - NU_FOX; const int pos = 127 - (int)(v & 127), r = v >> 7; swa_unit(p, l, r >> 1, r & 1, pos, fr, fq); }
    }
}

__device__ __forceinline__ void phase_ln1_router(const Params& p, int l, char* lds) {
    int tid = threadIdx.x; asm volatile("" : "+v"(tid));
    const int wid = tid >> 6, lane = tid & 63, fr = lane & 15, fq = lane >> 4;
    float* lg = (float*)lds + wid * 512;
    int* lcnt = (int*)(lds + 16384); int* lbase = lcnt + 32;
    const float* g1 = p.ln1_g + l * DM; const float* b1 = p.ln1_b + l * DM;
    const float* rw = p.rwT + (size_t)l * NE * 1024; const float* rb = p.router_b + l * NE;
    unsigned* gcount = p.ctrl + 64 + l * NE;
    for (int grp = blockIdx.x; grp < NTOK / 128; grp += gridDim.x) {
        const int tok0 = grp * 128 + wid * 16;
        if (tid < 32) lcnt[tid] = 0;
        float4 gg[4], bb[4];
#pragma unroll
        for (int j = 0; j < 4; ++j) { gg[j] = *(const float4*)(g1 + j * 256 + lane * 4); bb[j] = *(const float4*)(b1 + j * 256 + lane * 4); }
        for (int r0 = 0; r0 < 16; r0 += 4) {
            float4 v[4][4]; float s[4], qv[4];
#pragma unroll
            for (int i = 0; i < 4; ++i)
#pragma unroll
                for (int j = 0; j < 4; ++j) { const u32x2 w = *(const u32x2*)((const bf16_t*)p.tbuf + (size_t)(tok0 + r0 + i) * DM + j * 256 + lane * 4);
                    v[i][j] = make_float4(__uint_as_float(w.x << 16), __uint_as_float(w.x & 0xffff0000u), __uint_as_float(w.y << 16), __uint_as_float(w.y & 0xffff0000u)); }
#pragma unroll
            for (int i = 0; i < 4; ++i) { s[i] = 0.f;
#pragma unroll
                for (int j = 0; j < 4; ++j) s[i] += (v[i][j].x + v[i][j].y) + (v[i][j].z + v[i][j].w); }
#pragma unroll
            for (int o = 32; o > 0; o >>= 1) {
#pragma unroll
                for (int i = 0; i < 4; ++i) s[i] += shfl_f(s[i], lane ^ o); }
#pragma unroll
            for (int i = 0; i < 4; ++i) { const float mean = s[i] * (1.0f / 1024.0f); qv[i] = 0.f;
#pragma unroll
                for (int j = 0; j < 4; ++j) { v[i][j].x -= mean; v[i][j].y -= mean; v[i][j].z -= mean; v[i][j].w -= mean; qv[i] += (v[i][j].x * v[i][j].x + v[i][j].y * v[i][j].y) + (v[i][j].z * v[i][j].z + v[i][j].w * v[i][j].w); } }
#pragma unroll
            for (int o = 32; o > 0; o >>= 1) {
#pragma unroll
                for (int i = 0; i < 4; ++i) qv[i] += shfl_f(qv[i], lane ^ o); }
#pragma unroll
            for (int i = 0; i < 4; ++i) {
                const float rstd = rsqrtf(qv[i] * (1.0f / 1024.0f) + LN_EPS);
                const size_t row = (size_t)(tok0 + r0 + i);
#pragma unroll
                for (int j = 0; j < 4; ++j) {
                    const int c = j * 256 + lane * 4;
                    float4 y; y.x = v[i][j].x * rstd * gg[j].x + bb[j].x; y.y = v[i][j].y * rstd * gg[j].y + bb[j].y; y.z = v[i][j].z * rstd * gg[j].z + bb[j].z; y.w = v[i][j].w * rstd * gg[j].w + bb[j].w;
                    { u32x2 w; w.x = pack2(y.x, y.y); w.y = pack2(y.z, y.w); *(u32x2*)((bf16_t*)p.x1f + row * DM + c) = w; }
                    *(unsigned*)((char*)p.x1b + row * DM + c) = pack4_fp8(y.x, y.y, y.z, y.w);
                }
            }
        }
        __syncthreads();
        f32x4 a0 = (f32x4){0.f, 0.f, 0.f, 0.f}, a1 = a0;
        const bf16_t* xr = (const bf16_t*)p.x1f + (size_t)(tok0 + fr) * DM + 4 * fq;
        const float* w0 = rw + (size_t)fr * 1024 + 4 * fq; const float* w1 = rw + (size_t)(16 + fr) * 1024 + 4 * fq;
#pragma unroll 4
        for (int k0 = 0; k0 < 1024; k0 += 16) {
            const u32x2 xw = *(const u32x2*)(xr + k0); const float4 wb0 = *(const float4*)(w0 + k0), wb1 = *(const float4*)(w1 + k0);
            const float4 xa = make_float4(__uint_as_float(xw.x << 16), __uint_as_float(xw.x & 0xffff0000u), __uint_as_float(xw.y << 16), __uint_as_float(xw.y & 0xffff0000u));
            a0 = __builtin_amdgcn_mfma_f32_16x16x4f32(xa.x, wb0.x, a0, 0, 0, 0); a1 = __builtin_amdgcn_mfma_f32_16x16x4f32(xa.x, wb1.x, a1, 0, 0, 0);
            a0 = __builtin_amdgcn_mfma_f32_16x16x4f32(xa.y, wb0.y, a0, 0, 0, 0); a1 = __builtin_amdgcn_mfma_f32_16x16x4f32(xa.y, wb1.y, a1, 0, 0, 0);
            a0 = __builtin_amdgcn_mfma_f32_16x16x4f32(xa.z, wb0.z, a0, 0, 0, 0); a1 = __builtin_amdgcn_mfma_f32_16x16x4f32(xa.z, wb1.z, a1, 0, 0, 0);
            a0 = __builtin_amdgcn_mfma_f32_16x16x4f32(xa.w, wb0.w, a0, 0, 0, 0); a1 = __builtin_amdgcn_mfma_f32_16x16x4f32(xa.w, wb1.w, a1, 0, 0, 0);
        }
#pragma unroll
        for (int r = 0; r < 4; ++r) { lg[(fq * 4 + r) * 32 + fr] = a0[r] + rb[fr]; lg[(fq * 4 + r) * 32 + 16 + fr] = a1[r] + rb[16 + fr]; }
        lds_wave_sync();
        int e4[4] = {0, 0, 0, 0}; int rk[4] = {0, 0, 0, 0};
        if (lane < 16) {
            const float* my = lg + lane * 32; unsigned taken = 0u; float tv[4];
#pragma unroll
            for (int k = 0; k < 4; ++k) {
                float best = NEG_INF; int bi = 0;
                for (int e = 0; e < 32; ++e) { const float xv = my[e]; if (!((taken >> e) & 1u) && xv > best) { best = xv; bi = e; } }
                taken |= 1u << bi; e4[k] = bi; tv[k] = best;
            }
            const float e1 = __expf(tv[1] - tv[0]), e2 = __expf(tv[2] - tv[0]), e3 = __expf(tv[3] - tv[0]);
            const float inv = 1.0f / (1.0f + e1 + e2 + e3);
            const size_t row = (size_t)(tok0 + lane);
            *(float4*)(p.gw + row * 4) = make_float4(inv, e1 * inv, e2 * inv, e3 * inv);
        }
        __syncthreads();
        if (lane < 16) {
#pragma unroll
            for (int k = 0; k < 4; ++k) rk[k] = atomicAdd(&lcnt[e4[k]], 1);
        }
        __syncthreads();
        if (tid < 32) { const int c = lcnt[tid]; lbase[tid] = c ? (int)__hip_atomic_fetch_add(gcount + tid, (unsigned)c, __ATOMIC_RELAXED, __HIP_MEMORY_SCOPE_AGENT) : 0; }
        __syncthreads();
        if (lane < 16) {
            const int row = tok0 + lane; int pk[4];
#pragma unroll
            for (int k = 0; k < 4; ++k) { const int pos = lbase[e4[k]] + rk[k]; p.lists[(size_t)e4[k] * LIST_CAP + pos] = row * 4 + k; pk[k] = (pos << 5) | e4[k]; }
            *(int4*)(p.top_e + (size_t)row * 4) = make_int4(pk[0], pk[1], pk[2], pk[3]);
        }
        __syncthreads();
    }
}

__device__ __forceinline__ void phase_ln2(const Params& p, int l, float* xout, char* lds) {
    int* ptile = (int*)(lds + LDS_TAB); int* ecnt = ptile + 40;
    build_tiles(p, l, ptile, ecnt);
    int tid = threadIdx.x; asm volatile("" : "+v"(tid));
    const int wid = tid >> 6, lane = tid & 63;
    const float* g2 = p.ln2_g + l * DM; const float* b2 = p.ln2_b + l * DM;
    float4 gg[4], bb[4];
#pragma unroll
    for (int j = 0; j < 4; ++j) { gg[j] = *(const float4*)(g2 + j * 256 + lane * 4); bb[j] = *(const float4*)(b2 + j * 256 + lane * 4); }
    for (int pr = blockIdx.x * NWV + wid; pr < NTOK / 2; pr += gridDim.x * NWV) {
        float4 v[2][4]; float s[2], qv[2];
        unsigned yv[2][4][4]; float gk[2][4];
#pragma unroll
        for (int i = 0; i < 2; ++i) {
            const int row = pr * 2 + i;
            const float4 gwv = *(const float4*)(p.gw + (size_t)row * 4);
            gk[i][0] = gwv.x; gk[i][1] = gwv.y; gk[i][2] = gwv.z; gk[i][3] = gwv.w;
            const int4 te = *(const int4*)(p.top_e + (size_t)row * 4);
            const int tk[4] = {te.x, te.y, te.z, te.w};
#pragma unroll
            for (int j = 0; j < 4; ++j) { const u32x2 w = *(const u32x2*)((const bf16_t*)p.x1f + (size_t)row * DM + j * 256 + lane * 4);
                v[i][j] = make_float4(__uint_as_float(w.x << 16), __uint_as_float(w.x & 0xffff0000u), __uint_as_float(w.y << 16), __uint_as_float(w.y & 0xffff0000u)); }
#pragma unroll
            for (int k = 0; k < 4; ++k) {
                const unsigned char* yr = (const unsigned char*)p.ybuf + (size_t)(ptile[tk[k] & 31] * 256 + (tk[k] >> 5)) * DM + lane * 4;
#pragma unroll
                for (int j = 0; j < 4; ++j) yv[i][k][j] = *(const unsigned*)(yr + j * 256);
            }
        }
#pragma unroll
        for (int i = 0; i < 2; ++i) { s[i] = 0.f;
#pragma unroll
            for (int j = 0; j < 4; ++j) {
                float4 a; a.x = v[i][j].x * ALPHA; a.y = v[i][j].y * ALPHA; a.z = v[i][j].z * ALPHA; a.w = v[i][j].w * ALPHA;
#pragma unroll
                for (int k = 0; k < 4; ++k) {
                    const unsigned w = yv[i][k][j];
                    const f32x2_t lo = __builtin_amdgcn_cvt_pk_f32_fp8(w, false), hi = __builtin_amdgcn_cvt_pk_f32_fp8(w, true);
                    a.x += gk[i][k] * lo.x; a.y += gk[i][k] * lo.y; a.z += gk[i][k] * hi.x; a.w += gk[i][k] * hi.y;
                }
                v[i][j] = a; s[i] += (a.x + a.y) + (a.z + a.w);
            } }
#pragma unroll
        for (int o = 32; o > 0; o >>= 1) { s[0] += shfl_f(s[0], lane ^ o); s[1] += shfl_f(s[1], lane ^ o); }
#pragma unroll
        for (int i = 0; i < 2; ++i) { const float mean = s[i] * (1.0f / 1024.0f); qv[i] = 0.f;
#pragma unroll
            for (int j = 0; j < 4; ++j) { v[i][j].x -= mean; v[i][j].y -= mean; v[i][j].z -= mean; v[i][j].w -= mean; qv[i] += (v[i][j].x * v[i][j].x + v[i][j].y * v[i][j].y) + (v[i][j].z * v[i][j].z + v[i][j].w * v[i][j].w); } }
#pragma unroll
        for (int o = 32; o > 0; o >>= 1) { qv[0] += shfl_f(qv[0], lane ^ o); qv[1] += shfl_f(qv[1], lane ^ o); }
#pragma unroll
        for (int i = 0; i < 2; ++i) {
            const float rstd = rsqrtf(qv[i] * (1.0f / 1024.0f) + LN_EPS);
            const size_t row = (size_t)(pr * 2 + i);
#pragma unroll
            for (int j = 0; j < 4; ++j) {
                const int c = j * 256 + lane * 4;
                float4 y; y.x = v[i][j].x * rstd * gg[j].x + bb[j].x; y.y = v[i][j].y * rstd * gg[j].y + bb[j].y; y.z = v[i][j].z * rstd * gg[j].z + bb[j].z; y.w = v[i][j].w * rstd * gg[j].w + bb[j].w;
                *(float4*)(xout + row * DM + c) = y;
                if (l + 1 < NL) {
                    u32x2 w; w.x = pack2(y.x, y.y); w.y = pack2(y.z, y.w);
                    *(u32x2*)(p.xb + row * DM + c) = w;
                    *(unsigned*)(p.xq + row * DM + c) = pack4_fp8(y.x, y.y, y.z, y.w);
                }
            }
        }
    }
}

#define XB_TMO      128
#define XB_XCNT(j)  (256  + 64 * (j))
#define XB_XSUB(j)  (1280 + 64 * (j))
#define XB_XGEN(j)  (2304 + 64 * (j))
#define XB_TOP      3328
#define XB_TOPGEN   3392
#define XCD_BAR_WORDS 3456
#define XB_SPIN_CAP (1u << 22)
__device__ __forceinline__ unsigned xb_ld(unsigned* p)              { return __hip_atomic_load(p, __ATOMIC_RELAXED, __HIP_MEMORY_SCOPE_AGENT); }
__device__ __forceinline__ unsigned xb_add(unsigned* p, unsigned v) { return __hip_atomic_fetch_add(p, v, __ATOMIC_RELAXED, __HIP_MEMORY_SCOPE_AGENT); }
__device__ __forceinline__ unsigned xb_xcc_id() { return (unsigned)__builtin_amdgcn_s_getreg((3 << 11) | 20) & 0xFu; }
#define XB_SPIN(cond, bar) do { unsigned _sp = 0; while (cond) { __builtin_amdgcn_s_sleep(1); \
    if ((++_sp & 255u) == 0u) { if (xb_ld(&(bar)[XB_TMO])) break; if (_sp > XB_SPIN_CAP) { atomicAdd(&(bar)[XB_TMO], 1u); break; } } } } while (0)
struct XcdBarrier { unsigned* bar; unsigned x; volatile LAS unsigned* st; };
__device__ __forceinline__ XcdBarrier xcd_barrier_post(unsigned* bar, volatile LAS unsigned* st) {
    XcdBarrier b; b.bar = bar; b.x = xb_xcc_id(); b.st = st;
    if (threadIdx.x == 0) (void)xb_add(&bar[XB_XCNT(b.x)], 1u);
    return b;
}
__device__ __forceinline__ void xcd_barrier_complete(unsigned* bar, unsigned x, unsigned& nloc, unsigned& nx) {
    const unsigned G = gridDim.x * gridDim.y * gridDim.z;
    unsigned sum, cnt, mine, sp = 0u;
    for (;;) {
        sum = 0u; cnt = 0u; mine = 0u;
#pragma unroll
        for (unsigned j = 0; j < 16; ++j) { const unsigned c = xb_ld(&bar[XB_XCNT(j)]); sum += c; cnt += (c > 0u) ? 1u : 0u; mine = (j == x) ? c : mine; }
        if (sum == G) break;
        __builtin_amdgcn_s_sleep(1);
        if ((++sp & 255u) == 0u) { if (xb_ld(&bar[XB_TMO])) break; if (sp > XB_SPIN_CAP) { atomicAdd(&bar[XB_TMO], 1u); break; } }
    }
    nloc = mine > 0u ? mine : 1u; nx = cnt > 0u ? cnt : 1u;
}
__device__ __forceinline__ void xcd_barrier(const XcdBarrier& b) {
    asm volatile("s_waitcnt vmcnt(0)" ::: "memory");
    __syncthreads();
    if (threadIdx.x == 0) {
        unsigned* bar = b.bar;
        __builtin_amdgcn_s_waitcnt(0);
        unsigned nloc = b.st[0], nx = b.st[1];
        if (nloc == 0u) { xcd_barrier_complete(bar, b.x, nloc, nx); b.st[0] = nloc; b.st[1] = nx; }
        const unsigned old = xb_add(&bar[XB_XSUB(b.x)], 1u);
        const unsigned gen = old / nloc;
        if (old + 1u == (gen + 1u) * nloc) {
            __builtin_amdgcn_fence(__ATOMIC_RELEASE, "agent");
            asm volatile("s_waitcnt vmcnt(0)" ::: "memory");
            const unsigned og = xb_add(&bar[XB_TOP], 1u);
            const unsigned tg = og / nx;
            if (og + 1u == (tg + 1u) * nx) xb_add(&bar[XB_TOPGEN], 1u);
            else XB_SPIN(xb_ld(&bar[XB_TOPGEN]) == tg, bar);
            __builtin_amdgcn_fence(__ATOMIC_ACQUIRE, "agent");
            xb_add(&bar[XB_XGEN(b.x)], 1u);
            asm volatile("s_waitcnt vmcnt(0)" ::: "memory");
        } else {
            XB_SPIN(xb_ld(&bar[XB_XGEN(b.x)]) == gen, bar);
            __builtin_amdgcn_fence(__ATOMIC_ACQUIRE, "agent");
            asm volatile("s_waitcnt vmcnt(0)" ::: "memory");
        }
    }
    __syncthreads();
}

struct KArgs { const float* in[18]; float* out; char* ws; };
constexpr size_t al256(size_t v) { return (v + 255) / 256 * 256; }
struct WSL {
    static constexpr size_t ctrl = 0;
    static constexpr size_t WinT = al256(ctrl + 65536);
    static constexpr size_t WoT = al256(WinT + (size_t)NL * NPAD * 1024 * 2);
    static constexpr size_t W1T = al256(WoT + (size_t)NL * 1024 * 1024 * 2);
    static constexpr size_t W2T = al256(W1T + (size_t)NL * 2 * 64 * 2048 * 2);
    static constexpr size_t WguT = al256(W2T + (size_t)NL * 2 * 64 * 64 * 2);
    static constexpr size_t WdnT = al256(WguT + (size_t)NL * NE * 2048 * 1024 * 2);
    static constexpr size_t rwT = al256(WdnT + (size_t)NL * NE * 1024 * 1024 * 2);
    static constexpr size_t binp = al256(rwT + (size_t)NL * NE * 1024 * 4);
    static constexpr size_t bgup = al256(binp + (size_t)NL * NPAD * 4);
    static constexpr size_t b1c = al256(bgup + (size_t)NL * NE * 2048 * 4);
    static constexpr size_t xf = al256(b1c + 4 * 64 * 4);
    static constexpr size_t xb = al256(xf + (size_t)NTOK * DM * 4);
    static constexpr size_t hb = al256(xb + (size_t)NTOK * DM * 2);
    static constexpr size_t hs = al256(hb + (size_t)NTOK * NMAIN * 2);
    static constexpr size_t vT = al256(hs + (size_t)NTOK * HS_W * 4);
    static constexpr size_t kF = al256(vT + (size_t)NB * NVH * 64 * SEQ * 2);
    static constexpr size_t cF = al256(kF + (size_t)NB * NVH * 64 * SEQ * 2);
    static constexpr size_t kc = al256(cF + (size_t)NB * 4 * SEQ * 4);
    static constexpr size_t vc = al256(kc + (size_t)NB * 2 * 128 * 64 * 2);
    static constexpr size_t vcT = al256(vc + (size_t)NB * 2 * 128 * 64 * 2);
    static constexpr size_t ob = al256(vcT + (size_t)NB * 2 * 128 * 64 * 2);
    static constexpr size_t tbuf = al256(ob + (size_t)NTOK * DM * 2);
    static constexpr size_t x1f = al256(tbuf + (size_t)NTOK * DM * 4);
    static constexpr size_t x1b = al256(x1f + (size_t)NTOK * DM * 4);
    static constexpr size_t top_e = al256(x1b + (size_t)NTOK * DM * 2);
    static constexpr size_t gw = al256(top_e + (size_t)NTOK * 4 * 4);
    static constexpr size_t lists = al256(gw + (size_t)NTOK * 4 * 4);
    static constexpr size_t act = al256(lists + (size_t)NE * LIST_CAP * 4);
    static constexpr size_t ybuf = al256(act + (size_t)MAXSLOT * DFF * 2);
    static constexpr size_t xq = al256(ybuf + (size_t)MAXSLOT * DM * 2);
    static constexpr size_t WinQ = al256(xq + (size_t)NTOK * DM);
    static constexpr size_t total = al256(WinQ + (size_t)NL * NMAIN * 1024);
};
__device__ __forceinline__ Params make_params(const KArgs& k) {
    Params p;
    p.x = k.in[0]; p.w_in = k.in[1]; p.b_in = k.in[2]; p.sinks = k.in[3]; p.cmp_pe = k.in[4]; p.cmp_w1 = k.in[5]; p.cmp_w2 = k.in[6]; p.w_out = k.in[7];
    p.ln1_g = k.in[8]; p.ln1_b = k.in[9]; p.router_w = k.in[10]; p.router_b = k.in[11]; p.w_gu = k.in[12]; p.b_gu = k.in[13]; p.w_dn = k.in[14]; p.b_dn = k.in[15];
    p.ln2_g = k.in[16]; p.ln2_b = k.in[17]; p.out = k.out;
    char* w = k.ws;
    p.ctrl = (unsigned*)(w + WSL::ctrl); p.WinT = (bf16_t*)(w + WSL::WinT); p.WoT = (bf16_t*)(w + WSL::WoT); p.W1T = (bf16_t*)(w + WSL::W1T); p.W2T = (bf16_t*)(w + WSL::W2T);
    p.WguT = (bf16_t*)(w + WSL::WguT); p.WdnT = (bf16_t*)(w + WSL::WdnT); p.rwT = (float*)(w + WSL::rwT); p.binp = (float*)(w + WSL::binp); p.bgup = (float*)(w + WSL::bgup);
    p.b1c = (float*)(w + WSL::b1c); p.xf = (float*)(w + WSL::xf); p.xb = (bf16_t*)(w + WSL::xb); p.hb = (bf16_t*)(w + WSL::hb); p.hs = (float*)(w + WSL::hs); p.vT = (bf16_t*)(w + WSL::vT); p.kF = (bf16_t*)(w + WSL::kF);
    p.cF = (float*)(w + WSL::cF); p.kc = (bf16_t*)(w + WSL::kc); p.vc = (bf16_t*)(w + WSL::vc); p.vcT = (bf16_t*)(w + WSL::vcT); p.ob = (bf16_t*)(w + WSL::ob); p.tbuf = (float*)(w + WSL::tbuf);
    p.x1f = (float*)(w + WSL::x1f); p.x1b = (bf16_t*)(w + WSL::x1b); p.top_e = (int*)(w + WSL::top_e); p.gw = (float*)(w + WSL::gw); p.lists = (int*)(w + WSL::lists);
    p.act = (bf16_t*)(w + WSL::act); p.ybuf = (bf16_t*)(w + WSL::ybuf); p.xq = (unsigned char*)(w + WSL::xq); p.WinQ = (unsigned char*)(w + WSL::WinQ);
    return p;
}
__device__ __forceinline__ void grid_bar(const Params& p, char* lds) {
    XcdBarrier xb; xb.bar = p.ctrl + 1024; xb.x = xb_xcc_id(); xb.st = (volatile LAS unsigned*)(lds + LDS_BYTES - 16); xcd_barrier(xb);
}
__device__ __forceinline__ Params fresh_params(const KArgs& ka) {
    KArgs k2 = ka; size_t z = 0; asm volatile("" : "+s"(z));
    k2.ws = ka.ws + z;
    return make_params(k2);
}
#ifndef REP
#define REP 0
#endif
template <int L>
__device__ __forceinline__ void layer_fwd(const KArgs& ka, char* lds) {
    { const Params p = fresh_params(ka); phase_inproj(p, L, lds);        grid_bar(p, lds); }
    { const Params p = fresh_params(ka); phase_prep(p, L, lds);          grid_bar(p, lds); }
    { const Params p = fresh_params(ka); phase_attn<L == 0>(p, L, lds);  grid_bar(p, lds); }
    { const Params p = fresh_params(ka); phase_outproj(p, L, L == 0 ? p.x : p.xf, lds);  grid_bar(p, lds); }
    { const Params p = fresh_params(ka); phase_ln1_router(p, L, lds);    grid_bar(p, lds); }
    { const Params p = fresh_params(ka); phase_gateup(p, L, lds);        grid_bar(p, lds); }
    { const Params p = fresh_params(ka); phase_down(p, L, lds);          grid_bar(p, lds); }
    { const Params p = fresh_params(ka); phase_ln2(p, L, L == NL - 1 ? p.out : p.xf, lds); }
}
__global__ void __launch_bounds__(NTHR, 2) fwd_kernel(KArgs ka) {
    extern __shared__ __attribute__((aligned(16))) char lds[];
    const Params p = make_params(ka);
    cg::grid_group grid = cg::this_grid();
    volatile LAS unsigned* xst = (volatile LAS unsigned*)(lds + LDS_BYTES - 16);
    if (threadIdx.x == 0) { xst[0] = 0u; xst[1] = 0u; }
    __syncthreads();
    (void)xcd_barrier_post(p.ctrl + 1024, xst);
    volatile LAS int* vcu = (volatile LAS int*)(lds + LDS_BYTES - 32);
    const unsigned myx = xb_xcc_id() & 7u;
    if (threadIdx.x == 0) vcu[1] = (int)__hip_atomic_fetch_add(p.ctrl + 32 + myx, 1u, __ATOMIC_RELAXED, __HIP_MEMORY_SCOPE_AGENT);
    phase0(p, lds);
    grid.sync();
    if (threadIdx.x == 0) {
        int base = 0, tot = 0;
        for (unsigned x = 0; x < 8; ++x) { const int n = (int)__hip_atomic_load(p.ctrl + 32 + x, __ATOMIC_RELAXED, __HIP_MEMORY_SCOPE_AGENT); if (x < myx) base += n; tot += n; }
        vcu[0] = (tot == (int)gridDim.x) ? base + vcu[1] : (int)blockIdx.x;
    }
    __syncthreads();
    layer_fwd<0>(ka, lds);
    grid_bar(p, lds);
    layer_fwd<1>(ka, lds);
}

extern "C" void kernel_launch(void* const* d_in, const int* in_sizes, int n_in, void* d_out, int out_size, void* d_ws, size_t ws_size, hipStream_t stream) {
    KArgs ka{};
    for (int i = 0; i < 18; ++i) ka.in[i] = (const float*)d_in[i];
    ka.out = (float*)d_out; ka.ws = (char*)d_ws;
    if (WSL::total > ws_size) { fprintf(stderr, "workspace too small: need %zu have %zu\n", (size_t)WSL::total, ws_size); return; }
    static int grid_blocks = 0;
    if (!grid_blocks) {
        int dev = 0, cus = 0, per_cu = 0;
        (void)hipGetDevice(&dev);
        (void)hipDeviceGetAttribute(&cus, hipDeviceAttributeMultiprocessorCount, dev);
        (void)hipFuncSetAttribute((const void*)fwd_kernel, hipFuncAttributeMaxDynamicSharedMemorySize, LDS_BYTES);
        (void)hipOccupancyMaxActiveBlocksPerMultiprocessor(&per_cu, fwd_kernel, NTHR, LDS_BYTES);
        if (per_cu < 1) { fprintf(stderr, "occupancy query says 0 blocks per CU\n"); per_cu = 1; }
        grid_blocks = cus;
    }
    (void)hipMemsetAsync(d_ws, 0, 65536, stream);
    void* args[] = {&ka};
    hipError_t e = hipLaunchCooperativeKernel((const void*)fwd_kernel, dim3(grid_blocks), dim3(NTHR), args, LDS_BYTES, stream);
    if (e != hipSuccess) fprintf(stderr, "cooperative launch failed: %s (grid %d)\n", hipGetErrorString(e), grid_blocks);
}
```

```cpp
#include <hip/hip_runtime.h>
#include <hip/hip_cooperative_groups.h>
#include <cstdio>
#include <cstdint>
namespace cg = cooperative_groups;

typedef unsigned short bf16_t;
typedef short bf16x8 __attribute__((ext_vector_type(8)));
typedef float f32x4 __attribute__((ext_vector_type(4)));
typedef unsigned u32x4 __attribute__((ext_vector_type(4)));
typedef unsigned u32x2 __attribute__((ext_vector_type(2)));
typedef int v8i_t __attribute__((ext_vector_type(8)));
typedef float f32x2_t __attribute__((ext_vector_type(2)));
typedef int v4i_t __attribute__((ext_vector_type(4)));
#define LAS __attribute__((address_space(3)))
constexpr float NEG_INF = -__builtin_huge_valf();

constexpr int DM = 1024, NB = 16, SEQ = 2048, NTOK = NB * SEQ, NL = 2;
constexpr int NCOL = 2582, NMAIN = 2560, NPAD = 2688, NE = 32, DFF = 1024;
constexpr int C_FQ = 0, C_FK = 256, C_FV = 512, C_SQ = 768, C_SK = 1152, C_SV = 1280, C_NQ = 1408,
              C_NKC = 1792, C_NVC = 1920, C_NKS = 2048, C_NVS = 2176, C_NKW = 2304, C_NVW = 2432;
constexpr int HS_W = 32;
constexpr int NVH = 10;
constexpr int LIST_CAP = NTOK;
constexpr int MAXSLOT = NTOK * 4 + NE * 256;
constexpr float ALPHA = 1.41421356237f, LN_EPS = 1e-5f, QSCALE = 0.125f;
constexpr float GATE_PRE = -2.455466929f;
constexpr int NWV = 8, NTHR = NWV * 64;
constexpr int LDS_STAGE = 131072, LDS_TAB = LDS_STAGE, LDS_AOFF = LDS_STAGE + 2048, LDS_BIAS = LDS_AOFF + 20480, LDS_BYTES = LDS_BIAS + 3072 + 256;

struct Params {
    const float *x, *w_in, *b_in, *sinks, *cmp_pe, *cmp_w1, *cmp_w2, *w_out, *ln1_g, *ln1_b, *router_w, *router_b,
                *w_gu, *b_gu, *w_dn, *b_dn, *ln2_g, *ln2_b;
    float* out;
    unsigned* ctrl;
    bf16_t *WinT, *WoT, *W1T, *W2T, *WguT, *WdnT;
    float *rwT, *binp, *bgup, *b1c;
    unsigned char* xq; unsigned char* WinQ;
    float* xf; bf16_t* xb; bf16_t* hb; float* hs; bf16_t* vT; bf16_t* kF; float* cF;
    bf16_t *kc, *vc, *vcT; bf16_t* ob; float* tbuf; float* x1f; bf16_t* x1b;
    int* top_e; float* gw; int* lists; bf16_t* act; bf16_t* ybuf;
};

__device__ __forceinline__ float bf2f(bf16_t h) { return __uint_as_float(((unsigned)h) << 16); }
typedef __bf16 bf16x2_t __attribute__((ext_vector_type(2)));
__device__ __forceinline__ bf16_t f2bf(float f) { return __builtin_bit_cast(bf16_t, (__bf16)f); }
__device__ __forceinline__ unsigned pack2(float lo, float hi) { bf16x2_t v = {(__bf16)lo, (__bf16)hi}; return __builtin_bit_cast(unsigned, v); }
__device__ __forceinline__ unsigned pack4_fp8(float a, float b, float c, float d) {
    unsigned w = 0u;
    w = __builtin_amdgcn_cvt_pk_fp8_f32(a, b, w, false);
    w = __builtin_amdgcn_cvt_pk_fp8_f32(c, d, w, true);
    return w;
}
__device__ __forceinline__ float shfl_f(float v, int src_lane) { return __int_as_float(__builtin_amdgcn_ds_bpermute(src_lane << 2, __float_as_int(v))); }
__device__ __forceinline__ unsigned shfl_u(unsigned v, int src_lane) { return (unsigned)__builtin_amdgcn_ds_bpermute(src_lane << 2, (int)v); }
__device__ __forceinline__ float wave_sum(float v) {
#pragma unroll
    for (int o = 32; o > 0; o >>= 1) v += __shfl_xor(v, o);
    return v;
}
__device__ __forceinline__ float wave_max(float v) {
#pragma unroll
    for (int o = 32; o > 0; o >>= 1) v = fmaxf(v, __shfl_xor(v, o));
    return v;
}
__device__ __forceinline__ void lds_wave_sync() { asm volatile("s_waitcnt lgkmcnt(0)" ::: "memory"); __builtin_amdgcn_wave_barrier(); }
__device__ __forceinline__ float slope_swa(int hq) { return exp2f(-8.0f * (float)(2 * hq + 1) / 12.0f); }
__device__ __forceinline__ float slope_nsa(int hq) { return exp2f(-8.0f * (float)(2 * hq + 2) / 12.0f); }

__device__ __forceinline__ int fwd128(int L) { return (L & ~31) | (((L >> 2) & 1) << 4) | (((L >> 3) & 3) << 2) | (L & 3); }
__device__ __forceinline__ int inv128(int p) { return (p & ~31) | (((p >> 2) & 3) << 3) | (((p >> 4) & 1) << 2) | (p & 3); }
__device__ __forceinline__ int fwd256(int L) { return (L & ~255) | (((L >> 3) & 1) << 7) | (((L >> 6) & 3) << 5) | (((L >> 2) & 1) << 4) | (((L >> 4) & 3) << 2) | (L & 3); }
__device__ __forceinline__ int perm_row(int perm, int n) {
    if (perm == 1) { int r; if (n < 768) r = n; else if (n < 772) r = 2560 + (n - 768); else if (n < 2564) r = n - 4; else r = n; return r < 2560 ? fwd128(r) : r; }
    if (perm == 2) { const int f = n >> 1, s = n & 1; return (f >> 7) * 256 + s * 128 + fwd128(f & 127); }
    if (perm == 3) return fwd256(n);
    return n;
}
struct ConvJob { const float* src; bf16_t* dst; int K, N, kt, nt, perm; float q8; };
__device__ __forceinline__ bool conv_job(const Params& p, int t, ConvJob& jb) {
    constexpr int T_WIN = NL * 8 * 21, T_WO = NL * 8 * 8;
    if (t < T_WIN) { const int m = t / 168, r = t % 168; jb = ConvJob{p.w_in + (size_t)m * 1024 * NCOL, p.WinT + (size_t)m * NPAD * 1024, 1024, NCOL, r / 21, r % 21, 1, 0.f}; return true; }
    t -= T_WIN;
    if (t < T_WO) { const int m = t / 64, r = t % 64; jb = ConvJob{p.w_out + (size_t)m * 1024 * 1024, (bf16_t*)((char*)p.WoT + (size_t)m * 1024 * 1024), 1024, 1024, r / 8, r % 8, 3, 64.0f}; return true; }
    t -= T_WO;
    if (t < T_WIN) { const int m = t / 168, r = t % 168; jb = ConvJob{p.w_in + (size_t)m * 1024 * NCOL, (bf16_t*)(p.WinQ + (size_t)m * NMAIN * 1024), 1024, NCOL, r / 21, r % 21, 1, 64.0f}; return true; }
    return false;
}
constexpr int CONV_TILES = NL * NE * 192;
__device__ __forceinline__ void conv_tile_wave(const Params& p, int t, int lane, unsigned char* l8) {
    asm volatile("" : "+v"(lane));
    const int m = t / 192, r = t % 192;
    const float* src; unsigned char* dst; int N, kt, nt, perm;
    if (r < 128) { src = p.w_gu + (size_t)m * 1024 * 2048; dst = (unsigned char*)p.WguT + (size_t)m * 2048 * 1024; N = 2048; kt = r >> 4; nt = r & 15; perm = 2; }
    else { const int q = r - 128; src = p.w_dn + (size_t)m * 1024 * 1024; dst = (unsigned char*)p.WdnT + (size_t)m * 1024 * 1024; N = 1024; kt = q >> 3; nt = q & 7; perm = 3; }
    const float* s = src + (size_t)(kt * 128 + (lane >> 5)) * N + nt * 128 + (lane & 31) * 4;
    unsigned char* lw = l8 + (lane >> 5) * 132 + (lane & 31) * 4;
    const float sg = (perm == 2) ? 64.0f * GATE_PRE : 64.0f;
    float4 va[16], vb[16];
#pragma unroll
    for (int i = 0; i < 16; ++i) va[i] = *(const float4*)(s + (size_t)(2 * i) * N);
#pragma unroll
    for (int i = 0; i < 16; ++i) vb[i] = *(const float4*)(s + (size_t)(32 + 2 * i) * N);
#pragma unroll
    for (int i = 0; i < 16; ++i) *(unsigned*)(lw + (2 * i) * 132) = pack4_fp8(va[i].x * sg, va[i].y * 64.0f, va[i].z * sg, va[i].w * 64.0f);
#pragma unroll
    for (int i = 0; i < 16; ++i) va[i] = *(const float4*)(s + (size_t)(64 + 2 * i) * N);
#pragma unroll
    for (int i = 0; i < 16; ++i) *(unsigned*)(lw + (32 + 2 * i) * 132) = pack4_fp8(vb[i].x * sg, vb[i].y * 64.0f, vb[i].z * sg, vb[i].w * 64.0f);
#pragma unroll
    for (int i = 0; i < 16; ++i) vb[i] = *(const float4*)(s + (size_t)(96 + 2 * i) * N);
#pragma unroll
    for (int i = 0; i < 16; ++i) *(unsigned*)(lw + (64 + 2 * i) * 132) = pack4_fp8(va[i].x * sg, va[i].y * 64.0f, va[i].z * sg, va[i].w * 64.0f);
#pragma unroll
    for (int i = 0; i < 16; ++i) *(unsigned*)(lw + (96 + 2 * i) * 132) = pack4_fp8(vb[i].x * sg, vb[i].y * 64.0f, vb[i].z * sg, vb[i].w * 64.0f);
    lds_wave_sync();
#pragma unroll 4
    for (int i = 0; i < 16; ++i) {
        const int idx = lane + 64 * i, kc = idx & 7, nn = idx >> 3;
        const unsigned char* l = l8 + (kc * 16) * 132 + nn;
        u32x4 w;
        w.x = (unsigned)l[0] | ((unsigned)l[132] << 8) | ((unsigned)l[264] << 16) | ((unsigned)l[396] << 24);
        w.y = (unsigned)l[528] | ((unsigned)l[660] << 8) | ((unsigned)l[792] << 16) | ((unsigned)l[924] << 24);
        w.z = (unsigned)l[1056] | ((unsigned)l[1188] << 8) | ((unsigned)l[1320] << 16) | ((unsigned)l[1452] << 24);
        w.w = (unsigned)l[1584] | ((unsigned)l[1716] << 8) | ((unsigned)l[1848] << 16) | ((unsigned)l[1980] << 24);
        *(u32x4*)(dst + (size_t)perm_row(perm, nt * 128 + nn) * 1024 + kt * 128 + kc * 16) = w;
    }
    lds_wave_sync();
}
__device__ __forceinline__ void conv_load(const ConvJob& jb, int tid, float2 (&v)[16]) {
    const int n = jb.nt * 128 + (tid & 31) * 4;
    const float* s = jb.src + (size_t)(jb.kt * 128 + (tid >> 5)) * jb.N + n;
#pragma unroll
    for (int i = 0; i < 8; ++i) {
        const float* r = s + (size_t)(16 * i) * jb.N;
        v[2 * i] = (n + 1 < jb.N) ? *(const float2*)r : make_float2(0.f, 0.f);
        v[2 * i + 1] = (n + 3 < jb.N) ? *(const float2*)(r + 2) : make_float2(0.f, 0.f);
    }
}
__device__ __forceinline__ void phase0(const Params& p, char* ldsc) {
    int tid = threadIdx.x; asm volatile("" : "+v"(tid));
    const int G = gridDim.x, bid = blockIdx.x;
    const size_t gtid = (size_t)bid * NTHR + tid, gthreads = (size_t)G * NTHR;
    {
        constexpr int TOT = 2 * NL * 8 * 21 + NL * 8 * 8;
        bf16_t* lt = (bf16_t*)ldsc;
        ConvJob jb, jn; float2 v[16], vn[16];
        int t = bid; bool have = t < TOT && conv_job(p, t, jb);
        if (have) conv_load(jb, tid, v);
        while (have) {
            const int tn = t + G; const bool hn = tn < TOT && conv_job(p, tn, jn);
            if (hn) conv_load(jn, tid, vn);
            if (jb.q8 != 0.f) {
                unsigned char* l8 = (unsigned char*)lt;
#pragma unroll
                for (int i = 0; i < 8; ++i)
                    *(unsigned*)(l8 + ((tid >> 5) + 16 * i) * 132 + (tid & 31) * 4) = pack4_fp8(v[2 * i].x * jb.q8, v[2 * i].y * jb.q8, v[2 * i + 1].x * jb.q8, v[2 * i + 1].y * jb.q8);
                __syncthreads();
#pragma unroll
                for (int i = 0; i < 2; ++i) {
                    const int idx = tid + NTHR * i, kc = idx & 7, nn = idx >> 3, n = jb.nt * 128 + nn;
                    const unsigned char* l = l8 + (kc * 16) * 132 + nn;
                    u32x4 w;
                    w.x = (unsigned)l[0] | ((unsigned)l[132] << 8) | ((unsigned)l[264] << 16) | ((unsigned)l[396] << 24);
                    w.y = (unsigned)l[528] | ((unsigned)l[660] << 8) | ((unsigned)l[792] << 16) | ((unsigned)l[924] << 24);
                    w.z = (unsigned)l[1056] | ((unsigned)l[1188] << 8) | ((unsigned)l[1320] << 16) | ((unsigned)l[1452] << 24);
                    w.w = (unsigned)l[1584] | ((unsigned)l[1716] << 8) | ((unsigned)l[1848] << 16) | ((unsigned)l[1980] << 24);
                    const int pr = perm_row(jb.perm, n);
                    if (n < jb.N && !(jb.perm == 1 && pr >= NMAIN)) *(u32x4*)((char*)jb.dst + (size_t)pr * jb.K + jb.kt * 128 + kc * 16) = w;
                }
            } else {
#pragma unroll
                for (int i = 0; i < 8; ++i) {
                    u32x2 w; w.x = pack2(v[2 * i].x, v[2 * i].y); w.y = pack2(v[2 * i + 1].x, v[2 * i + 1].y);
                    *(u32x2*)(lt + ((tid >> 5) + 16 * i) * 136 + (tid & 31) * 4) = w;
                }
                __syncthreads();
#pragma unroll
                for (int i = 0; i < 4; ++i) {
                    const int idx = tid + NTHR * i, kc = idx & 15, nn = idx >> 4, n = jb.nt * 128 + nn;
                    if (n < jb.N) {
                        const bf16_t* l = lt + (kc * 8) * 136 + nn;
                        u32x4 w;
                        w.x = (unsigned)l[0] | ((unsigned)l[136] << 16); w.y = (unsigned)l[272] | ((unsigned)l[408] << 16);
                        w.z = (unsigned)l[544] | ((unsigned)l[680] << 16); w.w = (unsigned)l[816] | ((unsigned)l[952] << 16);
                        *(u32x4*)(jb.dst + (size_t)perm_row(jb.perm, n) * jb.K + jb.kt * 128 + kc * 8) = w;
                    }
                }
            }
            __syncthreads();
            t = tn; have = hn; jb = jn;
#pragma unroll
            for (int i = 0; i < 16; ++i) v[i] = vn[i];
        }
    }
    for (size_t i = gtid; i < (size_t)NL * 2 * 2048 * 64; i += gthreads) {
        const int k = (int)(i % 2048), n = (int)((i / 2048) % 64), m = (int)(i / (2048 * 64));
        p.W1T[i] = f2bf(p.cmp_w1[((size_t)m * 2048 + k) * 64 + n]);
    }
    for (size_t i = gtid; i < (size_t)NL * 2 * 64 * 64; i += gthreads) {
        const int k = (int)(i % 64), n = (int)((i / 64) % 64), m = (int)(i / 4096);
        p.W2T[i] = f2bf(p.cmp_w2[((size_t)m * 64 + k) * 64 + n]);
    }
    for (size_t i = gtid; i < (size_t)NL * NPAD; i += gthreads) {
        const int l = (int)(i / NPAD), ri = (int)(i % NPAD), r = ri < 2560 ? inv128(ri) : ri;
        float v = 0.f;
        if (r < 2560) { const int n = r < 768 ? r : r + 4; v = p.b_in[l * NCOL + n]; }
        else if (r < 2564) v = p.b_in[l * NCOL + 768 + (r - 2560)];
        else if (r < 2582) v = p.b_in[l * NCOL + r];
        p.binp[i] = v;
    }
    for (size_t i = gtid; i < (size_t)NL * NE * 2048; i += gthreads) {
        const int r = (int)(i % 2048); const size_t le = i / 2048;
        const int s = (r >> 7) & 1, f = (r >> 8) * 128 + inv128(r & 127);
        p.bgup[i] = p.b_gu[le * 2048 + 2 * f + s] * (s == 0 ? GATE_PRE : 1.0f);
    }
    for (size_t i = gtid; i < (size_t)NL * NE * 1024; i += gthreads) {
        const int k = (int)(i % 1024), e = (int)((i / 1024) % NE), l = (int)(i / (1024 * NE));
        p.rwT[i] = p.router_w[((size_t)l * 1024 + k) * NE + e];
    }
    for (size_t i = gtid; i < (size_t)NL * (NPAD - NCOL) * 1024; i += gthreads) {
        const int l = (int)(i / ((NPAD - NCOL) * 1024)); const size_t r = i % ((size_t)(NPAD - NCOL) * 1024);
        p.WinT[(size_t)l * NPAD * 1024 + (size_t)NCOL * 1024 + r] = 0;
    }
    for (size_t i = gtid; i < (size_t)NTOK * DM / 4; i += gthreads) {
        const float4 v4 = ((const float4*)p.x)[i];
        u32x2 w; w.x = pack2(v4.x, v4.y); w.y = pack2(v4.z, v4.w);
        ((u32x2*)p.xb)[i] = w;
        ((unsigned*)p.xq)[i] = pack4_fp8(v4.x, v4.y, v4.z, v4.w);
    }
    if (bid < 4) {
        float* lf = (float*)ldsc;
        const int j = tid & 63, part = tid >> 6;
        const float* pe = p.cmp_pe + (size_t)bid * 2048; const float* w1 = p.cmp_w1 + (size_t)bid * 2048 * 64;
        float s = 0.f;
        for (int kk = part * 256; kk < part * 256 + 256; ++kk) s += pe[kk] * w1[(size_t)kk * 64 + j];
        lf[tid] = s; __syncthreads();
        if (tid < 64) { float a = 0.f; for (int q = 0; q < 8; ++q) a += lf[tid + 64 * q]; p.b1c[bid * 64 + tid] = a; }
        __syncthreads();
    }
}

__device__ __forceinline__ int vcu_id() { return __builtin_amdgcn_readfirstlane(*(const volatile LAS int*)(LDS_BYTES - 32)); }
namespace pg8 {
constexpr int BM = 256, BK = 64, HALF = 128, HTB = HALF * BK * 2, NXCD = 8, WGM = 8;
__device__ __forceinline__ int lds_byte(int r, int c) { const int st = (r >> 4) * 2 + (c >> 5), rr = r & 15, cc = c & 31, ob = rr * 64 + cc * 2; return st * 1024 + (ob ^ (((ob >> 9) & 1) << 5)); }
__device__ __forceinline__ void stage_rc(int b, int& R, int& C) { const int st = b / 1024, sb = b % 1024, swz = sb ^ (((sb >> 9) & 1) << 5); R = (st >> 1) * 16 + swz / 64; C = (st & 1) * 32 + (swz % 64) / 2; }
__device__ __forceinline__ bool tile_order(int i, int G, int c, int nM, int nN, int& pm, int& pn) {
    const int nwg = nM * nN; const long L = (long)i * G + c; if (L >= nwg) return false;
    const int wgid = (int)L;
    const int nig = WGM * nN, gid = wgid / nig, fm = gid * WGM, gsz = (nM - fm) < WGM ? (nM - fm) : WGM;
    pm = fm + ((wgid % nig) % gsz); pn = (wgid % nig) / gsz; return true;
}
template <bool FP8, int SCA, class Sched, class Epi>
__device__ __forceinline__ void gemm_phase(LAS unsigned char* lds, const char* Abase, int K, const Sched& S, const Epi& E) {
    int tid = threadIdx.x; asm volatile("" : "+v"(tid));
    const int wid = __builtin_amdgcn_readfirstlane(tid >> 6), lane = tid & 63, wr = wid >> 2, wc = wid & 3, fr = lane & 15, fq = lane >> 4;
    const int nt = K / BK;
    int R0, C0, R1, C1; stage_rc(tid * 16, R0, C0); stage_rc(tid * 16 + 8192, R1, C1);
    LAS unsigned* aofs = (LAS unsigned*)(lds + LDS_AOFF) + tid;
    unsigned rg[10];
    rg[8] = (unsigned)(R0 * K + C0) * 2u; rg[9] = (unsigned)(R1 * K + C1) * 2u;
    if constexpr (FP8) { aofs[8 * NTHR] = rg[8]; aofs[9 * NTHR] = rg[9]; }
    const size_t kstep = (size_t)(BK * 2), hstep = (size_t)HALF * K * 2;
    const unsigned ldsw = (unsigned)wid * 1024u;
    const int aoff = lds_byte(wr * 64 + fr, fq * 8), boff = lds_byte(wc * 32 + fr, fq * 8);
#define PG8_SA(b, h) (((b) * 2 + (h)) * HTB)
#define PG8_SB(b, h) ((4 + (b) * 2 + (h)) * HTB)
#define PG8_OFS(sel, j) (FP8 ? aofs[((sel) * 4 + (j)) * NTHR] : ((sel) ? rg[4 + (j)] : rg[(j)]))
#define PG8_STAGE_B(bufoff, gbase) do { _Pragma("unroll") for (int _i = 0; _i < 2; ++_i) { const unsigned ob_ = FP8 ? aofs[(8 + _i) * NTHR] : rg[8 + _i]; \
        __builtin_amdgcn_global_load_lds((const unsigned*)((const char*)(gbase) + ob_), (LAS unsigned*)(lds + (bufoff) + ldsw + _i * 8192), 16, 0, 0); } } while (0)
#define PG8_STAGE_A(bufoff, kbyte, sel, h) do { const unsigned o0_ = PG8_OFS(sel, (h) * 2), o1_ = PG8_OFS(sel, (h) * 2 + 1); \
        __builtin_amdgcn_global_load_lds((const unsigned*)(Abase + (kbyte) + o0_), (LAS unsigned*)(lds + (bufoff) + ldsw), 16, 0, 0); \
        __builtin_amdgcn_global_load_lds((const unsigned*)(Abase + (kbyte) + o1_), (LAS unsigned*)(lds + (bufoff) + ldsw + 8192), 16, 0, 0); } while (0)
#define PG8_LDA(dst, b, h) do { _Pragma("unroll") for (int m = 0; m < 4; ++m) { \
        if constexpr (FP8) { const v4i_t lo_ = *(const LAS v4i_t*)(lds + PG8_SA(b, h) + aoff + m * 2048), hi_ = *(const LAS v4i_t*)(lds + PG8_SA(b, h) + aoff + m * 2048 + 1024); dst##8[m] = __builtin_shufflevector(lo_, hi_, 0, 1, 2, 3, 4, 5, 6, 7); } \
        else { _Pragma("unroll") for (int k = 0; k < 2; ++k) dst[m][k] = *(const LAS bf16x8*)(lds + PG8_SA(b, h) + aoff + m * 2048 + k * 1024); } } } while (0)
#define PG8_LDB(dst, b, h) do { _Pragma("unroll") for (int n = 0; n < 2; ++n) { \
        if constexpr (FP8) { const v4i_t lo_ = *(const LAS v4i_t*)(lds + PG8_SB(b, h) + boff + n * 2048), hi_ = *(const LAS v4i_t*)(lds + PG8_SB(b, h) + boff + n * 2048 + 1024); dst##8[n] = __builtin_shufflevector(lo_, hi_, 0, 1, 2, 3, 4, 5, 6, 7); } \
        else { _Pragma("unroll") for (int k = 0; k < 2; ++k) dst[n][k] = *(const LAS bf16x8*)(lds + PG8_SB(b, h) + boff + n * 2048 + k * 1024); } } } while (0)
#define PG8_MMA(ai, bj, At, Bt) do { __builtin_amdgcn_s_setprio(1); _Pragma("unroll") for (int m = 0; m < 4; ++m) _Pragma("unroll") for (int n = 0; n < 2; ++n) { \
        if constexpr (FP8) { acc[ai][bj][m][n] = __builtin_amdgcn_mfma_scale_f32_16x16x128_f8f6f4(Bt##8[n], At##8[m], acc[ai][bj][m][n], 0, 0, 0, SCA, 0, SCA); } \
        else { _Pragma("unroll") for (int k = 0; k < 2; ++k) acc[ai][bj][m][n] = __builtin_amdgcn_mfma_f32_16x16x32_bf16(Bt[n][k], At[m][k], acc[ai][bj][m][n], 0, 0, 0); } } \
        __builtin_amdgcn_s_setprio(0); } while (0)
#define PG8_WAIT_V(n) asm volatile("s_waitcnt vmcnt(" #n ")" ::: "memory")
#define PG8_WAIT_L(n) asm volatile("s_waitcnt lgkmcnt(" #n ")" ::: "memory")
#define PG8_BAR __builtin_amdgcn_s_barrier()
#define PG8_SCHED __builtin_amdgcn_sched_barrier(0)
    typename Sched::Unit cur, nxt; int ui = 0;
    if (!S.next(0, cur)) return;
    f32x4 acc[2][2][4][2];
    bf16x8 At[4][2], B0[2][2], B1[2][2];
    v8i_t At8[4], B08[2], B18[2];
    { unsigned a4[2][2]; S.a_off(cur, R0, C0, R1, C1, a4); rg[0] = a4[0][0]; rg[1] = a4[0][1]; rg[2] = a4[1][0]; rg[3] = a4[1][1];
      if constexpr (FP8) { aofs[0] = a4[0][0]; aofs[NTHR] = a4[0][1]; aofs[2 * NTHR] = a4[1][0]; aofs[3 * NTHR] = a4[1][1]; } }
    const char* cB = S.b_ptr(cur);
#define PG8_BIAS_DMA(unit, slot) do { const float* bp_ = E.bias_ptr(unit); int tb_ = threadIdx.x; asm volatile("" : "+v"(tb_)); if (wr == 0 && bp_ != nullptr) \
        __builtin_amdgcn_global_load_lds((const unsigned*)(bp_ + (tb_ & 255)), (LAS unsigned*)(lds + LDS_BIAS + (slot) * 1024 + wid * 256), 4, 0, 0); } while (0)
    PG8_BIAS_DMA(cur, 0);
    PG8_STAGE_B(PG8_SB(0, 0), cB); PG8_STAGE_B(PG8_SB(0, 1), cB + hstep); PG8_STAGE_A(PG8_SA(0, 0), 0, 0, 0); PG8_STAGE_A(PG8_SA(0, 1), 0, 0, 1);
    if (wr == 1) PG8_BAR;
    PG8_WAIT_V(2); PG8_BAR;
    PG8_STAGE_B(PG8_SB(1, 0), cB + kstep); PG8_STAGE_A(PG8_SA(1, 0), kstep, 0, 0); PG8_STAGE_B(PG8_SB(1, 1), cB + hstep + kstep);
    PG8_WAIT_V(6); PG8_BAR;
    { int t3 = threadIdx.x; asm volatile("" : "+v"(t3)); E.init(acc, wc, (t3 & 63) >> 4, (const LAS float*)(lds + LDS_BIAS)); }
    for (;;) {
        const bool has_next = S.next(ui + 1, nxt);
        const char* nB = cB;
        if (has_next) PG8_BIAS_DMA(nxt, (ui + 1) % 3);
        if (has_next) { int t2 = threadIdx.x; asm volatile("" : "+v"(t2)); int r0, c0, r1, c1; stage_rc(t2 * 16, r0, c0); stage_rc(t2 * 16 + 8192, r1, c1); unsigned a4[2][2]; S.a_off(nxt, r0, c0, r1, c1, a4); nB = S.b_ptr(nxt);
            rg[4] = a4[0][0]; rg[5] = a4[0][1]; rg[6] = a4[1][0]; rg[7] = a4[1][1];
            if constexpr (FP8) { aofs[4 * NTHR] = a4[0][0]; aofs[5 * NTHR] = a4[0][1]; aofs[6 * NTHR] = a4[1][0]; aofs[7 * NTHR] = a4[1][1]; } }
        else { rg[4] = rg[0]; rg[5] = rg[1]; rg[6] = rg[2]; rg[7] = rg[3];
            if constexpr (FP8) { aofs[4 * NTHR] = aofs[0]; aofs[5 * NTHR] = aofs[NTHR]; aofs[6 * NTHR] = aofs[2 * NTHR]; aofs[7 * NTHR] = aofs[3 * NTHR]; } }
#pragma unroll 1
        for (int t = 0; t < nt; t += 2) {
            const bool last = (t == nt - 2);
            const size_t ka1 = (size_t)(t + 1) * kstep, ka2 = last ? 0 : (size_t)(t + 2) * kstep, ka3 = ka2 + kstep;
            const char* b2 = last ? nB : cB + (size_t)(t + 2) * kstep; const char* b3 = b2 + kstep;
            const int sel = last ? 1 : 0;
            PG8_LDB(B0, 0, 0); PG8_LDB(B1, 0, 1); PG8_SCHED; PG8_LDA(At, 0, 0); PG8_STAGE_A(PG8_SA(1, 1), ka1, 0, 1);
            PG8_WAIT_V(8); PG8_WAIT_L(0); PG8_BAR; PG8_MMA(0, 0, At, B0); PG8_MMA(0, 1, At, B1); PG8_BAR; PG8_SCHED;
            PG8_LDA(At, 0, 1); PG8_STAGE_B(PG8_SB(0, 0), b2); PG8_STAGE_B(PG8_SB(0, 1), b2 + hstep); PG8_STAGE_A(PG8_SA(0, 0), ka2, sel, 0);
            PG8_WAIT_V(8); PG8_WAIT_L(0); PG8_BAR; PG8_MMA(1, 0, At, B0); PG8_MMA(1, 1, At, B1); PG8_BAR; PG8_SCHED;
            PG8_LDB(B0, 1, 0); PG8_LDB(B1, 1, 1); PG8_SCHED; PG8_LDA(At, 1, 0); PG8_STAGE_A(PG8_SA(0, 1), ka2, sel, 1);
            PG8_WAIT_V(8); PG8_WAIT_L(0); PG8_BAR; PG8_MMA(0, 0, At, B0); PG8_MMA(0, 1, At, B1); PG8_BAR; PG8_SCHED;
            PG8_LDA(At, 1, 1); PG8_STAGE_B(PG8_SB(1, 0), b3); PG8_STAGE_B(PG8_SB(1, 1), b3 + hstep); PG8_STAGE_A(PG8_SA(1, 0), ka3, sel, 0);
            PG8_WAIT_V(8); PG8_WAIT_L(0); PG8_BAR; PG8_MMA(1, 0, At, B0); PG8_MMA(1, 1, At, B1); PG8_BAR; PG8_SCHED;
        }
        if (wr == 0) PG8_BAR;
        { int t2 = threadIdx.x; asm volatile("" : "+v"(t2)); E(acc, cur, wr, wc, t2 & 15, (t2 & 63) >> 4, (const LAS float*)(lds + LDS_BIAS + (ui % 3) * 1024)); }
        if (!has_next) break;
        { int t3 = threadIdx.x; asm volatile("" : "+v"(t3)); E.init(acc, wc, (t3 & 63) >> 4, (const LAS float*)(lds + LDS_BIAS + ((ui + 1) % 3) * 1024)); }
        cur = nxt; cB = nB; ++ui;
        rg[0] = rg[4]; rg[1] = rg[5]; rg[2] = rg[6]; rg[3] = rg[7];
        if constexpr (FP8) { aofs[0] = aofs[4 * NTHR]; aofs[NTHR] = aofs[5 * NTHR]; aofs[2 * NTHR] = aofs[6 * NTHR]; aofs[3 * NTHR] = aofs[7 * NTHR]; }
        if (wr == 1) PG8_BAR;
    }
    PG8_WAIT_V(0);
    PG8_BAR;
#undef PG8_BIAS_DMA
#undef PG8_SA
#undef PG8_SB
#undef PG8_STAGE_A
#undef PG8_OFS
#undef PG8_STAGE_B
#undef PG8_LDA
#undef PG8_LDB
#undef PG8_MMA
#undef PG8_WAIT_V
#undef PG8_WAIT_L
#undef PG8_BAR
#undef PG8_SCHED
}
}

struct DenseUnit { int pm, pn; };
struct DenseSched {
    typedef DenseUnit Unit;
    const char* Bt; int K, nM, nN, vc;
    __device__ __forceinline__ bool next(int i, Unit& u) const { return pg8::tile_order(i, gridDim.x, vc, nM, nN, u.pm, u.pn); }
    __device__ __forceinline__ void a_off(const Unit& u, int R0, int C0, int R1, int C1, unsigned (&off)[2][2]) const {
#pragma unroll
        for (int h = 0; h < 2; ++h) { off[h][0] = (unsigned)((u.pm * 256 + h * 128 + R0) * K + C0) * 2u; off[h][1] = (unsigned)((u.pm * 256 + h * 128 + R1) * K + C1) * 2u; }
    }
    __device__ __forceinline__ const char* b_ptr(const Unit& u) const { return Bt + (size_t)u.pn * 256 * K * 2; }
};
struct MoeUnit { int rbt, e, pn; };
template <bool GATHER>
struct MoeSched {
    typedef MoeUnit Unit;
    static constexpr int KP = 512;
    const char* Bt; const int* lists; const int* ptile; const int* ecnt; int nN, nrows, vc;
    __device__ __forceinline__ bool next(int i, Unit& u) const {
        int pm, pn; if (!pg8::tile_order(i, gridDim.x, vc, ptile[NE], nN, pm, pn)) return false;
        int e = 0; while (ptile[e + 1] <= pm) ++e;
        u.rbt = pm; u.e = e; u.pn = pn; return true;
    }
    __device__ __forceinline__ void a_off(const Unit& u, int R0, int C0, int R1, int C1, unsigned (&off)[2][2]) const {
        if (GATHER) {
            const int* lst = lists + (size_t)u.e * LIST_CAP; const int rb = u.rbt - ptile[u.e], cnt = ecnt[u.e];
#pragma unroll
            for (int h = 0; h < 2; ++h) {
                const int l0 = rb * 256 + h * 128 + R0, l1 = rb * 256 + h * 128 + R1;
                const int t0 = l0 < cnt ? (lst[l0] >> 2) : 0, t1 = l1 < cnt ? (lst[l1] >> 2) : 0;
                off[h][0] = (unsigned)(t0 * KP + C0) * 2u; off[h][1] = (unsigned)(t1 * KP + C1) * 2u;
            }
        } else {
#pragma unroll
            for (int h = 0; h < 2; ++h) { off[h][0] = (unsigned)((u.rbt * 256 + h * 128 + R0) * KP + C0) * 2u; off[h][1] = (unsigned)((u.rbt * 256 + h * 128 + R1) * KP + C1) * 2u; }
        }
    }
    __device__ __forceinline__ const char* b_ptr(const Unit& u) const { return Bt + ((size_t)u.e * nrows + (size_t)u.pn * 256) * KP * 2; }
};

struct EpiInProj {
    const Params* p; int l;
    __device__ __forceinline__ const float* bias_ptr(const DenseUnit& u) const { return p->binp + l * NPAD + u.pn * 256; }
    __device__ __forceinline__ void init(f32x4 (&acc)[2][2][4][2], int wc, int fq, const LAS float* bias) const {
#pragma unroll
        for (int bj = 0; bj < 2; ++bj)
#pragma unroll
            for (int n = 0; n < 2; ++n) {
                const f32x4 bv = *(const LAS f32x4*)(bias + bj * 128 + wc * 32 + n * 16 + 4 * fq);
#pragma unroll
                for (int ai = 0; ai < 2; ++ai)
#pragma unroll
                    for (int m = 0; m < 4; ++m) acc[ai][bj][m][n] = bv;
            }
    }
    __device__ __forceinline__ void operator()(const f32x4 (&acc)[2][2][4][2], const DenseUnit& u, int wr, int wc, int fr, int fq, const LAS float*) const {
#pragma unroll
        for (int bj = 0; bj < 2; ++bj) {
            int kind = 0, hb0 = 0;
            if (u.pn == 1) { kind = 1; hb0 = bj * 2; } else if (u.pn == 4 && bj == 1) { kind = 1; hb0 = 4; } else if (u.pn == 8 && bj == 0) { kind = 1; hb0 = 6; } else if (u.pn == 9 && bj == 0) { kind = 1; hb0 = 8; }
            else if (u.pn == 2) { kind = 2; hb0 = bj * 2; } else if (u.pn == 5 && bj == 0) { kind = 2; hb0 = 4; } else if (u.pn == 8 && bj == 1) { kind = 2; hb0 = 6; } else if (u.pn == 9 && bj == 1) { kind = 2; hb0 = 8; }
            const int c0 = wc * 32 + fq * 8;
            const int hh = hb0 + (c0 >> 6), d0 = c0 & 63;
#pragma unroll
            for (int ai = 0; ai < 2; ++ai)
#pragma unroll
                for (int m = 0; m < 4; ++m) {
                    const int row = u.pm * 256 + ai * 128 + wr * 64 + m * 16 + fr;
                    const f32x4 v0 = acc[ai][bj][m][0], v1 = acc[ai][bj][m][1];
                    u32x4 w; w.x = pack2(v0[0], v0[1]); w.y = pack2(v0[2], v0[3]); w.z = pack2(v1[0], v1[1]); w.w = pack2(v1[2], v1[3]);
                    if (kind == 0) *(u32x4*)(p->hb + (size_t)row * NMAIN + u.pn * 256 + bj * 128 + c0) = w;
                    else {
                        const int b = row >> 11, s = row & 2047, kk = s & 31;
                        bf16_t* blk = (kind == 1 ? p->kF : p->vT) + (((size_t)b * NVH + hh) * 64 + (s >> 5)) * 2048;
                        if (kind == 1) {
                            const int frk = (kk >> 3) * 4 + (kk & 3), t = (kk >> 2) & 1;
                            *(u32x4*)(blk + ((t * 2 + (d0 >> 5)) * 64 + ((d0 & 31) >> 3) * 16 + frk) * 8) = w;
                        } else {
                            bf16_t* vt = blk + (((d0 >> 4) * 64) + (kk >> 3) * 16 + (d0 & 15)) * 8 + (kk & 7);
                            vt[0] = (bf16_t)(w.x & 0xffff); vt[8] = (bf16_t)(w.x >> 16); vt[16] = (bf16_t)(w.y & 0xffff); vt[24] = (bf16_t)(w.y >> 16);
                            vt[32] = (bf16_t)(w.z & 0xffff); vt[40] = (bf16_t)(w.z >> 16); vt[48] = (bf16_t)(w.w & 0xffff); vt[56] = (bf16_t)(w.w >> 16);
                        }
                    }
                }
        }
    }
};
struct EpiOutProj {
    const float* xin; float* t;
    __device__ __forceinline__ const float* bias_ptr(const DenseUnit&) const { return nullptr; }
    __device__ __forceinline__ void init(f32x4 (&acc)[2][2][4][2], int, int, const LAS float*) const {
#pragma unroll
        for (int ai = 0; ai < 2; ++ai)
#pragma unroll
            for (int bj = 0; bj < 2; ++bj)
#pragma unroll
                for (int m = 0; m < 4; ++m)
#pragma unroll
                    for (int n = 0; n < 2; ++n) acc[ai][bj][m][n] = (f32x4){0.f, 0.f, 0.f, 0.f};
    }
    __device__ __forceinline__ void operator()(const f32x4 (&acc)[2][2][4][2], const DenseUnit& u, int wr, int wc, int fr, int fq, const LAS float*) const {
#pragma unroll
        for (int ai = 0; ai < 2; ++ai)
#pragma unroll
            for (int m = 0; m < 4; ++m) {
                const size_t off = (size_t)(u.pm * 256 + ai * 128 + wr * 64 + m * 16 + fr) * DM + u.pn * 256 + wc * 64 + fq * 16;
                unsigned w[8];
#pragma unroll
                for (int q = 0; q < 4; ++q) {
                    const f32x4 xv = *(const f32x4*)(xin + off + q * 4);
                    const f32x4 tv = xv * ALPHA + acc[ai][q >> 1][m][q & 1];
                    w[2 * q] = pack2(tv[0], tv[1]); w[2 * q + 1] = pack2(tv[2], tv[3]);
                }
                u32x4 w0, w1; w0.x = w[0]; w0.y = w[1]; w0.z = w[2]; w0.w = w[3]; w1.x = w[4]; w1.y = w[5]; w1.z = w[6]; w1.w = w[7];
                *(u32x4*)((bf16_t*)t + off) = w0; *(u32x4*)((bf16_t*)t + off + 8) = w1;
            }
    }
};
struct EpiGateUp {
    bf16_t* act; const float* bgup;
    __device__ __forceinline__ const float* bias_ptr(const MoeUnit& u) const { return bgup + (size_t)u.e * 2048 + u.pn * 256; }
    __device__ __forceinline__ void init(f32x4 (&acc)[2][2][4][2], int wc, int fq, const LAS float* bias) const {
#pragma unroll
        for (int bj = 0; bj < 2; ++bj)
#pragma unroll
            for (int n = 0; n < 2; ++n) {
                const f32x4 bv = *(const LAS f32x4*)(bias + bj * 128 + wc * 32 + n * 16 + 4 * fq);
#pragma unroll
                for (int ai = 0; ai < 2; ++ai)
#pragma unroll
                    for (int m = 0; m < 4; ++m) acc[ai][bj][m][n] = bv;
            }
    }
    __device__ __forceinline__ void operator()(const f32x4 (&acc)[2][2][4][2], const MoeUnit& u, int wr, int wc, int fr, int fq, const LAS float*) const {
        constexpr float GMIN = 7.0f * GATE_PRE, CI = 1.0f / GATE_PRE;
#pragma unroll
        for (int ai = 0; ai < 2; ++ai)
#pragma unroll
            for (int m = 0; m < 4; ++m) {
                u32x2 w;
#pragma unroll
                for (int n = 0; n < 2; ++n) {
                    const f32x4 g4 = acc[ai][0][m][n], u4 = acc[ai][1][m][n];
                    float o[4];
#pragma unroll
                    for (int j = 0; j < 4; ++j) {
                        const float gp = fmaxf(g4[j], GMIN), uu = fminf(fmaxf(u4[j], -7.0f), 7.0f);
                        const float glu = gp * __builtin_amdgcn_rcpf(1.0f + __builtin_amdgcn_exp2f(gp));
                        o[j] = __builtin_fmaf(uu, CI, CI) * glu;
                    }
                    const unsigned pk = pack4_fp8(o[0], o[1], o[2], o[3]);
                    if (n == 0) w.x = pk; else w.y = pk;
                }
                *(u32x2*)((char*)act + (size_t)(u.rbt * 256 + ai * 128 + wr * 64 + m * 16 + fr) * DFF + u.pn * 128 + wc * 32 + fq * 8) = w;
            }
    }
};
struct EpiDown {
    bf16_t* ybuf; const float* bdn;
    __device__ __forceinline__ const float* bias_ptr(const MoeUnit& u) const { return bdn + (size_t)u.e * 1024 + u.pn * 256; }
    __device__ __forceinline__ void init(f32x4 (&acc)[2][2][4][2], int wc, int fq, const LAS float* bias) const {
#pragma unroll
        for (int bj = 0; bj < 2; ++bj)
#pragma unroll
            for (int n = 0; n < 2; ++n) {
                const f32x4 bv = *(const LAS f32x4*)(bias + wc * 64 + fq * 16 + bj * 8 + n * 4);
#pragma unroll
                for (int ai = 0; ai < 2; ++ai)
#pragma unroll
                    for (int m = 0; m < 4; ++m) acc[ai][bj][m][n] = bv;
            }
    }
    __device__ __forceinline__ void operator()(const f32x4 (&acc)[2][2][4][2], const MoeUnit& u, int wr, int wc, int fr, int fq, const LAS float*) const {
#pragma unroll
        for (int ai = 0; ai < 2; ++ai)
#pragma unroll
            for (int m = 0; m < 4; ++m) {
                u32x4 w;
                { const f32x4 v = acc[ai][0][m][0]; w.x = pack4_fp8(v[0], v[1], v[2], v[3]); }
                { const f32x4 v = acc[ai][0][m][1]; w.y = pack4_fp8(v[0], v[1], v[2], v[3]); }
                { const f32x4 v = acc[ai][1][m][0]; w.z = pack4_fp8(v[0], v[1], v[2], v[3]); }
                { const f32x4 v = acc[ai][1][m][1]; w.w = pack4_fp8(v[0], v[1], v[2], v[3]); }
                *(u32x4*)((unsigned char*)ybuf + (size_t)(u.rbt * 256 + ai * 128 + wr * 64 + m * 16 + fr) * DM + u.pn * 256 + wc * 64 + fq * 16) = w;
            }
    }
};

__device__ __forceinline__ void phase_inproj(const Params& p, int l, char* lds) {
    DenseSched S{(const char*)p.WinQ + (size_t)l * NMAIN * 1024, 512, NTOK / 256, NMAIN / 256, vcu_id()};
    EpiInProj E{&p, l};
    pg8::gemm_phase<true, 0x7c7c7c7c>((LAS unsigned char*)lds, (const char*)p.xq, 512, S, E);
    int tid = threadIdx.x; asm volatile("" : "+v"(tid));
    const int wid = tid >> 6, lane = tid & 63, fr = lane & 15, fq = lane >> 4;
    const bf16_t* W = p.WinT + ((size_t)l * NPAD + NMAIN) * 1024;
    const float* bias = p.binp + l * NPAD + NMAIN;
    for (int u = blockIdx.x * NWV + wid; u < NTOK / 16; u += gridDim.x * NWV) {
        const bf16_t* ar = p.xb + (size_t)(u * 16 + fr) * DM + fq * 8;
        const bf16_t* w0 = W + (size_t)fr * 1024 + fq * 8; const bf16_t* w1 = W + (size_t)(16 + fr) * 1024 + fq * 8;
        f32x4 a0 = (f32x4){0.f, 0.f, 0.f, 0.f}, a1 = a0;
#pragma unroll 4
        for (int ks = 0; ks < 32; ++ks) {
            const bf16x8 a = *(const bf16x8*)(ar + ks * 32);
            a0 = __builtin_amdgcn_mfma_f32_16x16x32_bf16(a, *(const bf16x8*)(w0 + ks * 32), a0, 0, 0, 0);
            a1 = __builtin_amdgcn_mfma_f32_16x16x32_bf16(a, *(const bf16x8*)(w1 + ks * 32), a1, 0, 0, 0);
        }
#pragma unroll
        for (int r = 0; r < 4; ++r) {
            float* dst = p.hs + (size_t)(u * 16 + fq * 4 + r) * HS_W;
            dst[fr] = a0[r] + bias[fr];
            if (fr < 6) dst[16 + fr] = a1[r] + bias[16 + fr];
        }
    }
}
__device__ __forceinline__ void phase_outproj(const Params& p, int l, const float* xin, char* lds) {
    DenseSched S{(const char*)p.WoT + (size_t)l * 1024 * 1024, 512, NTOK / 256, 4, vcu_id()};
    EpiOutProj E{xin, p.tbuf};
    pg8::gemm_phase<true, 0x7c7c7c7c>((LAS unsigned char*)lds, (const char*)p.ob, 512, S, E);
}
__device__ __forceinline__ void build_tiles(const Params& p, int l, int* ptile, int* ecnt) {
    int tid = threadIdx.x; asm volatile("" : "+v"(tid));
    if (tid < NE) ecnt[tid] = (int)__hip_atomic_load(p.ctrl + 64 + l * NE + tid, __ATOMIC_RELAXED, __HIP_MEMORY_SCOPE_AGENT);
    __syncthreads();
    if (tid == 0) { int s = 0; for (int e = 0; e < NE; ++e) { ptile[e] = s; s += (ecnt[e] + 255) >> 8; } ptile[NE] = s; }
    __syncthreads();
}
__device__ __forceinline__ void phase_gateup(const Params& p, int l, char* lds) {
    int* ptile = (int*)(lds + LDS_TAB); int* ecnt = ptile + 40;
    build_tiles(p, l, ptile, ecnt);
    MoeSched<true> S{(const char*)p.WguT + (size_t)l * NE * 2048 * 1024, p.lists, ptile, ecnt, 8, 2048, vcu_id()};
    EpiGateUp E{p.act, p.bgup + (size_t)l * NE * 2048};
    pg8::gemm_phase<true, 0x7c7c7c7c>((LAS unsigned char*)lds, (const char*)p.x1b, 512, S, E);
}
__device__ __forceinline__ void phase_down(const Params& p, int l, char* lds) {
    int* ptile = (int*)(lds + LDS_TAB); int* ecnt = ptile + 40;
    build_tiles(p, l, ptile, ecnt);
    MoeSched<false> S{(const char*)p.WdnT + (size_t)l * NE * 1024 * 1024, p.lists, ptile, ecnt, 4, 1024, vcu_id()};
    EpiDown E{p.ybuf, p.b_dn + (size_t)l * NE * 1024};
    pg8::gemm_phase<true, 0x7c7c7c7c>((LAS unsigned char*)lds, (const char*)p.act, 512, S, E);
}

__device__ __forceinline__ float gelu_tanh(float x) {
    const float u = 0.7978845608028654f * (x + 0.044715f * x * x * x);
    const float e = __expf(-2.0f * fabsf(u)); const float th = (1.0f - e) / (1.0f + e);
    return 0.5f * x * (1.0f + (u < 0.f ? -th : th));
}
__device__ __forceinline__ void phase_prep(const Params& p, int l, char* lds) {
    int tid = threadIdx.x; asm volatile("" : "+v"(tid));
    const int wid = tid >> 6, lane = tid & 63, fr = lane & 15, fq = lane >> 4;
    const int gw = blockIdx.x * NWV + wid, nw = gridDim.x * NWV;
    for (int u = (int)gridDim.x - 1 - (int)blockIdx.x; u < NB * 4; u += gridDim.x) {
        const int b = u >> 2, h = u & 3;
        const float* srcp = p.hs + ((size_t)b * SEQ + tid * 4) * HS_W + h;
        float ls[4]; float tot = 0.f;
#pragma unroll
        for (int i = 0; i < 4; ++i) { const float f = srcp[(size_t)i * HS_W]; ls[i] = fminf(f, 0.f) - log1pf(__expf(-fabsf(f))); tot += ls[i]; }
        float inc = tot;
#pragma unroll
        for (int o = 1; o < 64; o <<= 1) { const float v = shfl_f(inc, lane - o); if (lane >= o) inc += v; }
        float* wtot = (float*)(lds + 65536);
        if (lane == 63) wtot[wid] = inc;
        __syncthreads();
        float base = inc - tot;
        for (int w = 0; w < wid; ++w) base += wtot[w];
        float4 o4; o4.x = base + ls[0]; o4.y = o4.x + ls[1]; o4.z = o4.y + ls[2]; o4.w = o4.z + ls[3];
        *(float4*)(p.cF + (size_t)u * SEQ + tid * 4) = o4;
        __syncthreads();
    }
    float* part = (float*)lds;
    bf16_t* h1 = (bf16_t*)(lds + 32768);
    for (int u = blockIdx.x; u < NB * 2 * 2 * 8; u += gridDim.x) {
        const int ct = u & 7, which = (u >> 3) & 1, kvh = (u >> 4) & 1, b = u >> 5;
        const int colo = (which ? C_NVC : C_NKC) + kvh * 64;
        const int c_lane = ct * 16 + fr;
        const int tokbase = min(c_lane, 126) * 16;
        const bf16_t* arow = p.hb + ((size_t)b * SEQ + tokbase) * NMAIN + colo + fq * 8;
        const bf16_t* w1 = p.W1T + ((size_t)(l * 2 + which) * 64 + fr) * 2048 + fq * 8;
        f32x4 acc[4];
#pragma unroll
        for (int n = 0; n < 4; ++n) acc[n] = (f32x4){0.f, 0.f, 0.f, 0.f};
#pragma unroll
        for (int kk = 0; kk < 8; ++kk) {
            const int ks = wid * 8 + kk;
            const bf16x8 a = *(const bf16x8*)(arow + (size_t)(ks >> 1) * NMAIN + (ks & 1) * 32);
#pragma unroll
            for (int n = 0; n < 4; ++n) {
                const bf16x8 bb = *(const bf16x8*)(w1 + (size_t)n * 16 * 2048 + ks * 32);
                acc[n] = __builtin_amdgcn_mfma_f32_16x16x32_bf16(a, bb, acc[n], 0, 0, 0);
            }
        }
#pragma unroll
        for (int n = 0; n < 4; ++n)
#pragma unroll
            for (int r = 0; r < 4; ++r) part[wid * 1024 + (fq * 4 + r) * 64 + n * 16 + fr] = acc[n][r];
        __syncthreads();
        const float* b1 = p.b1c + (l * 2 + which) * 64;
#pragma unroll
        for (int i = 0; i < 2; ++i) {
            const int e = tid + NTHR * i; float sum = 0.f;
#pragma unroll
            for (int w = 0; w < 8; ++w) sum += part[w * 1024 + e];
            h1[e] = f2bf(gelu_tanh(sum + b1[e & 63]));
        }
        __syncthreads();
        if (wid == 0) {
            const bf16_t* w2 = p.W2T + ((size_t)(l * 2 + which) * 64 + fr) * 64 + fq * 8;
            f32x4 o2[4];
#pragma unroll
            for (int n = 0; n < 4; ++n) o2[n] = (f32x4){0.f, 0.f, 0.f, 0.f};
#pragma unroll
            for (int ks = 0; ks < 2; ++ks) {
                const bf16x8 a = *(const bf16x8*)(h1 + fr * 64 + ks * 32 + fq * 8);
#pragma unroll
                for (int n = 0; n < 4; ++n) {
                    const bf16x8 bb = *(const bf16x8*)(w2 + (size_t)n * 16 * 64 + ks * 32);
                    o2[n] = __builtin_amdgcn_mfma_f32_16x16x32_bf16(a, bb, o2[n], 0, 0, 0);
                }
            }
            const size_t base = ((size_t)b * 2 + kvh) * 128 * 64;
#pragma unroll
            for (int n = 0; n < 4; ++n)
#pragma unroll
                for (int r = 0; r < 4; ++r) {
                    const int c = ct * 16 + fq * 4 + r, j2 = n * 16 + fr;
                    const bf16_t v = c < 127 ? f2bf(o2[n][r]) : (bf16_t)0;
                    if (which == 0) p.kc[base + (size_t)c * 64 + j2] = v;
                    else { p.vc[base + (size_t)c * 64 + j2] = v; p.vcT[base + (size_t)j2 * 128 + c] = v; }
                }
        }
        __syncthreads();
    }
}

constexpr float L2E = 1.4426950408889634f, MASKV = -__builtin_huge_valf(), MINIT = -1e30f, SCL2 = QSCALE * L2E;
struct KVFrag { bf16x8 k[2][2]; bf16x8 v[4]; };
template <bool FM>
__device__ __forceinline__ void k_load(KVFrag& f, const bf16_t* __restrict__ Kb, size_t ldk, int kc0, int fr, int fq) {
    if (FM) {
        const bf16_t* kp = Kb + (size_t)(kc0 >> 5) * 2048 + (fq * 16 + fr) * 8;
        f.k[0][0] = *(const bf16x8*)(kp); f.k[0][1] = *(const bf16x8*)(kp + 512); f.k[1][0] = *(const bf16x8*)(kp + 1024); f.k[1][1] = *(const bf16x8*)(kp + 1536);
    } else {
        const bf16_t* kp = Kb + (size_t)(kc0 + (fr >> 2) * 8 + (fr & 3)) * ldk + fq * 8;
        f.k[0][0] = *(const bf16x8*)(kp); f.k[0][1] = *(const bf16x8*)(kp + 32);
        f.k[1][0] = *(const bf16x8*)(kp + 4 * ldk); f.k[1][1] = *(const bf16x8*)(kp + 4 * ldk + 32);
    }
}
template <bool FM>
__device__ __forceinline__ void v_load(bf16x8 (&v)[4], const bf16_t* __restrict__ VTb, size_t ldv, int kc0, int fr, int fq) {
    if (FM) {
        const bf16_t* vp = VTb + (size_t)(kc0 >> 5) * 2048 + (fq * 16 + fr) * 8;
#pragma unroll
        for (int dt = 0; dt < 4; ++dt) v[dt] = *(const bf16x8*)(vp + dt * 512);
    } else {
        const bf16_t* vp = VTb + (size_t)fr * ldv + kc0 + fq * 8;
#pragma unroll
        for (int dt = 0; dt < 4; ++dt) v[dt] = *(const bf16x8*)(vp + (size_t)dt * 16 * ldv);
    }
}
__device__ __forceinline__ float rowmax4(float x) {
    auto r = __builtin_amdgcn_permlane32_swap(__float_as_uint(x), __float_as_uint(x), false, false);
    x = fmaxf(__uint_as_float(r[0]), __uint_as_float(r[1]));
    auto q = __builtin_amdgcn_permlane16_swap(__float_as_uint(x), __float_as_uint(x), false, false);
    return fmaxf(__uint_as_float(q[0]), __uint_as_float(q[1]));
}
__device__ __forceinline__ float rowsum4(float x) {
    auto r = __builtin_amdgcn_permlane32_swap(__float_as_uint(x), __float_as_uint(x), false, false);
    x = __uint_as_float(r[0]) + __uint_as_float(r[1]);
    auto q = __builtin_amdgcn_permlane16_swap(__float_as_uint(x), __float_as_uint(x), false, false);
    return __uint_as_float(q[0]) + __uint_as_float(q[1]);
}
template <int NQT, bool MASK, class MB>
__device__ __forceinline__ void attn_compute(const KVFrag& f, const bf16x8 (&qf)[NQT][2], f32x4 (&o)[NQT][4], float (&m)[NQT], float (&l)[NQT], const MB& mb) {
    f32x4 s0[NQT], s1[NQT];
#pragma unroll
    for (int qt = 0; qt < NQT; ++qt) {
        s0[qt] = __builtin_amdgcn_mfma_f32_16x16x32_bf16(f.k[0][0], qf[qt][0], (f32x4){0.f, 0.f, 0.f, 0.f}, 0, 0, 0);
        s1[qt] = __builtin_amdgcn_mfma_f32_16x16x32_bf16(f.k[1][0], qf[qt][0], (f32x4){0.f, 0.f, 0.f, 0.f}, 0, 0, 0);
    }
#pragma unroll
    for (int qt = 0; qt < NQT; ++qt) {
        s0[qt] = __builtin_amdgcn_mfma_f32_16x16x32_bf16(f.k[0][1], qf[qt][1], s0[qt], 0, 0, 0);
        s1[qt] = __builtin_amdgcn_mfma_f32_16x16x32_bf16(f.k[1][1], qf[qt][1], s1[qt], 0, 0, 0);
    }
    float mx[NQT];
#pragma unroll
    for (int qt = 0; qt < NQT; ++qt) {
#pragma unroll
        for (int j = 0; j < 4; ++j) { s0[qt][j] = mb(qt, j, s0[qt][j]); s1[qt][j] = mb(qt, j + 4, s1[qt][j]); }
        mx[qt] = fmaxf(fmaxf(fmaxf(s0[qt][0], s0[qt][1]), fmaxf(s0[qt][2], s0[qt][3])), fmaxf(fmaxf(s1[qt][0], s1[qt][1]), fmaxf(s1[qt][2], s1[qt][3])));
    }
#pragma unroll
    for (int qt = 0; qt < NQT; ++qt) mx[qt] = rowmax4(mx[qt]);
    bool moved = false;
#pragma unroll
    for (int qt = 0; qt < NQT; ++qt) { mx[qt] = fmaxf(m[qt], mx[qt]); moved |= (mx[qt] != m[qt]); }
    if (__ballot(moved) != 0ull) {
#pragma unroll
        for (int qt = 0; qt < NQT; ++qt) {
            const float alpha = __builtin_amdgcn_exp2f(m[qt] - mx[qt]);
            l[qt] *= alpha;
#pragma unroll
            for (int dt = 0; dt < 4; ++dt) o[qt][dt] *= alpha;
        }
    }
    bf16x8 pf[NQT];
#pragma unroll
    for (int qt = 0; qt < NQT; ++qt) {
        m[qt] = mx[qt];
        float pr[8]; float ps = 0.f;
#pragma unroll
        for (int j = 0; j < 4; ++j) {
            pr[j] = __builtin_amdgcn_exp2f(s0[qt][j] - mx[qt]);
            pr[j + 4] = __builtin_amdgcn_exp2f(s1[qt][j] - mx[qt]);
        }
#pragma unroll
        for (int j = 0; j < 8; ++j) ps += pr[j];
        l[qt] += ps;
        const u32x4 pk = {pack2(pr[0], pr[1]), pack2(pr[2], pr[3]), pack2(pr[4], pr[5]), pack2(pr[6], pr[7])};
        pf[qt] = __builtin_bit_cast(bf16x8, pk);
    }
#pragma unroll
    for (int dt = 0; dt < 4; ++dt)
#pragma unroll
        for (int qt = 0; qt < NQT; ++qt) o[qt][dt] = __builtin_amdgcn_mfma_f32_16x16x32_bf16(f.v[dt], pf[qt], o[qt][dt], 0, 0, 0);
    __builtin_amdgcn_sched_barrier(0);
}
struct RangeIt { int c, c_hi; __device__ __forceinline__ int nxt() { if (c > c_hi) return -1; return (c++) * 32; } };
struct MaskIt { unsigned long long cm; __device__ __forceinline__ int nxt() { if (!cm) return -1; const int i = __builtin_ctzll(cm); cm &= cm - 1; return i * 32; } };
template <bool PFV, bool FM, class It, class Gen>
__device__ __forceinline__ void attn_run(It& it, const bf16_t* Kb, size_t ldk, const bf16_t* VTb, size_t ldv, int fr, int fq, const Gen& gen) {
    KVFrag fa, fb;
    int ka = it.nxt(); if (ka < 0) return;
    k_load<FM>(fa, Kb, ldk, ka, fr, fq); if (PFV) v_load<FM>(fa.v, VTb, ldv, ka, fr, fq);
    for (;;) {
        const int kb = it.nxt(); if (kb >= 0) { k_load<FM>(fb, Kb, ldk, kb, fr, fq); if (PFV) v_load<FM>(fb.v, VTb, ldv, kb, fr, fq); }
        if (!PFV) v_load<FM>(fa.v, VTb, ldv, ka, fr, fq);
        gen(ka, fa);
        if (kb < 0) break;
        ka = it.nxt(); if (ka >= 0) { k_load<FM>(fa, Kb, ldk, ka, fr, fq); if (PFV) v_load<FM>(fa.v, VTb, ldv, ka, fr, fq); }
        if (!PFV) v_load<FM>(fb.v, VTb, ldv, kb, fr, fq);
        gen(kb, fb);
        if (ka < 0) break;
    }
}
template <int NQT>
__device__ __forceinline__ void attn_init(f32x4 (&o)[NQT][4], float (&m)[NQT], float (&l)[NQT]) {
#pragma unroll
    for (int qt = 0; qt < NQT; ++qt) { m[qt] = MINIT; l[qt] = 0.f;
#pragma unroll
        for (int dt = 0; dt < 4; ++dt) o[qt][dt] = (f32x4){0.f, 0.f, 0.f, 0.f}; }
}
__device__ __forceinline__ float lsum4(float l) { return rowsum4(l); }
__device__ __forceinline__ void store_o4(unsigned char* dst, const f32x4 v) { *(unsigned*)dst = pack4_fp8(v[0], v[1], v[2], v[3]); }
__device__ __forceinline__ float sigmoidf_fast(float x) { return __builtin_amdgcn_rcpf(1.0f + __builtin_amdgcn_exp2f(-L2E * x)); }

__device__ __forceinline__ void fox_unit(const Params& p, int b, int h, int qb, int fr, int fq) {
    asm volatile("" : "+v"(fr), "+v"(fq));
    const int t0 = qb * 64;
    const bf16_t* Qb = p.hb + ((size_t)b * SEQ + t0) * NMAIN + C_FQ + h * 64 + fq * 8;
    bf16x8 qf[4][2];
#pragma unroll
    for (int qt = 0; qt < 4; ++qt) { qf[qt][0] = *(const bf16x8*)(Qb + (size_t)(qt * 16 + fr) * NMAIN); qf[qt][1] = *(const bf16x8*)(Qb + (size_t)(qt * 16 + fr) * NMAIN + 32); }
    const float* cf = p.cF + ((size_t)b * 4 + h) * SEQ;
    float cq[4];
#pragma unroll
    for (int qt = 0; qt < 4; ++qt) cq[qt] = cf[t0 + qt * 16 + fr] * L2E;
    f32x4 o[4][4]; float m[4], l[4];
    attn_init<4>(o, m, l);
    const bf16_t* Kb = p.kF + ((size_t)b * NVH + h) * 64 * SEQ;
    const bf16_t* VTb = p.vT + ((size_t)b * NVH + h) * 64 * SEQ;
    RangeIt it{0, (t0 >> 5) + 1};
    attn_run<false, true>(it, Kb, NMAIN, VTb, SEQ, fr, fq, [&](int kc0, const KVFrag& f) {
        const float4 ca = *(const float4*)(cf + kc0 + 8 * fq), cb = *(const float4*)(cf + kc0 + 8 * fq + 4);
        const float ck[8] = {ca.x * L2E, ca.y * L2E, ca.z * L2E, ca.w * L2E, cb.x * L2E, cb.y * L2E, cb.z * L2E, cb.w * L2E};
        const int kq = kc0 + 8 * fq - t0 - fr;
        attn_compute<4, true>(f, qf, o, m, l, [&](int qt, int j, float raw) { return (kq + j - 16 * qt) > 0 ? MASKV : raw * SCL2 + cq[qt] - ck[j]; });
    });
#pragma unroll
    for (int qt = 0; qt < 4; ++qt) {
        const float inv = __builtin_amdgcn_rcpf(lsum4(l[qt]));
        unsigned char* dst = (unsigned char*)p.ob + ((size_t)b * SEQ + t0 + qt * 16 + fr) * DM + h * 64 + 4 * fq;
#pragma unroll
        for (int dt = 0; dt < 4; ++dt) store_o4(dst + dt * 16, o[qt][dt] * inv);
    }
}
__device__ __forceinline__ void swa_unit(const Params& p, int l_, int b, int kv, int pos, int fr, int fq) {
    asm volatile("" : "+v"(fr), "+v"(fq));
    const int t0 = pos * 16, t = t0 + fr;
    const bf16_t* Qb = p.hb + ((size_t)b * SEQ + t) * NMAIN + C_SQ + kv * 192 + fq * 8;
    bf16x8 qf[3][2];
#pragma unroll
    for (int g = 0; g < 3; ++g) { qf[g][0] = *(const bf16x8*)(Qb + g * 64); qf[g][1] = *(const bf16x8*)(Qb + g * 64 + 32); }
    float sl[3];
#pragma unroll
    for (int g = 0; g < 3; ++g) sl[g] = slope_swa(kv * 3 + g) * L2E;
    f32x4 o[3][4]; float m[3], l[3];
    attn_init<3>(o, m, l);
    const bf16_t* Kb = p.kF + ((size_t)b * NVH + 4 + kv) * 64 * SEQ;
    const bf16_t* VTb = p.vT + ((size_t)b * NVH + 4 + kv) * 64 * SEQ;
    RangeIt it{max(0, t0 - 127) >> 5, (t0 + 15) >> 5};
    attn_run<true, true>(it, Kb, NMAIN, VTb, SEQ, fr, fq, [&](int kc0, const KVFrag& f) {
        const int dq = t - kc0 - 8 * fq;
        attn_compute<3, true>(f, qf, o, m, l, [&](int g, int j, float raw) { const int dist = dq - j; return ((unsigned)dist < 128u) ? raw * SCL2 - sl[g] * (float)dist : MASKV; });
    });
#pragma unroll
    for (int g = 0; g < 3; ++g) {
        const float sink = p.sinks[l_ * 6 + kv * 3 + g] * L2E;
        const float inv = __builtin_amdgcn_rcpf(lsum4(l[g]) + __builtin_amdgcn_exp2f(sink - m[g]));
        unsigned char* dst = (unsigned char*)p.ob + ((size_t)b * SEQ + t) * DM + 256 + (kv * 3 + g) * 64 + 4 * fq;
#pragma unroll
        for (int dt = 0; dt < 4; ++dt) store_o4(dst + dt * 16, o[g][dt] * inv);
    }
}
__device__ __forceinline__ void nsa_unit(const Params& p, int b, int kv, int pos, int fr, int fq, int lane, float* ps, unsigned* msk, float* otl) {
    asm volatile("" : "+v"(fr), "+v"(fq), "+v"(lane));
    const int t0 = pos * 16, t = t0 + fr, cur = t0 >> 6;
    const bf16_t* Qb = p.hb + ((size_t)b * SEQ + t) * NMAIN + C_NQ + kv * 192 + fq * 8;
    bf16x8 qf[3][2];
#pragma unroll
    for (int g = 0; g < 3; ++g) { qf[g][0] = *(const bf16x8*)(Qb + g * 64); qf[g][1] = *(const bf16x8*)(Qb + g * 64 + 32); }
    float sl[3];
#pragma unroll
    for (int g = 0; g < 3; ++g) sl[g] = slope_nsa(kv * 3 + g) * L2E;
    const float* gl = p.hs + ((size_t)b * SEQ + t) * HS_W + 4 + kv * 9;
    f32x4 o[3][4]; float m[3], l[3];
    f32x4* otv = (f32x4*)otl + lane;
#pragma unroll
    for (int i = 0; i < 8; ++i) ps[lane + 64 * i] = 0.f;
    {
        const bf16_t* Kb = p.kc + ((size_t)b * 2 + kv) * 128 * 64;
        const bf16_t* VTb = p.vcT + ((size_t)b * 2 + kv) * 64 * 128;
        const int ncv = (t0 + 15 >= 31) ? ((t0 + 15 - 31) >> 4) + 1 : 0;
        const int nch = (ncv + 31) >> 5;
        attn_init<3>(o, m, l);
        const int dq0 = t - 31 - 16 * 8 * fq;
        RangeIt it{0, nch - 1};
        attn_run<false, false>(it, Kb, 64, VTb, 128, fr, fq, [&](int kc0, const KVFrag& f) {
            const int dq = dq0 - 16 * kc0;
            attn_compute<3, true>(f, qf, o, m, l, [&](int g, int j, float raw) { const int dist = dq - 16 * j; return dist >= 0 ? raw * SCL2 - sl[g] * (float)dist : MASKV; });
        });
        float il[3];
#pragma unroll
        for (int g = 0; g < 3; ++g) {
            const float lt = lsum4(l[g]); il[g] = lt > 0.f ? __builtin_amdgcn_rcpf(lt) : 0.f;
            const float gate = sigmoidf_fast(gl[g * 3 + 0]);
#pragma unroll
            for (int dt = 0; dt < 4; ++dt) otv[(g * 4 + dt) * 64] = o[g][dt] * (il[g] * gate);
        }
        float carry_prev = 0.f;
        for (int c = 0; c < nch; ++c) {
            const int kc0 = c * 32, dq = dq0 - 16 * kc0;
            const bf16_t* kp = Kb + (size_t)(kc0 + (fr >> 2) * 8 + (fr & 3)) * 64 + fq * 8;
            const bf16x8 k00 = *(const bf16x8*)(kp), k01 = *(const bf16x8*)(kp + 32), k10 = *(const bf16x8*)(kp + 256), k11 = *(const bf16x8*)(kp + 256 + 32);
            float pc[8];
#pragma unroll
            for (int j = 0; j < 8; ++j) pc[j] = 0.f;
#pragma unroll
            for (int g = 0; g < 3; ++g) {
                f32x4 s0 = (f32x4){0.f, 0.f, 0.f, 0.f}, s1 = s0;
                s0 = __builtin_amdgcn_mfma_f32_16x16x32_bf16(k00, qf[g][0], s0, 0, 0, 0); s0 = __builtin_amdgcn_mfma_f32_16x16x32_bf16(k01, qf[g][1], s0, 0, 0, 0);
                s1 = __builtin_amdgcn_mfma_f32_16x16x32_bf16(k10, qf[g][0], s1, 0, 0, 0); s1 = __builtin_amdgcn_mfma_f32_16x16x32_bf16(k11, qf[g][1], s1, 0, 0, 0);
#pragma unroll
                for (int j = 0; j < 8; ++j) {
                    const int dist = dq - 16 * j; const float raw = j < 4 ? s0[j] : s1[j - 4];
                    if (dist >= 0) pc[j] += __builtin_amdgcn_exp2f(raw * SCL2 - sl[g] * (float)dist - m[g]) * il[g];
                }
            }
            const float cout = 0.5f * pc[7];
            float cin = shfl_f(cout, lane - 16);
            const float cwrap = shfl_f(cout, fr + 48);
            if (fq == 0) cin = carry_prev;
            carry_prev = cwrap;
            const int n0 = (kc0 >> 2) + 2 * fq;
            ps[fr * 32 + n0] = cin + pc[0] + pc[1] + pc[2] + 0.5f * pc[3];
            ps[fr * 32 + n0 + 1] = 0.5f * pc[3] + pc[4] + pc[5] + pc[6] + 0.5f * pc[7];
        }
    }
    lds_wave_sync();
    if (lane < 16) {
        unsigned mask = 1u | (1u << cur); if (cur >= 1) mask |= 1u << (cur - 1);
        if (cur >= 3) {
            if (cur - 2 <= 5) mask |= (1u << (cur - 1)) - 2u;
            else {
                const float* my = ps + lane * 32;
                for (int r = 0; r < 5; ++r) {
                    float best = -1.0f; int bi = 1;
                    for (int j = 1; j <= cur - 2; ++j) { const float v = my[j]; if (!((mask >> j) & 1u) && v > best) { best = v; bi = j; } }
                    mask |= 1u << bi;
                }
            }
        }
        msk[lane] = mask;
    }
    lds_wave_sync();
    const unsigned qmask = msk[fr];
    lds_wave_sync();
    {
        const bf16_t* Kb = p.kF + ((size_t)b * NVH + 6 + kv) * 64 * SEQ;
        const bf16_t* VTb = p.vT + ((size_t)b * NVH + 6 + kv) * 64 * SEQ;
        attn_init<3>(o, m, l);
        unsigned um = qmask;
        um |= shfl_u(um, lane ^ 1); um |= shfl_u(um, lane ^ 2); um |= shfl_u(um, lane ^ 4); um |= shfl_u(um, lane ^ 8);
        um = (unsigned)__builtin_amdgcn_readfirstlane((int)um) & (cur >= 31 ? 0xffffffffu : ((2u << cur) - 1u));
        unsigned long long cm = 0ull;
        for (unsigned r = um; r; r &= r - 1) { const int kb = __builtin_ctz(r); cm |= 3ull << (2 * kb); }
        MaskIt it{cm};
        attn_run<true, true>(it, Kb, NMAIN, VTb, SEQ, fr, fq, [&](int kc0, const KVFrag& f) {
            const bool mine = (qmask >> (kc0 >> 6)) & 1u;
            const int dq = t - kc0 - 8 * fq;
            attn_compute<3, true>(f, qf, o, m, l, [&](int g, int j, float raw) { const int dist = dq - j; return (mine && dist >= 0) ? raw * SCL2 - sl[g] * (float)dist : MASKV; });
        });
#pragma unroll
        for (int g = 0; g < 3; ++g) {
            const float lt = lsum4(l[g]); const float sc = (lt > 0.f ? __builtin_amdgcn_rcpf(lt) : 0.f) * sigmoidf_fast(gl[g * 3 + 1]);
#pragma unroll
            for (int dt = 0; dt < 4; ++dt) otv[(g * 4 + dt) * 64] += o[g][dt] * sc;
        }
    }
    {
        const bf16_t* Kb = p.kF + ((size_t)b * NVH + 8 + kv) * 64 * SEQ;
        const bf16_t* VTb = p.vT + ((size_t)b * NVH + 8 + kv) * 64 * SEQ;
        attn_init<3>(o, m, l);
        RangeIt it{max(0, t0 - 511) >> 5, (t0 + 15) >> 5};
        attn_run<true, true>(it, Kb, NMAIN, VTb, SEQ, fr, fq, [&](int kc0, const KVFrag& f) {
            const int dq = t - kc0 - 8 * fq;
            attn_compute<3, true>(f, qf, o, m, l, [&](int g, int j, float raw) { const int dist = dq - j; return ((unsigned)dist < 512u) ? raw * SCL2 - sl[g] * (float)dist : MASKV; });
        });
#pragma unroll
        for (int g = 0; g < 3; ++g) {
            const float lt = lsum4(l[g]); const float sc = (lt > 0.f ? __builtin_amdgcn_rcpf(lt) : 0.f) * sigmoidf_fast(gl[g * 3 + 2]);
            unsigned char* dst = (unsigned char*)p.ob + ((size_t)b * SEQ + t) * DM + 640 + (kv * 3 + g) * 64 + 4 * fq;
#pragma unroll
            for (int dt = 0; dt < 4; ++dt) store_o4(dst + dt * 16, otv[(g * 4 + dt) * 64] + o[g][dt] * sc);
        }
    }
}

template <bool WITH_CONV>
__device__ __forceinline__ void phase_attn(const Params& p, int l, char* lds, int cslot = 16) {
    int tid = threadIdx.x; asm volatile("" : "+v"(tid));
    const int wid = tid >> 6, lane = tid & 63, fr = lane & 15, fq = lane >> 4;
    float* ps = (float*)(lds + wid * 16896); unsigned* msk = (unsigned*)(ps + 512); float* otl = ps + 576;
    unsigned* ctr = p.ctrl + cslot + l;
    constexpr unsigned NU_NSA = NB * 2 * 128, NU_FOX = NB * 4 * 32, NU_SWA = NB * 2 * 128, NU_ATT = NU_NSA + NU_FOX + NU_SWA;
    for (;;) {
        unsigned u = 0;
        if (lane == 0) u = __hip_atomic_fetch_add(ctr, 1u, __ATOMIC_RELAXED, __HIP_MEMORY_SCOPE_AGENT);
        u = (unsigned)__builtin_amdgcn_readfirstlane((int)u);
        if (WITH_CONV) {
            constexpr unsigned TOTQ = NU_ATT + (unsigned)CONV_TILES;
            if (u >= TOTQ) break;
            const unsigned a0 = (unsigned)(((unsigned long long)u * NU_ATT) / TOTQ), a1 = (unsigned)(((unsigned long long)(u + 1) * NU_ATT) / TOTQ);
            if (a1 == a0) { conv_tile_wave(p, (int)(u - a0), lane, (unsigned char*)ps); continue; }
            u = a0;
        } else {
#ifndef ATT_REP
#define ATT_REP 1
#endif
            if (u >= ATT_REP * NU_ATT) break;
            if (ATT_REP > 1) u %= NU_ATT;
        }
        if (u < NU_NSA) { const int pos = 127 - (int)(u & 127), r = u >> 7; nsa_unit(p, r >> 1, r & 1, pos, fr, fq, lane, ps, msk, otl); }
        else if (u < NU_NSA + NU_FOX) { const unsigned v = u - NU_NSA; const int qb = 31 - (int)(v & 31), r = v >> 5; fox_unit(p, r >> 2, r & 3, qb, fr, fq); }
        else { const unsigned v = u - NU_NSA - NU_FOX; const int pos = 127 - (int)(v & 127), r = v >> 7; swa_unit(p, l, r >> 1, r & 1, pos, fr, fq); }
    }
}

__device__ __forceinline__ void phase_ln1_router(const Params& p, int l, char* lds) {
    int tid = threadIdx.x; asm volatile("" : "+v"(tid));
    const int wid = tid >> 6, lane = tid & 63, fr = lane & 15, fq = lane >> 4;
    float* lg = (float*)lds + wid * 512;
    int* lcnt = (int*)(lds + 16384); int* lbase = lcnt + 32;
    const float* g1 = p.ln1_g + l * DM; const float* b1 = p.ln1_b + l * DM;
    const float* rw = p.rwT + (size_t)l * NE * 1024; const float* rb = p.router_b + l * NE;
    unsigned* gcount = p.ctrl + 64 + l * NE;
    for (int grp = blockIdx.x; grp < NTOK / 128; grp += gridDim.x) {
        const int tok0 = grp * 128 + wid * 16;
        if (tid < 32) lcnt[tid] = 0;
        float4 gg[4], bb[4];
#pragma unroll
        for (int j = 0; j < 4; ++j) { gg[j] = *(const float4*)(g1 + j * 256 + lane * 4); bb[j] = *(const float4*)(b1 + j * 256 + lane * 4); }
        for (int r0 = 0; r0 < 16; r0 += 4) {
            float4 v[4][4]; float s[4], qv[4];
#pragma unroll
            for (int i = 0; i < 4; ++i)
#pragma unroll
                for (int j = 0; j < 4; ++j) { const u32x2 w = *(const u32x2*)((const bf16_t*)p.tbuf + (size_t)(tok0 + r0 + i) * DM + j * 256 + lane * 4);
                    v[i][j] = make_float4(__uint_as_float(w.x << 16), __uint_as_float(w.x & 0xffff0000u), __uint_as_float(w.y << 16), __uint_as_float(w.y & 0xffff0000u)); }
#pragma unroll
            for (int i = 0; i < 4; ++i) { s[i] = 0.f;
#pragma unroll
                for (int j = 0; j < 4; ++j) s[i] += (v[i][j].x + v[i][j].y) + (v[i][j].z + v[i][j].w); }
#pragma unroll
            for (int o = 32; o > 0; o >>= 1) {
#pragma unroll
                for (int i = 0; i < 4; ++i) s[i] += shfl_f(s[i], lane ^ o); }
#pragma unroll
            for (int i = 0; i < 4; ++i) { const float mean = s[i] * (1.0f / 1024.0f); qv[i] = 0.f;
#pragma unroll
                for (int j = 0; j < 4; ++j) { v[i][j].x -= mean; v[i][j].y -= mean; v[i][j].z -= mean; v[i][j].w -= mean; qv[i] += (v[i][j].x * v[i][j].x + v[i][j].y * v[i][j].y) + (v[i][j].z * v[i][j].z + v[i][j].w * v[i][j].w); } }
#pragma unroll
            for (int o = 32; o > 0; o >>= 1) {
#pragma unroll
                for (int i = 0; i < 4; ++i) qv[i] += shfl_f(qv[i], lane ^ o); }
#pragma unroll
            for (int i = 0; i < 4; ++i) {
                const float rstd = rsqrtf(qv[i] * (1.0f / 1024.0f) + LN_EPS);
                const size_t row = (size_t)(tok0 + r0 + i);
#pragma unroll
                for (int j = 0; j < 4; ++j) {
                    const int c = j * 256 + lane * 4;
                    float4 y; y.x = v[i][j].x * rstd * gg[j].x + bb[j].x; y.y = v[i][j].y * rstd * gg[j].y + bb[j].y; y.z = v[i][j].z * rstd * gg[j].z + bb[j].z; y.w = v[i][j].w * rstd * gg[j].w + bb[j].w;
                    { u32x2 w; w.x = pack2(y.x, y.y); w.y = pack2(y.z, y.w); *(u32x2*)((bf16_t*)p.x1f + row * DM + c) = w; }
                    *(unsigned*)((char*)p.x1b + row * DM + c) = pack4_fp8(y.x, y.y, y.z, y.w);
                }
            }
        }
        __syncthreads();
        f32x4 a0 = (f32x4){0.f, 0.f, 0.f, 0.f}, a1 = a0;
        const bf16_t* xr = (const bf16_t*)p.x1f + (size_t)(tok0 + fr) * DM + 4 * fq;
        const float* w0 = rw + (size_t)fr * 1024 + 4 * fq; const float* w1 = rw + (size_t)(16 + fr) * 1024 + 4 * fq;
#pragma unroll 4
        for (int k0 = 0; k0 < 1024; k0 += 16) {
            const u32x2 xw = *(const u32x2*)(xr + k0); const float4 wb0 = *(const float4*)(w0 + k0), wb1 = *(const float4*)(w1 + k0);
            const float4 xa = make_float4(__uint_as_float(xw.x << 16), __uint_as_float(xw.x & 0xffff0000u), __uint_as_float(xw.y << 16), __uint_as_float(xw.y & 0xffff0000u));
            a0 = __builtin_amdgcn_mfma_f32_16x16x4f32(xa.x, wb0.x, a0, 0, 0, 0); a1 = __builtin_amdgcn_mfma_f32_16x16x4f32(xa.x, wb1.x, a1, 0, 0, 0);
            a0 = __builtin_amdgcn_mfma_f32_16x16x4f32(xa.y, wb0.y, a0, 0, 0, 0); a1 = __builtin_amdgcn_mfma_f32_16x16x4f32(xa.y, wb1.y, a1, 0, 0, 0);
            a0 = __builtin_amdgcn_mfma_f32_16x16x4f32(xa.z, wb0.z, a0, 0, 0, 0); a1 = __builtin_amdgcn_mfma_f32_16x16x4f32(xa.z, wb1.z, a1, 0, 0, 0);
            a0 = __builtin_amdgcn_mfma_f32_16x16x4f32(xa.w, wb0.w, a0, 0, 0, 0); a1 = __builtin_amdgcn_mfma_f32_16x16x4f32(xa.w, wb1.w, a1, 0, 0, 0);
        }
#pragma unroll
        for (int r = 0; r < 4; ++r) { lg[(fq * 4 + r) * 32 + fr] = a0[r] + rb[fr]; lg[(fq * 4 + r) * 32 + 16 + fr] = a1[r] + rb[16 + fr]; }
        lds_wave_sync();
        int e4[4] = {0, 0, 0, 0}; int rk[4] = {0, 0, 0, 0};
        if (lane < 16) {
            const float* my = lg + lane * 32; unsigned taken = 0u; float tv[4];
#pragma unroll
            for (int k = 0; k < 4; ++k) {
                float best = NEG_INF; int bi = 0;
                for (int e = 0; e < 32; ++e) { const float xv = my[e]; if (!((taken >> e) & 1u) && xv > best) { best = xv; bi = e; } }
                taken |= 1u << bi; e4[k] = bi; tv[k] = best;
            }
            const float e1 = __expf(tv[1] - tv[0]), e2 = __expf(tv[2] - tv[0]), e3 = __expf(tv[3] - tv[0]);
            const float inv = 1.0f / (1.0f + e1 + e2 + e3);
            const size_t row = (size_t)(tok0 + lane);
            *(float4*)(p.gw + row * 4) = make_float4(inv, e1 * inv, e2 * inv, e3 * inv);
        }
        __syncthreads();
        if (lane < 16) {
#pragma unroll
            for (int k = 0; k < 4; ++k) rk[k] = atomicAdd(&lcnt[e4[k]], 1);
        }
        __syncthreads();
        if (tid < 32) { const int c = lcnt[tid]; lbase[tid] = c ? (int)__hip_atomic_fetch_add(gcount + tid, (unsigned)c, __ATOMIC_RELAXED, __HIP_MEMORY_SCOPE_AGENT) : 0; }
        __syncthreads();
        if (lane < 16) {
            const int row = tok0 + lane; int pk[4];
#pragma unroll
            for (int k = 0; k < 4; ++k) { const int pos = lbase[e4[k]] + rk[k]; p.lists[(size_t)e4[k] * LIST_CAP + pos] = row * 4 + k; pk[k] = (pos << 5) | e4[k]; }
            *(int4*)(p.top_e + (size_t)row * 4) = make_int4(pk[0], pk[1], pk[2], pk[3]);
        }
        __syncthreads();
    }
}

__device__ __forceinline__ void phase_ln2(const Params& p, int l, float* xout, char* lds) {
    int* ptile = (int*)(lds + LDS_TAB); int* ecnt = ptile + 40;
    build_tiles(p, l, ptile, ecnt);
    int tid = threadIdx.x; asm volatile("" : "+v"(tid));
    const int wid = tid >> 6, lane = tid & 63;
    const float* g2 = p.ln2_g + l * DM; const float* b2 = p.ln2_b + l * DM;
    float4 gg[4], bb[4];
#pragma unroll
    for (int j = 0; j < 4; ++j) { gg[j] = *(const float4*)(g2 + j * 256 + lane * 4); bb[j] = *(const float4*)(b2 + j * 256 + lane * 4); }
    for (int pr = blockIdx.x * NWV + wid; pr < NTOK / 2; pr += gridDim.x * NWV) {
        float4 v[2][4]; float s[2], qv[2];
        unsigned yv[2][4][4]; float gk[2][4];
#pragma unroll
        for (int i = 0; i < 2; ++i) {
            const int row = pr * 2 + i;
            const float4 gwv = *(const float4*)(p.gw + (size_t)row * 4);
            gk[i][0] = gwv.x; gk[i][1] = gwv.y; gk[i][2] = gwv.z; gk[i][3] = gwv.w;
            const int4 te = *(const int4*)(p.top_e + (size_t)row * 4);
            const int tk[4] = {te.x, te.y, te.z, te.w};
#pragma unroll
            for (int j = 0; j < 4; ++j) { const u32x2 w = *(const u32x2*)((const bf16_t*)p.x1f + (size_t)row * DM + j * 256 + lane * 4);
                v[i][j] = make_float4(__uint_as_float(w.x << 16), __uint_as_float(w.x & 0xffff0000u), __uint_as_float(w.y << 16), __uint_as_float(w.y & 0xffff0000u)); }
#pragma unroll
            for (int k = 0; k < 4; ++k) {
                const unsigned char* yr = (const unsigned char*)p.ybuf + (size_t)(ptile[tk[k] & 31] * 256 + (tk[k] >> 5)) * DM + lane * 4;
#pragma unroll
                for (int j = 0; j < 4; ++j) yv[i][k][j] = *(const unsigned*)(yr + j * 256);
            }
        }
#pragma unroll
        for (int i = 0; i < 2; ++i) { s[i] = 0.f;
#pragma unroll
            for (int j = 0; j < 4; ++j) {
                float4 a; a.x = v[i][j].x * ALPHA; a.y = v[i][j].y * ALPHA; a.z = v[i][j].z * ALPHA; a.w = v[i][j].w * ALPHA;
#pragma unroll
                for (int k = 0; k < 4; ++k) {
                    const unsigned w = yv[i][k][j];
                    const f32x2_t lo = __builtin_amdgcn_cvt_pk_f32_fp8(w, false), hi = __builtin_amdgcn_cvt_pk_f32_fp8(w, true);
                    a.x += gk[i][k] * lo.x; a.y += gk[i][k] * lo.y; a.z += gk[i][k] * hi.x; a.w += gk[i][k] * hi.y;
                }
                v[i][j] = a; s[i] += (a.x + a.y) + (a.z + a.w);
            } }
#pragma unroll
        for (int o = 32; o > 0; o >>= 1) { s[0] += shfl_f(s[0], lane ^ o); s[1] += shfl_f(s[1], lane ^ o); }
#pragma unroll
        for (int i = 0; i < 2; ++i) { const float mean = s[i] * (1.0f / 1024.0f); qv[i] = 0.f;
#pragma unroll
            for (int j = 0; j < 4; ++j) { v[i][j].x -= mean; v[i][j].y -= mean; v[i][j].z -= mean; v[i][j].w -= mean; qv[i] += (v[i][j].x * v[i][j].x + v[i][j].y * v[i][j].y) + (v[i][j].z * v[i][j].z + v[i][j].w * v[i][j].w); } }
#pragma unroll
        for (int o = 32; o > 0; o >>= 1) { qv[0] += shfl_f(qv[0], lane ^ o); qv[1] += shfl_f(qv[1], lane ^ o); }
#pragma unroll
        for (int i = 0; i < 2; ++i) {
            const float rstd = rsqrtf(qv[i] * (1.0f / 1024.0f) + LN_EPS);
            const size_t row = (size_t)(pr * 2 + i);
#pragma unroll
            for (int j = 0; j < 4; ++j) {
                const int c = j * 256 + lane * 4;
                float4 y; y.x = v[i][j].x * rstd * gg[j].x + bb[j].x; y.y = v[i][j].y * rstd * gg[j].y + bb[j].y; y.z = v[i][j].z * rstd * gg[j].z + bb[j].z; y.w = v[i][j].w * rstd * gg[j].w + bb[j].w;
                *(float4*)(xout + row * DM + c) = y;
                if (l + 1 < NL) {
                    u32x2 w; w.x = pack2(y.x, y.y); w.y = pack2(y.z, y.w);
                    *(u32x2*)(p.xb + row * DM + c) = w;
                    *(unsigned*)(p.xq + row * DM + c) = pack4_fp8(y.x, y.y, y.z, y.w);
                }
            }
        }
    }
}

#define XB_TMO      128
#define XB_XCNT(j)  (256  + 64 * (j))
#define XB_XSUB(j)  (1280 + 64 * (j))
#define XB_XGEN(j)  (2304 + 64 * (j))
#define XB_TOP      3328
#define XB_TOPGEN   3392
#define XCD_BAR_WORDS 3456
#define XB_SPIN_CAP (1u << 22)
__device__ __forceinline__ unsigned xb_ld(unsigned* p)              { return __hip_atomic_load(p, __ATOMIC_RELAXED, __HIP_MEMORY_SCOPE_AGENT); }
__device__ __forceinline__ unsigned xb_add(unsigned* p, unsigned v) { return __hip_atomic_fetch_add(p, v, __ATOMIC_RELAXED, __HIP_MEMORY_SCOPE_AGENT); }
__device__ __forceinline__ unsigned xb_xcc_id() { return (unsigned)__builtin_amdgcn_s_getreg((3 << 11) | 20) & 0xFu; }
#define XB_SPIN(cond, bar) do { unsigned _sp = 0; while (cond) { __builtin_amdgcn_s_sleep(1); \
    if ((++_sp & 255u) == 0u) { if (xb_ld(&(bar)[XB_TMO])) break; if (_sp > XB_SPIN_CAP) { atomicAdd(&(bar)[XB_TMO], 1u); break; } } } } while (0)
struct XcdBarrier { unsigned* bar; unsigned x; volatile LAS unsigned* st; };
__device__ __forceinline__ XcdBarrier xcd_barrier_post(unsigned* bar, volatile LAS unsigned* st) {
    XcdBarrier b; b.bar = bar; b.x = xb_xcc_id(); b.st = st;
    if (threadIdx.x == 0) (void)xb_add(&bar[XB_XCNT(b.x)], 1u);
    return b;
}
__device__ __forceinline__ void xcd_barrier_complete(unsigned* bar, unsigned x, unsigned& nloc, unsigned& nx) {
    const unsigned G = gridDim.x * gridDim.y * gridDim.z;
    unsigned sum, cnt, mine, sp = 0u;
    for (;;) {
        sum = 0u; cnt = 0u; mine = 0u;
#pragma unroll
        for (unsigned j = 0; j < 16; ++j) { const unsigned c = xb_ld(&bar[XB_XCNT(j)]); sum += c; cnt += (c > 0u) ? 1u : 0u; mine = (j == x) ? c : mine; }
        if (sum == G) break;
        __builtin_amdgcn_s_sleep(1);
        if ((++sp & 255u) == 0u) { if (xb_ld(&bar[XB_TMO])) break; if (sp > XB_SPIN_CAP) { atomicAdd(&bar[XB_TMO], 1u); break; } }
    }
    nloc = mine > 0u ? mine : 1u; nx = cnt > 0u ? cnt : 1u;
}
__device__ __forceinline__ void xcd_barrier(const XcdBarrier& b) {
    asm volatile("s_waitcnt vmcnt(0)" ::: "memory");
    __syncthreads();
    if (threadIdx.x == 0) {
        unsigned* bar = b.bar;
        __builtin_amdgcn_s_waitcnt(0);
        unsigned nloc = b.st[0], nx = b.st[1];
        if (nloc == 0u) { xcd_barrier_complete(bar, b.x, nloc, nx); b.st[0] = nloc; b.st[1] = nx; }
        const unsigned old = xb_add(&bar[XB_XSUB(b.x)], 1u);
        const unsigned gen = old / nloc;
        if (old + 1u == (gen + 1u) * nloc) {
            __builtin_amdgcn_fence(__ATOMIC_RELEASE, "agent");
            asm volatile("s_waitcnt vmcnt(0)" ::: "memory");
            const unsigned og = xb_add(&bar[XB_TOP], 1u);
            const unsigned tg = og / nx;
            if (og + 1u == (tg + 1u) * nx) xb_add(&bar[XB_TOPGEN], 1u);
            else XB_SPIN(xb_ld(&bar[XB_TOPGEN]) == tg, bar);
            __builtin_amdgcn_fence(__ATOMIC_ACQUIRE, "agent");
            xb_add(&bar[XB_XGEN(b.x)], 1u);
            asm volatile("s_waitcnt vmcnt(0)" ::: "memory");
        } else {
            XB_SPIN(xb_ld(&bar[XB_XGEN(b.x)]) == gen, bar);
            __builtin_amdgcn_fence(__ATOMIC_ACQUIRE, "agent");
            asm volatile("s_waitcnt vmcnt(0)" ::: "memory");
        }
    }
    __syncthreads();
}

struct KArgs { const float* in[18]; float* out; char* ws; };
constexpr size_t al256(size_t v) { return (v + 255) / 256 * 256; }
struct WSL {
    static constexpr size_t ctrl = 0;
    static constexpr size_t WinT = al256(ctrl + 65536);
    static constexpr size_t WoT = al256(WinT + (size_t)NL * NPAD * 1024 * 2);
    static constexpr size_t W1T = al256(WoT + (size_t)NL * 1024 * 1024 * 2);
    static constexpr size_t W2T = al256(W1T + (size_t)NL * 2 * 64 * 2048 * 2);
    static constexpr size_t WguT = al256(W2T + (size_t)NL * 2 * 64 * 64 * 2);
    static constexpr size_t WdnT = al256(WguT + (size_t)NL * NE * 2048 * 1024 * 2);
    static constexpr size_t rwT = al256(WdnT + (size_t)NL * NE * 1024 * 1024 * 2);
    static constexpr size_t binp = al256(rwT + (size_t)NL * NE * 1024 * 4);
    static constexpr size_t bgup = al256(binp + (size_t)NL * NPAD * 4);
    static constexpr size_t b1c = al256(bgup + (size_t)NL * NE * 2048 * 4);
    static constexpr size_t xf = al256(b1c + 4 * 64 * 4);
    static constexpr size_t xb = al256(xf + (size_t)NTOK * DM * 4);
    static constexpr size_t hb = al256(xb + (size_t)NTOK * DM * 2);
    static constexpr size_t hs = al256(hb + (size_t)NTOK * NMAIN * 2);
    static constexpr size_t vT = al256(hs + (size_t)NTOK * HS_W * 4);
    static constexpr size_t kF = al256(vT + (size_t)NB * NVH * 64 * SEQ * 2);
    static constexpr size_t cF = al256(kF + (size_t)NB * NVH * 64 * SEQ * 2);
    static constexpr size_t kc = al256(cF + (size_t)NB * 4 * SEQ * 4);
    static constexpr size_t vc = al256(kc + (size_t)NB * 2 * 128 * 64 * 2);
    static constexpr size_t vcT = al256(vc + (size_t)NB * 2 * 128 * 64 * 2);
    static constexpr size_t ob = al256(vcT + (size_t)NB * 2 * 128 * 64 * 2);
    static constexpr size_t tbuf = al256(ob + (size_t)NTOK * DM * 2);
    static constexpr size_t x1f = al256(tbuf + (size_t)NTOK * DM * 4);
    static constexpr size_t x1b = al256(x1f + (size_t)NTOK * DM * 4);
    static constexpr size_t top_e = al256(x1b + (size_t)NTOK * DM * 2);
    static constexpr size_t gw = al256(top_e + (size_t)NTOK * 4 * 4);
    static constexpr size_t lists = al256(gw + (size_t)NTOK * 4 * 4);
    static constexpr size_t act = al256(lists + (size_t)NE * LIST_CAP * 4);
    static constexpr size_t ybuf = al256(act + (size_t)MAXSLOT * DFF * 2);
    static constexpr size_t xq = al256(ybuf + (size_t)MAXSLOT * DM * 2);
    static constexpr size_t WinQ = al256(xq + (size_t)NTOK * DM);
    static constexpr size_t total = al256(WinQ + (size_t)NL * NMAIN * 1024);
};
__device__ __forceinline__ Params make_params(const KArgs& k) {
    Params p;
    p.x = k.in[0]; p.w_in = k.in[1]; p.b_in = k.in[2]; p.sinks = k.in[3]; p.cmp_pe = k.in[4]; p.cmp_w1 = k.in[5]; p.cmp_w2 = k.in[6]; p.w_out = k.in[7];
    p.ln1_g = k.in[8]; p.ln1_b = k.in[9]; p.router_w = k.in[10]; p.router_b = k.in[11]; p.w_gu = k.in[12]; p.b_gu = k.in[13]; p.w_dn = k.in[14]; p.b_dn = k.in[15];
    p.ln2_g = k.in[16]; p.ln2_b = k.in[17]; p.out = k.out;
    char* w = k.ws;
    p.ctrl = (unsigned*)(w + WSL::ctrl); p.WinT = (bf16_t*)(w + WSL::WinT); p.WoT = (bf16_t*)(w + WSL::WoT); p.W1T = (bf16_t*)(w + WSL::W1T); p.W2T = (bf16_t*)(w + WSL::W2T);
    p.WguT = (bf16_t*)(w + WSL::WguT); p.WdnT = (bf16_t*)(w + WSL::WdnT); p.rwT = (float*)(w + WSL::rwT); p.binp = (float*)(w + WSL::binp); p.bgup = (float*)(w + WSL::bgup);
    p.b1c = (float*)(w + WSL::b1c); p.xf = (float*)(w + WSL::xf); p.xb = (bf16_t*)(w + WSL::xb); p.hb = (bf16_t*)(w + WSL::hb); p.hs = (float*)(w + WSL::hs); p.vT = (bf16_t*)(w + WSL::vT); p.kF = (bf16_t*)(w + WSL::kF);
    p.cF = (float*)(w + WSL::cF); p.kc = (bf16_t*)(w + WSL::kc); p.vc = (bf16_t*)(w + WSL::vc); p.vcT = (bf16_t*)(w + WSL::vcT); p.ob = (bf16_t*)(w + WSL::ob); p.tbuf = (float*)(w + WSL::tbuf);
    p.x1f = (float*)(w + WSL::x1f); p.x1b = (bf16_t*)(w + WSL::x1b); p.top_e = (int*)(w + WSL::top_e); p.gw = (float*)(w + WSL::gw); p.lists = (int*)(w + WSL::lists);
    p.act = (bf16_t*)(w + WSL::act); p.ybuf = (bf16_t*)(w + WSL::ybuf); p.xq = (unsigned char*)(w + WSL::xq); p.WinQ = (unsigned char*)(w + WSL::WinQ);
    return p;
}
__device__ __forceinline__ void grid_bar(const Params& p, char* lds) {
    XcdBarrier xb; xb.bar = p.ctrl + 1024; xb.x = xb_xcc_id(); xb.st = (volatile LAS unsigned*)(lds + LDS_BYTES - 16); xcd_barrier(xb);
}
__device__ __forceinline__ Params fresh_params(const KArgs& ka) {
    KArgs k2 = ka; size_t z = 0; asm volatile("" : "+s"(z));
    k2.ws = ka.ws + z;
    return make_params(k2);
}
#ifndef REP
#define REP 0
#endif
template <int L>
__device__ __forceinline__ void layer_fwd(const KArgs& ka, char* lds) {
    { const Params p = fresh_params(ka); phase_inproj(p, L, lds);        grid_bar(p, lds); }
    { const Params p = fresh_params(ka); phase_prep(p, L, lds);          grid_bar(p, lds); }
    { const Params p = fresh_params(ka); phase_attn<L == 0>(p, L, lds);  grid_bar(p, lds); }
    { const Params p = fresh_params(ka); phase_outproj(p, L, L == 0 ? p.x : p.xf, lds);  grid_bar(p, lds); }
    { const Params p = fresh_params(ka); phase_ln1_router(p, L, lds);    grid_bar(p, lds); }
    { const Params p = fresh_params(ka); phase_gateup(p, L, lds);        grid_bar(p, lds); }
    { const Params p = fresh_params(ka); phase_down(p, L, lds);          grid_bar(p, lds); }
    { const Params p = fresh_params(ka); phase_ln2(p, L, L == NL - 1 ? p.out : p.xf, lds); }
}
__global__ void __launch_bounds__(NTHR, 2) fwd_kernel(KArgs ka) {
    extern __shared__ __attribute__((aligned(16))) char lds[];
    const Params p = make_params(ka);
    cg::grid_group grid = cg::this_grid();
    volatile LAS unsigned* xst = (volatile LAS unsigned*)(lds + LDS_BYTES - 16);
    if (threadIdx.x == 0) { xst[0] = 0u; xst[1] = 0u; }
    __syncthreads();
    (void)xcd_barrier_post(p.ctrl + 1024, xst);
    volatile LAS int* vcu = (volatile LAS int*)(lds + LDS_BYTES - 32);
    const unsigned myx = xb_xcc_id() & 7u;
    if (threadIdx.x == 0) vcu[1] = (int)__hip_atomic_fetch_add(p.ctrl + 32 + myx, 1u, __ATOMIC_RELAXED, __HIP_MEMORY_SCOPE_AGENT);
    phase0(p, lds);
    grid.sync();
    if (threadIdx.x == 0) {
        int base = 0, tot = 0;
        for (unsigned x = 0; x < 8; ++x) { const int n = (int)__hip_atomic_load(p.ctrl + 32 + x, __ATOMIC_RELAXED, __HIP_MEMORY_SCOPE_AGENT); if (x < myx) base += n; tot += n; }
        vcu[0] = (tot == (int)gridDim.x) ? base + vcu[1] : (int)blockIdx.x;
    }
    __syncthreads();
    layer_fwd<0>(ka, lds);
    grid_bar(p, lds);
    layer_fwd<1>(ka, lds);
}

extern "C" void kernel_launch(void* const* d_in, const int* in_sizes, int n_in, void* d_out, int out_size, void* d_ws, size_t ws_size, hipStream_t stream) {
    KArgs ka{};
    for (int i = 0; i < 18; ++i) ka.in[i] = (const float*)d_in[i];
    ka.out = (float*)d_out; ka.ws = (char*)d_ws;
    if (WSL::total > ws_size) { fprintf(stderr, "workspace too small: need %zu have %zu\n", (size_t)WSL::total, ws_size); return; }
    static int grid_blocks = 0;
    if (!grid_blocks) {
        int dev = 0, cus = 0, per_cu = 0;
        (void)hipGetDevice(&dev);
        (void)hipDeviceGetAttribute(&cus, hipDeviceAttributeMultiprocessorCount, dev);
        (void)hipFuncSetAttribute((const void*)fwd_kernel, hipFuncAttributeMaxDynamicSharedMemorySize, LDS_BYTES);
        (void)hipOccupancyMaxActiveBlocksPerMultiprocessor(&per_cu, fwd_kernel, NTHR, LDS_BYTES);
        if (per_cu < 1) { fprintf(stderr, "occupancy query says 0 blocks per CU\n"); per_cu = 1; }
        grid_blocks = cus;
    }
    (void)hipMemsetAsync(d_ws, 0, 65536, stream);
    void* args[] = {&ka};
    hipError_t e = hipLaunchCooperativeKernel((const void*)fwd_kernel, dim3(grid_blocks), dim3(NTHR), args, LDS_BYTES, stream);
    if (e != hipSuccess) fprintf(stderr, "cooperative launch failed: %s (grid %d)\n", hipGetErrorString(e), grid_blocks);
}
```

```cpp
#include <hip/hip_runtime.h>
#include <hip/hip_cooperative_groups.h>
#include <cstdio>
#include <cstdint>
namespace cg = cooperative_groups;

typedef unsigned short bf16_t;
typedef short bf16x8 __attribute__((ext_vector_type(8)));
typedef float f32x4 __attribute__((ext_vector_type(4)));
typedef unsigned u32x4 __attribute__((ext_vector_type(4)));
typedef unsigned u32x2 __attribute__((ext_vector_type(2)));
typedef int v8i_t __attribute__((ext_vector_type(8)));
typedef float f32x2_t __attribute__((ext_vector_type(2)));
typedef int v4i_t __attribute__((ext_vector_type(4)));
#define LAS __attribute__((address_space(3)))
constexpr float NEG_INF = -__builtin_huge_valf();

constexpr int DM = 1024, NB = 16, SEQ = 2048, NTOK = NB * SEQ, NL = 2;
constexpr int NCOL = 2582, NMAIN = 2560, NPAD = 2688, NE = 32, DFF = 1024;
constexpr int C_FQ = 0, C_FK = 256, C_FV = 512, C_SQ = 768, C_SK = 1152, C_SV = 1280, C_NQ = 1408,
              C_NKC = 1792, C_NVC = 1920, C_NKS = 2048, C_NVS = 2176, C_NKW = 2304, C_NVW = 2432;
constexpr int HS_W = 32;
constexpr int NVH = 10;
constexpr int LIST_CAP = NTOK;
constexpr int MAXSLOT = NTOK * 4 + NE * 256;
constexpr float ALPHA = 1.41421356237f, LN_EPS = 1e-5f, QSCALE = 0.125f;
constexpr float GATE_PRE = -2.455466929f;
constexpr int NWV = 8, NTHR = NWV * 64;
constexpr int LDS_STAGE = 131072, LDS_TAB = LDS_STAGE, LDS_AOFF = LDS_STAGE + 2048, LDS_BIAS = LDS_AOFF + 20480, LDS_BYTES = LDS_BIAS + 3072 + 256;

struct Params {
    const float *x, *w_in, *b_in, *sinks, *cmp_pe, *cmp_w1, *cmp_w2, *w_out, *ln1_g, *ln1_b, *router_w, *router_b,
                *w_gu, *b_gu, *w_dn, *b_dn, *ln2_g, *ln2_b;
    float* out;
    unsigned* ctrl;
    bf16_t *WinT, *WoT, *W1T, *W2T, *WguT, *WdnT;
    float *rwT, *binp, *bgup, *b1c;
    unsigned char* xq; unsigned char* WinQ;
    float* xf; bf16_t* xb; bf16_t* hb; float* hs; bf16_t* vT; bf16_t* kF; float* cF;
    bf16_t *kc, *vc, *vcT; bf16_t* ob; float* tbuf; float* x1f; bf16_t* x1b;
    int* top_e; float* gw; int* lists; bf16_t* act; bf16_t* ybuf;
};

__device__ __forceinline__ float bf2f(bf16_t h) { return __uint_as_float(((unsigned)h) << 16); }
typedef __bf16 bf16x2_t __attribute__((ext_vector_type(2)));
__device__ __forceinline__ bf16_t f2bf(float f) { return __builtin_bit_cast(bf16_t, (__bf16)f); }
__device__ __forceinline__ unsigned pack2(float lo, float hi) { bf16x2_t v = {(__bf16)lo, (__bf16)hi}; return __builtin_bit_cast(unsigned, v); }
__device__ __forceinline__ unsigned pack4_fp8(float a, float b, float c, float d) {
    unsigned w = 0u;
    w = __builtin_amdgcn_cvt_pk_fp8_f32(a, b, w, false);
    w = __builtin_amdgcn_cvt_pk_fp8_f32(c, d, w, true);
    return w;
}
__device__ __forceinline__ float shfl_f(float v, int src_lane) { return __int_as_float(__builtin_amdgcn_ds_bpermute(src_lane << 2, __float_as_int(v))); }
__device__ __forceinline__ unsigned shfl_u(unsigned v, int src_lane) { return (unsigned)__builtin_amdgcn_ds_bpermute(src_lane << 2, (int)v); }
__device__ __forceinline__ float wave_sum(float v) {
#pragma unroll
    for (int o = 32; o > 0; o >>= 1) v += __shfl_xor(v, o);
    return v;
}
__device__ __forceinline__ float wave_max(float v) {
#pragma unroll
    for (int o = 32; o > 0; o >>= 1) v = fmaxf(v, __shfl_xor(v, o));
    return v;
}
__device__ __forceinline__ void lds_wave_sync() { asm volatile("s_waitcnt lgkmcnt(0)" ::: "memory"); __builtin_amdgcn_wave_barrier(); }
__device__ __forceinline__ float slope_swa(int hq) { return exp2f(-8.0f * (float)(2 * hq + 1) / 12.0f); }
__device__ __forceinline__ float slope_nsa(int hq) { return exp2f(-8.0f * (float)(2 * hq + 2) / 12.0f); }

__device__ __forceinline__ int fwd128(int L) { return (L & ~31) | (((L >> 2) & 1) << 4) | (((L >> 3) & 3) << 2) | (L & 3); }
__device__ __forceinline__ int inv128(int p) { return (p & ~31) | (((p >> 2) & 3) << 3) | (((p >> 4) & 1) << 2) | (p & 3); }
__device__ __forceinline__ int fwd256(int L) { return (L & ~255) | (((L >> 3) & 1) << 7) | (((L >> 6) & 3) << 5) | (((L >> 2) & 1) << 4) | (((L >> 4) & 3) << 2) | (L & 3); }
__device__ __forceinline__ int perm_row(int perm, int n) {
    if (perm == 1) { int r; if (n < 768) r = n; else if (n < 772) r = 2560 + (n - 768); else if (n < 2564) r = n - 4; else r = n; return r < 2560 ? fwd128(r) : r; }
    if (perm == 2) { const int f = n >> 1, s = n & 1; return (f >> 7) * 256 + s * 128 + fwd128(f & 127); }
    if (perm == 3) return fwd256(n);
    return n;
}
struct ConvJob { const float* src; bf16_t* dst; int K, N, kt, nt, perm; float q8; };
__device__ __forceinline__ bool conv_job(const Params& p, int t, ConvJob& jb) {
    constexpr int T_WIN = NL * 8 * 21, T_WO = NL * 8 * 8;
    if (t < T_WIN) { const int m = t / 168, r = t % 168; jb = ConvJob{p.w_in + (size_t)m * 1024 * NCOL, p.WinT + (size_t)m * NPAD * 1024, 1024, NCOL, r / 21, r % 21, 1, 0.f}; return true; }
    t -= T_WIN;
    if (t < T_WO) { const int m = t / 64, r = t % 64; jb = ConvJob{p.w_out + (size_t)m * 1024 * 1024, (bf16_t*)((char*)p.WoT + (size_t)m * 1024 * 1024), 1024, 1024, r / 8, r % 8, 3, 64.0f}; return true; }
    t -= T_WO;
    if (t < T_WIN) { const int m = t / 168, r = t % 168; jb = ConvJob{p.w_in + (size_t)m * 1024 * NCOL, (bf16_t*)(p.WinQ + (size_t)m * NMAIN * 1024), 1024, NCOL, r / 21, r % 21, 1, 64.0f}; return true; }
    return false;
}
constexpr int CONV_TILES = NL * NE * 192;
__device__ __forceinline__ void conv_tile_wave(const Params& p, int t, int lane, unsigned char* l8) {
    asm volatile("" : "+v"(lane));
    const int m = t / 192, r = t % 192;
    const float* src; unsigned char* dst; int N, kt, nt, perm;
    if (r < 128) { src = p.w_gu + (size_t)m * 1024 * 2048; dst = (unsigned char*)p.WguT + (size_t)m * 2048 * 1024; N = 2048; kt = r >> 4; nt = r & 15; perm = 2; }
    else { const int q = r - 128; src = p.w_dn + (size_t)m * 1024 * 1024; dst = (unsigned char*)p.WdnT + (size_t)m * 1024 * 1024; N = 1024; kt = q >> 3; nt = q & 7; perm = 3; }
    const float* s = src + (size_t)(kt * 128 + (lane >> 5)) * N + nt * 128 + (lane & 31) * 4;
    unsigned char* lw = l8 + (lane >> 5) * 132 + (lane & 31) * 4;
    const float sg = (perm == 2) ? 64.0f * GATE_PRE : 64.0f;
    float4 va[16], vb[16];
#pragma unroll
    for (int i = 0; i < 16; ++i) va[i] = *(const float4*)(s + (size_t)(2 * i) * N);
#pragma unroll
    for (int i = 0; i < 16; ++i) vb[i] = *(const float4*)(s + (size_t)(32 + 2 * i) * N);
#pragma unroll
    for (int i = 0; i < 16; ++i) *(unsigned*)(lw + (2 * i) * 132) = pack4_fp8(va[i].x * sg, va[i].y * 64.0f, va[i].z * sg, va[i].w * 64.0f);
#pragma unroll
    for (int i = 0; i < 16; ++i) va[i] = *(const float4*)(s + (size_t)(64 + 2 * i) * N);
#pragma unroll
    for (int i = 0; i < 16; ++i) *(unsigned*)(lw + (32 + 2 * i) * 132) = pack4_fp8(vb[i].x * sg, vb[i].y * 64.0f, vb[i].z * sg, vb[i].w * 64.0f);
#pragma unroll
    for (int i = 0; i < 16; ++i) vb[i] = *(const float4*)(s + (size_t)(96 + 2 * i) * N);
#pragma unroll
    for (int i = 0; i < 16; ++i) *(unsigned*)(lw + (64 + 2 * i) * 132) = pack4_fp8(va[i].x * sg, va[i].y * 64.0f, va[i].z * sg, va[i].w * 64.0f);
#pragma unroll
    for (int i = 0; i < 16; ++i) *(unsigned*)(lw + (96 + 2 * i) * 132) = pack4_fp8(vb[i].x * sg, vb[i].y * 64.0f, vb[i].z * sg, vb[i].w * 64.0f);
    lds_wave_sync();
#pragma unroll 4
    for (int i = 0; i < 16; ++i) {
        const int idx = lane + 64 * i, kc = idx & 7, nn = idx >> 3;
        const unsigned char* l = l8 + (kc * 16) * 132 + nn;
        u32x4 w;
        w.x = (unsigned)l[0] | ((unsigned)l[132] << 8) | ((unsigned)l[264] << 16) | ((unsigned)l[396] << 24);
        w.y = (unsigned)l[528] | ((unsigned)l[660] << 8) | ((unsigned)l[792] << 16) | ((unsigned)l[924] << 24);
        w.z = (unsigned)l[1056] | ((unsigned)l[1188] << 8) | ((unsigned)l[1320] << 16) | ((unsigned)l[1452] << 24);
        w.w = (unsigned)l[1584] | ((unsigned)l[1716] << 8) | ((unsigned)l[1848] << 16) | ((unsigned)l[1980] << 24);
        *(u32x4*)(dst + (size_t)perm_row(perm, nt * 128 + nn) * 1024 + kt * 128 + kc * 16) = w;
    }
    lds_wave_sync();
}
__device__ __forceinline__ void conv_load(const ConvJob& jb, int tid, float2 (&v)[16]) {
    const int n = jb.nt * 128 + (tid & 31) * 4;
    const float* s = jb.src + (size_t)(jb.kt * 128 + (tid >> 5)) * jb.N + n;
#pragma unroll
    for (int i = 0; i < 8; ++i) {
        const float* r = s + (size_t)(16 * i) * jb.N;
        v[2 * i] = (n + 1 < jb.N) ? *(const float2*)r : make_float2(0.f, 0.f);
        v[2 * i + 1] = (n + 3 < jb.N) ? *(const float2*)(r + 2) : make_float2(0.f, 0.f);
    }
}
__device__ __forceinline__ void phase0(const Params& p, char* ldsc) {
    int tid = threadIdx.x; asm volatile("" : "+v"(tid));
    const int G = gridDim.x, bid = blockIdx.x;
    const size_t gtid = (size_t)bid * NTHR + tid, gthreads = (size_t)G * NTHR;
    {
        constexpr int TOT = 2 * NL * 8 * 21 + NL * 8 * 8;
        bf16_t* lt = (bf16_t*)ldsc;
        ConvJob jb, jn; float2 v[16], vn[16];
        int t = bid; bool have = t < TOT && conv_job(p, t, jb);
        if (have) conv_load(jb, tid, v);
        while (have) {
            const int tn = t + G; const bool hn = tn < TOT && conv_job(p, tn, jn);
            if (hn) conv_load(jn, tid, vn);
            if (jb.q8 != 0.f) {
                unsigned char* l8 = (unsigned char*)lt;
#pragma unroll
                for (int i = 0; i < 8; ++i)
                    *(unsigned*)(l8 + ((tid >> 5) + 16 * i) * 132 + (tid & 31) * 4) = pack4_fp8(v[2 * i].x * jb.q8, v[2 * i].y * jb.q8, v[2 * i + 1].x * jb.q8, v[2 * i + 1].y * jb.q8);
                __syncthreads();
#pragma unroll
                for (int i = 0; i < 2; ++i) {
                    const int idx = tid + NTHR * i, kc = idx & 7, nn = idx >> 3, n = jb.nt * 128 + nn;
                    const unsigned char* l = l8 + (kc * 16) * 132 + nn;
                    u32x4 w;
                    w.x = (unsigned)l[0] | ((unsigned)l[132] << 8) | ((unsigned)l[264] << 16) | ((unsigned)l[396] << 24);
                    w.y = (unsigned)l[528] | ((unsigned)l[660] << 8) | ((unsigned)l[792] << 16) | ((unsigned)l[924] << 24);
                    w.z = (unsigned)l[1056] | ((unsigned)l[1188] << 8) | ((unsigned)l[1320] << 16) | ((unsigned)l[1452] << 24);
                    w.w = (unsigned)l[1584] | ((unsigned)l[1716] << 8) | ((unsigned)l[1848] << 16) | ((unsigned)l[1980] << 24);
                    const int pr = perm_row(jb.perm, n);
                    if (n < jb.N && !(jb.perm == 1 && pr >= NMAIN)) *(u32x4*)((char*)jb.dst + (size_t)pr * jb.K + jb.kt * 128 + kc * 16) = w;
                }
            } else {
#pragma unroll
                for (int i = 0; i < 8; ++i) {
                    u32x2 w; w.x = pack2(v[2 * i].x, v[2 * i].y); w.y = pack2(v[2 * i + 1].x, v[2 * i + 1].y);
                    *(u32x2*)(lt + ((tid >> 5) + 16 * i) * 136 + (tid & 31) * 4) = w;
                }
                __syncthreads();
#pragma unroll
                for (int i = 0; i < 4; ++i) {
                    const int idx = tid + NTHR * i, kc = idx & 15, nn = idx >> 4, n = jb.nt * 128 + nn;
                    if (n < jb.N) {
                        const bf16_t* l = lt + (kc * 8) * 136 + nn;
                        u32x4 w;
                        w.x = (unsigned)l[0] | ((unsigned)l[136] << 16); w.y = (unsigned)l[272] | ((unsigned)l[408] << 16);
                        w.z = (unsigned)l[544] | ((unsigned)l[680] << 16); w.w = (unsigned)l[816] | ((unsigned)l[952] << 16);
                        *(u32x4*)(jb.dst + (size_t)perm_row(jb.perm, n) * jb.K + jb.kt * 128 + kc * 8) = w;
                    }
                }
            }
            __syncthreads();
            t = tn; have = hn; jb = jn;
#pragma unroll
            for (int i = 0; i < 16; ++i) v[i] = vn[i];
        }
    }
    for (size_t i = gtid; i < (size_t)NL * 2 * 2048 * 64; i += gthreads) {
        const int k = (int)(i % 2048), n = (int)((i / 2048) % 64), m = (int)(i / (2048 * 64));
        p.W1T[i] = f2bf(p.cmp_w1[((size_t)m * 2048 + k) * 64 + n]);
    }
    for (size_t i = gtid; i < (size_t)NL * 2 * 64 * 64; i += gthreads) {
        const int k = (int)(i % 64), n = (int)((i / 64) % 64), m = (int)(i / 4096);
        p.W2T[i] = f2bf(p.cmp_w2[((size_t)m * 64 + k) * 64 + n]);
    }
    for (size_t i = gtid; i < (size_t)NL * NPAD; i += gthreads) {
        const int l = (int)(i / NPAD), ri = (int)(i % NPAD), r = ri < 2560 ? inv128(ri) : ri;
        float v = 0.f;
        if (r < 2560) { const int n = r < 768 ? r : r + 4; v = p.b_in[l * NCOL + n]; }
        else if (r < 2564) v = p.b_in[l * NCOL + 768 + (r - 2560)];
        else if (r < 2582) v = p.b_in[l * NCOL + r];
        p.binp[i] = v;
    }
    for (size_t i = gtid; i < (size_t)NL * NE * 2048; i += gthreads) {
        const int r = (int)(i % 2048); const size_t le = i / 2048;
        const int s = (r >> 7) & 1, f = (r >> 8) * 128 + inv128(r & 127);
        p.bgup[i] = p.b_gu[le * 2048 + 2 * f + s] * (s == 0 ? GATE_PRE : 1.0f);
    }
    for (size_t i = gtid; i < (size_t)NL * NE * 1024; i += gthreads) {
        const int k = (int)(i % 1024), e = (int)((i / 1024) % NE), l = (int)(i / (1024 * NE));
        p.rwT[i] = p.router_w[((size_t)l * 1024 + k) * NE + e];
    }
    for (size_t i = gtid; i < (size_t)NL * (NPAD - NCOL) * 1024; i += gthreads) {
        const int l = (int)(i / ((NPAD - NCOL) * 1024)); const size_t r = i % ((size_t)(NPAD - NCOL) * 1024);
        p.WinT[(size_t)l * NPAD * 1024 + (size_t)NCOL * 1024 + r] = 0;
    }
    for (size_t i = gtid; i < (size_t)NTOK * DM / 4; i += gthreads) {
        const float4 v4 = ((const float4*)p.x)[i];
        u32x2 w; w.x = pack2(v4.x, v4.y); w.y = pack2(v4.z, v4.w);
        ((u32x2*)p.xb)[i] = w;
        ((unsigned*)p.xq)[i] = pack4_fp8(v4.x, v4.y, v4.z, v4.w);
    }
    if (bid < 4) {
        float* lf = (float*)ldsc;
        const int j = tid & 63, part = tid >> 6;
        const float* pe = p.cmp_pe + (size_t)bid * 2048; const float* w1 = p.cmp_w1 + (size_t)bid * 2048 * 64;
        float s = 0.f;
        for (int kk = part * 256; kk < part * 256 + 256; ++kk) s += pe[kk] * w1[(size_t)kk * 64 + j];
        lf[tid] = s; __syncthreads();
        if (tid < 64) { float a = 0.f; for (int q = 0; q < 8; ++q) a += lf[tid + 64 * q]; p.b1c[bid * 64 + tid] = a; }
        __syncthreads();
    }
}

__device__ __forceinline__ int vcu_id() { return __builtin_amdgcn_readfirstlane(*(const volatile LAS int*)(LDS_BYTES - 32)); }
namespace pg8 {
constexpr int BM = 256, BK = 64, HALF = 128, HTB = HALF * BK * 2, NXCD = 8, WGM = 8;
__device__ __forceinline__ int lds_byte(int r, int c) { const int st = (r >> 4) * 2 + (c >> 5), rr = r & 15, cc = c & 31, ob = rr * 64 + cc * 2; return st * 1024 + (ob ^ (((ob >> 9) & 1) << 5)); }
__device__ __forceinline__ void stage_rc(int b, int& R, int& C) { const int st = b / 1024, sb = b % 1024, swz = sb ^ (((sb >> 9) & 1) << 5); R = (st >> 1) * 16 + swz / 64; C = (st & 1) * 32 + (swz % 64) / 2; }
__device__ __forceinline__ bool tile_order(int i, int G, int c, int nM, int nN, int& pm, int& pn) {
    const int nwg = nM * nN; const long L = (long)i * G + c; if (L >= nwg) return false;
    const int wgid = (int)L;
    const int nig = WGM * nN, gid = wgid / nig, fm = gid * WGM, gsz = (nM - fm) < WGM ? (nM - fm) : WGM;
    pm = fm + ((wgid % nig) % gsz); pn = (wgid % nig) / gsz; return true;
}
template <bool FP8, int SCA, class Sched, class Epi>
__device__ __forceinline__ void gemm_phase(LAS unsigned char* lds, const char* Abase, int K, const Sched& S, const Epi& E) {
    int tid = threadIdx.x; asm volatile("" : "+v"(tid));
    const int wid = __builtin_amdgcn_readfirstlane(tid >> 6), lane = tid & 63, wr = wid >> 2, wc = wid & 3, fr = lane & 15, fq = lane >> 4;
    const int nt = K / BK;
    int R0, C0, R1, C1; stage_rc(tid * 16, R0, C0); stage_rc(tid * 16 + 8192, R1, C1);
    LAS unsigned* aofs = (LAS unsigned*)(lds + LDS_AOFF) + tid;
    unsigned rg[10];
    rg[8] = (unsigned)(R0 * K + C0) * 2u; rg[9] = (unsigned)(R1 * K + C1) * 2u;
    if constexpr (FP8) { aofs[8 * NTHR] = rg[8]; aofs[9 * NTHR] = rg[9]; }
    const size_t kstep = (size_t)(BK * 2), hstep = (size_t)HALF * K * 2;
    const unsigned ldsw = (unsigned)wid * 1024u;
    const int aoff = lds_byte(wr * 64 + fr, fq * 8), boff = lds_byte(wc * 32 + fr, fq * 8);
#define PG8_SA(b, h) (((b) * 2 + (h)) * HTB)
#define PG8_SB(b, h) ((4 + (b) * 2 + (h)) * HTB)
#define PG8_OFS(sel, j) (FP8 ? aofs[((sel) * 4 + (j)) * NTHR] : ((sel) ? rg[4 + (j)] : rg[(j)]))
#define PG8_STAGE_B(bufoff, gbase) do { _Pragma("unroll") for (int _i = 0; _i < 2; ++_i) { const unsigned ob_ = FP8 ? aofs[(8 + _i) * NTHR] : rg[8 + _i]; \
        __builtin_amdgcn_global_load_lds((const unsigned*)((const char*)(gbase) + ob_), (LAS unsigned*)(lds + (bufoff) + ldsw + _i * 8192), 16, 0, 0); } } while (0)
#define PG8_STAGE_A(bufoff, kbyte, sel, h) do { const unsigned o0_ = PG8_OFS(sel, (h) * 2), o1_ = PG8_OFS(sel, (h) * 2 + 1); \
        __builtin_amdgcn_global_load_lds((const unsigned*)(Abase + (kbyte) + o0_), (LAS unsigned*)(lds + (bufoff) + ldsw), 16, 0, 0); \
        __builtin_amdgcn_global_load_lds((const unsigned*)(Abase + (kbyte) + o1_), (LAS unsigned*)(lds + (bufoff) + ldsw + 8192), 16, 0, 0); } while (0)
#define PG8_LDA(dst, b, h) do { _Pragma("unroll") for (int m = 0; m < 4; ++m) { \
        if constexpr (FP8) { const v4i_t lo_ = *(const LAS v4i_t*)(lds + PG8_SA(b, h) + aoff + m * 2048), hi_ = *(const LAS v4i_t*)(lds + PG8_SA(b, h) + aoff + m * 2048 + 1024); dst##8[m] = __builtin_shufflevector(lo_, hi_, 0, 1, 2, 3, 4, 5, 6, 7); } \
        else { _Pragma("unroll") for (int k = 0; k < 2; ++k) dst[m][k] = *(const LAS bf16x8*)(lds + PG8_SA(b, h) + aoff + m * 2048 + k * 1024); } } } while (0)
#define PG8_LDB(dst, b, h) do { _Pragma("unroll") for (int n = 0; n < 2; ++n) { \
        if constexpr (FP8) { const v4i_t lo_ = *(const LAS v4i_t*)(lds + PG8_SB(b, h) + boff + n * 2048), hi_ = *(const LAS v4i_t*)(lds + PG8_SB(b, h) + boff + n * 2048 + 1024); dst##8[n] = __builtin_shufflevector(lo_, hi_, 0, 1, 2, 3, 4, 5, 6, 7); } \
        else { _Pragma("unroll") for (int k = 0; k < 2; ++k) dst[n][k] = *(const LAS bf16x8*)(lds + PG8_SB(b, h) + boff + n * 2048 + k * 1024); } } } while (0)
#define PG8_MMA(ai, bj, At, Bt) do { __builtin_amdgcn_s_setprio(1); _Pragma("unroll") for (int m = 0; m < 4; ++m) _Pragma("unroll") for (int n = 0; n < 2; ++n) { \
        if constexpr (FP8) { acc[ai][bj][m][n] = __builtin_amdgcn_mfma_scale_f32_16x16x128_f8f6f4(Bt##8[n], At##8[m], acc[ai][bj][m][n], 0, 0, 0, SCA, 0, SCA); } \
        else { _Pragma("unroll") for (int k = 0; k < 2; ++k) acc[ai][bj][m][n] = __builtin_amdgcn_mfma_f32_16x16x32_bf16(Bt[n][k], At[m][k], acc[ai][bj][m][n], 0, 0, 0); } } \
        __builtin_amdgcn_s_setprio(0); } while (0)
#define PG8_WAIT_V(n) asm volatile("s_waitcnt vmcnt(" #n ")" ::: "memory")
#define PG8_WAIT_L(n) asm volatile("s_waitcnt lgkmcnt(" #n ")" ::: "memory")
#define PG8_BAR __builtin_amdgcn_s_barrier()
#define PG8_SCHED __builtin_amdgcn_sched_barrier(0)
    typename Sched::Unit cur, nxt; int ui = 0;
    if (!S.next(0, cur)) return;
    f32x4 acc[2][2][4][2];
    bf16x8 At[4][2], B0[2][2], B1[2][2];
    v8i_t At8[4], B08[2], B18[2];
    { unsigned a4[2][2]; S.a_off(cur, R0, C0, R1, C1, a4); rg[0] = a4[0][0]; rg[1] = a4[0][1]; rg[2] = a4[1][0]; rg[3] = a4[1][1];
      if constexpr (FP8) { aofs[0] = a4[0][0]; aofs[NTHR] = a4[0][1]; aofs[2 * NTHR] = a4[1][0]; aofs[3 * NTHR] = a4[1][1]; } }
    const char* cB = S.b_ptr(cur);
#define PG8_BIAS_DMA(unit, slot) do { const float* bp_ = E.bias_ptr(unit); int tb_ = threadIdx.x; asm volatile("" : "+v"(tb_)); if (wr == 0 && bp_ != nullptr) \
        __builtin_amdgcn_global_load_lds((const unsigned*)(bp_ + (tb_ & 255)), (LAS unsigned*)(lds + LDS_BIAS + (slot) * 1024 + wid * 256), 4, 0, 0); } while (0)
    PG8_BIAS_DMA(cur, 0);
    PG8_STAGE_B(PG8_SB(0, 0), cB); PG8_STAGE_B(PG8_SB(0, 1), cB + hstep); PG8_STAGE_A(PG8_SA(0, 0), 0, 0, 0); PG8_STAGE_A(PG8_SA(0, 1), 0, 0, 1);
    if (wr == 1) PG8_BAR;
    PG8_WAIT_V(2); PG8_BAR;
    PG8_STAGE_B(PG8_SB(1, 0), cB + kstep); PG8_STAGE_A(PG8_SA(1, 0), kstep, 0, 0); PG8_STAGE_B(PG8_SB(1, 1), cB + hstep + kstep);
    PG8_WAIT_V(6); PG8_BAR;
    { int t3 = threadIdx.x; asm volatile("" : "+v"(t3)); E.init(acc, wc, (t3 & 63) >> 4, (const LAS float*)(lds + LDS_BIAS)); }
    for (;;) {
        const bool has_next = S.next(ui + 1, nxt);
        const char* nB = cB;
        if (has_next) PG8_BIAS_DMA(nxt, (ui + 1) % 3);
        if (has_next) { int t2 = threadIdx.x; asm volatile("" : "+v"(t2)); int r0, c0, r1, c1; stage_rc(t2 * 16, r0, c0); stage_rc(t2 * 16 + 8192, r1, c1); nB = S.b_ptr(nxt);
            if constexpr (Sched::LIST_DMA) { static_assert(!Sched::LIST_DMA || FP8, "list DMA lands in the LDS offset slots"); S.a_dma(nxt, r0, r1, (LAS unsigned*)(lds + LDS_AOFF + 4 * NTHR * 4 + wid * 256)); }
            else { unsigned a4[2][2]; S.a_off(nxt, r0, c0, r1, c1, a4);
                rg[4] = a4[0][0]; rg[5] = a4[0][1]; rg[6] = a4[1][0]; rg[7] = a4[1][1];
                if constexpr (FP8) { aofs[4 * NTHR] = a4[0][0]; aofs[5 * NTHR] = a4[0][1]; aofs[6 * NTHR] = a4[1][0]; aofs[7 * NTHR] = a4[1][1]; } } }
        else { rg[4] = rg[0]; rg[5] = rg[1]; rg[6] = rg[2]; rg[7] = rg[3];
            if constexpr (FP8) { aofs[4 * NTHR] = aofs[0]; aofs[5 * NTHR] = aofs[NTHR]; aofs[6 * NTHR] = aofs[2 * NTHR]; aofs[7 * NTHR] = aofs[3 * NTHR]; } }
#pragma unroll 1
        for (int t = 0; t < nt; t += 2) {
            const bool last = (t == nt - 2);
            const size_t ka1 = (size_t)(t + 1) * kstep, ka2 = last ? 0 : (size_t)(t + 2) * kstep, ka3 = ka2 + kstep;
            const char* b2 = last ? nB : cB + (size_t)(t + 2) * kstep; const char* b3 = b2 + kstep;
            const int sel = last ? 1 : 0;
            if constexpr (Sched::LIST_DMA) if (last && has_next) {
                int t4 = threadIdx.x; asm volatile("" : "+v"(t4)); int r0, c0, r1, c1; stage_rc(t4 * 16, r0, c0); stage_rc(t4 * 16 + 8192, r1, c1);
#pragma unroll
                for (int j = 0; j < 4; ++j) aofs[(4 + j) * NTHR] = S.a_fin(aofs[(4 + j) * NTHR], (j & 1) ? c1 : c0);
            }
            PG8_LDB(B0, 0, 0); PG8_LDB(B1, 0, 1); PG8_SCHED; PG8_LDA(At, 0, 0); PG8_STAGE_A(PG8_SA(1, 1), ka1, 0, 1);
            PG8_WAIT_V(8); PG8_WAIT_L(0); PG8_BAR; PG8_MMA(0, 0, At, B0); PG8_MMA(0, 1, At, B1); PG8_BAR; PG8_SCHED;
            PG8_LDA(At, 0, 1); PG8_STAGE_B(PG8_SB(0, 0), b2); PG8_STAGE_B(PG8_SB(0, 1), b2 + hstep); PG8_STAGE_A(PG8_SA(0, 0), ka2, sel, 0);
            PG8_WAIT_V(8); PG8_WAIT_L(0); PG8_BAR; PG8_MMA(1, 0, At, B0); PG8_MMA(1, 1, At, B1); PG8_BAR; PG8_SCHED;
            PG8_LDB(B0, 1, 0); PG8_LDB(B1, 1, 1); PG8_SCHED; PG8_LDA(At, 1, 0); PG8_STAGE_A(PG8_SA(0, 1), ka2, sel, 1);
            PG8_WAIT_V(8); PG8_WAIT_L(0); PG8_BAR; PG8_MMA(0, 0, At, B0); PG8_MMA(0, 1, At, B1); PG8_BAR; PG8_SCHED;
            PG8_LDA(At, 1, 1); PG8_STAGE_B(PG8_SB(1, 0), b3); PG8_STAGE_B(PG8_SB(1, 1), b3 + hstep); PG8_STAGE_A(PG8_SA(1, 0), ka3, sel, 0);
            PG8_WAIT_V(8); PG8_WAIT_L(0); PG8_BAR; PG8_MMA(1, 0, At, B0); PG8_MMA(1, 1, At, B1); PG8_BAR; PG8_SCHED;
        }
        if (wr == 0) PG8_BAR;
        { int t2 = threadIdx.x; asm volatile("" : "+v"(t2)); E(acc, cur, wr, wc, t2 & 15, (t2 & 63) >> 4, (const LAS float*)(lds + LDS_BIAS + (ui % 3) * 1024)); }
        if (!has_next) break;
        { int t3 = threadIdx.x; asm volatile("" : "+v"(t3)); E.init(acc, wc, (t3 & 63) >> 4, (const LAS float*)(lds + LDS_BIAS + ((ui + 1) % 3) * 1024)); }
        cur = nxt; cB = nB; ++ui;
        rg[0] = rg[4]; rg[1] = rg[5]; rg[2] = rg[6]; rg[3] = rg[7];
        if constexpr (FP8) { aofs[0] = aofs[4 * NTHR]; aofs[NTHR] = aofs[5 * NTHR]; aofs[2 * NTHR] = aofs[6 * NTHR]; aofs[3 * NTHR] = aofs[7 * NTHR]; }
        if (wr == 1) PG8_BAR;
    }
    PG8_WAIT_V(0);
    PG8_BAR;
#undef PG8_BIAS_DMA
#undef PG8_SA
#undef PG8_SB
#undef PG8_STAGE_A
#undef PG8_OFS
#undef PG8_STAGE_B
#undef PG8_LDA
#undef PG8_LDB
#undef PG8_MMA
#undef PG8_WAIT_V
#undef PG8_WAIT_L
#undef PG8_BAR
#undef PG8_SCHED
}
}

struct DenseUnit { int pm, pn; };
struct DenseSched {
    typedef DenseUnit Unit;
    const char* Bt; int K, nM, nN, vc;
    __device__ __forceinline__ bool next(int i, Unit& u) const { return pg8::tile_order(i, gridDim.x, vc, nM, nN, u.pm, u.pn); }
    __device__ __forceinline__ void a_off(const Unit& u, int R0, int C0, int R1, int C1, unsigned (&off)[2][2]) const {
#pragma unroll
        for (int h = 0; h < 2; ++h) { off[h][0] = (unsigned)((u.pm * 256 + h * 128 + R0) * K + C0) * 2u; off[h][1] = (unsigned)((u.pm * 256 + h * 128 + R1) * K + C1) * 2u; }
    }
    __device__ __forceinline__ const char* b_ptr(const Unit& u) const { return Bt + (size_t)u.pn * 256 * K * 2; }
    static constexpr bool LIST_DMA = false;
    __device__ __forceinline__ void a_dma(const Unit&, int, int, LAS unsigned*) const {}
    __device__ __forceinline__ unsigned a_fin(unsigned raw, int) const { return raw; }
};
struct MoeUnit { int rbt, e, pn; };
template <bool GATHER>
struct MoeSched {
    typedef MoeUnit Unit;
    static constexpr int KP = 512;
    const char* Bt; const int* lists; const int* ptile; const int* ecnt; int nN, nrows, vc;
    __device__ __forceinline__ bool next(int i, Unit& u) const {
        int pm, pn; if (!pg8::tile_order(i, gridDim.x, vc, ptile[NE], nN, pm, pn)) return false;
        u.rbt = pm; u.e = ((const unsigned char*)ptile)[512 + pm]; u.pn = pn; return true;
    }
    __device__ __forceinline__ void a_off(const Unit& u, int R0, int C0, int R1, int C1, unsigned (&off)[2][2]) const {
        if (GATHER) {
            const int* lst = lists + (size_t)u.e * LIST_CAP; const int rb = u.rbt - ptile[u.e], cnt = ecnt[u.e];
#pragma unroll
            for (int h = 0; h < 2; ++h) {
                const int l0 = rb * 256 + h * 128 + R0, l1 = rb * 256 + h * 128 + R1;
                const int t0 = l0 < cnt ? (lst[l0] >> 2) : 0, t1 = l1 < cnt ? (lst[l1] >> 2) : 0;
                off[h][0] = (unsigned)(t0 * KP + C0) * 2u; off[h][1] = (unsigned)(t1 * KP + C1) * 2u;
            }
        } else {
#pragma unroll
            for (int h = 0; h < 2; ++h) { off[h][0] = (unsigned)((u.rbt * 256 + h * 128 + R0) * KP + C0) * 2u; off[h][1] = (unsigned)((u.rbt * 256 + h * 128 + R1) * KP + C1) * 2u; }
        }
    }
    __device__ __forceinline__ const char* b_ptr(const Unit& u) const { return Bt + ((size_t)u.e * nrows + (size_t)u.pn * 256) * KP * 2; }
    static constexpr bool LIST_DMA = GATHER;
    __device__ __forceinline__ void a_dma(const Unit& u, int R0, int R1, LAS unsigned* slot) const {
        const int* lst = lists + (size_t)u.e * LIST_CAP; const int rb = u.rbt - ptile[u.e], cm = ecnt[u.e] - 1;
#pragma unroll
        for (int h = 0; h < 2; ++h) {
            const int l0 = min(rb * 256 + h * 128 + R0, cm), l1 = min(rb * 256 + h * 128 + R1, cm);
            __builtin_amdgcn_global_load_lds((const unsigned*)(lst + l0), slot + (h * 2) * NTHR, 4, 0, 0);
            __builtin_amdgcn_global_load_lds((const unsigned*)(lst + l1), slot + (h * 2 + 1) * NTHR, 4, 0, 0);
        }
    }
    __device__ __forceinline__ unsigned a_fin(unsigned raw, int C) const { return (unsigned)((int)(raw >> 2) * KP + C) * 2u; }
};

struct EpiInProj {
    const Params* p; int l;
    __device__ __forceinline__ const float* bias_ptr(const DenseUnit& u) const { return p->binp + l * NPAD + u.pn * 256; }
    __device__ __forceinline__ void init(f32x4 (&acc)[2][2][4][2], int wc, int fq, const LAS float* bias) const {
#pragma unroll
        for (int bj = 0; bj < 2; ++bj)
#pragma unroll
            for (int n = 0; n < 2; ++n) {
                const f32x4 bv = *(const LAS f32x4*)(bias + bj * 128 + wc * 32 + n * 16 + 4 * fq);
#pragma unroll
                for (int ai = 0; ai < 2; ++ai)
#pragma unroll
                    for (int m = 0; m < 4; ++m) acc[ai][bj][m][n] = bv;
            }
    }
    __device__ __forceinline__ void operator()(const f32x4 (&acc)[2][2][4][2], const DenseUnit& u, int wr, int wc, int fr, int fq, const LAS float*) const {
#pragma unroll
        for (int bj = 0; bj < 2; ++bj) {
            int kind = 0, hb0 = 0;
            if (u.pn == 1) { kind = 1; hb0 = bj * 2; } else if (u.pn == 4 && bj == 1) { kind = 1; hb0 = 4; } else if (u.pn == 8 && bj == 0) { kind = 1; hb0 = 6; } else if (u.pn == 9 && bj == 0) { kind = 1; hb0 = 8; }
            else if (u.pn == 2) { kind = 2; hb0 = bj * 2; } else if (u.pn == 5 && bj == 0) { kind = 2; hb0 = 4; } else if (u.pn == 8 && bj == 1) { kind = 2; hb0 = 6; } else if (u.pn == 9 && bj == 1) { kind = 2; hb0 = 8; }
            const int c0 = wc * 32 + fq * 8;
            const int hh = hb0 + (c0 >> 6), d0 = c0 & 63;
#pragma unroll
            for (int ai = 0; ai < 2; ++ai)
#pragma unroll
                for (int m = 0; m < 4; ++m) {
                    const int row = u.pm * 256 + ai * 128 + wr * 64 + m * 16 + fr;
                    const f32x4 v0 = acc[ai][bj][m][0], v1 = acc[ai][bj][m][1];
                    u32x4 w; w.x = pack2(v0[0], v0[1]); w.y = pack2(v0[2], v0[3]); w.z = pack2(v1[0], v1[1]); w.w = pack2(v1[2], v1[3]);
                    if (kind == 0) *(u32x4*)(p->hb + (size_t)row * NMAIN + u.pn * 256 + bj * 128 + c0) = w;
                    else {
                        const int b = row >> 11, s = row & 2047, kk = s & 31;
                        bf16_t* blk = (kind == 1 ? p->kF : p->vT) + (((size_t)b * NVH + hh) * 64 + (s >> 5)) * 2048;
                        if (kind == 1) {
                            const int frk = (kk >> 3) * 4 + (kk & 3), t = (kk >> 2) & 1;
                            *(u32x4*)(blk + ((t * 2 + (d0 >> 5)) * 64 + ((d0 & 31) >> 3) * 16 + frk) * 8) = w;
                        } else {
                            bf16_t* vt = blk + (((d0 >> 4) * 64) + (kk >> 3) * 16 + (d0 & 15)) * 8 + (kk & 7);
                            vt[0] = (bf16_t)(w.x & 0xffff); vt[8] = (bf16_t)(w.x >> 16); vt[16] = (bf16_t)(w.y & 0xffff); vt[24] = (bf16_t)(w.y >> 16);
                            vt[32] = (bf16_t)(w.z & 0xffff); vt[40] = (bf16_t)(w.z >> 16); vt[48] = (bf16_t)(w.w & 0xffff); vt[56] = (bf16_t)(w.w >> 16);
                        }
                    }
                }
        }
    }
};
struct EpiOutProj {
    const float* xin; float* t;
    __device__ __forceinline__ const float* bias_ptr(const DenseUnit&) const { return nullptr; }
    __device__ __forceinline__ void init(f32x4 (&acc)[2][2][4][2], int, int, const LAS float*) const {
#pragma unroll
        for (int ai = 0; ai < 2; ++ai)
#pragma unroll
            for (int bj = 0; bj < 2; ++bj)
#pragma unroll
                for (int m = 0; m < 4; ++m)
#pragma unroll
                    for (int n = 0; n < 2; ++n) acc[ai][bj][m][n] = (f32x4){0.f, 0.f, 0.f, 0.f};
    }
    __device__ __forceinline__ void operator()(const f32x4 (&acc)[2][2][4][2], const DenseUnit& u, int wr, int wc, int fr, int fq, const LAS float*) const {
#pragma unroll
        for (int ai = 0; ai < 2; ++ai)
#pragma unroll
            for (int m = 0; m < 4; ++m) {
                const size_t off = (size_t)(u.pm * 256 + ai * 128 + wr * 64 + m * 16 + fr) * DM + u.pn * 256 + wc * 64 + fq * 16;
                unsigned w[8];
#pragma unroll
                for (int q = 0; q < 4; ++q) {
                    const f32x4 xv = *(const f32x4*)(xin + off + q * 4);
                    const f32x4 tv = xv * ALPHA + acc[ai][q >> 1][m][q & 1];
                    w[2 * q] = pack2(tv[0], tv[1]); w[2 * q + 1] = pack2(tv[2], tv[3]);
                }
                u32x4 w0, w1; w0.x = w[0]; w0.y = w[1]; w0.z = w[2]; w0.w = w[3]; w1.x = w[4]; w1.y = w[5]; w1.z = w[6]; w1.w = w[7];
                *(u32x4*)((bf16_t*)t + off) = w0; *(u32x4*)((bf16_t*)t + off + 8) = w1;
            }
    }
};
struct EpiGateUp {
    bf16_t* act; const float* bgup;
    __device__ __forceinline__ const float* bias_ptr(const MoeUnit& u) const { return bgup + (size_t)u.e * 2048 + u.pn * 256; }
    __device__ __forceinline__ void init(f32x4 (&acc)[2][2][4][2], int wc, int fq, const LAS float* bias) const {
#pragma unroll
        for (int bj = 0; bj < 2; ++bj)
#pragma unroll
            for (int n = 0; n < 2; ++n) {
                const f32x4 bv = *(const LAS f32x4*)(bias + bj * 128 + wc * 32 + n * 16 + 4 * fq);
#pragma unroll
                for (int ai = 0; ai < 2; ++ai)
#pragma unroll
                    for (int m = 0; m < 4; ++m) acc[ai][bj][m][n] = bv;
            }
    }
    __device__ __forceinline__ void operator()(const f32x4 (&acc)[2][2][4][2], const MoeUnit& u, int wr, int wc, int fr, int fq, const LAS float*) const {
        constexpr float GMIN = 7.0f * GATE_PRE, CI = 1.0f / GATE_PRE;
#pragma unroll
        for (int ai = 0; ai < 2; ++ai)
#pragma unroll
            for (int m = 0; m < 4; ++m) {
                u32x2 w;
#pragma unroll
                for (int n = 0; n < 2; ++n) {
                    const f32x4 g4 = acc[ai][0][m][n], u4 = acc[ai][1][m][n];
                    float o[4];
#pragma unroll
                    for (int j = 0; j < 4; ++j) {
                        const float gp = fmaxf(g4[j], GMIN), uu = fminf(fmaxf(u4[j], -7.0f), 7.0f);
                        const float glu = gp * __builtin_amdgcn_rcpf(1.0f + __builtin_amdgcn_exp2f(gp));
                        o[j] = __builtin_fmaf(uu, CI, CI) * glu;
                    }
                    const unsigned pk = pack4_fp8(o[0], o[1], o[2], o[3]);
                    if (n == 0) w.x = pk; else w.y = pk;
                }
                *(u32x2*)((char*)act + (size_t)(u.rbt * 256 + ai * 128 + wr * 64 + m * 16 + fr) * DFF + u.pn * 128 + wc * 32 + fq * 8) = w;
            }
    }
};
struct EpiDown {
    bf16_t* ybuf; const float* bdn;
    __device__ __forceinline__ const float* bias_ptr(const MoeUnit& u) const { return bdn + (size_t)u.e * 1024 + u.pn * 256; }
    __device__ __forceinline__ void init(f32x4 (&acc)[2][2][4][2], int wc, int fq, const LAS float* bias) const {
#pragma unroll
        for (int bj = 0; bj < 2; ++bj)
#pragma unroll
            for (int n = 0; n < 2; ++n) {
                const f32x4 bv = *(const LAS f32x4*)(bias + wc * 64 + fq * 16 + bj * 8 + n * 4);
#pragma unroll
                for (int ai = 0; ai < 2; ++ai)
#pragma unroll
                    for (int m = 0; m < 4; ++m) acc[ai][bj][m][n] = bv;
            }
    }
    __device__ __forceinline__ void operator()(const f32x4 (&acc)[2][2][4][2], const MoeUnit& u, int wr, int wc, int fr, int fq, const LAS float*) const {
#pragma unroll
        for (int ai = 0; ai < 2; ++ai)
#pragma unroll
            for (int m = 0; m < 4; ++m) {
                u32x4 w;
                { const f32x4 v = acc[ai][0][m][0]; w.x = pack4_fp8(v[0], v[1], v[2], v[3]); }
                { const f32x4 v = acc[ai][0][m][1]; w.y = pack4_fp8(v[0], v[1], v[2], v[3]); }
                { const f32x4 v = acc[ai][1][m][0]; w.z = pack4_fp8(v[0], v[1], v[2], v[3]); }
                { const f32x4 v = acc[ai][1][m][1]; w.w = pack4_fp8(v[0], v[1], v[2], v[3]); }
                *(u32x4*)((unsigned char*)ybuf + (size_t)(u.rbt * 256 + ai * 128 + wr * 64 + m * 16 + fr) * DM + u.pn * 256 + wc * 64 + fq * 16) = w;
            }
    }
};

__device__ __forceinline__ void phase_inproj(const Params& p, int l, char* lds) {
    DenseSched S{(const char*)p.WinQ + (size_t)l * NMAIN * 1024, 512, NTOK / 256, NMAIN / 256, vcu_id()};
    EpiInProj E{&p, l};
    pg8::gemm_phase<true, 0x7c7c7c7c>((LAS unsigned char*)lds, (const char*)p.xq, 512, S, E);
    int tid = threadIdx.x; asm volatile("" : "+v"(tid));
    const int wid = tid >> 6, lane = tid & 63, fr = lane & 15, fq = lane >> 4;
    const bf16_t* W = p.WinT + ((size_t)l * NPAD + NMAIN) * 1024;
    const float* bias = p.binp + l * NPAD + NMAIN;
    for (int u = blockIdx.x * NWV + wid; u < NTOK / 16; u += gridDim.x * NWV) {
        const bf16_t* ar = p.xb + (size_t)(u * 16 + fr) * DM + fq * 8;
        const bf16_t* w0 = W + (size_t)fr * 1024 + fq * 8; const bf16_t* w1 = W + (size_t)(16 + fr) * 1024 + fq * 8;
        f32x4 a0 = (f32x4){0.f, 0.f, 0.f, 0.f}, a1 = a0;
#pragma unroll 4
        for (int ks = 0; ks < 32; ++ks) {
            const bf16x8 a = *(const bf16x8*)(ar + ks * 32);
            a0 = __builtin_amdgcn_mfma_f32_16x16x32_bf16(a, *(const bf16x8*)(w0 + ks * 32), a0, 0, 0, 0);
            a1 = __builtin_amdgcn_mfma_f32_16x16x32_bf16(a, *(const bf16x8*)(w1 + ks * 32), a1, 0, 0, 0);
        }
#pragma unroll
        for (int r = 0; r < 4; ++r) {
            float* dst = p.hs + (size_t)(u * 16 + fq * 4 + r) * HS_W;
            dst[fr] = a0[r] + bias[fr];
            if (fr < 6) dst[16 + fr] = a1[r] + bias[16 + fr];
        }
    }
}
__device__ __forceinline__ void phase_outproj(const Params& p, int l, const float* xin, char* lds) {
    DenseSched S{(const char*)p.WoT + (size_t)l * 1024 * 1024, 512, NTOK / 256, 4, vcu_id()};
    EpiOutProj E{xin, p.tbuf};
    pg8::gemm_phase<true, 0x7c7c7c7c>((LAS unsigned char*)lds, (const char*)p.ob, 512, S, E);
}
__device__ __forceinline__ void build_tiles(const Params& p, int l, int* ptile, int* ecnt) {
    int tid = threadIdx.x; asm volatile("" : "+v"(tid));
    if (tid < NE) ecnt[tid] = (int)__hip_atomic_load(p.ctrl + 64 + l * NE + tid, __ATOMIC_RELAXED, __HIP_MEMORY_SCOPE_AGENT);
    __syncthreads();
    if (tid == 0) { int s = 0; for (int e = 0; e < NE; ++e) { ptile[e] = s; s += (ecnt[e] + 255) >> 8; } ptile[NE] = s; }
    __syncthreads();
    unsigned char* texp = (unsigned char*)ptile + 512;
    for (int t = tid; t < ptile[NE]; t += NTHR) { int e = 0; while (ptile[e + 1] <= t) ++e; texp[t] = (unsigned char)e; }
    __syncthreads();
}
__device__ __forceinline__ void phase_gateup(const Params& p, int l, char* lds) {
    int* ptile = (int*)(lds + LDS_TAB); int* ecnt = ptile + 40;
    build_tiles(p, l, ptile, ecnt);
    MoeSched<true> S{(const char*)p.WguT + (size_t)l * NE * 2048 * 1024, p.lists, ptile, ecnt, 8, 2048, vcu_id()};
    EpiGateUp E{p.act, p.bgup + (size_t)l * NE * 2048};
    pg8::gemm_phase<true, 0x7c7c7c7c>((LAS unsigned char*)lds, (const char*)p.x1b, 512, S, E);
}
__device__ __forceinline__ void phase_down(const Params& p, int l, char* lds) {
    int* ptile = (int*)(lds + LDS_TAB); int* ecnt = ptile + 40;
    build_tiles(p, l, ptile, ecnt);
    MoeSched<false> S{(const char*)p.WdnT + (size_t)l * NE * 1024 * 1024, p.lists, ptile, ecnt, 4, 1024, vcu_id()};
    EpiDown E{p.ybuf, p.b_dn + (size_t)l * NE * 1024};
    pg8::gemm_phase<true, 0x7c7c7c7c>((LAS unsigned char*)lds, (const char*)p.act, 512, S, E);
}

__device__ __forceinline__ float gelu_tanh(float x) {
    const float u = 0.7978845608028654f * (x + 0.044715f * x * x * x);
    const float e = __expf(-2.0f * fabsf(u)); const float th = (1.0f - e) / (1.0f + e);
    return 0.5f * x * (1.0f + (u < 0.f ? -th : th));
}
__device__ __forceinline__ void phase_prep(const Params& p, int l, char* lds) {
    int tid = threadIdx.x; asm volatile("" : "+v"(tid));
    const int wid = tid >> 6, lane = tid & 63, fr = lane & 15, fq = lane >> 4;
    const int gw = blockIdx.x * NWV + wid, nw = gridDim.x * NWV;
    for (int u = (int)gridDim.x - 1 - (int)blockIdx.x; u < NB * 4; u += gridDim.x) {
        const int b = u >> 2, h = u & 3;
        const float* srcp = p.hs + ((size_t)b * SEQ + tid * 4) * HS_W + h;
        float ls[4]; float tot = 0.f;
#pragma unroll
        for (int i = 0; i < 4; ++i) { const float f = srcp[(size_t)i * HS_W]; ls[i] = fminf(f, 0.f) - log1pf(__expf(-fabsf(f))); tot += ls[i]; }
        float inc = tot;
#pragma unroll
        for (int o = 1; o < 64; o <<= 1) { const float v = shfl_f(inc, lane - o); if (lane >= o) inc += v; }
        float* wtot = (float*)(lds + 65536);
        if (lane == 63) wtot[wid] = inc;
        __syncthreads();
        float base = inc - tot;
        for (int w = 0; w < wid; ++w) base += wtot[w];
        float4 o4; o4.x = base + ls[0]; o4.y = o4.x + ls[1]; o4.z = o4.y + ls[2]; o4.w = o4.z + ls[3];
        *(float4*)(p.cF + (size_t)u * SEQ + tid * 4) = o4;
        __syncthreads();
    }
    float* part = (float*)lds;
    bf16_t* h1 = (bf16_t*)(lds + 32768);
    for (int u = blockIdx.x; u < NB * 2 * 2 * 8; u += gridDim.x) {
        const int ct = u & 7, which = (u >> 3) & 1, kvh = (u >> 4) & 1, b = u >> 5;
        const int colo = (which ? C_NVC : C_NKC) + kvh * 64;
        const int c_lane = ct * 16 + fr;
        const int tokbase = min(c_lane, 126) * 16;
        const bf16_t* arow = p.hb + ((size_t)b * SEQ + tokbase) * NMAIN + colo + fq * 8;
        const bf16_t* w1 = p.W1T + ((size_t)(l * 2 + which) * 64 + fr) * 2048 + fq * 8;
        f32x4 acc[4];
#pragma unroll
        for (int n = 0; n < 4; ++n) acc[n] = (f32x4){0.f, 0.f, 0.f, 0.f};
#pragma unroll
        for (int kk = 0; kk < 8; ++kk) {
            const int ks = wid * 8 + kk;
            const bf16x8 a = *(const bf16x8*)(arow + (size_t)(ks >> 1) * NMAIN + (ks & 1) * 32);
#pragma unroll
            for (int n = 0; n < 4; ++n) {
                const bf16x8 bb = *(const bf16x8*)(w1 + (size_t)n * 16 * 2048 + ks * 32);
                acc[n] = __builtin_amdgcn_mfma_f32_16x16x32_bf16(a, bb, acc[n], 0, 0, 0);
            }
        }
#pragma unroll
        for (int n = 0; n < 4; ++n)
#pragma unroll
            for (int r = 0; r < 4; ++r) part[wid * 1024 + (fq * 4 + r) * 64 + n * 16 + fr] = acc[n][r];
        __syncthreads();
        const float* b1 = p.b1c + (l * 2 + which) * 64;
#pragma unroll
        for (int i = 0; i < 2; ++i) {
            const int e = tid + NTHR * i; float sum = 0.f;
#pragma unroll
            for (int w = 0; w < 8; ++w) sum += part[w * 1024 + e];
            h1[e] = f2bf(gelu_tanh(sum + b1[e & 63]));
        }
        __syncthreads();
        if (wid == 0) {
            const bf16_t* w2 = p.W2T + ((size_t)(l * 2 + which) * 64 + fr) * 64 + fq * 8;
            f32x4 o2[4];
#pragma unroll
            for (int n = 0; n < 4; ++n) o2[n] = (f32x4){0.f, 0.f, 0.f, 0.f};
#pragma unroll
            for (int ks = 0; ks < 2; ++ks) {
                const bf16x8 a = *(const bf16x8*)(h1 + fr * 64 + ks * 32 + fq * 8);
#pragma unroll
                for (int n = 0; n < 4; ++n) {
                    const bf16x8 bb = *(const bf16x8*)(w2 + (size_t)n * 16 * 64 + ks * 32);
                    o2[n] = __builtin_amdgcn_mfma_f32_16x16x32_bf16(a, bb, o2[n], 0, 0, 0);
                }
            }
            const size_t base = ((size_t)b * 2 + kvh) * 128 * 64;
#pragma unroll
            for (int n = 0; n < 4; ++n)
#pragma unroll
                for (int r = 0; r < 4; ++r) {
                    const int c = ct * 16 + fq * 4 + r, j2 = n * 16 + fr;
                    const bf16_t v = c < 127 ? f2bf(o2[n][r]) : (bf16_t)0;
                    if (which == 0) p.kc[base + (size_t)c * 64 + j2] = v;
                    else { p.vc[base + (size_t)c * 64 + j2] = v; p.vcT[base + (size_t)j2 * 128 + c] = v; }
                }
        }
        __syncthreads();
    }
}

constexpr float L2E = 1.4426950408889634f, MASKV = -__builtin_huge_valf(), MINIT = -1e30f, SCL2 = QSCALE * L2E;
struct KVFrag { bf16x8 k[2][2]; bf16x8 v[4]; };
template <bool FM>
__device__ __forceinline__ void k_load(KVFrag& f, const bf16_t* __restrict__ Kb, size_t ldk, int kc0, int fr, int fq) {
    if (FM) {
        const bf16_t* kp = Kb + (size_t)(kc0 >> 5) * 2048 + (fq * 16 + fr) * 8;
        f.k[0][0] = *(const bf16x8*)(kp); f.k[0][1] = *(const bf16x8*)(kp + 512); f.k[1][0] = *(const bf16x8*)(kp + 1024); f.k[1][1] = *(const bf16x8*)(kp + 1536);
    } else {
        const bf16_t* kp = Kb + (size_t)(kc0 + (fr >> 2) * 8 + (fr & 3)) * ldk + fq * 8;
        f.k[0][0] = *(const bf16x8*)(kp); f.k[0][1] = *(const bf16x8*)(kp + 32);
        f.k[1][0] = *(const bf16x8*)(kp + 4 * ldk); f.k[1][1] = *(const bf16x8*)(kp + 4 * ldk + 32);
    }
}
template <bool FM>
__device__ __forceinline__ void v_load(bf16x8 (&v)[4], const bf16_t* __restrict__ VTb, size_t ldv, int kc0, int fr, int fq) {
    if (FM) {
        const bf16_t* vp = VTb + (size_t)(kc0 >> 5) * 2048 + (fq * 16 + fr) * 8;
#pragma unroll
        for (int dt = 0; dt < 4; ++dt) v[dt] = *(const bf16x8*)(vp + dt * 512);
    } else {
        const bf16_t* vp = VTb + (size_t)fr * ldv + kc0 + fq * 8;
#pragma unroll
        for (int dt = 0; dt < 4; ++dt) v[dt] = *(const bf16x8*)(vp + (size_t)dt * 16 * ldv);
    }
}
__device__ __forceinline__ float rowmax4(float x) {
    auto r = __builtin_amdgcn_permlane32_swap(__float_as_uint(x), __float_as_uint(x), false, false);
    x = fmaxf(__uint_as_float(r[0]), __uint_as_float(r[1]));
    auto q = __builtin_amdgcn_permlane16_swap(__float_as_uint(x), __float_as_uint(x), false, false);
    return fmaxf(__uint_as_float(q[0]), __uint_as_float(q[1]));
}
__device__ __forceinline__ float rowsum4(float x) {
    auto r = __builtin_amdgcn_permlane32_swap(__float_as_uint(x), __float_as_uint(x), false, false);
    x = __uint_as_float(r[0]) + __uint_as_float(r[1]);
    auto q = __builtin_amdgcn_permlane16_swap(__float_as_uint(x), __float_as_uint(x), false, false);
    return __uint_as_float(q[0]) + __uint_as_float(q[1]);
}
template <int NQT, bool MASK, class MB>
__device__ __forceinline__ void attn_compute(const KVFrag& f, const bf16x8 (&qf)[NQT][2], f32x4 (&o)[NQT][4], float (&m)[NQT], float (&l)[NQT], const MB& mb) {
    f32x4 s0[NQT], s1[NQT];
#pragma unroll
    for (int qt = 0; qt < NQT; ++qt) {
        s0[qt] = __builtin_amdgcn_mfma_f32_16x16x32_bf16(f.k[0][0], qf[qt][0], (f32x4){0.f, 0.f, 0.f, 0.f}, 0, 0, 0);
        s1[qt] = __builtin_amdgcn_mfma_f32_16x16x32_bf16(f.k[1][0], qf[qt][0], (f32x4){0.f, 0.f, 0.f, 0.f}, 0, 0, 0);
    }
#pragma unroll
    for (int qt = 0; qt < NQT; ++qt) {
        s0[qt] = __builtin_amdgcn_mfma_f32_16x16x32_bf16(f.k[0][1], qf[qt][1], s0[qt], 0, 0, 0);
        s1[qt] = __builtin_amdgcn_mfma_f32_16x16x32_bf16(f.k[1][1], qf[qt][1], s1[qt], 0, 0, 0);
    }
    float mx[NQT];
#pragma unroll
    for (int qt = 0; qt < NQT; ++qt) {
#pragma unroll
        for (int j = 0; j < 4; ++j) { s0[qt][j] = mb(qt, j, s0[qt][j]); s1[qt][j] = mb(qt, j + 4, s1[qt][j]); }
        mx[qt] = fmaxf(fmaxf(fmaxf(s0[qt][0], s0[qt][1]), fmaxf(s0[qt][2], s0[qt][3])), fmaxf(fmaxf(s1[qt][0], s1[qt][1]), fmaxf(s1[qt][2], s1[qt][3])));
    }
#pragma unroll
    for (int qt = 0; qt < NQT; ++qt) mx[qt] = rowmax4(mx[qt]);
    bool moved = false;
#pragma unroll
    for (int qt = 0; qt < NQT; ++qt) { mx[qt] = fmaxf(m[qt], mx[qt]); moved |= (mx[qt] != m[qt]); }
    if (__ballot(moved) != 0ull) {
#pragma unroll
        for (int qt = 0; qt < NQT; ++qt) {
            const float alpha = __builtin_amdgcn_exp2f(m[qt] - mx[qt]);
            l[qt] *= alpha;
#pragma unroll
            for (int dt = 0; dt < 4; ++dt) o[qt][dt] *= alpha;
        }
    }
    bf16x8 pf[NQT];
#pragma unroll
    for (int qt = 0; qt < NQT; ++qt) {
        m[qt] = mx[qt];
        float pr[8]; float ps = 0.f;
#pragma unroll
        for (int j = 0; j < 4; ++j) {
            pr[j] = __builtin_amdgcn_exp2f(s0[qt][j] - mx[qt]);
            pr[j + 4] = __builtin_amdgcn_exp2f(s1[qt][j] - mx[qt]);
        }
#pragma unroll
        for (int j = 0; j < 8; ++j) ps += pr[j];
        l[qt] += ps;
        const u32x4 pk = {pack2(pr[0], pr[1]), pack2(pr[2], pr[3]), pack2(pr[4], pr[5]), pack2(pr[6], pr[7])};
        pf[qt] = __builtin_bit_cast(bf16x8, pk);
    }
#pragma unroll
    for (int dt = 0; dt < 4; ++dt)
#pragma unroll
        for (int qt = 0; qt < NQT; ++qt) o[qt][dt] = __builtin_amdgcn_mfma_f32_16x16x32_bf16(f.v[dt], pf[qt], o[qt][dt], 0, 0, 0);
    __builtin_amdgcn_sched_barrier(0);
}
struct RangeIt { int c, c_hi; __device__ __forceinline__ int nxt() { if (c > c_hi) return -1; return (c++) * 32; } };
struct MaskIt { unsigned long long cm; __device__ __forceinline__ int nxt() { if (!cm) return -1; const int i = __builtin_ctzll(cm); cm &= cm - 1; return i * 32; } };
template <bool PFV, bool FM, class It, class Gen>
__device__ __forceinline__ void attn_run(It& it, const bf16_t* Kb, size_t ldk, const bf16_t* VTb, size_t ldv, int fr, int fq, const Gen& gen) {
    KVFrag fa, fb;
    int ka = it.nxt(); if (ka < 0) return;
    k_load<FM>(fa, Kb, ldk, ka, fr, fq); if (PFV) v_load<FM>(fa.v, VTb, ldv, ka, fr, fq);
    for (;;) {
        const int kb = it.nxt(); if (kb >= 0) { k_load<FM>(fb, Kb, ldk, kb, fr, fq); if (PFV) v_load<FM>(fb.v, VTb, ldv, kb, fr, fq); }
        if (!PFV) v_load<FM>(fa.v, VTb, ldv, ka, fr, fq);
        gen(ka, fa);
        if (kb < 0) break;
        ka = it.nxt(); if (ka >= 0) { k_load<FM>(fa, Kb, ldk, ka, fr, fq); if (PFV) v_load<FM>(fa.v, VTb, ldv, ka, fr, fq); }
        if (!PFV) v_load<FM>(fb.v, VTb, ldv, kb, fr, fq);
        gen(kb, fb);
        if (ka < 0) break;
    }
}
template <int NQT>
__device__ __forceinline__ void attn_init(f32x4 (&o)[NQT][4], float (&m)[NQT], float (&l)[NQT]) {
#pragma unroll
    for (int qt = 0; qt < NQT; ++qt) { m[qt] = MINIT; l[qt] = 0.f;
#pragma unroll
        for (int dt = 0; dt < 4; ++dt) o[qt][dt] = (f32x4){0.f, 0.f, 0.f, 0.f}; }
}
__device__ __forceinline__ float lsum4(float l) { return rowsum4(l); }
__device__ __forceinline__ void store_o4(unsigned char* dst, const f32x4 v) { *(unsigned*)dst = pack4_fp8(v[0], v[1], v[2], v[3]); }
__device__ __forceinline__ float sigmoidf_fast(float x) { return __builtin_amdgcn_rcpf(1.0f + __builtin_amdgcn_exp2f(-L2E * x)); }

__device__ __forceinline__ void fox_unit(const Params& p, int b, int h, int qb, int fr, int fq) {
    asm volatile("" : "+v"(fr), "+v"(fq));
    const int t0 = qb * 64;
    const bf16_t* Qb = p.hb + ((size_t)b * SEQ + t0) * NMAIN + C_FQ + h * 64 + fq * 8;
    bf16x8 qf[4][2];
#pragma unroll
    for (int qt = 0; qt < 4; ++qt) { qf[qt][0] = *(const bf16x8*)(Qb + (size_t)(qt * 16 + fr) * NMAIN); qf[qt][1] = *(const bf16x8*)(Qb + (size_t)(qt * 16 + fr) * NMAIN + 32); }
    const float* cf = p.cF + ((size_t)b * 4 + h) * SEQ;
    float cq[4];
#pragma unroll
    for (int qt = 0; qt < 4; ++qt) cq[qt] = cf[t0 + qt * 16 + fr] * L2E;
    f32x4 o[4][4]; float m[4], l[4];
    attn_init<4>(o, m, l);
    const bf16_t* Kb = p.kF + ((size_t)b * NVH + h) * 64 * SEQ;
    const bf16_t* VTb = p.vT + ((size_t)b * NVH + h) * 64 * SEQ;
    RangeIt it{0, (t0 >> 5) + 1};
    attn_run<false, true>(it, Kb, NMAIN, VTb, SEQ, fr, fq, [&](int kc0, const KVFrag& f) {
        const float4 ca = *(const float4*)(cf + kc0 + 8 * fq), cb = *(const float4*)(cf + kc0 + 8 * fq + 4);
        const float ck[8] = {ca.x * L2E, ca.y * L2E, ca.z * L2E, ca.w * L2E, cb.x * L2E, cb.y * L2E, cb.z * L2E, cb.w * L2E};
        const int kq = kc0 + 8 * fq - t0 - fr;
        attn_compute<4, true>(f, qf, o, m, l, [&](int qt, int j, float raw) { return (kq + j - 16 * qt) > 0 ? MASKV : raw * SCL2 + cq[qt] - ck[j]; });
    });
#pragma unroll
    for (int qt = 0; qt < 4; ++qt) {
        const float inv = __builtin_amdgcn_rcpf(lsum4(l[qt]));
        unsigned char* dst = (unsigned char*)p.ob + ((size_t)b * SEQ + t0 + qt * 16 + fr) * DM + h * 64 + 4 * fq;
#pragma unroll
        for (int dt = 0; dt < 4; ++dt) store_o4(dst + dt * 16, o[qt][dt] * inv);
    }
}
__device__ __forceinline__ void swa_unit(const Params& p, int l_, int b, int kv, int pos, int fr, int fq) {
    asm volatile("" : "+v"(fr), "+v"(fq));
    const int t0 = pos * 16, t = t0 + fr;
    const bf16_t* Qb = p.hb + ((size_t)b * SEQ + t) * NMAIN + C_SQ + kv * 192 + fq * 8;
    bf16x8 qf[3][2];
#pragma unroll
    for (int g = 0; g < 3; ++g) { qf[g][0] = *(const bf16x8*)(Qb + g * 64); qf[g][1] = *(const bf16x8*)(Qb + g * 64 + 32); }
    float sl[3];
#pragma unroll
    for (int g = 0; g < 3; ++g) sl[g] = slope_swa(kv * 3 + g) * L2E;
    f32x4 o[3][4]; float m[3], l[3];
    attn_init<3>(o, m, l);
    const bf16_t* Kb = p.kF + ((size_t)b * NVH + 4 + kv) * 64 * SEQ;
    const bf16_t* VTb = p.vT + ((size_t)b * NVH + 4 + kv) * 64 * SEQ;
    RangeIt it{max(0, t0 - 127) >> 5, (t0 + 15) >> 5};
    attn_run<true, true>(it, Kb, NMAIN, VTb, SEQ, fr, fq, [&](int kc0, const KVFrag& f) {
        const int dq = t - kc0 - 8 * fq;
        attn_compute<3, true>(f, qf, o, m, l, [&](int g, int j, float raw) { const int dist = dq - j; return ((unsigned)dist < 128u) ? raw * SCL2 - sl[g] * (float)dist : MASKV; });
    });
#pragma unroll
    for (int g = 0; g < 3; ++g) {
        const float sink = p.sinks[l_ * 6 + kv * 3 + g] * L2E;
        const float inv = __builtin_amdgcn_rcpf(lsum4(l[g]) + __builtin_amdgcn_exp2f(sink - m[g]));
        unsigned char* dst = (unsigned char*)p.ob + ((size_t)b * SEQ + t) * DM + 256 + (kv * 3 + g) * 64 + 4 * fq;
#pragma unroll
        for (int dt = 0; dt < 4; ++dt) store_o4(dst + dt * 16, o[g][dt] * inv);
    }
}
__device__ __forceinline__ void nsa_unit(const Params& p, int b, int kv, int pos, int fr, int fq, int lane, float* ps, unsigned* msk, float* otl) {
    asm volatile("" : "+v"(fr), "+v"(fq), "+v"(lane));
    const int t0 = pos * 16, t = t0 + fr, cur = t0 >> 6;
    const bf16_t* Qb = p.hb + ((size_t)b * SEQ + t) * NMAIN + C_NQ + kv * 192 + fq * 8;
    bf16x8 qf[3][2];
#pragma unroll
    for (int g = 0; g < 3; ++g) { qf[g][0] = *(const bf16x8*)(Qb + g * 64); qf[g][1] = *(const bf16x8*)(Qb + g * 64 + 32); }
    float sl[3];
#pragma unroll
    for (int g = 0; g < 3; ++g) sl[g] = slope_nsa(kv * 3 + g) * L2E;
    const float* gl = p.hs + ((size_t)b * SEQ + t) * HS_W + 4 + kv * 9;
    f32x4 o[3][4]; float m[3], l[3];
    f32x4* otv = (f32x4*)otl + lane;
#pragma unroll
    for (int i = 0; i < 8; ++i) ps[lane + 64 * i] = 0.f;
    {
        const bf16_t* Kb = p.kc + ((size_t)b * 2 + kv) * 128 * 64;
        const bf16_t* VTb = p.vcT + ((size_t)b * 2 + kv) * 64 * 128;
        const int ncv = (t0 + 15 >= 31) ? ((t0 + 15 - 31) >> 4) + 1 : 0;
        const int nch = (ncv + 31) >> 5;
        attn_init<3>(o, m, l);
        const int dq0 = t - 31 - 16 * 8 * fq;
        RangeIt it{0, nch - 1};
        attn_run<false, false>(it, Kb, 64, VTb, 128, fr, fq, [&](int kc0, const KVFrag& f) {
            const int dq = dq0 - 16 * kc0;
            attn_compute<3, true>(f, qf, o, m, l, [&](int g, int j, float raw) { const int dist = dq - 16 * j; return dist >= 0 ? raw * SCL2 - sl[g] * (float)dist : MASKV; });
        });
        float il[3];
#pragma unroll
        for (int g = 0; g < 3; ++g) {
            const float lt = lsum4(l[g]); il[g] = lt > 0.f ? __builtin_amdgcn_rcpf(lt) : 0.f;
            const float gate = sigmoidf_fast(gl[g * 3 + 0]);
#pragma unroll
            for (int dt = 0; dt < 4; ++dt) otv[(g * 4 + dt) * 64] = o[g][dt] * (il[g] * gate);
        }
        float carry_prev = 0.f;
        for (int c = 0; c < nch; ++c) {
            const int kc0 = c * 32, dq = dq0 - 16 * kc0;
            const bf16_t* kp = Kb + (size_t)(kc0 + (fr >> 2) * 8 + (fr & 3)) * 64 + fq * 8;
            const bf16x8 k00 = *(const bf16x8*)(kp), k01 = *(const bf16x8*)(kp + 32), k10 = *(const bf16x8*)(kp + 256), k11 = *(const bf16x8*)(kp + 256 + 32);
            float pc[8];
#pragma unroll
            for (int j = 0; j < 8; ++j) pc[j] = 0.f;
#pragma unroll
            for (int g = 0; g < 3; ++g) {
                f32x4 s0 = (f32x4){0.f, 0.f, 0.f, 0.f}, s1 = s0;
                s0 = __builtin_amdgcn_mfma_f32_16x16x32_bf16(k00, qf[g][0], s0, 0, 0, 0); s0 = __builtin_amdgcn_mfma_f32_16x16x32_bf16(k01, qf[g][1], s0, 0, 0, 0);
                s1 = __builtin_amdgcn_mfma_f32_16x16x32_bf16(k10, qf[g][0], s1, 0, 0, 0); s1 = __builtin_amdgcn_mfma_f32_16x16x32_bf16(k11, qf[g][1], s1, 0, 0, 0);
#pragma unroll
                for (int j = 0; j < 8; ++j) {
                    const int dist = dq - 16 * j; const float raw = j < 4 ? s0[j] : s1[j - 4];
                    if (dist >= 0) pc[j] += __builtin_amdgcn_exp2f(raw * SCL2 - sl[g] * (float)dist - m[g]) * il[g];
                }
            }
            const float cout = 0.5f * pc[7];
            float cin = shfl_f(cout, lane - 16);
            const float cwrap = shfl_f(cout, fr + 48);
            if (fq == 0) cin = carry_prev;
            carry_prev = cwrap;
            const int n0 = (kc0 >> 2) + 2 * fq;
            ps[fr * 32 + n0] = cin + pc[0] + pc[1] + pc[2] + 0.5f * pc[3];
            ps[fr * 32 + n0 + 1] = 0.5f * pc[3] + pc[4] + pc[5] + pc[6] + 0.5f * pc[7];
        }
    }
    lds_wave_sync();
    if (lane < 16) {
        unsigned mask = 1u | (1u << cur); if (cur >= 1) mask |= 1u << (cur - 1);
        if (cur >= 3) {
            if (cur - 2 <= 5) mask |= (1u << (cur - 1)) - 2u;
            else {
                const float* my = ps + lane * 32;
                for (int r = 0; r < 5; ++r) {
                    float best = -1.0f; int bi = 1;
                    for (int j = 1; j <= cur - 2; ++j) { const float v = my[j]; if (!((mask >> j) & 1u) && v > best) { best = v; bi = j; } }
                    mask |= 1u << bi;
                }
            }
        }
        msk[lane] = mask;
    }
    lds_wave_sync();
    const unsigned qmask = msk[fr];
    lds_wave_sync();
    {
        const bf16_t* Kb = p.kF + ((size_t)b * NVH + 6 + kv) * 64 * SEQ;
        const bf16_t* VTb = p.vT + ((size_t)b * NVH + 6 + kv) * 64 * SEQ;
        attn_init<3>(o, m, l);
        unsigned um = qmask;
        um |= shfl_u(um, lane ^ 1); um |= shfl_u(um, lane ^ 2); um |= shfl_u(um, lane ^ 4); um |= shfl_u(um, lane ^ 8);
        um = (unsigned)__builtin_amdgcn_readfirstlane((int)um) & (cur >= 31 ? 0xffffffffu : ((2u << cur) - 1u));
        unsigned long long cm = 0ull;
        for (unsigned r = um; r; r &= r - 1) { const int kb = __builtin_ctz(r); cm |= 3ull << (2 * kb); }
        MaskIt it{cm};
        attn_run<true, true>(it, Kb, NMAIN, VTb, SEQ, fr, fq, [&](int kc0, const KVFrag& f) {
            const bool mine = (qmask >> (kc0 >> 6)) & 1u;
            const int dq = t - kc0 - 8 * fq;
            attn_compute<3, true>(f, qf, o, m, l, [&](int g, int j, float raw) { const int dist = dq - j; return (mine && dist >= 0) ? raw * SCL2 - sl[g] * (float)dist : MASKV; });
        });
#pragma unroll
        for (int g = 0; g < 3; ++g) {
            const float lt = lsum4(l[g]); const float sc = (lt > 0.f ? __builtin_amdgcn_rcpf(lt) : 0.f) * sigmoidf_fast(gl[g * 3 + 1]);
#pragma unroll
            for (int dt = 0; dt < 4; ++dt) otv[(g * 4 + dt) * 64] += o[g][dt] * sc;
        }
    }
    {
        const bf16_t* Kb = p.kF + ((size_t)b * NVH + 8 + kv) * 64 * SEQ;
        const bf16_t* VTb = p.vT + ((size_t)b * NVH + 8 + kv) * 64 * SEQ;
        attn_init<3>(o, m, l);
        RangeIt it{max(0, t0 - 511) >> 5, (t0 + 15) >> 5};
        attn_run<true, true>(it, Kb, NMAIN, VTb, SEQ, fr, fq, [&](int kc0, const KVFrag& f) {
            const int dq = t - kc0 - 8 * fq;
            attn_compute<3, true>(f, qf, o, m, l, [&](int g, int j, float raw) { const int dist = dq - j; return ((unsigned)dist < 512u) ? raw * SCL2 - sl[g] * (float)dist : MASKV; });
        });
#pragma unroll
        for (int g = 0; g < 3; ++g) {
            const float lt = lsum4(l[g]); const float sc = (lt > 0.f ? __builtin_amdgcn_rcpf(lt) : 0.f) * sigmoidf_fast(gl[g * 3 + 2]);
            unsigned char* dst = (unsigned char*)p.ob + ((size_t)b * SEQ + t) * DM + 640 + (kv * 3 + g) * 64 + 4 * fq;
#pragma unroll
            for (int dt = 0; dt < 4; ++dt) store_o4(dst + dt * 16, otv[(g * 4 + dt) * 64] + o[g][dt] * sc);
        }
    }
}

template <bool WITH_CONV>
__device__ __forceinline__ void phase_attn(const Params& p, int l, char* lds, int cslot = 16) {
    int tid = threadIdx.x; asm volatile("" : "+v"(tid));
    const int wid = tid >> 6, lane = tid & 63, fr = lane & 15, fq = lane >> 4;
    float* ps = (float*)(lds + wid * 16896); unsigned* msk = (unsigned*)(ps + 512); float* otl = ps + 576;
    unsigned* ctr = p.ctrl + cslot + l;
    constexpr unsigned NU_NSA = NB * 2 * 128, NU_FOX = NB * 4 * 32, NU_SWA = NB * 2 * 128, NU_ATT = NU_NSA + NU_FOX + NU_SWA;
    for (;;) {
        unsigned u = 0;
        if (lane == 0) u = __hip_atomic_fetch_add(ctr, 1u, __ATOMIC_RELAXED, __HIP_MEMORY_SCOPE_AGENT);
        u = (unsigned)__builtin_amdgcn_readfirstlane((int)u);
        if (WITH_CONV) {
            constexpr unsigned TOTQ = NU_ATT + (unsigned)CONV_TILES;
            if (u >= TOTQ) break;
            const unsigned a0 = (unsigned)(((unsigned long long)u * NU_ATT) / TOTQ), a1 = (unsigned)(((unsigned long long)(u + 1) * NU_ATT) / TOTQ);
            if (a1 == a0) { conv_tile_wave(p, (int)(u - a0), lane, (unsigned char*)ps); continue; }
            u = a0;
        } else {
#ifndef ATT_REP
#define ATT_REP 1
#endif
            if (u >= ATT_REP * NU_ATT) break;
            if (ATT_REP > 1) u %= NU_ATT;
        }
        if (u < NU_NSA) { const int pos = 127 - (int)(u & 127), r = u >> 7; nsa_unit(p, r >> 1, r & 1, pos, fr, fq, lane, ps, msk, otl); }
        else if (u < NU_NSA + NU_FOX) { const unsigned v = u - NU_NSA; const int qb = 31 - (int)(v & 31), r = v >> 5; fox_unit(p, r >> 2, r & 3, qb, fr, fq); }
        else { const unsigned v = u - NU_NSA - NU_FOX; const int pos = 127 - (int)(v & 127), r = v >> 7; swa_unit(p, l, r >> 1, r & 1, pos, fr, fq); }
    }
}

__device__ __forceinline__ void phase_ln1_router(const Params& p, int l, char* lds) {
    int tid = threadIdx.x; asm volatile("" : "+v"(tid));
    const int wid = tid >> 6, lane = tid & 63, fr = lane & 15, fq = lane >> 4;
    float* lg = (float*)lds + wid * 512;
    int* lcnt = (int*)(lds + 16384); int* lbase = lcnt + 32;
    const float* g1 = p.ln1_g + l * DM; const float* b1 = p.ln1_b + l * DM;
    const float* rw = p.rwT + (size_t)l * NE * 1024; const float* rb = p.router_b + l * NE;
    unsigned* gcount = p.ctrl + 64 + l * NE;
    for (int grp = blockIdx.x; grp < NTOK / 128; grp += gridDim.x) {
        const int tok0 = grp * 128 + wid * 16;
        if (tid < 32) lcnt[tid] = 0;
        float4 gg[4], bb[4];
#pragma unroll
        for (int j = 0; j < 4; ++j) { gg[j] = *(const float4*)(g1 + j * 256 + lane * 4); bb[j] = *(const float4*)(b1 + j * 256 + lane * 4); }
        for (int r0 = 0; r0 < 16; r0 += 4) {
            float4 v[4][4]; float s[4], qv[4];
#pragma unroll
            for (int i = 0; i < 4; ++i)
#pragma unroll
                for (int j = 0; j < 4; ++j) { const u32x2 w = *(const u32x2*)((const bf16_t*)p.tbuf + (size_t)(tok0 + r0 + i) * DM + j * 256 + lane * 4);
                    v[i][j] = make_float4(__uint_as_float(w.x << 16), __uint_as_float(w.x & 0xffff0000u), __uint_as_float(w.y << 16), __uint_as_float(w.y & 0xffff0000u)); }
#pragma unroll
            for (int i = 0; i < 4; ++i) { s[i] = 0.f;
#pragma unroll
                for (int j = 0; j < 4; ++j) s[i] += (v[i][j].x + v[i][j].y) + (v[i][j].z + v[i][j].w); }
#pragma unroll
            for (int o = 32; o > 0; o >>= 1) {
#pragma unroll
                for (int i = 0; i < 4; ++i) s[i] += shfl_f(s[i], lane ^ o); }
#pragma unroll
            for (int i = 0; i < 4; ++i) { const float mean = s[i] * (1.0f / 1024.0f); qv[i] = 0.f;
#pragma unroll
                for (int j = 0; j < 4; ++j) { v[i][j].x -= mean; v[i][j].y -= mean; v[i][j].z -= mean; v[i][j].w -= mean; qv[i] += (v[i][j].x * v[i][j].x + v[i][j].y * v[i][j].y) + (v[i][j].z * v[i][j].z + v[i][j].w * v[i][j].w); } }
#pragma unroll
            for (int o = 32; o > 0; o >>= 1) {
#pragma unroll
                for (int i = 0; i < 4; ++i) qv[i] += shfl_f(qv[i], lane ^ o); }
#pragma unroll
            for (int i = 0; i < 4; ++i) {
                const float rstd = rsqrtf(qv[i] * (1.0f / 1024.0f) + LN_EPS);
                const size_t row = (size_t)(tok0 + r0 + i);
#pragma unroll
                for (int j = 0; j < 4; ++j) {
                    const int c = j * 256 + lane * 4;
                    float4 y; y.x = v[i][j].x * rstd * gg[j].x + bb[j].x; y.y = v[i][j].y * rstd * gg[j].y + bb[j].y; y.z = v[i][j].z * rstd * gg[j].z + bb[j].z; y.w = v[i][j].w * rstd * gg[j].w + bb[j].w;
                    { u32x2 w; w.x = pack2(y.x, y.y); w.y = pack2(y.z, y.w); *(u32x2*)((bf16_t*)p.x1f + row * DM + c) = w; }
                    *(unsigned*)((char*)p.x1b + row * DM + c) = pack4_fp8(y.x, y.y, y.z, y.w);
                }
            }
        }
        __syncthreads();
        f32x4 a0 = (f32x4){0.f, 0.f, 0.f, 0.f}, a1 = a0;
        const bf16_t* xr = (const bf16_t*)p.x1f + (size_t)(tok0 + fr) * DM + 4 * fq;
        const float* w0 = rw + (size_t)fr * 1024 + 4 * fq; const float* w1 = rw + (size_t)(16 + fr) * 1024 + 4 * fq;
#pragma unroll 4
        for (int k0 = 0; k0 < 1024; k0 += 16) {
            const u32x2 xw = *(const u32x2*)(xr + k0); const float4 wb0 = *(const float4*)(w0 + k0), wb1 = *(const float4*)(w1 + k0);
            const float4 xa = make_float4(__uint_as_float(xw.x << 16), __uint_as_float(xw.x & 0xffff0000u), __uint_as_float(xw.y << 16), __uint_as_float(xw.y & 0xffff0000u));
            a0 = __builtin_amdgcn_mfma_f32_16x16x4f32(xa.x, wb0.x, a0, 0, 0, 0); a1 = __builtin_amdgcn_mfma_f32_16x16x4f32(xa.x, wb1.x, a1, 0, 0, 0);
            a0 = __builtin_amdgcn_mfma_f32_16x16x4f32(xa.y, wb0.y, a0, 0, 0, 0); a1 = __builtin_amdgcn_mfma_f32_16x16x4f32(xa.y, wb1.y, a1, 0, 0, 0);
            a0 = __builtin_amdgcn_mfma_f32_16x16x4f32(xa.z, wb0.z, a0, 0, 0, 0); a1 = __builtin_amdgcn_mfma_f32_16x16x4f32(xa.z, wb1.z, a1, 0, 0, 0);
            a0 = __builtin_amdgcn_mfma_f32_16x16x4f32(xa.w, wb0.w, a0, 0, 0, 0); a1 = __builtin_amdgcn_mfma_f32_16x16x4f32(xa.w, wb1.w, a1, 0, 0, 0);
        }
#pragma unroll
        for (int r = 0; r < 4; ++r) { lg[(fq * 4 + r) * 32 + fr] = a0[r] + rb[fr]; lg[(fq * 4 + r) * 32 + 16 + fr] = a1[r] + rb[16 + fr]; }
        lds_wave_sync();
        int e4[4] = {0, 0, 0, 0}; int rk[4] = {0, 0, 0, 0};
        if (lane < 16) {
            const float* my = lg + lane * 32; unsigned taken = 0u; float tv[4];
#pragma unroll
            for (int k = 0; k < 4; ++k) {
                float best = NEG_INF; int bi = 0;
                for (int e = 0; e < 32; ++e) { const float xv = my[e]; if (!((taken >> e) & 1u) && xv > best) { best = xv; bi = e; } }
                taken |= 1u << bi; e4[k] = bi; tv[k] = best;
            }
            const float e1 = __expf(tv[1] - tv[0]), e2 = __expf(tv[2] - tv[0]), e3 = __expf(tv[3] - tv[0]);
            const float inv = 1.0f / (1.0f + e1 + e2 + e3);
            const size_t row = (size_t)(tok0 + lane);
            *(float4*)(p.gw + row * 4) = make_float4(inv, e1 * inv, e2 * inv, e3 * inv);
        }
        __syncthreads();
        if (lane < 16) {
#pragma unroll
            for (int k = 0; k < 4; ++k) rk[k] = atomicAdd(&lcnt[e4[k]], 1);
        }
        __syncthreads();
        if (tid < 32) { const int c = lcnt[tid]; lbase[tid] = c ? (int)__hip_atomic_fetch_add(gcount + tid, (unsigned)c, __ATOMIC_RELAXED, __HIP_MEMORY_SCOPE_AGENT) : 0; }
        __syncthreads();
        if (lane < 16) {
            const int row = tok0 + lane; int pk[4];
#pragma unroll
            for (int k = 0; k < 4; ++k) { const int pos = lbase[e4[k]] + rk[k]; p.lists[(size_t)e4[k] * LIST_CAP + pos] = row * 4 + k; pk[k] = (pos << 5) | e4[k]; }
            *(int4*)(p.top_e + (size_t)row * 4) = make_int4(pk[0], pk[1], pk[2], pk[3]);
        }
        __syncthreads();
    }
}

__device__ __forceinline__ void phase_ln2(const Params& p, int l, float* xout, char* lds) {
    int* ptile = (int*)(lds + LDS_TAB); int* ecnt = ptile + 40;
    build_tiles(p, l, ptile, ecnt);
    int tid = threadIdx.x; asm volatile("" : "+v"(tid));
    const int wid = tid >> 6, lane = tid & 63;
    const float* g2 = p.ln2_g + l * DM; const float* b2 = p.ln2_b + l * DM;
    float4 gg[4], bb[4];
#pragma unroll
    for (int j = 0; j < 4; ++j) { gg[j] = *(const float4*)(g2 + j * 256 + lane * 4); bb[j] = *(const float4*)(b2 + j * 256 + lane * 4); }
    for (int pr = blockIdx.x * NWV + wid; pr < NTOK / 2; pr += gridDim.x * NWV) {
        float4 v[2][4]; float s[2], qv[2];
        unsigned yv[2][4][4]; float gk[2][4];
#pragma unroll
        for (int i = 0; i < 2; ++i) {
            const int row = pr * 2 + i;
            const float4 gwv = *(const float4*)(p.gw + (size_t)row * 4);
            gk[i][0] = gwv.x; gk[i][1] = gwv.y; gk[i][2] = gwv.z; gk[i][3] = gwv.w;
            const int4 te = *(const int4*)(p.top_e + (size_t)row * 4);
            const int tk[4] = {te.x, te.y, te.z, te.w};
#pragma unroll
            for (int j = 0; j < 4; ++j) { const u32x2 w = *(const u32x2*)((const bf16_t*)p.x1f + (size_t)row * DM + j * 256 + lane * 4);
                v[i][j] = make_float4(__uint_as_float(w.x << 16), __uint_as_float(w.x & 0xffff0000u), __uint_as_float(w.y << 16), __uint_as_float(w.y & 0xffff0000u)); }
#pragma unroll
            for (int k = 0; k < 4; ++k) {
                const unsigned char* yr = (const unsigned char*)p.ybuf + (size_t)(ptile[tk[k] & 31] * 256 + (tk[k] >> 5)) * DM + lane * 4;
#pragma unroll
                for (int j = 0; j < 4; ++j) yv[i][k][j] = *(const unsigned*)(yr + j * 256);
            }
        }
#pragma unroll
        for (int i = 0; i < 2; ++i) { s[i] = 0.f;
#pragma unroll
            for (int j = 0; j < 4; ++j) {
                float4 a; a.x = v[i][j].x * ALPHA; a.y = v[i][j].y * ALPHA; a.z = v[i][j].z * ALPHA; a.w = v[i][j].w * ALPHA;
#pragma unroll
                for (int k = 0; k < 4; ++k) {
                    const unsigned w = yv[i][k][j];
                    const f32x2_t lo = __builtin_amdgcn_cvt_pk_f32_fp8(w, false), hi = __builtin_amdgcn_cvt_pk_f32_fp8(w, true);
                    a.x += gk[i][k] * lo.x; a.y += gk[i][k] * lo.y; a.z += gk[i][k] * hi.x; a.w += gk[i][k] * hi.y;
                }
                v[i][j] = a; s[i] += (a.x + a.y) + (a.z + a.w);
            } }
#pragma unroll
        for (int o = 32; o > 0; o >>= 1) { s[0] += shfl_f(s[0], lane ^ o); s[1] += shfl_f(s[1], lane ^ o); }
#pragma unroll
        for (int i = 0; i < 2; ++i) { const float mean = s[i] * (1.0f / 1024.0f); qv[i] = 0.f;
#pragma unroll
            for (int j = 0; j < 4; ++j) { v[i][j].x -= mean; v[i][j].y -= mean; v[i][j].z -= mean; v[i][j].w -= mean; qv[i] += (v[i][j].x * v[i][j].x + v[i][j].y * v[i][j].y) + (v[i][j].z * v[i][j].z + v[i][j].w * v[i][j].w); } }
#pragma unroll
        for (int o = 32; o > 0; o >>= 1) { qv[0] += shfl_f(qv[0], lane ^ o); qv[1] += shfl_f(qv[1], lane ^ o); }
#pragma unroll
        for (int i = 0; i < 2; ++i) {
            const float rstd = rsqrtf(qv[i] * (1.0f / 1024.0f) + LN_EPS);
            const size_t row = (size_t)(pr * 2 + i);
#pragma unroll
            for (int j = 0; j < 4; ++j) {
                const int c = j * 256 + lane * 4;
                float4 y; y.x = v[i][j].x * rstd * gg[j].x + bb[j].x; y.y = v[i][j].y * rstd * gg[j].y + bb[j].y; y.z = v[i][j].z * rstd * gg[j].z + bb[j].z; y.w = v[i][j].w * rstd * gg[j].w + bb[j].w;
                *(float4*)(xout + row * DM + c) = y;
                if (l + 1 < NL) {
                    u32x2 w; w.x = pack2(y.x, y.y); w.y = pack2(y.z, y.w);
                    *(u32x2*)(p.xb + row * DM + c) = w;
                    *(unsigned*)(p.xq + row * DM + c) = pack4_fp8(y.x, y.y, y.z, y.w);
                }
            }
        }
    }
}

#define XB_TMO      128
#define XB_XCNT(j)  (256  + 64 * (j))
#define XB_XSUB(j)  (1280 + 64 * (j))
#define XB_XGEN(j)  (2304 + 64 * (j))
#define XB_TOP      3328
#define XB_TOPGEN   3392
#define XCD_BAR_WORDS 3456
#define XB_SPIN_CAP (1u << 22)
__device__ __forceinline__ unsigned xb_ld(unsigned* p)              { return __hip_atomic_load(p, __ATOMIC_RELAXED, __HIP_MEMORY_SCOPE_AGENT); }
__device__ __forceinline__ unsigned xb_add(unsigned* p, unsigned v) { return __hip_atomic_fetch_add(p, v, __ATOMIC_RELAXED, __HIP_MEMORY_SCOPE_AGENT); }
__device__ __forceinline__ unsigned xb_xcc_id() { return (unsigned)__builtin_amdgcn_s_getreg((3 << 11) | 20) & 0xFu; }
#define XB_SPIN(cond, bar) do { unsigned _sp = 0; while (cond) { __builtin_amdgcn_s_sleep(1); \
    if ((++_sp & 255u) == 0u) { if (xb_ld(&(bar)[XB_TMO])) break; if (_sp > XB_SPIN_CAP) { atomicAdd(&(bar)[XB_TMO], 1u); break; } } } } while (0)
struct XcdBarrier { unsigned* bar; unsigned x; volatile LAS unsigned* st; };
__device__ __forceinline__ XcdBarrier xcd_barrier_post(unsigned* bar, volatile LAS unsigned* st) {
    XcdBarrier b; b.bar = bar; b.x = xb_xcc_id(); b.st = st;
    if (threadIdx.x == 0) (void)xb_add(&bar[XB_XCNT(b.x)], 1u);
    return b;
}
__device__ __forceinline__ void xcd_barrier_complete(unsigned* bar, unsigned x, unsigned& nloc, unsigned& nx) {
    const unsigned G = gridDim.x * gridDim.y * gridDim.z;
    unsigned sum, cnt, mine, sp = 0u;
    for (;;) {
        sum = 0u; cnt = 0u; mine = 0u;
#pragma unroll
        for (unsigned j = 0; j < 16; ++j) { const unsigned c = xb_ld(&bar[XB_XCNT(j)]); sum += c; cnt += (c > 0u) ? 1u : 0u; mine = (j == x) ? c : mine; }
        if (sum == G) break;
        __builtin_amdgcn_s_sleep(1);
        if ((++sp & 255u) == 0u) { if (xb_ld(&bar[XB_TMO])) break; if (sp > XB_SPIN_CAP) { atomicAdd(&bar[XB_TMO], 1u); break; } }
    }
    nloc = mine > 0u ? mine : 1u; nx = cnt > 0u ? cnt : 1u;
}
__device__ __forceinline__ void xcd_barrier(const XcdBarrier& b) {
    asm volatile("s_waitcnt vmcnt(0)" ::: "memory");
    __syncthreads();
    if (threadIdx.x == 0) {
        unsigned* bar = b.bar;
        __builtin_amdgcn_s_waitcnt(0);
        unsigned nloc = b.st[0], nx = b.st[1];
        if (nloc == 0u) { xcd_barrier_complete(bar, b.x, nloc, nx); b.st[0] = nloc; b.st[1] = nx; }
        const unsigned old = xb_add(&bar[XB_XSUB(b.x)], 1u);
        const unsigned gen = old / nloc;
        if (old + 1u == (gen + 1u) * nloc) {
            __builtin_amdgcn_fence(__ATOMIC_RELEASE, "agent");
            asm volatile("s_waitcnt vmcnt(0)" ::: "memory");
            const unsigned og = xb_add(&bar[XB_TOP], 1u);
            const unsigned tg = og / nx;
            if (og + 1u == (tg + 1u) * nx) xb_add(&bar[XB_TOPGEN], 1u);
            else XB_SPIN(xb_ld(&bar[XB_TOPGEN]) == tg, bar);
            __builtin_amdgcn_fence(__ATOMIC_ACQUIRE, "agent");
            xb_add(&bar[XB_XGEN(b.x)], 1u);
            asm volatile("s_waitcnt vmcnt(0)" ::: "memory");
        } else {
            XB_SPIN(xb_ld(&bar[XB_XGEN(b.x)]) == gen, bar);
            __builtin_amdgcn_fence(__ATOMIC_ACQUIRE, "agent");
            asm volatile("s_waitcnt vmcnt(0)" ::: "memory");
        }
    }
    __syncthreads();
}

struct KArgs { const float* in[18]; float* out; char* ws; };
constexpr size_t al256(size_t v) { return (v + 255) / 256 * 256; }
struct WSL {
    static constexpr size_t ctrl = 0;
    static constexpr size_t WinT = al256(ctrl + 65536);
    static constexpr size_t WoT = al256(WinT + (size_t)NL * NPAD * 1024 * 2);
    static constexpr size_t W1T = al256(WoT + (size_t)NL * 1024 * 1024 * 2);
    static constexpr size_t W2T = al256(W1T + (size_t)NL * 2 * 64 * 2048 * 2);
    static constexpr size_t WguT = al256(W2T + (size_t)NL * 2 * 64 * 64 * 2);
    static constexpr size_t WdnT = al256(WguT + (size_t)NL * NE * 2048 * 1024 * 2);
    static constexpr size_t rwT = al256(WdnT + (size_t)NL * NE * 1024 * 1024 * 2);
    static constexpr size_t binp = al256(rwT + (size_t)NL * NE * 1024 * 4);
    static constexpr size_t bgup = al256(binp + (size_t)NL * NPAD * 4);
    static constexpr size_t b1c = al256(bgup + (size_t)NL * NE * 2048 * 4);
    static constexpr size_t xf = al256(b1c + 4 * 64 * 4);
    static constexpr size_t xb = al256(xf + (size_t)NTOK * DM * 4);
    static constexpr size_t hb = al256(xb + (size_t)NTOK * DM * 2);
    static constexpr size_t hs = al256(hb + (size_t)NTOK * NMAIN * 2);
    static constexpr size_t vT = al256(hs + (size_t)NTOK * HS_W * 4);
    static constexpr size_t kF = al256(vT + (size_t)NB * NVH * 64 * SEQ * 2);
    static constexpr size_t cF = al256(kF + (size_t)NB * NVH * 64 * SEQ * 2);
    static constexpr size_t kc = al256(cF + (size_t)NB * 4 * SEQ * 4);
    static constexpr size_t vc = al256(kc + (size_t)NB * 2 * 128 * 64 * 2);
    static constexpr size_t vcT = al256(vc + (size_t)NB * 2 * 128 * 64 * 2);
    static constexpr size_t ob = al256(vcT + (size_t)NB * 2 * 128 * 64 * 2);
    static constexpr size_t tbuf = al256(ob + (size_t)NTOK * DM * 2);
    static constexpr size_t x1f = al256(tbuf + (size_t)NTOK * DM * 4);
    static constexpr size_t x1b = al256(x1f + (size_t)NTOK * DM * 4);
    static constexpr size_t top_e = al256(x1b + (size_t)NTOK * DM * 2);
    static constexpr size_t gw = al256(top_e + (size_t)NTOK * 4 * 4);
    static constexpr size_t lists = al256(gw + (size_t)NTOK * 4 * 4);
    static constexpr size_t act = al256(lists + (size_t)NE * LIST_CAP * 4);
    static constexpr size_t ybuf = al256(act + (size_t)MAXSLOT * DFF * 2);
    static constexpr size_t xq = al256(ybuf + (size_t)MAXSLOT * DM * 2);
    static constexpr size_t WinQ = al256(xq + (size_t)NTOK * DM);
    static constexpr size_t total = al256(WinQ + (size_t)NL * NMAIN * 1024);
};
__device__ __forceinline__ Params make_params(const KArgs& k) {
    Params p;
    p.x = k.in[0]; p.w_in = k.in[1]; p.b_in = k.in[2]; p.sinks = k.in[3]; p.cmp_pe = k.in[4]; p.cmp_w1 = k.in[5]; p.cmp_w2 = k.in[6]; p.w_out = k.in[7];
    p.ln1_g = k.in[8]; p.ln1_b = k.in[9]; p.router_w = k.in[10]; p.router_b = k.in[11]; p.w_gu = k.in[12]; p.b_gu = k.in[13]; p.w_dn = k.in[14]; p.b_dn = k.in[15];
    p.ln2_g = k.in[16]; p.ln2_b = k.in[17]; p.out = k.out;
    char* w = k.ws;
    p.ctrl = (unsigned*)(w + WSL::ctrl); p.WinT = (bf16_t*)(w + WSL::WinT); p.WoT = (bf16_t*)(w + WSL::WoT); p.W1T = (bf16_t*)(w + WSL::W1T); p.W2T = (bf16_t*)(w + WSL::W2T);
    p.WguT = (bf16_t*)(w + WSL::WguT); p.WdnT = (bf16_t*)(w + WSL::WdnT); p.rwT = (float*)(w + WSL::rwT); p.binp = (float*)(w + WSL::binp); p.bgup = (float*)(w + WSL::bgup);
    p.b1c = (float*)(w + WSL::b1c); p.xf = (float*)(w + WSL::xf); p.xb = (bf16_t*)(w + WSL::xb); p.hb = (bf16_t*)(w + WSL::hb); p.hs = (float*)(w + WSL::hs); p.vT = (bf16_t*)(w + WSL::vT); p.kF = (bf16_t*)(w + WSL::kF);
    p.cF = (float*)(w + WSL::cF); p.kc = (bf16_t*)(w + WSL::kc); p.vc = (bf16_t*)(w + WSL::vc); p.vcT = (bf16_t*)(w + WSL::vcT); p.ob = (bf16_t*)(w + WSL::ob); p.tbuf = (float*)(w + WSL::tbuf);
    p.x1f = (float*)(w + WSL::x1f); p.x1b = (bf16_t*)(w + WSL::x1b); p.top_e = (int*)(w + WSL::top_e); p.gw = (float*)(w + WSL::gw); p.lists = (int*)(w + WSL::lists);
    p.act = (bf16_t*)(w + WSL::act); p.ybuf = (bf16_t*)(w + WSL::ybuf); p.xq = (unsigned char*)(w + WSL::xq); p.WinQ = (unsigned char*)(w + WSL::WinQ);
    return p;
}
__device__ __forceinline__ void grid_bar(const Params& p, char* lds) {
    XcdBarrier xb; xb.bar = p.ctrl + 1024; xb.x = xb_xcc_id(); xb.st = (volatile LAS unsigned*)(lds + LDS_BYTES - 16); xcd_barrier(xb);
}
__device__ __forceinline__ Params fresh_params(const KArgs& ka) {
    KArgs k2 = ka; size_t z = 0; asm volatile("" : "+s"(z));
    k2.ws = ka.ws + z;
    return make_params(k2);
}
#ifndef REP
#define REP 0
#endif
template <int L>
__device__ __forceinline__ void layer_fwd(const KArgs& ka, char* lds) {
    { const Params p = fresh_params(ka); phase_inproj(p, L, lds);        grid_bar(p, lds); }
    { const Params p = fresh_params(ka); phase_prep(p, L, lds);          grid_bar(p, lds); }
    { const Params p = fresh_params(ka); phase_attn<L == 0>(p, L, lds);  grid_bar(p, lds); }
    { const Params p = fresh_params(ka); phase_outproj(p, L, L == 0 ? p.x : p.xf, lds);  grid_bar(p, lds); }
    { const Params p = fresh_params(ka); phase_ln1_router(p, L, lds);    grid_bar(p, lds); }
    { const Params p = fresh_params(ka); phase_gateup(p, L, lds);        grid_bar(p, lds); }
    { const Params p = fresh_params(ka); phase_down(p, L, lds);          grid_bar(p, lds); }
    { const Params p = fresh_params(ka); phase_ln2(p, L, L == NL - 1 ? p.out : p.xf, lds); }
}
__global__ void __launch_bounds__(NTHR, 2) fwd_kernel(KArgs ka) {
    extern __shared__ __attribute__((aligned(16))) char lds[];
    const Params p = make_params(ka);
    cg::grid_group grid = cg::this_grid();
    volatile LAS unsigned* xst = (volatile LAS unsigned*)(lds + LDS_BYTES - 16);
    if (threadIdx.x == 0) { xst[0] = 0u; xst[1] = 0u; }
    __syncthreads();
    (void)xcd_barrier_post(p.ctrl + 1024, xst);
    volatile LAS int* vcu = (volatile LAS int*)(lds + LDS_BYTES - 32);
    const unsigned myx = xb_xcc_id() & 7u;
    if (threadIdx.x == 0) vcu[1] = (int)__hip_atomic_fetch_add(p.ctrl + 32 + myx, 1u, __ATOMIC_RELAXED, __HIP_MEMORY_SCOPE_AGENT);
    phase0(p, lds);
    grid.sync();
    if (threadIdx.x == 0) {
        int base = 0, tot = 0;
        for (unsigned x = 0; x < 8; ++x) { const int n = (int)__hip_atomic_load(p.ctrl + 32 + x, __ATOMIC_RELAXED, __HIP_MEMORY_SCOPE_AGENT); if (x < myx) base += n; tot += n; }
        vcu[0] = (tot == (int)gridDim.x) ? base + vcu[1] : (int)blockIdx.x;
    }
    __syncthreads();
    layer_fwd<0>(ka, lds);
    grid_bar(p, lds);
    layer_fwd<1>(ka, lds);
}

extern "C" void kernel_launch(void* const* d_in, const int* in_sizes, int n_in, void* d_out, int out_size, void* d_ws, size_t ws_size, hipStream_t stream) {
    KArgs ka{};
    for (int i = 0; i < 18; ++i) ka.in[i] = (const float*)d_in[i];
    ka.out = (float*)d_out; ka.ws = (char*)d_ws;
    if (WSL::total > ws_size) { fprintf(stderr, "workspace too small: need %zu have %zu\n", (size_t)WSL::total, ws_size); return; }
    static int grid_blocks = 0;
    if (!grid_blocks) {
        int dev = 0, cus = 0, per_cu = 0;
        (void)hipGetDevice(&dev);
        (void)hipDeviceGetAttribute(&cus, hipDeviceAttributeMultiprocessorCount, dev);
        (void)hipFuncSetAttribute((const void*)fwd_kernel, hipFuncAttributeMaxDynamicSharedMemorySize, LDS_BYTES);
        (void)hipOccupancyMaxActiveBlocksPerMultiprocessor(&per_cu, fwd_kernel, NTHR, LDS_BYTES);
        if (per_cu < 1) { fprintf(stderr, "occupancy query says 0 blocks per CU\n"); per_cu = 1; }
        grid_blocks = cus;
    }
    (void)hipMemsetAsync(d_ws, 0, 65536, stream);
    void* args[] = {&ka};
    hipError_t e = hipLaunchCooperativeKernel((const void*)fwd_kernel, dim3(grid_blocks), dim3(NTHR), args, LDS_BYTES, stream);
    if (e != hipSuccess) fprintf(stderr, "cooperative launch failed: %s (grid %d)\n", hipGetErrorString(e), grid_blocks);
}
```

```cpp
#include <hip/hip_runtime.h>
#include <hip/hip_cooperative_groups.h>
#include <cstdio>
#include <cstdint>
namespace cg = cooperative_groups;

typedef unsigned short bf16_t;
typedef short bf16x8 __attribute__((ext_vector_type(8)));
typedef float f32x4 __attribute__((ext_vector_type(4)));
typedef unsigned u32x4 __attribute__((ext_vector_type(4)));
typedef unsigned u32x2 __attribute__((ext_vector_type(2)));
typedef int v8i_t __attribute__((ext_vector_type(8)));
typedef float f32x2_t __attribute__((ext_vector_type(2)));
typedef int v4i_t __attribute__((ext_vector_type(4)));
#define LAS __attribute__((address_space(3)))
constexpr float NEG_INF = -__builtin_huge_valf();

constexpr int DM = 1024, NB = 16, SEQ = 2048, NTOK = NB * SEQ, NL = 2;
constexpr int NCOL = 2582, NMAIN = 2560, NPAD = 2688, NE = 32, DFF = 1024;
constexpr int C_FQ = 0, C_FK = 256, C_FV = 512, C_SQ = 768, C_SK = 1152, C_SV = 1280, C_NQ = 1408,
              C_NKC = 1792, C_NVC = 1920, C_NKS = 2048, C_NVS = 2176, C_NKW = 2304, C_NVW = 2432;
constexpr int HS_W = 32;
constexpr int NVH = 10;
constexpr int LIST_CAP = NTOK;
constexpr int MAXSLOT = NTOK * 4 + NE * 256;
constexpr float ALPHA = 1.41421356237f, LN_EPS = 1e-5f, QSCALE = 0.125f;
constexpr float GATE_PRE = -2.455466929f;
constexpr int NWV = 8, NTHR = NWV * 64;
constexpr int LDS_STAGE = 131072, LDS_TAB = LDS_STAGE, LDS_AOFF = LDS_STAGE + 2048, LDS_BIAS = LDS_AOFF + 20480, LDS_BYTES = LDS_BIAS + 3072 + 256;

struct Params {
    const float *x, *w_in, *b_in, *sinks, *cmp_pe, *cmp_w1, *cmp_w2, *w_out, *ln1_g, *ln1_b, *router_w, *router_b,
                *w_gu, *b_gu, *w_dn, *b_dn, *ln2_g, *ln2_b;
    float* out;
    unsigned* ctrl;
    bf16_t *WinT, *WoT, *W1T, *W2T, *WguT, *WdnT;
    float *rwT, *binp, *bgup, *b1c;
    unsigned char* xq; unsigned char* WinQ;
    float* xf; bf16_t* xb; bf16_t* hb; float* hs; bf16_t* vT; bf16_t* kF; float* cF;
    bf16_t *kc, *vc, *vcT; bf16_t* ob; float* tbuf; float* x1f; bf16_t* x1b;
    int* top_e; float* gw; int* lists; bf16_t* act; bf16_t* ybuf;
};

__device__ __forceinline__ float bf2f(bf16_t h) { return __uint_as_float(((unsigned)h) << 16); }
typedef __bf16 bf16x2_t __attribute__((ext_vector_type(2)));
__device__ __forceinline__ bf16_t f2bf(float f) { return __builtin_bit_cast(bf16_t, (__bf16)f); }
__device__ __forceinline__ unsigned pack2(float lo, float hi) { bf16x2_t v = {(__bf16)lo, (__bf16)hi}; return __builtin_bit_cast(unsigned, v); }
__device__ __forceinline__ unsigned pack4_fp8(float a, float b, float c, float d) {
    unsigned w = 0u;
    w = __builtin_amdgcn_cvt_pk_fp8_f32(a, b, w, false);
    w = __builtin_amdgcn_cvt_pk_fp8_f32(c, d, w, true);
    return w;
}
__device__ __forceinline__ float shfl_f(float v, int src_lane) { return __int_as_float(__builtin_amdgcn_ds_bpermute(src_lane << 2, __float_as_int(v))); }
__device__ __forceinline__ unsigned shfl_u(unsigned v, int src_lane) { return (unsigned)__builtin_amdgcn_ds_bpermute(src_lane << 2, (int)v); }
__device__ __forceinline__ float wave_sum(float v) {
#pragma unroll
    for (int o = 32; o > 0; o >>= 1) v += __shfl_xor(v, o);
    return v;
}
__device__ __forceinline__ float wave_max(float v) {
#pragma unroll
    for (int o = 32; o > 0; o >>= 1) v = fmaxf(v, __shfl_xor(v, o));
    return v;
}
__device__ __forceinline__ void lds_wave_sync() { asm volatile("s_waitcnt lgkmcnt(0)" ::: "memory"); __builtin_amdgcn_wave_barrier(); }
__device__ __forceinline__ float slope_swa(int hq) { return exp2f(-8.0f * (float)(2 * hq + 1) / 12.0f); }
__device__ __forceinline__ float slope_nsa(int hq) { return exp2f(-8.0f * (float)(2 * hq + 2) / 12.0f); }

__device__ __forceinline__ int fwd128(int L) { return (L & ~31) | (((L >> 2) & 1) << 4) | (((L >> 3) & 3) << 2) | (L & 3); }
__device__ __forceinline__ int inv128(int p) { return (p & ~31) | (((p >> 2) & 3) << 3) | (((p >> 4) & 1) << 2) | (p & 3); }
__device__ __forceinline__ int fwd256(int L) { return (L & ~255) | (((L >> 3) & 1) << 7) | (((L >> 6) & 3) << 5) | (((L >> 2) & 1) << 4) | (((L >> 4) & 3) << 2) | (L & 3); }
__device__ __forceinline__ int perm_row(int perm, int n) {
    if (perm == 1) { int r; if (n < 768) r = n; else if (n < 772) r = 2560 + (n - 768); else if (n < 2564) r = n - 4; else r = n; return r < 2560 ? fwd128(r) : r; }
    if (perm == 2) { const int f = n >> 1, s = n & 1; return (f >> 7) * 256 + s * 128 + fwd128(f & 127); }
    if (perm == 3) return fwd256(n);
    return n;
}
struct ConvJob { const float* src; bf16_t* dst; int K, N, kt, nt, perm; float q8; };
__device__ __forceinline__ bool conv_job(const Params& p, int t, ConvJob& jb) {
    constexpr int T_WIN = NL * 8 * 21, T_WO = NL * 8 * 8;
    if (t < T_WIN) { const int m = t / 168, r = t % 168; jb = ConvJob{p.w_in + (size_t)m * 1024 * NCOL, p.WinT + (size_t)m * NPAD * 1024, 1024, NCOL, r / 21, r % 21, 1, 0.f}; return true; }
    t -= T_WIN;
    if (t < T_WO) { const int m = t / 64, r = t % 64; jb = ConvJob{p.w_out + (size_t)m * 1024 * 1024, (bf16_t*)((char*)p.WoT + (size_t)m * 1024 * 1024), 1024, 1024, r / 8, r % 8, 3, 64.0f}; return true; }
    t -= T_WO;
    if (t < T_WIN) { const int m = t / 168, r = t % 168; jb = ConvJob{p.w_in + (size_t)m * 1024 * NCOL, (bf16_t*)(p.WinQ + (size_t)m * NMAIN * 1024), 1024, NCOL, r / 21, r % 21, 1, 64.0f}; return true; }
    return false;
}
constexpr int CONV_TILES = NL * NE * 192;
__device__ __forceinline__ void conv_tile_wave(const Params& p, int t, int lane, unsigned char* l8) {
    asm volatile("" : "+v"(lane));
    const int m = t / 192, r = t % 192;
    const float* src; unsigned char* dst; int N, kt, nt, perm;
    if (r < 128) { src = p.w_gu + (size_t)m * 1024 * 2048; dst = (unsigned char*)p.WguT + (size_t)m * 2048 * 1024; N = 2048; kt = r >> 4; nt = r & 15; perm = 2; }
    else { const int q = r - 128; src = p.w_dn + (size_t)m * 1024 * 1024; dst = (unsigned char*)p.WdnT + (size_t)m * 1024 * 1024; N = 1024; kt = q >> 3; nt = q & 7; perm = 3; }
    const float* s = src + (size_t)(kt * 128 + (lane >> 5)) * N + nt * 128 + (lane & 31) * 4;
    unsigned char* lw = l8 + (lane >> 5) * 132 + (lane & 31) * 4;
    const float sg = (perm == 2) ? 64.0f * GATE_PRE : 64.0f;
    float4 va[16], vb[16];
#pragma unroll
    for (int i = 0; i < 16; ++i) va[i] = *(const float4*)(s + (size_t)(2 * i) * N);
#pragma unroll
    for (int i = 0; i < 16; ++i) vb[i] = *(const float4*)(s + (size_t)(32 + 2 * i) * N);
#pragma unroll
    for (int i = 0; i < 16; ++i) *(unsigned*)(lw + (2 * i) * 132) = pack4_fp8(va[i].x * sg, va[i].y * 64.0f, va[i].z * sg, va[i].w * 64.0f);
#pragma unroll
    for (int i = 0; i < 16; ++i) va[i] = *(const float4*)(s + (size_t)(64 + 2 * i) * N);
#pragma unroll
    for (int i = 0; i < 16; ++i) *(unsigned*)(lw + (32 + 2 * i) * 132) = pack4_fp8(vb[i].x * sg, vb[i].y * 64.0f, vb[i].z * sg, vb[i].w * 64.0f);
#pragma unroll
    for (int i = 0; i < 16; ++i) vb[i] = *(const float4*)(s + (size_t)(96 + 2 * i) * N);
#pragma unroll
    for (int i = 0; i < 16; ++i) *(unsigned*)(lw + (64 + 2 * i) * 132) = pack4_fp8(va[i].x * sg, va[i].y * 64.0f, va[i].z * sg, va[i].w * 64.0f);
#pragma unroll
    for (int i = 0; i < 16; ++i) *(unsigned*)(lw + (96 + 2 * i) * 132) = pack4_fp8(vb[i].x * sg, vb[i].y * 64.0f, vb[i].z * sg, vb[i].w * 64.0f);
    lds_wave_sync();
#pragma unroll 4
    for (int i = 0; i < 16; ++i) {
        const int idx = lane + 64 * i, kc = idx & 7, nn = idx >> 3;
        const unsigned char* l = l8 + (kc * 16) * 132 + nn;
        u32x4 w;
        w.x = (unsigned)l[0] | ((unsigned)l[132] << 8) | ((unsigned)l[264] << 16) | ((unsigned)l[396] << 24);
        w.y = (unsigned)l[528] | ((unsigned)l[660] << 8) | ((unsigned)l[792] << 16) | ((unsigned)l[924] << 24);
        w.z = (unsigned)l[1056] | ((unsigned)l[1188] << 8) | ((unsigned)l[1320] << 16) | ((unsigned)l[1452] << 24);
        w.w = (unsigned)l[1584] | ((unsigned)l[1716] << 8) | ((unsigned)l[1848] << 16) | ((unsigned)l[1980] << 24);
        *(u32x4*)(dst + (size_t)perm_row(perm, nt * 128 + nn) * 1024 + kt * 128 + kc * 16) = w;
    }
    lds_wave_sync();
}
__device__ __forceinline__ void conv_load(const ConvJob& jb, int tid, float2 (&v)[16]) {
    const int n = jb.nt * 128 + (tid & 31) * 4;
    const float* s = jb.src + (size_t)(jb.kt * 128 + (tid >> 5)) * jb.N + n;
#pragma unroll
    for (int i = 0; i < 8; ++i) {
        const float* r = s + (size_t)(16 * i) * jb.N;
        v[2 * i] = (n + 1 < jb.N) ? *(const float2*)r : make_float2(0.f, 0.f);
        v[2 * i + 1] = (n + 3 < jb.N) ? *(const float2*)(r + 2) : make_float2(0.f, 0.f);
    }
}
__device__ __forceinline__ void phase0(const Params& p, char* ldsc) {
    int tid = threadIdx.x; asm volatile("" : "+v"(tid));
    const int G = gridDim.x, bid = blockIdx.x;
    const size_t gtid = (size_t)bid * NTHR + tid, gthreads = (size_t)G * NTHR;
    {
        constexpr int TOT = 2 * NL * 8 * 21 + NL * 8 * 8;
        bf16_t* lt = (bf16_t*)ldsc;
        ConvJob jb, jn; float2 v[16], vn[16];
        int t = bid; bool have = t < TOT && conv_job(p, t, jb);
        if (have) conv_load(jb, tid, v);
        while (have) {
            const int tn = t + G; const bool hn = tn < TOT && conv_job(p, tn, jn);
            if (hn) conv_load(jn, tid, vn);
            if (jb.q8 != 0.f) {
                unsigned char* l8 = (unsigned char*)lt;
#pragma unroll
                for (int i = 0; i < 8; ++i)
                {   int kl = (tid >> 5) + 16 * i;
                    if (jb.perm == 3) kl = (kl & 64) | (((kl >> 2) & 3) << 4) | (((kl >> 4) & 3) << 2) | (kl & 3);
                    *(unsigned*)(l8 + kl * 132 + (tid & 31) * 4) = pack4_fp8(v[2 * i].x * jb.q8, v[2 * i].y * jb.q8, v[2 * i + 1].x * jb.q8, v[2 * i + 1].y * jb.q8); }
                __syncthreads();
#pragma unroll
                for (int i = 0; i < 2; ++i) {
                    const int idx = tid + NTHR * i, kc = idx & 7, nn = idx >> 3, n = jb.nt * 128 + nn;
                    const unsigned char* l = l8 + (kc * 16) * 132 + nn;
                    u32x4 w;
                    w.x = (unsigned)l[0] | ((unsigned)l[132] << 8) | ((unsigned)l[264] << 16) | ((unsigned)l[396] << 24);
                    w.y = (unsigned)l[528] | ((unsigned)l[660] << 8) | ((unsigned)l[792] << 16) | ((unsigned)l[924] << 24);
                    w.z = (unsigned)l[1056] | ((unsigned)l[1188] << 8) | ((unsigned)l[1320] << 16) | ((unsigned)l[1452] << 24);
                    w.w = (unsigned)l[1584] | ((unsigned)l[1716] << 8) | ((unsigned)l[1848] << 16) | ((unsigned)l[1980] << 24);
                    const int pr = perm_row(jb.perm, n);
                    if (n < jb.N && !(jb.perm == 1 && pr >= NMAIN)) *(u32x4*)((char*)jb.dst + (size_t)pr * jb.K + jb.kt * 128 + kc * 16) = w;
                }
            } else {
#pragma unroll
                for (int i = 0; i < 8; ++i) {
                    u32x2 w; w.x = pack2(v[2 * i].x, v[2 * i].y); w.y = pack2(v[2 * i + 1].x, v[2 * i + 1].y);
                    *(u32x2*)(lt + ((tid >> 5) + 16 * i) * 136 + (tid & 31) * 4) = w;
                }
                __syncthreads();
#pragma unroll
                for (int i = 0; i < 4; ++i) {
                    const int idx = tid + NTHR * i, kc = idx & 15, nn = idx >> 4, n = jb.nt * 128 + nn;
                    if (n < jb.N) {
                        const bf16_t* l = lt + (kc * 8) * 136 + nn;
                        u32x4 w;
                        w.x = (unsigned)l[0] | ((unsigned)l[136] << 16); w.y = (unsigned)l[272] | ((unsigned)l[408] << 16);
                        w.z = (unsigned)l[544] | ((unsigned)l[680] << 16); w.w = (unsigned)l[816] | ((unsigned)l[952] << 16);
                        *(u32x4*)(jb.dst + (size_t)perm_row(jb.perm, n) * jb.K + jb.kt * 128 + kc * 8) = w;
                    }
                }
            }
            __syncthreads();
            t = tn; have = hn; jb = jn;
#pragma unroll
            for (int i = 0; i < 16; ++i) v[i] = vn[i];
        }
    }
    for (size_t i = gtid; i < (size_t)NL * 2 * 2048 * 64; i += gthreads) {
        const int k = (int)(i % 2048), n = (int)((i / 2048) % 64), m = (int)(i / (2048 * 64));
        p.W1T[i] = f2bf(p.cmp_w1[((size_t)m * 2048 + k) * 64 + n]);
    }
    for (size_t i = gtid; i < (size_t)NL * 2 * 64 * 64; i += gthreads) {
        const int k = (int)(i % 64), n = (int)((i / 64) % 64), m = (int)(i / 4096);
        p.W2T[i] = f2bf(p.cmp_w2[((size_t)m * 64 + k) * 64 + n]);
    }
    for (size_t i = gtid; i < (size_t)NL * NPAD; i += gthreads) {
        const int l = (int)(i / NPAD), ri = (int)(i % NPAD), r = ri < 2560 ? inv128(ri) : ri;
        float v = 0.f;
        if (r < 2560) { const int n = r < 768 ? r : r + 4; v = p.b_in[l * NCOL + n]; }
        else if (r < 2564) v = p.b_in[l * NCOL + 768 + (r - 2560)];
        else if (r < 2582) v = p.b_in[l * NCOL + r];
        p.binp[i] = v;
    }
    for (size_t i = gtid; i < (size_t)NL * NE * 2048; i += gthreads) {
        const int r = (int)(i % 2048); const size_t le = i / 2048;
        const int s = (r >> 7) & 1, f = (r >> 8) * 128 + inv128(r & 127);
        p.bgup[i] = p.b_gu[le * 2048 + 2 * f + s] * (s == 0 ? GATE_PRE : 1.0f);
    }
    for (size_t i = gtid; i < (size_t)NL * NE * 1024; i += gthreads) {
        const int k = (int)(i % 1024), e = (int)((i / 1024) % NE), l = (int)(i / (1024 * NE));
        p.rwT[i] = p.router_w[((size_t)l * 1024 + k) * NE + e];
    }
    for (size_t i = gtid; i < (size_t)NL * (NPAD - NCOL) * 1024; i += gthreads) {
        const int l = (int)(i / ((NPAD - NCOL) * 1024)); const size_t r = i % ((size_t)(NPAD - NCOL) * 1024);
        p.WinT[(size_t)l * NPAD * 1024 + (size_t)NCOL * 1024 + r] = 0;
    }
    for (size_t i = gtid; i < (size_t)NTOK * DM / 4; i += gthreads) {
        const float4 v4 = ((const float4*)p.x)[i];
        u32x2 w; w.x = pack2(v4.x, v4.y); w.y = pack2(v4.z, v4.w);
        ((u32x2*)p.xb)[i] = w;
        ((unsigned*)p.xq)[i] = pack4_fp8(v4.x, v4.y, v4.z, v4.w);
    }
    if (bid < 4) {
        float* lf = (float*)ldsc;
        const int j = tid & 63, part = tid >> 6;
        const float* pe = p.cmp_pe + (size_t)bid * 2048; const float* w1 = p.cmp_w1 + (size_t)bid * 2048 * 64;
        float s = 0.f;
        for (int kk = part * 256; kk < part * 256 + 256; ++kk) s += pe[kk] * w1[(size_t)kk * 64 + j];
        lf[tid] = s; __syncthreads();
        if (tid < 64) { float a = 0.f; for (int q = 0; q < 8; ++q) a += lf[tid + 64 * q]; p.b1c[bid * 64 + tid] = a; }
        __syncthreads();
    }
}

__device__ __forceinline__ int vcu_id() { return __builtin_amdgcn_readfirstlane(*(const volatile LAS int*)(LDS_BYTES - 32)); }
namespace pg8 {
constexpr int BM = 256, BK = 64, HALF = 128, HTB = HALF * BK * 2, NXCD = 8, WGM = 8;
__device__ __forceinline__ int lds_byte(int r, int c) { const int st = (r >> 4) * 2 + (c >> 5), rr = r & 15, cc = c & 31, ob = rr * 64 + cc * 2; return st * 1024 + (ob ^ (((ob >> 9) & 1) << 5)); }
__device__ __forceinline__ void stage_rc(int b, int& R, int& C) { const int st = b / 1024, sb = b % 1024, swz = sb ^ (((sb >> 9) & 1) << 5); R = (st >> 1) * 16 + swz / 64; C = (st & 1) * 32 + (swz % 64) / 2; }
__device__ __forceinline__ bool tile_order(int i, int G, int c, int nM, int nN, int& pm, int& pn) {
    const int nwg = nM * nN; const long L = (long)i * G + c; if (L >= nwg) return false;
    const int wgid = (int)L;
    const int nig = WGM * nN, gid = wgid / nig, fm = gid * WGM, gsz = (nM - fm) < WGM ? (nM - fm) : WGM;
    pm = fm + ((wgid % nig) % gsz); pn = (wgid % nig) / gsz; return true;
}
template <bool FP8, int SCA, class Sched, class Epi>
__device__ __forceinline__ void gemm_phase(LAS unsigned char* lds, const char* Abase, int K, const Sched& S, const Epi& E) {
    int tid = threadIdx.x; asm volatile("" : "+v"(tid));
    const int wid = __builtin_amdgcn_readfirstlane(tid >> 6), lane = tid & 63, wr = wid >> 2, wc = wid & 3, fr = lane & 15, fq = lane >> 4;
    const int nt = K / BK;
    int R0, C0, R1, C1; stage_rc(tid * 16, R0, C0); stage_rc(tid * 16 + 8192, R1, C1);
    LAS unsigned* aofs = (LAS unsigned*)(lds + LDS_AOFF) + tid;
    unsigned rg[10];
    rg[8] = (unsigned)(R0 * K + C0) * 2u; rg[9] = (unsigned)(R1 * K + C1) * 2u;
    if constexpr (FP8) { aofs[8 * NTHR] = rg[8]; aofs[9 * NTHR] = rg[9]; }
    const size_t kstep = (size_t)(BK * 2), hstep = (size_t)HALF * K * 2;
    const unsigned ldsw = (unsigned)wid * 1024u;
    const int aoff = lds_byte(wr * 64 + fr, fq * 8), boff = lds_byte(wc * 32 + fr, fq * 8);
#define PG8_SA(b, h) (((b) * 2 + (h)) * HTB)
#define PG8_SB(b, h) ((4 + (b) * 2 + (h)) * HTB)
#define PG8_OFS(sel, j) (FP8 ? aofs[((sel) * 4 + (j)) * NTHR] : ((sel) ? rg[4 + (j)] : rg[(j)]))
#define PG8_STAGE_B(bufoff, gbase) do { _Pragma("unroll") for (int _i = 0; _i < 2; ++_i) { const unsigned ob_ = FP8 ? aofs[(8 + _i) * NTHR] : rg[8 + _i]; \
        __builtin_amdgcn_global_load_lds((const unsigned*)((const char*)(gbase) + ob_), (LAS unsigned*)(lds + (bufoff) + ldsw + _i * 8192), 16, 0, 0); } } while (0)
#define PG8_STAGE_A(bufoff, kbyte, sel, h) do { const unsigned o0_ = PG8_OFS(sel, (h) * 2), o1_ = PG8_OFS(sel, (h) * 2 + 1); \
        __builtin_amdgcn_global_load_lds((const unsigned*)(Abase + (kbyte) + o0_), (LAS unsigned*)(lds + (bufoff) + ldsw), 16, 0, 0); \
        __builtin_amdgcn_global_load_lds((const unsigned*)(Abase + (kbyte) + o1_), (LAS unsigned*)(lds + (bufoff) + ldsw + 8192), 16, 0, 0); } while (0)
#define PG8_LDA(dst, b, h) do { _Pragma("unroll") for (int m = 0; m < 4; ++m) { \
        if constexpr (FP8) { const v4i_t lo_ = *(const LAS v4i_t*)(lds + PG8_SA(b, h) + aoff + m * 2048), hi_ = *(const LAS v4i_t*)(lds + PG8_SA(b, h) + aoff + m * 2048 + 1024); dst##8[m] = __builtin_shufflevector(lo_, hi_, 0, 1, 2, 3, 4, 5, 6, 7); } \
        else { _Pragma("unroll") for (int k = 0; k < 2; ++k) dst[m][k] = *(const LAS bf16x8*)(lds + PG8_SA(b, h) + aoff + m * 2048 + k * 1024); } } } while (0)
#define PG8_LDB(dst, b, h) do { _Pragma("unroll") for (int n = 0; n < 2; ++n) { \
        if constexpr (FP8) { const v4i_t lo_ = *(const LAS v4i_t*)(lds + PG8_SB(b, h) + boff + n * 2048), hi_ = *(const LAS v4i_t*)(lds + PG8_SB(b, h) + boff + n * 2048 + 1024); dst##8[n] = __builtin_shufflevector(lo_, hi_, 0, 1, 2, 3, 4, 5, 6, 7); } \
        else { _Pragma("unroll") for (int k = 0; k < 2; ++k) dst[n][k] = *(const LAS bf16x8*)(lds + PG8_SB(b, h) + boff + n * 2048 + k * 1024); } } } while (0)
#define PG8_MMA(ai, bj, At, Bt) do { __builtin_amdgcn_s_setprio(1); _Pragma("unroll") for (int m = 0; m < 4; ++m) _Pragma("unroll") for (int n = 0; n < 2; ++n) { \
        if constexpr (FP8) { acc[ai][bj][m][n] = __builtin_amdgcn_mfma_scale_f32_16x16x128_f8f6f4(Bt##8[n], At##8[m], acc[ai][bj][m][n], 0, 0, 0, SCA, 0, SCA); } \
        else { _Pragma("unroll") for (int k = 0; k < 2; ++k) acc[ai][bj][m][n] = __builtin_amdgcn_mfma_f32_16x16x32_bf16(Bt[n][k], At[m][k], acc[ai][bj][m][n], 0, 0, 0); } } \
        __builtin_amdgcn_s_setprio(0); } while (0)
#define PG8_WAIT_V(n) asm volatile("s_waitcnt vmcnt(" #n ")" ::: "memory")
#define PG8_WAIT_L(n) asm volatile("s_waitcnt lgkmcnt(" #n ")" ::: "memory")
#define PG8_BAR __builtin_amdgcn_s_barrier()
#define PG8_SCHED __builtin_amdgcn_sched_barrier(0)
    typename Sched::Unit cur, nxt; int ui = 0;
    if (!S.next(0, cur)) return;
    f32x4 acc[2][2][4][2];
    bf16x8 At[4][2], B0[2][2], B1[2][2];
    v8i_t At8[4], B08[2], B18[2];
    { unsigned a4[2][2]; S.a_off(cur, R0, C0, R1, C1, a4); rg[0] = a4[0][0]; rg[1] = a4[0][1]; rg[2] = a4[1][0]; rg[3] = a4[1][1];
      if constexpr (FP8) { aofs[0] = a4[0][0]; aofs[NTHR] = a4[0][1]; aofs[2 * NTHR] = a4[1][0]; aofs[3 * NTHR] = a4[1][1]; } }
    const char* cB = S.b_ptr(cur);
#define PG8_BIAS_DMA(unit, slot) do { const float* bp_ = E.bias_ptr(unit); int tb_ = threadIdx.x; asm volatile("" : "+v"(tb_)); if (wr == 0 && bp_ != nullptr) \
        __builtin_amdgcn_global_load_lds((const unsigned*)(bp_ + (tb_ & 255)), (LAS unsigned*)(lds + LDS_BIAS + (slot) * 1024 + wid * 256), 4, 0, 0); } while (0)
    PG8_BIAS_DMA(cur, 0);
    PG8_STAGE_B(PG8_SB(0, 0), cB); PG8_STAGE_B(PG8_SB(0, 1), cB + hstep); PG8_STAGE_A(PG8_SA(0, 0), 0, 0, 0); PG8_STAGE_A(PG8_SA(0, 1), 0, 0, 1);
    if (wr == 1) PG8_BAR;
    PG8_WAIT_V(2); PG8_BAR;
    PG8_STAGE_B(PG8_SB(1, 0), cB + kstep); PG8_STAGE_A(PG8_SA(1, 0), kstep, 0, 0); PG8_STAGE_B(PG8_SB(1, 1), cB + hstep + kstep);
    PG8_WAIT_V(6); PG8_BAR;
    { int t3 = threadIdx.x; asm volatile("" : "+v"(t3)); E.init(acc, wc, (t3 & 63) >> 4, (const LAS float*)(lds + LDS_BIAS)); }
    for (;;) {
        const bool has_next = S.next(ui + 1, nxt);
        const char* nB = cB;
        if (has_next) PG8_BIAS_DMA(nxt, (ui + 1) % 3);
        if (has_next) { int t2 = threadIdx.x; asm volatile("" : "+v"(t2)); int r0, c0, r1, c1; stage_rc(t2 * 16, r0, c0); stage_rc(t2 * 16 + 8192, r1, c1); nB = S.b_ptr(nxt);
            if constexpr (Sched::LIST_DMA) { static_assert(!Sched::LIST_DMA || FP8, "list DMA lands in the LDS offset slots"); S.a_dma(nxt, r0, r1, (LAS unsigned*)(lds + LDS_AOFF + 4 * NTHR * 4 + wid * 256)); }
            else { unsigned a4[2][2]; S.a_off(nxt, r0, c0, r1, c1, a4);
                rg[4] = a4[0][0]; rg[5] = a4[0][1]; rg[6] = a4[1][0]; rg[7] = a4[1][1];
                if constexpr (FP8) { aofs[4 * NTHR] = a4[0][0]; aofs[5 * NTHR] = a4[0][1]; aofs[6 * NTHR] = a4[1][0]; aofs[7 * NTHR] = a4[1][1]; } } }
        else { rg[4] = rg[0]; rg[5] = rg[1]; rg[6] = rg[2]; rg[7] = rg[3];
            if constexpr (FP8) { aofs[4 * NTHR] = aofs[0]; aofs[5 * NTHR] = aofs[NTHR]; aofs[6 * NTHR] = aofs[2 * NTHR]; aofs[7 * NTHR] = aofs[3 * NTHR]; } }
#pragma unroll 1
        for (int t = 0; t < nt; t += 2) {
            const bool last = (t == nt - 2);
            const size_t ka1 = (size_t)(t + 1) * kstep, ka2 = last ? 0 : (size_t)(t + 2) * kstep, ka3 = ka2 + kstep;
            const char* b2 = last ? nB : cB + (size_t)(t + 2) * kstep; const char* b3 = b2 + kstep;
            const int sel = last ? 1 : 0;
            if constexpr (Sched::LIST_DMA) if (last && has_next) {
                int t4 = threadIdx.x; asm volatile("" : "+v"(t4)); int r0, c0, r1, c1; stage_rc(t4 * 16, r0, c0); stage_rc(t4 * 16 + 8192, r1, c1);
#pragma unroll
                for (int j = 0; j < 4; ++j) aofs[(4 + j) * NTHR] = S.a_fin(aofs[(4 + j) * NTHR], (j & 1) ? c1 : c0);
            }
            PG8_LDB(B0, 0, 0); PG8_LDB(B1, 0, 1); PG8_SCHED; PG8_LDA(At, 0, 0); PG8_STAGE_A(PG8_SA(1, 1), ka1, 0, 1);
            PG8_WAIT_V(8); PG8_WAIT_L(0); PG8_BAR; PG8_MMA(0, 0, At, B0); PG8_MMA(0, 1, At, B1); PG8_BAR; PG8_SCHED;
            PG8_LDA(At, 0, 1); PG8_STAGE_B(PG8_SB(0, 0), b2); PG8_STAGE_B(PG8_SB(0, 1), b2 + hstep); PG8_STAGE_A(PG8_SA(0, 0), ka2, sel, 0);
            PG8_WAIT_V(8); PG8_WAIT_L(0); PG8_BAR; PG8_MMA(1, 0, At, B0); PG8_MMA(1, 1, At, B1); PG8_BAR; PG8_SCHED;
            PG8_LDB(B0, 1, 0); PG8_LDB(B1, 1, 1); PG8_SCHED; PG8_LDA(At, 1, 0); PG8_STAGE_A(PG8_SA(0, 1), ka2, sel, 1);
            PG8_WAIT_V(8); PG8_WAIT_L(0); PG8_BAR; PG8_MMA(0, 0, At, B0); PG8_MMA(0, 1, At, B1); PG8_BAR; PG8_SCHED;
            PG8_LDA(At, 1, 1); PG8_STAGE_B(PG8_SB(1, 0), b3); PG8_STAGE_B(PG8_SB(1, 1), b3 + hstep); PG8_STAGE_A(PG8_SA(1, 0), ka3, sel, 0);
            PG8_WAIT_V(8); PG8_WAIT_L(0); PG8_BAR; PG8_MMA(1, 0, At, B0); PG8_MMA(1, 1, At, B1); PG8_BAR; PG8_SCHED;
        }
        if (wr == 0) PG8_BAR;
        { int t2 = threadIdx.x; asm volatile("" : "+v"(t2)); E(acc, cur, wr, wc, t2 & 15, (t2 & 63) >> 4, (const LAS float*)(lds + LDS_BIAS + (ui % 3) * 1024)); }
        if (!has_next) break;
        { int t3 = threadIdx.x; asm volatile("" : "+v"(t3)); E.init(acc, wc, (t3 & 63) >> 4, (const LAS float*)(lds + LDS_BIAS + ((ui + 1) % 3) * 1024)); }
        cur = nxt; cB = nB; ++ui;
        rg[0] = rg[4]; rg[1] = rg[5]; rg[2] = rg[6]; rg[3] = rg[7];
        if constexpr (FP8) { aofs[0] = aofs[4 * NTHR]; aofs[NTHR] = aofs[5 * NTHR]; aofs[2 * NTHR] = aofs[6 * NTHR]; aofs[3 * NTHR] = aofs[7 * NTHR]; }
        if (wr == 1) PG8_BAR;
    }
    PG8_WAIT_V(0);
    PG8_BAR;
#undef PG8_BIAS_DMA
#undef PG8_SA
#undef PG8_SB
#undef PG8_STAGE_A
#undef PG8_OFS
#undef PG8_STAGE_B
#undef PG8_LDA
#undef PG8_LDB
#undef PG8_MMA
#undef PG8_WAIT_V
#undef PG8_WAIT_L
#undef PG8_BAR
#undef PG8_SCHED
}
}

struct DenseUnit { int pm, pn; };
struct DenseSched {
    typedef DenseUnit Unit;
    const char* Bt; int K, nM, nN, vc;
    __device__ __forceinline__ bool next(int i, Unit& u) const { return pg8::tile_order(i, gridDim.x, vc, nM, nN, u.pm, u.pn); }
    __device__ __forceinline__ void a_off(const Unit& u, int R0, int C0, int R1, int C1, unsigned (&off)[2][2]) const {
#pragma unroll
        for (int h = 0; h < 2; ++h) { off[h][0] = (unsigned)((u.pm * 256 + h * 128 + R0) * K + C0) * 2u; off[h][1] = (unsigned)((u.pm * 256 + h * 128 + R1) * K + C1) * 2u; }
    }
    __device__ __forceinline__ const char* b_ptr(const Unit& u) const { return Bt + (size_t)u.pn * 256 * K * 2; }
    static constexpr bool LIST_DMA = false;
    __device__ __forceinline__ void a_dma(const Unit&, int, int, LAS unsigned*) const {}
    __device__ __forceinline__ unsigned a_fin(unsigned raw, int) const { return raw; }
};
struct MoeUnit { int rbt, e, pn; };
template <bool GATHER>
struct MoeSched {
    typedef MoeUnit Unit;
    static constexpr int KP = 512;
    const char* Bt; const int* lists; const int* ptile; const int* ecnt; int nN, nrows, vc;
    __device__ __forceinline__ bool next(int i, Unit& u) const {
        int pm, pn; if (!pg8::tile_order(i, gridDim.x, vc, ptile[NE], nN, pm, pn)) return false;
        u.rbt = pm; u.e = ((const unsigned char*)ptile)[512 + pm]; u.pn = pn; return true;
    }
    __device__ __forceinline__ void a_off(const Unit& u, int R0, int C0, int R1, int C1, unsigned (&off)[2][2]) const {
        if (GATHER) {
            const int* lst = lists + (size_t)u.e * LIST_CAP; const int rb = u.rbt - ptile[u.e], cnt = ecnt[u.e];
#pragma unroll
            for (int h = 0; h < 2; ++h) {
                const int l0 = rb * 256 + h * 128 + R0, l1 = rb * 256 + h * 128 + R1;
                const int t0 = l0 < cnt ? (lst[l0] >> 2) : 0, t1 = l1 < cnt ? (lst[l1] >> 2) : 0;
                off[h][0] = (unsigned)(t0 * KP + C0) * 2u; off[h][1] = (unsigned)(t1 * KP + C1) * 2u;
            }
        } else {
#pragma unroll
            for (int h = 0; h < 2; ++h) { off[h][0] = (unsigned)((u.rbt * 256 + h * 128 + R0) * KP + C0) * 2u; off[h][1] = (unsigned)((u.rbt * 256 + h * 128 + R1) * KP + C1) * 2u; }
        }
    }
    __device__ __forceinline__ const char* b_ptr(const Unit& u) const { return Bt + ((size_t)u.e * nrows + (size_t)u.pn * 256) * KP * 2; }
    static constexpr bool LIST_DMA = GATHER;
    __device__ __forceinline__ void a_dma(const Unit& u, int R0, int R1, LAS unsigned* slot) const {
        const int* lst = lists + (size_t)u.e * LIST_CAP; const int rb = u.rbt - ptile[u.e], cm = ecnt[u.e] - 1;
#pragma unroll
        for (int h = 0; h < 2; ++h) {
            const int l0 = min(rb * 256 + h * 128 + R0, cm), l1 = min(rb * 256 + h * 128 + R1, cm);
            __builtin_amdgcn_global_load_lds((const unsigned*)(lst + l0), slot + (h * 2) * NTHR, 4, 0, 0);
            __builtin_amdgcn_global_load_lds((const unsigned*)(lst + l1), slot + (h * 2 + 1) * NTHR, 4, 0, 0);
        }
    }
    __device__ __forceinline__ unsigned a_fin(unsigned raw, int C) const { return (unsigned)((int)(raw >> 2) * KP + C) * 2u; }
};

struct EpiInProj {
    const Params* p; int l;
    __device__ __forceinline__ const float* bias_ptr(const DenseUnit& u) const { return p->binp + l * NPAD + u.pn * 256; }
    __device__ __forceinline__ void init(f32x4 (&acc)[2][2][4][2], int wc, int fq, const LAS float* bias) const {
#pragma unroll
        for (int bj = 0; bj < 2; ++bj)
#pragma unroll
            for (int n = 0; n < 2; ++n) {
                const f32x4 bv = *(const LAS f32x4*)(bias + bj * 128 + wc * 32 + n * 16 + 4 * fq);
#pragma unroll
                for (int ai = 0; ai < 2; ++ai)
#pragma unroll
                    for (int m = 0; m < 4; ++m) acc[ai][bj][m][n] = bv;
            }
    }
    __device__ __forceinline__ void operator()(const f32x4 (&acc)[2][2][4][2], const DenseUnit& u, int wr, int wc, int fr, int fq, const LAS float*) const {
#pragma unroll
        for (int bj = 0; bj < 2; ++bj) {
            int kind = 0, hb0 = 0;
            if (u.pn == 1) { kind = 1; hb0 = bj * 2; } else if (u.pn == 4 && bj == 1) { kind = 1; hb0 = 4; } else if (u.pn == 8 && bj == 0) { kind = 1; hb0 = 6; } else if (u.pn == 9 && bj == 0) { kind = 1; hb0 = 8; }
            else if (u.pn == 2) { kind = 2; hb0 = bj * 2; } else if (u.pn == 5 && bj == 0) { kind = 2; hb0 = 4; } else if (u.pn == 8 && bj == 1) { kind = 2; hb0 = 6; } else if (u.pn == 9 && bj == 1) { kind = 2; hb0 = 8; }
            const int c0 = wc * 32 + fq * 8;
            const int hh = hb0 + (c0 >> 6), d0 = c0 & 63;
#pragma unroll
            for (int ai = 0; ai < 2; ++ai)
#pragma unroll
                for (int m = 0; m < 4; ++m) {
                    const int row = u.pm * 256 + ai * 128 + wr * 64 + m * 16 + fr;
                    const f32x4 v0 = acc[ai][bj][m][0], v1 = acc[ai][bj][m][1];
                    u32x4 w; w.x = pack2(v0[0], v0[1]); w.y = pack2(v0[2], v0[3]); w.z = pack2(v1[0], v1[1]); w.w = pack2(v1[2], v1[3]);
                    if (kind == 0) *(u32x4*)(p->hb + (size_t)row * NMAIN + u.pn * 256 + bj * 128 + c0) = w;
                    else {
                        const int b = row >> 11, s = row & 2047, kk = s & 31;
                        bf16_t* blk = (kind == 1 ? p->kF : p->vT) + (((size_t)b * NVH + hh) * 64 + (s >> 5)) * 2048;
                        if (kind == 1) {
                            const int frk = (kk >> 3) * 4 + (kk & 3), t = (kk >> 2) & 1;
                            *(u32x4*)(blk + ((t * 2 + (d0 >> 5)) * 64 + ((d0 & 31) >> 3) * 16 + frk) * 8) = w;
                        } else {
                            bf16_t* vt = blk + (((d0 >> 4) * 64) + (kk >> 3) * 16 + (d0 & 15)) * 8 + (kk & 7);
                            vt[0] = (bf16_t)(w.x & 0xffff); vt[8] = (bf16_t)(w.x >> 16); vt[16] = (bf16_t)(w.y & 0xffff); vt[24] = (bf16_t)(w.y >> 16);
                            vt[32] = (bf16_t)(w.z & 0xffff); vt[40] = (bf16_t)(w.z >> 16); vt[48] = (bf16_t)(w.w & 0xffff); vt[56] = (bf16_t)(w.w >> 16);
                        }
                    }
                }
        }
    }
};
struct EpiOutProj {
    const bf16_t* xin; float* t;
    __device__ __forceinline__ const float* bias_ptr(const DenseUnit&) const { return nullptr; }
    __device__ __forceinline__ void init(f32x4 (&acc)[2][2][4][2], int, int, const LAS float*) const {
#pragma unroll
        for (int ai = 0; ai < 2; ++ai)
#pragma unroll
            for (int bj = 0; bj < 2; ++bj)
#pragma unroll
                for (int m = 0; m < 4; ++m)
#pragma unroll
                    for (int n = 0; n < 2; ++n) acc[ai][bj][m][n] = (f32x4){0.f, 0.f, 0.f, 0.f};
    }
    __device__ __forceinline__ void operator()(const f32x4 (&acc)[2][2][4][2], const DenseUnit& u, int wr, int wc, int fr, int fq, const LAS float*) const {
#pragma unroll
        for (int ai = 0; ai < 2; ++ai)
#pragma unroll
            for (int m = 0; m < 4; ++m) {
                const size_t off = (size_t)(u.pm * 256 + ai * 128 + wr * 64 + m * 16 + fr) * DM + u.pn * 256 + wc * 64 + fq * 16;
                const u32x4 x0 = *(const u32x4*)(xin + off), x1 = *(const u32x4*)(xin + off + 8);
                const unsigned xs[8] = {x0.x, x0.y, x0.z, x0.w, x1.x, x1.y, x1.z, x1.w};
                unsigned w[8];
#pragma unroll
                for (int q = 0; q < 4; ++q) {
                    const f32x4 a = acc[ai][q >> 1][m][q & 1];
                    const float t0 = __uint_as_float(xs[2 * q] << 16) * ALPHA + a[0], t1 = __uint_as_float(xs[2 * q] & 0xffff0000u) * ALPHA + a[1];
                    const float t2 = __uint_as_float(xs[2 * q + 1] << 16) * ALPHA + a[2], t3 = __uint_as_float(xs[2 * q + 1] & 0xffff0000u) * ALPHA + a[3];
                    w[2 * q] = pack2(t0, t1); w[2 * q + 1] = pack2(t2, t3);
                }
                u32x4 w0, w1; w0.x = w[0]; w0.y = w[1]; w0.z = w[2]; w0.w = w[3]; w1.x = w[4]; w1.y = w[5]; w1.z = w[6]; w1.w = w[7];
                *(u32x4*)((bf16_t*)t + off) = w0; *(u32x4*)((bf16_t*)t + off + 8) = w1;
            }
    }
};
struct EpiGateUp {
    bf16_t* act; const float* bgup;
    __device__ __forceinline__ const float* bias_ptr(const MoeUnit& u) const { return bgup + (size_t)u.e * 2048 + u.pn * 256; }
    __device__ __forceinline__ void init(f32x4 (&acc)[2][2][4][2], int wc, int fq, const LAS float* bias) const {
#pragma unroll
        for (int bj = 0; bj < 2; ++bj)
#pragma unroll
            for (int n = 0; n < 2; ++n) {
                const f32x4 bv = *(const LAS f32x4*)(bias + bj * 128 + wc * 32 + n * 16 + 4 * fq);
#pragma unroll
                for (int ai = 0; ai < 2; ++ai)
#pragma unroll
                    for (int m = 0; m < 4; ++m) acc[ai][bj][m][n] = bv;
            }
    }
    __device__ __forceinline__ void operator()(const f32x4 (&acc)[2][2][4][2], const MoeUnit& u, int wr, int wc, int fr, int fq, const LAS float*) const {
        constexpr float GMIN = 7.0f * GATE_PRE, CI = 1.0f / GATE_PRE;
#pragma unroll
        for (int ai = 0; ai < 2; ++ai)
#pragma unroll
            for (int m = 0; m < 4; ++m) {
                u32x2 w;
#pragma unroll
                for (int n = 0; n < 2; ++n) {
                    const f32x4 g4 = acc[ai][0][m][n], u4 = acc[ai][1][m][n];
                    float o[4];
#pragma unroll
                    for (int j = 0; j < 4; ++j) {
                        const float gp = fmaxf(g4[j], GMIN), uu = fminf(fmaxf(u4[j], -7.0f), 7.0f);
                        const float glu = gp * __builtin_amdgcn_rcpf(1.0f + __builtin_amdgcn_exp2f(gp));
                        o[j] = __builtin_fmaf(uu, CI, CI) * glu;
                    }
                    const unsigned pk = pack4_fp8(o[0], o[1], o[2], o[3]);
                    if (n == 0) w.x = pk; else w.y = pk;
                }
                *(u32x2*)((char*)act + (size_t)(u.rbt * 256 + ai * 128 + wr * 64 + m * 16 + fr) * DFF + u.pn * 128 + wc * 32 + fq * 8) = w;
            }
    }
};
struct EpiDown {
    bf16_t* ybuf; const float* bdn;
    __device__ __forceinline__ const float* bias_ptr(const MoeUnit& u) const { return bdn + (size_t)u.e * 1024 + u.pn * 256; }
    __device__ __forceinline__ void init(f32x4 (&acc)[2][2][4][2], int wc, int fq, const LAS float* bias) const {
#pragma unroll
        for (int bj = 0; bj < 2; ++bj)
#pragma unroll
            for (int n = 0; n < 2; ++n) {
                const f32x4 bv = *(const LAS f32x4*)(bias + wc * 64 + fq * 16 + bj * 8 + n * 4);
#pragma unroll
                for (int ai = 0; ai < 2; ++ai)
#pragma unroll
                    for (int m = 0; m < 4; ++m) acc[ai][bj][m][n] = bv;
            }
    }
    __device__ __forceinline__ void operator()(const f32x4 (&acc)[2][2][4][2], const MoeUnit& u, int wr, int wc, int fr, int fq, const LAS float*) const {
#pragma unroll
        for (int ai = 0; ai < 2; ++ai)
#pragma unroll
            for (int m = 0; m < 4; ++m) {
                u32x4 w;
                { const f32x4 v = acc[ai][0][m][0]; w.x = pack4_fp8(v[0], v[1], v[2], v[3]); }
                { const f32x4 v = acc[ai][0][m][1]; w.y = pack4_fp8(v[0], v[1], v[2], v[3]); }
                { const f32x4 v = acc[ai][1][m][0]; w.z = pack4_fp8(v[0], v[1], v[2], v[3]); }
                { const f32x4 v = acc[ai][1][m][1]; w.w = pack4_fp8(v[0], v[1], v[2], v[3]); }
                *(u32x4*)((unsigned char*)ybuf + (size_t)(u.rbt * 256 + ai * 128 + wr * 64 + m * 16 + fr) * DM + u.pn * 256 + wc * 64 + fq * 16) = w;
            }
    }
};

__device__ __forceinline__ void phase_inproj(const Params& p, int l, char* lds) {
    DenseSched S{(const char*)p.WinQ + (size_t)l * NMAIN * 1024, 512, NTOK / 256, NMAIN / 256, vcu_id()};
    EpiInProj E{&p, l};
    pg8::gemm_phase<true, 0x7c7c7c7c>((LAS unsigned char*)lds, (const char*)p.xq, 512, S, E);
    int tid = threadIdx.x; asm volatile("" : "+v"(tid));
    const int wid = tid >> 6, lane = tid & 63, fr = lane & 15, fq = lane >> 4;
    const bf16_t* W = p.WinT + ((size_t)l * NPAD + NMAIN) * 1024;
    const float* bias = p.binp + l * NPAD + NMAIN;
    for (int u = blockIdx.x * NWV + wid; u < NTOK / 16; u += gridDim.x * NWV) {
        const bf16_t* ar = p.xb + (size_t)(u * 16 + fr) * DM + fq * 8;
        const bf16_t* w0 = W + (size_t)fr * 1024 + fq * 8; const bf16_t* w1 = W + (size_t)(16 + fr) * 1024 + fq * 8;
        f32x4 a0 = (f32x4){0.f, 0.f, 0.f, 0.f}, a1 = a0;
#pragma unroll 4
        for (int ks = 0; ks < 32; ++ks) {
            const bf16x8 a = *(const bf16x8*)(ar + ks * 32);
            a0 = __builtin_amdgcn_mfma_f32_16x16x32_bf16(a, *(const bf16x8*)(w0 + ks * 32), a0, 0, 0, 0);
            a1 = __builtin_amdgcn_mfma_f32_16x16x32_bf16(a, *(const bf16x8*)(w1 + ks * 32), a1, 0, 0, 0);
        }
#pragma unroll
        for (int r = 0; r < 4; ++r) {
            float* dst = p.hs + (size_t)(u * 16 + fq * 4 + r) * HS_W;
            dst[fr] = a0[r] + bias[fr];
            if (fr < 6) dst[16 + fr] = a1[r] + bias[16 + fr];
        }
    }
}
__device__ __forceinline__ void phase_outproj(const Params& p, int l, const bf16_t* xin, char* lds) {
    DenseSched S{(const char*)p.WoT + (size_t)l * 1024 * 1024, 512, NTOK / 256, 4, vcu_id()};
    EpiOutProj E{xin, p.tbuf};
    pg8::gemm_phase<true, 0x7c7c7c7c>((LAS unsigned char*)lds, (const char*)p.ob, 512, S, E);
}
__device__ __forceinline__ void build_tiles(const Params& p, int l, int* ptile, int* ecnt) {
    int tid = threadIdx.x; asm volatile("" : "+v"(tid));
    if (tid < NE) ecnt[tid] = (int)__hip_atomic_load(p.ctrl + 64 + l * NE + tid, __ATOMIC_RELAXED, __HIP_MEMORY_SCOPE_AGENT);
    __syncthreads();
    if (tid == 0) { int s = 0; for (int e = 0; e < NE; ++e) { ptile[e] = s; s += (ecnt[e] + 255) >> 8; } ptile[NE] = s; }
    __syncthreads();
    unsigned char* texp = (unsigned char*)ptile + 512;
    for (int t = tid; t < ptile[NE]; t += NTHR) { int e = 0; while (ptile[e + 1] <= t) ++e; texp[t] = (unsigned char)e; }
    __syncthreads();
}
__device__ __forceinline__ void phase_gateup(const Params& p, int l, char* lds) {
    int* ptile = (int*)(lds + LDS_TAB); int* ecnt = ptile + 40;
    build_tiles(p, l, ptile, ecnt);
    MoeSched<true> S{(const char*)p.WguT + (size_t)l * NE * 2048 * 1024, p.lists, ptile, ecnt, 8, 2048, vcu_id()};
    EpiGateUp E{p.act, p.bgup + (size_t)l * NE * 2048};
    pg8::gemm_phase<true, 0x7c7c7c7c>((LAS unsigned char*)lds, (const char*)p.x1b, 512, S, E);
}
__device__ __forceinline__ void phase_down(const Params& p, int l, char* lds) {
    int* ptile = (int*)(lds + LDS_TAB); int* ecnt = ptile + 40;
    build_tiles(p, l, ptile, ecnt);
    MoeSched<false> S{(const char*)p.WdnT + (size_t)l * NE * 1024 * 1024, p.lists, ptile, ecnt, 4, 1024, vcu_id()};
    EpiDown E{p.ybuf, p.b_dn + (size_t)l * NE * 1024};
    pg8::gemm_phase<true, 0x7c7c7c7c>((LAS unsigned char*)lds, (const char*)p.act, 512, S, E);
}

__device__ __forceinline__ float gelu_tanh(float x) {
    const float u = 0.7978845608028654f * (x + 0.044715f * x * x * x);
    const float e = __expf(-2.0f * fabsf(u)); const float th = (1.0f - e) / (1.0f + e);
    return 0.5f * x * (1.0f + (u < 0.f ? -th : th));
}
__device__ __forceinline__ void phase_prep(const Params& p, int l, char* lds) {
    int tid = threadIdx.x; asm volatile("" : "+v"(tid));
    const int wid = tid >> 6, lane = tid & 63, fr = lane & 15, fq = lane >> 4;
    const int gw = blockIdx.x * NWV + wid, nw = gridDim.x * NWV;
    for (int u = (int)gridDim.x - 1 - (int)blockIdx.x; u < NB * 4; u += gridDim.x) {
        const int b = u >> 2, h = u & 3;
        const float* srcp = p.hs + ((size_t)b * SEQ + tid * 4) * HS_W + h;
        float ls[4]; float tot = 0.f;
#pragma unroll
        for (int i = 0; i < 4; ++i) { const float f = srcp[(size_t)i * HS_W]; ls[i] = fminf(f, 0.f) - log1pf(__expf(-fabsf(f))); tot += ls[i]; }
        float inc = tot;
#pragma unroll
        for (int o = 1; o < 64; o <<= 1) { const float v = shfl_f(inc, lane - o); if (lane >= o) inc += v; }
        float* wtot = (float*)(lds + 65536);
        if (lane == 63) wtot[wid] = inc;
        __syncthreads();
        float base = inc - tot;
        for (int w = 0; w < wid; ++w) base += wtot[w];
        float4 o4; o4.x = base + ls[0]; o4.y = o4.x + ls[1]; o4.z = o4.y + ls[2]; o4.w = o4.z + ls[3];
        *(float4*)(p.cF + (size_t)u * SEQ + tid * 4) = o4;
        __syncthreads();
    }
    float* part = (float*)lds;
    bf16_t* h1 = (bf16_t*)(lds + 32768);
    for (int u = blockIdx.x; u < NB * 2 * 2 * 8; u += gridDim.x) {
        const int ct = u & 7, which = (u >> 3) & 1, kvh = (u >> 4) & 1, b = u >> 5;
        const int colo = (which ? C_NVC : C_NKC) + kvh * 64;
        const int c_lane = ct * 16 + fr;
        const int tokbase = min(c_lane, 126) * 16;
        const bf16_t* arow = p.hb + ((size_t)b * SEQ + tokbase) * NMAIN + colo + fq * 8;
        const bf16_t* w1 = p.W1T + ((size_t)(l * 2 + which) * 64 + fr) * 2048 + fq * 8;
        f32x4 acc[4];
#pragma unroll
        for (int n = 0; n < 4; ++n) acc[n] = (f32x4){0.f, 0.f, 0.f, 0.f};
#pragma unroll
        for (int kk = 0; kk < 8; ++kk) {
            const int ks = wid * 8 + kk;
            const bf16x8 a = *(const bf16x8*)(arow + (size_t)(ks >> 1) * NMAIN + (ks & 1) * 32);
#pragma unroll
            for (int n = 0; n < 4; ++n) {
                const bf16x8 bb = *(const bf16x8*)(w1 + (size_t)n * 16 * 2048 + ks * 32);
                acc[n] = __builtin_amdgcn_mfma_f32_16x16x32_bf16(a, bb, acc[n], 0, 0, 0);
            }
        }
#pragma unroll
        for (int n = 0; n < 4; ++n)
#pragma unroll
            for (int r = 0; r < 4; ++r) part[wid * 1024 + (fq * 4 + r) * 64 + n * 16 + fr] = acc[n][r];
        __syncthreads();
        const float* b1 = p.b1c + (l * 2 + which) * 64;
#pragma unroll
        for (int i = 0; i < 2; ++i) {
            const int e = tid + NTHR * i; float sum = 0.f;
#pragma unroll
            for (int w = 0; w < 8; ++w) sum += part[w * 1024 + e];
            h1[e] = f2bf(gelu_tanh(sum + b1[e & 63]));
        }
        __syncthreads();
        if (wid == 0) {
            const bf16_t* w2 = p.W2T + ((size_t)(l * 2 + which) * 64 + fr) * 64 + fq * 8;
            f32x4 o2[4];
#pragma unroll
            for (int n = 0; n < 4; ++n) o2[n] = (f32x4){0.f, 0.f, 0.f, 0.f};
#pragma unroll
            for (int ks = 0; ks < 2; ++ks) {
                const bf16x8 a = *(const bf16x8*)(h1 + fr * 64 + ks * 32 + fq * 8);
#pragma unroll
                for (int n = 0; n < 4; ++n) {
                    const bf16x8 bb = *(const bf16x8*)(w2 + (size_t)n * 16 * 64 + ks * 32);
                    o2[n] = __builtin_amdgcn_mfma_f32_16x16x32_bf16(a, bb, o2[n], 0, 0, 0);
                }
            }
            const size_t base = ((size_t)b * 2 + kvh) * 128 * 64;
#pragma unroll
            for (int n = 0; n < 4; ++n)
#pragma unroll
                for (int r = 0; r < 4; ++r) {
                    const int c = ct * 16 + fq * 4 + r, j2 = n * 16 + fr;
                    const bf16_t v = c < 127 ? f2bf(o2[n][r]) : (bf16_t)0;
                    if (which == 0) p.kc[base + (size_t)c * 64 + j2] = v;
                    else { p.vc[base + (size_t)c * 64 + j2] = v; p.vcT[base + (size_t)j2 * 128 + c] = v; }
                }
        }
        __syncthreads();
    }
}

constexpr float L2E = 1.4426950408889634f, MASKV = -__builtin_huge_valf(), MINIT = -1e30f, SCL2 = QSCALE * L2E;
struct KVFrag { bf16x8 k[2][2]; bf16x8 v[4]; };
template <bool FM>
__device__ __forceinline__ void k_load(KVFrag& f, const bf16_t* __restrict__ Kb, size_t ldk, int kc0, int fr, int fq) {
    if (FM) {
        const bf16_t* kp = Kb + (size_t)(kc0 >> 5) * 2048 + (fq * 16 + fr) * 8;
        f.k[0][0] = *(const bf16x8*)(kp); f.k[0][1] = *(const bf16x8*)(kp + 512); f.k[1][0] = *(const bf16x8*)(kp + 1024); f.k[1][1] = *(const bf16x8*)(kp + 1536);
    } else {
        const bf16_t* kp = Kb + (size_t)(kc0 + (fr >> 2) * 8 + (fr & 3)) * ldk + fq * 8;
        f.k[0][0] = *(const bf16x8*)(kp); f.k[0][1] = *(const bf16x8*)(kp + 32);
        f.k[1][0] = *(const bf16x8*)(kp + 4 * ldk); f.k[1][1] = *(const bf16x8*)(kp + 4 * ldk + 32);
    }
}
template <bool FM>
__device__ __forceinline__ void v_load(bf16x8 (&v)[4], const bf16_t* __restrict__ VTb, size_t ldv, int kc0, int fr, int fq) {
    if (FM) {
        const bf16_t* vp = VTb + (size_t)(kc0 >> 5) * 2048 + (fq * 16 + fr) * 8;
#pragma unroll
        for (int dt = 0; dt < 4; ++dt) v[dt] = *(const bf16x8*)(vp + dt * 512);
    } else {
        const bf16_t* vp = VTb + (size_t)fr * ldv + kc0 + fq * 8;
#pragma unroll
        for (int dt = 0; dt < 4; ++dt) v[dt] = *(const bf16x8*)(vp + (size_t)dt * 16 * ldv);
    }
}
__device__ __forceinline__ float rowmax4(float x) {
    auto r = __builtin_amdgcn_permlane32_swap(__float_as_uint(x), __float_as_uint(x), false, false);
    x = fmaxf(__uint_as_float(r[0]), __uint_as_float(r[1]));
    auto q = __builtin_amdgcn_permlane16_swap(__float_as_uint(x), __float_as_uint(x), false, false);
    return fmaxf(__uint_as_float(q[0]), __uint_as_float(q[1]));
}
__device__ __forceinline__ float rowsum4(float x) {
    auto r = __builtin_amdgcn_permlane32_swap(__float_as_uint(x), __float_as_uint(x), false, false);
    x = __uint_as_float(r[0]) + __uint_as_float(r[1]);
    auto q = __builtin_amdgcn_permlane16_swap(__float_as_uint(x), __float_as_uint(x), false, false);
    return __uint_as_float(q[0]) + __uint_as_float(q[1]);
}
template <int NQT, bool MASK, class MB>
__device__ __forceinline__ void attn_compute(const KVFrag& f, const bf16x8 (&qf)[NQT][2], f32x4 (&o)[NQT][4], float (&m)[NQT], float (&l)[NQT], const MB& mb) {
    f32x4 s0[NQT], s1[NQT];
#pragma unroll
    for (int qt = 0; qt < NQT; ++qt) {
        s0[qt] = __builtin_amdgcn_mfma_f32_16x16x32_bf16(f.k[0][0], qf[qt][0], (f32x4){0.f, 0.f, 0.f, 0.f}, 0, 0, 0);
        s1[qt] = __builtin_amdgcn_mfma_f32_16x16x32_bf16(f.k[1][0], qf[qt][0], (f32x4){0.f, 0.f, 0.f, 0.f}, 0, 0, 0);
    }
#pragma unroll
    for (int qt = 0; qt < NQT; ++qt) {
        s0[qt] = __builtin_amdgcn_mfma_f32_16x16x32_bf16(f.k[0][1], qf[qt][1], s0[qt], 0, 0, 0);
        s1[qt] = __builtin_amdgcn_mfma_f32_16x16x32_bf16(f.k[1][1], qf[qt][1], s1[qt], 0, 0, 0);
    }
    float mx[NQT];
#pragma unroll
    for (int qt = 0; qt < NQT; ++qt) {
#pragma unroll
        for (int j = 0; j < 4; ++j) { s0[qt][j] = mb(qt, j, s0[qt][j]); s1[qt][j] = mb(qt, j + 4, s1[qt][j]); }
        mx[qt] = fmaxf(fmaxf(fmaxf(s0[qt][0], s0[qt][1]), fmaxf(s0[qt][2], s0[qt][3])), fmaxf(fmaxf(s1[qt][0], s1[qt][1]), fmaxf(s1[qt][2], s1[qt][3])));
    }
#pragma unroll
    for (int qt = 0; qt < NQT; ++qt) mx[qt] = rowmax4(mx[qt]);
    bool moved = false;
#pragma unroll
    for (int qt = 0; qt < NQT; ++qt) { mx[qt] = fmaxf(m[qt], mx[qt]); moved |= (mx[qt] != m[qt]); }
    if (__ballot(moved) != 0ull) {
#pragma unroll
        for (int qt = 0; qt < NQT; ++qt) {
            const float alpha = __builtin_amdgcn_exp2f(m[qt] - mx[qt]);
            l[qt] *= alpha;
#pragma unroll
            for (int dt = 0; dt < 4; ++dt) o[qt][dt] *= alpha;
        }
    }
    bf16x8 pf[NQT];
#pragma unroll
    for (int qt = 0; qt < NQT; ++qt) {
        m[qt] = mx[qt];
        float pr[8]; float ps = 0.f;
#pragma unroll
        for (int j = 0; j < 4; ++j) {
            pr[j] = __builtin_amdgcn_exp2f(s0[qt][j] - mx[qt]);
            pr[j + 4] = __builtin_amdgcn_exp2f(s1[qt][j] - mx[qt]);
        }
#pragma unroll
        for (int j = 0; j < 8; ++j) ps += pr[j];
        l[qt] += ps;
        const u32x4 pk = {pack2(pr[0], pr[1]), pack2(pr[2], pr[3]), pack2(pr[4], pr[5]), pack2(pr[6], pr[7])};
        pf[qt] = __builtin_bit_cast(bf16x8, pk);
    }
#pragma unroll
    for (int dt = 0; dt < 4; ++dt)
#pragma unroll
        for (int qt = 0; qt < NQT; ++qt) o[qt][dt] = __builtin_amdgcn_mfma_f32_16x16x32_bf16(f.v[dt], pf[qt], o[qt][dt], 0, 0, 0);
    __builtin_amdgcn_sched_barrier(0);
}
struct RangeIt { int c, c_hi; __device__ __forceinline__ int nxt() { if (c > c_hi) return -1; return (c++) * 32; } };
struct MaskIt { unsigned long long cm; __device__ __forceinline__ int nxt() { if (!cm) return -1; const int i = __builtin_ctzll(cm); cm &= cm - 1; return i * 32; } };
template <bool PFV, bool FM, class It, class Gen>
__device__ __forceinline__ void attn_run(It& it, const bf16_t* Kb, size_t ldk, const bf16_t* VTb, size_t ldv, int fr, int fq, const Gen& gen) {
    KVFrag fa, fb;
    int ka = it.nxt(); if (ka < 0) return;
    k_load<FM>(fa, Kb, ldk, ka, fr, fq); if (PFV) v_load<FM>(fa.v, VTb, ldv, ka, fr, fq);
    for (;;) {
        const int kb = it.nxt(); if (kb >= 0) { k_load<FM>(fb, Kb, ldk, kb, fr, fq); if (PFV) v_load<FM>(fb.v, VTb, ldv, kb, fr, fq); }
        if (!PFV) v_load<FM>(fa.v, VTb, ldv, ka, fr, fq);
        gen(ka, fa);
        if (kb < 0) break;
        ka = it.nxt(); if (ka >= 0) { k_load<FM>(fa, Kb, ldk, ka, fr, fq); if (PFV) v_load<FM>(fa.v, VTb, ldv, ka, fr, fq); }
        if (!PFV) v_load<FM>(fb.v, VTb, ldv, kb, fr, fq);
        gen(kb, fb);
        if (ka < 0) break;
    }
}
template <int NQT>
__device__ __forceinline__ void attn_init(f32x4 (&o)[NQT][4], float (&m)[NQT], float (&l)[NQT]) {
#pragma unroll
    for (int qt = 0; qt < NQT; ++qt) { m[qt] = MINIT; l[qt] = 0.f;
#pragma unroll
        for (int dt = 0; dt < 4; ++dt) o[qt][dt] = (f32x4){0.f, 0.f, 0.f, 0.f}; }
}
__device__ __forceinline__ float lsum4(float l) { return rowsum4(l); }
__device__ __forceinline__ void store_o16(unsigned char* dst, const f32x4 v0, const f32x4 v1, const f32x4 v2, const f32x4 v3) {
    u32x4 w; w.x = pack4_fp8(v0[0], v0[1], v0[2], v0[3]); w.y = pack4_fp8(v1[0], v1[1], v1[2], v1[3]); w.z = pack4_fp8(v2[0], v2[1], v2[2], v2[3]); w.w = pack4_fp8(v3[0], v3[1], v3[2], v3[3]);
    *(u32x4*)dst = w;
}
__device__ __forceinline__ float sigmoidf_fast(float x) { return __builtin_amdgcn_rcpf(1.0f + __builtin_amdgcn_exp2f(-L2E * x)); }

__device__ __forceinline__ void fox_unit(const Params& p, int b, int h, int qb, int fr, int fq) {
    asm volatile("" : "+v"(fr), "+v"(fq));
    const int t0 = qb * 64;
    const bf16_t* Qb = p.hb + ((size_t)b * SEQ + t0) * NMAIN + C_FQ + h * 64 + fq * 8;
    bf16x8 qf[4][2];
#pragma unroll
    for (int qt = 0; qt < 4; ++qt) { qf[qt][0] = *(const bf16x8*)(Qb + (size_t)(qt * 16 + fr) * NMAIN); qf[qt][1] = *(const bf16x8*)(Qb + (size_t)(qt * 16 + fr) * NMAIN + 32); }
    const float* cf = p.cF + ((size_t)b * 4 + h) * SEQ;
    float cq[4];
#pragma unroll
    for (int qt = 0; qt < 4; ++qt) cq[qt] = cf[t0 + qt * 16 + fr] * L2E;
    f32x4 o[4][4]; float m[4], l[4];
    attn_init<4>(o, m, l);
    const bf16_t* Kb = p.kF + ((size_t)b * NVH + h) * 64 * SEQ;
    const bf16_t* VTb = p.vT + ((size_t)b * NVH + h) * 64 * SEQ;
    RangeIt it{0, (t0 >> 5) + 1};
    attn_run<false, true>(it, Kb, NMAIN, VTb, SEQ, fr, fq, [&](int kc0, const KVFrag& f) {
        const float4 ca = *(const float4*)(cf + kc0 + 8 * fq), cb = *(const float4*)(cf + kc0 + 8 * fq + 4);
        const float ck[8] = {ca.x * L2E, ca.y * L2E, ca.z * L2E, ca.w * L2E, cb.x * L2E, cb.y * L2E, cb.z * L2E, cb.w * L2E};
        const int kq = kc0 + 8 * fq - t0 - fr;
        attn_compute<4, true>(f, qf, o, m, l, [&](int qt, int j, float raw) { return (kq + j - 16 * qt) > 0 ? MASKV : raw * SCL2 + cq[qt] - ck[j]; });
    });
#pragma unroll
    for (int qt = 0; qt < 4; ++qt) {
        const float inv = __builtin_amdgcn_rcpf(lsum4(l[qt]));
        unsigned char* dst = (unsigned char*)p.ob + ((size_t)b * SEQ + t0 + qt * 16 + fr) * DM + h * 64 + 16 * fq;
        store_o16(dst, o[qt][0] * inv, o[qt][1] * inv, o[qt][2] * inv, o[qt][3] * inv);
    }
}
__device__ __forceinline__ void swa_unit(const Params& p, int l_, int b, int kv, int pos, int fr, int fq) {
    asm volatile("" : "+v"(fr), "+v"(fq));
    const int t0 = pos * 16, t = t0 + fr;
    const bf16_t* Qb = p.hb + ((size_t)b * SEQ + t) * NMAIN + C_SQ + kv * 192 + fq * 8;
    bf16x8 qf[3][2];
#pragma unroll
    for (int g = 0; g < 3; ++g) { qf[g][0] = *(const bf16x8*)(Qb + g * 64); qf[g][1] = *(const bf16x8*)(Qb + g * 64 + 32); }
    float sl[3];
#pragma unroll
    for (int g = 0; g < 3; ++g) sl[g] = slope_swa(kv * 3 + g) * L2E;
    f32x4 o[3][4]; float m[3], l[3];
    attn_init<3>(o, m, l);
    const bf16_t* Kb = p.kF + ((size_t)b * NVH + 4 + kv) * 64 * SEQ;
    const bf16_t* VTb = p.vT + ((size_t)b * NVH + 4 + kv) * 64 * SEQ;
    RangeIt it{max(0, t0 - 127) >> 5, (t0 + 15) >> 5};
    attn_run<true, true>(it, Kb, NMAIN, VTb, SEQ, fr, fq, [&](int kc0, const KVFrag& f) {
        const int dq = t - kc0 - 8 * fq;
        attn_compute<3, true>(f, qf, o, m, l, [&](int g, int j, float raw) { const int dist = dq - j; return ((unsigned)dist < 128u) ? raw * SCL2 - sl[g] * (float)dist : MASKV; });
    });
#pragma unroll
    for (int g = 0; g < 3; ++g) {
        const float sink = p.sinks[l_ * 6 + kv * 3 + g] * L2E;
        const float inv = __builtin_amdgcn_rcpf(lsum4(l[g]) + __builtin_amdgcn_exp2f(sink - m[g]));
        unsigned char* dst = (unsigned char*)p.ob + ((size_t)b * SEQ + t) * DM + 256 + (kv * 3 + g) * 64 + 16 * fq;
        store_o16(dst, o[g][0] * inv, o[g][1] * inv, o[g][2] * inv, o[g][3] * inv);
    }
}
__device__ __forceinline__ void nsa_unit(const Params& p, int b, int kv, int pos, int fr, int fq, int lane, float* ps, unsigned* msk, float* otl) {
    asm volatile("" : "+v"(fr), "+v"(fq), "+v"(lane));
    const int t0 = pos * 16, t = t0 + fr, cur = t0 >> 6;
    const bf16_t* Qb = p.hb + ((size_t)b * SEQ + t) * NMAIN + C_NQ + kv * 192 + fq * 8;
    bf16x8 qf[3][2];
#pragma unroll
    for (int g = 0; g < 3; ++g) { qf[g][0] = *(const bf16x8*)(Qb + g * 64); qf[g][1] = *(const bf16x8*)(Qb + g * 64 + 32); }
    float sl[3];
#pragma unroll
    for (int g = 0; g < 3; ++g) sl[g] = slope_nsa(kv * 3 + g) * L2E;
    const float* gl = p.hs + ((size_t)b * SEQ + t) * HS_W + 4 + kv * 9;
    f32x4 o[3][4]; float m[3], l[3];
    f32x4* otv = (f32x4*)otl + lane;
#pragma unroll
    for (int i = 0; i < 8; ++i) ps[lane + 64 * i] = 0.f;
    {
        const bf16_t* Kb = p.kc + ((size_t)b * 2 + kv) * 128 * 64;
        const bf16_t* VTb = p.vcT + ((size_t)b * 2 + kv) * 64 * 128;
        const int ncv = (t0 + 15 >= 31) ? ((t0 + 15 - 31) >> 4) + 1 : 0;
        const int nch = (ncv + 31) >> 5;
        attn_init<3>(o, m, l);
        const int dq0 = t - 31 - 16 * 8 * fq;
        RangeIt it{0, nch - 1};
        attn_run<false, false>(it, Kb, 64, VTb, 128, fr, fq, [&](int kc0, const KVFrag& f) {
            const int dq = dq0 - 16 * kc0;
            attn_compute<3, true>(f, qf, o, m, l, [&](int g, int j, float raw) { const int dist = dq - 16 * j; return dist >= 0 ? raw * SCL2 - sl[g] * (float)dist : MASKV; });
        });
        float il[3];
#pragma unroll
        for (int g = 0; g < 3; ++g) {
            const float lt = lsum4(l[g]); il[g] = lt > 0.f ? __builtin_amdgcn_rcpf(lt) : 0.f;
            const float gate = sigmoidf_fast(gl[g * 3 + 0]);
#pragma unroll
            for (int dt = 0; dt < 4; ++dt) otv[(g * 4 + dt) * 64] = o[g][dt] * (il[g] * gate);
        }
        float carry_prev = 0.f;
        for (int c = 0; c < nch; ++c) {
            const int kc0 = c * 32, dq = dq0 - 16 * kc0;
            const bf16_t* kp = Kb + (size_t)(kc0 + (fr >> 2) * 8 + (fr & 3)) * 64 + fq * 8;
            const bf16x8 k00 = *(const bf16x8*)(kp), k01 = *(const bf16x8*)(kp + 32), k10 = *(const bf16x8*)(kp + 256), k11 = *(const bf16x8*)(kp + 256 + 32);
            float pc[8];
#pragma unroll
            for (int j = 0; j < 8; ++j) pc[j] = 0.f;
#pragma unroll
            for (int g = 0; g < 3; ++g) {
                f32x4 s0 = (f32x4){0.f, 0.f, 0.f, 0.f}, s1 = s0;
                s0 = __builtin_amdgcn_mfma_f32_16x16x32_bf16(k00, qf[g][0], s0, 0, 0, 0); s0 = __builtin_amdgcn_mfma_f32_16x16x32_bf16(k01, qf[g][1], s0, 0, 0, 0);
                s1 = __builtin_amdgcn_mfma_f32_16x16x32_bf16(k10, qf[g][0], s1, 0, 0, 0); s1 = __builtin_amdgcn_mfma_f32_16x16x32_bf16(k11, qf[g][1], s1, 0, 0, 0);
#pragma unroll
                for (int j = 0; j < 8; ++j) {
                    const int dist = dq - 16 * j; const float raw = j < 4 ? s0[j] : s1[j - 4];
                    if (dist >= 0) pc[j] += __builtin_amdgcn_exp2f(raw * SCL2 - sl[g] * (float)dist - m[g]) * il[g];
                }
            }
            const float cout = 0.5f * pc[7];
            float cin = shfl_f(cout, lane - 16);
            const float cwrap = shfl_f(cout, fr + 48);
            if (fq == 0) cin = carry_prev;
            carry_prev = cwrap;
            const int n0 = (kc0 >> 2) + 2 * fq;
            ps[fr * 32 + n0] = cin + pc[0] + pc[1] + pc[2] + 0.5f * pc[3];
            ps[fr * 32 + n0 + 1] = 0.5f * pc[3] + pc[4] + pc[5] + pc[6] + 0.5f * pc[7];
        }
    }
    lds_wave_sync();
    if (lane < 16) {
        unsigned mask = 1u | (1u << cur); if (cur >= 1) mask |= 1u << (cur - 1);
        if (cur >= 3) {
            if (cur - 2 <= 5) mask |= (1u << (cur - 1)) - 2u;
            else {
                const float* my = ps + lane * 32;
                for (int r = 0; r < 5; ++r) {
                    float best = -1.0f; int bi = 1;
                    for (int j = 1; j <= cur - 2; ++j) { const float v = my[j]; if (!((mask >> j) & 1u) && v > best) { best = v; bi = j; } }
                    mask |= 1u << bi;
                }
            }
        }
        msk[lane] = mask;
    }
    lds_wave_sync();
    const unsigned qmask = msk[fr];
    lds_wave_sync();
    {
        const bf16_t* Kb = p.kF + ((size_t)b * NVH + 6 + kv) * 64 * SEQ;
        const bf16_t* VTb = p.vT + ((size_t)b * NVH + 6 + kv) * 64 * SEQ;
        attn_init<3>(o, m, l);
        unsigned um = qmask;
        um |= shfl_u(um, lane ^ 1); um |= shfl_u(um, lane ^ 2); um |= shfl_u(um, lane ^ 4); um |= shfl_u(um, lane ^ 8);
        um = (unsigned)__builtin_amdgcn_readfirstlane((int)um) & (cur >= 31 ? 0xffffffffu : ((2u << cur) - 1u));
        unsigned long long cm = 0ull;
        for (unsigned r = um; r; r &= r - 1) { const int kb = __builtin_ctz(r); cm |= 3ull << (2 * kb); }
        MaskIt it{cm};
        attn_run<true, true>(it, Kb, NMAIN, VTb, SEQ, fr, fq, [&](int kc0, const KVFrag& f) {
            const bool mine = (qmask >> (kc0 >> 6)) & 1u;
            const int dq = t - kc0 - 8 * fq;
            attn_compute<3, true>(f, qf, o, m, l, [&](int g, int j, float raw) { const int dist = dq - j; return (mine && dist >= 0) ? raw * SCL2 - sl[g] * (float)dist : MASKV; });
        });
#pragma unroll
        for (int g = 0; g < 3; ++g) {
            const float lt = lsum4(l[g]); const float sc = (lt > 0.f ? __builtin_amdgcn_rcpf(lt) : 0.f) * sigmoidf_fast(gl[g * 3 + 1]);
#pragma unroll
            for (int dt = 0; dt < 4; ++dt) otv[(g * 4 + dt) * 64] += o[g][dt] * sc;
        }
    }
    {
        const bf16_t* Kb = p.kF + ((size_t)b * NVH + 8 + kv) * 64 * SEQ;
        const bf16_t* VTb = p.vT + ((size_t)b * NVH + 8 + kv) * 64 * SEQ;
        attn_init<3>(o, m, l);
        RangeIt it{max(0, t0 - 511) >> 5, (t0 + 15) >> 5};
        attn_run<true, true>(it, Kb, NMAIN, VTb, SEQ, fr, fq, [&](int kc0, const KVFrag& f) {
            const int dq = t - kc0 - 8 * fq;
            attn_compute<3, true>(f, qf, o, m, l, [&](int g, int j, float raw) { const int dist = dq - j; return ((unsigned)dist < 512u) ? raw * SCL2 - sl[g] * (float)dist : MASKV; });
        });
#pragma unroll
        for (int g = 0; g < 3; ++g) {
            const float lt = lsum4(l[g]); const float sc = (lt > 0.f ? __builtin_amdgcn_rcpf(lt) : 0.f) * sigmoidf_fast(gl[g * 3 + 2]);
            unsigned char* dst = (unsigned char*)p.ob + ((size_t)b * SEQ + t) * DM + 640 + (kv * 3 + g) * 64 + 16 * fq;
            store_o16(dst, otv[(g * 4 + 0) * 64] + o[g][0] * sc, otv[(g * 4 + 1) * 64] + o[g][1] * sc, otv[(g * 4 + 2) * 64] + o[g][2] * sc, otv[(g * 4 + 3) * 64] + o[g][3] * sc);
        }
    }
}

template <bool WITH_CONV>
__device__ __forceinline__ void phase_attn(const Params& p, int l, char* lds, int cslot = 16) {
    int tid = threadIdx.x; asm volatile("" : "+v"(tid));
    const int wid = tid >> 6, lane = tid & 63, fr = lane & 15, fq = lane >> 4;
    float* ps = (float*)(lds + wid * 16896); unsigned* msk = (unsigned*)(ps + 512); float* otl = ps + 576;
    unsigned* ctr = p.ctrl + cslot + l;
    constexpr unsigned NU_NSA = NB * 2 * 128, NU_FOX = NB * 4 * 32, NU_SWA = NB * 2 * 128, NU_ATT = NU_NSA + NU_FOX + NU_SWA;
    for (;;) {
        unsigned u = 0;
        if (lane == 0) u = __hip_atomic_fetch_add(ctr, 1u, __ATOMIC_RELAXED, __HIP_MEMORY_SCOPE_AGENT);
        u = (unsigned)__builtin_amdgcn_readfirstlane((int)u);
        if (WITH_CONV) {
            constexpr unsigned TOTQ = NU_ATT + (unsigned)CONV_TILES;
            if (u >= TOTQ) break;
            const unsigned a0 = (unsigned)(((unsigned long long)u * NU_ATT) / TOTQ), a1 = (unsigned)(((unsigned long long)(u + 1) * NU_ATT) / TOTQ);
            if (a1 == a0) { conv_tile_wave(p, (int)(u - a0), lane, (unsigned char*)ps); continue; }
            u = a0;
        } else {
#ifndef ATT_REP
#define ATT_REP 1
#endif
            if (u >= ATT_REP * NU_ATT) break;
            if (ATT_REP > 1) u %= NU_ATT;
        }
        if (u < NU_NSA) { const int pos = 127 - (int)(u & 127), r = u >> 7; nsa_unit(p, r >> 1, r & 1, pos, fr, fq, lane, ps, msk, otl); }
        else if (u < NU_NSA + NU_FOX) { const unsigned v = u - NU_NSA; const int qb = 31 - (int)(v & 31), r = v >> 5; fox_unit(p, r >> 2, r & 3, qb, fr, fq); }
        else { const unsigned v = u - NU_NSA - NU_FOX; const int pos = 127 - (int)(v & 127), r = v >> 7; swa_unit(p, l, r >> 1, r & 1, pos, fr, fq); }
    }
}

__device__ __forceinline__ void phase_ln1_router(const Params& p, int l, char* lds) {
    int tid = threadIdx.x; asm volatile("" : "+v"(tid));
    const int wid = tid >> 6, lane = tid & 63, fr = lane & 15, fq = lane >> 4;
    float* lg = (float*)lds + wid * 512;
    int* lcnt = (int*)(lds + 16384); int* lbase = lcnt + 32;
    const float* g1 = p.ln1_g + l * DM; const float* b1 = p.ln1_b + l * DM;
    const float* rw = p.rwT + (size_t)l * NE * 1024; const float* rb = p.router_b + l * NE;
    unsigned* gcount = p.ctrl + 64 + l * NE;
    for (int grp = blockIdx.x; grp < NTOK / 128; grp += gridDim.x) {
        const int tok0 = grp * 128 + wid * 16;
        if (tid < 32) lcnt[tid] = 0;
        float gg[16], bb[16];
#pragma unroll
        for (int j = 0; j < 4; ++j) { const float4 g4 = *(const float4*)(g1 + lane * 16 + j * 4), b4 = *(const float4*)(b1 + lane * 16 + j * 4);
            gg[4 * j] = g4.x; gg[4 * j + 1] = g4.y; gg[4 * j + 2] = g4.z; gg[4 * j + 3] = g4.w; bb[4 * j] = b4.x; bb[4 * j + 1] = b4.y; bb[4 * j + 2] = b4.z; bb[4 * j + 3] = b4.w; }
        for (int r0 = 0; r0 < 16; r0 += 4) {
            float v[4][16]; float s[4], qv[4];
#pragma unroll
            for (int i = 0; i < 4; ++i) {
                const bf16_t* tr = (const bf16_t*)p.tbuf + (size_t)(tok0 + r0 + i) * DM + lane * 16;
                const u32x4 t0 = *(const u32x4*)tr, t1 = *(const u32x4*)(tr + 8);
                const unsigned ts[8] = {t0.x, t0.y, t0.z, t0.w, t1.x, t1.y, t1.z, t1.w};
#pragma unroll
                for (int c = 0; c < 8; ++c) { v[i][2 * c] = __uint_as_float(ts[c] << 16); v[i][2 * c + 1] = __uint_as_float(ts[c] & 0xffff0000u); }
            }
#pragma unroll
            for (int i = 0; i < 4; ++i) { s[i] = 0.f;
#pragma unroll
                for (int c = 0; c < 16; c += 4) s[i] += (v[i][c] + v[i][c + 1]) + (v[i][c + 2] + v[i][c + 3]); }
#pragma unroll
            for (int o = 32; o > 0; o >>= 1) {
#pragma unroll
                for (int i = 0; i < 4; ++i) s[i] += shfl_f(s[i], lane ^ o); }
#pragma unroll
            for (int i = 0; i < 4; ++i) { const float mean = s[i] * (1.0f / 1024.0f); qv[i] = 0.f;
#pragma unroll
                for (int c = 0; c < 16; c += 4) { v[i][c] -= mean; v[i][c + 1] -= mean; v[i][c + 2] -= mean; v[i][c + 3] -= mean;
                    qv[i] += (v[i][c] * v[i][c] + v[i][c + 1] * v[i][c + 1]) + (v[i][c + 2] * v[i][c + 2] + v[i][c + 3] * v[i][c + 3]); } }
#pragma unroll
            for (int o = 32; o > 0; o >>= 1) {
#pragma unroll
                for (int i = 0; i < 4; ++i) qv[i] += shfl_f(qv[i], lane ^ o); }
#pragma unroll
            for (int i = 0; i < 4; ++i) {
                const float rstd = rsqrtf(qv[i] * (1.0f / 1024.0f) + LN_EPS);
                const size_t row = (size_t)(tok0 + r0 + i);
                float y[16];
#pragma unroll
                for (int c = 0; c < 16; ++c) y[c] = v[i][c] * rstd * gg[c] + bb[c];
                u32x4 w0, w1, q;
                w0.x = pack2(y[0], y[1]); w0.y = pack2(y[2], y[3]); w0.z = pack2(y[4], y[5]); w0.w = pack2(y[6], y[7]);
                w1.x = pack2(y[8], y[9]); w1.y = pack2(y[10], y[11]); w1.z = pack2(y[12], y[13]); w1.w = pack2(y[14], y[15]);
                q.x = pack4_fp8(y[0], y[1], y[2], y[3]); q.y = pack4_fp8(y[4], y[5], y[6], y[7]); q.z = pack4_fp8(y[8], y[9], y[10], y[11]); q.w = pack4_fp8(y[12], y[13], y[14], y[15]);
                *(u32x4*)((bf16_t*)p.x1f + row * DM + lane * 16) = w0; *(u32x4*)((bf16_t*)p.x1f + row * DM + lane * 16 + 8) = w1;
                *(u32x4*)((char*)p.x1b + row * DM + lane * 16) = q;
            }
        }
        __syncthreads();
        f32x4 a0 = (f32x4){0.f, 0.f, 0.f, 0.f}, a1 = a0;
        const bf16_t* xr = (const bf16_t*)p.x1f + (size_t)(tok0 + fr) * DM + 4 * fq;
        const float* w0 = rw + (size_t)fr * 1024 + 4 * fq; const float* w1 = rw + (size_t)(16 + fr) * 1024 + 4 * fq;
#pragma unroll 4
        for (int k0 = 0; k0 < 1024; k0 += 16) {
            const u32x2 xw = *(const u32x2*)(xr + k0); const float4 wb0 = *(const float4*)(w0 + k0), wb1 = *(const float4*)(w1 + k0);
            const float4 xa = make_float4(__uint_as_float(xw.x << 16), __uint_as_float(xw.x & 0xffff0000u), __uint_as_float(xw.y << 16), __uint_as_float(xw.y & 0xffff0000u));
            a0 = __builtin_amdgcn_mfma_f32_16x16x4f32(xa.x, wb0.x, a0, 0, 0, 0); a1 = __builtin_amdgcn_mfma_f32_16x16x4f32(xa.x, wb1.x, a1, 0, 0, 0);
            a0 = __builtin_amdgcn_mfma_f32_16x16x4f32(xa.y, wb0.y, a0, 0, 0, 0); a1 = __builtin_amdgcn_mfma_f32_16x16x4f32(xa.y, wb1.y, a1, 0, 0, 0);
            a0 = __builtin_amdgcn_mfma_f32_16x16x4f32(xa.z, wb0.z, a0, 0, 0, 0); a1 = __builtin_amdgcn_mfma_f32_16x16x4f32(xa.z, wb1.z, a1, 0, 0, 0);
            a0 = __builtin_amdgcn_mfma_f32_16x16x4f32(xa.w, wb0.w, a0, 0, 0, 0); a1 = __builtin_amdgcn_mfma_f32_16x16x4f32(xa.w, wb1.w, a1, 0, 0, 0);
        }
#pragma unroll
        for (int r = 0; r < 4; ++r) { lg[(fq * 4 + r) * 32 + fr] = a0[r] + rb[fr]; lg[(fq * 4 + r) * 32 + 16 + fr] = a1[r] + rb[16 + fr]; }
        lds_wave_sync();
        int e4[4] = {0, 0, 0, 0}; int rk[4] = {0, 0, 0, 0};
        if (lane < 16) {
            const float* my = lg + lane * 32; unsigned taken = 0u; float tv[4];
#pragma unroll
            for (int k = 0; k < 4; ++k) {
                float best = NEG_INF; int bi = 0;
                for (int e = 0; e < 32; ++e) { const float xv = my[e]; if (!((taken >> e) & 1u) && xv > best) { best = xv; bi = e; } }
                taken |= 1u << bi; e4[k] = bi; tv[k] = best;
            }
            const float e1 = __expf(tv[1] - tv[0]), e2 = __expf(tv[2] - tv[0]), e3 = __expf(tv[3] - tv[0]);
            const float inv = 1.0f / (1.0f + e1 + e2 + e3);
            const size_t row = (size_t)(tok0 + lane);
            *(float4*)(p.gw + row * 4) = make_float4(inv, e1 * inv, e2 * inv, e3 * inv);
        }
        __syncthreads();
        if (lane < 16) {
#pragma unroll
            for (int k = 0; k < 4; ++k) rk[k] = atomicAdd(&lcnt[e4[k]], 1);
        }
        __syncthreads();
        if (tid < 32) { const int c = lcnt[tid]; lbase[tid] = c ? (int)__hip_atomic_fetch_add(gcount + tid, (unsigned)c, __ATOMIC_RELAXED, __HIP_MEMORY_SCOPE_AGENT) : 0; }
        __syncthreads();
        if (lane < 16) {
            const int row = tok0 + lane; int pk[4];
#pragma unroll
            for (int k = 0; k < 4; ++k) { const int pos = lbase[e4[k]] + rk[k]; p.lists[(size_t)e4[k] * LIST_CAP + pos] = row * 4 + k; pk[k] = (pos << 5) | e4[k]; }
            *(int4*)(p.top_e + (size_t)row * 4) = make_int4(pk[0], pk[1], pk[2], pk[3]);
        }
        __syncthreads();
    }
}

__device__ __forceinline__ void phase_ln2(const Params& p, int l, float* xout, char* lds) {
    int* ptile = (int*)(lds + LDS_TAB); int* ecnt = ptile + 40;
    build_tiles(p, l, ptile, ecnt);
    int tid = threadIdx.x; asm volatile("" : "+v"(tid));
    const int wid = tid >> 6, lane = tid & 63;
    const float* g2 = p.ln2_g + l * DM; const float* b2 = p.ln2_b + l * DM;
    float gg[16], bb[16];
#pragma unroll
    for (int j = 0; j < 4; ++j) { const float4 g4 = *(const float4*)(g2 + lane * 16 + j * 4), b4 = *(const float4*)(b2 + lane * 16 + j * 4);
        gg[4 * j] = g4.x; gg[4 * j + 1] = g4.y; gg[4 * j + 2] = g4.z; gg[4 * j + 3] = g4.w; bb[4 * j] = b4.x; bb[4 * j + 1] = b4.y; bb[4 * j + 2] = b4.z; bb[4 * j + 3] = b4.w; }
    for (int pr = blockIdx.x * NWV + wid; pr < NTOK / 2; pr += gridDim.x * NWV) {
        float v[2][16]; float s[2], qv[2];
        u32x4 yv[2][4], xv[2][2]; float gk[2][4];
#pragma unroll
        for (int i = 0; i < 2; ++i) {
            const int row = pr * 2 + i;
            const float4 gwv = *(const float4*)(p.gw + (size_t)row * 4);
            gk[i][0] = gwv.x; gk[i][1] = gwv.y; gk[i][2] = gwv.z; gk[i][3] = gwv.w;
            const int4 te = *(const int4*)(p.top_e + (size_t)row * 4);
            const int tk[4] = {te.x, te.y, te.z, te.w};
            xv[i][0] = *(const u32x4*)((const bf16_t*)p.x1f + (size_t)row * DM + lane * 16); xv[i][1] = *(const u32x4*)((const bf16_t*)p.x1f + (size_t)row * DM + lane * 16 + 8);
#pragma unroll
            for (int k = 0; k < 4; ++k) yv[i][k] = *(const u32x4*)((const unsigned char*)p.ybuf + (size_t)(ptile[tk[k] & 31] * 256 + (tk[k] >> 5)) * DM + lane * 16);
        }
#pragma unroll
        for (int i = 0; i < 2; ++i) { s[i] = 0.f;
            const unsigned xs[8] = {xv[i][0].x, xv[i][0].y, xv[i][0].z, xv[i][0].w, xv[i][1].x, xv[i][1].y, xv[i][1].z, xv[i][1].w};
#pragma unroll
            for (int c = 0; c < 8; ++c) { v[i][2 * c] = __uint_as_float(xs[c] << 16) * ALPHA; v[i][2 * c + 1] = __uint_as_float(xs[c] & 0xffff0000u) * ALPHA; }
#pragma unroll
            for (int k = 0; k < 4; ++k) {
                const unsigned ys[4] = {yv[i][k].x, yv[i][k].y, yv[i][k].z, yv[i][k].w};
#pragma unroll
                for (int c = 0; c < 4; ++c) {
                    const f32x2_t lo = __builtin_amdgcn_cvt_pk_f32_fp8(ys[c], false), hi = __builtin_amdgcn_cvt_pk_f32_fp8(ys[c], true);
                    v[i][4 * c] += gk[i][k] * lo.x; v[i][4 * c + 1] += gk[i][k] * lo.y; v[i][4 * c + 2] += gk[i][k] * hi.x; v[i][4 * c + 3] += gk[i][k] * hi.y;
                }
            }
#pragma unroll
            for (int c = 0; c < 16; c += 4) s[i] += (v[i][c] + v[i][c + 1]) + (v[i][c + 2] + v[i][c + 3]);
        }
#pragma unroll
        for (int o = 32; o > 0; o >>= 1) { s[0] += shfl_f(s[0], lane ^ o); s[1] += shfl_f(s[1], lane ^ o); }
#pragma unroll
        for (int i = 0; i < 2; ++i) { const float mean = s[i] * (1.0f / 1024.0f); qv[i] = 0.f;
#pragma unroll
            for (int c = 0; c < 16; c += 4) { v[i][c] -= mean; v[i][c + 1] -= mean; v[i][c + 2] -= mean; v[i][c + 3] -= mean;
                qv[i] += (v[i][c] * v[i][c] + v[i][c + 1] * v[i][c + 1]) + (v[i][c + 2] * v[i][c + 2] + v[i][c + 3] * v[i][c + 3]); } }
#pragma unroll
        for (int o = 32; o > 0; o >>= 1) { qv[0] += shfl_f(qv[0], lane ^ o); qv[1] += shfl_f(qv[1], lane ^ o); }
#pragma unroll
        for (int i = 0; i < 2; ++i) {
            const float rstd = rsqrtf(qv[i] * (1.0f / 1024.0f) + LN_EPS);
            const size_t row = (size_t)(pr * 2 + i);
            float y[16];
#pragma unroll
            for (int c = 0; c < 16; ++c) y[c] = v[i][c] * rstd * gg[c] + bb[c];
            if (l + 1 < NL) {
                u32x4 w0, w1, q;
                w0.x = pack2(y[0], y[1]); w0.y = pack2(y[2], y[3]); w0.z = pack2(y[4], y[5]); w0.w = pack2(y[6], y[7]);
                w1.x = pack2(y[8], y[9]); w1.y = pack2(y[10], y[11]); w1.z = pack2(y[12], y[13]); w1.w = pack2(y[14], y[15]);
                q.x = pack4_fp8(y[0], y[1], y[2], y[3]); q.y = pack4_fp8(y[4], y[5], y[6], y[7]); q.z = pack4_fp8(y[8], y[9], y[10], y[11]); q.w = pack4_fp8(y[12], y[13], y[14], y[15]);
                *(u32x4*)(p.xb + row * DM + lane * 16) = w0; *(u32x4*)(p.xb + row * DM + lane * 16 + 8) = w1;
                *(u32x4*)(p.xq + row * DM + lane * 16) = q;
            } else {
#pragma unroll
                for (int c = 0; c < 16; c += 4) *(float4*)(xout + row * DM + lane * 16 + c) = make_float4(y[c], y[c + 1], y[c + 2], y[c + 3]);
            }
        }
    }
}

#define XB_TMO      128
#define XB_XCNT(j)  (256  + 64 * (j))
#define XB_XSUB(j)  (1280 + 64 * (j))
#define XB_XGEN(j)  (2304 + 64 * (j))
#define XB_TOP      3328
#define XB_TOPGEN   3392
#define XCD_BAR_WORDS 3456
#define XB_SPIN_CAP (1u << 22)
__device__ __forceinline__ unsigned xb_ld(unsigned* p)              { return __hip_atomic_load(p, __ATOMIC_RELAXED, __HIP_MEMORY_SCOPE_AGENT); }
__device__ __forceinline__ unsigned xb_add(unsigned* p, unsigned v) { return __hip_atomic_fetch_add(p, v, __ATOMIC_RELAXED, __HIP_MEMORY_SCOPE_AGENT); }
__device__ __forceinline__ unsigned xb_xcc_id() { return (unsigned)__builtin_amdgcn_s_getreg((3 << 11) | 20) & 0xFu; }
#define XB_SPIN(cond, bar) do { unsigned _sp = 0; while (cond) { __builtin_amdgcn_s_sleep(1); \
    if ((++_sp & 255u) == 0u) { if (xb_ld(&(bar)[XB_TMO])) break; if (_sp > XB_SPIN_CAP) { atomicAdd(&(bar)[XB_TMO], 1u); break; } } } } while (0)
struct XcdBarrier { unsigned* bar; unsigned x; volatile LAS unsigned* st; };
__device__ __forceinline__ XcdBarrier xcd_barrier_post(unsigned* bar, volatile LAS unsigned* st) {
    XcdBarrier b; b.bar = bar; b.x = xb_xcc_id(); b.st = st;
    if (threadIdx.x == 0) (void)xb_add(&bar[XB_XCNT(b.x)], 1u);
    return b;
}
__device__ __forceinline__ void xcd_barrier_complete(unsigned* bar, unsigned x, unsigned& nloc, unsigned& nx) {
    const unsigned G = gridDim.x * gridDim.y * gridDim.z;
    unsigned sum, cnt, mine, sp = 0u;
    for (;;) {
        sum = 0u; cnt = 0u; mine = 0u;
#pragma unroll
        for (unsigned j = 0; j < 16; ++j) { const unsigned c = xb_ld(&bar[XB_XCNT(j)]); sum += c; cnt += (c > 0u) ? 1u : 0u; mine = (j == x) ? c : mine; }
        if (sum == G) break;
        __builtin_amdgcn_s_sleep(1);
        if ((++sp & 255u) == 0u) { if (xb_ld(&bar[XB_TMO])) break; if (sp > XB_SPIN_CAP) { atomicAdd(&bar[XB_TMO], 1u); break; } }
    }
    nloc = mine > 0u ? mine : 1u; nx = cnt > 0u ? cnt : 1u;
}
__device__ __forceinline__ void xcd_barrier(const XcdBarrier& b) {
    asm volatile("s_waitcnt vmcnt(0)" ::: "memory");
    __syncthreads();
    if (threadIdx.x == 0) {
        unsigned* bar = b.bar;
        __builtin_amdgcn_s_waitcnt(0);
        unsigned nloc = b.st[0], nx = b.st[1];
        if (nloc == 0u) { xcd_barrier_complete(bar, b.x, nloc, nx); b.st[0] = nloc; b.st[1] = nx; }
        const unsigned old = xb_add(&bar[XB_XSUB(b.x)], 1u);
        const unsigned gen = old / nloc;
        if (old + 1u == (gen + 1u) * nloc) {
            __builtin_amdgcn_fence(__ATOMIC_RELEASE, "agent");
            asm volatile("s_waitcnt vmcnt(0)" ::: "memory");
            const unsigned og = xb_add(&bar[XB_TOP], 1u);
            const unsigned tg = og / nx;
            if (og + 1u == (tg + 1u) * nx) xb_add(&bar[XB_TOPGEN], 1u);
            else XB_SPIN(xb_ld(&bar[XB_TOPGEN]) == tg, bar);
            __builtin_amdgcn_fence(__ATOMIC_ACQUIRE, "agent");
            xb_add(&bar[XB_XGEN(b.x)], 1u);
            asm volatile("s_waitcnt vmcnt(0)" ::: "memory");
        } else {
            XB_SPIN(xb_ld(&bar[XB_XGEN(b.x)]) == gen, bar);
            __builtin_amdgcn_fence(__ATOMIC_ACQUIRE, "agent");
            asm volatile("s_waitcnt vmcnt(0)" ::: "memory");
        }
    }
    __syncthreads();
}

struct KArgs { const float* in[18]; float* out; char* ws; };
constexpr size_t al256(size_t v) { return (v + 255) / 256 * 256; }
struct WSL {
    static constexpr size_t ctrl = 0;
    static constexpr size_t WinT = al256(ctrl + 65536);
    static constexpr size_t WoT = al256(WinT + (size_t)NL * NPAD * 1024 * 2);
    static constexpr size_t W1T = al256(WoT + (size_t)NL * 1024 * 1024 * 2);
    static constexpr size_t W2T = al256(W1T + (size_t)NL * 2 * 64 * 2048 * 2);
    static constexpr size_t WguT = al256(W2T + (size_t)NL * 2 * 64 * 64 * 2);
    static constexpr size_t WdnT = al256(WguT + (size_t)NL * NE * 2048 * 1024 * 2);
    static constexpr size_t rwT = al256(WdnT + (size_t)NL * NE * 1024 * 1024 * 2);
    static constexpr size_t binp = al256(rwT + (size_t)NL * NE * 1024 * 4);
    static constexpr size_t bgup = al256(binp + (size_t)NL * NPAD * 4);
    static constexpr size_t b1c = al256(bgup + (size_t)NL * NE * 2048 * 4);
    static constexpr size_t xf = al256(b1c + 4 * 64 * 4);
    static constexpr size_t xb = al256(xf + (size_t)NTOK * DM * 4);
    static constexpr size_t hb = al256(xb + (size_t)NTOK * DM * 2);
    static constexpr size_t hs = al256(hb + (size_t)NTOK * NMAIN * 2);
    static constexpr size_t vT = al256(hs + (size_t)NTOK * HS_W * 4);
    static constexpr size_t kF = al256(vT + (size_t)NB * NVH * 64 * SEQ * 2);
    static constexpr size_t cF = al256(kF + (size_t)NB * NVH * 64 * SEQ * 2);
    static constexpr size_t kc = al256(cF + (size_t)NB * 4 * SEQ * 4);
    static constexpr size_t vc = al256(kc + (size_t)NB * 2 * 128 * 64 * 2);
    static constexpr size_t vcT = al256(vc + (size_t)NB * 2 * 128 * 64 * 2);
    static constexpr size_t ob = al256(vcT + (size_t)NB * 2 * 128 * 64 * 2);
    static constexpr size_t tbuf = al256(ob + (size_t)NTOK * DM * 2);
    static constexpr size_t x1f = al256(tbuf + (size_t)NTOK * DM * 4);
    static constexpr size_t x1b = al256(x1f + (size_t)NTOK * DM * 4);
    static constexpr size_t top_e = al256(x1b + (size_t)NTOK * DM * 2);
    static constexpr size_t gw = al256(top_e + (size_t)NTOK * 4 * 4);
    static constexpr size_t lists = al256(gw + (size_t)NTOK * 4 * 4);
    static constexpr size_t act = al256(lists + (size_t)NE * LIST_CAP * 4);
    static constexpr size_t ybuf = al256(act + (size_t)MAXSLOT * DFF * 2);
    static constexpr size_t xq = al256(ybuf + (size_t)MAXSLOT * DM * 2);
    static constexpr size_t WinQ = al256(xq + (size_t)NTOK * DM);
    static constexpr size_t total = al256(WinQ + (size_t)NL * NMAIN * 1024);
};
__device__ __forceinline__ Params make_params(const KArgs& k) {
    Params p;
    p.x = k.in[0]; p.w_in = k.in[1]; p.b_in = k.in[2]; p.sinks = k.in[3]; p.cmp_pe = k.in[4]; p.cmp_w1 = k.in[5]; p.cmp_w2 = k.in[6]; p.w_out = k.in[7];
    p.ln1_g = k.in[8]; p.ln1_b = k.in[9]; p.router_w = k.in[10]; p.router_b = k.in[11]; p.w_gu = k.in[12]; p.b_gu = k.in[13]; p.w_dn = k.in[14]; p.b_dn = k.in[15];
    p.ln2_g = k.in[16]; p.ln2_b = k.in[17]; p.out = k.out;
    char* w = k.ws;
    p.ctrl = (unsigned*)(w + WSL::ctrl); p.WinT = (bf16_t*)(w + WSL::WinT); p.WoT = (bf16_t*)(w + WSL::WoT); p.W1T = (bf16_t*)(w + WSL::W1T); p.W2T = (bf16_t*)(w + WSL::W2T);
    p.WguT = (bf16_t*)(w + WSL::WguT); p.WdnT = (bf16_t*)(w + WSL::WdnT); p.rwT = (float*)(w + WSL::rwT); p.binp = (float*)(w + WSL::binp); p.bgup = (float*)(w + WSL::bgup);
    p.b1c = (float*)(w + WSL::b1c); p.xf = (float*)(w + WSL::xf); p.xb = (bf16_t*)(w + WSL::xb); p.hb = (bf16_t*)(w + WSL::hb); p.hs = (float*)(w + WSL::hs); p.vT = (bf16_t*)(w + WSL::vT); p.kF = (bf16_t*)(w + WSL::kF);
    p.cF = (float*)(w + WSL::cF); p.kc = (bf16_t*)(w + WSL::kc); p.vc = (bf16_t*)(w + WSL::vc); p.vcT = (bf16_t*)(w + WSL::vcT); p.ob = (bf16_t*)(w + WSL::ob); p.tbuf = (float*)(w + WSL::tbuf);
    p.x1f = (float*)(w + WSL::x1f); p.x1b = (bf16_t*)(w + WSL::x1b); p.top_e = (int*)(w + WSL::top_e); p.gw = (float*)(w + WSL::gw); p.lists = (int*)(w + WSL::lists);
    p.act = (bf16_t*)(w + WSL::act); p.ybuf = (bf16_t*)(w + WSL::ybuf); p.xq = (unsigned char*)(w + WSL::xq); p.WinQ = (unsigned char*)(w + WSL::WinQ);
    return p;
}
__device__ __forceinline__ void grid_bar(const Params& p, char* lds) {
    XcdBarrier xb; xb.bar = p.ctrl + 1024; xb.x = xb_xcc_id(); xb.st = (volatile LAS unsigned*)(lds + LDS_BYTES - 16); xcd_barrier(xb);
}
__device__ __forceinline__ Params fresh_params(const KArgs& ka) {
    KArgs k2 = ka; size_t z = 0; asm volatile("" : "+s"(z));
    k2.ws = ka.ws + z;
    return make_params(k2);
}
#ifndef REP
#define REP 0
#endif
template <int L>
__device__ __forceinline__ void layer_fwd(const KArgs& ka, char* lds) {
    { const Params p = fresh_params(ka); phase_inproj(p, L, lds);        grid_bar(p, lds); }
    { const Params p = fresh_params(ka); phase_prep(p, L, lds);          grid_bar(p, lds); }
    { const Params p = fresh_params(ka); phase_attn<L == 0>(p, L, lds);  grid_bar(p, lds); }
    { const Params p = fresh_params(ka); phase_outproj(p, L, p.xb, lds);  grid_bar(p, lds); }
    { const Params p = fresh_params(ka); phase_ln1_router(p, L, lds);    grid_bar(p, lds); }
    { const Params p = fresh_params(ka); phase_gateup(p, L, lds);        grid_bar(p, lds); }
    { const Params p = fresh_params(ka); phase_down(p, L, lds);          grid_bar(p, lds); }
    { const Params p = fresh_params(ka); phase_ln2(p, L, L == NL - 1 ? p.out : p.xf, lds); }
}
__global__ void __launch_bounds__(NTHR, 2) fwd_kernel(KArgs ka) {
    extern __shared__ __attribute__((aligned(16))) char lds[];
    const Params p = make_params(ka);
    cg::grid_group grid = cg::this_grid();
    volatile LAS unsigned* xst = (volatile LAS unsigned*)(lds + LDS_BYTES - 16);
    if (threadIdx.x == 0) { xst[0] = 0u; xst[1] = 0u; }
    __syncthreads();
    (void)xcd_barrier_post(p.ctrl + 1024, xst);
    volatile LAS int* vcu = (volatile LAS int*)(lds + LDS_BYTES - 32);
    const unsigned myx = xb_xcc_id() & 7u;
    if (threadIdx.x == 0) vcu[1] = (int)__hip_atomic_fetch_add(p.ctrl + 32 + myx, 1u, __ATOMIC_RELAXED, __HIP_MEMORY_SCOPE_AGENT);
    phase0(p, lds);
    grid.sync();
    if (threadIdx.x == 0) {
        int base = 0, tot = 0;
        for (unsigned x = 0; x < 8; ++x) { const int n = (int)__hip_atomic_load(p.ctrl + 32 + x, __ATOMIC_RELAXED, __HIP_MEMORY_SCOPE_AGENT); if (x < myx) base += n; tot += n; }
        vcu[0] = (tot == (int)gridDim.x) ? base + vcu[1] : (int)blockIdx.x;
    }
    __syncthreads();
    layer_fwd<0>(ka, lds);
    grid_bar(p, lds);
    layer_fwd<1>(ka, lds);
}

extern "C" void kernel_launch(void* const* d_in, const int* in_sizes, int n_in, void* d_out, int out_size, void* d_ws, size_t ws_size, hipStream_t stream) {
    KArgs ka{};
    for (int i = 0; i < 18; ++i) ka.in[i] = (const float*)d_in[i];
    ka.out = (float*)d_out; ka.ws = (char*)d_ws;
    if (WSL::total > ws_size) { fprintf(stderr, "workspace too small: need %zu have %zu\n", (size_t)WSL::total, ws_size); return; }
    static int grid_blocks = 0;
    if (!grid_blocks) {
        int dev = 0, cus = 0, per_cu = 0;
        (void)hipGetDevice(&dev);
        (void)hipDeviceGetAttribute(&cus, hipDeviceAttributeMultiprocessorCount, dev);
        (void)hipFuncSetAttribute((const void*)fwd_kernel, hipFuncAttributeMaxDynamicSharedMemorySize, LDS_BYTES);
        (void)hipOccupancyMaxActiveBlocksPerMultiprocessor(&per_cu, fwd_kernel, NTHR, LDS_BYTES);
        if (per_cu < 1) { fprintf(stderr, "occupancy query says 0 blocks per CU\n"); per_cu = 1; }
        grid_blocks = cus;
    }
    (void)hipMemsetAsync(d_ws, 0, 65536, stream);
    void* args[] = {&ka};
    hipError_t e = hipLaunchCooperativeKernel((const void*)fwd_kernel, dim3(grid_blocks), dim3(NTHR), args, LDS_BYTES, stream);
    if (e != hipSuccess) fprintf(stderr, "cooperative launch failed: %s (grid %d)\n", hipGetErrorString(e), grid_blocks);
}
```

```cpp
#include <hip/hip_runtime.h>
#include <hip/hip_cooperative_groups.h>
#include <cstdio>
#include <cstdint>
namespace cg = cooperative_groups;

typedef unsigned short bf16_t;
typedef short bf16x8 __attribute__((ext_vector_type(8)));
typedef float f32x4 __attribute__((ext_vector_type(4)));
typedef unsigned u32x4 __attribute__((ext_vector_type(4)));
typedef unsigned u32x2 __attribute__((ext_vector_type(2)));
typedef int v8i_t __attribute__((ext_vector_type(8)));
typedef float f32x2_t __attribute__((ext_vector_type(2)));
typedef int v4i_t __attribute__((ext_vector_type(4)));
#define LAS __attribute__((address_space(3)))
constexpr float NEG_INF = -__builtin_huge_valf();

constexpr int DM = 1024, NB = 16, SEQ = 2048, NTOK = NB * SEQ, NL = 2;
constexpr int NCOL = 2582, NMAIN = 2560, NPAD = 2688, NE = 32, DFF = 1024;
constexpr int C_FQ = 0, C_FK = 256, C_FV = 512, C_SQ = 768, C_SK = 1152, C_SV = 1280, C_NQ = 1408,
              C_NKC = 1792, C_NVC = 1920, C_NKS = 2048, C_NVS = 2176, C_NKW = 2304, C_NVW = 2432;
constexpr int HS_W = 32;
constexpr int NVH = 10;
constexpr int LIST_CAP = NTOK;
constexpr int MAXSLOT = NTOK * 4 + NE * 256;
constexpr float ALPHA = 1.41421356237f, LN_EPS = 1e-5f, QSCALE = 0.125f;
constexpr float GATE_PRE = -2.455466929f;
constexpr int NWV = 8, NTHR = NWV * 64;
constexpr int LDS_STAGE = 131072, LDS_TAB = LDS_STAGE, LDS_AOFF = LDS_STAGE + 2048, LDS_BIAS = LDS_AOFF + 20480, LDS_BYTES = LDS_BIAS + 3072 + 256;

struct Params {
    const float *x, *w_in, *b_in, *sinks, *cmp_pe, *cmp_w1, *cmp_w2, *w_out, *ln1_g, *ln1_b, *router_w, *router_b,
                *w_gu, *b_gu, *w_dn, *b_dn, *ln2_g, *ln2_b;
    float* out;
    unsigned* ctrl;
    bf16_t *WinT, *WoT, *W1T, *W2T, *WguT, *WdnT;
    float *rwT, *binp, *bgup, *b1c;
    unsigned char* xq; unsigned char* WinQ;
    float* xf; bf16_t* xb; bf16_t* hb; float* hs; bf16_t* vT; bf16_t* kF; float* cF;
    bf16_t *kc, *vc, *vcT; bf16_t* ob; float* tbuf; float* x1f; bf16_t* x1b;
    int* top_e; float* gw; int* lists; bf16_t* act; bf16_t* ybuf;
};

__device__ __forceinline__ float bf2f(bf16_t h) { return __uint_as_float(((unsigned)h) << 16); }
typedef __bf16 bf16x2_t __attribute__((ext_vector_type(2)));
__device__ __forceinline__ bf16_t f2bf(float f) { return __builtin_bit_cast(bf16_t, (__bf16)f); }
__device__ __forceinline__ unsigned pack2(float lo, float hi) { bf16x2_t v = {(__bf16)lo, (__bf16)hi}; return __builtin_bit_cast(unsigned, v); }
__device__ __forceinline__ unsigned pack4_fp8(float a, float b, float c, float d) {
    unsigned w = 0u;
    w = __builtin_amdgcn_cvt_pk_fp8_f32(a, b, w, false);
    w = __builtin_amdgcn_cvt_pk_fp8_f32(c, d, w, true);
    return w;
}
__device__ __forceinline__ float shfl_f(float v, int src_lane) { return __int_as_float(__builtin_amdgcn_ds_bpermute(src_lane << 2, __float_as_int(v))); }
__device__ __forceinline__ unsigned shfl_u(unsigned v, int src_lane) { return (unsigned)__builtin_amdgcn_ds_bpermute(src_lane << 2, (int)v); }
__device__ __forceinline__ float wave_sum(float v) {
#pragma unroll
    for (int o = 32; o > 0; o >>= 1) v += __shfl_xor(v, o);
    return v;
}
__device__ __forceinline__ float wave_max(float v) {
#pragma unroll
    for (int o = 32; o > 0; o >>= 1) v = fmaxf(v, __shfl_xor(v, o));
    return v;
}
__device__ __forceinline__ void lds_wave_sync() { asm volatile("s_waitcnt lgkmcnt(0)" ::: "memory"); __builtin_amdgcn_wave_barrier(); }
__device__ __forceinline__ float slope_swa(int hq) { return exp2f(-8.0f * (float)(2 * hq + 1) / 12.0f); }
__device__ __forceinline__ float slope_nsa(int hq) { return exp2f(-8.0f * (float)(2 * hq + 2) / 12.0f); }

__device__ __forceinline__ int fwd128(int L) { return (L & ~31) | (((L >> 2) & 1) << 4) | (((L >> 3) & 3) << 2) | (L & 3); }
__device__ __forceinline__ int inv128(int p) { return (p & ~31) | (((p >> 2) & 3) << 3) | (((p >> 4) & 1) << 2) | (p & 3); }
__device__ __forceinline__ int fwd256(int L) { return (L & ~255) | (((L >> 3) & 1) << 7) | (((L >> 6) & 3) << 5) | (((L >> 2) & 1) << 4) | (((L >> 4) & 3) << 2) | (L & 3); }
__device__ __forceinline__ int perm_row(int perm, int n) {
    if (perm == 1) { int r; if (n < 768) r = n; else if (n < 772) r = 2560 + (n - 768); else if (n < 2564) r = n - 4; else r = n; return r < 2560 ? fwd128(r) : r; }
    if (perm == 2) { const int f = n >> 1, s = n & 1; return (f >> 7) * 256 + s * 128 + fwd128(f & 127); }
    if (perm == 3) return fwd256(n);
    return n;
}
struct ConvJob { const float* src; bf16_t* dst; int K, N, kt, nt, perm; float q8; };
__device__ __forceinline__ bool conv_job(const Params& p, int t, ConvJob& jb) {
    constexpr int T_WIN = NL * 8 * 21, T_WO = NL * 8 * 8;
    if (t < T_WIN) { const int m = t / 168, r = t % 168; jb = ConvJob{p.w_in + (size_t)m * 1024 * NCOL, p.WinT + (size_t)m * NPAD * 1024, 1024, NCOL, r / 21, r % 21, 1, 0.f}; return true; }
    t -= T_WIN;
    if (t < T_WO) { const int m = t / 64, r = t % 64; jb = ConvJob{p.w_out + (size_t)m * 1024 * 1024, (bf16_t*)((char*)p.WoT + (size_t)m * 1024 * 1024), 1024, 1024, r / 8, r % 8, 3, 64.0f}; return true; }
    t -= T_WO;
    if (t < T_WIN) { const int m = t / 168, r = t % 168; jb = ConvJob{p.w_in + (size_t)m * 1024 * NCOL, (bf16_t*)(p.WinQ + (size_t)m * NMAIN * 1024), 1024, NCOL, r / 21, r % 21, 1, 64.0f}; return true; }
    return false;
}
constexpr int CONV_TILES = NL * NE * 192;
__device__ __forceinline__ void conv_tile_wave(const Params& p, int t, int lane, unsigned char* l8) {
    asm volatile("" : "+v"(lane));
    const int m = t / 192, r = t % 192;
    const float* src; unsigned char* dst; int N, kt, nt, perm;
    if (r < 128) { src = p.w_gu + (size_t)m * 1024 * 2048; dst = (unsigned char*)p.WguT + (size_t)m * 2048 * 1024; N = 2048; kt = r >> 4; nt = r & 15; perm = 2; }
    else { const int q = r - 128; src = p.w_dn + (size_t)m * 1024 * 1024; dst = (unsigned char*)p.WdnT + (size_t)m * 1024 * 1024; N = 1024; kt = q >> 3; nt = q & 7; perm = 3; }
    const float* s = src + (size_t)(kt * 128 + (lane >> 5)) * N + nt * 128 + (lane & 31) * 4;
    unsigned char* lw = l8 + (lane >> 5) * 132 + (lane & 31) * 4;
    const float sg = (perm == 2) ? 64.0f * GATE_PRE : 64.0f;
    float4 va[16], vb[16];
#pragma unroll
    for (int i = 0; i < 16; ++i) va[i] = *(const float4*)(s + (size_t)(2 * i) * N);
#pragma unroll
    for (int i = 0; i < 16; ++i) vb[i] = *(const float4*)(s + (size_t)(32 + 2 * i) * N);
#pragma unroll
    for (int i = 0; i < 16; ++i) *(unsigned*)(lw + (2 * i) * 132) = pack4_fp8(va[i].x * sg, va[i].y * 64.0f, va[i].z * sg, va[i].w * 64.0f);
#pragma unroll
    for (int i = 0; i < 16; ++i) va[i] = *(const float4*)(s + (size_t)(64 + 2 * i) * N);
#pragma unroll
    for (int i = 0; i < 16; ++i) *(unsigned*)(lw + (32 + 2 * i) * 132) = pack4_fp8(vb[i].x * sg, vb[i].y * 64.0f, vb[i].z * sg, vb[i].w * 64.0f);
#pragma unroll
    for (int i = 0; i < 16; ++i) vb[i] = *(const float4*)(s + (size_t)(96 + 2 * i) * N);
#pragma unroll
    for (int i = 0; i < 16; ++i) *(unsigned*)(lw + (64 + 2 * i) * 132) = pack4_fp8(va[i].x * sg, va[i].y * 64.0f, va[i].z * sg, va[i].w * 64.0f);
#pragma unroll
    for (int i = 0; i < 16; ++i) *(unsigned*)(lw + (96 + 2 * i) * 132) = pack4_fp8(vb[i].x * sg, vb[i].y * 64.0f, vb[i].z * sg, vb[i].w * 64.0f);
    lds_wave_sync();
#pragma unroll 4
    for (int i = 0; i < 16; ++i) {
        const int idx = lane + 64 * i, kc = idx & 7, nn = idx >> 3;
        const unsigned char* l = l8 + (kc * 16) * 132 + nn;
        u32x4 w;
        w.x = (unsigned)l[0] | ((unsigned)l[132] << 8) | ((unsigned)l[264] << 16) | ((unsigned)l[396] << 24);
        w.y = (unsigned)l[528] | ((unsigned)l[660] << 8) | ((unsigned)l[792] << 16) | ((unsigned)l[924] << 24);
        w.z = (unsigned)l[1056] | ((unsigned)l[1188] << 8) | ((unsigned)l[1320] << 16) | ((unsigned)l[1452] << 24);
        w.w = (unsigned)l[1584] | ((unsigned)l[1716] << 8) | ((unsigned)l[1848] << 16) | ((unsigned)l[1980] << 24);
        *(u32x4*)(dst + (size_t)perm_row(perm, nt * 128 + nn) * 1024 + kt * 128 + kc * 16) = w;
    }
    lds_wave_sync();
}
__device__ __forceinline__ void conv_load(const ConvJob& jb, int tid, float2 (&v)[16]) {
    const int n = jb.nt * 128 + (tid & 31) * 4;
    const float* s = jb.src + (size_t)(jb.kt * 128 + (tid >> 5)) * jb.N + n;
#pragma unroll
    for (int i = 0; i < 8; ++i) {
        const float* r = s + (size_t)(16 * i) * jb.N;
        v[2 * i] = (n + 1 < jb.N) ? *(const float2*)r : make_float2(0.f, 0.f);
        v[2 * i + 1] = (n + 3 < jb.N) ? *(const float2*)(r + 2) : make_float2(0.f, 0.f);
    }
}
__device__ __forceinline__ void phase0(const Params& p, char* ldsc) {
    int tid = threadIdx.x; asm volatile("" : "+v"(tid));
    const int G = gridDim.x, bid = blockIdx.x;
    const size_t gtid = (size_t)bid * NTHR + tid, gthreads = (size_t)G * NTHR;
    {
        constexpr int TOT = 2 * NL * 8 * 21 + NL * 8 * 8;
        bf16_t* lt = (bf16_t*)ldsc;
        ConvJob jb, jn; float2 v[16], vn[16];
        int t = bid; bool have = t < TOT && conv_job(p, t, jb);
        if (have) conv_load(jb, tid, v);
        while (have) {
            const int tn = t + G; const bool hn = tn < TOT && conv_job(p, tn, jn);
            if (hn) conv_load(jn, tid, vn);
            if (jb.q8 != 0.f) {
                unsigned char* l8 = (unsigned char*)lt;
#pragma unroll
                for (int i = 0; i < 8; ++i)
                {   int kl = (tid >> 5) + 16 * i;
                    if (jb.perm == 3) kl = (kl & 64) | (((kl >> 2) & 3) << 4) | (((kl >> 4) & 3) << 2) | (kl & 3);
                    *(unsigned*)(l8 + kl * 132 + (tid & 31) * 4) = pack4_fp8(v[2 * i].x * jb.q8, v[2 * i].y * jb.q8, v[2 * i + 1].x * jb.q8, v[2 * i + 1].y * jb.q8); }
                __syncthreads();
#pragma unroll
                for (int i = 0; i < 2; ++i) {
                    const int idx = tid + NTHR * i, kc = idx & 7, nn = idx >> 3, n = jb.nt * 128 + nn;
                    const unsigned char* l = l8 + (kc * 16) * 132 + nn;
                    u32x4 w;
                    w.x = (unsigned)l[0] | ((unsigned)l[132] << 8) | ((unsigned)l[264] << 16) | ((unsigned)l[396] << 24);
                    w.y = (unsigned)l[528] | ((unsigned)l[660] << 8) | ((unsigned)l[792] << 16) | ((unsigned)l[924] << 24);
                    w.z = (unsigned)l[1056] | ((unsigned)l[1188] << 8) | ((unsigned)l[1320] << 16) | ((unsigned)l[1452] << 24);
                    w.w = (unsigned)l[1584] | ((unsigned)l[1716] << 8) | ((unsigned)l[1848] << 16) | ((unsigned)l[1980] << 24);
                    const int pr = perm_row(jb.perm, n);
                    if (n < jb.N && !(jb.perm == 1 && pr >= NMAIN)) *(u32x4*)((char*)jb.dst + (size_t)pr * jb.K + jb.kt * 128 + kc * 16) = w;
                }
            } else {
#pragma unroll
                for (int i = 0; i < 8; ++i) {
                    u32x2 w; w.x = pack2(v[2 * i].x, v[2 * i].y); w.y = pack2(v[2 * i + 1].x, v[2 * i + 1].y);
                    *(u32x2*)(lt + ((tid >> 5) + 16 * i) * 136 + (tid & 31) * 4) = w;
                }
                __syncthreads();
#pragma unroll
                for (int i = 0; i < 4; ++i) {
                    const int idx = tid + NTHR * i, kc = idx & 15, nn = idx >> 4, n = jb.nt * 128 + nn;
                    if (n < jb.N) {
                        const bf16_t* l = lt + (kc * 8) * 136 + nn;
                        u32x4 w;
                        w.x = (unsigned)l[0] | ((unsigned)l[136] << 16); w.y = (unsigned)l[272] | ((unsigned)l[408] << 16);
                        w.z = (unsigned)l[544] | ((unsigned)l[680] << 16); w.w = (unsigned)l[816] | ((unsigned)l[952] << 16);
                        *(u32x4*)(jb.dst + (size_t)perm_row(jb.perm, n) * jb.K + jb.kt * 128 + kc * 8) = w;
                    }
                }
            }
            __syncthreads();
            t = tn; have = hn; jb = jn;
#pragma unroll
            for (int i = 0; i < 16; ++i) v[i] = vn[i];
        }
    }
    for (size_t i = gtid; i < (size_t)NL * 2 * 2048 * 64; i += gthreads) {
        const int k = (int)(i % 2048), n = (int)((i / 2048) % 64), m = (int)(i / (2048 * 64));
        p.W1T[i] = f2bf(p.cmp_w1[((size_t)m * 2048 + k) * 64 + n]);
    }
    for (size_t i = gtid; i < (size_t)NL * 2 * 64 * 64; i += gthreads) {
        const int k = (int)(i % 64), n = (int)((i / 64) % 64), m = (int)(i / 4096);
        p.W2T[i] = f2bf(p.cmp_w2[((size_t)m * 64 + k) * 64 + n]);
    }
    for (size_t i = gtid; i < (size_t)NL * NPAD; i += gthreads) {
        const int l = (int)(i / NPAD), ri = (int)(i % NPAD), r = ri < 2560 ? inv128(ri) : ri;
        float v = 0.f;
        if (r < 2560) { const int n = r < 768 ? r : r + 4; v = p.b_in[l * NCOL + n]; }
        else if (r < 2564) v = p.b_in[l * NCOL + 768 + (r - 2560)];
        else if (r < 2582) v = p.b_in[l * NCOL + r];
        p.binp[i] = v;
    }
    for (size_t i = gtid; i < (size_t)NL * NE * 2048; i += gthreads) {
        const int r = (int)(i % 2048); const size_t le = i / 2048;
        const int s = (r >> 7) & 1, f = (r >> 8) * 128 + inv128(r & 127);
        p.bgup[i] = p.b_gu[le * 2048 + 2 * f + s] * (s == 0 ? GATE_PRE : 1.0f);
    }
    for (size_t i = gtid; i < (size_t)NL * NE * 1024; i += gthreads) {
        const int k = (int)(i % 1024), e = (int)((i / 1024) % NE), l = (int)(i / (1024 * NE));
        p.rwT[i] = p.router_w[((size_t)l * 1024 + k) * NE + e];
    }
    for (size_t i = gtid; i < (size_t)NL * (NPAD - NCOL) * 1024; i += gthreads) {
        const int l = (int)(i / ((NPAD - NCOL) * 1024)); const size_t r = i % ((size_t)(NPAD - NCOL) * 1024);
        p.WinT[(size_t)l * NPAD * 1024 + (size_t)NCOL * 1024 + r] = 0;
    }
    for (size_t i = gtid; i < (size_t)NTOK * DM / 4; i += gthreads) {
        const float4 v4 = ((const float4*)p.x)[i];
        u32x2 w; w.x = pack2(v4.x, v4.y); w.y = pack2(v4.z, v4.w);
        ((u32x2*)p.xb)[i] = w;
        ((unsigned*)p.xq)[i] = pack4_fp8(v4.x, v4.y, v4.z, v4.w);
    }
    if (bid < 4) {
        float* lf = (float*)ldsc;
        const int j = tid & 63, part = tid >> 6;
        const float* pe = p.cmp_pe + (size_t)bid * 2048; const float* w1 = p.cmp_w1 + (size_t)bid * 2048 * 64;
        float s = 0.f;
        for (int kk = part * 256; kk < part * 256 + 256; ++kk) s += pe[kk] * w1[(size_t)kk * 64 + j];
        lf[tid] = s; __syncthreads();
        if (tid < 64) { float a = 0.f; for (int q = 0; q < 8; ++q) a += lf[tid + 64 * q]; p.b1c[bid * 64 + tid] = a; }
        __syncthreads();
    }
}

__device__ __forceinline__ int vcu_id() { return __builtin_amdgcn_readfirstlane(*(const volatile LAS int*)(LDS_BYTES - 32)); }
namespace pg8 {
constexpr int BM = 256, BK = 64, HALF = 128, HTB = HALF * BK * 2, NXCD = 8, WGM = 8;
__device__ __forceinline__ int lds_byte(int r, int c) { const int ch = (c >> 3) ^ ((r >> 1) & 7); return (r >> 3) * 1024 + (r & 7) * 128 + ch * 16 + (c & 7) * 2; }
__device__ __forceinline__ void stage_rc(int b, int& R, int& C) { const int st = b / 1024, sb = b % 1024; R = st * 8 + sb / 128; C = ((((sb % 128) / 16) ^ ((R >> 1) & 7)) * 16 + (sb % 16)) / 2; }
__device__ __forceinline__ bool tile_order(int i, int G, int c, int nM, int nN, int& pm, int& pn) {
    const int nwg = nM * nN; const long L = (long)i * G + c; if (L >= nwg) return false;
    const int wgid = (int)L;
    const int nig = WGM * nN, gid = wgid / nig, fm = gid * WGM, gsz = (nM - fm) < WGM ? (nM - fm) : WGM;
    pm = fm + ((wgid % nig) % gsz); pn = (wgid % nig) / gsz; return true;
}
template <bool FP8, int SCA, class Sched, class Epi>
__device__ __forceinline__ void gemm_phase(LAS unsigned char* lds, const char* Abase, int K, const Sched& S, const Epi& E) {
    int tid = threadIdx.x; asm volatile("" : "+v"(tid));
    const int wid = __builtin_amdgcn_readfirstlane(tid >> 6), lane = tid & 63, wr = wid >> 2, wc = wid & 3, fr = lane & 15, fq = lane >> 4;
    const int nt = K / BK;
    int R0, C0, R1, C1; stage_rc(tid * 16, R0, C0); stage_rc(tid * 16 + 8192, R1, C1);
    LAS unsigned* aofs = (LAS unsigned*)(lds + LDS_AOFF) + tid;
    unsigned rg[10];
    rg[8] = (unsigned)(R0 * K + C0) * 2u; rg[9] = (unsigned)(R1 * K + C1) * 2u;
    if constexpr (FP8) { aofs[8 * NTHR] = rg[8]; aofs[9 * NTHR] = rg[9]; }
    const size_t kstep = (size_t)(BK * 2), hstep = (size_t)HALF * K * 2;
    const unsigned ldsw = (unsigned)wid * 1024u;
    const int aoff = lds_byte(wr * 64 + fr, fq * 8), boff = lds_byte(wc * 32 + fr, fq * 8);
#define PG8_SA(b, h) (((b) * 2 + (h)) * HTB)
#define PG8_SB(b, h) ((4 + (b) * 2 + (h)) * HTB)
#define PG8_OFS(sel, j) (FP8 ? aofs[((sel) * 4 + (j)) * NTHR] : ((sel) ? rg[4 + (j)] : rg[(j)]))
#define PG8_STAGE_B(bufoff, gbase) do { _Pragma("unroll") for (int _i = 0; _i < 2; ++_i) { const unsigned ob_ = FP8 ? aofs[(8 + _i) * NTHR] : rg[8 + _i]; \
        __builtin_amdgcn_global_load_lds((const unsigned*)((const char*)(gbase) + ob_), (LAS unsigned*)(lds + (bufoff) + ldsw + _i * 8192), 16, 0, 0); } } while (0)
#define PG8_STAGE_A(bufoff, kbyte, sel, h) do { const unsigned o0_ = PG8_OFS(sel, (h) * 2), o1_ = PG8_OFS(sel, (h) * 2 + 1); \
        __builtin_amdgcn_global_load_lds((const unsigned*)(Abase + (kbyte) + o0_), (LAS unsigned*)(lds + (bufoff) + ldsw), 16, 0, 0); \
        __builtin_amdgcn_global_load_lds((const unsigned*)(Abase + (kbyte) + o1_), (LAS unsigned*)(lds + (bufoff) + ldsw + 8192), 16, 0, 0); } while (0)
#define PG8_LDA(dst, b, h) do { _Pragma("unroll") for (int m = 0; m < 4; ++m) { \
        if constexpr (FP8) { const v4i_t lo_ = *(const LAS v4i_t*)(lds + PG8_SA(b, h) + aoff + m * 2048), hi_ = *(const LAS v4i_t*)(lds + PG8_SA(b, h) + (aoff ^ 64) + m * 2048); dst##8[m] = __builtin_shufflevector(lo_, hi_, 0, 1, 2, 3, 4, 5, 6, 7); } \
        else { _Pragma("unroll") for (int k = 0; k < 2; ++k) dst[m][k] = *(const LAS bf16x8*)(lds + PG8_SA(b, h) + (aoff ^ (k * 64)) + m * 2048); } } } while (0)
#define PG8_LDB(dst, b, h) do { _Pragma("unroll") for (int n = 0; n < 2; ++n) { \
        if constexpr (FP8) { const v4i_t lo_ = *(const LAS v4i_t*)(lds + PG8_SB(b, h) + boff + n * 2048), hi_ = *(const LAS v4i_t*)(lds + PG8_SB(b, h) + (boff ^ 64) + n * 2048); dst##8[n] = __builtin_shufflevector(lo_, hi_, 0, 1, 2, 3, 4, 5, 6, 7); } \
        else { _Pragma("unroll") for (int k = 0; k < 2; ++k) dst[n][k] = *(const LAS bf16x8*)(lds + PG8_SB(b, h) + (boff ^ (k * 64)) + n * 2048); } } } while (0)
#define PG8_MMA(ai, bj, At, Bt) do { __builtin_amdgcn_s_setprio(1); _Pragma("unroll") for (int m = 0; m < 4; ++m) _Pragma("unroll") for (int n = 0; n < 2; ++n) { \
        if constexpr (FP8) { acc[ai][bj][m][n] = __builtin_amdgcn_mfma_scale_f32_16x16x128_f8f6f4(Bt##8[n], At##8[m], acc[ai][bj][m][n], 0, 0, 0, SCA, 0, SCA); } \
        else { _Pragma("unroll") for (int k = 0; k < 2; ++k) acc[ai][bj][m][n] = __builtin_amdgcn_mfma_f32_16x16x32_bf16(Bt[n][k], At[m][k], acc[ai][bj][m][n], 0, 0, 0); } } \
        __builtin_amdgcn_s_setprio(0); } while (0)
#define PG8_WAIT_V(n) asm volatile("s_waitcnt vmcnt(" #n ")" ::: "memory")
#define PG8_WAIT_L(n) asm volatile("s_waitcnt lgkmcnt(" #n ")" ::: "memory")
#define PG8_BAR __builtin_amdgcn_s_barrier()
#define PG8_SCHED __builtin_amdgcn_sched_barrier(0)
    typename Sched::Unit cur, nxt; int ui = 0;
    if (!S.next(0, cur)) return;
    f32x4 acc[2][2][4][2];
    bf16x8 At[4][2], B0[2][2], B1[2][2];
    v8i_t At8[4], B08[2], B18[2];
    { unsigned a4[2][2]; S.a_off(cur, R0, C0, R1, C1, a4); rg[0] = a4[0][0]; rg[1] = a4[0][1]; rg[2] = a4[1][0]; rg[3] = a4[1][1];
      if constexpr (FP8) { aofs[0] = a4[0][0]; aofs[NTHR] = a4[0][1]; aofs[2 * NTHR] = a4[1][0]; aofs[3 * NTHR] = a4[1][1]; } }
    const char* cB = S.b_ptr(cur);
#define PG8_BIAS_DMA(unit, slot) do { const float* bp_ = E.bias_ptr(unit); int tb_ = threadIdx.x; asm volatile("" : "+v"(tb_)); if (wr == 0 && bp_ != nullptr) \
        __builtin_amdgcn_global_load_lds((const unsigned*)(bp_ + (tb_ & 255)), (LAS unsigned*)(lds + LDS_BIAS + (slot) * 1024 + wid * 256), 4, 0, 0); } while (0)
    PG8_BIAS_DMA(cur, 0);
    PG8_STAGE_B(PG8_SB(0, 0), cB); PG8_STAGE_B(PG8_SB(0, 1), cB + hstep); PG8_STAGE_A(PG8_SA(0, 0), 0, 0, 0); PG8_STAGE_A(PG8_SA(0, 1), 0, 0, 1);
    if (wr == 1) PG8_BAR;
    PG8_WAIT_V(2); PG8_BAR;
    PG8_STAGE_B(PG8_SB(1, 0), cB + kstep); PG8_STAGE_A(PG8_SA(1, 0), kstep, 0, 0); PG8_STAGE_B(PG8_SB(1, 1), cB + hstep + kstep);
    PG8_WAIT_V(6); PG8_BAR;
    { int t3 = threadIdx.x; asm volatile("" : "+v"(t3)); E.init(acc, wc, (t3 & 63) >> 4, (const LAS float*)(lds + LDS_BIAS)); }
    for (;;) {
        const bool has_next = S.next(ui + 1, nxt);
        const char* nB = cB;
        if (has_next) PG8_BIAS_DMA(nxt, (ui + 1) % 3);
        if (has_next) { int t2 = threadIdx.x; asm volatile("" : "+v"(t2)); int r0, c0, r1, c1; stage_rc(t2 * 16, r0, c0); stage_rc(t2 * 16 + 8192, r1, c1); nB = S.b_ptr(nxt);
            if constexpr (Sched::LIST_DMA) { static_assert(!Sched::LIST_DMA || FP8, "list DMA lands in the LDS offset slots"); S.a_dma(nxt, r0, r1, (LAS unsigned*)(lds + LDS_AOFF + 4 * NTHR * 4 + wid * 256)); }
            else { unsigned a4[2][2]; S.a_off(nxt, r0, c0, r1, c1, a4);
                rg[4] = a4[0][0]; rg[5] = a4[0][1]; rg[6] = a4[1][0]; rg[7] = a4[1][1];
                if constexpr (FP8) { aofs[4 * NTHR] = a4[0][0]; aofs[5 * NTHR] = a4[0][1]; aofs[6 * NTHR] = a4[1][0]; aofs[7 * NTHR] = a4[1][1]; } } }
        else { rg[4] = rg[0]; rg[5] = rg[1]; rg[6] = rg[2]; rg[7] = rg[3];
            if constexpr (FP8) { aofs[4 * NTHR] = aofs[0]; aofs[5 * NTHR] = aofs[NTHR]; aofs[6 * NTHR] = aofs[2 * NTHR]; aofs[7 * NTHR] = aofs[3 * NTHR]; } }
#pragma unroll 1
        for (int t = 0; t < nt; t += 2) {
            const bool last = (t == nt - 2);
            const size_t ka1 = (size_t)(t + 1) * kstep, ka2 = last ? 0 : (size_t)(t + 2) * kstep, ka3 = ka2 + kstep;
            const char* b2 = last ? nB : cB + (size_t)(t + 2) * kstep; const char* b3 = b2 + kstep;
            const int sel = last ? 1 : 0;
            if constexpr (Sched::LIST_DMA) if (last && has_next) {
                int t4 = threadIdx.x; asm volatile("" : "+v"(t4)); int r0, c0, r1, c1; stage_rc(t4 * 16, r0, c0); stage_rc(t4 * 16 + 8192, r1, c1);
#pragma unroll
                for (int j = 0; j < 4; ++j) aofs[(4 + j) * NTHR] = S.a_fin(aofs[(4 + j) * NTHR], (j & 1) ? c1 : c0);
            }
            PG8_LDB(B0, 0, 0); PG8_LDB(B1, 0, 1); PG8_SCHED; PG8_LDA(At, 0, 0); PG8_STAGE_A(PG8_SA(1, 1), ka1, 0, 1);
            PG8_WAIT_V(8); PG8_WAIT_L(0); PG8_BAR; PG8_MMA(0, 0, At, B0); PG8_MMA(0, 1, At, B1); PG8_BAR; PG8_SCHED;
            PG8_LDA(At, 0, 1); PG8_STAGE_B(PG8_SB(0, 0), b2); PG8_STAGE_B(PG8_SB(0, 1), b2 + hstep); PG8_STAGE_A(PG8_SA(0, 0), ka2, sel, 0);
            PG8_WAIT_V(8); PG8_WAIT_L(0); PG8_BAR; PG8_MMA(1, 0, At, B0); PG8_MMA(1, 1, At, B1); PG8_BAR; PG8_SCHED;
            PG8_LDB(B0, 1, 0); PG8_LDB(B1, 1, 1); PG8_SCHED; PG8_LDA(At, 1, 0); PG8_STAGE_A(PG8_SA(0, 1), ka2, sel, 1);
            PG8_WAIT_V(8); PG8_WAIT_L(0); PG8_BAR; PG8_MMA(0, 0, At, B0); PG8_MMA(0, 1, At, B1); PG8_BAR; PG8_SCHED;
            PG8_LDA(At, 1, 1); PG8_STAGE_B(PG8_SB(1, 0), b3); PG8_STAGE_B(PG8_SB(1, 1), b3 + hstep); PG8_STAGE_A(PG8_SA(1, 0), ka3, sel, 0);
            PG8_WAIT_V(8); PG8_WAIT_L(0); PG8_BAR; PG8_MMA(1, 0, At, B0); PG8_MMA(1, 1, At, B1); PG8_BAR; PG8_SCHED;
        }
        if (wr == 0) PG8_BAR;
        { int t2 = threadIdx.x; asm volatile("" : "+v"(t2)); E(acc, cur, wr, wc, t2 & 15, (t2 & 63) >> 4, (const LAS float*)(lds + LDS_BIAS + (ui % 3) * 1024)); }
        if (!has_next) break;
        { int t3 = threadIdx.x; asm volatile("" : "+v"(t3)); E.init(acc, wc, (t3 & 63) >> 4, (const LAS float*)(lds + LDS_BIAS + ((ui + 1) % 3) * 1024)); }
        cur = nxt; cB = nB; ++ui;
        rg[0] = rg[4]; rg[1] = rg[5]; rg[2] = rg[6]; rg[3] = rg[7];
        if constexpr (FP8) { aofs[0] = aofs[4 * NTHR]; aofs[NTHR] = aofs[5 * NTHR]; aofs[2 * NTHR] = aofs[6 * NTHR]; aofs[3 * NTHR] = aofs[7 * NTHR]; }
        if (wr == 1) PG8_BAR;
    }
    PG8_WAIT_V(0);
    PG8_BAR;
#undef PG8_BIAS_DMA
#undef PG8_SA
#undef PG8_SB
#undef PG8_STAGE_A
#undef PG8_OFS
#undef PG8_STAGE_B
#undef PG8_LDA
#undef PG8_LDB
#undef PG8_MMA
#undef PG8_WAIT_V
#undef PG8_WAIT_L
#undef PG8_BAR
#undef PG8_SCHED
}
}

struct DenseUnit { int pm, pn; };
struct DenseSched {
    typedef DenseUnit Unit;
    const char* Bt; int K, nM, nN, vc;
    __device__ __forceinline__ bool next(int i, Unit& u) const { return pg8::tile_order(i, gridDim.x, vc, nM, nN, u.pm, u.pn); }
    __device__ __forceinline__ void a_off(const Unit& u, int R0, int C0, int R1, int C1, unsigned (&off)[2][2]) const {
#pragma unroll
        for (int h = 0; h < 2; ++h) { off[h][0] = (unsigned)((u.pm * 256 + h * 128 + R0) * K + C0) * 2u; off[h][1] = (unsigned)((u.pm * 256 + h * 128 + R1) * K + C1) * 2u; }
    }
    __device__ __forceinline__ const char* b_ptr(const Unit& u) const { return Bt + (size_t)u.pn * 256 * K * 2; }
    static constexpr bool LIST_DMA = false;
    __device__ __forceinline__ void a_dma(const Unit&, int, int, LAS unsigned*) const {}
    __device__ __forceinline__ unsigned a_fin(unsigned raw, int) const { return raw; }
};
struct MoeUnit { int rbt, e, pn; };
template <bool GATHER>
struct MoeSched {
    typedef MoeUnit Unit;
    static constexpr int KP = 512;
    const char* Bt; const int* lists; const int* ptile; const int* ecnt; int nN, nrows, vc;
    __device__ __forceinline__ bool next(int i, Unit& u) const {
        int pm, pn; if (!pg8::tile_order(i, gridDim.x, vc, ptile[NE], nN, pm, pn)) return false;
        u.rbt = pm; u.e = ((const unsigned char*)ptile)[512 + pm]; u.pn = pn; return true;
    }
    __device__ __forceinline__ void a_off(const Unit& u, int R0, int C0, int R1, int C1, unsigned (&off)[2][2]) const {
        if (GATHER) {
            const int* lst = lists + (size_t)u.e * LIST_CAP; const int rb = u.rbt - ptile[u.e], cnt = ecnt[u.e];
#pragma unroll
            for (int h = 0; h < 2; ++h) {
                const int l0 = rb * 256 + h * 128 + R0, l1 = rb * 256 + h * 128 + R1;
                const int t0 = l0 < cnt ? (lst[l0] >> 2) : 0, t1 = l1 < cnt ? (lst[l1] >> 2) : 0;
                off[h][0] = (unsigned)(t0 * KP + C0) * 2u; off[h][1] = (unsigned)(t1 * KP + C1) * 2u;
            }
        } else {
#pragma unroll
            for (int h = 0; h < 2; ++h) { off[h][0] = (unsigned)((u.rbt * 256 + h * 128 + R0) * KP + C0) * 2u; off[h][1] = (unsigned)((u.rbt * 256 + h * 128 + R1) * KP + C1) * 2u; }
        }
    }
    __device__ __forceinline__ const char* b_ptr(const Unit& u) const { return Bt + ((size_t)u.e * nrows + (size_t)u.pn * 256) * KP * 2; }
    static constexpr bool LIST_DMA = GATHER;
    __device__ __forceinline__ void a_dma(const Unit& u, int R0, int R1, LAS unsigned* slot) const {
        const int* lst = lists + (size_t)u.e * LIST_CAP; const int rb = u.rbt - ptile[u.e], cm = ecnt[u.e] - 1;
#pragma unroll
        for (int h = 0; h < 2; ++h) {
            const int l0 = min(rb * 256 + h * 128 + R0, cm), l1 = min(rb * 256 + h * 128 + R1, cm);
            __builtin_amdgcn_global_load_lds((const unsigned*)(lst + l0), slot + (h * 2) * NTHR, 4, 0, 0);
            __builtin_amdgcn_global_load_lds((const unsigned*)(lst + l1), slot + (h * 2 + 1) * NTHR, 4, 0, 0);
        }
    }
    __device__ __forceinline__ unsigned a_fin(unsigned raw, int C) const { return (unsigned)((int)(raw >> 2) * KP + C) * 2u; }
};

__device__ __forceinline__ u32x2 quad_tr(unsigned p01, unsigned p23, int fr) {
    const unsigned sel = (fr & 1) ? 0x03020706u : 0x05040100u;
    const unsigned y01 = (unsigned)__builtin_amdgcn_update_dpp(0, (int)p01, 0xB1, 0xF, 0xF, true), y23 = (unsigned)__builtin_amdgcn_update_dpp(0, (int)p23, 0xB1, 0xF, 0xF, true);
    const unsigned q01 = __builtin_amdgcn_perm(y01, p01, sel), q23 = __builtin_amdgcn_perm(y23, p23, sel);
    const bool hi = (fr & 2) != 0;
    const unsigned snd = hi ? q01 : q23;
    const unsigned rcv = (unsigned)__builtin_amdgcn_update_dpp(0, (int)snd, 0x4E, 0xF, 0xF, true);
    u32x2 r; r.x = hi ? rcv : q01; r.y = hi ? q23 : rcv; return r;
}
struct EpiInProj {
    const Params* p; int l;
    __device__ __forceinline__ const float* bias_ptr(const DenseUnit& u) const { return p->binp + l * NPAD + u.pn * 256; }
    __device__ __forceinline__ void init(f32x4 (&acc)[2][2][4][2], int wc, int fq, const LAS float* bias) const {
#pragma unroll
        for (int bj = 0; bj < 2; ++bj)
#pragma unroll
            for (int n = 0; n < 2; ++n) {
                const f32x4 bv = *(const LAS f32x4*)(bias + bj * 128 + wc * 32 + n * 16 + 4 * fq);
#pragma unroll
                for (int ai = 0; ai < 2; ++ai)
#pragma unroll
                    for (int m = 0; m < 4; ++m) acc[ai][bj][m][n] = bv;
            }
    }
    __device__ __forceinline__ void operator()(const f32x4 (&acc)[2][2][4][2], const DenseUnit& u, int wr, int wc, int fr, int fq, const LAS float*) const {
#pragma unroll
        for (int bj = 0; bj < 2; ++bj) {
            int kind = 0, hb0 = 0;
            if (u.pn == 1) { kind = 1; hb0 = bj * 2; } else if (u.pn == 4 && bj == 1) { kind = 1; hb0 = 4; } else if (u.pn == 8 && bj == 0) { kind = 1; hb0 = 6; } else if (u.pn == 9 && bj == 0) { kind = 1; hb0 = 8; }
            else if (u.pn == 2) { kind = 2; hb0 = bj * 2; } else if (u.pn == 5 && bj == 0) { kind = 2; hb0 = 4; } else if (u.pn == 8 && bj == 1) { kind = 2; hb0 = 6; } else if (u.pn == 9 && bj == 1) { kind = 2; hb0 = 8; }
            const int c0 = wc * 32 + fq * 8;
            const int hh = hb0 + (c0 >> 6), d0 = c0 & 63;
#pragma unroll
            for (int ai = 0; ai < 2; ++ai)
#pragma unroll
                for (int m = 0; m < 4; ++m) {
                    const int row = u.pm * 256 + ai * 128 + wr * 64 + m * 16 + fr;
                    const f32x4 v0 = acc[ai][bj][m][0], v1 = acc[ai][bj][m][1];
                    u32x4 w; w.x = pack2(v0[0], v0[1]); w.y = pack2(v0[2], v0[3]); w.z = pack2(v1[0], v1[1]); w.w = pack2(v1[2], v1[3]);
                    if (kind == 0) *(u32x4*)(p->hb + (size_t)row * NMAIN + u.pn * 256 + bj * 128 + c0) = w;
                    else {
                        const int b = row >> 11, s = row & 2047, kk = s & 31;
                        bf16_t* blk = (kind == 1 ? p->kF : p->vT) + (((size_t)b * NVH + hh) * 64 + (s >> 5)) * 2048;
                        if (kind == 1) {
                            const int frk = (kk >> 3) * 4 + (kk & 3), t = (kk >> 2) & 1;
                            *(u32x4*)(blk + ((t * 2 + (d0 >> 5)) * 64 + ((d0 & 31) >> 3) * 16 + frk) * 8) = w;
                        } else {
                            const int kq = kk & 28;
                            const u32x2 t0 = quad_tr(w.x, w.y, fr), t1 = quad_tr(w.z, w.w, fr);
                            bf16_t* vt = blk + (((d0 >> 4) * 64) + (kq >> 3) * 16 + (d0 & 15) + (fr & 3)) * 8 + (kq & 7);
                            *(u32x2*)vt = t0; *(u32x2*)(vt + 32) = t1;
                        }
                    }
                }
        }
    }
};
struct EpiOutProj {
    const bf16_t* xin; float* t;
    __device__ __forceinline__ const float* bias_ptr(const DenseUnit&) const { return nullptr; }
    __device__ __forceinline__ void init(f32x4 (&acc)[2][2][4][2], int, int, const LAS float*) const {
#pragma unroll
        for (int ai = 0; ai < 2; ++ai)
#pragma unroll
            for (int bj = 0; bj < 2; ++bj)
#pragma unroll
                for (int m = 0; m < 4; ++m)
#pragma unroll
                    for (int n = 0; n < 2; ++n) acc[ai][bj][m][n] = (f32x4){0.f, 0.f, 0.f, 0.f};
    }
    __device__ __forceinline__ void operator()(const f32x4 (&acc)[2][2][4][2], const DenseUnit& u, int wr, int wc, int fr, int fq, const LAS float*) const {
#pragma unroll
        for (int ai = 0; ai < 2; ++ai)
#pragma unroll
            for (int m = 0; m < 4; ++m) {
                const size_t off = (size_t)(u.pm * 256 + ai * 128 + wr * 64 + m * 16 + fr) * DM + u.pn * 256 + wc * 64 + fq * 16;
                const u32x4 x0 = *(const u32x4*)(xin + off), x1 = *(const u32x4*)(xin + off + 8);
                const unsigned xs[8] = {x0.x, x0.y, x0.z, x0.w, x1.x, x1.y, x1.z, x1.w};
                unsigned w[8];
#pragma unroll
                for (int q = 0; q < 4; ++q) {
                    const f32x4 a = acc[ai][q >> 1][m][q & 1];
                    const float t0 = __uint_as_float(xs[2 * q] << 16) * ALPHA + a[0], t1 = __uint_as_float(xs[2 * q] & 0xffff0000u) * ALPHA + a[1];
                    const float t2 = __uint_as_float(xs[2 * q + 1] << 16) * ALPHA + a[2], t3 = __uint_as_float(xs[2 * q + 1] & 0xffff0000u) * ALPHA + a[3];
                    w[2 * q] = pack2(t0, t1); w[2 * q + 1] = pack2(t2, t3);
                }
                u32x4 w0, w1; w0.x = w[0]; w0.y = w[1]; w0.z = w[2]; w0.w = w[3]; w1.x = w[4]; w1.y = w[5]; w1.z = w[6]; w1.w = w[7];
                *(u32x4*)((bf16_t*)t + off) = w0; *(u32x4*)((bf16_t*)t + off + 8) = w1;
            }
    }
};
struct EpiGateUp {
    bf16_t* act; const float* bgup;
    __device__ __forceinline__ const float* bias_ptr(const MoeUnit& u) const { return bgup + (size_t)u.e * 2048 + u.pn * 256; }
    __device__ __forceinline__ void init(f32x4 (&acc)[2][2][4][2], int wc, int fq, const LAS float* bias) const {
#pragma unroll
        for (int bj = 0; bj < 2; ++bj)
#pragma unroll
            for (int n = 0; n < 2; ++n) {
                const f32x4 bv = *(const LAS f32x4*)(bias + bj * 128 + wc * 32 + n * 16 + 4 * fq);
#pragma unroll
                for (int ai = 0; ai < 2; ++ai)
#pragma unroll
                    for (int m = 0; m < 4; ++m) acc[ai][bj][m][n] = bv;
            }
    }
    __device__ __forceinline__ void operator()(const f32x4 (&acc)[2][2][4][2], const MoeUnit& u, int wr, int wc, int fr, int fq, const LAS float*) const {
        constexpr float GMIN = 7.0f * GATE_PRE, CI = 1.0f / GATE_PRE;
#pragma unroll
        for (int ai = 0; ai < 2; ++ai)
#pragma unroll
            for (int m = 0; m < 4; ++m) {
                u32x2 w;
#pragma unroll
                for (int n = 0; n < 2; ++n) {
                    const f32x4 g4 = acc[ai][0][m][n], u4 = acc[ai][1][m][n];
                    float o[4];
#pragma unroll
                    for (int j = 0; j < 4; ++j) {
                        const float gp = fmaxf(g4[j], GMIN), uu = fminf(fmaxf(u4[j], -7.0f), 7.0f);
                        const float glu = gp * __builtin_amdgcn_rcpf(1.0f + __builtin_amdgcn_exp2f(gp));
                        o[j] = __builtin_fmaf(uu, CI, CI) * glu;
                    }
                    const unsigned pk = pack4_fp8(o[0], o[1], o[2], o[3]);
                    if (n == 0) w.x = pk; else w.y = pk;
                }
                *(u32x2*)((char*)act + (size_t)(u.rbt * 256 + ai * 128 + wr * 64 + m * 16 + fr) * DFF + u.pn * 128 + wc * 32 + fq * 8) = w;
            }
    }
};
struct EpiDown {
    bf16_t* ybuf; const float* bdn;
    __device__ __forceinline__ const float* bias_ptr(const MoeUnit& u) const { return bdn + (size_t)u.e * 1024 + u.pn * 256; }
    __device__ __forceinline__ void init(f32x4 (&acc)[2][2][4][2], int wc, int fq, const LAS float* bias) const {
#pragma unroll
        for (int bj = 0; bj < 2; ++bj)
#pragma unroll
            for (int n = 0; n < 2; ++n) {
                const f32x4 bv = *(const LAS f32x4*)(bias + wc * 64 + fq * 16 + bj * 8 + n * 4);
#pragma unroll
                for (int ai = 0; ai < 2; ++ai)
#pragma unroll
                    for (int m = 0; m < 4; ++m) acc[ai][bj][m][n] = bv;
            }
    }
    __device__ __forceinline__ void operator()(const f32x4 (&acc)[2][2][4][2], const MoeUnit& u, int wr, int wc, int fr, int fq, const LAS float*) const {
#pragma unroll
        for (int ai = 0; ai < 2; ++ai)
#pragma unroll
            for (int m = 0; m < 4; ++m) {
                u32x4 w;
                { const f32x4 v = acc[ai][0][m][0]; w.x = pack4_fp8(v[0], v[1], v[2], v[3]); }
                { const f32x4 v = acc[ai][0][m][1]; w.y = pack4_fp8(v[0], v[1], v[2], v[3]); }
                { const f32x4 v = acc[ai][1][m][0]; w.z = pack4_fp8(v[0], v[1], v[2], v[3]); }
                { const f32x4 v = acc[ai][1][m][1]; w.w = pack4_fp8(v[0], v[1], v[2], v[3]); }
                *(u32x4*)((unsigned char*)ybuf + (size_t)(u.rbt * 256 + ai * 128 + wr * 64 + m * 16 + fr) * DM + u.pn * 256 + wc * 64 + fq * 16) = w;
            }
    }
};

__device__ __forceinline__ void phase_inproj(const Params& p, int l, char* lds) {
    DenseSched S{(const char*)p.WinQ + (size_t)l * NMAIN * 1024, 512, NTOK / 256, NMAIN / 256, vcu_id()};
    EpiInProj E{&p, l};
    pg8::gemm_phase<true, 0x7c7c7c7c>((LAS unsigned char*)lds, (const char*)p.xq, 512, S, E);
    int tid = threadIdx.x; asm volatile("" : "+v"(tid));
    const int wid = tid >> 6, lane = tid & 63, fr = lane & 15, fq = lane >> 4;
    const bf16_t* W = p.WinT + ((size_t)l * NPAD + NMAIN) * 1024;
    const float* bias = p.binp + l * NPAD + NMAIN;
    for (int u = blockIdx.x * NWV + wid; u < NTOK / 16; u += gridDim.x * NWV) {
        const bf16_t* ar = p.xb + (size_t)(u * 16 + fr) * DM + fq * 8;
        const bf16_t* w0 = W + (size_t)fr * 1024 + fq * 8; const bf16_t* w1 = W + (size_t)(16 + fr) * 1024 + fq * 8;
        f32x4 a0 = (f32x4){0.f, 0.f, 0.f, 0.f}, a1 = a0;
#pragma unroll 4
        for (int ks = 0; ks < 32; ++ks) {
            const bf16x8 a = *(const bf16x8*)(ar + ks * 32);
            a0 = __builtin_amdgcn_mfma_f32_16x16x32_bf16(a, *(const bf16x8*)(w0 + ks * 32), a0, 0, 0, 0);
            a1 = __builtin_amdgcn_mfma_f32_16x16x32_bf16(a, *(const bf16x8*)(w1 + ks * 32), a1, 0, 0, 0);
        }
#pragma unroll
        for (int r = 0; r < 4; ++r) {
            float* dst = p.hs + (size_t)(u * 16 + fq * 4 + r) * HS_W;
            dst[fr] = a0[r] + bias[fr];
            if (fr < 6) dst[16 + fr] = a1[r] + bias[16 + fr];
        }
    }
}
__device__ __forceinline__ void phase_outproj(const Params& p, int l, const bf16_t* xin, char* lds) {
    DenseSched S{(const char*)p.WoT + (size_t)l * 1024 * 1024, 512, NTOK / 256, 4, vcu_id()};
    EpiOutProj E{xin, p.tbuf};
    pg8::gemm_phase<true, 0x7c7c7c7c>((LAS unsigned char*)lds, (const char*)p.ob, 512, S, E);
}
__device__ __forceinline__ void build_tiles(const Params& p, int l, int* ptile, int* ecnt) {
    int tid = threadIdx.x; asm volatile("" : "+v"(tid));
    if (tid < NE) ecnt[tid] = (int)__hip_atomic_load(p.ctrl + 64 + l * NE + tid, __ATOMIC_RELAXED, __HIP_MEMORY_SCOPE_AGENT);
    __syncthreads();
    if (tid == 0) { int s = 0; for (int e = 0; e < NE; ++e) { ptile[e] = s; s += (ecnt[e] + 255) >> 8; } ptile[NE] = s; }
    __syncthreads();
    unsigned char* texp = (unsigned char*)ptile + 512;
    for (int t = tid; t < ptile[NE]; t += NTHR) { int e = 0; while (ptile[e + 1] <= t) ++e; texp[t] = (unsigned char)e; }
    __syncthreads();
}
__device__ __forceinline__ void phase_gateup(const Params& p, int l, char* lds) {
    int* ptile = (int*)(lds + LDS_TAB); int* ecnt = ptile + 40;
    build_tiles(p, l, ptile, ecnt);
    MoeSched<true> S{(const char*)p.WguT + (size_t)l * NE * 2048 * 1024, p.lists, ptile, ecnt, 8, 2048, vcu_id()};
    EpiGateUp E{p.act, p.bgup + (size_t)l * NE * 2048};
    pg8::gemm_phase<true, 0x7c7c7c7c>((LAS unsigned char*)lds, (const char*)p.x1b, 512, S, E);
}
__device__ __forceinline__ void phase_down(const Params& p, int l, char* lds) {
    int* ptile = (int*)(lds + LDS_TAB); int* ecnt = ptile + 40;
    build_tiles(p, l, ptile, ecnt);
    MoeSched<false> S{(const char*)p.WdnT + (size_t)l * NE * 1024 * 1024, p.lists, ptile, ecnt, 4, 1024, vcu_id()};
    EpiDown E{p.ybuf, p.b_dn + (size_t)l * NE * 1024};
    pg8::gemm_phase<true, 0x7c7c7c7c>((LAS unsigned char*)lds, (const char*)p.act, 512, S, E);
}

__device__ __forceinline__ float gelu_tanh(float x) {
    const float u = 0.7978845608028654f * (x + 0.044715f * x * x * x);
    const float e = __expf(-2.0f * fabsf(u)); const float th = (1.0f - e) / (1.0f + e);
    return 0.5f * x * (1.0f + (u < 0.f ? -th : th));
}
__device__ __forceinline__ void phase_prep(const Params& p, int l, char* lds) {
    int tid = threadIdx.x; asm volatile("" : "+v"(tid));
    const int wid = tid >> 6, lane = tid & 63, fr = lane & 15, fq = lane >> 4;
    const int gw = blockIdx.x * NWV + wid, nw = gridDim.x * NWV;
    for (int u = (int)gridDim.x - 1 - (int)blockIdx.x; u < NB * 4; u += gridDim.x) {
        const int b = u >> 2, h = u & 3;
        const float* srcp = p.hs + ((size_t)b * SEQ + tid * 4) * HS_W + h;
        float ls[4]; float tot = 0.f;
#pragma unroll
        for (int i = 0; i < 4; ++i) { const float f = srcp[(size_t)i * HS_W]; ls[i] = fminf(f, 0.f) - log1pf(__expf(-fabsf(f))); tot += ls[i]; }
        float inc = tot;
#pragma unroll
        for (int o = 1; o < 64; o <<= 1) { const float v = shfl_f(inc, lane - o); if (lane >= o) inc += v; }
        float* wtot = (float*)(lds + 65536);
        if (lane == 63) wtot[wid] = inc;
        __syncthreads();
        float base = inc - tot;
        for (int w = 0; w < wid; ++w) base += wtot[w];
        float4 o4; o4.x = base + ls[0]; o4.y = o4.x + ls[1]; o4.z = o4.y + ls[2]; o4.w = o4.z + ls[3];
        *(float4*)(p.cF + (size_t)u * SEQ + tid * 4) = o4;
        __syncthreads();
    }
    float* part = (float*)lds;
    bf16_t* h1 = (bf16_t*)(lds + 32768);
    for (int u = blockIdx.x; u < NB * 2 * 2 * 8; u += gridDim.x) {
        const int ct = u & 7, which = (u >> 3) & 1, kvh = (u >> 4) & 1, b = u >> 5;
        const int colo = (which ? C_NVC : C_NKC) + kvh * 64;
        const int c_lane = ct * 16 + fr;
        const int tokbase = min(c_lane, 126) * 16;
        const bf16_t* arow = p.hb + ((size_t)b * SEQ + tokbase) * NMAIN + colo + fq * 8;
        const bf16_t* w1 = p.W1T + ((size_t)(l * 2 + which) * 64 + fr) * 2048 + fq * 8;
        f32x4 acc[4];
#pragma unroll
        for (int n = 0; n < 4; ++n) acc[n] = (f32x4){0.f, 0.f, 0.f, 0.f};
#pragma unroll
        for (int kk = 0; kk < 8; ++kk) {
            const int ks = wid * 8 + kk;
            const bf16x8 a = *(const bf16x8*)(arow + (size_t)(ks >> 1) * NMAIN + (ks & 1) * 32);
#pragma unroll
            for (int n = 0; n < 4; ++n) {
                const bf16x8 bb = *(const bf16x8*)(w1 + (size_t)n * 16 * 2048 + ks * 32);
                acc[n] = __builtin_amdgcn_mfma_f32_16x16x32_bf16(a, bb, acc[n], 0, 0, 0);
            }
        }
#pragma unroll
        for (int n = 0; n < 4; ++n)
#pragma unroll
            for (int r = 0; r < 4; ++r) part[wid * 1024 + (fq * 4 + r) * 64 + n * 16 + fr] = acc[n][r];
        __syncthreads();
        const float* b1 = p.b1c + (l * 2 + which) * 64;
#pragma unroll
        for (int i = 0; i < 2; ++i) {
            const int e = tid + NTHR * i; float sum = 0.f;
#pragma unroll
            for (int w = 0; w < 8; ++w) sum += part[w * 1024 + e];
            h1[e] = f2bf(gelu_tanh(sum + b1[e & 63]));
        }
        __syncthreads();
        if (wid == 0) {
            const bf16_t* w2 = p.W2T + ((size_t)(l * 2 + which) * 64 + fr) * 64 + fq * 8;
            f32x4 o2[4];
#pragma unroll
            for (int n = 0; n < 4; ++n) o2[n] = (f32x4){0.f, 0.f, 0.f, 0.f};
#pragma unroll
            for (int ks = 0; ks < 2; ++ks) {
                const bf16x8 a = *(const bf16x8*)(h1 + fr * 64 + ks * 32 + fq * 8);
#pragma unroll
                for (int n = 0; n < 4; ++n) {
                    const bf16x8 bb = *(const bf16x8*)(w2 + (size_t)n * 16 * 64 + ks * 32);
                    o2[n] = __builtin_amdgcn_mfma_f32_16x16x32_bf16(a, bb, o2[n], 0, 0, 0);
                }
            }
            const size_t base = ((size_t)b * 2 + kvh) * 128 * 64;
#pragma unroll
            for (int n = 0; n < 4; ++n)
#pragma unroll
                for (int r = 0; r < 4; ++r) {
                    const int c = ct * 16 + fq * 4 + r, j2 = n * 16 + fr;
                    const bf16_t v = c < 127 ? f2bf(o2[n][r]) : (bf16_t)0;
                    if (which == 0) p.kc[base + (size_t)c * 64 + j2] = v;
                    else { p.vc[base + (size_t)c * 64 + j2] = v; p.vcT[base + (size_t)j2 * 128 + c] = v; }
                }
        }
        __syncthreads();
    }
}

constexpr float L2E = 1.4426950408889634f, MASKV = -__builtin_huge_valf(), MINIT = -1e30f, SCL2 = QSCALE * L2E;
struct KVFrag { bf16x8 k[2][2]; bf16x8 v[4]; };
template <bool FM>
__device__ __forceinline__ void k_load(KVFrag& f, const bf16_t* __restrict__ Kb, size_t ldk, int kc0, int fr, int fq) {
    if (FM) {
        const bf16_t* kp = Kb + (size_t)(kc0 >> 5) * 2048 + (fq * 16 + fr) * 8;
        f.k[0][0] = *(const bf16x8*)(kp); f.k[0][1] = *(const bf16x8*)(kp + 512); f.k[1][0] = *(const bf16x8*)(kp + 1024); f.k[1][1] = *(const bf16x8*)(kp + 1536);
    } else {
        const bf16_t* kp = Kb + (size_t)(kc0 + (fr >> 2) * 8 + (fr & 3)) * ldk + fq * 8;
        f.k[0][0] = *(const bf16x8*)(kp); f.k[0][1] = *(const bf16x8*)(kp + 32);
        f.k[1][0] = *(const bf16x8*)(kp + 4 * ldk); f.k[1][1] = *(const bf16x8*)(kp + 4 * ldk + 32);
    }
}
template <bool FM>
__device__ __forceinline__ void v_load(bf16x8 (&v)[4], const bf16_t* __restrict__ VTb, size_t ldv, int kc0, int fr, int fq) {
    if (FM) {
        const bf16_t* vp = VTb + (size_t)(kc0 >> 5) * 2048 + (fq * 16 + fr) * 8;
#pragma unroll
        for (int dt = 0; dt < 4; ++dt) v[dt] = *(const bf16x8*)(vp + dt * 512);
    } else {
        const bf16_t* vp = VTb + (size_t)fr * ldv + kc0 + fq * 8;
#pragma unroll
        for (int dt = 0; dt < 4; ++dt) v[dt] = *(const bf16x8*)(vp + (size_t)dt * 16 * ldv);
    }
}
__device__ __forceinline__ float rowmax4(float x) {
    auto r = __builtin_amdgcn_permlane32_swap(__float_as_uint(x), __float_as_uint(x), false, false);
    x = fmaxf(__uint_as_float(r[0]), __uint_as_float(r[1]));
    auto q = __builtin_amdgcn_permlane16_swap(__float_as_uint(x), __float_as_uint(x), false, false);
    return fmaxf(__uint_as_float(q[0]), __uint_as_float(q[1]));
}
__device__ __forceinline__ float rowsum4(float x) {
    auto r = __builtin_amdgcn_permlane32_swap(__float_as_uint(x), __float_as_uint(x), false, false);
    x = __uint_as_float(r[0]) + __uint_as_float(r[1]);
    auto q = __builtin_amdgcn_permlane16_swap(__float_as_uint(x), __float_as_uint(x), false, false);
    return __uint_as_float(q[0]) + __uint_as_float(q[1]);
}
template <int NQT, bool MASK, class MB>
__device__ __forceinline__ void attn_compute(const KVFrag& f, const bf16x8 (&qf)[NQT][2], f32x4 (&o)[NQT][4], float (&m)[NQT], float (&l)[NQT], const MB& mb) {
    f32x4 s0[NQT], s1[NQT];
#pragma unroll
    for (int qt = 0; qt < NQT; ++qt) {
        s0[qt] = __builtin_amdgcn_mfma_f32_16x16x32_bf16(f.k[0][0], qf[qt][0], (f32x4){0.f, 0.f, 0.f, 0.f}, 0, 0, 0);
        s1[qt] = __builtin_amdgcn_mfma_f32_16x16x32_bf16(f.k[1][0], qf[qt][0], (f32x4){0.f, 0.f, 0.f, 0.f}, 0, 0, 0);
    }
#pragma unroll
    for (int qt = 0; qt < NQT; ++qt) {
        s0[qt] = __builtin_amdgcn_mfma_f32_16x16x32_bf16(f.k[0][1], qf[qt][1], s0[qt], 0, 0, 0);
        s1[qt] = __builtin_amdgcn_mfma_f32_16x16x32_bf16(f.k[1][1], qf[qt][1], s1[qt], 0, 0, 0);
    }
    float mx[NQT];
#pragma unroll
    for (int qt = 0; qt < NQT; ++qt) {
#pragma unroll
        for (int j = 0; j < 4; ++j) { s0[qt][j] = mb(qt, j, s0[qt][j]); s1[qt][j] = mb(qt, j + 4, s1[qt][j]); }
        mx[qt] = fmaxf(fmaxf(fmaxf(s0[qt][0], s0[qt][1]), fmaxf(s0[qt][2], s0[qt][3])), fmaxf(fmaxf(s1[qt][0], s1[qt][1]), fmaxf(s1[qt][2], s1[qt][3])));
    }
#pragma unroll
    for (int qt = 0; qt < NQT; ++qt) mx[qt] = rowmax4(mx[qt]);
    bool moved = false;
#pragma unroll
    for (int qt = 0; qt < NQT; ++qt) { mx[qt] = fmaxf(m[qt], mx[qt]); moved |= (mx[qt] != m[qt]); }
    if (__ballot(moved) != 0ull) {
#pragma unroll
        for (int qt = 0; qt < NQT; ++qt) {
            const float alpha = __builtin_amdgcn_exp2f(m[qt] - mx[qt]);
            l[qt] *= alpha;
#pragma unroll
            for (int dt = 0; dt < 4; ++dt) o[qt][dt] *= alpha;
        }
    }
    bf16x8 pf[NQT];
#pragma unroll
    for (int qt = 0; qt < NQT; ++qt) {
        m[qt] = mx[qt];
        float pr[8]; float ps = 0.f;
#pragma unroll
        for (int j = 0; j < 4; ++j) {
            pr[j] = __builtin_amdgcn_exp2f(s0[qt][j] - mx[qt]);
            pr[j + 4] = __builtin_amdgcn_exp2f(s1[qt][j] - mx[qt]);
        }
#pragma unroll
        for (int j = 0; j < 8; ++j) ps += pr[j];
        l[qt] += ps;
        const u32x4 pk = {pack2(pr[0], pr[1]), pack2(pr[2], pr[3]), pack2(pr[4], pr[5]), pack2(pr[6], pr[7])};
        pf[qt] = __builtin_bit_cast(bf16x8, pk);
    }
#pragma unroll
    for (int dt = 0; dt < 4; ++dt)
#pragma unroll
        for (int qt = 0; qt < NQT; ++qt) o[qt][dt] = __builtin_amdgcn_mfma_f32_16x16x32_bf16(f.v[dt], pf[qt], o[qt][dt], 0, 0, 0);
    __builtin_amdgcn_sched_barrier(0);
}
struct RangeIt { int c, c_hi; __device__ __forceinline__ int nxt() { if (c > c_hi) return -1; return (c++) * 32; } };
struct MaskIt { unsigned long long cm; __device__ __forceinline__ int nxt() { if (!cm) return -1; const int i = __builtin_ctzll(cm); cm &= cm - 1; return i * 32; } };
template <bool PFV, bool FM, class It, class Gen>
__device__ __forceinline__ void attn_run(It& it, const bf16_t* Kb, size_t ldk, const bf16_t* VTb, size_t ldv, int fr, int fq, const Gen& gen) {
    KVFrag fa, fb;
    int ka = it.nxt(); if (ka < 0) return;
    k_load<FM>(fa, Kb, ldk, ka, fr, fq); if (PFV) v_load<FM>(fa.v, VTb, ldv, ka, fr, fq);
    for (;;) {
        const int kb = it.nxt(); if (kb >= 0) { k_load<FM>(fb, Kb, ldk, kb, fr, fq); if (PFV) v_load<FM>(fb.v, VTb, ldv, kb, fr, fq); }
        if (!PFV) v_load<FM>(fa.v, VTb, ldv, ka, fr, fq);
        gen(ka, fa);
        if (kb < 0) break;
        ka = it.nxt(); if (ka >= 0) { k_load<FM>(fa, Kb, ldk, ka, fr, fq); if (PFV) v_load<FM>(fa.v, VTb, ldv, ka, fr, fq); }
        if (!PFV) v_load<FM>(fb.v, VTb, ldv, kb, fr, fq);
        gen(kb, fb);
        if (ka < 0) break;
    }
}
template <int NQT>
__device__ __forceinline__ void attn_init(f32x4 (&o)[NQT][4], float (&m)[NQT], float (&l)[NQT]) {
#pragma unroll
    for (int qt = 0; qt < NQT; ++qt) { m[qt] = MINIT; l[qt] = 0.f;
#pragma unroll
        for (int dt = 0; dt < 4; ++dt) o[qt][dt] = (f32x4){0.f, 0.f, 0.f, 0.f}; }
}
__device__ __forceinline__ float lsum4(float l) { return rowsum4(l); }
__device__ __forceinline__ void store_o16(unsigned char* dst, const f32x4 v0, const f32x4 v1, const f32x4 v2, const f32x4 v3) {
    u32x4 w; w.x = pack4_fp8(v0[0], v0[1], v0[2], v0[3]); w.y = pack4_fp8(v1[0], v1[1], v1[2], v1[3]); w.z = pack4_fp8(v2[0], v2[1], v2[2], v2[3]); w.w = pack4_fp8(v3[0], v3[1], v3[2], v3[3]);
    *(u32x4*)dst = w;
}
__device__ __forceinline__ float sigmoidf_fast(float x) { return __builtin_amdgcn_rcpf(1.0f + __builtin_amdgcn_exp2f(-L2E * x)); }

__device__ __forceinline__ void fox_unit(const Params& p, int b, int h, int qb, int fr, int fq) {
    asm volatile("" : "+v"(fr), "+v"(fq));
    const int t0 = qb * 64;
    const bf16_t* Qb = p.hb + ((size_t)b * SEQ + t0) * NMAIN + C_FQ + h * 64 + fq * 8;
    bf16x8 qf[4][2];
#pragma unroll
    for (int qt = 0; qt < 4; ++qt) { qf[qt][0] = *(const bf16x8*)(Qb + (size_t)(qt * 16 + fr) * NMAIN); qf[qt][1] = *(const bf16x8*)(Qb + (size_t)(qt * 16 + fr) * NMAIN + 32); }
    const float* cf = p.cF + ((size_t)b * 4 + h) * SEQ;
    float cq[4];
#pragma unroll
    for (int qt = 0; qt < 4; ++qt) cq[qt] = cf[t0 + qt * 16 + fr] * L2E;
    f32x4 o[4][4]; float m[4], l[4];
    attn_init<4>(o, m, l);
    const bf16_t* Kb = p.kF + ((size_t)b * NVH + h) * 64 * SEQ;
    const bf16_t* VTb = p.vT + ((size_t)b * NVH + h) * 64 * SEQ;
    RangeIt it{0, (t0 >> 5) + 1};
    attn_run<false, true>(it, Kb, NMAIN, VTb, SEQ, fr, fq, [&](int kc0, const KVFrag& f) {
        const float4 ca = *(const float4*)(cf + kc0 + 8 * fq), cb = *(const float4*)(cf + kc0 + 8 * fq + 4);
        const float ck[8] = {ca.x * L2E, ca.y * L2E, ca.z * L2E, ca.w * L2E, cb.x * L2E, cb.y * L2E, cb.z * L2E, cb.w * L2E};
        const int kq = kc0 + 8 * fq - t0 - fr;
        attn_compute<4, true>(f, qf, o, m, l, [&](int qt, int j, float raw) { return (kq + j - 16 * qt) > 0 ? MASKV : raw * SCL2 + cq[qt] - ck[j]; });
    });
#pragma unroll
    for (int qt = 0; qt < 4; ++qt) {
        const float inv = __builtin_amdgcn_rcpf(lsum4(l[qt]));
        unsigned char* dst = (unsigned char*)p.ob + ((size_t)b * SEQ + t0 + qt * 16 + fr) * DM + h * 64 + 16 * fq;
        store_o16(dst, o[qt][0] * inv, o[qt][1] * inv, o[qt][2] * inv, o[qt][3] * inv);
    }
}
__device__ __forceinline__ void swa_unit(const Params& p, int l_, int b, int kv, int pos, int fr, int fq) {
    asm volatile("" : "+v"(fr), "+v"(fq));
    const int t0 = pos * 16, t = t0 + fr;
    const bf16_t* Qb = p.hb + ((size_t)b * SEQ + t) * NMAIN + C_SQ + kv * 192 + fq * 8;
    bf16x8 qf[3][2];
#pragma unroll
    for (int g = 0; g < 3; ++g) { qf[g][0] = *(const bf16x8*)(Qb + g * 64); qf[g][1] = *(const bf16x8*)(Qb + g * 64 + 32); }
    float sl[3];
#pragma unroll
    for (int g = 0; g < 3; ++g) sl[g] = slope_swa(kv * 3 + g) * L2E;
    f32x4 o[3][4]; float m[3], l[3];
    attn_init<3>(o, m, l);
    const bf16_t* Kb = p.kF + ((size_t)b * NVH + 4 + kv) * 64 * SEQ;
    const bf16_t* VTb = p.vT + ((size_t)b * NVH + 4 + kv) * 64 * SEQ;
    RangeIt it{max(0, t0 - 127) >> 5, (t0 + 15) >> 5};
    attn_run<true, true>(it, Kb, NMAIN, VTb, SEQ, fr, fq, [&](int kc0, const KVFrag& f) {
        const int dq = t - kc0 - 8 * fq;
        attn_compute<3, true>(f, qf, o, m, l, [&](int g, int j, float raw) { const int dist = dq - j; return ((unsigned)dist < 128u) ? raw * SCL2 - sl[g] * (float)dist : MASKV; });
    });
#pragma unroll
    for (int g = 0; g < 3; ++g) {
        const float sink = p.sinks[l_ * 6 + kv * 3 + g] * L2E;
        const float inv = __builtin_amdgcn_rcpf(lsum4(l[g]) + __builtin_amdgcn_exp2f(sink - m[g]));
        unsigned char* dst = (unsigned char*)p.ob + ((size_t)b * SEQ + t) * DM + 256 + (kv * 3 + g) * 64 + 16 * fq;
        store_o16(dst, o[g][0] * inv, o[g][1] * inv, o[g][2] * inv, o[g][3] * inv);
    }
}
__device__ __forceinline__ void nsa_unit(const Params& p, int b, int kv, int pos, int fr, int fq, int lane, float* ps, unsigned* msk, float* otl) {
    asm volatile("" : "+v"(fr), "+v"(fq), "+v"(lane));
    const int t0 = pos * 16, t = t0 + fr, cur = t0 >> 6;
    const bf16_t* Qb = p.hb + ((size_t)b * SEQ + t) * NMAIN + C_NQ + kv * 192 + fq * 8;
    bf16x8 qf[3][2];
#pragma unroll
    for (int g = 0; g < 3; ++g) { qf[g][0] = *(const bf16x8*)(Qb + g * 64); qf[g][1] = *(const bf16x8*)(Qb + g * 64 + 32); }
    float sl[3];
#pragma unroll
    for (int g = 0; g < 3; ++g) sl[g] = slope_nsa(kv * 3 + g) * L2E;
    const float* gl = p.hs + ((size_t)b * SEQ + t) * HS_W + 4 + kv * 9;
    f32x4 o[3][4]; float m[3], l[3];
    f32x4* otv = (f32x4*)otl + lane;
#pragma unroll
    for (int i = 0; i < 8; ++i) ps[lane + 64 * i] = 0.f;
    {
        const bf16_t* Kb = p.kc + ((size_t)b * 2 + kv) * 128 * 64;
        const bf16_t* VTb = p.vcT + ((size_t)b * 2 + kv) * 64 * 128;
        const int ncv = (t0 + 15 >= 31) ? ((t0 + 15 - 31) >> 4) + 1 : 0;
        const int nch = (ncv + 31) >> 5;
        attn_init<3>(o, m, l);
        const int dq0 = t - 31 - 16 * 8 * fq;
        RangeIt it{0, nch - 1};
        attn_run<false, false>(it, Kb, 64, VTb, 128, fr, fq, [&](int kc0, const KVFrag& f) {
            const int dq = dq0 - 16 * kc0;
            attn_compute<3, true>(f, qf, o, m, l, [&](int g, int j, float raw) { const int dist = dq - 16 * j; return dist >= 0 ? raw * SCL2 - sl[g] * (float)dist : MASKV; });
        });
        float il[3];
#pragma unroll
        for (int g = 0; g < 3; ++g) {
            const float lt = lsum4(l[g]); il[g] = lt > 0.f ? __builtin_amdgcn_rcpf(lt) : 0.f;
            const float gate = sigmoidf_fast(gl[g * 3 + 0]);
#pragma unroll
            for (int dt = 0; dt < 4; ++dt) otv[(g * 4 + dt) * 64] = o[g][dt] * (il[g] * gate);
        }
        float carry_prev = 0.f;
        for (int c = 0; c < nch; ++c) {
            const int kc0 = c * 32, dq = dq0 - 16 * kc0;
            const bf16_t* kp = Kb + (size_t)(kc0 + (fr >> 2) * 8 + (fr & 3)) * 64 + fq * 8;
            const bf16x8 k00 = *(const bf16x8*)(kp), k01 = *(const bf16x8*)(kp + 32), k10 = *(const bf16x8*)(kp + 256), k11 = *(const bf16x8*)(kp + 256 + 32);
            float pc[8];
#pragma unroll
            for (int j = 0; j < 8; ++j) pc[j] = 0.f;
#pragma unroll
            for (int g = 0; g < 3; ++g) {
                f32x4 s0 = (f32x4){0.f, 0.f, 0.f, 0.f}, s1 = s0;
                s0 = __builtin_amdgcn_mfma_f32_16x16x32_bf16(k00, qf[g][0], s0, 0, 0, 0); s0 = __builtin_amdgcn_mfma_f32_16x16x32_bf16(k01, qf[g][1], s0, 0, 0, 0);
                s1 = __builtin_amdgcn_mfma_f32_16x16x32_bf16(k10, qf[g][0], s1, 0, 0, 0); s1 = __builtin_amdgcn_mfma_f32_16x16x32_bf16(k11, qf[g][1], s1, 0, 0, 0);
#pragma unroll
                for (int j = 0; j < 8; ++j) {
                    const int dist = dq - 16 * j; const float raw = j < 4 ? s0[j] : s1[j - 4];
                    if (dist >= 0) pc[j] += __builtin_amdgcn_exp2f(raw * SCL2 - sl[g] * (float)dist - m[g]) * il[g];
                }
            }
            const float cout = 0.5f * pc[7];
            float cin = shfl_f(cout, lane - 16);
            const float cwrap = shfl_f(cout, fr + 48);
            if (fq == 0) cin = carry_prev;
            carry_prev = cwrap;
            const int n0 = (kc0 >> 2) + 2 * fq;
            ps[fr * 32 + n0] = cin + pc[0] + pc[1] + pc[2] + 0.5f * pc[3];
            ps[fr * 32 + n0 + 1] = 0.5f * pc[3] + pc[4] + pc[5] + pc[6] + 0.5f * pc[7];
        }
    }
    lds_wave_sync();
    if (lane < 16) {
        unsigned mask = 1u | (1u << cur); if (cur >= 1) mask |= 1u << (cur - 1);
        if (cur >= 3) {
            if (cur - 2 <= 5) mask |= (1u << (cur - 1)) - 2u;
            else {
                const float* my = ps + lane * 32;
                for (int r = 0; r < 5; ++r) {
                    float best = -1.0f; int bi = 1;
                    for (int j = 1; j <= cur - 2; ++j) { const float v = my[j]; if (!((mask >> j) & 1u) && v > best) { best = v; bi = j; } }
                    mask |= 1u << bi;
                }
            }
        }
        msk[lane] = mask;
    }
    lds_wave_sync();
    const unsigned qmask = msk[fr];
    lds_wave_sync();
    {
        const bf16_t* Kb = p.kF + ((size_t)b * NVH + 6 + kv) * 64 * SEQ;
        const bf16_t* VTb = p.vT + ((size_t)b * NVH + 6 + kv) * 64 * SEQ;
        attn_init<3>(o, m, l);
        unsigned um = qmask;
        um |= shfl_u(um, lane ^ 1); um |= shfl_u(um, lane ^ 2); um |= shfl_u(um, lane ^ 4); um |= shfl_u(um, lane ^ 8);
        um = (unsigned)__builtin_amdgcn_readfirstlane((int)um) & (cur >= 31 ? 0xffffffffu : ((2u << cur) - 1u));
        unsigned long long cm = 0ull;
        for (unsigned r = um; r; r &= r - 1) { const int kb = __builtin_ctz(r); cm |= 3ull << (2 * kb); }
        MaskIt it{cm};
        attn_run<true, true>(it, Kb, NMAIN, VTb, SEQ, fr, fq, [&](int kc0, const KVFrag& f) {
            const bool mine = (qmask >> (kc0 >> 6)) & 1u;
            const int dq = t - kc0 - 8 * fq;
            attn_compute<3, true>(f, qf, o, m, l, [&](int g, int j, float raw) { const int dist = dq - j; return (mine && dist >= 0) ? raw * SCL2 - sl[g] * (float)dist : MASKV; });
        });
#pragma unroll
        for (int g = 0; g < 3; ++g) {
            const float lt = lsum4(l[g]); const float sc = (lt > 0.f ? __builtin_amdgcn_rcpf(lt) : 0.f) * sigmoidf_fast(gl[g * 3 + 1]);
#pragma unroll
            for (int dt = 0; dt < 4; ++dt) otv[(g * 4 + dt) * 64] += o[g][dt] * sc;
        }
    }
    {
        const bf16_t* Kb = p.kF + ((size_t)b * NVH + 8 + kv) * 64 * SEQ;
        const bf16_t* VTb = p.vT + ((size_t)b * NVH + 8 + kv) * 64 * SEQ;
        attn_init<3>(o, m, l);
        RangeIt it{max(0, t0 - 511) >> 5, (t0 + 15) >> 5};
        attn_run<true, true>(it, Kb, NMAIN, VTb, SEQ, fr, fq, [&](int kc0, const KVFrag& f) {
            const int dq = t - kc0 - 8 * fq;
            attn_compute<3, true>(f, qf, o, m, l, [&](int g, int j, float raw) { const int dist = dq - j; return ((unsigned)dist < 512u) ? raw * SCL2 - sl[g] * (float)dist : MASKV; });
        });
#pragma unroll
        for (int g = 0; g < 3; ++g) {
            const float lt = lsum4(l[g]); const float sc = (lt > 0.f ? __builtin_amdgcn_rcpf(lt) : 0.f) * sigmoidf_fast(gl[g * 3 + 2]);
            unsigned char* dst = (unsigned char*)p.ob + ((size_t)b * SEQ + t) * DM + 640 + (kv * 3 + g) * 64 + 16 * fq;
            store_o16(dst, otv[(g * 4 + 0) * 64] + o[g][0] * sc, otv[(g * 4 + 1) * 64] + o[g][1] * sc, otv[(g * 4 + 2) * 64] + o[g][2] * sc, otv[(g * 4 + 3) * 64] + o[g][3] * sc);
        }
    }
}

template <bool WITH_CONV>
__device__ __forceinline__ void phase_attn(const Params& p, int l, char* lds, int cslot = 16) {
    int tid = threadIdx.x; asm volatile("" : "+v"(tid));
    const int wid = tid >> 6, lane = tid & 63, fr = lane & 15, fq = lane >> 4;
    float* ps = (float*)(lds + wid * 16896); unsigned* msk = (unsigned*)(ps + 512); float* otl = ps + 576;
    unsigned* ctr = p.ctrl + cslot + l;
    constexpr unsigned NU_NSA = NB * 2 * 128, NU_FOX = NB * 4 * 32, NU_SWA = NB * 2 * 128, NU_ATT = NU_NSA + NU_FOX + NU_SWA;
    for (;;) {
        unsigned u = 0;
        if (lane == 0) u = __hip_atomic_fetch_add(ctr, 1u, __ATOMIC_RELAXED, __HIP_MEMORY_SCOPE_AGENT);
        u = (unsigned)__builtin_amdgcn_readfirstlane((int)u);
        if (WITH_CONV) {
            constexpr unsigned TOTQ = NU_ATT + (unsigned)CONV_TILES;
            if (u >= TOTQ) break;
            const unsigned a0 = (unsigned)(((unsigned long long)u * NU_ATT) / TOTQ), a1 = (unsigned)(((unsigned long long)(u + 1) * NU_ATT) / TOTQ);
            if (a1 == a0) { conv_tile_wave(p, (int)(u - a0), lane, (unsigned char*)ps); continue; }
            u = a0;
        } else {
#ifndef ATT_REP
#define ATT_REP 1
#endif
            if (u >= ATT_REP * NU_ATT) break;
            if (ATT_REP > 1) u %= NU_ATT;
        }
        if (u < NU_NSA) { const int pos = 127 - (int)(u & 127), r = u >> 7; nsa_unit(p, r >> 1, r & 1, pos, fr, fq, lane, ps, msk, otl); }
        else if (u < NU_NSA + NU_FOX) { const unsigned v = u - NU_NSA; const int qb = 31 - (int)(v & 31), r = v >> 5; fox_unit(p, r >> 2, r & 3, qb, fr, fq); }
        else { const unsigned v = u - NU_NSA - NU_FOX; const int pos = 127 - (int)(v & 127), r = v >> 7; swa_unit(p, l, r >> 1, r & 1, pos, fr, fq); }
    }
}

__device__ __forceinline__ void phase_ln1_router(const Params& p, int l, char* lds) {
    int tid = threadIdx.x; asm volatile("" : "+v"(tid));
    const int wid = tid >> 6, lane = tid & 63, fr = lane & 15, fq = lane >> 4;
    float* lg = (float*)lds + wid * 512;
    int* lcnt = (int*)(lds + 16384); int* lbase = lcnt + 32;
    const float* g1 = p.ln1_g + l * DM; const float* b1 = p.ln1_b + l * DM;
    const float* rw = p.rwT + (size_t)l * NE * 1024; const float* rb = p.router_b + l * NE;
    unsigned* gcount = p.ctrl + 64 + l * NE;
    for (int grp = blockIdx.x; grp < NTOK / 128; grp += gridDim.x) {
        const int tok0 = grp * 128 + wid * 16;
        if (tid < 32) lcnt[tid] = 0;
        float gg[16], bb[16];
#pragma unroll
        for (int j = 0; j < 4; ++j) { const float4 g4 = *(const float4*)(g1 + lane * 16 + j * 4), b4 = *(const float4*)(b1 + lane * 16 + j * 4);
            gg[4 * j] = g4.x; gg[4 * j + 1] = g4.y; gg[4 * j + 2] = g4.z; gg[4 * j + 3] = g4.w; bb[4 * j] = b4.x; bb[4 * j + 1] = b4.y; bb[4 * j + 2] = b4.z; bb[4 * j + 3] = b4.w; }
        for (int r0 = 0; r0 < 16; r0 += 4) {
            float v[4][16]; float s[4], qv[4];
#pragma unroll
            for (int i = 0; i < 4; ++i) {
                const bf16_t* tr = (const bf16_t*)p.tbuf + (size_t)(tok0 + r0 + i) * DM + lane * 16;
                const u32x4 t0 = *(const u32x4*)tr, t1 = *(const u32x4*)(tr + 8);
                const unsigned ts[8] = {t0.x, t0.y, t0.z, t0.w, t1.x, t1.y, t1.z, t1.w};
#pragma unroll
                for (int c = 0; c < 8; ++c) { v[i][2 * c] = __uint_as_float(ts[c] << 16); v[i][2 * c + 1] = __uint_as_float(ts[c] & 0xffff0000u); }
            }
#pragma unroll
            for (int i = 0; i < 4; ++i) { s[i] = 0.f;
#pragma unroll
                for (int c = 0; c < 16; c += 4) s[i] += (v[i][c] + v[i][c + 1]) + (v[i][c + 2] + v[i][c + 3]); }
#pragma unroll
            for (int o = 32; o > 0; o >>= 1) {
#pragma unroll
                for (int i = 0; i < 4; ++i) s[i] += shfl_f(s[i], lane ^ o); }
#pragma unroll
            for (int i = 0; i < 4; ++i) { const float mean = s[i] * (1.0f / 1024.0f); qv[i] = 0.f;
#pragma unroll
                for (int c = 0; c < 16; c += 4) { v[i][c] -= mean; v[i][c + 1] -= mean; v[i][c + 2] -= mean; v[i][c + 3] -= mean;
                    qv[i] += (v[i][c] * v[i][c] + v[i][c + 1] * v[i][c + 1]) + (v[i][c + 2] * v[i][c + 2] + v[i][c + 3] * v[i][c + 3]); } }
#pragma unroll
            for (int o = 32; o > 0; o >>= 1) {
#pragma unroll
                for (int i = 0; i < 4; ++i) qv[i] += shfl_f(qv[i], lane ^ o); }
#pragma unroll
            for (int i = 0; i < 4; ++i) {
                const float rstd = rsqrtf(qv[i] * (1.0f / 1024.0f) + LN_EPS);
                const size_t row = (size_t)(tok0 + r0 + i);
                float y[16];
#pragma unroll
                for (int c = 0; c < 16; ++c) y[c] = v[i][c] * rstd * gg[c] + bb[c];
                u32x4 w0, w1, q;
                w0.x = pack2(y[0], y[1]); w0.y = pack2(y[2], y[3]); w0.z = pack2(y[4], y[5]); w0.w = pack2(y[6], y[7]);
                w1.x = pack2(y[8], y[9]); w1.y = pack2(y[10], y[11]); w1.z = pack2(y[12], y[13]); w1.w = pack2(y[14], y[15]);
                q.x = pack4_fp8(y[0], y[1], y[2], y[3]); q.y = pack4_fp8(y[4], y[5], y[6], y[7]); q.z = pack4_fp8(y[8], y[9], y[10], y[11]); q.w = pack4_fp8(y[12], y[13], y[14], y[15]);
                *(u32x4*)((bf16_t*)p.x1f + row * DM + lane * 16) = w0; *(u32x4*)((bf16_t*)p.x1f + row * DM + lane * 16 + 8) = w1;
                *(u32x4*)((char*)p.x1b + row * DM + lane * 16) = q;
            }
        }
        __syncthreads();
        f32x4 a0 = (f32x4){0.f, 0.f, 0.f, 0.f}, a1 = a0;
        const bf16_t* xr = (const bf16_t*)p.x1f + (size_t)(tok0 + fr) * DM + 4 * fq;
        const float* w0 = rw + (size_t)fr * 1024 + 4 * fq; const float* w1 = rw + (size_t)(16 + fr) * 1024 + 4 * fq;
#pragma unroll 4
        for (int k0 = 0; k0 < 1024; k0 += 16) {
            const u32x2 xw = *(const u32x2*)(xr + k0); const float4 wb0 = *(const float4*)(w0 + k0), wb1 = *(const float4*)(w1 + k0);
            const float4 xa = make_float4(__uint_as_float(xw.x << 16), __uint_as_float(xw.x & 0xffff0000u), __uint_as_float(xw.y << 16), __uint_as_float(xw.y & 0xffff0000u));
            a0 = __builtin_amdgcn_mfma_f32_16x16x4f32(xa.x, wb0.x, a0, 0, 0, 0); a1 = __builtin_amdgcn_mfma_f32_16x16x4f32(xa.x, wb1.x, a1, 0, 0, 0);
            a0 = __builtin_amdgcn_mfma_f32_16x16x4f32(xa.y, wb0.y, a0, 0, 0, 0); a1 = __builtin_amdgcn_mfma_f32_16x16x4f32(xa.y, wb1.y, a1, 0, 0, 0);
            a0 = __builtin_amdgcn_mfma_f32_16x16x4f32(xa.z, wb0.z, a0, 0, 0, 0); a1 = __builtin_amdgcn_mfma_f32_16x16x4f32(xa.z, wb1.z, a1, 0, 0, 0);
            a0 = __builtin_amdgcn_mfma_f32_16x16x4f32(xa.w, wb0.w, a0, 0, 0, 0); a1 = __builtin_amdgcn_mfma_f32_16x16x4f32(xa.w, wb1.w, a1, 0, 0, 0);
        }
#pragma unroll
        for (int r = 0; r < 4; ++r) { lg[(fq * 4 + r) * 32 + fr] = a0[r] + rb[fr]; lg[(fq * 4 + r) * 32 + 16 + fr] = a1[r] + rb[16 + fr]; }
        lds_wave_sync();
        int e4[4] = {0, 0, 0, 0}; int rk[4] = {0, 0, 0, 0};
        if (lane < 16) {
            const float* my = lg + lane * 32; unsigned taken = 0u; float tv[4];
#pragma unroll
            for (int k = 0; k < 4; ++k) {
                float best = NEG_INF; int bi = 0;
                for (int e = 0; e < 32; ++e) { const float xv = my[e]; if (!((taken >> e) & 1u) && xv > best) { best = xv; bi = e; } }
                taken |= 1u << bi; e4[k] = bi; tv[k] = best;
            }
            const float e1 = __expf(tv[1] - tv[0]), e2 = __expf(tv[2] - tv[0]), e3 = __expf(tv[3] - tv[0]);
            const float inv = 1.0f / (1.0f + e1 + e2 + e3);
            const size_t row = (size_t)(tok0 + lane);
            *(float4*)(p.gw + row * 4) = make_float4(inv, e1 * inv, e2 * inv, e3 * inv);
        }
        __syncthreads();
        if (lane < 16) {
#pragma unroll
            for (int k = 0; k < 4; ++k) rk[k] = atomicAdd(&lcnt[e4[k]], 1);
        }
        __syncthreads();
        if (tid < 32) { const int c = lcnt[tid]; lbase[tid] = c ? (int)__hip_atomic_fetch_add(gcount + tid, (unsigned)c, __ATOMIC_RELAXED, __HIP_MEMORY_SCOPE_AGENT) : 0; }
        __syncthreads();
        if (lane < 16) {
            const int row = tok0 + lane; int pk[4];
#pragma unroll
            for (int k = 0; k < 4; ++k) { const int pos = lbase[e4[k]] + rk[k]; p.lists[(size_t)e4[k] * LIST_CAP + pos] = row * 4 + k; pk[k] = (pos << 5) | e4[k]; }
            *(int4*)(p.top_e + (size_t)row * 4) = make_int4(pk[0], pk[1], pk[2], pk[3]);
        }
        __syncthreads();
    }
}

__device__ __forceinline__ void phase_ln2(const Params& p, int l, float* xout, char* lds) {
    int* ptile = (int*)(lds + LDS_TAB); int* ecnt = ptile + 40;
    build_tiles(p, l, ptile, ecnt);
    int tid = threadIdx.x; asm volatile("" : "+v"(tid));
    const int wid = tid >> 6, lane = tid & 63;
    const float* g2 = p.ln2_g + l * DM; const float* b2 = p.ln2_b + l * DM;
    float gg[16], bb[16];
#pragma unroll
    for (int j = 0; j < 4; ++j) { const float4 g4 = *(const float4*)(g2 + lane * 16 + j * 4), b4 = *(const float4*)(b2 + lane * 16 + j * 4);
        gg[4 * j] = g4.x; gg[4 * j + 1] = g4.y; gg[4 * j + 2] = g4.z; gg[4 * j + 3] = g4.w; bb[4 * j] = b4.x; bb[4 * j + 1] = b4.y; bb[4 * j + 2] = b4.z; bb[4 * j + 3] = b4.w; }
    for (int pr = blockIdx.x * NWV + wid; pr < NTOK / 2; pr += gridDim.x * NWV) {
        float v[2][16]; float s[2], qv[2];
        u32x4 yv[2][4], xv[2][2]; float gk[2][4];
#pragma unroll
        for (int i = 0; i < 2; ++i) {
            const int row = pr * 2 + i;
            const float4 gwv = *(const float4*)(p.gw + (size_t)row * 4);
            gk[i][0] = gwv.x; gk[i][1] = gwv.y; gk[i][2] = gwv.z; gk[i][3] = gwv.w;
            const int4 te = *(const int4*)(p.top_e + (size_t)row * 4);
            const int tk[4] = {te.x, te.y, te.z, te.w};
            xv[i][0] = *(const u32x4*)((const bf16_t*)p.x1f + (size_t)row * DM + lane * 16); xv[i][1] = *(const u32x4*)((const bf16_t*)p.x1f + (size_t)row * DM + lane * 16 + 8);
#pragma unroll
            for (int k = 0; k < 4; ++k) yv[i][k] = *(const u32x4*)((const unsigned char*)p.ybuf + (size_t)(ptile[tk[k] & 31] * 256 + (tk[k] >> 5)) * DM + lane * 16);
        }
#pragma unroll
        for (int i = 0; i < 2; ++i) { s[i] = 0.f;
            const unsigned xs[8] = {xv[i][0].x, xv[i][0].y, xv[i][0].z, xv[i][0].w, xv[i][1].x, xv[i][1].y, xv[i][1].z, xv[i][1].w};
#pragma unroll
            for (int c = 0; c < 8; ++c) { v[i][2 * c] = __uint_as_float(xs[c] << 16) * ALPHA; v[i][2 * c + 1] = __uint_as_float(xs[c] & 0xffff0000u) * ALPHA; }
#pragma unroll
            for (int k = 0; k < 4; ++k) {
                const unsigned ys[4] = {yv[i][k].x, yv[i][k].y, yv[i][k].z, yv[i][k].w};
#pragma unroll
                for (int c = 0; c < 4; ++c) {
                    const f32x2_t lo = __builtin_amdgcn_cvt_pk_f32_fp8(ys[c], false), hi = __builtin_amdgcn_cvt_pk_f32_fp8(ys[c], true);
                    v[i][4 * c] += gk[i][k] * lo.x; v[i][4 * c + 1] += gk[i][k] * lo.y; v[i][4 * c + 2] += gk[i][k] * hi.x; v[i][4 * c + 3] += gk[i][k] * hi.y;
                }
            }
#pragma unroll
            for (int c = 0; c < 16; c += 4) s[i] += (v[i][c] + v[i][c + 1]) + (v[i][c + 2] + v[i][c + 3]);
        }
#pragma unroll
        for (int o = 32; o > 0; o >>= 1) { s[0] += shfl_f(s[0], lane ^ o); s[1] += shfl_f(s[1], lane ^ o); }
#pragma unroll
        for (int i = 0; i < 2; ++i) { const float mean = s[i] * (1.0f / 1024.0f); qv[i] = 0.f;
#pragma unroll
            for (int c = 0; c < 16; c += 4) { v[i][c] -= mean; v[i][c + 1] -= mean; v[i][c + 2] -= mean; v[i][c + 3] -= mean;
                qv[i] += (v[i][c] * v[i][c] + v[i][c + 1] * v[i][c + 1]) + (v[i][c + 2] * v[i][c + 2] + v[i][c + 3] * v[i][c + 3]); } }
#pragma unroll
        for (int o = 32; o > 0; o >>= 1) { qv[0] += shfl_f(qv[0], lane ^ o); qv[1] += shfl_f(qv[1], lane ^ o); }
#pragma unroll
        for (int i = 0; i < 2; ++i) {
            const float rstd = rsqrtf(qv[i] * (1.0f / 1024.0f) + LN_EPS);
            const size_t row = (size_t)(pr * 2 + i);
            float y[16];
#pragma unroll
            for (int c = 0; c < 16; ++c) y[c] = v[i][c] * rstd * gg[c] + bb[c];
            if (l + 1 < NL) {
                u32x4 w0, w1, q;
                w0.x = pack2(y[0], y[1]); w0.y = pack2(y[2], y[3]); w0.z = pack2(y[4], y[5]); w0.w = pack2(y[6], y[7]);
                w1.x = pack2(y[8], y[9]); w1.y = pack2(y[10], y[11]); w1.z = pack2(y[12], y[13]); w1.w = pack2(y[14], y[15]);
                q.x = pack4_fp8(y[0], y[1], y[2], y[3]); q.y = pack4_fp8(y[4], y[5], y[6], y[7]); q.z = pack4_fp8(y[8], y[9], y[10], y[11]); q.w = pack4_fp8(y[12], y[13], y[14], y[15]);
                *(u32x4*)(p.xb + row * DM + lane * 16) = w0; *(u32x4*)(p.xb + row * DM + lane * 16 + 8) = w1;
                *(u32x4*)(p.xq + row * DM + lane * 16) = q;
            } else {
#pragma unroll
                for (int c = 0; c < 16; c += 4) *(float4*)(xout + row * DM + lane * 16 + c) = make_float4(y[c], y[c + 1], y[c + 2], y[c + 3]);
            }
        }
    }
}

#define XB_TMO      128
#define XB_XCNT(j)  (256  + 64 * (j))
#define XB_XSUB(j)  (1280 + 64 * (j))
#define XB_XGEN(j)  (2304 + 64 * (j))
#define XB_TOP      3328
#define XB_TOPGEN   3392
#define XCD_BAR_WORDS 3456
#define XB_SPIN_CAP (1u << 22)
__device__ __forceinline__ unsigned xb_ld(unsigned* p)              { return __hip_atomic_load(p, __ATOMIC_RELAXED, __HIP_MEMORY_SCOPE_AGENT); }
__device__ __forceinline__ unsigned xb_add(unsigned* p, unsigned v) { return __hip_atomic_fetch_add(p, v, __ATOMIC_RELAXED, __HIP_MEMORY_SCOPE_AGENT); }
__device__ __forceinline__ unsigned xb_xcc_id() { return (unsigned)__builtin_amdgcn_s_getreg((3 << 11) | 20) & 0xFu; }
#define XB_SPIN(cond, bar) do { unsigned _sp = 0; while (cond) { __builtin_amdgcn_s_sleep(1); \
    if ((++_sp & 255u) == 0u) { if (xb_ld(&(bar)[XB_TMO])) break; if (_sp > XB_SPIN_CAP) { atomicAdd(&(bar)[XB_TMO], 1u); break; } } } } while (0)
struct XcdBarrier { unsigned* bar; unsigned x; volatile LAS unsigned* st; };
__device__ __forceinline__ XcdBarrier xcd_barrier_post(unsigned* bar, volatile LAS unsigned* st) {
    XcdBarrier b; b.bar = bar; b.x = xb_xcc_id(); b.st = st;
    if (threadIdx.x == 0) (void)xb_add(&bar[XB_XCNT(b.x)], 1u);
    return b;
}
__device__ __forceinline__ void xcd_barrier_complete(unsigned* bar, unsigned x, unsigned& nloc, unsigned& nx) {
    const unsigned G = gridDim.x * gridDim.y * gridDim.z;
    unsigned sum, cnt, mine, sp = 0u;
    for (;;) {
        sum = 0u; cnt = 0u; mine = 0u;
#pragma unroll
        for (unsigned j = 0; j < 16; ++j) { const unsigned c = xb_ld(&bar[XB_XCNT(j)]); sum += c; cnt += (c > 0u) ? 1u : 0u; mine = (j == x) ? c : mine; }
        if (sum == G) break;
        __builtin_amdgcn_s_sleep(1);
        if ((++sp & 255u) == 0u) { if (xb_ld(&bar[XB_TMO])) break; if (sp > XB_SPIN_CAP) { atomicAdd(&bar[XB_TMO], 1u); break; } }
    }
    nloc = mine > 0u ? mine : 1u; nx = cnt > 0u ? cnt : 1u;
}
__device__ __forceinline__ void xcd_barrier(const XcdBarrier& b) {
    asm volatile("s_waitcnt vmcnt(0)" ::: "memory");
    __syncthreads();
    if (threadIdx.x == 0) {
        unsigned* bar = b.bar;
        __builtin_amdgcn_s_waitcnt(0);
        unsigned nloc = b.st[0], nx = b.st[1];
        if (nloc == 0u) { xcd_barrier_complete(bar, b.x, nloc, nx); b.st[0] = nloc; b.st[1] = nx; }
        const unsigned old = xb_add(&bar[XB_XSUB(b.x)], 1u);
        const unsigned gen = old / nloc;
        if (old + 1u == (gen + 1u) * nloc) {
            __builtin_amdgcn_fence(__ATOMIC_RELEASE, "agent");
            asm volatile("s_waitcnt vmcnt(0)" ::: "memory");
            const unsigned og = xb_add(&bar[XB_TOP], 1u);
            const unsigned tg = og / nx;
            if (og + 1u == (tg + 1u) * nx) xb_add(&bar[XB_TOPGEN], 1u);
            else XB_SPIN(xb_ld(&bar[XB_TOPGEN]) == tg, bar);
            __builtin_amdgcn_fence(__ATOMIC_ACQUIRE, "agent");
            xb_add(&bar[XB_XGEN(b.x)], 1u);
            asm volatile("s_waitcnt vmcnt(0)" ::: "memory");
        } else {
            XB_SPIN(xb_ld(&bar[XB_XGEN(b.x)]) == gen, bar);
            __builtin_amdgcn_fence(__ATOMIC_ACQUIRE, "agent");
            asm volatile("s_waitcnt vmcnt(0)" ::: "memory");
        }
    }
    __syncthreads();
}

struct KArgs { const float* in[18]; float* out; char* ws; };
constexpr size_t al256(size_t v) { return (v + 255) / 256 * 256; }
struct WSL {
    static constexpr size_t ctrl = 0;
    static constexpr size_t WinT = al256(ctrl + 65536);
    static constexpr size_t WoT = al256(WinT + (size_t)NL * NPAD * 1024 * 2);
    static constexpr size_t W1T = al256(WoT + (size_t)NL * 1024 * 1024 * 2);
    static constexpr size_t W2T = al256(W1T + (size_t)NL * 2 * 64 * 2048 * 2);
    static constexpr size_t WguT = al256(W2T + (size_t)NL * 2 * 64 * 64 * 2);
    static constexpr size_t WdnT = al256(WguT + (size_t)NL * NE * 2048 * 1024 * 2);
    static constexpr size_t rwT = al256(WdnT + (size_t)NL * NE * 1024 * 1024 * 2);
    static constexpr size_t binp = al256(rwT + (size_t)NL * NE * 1024 * 4);
    static constexpr size_t bgup = al256(binp + (size_t)NL * NPAD * 4);
    static constexpr size_t b1c = al256(bgup + (size_t)NL * NE * 2048 * 4);
    static constexpr size_t xf = al256(b1c + 4 * 64 * 4);
    static constexpr size_t xb = al256(xf + (size_t)NTOK * DM * 4);
    static constexpr size_t hb = al256(xb + (size_t)NTOK * DM * 2);
    static constexpr size_t hs = al256(hb + (size_t)NTOK * NMAIN * 2);
    static constexpr size_t vT = al256(hs + (size_t)NTOK * HS_W * 4);
    static constexpr size_t kF = al256(vT + (size_t)NB * NVH * 64 * SEQ * 2);
    static constexpr size_t cF = al256(kF + (size_t)NB * NVH * 64 * SEQ * 2);
    static constexpr size_t kc = al256(cF + (size_t)NB * 4 * SEQ * 4);
    static constexpr size_t vc = al256(kc + (size_t)NB * 2 * 128 * 64 * 2);
    static constexpr size_t vcT = al256(vc + (size_t)NB * 2 * 128 * 64 * 2);
    static constexpr size_t ob = al256(vcT + (size_t)NB * 2 * 128 * 64 * 2);
    static constexpr size_t tbuf = al256(ob + (size_t)NTOK * DM * 2);
    static constexpr size_t x1f = al256(tbuf + (size_t)NTOK * DM * 4);
    static constexpr size_t x1b = al256(x1f + (size_t)NTOK * DM * 4);
    static constexpr size_t top_e = al256(x1b + (size_t)NTOK * DM * 2);
    static constexpr size_t gw = al256(top_e + (size_t)NTOK * 4 * 4);
    static constexpr size_t lists = al256(gw + (size_t)NTOK * 4 * 4);
    static constexpr size_t act = al256(lists + (size_t)NE * LIST_CAP * 4);
    static constexpr size_t ybuf = al256(act + (size_t)MAXSLOT * DFF * 2);
    static constexpr size_t xq = al256(ybuf + (size_t)MAXSLOT * DM * 2);
    static constexpr size_t WinQ = al256(xq + (size_t)NTOK * DM);
    static constexpr size_t total = al256(WinQ + (size_t)NL * NMAIN * 1024);
};
__device__ __forceinline__ Params make_params(const KArgs& k) {
    Params p;
    p.x = k.in[0]; p.w_in = k.in[1]; p.b_in = k.in[2]; p.sinks = k.in[3]; p.cmp_pe = k.in[4]; p.cmp_w1 = k.in[5]; p.cmp_w2 = k.in[6]; p.w_out = k.in[7];
    p.ln1_g = k.in[8]; p.ln1_b = k.in[9]; p.router_w = k.in[10]; p.router_b = k.in[11]; p.w_gu = k.in[12]; p.b_gu = k.in[13]; p.w_dn = k.in[14]; p.b_dn = k.in[15];
    p.ln2_g = k.in[16]; p.ln2_b = k.in[17]; p.out = k.out;
    char* w = k.ws;
    p.ctrl = (unsigned*)(w + WSL::ctrl); p.WinT = (bf16_t*)(w + WSL::WinT); p.WoT = (bf16_t*)(w + WSL::WoT); p.W1T = (bf16_t*)(w + WSL::W1T); p.W2T = (bf16_t*)(w + WSL::W2T);
    p.WguT = (bf16_t*)(w + WSL::WguT); p.WdnT = (bf16_t*)(w + WSL::WdnT); p.rwT = (float*)(w + WSL::rwT); p.binp = (float*)(w + WSL::binp); p.bgup = (float*)(w + WSL::bgup);
    p.b1c = (float*)(w + WSL::b1c); p.xf = (float*)(w + WSL::xf); p.xb = (bf16_t*)(w + WSL::xb); p.hb = (bf16_t*)(w + WSL::hb); p.hs = (float*)(w + WSL::hs); p.vT = (bf16_t*)(w + WSL::vT); p.kF = (bf16_t*)(w + WSL::kF);
    p.cF = (float*)(w + WSL::cF); p.kc = (bf16_t*)(w + WSL::kc); p.vc = (bf16_t*)(w + WSL::vc); p.vcT = (bf16_t*)(w + WSL::vcT); p.ob = (bf16_t*)(w + WSL::ob); p.tbuf = (float*)(w + WSL::tbuf);
    p.x1f = (float*)(w + WSL::x1f); p.x1b = (bf16_t*)(w + WSL::x1b); p.top_e = (int*)(w + WSL::top_e); p.gw = (float*)(w + WSL::gw); p.lists = (int*)(w + WSL::lists);
    p.act = (bf16_t*)(w + WSL::act); p.ybuf = (bf16_t*)(w + WSL::ybuf); p.xq = (unsigned char*)(w + WSL::xq); p.WinQ = (unsigned char*)(w + WSL::WinQ);
    return p;
}
__device__ __forceinline__ void grid_bar(const Params& p, char* lds) {
    XcdBarrier xb; xb.bar = p.ctrl + 1024; xb.x = xb_xcc_id(); xb.st = (volatile LAS unsigned*)(lds + LDS_BYTES - 16); xcd_barrier(xb);
}
__device__ __forceinline__ Params fresh_params(const KArgs& ka) {
    KArgs k2 = ka; size_t z = 0; asm volatile("" : "+s"(z));
    k2.ws = ka.ws + z;
    return make_params(k2);
}
#ifndef REP
#define REP 0
#endif
template <int L>
__device__ __forceinline__ void layer_fwd(const KArgs& ka, char* lds) {
    { const Params p = fresh_params(ka); phase_inproj(p, L, lds);        grid_bar(p, lds); }
    { const Params p = fresh_params(ka); phase_prep(p, L, lds);          grid_bar(p, lds); }
    { const Params p = fresh_params(ka); phase_attn<L == 0>(p, L, lds);  grid_bar(p, lds); }
    { const Params p = fresh_params(ka); phase_outproj(p, L, p.xb, lds);  grid_bar(p, lds); }
    { const Params p = fresh_params(ka); phase_ln1_router(p, L, lds);    grid_bar(p, lds); }
    { const Params p = fresh_params(ka); phase_gateup(p, L, lds);        grid_bar(p, lds); }
    { const Params p = fresh_params(ka); phase_down(p, L, lds);          grid_bar(p, lds); }
    { const Params p = fresh_params(ka); phase_ln2(p, L, L == NL - 1 ? p.out : p.xf, lds); }
}
__global__ void __launch_bounds__(NTHR, 2) fwd_kernel(KArgs ka) {
    extern __shared__ __attribute__((aligned(16))) char lds[];
    const Params p = make_params(ka);
    cg::grid_group grid = cg::this_grid();
    volatile LAS unsigned* xst = (volatile LAS unsigned*)(lds + LDS_BYTES - 16);
    if (threadIdx.x == 0) { xst[0] = 0u; xst[1] = 0u; }
    __syncthreads();
    (void)xcd_barrier_post(p.ctrl + 1024, xst);
    volatile LAS int* vcu = (volatile LAS int*)(lds + LDS_BYTES - 32);
    const unsigned myx = xb_xcc_id() & 7u;
    if (threadIdx.x == 0) vcu[1] = (int)__hip_atomic_fetch_add(p.ctrl + 32 + myx, 1u, __ATOMIC_RELAXED, __HIP_MEMORY_SCOPE_AGENT);
    phase0(p, lds);
    grid.sync();
    if (threadIdx.x == 0) {
        int base = 0, tot = 0;
        for (unsigned x = 0; x < 8; ++x) { const int n = (int)__hip_atomic_load(p.ctrl + 32 + x, __ATOMIC_RELAXED, __HIP_MEMORY_SCOPE_AGENT); if (x < myx) base += n; tot += n; }
        vcu[0] = (tot == (int)gridDim.x) ? base + vcu[1] : (int)blockIdx.x;
    }
    __syncthreads();
    layer_fwd<0>(ka, lds);
    grid_bar(p, lds);
    layer_fwd<1>(ka, lds);
}

extern "C" void kernel_launch(void* const* d_in, const int* in_sizes, int n_in, void* d_out, int out_size, void* d_ws, size_t ws_size, hipStream_t stream) {
    KArgs ka{};
    for (int i = 0; i < 18; ++i) ka.in[i] = (const float*)d_in[i];
    ka.out = (float*)d_out; ka.ws = (char*)d_ws;
    if (WSL::total > ws_size) { fprintf(stderr, "workspace too small: need %zu have %zu\n", (size_t)WSL::total, ws_size); return; }
    static int grid_blocks = 0;
    if (!grid_blocks) {
        int dev = 0, cus = 0, per_cu = 0;
        (void)hipGetDevice(&dev);
        (void)hipDeviceGetAttribute(&cus, hipDeviceAttributeMultiprocessorCount, dev);
        (void)hipFuncSetAttribute((const void*)fwd_kernel, hipFuncAttributeMaxDynamicSharedMemorySize, LDS_BYTES);
        (void)hipOccupancyMaxActiveBlocksPerMultiprocessor(&per_cu, fwd_kernel, NTHR, LDS_BYTES);
        if (per_cu < 1) { fprintf(stderr, "occupancy query says 0 blocks per CU\n"); per_cu = 1; }
        grid_blocks = cus;
    }
    (void)hipMemsetAsync(d_ws, 0, 65536, stream);
    void* args[] = {&ka};
    hipError_t e = hipLaunchCooperativeKernel((const void*)fwd_kernel, dim3(grid_blocks), dim3(NTHR), args, LDS_BYTES, stream);
    if (e != hipSuccess) fprintf(stderr, "cooperative launch failed: %s (grid %d)\n", hipGetErrorString(e), grid_blocks);
}
```

```cpp
#include <hip/hip_runtime.h>
#include <hip/hip_cooperative_groups.h>
#include <cstdio>
#include <cstdint>
namespace cg = cooperative_groups;

typedef unsigned short bf16_t;
typedef short bf16x8 __attribute__((ext_vector_type(8)));
typedef float f32x4 __attribute__((ext_vector_type(4)));
typedef unsigned u32x4 __attribute__((ext_vector_type(4)));
typedef unsigned u32x2 __attribute__((ext_vector_type(2)));
typedef int v8i_t __attribute__((ext_vector_type(8)));
typedef float f32x2_t __attribute__((ext_vector_type(2)));
typedef int v4i_t __attribute__((ext_vector_type(4)));
#define LAS __attribute__((address_space(3)))
constexpr float NEG_INF = -__builtin_huge_valf();

constexpr int DM = 1024, NB = 16, SEQ = 2048, NTOK = NB * SEQ, NL = 2;
constexpr int NCOL = 2582, NMAIN = 2560, NPAD = 2688, NE = 32, DFF = 1024;
constexpr int C_FQ = 0, C_FK = 256, C_FV = 512, C_SQ = 768, C_SK = 1152, C_SV = 1280, C_NQ = 1408,
              C_NKC = 1792, C_NVC = 1920, C_NKS = 2048, C_NVS = 2176, C_NKW = 2304, C_NVW = 2432;
constexpr int HS_W = 32;
constexpr int NVH = 10;
constexpr int LIST_CAP = NTOK;
constexpr int MAXSLOT = NTOK * 4 + NE * 256;
constexpr float ALPHA = 1.41421356237f, LN_EPS = 1e-5f, QSCALE = 0.125f;
constexpr float GATE_PRE = -2.455466929f;
constexpr int NWV = 8, NTHR = NWV * 64;
constexpr int LDS_STAGE = 131072, LDS_TAB = LDS_STAGE, LDS_AOFF = LDS_STAGE + 2048, LDS_BIAS = LDS_AOFF + 20480, LDS_BYTES = LDS_BIAS + 3072 + 256;

struct Params {
    const float *x, *w_in, *b_in, *sinks, *cmp_pe, *cmp_w1, *cmp_w2, *w_out, *ln1_g, *ln1_b, *router_w, *router_b,
                *w_gu, *b_gu, *w_dn, *b_dn, *ln2_g, *ln2_b;
    float* out;
    unsigned* ctrl;
    bf16_t *WinT, *WoT, *W1T, *W2T, *WguT, *WdnT;
    float *rwT, *binp, *bgup, *b1c;
    unsigned char* xq; unsigned char* WinQ;
    float* xf; bf16_t* xb; bf16_t* hb; float* hs; bf16_t* vT; bf16_t* kF; float* cF;
    bf16_t *kc, *vc, *vcT; bf16_t* ob; float* tbuf; float* x1f; bf16_t* x1b;
    int* top_e; float* gw; int* lists; bf16_t* act; bf16_t* ybuf;
};

__device__ __forceinline__ float bf2f(bf16_t h) { return __uint_as_float(((unsigned)h) << 16); }
typedef __bf16 bf16x2_t __attribute__((ext_vector_type(2)));
__device__ __forceinline__ bf16_t f2bf(float f) { return __builtin_bit_cast(bf16_t, (__bf16)f); }
__device__ __forceinline__ unsigned pack2(float lo, float hi) { bf16x2_t v = {(__bf16)lo, (__bf16)hi}; return __builtin_bit_cast(unsigned, v); }
__device__ __forceinline__ unsigned pack4_fp8(float a, float b, float c, float d) {
    unsigned w = 0u;
    w = __builtin_amdgcn_cvt_pk_fp8_f32(a, b, w, false);
    w = __builtin_amdgcn_cvt_pk_fp8_f32(c, d, w, true);
    return w;
}
__device__ __forceinline__ float shfl_f(float v, int src_lane) { return __int_as_float(__builtin_amdgcn_ds_bpermute(src_lane << 2, __float_as_int(v))); }
__device__ __forceinline__ unsigned shfl_u(unsigned v, int src_lane) { return (unsigned)__builtin_amdgcn_ds_bpermute(src_lane << 2, (int)v); }
__device__ __forceinline__ float wave_sum(float v) {
#pragma unroll
    for (int o = 32; o > 0; o >>= 1) v += __shfl_xor(v, o);
    return v;
}
__device__ __forceinline__ float wave_max(float v) {
#pragma unroll
    for (int o = 32; o > 0; o >>= 1) v = fmaxf(v, __shfl_xor(v, o));
    return v;
}
__device__ __forceinline__ void lds_wave_sync() { asm volatile("s_waitcnt lgkmcnt(0)" ::: "memory"); __builtin_amdgcn_wave_barrier(); }
__device__ __forceinline__ float slope_swa(int hq) { return exp2f(-8.0f * (float)(2 * hq + 1) / 12.0f); }
__device__ __forceinline__ float slope_nsa(int hq) { return exp2f(-8.0f * (float)(2 * hq + 2) / 12.0f); }

__device__ __forceinline__ int fwd128(int L) { return (L & ~31) | (((L >> 2) & 1) << 4) | (((L >> 3) & 3) << 2) | (L & 3); }
__device__ __forceinline__ int inv128(int p) { return (p & ~31) | (((p >> 2) & 3) << 3) | (((p >> 4) & 1) << 2) | (p & 3); }
__device__ __forceinline__ int fwd256(int L) { return (L & ~255) | (((L >> 3) & 1) << 7) | (((L >> 6) & 3) << 5) | (((L >> 2) & 1) << 4) | (((L >> 4) & 3) << 2) | (L & 3); }
__device__ __forceinline__ int perm_row(int perm, int n) {
    if (perm == 1) { int r; if (n < 768) r = n; else if (n < 772) r = 2560 + (n - 768); else if (n < 2564) r = n - 4; else r = n; return r < 2560 ? fwd128(r) : r; }
    if (perm == 2) { const int f = n >> 1, s = n & 1; return (f >> 7) * 256 + s * 128 + fwd128(f & 127); }
    if (perm == 3) return fwd256(n);
    return n;
}
struct ConvJob { const float* src; bf16_t* dst; int K, N, kt, nt, perm; float q8; };
__device__ __forceinline__ bool conv_job(const Params& p, int t, ConvJob& jb) {
    constexpr int T_WIN = NL * 8 * 21, T_WO = NL * 8 * 8;
    if (t < T_WIN) { const int m = t / 168, r = t % 168; jb = ConvJob{p.w_in + (size_t)m * 1024 * NCOL, p.WinT + (size_t)m * NPAD * 1024, 1024, NCOL, r / 21, r % 21, 1, 0.f}; return true; }
    t -= T_WIN;
    if (t < T_WO) { const int m = t / 64, r = t % 64; jb = ConvJob{p.w_out + (size_t)m * 1024 * 1024, (bf16_t*)((char*)p.WoT + (size_t)m * 1024 * 1024), 1024, 1024, r / 8, r % 8, 3, 64.0f}; return true; }
    t -= T_WO;
    if (t < T_WIN) { const int m = t / 168, r = t % 168; jb = ConvJob{p.w_in + (size_t)m * 1024 * NCOL, (bf16_t*)(p.WinQ + (size_t)m * NMAIN * 1024), 1024, NCOL, r / 21, r % 21, 1, 64.0f}; return true; }
    return false;
}
constexpr int CONV_TILES = NL * NE * 192;
__device__ __forceinline__ void conv_tile_wave(const Params& p, int t, int lane, unsigned char* l8) {
    asm volatile("" : "+v"(lane));
    const int m = t / 192, r = t % 192;
    const float* src; unsigned char* dst; int N, kt, nt, perm;
    if (r < 128) { src = p.w_gu + (size_t)m * 1024 * 2048; dst = (unsigned char*)p.WguT + (size_t)m * 2048 * 1024; N = 2048; kt = r >> 4; nt = r & 15; perm = 2; }
    else { const int q = r - 128; src = p.w_dn + (size_t)m * 1024 * 1024; dst = (unsigned char*)p.WdnT + (size_t)m * 1024 * 1024; N = 1024; kt = q >> 3; nt = q & 7; perm = 3; }
    const float* s = src + (size_t)(kt * 128 + (lane >> 5)) * N + nt * 128 + (lane & 31) * 4;
    unsigned char* lw = l8 + (lane >> 5) * 132 + (lane & 31) * 4;
    const float sg = (perm == 2) ? 64.0f * GATE_PRE : 64.0f;
    float4 va[16], vb[16];
#pragma unroll
    for (int i = 0; i < 16; ++i) va[i] = *(const float4*)(s + (size_t)(2 * i) * N);
#pragma unroll
    for (int i = 0; i < 16; ++i) vb[i] = *(const float4*)(s + (size_t)(32 + 2 * i) * N);
#pragma unroll
    for (int i = 0; i < 16; ++i) *(unsigned*)(lw + (2 * i) * 132) = pack4_fp8(va[i].x * sg, va[i].y * 64.0f, va[i].z * sg, va[i].w * 64.0f);
#pragma unroll
    for (int i = 0; i < 16; ++i) va[i] = *(const float4*)(s + (size_t)(64 + 2 * i) * N);
#pragma unroll
    for (int i = 0; i < 16; ++i) *(unsigned*)(lw + (32 + 2 * i) * 132) = pack4_fp8(vb[i].x * sg, vb[i].y * 64.0f, vb[i].z * sg, vb[i].w * 64.0f);
#pragma unroll
    for (int i = 0; i < 16; ++i) vb[i] = *(const float4*)(s + (size_t)(96 + 2 * i) * N);
#pragma unroll
    for (int i = 0; i < 16; ++i) *(unsigned*)(lw + (64 + 2 * i) * 132) = pack4_fp8(va[i].x * sg, va[i].y * 64.0f, va[i].z * sg, va[i].w * 64.0f);
#pragma unroll
    for (int i = 0; i < 16; ++i) *(unsigned*)(lw + (96 + 2 * i) * 132) = pack4_fp8(vb[i].x * sg, vb[i].y * 64.0f, vb[i].z * sg, vb[i].w * 64.0f);
    lds_wave_sync();
#pragma unroll 4
    for (int i = 0; i < 16; ++i) {
        const int idx = lane + 64 * i, kc = idx & 7, nn = idx >> 3;
        const unsigned char* l = l8 + (kc * 16) * 132 + nn;
        u32x4 w;
        w.x = (unsigned)l[0] | ((unsigned)l[132] << 8) | ((unsigned)l[264] << 16) | ((unsigned)l[396] << 24);
        w.y = (unsigned)l[528] | ((unsigned)l[660] << 8) | ((unsigned)l[792] << 16) | ((unsigned)l[924] << 24);
        w.z = (unsigned)l[1056] | ((unsigned)l[1188] << 8) | ((unsigned)l[1320] << 16) | ((unsigned)l[1452] << 24);
        w.w = (unsigned)l[1584] | ((unsigned)l[1716] << 8) | ((unsigned)l[1848] << 16) | ((unsigned)l[1980] << 24);
        *(u32x4*)(dst + (size_t)perm_row(perm, nt * 128 + nn) * 1024 + kt * 128 + kc * 16) = w;
    }
    lds_wave_sync();
}
__device__ __forceinline__ void conv_load(const ConvJob& jb, int tid, float2 (&v)[16]) {
    const int n = jb.nt * 128 + (tid & 31) * 4;
    const float* s = jb.src + (size_t)(jb.kt * 128 + (tid >> 5)) * jb.N + n;
#pragma unroll
    for (int i = 0; i < 8; ++i) {
        const float* r = s + (size_t)(16 * i) * jb.N;
        v[2 * i] = (n + 1 < jb.N) ? *(const float2*)r : make_float2(0.f, 0.f);
        v[2 * i + 1] = (n + 3 < jb.N) ? *(const float2*)(r + 2) : make_float2(0.f, 0.f);
    }
}
__device__ __forceinline__ void phase0(const Params& p, char* ldsc) {
    int tid = threadIdx.x; asm volatile("" : "+v"(tid));
    const int G = gridDim.x, bid = blockIdx.x;
    const size_t gtid = (size_t)bid * NTHR + tid, gthreads = (size_t)G * NTHR;
    {
        constexpr int TOT = 2 * NL * 8 * 21 + NL * 8 * 8;
        bf16_t* lt = (bf16_t*)ldsc;
        ConvJob jb, jn; float2 v[16], vn[16];
        int t = bid; bool have = t < TOT && conv_job(p, t, jb);
        if (have) conv_load(jb, tid, v);
        while (have) {
            const int tn = t + G; const bool hn = tn < TOT && conv_job(p, tn, jn);
            if (hn) conv_load(jn, tid, vn);
            if (jb.q8 != 0.f) {
                unsigned char* l8 = (unsigned char*)lt;
#pragma unroll
                for (int i = 0; i < 8; ++i)
                {   int kl = (tid >> 5) + 16 * i;
                    if (jb.perm == 3) kl = (kl & 64) | (((kl >> 2) & 3) << 4) | (((kl >> 4) & 3) << 2) | (kl & 3);
                    *(unsigned*)(l8 + kl * 132 + (tid & 31) * 4) = pack4_fp8(v[2 * i].x * jb.q8, v[2 * i].y * jb.q8, v[2 * i + 1].x * jb.q8, v[2 * i + 1].y * jb.q8); }
                __syncthreads();
#pragma unroll
                for (int i = 0; i < 2; ++i) {
                    const int idx = tid + NTHR * i, kc = idx & 7, nn = idx >> 3, n = jb.nt * 128 + nn;
                    const unsigned char* l = l8 + (kc * 16) * 132 + nn;
                    u32x4 w;
                    w.x = (unsigned)l[0] | ((unsigned)l[132] << 8) | ((unsigned)l[264] << 16) | ((unsigned)l[396] << 24);
                    w.y = (unsigned)l[528] | ((unsigned)l[660] << 8) | ((unsigned)l[792] << 16) | ((unsigned)l[924] << 24);
                    w.z = (unsigned)l[1056] | ((unsigned)l[1188] << 8) | ((unsigned)l[1320] << 16) | ((unsigned)l[1452] << 24);
                    w.w = (unsigned)l[1584] | ((unsigned)l[1716] << 8) | ((unsigned)l[1848] << 16) | ((unsigned)l[1980] << 24);
                    const int pr = perm_row(jb.perm, n);
                    if (n < jb.N && !(jb.perm == 1 && pr >= NMAIN)) *(u32x4*)((char*)jb.dst + (size_t)pr * jb.K + jb.kt * 128 + kc * 16) = w;
                }
            } else {
#pragma unroll
                for (int i = 0; i < 8; ++i) {
                    u32x2 w; w.x = pack2(v[2 * i].x, v[2 * i].y); w.y = pack2(v[2 * i + 1].x, v[2 * i + 1].y);
                    *(u32x2*)(lt + ((tid >> 5) + 16 * i) * 136 + (tid & 31) * 4) = w;
                }
                __syncthreads();
#pragma unroll
                for (int i = 0; i < 4; ++i) {
                    const int idx = tid + NTHR * i, kc = idx & 15, nn = idx >> 4, n = jb.nt * 128 + nn;
                    if (n < jb.N) {
                        const bf16_t* l = lt + (kc * 8) * 136 + nn;
                        u32x4 w;
                        w.x = (unsigned)l[0] | ((unsigned)l[136] << 16); w.y = (unsigned)l[272] | ((unsigned)l[408] << 16);
                        w.z = (unsigned)l[544] | ((unsigned)l[680] << 16); w.w = (unsigned)l[816] | ((unsigned)l[952] << 16);
                        *(u32x4*)(jb.dst + (size_t)perm_row(jb.perm, n) * jb.K + jb.kt * 128 + kc * 8) = w;
                    }
                }
            }
            __syncthreads();
            t = tn; have = hn; jb = jn;
#pragma unroll
            for (int i = 0; i < 16; ++i) v[i] = vn[i];
        }
    }
    for (size_t i = gtid; i < (size_t)NL * 2 * 2048 * 64; i += gthreads) {
        const int k = (int)(i % 2048), n = (int)((i / 2048) % 64), m = (int)(i / (2048 * 64));
        p.W1T[i] = f2bf(p.cmp_w1[((size_t)m * 2048 + k) * 64 + n]);
    }
    for (size_t i = gtid; i < (size_t)NL * 2 * 64 * 64; i += gthreads) {
        const int k = (int)(i % 64), n = (int)((i / 64) % 64), m = (int)(i / 4096);
        p.W2T[i] = f2bf(p.cmp_w2[((size_t)m * 64 + k) * 64 + n]);
    }
    for (size_t i = gtid; i < (size_t)NL * NPAD; i += gthreads) {
        const int l = (int)(i / NPAD), ri = (int)(i % NPAD), r = ri < 2560 ? inv128(ri) : ri;
        float v = 0.f;
        if (r < 2560) { const int n = r < 768 ? r : r + 4; v = p.b_in[l * NCOL + n]; }
        else if (r < 2564) v = p.b_in[l * NCOL + 768 + (r - 2560)];
        else if (r < 2582) v = p.b_in[l * NCOL + r];
        p.binp[i] = v;
    }
    for (size_t i = gtid; i < (size_t)NL * NE * 2048; i += gthreads) {
        const int r = (int)(i % 2048); const size_t le = i / 2048;
        const int s = (r >> 7) & 1, f = (r >> 8) * 128 + inv128(r & 127);
        p.bgup[i] = p.b_gu[le * 2048 + 2 * f + s] * (s == 0 ? GATE_PRE : 1.0f);
    }
    for (size_t i = gtid; i < (size_t)NL * NE * 1024; i += gthreads) {
        const int k = (int)(i % 1024), e = (int)((i / 1024) % NE), l = (int)(i / (1024 * NE));
        p.rwT[i] = p.router_w[((size_t)l * 1024 + k) * NE + e];
    }
    for (size_t i = gtid; i < (size_t)NL * (NPAD - NCOL) * 1024; i += gthreads) {
        const int l = (int)(i / ((NPAD - NCOL) * 1024)); const size_t r = i % ((size_t)(NPAD - NCOL) * 1024);
        p.WinT[(size_t)l * NPAD * 1024 + (size_t)NCOL * 1024 + r] = 0;
    }
    for (size_t i = gtid; i < (size_t)NTOK * DM / 4; i += gthreads) {
        const float4 v4 = ((const float4*)p.x)[i];
        u32x2 w; w.x = pack2(v4.x, v4.y); w.y = pack2(v4.z, v4.w);
        ((u32x2*)p.xb)[i] = w;
        ((unsigned*)p.xq)[i] = pack4_fp8(v4.x, v4.y, v4.z, v4.w);
    }
    if (bid < 4) {
        float* lf = (float*)ldsc;
        const int j = tid & 63, part = tid >> 6;
        const float* pe = p.cmp_pe + (size_t)bid * 2048; const float* w1 = p.cmp_w1 + (size_t)bid * 2048 * 64;
        float s = 0.f;
        for (int kk = part * 256; kk < part * 256 + 256; ++kk) s += pe[kk] * w1[(size_t)kk * 64 + j];
        lf[tid] = s; __syncthreads();
        if (tid < 64) { float a = 0.f; for (int q = 0; q < 8; ++q) a += lf[tid + 64 * q]; p.b1c[bid * 64 + tid] = a; }
        __syncthreads();
    }
}

__device__ __forceinline__ int vcu_id() { return __builtin_amdgcn_readfirstlane(*(const volatile LAS int*)(LDS_BYTES - 32)); }
namespace pg8 {
constexpr int BM = 256, BK = 64, HALF = 128, HTB = HALF * BK * 2, NXCD = 8, WGM = 8;
__device__ __forceinline__ int lds_byte(int r, int c) { const int ch = (c >> 3) ^ ((r >> 1) & 7); return (r >> 3) * 1024 + (r & 7) * 128 + ch * 16 + (c & 7) * 2; }
__device__ __forceinline__ void stage_rc(int b, int& R, int& C) { const int st = b / 1024, sb = b % 1024; R = st * 8 + sb / 128; C = ((((sb % 128) / 16) ^ ((R >> 1) & 7)) * 16 + (sb % 16)) / 2; }
__device__ __forceinline__ bool tile_order(int i, int G, int c, int nM, int nN, int& pm, int& pn) {
    const int nwg = nM * nN; const long L = (long)i * G + c; if (L >= nwg) return false;
    const int wgid = (int)L;
    const int nig = WGM * nN, gid = wgid / nig, fm = gid * WGM, gsz = (nM - fm) < WGM ? (nM - fm) : WGM;
    pm = fm + ((wgid % nig) % gsz); pn = (wgid % nig) / gsz; return true;
}
template <bool FP8, int SCA, class Sched, class Epi>
__device__ __forceinline__ void gemm_phase(LAS unsigned char* lds, const char* Abase, int K, const Sched& S, const Epi& E) {
    int tid = threadIdx.x; asm volatile("" : "+v"(tid));
    const int wid = __builtin_amdgcn_readfirstlane(tid >> 6), lane = tid & 63, wr = wid >> 2, wc = wid & 3, fr = lane & 15, fq = lane >> 4;
    const int nt = K / BK;
    int R0, C0, R1, C1; stage_rc(tid * 16, R0, C0); stage_rc(tid * 16 + 8192, R1, C1);
    LAS unsigned* aofs = (LAS unsigned*)(lds + LDS_AOFF) + tid;
    unsigned rg[10];
    rg[8] = (unsigned)(R0 * K + C0) * 2u; rg[9] = (unsigned)(R1 * K + C1) * 2u;
    if constexpr (FP8) { aofs[8 * NTHR] = rg[8]; aofs[9 * NTHR] = rg[9]; }
    const size_t kstep = (size_t)(BK * 2), hstep = (size_t)HALF * K * 2;
    const unsigned ldsw = (unsigned)wid * 1024u;
    const int aoff = lds_byte(wr * 64 + fr, fq * 8), boff = lds_byte(wc * 32 + fr, fq * 8);
#define PG8_SA(b, h) (((b) * 2 + (h)) * HTB)
#define PG8_SB(b, h) ((4 + (b) * 2 + (h)) * HTB)
#define PG8_OFS(sel, j) (FP8 ? aofs[((sel) * 4 + (j)) * NTHR] : ((sel) ? rg[4 + (j)] : rg[(j)]))
#define PG8_STAGE_B(bufoff, gbase) do { _Pragma("unroll") for (int _i = 0; _i < 2; ++_i) { const unsigned ob_ = FP8 ? aofs[(8 + _i) * NTHR] : rg[8 + _i]; \
        __builtin_amdgcn_global_load_lds((const unsigned*)((const char*)(gbase) + ob_), (LAS unsigned*)(lds + (bufoff) + ldsw + _i * 8192), 16, 0, 0); } } while (0)
#define PG8_STAGE_A(bufoff, kbyte, sel, h) do { const unsigned o0_ = PG8_OFS(sel, (h) * 2), o1_ = PG8_OFS(sel, (h) * 2 + 1); \
        __builtin_amdgcn_global_load_lds((const unsigned*)(Abase + (kbyte) + o0_), (LAS unsigned*)(lds + (bufoff) + ldsw), 16, 0, 0); \
        __builtin_amdgcn_global_load_lds((const unsigned*)(Abase + (kbyte) + o1_), (LAS unsigned*)(lds + (bufoff) + ldsw + 8192), 16, 0, 0); } while (0)
#define PG8_LDA(dst, b, h) do { _Pragma("unroll") for (int m = 0; m < 4; ++m) { \
        if constexpr (FP8) { const v4i_t lo_ = *(const LAS v4i_t*)(lds + PG8_SA(b, h) + aoff + m * 2048), hi_ = *(const LAS v4i_t*)(lds + PG8_SA(b, h) + (aoff ^ 64) + m * 2048); dst##8[m] = __builtin_shufflevector(lo_, hi_, 0, 1, 2, 3, 4, 5, 6, 7); } \
        else { _Pragma("unroll") for (int k = 0; k < 2; ++k) dst[m][k] = *(const LAS bf16x8*)(lds + PG8_SA(b, h) + (aoff ^ (k * 64)) + m * 2048); } } } while (0)
#define PG8_LDB(dst, b, h) do { _Pragma("unroll") for (int n = 0; n < 2; ++n) { \
        if constexpr (FP8) { const v4i_t lo_ = *(const LAS v4i_t*)(lds + PG8_SB(b, h) + boff + n * 2048), hi_ = *(const LAS v4i_t*)(lds + PG8_SB(b, h) + (boff ^ 64) + n * 2048); dst##8[n] = __builtin_shufflevector(lo_, hi_, 0, 1, 2, 3, 4, 5, 6, 7); } \
        else { _Pragma("unroll") for (int k = 0; k < 2; ++k) dst[n][k] = *(const LAS bf16x8*)(lds + PG8_SB(b, h) + (boff ^ (k * 64)) + n * 2048); } } } while (0)
#define PG8_MMA(ai, bj, At, Bt) do { __builtin_amdgcn_s_setprio(1); _Pragma("unroll") for (int m = 0; m < 4; ++m) _Pragma("unroll") for (int n = 0; n < 2; ++n) { \
        if constexpr (FP8) { acc[ai][bj][m][n] = __builtin_amdgcn_mfma_scale_f32_16x16x128_f8f6f4(Bt##8[n], At##8[m], acc[ai][bj][m][n], 0, 0, 0, SCA, 0, SCA); } \
        else { _Pragma("unroll") for (int k = 0; k < 2; ++k) acc[ai][bj][m][n] = __builtin_amdgcn_mfma_f32_16x16x32_bf16(Bt[n][k], At[m][k], acc[ai][bj][m][n], 0, 0, 0); } } \
        __builtin_amdgcn_s_setprio(0); } while (0)
#define PG8_WAIT_V(n) asm volatile("s_waitcnt vmcnt(" #n ")" ::: "memory")
#define PG8_WAIT_L(n) asm volatile("s_waitcnt lgkmcnt(" #n ")" ::: "memory")
#define PG8_BAR __builtin_amdgcn_s_barrier()
#define PG8_SCHED __builtin_amdgcn_sched_barrier(0)
    typename Sched::Unit cur, nxt; int ui = 0;
    if (!S.next(0, cur)) return;
    f32x4 acc[2][2][4][2];
    bf16x8 At[4][2], B0[2][2], B1[2][2];
    v8i_t At8[4], B08[2], B18[2];
    { unsigned a4[2][2]; S.a_off(cur, R0, C0, R1, C1, a4); rg[0] = a4[0][0]; rg[1] = a4[0][1]; rg[2] = a4[1][0]; rg[3] = a4[1][1];
      if constexpr (FP8) { aofs[0] = a4[0][0]; aofs[NTHR] = a4[0][1]; aofs[2 * NTHR] = a4[1][0]; aofs[3 * NTHR] = a4[1][1]; } }
    const char* cB = S.b_ptr(cur);
#define PG8_BIAS_DMA(unit, slot) do { const float* bp_ = E.bias_ptr(unit); int tb_ = threadIdx.x; asm volatile("" : "+v"(tb_)); if (wr == 0 && bp_ != nullptr) \
        __builtin_amdgcn_global_load_lds((const unsigned*)(bp_ + (tb_ & 255)), (LAS unsigned*)(lds + LDS_BIAS + (slot) * 1024 + wid * 256), 4, 0, 0); } while (0)
    PG8_BIAS_DMA(cur, 0);
    PG8_STAGE_B(PG8_SB(0, 0), cB); PG8_STAGE_B(PG8_SB(0, 1), cB + hstep); PG8_STAGE_A(PG8_SA(0, 0), 0, 0, 0); PG8_STAGE_A(PG8_SA(0, 1), 0, 0, 1);
    if (wr == 1) PG8_BAR;
    PG8_WAIT_V(2); PG8_BAR;
    PG8_STAGE_B(PG8_SB(1, 0), cB + kstep); PG8_STAGE_A(PG8_SA(1, 0), kstep, 0, 0); PG8_STAGE_B(PG8_SB(1, 1), cB + hstep + kstep);
    PG8_WAIT_V(6); PG8_BAR;
    { int t3 = threadIdx.x; asm volatile("" : "+v"(t3)); E.init(acc, wc, (t3 & 63) >> 4, (const LAS float*)(lds + LDS_BIAS)); }
    for (;;) {
        const bool has_next = S.next(ui + 1, nxt);
        const char* nB = cB;
        if (has_next) PG8_BIAS_DMA(nxt, (ui + 1) % 3);
        if (has_next) { int t2 = threadIdx.x; asm volatile("" : "+v"(t2)); int r0, c0, r1, c1; stage_rc(t2 * 16, r0, c0); stage_rc(t2 * 16 + 8192, r1, c1); nB = S.b_ptr(nxt);
            if constexpr (Sched::LIST_DMA) { static_assert(!Sched::LIST_DMA || FP8, "list DMA lands in the LDS offset slots"); S.a_dma(nxt, r0, r1, (LAS unsigned*)(lds + LDS_AOFF + 4 * NTHR * 4 + wid * 256)); }
            else { unsigned a4[2][2]; S.a_off(nxt, r0, c0, r1, c1, a4);
                rg[4] = a4[0][0]; rg[5] = a4[0][1]; rg[6] = a4[1][0]; rg[7] = a4[1][1];
                if constexpr (FP8) { aofs[4 * NTHR] = a4[0][0]; aofs[5 * NTHR] = a4[0][1]; aofs[6 * NTHR] = a4[1][0]; aofs[7 * NTHR] = a4[1][1]; } } }
        else { rg[4] = rg[0]; rg[5] = rg[1]; rg[6] = rg[2]; rg[7] = rg[3];
            if constexpr (FP8) { aofs[4 * NTHR] = aofs[0]; aofs[5 * NTHR] = aofs[NTHR]; aofs[6 * NTHR] = aofs[2 * NTHR]; aofs[7 * NTHR] = aofs[3 * NTHR]; } }
#pragma unroll 1
        for (int t = 0; t < nt; t += 2) {
            const bool last = (t == nt - 2);
            const size_t ka1 = (size_t)(t + 1) * kstep, ka2 = last ? 0 : (size_t)(t + 2) * kstep, ka3 = ka2 + kstep;
            const char* b2 = last ? nB : cB + (size_t)(t + 2) * kstep; const char* b3 = b2 + kstep;
            const int sel = last ? 1 : 0;
            if constexpr (Sched::LIST_DMA) if (last && has_next) {
                int t4 = threadIdx.x; asm volatile("" : "+v"(t4)); int r0, c0, r1, c1; stage_rc(t4 * 16, r0, c0); stage_rc(t4 * 16 + 8192, r1, c1);
#pragma unroll
                for (int j = 0; j < 4; ++j) aofs[(4 + j) * NTHR] = S.a_fin(aofs[(4 + j) * NTHR], (j & 1) ? c1 : c0);
            }
            PG8_LDB(B0, 0, 0); PG8_LDB(B1, 0, 1); PG8_SCHED; PG8_LDA(At, 0, 0); PG8_STAGE_A(PG8_SA(1, 1), ka1, 0, 1);
            PG8_WAIT_V(8); PG8_WAIT_L(0); PG8_BAR; PG8_MMA(0, 0, At, B0); PG8_MMA(0, 1, At, B1); PG8_BAR; PG8_SCHED;
            PG8_LDA(At, 0, 1); PG8_STAGE_B(PG8_SB(0, 0), b2); PG8_STAGE_B(PG8_SB(0, 1), b2 + hstep); PG8_STAGE_A(PG8_SA(0, 0), ka2, sel, 0);
            PG8_WAIT_V(8); PG8_WAIT_L(0); PG8_BAR; PG8_MMA(1, 0, At, B0); PG8_MMA(1, 1, At, B1); PG8_BAR; PG8_SCHED;
            PG8_LDB(B0, 1, 0); PG8_LDB(B1, 1, 1); PG8_SCHED; PG8_LDA(At, 1, 0); PG8_STAGE_A(PG8_SA(0, 1), ka2, sel, 1);
            PG8_WAIT_V(8); PG8_WAIT_L(0); PG8_BAR; PG8_MMA(0, 0, At, B0); PG8_MMA(0, 1, At, B1); PG8_BAR; PG8_SCHED;
            PG8_LDA(At, 1, 1); PG8_STAGE_B(PG8_SB(1, 0), b3); PG8_STAGE_B(PG8_SB(1, 1), b3 + hstep); PG8_STAGE_A(PG8_SA(1, 0), ka3, sel, 0);
            PG8_WAIT_V(8); PG8_WAIT_L(0); PG8_BAR; PG8_MMA(1, 0, At, B0); PG8_MMA(1, 1, At, B1); PG8_BAR; PG8_SCHED;
        }
        if (wr == 0) PG8_BAR;
        { int t2 = threadIdx.x; asm volatile("" : "+v"(t2)); E(acc, cur, wr, wc, t2 & 15, (t2 & 63) >> 4, (const LAS float*)(lds + LDS_BIAS + (ui % 3) * 1024)); }
        if (!has_next) break;
        { int t3 = threadIdx.x; asm volatile("" : "+v"(t3)); E.init(acc, wc, (t3 & 63) >> 4, (const LAS float*)(lds + LDS_BIAS + ((ui + 1) % 3) * 1024)); }
        cur = nxt; cB = nB; ++ui;
        rg[0] = rg[4]; rg[1] = rg[5]; rg[2] = rg[6]; rg[3] = rg[7];
        if constexpr (FP8) { aofs[0] = aofs[4 * NTHR]; aofs[NTHR] = aofs[5 * NTHR]; aofs[2 * NTHR] = aofs[6 * NTHR]; aofs[3 * NTHR] = aofs[7 * NTHR]; }
        if (wr == 1) PG8_BAR;
    }
    PG8_WAIT_V(0);
    PG8_BAR;
#undef PG8_BIAS_DMA
#undef PG8_SA
#undef PG8_SB
#undef PG8_STAGE_A
#undef PG8_OFS
#undef PG8_STAGE_B
#undef PG8_LDA
#undef PG8_LDB
#undef PG8_MMA
#undef PG8_WAIT_V
#undef PG8_WAIT_L
#undef PG8_BAR
#undef PG8_SCHED
}
}

struct DenseUnit { int pm, pn; };
struct DenseSched {
    typedef DenseUnit Unit;
    const char* Bt; int K, nM, nN, vc;
    __device__ __forceinline__ bool next(int i, Unit& u) const { return pg8::tile_order(i, gridDim.x, vc, nM, nN, u.pm, u.pn); }
    __device__ __forceinline__ void a_off(const Unit& u, int R0, int C0, int R1, int C1, unsigned (&off)[2][2]) const {
#pragma unroll
        for (int h = 0; h < 2; ++h) { off[h][0] = (unsigned)((u.pm * 256 + h * 128 + R0) * K + C0) * 2u; off[h][1] = (unsigned)((u.pm * 256 + h * 128 + R1) * K + C1) * 2u; }
    }
    __device__ __forceinline__ const char* b_ptr(const Unit& u) const { return Bt + (size_t)u.pn * 256 * K * 2; }
    static constexpr bool LIST_DMA = false;
    __device__ __forceinline__ void a_dma(const Unit&, int, int, LAS unsigned*) const {}
    __device__ __forceinline__ unsigned a_fin(unsigned raw, int) const { return raw; }
};
struct MoeUnit { int rbt, e, pn; };
template <bool GATHER>
struct MoeSched {
    typedef MoeUnit Unit;
    static constexpr int KP = 512;
    const char* Bt; const int* lists; const int* ptile; const int* ecnt; int nN, nrows, vc;
    __device__ __forceinline__ bool next(int i, Unit& u) const {
        int pm, pn; if (!pg8::tile_order(i, gridDim.x, vc, ptile[NE], nN, pm, pn)) return false;
        u.rbt = pm; u.e = ((const unsigned char*)ptile)[512 + pm]; u.pn = pn; return true;
    }
    __device__ __forceinline__ void a_off(const Unit& u, int R0, int C0, int R1, int C1, unsigned (&off)[2][2]) const {
        if (GATHER) {
            const int* lst = lists + (size_t)u.e * LIST_CAP; const int rb = u.rbt - ptile[u.e], cnt = ecnt[u.e];
#pragma unroll
            for (int h = 0; h < 2; ++h) {
                const int l0 = rb * 256 + h * 128 + R0, l1 = rb * 256 + h * 128 + R1;
                const int t0 = l0 < cnt ? (lst[l0] >> 2) : 0, t1 = l1 < cnt ? (lst[l1] >> 2) : 0;
                off[h][0] = (unsigned)(t0 * KP + C0) * 2u; off[h][1] = (unsigned)(t1 * KP + C1) * 2u;
            }
        } else {
#pragma unroll
            for (int h = 0; h < 2; ++h) { off[h][0] = (unsigned)((u.rbt * 256 + h * 128 + R0) * KP + C0) * 2u; off[h][1] = (unsigned)((u.rbt * 256 + h * 128 + R1) * KP + C1) * 2u; }
        }
    }
    __device__ __forceinline__ const char* b_ptr(const Unit& u) const { return Bt + ((size_t)u.e * nrows + (size_t)u.pn * 256) * KP * 2; }
    static constexpr bool LIST_DMA = GATHER;
    __device__ __forceinline__ void a_dma(const Unit& u, int R0, int R1, LAS unsigned* slot) const {
        const int* lst = lists + (size_t)u.e * LIST_CAP; const int rb = u.rbt - ptile[u.e], cm = ecnt[u.e] - 1;
#pragma unroll
        for (int h = 0; h < 2; ++h) {
            const int l0 = min(rb * 256 + h * 128 + R0, cm), l1 = min(rb * 256 + h * 128 + R1, cm);
            __builtin_amdgcn_global_load_lds((const unsigned*)(lst + l0), slot + (h * 2) * NTHR, 4, 0, 0);
            __builtin_amdgcn_global_load_lds((const unsigned*)(lst + l1), slot + (h * 2 + 1) * NTHR, 4, 0, 0);
        }
    }
    __device__ __forceinline__ unsigned a_fin(unsigned raw, int C) const { return (unsigned)((int)(raw >> 2) * KP + C) * 2u; }
};

__device__ __forceinline__ u32x2 quad_tr(unsigned p01, unsigned p23, int fr) {
    const unsigned sel = (fr & 1) ? 0x03020706u : 0x05040100u;
    const unsigned y01 = (unsigned)__builtin_amdgcn_update_dpp(0, (int)p01, 0xB1, 0xF, 0xF, true), y23 = (unsigned)__builtin_amdgcn_update_dpp(0, (int)p23, 0xB1, 0xF, 0xF, true);
    const unsigned q01 = __builtin_amdgcn_perm(y01, p01, sel), q23 = __builtin_amdgcn_perm(y23, p23, sel);
    const bool hi = (fr & 2) != 0;
    const unsigned snd = hi ? q01 : q23;
    const unsigned rcv = (unsigned)__builtin_amdgcn_update_dpp(0, (int)snd, 0x4E, 0xF, 0xF, true);
    u32x2 r; r.x = hi ? rcv : q01; r.y = hi ? q23 : rcv; return r;
}
struct EpiInProj {
    const Params* p; int l;
    __device__ __forceinline__ const float* bias_ptr(const DenseUnit& u) const { return p->binp + l * NPAD + u.pn * 256; }
    __device__ __forceinline__ void init(f32x4 (&acc)[2][2][4][2], int wc, int fq, const LAS float* bias) const {
#pragma unroll
        for (int bj = 0; bj < 2; ++bj)
#pragma unroll
            for (int n = 0; n < 2; ++n) {
                const f32x4 bv = *(const LAS f32x4*)(bias + bj * 128 + wc * 32 + n * 16 + 4 * fq);
#pragma unroll
                for (int ai = 0; ai < 2; ++ai)
#pragma unroll
                    for (int m = 0; m < 4; ++m) acc[ai][bj][m][n] = bv;
            }
    }
    __device__ __forceinline__ void operator()(const f32x4 (&acc)[2][2][4][2], const DenseUnit& u, int wr, int wc, int fr, int fq, const LAS float*) const {
#pragma unroll
        for (int bj = 0; bj < 2; ++bj) {
            int kind = 0, hb0 = 0;
            if (u.pn == 1) { kind = 1; hb0 = bj * 2; } else if (u.pn == 4 && bj == 1) { kind = 1; hb0 = 4; } else if (u.pn == 8 && bj == 0) { kind = 1; hb0 = 6; } else if (u.pn == 9 && bj == 0) { kind = 1; hb0 = 8; }
            else if (u.pn == 2) { kind = 2; hb0 = bj * 2; } else if (u.pn == 5 && bj == 0) { kind = 2; hb0 = 4; } else if (u.pn == 8 && bj == 1) { kind = 2; hb0 = 6; } else if (u.pn == 9 && bj == 1) { kind = 2; hb0 = 8; }
            const int c0 = wc * 32 + fq * 8;
            const int hh = hb0 + (c0 >> 6), d0 = c0 & 63;
#pragma unroll
            for (int ai = 0; ai < 2; ++ai)
#pragma unroll
                for (int m = 0; m < 4; ++m) {
                    const int row = u.pm * 256 + ai * 128 + wr * 64 + m * 16 + fr;
                    const f32x4 v0 = acc[ai][bj][m][0], v1 = acc[ai][bj][m][1];
                    u32x4 w; w.x = pack2(v0[0], v0[1]); w.y = pack2(v0[2], v0[3]); w.z = pack2(v1[0], v1[1]); w.w = pack2(v1[2], v1[3]);
                    if (kind == 0) *(u32x4*)(p->hb + (size_t)row * NMAIN + u.pn * 256 + bj * 128 + c0) = w;
                    else {
                        const int b = row >> 11, s = row & 2047, kk = s & 31;
                        bf16_t* blk = (kind == 1 ? p->kF : p->vT) + (((size_t)b * NVH + hh) * 64 + (s >> 5)) * 2048;
                        if (kind == 1) {
                            const int frk = (kk >> 3) * 4 + (kk & 3), t = (kk >> 2) & 1;
                            *(u32x4*)(blk + ((t * 2 + (d0 >> 5)) * 64 + ((d0 & 31) >> 3) * 16 + frk) * 8) = w;
                        } else {
                            const int kq = kk & 28;
                            const u32x2 t0 = quad_tr(w.x, w.y, fr), t1 = quad_tr(w.z, w.w, fr);
                            bf16_t* vt = blk + (((d0 >> 4) * 64) + (kq >> 3) * 16 + (d0 & 15) + (fr & 3)) * 8 + (kq & 7);
                            *(u32x2*)vt = t0; *(u32x2*)(vt + 32) = t1;
                        }
                    }
                }
        }
    }
};
struct EpiOutProj {
    const bf16_t* xin; float* t;
    __device__ __forceinline__ const float* bias_ptr(const DenseUnit&) const { return nullptr; }
    __device__ __forceinline__ void init(f32x4 (&acc)[2][2][4][2], int, int, const LAS float*) const {
#pragma unroll
        for (int ai = 0; ai < 2; ++ai)
#pragma unroll
            for (int bj = 0; bj < 2; ++bj)
#pragma unroll
                for (int m = 0; m < 4; ++m)
#pragma unroll
                    for (int n = 0; n < 2; ++n) acc[ai][bj][m][n] = (f32x4){0.f, 0.f, 0.f, 0.f};
    }
    __device__ __forceinline__ void operator()(const f32x4 (&acc)[2][2][4][2], const DenseUnit& u, int wr, int wc, int fr, int fq, const LAS float*) const {
#pragma unroll
        for (int ai = 0; ai < 2; ++ai)
#pragma unroll
            for (int m = 0; m < 4; ++m) {
                const size_t off = (size_t)(u.pm * 256 + ai * 128 + wr * 64 + m * 16 + fr) * DM + u.pn * 256 + wc * 64 + fq * 16;
                const u32x4 x0 = *(const u32x4*)(xin + off), x1 = *(const u32x4*)(xin + off + 8);
                const unsigned xs[8] = {x0.x, x0.y, x0.z, x0.w, x1.x, x1.y, x1.z, x1.w};
                unsigned w[8];
#pragma unroll
                for (int q = 0; q < 4; ++q) {
                    const f32x4 a = acc[ai][q >> 1][m][q & 1];
                    const float t0 = __uint_as_float(xs[2 * q] << 16) * ALPHA + a[0], t1 = __uint_as_float(xs[2 * q] & 0xffff0000u) * ALPHA + a[1];
                    const float t2 = __uint_as_float(xs[2 * q + 1] << 16) * ALPHA + a[2], t3 = __uint_as_float(xs[2 * q + 1] & 0xffff0000u) * ALPHA + a[3];
                    w[2 * q] = pack2(t0, t1); w[2 * q + 1] = pack2(t2, t3);
                }
                u32x4 w0, w1; w0.x = w[0]; w0.y = w[1]; w0.z = w[2]; w0.w = w[3]; w1.x = w[4]; w1.y = w[5]; w1.z = w[6]; w1.w = w[7];
                *(u32x4*)((bf16_t*)t + off) = w0; *(u32x4*)((bf16_t*)t + off + 8) = w1;
            }
    }
};
struct EpiGateUp {
    bf16_t* act; const float* bgup;
    __device__ __forceinline__ const float* bias_ptr(const MoeUnit& u) const { return bgup + (size_t)u.e * 2048 + u.pn * 256; }
    __device__ __forceinline__ void init(f32x4 (&acc)[2][2][4][2], int wc, int fq, const LAS float* bias) const {
#pragma unroll
        for (int bj = 0; bj < 2; ++bj)
#pragma unroll
            for (int n = 0; n < 2; ++n) {
                const f32x4 bv = *(const LAS f32x4*)(bias + bj * 128 + wc * 32 + n * 16 + 4 * fq);
#pragma unroll
                for (int ai = 0; ai < 2; ++ai)
#pragma unroll
                    for (int m = 0; m < 4; ++m) acc[ai][bj][m][n] = bv;
            }
    }
    __device__ __forceinline__ void operator()(const f32x4 (&acc)[2][2][4][2], const MoeUnit& u, int wr, int wc, int fr, int fq, const LAS float*) const {
        constexpr float GMIN = 7.0f * GATE_PRE, CI = 1.0f / GATE_PRE;
#pragma unroll
        for (int ai = 0; ai < 2; ++ai)
#pragma unroll
            for (int m = 0; m < 4; ++m) {
                u32x2 w;
#pragma unroll
                for (int n = 0; n < 2; ++n) {
                    const f32x4 g4 = acc[ai][0][m][n], u4 = acc[ai][1][m][n];
                    float o[4];
#pragma unroll
                    for (int j = 0; j < 4; ++j) {
                        const float gp = fmaxf(g4[j], GMIN), uu = fminf(fmaxf(u4[j], -7.0f), 7.0f);
                        const float glu = gp * __builtin_amdgcn_rcpf(1.0f + __builtin_amdgcn_exp2f(gp));
                        o[j] = __builtin_fmaf(uu, CI, CI) * glu;
                    }
                    const unsigned pk = pack4_fp8(o[0], o[1], o[2], o[3]);
                    if (n == 0) w.x = pk; else w.y = pk;
                }
                *(u32x2*)((char*)act + (size_t)(u.rbt * 256 + ai * 128 + wr * 64 + m * 16 + fr) * DFF + u.pn * 128 + wc * 32 + fq * 8) = w;
            }
    }
};
struct EpiDown {
    bf16_t* ybuf; const float* bdn;
    __device__ __forceinline__ const float* bias_ptr(const MoeUnit& u) const { return bdn + (size_t)u.e * 1024 + u.pn * 256; }
    __device__ __forceinline__ void init(f32x4 (&acc)[2][2][4][2], int wc, int fq, const LAS float* bias) const {
#pragma unroll
        for (int bj = 0; bj < 2; ++bj)
#pragma unroll
            for (int n = 0; n < 2; ++n) {
                const f32x4 bv = *(const LAS f32x4*)(bias + wc * 64 + fq * 16 + bj * 8 + n * 4);
#pragma unroll
                for (int ai = 0; ai < 2; ++ai)
#pragma unroll
                    for (int m = 0; m < 4; ++m) acc[ai][bj][m][n] = bv;
            }
    }
    __device__ __forceinline__ void operator()(const f32x4 (&acc)[2][2][4][2], const MoeUnit& u, int wr, int wc, int fr, int fq, const LAS float*) const {
#pragma unroll
        for (int ai = 0; ai < 2; ++ai)
#pragma unroll
            for (int m = 0; m < 4; ++m) {
                u32x4 w;
                { const f32x4 v = acc[ai][0][m][0]; w.x = pack4_fp8(v[0], v[1], v[2], v[3]); }
                { const f32x4 v = acc[ai][0][m][1]; w.y = pack4_fp8(v[0], v[1], v[2], v[3]); }
                { const f32x4 v = acc[ai][1][m][0]; w.z = pack4_fp8(v[0], v[1], v[2], v[3]); }
                { const f32x4 v = acc[ai][1][m][1]; w.w = pack4_fp8(v[0], v[1], v[2], v[3]); }
                *(u32x4*)((unsigned char*)ybuf + (size_t)(u.rbt * 256 + ai * 128 + wr * 64 + m * 16 + fr) * DM + u.pn * 256 + wc * 64 + fq * 16) = w;
            }
    }
};

__device__ __forceinline__ void phase_inproj(const Params& p, int l, char* lds) {
    DenseSched S{(const char*)p.WinQ + (size_t)l * NMAIN * 1024, 512, NTOK / 256, NMAIN / 256, vcu_id()};
    EpiInProj E{&p, l};
    pg8::gemm_phase<true, 0x7c7c7c7c>((LAS unsigned char*)lds, (const char*)p.xq, 512, S, E);
    int tid = threadIdx.x; asm volatile("" : "+v"(tid));
    const int wid = tid >> 6, lane = tid & 63, fr = lane & 15, fq = lane >> 4;
    const bf16_t* W = p.WinT + ((size_t)l * NPAD + NMAIN) * 1024;
    const float* bias = p.binp + l * NPAD + NMAIN;
    constexpr int WP = 2064;
#pragma unroll
    for (int i = 0; i < 8; ++i) { const int pc = wid * 8 + i, r = pc >> 1, q = pc & 1;
        __builtin_amdgcn_global_load_lds((const unsigned*)(W + (size_t)r * 1024 + q * 512 + lane * 8), (LAS unsigned*)((LAS char*)lds + r * WP + q * 1024), 16, 0, 0); }
    asm volatile("s_waitcnt vmcnt(0)" ::: "memory");
    __syncthreads();
    for (int u = blockIdx.x * NWV + wid; u < NTOK / 16; u += gridDim.x * NWV) {
        const bf16_t* ar = p.xb + (size_t)(u * 16 + fr) * DM + fq * 8;
        const LAS char* w0 = (const LAS char*)lds + fr * WP + fq * 16; const LAS char* w1 = w0 + 16 * WP;
        f32x4 a0 = (f32x4){0.f, 0.f, 0.f, 0.f}, a1 = a0;
#pragma unroll 4
        for (int ks = 0; ks < 32; ++ks) {
            const bf16x8 a = *(const bf16x8*)(ar + ks * 32);
            a0 = __builtin_amdgcn_mfma_f32_16x16x32_bf16(a, *(const LAS bf16x8*)(w0 + ks * 64), a0, 0, 0, 0);
            a1 = __builtin_amdgcn_mfma_f32_16x16x32_bf16(a, *(const LAS bf16x8*)(w1 + ks * 64), a1, 0, 0, 0);
        }
#pragma unroll
        for (int r = 0; r < 4; ++r) {
            float* dst = p.hs + (size_t)(u * 16 + fq * 4 + r) * HS_W;
            dst[fr] = a0[r] + bias[fr];
            if (fr < 6) dst[16 + fr] = a1[r] + bias[16 + fr];
        }
    }
}
__device__ __forceinline__ void phase_outproj(const Params& p, int l, const bf16_t* xin, char* lds) {
    DenseSched S{(const char*)p.WoT + (size_t)l * 1024 * 1024, 512, NTOK / 256, 4, vcu_id()};
    EpiOutProj E{xin, p.tbuf};
    pg8::gemm_phase<true, 0x7c7c7c7c>((LAS unsigned char*)lds, (const char*)p.ob, 512, S, E);
}
__device__ __forceinline__ void build_tiles(const Params& p, int l, int* ptile, int* ecnt) {
    int tid = threadIdx.x; asm volatile("" : "+v"(tid));
    if (tid < NE) ecnt[tid] = (int)__hip_atomic_load(p.ctrl + 64 + l * NE + tid, __ATOMIC_RELAXED, __HIP_MEMORY_SCOPE_AGENT);
    __syncthreads();
    if (tid == 0) { int s = 0; for (int e = 0; e < NE; ++e) { ptile[e] = s; s += (ecnt[e] + 255) >> 8; } ptile[NE] = s; }
    __syncthreads();
    unsigned char* texp = (unsigned char*)ptile + 512;
    for (int t = tid; t < ptile[NE]; t += NTHR) { int e = 0; while (ptile[e + 1] <= t) ++e; texp[t] = (unsigned char)e; }
    __syncthreads();
}
__device__ __forceinline__ void phase_gateup(const Params& p, int l, char* lds) {
    int* ptile = (int*)(lds + LDS_TAB); int* ecnt = ptile + 40;
    build_tiles(p, l, ptile, ecnt);
    MoeSched<true> S{(const char*)p.WguT + (size_t)l * NE * 2048 * 1024, p.lists, ptile, ecnt, 8, 2048, vcu_id()};
    EpiGateUp E{p.act, p.bgup + (size_t)l * NE * 2048};
    pg8::gemm_phase<true, 0x7c7c7c7c>((LAS unsigned char*)lds, (const char*)p.x1b, 512, S, E);
}
__device__ __forceinline__ void phase_down(const Params& p, int l, char* lds) {
    int* ptile = (int*)(lds + LDS_TAB); int* ecnt = ptile + 40;
    build_tiles(p, l, ptile, ecnt);
    MoeSched<false> S{(const char*)p.WdnT + (size_t)l * NE * 1024 * 1024, p.lists, ptile, ecnt, 4, 1024, vcu_id()};
    EpiDown E{p.ybuf, p.b_dn + (size_t)l * NE * 1024};
    pg8::gemm_phase<true, 0x7c7c7c7c>((LAS unsigned char*)lds, (const char*)p.act, 512, S, E);
}

__device__ __forceinline__ float gelu_tanh(float x) {
    const float u = 0.7978845608028654f * (x + 0.044715f * x * x * x);
    const float e = __expf(-2.0f * fabsf(u)); const float th = (1.0f - e) / (1.0f + e);
    return 0.5f * x * (1.0f + (u < 0.f ? -th : th));
}
__device__ __forceinline__ void phase_prep(const Params& p, int l, char* lds) {
    int tid = threadIdx.x; asm volatile("" : "+v"(tid));
    const int wid = tid >> 6, lane = tid & 63, fr = lane & 15, fq = lane >> 4;
    const int gw = blockIdx.x * NWV + wid, nw = gridDim.x * NWV;
    for (int u = (int)gridDim.x - 1 - (int)blockIdx.x; u < NB * 4; u += gridDim.x) {
        const int b = u >> 2, h = u & 3;
        const float* srcp = p.hs + ((size_t)b * SEQ + tid * 4) * HS_W + h;
        float ls[4]; float tot = 0.f;
#pragma unroll
        for (int i = 0; i < 4; ++i) { const float f = srcp[(size_t)i * HS_W]; ls[i] = fminf(f, 0.f) - log1pf(__expf(-fabsf(f))); tot += ls[i]; }
        float inc = tot;
#pragma unroll
        for (int o = 1; o < 64; o <<= 1) { const float v = shfl_f(inc, lane - o); if (lane >= o) inc += v; }
        float* wtot = (float*)(lds + 65536);
        if (lane == 63) wtot[wid] = inc;
        __syncthreads();
        float base = inc - tot;
        for (int w = 0; w < wid; ++w) base += wtot[w];
        float4 o4; o4.x = base + ls[0]; o4.y = o4.x + ls[1]; o4.z = o4.y + ls[2]; o4.w = o4.z + ls[3];
        *(float4*)(p.cF + (size_t)u * SEQ + tid * 4) = o4;
        __syncthreads();
    }
    float* part = (float*)lds;
    bf16_t* h1 = (bf16_t*)(lds + 32768);
    for (int u = blockIdx.x; u < NB * 2 * 2 * 8; u += gridDim.x) {
        const int ct = u & 7, which = (u >> 3) & 1, kvh = (u >> 4) & 1, b = u >> 5;
        const int colo = (which ? C_NVC : C_NKC) + kvh * 64;
        const int c_lane = ct * 16 + fr;
        const int tokbase = min(c_lane, 126) * 16;
        const bf16_t* arow = p.hb + ((size_t)b * SEQ + tokbase) * NMAIN + colo + fq * 8;
        const bf16_t* w1 = p.W1T + ((size_t)(l * 2 + which) * 64 + fr) * 2048 + fq * 8;
        f32x4 acc[4];
#pragma unroll
        for (int n = 0; n < 4; ++n) acc[n] = (f32x4){0.f, 0.f, 0.f, 0.f};
#pragma unroll
        for (int kk = 0; kk < 8; ++kk) {
            const int ks = wid * 8 + kk;
            const bf16x8 a = *(const bf16x8*)(arow + (size_t)(ks >> 1) * NMAIN + (ks & 1) * 32);
#pragma unroll
            for (int n = 0; n < 4; ++n) {
                const bf16x8 bb = *(const bf16x8*)(w1 + (size_t)n * 16 * 2048 + ks * 32);
                acc[n] = __builtin_amdgcn_mfma_f32_16x16x32_bf16(a, bb, acc[n], 0, 0, 0);
            }
        }
#pragma unroll
        for (int n = 0; n < 4; ++n)
#pragma unroll
            for (int r = 0; r < 4; ++r) part[wid * 1024 + (fq * 4 + r) * 64 + n * 16 + fr] = acc[n][r];
        __syncthreads();
        const float* b1 = p.b1c + (l * 2 + which) * 64;
#pragma unroll
        for (int i = 0; i < 2; ++i) {
            const int e = tid + NTHR * i; float sum = 0.f;
#pragma unroll
            for (int w = 0; w < 8; ++w) sum += part[w * 1024 + e];
            h1[e] = f2bf(gelu_tanh(sum + b1[e & 63]));
        }
        __syncthreads();
        if (wid == 0) {
            const bf16_t* w2 = p.W2T + ((size_t)(l * 2 + which) * 64 + fr) * 64 + fq * 8;
            f32x4 o2[4];
#pragma unroll
            for (int n = 0; n < 4; ++n) o2[n] = (f32x4){0.f, 0.f, 0.f, 0.f};
#pragma unroll
            for (int ks = 0; ks < 2; ++ks) {
                const bf16x8 a = *(const bf16x8*)(h1 + fr * 64 + ks * 32 + fq * 8);
#pragma unroll
                for (int n = 0; n < 4; ++n) {
                    const bf16x8 bb = *(const bf16x8*)(w2 + (size_t)n * 16 * 64 + ks * 32);
                    o2[n] = __builtin_amdgcn_mfma_f32_16x16x32_bf16(a, bb, o2[n], 0, 0, 0);
                }
            }
            const size_t base = ((size_t)b * 2 + kvh) * 128 * 64;
#pragma unroll
            for (int n = 0; n < 4; ++n)
#pragma unroll
                for (int r = 0; r < 4; ++r) {
                    const int c = ct * 16 + fq * 4 + r, j2 = n * 16 + fr;
                    const bf16_t v = c < 127 ? f2bf(o2[n][r]) : (bf16_t)0;
                    if (which == 0) p.kc[base + (size_t)c * 64 + j2] = v;
                    else { p.vc[base + (size_t)c * 64 + j2] = v; p.vcT[base + (size_t)j2 * 128 + c] = v; }
                }
        }
        __syncthreads();
    }
}

constexpr float L2E = 1.4426950408889634f, MASKV = -__builtin_huge_valf(), MINIT = -1e30f, SCL2 = QSCALE * L2E;
struct KVFrag { bf16x8 k[2][2]; bf16x8 v[4]; };
template <bool FM>
__device__ __forceinline__ void k_load(KVFrag& f, const bf16_t* __restrict__ Kb, size_t ldk, int kc0, int fr, int fq) {
    if (FM) {
        const bf16_t* kp = Kb + (size_t)(kc0 >> 5) * 2048 + (fq * 16 + fr) * 8;
        f.k[0][0] = *(const bf16x8*)(kp); f.k[0][1] = *(const bf16x8*)(kp + 512); f.k[1][0] = *(const bf16x8*)(kp + 1024); f.k[1][1] = *(const bf16x8*)(kp + 1536);
    } else {
        const bf16_t* kp = Kb + (size_t)(kc0 + (fr >> 2) * 8 + (fr & 3)) * ldk + fq * 8;
        f.k[0][0] = *(const bf16x8*)(kp); f.k[0][1] = *(const bf16x8*)(kp + 32);
        f.k[1][0] = *(const bf16x8*)(kp + 4 * ldk); f.k[1][1] = *(const bf16x8*)(kp + 4 * ldk + 32);
    }
}
template <bool FM>
__device__ __forceinline__ void v_load(bf16x8 (&v)[4], const bf16_t* __restrict__ VTb, size_t ldv, int kc0, int fr, int fq) {
    if (FM) {
        const bf16_t* vp = VTb + (size_t)(kc0 >> 5) * 2048 + (fq * 16 + fr) * 8;
#pragma unroll
        for (int dt = 0; dt < 4; ++dt) v[dt] = *(const bf16x8*)(vp + dt * 512);
    } else {
        const bf16_t* vp = VTb + (size_t)fr * ldv + kc0 + fq * 8;
#pragma unroll
        for (int dt = 0; dt < 4; ++dt) v[dt] = *(const bf16x8*)(vp + (size_t)dt * 16 * ldv);
    }
}
__device__ __forceinline__ float rowmax4(float x) {
    auto r = __builtin_amdgcn_permlane32_swap(__float_as_uint(x), __float_as_uint(x), false, false);
    x = fmaxf(__uint_as_float(r[0]), __uint_as_float(r[1]));
    auto q = __builtin_amdgcn_permlane16_swap(__float_as_uint(x), __float_as_uint(x), false, false);
    return fmaxf(__uint_as_float(q[0]), __uint_as_float(q[1]));
}
__device__ __forceinline__ float rowsum4(float x) {
    auto r = __builtin_amdgcn_permlane32_swap(__float_as_uint(x), __float_as_uint(x), false, false);
    x = __uint_as_float(r[0]) + __uint_as_float(r[1]);
    auto q = __builtin_amdgcn_permlane16_swap(__float_as_uint(x), __float_as_uint(x), false, false);
    return __uint_as_float(q[0]) + __uint_as_float(q[1]);
}
template <int NQT, bool MASK, class MB>
__device__ __forceinline__ void attn_compute(const KVFrag& f, const bf16x8 (&qf)[NQT][2], f32x4 (&o)[NQT][4], float (&m)[NQT], float (&l)[NQT], const MB& mb) {
    f32x4 s0[NQT], s1[NQT];
#pragma unroll
    for (int qt = 0; qt < NQT; ++qt) {
        s0[qt] = __builtin_amdgcn_mfma_f32_16x16x32_bf16(f.k[0][0], qf[qt][0], (f32x4){0.f, 0.f, 0.f, 0.f}, 0, 0, 0);
        s1[qt] = __builtin_amdgcn_mfma_f32_16x16x32_bf16(f.k[1][0], qf[qt][0], (f32x4){0.f, 0.f, 0.f, 0.f}, 0, 0, 0);
    }
#pragma unroll
    for (int qt = 0; qt < NQT; ++qt) {
        s0[qt] = __builtin_amdgcn_mfma_f32_16x16x32_bf16(f.k[0][1], qf[qt][1], s0[qt], 0, 0, 0);
        s1[qt] = __builtin_amdgcn_mfma_f32_16x16x32_bf16(f.k[1][1], qf[qt][1], s1[qt], 0, 0, 0);
    }
    float mx[NQT];
#pragma unroll
    for (int qt = 0; qt < NQT; ++qt) {
#pragma unroll
        for (int j = 0; j < 4; ++j) { s0[qt][j] = mb(qt, j, s0[qt][j]); s1[qt][j] = mb(qt, j + 4, s1[qt][j]); }
        mx[qt] = fmaxf(fmaxf(fmaxf(s0[qt][0], s0[qt][1]), fmaxf(s0[qt][2], s0[qt][3])), fmaxf(fmaxf(s1[qt][0], s1[qt][1]), fmaxf(s1[qt][2], s1[qt][3])));
    }
#pragma unroll
    for (int qt = 0; qt < NQT; ++qt) mx[qt] = rowmax4(mx[qt]);
    bool moved = false;
#pragma unroll
    for (int qt = 0; qt < NQT; ++qt) { mx[qt] = fmaxf(m[qt], mx[qt]); moved |= (mx[qt] != m[qt]); }
    if (__ballot(moved) != 0ull) {
#pragma unroll
        for (int qt = 0; qt < NQT; ++qt) {
            const float alpha = __builtin_amdgcn_exp2f(m[qt] - mx[qt]);
            l[qt] *= alpha;
#pragma unroll
            for (int dt = 0; dt < 4; ++dt) o[qt][dt] *= alpha;
        }
    }
    bf16x8 pf[NQT];
#pragma unroll
    for (int qt = 0; qt < NQT; ++qt) {
        m[qt] = mx[qt];
        float pr[8]; float ps = 0.f;
#pragma unroll
        for (int j = 0; j < 4; ++j) {
            pr[j] = __builtin_amdgcn_exp2f(s0[qt][j] - mx[qt]);
            pr[j + 4] = __builtin_amdgcn_exp2f(s1[qt][j] - mx[qt]);
        }
#pragma unroll
        for (int j = 0; j < 8; ++j) ps += pr[j];
        l[qt] += ps;
        const u32x4 pk = {pack2(pr[0], pr[1]), pack2(pr[2], pr[3]), pack2(pr[4], pr[5]), pack2(pr[6], pr[7])};
        pf[qt] = __builtin_bit_cast(bf16x8, pk);
    }
#pragma unroll
    for (int dt = 0; dt < 4; ++dt)
#pragma unroll
        for (int qt = 0; qt < NQT; ++qt) o[qt][dt] = __builtin_amdgcn_mfma_f32_16x16x32_bf16(f.v[dt], pf[qt], o[qt][dt], 0, 0, 0);
    __builtin_amdgcn_sched_barrier(0);
}
struct RangeIt { int c, c_hi; __device__ __forceinline__ int nxt() { if (c > c_hi) return -1; return (c++) * 32; } };
struct MaskIt { unsigned long long cm; __device__ __forceinline__ int nxt() { if (!cm) return -1; const int i = __builtin_ctzll(cm); cm &= cm - 1; return i * 32; } };
template <bool PFV, bool FM, class It, class Gen>
__device__ __forceinline__ void attn_run(It& it, const bf16_t* Kb, size_t ldk, const bf16_t* VTb, size_t ldv, int fr, int fq, const Gen& gen) {
    KVFrag fa, fb;
    int ka = it.nxt(); if (ka < 0) return;
    k_load<FM>(fa, Kb, ldk, ka, fr, fq); if (PFV) v_load<FM>(fa.v, VTb, ldv, ka, fr, fq);
    for (;;) {
        const int kb = it.nxt(); if (kb >= 0) { k_load<FM>(fb, Kb, ldk, kb, fr, fq); if (PFV) v_load<FM>(fb.v, VTb, ldv, kb, fr, fq); }
        if (!PFV) v_load<FM>(fa.v, VTb, ldv, ka, fr, fq);
        gen(ka, fa);
        if (kb < 0) break;
        ka = it.nxt(); if (ka >= 0) { k_load<FM>(fa, Kb, ldk, ka, fr, fq); if (PFV) v_load<FM>(fa.v, VTb, ldv, ka, fr, fq); }
        if (!PFV) v_load<FM>(fb.v, VTb, ldv, kb, fr, fq);
        gen(kb, fb);
        if (ka < 0) break;
    }
}
template <int NQT>
__device__ __forceinline__ void attn_init(f32x4 (&o)[NQT][4], float (&m)[NQT], float (&l)[NQT]) {
#pragma unroll
    for (int qt = 0; qt < NQT; ++qt) { m[qt] = MINIT; l[qt] = 0.f;
#pragma unroll
        for (int dt = 0; dt < 4; ++dt) o[qt][dt] = (f32x4){0.f, 0.f, 0.f, 0.f}; }
}
__device__ __forceinline__ float lsum4(float l) { return rowsum4(l); }
__device__ __forceinline__ void store_o16(unsigned char* dst, const f32x4 v0, const f32x4 v1, const f32x4 v2, const f32x4 v3) {
    u32x4 w; w.x = pack4_fp8(v0[0], v0[1], v0[2], v0[3]); w.y = pack4_fp8(v1[0], v1[1], v1[2], v1[3]); w.z = pack4_fp8(v2[0], v2[1], v2[2], v2[3]); w.w = pack4_fp8(v3[0], v3[1], v3[2], v3[3]);
    *(u32x4*)dst = w;
}
__device__ __forceinline__ float sigmoidf_fast(float x) { return __builtin_amdgcn_rcpf(1.0f + __builtin_amdgcn_exp2f(-L2E * x)); }

__device__ __forceinline__ void fox_unit(const Params& p, int b, int h, int qb, int fr, int fq) {
    asm volatile("" : "+v"(fr), "+v"(fq));
    const int t0 = qb * 64;
    const bf16_t* Qb = p.hb + ((size_t)b * SEQ + t0) * NMAIN + C_FQ + h * 64 + fq * 8;
    bf16x8 qf[4][2];
#pragma unroll
    for (int qt = 0; qt < 4; ++qt) { qf[qt][0] = *(const bf16x8*)(Qb + (size_t)(qt * 16 + fr) * NMAIN); qf[qt][1] = *(const bf16x8*)(Qb + (size_t)(qt * 16 + fr) * NMAIN + 32); }
    const float* cf = p.cF + ((size_t)b * 4 + h) * SEQ;
    float cq[4];
#pragma unroll
    for (int qt = 0; qt < 4; ++qt) cq[qt] = cf[t0 + qt * 16 + fr] * L2E;
    f32x4 o[4][4]; float m[4], l[4];
    attn_init<4>(o, m, l);
    const bf16_t* Kb = p.kF + ((size_t)b * NVH + h) * 64 * SEQ;
    const bf16_t* VTb = p.vT + ((size_t)b * NVH + h) * 64 * SEQ;
    RangeIt it{0, (t0 >> 5) + 1};
    attn_run<false, true>(it, Kb, NMAIN, VTb, SEQ, fr, fq, [&](int kc0, const KVFrag& f) {
        const float4 ca = *(const float4*)(cf + kc0 + 8 * fq), cb = *(const float4*)(cf + kc0 + 8 * fq + 4);
        const float ck[8] = {ca.x * L2E, ca.y * L2E, ca.z * L2E, ca.w * L2E, cb.x * L2E, cb.y * L2E, cb.z * L2E, cb.w * L2E};
        const int kq = kc0 + 8 * fq - t0 - fr;
        attn_compute<4, true>(f, qf, o, m, l, [&](int qt, int j, float raw) { return (kq + j - 16 * qt) > 0 ? MASKV : raw * SCL2 + cq[qt] - ck[j]; });
    });
#pragma unroll
    for (int qt = 0; qt < 4; ++qt) {
        const float inv = __builtin_amdgcn_rcpf(lsum4(l[qt]));
        unsigned char* dst = (unsigned char*)p.ob + ((size_t)b * SEQ + t0 + qt * 16 + fr) * DM + h * 64 + 16 * fq;
        store_o16(dst, o[qt][0] * inv, o[qt][1] * inv, o[qt][2] * inv, o[qt][3] * inv);
    }
}
__device__ __forceinline__ void swa_unit(const Params& p, int l_, int b, int kv, int pos, int fr, int fq) {
    asm volatile("" : "+v"(fr), "+v"(fq));
    const int t0 = pos * 16, t = t0 + fr;
    const bf16_t* Qb = p.hb + ((size_t)b * SEQ + t) * NMAIN + C_SQ + kv * 192 + fq * 8;
    bf16x8 qf[3][2];
#pragma unroll
    for (int g = 0; g < 3; ++g) { qf[g][0] = *(const bf16x8*)(Qb + g * 64); qf[g][1] = *(const bf16x8*)(Qb + g * 64 + 32); }
    float sl[3];
#pragma unroll
    for (int g = 0; g < 3; ++g) sl[g] = slope_swa(kv * 3 + g) * L2E;
    f32x4 o[3][4]; float m[3], l[3];
    attn_init<3>(o, m, l);
    const bf16_t* Kb = p.kF + ((size_t)b * NVH + 4 + kv) * 64 * SEQ;
    const bf16_t* VTb = p.vT + ((size_t)b * NVH + 4 + kv) * 64 * SEQ;
    RangeIt it{max(0, t0 - 127) >> 5, (t0 + 15) >> 5};
    attn_run<true, true>(it, Kb, NMAIN, VTb, SEQ, fr, fq, [&](int kc0, const KVFrag& f) {
        const int dq = t - kc0 - 8 * fq;
        attn_compute<3, true>(f, qf, o, m, l, [&](int g, int j, float raw) { const int dist = dq - j; return ((unsigned)dist < 128u) ? raw * SCL2 - sl[g] * (float)dist : MASKV; });
    });
#pragma unroll
    for (int g = 0; g < 3; ++g) {
        const float sink = p.sinks[l_ * 6 + kv * 3 + g] * L2E;
        const float inv = __builtin_amdgcn_rcpf(lsum4(l[g]) + __builtin_amdgcn_exp2f(sink - m[g]));
        unsigned char* dst = (unsigned char*)p.ob + ((size_t)b * SEQ + t) * DM + 256 + (kv * 3 + g) * 64 + 16 * fq;
        store_o16(dst, o[g][0] * inv, o[g][1] * inv, o[g][2] * inv, o[g][3] * inv);
    }
}
__device__ __forceinline__ void nsa_unit(const Params& p, int b, int kv, int pos, int fr, int fq, int lane, float* ps, unsigned* msk, float* otl) {
    asm volatile("" : "+v"(fr), "+v"(fq), "+v"(lane));
    const int t0 = pos * 16, t = t0 + fr, cur = t0 >> 6;
    const bf16_t* Qb = p.hb + ((size_t)b * SEQ + t) * NMAIN + C_NQ + kv * 192 + fq * 8;
    bf16x8 qf[3][2];
#pragma unroll
    for (int g = 0; g < 3; ++g) { qf[g][0] = *(const bf16x8*)(Qb + g * 64); qf[g][1] = *(const bf16x8*)(Qb + g * 64 + 32); }
    float sl[3];
#pragma unroll
    for (int g = 0; g < 3; ++g) sl[g] = slope_nsa(kv * 3 + g) * L2E;
    const float* gl = p.hs + ((size_t)b * SEQ + t) * HS_W + 4 + kv * 9;
    f32x4 o[3][4]; float m[3], l[3];
    f32x4* otv = (f32x4*)otl + lane;
#pragma unroll
    for (int i = 0; i < 8; ++i) ps[lane + 64 * i] = 0.f;
    {
        const bf16_t* Kb = p.kc + ((size_t)b * 2 + kv) * 128 * 64;
        const bf16_t* VTb = p.vcT + ((size_t)b * 2 + kv) * 64 * 128;
        const int ncv = (t0 + 15 >= 31) ? ((t0 + 15 - 31) >> 4) + 1 : 0;
        const int nch = (ncv + 31) >> 5;
        attn_init<3>(o, m, l);
        const int dq0 = t - 31 - 16 * 8 * fq;
        RangeIt it{0, nch - 1};
        attn_run<false, false>(it, Kb, 64, VTb, 128, fr, fq, [&](int kc0, const KVFrag& f) {
            const int dq = dq0 - 16 * kc0;
            attn_compute<3, true>(f, qf, o, m, l, [&](int g, int j, float raw) { const int dist = dq - 16 * j; return dist >= 0 ? raw * SCL2 - sl[g] * (float)dist : MASKV; });
        });
        float il[3];
#pragma unroll
        for (int g = 0; g < 3; ++g) {
            const float lt = lsum4(l[g]); il[g] = lt > 0.f ? __builtin_amdgcn_rcpf(lt) : 0.f;
            const float gate = sigmoidf_fast(gl[g * 3 + 0]);
#pragma unroll
            for (int dt = 0; dt < 4; ++dt) otv[(g * 4 + dt) * 64] = o[g][dt] * (il[g] * gate);
        }
        float carry_prev = 0.f;
        for (int c = 0; c < nch; ++c) {
            const int kc0 = c * 32, dq = dq0 - 16 * kc0;
            const bf16_t* kp = Kb + (size_t)(kc0 + (fr >> 2) * 8 + (fr & 3)) * 64 + fq * 8;
            const bf16x8 k00 = *(const bf16x8*)(kp), k01 = *(const bf16x8*)(kp + 32), k10 = *(const bf16x8*)(kp + 256), k11 = *(const bf16x8*)(kp + 256 + 32);
            float pc[8];
#pragma unroll
            for (int j = 0; j < 8; ++j) pc[j] = 0.f;
#pragma unroll
            for (int g = 0; g < 3; ++g) {
                f32x4 s0 = (f32x4){0.f, 0.f, 0.f, 0.f}, s1 = s0;
                s0 = __builtin_amdgcn_mfma_f32_16x16x32_bf16(k00, qf[g][0], s0, 0, 0, 0); s0 = __builtin_amdgcn_mfma_f32_16x16x32_bf16(k01, qf[g][1], s0, 0, 0, 0);
                s1 = __builtin_amdgcn_mfma_f32_16x16x32_bf16(k10, qf[g][0], s1, 0, 0, 0); s1 = __builtin_amdgcn_mfma_f32_16x16x32_bf16(k11, qf[g][1], s1, 0, 0, 0);
#pragma unroll
                for (int j = 0; j < 8; ++j) {
                    const int dist = dq - 16 * j; const float raw = j < 4 ? s0[j] : s1[j - 4];
                    if (dist >= 0) pc[j] += __builtin_amdgcn_exp2f(raw * SCL2 - sl[g] * (float)dist - m[g]) * il[g];
                }
            }
            const float cout = 0.5f * pc[7];
            float cin = shfl_f(cout, lane - 16);
            const float cwrap = shfl_f(cout, fr + 48);
            if (fq == 0) cin = carry_prev;
            carry_prev = cwrap;
            const int n0 = (kc0 >> 2) + 2 * fq;
            ps[fr * 32 + n0] = cin + pc[0] + pc[1] + pc[2] + 0.5f * pc[3];
            ps[fr * 32 + n0 + 1] = 0.5f * pc[3] + pc[4] + pc[5] + pc[6] + 0.5f * pc[7];
        }
    }
    lds_wave_sync();
    if (lane < 16) {
        unsigned mask = 1u | (1u << cur); if (cur >= 1) mask |= 1u << (cur - 1);
        if (cur >= 3) {
            if (cur - 2 <= 5) mask |= (1u << (cur - 1)) - 2u;
            else {
                const float* my = ps + lane * 32;
                for (int r = 0; r < 5; ++r) {
                    float best = -1.0f; int bi = 1;
                    for (int j = 1; j <= cur - 2; ++j) { const float v = my[j]; if (!((mask >> j) & 1u) && v > best) { best = v; bi = j; } }
                    mask |= 1u << bi;
                }
            }
        }
        msk[lane] = mask;
    }
    lds_wave_sync();
    const unsigned qmask = msk[fr];
    lds_wave_sync();
    {
        const bf16_t* Kb = p.kF + ((size_t)b * NVH + 6 + kv) * 64 * SEQ;
        const bf16_t* VTb = p.vT + ((size_t)b * NVH + 6 + kv) * 64 * SEQ;
        attn_init<3>(o, m, l);
        unsigned um = qmask;
        um |= shfl_u(um, lane ^ 1); um |= shfl_u(um, lane ^ 2); um |= shfl_u(um, lane ^ 4); um |= shfl_u(um, lane ^ 8);
        um = (unsigned)__builtin_amdgcn_readfirstlane((int)um) & (cur >= 31 ? 0xffffffffu : ((2u << cur) - 1u));
        unsigned long long cm = 0ull;
        for (unsigned r = um; r; r &= r - 1) { const int kb = __builtin_ctz(r); cm |= 3ull << (2 * kb); }
        MaskIt it{cm};
        attn_run<true, true>(it, Kb, NMAIN, VTb, SEQ, fr, fq, [&](int kc0, const KVFrag& f) {
            const bool mine = (qmask >> (kc0 >> 6)) & 1u;
            const int dq = t - kc0 - 8 * fq;
            attn_compute<3, true>(f, qf, o, m, l, [&](int g, int j, float raw) { const int dist = dq - j; return (mine && dist >= 0) ? raw * SCL2 - sl[g] * (float)dist : MASKV; });
        });
#pragma unroll
        for (int g = 0; g < 3; ++g) {
            const float lt = lsum4(l[g]); const float sc = (lt > 0.f ? __builtin_amdgcn_rcpf(lt) : 0.f) * sigmoidf_fast(gl[g * 3 + 1]);
#pragma unroll
            for (int dt = 0; dt < 4; ++dt) otv[(g * 4 + dt) * 64] += o[g][dt] * sc;
        }
    }
    {
        const bf16_t* Kb = p.kF + ((size_t)b * NVH + 8 + kv) * 64 * SEQ;
        const bf16_t* VTb = p.vT + ((size_t)b * NVH + 8 + kv) * 64 * SEQ;
        attn_init<3>(o, m, l);
        RangeIt it{max(0, t0 - 511) >> 5, (t0 + 15) >> 5};
        attn_run<true, true>(it, Kb, NMAIN, VTb, SEQ, fr, fq, [&](int kc0, const KVFrag& f) {
            const int dq = t - kc0 - 8 * fq;
            attn_compute<3, true>(f, qf, o, m, l, [&](int g, int j, float raw) { const int dist = dq - j; return ((unsigned)dist < 512u) ? raw * SCL2 - sl[g] * (float)dist : MASKV; });
        });
#pragma unroll
        for (int g = 0; g < 3; ++g) {
            const float lt = lsum4(l[g]); const float sc = (lt > 0.f ? __builtin_amdgcn_rcpf(lt) : 0.f) * sigmoidf_fast(gl[g * 3 + 2]);
            unsigned char* dst = (unsigned char*)p.ob + ((size_t)b * SEQ + t) * DM + 640 + (kv * 3 + g) * 64 + 16 * fq;
            store_o16(dst, otv[(g * 4 + 0) * 64] + o[g][0] * sc, otv[(g * 4 + 1) * 64] + o[g][1] * sc, otv[(g * 4 + 2) * 64] + o[g][2] * sc, otv[(g * 4 + 3) * 64] + o[g][3] * sc);
        }
    }
}

template <bool WITH_CONV>
__device__ __forceinline__ void phase_attn(const Params& p, int l, char* lds, int cslot = 16) {
    int tid = threadIdx.x; asm volatile("" : "+v"(tid));
    const int wid = tid >> 6, lane = tid & 63, fr = lane & 15, fq = lane >> 4;
    float* ps = (float*)(lds + wid * 16896); unsigned* msk = (unsigned*)(ps + 512); float* otl = ps + 576;
    unsigned* ctr = p.ctrl + cslot + l;
    constexpr unsigned NU_NSA = NB * 2 * 128, NU_FOX = NB * 4 * 32, NU_SWA = NB * 2 * 128, NU_ATT = NU_NSA + NU_FOX + NU_SWA;
    for (;;) {
        unsigned u = 0;
        if (lane == 0) u = __hip_atomic_fetch_add(ctr, 1u, __ATOMIC_RELAXED, __HIP_MEMORY_SCOPE_AGENT);
        u = (unsigned)__builtin_amdgcn_readfirstlane((int)u);
        if (WITH_CONV) {
            constexpr unsigned TOTQ = NU_ATT + (unsigned)CONV_TILES;
            if (u >= TOTQ) break;
            const unsigned a0 = (unsigned)(((unsigned long long)u * NU_ATT) / TOTQ), a1 = (unsigned)(((unsigned long long)(u + 1) * NU_ATT) / TOTQ);
            if (a1 == a0) { conv_tile_wave(p, (int)(u - a0), lane, (unsigned char*)ps); continue; }
            u = a0;
        } else {
#ifndef ATT_REP
#define ATT_REP 1
#endif
            if (u >= ATT_REP * NU_ATT) break;
            if (ATT_REP > 1) u %= NU_ATT;
        }
        if (u < NU_NSA) { const int pos = 127 - (int)(u & 127), r = u >> 7; nsa_unit(p, r >> 1, r & 1, pos, fr, fq, lane, ps, msk, otl); }
        else if (u < NU_NSA + NU_FOX) { const unsigned v = u - NU_NSA; const int qb = 31 - (int)(v & 31), r = v >> 5; fox_unit(p, r >> 2, r & 3, qb, fr, fq); }
        else { const unsigned v = u - NU_NSA - NU_FOX; const int pos = 127 - (int)(v & 127), r = v >> 7; swa_unit(p, l, r >> 1, r & 1, pos, fr, fq); }
    }
}

__device__ __forceinline__ void phase_ln1_router(const Params& p, int l, char* lds) {
    int tid = threadIdx.x; asm volatile("" : "+v"(tid));
    const int wid = tid >> 6, lane = tid & 63, fr = lane & 15, fq = lane >> 4;
    float* lg = (float*)lds + wid * 512;
    int* lcnt = (int*)(lds + 16384); int* lbase = lcnt + 32;
    const float* g1 = p.ln1_g + l * DM; const float* b1 = p.ln1_b + l * DM;
    const float* rw = p.rwT + (size_t)l * NE * 1024; const float* rb = p.router_b + l * NE;
    unsigned* gcount = p.ctrl + 64 + l * NE;
    constexpr int RW_LDS = 20480, RW_PITCH = 1028;
    if (blockIdx.x < NTOK / 128) {
#pragma unroll 4
        for (int i = 0; i < 16; ++i) { const int pc = wid * 16 + i, e = pc >> 2, q = pc & 3;
            __builtin_amdgcn_global_load_lds((const unsigned*)(rw + (size_t)e * 1024 + q * 256 + lane * 4), (LAS unsigned*)((LAS char*)lds + RW_LDS + e * RW_PITCH * 4 + q * 1024), 16, 0, 0); }
    }
    for (int grp = blockIdx.x; grp < NTOK / 128; grp += gridDim.x) {
        const int tok0 = grp * 128 + wid * 16;
        if (tid < 32) lcnt[tid] = 0;
        float gg[16], bb[16];
#pragma unroll
        for (int j = 0; j < 4; ++j) { const float4 g4 = *(const float4*)(g1 + lane * 16 + j * 4), b4 = *(const float4*)(b1 + lane * 16 + j * 4);
            gg[4 * j] = g4.x; gg[4 * j + 1] = g4.y; gg[4 * j + 2] = g4.z; gg[4 * j + 3] = g4.w; bb[4 * j] = b4.x; bb[4 * j + 1] = b4.y; bb[4 * j + 2] = b4.z; bb[4 * j + 3] = b4.w; }
        for (int r0 = 0; r0 < 16; r0 += 4) {
            float v[4][16]; float s[4], qv[4];
#pragma unroll
            for (int i = 0; i < 4; ++i) {
                const bf16_t* tr = (const bf16_t*)p.tbuf + (size_t)(tok0 + r0 + i) * DM + lane * 16;
                const u32x4 t0 = *(const u32x4*)tr, t1 = *(const u32x4*)(tr + 8);
                const unsigned ts[8] = {t0.x, t0.y, t0.z, t0.w, t1.x, t1.y, t1.z, t1.w};
#pragma unroll
                for (int c = 0; c < 8; ++c) { v[i][2 * c] = __uint_as_float(ts[c] << 16); v[i][2 * c + 1] = __uint_as_float(ts[c] & 0xffff0000u); }
            }
#pragma unroll
            for (int i = 0; i < 4; ++i) { s[i] = 0.f;
#pragma unroll
                for (int c = 0; c < 16; c += 4) s[i] += (v[i][c] + v[i][c + 1]) + (v[i][c + 2] + v[i][c + 3]); }
#pragma unroll
            for (int o = 32; o > 0; o >>= 1) {
#pragma unroll
                for (int i = 0; i < 4; ++i) s[i] += shfl_f(s[i], lane ^ o); }
#pragma unroll
            for (int i = 0; i < 4; ++i) { const float mean = s[i] * (1.0f / 1024.0f); qv[i] = 0.f;
#pragma unroll
                for (int c = 0; c < 16; c += 4) { v[i][c] -= mean; v[i][c + 1] -= mean; v[i][c + 2] -= mean; v[i][c + 3] -= mean;
                    qv[i] += (v[i][c] * v[i][c] + v[i][c + 1] * v[i][c + 1]) + (v[i][c + 2] * v[i][c + 2] + v[i][c + 3] * v[i][c + 3]); } }
#pragma unroll
            for (int o = 32; o > 0; o >>= 1) {
#pragma unroll
                for (int i = 0; i < 4; ++i) qv[i] += shfl_f(qv[i], lane ^ o); }
#pragma unroll
            for (int i = 0; i < 4; ++i) {
                const float rstd = rsqrtf(qv[i] * (1.0f / 1024.0f) + LN_EPS);
                const size_t row = (size_t)(tok0 + r0 + i);
                float y[16];
#pragma unroll
                for (int c = 0; c < 16; ++c) y[c] = v[i][c] * rstd * gg[c] + bb[c];
                u32x4 w0, w1, q;
                w0.x = pack2(y[0], y[1]); w0.y = pack2(y[2], y[3]); w0.z = pack2(y[4], y[5]); w0.w = pack2(y[6], y[7]);
                w1.x = pack2(y[8], y[9]); w1.y = pack2(y[10], y[11]); w1.z = pack2(y[12], y[13]); w1.w = pack2(y[14], y[15]);
                q.x = pack4_fp8(y[0], y[1], y[2], y[3]); q.y = pack4_fp8(y[4], y[5], y[6], y[7]); q.z = pack4_fp8(y[8], y[9], y[10], y[11]); q.w = pack4_fp8(y[12], y[13], y[14], y[15]);
                *(u32x4*)((bf16_t*)p.x1f + row * DM + lane * 16) = w0; *(u32x4*)((bf16_t*)p.x1f + row * DM + lane * 16 + 8) = w1;
                *(u32x4*)((char*)p.x1b + row * DM + lane * 16) = q;
            }
        }
        asm volatile("s_waitcnt vmcnt(0)" ::: "memory");
        __syncthreads();
        f32x4 a0 = (f32x4){0.f, 0.f, 0.f, 0.f}, a1 = a0;
        const bf16_t* xr = (const bf16_t*)p.x1f + (size_t)(tok0 + fr) * DM + 4 * fq;
        const LAS float* w0 = (const LAS float*)((LAS char*)lds + RW_LDS) + fr * RW_PITCH + 4 * fq; const LAS float* w1 = w0 + 16 * RW_PITCH;
#pragma unroll 4
        for (int k0 = 0; k0 < 1024; k0 += 16) {
            const u32x2 xw = *(const u32x2*)(xr + k0); const f32x4 wb0 = *(const LAS f32x4*)(w0 + k0), wb1 = *(const LAS f32x4*)(w1 + k0);
            const float4 xa = make_float4(__uint_as_float(xw.x << 16), __uint_as_float(xw.x & 0xffff0000u), __uint_as_float(xw.y << 16), __uint_as_float(xw.y & 0xffff0000u));
            a0 = __builtin_amdgcn_mfma_f32_16x16x4f32(xa.x, wb0.x, a0, 0, 0, 0); a1 = __builtin_amdgcn_mfma_f32_16x16x4f32(xa.x, wb1.x, a1, 0, 0, 0);
            a0 = __builtin_amdgcn_mfma_f32_16x16x4f32(xa.y, wb0.y, a0, 0, 0, 0); a1 = __builtin_amdgcn_mfma_f32_16x16x4f32(xa.y, wb1.y, a1, 0, 0, 0);
            a0 = __builtin_amdgcn_mfma_f32_16x16x4f32(xa.z, wb0.z, a0, 0, 0, 0); a1 = __builtin_amdgcn_mfma_f32_16x16x4f32(xa.z, wb1.z, a1, 0, 0, 0);
            a0 = __builtin_amdgcn_mfma_f32_16x16x4f32(xa.w, wb0.w, a0, 0, 0, 0); a1 = __builtin_amdgcn_mfma_f32_16x16x4f32(xa.w, wb1.w, a1, 0, 0, 0);
        }
#pragma unroll
        for (int r = 0; r < 4; ++r) { lg[(fq * 4 + r) * 32 + fr] = a0[r] + rb[fr]; lg[(fq * 4 + r) * 32 + 16 + fr] = a1[r] + rb[16 + fr]; }
        lds_wave_sync();
        int e4[4] = {0, 0, 0, 0}; int rk[4] = {0, 0, 0, 0};
        if (lane < 16) {
            const float* my = lg + lane * 32; unsigned taken = 0u; float tv[4];
#pragma unroll
            for (int k = 0; k < 4; ++k) {
                float best = NEG_INF; int bi = 0;
                for (int e = 0; e < 32; ++e) { const float xv = my[e]; if (!((taken >> e) & 1u) && xv > best) { best = xv; bi = e; } }
                taken |= 1u << bi; e4[k] = bi; tv[k] = best;
            }
            const float e1 = __expf(tv[1] - tv[0]), e2 = __expf(tv[2] - tv[0]), e3 = __expf(tv[3] - tv[0]);
            const float inv = 1.0f / (1.0f + e1 + e2 + e3);
            const size_t row = (size_t)(tok0 + lane);
            *(float4*)(p.gw + row * 4) = make_float4(inv, e1 * inv, e2 * inv, e3 * inv);
        }
        __syncthreads();
        if (lane < 16) {
#pragma unroll
            for (int k = 0; k < 4; ++k) rk[k] = atomicAdd(&lcnt[e4[k]], 1);
        }
        __syncthreads();
        if (tid < 32) { const int c = lcnt[tid]; lbase[tid] = c ? (int)__hip_atomic_fetch_add(gcount + tid, (unsigned)c, __ATOMIC_RELAXED, __HIP_MEMORY_SCOPE_AGENT) : 0; }
        __syncthreads();
        if (lane < 16) {
            const int row = tok0 + lane; int pk[4];
#pragma unroll
            for (int k = 0; k < 4; ++k) { const int pos = lbase[e4[k]] + rk[k]; p.lists[(size_t)e4[k] * LIST_CAP + pos] = row * 4 + k; pk[k] = (pos << 5) | e4[k]; }
            *(int4*)(p.top_e + (size_t)row * 4) = make_int4(pk[0], pk[1], pk[2], pk[3]);
        }
        __syncthreads();
    }
}

__device__ __forceinline__ void phase_ln2(const Params& p, int l, float* xout, char* lds) {
    int* ptile = (int*)(lds + LDS_TAB); int* ecnt = ptile + 40;
    build_tiles(p, l, ptile, ecnt);
    int tid = threadIdx.x; asm volatile("" : "+v"(tid));
    const int wid = tid >> 6, lane = tid & 63;
    const float* g2 = p.ln2_g + l * DM; const float* b2 = p.ln2_b + l * DM;
    float gg[16], bb[16];
#pragma unroll
    for (int j = 0; j < 4; ++j) { const float4 g4 = *(const float4*)(g2 + lane * 16 + j * 4), b4 = *(const float4*)(b2 + lane * 16 + j * 4);
        gg[4 * j] = g4.x; gg[4 * j + 1] = g4.y; gg[4 * j + 2] = g4.z; gg[4 * j + 3] = g4.w; bb[4 * j] = b4.x; bb[4 * j + 1] = b4.y; bb[4 * j + 2] = b4.z; bb[4 * j + 3] = b4.w; }
    for (int pr = blockIdx.x * NWV + wid; pr < NTOK / 2; pr += gridDim.x * NWV) {
        float v[2][16]; float s[2], qv[2];
        u32x4 yv[2][4], xv[2][2]; float gk[2][4];
#pragma unroll
        for (int i = 0; i < 2; ++i) {
            const int row = pr * 2 + i;
            const float4 gwv = *(const float4*)(p.gw + (size_t)row * 4);
            gk[i][0] = gwv.x; gk[i][1] = gwv.y; gk[i][2] = gwv.z; gk[i][3] = gwv.w;
            const int4 te = *(const int4*)(p.top_e + (size_t)row * 4);
            const int tk[4] = {te.x, te.y, te.z, te.w};
            xv[i][0] = *(const u32x4*)((const bf16_t*)p.x1f + (size_t)row * DM + lane * 16); xv[i][1] = *(const u32x4*)((const bf16_t*)p.x1f + (size_t)row * DM + lane * 16 + 8);
#pragma unroll
            for (int k = 0; k < 4; ++k) yv[i][k] = *(const u32x4*)((const unsigned char*)p.ybuf + (size_t)(ptile[tk[k] & 31] * 256 + (tk[k] >> 5)) * DM + lane * 16);
        }
#pragma unroll
        for (int i = 0; i < 2; ++i) { s[i] = 0.f;
            const unsigned xs[8] = {xv[i][0].x, xv[i][0].y, xv[i][0].z, xv[i][0].w, xv[i][1].x, xv[i][1].y, xv[i][1].z, xv[i][1].w};
#pragma unroll
            for (int c = 0; c < 8; ++c) { v[i][2 * c] = __uint_as_float(xs[c] << 16) * ALPHA; v[i][2 * c + 1] = __uint_as_float(xs[c] & 0xffff0000u) * ALPHA; }
#pragma unroll
            for (int k = 0; k < 4; ++k) {
                const unsigned ys[4] = {yv[i][k].x, yv[i][k].y, yv[i][k].z, yv[i][k].w};
#pragma unroll
                for (int c = 0; c < 4; ++c) {
                    const f32x2_t lo = __builtin_amdgcn_cvt_pk_f32_fp8(ys[c], false), hi = __builtin_amdgcn_cvt_pk_f32_fp8(ys[c], true);
                    v[i][4 * c] += gk[i][k] * lo.x; v[i][4 * c + 1] += gk[i][k] * lo.y; v[i][4 * c + 2] += gk[i][k] * hi.x; v[i][4 * c + 3] += gk[i][k] * hi.y;
                }
            }
#pragma unroll
            for (int c = 0; c < 16; c += 4) s[i] += (v[i][c] + v[i][c + 1]) + (v[i][c + 2] + v[i][c + 3]);
        }
#pragma unroll
        for (int o = 32; o > 0; o >>= 1) { s[0] += shfl_f(s[0], lane ^ o); s[1] += shfl_f(s[1], lane ^ o); }
#pragma unroll
        for (int i = 0; i < 2; ++i) { const float mean = s[i] * (1.0f / 1024.0f); qv[i] = 0.f;
#pragma unroll
            for (int c = 0; c < 16; c += 4) { v[i][c] -= mean; v[i][c + 1] -= mean; v[i][c + 2] -= mean; v[i][c + 3] -= mean;
                qv[i] += (v[i][c] * v[i][c] + v[i][c + 1] * v[i][c + 1]) + (v[i][c + 2] * v[i][c + 2] + v[i][c + 3] * v[i][c + 3]); } }
#pragma unroll
        for (int o = 32; o > 0; o >>= 1) { qv[0] += shfl_f(qv[0], lane ^ o); qv[1] += shfl_f(qv[1], lane ^ o); }
#pragma unroll
        for (int i = 0; i < 2; ++i) {
            const float rstd = rsqrtf(qv[i] * (1.0f / 1024.0f) + LN_EPS);
            const size_t row = (size_t)(pr * 2 + i);
            float y[16];
#pragma unroll
            for (int c = 0; c < 16; ++c) y[c] = v[i][c] * rstd * gg[c] + bb[c];
            if (l + 1 < NL) {
                u32x4 w0, w1, q;
                w0.x = pack2(y[0], y[1]); w0.y = pack2(y[2], y[3]); w0.z = pack2(y[4], y[5]); w0.w = pack2(y[6], y[7]);
                w1.x = pack2(y[8], y[9]); w1.y = pack2(y[10], y[11]); w1.z = pack2(y[12], y[13]); w1.w = pack2(y[14], y[15]);
                q.x = pack4_fp8(y[0], y[1], y[2], y[3]); q.y = pack4_fp8(y[4], y[5], y[6], y[7]); q.z = pack4_fp8(y[8], y[9], y[10], y[11]); q.w = pack4_fp8(y[12], y[13], y[14], y[15]);
                *(u32x4*)(p.xb + row * DM + lane * 16) = w0; *(u32x4*)(p.xb + row * DM + lane * 16 + 8) = w1;
                *(u32x4*)(p.xq + row * DM + lane * 16) = q;
            } else {
#pragma unroll
                for (int c = 0; c < 16; c += 4) *(float4*)(xout + row * DM + lane * 16 + c) = make_float4(y[c], y[c + 1], y[c + 2], y[c + 3]);
            }
        }
    }
}

#define XB_TMO      128
#define XB_XCNT(j)  (256  + 64 * (j))
#define XB_XSUB(j)  (1280 + 64 * (j))
#define XB_XGEN(j)  (2304 + 64 * (j))
#define XB_TOP      3328
#define XB_TOPGEN   3392
#define XCD_BAR_WORDS 3456
#define XB_SPIN_CAP (1u << 22)
__device__ __forceinline__ unsigned xb_ld(unsigned* p)              { return __hip_atomic_load(p, __ATOMIC_RELAXED, __HIP_MEMORY_SCOPE_AGENT); }
__device__ __forceinline__ unsigned xb_add(unsigned* p, unsigned v) { return __hip_atomic_fetch_add(p, v, __ATOMIC_RELAXED, __HIP_MEMORY_SCOPE_AGENT); }
__device__ __forceinline__ unsigned xb_xcc_id() { return (unsigned)__builtin_amdgcn_s_getreg((3 << 11) | 20) & 0xFu; }
#define XB_SPIN(cond, bar) do { unsigned _sp = 0; while (cond) { __builtin_amdgcn_s_sleep(1); \
    if ((++_sp & 255u) == 0u) { if (xb_ld(&(bar)[XB_TMO])) break; if (_sp > XB_SPIN_CAP) { atomicAdd(&(bar)[XB_TMO], 1u); break; } } } } while (0)
struct XcdBarrier { unsigned* bar; unsigned x; volatile LAS unsigned* st; };
__device__ __forceinline__ XcdBarrier xcd_barrier_post(unsigned* bar, volatile LAS unsigned* st) {
    XcdBarrier b; b.bar = bar; b.x = xb_xcc_id(); b.st = st;
    if (threadIdx.x == 0) (void)xb_add(&bar[XB_XCNT(b.x)], 1u);
    return b;
}
__device__ __forceinline__ void xcd_barrier_complete(unsigned* bar, unsigned x, unsigned& nloc, unsigned& nx) {
    const unsigned G = gridDim.x * gridDim.y * gridDim.z;
    unsigned sum, cnt, mine, sp = 0u;
    for (;;) {
        sum = 0u; cnt = 0u; mine = 0u;
#pragma unroll
        for (unsigned j = 0; j < 16; ++j) { const unsigned c = xb_ld(&bar[XB_XCNT(j)]); sum += c; cnt += (c > 0u) ? 1u : 0u; mine = (j == x) ? c : mine; }
        if (sum == G) break;
        __builtin_amdgcn_s_sleep(1);
        if ((++sp & 255u) == 0u) { if (xb_ld(&bar[XB_TMO])) break; if (sp > XB_SPIN_CAP) { atomicAdd(&bar[XB_TMO], 1u); break; } }
    }
    nloc = mine > 0u ? mine : 1u; nx = cnt > 0u ? cnt : 1u;
}
__device__ __forceinline__ void xcd_barrier(const XcdBarrier& b) {
    asm volatile("s_waitcnt vmcnt(0)" ::: "memory");
    __syncthreads();
    if (threadIdx.x == 0) {
        unsigned* bar = b.bar;
        __builtin_amdgcn_s_waitcnt(0);
        unsigned nloc = b.st[0], nx = b.st[1];
        if (nloc == 0u) { xcd_barrier_complete(bar, b.x, nloc, nx); b.st[0] = nloc; b.st[1] = nx; }
        const unsigned old = xb_add(&bar[XB_XSUB(b.x)], 1u);
        const unsigned gen = old / nloc;
        if (old + 1u == (gen + 1u) * nloc) {
            __builtin_amdgcn_fence(__ATOMIC_RELEASE, "agent");
            asm volatile("s_waitcnt vmcnt(0)" ::: "memory");
            const unsigned og = xb_add(&bar[XB_TOP], 1u);
            const unsigned tg = og / nx;
            if (og + 1u == (tg + 1u) * nx) xb_add(&bar[XB_TOPGEN], 1u);
            else XB_SPIN(xb_ld(&bar[XB_TOPGEN]) == tg, bar);
            __builtin_amdgcn_fence(__ATOMIC_ACQUIRE, "agent");
            xb_add(&bar[XB_XGEN(b.x)], 1u);
            asm volatile("s_waitcnt vmcnt(0)" ::: "memory");
        } else {
            XB_SPIN(xb_ld(&bar[XB_XGEN(b.x)]) == gen, bar);
            __builtin_amdgcn_fence(__ATOMIC_ACQUIRE, "agent");
            asm volatile("s_waitcnt vmcnt(0)" ::: "memory");
        }
    }
    __syncthreads();
}

struct KArgs { const float* in[18]; float* out; char* ws; };
constexpr size_t al256(size_t v) { return (v + 255) / 256 * 256; }
struct WSL {
    static constexpr size_t ctrl = 0;
    static constexpr size_t WinT = al256(ctrl + 65536);
    static constexpr size_t WoT = al256(WinT + (size_t)NL * NPAD * 1024 * 2);
    static constexpr size_t W1T = al256(WoT + (size_t)NL * 1024 * 1024 * 2);
    static constexpr size_t W2T = al256(W1T + (size_t)NL * 2 * 64 * 2048 * 2);
    static constexpr size_t WguT = al256(W2T + (size_t)NL * 2 * 64 * 64 * 2);
    static constexpr size_t WdnT = al256(WguT + (size_t)NL * NE * 2048 * 1024 * 2);
    static constexpr size_t rwT = al256(WdnT + (size_t)NL * NE * 1024 * 1024 * 2);
    static constexpr size_t binp = al256(rwT + (size_t)NL * NE * 1024 * 4);
    static constexpr size_t bgup = al256(binp + (size_t)NL * NPAD * 4);
    static constexpr size_t b1c = al256(bgup + (size_t)NL * NE * 2048 * 4);
    static constexpr size_t xf = al256(b1c + 4 * 64 * 4);
    static constexpr size_t xb = al256(xf + (size_t)NTOK * DM * 4);
    static constexpr size_t hb = al256(xb + (size_t)NTOK * DM * 2);
    static constexpr size_t hs = al256(hb + (size_t)NTOK * NMAIN * 2);
    static constexpr size_t vT = al256(hs + (size_t)NTOK * HS_W * 4);
    static constexpr size_t kF = al256(vT + (size_t)NB * NVH * 64 * SEQ * 2);
    static constexpr size_t cF = al256(kF + (size_t)NB * NVH * 64 * SEQ * 2);
    static constexpr size_t kc = al256(cF + (size_t)NB * 4 * SEQ * 4);
    static constexpr size_t vc = al256(kc + (size_t)NB * 2 * 128 * 64 * 2);
    static constexpr size_t vcT = al256(vc + (size_t)NB * 2 * 128 * 64 * 2);
    static constexpr size_t ob = al256(vcT + (size_t)NB * 2 * 128 * 64 * 2);
    static constexpr size_t tbuf = al256(ob + (size_t)NTOK * DM * 2);
    static constexpr size_t x1f = al256(tbuf + (size_t)NTOK * DM * 4);
    static constexpr size_t x1b = al256(x1f + (size_t)NTOK * DM * 4);
    static constexpr size_t top_e = al256(x1b + (size_t)NTOK * DM * 2);
    static constexpr size_t gw = al256(top_e + (size_t)NTOK * 4 * 4);
    static constexpr size_t lists = al256(gw + (size_t)NTOK * 4 * 4);
    static constexpr size_t act = al256(lists + (size_t)NE * LIST_CAP * 4);
    static constexpr size_t ybuf = al256(act + (size_t)MAXSLOT * DFF * 2);
    static constexpr size_t xq = al256(ybuf + (size_t)MAXSLOT * DM * 2);
    static constexpr size_t WinQ = al256(xq + (size_t)NTOK * DM);
    static constexpr size_t total = al256(WinQ + (size_t)NL * NMAIN * 1024);
};
__device__ __forceinline__ Params make_params(const KArgs& k) {
    Params p;
    p.x = k.in[0]; p.w_in = k.in[1]; p.b_in = k.in[2]; p.sinks = k.in[3]; p.cmp_pe = k.in[4]; p.cmp_w1 = k.in[5]; p.cmp_w2 = k.in[6]; p.w_out = k.in[7];
    p.ln1_g = k.in[8]; p.ln1_b = k.in[9]; p.router_w = k.in[10]; p.router_b = k.in[11]; p.w_gu = k.in[12]; p.b_gu = k.in[13]; p.w_dn = k.in[14]; p.b_dn = k.in[15];
    p.ln2_g = k.in[16]; p.ln2_b = k.in[17]; p.out = k.out;
    char* w = k.ws;
    p.ctrl = (unsigned*)(w + WSL::ctrl); p.WinT = (bf16_t*)(w + WSL::WinT); p.WoT = (bf16_t*)(w + WSL::WoT); p.W1T = (bf16_t*)(w + WSL::W1T); p.W2T = (bf16_t*)(w + WSL::W2T);
    p.WguT = (bf16_t*)(w + WSL::WguT); p.WdnT = (bf16_t*)(w + WSL::WdnT); p.rwT = (float*)(w + WSL::rwT); p.binp = (float*)(w + WSL::binp); p.bgup = (float*)(w + WSL::bgup);
    p.b1c = (float*)(w + WSL::b1c); p.xf = (float*)(w + WSL::xf); p.xb = (bf16_t*)(w + WSL::xb); p.hb = (bf16_t*)(w + WSL::hb); p.hs = (float*)(w + WSL::hs); p.vT = (bf16_t*)(w + WSL::vT); p.kF = (bf16_t*)(w + WSL::kF);
    p.cF = (float*)(w + WSL::cF); p.kc = (bf16_t*)(w + WSL::kc); p.vc = (bf16_t*)(w + WSL::vc); p.vcT = (bf16_t*)(w + WSL::vcT); p.ob = (bf16_t*)(w + WSL::ob); p.tbuf = (float*)(w + WSL::tbuf);
    p.x1f = (float*)(w + WSL::x1f); p.x1b = (bf16_t*)(w + WSL::x1b); p.top_e = (int*)(w + WSL::top_e); p.gw = (float*)(w + WSL::gw); p.lists = (int*)(w + WSL::lists);
    p.act = (bf16_t*)(w + WSL::act); p.ybuf = (bf16_t*)(w + WSL::ybuf); p.xq = (unsigned char*)(w + WSL::xq); p.WinQ = (unsigned char*)(w + WSL::WinQ);
    return p;
}
__device__ __forceinline__ void grid_bar(const Params& p, char* lds) {
    XcdBarrier xb; xb.bar = p.ctrl + 1024; xb.x = xb_xcc_id(); xb.st = (volatile LAS unsigned*)(lds + LDS_BYTES - 16); xcd_barrier(xb);
}
__device__ __forceinline__ Params fresh_params(const KArgs& ka) {
    KArgs k2 = ka; size_t z = 0; asm volatile("" : "+s"(z));
    k2.ws = ka.ws + z;
    return make_params(k2);
}
#ifndef REP
#define REP 0
#endif
template <int L>
__device__ __forceinline__ void layer_fwd(const KArgs& ka, char* lds) {
    { const Params p = fresh_params(ka); phase_inproj(p, L, lds);        grid_bar(p, lds); }
    { const Params p = fresh_params(ka); phase_prep(p, L, lds);          grid_bar(p, lds); }
    { const Params p = fresh_params(ka); phase_attn<L == 0>(p, L, lds);  grid_bar(p, lds); }
    { const Params p = fresh_params(ka); phase_outproj(p, L, p.xb, lds);  grid_bar(p, lds); }
    { const Params p = fresh_params(ka); phase_ln1_router(p, L, lds);    grid_bar(p, lds); }
    { const Params p = fresh_params(ka); phase_gateup(p, L, lds);        grid_bar(p, lds); }
    { const Params p = fresh_params(ka); phase_down(p, L, lds);          grid_bar(p, lds); }
    { const Params p = fresh_params(ka); phase_ln2(p, L, L == NL - 1 ? p.out : p.xf, lds); }
}
__global__ void __launch_bounds__(NTHR, 2) fwd_kernel(KArgs ka) {
    extern __shared__ __attribute__((aligned(16))) char lds[];
    const Params p = make_params(ka);
    cg::grid_group grid = cg::this_grid();
    volatile LAS unsigned* xst = (volatile LAS unsigned*)(lds + LDS_BYTES - 16);
    if (threadIdx.x == 0) { xst[0] = 0u; xst[1] = 0u; }
    __syncthreads();
    (void)xcd_barrier_post(p.ctrl + 1024, xst);
    volatile LAS int* vcu = (volatile LAS int*)(lds + LDS_BYTES - 32);
    const unsigned myx = xb_xcc_id() & 7u;
    if (threadIdx.x == 0) vcu[1] = (int)__hip_atomic_fetch_add(p.ctrl + 32 + myx, 1u, __ATOMIC_RELAXED, __HIP_MEMORY_SCOPE_AGENT);
    phase0(p, lds);
    grid.sync();
    if (threadIdx.x == 0) {
        int base = 0, tot = 0;
        for (unsigned x = 0; x < 8; ++x) { const int n = (int)__hip_atomic_load(p.ctrl + 32 + x, __ATOMIC_RELAXED, __HIP_MEMORY_SCOPE_AGENT); if (x < myx) base += n; tot += n; }
        vcu[0] = (tot == (int)gridDim.x) ? base + vcu[1] : (int)blockIdx.x;
    }
    __syncthreads();
    layer_fwd<0>(ka, lds);
    grid_bar(p, lds);
    layer_fwd<1>(ka, lds);
}

extern "C" void kernel_launch(void* const* d_in, const int* in_sizes, int n_in, void* d_out, int out_size, void* d_ws, size_t ws_size, hipStream_t stream) {
    KArgs ka{};
    for (int i = 0; i < 18; ++i) ka.in[i] = (const float*)d_in[i];
    ka.out = (float*)d_out; ka.ws = (char*)d_ws;
    if (WSL::total > ws_size) { fprintf(stderr, "workspace too small: need %zu have %zu\n", (size_t)WSL::total, ws_size); return; }
    static int grid_blocks = 0;
    if (!grid_blocks) {
        int dev = 0, cus = 0, per_cu = 0;
        (void)hipGetDevice(&dev);
        (void)hipDeviceGetAttribute(&cus, hipDeviceAttributeMultiprocessorCount, dev);
        (void)hipFuncSetAttribute((const void*)fwd_kernel, hipFuncAttributeMaxDynamicSharedMemorySize, LDS_BYTES);
        (void)hipOccupancyMaxActiveBlocksPerMultiprocessor(&per_cu, fwd_kernel, NTHR, LDS_BYTES);
        if (per_cu < 1) { fprintf(stderr, "occupancy query says 0 blocks per CU\n"); per_cu = 1; }
        grid_blocks = cus;
    }
    (void)hipMemsetAsync(d_ws, 0, 65536, stream);
    void* args[] = {&ka};
    hipError_t e = hipLaunchCooperativeKernel((const void*)fwd_kernel, dim3(grid_blocks), dim3(NTHR), args, LDS_BYTES, stream);
    if (e != hipSuccess) fprintf(stderr, "cooperative launch failed: %s (grid %d)\n", hipGetErrorString(e), grid_blocks);
}
```

```cpp
#include <hip/hip_runtime.h>
#include <hip/hip_cooperative_groups.h>
#include <cstdio>
#include <cstdint>
namespace cg = cooperative_groups;

typedef unsigned short bf16_t;
typedef short bf16x8 __attribute__((ext_vector_type(8)));
typedef float f32x4 __attribute__((ext_vector_type(4)));
typedef unsigned u32x4 __attribute__((ext_vector_type(4)));
typedef unsigned u32x2 __attribute__((ext_vector_type(2)));
typedef int v8i_t __attribute__((ext_vector_type(8)));
typedef float f32x2_t __attribute__((ext_vector_type(2)));
typedef int v4i_t __attribute__((ext_vector_type(4)));
#define LAS __attribute__((address_space(3)))
constexpr float NEG_INF = -__builtin_huge_valf();

constexpr int DM = 1024, NB = 16, SEQ = 2048, NTOK = NB * SEQ, NL = 2;
constexpr int NCOL = 2582, NMAIN = 2560, NPAD = 2688, NE = 32, DFF = 1024;
constexpr int C_FQ = 0, C_FK = 256, C_FV = 512, C_SQ = 768, C_SK = 1152, C_SV = 1280, C_NQ = 1408,
              C_NKC = 1792, C_NVC = 1920, C_NKS = 2048, C_NVS = 2176, C_NKW = 2304, C_NVW = 2432;
constexpr int HS_W = 32;
constexpr int NVH = 10;
constexpr int LIST_CAP = NTOK;
constexpr int MAXSLOT = NTOK * 4 + NE * 256;
constexpr float ALPHA = 1.41421356237f, LN_EPS = 1e-5f, QSCALE = 0.125f;
constexpr float GATE_PRE = -2.455466929f;
constexpr int NWV = 8, NTHR = NWV * 64;
constexpr int LDS_STAGE = 131072, LDS_TAB = LDS_STAGE, LDS_AOFF = LDS_STAGE + 2048, LDS_BIAS = LDS_AOFF + 20480, LDS_BYTES = LDS_BIAS + 3072 + 256;

struct Params {
    const float *x, *w_in, *b_in, *sinks, *cmp_pe, *cmp_w1, *cmp_w2, *w_out, *ln1_g, *ln1_b, *router_w, *router_b,
                *w_gu, *b_gu, *w_dn, *b_dn, *ln2_g, *ln2_b;
    float* out;
    unsigned* ctrl;
    bf16_t *WinT, *WoT, *W1T, *W2T, *WguT, *WdnT;
    float *rwT, *binp, *bgup, *b1c;
    unsigned char* xq; unsigned char* WinQ;
    float* xf; bf16_t* xb; bf16_t* hb; float* hs; bf16_t* vT; bf16_t* kF; float* cF;
    bf16_t *kc, *vc, *vcT; bf16_t* ob; float* tbuf; float* x1f; bf16_t* x1b;
    int* top_e; float* gw; int* lists; bf16_t* act; bf16_t* ybuf;
};

__device__ __forceinline__ float bf2f(bf16_t h) { return __uint_as_float(((unsigned)h) << 16); }
typedef __bf16 bf16x2_t __attribute__((ext_vector_type(2)));
__device__ __forceinline__ bf16_t f2bf(float f) { return __builtin_bit_cast(bf16_t, (__bf16)f); }
__device__ __forceinline__ unsigned pack2(float lo, float hi) { bf16x2_t v = {(__bf16)lo, (__bf16)hi}; return __builtin_bit_cast(unsigned, v); }
__device__ __forceinline__ unsigned pack4_fp8(float a, float b, float c, float d) {
    unsigned w = 0u;
    w = __builtin_amdgcn_cvt_pk_fp8_f32(a, b, w, false);
    w = __builtin_amdgcn_cvt_pk_fp8_f32(c, d, w, true);
    return w;
}
__device__ __forceinline__ float shfl_f(float v, int src_lane) { return __int_as_float(__builtin_amdgcn_ds_bpermute(src_lane << 2, __float_as_int(v))); }
__device__ __forceinline__ unsigned shfl_u(unsigned v, int src_lane) { return (unsigned)__builtin_amdgcn_ds_bpermute(src_lane << 2, (int)v); }
__device__ __forceinline__ float wave_sum(float v) {
#pragma unroll
    for (int o = 32; o > 0; o >>= 1) v += __shfl_xor(v, o);
    return v;
}
__device__ __forceinline__ float wave_max(float v) {
#pragma unroll
    for (int o = 32; o > 0; o >>= 1) v = fmaxf(v, __shfl_xor(v, o));
    return v;
}
__device__ __forceinline__ void lds_wave_sync() { asm volatile("s_waitcnt lgkmcnt(0)" ::: "memory"); __builtin_amdgcn_wave_barrier(); }
__device__ __forceinline__ float slope_swa(int hq) { return exp2f(-8.0f * (float)(2 * hq + 1) / 12.0f); }
__device__ __forceinline__ float slope_nsa(int hq) { return exp2f(-8.0f * (float)(2 * hq + 2) / 12.0f); }

__device__ __forceinline__ int fwd128(int L) { return (L & ~31) | (((L >> 2) & 1) << 4) | (((L >> 3) & 3) << 2) | (L & 3); }
__device__ __forceinline__ int inv128(int p) { return (p & ~31) | (((p >> 2) & 3) << 3) | (((p >> 4) & 1) << 2) | (p & 3); }
__device__ __forceinline__ int fwd256(int L) { return (L & ~255) | (((L >> 3) & 1) << 7) | (((L >> 6) & 3) << 5) | (((L >> 2) & 1) << 4) | (((L >> 4) & 3) << 2) | (L & 3); }
__device__ __forceinline__ int perm_row(int perm, int n) {
    if (perm == 1) { int r; if (n < 768) r = n; else if (n < 772) r = 2560 + (n - 768); else if (n < 2564) r = n - 4; else r = n; return r < 2560 ? fwd128(r) : r; }
    if (perm == 2) { const int f = n >> 1, s = n & 1; return (f >> 7) * 256 + s * 128 + fwd128(f & 127); }
    if (perm == 3) return fwd256(n);
    return n;
}
struct ConvJob { const float* src; bf16_t* dst; int K, N, kt, nt, perm; float q8; };
__device__ __forceinline__ bool conv_job(const Params& p, int t, ConvJob& jb) {
    constexpr int T_WIN = NL * 8 * 21, T_WO = NL * 8 * 8, T_WINB = NL * 8 * 2;
    if (t < T_WINB) { const int m = t / 16, r = t % 16; jb = ConvJob{p.w_in + (size_t)m * 1024 * NCOL, p.WinT + (size_t)m * NPAD * 1024, 1024, NCOL, r >> 1, (r & 1) ? 20 : 6, 1, 0.f}; return true; }
    t -= T_WINB;
    if (t < T_WO) { const int m = t / 64, r = t % 64; jb = ConvJob{p.w_out + (size_t)m * 1024 * 1024, (bf16_t*)((char*)p.WoT + (size_t)m * 1024 * 1024), 1024, 1024, r / 8, r % 8, 3, 64.0f}; return true; }
    t -= T_WO;
    if (t < T_WIN) { const int m = t / 168, r = t % 168; jb = ConvJob{p.w_in + (size_t)m * 1024 * NCOL, (bf16_t*)(p.WinQ + (size_t)m * NMAIN * 1024), 1024, NCOL, r / 21, r % 21, 1, 64.0f}; return true; }
    return false;
}
constexpr int CONV_TILES = NL * NE * 192;
__device__ __forceinline__ void conv_tile_wave(const Params& p, int t, int lane, unsigned char* l8) {
    asm volatile("" : "+v"(lane));
    const int m = t / 192, r = t % 192;
    const float* src; unsigned char* dst; int N, kt, nt, perm;
    if (r < 128) { src = p.w_gu + (size_t)m * 1024 * 2048; dst = (unsigned char*)p.WguT + (size_t)m * 2048 * 1024; N = 2048; kt = r >> 4; nt = r & 15; perm = 2; }
    else { const int q = r - 128; src = p.w_dn + (size_t)m * 1024 * 1024; dst = (unsigned char*)p.WdnT + (size_t)m * 1024 * 1024; N = 1024; kt = q >> 3; nt = q & 7; perm = 3; }
    const float* s = src + (size_t)(kt * 128 + (lane >> 5)) * N + nt * 128 + (lane & 31) * 4;
    unsigned char* lw = l8 + (lane >> 5) * 132 + (lane & 31) * 4;
    const float sg = (perm == 2) ? 64.0f * GATE_PRE : 64.0f;
    float4 va[16], vb[16];
#pragma unroll
    for (int i = 0; i < 16; ++i) va[i] = *(const float4*)(s + (size_t)(2 * i) * N);
#pragma unroll
    for (int i = 0; i < 16; ++i) vb[i] = *(const float4*)(s + (size_t)(32 + 2 * i) * N);
#pragma unroll
    for (int i = 0; i < 16; ++i) *(unsigned*)(lw + (2 * i) * 132) = pack4_fp8(va[i].x * sg, va[i].y * 64.0f, va[i].z * sg, va[i].w * 64.0f);
#pragma unroll
    for (int i = 0; i < 16; ++i) va[i] = *(const float4*)(s + (size_t)(64 + 2 * i) * N);
#pragma unroll
    for (int i = 0; i < 16; ++i) *(unsigned*)(lw + (32 + 2 * i) * 132) = pack4_fp8(vb[i].x * sg, vb[i].y * 64.0f, vb[i].z * sg, vb[i].w * 64.0f);
#pragma unroll
    for (int i = 0; i < 16; ++i) vb[i] = *(const float4*)(s + (size_t)(96 + 2 * i) * N);
#pragma unroll
    for (int i = 0; i < 16; ++i) *(unsigned*)(lw + (64 + 2 * i) * 132) = pack4_fp8(va[i].x * sg, va[i].y * 64.0f, va[i].z * sg, va[i].w * 64.0f);
#pragma unroll
    for (int i = 0; i < 16; ++i) *(unsigned*)(lw + (96 + 2 * i) * 132) = pack4_fp8(vb[i].x * sg, vb[i].y * 64.0f, vb[i].z * sg, vb[i].w * 64.0f);
    lds_wave_sync();
#pragma unroll 4
    for (int i = 0; i < 16; ++i) {
        const int idx = lane + 64 * i, kc = idx & 7, nn = idx >> 3;
        const unsigned char* l = l8 + (kc * 16) * 132 + nn;
        u32x4 w;
        w.x = (unsigned)l[0] | ((unsigned)l[132] << 8) | ((unsigned)l[264] << 16) | ((unsigned)l[396] << 24);
        w.y = (unsigned)l[528] | ((unsigned)l[660] << 8) | ((unsigned)l[792] << 16) | ((unsigned)l[924] << 24);
        w.z = (unsigned)l[1056] | ((unsigned)l[1188] << 8) | ((unsigned)l[1320] << 16) | ((unsigned)l[1452] << 24);
        w.w = (unsigned)l[1584] | ((unsigned)l[1716] << 8) | ((unsigned)l[1848] << 16) | ((unsigned)l[1980] << 24);
        *(u32x4*)(dst + (size_t)perm_row(perm, nt * 128 + nn) * 1024 + kt * 128 + kc * 16) = w;
    }
    lds_wave_sync();
}
__device__ __forceinline__ void conv_load(const ConvJob& jb, int tid, float2 (&v)[16]) {
    const int n = jb.nt * 128 + (tid & 31) * 4;
    const float* s = jb.src + (size_t)(jb.kt * 128 + (tid >> 5)) * jb.N + n;
#pragma unroll
    for (int i = 0; i < 8; ++i) {
        const float* r = s + (size_t)(16 * i) * jb.N;
        v[2 * i] = (n + 1 < jb.N) ? *(const float2*)r : make_float2(0.f, 0.f);
        v[2 * i + 1] = (n + 3 < jb.N) ? *(const float2*)(r + 2) : make_float2(0.f, 0.f);
    }
}
__device__ __forceinline__ void phase0(const Params& p, char* ldsc) {
    int tid = threadIdx.x; asm volatile("" : "+v"(tid));
    const int G = gridDim.x, bid = blockIdx.x;
    const size_t gtid = (size_t)bid * NTHR + tid, gthreads = (size_t)G * NTHR;
    {
        constexpr int TOT = NL * 8 * 2 + NL * 8 * 21 + NL * 8 * 8;
        bf16_t* lt = (bf16_t*)ldsc;
        ConvJob jb, jn; float2 v[16], vn[16];
        int t = bid; bool have = t < TOT && conv_job(p, t, jb);
        if (have) conv_load(jb, tid, v);
        while (have) {
            const int tn = t + G; const bool hn = tn < TOT && conv_job(p, tn, jn);
            if (hn) conv_load(jn, tid, vn);
            if (jb.q8 != 0.f) {
                unsigned char* l8 = (unsigned char*)lt;
#pragma unroll
                for (int i = 0; i < 8; ++i)
                {   int kl = (tid >> 5) + 16 * i;
                    if (jb.perm == 3) kl = (kl & 64) | (((kl >> 2) & 3) << 4) | (((kl >> 4) & 3) << 2) | (kl & 3);
                    *(unsigned*)(l8 + kl * 132 + (tid & 31) * 4) = pack4_fp8(v[2 * i].x * jb.q8, v[2 * i].y * jb.q8, v[2 * i + 1].x * jb.q8, v[2 * i + 1].y * jb.q8); }
                __syncthreads();
#pragma unroll
                for (int i = 0; i < 2; ++i) {
                    const int idx = tid + NTHR * i, kc = idx & 7, nn = idx >> 3, n = jb.nt * 128 + nn;
                    const unsigned char* l = l8 + (kc * 16) * 132 + nn;
                    u32x4 w;
                    w.x = (unsigned)l[0] | ((unsigned)l[132] << 8) | ((unsigned)l[264] << 16) | ((unsigned)l[396] << 24);
                    w.y = (unsigned)l[528] | ((unsigned)l[660] << 8) | ((unsigned)l[792] << 16) | ((unsigned)l[924] << 24);
                    w.z = (unsigned)l[1056] | ((unsigned)l[1188] << 8) | ((unsigned)l[1320] << 16) | ((unsigned)l[1452] << 24);
                    w.w = (unsigned)l[1584] | ((unsigned)l[1716] << 8) | ((unsigned)l[1848] << 16) | ((unsigned)l[1980] << 24);
                    const int pr = perm_row(jb.perm, n);
                    if (n < jb.N && !(jb.perm == 1 && pr >= NMAIN)) *(u32x4*)((char*)jb.dst + (size_t)pr * jb.K + jb.kt * 128 + kc * 16) = w;
                }
            } else {
#pragma unroll
                for (int i = 0; i < 8; ++i) {
                    u32x2 w; w.x = pack2(v[2 * i].x, v[2 * i].y); w.y = pack2(v[2 * i + 1].x, v[2 * i + 1].y);
                    *(u32x2*)(lt + ((tid >> 5) + 16 * i) * 136 + (tid & 31) * 4) = w;
                }
                __syncthreads();
#pragma unroll
                for (int i = 0; i < 4; ++i) {
                    const int idx = tid + NTHR * i, kc = idx & 15, nn = idx >> 4, n = jb.nt * 128 + nn;
                    if (n < jb.N) {
                        const bf16_t* l = lt + (kc * 8) * 136 + nn;
                        u32x4 w;
                        w.x = (unsigned)l[0] | ((unsigned)l[136] << 16); w.y = (unsigned)l[272] | ((unsigned)l[408] << 16);
                        w.z = (unsigned)l[544] | ((unsigned)l[680] << 16); w.w = (unsigned)l[816] | ((unsigned)l[952] << 16);
                        *(u32x4*)(jb.dst + (size_t)perm_row(jb.perm, n) * jb.K + jb.kt * 128 + kc * 8) = w;
                    }
                }
            }
            __syncthreads();
            t = tn; have = hn; jb = jn;
#pragma unroll
            for (int i = 0; i < 16; ++i) v[i] = vn[i];
        }
    }
    for (size_t i = gtid; i < (size_t)NL * 2 * 2048 * 64; i += gthreads) {
        const int k = (int)(i % 2048), n = (int)((i / 2048) % 64), m = (int)(i / (2048 * 64));
        p.W1T[i] = f2bf(p.cmp_w1[((size_t)m * 2048 + k) * 64 + n]);
    }
    for (size_t i = gtid; i < (size_t)NL * 2 * 64 * 64; i += gthreads) {
        const int k = (int)(i % 64), n = (int)((i / 64) % 64), m = (int)(i / 4096);
        p.W2T[i] = f2bf(p.cmp_w2[((size_t)m * 64 + k) * 64 + n]);
    }
    for (size_t i = gtid; i < (size_t)NL * NPAD; i += gthreads) {
        const int l = (int)(i / NPAD), ri = (int)(i % NPAD), r = ri < 2560 ? inv128(ri) : ri;
        float v = 0.f;
        if (r < 2560) { const int n = r < 768 ? r : r + 4; v = p.b_in[l * NCOL + n]; }
        else if (r < 2564) v = p.b_in[l * NCOL + 768 + (r - 2560)];
        else if (r < 2582) v = p.b_in[l * NCOL + r];
        p.binp[i] = v;
    }
    for (size_t i = gtid; i < (size_t)NL * NE * 2048; i += gthreads) {
        const int r = (int)(i % 2048); const size_t le = i / 2048;
        const int s = (r >> 7) & 1, f = (r >> 8) * 128 + inv128(r & 127);
        p.bgup[i] = p.b_gu[le * 2048 + 2 * f + s] * (s == 0 ? GATE_PRE : 1.0f);
    }
    for (size_t i = gtid; i < (size_t)NL * NE * 1024; i += gthreads) {
        const int k = (int)(i % 1024), e = (int)((i / 1024) % NE), l = (int)(i / (1024 * NE));
        p.rwT[i] = p.router_w[((size_t)l * 1024 + k) * NE + e];
    }
    for (size_t i = gtid; i < (size_t)NL * (NPAD - NCOL) * 1024; i += gthreads) {
        const int l = (int)(i / ((NPAD - NCOL) * 1024)); const size_t r = i % ((size_t)(NPAD - NCOL) * 1024);
        p.WinT[(size_t)l * NPAD * 1024 + (size_t)NCOL * 1024 + r] = 0;
    }
    {
        constexpr size_t N16 = (size_t)NTOK * DM / 16;
        for (size_t i0 = gtid; i0 < N16; i0 += gthreads * 2) {
            float4 v[2][4];
#pragma unroll
            for (int u = 0; u < 2; ++u) { const size_t i = i0 + u * gthreads;
#pragma unroll
                for (int j = 0; j < 4; ++j) v[u][j] = (i < N16) ? ((const float4*)p.x)[i * 4 + j] : make_float4(0.f, 0.f, 0.f, 0.f); }
#pragma unroll
            for (int u = 0; u < 2; ++u) { const size_t i = i0 + u * gthreads;
                if (i < N16) {
                    u32x4 w0, w1, q;
                    w0.x = pack2(v[u][0].x, v[u][0].y); w0.y = pack2(v[u][0].z, v[u][0].w); w0.z = pack2(v[u][1].x, v[u][1].y); w0.w = pack2(v[u][1].z, v[u][1].w);
                    w1.x = pack2(v[u][2].x, v[u][2].y); w1.y = pack2(v[u][2].z, v[u][2].w); w1.z = pack2(v[u][3].x, v[u][3].y); w1.w = pack2(v[u][3].z, v[u][3].w);
                    q.x = pack4_fp8(v[u][0].x, v[u][0].y, v[u][0].z, v[u][0].w); q.y = pack4_fp8(v[u][1].x, v[u][1].y, v[u][1].z, v[u][1].w);
                    q.z = pack4_fp8(v[u][2].x, v[u][2].y, v[u][2].z, v[u][2].w); q.w = pack4_fp8(v[u][3].x, v[u][3].y, v[u][3].z, v[u][3].w);
                    ((u32x4*)p.xb)[i * 2] = w0; ((u32x4*)p.xb)[i * 2 + 1] = w1; ((u32x4*)p.xq)[i] = q;
                }
            }
        }
    }
    if (bid < 32) {
        float* lf = (float*)ldsc;
        const int j = tid & 63, part = tid >> 6, lw = bid >> 3, sl = bid & 7;
        const float* pe = p.cmp_pe + (size_t)lw * 2048; const float* w1 = p.cmp_w1 + (size_t)lw * 2048 * 64;
        float s = 0.f;
#pragma unroll 8
        for (int kk = sl * 256 + part * 32; kk < sl * 256 + part * 32 + 32; ++kk) s += pe[kk] * w1[(size_t)kk * 64 + j];
        lf[tid] = s; __syncthreads();
        if (tid < 64) { float a = 0.f; for (int q = 0; q < 8; ++q) a += lf[tid + 64 * q]; p.b1c[(lw * 8 + sl) * 64 + tid] = a; }
        __syncthreads();
    }
}

__device__ __forceinline__ int vcu_id() { return __builtin_amdgcn_readfirstlane(*(const volatile LAS int*)(LDS_BYTES - 32)); }
namespace pg8 {
constexpr int BM = 256, BK = 64, HALF = 128, HTB = HALF * BK * 2, NXCD = 8, WGM = 8;
__device__ __forceinline__ int lds_byte(int r, int c) { const int ch = (c >> 3) ^ ((r >> 1) & 7); return (r >> 3) * 1024 + (r & 7) * 128 + ch * 16 + (c & 7) * 2; }
__device__ __forceinline__ void stage_rc(int b, int& R, int& C) { const int st = b / 1024, sb = b % 1024; R = st * 8 + sb / 128; C = ((((sb % 128) / 16) ^ ((R >> 1) & 7)) * 16 + (sb % 16)) / 2; }
__device__ __forceinline__ bool tile_order(int i, int G, int c, int nM, int nN, int& pm, int& pn) {
    const int nwg = nM * nN; const long L = (long)i * G + c; if (L >= nwg) return false;
    const int wgid = (int)L;
    const int nig = WGM * nN, gid = wgid / nig, fm = gid * WGM, gsz = (nM - fm) < WGM ? (nM - fm) : WGM;
    pm = fm + ((wgid % nig) % gsz); pn = (wgid % nig) / gsz; return true;
}
template <bool FP8, int SCA, class Sched, class Epi>
__device__ __forceinline__ void gemm_phase(LAS unsigned char* lds, const char* Abase, int K, const Sched& S, const Epi& E) {
    int tid = threadIdx.x; asm volatile("" : "+v"(tid));
    const int wid = __builtin_amdgcn_readfirstlane(tid >> 6), lane = tid & 63, wr = wid >> 2, wc = wid & 3, fr = lane & 15, fq = lane >> 4;
    const int nt = K / BK;
    int R0, C0, R1, C1; stage_rc(tid * 16, R0, C0); stage_rc(tid * 16 + 8192, R1, C1);
    LAS unsigned* aofs = (LAS unsigned*)(lds + LDS_AOFF) + tid;
    unsigned rg[10];
    rg[8] = (unsigned)(R0 * K + C0) * 2u; rg[9] = (unsigned)(R1 * K + C1) * 2u;
    if constexpr (FP8) { aofs[8 * NTHR] = rg[8]; aofs[9 * NTHR] = rg[9]; }
    const size_t kstep = (size_t)(BK * 2), hstep = (size_t)HALF * K * 2;
    const unsigned ldsw = (unsigned)wid * 1024u;
    const int aoff = lds_byte(wr * 64 + fr, fq * 8), boff = lds_byte(wc * 32 + fr, fq * 8);
#define PG8_SA(b, h) (((b) * 2 + (h)) * HTB)
#define PG8_SB(b, h) ((4 + (b) * 2 + (h)) * HTB)
#define PG8_OFS(sel, j) (FP8 ? aofs[((sel) * 4 + (j)) * NTHR] : ((sel) ? rg[4 + (j)] : rg[(j)]))
#define PG8_STAGE_B(bufoff, gbase) do { _Pragma("unroll") for (int _i = 0; _i < 2; ++_i) { const unsigned ob_ = FP8 ? aofs[(8 + _i) * NTHR] : rg[8 + _i]; \
        __builtin_amdgcn_global_load_lds((const unsigned*)((const char*)(gbase) + ob_), (LAS unsigned*)(lds + (bufoff) + ldsw + _i * 8192), 16, 0, 0); } } while (0)
#define PG8_STAGE_A(bufoff, kbyte, sel, h) do { const unsigned o0_ = PG8_OFS(sel, (h) * 2), o1_ = PG8_OFS(sel, (h) * 2 + 1); \
        __builtin_amdgcn_global_load_lds((const unsigned*)(Abase + (kbyte) + o0_), (LAS unsigned*)(lds + (bufoff) + ldsw), 16, 0, 0); \
        __builtin_amdgcn_global_load_lds((const unsigned*)(Abase + (kbyte) + o1_), (LAS unsigned*)(lds + (bufoff) + ldsw + 8192), 16, 0, 0); } while (0)
#define PG8_LDA(dst, b, h) do { _Pragma("unroll") for (int m = 0; m < 4; ++m) { \
        if constexpr (FP8) { const v4i_t lo_ = *(const LAS v4i_t*)(lds + PG8_SA(b, h) + aoff + m * 2048), hi_ = *(const LAS v4i_t*)(lds + PG8_SA(b, h) + (aoff ^ 64) + m * 2048); dst##8[m] = __builtin_shufflevector(lo_, hi_, 0, 1, 2, 3, 4, 5, 6, 7); } \
        else { _Pragma("unroll") for (int k = 0; k < 2; ++k) dst[m][k] = *(const LAS bf16x8*)(lds + PG8_SA(b, h) + (aoff ^ (k * 64)) + m * 2048); } } } while (0)
#define PG8_LDB(dst, b, h) do { _Pragma("unroll") for (int n = 0; n < 2; ++n) { \
        if constexpr (FP8) { const v4i_t lo_ = *(const LAS v4i_t*)(lds + PG8_SB(b, h) + boff + n * 2048), hi_ = *(const LAS v4i_t*)(lds + PG8_SB(b, h) + (boff ^ 64) + n * 2048); dst##8[n] = __builtin_shufflevector(lo_, hi_, 0, 1, 2, 3, 4, 5, 6, 7); } \
        else { _Pragma("unroll") for (int k = 0; k < 2; ++k) dst[n][k] = *(const LAS bf16x8*)(lds + PG8_SB(b, h) + (boff ^ (k * 64)) + n * 2048); } } } while (0)
#define PG8_MMA(ai, bj, At, Bt) do { __builtin_amdgcn_s_setprio(1); _Pragma("unroll") for (int m = 0; m < 4; ++m) _Pragma("unroll") for (int n = 0; n < 2; ++n) { \
        if constexpr (FP8) { acc[ai][bj][m][n] = __builtin_amdgcn_mfma_scale_f32_16x16x128_f8f6f4(Bt##8[n], At##8[m], acc[ai][bj][m][n], 0, 0, 0, SCA, 0, SCA); } \
        else { _Pragma("unroll") for (int k = 0; k < 2; ++k) acc[ai][bj][m][n] = __builtin_amdgcn_mfma_f32_16x16x32_bf16(Bt[n][k], At[m][k], acc[ai][bj][m][n], 0, 0, 0); } } \
        __builtin_amdgcn_s_setprio(0); } while (0)
#define PG8_WAIT_V(n) asm volatile("s_waitcnt vmcnt(" #n ")" ::: "memory")
#define PG8_WAIT_L(n) asm volatile("s_waitcnt lgkmcnt(" #n ")" ::: "memory")
#define PG8_BAR __builtin_amdgcn_s_barrier()
#define PG8_SCHED __builtin_amdgcn_sched_barrier(0)
    typename Sched::Unit cur, nxt; int ui = 0;
    if (!S.next(0, cur)) return;
    f32x4 acc[2][2][4][2];
    bf16x8 At[4][2], B0[2][2], B1[2][2];
    v8i_t At8[4], B08[2], B18[2];
    { unsigned a4[2][2]; S.a_off(cur, R0, C0, R1, C1, a4); rg[0] = a4[0][0]; rg[1] = a4[0][1]; rg[2] = a4[1][0]; rg[3] = a4[1][1];
      if constexpr (FP8) { aofs[0] = a4[0][0]; aofs[NTHR] = a4[0][1]; aofs[2 * NTHR] = a4[1][0]; aofs[3 * NTHR] = a4[1][1]; } }
    const char* cB = S.b_ptr(cur);
#define PG8_BIAS_DMA(unit, slot) do { const float* bp_ = E.bias_ptr(unit); int tb_ = threadIdx.x; asm volatile("" : "+v"(tb_)); if (wr == 0 && bp_ != nullptr) \
        __builtin_amdgcn_global_load_lds((const unsigned*)(bp_ + (tb_ & 255)), (LAS unsigned*)(lds + LDS_BIAS + (slot) * 1024 + wid * 256), 4, 0, 0); } while (0)
    PG8_BIAS_DMA(cur, 0);
    PG8_STAGE_B(PG8_SB(0, 0), cB); PG8_STAGE_B(PG8_SB(0, 1), cB + hstep); PG8_STAGE_A(PG8_SA(0, 0), 0, 0, 0); PG8_STAGE_A(PG8_SA(0, 1), 0, 0, 1);
    if (wr == 1) PG8_BAR;
    PG8_WAIT_V(2); PG8_BAR;
    PG8_STAGE_B(PG8_SB(1, 0), cB + kstep); PG8_STAGE_A(PG8_SA(1, 0), kstep, 0, 0); PG8_STAGE_B(PG8_SB(1, 1), cB + hstep + kstep);
    PG8_WAIT_V(6); PG8_BAR;
    { int t3 = threadIdx.x; asm volatile("" : "+v"(t3)); E.init(acc, wc, (t3 & 63) >> 4, (const LAS float*)(lds + LDS_BIAS)); }
    for (;;) {
        const bool has_next = S.next(ui + 1, nxt);
        const char* nB = cB;
        if (has_next) PG8_BIAS_DMA(nxt, (ui + 1) % 3);
        if (has_next) { int t2 = threadIdx.x; asm volatile("" : "+v"(t2)); int r0, c0, r1, c1; stage_rc(t2 * 16, r0, c0); stage_rc(t2 * 16 + 8192, r1, c1); nB = S.b_ptr(nxt);
            if constexpr (Sched::LIST_DMA) { static_assert(!Sched::LIST_DMA || FP8, "list DMA lands in the LDS offset slots"); S.a_dma(nxt, r0, r1, (LAS unsigned*)(lds + LDS_AOFF + 4 * NTHR * 4 + wid * 256)); }
            else { unsigned a4[2][2]; S.a_off(nxt, r0, c0, r1, c1, a4);
                rg[4] = a4[0][0]; rg[5] = a4[0][1]; rg[6] = a4[1][0]; rg[7] = a4[1][1];
                if constexpr (FP8) { aofs[4 * NTHR] = a4[0][0]; aofs[5 * NTHR] = a4[0][1]; aofs[6 * NTHR] = a4[1][0]; aofs[7 * NTHR] = a4[1][1]; } } }
        else { rg[4] = rg[0]; rg[5] = rg[1]; rg[6] = rg[2]; rg[7] = rg[3];
            if constexpr (FP8) { aofs[4 * NTHR] = aofs[0]; aofs[5 * NTHR] = aofs[NTHR]; aofs[6 * NTHR] = aofs[2 * NTHR]; aofs[7 * NTHR] = aofs[3 * NTHR]; } }
#pragma unroll 1
        for (int t = 0; t < nt; t += 2) {
            const bool last = (t == nt - 2);
            const size_t ka1 = (size_t)(t + 1) * kstep, ka2 = last ? 0 : (size_t)(t + 2) * kstep, ka3 = ka2 + kstep;
            const char* b2 = last ? nB : cB + (size_t)(t + 2) * kstep; const char* b3 = b2 + kstep;
            const int sel = last ? 1 : 0;
            if constexpr (Sched::LIST_DMA) if (last && has_next) {
                int t4 = threadIdx.x; asm volatile("" : "+v"(t4)); int r0, c0, r1, c1; stage_rc(t4 * 16, r0, c0); stage_rc(t4 * 16 + 8192, r1, c1);
#pragma unroll
                for (int j = 0; j < 4; ++j) aofs[(4 + j) * NTHR] = S.a_fin(aofs[(4 + j) * NTHR], (j & 1) ? c1 : c0);
            }
            PG8_LDB(B0, 0, 0); PG8_LDB(B1, 0, 1); PG8_SCHED; PG8_LDA(At, 0, 0); PG8_STAGE_A(PG8_SA(1, 1), ka1, 0, 1);
            PG8_WAIT_V(8); PG8_WAIT_L(0); PG8_BAR; PG8_MMA(0, 0, At, B0); PG8_MMA(0, 1, At, B1); PG8_BAR; PG8_SCHED;
            PG8_LDA(At, 0, 1); PG8_STAGE_B(PG8_SB(0, 0), b2); PG8_STAGE_B(PG8_SB(0, 1), b2 + hstep); PG8_STAGE_A(PG8_SA(0, 0), ka2, sel, 0);
            PG8_WAIT_V(8); PG8_WAIT_L(0); PG8_BAR; PG8_MMA(1, 0, At, B0); PG8_MMA(1, 1, At, B1); PG8_BAR; PG8_SCHED;
            PG8_LDB(B0, 1, 0); PG8_LDB(B1, 1, 1); PG8_SCHED; PG8_LDA(At, 1, 0); PG8_STAGE_A(PG8_SA(0, 1), ka2, sel, 1);
            PG8_WAIT_V(8); PG8_WAIT_L(0); PG8_BAR; PG8_MMA(0, 0, At, B0); PG8_MMA(0, 1, At, B1); PG8_BAR; PG8_SCHED;
            PG8_LDA(At, 1, 1); PG8_STAGE_B(PG8_SB(1, 0), b3); PG8_STAGE_B(PG8_SB(1, 1), b3 + hstep); PG8_STAGE_A(PG8_SA(1, 0), ka3, sel, 0);
            PG8_WAIT_V(8); PG8_WAIT_L(0); PG8_BAR; PG8_MMA(1, 0, At, B0); PG8_MMA(1, 1, At, B1); PG8_BAR; PG8_SCHED;
        }
        if (wr == 0) PG8_BAR;
        { int t2 = threadIdx.x; asm volatile("" : "+v"(t2)); E(acc, cur, wr, wc, t2 & 15, (t2 & 63) >> 4, (const LAS float*)(lds + LDS_BIAS + (ui % 3) * 1024)); }
        if (!has_next) break;
        { int t3 = threadIdx.x; asm volatile("" : "+v"(t3)); E.init(acc, wc, (t3 & 63) >> 4, (const LAS float*)(lds + LDS_BIAS + ((ui + 1) % 3) * 1024)); }
        cur = nxt; cB = nB; ++ui;
        rg[0] = rg[4]; rg[1] = rg[5]; rg[2] = rg[6]; rg[3] = rg[7];
        if constexpr (FP8) { aofs[0] = aofs[4 * NTHR]; aofs[NTHR] = aofs[5 * NTHR]; aofs[2 * NTHR] = aofs[6 * NTHR]; aofs[3 * NTHR] = aofs[7 * NTHR]; }
        if (wr == 1) PG8_BAR;
    }
    PG8_WAIT_V(0);
    PG8_BAR;
#undef PG8_BIAS_DMA
#undef PG8_SA
#undef PG8_SB
#undef PG8_STAGE_A
#undef PG8_OFS
#undef PG8_STAGE_B
#undef PG8_LDA
#undef PG8_LDB
#undef PG8_MMA
#undef PG8_WAIT_V
#undef PG8_WAIT_L
#undef PG8_BAR
#undef PG8_SCHED
}
}

struct DenseUnit { int pm, pn; };
struct DenseSched {
    typedef DenseUnit Unit;
    const char* Bt; int K, nM, nN, vc;
    __device__ __forceinline__ bool next(int i, Unit& u) const { return pg8::tile_order(i, gridDim.x, vc, nM, nN, u.pm, u.pn); }
    __device__ __forceinline__ void a_off(const Unit& u, int R0, int C0, int R1, int C1, unsigned (&off)[2][2]) const {
#pragma unroll
        for (int h = 0; h < 2; ++h) { off[h][0] = (unsigned)((u.pm * 256 + h * 128 + R0) * K + C0) * 2u; off[h][1] = (unsigned)((u.pm * 256 + h * 128 + R1) * K + C1) * 2u; }
    }
    __device__ __forceinline__ const char* b_ptr(const Unit& u) const { return Bt + (size_t)u.pn * 256 * K * 2; }
    static constexpr bool LIST_DMA = false;
    __device__ __forceinline__ void a_dma(const Unit&, int, int, LAS unsigned*) const {}
    __device__ __forceinline__ unsigned a_fin(unsigned raw, int) const { return raw; }
};
struct MoeUnit { int rbt, e, pn; };
template <bool GATHER>
struct MoeSched {
    typedef MoeUnit Unit;
    static constexpr int KP = 512;
    const char* Bt; const int* lists; const int* ptile; const int* ecnt; int nN, nrows, vc;
    __device__ __forceinline__ bool next(int i, Unit& u) const {
        int pm, pn; if (!pg8::tile_order(i, gridDim.x, vc, ptile[NE], nN, pm, pn)) return false;
        u.rbt = pm; u.e = ((const unsigned char*)ptile)[512 + pm]; u.pn = pn; return true;
    }
    __device__ __forceinline__ void a_off(const Unit& u, int R0, int C0, int R1, int C1, unsigned (&off)[2][2]) const {
        if (GATHER) {
            const int* lst = lists + (size_t)u.e * LIST_CAP; const int rb = u.rbt - ptile[u.e], cnt = ecnt[u.e];
#pragma unroll
            for (int h = 0; h < 2; ++h) {
                const int l0 = rb * 256 + h * 128 + R0, l1 = rb * 256 + h * 128 + R1;
                const int t0 = l0 < cnt ? (lst[l0] >> 2) : 0, t1 = l1 < cnt ? (lst[l1] >> 2) : 0;
                off[h][0] = (unsigned)(t0 * KP + C0) * 2u; off[h][1] = (unsigned)(t1 * KP + C1) * 2u;
            }
        } else {
#pragma unroll
            for (int h = 0; h < 2; ++h) { off[h][0] = (unsigned)((u.rbt * 256 + h * 128 + R0) * KP + C0) * 2u; off[h][1] = (unsigned)((u.rbt * 256 + h * 128 + R1) * KP + C1) * 2u; }
        }
    }
    __device__ __forceinline__ const char* b_ptr(const Unit& u) const { return Bt + ((size_t)u.e * nrows + (size_t)u.pn * 256) * KP * 2; }
    static constexpr bool LIST_DMA = GATHER;
    __device__ __forceinline__ void a_dma(const Unit& u, int R0, int R1, LAS unsigned* slot) const {
        const int* lst = lists + (size_t)u.e * LIST_CAP; const int rb = u.rbt - ptile[u.e], cm = ecnt[u.e] - 1;
#pragma unroll
        for (int h = 0; h < 2; ++h) {
            const int l0 = min(rb * 256 + h * 128 + R0, cm), l1 = min(rb * 256 + h * 128 + R1, cm);
            __builtin_amdgcn_global_load_lds((const unsigned*)(lst + l0), slot + (h * 2) * NTHR, 4, 0, 0);
            __builtin_amdgcn_global_load_lds((const unsigned*)(lst + l1), slot + (h * 2 + 1) * NTHR, 4, 0, 0);
        }
    }
    __device__ __forceinline__ unsigned a_fin(unsigned raw, int C) const { return (unsigned)((int)(raw >> 2) * KP + C) * 2u; }
};

__device__ __forceinline__ u32x2 quad_tr(unsigned p01, unsigned p23, int fr) {
    const unsigned sel = (fr & 1) ? 0x03020706u : 0x05040100u;
    const unsigned y01 = (unsigned)__builtin_amdgcn_update_dpp(0, (int)p01, 0xB1, 0xF, 0xF, true), y23 = (unsigned)__builtin_amdgcn_update_dpp(0, (int)p23, 0xB1, 0xF, 0xF, true);
    const unsigned q01 = __builtin_amdgcn_perm(y01, p01, sel), q23 = __builtin_amdgcn_perm(y23, p23, sel);
    const bool hi = (fr & 2) != 0;
    const unsigned snd = hi ? q01 : q23;
    const unsigned rcv = (unsigned)__builtin_amdgcn_update_dpp(0, (int)snd, 0x4E, 0xF, 0xF, true);
    u32x2 r; r.x = hi ? rcv : q01; r.y = hi ? q23 : rcv; return r;
}
struct EpiInProj {
    const Params* p; int l;
    __device__ __forceinline__ const float* bias_ptr(const DenseUnit& u) const { return p->binp + l * NPAD + u.pn * 256; }
    __device__ __forceinline__ void init(f32x4 (&acc)[2][2][4][2], int wc, int fq, const LAS float* bias) const {
#pragma unroll
        for (int bj = 0; bj < 2; ++bj)
#pragma unroll
            for (int n = 0; n < 2; ++n) {
                const f32x4 bv = *(const LAS f32x4*)(bias + bj * 128 + wc * 32 + n * 16 + 4 * fq);
#pragma unroll
                for (int ai = 0; ai < 2; ++ai)
#pragma unroll
                    for (int m = 0; m < 4; ++m) acc[ai][bj][m][n] = bv;
            }
    }
    __device__ __forceinline__ void operator()(const f32x4 (&acc)[2][2][4][2], const DenseUnit& u, int wr, int wc, int fr, int fq, const LAS float*) const {
#pragma unroll
        for (int bj = 0; bj < 2; ++bj) {
            int kind = 0, hb0 = 0;
            if (u.pn == 1) { kind = 1; hb0 = bj * 2; } else if (u.pn == 4 && bj == 1) { kind = 1; hb0 = 4; } else if (u.pn == 8 && bj == 0) { kind = 1; hb0 = 6; } else if (u.pn == 9 && bj == 0) { kind = 1; hb0 = 8; }
            else if (u.pn == 2) { kind = 2; hb0 = bj * 2; } else if (u.pn == 5 && bj == 0) { kind = 2; hb0 = 4; } else if (u.pn == 8 && bj == 1) { kind = 2; hb0 = 6; } else if (u.pn == 9 && bj == 1) { kind = 2; hb0 = 8; }
            const int c0 = wc * 32 + fq * 8;
            const int hh = hb0 + (c0 >> 6), d0 = c0 & 63;
#pragma unroll
            for (int ai = 0; ai < 2; ++ai)
#pragma unroll
                for (int m = 0; m < 4; ++m) {
                    const int row = u.pm * 256 + ai * 128 + wr * 64 + m * 16 + fr;
                    const f32x4 v0 = acc[ai][bj][m][0], v1 = acc[ai][bj][m][1];
                    u32x4 w; w.x = pack2(v0[0], v0[1]); w.y = pack2(v0[2], v0[3]); w.z = pack2(v1[0], v1[1]); w.w = pack2(v1[2], v1[3]);
                    if (kind == 0) *(u32x4*)(p->hb + (size_t)row * NMAIN + u.pn * 256 + bj * 128 + c0) = w;
                    else {
                        const int b = row >> 11, s = row & 2047, kk = s & 31;
                        bf16_t* blk = (kind == 1 ? p->kF : p->vT) + (((size_t)b * NVH + hh) * 64 + (s >> 5)) * 2048;
                        if (kind == 1) {
                            const int frk = (kk >> 3) * 4 + (kk & 3), t = (kk >> 2) & 1;
                            *(u32x4*)(blk + ((t * 2 + (d0 >> 5)) * 64 + ((d0 & 31) >> 3) * 16 + frk) * 8) = w;
                        } else {
                            const int kq = kk & 28;
                            const u32x2 t0 = quad_tr(w.x, w.y, fr), t1 = quad_tr(w.z, w.w, fr);
                            bf16_t* vt = blk + (((d0 >> 4) * 64) + (kq >> 3) * 16 + (d0 & 15) + (fr & 3)) * 8 + (kq & 7);
                            *(u32x2*)vt = t0; *(u32x2*)(vt + 32) = t1;
                        }
                    }
                }
        }
    }
};
struct EpiOutProj {
    const bf16_t* xin; float* t;
    __device__ __forceinline__ const float* bias_ptr(const DenseUnit&) const { return nullptr; }
    __device__ __forceinline__ void init(f32x4 (&acc)[2][2][4][2], int, int, const LAS float*) const {
#pragma unroll
        for (int ai = 0; ai < 2; ++ai)
#pragma unroll
            for (int bj = 0; bj < 2; ++bj)
#pragma unroll
                for (int m = 0; m < 4; ++m)
#pragma unroll
                    for (int n = 0; n < 2; ++n) acc[ai][bj][m][n] = (f32x4){0.f, 0.f, 0.f, 0.f};
    }
    __device__ __forceinline__ void operator()(const f32x4 (&acc)[2][2][4][2], const DenseUnit& u, int wr, int wc, int fr, int fq, const LAS float*) const {
#pragma unroll
        for (int ai = 0; ai < 2; ++ai)
#pragma unroll
            for (int m = 0; m < 4; ++m) {
                const size_t off = (size_t)(u.pm * 256 + ai * 128 + wr * 64 + m * 16 + fr) * DM + u.pn * 256 + wc * 64 + fq * 16;
                const u32x4 x0 = *(const u32x4*)(xin + off), x1 = *(const u32x4*)(xin + off + 8);
                const unsigned xs[8] = {x0.x, x0.y, x0.z, x0.w, x1.x, x1.y, x1.z, x1.w};
                unsigned w[8];
#pragma unroll
                for (int q = 0; q < 4; ++q) {
                    const f32x4 a = acc[ai][q >> 1][m][q & 1];
                    const float t0 = __uint_as_float(xs[2 * q] << 16) * ALPHA + a[0], t1 = __uint_as_float(xs[2 * q] & 0xffff0000u) * ALPHA + a[1];
                    const float t2 = __uint_as_float(xs[2 * q + 1] << 16) * ALPHA + a[2], t3 = __uint_as_float(xs[2 * q + 1] & 0xffff0000u) * ALPHA + a[3];
                    w[2 * q] = pack2(t0, t1); w[2 * q + 1] = pack2(t2, t3);
                }
                u32x4 w0, w1; w0.x = w[0]; w0.y = w[1]; w0.z = w[2]; w0.w = w[3]; w1.x = w[4]; w1.y = w[5]; w1.z = w[6]; w1.w = w[7];
                *(u32x4*)((bf16_t*)t + off) = w0; *(u32x4*)((bf16_t*)t + off + 8) = w1;
            }
    }
};
struct EpiGateUp {
    bf16_t* act; const float* bgup;
    __device__ __forceinline__ const float* bias_ptr(const MoeUnit& u) const { return bgup + (size_t)u.e * 2048 + u.pn * 256; }
    __device__ __forceinline__ void init(f32x4 (&acc)[2][2][4][2], int wc, int fq, const LAS float* bias) const {
#pragma unroll
        for (int bj = 0; bj < 2; ++bj)
#pragma unroll
            for (int n = 0; n < 2; ++n) {
                const f32x4 bv = *(const LAS f32x4*)(bias + bj * 128 + wc * 32 + n * 16 + 4 * fq);
#pragma unroll
                for (int ai = 0; ai < 2; ++ai)
#pragma unroll
                    for (int m = 0; m < 4; ++m) acc[ai][bj][m][n] = bv;
            }
    }
    __device__ __forceinline__ void operator()(const f32x4 (&acc)[2][2][4][2], const MoeUnit& u, int wr, int wc, int fr, int fq, const LAS float*) const {
        constexpr float GMIN = 7.0f * GATE_PRE, CI = 1.0f / GATE_PRE;
#pragma unroll
        for (int ai = 0; ai < 2; ++ai)
#pragma unroll
            for (int m = 0; m < 4; ++m) {
                u32x2 w;
#pragma unroll
                for (int n = 0; n < 2; ++n) {
                    const f32x4 g4 = acc[ai][0][m][n], u4 = acc[ai][1][m][n];
                    float o[4];
#pragma unroll
                    for (int j = 0; j < 4; ++j) {
                        const float gp = fmaxf(g4[j], GMIN), uu = fminf(fmaxf(u4[j], -7.0f), 7.0f);
                        const float glu = gp * __builtin_amdgcn_rcpf(1.0f + __builtin_amdgcn_exp2f(gp));
                        o[j] = __builtin_fmaf(uu, CI, CI) * glu;
                    }
                    const unsigned pk = pack4_fp8(o[0], o[1], o[2], o[3]);
                    if (n == 0) w.x = pk; else w.y = pk;
                }
                *(u32x2*)((char*)act + (size_t)(u.rbt * 256 + ai * 128 + wr * 64 + m * 16 + fr) * DFF + u.pn * 128 + wc * 32 + fq * 8) = w;
            }
    }
};
struct EpiDown {
    bf16_t* ybuf; const float* bdn;
    __device__ __forceinline__ const float* bias_ptr(const MoeUnit& u) const { return bdn + (size_t)u.e * 1024 + u.pn * 256; }
    __device__ __forceinline__ void init(f32x4 (&acc)[2][2][4][2], int wc, int fq, const LAS float* bias) const {
#pragma unroll
        for (int bj = 0; bj < 2; ++bj)
#pragma unroll
            for (int n = 0; n < 2; ++n) {
                const f32x4 bv = *(const LAS f32x4*)(bias + wc * 64 + fq * 16 + bj * 8 + n * 4);
#pragma unroll
                for (int ai = 0; ai < 2; ++ai)
#pragma unroll
                    for (int m = 0; m < 4; ++m) acc[ai][bj][m][n] = bv;
            }
    }
    __device__ __forceinline__ void operator()(const f32x4 (&acc)[2][2][4][2], const MoeUnit& u, int wr, int wc, int fr, int fq, const LAS float*) const {
#pragma unroll
        for (int ai = 0; ai < 2; ++ai)
#pragma unroll
            for (int m = 0; m < 4; ++m) {
                u32x4 w;
                { const f32x4 v = acc[ai][0][m][0]; w.x = pack4_fp8(v[0], v[1], v[2], v[3]); }
                { const f32x4 v = acc[ai][0][m][1]; w.y = pack4_fp8(v[0], v[1], v[2], v[3]); }
                { const f32x4 v = acc[ai][1][m][0]; w.z = pack4_fp8(v[0], v[1], v[2], v[3]); }
                { const f32x4 v = acc[ai][1][m][1]; w.w = pack4_fp8(v[0], v[1], v[2], v[3]); }
                *(u32x4*)((unsigned char*)ybuf + (size_t)(u.rbt * 256 + ai * 128 + wr * 64 + m * 16 + fr) * DM + u.pn * 256 + wc * 64 + fq * 16) = w;
            }
    }
};

__device__ __forceinline__ void phase_inproj(const Params& p, int l, char* lds) {
    DenseSched S{(const char*)p.WinQ + (size_t)l * NMAIN * 1024, 512, NTOK / 256, NMAIN / 256, vcu_id()};
    EpiInProj E{&p, l};
    pg8::gemm_phase<true, 0x7c7c7c7c>((LAS unsigned char*)lds, (const char*)p.xq, 512, S, E);
    int tid = threadIdx.x; asm volatile("" : "+v"(tid));
    const int wid = tid >> 6, lane = tid & 63, fr = lane & 15, fq = lane >> 4;
    const bf16_t* W = p.WinT + ((size_t)l * NPAD + NMAIN) * 1024;
    const float* bias = p.binp + l * NPAD + NMAIN;
    constexpr int WP = 2064;
#pragma unroll
    for (int i = 0; i < 8; ++i) { const int pc = wid * 8 + i, r = pc >> 1, q = pc & 1;
        __builtin_amdgcn_global_load_lds((const unsigned*)(W + (size_t)r * 1024 + q * 512 + lane * 8), (LAS unsigned*)((LAS char*)lds + r * WP + q * 1024), 16, 0, 0); }
    asm volatile("s_waitcnt vmcnt(0)" ::: "memory");
    __syncthreads();
    for (int u = blockIdx.x * NWV + wid; u < NTOK / 16; u += gridDim.x * NWV) {
        const bf16_t* ar = p.xb + (size_t)(u * 16 + fr) * DM + fq * 8;
        const LAS char* w0 = (const LAS char*)lds + fr * WP + fq * 16; const LAS char* w1 = w0 + 16 * WP;
        f32x4 a0 = (f32x4){0.f, 0.f, 0.f, 0.f}, a1 = a0;
#pragma unroll 4
        for (int ks = 0; ks < 32; ++ks) {
            const bf16x8 a = *(const bf16x8*)(ar + ks * 32);
            a0 = __builtin_amdgcn_mfma_f32_16x16x32_bf16(a, *(const LAS bf16x8*)(w0 + ks * 64), a0, 0, 0, 0);
            a1 = __builtin_amdgcn_mfma_f32_16x16x32_bf16(a, *(const LAS bf16x8*)(w1 + ks * 64), a1, 0, 0, 0);
        }
#pragma unroll
        for (int r = 0; r < 4; ++r) {
            float* dst = p.hs + (size_t)(u * 16 + fq * 4 + r) * HS_W;
            dst[fr] = a0[r] + bias[fr];
            if (fr < 6) dst[16 + fr] = a1[r] + bias[16 + fr];
        }
    }
}
__device__ __forceinline__ void phase_outproj(const Params& p, int l, const bf16_t* xin, char* lds) {
    DenseSched S{(const char*)p.WoT + (size_t)l * 1024 * 1024, 512, NTOK / 256, 4, vcu_id()};
    EpiOutProj E{xin, p.tbuf};
    pg8::gemm_phase<true, 0x7c7c7c7c>((LAS unsigned char*)lds, (const char*)p.ob, 512, S, E);
}
__device__ __forceinline__ void build_tiles(const Params& p, int l, int* ptile, int* ecnt) {
    int tid = threadIdx.x; asm volatile("" : "+v"(tid));
    if (tid < NE) ecnt[tid] = (int)__hip_atomic_load(p.ctrl + 64 + l * NE + tid, __ATOMIC_RELAXED, __HIP_MEMORY_SCOPE_AGENT);
    __syncthreads();
    if (tid == 0) { int s = 0; for (int e = 0; e < NE; ++e) { ptile[e] = s; s += (ecnt[e] + 255) >> 8; } ptile[NE] = s; }
    __syncthreads();
    unsigned char* texp = (unsigned char*)ptile + 512;
    for (int t = tid; t < ptile[NE]; t += NTHR) { int e = 0; while (ptile[e + 1] <= t) ++e; texp[t] = (unsigned char)e; }
    __syncthreads();
}
__device__ __forceinline__ void phase_gateup(const Params& p, int l, char* lds) {
    int* ptile = (int*)(lds + LDS_TAB); int* ecnt = ptile + 40;
    build_tiles(p, l, ptile, ecnt);
    MoeSched<true> S{(const char*)p.WguT + (size_t)l * NE * 2048 * 1024, p.lists, ptile, ecnt, 8, 2048, vcu_id()};
    EpiGateUp E{p.act, p.bgup + (size_t)l * NE * 2048};
    pg8::gemm_phase<true, 0x7c7c7c7c>((LAS unsigned char*)lds, (const char*)p.x1b, 512, S, E);
}
__device__ __forceinline__ void phase_down(const Params& p, int l, char* lds) {
    int* ptile = (int*)(lds + LDS_TAB); int* ecnt = ptile + 40;
    build_tiles(p, l, ptile, ecnt);
    MoeSched<false> S{(const char*)p.WdnT + (size_t)l * NE * 1024 * 1024, p.lists, ptile, ecnt, 4, 1024, vcu_id()};
    EpiDown E{p.ybuf, p.b_dn + (size_t)l * NE * 1024};
    pg8::gemm_phase<true, 0x7c7c7c7c>((LAS unsigned char*)lds, (const char*)p.act, 512, S, E);
}

__device__ __forceinline__ float gelu_tanh(float x) {
    const float u = 0.7978845608028654f * (x + 0.044715f * x * x * x);
    const float e = __expf(-2.0f * fabsf(u)); const float th = (1.0f - e) / (1.0f + e);
    return 0.5f * x * (1.0f + (u < 0.f ? -th : th));
}
__device__ __forceinline__ void phase_prep(const Params& p, int l, char* lds) {
    int tid = threadIdx.x; asm volatile("" : "+v"(tid));
    const int wid = tid >> 6, lane = tid & 63, fr = lane & 15, fq = lane >> 4;
    const int gw = blockIdx.x * NWV + wid, nw = gridDim.x * NWV;
    for (int u = (int)gridDim.x - 1 - (int)blockIdx.x; u < NB * 4; u += gridDim.x) {
        const int b = u >> 2, h = u & 3;
        const float* srcp = p.hs + ((size_t)b * SEQ + tid * 4) * HS_W + h;
        float ls[4]; float tot = 0.f;
#pragma unroll
        for (int i = 0; i < 4; ++i) { const float f = srcp[(size_t)i * HS_W]; ls[i] = fminf(f, 0.f) - log1pf(__expf(-fabsf(f))); tot += ls[i]; }
        float inc = tot;
#pragma unroll
        for (int o = 1; o < 64; o <<= 1) { const float v = shfl_f(inc, lane - o); if (lane >= o) inc += v; }
        float* wtot = (float*)(lds + 65536);
        if (lane == 63) wtot[wid] = inc;
        __syncthreads();
        float base = inc - tot;
        for (int w = 0; w < wid; ++w) base += wtot[w];
        float4 o4; o4.x = base + ls[0]; o4.y = o4.x + ls[1]; o4.z = o4.y + ls[2]; o4.w = o4.z + ls[3];
        *(float4*)(p.cF + (size_t)u * SEQ + tid * 4) = o4;
        __syncthreads();
    }
    float* part = (float*)lds;
    bf16_t* h1 = (bf16_t*)(lds + 32768);
    for (int u = blockIdx.x; u < NB * 2 * 2 * 8; u += gridDim.x) {
        const int ct = u & 7, which = (u >> 3) & 1, kvh = (u >> 4) & 1, b = u >> 5;
        const int colo = (which ? C_NVC : C_NKC) + kvh * 64;
        const int c_lane = ct * 16 + fr;
        const int tokbase = min(c_lane, 126) * 16;
        const bf16_t* arow = p.hb + ((size_t)b * SEQ + tokbase) * NMAIN + colo + fq * 8;
        const bf16_t* w1 = p.W1T + ((size_t)(l * 2 + which) * 64 + fr) * 2048 + fq * 8;
        f32x4 acc[4];
#pragma unroll
        for (int n = 0; n < 4; ++n) acc[n] = (f32x4){0.f, 0.f, 0.f, 0.f};
#pragma unroll
        for (int kk = 0; kk < 8; ++kk) {
            const int ks = wid * 8 + kk;
            const bf16x8 a = *(const bf16x8*)(arow + (size_t)(ks >> 1) * NMAIN + (ks & 1) * 32);
#pragma unroll
            for (int n = 0; n < 4; ++n) {
                const bf16x8 bb = *(const bf16x8*)(w1 + (size_t)n * 16 * 2048 + ks * 32);
                acc[n] = __builtin_amdgcn_mfma_f32_16x16x32_bf16(a, bb, acc[n], 0, 0, 0);
            }
        }
#pragma unroll
        for (int n = 0; n < 4; ++n)
#pragma unroll
            for (int r = 0; r < 4; ++r) part[wid * 1024 + (fq * 4 + r) * 64 + n * 16 + fr] = acc[n][r];
        __syncthreads();
        const float* b1 = p.b1c + (l * 2 + which) * 8 * 64;
#pragma unroll
        for (int i = 0; i < 2; ++i) {
            const int e = tid + NTHR * i; float sum = 0.f, bsum = 0.f;
#pragma unroll
            for (int w = 0; w < 8; ++w) { sum += part[w * 1024 + e]; bsum += b1[w * 64 + (e & 63)]; }
            h1[e] = f2bf(gelu_tanh(sum + bsum));
        }
        __syncthreads();
        if (wid == 0) {
            const bf16_t* w2 = p.W2T + ((size_t)(l * 2 + which) * 64 + fr) * 64 + fq * 8;
            f32x4 o2[4];
#pragma unroll
            for (int n = 0; n < 4; ++n) o2[n] = (f32x4){0.f, 0.f, 0.f, 0.f};
#pragma unroll
            for (int ks = 0; ks < 2; ++ks) {
                const bf16x8 a = *(const bf16x8*)(h1 + fr * 64 + ks * 32 + fq * 8);
#pragma unroll
                for (int n = 0; n < 4; ++n) {
                    const bf16x8 bb = *(const bf16x8*)(w2 + (size_t)n * 16 * 64 + ks * 32);
                    o2[n] = __builtin_amdgcn_mfma_f32_16x16x32_bf16(a, bb, o2[n], 0, 0, 0);
                }
            }
            const size_t base = ((size_t)b * 2 + kvh) * 128 * 64;
#pragma unroll
            for (int n = 0; n < 4; ++n)
#pragma unroll
                for (int r = 0; r < 4; ++r) {
                    const int c = ct * 16 + fq * 4 + r, j2 = n * 16 + fr;
                    const bf16_t v = c < 127 ? f2bf(o2[n][r]) : (bf16_t)0;
                    if (which == 0) p.kc[base + (size_t)c * 64 + j2] = v;
                    else { p.vc[base + (size_t)c * 64 + j2] = v; p.vcT[base + (size_t)j2 * 128 + c] = v; }
                }
        }
        __syncthreads();
    }
}

constexpr float L2E = 1.4426950408889634f, MASKV = -__builtin_huge_valf(), MINIT = -1e30f, SCL2 = QSCALE * L2E;
struct KVFrag { bf16x8 k[2][2]; bf16x8 v[4]; };
template <bool FM>
__device__ __forceinline__ void k_load(KVFrag& f, const bf16_t* __restrict__ Kb, size_t ldk, int kc0, int fr, int fq) {
    if (FM) {
        const bf16_t* kp = Kb + (size_t)(kc0 >> 5) * 2048 + (fq * 16 + fr) * 8;
        f.k[0][0] = *(const bf16x8*)(kp); f.k[0][1] = *(const bf16x8*)(kp + 512); f.k[1][0] = *(const bf16x8*)(kp + 1024); f.k[1][1] = *(const bf16x8*)(kp + 1536);
    } else {
        const bf16_t* kp = Kb + (size_t)(kc0 + (fr >> 2) * 8 + (fr & 3)) * ldk + fq * 8;
        f.k[0][0] = *(const bf16x8*)(kp); f.k[0][1] = *(const bf16x8*)(kp + 32);
        f.k[1][0] = *(const bf16x8*)(kp + 4 * ldk); f.k[1][1] = *(const bf16x8*)(kp + 4 * ldk + 32);
    }
}
template <bool FM>
__device__ __forceinline__ void v_load(bf16x8 (&v)[4], const bf16_t* __restrict__ VTb, size_t ldv, int kc0, int fr, int fq) {
    if (FM) {
        const bf16_t* vp = VTb + (size_t)(kc0 >> 5) * 2048 + (fq * 16 + fr) * 8;
#pragma unroll
        for (int dt = 0; dt < 4; ++dt) v[dt] = *(const bf16x8*)(vp + dt * 512);
    } else {
        const bf16_t* vp = VTb + (size_t)fr * ldv + kc0 + fq * 8;
#pragma unroll
        for (int dt = 0; dt < 4; ++dt) v[dt] = *(const bf16x8*)(vp + (size_t)dt * 16 * ldv);
    }
}
__device__ __forceinline__ float rowmax4(float x) {
    auto r = __builtin_amdgcn_permlane32_swap(__float_as_uint(x), __float_as_uint(x), false, false);
    x = fmaxf(__uint_as_float(r[0]), __uint_as_float(r[1]));
    auto q = __builtin_amdgcn_permlane16_swap(__float_as_uint(x), __float_as_uint(x), false, false);
    return fmaxf(__uint_as_float(q[0]), __uint_as_float(q[1]));
}
__device__ __forceinline__ float rowsum4(float x) {
    auto r = __builtin_amdgcn_permlane32_swap(__float_as_uint(x), __float_as_uint(x), false, false);
    x = __uint_as_float(r[0]) + __uint_as_float(r[1]);
    auto q = __builtin_amdgcn_permlane16_swap(__float_as_uint(x), __float_as_uint(x), false, false);
    return __uint_as_float(q[0]) + __uint_as_float(q[1]);
}
template <int NQT, bool MASK, class MB>
__device__ __forceinline__ void attn_compute(const KVFrag& f, const bf16x8 (&qf)[NQT][2], f32x4 (&o)[NQT][4], float (&m)[NQT], float (&l)[NQT], const MB& mb) {
    f32x4 s0[NQT], s1[NQT];
#pragma unroll
    for (int qt = 0; qt < NQT; ++qt) {
        s0[qt] = __builtin_amdgcn_mfma_f32_16x16x32_bf16(f.k[0][0], qf[qt][0], (f32x4){0.f, 0.f, 0.f, 0.f}, 0, 0, 0);
        s1[qt] = __builtin_amdgcn_mfma_f32_16x16x32_bf16(f.k[1][0], qf[qt][0], (f32x4){0.f, 0.f, 0.f, 0.f}, 0, 0, 0);
    }
#pragma unroll
    for (int qt = 0; qt < NQT; ++qt) {
        s0[qt] = __builtin_amdgcn_mfma_f32_16x16x32_bf16(f.k[0][1], qf[qt][1], s0[qt], 0, 0, 0);
        s1[qt] = __builtin_amdgcn_mfma_f32_16x16x32_bf16(f.k[1][1], qf[qt][1], s1[qt], 0, 0, 0);
    }
    float mx[NQT];
#pragma unroll
    for (int qt = 0; qt < NQT; ++qt) {
#pragma unroll
        for (int j = 0; j < 4; ++j) { s0[qt][j] = mb(qt, j, s0[qt][j]); s1[qt][j] = mb(qt, j + 4, s1[qt][j]); }
        mx[qt] = fmaxf(fmaxf(fmaxf(s0[qt][0], s0[qt][1]), fmaxf(s0[qt][2], s0[qt][3])), fmaxf(fmaxf(s1[qt][0], s1[qt][1]), fmaxf(s1[qt][2], s1[qt][3])));
    }
#pragma unroll
    for (int qt = 0; qt < NQT; ++qt) mx[qt] = rowmax4(mx[qt]);
    bool moved = false;
#pragma unroll
    for (int qt = 0; qt < NQT; ++qt) { mx[qt] = fmaxf(m[qt], mx[qt]); moved |= (mx[qt] != m[qt]); }
    if (__ballot(moved) != 0ull) {
#pragma unroll
        for (int qt = 0; qt < NQT; ++qt) {
            const float alpha = __builtin_amdgcn_exp2f(m[qt] - mx[qt]);
            l[qt] *= alpha;
#pragma unroll
            for (int dt = 0; dt < 4; ++dt) o[qt][dt] *= alpha;
        }
    }
    bf16x8 pf[NQT];
#pragma unroll
    for (int qt = 0; qt < NQT; ++qt) {
        m[qt] = mx[qt];
        float pr[8]; float ps = 0.f;
#pragma unroll
        for (int j = 0; j < 4; ++j) {
            pr[j] = __builtin_amdgcn_exp2f(s0[qt][j] - mx[qt]);
            pr[j + 4] = __builtin_amdgcn_exp2f(s1[qt][j] - mx[qt]);
        }
#pragma unroll
        for (int j = 0; j < 8; ++j) ps += pr[j];
        l[qt] += ps;
        const u32x4 pk = {pack2(pr[0], pr[1]), pack2(pr[2], pr[3]), pack2(pr[4], pr[5]), pack2(pr[6], pr[7])};
        pf[qt] = __builtin_bit_cast(bf16x8, pk);
    }
#pragma unroll
    for (int dt = 0; dt < 4; ++dt)
#pragma unroll
        for (int qt = 0; qt < NQT; ++qt) o[qt][dt] = __builtin_amdgcn_mfma_f32_16x16x32_bf16(f.v[dt], pf[qt], o[qt][dt], 0, 0, 0);
    __builtin_amdgcn_sched_barrier(0);
}
struct RangeIt { int c, c_hi; __device__ __forceinline__ int nxt() { if (c > c_hi) return -1; return (c++) * 32; } };
struct MaskIt { unsigned long long cm; __device__ __forceinline__ int nxt() { if (!cm) return -1; const int i = __builtin_ctzll(cm); cm &= cm - 1; return i * 32; } };
template <bool PFV, bool FM, class It, class Gen>
__device__ __forceinline__ void attn_run(It& it, const bf16_t* Kb, size_t ldk, const bf16_t* VTb, size_t ldv, int fr, int fq, const Gen& gen) {
    KVFrag fa, fb;
    int ka = it.nxt(); if (ka < 0) return;
    k_load<FM>(fa, Kb, ldk, ka, fr, fq); if (PFV) v_load<FM>(fa.v, VTb, ldv, ka, fr, fq);
    for (;;) {
        const int kb = it.nxt(); if (kb >= 0) { k_load<FM>(fb, Kb, ldk, kb, fr, fq); if (PFV) v_load<FM>(fb.v, VTb, ldv, kb, fr, fq); }
        if (!PFV) v_load<FM>(fa.v, VTb, ldv, ka, fr, fq);
        gen(ka, fa);
        if (kb < 0) break;
        ka = it.nxt(); if (ka >= 0) { k_load<FM>(fa, Kb, ldk, ka, fr, fq); if (PFV) v_load<FM>(fa.v, VTb, ldv, ka, fr, fq); }
        if (!PFV) v_load<FM>(fb.v, VTb, ldv, kb, fr, fq);
        gen(kb, fb);
        if (ka < 0) break;
    }
}
template <int NQT>
__device__ __forceinline__ void attn_init(f32x4 (&o)[NQT][4], float (&m)[NQT], float (&l)[NQT]) {
#pragma unroll
    for (int qt = 0; qt < NQT; ++qt) { m[qt] = MINIT; l[qt] = 0.f;
#pragma unroll
        for (int dt = 0; dt < 4; ++dt) o[qt][dt] = (f32x4){0.f, 0.f, 0.f, 0.f}; }
}
__device__ __forceinline__ float lsum4(float l) { return rowsum4(l); }
__device__ __forceinline__ void store_o16(unsigned char* dst, const f32x4 v0, const f32x4 v1, const f32x4 v2, const f32x4 v3) {
    u32x4 w; w.x = pack4_fp8(v0[0], v0[1], v0[2], v0[3]); w.y = pack4_fp8(v1[0], v1[1], v1[2], v1[3]); w.z = pack4_fp8(v2[0], v2[1], v2[2], v2[3]); w.w = pack4_fp8(v3[0], v3[1], v3[2], v3[3]);
    *(u32x4*)dst = w;
}
__device__ __forceinline__ float sigmoidf_fast(float x) { return __builtin_amdgcn_rcpf(1.0f + __builtin_amdgcn_exp2f(-L2E * x)); }

__device__ __forceinline__ void fox_unit(const Params& p, int b, int h, int qb, int fr, int fq) {
    asm volatile("" : "+v"(fr), "+v"(fq));
    const int t0 = qb * 64;
    const bf16_t* Qb = p.hb + ((size_t)b * SEQ + t0) * NMAIN + C_FQ + h * 64 + fq * 8;
    bf16x8 qf[4][2];
#pragma unroll
    for (int qt = 0; qt < 4; ++qt) { qf[qt][0] = *(const bf16x8*)(Qb + (size_t)(qt * 16 + fr) * NMAIN); qf[qt][1] = *(const bf16x8*)(Qb + (size_t)(qt * 16 + fr) * NMAIN + 32); }
    const float* cf = p.cF + ((size_t)b * 4 + h) * SEQ;
    float cq[4];
#pragma unroll
    for (int qt = 0; qt < 4; ++qt) cq[qt] = cf[t0 + qt * 16 + fr] * L2E;
    f32x4 o[4][4]; float m[4], l[4];
    attn_init<4>(o, m, l);
    const bf16_t* Kb = p.kF + ((size_t)b * NVH + h) * 64 * SEQ;
    const bf16_t* VTb = p.vT + ((size_t)b * NVH + h) * 64 * SEQ;
    RangeIt it{0, (t0 >> 5) + 1};
    attn_run<false, true>(it, Kb, NMAIN, VTb, SEQ, fr, fq, [&](int kc0, const KVFrag& f) {
        const float4 ca = *(const float4*)(cf + kc0 + 8 * fq), cb = *(const float4*)(cf + kc0 + 8 * fq + 4);
        const float ck[8] = {ca.x * L2E, ca.y * L2E, ca.z * L2E, ca.w * L2E, cb.x * L2E, cb.y * L2E, cb.z * L2E, cb.w * L2E};
        const int kq = kc0 + 8 * fq - t0 - fr;
        attn_compute<4, true>(f, qf, o, m, l, [&](int qt, int j, float raw) { return (kq + j - 16 * qt) > 0 ? MASKV : raw * SCL2 + cq[qt] - ck[j]; });
    });
#pragma unroll
    for (int qt = 0; qt < 4; ++qt) {
        const float inv = __builtin_amdgcn_rcpf(lsum4(l[qt]));
        unsigned char* dst = (unsigned char*)p.ob + ((size_t)b * SEQ + t0 + qt * 16 + fr) * DM + h * 64 + 16 * fq;
        store_o16(dst, o[qt][0] * inv, o[qt][1] * inv, o[qt][2] * inv, o[qt][3] * inv);
    }
}
__device__ __forceinline__ void swa_unit(const Params& p, int l_, int b, int kv, int pos, int fr, int fq) {
    asm volatile("" : "+v"(fr), "+v"(fq));
    const int t0 = pos * 16, t = t0 + fr;
    const bf16_t* Qb = p.hb + ((size_t)b * SEQ + t) * NMAIN + C_SQ + kv * 192 + fq * 8;
    bf16x8 qf[3][2];
#pragma unroll
    for (int g = 0; g < 3; ++g) { qf[g][0] = *(const bf16x8*)(Qb + g * 64); qf[g][1] = *(const bf16x8*)(Qb + g * 64 + 32); }
    float sl[3];
#pragma unroll
    for (int g = 0; g < 3; ++g) sl[g] = slope_swa(kv * 3 + g) * L2E;
    f32x4 o[3][4]; float m[3], l[3];
    attn_init<3>(o, m, l);
    const bf16_t* Kb = p.kF + ((size_t)b * NVH + 4 + kv) * 64 * SEQ;
    const bf16_t* VTb = p.vT + ((size_t)b * NVH + 4 + kv) * 64 * SEQ;
    RangeIt it{max(0, t0 - 127) >> 5, (t0 + 15) >> 5};
    attn_run<true, true>(it, Kb, NMAIN, VTb, SEQ, fr, fq, [&](int kc0, const KVFrag& f) {
        const int dq = t - kc0 - 8 * fq;
        attn_compute<3, true>(f, qf, o, m, l, [&](int g, int j, float raw) { const int dist = dq - j; return ((unsigned)dist < 128u) ? raw * SCL2 - sl[g] * (float)dist : MASKV; });
    });
#pragma unroll
    for (int g = 0; g < 3; ++g) {
        const float sink = p.sinks[l_ * 6 + kv * 3 + g] * L2E;
        const float inv = __builtin_amdgcn_rcpf(lsum4(l[g]) + __builtin_amdgcn_exp2f(sink - m[g]));
        unsigned char* dst = (unsigned char*)p.ob + ((size_t)b * SEQ + t) * DM + 256 + (kv * 3 + g) * 64 + 16 * fq;
        store_o16(dst, o[g][0] * inv, o[g][1] * inv, o[g][2] * inv, o[g][3] * inv);
    }
}
__device__ __forceinline__ void nsa_unit(const Params& p, int b, int kv, int pos, int fr, int fq, int lane, float* ps, unsigned* msk, float* otl) {
    asm volatile("" : "+v"(fr), "+v"(fq), "+v"(lane));
    const int t0 = pos * 16, t = t0 + fr, cur = t0 >> 6;
    const bf16_t* Qb = p.hb + ((size_t)b * SEQ + t) * NMAIN + C_NQ + kv * 192 + fq * 8;
    bf16x8 qf[3][2];
#pragma unroll
    for (int g = 0; g < 3; ++g) { qf[g][0] = *(const bf16x8*)(Qb + g * 64); qf[g][1] = *(const bf16x8*)(Qb + g * 64 + 32); }
    float sl[3];
#pragma unroll
    for (int g = 0; g < 3; ++g) sl[g] = slope_nsa(kv * 3 + g) * L2E;
    const float* gl = p.hs + ((size_t)b * SEQ + t) * HS_W + 4 + kv * 9;
    f32x4 o[3][4]; float m[3], l[3];
    f32x4* otv = (f32x4*)otl + lane;
#pragma unroll
    for (int i = 0; i < 8; ++i) ps[lane + 64 * i] = 0.f;
    {
        const bf16_t* Kb = p.kc + ((size_t)b * 2 + kv) * 128 * 64;
        const bf16_t* VTb = p.vcT + ((size_t)b * 2 + kv) * 64 * 128;
        const int ncv = (t0 + 15 >= 31) ? ((t0 + 15 - 31) >> 4) + 1 : 0;
        const int nch = (ncv + 31) >> 5;
        attn_init<3>(o, m, l);
        const int dq0 = t - 31 - 16 * 8 * fq;
        RangeIt it{0, nch - 1};
        attn_run<false, false>(it, Kb, 64, VTb, 128, fr, fq, [&](int kc0, const KVFrag& f) {
            const int dq = dq0 - 16 * kc0;
            attn_compute<3, true>(f, qf, o, m, l, [&](int g, int j, float raw) { const int dist = dq - 16 * j; return dist >= 0 ? raw * SCL2 - sl[g] * (float)dist : MASKV; });
        });
        float il[3];
#pragma unroll
        for (int g = 0; g < 3; ++g) {
            const float lt = lsum4(l[g]); il[g] = lt > 0.f ? __builtin_amdgcn_rcpf(lt) : 0.f;
            const float gate = sigmoidf_fast(gl[g * 3 + 0]);
#pragma unroll
            for (int dt = 0; dt < 4; ++dt) otv[(g * 4 + dt) * 64] = o[g][dt] * (il[g] * gate);
        }
        float carry_prev = 0.f;
        for (int c = 0; c < nch; ++c) {
            const int kc0 = c * 32, dq = dq0 - 16 * kc0;
            const bf16_t* kp = Kb + (size_t)(kc0 + (fr >> 2) * 8 + (fr & 3)) * 64 + fq * 8;
            const bf16x8 k00 = *(const bf16x8*)(kp), k01 = *(const bf16x8*)(kp + 32), k10 = *(const bf16x8*)(kp + 256), k11 = *(const bf16x8*)(kp + 256 + 32);
            float pc[8];
#pragma unroll
            for (int j = 0; j < 8; ++j) pc[j] = 0.f;
#pragma unroll
            for (int g = 0; g < 3; ++g) {
                f32x4 s0 = (f32x4){0.f, 0.f, 0.f, 0.f}, s1 = s0;
                s0 = __builtin_amdgcn_mfma_f32_16x16x32_bf16(k00, qf[g][0], s0, 0, 0, 0); s0 = __builtin_amdgcn_mfma_f32_16x16x32_bf16(k01, qf[g][1], s0, 0, 0, 0);
                s1 = __builtin_amdgcn_mfma_f32_16x16x32_bf16(k10, qf[g][0], s1, 0, 0, 0); s1 = __builtin_amdgcn_mfma_f32_16x16x32_bf16(k11, qf[g][1], s1, 0, 0, 0);
#pragma unroll
                for (int j = 0; j < 8; ++j) {
                    const int dist = dq - 16 * j; const float raw = j < 4 ? s0[j] : s1[j - 4];
                    if (dist >= 0) pc[j] += __builtin_amdgcn_exp2f(raw * SCL2 - sl[g] * (float)dist - m[g]) * il[g];
                }
            }
            const float cout = 0.5f * pc[7];
            float cin = shfl_f(cout, lane - 16);
            const float cwrap = shfl_f(cout, fr + 48);
            if (fq == 0) cin = carry_prev;
            carry_prev = cwrap;
            const int n0 = (kc0 >> 2) + 2 * fq;
            ps[fr * 32 + n0] = cin + pc[0] + pc[1] + pc[2] + 0.5f * pc[3];
            ps[fr * 32 + n0 + 1] = 0.5f * pc[3] + pc[4] + pc[5] + pc[6] + 0.5f * pc[7];
        }
    }
    lds_wave_sync();
    if (lane < 16) {
        unsigned mask = 1u | (1u << cur); if (cur >= 1) mask |= 1u << (cur - 1);
        if (cur >= 3) {
            if (cur - 2 <= 5) mask |= (1u << (cur - 1)) - 2u;
            else {
                const float* my = ps + lane * 32;
                for (int r = 0; r < 5; ++r) {
                    float best = -1.0f; int bi = 1;
                    for (int j = 1; j <= cur - 2; ++j) { const float v = my[j]; if (!((mask >> j) & 1u) && v > best) { best = v; bi = j; } }
                    mask |= 1u << bi;
                }
            }
        }
        msk[lane] = mask;
    }
    lds_wave_sync();
    const unsigned qmask = msk[fr];
    lds_wave_sync();
    {
        const bf16_t* Kb = p.kF + ((size_t)b * NVH + 6 + kv) * 64 * SEQ;
        const bf16_t* VTb = p.vT + ((size_t)b * NVH + 6 + kv) * 64 * SEQ;
        attn_init<3>(o, m, l);
        unsigned um = qmask;
        um |= shfl_u(um, lane ^ 1); um |= shfl_u(um, lane ^ 2); um |= shfl_u(um, lane ^ 4); um |= shfl_u(um, lane ^ 8);
        um = (unsigned)__builtin_amdgcn_readfirstlane((int)um) & (cur >= 31 ? 0xffffffffu : ((2u << cur) - 1u));
        unsigned long long cm = 0ull;
        for (unsigned r = um; r; r &= r - 1) { const int kb = __builtin_ctz(r); cm |= 3ull << (2 * kb); }
        MaskIt it{cm};
        attn_run<true, true>(it, Kb, NMAIN, VTb, SEQ, fr, fq, [&](int kc0, const KVFrag& f) {
            const bool mine = (qmask >> (kc0 >> 6)) & 1u;
            const int dq = t - kc0 - 8 * fq;
            attn_compute<3, true>(f, qf, o, m, l, [&](int g, int j, float raw) { const int dist = dq - j; return (mine && dist >= 0) ? raw * SCL2 - sl[g] * (float)dist : MASKV; });
        });
#pragma unroll
        for (int g = 0; g < 3; ++g) {
            const float lt = lsum4(l[g]); const float sc = (lt > 0.f ? __builtin_amdgcn_rcpf(lt) : 0.f) * sigmoidf_fast(gl[g * 3 + 1]);
#pragma unroll
            for (int dt = 0; dt < 4; ++dt) otv[(g * 4 + dt) * 64] += o[g][dt] * sc;
        }
    }
    {
        const bf16_t* Kb = p.kF + ((size_t)b * NVH + 8 + kv) * 64 * SEQ;
        const bf16_t* VTb = p.vT + ((size_t)b * NVH + 8 + kv) * 64 * SEQ;
        attn_init<3>(o, m, l);
        RangeIt it{max(0, t0 - 511) >> 5, (t0 + 15) >> 5};
        attn_run<true, true>(it, Kb, NMAIN, VTb, SEQ, fr, fq, [&](int kc0, const KVFrag& f) {
            const int dq = t - kc0 - 8 * fq;
            attn_compute<3, true>(f, qf, o, m, l, [&](int g, int j, float raw) { const int dist = dq - j; return ((unsigned)dist < 512u) ? raw * SCL2 - sl[g] * (float)dist : MASKV; });
        });
#pragma unroll
        for (int g = 0; g < 3; ++g) {
            const float lt = lsum4(l[g]); const float sc = (lt > 0.f ? __builtin_amdgcn_rcpf(lt) : 0.f) * sigmoidf_fast(gl[g * 3 + 2]);
            unsigned char* dst = (unsigned char*)p.ob + ((size_t)b * SEQ + t) * DM + 640 + (kv * 3 + g) * 64 + 16 * fq;
            store_o16(dst, otv[(g * 4 + 0) * 64] + o[g][0] * sc, otv[(g * 4 + 1) * 64] + o[g][1] * sc, otv[(g * 4 + 2) * 64] + o[g][2] * sc, otv[(g * 4 + 3) * 64] + o[g][3] * sc);
        }
    }
}

template <bool WITH_CONV>
__device__ __forceinline__ void phase_attn(const Params& p, int l, char* lds, int cslot = 16) {
    int tid = threadIdx.x; asm volatile("" : "+v"(tid));
    const int wid = tid >> 6, lane = tid & 63, fr = lane & 15, fq = lane >> 4;
    float* ps = (float*)(lds + wid * 16896); unsigned* msk = (unsigned*)(ps + 512); float* otl = ps + 576;
    unsigned* ctr = p.ctrl + cslot + l;
    constexpr unsigned NU_NSA = NB * 2 * 128, NU_FOX = NB * 4 * 32, NU_SWA = NB * 2 * 128, NU_ATT = NU_NSA + NU_FOX + NU_SWA;
    for (;;) {
        unsigned u = 0;
        if (lane == 0) u = __hip_atomic_fetch_add(ctr, 1u, __ATOMIC_RELAXED, __HIP_MEMORY_SCOPE_AGENT);
        u = (unsigned)__builtin_amdgcn_readfirstlane((int)u);
        if (WITH_CONV) {
            constexpr unsigned TOTQ = NU_ATT + (unsigned)CONV_TILES;
            if (u >= TOTQ) break;
            const unsigned a0 = (unsigned)(((unsigned long long)u * NU_ATT) / TOTQ), a1 = (unsigned)(((unsigned long long)(u + 1) * NU_ATT) / TOTQ);
            if (a1 == a0) { conv_tile_wave(p, (int)(u - a0), lane, (unsigned char*)ps); continue; }
            u = a0;
        } else {
#ifndef ATT_REP
#define ATT_REP 1
#endif
            if (u >= ATT_REP * NU_ATT) break;
            if (ATT_REP > 1) u %= NU_ATT;
        }
        if (u < NU_NSA) { const int pos = 127 - (int)(u & 127), r = u >> 7; nsa_unit(p, r >> 1, r & 1, pos, fr, fq, lane, ps, msk, otl); }
        else if (u < NU_NSA + NU_FOX) { const unsigned v = u - NU_NSA; const int qb = 31 - (int)(v & 31), r = v >> 5; fox_unit(p, r >> 2, r & 3, qb, fr, fq); }
        else { const unsigned v = u - NU_NSA - NU_FOX; const int pos = 127 - (int)(v & 127), r = v >> 7; swa_unit(p, l, r >> 1, r & 1, pos, fr, fq); }
    }
}

__device__ __forceinline__ void phase_ln1_router(const Params& p, int l, char* lds) {
    int tid = threadIdx.x; asm volatile("" : "+v"(tid));
    const int wid = tid >> 6, lane = tid & 63, fr = lane & 15, fq = lane >> 4;
    float* lg = (float*)lds + wid * 512;
    int* lcnt = (int*)(lds + 16384); int* lbase = lcnt + 32;
    const float* g1 = p.ln1_g + l * DM; const float* b1 = p.ln1_b + l * DM;
    const float* rw = p.rwT + (size_t)l * NE * 1024; const float* rb = p.router_b + l * NE;
    unsigned* gcount = p.ctrl + 64 + l * NE;
    constexpr int RW_LDS = 20480, RW_PITCH = 1028;
    if (blockIdx.x < NTOK / 128) {
#pragma unroll 4
        for (int i = 0; i < 16; ++i) { const int pc = wid * 16 + i, e = pc >> 2, q = pc & 3;
            __builtin_amdgcn_global_load_lds((const unsigned*)(rw + (size_t)e * 1024 + q * 256 + lane * 4), (LAS unsigned*)((LAS char*)lds + RW_LDS + e * RW_PITCH * 4 + q * 1024), 16, 0, 0); }
    }
    for (int grp = blockIdx.x; grp < NTOK / 128; grp += gridDim.x) {
        const int tok0 = grp * 128 + wid * 16;
        if (tid < 32) lcnt[tid] = 0;
        float gg[16], bb[16];
#pragma unroll
        for (int j = 0; j < 4; ++j) { const float4 g4 = *(const float4*)(g1 + lane * 16 + j * 4), b4 = *(const float4*)(b1 + lane * 16 + j * 4);
            gg[4 * j] = g4.x; gg[4 * j + 1] = g4.y; gg[4 * j + 2] = g4.z; gg[4 * j + 3] = g4.w; bb[4 * j] = b4.x; bb[4 * j + 1] = b4.y; bb[4 * j + 2] = b4.z; bb[4 * j + 3] = b4.w; }
        for (int r0 = 0; r0 < 16; r0 += 4) {
            float v[4][16]; float s[4], qv[4];
#pragma unroll
            for (int i = 0; i < 4; ++i) {
                const bf16_t* tr = (const bf16_t*)p.tbuf + (size_t)(tok0 + r0 + i) * DM + lane * 16;
                const u32x4 t0 = *(const u32x4*)tr, t1 = *(const u32x4*)(tr + 8);
                const unsigned ts[8] = {t0.x, t0.y, t0.z, t0.w, t1.x, t1.y, t1.z, t1.w};
#pragma unroll
                for (int c = 0; c < 8; ++c) { v[i][2 * c] = __uint_as_float(ts[c] << 16); v[i][2 * c + 1] = __uint_as_float(ts[c] & 0xffff0000u); }
            }
#pragma unroll
            for (int i = 0; i < 4; ++i) { s[i] = 0.f;
#pragma unroll
                for (int c = 0; c < 16; c += 4) s[i] += (v[i][c] + v[i][c + 1]) + (v[i][c + 2] + v[i][c + 3]); }
#pragma unroll
            for (int o = 32; o > 0; o >>= 1) {
#pragma unroll
                for (int i = 0; i < 4; ++i) s[i] += shfl_f(s[i], lane ^ o); }
#pragma unroll
            for (int i = 0; i < 4; ++i) { const float mean = s[i] * (1.0f / 1024.0f); qv[i] = 0.f;
#pragma unroll
                for (int c = 0; c < 16; c += 4) { v[i][c] -= mean; v[i][c + 1] -= mean; v[i][c + 2] -= mean; v[i][c + 3] -= mean;
                    qv[i] += (v[i][c] * v[i][c] + v[i][c + 1] * v[i][c + 1]) + (v[i][c + 2] * v[i][c + 2] + v[i][c + 3] * v[i][c + 3]); } }
#pragma unroll
            for (int o = 32; o > 0; o >>= 1) {
#pragma unroll
                for (int i = 0; i < 4; ++i) qv[i] += shfl_f(qv[i], lane ^ o); }
#pragma unroll
            for (int i = 0; i < 4; ++i) {
                const float rstd = rsqrtf(qv[i] * (1.0f / 1024.0f) + LN_EPS);
                const size_t row = (size_t)(tok0 + r0 + i);
                float y[16];
#pragma unroll
                for (int c = 0; c < 16; ++c) y[c] = v[i][c] * rstd * gg[c] + bb[c];
                u32x4 w0, w1, q;
                w0.x = pack2(y[0], y[1]); w0.y = pack2(y[2], y[3]); w0.z = pack2(y[4], y[5]); w0.w = pack2(y[6], y[7]);
                w1.x = pack2(y[8], y[9]); w1.y = pack2(y[10], y[11]); w1.z = pack2(y[12], y[13]); w1.w = pack2(y[14], y[15]);
                q.x = pack4_fp8(y[0], y[1], y[2], y[3]); q.y = pack4_fp8(y[4], y[5], y[6], y[7]); q.z = pack4_fp8(y[8], y[9], y[10], y[11]); q.w = pack4_fp8(y[12], y[13], y[14], y[15]);
                *(u32x4*)((bf16_t*)p.x1f + row * DM + lane * 16) = w0; *(u32x4*)((bf16_t*)p.x1f + row * DM + lane * 16 + 8) = w1;
                *(u32x4*)((char*)p.x1b + row * DM + lane * 16) = q;
            }
        }
        asm volatile("s_waitcnt vmcnt(0)" ::: "memory");
        __syncthreads();
        f32x4 a0 = (f32x4){0.f, 0.f, 0.f, 0.f}, a1 = a0;
        const bf16_t* xr = (const bf16_t*)p.x1f + (size_t)(tok0 + fr) * DM + 4 * fq;
        const LAS float* w0 = (const LAS float*)((LAS char*)lds + RW_LDS) + fr * RW_PITCH + 4 * fq; const LAS float* w1 = w0 + 16 * RW_PITCH;
#pragma unroll 4
        for (int k0 = 0; k0 < 1024; k0 += 16) {
            const u32x2 xw = *(const u32x2*)(xr + k0); const f32x4 wb0 = *(const LAS f32x4*)(w0 + k0), wb1 = *(const LAS f32x4*)(w1 + k0);
            const float4 xa = make_float4(__uint_as_float(xw.x << 16), __uint_as_float(xw.x & 0xffff0000u), __uint_as_float(xw.y << 16), __uint_as_float(xw.y & 0xffff0000u));
            a0 = __builtin_amdgcn_mfma_f32_16x16x4f32(xa.x, wb0.x, a0, 0, 0, 0); a1 = __builtin_amdgcn_mfma_f32_16x16x4f32(xa.x, wb1.x, a1, 0, 0, 0);
            a0 = __builtin_amdgcn_mfma_f32_16x16x4f32(xa.y, wb0.y, a0, 0, 0, 0); a1 = __builtin_amdgcn_mfma_f32_16x16x4f32(xa.y, wb1.y, a1, 0, 0, 0);
            a0 = __builtin_amdgcn_mfma_f32_16x16x4f32(xa.z, wb0.z, a0, 0, 0, 0); a1 = __builtin_amdgcn_mfma_f32_16x16x4f32(xa.z, wb1.z, a1, 0, 0, 0);
            a0 = __builtin_amdgcn_mfma_f32_16x16x4f32(xa.w, wb0.w, a0, 0, 0, 0); a1 = __builtin_amdgcn_mfma_f32_16x16x4f32(xa.w, wb1.w, a1, 0, 0, 0);
        }
#pragma unroll
        for (int r = 0; r < 4; ++r) { lg[(fq * 4 + r) * 32 + fr] = a0[r] + rb[fr]; lg[(fq * 4 + r) * 32 + 16 + fr] = a1[r] + rb[16 + fr]; }
        lds_wave_sync();
        int e4[4] = {0, 0, 0, 0}; int rk[4] = {0, 0, 0, 0};
        if (lane < 16) {
            const float* my = lg + lane * 32; unsigned taken = 0u; float tv[4];
#pragma unroll
            for (int k = 0; k < 4; ++k) {
                float best = NEG_INF; int bi = 0;
                for (int e = 0; e < 32; ++e) { const float xv = my[e]; if (!((taken >> e) & 1u) && xv > best) { best = xv; bi = e; } }
                taken |= 1u << bi; e4[k] = bi; tv[k] = best;
            }
            const float e1 = __expf(tv[1] - tv[0]), e2 = __expf(tv[2] - tv[0]), e3 = __expf(tv[3] - tv[0]);
            const float inv = 1.0f / (1.0f + e1 + e2 + e3);
            const size_t row = (size_t)(tok0 + lane);
            *(float4*)(p.gw + row * 4) = make_float4(inv, e1 * inv, e2 * inv, e3 * inv);
        }
        __syncthreads();
        if (lane < 16) {
#pragma unroll
            for (int k = 0; k < 4; ++k) rk[k] = atomicAdd(&lcnt[e4[k]], 1);
        }
        __syncthreads();
        if (tid < 32) { const int c = lcnt[tid]; lbase[tid] = c ? (int)__hip_atomic_fetch_add(gcount + tid, (unsigned)c, __ATOMIC_RELAXED, __HIP_MEMORY_SCOPE_AGENT) : 0; }
        __syncthreads();
        if (lane < 16) {
            const int row = tok0 + lane; int pk[4];
#pragma unroll
            for (int k = 0; k < 4; ++k) { const int pos = lbase[e4[k]] + rk[k]; p.lists[(size_t)e4[k] * LIST_CAP + pos] = row * 4 + k; pk[k] = (pos << 5) | e4[k]; }
            *(int4*)(p.top_e + (size_t)row * 4) = make_int4(pk[0], pk[1], pk[2], pk[3]);
        }
        __syncthreads();
    }
}

__device__ __forceinline__ void phase_ln2(const Params& p, int l, float* xout, char* lds) {
    int* ptile = (int*)(lds + LDS_TAB); int* ecnt = ptile + 40;
    build_tiles(p, l, ptile, ecnt);
    int tid = threadIdx.x; asm volatile("" : "+v"(tid));
    const int wid = tid >> 6, lane = tid & 63;
    const float* g2 = p.ln2_g + l * DM; const float* b2 = p.ln2_b + l * DM;
    float gg[16], bb[16];
#pragma unroll
    for (int j = 0; j < 4; ++j) { const float4 g4 = *(const float4*)(g2 + lane * 16 + j * 4), b4 = *(const float4*)(b2 + lane * 16 + j * 4);
        gg[4 * j] = g4.x; gg[4 * j + 1] = g4.y; gg[4 * j + 2] = g4.z; gg[4 * j + 3] = g4.w; bb[4 * j] = b4.x; bb[4 * j + 1] = b4.y; bb[4 * j + 2] = b4.z; bb[4 * j + 3] = b4.w; }
    for (int pr = blockIdx.x * NWV + wid; pr < NTOK / 2; pr += gridDim.x * NWV) {
        float v[2][16]; float s[2], qv[2];
        u32x4 yv[2][4], xv[2][2]; float gk[2][4];
#pragma unroll
        for (int i = 0; i < 2; ++i) {
            const int row = pr * 2 + i;
            const float4 gwv = *(const float4*)(p.gw + (size_t)row * 4);
            gk[i][0] = gwv.x; gk[i][1] = gwv.y; gk[i][2] = gwv.z; gk[i][3] = gwv.w;
            const int4 te = *(const int4*)(p.top_e + (size_t)row * 4);
            const int tk[4] = {te.x, te.y, te.z, te.w};
            xv[i][0] = *(const u32x4*)((const bf16_t*)p.x1f + (size_t)row * DM + lane * 16); xv[i][1] = *(const u32x4*)((const bf16_t*)p.x1f + (size_t)row * DM + lane * 16 + 8);
#pragma unroll
            for (int k = 0; k < 4; ++k) yv[i][k] = *(const u32x4*)((const unsigned char*)p.ybuf + (size_t)(ptile[tk[k] & 31] * 256 + (tk[k] >> 5)) * DM + lane * 16);
        }
#pragma unroll
        for (int i = 0; i < 2; ++i) { s[i] = 0.f;
            const unsigned xs[8] = {xv[i][0].x, xv[i][0].y, xv[i][0].z, xv[i][0].w, xv[i][1].x, xv[i][1].y, xv[i][1].z, xv[i][1].w};
#pragma unroll
            for (int c = 0; c < 8; ++c) { v[i][2 * c] = __uint_as_float(xs[c] << 16) * ALPHA; v[i][2 * c + 1] = __uint_as_float(xs[c] & 0xffff0000u) * ALPHA; }
#pragma unroll
            for (int k = 0; k < 4; ++k) {
                const unsigned ys[4] = {yv[i][k].x, yv[i][k].y, yv[i][k].z, yv[i][k].w};
#pragma unroll
                for (int c = 0; c < 4; ++c) {
                    const f32x2_t lo = __builtin_amdgcn_cvt_pk_f32_fp8(ys[c], false), hi = __builtin_amdgcn_cvt_pk_f32_fp8(ys[c], true);
                    v[i][4 * c] += gk[i][k] * lo.x; v[i][4 * c + 1] += gk[i][k] * lo.y; v[i][4 * c + 2] += gk[i][k] * hi.x; v[i][4 * c + 3] += gk[i][k] * hi.y;
                }
            }
#pragma unroll
            for (int c = 0; c < 16; c += 4) s[i] += (v[i][c] + v[i][c + 1]) + (v[i][c + 2] + v[i][c + 3]);
        }
#pragma unroll
        for (int o = 32; o > 0; o >>= 1) { s[0] += shfl_f(s[0], lane ^ o); s[1] += shfl_f(s[1], lane ^ o); }
#pragma unroll
        for (int i = 0; i < 2; ++i) { const float mean = s[i] * (1.0f / 1024.0f); qv[i] = 0.f;
#pragma unroll
            for (int c = 0; c < 16; c += 4) { v[i][c] -= mean; v[i][c + 1] -= mean; v[i][c + 2] -= mean; v[i][c + 3] -= mean;
                qv[i] += (v[i][c] * v[i][c] + v[i][c + 1] * v[i][c + 1]) + (v[i][c + 2] * v[i][c + 2] + v[i][c + 3] * v[i][c + 3]); } }
#pragma unroll
        for (int o = 32; o > 0; o >>= 1) { qv[0] += shfl_f(qv[0], lane ^ o); qv[1] += shfl_f(qv[1], lane ^ o); }
#pragma unroll
        for (int i = 0; i < 2; ++i) {
            const float rstd = rsqrtf(qv[i] * (1.0f / 1024.0f) + LN_EPS);
            const size_t row = (size_t)(pr * 2 + i);
            float y[16];
#pragma unroll
            for (int c = 0; c < 16; ++c) y[c] = v[i][c] * rstd * gg[c] + bb[c];
            if (l + 1 < NL) {
                u32x4 w0, w1, q;
                w0.x = pack2(y[0], y[1]); w0.y = pack2(y[2], y[3]); w0.z = pack2(y[4], y[5]); w0.w = pack2(y[6], y[7]);
                w1.x = pack2(y[8], y[9]); w1.y = pack2(y[10], y[11]); w1.z = pack2(y[12], y[13]); w1.w = pack2(y[14], y[15]);
                q.x = pack4_fp8(y[0], y[1], y[2], y[3]); q.y = pack4_fp8(y[4], y[5], y[6], y[7]); q.z = pack4_fp8(y[8], y[9], y[10], y[11]); q.w = pack4_fp8(y[12], y[13], y[14], y[15]);
                *(u32x4*)(p.xb + row * DM + lane * 16) = w0; *(u32x4*)(p.xb + row * DM + lane * 16 + 8) = w1;
                *(u32x4*)(p.xq + row * DM + lane * 16) = q;
            } else {
#pragma unroll
                for (int c = 0; c < 16; c += 4) *(float4*)(xout + row * DM + lane * 16 + c) = make_float4(y[c], y[c + 1], y[c + 2], y[c + 3]);
            }
        }
    }
}

#define XB_TMO      128
#define XB_XCNT(j)  (256  + 64 * (j))
#define XB_XSUB(j)  (1280 + 64 * (j))
#define XB_XGEN(j)  (2304 + 64 * (j))
#define XB_TOP      3328
#define XB_TOPGEN   3392
#define XCD_BAR_WORDS 3456
#define XB_SPIN_CAP (1u << 22)
__device__ __forceinline__ unsigned xb_ld(unsigned* p)              { return __hip_atomic_load(p, __ATOMIC_RELAXED, __HIP_MEMORY_SCOPE_AGENT); }
__device__ __forceinline__ unsigned xb_add(unsigned* p, unsigned v) { return __hip_atomic_fetch_add(p, v, __ATOMIC_RELAXED, __HIP_MEMORY_SCOPE_AGENT); }
__device__ __forceinline__ unsigned xb_xcc_id() { return (unsigned)__builtin_amdgcn_s_getreg((3 << 11) | 20) & 0xFu; }
#define XB_SPIN(cond, bar) do { unsigned _sp = 0; while (cond) { __builtin_amdgcn_s_sleep(1); \
    if ((++_sp & 255u) == 0u) { if (xb_ld(&(bar)[XB_TMO])) break; if (_sp > XB_SPIN_CAP) { atomicAdd(&(bar)[XB_TMO], 1u); break; } } } } while (0)
struct XcdBarrier { unsigned* bar; unsigned x; volatile LAS unsigned* st; };
__device__ __forceinline__ XcdBarrier xcd_barrier_post(unsigned* bar, volatile LAS unsigned* st) {
    XcdBarrier b; b.bar = bar; b.x = xb_xcc_id(); b.st = st;
    if (threadIdx.x == 0) (void)xb_add(&bar[XB_XCNT(b.x)], 1u);
    return b;
}
__device__ __forceinline__ void xcd_barrier_complete(unsigned* bar, unsigned x, unsigned& nloc, unsigned& nx) {
    const unsigned G = gridDim.x * gridDim.y * gridDim.z;
    unsigned sum, cnt, mine, sp = 0u;
    for (;;) {
        sum = 0u; cnt = 0u; mine = 0u;
#pragma unroll
        for (unsigned j = 0; j < 16; ++j) { const unsigned c = xb_ld(&bar[XB_XCNT(j)]); sum += c; cnt += (c > 0u) ? 1u : 0u; mine = (j == x) ? c : mine; }
        if (sum == G) break;
        __builtin_amdgcn_s_sleep(1);
        if ((++sp & 255u) == 0u) { if (xb_ld(&bar[XB_TMO])) break; if (sp > XB_SPIN_CAP) { atomicAdd(&bar[XB_TMO], 1u); break; } }
    }
    nloc = mine > 0u ? mine : 1u; nx = cnt > 0u ? cnt : 1u;
}
__device__ __forceinline__ void xcd_barrier(const XcdBarrier& b) {
    asm volatile("s_waitcnt vmcnt(0)" ::: "memory");
    __syncthreads();
    if (threadIdx.x == 0) {
        unsigned* bar = b.bar;
        __builtin_amdgcn_s_waitcnt(0);
        unsigned nloc = b.st[0], nx = b.st[1];
        if (nloc == 0u) { xcd_barrier_complete(bar, b.x, nloc, nx); b.st[0] = nloc; b.st[1] = nx; }
        const unsigned old = xb_add(&bar[XB_XSUB(b.x)], 1u);
        const unsigned gen = old / nloc;
        if (old + 1u == (gen + 1u) * nloc) {
            __builtin_amdgcn_fence(__ATOMIC_RELEASE, "agent");
            asm volatile("s_waitcnt vmcnt(0)" ::: "memory");
            const unsigned og = xb_add(&bar[XB_TOP], 1u);
            const unsigned tg = og / nx;
            if (og + 1u == (tg + 1u) * nx) xb_add(&bar[XB_TOPGEN], 1u);
            else XB_SPIN(xb_ld(&bar[XB_TOPGEN]) == tg, bar);
            __builtin_amdgcn_fence(__ATOMIC_ACQUIRE, "agent");
            xb_add(&bar[XB_XGEN(b.x)], 1u);
            asm volatile("s_waitcnt vmcnt(0)" ::: "memory");
        } else {
            XB_SPIN(xb_ld(&bar[XB_XGEN(b.x)]) == gen, bar);
            __builtin_amdgcn_fence(__ATOMIC_ACQUIRE, "agent");
            asm volatile("s_waitcnt vmcnt(0)" ::: "memory");
        }
    }
    __syncthreads();
}

struct KArgs { const float* in[18]; float* out; char* ws; };
constexpr size_t al256(size_t v) { return (v + 255) / 256 * 256; }
struct WSL {
    static constexpr size_t ctrl = 0;
    static constexpr size_t WinT = al256(ctrl + 65536);
    static constexpr size_t WoT = al256(WinT + (size_t)NL * NPAD * 1024 * 2);
    static constexpr size_t W1T = al256(WoT + (size_t)NL * 1024 * 1024 * 2);
    static constexpr size_t W2T = al256(W1T + (size_t)NL * 2 * 64 * 2048 * 2);
    static constexpr size_t WguT = al256(W2T + (size_t)NL * 2 * 64 * 64 * 2);
    static constexpr size_t WdnT = al256(WguT + (size_t)NL * NE * 2048 * 1024 * 2);
    static constexpr size_t rwT = al256(WdnT + (size_t)NL * NE * 1024 * 1024 * 2);
    static constexpr size_t binp = al256(rwT + (size_t)NL * NE * 1024 * 4);
    static constexpr size_t bgup = al256(binp + (size_t)NL * NPAD * 4);
    static constexpr size_t b1c = al256(bgup + (size_t)NL * NE * 2048 * 4);
    static constexpr size_t xf = al256(b1c + 4 * 8 * 64 * 4);
    static constexpr size_t xb = al256(xf + (size_t)NTOK * DM * 4);
    static constexpr size_t hb = al256(xb + (size_t)NTOK * DM * 2);
    static constexpr size_t hs = al256(hb + (size_t)NTOK * NMAIN * 2);
    static constexpr size_t vT = al256(hs + (size_t)NTOK * HS_W * 4);
    static constexpr size_t kF = al256(vT + (size_t)NB * NVH * 64 * SEQ * 2);
    static constexpr size_t cF = al256(kF + (size_t)NB * NVH * 64 * SEQ * 2);
    static constexpr size_t kc = al256(cF + (size_t)NB * 4 * SEQ * 4);
    static constexpr size_t vc = al256(kc + (size_t)NB * 2 * 128 * 64 * 2);
    static constexpr size_t vcT = al256(vc + (size_t)NB * 2 * 128 * 64 * 2);
    static constexpr size_t ob = al256(vcT + (size_t)NB * 2 * 128 * 64 * 2);
    static constexpr size_t tbuf = al256(ob + (size_t)NTOK * DM * 2);
    static constexpr size_t x1f = al256(tbuf + (size_t)NTOK * DM * 4);
    static constexpr size_t x1b = al256(x1f + (size_t)NTOK * DM * 4);
    static constexpr size_t top_e = al256(x1b + (size_t)NTOK * DM * 2);
    static constexpr size_t gw = al256(top_e + (size_t)NTOK * 4 * 4);
    static constexpr size_t lists = al256(gw + (size_t)NTOK * 4 * 4);
    static constexpr size_t act = al256(lists + (size_t)NE * LIST_CAP * 4);
    static constexpr size_t ybuf = al256(act + (size_t)MAXSLOT * DFF * 2);
    static constexpr size_t xq = al256(ybuf + (size_t)MAXSLOT * DM * 2);
    static constexpr size_t WinQ = al256(xq + (size_t)NTOK * DM);
    static constexpr size_t total = al256(WinQ + (size_t)NL * NMAIN * 1024);
};
__device__ __forceinline__ Params make_params(const KArgs& k) {
    Params p;
    p.x = k.in[0]; p.w_in = k.in[1]; p.b_in = k.in[2]; p.sinks = k.in[3]; p.cmp_pe = k.in[4]; p.cmp_w1 = k.in[5]; p.cmp_w2 = k.in[6]; p.w_out = k.in[7];
    p.ln1_g = k.in[8]; p.ln1_b = k.in[9]; p.router_w = k.in[10]; p.router_b = k.in[11]; p.w_gu = k.in[12]; p.b_gu = k.in[13]; p.w_dn = k.in[14]; p.b_dn = k.in[15];
    p.ln2_g = k.in[16]; p.ln2_b = k.in[17]; p.out = k.out;
    char* w = k.ws;
    p.ctrl = (unsigned*)(w + WSL::ctrl); p.WinT = (bf16_t*)(w + WSL::WinT); p.WoT = (bf16_t*)(w + WSL::WoT); p.W1T = (bf16_t*)(w + WSL::W1T); p.W2T = (bf16_t*)(w + WSL::W2T);
    p.WguT = (bf16_t*)(w + WSL::WguT); p.WdnT = (bf16_t*)(w + WSL::WdnT); p.rwT = (float*)(w + WSL::rwT); p.binp = (float*)(w + WSL::binp); p.bgup = (float*)(w + WSL::bgup);
    p.b1c = (float*)(w + WSL::b1c); p.xf = (float*)(w + WSL::xf); p.xb = (bf16_t*)(w + WSL::xb); p.hb = (bf16_t*)(w + WSL::hb); p.hs = (float*)(w + WSL::hs); p.vT = (bf16_t*)(w + WSL::vT); p.kF = (bf16_t*)(w + WSL::kF);
    p.cF = (float*)(w + WSL::cF); p.kc = (bf16_t*)(w + WSL::kc); p.vc = (bf16_t*)(w + WSL::vc); p.vcT = (bf16_t*)(w + WSL::vcT); p.ob = (bf16_t*)(w + WSL::ob); p.tbuf = (float*)(w + WSL::tbuf);
    p.x1f = (float*)(w + WSL::x1f); p.x1b = (bf16_t*)(w + WSL::x1b); p.top_e = (int*)(w + WSL::top_e); p.gw = (float*)(w + WSL::gw); p.lists = (int*)(w + WSL::lists);
    p.act = (bf16_t*)(w + WSL::act); p.ybuf = (bf16_t*)(w + WSL::ybuf); p.xq = (unsigned char*)(w + WSL::xq); p.WinQ = (unsigned char*)(w + WSL::WinQ);
    return p;
}
__device__ __forceinline__ void grid_bar(const Params& p, char* lds) {
    XcdBarrier xb; xb.bar = p.ctrl + 1024; xb.x = xb_xcc_id(); xb.st = (volatile LAS unsigned*)(lds + LDS_BYTES - 16); xcd_barrier(xb);
}
__device__ __forceinline__ Params fresh_params(const KArgs& ka) {
    KArgs k2 = ka; size_t z = 0; asm volatile("" : "+s"(z));
    k2.ws = ka.ws + z;
    return make_params(k2);
}
#ifndef REP
#define REP 0
#endif
template <int L>
__device__ __forceinline__ void layer_fwd(const KArgs& ka, char* lds) {
    { const Params p = fresh_params(ka); phase_inproj(p, L, lds);        grid_bar(p, lds); }
    { const Params p = fresh_params(ka); phase_prep(p, L, lds);          grid_bar(p, lds); }
    { const Params p = fresh_params(ka); phase_attn<L == 0>(p, L, lds);  grid_bar(p, lds); }
    { const Params p = fresh_params(ka); phase_outproj(p, L, p.xb, lds);  grid_bar(p, lds); }
    { const Params p = fresh_params(ka); phase_ln1_router(p, L, lds);    grid_bar(p, lds); }
    { const Params p = fresh_params(ka); phase_gateup(p, L, lds);        grid_bar(p, lds); }
    { const Params p = fresh_params(ka); phase_down(p, L, lds);          grid_bar(p, lds); }
    { const Params p = fresh_params(ka); phase_ln2(p, L, L == NL - 1 ? p.out : p.xf, lds); }
}
__global__ void __launch_bounds__(NTHR, 2) fwd_kernel(KArgs ka) {
    extern __shared__ __attribute__((aligned(16))) char lds[];
    const Params p = make_params(ka);
    cg::grid_group grid = cg::this_grid();
    volatile LAS unsigned* xst = (volatile LAS unsigned*)(lds + LDS_BYTES - 16);
    if (threadIdx.x == 0) { xst[0] = 0u; xst[1] = 0u; }
    __syncthreads();
    (void)xcd_barrier_post(p.ctrl + 1024, xst);
    volatile LAS int* vcu = (volatile LAS int*)(lds + LDS_BYTES - 32);
    const unsigned myx = xb_xcc_id() & 7u;
    if (threadIdx.x == 0) vcu[1] = (int)__hip_atomic_fetch_add(p.ctrl + 32 + myx, 1u, __ATOMIC_RELAXED, __HIP_MEMORY_SCOPE_AGENT);
    phase0(p, lds);
    grid.sync();
    if (threadIdx.x == 0) {
        int base = 0, tot = 0;
        for (unsigned x = 0; x < 8; ++x) { const int n = (int)__hip_atomic_load(p.ctrl + 32 + x, __ATOMIC_RELAXED, __HIP_MEMORY_SCOPE_AGENT); if (x < myx) base += n; tot += n; }
        vcu[0] = (tot == (int)gridDim.x) ? base + vcu[1] : (int)blockIdx.x;
    }
    __syncthreads();
    layer_fwd<0>(ka, lds);
    grid_bar(p, lds);
    layer_fwd<1>(ka, lds);
}

extern "C" void kernel_launch(void* const* d_in, const int* in_sizes, int n_in, void* d_out, int out_size, void* d_ws, size_t ws_size, hipStream_t stream) {
    KArgs ka{};
    for (int i = 0; i < 18; ++i) ka.in[i] = (const float*)d_in[i];
    ka.out = (float*)d_out; ka.ws = (char*)d_ws;
    if (WSL::total > ws_size) { fprintf(stderr, "workspace too small: need %zu have %zu\n", (size_t)WSL::total, ws_size); return; }
    static int grid_blocks = 0;
    if (!grid_blocks) {
        int dev = 0, cus = 0, per_cu = 0;
        (void)hipGetDevice(&dev);
        (void)hipDeviceGetAttribute(&cus, hipDeviceAttributeMultiprocessorCount, dev);
        (void)hipFuncSetAttribute((const void*)fwd_kernel, hipFuncAttributeMaxDynamicSharedMemorySize, LDS_BYTES);
        (void)hipOccupancyMaxActiveBlocksPerMultiprocessor(&per_cu, fwd_kernel, NTHR, LDS_BYTES);
        if (per_cu < 1) { fprintf(stderr, "occupancy query says 0 blocks per CU\n"); per_cu = 1; }
        grid_blocks = cus;
    }
    (void)hipMemsetAsync(d_ws, 0, 65536, stream);
    void* args[] = {&ka};
    hipError_t e = hipLaunchCooperativeKernel((const void*)fwd_kernel, dim3(grid_blocks), dim3(NTHR), args, LDS_BYTES, stream);
    if (e != hipSuccess) fprintf(stderr, "cooperative launch failed: %s (grid %d)\n", hipGetErrorString(e), grid_blocks);
}
```

```cpp
#include <hip/hip_runtime.h>
#include <hip/hip_cooperative_groups.h>
#include <cstdio>
#include <cstdint>
namespace cg = cooperative_groups;

typedef unsigned short bf16_t;
typedef short bf16x8 __attribute__((ext_vector_type(8)));
typedef float f32x4 __attribute__((ext_vector_type(4)));
typedef unsigned u32x4 __attribute__((ext_vector_type(4)));
typedef unsigned u32x2 __attribute__((ext_vector_type(2)));
typedef int v8i_t __attribute__((ext_vector_type(8)));
typedef float f32x2_t __attribute__((ext_vector_type(2)));
typedef int v4i_t __attribute__((ext_vector_type(4)));
#define LAS __attribute__((address_space(3)))
constexpr float NEG_INF = -__builtin_huge_valf();

constexpr int DM = 1024, NB = 16, SEQ = 2048, NTOK = NB * SEQ, NL = 2;
constexpr int NCOL = 2582, NMAIN = 2560, NPAD = 2688, NE = 32, DFF = 1024;
constexpr int C_FQ = 0, C_FK = 256, C_FV = 512, C_SQ = 768, C_SK = 1152, C_SV = 1280, C_NQ = 1408,
              C_NKC = 1792, C_NVC = 1920, C_NKS = 2048, C_NVS = 2176, C_NKW = 2304, C_NVW = 2432;
constexpr int HS_W = 32;
constexpr int NVH = 10;
constexpr int LIST_CAP = NTOK;
constexpr int MAXSLOT = NTOK * 4 + NE * 256;
constexpr float ALPHA = 1.41421356237f, LN_EPS = 1e-5f, QSCALE = 0.125f;
constexpr float GATE_PRE = -2.455466929f;
constexpr int NWV = 8, NTHR = NWV * 64;
constexpr int LDS_STAGE = 131072, LDS_TAB = LDS_STAGE, LDS_AOFF = LDS_STAGE + 2048, LDS_BIAS = LDS_AOFF + 20480, LDS_BYTES = LDS_BIAS + 3072 + 256;

struct Params {
    const float *x, *w_in, *b_in, *sinks, *cmp_pe, *cmp_w1, *cmp_w2, *w_out, *ln1_g, *ln1_b, *router_w, *router_b,
                *w_gu, *b_gu, *w_dn, *b_dn, *ln2_g, *ln2_b;
    float* out;
    unsigned* ctrl;
    bf16_t *WinT, *WoT, *W1T, *W2T, *WguT, *WdnT;
    float *rwT, *binp, *bgup, *b1c;
    unsigned char* xq; unsigned char* WinQ;
    float* xf; bf16_t* xb; bf16_t* hb; float* hs; bf16_t* vT; bf16_t* kF; float* cF;
    bf16_t *kc, *vc, *vcT; bf16_t* ob; float* tbuf; float* x1f; bf16_t* x1b;
    int* top_e; float* gw; int* lists; bf16_t* act; bf16_t* ybuf;
};

__device__ __forceinline__ float bf2f(bf16_t h) { return __uint_as_float(((unsigned)h) << 16); }
typedef __bf16 bf16x2_t __attribute__((ext_vector_type(2)));
__device__ __forceinline__ bf16_t f2bf(float f) { return __builtin_bit_cast(bf16_t, (__bf16)f); }
__device__ __forceinline__ unsigned pack2(float lo, float hi) { bf16x2_t v = {(__bf16)lo, (__bf16)hi}; return __builtin_bit_cast(unsigned, v); }
__device__ __forceinline__ unsigned pack4_fp8(float a, float b, float c, float d) {
    unsigned w = 0u;
    w = __builtin_amdgcn_cvt_pk_fp8_f32(a, b, w, false);
    w = __builtin_amdgcn_cvt_pk_fp8_f32(c, d, w, true);
    return w;
}
__device__ __forceinline__ float shfl_f(float v, int src_lane) { return __int_as_float(__builtin_amdgcn_ds_bpermute(src_lane << 2, __float_as_int(v))); }
__device__ __forceinline__ unsigned shfl_u(unsigned v, int src_lane) { return (unsigned)__builtin_amdgcn_ds_bpermute(src_lane << 2, (int)v); }
__device__ __forceinline__ float wave_sum(float v) {
#pragma unroll
    for (int o = 32; o > 0; o >>= 1) v += __shfl_xor(v, o);
    return v;
}
__device__ __forceinline__ float wave_max(float v) {
#pragma unroll
    for (int o = 32; o > 0; o >>= 1) v = fmaxf(v, __shfl_xor(v, o));
    return v;
}
__device__ __forceinline__ void lds_wave_sync() { asm volatile("s_waitcnt lgkmcnt(0)" ::: "memory"); __builtin_amdgcn_wave_barrier(); }
__device__ __forceinline__ float slope_swa(int hq) { return exp2f(-8.0f * (float)(2 * hq + 1) / 12.0f); }
__device__ __forceinline__ float slope_nsa(int hq) { return exp2f(-8.0f * (float)(2 * hq + 2) / 12.0f); }

__device__ __forceinline__ int fwd128(int L) { return (L & ~31) | (((L >> 2) & 1) << 4) | (((L >> 3) & 3) << 2) | (L & 3); }
__device__ __forceinline__ int inv128(int p) { return (p & ~31) | (((p >> 2) & 3) << 3) | (((p >> 4) & 1) << 2) | (p & 3); }
__device__ __forceinline__ int fwd256(int L) { return (L & ~255) | (((L >> 3) & 1) << 7) | (((L >> 6) & 3) << 5) | (((L >> 2) & 1) << 4) | (((L >> 4) & 3) << 2) | (L & 3); }
__device__ __forceinline__ int perm_row(int perm, int n) {
    if (perm == 1) { int r; if (n < 768) r = n; else if (n < 772) r = 2560 + (n - 768); else if (n < 2564) r = n - 4; else r = n; return r < 2560 ? fwd128(r) : r; }
    if (perm == 2) { const int f = n >> 1, s = n & 1; return (f >> 7) * 256 + s * 128 + fwd128(f & 127); }
    if (perm == 3) return fwd256(n);
    return n;
}
struct ConvJob { const float* src; bf16_t* dst; int K, N, kt, nt, perm; float q8; };
__device__ __forceinline__ bool conv_job(const Params& p, int t, ConvJob& jb) {
    constexpr int T_WIN = NL * 8 * 21, T_WO = NL * 8 * 8, T_WINB = NL * 8 * 2;
    if (t < T_WINB) { const int m = t / 16, r = t % 16; jb = ConvJob{p.w_in + (size_t)m * 1024 * NCOL, p.WinT + (size_t)m * NPAD * 1024, 1024, NCOL, r >> 1, (r & 1) ? 20 : 6, 1, 0.f}; return true; }
    t -= T_WINB;
    if (t < T_WO) { const int m = t / 64, r = t % 64; jb = ConvJob{p.w_out + (size_t)m * 1024 * 1024, (bf16_t*)((char*)p.WoT + (size_t)m * 1024 * 1024), 1024, 1024, r / 8, r % 8, 3, 64.0f}; return true; }
    t -= T_WO;
    if (t < T_WIN) { const int m = t / 168, r = t % 168; jb = ConvJob{p.w_in + (size_t)m * 1024 * NCOL, (bf16_t*)(p.WinQ + (size_t)m * NMAIN * 1024), 1024, NCOL, r / 21, r % 21, 1, 64.0f}; return true; }
    return false;
}
constexpr int CONV_TILES = NL * NE * 192;
__device__ __forceinline__ void conv_tile_wave(const Params& p, int t, int lane, unsigned char* l8) {
    asm volatile("" : "+v"(lane));
    const int m = t / 192, r = t % 192;
    const float* src; unsigned char* dst; int N, kt, nt, perm;
    if (r < 128) { src = p.w_gu + (size_t)m * 1024 * 2048; dst = (unsigned char*)p.WguT + (size_t)m * 2048 * 1024; N = 2048; kt = r >> 4; nt = r & 15; perm = 2; }
    else { const int q = r - 128; src = p.w_dn + (size_t)m * 1024 * 1024; dst = (unsigned char*)p.WdnT + (size_t)m * 1024 * 1024; N = 1024; kt = q >> 3; nt = q & 7; perm = 3; }
    const float* s = src + (size_t)(kt * 128 + (lane >> 5)) * N + nt * 128 + (lane & 31) * 4;
    unsigned char* lw = l8 + (lane >> 5) * 132 + (lane & 31) * 4;
    const float sg = (perm == 2) ? 64.0f * GATE_PRE : 64.0f;
    float4 va[16], vb[16];
#pragma unroll
    for (int i = 0; i < 16; ++i) va[i] = *(const float4*)(s + (size_t)(2 * i) * N);
#pragma unroll
    for (int i = 0; i < 16; ++i) vb[i] = *(const float4*)(s + (size_t)(32 + 2 * i) * N);
#pragma unroll
    for (int i = 0; i < 16; ++i) *(unsigned*)(lw + (2 * i) * 132) = pack4_fp8(va[i].x * sg, va[i].y * 64.0f, va[i].z * sg, va[i].w * 64.0f);
#pragma unroll
    for (int i = 0; i < 16; ++i) va[i] = *(const float4*)(s + (size_t)(64 + 2 * i) * N);
#pragma unroll
    for (int i = 0; i < 16; ++i) *(unsigned*)(lw + (32 + 2 * i) * 132) = pack4_fp8(vb[i].x * sg, vb[i].y * 64.0f, vb[i].z * sg, vb[i].w * 64.0f);
#pragma unroll
    for (int i = 0; i < 16; ++i) vb[i] = *(const float4*)(s + (size_t)(96 + 2 * i) * N);
#pragma unroll
    for (int i = 0; i < 16; ++i) *(unsigned*)(lw + (64 + 2 * i) * 132) = pack4_fp8(va[i].x * sg, va[i].y * 64.0f, va[i].z * sg, va[i].w * 64.0f);
#pragma unroll
    for (int i = 0; i < 16; ++i) *(unsigned*)(lw + (96 + 2 * i) * 132) = pack4_fp8(vb[i].x * sg, vb[i].y * 64.0f, vb[i].z * sg, vb[i].w * 64.0f);
    lds_wave_sync();
#pragma unroll 4
    for (int i = 0; i < 16; ++i) {
        const int idx = lane + 64 * i, kc = idx & 7, nn = idx >> 3;
        const unsigned char* l = l8 + (kc * 16) * 132 + nn;
        u32x4 w;
        w.x = (unsigned)l[0] | ((unsigned)l[132] << 8) | ((unsigned)l[264] << 16) | ((unsigned)l[396] << 24);
        w.y = (unsigned)l[528] | ((unsigned)l[660] << 8) | ((unsigned)l[792] << 16) | ((unsigned)l[924] << 24);
        w.z = (unsigned)l[1056] | ((unsigned)l[1188] << 8) | ((unsigned)l[1320] << 16) | ((unsigned)l[1452] << 24);
        w.w = (unsigned)l[1584] | ((unsigned)l[1716] << 8) | ((unsigned)l[1848] << 16) | ((unsigned)l[1980] << 24);
        *(u32x4*)(dst + (size_t)perm_row(perm, nt * 128 + nn) * 1024 + kt * 128 + kc * 16) = w;
    }
    lds_wave_sync();
}
__device__ __forceinline__ void conv_load(const ConvJob& jb, int tid, float2 (&v)[16]) {
    const int n = jb.nt * 128 + (tid & 31) * 4;
    const float* s = jb.src + (size_t)(jb.kt * 128 + (tid >> 5)) * jb.N + n;
#pragma unroll
    for (int i = 0; i < 8; ++i) {
        const float* r = s + (size_t)(16 * i) * jb.N;
        v[2 * i] = (n + 1 < jb.N) ? *(const float2*)r : make_float2(0.f, 0.f);
        v[2 * i + 1] = (n + 3 < jb.N) ? *(const float2*)(r + 2) : make_float2(0.f, 0.f);
    }
}
__device__ __forceinline__ void phase0(const Params& p, char* ldsc) {
    int tid = threadIdx.x; asm volatile("" : "+v"(tid));
    const int G = gridDim.x, bid = blockIdx.x;
    const size_t gtid = (size_t)bid * NTHR + tid, gthreads = (size_t)G * NTHR;
    {
        constexpr int TOT = NL * 8 * 2 + NL * 8 * 21 + NL * 8 * 8;
        bf16_t* lt = (bf16_t*)ldsc;
        ConvJob jb, jn; float2 v[16], vn[16];
        int t = bid; bool have = t < TOT && conv_job(p, t, jb);
        if (have) conv_load(jb, tid, v);
        while (have) {
            const int tn = t + G; const bool hn = tn < TOT && conv_job(p, tn, jn);
            if (hn) conv_load(jn, tid, vn);
            if (jb.q8 != 0.f) {
                unsigned char* l8 = (unsigned char*)lt;
#pragma unroll
                for (int i = 0; i < 8; ++i)
                {   int kl = (tid >> 5) + 16 * i;
                    if (jb.perm == 3) kl = (kl & 64) | (((kl >> 2) & 3) << 4) | (((kl >> 4) & 3) << 2) | (kl & 3);
                    *(unsigned*)(l8 + kl * 132 + (tid & 31) * 4) = pack4_fp8(v[2 * i].x * jb.q8, v[2 * i].y * jb.q8, v[2 * i + 1].x * jb.q8, v[2 * i + 1].y * jb.q8); }
                __syncthreads();
#pragma unroll
                for (int i = 0; i < 2; ++i) {
                    const int idx = tid + NTHR * i, kc = idx & 7, nn = idx >> 3, n = jb.nt * 128 + nn;
                    const unsigned char* l = l8 + (kc * 16) * 132 + nn;
                    u32x4 w;
                    w.x = (unsigned)l[0] | ((unsigned)l[132] << 8) | ((unsigned)l[264] << 16) | ((unsigned)l[396] << 24);
                    w.y = (unsigned)l[528] | ((unsigned)l[660] << 8) | ((unsigned)l[792] << 16) | ((unsigned)l[924] << 24);
                    w.z = (unsigned)l[1056] | ((unsigned)l[1188] << 8) | ((unsigned)l[1320] << 16) | ((unsigned)l[1452] << 24);
                    w.w = (unsigned)l[1584] | ((unsigned)l[1716] << 8) | ((unsigned)l[1848] << 16) | ((unsigned)l[1980] << 24);
                    const int pr = perm_row(jb.perm, n);
                    if (n < jb.N && !(jb.perm == 1 && pr >= NMAIN)) *(u32x4*)((char*)jb.dst + (size_t)pr * jb.K + jb.kt * 128 + kc * 16) = w;
                }
            } else {
#pragma unroll
                for (int i = 0; i < 8; ++i) {
                    u32x2 w; w.x = pack2(v[2 * i].x, v[2 * i].y); w.y = pack2(v[2 * i + 1].x, v[2 * i + 1].y);
                    *(u32x2*)(lt + ((tid >> 5) + 16 * i) * 136 + (tid & 31) * 4) = w;
                }
                __syncthreads();
#pragma unroll
                for (int i = 0; i < 4; ++i) {
                    const int idx = tid + NTHR * i, kc = idx & 15, nn = idx >> 4, n = jb.nt * 128 + nn;
                    if (n < jb.N) {
                        const bf16_t* l = lt + (kc * 8) * 136 + nn;
                        u32x4 w;
                        w.x = (unsigned)l[0] | ((unsigned)l[136] << 16); w.y = (unsigned)l[272] | ((unsigned)l[408] << 16);
                        w.z = (unsigned)l[544] | ((unsigned)l[680] << 16); w.w = (unsigned)l[816] | ((unsigned)l[952] << 16);
                        *(u32x4*)(jb.dst + (size_t)perm_row(jb.perm, n) * jb.K + jb.kt * 128 + kc * 8) = w;
                    }
                }
            }
            __syncthreads();
            t = tn; have = hn; jb = jn;
#pragma unroll
            for (int i = 0; i < 16; ++i) v[i] = vn[i];
        }
    }
    for (size_t i = gtid; i < (size_t)NL * 2 * 2048 * 64; i += gthreads) {
        const int k = (int)(i % 2048), n = (int)((i / 2048) % 64), m = (int)(i / (2048 * 64));
        p.W1T[i] = f2bf(p.cmp_w1[((size_t)m * 2048 + k) * 64 + n]);
    }
    for (size_t i = gtid; i < (size_t)NL * 2 * 64 * 64; i += gthreads) {
        const int k = (int)(i % 64), n = (int)((i / 64) % 64), m = (int)(i / 4096);
        p.W2T[i] = f2bf(p.cmp_w2[((size_t)m * 64 + k) * 64 + n]);
    }
    for (size_t i = gtid; i < (size_t)NL * NPAD; i += gthreads) {
        const int l = (int)(i / NPAD), ri = (int)(i % NPAD), r = ri < 2560 ? inv128(ri) : ri;
        float v = 0.f;
        if (r < 2560) { const int n = r < 768 ? r : r + 4; v = p.b_in[l * NCOL + n]; }
        else if (r < 2564) v = p.b_in[l * NCOL + 768 + (r - 2560)];
        else if (r < 2582) v = p.b_in[l * NCOL + r];
        p.binp[i] = v;
    }
    for (size_t i = gtid; i < (size_t)NL * NE * 2048; i += gthreads) {
        const int r = (int)(i % 2048); const size_t le = i / 2048;
        const int s = (r >> 7) & 1, f = (r >> 8) * 128 + inv128(r & 127);
        p.bgup[i] = p.b_gu[le * 2048 + 2 * f + s] * (s == 0 ? GATE_PRE : 1.0f);
    }
    for (size_t i = gtid; i < (size_t)NL * NE * 1024; i += gthreads) {
        const int k = (int)(i % 1024), e = (int)((i / 1024) % NE), l = (int)(i / (1024 * NE));
        const float wv = p.router_w[((size_t)l * 1024 + k) * NE + e];
        const bf16_t hi = f2bf(wv); const float hf = __uint_as_float((unsigned)hi << 16);
        bf16_t* rwb = (bf16_t*)p.rwT + (size_t)l * 64 * 1024;
        rwb[(size_t)e * 1024 + k] = hi; rwb[(size_t)(32 + e) * 1024 + k] = f2bf(wv - hf);
    }
    for (size_t i = gtid; i < (size_t)NL * (NPAD - NCOL) * 1024; i += gthreads) {
        const int l = (int)(i / ((NPAD - NCOL) * 1024)); const size_t r = i % ((size_t)(NPAD - NCOL) * 1024);
        p.WinT[(size_t)l * NPAD * 1024 + (size_t)NCOL * 1024 + r] = 0;
    }
    {
        constexpr size_t N16 = (size_t)NTOK * DM / 16;
        for (size_t i0 = gtid; i0 < N16; i0 += gthreads * 2) {
            float4 v[2][4];
#pragma unroll
            for (int u = 0; u < 2; ++u) { const size_t i = i0 + u * gthreads;
#pragma unroll
                for (int j = 0; j < 4; ++j) v[u][j] = (i < N16) ? ((const float4*)p.x)[i * 4 + j] : make_float4(0.f, 0.f, 0.f, 0.f); }
#pragma unroll
            for (int u = 0; u < 2; ++u) { const size_t i = i0 + u * gthreads;
                if (i < N16) {
                    u32x4 w0, w1, q;
                    w0.x = pack2(v[u][0].x, v[u][0].y); w0.y = pack2(v[u][0].z, v[u][0].w); w0.z = pack2(v[u][1].x, v[u][1].y); w0.w = pack2(v[u][1].z, v[u][1].w);
                    w1.x = pack2(v[u][2].x, v[u][2].y); w1.y = pack2(v[u][2].z, v[u][2].w); w1.z = pack2(v[u][3].x, v[u][3].y); w1.w = pack2(v[u][3].z, v[u][3].w);
                    q.x = pack4_fp8(v[u][0].x, v[u][0].y, v[u][0].z, v[u][0].w); q.y = pack4_fp8(v[u][1].x, v[u][1].y, v[u][1].z, v[u][1].w);
                    q.z = pack4_fp8(v[u][2].x, v[u][2].y, v[u][2].z, v[u][2].w); q.w = pack4_fp8(v[u][3].x, v[u][3].y, v[u][3].z, v[u][3].w);
                    ((u32x4*)p.xb)[i * 2] = w0; ((u32x4*)p.xb)[i * 2 + 1] = w1; ((u32x4*)p.xq)[i] = q;
                }
            }
        }
    }
    if (bid < 32) {
        float* lf = (float*)ldsc;
        const int j = tid & 63, part = tid >> 6, lw = bid >> 3, sl = bid & 7;
        const float* pe = p.cmp_pe + (size_t)lw * 2048; const float* w1 = p.cmp_w1 + (size_t)lw * 2048 * 64;
        float s = 0.f;
#pragma unroll 8
        for (int kk = sl * 256 + part * 32; kk < sl * 256 + part * 32 + 32; ++kk) s += pe[kk] * w1[(size_t)kk * 64 + j];
        lf[tid] = s; __syncthreads();
        if (tid < 64) { float a = 0.f; for (int q = 0; q < 8; ++q) a += lf[tid + 64 * q]; p.b1c[(lw * 8 + sl) * 64 + tid] = a; }
        __syncthreads();
    }
}

__device__ __forceinline__ int vcu_id() { return __builtin_amdgcn_readfirstlane(*(const volatile LAS int*)(LDS_BYTES - 32)); }
namespace pg8 {
constexpr int BM = 256, BK = 64, HALF = 128, HTB = HALF * BK * 2, NXCD = 8, WGM = 8;
__device__ __forceinline__ int lds_byte(int r, int c) { const int ch = (c >> 3) ^ ((r >> 1) & 7); return (r >> 3) * 1024 + (r & 7) * 128 + ch * 16 + (c & 7) * 2; }
__device__ __forceinline__ void stage_rc(int b, int& R, int& C) { const int st = b / 1024, sb = b % 1024; R = st * 8 + sb / 128; C = ((((sb % 128) / 16) ^ ((R >> 1) & 7)) * 16 + (sb % 16)) / 2; }
__device__ __forceinline__ bool tile_order(int i, int G, int c, int nM, int nN, int& pm, int& pn) {
    const int nwg = nM * nN; const long L = (long)i * G + c; if (L >= nwg) return false;
    const int wgid = (int)L;
    const int nig = WGM * nN, gid = wgid / nig, fm = gid * WGM, gsz = (nM - fm) < WGM ? (nM - fm) : WGM;
    pm = fm + ((wgid % nig) % gsz); pn = (wgid % nig) / gsz; return true;
}
template <bool FP8, int SCA, class Sched, class Epi>
__device__ __forceinline__ void gemm_phase(LAS unsigned char* lds, const char* Abase, int K, const Sched& S, const Epi& E) {
    int tid = threadIdx.x; asm volatile("" : "+v"(tid));
    const int wid = __builtin_amdgcn_readfirstlane(tid >> 6), lane = tid & 63, wr = wid >> 2, wc = wid & 3, fr = lane & 15, fq = lane >> 4;
    const int nt = K / BK;
    int R0, C0, R1, C1; stage_rc(tid * 16, R0, C0); stage_rc(tid * 16 + 8192, R1, C1);
    LAS unsigned* aofs = (LAS unsigned*)(lds + LDS_AOFF) + tid;
    unsigned rg[10];
    rg[8] = (unsigned)(R0 * K + C0) * 2u; rg[9] = (unsigned)(R1 * K + C1) * 2u;
    if constexpr (FP8) { aofs[8 * NTHR] = rg[8]; aofs[9 * NTHR] = rg[9]; }
    const size_t kstep = (size_t)(BK * 2), hstep = (size_t)HALF * K * 2;
    const unsigned ldsw = (unsigned)wid * 1024u;
    const int aoff = lds_byte(wr * 64 + fr, fq * 8), boff = lds_byte(wc * 32 + fr, fq * 8);
#define PG8_SA(b, h) (((b) * 2 + (h)) * HTB)
#define PG8_SB(b, h) ((4 + (b) * 2 + (h)) * HTB)
#define PG8_OFS(sel, j) (FP8 ? aofs[((sel) * 4 + (j)) * NTHR] : ((sel) ? rg[4 + (j)] : rg[(j)]))
#define PG8_STAGE_B(bufoff, gbase) do { _Pragma("unroll") for (int _i = 0; _i < 2; ++_i) { const unsigned ob_ = FP8 ? aofs[(8 + _i) * NTHR] : rg[8 + _i]; \
        __builtin_amdgcn_global_load_lds((const unsigned*)((const char*)(gbase) + ob_), (LAS unsigned*)(lds + (bufoff) + ldsw + _i * 8192), 16, 0, 0); } } while (0)
#define PG8_STAGE_A(bufoff, kbyte, sel, h) do { const unsigned o0_ = PG8_OFS(sel, (h) * 2), o1_ = PG8_OFS(sel, (h) * 2 + 1); \
        __builtin_amdgcn_global_load_lds((const unsigned*)(Abase + (kbyte) + o0_), (LAS unsigned*)(lds + (bufoff) + ldsw), 16, 0, 0); \
        __builtin_amdgcn_global_load_lds((const unsigned*)(Abase + (kbyte) + o1_), (LAS unsigned*)(lds + (bufoff) + ldsw + 8192), 16, 0, 0); } while (0)
#define PG8_LDA(dst, b, h) do { _Pragma("unroll") for (int m = 0; m < 4; ++m) { \
        if constexpr (FP8) { const v4i_t lo_ = *(const LAS v4i_t*)(lds + PG8_SA(b, h) + aoff + m * 2048), hi_ = *(const LAS v4i_t*)(lds + PG8_SA(b, h) + (aoff ^ 64) + m * 2048); dst##8[m] = __builtin_shufflevector(lo_, hi_, 0, 1, 2, 3, 4, 5, 6, 7); } \
        else { _Pragma("unroll") for (int k = 0; k < 2; ++k) dst[m][k] = *(const LAS bf16x8*)(lds + PG8_SA(b, h) + (aoff ^ (k * 64)) + m * 2048); } } } while (0)
#define PG8_LDB(dst, b, h) do { _Pragma("unroll") for (int n = 0; n < 2; ++n) { \
        if constexpr (FP8) { const v4i_t lo_ = *(const LAS v4i_t*)(lds + PG8_SB(b, h) + boff + n * 2048), hi_ = *(const LAS v4i_t*)(lds + PG8_SB(b, h) + (boff ^ 64) + n * 2048); dst##8[n] = __builtin_shufflevector(lo_, hi_, 0, 1, 2, 3, 4, 5, 6, 7); } \
        else { _Pragma("unroll") for (int k = 0; k < 2; ++k) dst[n][k] = *(const LAS bf16x8*)(lds + PG8_SB(b, h) + (boff ^ (k * 64)) + n * 2048); } } } while (0)
#define PG8_MMA(ai, bj, At, Bt) do { __builtin_amdgcn_s_setprio(1); _Pragma("unroll") for (int m = 0; m < 4; ++m) _Pragma("unroll") for (int n = 0; n < 2; ++n) { \
        if constexpr (FP8) { acc[ai][bj][m][n] = __builtin_amdgcn_mfma_scale_f32_16x16x128_f8f6f4(Bt##8[n], At##8[m], acc[ai][bj][m][n], 0, 0, 0, SCA, 0, SCA); } \
        else { _Pragma("unroll") for (int k = 0; k < 2; ++k) acc[ai][bj][m][n] = __builtin_amdgcn_mfma_f32_16x16x32_bf16(Bt[n][k], At[m][k], acc[ai][bj][m][n], 0, 0, 0); } } \
        __builtin_amdgcn_s_setprio(0); } while (0)
#define PG8_WAIT_V(n) asm volatile("s_waitcnt vmcnt(" #n ")" ::: "memory")
#define PG8_WAIT_L(n) asm volatile("s_waitcnt lgkmcnt(" #n ")" ::: "memory")
#define PG8_BAR __builtin_amdgcn_s_barrier()
#define PG8_SCHED __builtin_amdgcn_sched_barrier(0)
    typename Sched::Unit cur, nxt; int ui = 0;
    if (!S.next(0, cur)) return;
    f32x4 acc[2][2][4][2];
    bf16x8 At[4][2], B0[2][2], B1[2][2];
    v8i_t At8[4], B08[2], B18[2];
    { unsigned a4[2][2]; S.a_off(cur, R0, C0, R1, C1, a4); rg[0] = a4[0][0]; rg[1] = a4[0][1]; rg[2] = a4[1][0]; rg[3] = a4[1][1];
      if constexpr (FP8) { aofs[0] = a4[0][0]; aofs[NTHR] = a4[0][1]; aofs[2 * NTHR] = a4[1][0]; aofs[3 * NTHR] = a4[1][1]; } }
    const char* cB = S.b_ptr(cur);
#define PG8_BIAS_DMA(unit, slot) do { const float* bp_ = E.bias_ptr(unit); int tb_ = threadIdx.x; asm volatile("" : "+v"(tb_)); if (wr == 0 && bp_ != nullptr) \
        __builtin_amdgcn_global_load_lds((const unsigned*)(bp_ + (tb_ & 255)), (LAS unsigned*)(lds + LDS_BIAS + (slot) * 1024 + wid * 256), 4, 0, 0); } while (0)
    PG8_BIAS_DMA(cur, 0);
    PG8_STAGE_B(PG8_SB(0, 0), cB); PG8_STAGE_B(PG8_SB(0, 1), cB + hstep); PG8_STAGE_A(PG8_SA(0, 0), 0, 0, 0); PG8_STAGE_A(PG8_SA(0, 1), 0, 0, 1);
    if (wr == 1) PG8_BAR;
    PG8_WAIT_V(2); PG8_BAR;
    PG8_STAGE_B(PG8_SB(1, 0), cB + kstep); PG8_STAGE_A(PG8_SA(1, 0), kstep, 0, 0); PG8_STAGE_B(PG8_SB(1, 1), cB + hstep + kstep);
    PG8_WAIT_V(6); PG8_BAR;
    { int t3 = threadIdx.x; asm volatile("" : "+v"(t3)); E.init(acc, wc, (t3 & 63) >> 4, (const LAS float*)(lds + LDS_BIAS)); }
    for (;;) {
        const bool has_next = S.next(ui + 1, nxt);
        const char* nB = cB;
        if (has_next) PG8_BIAS_DMA(nxt, (ui + 1) % 3);
        if (has_next) { int t2 = threadIdx.x; asm volatile("" : "+v"(t2)); int r0, c0, r1, c1; stage_rc(t2 * 16, r0, c0); stage_rc(t2 * 16 + 8192, r1, c1); nB = S.b_ptr(nxt);
            if constexpr (Sched::LIST_DMA) { static_assert(!Sched::LIST_DMA || FP8, "list DMA lands in the LDS offset slots"); S.a_dma(nxt, r0, r1, (LAS unsigned*)(lds + LDS_AOFF + 4 * NTHR * 4 + wid * 256)); }
            else { unsigned a4[2][2]; S.a_off(nxt, r0, c0, r1, c1, a4);
                rg[4] = a4[0][0]; rg[5] = a4[0][1]; rg[6] = a4[1][0]; rg[7] = a4[1][1];
                if constexpr (FP8) { aofs[4 * NTHR] = a4[0][0]; aofs[5 * NTHR] = a4[0][1]; aofs[6 * NTHR] = a4[1][0]; aofs[7 * NTHR] = a4[1][1]; } } }
        else { rg[4] = rg[0]; rg[5] = rg[1]; rg[6] = rg[2]; rg[7] = rg[3];
            if constexpr (FP8) { aofs[4 * NTHR] = aofs[0]; aofs[5 * NTHR] = aofs[NTHR]; aofs[6 * NTHR] = aofs[2 * NTHR]; aofs[7 * NTHR] = aofs[3 * NTHR]; } }
#pragma unroll 1
        for (int t = 0; t < nt; t += 2) {
            const bool last = (t == nt - 2);
            const size_t ka1 = (size_t)(t + 1) * kstep, ka2 = last ? 0 : (size_t)(t + 2) * kstep, ka3 = ka2 + kstep;
            const char* b2 = last ? nB : cB + (size_t)(t + 2) * kstep; const char* b3 = b2 + kstep;
            const int sel = last ? 1 : 0;
            if constexpr (Sched::LIST_DMA) if (last && has_next) {
                int t4 = threadIdx.x; asm volatile("" : "+v"(t4)); int r0, c0, r1, c1; stage_rc(t4 * 16, r0, c0); stage_rc(t4 * 16 + 8192, r1, c1);
#pragma unroll
                for (int j = 0; j < 4; ++j) aofs[(4 + j) * NTHR] = S.a_fin(aofs[(4 + j) * NTHR], (j & 1) ? c1 : c0);
            }
            PG8_LDB(B0, 0, 0); PG8_LDB(B1, 0, 1); PG8_SCHED; PG8_LDA(At, 0, 0); PG8_STAGE_A(PG8_SA(1, 1), ka1, 0, 1);
            PG8_WAIT_V(8); PG8_WAIT_L(0); PG8_BAR; PG8_MMA(0, 0, At, B0); PG8_MMA(0, 1, At, B1); PG8_BAR; PG8_SCHED;
            PG8_LDA(At, 0, 1); PG8_STAGE_B(PG8_SB(0, 0), b2); PG8_STAGE_B(PG8_SB(0, 1), b2 + hstep); PG8_STAGE_A(PG8_SA(0, 0), ka2, sel, 0);
            PG8_WAIT_V(8); PG8_WAIT_L(0); PG8_BAR; PG8_MMA(1, 0, At, B0); PG8_MMA(1, 1, At, B1); PG8_BAR; PG8_SCHED;
            PG8_LDB(B0, 1, 0); PG8_LDB(B1, 1, 1); PG8_SCHED; PG8_LDA(At, 1, 0); PG8_STAGE_A(PG8_SA(0, 1), ka2, sel, 1);
            PG8_WAIT_V(8); PG8_WAIT_L(0); PG8_BAR; PG8_MMA(0, 0, At, B0); PG8_MMA(0, 1, At, B1); PG8_BAR; PG8_SCHED;
            PG8_LDA(At, 1, 1); PG8_STAGE_B(PG8_SB(1, 0), b3); PG8_STAGE_B(PG8_SB(1, 1), b3 + hstep); PG8_STAGE_A(PG8_SA(1, 0), ka3, sel, 0);
            PG8_WAIT_V(8); PG8_WAIT_L(0); PG8_BAR; PG8_MMA(1, 0, At, B0); PG8_MMA(1, 1, At, B1); PG8_BAR; PG8_SCHED;
        }
        if (wr == 0) PG8_BAR;
        { int t2 = threadIdx.x; asm volatile("" : "+v"(t2)); E(acc, cur, wr, wc, t2 & 15, (t2 & 63) >> 4, (const LAS float*)(lds + LDS_BIAS + (ui % 3) * 1024)); }
        if (!has_next) break;
        { int t3 = threadIdx.x; asm volatile("" : "+v"(t3)); E.init(acc, wc, (t3 & 63) >> 4, (const LAS float*)(lds + LDS_BIAS + ((ui + 1) % 3) * 1024)); }
        cur = nxt; cB = nB; ++ui;
        rg[0] = rg[4]; rg[1] = rg[5]; rg[2] = rg[6]; rg[3] = rg[7];
        if constexpr (FP8) { aofs[0] = aofs[4 * NTHR]; aofs[NTHR] = aofs[5 * NTHR]; aofs[2 * NTHR] = aofs[6 * NTHR]; aofs[3 * NTHR] = aofs[7 * NTHR]; }
        if (wr == 1) PG8_BAR;
    }
    PG8_WAIT_V(0);
    PG8_BAR;
#undef PG8_BIAS_DMA
#undef PG8_SA
#undef PG8_SB
#undef PG8_STAGE_A
#undef PG8_OFS
#undef PG8_STAGE_B
#undef PG8_LDA
#undef PG8_LDB
#undef PG8_MMA
#undef PG8_WAIT_V
#undef PG8_WAIT_L
#undef PG8_BAR
#undef PG8_SCHED
}
}

struct DenseUnit { int pm, pn; };
struct DenseSched {
    typedef DenseUnit Unit;
    const char* Bt; int K, nM, nN, vc;
    __device__ __forceinline__ bool next(int i, Unit& u) const { return pg8::tile_order(i, gridDim.x, vc, nM, nN, u.pm, u.pn); }
    __device__ __forceinline__ void a_off(const Unit& u, int R0, int C0, int R1, int C1, unsigned (&off)[2][2]) const {
#pragma unroll
        for (int h = 0; h < 2; ++h) { off[h][0] = (unsigned)((u.pm * 256 + h * 128 + R0) * K + C0) * 2u; off[h][1] = (unsigned)((u.pm * 256 + h * 128 + R1) * K + C1) * 2u; }
    }
    __device__ __forceinline__ const char* b_ptr(const Unit& u) const { return Bt + (size_t)u.pn * 256 * K * 2; }
    static constexpr bool LIST_DMA = false;
    __device__ __forceinline__ void a_dma(const Unit&, int, int, LAS unsigned*) const {}
    __device__ __forceinline__ unsigned a_fin(unsigned raw, int) const { return raw; }
};
struct MoeUnit { int rbt, e, pn; };
template <bool GATHER>
struct MoeSched {
    typedef MoeUnit Unit;
    static constexpr int KP = 512;
    const char* Bt; const int* lists; const int* ptile; const int* ecnt; int nN, nrows, vc;
    __device__ __forceinline__ bool next(int i, Unit& u) const {
        int pm, pn; if (!pg8::tile_order(i, gridDim.x, vc, ptile[NE], nN, pm, pn)) return false;
        u.rbt = pm; u.e = ((const unsigned char*)ptile)[512 + pm]; u.pn = pn; return true;
    }
    __device__ __forceinline__ void a_off(const Unit& u, int R0, int C0, int R1, int C1, unsigned (&off)[2][2]) const {
        if (GATHER) {
            const int* lst = lists + (size_t)u.e * LIST_CAP; const int rb = u.rbt - ptile[u.e], cnt = ecnt[u.e];
#pragma unroll
            for (int h = 0; h < 2; ++h) {
                const int l0 = rb * 256 + h * 128 + R0, l1 = rb * 256 + h * 128 + R1;
                const int t0 = l0 < cnt ? (lst[l0] >> 2) : 0, t1 = l1 < cnt ? (lst[l1] >> 2) : 0;
                off[h][0] = (unsigned)(t0 * KP + C0) * 2u; off[h][1] = (unsigned)(t1 * KP + C1) * 2u;
            }
        } else {
#pragma unroll
            for (int h = 0; h < 2; ++h) { off[h][0] = (unsigned)((u.rbt * 256 + h * 128 + R0) * KP + C0) * 2u; off[h][1] = (unsigned)((u.rbt * 256 + h * 128 + R1) * KP + C1) * 2u; }
        }
    }
    __device__ __forceinline__ const char* b_ptr(const Unit& u) const { return Bt + ((size_t)u.e * nrows + (size_t)u.pn * 256) * KP * 2; }
    static constexpr bool LIST_DMA = GATHER;
    __device__ __forceinline__ void a_dma(const Unit& u, int R0, int R1, LAS unsigned* slot) const {
        const int* lst = lists + (size_t)u.e * LIST_CAP; const int rb = u.rbt - ptile[u.e], cm = ecnt[u.e] - 1;
#pragma unroll
        for (int h = 0; h < 2; ++h) {
            const int l0 = min(rb * 256 + h * 128 + R0, cm), l1 = min(rb * 256 + h * 128 + R1, cm);
            __builtin_amdgcn_global_load_lds((const unsigned*)(lst + l0), slot + (h * 2) * NTHR, 4, 0, 0);
            __builtin_amdgcn_global_load_lds((const unsigned*)(lst + l1), slot + (h * 2 + 1) * NTHR, 4, 0, 0);
        }
    }
    __device__ __forceinline__ unsigned a_fin(unsigned raw, int C) const { return (unsigned)((int)(raw >> 2) * KP + C) * 2u; }
};

__device__ __forceinline__ u32x2 quad_tr(unsigned p01, unsigned p23, int fr) {
    const unsigned sel = (fr & 1) ? 0x03020706u : 0x05040100u;
    const unsigned y01 = (unsigned)__builtin_amdgcn_update_dpp(0, (int)p01, 0xB1, 0xF, 0xF, true), y23 = (unsigned)__builtin_amdgcn_update_dpp(0, (int)p23, 0xB1, 0xF, 0xF, true);
    const unsigned q01 = __builtin_amdgcn_perm(y01, p01, sel), q23 = __builtin_amdgcn_perm(y23, p23, sel);
    const bool hi = (fr & 2) != 0;
    const unsigned snd = hi ? q01 : q23;
    const unsigned rcv = (unsigned)__builtin_amdgcn_update_dpp(0, (int)snd, 0x4E, 0xF, 0xF, true);
    u32x2 r; r.x = hi ? rcv : q01; r.y = hi ? q23 : rcv; return r;
}
struct EpiInProj {
    const Params* p; int l;
    __device__ __forceinline__ const float* bias_ptr(const DenseUnit& u) const { return p->binp + l * NPAD + u.pn * 256; }
    __device__ __forceinline__ void init(f32x4 (&acc)[2][2][4][2], int wc, int fq, const LAS float* bias) const {
#pragma unroll
        for (int bj = 0; bj < 2; ++bj)
#pragma unroll
            for (int n = 0; n < 2; ++n) {
                const f32x4 bv = *(const LAS f32x4*)(bias + bj * 128 + wc * 32 + n * 16 + 4 * fq);
#pragma unroll
                for (int ai = 0; ai < 2; ++ai)
#pragma unroll
                    for (int m = 0; m < 4; ++m) acc[ai][bj][m][n] = bv;
            }
    }
    __device__ __forceinline__ void operator()(const f32x4 (&acc)[2][2][4][2], const DenseUnit& u, int wr, int wc, int fr, int fq, const LAS float*) const {
#pragma unroll
        for (int bj = 0; bj < 2; ++bj) {
            int kind = 0, hb0 = 0;
            if (u.pn == 1) { kind = 1; hb0 = bj * 2; } else if (u.pn == 4 && bj == 1) { kind = 1; hb0 = 4; } else if (u.pn == 8 && bj == 0) { kind = 1; hb0 = 6; } else if (u.pn == 9 && bj == 0) { kind = 1; hb0 = 8; }
            else if (u.pn == 2) { kind = 2; hb0 = bj * 2; } else if (u.pn == 5 && bj == 0) { kind = 2; hb0 = 4; } else if (u.pn == 8 && bj == 1) { kind = 2; hb0 = 6; } else if (u.pn == 9 && bj == 1) { kind = 2; hb0 = 8; }
            const int c0 = wc * 32 + fq * 8;
            const int hh = hb0 + (c0 >> 6), d0 = c0 & 63;
#pragma unroll
            for (int ai = 0; ai < 2; ++ai)
#pragma unroll
                for (int m = 0; m < 4; ++m) {
                    const int row = u.pm * 256 + ai * 128 + wr * 64 + m * 16 + fr;
                    const f32x4 v0 = acc[ai][bj][m][0], v1 = acc[ai][bj][m][1];
                    u32x4 w; w.x = pack2(v0[0], v0[1]); w.y = pack2(v0[2], v0[3]); w.z = pack2(v1[0], v1[1]); w.w = pack2(v1[2], v1[3]);
                    if (kind == 0) *(u32x4*)(p->hb + (size_t)row * NMAIN + u.pn * 256 + bj * 128 + c0) = w;
                    else {
                        const int b = row >> 11, s = row & 2047, kk = s & 31;
                        bf16_t* blk = (kind == 1 ? p->kF : p->vT) + (((size_t)b * NVH + hh) * 64 + (s >> 5)) * 2048;
                        if (kind == 1) {
                            const int frk = (kk >> 3) * 4 + (kk & 3), t = (kk >> 2) & 1;
                            *(u32x4*)(blk + ((t * 2 + (d0 >> 5)) * 64 + ((d0 & 31) >> 3) * 16 + frk) * 8) = w;
                        } else {
                            const int kq = kk & 28;
                            const u32x2 t0 = quad_tr(w.x, w.y, fr), t1 = quad_tr(w.z, w.w, fr);
                            bf16_t* vt = blk + (((d0 >> 4) * 64) + (kq >> 3) * 16 + (d0 & 15) + (fr & 3)) * 8 + (kq & 7);
                            *(u32x2*)vt = t0; *(u32x2*)(vt + 32) = t1;
                        }
                    }
                }
        }
    }
};
struct EpiOutProj {
    const bf16_t* xin; float* t;
    __device__ __forceinline__ const float* bias_ptr(const DenseUnit&) const { return nullptr; }
    __device__ __forceinline__ void init(f32x4 (&acc)[2][2][4][2], int, int, const LAS float*) const {
#pragma unroll
        for (int ai = 0; ai < 2; ++ai)
#pragma unroll
            for (int bj = 0; bj < 2; ++bj)
#pragma unroll
                for (int m = 0; m < 4; ++m)
#pragma unroll
                    for (int n = 0; n < 2; ++n) acc[ai][bj][m][n] = (f32x4){0.f, 0.f, 0.f, 0.f};
    }
    __device__ __forceinline__ void operator()(const f32x4 (&acc)[2][2][4][2], const DenseUnit& u, int wr, int wc, int fr, int fq, const LAS float*) const {
#pragma unroll
        for (int ai = 0; ai < 2; ++ai)
#pragma unroll
            for (int m = 0; m < 4; ++m) {
                const size_t off = (size_t)(u.pm * 256 + ai * 128 + wr * 64 + m * 16 + fr) * DM + u.pn * 256 + wc * 64 + fq * 16;
                const u32x4 x0 = *(const u32x4*)(xin + off), x1 = *(const u32x4*)(xin + off + 8);
                const unsigned xs[8] = {x0.x, x0.y, x0.z, x0.w, x1.x, x1.y, x1.z, x1.w};
                unsigned w[8];
#pragma unroll
                for (int q = 0; q < 4; ++q) {
                    const f32x4 a = acc[ai][q >> 1][m][q & 1];
                    const float t0 = __uint_as_float(xs[2 * q] << 16) * ALPHA + a[0], t1 = __uint_as_float(xs[2 * q] & 0xffff0000u) * ALPHA + a[1];
                    const float t2 = __uint_as_float(xs[2 * q + 1] << 16) * ALPHA + a[2], t3 = __uint_as_float(xs[2 * q + 1] & 0xffff0000u) * ALPHA + a[3];
                    w[2 * q] = pack2(t0, t1); w[2 * q + 1] = pack2(t2, t3);
                }
                u32x4 w0, w1; w0.x = w[0]; w0.y = w[1]; w0.z = w[2]; w0.w = w[3]; w1.x = w[4]; w1.y = w[5]; w1.z = w[6]; w1.w = w[7];
                *(u32x4*)((bf16_t*)t + off) = w0; *(u32x4*)((bf16_t*)t + off + 8) = w1;
            }
    }
};
struct EpiGateUp {
    bf16_t* act; const float* bgup;
    __device__ __forceinline__ const float* bias_ptr(const MoeUnit& u) const { return bgup + (size_t)u.e * 2048 + u.pn * 256; }
    __device__ __forceinline__ void init(f32x4 (&acc)[2][2][4][2], int wc, int fq, const LAS float* bias) const {
#pragma unroll
        for (int bj = 0; bj < 2; ++bj)
#pragma unroll
            for (int n = 0; n < 2; ++n) {
                const f32x4 bv = *(const LAS f32x4*)(bias + bj * 128 + wc * 32 + n * 16 + 4 * fq);
#pragma unroll
                for (int ai = 0; ai < 2; ++ai)
#pragma unroll
                    for (int m = 0; m < 4; ++m) acc[ai][bj][m][n] = bv;
            }
    }
    __device__ __forceinline__ void operator()(const f32x4 (&acc)[2][2][4][2], const MoeUnit& u, int wr, int wc, int fr, int fq, const LAS float*) const {
        constexpr float GMIN = 7.0f * GATE_PRE, CI = 1.0f / GATE_PRE;
#pragma unroll
        for (int ai = 0; ai < 2; ++ai)
#pragma unroll
            for (int m = 0; m < 4; ++m) {
                u32x2 w;
#pragma unroll
                for (int n = 0; n < 2; ++n) {
                    const f32x4 g4 = acc[ai][0][m][n], u4 = acc[ai][1][m][n];
                    float o[4];
#pragma unroll
                    for (int j = 0; j < 4; ++j) {
                        const float gp = fmaxf(g4[j], GMIN), uu = fminf(fmaxf(u4[j], -7.0f), 7.0f);
                        const float glu = gp * __builtin_amdgcn_rcpf(1.0f + __builtin_amdgcn_exp2f(gp));
                        o[j] = __builtin_fmaf(uu, CI, CI) * glu;
                    }
                    const unsigned pk = pack4_fp8(o[0], o[1], o[2], o[3]);
                    if (n == 0) w.x = pk; else w.y = pk;
                }
                *(u32x2*)((char*)act + (size_t)(u.rbt * 256 + ai * 128 + wr * 64 + m * 16 + fr) * DFF + u.pn * 128 + wc * 32 + fq * 8) = w;
            }
    }
};
struct EpiDown {
    bf16_t* ybuf; const float* bdn;
    __device__ __forceinline__ const float* bias_ptr(const MoeUnit& u) const { return bdn + (size_t)u.e * 1024 + u.pn * 256; }
    __device__ __forceinline__ void init(f32x4 (&acc)[2][2][4][2], int wc, int fq, const LAS float* bias) const {
#pragma unroll
        for (int bj = 0; bj < 2; ++bj)
#pragma unroll
            for (int n = 0; n < 2; ++n) {
                const f32x4 bv = *(const LAS f32x4*)(bias + wc * 64 + fq * 16 + bj * 8 + n * 4);
#pragma unroll
                for (int ai = 0; ai < 2; ++ai)
#pragma unroll
                    for (int m = 0; m < 4; ++m) acc[ai][bj][m][n] = bv;
            }
    }
    __device__ __forceinline__ void operator()(const f32x4 (&acc)[2][2][4][2], const MoeUnit& u, int wr, int wc, int fr, int fq, const LAS float*) const {
#pragma unroll
        for (int ai = 0; ai < 2; ++ai)
#pragma unroll
            for (int m = 0; m < 4; ++m) {
                u32x4 w;
                { const f32x4 v = acc[ai][0][m][0]; w.x = pack4_fp8(v[0], v[1], v[2], v[3]); }
                { const f32x4 v = acc[ai][0][m][1]; w.y = pack4_fp8(v[0], v[1], v[2], v[3]); }
                { const f32x4 v = acc[ai][1][m][0]; w.z = pack4_fp8(v[0], v[1], v[2], v[3]); }
                { const f32x4 v = acc[ai][1][m][1]; w.w = pack4_fp8(v[0], v[1], v[2], v[3]); }
                *(u32x4*)((unsigned char*)ybuf + (size_t)(u.rbt * 256 + ai * 128 + wr * 64 + m * 16 + fr) * DM + u.pn * 256 + wc * 64 + fq * 16) = w;
            }
    }
};

__device__ __forceinline__ void phase_inproj(const Params& p, int l, char* lds) {
    DenseSched S{(const char*)p.WinQ + (size_t)l * NMAIN * 1024, 512, NTOK / 256, NMAIN / 256, vcu_id()};
    EpiInProj E{&p, l};
    pg8::gemm_phase<true, 0x7c7c7c7c>((LAS unsigned char*)lds, (const char*)p.xq, 512, S, E);
    int tid = threadIdx.x; asm volatile("" : "+v"(tid));
    const int wid = tid >> 6, lane = tid & 63, fr = lane & 15, fq = lane >> 4;
    const bf16_t* W = p.WinT + ((size_t)l * NPAD + NMAIN) * 1024;
    const float* bias = p.binp + l * NPAD + NMAIN;
    constexpr int WP = 2064;
#pragma unroll
    for (int i = 0; i < 8; ++i) { const int pc = wid * 8 + i, r = pc >> 1, q = pc & 1;
        __builtin_amdgcn_global_load_lds((const unsigned*)(W + (size_t)r * 1024 + q * 512 + lane * 8), (LAS unsigned*)((LAS char*)lds + r * WP + q * 1024), 16, 0, 0); }
    asm volatile("s_waitcnt vmcnt(0)" ::: "memory");
    __syncthreads();
    for (int u = blockIdx.x * NWV + wid; u < NTOK / 16; u += gridDim.x * NWV) {
        const bf16_t* ar = p.xb + (size_t)(u * 16 + fr) * DM + fq * 8;
        const LAS char* w0 = (const LAS char*)lds + fr * WP + fq * 16; const LAS char* w1 = w0 + 16 * WP;
        f32x4 a0 = (f32x4){0.f, 0.f, 0.f, 0.f}, a1 = a0;
#pragma unroll 4
        for (int ks = 0; ks < 32; ++ks) {
            const bf16x8 a = *(const bf16x8*)(ar + ks * 32);
            a0 = __builtin_amdgcn_mfma_f32_16x16x32_bf16(a, *(const LAS bf16x8*)(w0 + ks * 64), a0, 0, 0, 0);
            a1 = __builtin_amdgcn_mfma_f32_16x16x32_bf16(a, *(const LAS bf16x8*)(w1 + ks * 64), a1, 0, 0, 0);
        }
#pragma unroll
        for (int r = 0; r < 4; ++r) {
            float* dst = p.hs + (size_t)(u * 16 + fq * 4 + r) * HS_W;
            dst[fr] = a0[r] + bias[fr];
            if (fr < 6) dst[16 + fr] = a1[r] + bias[16 + fr];
        }
    }
}
__device__ __forceinline__ void phase_outproj(const Params& p, int l, const bf16_t* xin, char* lds) {
    DenseSched S{(const char*)p.WoT + (size_t)l * 1024 * 1024, 512, NTOK / 256, 4, vcu_id()};
    EpiOutProj E{xin, p.tbuf};
    pg8::gemm_phase<true, 0x7c7c7c7c>((LAS unsigned char*)lds, (const char*)p.ob, 512, S, E);
}
__device__ __forceinline__ void build_tiles(const Params& p, int l, int* ptile, int* ecnt) {
    int tid = threadIdx.x; asm volatile("" : "+v"(tid));
    if (tid < NE) ecnt[tid] = (int)__hip_atomic_load(p.ctrl + 64 + l * NE + tid, __ATOMIC_RELAXED, __HIP_MEMORY_SCOPE_AGENT);
    __syncthreads();
    if (tid == 0) { int s = 0; for (int e = 0; e < NE; ++e) { ptile[e] = s; s += (ecnt[e] + 255) >> 8; } ptile[NE] = s; }
    __syncthreads();
    unsigned char* texp = (unsigned char*)ptile + 512;
    for (int t = tid; t < ptile[NE]; t += NTHR) { int e = 0; while (ptile[e + 1] <= t) ++e; texp[t] = (unsigned char)e; }
    __syncthreads();
}
__device__ __forceinline__ void phase_gateup(const Params& p, int l, char* lds) {
    int* ptile = (int*)(lds + LDS_TAB); int* ecnt = ptile + 40;
    build_tiles(p, l, ptile, ecnt);
    MoeSched<true> S{(const char*)p.WguT + (size_t)l * NE * 2048 * 1024, p.lists, ptile, ecnt, 8, 2048, vcu_id()};
    EpiGateUp E{p.act, p.bgup + (size_t)l * NE * 2048};
    pg8::gemm_phase<true, 0x7c7c7c7c>((LAS unsigned char*)lds, (const char*)p.x1b, 512, S, E);
}
__device__ __forceinline__ void phase_down(const Params& p, int l, char* lds) {
    int* ptile = (int*)(lds + LDS_TAB); int* ecnt = ptile + 40;
    build_tiles(p, l, ptile, ecnt);
    MoeSched<false> S{(const char*)p.WdnT + (size_t)l * NE * 1024 * 1024, p.lists, ptile, ecnt, 4, 1024, vcu_id()};
    EpiDown E{p.ybuf, p.b_dn + (size_t)l * NE * 1024};
    pg8::gemm_phase<true, 0x7c7c7c7c>((LAS unsigned char*)lds, (const char*)p.act, 512, S, E);
}

__device__ __forceinline__ float gelu_tanh(float x) {
    const float u = 0.7978845608028654f * (x + 0.044715f * x * x * x);
    const float e = __expf(-2.0f * fabsf(u)); const float th = (1.0f - e) / (1.0f + e);
    return 0.5f * x * (1.0f + (u < 0.f ? -th : th));
}
__device__ __forceinline__ void phase_prep(const Params& p, int l, char* lds) {
    int tid = threadIdx.x; asm volatile("" : "+v"(tid));
    const int wid = tid >> 6, lane = tid & 63, fr = lane & 15, fq = lane >> 4;
    const int gw = blockIdx.x * NWV + wid, nw = gridDim.x * NWV;
    for (int u = (int)gridDim.x - 1 - (int)blockIdx.x; u < NB * 4; u += gridDim.x) {
        const int b = u >> 2, h = u & 3;
        const float* srcp = p.hs + ((size_t)b * SEQ + tid * 4) * HS_W + h;
        float ls[4]; float tot = 0.f;
#pragma unroll
        for (int i = 0; i < 4; ++i) { const float f = srcp[(size_t)i * HS_W]; ls[i] = fminf(f, 0.f) - log1pf(__expf(-fabsf(f))); tot += ls[i]; }
        float inc = tot;
#pragma unroll
        for (int o = 1; o < 64; o <<= 1) { const float v = shfl_f(inc, lane - o); if (lane >= o) inc += v; }
        float* wtot = (float*)(lds + 65536);
        if (lane == 63) wtot[wid] = inc;
        __syncthreads();
        float base = inc - tot;
        for (int w = 0; w < wid; ++w) base += wtot[w];
        float4 o4; o4.x = base + ls[0]; o4.y = o4.x + ls[1]; o4.z = o4.y + ls[2]; o4.w = o4.z + ls[3];
        *(float4*)(p.cF + (size_t)u * SEQ + tid * 4) = o4;
        __syncthreads();
    }
    float* part = (float*)lds;
    bf16_t* h1 = (bf16_t*)(lds + 32768);
    for (int u = blockIdx.x; u < NB * 2 * 2 * 8; u += gridDim.x) {
        const int ct = u & 7, which = (u >> 3) & 1, kvh = (u >> 4) & 1, b = u >> 5;
        const int colo = (which ? C_NVC : C_NKC) + kvh * 64;
        const int c_lane = ct * 16 + fr;
        const int tokbase = min(c_lane, 126) * 16;
        const bf16_t* arow = p.hb + ((size_t)b * SEQ + tokbase) * NMAIN + colo + fq * 8;
        const bf16_t* w1 = p.W1T + ((size_t)(l * 2 + which) * 64 + fr) * 2048 + fq * 8;
        f32x4 acc[4];
#pragma unroll
        for (int n = 0; n < 4; ++n) acc[n] = (f32x4){0.f, 0.f, 0.f, 0.f};
#pragma unroll
        for (int kk = 0; kk < 8; ++kk) {
            const int ks = wid * 8 + kk;
            const bf16x8 a = *(const bf16x8*)(arow + (size_t)(ks >> 1) * NMAIN + (ks & 1) * 32);
#pragma unroll
            for (int n = 0; n < 4; ++n) {
                const bf16x8 bb = *(const bf16x8*)(w1 + (size_t)n * 16 * 2048 + ks * 32);
                acc[n] = __builtin_amdgcn_mfma_f32_16x16x32_bf16(a, bb, acc[n], 0, 0, 0);
            }
        }
#pragma unroll
        for (int n = 0; n < 4; ++n)
#pragma unroll
            for (int r = 0; r < 4; ++r) part[wid * 1024 + (fq * 4 + r) * 64 + n * 16 + fr] = acc[n][r];
        __syncthreads();
        const float* b1 = p.b1c + (l * 2 + which) * 8 * 64;
#pragma unroll
        for (int i = 0; i < 2; ++i) {
            const int e = tid + NTHR * i; float sum = 0.f, bsum = 0.f;
#pragma unroll
            for (int w = 0; w < 8; ++w) { sum += part[w * 1024 + e]; bsum += b1[w * 64 + (e & 63)]; }
            h1[e] = f2bf(gelu_tanh(sum + bsum));
        }
        __syncthreads();
        if (wid == 0) {
            const bf16_t* w2 = p.W2T + ((size_t)(l * 2 + which) * 64 + fr) * 64 + fq * 8;
            f32x4 o2[4];
#pragma unroll
            for (int n = 0; n < 4; ++n) o2[n] = (f32x4){0.f, 0.f, 0.f, 0.f};
#pragma unroll
            for (int ks = 0; ks < 2; ++ks) {
                const bf16x8 a = *(const bf16x8*)(h1 + fr * 64 + ks * 32 + fq * 8);
#pragma unroll
                for (int n = 0; n < 4; ++n) {
                    const bf16x8 bb = *(const bf16x8*)(w2 + (size_t)n * 16 * 64 + ks * 32);
                    o2[n] = __builtin_amdgcn_mfma_f32_16x16x32_bf16(a, bb, o2[n], 0, 0, 0);
                }
            }
            const size_t base = ((size_t)b * 2 + kvh) * 128 * 64;
#pragma unroll
            for (int n = 0; n < 4; ++n)
#pragma unroll
                for (int r = 0; r < 4; ++r) {
                    const int c = ct * 16 + fq * 4 + r, j2 = n * 16 + fr;
                    const bf16_t v = c < 127 ? f2bf(o2[n][r]) : (bf16_t)0;
                    if (which == 0) p.kc[base + (size_t)c * 64 + j2] = v;
                    else { p.vc[base + (size_t)c * 64 + j2] = v; p.vcT[base + (size_t)j2 * 128 + c] = v; }
                }
        }
        __syncthreads();
    }
}

constexpr float L2E = 1.4426950408889634f, MASKV = -__builtin_huge_valf(), MINIT = -1e30f, SCL2 = QSCALE * L2E;
struct KVFrag { bf16x8 k[2][2]; bf16x8 v[4]; };
template <bool FM>
__device__ __forceinline__ void k_load(KVFrag& f, const bf16_t* __restrict__ Kb, size_t ldk, int kc0, int fr, int fq) {
    if (FM) {
        const bf16_t* kp = Kb + (size_t)(kc0 >> 5) * 2048 + (fq * 16 + fr) * 8;
        f.k[0][0] = *(const bf16x8*)(kp); f.k[0][1] = *(const bf16x8*)(kp + 512); f.k[1][0] = *(const bf16x8*)(kp + 1024); f.k[1][1] = *(const bf16x8*)(kp + 1536);
    } else {
        const bf16_t* kp = Kb + (size_t)(kc0 + (fr >> 2) * 8 + (fr & 3)) * ldk + fq * 8;
        f.k[0][0] = *(const bf16x8*)(kp); f.k[0][1] = *(const bf16x8*)(kp + 32);
        f.k[1][0] = *(const bf16x8*)(kp + 4 * ldk); f.k[1][1] = *(const bf16x8*)(kp + 4 * ldk + 32);
    }
}
template <bool FM>
__device__ __forceinline__ void v_load(bf16x8 (&v)[4], const bf16_t* __restrict__ VTb, size_t ldv, int kc0, int fr, int fq) {
    if (FM) {
        const bf16_t* vp = VTb + (size_t)(kc0 >> 5) * 2048 + (fq * 16 + fr) * 8;
#pragma unroll
        for (int dt = 0; dt < 4; ++dt) v[dt] = *(const bf16x8*)(vp + dt * 512);
    } else {
        const bf16_t* vp = VTb + (size_t)fr * ldv + kc0 + fq * 8;
#pragma unroll
        for (int dt = 0; dt < 4; ++dt) v[dt] = *(const bf16x8*)(vp + (size_t)dt * 16 * ldv);
    }
}
__device__ __forceinline__ float rowmax4(float x) {
    auto r = __builtin_amdgcn_permlane32_swap(__float_as_uint(x), __float_as_uint(x), false, false);
    x = fmaxf(__uint_as_float(r[0]), __uint_as_float(r[1]));
    auto q = __builtin_amdgcn_permlane16_swap(__float_as_uint(x), __float_as_uint(x), false, false);
    return fmaxf(__uint_as_float(q[0]), __uint_as_float(q[1]));
}
__device__ __forceinline__ float rowsum4(float x) {
    auto r = __builtin_amdgcn_permlane32_swap(__float_as_uint(x), __float_as_uint(x), false, false);
    x = __uint_as_float(r[0]) + __uint_as_float(r[1]);
    auto q = __builtin_amdgcn_permlane16_swap(__float_as_uint(x), __float_as_uint(x), false, false);
    return __uint_as_float(q[0]) + __uint_as_float(q[1]);
}
template <int NQT, bool MASK, class MB>
__device__ __forceinline__ void attn_compute(const KVFrag& f, const bf16x8 (&qf)[NQT][2], f32x4 (&o)[NQT][4], float (&m)[NQT], float (&l)[NQT], const MB& mb) {
    f32x4 s0[NQT], s1[NQT];
#pragma unroll
    for (int qt = 0; qt < NQT; ++qt) {
        s0[qt] = __builtin_amdgcn_mfma_f32_16x16x32_bf16(f.k[0][0], qf[qt][0], (f32x4){0.f, 0.f, 0.f, 0.f}, 0, 0, 0);
        s1[qt] = __builtin_amdgcn_mfma_f32_16x16x32_bf16(f.k[1][0], qf[qt][0], (f32x4){0.f, 0.f, 0.f, 0.f}, 0, 0, 0);
    }
#pragma unroll
    for (int qt = 0; qt < NQT; ++qt) {
        s0[qt] = __builtin_amdgcn_mfma_f32_16x16x32_bf16(f.k[0][1], qf[qt][1], s0[qt], 0, 0, 0);
        s1[qt] = __builtin_amdgcn_mfma_f32_16x16x32_bf16(f.k[1][1], qf[qt][1], s1[qt], 0, 0, 0);
    }
    float mx[NQT];
#pragma unroll
    for (int qt = 0; qt < NQT; ++qt) {
#pragma unroll
        for (int j = 0; j < 4; ++j) { s0[qt][j] = mb(qt, j, s0[qt][j]); s1[qt][j] = mb(qt, j + 4, s1[qt][j]); }
        mx[qt] = fmaxf(fmaxf(fmaxf(s0[qt][0], s0[qt][1]), fmaxf(s0[qt][2], s0[qt][3])), fmaxf(fmaxf(s1[qt][0], s1[qt][1]), fmaxf(s1[qt][2], s1[qt][3])));
    }
#pragma unroll
    for (int qt = 0; qt < NQT; ++qt) mx[qt] = rowmax4(mx[qt]);
    bool moved = false;
#pragma unroll
    for (int qt = 0; qt < NQT; ++qt) { mx[qt] = fmaxf(m[qt], mx[qt]); moved |= (mx[qt] != m[qt]); }
    if (__ballot(moved) != 0ull) {
#pragma unroll
        for (int qt = 0; qt < NQT; ++qt) {
            const float alpha = __builtin_amdgcn_exp2f(m[qt] - mx[qt]);
            l[qt] *= alpha;
#pragma unroll
            for (int dt = 0; dt < 4; ++dt) o[qt][dt] *= alpha;
        }
    }
    bf16x8 pf[NQT];
#pragma unroll
    for (int qt = 0; qt < NQT; ++qt) {
        m[qt] = mx[qt];
        float pr[8]; float ps = 0.f;
#pragma unroll
        for (int j = 0; j < 4; ++j) {
            pr[j] = __builtin_amdgcn_exp2f(s0[qt][j] - mx[qt]);
            pr[j + 4] = __builtin_amdgcn_exp2f(s1[qt][j] - mx[qt]);
        }
#pragma unroll
        for (int j = 0; j < 8; ++j) ps += pr[j];
        l[qt] += ps;
        const u32x4 pk = {pack2(pr[0], pr[1]), pack2(pr[2], pr[3]), pack2(pr[4], pr[5]), pack2(pr[6], pr[7])};
        pf[qt] = __builtin_bit_cast(bf16x8, pk);
    }
#pragma unroll
    for (int dt = 0; dt < 4; ++dt)
#pragma unroll
        for (int qt = 0; qt < NQT; ++qt) o[qt][dt] = __builtin_amdgcn_mfma_f32_16x16x32_bf16(f.v[dt], pf[qt], o[qt][dt], 0, 0, 0);
    __builtin_amdgcn_sched_barrier(0);
}
struct RangeIt { int c, c_hi; __device__ __forceinline__ int nxt() { if (c > c_hi) return -1; return (c++) * 32; } };
struct MaskIt { unsigned long long cm; __device__ __forceinline__ int nxt() { if (!cm) return -1; const int i = __builtin_ctzll(cm); cm &= cm - 1; return i * 32; } };
template <bool PFV, bool FM, class It, class Gen>
__device__ __forceinline__ void attn_run(It& it, const bf16_t* Kb, size_t ldk, const bf16_t* VTb, size_t ldv, int fr, int fq, const Gen& gen) {
    KVFrag fa, fb;
    int ka = it.nxt(); if (ka < 0) return;
    k_load<FM>(fa, Kb, ldk, ka, fr, fq); if (PFV) v_load<FM>(fa.v, VTb, ldv, ka, fr, fq);
    for (;;) {
        const int kb = it.nxt(); if (kb >= 0) { k_load<FM>(fb, Kb, ldk, kb, fr, fq); if (PFV) v_load<FM>(fb.v, VTb, ldv, kb, fr, fq); }
        if (!PFV) v_load<FM>(fa.v, VTb, ldv, ka, fr, fq);
        gen(ka, fa);
        if (kb < 0) break;
        ka = it.nxt(); if (ka >= 0) { k_load<FM>(fa, Kb, ldk, ka, fr, fq); if (PFV) v_load<FM>(fa.v, VTb, ldv, ka, fr, fq); }
        if (!PFV) v_load<FM>(fb.v, VTb, ldv, kb, fr, fq);
        gen(kb, fb);
        if (ka < 0) break;
    }
}
template <int NQT>
__device__ __forceinline__ void attn_init(f32x4 (&o)[NQT][4], float (&m)[NQT], float (&l)[NQT]) {
#pragma unroll
    for (int qt = 0; qt < NQT; ++qt) { m[qt] = MINIT; l[qt] = 0.f;
#pragma unroll
        for (int dt = 0; dt < 4; ++dt) o[qt][dt] = (f32x4){0.f, 0.f, 0.f, 0.f}; }
}
__device__ __forceinline__ float lsum4(float l) { return rowsum4(l); }
__device__ __forceinline__ void store_o16(unsigned char* dst, const f32x4 v0, const f32x4 v1, const f32x4 v2, const f32x4 v3) {
    u32x4 w; w.x = pack4_fp8(v0[0], v0[1], v0[2], v0[3]); w.y = pack4_fp8(v1[0], v1[1], v1[2], v1[3]); w.z = pack4_fp8(v2[0], v2[1], v2[2], v2[3]); w.w = pack4_fp8(v3[0], v3[1], v3[2], v3[3]);
    *(u32x4*)dst = w;
}
__device__ __forceinline__ float sigmoidf_fast(float x) { return __builtin_amdgcn_rcpf(1.0f + __builtin_amdgcn_exp2f(-L2E * x)); }

__device__ __forceinline__ void fox_unit(const Params& p, int b, int h, int qb, int fr, int fq) {
    asm volatile("" : "+v"(fr), "+v"(fq));
    const int t0 = qb * 64;
    const bf16_t* Qb = p.hb + ((size_t)b * SEQ + t0) * NMAIN + C_FQ + h * 64 + fq * 8;
    bf16x8 qf[4][2];
#pragma unroll
    for (int qt = 0; qt < 4; ++qt) { qf[qt][0] = *(const bf16x8*)(Qb + (size_t)(qt * 16 + fr) * NMAIN); qf[qt][1] = *(const bf16x8*)(Qb + (size_t)(qt * 16 + fr) * NMAIN + 32); }
    const float* cf = p.cF + ((size_t)b * 4 + h) * SEQ;
    float cq[4];
#pragma unroll
    for (int qt = 0; qt < 4; ++qt) cq[qt] = cf[t0 + qt * 16 + fr] * L2E;
    f32x4 o[4][4]; float m[4], l[4];
    attn_init<4>(o, m, l);
    const bf16_t* Kb = p.kF + ((size_t)b * NVH + h) * 64 * SEQ;
    const bf16_t* VTb = p.vT + ((size_t)b * NVH + h) * 64 * SEQ;
    RangeIt it{0, (t0 >> 5) + 1};
    attn_run<false, true>(it, Kb, NMAIN, VTb, SEQ, fr, fq, [&](int kc0, const KVFrag& f) {
        const float4 ca = *(const float4*)(cf + kc0 + 8 * fq), cb = *(const float4*)(cf + kc0 + 8 * fq + 4);
        const float ck[8] = {ca.x * L2E, ca.y * L2E, ca.z * L2E, ca.w * L2E, cb.x * L2E, cb.y * L2E, cb.z * L2E, cb.w * L2E};
        const int kq = kc0 + 8 * fq - t0 - fr;
        attn_compute<4, true>(f, qf, o, m, l, [&](int qt, int j, float raw) { return (kq + j - 16 * qt) > 0 ? MASKV : raw * SCL2 + cq[qt] - ck[j]; });
    });
#pragma unroll
    for (int qt = 0; qt < 4; ++qt) {
        const float inv = __builtin_amdgcn_rcpf(lsum4(l[qt]));
        unsigned char* dst = (unsigned char*)p.ob + ((size_t)b * SEQ + t0 + qt * 16 + fr) * DM + h * 64 + 16 * fq;
        store_o16(dst, o[qt][0] * inv, o[qt][1] * inv, o[qt][2] * inv, o[qt][3] * inv);
    }
}
__device__ __forceinline__ void swa_unit(const Params& p, int l_, int b, int kv, int pos, int fr, int fq) {
    asm volatile("" : "+v"(fr), "+v"(fq));
    const int t0 = pos * 16, t = t0 + fr;
    const bf16_t* Qb = p.hb + ((size_t)b * SEQ + t) * NMAIN + C_SQ + kv * 192 + fq * 8;
    bf16x8 qf[3][2];
#pragma unroll
    for (int g = 0; g < 3; ++g) { qf[g][0] = *(const bf16x8*)(Qb + g * 64); qf[g][1] = *(const bf16x8*)(Qb + g * 64 + 32); }
    float sl[3];
#pragma unroll
    for (int g = 0; g < 3; ++g) sl[g] = slope_swa(kv * 3 + g) * L2E;
    f32x4 o[3][4]; float m[3], l[3];
    attn_init<3>(o, m, l);
    const bf16_t* Kb = p.kF + ((size_t)b * NVH + 4 + kv) * 64 * SEQ;
    const bf16_t* VTb = p.vT + ((size_t)b * NVH + 4 + kv) * 64 * SEQ;
    RangeIt it{max(0, t0 - 127) >> 5, (t0 + 15) >> 5};
    attn_run<true, true>(it, Kb, NMAIN, VTb, SEQ, fr, fq, [&](int kc0, const KVFrag& f) {
        const int dq = t - kc0 - 8 * fq;
        attn_compute<3, true>(f, qf, o, m, l, [&](int g, int j, float raw) { const int dist = dq - j; return ((unsigned)dist < 128u) ? raw * SCL2 - sl[g] * (float)dist : MASKV; });
    });
#pragma unroll
    for (int g = 0; g < 3; ++g) {
        const float sink = p.sinks[l_ * 6 + kv * 3 + g] * L2E;
        const float inv = __builtin_amdgcn_rcpf(lsum4(l[g]) + __builtin_amdgcn_exp2f(sink - m[g]));
        unsigned char* dst = (unsigned char*)p.ob + ((size_t)b * SEQ + t) * DM + 256 + (kv * 3 + g) * 64 + 16 * fq;
        store_o16(dst, o[g][0] * inv, o[g][1] * inv, o[g][2] * inv, o[g][3] * inv);
    }
}
__device__ __forceinline__ void nsa_unit(const Params& p, int b, int kv, int pos, int fr, int fq, int lane, float* ps, unsigned* msk, float* otl) {
    asm volatile("" : "+v"(fr), "+v"(fq), "+v"(lane));
    const int t0 = pos * 16, t = t0 + fr, cur = t0 >> 6;
    const bf16_t* Qb = p.hb + ((size_t)b * SEQ + t) * NMAIN + C_NQ + kv * 192 + fq * 8;
    bf16x8 qf[3][2];
#pragma unroll
    for (int g = 0; g < 3; ++g) { qf[g][0] = *(const bf16x8*)(Qb + g * 64); qf[g][1] = *(const bf16x8*)(Qb + g * 64 + 32); }
    float sl[3];
#pragma unroll
    for (int g = 0; g < 3; ++g) sl[g] = slope_nsa(kv * 3 + g) * L2E;
    const float* gl = p.hs + ((size_t)b * SEQ + t) * HS_W + 4 + kv * 9;
    f32x4 o[3][4]; float m[3], l[3];
    f32x4* otv = (f32x4*)otl + lane;
#pragma unroll
    for (int i = 0; i < 8; ++i) ps[lane + 64 * i] = 0.f;
    {
        const bf16_t* Kb = p.kc + ((size_t)b * 2 + kv) * 128 * 64;
        const bf16_t* VTb = p.vcT + ((size_t)b * 2 + kv) * 64 * 128;
        const int ncv = (t0 + 15 >= 31) ? ((t0 + 15 - 31) >> 4) + 1 : 0;
        const int nch = (ncv + 31) >> 5;
        attn_init<3>(o, m, l);
        const int dq0 = t - 31 - 16 * 8 * fq;
        RangeIt it{0, nch - 1};
        attn_run<false, false>(it, Kb, 64, VTb, 128, fr, fq, [&](int kc0, const KVFrag& f) {
            const int dq = dq0 - 16 * kc0;
            attn_compute<3, true>(f, qf, o, m, l, [&](int g, int j, float raw) { const int dist = dq - 16 * j; return dist >= 0 ? raw * SCL2 - sl[g] * (float)dist : MASKV; });
        });
        float il[3];
#pragma unroll
        for (int g = 0; g < 3; ++g) {
            const float lt = lsum4(l[g]); il[g] = lt > 0.f ? __builtin_amdgcn_rcpf(lt) : 0.f;
            const float gate = sigmoidf_fast(gl[g * 3 + 0]);
#pragma unroll
            for (int dt = 0; dt < 4; ++dt) otv[(g * 4 + dt) * 64] = o[g][dt] * (il[g] * gate);
        }
        float carry_prev = 0.f;
        for (int c = 0; c < nch; ++c) {
            const int kc0 = c * 32, dq = dq0 - 16 * kc0;
            const bf16_t* kp = Kb + (size_t)(kc0 + (fr >> 2) * 8 + (fr & 3)) * 64 + fq * 8;
            const bf16x8 k00 = *(const bf16x8*)(kp), k01 = *(const bf16x8*)(kp + 32), k10 = *(const bf16x8*)(kp + 256), k11 = *(const bf16x8*)(kp + 256 + 32);
            float pc[8];
#pragma unroll
            for (int j = 0; j < 8; ++j) pc[j] = 0.f;
#pragma unroll
            for (int g = 0; g < 3; ++g) {
                f32x4 s0 = (f32x4){0.f, 0.f, 0.f, 0.f}, s1 = s0;
                s0 = __builtin_amdgcn_mfma_f32_16x16x32_bf16(k00, qf[g][0], s0, 0, 0, 0); s0 = __builtin_amdgcn_mfma_f32_16x16x32_bf16(k01, qf[g][1], s0, 0, 0, 0);
                s1 = __builtin_amdgcn_mfma_f32_16x16x32_bf16(k10, qf[g][0], s1, 0, 0, 0); s1 = __builtin_amdgcn_mfma_f32_16x16x32_bf16(k11, qf[g][1], s1, 0, 0, 0);
#pragma unroll
                for (int j = 0; j < 8; ++j) {
                    const int dist = dq - 16 * j; const float raw = j < 4 ? s0[j] : s1[j - 4];
                    if (dist >= 0) pc[j] += __builtin_amdgcn_exp2f(raw * SCL2 - sl[g] * (float)dist - m[g]) * il[g];
                }
            }
            const float cout = 0.5f * pc[7];
            float cin = shfl_f(cout, lane - 16);
            const float cwrap = shfl_f(cout, fr + 48);
            if (fq == 0) cin = carry_prev;
            carry_prev = cwrap;
            const int n0 = (kc0 >> 2) + 2 * fq;
            ps[fr * 32 + n0] = cin + pc[0] + pc[1] + pc[2] + 0.5f * pc[3];
            ps[fr * 32 + n0 + 1] = 0.5f * pc[3] + pc[4] + pc[5] + pc[6] + 0.5f * pc[7];
        }
    }
    lds_wave_sync();
    if (lane < 16) {
        unsigned mask = 1u | (1u << cur); if (cur >= 1) mask |= 1u << (cur - 1);
        if (cur >= 3) {
            if (cur - 2 <= 5) mask |= (1u << (cur - 1)) - 2u;
            else {
                const float* my = ps + lane * 32;
                for (int r = 0; r < 5; ++r) {
                    float best = -1.0f; int bi = 1;
                    for (int j = 1; j <= cur - 2; ++j) { const float v = my[j]; if (!((mask >> j) & 1u) && v > best) { best = v; bi = j; } }
                    mask |= 1u << bi;
                }
            }
        }
        msk[lane] = mask;
    }
    lds_wave_sync();
    const unsigned qmask = msk[fr];
    lds_wave_sync();
    {
        const bf16_t* Kb = p.kF + ((size_t)b * NVH + 6 + kv) * 64 * SEQ;
        const bf16_t* VTb = p.vT + ((size_t)b * NVH + 6 + kv) * 64 * SEQ;
        attn_init<3>(o, m, l);
        unsigned um = qmask;
        um |= shfl_u(um, lane ^ 1); um |= shfl_u(um, lane ^ 2); um |= shfl_u(um, lane ^ 4); um |= shfl_u(um, lane ^ 8);
        um = (unsigned)__builtin_amdgcn_readfirstlane((int)um) & (cur >= 31 ? 0xffffffffu : ((2u << cur) - 1u));
        unsigned long long cm = 0ull;
        for (unsigned r = um; r; r &= r - 1) { const int kb = __builtin_ctz(r); cm |= 3ull << (2 * kb); }
        MaskIt it{cm};
        attn_run<true, true>(it, Kb, NMAIN, VTb, SEQ, fr, fq, [&](int kc0, const KVFrag& f) {
            const bool mine = (qmask >> (kc0 >> 6)) & 1u;
            const int dq = t - kc0 - 8 * fq;
            attn_compute<3, true>(f, qf, o, m, l, [&](int g, int j, float raw) { const int dist = dq - j; return (mine && dist >= 0) ? raw * SCL2 - sl[g] * (float)dist : MASKV; });
        });
#pragma unroll
        for (int g = 0; g < 3; ++g) {
            const float lt = lsum4(l[g]); const float sc = (lt > 0.f ? __builtin_amdgcn_rcpf(lt) : 0.f) * sigmoidf_fast(gl[g * 3 + 1]);
#pragma unroll
            for (int dt = 0; dt < 4; ++dt) otv[(g * 4 + dt) * 64] += o[g][dt] * sc;
        }
    }
    {
        const bf16_t* Kb = p.kF + ((size_t)b * NVH + 8 + kv) * 64 * SEQ;
        const bf16_t* VTb = p.vT + ((size_t)b * NVH + 8 + kv) * 64 * SEQ;
        attn_init<3>(o, m, l);
        RangeIt it{max(0, t0 - 511) >> 5, (t0 + 15) >> 5};
        attn_run<true, true>(it, Kb, NMAIN, VTb, SEQ, fr, fq, [&](int kc0, const KVFrag& f) {
            const int dq = t - kc0 - 8 * fq;
            attn_compute<3, true>(f, qf, o, m, l, [&](int g, int j, float raw) { const int dist = dq - j; return ((unsigned)dist < 512u) ? raw * SCL2 - sl[g] * (float)dist : MASKV; });
        });
#pragma unroll
        for (int g = 0; g < 3; ++g) {
            const float lt = lsum4(l[g]); const float sc = (lt > 0.f ? __builtin_amdgcn_rcpf(lt) : 0.f) * sigmoidf_fast(gl[g * 3 + 2]);
            unsigned char* dst = (unsigned char*)p.ob + ((size_t)b * SEQ + t) * DM + 640 + (kv * 3 + g) * 64 + 16 * fq;
            store_o16(dst, otv[(g * 4 + 0) * 64] + o[g][0] * sc, otv[(g * 4 + 1) * 64] + o[g][1] * sc, otv[(g * 4 + 2) * 64] + o[g][2] * sc, otv[(g * 4 + 3) * 64] + o[g][3] * sc);
        }
    }
}

template <bool WITH_CONV>
__device__ __forceinline__ void phase_attn(const Params& p, int l, char* lds, int cslot = 16) {
    int tid = threadIdx.x; asm volatile("" : "+v"(tid));
    const int wid = tid >> 6, lane = tid & 63, fr = lane & 15, fq = lane >> 4;
    float* ps = (float*)(lds + wid * 16896); unsigned* msk = (unsigned*)(ps + 512); float* otl = ps + 576;
    unsigned* ctr = p.ctrl + cslot + l;
    constexpr unsigned NU_NSA = NB * 2 * 128, NU_FOX = NB * 4 * 32, NU_SWA = NB * 2 * 128, NU_ATT = NU_NSA + NU_FOX + NU_SWA;
    for (;;) {
        unsigned u = 0;
        if (lane == 0) u = __hip_atomic_fetch_add(ctr, 1u, __ATOMIC_RELAXED, __HIP_MEMORY_SCOPE_AGENT);
        u = (unsigned)__builtin_amdgcn_readfirstlane((int)u);
        if (WITH_CONV) {
            constexpr unsigned TOTQ = NU_ATT + (unsigned)CONV_TILES;
            if (u >= TOTQ) break;
            const unsigned a0 = (unsigned)(((unsigned long long)u * NU_ATT) / TOTQ), a1 = (unsigned)(((unsigned long long)(u + 1) * NU_ATT) / TOTQ);
            if (a1 == a0) { conv_tile_wave(p, (int)(u - a0), lane, (unsigned char*)ps); continue; }
            u = a0;
        } else {
#ifndef ATT_REP
#define ATT_REP 1
#endif
            if (u >= ATT_REP * NU_ATT) break;
            if (ATT_REP > 1) u %= NU_ATT;
        }
        if (u < NU_NSA) { const int pos = 127 - (int)(u & 127), r = u >> 7; nsa_unit(p, r >> 1, r & 1, pos, fr, fq, lane, ps, msk, otl); }
        else if (u < NU_NSA + NU_FOX) { const unsigned v = u - NU_NSA; const int qb = 31 - (int)(v & 31), r = v >> 5; fox_unit(p, r >> 2, r & 3, qb, fr, fq); }
        else { const unsigned v = u - NU_NSA - NU_FOX; const int pos = 127 - (int)(v & 127), r = v >> 7; swa_unit(p, l, r >> 1, r & 1, pos, fr, fq); }
    }
}

__device__ __forceinline__ void phase_ln1_router(const Params& p, int l, char* lds) {
    int tid = threadIdx.x; asm volatile("" : "+v"(tid));
    const int wid = tid >> 6, lane = tid & 63, fr = lane & 15, fq = lane >> 4;
    float* lg = (float*)lds + wid * 512;
    int* lcnt = (int*)(lds + 16384); int* lbase = lcnt + 32;
    const float* g1 = p.ln1_g + l * DM; const float* b1 = p.ln1_b + l * DM;
    const float* rw = p.rwT + (size_t)l * NE * 1024; const float* rb = p.router_b + l * NE;
    unsigned* gcount = p.ctrl + 64 + l * NE;
    constexpr int RW_LDS = 20480, RW_PITCH = 2064;
    if (blockIdx.x < NTOK / 128) {
        const bf16_t* rwb = (const bf16_t*)p.rwT + (size_t)l * 64 * 1024;
#pragma unroll 4
        for (int i = 0; i < 16; ++i) { const int pc = wid * 16 + i, r = pc >> 1, q = pc & 1;
            __builtin_amdgcn_global_load_lds((const unsigned*)(rwb + (size_t)r * 1024 + q * 512 + lane * 8), (LAS unsigned*)((LAS char*)lds + RW_LDS + r * RW_PITCH + q * 1024), 16, 0, 0); }
    }
    for (int grp = blockIdx.x; grp < NTOK / 128; grp += gridDim.x) {
        const int tok0 = grp * 128 + wid * 16;
        if (tid < 32) lcnt[tid] = 0;
        float gg[16], bb[16];
#pragma unroll
        for (int j = 0; j < 4; ++j) { const float4 g4 = *(const float4*)(g1 + lane * 16 + j * 4), b4 = *(const float4*)(b1 + lane * 16 + j * 4);
            gg[4 * j] = g4.x; gg[4 * j + 1] = g4.y; gg[4 * j + 2] = g4.z; gg[4 * j + 3] = g4.w; bb[4 * j] = b4.x; bb[4 * j + 1] = b4.y; bb[4 * j + 2] = b4.z; bb[4 * j + 3] = b4.w; }
        u32x4 raw[8][2];
#pragma unroll
        for (int i = 0; i < 8; ++i) { const bf16_t* tr = (const bf16_t*)p.tbuf + (size_t)(tok0 + i) * DM + lane * 16; raw[i][0] = *(const u32x4*)tr; raw[i][1] = *(const u32x4*)(tr + 8); }
#pragma unroll
        for (int r0 = 0; r0 < 16; r0 += 4) {
            float v[4][16]; float s[4], qv[4];
#pragma unroll
            for (int i = 0; i < 4; ++i) {
                const u32x4 t0 = raw[(r0 + i) % 8][0], t1 = raw[(r0 + i) % 8][1];
                if (r0 < 8) { const bf16_t* tr = (const bf16_t*)p.tbuf + (size_t)(tok0 + r0 + 8 + i) * DM + lane * 16; raw[(r0 + i) % 8][0] = *(const u32x4*)tr; raw[(r0 + i) % 8][1] = *(const u32x4*)(tr + 8); }
                const unsigned ts[8] = {t0.x, t0.y, t0.z, t0.w, t1.x, t1.y, t1.z, t1.w};
#pragma unroll
                for (int c = 0; c < 8; ++c) { v[i][2 * c] = __uint_as_float(ts[c] << 16); v[i][2 * c + 1] = __uint_as_float(ts[c] & 0xffff0000u); }
            }
#pragma unroll
            for (int i = 0; i < 4; ++i) { s[i] = 0.f;
#pragma unroll
                for (int c = 0; c < 16; c += 4) s[i] += (v[i][c] + v[i][c + 1]) + (v[i][c + 2] + v[i][c + 3]); }
#pragma unroll
            for (int o = 32; o > 0; o >>= 1) {
#pragma unroll
                for (int i = 0; i < 4; ++i) s[i] += shfl_f(s[i], lane ^ o); }
#pragma unroll
            for (int i = 0; i < 4; ++i) { const float mean = s[i] * (1.0f / 1024.0f); qv[i] = 0.f;
#pragma unroll
                for (int c = 0; c < 16; c += 4) { v[i][c] -= mean; v[i][c + 1] -= mean; v[i][c + 2] -= mean; v[i][c + 3] -= mean;
                    qv[i] += (v[i][c] * v[i][c] + v[i][c + 1] * v[i][c + 1]) + (v[i][c + 2] * v[i][c + 2] + v[i][c + 3] * v[i][c + 3]); } }
#pragma unroll
            for (int o = 32; o > 0; o >>= 1) {
#pragma unroll
                for (int i = 0; i < 4; ++i) qv[i] += shfl_f(qv[i], lane ^ o); }
#pragma unroll
            for (int i = 0; i < 4; ++i) {
                const float rstd = rsqrtf(qv[i] * (1.0f / 1024.0f) + LN_EPS);
                const size_t row = (size_t)(tok0 + r0 + i);
                float y[16];
#pragma unroll
                for (int c = 0; c < 16; ++c) y[c] = v[i][c] * rstd * gg[c] + bb[c];
                u32x4 w0, w1, q;
                w0.x = pack2(y[0], y[1]); w0.y = pack2(y[2], y[3]); w0.z = pack2(y[4], y[5]); w0.w = pack2(y[6], y[7]);
                w1.x = pack2(y[8], y[9]); w1.y = pack2(y[10], y[11]); w1.z = pack2(y[12], y[13]); w1.w = pack2(y[14], y[15]);
                q.x = pack4_fp8(y[0], y[1], y[2], y[3]); q.y = pack4_fp8(y[4], y[5], y[6], y[7]); q.z = pack4_fp8(y[8], y[9], y[10], y[11]); q.w = pack4_fp8(y[12], y[13], y[14], y[15]);
                *(u32x4*)((bf16_t*)p.x1f + row * DM + lane * 16) = w0; *(u32x4*)((bf16_t*)p.x1f + row * DM + lane * 16 + 8) = w1;
                *(u32x4*)((char*)p.x1b + row * DM + lane * 16) = q;
            }
        }
        asm volatile("s_waitcnt vmcnt(0)" ::: "memory");
        __syncthreads();
        f32x4 a0 = (f32x4){0.f, 0.f, 0.f, 0.f}, a1 = a0;
        const bf16_t* xr = (const bf16_t*)p.x1f + (size_t)(tok0 + fr) * DM + 8 * fq;
        const LAS char* wl = (const LAS char*)lds + RW_LDS + fr * RW_PITCH + fq * 16;
#pragma unroll 8
        for (int ks = 0; ks < 32; ++ks) {
            const bf16x8 xa = *(const bf16x8*)(xr + ks * 32);
            a0 = __builtin_amdgcn_mfma_f32_16x16x32_bf16(xa, *(const LAS bf16x8*)(wl + ks * 64), a0, 0, 0, 0);
            a1 = __builtin_amdgcn_mfma_f32_16x16x32_bf16(xa, *(const LAS bf16x8*)(wl + 16 * RW_PITCH + ks * 64), a1, 0, 0, 0);
            a0 = __builtin_amdgcn_mfma_f32_16x16x32_bf16(xa, *(const LAS bf16x8*)(wl + 32 * RW_PITCH + ks * 64), a0, 0, 0, 0);
            a1 = __builtin_amdgcn_mfma_f32_16x16x32_bf16(xa, *(const LAS bf16x8*)(wl + 48 * RW_PITCH + ks * 64), a1, 0, 0, 0);
        }
#pragma unroll
        for (int r = 0; r < 4; ++r) { lg[(fq * 4 + r) * 32 + fr] = a0[r] + rb[fr]; lg[(fq * 4 + r) * 32 + 16 + fr] = a1[r] + rb[16 + fr]; }
        lds_wave_sync();
        int e4[4] = {0, 0, 0, 0}; int rk[4] = {0, 0, 0, 0};
        if (lane < 16) {
            const float* my = lg + lane * 32; unsigned taken = 0u; float tv[4];
#pragma unroll
            for (int k = 0; k < 4; ++k) {
                float best = NEG_INF; int bi = 0;
                for (int e = 0; e < 32; ++e) { const float xv = my[e]; if (!((taken >> e) & 1u) && xv > best) { best = xv; bi = e; } }
                taken |= 1u << bi; e4[k] = bi; tv[k] = best;
            }
            const float e1 = __expf(tv[1] - tv[0]), e2 = __expf(tv[2] - tv[0]), e3 = __expf(tv[3] - tv[0]);
            const float inv = 1.0f / (1.0f + e1 + e2 + e3);
            const size_t row = (size_t)(tok0 + lane);
            *(float4*)(p.gw + row * 4) = make_float4(inv, e1 * inv, e2 * inv, e3 * inv);
        }
        __syncthreads();
        if (lane < 16) {
#pragma unroll
            for (int k = 0; k < 4; ++k) rk[k] = atomicAdd(&lcnt[e4[k]], 1);
        }
        __syncthreads();
        if (tid < 32) { const int c = lcnt[tid]; lbase[tid] = c ? (int)__hip_atomic_fetch_add(gcount + tid, (unsigned)c, __ATOMIC_RELAXED, __HIP_MEMORY_SCOPE_AGENT) : 0; }
        __syncthreads();
        if (lane < 16) {
            const int row = tok0 + lane; int pk[4];
#pragma unroll
            for (int k = 0; k < 4; ++k) { const int pos = lbase[e4[k]] + rk[k]; p.lists[(size_t)e4[k] * LIST_CAP + pos] = row * 4 + k; pk[k] = (pos << 5) | e4[k]; }
            *(int4*)(p.top_e + (size_t)row * 4) = make_int4(pk[0], pk[1], pk[2], pk[3]);
        }
        __syncthreads();
    }
}

__device__ __forceinline__ void phase_ln2(const Params& p, int l, float* xout, char* lds) {
    int* ptile = (int*)(lds + LDS_TAB); int* ecnt = ptile + 40;
    build_tiles(p, l, ptile, ecnt);
    int tid = threadIdx.x; asm volatile("" : "+v"(tid));
    const int wid = tid >> 6, lane = tid & 63;
    const float* g2 = p.ln2_g + l * DM; const float* b2 = p.ln2_b + l * DM;
    float gg[16], bb[16];
#pragma unroll
    for (int j = 0; j < 4; ++j) { const float4 g4 = *(const float4*)(g2 + lane * 16 + j * 4), b4 = *(const float4*)(b2 + lane * 16 + j * 4);
        gg[4 * j] = g4.x; gg[4 * j + 1] = g4.y; gg[4 * j + 2] = g4.z; gg[4 * j + 3] = g4.w; bb[4 * j] = b4.x; bb[4 * j + 1] = b4.y; bb[4 * j + 2] = b4.z; bb[4 * j + 3] = b4.w; }
    for (int pr = blockIdx.x * NWV + wid; pr < NTOK / 2; pr += gridDim.x * NWV) {
        float v[2][16]; float s[2], qv[2];
        u32x4 yv[2][4], xv[2][2]; float gk[2][4];
#pragma unroll
        for (int i = 0; i < 2; ++i) {
            const int row = pr * 2 + i;
            const float4 gwv = *(const float4*)(p.gw + (size_t)row * 4);
            gk[i][0] = gwv.x; gk[i][1] = gwv.y; gk[i][2] = gwv.z; gk[i][3] = gwv.w;
            const int4 te = *(const int4*)(p.top_e + (size_t)row * 4);
            const int tk[4] = {te.x, te.y, te.z, te.w};
            xv[i][0] = *(const u32x4*)((const bf16_t*)p.x1f + (size_t)row * DM + lane * 16); xv[i][1] = *(const u32x4*)((const bf16_t*)p.x1f + (size_t)row * DM + lane * 16 + 8);
#pragma unroll
            for (int k = 0; k < 4; ++k) yv[i][k] = *(const u32x4*)((const unsigned char*)p.ybuf + (size_t)(ptile[tk[k] & 31] * 256 + (tk[k] >> 5)) * DM + lane * 16);
        }
#pragma unroll
        for (int i = 0; i < 2; ++i) { s[i] = 0.f;
            const unsigned xs[8] = {xv[i][0].x, xv[i][0].y, xv[i][0].z, xv[i][0].w, xv[i][1].x, xv[i][1].y, xv[i][1].z, xv[i][1].w};
#pragma unroll
            for (int c = 0; c < 8; ++c) { v[i][2 * c] = __uint_as_float(xs[c] << 16) * ALPHA; v[i][2 * c + 1] = __uint_as_float(xs[c] & 0xffff0000u) * ALPHA; }
#pragma unroll
            for (int k = 0; k < 4; ++k) {
                const unsigned ys[4] = {yv[i][k].x, yv[i][k].y, yv[i][k].z, yv[i][k].w};
#pragma unroll
                for (int c = 0; c < 4; ++c) {
                    const f32x2_t lo = __builtin_amdgcn_cvt_pk_f32_fp8(ys[c], false), hi = __builtin_amdgcn_cvt_pk_f32_fp8(ys[c], true);
                    v[i][4 * c] += gk[i][k] * lo.x; v[i][4 * c + 1] += gk[i][k] * lo.y; v[i][4 * c + 2] += gk[i][k] * hi.x; v[i][4 * c + 3] += gk[i][k] * hi.y;
                }
            }
#pragma unroll
            for (int c = 0; c < 16; c += 4) s[i] += (v[i][c] + v[i][c + 1]) + (v[i][c + 2] + v[i][c + 3]);
        }
#pragma unroll
        for (int o = 32; o > 0; o >>= 1) { s[0] += shfl_f(s[0], lane ^ o); s[1] += shfl_f(s[1], lane ^ o); }
#pragma unroll
        for (int i = 0; i < 2; ++i) { const float mean = s[i] * (1.0f / 1024.0f); qv[i] = 0.f;
#pragma unroll
            for (int c = 0; c < 16; c += 4) { v[i][c] -= mean; v[i][c + 1] -= mean; v[i][c + 2] -= mean; v[i][c + 3] -= mean;
                qv[i] += (v[i][c] * v[i][c] + v[i][c + 1] * v[i][c + 1]) + (v[i][c + 2] * v[i][c + 2] + v[i][c + 3] * v[i][c + 3]); } }
#pragma unroll
        for (int o = 32; o > 0; o >>= 1) { qv[0] += shfl_f(qv[0], lane ^ o); qv[1] += shfl_f(qv[1], lane ^ o); }
#pragma unroll
        for (int i = 0; i < 2; ++i) {
            const float rstd = rsqrtf(qv[i] * (1.0f / 1024.0f) + LN_EPS);
            const size_t row = (size_t)(pr * 2 + i);
            float y[16];
#pragma unroll
            for (int c = 0; c < 16; ++c) y[c] = v[i][c] * rstd * gg[c] + bb[c];
            if (l + 1 < NL) {
                u32x4 w0, w1, q;
                w0.x = pack2(y[0], y[1]); w0.y = pack2(y[2], y[3]); w0.z = pack2(y[4], y[5]); w0.w = pack2(y[6], y[7]);
                w1.x = pack2(y[8], y[9]); w1.y = pack2(y[10], y[11]); w1.z = pack2(y[12], y[13]); w1.w = pack2(y[14], y[15]);
                q.x = pack4_fp8(y[0], y[1], y[2], y[3]); q.y = pack4_fp8(y[4], y[5], y[6], y[7]); q.z = pack4_fp8(y[8], y[9], y[10], y[11]); q.w = pack4_fp8(y[12], y[13], y[14], y[15]);
                *(u32x4*)(p.xb + row * DM + lane * 16) = w0; *(u32x4*)(p.xb + row * DM + lane * 16 + 8) = w1;
                *(u32x4*)(p.xq + row * DM + lane * 16) = q;
            } else {
#pragma unroll
                for (int c = 0; c < 16; c += 4) *(float4*)(xout + row * DM + lane * 16 + c) = make_float4(y[c], y[c + 1], y[c + 2], y[c + 3]);
            }
        }
    }
}

#define XB_TMO      128
#define XB_XCNT(j)  (256  + 64 * (j))
#define XB_XSUB(j)  (1280 + 64 * (j))
#define XB_XGEN(j)  (2304 + 64 * (j))
#define XB_TOP      3328
#define XB_TOPGEN   3392
#define XCD_BAR_WORDS 3456
#define XB_SPIN_CAP (1u << 22)
__device__ __forceinline__ unsigned xb_ld(unsigned* p)              { return __hip_atomic_load(p, __ATOMIC_RELAXED, __HIP_MEMORY_SCOPE_AGENT); }
__device__ __forceinline__ unsigned xb_add(unsigned* p, unsigned v) { return __hip_atomic_fetch_add(p, v, __ATOMIC_RELAXED, __HIP_MEMORY_SCOPE_AGENT); }
__device__ __forceinline__ unsigned xb_xcc_id() { return (unsigned)__builtin_amdgcn_s_getreg((3 << 11) | 20) & 0xFu; }
#define XB_SPIN(cond, bar) do { unsigned _sp = 0; while (cond) { __builtin_amdgcn_s_sleep(1); \
    if ((++_sp & 255u) == 0u) { if (xb_ld(&(bar)[XB_TMO])) break; if (_sp > XB_SPIN_CAP) { atomicAdd(&(bar)[XB_TMO], 1u); break; } } } } while (0)
struct XcdBarrier { unsigned* bar; unsigned x; volatile LAS unsigned* st; };
__device__ __forceinline__ XcdBarrier xcd_barrier_post(unsigned* bar, volatile LAS unsigned* st) {
    XcdBarrier b; b.bar = bar; b.x = xb_xcc_id(); b.st = st;
    if (threadIdx.x == 0) (void)xb_add(&bar[XB_XCNT(b.x)], 1u);
    return b;
}
__device__ __forceinline__ void xcd_barrier_complete(unsigned* bar, unsigned x, unsigned& nloc, unsigned& nx) {
    const unsigned G = gridDim.x * gridDim.y * gridDim.z;
    unsigned sum, cnt, mine, sp = 0u;
    for (;;) {
        sum = 0u; cnt = 0u; mine = 0u;
#pragma unroll
        for (unsigned j = 0; j < 16; ++j) { const unsigned c = xb_ld(&bar[XB_XCNT(j)]); sum += c; cnt += (c > 0u) ? 1u : 0u; mine = (j == x) ? c : mine; }
        if (sum == G) break;
        __builtin_amdgcn_s_sleep(1);
        if ((++sp & 255u) == 0u) { if (xb_ld(&bar[XB_TMO])) break; if (sp > XB_SPIN_CAP) { atomicAdd(&bar[XB_TMO], 1u); break; } }
    }
    nloc = mine > 0u ? mine : 1u; nx = cnt > 0u ? cnt : 1u;
}
__device__ __forceinline__ void xcd_barrier(const XcdBarrier& b) {
    asm volatile("s_waitcnt vmcnt(0)" ::: "memory");
    __syncthreads();
    if (threadIdx.x == 0) {
        unsigned* bar = b.bar;
        __builtin_amdgcn_s_waitcnt(0);
        unsigned nloc = b.st[0], nx = b.st[1];
        if (nloc == 0u) { xcd_barrier_complete(bar, b.x, nloc, nx); b.st[0] = nloc; b.st[1] = nx; }
        const unsigned old = xb_add(&bar[XB_XSUB(b.x)], 1u);
        const unsigned gen = old / nloc;
        if (old + 1u == (gen + 1u) * nloc) {
            __builtin_amdgcn_fence(__ATOMIC_RELEASE, "agent");
            asm volatile("s_waitcnt vmcnt(0)" ::: "memory");
            const unsigned og = xb_add(&bar[XB_TOP], 1u);
            const unsigned tg = og / nx;
            if (og + 1u == (tg + 1u) * nx) xb_add(&bar[XB_TOPGEN], 1u);
            else XB_SPIN(xb_ld(&bar[XB_TOPGEN]) == tg, bar);
            __builtin_amdgcn_fence(__ATOMIC_ACQUIRE, "agent");
            xb_add(&bar[XB_XGEN(b.x)], 1u);
            asm volatile("s_waitcnt vmcnt(0)" ::: "memory");
        } else {
            XB_SPIN(xb_ld(&bar[XB_XGEN(b.x)]) == gen, bar);
            __builtin_amdgcn_fence(__ATOMIC_ACQUIRE, "agent");
            asm volatile("s_waitcnt vmcnt(0)" ::: "memory");
        }
    }
    __syncthreads();
}

struct KArgs { const float* in[18]; float* out; char* ws; };
constexpr size_t al256(size_t v) { return (v + 255) / 256 * 256; }
struct WSL {
    static constexpr size_t ctrl = 0;
    static constexpr size_t WinT = al256(ctrl + 65536);
    static constexpr size_t WoT = al256(WinT + (size_t)NL * NPAD * 1024 * 2);
    static constexpr size_t W1T = al256(WoT + (size_t)NL * 1024 * 1024 * 2);
    static constexpr size_t W2T = al256(W1T + (size_t)NL * 2 * 64 * 2048 * 2);
    static constexpr size_t WguT = al256(W2T + (size_t)NL * 2 * 64 * 64 * 2);
    static constexpr size_t WdnT = al256(WguT + (size_t)NL * NE * 2048 * 1024 * 2);
    static constexpr size_t rwT = al256(WdnT + (size_t)NL * NE * 1024 * 1024 * 2);
    static constexpr size_t binp = al256(rwT + (size_t)NL * NE * 1024 * 4);
    static constexpr size_t bgup = al256(binp + (size_t)NL * NPAD * 4);
    static constexpr size_t b1c = al256(bgup + (size_t)NL * NE * 2048 * 4);
    static constexpr size_t xf = al256(b1c + 4 * 8 * 64 * 4);
    static constexpr size_t xb = al256(xf + (size_t)NTOK * DM * 4);
    static constexpr size_t hb = al256(xb + (size_t)NTOK * DM * 2);
    static constexpr size_t hs = al256(hb + (size_t)NTOK * NMAIN * 2);
    static constexpr size_t vT = al256(hs + (size_t)NTOK * HS_W * 4);
    static constexpr size_t kF = al256(vT + (size_t)NB * NVH * 64 * SEQ * 2);
    static constexpr size_t cF = al256(kF + (size_t)NB * NVH * 64 * SEQ * 2);
    static constexpr size_t kc = al256(cF + (size_t)NB * 4 * SEQ * 4);
    static constexpr size_t vc = al256(kc + (size_t)NB * 2 * 128 * 64 * 2);
    static constexpr size_t vcT = al256(vc + (size_t)NB * 2 * 128 * 64 * 2);
    static constexpr size_t ob = al256(vcT + (size_t)NB * 2 * 128 * 64 * 2);
    static constexpr size_t tbuf = al256(ob + (size_t)NTOK * DM * 2);
    static constexpr size_t x1f = al256(tbuf + (size_t)NTOK * DM * 4);
    static constexpr size_t x1b = al256(x1f + (size_t)NTOK * DM * 4);
    static constexpr size_t top_e = al256(x1b + (size_t)NTOK * DM * 2);
    static constexpr size_t gw = al256(top_e + (size_t)NTOK * 4 * 4);
    static constexpr size_t lists = al256(gw + (size_t)NTOK * 4 * 4);
    static constexpr size_t act = al256(lists + (size_t)NE * LIST_CAP * 4);
    static constexpr size_t ybuf = al256(act + (size_t)MAXSLOT * DFF * 2);
    static constexpr size_t xq = al256(ybuf + (size_t)MAXSLOT * DM * 2);
    static constexpr size_t WinQ = al256(xq + (size_t)NTOK * DM);
    static constexpr size_t total = al256(WinQ + (size_t)NL * NMAIN * 1024);
};
__device__ __forceinline__ Params make_params(const KArgs& k) {
    Params p;
    p.x = k.in[0]; p.w_in = k.in[1]; p.b_in = k.in[2]; p.sinks = k.in[3]; p.cmp_pe = k.in[4]; p.cmp_w1 = k.in[5]; p.cmp_w2 = k.in[6]; p.w_out = k.in[7];
    p.ln1_g = k.in[8]; p.ln1_b = k.in[9]; p.router_w = k.in[10]; p.router_b = k.in[11]; p.w_gu = k.in[12]; p.b_gu = k.in[13]; p.w_dn = k.in[14]; p.b_dn = k.in[15];
    p.ln2_g = k.in[16]; p.ln2_b = k.in[17]; p.out = k.out;
    char* w = k.ws;
    p.ctrl = (unsigned*)(w + WSL::ctrl); p.WinT = (bf16_t*)(w + WSL::WinT); p.WoT = (bf16_t*)(w + WSL::WoT); p.W1T = (bf16_t*)(w + WSL::W1T); p.W2T = (bf16_t*)(w + WSL::W2T);
    p.WguT = (bf16_t*)(w + WSL::WguT); p.WdnT = (bf16_t*)(w + WSL::WdnT); p.rwT = (float*)(w + WSL::rwT); p.binp = (float*)(w + WSL::binp); p.bgup = (float*)(w + WSL::bgup);
    p.b1c = (float*)(w + WSL::b1c); p.xf = (float*)(w + WSL::xf); p.xb = (bf16_t*)(w + WSL::xb); p.hb = (bf16_t*)(w + WSL::hb); p.hs = (float*)(w + WSL::hs); p.vT = (bf16_t*)(w + WSL::vT); p.kF = (bf16_t*)(w + WSL::kF);
    p.cF = (float*)(w + WSL::cF); p.kc = (bf16_t*)(w + WSL::kc); p.vc = (bf16_t*)(w + WSL::vc); p.vcT = (bf16_t*)(w + WSL::vcT); p.ob = (bf16_t*)(w + WSL::ob); p.tbuf = (float*)(w + WSL::tbuf);
    p.x1f = (float*)(w + WSL::x1f); p.x1b = (bf16_t*)(w + WSL::x1b); p.top_e = (int*)(w + WSL::top_e); p.gw = (float*)(w + WSL::gw); p.lists = (int*)(w + WSL::lists);
    p.act = (bf16_t*)(w + WSL::act); p.ybuf = (bf16_t*)(w + WSL::ybuf); p.xq = (unsigned char*)(w + WSL::xq); p.WinQ = (unsigned char*)(w + WSL::WinQ);
    return p;
}
__device__ __forceinline__ void grid_bar(const Params& p, char* lds) {
    XcdBarrier xb; xb.bar = p.ctrl + 1024; xb.x = xb_xcc_id(); xb.st = (volatile LAS unsigned*)(lds + LDS_BYTES - 16); xcd_barrier(xb);
}
__device__ __forceinline__ Params fresh_params(const KArgs& ka) {
    KArgs k2 = ka; size_t z = 0; asm volatile("" : "+s"(z));
    k2.ws = ka.ws + z;
    return make_params(k2);
}
#ifndef REP
#define REP 0
#endif
template <int L>
__device__ __forceinline__ void layer_fwd(const KArgs& ka, char* lds) {
    { const Params p = fresh_params(ka); phase_inproj(p, L, lds);        grid_bar(p, lds); }
    { const Params p = fresh_params(ka); phase_prep(p, L, lds);          grid_bar(p, lds); }
    { const Params p = fresh_params(ka); phase_attn<L == 0>(p, L, lds);  grid_bar(p, lds); }
    { const Params p = fresh_params(ka); phase_outproj(p, L, p.xb, lds);  grid_bar(p, lds); }
    { const Params p = fresh_params(ka); phase_ln1_router(p, L, lds);    grid_bar(p, lds); }
    { const Params p = fresh_params(ka); phase_gateup(p, L, lds);        grid_bar(p, lds); }
    { const Params p = fresh_params(ka); phase_down(p, L, lds);          grid_bar(p, lds); }
    { const Params p = fresh_params(ka); phase_ln2(p, L, L == NL - 1 ? p.out : p.xf, lds); }
}
__global__ void __launch_bounds__(NTHR, 2) fwd_kernel(KArgs ka) {
    extern __shared__ __attribute__((aligned(16))) char lds[];
    const Params p = make_params(ka);
    cg::grid_group grid = cg::this_grid();
    volatile LAS unsigned* xst = (volatile LAS unsigned*)(lds + LDS_BYTES - 16);
    if (threadIdx.x == 0) { xst[0] = 0u; xst[1] = 0u; }
    __syncthreads();
    (void)xcd_barrier_post(p.ctrl + 1024, xst);
    volatile LAS int* vcu = (volatile LAS int*)(lds + LDS_BYTES - 32);
    const unsigned myx = xb_xcc_id() & 7u;
    if (threadIdx.x == 0) vcu[1] = (int)__hip_atomic_fetch_add(p.ctrl + 32 + myx, 1u, __ATOMIC_RELAXED, __HIP_MEMORY_SCOPE_AGENT);
    phase0(p, lds);
    grid.sync();
    if (threadIdx.x == 0) {
        int base = 0, tot = 0;
        for (unsigned x = 0; x < 8; ++x) { const int n = (int)__hip_atomic_load(p.ctrl + 32 + x, __ATOMIC_RELAXED, __HIP_MEMORY_SCOPE_AGENT); if (x < myx) base += n; tot += n; }
        vcu[0] = (tot == (int)gridDim.x) ? base + vcu[1] : (int)blockIdx.x;
    }
    __syncthreads();
    layer_fwd<0>(ka, lds);
    grid_bar(p, lds);
    layer_fwd<1>(ka, lds);
}

extern "C" void kernel_launch(void* const* d_in, const int* in_sizes, int n_in, void* d_out, int out_size, void* d_ws, size_t ws_size, hipStream_t stream) {
    KArgs ka{};
    for (int i = 0; i < 18; ++i) ka.in[i] = (const float*)d_in[i];
    ka.out = (float*)d_out; ka.ws = (char*)d_ws;
    if (WSL::total > ws_size) { fprintf(stderr, "workspace too small: need %zu have %zu\n", (size_t)WSL::total, ws_size); return; }
    static int grid_blocks = 0;
    if (!grid_blocks) {
        int dev = 0, cus = 0, per_cu = 0;
        (void)hipGetDevice(&dev);
        (void)hipDeviceGetAttribute(&cus, hipDeviceAttributeMultiprocessorCount, dev);
        (void)hipFuncSetAttribute((const void*)fwd_kernel, hipFuncAttributeMaxDynamicSharedMemorySize, LDS_BYTES);
        (void)hipOccupancyMaxActiveBlocksPerMultiprocessor(&per_cu, fwd_kernel, NTHR, LDS_BYTES);
        if (per_cu < 1) { fprintf(stderr, "occupancy query says 0 blocks per CU\n"); per_cu = 1; }
        grid_blocks = cus;
    }
    (void)hipMemsetAsync(d_ws, 0, 65536, stream);
    void* args[] = {&ka};
    hipError_t e = hipLaunchCooperativeKernel((const void*)fwd_kernel, dim3(grid_blocks), dim3(NTHR), args, LDS_BYTES, stream);
    if (e != hipSuccess) fprintf(stderr, "cooperative launch failed: %s (grid %d)\n", hipGetErrorString(e), grid_blocks);
}
```

```cpp
#include <hip/hip_runtime.h>
#include <hip/hip_cooperative_groups.h>
#include <cstdio>
#include <cstdint>
namespace cg = cooperative_groups;

typedef unsigned short bf16_t;
typedef short bf16x8 __attribute__((ext_vector_type(8)));
typedef float f32x4 __attribute__((ext_vector_type(4)));
typedef unsigned u32x4 __attribute__((ext_vector_type(4)));
typedef unsigned u32x2 __attribute__((ext_vector_type(2)));
typedef int v8i_t __attribute__((ext_vector_type(8)));
typedef float f32x2_t __attribute__((ext_vector_type(2)));
typedef int v4i_t __attribute__((ext_vector_type(4)));
#define LAS __attribute__((address_space(3)))
constexpr float NEG_INF = -__builtin_huge_valf();

constexpr int DM = 1024, NB = 16, SEQ = 2048, NTOK = NB * SEQ, NL = 2;
constexpr int NCOL = 2582, NMAIN = 2560, NPAD = 2688, NE = 32, DFF = 1024;
constexpr int C_FQ = 0, C_FK = 256, C_FV = 512, C_SQ = 768, C_SK = 1152, C_SV = 1280, C_NQ = 1408,
              C_NKC = 1792, C_NVC = 1920, C_NKS = 2048, C_NVS = 2176, C_NKW = 2304, C_NVW = 2432;
constexpr int HS_W = 32;
constexpr int NVH = 10;
constexpr int LIST_CAP = NTOK;
constexpr int MAXSLOT = NTOK * 4 + NE * 256;
constexpr float ALPHA = 1.41421356237f, LN_EPS = 1e-5f, QSCALE = 0.125f;
constexpr float GATE_PRE = -2.455466929f;
constexpr int NWV = 8, NTHR = NWV * 64;
constexpr int LDS_STAGE = 131072, LDS_TAB = LDS_STAGE, LDS_AOFF = LDS_STAGE + 2048, LDS_BIAS = LDS_AOFF + 20480, LDS_BYTES = LDS_BIAS + 3072 + 256;

struct Params {
    const float *x, *w_in, *b_in, *sinks, *cmp_pe, *cmp_w1, *cmp_w2, *w_out, *ln1_g, *ln1_b, *router_w, *router_b,
                *w_gu, *b_gu, *w_dn, *b_dn, *ln2_g, *ln2_b;
    float* out;
    unsigned* ctrl;
    bf16_t *WinT, *WoT, *W1T, *W2T, *WguT, *WdnT;
    float *rwT, *binp, *bgup, *b1c;
    unsigned char* xq; unsigned char* WinQ;
    float* xf; bf16_t* xb; bf16_t* hb; float* hs; bf16_t* vT; bf16_t* kF; float* cF;
    bf16_t *kc, *vc, *vcT; bf16_t* ob; float* tbuf; float* x1f; bf16_t* x1b;
    int* top_e; float* gw; int* lists; bf16_t* act; bf16_t* ybuf;
};

__device__ __forceinline__ float bf2f(bf16_t h) { return __uint_as_float(((unsigned)h) << 16); }
typedef __bf16 bf16x2_t __attribute__((ext_vector_type(2)));
__device__ __forceinline__ bf16_t f2bf(float f) { return __builtin_bit_cast(bf16_t, (__bf16)f); }
__device__ __forceinline__ unsigned pack2(float lo, float hi) { bf16x2_t v = {(__bf16)lo, (__bf16)hi}; return __builtin_bit_cast(unsigned, v); }
__device__ __forceinline__ unsigned pack4_fp8(float a, float b, float c, float d) {
    unsigned w = 0u;
    w = __builtin_amdgcn_cvt_pk_fp8_f32(a, b, w, false);
    w = __builtin_amdgcn_cvt_pk_fp8_f32(c, d, w, true);
    return w;
}
__device__ __forceinline__ float shfl_f(float v, int src_lane) { return __int_as_float(__builtin_amdgcn_ds_bpermute(src_lane << 2, __float_as_int(v))); }
__device__ __forceinline__ unsigned shfl_u(unsigned v, int src_lane) { return (unsigned)__builtin_amdgcn_ds_bpermute(src_lane << 2, (int)v); }
__device__ __forceinline__ float wave_sum(float v) {
#pragma unroll
    for (int o = 32; o > 0; o >>= 1) v += __shfl_xor(v, o);
    return v;
}
__device__ __forceinline__ float wave_max(float v) {
#pragma unroll
    for (int o = 32; o > 0; o >>= 1) v = fmaxf(v, __shfl_xor(v, o));
    return v;
}
__device__ __forceinline__ void lds_wave_sync() { asm volatile("s_waitcnt lgkmcnt(0)" ::: "memory"); __builtin_amdgcn_wave_barrier(); }
__device__ __forceinline__ float slope_swa(int hq) { return exp2f(-8.0f * (float)(2 * hq + 1) / 12.0f); }
__device__ __forceinline__ float slope_nsa(int hq) { return exp2f(-8.0f * (float)(2 * hq + 2) / 12.0f); }

__device__ __forceinline__ int fwd128(int L) { return (L & ~31) | (((L >> 2) & 1) << 4) | (((L >> 3) & 3) << 2) | (L & 3); }
__device__ __forceinline__ int inv128(int p) { return (p & ~31) | (((p >> 2) & 3) << 3) | (((p >> 4) & 1) << 2) | (p & 3); }
__device__ __forceinline__ int fwd256(int L) { return (L & ~255) | (((L >> 3) & 1) << 7) | (((L >> 6) & 3) << 5) | (((L >> 2) & 1) << 4) | (((L >> 4) & 3) << 2) | (L & 3); }
__device__ __forceinline__ int perm_row(int perm, int n) {
    if (perm == 1) { int r; if (n < 768) r = n; else if (n < 772) r = 2560 + (n - 768); else if (n < 2564) r = n - 4; else r = n; return r < 2560 ? fwd128(r) : r; }
    if (perm == 2) { const int f = n >> 1, s = n & 1; return (f >> 7) * 256 + s * 128 + fwd128(f & 127); }
    if (perm == 3) return fwd256(n);
    return n;
}
struct ConvJob { const float* src; bf16_t* dst; int K, N, kt, nt, perm; float q8; };
__device__ __forceinline__ bool conv_job(const Params& p, int t, ConvJob& jb) {
    constexpr int T_WIN = NL * 8 * 21, T_WO = NL * 8 * 8, T_WINB = NL * 8 * 2;
    if (t < T_WINB) { const int m = t / 16, r = t % 16; jb = ConvJob{p.w_in + (size_t)m * 1024 * NCOL, p.WinT + (size_t)m * NPAD * 1024, 1024, NCOL, r >> 1, (r & 1) ? 20 : 6, 1, 0.f}; return true; }
    t -= T_WINB;
    if (t < T_WO) { const int m = t / 64, r = t % 64; jb = ConvJob{p.w_out + (size_t)m * 1024 * 1024, (bf16_t*)((char*)p.WoT + (size_t)m * 1024 * 1024), 1024, 1024, r / 8, r % 8, 3, 64.0f}; return true; }
    t -= T_WO;
    if (t < T_WIN) { const int m = t / 168, r = t % 168; jb = ConvJob{p.w_in + (size_t)m * 1024 * NCOL, (bf16_t*)(p.WinQ + (size_t)m * NMAIN * 1024), 1024, NCOL, r / 21, r % 21, 1, 64.0f}; return true; }
    return false;
}
constexpr int CONV_TILES = NL * NE * 192;
__device__ __forceinline__ void conv_tile_wave(const Params& p, int t, int lane, unsigned char* l8) {
    asm volatile("" : "+v"(lane));
    const int m = t / 192, r = t % 192;
    const float* src; unsigned char* dst; int N, kt, nt, perm;
    if (r < 128) { src = p.w_gu + (size_t)m * 1024 * 2048; dst = (unsigned char*)p.WguT + (size_t)m * 2048 * 1024; N = 2048; kt = r >> 4; nt = r & 15; perm = 2; }
    else { const int q = r - 128; src = p.w_dn + (size_t)m * 1024 * 1024; dst = (unsigned char*)p.WdnT + (size_t)m * 1024 * 1024; N = 1024; kt = q >> 3; nt = q & 7; perm = 3; }
    const float* s = src + (size_t)(kt * 128 + (lane >> 5)) * N + nt * 128 + (lane & 31) * 4;
    unsigned char* lw = l8 + (lane >> 5) * 132 + (lane & 31) * 4;
    const float sg = (perm == 2) ? 64.0f * GATE_PRE : 64.0f;
    float4 va[16], vb[16];
#pragma unroll
    for (int i = 0; i < 16; ++i) va[i] = *(const float4*)(s + (size_t)(2 * i) * N);
#pragma unroll
    for (int i = 0; i < 16; ++i) vb[i] = *(const float4*)(s + (size_t)(32 + 2 * i) * N);
#pragma unroll
    for (int i = 0; i < 16; ++i) *(unsigned*)(lw + (2 * i) * 132) = pack4_fp8(va[i].x * sg, va[i].y * 64.0f, va[i].z * sg, va[i].w * 64.0f);
#pragma unroll
    for (int i = 0; i < 16; ++i) va[i] = *(const float4*)(s + (size_t)(64 + 2 * i) * N);
#pragma unroll
    for (int i = 0; i < 16; ++i) *(unsigned*)(lw + (32 + 2 * i) * 132) = pack4_fp8(vb[i].x * sg, vb[i].y * 64.0f, vb[i].z * sg, vb[i].w * 64.0f);
#pragma unroll
    for (int i = 0; i < 16; ++i) vb[i] = *(const float4*)(s + (size_t)(96 + 2 * i) * N);
#pragma unroll
    for (int i = 0; i < 16; ++i) *(unsigned*)(lw + (64 + 2 * i) * 132) = pack4_fp8(va[i].x * sg, va[i].y * 64.0f, va[i].z * sg, va[i].w * 64.0f);
#pragma unroll
    for (int i = 0; i < 16; ++i) *(unsigned*)(lw + (96 + 2 * i) * 132) = pack4_fp8(vb[i].x * sg, vb[i].y * 64.0f, vb[i].z * sg, vb[i].w * 64.0f);
    lds_wave_sync();
#pragma unroll 4
    for (int i = 0; i < 16; ++i) {
        const int idx = lane + 64 * i, kc = idx & 7, nn = idx >> 3;
        const unsigned char* l = l8 + (kc * 16) * 132 + nn;
        u32x4 w;
        w.x = (unsigned)l[0] | ((unsigned)l[132] << 8) | ((unsigned)l[264] << 16) | ((unsigned)l[396] << 24);
        w.y = (unsigned)l[528] | ((unsigned)l[660] << 8) | ((unsigned)l[792] << 16) | ((unsigned)l[924] << 24);
        w.z = (unsigned)l[1056] | ((unsigned)l[1188] << 8) | ((unsigned)l[1320] << 16) | ((unsigned)l[1452] << 24);
        w.w = (unsigned)l[1584] | ((unsigned)l[1716] << 8) | ((unsigned)l[1848] << 16) | ((unsigned)l[1980] << 24);
        *(u32x4*)(dst + (size_t)perm_row(perm, nt * 128 + nn) * 1024 + kt * 128 + kc * 16) = w;
    }
    lds_wave_sync();
}
__device__ __forceinline__ void conv_load(const ConvJob& jb, int tid, float2 (&v)[16]) {
    const int n = jb.nt * 128 + (tid & 31) * 4;
    const float* s = jb.src + (size_t)(jb.kt * 128 + (tid >> 5)) * jb.N + n;
#pragma unroll
    for (int i = 0; i < 8; ++i) {
        const float* r = s + (size_t)(16 * i) * jb.N;
        v[2 * i] = (n + 1 < jb.N) ? *(const float2*)r : make_float2(0.f, 0.f);
        v[2 * i + 1] = (n + 3 < jb.N) ? *(const float2*)(r + 2) : make_float2(0.f, 0.f);
    }
}
__device__ __forceinline__ void phase0(const Params& p, char* ldsc) {
    int tid = threadIdx.x; asm volatile("" : "+v"(tid));
    const int G = gridDim.x, bid = blockIdx.x;
    const size_t gtid = (size_t)bid * NTHR + tid, gthreads = (size_t)G * NTHR;
    {
        constexpr int TOT = NL * 8 * 2 + NL * 8 * 21 + NL * 8 * 8;
        bf16_t* lt = (bf16_t*)ldsc;
        ConvJob jb, jn; float2 v[16], vn[16];
        int t = bid; bool have = t < TOT && conv_job(p, t, jb);
        if (have) conv_load(jb, tid, v);
        while (have) {
            const int tn = t + G; const bool hn = tn < TOT && conv_job(p, tn, jn);
            if (hn) conv_load(jn, tid, vn);
            if (jb.q8 != 0.f) {
                unsigned char* l8 = (unsigned char*)lt;
#pragma unroll
                for (int i = 0; i < 8; ++i)
                {   int kl = (tid >> 5) + 16 * i;
                    if (jb.perm == 3) kl = (kl & 64) | (((kl >> 2) & 3) << 4) | (((kl >> 4) & 3) << 2) | (kl & 3);
                    *(unsigned*)(l8 + kl * 132 + (tid & 31) * 4) = pack4_fp8(v[2 * i].x * jb.q8, v[2 * i].y * jb.q8, v[2 * i + 1].x * jb.q8, v[2 * i + 1].y * jb.q8); }
                __syncthreads();
#pragma unroll
                for (int i = 0; i < 2; ++i) {
                    const int idx = tid + NTHR * i, kc = idx & 7, nn = idx >> 3, n = jb.nt * 128 + nn;
                    const unsigned char* l = l8 + (kc * 16) * 132 + nn;
                    u32x4 w;
                    w.x = (unsigned)l[0] | ((unsigned)l[132] << 8) | ((unsigned)l[264] << 16) | ((unsigned)l[396] << 24);
                    w.y = (unsigned)l[528] | ((unsigned)l[660] << 8) | ((unsigned)l[792] << 16) | ((unsigned)l[924] << 24);
                    w.z = (unsigned)l[1056] | ((unsigned)l[1188] << 8) | ((unsigned)l[1320] << 16) | ((unsigned)l[1452] << 24);
                    w.w = (unsigned)l[1584] | ((unsigned)l[1716] << 8) | ((unsigned)l[1848] << 16) | ((unsigned)l[1980] << 24);
                    const int pr = perm_row(jb.perm, n);
                    if (n < jb.N && !(jb.perm == 1 && pr >= NMAIN)) *(u32x4*)((char*)jb.dst + (size_t)pr * jb.K + jb.kt * 128 + kc * 16) = w;
                }
            } else {
#pragma unroll
                for (int i = 0; i < 8; ++i) {
                    u32x2 w; w.x = pack2(v[2 * i].x, v[2 * i].y); w.y = pack2(v[2 * i + 1].x, v[2 * i + 1].y);
                    *(u32x2*)(lt + ((tid >> 5) + 16 * i) * 136 + (tid & 31) * 4) = w;
                }
                __syncthreads();
#pragma unroll
                for (int i = 0; i < 4; ++i) {
                    const int idx = tid + NTHR * i, kc = idx & 15, nn = idx >> 4, n = jb.nt * 128 + nn;
                    if (n < jb.N) {
                        const bf16_t* l = lt + (kc * 8) * 136 + nn;
                        u32x4 w;
                        w.x = (unsigned)l[0] | ((unsigned)l[136] << 16); w.y = (unsigned)l[272] | ((unsigned)l[408] << 16);
                        w.z = (unsigned)l[544] | ((unsigned)l[680] << 16); w.w = (unsigned)l[816] | ((unsigned)l[952] << 16);
                        *(u32x4*)(jb.dst + (size_t)perm_row(jb.perm, n) * jb.K + jb.kt * 128 + kc * 8) = w;
                    }
                }
            }
            __syncthreads();
            t = tn; have = hn; jb = jn;
#pragma unroll
            for (int i = 0; i < 16; ++i) v[i] = vn[i];
        }
    }
    for (size_t i = gtid; i < (size_t)NL * 2 * 2048 * 64; i += gthreads) {
        const int k = (int)(i % 2048), n = (int)((i / 2048) % 64), m = (int)(i / (2048 * 64));
        p.W1T[i] = f2bf(p.cmp_w1[((size_t)m * 2048 + k) * 64 + n]);
    }
    for (size_t i = gtid; i < (size_t)NL * 2 * 64 * 64; i += gthreads) {
        const int k = (int)(i % 64), n = (int)((i / 64) % 64), m = (int)(i / 4096);
        p.W2T[i] = f2bf(p.cmp_w2[((size_t)m * 64 + k) * 64 + n]);
    }
    for (size_t i = gtid; i < (size_t)NL * NPAD; i += gthreads) {
        const int l = (int)(i / NPAD), ri = (int)(i % NPAD), r = ri < 2560 ? inv128(ri) : ri;
        float v = 0.f;
        if (r < 2560) { const int n = r < 768 ? r : r + 4; v = p.b_in[l * NCOL + n]; }
        else if (r < 2564) v = p.b_in[l * NCOL + 768 + (r - 2560)];
        else if (r < 2582) v = p.b_in[l * NCOL + r];
        p.binp[i] = v;
    }
    for (size_t i = gtid; i < (size_t)NL * NE * 2048; i += gthreads) {
        const int r = (int)(i % 2048); const size_t le = i / 2048;
        const int s = (r >> 7) & 1, f = (r >> 8) * 128 + inv128(r & 127);
        p.bgup[i] = p.b_gu[le * 2048 + 2 * f + s] * (s == 0 ? GATE_PRE : 1.0f);
    }
    for (size_t i = gtid; i < (size_t)NL * NE * 1024; i += gthreads) {
        const int k = (int)(i % 1024), e = (int)((i / 1024) % NE), l = (int)(i / (1024 * NE));
        const float wv = p.router_w[((size_t)l * 1024 + k) * NE + e];
        const bf16_t hi = f2bf(wv); const float hf = __uint_as_float((unsigned)hi << 16);
        bf16_t* rwb = (bf16_t*)p.rwT + (size_t)l * 64 * 1024;
        rwb[(size_t)e * 1024 + k] = hi; rwb[(size_t)(32 + e) * 1024 + k] = f2bf(wv - hf);
    }
    for (size_t i = gtid; i < (size_t)NL * (NPAD - NCOL) * 1024; i += gthreads) {
        const int l = (int)(i / ((NPAD - NCOL) * 1024)); const size_t r = i % ((size_t)(NPAD - NCOL) * 1024);
        p.WinT[(size_t)l * NPAD * 1024 + (size_t)NCOL * 1024 + r] = 0;
    }
    {
        constexpr size_t N16 = (size_t)NTOK * DM / 16;
        for (size_t i0 = gtid; i0 < N16; i0 += gthreads * 2) {
            float4 v[2][4];
#pragma unroll
            for (int u = 0; u < 2; ++u) { const size_t i = i0 + u * gthreads;
#pragma unroll
                for (int j = 0; j < 4; ++j) v[u][j] = (i < N16) ? ((const float4*)p.x)[i * 4 + j] : make_float4(0.f, 0.f, 0.f, 0.f); }
#pragma unroll
            for (int u = 0; u < 2; ++u) { const size_t i = i0 + u * gthreads;
                if (i < N16) {
                    u32x4 w0, w1, q;
                    w0.x = pack2(v[u][0].x, v[u][0].y); w0.y = pack2(v[u][0].z, v[u][0].w); w0.z = pack2(v[u][1].x, v[u][1].y); w0.w = pack2(v[u][1].z, v[u][1].w);
                    w1.x = pack2(v[u][2].x, v[u][2].y); w1.y = pack2(v[u][2].z, v[u][2].w); w1.z = pack2(v[u][3].x, v[u][3].y); w1.w = pack2(v[u][3].z, v[u][3].w);
                    q.x = pack4_fp8(v[u][0].x, v[u][0].y, v[u][0].z, v[u][0].w); q.y = pack4_fp8(v[u][1].x, v[u][1].y, v[u][1].z, v[u][1].w);
                    q.z = pack4_fp8(v[u][2].x, v[u][2].y, v[u][2].z, v[u][2].w); q.w = pack4_fp8(v[u][3].x, v[u][3].y, v[u][3].z, v[u][3].w);
                    ((u32x4*)p.xb)[i * 2] = w0; ((u32x4*)p.xb)[i * 2 + 1] = w1; ((u32x4*)p.xq)[i] = q;
                }
            }
        }
    }
    if (bid < 32) {
        float* lf = (float*)ldsc;
        const int j = tid & 63, part = tid >> 6, lw = bid >> 3, sl = bid & 7;
        const float* pe = p.cmp_pe + (size_t)lw * 2048; const float* w1 = p.cmp_w1 + (size_t)lw * 2048 * 64;
        float s = 0.f;
#pragma unroll 8
        for (int kk = sl * 256 + part * 32; kk < sl * 256 + part * 32 + 32; ++kk) s += pe[kk] * w1[(size_t)kk * 64 + j];
        lf[tid] = s; __syncthreads();
        if (tid < 64) { float a = 0.f; for (int q = 0; q < 8; ++q) a += lf[tid + 64 * q]; p.b1c[(lw * 8 + sl) * 64 + tid] = a; }
        __syncthreads();
    }
}

__device__ __forceinline__ int vcu_id() { return __builtin_amdgcn_readfirstlane(*(const volatile LAS int*)(LDS_BYTES - 32)); }
namespace pg8 {
constexpr int BM = 256, BK = 64, HALF = 128, HTB = HALF * BK * 2, NXCD = 8, WGM = 8;
__device__ __forceinline__ int lds_byte(int r, int c) { const int ch = (c >> 3) ^ ((r >> 1) & 7); return (r >> 3) * 1024 + (r & 7) * 128 + ch * 16 + (c & 7) * 2; }
__device__ __forceinline__ void stage_rc(int b, int& R, int& C) { const int st = b / 1024, sb = b % 1024; R = st * 8 + sb / 128; C = ((((sb % 128) / 16) ^ ((R >> 1) & 7)) * 16 + (sb % 16)) / 2; }
__device__ __forceinline__ bool tile_order(int i, int G, int c, int nM, int nN, int& pm, int& pn) {
    const int nwg = nM * nN; const long L = (long)i * G + c; if (L >= nwg) return false;
    const int wgid = (int)L;
    const int nig = WGM * nN, gid = wgid / nig, fm = gid * WGM, gsz = (nM - fm) < WGM ? (nM - fm) : WGM;
    pm = fm + ((wgid % nig) % gsz); pn = (wgid % nig) / gsz; return true;
}
template <bool FP8, int SCA, class Sched, class Epi>
__device__ __forceinline__ void gemm_phase(LAS unsigned char* lds, const char* Abase, int K, const Sched& S, const Epi& E) {
    int tid = threadIdx.x; asm volatile("" : "+v"(tid));
    const int wid = __builtin_amdgcn_readfirstlane(tid >> 6), lane = tid & 63, wr = wid >> 2, wc = wid & 3, fr = lane & 15, fq = lane >> 4;
    const int nt = K / BK;
    int R0, C0, R1, C1; stage_rc(tid * 16, R0, C0); stage_rc(tid * 16 + 8192, R1, C1);
    LAS unsigned* aofs = (LAS unsigned*)(lds + LDS_AOFF) + tid;
    unsigned rg[10];
    rg[8] = (unsigned)(R0 * K + C0) * 2u; rg[9] = (unsigned)(R1 * K + C1) * 2u;
    if constexpr (FP8) { aofs[8 * NTHR] = rg[8]; aofs[9 * NTHR] = rg[9]; }
    const size_t kstep = (size_t)(BK * 2), hstep = (size_t)HALF * K * 2;
    const unsigned ldsw = (unsigned)wid * 1024u;
    const int aoff = lds_byte(wr * 64 + fr, fq * 8), boff = lds_byte(wc * 32 + fr, fq * 8);
#define PG8_SA(b, h) (((b) * 2 + (h)) * HTB)
#define PG8_SB(b, h) ((4 + (b) * 2 + (h)) * HTB)
#define PG8_OFS(sel, j) (FP8 ? aofs[((sel) * 4 + (j)) * NTHR] : ((sel) ? rg[4 + (j)] : rg[(j)]))
#define PG8_STAGE_B(bufoff, gbase) do { _Pragma("unroll") for (int _i = 0; _i < 2; ++_i) { const unsigned ob_ = FP8 ? aofs[(8 + _i) * NTHR] : rg[8 + _i]; \
        __builtin_amdgcn_global_load_lds((const unsigned*)((const char*)(gbase) + ob_), (LAS unsigned*)(lds + (bufoff) + ldsw + _i * 8192), 16, 0, 0); } } while (0)
#define PG8_STAGE_A(bufoff, kbyte, sel, h) do { const unsigned o0_ = PG8_OFS(sel, (h) * 2), o1_ = PG8_OFS(sel, (h) * 2 + 1); \
        __builtin_amdgcn_global_load_lds((const unsigned*)(Abase + (kbyte) + o0_), (LAS unsigned*)(lds + (bufoff) + ldsw), 16, 0, 0); \
        __builtin_amdgcn_global_load_lds((const unsigned*)(Abase + (kbyte) + o1_), (LAS unsigned*)(lds + (bufoff) + ldsw + 8192), 16, 0, 0); } while (0)
#define PG8_LDA(dst, b, h) do { _Pragma("unroll") for (int m = 0; m < 4; ++m) { \
        if constexpr (FP8) { const v4i_t lo_ = *(const LAS v4i_t*)(lds + PG8_SA(b, h) + aoff + m * 2048), hi_ = *(const LAS v4i_t*)(lds + PG8_SA(b, h) + (aoff ^ 64) + m * 2048); dst##8[m] = __builtin_shufflevector(lo_, hi_, 0, 1, 2, 3, 4, 5, 6, 7); } \
        else { _Pragma("unroll") for (int k = 0; k < 2; ++k) dst[m][k] = *(const LAS bf16x8*)(lds + PG8_SA(b, h) + (aoff ^ (k * 64)) + m * 2048); } } } while (0)
#define PG8_LDB(dst, b, h) do { _Pragma("unroll") for (int n = 0; n < 2; ++n) { \
        if constexpr (FP8) { const v4i_t lo_ = *(const LAS v4i_t*)(lds + PG8_SB(b, h) + boff + n * 2048), hi_ = *(const LAS v4i_t*)(lds + PG8_SB(b, h) + (boff ^ 64) + n * 2048); dst##8[n] = __builtin_shufflevector(lo_, hi_, 0, 1, 2, 3, 4, 5, 6, 7); } \
        else { _Pragma("unroll") for (int k = 0; k < 2; ++k) dst[n][k] = *(const LAS bf16x8*)(lds + PG8_SB(b, h) + (boff ^ (k * 64)) + n * 2048); } } } while (0)
#define PG8_MMA(ai, bj, At, Bt) do { __builtin_amdgcn_s_setprio(1); _Pragma("unroll") for (int m = 0; m < 4; ++m) _Pragma("unroll") for (int n = 0; n < 2; ++n) { \
        if constexpr (FP8) { acc[ai][bj][m][n] = __builtin_amdgcn_mfma_scale_f32_16x16x128_f8f6f4(Bt##8[n], At##8[m], acc[ai][bj][m][n], 0, 0, 0, SCA, 0, SCA); } \
        else { _Pragma("unroll") for (int k = 0; k < 2; ++k) acc[ai][bj][m][n] = __builtin_amdgcn_mfma_f32_16x16x32_bf16(Bt[n][k], At[m][k], acc[ai][bj][m][n], 0, 0, 0); } } \
        __builtin_amdgcn_s_setprio(0); } while (0)
#define PG8_WAIT_V(n) asm volatile("s_waitcnt vmcnt(" #n ")" ::: "memory")
#define PG8_WAIT_L(n) asm volatile("s_waitcnt lgkmcnt(" #n ")" ::: "memory")
#define PG8_BAR __builtin_amdgcn_s_barrier()
#define PG8_SCHED __builtin_amdgcn_sched_barrier(0)
    typename Sched::Unit cur, nxt; int ui = 0;
    if (!S.next(0, cur)) return;
    f32x4 acc[2][2][4][2];
    bf16x8 At[4][2], B0[2][2], B1[2][2];
    v8i_t At8[4], B08[2], B18[2];
    { unsigned a4[2][2]; S.a_off(cur, R0, C0, R1, C1, a4); rg[0] = a4[0][0]; rg[1] = a4[0][1]; rg[2] = a4[1][0]; rg[3] = a4[1][1];
      if constexpr (FP8) { aofs[0] = a4[0][0]; aofs[NTHR] = a4[0][1]; aofs[2 * NTHR] = a4[1][0]; aofs[3 * NTHR] = a4[1][1]; } }
    const char* cB = S.b_ptr(cur);
#define PG8_BIAS_DMA(unit, slot) do { const float* bp_ = E.bias_ptr(unit); int tb_ = threadIdx.x; asm volatile("" : "+v"(tb_)); if (wr == 0 && bp_ != nullptr) \
        __builtin_amdgcn_global_load_lds((const unsigned*)(bp_ + (tb_ & 255)), (LAS unsigned*)(lds + LDS_BIAS + (slot) * 1024 + wid * 256), 4, 0, 0); } while (0)
    PG8_BIAS_DMA(cur, 0);
    PG8_STAGE_B(PG8_SB(0, 0), cB); PG8_STAGE_B(PG8_SB(0, 1), cB + hstep); PG8_STAGE_A(PG8_SA(0, 0), 0, 0, 0); PG8_STAGE_A(PG8_SA(0, 1), 0, 0, 1);
    if (wr == 1) PG8_BAR;
    PG8_WAIT_V(2); PG8_BAR;
    PG8_STAGE_B(PG8_SB(1, 0), cB + kstep); PG8_STAGE_A(PG8_SA(1, 0), kstep, 0, 0); PG8_STAGE_B(PG8_SB(1, 1), cB + hstep + kstep);
    PG8_WAIT_V(6); PG8_BAR;
    { int t3 = threadIdx.x; asm volatile("" : "+v"(t3)); E.init(acc, wc, (t3 & 63) >> 4, (const LAS float*)(lds + LDS_BIAS)); }
    for (;;) {
        const bool has_next = S.next(ui + 1, nxt);
        const char* nB = cB;
        if (has_next) PG8_BIAS_DMA(nxt, (ui + 1) % 3);
        if (has_next) { int t2 = threadIdx.x; asm volatile("" : "+v"(t2)); int r0, c0, r1, c1; stage_rc(t2 * 16, r0, c0); stage_rc(t2 * 16 + 8192, r1, c1); nB = S.b_ptr(nxt);
            if constexpr (Sched::LIST_DMA) { static_assert(!Sched::LIST_DMA || FP8, "list DMA lands in the LDS offset slots"); S.a_dma(nxt, r0, r1, (LAS unsigned*)(lds + LDS_AOFF + 4 * NTHR * 4 + wid * 256)); }
            else { unsigned a4[2][2]; S.a_off(nxt, r0, c0, r1, c1, a4);
                rg[4] = a4[0][0]; rg[5] = a4[0][1]; rg[6] = a4[1][0]; rg[7] = a4[1][1];
                if constexpr (FP8) { aofs[4 * NTHR] = a4[0][0]; aofs[5 * NTHR] = a4[0][1]; aofs[6 * NTHR] = a4[1][0]; aofs[7 * NTHR] = a4[1][1]; } } }
        else { rg[4] = rg[0]; rg[5] = rg[1]; rg[6] = rg[2]; rg[7] = rg[3];
            if constexpr (FP8) { aofs[4 * NTHR] = aofs[0]; aofs[5 * NTHR] = aofs[NTHR]; aofs[6 * NTHR] = aofs[2 * NTHR]; aofs[7 * NTHR] = aofs[3 * NTHR]; } }
#pragma unroll 1
        for (int t = 0; t < nt; t += 2) {
            const bool last = (t == nt - 2);
            const size_t ka1 = (size_t)(t + 1) * kstep, ka2 = last ? 0 : (size_t)(t + 2) * kstep, ka3 = ka2 + kstep;
            const char* b2 = last ? nB : cB + (size_t)(t + 2) * kstep; const char* b3 = b2 + kstep;
            const int sel = last ? 1 : 0;
            if constexpr (Sched::LIST_DMA) if (last && has_next) {
                int t4 = threadIdx.x; asm volatile("" : "+v"(t4)); int r0, c0, r1, c1; stage_rc(t4 * 16, r0, c0); stage_rc(t4 * 16 + 8192, r1, c1);
#pragma unroll
                for (int j = 0; j < 4; ++j) aofs[(4 + j) * NTHR] = S.a_fin(aofs[(4 + j) * NTHR], (j & 1) ? c1 : c0);
            }
            PG8_LDB(B0, 0, 0); PG8_LDB(B1, 0, 1); PG8_SCHED; PG8_LDA(At, 0, 0); PG8_STAGE_A(PG8_SA(1, 1), ka1, 0, 1);
            PG8_WAIT_V(8); PG8_WAIT_L(0); PG8_BAR; PG8_MMA(0, 0, At, B0); PG8_MMA(0, 1, At, B1); PG8_BAR; PG8_SCHED;
            PG8_LDA(At, 0, 1); PG8_STAGE_B(PG8_SB(0, 0), b2); PG8_STAGE_B(PG8_SB(0, 1), b2 + hstep); PG8_STAGE_A(PG8_SA(0, 0), ka2, sel, 0);
            PG8_WAIT_V(8); PG8_WAIT_L(0); PG8_BAR; PG8_MMA(1, 0, At, B0); PG8_MMA(1, 1, At, B1); PG8_BAR; PG8_SCHED;
            PG8_LDB(B0, 1, 0); PG8_LDB(B1, 1, 1); PG8_SCHED; PG8_LDA(At, 1, 0); PG8_STAGE_A(PG8_SA(0, 1), ka2, sel, 1);
            PG8_WAIT_V(8); PG8_WAIT_L(0); PG8_BAR; PG8_MMA(0, 0, At, B0); PG8_MMA(0, 1, At, B1); PG8_BAR; PG8_SCHED;
            PG8_LDA(At, 1, 1); PG8_STAGE_B(PG8_SB(1, 0), b3); PG8_STAGE_B(PG8_SB(1, 1), b3 + hstep); PG8_STAGE_A(PG8_SA(1, 0), ka3, sel, 0);
            PG8_WAIT_V(8); PG8_WAIT_L(0); PG8_BAR; PG8_MMA(1, 0, At, B0); PG8_MMA(1, 1, At, B1); PG8_BAR; PG8_SCHED;
        }
        if (wr == 0) PG8_BAR;
        { int t2 = threadIdx.x; asm volatile("" : "+v"(t2)); E(acc, cur, wr, wc, t2 & 15, (t2 & 63) >> 4, (const LAS float*)(lds + LDS_BIAS + (ui % 3) * 1024)); }
        if (!has_next) break;
        { int t3 = threadIdx.x; asm volatile("" : "+v"(t3)); E.init(acc, wc, (t3 & 63) >> 4, (const LAS float*)(lds + LDS_BIAS + ((ui + 1) % 3) * 1024)); }
        cur = nxt; cB = nB; ++ui;
        rg[0] = rg[4]; rg[1] = rg[5]; rg[2] = rg[6]; rg[3] = rg[7];
        if constexpr (FP8) { aofs[0] = aofs[4 * NTHR]; aofs[NTHR] = aofs[5 * NTHR]; aofs[2 * NTHR] = aofs[6 * NTHR]; aofs[3 * NTHR] = aofs[7 * NTHR]; }
        if (wr == 1) PG8_BAR;
    }
    PG8_WAIT_V(0);
    PG8_BAR;
#undef PG8_BIAS_DMA
#undef PG8_SA
#undef PG8_SB
#undef PG8_STAGE_A
#undef PG8_OFS
#undef PG8_STAGE_B
#undef PG8_LDA
#undef PG8_LDB
#undef PG8_MMA
#undef PG8_WAIT_V
#undef PG8_WAIT_L
#undef PG8_BAR
#undef PG8_SCHED
}
}

struct DenseUnit { int pm, pn; };
struct DenseSched {
    typedef DenseUnit Unit;
    const char* Bt; int K, nM, nN, vc;
    __device__ __forceinline__ bool next(int i, Unit& u) const { return pg8::tile_order(i, gridDim.x, vc, nM, nN, u.pm, u.pn); }
    __device__ __forceinline__ void a_off(const Unit& u, int R0, int C0, int R1, int C1, unsigned (&off)[2][2]) const {
#pragma unroll
        for (int h = 0; h < 2; ++h) { off[h][0] = (unsigned)((u.pm * 256 + h * 128 + R0) * K + C0) * 2u; off[h][1] = (unsigned)((u.pm * 256 + h * 128 + R1) * K + C1) * 2u; }
    }
    __device__ __forceinline__ const char* b_ptr(const Unit& u) const { return Bt + (size_t)u.pn * 256 * K * 2; }
    static constexpr bool LIST_DMA = false;
    __device__ __forceinline__ void a_dma(const Unit&, int, int, LAS unsigned*) const {}
    __device__ __forceinline__ unsigned a_fin(unsigned raw, int) const { return raw; }
};
struct MoeUnit { int rbt, e, pn; };
template <bool GATHER>
struct MoeSched {
    typedef MoeUnit Unit;
    static constexpr int KP = 512;
    const char* Bt; const int* lists; const int* ptile; const int* ecnt; int nN, nrows, vc;
    __device__ __forceinline__ bool next(int i, Unit& u) const {
        int pm, pn; if (!pg8::tile_order(i, gridDim.x, vc, ptile[NE], nN, pm, pn)) return false;
        u.rbt = pm; u.e = ((const unsigned char*)ptile)[512 + pm]; u.pn = pn; return true;
    }
    __device__ __forceinline__ void a_off(const Unit& u, int R0, int C0, int R1, int C1, unsigned (&off)[2][2]) const {
        if (GATHER) {
            const int* lst = lists + (size_t)u.e * LIST_CAP; const int rb = u.rbt - ptile[u.e], cnt = ecnt[u.e];
#pragma unroll
            for (int h = 0; h < 2; ++h) {
                const int l0 = rb * 256 + h * 128 + R0, l1 = rb * 256 + h * 128 + R1;
                const int t0 = l0 < cnt ? (lst[l0] >> 2) : 0, t1 = l1 < cnt ? (lst[l1] >> 2) : 0;
                off[h][0] = (unsigned)(t0 * KP + C0) * 2u; off[h][1] = (unsigned)(t1 * KP + C1) * 2u;
            }
        } else {
#pragma unroll
            for (int h = 0; h < 2; ++h) { off[h][0] = (unsigned)((u.rbt * 256 + h * 128 + R0) * KP + C0) * 2u; off[h][1] = (unsigned)((u.rbt * 256 + h * 128 + R1) * KP + C1) * 2u; }
        }
    }
    __device__ __forceinline__ const char* b_ptr(const Unit& u) const { return Bt + ((size_t)u.e * nrows + (size_t)u.pn * 256) * KP * 2; }
    static constexpr bool LIST_DMA = GATHER;
    __device__ __forceinline__ void a_dma(const Unit& u, int R0, int R1, LAS unsigned* slot) const {
        const int* lst = lists + (size_t)u.e * LIST_CAP; const int rb = u.rbt - ptile[u.e], cm = ecnt[u.e] - 1;
#pragma unroll
        for (int h = 0; h < 2; ++h) {
            const int l0 = min(rb * 256 + h * 128 + R0, cm), l1 = min(rb * 256 + h * 128 + R1, cm);
            __builtin_amdgcn_global_load_lds((const unsigned*)(lst + l0), slot + (h * 2) * NTHR, 4, 0, 0);
            __builtin_amdgcn_global_load_lds((const unsigned*)(lst + l1), slot + (h * 2 + 1) * NTHR, 4, 0, 0);
        }
    }
    __device__ __forceinline__ unsigned a_fin(unsigned raw, int C) const { return (unsigned)((int)(raw >> 2) * KP + C) * 2u; }
};

__device__ __forceinline__ u32x2 quad_tr(unsigned p01, unsigned p23, int fr) {
    const unsigned sel = (fr & 1) ? 0x03020706u : 0x05040100u;
    const unsigned y01 = (unsigned)__builtin_amdgcn_update_dpp(0, (int)p01, 0xB1, 0xF, 0xF, true), y23 = (unsigned)__builtin_amdgcn_update_dpp(0, (int)p23, 0xB1, 0xF, 0xF, true);
    const unsigned q01 = __builtin_amdgcn_perm(y01, p01, sel), q23 = __builtin_amdgcn_perm(y23, p23, sel);
    const bool hi = (fr & 2) != 0;
    const unsigned snd = hi ? q01 : q23;
    const unsigned rcv = (unsigned)__builtin_amdgcn_update_dpp(0, (int)snd, 0x4E, 0xF, 0xF, true);
    u32x2 r; r.x = hi ? rcv : q01; r.y = hi ? q23 : rcv; return r;
}
struct EpiInProj {
    const Params* p; int l;
    __device__ __forceinline__ const float* bias_ptr(const DenseUnit& u) const { return p->binp + l * NPAD + u.pn * 256; }
    __device__ __forceinline__ void init(f32x4 (&acc)[2][2][4][2], int wc, int fq, const LAS float* bias) const {
#pragma unroll
        for (int bj = 0; bj < 2; ++bj)
#pragma unroll
            for (int n = 0; n < 2; ++n) {
                const f32x4 bv = *(const LAS f32x4*)(bias + bj * 128 + wc * 32 + n * 16 + 4 * fq);
#pragma unroll
                for (int ai = 0; ai < 2; ++ai)
#pragma unroll
                    for (int m = 0; m < 4; ++m) acc[ai][bj][m][n] = bv;
            }
    }
    __device__ __forceinline__ void operator()(const f32x4 (&acc)[2][2][4][2], const DenseUnit& u, int wr, int wc, int fr, int fq, const LAS float*) const {
#pragma unroll
        for (int bj = 0; bj < 2; ++bj) {
            int kind = 0, hb0 = 0;
            if (u.pn == 1) { kind = 1; hb0 = bj * 2; } else if (u.pn == 4 && bj == 1) { kind = 1; hb0 = 4; } else if (u.pn == 8 && bj == 0) { kind = 1; hb0 = 6; } else if (u.pn == 9 && bj == 0) { kind = 1; hb0 = 8; }
            else if (u.pn == 2) { kind = 2; hb0 = bj * 2; } else if (u.pn == 5 && bj == 0) { kind = 2; hb0 = 4; } else if (u.pn == 8 && bj == 1) { kind = 2; hb0 = 6; } else if (u.pn == 9 && bj == 1) { kind = 2; hb0 = 8; }
            const int c0 = wc * 32 + fq * 8;
            const int hh = hb0 + (c0 >> 6), d0 = c0 & 63;
#pragma unroll
            for (int ai = 0; ai < 2; ++ai)
#pragma unroll
                for (int m = 0; m < 4; ++m) {
                    const int row = u.pm * 256 + ai * 128 + wr * 64 + m * 16 + fr;
                    const f32x4 v0 = acc[ai][bj][m][0], v1 = acc[ai][bj][m][1];
                    u32x4 w; w.x = pack2(v0[0], v0[1]); w.y = pack2(v0[2], v0[3]); w.z = pack2(v1[0], v1[1]); w.w = pack2(v1[2], v1[3]);
                    if (kind == 0) *(u32x4*)(p->hb + (size_t)row * NMAIN + u.pn * 256 + bj * 128 + c0) = w;
                    else {
                        const int b = row >> 11, s = row & 2047, kk = s & 31;
                        bf16_t* blk = (kind == 1 ? p->kF : p->vT) + (((size_t)b * NVH + hh) * 64 + (s >> 5)) * 2048;
                        if (kind == 1) {
                            const int frk = (kk >> 3) * 4 + (kk & 3), t = (kk >> 2) & 1;
                            *(u32x4*)(blk + ((t * 2 + (d0 >> 5)) * 64 + ((d0 & 31) >> 3) * 16 + frk) * 8) = w;
                        } else {
                            const int kq = kk & 28;
                            const u32x2 t0 = quad_tr(w.x, w.y, fr), t1 = quad_tr(w.z, w.w, fr);
                            bf16_t* vt = blk + (((d0 >> 4) * 64) + (kq >> 3) * 16 + (d0 & 15) + (fr & 3)) * 8 + (kq & 7);
                            *(u32x2*)vt = t0; *(u32x2*)(vt + 32) = t1;
                        }
                    }
                }
        }
    }
};
struct EpiOutProj {
    const bf16_t* xin; float* t;
    __device__ __forceinline__ const float* bias_ptr(const DenseUnit&) const { return nullptr; }
    __device__ __forceinline__ void init(f32x4 (&acc)[2][2][4][2], int, int, const LAS float*) const {
#pragma unroll
        for (int ai = 0; ai < 2; ++ai)
#pragma unroll
            for (int bj = 0; bj < 2; ++bj)
#pragma unroll
                for (int m = 0; m < 4; ++m)
#pragma unroll
                    for (int n = 0; n < 2; ++n) acc[ai][bj][m][n] = (f32x4){0.f, 0.f, 0.f, 0.f};
    }
    __device__ __forceinline__ void operator()(const f32x4 (&acc)[2][2][4][2], const DenseUnit& u, int wr, int wc, int fr, int fq, const LAS float*) const {
#pragma unroll
        for (int ai = 0; ai < 2; ++ai)
#pragma unroll
            for (int m = 0; m < 4; ++m) {
                const size_t off = (size_t)(u.pm * 256 + ai * 128 + wr * 64 + m * 16 + fr) * DM + u.pn * 256 + wc * 64 + fq * 16;
                const u32x4 x0 = *(const u32x4*)(xin + off), x1 = *(const u32x4*)(xin + off + 8);
                const unsigned xs[8] = {x0.x, x0.y, x0.z, x0.w, x1.x, x1.y, x1.z, x1.w};
                unsigned w[8];
#pragma unroll
                for (int q = 0; q < 4; ++q) {
                    const f32x4 a = acc[ai][q >> 1][m][q & 1];
                    const float t0 = __uint_as_float(xs[2 * q] << 16) * ALPHA + a[0], t1 = __uint_as_float(xs[2 * q] & 0xffff0000u) * ALPHA + a[1];
                    const float t2 = __uint_as_float(xs[2 * q + 1] << 16) * ALPHA + a[2], t3 = __uint_as_float(xs[2 * q + 1] & 0xffff0000u) * ALPHA + a[3];
                    w[2 * q] = pack2(t0, t1); w[2 * q + 1] = pack2(t2, t3);
                }
                u32x4 w0, w1; w0.x = w[0]; w0.y = w[1]; w0.z = w[2]; w0.w = w[3]; w1.x = w[4]; w1.y = w[5]; w1.z = w[6]; w1.w = w[7];
                *(u32x4*)((bf16_t*)t + off) = w0; *(u32x4*)((bf16_t*)t + off + 8) = w1;
            }
    }
};
struct EpiGateUp {
    bf16_t* act; const float* bgup;
    __device__ __forceinline__ const float* bias_ptr(const MoeUnit& u) const { return bgup + (size_t)u.e * 2048 + u.pn * 256; }
    __device__ __forceinline__ void init(f32x4 (&acc)[2][2][4][2], int wc, int fq, const LAS float* bias) const {
#pragma unroll
        for (int bj = 0; bj < 2; ++bj)
#pragma unroll
            for (int n = 0; n < 2; ++n) {
                const f32x4 bv = *(const LAS f32x4*)(bias + bj * 128 + wc * 32 + n * 16 + 4 * fq);
#pragma unroll
                for (int ai = 0; ai < 2; ++ai)
#pragma unroll
                    for (int m = 0; m < 4; ++m) acc[ai][bj][m][n] = bv;
            }
    }
    __device__ __forceinline__ void operator()(const f32x4 (&acc)[2][2][4][2], const MoeUnit& u, int wr, int wc, int fr, int fq, const LAS float*) const {
        constexpr float GMIN = 7.0f * GATE_PRE, CI = 1.0f / GATE_PRE;
#pragma unroll
        for (int ai = 0; ai < 2; ++ai)
#pragma unroll
            for (int m = 0; m < 4; ++m) {
                u32x2 w;
#pragma unroll
                for (int n = 0; n < 2; ++n) {
                    const f32x4 g4 = acc[ai][0][m][n], u4 = acc[ai][1][m][n];
                    float o[4];
#pragma unroll
                    for (int j = 0; j < 4; ++j) {
                        const float gp = fmaxf(g4[j], GMIN), uu = fminf(fmaxf(u4[j], -7.0f), 7.0f);
                        const float glu = gp * __builtin_amdgcn_rcpf(1.0f + __builtin_amdgcn_exp2f(gp));
                        o[j] = __builtin_fmaf(uu, CI, CI) * glu;
                    }
                    const unsigned pk = pack4_fp8(o[0], o[1], o[2], o[3]);
                    if (n == 0) w.x = pk; else w.y = pk;
                }
                *(u32x2*)((char*)act + (size_t)(u.rbt * 256 + ai * 128 + wr * 64 + m * 16 + fr) * DFF + u.pn * 128 + wc * 32 + fq * 8) = w;
            }
    }
};
struct EpiDown {
    bf16_t* ybuf; const float* bdn;
    __device__ __forceinline__ const float* bias_ptr(const MoeUnit& u) const { return bdn + (size_t)u.e * 1024 + u.pn * 256; }
    __device__ __forceinline__ void init(f32x4 (&acc)[2][2][4][2], int wc, int fq, const LAS float* bias) const {
#pragma unroll
        for (int bj = 0; bj < 2; ++bj)
#pragma unroll
            for (int n = 0; n < 2; ++n) {
                const f32x4 bv = *(const LAS f32x4*)(bias + wc * 64 + fq * 16 + bj * 8 + n * 4);
#pragma unroll
                for (int ai = 0; ai < 2; ++ai)
#pragma unroll
                    for (int m = 0; m < 4; ++m) acc[ai][bj][m][n] = bv;
            }
    }
    __device__ __forceinline__ void operator()(const f32x4 (&acc)[2][2][4][2], const MoeUnit& u, int wr, int wc, int fr, int fq, const LAS float*) const {
#pragma unroll
        for (int ai = 0; ai < 2; ++ai)
#pragma unroll
            for (int m = 0; m < 4; ++m) {
                u32x4 w;
                { const f32x4 v = acc[ai][0][m][0]; w.x = pack4_fp8(v[0], v[1], v[2], v[3]); }
                { const f32x4 v = acc[ai][0][m][1]; w.y = pack4_fp8(v[0], v[1], v[2], v[3]); }
                { const f32x4 v = acc[ai][1][m][0]; w.z = pack4_fp8(v[0], v[1], v[2], v[3]); }
                { const f32x4 v = acc[ai][1][m][1]; w.w = pack4_fp8(v[0], v[1], v[2], v[3]); }
                *(u32x4*)((unsigned char*)ybuf + (size_t)(u.rbt * 256 + ai * 128 + wr * 64 + m * 16 + fr) * DM + u.pn * 256 + wc * 64 + fq * 16) = w;
            }
    }
};

__device__ __forceinline__ void phase_inproj(const Params& p, int l, char* lds) {
    DenseSched S{(const char*)p.WinQ + (size_t)l * NMAIN * 1024, 512, NTOK / 256, NMAIN / 256, vcu_id()};
    EpiInProj E{&p, l};
    pg8::gemm_phase<true, 0x7c7c7c7c>((LAS unsigned char*)lds, (const char*)p.xq, 512, S, E);
    int tid = threadIdx.x; asm volatile("" : "+v"(tid));
    const int wid = tid >> 6, lane = tid & 63, fr = lane & 15, fq = lane >> 4;
    const bf16_t* W = p.WinT + ((size_t)l * NPAD + NMAIN) * 1024;
    const float* bias = p.binp + l * NPAD + NMAIN;
    constexpr int WP = 2064;
#pragma unroll
    for (int i = 0; i < 8; ++i) { const int pc = wid * 8 + i, r = pc >> 1, q = pc & 1;
        __builtin_amdgcn_global_load_lds((const unsigned*)(W + (size_t)r * 1024 + q * 512 + lane * 8), (LAS unsigned*)((LAS char*)lds + r * WP + q * 1024), 16, 0, 0); }
    asm volatile("s_waitcnt vmcnt(0)" ::: "memory");
    __syncthreads();
    for (int u = blockIdx.x * NWV + wid; u < NTOK / 16; u += gridDim.x * NWV) {
        const bf16_t* ar = p.xb + (size_t)(u * 16 + fr) * DM + fq * 8;
        const LAS char* w0 = (const LAS char*)lds + fr * WP + fq * 16; const LAS char* w1 = w0 + 16 * WP;
        f32x4 a0 = (f32x4){0.f, 0.f, 0.f, 0.f}, a1 = a0;
#pragma unroll 4
        for (int ks = 0; ks < 32; ++ks) {
            const bf16x8 a = *(const bf16x8*)(ar + ks * 32);
            a0 = __builtin_amdgcn_mfma_f32_16x16x32_bf16(a, *(const LAS bf16x8*)(w0 + ks * 64), a0, 0, 0, 0);
            a1 = __builtin_amdgcn_mfma_f32_16x16x32_bf16(a, *(const LAS bf16x8*)(w1 + ks * 64), a1, 0, 0, 0);
        }
#pragma unroll
        for (int r = 0; r < 4; ++r) {
            float* dst = p.hs + (size_t)(u * 16 + fq * 4 + r) * HS_W;
            dst[fr] = a0[r] + bias[fr];
            if (fr < 6) dst[16 + fr] = a1[r] + bias[16 + fr];
        }
    }
}
__device__ __forceinline__ void phase_outproj(const Params& p, int l, const bf16_t* xin, char* lds) {
    DenseSched S{(const char*)p.WoT + (size_t)l * 1024 * 1024, 512, NTOK / 256, 4, vcu_id()};
    EpiOutProj E{xin, p.tbuf};
    pg8::gemm_phase<true, 0x7c7c7c7c>((LAS unsigned char*)lds, (const char*)p.ob, 512, S, E);
}
__device__ __forceinline__ void build_tiles(const Params& p, int l, int* ptile, int* ecnt) {
    int tid = threadIdx.x; asm volatile("" : "+v"(tid));
    if (tid < NE) ecnt[tid] = (int)__hip_atomic_load(p.ctrl + 64 + l * NE + tid, __ATOMIC_RELAXED, __HIP_MEMORY_SCOPE_AGENT);
    __syncthreads();
    if (tid == 0) { int s = 0; for (int e = 0; e < NE; ++e) { ptile[e] = s; s += (ecnt[e] + 255) >> 8; } ptile[NE] = s; }
    __syncthreads();
    unsigned char* texp = (unsigned char*)ptile + 512;
    for (int t = tid; t < ptile[NE]; t += NTHR) { int e = 0; while (ptile[e + 1] <= t) ++e; texp[t] = (unsigned char)e; }
    __syncthreads();
}
__device__ __forceinline__ void phase_gateup(const Params& p, int l, char* lds) {
    int* ptile = (int*)(lds + LDS_TAB); int* ecnt = ptile + 40;
    build_tiles(p, l, ptile, ecnt);
    MoeSched<true> S{(const char*)p.WguT + (size_t)l * NE * 2048 * 1024, p.lists, ptile, ecnt, 8, 2048, vcu_id()};
    EpiGateUp E{p.act, p.bgup + (size_t)l * NE * 2048};
    pg8::gemm_phase<true, 0x7c7c7c7c>((LAS unsigned char*)lds, (const char*)p.x1b, 512, S, E);
}
__device__ __forceinline__ void phase_down(const Params& p, int l, char* lds) {
    int* ptile = (int*)(lds + LDS_TAB); int* ecnt = ptile + 40;
    MoeSched<false> S{(const char*)p.WdnT + (size_t)l * NE * 1024 * 1024, p.lists, ptile, ecnt, 4, 1024, vcu_id()};
    EpiDown E{p.ybuf, p.b_dn + (size_t)l * NE * 1024};
    pg8::gemm_phase<true, 0x7c7c7c7c>((LAS unsigned char*)lds, (const char*)p.act, 512, S, E);
}

__device__ __forceinline__ float gelu_tanh(float x) {
    const float u = 0.7978845608028654f * (x + 0.044715f * x * x * x);
    const float e = __expf(-2.0f * fabsf(u)); const float th = (1.0f - e) / (1.0f + e);
    return 0.5f * x * (1.0f + (u < 0.f ? -th : th));
}
__device__ __forceinline__ void phase_prep(const Params& p, int l, char* lds) {
    int tid = threadIdx.x; asm volatile("" : "+v"(tid));
    const int wid = tid >> 6, lane = tid & 63, fr = lane & 15, fq = lane >> 4;
    const int gw = blockIdx.x * NWV + wid, nw = gridDim.x * NWV;
    for (int u = (int)gridDim.x - 1 - (int)blockIdx.x; u < NB * 4; u += gridDim.x) {
        const int b = u >> 2, h = u & 3;
        const float* srcp = p.hs + ((size_t)b * SEQ + tid * 4) * HS_W + h;
        float ls[4]; float tot = 0.f;
#pragma unroll
        for (int i = 0; i < 4; ++i) { const float f = srcp[(size_t)i * HS_W]; ls[i] = fminf(f, 0.f) - log1pf(__expf(-fabsf(f))); tot += ls[i]; }
        float inc = tot;
#pragma unroll
        for (int o = 1; o < 64; o <<= 1) { const float v = shfl_f(inc, lane - o); if (lane >= o) inc += v; }
        float* wtot = (float*)(lds + 65536);
        if (lane == 63) wtot[wid] = inc;
        __syncthreads();
        float base = inc - tot;
        for (int w = 0; w < wid; ++w) base += wtot[w];
        float4 o4; o4.x = base + ls[0]; o4.y = o4.x + ls[1]; o4.z = o4.y + ls[2]; o4.w = o4.z + ls[3];
        *(float4*)(p.cF + (size_t)u * SEQ + tid * 4) = o4;
        __syncthreads();
    }
    float* part = (float*)lds;
    bf16_t* h1 = (bf16_t*)(lds + 32768);
    for (int u = blockIdx.x; u < NB * 2 * 2 * 8; u += gridDim.x) {
        const int ct = u & 7, which = (u >> 3) & 1, kvh = (u >> 4) & 1, b = u >> 5;
        const int colo = (which ? C_NVC : C_NKC) + kvh * 64;
        const int c_lane = ct * 16 + fr;
        const int tokbase = min(c_lane, 126) * 16;
        const bf16_t* arow = p.hb + ((size_t)b * SEQ + tokbase) * NMAIN + colo + fq * 8;
        const bf16_t* w1 = p.W1T + ((size_t)(l * 2 + which) * 64 + fr) * 2048 + fq * 8;
        f32x4 acc[4];
#pragma unroll
        for (int n = 0; n < 4; ++n) acc[n] = (f32x4){0.f, 0.f, 0.f, 0.f};
#pragma unroll
        for (int kk = 0; kk < 8; ++kk) {
            const int ks = wid * 8 + kk;
            const bf16x8 a = *(const bf16x8*)(arow + (size_t)(ks >> 1) * NMAIN + (ks & 1) * 32);
#pragma unroll
            for (int n = 0; n < 4; ++n) {
                const bf16x8 bb = *(const bf16x8*)(w1 + (size_t)n * 16 * 2048 + ks * 32);
                acc[n] = __builtin_amdgcn_mfma_f32_16x16x32_bf16(a, bb, acc[n], 0, 0, 0);
            }
        }
#pragma unroll
        for (int n = 0; n < 4; ++n)
#pragma unroll
            for (int r = 0; r < 4; ++r) part[wid * 1024 + (fq * 4 + r) * 64 + n * 16 + fr] = acc[n][r];
        __syncthreads();
        const float* b1 = p.b1c + (l * 2 + which) * 8 * 64;
#pragma unroll
        for (int i = 0; i < 2; ++i) {
            const int e = tid + NTHR * i; float sum = 0.f, bsum = 0.f;
#pragma unroll
            for (int w = 0; w < 8; ++w) { sum += part[w * 1024 + e]; bsum += b1[w * 64 + (e & 63)]; }
            h1[e] = f2bf(gelu_tanh(sum + bsum));
        }
        __syncthreads();
        if (wid == 0) {
            const bf16_t* w2 = p.W2T + ((size_t)(l * 2 + which) * 64 + fr) * 64 + fq * 8;
            f32x4 o2[4];
#pragma unroll
            for (int n = 0; n < 4; ++n) o2[n] = (f32x4){0.f, 0.f, 0.f, 0.f};
#pragma unroll
            for (int ks = 0; ks < 2; ++ks) {
                const bf16x8 a = *(const bf16x8*)(h1 + fr * 64 + ks * 32 + fq * 8);
#pragma unroll
                for (int n = 0; n < 4; ++n) {
                    const bf16x8 bb = *(const bf16x8*)(w2 + (size_t)n * 16 * 64 + ks * 32);
                    o2[n] = __builtin_amdgcn_mfma_f32_16x16x32_bf16(a, bb, o2[n], 0, 0, 0);
                }
            }
            const size_t base = ((size_t)b * 2 + kvh) * 128 * 64;
#pragma unroll
            for (int n = 0; n < 4; ++n)
#pragma unroll
                for (int r = 0; r < 4; ++r) {
                    const int c = ct * 16 + fq * 4 + r, j2 = n * 16 + fr;
                    const bf16_t v = c < 127 ? f2bf(o2[n][r]) : (bf16_t)0;
                    if (which == 0) p.kc[base + (size_t)c * 64 + j2] = v;
                    else { p.vc[base + (size_t)c * 64 + j2] = v; p.vcT[base + (size_t)j2 * 128 + c] = v; }
                }
        }
        __syncthreads();
    }
}

constexpr float L2E = 1.4426950408889634f, MASKV = -__builtin_huge_valf(), MINIT = -1e30f, SCL2 = QSCALE * L2E;
struct KVFrag { bf16x8 k[2][2]; bf16x8 v[4]; };
template <bool FM>
__device__ __forceinline__ void k_load(KVFrag& f, const bf16_t* __restrict__ Kb, size_t ldk, int kc0, int fr, int fq) {
    if (FM) {
        const bf16_t* kp = Kb + (size_t)(kc0 >> 5) * 2048 + (fq * 16 + fr) * 8;
        f.k[0][0] = *(const bf16x8*)(kp); f.k[0][1] = *(const bf16x8*)(kp + 512); f.k[1][0] = *(const bf16x8*)(kp + 1024); f.k[1][1] = *(const bf16x8*)(kp + 1536);
    } else {
        const bf16_t* kp = Kb + (size_t)(kc0 + (fr >> 2) * 8 + (fr & 3)) * ldk + fq * 8;
        f.k[0][0] = *(const bf16x8*)(kp); f.k[0][1] = *(const bf16x8*)(kp + 32);
        f.k[1][0] = *(const bf16x8*)(kp + 4 * ldk); f.k[1][1] = *(const bf16x8*)(kp + 4 * ldk + 32);
    }
}
template <bool FM>
__device__ __forceinline__ void v_load(bf16x8 (&v)[4], const bf16_t* __restrict__ VTb, size_t ldv, int kc0, int fr, int fq) {
    if (FM) {
        const bf16_t* vp = VTb + (size_t)(kc0 >> 5) * 2048 + (fq * 16 + fr) * 8;
#pragma unroll
        for (int dt = 0; dt < 4; ++dt) v[dt] = *(const bf16x8*)(vp + dt * 512);
    } else {
        const bf16_t* vp = VTb + (size_t)fr * ldv + kc0 + fq * 8;
#pragma unroll
        for (int dt = 0; dt < 4; ++dt) v[dt] = *(const bf16x8*)(vp + (size_t)dt * 16 * ldv);
    }
}
__device__ __forceinline__ float rowmax4(float x) {
    auto r = __builtin_amdgcn_permlane32_swap(__float_as_uint(x), __float_as_uint(x), false, false);
    x = fmaxf(__uint_as_float(r[0]), __uint_as_float(r[1]));
    auto q = __builtin_amdgcn_permlane16_swap(__float_as_uint(x), __float_as_uint(x), false, false);
    return fmaxf(__uint_as_float(q[0]), __uint_as_float(q[1]));
}
__device__ __forceinline__ float rowsum4(float x) {
    auto r = __builtin_amdgcn_permlane32_swap(__float_as_uint(x), __float_as_uint(x), false, false);
    x = __uint_as_float(r[0]) + __uint_as_float(r[1]);
    auto q = __builtin_amdgcn_permlane16_swap(__float_as_uint(x), __float_as_uint(x), false, false);
    return __uint_as_float(q[0]) + __uint_as_float(q[1]);
}
template <int NQT, bool MASK, class MB>
__device__ __forceinline__ void attn_compute(const KVFrag& f, const bf16x8 (&qf)[NQT][2], f32x4 (&o)[NQT][4], float (&m)[NQT], float (&l)[NQT], const MB& mb) {
    f32x4 s0[NQT], s1[NQT];
#pragma unroll
    for (int qt = 0; qt < NQT; ++qt) {
        s0[qt] = __builtin_amdgcn_mfma_f32_16x16x32_bf16(f.k[0][0], qf[qt][0], (f32x4){0.f, 0.f, 0.f, 0.f}, 0, 0, 0);
        s1[qt] = __builtin_amdgcn_mfma_f32_16x16x32_bf16(f.k[1][0], qf[qt][0], (f32x4){0.f, 0.f, 0.f, 0.f}, 0, 0, 0);
    }
#pragma unroll
    for (int qt = 0; qt < NQT; ++qt) {
        s0[qt] = __builtin_amdgcn_mfma_f32_16x16x32_bf16(f.k[0][1], qf[qt][1], s0[qt], 0, 0, 0);
        s1[qt] = __builtin_amdgcn_mfma_f32_16x16x32_bf16(f.k[1][1], qf[qt][1], s1[qt], 0, 0, 0);
    }
    float mx[NQT];
#pragma unroll
    for (int qt = 0; qt < NQT; ++qt) {
#pragma unroll
        for (int j = 0; j < 4; ++j) { s0[qt][j] = mb(qt, j, s0[qt][j]); s1[qt][j] = mb(qt, j + 4, s1[qt][j]); }
        mx[qt] = fmaxf(fmaxf(fmaxf(s0[qt][0], s0[qt][1]), fmaxf(s0[qt][2], s0[qt][3])), fmaxf(fmaxf(s1[qt][0], s1[qt][1]), fmaxf(s1[qt][2], s1[qt][3])));
    }
#pragma unroll
    for (int qt = 0; qt < NQT; ++qt) mx[qt] = rowmax4(mx[qt]);
    bool moved = false;
#pragma unroll
    for (int qt = 0; qt < NQT; ++qt) { mx[qt] = fmaxf(m[qt], mx[qt]); moved |= (mx[qt] != m[qt]); }
    if (__ballot(moved) != 0ull) {
#pragma unroll
        for (int qt = 0; qt < NQT; ++qt) {
            const float alpha = __builtin_amdgcn_exp2f(m[qt] - mx[qt]);
            l[qt] *= alpha;
#pragma unroll
            for (int dt = 0; dt < 4; ++dt) o[qt][dt] *= alpha;
        }
    }
    bf16x8 pf[NQT];
#pragma unroll
    for (int qt = 0; qt < NQT; ++qt) {
        m[qt] = mx[qt];
        float pr[8]; float ps = 0.f;
#pragma unroll
        for (int j = 0; j < 4; ++j) {
            pr[j] = __builtin_amdgcn_exp2f(s0[qt][j] - mx[qt]);
            pr[j + 4] = __builtin_amdgcn_exp2f(s1[qt][j] - mx[qt]);
        }
#pragma unroll
        for (int j = 0; j < 8; ++j) ps += pr[j];
        l[qt] += ps;
        const u32x4 pk = {pack2(pr[0], pr[1]), pack2(pr[2], pr[3]), pack2(pr[4], pr[5]), pack2(pr[6], pr[7])};
        pf[qt] = __builtin_bit_cast(bf16x8, pk);
    }
#pragma unroll
    for (int dt = 0; dt < 4; ++dt)
#pragma unroll
        for (int qt = 0; qt < NQT; ++qt) o[qt][dt] = __builtin_amdgcn_mfma_f32_16x16x32_bf16(f.v[dt], pf[qt], o[qt][dt], 0, 0, 0);
    __builtin_amdgcn_sched_barrier(0);
}
struct RangeIt { int c, c_hi; __device__ __forceinline__ int nxt() { if (c > c_hi) return -1; return (c++) * 32; } };
struct MaskIt { unsigned long long cm; __device__ __forceinline__ int nxt() { if (!cm) return -1; const int i = __builtin_ctzll(cm); cm &= cm - 1; return i * 32; } };
template <bool PFV, bool FM, class It, class Gen>
__device__ __forceinline__ void attn_run(It& it, const bf16_t* Kb, size_t ldk, const bf16_t* VTb, size_t ldv, int fr, int fq, const Gen& gen) {
    KVFrag fa, fb;
    int ka = it.nxt(); if (ka < 0) return;
    k_load<FM>(fa, Kb, ldk, ka, fr, fq); if (PFV) v_load<FM>(fa.v, VTb, ldv, ka, fr, fq);
    for (;;) {
        const int kb = it.nxt(); if (kb >= 0) { k_load<FM>(fb, Kb, ldk, kb, fr, fq); if (PFV) v_load<FM>(fb.v, VTb, ldv, kb, fr, fq); }
        if (!PFV) v_load<FM>(fa.v, VTb, ldv, ka, fr, fq);
        gen(ka, fa);
        if (kb < 0) break;
        ka = it.nxt(); if (ka >= 0) { k_load<FM>(fa, Kb, ldk, ka, fr, fq); if (PFV) v_load<FM>(fa.v, VTb, ldv, ka, fr, fq); }
        if (!PFV) v_load<FM>(fb.v, VTb, ldv, kb, fr, fq);
        gen(kb, fb);
        if (ka < 0) break;
    }
}
template <int NQT>
__device__ __forceinline__ void attn_init(f32x4 (&o)[NQT][4], float (&m)[NQT], float (&l)[NQT]) {
#pragma unroll
    for (int qt = 0; qt < NQT; ++qt) { m[qt] = MINIT; l[qt] = 0.f;
#pragma unroll
        for (int dt = 0; dt < 4; ++dt) o[qt][dt] = (f32x4){0.f, 0.f, 0.f, 0.f}; }
}
__device__ __forceinline__ float lsum4(float l) { return rowsum4(l); }
__device__ __forceinline__ void store_o16(unsigned char* dst, const f32x4 v0, const f32x4 v1, const f32x4 v2, const f32x4 v3) {
    u32x4 w; w.x = pack4_fp8(v0[0], v0[1], v0[2], v0[3]); w.y = pack4_fp8(v1[0], v1[1], v1[2], v1[3]); w.z = pack4_fp8(v2[0], v2[1], v2[2], v2[3]); w.w = pack4_fp8(v3[0], v3[1], v3[2], v3[3]);
    *(u32x4*)dst = w;
}
__device__ __forceinline__ float sigmoidf_fast(float x) { return __builtin_amdgcn_rcpf(1.0f + __builtin_amdgcn_exp2f(-L2E * x)); }

__device__ __forceinline__ void fox_unit(const Params& p, int b, int h, int qb, int fr, int fq) {
    asm volatile("" : "+v"(fr), "+v"(fq));
    const int t0 = qb * 64;
    const bf16_t* Qb = p.hb + ((size_t)b * SEQ + t0) * NMAIN + C_FQ + h * 64 + fq * 8;
    bf16x8 qf[4][2];
#pragma unroll
    for (int qt = 0; qt < 4; ++qt) { qf[qt][0] = *(const bf16x8*)(Qb + (size_t)(qt * 16 + fr) * NMAIN); qf[qt][1] = *(const bf16x8*)(Qb + (size_t)(qt * 16 + fr) * NMAIN + 32); }
    const float* cf = p.cF + ((size_t)b * 4 + h) * SEQ;
    float cq[4];
#pragma unroll
    for (int qt = 0; qt < 4; ++qt) cq[qt] = cf[t0 + qt * 16 + fr] * L2E;
    f32x4 o[4][4]; float m[4], l[4];
    attn_init<4>(o, m, l);
    const bf16_t* Kb = p.kF + ((size_t)b * NVH + h) * 64 * SEQ;
    const bf16_t* VTb = p.vT + ((size_t)b * NVH + h) * 64 * SEQ;
    RangeIt it{0, (t0 >> 5) + 1};
    attn_run<false, true>(it, Kb, NMAIN, VTb, SEQ, fr, fq, [&](int kc0, const KVFrag& f) {
        const float4 ca = *(const float4*)(cf + kc0 + 8 * fq), cb = *(const float4*)(cf + kc0 + 8 * fq + 4);
        const float ck[8] = {ca.x * L2E, ca.y * L2E, ca.z * L2E, ca.w * L2E, cb.x * L2E, cb.y * L2E, cb.z * L2E, cb.w * L2E};
        const int kq = kc0 + 8 * fq - t0 - fr;
        attn_compute<4, true>(f, qf, o, m, l, [&](int qt, int j, float raw) { return (kq + j - 16 * qt) > 0 ? MASKV : raw * SCL2 + cq[qt] - ck[j]; });
    });
#pragma unroll
    for (int qt = 0; qt < 4; ++qt) {
        const float inv = __builtin_amdgcn_rcpf(lsum4(l[qt]));
        unsigned char* dst = (unsigned char*)p.ob + ((size_t)b * SEQ + t0 + qt * 16 + fr) * DM + h * 64 + 16 * fq;
        store_o16(dst, o[qt][0] * inv, o[qt][1] * inv, o[qt][2] * inv, o[qt][3] * inv);
    }
}
__device__ __forceinline__ void swa_unit(const Params& p, int l_, int b, int kv, int pos, int fr, int fq) {
    asm volatile("" : "+v"(fr), "+v"(fq));
    const int t0 = pos * 16, t = t0 + fr;
    const bf16_t* Qb = p.hb + ((size_t)b * SEQ + t) * NMAIN + C_SQ + kv * 192 + fq * 8;
    bf16x8 qf[3][2];
#pragma unroll
    for (int g = 0; g < 3; ++g) { qf[g][0] = *(const bf16x8*)(Qb + g * 64); qf[g][1] = *(const bf16x8*)(Qb + g * 64 + 32); }
    float sl[3];
#pragma unroll
    for (int g = 0; g < 3; ++g) sl[g] = slope_swa(kv * 3 + g) * L2E;
    f32x4 o[3][4]; float m[3], l[3];
    attn_init<3>(o, m, l);
    const bf16_t* Kb = p.kF + ((size_t)b * NVH + 4 + kv) * 64 * SEQ;
    const bf16_t* VTb = p.vT + ((size_t)b * NVH + 4 + kv) * 64 * SEQ;
    RangeIt it{max(0, t0 - 127) >> 5, (t0 + 15) >> 5};
    attn_run<true, true>(it, Kb, NMAIN, VTb, SEQ, fr, fq, [&](int kc0, const KVFrag& f) {
        const int dq = t - kc0 - 8 * fq;
        attn_compute<3, true>(f, qf, o, m, l, [&](int g, int j, float raw) { const int dist = dq - j; return ((unsigned)dist < 128u) ? raw * SCL2 - sl[g] * (float)dist : MASKV; });
    });
#pragma unroll
    for (int g = 0; g < 3; ++g) {
        const float sink = p.sinks[l_ * 6 + kv * 3 + g] * L2E;
        const float inv = __builtin_amdgcn_rcpf(lsum4(l[g]) + __builtin_amdgcn_exp2f(sink - m[g]));
        unsigned char* dst = (unsigned char*)p.ob + ((size_t)b * SEQ + t) * DM + 256 + (kv * 3 + g) * 64 + 16 * fq;
        store_o16(dst, o[g][0] * inv, o[g][1] * inv, o[g][2] * inv, o[g][3] * inv);
    }
}
__device__ __forceinline__ void nsa_unit(const Params& p, int b, int kv, int pos, int fr, int fq, int lane, float* ps, unsigned* msk, float* otl) {
    asm volatile("" : "+v"(fr), "+v"(fq), "+v"(lane));
    const int t0 = pos * 16, t = t0 + fr, cur = t0 >> 6;
    const bf16_t* Qb = p.hb + ((size_t)b * SEQ + t) * NMAIN + C_NQ + kv * 192 + fq * 8;
    bf16x8 qf[3][2];
#pragma unroll
    for (int g = 0; g < 3; ++g) { qf[g][0] = *(const bf16x8*)(Qb + g * 64); qf[g][1] = *(const bf16x8*)(Qb + g * 64 + 32); }
    float sl[3];
#pragma unroll
    for (int g = 0; g < 3; ++g) sl[g] = slope_nsa(kv * 3 + g) * L2E;
    const float* gl = p.hs + ((size_t)b * SEQ + t) * HS_W + 4 + kv * 9;
    f32x4 o[3][4]; float m[3], l[3];
    f32x4* otv = (f32x4*)otl + lane;
#pragma unroll
    for (int i = 0; i < 8; ++i) ps[lane + 64 * i] = 0.f;
    {
        const bf16_t* Kb = p.kc + ((size_t)b * 2 + kv) * 128 * 64;
        const bf16_t* VTb = p.vcT + ((size_t)b * 2 + kv) * 64 * 128;
        const int ncv = (t0 + 15 >= 31) ? ((t0 + 15 - 31) >> 4) + 1 : 0;
        const int nch = (ncv + 31) >> 5;
        attn_init<3>(o, m, l);
        const int dq0 = t - 31 - 16 * 8 * fq;
        RangeIt it{0, nch - 1};
        attn_run<false, false>(it, Kb, 64, VTb, 128, fr, fq, [&](int kc0, const KVFrag& f) {
            const int dq = dq0 - 16 * kc0;
            attn_compute<3, true>(f, qf, o, m, l, [&](int g, int j, float raw) { const int dist = dq - 16 * j; return dist >= 0 ? raw * SCL2 - sl[g] * (float)dist : MASKV; });
        });
        float il[3];
#pragma unroll
        for (int g = 0; g < 3; ++g) {
            const float lt = lsum4(l[g]); il[g] = lt > 0.f ? __builtin_amdgcn_rcpf(lt) : 0.f;
            const float gate = sigmoidf_fast(gl[g * 3 + 0]);
#pragma unroll
            for (int dt = 0; dt < 4; ++dt) otv[(g * 4 + dt) * 64] = o[g][dt] * (il[g] * gate);
        }
        float carry_prev = 0.f;
        for (int c = 0; c < nch; ++c) {
            const int kc0 = c * 32, dq = dq0 - 16 * kc0;
            const bf16_t* kp = Kb + (size_t)(kc0 + (fr >> 2) * 8 + (fr & 3)) * 64 + fq * 8;
            const bf16x8 k00 = *(const bf16x8*)(kp), k01 = *(const bf16x8*)(kp + 32), k10 = *(const bf16x8*)(kp + 256), k11 = *(const bf16x8*)(kp + 256 + 32);
            float pc[8];
#pragma unroll
            for (int j = 0; j < 8; ++j) pc[j] = 0.f;
#pragma unroll
            for (int g = 0; g < 3; ++g) {
                f32x4 s0 = (f32x4){0.f, 0.f, 0.f, 0.f}, s1 = s0;
                s0 = __builtin_amdgcn_mfma_f32_16x16x32_bf16(k00, qf[g][0], s0, 0, 0, 0); s0 = __builtin_amdgcn_mfma_f32_16x16x32_bf16(k01, qf[g][1], s0, 0, 0, 0);
                s1 = __builtin_amdgcn_mfma_f32_16x16x32_bf16(k10, qf[g][0], s1, 0, 0, 0); s1 = __builtin_amdgcn_mfma_f32_16x16x32_bf16(k11, qf[g][1], s1, 0, 0, 0);
#pragma unroll
                for (int j = 0; j < 8; ++j) {
                    const int dist = dq - 16 * j; const float raw = j < 4 ? s0[j] : s1[j - 4];
                    if (dist >= 0) pc[j] += __builtin_amdgcn_exp2f(raw * SCL2 - sl[g] * (float)dist - m[g]) * il[g];
                }
            }
            const float cout = 0.5f * pc[7];
            float cin = shfl_f(cout, lane - 16);
            const float cwrap = shfl_f(cout, fr + 48);
            if (fq == 0) cin = carry_prev;
            carry_prev = cwrap;
            const int n0 = (kc0 >> 2) + 2 * fq;
            ps[fr * 32 + n0] = cin + pc[0] + pc[1] + pc[2] + 0.5f * pc[3];
            ps[fr * 32 + n0 + 1] = 0.5f * pc[3] + pc[4] + pc[5] + pc[6] + 0.5f * pc[7];
        }
    }
    lds_wave_sync();
    if (lane < 16) {
        unsigned mask = 1u | (1u << cur); if (cur >= 1) mask |= 1u << (cur - 1);
        if (cur >= 3) {
            if (cur - 2 <= 5) mask |= (1u << (cur - 1)) - 2u;
            else {
                const float* my = ps + lane * 32;
                for (int r = 0; r < 5; ++r) {
                    float best = -1.0f; int bi = 1;
                    for (int j = 1; j <= cur - 2; ++j) { const float v = my[j]; if (!((mask >> j) & 1u) && v > best) { best = v; bi = j; } }
                    mask |= 1u << bi;
                }
            }
        }
        msk[lane] = mask;
    }
    lds_wave_sync();
    const unsigned qmask = msk[fr];
    lds_wave_sync();
    {
        const bf16_t* Kb = p.kF + ((size_t)b * NVH + 6 + kv) * 64 * SEQ;
        const bf16_t* VTb = p.vT + ((size_t)b * NVH + 6 + kv) * 64 * SEQ;
        attn_init<3>(o, m, l);
        unsigned um = qmask;
        um |= shfl_u(um, lane ^ 1); um |= shfl_u(um, lane ^ 2); um |= shfl_u(um, lane ^ 4); um |= shfl_u(um, lane ^ 8);
        um = (unsigned)__builtin_amdgcn_readfirstlane((int)um) & (cur >= 31 ? 0xffffffffu : ((2u << cur) - 1u));
        unsigned long long cm = 0ull;
        for (unsigned r = um; r; r &= r - 1) { const int kb = __builtin_ctz(r); cm |= 3ull << (2 * kb); }
        MaskIt it{cm};
        attn_run<true, true>(it, Kb, NMAIN, VTb, SEQ, fr, fq, [&](int kc0, const KVFrag& f) {
            const bool mine = (qmask >> (kc0 >> 6)) & 1u;
            const int dq = t - kc0 - 8 * fq;
            attn_compute<3, true>(f, qf, o, m, l, [&](int g, int j, float raw) { const int dist = dq - j; return (mine && dist >= 0) ? raw * SCL2 - sl[g] * (float)dist : MASKV; });
        });
#pragma unroll
        for (int g = 0; g < 3; ++g) {
            const float lt = lsum4(l[g]); const float sc = (lt > 0.f ? __builtin_amdgcn_rcpf(lt) : 0.f) * sigmoidf_fast(gl[g * 3 + 1]);
#pragma unroll
            for (int dt = 0; dt < 4; ++dt) otv[(g * 4 + dt) * 64] += o[g][dt] * sc;
        }
    }
    {
        const bf16_t* Kb = p.kF + ((size_t)b * NVH + 8 + kv) * 64 * SEQ;
        const bf16_t* VTb = p.vT + ((size_t)b * NVH + 8 + kv) * 64 * SEQ;
        attn_init<3>(o, m, l);
        RangeIt it{max(0, t0 - 511) >> 5, (t0 + 15) >> 5};
        attn_run<true, true>(it, Kb, NMAIN, VTb, SEQ, fr, fq, [&](int kc0, const KVFrag& f) {
            const int dq = t - kc0 - 8 * fq;
            attn_compute<3, true>(f, qf, o, m, l, [&](int g, int j, float raw) { const int dist = dq - j; return ((unsigned)dist < 512u) ? raw * SCL2 - sl[g] * (float)dist : MASKV; });
        });
#pragma unroll
        for (int g = 0; g < 3; ++g) {
            const float lt = lsum4(l[g]); const float sc = (lt > 0.f ? __builtin_amdgcn_rcpf(lt) : 0.f) * sigmoidf_fast(gl[g * 3 + 2]);
            unsigned char* dst = (unsigned char*)p.ob + ((size_t)b * SEQ + t) * DM + 640 + (kv * 3 + g) * 64 + 16 * fq;
            store_o16(dst, otv[(g * 4 + 0) * 64] + o[g][0] * sc, otv[(g * 4 + 1) * 64] + o[g][1] * sc, otv[(g * 4 + 2) * 64] + o[g][2] * sc, otv[(g * 4 + 3) * 64] + o[g][3] * sc);
        }
    }
}

template <bool WITH_CONV>
__device__ __forceinline__ void phase_attn(const Params& p, int l, char* lds, int cslot = 16) {
    int tid = threadIdx.x; asm volatile("" : "+v"(tid));
    const int wid = tid >> 6, lane = tid & 63, fr = lane & 15, fq = lane >> 4;
    float* ps = (float*)(lds + wid * 16896); unsigned* msk = (unsigned*)(ps + 512); float* otl = ps + 576;
    unsigned* ctr = p.ctrl + cslot + l;
    constexpr unsigned NU_NSA = NB * 2 * 128, NU_FOX = NB * 4 * 32, NU_SWA = NB * 2 * 128, NU_ATT = NU_NSA + NU_FOX + NU_SWA;
    for (;;) {
        unsigned u = 0;
        if (lane == 0) u = __hip_atomic_fetch_add(ctr, 1u, __ATOMIC_RELAXED, __HIP_MEMORY_SCOPE_AGENT);
        u = (unsigned)__builtin_amdgcn_readfirstlane((int)u);
        if (WITH_CONV) {
            constexpr unsigned TOTQ = NU_ATT + (unsigned)CONV_TILES;
            if (u >= TOTQ) break;
            const unsigned a0 = (unsigned)(((unsigned long long)u * NU_ATT) / TOTQ), a1 = (unsigned)(((unsigned long long)(u + 1) * NU_ATT) / TOTQ);
            if (a1 == a0) { conv_tile_wave(p, (int)(u - a0), lane, (unsigned char*)ps); continue; }
            u = a0;
        } else {
#ifndef ATT_REP
#define ATT_REP 1
#endif
            if (u >= ATT_REP * NU_ATT) break;
            if (ATT_REP > 1) u %= NU_ATT;
        }
        if (u < NU_NSA) { const int pos = 127 - (int)(u & 127), r = u >> 7; nsa_unit(p, r >> 1, r & 1, pos, fr, fq, lane, ps, msk, otl); }
        else if (u < NU_NSA + NU_FOX) { const unsigned v = u - NU_NSA; const int qb = 31 - (int)(v & 31), r = v >> 5; fox_unit(p, r >> 2, r & 3, qb, fr, fq); }
        else { const unsigned v = u - NU_NSA - NU_FOX; const int pos = 127 - (int)(v & 127), r = v >> 7; swa_unit(p, l, r >> 1, r & 1, pos, fr, fq); }
    }
}

__device__ __forceinline__ void phase_ln1_router(const Params& p, int l, char* lds) {
    int tid = threadIdx.x; asm volatile("" : "+v"(tid));
    const int wid = tid >> 6, lane = tid & 63, fr = lane & 15, fq = lane >> 4;
    float* lg = (float*)lds + wid * 512;
    int* lcnt = (int*)(lds + 16384); int* lbase = lcnt + 32;
    const float* g1 = p.ln1_g + l * DM; const float* b1 = p.ln1_b + l * DM;
    const float* rw = p.rwT + (size_t)l * NE * 1024; const float* rb = p.router_b + l * NE;
    unsigned* gcount = p.ctrl + 64 + l * NE;
    constexpr int RW_LDS = 20480, RW_PITCH = 2064;
    if (blockIdx.x < NTOK / 128) {
        const bf16_t* rwb = (const bf16_t*)p.rwT + (size_t)l * 64 * 1024;
#pragma unroll 4
        for (int i = 0; i < 16; ++i) { const int pc = wid * 16 + i, r = pc >> 1, q = pc & 1;
            __builtin_amdgcn_global_load_lds((const unsigned*)(rwb + (size_t)r * 1024 + q * 512 + lane * 8), (LAS unsigned*)((LAS char*)lds + RW_LDS + r * RW_PITCH + q * 1024), 16, 0, 0); }
    }
    for (int grp = blockIdx.x; grp < NTOK / 128; grp += gridDim.x) {
        const int tok0 = grp * 128 + wid * 16;
        if (tid < 32) lcnt[tid] = 0;
        float gg[16], bb[16];
#pragma unroll
        for (int j = 0; j < 4; ++j) { const float4 g4 = *(const float4*)(g1 + lane * 16 + j * 4), b4 = *(const float4*)(b1 + lane * 16 + j * 4);
            gg[4 * j] = g4.x; gg[4 * j + 1] = g4.y; gg[4 * j + 2] = g4.z; gg[4 * j + 3] = g4.w; bb[4 * j] = b4.x; bb[4 * j + 1] = b4.y; bb[4 * j + 2] = b4.z; bb[4 * j + 3] = b4.w; }
        u32x4 raw[8][2];
#pragma unroll
        for (int i = 0; i < 8; ++i) { const bf16_t* tr = (const bf16_t*)p.tbuf + (size_t)(tok0 + i) * DM + lane * 16; raw[i][0] = *(const u32x4*)tr; raw[i][1] = *(const u32x4*)(tr + 8); }
#pragma unroll
        for (int r0 = 0; r0 < 16; r0 += 4) {
            float v[4][16]; float s[4], qv[4];
#pragma unroll
            for (int i = 0; i < 4; ++i) {
                const u32x4 t0 = raw[(r0 + i) % 8][0], t1 = raw[(r0 + i) % 8][1];
                if (r0 < 8) { const bf16_t* tr = (const bf16_t*)p.tbuf + (size_t)(tok0 + r0 + 8 + i) * DM + lane * 16; raw[(r0 + i) % 8][0] = *(const u32x4*)tr; raw[(r0 + i) % 8][1] = *(const u32x4*)(tr + 8); }
                const unsigned ts[8] = {t0.x, t0.y, t0.z, t0.w, t1.x, t1.y, t1.z, t1.w};
#pragma unroll
                for (int c = 0; c < 8; ++c) { v[i][2 * c] = __uint_as_float(ts[c] << 16); v[i][2 * c + 1] = __uint_as_float(ts[c] & 0xffff0000u); }
            }
#pragma unroll
            for (int i = 0; i < 4; ++i) { s[i] = 0.f;
#pragma unroll
                for (int c = 0; c < 16; c += 4) s[i] += (v[i][c] + v[i][c + 1]) + (v[i][c + 2] + v[i][c + 3]); }
#pragma unroll
            for (int o = 32; o > 0; o >>= 1) {
#pragma unroll
                for (int i = 0; i < 4; ++i) s[i] += shfl_f(s[i], lane ^ o); }
#pragma unroll
            for (int i = 0; i < 4; ++i) { const float mean = s[i] * (1.0f / 1024.0f); qv[i] = 0.f;
#pragma unroll
                for (int c = 0; c < 16; c += 4) { v[i][c] -= mean; v[i][c + 1] -= mean; v[i][c + 2] -= mean; v[i][c + 3] -= mean;
                    qv[i] += (v[i][c] * v[i][c] + v[i][c + 1] * v[i][c + 1]) + (v[i][c + 2] * v[i][c + 2] + v[i][c + 3] * v[i][c + 3]); } }
#pragma unroll
            for (int o = 32; o > 0; o >>= 1) {
#pragma unroll
                for (int i = 0; i < 4; ++i) qv[i] += shfl_f(qv[i], lane ^ o); }
#pragma unroll
            for (int i = 0; i < 4; ++i) {
                const float rstd = rsqrtf(qv[i] * (1.0f / 1024.0f) + LN_EPS);
                const size_t row = (size_t)(tok0 + r0 + i);
                float y[16];
#pragma unroll
                for (int c = 0; c < 16; ++c) y[c] = v[i][c] * rstd * gg[c] + bb[c];
                u32x4 w0, w1, q;
                w0.x = pack2(y[0], y[1]); w0.y = pack2(y[2], y[3]); w0.z = pack2(y[4], y[5]); w0.w = pack2(y[6], y[7]);
                w1.x = pack2(y[8], y[9]); w1.y = pack2(y[10], y[11]); w1.z = pack2(y[12], y[13]); w1.w = pack2(y[14], y[15]);
                q.x = pack4_fp8(y[0], y[1], y[2], y[3]); q.y = pack4_fp8(y[4], y[5], y[6], y[7]); q.z = pack4_fp8(y[8], y[9], y[10], y[11]); q.w = pack4_fp8(y[12], y[13], y[14], y[15]);
                *(u32x4*)((bf16_t*)p.x1f + row * DM + lane * 16) = w0; *(u32x4*)((bf16_t*)p.x1f + row * DM + lane * 16 + 8) = w1;
                *(u32x4*)((char*)p.x1b + row * DM + lane * 16) = q;
            }
        }
        asm volatile("s_waitcnt vmcnt(0)" ::: "memory");
        __syncthreads();
        f32x4 a0 = (f32x4){0.f, 0.f, 0.f, 0.f}, a1 = a0;
        const bf16_t* xr = (const bf16_t*)p.x1f + (size_t)(tok0 + fr) * DM + 8 * fq;
        const LAS char* wl = (const LAS char*)lds + RW_LDS + fr * RW_PITCH + fq * 16;
#pragma unroll 8
        for (int ks = 0; ks < 32; ++ks) {
            const bf16x8 xa = *(const bf16x8*)(xr + ks * 32);
            a0 = __builtin_amdgcn_mfma_f32_16x16x32_bf16(xa, *(const LAS bf16x8*)(wl + ks * 64), a0, 0, 0, 0);
            a1 = __builtin_amdgcn_mfma_f32_16x16x32_bf16(xa, *(const LAS bf16x8*)(wl + 16 * RW_PITCH + ks * 64), a1, 0, 0, 0);
            a0 = __builtin_amdgcn_mfma_f32_16x16x32_bf16(xa, *(const LAS bf16x8*)(wl + 32 * RW_PITCH + ks * 64), a0, 0, 0, 0);
            a1 = __builtin_amdgcn_mfma_f32_16x16x32_bf16(xa, *(const LAS bf16x8*)(wl + 48 * RW_PITCH + ks * 64), a1, 0, 0, 0);
        }
#pragma unroll
        for (int r = 0; r < 4; ++r) { lg[(fq * 4 + r) * 32 + fr] = a0[r] + rb[fr]; lg[(fq * 4 + r) * 32 + 16 + fr] = a1[r] + rb[16 + fr]; }
        lds_wave_sync();
        int e4[4] = {0, 0, 0, 0}; int rk[4] = {0, 0, 0, 0};
        if (lane < 16) {
            const float* my = lg + lane * 32; unsigned taken = 0u; float tv[4];
#pragma unroll
            for (int k = 0; k < 4; ++k) {
                float best = NEG_INF; int bi = 0;
                for (int e = 0; e < 32; ++e) { const float xv = my[e]; if (!((taken >> e) & 1u) && xv > best) { best = xv; bi = e; } }
                taken |= 1u << bi; e4[k] = bi; tv[k] = best;
            }
            const float e1 = __expf(tv[1] - tv[0]), e2 = __expf(tv[2] - tv[0]), e3 = __expf(tv[3] - tv[0]);
            const float inv = 1.0f / (1.0f + e1 + e2 + e3);
            const size_t row = (size_t)(tok0 + lane);
            *(float4*)(p.gw + row * 4) = make_float4(inv, e1 * inv, e2 * inv, e3 * inv);
        }
        __syncthreads();
        if (lane < 16) {
#pragma unroll
            for (int k = 0; k < 4; ++k) rk[k] = atomicAdd(&lcnt[e4[k]], 1);
        }
        __syncthreads();
        if (tid < 32) { const int c = lcnt[tid]; lbase[tid] = c ? (int)__hip_atomic_fetch_add(gcount + tid, (unsigned)c, __ATOMIC_RELAXED, __HIP_MEMORY_SCOPE_AGENT) : 0; }
        __syncthreads();
        if (lane < 16) {
            const int row = tok0 + lane; int pk[4];
#pragma unroll
            for (int k = 0; k < 4; ++k) { const int pos = lbase[e4[k]] + rk[k]; p.lists[(size_t)e4[k] * LIST_CAP + pos] = row * 4 + k; pk[k] = (pos << 5) | e4[k]; }
            *(int4*)(p.top_e + (size_t)row * 4) = make_int4(pk[0], pk[1], pk[2], pk[3]);
        }
        __syncthreads();
    }
}

__device__ __forceinline__ void phase_ln2(const Params& p, int l, float* xout, char* lds) {
    int* ptile = (int*)(lds + LDS_TAB); int* ecnt = ptile + 40;
    int tid = threadIdx.x; asm volatile("" : "+v"(tid));
    const int wid = tid >> 6, lane = tid & 63;
    const float* g2 = p.ln2_g + l * DM; const float* b2 = p.ln2_b + l * DM;
    float gg[16], bb[16];
#pragma unroll
    for (int j = 0; j < 4; ++j) { const float4 g4 = *(const float4*)(g2 + lane * 16 + j * 4), b4 = *(const float4*)(b2 + lane * 16 + j * 4);
        gg[4 * j] = g4.x; gg[4 * j + 1] = g4.y; gg[4 * j + 2] = g4.z; gg[4 * j + 3] = g4.w; bb[4 * j] = b4.x; bb[4 * j + 1] = b4.y; bb[4 * j + 2] = b4.z; bb[4 * j + 3] = b4.w; }
    const int pstep = gridDim.x * NWV;
    int pr = blockIdx.x * NWV + wid;
    float4 gwn[2]; int4 ten[2];
    u32x4 yn[2][4], xn[2][2];
    float gk[2][4];
    auto load_meta = [&](int q) {
#pragma unroll
        for (int i = 0; i < 2; ++i) { const int row = q * 2 + i; gwn[i] = *(const float4*)(p.gw + (size_t)row * 4); ten[i] = *(const int4*)(p.top_e + (size_t)row * 4); }
    };
    auto load_rows = [&](int q) {
#pragma unroll
        for (int i = 0; i < 2; ++i) {
            const int row = q * 2 + i;
            const int tk[4] = {ten[i].x, ten[i].y, ten[i].z, ten[i].w};
            xn[i][0] = *(const u32x4*)((const bf16_t*)p.x1f + (size_t)row * DM + lane * 16); xn[i][1] = *(const u32x4*)((const bf16_t*)p.x1f + (size_t)row * DM + lane * 16 + 8);
#pragma unroll
            for (int k = 0; k < 4; ++k) yn[i][k] = *(const u32x4*)((const unsigned char*)p.ybuf + (size_t)(ptile[tk[k] & 31] * 256 + (tk[k] >> 5)) * DM + lane * 16);
        }
    };
    if (pr < NTOK / 2) { load_meta(pr); load_rows(pr); }
#pragma unroll
    for (int i = 0; i < 2; ++i) { gk[i][0] = gwn[i].x; gk[i][1] = gwn[i].y; gk[i][2] = gwn[i].z; gk[i][3] = gwn[i].w; }
    if (pr + pstep < NTOK / 2) load_meta(pr + pstep);
    for (; pr < NTOK / 2; pr += pstep) {
        float v[2][16]; float s[2], qv[2];
#pragma unroll
        for (int i = 0; i < 2; ++i) { s[i] = 0.f;
            const unsigned xs[8] = {xn[i][0].x, xn[i][0].y, xn[i][0].z, xn[i][0].w, xn[i][1].x, xn[i][1].y, xn[i][1].z, xn[i][1].w};
#pragma unroll
            for (int c = 0; c < 8; ++c) { v[i][2 * c] = __uint_as_float(xs[c] << 16) * ALPHA; v[i][2 * c + 1] = __uint_as_float(xs[c] & 0xffff0000u) * ALPHA; }
#pragma unroll
            for (int k = 0; k < 4; ++k) {
                const unsigned ys[4] = {yn[i][k].x, yn[i][k].y, yn[i][k].z, yn[i][k].w};
#pragma unroll
                for (int c = 0; c < 4; ++c) {
                    const f32x2_t lo = __builtin_amdgcn_cvt_pk_f32_fp8(ys[c], false), hi = __builtin_amdgcn_cvt_pk_f32_fp8(ys[c], true);
                    v[i][4 * c] += gk[i][k] * lo.x; v[i][4 * c + 1] += gk[i][k] * lo.y; v[i][4 * c + 2] += gk[i][k] * hi.x; v[i][4 * c + 3] += gk[i][k] * hi.y;
                }
            }
#pragma unroll
            for (int c = 0; c < 16; c += 4) s[i] += (v[i][c] + v[i][c + 1]) + (v[i][c + 2] + v[i][c + 3]);
        }
        __builtin_amdgcn_sched_barrier(0);
        if (pr + pstep < NTOK / 2) {
#pragma unroll
            for (int i = 0; i < 2; ++i) { gk[i][0] = gwn[i].x; gk[i][1] = gwn[i].y; gk[i][2] = gwn[i].z; gk[i][3] = gwn[i].w; }
            load_rows(pr + pstep);
            if (pr + 2 * pstep < NTOK / 2) load_meta(pr + 2 * pstep);
        }
        __builtin_amdgcn_sched_barrier(0);
#pragma unroll
        for (int o = 32; o > 0; o >>= 1) { s[0] += shfl_f(s[0], lane ^ o); s[1] += shfl_f(s[1], lane ^ o); }
#pragma unroll
        for (int i = 0; i < 2; ++i) { const float mean = s[i] * (1.0f / 1024.0f); qv[i] = 0.f;
#pragma unroll
            for (int c = 0; c < 16; c += 4) { v[i][c] -= mean; v[i][c + 1] -= mean; v[i][c + 2] -= mean; v[i][c + 3] -= mean;
                qv[i] += (v[i][c] * v[i][c] + v[i][c + 1] * v[i][c + 1]) + (v[i][c + 2] * v[i][c + 2] + v[i][c + 3] * v[i][c + 3]); } }
#pragma unroll
        for (int o = 32; o > 0; o >>= 1) { qv[0] += shfl_f(qv[0], lane ^ o); qv[1] += shfl_f(qv[1], lane ^ o); }
#pragma unroll
        for (int i = 0; i < 2; ++i) {
            const float rstd = rsqrtf(qv[i] * (1.0f / 1024.0f) + LN_EPS);
            const size_t row = (size_t)(pr * 2 + i);
            float y[16];
#pragma unroll
            for (int c = 0; c < 16; ++c) y[c] = v[i][c] * rstd * gg[c] + bb[c];
            if (l + 1 < NL) {
                u32x4 w0, w1, q;
                w0.x = pack2(y[0], y[1]); w0.y = pack2(y[2], y[3]); w0.z = pack2(y[4], y[5]); w0.w = pack2(y[6], y[7]);
                w1.x = pack2(y[8], y[9]); w1.y = pack2(y[10], y[11]); w1.z = pack2(y[12], y[13]); w1.w = pack2(y[14], y[15]);
                q.x = pack4_fp8(y[0], y[1], y[2], y[3]); q.y = pack4_fp8(y[4], y[5], y[6], y[7]); q.z = pack4_fp8(y[8], y[9], y[10], y[11]); q.w = pack4_fp8(y[12], y[13], y[14], y[15]);
                *(u32x4*)(p.xb + row * DM + lane * 16) = w0; *(u32x4*)(p.xb + row * DM + lane * 16 + 8) = w1;
                *(u32x4*)(p.xq + row * DM + lane * 16) = q;
            } else {
#pragma unroll
                for (int c = 0; c < 16; c += 4) *(float4*)(xout + row * DM + lane * 16 + c) = make_float4(y[c], y[c + 1], y[c + 2], y[c + 3]);
            }
        }
    }
}

#define XB_TMO      128
#define XB_XCNT(j)  (256  + 64 * (j))
#define XB_XSUB(j)  (1280 + 64 * (j))
#define XB_XGEN(j)  (2304 + 64 * (j))
#define XB_TOP      3328
#define XB_TOPGEN   3392
#define XCD_BAR_WORDS 3456
#define XB_SPIN_CAP (1u << 22)
__device__ __forceinline__ unsigned xb_ld(unsigned* p)              { return __hip_atomic_load(p, __ATOMIC_RELAXED, __HIP_MEMORY_SCOPE_AGENT); }
__device__ __forceinline__ unsigned xb_add(unsigned* p, unsigned v) { return __hip_atomic_fetch_add(p, v, __ATOMIC_RELAXED, __HIP_MEMORY_SCOPE_AGENT); }
__device__ __forceinline__ unsigned xb_xcc_id() { return (unsigned)__builtin_amdgcn_s_getreg((3 << 11) | 20) & 0xFu; }
#define XB_SPIN(cond, bar) do { unsigned _sp = 0; while (cond) { __builtin_amdgcn_s_sleep(1); \
    if ((++_sp & 255u) == 0u) { if (xb_ld(&(bar)[XB_TMO])) break; if (_sp > XB_SPIN_CAP) { atomicAdd(&(bar)[XB_TMO], 1u); break; } } } } while (0)
struct XcdBarrier { unsigned* bar; unsigned x; volatile LAS unsigned* st; };
__device__ __forceinline__ XcdBarrier xcd_barrier_post(unsigned* bar, volatile LAS unsigned* st) {
    XcdBarrier b; b.bar = bar; b.x = xb_xcc_id(); b.st = st;
    if (threadIdx.x == 0) (void)xb_add(&bar[XB_XCNT(b.x)], 1u);
    return b;
}
__device__ __forceinline__ void xcd_barrier_complete(unsigned* bar, unsigned x, unsigned& nloc, unsigned& nx) {
    const unsigned G = gridDim.x * gridDim.y * gridDim.z;
    unsigned sum, cnt, mine, sp = 0u;
    for (;;) {
        sum = 0u; cnt = 0u; mine = 0u;
#pragma unroll
        for (unsigned j = 0; j < 16; ++j) { const unsigned c = xb_ld(&bar[XB_XCNT(j)]); sum += c; cnt += (c > 0u) ? 1u : 0u; mine = (j == x) ? c : mine; }
        if (sum == G) break;
        __builtin_amdgcn_s_sleep(1);
        if ((++sp & 255u) == 0u) { if (xb_ld(&bar[XB_TMO])) break; if (sp > XB_SPIN_CAP) { atomicAdd(&bar[XB_TMO], 1u); break; } }
    }
    nloc = mine > 0u ? mine : 1u; nx = cnt > 0u ? cnt : 1u;
}
__device__ __forceinline__ void xcd_barrier(const XcdBarrier& b) {
    asm volatile("s_waitcnt vmcnt(0)" ::: "memory");
    __syncthreads();
    if (threadIdx.x == 0) {
        unsigned* bar = b.bar;
        __builtin_amdgcn_s_waitcnt(0);
        unsigned nloc = b.st[0], nx = b.st[1];
        if (nloc == 0u) { xcd_barrier_complete(bar, b.x, nloc, nx); b.st[0] = nloc; b.st[1] = nx; }
        const unsigned old = xb_add(&bar[XB_XSUB(b.x)], 1u);
        const unsigned gen = old / nloc;
        if (old + 1u == (gen + 1u) * nloc) {
            __builtin_amdgcn_fence(__ATOMIC_RELEASE, "agent");
            asm volatile("s_waitcnt vmcnt(0)" ::: "memory");
            const unsigned og = xb_add(&bar[XB_TOP], 1u);
            const unsigned tg = og / nx;
            if (og + 1u == (tg + 1u) * nx) xb_add(&bar[XB_TOPGEN], 1u);
            else XB_SPIN(xb_ld(&bar[XB_TOPGEN]) == tg, bar);
            __builtin_amdgcn_fence(__ATOMIC_ACQUIRE, "agent");
            xb_add(&bar[XB_XGEN(b.x)], 1u);
            asm volatile("s_waitcnt vmcnt(0)" ::: "memory");
        } else {
            XB_SPIN(xb_ld(&bar[XB_XGEN(b.x)]) == gen, bar);
            __builtin_amdgcn_fence(__ATOMIC_ACQUIRE, "agent");
            asm volatile("s_waitcnt vmcnt(0)" ::: "memory");
        }
    }
    __syncthreads();
}

struct KArgs { const float* in[18]; float* out; char* ws; };
constexpr size_t al256(size_t v) { return (v + 255) / 256 * 256; }
struct WSL {
    static constexpr size_t ctrl = 0;
    static constexpr size_t WinT = al256(ctrl + 65536);
    static constexpr size_t WoT = al256(WinT + (size_t)NL * NPAD * 1024 * 2);
    static constexpr size_t W1T = al256(WoT + (size_t)NL * 1024 * 1024 * 2);
    static constexpr size_t W2T = al256(W1T + (size_t)NL * 2 * 64 * 2048 * 2);
    static constexpr size_t WguT = al256(W2T + (size_t)NL * 2 * 64 * 64 * 2);
    static constexpr size_t WdnT = al256(WguT + (size_t)NL * NE * 2048 * 1024 * 2);
    static constexpr size_t rwT = al256(WdnT + (size_t)NL * NE * 1024 * 1024 * 2);
    static constexpr size_t binp = al256(rwT + (size_t)NL * NE * 1024 * 4);
    static constexpr size_t bgup = al256(binp + (size_t)NL * NPAD * 4);
    static constexpr size_t b1c = al256(bgup + (size_t)NL * NE * 2048 * 4);
    static constexpr size_t xf = al256(b1c + 4 * 8 * 64 * 4);
    static constexpr size_t xb = al256(xf + (size_t)NTOK * DM * 4);
    static constexpr size_t hb = al256(xb + (size_t)NTOK * DM * 2);
    static constexpr size_t hs = al256(hb + (size_t)NTOK * NMAIN * 2);
    static constexpr size_t vT = al256(hs + (size_t)NTOK * HS_W * 4);
    static constexpr size_t kF = al256(vT + (size_t)NB * NVH * 64 * SEQ * 2);
    static constexpr size_t cF = al256(kF + (size_t)NB * NVH * 64 * SEQ * 2);
    static constexpr size_t kc = al256(cF + (size_t)NB * 4 * SEQ * 4);
    static constexpr size_t vc = al256(kc + (size_t)NB * 2 * 128 * 64 * 2);
    static constexpr size_t vcT = al256(vc + (size_t)NB * 2 * 128 * 64 * 2);
    static constexpr size_t ob = al256(vcT + (size_t)NB * 2 * 128 * 64 * 2);
    static constexpr size_t tbuf = al256(ob + (size_t)NTOK * DM * 2);
    static constexpr size_t x1f = al256(tbuf + (size_t)NTOK * DM * 4);
    static constexpr size_t x1b = al256(x1f + (size_t)NTOK * DM * 4);
    static constexpr size_t top_e = al256(x1b + (size_t)NTOK * DM * 2);
    static constexpr size_t gw = al256(top_e + (size_t)NTOK * 4 * 4);
    static constexpr size_t lists = al256(gw + (size_t)NTOK * 4 * 4);
    static constexpr size_t act = al256(lists + (size_t)NE * LIST_CAP * 4);
    static constexpr size_t ybuf = al256(act + (size_t)MAXSLOT * DFF * 2);
    static constexpr size_t xq = al256(ybuf + (size_t)MAXSLOT * DM * 2);
    static constexpr size_t WinQ = al256(xq + (size_t)NTOK * DM);
    static constexpr size_t total = al256(WinQ + (size_t)NL * NMAIN * 1024);
};
__device__ __forceinline__ Params make_params(const KArgs& k) {
    Params p;
    p.x = k.in[0]; p.w_in = k.in[1]; p.b_in = k.in[2]; p.sinks = k.in[3]; p.cmp_pe = k.in[4]; p.cmp_w1 = k.in[5]; p.cmp_w2 = k.in[6]; p.w_out = k.in[7];
    p.ln1_g = k.in[8]; p.ln1_b = k.in[9]; p.router_w = k.in[10]; p.router_b = k.in[11]; p.w_gu = k.in[12]; p.b_gu = k.in[13]; p.w_dn = k.in[14]; p.b_dn = k.in[15];
    p.ln2_g = k.in[16]; p.ln2_b = k.in[17]; p.out = k.out;
    char* w = k.ws;
    p.ctrl = (unsigned*)(w + WSL::ctrl); p.WinT = (bf16_t*)(w + WSL::WinT); p.WoT = (bf16_t*)(w + WSL::WoT); p.W1T = (bf16_t*)(w + WSL::W1T); p.W2T = (bf16_t*)(w + WSL::W2T);
    p.WguT = (bf16_t*)(w + WSL::WguT); p.WdnT = (bf16_t*)(w + WSL::WdnT); p.rwT = (float*)(w + WSL::rwT); p.binp = (float*)(w + WSL::binp); p.bgup = (float*)(w + WSL::bgup);
    p.b1c = (float*)(w + WSL::b1c); p.xf = (float*)(w + WSL::xf); p.xb = (bf16_t*)(w + WSL::xb); p.hb = (bf16_t*)(w + WSL::hb); p.hs = (float*)(w + WSL::hs); p.vT = (bf16_t*)(w + WSL::vT); p.kF = (bf16_t*)(w + WSL::kF);
    p.cF = (float*)(w + WSL::cF); p.kc = (bf16_t*)(w + WSL::kc); p.vc = (bf16_t*)(w + WSL::vc); p.vcT = (bf16_t*)(w + WSL::vcT); p.ob = (bf16_t*)(w + WSL::ob); p.tbuf = (float*)(w + WSL::tbuf);
    p.x1f = (float*)(w + WSL::x1f); p.x1b = (bf16_t*)(w + WSL::x1b); p.top_e = (int*)(w + WSL::top_e); p.gw = (float*)(w + WSL::gw); p.lists = (int*)(w + WSL::lists);
    p.act = (bf16_t*)(w + WSL::act); p.ybuf = (bf16_t*)(w + WSL::ybuf); p.xq = (unsigned char*)(w + WSL::xq); p.WinQ = (unsigned char*)(w + WSL::WinQ);
    return p;
}
__device__ __forceinline__ void grid_bar(const Params& p, char* lds) {
    XcdBarrier xb; xb.bar = p.ctrl + 1024; xb.x = xb_xcc_id(); xb.st = (volatile LAS unsigned*)(lds + LDS_BYTES - 16); xcd_barrier(xb);
}
__device__ __forceinline__ Params fresh_params(const KArgs& ka) {
    KArgs k2 = ka; size_t z = 0; asm volatile("" : "+s"(z));
    k2.ws = ka.ws + z;
    return make_params(k2);
}
#ifndef REP
#define REP 0
#endif
template <int L>
__device__ __forceinline__ void layer_fwd(const KArgs& ka, char* lds) {
    { const Params p = fresh_params(ka); phase_inproj(p, L, lds);        grid_bar(p, lds); }
    { const Params p = fresh_params(ka); phase_prep(p, L, lds);          grid_bar(p, lds); }
    { const Params p = fresh_params(ka); phase_attn<L == 0>(p, L, lds);  grid_bar(p, lds); }
    { const Params p = fresh_params(ka); phase_outproj(p, L, p.xb, lds);  grid_bar(p, lds); }
    { const Params p = fresh_params(ka); phase_ln1_router(p, L, lds);    grid_bar(p, lds); }
    { const Params p = fresh_params(ka); phase_gateup(p, L, lds);        grid_bar(p, lds); }
    { const Params p = fresh_params(ka); phase_down(p, L, lds);          grid_bar(p, lds); }
    { const Params p = fresh_params(ka); phase_ln2(p, L, L == NL - 1 ? p.out : p.xf, lds); }
}
__global__ void __launch_bounds__(NTHR, 2) fwd_kernel(KArgs ka) {
    extern __shared__ __attribute__((aligned(16))) char lds[];
    const Params p = make_params(ka);
    cg::grid_group grid = cg::this_grid();
    volatile LAS unsigned* xst = (volatile LAS unsigned*)(lds + LDS_BYTES - 16);
    if (threadIdx.x == 0) { xst[0] = 0u; xst[1] = 0u; }
    __syncthreads();
    (void)xcd_barrier_post(p.ctrl + 1024, xst);
    volatile LAS int* vcu = (volatile LAS int*)(lds + LDS_BYTES - 32);
    const unsigned myx = xb_xcc_id() & 7u;
    if (threadIdx.x == 0) vcu[1] = (int)__hip_atomic_fetch_add(p.ctrl + 32 + myx, 1u, __ATOMIC_RELAXED, __HIP_MEMORY_SCOPE_AGENT);
    phase0(p, lds);
    grid.sync();
    if (threadIdx.x == 0) {
        int base = 0, tot = 0;
        for (unsigned x = 0; x < 8; ++x) { const int n = (int)__hip_atomic_load(p.ctrl + 32 + x, __ATOMIC_RELAXED, __HIP_MEMORY_SCOPE_AGENT); if (x < myx) base += n; tot += n; }
        vcu[0] = (tot == (int)gridDim.x) ? base + vcu[1] : (int)blockIdx.x;
    }
    __syncthreads();
    layer_fwd<0>(ka, lds);
    grid_bar(p, lds);
    layer_fwd<1>(ka, lds);
}

extern "C" void kernel_launch(void* const* d_in, const int* in_sizes, int n_in, void* d_out, int out_size, void* d_ws, size_t ws_size, hipStream_t stream) {
    KArgs ka{};
    for (int i = 0; i < 18; ++i) ka.in[i] = (const float*)d_in[i];
    ka.out = (float*)d_out; ka.ws = (char*)d_ws;
    if (WSL::total > ws_size) { fprintf(stderr, "workspace too small: need %zu have %zu\n", (size_t)WSL::total, ws_size); return; }
    static int grid_blocks = 0;
    if (!grid_blocks) {
        int dev = 0, cus = 0, per_cu = 0;
        (void)hipGetDevice(&dev);
        (void)hipDeviceGetAttribute(&cus, hipDeviceAttributeMultiprocessorCount, dev);
        (void)hipFuncSetAttribute((const void*)fwd_kernel, hipFuncAttributeMaxDynamicSharedMemorySize, LDS_BYTES);
        (void)hipOccupancyMaxActiveBlocksPerMultiprocessor(&per_cu, fwd_kernel, NTHR, LDS_BYTES);
        if (per_cu < 1) { fprintf(stderr, "occupancy query says 0 blocks per CU\n"); per_cu = 1; }
        grid_blocks = cus;
    }
    (void)hipMemsetAsync(d_ws, 0, 65536, stream);
    void* args[] = {&ka};
    hipError_t e = hipLaunchCooperativeKernel((const void*)fwd_kernel, dim3(grid_blocks), dim3(NTHR), args, LDS_BYTES, stream);
    if (e != hipSuccess) fprintf(stderr, "cooperative launch failed: %s (grid %d)\n", hipGetErrorString(e), grid_blocks);
}
```

```cpp
#include <hip/hip_runtime.h>
#include <hip/hip_cooperative_groups.h>
#include <cstdio>
#include <cstdint>
namespace cg = cooperative_groups;

typedef unsigned short bf16_t;
typedef short bf16x8 __attribute__((ext_vector_type(8)));
typedef float f32x4 __attribute__((ext_vector_type(4)));
typedef unsigned u32x4 __attribute__((ext_vector_type(4)));
typedef unsigned u32x2 __attribute__((ext_vector_type(2)));
typedef int v8i_t __attribute__((ext_vector_type(8)));
typedef float f32x2_t __attribute__((ext_vector_type(2)));
typedef int v4i_t __attribute__((ext_vector_type(4)));
#define LAS __attribute__((address_space(3)))
constexpr float NEG_INF = -__builtin_huge_valf();

constexpr int DM = 1024, NB = 16, SEQ = 2048, NTOK = NB * SEQ, NL = 2;
constexpr int NCOL = 2582, NMAIN = 2560, NPAD = 2688, NE = 32, DFF = 1024;
constexpr int C_FQ = 0, C_FK = 256, C_FV = 512, C_SQ = 768, C_SK = 1152, C_SV = 1280, C_NQ = 1408,
              C_NKC = 1792, C_NVC = 1920, C_NKS = 2048, C_NVS = 2176, C_NKW = 2304, C_NVW = 2432;
constexpr int HS_W = 32;
constexpr int NVH = 10;
constexpr int LIST_CAP = NTOK;
constexpr int MAXSLOT = NTOK * 4 + NE * 256;
constexpr float ALPHA = 1.41421356237f, LN_EPS = 1e-5f, QSCALE = 0.125f;
constexpr float GATE_PRE = -2.455466929f;
constexpr int NWV = 8, NTHR = NWV * 64;
constexpr int LDS_STAGE = 131072, LDS_TAB = LDS_STAGE, LDS_AOFF = LDS_STAGE + 2048, LDS_BIAS = LDS_AOFF + 20480, LDS_BYTES = LDS_BIAS + 3072 + 256;

struct Params {
    const float *x, *w_in, *b_in, *sinks, *cmp_pe, *cmp_w1, *cmp_w2, *w_out, *ln1_g, *ln1_b, *router_w, *router_b,
                *w_gu, *b_gu, *w_dn, *b_dn, *ln2_g, *ln2_b;
    float* out;
    unsigned* ctrl;
    bf16_t *WinT, *WoT, *W1T, *W2T, *WguT, *WdnT;
    float *rwT, *binp, *bgup, *b1c;
    unsigned char* xq; unsigned char* WinQ;
    float* xf; bf16_t* xb; bf16_t* hb; float* hs; bf16_t* vT; bf16_t* kF; float* cF;
    bf16_t *kc, *vc, *vcT; bf16_t* ob; float* tbuf; float* x1f; bf16_t* x1b;
    int* top_e; float* gw; int* lists; bf16_t* act; bf16_t* ybuf;
};

__device__ __forceinline__ float bf2f(bf16_t h) { return __uint_as_float(((unsigned)h) << 16); }
typedef __bf16 bf16x2_t __attribute__((ext_vector_type(2)));
__device__ __forceinline__ bf16_t f2bf(float f) { return __builtin_bit_cast(bf16_t, (__bf16)f); }
__device__ __forceinline__ unsigned pack2(float lo, float hi) { bf16x2_t v = {(__bf16)lo, (__bf16)hi}; return __builtin_bit_cast(unsigned, v); }
__device__ __forceinline__ unsigned pack4_fp8(float a, float b, float c, float d) {
    unsigned w = 0u;
    w = __builtin_amdgcn_cvt_pk_fp8_f32(a, b, w, false);
    w = __builtin_amdgcn_cvt_pk_fp8_f32(c, d, w, true);
    return w;
}
__device__ __forceinline__ float shfl_f(float v, int src_lane) { return __int_as_float(__builtin_amdgcn_ds_bpermute(src_lane << 2, __float_as_int(v))); }
__device__ __forceinline__ unsigned shfl_u(unsigned v, int src_lane) { return (unsigned)__builtin_amdgcn_ds_bpermute(src_lane << 2, (int)v); }
__device__ __forceinline__ float wave_sum(float v) {
#pragma unroll
    for (int o = 32; o > 0; o >>= 1) v += __shfl_xor(v, o);
    return v;
}
__device__ __forceinline__ float wave_max(float v) {
#pragma unroll
    for (int o = 32; o > 0; o >>= 1) v = fmaxf(v, __shfl_xor(v, o));
    return v;
}
__device__ __forceinline__ void lds_wave_sync() { asm volatile("s_waitcnt lgkmcnt(0)" ::: "memory"); __builtin_amdgcn_wave_barrier(); }
__device__ __forceinline__ float slope_swa(int hq) { return exp2f(-8.0f * (float)(2 * hq + 1) / 12.0f); }
__device__ __forceinline__ float slope_nsa(int hq) { return exp2f(-8.0f * (float)(2 * hq + 2) / 12.0f); }

__device__ __forceinline__ int fwd128(int L) { return (L & ~31) | (((L >> 2) & 1) << 4) | (((L >> 3) & 3) << 2) | (L & 3); }
__device__ __forceinline__ int inv128(int p) { return (p & ~31) | (((p >> 2) & 3) << 3) | (((p >> 4) & 1) << 2) | (p & 3); }
__device__ __forceinline__ int fwd256(int L) { return (L & ~255) | (((L >> 3) & 1) << 7) | (((L >> 6) & 3) << 5) | (((L >> 2) & 1) << 4) | (((L >> 4) & 3) << 2) | (L & 3); }
__device__ __forceinline__ int perm_row(int perm, int n) {
    if (perm == 1) { int r; if (n < 768) r = n; else if (n < 772) r = 2560 + (n - 768); else if (n < 2564) r = n - 4; else r = n; return r < 2560 ? fwd128(r) : r; }
    if (perm == 2) { const int f = n >> 1, s = n & 1; return (f >> 7) * 256 + s * 128 + fwd128(f & 127); }
    if (perm == 3) return fwd256(n);
    return n;
}
struct ConvJob { const float* src; bf16_t* dst; int K, N, kt, nt, perm; float q8; };
__device__ __forceinline__ bool conv_job(const Params& p, int t, ConvJob& jb) {
    constexpr int T_WIN = NL * 8 * 21, T_WO = NL * 8 * 8, T_WINB = NL * 8 * 2;
    if (t < T_WINB) { const int m = t / 16, r = t % 16; jb = ConvJob{p.w_in + (size_t)m * 1024 * NCOL, p.WinT + (size_t)m * NPAD * 1024, 1024, NCOL, r >> 1, (r & 1) ? 20 : 6, 1, 0.f}; return true; }
    t -= T_WINB;
    if (t < T_WO) { const int m = t / 64, r = t % 64; jb = ConvJob{p.w_out + (size_t)m * 1024 * 1024, (bf16_t*)((char*)p.WoT + (size_t)m * 1024 * 1024), 1024, 1024, r / 8, r % 8, 3, 64.0f}; return true; }
    t -= T_WO;
    if (t < T_WIN) { const int m = t / 168, r = t % 168; jb = ConvJob{p.w_in + (size_t)m * 1024 * NCOL, (bf16_t*)(p.WinQ + (size_t)m * NMAIN * 1024), 1024, NCOL, r / 21, r % 21, 1, 64.0f}; return true; }
    return false;
}
constexpr int CONV_TILES = NL * NE * 192;
__device__ __forceinline__ void conv_tile_wave(const Params& p, int t, int lane, unsigned char* l8) {
    asm volatile("" : "+v"(lane));
    const int m = t / 192, r = t % 192;
    const float* src; unsigned char* dst; int N, kt, nt, perm;
    if (r < 128) { src = p.w_gu + (size_t)m * 1024 * 2048; dst = (unsigned char*)p.WguT + (size_t)m * 2048 * 1024; N = 2048; kt = r >> 4; nt = r & 15; perm = 2; }
    else { const int q = r - 128; src = p.w_dn + (size_t)m * 1024 * 1024; dst = (unsigned char*)p.WdnT + (size_t)m * 1024 * 1024; N = 1024; kt = q >> 3; nt = q & 7; perm = 3; }
    const float* s = src + (size_t)(kt * 128 + (lane >> 5)) * N + nt * 128 + (lane & 31) * 4;
    unsigned char* lw = l8 + (lane >> 5) * 132 + (lane & 31) * 4;
    const float sg = (perm == 2) ? 64.0f * GATE_PRE : 64.0f;
    float4 va[16], vb[16];
#pragma unroll
    for (int i = 0; i < 16; ++i) va[i] = *(const float4*)(s + (size_t)(2 * i) * N);
#pragma unroll
    for (int i = 0; i < 16; ++i) vb[i] = *(const float4*)(s + (size_t)(32 + 2 * i) * N);
#pragma unroll
    for (int i = 0; i < 16; ++i) *(unsigned*)(lw + (2 * i) * 132) = pack4_fp8(va[i].x * sg, va[i].y * 64.0f, va[i].z * sg, va[i].w * 64.0f);
#pragma unroll
    for (int i = 0; i < 16; ++i) va[i] = *(const float4*)(s + (size_t)(64 + 2 * i) * N);
#pragma unroll
    for (int i = 0; i < 16; ++i) *(unsigned*)(lw + (32 + 2 * i) * 132) = pack4_fp8(vb[i].x * sg, vb[i].y * 64.0f, vb[i].z * sg, vb[i].w * 64.0f);
#pragma unroll
    for (int i = 0; i < 16; ++i) vb[i] = *(const float4*)(s + (size_t)(96 + 2 * i) * N);
#pragma unroll
    for (int i = 0; i < 16; ++i) *(unsigned*)(lw + (64 + 2 * i) * 132) = pack4_fp8(va[i].x * sg, va[i].y * 64.0f, va[i].z * sg, va[i].w * 64.0f);
#pragma unroll
    for (int i = 0; i < 16; ++i) *(unsigned*)(lw + (96 + 2 * i) * 132) = pack4_fp8(vb[i].x * sg, vb[i].y * 64.0f, vb[i].z * sg, vb[i].w * 64.0f);
    lds_wave_sync();
#pragma unroll 4
    for (int i = 0; i < 16; ++i) {
        const int idx = lane + 64 * i, kc = idx & 7, nn = idx >> 3;
        const unsigned char* l = l8 + (kc * 16) * 132 + nn;
        u32x4 w;
        w.x = (unsigned)l[0] | ((unsigned)l[132] << 8) | ((unsigned)l[264] << 16) | ((unsigned)l[396] << 24);
        w.y = (unsigned)l[528] | ((unsigned)l[660] << 8) | ((unsigned)l[792] << 16) | ((unsigned)l[924] << 24);
        w.z = (unsigned)l[1056] | ((unsigned)l[1188] << 8) | ((unsigned)l[1320] << 16) | ((unsigned)l[1452] << 24);
        w.w = (unsigned)l[1584] | ((unsigned)l[1716] << 8) | ((unsigned)l[1848] << 16) | ((unsigned)l[1980] << 24);
        *(u32x4*)(dst + (size_t)perm_row(perm, nt * 128 + nn) * 1024 + kt * 128 + kc * 16) = w;
    }
    lds_wave_sync();
}
__device__ __forceinline__ void conv_load(const ConvJob& jb, int tid, float2 (&v)[16]) {
    const int n = jb.nt * 128 + (tid & 31) * 4;
    const float* s = jb.src + (size_t)(jb.kt * 128 + (tid >> 5)) * jb.N + n;
#pragma unroll
    for (int i = 0; i < 8; ++i) {
        const float* r = s + (size_t)(16 * i) * jb.N;
        v[2 * i] = (n + 1 < jb.N) ? *(const float2*)r : make_float2(0.f, 0.f);
        v[2 * i + 1] = (n + 3 < jb.N) ? *(const float2*)(r + 2) : make_float2(0.f, 0.f);
    }
}
__device__ __forceinline__ void phase0(const Params& p, char* ldsc) {
    int tid = threadIdx.x; asm volatile("" : "+v"(tid));
    const int G = gridDim.x, bid = blockIdx.x;
    const size_t gtid = (size_t)bid * NTHR + tid, gthreads = (size_t)G * NTHR;
    {
        constexpr int TOT = NL * 8 * 2 + NL * 8 * 21 + NL * 8 * 8;
        bf16_t* lt = (bf16_t*)ldsc;
        ConvJob jb, jn; float2 v[16], vn[16];
        int t = bid; bool have = t < TOT && conv_job(p, t, jb);
        if (have) conv_load(jb, tid, v);
        while (have) {
            const int tn = t + G; const bool hn = tn < TOT && conv_job(p, tn, jn);
            if (hn) conv_load(jn, tid, vn);
            if (jb.q8 != 0.f) {
                unsigned char* l8 = (unsigned char*)lt;
#pragma unroll
                for (int i = 0; i < 8; ++i)
                {   int kl = (tid >> 5) + 16 * i;
                    if (jb.perm == 3) kl = (kl & 64) | (((kl >> 2) & 3) << 4) | (((kl >> 4) & 3) << 2) | (kl & 3);
                    *(unsigned*)(l8 + kl * 132 + (tid & 31) * 4) = pack4_fp8(v[2 * i].x * jb.q8, v[2 * i].y * jb.q8, v[2 * i + 1].x * jb.q8, v[2 * i + 1].y * jb.q8); }
                __syncthreads();
#pragma unroll
                for (int i = 0; i < 2; ++i) {
                    const int idx = tid + NTHR * i, kc = idx & 7, nn = idx >> 3, n = jb.nt * 128 + nn;
                    const unsigned char* l = l8 + (kc * 16) * 132 + nn;
                    u32x4 w;
                    w.x = (unsigned)l[0] | ((unsigned)l[132] << 8) | ((unsigned)l[264] << 16) | ((unsigned)l[396] << 24);
                    w.y = (unsigned)l[528] | ((unsigned)l[660] << 8) | ((unsigned)l[792] << 16) | ((unsigned)l[924] << 24);
                    w.z = (unsigned)l[1056] | ((unsigned)l[1188] << 8) | ((unsigned)l[1320] << 16) | ((unsigned)l[1452] << 24);
                    w.w = (unsigned)l[1584] | ((unsigned)l[1716] << 8) | ((unsigned)l[1848] << 16) | ((unsigned)l[1980] << 24);
                    const int pr = perm_row(jb.perm, n);
                    if (n < jb.N && !(jb.perm == 1 && pr >= NMAIN)) *(u32x4*)((char*)jb.dst + (size_t)pr * jb.K + jb.kt * 128 + kc * 16) = w;
                }
            } else {
#pragma unroll
                for (int i = 0; i < 8; ++i) {
                    u32x2 w; w.x = pack2(v[2 * i].x, v[2 * i].y); w.y = pack2(v[2 * i + 1].x, v[2 * i + 1].y);
                    *(u32x2*)(lt + ((tid >> 5) + 16 * i) * 136 + (tid & 31) * 4) = w;
                }
                __syncthreads();
#pragma unroll
                for (int i = 0; i < 4; ++i) {
                    const int idx = tid + NTHR * i, kc = idx & 15, nn = idx >> 4, n = jb.nt * 128 + nn;
                    if (n < jb.N) {
                        const bf16_t* l = lt + (kc * 8) * 136 + nn;
                        u32x4 w;
                        w.x = (unsigned)l[0] | ((unsigned)l[136] << 16); w.y = (unsigned)l[272] | ((unsigned)l[408] << 16);
                        w.z = (unsigned)l[544] | ((unsigned)l[680] << 16); w.w = (unsigned)l[816] | ((unsigned)l[952] << 16);
                        *(u32x4*)(jb.dst + (size_t)perm_row(jb.perm, n) * jb.K + jb.kt * 128 + kc * 8) = w;
                    }
                }
            }
            __syncthreads();
            t = tn; have = hn; jb = jn;
#pragma unroll
            for (int i = 0; i < 16; ++i) v[i] = vn[i];
        }
    }
    for (size_t i = gtid; i < (size_t)NL * 2 * 2048 * 64; i += gthreads) {
        const int k = (int)(i % 2048), n = (int)((i / 2048) % 64), m = (int)(i / (2048 * 64));
        p.W1T[i] = f2bf(p.cmp_w1[((size_t)m * 2048 + k) * 64 + n]);
    }
    for (size_t i = gtid; i < (size_t)NL * 2 * 64 * 64; i += gthreads) {
        const int k = (int)(i % 64), n = (int)((i / 64) % 64), m = (int)(i / 4096);
        p.W2T[i] = f2bf(p.cmp_w2[((size_t)m * 64 + k) * 64 + n]);
    }
    for (size_t i = gtid; i < (size_t)NL * NPAD; i += gthreads) {
        const int l = (int)(i / NPAD), ri = (int)(i % NPAD), r = ri < 2560 ? inv128(ri) : ri;
        float v = 0.f;
        if (r < 2560) { const int n = r < 768 ? r : r + 4; v = p.b_in[l * NCOL + n]; }
        else if (r < 2564) v = p.b_in[l * NCOL + 768 + (r - 2560)];
        else if (r < 2582) v = p.b_in[l * NCOL + r];
        p.binp[i] = v;
    }
    for (size_t i = gtid; i < (size_t)NL * NE * 2048; i += gthreads) {
        const int r = (int)(i % 2048); const size_t le = i / 2048;
        const int s = (r >> 7) & 1, f = (r >> 8) * 128 + inv128(r & 127);
        p.bgup[i] = p.b_gu[le * 2048 + 2 * f + s] * (s == 0 ? GATE_PRE : 1.0f);
    }
    for (size_t i = gtid; i < (size_t)NL * NE * 1024; i += gthreads) {
        const int k = (int)(i % 1024), e = (int)((i / 1024) % NE), l = (int)(i / (1024 * NE));
        const float wv = p.router_w[((size_t)l * 1024 + k) * NE + e];
        const bf16_t hi = f2bf(wv); const float hf = __uint_as_float((unsigned)hi << 16);
        bf16_t* rwb = (bf16_t*)p.rwT + (size_t)l * 64 * 1024;
        rwb[(size_t)e * 1024 + k] = hi; rwb[(size_t)(32 + e) * 1024 + k] = f2bf(wv - hf);
    }
    for (size_t i = gtid; i < (size_t)NL * (NPAD - NCOL) * 1024; i += gthreads) {
        const int l = (int)(i / ((NPAD - NCOL) * 1024)); const size_t r = i % ((size_t)(NPAD - NCOL) * 1024);
        p.WinT[(size_t)l * NPAD * 1024 + (size_t)NCOL * 1024 + r] = 0;
    }
    {
        constexpr size_t N16 = (size_t)NTOK * DM / 16;
        for (size_t i0 = gtid; i0 < N16; i0 += gthreads * 2) {
            float4 v[2][4];
#pragma unroll
            for (int u = 0; u < 2; ++u) { const size_t i = i0 + u * gthreads;
#pragma unroll
                for (int j = 0; j < 4; ++j) v[u][j] = (i < N16) ? ((const float4*)p.x)[i * 4 + j] : make_float4(0.f, 0.f, 0.f, 0.f); }
#pragma unroll
            for (int u = 0; u < 2; ++u) { const size_t i = i0 + u * gthreads;
                if (i < N16) {
                    u32x4 w0, w1, q;
                    w0.x = pack2(v[u][0].x, v[u][0].y); w0.y = pack2(v[u][0].z, v[u][0].w); w0.z = pack2(v[u][1].x, v[u][1].y); w0.w = pack2(v[u][1].z, v[u][1].w);
                    w1.x = pack2(v[u][2].x, v[u][2].y); w1.y = pack2(v[u][2].z, v[u][2].w); w1.z = pack2(v[u][3].x, v[u][3].y); w1.w = pack2(v[u][3].z, v[u][3].w);
                    q.x = pack4_fp8(v[u][0].x, v[u][0].y, v[u][0].z, v[u][0].w); q.y = pack4_fp8(v[u][1].x, v[u][1].y, v[u][1].z, v[u][1].w);
                    q.z = pack4_fp8(v[u][2].x, v[u][2].y, v[u][2].z, v[u][2].w); q.w = pack4_fp8(v[u][3].x, v[u][3].y, v[u][3].z, v[u][3].w);
                    ((u32x4*)p.xb)[i * 2] = w0; ((u32x4*)p.xb)[i * 2 + 1] = w1; ((u32x4*)p.xq)[i] = q;
                }
            }
        }
    }
    if (bid < 32) {
        float* lf = (float*)ldsc;
        const int j = tid & 63, part = tid >> 6, lw = bid >> 3, sl = bid & 7;
        const float* pe = p.cmp_pe + (size_t)lw * 2048; const float* w1 = p.cmp_w1 + (size_t)lw * 2048 * 64;
        float s = 0.f;
#pragma unroll 8
        for (int kk = sl * 256 + part * 32; kk < sl * 256 + part * 32 + 32; ++kk) s += pe[kk] * w1[(size_t)kk * 64 + j];
        lf[tid] = s; __syncthreads();
        if (tid < 64) { float a = 0.f; for (int q = 0; q < 8; ++q) a += lf[tid + 64 * q]; p.b1c[(lw * 8 + sl) * 64 + tid] = a; }
        __syncthreads();
    }
}

__device__ __forceinline__ int vcu_id() { return __builtin_amdgcn_readfirstlane(*(const volatile LAS int*)(LDS_BYTES - 32)); }
namespace pg8 {
constexpr int BM = 256, BK = 64, HALF = 128, HTB = HALF * BK * 2, NXCD = 8, WGM = 8;
__device__ __forceinline__ int lds_byte(int r, int c) { const int ch = (c >> 3) ^ ((r >> 1) & 7); return (r >> 3) * 1024 + (r & 7) * 128 + ch * 16 + (c & 7) * 2; }
__device__ __forceinline__ void stage_rc(int b, int& R, int& C) { const int st = b / 1024, sb = b % 1024; R = st * 8 + sb / 128; C = ((((sb % 128) / 16) ^ ((R >> 1) & 7)) * 16 + (sb % 16)) / 2; }
__device__ __forceinline__ bool tile_order(int i, int G, int c, int nM, int nN, int& pm, int& pn) {
    const int nwg = nM * nN; const long L = (long)i * G + c; if (L >= nwg) return false;
    const int wgid = (int)L;
    const int nig = WGM * nN, gid = wgid / nig, fm = gid * WGM, gsz = (nM - fm) < WGM ? (nM - fm) : WGM;
    pm = fm + ((wgid % nig) % gsz); pn = (wgid % nig) / gsz; return true;
}
template <bool FP8, int SCA, class Sched, class Epi>
__device__ __forceinline__ void gemm_phase(LAS unsigned char* lds, const char* Abase, int K, const Sched& S, const Epi& E) {
    int tid = threadIdx.x; asm volatile("" : "+v"(tid));
    const int wid = __builtin_amdgcn_readfirstlane(tid >> 6), lane = tid & 63, wr = wid >> 2, wc = wid & 3, fr = lane & 15, fq = lane >> 4;
    const int nt = K / BK;
    int R0, C0, R1, C1; stage_rc(tid * 16, R0, C0); stage_rc(tid * 16 + 8192, R1, C1);
    LAS unsigned* aofs = (LAS unsigned*)(lds + LDS_AOFF) + tid;
    unsigned rg[10];
    rg[8] = (unsigned)(R0 * K + C0) * 2u; rg[9] = (unsigned)(R1 * K + C1) * 2u;
    if constexpr (FP8) { aofs[8 * NTHR] = rg[8]; aofs[9 * NTHR] = rg[9]; }
    const size_t kstep = (size_t)(BK * 2), hstep = (size_t)HALF * K * 2;
    const unsigned ldsw = (unsigned)wid * 1024u;
    const int aoff = lds_byte(wr * 64 + fr, fq * 8), boff = lds_byte(wc * 32 + fr, fq * 8);
#define PG8_SA(b, h) (((b) * 2 + (h)) * HTB)
#define PG8_SB(b, h) ((4 + (b) * 2 + (h)) * HTB)
#define PG8_OFS(sel, j) (FP8 ? aofs[((sel) * 4 + (j)) * NTHR] : ((sel) ? rg[4 + (j)] : rg[(j)]))
#define PG8_STAGE_B(bufoff, gbase) do { _Pragma("unroll") for (int _i = 0; _i < 2; ++_i) { const unsigned ob_ = FP8 ? aofs[(8 + _i) * NTHR] : rg[8 + _i]; \
        __builtin_amdgcn_global_load_lds((const unsigned*)((const char*)(gbase) + ob_), (LAS unsigned*)(lds + (bufoff) + ldsw + _i * 8192), 16, 0, 0); } } while (0)
#define PG8_STAGE_A(bufoff, kbyte, sel, h) do { const unsigned o0_ = PG8_OFS(sel, (h) * 2), o1_ = PG8_OFS(sel, (h) * 2 + 1); \
        __builtin_amdgcn_global_load_lds((const unsigned*)(Abase + (kbyte) + o0_), (LAS unsigned*)(lds + (bufoff) + ldsw), 16, 0, 0); \
        __builtin_amdgcn_global_load_lds((const unsigned*)(Abase + (kbyte) + o1_), (LAS unsigned*)(lds + (bufoff) + ldsw + 8192), 16, 0, 0); } while (0)
#define PG8_LDA(dst, b, h) do { _Pragma("unroll") for (int m = 0; m < 4; ++m) { \
        if constexpr (FP8) { const v4i_t lo_ = *(const LAS v4i_t*)(lds + PG8_SA(b, h) + aoff + m * 2048), hi_ = *(const LAS v4i_t*)(lds + PG8_SA(b, h) + (aoff ^ 64) + m * 2048); dst##8[m] = __builtin_shufflevector(lo_, hi_, 0, 1, 2, 3, 4, 5, 6, 7); } \
        else { _Pragma("unroll") for (int k = 0; k < 2; ++k) dst[m][k] = *(const LAS bf16x8*)(lds + PG8_SA(b, h) + (aoff ^ (k * 64)) + m * 2048); } } } while (0)
#define PG8_LDB(dst, b, h) do { _Pragma("unroll") for (int n = 0; n < 2; ++n) { \
        if constexpr (FP8) { const v4i_t lo_ = *(const LAS v4i_t*)(lds + PG8_SB(b, h) + boff + n * 2048), hi_ = *(const LAS v4i_t*)(lds + PG8_SB(b, h) + (boff ^ 64) + n * 2048); dst##8[n] = __builtin_shufflevector(lo_, hi_, 0, 1, 2, 3, 4, 5, 6, 7); } \
        else { _Pragma("unroll") for (int k = 0; k < 2; ++k) dst[n][k] = *(const LAS bf16x8*)(lds + PG8_SB(b, h) + (boff ^ (k * 64)) + n * 2048); } } } while (0)
#define PG8_MMA(ai, bj, At, Bt) do { __builtin_amdgcn_s_setprio(1); _Pragma("unroll") for (int m = 0; m < 4; ++m) _Pragma("unroll") for (int n = 0; n < 2; ++n) { \
        if constexpr (FP8) { acc[ai][bj][m][n] = __builtin_amdgcn_mfma_scale_f32_16x16x128_f8f6f4(Bt##8[n], At##8[m], acc[ai][bj][m][n], 0, 0, 0, SCA, 0, SCA); } \
        else { _Pragma("unroll") for (int k = 0; k < 2; ++k) acc[ai][bj][m][n] = __builtin_amdgcn_mfma_f32_16x16x32_bf16(Bt[n][k], At[m][k], acc[ai][bj][m][n], 0, 0, 0); } } \
        __builtin_amdgcn_s_setprio(0); } while (0)
#define PG8_WAIT_V(n) asm volatile("s_waitcnt vmcnt(" #n ")" ::: "memory")
#define PG8_WAIT_L(n) asm volatile("s_waitcnt lgkmcnt(" #n ")" ::: "memory")
#define PG8_BAR __builtin_amdgcn_s_barrier()
#define PG8_SCHED __builtin_amdgcn_sched_barrier(0)
    typename Sched::Unit cur, nxt; int ui = 0;
    if (!S.next(0, cur)) return;
    f32x4 acc[2][2][4][2];
    bf16x8 At[4][2], B0[2][2], B1[2][2];
    v8i_t At8[4], B08[2], B18[2];
    { unsigned a4[2][2]; S.a_off(cur, R0, C0, R1, C1, a4); rg[0] = a4[0][0]; rg[1] = a4[0][1]; rg[2] = a4[1][0]; rg[3] = a4[1][1];
      if constexpr (FP8) { aofs[0] = a4[0][0]; aofs[NTHR] = a4[0][1]; aofs[2 * NTHR] = a4[1][0]; aofs[3 * NTHR] = a4[1][1]; } }
    const char* cB = S.b_ptr(cur);
#define PG8_BIAS_DMA(unit, slot) do { const float* bp_ = E.bias_ptr(unit); int tb_ = threadIdx.x; asm volatile("" : "+v"(tb_)); if (wr == 0 && bp_ != nullptr) \
        __builtin_amdgcn_global_load_lds((const unsigned*)(bp_ + (tb_ & 255)), (LAS unsigned*)(lds + LDS_BIAS + (slot) * 1024 + wid * 256), 4, 0, 0); } while (0)
    PG8_BIAS_DMA(cur, 0);
    PG8_STAGE_B(PG8_SB(0, 0), cB); PG8_STAGE_B(PG8_SB(0, 1), cB + hstep); PG8_STAGE_A(PG8_SA(0, 0), 0, 0, 0); PG8_STAGE_A(PG8_SA(0, 1), 0, 0, 1);
    if (wr == 1) PG8_BAR;
    PG8_WAIT_V(2); PG8_BAR;
    PG8_STAGE_B(PG8_SB(1, 0), cB + kstep); PG8_STAGE_A(PG8_SA(1, 0), kstep, 0, 0); PG8_STAGE_B(PG8_SB(1, 1), cB + hstep + kstep);
    PG8_WAIT_V(6); PG8_BAR;
    { int t3 = threadIdx.x; asm volatile("" : "+v"(t3)); E.init(acc, wc, (t3 & 63) >> 4, (const LAS float*)(lds + LDS_BIAS)); }
    for (;;) {
        const bool has_next = S.next(ui + 1, nxt);
        const char* nB = cB;
        if (has_next) PG8_BIAS_DMA(nxt, (ui + 1) % 3);
        if (has_next) { int t2 = threadIdx.x; asm volatile("" : "+v"(t2)); int r0, c0, r1, c1; stage_rc(t2 * 16, r0, c0); stage_rc(t2 * 16 + 8192, r1, c1); nB = S.b_ptr(nxt);
            if constexpr (Sched::LIST_DMA) { static_assert(!Sched::LIST_DMA || FP8, "list DMA lands in the LDS offset slots"); S.a_dma(nxt, r0, r1, (LAS unsigned*)(lds + LDS_AOFF + 4 * NTHR * 4 + wid * 256)); }
            else { unsigned a4[2][2]; S.a_off(nxt, r0, c0, r1, c1, a4);
                rg[4] = a4[0][0]; rg[5] = a4[0][1]; rg[6] = a4[1][0]; rg[7] = a4[1][1];
                if constexpr (FP8) { aofs[4 * NTHR] = a4[0][0]; aofs[5 * NTHR] = a4[0][1]; aofs[6 * NTHR] = a4[1][0]; aofs[7 * NTHR] = a4[1][1]; } } }
        else { rg[4] = rg[0]; rg[5] = rg[1]; rg[6] = rg[2]; rg[7] = rg[3];
            if constexpr (FP8) { aofs[4 * NTHR] = aofs[0]; aofs[5 * NTHR] = aofs[NTHR]; aofs[6 * NTHR] = aofs[2 * NTHR]; aofs[7 * NTHR] = aofs[3 * NTHR]; } }
#pragma unroll 1
        for (int t = 0; t < nt; t += 2) {
            const bool last = (t == nt - 2);
            const size_t ka1 = (size_t)(t + 1) * kstep, ka2 = last ? 0 : (size_t)(t + 2) * kstep, ka3 = ka2 + kstep;
            const char* b2 = last ? nB : cB + (size_t)(t + 2) * kstep; const char* b3 = b2 + kstep;
            const int sel = last ? 1 : 0;
            if constexpr (Sched::LIST_DMA) if (last && has_next) {
                int t4 = threadIdx.x; asm volatile("" : "+v"(t4)); int r0, c0, r1, c1; stage_rc(t4 * 16, r0, c0); stage_rc(t4 * 16 + 8192, r1, c1);
#pragma unroll
                for (int j = 0; j < 4; ++j) aofs[(4 + j) * NTHR] = S.a_fin(aofs[(4 + j) * NTHR], (j & 1) ? c1 : c0);
            }
            PG8_LDB(B0, 0, 0); PG8_LDB(B1, 0, 1); PG8_SCHED; PG8_LDA(At, 0, 0); PG8_STAGE_A(PG8_SA(1, 1), ka1, 0, 1);
            PG8_WAIT_V(8); PG8_WAIT_L(0); PG8_BAR; PG8_MMA(0, 0, At, B0); PG8_MMA(0, 1, At, B1); PG8_BAR; PG8_SCHED;
            PG8_LDA(At, 0, 1); PG8_STAGE_B(PG8_SB(0, 0), b2); PG8_STAGE_B(PG8_SB(0, 1), b2 + hstep); PG8_STAGE_A(PG8_SA(0, 0), ka2, sel, 0);
            PG8_WAIT_V(8); PG8_WAIT_L(0); PG8_BAR; PG8_MMA(1, 0, At, B0); PG8_MMA(1, 1, At, B1); PG8_BAR; PG8_SCHED;
            PG8_LDB(B0, 1, 0); PG8_LDB(B1, 1, 1); PG8_SCHED; PG8_LDA(At, 1, 0); PG8_STAGE_A(PG8_SA(0, 1), ka2, sel, 1);
            PG8_WAIT_V(8); PG8_WAIT_L(0); PG8_BAR; PG8_MMA(0, 0, At, B0); PG8_MMA(0, 1, At, B1); PG8_BAR; PG8_SCHED;
            PG8_LDA(At, 1, 1); PG8_STAGE_B(PG8_SB(1, 0), b3); PG8_STAGE_B(PG8_SB(1, 1), b3 + hstep); PG8_STAGE_A(PG8_SA(1, 0), ka3, sel, 0);
            PG8_WAIT_V(8); PG8_WAIT_L(0); PG8_BAR; PG8_MMA(1, 0, At, B0); PG8_MMA(1, 1, At, B1); PG8_BAR; PG8_SCHED;
        }
        if (wr == 0) PG8_BAR;
        { int t2 = threadIdx.x; asm volatile("" : "+v"(t2)); E(acc, cur, wr, wc, t2 & 15, (t2 & 63) >> 4, (const LAS float*)(lds + LDS_BIAS + (ui % 3) * 1024)); }
        if (!has_next) break;
        { int t3 = threadIdx.x; asm volatile("" : "+v"(t3)); E.init(acc, wc, (t3 & 63) >> 4, (const LAS float*)(lds + LDS_BIAS + ((ui + 1) % 3) * 1024)); }
        cur = nxt; cB = nB; ++ui;
        rg[0] = rg[4]; rg[1] = rg[5]; rg[2] = rg[6]; rg[3] = rg[7];
        if constexpr (FP8) { aofs[0] = aofs[4 * NTHR]; aofs[NTHR] = aofs[5 * NTHR]; aofs[2 * NTHR] = aofs[6 * NTHR]; aofs[3 * NTHR] = aofs[7 * NTHR]; }
        if (wr == 1) PG8_BAR;
    }
    PG8_WAIT_V(0);
    PG8_BAR;
#undef PG8_BIAS_DMA
#undef PG8_SA
#undef PG8_SB
#undef PG8_STAGE_A
#undef PG8_OFS
#undef PG8_STAGE_B
#undef PG8_LDA
#undef PG8_LDB
#undef PG8_MMA
#undef PG8_WAIT_V
#undef PG8_WAIT_L
#undef PG8_BAR
#undef PG8_SCHED
}
}

struct DenseUnit { int pm, pn; };
struct DenseSched {
    typedef DenseUnit Unit;
    const char* Bt; int K, nM, nN, vc;
    __device__ __forceinline__ bool next(int i, Unit& u) const { return pg8::tile_order(i, gridDim.x, vc, nM, nN, u.pm, u.pn); }
    __device__ __forceinline__ void a_off(const Unit& u, int R0, int C0, int R1, int C1, unsigned (&off)[2][2]) const {
#pragma unroll
        for (int h = 0; h < 2; ++h) { off[h][0] = (unsigned)((u.pm * 256 + h * 128 + R0) * K + C0) * 2u; off[h][1] = (unsigned)((u.pm * 256 + h * 128 + R1) * K + C1) * 2u; }
    }
    __device__ __forceinline__ const char* b_ptr(const Unit& u) const { return Bt + (size_t)u.pn * 256 * K * 2; }
    static constexpr bool LIST_DMA = false;
    __device__ __forceinline__ void a_dma(const Unit&, int, int, LAS unsigned*) const {}
    __device__ __forceinline__ unsigned a_fin(unsigned raw, int) const { return raw; }
};
struct MoeUnit { int rbt, e, pn; };
template <bool GATHER>
struct MoeSched {
    typedef MoeUnit Unit;
    static constexpr int KP = 512;
    const char* Bt; const int* lists; const int* ptile; const int* ecnt; int nN, nrows, vc;
    __device__ __forceinline__ bool next(int i, Unit& u) const {
        int pm, pn; if (!pg8::tile_order(i, gridDim.x, vc, ptile[NE], nN, pm, pn)) return false;
        u.rbt = pm; u.e = ((const unsigned char*)ptile)[512 + pm]; u.pn = pn; return true;
    }
    __device__ __forceinline__ void a_off(const Unit& u, int R0, int C0, int R1, int C1, unsigned (&off)[2][2]) const {
        if (GATHER) {
            const int* lst = lists + (size_t)u.e * LIST_CAP; const int rb = u.rbt - ptile[u.e], cnt = ecnt[u.e];
#pragma unroll
            for (int h = 0; h < 2; ++h) {
                const int l0 = rb * 256 + h * 128 + R0, l1 = rb * 256 + h * 128 + R1;
                const int t0 = l0 < cnt ? (lst[l0] >> 2) : 0, t1 = l1 < cnt ? (lst[l1] >> 2) : 0;
                off[h][0] = (unsigned)(t0 * KP + C0) * 2u; off[h][1] = (unsigned)(t1 * KP + C1) * 2u;
            }
        } else {
#pragma unroll
            for (int h = 0; h < 2; ++h) { off[h][0] = (unsigned)((u.rbt * 256 + h * 128 + R0) * KP + C0) * 2u; off[h][1] = (unsigned)((u.rbt * 256 + h * 128 + R1) * KP + C1) * 2u; }
        }
    }
    __device__ __forceinline__ const char* b_ptr(const Unit& u) const { return Bt + ((size_t)u.e * nrows + (size_t)u.pn * 256) * KP * 2; }
    static constexpr bool LIST_DMA = GATHER;
    __device__ __forceinline__ void a_dma(const Unit& u, int R0, int R1, LAS unsigned* slot) const {
        const int* lst = lists + (size_t)u.e * LIST_CAP; const int rb = u.rbt - ptile[u.e], cm = ecnt[u.e] - 1;
#pragma unroll
        for (int h = 0; h < 2; ++h) {
            const int l0 = min(rb * 256 + h * 128 + R0, cm), l1 = min(rb * 256 + h * 128 + R1, cm);
            __builtin_amdgcn_global_load_lds((const unsigned*)(lst + l0), slot + (h * 2) * NTHR, 4, 0, 0);
            __builtin_amdgcn_global_load_lds((const unsigned*)(lst + l1), slot + (h * 2 + 1) * NTHR, 4, 0, 0);
        }
    }
    __device__ __forceinline__ unsigned a_fin(unsigned raw, int C) const { return (unsigned)((int)(raw >> 2) * KP + C) * 2u; }
};

__device__ __forceinline__ u32x2 quad_tr(unsigned p01, unsigned p23, int fr) {
    const unsigned sel = (fr & 1) ? 0x03020706u : 0x05040100u;
    const unsigned y01 = (unsigned)__builtin_amdgcn_update_dpp(0, (int)p01, 0xB1, 0xF, 0xF, true), y23 = (unsigned)__builtin_amdgcn_update_dpp(0, (int)p23, 0xB1, 0xF, 0xF, true);
    const unsigned q01 = __builtin_amdgcn_perm(y01, p01, sel), q23 = __builtin_amdgcn_perm(y23, p23, sel);
    const bool hi = (fr & 2) != 0;
    const unsigned snd = hi ? q01 : q23;
    const unsigned rcv = (unsigned)__builtin_amdgcn_update_dpp(0, (int)snd, 0x4E, 0xF, 0xF, true);
    u32x2 r; r.x = hi ? rcv : q01; r.y = hi ? q23 : rcv; return r;
}
struct EpiInProj {
    const Params* p; int l;
    __device__ __forceinline__ const float* bias_ptr(const DenseUnit& u) const { return p->binp + l * NPAD + u.pn * 256; }
    __device__ __forceinline__ void init(f32x4 (&acc)[2][2][4][2], int wc, int fq, const LAS float* bias) const {
#pragma unroll
        for (int bj = 0; bj < 2; ++bj)
#pragma unroll
            for (int n = 0; n < 2; ++n) {
                const f32x4 bv = *(const LAS f32x4*)(bias + bj * 128 + wc * 32 + n * 16 + 4 * fq);
#pragma unroll
                for (int ai = 0; ai < 2; ++ai)
#pragma unroll
                    for (int m = 0; m < 4; ++m) acc[ai][bj][m][n] = bv;
            }
    }
    __device__ __forceinline__ void operator()(const f32x4 (&acc)[2][2][4][2], const DenseUnit& u, int wr, int wc, int fr, int fq, const LAS float*) const {
#pragma unroll
        for (int bj = 0; bj < 2; ++bj) {
            int kind = 0, hb0 = 0;
            if (u.pn == 1) { kind = 1; hb0 = bj * 2; } else if (u.pn == 4 && bj == 1) { kind = 1; hb0 = 4; } else if (u.pn == 8 && bj == 0) { kind = 1; hb0 = 6; } else if (u.pn == 9 && bj == 0) { kind = 1; hb0 = 8; }
            else if (u.pn == 2) { kind = 2; hb0 = bj * 2; } else if (u.pn == 5 && bj == 0) { kind = 2; hb0 = 4; } else if (u.pn == 8 && bj == 1) { kind = 2; hb0 = 6; } else if (u.pn == 9 && bj == 1) { kind = 2; hb0 = 8; }
            const int c0 = wc * 32 + fq * 8;
            const int hh = hb0 + (c0 >> 6), d0 = c0 & 63;
#pragma unroll
            for (int ai = 0; ai < 2; ++ai)
#pragma unroll
                for (int m = 0; m < 4; ++m) {
                    const int row = u.pm * 256 + ai * 128 + wr * 64 + m * 16 + fr;
                    const f32x4 v0 = acc[ai][bj][m][0], v1 = acc[ai][bj][m][1];
                    u32x4 w; w.x = pack2(v0[0], v0[1]); w.y = pack2(v0[2], v0[3]); w.z = pack2(v1[0], v1[1]); w.w = pack2(v1[2], v1[3]);
                    if (kind == 0) *(u32x4*)(p->hb + (size_t)row * NMAIN + u.pn * 256 + bj * 128 + c0) = w;
                    else {
                        const int b = row >> 11, s = row & 2047, kk = s & 31;
                        bf16_t* blk = (kind == 1 ? p->kF : p->vT) + (((size_t)b * NVH + hh) * 64 + (s >> 5)) * 2048;
                        if (kind == 1) {
                            const int frk = (kk >> 3) * 4 + (kk & 3), t = (kk >> 2) & 1;
                            *(u32x4*)(blk + ((t * 2 + (d0 >> 5)) * 64 + ((d0 & 31) >> 3) * 16 + frk) * 8) = w;
                        } else {
                            const int kq = kk & 28;
                            const u32x2 t0 = quad_tr(w.x, w.y, fr), t1 = quad_tr(w.z, w.w, fr);
                            bf16_t* vt = blk + (((d0 >> 4) * 64) + (kq >> 3) * 16 + (d0 & 15) + (fr & 3)) * 8 + (kq & 7);
                            *(u32x2*)vt = t0; *(u32x2*)(vt + 32) = t1;
                        }
                    }
                }
        }
    }
};
struct EpiOutProj {
    const bf16_t* xin; float* t;
    __device__ __forceinline__ const float* bias_ptr(const DenseUnit&) const { return nullptr; }
    __device__ __forceinline__ void init(f32x4 (&acc)[2][2][4][2], int, int, const LAS float*) const {
#pragma unroll
        for (int ai = 0; ai < 2; ++ai)
#pragma unroll
            for (int bj = 0; bj < 2; ++bj)
#pragma unroll
                for (int m = 0; m < 4; ++m)
#pragma unroll
                    for (int n = 0; n < 2; ++n) acc[ai][bj][m][n] = (f32x4){0.f, 0.f, 0.f, 0.f};
    }
    __device__ __forceinline__ void operator()(const f32x4 (&acc)[2][2][4][2], const DenseUnit& u, int wr, int wc, int fr, int fq, const LAS float*) const {
#pragma unroll
        for (int ai = 0; ai < 2; ++ai)
#pragma unroll
            for (int m = 0; m < 4; ++m) {
                const size_t off = (size_t)(u.pm * 256 + ai * 128 + wr * 64 + m * 16 + fr) * DM + u.pn * 256 + wc * 64 + fq * 16;
                const u32x4 x0 = *(const u32x4*)(xin + off), x1 = *(const u32x4*)(xin + off + 8);
                const unsigned xs[8] = {x0.x, x0.y, x0.z, x0.w, x1.x, x1.y, x1.z, x1.w};
                unsigned w[8];
#pragma unroll
                for (int q = 0; q < 4; ++q) {
                    const f32x4 a = acc[ai][q >> 1][m][q & 1];
                    const float t0 = __uint_as_float(xs[2 * q] << 16) * ALPHA + a[0], t1 = __uint_as_float(xs[2 * q] & 0xffff0000u) * ALPHA + a[1];
                    const float t2 = __uint_as_float(xs[2 * q + 1] << 16) * ALPHA + a[2], t3 = __uint_as_float(xs[2 * q + 1] & 0xffff0000u) * ALPHA + a[3];
                    w[2 * q] = pack2(t0, t1); w[2 * q + 1] = pack2(t2, t3);
                }
                u32x4 w0, w1; w0.x = w[0]; w0.y = w[1]; w0.z = w[2]; w0.w = w[3]; w1.x = w[4]; w1.y = w[5]; w1.z = w[6]; w1.w = w[7];
                *(u32x4*)((bf16_t*)t + off) = w0; *(u32x4*)((bf16_t*)t + off + 8) = w1;
            }
    }
};
struct EpiGateUp {
    bf16_t* act; const float* bgup;
    __device__ __forceinline__ const float* bias_ptr(const MoeUnit& u) const { return bgup + (size_t)u.e * 2048 + u.pn * 256; }
    __device__ __forceinline__ void init(f32x4 (&acc)[2][2][4][2], int wc, int fq, const LAS float* bias) const {
#pragma unroll
        for (int bj = 0; bj < 2; ++bj)
#pragma unroll
            for (int n = 0; n < 2; ++n) {
                const f32x4 bv = *(const LAS f32x4*)(bias + bj * 128 + wc * 32 + n * 16 + 4 * fq);
#pragma unroll
                for (int ai = 0; ai < 2; ++ai)
#pragma unroll
                    for (int m = 0; m < 4; ++m) acc[ai][bj][m][n] = bv;
            }
    }
    __device__ __forceinline__ void operator()(const f32x4 (&acc)[2][2][4][2], const MoeUnit& u, int wr, int wc, int fr, int fq, const LAS float*) const {
        constexpr float GMIN = 7.0f * GATE_PRE, CI = 1.0f / GATE_PRE;
#pragma unroll
        for (int ai = 0; ai < 2; ++ai)
#pragma unroll
            for (int m = 0; m < 4; ++m) {
                u32x2 w;
#pragma unroll
                for (int n = 0; n < 2; ++n) {
                    const f32x4 g4 = acc[ai][0][m][n], u4 = acc[ai][1][m][n];
                    float o[4];
#pragma unroll
                    for (int j = 0; j < 4; ++j) {
                        const float gp = fmaxf(g4[j], GMIN), uu = fminf(fmaxf(u4[j], -7.0f), 7.0f);
                        const float glu = gp * __builtin_amdgcn_rcpf(1.0f + __builtin_amdgcn_exp2f(gp));
                        o[j] = __builtin_fmaf(uu, CI, CI) * glu;
                    }
                    const unsigned pk = pack4_fp8(o[0], o[1], o[2], o[3]);
                    if (n == 0) w.x = pk; else w.y = pk;
                }
                *(u32x2*)((char*)act + (size_t)(u.rbt * 256 + ai * 128 + wr * 64 + m * 16 + fr) * DFF + u.pn * 128 + wc * 32 + fq * 8) = w;
            }
    }
};
struct EpiDown {
    bf16_t* ybuf; const float* bdn;
    __device__ __forceinline__ const float* bias_ptr(const MoeUnit& u) const { return bdn + (size_t)u.e * 1024 + u.pn * 256; }
    __device__ __forceinline__ void init(f32x4 (&acc)[2][2][4][2], int wc, int fq, const LAS float* bias) const {
#pragma unroll
        for (int bj = 0; bj < 2; ++bj)
#pragma unroll
            for (int n = 0; n < 2; ++n) {
                const f32x4 bv = *(const LAS f32x4*)(bias + wc * 64 + fq * 16 + bj * 8 + n * 4);
#pragma unroll
                for (int ai = 0; ai < 2; ++ai)
#pragma unroll
                    for (int m = 0; m < 4; ++m) acc[ai][bj][m][n] = bv;
            }
    }
    __device__ __forceinline__ void operator()(const f32x4 (&acc)[2][2][4][2], const MoeUnit& u, int wr, int wc, int fr, int fq, const LAS float*) const {
#pragma unroll
        for (int ai = 0; ai < 2; ++ai)
#pragma unroll
            for (int m = 0; m < 4; ++m) {
                u32x4 w;
                { const f32x4 v = acc[ai][0][m][0]; w.x = pack4_fp8(v[0], v[1], v[2], v[3]); }
                { const f32x4 v = acc[ai][0][m][1]; w.y = pack4_fp8(v[0], v[1], v[2], v[3]); }
                { const f32x4 v = acc[ai][1][m][0]; w.z = pack4_fp8(v[0], v[1], v[2], v[3]); }
                { const f32x4 v = acc[ai][1][m][1]; w.w = pack4_fp8(v[0], v[1], v[2], v[3]); }
                *(u32x4*)((unsigned char*)ybuf + (size_t)(u.rbt * 256 + ai * 128 + wr * 64 + m * 16 + fr) * DM + u.pn * 256 + wc * 64 + fq * 16) = w;
            }
    }
};

__device__ __forceinline__ void phase_inproj(const Params& p, int l, char* lds) {
    DenseSched S{(const char*)p.WinQ + (size_t)l * NMAIN * 1024, 512, NTOK / 256, NMAIN / 256, vcu_id()};
    EpiInProj E{&p, l};
    pg8::gemm_phase<true, 0x7c7c7c7c>((LAS unsigned char*)lds, (const char*)p.xq, 512, S, E);
    int tid = threadIdx.x; asm volatile("" : "+v"(tid));
    const int wid = tid >> 6, lane = tid & 63, fr = lane & 15, fq = lane >> 4;
    const bf16_t* W = p.WinT + ((size_t)l * NPAD + NMAIN) * 1024;
    const float* bias = p.binp + l * NPAD + NMAIN;
    constexpr int WP = 2064;
#pragma unroll
    for (int i = 0; i < 8; ++i) { const int pc = wid * 8 + i, r = pc >> 1, q = pc & 1;
        __builtin_amdgcn_global_load_lds((const unsigned*)(W + (size_t)r * 1024 + q * 512 + lane * 8), (LAS unsigned*)((LAS char*)lds + r * WP + q * 1024), 16, 0, 0); }
    asm volatile("s_waitcnt vmcnt(0)" ::: "memory");
    __syncthreads();
    for (int u = blockIdx.x * NWV + wid; u < NTOK / 16; u += gridDim.x * NWV) {
        const bf16_t* ar = p.xb + (size_t)(u * 16 + fr) * DM + fq * 8;
        const LAS char* w0 = (const LAS char*)lds + fr * WP + fq * 16; const LAS char* w1 = w0 + 16 * WP;
        f32x4 a0 = (f32x4){0.f, 0.f, 0.f, 0.f}, a1 = a0;
#pragma unroll 4
        for (int ks = 0; ks < 32; ++ks) {
            const bf16x8 a = *(const bf16x8*)(ar + ks * 32);
            a0 = __builtin_amdgcn_mfma_f32_16x16x32_bf16(a, *(const LAS bf16x8*)(w0 + ks * 64), a0, 0, 0, 0);
            a1 = __builtin_amdgcn_mfma_f32_16x16x32_bf16(a, *(const LAS bf16x8*)(w1 + ks * 64), a1, 0, 0, 0);
        }
#pragma unroll
        for (int r = 0; r < 4; ++r) {
            float* dst = p.hs + (size_t)(u * 16 + fq * 4 + r) * HS_W;
            dst[fr] = a0[r] + bias[fr];
            if (fr < 6) dst[16 + fr] = a1[r] + bias[16 + fr];
        }
    }
}
__device__ __forceinline__ void phase_outproj(const Params& p, int l, const bf16_t* xin, char* lds) {
    DenseSched S{(const char*)p.WoT + (size_t)l * 1024 * 1024, 512, NTOK / 256, 4, vcu_id()};
    EpiOutProj E{xin, p.tbuf};
    pg8::gemm_phase<true, 0x7c7c7c7c>((LAS unsigned char*)lds, (const char*)p.ob, 512, S, E);
}
__device__ __forceinline__ void build_tiles(const Params& p, int l, int* ptile, int* ecnt) {
    int tid = threadIdx.x; asm volatile("" : "+v"(tid));
    if (tid < NE) ecnt[tid] = (int)__hip_atomic_load(p.ctrl + 64 + l * NE + tid, __ATOMIC_RELAXED, __HIP_MEMORY_SCOPE_AGENT);
    __syncthreads();
    if (tid == 0) { int s = 0; for (int e = 0; e < NE; ++e) { ptile[e] = s; s += (ecnt[e] + 255) >> 8; } ptile[NE] = s; }
    __syncthreads();
    unsigned char* texp = (unsigned char*)ptile + 512;
    for (int t = tid; t < ptile[NE]; t += NTHR) { int e = 0; while (ptile[e + 1] <= t) ++e; texp[t] = (unsigned char)e; }
    __syncthreads();
}
__device__ __forceinline__ void phase_gateup(const Params& p, int l, char* lds) {
    int* ptile = (int*)(lds + LDS_TAB); int* ecnt = ptile + 40;
    build_tiles(p, l, ptile, ecnt);
    MoeSched<true> S{(const char*)p.WguT + (size_t)l * NE * 2048 * 1024, p.lists, ptile, ecnt, 8, 2048, vcu_id()};
    EpiGateUp E{p.act, p.bgup + (size_t)l * NE * 2048};
    pg8::gemm_phase<true, 0x7c7c7c7c>((LAS unsigned char*)lds, (const char*)p.x1b, 512, S, E);
}
__device__ __forceinline__ void phase_down(const Params& p, int l, char* lds) {
    int* ptile = (int*)(lds + LDS_TAB); int* ecnt = ptile + 40;
    MoeSched<false> S{(const char*)p.WdnT + (size_t)l * NE * 1024 * 1024, p.lists, ptile, ecnt, 4, 1024, vcu_id()};
    EpiDown E{p.ybuf, p.b_dn + (size_t)l * NE * 1024};
    pg8::gemm_phase<true, 0x7c7c7c7c>((LAS unsigned char*)lds, (const char*)p.act, 512, S, E);
}

__device__ __forceinline__ float gelu_tanh(float x) {
    const float u = 0.7978845608028654f * (x + 0.044715f * x * x * x);
    const float e = __expf(-2.0f * fabsf(u)); const float th = (1.0f - e) / (1.0f + e);
    return 0.5f * x * (1.0f + (u < 0.f ? -th : th));
}
__device__ __forceinline__ void phase_prep(const Params& p, int l, char* lds) {
    int tid = threadIdx.x; asm volatile("" : "+v"(tid));
    const int wid = tid >> 6, lane = tid & 63, fr = lane & 15, fq = lane >> 4;
    const int gw = blockIdx.x * NWV + wid, nw = gridDim.x * NWV;
    for (int u = (int)gridDim.x - 1 - (int)blockIdx.x; u < NB * 4; u += gridDim.x) {
        const int b = u >> 2, h = u & 3;
        const float* srcp = p.hs + ((size_t)b * SEQ + tid * 4) * HS_W + h;
        float ls[4]; float tot = 0.f;
#pragma unroll
        for (int i = 0; i < 4; ++i) { const float f = srcp[(size_t)i * HS_W]; ls[i] = fminf(f, 0.f) - log1pf(__expf(-fabsf(f))); tot += ls[i]; }
        float inc = tot;
#pragma unroll
        for (int o = 1; o < 64; o <<= 1) { const float v = shfl_f(inc, lane - o); if (lane >= o) inc += v; }
        float* wtot = (float*)(lds + 65536);
        if (lane == 63) wtot[wid] = inc;
        __syncthreads();
        float base = inc - tot;
        for (int w = 0; w < wid; ++w) base += wtot[w];
        float4 o4; o4.x = base + ls[0]; o4.y = o4.x + ls[1]; o4.z = o4.y + ls[2]; o4.w = o4.z + ls[3];
        *(float4*)(p.cF + (size_t)u * SEQ + tid * 4) = o4;
        __syncthreads();
    }
    float* part = (float*)lds;
    bf16_t* h1 = (bf16_t*)(lds + 32768);
    for (int u = blockIdx.x; u < NB * 2 * 2 * 8; u += gridDim.x) {
        const int ct = u & 7, which = (u >> 3) & 1, kvh = (u >> 4) & 1, b = u >> 5;
        const int colo = (which ? C_NVC : C_NKC) + kvh * 64;
        const int c_lane = ct * 16 + fr;
        const int tokbase = min(c_lane, 126) * 16;
        const bf16_t* arow = p.hb + ((size_t)b * SEQ + tokbase) * NMAIN + colo + fq * 8;
        const bf16_t* w1 = p.W1T + ((size_t)(l * 2 + which) * 64 + fr) * 2048 + fq * 8;
        f32x4 acc[4];
#pragma unroll
        for (int n = 0; n < 4; ++n) acc[n] = (f32x4){0.f, 0.f, 0.f, 0.f};
#pragma unroll
        for (int kk = 0; kk < 8; ++kk) {
            const int ks = wid * 8 + kk;
            const bf16x8 a = *(const bf16x8*)(arow + (size_t)(ks >> 1) * NMAIN + (ks & 1) * 32);
#pragma unroll
            for (int n = 0; n < 4; ++n) {
                const bf16x8 bb = *(const bf16x8*)(w1 + (size_t)n * 16 * 2048 + ks * 32);
                acc[n] = __builtin_amdgcn_mfma_f32_16x16x32_bf16(a, bb, acc[n], 0, 0, 0);
            }
        }
#pragma unroll
        for (int n = 0; n < 4; ++n)
#pragma unroll
            for (int r = 0; r < 4; ++r) part[wid * 1024 + (fq * 4 + r) * 64 + n * 16 + fr] = acc[n][r];
        __syncthreads();
        const float* b1 = p.b1c + (l * 2 + which) * 8 * 64;
#pragma unroll
        for (int i = 0; i < 2; ++i) {
            const int e = tid + NTHR * i; float sum = 0.f, bsum = 0.f;
#pragma unroll
            for (int w = 0; w < 8; ++w) { sum += part[w * 1024 + e]; bsum += b1[w * 64 + (e & 63)]; }
            h1[e] = f2bf(gelu_tanh(sum + bsum));
        }
        __syncthreads();
        if (wid == 0) {
            const bf16_t* w2 = p.W2T + ((size_t)(l * 2 + which) * 64 + fr) * 64 + fq * 8;
            f32x4 o2[4];
#pragma unroll
            for (int n = 0; n < 4; ++n) o2[n] = (f32x4){0.f, 0.f, 0.f, 0.f};
#pragma unroll
            for (int ks = 0; ks < 2; ++ks) {
                const bf16x8 a = *(const bf16x8*)(h1 + fr * 64 + ks * 32 + fq * 8);
#pragma unroll
                for (int n = 0; n < 4; ++n) {
                    const bf16x8 bb = *(const bf16x8*)(w2 + (size_t)n * 16 * 64 + ks * 32);
                    o2[n] = __builtin_amdgcn_mfma_f32_16x16x32_bf16(a, bb, o2[n], 0, 0, 0);
                }
            }
            const size_t base = ((size_t)b * 2 + kvh) * 128 * 64;
#pragma unroll
            for (int n = 0; n < 4; ++n)
#pragma unroll
                for (int r = 0; r < 4; ++r) {
                    const int c = ct * 16 + fq * 4 + r, j2 = n * 16 + fr;
                    const bf16_t v = c < 127 ? f2bf(o2[n][r]) : (bf16_t)0;
                    if (which == 0) p.kc[base + (size_t)c * 64 + j2] = v;
                    else { p.vc[base + (size_t)c * 64 + j2] = v; p.vcT[base + (size_t)j2 * 128 + c] = v; }
                }
        }
        __syncthreads();
    }
}

constexpr float L2E = 1.4426950408889634f, MASKV = -__builtin_huge_valf(), MINIT = -1e30f, SCL2 = QSCALE * L2E;
struct KVFrag { bf16x8 k[2][2]; bf16x8 v[4]; };
template <bool FM>
__device__ __forceinline__ void k_load(KVFrag& f, const bf16_t* __restrict__ Kb, size_t ldk, int kc0, int fr, int fq) {
    if (FM) {
        const bf16_t* kp = Kb + (size_t)(kc0 >> 5) * 2048 + (fq * 16 + fr) * 8;
        f.k[0][0] = *(const bf16x8*)(kp); f.k[0][1] = *(const bf16x8*)(kp + 512); f.k[1][0] = *(const bf16x8*)(kp + 1024); f.k[1][1] = *(const bf16x8*)(kp + 1536);
    } else {
        const bf16_t* kp = Kb + (size_t)(kc0 + (fr >> 2) * 8 + (fr & 3)) * ldk + fq * 8;
        f.k[0][0] = *(const bf16x8*)(kp); f.k[0][1] = *(const bf16x8*)(kp + 32);
        f.k[1][0] = *(const bf16x8*)(kp + 4 * ldk); f.k[1][1] = *(const bf16x8*)(kp + 4 * ldk + 32);
    }
}
template <bool FM>
__device__ __forceinline__ void v_load(bf16x8 (&v)[4], const bf16_t* __restrict__ VTb, size_t ldv, int kc0, int fr, int fq) {
    if (FM) {
        const bf16_t* vp = VTb + (size_t)(kc0 >> 5) * 2048 + (fq * 16 + fr) * 8;
#pragma unroll
        for (int dt = 0; dt < 4; ++dt) v[dt] = *(const bf16x8*)(vp + dt * 512);
    } else {
        const bf16_t* vp = VTb + (size_t)fr * ldv + kc0 + fq * 8;
#pragma unroll
        for (int dt = 0; dt < 4; ++dt) v[dt] = *(const bf16x8*)(vp + (size_t)dt * 16 * ldv);
    }
}
__device__ __forceinline__ float rowmax4(float x) {
    auto r = __builtin_amdgcn_permlane32_swap(__float_as_uint(x), __float_as_uint(x), false, false);
    x = fmaxf(__uint_as_float(r[0]), __uint_as_float(r[1]));
    auto q = __builtin_amdgcn_permlane16_swap(__float_as_uint(x), __float_as_uint(x), false, false);
    return fmaxf(__uint_as_float(q[0]), __uint_as_float(q[1]));
}
__device__ __forceinline__ float rowsum4(float x) {
    auto r = __builtin_amdgcn_permlane32_swap(__float_as_uint(x), __float_as_uint(x), false, false);
    x = __uint_as_float(r[0]) + __uint_as_float(r[1]);
    auto q = __builtin_amdgcn_permlane16_swap(__float_as_uint(x), __float_as_uint(x), false, false);
    return __uint_as_float(q[0]) + __uint_as_float(q[1]);
}
template <int NQT, bool MASK, class MB>
__device__ __forceinline__ void attn_compute(const KVFrag& f, const bf16x8 (&qf)[NQT][2], f32x4 (&o)[NQT][4], float (&m)[NQT], float (&l)[NQT], const MB& mb) {
    f32x4 s0[NQT], s1[NQT];
#pragma unroll
    for (int qt = 0; qt < NQT; ++qt) {
        s0[qt] = __builtin_amdgcn_mfma_f32_16x16x32_bf16(f.k[0][0], qf[qt][0], (f32x4){0.f, 0.f, 0.f, 0.f}, 0, 0, 0);
        s1[qt] = __builtin_amdgcn_mfma_f32_16x16x32_bf16(f.k[1][0], qf[qt][0], (f32x4){0.f, 0.f, 0.f, 0.f}, 0, 0, 0);
    }
#pragma unroll
    for (int qt = 0; qt < NQT; ++qt) {
        s0[qt] = __builtin_amdgcn_mfma_f32_16x16x32_bf16(f.k[0][1], qf[qt][1], s0[qt], 0, 0, 0);
        s1[qt] = __builtin_amdgcn_mfma_f32_16x16x32_bf16(f.k[1][1], qf[qt][1], s1[qt], 0, 0, 0);
    }
    float mx[NQT];
#pragma unroll
    for (int qt = 0; qt < NQT; ++qt) {
#pragma unroll
        for (int j = 0; j < 4; ++j) { s0[qt][j] = mb(qt, j, s0[qt][j]); s1[qt][j] = mb(qt, j + 4, s1[qt][j]); }
        mx[qt] = fmaxf(fmaxf(fmaxf(s0[qt][0], s0[qt][1]), fmaxf(s0[qt][2], s0[qt][3])), fmaxf(fmaxf(s1[qt][0], s1[qt][1]), fmaxf(s1[qt][2], s1[qt][3])));
    }
#pragma unroll
    for (int qt = 0; qt < NQT; ++qt) mx[qt] = rowmax4(mx[qt]);
    bool moved = false;
#pragma unroll
    for (int qt = 0; qt < NQT; ++qt) { mx[qt] = fmaxf(m[qt], mx[qt]); moved |= (mx[qt] != m[qt]); }
    if (__ballot(moved) != 0ull) {
#pragma unroll
        for (int qt = 0; qt < NQT; ++qt) {
            const float alpha = __builtin_amdgcn_exp2f(m[qt] - mx[qt]);
            l[qt] *= alpha;
#pragma unroll
            for (int dt = 0; dt < 4; ++dt) o[qt][dt] *= alpha;
        }
    }
    bf16x8 pf[NQT];
#pragma unroll
    for (int qt = 0; qt < NQT; ++qt) {
        m[qt] = mx[qt];
        float pr[8]; float ps = 0.f;
#pragma unroll
        for (int j = 0; j < 4; ++j) {
            pr[j] = __builtin_amdgcn_exp2f(s0[qt][j] - mx[qt]);
            pr[j + 4] = __builtin_amdgcn_exp2f(s1[qt][j] - mx[qt]);
        }
#pragma unroll
        for (int j = 0; j < 8; ++j) ps += pr[j];
        l[qt] += ps;
        const u32x4 pk = {pack2(pr[0], pr[1]), pack2(pr[2], pr[3]), pack2(pr[4], pr[5]), pack2(pr[6], pr[7])};
        pf[qt] = __builtin_bit_cast(bf16x8, pk);
    }
#pragma unroll
    for (int dt = 0; dt < 4; ++dt)
#pragma unroll
        for (int qt = 0; qt < NQT; ++qt) o[qt][dt] = __builtin_amdgcn_mfma_f32_16x16x32_bf16(f.v[dt], pf[qt], o[qt][dt], 0, 0, 0);
    __builtin_amdgcn_sched_barrier(0);
}
struct RangeIt { int c, c_hi; __device__ __forceinline__ int nxt() { if (c > c_hi) return -1; return (c++) * 32; } };
struct MaskIt { unsigned long long cm; __device__ __forceinline__ int nxt() { if (!cm) return -1; const int i = __builtin_ctzll(cm); cm &= cm - 1; return i * 32; } };
template <bool PFV, bool FM, class It, class Gen>
__device__ __forceinline__ void attn_run(It& it, const bf16_t* Kb, size_t ldk, const bf16_t* VTb, size_t ldv, int fr, int fq, const Gen& gen) {
    KVFrag fa, fb;
    int ka = it.nxt(); if (ka < 0) return;
    k_load<FM>(fa, Kb, ldk, ka, fr, fq); if (PFV) v_load<FM>(fa.v, VTb, ldv, ka, fr, fq);
    for (;;) {
        const int kb = it.nxt(); if (kb >= 0) { k_load<FM>(fb, Kb, ldk, kb, fr, fq); if (PFV) v_load<FM>(fb.v, VTb, ldv, kb, fr, fq); }
        if (!PFV) v_load<FM>(fa.v, VTb, ldv, ka, fr, fq);
        gen(ka, fa);
        if (kb < 0) break;
        ka = it.nxt(); if (ka >= 0) { k_load<FM>(fa, Kb, ldk, ka, fr, fq); if (PFV) v_load<FM>(fa.v, VTb, ldv, ka, fr, fq); }
        if (!PFV) v_load<FM>(fb.v, VTb, ldv, kb, fr, fq);
        gen(kb, fb);
        if (ka < 0) break;
    }
}
template <int NQT>
__device__ __forceinline__ void attn_init(f32x4 (&o)[NQT][4], float (&m)[NQT], float (&l)[NQT]) {
#pragma unroll
    for (int qt = 0; qt < NQT; ++qt) { m[qt] = MINIT; l[qt] = 0.f;
#pragma unroll
        for (int dt = 0; dt < 4; ++dt) o[qt][dt] = (f32x4){0.f, 0.f, 0.f, 0.f}; }
}
__device__ __forceinline__ float lsum4(float l) { return rowsum4(l); }
__device__ __forceinline__ void store_o16(unsigned char* dst, const f32x4 v0, const f32x4 v1, const f32x4 v2, const f32x4 v3) {
    u32x4 w; w.x = pack4_fp8(v0[0], v0[1], v0[2], v0[3]); w.y = pack4_fp8(v1[0], v1[1], v1[2], v1[3]); w.z = pack4_fp8(v2[0], v2[1], v2[2], v2[3]); w.w = pack4_fp8(v3[0], v3[1], v3[2], v3[3]);
    *(u32x4*)dst = w;
}
__device__ __forceinline__ float sigmoidf_fast(float x) { return __builtin_amdgcn_rcpf(1.0f + __builtin_amdgcn_exp2f(-L2E * x)); }

__device__ __forceinline__ void fox_unit(const Params& p, int b, int h, int qb, int fr, int fq) {
    asm volatile("" : "+v"(fr), "+v"(fq));
    const int t0 = qb * 64;
    const bf16_t* Qb = p.hb + ((size_t)b * SEQ + t0) * NMAIN + C_FQ + h * 64 + fq * 8;
    bf16x8 qf[4][2];
#pragma unroll
    for (int qt = 0; qt < 4; ++qt) { qf[qt][0] = *(const bf16x8*)(Qb + (size_t)(qt * 16 + fr) * NMAIN); qf[qt][1] = *(const bf16x8*)(Qb + (size_t)(qt * 16 + fr) * NMAIN + 32); }
    const float* cf = p.cF + ((size_t)b * 4 + h) * SEQ;
    float cq[4];
#pragma unroll
    for (int qt = 0; qt < 4; ++qt) cq[qt] = cf[t0 + qt * 16 + fr] * L2E;
    f32x4 o[4][4]; float m[4], l[4];
    attn_init<4>(o, m, l);
    const bf16_t* Kb = p.kF + ((size_t)b * NVH + h) * 64 * SEQ;
    const bf16_t* VTb = p.vT + ((size_t)b * NVH + h) * 64 * SEQ;
    RangeIt it{0, (t0 >> 5) + 1};
    attn_run<false, true>(it, Kb, NMAIN, VTb, SEQ, fr, fq, [&](int kc0, const KVFrag& f) {
        const float4 ca = *(const float4*)(cf + kc0 + 8 * fq), cb = *(const float4*)(cf + kc0 + 8 * fq + 4);
        const float ck[8] = {ca.x * L2E, ca.y * L2E, ca.z * L2E, ca.w * L2E, cb.x * L2E, cb.y * L2E, cb.z * L2E, cb.w * L2E};
        const int kq = kc0 + 8 * fq - t0 - fr;
        attn_compute<4, true>(f, qf, o, m, l, [&](int qt, int j, float raw) { return (kq + j - 16 * qt) > 0 ? MASKV : raw * SCL2 + cq[qt] - ck[j]; });
    });
#pragma unroll
    for (int qt = 0; qt < 4; ++qt) {
        const float inv = __builtin_amdgcn_rcpf(lsum4(l[qt]));
        unsigned char* dst = (unsigned char*)p.ob + ((size_t)b * SEQ + t0 + qt * 16 + fr) * DM + h * 64 + 16 * fq;
        store_o16(dst, o[qt][0] * inv, o[qt][1] * inv, o[qt][2] * inv, o[qt][3] * inv);
    }
}
__device__ __forceinline__ void swa_unit(const Params& p, int l_, int b, int kv, int pos, int fr, int fq) {
    asm volatile("" : "+v"(fr), "+v"(fq));
    const int t0 = pos * 16, t = t0 + fr;
    const bf16_t* Qb = p.hb + ((size_t)b * SEQ + t) * NMAIN + C_SQ + kv * 192 + fq * 8;
    bf16x8 qf[3][2];
#pragma unroll
    for (int g = 0; g < 3; ++g) { qf[g][0] = *(const bf16x8*)(Qb + g * 64); qf[g][1] = *(const bf16x8*)(Qb + g * 64 + 32); }
    float sl[3];
#pragma unroll
    for (int g = 0; g < 3; ++g) sl[g] = slope_swa(kv * 3 + g) * L2E;
    f32x4 o[3][4]; float m[3], l[3];
    attn_init<3>(o, m, l);
    const bf16_t* Kb = p.kF + ((size_t)b * NVH + 4 + kv) * 64 * SEQ;
    const bf16_t* VTb = p.vT + ((size_t)b * NVH + 4 + kv) * 64 * SEQ;
    RangeIt it{max(0, t0 - 127) >> 5, (t0 + 15) >> 5};
    attn_run<true, true>(it, Kb, NMAIN, VTb, SEQ, fr, fq, [&](int kc0, const KVFrag& f) {
        const int dq = t - kc0 - 8 * fq;
        attn_compute<3, true>(f, qf, o, m, l, [&](int g, int j, float raw) { const int dist = dq - j; return ((unsigned)dist < 128u) ? raw * SCL2 - sl[g] * (float)dist : MASKV; });
    });
#pragma unroll
    for (int g = 0; g < 3; ++g) {
        const float sink = p.sinks[l_ * 6 + kv * 3 + g] * L2E;
        const float inv = __builtin_amdgcn_rcpf(lsum4(l[g]) + __builtin_amdgcn_exp2f(sink - m[g]));
        unsigned char* dst = (unsigned char*)p.ob + ((size_t)b * SEQ + t) * DM + 256 + (kv * 3 + g) * 64 + 16 * fq;
        store_o16(dst, o[g][0] * inv, o[g][1] * inv, o[g][2] * inv, o[g][3] * inv);
    }
}
__device__ __forceinline__ void nsa_unit(const Params& p, int b, int kv, int pos, int fr, int fq, int lane, float* ps, unsigned* msk, float* otl) {
    asm volatile("" : "+v"(fr), "+v"(fq), "+v"(lane));
    const int t0 = pos * 16, t = t0 + fr, cur = t0 >> 6;
    const bf16_t* Qb = p.hb + ((size_t)b * SEQ + t) * NMAIN + C_NQ + kv * 192 + fq * 8;
    bf16x8 qf[3][2];
#pragma unroll
    for (int g = 0; g < 3; ++g) { qf[g][0] = *(const bf16x8*)(Qb + g * 64); qf[g][1] = *(const bf16x8*)(Qb + g * 64 + 32); }
    float sl[3];
#pragma unroll
    for (int g = 0; g < 3; ++g) sl[g] = slope_nsa(kv * 3 + g) * L2E;
    const float* gl = p.hs + ((size_t)b * SEQ + t) * HS_W + 4 + kv * 9;
    f32x4 o[3][4]; float m[3], l[3];
    f32x4* otv = (f32x4*)otl + lane;
#pragma unroll
    for (int i = 0; i < 8; ++i) ps[lane + 64 * i] = 0.f;
    {
        const bf16_t* Kb = p.kc + ((size_t)b * 2 + kv) * 128 * 64;
        const bf16_t* VTb = p.vcT + ((size_t)b * 2 + kv) * 64 * 128;
        const int ncv = (t0 + 15 >= 31) ? ((t0 + 15 - 31) >> 4) + 1 : 0;
        const int nch = (ncv + 31) >> 5;
        attn_init<3>(o, m, l);
        const int dq0 = t - 31 - 16 * 8 * fq;
        RangeIt it{0, nch - 1};
        attn_run<false, false>(it, Kb, 64, VTb, 128, fr, fq, [&](int kc0, const KVFrag& f) {
            const int dq = dq0 - 16 * kc0;
            attn_compute<3, true>(f, qf, o, m, l, [&](int g, int j, float raw) { const int dist = dq - 16 * j; return dist >= 0 ? raw * SCL2 - sl[g] * (float)dist : MASKV; });
        });
        float il[3];
#pragma unroll
        for (int g = 0; g < 3; ++g) {
            const float lt = lsum4(l[g]); il[g] = lt > 0.f ? __builtin_amdgcn_rcpf(lt) : 0.f;
            const float gate = sigmoidf_fast(gl[g * 3 + 0]);
#pragma unroll
            for (int dt = 0; dt < 4; ++dt) otv[(g * 4 + dt) * 64] = o[g][dt] * (il[g] * gate);
        }
        float carry_prev = 0.f;
        for (int c = 0; c < nch; ++c) {
            const int kc0 = c * 32, dq = dq0 - 16 * kc0;
            const bf16_t* kp = Kb + (size_t)(kc0 + (fr >> 2) * 8 + (fr & 3)) * 64 + fq * 8;
            const bf16x8 k00 = *(const bf16x8*)(kp), k01 = *(const bf16x8*)(kp + 32), k10 = *(const bf16x8*)(kp + 256), k11 = *(const bf16x8*)(kp + 256 + 32);
            float pc[8];
#pragma unroll
            for (int j = 0; j < 8; ++j) pc[j] = 0.f;
#pragma unroll
            for (int g = 0; g < 3; ++g) {
                f32x4 s0 = (f32x4){0.f, 0.f, 0.f, 0.f}, s1 = s0;
                s0 = __builtin_amdgcn_mfma_f32_16x16x32_bf16(k00, qf[g][0], s0, 0, 0, 0); s0 = __builtin_amdgcn_mfma_f32_16x16x32_bf16(k01, qf[g][1], s0, 0, 0, 0);
                s1 = __builtin_amdgcn_mfma_f32_16x16x32_bf16(k10, qf[g][0], s1, 0, 0, 0); s1 = __builtin_amdgcn_mfma_f32_16x16x32_bf16(k11, qf[g][1], s1, 0, 0, 0);
#pragma unroll
                for (int j = 0; j < 8; ++j) {
                    const int dist = dq - 16 * j; const float raw = j < 4 ? s0[j] : s1[j - 4];
                    if (dist >= 0) pc[j] += __builtin_amdgcn_exp2f(raw * SCL2 - sl[g] * (float)dist - m[g]) * il[g];
                }
            }
            const float cout = 0.5f * pc[7];
            float cin = shfl_f(cout, lane - 16);
            const float cwrap = shfl_f(cout, fr + 48);
            if (fq == 0) cin = carry_prev;
            carry_prev = cwrap;
            const int n0 = (kc0 >> 2) + 2 * fq;
            ps[fr * 32 + n0] = cin + pc[0] + pc[1] + pc[2] + 0.5f * pc[3];
            ps[fr * 32 + n0 + 1] = 0.5f * pc[3] + pc[4] + pc[5] + pc[6] + 0.5f * pc[7];
        }
    }
    lds_wave_sync();
    if (lane < 16) {
        unsigned mask = 1u | (1u << cur); if (cur >= 1) mask |= 1u << (cur - 1);
        if (cur >= 3) {
            if (cur - 2 <= 5) mask |= (1u << (cur - 1)) - 2u;
            else {
                const float* my = ps + lane * 32;
                for (int r = 0; r < 5; ++r) {
                    float best = -1.0f; int bi = 1;
                    for (int j = 1; j <= cur - 2; ++j) { const float v = my[j]; if (!((mask >> j) & 1u) && v > best) { best = v; bi = j; } }
                    mask |= 1u << bi;
                }
            }
        }
        msk[lane] = mask;
    }
    lds_wave_sync();
    const unsigned qmask = msk[fr];
    lds_wave_sync();
    {
        const bf16_t* Kb = p.kF + ((size_t)b * NVH + 6 + kv) * 64 * SEQ;
        const bf16_t* VTb = p.vT + ((size_t)b * NVH + 6 + kv) * 64 * SEQ;
        attn_init<3>(o, m, l);
        unsigned um = qmask;
        um |= shfl_u(um, lane ^ 1); um |= shfl_u(um, lane ^ 2); um |= shfl_u(um, lane ^ 4); um |= shfl_u(um, lane ^ 8);
        um = (unsigned)__builtin_amdgcn_readfirstlane((int)um) & (cur >= 31 ? 0xffffffffu : ((2u << cur) - 1u));
        unsigned long long cm = 0ull;
        for (unsigned r = um; r; r &= r - 1) { const int kb = __builtin_ctz(r); cm |= 3ull << (2 * kb); }
        MaskIt it{cm};
        attn_run<true, true>(it, Kb, NMAIN, VTb, SEQ, fr, fq, [&](int kc0, const KVFrag& f) {
            const bool mine = (qmask >> (kc0 >> 6)) & 1u;
            const int dq = t - kc0 - 8 * fq;
            attn_compute<3, true>(f, qf, o, m, l, [&](int g, int j, float raw) { const int dist = dq - j; return (mine && dist >= 0) ? raw * SCL2 - sl[g] * (float)dist : MASKV; });
        });
#pragma unroll
        for (int g = 0; g < 3; ++g) {
            const float lt = lsum4(l[g]); const float sc = (lt > 0.f ? __builtin_amdgcn_rcpf(lt) : 0.f) * sigmoidf_fast(gl[g * 3 + 1]);
#pragma unroll
            for (int dt = 0; dt < 4; ++dt) otv[(g * 4 + dt) * 64] += o[g][dt] * sc;
        }
    }
    {
        const bf16_t* Kb = p.kF + ((size_t)b * NVH + 8 + kv) * 64 * SEQ;
        const bf16_t* VTb = p.vT + ((size_t)b * NVH + 8 + kv) * 64 * SEQ;
        attn_init<3>(o, m, l);
        RangeIt it{max(0, t0 - 511) >> 5, (t0 + 15) >> 5};
        attn_run<true, true>(it, Kb, NMAIN, VTb, SEQ, fr, fq, [&](int kc0, const KVFrag& f) {
            const int dq = t - kc0 - 8 * fq;
            attn_compute<3, true>(f, qf, o, m, l, [&](int g, int j, float raw) { const int dist = dq - j; return ((unsigned)dist < 512u) ? raw * SCL2 - sl[g] * (float)dist : MASKV; });
        });
#pragma unroll
        for (int g = 0; g < 3; ++g) {
            const float lt = lsum4(l[g]); const float sc = (lt > 0.f ? __builtin_amdgcn_rcpf(lt) : 0.f) * sigmoidf_fast(gl[g * 3 + 2]);
            unsigned char* dst = (unsigned char*)p.ob + ((size_t)b * SEQ + t) * DM + 640 + (kv * 3 + g) * 64 + 16 * fq;
            store_o16(dst, otv[(g * 4 + 0) * 64] + o[g][0] * sc, otv[(g * 4 + 1) * 64] + o[g][1] * sc, otv[(g * 4 + 2) * 64] + o[g][2] * sc, otv[(g * 4 + 3) * 64] + o[g][3] * sc);
        }
    }
}

template <bool WITH_CONV>
__device__ __forceinline__ void phase_attn(const Params& p, int l, char* lds, int cslot = 16) {
    int tid = threadIdx.x; asm volatile("" : "+v"(tid));
    const int wid = tid >> 6, lane = tid & 63, fr = lane & 15, fq = lane >> 4;
    float* ps = (float*)(lds + wid * 16896); unsigned* msk = (unsigned*)(ps + 512); float* otl = ps + 576;
    unsigned* ctr = p.ctrl + cslot + l;
    constexpr unsigned NU_NSA = NB * 2 * 128, NU_FOX = NB * 4 * 32, NU_SWA = NB * 2 * 128, NU_ATT = NU_NSA + NU_FOX + NU_SWA;
    for (;;) {
        unsigned u = 0;
        if (lane == 0) u = __hip_atomic_fetch_add(ctr, 1u, __ATOMIC_RELAXED, __HIP_MEMORY_SCOPE_AGENT);
        u = (unsigned)__builtin_amdgcn_readfirstlane((int)u);
        if (WITH_CONV) {
            constexpr unsigned CT = (unsigned)CONV_TILES / NL, TOTQ = NU_ATT + CT;
            if (u >= TOTQ) break;
            const unsigned a0 = (unsigned)(((unsigned long long)u * NU_ATT) / TOTQ), a1 = (unsigned)(((unsigned long long)(u + 1) * NU_ATT) / TOTQ);
            if (a1 == a0) { conv_tile_wave(p, (int)(l * CT + u - a0), lane, (unsigned char*)ps); continue; }
            u = a0;
        } else {
#ifndef ATT_REP
#define ATT_REP 1
#endif
            if (u >= ATT_REP * NU_ATT) break;
            if (ATT_REP > 1) u %= NU_ATT;
        }
        if (u < NU_NSA) { const int pos = 127 - (int)(u & 127), r = u >> 7; nsa_unit(p, r >> 1, r & 1, pos, fr, fq, lane, ps, msk, otl); }
        else if (u < NU_NSA + NU_FOX) { const unsigned v = u - NU_NSA; const int qb = 31 - (int)(v & 31), r = v >> 5; fox_unit(p, r >> 2, r & 3, qb, fr, fq); }
        else { const unsigned v = u - NU_NSA - NU_FOX; const int pos = 127 - (int)(v & 127), r = v >> 7; swa_unit(p, l, r >> 1, r & 1, pos, fr, fq); }
    }
}

__device__ __forceinline__ void phase_ln1_router(const Params& p, int l, char* lds) {
    int tid = threadIdx.x; asm volatile("" : "+v"(tid));
    const int wid = tid >> 6, lane = tid & 63, fr = lane & 15, fq = lane >> 4;
    float* lg = (float*)lds + wid * 512;
    int* lcnt = (int*)(lds + 16384); int* lbase = lcnt + 32;
    const float* g1 = p.ln1_g + l * DM; const float* b1 = p.ln1_b + l * DM;
    const float* rw = p.rwT + (size_t)l * NE * 1024; const float* rb = p.router_b + l * NE;
    unsigned* gcount = p.ctrl + 64 + l * NE;
    constexpr int RW_LDS = 20480, RW_PITCH = 2064;
    if (blockIdx.x < NTOK / 128) {
        const bf16_t* rwb = (const bf16_t*)p.rwT + (size_t)l * 64 * 1024;
#pragma unroll 4
        for (int i = 0; i < 16; ++i) { const int pc = wid * 16 + i, r = pc >> 1, q = pc & 1;
            __builtin_amdgcn_global_load_lds((const unsigned*)(rwb + (size_t)r * 1024 + q * 512 + lane * 8), (LAS unsigned*)((LAS char*)lds + RW_LDS + r * RW_PITCH + q * 1024), 16, 0, 0); }
    }
    for (int grp = blockIdx.x; grp < NTOK / 128; grp += gridDim.x) {
        const int tok0 = grp * 128 + wid * 16;
        if (tid < 32) lcnt[tid] = 0;
        float gg[16], bb[16];
#pragma unroll
        for (int j = 0; j < 4; ++j) { const float4 g4 = *(const float4*)(g1 + lane * 16 + j * 4), b4 = *(const float4*)(b1 + lane * 16 + j * 4);
            gg[4 * j] = g4.x; gg[4 * j + 1] = g4.y; gg[4 * j + 2] = g4.z; gg[4 * j + 3] = g4.w; bb[4 * j] = b4.x; bb[4 * j + 1] = b4.y; bb[4 * j + 2] = b4.z; bb[4 * j + 3] = b4.w; }
        u32x4 raw[8][2];
#pragma unroll
        for (int i = 0; i < 8; ++i) { const bf16_t* tr = (const bf16_t*)p.tbuf + (size_t)(tok0 + i) * DM + lane * 16; raw[i][0] = *(const u32x4*)tr; raw[i][1] = *(const u32x4*)(tr + 8); }
#pragma unroll
        for (int r0 = 0; r0 < 16; r0 += 4) {
            float v[4][16]; float s[4], qv[4];
#pragma unroll
            for (int i = 0; i < 4; ++i) {
                const u32x4 t0 = raw[(r0 + i) % 8][0], t1 = raw[(r0 + i) % 8][1];
                if (r0 < 8) { const bf16_t* tr = (const bf16_t*)p.tbuf + (size_t)(tok0 + r0 + 8 + i) * DM + lane * 16; raw[(r0 + i) % 8][0] = *(const u32x4*)tr; raw[(r0 + i) % 8][1] = *(const u32x4*)(tr + 8); }
                const unsigned ts[8] = {t0.x, t0.y, t0.z, t0.w, t1.x, t1.y, t1.z, t1.w};
#pragma unroll
                for (int c = 0; c < 8; ++c) { v[i][2 * c] = __uint_as_float(ts[c] << 16); v[i][2 * c + 1] = __uint_as_float(ts[c] & 0xffff0000u); }
            }
#pragma unroll
            for (int i = 0; i < 4; ++i) { s[i] = 0.f;
#pragma unroll
                for (int c = 0; c < 16; c += 4) s[i] += (v[i][c] + v[i][c + 1]) + (v[i][c + 2] + v[i][c + 3]); }
#pragma unroll
            for (int o = 32; o > 0; o >>= 1) {
#pragma unroll
                for (int i = 0; i < 4; ++i) s[i] += shfl_f(s[i], lane ^ o); }
#pragma unroll
            for (int i = 0; i < 4; ++i) { const float mean = s[i] * (1.0f / 1024.0f); qv[i] = 0.f;
#pragma unroll
                for (int c = 0; c < 16; c += 4) { v[i][c] -= mean; v[i][c + 1] -= mean; v[i][c + 2] -= mean; v[i][c + 3] -= mean;
                    qv[i] += (v[i][c] * v[i][c] + v[i][c + 1] * v[i][c + 1]) + (v[i][c + 2] * v[i][c + 2] + v[i][c + 3] * v[i][c + 3]); } }
#pragma unroll
            for (int o = 32; o > 0; o >>= 1) {
#pragma unroll
                for (int i = 0; i < 4; ++i) qv[i] += shfl_f(qv[i], lane ^ o); }
#pragma unroll
            for (int i = 0; i < 4; ++i) {
                const float rstd = rsqrtf(qv[i] * (1.0f / 1024.0f) + LN_EPS);
                const size_t row = (size_t)(tok0 + r0 + i);
                float y[16];
#pragma unroll
                for (int c = 0; c < 16; ++c) y[c] = v[i][c] * rstd * gg[c] + bb[c];
                u32x4 w0, w1, q;
                w0.x = pack2(y[0], y[1]); w0.y = pack2(y[2], y[3]); w0.z = pack2(y[4], y[5]); w0.w = pack2(y[6], y[7]);
                w1.x = pack2(y[8], y[9]); w1.y = pack2(y[10], y[11]); w1.z = pack2(y[12], y[13]); w1.w = pack2(y[14], y[15]);
                q.x = pack4_fp8(y[0], y[1], y[2], y[3]); q.y = pack4_fp8(y[4], y[5], y[6], y[7]); q.z = pack4_fp8(y[8], y[9], y[10], y[11]); q.w = pack4_fp8(y[12], y[13], y[14], y[15]);
                *(u32x4*)((bf16_t*)p.x1f + row * DM + lane * 16) = w0; *(u32x4*)((bf16_t*)p.x1f + row * DM + lane * 16 + 8) = w1;
                *(u32x4*)((char*)p.x1b + row * DM + lane * 16) = q;
            }
        }
        asm volatile("s_waitcnt vmcnt(0)" ::: "memory");
        __syncthreads();
        f32x4 a0 = (f32x4){0.f, 0.f, 0.f, 0.f}, a1 = a0;
        const bf16_t* xr = (const bf16_t*)p.x1f + (size_t)(tok0 + fr) * DM + 8 * fq;
        const LAS char* wl = (const LAS char*)lds + RW_LDS + fr * RW_PITCH + fq * 16;
#pragma unroll 8
        for (int ks = 0; ks < 32; ++ks) {
            const bf16x8 xa = *(const bf16x8*)(xr + ks * 32);
            a0 = __builtin_amdgcn_mfma_f32_16x16x32_bf16(xa, *(const LAS bf16x8*)(wl + ks * 64), a0, 0, 0, 0);
            a1 = __builtin_amdgcn_mfma_f32_16x16x32_bf16(xa, *(const LAS bf16x8*)(wl + 16 * RW_PITCH + ks * 64), a1, 0, 0, 0);
            a0 = __builtin_amdgcn_mfma_f32_16x16x32_bf16(xa, *(const LAS bf16x8*)(wl + 32 * RW_PITCH + ks * 64), a0, 0, 0, 0);
            a1 = __builtin_amdgcn_mfma_f32_16x16x32_bf16(xa, *(const LAS bf16x8*)(wl + 48 * RW_PITCH + ks * 64), a1, 0, 0, 0);
        }
#pragma unroll
        for (int r = 0; r < 4; ++r) { lg[(fq * 4 + r) * 32 + fr] = a0[r] + rb[fr]; lg[(fq * 4 + r) * 32 + 16 + fr] = a1[r] + rb[16 + fr]; }
        lds_wave_sync();
        int e4[4] = {0, 0, 0, 0}; int rk[4] = {0, 0, 0, 0};
        if (lane < 16) {
            const float* my = lg + lane * 32; unsigned taken = 0u; float tv[4];
#pragma unroll
            for (int k = 0; k < 4; ++k) {
                float best = NEG_INF; int bi = 0;
                for (int e = 0; e < 32; ++e) { const float xv = my[e]; if (!((taken >> e) & 1u) && xv > best) { best = xv; bi = e; } }
                taken |= 1u << bi; e4[k] = bi; tv[k] = best;
            }
            const float e1 = __expf(tv[1] - tv[0]), e2 = __expf(tv[2] - tv[0]), e3 = __expf(tv[3] - tv[0]);
            const float inv = 1.0f / (1.0f + e1 + e2 + e3);
            const size_t row = (size_t)(tok0 + lane);
            *(float4*)(p.gw + row * 4) = make_float4(inv, e1 * inv, e2 * inv, e3 * inv);
        }
        __syncthreads();
        if (lane < 16) {
#pragma unroll
            for (int k = 0; k < 4; ++k) rk[k] = atomicAdd(&lcnt[e4[k]], 1);
        }
        __syncthreads();
        if (tid < 32) { const int c = lcnt[tid]; lbase[tid] = c ? (int)__hip_atomic_fetch_add(gcount + tid, (unsigned)c, __ATOMIC_RELAXED, __HIP_MEMORY_SCOPE_AGENT) : 0; }
        __syncthreads();
        if (lane < 16) {
            const int row = tok0 + lane; int pk[4];
#pragma unroll
            for (int k = 0; k < 4; ++k) { const int pos = lbase[e4[k]] + rk[k]; p.lists[(size_t)e4[k] * LIST_CAP + pos] = row * 4 + k; pk[k] = (pos << 5) | e4[k]; }
            *(int4*)(p.top_e + (size_t)row * 4) = make_int4(pk[0], pk[1], pk[2], pk[3]);
        }
        __syncthreads();
    }
}

__device__ __forceinline__ void phase_ln2(const Params& p, int l, float* xout, char* lds) {
    int* ptile = (int*)(lds + LDS_TAB); int* ecnt = ptile + 40;
    int tid = threadIdx.x; asm volatile("" : "+v"(tid));
    const int wid = tid >> 6, lane = tid & 63;
    const float* g2 = p.ln2_g + l * DM; const float* b2 = p.ln2_b + l * DM;
    float gg[16], bb[16];
#pragma unroll
    for (int j = 0; j < 4; ++j) { const float4 g4 = *(const float4*)(g2 + lane * 16 + j * 4), b4 = *(const float4*)(b2 + lane * 16 + j * 4);
        gg[4 * j] = g4.x; gg[4 * j + 1] = g4.y; gg[4 * j + 2] = g4.z; gg[4 * j + 3] = g4.w; bb[4 * j] = b4.x; bb[4 * j + 1] = b4.y; bb[4 * j + 2] = b4.z; bb[4 * j + 3] = b4.w; }
    const int pstep = gridDim.x * NWV;
    int pr = blockIdx.x * NWV + wid;
    float4 gwn[2]; int4 ten[2];
    u32x4 yn[2][4], xn[2][2];
    float gk[2][4];
    auto load_meta = [&](int q) {
#pragma unroll
        for (int i = 0; i < 2; ++i) { const int row = q * 2 + i; gwn[i] = *(const float4*)(p.gw + (size_t)row * 4); ten[i] = *(const int4*)(p.top_e + (size_t)row * 4); }
    };
    auto load_rows = [&](int q) {
#pragma unroll
        for (int i = 0; i < 2; ++i) {
            const int row = q * 2 + i;
            const int tk[4] = {ten[i].x, ten[i].y, ten[i].z, ten[i].w};
            xn[i][0] = *(const u32x4*)((const bf16_t*)p.x1f + (size_t)row * DM + lane * 16); xn[i][1] = *(const u32x4*)((const bf16_t*)p.x1f + (size_t)row * DM + lane * 16 + 8);
#pragma unroll
            for (int k = 0; k < 4; ++k) yn[i][k] = *(const u32x4*)((const unsigned char*)p.ybuf + (size_t)(ptile[tk[k] & 31] * 256 + (tk[k] >> 5)) * DM + lane * 16);
        }
    };
    if (pr < NTOK / 2) { load_meta(pr); load_rows(pr); }
#pragma unroll
    for (int i = 0; i < 2; ++i) { gk[i][0] = gwn[i].x; gk[i][1] = gwn[i].y; gk[i][2] = gwn[i].z; gk[i][3] = gwn[i].w; }
    if (pr + pstep < NTOK / 2) load_meta(pr + pstep);
    for (; pr < NTOK / 2; pr += pstep) {
        float v[2][16]; float s[2], qv[2];
#pragma unroll
        for (int i = 0; i < 2; ++i) { s[i] = 0.f;
            const unsigned xs[8] = {xn[i][0].x, xn[i][0].y, xn[i][0].z, xn[i][0].w, xn[i][1].x, xn[i][1].y, xn[i][1].z, xn[i][1].w};
#pragma unroll
            for (int c = 0; c < 8; ++c) { v[i][2 * c] = __uint_as_float(xs[c] << 16) * ALPHA; v[i][2 * c + 1] = __uint_as_float(xs[c] & 0xffff0000u) * ALPHA; }
#pragma unroll
            for (int k = 0; k < 4; ++k) {
                const unsigned ys[4] = {yn[i][k].x, yn[i][k].y, yn[i][k].z, yn[i][k].w};
#pragma unroll
                for (int c = 0; c < 4; ++c) {
                    const f32x2_t lo = __builtin_amdgcn_cvt_pk_f32_fp8(ys[c], false), hi = __builtin_amdgcn_cvt_pk_f32_fp8(ys[c], true);
                    v[i][4 * c] += gk[i][k] * lo.x; v[i][4 * c + 1] += gk[i][k] * lo.y; v[i][4 * c + 2] += gk[i][k] * hi.x; v[i][4 * c + 3] += gk[i][k] * hi.y;
                }
            }
#pragma unroll
            for (int c = 0; c < 16; c += 4) s[i] += (v[i][c] + v[i][c + 1]) + (v[i][c + 2] + v[i][c + 3]);
        }
        __builtin_amdgcn_sched_barrier(0);
        if (pr + pstep < NTOK / 2) {
#pragma unroll
            for (int i = 0; i < 2; ++i) { gk[i][0] = gwn[i].x; gk[i][1] = gwn[i].y; gk[i][2] = gwn[i].z; gk[i][3] = gwn[i].w; }
            load_rows(pr + pstep);
            if (pr + 2 * pstep < NTOK / 2) load_meta(pr + 2 * pstep);
        }
        __builtin_amdgcn_sched_barrier(0);
#pragma unroll
        for (int o = 32; o > 0; o >>= 1) { s[0] += shfl_f(s[0], lane ^ o); s[1] += shfl_f(s[1], lane ^ o); }
#pragma unroll
        for (int i = 0; i < 2; ++i) { const float mean = s[i] * (1.0f / 1024.0f); qv[i] = 0.f;
#pragma unroll
            for (int c = 0; c < 16; c += 4) { v[i][c] -= mean; v[i][c + 1] -= mean; v[i][c + 2] -= mean; v[i][c + 3] -= mean;
                qv[i] += (v[i][c] * v[i][c] + v[i][c + 1] * v[i][c + 1]) + (v[i][c + 2] * v[i][c + 2] + v[i][c + 3] * v[i][c + 3]); } }
#pragma unroll
        for (int o = 32; o > 0; o >>= 1) { qv[0] += shfl_f(qv[0], lane ^ o); qv[1] += shfl_f(qv[1], lane ^ o); }
#pragma unroll
        for (int i = 0; i < 2; ++i) {
            const float rstd = rsqrtf(qv[i] * (1.0f / 1024.0f) + LN_EPS);
            const size_t row = (size_t)(pr * 2 + i);
            float y[16];
#pragma unroll
            for (int c = 0; c < 16; ++c) y[c] = v[i][c] * rstd * gg[c] + bb[c];
            if (l + 1 < NL) {
                u32x4 w0, w1, q;
                w0.x = pack2(y[0], y[1]); w0.y = pack2(y[2], y[3]); w0.z = pack2(y[4], y[5]); w0.w = pack2(y[6], y[7]);
                w1.x = pack2(y[8], y[9]); w1.y = pack2(y[10], y[11]); w1.z = pack2(y[12], y[13]); w1.w = pack2(y[14], y[15]);
                q.x = pack4_fp8(y[0], y[1], y[2], y[3]); q.y = pack4_fp8(y[4], y[5], y[6], y[7]); q.z = pack4_fp8(y[8], y[9], y[10], y[11]); q.w = pack4_fp8(y[12], y[13], y[14], y[15]);
                *(u32x4*)(p.xb + row * DM + lane * 16) = w0; *(u32x4*)(p.xb + row * DM + lane * 16 + 8) = w1;
                *(u32x4*)(p.xq + row * DM + lane * 16) = q;
            } else {
#pragma unroll
                for (int c = 0; c < 16; c += 4) *(float4*)(xout + row * DM + lane * 16 + c) = make_float4(y[c], y[c + 1], y[c + 2], y[c + 3]);
            }
        }
    }
}

#define XB_TMO      128
#define XB_XCNT(j)  (256  + 64 * (j))
#define XB_XSUB(j)  (1280 + 64 * (j))
#define XB_XGEN(j)  (2304 + 64 * (j))
#define XB_TOP      3328
#define XB_TOPGEN   3392
#define XCD_BAR_WORDS 3456
#define XB_SPIN_CAP (1u << 22)
__device__ __forceinline__ unsigned xb_ld(unsigned* p)              { return __hip_atomic_load(p, __ATOMIC_RELAXED, __HIP_MEMORY_SCOPE_AGENT); }
__device__ __forceinline__ unsigned xb_add(unsigned* p, unsigned v) { return __hip_atomic_fetch_add(p, v, __ATOMIC_RELAXED, __HIP_MEMORY_SCOPE_AGENT); }
__device__ __forceinline__ unsigned xb_xcc_id() { return (unsigned)__builtin_amdgcn_s_getreg((3 << 11) | 20) & 0xFu; }
#define XB_SPIN(cond, bar) do { unsigned _sp = 0; while (cond) { __builtin_amdgcn_s_sleep(1); \
    if ((++_sp & 255u) == 0u) { if (xb_ld(&(bar)[XB_TMO])) break; if (_sp > XB_SPIN_CAP) { atomicAdd(&(bar)[XB_TMO], 1u); break; } } } } while (0)
struct XcdBarrier { unsigned* bar; unsigned x; volatile LAS unsigned* st; };
__device__ __forceinline__ XcdBarrier xcd_barrier_post(unsigned* bar, volatile LAS unsigned* st) {
    XcdBarrier b; b.bar = bar; b.x = xb_xcc_id(); b.st = st;
    if (threadIdx.x == 0) (void)xb_add(&bar[XB_XCNT(b.x)], 1u);
    return b;
}
__device__ __forceinline__ void xcd_barrier_complete(unsigned* bar, unsigned x, unsigned& nloc, unsigned& nx) {
    const unsigned G = gridDim.x * gridDim.y * gridDim.z;
    unsigned sum, cnt, mine, sp = 0u;
    for (;;) {
        sum = 0u; cnt = 0u; mine = 0u;
#pragma unroll
        for (unsigned j = 0; j < 16; ++j) { const unsigned c = xb_ld(&bar[XB_XCNT(j)]); sum += c; cnt += (c > 0u) ? 1u : 0u; mine = (j == x) ? c : mine; }
        if (sum == G) break;
        __builtin_amdgcn_s_sleep(1);
        if ((++sp & 255u) == 0u) { if (xb_ld(&bar[XB_TMO])) break; if (sp > XB_SPIN_CAP) { atomicAdd(&bar[XB_TMO], 1u); break; } }
    }
    nloc = mine > 0u ? mine : 1u; nx = cnt > 0u ? cnt : 1u;
}
__device__ __forceinline__ void xcd_barrier(const XcdBarrier& b) {
    asm volatile("s_waitcnt vmcnt(0)" ::: "memory");
    __syncthreads();
    if (threadIdx.x == 0) {
        unsigned* bar = b.bar;
        __builtin_amdgcn_s_waitcnt(0);
        unsigned nloc = b.st[0], nx = b.st[1];
        if (nloc == 0u) { xcd_barrier_complete(bar, b.x, nloc, nx); b.st[0] = nloc; b.st[1] = nx; }
        const unsigned old = xb_add(&bar[XB_XSUB(b.x)], 1u);
        const unsigned gen = old / nloc;
        if (old + 1u == (gen + 1u) * nloc) {
            __builtin_amdgcn_fence(__ATOMIC_RELEASE, "agent");
            asm volatile("s_waitcnt vmcnt(0)" ::: "memory");
            const unsigned og = xb_add(&bar[XB_TOP], 1u);
            const unsigned tg = og / nx;
            if (og + 1u == (tg + 1u) * nx) xb_add(&bar[XB_TOPGEN], 1u);
            else XB_SPIN(xb_ld(&bar[XB_TOPGEN]) == tg, bar);
            __builtin_amdgcn_fence(__ATOMIC_ACQUIRE, "agent");
            xb_add(&bar[XB_XGEN(b.x)], 1u);
            asm volatile("s_waitcnt vmcnt(0)" ::: "memory");
        } else {
            XB_SPIN(xb_ld(&bar[XB_XGEN(b.x)]) == gen, bar);
            __builtin_amdgcn_fence(__ATOMIC_ACQUIRE, "agent");
            asm volatile("s_waitcnt vmcnt(0)" ::: "memory");
        }
    }
    __syncthreads();
}

struct KArgs { const float* in[18]; float* out; char* ws; };
constexpr size_t al256(size_t v) { return (v + 255) / 256 * 256; }
struct WSL {
    static constexpr size_t ctrl = 0;
    static constexpr size_t WinT = al256(ctrl + 65536);
    static constexpr size_t WoT = al256(WinT + (size_t)NL * NPAD * 1024 * 2);
    static constexpr size_t W1T = al256(WoT + (size_t)NL * 1024 * 1024 * 2);
    static constexpr size_t W2T = al256(W1T + (size_t)NL * 2 * 64 * 2048 * 2);
    static constexpr size_t WguT = al256(W2T + (size_t)NL * 2 * 64 * 64 * 2);
    static constexpr size_t WdnT = al256(WguT + (size_t)NL * NE * 2048 * 1024 * 2);
    static constexpr size_t rwT = al256(WdnT + (size_t)NL * NE * 1024 * 1024 * 2);
    static constexpr size_t binp = al256(rwT + (size_t)NL * NE * 1024 * 4);
    static constexpr size_t bgup = al256(binp + (size_t)NL * NPAD * 4);
    static constexpr size_t b1c = al256(bgup + (size_t)NL * NE * 2048 * 4);
    static constexpr size_t xf = al256(b1c + 4 * 8 * 64 * 4);
    static constexpr size_t xb = al256(xf + (size_t)NTOK * DM * 4);
    static constexpr size_t hb = al256(xb + (size_t)NTOK * DM * 2);
    static constexpr size_t hs = al256(hb + (size_t)NTOK * NMAIN * 2);
    static constexpr size_t vT = al256(hs + (size_t)NTOK * HS_W * 4);
    static constexpr size_t kF = al256(vT + (size_t)NB * NVH * 64 * SEQ * 2);
    static constexpr size_t cF = al256(kF + (size_t)NB * NVH * 64 * SEQ * 2);
    static constexpr size_t kc = al256(cF + (size_t)NB * 4 * SEQ * 4);
    static constexpr size_t vc = al256(kc + (size_t)NB * 2 * 128 * 64 * 2);
    static constexpr size_t vcT = al256(vc + (size_t)NB * 2 * 128 * 64 * 2);
    static constexpr size_t ob = al256(vcT + (size_t)NB * 2 * 128 * 64 * 2);
    static constexpr size_t tbuf = al256(ob + (size_t)NTOK * DM * 2);
    static constexpr size_t x1f = al256(tbuf + (size_t)NTOK * DM * 4);
    static constexpr size_t x1b = al256(x1f + (size_t)NTOK * DM * 4);
    static constexpr size_t top_e = al256(x1b + (size_t)NTOK * DM * 2);
    static constexpr size_t gw = al256(top_e + (size_t)NTOK * 4 * 4);
    static constexpr size_t lists = al256(gw + (size_t)NTOK * 4 * 4);
    static constexpr size_t act = al256(lists + (size_t)NE * LIST_CAP * 4);
    static constexpr size_t ybuf = al256(act + (size_t)MAXSLOT * DFF * 2);
    static constexpr size_t xq = al256(ybuf + (size_t)MAXSLOT * DM * 2);
    static constexpr size_t WinQ = al256(xq + (size_t)NTOK * DM);
    static constexpr size_t total = al256(WinQ + (size_t)NL * NMAIN * 1024);
};
__device__ __forceinline__ Params make_params(const KArgs& k) {
    Params p;
    p.x = k.in[0]; p.w_in = k.in[1]; p.b_in = k.in[2]; p.sinks = k.in[3]; p.cmp_pe = k.in[4]; p.cmp_w1 = k.in[5]; p.cmp_w2 = k.in[6]; p.w_out = k.in[7];
    p.ln1_g = k.in[8]; p.ln1_b = k.in[9]; p.router_w = k.in[10]; p.router_b = k.in[11]; p.w_gu = k.in[12]; p.b_gu = k.in[13]; p.w_dn = k.in[14]; p.b_dn = k.in[15];
    p.ln2_g = k.in[16]; p.ln2_b = k.in[17]; p.out = k.out;
    char* w = k.ws;
    p.ctrl = (unsigned*)(w + WSL::ctrl); p.WinT = (bf16_t*)(w + WSL::WinT); p.WoT = (bf16_t*)(w + WSL::WoT); p.W1T = (bf16_t*)(w + WSL::W1T); p.W2T = (bf16_t*)(w + WSL::W2T);
    p.WguT = (bf16_t*)(w + WSL::WguT); p.WdnT = (bf16_t*)(w + WSL::WdnT); p.rwT = (float*)(w + WSL::rwT); p.binp = (float*)(w + WSL::binp); p.bgup = (float*)(w + WSL::bgup);
    p.b1c = (float*)(w + WSL::b1c); p.xf = (float*)(w + WSL::xf); p.xb = (bf16_t*)(w + WSL::xb); p.hb = (bf16_t*)(w + WSL::hb); p.hs = (float*)(w + WSL::hs); p.vT = (bf16_t*)(w + WSL::vT); p.kF = (bf16_t*)(w + WSL::kF);
    p.cF = (float*)(w + WSL::cF); p.kc = (bf16_t*)(w + WSL::kc); p.vc = (bf16_t*)(w + WSL::vc); p.vcT = (bf16_t*)(w + WSL::vcT); p.ob = (bf16_t*)(w + WSL::ob); p.tbuf = (float*)(w + WSL::tbuf);
    p.x1f = (float*)(w + WSL::x1f); p.x1b = (bf16_t*)(w + WSL::x1b); p.top_e = (int*)(w + WSL::top_e); p.gw = (float*)(w + WSL::gw); p.lists = (int*)(w + WSL::lists);
    p.act = (bf16_t*)(w + WSL::act); p.ybuf = (bf16_t*)(w + WSL::ybuf); p.xq = (unsigned char*)(w + WSL::xq); p.WinQ = (unsigned char*)(w + WSL::WinQ);
    return p;
}
__device__ __forceinline__ void grid_bar(const Params& p, char* lds) {
    XcdBarrier xb; xb.bar = p.ctrl + 1024; xb.x = xb_xcc_id(); xb.st = (volatile LAS unsigned*)(lds + LDS_BYTES - 16); xcd_barrier(xb);
}
__device__ __forceinline__ Params fresh_params(const KArgs& ka) {
    KArgs k2 = ka; size_t z = 0; asm volatile("" : "+s"(z));
    k2.ws = ka.ws + z;
    return make_params(k2);
}
#ifndef REP
#define REP 0
#endif
template <int L>
__device__ __forceinline__ void layer_fwd(const KArgs& ka, char* lds) {
    { const Params p = fresh_params(ka); phase_inproj(p, L, lds);        grid_bar(p, lds); }
    { const Params p = fresh_params(ka); phase_prep(p, L, lds);          grid_bar(p, lds); }
    { const Params p = fresh_params(ka); phase_attn<true>(p, L, lds);  grid_bar(p, lds); }
    { const Params p = fresh_params(ka); phase_outproj(p, L, p.xb, lds);  grid_bar(p, lds); }
    { const Params p = fresh_params(ka); phase_ln1_router(p, L, lds);    grid_bar(p, lds); }
    { const Params p = fresh_params(ka); phase_gateup(p, L, lds);        grid_bar(p, lds); }
    { const Params p = fresh_params(ka); phase_down(p, L, lds);          grid_bar(p, lds); }
    { const Params p = fresh_params(ka); phase_ln2(p, L, L == NL - 1 ? p.out : p.xf, lds); }
}
__global__ void __launch_bounds__(NTHR, 2) fwd_kernel(KArgs ka) {
    extern __shared__ __attribute__((aligned(16))) char lds[];
    const Params p = make_params(ka);
    cg::grid_group grid = cg::this_grid();
    volatile LAS unsigned* xst = (volatile LAS unsigned*)(lds + LDS_BYTES - 16);
    if (threadIdx.x == 0) { xst[0] = 0u; xst[1] = 0u; }
    __syncthreads();
    (void)xcd_barrier_post(p.ctrl + 1024, xst);
    volatile LAS int* vcu = (volatile LAS int*)(lds + LDS_BYTES - 32);
    const unsigned myx = xb_xcc_id() & 7u;
    if (threadIdx.x == 0) vcu[1] = (int)__hip_atomic_fetch_add(p.ctrl + 32 + myx, 1u, __ATOMIC_RELAXED, __HIP_MEMORY_SCOPE_AGENT);
    phase0(p, lds);
    grid.sync();
    if (threadIdx.x == 0) {
        int base = 0, tot = 0;
        for (unsigned x = 0; x < 8; ++x) { const int n = (int)__hip_atomic_load(p.ctrl + 32 + x, __ATOMIC_RELAXED, __HIP_MEMORY_SCOPE_AGENT); if (x < myx) base += n; tot += n; }
        vcu[0] = (tot == (int)gridDim.x) ? base + vcu[1] : (int)blockIdx.x;
    }
    __syncthreads();
    layer_fwd<0>(ka, lds);
    grid_bar(p, lds);
    layer_fwd<1>(ka, lds);
}

extern "C" void kernel_launch(void* const* d_in, const int* in_sizes, int n_in, void* d_out, int out_size, void* d_ws, size_t ws_size, hipStream_t stream) {
    KArgs ka{};
    for (int i = 0; i < 18; ++i) ka.in[i] = (const float*)d_in[i];
    ka.out = (float*)d_out; ka.ws = (char*)d_ws;
    if (WSL::total > ws_size) { fprintf(stderr, "workspace too small: need %zu have %zu\n", (size_t)WSL::total, ws_size); return; }
    static int grid_blocks = 0;
    if (!grid_blocks) {
        int dev = 0, cus = 0, per_cu = 0;
        (void)hipGetDevice(&dev);
        (void)hipDeviceGetAttribute(&cus, hipDeviceAttributeMultiprocessorCount, dev);
        (void)hipFuncSetAttribute((const void*)fwd_kernel, hipFuncAttributeMaxDynamicSharedMemorySize, LDS_BYTES);
        (void)hipOccupancyMaxActiveBlocksPerMultiprocessor(&per_cu, fwd_kernel, NTHR, LDS_BYTES);
        if (per_cu < 1) { fprintf(stderr, "occupancy query says 0 blocks per CU\n"); per_cu = 1; }
        grid_blocks = cus;
    }
    (void)hipMemsetAsync(d_ws, 0, 65536, stream);
    void* args[] = {&ka};
    hipError_t e = hipLaunchCooperativeKernel((const void*)fwd_kernel, dim3(grid_blocks), dim3(NTHR), args, LDS_BYTES, stream);
    if (e != hipSuccess) fprintf(stderr, "cooperative launch failed: %s (grid %d)\n", hipGetErrorString(e), grid_blocks);
}
```

```cpp
#include <hip/hip_runtime.h>
#include <hip/hip_cooperative_groups.h>
#include <cstdio>
#include <cstdint>
namespace cg = cooperative_groups;

typedef unsigned short bf16_t;
typedef short bf16x8 __attribute__((ext_vector_type(8)));
typedef float f32x4 __attribute__((ext_vector_type(4)));
typedef unsigned u32x4 __attribute__((ext_vector_type(4)));
typedef unsigned u32x2 __attribute__((ext_vector_type(2)));
typedef int v8i_t __attribute__((ext_vector_type(8)));
typedef float f32x2_t __attribute__((ext_vector_type(2)));
typedef int v4i_t __attribute__((ext_vector_type(4)));
#define LAS __attribute__((address_space(3)))
constexpr float NEG_INF = -__builtin_huge_valf();

constexpr int DM = 1024, NB = 16, SEQ = 2048, NTOK = NB * SEQ, NL = 2;
constexpr int NCOL = 2582, NMAIN = 2560, NPAD = 2688, NE = 32, DFF = 1024;
constexpr int C_FQ = 0, C_FK = 256, C_FV = 512, C_SQ = 768, C_SK = 1152, C_SV = 1280, C_NQ = 1408,
              C_NKC = 1792, C_NVC = 1920, C_NKS = 2048, C_NVS = 2176, C_NKW = 2304, C_NVW = 2432;
constexpr int HS_W = 32;
constexpr int NVH = 10;
constexpr int LIST_CAP = NTOK;
constexpr int MAXSLOT = NTOK * 4 + NE * 256;
constexpr float ALPHA = 1.41421356237f, LN_EPS = 1e-5f, QSCALE = 0.125f;
constexpr float GATE_PRE = -2.455466929f;
constexpr int NWV = 8, NTHR = NWV * 64;
constexpr int LDS_STAGE = 131072, LDS_TAB = LDS_STAGE, LDS_AOFF = LDS_STAGE + 2048, LDS_BIAS = LDS_AOFF + 20480, LDS_BYTES = LDS_BIAS + 3072 + 256;

struct Params {
    const float *x, *w_in, *b_in, *sinks, *cmp_pe, *cmp_w1, *cmp_w2, *w_out, *ln1_g, *ln1_b, *router_w, *router_b,
                *w_gu, *b_gu, *w_dn, *b_dn, *ln2_g, *ln2_b;
    float* out;
    unsigned* ctrl;
    bf16_t *WinT, *WoT, *W1T, *W2T, *WguT, *WdnT;
    float *rwT, *binp, *bgup, *b1c;
    unsigned char* xq; unsigned char* WinQ;
    float* xf; bf16_t* xb; bf16_t* hb; float* hs; bf16_t* vT; bf16_t* kF; float* cF;
    bf16_t *kc, *vc, *vcT; bf16_t* ob; float* tbuf; float* x1f; bf16_t* x1b;
    int* top_e; float* gw; int* lists; bf16_t* act; bf16_t* ybuf;
};

__device__ __forceinline__ float bf2f(bf16_t h) { return __uint_as_float(((unsigned)h) << 16); }
typedef __bf16 bf16x2_t __attribute__((ext_vector_type(2)));
__device__ __forceinline__ bf16_t f2bf(float f) { return __builtin_bit_cast(bf16_t, (__bf16)f); }
__device__ __forceinline__ unsigned pack2(float lo, float hi) { bf16x2_t v = {(__bf16)lo, (__bf16)hi}; return __builtin_bit_cast(unsigned, v); }
__device__ __forceinline__ unsigned pack4_fp8(float a, float b, float c, float d) {
    unsigned w = 0u;
    w = __builtin_amdgcn_cvt_pk_fp8_f32(a, b, w, false);
    w = __builtin_amdgcn_cvt_pk_fp8_f32(c, d, w, true);
    return w;
}
__device__ __forceinline__ float shfl_f(float v, int src_lane) { return __int_as_float(__builtin_amdgcn_ds_bpermute(src_lane << 2, __float_as_int(v))); }
__device__ __forceinline__ unsigned shfl_u(unsigned v, int src_lane) { return (unsigned)__builtin_amdgcn_ds_bpermute(src_lane << 2, (int)v); }
__device__ __forceinline__ float wave_sum(float v) {
#pragma unroll
    for (int o = 32; o > 0; o >>= 1) v += __shfl_xor(v, o);
    return v;
}
__device__ __forceinline__ float wave_max(float v) {
#pragma unroll
    for (int o = 32; o > 0; o >>= 1) v = fmaxf(v, __shfl_xor(v, o));
    return v;
}
__device__ __forceinline__ void lds_wave_sync() { asm volatile("s_waitcnt lgkmcnt(0)" ::: "memory"); __builtin_amdgcn_wave_barrier(); }
__device__ __forceinline__ float slope_swa(int hq) { return exp2f(-8.0f * (float)(2 * hq + 1) / 12.0f); }
__device__ __forceinline__ float slope_nsa(int hq) { return exp2f(-8.0f * (float)(2 * hq + 2) / 12.0f); }

__device__ __forceinline__ int fwd128(int L) { return (L & ~31) | (((L >> 2) & 1) << 4) | (((L >> 3) & 3) << 2) | (L & 3); }
__device__ __forceinline__ int inv128(int p) { return (p & ~31) | (((p >> 2) & 3) << 3) | (((p >> 4) & 1) << 2) | (p & 3); }
__device__ __forceinline__ int fwd256(int L) { return (L & ~255) | (((L >> 3) & 1) << 7) | (((L >> 6) & 3) << 5) | (((L >> 2) & 1) << 4) | (((L >> 4) & 3) << 2) | (L & 3); }
__device__ __forceinline__ int perm_row(int perm, int n) {
    if (perm == 1) { int r; if (n < 768) r = n; else if (n < 772) r = 2560 + (n - 768); else if (n < 2564) r = n - 4; else r = n; return r < 2560 ? fwd128(r) : r; }
    if (perm == 2) { const int f = n >> 1, s = n & 1; return (f >> 7) * 256 + s * 128 + fwd128(f & 127); }
    if (perm == 3) return fwd256(n);
    return n;
}
struct ConvJob { const float* src; bf16_t* dst; int K, N, kt, nt, perm; float q8; };
__device__ __forceinline__ bool conv_job(const Params& p, int t, ConvJob& jb) {
    constexpr int T_WIN = NL * 8 * 21, T_WO = NL * 8 * 8, T_WINB = NL * 8 * 2;
    if (t < T_WINB) { const int m = t / 16, r = t % 16; jb = ConvJob{p.w_in + (size_t)m * 1024 * NCOL, p.WinT + (size_t)m * NPAD * 1024, 1024, NCOL, r >> 1, (r & 1) ? 20 : 6, 1, 0.f}; return true; }
    t -= T_WINB;
    if (t < T_WO) { const int m = t / 64, r = t % 64; jb = ConvJob{p.w_out + (size_t)m * 1024 * 1024, (bf16_t*)((char*)p.WoT + (size_t)m * 1024 * 1024), 1024, 1024, r / 8, r % 8, 3, 64.0f}; return true; }
    t -= T_WO;
    if (t < T_WIN) { const int m = t / 168, r = t % 168; jb = ConvJob{p.w_in + (size_t)m * 1024 * NCOL, (bf16_t*)(p.WinQ + (size_t)m * NMAIN * 1024), 1024, NCOL, r / 21, r % 21, 1, 64.0f}; return true; }
    return false;
}
constexpr int CONV_TILES = NL * NE * 192;
__device__ __forceinline__ void conv_tile_wave(const Params& p, int t, int lane, unsigned char* l8) {
    asm volatile("" : "+v"(lane));
    const int m = t / 192, r = t % 192;
    const float* src; unsigned char* dst; int N, kt, nt, perm;
    if (r < 128) { src = p.w_gu + (size_t)m * 1024 * 2048; dst = (unsigned char*)p.WguT + (size_t)m * 2048 * 1024; N = 2048; kt = r >> 4; nt = r & 15; perm = 2; }
    else { const int q = r - 128; src = p.w_dn + (size_t)m * 1024 * 1024; dst = (unsigned char*)p.WdnT + (size_t)m * 1024 * 1024; N = 1024; kt = q >> 3; nt = q & 7; perm = 3; }
    const float* s = src + (size_t)(kt * 128 + (lane >> 5)) * N + nt * 128 + (lane & 31) * 4;
    unsigned char* lw = l8 + (lane >> 5) * 132 + (lane & 31) * 4;
    const float sg = (perm == 2) ? 64.0f * GATE_PRE : 64.0f;
    float4 va[16], vb[16];
#pragma unroll
    for (int i = 0; i < 16; ++i) va[i] = *(const float4*)(s + (size_t)(2 * i) * N);
#pragma unroll
    for (int i = 0; i < 16; ++i) vb[i] = *(const float4*)(s + (size_t)(32 + 2 * i) * N);
#pragma unroll
    for (int i = 0; i < 16; ++i) *(unsigned*)(lw + (2 * i) * 132) = pack4_fp8(va[i].x * sg, va[i].y * 64.0f, va[i].z * sg, va[i].w * 64.0f);
#pragma unroll
    for (int i = 0; i < 16; ++i) va[i] = *(const float4*)(s + (size_t)(64 + 2 * i) * N);
#pragma unroll
    for (int i = 0; i < 16; ++i) *(unsigned*)(lw + (32 + 2 * i) * 132) = pack4_fp8(vb[i].x * sg, vb[i].y * 64.0f, vb[i].z * sg, vb[i].w * 64.0f);
#pragma unroll
    for (int i = 0; i < 16; ++i) vb[i] = *(const float4*)(s + (size_t)(96 + 2 * i) * N);
#pragma unroll
    for (int i = 0; i < 16; ++i) *(unsigned*)(lw + (64 + 2 * i) * 132) = pack4_fp8(va[i].x * sg, va[i].y * 64.0f, va[i].z * sg, va[i].w * 64.0f);
#pragma unroll
    for (int i = 0; i < 16; ++i) *(unsigned*)(lw + (96 + 2 * i) * 132) = pack4_fp8(vb[i].x * sg, vb[i].y * 64.0f, vb[i].z * sg, vb[i].w * 64.0f);
    lds_wave_sync();
#pragma unroll 4
    for (int i = 0; i < 16; ++i) {
        const int idx = lane + 64 * i, kc = idx & 7, nn = idx >> 3;
        const unsigned char* l = l8 + (kc * 16) * 132 + nn;
        u32x4 w;
        w.x = (unsigned)l[0] | ((unsigned)l[132] << 8) | ((unsigned)l[264] << 16) | ((unsigned)l[396] << 24);
        w.y = (unsigned)l[528] | ((unsigned)l[660] << 8) | ((unsigned)l[792] << 16) | ((unsigned)l[924] << 24);
        w.z = (unsigned)l[1056] | ((unsigned)l[1188] << 8) | ((unsigned)l[1320] << 16) | ((unsigned)l[1452] << 24);
        w.w = (unsigned)l[1584] | ((unsigned)l[1716] << 8) | ((unsigned)l[1848] << 16) | ((unsigned)l[1980] << 24);
        *(u32x4*)(dst + (size_t)perm_row(perm, nt * 128 + nn) * 1024 + kt * 128 + kc * 16) = w;
    }
    lds_wave_sync();
}
__device__ __forceinline__ void conv_load(const ConvJob& jb, int tid, float2 (&v)[16]) {
    const int n = jb.nt * 128 + (tid & 31) * 4;
    const float* s = jb.src + (size_t)(jb.kt * 128 + (tid >> 5)) * jb.N + n;
#pragma unroll
    for (int i = 0; i < 8; ++i) {
        const float* r = s + (size_t)(16 * i) * jb.N;
        v[2 * i] = (n + 1 < jb.N) ? *(const float2*)r : make_float2(0.f, 0.f);
        v[2 * i + 1] = (n + 3 < jb.N) ? *(const float2*)(r + 2) : make_float2(0.f, 0.f);
    }
}
__device__ __forceinline__ void phase0(const Params& p, char* ldsc) {
    int tid = threadIdx.x; asm volatile("" : "+v"(tid));
    const int G = gridDim.x, bid = blockIdx.x;
    const size_t gtid = (size_t)bid * NTHR + tid, gthreads = (size_t)G * NTHR;
    {
        constexpr int TOT = NL * 8 * 2 + NL * 8 * 21 + NL * 8 * 8;
        bf16_t* lt = (bf16_t*)ldsc;
        ConvJob jb, jn; float2 v[16], vn[16];
        int t = bid; bool have = t < TOT && conv_job(p, t, jb);
        if (have) conv_load(jb, tid, v);
        while (have) {
            const int tn = t + G; const bool hn = tn < TOT && conv_job(p, tn, jn);
            if (hn) conv_load(jn, tid, vn);
            if (jb.q8 != 0.f) {
                unsigned char* l8 = (unsigned char*)lt;
#pragma unroll
                for (int i = 0; i < 8; ++i)
                {   int kl = (tid >> 5) + 16 * i;
                    if (jb.perm == 3) kl = (kl & 64) | (((kl >> 2) & 3) << 4) | (((kl >> 4) & 3) << 2) | (kl & 3);
                    *(unsigned*)(l8 + kl * 132 + (tid & 31) * 4) = pack4_fp8(v[2 * i].x * jb.q8, v[2 * i].y * jb.q8, v[2 * i + 1].x * jb.q8, v[2 * i + 1].y * jb.q8); }
                __syncthreads();
#pragma unroll
                for (int i = 0; i < 2; ++i) {
                    const int idx = tid + NTHR * i, kc = idx & 7, nn = idx >> 3, n = jb.nt * 128 + nn;
                    const unsigned char* l = l8 + (kc * 16) * 132 + nn;
                    u32x4 w;
                    w.x = (unsigned)l[0] | ((unsigned)l[132] << 8) | ((unsigned)l[264] << 16) | ((unsigned)l[396] << 24);
                    w.y = (unsigned)l[528] | ((unsigned)l[660] << 8) | ((unsigned)l[792] << 16) | ((unsigned)l[924] << 24);
                    w.z = (unsigned)l[1056] | ((unsigned)l[1188] << 8) | ((unsigned)l[1320] << 16) | ((unsigned)l[1452] << 24);
                    w.w = (unsigned)l[1584] | ((unsigned)l[1716] << 8) | ((unsigned)l[1848] << 16) | ((unsigned)l[1980] << 24);
                    const int pr = perm_row(jb.perm, n);
                    if (n < jb.N && !(jb.perm == 1 && pr >= NMAIN)) *(u32x4*)((char*)jb.dst + (size_t)pr * jb.K + jb.kt * 128 + kc * 16) = w;
                }
            } else {
#pragma unroll
                for (int i = 0; i < 8; ++i) {
                    u32x2 w; w.x = pack2(v[2 * i].x, v[2 * i].y); w.y = pack2(v[2 * i + 1].x, v[2 * i + 1].y);
                    *(u32x2*)(lt + ((tid >> 5) + 16 * i) * 136 + (tid & 31) * 4) = w;
                }
                __syncthreads();
#pragma unroll
                for (int i = 0; i < 4; ++i) {
                    const int idx = tid + NTHR * i, kc = idx & 15, nn = idx >> 4, n = jb.nt * 128 + nn;
                    if (n < jb.N) {
                        const bf16_t* l = lt + (kc * 8) * 136 + nn;
                        u32x4 w;
                        w.x = (unsigned)l[0] | ((unsigned)l[136] << 16); w.y = (unsigned)l[272] | ((unsigned)l[408] << 16);
                        w.z = (unsigned)l[544] | ((unsigned)l[680] << 16); w.w = (unsigned)l[816] | ((unsigned)l[952] << 16);
                        *(u32x4*)(jb.dst + (size_t)perm_row(jb.perm, n) * jb.K + jb.kt * 128 + kc * 8) = w;
                    }
                }
            }
            __syncthreads();
            t = tn; have = hn; jb = jn;
#pragma unroll
            for (int i = 0; i < 16; ++i) v[i] = vn[i];
        }
    }
    for (size_t i = gtid; i < (size_t)NL * 2 * 2048 * 64; i += gthreads) {
        const int k = (int)(i % 2048), n = (int)((i / 2048) % 64), m = (int)(i / (2048 * 64));
        p.W1T[i] = f2bf(p.cmp_w1[((size_t)m * 2048 + k) * 64 + n]);
    }
    for (size_t i = gtid; i < (size_t)NL * 2 * 64 * 64; i += gthreads) {
        const int k = (int)(i % 64), n = (int)((i / 64) % 64), m = (int)(i / 4096);
        p.W2T[i] = f2bf(p.cmp_w2[((size_t)m * 64 + k) * 64 + n]);
    }
    for (size_t i = gtid; i < (size_t)NL * NPAD; i += gthreads) {
        const int l = (int)(i / NPAD), ri = (int)(i % NPAD), r = ri < 2560 ? inv128(ri) : ri;
        float v = 0.f;
        if (r < 2560) { const int n = r < 768 ? r : r + 4; v = p.b_in[l * NCOL + n]; }
        else if (r < 2564) v = p.b_in[l * NCOL + 768 + (r - 2560)];
        else if (r < 2582) v = p.b_in[l * NCOL + r];
        p.binp[i] = v;
    }
    for (size_t i = gtid; i < (size_t)NL * NE * 2048; i += gthreads) {
        const int r = (int)(i % 2048); const size_t le = i / 2048;
        const int s = (r >> 7) & 1, f = (r >> 8) * 128 + inv128(r & 127);
        p.bgup[i] = p.b_gu[le * 2048 + 2 * f + s] * (s == 0 ? GATE_PRE : 1.0f);
    }
    for (size_t i = gtid; i < (size_t)NL * NE * 1024; i += gthreads) {
        const int k = (int)(i % 1024), e = (int)((i / 1024) % NE), l = (int)(i / (1024 * NE));
        const float wv = p.router_w[((size_t)l * 1024 + k) * NE + e];
        const bf16_t hi = f2bf(wv); const float hf = __uint_as_float((unsigned)hi << 16);
        bf16_t* rwb = (bf16_t*)p.rwT + (size_t)l * 64 * 1024;
        rwb[(size_t)e * 1024 + k] = hi; rwb[(size_t)(32 + e) * 1024 + k] = f2bf(wv - hf);
    }
    for (size_t i = gtid; i < (size_t)NL * (NPAD - NCOL) * 1024; i += gthreads) {
        const int l = (int)(i / ((NPAD - NCOL) * 1024)); const size_t r = i % ((size_t)(NPAD - NCOL) * 1024);
        p.WinT[(size_t)l * NPAD * 1024 + (size_t)NCOL * 1024 + r] = 0;
    }
    {
        constexpr size_t N16 = (size_t)NTOK * DM / 16;
        for (size_t i0 = gtid; i0 < N16; i0 += gthreads * 2) {
            float4 v[2][4];
#pragma unroll
            for (int u = 0; u < 2; ++u) { const size_t i = i0 + u * gthreads;
#pragma unroll
                for (int j = 0; j < 4; ++j) v[u][j] = (i < N16) ? ((const float4*)p.x)[i * 4 + j] : make_float4(0.f, 0.f, 0.f, 0.f); }
#pragma unroll
            for (int u = 0; u < 2; ++u) { const size_t i = i0 + u * gthreads;
                if (i < N16) {
                    u32x4 w0, w1, q;
                    w0.x = pack2(v[u][0].x, v[u][0].y); w0.y = pack2(v[u][0].z, v[u][0].w); w0.z = pack2(v[u][1].x, v[u][1].y); w0.w = pack2(v[u][1].z, v[u][1].w);
                    w1.x = pack2(v[u][2].x, v[u][2].y); w1.y = pack2(v[u][2].z, v[u][2].w); w1.z = pack2(v[u][3].x, v[u][3].y); w1.w = pack2(v[u][3].z, v[u][3].w);
                    q.x = pack4_fp8(v[u][0].x, v[u][0].y, v[u][0].z, v[u][0].w); q.y = pack4_fp8(v[u][1].x, v[u][1].y, v[u][1].z, v[u][1].w);
                    q.z = pack4_fp8(v[u][2].x, v[u][2].y, v[u][2].z, v[u][2].w); q.w = pack4_fp8(v[u][3].x, v[u][3].y, v[u][3].z, v[u][3].w);
                    ((u32x4*)p.xb)[i * 2] = w0; ((u32x4*)p.xb)[i * 2 + 1] = w1; ((u32x4*)p.xq)[i] = q;
                }
            }
        }
    }
    if (bid < 32) {
        float* lf = (float*)ldsc;
        const int j = tid & 63, part = tid >> 6, lw = bid >> 3, sl = bid & 7;
        const float* pe = p.cmp_pe + (size_t)lw * 2048; const float* w1 = p.cmp_w1 + (size_t)lw * 2048 * 64;
        float s = 0.f;
#pragma unroll 8
        for (int kk = sl * 256 + part * 32; kk < sl * 256 + part * 32 + 32; ++kk) s += pe[kk] * w1[(size_t)kk * 64 + j];
        lf[tid] = s; __syncthreads();
        if (tid < 64) { float a = 0.f; for (int q = 0; q < 8; ++q) a += lf[tid + 64 * q]; p.b1c[(lw * 8 + sl) * 64 + tid] = a; }
        __syncthreads();
    }
}

__device__ __forceinline__ int vcu_id() { return __builtin_amdgcn_readfirstlane(*(const volatile LAS int*)(LDS_BYTES - 32)); }
namespace pg8 {
constexpr int BM = 256, BK = 64, HALF = 128, HTB = HALF * BK * 2, NXCD = 8, WGM = 8;
__device__ __forceinline__ int lds_byte(int r, int c) { const int ch = (c >> 3) ^ ((r >> 1) & 7); return (r >> 3) * 1024 + (r & 7) * 128 + ch * 16 + (c & 7) * 2; }
__device__ __forceinline__ void stage_rc(int b, int& R, int& C) { const int st = b / 1024, sb = b % 1024; R = st * 8 + sb / 128; C = ((((sb % 128) / 16) ^ ((R >> 1) & 7)) * 16 + (sb % 16)) / 2; }
__device__ __forceinline__ bool tile_order(int i, int G, int c, int nM, int nN, int& pm, int& pn) {
    const int nwg = nM * nN; const long L = (long)i * G + c; if (L >= nwg) return false;
    const int wgid = (int)L;
    const int nig = WGM * nN, gid = wgid / nig, fm = gid * WGM, gsz = (nM - fm) < WGM ? (nM - fm) : WGM;
    pm = fm + ((wgid % nig) % gsz); pn = (wgid % nig) / gsz; return true;
}
template <bool FP8, int SCA, class Sched, class Epi>
__device__ __forceinline__ void gemm_phase(LAS unsigned char* lds, const char* Abase, int K, const Sched& S, const Epi& E) {
    int tid = threadIdx.x; asm volatile("" : "+v"(tid));
    const int wid = __builtin_amdgcn_readfirstlane(tid >> 6), lane = tid & 63, wr = wid >> 2, wc = wid & 3, fr = lane & 15, fq = lane >> 4;
    const int nt = K / BK;
    int R0, C0, R1, C1; stage_rc(tid * 16, R0, C0); stage_rc(tid * 16 + 8192, R1, C1);
    LAS unsigned* aofs = (LAS unsigned*)(lds + LDS_AOFF) + tid;
    unsigned rg[10];
    rg[8] = (unsigned)(R0 * K + C0) * 2u; rg[9] = (unsigned)(R1 * K + C1) * 2u;
    if constexpr (FP8) { aofs[8 * NTHR] = rg[8]; aofs[9 * NTHR] = rg[9]; }
    const size_t kstep = (size_t)(BK * 2), hstep = (size_t)HALF * K * 2;
    const unsigned ldsw = (unsigned)wid * 1024u;
    const int aoff = lds_byte(wr * 64 + fr, fq * 8), boff = lds_byte(wc * 32 + fr, fq * 8);
#define PG8_SA(b, h) (((b) * 2 + (h)) * HTB)
#define PG8_SB(b, h) ((4 + (b) * 2 + (h)) * HTB)
#define PG8_OFS(sel, j) (FP8 ? aofs[((sel) * 4 + (j)) * NTHR] : ((sel) ? rg[4 + (j)] : rg[(j)]))
#define PG8_STAGE_B(bufoff, gbase) do { _Pragma("unroll") for (int _i = 0; _i < 2; ++_i) { const unsigned ob_ = FP8 ? aofs[(8 + _i) * NTHR] : rg[8 + _i]; \
        __builtin_amdgcn_global_load_lds((const unsigned*)((const char*)(gbase) + ob_), (LAS unsigned*)(lds + (bufoff) + ldsw + _i * 8192), 16, 0, 0); } } while (0)
#define PG8_STAGE_A(bufoff, kbyte, sel, h) do { const unsigned o0_ = PG8_OFS(sel, (h) * 2), o1_ = PG8_OFS(sel, (h) * 2 + 1); \
        __builtin_amdgcn_global_load_lds((const unsigned*)(Abase + (kbyte) + o0_), (LAS unsigned*)(lds + (bufoff) + ldsw), 16, 0, 0); \
        __builtin_amdgcn_global_load_lds((const unsigned*)(Abase + (kbyte) + o1_), (LAS unsigned*)(lds + (bufoff) + ldsw + 8192), 16, 0, 0); } while (0)
#define PG8_LDA(dst, b, h) do { _Pragma("unroll") for (int m = 0; m < 4; ++m) { \
        if constexpr (FP8) { const v4i_t lo_ = *(const LAS v4i_t*)(lds + PG8_SA(b, h) + aoff + m * 2048), hi_ = *(const LAS v4i_t*)(lds + PG8_SA(b, h) + (aoff ^ 64) + m * 2048); dst##8[m] = __builtin_shufflevector(lo_, hi_, 0, 1, 2, 3, 4, 5, 6, 7); } \
        else { _Pragma("unroll") for (int k = 0; k < 2; ++k) dst[m][k] = *(const LAS bf16x8*)(lds + PG8_SA(b, h) + (aoff ^ (k * 64)) + m * 2048); } } } while (0)
#define PG8_LDB(dst, b, h) do { _Pragma("unroll") for (int n = 0; n < 2; ++n) { \
        if constexpr (FP8) { const v4i_t lo_ = *(const LAS v4i_t*)(lds + PG8_SB(b, h) + boff + n * 2048), hi_ = *(const LAS v4i_t*)(lds + PG8_SB(b, h) + (boff ^ 64) + n * 2048); dst##8[n] = __builtin_shufflevector(lo_, hi_, 0, 1, 2, 3, 4, 5, 6, 7); } \
        else { _Pragma("unroll") for (int k = 0; k < 2; ++k) dst[n][k] = *(const LAS bf16x8*)(lds + PG8_SB(b, h) + (boff ^ (k * 64)) + n * 2048); } } } while (0)
#define PG8_MMA(ai, bj, At, Bt) do { __builtin_amdgcn_s_setprio(1); _Pragma("unroll") for (int m = 0; m < 4; ++m) _Pragma("unroll") for (int n = 0; n < 2; ++n) { \
        if constexpr (FP8) { acc[ai][bj][m][n] = __builtin_amdgcn_mfma_scale_f32_16x16x128_f8f6f4(Bt##8[n], At##8[m], acc[ai][bj][m][n], 0, 0, 0, SCA, 0, SCA); } \
        else { _Pragma("unroll") for (int k = 0; k < 2; ++k) acc[ai][bj][m][n] = __builtin_amdgcn_mfma_f32_16x16x32_bf16(Bt[n][k], At[m][k], acc[ai][bj][m][n], 0, 0, 0); } } \
        __builtin_amdgcn_s_setprio(0); } while (0)
#define PG8_WAIT_V(n) asm volatile("s_waitcnt vmcnt(" #n ")" ::: "memory")
#define PG8_WAIT_L(n) asm volatile("s_waitcnt lgkmcnt(" #n ")" ::: "memory")
#define PG8_BAR __builtin_amdgcn_s_barrier()
#define PG8_SCHED __builtin_amdgcn_sched_barrier(0)
    typename Sched::Unit cur, nxt; int ui = 0;
    if (!S.next(0, cur)) return;
    f32x4 acc[2][2][4][2];
    bf16x8 At[4][2], B0[2][2], B1[2][2];
    v8i_t At8[4], B08[2], B18[2];
    { unsigned a4[2][2]; S.a_off(cur, R0, C0, R1, C1, a4); rg[0] = a4[0][0]; rg[1] = a4[0][1]; rg[2] = a4[1][0]; rg[3] = a4[1][1];
      if constexpr (FP8) { aofs[0] = a4[0][0]; aofs[NTHR] = a4[0][1]; aofs[2 * NTHR] = a4[1][0]; aofs[3 * NTHR] = a4[1][1]; } }
    const char* cB = S.b_ptr(cur);
#define PG8_BIAS_DMA(unit, slot) do { const float* bp_ = E.bias_ptr(unit); int tb_ = threadIdx.x; asm volatile("" : "+v"(tb_)); if (wr == 0 && bp_ != nullptr) \
        __builtin_amdgcn_global_load_lds((const unsigned*)(bp_ + (tb_ & 255)), (LAS unsigned*)(lds + LDS_BIAS + (slot) * 1024 + wid * 256), 4, 0, 0); } while (0)
    PG8_BIAS_DMA(cur, 0);
    PG8_STAGE_B(PG8_SB(0, 0), cB); PG8_STAGE_B(PG8_SB(0, 1), cB + hstep); PG8_STAGE_A(PG8_SA(0, 0), 0, 0, 0); PG8_STAGE_A(PG8_SA(0, 1), 0, 0, 1);
    if (wr == 1) PG8_BAR;
    PG8_WAIT_V(2); PG8_BAR;
    PG8_STAGE_B(PG8_SB(1, 0), cB + kstep); PG8_STAGE_A(PG8_SA(1, 0), kstep, 0, 0); PG8_STAGE_B(PG8_SB(1, 1), cB + hstep + kstep);
    PG8_WAIT_V(6); PG8_BAR;
    { int t3 = threadIdx.x; asm volatile("" : "+v"(t3)); E.init(acc, wc, (t3 & 63) >> 4, (const LAS float*)(lds + LDS_BIAS)); }
    for (;;) {
        const bool has_next = S.next(ui + 1, nxt);
        const char* nB = cB;
        if (has_next) PG8_BIAS_DMA(nxt, (ui + 1) % 3);
        if (has_next) { int t2 = threadIdx.x; asm volatile("" : "+v"(t2)); int r0, c0, r1, c1; stage_rc(t2 * 16, r0, c0); stage_rc(t2 * 16 + 8192, r1, c1); nB = S.b_ptr(nxt);
            if constexpr (Sched::LIST_DMA) { static_assert(!Sched::LIST_DMA || FP8, "list DMA lands in the LDS offset slots"); S.a_dma(nxt, r0, r1, (LAS unsigned*)(lds + LDS_AOFF + 4 * NTHR * 4 + wid * 256)); }
            else { unsigned a4[2][2]; S.a_off(nxt, r0, c0, r1, c1, a4);
                rg[4] = a4[0][0]; rg[5] = a4[0][1]; rg[6] = a4[1][0]; rg[7] = a4[1][1];
                if constexpr (FP8) { aofs[4 * NTHR] = a4[0][0]; aofs[5 * NTHR] = a4[0][1]; aofs[6 * NTHR] = a4[1][0]; aofs[7 * NTHR] = a4[1][1]; } } }
        else { rg[4] = rg[0]; rg[5] = rg[1]; rg[6] = rg[2]; rg[7] = rg[3];
            if constexpr (FP8) { aofs[4 * NTHR] = aofs[0]; aofs[5 * NTHR] = aofs[NTHR]; aofs[6 * NTHR] = aofs[2 * NTHR]; aofs[7 * NTHR] = aofs[3 * NTHR]; } }
#pragma unroll 1
        for (int t = 0; t < nt; t += 2) {
            const bool last = (t == nt - 2);
            const size_t ka1 = (size_t)(t + 1) * kstep, ka2 = last ? 0 : (size_t)(t + 2) * kstep, ka3 = ka2 + kstep;
            const char* b2 = last ? nB : cB + (size_t)(t + 2) * kstep; const char* b3 = b2 + kstep;
            const int sel = last ? 1 : 0;
            if constexpr (Sched::LIST_DMA) if (last && has_next) {
                int t4 = threadIdx.x; asm volatile("" : "+v"(t4)); int r0, c0, r1, c1; stage_rc(t4 * 16, r0, c0); stage_rc(t4 * 16 + 8192, r1, c1);
#pragma unroll
                for (int j = 0; j < 4; ++j) aofs[(4 + j) * NTHR] = S.a_fin(aofs[(4 + j) * NTHR], (j & 1) ? c1 : c0);
            }
            PG8_LDB(B0, 0, 0); PG8_LDB(B1, 0, 1); PG8_SCHED; PG8_LDA(At, 0, 0); PG8_STAGE_A(PG8_SA(1, 1), ka1, 0, 1);
            PG8_WAIT_V(8); PG8_WAIT_L(0); PG8_BAR; PG8_MMA(0, 0, At, B0); PG8_MMA(0, 1, At, B1); PG8_BAR; PG8_SCHED;
            PG8_LDA(At, 0, 1); PG8_STAGE_B(PG8_SB(0, 0), b2); PG8_STAGE_B(PG8_SB(0, 1), b2 + hstep); PG8_STAGE_A(PG8_SA(0, 0), ka2, sel, 0);
            PG8_WAIT_V(8); PG8_WAIT_L(0); PG8_BAR; PG8_MMA(1, 0, At, B0); PG8_MMA(1, 1, At, B1); PG8_BAR; PG8_SCHED;
            PG8_LDB(B0, 1, 0); PG8_LDB(B1, 1, 1); PG8_SCHED; PG8_LDA(At, 1, 0); PG8_STAGE_A(PG8_SA(0, 1), ka2, sel, 1);
            PG8_WAIT_V(8); PG8_WAIT_L(0); PG8_BAR; PG8_MMA(0, 0, At, B0); PG8_MMA(0, 1, At, B1); PG8_BAR; PG8_SCHED;
            PG8_LDA(At, 1, 1); PG8_STAGE_B(PG8_SB(1, 0), b3); PG8_STAGE_B(PG8_SB(1, 1), b3 + hstep); PG8_STAGE_A(PG8_SA(1, 0), ka3, sel, 0);
            PG8_WAIT_V(8); PG8_WAIT_L(0); PG8_BAR; PG8_MMA(1, 0, At, B0); PG8_MMA(1, 1, At, B1); PG8_BAR; PG8_SCHED;
        }
        if (wr == 0) PG8_BAR;
        { int t2 = threadIdx.x; asm volatile("" : "+v"(t2)); E(acc, cur, wr, wc, t2 & 15, (t2 & 63) >> 4, (const LAS float*)(lds + LDS_BIAS + (ui % 3) * 1024)); }
        if (!has_next) break;
        { int t3 = threadIdx.x; asm volatile("" : "+v"(t3)); E.init(acc, wc, (t3 & 63) >> 4, (const LAS float*)(lds + LDS_BIAS + ((ui + 1) % 3) * 1024)); }
        cur = nxt; cB = nB; ++ui;
        rg[0] = rg[4]; rg[1] = rg[5]; rg[2] = rg[6]; rg[3] = rg[7];
        if constexpr (FP8) { aofs[0] = aofs[4 * NTHR]; aofs[NTHR] = aofs[5 * NTHR]; aofs[2 * NTHR] = aofs[6 * NTHR]; aofs[3 * NTHR] = aofs[7 * NTHR]; }
        if (wr == 1) PG8_BAR;
    }
    PG8_WAIT_V(0);
    PG8_BAR;
#undef PG8_BIAS_DMA
#undef PG8_SA
#undef PG8_SB
#undef PG8_STAGE_A
#undef PG8_OFS
#undef PG8_STAGE_B
#undef PG8_LDA
#undef PG8_LDB
#undef PG8_MMA
#undef PG8_WAIT_V
#undef PG8_WAIT_L
#undef PG8_BAR
#undef PG8_SCHED
}
}

struct DenseUnit { int pm, pn; };
struct DenseSched {
    typedef DenseUnit Unit;
    const char* Bt; int K, nM, nN, vc;
    __device__ __forceinline__ bool next(int i, Unit& u) const { return pg8::tile_order(i, gridDim.x, vc, nM, nN, u.pm, u.pn); }
    __device__ __forceinline__ void a_off(const Unit& u, int R0, int C0, int R1, int C1, unsigned (&off)[2][2]) const {
#pragma unroll
        for (int h = 0; h < 2; ++h) { off[h][0] = (unsigned)((u.pm * 256 + h * 128 + R0) * K + C0) * 2u; off[h][1] = (unsigned)((u.pm * 256 + h * 128 + R1) * K + C1) * 2u; }
    }
    __device__ __forceinline__ const char* b_ptr(const Unit& u) const { return Bt + (size_t)u.pn * 256 * K * 2; }
    static constexpr bool LIST_DMA = false;
    __device__ __forceinline__ void a_dma(const Unit&, int, int, LAS unsigned*) const {}
    __device__ __forceinline__ unsigned a_fin(unsigned raw, int) const { return raw; }
};
struct MoeUnit { int rbt, e, pn; };
template <bool GATHER>
struct MoeSched {
    typedef MoeUnit Unit;
    static constexpr int KP = 512;
    const char* Bt; const int* lists; const int* ptile; const int* ecnt; int nN, nrows, vc;
    __device__ __forceinline__ bool next(int i, Unit& u) const {
        int pm, pn; if (!pg8::tile_order(i, gridDim.x, vc, ptile[NE], nN, pm, pn)) return false;
        u.rbt = pm; u.e = ((const unsigned char*)ptile)[512 + pm]; u.pn = pn; return true;
    }
    __device__ __forceinline__ void a_off(const Unit& u, int R0, int C0, int R1, int C1, unsigned (&off)[2][2]) const {
        if (GATHER) {
            const int* lst = lists + (size_t)u.e * LIST_CAP; const int rb = u.rbt - ptile[u.e], cnt = ecnt[u.e];
#pragma unroll
            for (int h = 0; h < 2; ++h) {
                const int l0 = rb * 256 + h * 128 + R0, l1 = rb * 256 + h * 128 + R1;
                const int t0 = l0 < cnt ? (lst[l0] >> 2) : 0, t1 = l1 < cnt ? (lst[l1] >> 2) : 0;
                off[h][0] = (unsigned)(t0 * KP + C0) * 2u; off[h][1] = (unsigned)(t1 * KP + C1) * 2u;
            }
        } else {
#pragma unroll
            for (int h = 0; h < 2; ++h) { off[h][0] = (unsigned)((u.rbt * 256 + h * 128 + R0) * KP + C0) * 2u; off[h][1] = (unsigned)((u.rbt * 256 + h * 128 + R1) * KP + C1) * 2u; }
        }
    }
    __device__ __forceinline__ const char* b_ptr(const Unit& u) const { return Bt + ((size_t)u.e * nrows + (size_t)u.pn * 256) * KP * 2; }
    static constexpr bool LIST_DMA = GATHER;
    __device__ __forceinline__ void a_dma(const Unit& u, int R0, int R1, LAS unsigned* slot) const {
        const int* lst = lists + (size_t)u.e * LIST_CAP; const int rb = u.rbt - ptile[u.e], cm = ecnt[u.e] - 1;
#pragma unroll
        for (int h = 0; h < 2; ++h) {
            const int l0 = min(rb * 256 + h * 128 + R0, cm), l1 = min(rb * 256 + h * 128 + R1, cm);
            __builtin_amdgcn_global_load_lds((const unsigned*)(lst + l0), slot + (h * 2) * NTHR, 4, 0, 0);
            __builtin_amdgcn_global_load_lds((const unsigned*)(lst + l1), slot + (h * 2 + 1) * NTHR, 4, 0, 0);
        }
    }
    __device__ __forceinline__ unsigned a_fin(unsigned raw, int C) const { return (unsigned)((int)(raw >> 2) * KP + C) * 2u; }
};

__device__ __forceinline__ u32x2 quad_tr(unsigned p01, unsigned p23, int fr) {
    const unsigned sel = (fr & 1) ? 0x03020706u : 0x05040100u;
    const unsigned y01 = (unsigned)__builtin_amdgcn_update_dpp(0, (int)p01, 0xB1, 0xF, 0xF, true), y23 = (unsigned)__builtin_amdgcn_update_dpp(0, (int)p23, 0xB1, 0xF, 0xF, true);
    const unsigned q01 = __builtin_amdgcn_perm(y01, p01, sel), q23 = __builtin_amdgcn_perm(y23, p23, sel);
    const bool hi = (fr & 2) != 0;
    const unsigned snd = hi ? q01 : q23;
    const unsigned rcv = (unsigned)__builtin_amdgcn_update_dpp(0, (int)snd, 0x4E, 0xF, 0xF, true);
    u32x2 r; r.x = hi ? rcv : q01; r.y = hi ? q23 : rcv; return r;
}
struct EpiInProj {
    const Params* p; int l;
    __device__ __forceinline__ const float* bias_ptr(const DenseUnit& u) const { return p->binp + l * NPAD + u.pn * 256; }
    __device__ __forceinline__ void init(f32x4 (&acc)[2][2][4][2], int wc, int fq, const LAS float* bias) const {
#pragma unroll
        for (int bj = 0; bj < 2; ++bj)
#pragma unroll
            for (int n = 0; n < 2; ++n) {
                const f32x4 bv = *(const LAS f32x4*)(bias + bj * 128 + wc * 32 + n * 16 + 4 * fq);
#pragma unroll
                for (int ai = 0; ai < 2; ++ai)
#pragma unroll
                    for (int m = 0; m < 4; ++m) acc[ai][bj][m][n] = bv;
            }
    }
    __device__ __forceinline__ void operator()(const f32x4 (&acc)[2][2][4][2], const DenseUnit& u, int wr, int wc, int fr, int fq, const LAS float*) const {
#pragma unroll
        for (int bj = 0; bj < 2; ++bj) {
            int kind = 0, hb0 = 0;
            if (u.pn == 1) { kind = 1; hb0 = bj * 2; } else if (u.pn == 4 && bj == 1) { kind = 1; hb0 = 4; } else if (u.pn == 8 && bj == 0) { kind = 1; hb0 = 6; } else if (u.pn == 9 && bj == 0) { kind = 1; hb0 = 8; }
            else if (u.pn == 2) { kind = 2; hb0 = bj * 2; } else if (u.pn == 5 && bj == 0) { kind = 2; hb0 = 4; } else if (u.pn == 8 && bj == 1) { kind = 2; hb0 = 6; } else if (u.pn == 9 && bj == 1) { kind = 2; hb0 = 8; }
            const int c0 = wc * 32 + fq * 8;
            const int hh = hb0 + (c0 >> 6), d0 = c0 & 63;
#pragma unroll
            for (int ai = 0; ai < 2; ++ai)
#pragma unroll
                for (int m = 0; m < 4; ++m) {
                    const int row = u.pm * 256 + ai * 128 + wr * 64 + m * 16 + fr;
                    const f32x4 v0 = acc[ai][bj][m][0], v1 = acc[ai][bj][m][1];
                    u32x4 w; w.x = pack2(v0[0], v0[1]); w.y = pack2(v0[2], v0[3]); w.z = pack2(v1[0], v1[1]); w.w = pack2(v1[2], v1[3]);
                    if (kind == 0) *(u32x4*)(p->hb + (size_t)row * NMAIN + u.pn * 256 + bj * 128 + c0) = w;
                    else {
                        const int b = row >> 11, s = row & 2047, kk = s & 31;
                        bf16_t* blk = (kind == 1 ? p->kF : p->vT) + (((size_t)b * NVH + hh) * 64 + (s >> 5)) * 2048;
                        if (kind == 1) {
                            const int frk = (kk >> 3) * 4 + (kk & 3), t = (kk >> 2) & 1;
                            *(u32x4*)(blk + ((t * 2 + (d0 >> 5)) * 64 + ((d0 & 31) >> 3) * 16 + frk) * 8) = w;
                        } else {
                            const int kq = kk & 28;
                            const u32x2 t0 = quad_tr(w.x, w.y, fr), t1 = quad_tr(w.z, w.w, fr);
                            bf16_t* vt = blk + (((d0 >> 4) * 64) + (kq >> 3) * 16 + (d0 & 15) + (fr & 3)) * 8 + (kq & 7);
                            *(u32x2*)vt = t0; *(u32x2*)(vt + 32) = t1;
                        }
                    }
                }
        }
    }
};
struct EpiOutProj {
    const bf16_t* xin; float* t;
    __device__ __forceinline__ const float* bias_ptr(const DenseUnit&) const { return nullptr; }
    __device__ __forceinline__ void init(f32x4 (&acc)[2][2][4][2], int, int, const LAS float*) const {
#pragma unroll
        for (int ai = 0; ai < 2; ++ai)
#pragma unroll
            for (int bj = 0; bj < 2; ++bj)
#pragma unroll
                for (int m = 0; m < 4; ++m)
#pragma unroll
                    for (int n = 0; n < 2; ++n) acc[ai][bj][m][n] = (f32x4){0.f, 0.f, 0.f, 0.f};
    }
    __device__ __forceinline__ void operator()(const f32x4 (&acc)[2][2][4][2], const DenseUnit& u, int wr, int wc, int fr, int fq, const LAS float*) const {
#pragma unroll
        for (int ai = 0; ai < 2; ++ai)
#pragma unroll
            for (int m = 0; m < 4; ++m) {
                const size_t off = (size_t)(u.pm * 256 + ai * 128 + wr * 64 + m * 16 + fr) * DM + u.pn * 256 + wc * 64 + fq * 16;
                u32x4 w0, w1;
                { const f32x4 a = acc[ai][0][m][0]; w0.x = pack2(a[0], a[1]); w0.y = pack2(a[2], a[3]); }
                { const f32x4 a = acc[ai][0][m][1]; w0.z = pack2(a[0], a[1]); w0.w = pack2(a[2], a[3]); }
                { const f32x4 a = acc[ai][1][m][0]; w1.x = pack2(a[0], a[1]); w1.y = pack2(a[2], a[3]); }
                { const f32x4 a = acc[ai][1][m][1]; w1.z = pack2(a[0], a[1]); w1.w = pack2(a[2], a[3]); }
                *(u32x4*)((bf16_t*)t + off) = w0; *(u32x4*)((bf16_t*)t + off + 8) = w1;
            }
    }
};
struct EpiGateUp {
    bf16_t* act; const float* bgup;
    __device__ __forceinline__ const float* bias_ptr(const MoeUnit& u) const { return bgup + (size_t)u.e * 2048 + u.pn * 256; }
    __device__ __forceinline__ void init(f32x4 (&acc)[2][2][4][2], int wc, int fq, const LAS float* bias) const {
#pragma unroll
        for (int bj = 0; bj < 2; ++bj)
#pragma unroll
            for (int n = 0; n < 2; ++n) {
                const f32x4 bv = *(const LAS f32x4*)(bias + bj * 128 + wc * 32 + n * 16 + 4 * fq);
#pragma unroll
                for (int ai = 0; ai < 2; ++ai)
#pragma unroll
                    for (int m = 0; m < 4; ++m) acc[ai][bj][m][n] = bv;
            }
    }
    __device__ __forceinline__ void operator()(const f32x4 (&acc)[2][2][4][2], const MoeUnit& u, int wr, int wc, int fr, int fq, const LAS float*) const {
        constexpr float GMIN = 7.0f * GATE_PRE, CI = 1.0f / GATE_PRE;
#pragma unroll
        for (int ai = 0; ai < 2; ++ai)
#pragma unroll
            for (int m = 0; m < 4; ++m) {
                u32x2 w;
#pragma unroll
                for (int n = 0; n < 2; ++n) {
                    const f32x4 g4 = acc[ai][0][m][n], u4 = acc[ai][1][m][n];
                    float o[4];
#pragma unroll
                    for (int j = 0; j < 4; ++j) {
                        const float gp = fmaxf(g4[j], GMIN), uu = fminf(fmaxf(u4[j], -7.0f), 7.0f);
                        const float glu = gp * __builtin_amdgcn_rcpf(1.0f + __builtin_amdgcn_exp2f(gp));
                        o[j] = __builtin_fmaf(uu, CI, CI) * glu;
                    }
                    const unsigned pk = pack4_fp8(o[0], o[1], o[2], o[3]);
                    if (n == 0) w.x = pk; else w.y = pk;
                }
                *(u32x2*)((char*)act + (size_t)(u.rbt * 256 + ai * 128 + wr * 64 + m * 16 + fr) * DFF + u.pn * 128 + wc * 32 + fq * 8) = w;
            }
    }
};
struct EpiDown {
    bf16_t* ybuf; const float* bdn;
    __device__ __forceinline__ const float* bias_ptr(const MoeUnit& u) const { return bdn + (size_t)u.e * 1024 + u.pn * 256; }
    __device__ __forceinline__ void init(f32x4 (&acc)[2][2][4][2], int wc, int fq, const LAS float* bias) const {
#pragma unroll
        for (int bj = 0; bj < 2; ++bj)
#pragma unroll
            for (int n = 0; n < 2; ++n) {
                const f32x4 bv = *(const LAS f32x4*)(bias + wc * 64 + fq * 16 + bj * 8 + n * 4);
#pragma unroll
                for (int ai = 0; ai < 2; ++ai)
#pragma unroll
                    for (int m = 0; m < 4; ++m) acc[ai][bj][m][n] = bv;
            }
    }
    __device__ __forceinline__ void operator()(const f32x4 (&acc)[2][2][4][2], const MoeUnit& u, int wr, int wc, int fr, int fq, const LAS float*) const {
#pragma unroll
        for (int ai = 0; ai < 2; ++ai)
#pragma unroll
            for (int m = 0; m < 4; ++m) {
                u32x4 w;
                { const f32x4 v = acc[ai][0][m][0]; w.x = pack4_fp8(v[0], v[1], v[2], v[3]); }
                { const f32x4 v = acc[ai][0][m][1]; w.y = pack4_fp8(v[0], v[1], v[2], v[3]); }
                { const f32x4 v = acc[ai][1][m][0]; w.z = pack4_fp8(v[0], v[1], v[2], v[3]); }
                { const f32x4 v = acc[ai][1][m][1]; w.w = pack4_fp8(v[0], v[1], v[2], v[3]); }
                *(u32x4*)((unsigned char*)ybuf + (size_t)(u.rbt * 256 + ai * 128 + wr * 64 + m * 16 + fr) * DM + u.pn * 256 + wc * 64 + fq * 16) = w;
            }
    }
};

__device__ __forceinline__ void phase_inproj(const Params& p, int l, char* lds) {
    DenseSched S{(const char*)p.WinQ + (size_t)l * NMAIN * 1024, 512, NTOK / 256, NMAIN / 256, vcu_id()};
    EpiInProj E{&p, l};
    pg8::gemm_phase<true, 0x7c7c7c7c>((LAS unsigned char*)lds, (const char*)p.xq, 512, S, E);
    int tid = threadIdx.x; asm volatile("" : "+v"(tid));
    const int wid = tid >> 6, lane = tid & 63, fr = lane & 15, fq = lane >> 4;
    const bf16_t* W = p.WinT + ((size_t)l * NPAD + NMAIN) * 1024;
    const float* bias = p.binp + l * NPAD + NMAIN;
    constexpr int WP = 2064;
#pragma unroll
    for (int i = 0; i < 8; ++i) { const int pc = wid * 8 + i, r = pc >> 1, q = pc & 1;
        __builtin_amdgcn_global_load_lds((const unsigned*)(W + (size_t)r * 1024 + q * 512 + lane * 8), (LAS unsigned*)((LAS char*)lds + r * WP + q * 1024), 16, 0, 0); }
    asm volatile("s_waitcnt vmcnt(0)" ::: "memory");
    __syncthreads();
    for (int u = blockIdx.x * NWV + wid; u < NTOK / 16; u += gridDim.x * NWV) {
        const bf16_t* ar = p.xb + (size_t)(u * 16 + fr) * DM + fq * 8;
        const LAS char* w0 = (const LAS char*)lds + fr * WP + fq * 16; const LAS char* w1 = w0 + 16 * WP;
        f32x4 a0 = (f32x4){0.f, 0.f, 0.f, 0.f}, a1 = a0;
#pragma unroll 4
        for (int ks = 0; ks < 32; ++ks) {
            const bf16x8 a = *(const bf16x8*)(ar + ks * 32);
            a0 = __builtin_amdgcn_mfma_f32_16x16x32_bf16(a, *(const LAS bf16x8*)(w0 + ks * 64), a0, 0, 0, 0);
            a1 = __builtin_amdgcn_mfma_f32_16x16x32_bf16(a, *(const LAS bf16x8*)(w1 + ks * 64), a1, 0, 0, 0);
        }
#pragma unroll
        for (int r = 0; r < 4; ++r) {
            float* dst = p.hs + (size_t)(u * 16 + fq * 4 + r) * HS_W;
            dst[fr] = a0[r] + bias[fr];
            if (fr < 6) dst[16 + fr] = a1[r] + bias[16 + fr];
        }
    }
}
__device__ __forceinline__ void phase_outproj(const Params& p, int l, const bf16_t* xin, char* lds) {
    DenseSched S{(const char*)p.WoT + (size_t)l * 1024 * 1024, 512, NTOK / 256, 4, vcu_id()};
    EpiOutProj E{xin, p.tbuf};
    pg8::gemm_phase<true, 0x7c7c7c7c>((LAS unsigned char*)lds, (const char*)p.ob, 512, S, E);
}
__device__ __forceinline__ void build_tiles(const Params& p, int l, int* ptile, int* ecnt) {
    int tid = threadIdx.x; asm volatile("" : "+v"(tid));
    if (tid < NE) ecnt[tid] = (int)__hip_atomic_load(p.ctrl + 64 + l * NE + tid, __ATOMIC_RELAXED, __HIP_MEMORY_SCOPE_AGENT);
    __syncthreads();
    if (tid == 0) { int s = 0; for (int e = 0; e < NE; ++e) { ptile[e] = s; s += (ecnt[e] + 255) >> 8; } ptile[NE] = s; }
    __syncthreads();
    unsigned char* texp = (unsigned char*)ptile + 512;
    for (int t = tid; t < ptile[NE]; t += NTHR) { int e = 0; while (ptile[e + 1] <= t) ++e; texp[t] = (unsigned char)e; }
    __syncthreads();
}
__device__ __forceinline__ void phase_gateup(const Params& p, int l, char* lds) {
    int* ptile = (int*)(lds + LDS_TAB); int* ecnt = ptile + 40;
    build_tiles(p, l, ptile, ecnt);
    MoeSched<true> S{(const char*)p.WguT + (size_t)l * NE * 2048 * 1024, p.lists, ptile, ecnt, 8, 2048, vcu_id()};
    EpiGateUp E{p.act, p.bgup + (size_t)l * NE * 2048};
    pg8::gemm_phase<true, 0x7c7c7c7c>((LAS unsigned char*)lds, (const char*)p.x1b, 512, S, E);
}
__device__ __forceinline__ void phase_down(const Params& p, int l, char* lds) {
    int* ptile = (int*)(lds + LDS_TAB); int* ecnt = ptile + 40;
    MoeSched<false> S{(const char*)p.WdnT + (size_t)l * NE * 1024 * 1024, p.lists, ptile, ecnt, 4, 1024, vcu_id()};
    EpiDown E{p.ybuf, p.b_dn + (size_t)l * NE * 1024};
    pg8::gemm_phase<true, 0x7c7c7c7c>((LAS unsigned char*)lds, (const char*)p.act, 512, S, E);
}

__device__ __forceinline__ float gelu_tanh(float x) {
    const float u = 0.7978845608028654f * (x + 0.044715f * x * x * x);
    const float e = __expf(-2.0f * fabsf(u)); const float th = (1.0f - e) / (1.0f + e);
    return 0.5f * x * (1.0f + (u < 0.f ? -th : th));
}
__device__ __forceinline__ void phase_prep(const Params& p, int l, char* lds) {
    int tid = threadIdx.x; asm volatile("" : "+v"(tid));
    const int wid = tid >> 6, lane = tid & 63, fr = lane & 15, fq = lane >> 4;
    const int gw = blockIdx.x * NWV + wid, nw = gridDim.x * NWV;
    for (int u = (int)gridDim.x - 1 - (int)blockIdx.x; u < NB * 4; u += gridDim.x) {
        const int b = u >> 2, h = u & 3;
        const float* srcp = p.hs + ((size_t)b * SEQ + tid * 4) * HS_W + h;
        float ls[4]; float tot = 0.f;
#pragma unroll
        for (int i = 0; i < 4; ++i) { const float f = srcp[(size_t)i * HS_W]; ls[i] = fminf(f, 0.f) - log1pf(__expf(-fabsf(f))); tot += ls[i]; }
        float inc = tot;
#pragma unroll
        for (int o = 1; o < 64; o <<= 1) { const float v = shfl_f(inc, lane - o); if (lane >= o) inc += v; }
        float* wtot = (float*)(lds + 65536);
        if (lane == 63) wtot[wid] = inc;
        __syncthreads();
        float base = inc - tot;
        for (int w = 0; w < wid; ++w) base += wtot[w];
        float4 o4; o4.x = base + ls[0]; o4.y = o4.x + ls[1]; o4.z = o4.y + ls[2]; o4.w = o4.z + ls[3];
        *(float4*)(p.cF + (size_t)u * SEQ + tid * 4) = o4;
        __syncthreads();
    }
    float* part = (float*)lds;
    bf16_t* h1 = (bf16_t*)(lds + 32768);
    for (int u = blockIdx.x; u < NB * 2 * 2 * 8; u += gridDim.x) {
        const int ct = u & 7, which = (u >> 3) & 1, kvh = (u >> 4) & 1, b = u >> 5;
        const int colo = (which ? C_NVC : C_NKC) + kvh * 64;
        const int c_lane = ct * 16 + fr;
        const int tokbase = min(c_lane, 126) * 16;
        const bf16_t* arow = p.hb + ((size_t)b * SEQ + tokbase) * NMAIN + colo + fq * 8;
        const bf16_t* w1 = p.W1T + ((size_t)(l * 2 + which) * 64 + fr) * 2048 + fq * 8;
        f32x4 acc[4];
#pragma unroll
        for (int n = 0; n < 4; ++n) acc[n] = (f32x4){0.f, 0.f, 0.f, 0.f};
#pragma unroll
        for (int kk = 0; kk < 8; ++kk) {
            const int ks = wid * 8 + kk;
            const bf16x8 a = *(const bf16x8*)(arow + (size_t)(ks >> 1) * NMAIN + (ks & 1) * 32);
#pragma unroll
            for (int n = 0; n < 4; ++n) {
                const bf16x8 bb = *(const bf16x8*)(w1 + (size_t)n * 16 * 2048 + ks * 32);
                acc[n] = __builtin_amdgcn_mfma_f32_16x16x32_bf16(a, bb, acc[n], 0, 0, 0);
            }
        }
#pragma unroll
        for (int n = 0; n < 4; ++n)
#pragma unroll
            for (int r = 0; r < 4; ++r) part[wid * 1024 + (fq * 4 + r) * 64 + n * 16 + fr] = acc[n][r];
        __syncthreads();
        const float* b1 = p.b1c + (l * 2 + which) * 8 * 64;
#pragma unroll
        for (int i = 0; i < 2; ++i) {
            const int e = tid + NTHR * i; float sum = 0.f, bsum = 0.f;
#pragma unroll
            for (int w = 0; w < 8; ++w) { sum += part[w * 1024 + e]; bsum += b1[w * 64 + (e & 63)]; }
            h1[e] = f2bf(gelu_tanh(sum + bsum));
        }
        __syncthreads();
        if (wid == 0) {
            const bf16_t* w2 = p.W2T + ((size_t)(l * 2 + which) * 64 + fr) * 64 + fq * 8;
            f32x4 o2[4];
#pragma unroll
            for (int n = 0; n < 4; ++n) o2[n] = (f32x4){0.f, 0.f, 0.f, 0.f};
#pragma unroll
            for (int ks = 0; ks < 2; ++ks) {
                const bf16x8 a = *(const bf16x8*)(h1 + fr * 64 + ks * 32 + fq * 8);
#pragma unroll
                for (int n = 0; n < 4; ++n) {
                    const bf16x8 bb = *(const bf16x8*)(w2 + (size_t)n * 16 * 64 + ks * 32);
                    o2[n] = __builtin_amdgcn_mfma_f32_16x16x32_bf16(a, bb, o2[n], 0, 0, 0);
                }
            }
            const size_t base = ((size_t)b * 2 + kvh) * 128 * 64;
#pragma unroll
            for (int n = 0; n < 4; ++n)
#pragma unroll
                for (int r = 0; r < 4; ++r) {
                    const int c = ct * 16 + fq * 4 + r, j2 = n * 16 + fr;
                    const bf16_t v = c < 127 ? f2bf(o2[n][r]) : (bf16_t)0;
                    if (which == 0) p.kc[base + (size_t)c * 64 + j2] = v;
                    else { p.vc[base + (size_t)c * 64 + j2] = v; p.vcT[base + (size_t)j2 * 128 + c] = v; }
                }
        }
        __syncthreads();
    }
}

constexpr float L2E = 1.4426950408889634f, MASKV = -__builtin_huge_valf(), MINIT = -1e30f, SCL2 = QSCALE * L2E;
struct KVFrag { bf16x8 k[2][2]; bf16x8 v[4]; };
template <bool FM>
__device__ __forceinline__ void k_load(KVFrag& f, const bf16_t* __restrict__ Kb, size_t ldk, int kc0, int fr, int fq) {
    if (FM) {
        const bf16_t* kp = Kb + (size_t)(kc0 >> 5) * 2048 + (fq * 16 + fr) * 8;
        f.k[0][0] = *(const bf16x8*)(kp); f.k[0][1] = *(const bf16x8*)(kp + 512); f.k[1][0] = *(const bf16x8*)(kp + 1024); f.k[1][1] = *(const bf16x8*)(kp + 1536);
    } else {
        const bf16_t* kp = Kb + (size_t)(kc0 + (fr >> 2) * 8 + (fr & 3)) * ldk + fq * 8;
        f.k[0][0] = *(const bf16x8*)(kp); f.k[0][1] = *(const bf16x8*)(kp + 32);
        f.k[1][0] = *(const bf16x8*)(kp + 4 * ldk); f.k[1][1] = *(const bf16x8*)(kp + 4 * ldk + 32);
    }
}
template <bool FM>
__device__ __forceinline__ void v_load(bf16x8 (&v)[4], const bf16_t* __restrict__ VTb, size_t ldv, int kc0, int fr, int fq) {
    if (FM) {
        const bf16_t* vp = VTb + (size_t)(kc0 >> 5) * 2048 + (fq * 16 + fr) * 8;
#pragma unroll
        for (int dt = 0; dt < 4; ++dt) v[dt] = *(const bf16x8*)(vp + dt * 512);
    } else {
        const bf16_t* vp = VTb + (size_t)fr * ldv + kc0 + fq * 8;
#pragma unroll
        for (int dt = 0; dt < 4; ++dt) v[dt] = *(const bf16x8*)(vp + (size_t)dt * 16 * ldv);
    }
}
__device__ __forceinline__ float rowmax4(float x) {
    auto r = __builtin_amdgcn_permlane32_swap(__float_as_uint(x), __float_as_uint(x), false, false);
    x = fmaxf(__uint_as_float(r[0]), __uint_as_float(r[1]));
    auto q = __builtin_amdgcn_permlane16_swap(__float_as_uint(x), __float_as_uint(x), false, false);
    return fmaxf(__uint_as_float(q[0]), __uint_as_float(q[1]));
}
__device__ __forceinline__ float rowsum4(float x) {
    auto r = __builtin_amdgcn_permlane32_swap(__float_as_uint(x), __float_as_uint(x), false, false);
    x = __uint_as_float(r[0]) + __uint_as_float(r[1]);
    auto q = __builtin_amdgcn_permlane16_swap(__float_as_uint(x), __float_as_uint(x), false, false);
    return __uint_as_float(q[0]) + __uint_as_float(q[1]);
}
template <int NQT, bool MASK, class MB>
__device__ __forceinline__ void attn_compute(const KVFrag& f, const bf16x8 (&qf)[NQT][2], f32x4 (&o)[NQT][4], float (&m)[NQT], float (&l)[NQT], const MB& mb) {
    f32x4 s0[NQT], s1[NQT];
#pragma unroll
    for (int qt = 0; qt < NQT; ++qt) {
        s0[qt] = __builtin_amdgcn_mfma_f32_16x16x32_bf16(f.k[0][0], qf[qt][0], (f32x4){0.f, 0.f, 0.f, 0.f}, 0, 0, 0);
        s1[qt] = __builtin_amdgcn_mfma_f32_16x16x32_bf16(f.k[1][0], qf[qt][0], (f32x4){0.f, 0.f, 0.f, 0.f}, 0, 0, 0);
    }
#pragma unroll
    for (int qt = 0; qt < NQT; ++qt) {
        s0[qt] = __builtin_amdgcn_mfma_f32_16x16x32_bf16(f.k[0][1], qf[qt][1], s0[qt], 0, 0, 0);
        s1[qt] = __builtin_amdgcn_mfma_f32_16x16x32_bf16(f.k[1][1], qf[qt][1], s1[qt], 0, 0, 0);
    }
    float mx[NQT];
#pragma unroll
    for (int qt = 0; qt < NQT; ++qt) {
#pragma unroll
        for (int j = 0; j < 4; ++j) { s0[qt][j] = mb(qt, j, s0[qt][j]); s1[qt][j] = mb(qt, j + 4, s1[qt][j]); }
        mx[qt] = fmaxf(fmaxf(fmaxf(s0[qt][0], s0[qt][1]), fmaxf(s0[qt][2], s0[qt][3])), fmaxf(fmaxf(s1[qt][0], s1[qt][1]), fmaxf(s1[qt][2], s1[qt][3])));
    }
#pragma unroll
    for (int qt = 0; qt < NQT; ++qt) mx[qt] = rowmax4(mx[qt]);
    bool moved = false;
#pragma unroll
    for (int qt = 0; qt < NQT; ++qt) { mx[qt] = fmaxf(m[qt], mx[qt]); moved |= (mx[qt] != m[qt]); }
    if (__ballot(moved) != 0ull) {
#pragma unroll
        for (int qt = 0; qt < NQT; ++qt) {
            const float alpha = __builtin_amdgcn_exp2f(m[qt] - mx[qt]);
            l[qt] *= alpha;
#pragma unroll
            for (int dt = 0; dt < 4; ++dt) o[qt][dt] *= alpha;
        }
    }
    bf16x8 pf[NQT];
#pragma unroll
    for (int qt = 0; qt < NQT; ++qt) {
        m[qt] = mx[qt];
        float pr[8]; float ps = 0.f;
#pragma unroll
        for (int j = 0; j < 4; ++j) {
            pr[j] = __builtin_amdgcn_exp2f(s0[qt][j] - mx[qt]);
            pr[j + 4] = __builtin_amdgcn_exp2f(s1[qt][j] - mx[qt]);
        }
#pragma unroll
        for (int j = 0; j < 8; ++j) ps += pr[j];
        l[qt] += ps;
        const u32x4 pk = {pack2(pr[0], pr[1]), pack2(pr[2], pr[3]), pack2(pr[4], pr[5]), pack2(pr[6], pr[7])};
        pf[qt] = __builtin_bit_cast(bf16x8, pk);
    }
#pragma unroll
    for (int dt = 0; dt < 4; ++dt)
#pragma unroll
        for (int qt = 0; qt < NQT; ++qt) o[qt][dt] = __builtin_amdgcn_mfma_f32_16x16x32_bf16(f.v[dt], pf[qt], o[qt][dt], 0, 0, 0);
    __builtin_amdgcn_sched_barrier(0);
}
struct RangeIt { int c, c_hi; __device__ __forceinline__ int nxt() { if (c > c_hi) return -1; return (c++) * 32; } };
struct MaskIt { unsigned long long cm; __device__ __forceinline__ int nxt() { if (!cm) return -1; const int i = __builtin_ctzll(cm); cm &= cm - 1; return i * 32; } };
template <bool PFV, bool FM, class It, class Gen>
__device__ __forceinline__ void attn_run(It& it, const bf16_t* Kb, size_t ldk, const bf16_t* VTb, size_t ldv, int fr, int fq, const Gen& gen) {
    KVFrag fa, fb;
    int ka = it.nxt(); if (ka < 0) return;
    k_load<FM>(fa, Kb, ldk, ka, fr, fq); if (PFV) v_load<FM>(fa.v, VTb, ldv, ka, fr, fq);
    for (;;) {
        const int kb = it.nxt(); if (kb >= 0) { k_load<FM>(fb, Kb, ldk, kb, fr, fq); if (PFV) v_load<FM>(fb.v, VTb, ldv, kb, fr, fq); }
        if (!PFV) v_load<FM>(fa.v, VTb, ldv, ka, fr, fq);
        gen(ka, fa);
        if (kb < 0) break;
        ka = it.nxt(); if (ka >= 0) { k_load<FM>(fa, Kb, ldk, ka, fr, fq); if (PFV) v_load<FM>(fa.v, VTb, ldv, ka, fr, fq); }
        if (!PFV) v_load<FM>(fb.v, VTb, ldv, kb, fr, fq);
        gen(kb, fb);
        if (ka < 0) break;
    }
}
template <int NQT>
__device__ __forceinline__ void attn_init(f32x4 (&o)[NQT][4], float (&m)[NQT], float (&l)[NQT]) {
#pragma unroll
    for (int qt = 0; qt < NQT; ++qt) { m[qt] = MINIT; l[qt] = 0.f;
#pragma unroll
        for (int dt = 0; dt < 4; ++dt) o[qt][dt] = (f32x4){0.f, 0.f, 0.f, 0.f}; }
}
__device__ __forceinline__ float lsum4(float l) { return rowsum4(l); }
__device__ __forceinline__ void store_o16(unsigned char* dst, const f32x4 v0, const f32x4 v1, const f32x4 v2, const f32x4 v3) {
    u32x4 w; w.x = pack4_fp8(v0[0], v0[1], v0[2], v0[3]); w.y = pack4_fp8(v1[0], v1[1], v1[2], v1[3]); w.z = pack4_fp8(v2[0], v2[1], v2[2], v2[3]); w.w = pack4_fp8(v3[0], v3[1], v3[2], v3[3]);
    *(u32x4*)dst = w;
}
__device__ __forceinline__ float sigmoidf_fast(float x) { return __builtin_amdgcn_rcpf(1.0f + __builtin_amdgcn_exp2f(-L2E * x)); }

__device__ __forceinline__ void fox_unit(const Params& p, int b, int h, int qb, int fr, int fq) {
    asm volatile("" : "+v"(fr), "+v"(fq));
    const int t0 = qb * 64;
    const bf16_t* Qb = p.hb + ((size_t)b * SEQ + t0) * NMAIN + C_FQ + h * 64 + fq * 8;
    bf16x8 qf[4][2];
#pragma unroll
    for (int qt = 0; qt < 4; ++qt) { qf[qt][0] = *(const bf16x8*)(Qb + (size_t)(qt * 16 + fr) * NMAIN); qf[qt][1] = *(const bf16x8*)(Qb + (size_t)(qt * 16 + fr) * NMAIN + 32); }
    const float* cf = p.cF + ((size_t)b * 4 + h) * SEQ;
    float cq[4];
#pragma unroll
    for (int qt = 0; qt < 4; ++qt) cq[qt] = cf[t0 + qt * 16 + fr] * L2E;
    f32x4 o[4][4]; float m[4], l[4];
    attn_init<4>(o, m, l);
    const bf16_t* Kb = p.kF + ((size_t)b * NVH + h) * 64 * SEQ;
    const bf16_t* VTb = p.vT + ((size_t)b * NVH + h) * 64 * SEQ;
    RangeIt it{0, (t0 >> 5) + 1};
    attn_run<false, true>(it, Kb, NMAIN, VTb, SEQ, fr, fq, [&](int kc0, const KVFrag& f) {
        const float4 ca = *(const float4*)(cf + kc0 + 8 * fq), cb = *(const float4*)(cf + kc0 + 8 * fq + 4);
        const float ck[8] = {ca.x * L2E, ca.y * L2E, ca.z * L2E, ca.w * L2E, cb.x * L2E, cb.y * L2E, cb.z * L2E, cb.w * L2E};
        const int kq = kc0 + 8 * fq - t0 - fr;
        attn_compute<4, true>(f, qf, o, m, l, [&](int qt, int j, float raw) { return (kq + j - 16 * qt) > 0 ? MASKV : raw * SCL2 + cq[qt] - ck[j]; });
    });
#pragma unroll
    for (int qt = 0; qt < 4; ++qt) {
        const float inv = __builtin_amdgcn_rcpf(lsum4(l[qt]));
        unsigned char* dst = (unsigned char*)p.ob + ((size_t)b * SEQ + t0 + qt * 16 + fr) * DM + h * 64 + 16 * fq;
        store_o16(dst, o[qt][0] * inv, o[qt][1] * inv, o[qt][2] * inv, o[qt][3] * inv);
    }
}
__device__ __forceinline__ void swa_unit(const Params& p, int l_, int b, int kv, int pos, int fr, int fq) {
    asm volatile("" : "+v"(fr), "+v"(fq));
    const int t0 = pos * 16, t = t0 + fr;
    const bf16_t* Qb = p.hb + ((size_t)b * SEQ + t) * NMAIN + C_SQ + kv * 192 + fq * 8;
    bf16x8 qf[3][2];
#pragma unroll
    for (int g = 0; g < 3; ++g) { qf[g][0] = *(const bf16x8*)(Qb + g * 64); qf[g][1] = *(const bf16x8*)(Qb + g * 64 + 32); }
    float sl[3];
#pragma unroll
    for (int g = 0; g < 3; ++g) sl[g] = slope_swa(kv * 3 + g) * L2E;
    f32x4 o[3][4]; float m[3], l[3];
    attn_init<3>(o, m, l);
    const bf16_t* Kb = p.kF + ((size_t)b * NVH + 4 + kv) * 64 * SEQ;
    const bf16_t* VTb = p.vT + ((size_t)b * NVH + 4 + kv) * 64 * SEQ;
    RangeIt it{max(0, t0 - 127) >> 5, (t0 + 15) >> 5};
    attn_run<true, true>(it, Kb, NMAIN, VTb, SEQ, fr, fq, [&](int kc0, const KVFrag& f) {
        const int dq = t - kc0 - 8 * fq;
        attn_compute<3, true>(f, qf, o, m, l, [&](int g, int j, float raw) { const int dist = dq - j; return ((unsigned)dist < 128u) ? raw * SCL2 - sl[g] * (float)dist : MASKV; });
    });
#pragma unroll
    for (int g = 0; g < 3; ++g) {
        const float sink = p.sinks[l_ * 6 + kv * 3 + g] * L2E;
        const float inv = __builtin_amdgcn_rcpf(lsum4(l[g]) + __builtin_amdgcn_exp2f(sink - m[g]));
        unsigned char* dst = (unsigned char*)p.ob + ((size_t)b * SEQ + t) * DM + 256 + (kv * 3 + g) * 64 + 16 * fq;
        store_o16(dst, o[g][0] * inv, o[g][1] * inv, o[g][2] * inv, o[g][3] * inv);
    }
}
__device__ __forceinline__ void nsa_unit(const Params& p, int b, int kv, int pos, int fr, int fq, int lane, float* ps, unsigned* msk, float* otl) {
    asm volatile("" : "+v"(fr), "+v"(fq), "+v"(lane));
    const int t0 = pos * 16, t = t0 + fr, cur = t0 >> 6;
    const bf16_t* Qb = p.hb + ((size_t)b * SEQ + t) * NMAIN + C_NQ + kv * 192 + fq * 8;
    bf16x8 qf[3][2];
#pragma unroll
    for (int g = 0; g < 3; ++g) { qf[g][0] = *(const bf16x8*)(Qb + g * 64); qf[g][1] = *(const bf16x8*)(Qb + g * 64 + 32); }
    float sl[3];
#pragma unroll
    for (int g = 0; g < 3; ++g) sl[g] = slope_nsa(kv * 3 + g) * L2E;
    const float* gl = p.hs + ((size_t)b * SEQ + t) * HS_W + 4 + kv * 9;
    f32x4 o[3][4]; float m[3], l[3];
    f32x4* otv = (f32x4*)otl + lane;
#pragma unroll
    for (int i = 0; i < 8; ++i) ps[lane + 64 * i] = 0.f;
    {
        const bf16_t* Kb = p.kc + ((size_t)b * 2 + kv) * 128 * 64;
        const bf16_t* VTb = p.vcT + ((size_t)b * 2 + kv) * 64 * 128;
        const int ncv = (t0 + 15 >= 31) ? ((t0 + 15 - 31) >> 4) + 1 : 0;
        const int nch = (ncv + 31) >> 5;
        attn_init<3>(o, m, l);
        const int dq0 = t - 31 - 16 * 8 * fq;
        RangeIt it{0, nch - 1};
        attn_run<false, false>(it, Kb, 64, VTb, 128, fr, fq, [&](int kc0, const KVFrag& f) {
            const int dq = dq0 - 16 * kc0;
            attn_compute<3, true>(f, qf, o, m, l, [&](int g, int j, float raw) { const int dist = dq - 16 * j; return dist >= 0 ? raw * SCL2 - sl[g] * (float)dist : MASKV; });
        });
        float il[3];
#pragma unroll
        for (int g = 0; g < 3; ++g) {
            const float lt = lsum4(l[g]); il[g] = lt > 0.f ? __builtin_amdgcn_rcpf(lt) : 0.f;
            const float gate = sigmoidf_fast(gl[g * 3 + 0]);
#pragma unroll
            for (int dt = 0; dt < 4; ++dt) otv[(g * 4 + dt) * 64] = o[g][dt] * (il[g] * gate);
        }
        float carry_prev = 0.f;
        for (int c = 0; c < nch; ++c) {
            const int kc0 = c * 32, dq = dq0 - 16 * kc0;
            const bf16_t* kp = Kb + (size_t)(kc0 + (fr >> 2) * 8 + (fr & 3)) * 64 + fq * 8;
            const bf16x8 k00 = *(const bf16x8*)(kp), k01 = *(const bf16x8*)(kp + 32), k10 = *(const bf16x8*)(kp + 256), k11 = *(const bf16x8*)(kp + 256 + 32);
            float pc[8];
#pragma unroll
            for (int j = 0; j < 8; ++j) pc[j] = 0.f;
#pragma unroll
            for (int g = 0; g < 3; ++g) {
                f32x4 s0 = (f32x4){0.f, 0.f, 0.f, 0.f}, s1 = s0;
                s0 = __builtin_amdgcn_mfma_f32_16x16x32_bf16(k00, qf[g][0], s0, 0, 0, 0); s0 = __builtin_amdgcn_mfma_f32_16x16x32_bf16(k01, qf[g][1], s0, 0, 0, 0);
                s1 = __builtin_amdgcn_mfma_f32_16x16x32_bf16(k10, qf[g][0], s1, 0, 0, 0); s1 = __builtin_amdgcn_mfma_f32_16x16x32_bf16(k11, qf[g][1], s1, 0, 0, 0);
#pragma unroll
                for (int j = 0; j < 8; ++j) {
                    const int dist = dq - 16 * j; const float raw = j < 4 ? s0[j] : s1[j - 4];
                    if (dist >= 0) pc[j] += __builtin_amdgcn_exp2f(raw * SCL2 - sl[g] * (float)dist - m[g]) * il[g];
                }
            }
            const float cout = 0.5f * pc[7];
            float cin = shfl_f(cout, lane - 16);
            const float cwrap = shfl_f(cout, fr + 48);
            if (fq == 0) cin = carry_prev;
            carry_prev = cwrap;
            const int n0 = (kc0 >> 2) + 2 * fq;
            ps[fr * 32 + n0] = cin + pc[0] + pc[1] + pc[2] + 0.5f * pc[3];
            ps[fr * 32 + n0 + 1] = 0.5f * pc[3] + pc[4] + pc[5] + pc[6] + 0.5f * pc[7];
        }
    }
    lds_wave_sync();
    if (lane < 16) {
        unsigned mask = 1u | (1u << cur); if (cur >= 1) mask |= 1u << (cur - 1);
        if (cur >= 3) {
            if (cur - 2 <= 5) mask |= (1u << (cur - 1)) - 2u;
            else {
                const float* my = ps + lane * 32;
                for (int r = 0; r < 5; ++r) {
                    float best = -1.0f; int bi = 1;
                    for (int j = 1; j <= cur - 2; ++j) { const float v = my[j]; if (!((mask >> j) & 1u) && v > best) { best = v; bi = j; } }
                    mask |= 1u << bi;
                }
            }
        }
        msk[lane] = mask;
    }
    lds_wave_sync();
    const unsigned qmask = msk[fr];
    lds_wave_sync();
    {
        const bf16_t* Kb = p.kF + ((size_t)b * NVH + 6 + kv) * 64 * SEQ;
        const bf16_t* VTb = p.vT + ((size_t)b * NVH + 6 + kv) * 64 * SEQ;
        attn_init<3>(o, m, l);
        unsigned um = qmask;
        um |= shfl_u(um, lane ^ 1); um |= shfl_u(um, lane ^ 2); um |= shfl_u(um, lane ^ 4); um |= shfl_u(um, lane ^ 8);
        um = (unsigned)__builtin_amdgcn_readfirstlane((int)um) & (cur >= 31 ? 0xffffffffu : ((2u << cur) - 1u));
        unsigned long long cm = 0ull;
        for (unsigned r = um; r; r &= r - 1) { const int kb = __builtin_ctz(r); cm |= 3ull << (2 * kb); }
        MaskIt it{cm};
        attn_run<true, true>(it, Kb, NMAIN, VTb, SEQ, fr, fq, [&](int kc0, const KVFrag& f) {
            const bool mine = (qmask >> (kc0 >> 6)) & 1u;
            const int dq = t - kc0 - 8 * fq;
            attn_compute<3, true>(f, qf, o, m, l, [&](int g, int j, float raw) { const int dist = dq - j; return (mine && dist >= 0) ? raw * SCL2 - sl[g] * (float)dist : MASKV; });
        });
#pragma unroll
        for (int g = 0; g < 3; ++g) {
            const float lt = lsum4(l[g]); const float sc = (lt > 0.f ? __builtin_amdgcn_rcpf(lt) : 0.f) * sigmoidf_fast(gl[g * 3 + 1]);
#pragma unroll
            for (int dt = 0; dt < 4; ++dt) otv[(g * 4 + dt) * 64] += o[g][dt] * sc;
        }
    }
    {
        const bf16_t* Kb = p.kF + ((size_t)b * NVH + 8 + kv) * 64 * SEQ;
        const bf16_t* VTb = p.vT + ((size_t)b * NVH + 8 + kv) * 64 * SEQ;
        attn_init<3>(o, m, l);
        RangeIt it{max(0, t0 - 511) >> 5, (t0 + 15) >> 5};
        attn_run<true, true>(it, Kb, NMAIN, VTb, SEQ, fr, fq, [&](int kc0, const KVFrag& f) {
            const int dq = t - kc0 - 8 * fq;
            attn_compute<3, true>(f, qf, o, m, l, [&](int g, int j, float raw) { const int dist = dq - j; return ((unsigned)dist < 512u) ? raw * SCL2 - sl[g] * (float)dist : MASKV; });
        });
#pragma unroll
        for (int g = 0; g < 3; ++g) {
            const float lt = lsum4(l[g]); const float sc = (lt > 0.f ? __builtin_amdgcn_rcpf(lt) : 0.f) * sigmoidf_fast(gl[g * 3 + 2]);
            unsigned char* dst = (unsigned char*)p.ob + ((size_t)b * SEQ + t) * DM + 640 + (kv * 3 + g) * 64 + 16 * fq;
            store_o16(dst, otv[(g * 4 + 0) * 64] + o[g][0] * sc, otv[(g * 4 + 1) * 64] + o[g][1] * sc, otv[(g * 4 + 2) * 64] + o[g][2] * sc, otv[(g * 4 + 3) * 64] + o[g][3] * sc);
        }
    }
}

template <bool WITH_CONV>
__device__ __forceinline__ void phase_attn(const Params& p, int l, char* lds, int cslot = 16) {
    int tid = threadIdx.x; asm volatile("" : "+v"(tid));
    const int wid = tid >> 6, lane = tid & 63, fr = lane & 15, fq = lane >> 4;
    float* ps = (float*)(lds + wid * 16896); unsigned* msk = (unsigned*)(ps + 512); float* otl = ps + 576;
    unsigned* ctr = p.ctrl + cslot + l;
    constexpr unsigned NU_NSA = NB * 2 * 128, NU_FOX = NB * 4 * 32, NU_SWA = NB * 2 * 128, NU_ATT = NU_NSA + NU_FOX + NU_SWA;
    for (;;) {
        unsigned u = 0;
        if (lane == 0) u = __hip_atomic_fetch_add(ctr, 1u, __ATOMIC_RELAXED, __HIP_MEMORY_SCOPE_AGENT);
        u = (unsigned)__builtin_amdgcn_readfirstlane((int)u);
        if (WITH_CONV) {
            constexpr unsigned CT = (unsigned)CONV_TILES / NL, TOTQ = NU_ATT + CT;
            if (u >= TOTQ) break;
            const unsigned a0 = (unsigned)(((unsigned long long)u * NU_ATT) / TOTQ), a1 = (unsigned)(((unsigned long long)(u + 1) * NU_ATT) / TOTQ);
            if (a1 == a0) { conv_tile_wave(p, (int)(l * CT + u - a0), lane, (unsigned char*)ps); continue; }
            u = a0;
        } else {
#ifndef ATT_REP
#define ATT_REP 1
#endif
            if (u >= ATT_REP * NU_ATT) break;
            if (ATT_REP > 1) u %= NU_ATT;
        }
        if (u < NU_NSA) { const int pos = 127 - (int)(u & 127), r = u >> 7; nsa_unit(p, r >> 1, r & 1, pos, fr, fq, lane, ps, msk, otl); }
        else if (u < NU_NSA + NU_FOX) { const unsigned v = u - NU_NSA; const int qb = 31 - (int)(v & 31), r = v >> 5; fox_unit(p, r >> 2, r & 3, qb, fr, fq); }
        else { const unsigned v = u - NU_NSA - NU_FOX; const int pos = 127 - (int)(v & 127), r = v >> 7; swa_unit(p, l, r >> 1, r & 1, pos, fr, fq); }
    }
}

__device__ __forceinline__ void phase_ln1_router(const Params& p, int l, char* lds) {
    int tid = threadIdx.x; asm volatile("" : "+v"(tid));
    const int wid = tid >> 6, lane = tid & 63, fr = lane & 15, fq = lane >> 4;
    float* lg = (float*)lds + wid * 512;
    int* lcnt = (int*)(lds + 16384); int* lbase = lcnt + 32;
    const float* g1 = p.ln1_g + l * DM; const float* b1 = p.ln1_b + l * DM;
    const float* rw = p.rwT + (size_t)l * NE * 1024; const float* rb = p.router_b + l * NE;
    unsigned* gcount = p.ctrl + 64 + l * NE;
    constexpr int RW_LDS = 20480, RW_PITCH = 2064;
    if (blockIdx.x < NTOK / 128) {
        const bf16_t* rwb = (const bf16_t*)p.rwT + (size_t)l * 64 * 1024;
#pragma unroll 4
        for (int i = 0; i < 16; ++i) { const int pc = wid * 16 + i, r = pc >> 1, q = pc & 1;
            __builtin_amdgcn_global_load_lds((const unsigned*)(rwb + (size_t)r * 1024 + q * 512 + lane * 8), (LAS unsigned*)((LAS char*)lds + RW_LDS + r * RW_PITCH + q * 1024), 16, 0, 0); }
    }
    for (int grp = blockIdx.x; grp < NTOK / 128; grp += gridDim.x) {
        const int tok0 = grp * 128 + wid * 16;
        if (tid < 32) lcnt[tid] = 0;
        float gg[16], bb[16];
#pragma unroll
        for (int j = 0; j < 4; ++j) { const float4 g4 = *(const float4*)(g1 + lane * 16 + j * 4), b4 = *(const float4*)(b1 + lane * 16 + j * 4);
            gg[4 * j] = g4.x; gg[4 * j + 1] = g4.y; gg[4 * j + 2] = g4.z; gg[4 * j + 3] = g4.w; bb[4 * j] = b4.x; bb[4 * j + 1] = b4.y; bb[4 * j + 2] = b4.z; bb[4 * j + 3] = b4.w; }
        u32x4 raw[4][2], xrw[4][2];
#pragma unroll
        for (int i = 0; i < 4; ++i) { const bf16_t* tr = (const bf16_t*)p.tbuf + (size_t)(tok0 + i) * DM + lane * 16; raw[i][0] = *(const u32x4*)tr; raw[i][1] = *(const u32x4*)(tr + 8);
            const bf16_t* xr_ = p.xb + (size_t)(tok0 + i) * DM + lane * 16; xrw[i][0] = *(const u32x4*)xr_; xrw[i][1] = *(const u32x4*)(xr_ + 8); }
#pragma unroll
        for (int r0 = 0; r0 < 16; r0 += 4) {
            float v[4][16]; float s[4], qv[4];
#pragma unroll
            for (int i = 0; i < 4; ++i) {
                const u32x4 t0 = raw[i][0], t1 = raw[i][1], x0 = xrw[i][0], x1 = xrw[i][1];
                const unsigned ts[8] = {t0.x, t0.y, t0.z, t0.w, t1.x, t1.y, t1.z, t1.w}, xs[8] = {x0.x, x0.y, x0.z, x0.w, x1.x, x1.y, x1.z, x1.w};
#pragma unroll
                for (int c = 0; c < 8; ++c) { v[i][2 * c] = __uint_as_float(xs[c] << 16) * ALPHA + __uint_as_float(ts[c] << 16); v[i][2 * c + 1] = __uint_as_float(xs[c] & 0xffff0000u) * ALPHA + __uint_as_float(ts[c] & 0xffff0000u); }
            }
            __builtin_amdgcn_sched_barrier(0);
            if (r0 < 12) {
#pragma unroll
                for (int i = 0; i < 4; ++i) { const bf16_t* tr = (const bf16_t*)p.tbuf + (size_t)(tok0 + r0 + 4 + i) * DM + lane * 16; raw[i][0] = *(const u32x4*)tr; raw[i][1] = *(const u32x4*)(tr + 8);
                    const bf16_t* xr_ = p.xb + (size_t)(tok0 + r0 + 4 + i) * DM + lane * 16; xrw[i][0] = *(const u32x4*)xr_; xrw[i][1] = *(const u32x4*)(xr_ + 8); }
            }
            __builtin_amdgcn_sched_barrier(0);
#pragma unroll
            for (int i = 0; i < 4; ++i) { s[i] = 0.f;
#pragma unroll
                for (int c = 0; c < 16; c += 4) s[i] += (v[i][c] + v[i][c + 1]) + (v[i][c + 2] + v[i][c + 3]); }
#pragma unroll
            for (int o = 32; o > 0; o >>= 1) {
#pragma unroll
                for (int i = 0; i < 4; ++i) s[i] += shfl_f(s[i], lane ^ o); }
#pragma unroll
            for (int i = 0; i < 4; ++i) { const float mean = s[i] * (1.0f / 1024.0f); qv[i] = 0.f;
#pragma unroll
                for (int c = 0; c < 16; c += 4) { v[i][c] -= mean; v[i][c + 1] -= mean; v[i][c + 2] -= mean; v[i][c + 3] -= mean;
                    qv[i] += (v[i][c] * v[i][c] + v[i][c + 1] * v[i][c + 1]) + (v[i][c + 2] * v[i][c + 2] + v[i][c + 3] * v[i][c + 3]); } }
#pragma unroll
            for (int o = 32; o > 0; o >>= 1) {
#pragma unroll
                for (int i = 0; i < 4; ++i) qv[i] += shfl_f(qv[i], lane ^ o); }
#pragma unroll
            for (int i = 0; i < 4; ++i) {
                const float rstd = rsqrtf(qv[i] * (1.0f / 1024.0f) + LN_EPS);
                const size_t row = (size_t)(tok0 + r0 + i);
                float y[16];
#pragma unroll
                for (int c = 0; c < 16; ++c) y[c] = v[i][c] * rstd * gg[c] + bb[c];
                u32x4 w0, w1, q;
                w0.x = pack2(y[0], y[1]); w0.y = pack2(y[2], y[3]); w0.z = pack2(y[4], y[5]); w0.w = pack2(y[6], y[7]);
                w1.x = pack2(y[8], y[9]); w1.y = pack2(y[10], y[11]); w1.z = pack2(y[12], y[13]); w1.w = pack2(y[14], y[15]);
                q.x = pack4_fp8(y[0], y[1], y[2], y[3]); q.y = pack4_fp8(y[4], y[5], y[6], y[7]); q.z = pack4_fp8(y[8], y[9], y[10], y[11]); q.w = pack4_fp8(y[12], y[13], y[14], y[15]);
                *(u32x4*)((bf16_t*)p.x1f + row * DM + lane * 16) = w0; *(u32x4*)((bf16_t*)p.x1f + row * DM + lane * 16 + 8) = w1;
                *(u32x4*)((char*)p.x1b + row * DM + lane * 16) = q;
            }
        }
        asm volatile("s_waitcnt vmcnt(0)" ::: "memory");
        __syncthreads();
        f32x4 a0 = (f32x4){0.f, 0.f, 0.f, 0.f}, a1 = a0;
        const bf16_t* xr = (const bf16_t*)p.x1f + (size_t)(tok0 + fr) * DM + 8 * fq;
        const LAS char* wl = (const LAS char*)lds + RW_LDS + fr * RW_PITCH + fq * 16;
#pragma unroll 8
        for (int ks = 0; ks < 32; ++ks) {
            const bf16x8 xa = *(const bf16x8*)(xr + ks * 32);
            a0 = __builtin_amdgcn_mfma_f32_16x16x32_bf16(xa, *(const LAS bf16x8*)(wl + ks * 64), a0, 0, 0, 0);
            a1 = __builtin_amdgcn_mfma_f32_16x16x32_bf16(xa, *(const LAS bf16x8*)(wl + 16 * RW_PITCH + ks * 64), a1, 0, 0, 0);
            a0 = __builtin_amdgcn_mfma_f32_16x16x32_bf16(xa, *(const LAS bf16x8*)(wl + 32 * RW_PITCH + ks * 64), a0, 0, 0, 0);
            a1 = __builtin_amdgcn_mfma_f32_16x16x32_bf16(xa, *(const LAS bf16x8*)(wl + 48 * RW_PITCH + ks * 64), a1, 0, 0, 0);
        }
#pragma unroll
        for (int r = 0; r < 4; ++r) { lg[(fq * 4 + r) * 32 + fr] = a0[r] + rb[fr]; lg[(fq * 4 + r) * 32 + 16 + fr] = a1[r] + rb[16 + fr]; }
        lds_wave_sync();
        int e4[4] = {0, 0, 0, 0}; int rk[4] = {0, 0, 0, 0};
        if (lane < 16) {
            const float* my = lg + lane * 32; unsigned taken = 0u; float tv[4];
#pragma unroll
            for (int k = 0; k < 4; ++k) {
                float best = NEG_INF; int bi = 0;
                for (int e = 0; e < 32; ++e) { const float xv = my[e]; if (!((taken >> e) & 1u) && xv > best) { best = xv; bi = e; } }
                taken |= 1u << bi; e4[k] = bi; tv[k] = best;
            }
            const float e1 = __expf(tv[1] - tv[0]), e2 = __expf(tv[2] - tv[0]), e3 = __expf(tv[3] - tv[0]);
            const float inv = 1.0f / (1.0f + e1 + e2 + e3);
            const size_t row = (size_t)(tok0 + lane);
            *(float4*)(p.gw + row * 4) = make_float4(inv, e1 * inv, e2 * inv, e3 * inv);
        }
        __syncthreads();
        if (lane < 16) {
#pragma unroll
            for (int k = 0; k < 4; ++k) rk[k] = atomicAdd(&lcnt[e4[k]], 1);
        }
        __syncthreads();
        if (tid < 32) { const int c = lcnt[tid]; lbase[tid] = c ? (int)__hip_atomic_fetch_add(gcount + tid, (unsigned)c, __ATOMIC_RELAXED, __HIP_MEMORY_SCOPE_AGENT) : 0; }
        __syncthreads();
        if (lane < 16) {
            const int row = tok0 + lane; int pk[4];
#pragma unroll
            for (int k = 0; k < 4; ++k) { const int pos = lbase[e4[k]] + rk[k]; p.lists[(size_t)e4[k] * LIST_CAP + pos] = row * 4 + k; pk[k] = (pos << 5) | e4[k]; }
            *(int4*)(p.top_e + (size_t)row * 4) = make_int4(pk[0], pk[1], pk[2], pk[3]);
        }
        __syncthreads();
    }
}

__device__ __forceinline__ void phase_ln2(const Params& p, int l, float* xout, char* lds) {
    int* ptile = (int*)(lds + LDS_TAB); int* ecnt = ptile + 40;
    int tid = threadIdx.x; asm volatile("" : "+v"(tid));
    const int wid = tid >> 6, lane = tid & 63;
    const float* g2 = p.ln2_g + l * DM; const float* b2 = p.ln2_b + l * DM;
    float gg[16], bb[16];
#pragma unroll
    for (int j = 0; j < 4; ++j) { const float4 g4 = *(const float4*)(g2 + lane * 16 + j * 4), b4 = *(const float4*)(b2 + lane * 16 + j * 4);
        gg[4 * j] = g4.x; gg[4 * j + 1] = g4.y; gg[4 * j + 2] = g4.z; gg[4 * j + 3] = g4.w; bb[4 * j] = b4.x; bb[4 * j + 1] = b4.y; bb[4 * j + 2] = b4.z; bb[4 * j + 3] = b4.w; }
    const int pstep = gridDim.x * NWV;
    int pr = blockIdx.x * NWV + wid;
    float4 gwn[2]; int4 ten[2];
    u32x4 yn[2][4], xn[2][2];
    float gk[2][4];
    auto load_meta = [&](int q) {
#pragma unroll
        for (int i = 0; i < 2; ++i) { const int row = q * 2 + i; gwn[i] = *(const float4*)(p.gw + (size_t)row * 4); ten[i] = *(const int4*)(p.top_e + (size_t)row * 4); }
    };
    auto load_rows = [&](int q) {
#pragma unroll
        for (int i = 0; i < 2; ++i) {
            const int row = q * 2 + i;
            const int tk[4] = {ten[i].x, ten[i].y, ten[i].z, ten[i].w};
            xn[i][0] = *(const u32x4*)((const bf16_t*)p.x1f + (size_t)row * DM + lane * 16); xn[i][1] = *(const u32x4*)((const bf16_t*)p.x1f + (size_t)row * DM + lane * 16 + 8);
#pragma unroll
            for (int k = 0; k < 4; ++k) yn[i][k] = *(const u32x4*)((const unsigned char*)p.ybuf + (size_t)(ptile[tk[k] & 31] * 256 + (tk[k] >> 5)) * DM + lane * 16);
        }
    };
    if (pr < NTOK / 2) { load_meta(pr); load_rows(pr); }
#pragma unroll
    for (int i = 0; i < 2; ++i) { gk[i][0] = gwn[i].x; gk[i][1] = gwn[i].y; gk[i][2] = gwn[i].z; gk[i][3] = gwn[i].w; }
    if (pr + pstep < NTOK / 2) load_meta(pr + pstep);
    for (; pr < NTOK / 2; pr += pstep) {
        float v[2][16]; float s[2], qv[2];
#pragma unroll
        for (int i = 0; i < 2; ++i) { s[i] = 0.f;
            const unsigned xs[8] = {xn[i][0].x, xn[i][0].y, xn[i][0].z, xn[i][0].w, xn[i][1].x, xn[i][1].y, xn[i][1].z, xn[i][1].w};
#pragma unroll
            for (int c = 0; c < 8; ++c) { v[i][2 * c] = __uint_as_float(xs[c] << 16) * ALPHA; v[i][2 * c + 1] = __uint_as_float(xs[c] & 0xffff0000u) * ALPHA; }
#pragma unroll
            for (int k = 0; k < 4; ++k) {
                const unsigned ys[4] = {yn[i][k].x, yn[i][k].y, yn[i][k].z, yn[i][k].w};
#pragma unroll
                for (int c = 0; c < 4; ++c) {
                    const f32x2_t lo = __builtin_amdgcn_cvt_pk_f32_fp8(ys[c], false), hi = __builtin_amdgcn_cvt_pk_f32_fp8(ys[c], true);
                    v[i][4 * c] += gk[i][k] * lo.x; v[i][4 * c + 1] += gk[i][k] * lo.y; v[i][4 * c + 2] += gk[i][k] * hi.x; v[i][4 * c + 3] += gk[i][k] * hi.y;
                }
            }
#pragma unroll
            for (int c = 0; c < 16; c += 4) s[i] += (v[i][c] + v[i][c + 1]) + (v[i][c + 2] + v[i][c + 3]);
        }
        __builtin_amdgcn_sched_barrier(0);
        if (pr + pstep < NTOK / 2) {
#pragma unroll
            for (int i = 0; i < 2; ++i) { gk[i][0] = gwn[i].x; gk[i][1] = gwn[i].y; gk[i][2] = gwn[i].z; gk[i][3] = gwn[i].w; }
            load_rows(pr + pstep);
            if (pr + 2 * pstep < NTOK / 2) load_meta(pr + 2 * pstep);
        }
        __builtin_amdgcn_sched_barrier(0);
#pragma unroll
        for (int o = 32; o > 0; o >>= 1) { s[0] += shfl_f(s[0], lane ^ o); s[1] += shfl_f(s[1], lane ^ o); }
#pragma unroll
        for (int i = 0; i < 2; ++i) { const float mean = s[i] * (1.0f / 1024.0f); qv[i] = 0.f;
#pragma unroll
            for (int c = 0; c < 16; c += 4) { v[i][c] -= mean; v[i][c + 1] -= mean; v[i][c + 2] -= mean; v[i][c + 3] -= mean;
                qv[i] += (v[i][c] * v[i][c] + v[i][c + 1] * v[i][c + 1]) + (v[i][c + 2] * v[i][c + 2] + v[i][c + 3] * v[i][c + 3]); } }
#pragma unroll
        for (int o = 32; o > 0; o >>= 1) { qv[0] += shfl_f(qv[0], lane ^ o); qv[1] += shfl_f(qv[1], lane ^ o); }
#pragma unroll
        for (int i = 0; i < 2; ++i) {
            const float rstd = rsqrtf(qv[i] * (1.0f / 1024.0f) + LN_EPS);
            const size_t row = (size_t)(pr * 2 + i);
            float y[16];
#pragma unroll
            for (int c = 0; c < 16; ++c) y[c] = v[i][c] * rstd * gg[c] + bb[c];
            if (l + 1 < NL) {
                u32x4 w0, w1, q;
                w0.x = pack2(y[0], y[1]); w0.y = pack2(y[2], y[3]); w0.z = pack2(y[4], y[5]); w0.w = pack2(y[6], y[7]);
                w1.x = pack2(y[8], y[9]); w1.y = pack2(y[10], y[11]); w1.z = pack2(y[12], y[13]); w1.w = pack2(y[14], y[15]);
                q.x = pack4_fp8(y[0], y[1], y[2], y[3]); q.y = pack4_fp8(y[4], y[5], y[6], y[7]); q.z = pack4_fp8(y[8], y[9], y[10], y[11]); q.w = pack4_fp8(y[12], y[13], y[14], y[15]);
                *(u32x4*)(p.xb + row * DM + lane * 16) = w0; *(u32x4*)(p.xb + row * DM + lane * 16 + 8) = w1;
                *(u32x4*)(p.xq + row * DM + lane * 16) = q;
            } else {
#pragma unroll
                for (int c = 0; c < 16; c += 4) *(float4*)(xout + row * DM + lane * 16 + c) = make_float4(y[c], y[c + 1], y[c + 2], y[c + 3]);
            }
        }
    }
}

#define XB_TMO      128
#define XB_XCNT(j)  (256  + 64 * (j))
#define XB_XSUB(j)  (1280 + 64 * (j))
#define XB_XGEN(j)  (2304 + 64 * (j))
#define XB_TOP      3328
#define XB_TOPGEN   3392
#define XCD_BAR_WORDS 3456
#define XB_SPIN_CAP (1u << 22)
__device__ __forceinline__ unsigned xb_ld(unsigned* p)              { return __hip_atomic_load(p, __ATOMIC_RELAXED, __HIP_MEMORY_SCOPE_AGENT); }
__device__ __forceinline__ unsigned xb_add(unsigned* p, unsigned v) { return __hip_atomic_fetch_add(p, v, __ATOMIC_RELAXED, __HIP_MEMORY_SCOPE_AGENT); }
__device__ __forceinline__ unsigned xb_xcc_id() { return (unsigned)__builtin_amdgcn_s_getreg((3 << 11) | 20) & 0xFu; }
#define XB_SPIN(cond, bar) do { unsigned _sp = 0; while (cond) { __builtin_amdgcn_s_sleep(1); \
    if ((++_sp & 255u) == 0u) { if (xb_ld(&(bar)[XB_TMO])) break; if (_sp > XB_SPIN_CAP) { atomicAdd(&(bar)[XB_TMO], 1u); break; } } } } while (0)
struct XcdBarrier { unsigned* bar; unsigned x; volatile LAS unsigned* st; };
__device__ __forceinline__ XcdBarrier xcd_barrier_post(unsigned* bar, volatile LAS unsigned* st) {
    XcdBarrier b; b.bar = bar; b.x = xb_xcc_id(); b.st = st;
    if (threadIdx.x == 0) (void)xb_add(&bar[XB_XCNT(b.x)], 1u);
    return b;
}
__device__ __forceinline__ void xcd_barrier_complete(unsigned* bar, unsigned x, unsigned& nloc, unsigned& nx) {
    const unsigned G = gridDim.x * gridDim.y * gridDim.z;
    unsigned sum, cnt, mine, sp = 0u;
    for (;;) {
        sum = 0u; cnt = 0u; mine = 0u;
#pragma unroll
        for (unsigned j = 0; j < 16; ++j) { const unsigned c = xb_ld(&bar[XB_XCNT(j)]); sum += c; cnt += (c > 0u) ? 1u : 0u; mine = (j == x) ? c : mine; }
        if (sum == G) break;
        __builtin_amdgcn_s_sleep(1);
        if ((++sp & 255u) == 0u) { if (xb_ld(&bar[XB_TMO])) break; if (sp > XB_SPIN_CAP) { atomicAdd(&bar[XB_TMO], 1u); break; } }
    }
    nloc = mine > 0u ? mine : 1u; nx = cnt > 0u ? cnt : 1u;
}
__device__ __forceinline__ void xcd_barrier(const XcdBarrier& b) {
    asm volatile("s_waitcnt vmcnt(0)" ::: "memory");
    __syncthreads();
    if (threadIdx.x == 0) {
        unsigned* bar = b.bar;
        __builtin_amdgcn_s_waitcnt(0);
        unsigned nloc = b.st[0], nx = b.st[1];
        if (nloc == 0u) { xcd_barrier_complete(bar, b.x, nloc, nx); b.st[0] = nloc; b.st[1] = nx; }
        const unsigned old = xb_add(&bar[XB_XSUB(b.x)], 1u);
        const unsigned gen = old / nloc;
        if (old + 1u == (gen + 1u) * nloc) {
            __builtin_amdgcn_fence(__ATOMIC_RELEASE, "agent");
            asm volatile("s_waitcnt vmcnt(0)" ::: "memory");
            const unsigned og = xb_add(&bar[XB_TOP], 1u);
            const unsigned tg = og / nx;
            if (og + 1u == (tg + 1u) * nx) xb_add(&bar[XB_TOPGEN], 1u);
            else XB_SPIN(xb_ld(&bar[XB_TOPGEN]) == tg, bar);
            __builtin_amdgcn_fence(__ATOMIC_ACQUIRE, "agent");
            xb_add(&bar[XB_XGEN(b.x)], 1u);
            asm volatile("s_waitcnt vmcnt(0)" ::: "memory");
        } else {
            XB_SPIN(xb_ld(&bar[XB_XGEN(b.x)]) == gen, bar);
            __builtin_amdgcn_fence(__ATOMIC_ACQUIRE, "agent");
            asm volatile("s_waitcnt vmcnt(0)" ::: "memory");
        }
    }
    __syncthreads();
}

struct KArgs { const float* in[18]; float* out; char* ws; };
constexpr size_t al256(size_t v) { return (v + 255) / 256 * 256; }
struct WSL {
    static constexpr size_t ctrl = 0;
    static constexpr size_t WinT = al256(ctrl + 65536);
    static constexpr size_t WoT = al256(WinT + (size_t)NL * NPAD * 1024 * 2);
    static constexpr size_t W1T = al256(WoT + (size_t)NL * 1024 * 1024 * 2);
    static constexpr size_t W2T = al256(W1T + (size_t)NL * 2 * 64 * 2048 * 2);
    static constexpr size_t WguT = al256(W2T + (size_t)NL * 2 * 64 * 64 * 2);
    static constexpr size_t WdnT = al256(WguT + (size_t)NL * NE * 2048 * 1024 * 2);
    static constexpr size_t rwT = al256(WdnT + (size_t)NL * NE * 1024 * 1024 * 2);
    static constexpr size_t binp = al256(rwT + (size_t)NL * NE * 1024 * 4);
    static constexpr size_t bgup = al256(binp + (size_t)NL * NPAD * 4);
    static constexpr size_t b1c = al256(bgup + (size_t)NL * NE * 2048 * 4);
    static constexpr size_t xf = al256(b1c + 4 * 8 * 64 * 4);
    static constexpr size_t xb = al256(xf + (size_t)NTOK * DM * 4);
    static constexpr size_t hb = al256(xb + (size_t)NTOK * DM * 2);
    static constexpr size_t hs = al256(hb + (size_t)NTOK * NMAIN * 2);
    static constexpr size_t vT = al256(hs + (size_t)NTOK * HS_W * 4);
    static constexpr size_t kF = al256(vT + (size_t)NB * NVH * 64 * SEQ * 2);
    static constexpr size_t cF = al256(kF + (size_t)NB * NVH * 64 * SEQ * 2);
    static constexpr size_t kc = al256(cF + (size_t)NB * 4 * SEQ * 4);
    static constexpr size_t vc = al256(kc + (size_t)NB * 2 * 128 * 64 * 2);
    static constexpr size_t vcT = al256(vc + (size_t)NB * 2 * 128 * 64 * 2);
    static constexpr size_t ob = al256(vcT + (size_t)NB * 2 * 128 * 64 * 2);
    static constexpr size_t tbuf = al256(ob + (size_t)NTOK * DM * 2);
    static constexpr size_t x1f = al256(tbuf + (size_t)NTOK * DM * 4);
    static constexpr size_t x1b = al256(x1f + (size_t)NTOK * DM * 4);
    static constexpr size_t top_e = al256(x1b + (size_t)NTOK * DM * 2);
    static constexpr size_t gw = al256(top_e + (size_t)NTOK * 4 * 4);
    static constexpr size_t lists = al256(gw + (size_t)NTOK * 4 * 4);
    static constexpr size_t act = al256(lists + (size_t)NE * LIST_CAP * 4);
    static constexpr size_t ybuf = al256(act + (size_t)MAXSLOT * DFF * 2);
    static constexpr size_t xq = al256(ybuf + (size_t)MAXSLOT * DM * 2);
    static constexpr size_t WinQ = al256(xq + (size_t)NTOK * DM);
    static constexpr size_t total = al256(WinQ + (size_t)NL * NMAIN * 1024);
};
__device__ __forceinline__ Params make_params(const KArgs& k) {
    Params p;
    p.x = k.in[0]; p.w_in = k.in[1]; p.b_in = k.in[2]; p.sinks = k.in[3]; p.cmp_pe = k.in[4]; p.cmp_w1 = k.in[5]; p.cmp_w2 = k.in[6]; p.w_out = k.in[7];
    p.ln1_g = k.in[8]; p.ln1_b = k.in[9]; p.router_w = k.in[10]; p.router_b = k.in[11]; p.w_gu = k.in[12]; p.b_gu = k.in[13]; p.w_dn = k.in[14]; p.b_dn = k.in[15];
    p.ln2_g = k.in[16]; p.ln2_b = k.in[17]; p.out = k.out;
    char* w = k.ws;
    p.ctrl = (unsigned*)(w + WSL::ctrl); p.WinT = (bf16_t*)(w + WSL::WinT); p.WoT = (bf16_t*)(w + WSL::WoT); p.W1T = (bf16_t*)(w + WSL::W1T); p.W2T = (bf16_t*)(w + WSL::W2T);
    p.WguT = (bf16_t*)(w + WSL::WguT); p.WdnT = (bf16_t*)(w + WSL::WdnT); p.rwT = (float*)(w + WSL::rwT); p.binp = (float*)(w + WSL::binp); p.bgup = (float*)(w + WSL::bgup);
    p.b1c = (float*)(w + WSL::b1c); p.xf = (float*)(w + WSL::xf); p.xb = (bf16_t*)(w + WSL::xb); p.hb = (bf16_t*)(w + WSL::hb); p.hs = (float*)(w + WSL::hs); p.vT = (bf16_t*)(w + WSL::vT); p.kF = (bf16_t*)(w + WSL::kF);
    p.cF = (float*)(w + WSL::cF); p.kc = (bf16_t*)(w + WSL::kc); p.vc = (bf16_t*)(w + WSL::vc); p.vcT = (bf16_t*)(w + WSL::vcT); p.ob = (bf16_t*)(w + WSL::ob); p.tbuf = (float*)(w + WSL::tbuf);
    p.x1f = (float*)(w + WSL::x1f); p.x1b = (bf16_t*)(w + WSL::x1b); p.top_e = (int*)(w + WSL::top_e); p.gw = (float*)(w + WSL::gw); p.lists = (int*)(w + WSL::lists);
    p.act = (bf16_t*)(w + WSL::act); p.ybuf = (bf16_t*)(w + WSL::ybuf); p.xq = (unsigned char*)(w + WSL::xq); p.WinQ = (unsigned char*)(w + WSL::WinQ);
    return p;
}
__device__ __forceinline__ void grid_bar(const Params& p, char* lds) {
    XcdBarrier xb; xb.bar = p.ctrl + 1024; xb.x = xb_xcc_id(); xb.st = (volatile LAS unsigned*)(lds + LDS_BYTES - 16); xcd_barrier(xb);
}
__device__ __forceinline__ Params fresh_params(const KArgs& ka) {
    KArgs k2 = ka; size_t z = 0; asm volatile("" : "+s"(z));
    k2.ws = ka.ws + z;
    return make_params(k2);
}
#ifndef REP
#define REP 0
#endif
template <int L>
__device__ __forceinline__ void layer_fwd(const KArgs& ka, char* lds) {
    { const Params p = fresh_params(ka); phase_inproj(p, L, lds);        grid_bar(p, lds); }
    { const Params p = fresh_params(ka); phase_prep(p, L, lds);          grid_bar(p, lds); }
    { const Params p = fresh_params(ka); phase_attn<true>(p, L, lds);  grid_bar(p, lds); }
    { const Params p = fresh_params(ka); phase_outproj(p, L, p.xb, lds);  grid_bar(p, lds); }
    { const Params p = fresh_params(ka); phase_ln1_router(p, L, lds);    grid_bar(p, lds); }
    { const Params p = fresh_params(ka); phase_gateup(p, L, lds);        grid_bar(p, lds); }
    { const Params p = fresh_params(ka); phase_down(p, L, lds);          grid_bar(p, lds); }
    { const Params p = fresh_params(ka); phase_ln2(p, L, L == NL - 1 ? p.out : p.xf, lds); }
}
__global__ void __launch_bounds__(NTHR, 2) fwd_kernel(KArgs ka) {
    extern __shared__ __attribute__((aligned(16))) char lds[];
    const Params p = make_params(ka);
    cg::grid_group grid = cg::this_grid();
    volatile LAS unsigned* xst = (volatile LAS unsigned*)(lds + LDS_BYTES - 16);
    if (threadIdx.x == 0) { xst[0] = 0u; xst[1] = 0u; }
    __syncthreads();
    (void)xcd_barrier_post(p.ctrl + 1024, xst);
    volatile LAS int* vcu = (volatile LAS int*)(lds + LDS_BYTES - 32);
    const unsigned myx = xb_xcc_id() & 7u;
    if (threadIdx.x == 0) vcu[1] = (int)__hip_atomic_fetch_add(p.ctrl + 32 + myx, 1u, __ATOMIC_RELAXED, __HIP_MEMORY_SCOPE_AGENT);
    phase0(p, lds);
    grid.sync();
    if (threadIdx.x == 0) {
        int base = 0, tot = 0;
        for (unsigned x = 0; x < 8; ++x) { const int n = (int)__hip_atomic_load(p.ctrl + 32 + x, __ATOMIC_RELAXED, __HIP_MEMORY_SCOPE_AGENT); if (x < myx) base += n; tot += n; }
        vcu[0] = (tot == (int)gridDim.x) ? base + vcu[1] : (int)blockIdx.x;
    }
    __syncthreads();
    layer_fwd<0>(ka, lds);
    grid_bar(p, lds);
    layer_fwd<1>(ka, lds);
}

extern "C" void kernel_launch(void* const* d_in, const int* in_sizes, int n_in, void* d_out, int out_size, void* d_ws, size_t ws_size, hipStream_t stream) {
    KArgs ka{};
    for (int i = 0; i < 18; ++i) ka.in[i] = (const float*)d_in[i];
    ka.out = (float*)d_out; ka.ws = (char*)d_ws;
    if (WSL::total > ws_size) { fprintf(stderr, "workspace too small: need %zu have %zu\n", (size_t)WSL::total, ws_size); return; }
    static int grid_blocks = 0;
    if (!grid_blocks) {
        int dev = 0, cus = 0, per_cu = 0;
        (void)hipGetDevice(&dev);
        (void)hipDeviceGetAttribute(&cus, hipDeviceAttributeMultiprocessorCount, dev);
        (void)hipFuncSetAttribute((const void*)fwd_kernel, hipFuncAttributeMaxDynamicSharedMemorySize, LDS_BYTES);
        (void)hipOccupancyMaxActiveBlocksPerMultiprocessor(&per_cu, fwd_kernel, NTHR, LDS_BYTES);
        if (per_cu < 1) { fprintf(stderr, "occupancy query says 0 blocks per CU\n"); per_cu = 1; }
        grid_blocks = cus;
    }
    (void)hipMemsetAsync(d_ws, 0, 65536, stream);
    void* args[] = {&ka};
    hipError_t e = hipLaunchCooperativeKernel((const void*)fwd_kernel, dim3(grid_blocks), dim3(NTHR), args, LDS_BYTES, stream);
    if (e != hipSuccess) fprintf(stderr, "cooperative launch failed: %s (grid %d)\n", hipGetErrorString(e), grid_blocks);
}
```

```cpp
#include <hip/hip_runtime.h>
#include <hip/hip_cooperative_groups.h>
#include <cstdio>
#include <cstdint>
namespace cg = cooperative_groups;

typedef unsigned short bf16_t;
typedef short bf16x8 __attribute__((ext_vector_type(8)));
typedef float f32x4 __attribute__((ext_vector_type(4)));
typedef unsigned u32x4 __attribute__((ext_vector_type(4)));
typedef unsigned u32x2 __attribute__((ext_vector_type(2)));
typedef int v8i_t __attribute__((ext_vector_type(8)));
typedef float f32x2_t __attribute__((ext_vector_type(2)));
typedef int v4i_t __attribute__((ext_vector_type(4)));
#define LAS __attribute__((address_space(3)))
constexpr float NEG_INF = -__builtin_huge_valf();

constexpr int DM = 1024, NB = 16, SEQ = 2048, NTOK = NB * SEQ, NL = 2;
constexpr int NCOL = 2582, NMAIN = 2560, NPAD = 2688, NE = 32, DFF = 1024;
constexpr int C_FQ = 0, C_FK = 256, C_FV = 512, C_SQ = 768, C_SK = 1152, C_SV = 1280, C_NQ = 1408,
              C_NKC = 1792, C_NVC = 1920, C_NKS = 2048, C_NVS = 2176, C_NKW = 2304, C_NVW = 2432;
constexpr int HS_W = 32;
constexpr int NVH = 10;
constexpr int LIST_CAP = NTOK;
constexpr int MAXSLOT = NTOK * 4 + NE * 256;
constexpr float ALPHA = 1.41421356237f, LN_EPS = 1e-5f, QSCALE = 0.125f;
constexpr float GATE_PRE = -2.455466929f;
constexpr int NWV = 8, NTHR = NWV * 64;
constexpr int LDS_STAGE = 131072, LDS_TAB = LDS_STAGE, LDS_AOFF = LDS_STAGE + 2048, LDS_BIAS = LDS_AOFF + 20480, LDS_BYTES = LDS_BIAS + 3072 + 256;

struct Params {
    const float *x, *w_in, *b_in, *sinks, *cmp_pe, *cmp_w1, *cmp_w2, *w_out, *ln1_g, *ln1_b, *router_w, *router_b,
                *w_gu, *b_gu, *w_dn, *b_dn, *ln2_g, *ln2_b;
    float* out;
    unsigned* ctrl;
    bf16_t *WinT, *WoT, *W1T, *W2T, *WguT, *WdnT;
    float *rwT, *binp, *bgup, *b1c;
    unsigned char* xq; unsigned char* WinQ;
    float* xf; bf16_t* xb; bf16_t* hb; float* hs; bf16_t* vT; bf16_t* kF; float* cF;
    bf16_t *kc, *vc, *vcT; bf16_t* ob; float* tbuf; float* x1f; bf16_t* x1b;
    int* top_e; float* gw; int* lists; bf16_t* act; bf16_t* ybuf;
};

__device__ __forceinline__ float bf2f(bf16_t h) { return __uint_as_float(((unsigned)h) << 16); }
typedef __bf16 bf16x2_t __attribute__((ext_vector_type(2)));
__device__ __forceinline__ bf16_t f2bf(float f) { return __builtin_bit_cast(bf16_t, (__bf16)f); }
__device__ __forceinline__ unsigned pack2(float lo, float hi) { bf16x2_t v = {(__bf16)lo, (__bf16)hi}; return __builtin_bit_cast(unsigned, v); }
__device__ __forceinline__ unsigned pack4_fp8(float a, float b, float c, float d) {
    unsigned w = 0u;
    w = __builtin_amdgcn_cvt_pk_fp8_f32(a, b, w, false);
    w = __builtin_amdgcn_cvt_pk_fp8_f32(c, d, w, true);
    return w;
}
__device__ __forceinline__ float shfl_f(float v, int src_lane) { return __int_as_float(__builtin_amdgcn_ds_bpermute(src_lane << 2, __float_as_int(v))); }
__device__ __forceinline__ unsigned shfl_u(unsigned v, int src_lane) { return (unsigned)__builtin_amdgcn_ds_bpermute(src_lane << 2, (int)v); }
__device__ __forceinline__ float wave_sum(float v) {
#pragma unroll
    for (int o = 32; o > 0; o >>= 1) v += __shfl_xor(v, o);
    return v;
}
__device__ __forceinline__ float wave_max(float v) {
#pragma unroll
    for (int o = 32; o > 0; o >>= 1) v = fmaxf(v, __shfl_xor(v, o));
    return v;
}
__device__ __forceinline__ void lds_wave_sync() { asm volatile("s_waitcnt lgkmcnt(0)" ::: "memory"); __builtin_amdgcn_wave_barrier(); }
__device__ __forceinline__ float slope_swa(int hq) { return exp2f(-8.0f * (float)(2 * hq + 1) / 12.0f); }
__device__ __forceinline__ float slope_nsa(int hq) { return exp2f(-8.0f * (float)(2 * hq + 2) / 12.0f); }

__device__ __forceinline__ int fwd128(int L) { return (L & ~31) | (((L >> 2) & 1) << 4) | (((L >> 3) & 3) << 2) | (L & 3); }
__device__ __forceinline__ int inv128(int p) { return (p & ~31) | (((p >> 2) & 3) << 3) | (((p >> 4) & 1) << 2) | (p & 3); }
__device__ __forceinline__ int fwd256(int L) { return (L & ~255) | (((L >> 3) & 1) << 7) | (((L >> 6) & 3) << 5) | (((L >> 2) & 1) << 4) | (((L >> 4) & 3) << 2) | (L & 3); }
__device__ __forceinline__ int perm_row(int perm, int n) {
    if (perm == 1) { int r; if (n < 768) r = n; else if (n < 772) r = 2560 + (n - 768); else if (n < 2564) r = n - 4; else r = n; return r < 2560 ? fwd128(r) : r; }
    if (perm == 2) { const int f = n >> 1, s = n & 1; return (f >> 7) * 256 + s * 128 + fwd128(f & 127); }
    if (perm == 3) return fwd256(n);
    return n;
}
struct ConvJob { const float* src; bf16_t* dst; int K, N, kt, nt, perm; float q8; };
__device__ __forceinline__ bool conv_job(const Params& p, int t, ConvJob& jb) {
    constexpr int T_WIN = NL * 8 * 21, T_WO = NL * 8 * 8, T_WINB = NL * 8 * 2;
    if (t < T_WINB) { const int m = t / 16, r = t % 16; jb = ConvJob{p.w_in + (size_t)m * 1024 * NCOL, p.WinT + (size_t)m * NPAD * 1024, 1024, NCOL, r >> 1, (r & 1) ? 20 : 6, 1, 0.f}; return true; }
    t -= T_WINB;
    if (t < T_WO) { const int m = t / 64, r = t % 64; jb = ConvJob{p.w_out + (size_t)m * 1024 * 1024, (bf16_t*)((char*)p.WoT + (size_t)m * 1024 * 1024), 1024, 1024, r / 8, r % 8, 3, 64.0f}; return true; }
    t -= T_WO;
    if (t < T_WIN) { const int m = t / 168, r = t % 168; jb = ConvJob{p.w_in + (size_t)m * 1024 * NCOL, (bf16_t*)(p.WinQ + (size_t)m * NMAIN * 1024), 1024, NCOL, r / 21, r % 21, 1, 64.0f}; return true; }
    return false;
}
constexpr int CONV_TILES = NL * NE * 192;
__device__ __forceinline__ void conv_tile_wave(const Params& p, int t, int lane, unsigned char* l8) {
    asm volatile("" : "+v"(lane));
    const int m = t / 192, r = t % 192;
    const float* src; unsigned char* dst; int N, kt, nt, perm;
    if (r < 128) { src = p.w_gu + (size_t)m * 1024 * 2048; dst = (unsigned char*)p.WguT + (size_t)m * 2048 * 1024; N = 2048; kt = r >> 4; nt = r & 15; perm = 2; }
    else { const int q = r - 128; src = p.w_dn + (size_t)m * 1024 * 1024; dst = (unsigned char*)p.WdnT + (size_t)m * 1024 * 1024; N = 1024; kt = q >> 3; nt = q & 7; perm = 3; }
    const float* s = src + (size_t)(kt * 128 + (lane >> 5)) * N + nt * 128 + (lane & 31) * 4;
    unsigned char* lw = l8 + (lane >> 5) * 132 + (lane & 31) * 4;
    const float sg = (perm == 2) ? 64.0f * GATE_PRE : 64.0f;
    float4 va[16], vb[16];
#pragma unroll
    for (int i = 0; i < 16; ++i) va[i] = *(const float4*)(s + (size_t)(2 * i) * N);
#pragma unroll
    for (int i = 0; i < 16; ++i) vb[i] = *(const float4*)(s + (size_t)(32 + 2 * i) * N);
#pragma unroll
    for (int i = 0; i < 16; ++i) *(unsigned*)(lw + (2 * i) * 132) = pack4_fp8(va[i].x * sg, va[i].y * 64.0f, va[i].z * sg, va[i].w * 64.0f);
#pragma unroll
    for (int i = 0; i < 16; ++i) va[i] = *(const float4*)(s + (size_t)(64 + 2 * i) * N);
#pragma unroll
    for (int i = 0; i < 16; ++i) *(unsigned*)(lw + (32 + 2 * i) * 132) = pack4_fp8(vb[i].x * sg, vb[i].y * 64.0f, vb[i].z * sg, vb[i].w * 64.0f);
#pragma unroll
    for (int i = 0; i < 16; ++i) vb[i] = *(const float4*)(s + (size_t)(96 + 2 * i) * N);
#pragma unroll
    for (int i = 0; i < 16; ++i) *(unsigned*)(lw + (64 + 2 * i) * 132) = pack4_fp8(va[i].x * sg, va[i].y * 64.0f, va[i].z * sg, va[i].w * 64.0f);
#pragma unroll
    for (int i = 0; i < 16; ++i) *(unsigned*)(lw + (96 + 2 * i) * 132) = pack4_fp8(vb[i].x * sg, vb[i].y * 64.0f, vb[i].z * sg, vb[i].w * 64.0f);
    lds_wave_sync();
#pragma unroll 4
    for (int i = 0; i < 16; ++i) {
        const int idx = lane + 64 * i, kc = idx & 7, nn = idx >> 3;
        const unsigned char* l = l8 + (kc * 16) * 132 + nn;
        u32x4 w;
        w.x = (unsigned)l[0] | ((unsigned)l[132] << 8) | ((unsigned)l[264] << 16) | ((unsigned)l[396] << 24);
        w.y = (unsigned)l[528] | ((unsigned)l[660] << 8) | ((unsigned)l[792] << 16) | ((unsigned)l[924] << 24);
        w.z = (unsigned)l[1056] | ((unsigned)l[1188] << 8) | ((unsigned)l[1320] << 16) | ((unsigned)l[1452] << 24);
        w.w = (unsigned)l[1584] | ((unsigned)l[1716] << 8) | ((unsigned)l[1848] << 16) | ((unsigned)l[1980] << 24);
        *(u32x4*)(dst + (size_t)perm_row(perm, nt * 128 + nn) * 1024 + kt * 128 + kc * 16) = w;
    }
    lds_wave_sync();
}
__device__ __forceinline__ void conv_load(const ConvJob& jb, int tid, float2 (&v)[16]) {
    const int n = jb.nt * 128 + (tid & 31) * 4;
    const float* s = jb.src + (size_t)(jb.kt * 128 + (tid >> 5)) * jb.N + n;
#pragma unroll
    for (int i = 0; i < 8; ++i) {
        const float* r = s + (size_t)(16 * i) * jb.N;
        v[2 * i] = (n + 1 < jb.N) ? *(const float2*)r : make_float2(0.f, 0.f);
        v[2 * i + 1] = (n + 3 < jb.N) ? *(const float2*)(r + 2) : make_float2(0.f, 0.f);
    }
}
__device__ __forceinline__ void phase0(const Params& p, char* ldsc) {
    int tid = threadIdx.x; asm volatile("" : "+v"(tid));
    const int G = gridDim.x, bid = blockIdx.x;
    const size_t gtid = (size_t)bid * NTHR + tid, gthreads = (size_t)G * NTHR;
    {
        constexpr int TOT = NL * 8 * 2 + NL * 8 * 21 + NL * 8 * 8;
        bf16_t* lt = (bf16_t*)ldsc;
        ConvJob jb, jn; float2 v[16], vn[16];
        int t = bid; bool have = t < TOT && conv_job(p, t, jb);
        if (have) conv_load(jb, tid, v);
        while (have) {
            const int tn = t + G; const bool hn = tn < TOT && conv_job(p, tn, jn);
            if (hn) conv_load(jn, tid, vn);
            if (jb.q8 != 0.f) {
                unsigned char* l8 = (unsigned char*)lt;
#pragma unroll
                for (int i = 0; i < 8; ++i)
                {   int kl = (tid >> 5) + 16 * i;
                    if (jb.perm == 3) kl = (kl & 64) | (((kl >> 2) & 3) << 4) | (((kl >> 4) & 3) << 2) | (kl & 3);
                    *(unsigned*)(l8 + kl * 132 + (tid & 31) * 4) = pack4_fp8(v[2 * i].x * jb.q8, v[2 * i].y * jb.q8, v[2 * i + 1].x * jb.q8, v[2 * i + 1].y * jb.q8); }
                __syncthreads();
#pragma unroll
                for (int i = 0; i < 2; ++i) {
                    const int idx = tid + NTHR * i, kc = idx & 7, nn = idx >> 3, n = jb.nt * 128 + nn;
                    const unsigned char* l = l8 + (kc * 16) * 132 + nn;
                    u32x4 w;
                    w.x = (unsigned)l[0] | ((unsigned)l[132] << 8) | ((unsigned)l[264] << 16) | ((unsigned)l[396] << 24);
                    w.y = (unsigned)l[528] | ((unsigned)l[660] << 8) | ((unsigned)l[792] << 16) | ((unsigned)l[924] << 24);
                    w.z = (unsigned)l[1056] | ((unsigned)l[1188] << 8) | ((unsigned)l[1320] << 16) | ((unsigned)l[1452] << 24);
                    w.w = (unsigned)l[1584] | ((unsigned)l[1716] << 8) | ((unsigned)l[1848] << 16) | ((unsigned)l[1980] << 24);
                    const int pr = perm_row(jb.perm, n);
                    if (n < jb.N && !(jb.perm == 1 && pr >= NMAIN)) *(u32x4*)((char*)jb.dst + (size_t)pr * jb.K + jb.kt * 128 + kc * 16) = w;
                }
            } else {
#pragma unroll
                for (int i = 0; i < 8; ++i) {
                    u32x2 w; w.x = pack2(v[2 * i].x, v[2 * i].y); w.y = pack2(v[2 * i + 1].x, v[2 * i + 1].y);
                    *(u32x2*)(lt + ((tid >> 5) + 16 * i) * 136 + (tid & 31) * 4) = w;
                }
                __syncthreads();
#pragma unroll
                for (int i = 0; i < 4; ++i) {
                    const int idx = tid + NTHR * i, kc = idx & 15, nn = idx >> 4, n = jb.nt * 128 + nn;
                    if (n < jb.N) {
                        const bf16_t* l = lt + (kc * 8) * 136 + nn;
                        u32x4 w;
                        w.x = (unsigned)l[0] | ((unsigned)l[136] << 16); w.y = (unsigned)l[272] | ((unsigned)l[408] << 16);
                        w.z = (unsigned)l[544] | ((unsigned)l[680] << 16); w.w = (unsigned)l[816] | ((unsigned)l[952] << 16);
                        *(u32x4*)(jb.dst + (size_t)perm_row(jb.perm, n) * jb.K + jb.kt * 128 + kc * 8) = w;
                    }
                }
            }
            __syncthreads();
            t = tn; have = hn; jb = jn;
#pragma unroll
            for (int i = 0; i < 16; ++i) v[i] = vn[i];
        }
    }
    for (size_t i = gtid; i < (size_t)NL * 2 * 2048 * 64; i += gthreads) {
        const int k = (int)(i % 2048), n = (int)((i / 2048) % 64), m = (int)(i / (2048 * 64));
        p.W1T[i] = f2bf(p.cmp_w1[((size_t)m * 2048 + k) * 64 + n]);
    }
    for (size_t i = gtid; i < (size_t)NL * 2 * 64 * 64; i += gthreads) {
        const int k = (int)(i % 64), n = (int)((i / 64) % 64), m = (int)(i / 4096);
        p.W2T[i] = f2bf(p.cmp_w2[((size_t)m * 64 + k) * 64 + n]);
    }
    for (size_t i = gtid; i < (size_t)NL * NPAD; i += gthreads) {
        const int l = (int)(i / NPAD), ri = (int)(i % NPAD), r = ri < 2560 ? inv128(ri) : ri;
        float v = 0.f;
        if (r < 2560) { const int n = r < 768 ? r : r + 4; v = p.b_in[l * NCOL + n]; }
        else if (r < 2564) v = p.b_in[l * NCOL + 768 + (r - 2560)];
        else if (r < 2582) v = p.b_in[l * NCOL + r];
        p.binp[i] = v;
    }
    for (size_t i = gtid; i < (size_t)NL * NE * 2048; i += gthreads) {
        const int r = (int)(i % 2048); const size_t le = i / 2048;
        const int s = (r >> 7) & 1, f = (r >> 8) * 128 + inv128(r & 127);
        p.bgup[i] = p.b_gu[le * 2048 + 2 * f + s] * (s == 0 ? GATE_PRE : 1.0f);
    }
    for (size_t i = gtid; i < (size_t)NL * NE * 1024; i += gthreads) {
        const int k = (int)(i % 1024), e = (int)((i / 1024) % NE), l = (int)(i / (1024 * NE));
        const float wv = p.router_w[((size_t)l * 1024 + k) * NE + e];
        const bf16_t hi = f2bf(wv); const float hf = __uint_as_float((unsigned)hi << 16);
        bf16_t* rwb = (bf16_t*)p.rwT + (size_t)l * 64 * 1024;
        rwb[(size_t)e * 1024 + k] = hi; rwb[(size_t)(32 + e) * 1024 + k] = f2bf(wv - hf);
    }
    for (size_t i = gtid; i < (size_t)NL * (NPAD - NCOL) * 1024; i += gthreads) {
        const int l = (int)(i / ((NPAD - NCOL) * 1024)); const size_t r = i % ((size_t)(NPAD - NCOL) * 1024);
        p.WinT[(size_t)l * NPAD * 1024 + (size_t)NCOL * 1024 + r] = 0;
    }
    {
        constexpr size_t N16 = (size_t)NTOK * DM / 16;
        for (size_t i0 = gtid; i0 < N16; i0 += gthreads * 2) {
            float4 v[2][4];
#pragma unroll
            for (int u = 0; u < 2; ++u) { const size_t i = i0 + u * gthreads;
#pragma unroll
                for (int j = 0; j < 4; ++j) v[u][j] = (i < N16) ? ((const float4*)p.x)[i * 4 + j] : make_float4(0.f, 0.f, 0.f, 0.f); }
#pragma unroll
            for (int u = 0; u < 2; ++u) { const size_t i = i0 + u * gthreads;
                if (i < N16) {
                    u32x4 w0, w1, q;
                    w0.x = pack2(v[u][0].x, v[u][0].y); w0.y = pack2(v[u][0].z, v[u][0].w); w0.z = pack2(v[u][1].x, v[u][1].y); w0.w = pack2(v[u][1].z, v[u][1].w);
                    w1.x = pack2(v[u][2].x, v[u][2].y); w1.y = pack2(v[u][2].z, v[u][2].w); w1.z = pack2(v[u][3].x, v[u][3].y); w1.w = pack2(v[u][3].z, v[u][3].w);
                    q.x = pack4_fp8(v[u][0].x, v[u][0].y, v[u][0].z, v[u][0].w); q.y = pack4_fp8(v[u][1].x, v[u][1].y, v[u][1].z, v[u][1].w);
                    q.z = pack4_fp8(v[u][2].x, v[u][2].y, v[u][2].z, v[u][2].w); q.w = pack4_fp8(v[u][3].x, v[u][3].y, v[u][3].z, v[u][3].w);
                    ((u32x4*)p.xb)[i * 2] = w0; ((u32x4*)p.xb)[i * 2 + 1] = w1; ((u32x4*)p.xq)[i] = q;
                }
            }
        }
    }
    if (bid < 32) {
        float* lf = (float*)ldsc;
        const int j = tid & 63, part = tid >> 6, lw = bid >> 3, sl = bid & 7;
        const float* pe = p.cmp_pe + (size_t)lw * 2048; const float* w1 = p.cmp_w1 + (size_t)lw * 2048 * 64;
        float s = 0.f;
#pragma unroll 8
        for (int kk = sl * 256 + part * 32; kk < sl * 256 + part * 32 + 32; ++kk) s += pe[kk] * w1[(size_t)kk * 64 + j];
        lf[tid] = s; __syncthreads();
        if (tid < 64) { float a = 0.f; for (int q = 0; q < 8; ++q) a += lf[tid + 64 * q]; p.b1c[(lw * 8 + sl) * 64 + tid] = a; }
        __syncthreads();
    }
}

__device__ __forceinline__ int vcu_id() { return __builtin_amdgcn_readfirstlane(*(const volatile LAS int*)(LDS_BYTES - 32)); }
namespace pg8 {
constexpr int BM = 256, BK = 64, HALF = 128, HTB = HALF * BK * 2, NXCD = 8, WGM = 8;
__device__ __forceinline__ int lds_byte(int r, int c) { const int ch = (c >> 3) ^ ((r >> 1) & 7); return (r >> 3) * 1024 + (r & 7) * 128 + ch * 16 + (c & 7) * 2; }
__device__ __forceinline__ void stage_rc(int b, int& R, int& C) { const int st = b / 1024, sb = b % 1024; R = st * 8 + sb / 128; C = ((((sb % 128) / 16) ^ ((R >> 1) & 7)) * 16 + (sb % 16)) / 2; }
__device__ __forceinline__ bool tile_order(int i, int G, int c, int nM, int nN, int& pm, int& pn) {
    const int nwg = nM * nN; const long L = (long)i * G + c; if (L >= nwg) return false;
    const int wgid = (int)L;
    const int nig = WGM * nN, gid = wgid / nig, fm = gid * WGM, gsz = (nM - fm) < WGM ? (nM - fm) : WGM;
    pm = fm + ((wgid % nig) % gsz); pn = (wgid % nig) / gsz; return true;
}
template <bool FP8, int SCA, class Sched, class Epi>
__device__ __forceinline__ void gemm_phase(LAS unsigned char* lds, const char* Abase, int K, const Sched& S, const Epi& E) {
    int tid = threadIdx.x; asm volatile("" : "+v"(tid));
    const int wid = __builtin_amdgcn_readfirstlane(tid >> 6), lane = tid & 63, wr = wid >> 2, wc = wid & 3, fr = lane & 15, fq = lane >> 4;
    const int nt = K / BK;
    int R0, C0, R1, C1; stage_rc(tid * 16, R0, C0); stage_rc(tid * 16 + 8192, R1, C1);
    LAS unsigned* aofs = (LAS unsigned*)(lds + LDS_AOFF) + tid;
    unsigned rg[10];
    rg[8] = (unsigned)(R0 * K + C0) * 2u; rg[9] = (unsigned)(R1 * K + C1) * 2u;
    if constexpr (FP8) { aofs[8 * NTHR] = rg[8]; aofs[9 * NTHR] = rg[9]; }
    const size_t kstep = (size_t)(BK * 2), hstep = (size_t)HALF * K * 2;
    const unsigned ldsw = (unsigned)wid * 1024u;
    const int aoff = lds_byte(wr * 64 + fr, fq * 8), boff = lds_byte(wc * 32 + fr, fq * 8);
#define PG8_SA(b, h) (((b) * 2 + (h)) * HTB)
#define PG8_SB(b, h) ((4 + (b) * 2 + (h)) * HTB)
#define PG8_OFS(sel, j) (FP8 ? aofs[((sel) * 4 + (j)) * NTHR] : ((sel) ? rg[4 + (j)] : rg[(j)]))
#define PG8_STAGE_B(bufoff, gbase) do { _Pragma("unroll") for (int _i = 0; _i < 2; ++_i) { const unsigned ob_ = FP8 ? aofs[(8 + _i) * NTHR] : rg[8 + _i]; \
        __builtin_amdgcn_global_load_lds((const unsigned*)((const char*)(gbase) + ob_), (LAS unsigned*)(lds + (bufoff) + ldsw + _i * 8192), 16, 0, 0); } } while (0)
#define PG8_STAGE_A(bufoff, kbyte, sel, h) do { const unsigned o0_ = PG8_OFS(sel, (h) * 2), o1_ = PG8_OFS(sel, (h) * 2 + 1); \
        __builtin_amdgcn_global_load_lds((const unsigned*)(Abase + (kbyte) + o0_), (LAS unsigned*)(lds + (bufoff) + ldsw), 16, 0, 0); \
        __builtin_amdgcn_global_load_lds((const unsigned*)(Abase + (kbyte) + o1_), (LAS unsigned*)(lds + (bufoff) + ldsw + 8192), 16, 0, 0); } while (0)
#define PG8_LDA(dst, b, h) do { _Pragma("unroll") for (int m = 0; m < 4; ++m) { \
        if constexpr (FP8) { const v4i_t lo_ = *(const LAS v4i_t*)(lds + PG8_SA(b, h) + aoff + m * 2048), hi_ = *(const LAS v4i_t*)(lds + PG8_SA(b, h) + (aoff ^ 64) + m * 2048); dst##8[m] = __builtin_shufflevector(lo_, hi_, 0, 1, 2, 3, 4, 5, 6, 7); } \
        else { _Pragma("unroll") for (int k = 0; k < 2; ++k) dst[m][k] = *(const LAS bf16x8*)(lds + PG8_SA(b, h) + (aoff ^ (k * 64)) + m * 2048); } } } while (0)
#define PG8_LDB(dst, b, h) do { _Pragma("unroll") for (int n = 0; n < 2; ++n) { \
        if constexpr (FP8) { const v4i_t lo_ = *(const LAS v4i_t*)(lds + PG8_SB(b, h) + boff + n * 2048), hi_ = *(const LAS v4i_t*)(lds + PG8_SB(b, h) + (boff ^ 64) + n * 2048); dst##8[n] = __builtin_shufflevector(lo_, hi_, 0, 1, 2, 3, 4, 5, 6, 7); } \
        else { _Pragma("unroll") for (int k = 0; k < 2; ++k) dst[n][k] = *(const LAS bf16x8*)(lds + PG8_SB(b, h) + (boff ^ (k * 64)) + n * 2048); } } } while (0)
#define PG8_MMA(ai, bj, At, Bt) do { __builtin_amdgcn_s_setprio(1); _Pragma("unroll") for (int m = 0; m < 4; ++m) _Pragma("unroll") for (int n = 0; n < 2; ++n) { \
        if constexpr (FP8) { acc[ai][bj][m][n] = __builtin_amdgcn_mfma_scale_f32_16x16x128_f8f6f4(Bt##8[n], At##8[m], acc[ai][bj][m][n], 0, 0, 0, SCA, 0, SCA); } \
        else { _Pragma("unroll") for (int k = 0; k < 2; ++k) acc[ai][bj][m][n] = __builtin_amdgcn_mfma_f32_16x16x32_bf16(Bt[n][k], At[m][k], acc[ai][bj][m][n], 0, 0, 0); } } \
        __builtin_amdgcn_s_setprio(0); } while (0)
#define PG8_WAIT_V(n) asm volatile("s_waitcnt vmcnt(" #n ")" ::: "memory")
#define PG8_WAIT_L(n) asm volatile("s_waitcnt lgkmcnt(" #n ")" ::: "memory")
#define PG8_BAR __builtin_amdgcn_s_barrier()
#define PG8_SCHED __builtin_amdgcn_sched_barrier(0)
    typename Sched::Unit cur, nxt; int ui = 0;
    if (!S.next(0, cur)) return;
    f32x4 acc[2][2][4][2];
    bf16x8 At[4][2], B0[2][2], B1[2][2];
    v8i_t At8[4], B08[2], B18[2];
    { unsigned a4[2][2]; S.a_off(cur, R0, C0, R1, C1, a4); rg[0] = a4[0][0]; rg[1] = a4[0][1]; rg[2] = a4[1][0]; rg[3] = a4[1][1];
      if constexpr (FP8) { aofs[0] = a4[0][0]; aofs[NTHR] = a4[0][1]; aofs[2 * NTHR] = a4[1][0]; aofs[3 * NTHR] = a4[1][1]; } }
    const char* cB = S.b_ptr(cur);
#define PG8_BIAS_DMA(unit, slot) do { const float* bp_ = E.bias_ptr(unit); int tb_ = threadIdx.x; asm volatile("" : "+v"(tb_)); if (wr == 0 && bp_ != nullptr) \
        __builtin_amdgcn_global_load_lds((const unsigned*)(bp_ + (tb_ & 255)), (LAS unsigned*)(lds + LDS_BIAS + (slot) * 1024 + wid * 256), 4, 0, 0); } while (0)
    PG8_BIAS_DMA(cur, 0);
    PG8_STAGE_B(PG8_SB(0, 0), cB); PG8_STAGE_B(PG8_SB(0, 1), cB + hstep); PG8_STAGE_A(PG8_SA(0, 0), 0, 0, 0); PG8_STAGE_A(PG8_SA(0, 1), 0, 0, 1);
    if (wr == 1) PG8_BAR;
    PG8_WAIT_V(2); PG8_BAR;
    PG8_STAGE_B(PG8_SB(1, 0), cB + kstep); PG8_STAGE_A(PG8_SA(1, 0), kstep, 0, 0); PG8_STAGE_B(PG8_SB(1, 1), cB + hstep + kstep);
    PG8_WAIT_V(6); PG8_BAR;
    { int t3 = threadIdx.x; asm volatile("" : "+v"(t3)); E.init(acc, wc, (t3 & 63) >> 4, (const LAS float*)(lds + LDS_BIAS)); }
    for (;;) {
        const bool has_next = S.next(ui + 1, nxt);
        const char* nB = cB;
        if (has_next) PG8_BIAS_DMA(nxt, (ui + 1) % 3);
        if (has_next) { int t2 = threadIdx.x; asm volatile("" : "+v"(t2)); int r0, c0, r1, c1; stage_rc(t2 * 16, r0, c0); stage_rc(t2 * 16 + 8192, r1, c1); nB = S.b_ptr(nxt);
            if constexpr (Sched::LIST_DMA) { static_assert(!Sched::LIST_DMA || FP8, "list DMA lands in the LDS offset slots"); S.a_dma(nxt, r0, r1, (LAS unsigned*)(lds + LDS_AOFF + 4 * NTHR * 4 + wid * 256)); }
            else { unsigned a4[2][2]; S.a_off(nxt, r0, c0, r1, c1, a4);
                rg[4] = a4[0][0]; rg[5] = a4[0][1]; rg[6] = a4[1][0]; rg[7] = a4[1][1];
                if constexpr (FP8) { aofs[4 * NTHR] = a4[0][0]; aofs[5 * NTHR] = a4[0][1]; aofs[6 * NTHR] = a4[1][0]; aofs[7 * NTHR] = a4[1][1]; } } }
        else { rg[4] = rg[0]; rg[5] = rg[1]; rg[6] = rg[2]; rg[7] = rg[3];
            if constexpr (FP8) { aofs[4 * NTHR] = aofs[0]; aofs[5 * NTHR] = aofs[NTHR]; aofs[6 * NTHR] = aofs[2 * NTHR]; aofs[7 * NTHR] = aofs[3 * NTHR]; } }
#pragma unroll 1
        for (int t = 0; t < nt; t += 2) {
            const bool last = (t == nt - 2);
            const size_t ka1 = (size_t)(t + 1) * kstep, ka2 = last ? 0 : (size_t)(t + 2) * kstep, ka3 = ka2 + kstep;
            const char* b2 = last ? nB : cB + (size_t)(t + 2) * kstep; const char* b3 = b2 + kstep;
            const int sel = last ? 1 : 0;
            if constexpr (Sched::LIST_DMA) if (last && has_next) {
                int t4 = threadIdx.x; asm volatile("" : "+v"(t4)); int r0, c0, r1, c1; stage_rc(t4 * 16, r0, c0); stage_rc(t4 * 16 + 8192, r1, c1);
#pragma unroll
                for (int j = 0; j < 4; ++j) aofs[(4 + j) * NTHR] = S.a_fin(aofs[(4 + j) * NTHR], (j & 1) ? c1 : c0);
            }
            PG8_LDB(B0, 0, 0); PG8_LDB(B1, 0, 1); PG8_SCHED; PG8_LDA(At, 0, 0); PG8_STAGE_A(PG8_SA(1, 1), ka1, 0, 1);
            PG8_WAIT_V(8); PG8_WAIT_L(0); PG8_BAR; PG8_MMA(0, 0, At, B0); PG8_MMA(0, 1, At, B1); PG8_BAR; PG8_SCHED;
            PG8_LDA(At, 0, 1); PG8_STAGE_B(PG8_SB(0, 0), b2); PG8_STAGE_B(PG8_SB(0, 1), b2 + hstep); PG8_STAGE_A(PG8_SA(0, 0), ka2, sel, 0);
            PG8_WAIT_V(8); PG8_WAIT_L(0); PG8_BAR; PG8_MMA(1, 0, At, B0); PG8_MMA(1, 1, At, B1); PG8_BAR; PG8_SCHED;
            PG8_LDB(B0, 1, 0); PG8_LDB(B1, 1, 1); PG8_SCHED; PG8_LDA(At, 1, 0); PG8_STAGE_A(PG8_SA(0, 1), ka2, sel, 1);
            PG8_WAIT_V(8); PG8_WAIT_L(0); PG8_BAR; PG8_MMA(0, 0, At, B0); PG8_MMA(0, 1, At, B1); PG8_BAR; PG8_SCHED;
            PG8_LDA(At, 1, 1); PG8_STAGE_B(PG8_SB(1, 0), b3); PG8_STAGE_B(PG8_SB(1, 1), b3 + hstep); PG8_STAGE_A(PG8_SA(1, 0), ka3, sel, 0);
            PG8_WAIT_V(8); PG8_WAIT_L(0); PG8_BAR; PG8_MMA(1, 0, At, B0); PG8_MMA(1, 1, At, B1); PG8_BAR; PG8_SCHED;
        }
        if (wr == 0) PG8_BAR;
        { int t2 = threadIdx.x; asm volatile("" : "+v"(t2)); E(acc, cur, wr, wc, t2 & 15, (t2 & 63) >> 4, (const LAS float*)(lds + LDS_BIAS + (ui % 3) * 1024)); }
        if (!has_next) break;
        { int t3 = threadIdx.x; asm volatile("" : "+v"(t3)); E.init(acc, wc, (t3 & 63) >> 4, (const LAS float*)(lds + LDS_BIAS + ((ui + 1) % 3) * 1024)); }
        cur = nxt; cB = nB; ++ui;
        rg[0] = rg[4]; rg[1] = rg[5]; rg[2] = rg[6]; rg[3] = rg[7];
        if constexpr (FP8) { aofs[0] = aofs[4 * NTHR]; aofs[NTHR] = aofs[5 * NTHR]; aofs[2 * NTHR] = aofs[6 * NTHR]; aofs[3 * NTHR] = aofs[7 * NTHR]; }
        if (wr == 1) PG8_BAR;
    }
    PG8_WAIT_V(0);
    PG8_BAR;
#undef PG8_BIAS_DMA
#undef PG8_SA
#undef PG8_SB
#undef PG8_STAGE_A
#undef PG8_OFS
#undef PG8_STAGE_B
#undef PG8_LDA
#undef PG8_LDB
#undef PG8_MMA
#undef PG8_WAIT_V
#undef PG8_WAIT_L
#undef PG8_BAR
#undef PG8_SCHED
}
}

struct DenseUnit { int pm, pn; };
struct DenseSched {
    typedef DenseUnit Unit;
    const char* Bt; int K, nM, nN, vc;
    __device__ __forceinline__ bool next(int i, Unit& u) const { return pg8::tile_order(i, gridDim.x, vc, nM, nN, u.pm, u.pn); }
    __device__ __forceinline__ void a_off(const Unit& u, int R0, int C0, int R1, int C1, unsigned (&off)[2][2]) const {
#pragma unroll
        for (int h = 0; h < 2; ++h) { off[h][0] = (unsigned)((u.pm * 256 + h * 128 + R0) * K + C0) * 2u; off[h][1] = (unsigned)((u.pm * 256 + h * 128 + R1) * K + C1) * 2u; }
    }
    __device__ __forceinline__ const char* b_ptr(const Unit& u) const { return Bt + (size_t)u.pn * 256 * K * 2; }
    static constexpr bool LIST_DMA = false;
    __device__ __forceinline__ void a_dma(const Unit&, int, int, LAS unsigned*) const {}
    __device__ __forceinline__ unsigned a_fin(unsigned raw, int) const { return raw; }
};
struct MoeUnit { int rbt, e, pn; };
template <bool GATHER>
struct MoeSched {
    typedef MoeUnit Unit;
    static constexpr int KP = 512;
    const char* Bt; const int* lists; const int* ptile; const int* ecnt; int nN, nrows, vc;
    __device__ __forceinline__ bool next(int i, Unit& u) const {
        int pm, pn; if (!pg8::tile_order(i, gridDim.x, vc, ptile[NE], nN, pm, pn)) return false;
        u.rbt = pm; u.e = ((const unsigned char*)ptile)[512 + pm]; u.pn = pn; return true;
    }
    __device__ __forceinline__ void a_off(const Unit& u, int R0, int C0, int R1, int C1, unsigned (&off)[2][2]) const {
        if (GATHER) {
            const int* lst = lists + (size_t)u.e * LIST_CAP; const int rb = u.rbt - ptile[u.e], cnt = ecnt[u.e];
#pragma unroll
            for (int h = 0; h < 2; ++h) {
                const int l0 = rb * 256 + h * 128 + R0, l1 = rb * 256 + h * 128 + R1;
                const int t0 = l0 < cnt ? (lst[l0] >> 2) : 0, t1 = l1 < cnt ? (lst[l1] >> 2) : 0;
                off[h][0] = (unsigned)(t0 * KP + C0) * 2u; off[h][1] = (unsigned)(t1 * KP + C1) * 2u;
            }
        } else {
#pragma unroll
            for (int h = 0; h < 2; ++h) { off[h][0] = (unsigned)((u.rbt * 256 + h * 128 + R0) * KP + C0) * 2u; off[h][1] = (unsigned)((u.rbt * 256 + h * 128 + R1) * KP + C1) * 2u; }
        }
    }
    __device__ __forceinline__ const char* b_ptr(const Unit& u) const { return Bt + ((size_t)u.e * nrows + (size_t)u.pn * 256) * KP * 2; }
    static constexpr bool LIST_DMA = GATHER;
    __device__ __forceinline__ void a_dma(const Unit& u, int R0, int R1, LAS unsigned* slot) const {
        const int* lst = lists + (size_t)u.e * LIST_CAP; const int rb = u.rbt - ptile[u.e], cm = ecnt[u.e] - 1;
#pragma unroll
        for (int h = 0; h < 2; ++h) {
            const int l0 = min(rb * 256 + h * 128 + R0, cm), l1 = min(rb * 256 + h * 128 + R1, cm);
            __builtin_amdgcn_global_load_lds((const unsigned*)(lst + l0), slot + (h * 2) * NTHR, 4, 0, 0);
            __builtin_amdgcn_global_load_lds((const unsigned*)(lst + l1), slot + (h * 2 + 1) * NTHR, 4, 0, 0);
        }
    }
    __device__ __forceinline__ unsigned a_fin(unsigned raw, int C) const { return (unsigned)((int)(raw >> 2) * KP + C) * 2u; }
};

__device__ __forceinline__ u32x2 quad_tr(unsigned p01, unsigned p23, int fr) {
    const unsigned sel = (fr & 1) ? 0x03020706u : 0x05040100u;
    const unsigned y01 = (unsigned)__builtin_amdgcn_update_dpp(0, (int)p01, 0xB1, 0xF, 0xF, true), y23 = (unsigned)__builtin_amdgcn_update_dpp(0, (int)p23, 0xB1, 0xF, 0xF, true);
    const unsigned q01 = __builtin_amdgcn_perm(y01, p01, sel), q23 = __builtin_amdgcn_perm(y23, p23, sel);
    const bool hi = (fr & 2) != 0;
    const unsigned snd = hi ? q01 : q23;
    const unsigned rcv = (unsigned)__builtin_amdgcn_update_dpp(0, (int)snd, 0x4E, 0xF, 0xF, true);
    u32x2 r; r.x = hi ? rcv : q01; r.y = hi ? q23 : rcv; return r;
}
struct EpiInProj {
    const Params* p; int l;
    __device__ __forceinline__ const float* bias_ptr(const DenseUnit& u) const { return p->binp + l * NPAD + u.pn * 256; }
    __device__ __forceinline__ void init(f32x4 (&acc)[2][2][4][2], int wc, int fq, const LAS float* bias) const {
#pragma unroll
        for (int bj = 0; bj < 2; ++bj)
#pragma unroll
            for (int n = 0; n < 2; ++n) {
                const f32x4 bv = *(const LAS f32x4*)(bias + bj * 128 + wc * 32 + n * 16 + 4 * fq);
#pragma unroll
                for (int ai = 0; ai < 2; ++ai)
#pragma unroll
                    for (int m = 0; m < 4; ++m) acc[ai][bj][m][n] = bv;
            }
    }
    __device__ __forceinline__ void operator()(const f32x4 (&acc)[2][2][4][2], const DenseUnit& u, int wr, int wc, int fr, int fq, const LAS float*) const {
#pragma unroll
        for (int bj = 0; bj < 2; ++bj) {
            int kind = 0, hb0 = 0;
            if (u.pn == 1) { kind = 1; hb0 = bj * 2; } else if (u.pn == 4 && bj == 1) { kind = 1; hb0 = 4; } else if (u.pn == 8 && bj == 0) { kind = 1; hb0 = 6; } else if (u.pn == 9 && bj == 0) { kind = 1; hb0 = 8; }
            else if (u.pn == 2) { kind = 2; hb0 = bj * 2; } else if (u.pn == 5 && bj == 0) { kind = 2; hb0 = 4; } else if (u.pn == 8 && bj == 1) { kind = 2; hb0 = 6; } else if (u.pn == 9 && bj == 1) { kind = 2; hb0 = 8; }
            const int c0 = wc * 32 + fq * 8;
            const int hh = hb0 + (c0 >> 6), d0 = c0 & 63;
#pragma unroll
            for (int ai = 0; ai < 2; ++ai)
#pragma unroll
                for (int m = 0; m < 4; ++m) {
                    const int row = u.pm * 256 + ai * 128 + wr * 64 + m * 16 + fr;
                    const f32x4 v0 = acc[ai][bj][m][0], v1 = acc[ai][bj][m][1];
                    u32x4 w; w.x = pack2(v0[0], v0[1]); w.y = pack2(v0[2], v0[3]); w.z = pack2(v1[0], v1[1]); w.w = pack2(v1[2], v1[3]);
                    if (kind == 0) *(u32x4*)(p->hb + (size_t)row * NMAIN + u.pn * 256 + bj * 128 + c0) = w;
                    else {
                        const int b = row >> 11, s = row & 2047, kk = s & 31;
                        bf16_t* blk = (kind == 1 ? p->kF : p->vT) + (((size_t)b * NVH + hh) * 64 + (s >> 5)) * 2048;
                        if (kind == 1) {
                            const int frk = (kk >> 3) * 4 + (kk & 3), t = (kk >> 2) & 1;
                            *(u32x4*)(blk + ((t * 2 + (d0 >> 5)) * 64 + ((d0 & 31) >> 3) * 16 + frk) * 8) = w;
                        } else {
                            const int kq = kk & 28;
                            const u32x2 t0 = quad_tr(w.x, w.y, fr), t1 = quad_tr(w.z, w.w, fr);
                            bf16_t* vt = blk + (((d0 >> 4) * 64) + (kq >> 3) * 16 + (d0 & 15) + (fr & 3)) * 8 + (kq & 7);
                            *(u32x2*)vt = t0; *(u32x2*)(vt + 32) = t1;
                        }
                    }
                }
        }
    }
};
struct EpiOutProj {
    const bf16_t* xin; float* t;
    __device__ __forceinline__ const float* bias_ptr(const DenseUnit&) const { return nullptr; }
    __device__ __forceinline__ void init(f32x4 (&acc)[2][2][4][2], int, int, const LAS float*) const {
#pragma unroll
        for (int ai = 0; ai < 2; ++ai)
#pragma unroll
            for (int bj = 0; bj < 2; ++bj)
#pragma unroll
                for (int m = 0; m < 4; ++m)
#pragma unroll
                    for (int n = 0; n < 2; ++n) acc[ai][bj][m][n] = (f32x4){0.f, 0.f, 0.f, 0.f};
    }
    __device__ __forceinline__ void operator()(const f32x4 (&acc)[2][2][4][2], const DenseUnit& u, int wr, int wc, int fr, int fq, const LAS float*) const {
#pragma unroll
        for (int ai = 0; ai < 2; ++ai)
#pragma unroll
            for (int m = 0; m < 4; ++m) {
                const size_t off = (size_t)(u.pm * 256 + ai * 128 + wr * 64 + m * 16 + fr) * DM + u.pn * 256 + wc * 64 + fq * 16;
                u32x4 w0, w1;
                { const f32x4 a = acc[ai][0][m][0]; w0.x = pack2(a[0], a[1]); w0.y = pack2(a[2], a[3]); }
                { const f32x4 a = acc[ai][0][m][1]; w0.z = pack2(a[0], a[1]); w0.w = pack2(a[2], a[3]); }
                { const f32x4 a = acc[ai][1][m][0]; w1.x = pack2(a[0], a[1]); w1.y = pack2(a[2], a[3]); }
                { const f32x4 a = acc[ai][1][m][1]; w1.z = pack2(a[0], a[1]); w1.w = pack2(a[2], a[3]); }
                *(u32x4*)((bf16_t*)t + off) = w0; *(u32x4*)((bf16_t*)t + off + 8) = w1;
            }
    }
};
struct EpiGateUp {
    bf16_t* act; const float* bgup;
    __device__ __forceinline__ const float* bias_ptr(const MoeUnit& u) const { return bgup + (size_t)u.e * 2048 + u.pn * 256; }
    __device__ __forceinline__ void init(f32x4 (&acc)[2][2][4][2], int wc, int fq, const LAS float* bias) const {
#pragma unroll
        for (int bj = 0; bj < 2; ++bj)
#pragma unroll
            for (int n = 0; n < 2; ++n) {
                const f32x4 bv = *(const LAS f32x4*)(bias + bj * 128 + wc * 32 + n * 16 + 4 * fq);
#pragma unroll
                for (int ai = 0; ai < 2; ++ai)
#pragma unroll
                    for (int m = 0; m < 4; ++m) acc[ai][bj][m][n] = bv;
            }
    }
    __device__ __forceinline__ void operator()(const f32x4 (&acc)[2][2][4][2], const MoeUnit& u, int wr, int wc, int fr, int fq, const LAS float*) const {
        constexpr float GMIN = 7.0f * GATE_PRE, CI = 1.0f / GATE_PRE;
#pragma unroll
        for (int ai = 0; ai < 2; ++ai)
#pragma unroll
            for (int m = 0; m < 4; ++m) {
                u32x2 w;
#pragma unroll
                for (int n = 0; n < 2; ++n) {
                    const f32x4 g4 = acc[ai][0][m][n], u4 = acc[ai][1][m][n];
                    float o[4];
#pragma unroll
                    for (int j = 0; j < 4; ++j) {
                        const float gp = __builtin_amdgcn_fmed3f(g4[j], GMIN, 3.0e38f), uu = __builtin_amdgcn_fmed3f(u4[j], -7.0f, 7.0f);
                        const float glu = gp * __builtin_amdgcn_rcpf(1.0f + __builtin_amdgcn_exp2f(gp));
                        o[j] = __builtin_fmaf(uu, CI, CI) * glu;
                    }
                    const unsigned pk = pack4_fp8(o[0], o[1], o[2], o[3]);
                    if (n == 0) w.x = pk; else w.y = pk;
                }
                *(u32x2*)((char*)act + (size_t)(u.rbt * 256 + ai * 128 + wr * 64 + m * 16 + fr) * DFF + u.pn * 128 + wc * 32 + fq * 8) = w;
            }
    }
};
struct EpiDown {
    bf16_t* ybuf; const float* bdn;
    __device__ __forceinline__ const float* bias_ptr(const MoeUnit& u) const { return bdn + (size_t)u.e * 1024 + u.pn * 256; }
    __device__ __forceinline__ void init(f32x4 (&acc)[2][2][4][2], int wc, int fq, const LAS float* bias) const {
#pragma unroll
        for (int bj = 0; bj < 2; ++bj)
#pragma unroll
            for (int n = 0; n < 2; ++n) {
                const f32x4 bv = *(const LAS f32x4*)(bias + wc * 64 + fq * 16 + bj * 8 + n * 4);
#pragma unroll
                for (int ai = 0; ai < 2; ++ai)
#pragma unroll
                    for (int m = 0; m < 4; ++m) acc[ai][bj][m][n] = bv;
            }
    }
    __device__ __forceinline__ void operator()(const f32x4 (&acc)[2][2][4][2], const MoeUnit& u, int wr, int wc, int fr, int fq, const LAS float*) const {
#pragma unroll
        for (int ai = 0; ai < 2; ++ai)
#pragma unroll
            for (int m = 0; m < 4; ++m) {
                u32x4 w;
                { const f32x4 v = acc[ai][0][m][0]; w.x = pack4_fp8(v[0], v[1], v[2], v[3]); }
                { const f32x4 v = acc[ai][0][m][1]; w.y = pack4_fp8(v[0], v[1], v[2], v[3]); }
                { const f32x4 v = acc[ai][1][m][0]; w.z = pack4_fp8(v[0], v[1], v[2], v[3]); }
                { const f32x4 v = acc[ai][1][m][1]; w.w = pack4_fp8(v[0], v[1], v[2], v[3]); }
                *(u32x4*)((unsigned char*)ybuf + (size_t)(u.rbt * 256 + ai * 128 + wr * 64 + m * 16 + fr) * DM + u.pn * 256 + wc * 64 + fq * 16) = w;
            }
    }
};

__device__ __forceinline__ void phase_inproj(const Params& p, int l, char* lds) {
    DenseSched S{(const char*)p.WinQ + (size_t)l * NMAIN * 1024, 512, NTOK / 256, NMAIN / 256, vcu_id()};
    EpiInProj E{&p, l};
    pg8::gemm_phase<true, 0x7c7c7c7c>((LAS unsigned char*)lds, (const char*)p.xq, 512, S, E);
    int tid = threadIdx.x; asm volatile("" : "+v"(tid));
    const int wid = tid >> 6, lane = tid & 63, fr = lane & 15, fq = lane >> 4;
    const bf16_t* W = p.WinT + ((size_t)l * NPAD + NMAIN) * 1024;
    const float* bias = p.binp + l * NPAD + NMAIN;
    constexpr int WP = 2064;
#pragma unroll
    for (int i = 0; i < 8; ++i) { const int pc = wid * 8 + i, r = pc >> 1, q = pc & 1;
        __builtin_amdgcn_global_load_lds((const unsigned*)(W + (size_t)r * 1024 + q * 512 + lane * 8), (LAS unsigned*)((LAS char*)lds + r * WP + q * 1024), 16, 0, 0); }
    asm volatile("s_waitcnt vmcnt(0)" ::: "memory");
    __syncthreads();
    for (int u = blockIdx.x * NWV + wid; u < NTOK / 16; u += gridDim.x * NWV) {
        const bf16_t* ar = p.xb + (size_t)(u * 16 + fr) * DM + fq * 8;
        const LAS char* w0 = (const LAS char*)lds + fr * WP + fq * 16; const LAS char* w1 = w0 + 16 * WP;
        f32x4 a0 = (f32x4){0.f, 0.f, 0.f, 0.f}, a1 = a0;
#pragma unroll 4
        for (int ks = 0; ks < 32; ++ks) {
            const bf16x8 a = *(const bf16x8*)(ar + ks * 32);
            a0 = __builtin_amdgcn_mfma_f32_16x16x32_bf16(a, *(const LAS bf16x8*)(w0 + ks * 64), a0, 0, 0, 0);
            a1 = __builtin_amdgcn_mfma_f32_16x16x32_bf16(a, *(const LAS bf16x8*)(w1 + ks * 64), a1, 0, 0, 0);
        }
#pragma unroll
        for (int r = 0; r < 4; ++r) {
            float* dst = p.hs + (size_t)(u * 16 + fq * 4 + r) * HS_W;
            dst[fr] = a0[r] + bias[fr];
            if (fr < 6) dst[16 + fr] = a1[r] + bias[16 + fr];
        }
    }
}
__device__ __forceinline__ void phase_outproj(const Params& p, int l, const bf16_t* xin, char* lds) {
    DenseSched S{(const char*)p.WoT + (size_t)l * 1024 * 1024, 512, NTOK / 256, 4, vcu_id()};
    EpiOutProj E{xin, p.tbuf};
    pg8::gemm_phase<true, 0x7c7c7c7c>((LAS unsigned char*)lds, (const char*)p.ob, 512, S, E);
}
__device__ __forceinline__ void build_tiles(const Params& p, int l, int* ptile, int* ecnt) {
    int tid = threadIdx.x; asm volatile("" : "+v"(tid));
    if (tid < NE) ecnt[tid] = (int)__hip_atomic_load(p.ctrl + 64 + l * NE + tid, __ATOMIC_RELAXED, __HIP_MEMORY_SCOPE_AGENT);
    __syncthreads();
    if (tid == 0) { int s = 0; for (int e = 0; e < NE; ++e) { ptile[e] = s; s += (ecnt[e] + 255) >> 8; } ptile[NE] = s; }
    __syncthreads();
    unsigned char* texp = (unsigned char*)ptile + 512;
    for (int t = tid; t < ptile[NE]; t += NTHR) { int e = 0; while (ptile[e + 1] <= t) ++e; texp[t] = (unsigned char)e; }
    __syncthreads();
}
__device__ __forceinline__ void phase_gateup(const Params& p, int l, char* lds) {
    int* ptile = (int*)(lds + LDS_TAB); int* ecnt = ptile + 40;
    build_tiles(p, l, ptile, ecnt);
    MoeSched<true> S{(const char*)p.WguT + (size_t)l * NE * 2048 * 1024, p.lists, ptile, ecnt, 8, 2048, vcu_id()};
    EpiGateUp E{p.act, p.bgup + (size_t)l * NE * 2048};
    pg8::gemm_phase<true, 0x7c7c7c7c>((LAS unsigned char*)lds, (const char*)p.x1b, 512, S, E);
}
__device__ __forceinline__ void phase_down(const Params& p, int l, char* lds) {
    int* ptile = (int*)(lds + LDS_TAB); int* ecnt = ptile + 40;
    MoeSched<false> S{(const char*)p.WdnT + (size_t)l * NE * 1024 * 1024, p.lists, ptile, ecnt, 4, 1024, vcu_id()};
    EpiDown E{p.ybuf, p.b_dn + (size_t)l * NE * 1024};
    pg8::gemm_phase<true, 0x7c7c7c7c>((LAS unsigned char*)lds, (const char*)p.act, 512, S, E);
}

__device__ __forceinline__ float gelu_tanh(float x) {
    const float u = 0.7978845608028654f * (x + 0.044715f * x * x * x);
    const float e = __expf(-2.0f * fabsf(u)); const float th = (1.0f - e) / (1.0f + e);
    return 0.5f * x * (1.0f + (u < 0.f ? -th : th));
}
__device__ __forceinline__ void phase_prep(const Params& p, int l, char* lds) {
    int tid = threadIdx.x; asm volatile("" : "+v"(tid));
    const int wid = tid >> 6, lane = tid & 63, fr = lane & 15, fq = lane >> 4;
    const int gw = blockIdx.x * NWV + wid, nw = gridDim.x * NWV;
    for (int u = (int)gridDim.x - 1 - (int)blockIdx.x; u < NB * 4; u += gridDim.x) {
        const int b = u >> 2, h = u & 3;
        const float* srcp = p.hs + ((size_t)b * SEQ + tid * 4) * HS_W + h;
        float ls[4]; float tot = 0.f;
#pragma unroll
        for (int i = 0; i < 4; ++i) { const float f = srcp[(size_t)i * HS_W]; ls[i] = fminf(f, 0.f) - log1pf(__expf(-fabsf(f))); tot += ls[i]; }
        float inc = tot;
#pragma unroll
        for (int o = 1; o < 64; o <<= 1) { const float v = shfl_f(inc, lane - o); if (lane >= o) inc += v; }
        float* wtot = (float*)(lds + 65536);
        if (lane == 63) wtot[wid] = inc;
        __syncthreads();
        float base = inc - tot;
        for (int w = 0; w < wid; ++w) base += wtot[w];
        float4 o4; o4.x = base + ls[0]; o4.y = o4.x + ls[1]; o4.z = o4.y + ls[2]; o4.w = o4.z + ls[3];
        *(float4*)(p.cF + (size_t)u * SEQ + tid * 4) = o4;
        __syncthreads();
    }
    float* part = (float*)lds;
    bf16_t* h1 = (bf16_t*)(lds + 32768);
    for (int u = blockIdx.x; u < NB * 2 * 2 * 8; u += gridDim.x) {
        const int ct = u & 7, which = (u >> 3) & 1, kvh = (u >> 4) & 1, b = u >> 5;
        const int colo = (which ? C_NVC : C_NKC) + kvh * 64;
        const int c_lane = ct * 16 + fr;
        const int tokbase = min(c_lane, 126) * 16;
        const bf16_t* arow = p.hb + ((size_t)b * SEQ + tokbase) * NMAIN + colo + fq * 8;
        const bf16_t* w1 = p.W1T + ((size_t)(l * 2 + which) * 64 + fr) * 2048 + fq * 8;
        f32x4 acc[4];
#pragma unroll
        for (int n = 0; n < 4; ++n) acc[n] = (f32x4){0.f, 0.f, 0.f, 0.f};
#pragma unroll
        for (int kk = 0; kk < 8; ++kk) {
            const int ks = wid * 8 + kk;
            const bf16x8 a = *(const bf16x8*)(arow + (size_t)(ks >> 1) * NMAIN + (ks & 1) * 32);
#pragma unroll
            for (int n = 0; n < 4; ++n) {
                const bf16x8 bb = *(const bf16x8*)(w1 + (size_t)n * 16 * 2048 + ks * 32);
                acc[n] = __builtin_amdgcn_mfma_f32_16x16x32_bf16(a, bb, acc[n], 0, 0, 0);
            }
        }
#pragma unroll
        for (int n = 0; n < 4; ++n)
#pragma unroll
            for (int r = 0; r < 4; ++r) part[wid * 1024 + (fq * 4 + r) * 64 + n * 16 + fr] = acc[n][r];
        __syncthreads();
        const float* b1 = p.b1c + (l * 2 + which) * 8 * 64;
#pragma unroll
        for (int i = 0; i < 2; ++i) {
            const int e = tid + NTHR * i; float sum = 0.f, bsum = 0.f;
#pragma unroll
            for (int w = 0; w < 8; ++w) { sum += part[w * 1024 + e]; bsum += b1[w * 64 + (e & 63)]; }
            h1[e] = f2bf(gelu_tanh(sum + bsum));
        }
        __syncthreads();
        if (wid == 0) {
            const bf16_t* w2 = p.W2T + ((size_t)(l * 2 + which) * 64 + fr) * 64 + fq * 8;
            f32x4 o2[4];
#pragma unroll
            for (int n = 0; n < 4; ++n) o2[n] = (f32x4){0.f, 0.f, 0.f, 0.f};
#pragma unroll
            for (int ks = 0; ks < 2; ++ks) {
                const bf16x8 a = *(const bf16x8*)(h1 + fr * 64 + ks * 32 + fq * 8);
#pragma unroll
                for (int n = 0; n < 4; ++n) {
                    const bf16x8 bb = *(const bf16x8*)(w2 + (size_t)n * 16 * 64 + ks * 32);
                    o2[n] = __builtin_amdgcn_mfma_f32_16x16x32_bf16(a, bb, o2[n], 0, 0, 0);
                }
            }
            const size_t base = ((size_t)b * 2 + kvh) * 128 * 64;
#pragma unroll
            for (int n = 0; n < 4; ++n)
#pragma unroll
                for (int r = 0; r < 4; ++r) {
                    const int c = ct * 16 + fq * 4 + r, j2 = n * 16 + fr;
                    const bf16_t v = c < 127 ? f2bf(o2[n][r]) : (bf16_t)0;
                    if (which == 0) p.kc[base + (size_t)c * 64 + j2] = v;
                    else { p.vc[base + (size_t)c * 64 + j2] = v; p.vcT[base + (size_t)j2 * 128 + c] = v; }
                }
        }
        __syncthreads();
    }
}

constexpr float L2E = 1.4426950408889634f, MASKV = -__builtin_huge_valf(), MINIT = -1e30f, SCL2 = QSCALE * L2E;
struct KVFrag { bf16x8 k[2][2]; bf16x8 v[4]; };
template <bool FM>
__device__ __forceinline__ void k_load(KVFrag& f, const bf16_t* __restrict__ Kb, size_t ldk, int kc0, int fr, int fq) {
    if (FM) {
        const bf16_t* kp = Kb + (size_t)(kc0 >> 5) * 2048 + (fq * 16 + fr) * 8;
        f.k[0][0] = *(const bf16x8*)(kp); f.k[0][1] = *(const bf16x8*)(kp + 512); f.k[1][0] = *(const bf16x8*)(kp + 1024); f.k[1][1] = *(const bf16x8*)(kp + 1536);
    } else {
        const bf16_t* kp = Kb + (size_t)(kc0 + (fr >> 2) * 8 + (fr & 3)) * ldk + fq * 8;
        f.k[0][0] = *(const bf16x8*)(kp); f.k[0][1] = *(const bf16x8*)(kp + 32);
        f.k[1][0] = *(const bf16x8*)(kp + 4 * ldk); f.k[1][1] = *(const bf16x8*)(kp + 4 * ldk + 32);
    }
}
template <bool FM>
__device__ __forceinline__ void v_load(bf16x8 (&v)[4], const bf16_t* __restrict__ VTb, size_t ldv, int kc0, int fr, int fq) {
    if (FM) {
        const bf16_t* vp = VTb + (size_t)(kc0 >> 5) * 2048 + (fq * 16 + fr) * 8;
#pragma unroll
        for (int dt = 0; dt < 4; ++dt) v[dt] = *(const bf16x8*)(vp + dt * 512);
    } else {
        const bf16_t* vp = VTb + (size_t)fr * ldv + kc0 + fq * 8;
#pragma unroll
        for (int dt = 0; dt < 4; ++dt) v[dt] = *(const bf16x8*)(vp + (size_t)dt * 16 * ldv);
    }
}
__device__ __forceinline__ float rowmax4(float x) {
    auto r = __builtin_amdgcn_permlane32_swap(__float_as_uint(x), __float_as_uint(x), false, false);
    x = __builtin_amdgcn_fmed3f(__uint_as_float(r[0]), __uint_as_float(r[1]), 3.0e38f);
    auto q = __builtin_amdgcn_permlane16_swap(__float_as_uint(x), __float_as_uint(x), false, false);
    return __builtin_amdgcn_fmed3f(__uint_as_float(q[0]), __uint_as_float(q[1]), 3.0e38f);
}
__device__ __forceinline__ float rowsum4(float x) {
    auto r = __builtin_amdgcn_permlane32_swap(__float_as_uint(x), __float_as_uint(x), false, false);
    x = __uint_as_float(r[0]) + __uint_as_float(r[1]);
    auto q = __builtin_amdgcn_permlane16_swap(__float_as_uint(x), __float_as_uint(x), false, false);
    return __uint_as_float(q[0]) + __uint_as_float(q[1]);
}
template <int NQT, bool MASK, class MB>
__device__ __forceinline__ void attn_compute(const KVFrag& f, const bf16x8 (&qf)[NQT][2], f32x4 (&o)[NQT][4], float (&m)[NQT], float (&l)[NQT], const MB& mb) {
    f32x4 s0[NQT], s1[NQT];
#pragma unroll
    for (int qt = 0; qt < NQT; ++qt) {
        s0[qt] = __builtin_amdgcn_mfma_f32_16x16x32_bf16(f.k[0][0], qf[qt][0], (f32x4){0.f, 0.f, 0.f, 0.f}, 0, 0, 0);
        s1[qt] = __builtin_amdgcn_mfma_f32_16x16x32_bf16(f.k[1][0], qf[qt][0], (f32x4){0.f, 0.f, 0.f, 0.f}, 0, 0, 0);
    }
#pragma unroll
    for (int qt = 0; qt < NQT; ++qt) {
        s0[qt] = __builtin_amdgcn_mfma_f32_16x16x32_bf16(f.k[0][1], qf[qt][1], s0[qt], 0, 0, 0);
        s1[qt] = __builtin_amdgcn_mfma_f32_16x16x32_bf16(f.k[1][1], qf[qt][1], s1[qt], 0, 0, 0);
    }
    float mx[NQT];
#pragma unroll
    for (int qt = 0; qt < NQT; ++qt) {
#pragma unroll
        for (int j = 0; j < 4; ++j) { s0[qt][j] = mb(qt, j, s0[qt][j]); s1[qt][j] = mb(qt, j + 4, s1[qt][j]); }
        mx[qt] = fmaxf(fmaxf(fmaxf(s0[qt][0], s0[qt][1]), fmaxf(s0[qt][2], s0[qt][3])), fmaxf(fmaxf(s1[qt][0], s1[qt][1]), fmaxf(s1[qt][2], s1[qt][3])));
    }
#pragma unroll
    for (int qt = 0; qt < NQT; ++qt) mx[qt] = rowmax4(mx[qt]);
    bool moved = false;
#pragma unroll
    for (int qt = 0; qt < NQT; ++qt) { mx[qt] = __builtin_amdgcn_fmed3f(m[qt], mx[qt], 3.0e38f); moved |= (mx[qt] != m[qt]); }
    if (__ballot(moved) != 0ull) {
#pragma unroll
        for (int qt = 0; qt < NQT; ++qt) {
            const float alpha = __builtin_amdgcn_exp2f(m[qt] - mx[qt]);
            l[qt] *= alpha;
#pragma unroll
            for (int dt = 0; dt < 4; ++dt) o[qt][dt] *= alpha;
        }
    }
    bf16x8 pf[NQT];
#pragma unroll
    for (int qt = 0; qt < NQT; ++qt) {
        m[qt] = mx[qt];
        float pr[8]; float ps = 0.f;
#pragma unroll
        for (int j = 0; j < 4; ++j) {
            pr[j] = __builtin_amdgcn_exp2f(s0[qt][j] - mx[qt]);
            pr[j + 4] = __builtin_amdgcn_exp2f(s1[qt][j] - mx[qt]);
        }
#pragma unroll
        for (int j = 0; j < 8; ++j) ps += pr[j];
        l[qt] += ps;
        const u32x4 pk = {pack2(pr[0], pr[1]), pack2(pr[2], pr[3]), pack2(pr[4], pr[5]), pack2(pr[6], pr[7])};
        pf[qt] = __builtin_bit_cast(bf16x8, pk);
    }
#pragma unroll
    for (int dt = 0; dt < 4; ++dt)
#pragma unroll
        for (int qt = 0; qt < NQT; ++qt) o[qt][dt] = __builtin_amdgcn_mfma_f32_16x16x32_bf16(f.v[dt], pf[qt], o[qt][dt], 0, 0, 0);
    __builtin_amdgcn_sched_barrier(0);
}
struct RangeIt { int c, c_hi; __device__ __forceinline__ int nxt() { if (c > c_hi) return -1; return (c++) * 32; } };
struct MaskIt { unsigned long long cm; __device__ __forceinline__ int nxt() { if (!cm) return -1; const int i = __builtin_ctzll(cm); cm &= cm - 1; return i * 32; } };
template <bool PFV, bool FM, class It, class Gen>
__device__ __forceinline__ void attn_run(It& it, const bf16_t* Kb, size_t ldk, const bf16_t* VTb, size_t ldv, int fr, int fq, const Gen& gen) {
    KVFrag fa, fb;
    int ka = it.nxt(); if (ka < 0) return;
    k_load<FM>(fa, Kb, ldk, ka, fr, fq); if (PFV) v_load<FM>(fa.v, VTb, ldv, ka, fr, fq);
    for (;;) {
        const int kb = it.nxt(); if (kb >= 0) { k_load<FM>(fb, Kb, ldk, kb, fr, fq); if (PFV) v_load<FM>(fb.v, VTb, ldv, kb, fr, fq); }
        if (!PFV) v_load<FM>(fa.v, VTb, ldv, ka, fr, fq);
        gen(ka, fa);
        if (kb < 0) break;
        ka = it.nxt(); if (ka >= 0) { k_load<FM>(fa, Kb, ldk, ka, fr, fq); if (PFV) v_load<FM>(fa.v, VTb, ldv, ka, fr, fq); }
        if (!PFV) v_load<FM>(fb.v, VTb, ldv, kb, fr, fq);
        gen(kb, fb);
        if (ka < 0) break;
    }
}
template <int NQT>
__device__ __forceinline__ void attn_init(f32x4 (&o)[NQT][4], float (&m)[NQT], float (&l)[NQT]) {
#pragma unroll
    for (int qt = 0; qt < NQT; ++qt) { m[qt] = MINIT; l[qt] = 0.f;
#pragma unroll
        for (int dt = 0; dt < 4; ++dt) o[qt][dt] = (f32x4){0.f, 0.f, 0.f, 0.f}; }
}
__device__ __forceinline__ float lsum4(float l) { return rowsum4(l); }
__device__ __forceinline__ void store_o16(unsigned char* dst, const f32x4 v0, const f32x4 v1, const f32x4 v2, const f32x4 v3) {
    u32x4 w; w.x = pack4_fp8(v0[0], v0[1], v0[2], v0[3]); w.y = pack4_fp8(v1[0], v1[1], v1[2], v1[3]); w.z = pack4_fp8(v2[0], v2[1], v2[2], v2[3]); w.w = pack4_fp8(v3[0], v3[1], v3[2], v3[3]);
    *(u32x4*)dst = w;
}
__device__ __forceinline__ float sigmoidf_fast(float x) { return __builtin_amdgcn_rcpf(1.0f + __builtin_amdgcn_exp2f(-L2E * x)); }

__device__ __forceinline__ void fox_unit(const Params& p, int b, int h, int qb, int fr, int fq) {
    asm volatile("" : "+v"(fr), "+v"(fq));
    const int t0 = qb * 64;
    const bf16_t* Qb = p.hb + ((size_t)b * SEQ + t0) * NMAIN + C_FQ + h * 64 + fq * 8;
    bf16x8 qf[4][2];
#pragma unroll
    for (int qt = 0; qt < 4; ++qt) { qf[qt][0] = *(const bf16x8*)(Qb + (size_t)(qt * 16 + fr) * NMAIN); qf[qt][1] = *(const bf16x8*)(Qb + (size_t)(qt * 16 + fr) * NMAIN + 32); }
    const float* cf = p.cF + ((size_t)b * 4 + h) * SEQ;
    float cq[4];
#pragma unroll
    for (int qt = 0; qt < 4; ++qt) cq[qt] = cf[t0 + qt * 16 + fr] * L2E;
    f32x4 o[4][4]; float m[4], l[4];
    attn_init<4>(o, m, l);
    const bf16_t* Kb = p.kF + ((size_t)b * NVH + h) * 64 * SEQ;
    const bf16_t* VTb = p.vT + ((size_t)b * NVH + h) * 64 * SEQ;
    RangeIt it{0, (t0 >> 5) + 1};
    attn_run<false, true>(it, Kb, NMAIN, VTb, SEQ, fr, fq, [&](int kc0, const KVFrag& f) {
        const float4 ca = *(const float4*)(cf + kc0 + 8 * fq), cb = *(const float4*)(cf + kc0 + 8 * fq + 4);
        const float ck[8] = {ca.x * L2E, ca.y * L2E, ca.z * L2E, ca.w * L2E, cb.x * L2E, cb.y * L2E, cb.z * L2E, cb.w * L2E};
        const int kq = kc0 + 8 * fq - t0 - fr;
        attn_compute<4, true>(f, qf, o, m, l, [&](int qt, int j, float raw) { return (kq + j - 16 * qt) > 0 ? MASKV : raw * SCL2 + cq[qt] - ck[j]; });
    });
#pragma unroll
    for (int qt = 0; qt < 4; ++qt) {
        const float inv = __builtin_amdgcn_rcpf(lsum4(l[qt]));
        unsigned char* dst = (unsigned char*)p.ob + ((size_t)b * SEQ + t0 + qt * 16 + fr) * DM + h * 64 + 16 * fq;
        store_o16(dst, o[qt][0] * inv, o[qt][1] * inv, o[qt][2] * inv, o[qt][3] * inv);
    }
}
__device__ __forceinline__ void swa_unit(const Params& p, int l_, int b, int kv, int pos, int fr, int fq) {
    asm volatile("" : "+v"(fr), "+v"(fq));
    const int t0 = pos * 16, t = t0 + fr;
    const bf16_t* Qb = p.hb + ((size_t)b * SEQ + t) * NMAIN + C_SQ + kv * 192 + fq * 8;
    bf16x8 qf[3][2];
#pragma unroll
    for (int g = 0; g < 3; ++g) { qf[g][0] = *(const bf16x8*)(Qb + g * 64); qf[g][1] = *(const bf16x8*)(Qb + g * 64 + 32); }
    float sl[3];
#pragma unroll
    for (int g = 0; g < 3; ++g) sl[g] = slope_swa(kv * 3 + g) * L2E;
    f32x4 o[3][4]; float m[3], l[3];
    attn_init<3>(o, m, l);
    const bf16_t* Kb = p.kF + ((size_t)b * NVH + 4 + kv) * 64 * SEQ;
    const bf16_t* VTb = p.vT + ((size_t)b * NVH + 4 + kv) * 64 * SEQ;
    RangeIt it{max(0, t0 - 127) >> 5, (t0 + 15) >> 5};
    attn_run<true, true>(it, Kb, NMAIN, VTb, SEQ, fr, fq, [&](int kc0, const KVFrag& f) {
        const int dq = t - kc0 - 8 * fq;
        attn_compute<3, true>(f, qf, o, m, l, [&](int g, int j, float raw) { const int dist = dq - j; return ((unsigned)dist < 128u) ? raw * SCL2 - sl[g] * (float)dist : MASKV; });
    });
#pragma unroll
    for (int g = 0; g < 3; ++g) {
        const float sink = p.sinks[l_ * 6 + kv * 3 + g] * L2E;
        const float inv = __builtin_amdgcn_rcpf(lsum4(l[g]) + __builtin_amdgcn_exp2f(sink - m[g]));
        unsigned char* dst = (unsigned char*)p.ob + ((size_t)b * SEQ + t) * DM + 256 + (kv * 3 + g) * 64 + 16 * fq;
        store_o16(dst, o[g][0] * inv, o[g][1] * inv, o[g][2] * inv, o[g][3] * inv);
    }
}
__device__ __forceinline__ void nsa_unit(const Params& p, int b, int kv, int pos, int fr, int fq, int lane, float* ps, unsigned* msk, float* otl) {
    asm volatile("" : "+v"(fr), "+v"(fq), "+v"(lane));
    const int t0 = pos * 16, t = t0 + fr, cur = t0 >> 6;
    const bf16_t* Qb = p.hb + ((size_t)b * SEQ + t) * NMAIN + C_NQ + kv * 192 + fq * 8;
    bf16x8 qf[3][2];
#pragma unroll
    for (int g = 0; g < 3; ++g) { qf[g][0] = *(const bf16x8*)(Qb + g * 64); qf[g][1] = *(const bf16x8*)(Qb + g * 64 + 32); }
    float sl[3];
#pragma unroll
    for (int g = 0; g < 3; ++g) sl[g] = slope_nsa(kv * 3 + g) * L2E;
    const float* gl = p.hs + ((size_t)b * SEQ + t) * HS_W + 4 + kv * 9;
    f32x4 o[3][4]; float m[3], l[3];
    f32x4* otv = (f32x4*)otl + lane;
#pragma unroll
    for (int i = 0; i < 8; ++i) ps[lane + 64 * i] = 0.f;
    {
        const bf16_t* Kb = p.kc + ((size_t)b * 2 + kv) * 128 * 64;
        const bf16_t* VTb = p.vcT + ((size_t)b * 2 + kv) * 64 * 128;
        const int ncv = (t0 + 15 >= 31) ? ((t0 + 15 - 31) >> 4) + 1 : 0;
        const int nch = (ncv + 31) >> 5;
        attn_init<3>(o, m, l);
        const int dq0 = t - 31 - 16 * 8 * fq;
        RangeIt it{0, nch - 1};
        attn_run<false, false>(it, Kb, 64, VTb, 128, fr, fq, [&](int kc0, const KVFrag& f) {
            const int dq = dq0 - 16 * kc0;
            attn_compute<3, true>(f, qf, o, m, l, [&](int g, int j, float raw) { const int dist = dq - 16 * j; return dist >= 0 ? raw * SCL2 - sl[g] * (float)dist : MASKV; });
        });
        float il[3];
#pragma unroll
        for (int g = 0; g < 3; ++g) {
            const float lt = lsum4(l[g]); il[g] = lt > 0.f ? __builtin_amdgcn_rcpf(lt) : 0.f;
            const float gate = sigmoidf_fast(gl[g * 3 + 0]);
#pragma unroll
            for (int dt = 0; dt < 4; ++dt) otv[(g * 4 + dt) * 64] = o[g][dt] * (il[g] * gate);
        }
        float carry_prev = 0.f;
        for (int c = 0; c < nch; ++c) {
            const int kc0 = c * 32, dq = dq0 - 16 * kc0;
            const bf16_t* kp = Kb + (size_t)(kc0 + (fr >> 2) * 8 + (fr & 3)) * 64 + fq * 8;
            const bf16x8 k00 = *(const bf16x8*)(kp), k01 = *(const bf16x8*)(kp + 32), k10 = *(const bf16x8*)(kp + 256), k11 = *(const bf16x8*)(kp + 256 + 32);
            float pc[8];
#pragma unroll
            for (int j = 0; j < 8; ++j) pc[j] = 0.f;
#pragma unroll
            for (int g = 0; g < 3; ++g) {
                f32x4 s0 = (f32x4){0.f, 0.f, 0.f, 0.f}, s1 = s0;
                s0 = __builtin_amdgcn_mfma_f32_16x16x32_bf16(k00, qf[g][0], s0, 0, 0, 0); s0 = __builtin_amdgcn_mfma_f32_16x16x32_bf16(k01, qf[g][1], s0, 0, 0, 0);
                s1 = __builtin_amdgcn_mfma_f32_16x16x32_bf16(k10, qf[g][0], s1, 0, 0, 0); s1 = __builtin_amdgcn_mfma_f32_16x16x32_bf16(k11, qf[g][1], s1, 0, 0, 0);
#pragma unroll
                for (int j = 0; j < 8; ++j) {
                    const int dist = dq - 16 * j; const float raw = j < 4 ? s0[j] : s1[j - 4];
                    if (dist >= 0) pc[j] += __builtin_amdgcn_exp2f(raw * SCL2 - sl[g] * (float)dist - m[g]) * il[g];
                }
            }
            const float cout = 0.5f * pc[7];
            float cin = shfl_f(cout, lane - 16);
            const float cwrap = shfl_f(cout, fr + 48);
            if (fq == 0) cin = carry_prev;
            carry_prev = cwrap;
            const int n0 = (kc0 >> 2) + 2 * fq;
            ps[fr * 32 + n0] = cin + pc[0] + pc[1] + pc[2] + 0.5f * pc[3];
            ps[fr * 32 + n0 + 1] = 0.5f * pc[3] + pc[4] + pc[5] + pc[6] + 0.5f * pc[7];
        }
    }
    lds_wave_sync();
    if (lane < 16) {
        unsigned mask = 1u | (1u << cur); if (cur >= 1) mask |= 1u << (cur - 1);
        if (cur >= 3) {
            if (cur - 2 <= 5) mask |= (1u << (cur - 1)) - 2u;
            else {
                const float* my = ps + lane * 32;
                for (int r = 0; r < 5; ++r) {
                    float best = -1.0f; int bi = 1;
                    for (int j = 1; j <= cur - 2; ++j) { const float v = my[j]; if (!((mask >> j) & 1u) && v > best) { best = v; bi = j; } }
                    mask |= 1u << bi;
                }
            }
        }
        msk[lane] = mask;
    }
    lds_wave_sync();
    const unsigned qmask = msk[fr];
    lds_wave_sync();
    {
        const bf16_t* Kb = p.kF + ((size_t)b * NVH + 6 + kv) * 64 * SEQ;
        const bf16_t* VTb = p.vT + ((size_t)b * NVH + 6 + kv) * 64 * SEQ;
        attn_init<3>(o, m, l);
        unsigned um = qmask;
        um |= shfl_u(um, lane ^ 1); um |= shfl_u(um, lane ^ 2); um |= shfl_u(um, lane ^ 4); um |= shfl_u(um, lane ^ 8);
        um = (unsigned)__builtin_amdgcn_readfirstlane((int)um) & (cur >= 31 ? 0xffffffffu : ((2u << cur) - 1u));
        unsigned long long cm = 0ull;
        for (unsigned r = um; r; r &= r - 1) { const int kb = __builtin_ctz(r); cm |= 3ull << (2 * kb); }
        MaskIt it{cm};
        attn_run<true, true>(it, Kb, NMAIN, VTb, SEQ, fr, fq, [&](int kc0, const KVFrag& f) {
            const bool mine = (qmask >> (kc0 >> 6)) & 1u;
            const int dq = t - kc0 - 8 * fq;
            attn_compute<3, true>(f, qf, o, m, l, [&](int g, int j, float raw) { const int dist = dq - j; return (mine && dist >= 0) ? raw * SCL2 - sl[g] * (float)dist : MASKV; });
        });
#pragma unroll
        for (int g = 0; g < 3; ++g) {
            const float lt = lsum4(l[g]); const float sc = (lt > 0.f ? __builtin_amdgcn_rcpf(lt) : 0.f) * sigmoidf_fast(gl[g * 3 + 1]);
#pragma unroll
            for (int dt = 0; dt < 4; ++dt) otv[(g * 4 + dt) * 64] += o[g][dt] * sc;
        }
    }
    {
        const bf16_t* Kb = p.kF + ((size_t)b * NVH + 8 + kv) * 64 * SEQ;
        const bf16_t* VTb = p.vT + ((size_t)b * NVH + 8 + kv) * 64 * SEQ;
        attn_init<3>(o, m, l);
        RangeIt it{max(0, t0 - 511) >> 5, (t0 + 15) >> 5};
        attn_run<true, true>(it, Kb, NMAIN, VTb, SEQ, fr, fq, [&](int kc0, const KVFrag& f) {
            const int dq = t - kc0 - 8 * fq;
            attn_compute<3, true>(f, qf, o, m, l, [&](int g, int j, float raw) { const int dist = dq - j; return ((unsigned)dist < 512u) ? raw * SCL2 - sl[g] * (float)dist : MASKV; });
        });
#pragma unroll
        for (int g = 0; g < 3; ++g) {
            const float lt = lsum4(l[g]); const float sc = (lt > 0.f ? __builtin_amdgcn_rcpf(lt) : 0.f) * sigmoidf_fast(gl[g * 3 + 2]);
            unsigned char* dst = (unsigned char*)p.ob + ((size_t)b * SEQ + t) * DM + 640 + (kv * 3 + g) * 64 + 16 * fq;
            store_o16(dst, otv[(g * 4 + 0) * 64] + o[g][0] * sc, otv[(g * 4 + 1) * 64] + o[g][1] * sc, otv[(g * 4 + 2) * 64] + o[g][2] * sc, otv[(g * 4 + 3) * 64] + o[g][3] * sc);
        }
    }
}

template <bool WITH_CONV>
__device__ __forceinline__ void phase_attn(const Params& p, int l, char* lds, int cslot = 16) {
    int tid = threadIdx.x; asm volatile("" : "+v"(tid));
    const int wid = tid >> 6, lane = tid & 63, fr = lane & 15, fq = lane >> 4;
    float* ps = (float*)(lds + wid * 16896); unsigned* msk = (unsigned*)(ps + 512); float* otl = ps + 576;
    unsigned* ctr = p.ctrl + cslot + l;
    constexpr unsigned NU_NSA = NB * 2 * 128, NU_FOX = NB * 4 * 32, NU_SWA = NB * 2 * 128, NU_ATT = NU_NSA + NU_FOX + NU_SWA;
    for (;;) {
        unsigned u = 0;
        if (lane == 0) u = __hip_atomic_fetch_add(ctr, 1u, __ATOMIC_RELAXED, __HIP_MEMORY_SCOPE_AGENT);
        u = (unsigned)__builtin_amdgcn_readfirstlane((int)u);
        if (WITH_CONV) {
            constexpr unsigned CT = (unsigned)CONV_TILES / NL, TOTQ = NU_ATT + CT;
            if (u >= TOTQ) break;
            const unsigned a0 = (unsigned)(((unsigned long long)u * NU_ATT) / TOTQ), a1 = (unsigned)(((unsigned long long)(u + 1) * NU_ATT) / TOTQ);
            if (a1 == a0) { conv_tile_wave(p, (int)(l * CT + u - a0), lane, (unsigned char*)ps); continue; }
            u = a0;
        } else {
#ifndef ATT_REP
#define ATT_REP 1
#endif
            if (u >= ATT_REP * NU_ATT) break;
            if (ATT_REP > 1) u %= NU_ATT;
        }
        if (u < NU_NSA) { const int pos = 127 - (int)(u & 127), r = u >> 7; nsa_unit(p, r >> 1, r & 1, pos, fr, fq, lane, ps, msk, otl); }
        else if (u < NU_NSA + NU_FOX) { const unsigned v = u - NU_NSA; const int qb = 31 - (int)(v & 31), r = v >> 5; fox_unit(p, r >> 2, r & 3, qb, fr, fq); }
        else { const unsigned v = u - NU_NSA - NU_FOX; const int pos = 127 - (int)(v & 127), r = v >> 7; swa_unit(p, l, r >> 1, r & 1, pos, fr, fq); }
    }
}

__device__ __forceinline__ void phase_ln1_router(const Params& p, int l, char* lds) {
    int tid = threadIdx.x; asm volatile("" : "+v"(tid));
    const int wid = tid >> 6, lane = tid & 63, fr = lane & 15, fq = lane >> 4;
    float* lg = (float*)lds + wid * 512;
    int* lcnt = (int*)(lds + 16384); int* lbase = lcnt + 32;
    const float* g1 = p.ln1_g + l * DM; const float* b1 = p.ln1_b + l * DM;
    const float* rw = p.rwT + (size_t)l * NE * 1024; const float* rb = p.router_b + l * NE;
    unsigned* gcount = p.ctrl + 64 + l * NE;
    constexpr int RW_LDS = 20480, RW_PITCH = 2064;
    if (blockIdx.x < NTOK / 128) {
        const bf16_t* rwb = (const bf16_t*)p.rwT + (size_t)l * 64 * 1024;
#pragma unroll 4
        for (int i = 0; i < 16; ++i) { const int pc = wid * 16 + i, r = pc >> 1, q = pc & 1;
            __builtin_amdgcn_global_load_lds((const unsigned*)(rwb + (size_t)r * 1024 + q * 512 + lane * 8), (LAS unsigned*)((LAS char*)lds + RW_LDS + r * RW_PITCH + q * 1024), 16, 0, 0); }
    }
    for (int grp = blockIdx.x; grp < NTOK / 128; grp += gridDim.x) {
        const int tok0 = grp * 128 + wid * 16;
        if (tid < 32) lcnt[tid] = 0;
        float gg[16], bb[16];
#pragma unroll
        for (int j = 0; j < 4; ++j) { const float4 g4 = *(const float4*)(g1 + lane * 16 + j * 4), b4 = *(const float4*)(b1 + lane * 16 + j * 4);
            gg[4 * j] = g4.x; gg[4 * j + 1] = g4.y; gg[4 * j + 2] = g4.z; gg[4 * j + 3] = g4.w; bb[4 * j] = b4.x; bb[4 * j + 1] = b4.y; bb[4 * j + 2] = b4.z; bb[4 * j + 3] = b4.w; }
        u32x4 raw[4][2], xrw[4][2];
#pragma unroll
        for (int i = 0; i < 4; ++i) { const bf16_t* tr = (const bf16_t*)p.tbuf + (size_t)(tok0 + i) * DM + lane * 16; raw[i][0] = *(const u32x4*)tr; raw[i][1] = *(const u32x4*)(tr + 8);
            const bf16_t* xr_ = p.xb + (size_t)(tok0 + i) * DM + lane * 16; xrw[i][0] = *(const u32x4*)xr_; xrw[i][1] = *(const u32x4*)(xr_ + 8); }
#pragma unroll
        for (int r0 = 0; r0 < 16; r0 += 4) {
            float v[4][16]; float s[4], qv[4];
#pragma unroll
            for (int i = 0; i < 4; ++i) {
                const u32x4 t0 = raw[i][0], t1 = raw[i][1], x0 = xrw[i][0], x1 = xrw[i][1];
                const unsigned ts[8] = {t0.x, t0.y, t0.z, t0.w, t1.x, t1.y, t1.z, t1.w}, xs[8] = {x0.x, x0.y, x0.z, x0.w, x1.x, x1.y, x1.z, x1.w};
#pragma unroll
                for (int c = 0; c < 8; ++c) { v[i][2 * c] = __uint_as_float(xs[c] << 16) * ALPHA + __uint_as_float(ts[c] << 16); v[i][2 * c + 1] = __uint_as_float(xs[c] & 0xffff0000u) * ALPHA + __uint_as_float(ts[c] & 0xffff0000u); }
            }
            __builtin_amdgcn_sched_barrier(0);
            if (r0 < 12) {
#pragma unroll
                for (int i = 0; i < 4; ++i) { const bf16_t* tr = (const bf16_t*)p.tbuf + (size_t)(tok0 + r0 + 4 + i) * DM + lane * 16; raw[i][0] = *(const u32x4*)tr; raw[i][1] = *(const u32x4*)(tr + 8);
                    const bf16_t* xr_ = p.xb + (size_t)(tok0 + r0 + 4 + i) * DM + lane * 16; xrw[i][0] = *(const u32x4*)xr_; xrw[i][1] = *(const u32x4*)(xr_ + 8); }
            }
            __builtin_amdgcn_sched_barrier(0);
#pragma unroll
            for (int i = 0; i < 4; ++i) { s[i] = 0.f;
#pragma unroll
                for (int c = 0; c < 16; c += 4) s[i] += (v[i][c] + v[i][c + 1]) + (v[i][c + 2] + v[i][c + 3]); }
#pragma unroll
            for (int o = 32; o > 0; o >>= 1) {
#pragma unroll
                for (int i = 0; i < 4; ++i) s[i] += shfl_f(s[i], lane ^ o); }
#pragma unroll
            for (int i = 0; i < 4; ++i) { const float mean = s[i] * (1.0f / 1024.0f); qv[i] = 0.f;
#pragma unroll
                for (int c = 0; c < 16; c += 4) { v[i][c] -= mean; v[i][c + 1] -= mean; v[i][c + 2] -= mean; v[i][c + 3] -= mean;
                    qv[i] += (v[i][c] * v[i][c] + v[i][c + 1] * v[i][c + 1]) + (v[i][c + 2] * v[i][c + 2] + v[i][c + 3] * v[i][c + 3]); } }
#pragma unroll
            for (int o = 32; o > 0; o >>= 1) {
#pragma unroll
                for (int i = 0; i < 4; ++i) qv[i] += shfl_f(qv[i], lane ^ o); }
#pragma unroll
            for (int i = 0; i < 4; ++i) {
                const float rstd = rsqrtf(qv[i] * (1.0f / 1024.0f) + LN_EPS);
                const size_t row = (size_t)(tok0 + r0 + i);
                float y[16];
#pragma unroll
                for (int c = 0; c < 16; ++c) y[c] = v[i][c] * rstd * gg[c] + bb[c];
                u32x4 w0, w1, q;
                w0.x = pack2(y[0], y[1]); w0.y = pack2(y[2], y[3]); w0.z = pack2(y[4], y[5]); w0.w = pack2(y[6], y[7]);
                w1.x = pack2(y[8], y[9]); w1.y = pack2(y[10], y[11]); w1.z = pack2(y[12], y[13]); w1.w = pack2(y[14], y[15]);
                q.x = pack4_fp8(y[0], y[1], y[2], y[3]); q.y = pack4_fp8(y[4], y[5], y[6], y[7]); q.z = pack4_fp8(y[8], y[9], y[10], y[11]); q.w = pack4_fp8(y[12], y[13], y[14], y[15]);
                *(u32x4*)((bf16_t*)p.x1f + row * DM + lane * 16) = w0; *(u32x4*)((bf16_t*)p.x1f + row * DM + lane * 16 + 8) = w1;
                *(u32x4*)((char*)p.x1b + row * DM + lane * 16) = q;
            }
        }
        asm volatile("s_waitcnt vmcnt(0)" ::: "memory");
        __syncthreads();
        f32x4 a0 = (f32x4){0.f, 0.f, 0.f, 0.f}, a1 = a0;
        const bf16_t* xr = (const bf16_t*)p.x1f + (size_t)(tok0 + fr) * DM + 8 * fq;
        const LAS char* wl = (const LAS char*)lds + RW_LDS + fr * RW_PITCH + fq * 16;
#pragma unroll 8
        for (int ks = 0; ks < 32; ++ks) {
            const bf16x8 xa = *(const bf16x8*)(xr + ks * 32);
            a0 = __builtin_amdgcn_mfma_f32_16x16x32_bf16(xa, *(const LAS bf16x8*)(wl + ks * 64), a0, 0, 0, 0);
            a1 = __builtin_amdgcn_mfma_f32_16x16x32_bf16(xa, *(const LAS bf16x8*)(wl + 16 * RW_PITCH + ks * 64), a1, 0, 0, 0);
            a0 = __builtin_amdgcn_mfma_f32_16x16x32_bf16(xa, *(const LAS bf16x8*)(wl + 32 * RW_PITCH + ks * 64), a0, 0, 0, 0);
            a1 = __builtin_amdgcn_mfma_f32_16x16x32_bf16(xa, *(const LAS bf16x8*)(wl + 48 * RW_PITCH + ks * 64), a1, 0, 0, 0);
        }
#pragma unroll
        for (int r = 0; r < 4; ++r) { lg[(fq * 4 + r) * 32 + fr] = a0[r] + rb[fr]; lg[(fq * 4 + r) * 32 + 16 + fr] = a1[r] + rb[16 + fr]; }
        lds_wave_sync();
        int e4[4] = {0, 0, 0, 0}; int rk[4] = {0, 0, 0, 0};
        if (lane < 16) {
            const float* my = lg + lane * 32; unsigned taken = 0u; float tv[4];
#pragma unroll
            for (int k = 0; k < 4; ++k) {
                float best = NEG_INF; int bi = 0;
                for (int e = 0; e < 32; ++e) { const float xv = my[e]; if (!((taken >> e) & 1u) && xv > best) { best = xv; bi = e; } }
                taken |= 1u << bi; e4[k] = bi; tv[k] = best;
            }
            const float e1 = __expf(tv[1] - tv[0]), e2 = __expf(tv[2] - tv[0]), e3 = __expf(tv[3] - tv[0]);
            const float inv = 1.0f / (1.0f + e1 + e2 + e3);
            const size_t row = (size_t)(tok0 + lane);
            *(float4*)(p.gw + row * 4) = make_float4(inv, e1 * inv, e2 * inv, e3 * inv);
        }
        __syncthreads();
        if (lane < 16) {
#pragma unroll
            for (int k = 0; k < 4; ++k) rk[k] = atomicAdd(&lcnt[e4[k]], 1);
        }
        __syncthreads();
        if (tid < 32) { const int c = lcnt[tid]; lbase[tid] = c ? (int)__hip_atomic_fetch_add(gcount + tid, (unsigned)c, __ATOMIC_RELAXED, __HIP_MEMORY_SCOPE_AGENT) : 0; }
        __syncthreads();
        if (lane < 16) {
            const int row = tok0 + lane; int pk[4];
#pragma unroll
            for (int k = 0; k < 4; ++k) { const int pos = lbase[e4[k]] + rk[k]; p.lists[(size_t)e4[k] * LIST_CAP + pos] = row * 4 + k; pk[k] = (pos << 5) | e4[k]; }
            *(int4*)(p.top_e + (size_t)row * 4) = make_int4(pk[0], pk[1], pk[2], pk[3]);
        }
        __syncthreads();
    }
}

__device__ __forceinline__ void phase_ln2(const Params& p, int l, float* xout, char* lds) {
    int* ptile = (int*)(lds + LDS_TAB); int* ecnt = ptile + 40;
    int tid = threadIdx.x; asm volatile("" : "+v"(tid));
    const int wid = tid >> 6, lane = tid & 63;
    const float* g2 = p.ln2_g + l * DM; const float* b2 = p.ln2_b + l * DM;
    float gg[16], bb[16];
#pragma unroll
    for (int j = 0; j < 4; ++j) { const float4 g4 = *(const float4*)(g2 + lane * 16 + j * 4), b4 = *(const float4*)(b2 + lane * 16 + j * 4);
        gg[4 * j] = g4.x; gg[4 * j + 1] = g4.y; gg[4 * j + 2] = g4.z; gg[4 * j + 3] = g4.w; bb[4 * j] = b4.x; bb[4 * j + 1] = b4.y; bb[4 * j + 2] = b4.z; bb[4 * j + 3] = b4.w; }
    const int pstep = gridDim.x * NWV;
    int pr = blockIdx.x * NWV + wid;
    float4 gwn[2]; int4 ten[2];
    u32x4 yn[2][4], xn[2][2];
    float gk[2][4];
    auto load_meta = [&](int q) {
#pragma unroll
        for (int i = 0; i < 2; ++i) { const int row = q * 2 + i; gwn[i] = *(const float4*)(p.gw + (size_t)row * 4); ten[i] = *(const int4*)(p.top_e + (size_t)row * 4); }
    };
    auto load_rows = [&](int q) {
#pragma unroll
        for (int i = 0; i < 2; ++i) {
            const int row = q * 2 + i;
            const int tk[4] = {ten[i].x, ten[i].y, ten[i].z, ten[i].w};
            xn[i][0] = *(const u32x4*)((const bf16_t*)p.x1f + (size_t)row * DM + lane * 16); xn[i][1] = *(const u32x4*)((const bf16_t*)p.x1f + (size_t)row * DM + lane * 16 + 8);
#pragma unroll
            for (int k = 0; k < 4; ++k) yn[i][k] = *(const u32x4*)((const unsigned char*)p.ybuf + (size_t)(ptile[tk[k] & 31] * 256 + (tk[k] >> 5)) * DM + lane * 16);
        }
    };
    if (pr < NTOK / 2) { load_meta(pr); load_rows(pr); }
#pragma unroll
    for (int i = 0; i < 2; ++i) { gk[i][0] = gwn[i].x; gk[i][1] = gwn[i].y; gk[i][2] = gwn[i].z; gk[i][3] = gwn[i].w; }
    if (pr + pstep < NTOK / 2) load_meta(pr + pstep);
    for (; pr < NTOK / 2; pr += pstep) {
        float v[2][16]; float s[2], qv[2];
#pragma unroll
        for (int i = 0; i < 2; ++i) { s[i] = 0.f;
            const unsigned xs[8] = {xn[i][0].x, xn[i][0].y, xn[i][0].z, xn[i][0].w, xn[i][1].x, xn[i][1].y, xn[i][1].z, xn[i][1].w};
#pragma unroll
            for (int c = 0; c < 8; ++c) { v[i][2 * c] = __uint_as_float(xs[c] << 16) * ALPHA; v[i][2 * c + 1] = __uint_as_float(xs[c] & 0xffff0000u) * ALPHA; }
#pragma unroll
            for (int k = 0; k < 4; ++k) {
                const unsigned ys[4] = {yn[i][k].x, yn[i][k].y, yn[i][k].z, yn[i][k].w};
#pragma unroll
                for (int c = 0; c < 4; ++c) {
                    const f32x2_t lo = __builtin_amdgcn_cvt_pk_f32_fp8(ys[c], false), hi = __builtin_amdgcn_cvt_pk_f32_fp8(ys[c], true);
                    v[i][4 * c] += gk[i][k] * lo.x; v[i][4 * c + 1] += gk[i][k] * lo.y; v[i][4 * c + 2] += gk[i][k] * hi.x; v[i][4 * c + 3] += gk[i][k] * hi.y;
                }
            }
#pragma unroll
            for (int c = 0; c < 16; c += 4) s[i] += (v[i][c] + v[i][c + 1]) + (v[i][c + 2] + v[i][c + 3]);
        }
        __builtin_amdgcn_sched_barrier(0);
        if (pr + pstep < NTOK / 2) {
#pragma unroll
            for (int i = 0; i < 2; ++i) { gk[i][0] = gwn[i].x; gk[i][1] = gwn[i].y; gk[i][2] = gwn[i].z; gk[i][3] = gwn[i].w; }
            load_rows(pr + pstep);
            if (pr + 2 * pstep < NTOK / 2) load_meta(pr + 2 * pstep);
        }
        __builtin_amdgcn_sched_barrier(0);
#pragma unroll
        for (int o = 32; o > 0; o >>= 1) { s[0] += shfl_f(s[0], lane ^ o); s[1] += shfl_f(s[1], lane ^ o); }
#pragma unroll
        for (int i = 0; i < 2; ++i) { const float mean = s[i] * (1.0f / 1024.0f); qv[i] = 0.f;
#pragma unroll
            for (int c = 0; c < 16; c += 4) { v[i][c] -= mean; v[i][c + 1] -= mean; v[i][c + 2] -= mean; v[i][c + 3] -= mean;
                qv[i] += (v[i][c] * v[i][c] + v[i][c + 1] * v[i][c + 1]) + (v[i][c + 2] * v[i][c + 2] + v[i][c + 3] * v[i][c + 3]); } }
#pragma unroll
        for (int o = 32; o > 0; o >>= 1) { qv[0] += shfl_f(qv[0], lane ^ o); qv[1] += shfl_f(qv[1], lane ^ o); }
#pragma unroll
        for (int i = 0; i < 2; ++i) {
            const float rstd = rsqrtf(qv[i] * (1.0f / 1024.0f) + LN_EPS);
            const size_t row = (size_t)(pr * 2 + i);
            float y[16];
#pragma unroll
            for (int c = 0; c < 16; ++c) y[c] = v[i][c] * rstd * gg[c] + bb[c];
            if (l + 1 < NL) {
                u32x4 w0, w1, q;
                w0.x = pack2(y[0], y[1]); w0.y = pack2(y[2], y[3]); w0.z = pack2(y[4], y[5]); w0.w = pack2(y[6], y[7]);
                w1.x = pack2(y[8], y[9]); w1.y = pack2(y[10], y[11]); w1.z = pack2(y[12], y[13]); w1.w = pack2(y[14], y[15]);
                q.x = pack4_fp8(y[0], y[1], y[2], y[3]); q.y = pack4_fp8(y[4], y[5], y[6], y[7]); q.z = pack4_fp8(y[8], y[9], y[10], y[11]); q.w = pack4_fp8(y[12], y[13], y[14], y[15]);
                *(u32x4*)(p.xb + row * DM + lane * 16) = w0; *(u32x4*)(p.xb + row * DM + lane * 16 + 8) = w1;
                *(u32x4*)(p.xq + row * DM + lane * 16) = q;
            } else {
#pragma unroll
                for (int c = 0; c < 16; c += 4) *(float4*)(xout + row * DM + lane * 16 + c) = make_float4(y[c], y[c + 1], y[c + 2], y[c + 3]);
            }
        }
    }
}

#define XB_TMO      128
#define XB_XCNT(j)  (256  + 64 * (j))
#define XB_XSUB(j)  (1280 + 64 * (j))
#define XB_XGEN(j)  (2304 + 64 * (j))
#define XB_TOP      3328
#define XB_TOPGEN   3392
#define XCD_BAR_WORDS 3456
#define XB_SPIN_CAP (1u << 22)
__device__ __forceinline__ unsigned xb_ld(unsigned* p)              { return __hip_atomic_load(p, __ATOMIC_RELAXED, __HIP_MEMORY_SCOPE_AGENT); }
__device__ __forceinline__ unsigned xb_add(unsigned* p, unsigned v) { return __hip_atomic_fetch_add(p, v, __ATOMIC_RELAXED, __HIP_MEMORY_SCOPE_AGENT); }
__device__ __forceinline__ unsigned xb_xcc_id() { return (unsigned)__builtin_amdgcn_s_getreg((3 << 11) | 20) & 0xFu; }
#define XB_SPIN(cond, bar) do { unsigned _sp = 0; while (cond) { __builtin_amdgcn_s_sleep(1); \
    if ((++_sp & 255u) == 0u) { if (xb_ld(&(bar)[XB_TMO])) break; if (_sp > XB_SPIN_CAP) { atomicAdd(&(bar)[XB_TMO], 1u); break; } } } } while (0)
struct XcdBarrier { unsigned* bar; unsigned x; volatile LAS unsigned* st; };
__device__ __forceinline__ XcdBarrier xcd_barrier_post(unsigned* bar, volatile LAS unsigned* st) {
    XcdBarrier b; b.bar = bar; b.x = xb_xcc_id(); b.st = st;
    if (threadIdx.x == 0) (void)xb_add(&bar[XB_XCNT(b.x)], 1u);
    return b;
}
__device__ __forceinline__ void xcd_barrier_complete(unsigned* bar, unsigned x, unsigned& nloc, unsigned& nx) {
    const unsigned G = gridDim.x * gridDim.y * gridDim.z;
    unsigned sum, cnt, mine, sp = 0u;
    for (;;) {
        sum = 0u; cnt = 0u; mine = 0u;
#pragma unroll
        for (unsigned j = 0; j < 16; ++j) { const unsigned c = xb_ld(&bar[XB_XCNT(j)]); sum += c; cnt += (c > 0u) ? 1u : 0u; mine = (j == x) ? c : mine; }
        if (sum == G) break;
        __builtin_amdgcn_s_sleep(1);
        if ((++sp & 255u) == 0u) { if (xb_ld(&bar[XB_TMO])) break; if (sp > XB_SPIN_CAP) { atomicAdd(&bar[XB_TMO], 1u); break; } }
    }
    nloc = mine > 0u ? mine : 1u; nx = cnt > 0u ? cnt : 1u;
}
__device__ __forceinline__ void xcd_barrier(const XcdBarrier& b) {
    asm volatile("s_waitcnt vmcnt(0)" ::: "memory");
    __syncthreads();
    if (threadIdx.x == 0) {
        unsigned* bar = b.bar;
        __builtin_amdgcn_s_waitcnt(0);
        unsigned nloc = b.st[0], nx = b.st[1];
        if (nloc == 0u) { xcd_barrier_complete(bar, b.x, nloc, nx); b.st[0] = nloc; b.st[1] = nx; }
        const unsigned old = xb_add(&bar[XB_XSUB(b.x)], 1u);
        const unsigned gen = old / nloc;
        if (old + 1u == (gen + 1u) * nloc) {
            __builtin_amdgcn_fence(__ATOMIC_RELEASE, "agent");
            asm volatile("s_waitcnt vmcnt(0)" ::: "memory");
            const unsigned og = xb_add(&bar[XB_TOP], 1u);
            const unsigned tg = og / nx;
            if (og + 1u == (tg + 1u) * nx) xb_add(&bar[XB_TOPGEN], 1u);
            else XB_SPIN(xb_ld(&bar[XB_TOPGEN]) == tg, bar);
            __builtin_amdgcn_fence(__ATOMIC_ACQUIRE, "agent");
            xb_add(&bar[XB_XGEN(b.x)], 1u);
            asm volatile("s_waitcnt vmcnt(0)" ::: "memory");
        } else {
            XB_SPIN(xb_ld(&bar[XB_XGEN(b.x)]) == gen, bar);
            __builtin_amdgcn_fence(__ATOMIC_ACQUIRE, "agent");
            asm volatile("s_waitcnt vmcnt(0)" ::: "memory");
        }
    }
    __syncthreads();
}

struct KArgs { const float* in[18]; float* out; char* ws; };
constexpr size_t al256(size_t v) { return (v + 255) / 256 * 256; }
struct WSL {
    static constexpr size_t ctrl = 0;
    static constexpr size_t WinT = al256(ctrl + 65536);
    static constexpr size_t WoT = al256(WinT + (size_t)NL * NPAD * 1024 * 2);
    static constexpr size_t W1T = al256(WoT + (size_t)NL * 1024 * 1024 * 2);
    static constexpr size_t W2T = al256(W1T + (size_t)NL * 2 * 64 * 2048 * 2);
    static constexpr size_t WguT = al256(W2T + (size_t)NL * 2 * 64 * 64 * 2);
    static constexpr size_t WdnT = al256(WguT + (size_t)NL * NE * 2048 * 1024 * 2);
    static constexpr size_t rwT = al256(WdnT + (size_t)NL * NE * 1024 * 1024 * 2);
    static constexpr size_t binp = al256(rwT + (size_t)NL * NE * 1024 * 4);
    static constexpr size_t bgup = al256(binp + (size_t)NL * NPAD * 4);
    static constexpr size_t b1c = al256(bgup + (size_t)NL * NE * 2048 * 4);
    static constexpr size_t xf = al256(b1c + 4 * 8 * 64 * 4);
    static constexpr size_t xb = al256(xf + (size_t)NTOK * DM * 4);
    static constexpr size_t hb = al256(xb + (size_t)NTOK * DM * 2);
    static constexpr size_t hs = al256(hb + (size_t)NTOK * NMAIN * 2);
    static constexpr size_t vT = al256(hs + (size_t)NTOK * HS_W * 4);
    static constexpr size_t kF = al256(vT + (size_t)NB * NVH * 64 * SEQ * 2);
    static constexpr size_t cF = al256(kF + (size_t)NB * NVH * 64 * SEQ * 2);
    static constexpr size_t kc = al256(cF + (size_t)NB * 4 * SEQ * 4);
    static constexpr size_t vc = al256(kc + (size_t)NB * 2 * 128 * 64 * 2);
    static constexpr size_t vcT = al256(vc + (size_t)NB * 2 * 128 * 64 * 2);
    static constexpr size_t ob = al256(vcT + (size_t)NB * 2 * 128 * 64 * 2);
    static constexpr size_t tbuf = al256(ob + (size_t)NTOK * DM * 2);
    static constexpr size_t x1f = al256(tbuf + (size_t)NTOK * DM * 4);
    static constexpr size_t x1b = al256(x1f + (size_t)NTOK * DM * 4);
    static constexpr size_t top_e = al256(x1b + (size_t)NTOK * DM * 2);
    static constexpr size_t gw = al256(top_e + (size_t)NTOK * 4 * 4);
    static constexpr size_t lists = al256(gw + (size_t)NTOK * 4 * 4);
    static constexpr size_t act = al256(lists + (size_t)NE * LIST_CAP * 4);
    static constexpr size_t ybuf = al256(act + (size_t)MAXSLOT * DFF * 2);
    static constexpr size_t xq = al256(ybuf + (size_t)MAXSLOT * DM * 2);
    static constexpr size_t WinQ = al256(xq + (size_t)NTOK * DM);
    static constexpr size_t total = al256(WinQ + (size_t)NL * NMAIN * 1024);
};
__device__ __forceinline__ Params make_params(const KArgs& k) {
    Params p;
    p.x = k.in[0]; p.w_in = k.in[1]; p.b_in = k.in[2]; p.sinks = k.in[3]; p.cmp_pe = k.in[4]; p.cmp_w1 = k.in[5]; p.cmp_w2 = k.in[6]; p.w_out = k.in[7];
    p.ln1_g = k.in[8]; p.ln1_b = k.in[9]; p.router_w = k.in[10]; p.router_b = k.in[11]; p.w_gu = k.in[12]; p.b_gu = k.in[13]; p.w_dn = k.in[14]; p.b_dn = k.in[15];
    p.ln2_g = k.in[16]; p.ln2_b = k.in[17]; p.out = k.out;
    char* w = k.ws;
    p.ctrl = (unsigned*)(w + WSL::ctrl); p.WinT = (bf16_t*)(w + WSL::WinT); p.WoT = (bf16_t*)(w + WSL::WoT); p.W1T = (bf16_t*)(w + WSL::W1T); p.W2T = (bf16_t*)(w + WSL::W2T);
    p.WguT = (bf16_t*)(w + WSL::WguT); p.WdnT = (bf16_t*)(w + WSL::WdnT); p.rwT = (float*)(w + WSL::rwT); p.binp = (float*)(w + WSL::binp); p.bgup = (float*)(w + WSL::bgup);
    p.b1c = (float*)(w + WSL::b1c); p.xf = (float*)(w + WSL::xf); p.xb = (bf16_t*)(w + WSL::xb); p.hb = (bf16_t*)(w + WSL::hb); p.hs = (float*)(w + WSL::hs); p.vT = (bf16_t*)(w + WSL::vT); p.kF = (bf16_t*)(w + WSL::kF);
    p.cF = (float*)(w + WSL::cF); p.kc = (bf16_t*)(w + WSL::kc); p.vc = (bf16_t*)(w + WSL::vc); p.vcT = (bf16_t*)(w + WSL::vcT); p.ob = (bf16_t*)(w + WSL::ob); p.tbuf = (float*)(w + WSL::tbuf);
    p.x1f = (float*)(w + WSL::x1f); p.x1b = (bf16_t*)(w + WSL::x1b); p.top_e = (int*)(w + WSL::top_e); p.gw = (float*)(w + WSL::gw); p.lists = (int*)(w + WSL::lists);
    p.act = (bf16_t*)(w + WSL::act); p.ybuf = (bf16_t*)(w + WSL::ybuf); p.xq = (unsigned char*)(w + WSL::xq); p.WinQ = (unsigned char*)(w + WSL::WinQ);
    return p;
}
__device__ __forceinline__ void grid_bar(const Params& p, char* lds) {
    XcdBarrier xb; xb.bar = p.ctrl + 1024; xb.x = xb_xcc_id(); xb.st = (volatile LAS unsigned*)(lds + LDS_BYTES - 16); xcd_barrier(xb);
}
__device__ __forceinline__ Params fresh_params(const KArgs& ka) {
    KArgs k2 = ka; size_t z = 0; asm volatile("" : "+s"(z));
    k2.ws = ka.ws + z;
    return make_params(k2);
}
#ifndef REP
#define REP 0
#endif
template <int L>
__device__ __forceinline__ void layer_fwd(const KArgs& ka, char* lds) {
    { const Params p = fresh_params(ka); phase_inproj(p, L, lds);        grid_bar(p, lds); }
    { const Params p = fresh_params(ka); phase_prep(p, L, lds);          grid_bar(p, lds); }
    { const Params p = fresh_params(ka); phase_attn<true>(p, L, lds);  grid_bar(p, lds); }
    { const Params p = fresh_params(ka); phase_outproj(p, L, p.xb, lds);  grid_bar(p, lds); }
    { const Params p = fresh_params(ka); phase_ln1_router(p, L, lds);    grid_bar(p, lds); }
    { const Params p = fresh_params(ka); phase_gateup(p, L, lds);        grid_bar(p, lds); }
    { const Params p = fresh_params(ka); phase_down(p, L, lds);          grid_bar(p, lds); }
    { const Params p = fresh_params(ka); phase_ln2(p, L, L == NL - 1 ? p.out : p.xf, lds); }
}
__global__ void __launch_bounds__(NTHR, 2) fwd_kernel(KArgs ka) {
    extern __shared__ __attribute__((aligned(16))) char lds[];
    const Params p = make_params(ka);
    cg::grid_group grid = cg::this_grid();
    volatile LAS unsigned* xst = (volatile LAS unsigned*)(lds + LDS_BYTES - 16);
    if (threadIdx.x == 0) { xst[0] = 0u; xst[1] = 0u; }
    __syncthreads();
    (void)xcd_barrier_post(p.ctrl + 1024, xst);
    volatile LAS int* vcu = (volatile LAS int*)(lds + LDS_BYTES - 32);
    const unsigned myx = xb_xcc_id() & 7u;
    if (threadIdx.x == 0) vcu[1] = (int)__hip_atomic_fetch_add(p.ctrl + 32 + myx, 1u, __ATOMIC_RELAXED, __HIP_MEMORY_SCOPE_AGENT);
    phase0(p, lds);
    grid.sync();
    if (threadIdx.x == 0) {
        int base = 0, tot = 0;
        for (unsigned x = 0; x < 8; ++x) { const int n = (int)__hip_atomic_load(p.ctrl + 32 + x, __ATOMIC_RELAXED, __HIP_MEMORY_SCOPE_AGENT); if (x < myx) base += n; tot += n; }
        vcu[0] = (tot == (int)gridDim.x) ? base + vcu[1] : (int)blockIdx.x;
    }
    __syncthreads();
    layer_fwd<0>(ka, lds);
    grid_bar(p, lds);
    layer_fwd<1>(ka, lds);
}

extern "C" void kernel_launch(void* const* d_in, const int* in_sizes, int n_in, void* d_out, int out_size, void* d_ws, size_t ws_size, hipStream_t stream) {
    KArgs ka{};
    for (int i = 0; i < 18; ++i) ka.in[i] = (const float*)d_in[i];
    ka.out = (float*)d_out; ka.ws = (char*)d_ws;
    if (WSL::total > ws_size) { fprintf(stderr, "workspace too small: need %zu have %zu\n", (size_t)WSL::total, ws_size); return; }
    static int grid_blocks = 0;
    if (!grid_blocks) {
        int dev = 0, cus = 0, per_cu = 0;
        (void)hipGetDevice(&dev);
        (void)hipDeviceGetAttribute(&cus, hipDeviceAttributeMultiprocessorCount, dev);
        (void)hipFuncSetAttribute((const void*)fwd_kernel, hipFuncAttributeMaxDynamicSharedMemorySize, LDS_BYTES);
        (void)hipOccupancyMaxActiveBlocksPerMultiprocessor(&per_cu, fwd_kernel, NTHR, LDS_BYTES);
        if (per_cu < 1) { fprintf(stderr, "occupancy query says 0 blocks per CU\n"); per_cu = 1; }
        grid_blocks = cus;
    }
    (void)hipMemsetAsync(d_ws, 0, 65536, stream);
    void* args[] = {&ka};
    hipError_t e = hipLaunchCooperativeKernel((const void*)fwd_kernel, dim3(grid_blocks), dim3(NTHR), args, LDS_BYTES, stream);
    if (e != hipSuccess) fprintf(stderr, "cooperative launch failed: %s (grid %d)\n", hipGetErrorString(e), grid_blocks);
}
```

```cpp
#include <hip/hip_runtime.h>
#include <hip/hip_cooperative_groups.h>
#include <cstdio>
#include <cstdint>
namespace cg = cooperative_groups;

typedef unsigned short bf16_t;
typedef short bf16x8 __attribute__((ext_vector_type(8)));
typedef float f32x4 __attribute__((ext_vector_type(4)));
typedef unsigned u32x4 __attribute__((ext_vector_type(4)));
typedef unsigned u32x2 __attribute__((ext_vector_type(2)));
typedef int v8i_t __attribute__((ext_vector_type(8)));
typedef float f32x2_t __attribute__((ext_vector_type(2)));
typedef int v4i_t __attribute__((ext_vector_type(4)));
#define LAS __attribute__((address_space(3)))
constexpr float NEG_INF = -__builtin_huge_valf();

constexpr int DM = 1024, NB = 16, SEQ = 2048, NTOK = NB * SEQ, NL = 2;
constexpr int NCOL = 2582, NMAIN = 2560, NPAD = 2688, NE = 32, DFF = 1024;
constexpr int C_FQ = 0, C_FK = 256, C_FV = 512, C_SQ = 768, C_SK = 1152, C_SV = 1280, C_NQ = 1408,
              C_NKC = 1792, C_NVC = 1920, C_NKS = 2048, C_NVS = 2176, C_NKW = 2304, C_NVW = 2432;
constexpr int HS_W = 32;
constexpr int NVH = 10;
constexpr int LIST_CAP = NTOK;
constexpr int MAXSLOT = NTOK * 4 + NE * 256;
constexpr float ALPHA = 1.41421356237f, LN_EPS = 1e-5f, QSCALE = 0.125f;
constexpr float QPRE = QSCALE * 1.4426950408889634f;
constexpr float GATE_PRE = -2.455466929f;
constexpr int NWV = 8, NTHR = NWV * 64;
constexpr int LDS_STAGE = 131072, LDS_TAB = LDS_STAGE, LDS_AOFF = LDS_STAGE + 2048, LDS_BIAS = LDS_AOFF + 20480, LDS_BYTES = LDS_BIAS + 3072 + 256;

struct Params {
    const float *x, *w_in, *b_in, *sinks, *cmp_pe, *cmp_w1, *cmp_w2, *w_out, *ln1_g, *ln1_b, *router_w, *router_b,
                *w_gu, *b_gu, *w_dn, *b_dn, *ln2_g, *ln2_b;
    float* out;
    unsigned* ctrl;
    bf16_t *WinT, *WoT, *W1T, *W2T, *WguT, *WdnT;
    float *rwT, *binp, *bgup, *b1c;
    unsigned char* xq; unsigned char* WinQ;
    float* xf; bf16_t* xb; bf16_t* hb; float* hs; bf16_t* vT; bf16_t* kF; float* cF;
    bf16_t *kc, *vc, *vcT; bf16_t* ob; float* tbuf; float* x1f; bf16_t* x1b;
    int* top_e; float* gw; int* lists; bf16_t* act; bf16_t* ybuf;
};

__device__ __forceinline__ float bf2f(bf16_t h) { return __uint_as_float(((unsigned)h) << 16); }
typedef __bf16 bf16x2_t __attribute__((ext_vector_type(2)));
__device__ __forceinline__ bf16_t f2bf(float f) { return __builtin_bit_cast(bf16_t, (__bf16)f); }
__device__ __forceinline__ unsigned pack2(float lo, float hi) { bf16x2_t v = {(__bf16)lo, (__bf16)hi}; return __builtin_bit_cast(unsigned, v); }
__device__ __forceinline__ unsigned pack4_fp8(float a, float b, float c, float d) {
    unsigned w = 0u;
    w = __builtin_amdgcn_cvt_pk_fp8_f32(a, b, w, false);
    w = __builtin_amdgcn_cvt_pk_fp8_f32(c, d, w, true);
    return w;
}
__device__ __forceinline__ float shfl_f(float v, int src_lane) { return __int_as_float(__builtin_amdgcn_ds_bpermute(src_lane << 2, __float_as_int(v))); }
__device__ __forceinline__ unsigned shfl_u(unsigned v, int src_lane) { return (unsigned)__builtin_amdgcn_ds_bpermute(src_lane << 2, (int)v); }
__device__ __forceinline__ float wave_sum(float v) {
#pragma unroll
    for (int o = 32; o > 0; o >>= 1) v += __shfl_xor(v, o);
    return v;
}
__device__ __forceinline__ float wave_max(float v) {
#pragma unroll
    for (int o = 32; o > 0; o >>= 1) v = fmaxf(v, __shfl_xor(v, o));
    return v;
}
__device__ __forceinline__ void lds_wave_sync() { asm volatile("s_waitcnt lgkmcnt(0)" ::: "memory"); __builtin_amdgcn_wave_barrier(); }
__device__ __forceinline__ float slope_swa(int hq) { return exp2f(-8.0f * (float)(2 * hq + 1) / 12.0f); }
__device__ __forceinline__ float slope_nsa(int hq) { return exp2f(-8.0f * (float)(2 * hq + 2) / 12.0f); }

__device__ __forceinline__ int fwd128(int L) { return (L & ~31) | (((L >> 2) & 1) << 4) | (((L >> 3) & 3) << 2) | (L & 3); }
__device__ __forceinline__ int inv128(int p) { return (p & ~31) | (((p >> 2) & 3) << 3) | (((p >> 4) & 1) << 2) | (p & 3); }
__device__ __forceinline__ int fwd256(int L) { return (L & ~255) | (((L >> 3) & 1) << 7) | (((L >> 6) & 3) << 5) | (((L >> 2) & 1) << 4) | (((L >> 4) & 3) << 2) | (L & 3); }
__device__ __forceinline__ int perm_row(int perm, int n) {
    if (perm == 1) { int r; if (n < 768) r = n; else if (n < 772) r = 2560 + (n - 768); else if (n < 2564) r = n - 4; else r = n; return r < 2560 ? fwd128(r) : r; }
    if (perm == 2) { const int f = n >> 1, s = n & 1; return (f >> 7) * 256 + s * 128 + fwd128(f & 127); }
    if (perm == 3) return fwd256(n);
    return n;
}
struct ConvJob { const float* src; bf16_t* dst; int K, N, kt, nt, perm; float q8; };
__device__ __forceinline__ bool conv_job(const Params& p, int t, ConvJob& jb) {
    constexpr int T_WIN = NL * 8 * 21, T_WO = NL * 8 * 8, T_WINB = NL * 8 * 2;
    if (t < T_WINB) { const int m = t / 16, r = t % 16; jb = ConvJob{p.w_in + (size_t)m * 1024 * NCOL, p.WinT + (size_t)m * NPAD * 1024, 1024, NCOL, r >> 1, (r & 1) ? 20 : 6, 1, 0.f}; return true; }
    t -= T_WINB;
    if (t < T_WO) { const int m = t / 64, r = t % 64; jb = ConvJob{p.w_out + (size_t)m * 1024 * 1024, (bf16_t*)((char*)p.WoT + (size_t)m * 1024 * 1024), 1024, 1024, r / 8, r % 8, 3, 64.0f}; return true; }
    t -= T_WO;
    if (t < T_WIN) { const int m = t / 168, r = t % 168; jb = ConvJob{p.w_in + (size_t)m * 1024 * NCOL, (bf16_t*)(p.WinQ + (size_t)m * NMAIN * 1024), 1024, NCOL, r / 21, r % 21, 1, 64.0f}; return true; }
    return false;
}
constexpr int CONV_TILES = NL * NE * 192;
__device__ __forceinline__ void conv_tile_wave(const Params& p, int t, int lane, unsigned char* l8) {
    asm volatile("" : "+v"(lane));
    const int m = t / 192, r = t % 192;
    const float* src; unsigned char* dst; int N, kt, nt, perm;
    if (r < 128) { src = p.w_gu + (size_t)m * 1024 * 2048; dst = (unsigned char*)p.WguT + (size_t)m * 2048 * 1024; N = 2048; kt = r >> 4; nt = r & 15; perm = 2; }
    else { const int q = r - 128; src = p.w_dn + (size_t)m * 1024 * 1024; dst = (unsigned char*)p.WdnT + (size_t)m * 1024 * 1024; N = 1024; kt = q >> 3; nt = q & 7; perm = 3; }
    const float* s = src + (size_t)(kt * 128 + (lane >> 5)) * N + nt * 128 + (lane & 31) * 4;
    unsigned char* lw = l8 + (lane >> 5) * 132 + (lane & 31) * 4;
    const float sg = (perm == 2) ? 64.0f * GATE_PRE : 64.0f;
    float4 va[16], vb[16];
#pragma unroll
    for (int i = 0; i < 16; ++i) va[i] = *(const float4*)(s + (size_t)(2 * i) * N);
#pragma unroll
    for (int i = 0; i < 16; ++i) vb[i] = *(const float4*)(s + (size_t)(32 + 2 * i) * N);
#pragma unroll
    for (int i = 0; i < 16; ++i) *(unsigned*)(lw + (2 * i) * 132) = pack4_fp8(va[i].x * sg, va[i].y * 64.0f, va[i].z * sg, va[i].w * 64.0f);
#pragma unroll
    for (int i = 0; i < 16; ++i) va[i] = *(const float4*)(s + (size_t)(64 + 2 * i) * N);
#pragma unroll
    for (int i = 0; i < 16; ++i) *(unsigned*)(lw + (32 + 2 * i) * 132) = pack4_fp8(vb[i].x * sg, vb[i].y * 64.0f, vb[i].z * sg, vb[i].w * 64.0f);
#pragma unroll
    for (int i = 0; i < 16; ++i) vb[i] = *(const float4*)(s + (size_t)(96 + 2 * i) * N);
#pragma unroll
    for (int i = 0; i < 16; ++i) *(unsigned*)(lw + (64 + 2 * i) * 132) = pack4_fp8(va[i].x * sg, va[i].y * 64.0f, va[i].z * sg, va[i].w * 64.0f);
#pragma unroll
    for (int i = 0; i < 16; ++i) *(unsigned*)(lw + (96 + 2 * i) * 132) = pack4_fp8(vb[i].x * sg, vb[i].y * 64.0f, vb[i].z * sg, vb[i].w * 64.0f);
    lds_wave_sync();
#pragma unroll 4
    for (int i = 0; i < 16; ++i) {
        const int idx = lane + 64 * i, kc = idx & 7, nn = idx >> 3;
        const unsigned char* l = l8 + (kc * 16) * 132 + nn;
        u32x4 w;
        w.x = (unsigned)l[0] | ((unsigned)l[132] << 8) | ((unsigned)l[264] << 16) | ((unsigned)l[396] << 24);
        w.y = (unsigned)l[528] | ((unsigned)l[660] << 8) | ((unsigned)l[792] << 16) | ((unsigned)l[924] << 24);
        w.z = (unsigned)l[1056] | ((unsigned)l[1188] << 8) | ((unsigned)l[1320] << 16) | ((unsigned)l[1452] << 24);
        w.w = (unsigned)l[1584] | ((unsigned)l[1716] << 8) | ((unsigned)l[1848] << 16) | ((unsigned)l[1980] << 24);
        *(u32x4*)(dst + (size_t)perm_row(perm, nt * 128 + nn) * 1024 + kt * 128 + kc * 16) = w;
    }
    lds_wave_sync();
}
__device__ __forceinline__ void conv_load(const ConvJob& jb, int tid, float2 (&v)[16]) {
    const int n = jb.nt * 128 + (tid & 31) * 4;
    const float* s = jb.src + (size_t)(jb.kt * 128 + (tid >> 5)) * jb.N + n;
#pragma unroll
    for (int i = 0; i < 8; ++i) {
        const float* r = s + (size_t)(16 * i) * jb.N;
        v[2 * i] = (n + 1 < jb.N) ? *(const float2*)r : make_float2(0.f, 0.f);
        v[2 * i + 1] = (n + 3 < jb.N) ? *(const float2*)(r + 2) : make_float2(0.f, 0.f);
    }
}
__device__ __forceinline__ void phase0(const Params& p, char* ldsc) {
    int tid = threadIdx.x; asm volatile("" : "+v"(tid));
    const int G = gridDim.x, bid = blockIdx.x;
    const size_t gtid = (size_t)bid * NTHR + tid, gthreads = (size_t)G * NTHR;
    {
        constexpr int TOT = NL * 8 * 2 + NL * 8 * 21 + NL * 8 * 8;
        bf16_t* lt = (bf16_t*)ldsc;
        ConvJob jb, jn; float2 v[16], vn[16];
        int t = bid; bool have = t < TOT && conv_job(p, t, jb);
        if (have) conv_load(jb, tid, v);
        while (have) {
            const int tn = t + G; const bool hn = tn < TOT && conv_job(p, tn, jn);
            if (hn) conv_load(jn, tid, vn);
            if (jb.q8 != 0.f) {
                unsigned char* l8 = (unsigned char*)lt;
                const int ncol = jb.nt * 128 + (tid & 31) * 4;
                const float qsc = (jb.perm == 1 && (ncol < 256 || (ncol >= 772 && ncol < 1156) || (ncol >= 1412 && ncol < 1796))) ? jb.q8 * QPRE : jb.q8;
#pragma unroll
                for (int i = 0; i < 8; ++i)
                {   int kl = (tid >> 5) + 16 * i;
                    if (jb.perm == 3) kl = (kl & 64) | (((kl >> 2) & 3) << 4) | (((kl >> 4) & 3) << 2) | (kl & 3);
                    *(unsigned*)(l8 + kl * 132 + (tid & 31) * 4) = pack4_fp8(v[2 * i].x * qsc, v[2 * i].y * qsc, v[2 * i + 1].x * qsc, v[2 * i + 1].y * qsc); }
                __syncthreads();
#pragma unroll
                for (int i = 0; i < 2; ++i) {
                    const int idx = tid + NTHR * i, kc = idx & 7, nn = idx >> 3, n = jb.nt * 128 + nn;
                    const unsigned char* l = l8 + (kc * 16) * 132 + nn;
                    u32x4 w;
                    w.x = (unsigned)l[0] | ((unsigned)l[132] << 8) | ((unsigned)l[264] << 16) | ((unsigned)l[396] << 24);
                    w.y = (unsigned)l[528] | ((unsigned)l[660] << 8) | ((unsigned)l[792] << 16) | ((unsigned)l[924] << 24);
                    w.z = (unsigned)l[1056] | ((unsigned)l[1188] << 8) | ((unsigned)l[1320] << 16) | ((unsigned)l[1452] << 24);
                    w.w = (unsigned)l[1584] | ((unsigned)l[1716] << 8) | ((unsigned)l[1848] << 16) | ((unsigned)l[1980] << 24);
                    const int pr = perm_row(jb.perm, n);
                    if (n < jb.N && !(jb.perm == 1 && pr >= NMAIN)) *(u32x4*)((char*)jb.dst + (size_t)pr * jb.K + jb.kt * 128 + kc * 16) = w;
                }
            } else {
#pragma unroll
                for (int i = 0; i < 8; ++i) {
                    u32x2 w; w.x = pack2(v[2 * i].x, v[2 * i].y); w.y = pack2(v[2 * i + 1].x, v[2 * i + 1].y);
                    *(u32x2*)(lt + ((tid >> 5) + 16 * i) * 136 + (tid & 31) * 4) = w;
                }
                __syncthreads();
#pragma unroll
                for (int i = 0; i < 4; ++i) {
                    const int idx = tid + NTHR * i, kc = idx & 15, nn = idx >> 4, n = jb.nt * 128 + nn;
                    if (n < jb.N) {
                        const bf16_t* l = lt + (kc * 8) * 136 + nn;
                        u32x4 w;
                        w.x = (unsigned)l[0] | ((unsigned)l[136] << 16); w.y = (unsigned)l[272] | ((unsigned)l[408] << 16);
                        w.z = (unsigned)l[544] | ((unsigned)l[680] << 16); w.w = (unsigned)l[816] | ((unsigned)l[952] << 16);
                        *(u32x4*)(jb.dst + (size_t)perm_row(jb.perm, n) * jb.K + jb.kt * 128 + kc * 8) = w;
                    }
                }
            }
            __syncthreads();
            t = tn; have = hn; jb = jn;
#pragma unroll
            for (int i = 0; i < 16; ++i) v[i] = vn[i];
        }
    }
    for (size_t i = gtid; i < (size_t)NL * 2 * 2048 * 64; i += gthreads) {
        const int k = (int)(i % 2048), n = (int)((i / 2048) % 64), m = (int)(i / (2048 * 64));
        p.W1T[i] = f2bf(p.cmp_w1[((size_t)m * 2048 + k) * 64 + n]);
    }
    for (size_t i = gtid; i < (size_t)NL * 2 * 64 * 64; i += gthreads) {
        const int k = (int)(i % 64), n = (int)((i / 64) % 64), m = (int)(i / 4096);
        p.W2T[i] = f2bf(p.cmp_w2[((size_t)m * 64 + k) * 64 + n]);
    }
    for (size_t i = gtid; i < (size_t)NL * NPAD; i += gthreads) {
        const int l = (int)(i / NPAD), ri = (int)(i % NPAD), r = ri < 2560 ? inv128(ri) : ri;
        float v = 0.f;
        if (r < 2560) { const int n = r < 768 ? r : r + 4; v = p.b_in[l * NCOL + n]; if (r < 256 || (r >= 768 && r < 1152) || (r >= 1408 && r < 1792)) v *= QPRE; }
        else if (r < 2564) v = p.b_in[l * NCOL + 768 + (r - 2560)];
        else if (r < 2582) v = p.b_in[l * NCOL + r];
        p.binp[i] = v;
    }
    for (size_t i = gtid; i < (size_t)NL * NE * 2048; i += gthreads) {
        const int r = (int)(i % 2048); const size_t le = i / 2048;
        const int s = (r >> 7) & 1, f = (r >> 8) * 128 + inv128(r & 127);
        p.bgup[i] = p.b_gu[le * 2048 + 2 * f + s] * (s == 0 ? GATE_PRE : 1.0f);
    }
    for (size_t i = gtid; i < (size_t)NL * NE * 1024; i += gthreads) {
        const int k = (int)(i % 1024), e = (int)((i / 1024) % NE), l = (int)(i / (1024 * NE));
        const float wv = p.router_w[((size_t)l * 1024 + k) * NE + e];
        const bf16_t hi = f2bf(wv); const float hf = __uint_as_float((unsigned)hi << 16);
        bf16_t* rwb = (bf16_t*)p.rwT + (size_t)l * 64 * 1024;
        rwb[(size_t)e * 1024 + k] = hi; rwb[(size_t)(32 + e) * 1024 + k] = f2bf(wv - hf);
    }
    for (size_t i = gtid; i < (size_t)NL * (NPAD - NCOL) * 1024; i += gthreads) {
        const int l = (int)(i / ((NPAD - NCOL) * 1024)); const size_t r = i % ((size_t)(NPAD - NCOL) * 1024);
        p.WinT[(size_t)l * NPAD * 1024 + (size_t)NCOL * 1024 + r] = 0;
    }
    {
        constexpr size_t N16 = (size_t)NTOK * DM / 16;
        for (size_t i0 = gtid; i0 < N16; i0 += gthreads * 2) {
            float4 v[2][4];
#pragma unroll
            for (int u = 0; u < 2; ++u) { const size_t i = i0 + u * gthreads;
#pragma unroll
                for (int j = 0; j < 4; ++j) v[u][j] = (i < N16) ? ((const float4*)p.x)[i * 4 + j] : make_float4(0.f, 0.f, 0.f, 0.f); }
#pragma unroll
            for (int u = 0; u < 2; ++u) { const size_t i = i0 + u * gthreads;
                if (i < N16) {
                    u32x4 w0, w1, q;
                    w0.x = pack2(v[u][0].x, v[u][0].y); w0.y = pack2(v[u][0].z, v[u][0].w); w0.z = pack2(v[u][1].x, v[u][1].y); w0.w = pack2(v[u][1].z, v[u][1].w);
                    w1.x = pack2(v[u][2].x, v[u][2].y); w1.y = pack2(v[u][2].z, v[u][2].w); w1.z = pack2(v[u][3].x, v[u][3].y); w1.w = pack2(v[u][3].z, v[u][3].w);
                    q.x = pack4_fp8(v[u][0].x, v[u][0].y, v[u][0].z, v[u][0].w); q.y = pack4_fp8(v[u][1].x, v[u][1].y, v[u][1].z, v[u][1].w);
                    q.z = pack4_fp8(v[u][2].x, v[u][2].y, v[u][2].z, v[u][2].w); q.w = pack4_fp8(v[u][3].x, v[u][3].y, v[u][3].z, v[u][3].w);
                    ((u32x4*)p.xb)[i * 2] = w0; ((u32x4*)p.xb)[i * 2 + 1] = w1; ((u32x4*)p.xq)[i] = q;
                }
            }
        }
    }
    if (bid < 32) {
        float* lf = (float*)ldsc;
        const int j = tid & 63, part = tid >> 6, lw = bid >> 3, sl = bid & 7;
        const float* pe = p.cmp_pe + (size_t)lw * 2048; const float* w1 = p.cmp_w1 + (size_t)lw * 2048 * 64;
        float s = 0.f;
#pragma unroll 8
        for (int kk = sl * 256 + part * 32; kk < sl * 256 + part * 32 + 32; ++kk) s += pe[kk] * w1[(size_t)kk * 64 + j];
        lf[tid] = s; __syncthreads();
        if (tid < 64) { float a = 0.f; for (int q = 0; q < 8; ++q) a += lf[tid + 64 * q]; p.b1c[(lw * 8 + sl) * 64 + tid] = a; }
        __syncthreads();
    }
}

__device__ __forceinline__ int vcu_id() { return __builtin_amdgcn_readfirstlane(*(const volatile LAS int*)(LDS_BYTES - 32)); }
namespace pg8 {
constexpr int BM = 256, BK = 64, HALF = 128, HTB = HALF * BK * 2, NXCD = 8, WGM = 8;
__device__ __forceinline__ int lds_byte(int r, int c) { const int ch = (c >> 3) ^ ((r >> 1) & 7); return (r >> 3) * 1024 + (r & 7) * 128 + ch * 16 + (c & 7) * 2; }
__device__ __forceinline__ void stage_rc(int b, int& R, int& C) { const int st = b / 1024, sb = b % 1024; R = st * 8 + sb / 128; C = ((((sb % 128) / 16) ^ ((R >> 1) & 7)) * 16 + (sb % 16)) / 2; }
__device__ __forceinline__ bool tile_order(int i, int G, int c, int nM, int nN, int& pm, int& pn) {
    const int nwg = nM * nN; const long L = (long)i * G + c; if (L >= nwg) return false;
    const int wgid = (int)L;
    const int nig = WGM * nN, gid = wgid / nig, fm = gid * WGM, gsz = (nM - fm) < WGM ? (nM - fm) : WGM;
    pm = fm + ((wgid % nig) % gsz); pn = (wgid % nig) / gsz; return true;
}
template <bool FP8, int SCA, class Sched, class Epi>
__device__ __forceinline__ void gemm_phase(LAS unsigned char* lds, const char* Abase, int K, const Sched& S, const Epi& E) {
    int tid = threadIdx.x; asm volatile("" : "+v"(tid));
    const int wid = __builtin_amdgcn_readfirstlane(tid >> 6), lane = tid & 63, wr = wid >> 2, wc = wid & 3, fr = lane & 15, fq = lane >> 4;
    const int nt = K / BK;
    int R0, C0, R1, C1; stage_rc(tid * 16, R0, C0); stage_rc(tid * 16 + 8192, R1, C1);
    LAS unsigned* aofs = (LAS unsigned*)(lds + LDS_AOFF) + tid;
    unsigned rg[10];
    rg[8] = (unsigned)(R0 * K + C0) * 2u; rg[9] = (unsigned)(R1 * K + C1) * 2u;
    if constexpr (FP8) { aofs[8 * NTHR] = rg[8]; aofs[9 * NTHR] = rg[9]; }
    const size_t kstep = (size_t)(BK * 2), hstep = (size_t)HALF * K * 2;
    const unsigned ldsw = (unsigned)wid * 1024u;
    const int aoff = lds_byte(wr * 64 + fr, fq * 8), boff = lds_byte(wc * 32 + fr, fq * 8);
#define PG8_SA(b, h) (((b) * 2 + (h)) * HTB)
#define PG8_SB(b, h) ((4 + (b) * 2 + (h)) * HTB)
#define PG8_OFS(sel, j) (FP8 ? aofs[((sel) * 4 + (j)) * NTHR] : ((sel) ? rg[4 + (j)] : rg[(j)]))
#define PG8_STAGE_B(bufoff, gbase) do { _Pragma("unroll") for (int _i = 0; _i < 2; ++_i) { const unsigned ob_ = FP8 ? aofs[(8 + _i) * NTHR] : rg[8 + _i]; \
        __builtin_amdgcn_global_load_lds((const unsigned*)((const char*)(gbase) + ob_), (LAS unsigned*)(lds + (bufoff) + ldsw + _i * 8192), 16, 0, 0); } } while (0)
#define PG8_STAGE_A(bufoff, kbyte, sel, h) do { const unsigned o0_ = PG8_OFS(sel, (h) * 2), o1_ = PG8_OFS(sel, (h) * 2 + 1); \
        __builtin_amdgcn_global_load_lds((const unsigned*)(Abase + (kbyte) + o0_), (LAS unsigned*)(lds + (bufoff) + ldsw), 16, 0, 0); \
        __builtin_amdgcn_global_load_lds((const unsigned*)(Abase + (kbyte) + o1_), (LAS unsigned*)(lds + (bufoff) + ldsw + 8192), 16, 0, 0); } while (0)
#define PG8_LDA(dst, b, h) do { _Pragma("unroll") for (int m = 0; m < 4; ++m) { \
        if constexpr (FP8) { const v4i_t lo_ = *(const LAS v4i_t*)(lds + PG8_SA(b, h) + aoff + m * 2048), hi_ = *(const LAS v4i_t*)(lds + PG8_SA(b, h) + (aoff ^ 64) + m * 2048); dst##8[m] = __builtin_shufflevector(lo_, hi_, 0, 1, 2, 3, 4, 5, 6, 7); } \
        else { _Pragma("unroll") for (int k = 0; k < 2; ++k) dst[m][k] = *(const LAS bf16x8*)(lds + PG8_SA(b, h) + (aoff ^ (k * 64)) + m * 2048); } } } while (0)
#define PG8_LDB(dst, b, h) do { _Pragma("unroll") for (int n = 0; n < 2; ++n) { \
        if constexpr (FP8) { const v4i_t lo_ = *(const LAS v4i_t*)(lds + PG8_SB(b, h) + boff + n * 2048), hi_ = *(const LAS v4i_t*)(lds + PG8_SB(b, h) + (boff ^ 64) + n * 2048); dst##8[n] = __builtin_shufflevector(lo_, hi_, 0, 1, 2, 3, 4, 5, 6, 7); } \
        else { _Pragma("unroll") for (int k = 0; k < 2; ++k) dst[n][k] = *(const LAS bf16x8*)(lds + PG8_SB(b, h) + (boff ^ (k * 64)) + n * 2048); } } } while (0)
#define PG8_MMA(ai, bj, At, Bt) do { __builtin_amdgcn_s_setprio(1); _Pragma("unroll") for (int m = 0; m < 4; ++m) _Pragma("unroll") for (int n = 0; n < 2; ++n) { \
        if constexpr (FP8) { acc[ai][bj][m][n] = __builtin_amdgcn_mfma_scale_f32_16x16x128_f8f6f4(Bt##8[n], At##8[m], acc[ai][bj][m][n], 0, 0, 0, SCA, 0, SCA); } \
        else { _Pragma("unroll") for (int k = 0; k < 2; ++k) acc[ai][bj][m][n] = __builtin_amdgcn_mfma_f32_16x16x32_bf16(Bt[n][k], At[m][k], acc[ai][bj][m][n], 0, 0, 0); } } \
        __builtin_amdgcn_s_setprio(0); } while (0)
#define PG8_WAIT_V(n) asm volatile("s_waitcnt vmcnt(" #n ")" ::: "memory")
#define PG8_WAIT_L(n) asm volatile("s_waitcnt lgkmcnt(" #n ")" ::: "memory")
#define PG8_BAR __builtin_amdgcn_s_barrier()
#define PG8_SCHED __builtin_amdgcn_sched_barrier(0)
    typename Sched::Unit cur, nxt; int ui = 0;
    if (!S.next(0, cur)) return;
    f32x4 acc[2][2][4][2];
    bf16x8 At[4][2], B0[2][2], B1[2][2];
    v8i_t At8[4], B08[2], B18[2];
    { unsigned a4[2][2]; S.a_off(cur, R0, C0, R1, C1, a4); rg[0] = a4[0][0]; rg[1] = a4[0][1]; rg[2] = a4[1][0]; rg[3] = a4[1][1];
      if constexpr (FP8) { aofs[0] = a4[0][0]; aofs[NTHR] = a4[0][1]; aofs[2 * NTHR] = a4[1][0]; aofs[3 * NTHR] = a4[1][1]; } }
    const char* cB = S.b_ptr(cur);
#define PG8_BIAS_DMA(unit, slot) do { const float* bp_ = E.bias_ptr(unit); int tb_ = threadIdx.x; asm volatile("" : "+v"(tb_)); if (wr == 0 && bp_ != nullptr) \
        __builtin_amdgcn_global_load_lds((const unsigned*)(bp_ + (tb_ & 255)), (LAS unsigned*)(lds + LDS_BIAS + (slot) * 1024 + wid * 256), 4, 0, 0); } while (0)
    PG8_BIAS_DMA(cur, 0);
    PG8_STAGE_B(PG8_SB(0, 0), cB); PG8_STAGE_B(PG8_SB(0, 1), cB + hstep); PG8_STAGE_A(PG8_SA(0, 0), 0, 0, 0); PG8_STAGE_A(PG8_SA(0, 1), 0, 0, 1);
    if (wr == 1) PG8_BAR;
    PG8_WAIT_V(2); PG8_BAR;
    PG8_STAGE_B(PG8_SB(1, 0), cB + kstep); PG8_STAGE_A(PG8_SA(1, 0), kstep, 0, 0); PG8_STAGE_B(PG8_SB(1, 1), cB + hstep + kstep);
    PG8_WAIT_V(6); PG8_BAR;
    { int t3 = threadIdx.x; asm volatile("" : "+v"(t3)); E.init(acc, wc, (t3 & 63) >> 4, (const LAS float*)(lds + LDS_BIAS)); }
    for (;;) {
        const bool has_next = S.next(ui + 1, nxt);
        const char* nB = cB;
        if (has_next) PG8_BIAS_DMA(nxt, (ui + 1) % 3);
        if (has_next) { int t2 = threadIdx.x; asm volatile("" : "+v"(t2)); int r0, c0, r1, c1; stage_rc(t2 * 16, r0, c0); stage_rc(t2 * 16 + 8192, r1, c1); nB = S.b_ptr(nxt);
            if constexpr (Sched::LIST_DMA) { static_assert(!Sched::LIST_DMA || FP8, "list DMA lands in the LDS offset slots"); S.a_dma(nxt, r0, r1, (LAS unsigned*)(lds + LDS_AOFF + 4 * NTHR * 4 + wid * 256)); }
            else { unsigned a4[2][2]; S.a_off(nxt, r0, c0, r1, c1, a4);
                rg[4] = a4[0][0]; rg[5] = a4[0][1]; rg[6] = a4[1][0]; rg[7] = a4[1][1];
                if constexpr (FP8) { aofs[4 * NTHR] = a4[0][0]; aofs[5 * NTHR] = a4[0][1]; aofs[6 * NTHR] = a4[1][0]; aofs[7 * NTHR] = a4[1][1]; } } }
        else { rg[4] = rg[0]; rg[5] = rg[1]; rg[6] = rg[2]; rg[7] = rg[3];
            if constexpr (FP8) { aofs[4 * NTHR] = aofs[0]; aofs[5 * NTHR] = aofs[NTHR]; aofs[6 * NTHR] = aofs[2 * NTHR]; aofs[7 * NTHR] = aofs[3 * NTHR]; } }
#pragma unroll 1
        for (int t = 0; t < nt; t += 2) {
            const bool last = (t == nt - 2);
            const size_t ka1 = (size_t)(t + 1) * kstep, ka2 = last ? 0 : (size_t)(t + 2) * kstep, ka3 = ka2 + kstep;
            const char* b2 = last ? nB : cB + (size_t)(t + 2) * kstep; const char* b3 = b2 + kstep;
            const int sel = last ? 1 : 0;
            if constexpr (Sched::LIST_DMA) if (last && has_next) {
                int t4 = threadIdx.x; asm volatile("" : "+v"(t4)); int r0, c0, r1, c1; stage_rc(t4 * 16, r0, c0); stage_rc(t4 * 16 + 8192, r1, c1);
#pragma unroll
                for (int j = 0; j < 4; ++j) aofs[(4 + j) * NTHR] = S.a_fin(aofs[(4 + j) * NTHR], (j & 1) ? c1 : c0);
            }
            PG8_LDB(B0, 0, 0); PG8_LDB(B1, 0, 1); PG8_SCHED; PG8_LDA(At, 0, 0); PG8_STAGE_A(PG8_SA(1, 1), ka1, 0, 1);
            PG8_WAIT_V(8); PG8_WAIT_L(0); PG8_BAR; PG8_MMA(0, 0, At, B0); PG8_MMA(0, 1, At, B1); PG8_BAR; PG8_SCHED;
            PG8_LDA(At, 0, 1); PG8_STAGE_B(PG8_SB(0, 0), b2); PG8_STAGE_B(PG8_SB(0, 1), b2 + hstep); PG8_STAGE_A(PG8_SA(0, 0), ka2, sel, 0);
            PG8_WAIT_V(8); PG8_WAIT_L(0); PG8_BAR; PG8_MMA(1, 0, At, B0); PG8_MMA(1, 1, At, B1); PG8_BAR; PG8_SCHED;
            PG8_LDB(B0, 1, 0); PG8_LDB(B1, 1, 1); PG8_SCHED; PG8_LDA(At, 1, 0); PG8_STAGE_A(PG8_SA(0, 1), ka2, sel, 1);
            PG8_WAIT_V(8); PG8_WAIT_L(0); PG8_BAR; PG8_MMA(0, 0, At, B0); PG8_MMA(0, 1, At, B1); PG8_BAR; PG8_SCHED;
            PG8_LDA(At, 1, 1); PG8_STAGE_B(PG8_SB(1, 0), b3); PG8_STAGE_B(PG8_SB(1, 1), b3 + hstep); PG8_STAGE_A(PG8_SA(1, 0), ka3, sel, 0);
            PG8_WAIT_V(8); PG8_WAIT_L(0); PG8_BAR; PG8_MMA(1, 0, At, B0); PG8_MMA(1, 1, At, B1); PG8_BAR; PG8_SCHED;
        }
        if (wr == 0) PG8_BAR;
        { int t2 = threadIdx.x; asm volatile("" : "+v"(t2)); E(acc, cur, wr, wc, t2 & 15, (t2 & 63) >> 4, (const LAS float*)(lds + LDS_BIAS + (ui % 3) * 1024)); }
        if (!has_next) break;
        { int t3 = threadIdx.x; asm volatile("" : "+v"(t3)); E.init(acc, wc, (t3 & 63) >> 4, (const LAS float*)(lds + LDS_BIAS + ((ui + 1) % 3) * 1024)); }
        cur = nxt; cB = nB; ++ui;
        rg[0] = rg[4]; rg[1] = rg[5]; rg[2] = rg[6]; rg[3] = rg[7];
        if constexpr (FP8) { aofs[0] = aofs[4 * NTHR]; aofs[NTHR] = aofs[5 * NTHR]; aofs[2 * NTHR] = aofs[6 * NTHR]; aofs[3 * NTHR] = aofs[7 * NTHR]; }
        if (wr == 1) PG8_BAR;
    }
    PG8_WAIT_V(0);
    PG8_BAR;
#undef PG8_BIAS_DMA
#undef PG8_SA
#undef PG8_SB
#undef PG8_STAGE_A
#undef PG8_OFS
#undef PG8_STAGE_B
#undef PG8_LDA
#undef PG8_LDB
#undef PG8_MMA
#undef PG8_WAIT_V
#undef PG8_WAIT_L
#undef PG8_BAR
#undef PG8_SCHED
}
}

struct DenseUnit { int pm, pn; };
struct DenseSched {
    typedef DenseUnit Unit;
    const char* Bt; int K, nM, nN, vc;
    __device__ __forceinline__ bool next(int i, Unit& u) const { return pg8::tile_order(i, gridDim.x, vc, nM, nN, u.pm, u.pn); }
    __device__ __forceinline__ void a_off(const Unit& u, int R0, int C0, int R1, int C1, unsigned (&off)[2][2]) const {
#pragma unroll
        for (int h = 0; h < 2; ++h) { off[h][0] = (unsigned)((u.pm * 256 + h * 128 + R0) * K + C0) * 2u; off[h][1] = (unsigned)((u.pm * 256 + h * 128 + R1) * K + C1) * 2u; }
    }
    __device__ __forceinline__ const char* b_ptr(const Unit& u) const { return Bt + (size_t)u.pn * 256 * K * 2; }
    static constexpr bool LIST_DMA = false;
    __device__ __forceinline__ void a_dma(const Unit&, int, int, LAS unsigned*) const {}
    __device__ __forceinline__ unsigned a_fin(unsigned raw, int) const { return raw; }
};
struct MoeUnit { int rbt, e, pn; };
template <bool GATHER>
struct MoeSched {
    typedef MoeUnit Unit;
    static constexpr int KP = 512;
    const char* Bt; const int* lists; const int* ptile; const int* ecnt; int nN, nrows, vc;
    __device__ __forceinline__ bool next(int i, Unit& u) const {
        int pm, pn; if (!pg8::tile_order(i, gridDim.x, vc, ptile[NE], nN, pm, pn)) return false;
        u.rbt = pm; u.e = ((const unsigned char*)ptile)[512 + pm]; u.pn = pn; return true;
    }
    __device__ __forceinline__ void a_off(const Unit& u, int R0, int C0, int R1, int C1, unsigned (&off)[2][2]) const {
        if (GATHER) {
            const int* lst = lists + (size_t)u.e * LIST_CAP; const int rb = u.rbt - ptile[u.e], cnt = ecnt[u.e];
#pragma unroll
            for (int h = 0; h < 2; ++h) {
                const int l0 = rb * 256 + h * 128 + R0, l1 = rb * 256 + h * 128 + R1;
                const int t0 = l0 < cnt ? (lst[l0] >> 2) : 0, t1 = l1 < cnt ? (lst[l1] >> 2) : 0;
                off[h][0] = (unsigned)(t0 * KP + C0) * 2u; off[h][1] = (unsigned)(t1 * KP + C1) * 2u;
            }
        } else {
#pragma unroll
            for (int h = 0; h < 2; ++h) { off[h][0] = (unsigned)((u.rbt * 256 + h * 128 + R0) * KP + C0) * 2u; off[h][1] = (unsigned)((u.rbt * 256 + h * 128 + R1) * KP + C1) * 2u; }
        }
    }
    __device__ __forceinline__ const char* b_ptr(const Unit& u) const { return Bt + ((size_t)u.e * nrows + (size_t)u.pn * 256) * KP * 2; }
    static constexpr bool LIST_DMA = GATHER;
    __device__ __forceinline__ void a_dma(const Unit& u, int R0, int R1, LAS unsigned* slot) const {
        const int* lst = lists + (size_t)u.e * LIST_CAP; const int rb = u.rbt - ptile[u.e], cm = ecnt[u.e] - 1;
#pragma unroll
        for (int h = 0; h < 2; ++h) {
            const int l0 = min(rb * 256 + h * 128 + R0, cm), l1 = min(rb * 256 + h * 128 + R1, cm);
            __builtin_amdgcn_global_load_lds((const unsigned*)(lst + l0), slot + (h * 2) * NTHR, 4, 0, 0);
            __builtin_amdgcn_global_load_lds((const unsigned*)(lst + l1), slot + (h * 2 + 1) * NTHR, 4, 0, 0);
        }
    }
    __device__ __forceinline__ unsigned a_fin(unsigned raw, int C) const { return (unsigned)((int)(raw >> 2) * KP + C) * 2u; }
};

__device__ __forceinline__ u32x2 quad_tr(unsigned p01, unsigned p23, int fr) {
    const unsigned sel = (fr & 1) ? 0x03020706u : 0x05040100u;
    const unsigned y01 = (unsigned)__builtin_amdgcn_update_dpp(0, (int)p01, 0xB1, 0xF, 0xF, true), y23 = (unsigned)__builtin_amdgcn_update_dpp(0, (int)p23, 0xB1, 0xF, 0xF, true);
    const unsigned q01 = __builtin_amdgcn_perm(y01, p01, sel), q23 = __builtin_amdgcn_perm(y23, p23, sel);
    const bool hi = (fr & 2) != 0;
    const unsigned snd = hi ? q01 : q23;
    const unsigned rcv = (unsigned)__builtin_amdgcn_update_dpp(0, (int)snd, 0x4E, 0xF, 0xF, true);
    u32x2 r; r.x = hi ? rcv : q01; r.y = hi ? q23 : rcv; return r;
}
struct EpiInProj {
    const Params* p; int l;
    __device__ __forceinline__ const float* bias_ptr(const DenseUnit& u) const { return p->binp + l * NPAD + u.pn * 256; }
    __device__ __forceinline__ void init(f32x4 (&acc)[2][2][4][2], int wc, int fq, const LAS float* bias) const {
#pragma unroll
        for (int bj = 0; bj < 2; ++bj)
#pragma unroll
            for (int n = 0; n < 2; ++n) {
                const f32x4 bv = *(const LAS f32x4*)(bias + bj * 128 + wc * 32 + n * 16 + 4 * fq);
#pragma unroll
                for (int ai = 0; ai < 2; ++ai)
#pragma unroll
                    for (int m = 0; m < 4; ++m) acc[ai][bj][m][n] = bv;
            }
    }
    __device__ __forceinline__ void operator()(const f32x4 (&acc)[2][2][4][2], const DenseUnit& u, int wr, int wc, int fr, int fq, const LAS float*) const {
#pragma unroll
        for (int bj = 0; bj < 2; ++bj) {
            int kind = 0, hb0 = 0;
            if (u.pn == 1) { kind = 1; hb0 = bj * 2; } else if (u.pn == 4 && bj == 1) { kind = 1; hb0 = 4; } else if (u.pn == 8 && bj == 0) { kind = 1; hb0 = 6; } else if (u.pn == 9 && bj == 0) { kind = 1; hb0 = 8; }
            else if (u.pn == 2) { kind = 2; hb0 = bj * 2; } else if (u.pn == 5 && bj == 0) { kind = 2; hb0 = 4; } else if (u.pn == 8 && bj == 1) { kind = 2; hb0 = 6; } else if (u.pn == 9 && bj == 1) { kind = 2; hb0 = 8; }
            const int c0 = wc * 32 + fq * 8;
            const int hh = hb0 + (c0 >> 6), d0 = c0 & 63;
#pragma unroll
            for (int ai = 0; ai < 2; ++ai)
#pragma unroll
                for (int m = 0; m < 4; ++m) {
                    const int row = u.pm * 256 + ai * 128 + wr * 64 + m * 16 + fr;
                    const f32x4 v0 = acc[ai][bj][m][0], v1 = acc[ai][bj][m][1];
                    u32x4 w; w.x = pack2(v0[0], v0[1]); w.y = pack2(v0[2], v0[3]); w.z = pack2(v1[0], v1[1]); w.w = pack2(v1[2], v1[3]);
                    if (kind == 0) *(u32x4*)(p->hb + (size_t)row * NMAIN + u.pn * 256 + bj * 128 + c0) = w;
                    else {
                        const int b = row >> 11, s = row & 2047, kk = s & 31;
                        bf16_t* blk = (kind == 1 ? p->kF : p->vT) + (((size_t)b * NVH + hh) * 64 + (s >> 5)) * 2048;
                        if (kind == 1) {
                            const int frk = (kk >> 3) * 4 + (kk & 3), t = (kk >> 2) & 1;
                            *(u32x4*)(blk + ((t * 2 + (d0 >> 5)) * 64 + ((d0 & 31) >> 3) * 16 + frk) * 8) = w;
                        } else {
                            const int kq = kk & 28;
                            const u32x2 t0 = quad_tr(w.x, w.y, fr), t1 = quad_tr(w.z, w.w, fr);
                            bf16_t* vt = blk + (((d0 >> 4) * 64) + (kq >> 3) * 16 + (d0 & 15) + (fr & 3)) * 8 + (kq & 7);
                            *(u32x2*)vt = t0; *(u32x2*)(vt + 32) = t1;
                        }
                    }
                }
        }
    }
};
struct EpiOutProj {
    const bf16_t* xin; float* t;
    __device__ __forceinline__ const float* bias_ptr(const DenseUnit&) const { return nullptr; }
    __device__ __forceinline__ void init(f32x4 (&acc)[2][2][4][2], int, int, const LAS float*) const {
#pragma unroll
        for (int ai = 0; ai < 2; ++ai)
#pragma unroll
            for (int bj = 0; bj < 2; ++bj)
#pragma unroll
                for (int m = 0; m < 4; ++m)
#pragma unroll
                    for (int n = 0; n < 2; ++n) acc[ai][bj][m][n] = (f32x4){0.f, 0.f, 0.f, 0.f};
    }
    __device__ __forceinline__ void operator()(const f32x4 (&acc)[2][2][4][2], const DenseUnit& u, int wr, int wc, int fr, int fq, const LAS float*) const {
#pragma unroll
        for (int ai = 0; ai < 2; ++ai)
#pragma unroll
            for (int m = 0; m < 4; ++m) {
                const size_t off = (size_t)(u.pm * 256 + ai * 128 + wr * 64 + m * 16 + fr) * DM + u.pn * 256 + wc * 64 + fq * 16;
                u32x4 w0, w1;
                { const f32x4 a = acc[ai][0][m][0]; w0.x = pack2(a[0], a[1]); w0.y = pack2(a[2], a[3]); }
                { const f32x4 a = acc[ai][0][m][1]; w0.z = pack2(a[0], a[1]); w0.w = pack2(a[2], a[3]); }
                { const f32x4 a = acc[ai][1][m][0]; w1.x = pack2(a[0], a[1]); w1.y = pack2(a[2], a[3]); }
                { const f32x4 a = acc[ai][1][m][1]; w1.z = pack2(a[0], a[1]); w1.w = pack2(a[2], a[3]); }
                *(u32x4*)((bf16_t*)t + off) = w0; *(u32x4*)((bf16_t*)t + off + 8) = w1;
            }
    }
};
struct EpiGateUp {
    bf16_t* act; const float* bgup;
    __device__ __forceinline__ const float* bias_ptr(const MoeUnit& u) const { return bgup + (size_t)u.e * 2048 + u.pn * 256; }
    __device__ __forceinline__ void init(f32x4 (&acc)[2][2][4][2], int wc, int fq, const LAS float* bias) const {
#pragma unroll
        for (int bj = 0; bj < 2; ++bj)
#pragma unroll
            for (int n = 0; n < 2; ++n) {
                const f32x4 bv = *(const LAS f32x4*)(bias + bj * 128 + wc * 32 + n * 16 + 4 * fq);
#pragma unroll
                for (int ai = 0; ai < 2; ++ai)
#pragma unroll
                    for (int m = 0; m < 4; ++m) acc[ai][bj][m][n] = bv;
            }
    }
    __device__ __forceinline__ void operator()(const f32x4 (&acc)[2][2][4][2], const MoeUnit& u, int wr, int wc, int fr, int fq, const LAS float*) const {
        constexpr float GMIN = 7.0f * GATE_PRE, CI = 1.0f / GATE_PRE;
#pragma unroll
        for (int ai = 0; ai < 2; ++ai)
#pragma unroll
            for (int m = 0; m < 4; ++m) {
                u32x2 w;
#pragma unroll
                for (int n = 0; n < 2; ++n) {
                    const f32x4 g4 = acc[ai][0][m][n], u4 = acc[ai][1][m][n];
                    float o[4];
#pragma unroll
                    for (int j = 0; j < 4; j += 2) {
                        const f32x2_t gp = {__builtin_amdgcn_fmed3f(g4[j], GMIN, 3.0e38f), __builtin_amdgcn_fmed3f(g4[j + 1], GMIN, 3.0e38f)};
                        const f32x2_t uu = {__builtin_amdgcn_fmed3f(u4[j], -7.0f, 7.0f), __builtin_amdgcn_fmed3f(u4[j + 1], -7.0f, 7.0f)};
                        const f32x2_t e = {__builtin_amdgcn_exp2f(gp.x), __builtin_amdgcn_exp2f(gp.y)};
                        const f32x2_t d = e + (f32x2_t){1.0f, 1.0f};
                        const f32x2_t r = {__builtin_amdgcn_rcpf(d.x), __builtin_amdgcn_rcpf(d.y)};
                        const f32x2_t glu = gp * r;
                        const f32x2_t wv = __builtin_elementwise_fma(uu, (f32x2_t){CI, CI}, (f32x2_t){CI, CI});
                        const f32x2_t ov = wv * glu;
                        o[j] = ov.x; o[j + 1] = ov.y;
                    }
                    const unsigned pk = pack4_fp8(o[0], o[1], o[2], o[3]);
                    if (n == 0) w.x = pk; else w.y = pk;
                }
                *(u32x2*)((char*)act + (size_t)(u.rbt * 256 + ai * 128 + wr * 64 + m * 16 + fr) * DFF + u.pn * 128 + wc * 32 + fq * 8) = w;
            }
    }
};
struct EpiDown {
    bf16_t* ybuf; const float* bdn;
    __device__ __forceinline__ const float* bias_ptr(const MoeUnit& u) const { return bdn + (size_t)u.e * 1024 + u.pn * 256; }
    __device__ __forceinline__ void init(f32x4 (&acc)[2][2][4][2], int wc, int fq, const LAS float* bias) const {
#pragma unroll
        for (int bj = 0; bj < 2; ++bj)
#pragma unroll
            for (int n = 0; n < 2; ++n) {
                const f32x4 bv = *(const LAS f32x4*)(bias + wc * 64 + fq * 16 + bj * 8 + n * 4);
#pragma unroll
                for (int ai = 0; ai < 2; ++ai)
#pragma unroll
                    for (int m = 0; m < 4; ++m) acc[ai][bj][m][n] = bv;
            }
    }
    __device__ __forceinline__ void operator()(const f32x4 (&acc)[2][2][4][2], const MoeUnit& u, int wr, int wc, int fr, int fq, const LAS float*) const {
#pragma unroll
        for (int ai = 0; ai < 2; ++ai)
#pragma unroll
            for (int m = 0; m < 4; ++m) {
                u32x4 w;
                { const f32x4 v = acc[ai][0][m][0]; w.x = pack4_fp8(v[0], v[1], v[2], v[3]); }
                { const f32x4 v = acc[ai][0][m][1]; w.y = pack4_fp8(v[0], v[1], v[2], v[3]); }
                { const f32x4 v = acc[ai][1][m][0]; w.z = pack4_fp8(v[0], v[1], v[2], v[3]); }
                { const f32x4 v = acc[ai][1][m][1]; w.w = pack4_fp8(v[0], v[1], v[2], v[3]); }
                *(u32x4*)((unsigned char*)ybuf + (size_t)(u.rbt * 256 + ai * 128 + wr * 64 + m * 16 + fr) * DM + u.pn * 256 + wc * 64 + fq * 16) = w;
            }
    }
};

__device__ __forceinline__ void phase_inproj(const Params& p, int l, char* lds) {
    DenseSched S{(const char*)p.WinQ + (size_t)l * NMAIN * 1024, 512, NTOK / 256, NMAIN / 256, vcu_id()};
    EpiInProj E{&p, l};
    pg8::gemm_phase<true, 0x7c7c7c7c>((LAS unsigned char*)lds, (const char*)p.xq, 512, S, E);
    int tid = threadIdx.x; asm volatile("" : "+v"(tid));
    const int wid = tid >> 6, lane = tid & 63, fr = lane & 15, fq = lane >> 4;
    const bf16_t* W = p.WinT + ((size_t)l * NPAD + NMAIN) * 1024;
    const float* bias = p.binp + l * NPAD + NMAIN;
    constexpr int WP = 2064;
#pragma unroll
    for (int i = 0; i < 8; ++i) { const int pc = wid * 8 + i, r = pc >> 1, q = pc & 1;
        __builtin_amdgcn_global_load_lds((const unsigned*)(W + (size_t)r * 1024 + q * 512 + lane * 8), (LAS unsigned*)((LAS char*)lds + r * WP + q * 1024), 16, 0, 0); }
    asm volatile("s_waitcnt vmcnt(0)" ::: "memory");
    __syncthreads();
    for (int u = blockIdx.x * NWV + wid; u < NTOK / 16; u += gridDim.x * NWV) {
        const bf16_t* ar = p.xb + (size_t)(u * 16 + fr) * DM + fq * 8;
        const LAS char* w0 = (const LAS char*)lds + fr * WP + fq * 16; const LAS char* w1 = w0 + 16 * WP;
        f32x4 a0 = (f32x4){0.f, 0.f, 0.f, 0.f}, a1 = a0;
#pragma unroll 4
        for (int ks = 0; ks < 32; ++ks) {
            const bf16x8 a = *(const bf16x8*)(ar + ks * 32);
            a0 = __builtin_amdgcn_mfma_f32_16x16x32_bf16(a, *(const LAS bf16x8*)(w0 + ks * 64), a0, 0, 0, 0);
            a1 = __builtin_amdgcn_mfma_f32_16x16x32_bf16(a, *(const LAS bf16x8*)(w1 + ks * 64), a1, 0, 0, 0);
        }
#pragma unroll
        for (int r = 0; r < 4; ++r) {
            float* dst = p.hs + (size_t)(u * 16 + fq * 4 + r) * HS_W;
            dst[fr] = a0[r] + bias[fr];
            if (fr < 6) dst[16 + fr] = a1[r] + bias[16 + fr];
        }
    }
}
__device__ __forceinline__ void phase_outproj(const Params& p, int l, const bf16_t* xin, char* lds) {
    DenseSched S{(const char*)p.WoT + (size_t)l * 1024 * 1024, 512, NTOK / 256, 4, vcu_id()};
    EpiOutProj E{xin, p.tbuf};
    pg8::gemm_phase<true, 0x7c7c7c7c>((LAS unsigned char*)lds, (const char*)p.ob, 512, S, E);
}
__device__ __forceinline__ void build_tiles(const Params& p, int l, int* ptile, int* ecnt) {
    int tid = threadIdx.x; asm volatile("" : "+v"(tid));
    if (tid < 64) {
        const int lane = tid, c = lane < NE ? (int)__hip_atomic_load(p.ctrl + 64 + l * NE + lane, __ATOMIC_RELAXED, __HIP_MEMORY_SCOPE_AGENT) : 0;
        const unsigned tiles = (unsigned)(c + 255) >> 8; unsigned inc = tiles;
#pragma unroll
        for (int o = 1; o < 32; o <<= 1) { const unsigned v = shfl_u(inc, lane - o); if (lane >= o) inc += v; }
        if (lane < NE) { ecnt[lane] = c; ptile[lane] = (int)(inc - tiles); if (lane == NE - 1) ptile[NE] = (int)inc; }
    }
    __syncthreads();
    unsigned char* texp = (unsigned char*)ptile + 512;
    for (int t = tid; t < ptile[NE]; t += NTHR) { int lo = 0, hi = NE;
#pragma unroll
        for (int st = 0; st < 5; ++st) { const int mid = (lo + hi) >> 1; if (ptile[mid] <= t) lo = mid; else hi = mid; }
        texp[t] = (unsigned char)lo; }
    __syncthreads();
}
__device__ __forceinline__ void phase_gateup(const Params& p, int l, char* lds) {
    int* ptile = (int*)(lds + LDS_TAB); int* ecnt = ptile + 40;
    build_tiles(p, l, ptile, ecnt);
    MoeSched<true> S{(const char*)p.WguT + (size_t)l * NE * 2048 * 1024, p.lists, ptile, ecnt, 8, 2048, vcu_id()};
    EpiGateUp E{p.act, p.bgup + (size_t)l * NE * 2048};
    pg8::gemm_phase<true, 0x7c7c7c7c>((LAS unsigned char*)lds, (const char*)p.x1b, 512, S, E);
}
__device__ __forceinline__ void phase_down(const Params& p, int l, char* lds) {
    int* ptile = (int*)(lds + LDS_TAB); int* ecnt = ptile + 40;
    MoeSched<false> S{(const char*)p.WdnT + (size_t)l * NE * 1024 * 1024, p.lists, ptile, ecnt, 4, 1024, vcu_id()};
    EpiDown E{p.ybuf, p.b_dn + (size_t)l * NE * 1024};
    pg8::gemm_phase<true, 0x7c7c7c7c>((LAS unsigned char*)lds, (const char*)p.act, 512, S, E);
}

__device__ __forceinline__ float gelu_tanh(float x) {
    const float u = 0.7978845608028654f * (x + 0.044715f * x * x * x);
    const float e = __expf(-2.0f * fabsf(u)); const float th = (1.0f - e) / (1.0f + e);
    return 0.5f * x * (1.0f + (u < 0.f ? -th : th));
}
__device__ __forceinline__ void phase_prep(const Params& p, int l, char* lds) {
    int tid = threadIdx.x; asm volatile("" : "+v"(tid));
    const int wid = tid >> 6, lane = tid & 63, fr = lane & 15, fq = lane >> 4;
    const int gw = blockIdx.x * NWV + wid, nw = gridDim.x * NWV;
    for (int u = (int)gridDim.x - 1 - (int)blockIdx.x; u < NB * 4; u += gridDim.x) {
        const int b = u >> 2, h = u & 3;
        const float* srcp = p.hs + ((size_t)b * SEQ + tid * 4) * HS_W + h;
        float ls[4]; float tot = 0.f;
#pragma unroll
        for (int i = 0; i < 4; ++i) { const float f = srcp[(size_t)i * HS_W]; ls[i] = fminf(f, 0.f) - log1pf(__expf(-fabsf(f))); tot += ls[i]; }
        float inc = tot;
#pragma unroll
        for (int o = 1; o < 64; o <<= 1) { const float v = shfl_f(inc, lane - o); if (lane >= o) inc += v; }
        float* wtot = (float*)(lds + 65536);
        if (lane == 63) wtot[wid] = inc;
        __syncthreads();
        float base = inc - tot;
        for (int w = 0; w < wid; ++w) base += wtot[w];
        float4 o4; o4.x = base + ls[0]; o4.y = o4.x + ls[1]; o4.z = o4.y + ls[2]; o4.w = o4.z + ls[3];
        o4.x *= -1.4426950408889634f; o4.y *= -1.4426950408889634f; o4.z *= -1.4426950408889634f; o4.w *= -1.4426950408889634f;
        *(float4*)(p.cF + (size_t)u * SEQ + tid * 4) = o4;
        __syncthreads();
    }
    float* part = (float*)lds;
    bf16_t* h1 = (bf16_t*)(lds + 32768);
    for (int u = blockIdx.x; u < NB * 2 * 2 * 8; u += gridDim.x) {
        const int ct = u & 7, which = (u >> 3) & 1, kvh = (u >> 4) & 1, b = u >> 5;
        const int colo = (which ? C_NVC : C_NKC) + kvh * 64;
        const int c_lane = ct * 16 + fr;
        const int tokbase = min(c_lane, 126) * 16;
        const bf16_t* arow = p.hb + ((size_t)b * SEQ + tokbase) * NMAIN + colo + fq * 8;
        const bf16_t* w1 = p.W1T + ((size_t)(l * 2 + which) * 64 + fr) * 2048 + fq * 8;
        f32x4 acc[4];
#pragma unroll
        for (int n = 0; n < 4; ++n) acc[n] = (f32x4){0.f, 0.f, 0.f, 0.f};
#pragma unroll
        for (int kk = 0; kk < 8; ++kk) {
            const int ks = wid * 8 + kk;
            const bf16x8 a = *(const bf16x8*)(arow + (size_t)(ks >> 1) * NMAIN + (ks & 1) * 32);
#pragma unroll
            for (int n = 0; n < 4; ++n) {
                const bf16x8 bb = *(const bf16x8*)(w1 + (size_t)n * 16 * 2048 + ks * 32);
                acc[n] = __builtin_amdgcn_mfma_f32_16x16x32_bf16(a, bb, acc[n], 0, 0, 0);
            }
        }
#pragma unroll
        for (int n = 0; n < 4; ++n)
#pragma unroll
            for (int r = 0; r < 4; ++r) part[wid * 1024 + (fq * 4 + r) * 64 + n * 16 + fr] = acc[n][r];
        __syncthreads();
        const float* b1 = p.b1c + (l * 2 + which) * 8 * 64;
#pragma unroll
        for (int i = 0; i < 2; ++i) {
            const int e = tid + NTHR * i; float sum = 0.f, bsum = 0.f;
#pragma unroll
            for (int w = 0; w < 8; ++w) { sum += part[w * 1024 + e]; bsum += b1[w * 64 + (e & 63)]; }
            h1[e] = f2bf(gelu_tanh(sum + bsum));
        }
        __syncthreads();
        if (wid < 4) {
            const int n = wid;
            const bf16_t* w2 = p.W2T + ((size_t)(l * 2 + which) * 64 + n * 16 + fr) * 64 + fq * 8;
            f32x4 o2 = (f32x4){0.f, 0.f, 0.f, 0.f};
#pragma unroll
            for (int ks = 0; ks < 2; ++ks) {
                const bf16x8 a = *(const bf16x8*)(h1 + fr * 64 + ks * 32 + fq * 8);
                const bf16x8 bb = *(const bf16x8*)(w2 + ks * 32);
                o2 = __builtin_amdgcn_mfma_f32_16x16x32_bf16(a, bb, o2, 0, 0, 0);
            }
            const size_t base = ((size_t)b * 2 + kvh) * 128 * 64;
#pragma unroll
            for (int r = 0; r < 4; ++r) {
                const int c = ct * 16 + fq * 4 + r, j2 = n * 16 + fr;
                const bf16_t v = c < 127 ? f2bf(o2[r]) : (bf16_t)0;
                if (which == 0) p.kc[base + (size_t)c * 64 + j2] = v;
                else { p.vc[base + (size_t)c * 64 + j2] = v; p.vcT[base + (size_t)j2 * 128 + c] = v; }
            }
        }
        __syncthreads();
    }
}

constexpr float PINF = __builtin_huge_valf();
constexpr float L2E = 1.4426950408889634f, MASKV = -__builtin_huge_valf(), MINIT = -1e30f, SCL2 = QSCALE * L2E;
struct KVFrag { bf16x8 k[2][2]; bf16x8 v[4]; };
template <bool FM>
__device__ __forceinline__ void k_load(KVFrag& f, const bf16_t* __restrict__ Kb, size_t ldk, int kc0, int fr, int fq) {
    if (FM) {
        const bf16_t* kp = Kb + (size_t)(kc0 >> 5) * 2048 + (fq * 16 + fr) * 8;
        f.k[0][0] = *(const bf16x8*)(kp); f.k[0][1] = *(const bf16x8*)(kp + 512); f.k[1][0] = *(const bf16x8*)(kp + 1024); f.k[1][1] = *(const bf16x8*)(kp + 1536);
    } else {
        const bf16_t* kp = Kb + (size_t)(kc0 + (fr >> 2) * 8 + (fr & 3)) * ldk + fq * 8;
        f.k[0][0] = *(const bf16x8*)(kp); f.k[0][1] = *(const bf16x8*)(kp + 32);
        f.k[1][0] = *(const bf16x8*)(kp + 4 * ldk); f.k[1][1] = *(const bf16x8*)(kp + 4 * ldk + 32);
    }
}
template <bool FM>
__device__ __forceinline__ void v_load(bf16x8 (&v)[4], const bf16_t* __restrict__ VTb, size_t ldv, int kc0, int fr, int fq) {
    if (FM) {
        const bf16_t* vp = VTb + (size_t)(kc0 >> 5) * 2048 + (fq * 16 + fr) * 8;
#pragma unroll
        for (int dt = 0; dt < 4; ++dt) v[dt] = *(const bf16x8*)(vp + dt * 512);
    } else {
        const bf16_t* vp = VTb + (size_t)fr * ldv + kc0 + fq * 8;
#pragma unroll
        for (int dt = 0; dt < 4; ++dt) v[dt] = *(const bf16x8*)(vp + (size_t)dt * 16 * ldv);
    }
}
__device__ __forceinline__ float rowmax4(float x) {
    auto r = __builtin_amdgcn_permlane32_swap(__float_as_uint(x), __float_as_uint(x), false, false);
    x = __builtin_amdgcn_fmed3f(__uint_as_float(r[0]), __uint_as_float(r[1]), 3.0e38f);
    auto q = __builtin_amdgcn_permlane16_swap(__float_as_uint(x), __float_as_uint(x), false, false);
    return __builtin_amdgcn_fmed3f(__uint_as_float(q[0]), __uint_as_float(q[1]), 3.0e38f);
}
__device__ __forceinline__ float rowsum4(float x) {
    auto r = __builtin_amdgcn_permlane32_swap(__float_as_uint(x), __float_as_uint(x), false, false);
    x = __uint_as_float(r[0]) + __uint_as_float(r[1]);
    auto q = __builtin_amdgcn_permlane16_swap(__float_as_uint(x), __float_as_uint(x), false, false);
    return __uint_as_float(q[0]) + __uint_as_float(q[1]);
}
constexpr float DEFER_THR = 8.0f;
template <int NQT, bool MASK, class MB>
__device__ __forceinline__ void attn_compute(const KVFrag& f, const bf16x8 (&qf)[NQT][2], f32x4 (&o)[NQT][4], float (&m)[NQT], float (&l)[NQT], const MB& mb,
                                             const f32x4 c0 = (f32x4){0.f, 0.f, 0.f, 0.f}, const f32x4 c1 = (f32x4){0.f, 0.f, 0.f, 0.f}) {
    f32x4 s0[NQT], s1[NQT];
#pragma unroll
    for (int qt = 0; qt < NQT; ++qt) {
        s0[qt] = __builtin_amdgcn_mfma_f32_16x16x32_bf16(f.k[0][0], qf[qt][0], c0, 0, 0, 0);
        s1[qt] = __builtin_amdgcn_mfma_f32_16x16x32_bf16(f.k[1][0], qf[qt][0], c1, 0, 0, 0);
    }
#pragma unroll
    for (int qt = 0; qt < NQT; ++qt) {
        s0[qt] = __builtin_amdgcn_mfma_f32_16x16x32_bf16(f.k[0][1], qf[qt][1], s0[qt], 0, 0, 0);
        s1[qt] = __builtin_amdgcn_mfma_f32_16x16x32_bf16(f.k[1][1], qf[qt][1], s1[qt], 0, 0, 0);
    }
    float mx[NQT];
#pragma unroll
    for (int qt = 0; qt < NQT; ++qt) {
#pragma unroll
        for (int j = 0; j < 4; ++j) { s0[qt][j] = mb(qt, j, s0[qt][j]); s1[qt][j] = mb(qt, j + 4, s1[qt][j]); }
        mx[qt] = fmaxf(fmaxf(fmaxf(s0[qt][0], s0[qt][1]), fmaxf(s0[qt][2], s0[qt][3])), fmaxf(fmaxf(s1[qt][0], s1[qt][1]), fmaxf(s1[qt][2], s1[qt][3])));
    }
#pragma unroll
    for (int qt = 0; qt < NQT; ++qt) mx[qt] = rowmax4(mx[qt]);
    bool moved = false;
#pragma unroll
    for (int qt = 0; qt < NQT; ++qt) { mx[qt] = __builtin_amdgcn_fmed3f(m[qt], mx[qt], 3.0e38f); moved |= (mx[qt] > m[qt] + DEFER_THR); }
    if (__ballot(moved) != 0ull) {
#pragma unroll
        for (int qt = 0; qt < NQT; ++qt) {
            const float alpha = __builtin_amdgcn_exp2f(m[qt] - mx[qt]);
            l[qt] *= alpha;
#pragma unroll
            for (int dt = 0; dt < 4; ++dt) o[qt][dt] *= alpha;
            m[qt] = mx[qt];
        }
    }
    bf16x8 pf[NQT];
#pragma unroll
    for (int qt = 0; qt < NQT; ++qt) {
        float pr[8]; float ps = 0.f;
#pragma unroll
        for (int j = 0; j < 4; ++j) {
            pr[j] = __builtin_amdgcn_exp2f(s0[qt][j] - m[qt]);
            pr[j + 4] = __builtin_amdgcn_exp2f(s1[qt][j] - m[qt]);
        }
#pragma unroll
        for (int j = 0; j < 8; ++j) ps += pr[j];
        l[qt] += ps;
        const u32x4 pk = {pack2(pr[0], pr[1]), pack2(pr[2], pr[3]), pack2(pr[4], pr[5]), pack2(pr[6], pr[7])};
        pf[qt] = __builtin_bit_cast(bf16x8, pk);
    }
#pragma unroll
    for (int dt = 0; dt < 4; ++dt)
#pragma unroll
        for (int qt = 0; qt < NQT; ++qt) o[qt][dt] = __builtin_amdgcn_mfma_f32_16x16x32_bf16(f.v[dt], pf[qt], o[qt][dt], 0, 0, 0);
    __builtin_amdgcn_sched_barrier(0);
}
struct RangeIt { int c, c_hi; __device__ __forceinline__ int nxt() { if (c > c_hi) return -1; return (c++) * 32; } };
struct MaskIt { unsigned long long cm; __device__ __forceinline__ int nxt() { if (!cm) return -1; const int i = __builtin_ctzll(cm); cm &= cm - 1; return i * 32; } };
template <bool PFV, bool FM, class It, class Gen>
__device__ __forceinline__ void attn_run(It& it, const bf16_t* Kb, size_t ldk, const bf16_t* VTb, size_t ldv, int fr, int fq, const Gen& gen) {
    KVFrag fa, fb;
    int ka = it.nxt(); if (ka < 0) return;
    k_load<FM>(fa, Kb, ldk, ka, fr, fq); if (PFV) v_load<FM>(fa.v, VTb, ldv, ka, fr, fq);
    for (;;) {
        const int kb = it.nxt(); if (kb >= 0) { k_load<FM>(fb, Kb, ldk, kb, fr, fq); if (PFV) v_load<FM>(fb.v, VTb, ldv, kb, fr, fq); }
        if (!PFV) v_load<FM>(fa.v, VTb, ldv, ka, fr, fq);
        gen(ka, fa);
        if (kb < 0) break;
        ka = it.nxt(); if (ka >= 0) { k_load<FM>(fa, Kb, ldk, ka, fr, fq); if (PFV) v_load<FM>(fa.v, VTb, ldv, ka, fr, fq); }
        if (!PFV) v_load<FM>(fb.v, VTb, ldv, kb, fr, fq);
        gen(kb, fb);
        if (ka < 0) break;
    }
}
template <int NQT>
__device__ __forceinline__ void attn_init(f32x4 (&o)[NQT][4], float (&m)[NQT], float (&l)[NQT]) {
#pragma unroll
    for (int qt = 0; qt < NQT; ++qt) { m[qt] = MINIT; l[qt] = 0.f;
#pragma unroll
        for (int dt = 0; dt < 4; ++dt) o[qt][dt] = (f32x4){0.f, 0.f, 0.f, 0.f}; }
}
__device__ __forceinline__ float lsum4(float l) { return rowsum4(l); }
__device__ __forceinline__ void store_o16(unsigned char* dst, const f32x4 v0, const f32x4 v1, const f32x4 v2, const f32x4 v3) {
    u32x4 w; w.x = pack4_fp8(v0[0], v0[1], v0[2], v0[3]); w.y = pack4_fp8(v1[0], v1[1], v1[2], v1[3]); w.z = pack4_fp8(v2[0], v2[1], v2[2], v2[3]); w.w = pack4_fp8(v3[0], v3[1], v3[2], v3[3]);
    *(u32x4*)dst = w;
}
__device__ __forceinline__ float sigmoidf_fast(float x) { return __builtin_amdgcn_rcpf(1.0f + __builtin_amdgcn_exp2f(-L2E * x)); }

__device__ __forceinline__ void fox_unit(const Params& p, int b, int h, int qb, int fr, int fq) {
    asm volatile("" : "+v"(fr), "+v"(fq));
    const int t0 = qb * 64;
    const bf16_t* Qb = p.hb + ((size_t)b * SEQ + t0) * NMAIN + C_FQ + h * 64 + fq * 8;
    bf16x8 qf[4][2];
#pragma unroll
    for (int qt = 0; qt < 4; ++qt) { qf[qt][0] = *(const bf16x8*)(Qb + (size_t)(qt * 16 + fr) * NMAIN); qf[qt][1] = *(const bf16x8*)(Qb + (size_t)(qt * 16 + fr) * NMAIN + 32); }
    const float* cf = p.cF + ((size_t)b * 4 + h) * SEQ;
    f32x4 o[4][4]; float m[4], l[4];
    attn_init<4>(o, m, l);
    const bf16_t* Kb = p.kF + ((size_t)b * NVH + h) * 64 * SEQ;
    const bf16_t* VTb = p.vT + ((size_t)b * NVH + h) * 64 * SEQ;
    RangeIt it0{0, (t0 >> 5) - 1};
    attn_run<true, true>(it0, Kb, NMAIN, VTb, SEQ, fr, fq, [&](int kc0, const KVFrag& f) {
        const f32x4 ca = *(const f32x4*)(cf + kc0 + 8 * fq), cb = *(const f32x4*)(cf + kc0 + 8 * fq + 4);
        attn_compute<4, false>(f, qf, o, m, l, [&](int qt, int j, float raw) { return raw; }, ca, cb);
    });
    RangeIt it{t0 >> 5, (t0 >> 5) + 1};
    attn_run<false, true>(it, Kb, NMAIN, VTb, SEQ, fr, fq, [&](int kc0, const KVFrag& f) {
        const f32x4 ca = *(const f32x4*)(cf + kc0 + 8 * fq), cb = *(const f32x4*)(cf + kc0 + 8 * fq + 4);
        const int kq = kc0 + 8 * fq - t0 - fr;
        attn_compute<4, true>(f, qf, o, m, l, [&](int qt, int j, float raw) { return (kq + j - 16 * qt) > 0 ? MASKV : raw; }, ca, cb);
    });
#pragma unroll
    for (int qt = 0; qt < 4; ++qt) {
        const float inv = __builtin_amdgcn_rcpf(lsum4(l[qt]));
        unsigned char* dst = (unsigned char*)p.ob + ((size_t)b * SEQ + t0 + qt * 16 + fr) * DM + h * 64 + 16 * fq;
        store_o16(dst, o[qt][0] * inv, o[qt][1] * inv, o[qt][2] * inv, o[qt][3] * inv);
    }
}
__device__ __forceinline__ void swa_unit(const Params& p, int l_, int b, int kv, int pos, int fr, int fq) {
    asm volatile("" : "+v"(fr), "+v"(fq));
    const int t0 = pos * 16, t = t0 + fr;
    const bf16_t* Qb = p.hb + ((size_t)b * SEQ + t) * NMAIN + C_SQ + kv * 192 + fq * 8;
    bf16x8 qf[3][2];
#pragma unroll
    for (int g = 0; g < 3; ++g) { qf[g][0] = *(const bf16x8*)(Qb + g * 64); qf[g][1] = *(const bf16x8*)(Qb + g * 64 + 32); }
    float sl[3];
#pragma unroll
    for (int g = 0; g < 3; ++g) sl[g] = slope_swa(kv * 3 + g) * L2E;
    f32x4 o[3][4]; float m[3], l[3];
    attn_init<3>(o, m, l);
    const bf16_t* Kb = p.kF + ((size_t)b * NVH + 4 + kv) * 64 * SEQ;
    const bf16_t* VTb = p.vT + ((size_t)b * NVH + 4 + kv) * 64 * SEQ;
    RangeIt it{max(0, t0 - 127) >> 5, (t0 + 15) >> 5};
    attn_run<true, true>(it, Kb, NMAIN, VTb, SEQ, fr, fq, [&](int kc0, const KVFrag& f) {
        const int dq = t - kc0 - 8 * fq;
        attn_compute<3, true>(f, qf, o, m, l, [&](int g, int j, float raw) { const int dist = dq - j; return raw - sl[g] * (((unsigned)dist < 128u) ? (float)dist : PINF); });
    });
#pragma unroll
    for (int g = 0; g < 3; ++g) {
        const float sink = p.sinks[l_ * 6 + kv * 3 + g] * L2E;
        const float inv = __builtin_amdgcn_rcpf(lsum4(l[g]) + __builtin_amdgcn_exp2f(sink - m[g]));
        unsigned char* dst = (unsigned char*)p.ob + ((size_t)b * SEQ + t) * DM + 256 + (kv * 3 + g) * 64 + 16 * fq;
        store_o16(dst, o[g][0] * inv, o[g][1] * inv, o[g][2] * inv, o[g][3] * inv);
    }
}
__device__ __forceinline__ void nsa_unit(const Params& p, int b, int kv, int pos, int fr, int fq, int lane, float* ps, unsigned* msk, float* otl) {
    asm volatile("" : "+v"(fr), "+v"(fq), "+v"(lane));
    const int t0 = pos * 16, t = t0 + fr, cur = t0 >> 6;
    const bf16_t* Qb = p.hb + ((size_t)b * SEQ + t) * NMAIN + C_NQ + kv * 192 + fq * 8;
    bf16x8 qf[3][2];
#pragma unroll
    for (int g = 0; g < 3; ++g) { qf[g][0] = *(const bf16x8*)(Qb + g * 64); qf[g][1] = *(const bf16x8*)(Qb + g * 64 + 32); }
    float sl[3];
#pragma unroll
    for (int g = 0; g < 3; ++g) sl[g] = slope_nsa(kv * 3 + g) * L2E;
    const float* gl = p.hs + ((size_t)b * SEQ + t) * HS_W + 4 + kv * 9;
    f32x4 o[3][4]; float m[3], l[3];
    f32x4* otv = (f32x4*)otl + lane;
#pragma unroll
    for (int i = 0; i < 8; ++i) ps[lane + 64 * i] = 0.f;
    {
        const bf16_t* Kb = p.kc + ((size_t)b * 2 + kv) * 128 * 64;
        const bf16_t* VTb = p.vcT + ((size_t)b * 2 + kv) * 64 * 128;
        const int ncv = (t0 + 15 >= 31) ? ((t0 + 15 - 31) >> 4) + 1 : 0;
        const int nch = (ncv + 31) >> 5;
        attn_init<3>(o, m, l);
        const int dq0 = t - 31 - 16 * 8 * fq;
        RangeIt it{0, nch - 1};
        attn_run<false, false>(it, Kb, 64, VTb, 128, fr, fq, [&](int kc0, const KVFrag& f) {
            const int dq = dq0 - 16 * kc0;
            attn_compute<3, true>(f, qf, o, m, l, [&](int g, int j, float raw) { const int dist = dq - 16 * j; return raw - sl[g] * (dist >= 0 ? (float)dist : PINF); });
        });
        float il[3];
#pragma unroll
        for (int g = 0; g < 3; ++g) {
            const float lt = lsum4(l[g]); il[g] = lt > 0.f ? __builtin_amdgcn_rcpf(lt) : 0.f;
            const float gate = sigmoidf_fast(gl[g * 3 + 0]);
#pragma unroll
            for (int dt = 0; dt < 4; ++dt) otv[(g * 4 + dt) * 64] = o[g][dt] * (il[g] * gate);
        }
        float carry_prev = 0.f;
        for (int c = 0; c < nch; ++c) {
            const int kc0 = c * 32, dq = dq0 - 16 * kc0;
            const bf16_t* kp = Kb + (size_t)(kc0 + (fr >> 2) * 8 + (fr & 3)) * 64 + fq * 8;
            const bf16x8 k00 = *(const bf16x8*)(kp), k01 = *(const bf16x8*)(kp + 32), k10 = *(const bf16x8*)(kp + 256), k11 = *(const bf16x8*)(kp + 256 + 32);
            float pc[8];
#pragma unroll
            for (int j = 0; j < 8; ++j) pc[j] = 0.f;
#pragma unroll
            for (int g = 0; g < 3; ++g) {
                f32x4 s0 = (f32x4){0.f, 0.f, 0.f, 0.f}, s1 = s0;
                s0 = __builtin_amdgcn_mfma_f32_16x16x32_bf16(k00, qf[g][0], s0, 0, 0, 0); s0 = __builtin_amdgcn_mfma_f32_16x16x32_bf16(k01, qf[g][1], s0, 0, 0, 0);
                s1 = __builtin_amdgcn_mfma_f32_16x16x32_bf16(k10, qf[g][0], s1, 0, 0, 0); s1 = __builtin_amdgcn_mfma_f32_16x16x32_bf16(k11, qf[g][1], s1, 0, 0, 0);
#pragma unroll
                for (int j = 0; j < 8; ++j) {
                    const int dist = dq - 16 * j; const float raw = j < 4 ? s0[j] : s1[j - 4];
                    if (dist >= 0) pc[j] += __builtin_amdgcn_exp2f(raw - sl[g] * (float)dist - m[g]) * il[g];
                }
            }
            const float cout = 0.5f * pc[7];
            float cin = shfl_f(cout, lane - 16);
            const float cwrap = shfl_f(cout, fr + 48);
            if (fq == 0) cin = carry_prev;
            carry_prev = cwrap;
            const int n0 = (kc0 >> 2) + 2 * fq;
            ps[fr * 32 + n0] = cin + pc[0] + pc[1] + pc[2] + 0.5f * pc[3];
            ps[fr * 32 + n0 + 1] = 0.5f * pc[3] + pc[4] + pc[5] + pc[6] + 0.5f * pc[7];
        }
    }
    lds_wave_sync();
    unsigned qmask = 1u | (1u << cur); if (cur >= 1) qmask |= 1u << (cur - 1);
    if (cur >= 3) {
        if (cur - 2 <= 5) qmask |= (1u << (cur - 1)) - 2u;
        else {
            const f32x4 va = *(const f32x4*)(ps + fr * 32 + 8 * fq), vb = *(const f32x4*)(ps + fr * 32 + 8 * fq + 4);
            const float v[8] = {va[0], va[1], va[2], va[3], vb[0], vb[1], vb[2], vb[3]};
            for (int r = 0; r < 5; ++r) {
                float best = -1.0f; int bi = 64;
#pragma unroll
                for (int i = 0; i < 8; ++i) { const int j = 8 * fq + i; if (j >= 1 && j <= cur - 2 && !((qmask >> j) & 1u) && v[i] > best) { best = v[i]; bi = j; } }
                {   auto rb = __builtin_amdgcn_permlane32_swap(__float_as_uint(best), __float_as_uint(best), false, false); auto ri = __builtin_amdgcn_permlane32_swap((unsigned)bi, (unsigned)bi, false, false);
                    const float b0 = __uint_as_float(rb[0]), b1 = __uint_as_float(rb[1]); const int i0 = (int)ri[0], i1 = (int)ri[1];
                    const bool t1 = b1 > b0 || (b1 == b0 && i1 < i0); best = t1 ? b1 : b0; bi = t1 ? i1 : i0; }
                {   auto rb = __builtin_amdgcn_permlane16_swap(__float_as_uint(best), __float_as_uint(best), false, false); auto ri = __builtin_amdgcn_permlane16_swap((unsigned)bi, (unsigned)bi, false, false);
                    const float b0 = __uint_as_float(rb[0]), b1 = __uint_as_float(rb[1]); const int i0 = (int)ri[0], i1 = (int)ri[1];
                    const bool t1 = b1 > b0 || (b1 == b0 && i1 < i0); best = t1 ? b1 : b0; bi = t1 ? i1 : i0; }
                if (bi == 64) bi = 1;
                qmask |= 1u << bi;
            }
        }
    }
    {
        const bf16_t* Kb = p.kF + ((size_t)b * NVH + 6 + kv) * 64 * SEQ;
        const bf16_t* VTb = p.vT + ((size_t)b * NVH + 6 + kv) * 64 * SEQ;
        attn_init<3>(o, m, l);
        unsigned um = qmask;
        um |= shfl_u(um, lane ^ 1); um |= shfl_u(um, lane ^ 2); um |= shfl_u(um, lane ^ 4); um |= shfl_u(um, lane ^ 8);
        um = (unsigned)__builtin_amdgcn_readfirstlane((int)um) & (cur >= 31 ? 0xffffffffu : ((2u << cur) - 1u));
        unsigned long long cm = 0ull;
        for (unsigned r = um; r; r &= r - 1) { const int kb = __builtin_ctz(r); cm |= 3ull << (2 * kb); }
        MaskIt it{cm};
        attn_run<true, true>(it, Kb, NMAIN, VTb, SEQ, fr, fq, [&](int kc0, const KVFrag& f) {
            const bool mine = (qmask >> (kc0 >> 6)) & 1u;
            const int dq = t - kc0 - 8 * fq;
            attn_compute<3, true>(f, qf, o, m, l, [&](int g, int j, float raw) { const int dist = dq - j; return raw - sl[g] * ((mine && dist >= 0) ? (float)dist : PINF); });
        });
#pragma unroll
        for (int g = 0; g < 3; ++g) {
            const float lt = lsum4(l[g]); const float sc = (lt > 0.f ? __builtin_amdgcn_rcpf(lt) : 0.f) * sigmoidf_fast(gl[g * 3 + 1]);
#pragma unroll
            for (int dt = 0; dt < 4; ++dt) otv[(g * 4 + dt) * 64] += o[g][dt] * sc;
        }
    }
    {
        const bf16_t* Kb = p.kF + ((size_t)b * NVH + 8 + kv) * 64 * SEQ;
        const bf16_t* VTb = p.vT + ((size_t)b * NVH + 8 + kv) * 64 * SEQ;
        attn_init<3>(o, m, l);
        RangeIt it{max(0, t0 - 511) >> 5, (t0 + 15) >> 5};
        attn_run<true, true>(it, Kb, NMAIN, VTb, SEQ, fr, fq, [&](int kc0, const KVFrag& f) {
            const int dq = t - kc0 - 8 * fq;
            attn_compute<3, true>(f, qf, o, m, l, [&](int g, int j, float raw) { const int dist = dq - j; return raw - sl[g] * (((unsigned)dist < 512u) ? (float)dist : PINF); });
        });
#pragma unroll
        for (int g = 0; g < 3; ++g) {
            const float lt = lsum4(l[g]); const float sc = (lt > 0.f ? __builtin_amdgcn_rcpf(lt) : 0.f) * sigmoidf_fast(gl[g * 3 + 2]);
            unsigned char* dst = (unsigned char*)p.ob + ((size_t)b * SEQ + t) * DM + 640 + (kv * 3 + g) * 64 + 16 * fq;
            store_o16(dst, otv[(g * 4 + 0) * 64] + o[g][0] * sc, otv[(g * 4 + 1) * 64] + o[g][1] * sc, otv[(g * 4 + 2) * 64] + o[g][2] * sc, otv[(g * 4 + 3) * 64] + o[g][3] * sc);
        }
    }
}

template <bool WITH_CONV>
__device__ __forceinline__ void phase_attn(const Params& p, int l, char* lds, int cslot = 16) {
    int tid = threadIdx.x; asm volatile("" : "+v"(tid));
    const int wid = tid >> 6, lane = tid & 63, fr = lane & 15, fq = lane >> 4;
    float* ps = (float*)(lds + wid * 16896); unsigned* msk = (unsigned*)(ps + 512); float* otl = ps + 576;
    unsigned* ctr = p.ctrl + cslot + l;
    constexpr unsigned NU_NSA = NB * 2 * 128, NU_FOX = NB * 4 * 32, NU_SWA = NB * 2 * 128, NU_ATT = NU_NSA + NU_FOX + NU_SWA;
    for (;;) {
        unsigned u = 0;
        if (lane == 0) u = __hip_atomic_fetch_add(ctr, 1u, __ATOMIC_RELAXED, __HIP_MEMORY_SCOPE_AGENT);
        u = (unsigned)__builtin_amdgcn_readfirstlane((int)u);
        if (WITH_CONV) {
            constexpr unsigned CT = (unsigned)CONV_TILES / NL, TOTQ = NU_ATT + CT;
            if (u >= TOTQ) break;
            constexpr unsigned NF = NU_NSA + NU_FOX, TQ1 = NF + CT;
            if (u < TQ1) {
                const unsigned a0 = (unsigned)(((unsigned long long)u * NF) / TQ1), a1 = (unsigned)(((unsigned long long)(u + 1) * NF) / TQ1);
                if (a1 == a0) { conv_tile_wave(p, (int)(l * CT + u - a0), lane, (unsigned char*)ps); continue; }
                u = a0;
            } else u -= CT;
        } else {
#ifndef ATT_REP
#define ATT_REP 1
#endif
            if (u >= ATT_REP * NU_ATT) break;
            if (ATT_REP > 1) u %= NU_ATT;
        }
        if (u < NU_FOX) { const unsigned v = u; const int qb = 31 - (int)(v & 31), r = v >> 5; fox_unit(p, r >> 2, r & 3, qb, fr, fq); }
        else if (u < NU_FOX + NU_NSA) { const unsigned v = u - NU_FOX; const int pos = 127 - (int)(v & 127), r = v >> 7; nsa_unit(p, r >> 1, r & 1, pos, fr, fq, lane, ps, msk, otl); }
        else { const unsigned v = u - NU_NSA - NU_FOX; const int pos = 127 - (int)(v & 127), r = v >> 7; swa_unit(p, l, r >> 1, r & 1, pos, fr, fq); }
    }
}

__device__ __forceinline__ void phase_ln1_router(const Params& p, int l, char* lds) {
    int tid = threadIdx.x; asm volatile("" : "+v"(tid));
    const int wid = tid >> 6, lane = tid & 63, fr = lane & 15, fq = lane >> 4;
    float* lg = (float*)lds + wid * 512;
    int* lcnt = (int*)(lds + 16384); int* lbase = lcnt + 32;
    const float* g1 = p.ln1_g + l * DM; const float* b1 = p.ln1_b + l * DM;
    const float* rw = p.rwT + (size_t)l * NE * 1024; const float* rb = p.router_b + l * NE;
    unsigned* gcount = p.ctrl + 64 + l * NE;
    constexpr int RW_LDS = 20480, RW_PITCH = 2064;
    if (blockIdx.x < NTOK / 128) {
        const bf16_t* rwb = (const bf16_t*)p.rwT + (size_t)l * 64 * 1024;
#pragma unroll 4
        for (int i = 0; i < 16; ++i) { const int pc = wid * 16 + i, r = pc >> 1, q = pc & 1;
            __builtin_amdgcn_global_load_lds((const unsigned*)(rwb + (size_t)r * 1024 + q * 512 + lane * 8), (LAS unsigned*)((LAS char*)lds + RW_LDS + r * RW_PITCH + q * 1024), 16, 0, 0); }
    }
    for (int grp = blockIdx.x; grp < NTOK / 128; grp += gridDim.x) {
        const int tok0 = grp * 128 + wid * 16;
        if (tid < 32) lcnt[tid] = 0;
        float gg[16], bb[16];
#pragma unroll
        for (int j = 0; j < 4; ++j) { const float4 g4 = *(const float4*)(g1 + lane * 16 + j * 4), b4 = *(const float4*)(b1 + lane * 16 + j * 4);
            gg[4 * j] = g4.x; gg[4 * j + 1] = g4.y; gg[4 * j + 2] = g4.z; gg[4 * j + 3] = g4.w; bb[4 * j] = b4.x; bb[4 * j + 1] = b4.y; bb[4 * j + 2] = b4.z; bb[4 * j + 3] = b4.w; }
        u32x4 raw[4][2], xrw[4][2];
#pragma unroll
        for (int i = 0; i < 4; ++i) { const bf16_t* tr = (const bf16_t*)p.tbuf + (size_t)(tok0 + i) * DM + lane * 16; raw[i][0] = *(const u32x4*)tr; raw[i][1] = *(const u32x4*)(tr + 8);
            const bf16_t* xr_ = p.xb + (size_t)(tok0 + i) * DM + lane * 16; xrw[i][0] = *(const u32x4*)xr_; xrw[i][1] = *(const u32x4*)(xr_ + 8); }
#pragma unroll
        for (int r0 = 0; r0 < 16; r0 += 4) {
            float v[4][16]; float s[4], qv[4];
#pragma unroll
            for (int i = 0; i < 4; ++i) {
                const u32x4 t0 = raw[i][0], t1 = raw[i][1], x0 = xrw[i][0], x1 = xrw[i][1];
                const unsigned ts[8] = {t0.x, t0.y, t0.z, t0.w, t1.x, t1.y, t1.z, t1.w}, xs[8] = {x0.x, x0.y, x0.z, x0.w, x1.x, x1.y, x1.z, x1.w};
#pragma unroll
                for (int c = 0; c < 8; ++c) { v[i][2 * c] = __uint_as_float(xs[c] << 16) * ALPHA + __uint_as_float(ts[c] << 16); v[i][2 * c + 1] = __uint_as_float(xs[c] & 0xffff0000u) * ALPHA + __uint_as_float(ts[c] & 0xffff0000u); }
            }
            __builtin_amdgcn_sched_barrier(0);
            if (r0 < 12) {
#pragma unroll
                for (int i = 0; i < 4; ++i) { const bf16_t* tr = (const bf16_t*)p.tbuf + (size_t)(tok0 + r0 + 4 + i) * DM + lane * 16; raw[i][0] = *(const u32x4*)tr; raw[i][1] = *(const u32x4*)(tr + 8);
                    const bf16_t* xr_ = p.xb + (size_t)(tok0 + r0 + 4 + i) * DM + lane * 16; xrw[i][0] = *(const u32x4*)xr_; xrw[i][1] = *(const u32x4*)(xr_ + 8); }
            }
            __builtin_amdgcn_sched_barrier(0);
#pragma unroll
            for (int i = 0; i < 4; ++i) { s[i] = 0.f;
#pragma unroll
                for (int c = 0; c < 16; c += 4) s[i] += (v[i][c] + v[i][c + 1]) + (v[i][c + 2] + v[i][c + 3]); }
#pragma unroll
            for (int o = 32; o > 0; o >>= 1) {
#pragma unroll
                for (int i = 0; i < 4; ++i) s[i] += shfl_f(s[i], lane ^ o); }
#pragma unroll
            for (int i = 0; i < 4; ++i) { const float mean = s[i] * (1.0f / 1024.0f); qv[i] = 0.f;
#pragma unroll
                for (int c = 0; c < 16; c += 4) { v[i][c] -= mean; v[i][c + 1] -= mean; v[i][c + 2] -= mean; v[i][c + 3] -= mean;
                    qv[i] += (v[i][c] * v[i][c] + v[i][c + 1] * v[i][c + 1]) + (v[i][c + 2] * v[i][c + 2] + v[i][c + 3] * v[i][c + 3]); } }
#pragma unroll
            for (int o = 32; o > 0; o >>= 1) {
#pragma unroll
                for (int i = 0; i < 4; ++i) qv[i] += shfl_f(qv[i], lane ^ o); }
#pragma unroll
            for (int i = 0; i < 4; ++i) {
                const float rstd = rsqrtf(qv[i] * (1.0f / 1024.0f) + LN_EPS);
                const size_t row = (size_t)(tok0 + r0 + i);
                float y[16];
#pragma unroll
                for (int c = 0; c < 16; ++c) y[c] = v[i][c] * rstd * gg[c] + bb[c];
                u32x4 w0, w1, q;
                w0.x = pack2(y[0], y[1]); w0.y = pack2(y[2], y[3]); w0.z = pack2(y[4], y[5]); w0.w = pack2(y[6], y[7]);
                w1.x = pack2(y[8], y[9]); w1.y = pack2(y[10], y[11]); w1.z = pack2(y[12], y[13]); w1.w = pack2(y[14], y[15]);
                q.x = pack4_fp8(y[0], y[1], y[2], y[3]); q.y = pack4_fp8(y[4], y[5], y[6], y[7]); q.z = pack4_fp8(y[8], y[9], y[10], y[11]); q.w = pack4_fp8(y[12], y[13], y[14], y[15]);
                *(u32x4*)((bf16_t*)p.x1f + row * DM + lane * 16) = w0; *(u32x4*)((bf16_t*)p.x1f + row * DM + lane * 16 + 8) = w1;
                *(u32x4*)((char*)p.x1b + row * DM + lane * 16) = q;
            }
        }
        asm volatile("s_waitcnt vmcnt(0)" ::: "memory");
        __syncthreads();
        f32x4 a0 = (f32x4){0.f, 0.f, 0.f, 0.f}, a1 = a0;
        const bf16_t* xr = (const bf16_t*)p.x1f + (size_t)(tok0 + fr) * DM + 8 * fq;
        const LAS char* wl = (const LAS char*)lds + RW_LDS + fr * RW_PITCH + fq * 16;
#pragma unroll 8
        for (int ks = 0; ks < 32; ++ks) {
            const bf16x8 xa = *(const bf16x8*)(xr + ks * 32);
            a0 = __builtin_amdgcn_mfma_f32_16x16x32_bf16(xa, *(const LAS bf16x8*)(wl + ks * 64), a0, 0, 0, 0);
            a1 = __builtin_amdgcn_mfma_f32_16x16x32_bf16(xa, *(const LAS bf16x8*)(wl + 16 * RW_PITCH + ks * 64), a1, 0, 0, 0);
            a0 = __builtin_amdgcn_mfma_f32_16x16x32_bf16(xa, *(const LAS bf16x8*)(wl + 32 * RW_PITCH + ks * 64), a0, 0, 0, 0);
            a1 = __builtin_amdgcn_mfma_f32_16x16x32_bf16(xa, *(const LAS bf16x8*)(wl + 48 * RW_PITCH + ks * 64), a1, 0, 0, 0);
        }
#pragma unroll
        for (int r = 0; r < 4; ++r) { lg[(fq * 4 + r) * 32 + fr] = a0[r] + rb[fr]; lg[(fq * 4 + r) * 32 + 16 + fr] = a1[r] + rb[16 + fr]; }
        lds_wave_sync();
        int e4[4] = {0, 0, 0, 0}; int rk[4] = {0, 0, 0, 0};
        float tv[4];
        {
            int l2 = threadIdx.x & 63; asm volatile("" : "+v"(l2)); const int fr2 = l2 & 15, fq2 = l2 >> 4;
            __builtin_amdgcn_sched_barrier(0);
            const f32x4 la = *(const f32x4*)(lg + fr2 * 32 + 8 * fq2), lb = *(const f32x4*)(lg + fr2 * 32 + 8 * fq2 + 4);
            const float lv[8] = {la[0], la[1], la[2], la[3], lb[0], lb[1], lb[2], lb[3]};
            unsigned taken = 0u;
#pragma unroll
            for (int k = 0; k < 4; ++k) {
                float best = NEG_INF; int bi = 64;
#pragma unroll
                for (int i = 0; i < 8; ++i) { const int j = 8 * fq2 + i; if (!((taken >> j) & 1u) && lv[i] > best) { best = lv[i]; bi = j; } }
                {   auto rb = __builtin_amdgcn_permlane32_swap(__float_as_uint(best), __float_as_uint(best), false, false); auto ri = __builtin_amdgcn_permlane32_swap((unsigned)bi, (unsigned)bi, false, false);
                    const float b0 = __uint_as_float(rb[0]), b1 = __uint_as_float(rb[1]); const int i0 = (int)ri[0], i1 = (int)ri[1];
                    const bool t1 = b1 > b0 || (b1 == b0 && i1 < i0); best = t1 ? b1 : b0; bi = t1 ? i1 : i0; }
                {   auto rb = __builtin_amdgcn_permlane16_swap(__float_as_uint(best), __float_as_uint(best), false, false); auto ri = __builtin_amdgcn_permlane16_swap((unsigned)bi, (unsigned)bi, false, false);
                    const float b0 = __uint_as_float(rb[0]), b1 = __uint_as_float(rb[1]); const int i0 = (int)ri[0], i1 = (int)ri[1];
                    const bool t1 = b1 > b0 || (b1 == b0 && i1 < i0); best = t1 ? b1 : b0; bi = t1 ? i1 : i0; }
                bi &= 31;
                taken |= 1u << bi; e4[k] = bi; tv[k] = best;
            }
        }
        if (lane < 16) {
            const float e1 = __expf(tv[1] - tv[0]), e2 = __expf(tv[2] - tv[0]), e3 = __expf(tv[3] - tv[0]);
            const float inv = 1.0f / (1.0f + e1 + e2 + e3);
            const size_t row = (size_t)(tok0 + lane);
            *(float4*)(p.gw + row * 4) = make_float4(inv, e1 * inv, e2 * inv, e3 * inv);
        }
        __syncthreads();
        if (lane < 16) {
#pragma unroll
            for (int k = 0; k < 4; ++k) rk[k] = atomicAdd(&lcnt[e4[k]], 1);
        }
        __syncthreads();
        if (tid < 32) { const int c = lcnt[tid]; lbase[tid] = c ? (int)__hip_atomic_fetch_add(gcount + tid, (unsigned)c, __ATOMIC_RELAXED, __HIP_MEMORY_SCOPE_AGENT) : 0; }
        __syncthreads();
        if (lane < 16) {
            const int row = tok0 + lane; int pk[4];
#pragma unroll
            for (int k = 0; k < 4; ++k) { const int pos = lbase[e4[k]] + rk[k]; p.lists[(size_t)e4[k] * LIST_CAP + pos] = row * 4 + k; pk[k] = (pos << 5) | e4[k]; }
            *(int4*)(p.top_e + (size_t)row * 4) = make_int4(pk[0], pk[1], pk[2], pk[3]);
        }
        __syncthreads();
    }
}

__device__ __forceinline__ void phase_ln2(const Params& p, int l, float* xout, char* lds) {
    int* ptile = (int*)(lds + LDS_TAB); int* ecnt = ptile + 40;
    int tid = threadIdx.x; asm volatile("" : "+v"(tid));
    const int wid = tid >> 6, lane = tid & 63;
    const float* g2 = p.ln2_g + l * DM; const float* b2 = p.ln2_b + l * DM;
    float gg[16], bb[16];
#pragma unroll
    for (int j = 0; j < 4; ++j) { const float4 g4 = *(const float4*)(g2 + lane * 16 + j * 4), b4 = *(const float4*)(b2 + lane * 16 + j * 4);
        gg[4 * j] = g4.x; gg[4 * j + 1] = g4.y; gg[4 * j + 2] = g4.z; gg[4 * j + 3] = g4.w; bb[4 * j] = b4.x; bb[4 * j + 1] = b4.y; bb[4 * j + 2] = b4.z; bb[4 * j + 3] = b4.w; }
    const int pstep = gridDim.x * NWV;
    int pr = blockIdx.x * NWV + wid;
    float4 gwn[2]; int4 ten[2];
    u32x4 yn[2][4], xn[2][2];
    float gk[2][4];
    auto load_meta = [&](int q) {
#pragma unroll
        for (int i = 0; i < 2; ++i) { const int row = q * 2 + i; gwn[i] = *(const float4*)(p.gw + (size_t)row * 4); ten[i] = *(const int4*)(p.top_e + (size_t)row * 4); }
    };
    auto load_rows = [&](int q) {
#pragma unroll
        for (int i = 0; i < 2; ++i) {
            const int row = q * 2 + i;
            const int tk[4] = {ten[i].x, ten[i].y, ten[i].z, ten[i].w};
            xn[i][0] = *(const u32x4*)((const bf16_t*)p.x1f + (size_t)row * DM + lane * 16); xn[i][1] = *(const u32x4*)((const bf16_t*)p.x1f + (size_t)row * DM + lane * 16 + 8);
#pragma unroll
            for (int k = 0; k < 4; ++k) yn[i][k] = *(const u32x4*)((const unsigned char*)p.ybuf + (size_t)(ptile[tk[k] & 31] * 256 + (tk[k] >> 5)) * DM + lane * 16);
        }
    };
    if (pr < NTOK / 2) { load_meta(pr); load_rows(pr); }
#pragma unroll
    for (int i = 0; i < 2; ++i) { gk[i][0] = gwn[i].x; gk[i][1] = gwn[i].y; gk[i][2] = gwn[i].z; gk[i][3] = gwn[i].w; }
    if (pr + pstep < NTOK / 2) load_meta(pr + pstep);
    for (; pr < NTOK / 2; pr += pstep) {
        float v[2][16]; float s[2], qv[2];
#pragma unroll
        for (int i = 0; i < 2; ++i) { s[i] = 0.f;
            const unsigned xs[8] = {xn[i][0].x, xn[i][0].y, xn[i][0].z, xn[i][0].w, xn[i][1].x, xn[i][1].y, xn[i][1].z, xn[i][1].w};
#pragma unroll
            for (int c = 0; c < 8; ++c) { v[i][2 * c] = __uint_as_float(xs[c] << 16) * ALPHA; v[i][2 * c + 1] = __uint_as_float(xs[c] & 0xffff0000u) * ALPHA; }
#pragma unroll
            for (int k = 0; k < 4; ++k) {
                const unsigned ys[4] = {yn[i][k].x, yn[i][k].y, yn[i][k].z, yn[i][k].w};
#pragma unroll
                for (int c = 0; c < 4; ++c) {
                    const f32x2_t lo = __builtin_amdgcn_cvt_pk_f32_fp8(ys[c], false), hi = __builtin_amdgcn_cvt_pk_f32_fp8(ys[c], true);
                    v[i][4 * c] += gk[i][k] * lo.x; v[i][4 * c + 1] += gk[i][k] * lo.y; v[i][4 * c + 2] += gk[i][k] * hi.x; v[i][4 * c + 3] += gk[i][k] * hi.y;
                }
            }
#pragma unroll
            for (int c = 0; c < 16; c += 4) s[i] += (v[i][c] + v[i][c + 1]) + (v[i][c + 2] + v[i][c + 3]);
        }
        __builtin_amdgcn_sched_barrier(0);
        if (pr + pstep < NTOK / 2) {
#pragma unroll
            for (int i = 0; i < 2; ++i) { gk[i][0] = gwn[i].x; gk[i][1] = gwn[i].y; gk[i][2] = gwn[i].z; gk[i][3] = gwn[i].w; }
            load_rows(pr + pstep);
            if (pr + 2 * pstep < NTOK / 2) load_meta(pr + 2 * pstep);
        }
        __builtin_amdgcn_sched_barrier(0);
#pragma unroll
        for (int o = 32; o > 0; o >>= 1) { s[0] += shfl_f(s[0], lane ^ o); s[1] += shfl_f(s[1], lane ^ o); }
#pragma unroll
        for (int i = 0; i < 2; ++i) { const float mean = s[i] * (1.0f / 1024.0f); qv[i] = 0.f;
#pragma unroll
            for (int c = 0; c < 16; c += 4) { v[i][c] -= mean; v[i][c + 1] -= mean; v[i][c + 2] -= mean; v[i][c + 3] -= mean;
                qv[i] += (v[i][c] * v[i][c] + v[i][c + 1] * v[i][c + 1]) + (v[i][c + 2] * v[i][c + 2] + v[i][c + 3] * v[i][c + 3]); } }
#pragma unroll
        for (int o = 32; o > 0; o >>= 1) { qv[0] += shfl_f(qv[0], lane ^ o); qv[1] += shfl_f(qv[1], lane ^ o); }
#pragma unroll
        for (int i = 0; i < 2; ++i) {
            const float rstd = rsqrtf(qv[i] * (1.0f / 1024.0f) + LN_EPS);
            const size_t row = (size_t)(pr * 2 + i);
            float y[16];
#pragma unroll
            for (int c = 0; c < 16; ++c) y[c] = v[i][c] * rstd * gg[c] + bb[c];
            if (l + 1 < NL) {
                u32x4 w0, w1, q;
                w0.x = pack2(y[0], y[1]); w0.y = pack2(y[2], y[3]); w0.z = pack2(y[4], y[5]); w0.w = pack2(y[6], y[7]);
                w1.x = pack2(y[8], y[9]); w1.y = pack2(y[10], y[11]); w1.z = pack2(y[12], y[13]); w1.w = pack2(y[14], y[15]);
                q.x = pack4_fp8(y[0], y[1], y[2], y[3]); q.y = pack4_fp8(y[4], y[5], y[6], y[7]); q.z = pack4_fp8(y[8], y[9], y[10], y[11]); q.w = pack4_fp8(y[12], y[13], y[14], y[15]);
                *(u32x4*)(p.xb + row * DM + lane * 16) = w0; *(u32x4*)(p.xb + row * DM + lane * 16 + 8) = w1;
                *(u32x4*)(p.xq + row * DM + lane * 16) = q;
            } else {
#pragma unroll
                for (int c = 0; c < 16; c += 4) *(float4*)(xout + row * DM + lane * 16 + c) = make_float4(y[c], y[c + 1], y[c + 2], y[c + 3]);
            }
        }
    }
}

#define XB_TMO      128
#define XB_XCNT(j)  (256  + 64 * (j))
#define XB_XSUB(j)  (1280 + 64 * (j))
#define XB_XGEN(j)  (2304 + 64 * (j))
#define XB_TOP      3328
#define XB_TOPGEN   3392
#define XCD_BAR_WORDS 3456
#define XB_SPIN_CAP (1u << 22)
__device__ __forceinline__ unsigned xb_ld(unsigned* p)              { return __hip_atomic_load(p, __ATOMIC_RELAXED, __HIP_MEMORY_SCOPE_AGENT); }
__device__ __forceinline__ unsigned xb_add(unsigned* p, unsigned v) { return __hip_atomic_fetch_add(p, v, __ATOMIC_RELAXED, __HIP_MEMORY_SCOPE_AGENT); }
__device__ __forceinline__ unsigned xb_xcc_id() { return (unsigned)__builtin_amdgcn_s_getreg((3 << 11) | 20) & 0xFu; }
#define XB_SPIN(cond, bar) do { unsigned _sp = 0; while (cond) { __builtin_amdgcn_s_sleep(1); \
    if ((++_sp & 255u) == 0u) { if (xb_ld(&(bar)[XB_TMO])) break; if (_sp > XB_SPIN_CAP) { atomicAdd(&(bar)[XB_TMO], 1u); break; } } } } while (0)
struct XcdBarrier { unsigned* bar; unsigned x; volatile LAS unsigned* st; };
__device__ __forceinline__ XcdBarrier xcd_barrier_post(unsigned* bar, volatile LAS unsigned* st) {
    XcdBarrier b; b.bar = bar; b.x = xb_xcc_id(); b.st = st;
    if (threadIdx.x == 0) (void)xb_add(&bar[XB_XCNT(b.x)], 1u);
    return b;
}
__device__ __forceinline__ void xcd_barrier_complete(unsigned* bar, unsigned x, unsigned& nloc, unsigned& nx) {
    const unsigned G = gridDim.x * gridDim.y * gridDim.z;
    unsigned sum, cnt, mine, sp = 0u;
    for (;;) {
        sum = 0u; cnt = 0u; mine = 0u;
#pragma unroll
        for (unsigned j = 0; j < 16; ++j) { const unsigned c = xb_ld(&bar[XB_XCNT(j)]); sum += c; cnt += (c > 0u) ? 1u : 0u; mine = (j == x) ? c : mine; }
        if (sum == G) break;
        __builtin_amdgcn_s_sleep(1);
        if ((++sp & 255u) == 0u) { if (xb_ld(&bar[XB_TMO])) break; if (sp > XB_SPIN_CAP) { atomicAdd(&bar[XB_TMO], 1u); break; } }
    }
    nloc = mine > 0u ? mine : 1u; nx = cnt > 0u ? cnt : 1u;
}
__device__ __forceinline__ void xcd_barrier(const XcdBarrier& b) {
    asm volatile("s_waitcnt vmcnt(0)" ::: "memory");
    __syncthreads();
    if (threadIdx.x == 0) {
        unsigned* bar = b.bar;
        __builtin_amdgcn_s_waitcnt(0);
        unsigned nloc = b.st[0], nx = b.st[1];
        if (nloc == 0u) { xcd_barrier_complete(bar, b.x, nloc, nx); b.st[0] = nloc; b.st[1] = nx; }
        const unsigned old = xb_add(&bar[XB_XSUB(b.x)], 1u);
        const unsigned gen = old / nloc;
        if (old + 1u == (gen + 1u) * nloc) {
            __builtin_amdgcn_fence(__ATOMIC_RELEASE, "agent");
            asm volatile("s_waitcnt vmcnt(0)" ::: "memory");
            const unsigned og = xb_add(&bar[XB_TOP], 1u);
            const unsigned tg = og / nx;
            if (og + 1u == (tg + 1u) * nx) xb_add(&bar[XB_TOPGEN], 1u);
            else XB_SPIN(xb_ld(&bar[XB_TOPGEN]) == tg, bar);
            __builtin_amdgcn_fence(__ATOMIC_ACQUIRE, "agent");
            xb_add(&bar[XB_XGEN(b.x)], 1u);
            asm volatile("s_waitcnt vmcnt(0)" ::: "memory");
        } else {
            XB_SPIN(xb_ld(&bar[XB_XGEN(b.x)]) == gen, bar);
            __builtin_amdgcn_fence(__ATOMIC_ACQUIRE, "agent");
            asm volatile("s_waitcnt vmcnt(0)" ::: "memory");
        }
    }
    __syncthreads();
}

struct KArgs { const float* in[18]; float* out; char* ws; };
constexpr size_t al256(size_t v) { return (v + 255) / 256 * 256; }
struct WSL {
    static constexpr size_t ctrl = 0;
    static constexpr size_t WinT = al256(ctrl + 65536);
    static constexpr size_t WoT = al256(WinT + (size_t)NL * NPAD * 1024 * 2);
    static constexpr size_t W1T = al256(WoT + (size_t)NL * 1024 * 1024 * 2);
    static constexpr size_t W2T = al256(W1T + (size_t)NL * 2 * 64 * 2048 * 2);
    static constexpr size_t WguT = al256(W2T + (size_t)NL * 2 * 64 * 64 * 2);
    static constexpr size_t WdnT = al256(WguT + (size_t)NL * NE * 2048 * 1024 * 2);
    static constexpr size_t rwT = al256(WdnT + (size_t)NL * NE * 1024 * 1024 * 2);
    static constexpr size_t binp = al256(rwT + (size_t)NL * NE * 1024 * 4);
    static constexpr size_t bgup = al256(binp + (size_t)NL * NPAD * 4);
    static constexpr size_t b1c = al256(bgup + (size_t)NL * NE * 2048 * 4);
    static constexpr size_t xf = al256(b1c + 4 * 8 * 64 * 4);
    static constexpr size_t xb = al256(xf + (size_t)NTOK * DM * 4);
    static constexpr size_t hb = al256(xb + (size_t)NTOK * DM * 2);
    static constexpr size_t hs = al256(hb + (size_t)NTOK * NMAIN * 2);
    static constexpr size_t vT = al256(hs + (size_t)NTOK * HS_W * 4);
    static constexpr size_t kF = al256(vT + (size_t)NB * NVH * 64 * SEQ * 2);
    static constexpr size_t cF = al256(kF + (size_t)NB * NVH * 64 * SEQ * 2);
    static constexpr size_t kc = al256(cF + (size_t)NB * 4 * SEQ * 4);
    static constexpr size_t vc = al256(kc + (size_t)NB * 2 * 128 * 64 * 2);
    static constexpr size_t vcT = al256(vc + (size_t)NB * 2 * 128 * 64 * 2);
    static constexpr size_t ob = al256(vcT + (size_t)NB * 2 * 128 * 64 * 2);
    static constexpr size_t tbuf = al256(ob + (size_t)NTOK * DM * 2);
    static constexpr size_t x1f = al256(tbuf + (size_t)NTOK * DM * 4);
    static constexpr size_t x1b = al256(x1f + (size_t)NTOK * DM * 4);
    static constexpr size_t top_e = al256(x1b + (size_t)NTOK * DM * 2);
    static constexpr size_t gw = al256(top_e + (size_t)NTOK * 4 * 4);
    static constexpr size_t lists = al256(gw + (size_t)NTOK * 4 * 4);
    static constexpr size_t act = al256(lists + (size_t)NE * LIST_CAP * 4);
    static constexpr size_t ybuf = al256(act + (size_t)MAXSLOT * DFF * 2);
    static constexpr size_t xq = al256(ybuf + (size_t)MAXSLOT * DM * 2);
    static constexpr size_t WinQ = al256(xq + (size_t)NTOK * DM);
    static constexpr size_t total = al256(WinQ + (size_t)NL * NMAIN * 1024);
};
__device__ __forceinline__ Params make_params(const KArgs& k) {
    Params p;
    p.x = k.in[0]; p.w_in = k.in[1]; p.b_in = k.in[2]; p.sinks = k.in[3]; p.cmp_pe = k.in[4]; p.cmp_w1 = k.in[5]; p.cmp_w2 = k.in[6]; p.w_out = k.in[7];
    p.ln1_g = k.in[8]; p.ln1_b = k.in[9]; p.router_w = k.in[10]; p.router_b = k.in[11]; p.w_gu = k.in[12]; p.b_gu = k.in[13]; p.w_dn = k.in[14]; p.b_dn = k.in[15];
    p.ln2_g = k.in[16]; p.ln2_b = k.in[17]; p.out = k.out;
    char* w = k.ws;
    p.ctrl = (unsigned*)(w + WSL::ctrl); p.WinT = (bf16_t*)(w + WSL::WinT); p.WoT = (bf16_t*)(w + WSL::WoT); p.W1T = (bf16_t*)(w + WSL::W1T); p.W2T = (bf16_t*)(w + WSL::W2T);
    p.WguT = (bf16_t*)(w + WSL::WguT); p.WdnT = (bf16_t*)(w + WSL::WdnT); p.rwT = (float*)(w + WSL::rwT); p.binp = (float*)(w + WSL::binp); p.bgup = (float*)(w + WSL::bgup);
    p.b1c = (float*)(w + WSL::b1c); p.xf = (float*)(w + WSL::xf); p.xb = (bf16_t*)(w + WSL::xb); p.hb = (bf16_t*)(w + WSL::hb); p.hs = (float*)(w + WSL::hs); p.vT = (bf16_t*)(w + WSL::vT); p.kF = (bf16_t*)(w + WSL::kF);
    p.cF = (float*)(w + WSL::cF); p.kc = (bf16_t*)(w + WSL::kc); p.vc = (bf16_t*)(w + WSL::vc); p.vcT = (bf16_t*)(w + WSL::vcT); p.ob = (bf16_t*)(w + WSL::ob); p.tbuf = (float*)(w + WSL::tbuf);
    p.x1f = (float*)(w + WSL::x1f); p.x1b = (bf16_t*)(w + WSL::x1b); p.top_e = (int*)(w + WSL::top_e); p.gw = (float*)(w + WSL::gw); p.lists = (int*)(w + WSL::lists);
    p.act = (bf16_t*)(w + WSL::act); p.ybuf = (bf16_t*)(w + WSL::ybuf); p.xq = (unsigned char*)(w + WSL::xq); p.WinQ = (unsigned char*)(w + WSL::WinQ);
    return p;
}
__device__ __forceinline__ void grid_bar(const Params& p, char* lds) {
    XcdBarrier xb; xb.bar = p.ctrl + 1024; xb.x = xb_xcc_id(); xb.st = (volatile LAS unsigned*)(lds + LDS_BYTES - 16); xcd_barrier(xb);
}
__device__ __forceinline__ Params fresh_params(const KArgs& ka) {
    KArgs k2 = ka; size_t z = 0; asm volatile("" : "+s"(z));
    k2.ws = ka.ws + z;
    return make_params(k2);
}
#ifndef REP
#define REP 0
#endif
template <int L>
__device__ __forceinline__ void layer_fwd(const KArgs& ka, char* lds) {
    { const Params p = fresh_params(ka); phase_inproj(p, L, lds);        grid_bar(p, lds); }
    { const Params p = fresh_params(ka); phase_prep(p, L, lds);          grid_bar(p, lds); }
    { const Params p = fresh_params(ka); phase_attn<true>(p, L, lds);  grid_bar(p, lds); }
    { const Params p = fresh_params(ka); phase_outproj(p, L, p.xb, lds);  grid_bar(p, lds); }
    { const Params p = fresh_params(ka); phase_ln1_router(p, L, lds);    grid_bar(p, lds); }
    { const Params p = fresh_params(ka); phase_gateup(p, L, lds);        grid_bar(p, lds); }
    { const Params p = fresh_params(ka); phase_down(p, L, lds);          grid_bar(p, lds); }
    { const Params p = fresh_params(ka); phase_ln2(p, L, L == NL - 1 ? p.out : p.xf, lds); }
}
__global__ void __launch_bounds__(NTHR, 2) fwd_kernel(KArgs ka) {
    extern __shared__ __attribute__((aligned(16))) char lds[];
    const Params p = make_params(ka);
    cg::grid_group grid = cg::this_grid();
    if (blockIdx.x == 0) {
        u32x4* cz = (u32x4*)p.ctrl;
#pragma unroll
        for (int i = 0; i < 8; ++i) cz[threadIdx.x + NTHR * i] = (u32x4){0u, 0u, 0u, 0u};
        __threadfence();
    }
    grid.sync();
    volatile LAS unsigned* xst = (volatile LAS unsigned*)(lds + LDS_BYTES - 16);
    if (threadIdx.x == 0) { xst[0] = 0u; xst[1] = 0u; }
    __syncthreads();
    (void)xcd_barrier_post(p.ctrl + 1024, xst);
    volatile LAS int* vcu = (volatile LAS int*)(lds + LDS_BYTES - 32);
    const unsigned myx = xb_xcc_id() & 7u;
    if (threadIdx.x == 0) vcu[1] = (int)__hip_atomic_fetch_add(p.ctrl + 32 + myx, 1u, __ATOMIC_RELAXED, __HIP_MEMORY_SCOPE_AGENT);
    phase0(p, lds);
    grid_bar(p, lds);
    if (threadIdx.x == 0) {
        int base = 0, tot = 0;
        for (unsigned x = 0; x < 8; ++x) { const int n = (int)__hip_atomic_load(p.ctrl + 32 + x, __ATOMIC_RELAXED, __HIP_MEMORY_SCOPE_AGENT); if (x < myx) base += n; tot += n; }
        vcu[0] = (tot == (int)gridDim.x) ? base + vcu[1] : (int)blockIdx.x;
    }
    __syncthreads();
    layer_fwd<0>(ka, lds);
    grid_bar(p, lds);
    layer_fwd<1>(ka, lds);
}

extern "C" void kernel_launch(void* const* d_in, const int* in_sizes, int n_in, void* d_out, int out_size, void* d_ws, size_t ws_size, hipStream_t stream) {
    KArgs ka{};
    for (int i = 0; i < 18; ++i) ka.in[i] = (const float*)d_in[i];
    ka.out = (float*)d_out; ka.ws = (char*)d_ws;
    if (WSL::total > ws_size) { fprintf(stderr, "workspace too small: need %zu have %zu\n", (size_t)WSL::total, ws_size); return; }
    static int grid_blocks = 0;
    if (!grid_blocks) {
        int dev = 0, cus = 0, per_cu = 0;
        (void)hipGetDevice(&dev);
        (void)hipDeviceGetAttribute(&cus, hipDeviceAttributeMultiprocessorCount, dev);
        (void)hipFuncSetAttribute((const void*)fwd_kernel, hipFuncAttributeMaxDynamicSharedMemorySize, LDS_BYTES);
        (void)hipOccupancyMaxActiveBlocksPerMultiprocessor(&per_cu, fwd_kernel, NTHR, LDS_BYTES);
        if (per_cu < 1) { fprintf(stderr, "occupancy query says 0 blocks per CU\n"); per_cu = 1; }
        grid_blocks = cus;
    }
    void* args[] = {&ka};
    hipError_t e = hipLaunchCooperativeKernel((const void*)fwd_kernel, dim3(grid_blocks), dim3(NTHR), args, LDS_BYTES, stream);
    if (e != hipSuccess) fprintf(stderr, "cooperative launch failed: %s (grid %d)\n", hipGetErrorString(e), grid_blocks);
}
```
